# Optimizing an MI355X kernel written in HIP

```python
import math
import jax
import jax.numpy as jnp
from jax import lax
import numpy as np

D_MODEL = 2048
BATCH = 2
SEQ = 4096
DEPTH = 4
DEC_BATCH = 32
DEC_SEQ = 4
PAST_LEN = 16384
PAGE_SIZE = 128

N_BRANCH = 4
BRANCH_WIDTH = D_MODEL // 2
GLA_HEADS = 4
GLA_QK = BRANCH_WIDTH // 2
GLA_V = BRANCH_WIDTH
GLA_DK = GLA_QK // GLA_HEADS
GLA_DV = GLA_V // GLA_HEADS
GLA_GATE_RANK = 16
GLA_TAU = 16.0
GLA_CHUNK = 64
SWA_HEAD_DIM = 64
SWA_Q_HEADS = BRANCH_WIDTH // SWA_HEAD_DIM
SWA_KV_HEADS = 2
WINDOW = 128
SWA_BLOCK = 128
RWKV_HEAD = 64
RWKV_HEADS = BRANCH_WIDTH // RWKV_HEAD
RWKV_DECAY_RANK = 64
RWKV_A_RANK = 64
RWKV_GATE_RANK = 128
RWKV_SIZES = (BRANCH_WIDTH, BRANCH_WIDTH, BRANCH_WIDTH, RWKV_DECAY_RANK, RWKV_A_RANK, RWKV_GATE_RANK)
RWKV_COLS = 3 * BRANCH_WIDTH + RWKV_DECAY_RANK + RWKV_A_RANK + RWKV_GATE_RANK
MEM_TOKENS = 256
MEM_HEADS = 4
MEM_HEAD_DIM = BRANCH_WIDTH // MEM_HEADS
D_FF = -(-8 * D_MODEL // (3 * 256)) * 256
DEEPNORM_ALPHA = (2 * DEPTH) ** 0.25
DEEPNORM_BETA = (8 * DEPTH) ** -0.25
NEG = -1e30
IN_SIZES = (GLA_QK, GLA_QK, GLA_V, GLA_V, GLA_GATE_RANK,
            SWA_Q_HEADS * SWA_HEAD_DIM, SWA_KV_HEADS * SWA_HEAD_DIM, SWA_KV_HEADS * SWA_HEAD_DIM,
            RWKV_COLS, MEM_HEADS * MEM_HEAD_DIM, N_BRANCH * D_MODEL)

kernel_name = 'hybrid_gla_swa_rwkv7_decoder_step'


def _split(u, sizes):
    pts, acc = [], 0
    for s in sizes[:-1]:
        acc += s
        pts.append(acc)
    return jnp.split(u, pts, axis=-1)


def _heads(t, h):
    return t.reshape(t.shape[:-1] + (h, t.shape[-1] // h))


def layer_norm(x, g, b, eps=1e-5):
    xf = x.astype(jnp.float32)
    mu = xf.mean(-1, keepdims=True)
    var = jnp.mean(jnp.square(xf - mu), -1, keepdims=True)
    return ((xf - mu) * lax.rsqrt(var + eps) * g + b).astype(x.dtype)


def head_norm(o, g, b, eps):
    of = o.astype(jnp.float32)
    mu = of.mean(-1, keepdims=True)
    var = jnp.mean(jnp.square(of - mu), -1, keepdims=True)
    n = (of - mu) * lax.rsqrt(var + eps)
    return n.reshape(o.shape[:-2] + (-1,)) * g + b


def alibi_slopes():
    return 2.0 ** (-8.0 * jnp.arange(1, SWA_Q_HEADS + 1, dtype=jnp.float32) / SWA_Q_HEADS)


def sink_softmax(s, sink):
    m = jnp.maximum(s.max(-1, keepdims=True), sink)
    p = jnp.exp(s - m)
    return p / (p.sum(-1, keepdims=True) + jnp.exp(sink - m))


def gla_chunked(q, k, v, log_a, s0):
    B, L, H, _ = q.shape
    C = math.gcd(GLA_CHUNK, L)
    n = L // C

    def to_chunks(t):
        return t.reshape(B, n, C, H, t.shape[-1]).transpose(1, 0, 3, 2, 4)

    causal = jnp.tril(jnp.ones((C, C), dtype=bool))

    def step(S, inp):
        qi, ki, vi, ai = inp
        b = jnp.cumsum(ai, axis=-2)
        q_dec = qi * jnp.exp(b)
        att = jnp.einsum('bhtk,bhsk->bhts', q_dec, ki * jnp.exp(-b))
        att = jnp.where(causal, att, 0.0)
        o = jnp.einsum('bhts,bhsv->bhtv', att, vi) + jnp.einsum('bhtk,bhkv->bhtv', q_dec, S)
        b_last = b[:, :, -1:, :]
        S = (jnp.exp(b_last[:, :, 0, :])[..., None] * S
             + jnp.einsum('bhsk,bhsv->bhkv', ki * jnp.exp(b_last - b), vi))
        return S, o

    S, o = lax.scan(step, s0, (to_chunks(q), to_chunks(k), to_chunks(v), to_chunks(log_a)))
    return o.transpose(1, 0, 3, 2, 4).reshape(B, L, H, v.shape[-1]), S


def swa_banded(q, k, v, sinks):
    B, L, HQ, D = q.shape
    KV = k.shape[2]
    G = HQ // KV
    T = SWA_BLOCK
    nb = L // T
    qb = q.reshape(B, nb, T, KV, G, D)

    def with_prev(t):
        tb = t.reshape(B, nb, T, KV, D)
        prev = jnp.concatenate([jnp.zeros_like(tb[:, :1]), tb[:, :-1]], axis=1)
        return jnp.concatenate([prev, tb], axis=2)

    k2, v2 = with_prev(k), with_prev(v)
    s = jnp.einsum('bntkgd,bnskd->bnkgts', qb, k2).astype(jnp.float32) * SWA_HEAD_DIM ** -0.5
    dist = T + jnp.arange(T)[:, None] - jnp.arange(2 * T)[None, :]
    valid = (dist >= 0) & (dist <= WINDOW)
    valid = valid[None] & ((jnp.arange(nb) > 0)[:, None, None] | (jnp.arange(2 * T) >= T)[None, None, :])
    slopes = alibi_slopes().reshape(KV, G, 1, 1)
    s = jnp.where(valid[None, :, None, None], s - slopes * dist, NEG)
    p = sink_softmax(s, sinks.astype(jnp.float32).reshape(KV, G, 1, 1))
    o = jnp.einsum('bnkgts,bnskd->bntkgd', p.astype(v.dtype), v2)
    return o.reshape(B, L, HQ, D)


def swa_with_buffer(q, k, v, kbuf, vbuf, sinks):
    B, L, HQ, D = q.shape
    KV = k.shape[2]
    G = HQ // KV
    W = kbuf.shape[1]
    kc = jnp.concatenate([kbuf.astype(k.dtype), k], axis=1)
    vc = jnp.concatenate([vbuf.astype(v.dtype), v], axis=1)
    s = jnp.einsum('btkgd,bskd->bkgts', q.reshape(B, L, KV, G, D), kc).astype(jnp.float32) * SWA_HEAD_DIM ** -0.5
    dist = W + jnp.arange(L)[:, None] - jnp.arange(W + L)[None, :]
    valid = (dist >= 0) & (dist <= WINDOW)
    slopes = alibi_slopes().reshape(KV, G, 1, 1)
    s = jnp.where(valid, s - slopes * dist, NEG)
    p = sink_softmax(s, sinks.astype(jnp.float32).reshape(KV, G, 1, 1))
    o = jnp.einsum('bkgts,bskd->btkgd', p.astype(v.dtype), vc).reshape(B, L, HQ, D)
    return o, kc[:, L:], vc[:, L:]


def rwkv7_scan(r, w, k, v, kk, a, s0):
    def step(S, inp):
        rt, wt, kt, vt, kkt, at = inp
        S = (S * wt[:, :, None, :]
             - jnp.einsum('bhvk,bhk->bhv', S, kkt)[..., None] * (kkt * at)[:, :, None, :]
             + vt[..., None] * kt[:, :, None, :])
        return S, jnp.einsum('bhvk,bhk->bhv', S, rt)

    xs = tuple(t.transpose(1, 0, 2, 3) for t in (r, w, k, v, kk, a))
    S, y = lax.scan(step, s0, xs)
    return y.transpose(1, 0, 2, 3), S


def rwkv7_branch(ru, prev, s0, p):
    B, L, _ = ru.shape
    f32 = jnp.float32
    shifted = jnp.concatenate([prev.astype(ru.dtype), ru[:, :-1]], axis=1)
    xm = (ru + (shifted - ru) * p['rwkv_mu']).astype(f32)
    r, k, v, wd, ad, gd = _split(xm, RWKV_SIZES)
    log_w = -jax.nn.softplus(-(p['rwkv_w0'] + jnp.tanh(wd) @ p['rwkv_w2'])) - 0.5
    decay = jnp.exp(-jnp.exp(log_w))
    a = jax.nn.sigmoid(p['rwkv_a0'] + ad @ p['rwkv_a2'])
    g = jax.nn.sigmoid(gd) @ p['rwkv_g2']
    kk = _heads(k * p['rwkv_k_k'], RWKV_HEADS)
    kk = kk / jnp.maximum(jnp.sqrt(jnp.sum(kk * kk, axis=-1, keepdims=True)), 1e-12)
    k = k * (1.0 + (a - 1.0) * p['rwkv_k_a'])
    rh, kh, vh, ah, wh = (_heads(t, RWKV_HEADS) for t in (r, k, v, a, decay))
    y, S = rwkv7_scan(rh, wh, kh, vh, kk, ah, s0.astype(f32))
    y = head_norm(y, p['rwkv_ln_g'], p['rwkv_ln_b'], 64e-5)
    bonus = (jnp.sum(rh * kh * p['rwkv_r_k'], axis=-1, keepdims=True) * vh).reshape(B, L, BRANCH_WIDTH)
    out = (y + bonus) * g
    return out.astype(ru.dtype), S.astype(s0.dtype), ru[:, -1:]


def mem_attend(q, mk, mv):
    s = jnp.einsum('bthd,bmhd->bhtm', q, mk.astype(q.dtype)).astype(jnp.float32) * MEM_HEAD_DIM ** -0.5
    pr = jax.nn.softmax(s, axis=-1)
    return jnp.einsum('bhtm,bmhd->bthd', pr.astype(q.dtype), mv.astype(q.dtype))


def trunk_layer(h, p, mem_k, mem_v, gla_s0, rwkv_s0, rwkv_prev, swa_kbuf, swa_vbuf):
    B, L, _ = h.shape
    f32 = jnp.float32
    u = h @ p['w_in']
    gq, gk, gv, gr, ga, sq, sk, sv, ru, mq, gpre = _split(u, IN_SIZES)

    log_a = jax.nn.log_sigmoid((ga @ p['gla_a_up'] + p['gla_a_b']).astype(f32)) / GLA_TAU
    o_a, gla_s = gla_chunked(_heads(gq, GLA_HEADS).astype(f32) * GLA_DK ** -0.5,
                             _heads(gk, GLA_HEADS).astype(f32),
                             _heads(gv, GLA_HEADS).astype(f32),
                             _heads(log_a, GLA_HEADS), gla_s0.astype(f32))
    o_a = (head_norm(o_a, p['gla_norm_g'], p['gla_norm_b'], 1e-5) * jax.nn.silu(gr.astype(f32))).astype(h.dtype)

    q_b = _heads(sq, SWA_Q_HEADS)
    k_b = _heads(sk, SWA_KV_HEADS)
    v_b = _heads(sv, SWA_KV_HEADS)
    if swa_kbuf is None:
        o_b = swa_banded(q_b, k_b, v_b, p['swa_sinks'])
        new_kbuf, new_vbuf = k_b[:, L - WINDOW:], v_b[:, L - WINDOW:]
    else:
        o_b, new_kbuf, new_vbuf = swa_with_buffer(q_b, k_b, v_b, swa_kbuf, swa_vbuf, p['swa_sinks'])
    o_b = o_b.reshape(B, L, BRANCH_WIDTH).astype(h.dtype)

    o_c, rwkv_s, rwkv_last = rwkv7_branch(ru, rwkv_prev, rwkv_s0, p)

    o_m = mem_attend(_heads(mq, MEM_HEADS), mem_k, mem_v).reshape(B, L, BRANCH_WIDTH).astype(h.dtype)

    branches = jnp.stack([o_a, o_b, o_c.astype(h.dtype), o_m], axis=2)
    gate = jax.nn.sigmoid(gpre.reshape(B, L, N_BRANCH, D_MODEL) + p['gate_b'])
    merged = jnp.einsum('btnd,btnd->btd', gate, jnp.einsum('btnw,nwd->btnd', branches, p['w_branch']))
    x = layer_norm(DEEPNORM_ALPHA * h + merged @ p['w_out'], p['ln1_g'], p['ln1_b'])

    gg, uu = jnp.split(x @ p['w_gu'], 2, axis=-1)
    x = layer_norm(DEEPNORM_ALPHA * x + (jax.nn.silu(gg) * uu) @ p['w_down'], p['ln2_g'], p['ln2_b'])
    return x, new_kbuf, new_vbuf, gla_s, rwkv_s, rwkv_last


def setup_inputs(seed: int = 0) -> dict:
    key = jax.random.key(seed)
    ks = iter(jax.random.split(key, 64))
    f32 = jnp.float32

    def nrm(shape, scale=1.0):
        return jax.random.normal(next(ks), shape, f32) * scale

    def near(shape, center, noise=0.05):
        return center + nrm(shape, noise)

    beta = DEEPNORM_BETA
    win_rows = min(WINDOW, PAST_LEN)
    n_in = sum(IN_SIZES)
    return {
        'x_prompt': nrm((BATCH, SEQ, D_MODEL)),
        'x_sample': nrm((DEC_BATCH, DEC_SEQ, D_MODEL)),
        'mem_prompt': nrm((BATCH, MEM_TOKENS, D_MODEL)),
        'cache_swa_k': nrm((DEPTH, DEC_BATCH, win_rows, SWA_KV_HEADS, SWA_HEAD_DIM)),
        'cache_swa_v': nrm((DEPTH, DEC_BATCH, win_rows, SWA_KV_HEADS, SWA_HEAD_DIM)),
        'cache_mem_k': nrm((DEPTH, DEC_BATCH, MEM_TOKENS, MEM_HEADS, MEM_HEAD_DIM)),
        'cache_mem_v': nrm((DEPTH, DEC_BATCH, MEM_TOKENS, MEM_HEADS, MEM_HEAD_DIM)),
        'state_gla': nrm((DEPTH, DEC_BATCH, GLA_HEADS, GLA_DK, GLA_DV)),
        'state_rwkv': nrm((DEPTH, DEC_BATCH, RWKV_HEADS, RWKV_HEAD, RWKV_HEAD), 0.3),
        'state_rwkv_shift': nrm((DEPTH, DEC_BATCH, 1, RWKV_COLS)),
        'w_in': nrm((DEPTH, D_MODEL, n_in), D_MODEL ** -0.5),
        'gate_b': nrm((DEPTH, N_BRANCH, D_MODEL), 0.1),
        'gla_a_up': nrm((DEPTH, GLA_GATE_RANK, GLA_QK), GLA_GATE_RANK ** -0.5),
        'gla_a_b': nrm((DEPTH, GLA_QK), 0.1),
        'gla_norm_g': near((DEPTH, GLA_V), 1.0),
        'gla_norm_b': nrm((DEPTH, GLA_V), 0.02),
        'swa_sinks': nrm((DEPTH, SWA_Q_HEADS), 0.5),
        'rwkv_mu': jax.random.uniform(next(ks), (DEPTH, RWKV_COLS), f32),
        'rwkv_w0': nrm((DEPTH, BRANCH_WIDTH), 0.5),
        'rwkv_w2': nrm((DEPTH, RWKV_DECAY_RANK, BRANCH_WIDTH), RWKV_DECAY_RANK ** -0.5),
        'rwkv_a0': nrm((DEPTH, BRANCH_WIDTH), 0.1),
        'rwkv_a2': nrm((DEPTH, RWKV_A_RANK, BRANCH_WIDTH), RWKV_A_RANK ** -0.5),
        'rwkv_g2': nrm((DEPTH, RWKV_GATE_RANK, BRANCH_WIDTH), RWKV_GATE_RANK ** -0.5),
        'rwkv_k_k': near((DEPTH, BRANCH_WIDTH), 0.85),
        'rwkv_k_a': near((DEPTH, BRANCH_WIDTH), 1.0),
        'rwkv_r_k': nrm((DEPTH, RWKV_HEADS, RWKV_HEAD), 0.1),
        'rwkv_ln_g': near((DEPTH, BRANCH_WIDTH), 1.0),
        'rwkv_ln_b': nrm((DEPTH, BRANCH_WIDTH), 0.02),
        'w_mem_kv': nrm((DEPTH, D_MODEL, 2 * MEM_HEADS * MEM_HEAD_DIM), D_MODEL ** -0.5),
        'w_branch': nrm((DEPTH, N_BRANCH, BRANCH_WIDTH, D_MODEL), BRANCH_WIDTH ** -0.5 * beta),
        'w_out': nrm((DEPTH, D_MODEL, D_MODEL), D_MODEL ** -0.5 * beta),
        'ln1_g': near((DEPTH, D_MODEL), 1.0),
        'ln1_b': nrm((DEPTH, D_MODEL), 0.02),
        'w_gu': nrm((DEPTH, D_MODEL, 2 * D_FF), D_MODEL ** -0.5),
        'w_down': nrm((DEPTH, D_FF, D_MODEL), D_FF ** -0.5 * beta),
        'ln2_g': near((DEPTH, D_MODEL), 1.0),
        'ln2_b': nrm((DEPTH, D_MODEL), 0.02),
    }


def reference(x_prompt, x_sample, mem_prompt, cache_swa_k, cache_swa_v, cache_mem_k, cache_mem_v,
              state_gla, state_rwkv, state_rwkv_shift, w_in, gate_b, gla_a_up, gla_a_b, gla_norm_g,
              gla_norm_b, swa_sinks, rwkv_mu, rwkv_w0, rwkv_w2, rwkv_a0, rwkv_a2, rwkv_g2, rwkv_k_k,
              rwkv_k_a, rwkv_r_k, rwkv_ln_g, rwkv_ln_b, w_mem_kv, w_branch, w_out, ln1_g, ln1_b,
              w_gu, w_down, ln2_g, ln2_b):
    stacked = {'w_in': w_in, 'gate_b': gate_b, 'gla_a_up': gla_a_up, 'gla_a_b': gla_a_b,
               'gla_norm_g': gla_norm_g, 'gla_norm_b': gla_norm_b, 'swa_sinks': swa_sinks,
               'rwkv_mu': rwkv_mu, 'rwkv_w0': rwkv_w0, 'rwkv_w2': rwkv_w2, 'rwkv_a0': rwkv_a0,
               'rwkv_a2': rwkv_a2, 'rwkv_g2': rwkv_g2, 'rwkv_k_k': rwkv_k_k, 'rwkv_k_a': rwkv_k_a,
               'rwkv_r_k': rwkv_r_k, 'rwkv_ln_g': rwkv_ln_g, 'rwkv_ln_b': rwkv_ln_b,
               'w_mem_kv': w_mem_kv, 'w_branch': w_branch, 'w_out': w_out, 'ln1_g': ln1_g,
               'ln1_b': ln1_b, 'w_gu': w_gu, 'w_down': w_down, 'ln2_g': ln2_g, 'ln2_b': ln2_b}
    bp = x_prompt.shape[0]
    yp, ys = x_prompt, x_sample
    p_swk, p_swv, p_mk, p_mv, p_gla, p_rw, p_rs = [], [], [], [], [], [], []
    s_swk, s_swv, s_gla, s_rw, s_rs = [], [], [], [], []
    for l in range(DEPTH):
        p = {name: arr[l] for name, arr in stacked.items()}
        mk, mv = jnp.split(mem_prompt @ p['w_mem_kv'], 2, axis=-1)
        mk, mv = _heads(mk, MEM_HEADS), _heads(mv, MEM_HEADS)
        gla0 = jnp.zeros((bp, GLA_HEADS, GLA_DK, GLA_DV), jnp.float32)
        rwkv0 = jnp.zeros((bp, RWKV_HEADS, RWKV_HEAD, RWKV_HEAD), jnp.float32)
        prev0 = jnp.zeros((bp, 1, RWKV_COLS), x_prompt.dtype)
        yp, kb, vb, gs, rs, rl = trunk_layer(yp, p, mk, mv, gla0, rwkv0, prev0, None, None)
        p_swk.append(kb); p_swv.append(vb); p_mk.append(mk); p_mv.append(mv)
        p_gla.append(gs); p_rw.append(rs); p_rs.append(rl)
        ys, kb, vb, gs, rs, rl = trunk_layer(ys, p, cache_mem_k[l], cache_mem_v[l], state_gla[l],
                                            state_rwkv[l], state_rwkv_shift[l],
                                            cache_swa_k[l], cache_swa_v[l])
        s_swk.append(kb); s_swv.append(vb); s_gla.append(gs); s_rw.append(rs); s_rs.append(rl)
    return (yp, ys,
            jnp.stack(p_swk), jnp.stack(p_swv), jnp.stack(p_mk), jnp.stack(p_mv),
            jnp.stack(p_gla), jnp.stack(p_rw), jnp.stack(p_rs),
            jnp.stack(s_swk), jnp.stack(s_swv), jnp.stack(s_gla), jnp.stack(s_rw), jnp.stack(s_rs))
```

```cpp
#include <hip/hip_runtime.h>
#include <cstdio>
#include <cstdint>
#include <cstring>

#define LAS __attribute__((address_space(3)))
typedef unsigned short bf16_t;
typedef short bf16x8 __attribute__((ext_vector_type(8)));
typedef float f32x4 __attribute__((ext_vector_type(4)));
typedef float f32x2 __attribute__((ext_vector_type(2)));
typedef unsigned u32x4 __attribute__((ext_vector_type(4)));
typedef unsigned u32x2 __attribute__((ext_vector_type(2)));

constexpr int DM = 2048, NL = 4;
constexpr int PB = 2, PS = 4096, MP = PB * PS;
constexpr int SB = 32, SS = 4, MS = SB * SS;
constexpr int MT = MP + MS;
constexpr int MPAD = 8448;
constexpr int NIN = 16912, NINP = 17152;
constexpr int U_GQ = 0, U_GK = 512, U_GV = 1024, U_GR = 2048, U_GA = 3072, U_SQ = 3328, U_SK = 4352, U_SV = 4480, U_RU = 4608, U_MQ = 7936, U_GP = 8960;
constexpr int RWC = 3328, BW = 1024, DFF = 5632, MEMT = 256;
constexpr float ALPHA = 1.681792830507429f;

constexpr size_t O_YP = 0;
constexpr size_t O_YS = O_YP + (size_t)MP * DM;
constexpr size_t O_SWKP = O_YS + (size_t)MS * DM;
constexpr size_t O_SWVP = O_SWKP + (size_t)NL * PB * 128 * 128;
constexpr size_t O_MKP = O_SWVP + (size_t)NL * PB * 128 * 128;
constexpr size_t O_MVP = O_MKP + (size_t)NL * PB * 256 * 1024;
constexpr size_t O_GLAP = O_MVP + (size_t)NL * PB * 256 * 1024;
constexpr size_t O_RWP = O_GLAP + (size_t)NL * PB * 4 * 128 * 256;
constexpr size_t O_RSP = O_RWP + (size_t)NL * PB * 16 * 64 * 64;
constexpr size_t O_SWKS = O_RSP + (size_t)NL * PB * RWC;
constexpr size_t O_SWVS = O_SWKS + (size_t)NL * SB * 128 * 128;
constexpr size_t O_GLAS = O_SWVS + (size_t)NL * SB * 128 * 128;
constexpr size_t O_RWS = O_GLAS + (size_t)NL * SB * 4 * 128 * 256;
constexpr size_t O_RSS = O_RWS + (size_t)NL * SB * 16 * 64 * 64;
constexpr size_t O_END = O_RSS + (size_t)NL * SB * RWC;
static_assert(O_END == 52881408, "output size");

constexpr size_t al256(size_t x) { return (x + 255) & ~(size_t)255; }
constexpr size_t WS_CTL = 0;
constexpr size_t WS_WIN = 65536;
constexpr size_t WS_WMEM = WS_WIN + (size_t)NL * NINP * DM * 2;
constexpr size_t WS_WBR = WS_WMEM + (size_t)NL * DM * DM * 2;
constexpr size_t WS_WOUT = WS_WBR + (size_t)NL * 4 * DM * BW * 2;
constexpr size_t WS_WGU = WS_WOUT + (size_t)NL * DM * DM * 2;
constexpr size_t WS_WDN = WS_WGU + (size_t)NL * 2 * DFF * DM * 2;
constexpr size_t WS_HF = WS_WDN + (size_t)NL * DM * DFF * 2;
constexpr size_t WS_HB = WS_HF + (size_t)MPAD * DM * 4;
constexpr size_t WS_U = WS_HB + (size_t)MPAD * DM * 2;
constexpr size_t WS_BR = WS_U + (size_t)MPAD * NINP * 2;
constexpr size_t WS_MG = WS_BR + (size_t)4 * MPAD * BW * 2;
constexpr size_t WS_MGB = WS_MG + (size_t)MPAD * DM * 4;
constexpr size_t WS_Y = WS_MGB + (size_t)MPAD * DM * 2;
constexpr size_t WS_X1F = WS_Y + (size_t)MPAD * DM * 4;
constexpr size_t WS_X1B = WS_X1F + (size_t)MPAD * DM * 4;
constexpr size_t WS_ACT = WS_X1B + (size_t)MPAD * DM * 2;
constexpr size_t WS_MEMB = WS_ACT + (size_t)MPAD * DFF * 2;
constexpr size_t WS_MKB = WS_MEMB + (size_t)512 * DM * 2;
constexpr size_t WS_MVT = WS_MKB + (size_t)NL * 512 * 1024 * 2;
constexpr size_t WS_SC = WS_MVT + (size_t)NL * 8 * 256 * 256 * 2;
constexpr size_t WS_PB = WS_SC + (size_t)8 * 4096 * 256 * 4;
constexpr size_t WS_RW = WS_PB + (size_t)8 * 4096 * 256 * 2;
constexpr size_t RW_ARR = (size_t)MPAD * BW * 4;
constexpr size_t WS_END = WS_RW + 8 * RW_ARR;

__device__ __forceinline__ float bf2f(bf16_t b) { return __uint_as_float(((unsigned)b) << 16); }
__device__ __forceinline__ bf16_t f2bf(float f) { unsigned u = __float_as_uint(f); u += 0x7FFFu + ((u >> 16) & 1u); return (bf16_t)(u >> 16); }
__device__ __forceinline__ unsigned pk2(float lo, float hi) { return (unsigned)f2bf(lo) | ((unsigned)f2bf(hi) << 16); }
__device__ __forceinline__ float wave_sum(float v) {
#pragma unroll
    for (int o = 32; o > 0; o >>= 1) v += __shfl_xor(v, o, 64);
    return v;
}
__device__ __forceinline__ float wave_max(float v) {
#pragma unroll
    for (int o = 32; o > 0; o >>= 1) v = fmaxf(v, __shfl_xor(v, o, 64));
    return v;
}
__device__ __forceinline__ float sigmoidf_(float x) { return 1.0f / (1.0f + __expf(-x)); }
__device__ __forceinline__ float softplusf_(float x) { return fmaxf(x, 0.f) + log1pf(__expf(-fabsf(x))); }

namespace pg8 {
constexpr int BM = 256, BK = 64, HALF = 128, HTB = HALF * BK * 2, STAGE_BYTES = 8 * HTB, NXCD = 8, WGM = 8;
__host__ __device__ __forceinline__ int lds_byte(int r, int c) { const int st = (r >> 4) * 2 + (c >> 5), rr = r & 15, cc = c & 31, ob = rr * 64 + cc * 2; return st * 1024 + (ob ^ (((ob >> 9) & 1) << 5)); }
__host__ __device__ __forceinline__ void stage_rc(int b, int& R, int& C) { const int st = b / 1024, sb = b % 1024, swz = sb ^ (((sb >> 9) & 1) << 5); R = (st >> 1) * 16 + swz / 64; C = (st & 1) * 32 + (swz % 64) / 2; }
__host__ __device__ __forceinline__ int perm32(int rho) { const int n = rho >> 4, i = rho & 15; return 8 * (i >> 2) + 4 * n + (i & 3); }

struct Unit { int pm, pn, z; };
struct Gemm {
    const bf16_t* A; const bf16_t* B;
    long zsAb, zsAh, zsBb, zsBh;
    int lda, ldb, K, nM, nN, nZ, nZh, zinner;
    int G, c;
    __device__ __forceinline__ bool next(int i, Unit& u) const {
        const int nt = nM * nN; int L, z;
        if (zinner) { const int it = i / nZ; z = i - it * nZ; const long LL = (long)it * G + c; if (LL >= nt) return false; L = (int)LL; }
        else { const long LL = (long)i * G + c; if (LL >= (long)nt * nZ) return false; z = (int)(LL / nt); L = (int)(LL - (long)z * nt); }
        int wgid = L; { const int q = nt / NXCD, r = nt % NXCD, xcd = wgid % NXCD, off = wgid / NXCD; wgid = (xcd < r ? xcd * (q + 1) : r * (q + 1) + (xcd - r) * q) + off; }
        const int nig = WGM * nN, gid = wgid / nig, fm = gid * WGM, gsz = (nM - fm) < WGM ? (nM - fm) : WGM;
        u.pm = fm + ((wgid % nig) % gsz); u.pn = (wgid % nig) / gsz; u.z = z; return true;
    }
    __device__ __forceinline__ const char* a_base(const Unit& u) const { const int zb = u.z / nZh, zh = u.z - zb * nZh; return (const char*)(A + zb * zsAb + zh * zsAh + (long)u.pm * BM * lda); }
    __device__ __forceinline__ const char* b_base(const Unit& u) const { const int zb = u.z / nZh, zh = u.z - zb * nZh; return (const char*)(B + zb * zsBb + zh * zsBh + (long)u.pn * BM * ldb); }
};

template <class Epi, bool ALIGN_EPI = true, bool SP2 = true>
__device__ __forceinline__ void gemm_phase(LAS unsigned char* lds, const Gemm& g, const Epi& E) {
    const int tid = threadIdx.x, wid = __builtin_amdgcn_readfirstlane(tid >> 6), lane = tid & 63, wr = wid >> 2, wc = wid & 3, fr = lane & 15, fq = lane >> 4;
    const int K = g.K, nt = K / BK;
    unsigned voffA[2], voffB[2];
#pragma unroll
    for (int i = 0; i < 2; ++i) { int R, C; stage_rc(tid * 16 + i * 8192, R, C); const int Rb = Epi::PERM ? ((R & ~31) + perm32(R & 31)) : R;
        voffA[i] = (unsigned)(R * g.lda + C) * 2u; voffB[i] = (unsigned)(Rb * g.ldb + C) * 2u; }
    const size_t kstep = (size_t)(BK * 2);
    const size_t hstepA = (size_t)HALF * g.lda * 2, hstepB = (size_t)HALF * g.ldb * 2;
    const unsigned ldsw = (unsigned)wid * 1024u;
    const int aoff = lds_byte(wr * 64 + fr, fq * 8), boff = lds_byte(wc * 32 + fr, fq * 8);
#define PG8_SA(b, h) (((b) * 2 + (h)) * HTB)
#define PG8_SB(b, h) ((4 + (b) * 2 + (h)) * HTB)
#define PG8_STAGE(bufoff, gbase, voff) do { _Pragma("unroll") for (int _i = 0; _i < 2; ++_i) \
        __builtin_amdgcn_global_load_lds((const unsigned*)((const char*)(gbase) + (voff)[_i]), (LAS unsigned*)(lds + (bufoff) + ldsw + _i * 8192), 16, 0, 0); } while (0)
#define PG8_LDA(dst, b, h) do { _Pragma("unroll") for (int m = 0; m < 4; ++m) _Pragma("unroll") for (int k = 0; k < 2; ++k) dst[m][k] = *(const LAS bf16x8*)(lds + PG8_SA(b, h) + aoff + m * 2048 + k * 1024); } while (0)
#define PG8_LDB(dst, b, h) do { _Pragma("unroll") for (int n = 0; n < 2; ++n) _Pragma("unroll") for (int k = 0; k < 2; ++k) dst[n][k] = *(const LAS bf16x8*)(lds + PG8_SB(b, h) + boff + n * 2048 + k * 1024); } while (0)
#define PG8_MMA(ai, bj, At, Bt) do { __builtin_amdgcn_s_setprio(1); _Pragma("unroll") for (int m = 0; m < 4; ++m) _Pragma("unroll") for (int n = 0; n < 2; ++n) _Pragma("unroll") for (int k = 0; k < 2; ++k) \
        acc[ai][bj][m][n] = __builtin_amdgcn_mfma_f32_16x16x32_bf16(Bt[n][k], At[m][k], acc[ai][bj][m][n], 0, 0, 0); __builtin_amdgcn_s_setprio(0); } while (0)
#define PG8_WAIT_V(n) asm volatile("s_waitcnt vmcnt(" #n ")" ::: "memory")
#define PG8_WAIT_L(n) asm volatile("s_waitcnt lgkmcnt(" #n ")" ::: "memory")
#define PG8_BAR __builtin_amdgcn_s_barrier()
#define PG8_SCHED __builtin_amdgcn_sched_barrier(0)
    Unit cur, nxt; int ui = 0;
    if (!g.next(0, cur)) return;
    f32x4 acc[2][2][4][2];
#pragma unroll
    for (int a = 0; a < 2; ++a)
#pragma unroll
        for (int b = 0; b < 2; ++b)
#pragma unroll
            for (int m = 0; m < 4; ++m)
#pragma unroll
                for (int n = 0; n < 2; ++n) acc[a][b][m][n] = (f32x4){0.f, 0.f, 0.f, 0.f};
    bf16x8 At[4][2], B0[2][2], B1[2][2];
    const char* cA = g.a_base(cur); const char* cB = g.b_base(cur);
    if constexpr (SP2) {
        PG8_STAGE(PG8_SB(0, 0), cB, voffB); PG8_STAGE(PG8_SB(0, 1), cB + hstepB, voffB); PG8_STAGE(PG8_SA(0, 0), cA, voffA); PG8_STAGE(PG8_SA(0, 1), cA + hstepA, voffA);
        if (wr == 1) PG8_BAR;
        PG8_WAIT_V(2); PG8_BAR;
        PG8_STAGE(PG8_SB(1, 0), cB + kstep, voffB); PG8_STAGE(PG8_SA(1, 0), cA + kstep, voffA); PG8_STAGE(PG8_SB(1, 1), cB + hstepB + kstep, voffB);
        PG8_WAIT_V(6); PG8_BAR;
    } else {
        PG8_STAGE(PG8_SB(0, 0), cB, voffB); PG8_STAGE(PG8_SA(0, 0), cA, voffA); PG8_STAGE(PG8_SB(0, 1), cB + hstepB, voffB); PG8_STAGE(PG8_SA(0, 1), cA + hstepA, voffA);
        if (wr == 1) PG8_BAR;
        PG8_WAIT_V(4); PG8_BAR;
        PG8_STAGE(PG8_SB(1, 0), cB + kstep, voffB); PG8_STAGE(PG8_SA(1, 0), cA + kstep, voffA); PG8_STAGE(PG8_SB(1, 1), cB + hstepB + kstep, voffB);
        PG8_WAIT_V(6); PG8_BAR;
    }
    for (;;) {
        const bool has_next = g.next(ui + 1, nxt);
        const char* nA = has_next ? g.a_base(nxt) : cA; const char* nB = has_next ? g.b_base(nxt) : cB;
        for (int t = 0; t < nt; t += 2) {
            const bool last = (t == nt - 2);
            const char* a1 = cA + (size_t)(t + 1) * kstep;
            const char* a2 = last ? nA : cA + (size_t)(t + 2) * kstep; const char* b2 = last ? nB : cB + (size_t)(t + 2) * kstep;
            const char* a3 = a2 + kstep; const char* b3 = b2 + kstep;
            if constexpr (SP2) {
            PG8_LDB(B0, 0, 0); PG8_LDB(B1, 0, 1); PG8_SCHED; PG8_LDA(At, 0, 0); PG8_STAGE(PG8_SA(1, 1), a1 + hstepA, voffA);
            PG8_WAIT_V(8); PG8_WAIT_L(0); PG8_BAR; PG8_MMA(0, 0, At, B0); PG8_MMA(0, 1, At, B1); PG8_BAR; PG8_SCHED;
            PG8_LDA(At, 0, 1); PG8_STAGE(PG8_SB(0, 0), b2, voffB); PG8_STAGE(PG8_SB(0, 1), b2 + hstepB, voffB); PG8_STAGE(PG8_SA(0, 0), a2, voffA);
            PG8_WAIT_V(8); PG8_WAIT_L(0); PG8_BAR; PG8_MMA(1, 0, At, B0); PG8_MMA(1, 1, At, B1); PG8_BAR; PG8_SCHED;
            PG8_LDB(B0, 1, 0); PG8_LDB(B1, 1, 1); PG8_SCHED; PG8_LDA(At, 1, 0); PG8_STAGE(PG8_SA(0, 1), a2 + hstepA, voffA);
            PG8_WAIT_V(8); PG8_WAIT_L(0); PG8_BAR; PG8_MMA(0, 0, At, B0); PG8_MMA(0, 1, At, B1); PG8_BAR; PG8_SCHED;
            PG8_LDA(At, 1, 1); PG8_STAGE(PG8_SB(1, 0), b3, voffB); PG8_STAGE(PG8_SB(1, 1), b3 + hstepB, voffB); PG8_STAGE(PG8_SA(1, 0), a3, voffA);
            PG8_WAIT_V(8); PG8_WAIT_L(0); PG8_BAR; PG8_MMA(1, 0, At, B0); PG8_MMA(1, 1, At, B1); PG8_BAR; PG8_SCHED;
            } else {
            PG8_LDB(B0, 0, 0); PG8_SCHED; PG8_LDA(At, 0, 0); PG8_STAGE(PG8_SA(1, 1), a1 + hstepA, voffA);
            PG8_WAIT_L(8); PG8_BAR; PG8_WAIT_L(0); PG8_MMA(0, 0, At, B0); PG8_BAR; PG8_SCHED;
            PG8_LDB(B1, 0, 1); PG8_STAGE(PG8_SB(0, 0), b2, voffB);
            PG8_BAR; PG8_WAIT_L(0); PG8_MMA(0, 1, At, B1); PG8_BAR;
            PG8_LDA(At, 0, 1); PG8_STAGE(PG8_SA(0, 0), a2, voffA);
            PG8_BAR; PG8_WAIT_L(0); PG8_MMA(1, 0, At, B0); PG8_BAR; PG8_SCHED;
            PG8_STAGE(PG8_SB(0, 1), b2 + hstepB, voffB);
            PG8_WAIT_V(6); PG8_BAR; PG8_MMA(1, 1, At, B1); PG8_BAR;
            PG8_LDB(B0, 1, 0); PG8_SCHED; PG8_LDA(At, 1, 0); PG8_STAGE(PG8_SA(0, 1), a2 + hstepA, voffA);
            PG8_WAIT_L(8); PG8_BAR; PG8_WAIT_L(0); PG8_MMA(0, 0, At, B0); PG8_BAR; PG8_SCHED;
            PG8_LDB(B1, 1, 1); PG8_STAGE(PG8_SB(1, 0), b3, voffB);
            PG8_BAR; PG8_WAIT_L(0); PG8_MMA(0, 1, At, B1); PG8_BAR;
            PG8_LDA(At, 1, 1); PG8_STAGE(PG8_SA(1, 0), a3, voffA);
            PG8_BAR; PG8_WAIT_L(0); PG8_MMA(1, 0, At, B0); PG8_BAR; PG8_SCHED;
            PG8_STAGE(PG8_SB(1, 1), b3 + hstepB, voffB);
            PG8_WAIT_V(6); PG8_BAR; PG8_MMA(1, 1, At, B1); PG8_BAR;
            }
        }
        if constexpr (ALIGN_EPI) { if (wr == 0) PG8_BAR; }
        E(acc, cur, wr, wc, fr, fq);
        if (!has_next) break;
#pragma unroll
        for (int a = 0; a < 2; ++a)
#pragma unroll
            for (int b = 0; b < 2; ++b)
#pragma unroll
                for (int m = 0; m < 4; ++m)
#pragma unroll
                    for (int n = 0; n < 2; ++n) acc[a][b][m][n] = (f32x4){0.f, 0.f, 0.f, 0.f};
        cur = nxt; cA = nA; cB = nB; ++ui;
        if constexpr (ALIGN_EPI) { if (wr == 1) PG8_BAR; }
    }
    PG8_WAIT_V(0);
    if constexpr (!ALIGN_EPI) { if (wr == 0) PG8_BAR; }
    PG8_BAR;
#undef PG8_SA
#undef PG8_SB
#undef PG8_STAGE
#undef PG8_LDA
#undef PG8_LDB
#undef PG8_MMA
#undef PG8_WAIT_V
#undef PG8_WAIT_L
#undef PG8_BAR
#undef PG8_SCHED
}

struct EpiBf16 {
    static constexpr bool PERM = true;
    bf16_t* O; long zs; int ldc, pad;
    __device__ __forceinline__ void operator()(const f32x4 (&acc)[2][2][4][2], const Unit& u, int wr, int wc, int fr, int fq) const {
        const int row0 = u.pm * BM + wr * 64 + fr, col0 = u.pn * BM + wc * 32 + 8 * fq; bf16_t* base = O + (long)u.z * zs;
#pragma unroll
        for (int ai = 0; ai < 2; ++ai)
#pragma unroll
            for (int m = 0; m < 4; ++m) { bf16_t* rowp = base + (size_t)(row0 + ai * HALF + m * 16) * ldc + col0;
#pragma unroll
                for (int bj = 0; bj < 2; ++bj) { const f32x4 v0 = acc[ai][bj][m][0], v1 = acc[ai][bj][m][1];
                    u32x4 w; w.x = pk2(v0[0], v0[1]); w.y = pk2(v0[2], v0[3]); w.z = pk2(v1[0], v1[1]); w.w = pk2(v1[2], v1[3]);
                    *(u32x4*)(rowp + bj * HALF) = w; } }
    }
};
struct EpiMem {
    static constexpr bool PERM = false;
    float* outK; float* outV; bf16_t* kb; bf16_t* vt;
    __device__ __forceinline__ void operator()(const f32x4 (&acc)[2][2][4][2], const Unit& u, int wr, int wc, int fr, int fq) const {
        const int row0 = u.pm * BM + wr * 64 + fr, col0 = u.pn * BM + wc * 32 + 4 * fq;
#pragma unroll
        for (int ai = 0; ai < 2; ++ai)
#pragma unroll
            for (int m = 0; m < 4; ++m) { const int row = row0 + ai * HALF + m * 16;
#pragma unroll
                for (int bj = 0; bj < 2; ++bj)
#pragma unroll
                    for (int n = 0; n < 2; ++n) { const int col = col0 + bj * HALF + n * 16; const f32x4 v = acc[ai][bj][m][n];
                        if (col < 1024) { *(f32x4*)(outK + ((size_t)u.z * 512 + row) * 1024 + col) = v;
                            u32x2 w; w.x = pk2(v[0], v[1]); w.y = pk2(v[2], v[3]); *(u32x2*)(kb + ((size_t)u.z * 512 + row) * 1024 + col) = w; }
                        else { const int c = col - 1024; *(f32x4*)(outV + ((size_t)u.z * 512 + row) * 1024 + c) = v;
                            const int b = row >> 8, mm = row & 255, h = c >> 8, d = c & 255; bf16_t* p = vt + ((((size_t)u.z * 2 + b) * 4 + h) * 256 + d) * 256 + mm;
                            p[0] = f2bf(v[0]); p[256] = f2bf(v[1]); p[512] = f2bf(v[2]); p[768] = f2bf(v[3]); } } }
    }
};
struct EpiMerge {
    static constexpr bool PERM = false;
    float* MG; bf16_t* MGB; const bf16_t* U; const float* gate_b;
    __device__ __forceinline__ void operator()(const f32x4 (&acc)[2][2][4][2], const Unit& u, int wr, int wc, int fr, int fq) const {
        const int row0 = u.pm * BM + wr * 64 + fr, col0 = u.pn * BM + wc * 32 + 4 * fq;
#pragma unroll
        for (int ai = 0; ai < 2; ++ai)
#pragma unroll
            for (int m = 0; m < 4; ++m) { const int row = row0 + ai * HALF + m * 16;
#pragma unroll
                for (int bj = 0; bj < 2; ++bj)
#pragma unroll
                    for (int n = 0; n < 2; ++n) { const int col = col0 + bj * HALF + n * 16; const f32x4 v = acc[ai][bj][m][n];
                        const u32x2 gp = *(const u32x2*)(U + (size_t)row * NINP + U_GP + u.z * DM + col); const f32x4 gb = *(const f32x4*)(gate_b + u.z * DM + col);
                        f32x4 gt; gt[0] = sigmoidf_(__uint_as_float(gp.x << 16) + gb[0]); gt[1] = sigmoidf_(__uint_as_float(gp.x & 0xffff0000u) + gb[1]);
                        gt[2] = sigmoidf_(__uint_as_float(gp.y << 16) + gb[2]); gt[3] = sigmoidf_(__uint_as_float(gp.y & 0xffff0000u) + gb[3]);
                        float* mp = MG + (size_t)row * DM + col; f32x4 r = gt * v;
                        if (u.z > 0) r += *(const f32x4*)mp;
                        if (u.z < 3) *(f32x4*)mp = r;
                        else { u32x2 w; w.x = pk2(r[0], r[1]); w.y = pk2(r[2], r[3]); *(u32x2*)(MGB + (size_t)row * DM + col) = w; } } }
    }
};
struct EpiRes {
    static constexpr bool PERM = false;
    const float* R; float* Y;
    __device__ __forceinline__ void operator()(const f32x4 (&acc)[2][2][4][2], const Unit& u, int wr, int wc, int fr, int fq) const {
        const int row0 = u.pm * BM + wr * 64 + fr, col0 = u.pn * BM + wc * 32 + 4 * fq;
#pragma unroll
        for (int ai = 0; ai < 2; ++ai)
#pragma unroll
            for (int m = 0; m < 4; ++m) { const size_t ro = (size_t)(row0 + ai * HALF + m * 16) * DM + col0;
#pragma unroll
                for (int bj = 0; bj < 2; ++bj)
#pragma unroll
                    for (int n = 0; n < 2; ++n) { const size_t o = ro + bj * HALF + n * 16; *(f32x4*)(Y + o) = *(const f32x4*)(R + o) * ALPHA + acc[ai][bj][m][n]; } }
    }
};
struct EpiSwiGLU {
    static constexpr bool PERM = true;
    bf16_t* O;
    __device__ __forceinline__ void operator()(const f32x4 (&acc)[2][2][4][2], const Unit& u, int wr, int wc, int fr, int fq) const {
        const int row0 = u.pm * BM + wr * 64 + fr, col0 = u.pn * HALF + wc * 32 + 8 * fq;
#pragma unroll
        for (int ai = 0; ai < 2; ++ai)
#pragma unroll
            for (int m = 0; m < 4; ++m) { bf16_t* rowp = O + (size_t)(row0 + ai * HALF + m * 16) * DFF + col0;
                float r[8];
#pragma unroll
                for (int n = 0; n < 2; ++n)
#pragma unroll
                    for (int j = 0; j < 4; ++j) { const float gg = acc[ai][0][m][n][j], uu = acc[ai][1][m][n][j]; r[n * 4 + j] = gg * sigmoidf_(gg) * uu; }
                u32x4 w; w.x = pk2(r[0], r[1]); w.y = pk2(r[2], r[3]); w.z = pk2(r[4], r[5]); w.w = pk2(r[6], r[7]);
                *(u32x4*)rowp = w; }
    }
};
struct EpiScore {
    static constexpr bool PERM = false;
    float* SC;
    __device__ __forceinline__ void operator()(const f32x4 (&acc)[2][2][4][2], const Unit& u, int wr, int wc, int fr, int fq) const {
        const int row0 = u.pm * BM + wr * 64 + fr, col0 = wc * 32 + 4 * fq; float* base = SC + (size_t)u.z * 4096 * 256;
#pragma unroll
        for (int ai = 0; ai < 2; ++ai)
#pragma unroll
            for (int m = 0; m < 4; ++m) { float* rowp = base + (size_t)(row0 + ai * HALF + m * 16) * 256 + col0;
#pragma unroll
                for (int bj = 0; bj < 2; ++bj)
#pragma unroll
                    for (int n = 0; n < 2; ++n) *(f32x4*)(rowp + bj * HALF + n * 16) = acc[ai][bj][m][n] * 0.0625f; }
    }
};
struct EpiPV {
    static constexpr bool PERM = true;
    bf16_t* O;
    __device__ __forceinline__ void operator()(const f32x4 (&acc)[2][2][4][2], const Unit& u, int wr, int wc, int fr, int fq) const {
        const int b = u.z >> 2, h = u.z & 3; const int row0 = b * PS + u.pm * BM + wr * 64 + fr, col0 = h * 256 + wc * 32 + 8 * fq;
#pragma unroll
        for (int ai = 0; ai < 2; ++ai)
#pragma unroll
            for (int m = 0; m < 4; ++m) { bf16_t* rowp = O + (size_t)(row0 + ai * HALF + m * 16) * BW + col0;
#pragma unroll
                for (int bj = 0; bj < 2; ++bj) { const f32x4 v0 = acc[ai][bj][m][0], v1 = acc[ai][bj][m][1];
                    u32x4 w; w.x = pk2(v0[0], v0[1]); w.y = pk2(v0[2], v0[3]); w.z = pk2(v1[0], v1[1]); w.w = pk2(v1[2], v1[3]);
                    *(u32x4*)(rowp + bj * HALF) = w; } }
    }
};
}

template <class Epi> __global__ void __launch_bounds__(512, 2) k_gemm(pg8::Gemm g, Epi E) {
    extern __shared__ __attribute__((aligned(16))) unsigned char lds[];
    g.G = (int)gridDim.x; g.c = (int)blockIdx.x;
    pg8::gemm_phase<Epi, true, true>((LAS unsigned char*)lds, g, E);
}

__device__ __forceinline__ int colmap(int mode, int n) {
    if (mode == 1) return n < 3088 ? n : (n < 3328 ? -1 : n - 240);
    if (mode == 2) { const int t = n >> 8, j = n & 255; return j < 128 ? t * 128 + j : DFF + t * 128 + (j - 128); }
    return n;
}
__global__ void __launch_bounds__(256) k_wprep(const float* __restrict__ src, bf16_t* __restrict__ dst, int K, int Nsrc, int mode, size_t sbs, size_t dbs) {
    __shared__ float tile[64][65];
    src += (size_t)blockIdx.z * sbs; dst += (size_t)blockIdx.z * dbs;
    const int tid = threadIdx.x, n0 = blockIdx.x * 64, k0 = blockIdx.y * 64, tx = tid & 63, ty = tid >> 6;
    const int c = colmap(mode, n0 + tx);
    for (int kk = ty; kk < 64; kk += 4) tile[kk][tx] = c >= 0 ? src[(size_t)(k0 + kk) * Nsrc + c] : 0.f;
    __syncthreads();
    const int r = tid >> 3, p = tid & 7;
    for (int rr = r; rr < 64; rr += 32) {
        u32x4 w; w.x = pk2(tile[p * 8 + 0][rr], tile[p * 8 + 1][rr]); w.y = pk2(tile[p * 8 + 2][rr], tile[p * 8 + 3][rr]);
        w.z = pk2(tile[p * 8 + 4][rr], tile[p * 8 + 5][rr]); w.w = pk2(tile[p * 8 + 6][rr], tile[p * 8 + 7][rr]);
        *(u32x4*)(dst + (size_t)(n0 + rr) * K + k0 + p * 8) = w;
    }
}
__global__ void __launch_bounds__(256) k_xprep(const float* __restrict__ xp, const float* __restrict__ xs, const float* __restrict__ mem, float* __restrict__ HF, bf16_t* __restrict__ HB, bf16_t* __restrict__ MEMB) {
    const size_t i4 = (size_t)blockIdx.x * 256 + threadIdx.x;
    const size_t nH = (size_t)MPAD * DM / 4, nM = (size_t)512 * DM / 4;
    if (i4 < nH) {
        const size_t e = i4 * 4; f32x4 v = (f32x4){0.f, 0.f, 0.f, 0.f};
        if (e < (size_t)MP * DM) v = *(const f32x4*)(xp + e); else if (e < (size_t)MT * DM) v = *(const f32x4*)(xs + (e - (size_t)MP * DM));
        *(f32x4*)(HF + e) = v; u32x2 w; w.x = pk2(v[0], v[1]); w.y = pk2(v[2], v[3]); *(u32x2*)(HB + e) = w;
    } else if (i4 < nH + nM) {
        const size_t e = (i4 - nH) * 4; const f32x4 v = *(const f32x4*)(mem + e); u32x2 w; w.x = pk2(v[0], v[1]); w.y = pk2(v[2], v[3]); *(u32x2*)(MEMB + e) = w;
    }
}

__global__ void __launch_bounds__(256) k_ln(const float* __restrict__ Y, const float* __restrict__ g, const float* __restrict__ b, float* __restrict__ XF, bf16_t* __restrict__ XB, float* __restrict__ OUT, int nrows, int nout) {
    const int row = blockIdx.x * 4 + (threadIdx.x >> 6), lane = threadIdx.x & 63;
    if (row >= nrows) return;
    const float* y = Y + (size_t)row * DM; f32x4 v[8]; float s = 0.f;
#pragma unroll
    for (int j = 0; j < 8; ++j) { v[j] = *(const f32x4*)(y + j * 256 + lane * 4); s += (v[j][0] + v[j][1]) + (v[j][2] + v[j][3]); }
    const float mean = wave_sum(s) * (1.0f / DM); float q = 0.f;
#pragma unroll
    for (int j = 0; j < 8; ++j) { const f32x4 d = v[j] - mean; q += (d[0] * d[0] + d[1] * d[1]) + (d[2] * d[2] + d[3] * d[3]); }
    const float rstd = rsqrtf(wave_sum(q) * (1.0f / DM) + 1e-5f);
#pragma unroll
    for (int j = 0; j < 8; ++j) { const int c = j * 256 + lane * 4; const f32x4 gg = *(const f32x4*)(g + c), bb = *(const f32x4*)(b + c);
        const f32x4 o = (v[j] - mean) * rstd * gg + bb; const size_t off = (size_t)row * DM + c;
        *(f32x4*)(XF + off) = o; u32x2 w; w.x = pk2(o[0], o[1]); w.y = pk2(o[2], o[3]); *(u32x2*)(XB + off) = w;
        if (OUT != nullptr && row < nout) *(f32x4*)(OUT + off) = o; }
}
__global__ void __launch_bounds__(256) k_softmax256(const float* __restrict__ SC, bf16_t* __restrict__ P, int nrows) {
    const int row = blockIdx.x * 4 + (threadIdx.x >> 6), lane = threadIdx.x & 63;
    if (row >= nrows) return;
    const f32x4 v = *(const f32x4*)(SC + (size_t)row * 256 + lane * 4);
    const float mx = wave_max(fmaxf(fmaxf(v[0], v[1]), fmaxf(v[2], v[3])));
    f32x4 e; e[0] = __expf(v[0] - mx); e[1] = __expf(v[1] - mx); e[2] = __expf(v[2] - mx); e[3] = __expf(v[3] - mx);
    const float inv = 1.0f / wave_sum((e[0] + e[1]) + (e[2] + e[3]));
    u32x2 w; w.x = pk2(e[0] * inv, e[1] * inv); w.y = pk2(e[2] * inv, e[3] * inv); *(u32x2*)(P + (size_t)row * 256 + lane * 4) = w;
}
__global__ void __launch_bounds__(256) k_copy_outs(const bf16_t* __restrict__ U, const float* __restrict__ ck, const float* __restrict__ cv, float* __restrict__ out, int layer) {
    const int i = blockIdx.x * 256 + threadIdx.x;
    constexpr int nA = PB * 128 * 128, nB = SB * 128 * 128, nC = PB * RWC, nD = SB * RWC;
    if (i < nA) { const int b = i / 16384, j = (i >> 7) & 127, c = i & 127; const size_t ur = (size_t)(b * PS + PS - 128 + j) * NINP;
        out[O_SWKP + (size_t)layer * nA + i] = bf2f(U[ur + U_SK + c]); out[O_SWVP + (size_t)layer * nA + i] = bf2f(U[ur + U_SV + c]); return; }
    int k = i - nA;
    if (k < nB) { const int sq = k / 16384, j = (k >> 7) & 127, c = k & 127; float kv, vv;
        if (j < 124) { const size_t o = ((size_t)sq * 128 + j + 4) * 128 + c; kv = ck[o]; vv = cv[o]; }
        else { const size_t ur = (size_t)(MP + sq * SS + j - 124) * NINP; kv = bf2f(U[ur + U_SK + c]); vv = bf2f(U[ur + U_SV + c]); }
        out[O_SWKS + (size_t)layer * nB + k] = kv; out[O_SWVS + (size_t)layer * nB + k] = vv; return; }
    k -= nB;
    if (k < nC) { const int b = k / RWC, c = k - b * RWC; out[O_RSP + (size_t)layer * nC + k] = bf2f(U[(size_t)(b * PS + PS - 1) * NINP + U_RU + c]); return; }
    k -= nC;
    if (k < nD) { const int sq = k / RWC, c = k - sq * RWC; out[O_RSS + (size_t)layer * nD + k] = bf2f(U[(size_t)(MP + sq * SS + SS - 1) * NINP + U_RU + c]); }
}

__device__ __forceinline__ void seq_info(int sq, int& row0, int& L) { if (sq < PB) { row0 = sq * PS; L = PS; } else { row0 = MP + (sq - PB) * SS; L = SS; } }

__global__ void __launch_bounds__(256) k_gla_naive(const bf16_t* __restrict__ U, const float* __restrict__ s0, const float* __restrict__ a_up, const float* __restrict__ a_b,
                                                   const float* __restrict__ ng, const float* __restrict__ nb, bf16_t* __restrict__ OB, float* __restrict__ outP, float* __restrict__ outS) {
    __shared__ float qs[16][128], ks[16][128], as[16][128], os[16][256];
    const int sq = blockIdx.x >> 2, h = blockIdx.x & 3, tid = threadIdx.x, lane = tid & 63, wave = tid >> 6;
    int row0, L; seq_info(sq, row0, L);
    float S[128];
    if (sq >= PB) { const float* p = s0 + ((size_t)(sq - PB) * 4 + h) * 128 * 256 + tid;
#pragma unroll
        for (int kk = 0; kk < 128; ++kk) S[kk] = p[(size_t)kk * 256]; }
    else {
#pragma unroll
        for (int kk = 0; kk < 128; ++kk) S[kk] = 0.f; }
    for (int t0 = 0; t0 < L; t0 += 16) {
        const int nT = (L - t0) < 16 ? (L - t0) : 16;
        for (int idx = tid; idx < nT * 128; idx += 256) {
            const int tt = idx >> 7, kk = idx & 127; const bf16_t* ur = U + (size_t)(row0 + t0 + tt) * NINP;
            qs[tt][kk] = bf2f(ur[U_GQ + h * 128 + kk]) * 0.08838834764831845f; ks[tt][kk] = bf2f(ur[U_GK + h * 128 + kk]);
            float x = a_b[h * 128 + kk];
#pragma unroll
            for (int r = 0; r < 16; ++r) x += bf2f(ur[U_GA + r]) * a_up[r * 512 + h * 128 + kk];
            const float ls = (fminf(x, 0.f) - log1pf(__expf(-fabsf(x)))) * (1.0f / 16.0f);
            as[tt][kk] = __expf(ls);
        }
        __syncthreads();
        for (int tt = 0; tt < nT; ++tt) {
            const float v = bf2f(U[(size_t)(row0 + t0 + tt) * NINP + U_GV + h * 256 + tid]); float o = 0.f;
#pragma unroll
            for (int kk = 0; kk < 128; ++kk) { S[kk] = as[tt][kk] * S[kk] + ks[tt][kk] * v; o += qs[tt][kk] * S[kk]; }
            os[tt][tid] = o;
        }
        __syncthreads();
        for (int tt = wave; tt < nT; tt += 4) {
            float x[4]; float s = 0.f;
#pragma unroll
            for (int j = 0; j < 4; ++j) { x[j] = os[tt][lane + 64 * j]; s += x[j]; }
            const float mean = wave_sum(s) * (1.0f / 256.0f); float q = 0.f;
#pragma unroll
            for (int j = 0; j < 4; ++j) { const float d = x[j] - mean; q += d * d; }
            const float rstd = rsqrtf(wave_sum(q) * (1.0f / 256.0f) + 1e-5f);
            const size_t row = (size_t)(row0 + t0 + tt);
#pragma unroll
            for (int j = 0; j < 4; ++j) { const int c = h * 256 + lane + 64 * j; const float n = (x[j] - mean) * rstd * ng[c] + nb[c];
                const float gr = bf2f(U[row * NINP + U_GR + c]); OB[row * BW + c] = f2bf(n * gr * sigmoidf_(gr)); }
        }
        __syncthreads();
    }
    float* op = (sq < PB ? outP + ((size_t)sq * 4 + h) * 128 * 256 : outS + ((size_t)(sq - PB) * 4 + h) * 128 * 256) + tid;
#pragma unroll
    for (int kk = 0; kk < 128; ++kk) op[(size_t)kk * 256] = S[kk];
}

__device__ __forceinline__ void unpack8(const u32x4 w, float (&x)[8]) {
    x[0] = __uint_as_float(w.x << 16); x[1] = __uint_as_float(w.x & 0xffff0000u); x[2] = __uint_as_float(w.y << 16); x[3] = __uint_as_float(w.y & 0xffff0000u);
    x[4] = __uint_as_float(w.z << 16); x[5] = __uint_as_float(w.z & 0xffff0000u); x[6] = __uint_as_float(w.w << 16); x[7] = __uint_as_float(w.w & 0xffff0000u);
}
template <bool ISBF> __device__ __forceinline__ void swa_step(const float (&q)[64], float (&acc)[64], float& m, float& l, const void* kp, const void* vp, float slope, float dist) {
    float s = 0.f;
#pragma unroll
    for (int j = 0; j < 8; ++j) { float x[8];
        if (ISBF) unpack8(*(const u32x4*)((const bf16_t*)kp + j * 8), x);
        else { const f32x4 a = *(const f32x4*)((const float*)kp + j * 8), b = *(const f32x4*)((const float*)kp + j * 8 + 4); x[0] = a[0]; x[1] = a[1]; x[2] = a[2]; x[3] = a[3]; x[4] = b[0]; x[5] = b[1]; x[6] = b[2]; x[7] = b[3]; }
#pragma unroll
        for (int d = 0; d < 8; ++d) s += q[j * 8 + d] * x[d]; }
    s = s * 0.125f - slope * dist;
    const float mn = fmaxf(m, s), c = __expf(m - mn), p = __expf(s - mn);
    l = l * c + p;
#pragma unroll
    for (int j = 0; j < 8; ++j) { float x[8];
        if (ISBF) unpack8(*(const u32x4*)((const bf16_t*)vp + j * 8), x);
        else { const f32x4 a = *(const f32x4*)((const float*)vp + j * 8), b = *(const f32x4*)((const float*)vp + j * 8 + 4); x[0] = a[0]; x[1] = a[1]; x[2] = a[2]; x[3] = a[3]; x[4] = b[0]; x[5] = b[1]; x[6] = b[2]; x[7] = b[3]; }
#pragma unroll
        for (int d = 0; d < 8; ++d) acc[j * 8 + d] = acc[j * 8 + d] * c + p * x[d]; }
    m = mn;
}
__global__ void __launch_bounds__(256) k_swa_naive(const bf16_t* __restrict__ U, const float* __restrict__ ck, const float* __restrict__ cv, const float* __restrict__ sinks, bf16_t* __restrict__ OB) {
    const int gid = blockIdx.x * 256 + threadIdx.x, h = gid & 15, row = gid >> 4;
    if (row >= MT) return;
    const int kvh = h >> 3;
    float q[64], acc[64];
#pragma unroll
    for (int j = 0; j < 8; ++j) { float x[8]; unpack8(*(const u32x4*)(U + (size_t)row * NINP + U_SQ + h * 64 + j * 8), x);
#pragma unroll
        for (int d = 0; d < 8; ++d) { q[j * 8 + d] = x[d]; acc[j * 8 + d] = 0.f; } }
    const float slope = exp2f(-0.5f * (float)(h + 1)); float m = sinks[h], l = 1.0f;
    if (row < MP) {
        const int t = row % PS, base = row - t, lo = t - 128 < 0 ? 0 : t - 128;
        for (int s = lo; s <= t; ++s) { const bf16_t* ur = U + (size_t)(base + s) * NINP;
            swa_step<true>(q, acc, m, l, ur + U_SK + kvh * 64, ur + U_SV + kvh * 64, slope, (float)(t - s)); }
    } else {
        const int sq = (row - MP) / SS, i = (row - MP) % SS;
        for (int idx = i; idx <= 128 + i; ++idx) {
            if (idx < 128) { const size_t o = (((size_t)sq * 128 + idx) * 2 + kvh) * 64; swa_step<false>(q, acc, m, l, ck + o, cv + o, slope, (float)(128 + i - idx)); }
            else { const bf16_t* ur = U + (size_t)(MP + sq * SS + idx - 128) * NINP; swa_step<true>(q, acc, m, l, ur + U_SK + kvh * 64, ur + U_SV + kvh * 64, slope, (float)(128 + i - idx)); }
        }
    }
    const float inv = 1.0f / l; bf16_t* op = OB + (size_t)row * BW + h * 64;
#pragma unroll
    for (int j = 0; j < 8; ++j) { u32x4 w; w.x = pk2(acc[j * 8] * inv, acc[j * 8 + 1] * inv); w.y = pk2(acc[j * 8 + 2] * inv, acc[j * 8 + 3] * inv);
        w.z = pk2(acc[j * 8 + 4] * inv, acc[j * 8 + 5] * inv); w.w = pk2(acc[j * 8 + 6] * inv, acc[j * 8 + 7] * inv); *(u32x4*)(op + j * 8) = w; }
}

__global__ void __launch_bounds__(256) k_rwkv_prep(const bf16_t* __restrict__ U, const float* __restrict__ shift, const float* __restrict__ mu, const float* __restrict__ w0, const float* __restrict__ w2,
                                                   const float* __restrict__ a0, const float* __restrict__ a2, const float* __restrict__ g2, const float* __restrict__ k_k, const float* __restrict__ k_a,
                                                   const float* __restrict__ r_k, float* __restrict__ RW) {
    __shared__ float xm[RWC]; __shared__ float tw[64], ad[64], sg[128];
    const int row = blockIdx.x, tid = threadIdx.x;
    const bf16_t* ur = U + (size_t)row * NINP + U_RU; const bf16_t* pr = ur - NINP; const float* ps = nullptr; bool first;
    if (row < MP) first = (row % PS) == 0; else { first = ((row - MP) % SS) == 0; ps = shift + (size_t)((row - MP) / SS) * RWC; }
    for (int c = tid; c < RWC; c += 256) { const float x = bf2f(ur[c]); const float s = first ? (ps ? ps[c] : 0.f) : bf2f(pr[c]); xm[c] = x + (s - x) * mu[c]; }
    __syncthreads();
    if (tid < 64) { tw[tid] = tanhf(xm[3072 + tid]); ad[tid] = xm[3136 + tid]; }
    if (tid >= 128) sg[tid - 128] = sigmoidf_(xm[3200 + tid - 128]);
    __syncthreads();
    float* R = RW; float* WD = RW + (size_t)MPAD * BW; float* K2 = WD + (size_t)MPAD * BW; float* V = K2 + (size_t)MPAD * BW; float* KK = V + (size_t)MPAD * BW;
    float* BV = KK + (size_t)MPAD * BW; float* G = BV + (size_t)MPAD * BW; float* BON = G + (size_t)MPAD * BW;
    for (int qd = 0; qd < 4; ++qd) {
        const int c = qd * 256 + tid; float accw = w0[c], acca = a0[c], accg = 0.f;
        for (int j = 0; j < 64; ++j) { accw += tw[j] * w2[j * BW + c]; acca += ad[j] * a2[j * BW + c]; }
        for (int j = 0; j < 128; ++j) accg += sg[j] * g2[j * BW + c];
        const float lw = -softplusf_(-accw) - 0.5f, decay = __expf(-__expf(lw)), a = sigmoidf_(acca);
        const float r = xm[c], k = xm[1024 + c], v = xm[2048 + c];
        const float kkr = k * k_k[c]; const float ss = wave_sum(kkr * kkr); const float kk = kkr / fmaxf(sqrtf(ss), 1e-12f);
        const float k2 = k * (1.0f + (a - 1.0f) * k_a[c]); const float rk = wave_sum(r * k2 * r_k[c]);
        const size_t o = (size_t)row * BW + c;
        R[o] = r; WD[o] = decay; K2[o] = k2; V[o] = v; KK[o] = kk; BV[o] = kk * a; G[o] = accg; BON[o] = rk * v;
    }
}
__global__ void __launch_bounds__(64) k_rwkv_scan_naive(const float* __restrict__ RW, const float* __restrict__ s0, const float* __restrict__ lng, const float* __restrict__ lnb, bf16_t* __restrict__ OB,
                                                        float* __restrict__ outP, float* __restrict__ outS) {
    const int sq = blockIdx.x >> 4, h = blockIdx.x & 15, lane = threadIdx.x;
    int row0, L; seq_info(sq, row0, L);
    const float* R = RW; const float* WD = RW + (size_t)MPAD * BW; const float* K2 = WD + (size_t)MPAD * BW; const float* V = K2 + (size_t)MPAD * BW; const float* KK = V + (size_t)MPAD * BW;
    const float* BV = KK + (size_t)MPAD * BW; const float* G = BV + (size_t)MPAD * BW; const float* BON = G + (size_t)MPAD * BW;
    float S[64];
    if (sq >= PB) { const float* p = s0 + (((size_t)(sq - PB) * 16 + h) * 64 + lane) * 64;
#pragma unroll
        for (int j = 0; j < 64; ++j) S[j] = p[j]; }
    else {
#pragma unroll
        for (int j = 0; j < 64; ++j) S[j] = 0.f; }
    const float lg = lng[h * 64 + lane], lb = lnb[h * 64 + lane];
    for (int t = 0; t < L; ++t) {
        const size_t base = (size_t)(row0 + t) * BW + h * 64; const float v = V[base + lane];
        float d = 0.f;
#pragma unroll
        for (int j = 0; j < 64; ++j) d += S[j] * KK[base + j];
        float y = 0.f;
#pragma unroll
        for (int j = 0; j < 64; ++j) { S[j] = S[j] * WD[base + j] - d * BV[base + j] + v * K2[base + j]; y += S[j] * R[base + j]; }
        const float mean = wave_sum(y) * (1.0f / 64.0f), dy = y - mean, var = wave_sum(dy * dy) * (1.0f / 64.0f);
        const float yn = dy * rsqrtf(var + 64e-5f) * lg + lb;
        OB[base + lane] = f2bf((yn + BON[base + lane]) * G[base + lane]);
    }
    float* op = (sq < PB ? outP + (((size_t)sq * 16 + h) * 64 + lane) * 64 : outS + (((size_t)(sq - PB) * 16 + h) * 64 + lane) * 64);
#pragma unroll
    for (int j = 0; j < 64; ++j) op[j] = S[j];
}
__global__ void __launch_bounds__(256) k_memattn_sample(const bf16_t* __restrict__ U, const float* __restrict__ mk, const float* __restrict__ mv, bf16_t* __restrict__ OB) {
    __shared__ float qs[4][256], ps[4][256];
    const int sq = blockIdx.x >> 2, h = blockIdx.x & 3, tid = threadIdx.x, lane = tid & 63, wave = tid >> 6;
#pragma unroll
    for (int t = 0; t < 4; ++t) qs[t][tid] = bf2f(U[(size_t)(MP + sq * SS + t) * NINP + U_MQ + h * 256 + tid]) * 0.0625f;
    __syncthreads();
    { const float* kr = mk + (((size_t)sq * MEMT + tid) * 4 + h) * 256; float s[4] = {0.f, 0.f, 0.f, 0.f};
        for (int d = 0; d < 256; d += 4) { const f32x4 kv = *(const f32x4*)(kr + d);
#pragma unroll
            for (int t = 0; t < 4; ++t) s[t] += kv[0] * qs[t][d] + kv[1] * qs[t][d + 1] + kv[2] * qs[t][d + 2] + kv[3] * qs[t][d + 3]; }
#pragma unroll
        for (int t = 0; t < 4; ++t) ps[t][tid] = s[t]; }
    __syncthreads();
    { float x[4]; float mx = -3.0e38f;
#pragma unroll
        for (int j = 0; j < 4; ++j) { x[j] = ps[wave][lane + 64 * j]; mx = fmaxf(mx, x[j]); }
        mx = wave_max(mx); float s = 0.f;
#pragma unroll
        for (int j = 0; j < 4; ++j) { x[j] = __expf(x[j] - mx); s += x[j]; }
        const float inv = 1.0f / wave_sum(s);
#pragma unroll
        for (int j = 0; j < 4; ++j) ps[wave][lane + 64 * j] = x[j] * inv; }
    __syncthreads();
    { float o[4] = {0.f, 0.f, 0.f, 0.f}; const float* vr = mv + ((size_t)sq * MEMT * 4 + h) * 256 + tid;
        for (int m = 0; m < MEMT; ++m) { const float vv = vr[(size_t)m * 1024];
#pragma unroll
            for (int t = 0; t < 4; ++t) o[t] += ps[t][m] * vv; }
#pragma unroll
        for (int t = 0; t < 4; ++t) OB[(size_t)(MP + sq * SS + t) * BW + h * 256 + tid] = f2bf(o[t]); }
}

template <class Epi> static void launch_gemm(const pg8::Gemm& g, const Epi& E, hipStream_t st) {
    static bool attr = false;
    if (!attr) { (void)hipFuncSetAttribute((const void*)k_gemm<Epi>, hipFuncAttributeMaxDynamicSharedMemorySize, pg8::STAGE_BYTES); attr = true; }
    hipLaunchKernelGGL((k_gemm<Epi>), dim3(256), dim3(512), pg8::STAGE_BYTES, st, g, E);
}
static pg8::Gemm mk_gemm(const bf16_t* A, const bf16_t* B, int lda, int ldb, int K, int nM, int nN) {
    pg8::Gemm g; memset(&g, 0, sizeof g); g.A = A; g.B = B; g.lda = lda; g.ldb = ldb; g.K = K; g.nM = nM; g.nN = nN; g.nZ = 1; g.nZh = 1; g.zinner = 0; return g;
}

extern "C" void kernel_launch(void* const* d_in, const int* in_sizes, int n_in, void* d_out, int out_size, void* d_ws, size_t ws_size, hipStream_t stream) {
    if (n_in != 37 || (size_t)out_size != O_END || ws_size < WS_END) { fprintf(stderr, "kernel_launch: unexpected sizes (n_in %d out %d ws %zu need %zu)\n", n_in, out_size, ws_size, (size_t)WS_END); return; }
    const float* const* in = (const float* const*)d_in;
    float* out = (float*)d_out; unsigned char* ws = (unsigned char*)d_ws;
    bf16_t* W_IN = (bf16_t*)(ws + WS_WIN); bf16_t* W_MEM = (bf16_t*)(ws + WS_WMEM); bf16_t* W_BR = (bf16_t*)(ws + WS_WBR); bf16_t* W_OUT = (bf16_t*)(ws + WS_WOUT);
    bf16_t* W_GU = (bf16_t*)(ws + WS_WGU); bf16_t* W_DN = (bf16_t*)(ws + WS_WDN);
    float* HF = (float*)(ws + WS_HF); bf16_t* HB = (bf16_t*)(ws + WS_HB); bf16_t* U = (bf16_t*)(ws + WS_U); bf16_t* BR = (bf16_t*)(ws + WS_BR);
    float* MG = (float*)(ws + WS_MG); bf16_t* MGB = (bf16_t*)(ws + WS_MGB); float* Y = (float*)(ws + WS_Y); float* X1F = (float*)(ws + WS_X1F); bf16_t* X1B = (bf16_t*)(ws + WS_X1B);
    bf16_t* ACT = (bf16_t*)(ws + WS_ACT); bf16_t* MEMB = (bf16_t*)(ws + WS_MEMB); bf16_t* MKB = (bf16_t*)(ws + WS_MKB); bf16_t* MVT = (bf16_t*)(ws + WS_MVT);
    float* SC = (float*)(ws + WS_SC); bf16_t* PBF = (bf16_t*)(ws + WS_PB); float* RW = (float*)(ws + WS_RW);

    hipLaunchKernelGGL(k_wprep, dim3(NINP / 64, DM / 64, NL), dim3(256), 0, stream, in[10], W_IN, DM, NIN, 1, (size_t)DM * NIN, (size_t)NINP * DM);
    hipLaunchKernelGGL(k_wprep, dim3(DM / 64, DM / 64, NL), dim3(256), 0, stream, in[28], W_MEM, DM, DM, 0, (size_t)DM * DM, (size_t)DM * DM);
    hipLaunchKernelGGL(k_wprep, dim3(DM / 64, BW / 64, NL * 4), dim3(256), 0, stream, in[29], W_BR, BW, DM, 0, (size_t)BW * DM, (size_t)DM * BW);
    hipLaunchKernelGGL(k_wprep, dim3(DM / 64, DM / 64, NL), dim3(256), 0, stream, in[30], W_OUT, DM, DM, 0, (size_t)DM * DM, (size_t)DM * DM);
    hipLaunchKernelGGL(k_wprep, dim3(2 * DFF / 64, DM / 64, NL), dim3(256), 0, stream, in[33], W_GU, DM, 2 * DFF, 2, (size_t)DM * 2 * DFF, (size_t)2 * DFF * DM);
    hipLaunchKernelGGL(k_wprep, dim3(DM / 64, DFF / 64, NL), dim3(256), 0, stream, in[34], W_DN, DFF, DM, 0, (size_t)DFF * DM, (size_t)DM * DFF);
    { const size_t n4 = (size_t)MPAD * DM / 4 + (size_t)512 * DM / 4; hipLaunchKernelGGL(k_xprep, dim3((unsigned)((n4 + 255) / 256)), dim3(256), 0, stream, in[0], in[1], in[2], HF, HB, MEMB); }
    { pg8::Gemm g = mk_gemm(MEMB, W_MEM, DM, DM, DM, 2, 8); g.nZ = NL; g.zsBb = (long)DM * DM;
      pg8::EpiMem E; memset(&E, 0, sizeof E); E.outK = out + O_MKP; E.outV = out + O_MVP; E.kb = MKB; E.vt = MVT; launch_gemm(g, E, stream); }

    for (int l = 0; l < NL; ++l) {
        { pg8::Gemm g = mk_gemm(HB, W_IN + (size_t)l * NINP * DM, DM, DM, DM, MPAD / 256, NINP / 256);
          pg8::EpiBf16 E; memset(&E, 0, sizeof E); E.O = U; E.ldc = NINP; launch_gemm(g, E, stream); }
        hipLaunchKernelGGL(k_copy_outs, dim3((PB * 16384 + SB * 16384 + PB * RWC + SB * RWC + 255) / 256), dim3(256), 0, stream, U,
                           in[3] + (size_t)l * SB * 16384, in[4] + (size_t)l * SB * 16384, out, l);
        hipLaunchKernelGGL(k_gla_naive, dim3((PB + SB) * 4), dim3(256), 0, stream, U, in[7] + (size_t)l * SB * 4 * 32768, in[12] + (size_t)l * 16 * 512, in[13] + (size_t)l * 512,
                           in[14] + (size_t)l * BW, in[15] + (size_t)l * BW, BR, out + O_GLAP + (size_t)l * PB * 4 * 32768, out + O_GLAS + (size_t)l * SB * 4 * 32768);
        hipLaunchKernelGGL(k_swa_naive, dim3(MT * 16 / 256), dim3(256), 0, stream, U, in[3] + (size_t)l * SB * 16384, in[4] + (size_t)l * SB * 16384, in[16] + (size_t)l * 16, BR + (size_t)MPAD * BW);
        hipLaunchKernelGGL(k_rwkv_prep, dim3(MT), dim3(256), 0, stream, U, in[9] + (size_t)l * SB * RWC, in[17] + (size_t)l * RWC, in[18] + (size_t)l * BW, in[19] + (size_t)l * 64 * BW,
                           in[20] + (size_t)l * BW, in[21] + (size_t)l * 64 * BW, in[22] + (size_t)l * 128 * BW, in[23] + (size_t)l * BW, in[24] + (size_t)l * BW, in[25] + (size_t)l * BW, RW);
        hipLaunchKernelGGL(k_rwkv_scan_naive, dim3((PB + SB) * 16), dim3(64), 0, stream, RW, in[8] + (size_t)l * SB * 16 * 4096, in[26] + (size_t)l * BW, in[27] + (size_t)l * BW, BR + (size_t)2 * MPAD * BW,
                           out + O_RWP + (size_t)l * PB * 16 * 4096, out + O_RWS + (size_t)l * SB * 16 * 4096);
        { pg8::Gemm g = mk_gemm(U + U_MQ, MKB + (size_t)l * 512 * 1024, NINP, 1024, 256, PS / 256, 1); g.nZ = 8; g.nZh = 4; g.zsAb = (long)PS * NINP; g.zsAh = 256; g.zsBb = 256 * 1024; g.zsBh = 256;
          pg8::EpiScore E; memset(&E, 0, sizeof E); E.SC = SC; launch_gemm(g, E, stream); }
        hipLaunchKernelGGL(k_softmax256, dim3(8 * 4096 / 4), dim3(256), 0, stream, SC, PBF, 8 * 4096);
        { pg8::Gemm g = mk_gemm(PBF, MVT + (size_t)l * 8 * 65536, 256, 256, 256, PS / 256, 1); g.nZ = 8; g.nZh = 4; g.zsAb = (long)4 * 4096 * 256; g.zsAh = (long)4096 * 256; g.zsBb = 4 * 65536; g.zsBh = 65536;
          pg8::EpiPV E; memset(&E, 0, sizeof E); E.O = BR + (size_t)3 * MPAD * BW; launch_gemm(g, E, stream); }
        hipLaunchKernelGGL(k_memattn_sample, dim3(SB * 4), dim3(256), 0, stream, U, in[5] + (size_t)l * SB * MEMT * 1024, in[6] + (size_t)l * SB * MEMT * 1024, BR + (size_t)3 * MPAD * BW);
        { pg8::Gemm g = mk_gemm(BR, W_BR + (size_t)l * 4 * DM * BW, BW, BW, BW, MPAD / 256, DM / 256); g.nZ = 4; g.zinner = 1; g.zsAb = (long)MPAD * BW; g.zsBb = (long)DM * BW;
          pg8::EpiMerge E; memset(&E, 0, sizeof E); E.MG = MG; E.MGB = MGB; E.U = U; E.gate_b = in[11] + (size_t)l * 4 * DM; launch_gemm(g, E, stream); }
        { pg8::Gemm g = mk_gemm(MGB, W_OUT + (size_t)l * DM * DM, DM, DM, DM, MPAD / 256, DM / 256);
          pg8::EpiRes E; memset(&E, 0, sizeof E); E.R = HF; E.Y = Y; launch_gemm(g, E, stream); }
        hipLaunchKernelGGL(k_ln, dim3(MPAD / 4), dim3(256), 0, stream, Y, in[31] + (size_t)l * DM, in[32] + (size_t)l * DM, X1F, X1B, (float*)nullptr, MPAD, 0);
        { pg8::Gemm g = mk_gemm(X1B, W_GU + (size_t)l * 2 * DFF * DM, DM, DM, DM, MPAD / 256, 2 * DFF / 256);
          pg8::EpiSwiGLU E; memset(&E, 0, sizeof E); E.O = ACT; launch_gemm(g, E, stream); }
        { pg8::Gemm g = mk_gemm(ACT, W_DN + (size_t)l * DM * DFF, DFF, DFF, DFF, MPAD / 256, DM / 256);
          pg8::EpiRes E; memset(&E, 0, sizeof E); E.R = X1F; E.Y = Y; launch_gemm(g, E, stream); }
        hipLaunchKernelGGL(k_ln, dim3(MPAD / 4), dim3(256), 0, stream, Y, in[35] + (size_t)l * DM, in[36] + (size_t)l * DM, HF, HB, l == NL - 1 ? out : (float*)nullptr, MPAD, MT);
    }
}
```

```cpp
#include <hip/hip_runtime.h>
#include <cstdio>
#include <cstdint>
#include <cstring>

#define LAS __attribute__((address_space(3)))
typedef unsigned short bf16_t;
typedef short bf16x8 __attribute__((ext_vector_type(8)));
typedef float f32x4 __attribute__((ext_vector_type(4)));
typedef float f32x2 __attribute__((ext_vector_type(2)));
typedef unsigned u32x4 __attribute__((ext_vector_type(4)));
typedef unsigned u32x2 __attribute__((ext_vector_type(2)));

constexpr int DM = 2048, NL = 4;
constexpr int PB = 2, PS = 4096, MP = PB * PS;
constexpr int SB = 32, SS = 4, MS = SB * SS;
constexpr int MT = MP + MS;
constexpr int MPAD = 8448;
constexpr int NIN = 16912, NINP = 17152;
constexpr int U_GQ = 0, U_GK = 512, U_GV = 1024, U_GR = 2048, U_GA = 3072, U_SQ = 3328, U_SK = 4352, U_SV = 4480, U_RU = 4608, U_MQ = 7936, U_GP = 8960;
constexpr int RWC = 3328, BW = 1024, DFF = 5632, MEMT = 256;
constexpr float ALPHA = 1.681792830507429f;

constexpr size_t O_YP = 0;
constexpr size_t O_YS = O_YP + (size_t)MP * DM;
constexpr size_t O_SWKP = O_YS + (size_t)MS * DM;
constexpr size_t O_SWVP = O_SWKP + (size_t)NL * PB * 128 * 128;
constexpr size_t O_MKP = O_SWVP + (size_t)NL * PB * 128 * 128;
constexpr size_t O_MVP = O_MKP + (size_t)NL * PB * 256 * 1024;
constexpr size_t O_GLAP = O_MVP + (size_t)NL * PB * 256 * 1024;
constexpr size_t O_RWP = O_GLAP + (size_t)NL * PB * 4 * 128 * 256;
constexpr size_t O_RSP = O_RWP + (size_t)NL * PB * 16 * 64 * 64;
constexpr size_t O_SWKS = O_RSP + (size_t)NL * PB * RWC;
constexpr size_t O_SWVS = O_SWKS + (size_t)NL * SB * 128 * 128;
constexpr size_t O_GLAS = O_SWVS + (size_t)NL * SB * 128 * 128;
constexpr size_t O_RWS = O_GLAS + (size_t)NL * SB * 4 * 128 * 256;
constexpr size_t O_RSS = O_RWS + (size_t)NL * SB * 16 * 64 * 64;
constexpr size_t O_END = O_RSS + (size_t)NL * SB * RWC;
static_assert(O_END == 52881408, "output size");

constexpr size_t al256(size_t x) { return (x + 255) & ~(size_t)255; }
constexpr size_t WS_CTL = 0;
constexpr size_t WS_WIN = 65536;
constexpr size_t WS_WMEM = WS_WIN + (size_t)NL * NINP * DM * 2;
constexpr size_t WS_WBR = WS_WMEM + (size_t)NL * DM * DM * 2;
constexpr size_t WS_WOUT = WS_WBR + (size_t)NL * 4 * DM * BW * 2;
constexpr size_t WS_WGU = WS_WOUT + (size_t)NL * DM * DM * 2;
constexpr size_t WS_WDN = WS_WGU + (size_t)NL * 2 * DFF * DM * 2;
constexpr size_t WS_HF = WS_WDN + (size_t)NL * DM * DFF * 2;
constexpr size_t WS_HB = WS_HF + (size_t)MPAD * DM * 4;
constexpr size_t WS_U = WS_HB + (size_t)MPAD * DM * 2;
constexpr size_t WS_BR = WS_U + (size_t)MPAD * NINP * 2;
constexpr size_t WS_MG = WS_BR + (size_t)4 * MPAD * BW * 2;
constexpr size_t WS_MGB = WS_MG + (size_t)MPAD * DM * 4;
constexpr size_t WS_Y = WS_MGB + (size_t)MPAD * DM * 2;
constexpr size_t WS_X1F = WS_Y + (size_t)MPAD * DM * 4;
constexpr size_t WS_X1B = WS_X1F + (size_t)MPAD * DM * 4;
constexpr size_t WS_ACT = WS_X1B + (size_t)MPAD * DM * 2;
constexpr size_t WS_MEMB = WS_ACT + (size_t)MPAD * DFF * 2;
constexpr size_t WS_MKB = WS_MEMB + (size_t)512 * DM * 2;
constexpr size_t WS_MVT = WS_MKB + (size_t)NL * 512 * 1024 * 2;
constexpr size_t WS_SC = WS_MVT + (size_t)NL * 8 * 256 * 256 * 2;
constexpr size_t WS_PB = WS_SC + (size_t)8 * 4096 * 256 * 4;
constexpr size_t WS_RW = WS_PB + (size_t)8 * 4096 * 256 * 2;
constexpr size_t RW_ARR = (size_t)MPAD * BW * 4;
constexpr size_t WS_END = WS_RW + 8 * RW_ARR;

__device__ __forceinline__ float bf2f(bf16_t b) { return __uint_as_float(((unsigned)b) << 16); }
__device__ __forceinline__ bf16_t f2bf(float f) { unsigned u = __float_as_uint(f); u += 0x7FFFu + ((u >> 16) & 1u); return (bf16_t)(u >> 16); }
__device__ __forceinline__ unsigned pk2(float lo, float hi) { return (unsigned)f2bf(lo) | ((unsigned)f2bf(hi) << 16); }
__device__ __forceinline__ float wave_sum(float v) {
#pragma unroll
    for (int o = 32; o > 0; o >>= 1) v += __shfl_xor(v, o, 64);
    return v;
}
__device__ __forceinline__ float wave_max(float v) {
#pragma unroll
    for (int o = 32; o > 0; o >>= 1) v = fmaxf(v, __shfl_xor(v, o, 64));
    return v;
}
__device__ __forceinline__ float sigmoidf_(float x) { return 1.0f / (1.0f + __expf(-x)); }
__device__ __forceinline__ float softplusf_(float x) { return fmaxf(x, 0.f) + log1pf(__expf(-fabsf(x))); }

namespace pg8 {
constexpr int BM = 256, BK = 64, HALF = 128, HTB = HALF * BK * 2, STAGE_BYTES = 8 * HTB, NXCD = 8, WGM = 8;
__host__ __device__ __forceinline__ int lds_byte(int r, int c) { const int st = (r >> 4) * 2 + (c >> 5), rr = r & 15, cc = c & 31, ob = rr * 64 + cc * 2; return st * 1024 + (ob ^ (((ob >> 9) & 1) << 5)); }
__host__ __device__ __forceinline__ void stage_rc(int b, int& R, int& C) { const int st = b / 1024, sb = b % 1024, swz = sb ^ (((sb >> 9) & 1) << 5); R = (st >> 1) * 16 + swz / 64; C = (st & 1) * 32 + (swz % 64) / 2; }
__host__ __device__ __forceinline__ int perm32(int rho) { const int n = rho >> 4, i = rho & 15; return 8 * (i >> 2) + 4 * n + (i & 3); }

struct Unit { int pm, pn, z; };
template <int LDA_, int LDB_, int K_, int NM_, int NN_, int NZ_ = 1, int NZH_ = 1, bool ZINNER_ = false, long ZSAB_ = 0, long ZSAH_ = 0, long ZSBB_ = 0, long ZSBH_ = 0>
struct Gemm {
    static constexpr int LDA = LDA_, LDB = LDB_, K = K_, NM = NM_, NN = NN_, NZ = NZ_, NZH = NZH_; static constexpr bool ZINNER = ZINNER_;
    const bf16_t* A; const bf16_t* B; int G, c;
    __device__ __forceinline__ bool next(int i, Unit& u) const {
        constexpr int nt = NM * NN; int L, z;
        if (ZINNER) { const int it = i / NZ; z = i - it * NZ; const long LL = (long)it * G + c; if (LL >= nt) return false; L = (int)LL; }
        else { const long LL = (long)i * G + c; if (LL >= (long)nt * NZ) return false; z = (int)(LL / nt); L = (int)(LL - (long)z * nt); }
        int wgid = L; { constexpr int q = nt / NXCD, r = nt % NXCD; const int xcd = wgid % NXCD, off = wgid / NXCD; wgid = (xcd < r ? xcd * (q + 1) : r * (q + 1) + (xcd - r) * q) + off; }
        constexpr int nig = WGM * NN; const int gid = wgid / nig, fm = gid * WGM, gsz = (NM - fm) < WGM ? (NM - fm) : WGM;
        u.pm = fm + ((wgid % nig) % gsz); u.pn = (wgid % nig) / gsz; u.z = z; return true;
    }
    __device__ __forceinline__ const char* a_base(const Unit& u) const { const int zb = u.z / NZH, zh = u.z - zb * NZH; return (const char*)(A + zb * ZSAB_ + zh * ZSAH_ + (long)u.pm * BM * LDA); }
    __device__ __forceinline__ const char* b_base(const Unit& u) const { const int zb = u.z / NZH, zh = u.z - zb * NZH; return (const char*)(B + zb * ZSBB_ + zh * ZSBH_ + (long)u.pn * BM * LDB); }
};

template <class GT, class Epi, bool ALIGN_EPI = true, bool SP2 = true>
__device__ __forceinline__ void gemm_phase(LAS unsigned char* lds, const int tid, const GT& g, const Epi& E) {
    const int wid = __builtin_amdgcn_readfirstlane(tid >> 6), lane = tid & 63, wr = wid >> 2, wc = wid & 3, fr = lane & 15, fq = lane >> 4;
    constexpr int nt = GT::K / BK;
    unsigned voffA[2], voffB[2];
#pragma unroll
    for (int i = 0; i < 2; ++i) { int R, C; stage_rc(tid * 16 + i * 8192, R, C); const int Rb = Epi::PERM ? ((R & ~31) + perm32(R & 31)) : R;
        voffA[i] = (unsigned)(R * GT::LDA + C) * 2u; voffB[i] = (unsigned)(Rb * GT::LDB + C) * 2u; }
    constexpr size_t kstep = (size_t)(BK * 2);
    constexpr size_t hstepA = (size_t)HALF * GT::LDA * 2, hstepB = (size_t)HALF * GT::LDB * 2;
    const unsigned ldsw = (unsigned)wid * 1024u;
    const int aoff = lds_byte(wr * 64 + fr, fq * 8), boff = lds_byte(wc * 32 + fr, fq * 8);
#define PG8_SA(b, h) (((b) * 2 + (h)) * HTB)
#define PG8_SB(b, h) ((4 + (b) * 2 + (h)) * HTB)
#define PG8_STAGE(bufoff, gbase, voff) do { _Pragma("unroll") for (int _i = 0; _i < 2; ++_i) \
        __builtin_amdgcn_global_load_lds((const unsigned*)((const char*)(gbase) + (voff)[_i]), (LAS unsigned*)(lds + (bufoff) + ldsw + _i * 8192), 16, 0, 0); } while (0)
#define PG8_LDA(dst, b, h) do { _Pragma("unroll") for (int m = 0; m < 4; ++m) _Pragma("unroll") for (int k = 0; k < 2; ++k) dst[m][k] = *(const LAS bf16x8*)(lds + PG8_SA(b, h) + aoff + m * 2048 + k * 1024); } while (0)
#define PG8_LDB(dst, b, h) do { _Pragma("unroll") for (int n = 0; n < 2; ++n) _Pragma("unroll") for (int k = 0; k < 2; ++k) dst[n][k] = *(const LAS bf16x8*)(lds + PG8_SB(b, h) + boff + n * 2048 + k * 1024); } while (0)
#define PG8_MMA(ai, bj, At, Bt) do { __builtin_amdgcn_s_setprio(1); _Pragma("unroll") for (int m = 0; m < 4; ++m) _Pragma("unroll") for (int n = 0; n < 2; ++n) _Pragma("unroll") for (int k = 0; k < 2; ++k) \
        acc[ai][bj][m][n] = __builtin_amdgcn_mfma_f32_16x16x32_bf16(Bt[n][k], At[m][k], acc[ai][bj][m][n], 0, 0, 0); __builtin_amdgcn_s_setprio(0); } while (0)
#define PG8_WAIT_V(n) asm volatile("s_waitcnt vmcnt(" #n ")" ::: "memory")
#define PG8_WAIT_L(n) asm volatile("s_waitcnt lgkmcnt(" #n ")" ::: "memory")
#define PG8_BAR __builtin_amdgcn_s_barrier()
#define PG8_SCHED __builtin_amdgcn_sched_barrier(0)
    Unit cur, nxt; int ui = 0;
    if (!g.next(0, cur)) return;
    f32x4 acc[2][2][4][2];
#pragma unroll
    for (int a = 0; a < 2; ++a)
#pragma unroll
        for (int b = 0; b < 2; ++b)
#pragma unroll
            for (int m = 0; m < 4; ++m)
#pragma unroll
                for (int n = 0; n < 2; ++n) acc[a][b][m][n] = (f32x4){0.f, 0.f, 0.f, 0.f};
    bf16x8 At[4][2], B0[2][2], B1[2][2];
    const char* cA = g.a_base(cur); const char* cB = g.b_base(cur);
    if constexpr (SP2) {
        PG8_STAGE(PG8_SB(0, 0), cB, voffB); PG8_STAGE(PG8_SB(0, 1), cB + hstepB, voffB); PG8_STAGE(PG8_SA(0, 0), cA, voffA); PG8_STAGE(PG8_SA(0, 1), cA + hstepA, voffA);
        if (wr == 1) PG8_BAR;
        PG8_WAIT_V(2); PG8_BAR;
        PG8_STAGE(PG8_SB(1, 0), cB + kstep, voffB); PG8_STAGE(PG8_SA(1, 0), cA + kstep, voffA); PG8_STAGE(PG8_SB(1, 1), cB + hstepB + kstep, voffB);
        PG8_WAIT_V(6); PG8_BAR;
    } else {
        PG8_STAGE(PG8_SB(0, 0), cB, voffB); PG8_STAGE(PG8_SA(0, 0), cA, voffA); PG8_STAGE(PG8_SB(0, 1), cB + hstepB, voffB); PG8_STAGE(PG8_SA(0, 1), cA + hstepA, voffA);
        if (wr == 1) PG8_BAR;
        PG8_WAIT_V(4); PG8_BAR;
        PG8_STAGE(PG8_SB(1, 0), cB + kstep, voffB); PG8_STAGE(PG8_SA(1, 0), cA + kstep, voffA); PG8_STAGE(PG8_SB(1, 1), cB + hstepB + kstep, voffB);
        PG8_WAIT_V(6); PG8_BAR;
    }
    for (;;) {
        const bool has_next = g.next(ui + 1, nxt);
        const char* nA = has_next ? g.a_base(nxt) : cA; const char* nB = has_next ? g.b_base(nxt) : cB;
#pragma unroll 1
        for (int t = 0; t < nt; t += 2) {
            const bool last = (t == nt - 2);
            const char* a1 = cA + (size_t)(t + 1) * kstep;
            const char* a2 = last ? nA : cA + (size_t)(t + 2) * kstep; const char* b2 = last ? nB : cB + (size_t)(t + 2) * kstep;
            const char* a3 = a2 + kstep; const char* b3 = b2 + kstep;
            if constexpr (SP2) {
            PG8_LDB(B0, 0, 0); PG8_LDB(B1, 0, 1); PG8_SCHED; PG8_LDA(At, 0, 0); PG8_STAGE(PG8_SA(1, 1), a1 + hstepA, voffA);
            PG8_WAIT_V(8); PG8_WAIT_L(0); PG8_BAR; PG8_MMA(0, 0, At, B0); PG8_MMA(0, 1, At, B1); PG8_BAR; PG8_SCHED;
            PG8_LDA(At, 0, 1); PG8_STAGE(PG8_SB(0, 0), b2, voffB); PG8_STAGE(PG8_SB(0, 1), b2 + hstepB, voffB); PG8_STAGE(PG8_SA(0, 0), a2, voffA);
            PG8_WAIT_V(8); PG8_WAIT_L(0); PG8_BAR; PG8_MMA(1, 0, At, B0); PG8_MMA(1, 1, At, B1); PG8_BAR; PG8_SCHED;
            PG8_LDB(B0, 1, 0); PG8_LDB(B1, 1, 1); PG8_SCHED; PG8_LDA(At, 1, 0); PG8_STAGE(PG8_SA(0, 1), a2 + hstepA, voffA);
            PG8_WAIT_V(8); PG8_WAIT_L(0); PG8_BAR; PG8_MMA(0, 0, At, B0); PG8_MMA(0, 1, At, B1); PG8_BAR; PG8_SCHED;
            PG8_LDA(At, 1, 1); PG8_STAGE(PG8_SB(1, 0), b3, voffB); PG8_STAGE(PG8_SB(1, 1), b3 + hstepB, voffB); PG8_STAGE(PG8_SA(1, 0), a3, voffA);
            PG8_WAIT_V(8); PG8_WAIT_L(0); PG8_BAR; PG8_MMA(1, 0, At, B0); PG8_MMA(1, 1, At, B1); PG8_BAR; PG8_SCHED;
            } else {
            PG8_LDB(B0, 0, 0); PG8_SCHED; PG8_LDA(At, 0, 0); PG8_STAGE(PG8_SA(1, 1), a1 + hstepA, voffA);
            PG8_WAIT_L(8); PG8_BAR; PG8_WAIT_L(0); PG8_MMA(0, 0, At, B0); PG8_BAR; PG8_SCHED;
            PG8_LDB(B1, 0, 1); PG8_STAGE(PG8_SB(0, 0), b2, voffB);
            PG8_BAR; PG8_WAIT_L(0); PG8_MMA(0, 1, At, B1); PG8_BAR;
            PG8_LDA(At, 0, 1); PG8_STAGE(PG8_SA(0, 0), a2, voffA);
            PG8_BAR; PG8_WAIT_L(0); PG8_MMA(1, 0, At, B0); PG8_BAR; PG8_SCHED;
            PG8_STAGE(PG8_SB(0, 1), b2 + hstepB, voffB);
            PG8_WAIT_V(6); PG8_BAR; PG8_MMA(1, 1, At, B1); PG8_BAR;
            PG8_LDB(B0, 1, 0); PG8_SCHED; PG8_LDA(At, 1, 0); PG8_STAGE(PG8_SA(0, 1), a2 + hstepA, voffA);
            PG8_WAIT_L(8); PG8_BAR; PG8_WAIT_L(0); PG8_MMA(0, 0, At, B0); PG8_BAR; PG8_SCHED;
            PG8_LDB(B1, 1, 1); PG8_STAGE(PG8_SB(1, 0), b3, voffB);
            PG8_BAR; PG8_WAIT_L(0); PG8_MMA(0, 1, At, B1); PG8_BAR;
            PG8_LDA(At, 1, 1); PG8_STAGE(PG8_SA(1, 0), a3, voffA);
            PG8_BAR; PG8_WAIT_L(0); PG8_MMA(1, 0, At, B0); PG8_BAR; PG8_SCHED;
            PG8_STAGE(PG8_SB(1, 1), b3 + hstepB, voffB);
            PG8_WAIT_V(6); PG8_BAR; PG8_MMA(1, 1, At, B1); PG8_BAR;
            }
        }
        if constexpr (ALIGN_EPI) { if (wr == 0) PG8_BAR; }
        E(acc, cur, wr, wc, fr, fq);
        if (!has_next) break;
#pragma unroll
        for (int a = 0; a < 2; ++a)
#pragma unroll
            for (int b = 0; b < 2; ++b)
#pragma unroll
                for (int m = 0; m < 4; ++m)
#pragma unroll
                    for (int n = 0; n < 2; ++n) acc[a][b][m][n] = (f32x4){0.f, 0.f, 0.f, 0.f};
        cur = nxt; cA = nA; cB = nB; ++ui;
        if constexpr (ALIGN_EPI) { if (wr == 1) PG8_BAR; }
    }
    PG8_WAIT_V(0);
    if constexpr (!ALIGN_EPI) { if (wr == 0) PG8_BAR; }
    PG8_BAR;
#undef PG8_SA
#undef PG8_SB
#undef PG8_STAGE
#undef PG8_LDA
#undef PG8_LDB
#undef PG8_MMA
#undef PG8_WAIT_V
#undef PG8_WAIT_L
#undef PG8_BAR
#undef PG8_SCHED
}

struct EpiBf16 {
    static constexpr bool PERM = true;
    bf16_t* O; long zs; int ldc, pad;
    __device__ __forceinline__ void operator()(const f32x4 (&acc)[2][2][4][2], const Unit& u, int wr, int wc, int fr, int fq) const {
        const int row0 = u.pm * BM + wr * 64 + fr, col0 = u.pn * BM + wc * 32 + 8 * fq; bf16_t* base = O + (long)u.z * zs;
#pragma unroll
        for (int ai = 0; ai < 2; ++ai)
#pragma unroll
            for (int m = 0; m < 4; ++m) { bf16_t* rowp = base + (size_t)(row0 + ai * HALF + m * 16) * ldc + col0;
#pragma unroll
                for (int bj = 0; bj < 2; ++bj) { const f32x4 v0 = acc[ai][bj][m][0], v1 = acc[ai][bj][m][1];
                    u32x4 w; w.x = pk2(v0[0], v0[1]); w.y = pk2(v0[2], v0[3]); w.z = pk2(v1[0], v1[1]); w.w = pk2(v1[2], v1[3]);
                    *(u32x4*)(rowp + bj * HALF) = w; } }
    }
};
struct EpiMem {
    static constexpr bool PERM = false;
    float* outK; float* outV; bf16_t* kb; bf16_t* vt;
    __device__ __forceinline__ void operator()(const f32x4 (&acc)[2][2][4][2], const Unit& u, int wr, int wc, int fr, int fq) const {
        const int row0 = u.pm * BM + wr * 64 + fr, col0 = u.pn * BM + wc * 32 + 4 * fq;
#pragma unroll
        for (int ai = 0; ai < 2; ++ai)
#pragma unroll
            for (int m = 0; m < 4; ++m) { const int row = row0 + ai * HALF + m * 16;
#pragma unroll
                for (int bj = 0; bj < 2; ++bj)
#pragma unroll
                    for (int n = 0; n < 2; ++n) { const int col = col0 + bj * HALF + n * 16; const f32x4 v = acc[ai][bj][m][n];
                        if (col < 1024) { *(f32x4*)(outK + ((size_t)u.z * 512 + row) * 1024 + col) = v;
                            u32x2 w; w.x = pk2(v[0], v[1]); w.y = pk2(v[2], v[3]); *(u32x2*)(kb + ((size_t)u.z * 512 + row) * 1024 + col) = w; }
                        else { const int c = col - 1024; *(f32x4*)(outV + ((size_t)u.z * 512 + row) * 1024 + c) = v;
                            const int b = row >> 8, mm = row & 255, h = c >> 8, d = c & 255; bf16_t* p = vt + ((((size_t)u.z * 2 + b) * 4 + h) * 256 + d) * 256 + mm;
                            p[0] = f2bf(v[0]); p[256] = f2bf(v[1]); p[512] = f2bf(v[2]); p[768] = f2bf(v[3]); } } }
    }
};
struct EpiMerge {
    static constexpr bool PERM = false;
    float* MG; bf16_t* MGB; const bf16_t* U; const float* gate_b;
    __device__ __forceinline__ void operator()(const f32x4 (&acc)[2][2][4][2], const Unit& u, int wr, int wc, int fr, int fq) const {
        const int row0 = u.pm * BM + wr * 64 + fr, col0 = u.pn * BM + wc * 32 + 4 * fq;
#pragma unroll
        for (int ai = 0; ai < 2; ++ai)
#pragma unroll
            for (int m = 0; m < 4; ++m) { const int row = row0 + ai * HALF + m * 16;
#pragma unroll
                for (int bj = 0; bj < 2; ++bj)
#pragma unroll
                    for (int n = 0; n < 2; ++n) { const int col = col0 + bj * HALF + n * 16; const f32x4 v = acc[ai][bj][m][n];
                        const u32x2 gp = *(const u32x2*)(U + (size_t)row * NINP + U_GP + u.z * DM + col); const f32x4 gb = *(const f32x4*)(gate_b + u.z * DM + col);
                        f32x4 gt; gt[0] = sigmoidf_(__uint_as_float(gp.x << 16) + gb[0]); gt[1] = sigmoidf_(__uint_as_float(gp.x & 0xffff0000u) + gb[1]);
                        gt[2] = sigmoidf_(__uint_as_float(gp.y << 16) + gb[2]); gt[3] = sigmoidf_(__uint_as_float(gp.y & 0xffff0000u) + gb[3]);
                        float* mp = MG + (size_t)row * DM + col; f32x4 r = gt * v;
                        if (u.z > 0) r += *(const f32x4*)mp;
                        if (u.z < 3) *(f32x4*)mp = r;
                        else { u32x2 w; w.x = pk2(r[0], r[1]); w.y = pk2(r[2], r[3]); *(u32x2*)(MGB + (size_t)row * DM + col) = w; } } }
    }
};
struct EpiRes {
    static constexpr bool PERM = false;
    const float* R; float* Y;
    __device__ __forceinline__ void operator()(const f32x4 (&acc)[2][2][4][2], const Unit& u, int wr, int wc, int fr, int fq) const {
        const int row0 = u.pm * BM + wr * 64 + fr, col0 = u.pn * BM + wc * 32 + 4 * fq;
#pragma unroll
        for (int ai = 0; ai < 2; ++ai)
#pragma unroll
            for (int m = 0; m < 4; ++m) { const size_t ro = (size_t)(row0 + ai * HALF + m * 16) * DM + col0;
#pragma unroll
                for (int bj = 0; bj < 2; ++bj)
#pragma unroll
                    for (int n = 0; n < 2; ++n) { const size_t o = ro + bj * HALF + n * 16; *(f32x4*)(Y + o) = *(const f32x4*)(R + o) * ALPHA + acc[ai][bj][m][n]; } }
    }
};
struct EpiSwiGLU {
    static constexpr bool PERM = true;
    bf16_t* O;
    __device__ __forceinline__ void operator()(const f32x4 (&acc)[2][2][4][2], const Unit& u, int wr, int wc, int fr, int fq) const {
        const int row0 = u.pm * BM + wr * 64 + fr, col0 = u.pn * HALF + wc * 32 + 8 * fq;
#pragma unroll
        for (int ai = 0; ai < 2; ++ai)
#pragma unroll
            for (int m = 0; m < 4; ++m) { bf16_t* rowp = O + (size_t)(row0 + ai * HALF + m * 16) * DFF + col0;
                float r[8];
#pragma unroll
                for (int n = 0; n < 2; ++n)
#pragma unroll
                    for (int j = 0; j < 4; ++j) { const float gg = acc[ai][0][m][n][j], uu = acc[ai][1][m][n][j]; r[n * 4 + j] = gg * sigmoidf_(gg) * uu; }
                u32x4 w; w.x = pk2(r[0], r[1]); w.y = pk2(r[2], r[3]); w.z = pk2(r[4], r[5]); w.w = pk2(r[6], r[7]);
                *(u32x4*)rowp = w; }
    }
};
struct EpiScore {
    static constexpr bool PERM = false;
    float* SC;
    __device__ __forceinline__ void operator()(const f32x4 (&acc)[2][2][4][2], const Unit& u, int wr, int wc, int fr, int fq) const {
        const int row0 = u.pm * BM + wr * 64 + fr, col0 = wc * 32 + 4 * fq; float* base = SC + (size_t)u.z * 4096 * 256;
#pragma unroll
        for (int ai = 0; ai < 2; ++ai)
#pragma unroll
            for (int m = 0; m < 4; ++m) { float* rowp = base + (size_t)(row0 + ai * HALF + m * 16) * 256 + col0;
#pragma unroll
                for (int bj = 0; bj < 2; ++bj)
#pragma unroll
                    for (int n = 0; n < 2; ++n) *(f32x4*)(rowp + bj * HALF + n * 16) = acc[ai][bj][m][n] * 0.0625f; }
    }
};
struct EpiPV {
    static constexpr bool PERM = true;
    bf16_t* O;
    __device__ __forceinline__ void operator()(const f32x4 (&acc)[2][2][4][2], const Unit& u, int wr, int wc, int fr, int fq) const {
        const int b = u.z >> 2, h = u.z & 3; const int row0 = b * PS + u.pm * BM + wr * 64 + fr, col0 = h * 256 + wc * 32 + 8 * fq;
#pragma unroll
        for (int ai = 0; ai < 2; ++ai)
#pragma unroll
            for (int m = 0; m < 4; ++m) { bf16_t* rowp = O + (size_t)(row0 + ai * HALF + m * 16) * BW + col0;
#pragma unroll
                for (int bj = 0; bj < 2; ++bj) { const f32x4 v0 = acc[ai][bj][m][0], v1 = acc[ai][bj][m][1];
                    u32x4 w; w.x = pk2(v0[0], v0[1]); w.y = pk2(v0[2], v0[3]); w.z = pk2(v1[0], v1[1]); w.w = pk2(v1[2], v1[3]);
                    *(u32x4*)(rowp + bj * HALF) = w; } }
    }
};
}


#define XB_TMO      128
#define XB_XCNT(j)  (256  + 64 * (j))
#define XB_XSUB(j)  (1280 + 64 * (j))
#define XB_XGEN(j)  (2304 + 64 * (j))
#define XB_TOP      3328
#define XB_TOPGEN   3392
#define XCD_BAR_WORDS 3456
#define XB_SPIN_CAP (1u << 18)
__device__ __forceinline__ unsigned xb_ld(unsigned* p)              { return __hip_atomic_load(p, __ATOMIC_RELAXED, __HIP_MEMORY_SCOPE_AGENT); }
__device__ __forceinline__ unsigned xb_add(unsigned* p, unsigned v) { return __hip_atomic_fetch_add(p, v, __ATOMIC_RELAXED, __HIP_MEMORY_SCOPE_AGENT); }
__device__ __forceinline__ unsigned xb_xcc_id() { return (unsigned)__builtin_amdgcn_s_getreg((3 << 11) | 20) & 0xFu; }
#define XB_SPIN(cond, bar) do { unsigned _sp = 0; while (cond) { __builtin_amdgcn_s_sleep(1); \
    if ((++_sp & 255u) == 0u) { if (xb_ld(&(bar)[XB_TMO])) break; if (_sp > XB_SPIN_CAP) { atomicAdd(&(bar)[XB_TMO], 1u); break; } } } } while (0)
struct XcdBarrier { unsigned* bar; unsigned x; volatile LAS unsigned* st; };
__device__ __forceinline__ XcdBarrier xcd_barrier_post(unsigned* bar, volatile LAS unsigned* st) {
    XcdBarrier b; b.bar = bar; b.x = xb_xcc_id(); b.st = st;
    if (threadIdx.x == 0) (void)xb_add(&bar[XB_XCNT(b.x)], 1u);
    return b;
}
__device__ __forceinline__ void xcd_barrier_complete(unsigned* bar, unsigned x, unsigned& nloc, unsigned& nx) {
    const unsigned G = gridDim.x * gridDim.y * gridDim.z;
    unsigned sum, cnt, mine, sp = 0u;
    for (;;) {
        sum = 0u; cnt = 0u; mine = 0u;
#pragma unroll
        for (unsigned j = 0; j < 16; ++j) { const unsigned c = xb_ld(&bar[XB_XCNT(j)]); sum += c; cnt += (c > 0u) ? 1u : 0u; mine = (j == x) ? c : mine; }
        if (sum == G) break;
        __builtin_amdgcn_s_sleep(1);
        if ((++sp & 255u) == 0u) { if (xb_ld(&bar[XB_TMO])) break; if (sp > XB_SPIN_CAP) { atomicAdd(&bar[XB_TMO], 1u); break; } }
    }
    nloc = mine > 0u ? mine : 1u; nx = cnt > 0u ? cnt : 1u;
}
__device__ __forceinline__ void xcd_barrier(const XcdBarrier& b) {
    asm volatile("s_waitcnt vmcnt(0)" ::: "memory");
    __syncthreads();
    if (threadIdx.x == 0) {
        unsigned* bar = b.bar;
        __builtin_amdgcn_s_waitcnt(0);
        unsigned nloc = b.st[0], nx = b.st[1];
        if (nloc == 0u) { xcd_barrier_complete(bar, b.x, nloc, nx); b.st[0] = nloc; b.st[1] = nx; }
        const unsigned old = xb_add(&bar[XB_XSUB(b.x)], 1u);
        const unsigned gen = old / nloc;
        if (old + 1u == (gen + 1u) * nloc) {
            __builtin_amdgcn_fence(__ATOMIC_RELEASE, "agent");
            asm volatile("s_waitcnt vmcnt(0)" ::: "memory");
            const unsigned og = xb_add(&bar[XB_TOP], 1u);
            const unsigned tg = og / nx;
            if (og + 1u == (tg + 1u) * nx) xb_add(&bar[XB_TOPGEN], 1u);
            else XB_SPIN(xb_ld(&bar[XB_TOPGEN]) == tg, bar);
            __builtin_amdgcn_fence(__ATOMIC_ACQUIRE, "agent");
            xb_add(&bar[XB_XGEN(b.x)], 1u);
            asm volatile("s_waitcnt vmcnt(0)" ::: "memory");
        } else {
            XB_SPIN(xb_ld(&bar[XB_XGEN(b.x)]) == gen, bar);
            __builtin_amdgcn_fence(__ATOMIC_ACQUIRE, "agent");
            asm volatile("s_waitcnt vmcnt(0)" ::: "memory");
        }
    }
    __syncthreads();
}

struct Ctx { int tid, lane, wave, bid, G; LAS unsigned char* lds; };
__device__ __forceinline__ Ctx fresh(const Ctx& c0) { Ctx c; c.wave = c0.wave; c.bid = c0.bid; c.G = c0.G; c.lds = c0.lds; asm volatile("" : "+s"(c.bid), "+s"(c.G), "+s"(c.wave));
    int lane = (int)__builtin_amdgcn_mbcnt_hi(~0u, __builtin_amdgcn_mbcnt_lo(~0u, 0u)); asm volatile("" : "+v"(lane)); c.lane = lane; c.tid = c.wave * 64 + lane; return c; }

__device__ __forceinline__ int colmap(int mode, int n) {
    if (mode == 1) return n < 3088 ? n : (n < 3328 ? -1 : n - 240);
    if (mode == 2) { const int t = n >> 8, j = n & 255; return j < 128 ? t * 128 + j : DFF + t * 128 + (j - 128); }
    return n;
}
__device__ __forceinline__ void ph_wprep(const Ctx& c, const float* __restrict__ src, bf16_t* __restrict__ dst, int K, int Nsrc, int Ndst, int mode, int nbatch, size_t sbs, size_t dbs) {
    LAS float* tile = (LAS float*)c.lds;
    const int nx = Ndst / 64, ny = K / 64, total = nx * ny * nbatch;
    const int tx = c.tid & 63, ty = c.tid >> 6, r = c.tid >> 3, p = c.tid & 7;
    for (int t = c.bid; t < total; t += c.G) {
        const int bx = t % nx, by = (t / nx) % ny, bz = t / (nx * ny);
        const float* s = src + (size_t)bz * sbs; bf16_t* d = dst + (size_t)bz * dbs;
        const int n0 = bx * 64, k0 = by * 64, cm = colmap(mode, n0 + tx);
        for (int kk = ty; kk < 64; kk += 8) tile[kk * 65 + tx] = cm >= 0 ? s[(size_t)(k0 + kk) * Nsrc + cm] : 0.f;
        __syncthreads();
        { u32x4 w; w.x = pk2(tile[(p * 8 + 0) * 65 + r], tile[(p * 8 + 1) * 65 + r]); w.y = pk2(tile[(p * 8 + 2) * 65 + r], tile[(p * 8 + 3) * 65 + r]);
          w.z = pk2(tile[(p * 8 + 4) * 65 + r], tile[(p * 8 + 5) * 65 + r]); w.w = pk2(tile[(p * 8 + 6) * 65 + r], tile[(p * 8 + 7) * 65 + r]);
          *(u32x4*)(d + (size_t)(n0 + r) * K + k0 + p * 8) = w; }
        __syncthreads();
    }
}
__device__ __forceinline__ void ph_xprep(const Ctx& c, const float* __restrict__ xp, const float* __restrict__ xs, const float* __restrict__ mem, float* __restrict__ HF, bf16_t* __restrict__ HB, bf16_t* __restrict__ MEMB) {
    const size_t nH = (size_t)MPAD * DM / 4, nM = (size_t)512 * DM / 4;
    for (size_t i4 = (size_t)c.bid * 512 + c.tid; i4 < nH + nM; i4 += (size_t)c.G * 512) {
        if (i4 < nH) {
            const size_t e = i4 * 4; f32x4 v = (f32x4){0.f, 0.f, 0.f, 0.f};
            if (e < (size_t)MP * DM) v = *(const f32x4*)(xp + e); else if (e < (size_t)MT * DM) v = *(const f32x4*)(xs + (e - (size_t)MP * DM));
            *(f32x4*)(HF + e) = v; u32x2 w; w.x = pk2(v[0], v[1]); w.y = pk2(v[2], v[3]); *(u32x2*)(HB + e) = w;
        } else {
            const size_t e = (i4 - nH) * 4; const f32x4 v = *(const f32x4*)(mem + e); u32x2 w; w.x = pk2(v[0], v[1]); w.y = pk2(v[2], v[3]); *(u32x2*)(MEMB + e) = w;
        }
    }
}
__device__ __forceinline__ void ph_ln(const Ctx& c, const float* __restrict__ Y, const float* __restrict__ g, const float* __restrict__ b, float* __restrict__ XF, bf16_t* __restrict__ XB, float* __restrict__ OUT, int nrows, int nout) {
    const int lane = c.lane;
    for (int row = c.bid * 8 + c.wave; row < nrows; row += c.G * 8) {
        const float* y = Y + (size_t)row * DM; f32x4 v[8]; float s = 0.f;
#pragma unroll
        for (int j = 0; j < 8; ++j) { v[j] = *(const f32x4*)(y + j * 256 + lane * 4); s += (v[j][0] + v[j][1]) + (v[j][2] + v[j][3]); }
        const float mean = wave_sum(s) * (1.0f / DM); float q = 0.f;
#pragma unroll
        for (int j = 0; j < 8; ++j) { const f32x4 d = v[j] - mean; q += (d[0] * d[0] + d[1] * d[1]) + (d[2] * d[2] + d[3] * d[3]); }
        const float rstd = rsqrtf(wave_sum(q) * (1.0f / DM) + 1e-5f);
#pragma unroll
        for (int j = 0; j < 8; ++j) { const int cc = j * 256 + lane * 4; const f32x4 gg = *(const f32x4*)(g + cc), bb = *(const f32x4*)(b + cc);
            const f32x4 o = (v[j] - mean) * rstd * gg + bb; const size_t off = (size_t)row * DM + cc;
            *(f32x4*)(XF + off) = o; u32x2 w; w.x = pk2(o[0], o[1]); w.y = pk2(o[2], o[3]); *(u32x2*)(XB + off) = w;
            if (OUT != nullptr && row < nout) *(f32x4*)(OUT + off) = o; }
    }
}
__device__ __forceinline__ void ph_softmax256(const Ctx& c, const float* __restrict__ SC, bf16_t* __restrict__ P, int nrows) {
    const int lane = c.lane;
    for (int row = c.bid * 8 + c.wave; row < nrows; row += c.G * 8) {
        const f32x4 v = *(const f32x4*)(SC + (size_t)row * 256 + lane * 4);
        const float mx = wave_max(fmaxf(fmaxf(v[0], v[1]), fmaxf(v[2], v[3])));
        f32x4 e; e[0] = __expf(v[0] - mx); e[1] = __expf(v[1] - mx); e[2] = __expf(v[2] - mx); e[3] = __expf(v[3] - mx);
        const float inv = 1.0f / wave_sum((e[0] + e[1]) + (e[2] + e[3]));
        u32x2 w; w.x = pk2(e[0] * inv, e[1] * inv); w.y = pk2(e[2] * inv, e[3] * inv); *(u32x2*)(P + (size_t)row * 256 + lane * 4) = w;
    }
}
__device__ __forceinline__ void ph_copy_outs(const Ctx& c, const bf16_t* __restrict__ U, const float* __restrict__ ck, const float* __restrict__ cv, float* __restrict__ out, int layer) {
    constexpr int nA = PB * 128 * 128, nB = SB * 128 * 128, nC = PB * RWC, nD = SB * RWC;
    for (int i = c.bid * 512 + c.tid; i < nA + nB + nC + nD; i += c.G * 512) {
        if (i < nA) { const int b = i / 16384, j = (i >> 7) & 127, cc = i & 127; const size_t ur = (size_t)(b * PS + PS - 128 + j) * NINP;
            out[O_SWKP + (size_t)layer * nA + i] = bf2f(U[ur + U_SK + cc]); out[O_SWVP + (size_t)layer * nA + i] = bf2f(U[ur + U_SV + cc]); continue; }
        int k = i - nA;
        if (k < nB) { const int sq = k / 16384, j = (k >> 7) & 127, cc = k & 127; float kv, vv;
            if (j < 124) { const size_t o = ((size_t)sq * 128 + j + 4) * 128 + cc; kv = ck[o]; vv = cv[o]; }
            else { const size_t ur = (size_t)(MP + sq * SS + j - 124) * NINP; kv = bf2f(U[ur + U_SK + cc]); vv = bf2f(U[ur + U_SV + cc]); }
            out[O_SWKS + (size_t)layer * nB + k] = kv; out[O_SWVS + (size_t)layer * nB + k] = vv; continue; }
        k -= nB;
        if (k < nC) { const int b = k / RWC, cc = k - b * RWC; out[O_RSP + (size_t)layer * nC + k] = bf2f(U[(size_t)(b * PS + PS - 1) * NINP + U_RU + cc]); continue; }
        k -= nC;
        { const int sq = k / RWC, cc = k - sq * RWC; out[O_RSS + (size_t)layer * nD + k] = bf2f(U[(size_t)(MP + sq * SS + SS - 1) * NINP + U_RU + cc]); }
    }
}

__device__ __forceinline__ void seq_info(int sq, int& row0, int& L) { if (sq < PB) { row0 = sq * PS; L = PS; } else { row0 = MP + (sq - PB) * SS; L = SS; } }

__device__ __forceinline__ void ph_gla_naive(const Ctx& c, const bf16_t* __restrict__ U, const float* __restrict__ s0, const float* __restrict__ a_up, const float* __restrict__ a_b,
                                             const float* __restrict__ ng, const float* __restrict__ nb, bf16_t* __restrict__ OB, float* __restrict__ outP, float* __restrict__ outS) {
    LAS float* qs = (LAS float*)c.lds;
    LAS float* ks = qs + 16 * 128; LAS float* as = ks + 16 * 128; LAS float* os = as + 16 * 128;
    const int kh = c.tid >> 8, vt = c.tid & 255, lane = c.lane;
    for (int u = c.bid; u < (PB + SB) * 4; u += c.G) {
        const int sq = u >> 2, h = u & 3;
        int row0, L; seq_info(sq, row0, L);
        float S[64];
        if (sq >= PB) { const float* p = s0 + (((size_t)(sq - PB) * 4 + h) * 128 + kh * 64) * 256 + vt;
#pragma unroll
            for (int kk = 0; kk < 64; ++kk) S[kk] = p[(size_t)kk * 256]; }
        else {
#pragma unroll
            for (int kk = 0; kk < 64; ++kk) S[kk] = 0.f; }
        for (int t0 = 0; t0 < L; t0 += 16) {
            const int nT = (L - t0) < 16 ? (L - t0) : 16;
            for (int idx = c.tid; idx < nT * 128; idx += 512) {
                const int tt = idx >> 7, kk = idx & 127; const bf16_t* ur = U + (size_t)(row0 + t0 + tt) * NINP;
                qs[idx] = bf2f(ur[U_GQ + h * 128 + kk]) * 0.08838834764831845f; ks[idx] = bf2f(ur[U_GK + h * 128 + kk]);
                float x = a_b[h * 128 + kk];
#pragma unroll
                for (int r = 0; r < 16; ++r) x += bf2f(ur[U_GA + r]) * a_up[r * 512 + h * 128 + kk];
                const float ls = (fminf(x, 0.f) - log1pf(__expf(-fabsf(x)))) * (1.0f / 16.0f);
                as[idx] = __expf(ls);
            }
            __syncthreads();
            for (int tt = 0; tt < nT; ++tt) {
                const float v = bf2f(U[(size_t)(row0 + t0 + tt) * NINP + U_GV + h * 256 + vt]); float o = 0.f; const int lb = tt * 128 + kh * 64;
#pragma unroll
                for (int kk = 0; kk < 64; ++kk) { S[kk] = as[lb + kk] * S[kk] + ks[lb + kk] * v; o += qs[lb + kk] * S[kk]; }
                os[(kh * 16 + tt) * 256 + vt] = o;
            }
            __syncthreads();
            for (int tt = c.wave; tt < nT; tt += 8) {
                float x[4]; float s = 0.f;
#pragma unroll
                for (int j = 0; j < 4; ++j) { x[j] = os[tt * 256 + lane + 64 * j] + os[(16 + tt) * 256 + lane + 64 * j]; s += x[j]; }
                const float mean = wave_sum(s) * (1.0f / 256.0f); float q = 0.f;
#pragma unroll
                for (int j = 0; j < 4; ++j) { const float d = x[j] - mean; q += d * d; }
                const float rstd = rsqrtf(wave_sum(q) * (1.0f / 256.0f) + 1e-5f);
                const size_t row = (size_t)(row0 + t0 + tt);
#pragma unroll
                for (int j = 0; j < 4; ++j) { const int cc = h * 256 + lane + 64 * j; const float n = (x[j] - mean) * rstd * ng[cc] + nb[cc];
                    const float gr = bf2f(U[row * NINP + U_GR + cc]); OB[row * BW + cc] = f2bf(n * gr * sigmoidf_(gr)); }
            }
            __syncthreads();
        }
        float* op = (sq < PB ? outP + (((size_t)sq * 4 + h) * 128 + kh * 64) * 256 : outS + (((size_t)(sq - PB) * 4 + h) * 128 + kh * 64) * 256) + vt;
#pragma unroll
        for (int kk = 0; kk < 64; ++kk) op[(size_t)kk * 256] = S[kk];
    }
}

__device__ __forceinline__ void unpack8(const u32x4 w, float (&x)[8]) {
    x[0] = __uint_as_float(w.x << 16); x[1] = __uint_as_float(w.x & 0xffff0000u); x[2] = __uint_as_float(w.y << 16); x[3] = __uint_as_float(w.y & 0xffff0000u);
    x[4] = __uint_as_float(w.z << 16); x[5] = __uint_as_float(w.z & 0xffff0000u); x[6] = __uint_as_float(w.w << 16); x[7] = __uint_as_float(w.w & 0xffff0000u);
}
template <bool ISBF> __device__ __forceinline__ void swa_step(const float (&q)[32], float (&acc)[32], float& m, float& l, const void* kp, const void* vp, float slope, float dist) {
    float s = 0.f;
#pragma unroll
    for (int j = 0; j < 4; ++j) { float x[8];
        if (ISBF) unpack8(*(const u32x4*)((const bf16_t*)kp + j * 8), x);
        else { const f32x4 a = *(const f32x4*)((const float*)kp + j * 8), b = *(const f32x4*)((const float*)kp + j * 8 + 4); x[0] = a[0]; x[1] = a[1]; x[2] = a[2]; x[3] = a[3]; x[4] = b[0]; x[5] = b[1]; x[6] = b[2]; x[7] = b[3]; }
#pragma unroll
        for (int d = 0; d < 8; ++d) s += q[j * 8 + d] * x[d]; }
    s += __shfl_xor(s, 1, 64);
    s = s * 0.125f - slope * dist;
    const float mn = fmaxf(m, s), cc = __expf(m - mn), p = __expf(s - mn);
    l = l * cc + p;
#pragma unroll
    for (int j = 0; j < 4; ++j) { float x[8];
        if (ISBF) unpack8(*(const u32x4*)((const bf16_t*)vp + j * 8), x);
        else { const f32x4 a = *(const f32x4*)((const float*)vp + j * 8), b = *(const f32x4*)((const float*)vp + j * 8 + 4); x[0] = a[0]; x[1] = a[1]; x[2] = a[2]; x[3] = a[3]; x[4] = b[0]; x[5] = b[1]; x[6] = b[2]; x[7] = b[3]; }
#pragma unroll
        for (int d = 0; d < 8; ++d) acc[j * 8 + d] = acc[j * 8 + d] * cc + p * x[d]; }
    m = mn;
}
__device__ __forceinline__ void ph_swa_naive(const Ctx& c, const bf16_t* __restrict__ U, const float* __restrict__ ck, const float* __restrict__ cv, const float* __restrict__ sinks, bf16_t* __restrict__ OB) {
    for (int gid = c.bid * 512 + c.tid; gid < MT * 32; gid += c.G * 512) {
        const int dh = gid & 1, h = (gid >> 1) & 15, row = gid >> 5, kvh = h >> 3, co = kvh * 64 + dh * 32;
        float q[32], acc[32];
#pragma unroll
        for (int j = 0; j < 4; ++j) { float x[8]; unpack8(*(const u32x4*)(U + (size_t)row * NINP + U_SQ + h * 64 + dh * 32 + j * 8), x);
#pragma unroll
            for (int d = 0; d < 8; ++d) { q[j * 8 + d] = x[d]; acc[j * 8 + d] = 0.f; } }
        const float slope = exp2f(-0.5f * (float)(h + 1)); float m = sinks[h], l = 1.0f;
        if (row < MP) {
            const int t = row % PS, base = row - t, lo = t - 128 < 0 ? 0 : t - 128;
            for (int s = lo; s <= t; ++s) { const bf16_t* ur = U + (size_t)(base + s) * NINP;
                swa_step<true>(q, acc, m, l, ur + U_SK + co, ur + U_SV + co, slope, (float)(t - s)); }
        } else {
            const int sq = (row - MP) / SS, i = (row - MP) % SS;
            for (int idx = i; idx <= 128 + i; ++idx) {
                if (idx < 128) { const size_t o = ((size_t)sq * 128 + idx) * 128 + co; swa_step<false>(q, acc, m, l, ck + o, cv + o, slope, (float)(128 + i - idx)); }
                else { const bf16_t* ur = U + (size_t)(MP + sq * SS + idx - 128) * NINP; swa_step<true>(q, acc, m, l, ur + U_SK + co, ur + U_SV + co, slope, (float)(128 + i - idx)); }
            }
        }
        const float inv = 1.0f / l; bf16_t* op = OB + (size_t)row * BW + h * 64 + dh * 32;
#pragma unroll
        for (int j = 0; j < 4; ++j) { u32x4 w; w.x = pk2(acc[j * 8] * inv, acc[j * 8 + 1] * inv); w.y = pk2(acc[j * 8 + 2] * inv, acc[j * 8 + 3] * inv);
            w.z = pk2(acc[j * 8 + 4] * inv, acc[j * 8 + 5] * inv); w.w = pk2(acc[j * 8 + 6] * inv, acc[j * 8 + 7] * inv); *(u32x4*)(op + j * 8) = w; }
    }
}

__device__ __forceinline__ void ph_rwkv_prep(const Ctx& c, const bf16_t* __restrict__ U, const float* __restrict__ shift, const float* __restrict__ mu, const float* __restrict__ w0, const float* __restrict__ w2,
                                             const float* __restrict__ a0, const float* __restrict__ a2, const float* __restrict__ g2, const float* __restrict__ k_k, const float* __restrict__ k_a,
                                             const float* __restrict__ r_k, float* __restrict__ RW) {
    LAS float* xm = (LAS float*)c.lds; LAS float* tw = xm + RWC; LAS float* ad = tw + 64; LAS float* sg = ad + 64;
    const int tid = c.tid;
    float* R = RW; float* WD = RW + (size_t)MPAD * BW; float* K2 = WD + (size_t)MPAD * BW; float* V = K2 + (size_t)MPAD * BW; float* KK = V + (size_t)MPAD * BW;
    float* BV = KK + (size_t)MPAD * BW; float* G = BV + (size_t)MPAD * BW; float* BON = G + (size_t)MPAD * BW;
    for (int row = c.bid; row < MT; row += c.G) {
        const bf16_t* ur = U + (size_t)row * NINP + U_RU; const bf16_t* pr = ur - NINP; const float* ps = nullptr; bool first;
        if (row < MP) first = (row % PS) == 0; else { first = ((row - MP) % SS) == 0; ps = shift + (size_t)((row - MP) / SS) * RWC; }
        for (int cc = tid; cc < RWC; cc += 512) { const float x = bf2f(ur[cc]); const float s = first ? (ps ? ps[cc] : 0.f) : bf2f(pr[cc]); xm[cc] = x + (s - x) * mu[cc]; }
        __syncthreads();
        if (tid < 64) { tw[tid] = tanhf(xm[3072 + tid]); ad[tid] = xm[3136 + tid]; }
        if (tid >= 128 && tid < 256) sg[tid - 128] = sigmoidf_(xm[3200 + tid - 128]);
        __syncthreads();
        for (int qd = 0; qd < 2; ++qd) {
            const int cc = qd * 512 + tid; float accw = w0[cc], acca = a0[cc], accg = 0.f;
#pragma unroll 4
            for (int j = 0; j < 64; ++j) { accw += tw[j] * w2[j * BW + cc]; acca += ad[j] * a2[j * BW + cc]; }
#pragma unroll 4
            for (int j = 0; j < 128; ++j) accg += sg[j] * g2[j * BW + cc];
            const float lw = -softplusf_(-accw) - 0.5f, decay = __expf(-__expf(lw)), a = sigmoidf_(acca);
            const float r = xm[cc], k = xm[1024 + cc], v = xm[2048 + cc];
            const float kkr = k * k_k[cc]; const float ss = wave_sum(kkr * kkr); const float kk = kkr / fmaxf(sqrtf(ss), 1e-12f);
            const float k2 = k * (1.0f + (a - 1.0f) * k_a[cc]); const float rk = wave_sum(r * k2 * r_k[cc]);
            const size_t o = (size_t)row * BW + cc;
            R[o] = r; WD[o] = decay; K2[o] = k2; V[o] = v; KK[o] = kk; BV[o] = kk * a; G[o] = accg; BON[o] = rk * v;
        }
        __syncthreads();
    }
}
__device__ __forceinline__ void ph_rwkv_scan_naive(const Ctx& c, const float* __restrict__ RW, const float* __restrict__ s0, const float* __restrict__ lng, const float* __restrict__ lnb, bf16_t* __restrict__ OB,
                                                   float* __restrict__ outP, float* __restrict__ outS) {
    const float* R = RW; const float* WD = RW + (size_t)MPAD * BW; const float* K2 = WD + (size_t)MPAD * BW; const float* V = K2 + (size_t)MPAD * BW; const float* KK = V + (size_t)MPAD * BW;
    const float* BV = KK + (size_t)MPAD * BW; const float* G = BV + (size_t)MPAD * BW; const float* BON = G + (size_t)MPAD * BW;
    const int lane = c.lane;
    for (int it = 0;; ++it) {
        const int u = (it * 8 + c.wave) * c.G + c.bid;
        if (u >= (PB + SB) * 16) break;
        const int sq = u >> 4, h = u & 15;
        int row0, L; seq_info(sq, row0, L);
        float S[64];
        if (sq >= PB) { const float* p = s0 + (((size_t)(sq - PB) * 16 + h) * 64 + lane) * 64;
#pragma unroll
            for (int j = 0; j < 64; ++j) S[j] = p[j]; }
        else {
#pragma unroll
            for (int j = 0; j < 64; ++j) S[j] = 0.f; }
        const float lg = lng[h * 64 + lane], lb = lnb[h * 64 + lane];
        for (int t = 0; t < L; ++t) {
            const size_t base = (size_t)(row0 + t) * BW + h * 64; const float v = V[base + lane];
            float d = 0.f;
#pragma unroll
            for (int j = 0; j < 64; ++j) d += S[j] * KK[base + j];
            float y = 0.f;
#pragma unroll
            for (int j = 0; j < 64; ++j) { S[j] = S[j] * WD[base + j] - d * BV[base + j] + v * K2[base + j]; y += S[j] * R[base + j]; }
            const float mean = wave_sum(y) * (1.0f / 64.0f), dy = y - mean, var = wave_sum(dy * dy) * (1.0f / 64.0f);
            const float yn = dy * rsqrtf(var + 64e-5f) * lg + lb;
            OB[base + lane] = f2bf((yn + BON[base + lane]) * G[base + lane]);
        }
        float* op = (sq < PB ? outP + (((size_t)sq * 16 + h) * 64 + lane) * 64 : outS + (((size_t)(sq - PB) * 16 + h) * 64 + lane) * 64);
#pragma unroll
        for (int j = 0; j < 64; ++j) op[j] = S[j];
    }
}
__device__ __forceinline__ void ph_memattn_sample(const Ctx& c, const bf16_t* __restrict__ U, const float* __restrict__ mk, const float* __restrict__ mv, bf16_t* __restrict__ OB) {
    LAS float* qs = (LAS float*)c.lds; LAS float* ps = qs + 2 * 4 * 256;
    const int hh = c.tid >> 8, vt = c.tid & 255, lane = c.lane;
    for (int u = c.bid; u < SB * 2; u += c.G) {
        const int sq = u >> 1, h = (u & 1) * 2 + hh;
#pragma unroll
        for (int t = 0; t < 4; ++t) qs[(hh * 4 + t) * 256 + vt] = bf2f(U[(size_t)(MP + sq * SS + t) * NINP + U_MQ + h * 256 + vt]) * 0.0625f;
        __syncthreads();
        { const float* kr = mk + (((size_t)sq * MEMT + vt) * 4 + h) * 256; float s[4] = {0.f, 0.f, 0.f, 0.f};
            for (int d = 0; d < 256; d += 4) { const f32x4 kv = *(const f32x4*)(kr + d);
#pragma unroll
                for (int t = 0; t < 4; ++t) { const LAS float* qq = qs + (hh * 4 + t) * 256 + d; s[t] += kv[0] * qq[0] + kv[1] * qq[1] + kv[2] * qq[2] + kv[3] * qq[3]; } }
#pragma unroll
            for (int t = 0; t < 4; ++t) ps[(hh * 4 + t) * 256 + vt] = s[t]; }
        __syncthreads();
        { LAS float* pr = ps + c.wave * 256; float x[4]; float mx = -3.0e38f;
#pragma unroll
            for (int j = 0; j < 4; ++j) { x[j] = pr[lane + 64 * j]; mx = fmaxf(mx, x[j]); }
            mx = wave_max(mx); float s = 0.f;
#pragma unroll
            for (int j = 0; j < 4; ++j) { x[j] = __expf(x[j] - mx); s += x[j]; }
            const float inv = 1.0f / wave_sum(s);
#pragma unroll
            for (int j = 0; j < 4; ++j) pr[lane + 64 * j] = x[j] * inv; }
        __syncthreads();
        { float o[4] = {0.f, 0.f, 0.f, 0.f}; const float* vr = mv + ((size_t)sq * MEMT * 4 + h) * 256 + vt;
            for (int m = 0; m < MEMT; ++m) { const float vv = vr[(size_t)m * 1024];
#pragma unroll
                for (int t = 0; t < 4; ++t) o[t] += ps[(hh * 4 + t) * 256 + m] * vv; }
#pragma unroll
            for (int t = 0; t < 4; ++t) OB[(size_t)(MP + sq * SS + t) * BW + h * 256 + vt] = f2bf(o[t]); }
        __syncthreads();
    }
}

constexpr int LDS_BAR_OFF = pg8::STAGE_BYTES;
constexpr int LDS_BYTES = pg8::STAGE_BYTES + 64;
struct Args { const float* in[37]; float* out; unsigned char* ws; };

typedef pg8::Gemm<DM, DM, DM, 2, 8, NL, 1, false, 0, 0, (long)DM * DM, 0> GemmMem;
typedef pg8::Gemm<DM, DM, DM, MPAD / 256, NINP / 256> GemmIn;
typedef pg8::Gemm<NINP, 1024, 256, PS / 256, 1, 8, 4, false, (long)PS * NINP, 256, 256 * 1024, 256> GemmScore;
typedef pg8::Gemm<256, 256, 256, PS / 256, 1, 8, 4, false, (long)4 * 4096 * 256, (long)4096 * 256, 4 * 65536, 65536> GemmPV;
typedef pg8::Gemm<BW, BW, BW, MPAD / 256, DM / 256, 4, 1, true, (long)MPAD * BW, 0, (long)DM * BW, 0> GemmBranch;
typedef pg8::Gemm<DM, DM, DM, MPAD / 256, DM / 256> GemmOut;
typedef pg8::Gemm<DM, DM, DM, MPAD / 256, 2 * DFF / 256> GemmGU;
typedef pg8::Gemm<DFF, DFF, DFF, MPAD / 256, DM / 256> GemmDown;
template <class GT> __device__ __forceinline__ GT mk_gemm(const Ctx& c, const bf16_t* A, const bf16_t* B) { GT g; g.A = A; g.B = B; g.G = c.G; g.c = c.bid; return g; }

template <int OFF> __device__ __forceinline__ unsigned long long karg_u64(unsigned long long kargs) {
    unsigned long long p; asm volatile("s_load_dwordx2 %0, %1, %2\n\ts_waitcnt lgkmcnt(0)" : "=s"(p) : "s"(kargs), "n"(OFF) : "memory"); return p;
}
#define INP(k) ((const float*)karg_u64<(k) * 8>(kargs))
#define OUTP() ((float*)karg_u64<37 * 8>(kargs))
#define WSP() ((unsigned char*)karg_u64<38 * 8>(kargs))

__global__ void __launch_bounds__(512, 2) mega_fwd(Args a_unused) {
    extern __shared__ __attribute__((aligned(16))) unsigned char lds_raw[];
    const unsigned long long kargs = (unsigned long long)__builtin_amdgcn_kernarg_segment_ptr();
    Ctx c0; c0.tid = threadIdx.x; c0.lane = c0.tid & 63; c0.wave = __builtin_amdgcn_readfirstlane(c0.tid >> 6); c0.bid = blockIdx.x; c0.G = gridDim.x; c0.lds = (LAS unsigned char*)lds_raw;
    if (c0.tid < 4) ((LAS unsigned*)(c0.lds + LDS_BAR_OFF))[c0.tid] = 0u;
    __syncthreads();
    const XcdBarrier bar = xcd_barrier_post((unsigned*)(WSP() + WS_CTL), (volatile LAS unsigned*)(c0.lds + LDS_BAR_OFF));

    { const Ctx c = fresh(c0); unsigned char* ws = WSP();
      ph_wprep(c, INP(10), (bf16_t*)(ws + WS_WIN), DM, NIN, NINP, 1, NL, (size_t)DM * NIN, (size_t)NINP * DM);
      ph_wprep(c, INP(28), (bf16_t*)(ws + WS_WMEM), DM, DM, DM, 0, NL, (size_t)DM * DM, (size_t)DM * DM);
      ph_wprep(c, INP(29), (bf16_t*)(ws + WS_WBR), BW, DM, DM, 0, NL * 4, (size_t)BW * DM, (size_t)DM * BW);
      ph_wprep(c, INP(30), (bf16_t*)(ws + WS_WOUT), DM, DM, DM, 0, NL, (size_t)DM * DM, (size_t)DM * DM);
      ph_wprep(c, INP(33), (bf16_t*)(ws + WS_WGU), DM, 2 * DFF, 2 * DFF, 2, NL, (size_t)DM * 2 * DFF, (size_t)2 * DFF * DM);
      ph_wprep(c, INP(34), (bf16_t*)(ws + WS_WDN), DFF, DM, DM, 0, NL, (size_t)DFF * DM, (size_t)DM * DFF);
      ph_xprep(c, INP(0), INP(1), INP(2), (float*)(ws + WS_HF), (bf16_t*)(ws + WS_HB), (bf16_t*)(ws + WS_MEMB)); }
    xcd_barrier(bar);
    { const Ctx c = fresh(c0); unsigned char* ws = WSP(); float* out = OUTP();
      GemmMem g = mk_gemm<GemmMem>(c, (const bf16_t*)(ws + WS_MEMB), (const bf16_t*)(ws + WS_WMEM));
      pg8::EpiMem E; E.outK = out + O_MKP; E.outV = out + O_MVP; E.kb = (bf16_t*)(ws + WS_MKB); E.vt = (bf16_t*)(ws + WS_MVT); pg8::gemm_phase<GemmMem, pg8::EpiMem, true, true>(c.lds, c.tid, g, E); }

    for (int l = 0; l < NL; ++l) {
        { const Ctx c = fresh(c0); unsigned char* ws = WSP();
          GemmIn g = mk_gemm<GemmIn>(c, (const bf16_t*)(ws + WS_HB), (const bf16_t*)(ws + WS_WIN) + (size_t)l * NINP * DM);
          pg8::EpiBf16 E; E.O = (bf16_t*)(ws + WS_U); E.zs = 0; E.ldc = NINP; E.pad = 0; pg8::gemm_phase<GemmIn, pg8::EpiBf16, true, true>(c.lds, c.tid, g, E); }
        xcd_barrier(bar);
        { const Ctx c = fresh(c0); unsigned char* ws = WSP(); float* out = OUTP(); const bf16_t* U = (const bf16_t*)(ws + WS_U); bf16_t* BR = (bf16_t*)(ws + WS_BR);
          ph_gla_naive(c, U, INP(7) + (size_t)l * SB * 4 * 32768, INP(12) + (size_t)l * 16 * 512, INP(13) + (size_t)l * 512, INP(14) + (size_t)l * BW, INP(15) + (size_t)l * BW, BR,
                       out + O_GLAP + (size_t)l * PB * 4 * 32768, out + O_GLAS + (size_t)l * SB * 4 * 32768); }
        { const Ctx c = fresh(c0); unsigned char* ws = WSP();
          ph_rwkv_prep(c, (const bf16_t*)(ws + WS_U), INP(9) + (size_t)l * SB * RWC, INP(17) + (size_t)l * RWC, INP(18) + (size_t)l * BW, INP(19) + (size_t)l * 64 * BW, INP(20) + (size_t)l * BW, INP(21) + (size_t)l * 64 * BW,
                       INP(22) + (size_t)l * 128 * BW, INP(23) + (size_t)l * BW, INP(24) + (size_t)l * BW, INP(25) + (size_t)l * BW, (float*)(ws + WS_RW)); }
        { const Ctx c = fresh(c0); unsigned char* ws = WSP();
          ph_swa_naive(c, (const bf16_t*)(ws + WS_U), INP(3) + (size_t)l * SB * 16384, INP(4) + (size_t)l * SB * 16384, INP(16) + (size_t)l * 16, (bf16_t*)(ws + WS_BR) + (size_t)MPAD * BW); }
        { const Ctx c = fresh(c0); unsigned char* ws = WSP();
          ph_copy_outs(c, (const bf16_t*)(ws + WS_U), INP(3) + (size_t)l * SB * 16384, INP(4) + (size_t)l * SB * 16384, OUTP(), l); }
        { const Ctx c = fresh(c0); unsigned char* ws = WSP();
          ph_memattn_sample(c, (const bf16_t*)(ws + WS_U), INP(5) + (size_t)l * SB * MEMT * 1024, INP(6) + (size_t)l * SB * MEMT * 1024, (bf16_t*)(ws + WS_BR) + (size_t)3 * MPAD * BW); }
        { const Ctx c = fresh(c0); unsigned char* ws = WSP();
          GemmScore g = mk_gemm<GemmScore>(c, (const bf16_t*)(ws + WS_U) + U_MQ, (const bf16_t*)(ws + WS_MKB) + (size_t)l * 512 * 1024);
          pg8::EpiScore E; E.SC = (float*)(ws + WS_SC); pg8::gemm_phase<GemmScore, pg8::EpiScore, true, true>(c.lds, c.tid, g, E); }
        xcd_barrier(bar);
        { const Ctx c = fresh(c0); unsigned char* ws = WSP(); float* out = OUTP();
          ph_rwkv_scan_naive(c, (const float*)(ws + WS_RW), INP(8) + (size_t)l * SB * 16 * 4096, INP(26) + (size_t)l * BW, INP(27) + (size_t)l * BW, (bf16_t*)(ws + WS_BR) + (size_t)2 * MPAD * BW,
                             out + O_RWP + (size_t)l * PB * 16 * 4096, out + O_RWS + (size_t)l * SB * 16 * 4096); }
        { const Ctx c = fresh(c0); unsigned char* ws = WSP(); ph_softmax256(c, (const float*)(ws + WS_SC), (bf16_t*)(ws + WS_PB), 8 * 4096); }
        xcd_barrier(bar);
        { const Ctx c = fresh(c0); unsigned char* ws = WSP();
          GemmPV g = mk_gemm<GemmPV>(c, (const bf16_t*)(ws + WS_PB), (const bf16_t*)(ws + WS_MVT) + (size_t)l * 8 * 65536);
          pg8::EpiPV E; E.O = (bf16_t*)(ws + WS_BR) + (size_t)3 * MPAD * BW; pg8::gemm_phase<GemmPV, pg8::EpiPV, true, true>(c.lds, c.tid, g, E); }
        xcd_barrier(bar);
        { const Ctx c = fresh(c0); unsigned char* ws = WSP();
          GemmBranch g = mk_gemm<GemmBranch>(c, (const bf16_t*)(ws + WS_BR), (const bf16_t*)(ws + WS_WBR) + (size_t)l * 4 * DM * BW);
          pg8::EpiMerge E; E.MG = (float*)(ws + WS_MG); E.MGB = (bf16_t*)(ws + WS_MGB); E.U = (const bf16_t*)(ws + WS_U); E.gate_b = INP(11) + (size_t)l * 4 * DM; pg8::gemm_phase<GemmBranch, pg8::EpiMerge, true, true>(c.lds, c.tid, g, E); }
        xcd_barrier(bar);
        { const Ctx c = fresh(c0); unsigned char* ws = WSP();
          GemmOut g = mk_gemm<GemmOut>(c, (const bf16_t*)(ws + WS_MGB), (const bf16_t*)(ws + WS_WOUT) + (size_t)l * DM * DM);
          pg8::EpiRes E; E.R = (const float*)(ws + WS_HF); E.Y = (float*)(ws + WS_Y); pg8::gemm_phase<GemmOut, pg8::EpiRes, true, true>(c.lds, c.tid, g, E); }
        xcd_barrier(bar);
        { const Ctx c = fresh(c0); unsigned char* ws = WSP(); ph_ln(c, (const float*)(ws + WS_Y), INP(31) + (size_t)l * DM, INP(32) + (size_t)l * DM, (float*)(ws + WS_X1F), (bf16_t*)(ws + WS_X1B), nullptr, MPAD, 0); }
        xcd_barrier(bar);
        { const Ctx c = fresh(c0); unsigned char* ws = WSP();
          GemmGU g = mk_gemm<GemmGU>(c, (const bf16_t*)(ws + WS_X1B), (const bf16_t*)(ws + WS_WGU) + (size_t)l * 2 * DFF * DM);
          pg8::EpiSwiGLU E; E.O = (bf16_t*)(ws + WS_ACT); pg8::gemm_phase<GemmGU, pg8::EpiSwiGLU, true, true>(c.lds, c.tid, g, E); }
        xcd_barrier(bar);
        { const Ctx c = fresh(c0); unsigned char* ws = WSP();
          GemmDown g = mk_gemm<GemmDown>(c, (const bf16_t*)(ws + WS_ACT), (const bf16_t*)(ws + WS_WDN) + (size_t)l * DM * DFF);
          pg8::EpiRes E; E.R = (const float*)(ws + WS_X1F); E.Y = (float*)(ws + WS_Y); pg8::gemm_phase<GemmDown, pg8::EpiRes, true, true>(c.lds, c.tid, g, E); }
        xcd_barrier(bar);
        { const Ctx c = fresh(c0); unsigned char* ws = WSP(); float* out = OUTP(); ph_ln(c, (const float*)(ws + WS_Y), INP(35) + (size_t)l * DM, INP(36) + (size_t)l * DM, (float*)(ws + WS_HF), (bf16_t*)(ws + WS_HB), l == NL - 1 ? out : nullptr, MPAD, MT); }
        xcd_barrier(bar);
    }
}

extern "C" void kernel_launch(void* const* d_in, const int* in_sizes, int n_in, void* d_out, int out_size, void* d_ws, size_t ws_size, hipStream_t stream) {
    static int grid = 0;
    if (grid == 0) {
        if (n_in != 37 || (size_t)out_size != O_END || ws_size < WS_END) { fprintf(stderr, "kernel_launch: unexpected sizes (n_in %d out %d ws %zu need %zu)\n", n_in, out_size, ws_size, (size_t)WS_END); grid = -1; return; }
        int dev = 0, cus = 0;
        if (hipGetDevice(&dev) != hipSuccess || hipDeviceGetAttribute(&cus, hipDeviceAttributeMultiprocessorCount, dev) != hipSuccess) { grid = -1; return; }
        if (hipFuncSetAttribute((const void*)mega_fwd, hipFuncAttributeMaxDynamicSharedMemorySize, LDS_BYTES) != hipSuccess) { fprintf(stderr, "kernel_launch: hipFuncSetAttribute failed\n"); grid = -1; return; }
        int per_cu = 0;
        if (hipOccupancyMaxActiveBlocksPerMultiprocessor(&per_cu, (const void*)mega_fwd, 512, LDS_BYTES) != hipSuccess || per_cu < 1) { fprintf(stderr, "kernel_launch: occupancy query says %d\n", per_cu); }
        (void)hipGetLastError();
        grid = cus;
    }
    if (grid < 0) return;
    (void)hipMemsetAsync((unsigned char*)d_ws + WS_CTL, 0, XCD_BAR_WORDS * sizeof(unsigned), stream);
    Args a; memset(&a, 0, sizeof a);
    for (int i = 0; i < 37; ++i) a.in[i] = (const float*)d_in[i];
    a.out = (float*)d_out; a.ws = (unsigned char*)d_ws;
    hipLaunchKernelGGL(mega_fwd, dim3(grid), dim3(512), LDS_BYTES, stream, a);
}
```

```cpp
#include <hip/hip_runtime.h>
#include <cstdio>
#include <cstdint>
#include <cstring>

#define LAS __attribute__((address_space(3)))
typedef unsigned short bf16_t;
typedef short bf16x8 __attribute__((ext_vector_type(8)));
typedef float f32x4 __attribute__((ext_vector_type(4)));
typedef float f32x2 __attribute__((ext_vector_type(2)));
typedef unsigned u32x4 __attribute__((ext_vector_type(4)));
typedef unsigned u32x2 __attribute__((ext_vector_type(2)));

constexpr int DM = 2048, NL = 4;
constexpr int PB = 2, PS = 4096, MP = PB * PS;
constexpr int SB = 32, SS = 4, MS = SB * SS;
constexpr int MT = MP + MS;
constexpr int MPAD = 8448;
constexpr int NIN = 16912, NINP = 17152;
constexpr int U_GQ = 0, U_GK = 512, U_GV = 1024, U_GR = 2048, U_GA = 3072, U_SQ = 3328, U_SK = 4352, U_SV = 4480, U_RU = 4608, U_MQ = 7936, U_GP = 8960;
constexpr int RWC = 3328, BW = 1024, DFF = 5632, MEMT = 256;
constexpr float ALPHA = 1.681792830507429f;

constexpr size_t O_YP = 0;
constexpr size_t O_YS = O_YP + (size_t)MP * DM;
constexpr size_t O_SWKP = O_YS + (size_t)MS * DM;
constexpr size_t O_SWVP = O_SWKP + (size_t)NL * PB * 128 * 128;
constexpr size_t O_MKP = O_SWVP + (size_t)NL * PB * 128 * 128;
constexpr size_t O_MVP = O_MKP + (size_t)NL * PB * 256 * 1024;
constexpr size_t O_GLAP = O_MVP + (size_t)NL * PB * 256 * 1024;
constexpr size_t O_RWP = O_GLAP + (size_t)NL * PB * 4 * 128 * 256;
constexpr size_t O_RSP = O_RWP + (size_t)NL * PB * 16 * 64 * 64;
constexpr size_t O_SWKS = O_RSP + (size_t)NL * PB * RWC;
constexpr size_t O_SWVS = O_SWKS + (size_t)NL * SB * 128 * 128;
constexpr size_t O_GLAS = O_SWVS + (size_t)NL * SB * 128 * 128;
constexpr size_t O_RWS = O_GLAS + (size_t)NL * SB * 4 * 128 * 256;
constexpr size_t O_RSS = O_RWS + (size_t)NL * SB * 16 * 64 * 64;
constexpr size_t O_END = O_RSS + (size_t)NL * SB * RWC;
static_assert(O_END == 52881408, "output size");

constexpr size_t al256(size_t x) { return (x + 255) & ~(size_t)255; }
constexpr size_t WS_CTL = 0;
constexpr size_t WS_WIN = 65536;
constexpr size_t WS_WMEM = WS_WIN + (size_t)NL * NINP * DM * 2;
constexpr size_t WS_WBR = WS_WMEM + (size_t)NL * DM * DM * 2;
constexpr size_t WS_WOUT = WS_WBR + (size_t)NL * 4 * DM * BW * 2;
constexpr size_t WS_WGU = WS_WOUT + (size_t)NL * DM * DM * 2;
constexpr size_t WS_WDN = WS_WGU + (size_t)NL * 2 * DFF * DM * 2;
constexpr size_t WS_HF = WS_WDN + (size_t)NL * DM * DFF * 2;
constexpr size_t WS_HB = WS_HF + (size_t)MPAD * DM * 4;
constexpr size_t WS_U = WS_HB + (size_t)MPAD * DM * 2;
constexpr size_t WS_BR = WS_U + (size_t)MPAD * NINP * 2;
constexpr size_t WS_MG = WS_BR + (size_t)4 * MPAD * BW * 2;
constexpr size_t WS_MGB = WS_MG + (size_t)MPAD * DM * 4;
constexpr size_t WS_Y = WS_MGB + (size_t)MPAD * DM * 2;
constexpr size_t WS_X1F = WS_Y + (size_t)MPAD * DM * 4;
constexpr size_t WS_X1B = WS_X1F + (size_t)MPAD * DM * 4;
constexpr size_t WS_ACT = WS_X1B + (size_t)MPAD * DM * 2;
constexpr size_t WS_MEMB = WS_ACT + (size_t)MPAD * DFF * 2;
constexpr size_t WS_MKB = WS_MEMB + (size_t)512 * DM * 2;
constexpr size_t WS_MVT = WS_MKB + (size_t)NL * 512 * 1024 * 2;
constexpr size_t WS_SC = WS_MVT + (size_t)NL * 8 * 256 * 256 * 2;
constexpr size_t WS_PB = WS_SC + (size_t)8 * 4096 * 256 * 4;
constexpr size_t WS_RW = WS_PB + (size_t)8 * 4096 * 256 * 2;
constexpr size_t RW_ARR = (size_t)MPAD * BW * 4;
constexpr int GL_NCH = 512 + 128;
constexpr size_t WS_GLQD = WS_RW + 8 * RW_ARR;
constexpr size_t WS_GLKH = WS_GLQD + (size_t)GL_NCH * 8192 * 2;
constexpr size_t WS_GLE = WS_GLKH + (size_t)GL_NCH * 8192 * 2;
constexpr size_t WS_GLVT = WS_GLE + (size_t)GL_NCH * 4096 * 2;
constexpr size_t WS_GLGC = WS_GLVT + (size_t)GL_NCH * 16384 * 2;
constexpr size_t WS_END = WS_GLGC + (size_t)GL_NCH * 128 * 4;

__device__ __forceinline__ float bf2f(bf16_t b) { return __uint_as_float(((unsigned)b) << 16); }
__device__ __forceinline__ bf16_t f2bf(float f) { unsigned u = __float_as_uint(f); u += 0x7FFFu + ((u >> 16) & 1u); return (bf16_t)(u >> 16); }
__device__ __forceinline__ unsigned pk2(float lo, float hi) { return (unsigned)f2bf(lo) | ((unsigned)f2bf(hi) << 16); }
__device__ __forceinline__ float wave_sum(float v) {
#pragma unroll
    for (int o = 32; o > 0; o >>= 1) v += __shfl_xor(v, o, 64);
    return v;
}
__device__ __forceinline__ float wave_max(float v) {
#pragma unroll
    for (int o = 32; o > 0; o >>= 1) v = fmaxf(v, __shfl_xor(v, o, 64));
    return v;
}
__device__ __forceinline__ float sigmoidf_(float x) { return 1.0f / (1.0f + __expf(-x)); }
__device__ __forceinline__ float softplusf_(float x) { return fmaxf(x, 0.f) + log1pf(__expf(-fabsf(x))); }

namespace pg8 {
constexpr int BM = 256, BK = 64, HALF = 128, HTB = HALF * BK * 2, STAGE_BYTES = 8 * HTB, NXCD = 8, WGM = 8;
__host__ __device__ __forceinline__ int lds_byte(int r, int c) { const int st = (r >> 4) * 2 + (c >> 5), rr = r & 15, cc = c & 31, ob = rr * 64 + cc * 2; return st * 1024 + (ob ^ (((ob >> 9) & 1) << 5)); }
__host__ __device__ __forceinline__ void stage_rc(int b, int& R, int& C) { const int st = b / 1024, sb = b % 1024, swz = sb ^ (((sb >> 9) & 1) << 5); R = (st >> 1) * 16 + swz / 64; C = (st & 1) * 32 + (swz % 64) / 2; }
__host__ __device__ __forceinline__ int perm32(int rho) { const int n = rho >> 4, i = rho & 15; return 8 * (i >> 2) + 4 * n + (i & 3); }

struct Unit { int pm, pn, z; };
template <int LDA_, int LDB_, int K_, int NM_, int NN_, int NZ_ = 1, int NZH_ = 1, bool ZINNER_ = false, long ZSAB_ = 0, long ZSAH_ = 0, long ZSBB_ = 0, long ZSBH_ = 0>
struct Gemm {
    static constexpr int LDA = LDA_, LDB = LDB_, K = K_, NM = NM_, NN = NN_, NZ = NZ_, NZH = NZH_; static constexpr bool ZINNER = ZINNER_;
    const bf16_t* A; const bf16_t* B; int G, c;
    __device__ __forceinline__ bool next(int i, Unit& u) const {
        constexpr int nt = NM * NN; int L, z;
        if (ZINNER) { const int it = i / NZ; z = i - it * NZ; const long LL = (long)it * G + c; if (LL >= nt) return false; L = (int)LL; }
        else { const long LL = (long)i * G + c; if (LL >= (long)nt * NZ) return false; z = (int)(LL / nt); L = (int)(LL - (long)z * nt); }
        int wgid = L; { constexpr int q = nt / NXCD, r = nt % NXCD; const int xcd = wgid % NXCD, off = wgid / NXCD; wgid = (xcd < r ? xcd * (q + 1) : r * (q + 1) + (xcd - r) * q) + off; }
        constexpr int nig = WGM * NN; const int gid = wgid / nig, fm = gid * WGM, gsz = (NM - fm) < WGM ? (NM - fm) : WGM;
        u.pm = fm + ((wgid % nig) % gsz); u.pn = (wgid % nig) / gsz; u.z = z; return true;
    }
    __device__ __forceinline__ const char* a_base(const Unit& u) const { const int zb = u.z / NZH, zh = u.z - zb * NZH; return (const char*)(A + zb * ZSAB_ + zh * ZSAH_ + (long)u.pm * BM * LDA); }
    __device__ __forceinline__ const char* b_base(const Unit& u) const { const int zb = u.z / NZH, zh = u.z - zb * NZH; return (const char*)(B + zb * ZSBB_ + zh * ZSBH_ + (long)u.pn * BM * LDB); }
};

template <class GT, class Epi, bool ALIGN_EPI = true, bool SP2 = true>
__device__ __forceinline__ void gemm_phase(LAS unsigned char* lds, const int tid, const GT& g, const Epi& E) {
    const int wid = __builtin_amdgcn_readfirstlane(tid >> 6), lane = tid & 63, wr = wid >> 2, wc = wid & 3, fr = lane & 15, fq = lane >> 4;
    constexpr int nt = GT::K / BK;
    unsigned voffA[2], voffB[2];
#pragma unroll
    for (int i = 0; i < 2; ++i) { int R, C; stage_rc(tid * 16 + i * 8192, R, C); const int Rb = Epi::PERM ? ((R & ~31) + perm32(R & 31)) : R;
        voffA[i] = (unsigned)(R * GT::LDA + C) * 2u; voffB[i] = (unsigned)(Rb * GT::LDB + C) * 2u; }
    constexpr size_t kstep = (size_t)(BK * 2);
    constexpr size_t hstepA = (size_t)HALF * GT::LDA * 2, hstepB = (size_t)HALF * GT::LDB * 2;
    const unsigned ldsw = (unsigned)wid * 1024u;
    const int aoff = lds_byte(wr * 64 + fr, fq * 8), boff = lds_byte(wc * 32 + fr, fq * 8);
#define PG8_SA(b, h) (((b) * 2 + (h)) * HTB)
#define PG8_SB(b, h) ((4 + (b) * 2 + (h)) * HTB)
#define PG8_STAGE(bufoff, gbase, voff) do { _Pragma("unroll") for (int _i = 0; _i < 2; ++_i) \
        __builtin_amdgcn_global_load_lds((const unsigned*)((const char*)(gbase) + (voff)[_i]), (LAS unsigned*)(lds + (bufoff) + ldsw + _i * 8192), 16, 0, 0); } while (0)
#define PG8_LDA(dst, b, h) do { _Pragma("unroll") for (int m = 0; m < 4; ++m) _Pragma("unroll") for (int k = 0; k < 2; ++k) dst[m][k] = *(const LAS bf16x8*)(lds + PG8_SA(b, h) + aoff + m * 2048 + k * 1024); } while (0)
#define PG8_LDB(dst, b, h) do { _Pragma("unroll") for (int n = 0; n < 2; ++n) _Pragma("unroll") for (int k = 0; k < 2; ++k) dst[n][k] = *(const LAS bf16x8*)(lds + PG8_SB(b, h) + boff + n * 2048 + k * 1024); } while (0)
#define PG8_MMA(ai, bj, At, Bt) do { __builtin_amdgcn_s_setprio(1); _Pragma("unroll") for (int m = 0; m < 4; ++m) _Pragma("unroll") for (int n = 0; n < 2; ++n) _Pragma("unroll") for (int k = 0; k < 2; ++k) \
        acc[ai][bj][m][n] = __builtin_amdgcn_mfma_f32_16x16x32_bf16(Bt[n][k], At[m][k], acc[ai][bj][m][n], 0, 0, 0); __builtin_amdgcn_s_setprio(0); } while (0)
#define PG8_WAIT_V(n) asm volatile("s_waitcnt vmcnt(" #n ")" ::: "memory")
#define PG8_WAIT_L(n) asm volatile("s_waitcnt lgkmcnt(" #n ")" ::: "memory")
#define PG8_BAR __builtin_amdgcn_s_barrier()
#define PG8_SCHED __builtin_amdgcn_sched_barrier(0)
    Unit cur, nxt; int ui = 0;
    if (!g.next(0, cur)) return;
    f32x4 acc[2][2][4][2];
#pragma unroll
    for (int a = 0; a < 2; ++a)
#pragma unroll
        for (int b = 0; b < 2; ++b)
#pragma unroll
            for (int m = 0; m < 4; ++m)
#pragma unroll
                for (int n = 0; n < 2; ++n) acc[a][b][m][n] = (f32x4){0.f, 0.f, 0.f, 0.f};
    bf16x8 At[4][2], B0[2][2], B1[2][2];
    const char* cA = g.a_base(cur); const char* cB = g.b_base(cur);
    if constexpr (SP2) {
        PG8_STAGE(PG8_SB(0, 0), cB, voffB); PG8_STAGE(PG8_SB(0, 1), cB + hstepB, voffB); PG8_STAGE(PG8_SA(0, 0), cA, voffA); PG8_STAGE(PG8_SA(0, 1), cA + hstepA, voffA);
        if (wr == 1) PG8_BAR;
        PG8_WAIT_V(2); PG8_BAR;
        PG8_STAGE(PG8_SB(1, 0), cB + kstep, voffB); PG8_STAGE(PG8_SA(1, 0), cA + kstep, voffA); PG8_STAGE(PG8_SB(1, 1), cB + hstepB + kstep, voffB);
        PG8_WAIT_V(6); PG8_BAR;
    } else {
        PG8_STAGE(PG8_SB(0, 0), cB, voffB); PG8_STAGE(PG8_SA(0, 0), cA, voffA); PG8_STAGE(PG8_SB(0, 1), cB + hstepB, voffB); PG8_STAGE(PG8_SA(0, 1), cA + hstepA, voffA);
        if (wr == 1) PG8_BAR;
        PG8_WAIT_V(4); PG8_BAR;
        PG8_STAGE(PG8_SB(1, 0), cB + kstep, voffB); PG8_STAGE(PG8_SA(1, 0), cA + kstep, voffA); PG8_STAGE(PG8_SB(1, 1), cB + hstepB + kstep, voffB);
        PG8_WAIT_V(6); PG8_BAR;
    }
    for (;;) {
        const bool has_next = g.next(ui + 1, nxt);
        const char* nA = has_next ? g.a_base(nxt) : cA; const char* nB = has_next ? g.b_base(nxt) : cB;
#pragma unroll 1
        for (int t = 0; t < nt; t += 2) {
            const bool last = (t == nt - 2);
            const char* a1 = cA + (size_t)(t + 1) * kstep;
            const char* a2 = last ? nA : cA + (size_t)(t + 2) * kstep; const char* b2 = last ? nB : cB + (size_t)(t + 2) * kstep;
            const char* a3 = a2 + kstep; const char* b3 = b2 + kstep;
            if constexpr (SP2) {
            PG8_LDB(B0, 0, 0); PG8_LDB(B1, 0, 1); PG8_SCHED; PG8_LDA(At, 0, 0); PG8_STAGE(PG8_SA(1, 1), a1 + hstepA, voffA);
            PG8_WAIT_V(8); PG8_WAIT_L(0); PG8_BAR; PG8_MMA(0, 0, At, B0); PG8_MMA(0, 1, At, B1); PG8_BAR; PG8_SCHED;
            PG8_LDA(At, 0, 1); PG8_STAGE(PG8_SB(0, 0), b2, voffB); PG8_STAGE(PG8_SB(0, 1), b2 + hstepB, voffB); PG8_STAGE(PG8_SA(0, 0), a2, voffA);
            PG8_WAIT_V(8); PG8_WAIT_L(0); PG8_BAR; PG8_MMA(1, 0, At, B0); PG8_MMA(1, 1, At, B1); PG8_BAR; PG8_SCHED;
            PG8_LDB(B0, 1, 0); PG8_LDB(B1, 1, 1); PG8_SCHED; PG8_LDA(At, 1, 0); PG8_STAGE(PG8_SA(0, 1), a2 + hstepA, voffA);
            PG8_WAIT_V(8); PG8_WAIT_L(0); PG8_BAR; PG8_MMA(0, 0, At, B0); PG8_MMA(0, 1, At, B1); PG8_BAR; PG8_SCHED;
            PG8_LDA(At, 1, 1); PG8_STAGE(PG8_SB(1, 0), b3, voffB); PG8_STAGE(PG8_SB(1, 1), b3 + hstepB, voffB); PG8_STAGE(PG8_SA(1, 0), a3, voffA);
            PG8_WAIT_V(8); PG8_WAIT_L(0); PG8_BAR; PG8_MMA(1, 0, At, B0); PG8_MMA(1, 1, At, B1); PG8_BAR; PG8_SCHED;
            } else {
            PG8_LDB(B0, 0, 0); PG8_SCHED; PG8_LDA(At, 0, 0); PG8_STAGE(PG8_SA(1, 1), a1 + hstepA, voffA);
            PG8_WAIT_L(8); PG8_BAR; PG8_WAIT_L(0); PG8_MMA(0, 0, At, B0); PG8_BAR; PG8_SCHED;
            PG8_LDB(B1, 0, 1); PG8_STAGE(PG8_SB(0, 0), b2, voffB);
            PG8_BAR; PG8_WAIT_L(0); PG8_MMA(0, 1, At, B1); PG8_BAR;
            PG8_LDA(At, 0, 1); PG8_STAGE(PG8_SA(0, 0), a2, voffA);
            PG8_BAR; PG8_WAIT_L(0); PG8_MMA(1, 0, At, B0); PG8_BAR; PG8_SCHED;
            PG8_STAGE(PG8_SB(0, 1), b2 + hstepB, voffB);
            PG8_WAIT_V(6); PG8_BAR; PG8_MMA(1, 1, At, B1); PG8_BAR;
            PG8_LDB(B0, 1, 0); PG8_SCHED; PG8_LDA(At, 1, 0); PG8_STAGE(PG8_SA(0, 1), a2 + hstepA, voffA);
            PG8_WAIT_L(8); PG8_BAR; PG8_WAIT_L(0); PG8_MMA(0, 0, At, B0); PG8_BAR; PG8_SCHED;
            PG8_LDB(B1, 1, 1); PG8_STAGE(PG8_SB(1, 0), b3, voffB);
            PG8_BAR; PG8_WAIT_L(0); PG8_MMA(0, 1, At, B1); PG8_BAR;
            PG8_LDA(At, 1, 1); PG8_STAGE(PG8_SA(1, 0), a3, voffA);
            PG8_BAR; PG8_WAIT_L(0); PG8_MMA(1, 0, At, B0); PG8_BAR; PG8_SCHED;
            PG8_STAGE(PG8_SB(1, 1), b3 + hstepB, voffB);
            PG8_WAIT_V(6); PG8_BAR; PG8_MMA(1, 1, At, B1); PG8_BAR;
            }
        }
        if constexpr (ALIGN_EPI) { if (wr == 0) PG8_BAR; }
        E(acc, cur, wr, wc, fr, fq);
        if (!has_next) break;
#pragma unroll
        for (int a = 0; a < 2; ++a)
#pragma unroll
            for (int b = 0; b < 2; ++b)
#pragma unroll
                for (int m = 0; m < 4; ++m)
#pragma unroll
                    for (int n = 0; n < 2; ++n) acc[a][b][m][n] = (f32x4){0.f, 0.f, 0.f, 0.f};
        cur = nxt; cA = nA; cB = nB; ++ui;
        if constexpr (ALIGN_EPI) { if (wr == 1) PG8_BAR; }
    }
    PG8_WAIT_V(0);
    if constexpr (!ALIGN_EPI) { if (wr == 0) PG8_BAR; }
    PG8_BAR;
#undef PG8_SA
#undef PG8_SB
#undef PG8_STAGE
#undef PG8_LDA
#undef PG8_LDB
#undef PG8_MMA
#undef PG8_WAIT_V
#undef PG8_WAIT_L
#undef PG8_BAR
#undef PG8_SCHED
}

struct EpiBf16 {
    static constexpr bool PERM = true;
    bf16_t* O; long zs; int ldc, pad;
    __device__ __forceinline__ void operator()(const f32x4 (&acc)[2][2][4][2], const Unit& u, int wr, int wc, int fr, int fq) const {
        const int row0 = u.pm * BM + wr * 64 + fr, col0 = u.pn * BM + wc * 32 + 8 * fq; bf16_t* base = O + (long)u.z * zs;
#pragma unroll
        for (int ai = 0; ai < 2; ++ai)
#pragma unroll
            for (int m = 0; m < 4; ++m) { bf16_t* rowp = base + (size_t)(row0 + ai * HALF + m * 16) * ldc + col0;
#pragma unroll
                for (int bj = 0; bj < 2; ++bj) { const f32x4 v0 = acc[ai][bj][m][0], v1 = acc[ai][bj][m][1];
                    u32x4 w; w.x = pk2(v0[0], v0[1]); w.y = pk2(v0[2], v0[3]); w.z = pk2(v1[0], v1[1]); w.w = pk2(v1[2], v1[3]);
                    *(u32x4*)(rowp + bj * HALF) = w; } }
    }
};
struct EpiMem {
    static constexpr bool PERM = false;
    float* outK; float* outV; bf16_t* kb; bf16_t* vt;
    __device__ __forceinline__ void operator()(const f32x4 (&acc)[2][2][4][2], const Unit& u, int wr, int wc, int fr, int fq) const {
        const int row0 = u.pm * BM + wr * 64 + fr, col0 = u.pn * BM + wc * 32 + 4 * fq;
#pragma unroll
        for (int ai = 0; ai < 2; ++ai)
#pragma unroll
            for (int m = 0; m < 4; ++m) { const int row = row0 + ai * HALF + m * 16;
#pragma unroll
                for (int bj = 0; bj < 2; ++bj)
#pragma unroll
                    for (int n = 0; n < 2; ++n) { const int col = col0 + bj * HALF + n * 16; const f32x4 v = acc[ai][bj][m][n];
                        if (col < 1024) { *(f32x4*)(outK + ((size_t)u.z * 512 + row) * 1024 + col) = v;
                            u32x2 w; w.x = pk2(v[0], v[1]); w.y = pk2(v[2], v[3]); *(u32x2*)(kb + ((size_t)u.z * 512 + row) * 1024 + col) = w; }
                        else { const int c = col - 1024; *(f32x4*)(outV + ((size_t)u.z * 512 + row) * 1024 + c) = v;
                            const int b = row >> 8, mm = row & 255, h = c >> 8, d = c & 255; bf16_t* p = vt + ((((size_t)u.z * 2 + b) * 4 + h) * 256 + d) * 256 + mm;
                            p[0] = f2bf(v[0]); p[256] = f2bf(v[1]); p[512] = f2bf(v[2]); p[768] = f2bf(v[3]); } } }
    }
};
struct EpiMerge {
    static constexpr bool PERM = false;
    float* MG; bf16_t* MGB; const bf16_t* U; const float* gate_b;
    __device__ __forceinline__ void operator()(const f32x4 (&acc)[2][2][4][2], const Unit& u, int wr, int wc, int fr, int fq) const {
        const int row0 = u.pm * BM + wr * 64 + fr, col0 = u.pn * BM + wc * 32 + 4 * fq;
#pragma unroll
        for (int ai = 0; ai < 2; ++ai)
#pragma unroll
            for (int m = 0; m < 4; ++m) { const int row = row0 + ai * HALF + m * 16;
#pragma unroll
                for (int bj = 0; bj < 2; ++bj)
#pragma unroll
                    for (int n = 0; n < 2; ++n) { const int col = col0 + bj * HALF + n * 16; const f32x4 v = acc[ai][bj][m][n];
                        const u32x2 gp = *(const u32x2*)(U + (size_t)row * NINP + U_GP + u.z * DM + col); const f32x4 gb = *(const f32x4*)(gate_b + u.z * DM + col);
                        f32x4 gt; gt[0] = sigmoidf_(__uint_as_float(gp.x << 16) + gb[0]); gt[1] = sigmoidf_(__uint_as_float(gp.x & 0xffff0000u) + gb[1]);
                        gt[2] = sigmoidf_(__uint_as_float(gp.y << 16) + gb[2]); gt[3] = sigmoidf_(__uint_as_float(gp.y & 0xffff0000u) + gb[3]);
                        float* mp = MG + (size_t)row * DM + col; f32x4 r = gt * v;
                        if (u.z > 0) r += *(const f32x4*)mp;
                        if (u.z < 3) *(f32x4*)mp = r;
                        else { u32x2 w; w.x = pk2(r[0], r[1]); w.y = pk2(r[2], r[3]); *(u32x2*)(MGB + (size_t)row * DM + col) = w; } } }
    }
};
struct EpiRes {
    static constexpr bool PERM = false;
    const float* R; float* Y;
    __device__ __forceinline__ void operator()(const f32x4 (&acc)[2][2][4][2], const Unit& u, int wr, int wc, int fr, int fq) const {
        const int row0 = u.pm * BM + wr * 64 + fr, col0 = u.pn * BM + wc * 32 + 4 * fq;
#pragma unroll
        for (int ai = 0; ai < 2; ++ai)
#pragma unroll
            for (int m = 0; m < 4; ++m) { const size_t ro = (size_t)(row0 + ai * HALF + m * 16) * DM + col0;
#pragma unroll
                for (int bj = 0; bj < 2; ++bj)
#pragma unroll
                    for (int n = 0; n < 2; ++n) { const size_t o = ro + bj * HALF + n * 16; *(f32x4*)(Y + o) = *(const f32x4*)(R + o) * ALPHA + acc[ai][bj][m][n]; } }
    }
};
struct EpiSwiGLU {
    static constexpr bool PERM = true;
    bf16_t* O;
    __device__ __forceinline__ void operator()(const f32x4 (&acc)[2][2][4][2], const Unit& u, int wr, int wc, int fr, int fq) const {
        const int row0 = u.pm * BM + wr * 64 + fr, col0 = u.pn * HALF + wc * 32 + 8 * fq;
#pragma unroll
        for (int ai = 0; ai < 2; ++ai)
#pragma unroll
            for (int m = 0; m < 4; ++m) { bf16_t* rowp = O + (size_t)(row0 + ai * HALF + m * 16) * DFF + col0;
                float r[8];
#pragma unroll
                for (int n = 0; n < 2; ++n)
#pragma unroll
                    for (int j = 0; j < 4; ++j) { const float gg = acc[ai][0][m][n][j], uu = acc[ai][1][m][n][j]; r[n * 4 + j] = gg * sigmoidf_(gg) * uu; }
                u32x4 w; w.x = pk2(r[0], r[1]); w.y = pk2(r[2], r[3]); w.z = pk2(r[4], r[5]); w.w = pk2(r[6], r[7]);
                *(u32x4*)rowp = w; }
    }
};
struct EpiScore {
    static constexpr bool PERM = false;
    float* SC;
    __device__ __forceinline__ void operator()(const f32x4 (&acc)[2][2][4][2], const Unit& u, int wr, int wc, int fr, int fq) const {
        const int row0 = u.pm * BM + wr * 64 + fr, col0 = wc * 32 + 4 * fq; float* base = SC + (size_t)u.z * 4096 * 256;
#pragma unroll
        for (int ai = 0; ai < 2; ++ai)
#pragma unroll
            for (int m = 0; m < 4; ++m) { float* rowp = base + (size_t)(row0 + ai * HALF + m * 16) * 256 + col0;
#pragma unroll
                for (int bj = 0; bj < 2; ++bj)
#pragma unroll
                    for (int n = 0; n < 2; ++n) *(f32x4*)(rowp + bj * HALF + n * 16) = acc[ai][bj][m][n] * 0.0625f; }
    }
};
struct EpiPV {
    static constexpr bool PERM = true;
    bf16_t* O;
    __device__ __forceinline__ void operator()(const f32x4 (&acc)[2][2][4][2], const Unit& u, int wr, int wc, int fr, int fq) const {
        const int b = u.z >> 2, h = u.z & 3; const int row0 = b * PS + u.pm * BM + wr * 64 + fr, col0 = h * 256 + wc * 32 + 8 * fq;
#pragma unroll
        for (int ai = 0; ai < 2; ++ai)
#pragma unroll
            for (int m = 0; m < 4; ++m) { bf16_t* rowp = O + (size_t)(row0 + ai * HALF + m * 16) * BW + col0;
#pragma unroll
                for (int bj = 0; bj < 2; ++bj) { const f32x4 v0 = acc[ai][bj][m][0], v1 = acc[ai][bj][m][1];
                    u32x4 w; w.x = pk2(v0[0], v0[1]); w.y = pk2(v0[2], v0[3]); w.z = pk2(v1[0], v1[1]); w.w = pk2(v1[2], v1[3]);
                    *(u32x4*)(rowp + bj * HALF) = w; } }
    }
};
}


#define XB_TMO      128
#define XB_XCNT(j)  (256  + 64 * (j))
#define XB_XSUB(j)  (1280 + 64 * (j))
#define XB_XGEN(j)  (2304 + 64 * (j))
#define XB_TOP      3328
#define XB_TOPGEN   3392
#define XCD_BAR_WORDS 3456
#define XB_SPIN_CAP (1u << 18)
__device__ __forceinline__ unsigned xb_ld(unsigned* p)              { return __hip_atomic_load(p, __ATOMIC_RELAXED, __HIP_MEMORY_SCOPE_AGENT); }
__device__ __forceinline__ unsigned xb_add(unsigned* p, unsigned v) { return __hip_atomic_fetch_add(p, v, __ATOMIC_RELAXED, __HIP_MEMORY_SCOPE_AGENT); }
__device__ __forceinline__ unsigned xb_xcc_id() { return (unsigned)__builtin_amdgcn_s_getreg((3 << 11) | 20) & 0xFu; }
#define XB_SPIN(cond, bar) do { unsigned _sp = 0; while (cond) { __builtin_amdgcn_s_sleep(1); \
    if ((++_sp & 255u) == 0u) { if (xb_ld(&(bar)[XB_TMO])) break; if (_sp > XB_SPIN_CAP) { atomicAdd(&(bar)[XB_TMO], 1u); break; } } } } while (0)
struct XcdBarrier { unsigned* bar; unsigned x; volatile LAS unsigned* st; };
__device__ __forceinline__ XcdBarrier xcd_barrier_post(unsigned* bar, volatile LAS unsigned* st) {
    XcdBarrier b; b.bar = bar; b.x = xb_xcc_id(); b.st = st;
    if (threadIdx.x == 0) (void)xb_add(&bar[XB_XCNT(b.x)], 1u);
    return b;
}
__device__ __forceinline__ void xcd_barrier_complete(unsigned* bar, unsigned x, unsigned& nloc, unsigned& nx) {
    const unsigned G = gridDim.x * gridDim.y * gridDim.z;
    unsigned sum, cnt, mine, sp = 0u;
    for (;;) {
        sum = 0u; cnt = 0u; mine = 0u;
#pragma unroll
        for (unsigned j = 0; j < 16; ++j) { const unsigned c = xb_ld(&bar[XB_XCNT(j)]); sum += c; cnt += (c > 0u) ? 1u : 0u; mine = (j == x) ? c : mine; }
        if (sum == G) break;
        __builtin_amdgcn_s_sleep(1);
        if ((++sp & 255u) == 0u) { if (xb_ld(&bar[XB_TMO])) break; if (sp > XB_SPIN_CAP) { atomicAdd(&bar[XB_TMO], 1u); break; } }
    }
    nloc = mine > 0u ? mine : 1u; nx = cnt > 0u ? cnt : 1u;
}
__device__ __forceinline__ void xcd_barrier(const XcdBarrier& b) {
    asm volatile("s_waitcnt vmcnt(0)" ::: "memory");
    __syncthreads();
    if (threadIdx.x == 0) {
        unsigned* bar = b.bar;
        __builtin_amdgcn_s_waitcnt(0);
        unsigned nloc = b.st[0], nx = b.st[1];
        if (nloc == 0u) { xcd_barrier_complete(bar, b.x, nloc, nx); b.st[0] = nloc; b.st[1] = nx; }
        const unsigned old = xb_add(&bar[XB_XSUB(b.x)], 1u);
        const unsigned gen = old / nloc;
        if (old + 1u == (gen + 1u) * nloc) {
            __builtin_amdgcn_fence(__ATOMIC_RELEASE, "agent");
            asm volatile("s_waitcnt vmcnt(0)" ::: "memory");
            const unsigned og = xb_add(&bar[XB_TOP], 1u);
            const unsigned tg = og / nx;
            if (og + 1u == (tg + 1u) * nx) xb_add(&bar[XB_TOPGEN], 1u);
            else XB_SPIN(xb_ld(&bar[XB_TOPGEN]) == tg, bar);
            __builtin_amdgcn_fence(__ATOMIC_ACQUIRE, "agent");
            xb_add(&bar[XB_XGEN(b.x)], 1u);
            asm volatile("s_waitcnt vmcnt(0)" ::: "memory");
        } else {
            XB_SPIN(xb_ld(&bar[XB_XGEN(b.x)]) == gen, bar);
            __builtin_amdgcn_fence(__ATOMIC_ACQUIRE, "agent");
            asm volatile("s_waitcnt vmcnt(0)" ::: "memory");
        }
    }
    __syncthreads();
}

struct Ctx { int tid, lane, wave, bid, G; LAS unsigned char* lds; };
__device__ __forceinline__ Ctx fresh(const Ctx& c0) { Ctx c; c.wave = c0.wave; c.bid = c0.bid; c.G = c0.G; c.lds = c0.lds; asm volatile("" : "+s"(c.bid), "+s"(c.G), "+s"(c.wave));
    int lane = (int)__builtin_amdgcn_mbcnt_hi(~0u, __builtin_amdgcn_mbcnt_lo(~0u, 0u)); asm volatile("" : "+v"(lane)); c.lane = lane; c.tid = c.wave * 64 + lane; return c; }

__device__ __forceinline__ int colmap(int mode, int n) {
    if (mode == 1) return n < 3088 ? n : (n < 3328 ? -1 : n - 240);
    if (mode == 2) { const int t = n >> 8, j = n & 255; return j < 128 ? t * 128 + j : DFF + t * 128 + (j - 128); }
    return n;
}
__device__ __forceinline__ void ph_wprep(const Ctx& c, const float* __restrict__ src, bf16_t* __restrict__ dst, int K, int Nsrc, int Ndst, int mode, int nbatch, size_t sbs, size_t dbs) {
    LAS float* tile = (LAS float*)c.lds;
    const int nx = Ndst / 64, ny = K / 64, total = nx * ny * nbatch;
    const int tx = c.tid & 63, ty = c.tid >> 6, r = c.tid >> 3, p = c.tid & 7;
    for (int t = c.bid; t < total; t += c.G) {
        const int bx = t % nx, by = (t / nx) % ny, bz = t / (nx * ny);
        const float* s = src + (size_t)bz * sbs; bf16_t* d = dst + (size_t)bz * dbs;
        const int n0 = bx * 64, k0 = by * 64, cm = colmap(mode, n0 + tx);
        for (int kk = ty; kk < 64; kk += 8) tile[kk * 65 + tx] = cm >= 0 ? s[(size_t)(k0 + kk) * Nsrc + cm] : 0.f;
        __syncthreads();
        { u32x4 w; w.x = pk2(tile[(p * 8 + 0) * 65 + r], tile[(p * 8 + 1) * 65 + r]); w.y = pk2(tile[(p * 8 + 2) * 65 + r], tile[(p * 8 + 3) * 65 + r]);
          w.z = pk2(tile[(p * 8 + 4) * 65 + r], tile[(p * 8 + 5) * 65 + r]); w.w = pk2(tile[(p * 8 + 6) * 65 + r], tile[(p * 8 + 7) * 65 + r]);
          *(u32x4*)(d + (size_t)(n0 + r) * K + k0 + p * 8) = w; }
        __syncthreads();
    }
}
__device__ __forceinline__ void ph_xprep(const Ctx& c, const float* __restrict__ xp, const float* __restrict__ xs, const float* __restrict__ mem, float* __restrict__ HF, bf16_t* __restrict__ HB, bf16_t* __restrict__ MEMB) {
    const size_t nH = (size_t)MPAD * DM / 4, nM = (size_t)512 * DM / 4;
    for (size_t i4 = (size_t)c.bid * 512 + c.tid; i4 < nH + nM; i4 += (size_t)c.G * 512) {
        if (i4 < nH) {
            const size_t e = i4 * 4; f32x4 v = (f32x4){0.f, 0.f, 0.f, 0.f};
            if (e < (size_t)MP * DM) v = *(const f32x4*)(xp + e); else if (e < (size_t)MT * DM) v = *(const f32x4*)(xs + (e - (size_t)MP * DM));
            *(f32x4*)(HF + e) = v; u32x2 w; w.x = pk2(v[0], v[1]); w.y = pk2(v[2], v[3]); *(u32x2*)(HB + e) = w;
        } else {
            const size_t e = (i4 - nH) * 4; const f32x4 v = *(const f32x4*)(mem + e); u32x2 w; w.x = pk2(v[0], v[1]); w.y = pk2(v[2], v[3]); *(u32x2*)(MEMB + e) = w;
        }
    }
}
__device__ __forceinline__ void ph_ln(const Ctx& c, const float* __restrict__ Y, const float* __restrict__ g, const float* __restrict__ b, float* __restrict__ XF, bf16_t* __restrict__ XB, float* __restrict__ OUT, int nrows, int nout) {
    const int lane = c.lane;
    for (int row = c.bid * 8 + c.wave; row < nrows; row += c.G * 8) {
        const float* y = Y + (size_t)row * DM; f32x4 v[8]; float s = 0.f;
#pragma unroll
        for (int j = 0; j < 8; ++j) { v[j] = *(const f32x4*)(y + j * 256 + lane * 4); s += (v[j][0] + v[j][1]) + (v[j][2] + v[j][3]); }
        const float mean = wave_sum(s) * (1.0f / DM); float q = 0.f;
#pragma unroll
        for (int j = 0; j < 8; ++j) { const f32x4 d = v[j] - mean; q += (d[0] * d[0] + d[1] * d[1]) + (d[2] * d[2] + d[3] * d[3]); }
        const float rstd = rsqrtf(wave_sum(q) * (1.0f / DM) + 1e-5f);
#pragma unroll
        for (int j = 0; j < 8; ++j) { const int cc = j * 256 + lane * 4; const f32x4 gg = *(const f32x4*)(g + cc), bb = *(const f32x4*)(b + cc);
            const f32x4 o = (v[j] - mean) * rstd * gg + bb; const size_t off = (size_t)row * DM + cc;
            *(f32x4*)(XF + off) = o; u32x2 w; w.x = pk2(o[0], o[1]); w.y = pk2(o[2], o[3]); *(u32x2*)(XB + off) = w;
            if (OUT != nullptr && row < nout) *(f32x4*)(OUT + off) = o; }
    }
}
__device__ __forceinline__ void ph_softmax256(const Ctx& c, const float* __restrict__ SC, bf16_t* __restrict__ P, int nrows) {
    const int lane = c.lane;
    for (int row = c.bid * 8 + c.wave; row < nrows; row += c.G * 8) {
        const f32x4 v = *(const f32x4*)(SC + (size_t)row * 256 + lane * 4);
        const float mx = wave_max(fmaxf(fmaxf(v[0], v[1]), fmaxf(v[2], v[3])));
        f32x4 e; e[0] = __expf(v[0] - mx); e[1] = __expf(v[1] - mx); e[2] = __expf(v[2] - mx); e[3] = __expf(v[3] - mx);
        const float inv = 1.0f / wave_sum((e[0] + e[1]) + (e[2] + e[3]));
        u32x2 w; w.x = pk2(e[0] * inv, e[1] * inv); w.y = pk2(e[2] * inv, e[3] * inv); *(u32x2*)(P + (size_t)row * 256 + lane * 4) = w;
    }
}
__device__ __forceinline__ void ph_copy_outs(const Ctx& c, const bf16_t* __restrict__ U, const float* __restrict__ ck, const float* __restrict__ cv, float* __restrict__ out, int layer) {
    constexpr int nA = PB * 128 * 128, nB = SB * 128 * 128, nC = PB * RWC, nD = SB * RWC;
    for (int i = c.bid * 512 + c.tid; i < nA + nB + nC + nD; i += c.G * 512) {
        if (i < nA) { const int b = i / 16384, j = (i >> 7) & 127, cc = i & 127; const size_t ur = (size_t)(b * PS + PS - 128 + j) * NINP;
            out[O_SWKP + (size_t)layer * nA + i] = bf2f(U[ur + U_SK + cc]); out[O_SWVP + (size_t)layer * nA + i] = bf2f(U[ur + U_SV + cc]); continue; }
        int k = i - nA;
        if (k < nB) { const int sq = k / 16384, j = (k >> 7) & 127, cc = k & 127; float kv, vv;
            if (j < 124) { const size_t o = ((size_t)sq * 128 + j + 4) * 128 + cc; kv = ck[o]; vv = cv[o]; }
            else { const size_t ur = (size_t)(MP + sq * SS + j - 124) * NINP; kv = bf2f(U[ur + U_SK + cc]); vv = bf2f(U[ur + U_SV + cc]); }
            out[O_SWKS + (size_t)layer * nB + k] = kv; out[O_SWVS + (size_t)layer * nB + k] = vv; continue; }
        k -= nB;
        if (k < nC) { const int b = k / RWC, cc = k - b * RWC; out[O_RSP + (size_t)layer * nC + k] = bf2f(U[(size_t)(b * PS + PS - 1) * NINP + U_RU + cc]); continue; }
        k -= nC;
        { const int sq = k / RWC, cc = k - sq * RWC; out[O_RSS + (size_t)layer * nD + k] = bf2f(U[(size_t)(MP + sq * SS + SS - 1) * NINP + U_RU + cc]); }
    }
}

__device__ __forceinline__ void seq_info(int sq, int& row0, int& L) { if (sq < PB) { row0 = sq * PS; L = PS; } else { row0 = MP + (sq - PB) * SS; L = SS; } }

__device__ __forceinline__ void ph_gla_naive(const Ctx& c, const bf16_t* __restrict__ U, const float* __restrict__ s0, const float* __restrict__ a_up, const float* __restrict__ a_b,
                                             const float* __restrict__ ng, const float* __restrict__ nb, bf16_t* __restrict__ OB, float* __restrict__ outP, float* __restrict__ outS) {
    LAS float* qs = (LAS float*)c.lds;
    LAS float* ks = qs + 16 * 128; LAS float* as = ks + 16 * 128; LAS float* os = as + 16 * 128;
    const int kh = c.tid >> 8, vt = c.tid & 255, lane = c.lane;
    for (int u = c.bid; u < (PB + SB) * 4; u += c.G) {
        const int sq = u >> 2, h = u & 3;
        int row0, L; seq_info(sq, row0, L);
        float S[64];
        if (sq >= PB) { const float* p = s0 + (((size_t)(sq - PB) * 4 + h) * 128 + kh * 64) * 256 + vt;
#pragma unroll
            for (int kk = 0; kk < 64; ++kk) S[kk] = p[(size_t)kk * 256]; }
        else {
#pragma unroll
            for (int kk = 0; kk < 64; ++kk) S[kk] = 0.f; }
        for (int t0 = 0; t0 < L; t0 += 16) {
            const int nT = (L - t0) < 16 ? (L - t0) : 16;
            for (int idx = c.tid; idx < nT * 128; idx += 512) {
                const int tt = idx >> 7, kk = idx & 127; const bf16_t* ur = U + (size_t)(row0 + t0 + tt) * NINP;
                qs[idx] = bf2f(ur[U_GQ + h * 128 + kk]) * 0.08838834764831845f; ks[idx] = bf2f(ur[U_GK + h * 128 + kk]);
                float x = a_b[h * 128 + kk];
#pragma unroll
                for (int r = 0; r < 16; ++r) x += bf2f(ur[U_GA + r]) * a_up[r * 512 + h * 128 + kk];
                const float ls = (fminf(x, 0.f) - log1pf(__expf(-fabsf(x)))) * (1.0f / 16.0f);
                as[idx] = __expf(ls);
            }
            __syncthreads();
            for (int tt = 0; tt < nT; ++tt) {
                const float v = bf2f(U[(size_t)(row0 + t0 + tt) * NINP + U_GV + h * 256 + vt]); float o = 0.f; const int lb = tt * 128 + kh * 64;
#pragma unroll
                for (int kk = 0; kk < 64; ++kk) { S[kk] = as[lb + kk] * S[kk] + ks[lb + kk] * v; o += qs[lb + kk] * S[kk]; }
                os[(kh * 16 + tt) * 256 + vt] = o;
            }
            __syncthreads();
            for (int tt = c.wave; tt < nT; tt += 8) {
                float x[4]; float s = 0.f;
#pragma unroll
                for (int j = 0; j < 4; ++j) { x[j] = os[tt * 256 + lane + 64 * j] + os[(16 + tt) * 256 + lane + 64 * j]; s += x[j]; }
                const float mean = wave_sum(s) * (1.0f / 256.0f); float q = 0.f;
#pragma unroll
                for (int j = 0; j < 4; ++j) { const float d = x[j] - mean; q += d * d; }
                const float rstd = rsqrtf(wave_sum(q) * (1.0f / 256.0f) + 1e-5f);
                const size_t row = (size_t)(row0 + t0 + tt);
#pragma unroll
                for (int j = 0; j < 4; ++j) { const int cc = h * 256 + lane + 64 * j; const float n = (x[j] - mean) * rstd * ng[cc] + nb[cc];
                    const float gr = bf2f(U[row * NINP + U_GR + cc]); OB[row * BW + cc] = f2bf(n * gr * sigmoidf_(gr)); }
            }
            __syncthreads();
        }
        float* op = (sq < PB ? outP + (((size_t)sq * 4 + h) * 128 + kh * 64) * 256 : outS + (((size_t)(sq - PB) * 4 + h) * 128 + kh * 64) * 256) + vt;
#pragma unroll
        for (int kk = 0; kk < 64; ++kk) op[(size_t)kk * 256] = S[kk];
    }
}

__device__ __forceinline__ f32x4 mma16(bf16x8 x, bf16x8 y, f32x4 c) { return __builtin_amdgcn_mfma_f32_16x16x32_bf16(x, y, c, 0, 0, 0); }
__device__ __forceinline__ void gla_chunk_info(int u, int& row0, int& ntok, int& h) {
    if (u < 512) { const int b = u >> 8; h = (u >> 6) & 3; row0 = b * PS + (u & 63) * 64; ntok = 64; }
    else { const int s = u - 512; h = s & 3; row0 = MP + (s >> 2) * SS; ntok = SS; }
}
__device__ __forceinline__ void ph_gla_pre(const Ctx& c, const bf16_t* __restrict__ U, const float* __restrict__ a_up, const float* __restrict__ a_b,
                                           bf16_t* __restrict__ QD, bf16_t* __restrict__ KHT, bf16_t* __restrict__ EE, bf16_t* __restrict__ VT, float* __restrict__ GC) {
    LAS float* ga_l = (LAS float*)c.lds;
    LAS float* tot = ga_l + 64 * 16;
    LAS bf16_t* Qd_l = (LAS bf16_t*)(tot + 4 * 128);
    LAS bf16_t* Kn_l = Qd_l + 64 * 136;
    LAS bf16_t* v_l = Kn_l + 64 * 136;
    const int tid = c.tid, lane = c.lane, r = lane & 15, q = lane >> 4, w = c.wave;
    for (int u = c.bid; u < GL_NCH; u += c.G) {
        int row0, ntok, h; gla_chunk_info(u, row0, ntok, h);
        for (int i = tid; i < 64 * 16; i += 512) { const int t = i >> 4, rr = i & 15; ga_l[i] = t < ntok ? bf2f(U[(size_t)(row0 + t) * NINP + U_GA + rr]) : 0.f; }
        for (int i = tid; i < 64 * 32; i += 512) { const int t = i >> 5, c8 = i & 31; u32x4 vv = (u32x4){0u, 0u, 0u, 0u};
            if (t < ntok) vv = *(const u32x4*)(U + (size_t)(row0 + t) * NINP + U_GV + h * 256 + c8 * 8);
            *(LAS u32x4*)(v_l + t * 264 + c8 * 8) = vv; }
        __syncthreads();
        const int kk = tid & 127, tq = tid >> 7;
        float cum[16];
        { float aup[16];
#pragma unroll
          for (int rr = 0; rr < 16; ++rr) aup[rr] = a_up[rr * 512 + h * 128 + kk];
          const float ab = a_b[h * 128 + kk]; float run = 0.f;
#pragma unroll
          for (int j = 0; j < 16; ++j) { const int t = tq * 16 + j; float x = ab;
#pragma unroll
              for (int rr = 0; rr < 16; ++rr) x += ga_l[t * 16 + rr] * aup[rr];
              const float la = t < ntok ? (fminf(x, 0.f) - log1pf(__expf(-fabsf(x)))) * (1.0f / 16.0f) : 0.f;
              run += la; cum[j] = run; }
          tot[tq * 128 + kk] = run; }
        __syncthreads();
        { float prefix = 0.f, bC = 0.f;
#pragma unroll
          for (int g = 0; g < 4; ++g) { const float tv = tot[g * 128 + kk]; bC += tv; if (g < tq) prefix += tv; }
          unsigned khp[8];
#pragma unroll
          for (int j = 0; j < 16; j += 2) { float kh2[2];
#pragma unroll
              for (int e = 0; e < 2; ++e) { const int t = tq * 16 + j + e; const float b = prefix + cum[j + e]; float qv = 0.f, kv = 0.f;
                  if (t < ntok) { const bf16_t* ur = U + (size_t)(row0 + t) * NINP; qv = bf2f(ur[U_GQ + h * 128 + kk]); kv = bf2f(ur[U_GK + h * 128 + kk]); }
                  Qd_l[t * 136 + kk] = f2bf(qv * __expf(b) * 0.08838834764831845f); Kn_l[t * 136 + kk] = f2bf(kv * __expf(-b)); kh2[e] = kv * __expf(bC - b); }
              khp[j >> 1] = pk2(kh2[0], kh2[1]); }
          bf16_t* kp = KHT + (size_t)u * 8192 + kk * 64 + tq * 16;
          *(u32x4*)kp = (u32x4){khp[0], khp[1], khp[2], khp[3]}; *(u32x4*)(kp + 8) = (u32x4){khp[4], khp[5], khp[6], khp[7]};
          if (tq == 0) GC[(size_t)u * 128 + kk] = __expf(bC); }
        __syncthreads();
        { const int tb = w >> 1;
#pragma unroll
          for (int e = 0; e < 2; ++e) { const int ib = (w & 1) * 2 + e; f32x4 d = (f32x4){0.f, 0.f, 0.f, 0.f};
              if (ib <= tb) {
#pragma unroll
                  for (int ks = 0; ks < 4; ++ks) d = mma16(*(const LAS bf16x8*)(Kn_l + (ib * 16 + r) * 136 + ks * 32 + q * 8), *(const LAS bf16x8*)(Qd_l + (tb * 16 + r) * 136 + ks * 32 + q * 8), d); }
              const int t = tb * 16 + r, i0 = ib * 16 + q * 4;
#pragma unroll
              for (int jj = 0; jj < 4; ++jj) if (i0 + jj > t) d[jj] = 0.f;
              u32x2 o; o.x = pk2(d[0], d[1]); o.y = pk2(d[2], d[3]); *(u32x2*)(EE + (size_t)u * 4096 + t * 64 + i0) = o; } }
        for (int i = tid; i < 64 * 16; i += 512) { const int t = i >> 4, c8 = i & 15; *(u32x4*)(QD + (size_t)u * 8192 + t * 128 + c8 * 8) = *(const LAS u32x4*)(Qd_l + t * 136 + c8 * 8); }
        { const int val = tid & 255, th = tid >> 8;
#pragma unroll
          for (int tg = 0; tg < 4; ++tg) { const int t0 = th * 32 + tg * 8; unsigned p4[4];
#pragma unroll
              for (int e = 0; e < 4; ++e) p4[e] = (unsigned)v_l[(t0 + 2 * e) * 264 + val] | ((unsigned)v_l[(t0 + 2 * e + 1) * 264 + val] << 16);
              *(u32x4*)(VT + (size_t)u * 16384 + val * 64 + t0) = (u32x4){p4[0], p4[1], p4[2], p4[3]}; } }
        __syncthreads();
    }
}
struct GlaFrag { bf16x8 qd[4], e[2], kh[2], vt[4][2]; f32x4 gc; };
__device__ __forceinline__ void gla_load_frag(GlaFrag& f, const bf16_t* __restrict__ QD, const bf16_t* __restrict__ KHT, const bf16_t* __restrict__ EE, const bf16_t* __restrict__ VT, const float* __restrict__ GC,
                                              int ch, int sl, int w, int r, int q) {
    const int rb = w >> 1;
#pragma unroll
    for (int ks = 0; ks < 4; ++ks) f.qd[ks] = *(const bf16x8*)(QD + (size_t)ch * 8192 + (rb * 16 + r) * 128 + ks * 32 + q * 8);
#pragma unroll
    for (int ks = 0; ks < 2; ++ks) { f.e[ks] = *(const bf16x8*)(EE + (size_t)ch * 4096 + (rb * 16 + r) * 64 + ks * 32 + q * 8);
        f.kh[ks] = *(const bf16x8*)(KHT + (size_t)ch * 8192 + (w * 16 + r) * 64 + ks * 32 + q * 8);
#pragma unroll
        for (int vb = 0; vb < 4; ++vb) f.vt[vb][ks] = *(const bf16x8*)(VT + (size_t)ch * 16384 + (sl * 64 + vb * 16 + r) * 64 + ks * 32 + q * 8); }
    f.gc = *(const f32x4*)(GC + (size_t)ch * 128 + w * 16 + q * 4);
}
__device__ __forceinline__ void ph_gla_seq(const Ctx& c, int boff, const bf16_t* __restrict__ QD, const bf16_t* __restrict__ KHT, const bf16_t* __restrict__ EE, const bf16_t* __restrict__ VT, const float* __restrict__ GC,
                                           const float* __restrict__ s0, float* __restrict__ outP, float* __restrict__ outS, bf16_t* __restrict__ OB) {
    LAS bf16_t* T_l = (LAS bf16_t*)c.lds;
    const int lane = c.lane, r = lane & 15, q = lane >> 4, w = c.wave;
    for (int u = (c.bid - boff + c.G) % c.G; u < 32 + 512; u += c.G) {
        int h, sl, nch, ch0, row0, ntok; const float* sp = nullptr; float* op;
        if (u < 32) { const int b = u >> 4; h = (u >> 2) & 3; sl = u & 3; nch = 64; ch0 = (b * 4 + h) * 64; row0 = b * PS; ntok = 64; op = outP + (size_t)(b * 4 + h) * 32768; }
        else { const int s = u - 32, sq = s >> 4; h = (s >> 2) & 3; sl = s & 3; nch = 1; ch0 = 512 + sq * 4 + h; row0 = MP + sq * SS; ntok = SS; sp = s0 + (size_t)(sq * 4 + h) * 32768; op = outS + (size_t)(sq * 4 + h) * 32768; }
        f32x4 acc[4];
#pragma unroll
        for (int vb = 0; vb < 4; ++vb)
#pragma unroll
            for (int jj = 0; jj < 4; ++jj) acc[vb][jj] = sp ? sp[(size_t)(w * 16 + q * 4 + jj) * 256 + sl * 64 + vb * 16 + r] : 0.f;
        GlaFrag cur; gla_load_frag(cur, QD, KHT, EE, VT, GC, ch0, sl, w, r, q);
        for (int ci = 0; ci < nch; ++ci) {
            GlaFrag nxt; if (ci + 1 < nch) gla_load_frag(nxt, QD, KHT, EE, VT, GC, ch0 + ci + 1, sl, w, r, q); else nxt = cur;
            LAS bf16_t* Tb = T_l + (ci & 1) * 64 * 136;
#pragma unroll
            for (int vb = 0; vb < 4; ++vb) { u32x2 o; o.x = pk2(acc[vb][0], acc[vb][1]); o.y = pk2(acc[vb][2], acc[vb][3]); *(LAS u32x2*)(Tb + (vb * 16 + r) * 136 + w * 16 + q * 4) = o; }
            __syncthreads();
            { const int rb = w >> 1, t = rb * 16 + r;
#pragma unroll
              for (int e = 0; e < 2; ++e) { const int cb = (w & 1) * 2 + e; f32x4 y = (f32x4){0.f, 0.f, 0.f, 0.f};
#pragma unroll
                  for (int ks = 0; ks < 4; ++ks) y = mma16(*(const LAS bf16x8*)(Tb + (cb * 16 + r) * 136 + ks * 32 + q * 8), cur.qd[ks], y);
#pragma unroll
                  for (int ks = 0; ks < 2; ++ks) y = mma16(e == 0 ? ((w & 1) ? cur.vt[2][ks] : cur.vt[0][ks]) : ((w & 1) ? cur.vt[3][ks] : cur.vt[1][ks]), cur.e[ks], y);
                  if (t < ntok) { u32x2 o; o.x = pk2(y[0], y[1]); o.y = pk2(y[2], y[3]); *(u32x2*)(OB + (size_t)(row0 + ci * 64 + t) * BW + h * 256 + sl * 64 + cb * 16 + q * 4) = o; } } }
#pragma unroll
            for (int vb = 0; vb < 4; ++vb) { acc[vb] = acc[vb] * cur.gc;
#pragma unroll
                for (int ks = 0; ks < 2; ++ks) acc[vb] = mma16(cur.kh[ks], cur.vt[vb][ks], acc[vb]); }
            cur = nxt;
        }
#pragma unroll
        for (int vb = 0; vb < 4; ++vb)
#pragma unroll
            for (int jj = 0; jj < 4; ++jj) op[(size_t)(w * 16 + q * 4 + jj) * 256 + sl * 64 + vb * 16 + r] = acc[vb][jj];
        __syncthreads();
    }
}
__device__ __forceinline__ void ph_gla_fin(const Ctx& c, const bf16_t* __restrict__ U, const float* __restrict__ ng, const float* __restrict__ nb, bf16_t* __restrict__ OB) {
    const int lane = c.lane;
    for (int i = c.bid * 8 + c.wave; i < MT * 4; i += c.G * 8) {
        const int row = i >> 2, h = i & 3, cc = h * 256 + lane * 4; bf16_t* p = OB + (size_t)row * BW + cc;
        const u32x2 raw = *(const u32x2*)p; float x[4] = {__uint_as_float(raw.x << 16), __uint_as_float(raw.x & 0xffff0000u), __uint_as_float(raw.y << 16), __uint_as_float(raw.y & 0xffff0000u)};
        const float mean = wave_sum((x[0] + x[1]) + (x[2] + x[3])) * (1.0f / 256.0f); float qq = 0.f;
#pragma unroll
        for (int j = 0; j < 4; ++j) { const float d = x[j] - mean; qq += d * d; }
        const float rstd = rsqrtf(wave_sum(qq) * (1.0f / 256.0f) + 1e-5f);
        const u32x2 gp = *(const u32x2*)(U + (size_t)row * NINP + U_GR + cc); const float gr[4] = {__uint_as_float(gp.x << 16), __uint_as_float(gp.x & 0xffff0000u), __uint_as_float(gp.y << 16), __uint_as_float(gp.y & 0xffff0000u)};
        const f32x4 gg = *(const f32x4*)(ng + cc), bb = *(const f32x4*)(nb + cc); float o[4];
#pragma unroll
        for (int j = 0; j < 4; ++j) o[j] = ((x[j] - mean) * rstd * gg[j] + bb[j]) * gr[j] * sigmoidf_(gr[j]);
        u32x2 ov; ov.x = pk2(o[0], o[1]); ov.y = pk2(o[2], o[3]); *(u32x2*)p = ov;
    }
}

__device__ __forceinline__ void unpack8(const u32x4 w, float (&x)[8]) {
    x[0] = __uint_as_float(w.x << 16); x[1] = __uint_as_float(w.x & 0xffff0000u); x[2] = __uint_as_float(w.y << 16); x[3] = __uint_as_float(w.y & 0xffff0000u);
    x[4] = __uint_as_float(w.z << 16); x[5] = __uint_as_float(w.z & 0xffff0000u); x[6] = __uint_as_float(w.w << 16); x[7] = __uint_as_float(w.w & 0xffff0000u);
}
template <bool ISBF> __device__ __forceinline__ void swa_step(const float (&q)[32], float (&acc)[32], float& m, float& l, const void* kp, const void* vp, float slope, float dist) {
    float s = 0.f;
#pragma unroll
    for (int j = 0; j < 4; ++j) { float x[8];
        if (ISBF) unpack8(*(const u32x4*)((const bf16_t*)kp + j * 8), x);
        else { const f32x4 a = *(const f32x4*)((const float*)kp + j * 8), b = *(const f32x4*)((const float*)kp + j * 8 + 4); x[0] = a[0]; x[1] = a[1]; x[2] = a[2]; x[3] = a[3]; x[4] = b[0]; x[5] = b[1]; x[6] = b[2]; x[7] = b[3]; }
#pragma unroll
        for (int d = 0; d < 8; ++d) s += q[j * 8 + d] * x[d]; }
    s += __shfl_xor(s, 1, 64);
    s = s * 0.125f - slope * dist;
    const float mn = fmaxf(m, s), cc = __expf(m - mn), p = __expf(s - mn);
    l = l * cc + p;
#pragma unroll
    for (int j = 0; j < 4; ++j) { float x[8];
        if (ISBF) unpack8(*(const u32x4*)((const bf16_t*)vp + j * 8), x);
        else { const f32x4 a = *(const f32x4*)((const float*)vp + j * 8), b = *(const f32x4*)((const float*)vp + j * 8 + 4); x[0] = a[0]; x[1] = a[1]; x[2] = a[2]; x[3] = a[3]; x[4] = b[0]; x[5] = b[1]; x[6] = b[2]; x[7] = b[3]; }
#pragma unroll
        for (int d = 0; d < 8; ++d) acc[j * 8 + d] = acc[j * 8 + d] * cc + p * x[d]; }
    m = mn;
}
__device__ __forceinline__ void ph_swa_naive(const Ctx& c, const bf16_t* __restrict__ U, const float* __restrict__ ck, const float* __restrict__ cv, const float* __restrict__ sinks, bf16_t* __restrict__ OB) {
    for (int gid = c.bid * 512 + c.tid; gid < MT * 32; gid += c.G * 512) {
        const int dh = gid & 1, h = (gid >> 1) & 15, row = gid >> 5, kvh = h >> 3, co = kvh * 64 + dh * 32;
        float q[32], acc[32];
#pragma unroll
        for (int j = 0; j < 4; ++j) { float x[8]; unpack8(*(const u32x4*)(U + (size_t)row * NINP + U_SQ + h * 64 + dh * 32 + j * 8), x);
#pragma unroll
            for (int d = 0; d < 8; ++d) { q[j * 8 + d] = x[d]; acc[j * 8 + d] = 0.f; } }
        const float slope = exp2f(-0.5f * (float)(h + 1)); float m = sinks[h], l = 1.0f;
        if (row < MP) {
            const int t = row % PS, base = row - t, lo = t - 128 < 0 ? 0 : t - 128;
            for (int s = lo; s <= t; ++s) { const bf16_t* ur = U + (size_t)(base + s) * NINP;
                swa_step<true>(q, acc, m, l, ur + U_SK + co, ur + U_SV + co, slope, (float)(t - s)); }
        } else {
            const int sq = (row - MP) / SS, i = (row - MP) % SS;
            for (int idx = i; idx <= 128 + i; ++idx) {
                if (idx < 128) { const size_t o = ((size_t)sq * 128 + idx) * 128 + co; swa_step<false>(q, acc, m, l, ck + o, cv + o, slope, (float)(128 + i - idx)); }
                else { const bf16_t* ur = U + (size_t)(MP + sq * SS + idx - 128) * NINP; swa_step<true>(q, acc, m, l, ur + U_SK + co, ur + U_SV + co, slope, (float)(128 + i - idx)); }
            }
        }
        const float inv = 1.0f / l; bf16_t* op = OB + (size_t)row * BW + h * 64 + dh * 32;
#pragma unroll
        for (int j = 0; j < 4; ++j) { u32x4 w; w.x = pk2(acc[j * 8] * inv, acc[j * 8 + 1] * inv); w.y = pk2(acc[j * 8 + 2] * inv, acc[j * 8 + 3] * inv);
            w.z = pk2(acc[j * 8 + 4] * inv, acc[j * 8 + 5] * inv); w.w = pk2(acc[j * 8 + 6] * inv, acc[j * 8 + 7] * inv); *(u32x4*)(op + j * 8) = w; }
    }
}

__device__ __forceinline__ void ph_rwkv_prep(const Ctx& c, const bf16_t* __restrict__ U, const float* __restrict__ shift, const float* __restrict__ mu, const float* __restrict__ w0, const float* __restrict__ w2,
                                             const float* __restrict__ a0, const float* __restrict__ a2, const float* __restrict__ g2, const float* __restrict__ k_k, const float* __restrict__ k_a,
                                             const float* __restrict__ r_k, float* __restrict__ RW) {
    LAS float* xm = (LAS float*)c.lds; LAS float* tw = xm + RWC; LAS float* ad = tw + 64; LAS float* sg = ad + 64;
    const int tid = c.tid;
    float* R = RW; float* WD = RW + (size_t)MPAD * BW; float* K2 = WD + (size_t)MPAD * BW; float* V = K2 + (size_t)MPAD * BW; float* KK = V + (size_t)MPAD * BW;
    float* BV = KK + (size_t)MPAD * BW; float* G = BV + (size_t)MPAD * BW; float* BON = G + (size_t)MPAD * BW;
    for (int row = c.bid; row < MT; row += c.G) {
        const bf16_t* ur = U + (size_t)row * NINP + U_RU; const bf16_t* pr = ur - NINP; const float* ps = nullptr; bool first;
        if (row < MP) first = (row % PS) == 0; else { first = ((row - MP) % SS) == 0; ps = shift + (size_t)((row - MP) / SS) * RWC; }
        for (int cc = tid; cc < RWC; cc += 512) { const float x = bf2f(ur[cc]); const float s = first ? (ps ? ps[cc] : 0.f) : bf2f(pr[cc]); xm[cc] = x + (s - x) * mu[cc]; }
        __syncthreads();
        if (tid < 64) { tw[tid] = tanhf(xm[3072 + tid]); ad[tid] = xm[3136 + tid]; }
        if (tid >= 128 && tid < 256) sg[tid - 128] = sigmoidf_(xm[3200 + tid - 128]);
        __syncthreads();
        for (int qd = 0; qd < 2; ++qd) {
            const int cc = qd * 512 + tid; float accw = w0[cc], acca = a0[cc], accg = 0.f;
#pragma unroll 4
            for (int j = 0; j < 64; ++j) { accw += tw[j] * w2[j * BW + cc]; acca += ad[j] * a2[j * BW + cc]; }
#pragma unroll 4
            for (int j = 0; j < 128; ++j) accg += sg[j] * g2[j * BW + cc];
            const float lw = -softplusf_(-accw) - 0.5f, decay = __expf(-__expf(lw)), a = sigmoidf_(acca);
            const float r = xm[cc], k = xm[1024 + cc], v = xm[2048 + cc];
            const float kkr = k * k_k[cc]; const float ss = wave_sum(kkr * kkr); const float kk = kkr / fmaxf(sqrtf(ss), 1e-12f);
            const float k2 = k * (1.0f + (a - 1.0f) * k_a[cc]); const float rk = wave_sum(r * k2 * r_k[cc]);
            const size_t o = (size_t)row * BW + cc;
            R[o] = r; WD[o] = decay; K2[o] = k2; V[o] = v; KK[o] = kk; BV[o] = kk * a; G[o] = accg; BON[o] = rk * v;
        }
        __syncthreads();
    }
}
__device__ __forceinline__ void ph_rwkv_scan_naive(const Ctx& c, const float* __restrict__ RW, const float* __restrict__ s0, const float* __restrict__ lng, const float* __restrict__ lnb, bf16_t* __restrict__ OB,
                                                   float* __restrict__ outP, float* __restrict__ outS) {
    const float* R = RW; const float* WD = RW + (size_t)MPAD * BW; const float* K2 = WD + (size_t)MPAD * BW; const float* V = K2 + (size_t)MPAD * BW; const float* KK = V + (size_t)MPAD * BW;
    const float* BV = KK + (size_t)MPAD * BW; const float* G = BV + (size_t)MPAD * BW; const float* BON = G + (size_t)MPAD * BW;
    const int lane = c.lane;
    for (int it = 0;; ++it) {
        const int u = (it * 8 + c.wave) * c.G + c.bid;
        if (u >= (PB + SB) * 16) break;
        const int sq = u >> 4, h = u & 15;
        int row0, L; seq_info(sq, row0, L);
        float S[64];
        if (sq >= PB) { const float* p = s0 + (((size_t)(sq - PB) * 16 + h) * 64 + lane) * 64;
#pragma unroll
            for (int j = 0; j < 64; ++j) S[j] = p[j]; }
        else {
#pragma unroll
            for (int j = 0; j < 64; ++j) S[j] = 0.f; }
        const float lg = lng[h * 64 + lane], lb = lnb[h * 64 + lane];
        for (int t = 0; t < L; ++t) {
            const size_t base = (size_t)(row0 + t) * BW + h * 64; const float v = V[base + lane];
            float d = 0.f;
#pragma unroll
            for (int j = 0; j < 64; ++j) d += S[j] * KK[base + j];
            float y = 0.f;
#pragma unroll
            for (int j = 0; j < 64; ++j) { S[j] = S[j] * WD[base + j] - d * BV[base + j] + v * K2[base + j]; y += S[j] * R[base + j]; }
            const float mean = wave_sum(y) * (1.0f / 64.0f), dy = y - mean, var = wave_sum(dy * dy) * (1.0f / 64.0f);
            const float yn = dy * rsqrtf(var + 64e-5f) * lg + lb;
            OB[base + lane] = f2bf((yn + BON[base + lane]) * G[base + lane]);
        }
        float* op = (sq < PB ? outP + (((size_t)sq * 16 + h) * 64 + lane) * 64 : outS + (((size_t)(sq - PB) * 16 + h) * 64 + lane) * 64);
#pragma unroll
        for (int j = 0; j < 64; ++j) op[j] = S[j];
    }
}
__device__ __forceinline__ void ph_memattn_sample(const Ctx& c, const bf16_t* __restrict__ U, const float* __restrict__ mk, const float* __restrict__ mv, bf16_t* __restrict__ OB) {
    LAS float* qs = (LAS float*)c.lds; LAS float* ps = qs + 2 * 4 * 256;
    const int hh = c.tid >> 8, vt = c.tid & 255, lane = c.lane;
    for (int u = c.bid; u < SB * 2; u += c.G) {
        const int sq = u >> 1, h = (u & 1) * 2 + hh;
#pragma unroll
        for (int t = 0; t < 4; ++t) qs[(hh * 4 + t) * 256 + vt] = bf2f(U[(size_t)(MP + sq * SS + t) * NINP + U_MQ + h * 256 + vt]) * 0.0625f;
        __syncthreads();
        { const float* kr = mk + (((size_t)sq * MEMT + vt) * 4 + h) * 256; float s[4] = {0.f, 0.f, 0.f, 0.f};
            for (int d = 0; d < 256; d += 4) { const f32x4 kv = *(const f32x4*)(kr + d);
#pragma unroll
                for (int t = 0; t < 4; ++t) { const LAS float* qq = qs + (hh * 4 + t) * 256 + d; s[t] += kv[0] * qq[0] + kv[1] * qq[1] + kv[2] * qq[2] + kv[3] * qq[3]; } }
#pragma unroll
            for (int t = 0; t < 4; ++t) ps[(hh * 4 + t) * 256 + vt] = s[t]; }
        __syncthreads();
        { LAS float* pr = ps + c.wave * 256; float x[4]; float mx = -3.0e38f;
#pragma unroll
            for (int j = 0; j < 4; ++j) { x[j] = pr[lane + 64 * j]; mx = fmaxf(mx, x[j]); }
            mx = wave_max(mx); float s = 0.f;
#pragma unroll
            for (int j = 0; j < 4; ++j) { x[j] = __expf(x[j] - mx); s += x[j]; }
            const float inv = 1.0f / wave_sum(s);
#pragma unroll
            for (int j = 0; j < 4; ++j) pr[lane + 64 * j] = x[j] * inv; }
        __syncthreads();
        { float o[4] = {0.f, 0.f, 0.f, 0.f}; const float* vr = mv + ((size_t)sq * MEMT * 4 + h) * 256 + vt;
            for (int m = 0; m < MEMT; ++m) { const float vv = vr[(size_t)m * 1024];
#pragma unroll
                for (int t = 0; t < 4; ++t) o[t] += ps[(hh * 4 + t) * 256 + m] * vv; }
#pragma unroll
            for (int t = 0; t < 4; ++t) OB[(size_t)(MP + sq * SS + t) * BW + h * 256 + vt] = f2bf(o[t]); }
        __syncthreads();
    }
}

constexpr int LDS_BAR_OFF = pg8::STAGE_BYTES;
constexpr int LDS_BYTES = pg8::STAGE_BYTES + 64;
struct Args { const float* in[37]; float* out; unsigned char* ws; };

typedef pg8::Gemm<DM, DM, DM, 2, 8, NL, 1, false, 0, 0, (long)DM * DM, 0> GemmMem;
typedef pg8::Gemm<DM, DM, DM, MPAD / 256, NINP / 256> GemmIn;
typedef pg8::Gemm<NINP, 1024, 256, PS / 256, 1, 8, 4, false, (long)PS * NINP, 256, 256 * 1024, 256> GemmScore;
typedef pg8::Gemm<256, 256, 256, PS / 256, 1, 8, 4, false, (long)4 * 4096 * 256, (long)4096 * 256, 4 * 65536, 65536> GemmPV;
typedef pg8::Gemm<BW, BW, BW, MPAD / 256, DM / 256, 4, 1, true, (long)MPAD * BW, 0, (long)DM * BW, 0> GemmBranch;
typedef pg8::Gemm<DM, DM, DM, MPAD / 256, DM / 256> GemmOut;
typedef pg8::Gemm<DM, DM, DM, MPAD / 256, 2 * DFF / 256> GemmGU;
typedef pg8::Gemm<DFF, DFF, DFF, MPAD / 256, DM / 256> GemmDown;
template <class GT> __device__ __forceinline__ GT mk_gemm(const Ctx& c, const bf16_t* A, const bf16_t* B) { GT g; g.A = A; g.B = B; g.G = c.G; g.c = c.bid; return g; }

template <int OFF> __device__ __forceinline__ unsigned long long karg_u64(unsigned long long kargs) {
    unsigned long long p; asm volatile("s_load_dwordx2 %0, %1, %2\n\ts_waitcnt lgkmcnt(0)" : "=s"(p) : "s"(kargs), "n"(OFF) : "memory"); return p;
}
#define INP(k) ((const float*)karg_u64<(k) * 8>(kargs))
#define OUTP() ((float*)karg_u64<37 * 8>(kargs))
#define WSP() ((unsigned char*)karg_u64<38 * 8>(kargs))

__global__ void __launch_bounds__(512, 2) mega_fwd(Args a_unused) {
    extern __shared__ __attribute__((aligned(16))) unsigned char lds_raw[];
    const unsigned long long kargs = (unsigned long long)__builtin_amdgcn_kernarg_segment_ptr();
    Ctx c0; c0.tid = threadIdx.x; c0.lane = c0.tid & 63; c0.wave = __builtin_amdgcn_readfirstlane(c0.tid >> 6); c0.bid = blockIdx.x; c0.G = gridDim.x; c0.lds = (LAS unsigned char*)lds_raw;
    if (c0.tid < 4) ((LAS unsigned*)(c0.lds + LDS_BAR_OFF))[c0.tid] = 0u;
    __syncthreads();
    const XcdBarrier bar = xcd_barrier_post((unsigned*)(WSP() + WS_CTL), (volatile LAS unsigned*)(c0.lds + LDS_BAR_OFF));

    { const Ctx c = fresh(c0); unsigned char* ws = WSP();
      ph_wprep(c, INP(10), (bf16_t*)(ws + WS_WIN), DM, NIN, NINP, 1, NL, (size_t)DM * NIN, (size_t)NINP * DM);
      ph_wprep(c, INP(28), (bf16_t*)(ws + WS_WMEM), DM, DM, DM, 0, NL, (size_t)DM * DM, (size_t)DM * DM);
      ph_wprep(c, INP(29), (bf16_t*)(ws + WS_WBR), BW, DM, DM, 0, NL * 4, (size_t)BW * DM, (size_t)DM * BW);
      ph_wprep(c, INP(30), (bf16_t*)(ws + WS_WOUT), DM, DM, DM, 0, NL, (size_t)DM * DM, (size_t)DM * DM);
      ph_wprep(c, INP(33), (bf16_t*)(ws + WS_WGU), DM, 2 * DFF, 2 * DFF, 2, NL, (size_t)DM * 2 * DFF, (size_t)2 * DFF * DM);
      ph_wprep(c, INP(34), (bf16_t*)(ws + WS_WDN), DFF, DM, DM, 0, NL, (size_t)DFF * DM, (size_t)DM * DFF);
      ph_xprep(c, INP(0), INP(1), INP(2), (float*)(ws + WS_HF), (bf16_t*)(ws + WS_HB), (bf16_t*)(ws + WS_MEMB)); }
    xcd_barrier(bar);
    { const Ctx c = fresh(c0); unsigned char* ws = WSP(); float* out = OUTP();
      GemmMem g = mk_gemm<GemmMem>(c, (const bf16_t*)(ws + WS_MEMB), (const bf16_t*)(ws + WS_WMEM));
      pg8::EpiMem E; E.outK = out + O_MKP; E.outV = out + O_MVP; E.kb = (bf16_t*)(ws + WS_MKB); E.vt = (bf16_t*)(ws + WS_MVT); pg8::gemm_phase<GemmMem, pg8::EpiMem, true, true>(c.lds, c.tid, g, E); }

    for (int l = 0; l < NL; ++l) {
        { const Ctx c = fresh(c0); unsigned char* ws = WSP();
          GemmIn g = mk_gemm<GemmIn>(c, (const bf16_t*)(ws + WS_HB), (const bf16_t*)(ws + WS_WIN) + (size_t)l * NINP * DM);
          pg8::EpiBf16 E; E.O = (bf16_t*)(ws + WS_U); E.zs = 0; E.ldc = NINP; E.pad = 0; pg8::gemm_phase<GemmIn, pg8::EpiBf16, true, true>(c.lds, c.tid, g, E); }
        xcd_barrier(bar);
        { const Ctx c = fresh(c0); unsigned char* ws = WSP(); float* out = OUTP(); const bf16_t* U = (const bf16_t*)(ws + WS_U); bf16_t* BR = (bf16_t*)(ws + WS_BR);
          (void)out; (void)BR;
          ph_gla_pre(c, U, INP(12) + (size_t)l * 16 * 512, INP(13) + (size_t)l * 512, (bf16_t*)(ws + WS_GLQD), (bf16_t*)(ws + WS_GLKH), (bf16_t*)(ws + WS_GLE), (bf16_t*)(ws + WS_GLVT), (float*)(ws + WS_GLGC)); }
        { const Ctx c = fresh(c0); unsigned char* ws = WSP();
          ph_rwkv_prep(c, (const bf16_t*)(ws + WS_U), INP(9) + (size_t)l * SB * RWC, INP(17) + (size_t)l * RWC, INP(18) + (size_t)l * BW, INP(19) + (size_t)l * 64 * BW, INP(20) + (size_t)l * BW, INP(21) + (size_t)l * 64 * BW,
                       INP(22) + (size_t)l * 128 * BW, INP(23) + (size_t)l * BW, INP(24) + (size_t)l * BW, INP(25) + (size_t)l * BW, (float*)(ws + WS_RW)); }
        { const Ctx c = fresh(c0); unsigned char* ws = WSP();
          ph_swa_naive(c, (const bf16_t*)(ws + WS_U), INP(3) + (size_t)l * SB * 16384, INP(4) + (size_t)l * SB * 16384, INP(16) + (size_t)l * 16, (bf16_t*)(ws + WS_BR) + (size_t)MPAD * BW); }
        { const Ctx c = fresh(c0); unsigned char* ws = WSP();
          ph_copy_outs(c, (const bf16_t*)(ws + WS_U), INP(3) + (size_t)l * SB * 16384, INP(4) + (size_t)l * SB * 16384, OUTP(), l); }
        { const Ctx c = fresh(c0); unsigned char* ws = WSP();
          ph_memattn_sample(c, (const bf16_t*)(ws + WS_U), INP(5) + (size_t)l * SB * MEMT * 1024, INP(6) + (size_t)l * SB * MEMT * 1024, (bf16_t*)(ws + WS_BR) + (size_t)3 * MPAD * BW); }
        { const Ctx c = fresh(c0); unsigned char* ws = WSP();
          GemmScore g = mk_gemm<GemmScore>(c, (const bf16_t*)(ws + WS_U) + U_MQ, (const bf16_t*)(ws + WS_MKB) + (size_t)l * 512 * 1024);
          pg8::EpiScore E; E.SC = (float*)(ws + WS_SC); pg8::gemm_phase<GemmScore, pg8::EpiScore, true, true>(c.lds, c.tid, g, E); }
        xcd_barrier(bar);
        { const Ctx c = fresh(c0); unsigned char* ws = WSP(); float* out = OUTP();
          ph_rwkv_scan_naive(c, (const float*)(ws + WS_RW), INP(8) + (size_t)l * SB * 16 * 4096, INP(26) + (size_t)l * BW, INP(27) + (size_t)l * BW, (bf16_t*)(ws + WS_BR) + (size_t)2 * MPAD * BW,
                             out + O_RWP + (size_t)l * PB * 16 * 4096, out + O_RWS + (size_t)l * SB * 16 * 4096); }
        { const Ctx c = fresh(c0); unsigned char* ws = WSP(); float* out = OUTP();
          ph_gla_seq(c, 32, (const bf16_t*)(ws + WS_GLQD), (const bf16_t*)(ws + WS_GLKH), (const bf16_t*)(ws + WS_GLE), (const bf16_t*)(ws + WS_GLVT), (const float*)(ws + WS_GLGC),
                     INP(7) + (size_t)l * SB * 4 * 32768, out + O_GLAP + (size_t)l * PB * 4 * 32768, out + O_GLAS + (size_t)l * SB * 4 * 32768, (bf16_t*)(ws + WS_BR)); }
        { const Ctx c = fresh(c0); unsigned char* ws = WSP(); ph_softmax256(c, (const float*)(ws + WS_SC), (bf16_t*)(ws + WS_PB), 8 * 4096); }
        xcd_barrier(bar);
        { const Ctx c = fresh(c0); unsigned char* ws = WSP(); ph_gla_fin(c, (const bf16_t*)(ws + WS_U), INP(14) + (size_t)l * BW, INP(15) + (size_t)l * BW, (bf16_t*)(ws + WS_BR)); }
        { const Ctx c = fresh(c0); unsigned char* ws = WSP();
          GemmPV g = mk_gemm<GemmPV>(c, (const bf16_t*)(ws + WS_PB), (const bf16_t*)(ws + WS_MVT) + (size_t)l * 8 * 65536);
          pg8::EpiPV E; E.O = (bf16_t*)(ws + WS_BR) + (size_t)3 * MPAD * BW; pg8::gemm_phase<GemmPV, pg8::EpiPV, true, true>(c.lds, c.tid, g, E); }
        xcd_barrier(bar);
        { const Ctx c = fresh(c0); unsigned char* ws = WSP();
          GemmBranch g = mk_gemm<GemmBranch>(c, (const bf16_t*)(ws + WS_BR), (const bf16_t*)(ws + WS_WBR) + (size_t)l * 4 * DM * BW);
          pg8::EpiMerge E; E.MG = (float*)(ws + WS_MG); E.MGB = (bf16_t*)(ws + WS_MGB); E.U = (const bf16_t*)(ws + WS_U); E.gate_b = INP(11) + (size_t)l * 4 * DM; pg8::gemm_phase<GemmBranch, pg8::EpiMerge, true, true>(c.lds, c.tid, g, E); }
        xcd_barrier(bar);
        { const Ctx c = fresh(c0); unsigned char* ws = WSP();
          GemmOut g = mk_gemm<GemmOut>(c, (const bf16_t*)(ws + WS_MGB), (const bf16_t*)(ws + WS_WOUT) + (size_t)l * DM * DM);
          pg8::EpiRes E; E.R = (const float*)(ws + WS_HF); E.Y = (float*)(ws + WS_Y); pg8::gemm_phase<GemmOut, pg8::EpiRes, true, true>(c.lds, c.tid, g, E); }
        xcd_barrier(bar);
        { const Ctx c = fresh(c0); unsigned char* ws = WSP(); ph_ln(c, (const float*)(ws + WS_Y), INP(31) + (size_t)l * DM, INP(32) + (size_t)l * DM, (float*)(ws + WS_X1F), (bf16_t*)(ws + WS_X1B), nullptr, MPAD, 0); }
        xcd_barrier(bar);
        { const Ctx c = fresh(c0); unsigned char* ws = WSP();
          GemmGU g = mk_gemm<GemmGU>(c, (const bf16_t*)(ws + WS_X1B), (const bf16_t*)(ws + WS_WGU) + (size_t)l * 2 * DFF * DM);
          pg8::EpiSwiGLU E; E.O = (bf16_t*)(ws + WS_ACT); pg8::gemm_phase<GemmGU, pg8::EpiSwiGLU, true, true>(c.lds, c.tid, g, E); }
        xcd_barrier(bar);
        { const Ctx c = fresh(c0); unsigned char* ws = WSP();
          GemmDown g = mk_gemm<GemmDown>(c, (const bf16_t*)(ws + WS_ACT), (const bf16_t*)(ws + WS_WDN) + (size_t)l * DM * DFF);
          pg8::EpiRes E; E.R = (const float*)(ws + WS_X1F); E.Y = (float*)(ws + WS_Y); pg8::gemm_phase<GemmDown, pg8::EpiRes, true, true>(c.lds, c.tid, g, E); }
        xcd_barrier(bar);
        { const Ctx c = fresh(c0); unsigned char* ws = WSP(); float* out = OUTP(); ph_ln(c, (const float*)(ws + WS_Y), INP(35) + (size_t)l * DM, INP(36) + (size_t)l * DM, (float*)(ws + WS_HF), (bf16_t*)(ws + WS_HB), l == NL - 1 ? out : nullptr, MPAD, MT); }
        xcd_barrier(bar);
    }
}

extern "C" void kernel_launch(void* const* d_in, const int* in_sizes, int n_in, void* d_out, int out_size, void* d_ws, size_t ws_size, hipStream_t stream) {
    static int grid = 0;
    if (grid == 0) {
        if (n_in != 37 || (size_t)out_size != O_END || ws_size < WS_END) { fprintf(stderr, "kernel_launch: unexpected sizes (n_in %d out %d ws %zu need %zu)\n", n_in, out_size, ws_size, (size_t)WS_END); grid = -1; return; }
        int dev = 0, cus = 0;
        if (hipGetDevice(&dev) != hipSuccess || hipDeviceGetAttribute(&cus, hipDeviceAttributeMultiprocessorCount, dev) != hipSuccess) { grid = -1; return; }
        if (hipFuncSetAttribute((const void*)mega_fwd, hipFuncAttributeMaxDynamicSharedMemorySize, LDS_BYTES) != hipSuccess) { fprintf(stderr, "kernel_launch: hipFuncSetAttribute failed\n"); grid = -1; return; }
        int per_cu = 0;
        if (hipOccupancyMaxActiveBlocksPerMultiprocessor(&per_cu, (const void*)mega_fwd, 512, LDS_BYTES) != hipSuccess || per_cu < 1) { fprintf(stderr, "kernel_launch: occupancy query says %d\n", per_cu); }
        (void)hipGetLastError();
        grid = cus;
    }
    if (grid < 0) return;
    (void)hipMemsetAsync((unsigned char*)d_ws + WS_CTL, 0, XCD_BAR_WORDS * sizeof(unsigned), stream);
    Args a; memset(&a, 0, sizeof a);
    for (int i = 0; i < 37; ++i) a.in[i] = (const float*)d_in[i];
    a.out = (float*)d_out; a.ws = (unsigned char*)d_ws;
    hipLaunchKernelGGL(mega_fwd, dim3(grid), dim3(512), LDS_BYTES, stream, a);
}
```

```cpp
#include <hip/hip_runtime.h>
#include <cstdio>
#include <cstdint>
#include <cstring>

#define LAS __attribute__((address_space(3)))
typedef unsigned short bf16_t;
typedef short bf16x8 __attribute__((ext_vector_type(8)));
typedef float f32x4 __attribute__((ext_vector_type(4)));
typedef float f32x2 __attribute__((ext_vector_type(2)));
typedef unsigned u32x4 __attribute__((ext_vector_type(4)));
typedef unsigned u32x2 __attribute__((ext_vector_type(2)));

constexpr int DM = 2048, NL = 4;
constexpr int PB = 2, PS = 4096, MP = PB * PS;
constexpr int SB = 32, SS = 4, MS = SB * SS;
constexpr int MT = MP + MS;
constexpr int MPAD = 8448;
constexpr int NIN = 16912, NINP = 17152;
constexpr int U_GQ = 0, U_GK = 512, U_GV = 1024, U_GR = 2048, U_GA = 3072, U_SQ = 3328, U_SK = 4352, U_SV = 4480, U_RU = 4608, U_MQ = 7936, U_GP = 8960;
constexpr int RWC = 3328, BW = 1024, DFF = 5632, MEMT = 256;
constexpr float ALPHA = 1.681792830507429f;

constexpr size_t O_YP = 0;
constexpr size_t O_YS = O_YP + (size_t)MP * DM;
constexpr size_t O_SWKP = O_YS + (size_t)MS * DM;
constexpr size_t O_SWVP = O_SWKP + (size_t)NL * PB * 128 * 128;
constexpr size_t O_MKP = O_SWVP + (size_t)NL * PB * 128 * 128;
constexpr size_t O_MVP = O_MKP + (size_t)NL * PB * 256 * 1024;
constexpr size_t O_GLAP = O_MVP + (size_t)NL * PB * 256 * 1024;
constexpr size_t O_RWP = O_GLAP + (size_t)NL * PB * 4 * 128 * 256;
constexpr size_t O_RSP = O_RWP + (size_t)NL * PB * 16 * 64 * 64;
constexpr size_t O_SWKS = O_RSP + (size_t)NL * PB * RWC;
constexpr size_t O_SWVS = O_SWKS + (size_t)NL * SB * 128 * 128;
constexpr size_t O_GLAS = O_SWVS + (size_t)NL * SB * 128 * 128;
constexpr size_t O_RWS = O_GLAS + (size_t)NL * SB * 4 * 128 * 256;
constexpr size_t O_RSS = O_RWS + (size_t)NL * SB * 16 * 64 * 64;
constexpr size_t O_END = O_RSS + (size_t)NL * SB * RWC;
static_assert(O_END == 52881408, "output size");

constexpr size_t al256(size_t x) { return (x + 255) & ~(size_t)255; }
constexpr size_t WS_CTL = 0;
constexpr size_t WS_WIN = 65536;
constexpr size_t WS_WMEM = WS_WIN + (size_t)NL * NINP * DM * 2;
constexpr size_t WS_WBR = WS_WMEM + (size_t)NL * DM * DM * 2;
constexpr size_t WS_WOUT = WS_WBR + (size_t)NL * 4 * DM * BW * 2;
constexpr size_t WS_WGU = WS_WOUT + (size_t)NL * DM * DM * 2;
constexpr size_t WS_WDN = WS_WGU + (size_t)NL * 2 * DFF * DM * 2;
constexpr size_t WS_HF = WS_WDN + (size_t)NL * DM * DFF * 2;
constexpr size_t WS_HB = WS_HF + (size_t)MPAD * DM * 4;
constexpr size_t WS_U = WS_HB + (size_t)MPAD * DM * 2;
constexpr size_t WS_BR = WS_U + (size_t)MPAD * NINP * 2;
constexpr size_t WS_MG = WS_BR + (size_t)4 * MPAD * BW * 2;
constexpr size_t WS_MGB = WS_MG + (size_t)MPAD * DM * 4;
constexpr size_t WS_Y = WS_MGB + (size_t)MPAD * DM * 2;
constexpr size_t WS_X1F = WS_Y + (size_t)MPAD * DM * 4;
constexpr size_t WS_X1B = WS_X1F + (size_t)MPAD * DM * 4;
constexpr size_t WS_ACT = WS_X1B + (size_t)MPAD * DM * 2;
constexpr size_t WS_MEMB = WS_ACT + (size_t)MPAD * DFF * 2;
constexpr size_t WS_MKB = WS_MEMB + (size_t)512 * DM * 2;
constexpr size_t WS_MVT = WS_MKB + (size_t)NL * 512 * 1024 * 2;
constexpr size_t WS_SC = WS_MVT + (size_t)NL * 8 * 256 * 256 * 2;
constexpr size_t WS_PB = WS_SC + (size_t)8 * 4096 * 256 * 4;
constexpr size_t WS_RW = WS_PB + (size_t)8 * 4096 * 256 * 2;
constexpr size_t RW_ARR = (size_t)MPAD * BW * 4;
constexpr int GL_NCH = 512 + 128;
constexpr size_t WS_GLQD = WS_RW + 8 * RW_ARR;
constexpr size_t WS_GLKH = WS_GLQD + (size_t)GL_NCH * 8192 * 2;
constexpr size_t WS_GLE = WS_GLKH + (size_t)GL_NCH * 8192 * 2;
constexpr size_t WS_GLVT = WS_GLE + (size_t)GL_NCH * 4096 * 2;
constexpr size_t WS_GLGC = WS_GLVT + (size_t)GL_NCH * 16384 * 2;
constexpr size_t WS_END = WS_GLGC + (size_t)GL_NCH * 128 * 4;

__device__ __forceinline__ float bf2f(bf16_t b) { return __uint_as_float(((unsigned)b) << 16); }
__device__ __forceinline__ bf16_t f2bf(float f) { unsigned u = __float_as_uint(f); u += 0x7FFFu + ((u >> 16) & 1u); return (bf16_t)(u >> 16); }
__device__ __forceinline__ unsigned pk2(float lo, float hi) { return (unsigned)f2bf(lo) | ((unsigned)f2bf(hi) << 16); }
__device__ __forceinline__ float wave_sum(float v) {
#pragma unroll
    for (int o = 32; o > 0; o >>= 1) v += __shfl_xor(v, o, 64);
    return v;
}
__device__ __forceinline__ float wave_max(float v) {
#pragma unroll
    for (int o = 32; o > 0; o >>= 1) v = fmaxf(v, __shfl_xor(v, o, 64));
    return v;
}
__device__ __forceinline__ float sigmoidf_(float x) { return 1.0f / (1.0f + __expf(-x)); }
__device__ __forceinline__ float softplusf_(float x) { return fmaxf(x, 0.f) + log1pf(__expf(-fabsf(x))); }

namespace pg8 {
constexpr int BM = 256, BK = 64, HALF = 128, HTB = HALF * BK * 2, STAGE_BYTES = 8 * HTB, NXCD = 8, WGM = 8;
__host__ __device__ __forceinline__ int lds_byte(int r, int c) { const int st = (r >> 4) * 2 + (c >> 5), rr = r & 15, cc = c & 31, ob = rr * 64 + cc * 2; return st * 1024 + (ob ^ (((ob >> 9) & 1) << 5)); }
__host__ __device__ __forceinline__ void stage_rc(int b, int& R, int& C) { const int st = b / 1024, sb = b % 1024, swz = sb ^ (((sb >> 9) & 1) << 5); R = (st >> 1) * 16 + swz / 64; C = (st & 1) * 32 + (swz % 64) / 2; }
__host__ __device__ __forceinline__ int perm32(int rho) { const int n = rho >> 4, i = rho & 15; return 8 * (i >> 2) + 4 * n + (i & 3); }

struct Unit { int pm, pn, z; };
template <int LDA_, int LDB_, int K_, int NM_, int NN_, int NZ_ = 1, int NZH_ = 1, bool ZINNER_ = false, long ZSAB_ = 0, long ZSAH_ = 0, long ZSBB_ = 0, long ZSBH_ = 0>
struct Gemm {
    static constexpr int LDA = LDA_, LDB = LDB_, K = K_, NM = NM_, NN = NN_, NZ = NZ_, NZH = NZH_; static constexpr bool ZINNER = ZINNER_;
    const bf16_t* A; const bf16_t* B; int G, c;
    __device__ __forceinline__ bool next(int i, Unit& u) const {
        constexpr int nt = NM * NN; int L, z;
        if (ZINNER) { const int it = i / NZ; z = i - it * NZ; const long LL = (long)it * G + c; if (LL >= nt) return false; L = (int)LL; }
        else { const long LL = (long)i * G + c; if (LL >= (long)nt * NZ) return false; z = (int)(LL / nt); L = (int)(LL - (long)z * nt); }
        int wgid = L; { constexpr int q = nt / NXCD, r = nt % NXCD; const int xcd = wgid % NXCD, off = wgid / NXCD; wgid = (xcd < r ? xcd * (q + 1) : r * (q + 1) + (xcd - r) * q) + off; }
        constexpr int nig = WGM * NN; const int gid = wgid / nig, fm = gid * WGM, gsz = (NM - fm) < WGM ? (NM - fm) : WGM;
        u.pm = fm + ((wgid % nig) % gsz); u.pn = (wgid % nig) / gsz; u.z = z; return true;
    }
    __device__ __forceinline__ const char* a_base(const Unit& u) const { const int zb = u.z / NZH, zh = u.z - zb * NZH; return (const char*)(A + zb * ZSAB_ + zh * ZSAH_ + (long)u.pm * BM * LDA); }
    __device__ __forceinline__ const char* b_base(const Unit& u) const { const int zb = u.z / NZH, zh = u.z - zb * NZH; return (const char*)(B + zb * ZSBB_ + zh * ZSBH_ + (long)u.pn * BM * LDB); }
};

template <class GT, class Epi, bool ALIGN_EPI = true, bool SP2 = true>
__device__ __forceinline__ void gemm_phase(LAS unsigned char* lds, const int tid, const GT& g, const Epi& E) {
    const int wid = __builtin_amdgcn_readfirstlane(tid >> 6), lane = tid & 63, wr = wid >> 2, wc = wid & 3, fr = lane & 15, fq = lane >> 4;
    constexpr int nt = GT::K / BK;
    unsigned voffA[2], voffB[2];
#pragma unroll
    for (int i = 0; i < 2; ++i) { int R, C; stage_rc(tid * 16 + i * 8192, R, C); const int Rb = Epi::PERM ? ((R & ~31) + perm32(R & 31)) : R;
        voffA[i] = (unsigned)(R * GT::LDA + C) * 2u; voffB[i] = (unsigned)(Rb * GT::LDB + C) * 2u; }
    constexpr size_t kstep = (size_t)(BK * 2);
    constexpr size_t hstepA = (size_t)HALF * GT::LDA * 2, hstepB = (size_t)HALF * GT::LDB * 2;
    const unsigned ldsw = (unsigned)wid * 1024u;
    const int aoff = lds_byte(wr * 64 + fr, fq * 8), boff = lds_byte(wc * 32 + fr, fq * 8);
#define PG8_SA(b, h) (((b) * 2 + (h)) * HTB)
#define PG8_SB(b, h) ((4 + (b) * 2 + (h)) * HTB)
#define PG8_STAGE(bufoff, gbase, voff) do { _Pragma("unroll") for (int _i = 0; _i < 2; ++_i) \
        __builtin_amdgcn_global_load_lds((const unsigned*)((const char*)(gbase) + (voff)[_i]), (LAS unsigned*)(lds + (bufoff) + ldsw + _i * 8192), 16, 0, 0); } while (0)
#define PG8_LDA(dst, b, h) do { _Pragma("unroll") for (int m = 0; m < 4; ++m) _Pragma("unroll") for (int k = 0; k < 2; ++k) dst[m][k] = *(const LAS bf16x8*)(lds + PG8_SA(b, h) + aoff + m * 2048 + k * 1024); } while (0)
#define PG8_LDB(dst, b, h) do { _Pragma("unroll") for (int n = 0; n < 2; ++n) _Pragma("unroll") for (int k = 0; k < 2; ++k) dst[n][k] = *(const LAS bf16x8*)(lds + PG8_SB(b, h) + boff + n * 2048 + k * 1024); } while (0)
#define PG8_MMA(ai, bj, At, Bt) do { __builtin_amdgcn_s_setprio(1); _Pragma("unroll") for (int m = 0; m < 4; ++m) _Pragma("unroll") for (int n = 0; n < 2; ++n) _Pragma("unroll") for (int k = 0; k < 2; ++k) \
        acc[ai][bj][m][n] = __builtin_amdgcn_mfma_f32_16x16x32_bf16(Bt[n][k], At[m][k], acc[ai][bj][m][n], 0, 0, 0); __builtin_amdgcn_s_setprio(0); } while (0)
#define PG8_WAIT_V(n) asm volatile("s_waitcnt vmcnt(" #n ")" ::: "memory")
#define PG8_WAIT_L(n) asm volatile("s_waitcnt lgkmcnt(" #n ")" ::: "memory")
#define PG8_BAR __builtin_amdgcn_s_barrier()
#define PG8_SCHED __builtin_amdgcn_sched_barrier(0)
    Unit cur, nxt; int ui = 0;
    if (!g.next(0, cur)) return;
    f32x4 acc[2][2][4][2];
#pragma unroll
    for (int a = 0; a < 2; ++a)
#pragma unroll
        for (int b = 0; b < 2; ++b)
#pragma unroll
            for (int m = 0; m < 4; ++m)
#pragma unroll
                for (int n = 0; n < 2; ++n) acc[a][b][m][n] = (f32x4){0.f, 0.f, 0.f, 0.f};
    bf16x8 At[4][2], B0[2][2], B1[2][2];
    const char* cA = g.a_base(cur); const char* cB = g.b_base(cur);
    if constexpr (SP2) {
        PG8_STAGE(PG8_SB(0, 0), cB, voffB); PG8_STAGE(PG8_SB(0, 1), cB + hstepB, voffB); PG8_STAGE(PG8_SA(0, 0), cA, voffA); PG8_STAGE(PG8_SA(0, 1), cA + hstepA, voffA);
        if (wr == 1) PG8_BAR;
        PG8_WAIT_V(2); PG8_BAR;
        PG8_STAGE(PG8_SB(1, 0), cB + kstep, voffB); PG8_STAGE(PG8_SA(1, 0), cA + kstep, voffA); PG8_STAGE(PG8_SB(1, 1), cB + hstepB + kstep, voffB);
        PG8_WAIT_V(6); PG8_BAR;
    } else {
        PG8_STAGE(PG8_SB(0, 0), cB, voffB); PG8_STAGE(PG8_SA(0, 0), cA, voffA); PG8_STAGE(PG8_SB(0, 1), cB + hstepB, voffB); PG8_STAGE(PG8_SA(0, 1), cA + hstepA, voffA);
        if (wr == 1) PG8_BAR;
        PG8_WAIT_V(4); PG8_BAR;
        PG8_STAGE(PG8_SB(1, 0), cB + kstep, voffB); PG8_STAGE(PG8_SA(1, 0), cA + kstep, voffA); PG8_STAGE(PG8_SB(1, 1), cB + hstepB + kstep, voffB);
        PG8_WAIT_V(6); PG8_BAR;
    }
    for (;;) {
        const bool has_next = g.next(ui + 1, nxt);
        const char* nA = has_next ? g.a_base(nxt) : cA; const char* nB = has_next ? g.b_base(nxt) : cB;
#pragma unroll 1
        for (int t = 0; t < nt; t += 2) {
            const bool last = (t == nt - 2);
            const char* a1 = cA + (size_t)(t + 1) * kstep;
            const char* a2 = last ? nA : cA + (size_t)(t + 2) * kstep; const char* b2 = last ? nB : cB + (size_t)(t + 2) * kstep;
            const char* a3 = a2 + kstep; const char* b3 = b2 + kstep;
            if constexpr (SP2) {
            PG8_LDB(B0, 0, 0); PG8_LDB(B1, 0, 1); PG8_SCHED; PG8_LDA(At, 0, 0); PG8_STAGE(PG8_SA(1, 1), a1 + hstepA, voffA);
            PG8_WAIT_V(8); PG8_WAIT_L(0); PG8_BAR; PG8_MMA(0, 0, At, B0); PG8_MMA(0, 1, At, B1); PG8_BAR; PG8_SCHED;
            PG8_LDA(At, 0, 1); PG8_STAGE(PG8_SB(0, 0), b2, voffB); PG8_STAGE(PG8_SB(0, 1), b2 + hstepB, voffB); PG8_STAGE(PG8_SA(0, 0), a2, voffA);
            PG8_WAIT_V(8); PG8_WAIT_L(0); PG8_BAR; PG8_MMA(1, 0, At, B0); PG8_MMA(1, 1, At, B1); PG8_BAR; PG8_SCHED;
            PG8_LDB(B0, 1, 0); PG8_LDB(B1, 1, 1); PG8_SCHED; PG8_LDA(At, 1, 0); PG8_STAGE(PG8_SA(0, 1), a2 + hstepA, voffA);
            PG8_WAIT_V(8); PG8_WAIT_L(0); PG8_BAR; PG8_MMA(0, 0, At, B0); PG8_MMA(0, 1, At, B1); PG8_BAR; PG8_SCHED;
            PG8_LDA(At, 1, 1); PG8_STAGE(PG8_SB(1, 0), b3, voffB); PG8_STAGE(PG8_SB(1, 1), b3 + hstepB, voffB); PG8_STAGE(PG8_SA(1, 0), a3, voffA);
            PG8_WAIT_V(8); PG8_WAIT_L(0); PG8_BAR; PG8_MMA(1, 0, At, B0); PG8_MMA(1, 1, At, B1); PG8_BAR; PG8_SCHED;
            } else {
            PG8_LDB(B0, 0, 0); PG8_SCHED; PG8_LDA(At, 0, 0); PG8_STAGE(PG8_SA(1, 1), a1 + hstepA, voffA);
            PG8_WAIT_L(8); PG8_BAR; PG8_WAIT_L(0); PG8_MMA(0, 0, At, B0); PG8_BAR; PG8_SCHED;
            PG8_LDB(B1, 0, 1); PG8_STAGE(PG8_SB(0, 0), b2, voffB);
            PG8_BAR; PG8_WAIT_L(0); PG8_MMA(0, 1, At, B1); PG8_BAR;
            PG8_LDA(At, 0, 1); PG8_STAGE(PG8_SA(0, 0), a2, voffA);
            PG8_BAR; PG8_WAIT_L(0); PG8_MMA(1, 0, At, B0); PG8_BAR; PG8_SCHED;
            PG8_STAGE(PG8_SB(0, 1), b2 + hstepB, voffB);
            PG8_WAIT_V(6); PG8_BAR; PG8_MMA(1, 1, At, B1); PG8_BAR;
            PG8_LDB(B0, 1, 0); PG8_SCHED; PG8_LDA(At, 1, 0); PG8_STAGE(PG8_SA(0, 1), a2 + hstepA, voffA);
            PG8_WAIT_L(8); PG8_BAR; PG8_WAIT_L(0); PG8_MMA(0, 0, At, B0); PG8_BAR; PG8_SCHED;
            PG8_LDB(B1, 1, 1); PG8_STAGE(PG8_SB(1, 0), b3, voffB);
            PG8_BAR; PG8_WAIT_L(0); PG8_MMA(0, 1, At, B1); PG8_BAR;
            PG8_LDA(At, 1, 1); PG8_STAGE(PG8_SA(1, 0), a3, voffA);
            PG8_BAR; PG8_WAIT_L(0); PG8_MMA(1, 0, At, B0); PG8_BAR; PG8_SCHED;
            PG8_STAGE(PG8_SB(1, 1), b3 + hstepB, voffB);
            PG8_WAIT_V(6); PG8_BAR; PG8_MMA(1, 1, At, B1); PG8_BAR;
            }
        }
        if constexpr (ALIGN_EPI) { if (wr == 0) PG8_BAR; }
        E(acc, cur, wr, wc, fr, fq);
        if (!has_next) break;
#pragma unroll
        for (int a = 0; a < 2; ++a)
#pragma unroll
            for (int b = 0; b < 2; ++b)
#pragma unroll
                for (int m = 0; m < 4; ++m)
#pragma unroll
                    for (int n = 0; n < 2; ++n) acc[a][b][m][n] = (f32x4){0.f, 0.f, 0.f, 0.f};
        cur = nxt; cA = nA; cB = nB; ++ui;
        if constexpr (ALIGN_EPI) { if (wr == 1) PG8_BAR; }
    }
    PG8_WAIT_V(0);
    if constexpr (!ALIGN_EPI) { if (wr == 0) PG8_BAR; }
    PG8_BAR;
#undef PG8_SA
#undef PG8_SB
#undef PG8_STAGE
#undef PG8_LDA
#undef PG8_LDB
#undef PG8_MMA
#undef PG8_WAIT_V
#undef PG8_WAIT_L
#undef PG8_BAR
#undef PG8_SCHED
}

struct EpiBf16 {
    static constexpr bool PERM = true;
    bf16_t* O; long zs; int ldc, pad;
    __device__ __forceinline__ void operator()(const f32x4 (&acc)[2][2][4][2], const Unit& u, int wr, int wc, int fr, int fq) const {
        const int row0 = u.pm * BM + wr * 64 + fr, col0 = u.pn * BM + wc * 32 + 8 * fq; bf16_t* base = O + (long)u.z * zs;
#pragma unroll
        for (int ai = 0; ai < 2; ++ai)
#pragma unroll
            for (int m = 0; m < 4; ++m) { bf16_t* rowp = base + (size_t)(row0 + ai * HALF + m * 16) * ldc + col0;
#pragma unroll
                for (int bj = 0; bj < 2; ++bj) { const f32x4 v0 = acc[ai][bj][m][0], v1 = acc[ai][bj][m][1];
                    u32x4 w; w.x = pk2(v0[0], v0[1]); w.y = pk2(v0[2], v0[3]); w.z = pk2(v1[0], v1[1]); w.w = pk2(v1[2], v1[3]);
                    *(u32x4*)(rowp + bj * HALF) = w; } }
    }
};
struct EpiMem {
    static constexpr bool PERM = false;
    float* outK; float* outV; bf16_t* kb; bf16_t* vt;
    __device__ __forceinline__ void operator()(const f32x4 (&acc)[2][2][4][2], const Unit& u, int wr, int wc, int fr, int fq) const {
        const int row0 = u.pm * BM + wr * 64 + fr, col0 = u.pn * BM + wc * 32 + 4 * fq;
#pragma unroll
        for (int ai = 0; ai < 2; ++ai)
#pragma unroll
            for (int m = 0; m < 4; ++m) { const int row = row0 + ai * HALF + m * 16;
#pragma unroll
                for (int bj = 0; bj < 2; ++bj)
#pragma unroll
                    for (int n = 0; n < 2; ++n) { const int col = col0 + bj * HALF + n * 16; const f32x4 v = acc[ai][bj][m][n];
                        if (col < 1024) { *(f32x4*)(outK + ((size_t)u.z * 512 + row) * 1024 + col) = v;
                            u32x2 w; w.x = pk2(v[0], v[1]); w.y = pk2(v[2], v[3]); *(u32x2*)(kb + ((size_t)u.z * 512 + row) * 1024 + col) = w; }
                        else { const int c = col - 1024; *(f32x4*)(outV + ((size_t)u.z * 512 + row) * 1024 + c) = v;
                            const int b = row >> 8, mm = row & 255, h = c >> 8, d = c & 255; bf16_t* p = vt + ((((size_t)u.z * 2 + b) * 4 + h) * 256 + d) * 256 + mm;
                            p[0] = f2bf(v[0]); p[256] = f2bf(v[1]); p[512] = f2bf(v[2]); p[768] = f2bf(v[3]); } } }
    }
};
struct EpiMerge {
    static constexpr bool PERM = false;
    float* MG; bf16_t* MGB; const bf16_t* U; const float* gate_b;
    __device__ __forceinline__ void operator()(const f32x4 (&acc)[2][2][4][2], const Unit& u, int wr, int wc, int fr, int fq) const {
        const int row0 = u.pm * BM + wr * 64 + fr, col0 = u.pn * BM + wc * 32 + 4 * fq;
#pragma unroll
        for (int ai = 0; ai < 2; ++ai)
#pragma unroll
            for (int m = 0; m < 4; ++m) { const int row = row0 + ai * HALF + m * 16;
#pragma unroll
                for (int bj = 0; bj < 2; ++bj)
#pragma unroll
                    for (int n = 0; n < 2; ++n) { const int col = col0 + bj * HALF + n * 16; const f32x4 v = acc[ai][bj][m][n];
                        const u32x2 gp = *(const u32x2*)(U + (size_t)row * NINP + U_GP + u.z * DM + col); const f32x4 gb = *(const f32x4*)(gate_b + u.z * DM + col);
                        f32x4 gt; gt[0] = sigmoidf_(__uint_as_float(gp.x << 16) + gb[0]); gt[1] = sigmoidf_(__uint_as_float(gp.x & 0xffff0000u) + gb[1]);
                        gt[2] = sigmoidf_(__uint_as_float(gp.y << 16) + gb[2]); gt[3] = sigmoidf_(__uint_as_float(gp.y & 0xffff0000u) + gb[3]);
                        float* mp = MG + (size_t)row * DM + col; f32x4 r = gt * v;
                        if (u.z > 0) r += *(const f32x4*)mp;
                        if (u.z < 3) *(f32x4*)mp = r;
                        else { u32x2 w; w.x = pk2(r[0], r[1]); w.y = pk2(r[2], r[3]); *(u32x2*)(MGB + (size_t)row * DM + col) = w; } } }
    }
};
struct EpiRes {
    static constexpr bool PERM = false;
    const float* R; float* Y;
    __device__ __forceinline__ void operator()(const f32x4 (&acc)[2][2][4][2], const Unit& u, int wr, int wc, int fr, int fq) const {
        const int row0 = u.pm * BM + wr * 64 + fr, col0 = u.pn * BM + wc * 32 + 4 * fq;
#pragma unroll
        for (int ai = 0; ai < 2; ++ai)
#pragma unroll
            for (int m = 0; m < 4; ++m) { const size_t ro = (size_t)(row0 + ai * HALF + m * 16) * DM + col0;
#pragma unroll
                for (int bj = 0; bj < 2; ++bj)
#pragma unroll
                    for (int n = 0; n < 2; ++n) { const size_t o = ro + bj * HALF + n * 16; *(f32x4*)(Y + o) = *(const f32x4*)(R + o) * ALPHA + acc[ai][bj][m][n]; } }
    }
};
struct EpiSwiGLU {
    static constexpr bool PERM = true;
    bf16_t* O;
    __device__ __forceinline__ void operator()(const f32x4 (&acc)[2][2][4][2], const Unit& u, int wr, int wc, int fr, int fq) const {
        const int row0 = u.pm * BM + wr * 64 + fr, col0 = u.pn * HALF + wc * 32 + 8 * fq;
#pragma unroll
        for (int ai = 0; ai < 2; ++ai)
#pragma unroll
            for (int m = 0; m < 4; ++m) { bf16_t* rowp = O + (size_t)(row0 + ai * HALF + m * 16) * DFF + col0;
                float r[8];
#pragma unroll
                for (int n = 0; n < 2; ++n)
#pragma unroll
                    for (int j = 0; j < 4; ++j) { const float gg = acc[ai][0][m][n][j], uu = acc[ai][1][m][n][j]; r[n * 4 + j] = gg * sigmoidf_(gg) * uu; }
                u32x4 w; w.x = pk2(r[0], r[1]); w.y = pk2(r[2], r[3]); w.z = pk2(r[4], r[5]); w.w = pk2(r[6], r[7]);
                *(u32x4*)rowp = w; }
    }
};
struct EpiScore {
    static constexpr bool PERM = false;
    float* SC;
    __device__ __forceinline__ void operator()(const f32x4 (&acc)[2][2][4][2], const Unit& u, int wr, int wc, int fr, int fq) const {
        const int row0 = u.pm * BM + wr * 64 + fr, col0 = wc * 32 + 4 * fq; float* base = SC + (size_t)u.z * 4096 * 256;
#pragma unroll
        for (int ai = 0; ai < 2; ++ai)
#pragma unroll
            for (int m = 0; m < 4; ++m) { float* rowp = base + (size_t)(row0 + ai * HALF + m * 16) * 256 + col0;
#pragma unroll
                for (int bj = 0; bj < 2; ++bj)
#pragma unroll
                    for (int n = 0; n < 2; ++n) *(f32x4*)(rowp + bj * HALF + n * 16) = acc[ai][bj][m][n] * 0.0625f; }
    }
};
struct EpiPV {
    static constexpr bool PERM = true;
    bf16_t* O;
    __device__ __forceinline__ void operator()(const f32x4 (&acc)[2][2][4][2], const Unit& u, int wr, int wc, int fr, int fq) const {
        const int b = u.z >> 2, h = u.z & 3; const int row0 = b * PS + u.pm * BM + wr * 64 + fr, col0 = h * 256 + wc * 32 + 8 * fq;
#pragma unroll
        for (int ai = 0; ai < 2; ++ai)
#pragma unroll
            for (int m = 0; m < 4; ++m) { bf16_t* rowp = O + (size_t)(row0 + ai * HALF + m * 16) * BW + col0;
#pragma unroll
                for (int bj = 0; bj < 2; ++bj) { const f32x4 v0 = acc[ai][bj][m][0], v1 = acc[ai][bj][m][1];
                    u32x4 w; w.x = pk2(v0[0], v0[1]); w.y = pk2(v0[2], v0[3]); w.z = pk2(v1[0], v1[1]); w.w = pk2(v1[2], v1[3]);
                    *(u32x4*)(rowp + bj * HALF) = w; } }
    }
};
}


#define XB_TMO      128
#define XB_XCNT(j)  (256  + 64 * (j))
#define XB_XSUB(j)  (1280 + 64 * (j))
#define XB_XGEN(j)  (2304 + 64 * (j))
#define XB_TOP      3328
#define XB_TOPGEN   3392
#define XCD_BAR_WORDS 3456
#define XB_SPIN_CAP (1u << 18)
__device__ __forceinline__ unsigned xb_ld(unsigned* p)              { return __hip_atomic_load(p, __ATOMIC_RELAXED, __HIP_MEMORY_SCOPE_AGENT); }
__device__ __forceinline__ unsigned xb_add(unsigned* p, unsigned v) { return __hip_atomic_fetch_add(p, v, __ATOMIC_RELAXED, __HIP_MEMORY_SCOPE_AGENT); }
__device__ __forceinline__ unsigned xb_xcc_id() { return (unsigned)__builtin_amdgcn_s_getreg((3 << 11) | 20) & 0xFu; }
#define XB_SPIN(cond, bar) do { unsigned _sp = 0; while (cond) { __builtin_amdgcn_s_sleep(1); \
    if ((++_sp & 255u) == 0u) { if (xb_ld(&(bar)[XB_TMO])) break; if (_sp > XB_SPIN_CAP) { atomicAdd(&(bar)[XB_TMO], 1u); break; } } } } while (0)
struct XcdBarrier { unsigned* bar; unsigned x; volatile LAS unsigned* st; };
__device__ __forceinline__ XcdBarrier xcd_barrier_post(unsigned* bar, volatile LAS unsigned* st) {
    XcdBarrier b; b.bar = bar; b.x = xb_xcc_id(); b.st = st;
    if (threadIdx.x == 0) (void)xb_add(&bar[XB_XCNT(b.x)], 1u);
    return b;
}
__device__ __forceinline__ void xcd_barrier_complete(unsigned* bar, unsigned x, unsigned& nloc, unsigned& nx) {
    const unsigned G = gridDim.x * gridDim.y * gridDim.z;
    unsigned sum, cnt, mine, sp = 0u;
    for (;;) {
        sum = 0u; cnt = 0u; mine = 0u;
#pragma unroll
        for (unsigned j = 0; j < 16; ++j) { const unsigned c = xb_ld(&bar[XB_XCNT(j)]); sum += c; cnt += (c > 0u) ? 1u : 0u; mine = (j == x) ? c : mine; }
        if (sum == G) break;
        __builtin_amdgcn_s_sleep(1);
        if ((++sp & 255u) == 0u) { if (xb_ld(&bar[XB_TMO])) break; if (sp > XB_SPIN_CAP) { atomicAdd(&bar[XB_TMO], 1u); break; } }
    }
    nloc = mine > 0u ? mine : 1u; nx = cnt > 0u ? cnt : 1u;
}
__device__ __forceinline__ void xcd_barrier(const XcdBarrier& b) {
    asm volatile("s_waitcnt vmcnt(0)" ::: "memory");
    __syncthreads();
    if (threadIdx.x == 0) {
        unsigned* bar = b.bar;
        __builtin_amdgcn_s_waitcnt(0);
        unsigned nloc = b.st[0], nx = b.st[1];
        if (nloc == 0u) { xcd_barrier_complete(bar, b.x, nloc, nx); b.st[0] = nloc; b.st[1] = nx; }
        const unsigned old = xb_add(&bar[XB_XSUB(b.x)], 1u);
        const unsigned gen = old / nloc;
        if (old + 1u == (gen + 1u) * nloc) {
            __builtin_amdgcn_fence(__ATOMIC_RELEASE, "agent");
            asm volatile("s_waitcnt vmcnt(0)" ::: "memory");
            const unsigned og = xb_add(&bar[XB_TOP], 1u);
            const unsigned tg = og / nx;
            if (og + 1u == (tg + 1u) * nx) xb_add(&bar[XB_TOPGEN], 1u);
            else XB_SPIN(xb_ld(&bar[XB_TOPGEN]) == tg, bar);
            __builtin_amdgcn_fence(__ATOMIC_ACQUIRE, "agent");
            xb_add(&bar[XB_XGEN(b.x)], 1u);
            asm volatile("s_waitcnt vmcnt(0)" ::: "memory");
        } else {
            XB_SPIN(xb_ld(&bar[XB_XGEN(b.x)]) == gen, bar);
            __builtin_amdgcn_fence(__ATOMIC_ACQUIRE, "agent");
            asm volatile("s_waitcnt vmcnt(0)" ::: "memory");
        }
    }
    __syncthreads();
}

struct Ctx { int tid, lane, wave, bid, G; LAS unsigned char* lds; };
__device__ __forceinline__ Ctx fresh(const Ctx& c0) { Ctx c; c.wave = c0.wave; c.bid = c0.bid; c.G = c0.G; c.lds = c0.lds; asm volatile("" : "+s"(c.bid), "+s"(c.G), "+s"(c.wave));
    int lane = (int)__builtin_amdgcn_mbcnt_hi(~0u, __builtin_amdgcn_mbcnt_lo(~0u, 0u)); asm volatile("" : "+v"(lane)); c.lane = lane; c.tid = c.wave * 64 + lane; return c; }

__device__ __forceinline__ int colmap(int mode, int n) {
    if (mode == 1) return n < 3088 ? n : (n < 3328 ? -1 : n - 240);
    if (mode == 2) { const int t = n >> 8, j = n & 255; return j < 128 ? t * 128 + j : DFF + t * 128 + (j - 128); }
    return n;
}
__device__ __forceinline__ void ph_wprep(const Ctx& c, const float* __restrict__ src, bf16_t* __restrict__ dst, int K, int Nsrc, int Ndst, int mode, int nbatch, size_t sbs, size_t dbs) {
    LAS float* tile = (LAS float*)c.lds;
    const int nx = Ndst / 64, ny = K / 64, total = nx * ny * nbatch;
    const int tx = c.tid & 63, ty = c.tid >> 6, r = c.tid >> 3, p = c.tid & 7;
    for (int t = c.bid; t < total; t += c.G) {
        const int bx = t % nx, by = (t / nx) % ny, bz = t / (nx * ny);
        const float* s = src + (size_t)bz * sbs; bf16_t* d = dst + (size_t)bz * dbs;
        const int n0 = bx * 64, k0 = by * 64, cm = colmap(mode, n0 + tx);
        for (int kk = ty; kk < 64; kk += 8) tile[kk * 65 + tx] = cm >= 0 ? s[(size_t)(k0 + kk) * Nsrc + cm] : 0.f;
        __syncthreads();
        { u32x4 w; w.x = pk2(tile[(p * 8 + 0) * 65 + r], tile[(p * 8 + 1) * 65 + r]); w.y = pk2(tile[(p * 8 + 2) * 65 + r], tile[(p * 8 + 3) * 65 + r]);
          w.z = pk2(tile[(p * 8 + 4) * 65 + r], tile[(p * 8 + 5) * 65 + r]); w.w = pk2(tile[(p * 8 + 6) * 65 + r], tile[(p * 8 + 7) * 65 + r]);
          *(u32x4*)(d + (size_t)(n0 + r) * K + k0 + p * 8) = w; }
        __syncthreads();
    }
}
__device__ __forceinline__ void ph_xprep(const Ctx& c, const float* __restrict__ xp, const float* __restrict__ xs, const float* __restrict__ mem, float* __restrict__ HF, bf16_t* __restrict__ HB, bf16_t* __restrict__ MEMB) {
    const size_t nH = (size_t)MPAD * DM / 4, nM = (size_t)512 * DM / 4;
    for (size_t i4 = (size_t)c.bid * 512 + c.tid; i4 < nH + nM; i4 += (size_t)c.G * 512) {
        if (i4 < nH) {
            const size_t e = i4 * 4; f32x4 v = (f32x4){0.f, 0.f, 0.f, 0.f};
            if (e < (size_t)MP * DM) v = *(const f32x4*)(xp + e); else if (e < (size_t)MT * DM) v = *(const f32x4*)(xs + (e - (size_t)MP * DM));
            *(f32x4*)(HF + e) = v; u32x2 w; w.x = pk2(v[0], v[1]); w.y = pk2(v[2], v[3]); *(u32x2*)(HB + e) = w;
        } else {
            const size_t e = (i4 - nH) * 4; const f32x4 v = *(const f32x4*)(mem + e); u32x2 w; w.x = pk2(v[0], v[1]); w.y = pk2(v[2], v[3]); *(u32x2*)(MEMB + e) = w;
        }
    }
}
__device__ __forceinline__ void ph_ln(const Ctx& c, const float* __restrict__ Y, const float* __restrict__ g, const float* __restrict__ b, float* __restrict__ XF, bf16_t* __restrict__ XB, float* __restrict__ OUT, int nrows, int nout) {
    const int lane = c.lane;
    for (int row = c.bid * 8 + c.wave; row < nrows; row += c.G * 8) {
        const float* y = Y + (size_t)row * DM; f32x4 v[8]; float s = 0.f;
#pragma unroll
        for (int j = 0; j < 8; ++j) { v[j] = *(const f32x4*)(y + j * 256 + lane * 4); s += (v[j][0] + v[j][1]) + (v[j][2] + v[j][3]); }
        const float mean = wave_sum(s) * (1.0f / DM); float q = 0.f;
#pragma unroll
        for (int j = 0; j < 8; ++j) { const f32x4 d = v[j] - mean; q += (d[0] * d[0] + d[1] * d[1]) + (d[2] * d[2] + d[3] * d[3]); }
        const float rstd = rsqrtf(wave_sum(q) * (1.0f / DM) + 1e-5f);
#pragma unroll
        for (int j = 0; j < 8; ++j) { const int cc = j * 256 + lane * 4; const f32x4 gg = *(const f32x4*)(g + cc), bb = *(const f32x4*)(b + cc);
            const f32x4 o = (v[j] - mean) * rstd * gg + bb; const size_t off = (size_t)row * DM + cc;
            *(f32x4*)(XF + off) = o; u32x2 w; w.x = pk2(o[0], o[1]); w.y = pk2(o[2], o[3]); *(u32x2*)(XB + off) = w;
            if (OUT != nullptr && row < nout) *(f32x4*)(OUT + off) = o; }
    }
}
__device__ __forceinline__ void ph_softmax256(const Ctx& c, const float* __restrict__ SC, bf16_t* __restrict__ P, int nrows) {
    const int lane = c.lane;
    for (int row = c.bid * 8 + c.wave; row < nrows; row += c.G * 8) {
        const f32x4 v = *(const f32x4*)(SC + (size_t)row * 256 + lane * 4);
        const float mx = wave_max(fmaxf(fmaxf(v[0], v[1]), fmaxf(v[2], v[3])));
        f32x4 e; e[0] = __expf(v[0] - mx); e[1] = __expf(v[1] - mx); e[2] = __expf(v[2] - mx); e[3] = __expf(v[3] - mx);
        const float inv = 1.0f / wave_sum((e[0] + e[1]) + (e[2] + e[3]));
        u32x2 w; w.x = pk2(e[0] * inv, e[1] * inv); w.y = pk2(e[2] * inv, e[3] * inv); *(u32x2*)(P + (size_t)row * 256 + lane * 4) = w;
    }
}
__device__ __forceinline__ void ph_copy_outs(const Ctx& c, const bf16_t* __restrict__ U, const float* __restrict__ ck, const float* __restrict__ cv, float* __restrict__ out, int layer) {
    constexpr int nA = PB * 128 * 128, nB = SB * 128 * 128, nC = PB * RWC, nD = SB * RWC;
    for (int i = c.bid * 512 + c.tid; i < nA + nB + nC + nD; i += c.G * 512) {
        if (i < nA) { const int b = i / 16384, j = (i >> 7) & 127, cc = i & 127; const size_t ur = (size_t)(b * PS + PS - 128 + j) * NINP;
            out[O_SWKP + (size_t)layer * nA + i] = bf2f(U[ur + U_SK + cc]); out[O_SWVP + (size_t)layer * nA + i] = bf2f(U[ur + U_SV + cc]); continue; }
        int k = i - nA;
        if (k < nB) { const int sq = k / 16384, j = (k >> 7) & 127, cc = k & 127; float kv, vv;
            if (j < 124) { const size_t o = ((size_t)sq * 128 + j + 4) * 128 + cc; kv = ck[o]; vv = cv[o]; }
            else { const size_t ur = (size_t)(MP + sq * SS + j - 124) * NINP; kv = bf2f(U[ur + U_SK + cc]); vv = bf2f(U[ur + U_SV + cc]); }
            out[O_SWKS + (size_t)layer * nB + k] = kv; out[O_SWVS + (size_t)layer * nB + k] = vv; continue; }
        k -= nB;
        if (k < nC) { const int b = k / RWC, cc = k - b * RWC; out[O_RSP + (size_t)layer * nC + k] = bf2f(U[(size_t)(b * PS + PS - 1) * NINP + U_RU + cc]); continue; }
        k -= nC;
        { const int sq = k / RWC, cc = k - sq * RWC; out[O_RSS + (size_t)layer * nD + k] = bf2f(U[(size_t)(MP + sq * SS + SS - 1) * NINP + U_RU + cc]); }
    }
}

__device__ __forceinline__ void seq_info(int sq, int& row0, int& L) { if (sq < PB) { row0 = sq * PS; L = PS; } else { row0 = MP + (sq - PB) * SS; L = SS; } }

__device__ __forceinline__ void ph_gla_naive(const Ctx& c, const bf16_t* __restrict__ U, const float* __restrict__ s0, const float* __restrict__ a_up, const float* __restrict__ a_b,
                                             const float* __restrict__ ng, const float* __restrict__ nb, bf16_t* __restrict__ OB, float* __restrict__ outP, float* __restrict__ outS) {
    LAS float* qs = (LAS float*)c.lds;
    LAS float* ks = qs + 16 * 128; LAS float* as = ks + 16 * 128; LAS float* os = as + 16 * 128;
    const int kh = c.tid >> 8, vt = c.tid & 255, lane = c.lane;
    for (int u = c.bid; u < (PB + SB) * 4; u += c.G) {
        const int sq = u >> 2, h = u & 3;
        int row0, L; seq_info(sq, row0, L);
        float S[64];
        if (sq >= PB) { const float* p = s0 + (((size_t)(sq - PB) * 4 + h) * 128 + kh * 64) * 256 + vt;
#pragma unroll
            for (int kk = 0; kk < 64; ++kk) S[kk] = p[(size_t)kk * 256]; }
        else {
#pragma unroll
            for (int kk = 0; kk < 64; ++kk) S[kk] = 0.f; }
        for (int t0 = 0; t0 < L; t0 += 16) {
            const int nT = (L - t0) < 16 ? (L - t0) : 16;
            for (int idx = c.tid; idx < nT * 128; idx += 512) {
                const int tt = idx >> 7, kk = idx & 127; const bf16_t* ur = U + (size_t)(row0 + t0 + tt) * NINP;
                qs[idx] = bf2f(ur[U_GQ + h * 128 + kk]) * 0.08838834764831845f; ks[idx] = bf2f(ur[U_GK + h * 128 + kk]);
                float x = a_b[h * 128 + kk];
#pragma unroll
                for (int r = 0; r < 16; ++r) x += bf2f(ur[U_GA + r]) * a_up[r * 512 + h * 128 + kk];
                const float ls = (fminf(x, 0.f) - log1pf(__expf(-fabsf(x)))) * (1.0f / 16.0f);
                as[idx] = __expf(ls);
            }
            __syncthreads();
            for (int tt = 0; tt < nT; ++tt) {
                const float v = bf2f(U[(size_t)(row0 + t0 + tt) * NINP + U_GV + h * 256 + vt]); float o = 0.f; const int lb = tt * 128 + kh * 64;
#pragma unroll
                for (int kk = 0; kk < 64; ++kk) { S[kk] = as[lb + kk] * S[kk] + ks[lb + kk] * v; o += qs[lb + kk] * S[kk]; }
                os[(kh * 16 + tt) * 256 + vt] = o;
            }
            __syncthreads();
            for (int tt = c.wave; tt < nT; tt += 8) {
                float x[4]; float s = 0.f;
#pragma unroll
                for (int j = 0; j < 4; ++j) { x[j] = os[tt * 256 + lane + 64 * j] + os[(16 + tt) * 256 + lane + 64 * j]; s += x[j]; }
                const float mean = wave_sum(s) * (1.0f / 256.0f); float q = 0.f;
#pragma unroll
                for (int j = 0; j < 4; ++j) { const float d = x[j] - mean; q += d * d; }
                const float rstd = rsqrtf(wave_sum(q) * (1.0f / 256.0f) + 1e-5f);
                const size_t row = (size_t)(row0 + t0 + tt);
#pragma unroll
                for (int j = 0; j < 4; ++j) { const int cc = h * 256 + lane + 64 * j; const float n = (x[j] - mean) * rstd * ng[cc] + nb[cc];
                    const float gr = bf2f(U[row * NINP + U_GR + cc]); OB[row * BW + cc] = f2bf(n * gr * sigmoidf_(gr)); }
            }
            __syncthreads();
        }
        float* op = (sq < PB ? outP + (((size_t)sq * 4 + h) * 128 + kh * 64) * 256 : outS + (((size_t)(sq - PB) * 4 + h) * 128 + kh * 64) * 256) + vt;
#pragma unroll
        for (int kk = 0; kk < 64; ++kk) op[(size_t)kk * 256] = S[kk];
    }
}

__device__ __forceinline__ f32x4 mma16(bf16x8 x, bf16x8 y, f32x4 c) { return __builtin_amdgcn_mfma_f32_16x16x32_bf16(x, y, c, 0, 0, 0); }
__device__ __forceinline__ void gla_chunk_info(int u, int& row0, int& ntok, int& h) {
    if (u < 512) { const int b = u >> 8; h = (u >> 6) & 3; row0 = b * PS + (u & 63) * 64; ntok = 64; }
    else { const int s = u - 512; h = s & 3; row0 = MP + (s >> 2) * SS; ntok = SS; }
}
__device__ __forceinline__ void ph_gla_pre(const Ctx& c, const bf16_t* __restrict__ U, const float* __restrict__ a_up, const float* __restrict__ a_b,
                                           bf16_t* __restrict__ QD, bf16_t* __restrict__ KHT, bf16_t* __restrict__ EE, bf16_t* __restrict__ VT, float* __restrict__ GC) {
    LAS float* ga_l = (LAS float*)c.lds;
    LAS float* tot = ga_l + 64 * 16;
    LAS bf16_t* Qd_l = (LAS bf16_t*)(tot + 4 * 128);
    LAS bf16_t* Kn_l = Qd_l + 64 * 136;
    LAS bf16_t* v_l = Kn_l + 64 * 136;
    const int tid = c.tid, lane = c.lane, r = lane & 15, q = lane >> 4, w = c.wave;
    for (int u = c.bid; u < GL_NCH; u += c.G) {
        int row0, ntok, h; gla_chunk_info(u, row0, ntok, h);
        for (int i = tid; i < 64 * 16; i += 512) { const int t = i >> 4, rr = i & 15; ga_l[i] = t < ntok ? bf2f(U[(size_t)(row0 + t) * NINP + U_GA + rr]) : 0.f; }
        for (int i = tid; i < 64 * 32; i += 512) { const int t = i >> 5, c8 = i & 31; u32x4 vv = (u32x4){0u, 0u, 0u, 0u};
            if (t < ntok) vv = *(const u32x4*)(U + (size_t)(row0 + t) * NINP + U_GV + h * 256 + c8 * 8);
            *(LAS u32x4*)(v_l + t * 264 + c8 * 8) = vv; }
        __syncthreads();
        const int kk = tid & 127, tq = tid >> 7;
        float cum[16];
        { float aup[16];
#pragma unroll
          for (int rr = 0; rr < 16; ++rr) aup[rr] = a_up[rr * 512 + h * 128 + kk];
          const float ab = a_b[h * 128 + kk]; float run = 0.f;
#pragma unroll
          for (int j = 0; j < 16; ++j) { const int t = tq * 16 + j; float x = ab;
#pragma unroll
              for (int rr = 0; rr < 16; ++rr) x += ga_l[t * 16 + rr] * aup[rr];
              const float la = t < ntok ? (fminf(x, 0.f) - log1pf(__expf(-fabsf(x)))) * (1.0f / 16.0f) : 0.f;
              run += la; cum[j] = run; }
          tot[tq * 128 + kk] = run; }
        __syncthreads();
        { float prefix = 0.f, bC = 0.f;
#pragma unroll
          for (int g = 0; g < 4; ++g) { const float tv = tot[g * 128 + kk]; bC += tv; if (g < tq) prefix += tv; }
          unsigned khp[8];
#pragma unroll
          for (int j = 0; j < 16; j += 2) { float kh2[2];
#pragma unroll
              for (int e = 0; e < 2; ++e) { const int t = tq * 16 + j + e; const float b = prefix + cum[j + e]; float qv = 0.f, kv = 0.f;
                  if (t < ntok) { const bf16_t* ur = U + (size_t)(row0 + t) * NINP; qv = bf2f(ur[U_GQ + h * 128 + kk]); kv = bf2f(ur[U_GK + h * 128 + kk]); }
                  Qd_l[t * 136 + kk] = f2bf(qv * __expf(b) * 0.08838834764831845f); Kn_l[t * 136 + kk] = f2bf(kv * __expf(-b)); kh2[e] = kv * __expf(bC - b); }
              khp[j >> 1] = pk2(kh2[0], kh2[1]); }
          bf16_t* kp = KHT + (size_t)u * 8192 + kk * 64 + tq * 16;
          *(u32x4*)kp = (u32x4){khp[0], khp[1], khp[2], khp[3]}; *(u32x4*)(kp + 8) = (u32x4){khp[4], khp[5], khp[6], khp[7]};
          if (tq == 0) GC[(size_t)u * 128 + kk] = __expf(bC); }
        __syncthreads();
        { const int tb = w >> 1;
#pragma unroll
          for (int e = 0; e < 2; ++e) { const int ib = (w & 1) * 2 + e; f32x4 d = (f32x4){0.f, 0.f, 0.f, 0.f};
              if (ib <= tb) {
#pragma unroll
                  for (int ks = 0; ks < 4; ++ks) d = mma16(*(const LAS bf16x8*)(Kn_l + (ib * 16 + r) * 136 + ks * 32 + q * 8), *(const LAS bf16x8*)(Qd_l + (tb * 16 + r) * 136 + ks * 32 + q * 8), d); }
              const int t = tb * 16 + r, i0 = ib * 16 + q * 4;
#pragma unroll
              for (int jj = 0; jj < 4; ++jj) if (i0 + jj > t) d[jj] = 0.f;
              u32x2 o; o.x = pk2(d[0], d[1]); o.y = pk2(d[2], d[3]); *(u32x2*)(EE + (size_t)u * 4096 + t * 64 + i0) = o; } }
        for (int i = tid; i < 64 * 16; i += 512) { const int t = i >> 4, c8 = i & 15; *(u32x4*)(QD + (size_t)u * 8192 + t * 128 + c8 * 8) = *(const LAS u32x4*)(Qd_l + t * 136 + c8 * 8); }
        { const int val = tid & 255, th = tid >> 8;
#pragma unroll
          for (int tg = 0; tg < 4; ++tg) { const int t0 = th * 32 + tg * 8; unsigned p4[4];
#pragma unroll
              for (int e = 0; e < 4; ++e) p4[e] = (unsigned)v_l[(t0 + 2 * e) * 264 + val] | ((unsigned)v_l[(t0 + 2 * e + 1) * 264 + val] << 16);
              *(u32x4*)(VT + (size_t)u * 16384 + val * 64 + t0) = (u32x4){p4[0], p4[1], p4[2], p4[3]}; } }
        __syncthreads();
    }
}
struct GlaFrag { bf16x8 qd[4], e[2], kh[2], vt[4][2]; f32x4 gc; };
__device__ __forceinline__ void gla_load_frag(GlaFrag& f, const bf16_t* __restrict__ QD, const bf16_t* __restrict__ KHT, const bf16_t* __restrict__ EE, const bf16_t* __restrict__ VT, const float* __restrict__ GC,
                                              int ch, int sl, int w, int r, int q) {
    const int rb = w >> 1;
#pragma unroll
    for (int ks = 0; ks < 4; ++ks) f.qd[ks] = *(const bf16x8*)(QD + (size_t)ch * 8192 + (rb * 16 + r) * 128 + ks * 32 + q * 8);
#pragma unroll
    for (int ks = 0; ks < 2; ++ks) { f.e[ks] = *(const bf16x8*)(EE + (size_t)ch * 4096 + (rb * 16 + r) * 64 + ks * 32 + q * 8);
        f.kh[ks] = *(const bf16x8*)(KHT + (size_t)ch * 8192 + (w * 16 + r) * 64 + ks * 32 + q * 8);
#pragma unroll
        for (int vb = 0; vb < 4; ++vb) f.vt[vb][ks] = *(const bf16x8*)(VT + (size_t)ch * 16384 + (sl * 64 + vb * 16 + r) * 64 + ks * 32 + q * 8); }
    f.gc = *(const f32x4*)(GC + (size_t)ch * 128 + w * 16 + q * 4);
}
__device__ __forceinline__ void ph_gla_seq(const Ctx& c, int boff, const bf16_t* __restrict__ QD, const bf16_t* __restrict__ KHT, const bf16_t* __restrict__ EE, const bf16_t* __restrict__ VT, const float* __restrict__ GC,
                                           const float* __restrict__ s0, float* __restrict__ outP, float* __restrict__ outS, bf16_t* __restrict__ OB) {
    LAS bf16_t* T_l = (LAS bf16_t*)c.lds;
    const int lane = c.lane, r = lane & 15, q = lane >> 4, w = c.wave;
    for (int u = (c.bid - boff + c.G) % c.G; u < 32 + 512; u += c.G) {
        int h, sl, nch, ch0, row0, ntok; const float* sp = nullptr; float* op;
        if (u < 32) { const int b = u >> 4; h = (u >> 2) & 3; sl = u & 3; nch = 64; ch0 = (b * 4 + h) * 64; row0 = b * PS; ntok = 64; op = outP + (size_t)(b * 4 + h) * 32768; }
        else { const int s = u - 32, sq = s >> 4; h = (s >> 2) & 3; sl = s & 3; nch = 1; ch0 = 512 + sq * 4 + h; row0 = MP + sq * SS; ntok = SS; sp = s0 + (size_t)(sq * 4 + h) * 32768; op = outS + (size_t)(sq * 4 + h) * 32768; }
        f32x4 acc[4];
#pragma unroll
        for (int vb = 0; vb < 4; ++vb)
#pragma unroll
            for (int jj = 0; jj < 4; ++jj) acc[vb][jj] = sp ? sp[(size_t)(w * 16 + q * 4 + jj) * 256 + sl * 64 + vb * 16 + r] : 0.f;
        GlaFrag cur; gla_load_frag(cur, QD, KHT, EE, VT, GC, ch0, sl, w, r, q);
        for (int ci = 0; ci < nch; ++ci) {
            GlaFrag nxt; if (ci + 1 < nch) gla_load_frag(nxt, QD, KHT, EE, VT, GC, ch0 + ci + 1, sl, w, r, q); else nxt = cur;
            LAS bf16_t* Tb = T_l + (ci & 1) * 64 * 136;
#pragma unroll
            for (int vb = 0; vb < 4; ++vb) { u32x2 o; o.x = pk2(acc[vb][0], acc[vb][1]); o.y = pk2(acc[vb][2], acc[vb][3]); *(LAS u32x2*)(Tb + (vb * 16 + r) * 136 + w * 16 + q * 4) = o; }
            __syncthreads();
            { const int rb = w >> 1, t = rb * 16 + r;
#pragma unroll
              for (int e = 0; e < 2; ++e) { const int cb = (w & 1) * 2 + e; f32x4 y = (f32x4){0.f, 0.f, 0.f, 0.f};
#pragma unroll
                  for (int ks = 0; ks < 4; ++ks) y = mma16(*(const LAS bf16x8*)(Tb + (cb * 16 + r) * 136 + ks * 32 + q * 8), cur.qd[ks], y);
#pragma unroll
                  for (int ks = 0; ks < 2; ++ks) y = mma16(e == 0 ? ((w & 1) ? cur.vt[2][ks] : cur.vt[0][ks]) : ((w & 1) ? cur.vt[3][ks] : cur.vt[1][ks]), cur.e[ks], y);
                  if (t < ntok) { u32x2 o; o.x = pk2(y[0], y[1]); o.y = pk2(y[2], y[3]); *(u32x2*)(OB + (size_t)(row0 + ci * 64 + t) * BW + h * 256 + sl * 64 + cb * 16 + q * 4) = o; } } }
#pragma unroll
            for (int vb = 0; vb < 4; ++vb) { acc[vb] = acc[vb] * cur.gc;
#pragma unroll
                for (int ks = 0; ks < 2; ++ks) acc[vb] = mma16(cur.kh[ks], cur.vt[vb][ks], acc[vb]); }
            cur = nxt;
        }
#pragma unroll
        for (int vb = 0; vb < 4; ++vb)
#pragma unroll
            for (int jj = 0; jj < 4; ++jj) op[(size_t)(w * 16 + q * 4 + jj) * 256 + sl * 64 + vb * 16 + r] = acc[vb][jj];
        __syncthreads();
    }
}
__device__ __forceinline__ void ph_gla_fin(const Ctx& c, const bf16_t* __restrict__ U, const float* __restrict__ ng, const float* __restrict__ nb, bf16_t* __restrict__ OB) {
    const int lane = c.lane;
    for (int i = c.bid * 8 + c.wave; i < MT * 4; i += c.G * 8) {
        const int row = i >> 2, h = i & 3, cc = h * 256 + lane * 4; bf16_t* p = OB + (size_t)row * BW + cc;
        const u32x2 raw = *(const u32x2*)p; float x[4] = {__uint_as_float(raw.x << 16), __uint_as_float(raw.x & 0xffff0000u), __uint_as_float(raw.y << 16), __uint_as_float(raw.y & 0xffff0000u)};
        const float mean = wave_sum((x[0] + x[1]) + (x[2] + x[3])) * (1.0f / 256.0f); float qq = 0.f;
#pragma unroll
        for (int j = 0; j < 4; ++j) { const float d = x[j] - mean; qq += d * d; }
        const float rstd = rsqrtf(wave_sum(qq) * (1.0f / 256.0f) + 1e-5f);
        const u32x2 gp = *(const u32x2*)(U + (size_t)row * NINP + U_GR + cc); const float gr[4] = {__uint_as_float(gp.x << 16), __uint_as_float(gp.x & 0xffff0000u), __uint_as_float(gp.y << 16), __uint_as_float(gp.y & 0xffff0000u)};
        const f32x4 gg = *(const f32x4*)(ng + cc), bb = *(const f32x4*)(nb + cc); float o[4];
#pragma unroll
        for (int j = 0; j < 4; ++j) o[j] = ((x[j] - mean) * rstd * gg[j] + bb[j]) * gr[j] * sigmoidf_(gr[j]);
        u32x2 ov; ov.x = pk2(o[0], o[1]); ov.y = pk2(o[2], o[3]); *(u32x2*)p = ov;
    }
}

__device__ __forceinline__ void unpack8(const u32x4 w, float (&x)[8]) {
    x[0] = __uint_as_float(w.x << 16); x[1] = __uint_as_float(w.x & 0xffff0000u); x[2] = __uint_as_float(w.y << 16); x[3] = __uint_as_float(w.y & 0xffff0000u);
    x[4] = __uint_as_float(w.z << 16); x[5] = __uint_as_float(w.z & 0xffff0000u); x[6] = __uint_as_float(w.w << 16); x[7] = __uint_as_float(w.w & 0xffff0000u);
}
template <bool ISBF> __device__ __forceinline__ void swa_step(const float (&q)[32], float (&acc)[32], float& m, float& l, const void* kp, const void* vp, float slope, float dist) {
    float s = 0.f;
#pragma unroll
    for (int j = 0; j < 4; ++j) { float x[8];
        if (ISBF) unpack8(*(const u32x4*)((const bf16_t*)kp + j * 8), x);
        else { const f32x4 a = *(const f32x4*)((const float*)kp + j * 8), b = *(const f32x4*)((const float*)kp + j * 8 + 4); x[0] = a[0]; x[1] = a[1]; x[2] = a[2]; x[3] = a[3]; x[4] = b[0]; x[5] = b[1]; x[6] = b[2]; x[7] = b[3]; }
#pragma unroll
        for (int d = 0; d < 8; ++d) s += q[j * 8 + d] * x[d]; }
    s += __shfl_xor(s, 1, 64);
    s = s * 0.125f - slope * dist;
    const float mn = fmaxf(m, s), cc = __expf(m - mn), p = __expf(s - mn);
    l = l * cc + p;
#pragma unroll
    for (int j = 0; j < 4; ++j) { float x[8];
        if (ISBF) unpack8(*(const u32x4*)((const bf16_t*)vp + j * 8), x);
        else { const f32x4 a = *(const f32x4*)((const float*)vp + j * 8), b = *(const f32x4*)((const float*)vp + j * 8 + 4); x[0] = a[0]; x[1] = a[1]; x[2] = a[2]; x[3] = a[3]; x[4] = b[0]; x[5] = b[1]; x[6] = b[2]; x[7] = b[3]; }
#pragma unroll
        for (int d = 0; d < 8; ++d) acc[j * 8 + d] = acc[j * 8 + d] * cc + p * x[d]; }
    m = mn;
}
__device__ __forceinline__ void ph_swa_naive(const Ctx& c, const bf16_t* __restrict__ U, const float* __restrict__ ck, const float* __restrict__ cv, const float* __restrict__ sinks, bf16_t* __restrict__ OB) {
    for (int gid = c.bid * 512 + c.tid; gid < MT * 32; gid += c.G * 512) {
        const int dh = gid & 1, h = (gid >> 1) & 15, row = gid >> 5, kvh = h >> 3, co = kvh * 64 + dh * 32;
        float q[32], acc[32];
#pragma unroll
        for (int j = 0; j < 4; ++j) { float x[8]; unpack8(*(const u32x4*)(U + (size_t)row * NINP + U_SQ + h * 64 + dh * 32 + j * 8), x);
#pragma unroll
            for (int d = 0; d < 8; ++d) { q[j * 8 + d] = x[d]; acc[j * 8 + d] = 0.f; } }
        const float slope = exp2f(-0.5f * (float)(h + 1)); float m = sinks[h], l = 1.0f;
        if (row < MP) {
            const int t = row % PS, base = row - t, lo = t - 128 < 0 ? 0 : t - 128;
            for (int s = lo; s <= t; ++s) { const bf16_t* ur = U + (size_t)(base + s) * NINP;
                swa_step<true>(q, acc, m, l, ur + U_SK + co, ur + U_SV + co, slope, (float)(t - s)); }
        } else {
            const int sq = (row - MP) / SS, i = (row - MP) % SS;
            for (int idx = i; idx <= 128 + i; ++idx) {
                if (idx < 128) { const size_t o = ((size_t)sq * 128 + idx) * 128 + co; swa_step<false>(q, acc, m, l, ck + o, cv + o, slope, (float)(128 + i - idx)); }
                else { const bf16_t* ur = U + (size_t)(MP + sq * SS + idx - 128) * NINP; swa_step<true>(q, acc, m, l, ur + U_SK + co, ur + U_SV + co, slope, (float)(128 + i - idx)); }
            }
        }
        const float inv = 1.0f / l; bf16_t* op = OB + (size_t)row * BW + h * 64 + dh * 32;
#pragma unroll
        for (int j = 0; j < 4; ++j) { u32x4 w; w.x = pk2(acc[j * 8] * inv, acc[j * 8 + 1] * inv); w.y = pk2(acc[j * 8 + 2] * inv, acc[j * 8 + 3] * inv);
            w.z = pk2(acc[j * 8 + 4] * inv, acc[j * 8 + 5] * inv); w.w = pk2(acc[j * 8 + 6] * inv, acc[j * 8 + 7] * inv); *(u32x4*)(op + j * 8) = w; }
    }
}

__device__ __forceinline__ void ph_rwkv_prep(const Ctx& c, const bf16_t* __restrict__ U, const float* __restrict__ shift, const float* __restrict__ mu, const float* __restrict__ w0, const float* __restrict__ w2,
                                             const float* __restrict__ a0, const float* __restrict__ a2, const float* __restrict__ g2, const float* __restrict__ k_k, const float* __restrict__ k_a,
                                             const float* __restrict__ r_k, float* __restrict__ RW) {
    LAS float* xm = (LAS float*)c.lds; LAS float* tw = xm + RWC; LAS float* ad = tw + 64; LAS float* sg = ad + 64;
    const int tid = c.tid;
    float* R = RW; float* WD = RW + (size_t)MPAD * BW; float* K2 = WD + (size_t)MPAD * BW; float* V = K2 + (size_t)MPAD * BW; float* KK = V + (size_t)MPAD * BW;
    float* BV = KK + (size_t)MPAD * BW; float* G = BV + (size_t)MPAD * BW; float* BON = G + (size_t)MPAD * BW;
    for (int row = c.bid; row < MT; row += c.G) {
        const bf16_t* ur = U + (size_t)row * NINP + U_RU; const bf16_t* pr = ur - NINP; const float* ps = nullptr; bool first;
        if (row < MP) first = (row % PS) == 0; else { first = ((row - MP) % SS) == 0; ps = shift + (size_t)((row - MP) / SS) * RWC; }
        for (int cc = tid; cc < RWC; cc += 512) { const float x = bf2f(ur[cc]); const float s = first ? (ps ? ps[cc] : 0.f) : bf2f(pr[cc]); xm[cc] = x + (s - x) * mu[cc]; }
        __syncthreads();
        if (tid < 64) { tw[tid] = tanhf(xm[3072 + tid]); ad[tid] = xm[3136 + tid]; }
        if (tid >= 128 && tid < 256) sg[tid - 128] = sigmoidf_(xm[3200 + tid - 128]);
        __syncthreads();
        for (int qd = 0; qd < 2; ++qd) {
            const int cc = qd * 512 + tid; float accw = w0[cc], acca = a0[cc], accg = 0.f;
#pragma unroll 4
            for (int j = 0; j < 64; ++j) { accw += tw[j] * w2[j * BW + cc]; acca += ad[j] * a2[j * BW + cc]; }
#pragma unroll 4
            for (int j = 0; j < 128; ++j) accg += sg[j] * g2[j * BW + cc];
            const float lw = -softplusf_(-accw) - 0.5f, decay = __expf(-__expf(lw)), a = sigmoidf_(acca);
            const float r = xm[cc], k = xm[1024 + cc], v = xm[2048 + cc];
            const float kkr = k * k_k[cc]; const float ss = wave_sum(kkr * kkr); const float kk = kkr / fmaxf(sqrtf(ss), 1e-12f);
            const float k2 = k * (1.0f + (a - 1.0f) * k_a[cc]); const float rk = wave_sum(r * k2 * r_k[cc]);
            const size_t o = (size_t)row * BW + cc;
            R[o] = r; WD[o] = decay; K2[o] = k2; V[o] = v; KK[o] = kk; BV[o] = kk * a; G[o] = accg; BON[o] = rk * v;
        }
        __syncthreads();
    }
}
__device__ __forceinline__ void ph_rwkv_scan_naive(const Ctx& c, const float* __restrict__ RW, const float* __restrict__ s0, const float* __restrict__ lng, const float* __restrict__ lnb, bf16_t* __restrict__ OB,
                                                   float* __restrict__ outP, float* __restrict__ outS) {
    const float* R = RW; const float* WD = RW + (size_t)MPAD * BW; const float* K2 = WD + (size_t)MPAD * BW; const float* V = K2 + (size_t)MPAD * BW; const float* KK = V + (size_t)MPAD * BW;
    const float* BV = KK + (size_t)MPAD * BW; const float* G = BV + (size_t)MPAD * BW; const float* BON = G + (size_t)MPAD * BW;
    const int lane = c.lane;
    for (int it = 0;; ++it) {
        const int u = (it * 8 + c.wave) * c.G + c.bid;
        if (u >= (PB + SB) * 16) break;
        const int sq = u >> 4, h = u & 15;
        int row0, L; seq_info(sq, row0, L);
        float S[64];
        if (sq >= PB) { const float* p = s0 + (((size_t)(sq - PB) * 16 + h) * 64 + lane) * 64;
#pragma unroll
            for (int j = 0; j < 64; ++j) S[j] = p[j]; }
        else {
#pragma unroll
            for (int j = 0; j < 64; ++j) S[j] = 0.f; }
        const float lg = lng[h * 64 + lane], lb = lnb[h * 64 + lane];
        for (int t = 0; t < L; ++t) {
            const size_t base = (size_t)(row0 + t) * BW + h * 64; const float v = V[base + lane];
            float d = 0.f;
#pragma unroll
            for (int j = 0; j < 64; ++j) d += S[j] * KK[base + j];
            float y = 0.f;
#pragma unroll
            for (int j = 0; j < 64; ++j) { S[j] = S[j] * WD[base + j] - d * BV[base + j] + v * K2[base + j]; y += S[j] * R[base + j]; }
            const float mean = wave_sum(y) * (1.0f / 64.0f), dy = y - mean, var = wave_sum(dy * dy) * (1.0f / 64.0f);
            const float yn = dy * rsqrtf(var + 64e-5f) * lg + lb;
            OB[base + lane] = f2bf((yn + BON[base + lane]) * G[base + lane]);
        }
        float* op = (sq < PB ? outP + (((size_t)sq * 16 + h) * 64 + lane) * 64 : outS + (((size_t)(sq - PB) * 16 + h) * 64 + lane) * 64);
#pragma unroll
        for (int j = 0; j < 64; ++j) op[j] = S[j];
    }
}
__device__ __forceinline__ void ph_rwkv_scan2(const Ctx& c, int boff, const float* __restrict__ RW, const float* __restrict__ s0, const float* __restrict__ lng, const float* __restrict__ lnb, bf16_t* __restrict__ OB,
                                              float* __restrict__ outP, float* __restrict__ outS) {
    LAS float* opb = (LAS float*)c.lds;
    LAS float* yb = opb + 2 * 16 * 384;
    const int tid = c.tid, lane = c.lane, w = c.wave, rl = lane >> 3, cg = lane & 7, vrow = w * 8 + rl;
    const float* G = RW + 6 * (size_t)MPAD * BW; const float* BON = RW + 7 * (size_t)MPAD * BW;
    for (int u = (c.bid - boff + c.G) % c.G; u < (PB + SB) * 16; u += c.G) {
        const int sq = u >> 4, h = u & 15;
        int row0, L; seq_info(sq, row0, L);
        float S[8];
        if (sq >= PB) { const float* p = s0 + (((size_t)(sq - PB) * 16 + h) * 64 + vrow) * 64 + cg * 8;
#pragma unroll
            for (int j = 0; j < 8; ++j) S[j] = p[j]; }
        else {
#pragma unroll
            for (int j = 0; j < 8; ++j) S[j] = 0.f; }
        const float lg = lng[h * 64 + lane], lb = lnb[h * 64 + lane];
        const int nb = (L + 15) >> 4;
#define RW_STAGE(bi_) do { const int t0_ = (bi_) * 16, nT_ = (L - t0_) < 16 ? (L - t0_) : 16; LAS float* dst_ = opb + ((bi_) & 1) * 16 * 384; \
        for (int idx = tid; idx < nT_ * 96; idx += 512) { const int t = idx / 96, rem = idx - t * 96, slot = rem >> 4, c4 = rem & 15; \
            const int arr = slot == 0 ? 1 : slot == 1 ? 4 : slot == 2 ? 5 : slot == 3 ? 2 : slot == 4 ? 0 : 3; \
            *(LAS f32x4*)(dst_ + t * 384 + slot * 64 + c4 * 4) = *(const f32x4*)(RW + (size_t)arr * MPAD * BW + (size_t)(row0 + t0_ + t) * BW + h * 64 + c4 * 4); } } while (0)
        RW_STAGE(0);
        for (int bi = 0; bi < nb; ++bi) {
            __syncthreads();
            if (bi + 1 < nb) RW_STAGE(bi + 1);
            const int t0 = bi * 16, nT = (L - t0) < 16 ? (L - t0) : 16; const LAS float* src = opb + (bi & 1) * 16 * 384;
            for (int tt = 0; tt < nT; ++tt) {
                const LAS float* b = src + tt * 384 + cg * 8;
                const f32x4 w0 = *(const LAS f32x4*)(b), w1 = *(const LAS f32x4*)(b + 4), k0 = *(const LAS f32x4*)(b + 64), k1 = *(const LAS f32x4*)(b + 68);
                const f32x4 b0 = *(const LAS f32x4*)(b + 128), b1 = *(const LAS f32x4*)(b + 132), q0 = *(const LAS f32x4*)(b + 192), q1 = *(const LAS f32x4*)(b + 196);
                const f32x4 r0 = *(const LAS f32x4*)(b + 256), r1 = *(const LAS f32x4*)(b + 260); const float v = src[tt * 384 + 320 + vrow];
                float d = (S[0] * k0[0] + S[1] * k0[1]) + (S[2] * k0[2] + S[3] * k0[3]) + (S[4] * k1[0] + S[5] * k1[1]) + (S[6] * k1[2] + S[7] * k1[3]);
                d += __shfl_xor(d, 1, 64); d += __shfl_xor(d, 2, 64); d += __shfl_xor(d, 4, 64);
                float y = 0.f;
#pragma unroll
                for (int j = 0; j < 4; ++j) { S[j] = S[j] * w0[j] - d * b0[j] + v * q0[j]; y += S[j] * r0[j]; S[4 + j] = S[4 + j] * w1[j] - d * b1[j] + v * q1[j]; y += S[4 + j] * r1[j]; }
                y += __shfl_xor(y, 1, 64); y += __shfl_xor(y, 2, 64); y += __shfl_xor(y, 4, 64);
                if (cg == 0) yb[tt * 64 + vrow] = y;
            }
            __syncthreads();
            for (int tt = w; tt < nT; tt += 8) {
                const float y = yb[tt * 64 + lane]; const float mean = wave_sum(y) * (1.0f / 64.0f), dy = y - mean, var = wave_sum(dy * dy) * (1.0f / 64.0f);
                const float yn = dy * rsqrtf(var + 64e-5f) * lg + lb; const size_t o = (size_t)(row0 + t0 + tt) * BW + h * 64 + lane;
                OB[o] = f2bf((yn + BON[o]) * G[o]);
            }
        }
#undef RW_STAGE
        float* op = (sq < PB ? outP + (((size_t)sq * 16 + h) * 64 + vrow) * 64 : outS + (((size_t)(sq - PB) * 16 + h) * 64 + vrow) * 64) + cg * 8;
#pragma unroll
        for (int j = 0; j < 8; ++j) op[j] = S[j];
        __syncthreads();
    }
}
__device__ __forceinline__ void ph_memattn_sample(const Ctx& c, const bf16_t* __restrict__ U, const float* __restrict__ mk, const float* __restrict__ mv, bf16_t* __restrict__ OB) {
    LAS float* qs = (LAS float*)c.lds; LAS float* ps = qs + 2 * 4 * 256;
    const int hh = c.tid >> 8, vt = c.tid & 255, lane = c.lane;
    for (int u = c.bid; u < SB * 2; u += c.G) {
        const int sq = u >> 1, h = (u & 1) * 2 + hh;
#pragma unroll
        for (int t = 0; t < 4; ++t) qs[(hh * 4 + t) * 256 + vt] = bf2f(U[(size_t)(MP + sq * SS + t) * NINP + U_MQ + h * 256 + vt]) * 0.0625f;
        __syncthreads();
        { const float* kr = mk + (((size_t)sq * MEMT + vt) * 4 + h) * 256; float s[4] = {0.f, 0.f, 0.f, 0.f};
            for (int d = 0; d < 256; d += 4) { const f32x4 kv = *(const f32x4*)(kr + d);
#pragma unroll
                for (int t = 0; t < 4; ++t) { const LAS float* qq = qs + (hh * 4 + t) * 256 + d; s[t] += kv[0] * qq[0] + kv[1] * qq[1] + kv[2] * qq[2] + kv[3] * qq[3]; } }
#pragma unroll
            for (int t = 0; t < 4; ++t) ps[(hh * 4 + t) * 256 + vt] = s[t]; }
        __syncthreads();
        { LAS float* pr = ps + c.wave * 256; float x[4]; float mx = -3.0e38f;
#pragma unroll
            for (int j = 0; j < 4; ++j) { x[j] = pr[lane + 64 * j]; mx = fmaxf(mx, x[j]); }
            mx = wave_max(mx); float s = 0.f;
#pragma unroll
            for (int j = 0; j < 4; ++j) { x[j] = __expf(x[j] - mx); s += x[j]; }
            const float inv = 1.0f / wave_sum(s);
#pragma unroll
            for (int j = 0; j < 4; ++j) pr[lane + 64 * j] = x[j] * inv; }
        __syncthreads();
        { float o[4] = {0.f, 0.f, 0.f, 0.f}; const float* vr = mv + ((size_t)sq * MEMT * 4 + h) * 256 + vt;
            for (int m = 0; m < MEMT; ++m) { const float vv = vr[(size_t)m * 1024];
#pragma unroll
                for (int t = 0; t < 4; ++t) o[t] += ps[(hh * 4 + t) * 256 + m] * vv; }
#pragma unroll
            for (int t = 0; t < 4; ++t) OB[(size_t)(MP + sq * SS + t) * BW + h * 256 + vt] = f2bf(o[t]); }
        __syncthreads();
    }
}

constexpr int LDS_BAR_OFF = pg8::STAGE_BYTES;
constexpr int LDS_BYTES = pg8::STAGE_BYTES + 64;
struct Args { const float* in[37]; float* out; unsigned char* ws; };

typedef pg8::Gemm<DM, DM, DM, 2, 8, NL, 1, false, 0, 0, (long)DM * DM, 0> GemmMem;
typedef pg8::Gemm<DM, DM, DM, MPAD / 256, NINP / 256> GemmIn;
typedef pg8::Gemm<NINP, 1024, 256, PS / 256, 1, 8, 4, false, (long)PS * NINP, 256, 256 * 1024, 256> GemmScore;
typedef pg8::Gemm<256, 256, 256, PS / 256, 1, 8, 4, false, (long)4 * 4096 * 256, (long)4096 * 256, 4 * 65536, 65536> GemmPV;
typedef pg8::Gemm<BW, BW, BW, MPAD / 256, DM / 256, 4, 1, true, (long)MPAD * BW, 0, (long)DM * BW, 0> GemmBranch;
typedef pg8::Gemm<DM, DM, DM, MPAD / 256, DM / 256> GemmOut;
typedef pg8::Gemm<DM, DM, DM, MPAD / 256, 2 * DFF / 256> GemmGU;
typedef pg8::Gemm<DFF, DFF, DFF, MPAD / 256, DM / 256> GemmDown;
template <class GT> __device__ __forceinline__ GT mk_gemm(const Ctx& c, const bf16_t* A, const bf16_t* B) { GT g; g.A = A; g.B = B; g.G = c.G; g.c = c.bid; return g; }

template <int OFF> __device__ __forceinline__ unsigned long long karg_u64(unsigned long long kargs) {
    unsigned long long p; asm volatile("s_load_dwordx2 %0, %1, %2\n\ts_waitcnt lgkmcnt(0)" : "=s"(p) : "s"(kargs), "n"(OFF) : "memory"); return p;
}
#define INP(k) ((const float*)karg_u64<(k) * 8>(kargs))
#define OUTP() ((float*)karg_u64<37 * 8>(kargs))
#define WSP() ((unsigned char*)karg_u64<38 * 8>(kargs))

__global__ void __launch_bounds__(512, 2) mega_fwd(Args a_unused) {
    extern __shared__ __attribute__((aligned(16))) unsigned char lds_raw[];
    const unsigned long long kargs = (unsigned long long)__builtin_amdgcn_kernarg_segment_ptr();
    Ctx c0; c0.tid = threadIdx.x; c0.lane = c0.tid & 63; c0.wave = __builtin_amdgcn_readfirstlane(c0.tid >> 6); c0.bid = blockIdx.x; c0.G = gridDim.x; c0.lds = (LAS unsigned char*)lds_raw;
    if (c0.tid < 4) ((LAS unsigned*)(c0.lds + LDS_BAR_OFF))[c0.tid] = 0u;
    __syncthreads();
    const XcdBarrier bar = xcd_barrier_post((unsigned*)(WSP() + WS_CTL), (volatile LAS unsigned*)(c0.lds + LDS_BAR_OFF));

    { const Ctx c = fresh(c0); unsigned char* ws = WSP();
      ph_wprep(c, INP(10), (bf16_t*)(ws + WS_WIN), DM, NIN, NINP, 1, NL, (size_t)DM * NIN, (size_t)NINP * DM);
      ph_wprep(c, INP(28), (bf16_t*)(ws + WS_WMEM), DM, DM, DM, 0, NL, (size_t)DM * DM, (size_t)DM * DM);
      ph_wprep(c, INP(29), (bf16_t*)(ws + WS_WBR), BW, DM, DM, 0, NL * 4, (size_t)BW * DM, (size_t)DM * BW);
      ph_wprep(c, INP(30), (bf16_t*)(ws + WS_WOUT), DM, DM, DM, 0, NL, (size_t)DM * DM, (size_t)DM * DM);
      ph_wprep(c, INP(33), (bf16_t*)(ws + WS_WGU), DM, 2 * DFF, 2 * DFF, 2, NL, (size_t)DM * 2 * DFF, (size_t)2 * DFF * DM);
      ph_wprep(c, INP(34), (bf16_t*)(ws + WS_WDN), DFF, DM, DM, 0, NL, (size_t)DFF * DM, (size_t)DM * DFF);
      ph_xprep(c, INP(0), INP(1), INP(2), (float*)(ws + WS_HF), (bf16_t*)(ws + WS_HB), (bf16_t*)(ws + WS_MEMB)); }
    xcd_barrier(bar);
    { const Ctx c = fresh(c0); unsigned char* ws = WSP(); float* out = OUTP();
      GemmMem g = mk_gemm<GemmMem>(c, (const bf16_t*)(ws + WS_MEMB), (const bf16_t*)(ws + WS_WMEM));
      pg8::EpiMem E; E.outK = out + O_MKP; E.outV = out + O_MVP; E.kb = (bf16_t*)(ws + WS_MKB); E.vt = (bf16_t*)(ws + WS_MVT); pg8::gemm_phase<GemmMem, pg8::EpiMem, true, true>(c.lds, c.tid, g, E); }

    for (int l = 0; l < NL; ++l) {
        { const Ctx c = fresh(c0); unsigned char* ws = WSP();
          GemmIn g = mk_gemm<GemmIn>(c, (const bf16_t*)(ws + WS_HB), (const bf16_t*)(ws + WS_WIN) + (size_t)l * NINP * DM);
          pg8::EpiBf16 E; E.O = (bf16_t*)(ws + WS_U); E.zs = 0; E.ldc = NINP; E.pad = 0; pg8::gemm_phase<GemmIn, pg8::EpiBf16, true, true>(c.lds, c.tid, g, E); }
        xcd_barrier(bar);
        { const Ctx c = fresh(c0); unsigned char* ws = WSP(); float* out = OUTP(); const bf16_t* U = (const bf16_t*)(ws + WS_U); bf16_t* BR = (bf16_t*)(ws + WS_BR);
          (void)out; (void)BR;
          ph_gla_pre(c, U, INP(12) + (size_t)l * 16 * 512, INP(13) + (size_t)l * 512, (bf16_t*)(ws + WS_GLQD), (bf16_t*)(ws + WS_GLKH), (bf16_t*)(ws + WS_GLE), (bf16_t*)(ws + WS_GLVT), (float*)(ws + WS_GLGC)); }
        { const Ctx c = fresh(c0); unsigned char* ws = WSP();
          ph_rwkv_prep(c, (const bf16_t*)(ws + WS_U), INP(9) + (size_t)l * SB * RWC, INP(17) + (size_t)l * RWC, INP(18) + (size_t)l * BW, INP(19) + (size_t)l * 64 * BW, INP(20) + (size_t)l * BW, INP(21) + (size_t)l * 64 * BW,
                       INP(22) + (size_t)l * 128 * BW, INP(23) + (size_t)l * BW, INP(24) + (size_t)l * BW, INP(25) + (size_t)l * BW, (float*)(ws + WS_RW)); }
        { const Ctx c = fresh(c0); unsigned char* ws = WSP();
          ph_swa_naive(c, (const bf16_t*)(ws + WS_U), INP(3) + (size_t)l * SB * 16384, INP(4) + (size_t)l * SB * 16384, INP(16) + (size_t)l * 16, (bf16_t*)(ws + WS_BR) + (size_t)MPAD * BW); }
        { const Ctx c = fresh(c0); unsigned char* ws = WSP();
          ph_copy_outs(c, (const bf16_t*)(ws + WS_U), INP(3) + (size_t)l * SB * 16384, INP(4) + (size_t)l * SB * 16384, OUTP(), l); }
        { const Ctx c = fresh(c0); unsigned char* ws = WSP();
          ph_memattn_sample(c, (const bf16_t*)(ws + WS_U), INP(5) + (size_t)l * SB * MEMT * 1024, INP(6) + (size_t)l * SB * MEMT * 1024, (bf16_t*)(ws + WS_BR) + (size_t)3 * MPAD * BW); }
        { const Ctx c = fresh(c0); unsigned char* ws = WSP();
          GemmScore g = mk_gemm<GemmScore>(c, (const bf16_t*)(ws + WS_U) + U_MQ, (const bf16_t*)(ws + WS_MKB) + (size_t)l * 512 * 1024);
          pg8::EpiScore E; E.SC = (float*)(ws + WS_SC); pg8::gemm_phase<GemmScore, pg8::EpiScore, true, true>(c.lds, c.tid, g, E); }
        xcd_barrier(bar);
        { const Ctx c = fresh(c0); unsigned char* ws = WSP(); float* out = OUTP();
          ph_rwkv_scan2(c, 64, (const float*)(ws + WS_RW), INP(8) + (size_t)l * SB * 16 * 4096, INP(26) + (size_t)l * BW, INP(27) + (size_t)l * BW, (bf16_t*)(ws + WS_BR) + (size_t)2 * MPAD * BW,
                             out + O_RWP + (size_t)l * PB * 16 * 4096, out + O_RWS + (size_t)l * SB * 16 * 4096); }
        { const Ctx c = fresh(c0); unsigned char* ws = WSP(); float* out = OUTP();
          ph_gla_seq(c, 32, (const bf16_t*)(ws + WS_GLQD), (const bf16_t*)(ws + WS_GLKH), (const bf16_t*)(ws + WS_GLE), (const bf16_t*)(ws + WS_GLVT), (const float*)(ws + WS_GLGC),
                     INP(7) + (size_t)l * SB * 4 * 32768, out + O_GLAP + (size_t)l * PB * 4 * 32768, out + O_GLAS + (size_t)l * SB * 4 * 32768, (bf16_t*)(ws + WS_BR)); }
        { const Ctx c = fresh(c0); unsigned char* ws = WSP(); ph_softmax256(c, (const float*)(ws + WS_SC), (bf16_t*)(ws + WS_PB), 8 * 4096); }
        xcd_barrier(bar);
        { const Ctx c = fresh(c0); unsigned char* ws = WSP(); ph_gla_fin(c, (const bf16_t*)(ws + WS_U), INP(14) + (size_t)l * BW, INP(15) + (size_t)l * BW, (bf16_t*)(ws + WS_BR)); }
        { const Ctx c = fresh(c0); unsigned char* ws = WSP();
          GemmPV g = mk_gemm<GemmPV>(c, (const bf16_t*)(ws + WS_PB), (const bf16_t*)(ws + WS_MVT) + (size_t)l * 8 * 65536);
          pg8::EpiPV E; E.O = (bf16_t*)(ws + WS_BR) + (size_t)3 * MPAD * BW; pg8::gemm_phase<GemmPV, pg8::EpiPV, true, true>(c.lds, c.tid, g, E); }
        xcd_barrier(bar);
        { const Ctx c = fresh(c0); unsigned char* ws = WSP();
          GemmBranch g = mk_gemm<GemmBranch>(c, (const bf16_t*)(ws + WS_BR), (const bf16_t*)(ws + WS_WBR) + (size_t)l * 4 * DM * BW);
          pg8::EpiMerge E; E.MG = (float*)(ws + WS_MG); E.MGB = (bf16_t*)(ws + WS_MGB); E.U = (const bf16_t*)(ws + WS_U); E.gate_b = INP(11) + (size_t)l * 4 * DM; pg8::gemm_phase<GemmBranch, pg8::EpiMerge, true, true>(c.lds, c.tid, g, E); }
        xcd_barrier(bar);
        { const Ctx c = fresh(c0); unsigned char* ws = WSP();
          GemmOut g = mk_gemm<GemmOut>(c, (const bf16_t*)(ws + WS_MGB), (const bf16_t*)(ws + WS_WOUT) + (size_t)l * DM * DM);
          pg8::EpiRes E; E.R = (const float*)(ws + WS_HF); E.Y = (float*)(ws + WS_Y); pg8::gemm_phase<GemmOut, pg8::EpiRes, true, true>(c.lds, c.tid, g, E); }
        xcd_barrier(bar);
        { const Ctx c = fresh(c0); unsigned char* ws = WSP(); ph_ln(c, (const float*)(ws + WS_Y), INP(31) + (size_t)l * DM, INP(32) + (size_t)l * DM, (float*)(ws + WS_X1F), (bf16_t*)(ws + WS_X1B), nullptr, MPAD, 0); }
        xcd_barrier(bar);
        { const Ctx c = fresh(c0); unsigned char* ws = WSP();
          GemmGU g = mk_gemm<GemmGU>(c, (const bf16_t*)(ws + WS_X1B), (const bf16_t*)(ws + WS_WGU) + (size_t)l * 2 * DFF * DM);
          pg8::EpiSwiGLU E; E.O = (bf16_t*)(ws + WS_ACT); pg8::gemm_phase<GemmGU, pg8::EpiSwiGLU, true, true>(c.lds, c.tid, g, E); }
        xcd_barrier(bar);
        { const Ctx c = fresh(c0); unsigned char* ws = WSP();
          GemmDown g = mk_gemm<GemmDown>(c, (const bf16_t*)(ws + WS_ACT), (const bf16_t*)(ws + WS_WDN) + (size_t)l * DM * DFF);
          pg8::EpiRes E; E.R = (const float*)(ws + WS_X1F); E.Y = (float*)(ws + WS_Y); pg8::gemm_phase<GemmDown, pg8::EpiRes, true, true>(c.lds, c.tid, g, E); }
        xcd_barrier(bar);
        { const Ctx c = fresh(c0); unsigned char* ws = WSP(); float* out = OUTP(); ph_ln(c, (const float*)(ws + WS_Y), INP(35) + (size_t)l * DM, INP(36) + (size_t)l * DM, (float*)(ws + WS_HF), (bf16_t*)(ws + WS_HB), l == NL - 1 ? out : nullptr, MPAD, MT); }
        xcd_barrier(bar);
    }
}

extern "C" void kernel_launch(void* const* d_in, const int* in_sizes, int n_in, void* d_out, int out_size, void* d_ws, size_t ws_size, hipStream_t stream) {
    static int grid = 0;
    if (grid == 0) {
        if (n_in != 37 || (size_t)out_size != O_END || ws_size < WS_END) { fprintf(stderr, "kernel_launch: unexpected sizes (n_in %d out %d ws %zu need %zu)\n", n_in, out_size, ws_size, (size_t)WS_END); grid = -1; return; }
        int dev = 0, cus = 0;
        if (hipGetDevice(&dev) != hipSuccess || hipDeviceGetAttribute(&cus, hipDeviceAttributeMultiprocessorCount, dev) != hipSuccess) { grid = -1; return; }
        if (hipFuncSetAttribute((const void*)mega_fwd, hipFuncAttributeMaxDynamicSharedMemorySize, LDS_BYTES) != hipSuccess) { fprintf(stderr, "kernel_launch: hipFuncSetAttribute failed\n"); grid = -1; return; }
        int per_cu = 0;
        if (hipOccupancyMaxActiveBlocksPerMultiprocessor(&per_cu, (const void*)mega_fwd, 512, LDS_BYTES) != hipSuccess || per_cu < 1) { fprintf(stderr, "kernel_launch: occupancy query says %d\n", per_cu); }
        (void)hipGetLastError();
        grid = cus;
    }
    if (grid < 0) return;
    (void)hipMemsetAsync((unsigned char*)d_ws + WS_CTL, 0, XCD_BAR_WORDS * sizeof(unsigned), stream);
    Args a; memset(&a, 0, sizeof a);
    for (int i = 0; i < 37; ++i) a.in[i] = (const float*)d_in[i];
    a.out = (float*)d_out; a.ws = (unsigned char*)d_ws;
    hipLaunchKernelGGL(mega_fwd, dim3(grid), dim3(512), LDS_BYTES, stream, a);
}
```

```cpp
#include <hip/hip_runtime.h>
#include <cstdio>
#include <cstdint>
#include <cstring>

#define LAS __attribute__((address_space(3)))
typedef unsigned short bf16_t;
typedef short bf16x8 __attribute__((ext_vector_type(8)));
typedef float f32x4 __attribute__((ext_vector_type(4)));
typedef float f32x2 __attribute__((ext_vector_type(2)));
typedef unsigned u32x4 __attribute__((ext_vector_type(4)));
typedef unsigned u32x2 __attribute__((ext_vector_type(2)));

constexpr int DM = 2048, NL = 4;
constexpr int PB = 2, PS = 4096, MP = PB * PS;
constexpr int SB = 32, SS = 4, MS = SB * SS;
constexpr int MT = MP + MS;
constexpr int MPAD = 8448;
constexpr int NIN = 16912, NINP = 17152;
constexpr int U_GQ = 0, U_GK = 512, U_GV = 1024, U_GR = 2048, U_GA = 3072, U_SQ = 3328, U_SK = 4352, U_SV = 4480, U_RU = 4608, U_MQ = 7936, U_GP = 8960;
constexpr int RWC = 3328, BW = 1024, DFF = 5632, MEMT = 256;
constexpr float ALPHA = 1.681792830507429f;

constexpr size_t O_YP = 0;
constexpr size_t O_YS = O_YP + (size_t)MP * DM;
constexpr size_t O_SWKP = O_YS + (size_t)MS * DM;
constexpr size_t O_SWVP = O_SWKP + (size_t)NL * PB * 128 * 128;
constexpr size_t O_MKP = O_SWVP + (size_t)NL * PB * 128 * 128;
constexpr size_t O_MVP = O_MKP + (size_t)NL * PB * 256 * 1024;
constexpr size_t O_GLAP = O_MVP + (size_t)NL * PB * 256 * 1024;
constexpr size_t O_RWP = O_GLAP + (size_t)NL * PB * 4 * 128 * 256;
constexpr size_t O_RSP = O_RWP + (size_t)NL * PB * 16 * 64 * 64;
constexpr size_t O_SWKS = O_RSP + (size_t)NL * PB * RWC;
constexpr size_t O_SWVS = O_SWKS + (size_t)NL * SB * 128 * 128;
constexpr size_t O_GLAS = O_SWVS + (size_t)NL * SB * 128 * 128;
constexpr size_t O_RWS = O_GLAS + (size_t)NL * SB * 4 * 128 * 256;
constexpr size_t O_RSS = O_RWS + (size_t)NL * SB * 16 * 64 * 64;
constexpr size_t O_END = O_RSS + (size_t)NL * SB * RWC;
static_assert(O_END == 52881408, "output size");

constexpr size_t al256(size_t x) { return (x + 255) & ~(size_t)255; }
constexpr size_t WS_CTL = 0;
constexpr size_t WS_WIN = 65536;
constexpr size_t WS_WMEM = WS_WIN + (size_t)NL * NINP * DM * 2;
constexpr size_t WS_WBR = WS_WMEM + (size_t)NL * DM * DM * 2;
constexpr size_t WS_WOUT = WS_WBR + (size_t)NL * 4 * DM * BW * 2;
constexpr size_t WS_WGU = WS_WOUT + (size_t)NL * DM * DM * 2;
constexpr size_t WS_WDN = WS_WGU + (size_t)NL * 2 * DFF * DM * 2;
constexpr size_t WS_HF = WS_WDN + (size_t)NL * DM * DFF * 2;
constexpr size_t WS_HB = WS_HF + (size_t)MPAD * DM * 4;
constexpr size_t WS_U = WS_HB + (size_t)MPAD * DM * 2;
constexpr size_t WS_BR = WS_U + (size_t)MPAD * NINP * 2;
constexpr size_t WS_MG = WS_BR + (size_t)4 * MPAD * BW * 2;
constexpr size_t WS_MGB = WS_MG + (size_t)MPAD * DM * 4;
constexpr size_t WS_Y = WS_MGB + (size_t)MPAD * DM * 2;
constexpr size_t WS_X1F = WS_Y + (size_t)MPAD * DM * 4;
constexpr size_t WS_X1B = WS_X1F + (size_t)MPAD * DM * 4;
constexpr size_t WS_ACT = WS_X1B + (size_t)MPAD * DM * 2;
constexpr size_t WS_MEMB = WS_ACT + (size_t)MPAD * DFF * 2;
constexpr size_t WS_MKB = WS_MEMB + (size_t)512 * DM * 2;
constexpr size_t WS_MVT = WS_MKB + (size_t)NL * 512 * 1024 * 2;
constexpr size_t WS_SC = WS_MVT + (size_t)NL * 8 * 256 * 256 * 2;
constexpr size_t WS_PB = WS_SC + (size_t)8 * 4096 * 256 * 4;
constexpr size_t WS_RW = WS_PB + (size_t)8 * 4096 * 256 * 2;
constexpr size_t RW_ARR = (size_t)MPAD * BW * 4;
constexpr int GL_NCH = 512 + 128;
constexpr size_t WS_GLQD = WS_RW + 8 * RW_ARR;
constexpr size_t WS_GLKH = WS_GLQD + (size_t)GL_NCH * 8192 * 2;
constexpr size_t WS_GLE = WS_GLKH + (size_t)GL_NCH * 8192 * 2;
constexpr size_t WS_GLVT = WS_GLE + (size_t)GL_NCH * 4096 * 2;
constexpr size_t WS_GLGC = WS_GLVT + (size_t)GL_NCH * 16384 * 2;
constexpr size_t WS_END = WS_GLGC + (size_t)GL_NCH * 128 * 4;

__device__ __forceinline__ float bf2f(bf16_t b) { return __uint_as_float(((unsigned)b) << 16); }
__device__ __forceinline__ bf16_t f2bf(float f) { unsigned u = __float_as_uint(f); u += 0x7FFFu + ((u >> 16) & 1u); return (bf16_t)(u >> 16); }
__device__ __forceinline__ unsigned pk2(float lo, float hi) { return (unsigned)f2bf(lo) | ((unsigned)f2bf(hi) << 16); }
__device__ __forceinline__ float wave_sum(float v) {
#pragma unroll
    for (int o = 32; o > 0; o >>= 1) v += __shfl_xor(v, o, 64);
    return v;
}
__device__ __forceinline__ float wave_max(float v) {
#pragma unroll
    for (int o = 32; o > 0; o >>= 1) v = fmaxf(v, __shfl_xor(v, o, 64));
    return v;
}
__device__ __forceinline__ float sigmoidf_(float x) { return 1.0f / (1.0f + __expf(-x)); }
__device__ __forceinline__ float softplusf_(float x) { return fmaxf(x, 0.f) + log1pf(__expf(-fabsf(x))); }

namespace pg8 {
constexpr int BM = 256, BK = 64, HALF = 128, HTB = HALF * BK * 2, STAGE_BYTES = 8 * HTB, NXCD = 8, WGM = 8;
__host__ __device__ __forceinline__ int lds_byte(int r, int c) { const int st = (r >> 4) * 2 + (c >> 5), rr = r & 15, cc = c & 31, ob = rr * 64 + cc * 2; return st * 1024 + (ob ^ (((ob >> 9) & 1) << 5)); }
__host__ __device__ __forceinline__ void stage_rc(int b, int& R, int& C) { const int st = b / 1024, sb = b % 1024, swz = sb ^ (((sb >> 9) & 1) << 5); R = (st >> 1) * 16 + swz / 64; C = (st & 1) * 32 + (swz % 64) / 2; }
__host__ __device__ __forceinline__ int perm32(int rho) { const int n = rho >> 4, i = rho & 15; return 8 * (i >> 2) + 4 * n + (i & 3); }

struct Unit { int pm, pn, z; };
template <int LDA_, int LDB_, int K_, int NM_, int NN_, int NZ_ = 1, int NZH_ = 1, bool ZINNER_ = false, long ZSAB_ = 0, long ZSAH_ = 0, long ZSBB_ = 0, long ZSBH_ = 0>
struct Gemm {
    static constexpr int LDA = LDA_, LDB = LDB_, K = K_, NM = NM_, NN = NN_, NZ = NZ_, NZH = NZH_; static constexpr bool ZINNER = ZINNER_;
    const bf16_t* A; const bf16_t* B; int G, c;
    __device__ __forceinline__ bool next(int i, Unit& u) const {
        constexpr int nt = NM * NN; int L, z;
        if (ZINNER) { const int it = i / NZ; z = i - it * NZ; const long LL = (long)it * G + c; if (LL >= nt) return false; L = (int)LL; }
        else { const long LL = (long)i * G + c; if (LL >= (long)nt * NZ) return false; z = (int)(LL / nt); L = (int)(LL - (long)z * nt); }
        int wgid = L; { constexpr int q = nt / NXCD, r = nt % NXCD; const int xcd = wgid % NXCD, off = wgid / NXCD; wgid = (xcd < r ? xcd * (q + 1) : r * (q + 1) + (xcd - r) * q) + off; }
        constexpr int nig = WGM * NN; const int gid = wgid / nig, fm = gid * WGM, gsz = (NM - fm) < WGM ? (NM - fm) : WGM;
        u.pm = fm + ((wgid % nig) % gsz); u.pn = (wgid % nig) / gsz; u.z = z; return true;
    }
    __device__ __forceinline__ const char* a_base(const Unit& u) const { const int zb = u.z / NZH, zh = u.z - zb * NZH; return (const char*)(A + zb * ZSAB_ + zh * ZSAH_ + (long)u.pm * BM * LDA); }
    __device__ __forceinline__ const char* b_base(const Unit& u) const { const int zb = u.z / NZH, zh = u.z - zb * NZH; return (const char*)(B + zb * ZSBB_ + zh * ZSBH_ + (long)u.pn * BM * LDB); }
};

template <class GT, class Epi, bool ALIGN_EPI = true, bool SP2 = true>
__device__ __forceinline__ void gemm_phase(LAS unsigned char* lds, const int tid, const GT& g, const Epi& E) {
    const int wid = __builtin_amdgcn_readfirstlane(tid >> 6), lane = tid & 63, wr = wid >> 2, wc = wid & 3, fr = lane & 15, fq = lane >> 4;
    constexpr int nt = GT::K / BK;
    unsigned voffA[2], voffB[2];
#pragma unroll
    for (int i = 0; i < 2; ++i) { int R, C; stage_rc(tid * 16 + i * 8192, R, C); const int Rb = Epi::PERM ? ((R & ~31) + perm32(R & 31)) : R;
        voffA[i] = (unsigned)(R * GT::LDA + C) * 2u; voffB[i] = (unsigned)(Rb * GT::LDB + C) * 2u; }
    constexpr size_t kstep = (size_t)(BK * 2);
    constexpr size_t hstepA = (size_t)HALF * GT::LDA * 2, hstepB = (size_t)HALF * GT::LDB * 2;
    const unsigned ldsw = (unsigned)wid * 1024u;
    const int aoff = lds_byte(wr * 64 + fr, fq * 8), boff = lds_byte(wc * 32 + fr, fq * 8);
#define PG8_SA(b, h) (((b) * 2 + (h)) * HTB)
#define PG8_SB(b, h) ((4 + (b) * 2 + (h)) * HTB)
#define PG8_STAGE(bufoff, gbase, voff) do { _Pragma("unroll") for (int _i = 0; _i < 2; ++_i) \
        __builtin_amdgcn_global_load_lds((const unsigned*)((const char*)(gbase) + (voff)[_i]), (LAS unsigned*)(lds + (bufoff) + ldsw + _i * 8192), 16, 0, 0); } while (0)
#define PG8_LDA(dst, b, h) do { _Pragma("unroll") for (int m = 0; m < 4; ++m) _Pragma("unroll") for (int k = 0; k < 2; ++k) dst[m][k] = *(const LAS bf16x8*)(lds + PG8_SA(b, h) + aoff + m * 2048 + k * 1024); } while (0)
#define PG8_LDB(dst, b, h) do { _Pragma("unroll") for (int n = 0; n < 2; ++n) _Pragma("unroll") for (int k = 0; k < 2; ++k) dst[n][k] = *(const LAS bf16x8*)(lds + PG8_SB(b, h) + boff + n * 2048 + k * 1024); } while (0)
#define PG8_MMA(ai, bj, At, Bt) do { __builtin_amdgcn_s_setprio(1); _Pragma("unroll") for (int m = 0; m < 4; ++m) _Pragma("unroll") for (int n = 0; n < 2; ++n) _Pragma("unroll") for (int k = 0; k < 2; ++k) \
        acc[ai][bj][m][n] = __builtin_amdgcn_mfma_f32_16x16x32_bf16(Bt[n][k], At[m][k], acc[ai][bj][m][n], 0, 0, 0); __builtin_amdgcn_s_setprio(0); } while (0)
#define PG8_WAIT_V(n) asm volatile("s_waitcnt vmcnt(" #n ")" ::: "memory")
#define PG8_WAIT_L(n) asm volatile("s_waitcnt lgkmcnt(" #n ")" ::: "memory")
#define PG8_BAR __builtin_amdgcn_s_barrier()
#define PG8_SCHED __builtin_amdgcn_sched_barrier(0)
    Unit cur, nxt; int ui = 0;
    if (!g.next(0, cur)) return;
    f32x4 acc[2][2][4][2];
#pragma unroll
    for (int a = 0; a < 2; ++a)
#pragma unroll
        for (int b = 0; b < 2; ++b)
#pragma unroll
            for (int m = 0; m < 4; ++m)
#pragma unroll
                for (int n = 0; n < 2; ++n) acc[a][b][m][n] = (f32x4){0.f, 0.f, 0.f, 0.f};
    bf16x8 At[4][2], B0[2][2], B1[2][2];
    const char* cA = g.a_base(cur); const char* cB = g.b_base(cur);
    if constexpr (SP2) {
        PG8_STAGE(PG8_SB(0, 0), cB, voffB); PG8_STAGE(PG8_SB(0, 1), cB + hstepB, voffB); PG8_STAGE(PG8_SA(0, 0), cA, voffA); PG8_STAGE(PG8_SA(0, 1), cA + hstepA, voffA);
        if (wr == 1) PG8_BAR;
        PG8_WAIT_V(2); PG8_BAR;
        PG8_STAGE(PG8_SB(1, 0), cB + kstep, voffB); PG8_STAGE(PG8_SA(1, 0), cA + kstep, voffA); PG8_STAGE(PG8_SB(1, 1), cB + hstepB + kstep, voffB);
        PG8_WAIT_V(6); PG8_BAR;
    } else {
        PG8_STAGE(PG8_SB(0, 0), cB, voffB); PG8_STAGE(PG8_SA(0, 0), cA, voffA); PG8_STAGE(PG8_SB(0, 1), cB + hstepB, voffB); PG8_STAGE(PG8_SA(0, 1), cA + hstepA, voffA);
        if (wr == 1) PG8_BAR;
        PG8_WAIT_V(4); PG8_BAR;
        PG8_STAGE(PG8_SB(1, 0), cB + kstep, voffB); PG8_STAGE(PG8_SA(1, 0), cA + kstep, voffA); PG8_STAGE(PG8_SB(1, 1), cB + hstepB + kstep, voffB);
        PG8_WAIT_V(6); PG8_BAR;
    }
    for (;;) {
        const bool has_next = g.next(ui + 1, nxt);
        const char* nA = has_next ? g.a_base(nxt) : cA; const char* nB = has_next ? g.b_base(nxt) : cB;
#pragma unroll 1
        for (int t = 0; t < nt; t += 2) {
            const bool last = (t == nt - 2);
            const char* a1 = cA + (size_t)(t + 1) * kstep;
            const char* a2 = last ? nA : cA + (size_t)(t + 2) * kstep; const char* b2 = last ? nB : cB + (size_t)(t + 2) * kstep;
            const char* a3 = a2 + kstep; const char* b3 = b2 + kstep;
            if constexpr (SP2) {
            PG8_LDB(B0, 0, 0); PG8_LDB(B1, 0, 1); PG8_SCHED; PG8_LDA(At, 0, 0); PG8_STAGE(PG8_SA(1, 1), a1 + hstepA, voffA);
            PG8_WAIT_V(8); PG8_WAIT_L(0); PG8_BAR; PG8_MMA(0, 0, At, B0); PG8_MMA(0, 1, At, B1); PG8_BAR; PG8_SCHED;
            PG8_LDA(At, 0, 1); PG8_STAGE(PG8_SB(0, 0), b2, voffB); PG8_STAGE(PG8_SB(0, 1), b2 + hstepB, voffB); PG8_STAGE(PG8_SA(0, 0), a2, voffA);
            PG8_WAIT_V(8); PG8_WAIT_L(0); PG8_BAR; PG8_MMA(1, 0, At, B0); PG8_MMA(1, 1, At, B1); PG8_BAR; PG8_SCHED;
            PG8_LDB(B0, 1, 0); PG8_LDB(B1, 1, 1); PG8_SCHED; PG8_LDA(At, 1, 0); PG8_STAGE(PG8_SA(0, 1), a2 + hstepA, voffA);
            PG8_WAIT_V(8); PG8_WAIT_L(0); PG8_BAR; PG8_MMA(0, 0, At, B0); PG8_MMA(0, 1, At, B1); PG8_BAR; PG8_SCHED;
            PG8_LDA(At, 1, 1); PG8_STAGE(PG8_SB(1, 0), b3, voffB); PG8_STAGE(PG8_SB(1, 1), b3 + hstepB, voffB); PG8_STAGE(PG8_SA(1, 0), a3, voffA);
            PG8_WAIT_V(8); PG8_WAIT_L(0); PG8_BAR; PG8_MMA(1, 0, At, B0); PG8_MMA(1, 1, At, B1); PG8_BAR; PG8_SCHED;
            } else {
            PG8_LDB(B0, 0, 0); PG8_SCHED; PG8_LDA(At, 0, 0); PG8_STAGE(PG8_SA(1, 1), a1 + hstepA, voffA);
            PG8_WAIT_L(8); PG8_BAR; PG8_WAIT_L(0); PG8_MMA(0, 0, At, B0); PG8_BAR; PG8_SCHED;
            PG8_LDB(B1, 0, 1); PG8_STAGE(PG8_SB(0, 0), b2, voffB);
            PG8_BAR; PG8_WAIT_L(0); PG8_MMA(0, 1, At, B1); PG8_BAR;
            PG8_LDA(At, 0, 1); PG8_STAGE(PG8_SA(0, 0), a2, voffA);
            PG8_BAR; PG8_WAIT_L(0); PG8_MMA(1, 0, At, B0); PG8_BAR; PG8_SCHED;
            PG8_STAGE(PG8_SB(0, 1), b2 + hstepB, voffB);
            PG8_WAIT_V(6); PG8_BAR; PG8_MMA(1, 1, At, B1); PG8_BAR;
            PG8_LDB(B0, 1, 0); PG8_SCHED; PG8_LDA(At, 1, 0); PG8_STAGE(PG8_SA(0, 1), a2 + hstepA, voffA);
            PG8_WAIT_L(8); PG8_BAR; PG8_WAIT_L(0); PG8_MMA(0, 0, At, B0); PG8_BAR; PG8_SCHED;
            PG8_LDB(B1, 1, 1); PG8_STAGE(PG8_SB(1, 0), b3, voffB);
            PG8_BAR; PG8_WAIT_L(0); PG8_MMA(0, 1, At, B1); PG8_BAR;
            PG8_LDA(At, 1, 1); PG8_STAGE(PG8_SA(1, 0), a3, voffA);
            PG8_BAR; PG8_WAIT_L(0); PG8_MMA(1, 0, At, B0); PG8_BAR; PG8_SCHED;
            PG8_STAGE(PG8_SB(1, 1), b3 + hstepB, voffB);
            PG8_WAIT_V(6); PG8_BAR; PG8_MMA(1, 1, At, B1); PG8_BAR;
            }
        }
        if constexpr (ALIGN_EPI) { if (wr == 0) PG8_BAR; }
        E(acc, cur, wr, wc, fr, fq);
        if (!has_next) break;
#pragma unroll
        for (int a = 0; a < 2; ++a)
#pragma unroll
            for (int b = 0; b < 2; ++b)
#pragma unroll
                for (int m = 0; m < 4; ++m)
#pragma unroll
                    for (int n = 0; n < 2; ++n) acc[a][b][m][n] = (f32x4){0.f, 0.f, 0.f, 0.f};
        cur = nxt; cA = nA; cB = nB; ++ui;
        if constexpr (ALIGN_EPI) { if (wr == 1) PG8_BAR; }
    }
    PG8_WAIT_V(0);
    if constexpr (!ALIGN_EPI) { if (wr == 0) PG8_BAR; }
    PG8_BAR;
#undef PG8_SA
#undef PG8_SB
#undef PG8_STAGE
#undef PG8_LDA
#undef PG8_LDB
#undef PG8_MMA
#undef PG8_WAIT_V
#undef PG8_WAIT_L
#undef PG8_BAR
#undef PG8_SCHED
}

struct EpiBf16 {
    static constexpr bool PERM = true;
    bf16_t* O; long zs; int ldc, pad;
    __device__ __forceinline__ void operator()(const f32x4 (&acc)[2][2][4][2], const Unit& u, int wr, int wc, int fr, int fq) const {
        const int row0 = u.pm * BM + wr * 64 + fr, col0 = u.pn * BM + wc * 32 + 8 * fq; bf16_t* base = O + (long)u.z * zs;
#pragma unroll
        for (int ai = 0; ai < 2; ++ai)
#pragma unroll
            for (int m = 0; m < 4; ++m) { bf16_t* rowp = base + (size_t)(row0 + ai * HALF + m * 16) * ldc + col0;
#pragma unroll
                for (int bj = 0; bj < 2; ++bj) { const f32x4 v0 = acc[ai][bj][m][0], v1 = acc[ai][bj][m][1];
                    u32x4 w; w.x = pk2(v0[0], v0[1]); w.y = pk2(v0[2], v0[3]); w.z = pk2(v1[0], v1[1]); w.w = pk2(v1[2], v1[3]);
                    *(u32x4*)(rowp + bj * HALF) = w; } }
    }
};
struct EpiMem {
    static constexpr bool PERM = false;
    float* outK; float* outV; bf16_t* kb; bf16_t* vt;
    __device__ __forceinline__ void operator()(const f32x4 (&acc)[2][2][4][2], const Unit& u, int wr, int wc, int fr, int fq) const {
        const int row0 = u.pm * BM + wr * 64 + fr, col0 = u.pn * BM + wc * 32 + 4 * fq;
#pragma unroll
        for (int ai = 0; ai < 2; ++ai)
#pragma unroll
            for (int m = 0; m < 4; ++m) { const int row = row0 + ai * HALF + m * 16;
#pragma unroll
                for (int bj = 0; bj < 2; ++bj)
#pragma unroll
                    for (int n = 0; n < 2; ++n) { const int col = col0 + bj * HALF + n * 16; const f32x4 v = acc[ai][bj][m][n];
                        if (col < 1024) { *(f32x4*)(outK + ((size_t)u.z * 512 + row) * 1024 + col) = v;
                            u32x2 w; w.x = pk2(v[0], v[1]); w.y = pk2(v[2], v[3]); *(u32x2*)(kb + ((size_t)u.z * 512 + row) * 1024 + col) = w; }
                        else { const int c = col - 1024; *(f32x4*)(outV + ((size_t)u.z * 512 + row) * 1024 + c) = v;
                            const int b = row >> 8, mm = row & 255, h = c >> 8, d = c & 255; bf16_t* p = vt + ((((size_t)u.z * 2 + b) * 4 + h) * 256 + d) * 256 + mm;
                            p[0] = f2bf(v[0]); p[256] = f2bf(v[1]); p[512] = f2bf(v[2]); p[768] = f2bf(v[3]); } } }
    }
};
struct EpiMerge {
    static constexpr bool PERM = false;
    float* MG; bf16_t* MGB; const bf16_t* U; const float* gate_b;
    __device__ __forceinline__ void operator()(const f32x4 (&acc)[2][2][4][2], const Unit& u, int wr, int wc, int fr, int fq) const {
        const int row0 = u.pm * BM + wr * 64 + fr, col0 = u.pn * BM + wc * 32 + 4 * fq;
#pragma unroll
        for (int ai = 0; ai < 2; ++ai)
#pragma unroll
            for (int m = 0; m < 4; ++m) { const int row = row0 + ai * HALF + m * 16;
#pragma unroll
                for (int bj = 0; bj < 2; ++bj)
#pragma unroll
                    for (int n = 0; n < 2; ++n) { const int col = col0 + bj * HALF + n * 16; const f32x4 v = acc[ai][bj][m][n];
                        const u32x2 gp = *(const u32x2*)(U + (size_t)row * NINP + U_GP + u.z * DM + col); const f32x4 gb = *(const f32x4*)(gate_b + u.z * DM + col);
                        f32x4 gt; gt[0] = sigmoidf_(__uint_as_float(gp.x << 16) + gb[0]); gt[1] = sigmoidf_(__uint_as_float(gp.x & 0xffff0000u) + gb[1]);
                        gt[2] = sigmoidf_(__uint_as_float(gp.y << 16) + gb[2]); gt[3] = sigmoidf_(__uint_as_float(gp.y & 0xffff0000u) + gb[3]);
                        float* mp = MG + (size_t)row * DM + col; f32x4 r = gt * v;
                        if (u.z > 0) r += *(const f32x4*)mp;
                        if (u.z < 3) *(f32x4*)mp = r;
                        else { u32x2 w; w.x = pk2(r[0], r[1]); w.y = pk2(r[2], r[3]); *(u32x2*)(MGB + (size_t)row * DM + col) = w; } } }
    }
};
struct EpiRes {
    static constexpr bool PERM = false;
    const float* R; float* Y;
    __device__ __forceinline__ void operator()(const f32x4 (&acc)[2][2][4][2], const Unit& u, int wr, int wc, int fr, int fq) const {
        const int row0 = u.pm * BM + wr * 64 + fr, col0 = u.pn * BM + wc * 32 + 4 * fq;
#pragma unroll
        for (int ai = 0; ai < 2; ++ai)
#pragma unroll
            for (int m = 0; m < 4; ++m) { const size_t ro = (size_t)(row0 + ai * HALF + m * 16) * DM + col0;
#pragma unroll
                for (int bj = 0; bj < 2; ++bj)
#pragma unroll
                    for (int n = 0; n < 2; ++n) { const size_t o = ro + bj * HALF + n * 16; *(f32x4*)(Y + o) = *(const f32x4*)(R + o) * ALPHA + acc[ai][bj][m][n]; } }
    }
};
struct EpiSwiGLU {
    static constexpr bool PERM = true;
    bf16_t* O;
    __device__ __forceinline__ void operator()(const f32x4 (&acc)[2][2][4][2], const Unit& u, int wr, int wc, int fr, int fq) const {
        const int row0 = u.pm * BM + wr * 64 + fr, col0 = u.pn * HALF + wc * 32 + 8 * fq;
#pragma unroll
        for (int ai = 0; ai < 2; ++ai)
#pragma unroll
            for (int m = 0; m < 4; ++m) { bf16_t* rowp = O + (size_t)(row0 + ai * HALF + m * 16) * DFF + col0;
                float r[8];
#pragma unroll
                for (int n = 0; n < 2; ++n)
#pragma unroll
                    for (int j = 0; j < 4; ++j) { const float gg = acc[ai][0][m][n][j], uu = acc[ai][1][m][n][j]; r[n * 4 + j] = gg * sigmoidf_(gg) * uu; }
                u32x4 w; w.x = pk2(r[0], r[1]); w.y = pk2(r[2], r[3]); w.z = pk2(r[4], r[5]); w.w = pk2(r[6], r[7]);
                *(u32x4*)rowp = w; }
    }
};
struct EpiScore {
    static constexpr bool PERM = false;
    float* SC;
    __device__ __forceinline__ void operator()(const f32x4 (&acc)[2][2][4][2], const Unit& u, int wr, int wc, int fr, int fq) const {
        const int row0 = u.pm * BM + wr * 64 + fr, col0 = wc * 32 + 4 * fq; float* base = SC + (size_t)u.z * 4096 * 256;
#pragma unroll
        for (int ai = 0; ai < 2; ++ai)
#pragma unroll
            for (int m = 0; m < 4; ++m) { float* rowp = base + (size_t)(row0 + ai * HALF + m * 16) * 256 + col0;
#pragma unroll
                for (int bj = 0; bj < 2; ++bj)
#pragma unroll
                    for (int n = 0; n < 2; ++n) *(f32x4*)(rowp + bj * HALF + n * 16) = acc[ai][bj][m][n] * 0.0625f; }
    }
};
struct EpiPV {
    static constexpr bool PERM = true;
    bf16_t* O;
    __device__ __forceinline__ void operator()(const f32x4 (&acc)[2][2][4][2], const Unit& u, int wr, int wc, int fr, int fq) const {
        const int b = u.z >> 2, h = u.z & 3; const int row0 = b * PS + u.pm * BM + wr * 64 + fr, col0 = h * 256 + wc * 32 + 8 * fq;
#pragma unroll
        for (int ai = 0; ai < 2; ++ai)
#pragma unroll
            for (int m = 0; m < 4; ++m) { bf16_t* rowp = O + (size_t)(row0 + ai * HALF + m * 16) * BW + col0;
#pragma unroll
                for (int bj = 0; bj < 2; ++bj) { const f32x4 v0 = acc[ai][bj][m][0], v1 = acc[ai][bj][m][1];
                    u32x4 w; w.x = pk2(v0[0], v0[1]); w.y = pk2(v0[2], v0[3]); w.z = pk2(v1[0], v1[1]); w.w = pk2(v1[2], v1[3]);
                    *(u32x4*)(rowp + bj * HALF) = w; } }
    }
};
}


#define XB_TMO      128
#define XB_XCNT(j)  (256  + 64 * (j))
#define XB_XSUB(j)  (1280 + 64 * (j))
#define XB_XGEN(j)  (2304 + 64 * (j))
#define XB_TOP      3328
#define XB_TOPGEN   3392
#define XCD_BAR_WORDS 3456
#define XB_SPIN_CAP (1u << 18)
__device__ __forceinline__ unsigned xb_ld(unsigned* p)              { return __hip_atomic_load(p, __ATOMIC_RELAXED, __HIP_MEMORY_SCOPE_AGENT); }
__device__ __forceinline__ unsigned xb_add(unsigned* p, unsigned v) { return __hip_atomic_fetch_add(p, v, __ATOMIC_RELAXED, __HIP_MEMORY_SCOPE_AGENT); }
__device__ __forceinline__ unsigned xb_xcc_id() { return (unsigned)__builtin_amdgcn_s_getreg((3 << 11) | 20) & 0xFu; }
#define XB_SPIN(cond, bar) do { unsigned _sp = 0; while (cond) { __builtin_amdgcn_s_sleep(1); \
    if ((++_sp & 255u) == 0u) { if (xb_ld(&(bar)[XB_TMO])) break; if (_sp > XB_SPIN_CAP) { atomicAdd(&(bar)[XB_TMO], 1u); break; } } } } while (0)
struct XcdBarrier { unsigned* bar; unsigned x; volatile LAS unsigned* st; };
__device__ __forceinline__ XcdBarrier xcd_barrier_post(unsigned* bar, volatile LAS unsigned* st) {
    XcdBarrier b; b.bar = bar; b.x = xb_xcc_id(); b.st = st;
    if (threadIdx.x == 0) (void)xb_add(&bar[XB_XCNT(b.x)], 1u);
    return b;
}
__device__ __forceinline__ void xcd_barrier_complete(unsigned* bar, unsigned x, unsigned& nloc, unsigned& nx) {
    const unsigned G = gridDim.x * gridDim.y * gridDim.z;
    unsigned sum, cnt, mine, sp = 0u;
    for (;;) {
        sum = 0u; cnt = 0u; mine = 0u;
#pragma unroll
        for (unsigned j = 0; j < 16; ++j) { const unsigned c = xb_ld(&bar[XB_XCNT(j)]); sum += c; cnt += (c > 0u) ? 1u : 0u; mine = (j == x) ? c : mine; }
        if (sum == G) break;
        __builtin_amdgcn_s_sleep(1);
        if ((++sp & 255u) == 0u) { if (xb_ld(&bar[XB_TMO])) break; if (sp > XB_SPIN_CAP) { atomicAdd(&bar[XB_TMO], 1u); break; } }
    }
    nloc = mine > 0u ? mine : 1u; nx = cnt > 0u ? cnt : 1u;
}
__device__ __forceinline__ void xcd_barrier(const XcdBarrier& b) {
    asm volatile("s_waitcnt vmcnt(0)" ::: "memory");
    __syncthreads();
    if (threadIdx.x == 0) {
        unsigned* bar = b.bar;
        __builtin_amdgcn_s_waitcnt(0);
        unsigned nloc = b.st[0], nx = b.st[1];
        if (nloc == 0u) { xcd_barrier_complete(bar, b.x, nloc, nx); b.st[0] = nloc; b.st[1] = nx; }
        const unsigned old = xb_add(&bar[XB_XSUB(b.x)], 1u);
        const unsigned gen = old / nloc;
        if (old + 1u == (gen + 1u) * nloc) {
            __builtin_amdgcn_fence(__ATOMIC_RELEASE, "agent");
            asm volatile("s_waitcnt vmcnt(0)" ::: "memory");
            const unsigned og = xb_add(&bar[XB_TOP], 1u);
            const unsigned tg = og / nx;
            if (og + 1u == (tg + 1u) * nx) xb_add(&bar[XB_TOPGEN], 1u);
            else XB_SPIN(xb_ld(&bar[XB_TOPGEN]) == tg, bar);
            __builtin_amdgcn_fence(__ATOMIC_ACQUIRE, "agent");
            xb_add(&bar[XB_XGEN(b.x)], 1u);
            asm volatile("s_waitcnt vmcnt(0)" ::: "memory");
        } else {
            XB_SPIN(xb_ld(&bar[XB_XGEN(b.x)]) == gen, bar);
            __builtin_amdgcn_fence(__ATOMIC_ACQUIRE, "agent");
            asm volatile("s_waitcnt vmcnt(0)" ::: "memory");
        }
    }
    __syncthreads();
}

struct Ctx { int tid, lane, wave, bid, G; LAS unsigned char* lds; };
__device__ __forceinline__ Ctx fresh(const Ctx& c0) { Ctx c; c.wave = c0.wave; c.bid = c0.bid; c.G = c0.G; c.lds = c0.lds; asm volatile("" : "+s"(c.bid), "+s"(c.G), "+s"(c.wave));
    int lane = (int)__builtin_amdgcn_mbcnt_hi(~0u, __builtin_amdgcn_mbcnt_lo(~0u, 0u)); asm volatile("" : "+v"(lane)); c.lane = lane; c.tid = c.wave * 64 + lane; return c; }

__device__ __forceinline__ int colmap(int mode, int n) {
    if (mode == 1) return n < 3088 ? n : (n < 3328 ? -1 : n - 240);
    if (mode == 2) { const int t = n >> 8, j = n & 255; return j < 128 ? t * 128 + j : DFF + t * 128 + (j - 128); }
    return n;
}
__device__ __forceinline__ void ph_wprep(const Ctx& c, const float* __restrict__ src, bf16_t* __restrict__ dst, int K, int Nsrc, int Ndst, int mode, int nbatch, size_t sbs, size_t dbs) {
    LAS float* tile = (LAS float*)c.lds;
    const int nx = Ndst / 64, ny = K / 64, total = nx * ny * nbatch;
    const int tx = c.tid & 63, ty = c.tid >> 6, r = c.tid >> 3, p = c.tid & 7;
    for (int t = c.bid; t < total; t += c.G) {
        const int bx = t % nx, by = (t / nx) % ny, bz = t / (nx * ny);
        const float* s = src + (size_t)bz * sbs; bf16_t* d = dst + (size_t)bz * dbs;
        const int n0 = bx * 64, k0 = by * 64, cm = colmap(mode, n0 + tx);
        for (int kk = ty; kk < 64; kk += 8) tile[kk * 65 + tx] = cm >= 0 ? s[(size_t)(k0 + kk) * Nsrc + cm] : 0.f;
        __syncthreads();
        { u32x4 w; w.x = pk2(tile[(p * 8 + 0) * 65 + r], tile[(p * 8 + 1) * 65 + r]); w.y = pk2(tile[(p * 8 + 2) * 65 + r], tile[(p * 8 + 3) * 65 + r]);
          w.z = pk2(tile[(p * 8 + 4) * 65 + r], tile[(p * 8 + 5) * 65 + r]); w.w = pk2(tile[(p * 8 + 6) * 65 + r], tile[(p * 8 + 7) * 65 + r]);
          *(u32x4*)(d + (size_t)(n0 + r) * K + k0 + p * 8) = w; }
        __syncthreads();
    }
}
__device__ __forceinline__ void ph_xprep(const Ctx& c, const float* __restrict__ xp, const float* __restrict__ xs, const float* __restrict__ mem, float* __restrict__ HF, bf16_t* __restrict__ HB, bf16_t* __restrict__ MEMB) {
    const size_t nH = (size_t)MPAD * DM / 4, nM = (size_t)512 * DM / 4;
    for (size_t i4 = (size_t)c.bid * 512 + c.tid; i4 < nH + nM; i4 += (size_t)c.G * 512) {
        if (i4 < nH) {
            const size_t e = i4 * 4; f32x4 v = (f32x4){0.f, 0.f, 0.f, 0.f};
            if (e < (size_t)MP * DM) v = *(const f32x4*)(xp + e); else if (e < (size_t)MT * DM) v = *(const f32x4*)(xs + (e - (size_t)MP * DM));
            *(f32x4*)(HF + e) = v; u32x2 w; w.x = pk2(v[0], v[1]); w.y = pk2(v[2], v[3]); *(u32x2*)(HB + e) = w;
        } else {
            const size_t e = (i4 - nH) * 4; const f32x4 v = *(const f32x4*)(mem + e); u32x2 w; w.x = pk2(v[0], v[1]); w.y = pk2(v[2], v[3]); *(u32x2*)(MEMB + e) = w;
        }
    }
}
__device__ __forceinline__ void ph_ln(const Ctx& c, const float* __restrict__ Y, const float* __restrict__ g, const float* __restrict__ b, float* __restrict__ XF, bf16_t* __restrict__ XB, float* __restrict__ OUT, int nrows, int nout) {
    const int lane = c.lane;
    for (int row = c.bid * 8 + c.wave; row < nrows; row += c.G * 8) {
        const float* y = Y + (size_t)row * DM; f32x4 v[8]; float s = 0.f;
#pragma unroll
        for (int j = 0; j < 8; ++j) { v[j] = *(const f32x4*)(y + j * 256 + lane * 4); s += (v[j][0] + v[j][1]) + (v[j][2] + v[j][3]); }
        const float mean = wave_sum(s) * (1.0f / DM); float q = 0.f;
#pragma unroll
        for (int j = 0; j < 8; ++j) { const f32x4 d = v[j] - mean; q += (d[0] * d[0] + d[1] * d[1]) + (d[2] * d[2] + d[3] * d[3]); }
        const float rstd = rsqrtf(wave_sum(q) * (1.0f / DM) + 1e-5f);
#pragma unroll
        for (int j = 0; j < 8; ++j) { const int cc = j * 256 + lane * 4; const f32x4 gg = *(const f32x4*)(g + cc), bb = *(const f32x4*)(b + cc);
            const f32x4 o = (v[j] - mean) * rstd * gg + bb; const size_t off = (size_t)row * DM + cc;
            *(f32x4*)(XF + off) = o; u32x2 w; w.x = pk2(o[0], o[1]); w.y = pk2(o[2], o[3]); *(u32x2*)(XB + off) = w;
            if (OUT != nullptr && row < nout) *(f32x4*)(OUT + off) = o; }
    }
}
__device__ __forceinline__ void ph_softmax256(const Ctx& c, const float* __restrict__ SC, bf16_t* __restrict__ P, int nrows) {
    const int lane = c.lane;
    for (int row = c.bid * 8 + c.wave; row < nrows; row += c.G * 8) {
        const f32x4 v = *(const f32x4*)(SC + (size_t)row * 256 + lane * 4);
        const float mx = wave_max(fmaxf(fmaxf(v[0], v[1]), fmaxf(v[2], v[3])));
        f32x4 e; e[0] = __expf(v[0] - mx); e[1] = __expf(v[1] - mx); e[2] = __expf(v[2] - mx); e[3] = __expf(v[3] - mx);
        const float inv = 1.0f / wave_sum((e[0] + e[1]) + (e[2] + e[3]));
        u32x2 w; w.x = pk2(e[0] * inv, e[1] * inv); w.y = pk2(e[2] * inv, e[3] * inv); *(u32x2*)(P + (size_t)row * 256 + lane * 4) = w;
    }
}
__device__ __forceinline__ void ph_copy_outs(const Ctx& c, const bf16_t* __restrict__ U, const float* __restrict__ ck, const float* __restrict__ cv, float* __restrict__ out, int layer) {
    constexpr int nA = PB * 128 * 128, nB = SB * 128 * 128, nC = PB * RWC, nD = SB * RWC;
    for (int i = c.bid * 512 + c.tid; i < nA + nB + nC + nD; i += c.G * 512) {
        if (i < nA) { const int b = i / 16384, j = (i >> 7) & 127, cc = i & 127; const size_t ur = (size_t)(b * PS + PS - 128 + j) * NINP;
            out[O_SWKP + (size_t)layer * nA + i] = bf2f(U[ur + U_SK + cc]); out[O_SWVP + (size_t)layer * nA + i] = bf2f(U[ur + U_SV + cc]); continue; }
        int k = i - nA;
        if (k < nB) { const int sq = k / 16384, j = (k >> 7) & 127, cc = k & 127; float kv, vv;
            if (j < 124) { const size_t o = ((size_t)sq * 128 + j + 4) * 128 + cc; kv = ck[o]; vv = cv[o]; }
            else { const size_t ur = (size_t)(MP + sq * SS + j - 124) * NINP; kv = bf2f(U[ur + U_SK + cc]); vv = bf2f(U[ur + U_SV + cc]); }
            out[O_SWKS + (size_t)layer * nB + k] = kv; out[O_SWVS + (size_t)layer * nB + k] = vv; continue; }
        k -= nB;
        if (k < nC) { const int b = k / RWC, cc = k - b * RWC; out[O_RSP + (size_t)layer * nC + k] = bf2f(U[(size_t)(b * PS + PS - 1) * NINP + U_RU + cc]); continue; }
        k -= nC;
        { const int sq = k / RWC, cc = k - sq * RWC; out[O_RSS + (size_t)layer * nD + k] = bf2f(U[(size_t)(MP + sq * SS + SS - 1) * NINP + U_RU + cc]); }
    }
}

__device__ __forceinline__ void seq_info(int sq, int& row0, int& L) { if (sq < PB) { row0 = sq * PS; L = PS; } else { row0 = MP + (sq - PB) * SS; L = SS; } }

__device__ __forceinline__ void ph_gla_naive(const Ctx& c, const bf16_t* __restrict__ U, const float* __restrict__ s0, const float* __restrict__ a_up, const float* __restrict__ a_b,
                                             const float* __restrict__ ng, const float* __restrict__ nb, bf16_t* __restrict__ OB, float* __restrict__ outP, float* __restrict__ outS) {
    LAS float* qs = (LAS float*)c.lds;
    LAS float* ks = qs + 16 * 128; LAS float* as = ks + 16 * 128; LAS float* os = as + 16 * 128;
    const int kh = c.tid >> 8, vt = c.tid & 255, lane = c.lane;
    for (int u = c.bid; u < (PB + SB) * 4; u += c.G) {
        const int sq = u >> 2, h = u & 3;
        int row0, L; seq_info(sq, row0, L);
        float S[64];
        if (sq >= PB) { const float* p = s0 + (((size_t)(sq - PB) * 4 + h) * 128 + kh * 64) * 256 + vt;
#pragma unroll
            for (int kk = 0; kk < 64; ++kk) S[kk] = p[(size_t)kk * 256]; }
        else {
#pragma unroll
            for (int kk = 0; kk < 64; ++kk) S[kk] = 0.f; }
        for (int t0 = 0; t0 < L; t0 += 16) {
            const int nT = (L - t0) < 16 ? (L - t0) : 16;
            for (int idx = c.tid; idx < nT * 128; idx += 512) {
                const int tt = idx >> 7, kk = idx & 127; const bf16_t* ur = U + (size_t)(row0 + t0 + tt) * NINP;
                qs[idx] = bf2f(ur[U_GQ + h * 128 + kk]) * 0.08838834764831845f; ks[idx] = bf2f(ur[U_GK + h * 128 + kk]);
                float x = a_b[h * 128 + kk];
#pragma unroll
                for (int r = 0; r < 16; ++r) x += bf2f(ur[U_GA + r]) * a_up[r * 512 + h * 128 + kk];
                const float ls = (fminf(x, 0.f) - log1pf(__expf(-fabsf(x)))) * (1.0f / 16.0f);
                as[idx] = __expf(ls);
            }
            __syncthreads();
            for (int tt = 0; tt < nT; ++tt) {
                const float v = bf2f(U[(size_t)(row0 + t0 + tt) * NINP + U_GV + h * 256 + vt]); float o = 0.f; const int lb = tt * 128 + kh * 64;
#pragma unroll
                for (int kk = 0; kk < 64; ++kk) { S[kk] = as[lb + kk] * S[kk] + ks[lb + kk] * v; o += qs[lb + kk] * S[kk]; }
                os[(kh * 16 + tt) * 256 + vt] = o;
            }
            __syncthreads();
            for (int tt = c.wave; tt < nT; tt += 8) {
                float x[4]; float s = 0.f;
#pragma unroll
                for (int j = 0; j < 4; ++j) { x[j] = os[tt * 256 + lane + 64 * j] + os[(16 + tt) * 256 + lane + 64 * j]; s += x[j]; }
                const float mean = wave_sum(s) * (1.0f / 256.0f); float q = 0.f;
#pragma unroll
                for (int j = 0; j < 4; ++j) { const float d = x[j] - mean; q += d * d; }
                const float rstd = rsqrtf(wave_sum(q) * (1.0f / 256.0f) + 1e-5f);
                const size_t row = (size_t)(row0 + t0 + tt);
#pragma unroll
                for (int j = 0; j < 4; ++j) { const int cc = h * 256 + lane + 64 * j; const float n = (x[j] - mean) * rstd * ng[cc] + nb[cc];
                    const float gr = bf2f(U[row * NINP + U_GR + cc]); OB[row * BW + cc] = f2bf(n * gr * sigmoidf_(gr)); }
            }
            __syncthreads();
        }
        float* op = (sq < PB ? outP + (((size_t)sq * 4 + h) * 128 + kh * 64) * 256 : outS + (((size_t)(sq - PB) * 4 + h) * 128 + kh * 64) * 256) + vt;
#pragma unroll
        for (int kk = 0; kk < 64; ++kk) op[(size_t)kk * 256] = S[kk];
    }
}

__device__ __forceinline__ f32x4 mma16(bf16x8 x, bf16x8 y, f32x4 c) { return __builtin_amdgcn_mfma_f32_16x16x32_bf16(x, y, c, 0, 0, 0); }
__device__ __forceinline__ void gla_chunk_info(int u, int& row0, int& ntok, int& h) {
    if (u < 512) { const int b = u >> 8; h = (u >> 6) & 3; row0 = b * PS + (u & 63) * 64; ntok = 64; }
    else { const int s = u - 512; h = s & 3; row0 = MP + (s >> 2) * SS; ntok = SS; }
}
__device__ __forceinline__ void ph_gla_pre(const Ctx& c, const bf16_t* __restrict__ U, const float* __restrict__ a_up, const float* __restrict__ a_b,
                                           bf16_t* __restrict__ QD, bf16_t* __restrict__ KHT, bf16_t* __restrict__ EE, bf16_t* __restrict__ VT, float* __restrict__ GC) {
    LAS float* ga_l = (LAS float*)c.lds;
    LAS float* tot = ga_l + 64 * 16;
    LAS bf16_t* Qd_l = (LAS bf16_t*)(tot + 4 * 128);
    LAS bf16_t* Kn_l = Qd_l + 64 * 136;
    LAS bf16_t* v_l = Kn_l + 64 * 136;
    const int tid = c.tid, lane = c.lane, r = lane & 15, q = lane >> 4, w = c.wave;
    for (int u = c.bid; u < GL_NCH; u += c.G) {
        int row0, ntok, h; gla_chunk_info(u, row0, ntok, h);
        for (int i = tid; i < 64 * 16; i += 512) { const int t = i >> 4, rr = i & 15; ga_l[i] = t < ntok ? bf2f(U[(size_t)(row0 + t) * NINP + U_GA + rr]) : 0.f; }
        for (int i = tid; i < 64 * 32; i += 512) { const int t = i >> 5, c8 = i & 31; u32x4 vv = (u32x4){0u, 0u, 0u, 0u};
            if (t < ntok) vv = *(const u32x4*)(U + (size_t)(row0 + t) * NINP + U_GV + h * 256 + c8 * 8);
            *(LAS u32x4*)(v_l + t * 264 + c8 * 8) = vv; }
        __syncthreads();
        const int kk = tid & 127, tq = tid >> 7;
        float cum[16];
        { float aup[16];
#pragma unroll
          for (int rr = 0; rr < 16; ++rr) aup[rr] = a_up[rr * 512 + h * 128 + kk];
          const float ab = a_b[h * 128 + kk]; float run = 0.f;
#pragma unroll
          for (int j = 0; j < 16; ++j) { const int t = tq * 16 + j; float x = ab;
#pragma unroll
              for (int rr = 0; rr < 16; ++rr) x += ga_l[t * 16 + rr] * aup[rr];
              const float la = t < ntok ? (fminf(x, 0.f) - log1pf(__expf(-fabsf(x)))) * (1.0f / 16.0f) : 0.f;
              run += la; cum[j] = run; }
          tot[tq * 128 + kk] = run; }
        __syncthreads();
        { float prefix = 0.f, bC = 0.f;
#pragma unroll
          for (int g = 0; g < 4; ++g) { const float tv = tot[g * 128 + kk]; bC += tv; if (g < tq) prefix += tv; }
          unsigned khp[8];
#pragma unroll
          for (int j = 0; j < 16; j += 2) { float kh2[2];
#pragma unroll
              for (int e = 0; e < 2; ++e) { const int t = tq * 16 + j + e; const float b = prefix + cum[j + e]; float qv = 0.f, kv = 0.f;
                  if (t < ntok) { const bf16_t* ur = U + (size_t)(row0 + t) * NINP; qv = bf2f(ur[U_GQ + h * 128 + kk]); kv = bf2f(ur[U_GK + h * 128 + kk]); }
                  Qd_l[t * 136 + kk] = f2bf(qv * __expf(b) * 0.08838834764831845f); Kn_l[t * 136 + kk] = f2bf(kv * __expf(-b)); kh2[e] = kv * __expf(bC - b); }
              khp[j >> 1] = pk2(kh2[0], kh2[1]); }
          bf16_t* kp = KHT + (size_t)u * 8192 + kk * 64 + tq * 16;
          *(u32x4*)kp = (u32x4){khp[0], khp[1], khp[2], khp[3]}; *(u32x4*)(kp + 8) = (u32x4){khp[4], khp[5], khp[6], khp[7]};
          if (tq == 0) GC[(size_t)u * 128 + kk] = __expf(bC); }
        __syncthreads();
        { const int tb = w >> 1;
#pragma unroll
          for (int e = 0; e < 2; ++e) { const int ib = (w & 1) * 2 + e; f32x4 d = (f32x4){0.f, 0.f, 0.f, 0.f};
              if (ib <= tb) {
#pragma unroll
                  for (int ks = 0; ks < 4; ++ks) d = mma16(*(const LAS bf16x8*)(Kn_l + (ib * 16 + r) * 136 + ks * 32 + q * 8), *(const LAS bf16x8*)(Qd_l + (tb * 16 + r) * 136 + ks * 32 + q * 8), d); }
              const int t = tb * 16 + r, i0 = ib * 16 + q * 4;
#pragma unroll
              for (int jj = 0; jj < 4; ++jj) if (i0 + jj > t) d[jj] = 0.f;
              u32x2 o; o.x = pk2(d[0], d[1]); o.y = pk2(d[2], d[3]); *(u32x2*)(EE + (size_t)u * 4096 + t * 64 + i0) = o; } }
        for (int i = tid; i < 64 * 16; i += 512) { const int t = i >> 4, c8 = i & 15; *(u32x4*)(QD + (size_t)u * 8192 + t * 128 + c8 * 8) = *(const LAS u32x4*)(Qd_l + t * 136 + c8 * 8); }
        { const int val = tid & 255, th = tid >> 8;
#pragma unroll
          for (int tg = 0; tg < 4; ++tg) { const int t0 = th * 32 + tg * 8; unsigned p4[4];
#pragma unroll
              for (int e = 0; e < 4; ++e) p4[e] = (unsigned)v_l[(t0 + 2 * e) * 264 + val] | ((unsigned)v_l[(t0 + 2 * e + 1) * 264 + val] << 16);
              *(u32x4*)(VT + (size_t)u * 16384 + val * 64 + t0) = (u32x4){p4[0], p4[1], p4[2], p4[3]}; } }
        __syncthreads();
    }
}
struct GlaFrag { bf16x8 qd[4], e[2], kh[2], vt[4][2]; f32x4 gc; };
__device__ __forceinline__ void gla_load_frag(GlaFrag& f, const bf16_t* __restrict__ QD, const bf16_t* __restrict__ KHT, const bf16_t* __restrict__ EE, const bf16_t* __restrict__ VT, const float* __restrict__ GC,
                                              int ch, int sl, int w, int r, int q) {
    const int rb = w >> 1;
#pragma unroll
    for (int ks = 0; ks < 4; ++ks) f.qd[ks] = *(const bf16x8*)(QD + (size_t)ch * 8192 + (rb * 16 + r) * 128 + ks * 32 + q * 8);
#pragma unroll
    for (int ks = 0; ks < 2; ++ks) { f.e[ks] = *(const bf16x8*)(EE + (size_t)ch * 4096 + (rb * 16 + r) * 64 + ks * 32 + q * 8);
        f.kh[ks] = *(const bf16x8*)(KHT + (size_t)ch * 8192 + (w * 16 + r) * 64 + ks * 32 + q * 8);
#pragma unroll
        for (int vb = 0; vb < 4; ++vb) f.vt[vb][ks] = *(const bf16x8*)(VT + (size_t)ch * 16384 + (sl * 64 + vb * 16 + r) * 64 + ks * 32 + q * 8); }
    f.gc = *(const f32x4*)(GC + (size_t)ch * 128 + w * 16 + q * 4);
}
__device__ __forceinline__ void ph_gla_seq(const Ctx& c, int boff, const bf16_t* __restrict__ QD, const bf16_t* __restrict__ KHT, const bf16_t* __restrict__ EE, const bf16_t* __restrict__ VT, const float* __restrict__ GC,
                                           const float* __restrict__ s0, float* __restrict__ outP, float* __restrict__ outS, bf16_t* __restrict__ OB) {
    LAS bf16_t* T_l = (LAS bf16_t*)c.lds;
    const int lane = c.lane, r = lane & 15, q = lane >> 4, w = c.wave;
    for (int u = (c.bid - boff + c.G) % c.G; u < 32 + 512; u += c.G) {
        int h, sl, nch, ch0, row0, ntok; const float* sp = nullptr; float* op;
        if (u < 32) { const int b = u >> 4; h = (u >> 2) & 3; sl = u & 3; nch = 64; ch0 = (b * 4 + h) * 64; row0 = b * PS; ntok = 64; op = outP + (size_t)(b * 4 + h) * 32768; }
        else { const int s = u - 32, sq = s >> 4; h = (s >> 2) & 3; sl = s & 3; nch = 1; ch0 = 512 + sq * 4 + h; row0 = MP + sq * SS; ntok = SS; sp = s0 + (size_t)(sq * 4 + h) * 32768; op = outS + (size_t)(sq * 4 + h) * 32768; }
        f32x4 acc[4];
#pragma unroll
        for (int vb = 0; vb < 4; ++vb)
#pragma unroll
            for (int jj = 0; jj < 4; ++jj) acc[vb][jj] = sp ? sp[(size_t)(w * 16 + q * 4 + jj) * 256 + sl * 64 + vb * 16 + r] : 0.f;
        GlaFrag cur; gla_load_frag(cur, QD, KHT, EE, VT, GC, ch0, sl, w, r, q);
        for (int ci = 0; ci < nch; ++ci) {
            GlaFrag nxt; if (ci + 1 < nch) gla_load_frag(nxt, QD, KHT, EE, VT, GC, ch0 + ci + 1, sl, w, r, q); else nxt = cur;
            LAS bf16_t* Tb = T_l + (ci & 1) * 64 * 136;
#pragma unroll
            for (int vb = 0; vb < 4; ++vb) { u32x2 o; o.x = pk2(acc[vb][0], acc[vb][1]); o.y = pk2(acc[vb][2], acc[vb][3]); *(LAS u32x2*)(Tb + (vb * 16 + r) * 136 + w * 16 + q * 4) = o; }
            __syncthreads();
            { const int rb = w >> 1, t = rb * 16 + r;
#pragma unroll
              for (int e = 0; e < 2; ++e) { const int cb = (w & 1) * 2 + e; f32x4 y = (f32x4){0.f, 0.f, 0.f, 0.f};
#pragma unroll
                  for (int ks = 0; ks < 4; ++ks) y = mma16(*(const LAS bf16x8*)(Tb + (cb * 16 + r) * 136 + ks * 32 + q * 8), cur.qd[ks], y);
#pragma unroll
                  for (int ks = 0; ks < 2; ++ks) y = mma16(e == 0 ? ((w & 1) ? cur.vt[2][ks] : cur.vt[0][ks]) : ((w & 1) ? cur.vt[3][ks] : cur.vt[1][ks]), cur.e[ks], y);
                  if (t < ntok) { u32x2 o; o.x = pk2(y[0], y[1]); o.y = pk2(y[2], y[3]); *(u32x2*)(OB + (size_t)(row0 + ci * 64 + t) * BW + h * 256 + sl * 64 + cb * 16 + q * 4) = o; } } }
#pragma unroll
            for (int vb = 0; vb < 4; ++vb) { acc[vb] = acc[vb] * cur.gc;
#pragma unroll
                for (int ks = 0; ks < 2; ++ks) acc[vb] = mma16(cur.kh[ks], cur.vt[vb][ks], acc[vb]); }
            cur = nxt;
        }
#pragma unroll
        for (int vb = 0; vb < 4; ++vb)
#pragma unroll
            for (int jj = 0; jj < 4; ++jj) op[(size_t)(w * 16 + q * 4 + jj) * 256 + sl * 64 + vb * 16 + r] = acc[vb][jj];
        __syncthreads();
    }
}
__device__ __forceinline__ void ph_gla_fin(const Ctx& c, const bf16_t* __restrict__ U, const float* __restrict__ ng, const float* __restrict__ nb, bf16_t* __restrict__ OB) {
    const int lane = c.lane;
    for (int i = c.bid * 8 + c.wave; i < MT * 4; i += c.G * 8) {
        const int row = i >> 2, h = i & 3, cc = h * 256 + lane * 4; bf16_t* p = OB + (size_t)row * BW + cc;
        const u32x2 raw = *(const u32x2*)p; float x[4] = {__uint_as_float(raw.x << 16), __uint_as_float(raw.x & 0xffff0000u), __uint_as_float(raw.y << 16), __uint_as_float(raw.y & 0xffff0000u)};
        const float mean = wave_sum((x[0] + x[1]) + (x[2] + x[3])) * (1.0f / 256.0f); float qq = 0.f;
#pragma unroll
        for (int j = 0; j < 4; ++j) { const float d = x[j] - mean; qq += d * d; }
        const float rstd = rsqrtf(wave_sum(qq) * (1.0f / 256.0f) + 1e-5f);
        const u32x2 gp = *(const u32x2*)(U + (size_t)row * NINP + U_GR + cc); const float gr[4] = {__uint_as_float(gp.x << 16), __uint_as_float(gp.x & 0xffff0000u), __uint_as_float(gp.y << 16), __uint_as_float(gp.y & 0xffff0000u)};
        const f32x4 gg = *(const f32x4*)(ng + cc), bb = *(const f32x4*)(nb + cc); float o[4];
#pragma unroll
        for (int j = 0; j < 4; ++j) o[j] = ((x[j] - mean) * rstd * gg[j] + bb[j]) * gr[j] * sigmoidf_(gr[j]);
        u32x2 ov; ov.x = pk2(o[0], o[1]); ov.y = pk2(o[2], o[3]); *(u32x2*)p = ov;
    }
}

__device__ __forceinline__ void unpack8(const u32x4 w, float (&x)[8]) {
    x[0] = __uint_as_float(w.x << 16); x[1] = __uint_as_float(w.x & 0xffff0000u); x[2] = __uint_as_float(w.y << 16); x[3] = __uint_as_float(w.y & 0xffff0000u);
    x[4] = __uint_as_float(w.z << 16); x[5] = __uint_as_float(w.z & 0xffff0000u); x[6] = __uint_as_float(w.w << 16); x[7] = __uint_as_float(w.w & 0xffff0000u);
}
template <bool ISBF> __device__ __forceinline__ void swa_step(const float (&q)[32], float (&acc)[32], float& m, float& l, const void* kp, const void* vp, float slope, float dist) {
    float s = 0.f;
#pragma unroll
    for (int j = 0; j < 4; ++j) { float x[8];
        if (ISBF) unpack8(*(const u32x4*)((const bf16_t*)kp + j * 8), x);
        else { const f32x4 a = *(const f32x4*)((const float*)kp + j * 8), b = *(const f32x4*)((const float*)kp + j * 8 + 4); x[0] = a[0]; x[1] = a[1]; x[2] = a[2]; x[3] = a[3]; x[4] = b[0]; x[5] = b[1]; x[6] = b[2]; x[7] = b[3]; }
#pragma unroll
        for (int d = 0; d < 8; ++d) s += q[j * 8 + d] * x[d]; }
    s += __shfl_xor(s, 1, 64);
    s = s * 0.125f - slope * dist;
    const float mn = fmaxf(m, s), cc = __expf(m - mn), p = __expf(s - mn);
    l = l * cc + p;
#pragma unroll
    for (int j = 0; j < 4; ++j) { float x[8];
        if (ISBF) unpack8(*(const u32x4*)((const bf16_t*)vp + j * 8), x);
        else { const f32x4 a = *(const f32x4*)((const float*)vp + j * 8), b = *(const f32x4*)((const float*)vp + j * 8 + 4); x[0] = a[0]; x[1] = a[1]; x[2] = a[2]; x[3] = a[3]; x[4] = b[0]; x[5] = b[1]; x[6] = b[2]; x[7] = b[3]; }
#pragma unroll
        for (int d = 0; d < 8; ++d) acc[j * 8 + d] = acc[j * 8 + d] * cc + p * x[d]; }
    m = mn;
}
__device__ __forceinline__ void ph_swa_naive(const Ctx& c, const bf16_t* __restrict__ U, const float* __restrict__ ck, const float* __restrict__ cv, const float* __restrict__ sinks, bf16_t* __restrict__ OB) {
    for (int gid = c.bid * 512 + c.tid; gid < MT * 32; gid += c.G * 512) {
        const int dh = gid & 1, h = (gid >> 1) & 15, row = gid >> 5, kvh = h >> 3, co = kvh * 64 + dh * 32;
        float q[32], acc[32];
#pragma unroll
        for (int j = 0; j < 4; ++j) { float x[8]; unpack8(*(const u32x4*)(U + (size_t)row * NINP + U_SQ + h * 64 + dh * 32 + j * 8), x);
#pragma unroll
            for (int d = 0; d < 8; ++d) { q[j * 8 + d] = x[d]; acc[j * 8 + d] = 0.f; } }
        const float slope = exp2f(-0.5f * (float)(h + 1)); float m = sinks[h], l = 1.0f;
        if (row < MP) {
            const int t = row % PS, base = row - t, lo = t - 128 < 0 ? 0 : t - 128;
            for (int s = lo; s <= t; ++s) { const bf16_t* ur = U + (size_t)(base + s) * NINP;
                swa_step<true>(q, acc, m, l, ur + U_SK + co, ur + U_SV + co, slope, (float)(t - s)); }
        } else {
            const int sq = (row - MP) / SS, i = (row - MP) % SS;
            for (int idx = i; idx <= 128 + i; ++idx) {
                if (idx < 128) { const size_t o = ((size_t)sq * 128 + idx) * 128 + co; swa_step<false>(q, acc, m, l, ck + o, cv + o, slope, (float)(128 + i - idx)); }
                else { const bf16_t* ur = U + (size_t)(MP + sq * SS + idx - 128) * NINP; swa_step<true>(q, acc, m, l, ur + U_SK + co, ur + U_SV + co, slope, (float)(128 + i - idx)); }
            }
        }
        const float inv = 1.0f / l; bf16_t* op = OB + (size_t)row * BW + h * 64 + dh * 32;
#pragma unroll
        for (int j = 0; j < 4; ++j) { u32x4 w; w.x = pk2(acc[j * 8] * inv, acc[j * 8 + 1] * inv); w.y = pk2(acc[j * 8 + 2] * inv, acc[j * 8 + 3] * inv);
            w.z = pk2(acc[j * 8 + 4] * inv, acc[j * 8 + 5] * inv); w.w = pk2(acc[j * 8 + 6] * inv, acc[j * 8 + 7] * inv); *(u32x4*)(op + j * 8) = w; }
    }
}

__device__ __forceinline__ void ph_rwkv_prep(const Ctx& c, const bf16_t* __restrict__ U, const float* __restrict__ shift, const float* __restrict__ mu, const float* __restrict__ w0, const float* __restrict__ w2,
                                             const float* __restrict__ a0, const float* __restrict__ a2, const float* __restrict__ g2, const float* __restrict__ k_k, const float* __restrict__ k_a,
                                             const float* __restrict__ r_k, float* __restrict__ RW) {
    LAS float* xm = (LAS float*)c.lds; LAS float* tw = xm + RWC; LAS float* ad = tw + 64; LAS float* sg = ad + 64;
    const int tid = c.tid;
    float* R = RW; float* WD = RW + (size_t)MPAD * BW; float* K2 = WD + (size_t)MPAD * BW; float* V = K2 + (size_t)MPAD * BW; float* KK = V + (size_t)MPAD * BW;
    float* BV = KK + (size_t)MPAD * BW; float* G = BV + (size_t)MPAD * BW; float* BON = G + (size_t)MPAD * BW;
    for (int row = c.bid; row < MT; row += c.G) {
        const bf16_t* ur = U + (size_t)row * NINP + U_RU; const bf16_t* pr = ur - NINP; const float* ps = nullptr; bool first;
        if (row < MP) first = (row % PS) == 0; else { first = ((row - MP) % SS) == 0; ps = shift + (size_t)((row - MP) / SS) * RWC; }
        for (int cc = tid; cc < RWC; cc += 512) { const float x = bf2f(ur[cc]); const float s = first ? (ps ? ps[cc] : 0.f) : bf2f(pr[cc]); xm[cc] = x + (s - x) * mu[cc]; }
        __syncthreads();
        if (tid < 64) { tw[tid] = tanhf(xm[3072 + tid]); ad[tid] = xm[3136 + tid]; }
        if (tid >= 128 && tid < 256) sg[tid - 128] = sigmoidf_(xm[3200 + tid - 128]);
        __syncthreads();
        for (int qd = 0; qd < 2; ++qd) {
            const int cc = qd * 512 + tid; float accw = w0[cc], acca = a0[cc], accg = 0.f;
#pragma unroll 4
            for (int j = 0; j < 64; ++j) { accw += tw[j] * w2[j * BW + cc]; acca += ad[j] * a2[j * BW + cc]; }
#pragma unroll 4
            for (int j = 0; j < 128; ++j) accg += sg[j] * g2[j * BW + cc];
            const float lw = -softplusf_(-accw) - 0.5f, decay = __expf(-__expf(lw)), a = sigmoidf_(acca);
            const float r = xm[cc], k = xm[1024 + cc], v = xm[2048 + cc];
            const float kkr = k * k_k[cc]; const float ss = wave_sum(kkr * kkr); const float kk = kkr / fmaxf(sqrtf(ss), 1e-12f);
            const float k2 = k * (1.0f + (a - 1.0f) * k_a[cc]); const float rk = wave_sum(r * k2 * r_k[cc]);
            const size_t o = (size_t)row * BW + cc;
            R[o] = r; WD[o] = decay; K2[o] = k2; V[o] = v; KK[o] = kk; BV[o] = kk * a; G[o] = accg; BON[o] = rk * v;
        }
        __syncthreads();
    }
}
constexpr int RWP_UNITS = (MP / 64) * 16 + SB * 16;
__device__ __forceinline__ void rwp_unit_info(int u, int& row0, int& ntok, int& h, int& sq, bool& seq_first) {
    if (u < (MP / 64) * 16) { const int blk = u >> 4; h = u & 15; row0 = blk * 64; ntok = 64; sq = -1; seq_first = (row0 % PS) == 0; }
    else { const int s = u - (MP / 64) * 16; sq = s >> 4; h = s & 15; row0 = MP + sq * SS; ntok = SS; seq_first = true; }
}
__device__ __forceinline__ void ph_rwkv_pre(const Ctx& c, const bf16_t* __restrict__ U, const float* __restrict__ shift, const float* __restrict__ mu, const float* __restrict__ w0, const float* __restrict__ w2,
                                            const float* __restrict__ a0, const float* __restrict__ a2, const float* __restrict__ g2, const float* __restrict__ k_k, const float* __restrict__ k_a,
                                            const float* __restrict__ r_k, float* __restrict__ RW) {
    LAS bf16_t* act_l = (LAS bf16_t*)c.lds;
    LAS bf16_t* wT_l = act_l + 64 * 264;
    LAS bf16_t* aT_l = wT_l + 64 * 72;
    LAS bf16_t* gT_l = aT_l + 64 * 72;
    LAS float* pre_l = (LAS float*)(c.lds + 73728);
    const int tid = c.tid, lane = c.lane, r = lane & 15, q = lane >> 4, w = c.wave;
    float* Rr = RW; float* WD = RW + (size_t)MPAD * BW; float* K2 = WD + (size_t)MPAD * BW; float* V = K2 + (size_t)MPAD * BW; float* KK = V + (size_t)MPAD * BW;
    float* BV = KK + (size_t)MPAD * BW; float* G = BV + (size_t)MPAD * BW; float* BON = G + (size_t)MPAD * BW;
    for (int u = c.bid; u < RWP_UNITS; u += c.G) {
        int row0, ntok, h, sq; bool seq_first; rwp_unit_info(u, row0, ntok, h, sq, seq_first);
        const float* sh = sq >= 0 ? shift + (size_t)sq * RWC : nullptr;
        for (int idx = tid; idx < 64 * 256; idx += 512) {
            const int t = idx >> 8, col = idx & 255; float val = 0.f;
            if (t < ntok) { const int cc = 3072 + col; const bf16_t* ur = U + (size_t)(row0 + t) * NINP + U_RU; const float x = bf2f(ur[cc]);
                const float p = (t == 0 && seq_first) ? (sh ? sh[cc] : 0.f) : bf2f(ur[cc - NINP]);
                const float xm = x + (p - x) * mu[cc];
                val = col < 64 ? tanhf(xm) : (col < 128 ? xm : sigmoidf_(xm)); }
            act_l[t * 264 + col] = f2bf(val);
        }
        for (int idx = tid; idx < 64 * 64; idx += 512) { const int j = idx >> 6, cc = idx & 63; wT_l[cc * 72 + j] = f2bf(w2[(size_t)j * BW + h * 64 + cc]); aT_l[cc * 72 + j] = f2bf(a2[(size_t)j * BW + h * 64 + cc]); }
        for (int idx = tid; idx < 128 * 64; idx += 512) { const int j = idx >> 6, cc = idx & 63; gT_l[cc * 136 + j] = f2bf(g2[(size_t)j * BW + h * 64 + cc]); }
        __syncthreads();
        { const int tb = w & 3, chf = w >> 2; bf16x8 af[8];
#pragma unroll
          for (int ks = 0; ks < 8; ++ks) af[ks] = *(const LAS bf16x8*)(act_l + (tb * 16 + r) * 264 + ks * 32 + q * 8);
#pragma unroll
          for (int e = 0; e < 2; ++e) { const int cb = chf * 2 + e; f32x4 dw = (f32x4){0.f, 0.f, 0.f, 0.f}, da = dw, dg = dw;
#pragma unroll
              for (int ks = 0; ks < 2; ++ks) { dw = mma16(*(const LAS bf16x8*)(wT_l + (cb * 16 + r) * 72 + ks * 32 + q * 8), af[ks], dw);
                  da = mma16(*(const LAS bf16x8*)(aT_l + (cb * 16 + r) * 72 + ks * 32 + q * 8), af[2 + ks], da); }
#pragma unroll
              for (int ks = 0; ks < 4; ++ks) dg = mma16(*(const LAS bf16x8*)(gT_l + (cb * 16 + r) * 136 + ks * 32 + q * 8), af[4 + ks], dg);
              const int o = (tb * 16 + r) * 68 + cb * 16 + q * 4;
              *(LAS f32x4*)(pre_l + o) = dw; *(LAS f32x4*)(pre_l + 64 * 68 + o) = da; *(LAS f32x4*)(pre_l + 2 * 64 * 68 + o) = dg; } }
        __syncthreads();
        { const int t = tid >> 3, cg = tid & 7, c0 = h * 64 + cg * 8;
          if (t < ntok) {
            const size_t row = (size_t)(row0 + t); const bf16_t* ur = U + row * NINP + U_RU; const bool fst = (t == 0 && seq_first);
            float rr[8], kx[8], vx[8];
#pragma unroll
            for (int part = 0; part < 3; ++part) { const int cc = part * 1024 + c0; float x[8], p[8];
                unpack8(*(const u32x4*)(ur + cc), x);
                if (!fst) unpack8(*(const u32x4*)(ur + cc - NINP), p);
                else {
#pragma unroll
                    for (int j = 0; j < 8; ++j) p[j] = sh ? sh[cc + j] : 0.f; }
#pragma unroll
                for (int j = 0; j < 8; ++j) { const float xm = x[j] + (p[j] - x[j]) * mu[cc + j]; if (part == 0) rr[j] = xm; else if (part == 1) kx[j] = xm; else vx[j] = xm; } }
            float dec[8], av[8], gg[8], kkr[8], k2[8]; float ss = 0.f, rk = 0.f;
#pragma unroll
            for (int j = 0; j < 8; ++j) { const int cc = c0 + j; const int o = t * 68 + cg * 8 + j;
                const float lw = -softplusf_(-(w0[cc] + pre_l[o])) - 0.5f; dec[j] = __expf(-__expf(lw)); av[j] = sigmoidf_(a0[cc] + pre_l[64 * 68 + o]); gg[j] = pre_l[2 * 64 * 68 + o];
                kkr[j] = kx[j] * k_k[cc]; ss += kkr[j] * kkr[j]; k2[j] = kx[j] * (1.0f + (av[j] - 1.0f) * k_a[cc]); rk += rr[j] * k2[j] * r_k[cc]; }
            ss += __shfl_xor(ss, 1, 64); ss += __shfl_xor(ss, 2, 64); ss += __shfl_xor(ss, 4, 64);
            rk += __shfl_xor(rk, 1, 64); rk += __shfl_xor(rk, 2, 64); rk += __shfl_xor(rk, 4, 64);
            const float inv = 1.0f / fmaxf(sqrtf(ss), 1e-12f); const size_t o = row * BW + c0;
#pragma unroll
            for (int j = 0; j < 8; ++j) { const float kk = kkr[j] * inv; Rr[o + j] = rr[j]; WD[o + j] = dec[j]; K2[o + j] = k2[j]; V[o + j] = vx[j]; KK[o + j] = kk; BV[o + j] = kk * av[j]; G[o + j] = gg[j]; BON[o + j] = rk * vx[j]; }
          } }
        __syncthreads();
    }
}

__device__ __forceinline__ void ph_rwkv_scan_naive(const Ctx& c, const float* __restrict__ RW, const float* __restrict__ s0, const float* __restrict__ lng, const float* __restrict__ lnb, bf16_t* __restrict__ OB,
                                                   float* __restrict__ outP, float* __restrict__ outS) {
    const float* R = RW; const float* WD = RW + (size_t)MPAD * BW; const float* K2 = WD + (size_t)MPAD * BW; const float* V = K2 + (size_t)MPAD * BW; const float* KK = V + (size_t)MPAD * BW;
    const float* BV = KK + (size_t)MPAD * BW; const float* G = BV + (size_t)MPAD * BW; const float* BON = G + (size_t)MPAD * BW;
    const int lane = c.lane;
    for (int it = 0;; ++it) {
        const int u = (it * 8 + c.wave) * c.G + c.bid;
        if (u >= (PB + SB) * 16) break;
        const int sq = u >> 4, h = u & 15;
        int row0, L; seq_info(sq, row0, L);
        float S[64];
        if (sq >= PB) { const float* p = s0 + (((size_t)(sq - PB) * 16 + h) * 64 + lane) * 64;
#pragma unroll
            for (int j = 0; j < 64; ++j) S[j] = p[j]; }
        else {
#pragma unroll
            for (int j = 0; j < 64; ++j) S[j] = 0.f; }
        const float lg = lng[h * 64 + lane], lb = lnb[h * 64 + lane];
        for (int t = 0; t < L; ++t) {
            const size_t base = (size_t)(row0 + t) * BW + h * 64; const float v = V[base + lane];
            float d = 0.f;
#pragma unroll
            for (int j = 0; j < 64; ++j) d += S[j] * KK[base + j];
            float y = 0.f;
#pragma unroll
            for (int j = 0; j < 64; ++j) { S[j] = S[j] * WD[base + j] - d * BV[base + j] + v * K2[base + j]; y += S[j] * R[base + j]; }
            const float mean = wave_sum(y) * (1.0f / 64.0f), dy = y - mean, var = wave_sum(dy * dy) * (1.0f / 64.0f);
            const float yn = dy * rsqrtf(var + 64e-5f) * lg + lb;
            OB[base + lane] = f2bf((yn + BON[base + lane]) * G[base + lane]);
        }
        float* op = (sq < PB ? outP + (((size_t)sq * 16 + h) * 64 + lane) * 64 : outS + (((size_t)(sq - PB) * 16 + h) * 64 + lane) * 64);
#pragma unroll
        for (int j = 0; j < 64; ++j) op[j] = S[j];
    }
}
__device__ __forceinline__ void ph_rwkv_scan2(const Ctx& c, int boff, const float* __restrict__ RW, const float* __restrict__ s0, const float* __restrict__ lng, const float* __restrict__ lnb, bf16_t* __restrict__ OB,
                                              float* __restrict__ outP, float* __restrict__ outS) {
    LAS float* opb = (LAS float*)c.lds;
    LAS float* yb = opb + 2 * 16 * 384;
    const int tid = c.tid, lane = c.lane, w = c.wave, rl = lane >> 3, cg = lane & 7, vrow = w * 8 + rl;
    const float* G = RW + 6 * (size_t)MPAD * BW; const float* BON = RW + 7 * (size_t)MPAD * BW;
    for (int u = (c.bid - boff + c.G) % c.G; u < (PB + SB) * 16; u += c.G) {
        const int sq = u >> 4, h = u & 15;
        int row0, L; seq_info(sq, row0, L);
        float S[8];
        if (sq >= PB) { const float* p = s0 + (((size_t)(sq - PB) * 16 + h) * 64 + vrow) * 64 + cg * 8;
#pragma unroll
            for (int j = 0; j < 8; ++j) S[j] = p[j]; }
        else {
#pragma unroll
            for (int j = 0; j < 8; ++j) S[j] = 0.f; }
        const float lg = lng[h * 64 + lane], lb = lnb[h * 64 + lane];
        const int nb = (L + 15) >> 4;
#define RW_STAGE(bi_) do { const int t0_ = (bi_) * 16, nT_ = (L - t0_) < 16 ? (L - t0_) : 16; LAS float* dst_ = opb + ((bi_) & 1) * 16 * 384; \
        for (int idx = tid; idx < nT_ * 96; idx += 512) { const int t = idx / 96, rem = idx - t * 96, slot = rem >> 4, c4 = rem & 15; \
            const int arr = slot == 0 ? 1 : slot == 1 ? 4 : slot == 2 ? 5 : slot == 3 ? 2 : slot == 4 ? 0 : 3; \
            *(LAS f32x4*)(dst_ + t * 384 + slot * 64 + c4 * 4) = *(const f32x4*)(RW + (size_t)arr * MPAD * BW + (size_t)(row0 + t0_ + t) * BW + h * 64 + c4 * 4); } } while (0)
        RW_STAGE(0);
        for (int bi = 0; bi < nb; ++bi) {
            __syncthreads();
            if (bi + 1 < nb) RW_STAGE(bi + 1);
            const int t0 = bi * 16, nT = (L - t0) < 16 ? (L - t0) : 16; const LAS float* src = opb + (bi & 1) * 16 * 384;
            for (int tt = 0; tt < nT; ++tt) {
                const LAS float* b = src + tt * 384 + cg * 8;
                const f32x4 w0 = *(const LAS f32x4*)(b), w1 = *(const LAS f32x4*)(b + 4), k0 = *(const LAS f32x4*)(b + 64), k1 = *(const LAS f32x4*)(b + 68);
                const f32x4 b0 = *(const LAS f32x4*)(b + 128), b1 = *(const LAS f32x4*)(b + 132), q0 = *(const LAS f32x4*)(b + 192), q1 = *(const LAS f32x4*)(b + 196);
                const f32x4 r0 = *(const LAS f32x4*)(b + 256), r1 = *(const LAS f32x4*)(b + 260); const float v = src[tt * 384 + 320 + vrow];
                float d = (S[0] * k0[0] + S[1] * k0[1]) + (S[2] * k0[2] + S[3] * k0[3]) + (S[4] * k1[0] + S[5] * k1[1]) + (S[6] * k1[2] + S[7] * k1[3]);
                d += __shfl_xor(d, 1, 64); d += __shfl_xor(d, 2, 64); d += __shfl_xor(d, 4, 64);
                float y = 0.f;
#pragma unroll
                for (int j = 0; j < 4; ++j) { S[j] = S[j] * w0[j] - d * b0[j] + v * q0[j]; y += S[j] * r0[j]; S[4 + j] = S[4 + j] * w1[j] - d * b1[j] + v * q1[j]; y += S[4 + j] * r1[j]; }
                y += __shfl_xor(y, 1, 64); y += __shfl_xor(y, 2, 64); y += __shfl_xor(y, 4, 64);
                if (cg == 0) yb[tt * 64 + vrow] = y;
            }
            __syncthreads();
            for (int tt = w; tt < nT; tt += 8) {
                const float y = yb[tt * 64 + lane]; const float mean = wave_sum(y) * (1.0f / 64.0f), dy = y - mean, var = wave_sum(dy * dy) * (1.0f / 64.0f);
                const float yn = dy * rsqrtf(var + 64e-5f) * lg + lb; const size_t o = (size_t)(row0 + t0 + tt) * BW + h * 64 + lane;
                OB[o] = f2bf((yn + BON[o]) * G[o]);
            }
        }
#undef RW_STAGE
        float* op = (sq < PB ? outP + (((size_t)sq * 16 + h) * 64 + vrow) * 64 : outS + (((size_t)(sq - PB) * 16 + h) * 64 + vrow) * 64) + cg * 8;
#pragma unroll
        for (int j = 0; j < 8; ++j) op[j] = S[j];
        __syncthreads();
    }
}
__device__ __forceinline__ void ph_memattn_sample(const Ctx& c, const bf16_t* __restrict__ U, const float* __restrict__ mk, const float* __restrict__ mv, bf16_t* __restrict__ OB) {
    LAS float* qs = (LAS float*)c.lds; LAS float* ps = qs + 2 * 4 * 256;
    const int hh = c.tid >> 8, vt = c.tid & 255, lane = c.lane;
    for (int u = c.bid; u < SB * 2; u += c.G) {
        const int sq = u >> 1, h = (u & 1) * 2 + hh;
#pragma unroll
        for (int t = 0; t < 4; ++t) qs[(hh * 4 + t) * 256 + vt] = bf2f(U[(size_t)(MP + sq * SS + t) * NINP + U_MQ + h * 256 + vt]) * 0.0625f;
        __syncthreads();
        { const float* kr = mk + (((size_t)sq * MEMT + vt) * 4 + h) * 256; float s[4] = {0.f, 0.f, 0.f, 0.f};
            for (int d = 0; d < 256; d += 4) { const f32x4 kv = *(const f32x4*)(kr + d);
#pragma unroll
                for (int t = 0; t < 4; ++t) { const LAS float* qq = qs + (hh * 4 + t) * 256 + d; s[t] += kv[0] * qq[0] + kv[1] * qq[1] + kv[2] * qq[2] + kv[3] * qq[3]; } }
#pragma unroll
            for (int t = 0; t < 4; ++t) ps[(hh * 4 + t) * 256 + vt] = s[t]; }
        __syncthreads();
        { LAS float* pr = ps + c.wave * 256; float x[4]; float mx = -3.0e38f;
#pragma unroll
            for (int j = 0; j < 4; ++j) { x[j] = pr[lane + 64 * j]; mx = fmaxf(mx, x[j]); }
            mx = wave_max(mx); float s = 0.f;
#pragma unroll
            for (int j = 0; j < 4; ++j) { x[j] = __expf(x[j] - mx); s += x[j]; }
            const float inv = 1.0f / wave_sum(s);
#pragma unroll
            for (int j = 0; j < 4; ++j) pr[lane + 64 * j] = x[j] * inv; }
        __syncthreads();
        { float o[4] = {0.f, 0.f, 0.f, 0.f}; const float* vr = mv + ((size_t)sq * MEMT * 4 + h) * 256 + vt;
            for (int m = 0; m < MEMT; ++m) { const float vv = vr[(size_t)m * 1024];
#pragma unroll
                for (int t = 0; t < 4; ++t) o[t] += ps[(hh * 4 + t) * 256 + m] * vv; }
#pragma unroll
            for (int t = 0; t < 4; ++t) OB[(size_t)(MP + sq * SS + t) * BW + h * 256 + vt] = f2bf(o[t]); }
        __syncthreads();
    }
}

constexpr int LDS_BAR_OFF = pg8::STAGE_BYTES;
constexpr int LDS_BYTES = pg8::STAGE_BYTES + 64;
struct Args { const float* in[37]; float* out; unsigned char* ws; };

typedef pg8::Gemm<DM, DM, DM, 2, 8, NL, 1, false, 0, 0, (long)DM * DM, 0> GemmMem;
typedef pg8::Gemm<DM, DM, DM, MPAD / 256, NINP / 256> GemmIn;
typedef pg8::Gemm<NINP, 1024, 256, PS / 256, 1, 8, 4, false, (long)PS * NINP, 256, 256 * 1024, 256> GemmScore;
typedef pg8::Gemm<256, 256, 256, PS / 256, 1, 8, 4, false, (long)4 * 4096 * 256, (long)4096 * 256, 4 * 65536, 65536> GemmPV;
typedef pg8::Gemm<BW, BW, BW, MPAD / 256, DM / 256, 4, 1, true, (long)MPAD * BW, 0, (long)DM * BW, 0> GemmBranch;
typedef pg8::Gemm<DM, DM, DM, MPAD / 256, DM / 256> GemmOut;
typedef pg8::Gemm<DM, DM, DM, MPAD / 256, 2 * DFF / 256> GemmGU;
typedef pg8::Gemm<DFF, DFF, DFF, MPAD / 256, DM / 256> GemmDown;
template <class GT> __device__ __forceinline__ GT mk_gemm(const Ctx& c, const bf16_t* A, const bf16_t* B) { GT g; g.A = A; g.B = B; g.G = c.G; g.c = c.bid; return g; }

template <int OFF> __device__ __forceinline__ unsigned long long karg_u64(unsigned long long kargs) {
    unsigned long long p; asm volatile("s_load_dwordx2 %0, %1, %2\n\ts_waitcnt lgkmcnt(0)" : "=s"(p) : "s"(kargs), "n"(OFF) : "memory"); return p;
}
#define INP(k) ((const float*)karg_u64<(k) * 8>(kargs))
#define OUTP() ((float*)karg_u64<37 * 8>(kargs))
#define WSP() ((unsigned char*)karg_u64<38 * 8>(kargs))

__global__ void __launch_bounds__(512, 2) mega_fwd(Args a_unused) {
    extern __shared__ __attribute__((aligned(16))) unsigned char lds_raw[];
    const unsigned long long kargs = (unsigned long long)__builtin_amdgcn_kernarg_segment_ptr();
    Ctx c0; c0.tid = threadIdx.x; c0.lane = c0.tid & 63; c0.wave = __builtin_amdgcn_readfirstlane(c0.tid >> 6); c0.bid = blockIdx.x; c0.G = gridDim.x; c0.lds = (LAS unsigned char*)lds_raw;
    if (c0.tid < 4) ((LAS unsigned*)(c0.lds + LDS_BAR_OFF))[c0.tid] = 0u;
    __syncthreads();
    const XcdBarrier bar = xcd_barrier_post((unsigned*)(WSP() + WS_CTL), (volatile LAS unsigned*)(c0.lds + LDS_BAR_OFF));

    { const Ctx c = fresh(c0); unsigned char* ws = WSP();
      ph_wprep(c, INP(10), (bf16_t*)(ws + WS_WIN), DM, NIN, NINP, 1, NL, (size_t)DM * NIN, (size_t)NINP * DM);
      ph_wprep(c, INP(28), (bf16_t*)(ws + WS_WMEM), DM, DM, DM, 0, NL, (size_t)DM * DM, (size_t)DM * DM);
      ph_wprep(c, INP(29), (bf16_t*)(ws + WS_WBR), BW, DM, DM, 0, NL * 4, (size_t)BW * DM, (size_t)DM * BW);
      ph_wprep(c, INP(30), (bf16_t*)(ws + WS_WOUT), DM, DM, DM, 0, NL, (size_t)DM * DM, (size_t)DM * DM);
      ph_wprep(c, INP(33), (bf16_t*)(ws + WS_WGU), DM, 2 * DFF, 2 * DFF, 2, NL, (size_t)DM * 2 * DFF, (size_t)2 * DFF * DM);
      ph_wprep(c, INP(34), (bf16_t*)(ws + WS_WDN), DFF, DM, DM, 0, NL, (size_t)DFF * DM, (size_t)DM * DFF);
      ph_xprep(c, INP(0), INP(1), INP(2), (float*)(ws + WS_HF), (bf16_t*)(ws + WS_HB), (bf16_t*)(ws + WS_MEMB)); }
    xcd_barrier(bar);
    { const Ctx c = fresh(c0); unsigned char* ws = WSP(); float* out = OUTP();
      GemmMem g = mk_gemm<GemmMem>(c, (const bf16_t*)(ws + WS_MEMB), (const bf16_t*)(ws + WS_WMEM));
      pg8::EpiMem E; E.outK = out + O_MKP; E.outV = out + O_MVP; E.kb = (bf16_t*)(ws + WS_MKB); E.vt = (bf16_t*)(ws + WS_MVT); pg8::gemm_phase<GemmMem, pg8::EpiMem, true, true>(c.lds, c.tid, g, E); }

    for (int l = 0; l < NL; ++l) {
        { const Ctx c = fresh(c0); unsigned char* ws = WSP();
          GemmIn g = mk_gemm<GemmIn>(c, (const bf16_t*)(ws + WS_HB), (const bf16_t*)(ws + WS_WIN) + (size_t)l * NINP * DM);
          pg8::EpiBf16 E; E.O = (bf16_t*)(ws + WS_U); E.zs = 0; E.ldc = NINP; E.pad = 0; pg8::gemm_phase<GemmIn, pg8::EpiBf16, true, true>(c.lds, c.tid, g, E); }
        xcd_barrier(bar);
        { const Ctx c = fresh(c0); unsigned char* ws = WSP(); float* out = OUTP(); const bf16_t* U = (const bf16_t*)(ws + WS_U); bf16_t* BR = (bf16_t*)(ws + WS_BR);
          (void)out; (void)BR;
          ph_gla_pre(c, U, INP(12) + (size_t)l * 16 * 512, INP(13) + (size_t)l * 512, (bf16_t*)(ws + WS_GLQD), (bf16_t*)(ws + WS_GLKH), (bf16_t*)(ws + WS_GLE), (bf16_t*)(ws + WS_GLVT), (float*)(ws + WS_GLGC)); }
        { const Ctx c = fresh(c0); unsigned char* ws = WSP();
          ph_rwkv_pre(c, (const bf16_t*)(ws + WS_U), INP(9) + (size_t)l * SB * RWC, INP(17) + (size_t)l * RWC, INP(18) + (size_t)l * BW, INP(19) + (size_t)l * 64 * BW, INP(20) + (size_t)l * BW, INP(21) + (size_t)l * 64 * BW,
                       INP(22) + (size_t)l * 128 * BW, INP(23) + (size_t)l * BW, INP(24) + (size_t)l * BW, INP(25) + (size_t)l * BW, (float*)(ws + WS_RW)); }
        { const Ctx c = fresh(c0); unsigned char* ws = WSP();
          ph_swa_naive(c, (const bf16_t*)(ws + WS_U), INP(3) + (size_t)l * SB * 16384, INP(4) + (size_t)l * SB * 16384, INP(16) + (size_t)l * 16, (bf16_t*)(ws + WS_BR) + (size_t)MPAD * BW); }
        { const Ctx c = fresh(c0); unsigned char* ws = WSP();
          ph_copy_outs(c, (const bf16_t*)(ws + WS_U), INP(3) + (size_t)l * SB * 16384, INP(4) + (size_t)l * SB * 16384, OUTP(), l); }
        { const Ctx c = fresh(c0); unsigned char* ws = WSP();
          ph_memattn_sample(c, (const bf16_t*)(ws + WS_U), INP(5) + (size_t)l * SB * MEMT * 1024, INP(6) + (size_t)l * SB * MEMT * 1024, (bf16_t*)(ws + WS_BR) + (size_t)3 * MPAD * BW); }
        { const Ctx c = fresh(c0); unsigned char* ws = WSP();
          GemmScore g = mk_gemm<GemmScore>(c, (const bf16_t*)(ws + WS_U) + U_MQ, (const bf16_t*)(ws + WS_MKB) + (size_t)l * 512 * 1024);
          pg8::EpiScore E; E.SC = (float*)(ws + WS_SC); pg8::gemm_phase<GemmScore, pg8::EpiScore, true, true>(c.lds, c.tid, g, E); }
        xcd_barrier(bar);
        { const Ctx c = fresh(c0); unsigned char* ws = WSP(); float* out = OUTP();
          ph_rwkv_scan2(c, 64, (const float*)(ws + WS_RW), INP(8) + (size_t)l * SB * 16 * 4096, INP(26) + (size_t)l * BW, INP(27) + (size_t)l * BW, (bf16_t*)(ws + WS_BR) + (size_t)2 * MPAD * BW,
                             out + O_RWP + (size_t)l * PB * 16 * 4096, out + O_RWS + (size_t)l * SB * 16 * 4096); }
        { const Ctx c = fresh(c0); unsigned char* ws = WSP(); float* out = OUTP();
          ph_gla_seq(c, 32, (const bf16_t*)(ws + WS_GLQD), (const bf16_t*)(ws + WS_GLKH), (const bf16_t*)(ws + WS_GLE), (const bf16_t*)(ws + WS_GLVT), (const float*)(ws + WS_GLGC),
                     INP(7) + (size_t)l * SB * 4 * 32768, out + O_GLAP + (size_t)l * PB * 4 * 32768, out + O_GLAS + (size_t)l * SB * 4 * 32768, (bf16_t*)(ws + WS_BR)); }
        { const Ctx c = fresh(c0); unsigned char* ws = WSP(); ph_softmax256(c, (const float*)(ws + WS_SC), (bf16_t*)(ws + WS_PB), 8 * 4096); }
        xcd_barrier(bar);
        { const Ctx c = fresh(c0); unsigned char* ws = WSP(); ph_gla_fin(c, (const bf16_t*)(ws + WS_U), INP(14) + (size_t)l * BW, INP(15) + (size_t)l * BW, (bf16_t*)(ws + WS_BR)); }
        { const Ctx c = fresh(c0); unsigned char* ws = WSP();
          GemmPV g = mk_gemm<GemmPV>(c, (const bf16_t*)(ws + WS_PB), (const bf16_t*)(ws + WS_MVT) + (size_t)l * 8 * 65536);
          pg8::EpiPV E; E.O = (bf16_t*)(ws + WS_BR) + (size_t)3 * MPAD * BW; pg8::gemm_phase<GemmPV, pg8::EpiPV, true, true>(c.lds, c.tid, g, E); }
        xcd_barrier(bar);
        { const Ctx c = fresh(c0); unsigned char* ws = WSP();
          GemmBranch g = mk_gemm<GemmBranch>(c, (const bf16_t*)(ws + WS_BR), (const bf16_t*)(ws + WS_WBR) + (size_t)l * 4 * DM * BW);
          pg8::EpiMerge E; E.MG = (float*)(ws + WS_MG); E.MGB = (bf16_t*)(ws + WS_MGB); E.U = (const bf16_t*)(ws + WS_U); E.gate_b = INP(11) + (size_t)l * 4 * DM; pg8::gemm_phase<GemmBranch, pg8::EpiMerge, true, true>(c.lds, c.tid, g, E); }
        xcd_barrier(bar);
        { const Ctx c = fresh(c0); unsigned char* ws = WSP();
          GemmOut g = mk_gemm<GemmOut>(c, (const bf16_t*)(ws + WS_MGB), (const bf16_t*)(ws + WS_WOUT) + (size_t)l * DM * DM);
          pg8::EpiRes E; E.R = (const float*)(ws + WS_HF); E.Y = (float*)(ws + WS_Y); pg8::gemm_phase<GemmOut, pg8::EpiRes, true, true>(c.lds, c.tid, g, E); }
        xcd_barrier(bar);
        { const Ctx c = fresh(c0); unsigned char* ws = WSP(); ph_ln(c, (const float*)(ws + WS_Y), INP(31) + (size_t)l * DM, INP(32) + (size_t)l * DM, (float*)(ws + WS_X1F), (bf16_t*)(ws + WS_X1B), nullptr, MPAD, 0); }
        xcd_barrier(bar);
        { const Ctx c = fresh(c0); unsigned char* ws = WSP();
          GemmGU g = mk_gemm<GemmGU>(c, (const bf16_t*)(ws + WS_X1B), (const bf16_t*)(ws + WS_WGU) + (size_t)l * 2 * DFF * DM);
          pg8::EpiSwiGLU E; E.O = (bf16_t*)(ws + WS_ACT); pg8::gemm_phase<GemmGU, pg8::EpiSwiGLU, true, true>(c.lds, c.tid, g, E); }
        xcd_barrier(bar);
        { const Ctx c = fresh(c0); unsigned char* ws = WSP();
          GemmDown g = mk_gemm<GemmDown>(c, (const bf16_t*)(ws + WS_ACT), (const bf16_t*)(ws + WS_WDN) + (size_t)l * DM * DFF);
          pg8::EpiRes E; E.R = (const float*)(ws + WS_X1F); E.Y = (float*)(ws + WS_Y); pg8::gemm_phase<GemmDown, pg8::EpiRes, true, true>(c.lds, c.tid, g, E); }
        xcd_barrier(bar);
        { const Ctx c = fresh(c0); unsigned char* ws = WSP(); float* out = OUTP(); ph_ln(c, (const float*)(ws + WS_Y), INP(35) + (size_t)l * DM, INP(36) + (size_t)l * DM, (float*)(ws + WS_HF), (bf16_t*)(ws + WS_HB), l == NL - 1 ? out : nullptr, MPAD, MT); }
        xcd_barrier(bar);
    }
}

extern "C" void kernel_launch(void* const* d_in, const int* in_sizes, int n_in, void* d_out, int out_size, void* d_ws, size_t ws_size, hipStream_t stream) {
    static int grid = 0;
    if (grid == 0) {
        if (n_in != 37 || (size_t)out_size != O_END || ws_size < WS_END) { fprintf(stderr, "kernel_launch: unexpected sizes (n_in %d out %d ws %zu need %zu)\n", n_in, out_size, ws_size, (size_t)WS_END); grid = -1; return; }
        int dev = 0, cus = 0;
        if (hipGetDevice(&dev) != hipSuccess || hipDeviceGetAttribute(&cus, hipDeviceAttributeMultiprocessorCount, dev) != hipSuccess) { grid = -1; return; }
        if (hipFuncSetAttribute((const void*)mega_fwd, hipFuncAttributeMaxDynamicSharedMemorySize, LDS_BYTES) != hipSuccess) { fprintf(stderr, "kernel_launch: hipFuncSetAttribute failed\n"); grid = -1; return; }
        int per_cu = 0;
        if (hipOccupancyMaxActiveBlocksPerMultiprocessor(&per_cu, (const void*)mega_fwd, 512, LDS_BYTES) != hipSuccess || per_cu < 1) { fprintf(stderr, "kernel_launch: occupancy query says %d\n", per_cu); }
        (void)hipGetLastError();
        grid = cus;
    }
    if (grid < 0) return;
    (void)hipMemsetAsync((unsigned char*)d_ws + WS_CTL, 0, XCD_BAR_WORDS * sizeof(unsigned), stream);
    Args a; memset(&a, 0, sizeof a);
    for (int i = 0; i < 37; ++i) a.in[i] = (const float*)d_in[i];
    a.out = (float*)d_out; a.ws = (unsigned char*)d_ws;
    hipLaunchKernelGGL(mega_fwd, dim3(grid), dim3(512), LDS_BYTES, stream, a);
}
```

```cpp
#include <hip/hip_runtime.h>
#include <cstdio>
#include <cstdint>
#include <cstring>

#define LAS __attribute__((address_space(3)))
typedef unsigned short bf16_t;
typedef short bf16x8 __attribute__((ext_vector_type(8)));
typedef float f32x4 __attribute__((ext_vector_type(4)));
typedef float f32x2 __attribute__((ext_vector_type(2)));
typedef unsigned u32x4 __attribute__((ext_vector_type(4)));
typedef unsigned u32x2 __attribute__((ext_vector_type(2)));

constexpr int DM = 2048, NL = 4;
constexpr int PB = 2, PS = 4096, MP = PB * PS;
constexpr int SB = 32, SS = 4, MS = SB * SS;
constexpr int MT = MP + MS;
constexpr int MPAD = 8448;
constexpr int NIN = 16912, NINP = 17152;
constexpr int U_GQ = 0, U_GK = 512, U_GV = 1024, U_GR = 2048, U_GA = 3072, U_SQ = 3328, U_SK = 4352, U_SV = 4480, U_RU = 4608, U_MQ = 7936, U_GP = 8960;
constexpr int RWC = 3328, BW = 1024, DFF = 5632, MEMT = 256;
constexpr float ALPHA = 1.681792830507429f;

constexpr size_t O_YP = 0;
constexpr size_t O_YS = O_YP + (size_t)MP * DM;
constexpr size_t O_SWKP = O_YS + (size_t)MS * DM;
constexpr size_t O_SWVP = O_SWKP + (size_t)NL * PB * 128 * 128;
constexpr size_t O_MKP = O_SWVP + (size_t)NL * PB * 128 * 128;
constexpr size_t O_MVP = O_MKP + (size_t)NL * PB * 256 * 1024;
constexpr size_t O_GLAP = O_MVP + (size_t)NL * PB * 256 * 1024;
constexpr size_t O_RWP = O_GLAP + (size_t)NL * PB * 4 * 128 * 256;
constexpr size_t O_RSP = O_RWP + (size_t)NL * PB * 16 * 64 * 64;
constexpr size_t O_SWKS = O_RSP + (size_t)NL * PB * RWC;
constexpr size_t O_SWVS = O_SWKS + (size_t)NL * SB * 128 * 128;
constexpr size_t O_GLAS = O_SWVS + (size_t)NL * SB * 128 * 128;
constexpr size_t O_RWS = O_GLAS + (size_t)NL * SB * 4 * 128 * 256;
constexpr size_t O_RSS = O_RWS + (size_t)NL * SB * 16 * 64 * 64;
constexpr size_t O_END = O_RSS + (size_t)NL * SB * RWC;
static_assert(O_END == 52881408, "output size");

constexpr size_t al256(size_t x) { return (x + 255) & ~(size_t)255; }
constexpr size_t WS_CTL = 0;
constexpr size_t WS_WIN = 65536;
constexpr size_t WS_WMEM = WS_WIN + (size_t)NL * NINP * DM * 2;
constexpr size_t WS_WBR = WS_WMEM + (size_t)NL * DM * DM * 2;
constexpr size_t WS_WOUT = WS_WBR + (size_t)NL * 4 * DM * BW * 2;
constexpr size_t WS_WGU = WS_WOUT + (size_t)NL * DM * DM * 2;
constexpr size_t WS_WDN = WS_WGU + (size_t)NL * 2 * DFF * DM * 2;
constexpr size_t WS_HF = WS_WDN + (size_t)NL * DM * DFF * 2;
constexpr size_t WS_HB = WS_HF + (size_t)MPAD * DM * 4;
constexpr size_t WS_U = WS_HB + (size_t)MPAD * DM * 2;
constexpr size_t WS_BR = WS_U + (size_t)MPAD * NINP * 2;
constexpr size_t WS_MG = WS_BR + (size_t)4 * MPAD * BW * 2;
constexpr size_t WS_MGB = WS_MG + (size_t)MPAD * DM * 4;
constexpr size_t WS_Y = WS_MGB + (size_t)MPAD * DM * 2;
constexpr size_t WS_X1F = WS_Y + (size_t)MPAD * DM * 4;
constexpr size_t WS_X1B = WS_X1F + (size_t)MPAD * DM * 4;
constexpr size_t WS_ACT = WS_X1B + (size_t)MPAD * DM * 2;
constexpr size_t WS_MEMB = WS_ACT + (size_t)MPAD * DFF * 2;
constexpr size_t WS_MKB = WS_MEMB + (size_t)512 * DM * 2;
constexpr size_t WS_MVT = WS_MKB + (size_t)NL * 512 * 1024 * 2;
constexpr size_t WS_SC = WS_MVT + (size_t)NL * 8 * 256 * 256 * 2;
constexpr size_t WS_PB = WS_SC + (size_t)8 * 4096 * 256 * 4;
constexpr size_t WS_RW = WS_PB + (size_t)8 * 4096 * 256 * 2;
constexpr size_t RW_ARR = (size_t)MPAD * BW * 4;
constexpr int GL_NCH = 512 + 128;
constexpr size_t WS_GLQD = WS_RW + 8 * RW_ARR;
constexpr size_t WS_GLKH = WS_GLQD + (size_t)GL_NCH * 8192 * 2;
constexpr size_t WS_GLE = WS_GLKH + (size_t)GL_NCH * 8192 * 2;
constexpr size_t WS_GLVT = WS_GLE + (size_t)GL_NCH * 4096 * 2;
constexpr size_t WS_GLGC = WS_GLVT + (size_t)GL_NCH * 16384 * 2;
constexpr int RB_NCH = PB * 16 * 256 + SB * 16;
constexpr int RB_EL = 9216;
constexpr int RB_QP = 4608, RB_KHP = 5760, RB_VT = 7296, RB_EP = 8832;
constexpr size_t WS_RB = WS_GLGC + (size_t)GL_NCH * 128 * 4;
constexpr size_t WS_END = WS_RB + (size_t)RB_NCH * RB_EL * 2;

__device__ __forceinline__ float bf2f(bf16_t b) { return __uint_as_float(((unsigned)b) << 16); }
__device__ __forceinline__ bf16_t f2bf(float f) { unsigned u = __float_as_uint(f); u += 0x7FFFu + ((u >> 16) & 1u); return (bf16_t)(u >> 16); }
__device__ __forceinline__ unsigned pk2(float lo, float hi) { return (unsigned)f2bf(lo) | ((unsigned)f2bf(hi) << 16); }
__device__ __forceinline__ float wave_sum(float v) {
#pragma unroll
    for (int o = 32; o > 0; o >>= 1) v += __shfl_xor(v, o, 64);
    return v;
}
__device__ __forceinline__ float wave_max(float v) {
#pragma unroll
    for (int o = 32; o > 0; o >>= 1) v = fmaxf(v, __shfl_xor(v, o, 64));
    return v;
}
__device__ __forceinline__ float sigmoidf_(float x) { return 1.0f / (1.0f + __expf(-x)); }
__device__ __forceinline__ float softplusf_(float x) { return fmaxf(x, 0.f) + log1pf(__expf(-fabsf(x))); }

namespace pg8 {
constexpr int BM = 256, BK = 64, HALF = 128, HTB = HALF * BK * 2, STAGE_BYTES = 8 * HTB, NXCD = 8, WGM = 8;
__host__ __device__ __forceinline__ int lds_byte(int r, int c) { const int st = (r >> 4) * 2 + (c >> 5), rr = r & 15, cc = c & 31, ob = rr * 64 + cc * 2; return st * 1024 + (ob ^ (((ob >> 9) & 1) << 5)); }
__host__ __device__ __forceinline__ void stage_rc(int b, int& R, int& C) { const int st = b / 1024, sb = b % 1024, swz = sb ^ (((sb >> 9) & 1) << 5); R = (st >> 1) * 16 + swz / 64; C = (st & 1) * 32 + (swz % 64) / 2; }
__host__ __device__ __forceinline__ int perm32(int rho) { const int n = rho >> 4, i = rho & 15; return 8 * (i >> 2) + 4 * n + (i & 3); }

struct Unit { int pm, pn, z; };
template <int LDA_, int LDB_, int K_, int NM_, int NN_, int NZ_ = 1, int NZH_ = 1, bool ZINNER_ = false, long ZSAB_ = 0, long ZSAH_ = 0, long ZSBB_ = 0, long ZSBH_ = 0>
struct Gemm {
    static constexpr int LDA = LDA_, LDB = LDB_, K = K_, NM = NM_, NN = NN_, NZ = NZ_, NZH = NZH_; static constexpr bool ZINNER = ZINNER_;
    const bf16_t* A; const bf16_t* B; int G, c;
    __device__ __forceinline__ bool next(int i, Unit& u) const {
        constexpr int nt = NM * NN; int L, z;
        if (ZINNER) { const int it = i / NZ; z = i - it * NZ; const long LL = (long)it * G + c; if (LL >= nt) return false; L = (int)LL; }
        else { const long LL = (long)i * G + c; if (LL >= (long)nt * NZ) return false; z = (int)(LL / nt); L = (int)(LL - (long)z * nt); }
        int wgid = L; { constexpr int q = nt / NXCD, r = nt % NXCD; const int xcd = wgid % NXCD, off = wgid / NXCD; wgid = (xcd < r ? xcd * (q + 1) : r * (q + 1) + (xcd - r) * q) + off; }
        constexpr int nig = WGM * NN; const int gid = wgid / nig, fm = gid * WGM, gsz = (NM - fm) < WGM ? (NM - fm) : WGM;
        u.pm = fm + ((wgid % nig) % gsz); u.pn = (wgid % nig) / gsz; u.z = z; return true;
    }
    __device__ __forceinline__ const char* a_base(const Unit& u) const { const int zb = u.z / NZH, zh = u.z - zb * NZH; return (const char*)(A + zb * ZSAB_ + zh * ZSAH_ + (long)u.pm * BM * LDA); }
    __device__ __forceinline__ const char* b_base(const Unit& u) const { const int zb = u.z / NZH, zh = u.z - zb * NZH; return (const char*)(B + zb * ZSBB_ + zh * ZSBH_ + (long)u.pn * BM * LDB); }
};

template <class GT, class Epi, bool ALIGN_EPI = true, bool SP2 = true>
__device__ __forceinline__ void gemm_phase(LAS unsigned char* lds, const int tid, const GT& g, const Epi& E) {
    const int wid = __builtin_amdgcn_readfirstlane(tid >> 6), lane = tid & 63, wr = wid >> 2, wc = wid & 3, fr = lane & 15, fq = lane >> 4;
    constexpr int nt = GT::K / BK;
    unsigned voffA[2], voffB[2];
#pragma unroll
    for (int i = 0; i < 2; ++i) { int R, C; stage_rc(tid * 16 + i * 8192, R, C); const int Rb = Epi::PERM ? ((R & ~31) + perm32(R & 31)) : R;
        voffA[i] = (unsigned)(R * GT::LDA + C) * 2u; voffB[i] = (unsigned)(Rb * GT::LDB + C) * 2u; }
    constexpr size_t kstep = (size_t)(BK * 2);
    constexpr size_t hstepA = (size_t)HALF * GT::LDA * 2, hstepB = (size_t)HALF * GT::LDB * 2;
    const unsigned ldsw = (unsigned)wid * 1024u;
    const int aoff = lds_byte(wr * 64 + fr, fq * 8), boff = lds_byte(wc * 32 + fr, fq * 8);
#define PG8_SA(b, h) (((b) * 2 + (h)) * HTB)
#define PG8_SB(b, h) ((4 + (b) * 2 + (h)) * HTB)
#define PG8_STAGE(bufoff, gbase, voff) do { _Pragma("unroll") for (int _i = 0; _i < 2; ++_i) \
        __builtin_amdgcn_global_load_lds((const unsigned*)((const char*)(gbase) + (voff)[_i]), (LAS unsigned*)(lds + (bufoff) + ldsw + _i * 8192), 16, 0, 0); } while (0)
#define PG8_LDA(dst, b, h) do { _Pragma("unroll") for (int m = 0; m < 4; ++m) _Pragma("unroll") for (int k = 0; k < 2; ++k) dst[m][k] = *(const LAS bf16x8*)(lds + PG8_SA(b, h) + aoff + m * 2048 + k * 1024); } while (0)
#define PG8_LDB(dst, b, h) do { _Pragma("unroll") for (int n = 0; n < 2; ++n) _Pragma("unroll") for (int k = 0; k < 2; ++k) dst[n][k] = *(const LAS bf16x8*)(lds + PG8_SB(b, h) + boff + n * 2048 + k * 1024); } while (0)
#define PG8_MMA(ai, bj, At, Bt) do { __builtin_amdgcn_s_setprio(1); _Pragma("unroll") for (int m = 0; m < 4; ++m) _Pragma("unroll") for (int n = 0; n < 2; ++n) _Pragma("unroll") for (int k = 0; k < 2; ++k) \
        acc[ai][bj][m][n] = __builtin_amdgcn_mfma_f32_16x16x32_bf16(Bt[n][k], At[m][k], acc[ai][bj][m][n], 0, 0, 0); __builtin_amdgcn_s_setprio(0); } while (0)
#define PG8_WAIT_V(n) asm volatile("s_waitcnt vmcnt(" #n ")" ::: "memory")
#define PG8_WAIT_L(n) asm volatile("s_waitcnt lgkmcnt(" #n ")" ::: "memory")
#define PG8_BAR __builtin_amdgcn_s_barrier()
#define PG8_SCHED __builtin_amdgcn_sched_barrier(0)
    Unit cur, nxt; int ui = 0;
    if (!g.next(0, cur)) return;
    f32x4 acc[2][2][4][2];
#pragma unroll
    for (int a = 0; a < 2; ++a)
#pragma unroll
        for (int b = 0; b < 2; ++b)
#pragma unroll
            for (int m = 0; m < 4; ++m)
#pragma unroll
                for (int n = 0; n < 2; ++n) acc[a][b][m][n] = (f32x4){0.f, 0.f, 0.f, 0.f};
    bf16x8 At[4][2], B0[2][2], B1[2][2];
    const char* cA = g.a_base(cur); const char* cB = g.b_base(cur);
    if constexpr (SP2) {
        PG8_STAGE(PG8_SB(0, 0), cB, voffB); PG8_STAGE(PG8_SB(0, 1), cB + hstepB, voffB); PG8_STAGE(PG8_SA(0, 0), cA, voffA); PG8_STAGE(PG8_SA(0, 1), cA + hstepA, voffA);
        if (wr == 1) PG8_BAR;
        PG8_WAIT_V(2); PG8_BAR;
        PG8_STAGE(PG8_SB(1, 0), cB + kstep, voffB); PG8_STAGE(PG8_SA(1, 0), cA + kstep, voffA); PG8_STAGE(PG8_SB(1, 1), cB + hstepB + kstep, voffB);
        PG8_WAIT_V(6); PG8_BAR;
    } else {
        PG8_STAGE(PG8_SB(0, 0), cB, voffB); PG8_STAGE(PG8_SA(0, 0), cA, voffA); PG8_STAGE(PG8_SB(0, 1), cB + hstepB, voffB); PG8_STAGE(PG8_SA(0, 1), cA + hstepA, voffA);
        if (wr == 1) PG8_BAR;
        PG8_WAIT_V(4); PG8_BAR;
        PG8_STAGE(PG8_SB(1, 0), cB + kstep, voffB); PG8_STAGE(PG8_SA(1, 0), cA + kstep, voffA); PG8_STAGE(PG8_SB(1, 1), cB + hstepB + kstep, voffB);
        PG8_WAIT_V(6); PG8_BAR;
    }
    for (;;) {
        const bool has_next = g.next(ui + 1, nxt);
        const char* nA = has_next ? g.a_base(nxt) : cA; const char* nB = has_next ? g.b_base(nxt) : cB;
#pragma unroll 1
        for (int t = 0; t < nt; t += 2) {
            const bool last = (t == nt - 2);
            const char* a1 = cA + (size_t)(t + 1) * kstep;
            const char* a2 = last ? nA : cA + (size_t)(t + 2) * kstep; const char* b2 = last ? nB : cB + (size_t)(t + 2) * kstep;
            const char* a3 = a2 + kstep; const char* b3 = b2 + kstep;
            if constexpr (SP2) {
            PG8_LDB(B0, 0, 0); PG8_LDB(B1, 0, 1); PG8_SCHED; PG8_LDA(At, 0, 0); PG8_STAGE(PG8_SA(1, 1), a1 + hstepA, voffA);
            PG8_WAIT_V(8); PG8_WAIT_L(0); PG8_BAR; PG8_MMA(0, 0, At, B0); PG8_MMA(0, 1, At, B1); PG8_BAR; PG8_SCHED;
            PG8_LDA(At, 0, 1); PG8_STAGE(PG8_SB(0, 0), b2, voffB); PG8_STAGE(PG8_SB(0, 1), b2 + hstepB, voffB); PG8_STAGE(PG8_SA(0, 0), a2, voffA);
            PG8_WAIT_V(8); PG8_WAIT_L(0); PG8_BAR; PG8_MMA(1, 0, At, B0); PG8_MMA(1, 1, At, B1); PG8_BAR; PG8_SCHED;
            PG8_LDB(B0, 1, 0); PG8_LDB(B1, 1, 1); PG8_SCHED; PG8_LDA(At, 1, 0); PG8_STAGE(PG8_SA(0, 1), a2 + hstepA, voffA);
            PG8_WAIT_V(8); PG8_WAIT_L(0); PG8_BAR; PG8_MMA(0, 0, At, B0); PG8_MMA(0, 1, At, B1); PG8_BAR; PG8_SCHED;
            PG8_LDA(At, 1, 1); PG8_STAGE(PG8_SB(1, 0), b3, voffB); PG8_STAGE(PG8_SB(1, 1), b3 + hstepB, voffB); PG8_STAGE(PG8_SA(1, 0), a3, voffA);
            PG8_WAIT_V(8); PG8_WAIT_L(0); PG8_BAR; PG8_MMA(1, 0, At, B0); PG8_MMA(1, 1, At, B1); PG8_BAR; PG8_SCHED;
            } else {
            PG8_LDB(B0, 0, 0); PG8_SCHED; PG8_LDA(At, 0, 0); PG8_STAGE(PG8_SA(1, 1), a1 + hstepA, voffA);
            PG8_WAIT_L(8); PG8_BAR; PG8_WAIT_L(0); PG8_MMA(0, 0, At, B0); PG8_BAR; PG8_SCHED;
            PG8_LDB(B1, 0, 1); PG8_STAGE(PG8_SB(0, 0), b2, voffB);
            PG8_BAR; PG8_WAIT_L(0); PG8_MMA(0, 1, At, B1); PG8_BAR;
            PG8_LDA(At, 0, 1); PG8_STAGE(PG8_SA(0, 0), a2, voffA);
            PG8_BAR; PG8_WAIT_L(0); PG8_MMA(1, 0, At, B0); PG8_BAR; PG8_SCHED;
            PG8_STAGE(PG8_SB(0, 1), b2 + hstepB, voffB);
            PG8_WAIT_V(6); PG8_BAR; PG8_MMA(1, 1, At, B1); PG8_BAR;
            PG8_LDB(B0, 1, 0); PG8_SCHED; PG8_LDA(At, 1, 0); PG8_STAGE(PG8_SA(0, 1), a2 + hstepA, voffA);
            PG8_WAIT_L(8); PG8_BAR; PG8_WAIT_L(0); PG8_MMA(0, 0, At, B0); PG8_BAR; PG8_SCHED;
            PG8_LDB(B1, 1, 1); PG8_STAGE(PG8_SB(1, 0), b3, voffB);
            PG8_BAR; PG8_WAIT_L(0); PG8_MMA(0, 1, At, B1); PG8_BAR;
            PG8_LDA(At, 1, 1); PG8_STAGE(PG8_SA(1, 0), a3, voffA);
            PG8_BAR; PG8_WAIT_L(0); PG8_MMA(1, 0, At, B0); PG8_BAR; PG8_SCHED;
            PG8_STAGE(PG8_SB(1, 1), b3 + hstepB, voffB);
            PG8_WAIT_V(6); PG8_BAR; PG8_MMA(1, 1, At, B1); PG8_BAR;
            }
        }
        if constexpr (ALIGN_EPI) { if (wr == 0) PG8_BAR; }
        E(acc, cur, wr, wc, fr, fq);
        if (!has_next) break;
#pragma unroll
        for (int a = 0; a < 2; ++a)
#pragma unroll
            for (int b = 0; b < 2; ++b)
#pragma unroll
                for (int m = 0; m < 4; ++m)
#pragma unroll
                    for (int n = 0; n < 2; ++n) acc[a][b][m][n] = (f32x4){0.f, 0.f, 0.f, 0.f};
        cur = nxt; cA = nA; cB = nB; ++ui;
        if constexpr (ALIGN_EPI) { if (wr == 1) PG8_BAR; }
    }
    PG8_WAIT_V(0);
    if constexpr (!ALIGN_EPI) { if (wr == 0) PG8_BAR; }
    PG8_BAR;
#undef PG8_SA
#undef PG8_SB
#undef PG8_STAGE
#undef PG8_LDA
#undef PG8_LDB
#undef PG8_MMA
#undef PG8_WAIT_V
#undef PG8_WAIT_L
#undef PG8_BAR
#undef PG8_SCHED
}

struct EpiBf16 {
    static constexpr bool PERM = true;
    bf16_t* O; long zs; int ldc, pad;
    __device__ __forceinline__ void operator()(const f32x4 (&acc)[2][2][4][2], const Unit& u, int wr, int wc, int fr, int fq) const {
        const int row0 = u.pm * BM + wr * 64 + fr, col0 = u.pn * BM + wc * 32 + 8 * fq; bf16_t* base = O + (long)u.z * zs;
#pragma unroll
        for (int ai = 0; ai < 2; ++ai)
#pragma unroll
            for (int m = 0; m < 4; ++m) { bf16_t* rowp = base + (size_t)(row0 + ai * HALF + m * 16) * ldc + col0;
#pragma unroll
                for (int bj = 0; bj < 2; ++bj) { const f32x4 v0 = acc[ai][bj][m][0], v1 = acc[ai][bj][m][1];
                    u32x4 w; w.x = pk2(v0[0], v0[1]); w.y = pk2(v0[2], v0[3]); w.z = pk2(v1[0], v1[1]); w.w = pk2(v1[2], v1[3]);
                    *(u32x4*)(rowp + bj * HALF) = w; } }
    }
};
struct EpiMem {
    static constexpr bool PERM = false;
    float* outK; float* outV; bf16_t* kb; bf16_t* vt;
    __device__ __forceinline__ void operator()(const f32x4 (&acc)[2][2][4][2], const Unit& u, int wr, int wc, int fr, int fq) const {
        const int row0 = u.pm * BM + wr * 64 + fr, col0 = u.pn * BM + wc * 32 + 4 * fq;
#pragma unroll
        for (int ai = 0; ai < 2; ++ai)
#pragma unroll
            for (int m = 0; m < 4; ++m) { const int row = row0 + ai * HALF + m * 16;
#pragma unroll
                for (int bj = 0; bj < 2; ++bj)
#pragma unroll
                    for (int n = 0; n < 2; ++n) { const int col = col0 + bj * HALF + n * 16; const f32x4 v = acc[ai][bj][m][n];
                        if (col < 1024) { *(f32x4*)(outK + ((size_t)u.z * 512 + row) * 1024 + col) = v;
                            u32x2 w; w.x = pk2(v[0], v[1]); w.y = pk2(v[2], v[3]); *(u32x2*)(kb + ((size_t)u.z * 512 + row) * 1024 + col) = w; }
                        else { const int c = col - 1024; *(f32x4*)(outV + ((size_t)u.z * 512 + row) * 1024 + c) = v;
                            const int b = row >> 8, mm = row & 255, h = c >> 8, d = c & 255; bf16_t* p = vt + ((((size_t)u.z * 2 + b) * 4 + h) * 256 + d) * 256 + mm;
                            p[0] = f2bf(v[0]); p[256] = f2bf(v[1]); p[512] = f2bf(v[2]); p[768] = f2bf(v[3]); } } }
    }
};
struct EpiMerge {
    static constexpr bool PERM = false;
    float* MG; bf16_t* MGB; const bf16_t* U; const float* gate_b;
    __device__ __forceinline__ void operator()(const f32x4 (&acc)[2][2][4][2], const Unit& u, int wr, int wc, int fr, int fq) const {
        const int row0 = u.pm * BM + wr * 64 + fr, col0 = u.pn * BM + wc * 32 + 4 * fq;
#pragma unroll
        for (int ai = 0; ai < 2; ++ai)
#pragma unroll
            for (int m = 0; m < 4; ++m) { const int row = row0 + ai * HALF + m * 16;
#pragma unroll
                for (int bj = 0; bj < 2; ++bj)
#pragma unroll
                    for (int n = 0; n < 2; ++n) { const int col = col0 + bj * HALF + n * 16; const f32x4 v = acc[ai][bj][m][n];
                        const u32x2 gp = *(const u32x2*)(U + (size_t)row * NINP + U_GP + u.z * DM + col); const f32x4 gb = *(const f32x4*)(gate_b + u.z * DM + col);
                        f32x4 gt; gt[0] = sigmoidf_(__uint_as_float(gp.x << 16) + gb[0]); gt[1] = sigmoidf_(__uint_as_float(gp.x & 0xffff0000u) + gb[1]);
                        gt[2] = sigmoidf_(__uint_as_float(gp.y << 16) + gb[2]); gt[3] = sigmoidf_(__uint_as_float(gp.y & 0xffff0000u) + gb[3]);
                        float* mp = MG + (size_t)row * DM + col; f32x4 r = gt * v;
                        if (u.z > 0) r += *(const f32x4*)mp;
                        if (u.z < 3) *(f32x4*)mp = r;
                        else { u32x2 w; w.x = pk2(r[0], r[1]); w.y = pk2(r[2], r[3]); *(u32x2*)(MGB + (size_t)row * DM + col) = w; } } }
    }
};
struct EpiRes {
    static constexpr bool PERM = false;
    const float* R; float* Y;
    __device__ __forceinline__ void operator()(const f32x4 (&acc)[2][2][4][2], const Unit& u, int wr, int wc, int fr, int fq) const {
        const int row0 = u.pm * BM + wr * 64 + fr, col0 = u.pn * BM + wc * 32 + 4 * fq;
#pragma unroll
        for (int ai = 0; ai < 2; ++ai)
#pragma unroll
            for (int m = 0; m < 4; ++m) { const size_t ro = (size_t)(row0 + ai * HALF + m * 16) * DM + col0;
#pragma unroll
                for (int bj = 0; bj < 2; ++bj)
#pragma unroll
                    for (int n = 0; n < 2; ++n) { const size_t o = ro + bj * HALF + n * 16; *(f32x4*)(Y + o) = *(const f32x4*)(R + o) * ALPHA + acc[ai][bj][m][n]; } }
    }
};
struct EpiSwiGLU {
    static constexpr bool PERM = true;
    bf16_t* O;
    __device__ __forceinline__ void operator()(const f32x4 (&acc)[2][2][4][2], const Unit& u, int wr, int wc, int fr, int fq) const {
        const int row0 = u.pm * BM + wr * 64 + fr, col0 = u.pn * HALF + wc * 32 + 8 * fq;
#pragma unroll
        for (int ai = 0; ai < 2; ++ai)
#pragma unroll
            for (int m = 0; m < 4; ++m) { bf16_t* rowp = O + (size_t)(row0 + ai * HALF + m * 16) * DFF + col0;
                float r[8];
#pragma unroll
                for (int n = 0; n < 2; ++n)
#pragma unroll
                    for (int j = 0; j < 4; ++j) { const float gg = acc[ai][0][m][n][j], uu = acc[ai][1][m][n][j]; r[n * 4 + j] = gg * sigmoidf_(gg) * uu; }
                u32x4 w; w.x = pk2(r[0], r[1]); w.y = pk2(r[2], r[3]); w.z = pk2(r[4], r[5]); w.w = pk2(r[6], r[7]);
                *(u32x4*)rowp = w; }
    }
};
struct EpiScore {
    static constexpr bool PERM = false;
    float* SC;
    __device__ __forceinline__ void operator()(const f32x4 (&acc)[2][2][4][2], const Unit& u, int wr, int wc, int fr, int fq) const {
        const int row0 = u.pm * BM + wr * 64 + fr, col0 = wc * 32 + 4 * fq; float* base = SC + (size_t)u.z * 4096 * 256;
#pragma unroll
        for (int ai = 0; ai < 2; ++ai)
#pragma unroll
            for (int m = 0; m < 4; ++m) { float* rowp = base + (size_t)(row0 + ai * HALF + m * 16) * 256 + col0;
#pragma unroll
                for (int bj = 0; bj < 2; ++bj)
#pragma unroll
                    for (int n = 0; n < 2; ++n) *(f32x4*)(rowp + bj * HALF + n * 16) = acc[ai][bj][m][n] * 0.0625f; }
    }
};
struct EpiPV {
    static constexpr bool PERM = true;
    bf16_t* O;
    __device__ __forceinline__ void operator()(const f32x4 (&acc)[2][2][4][2], const Unit& u, int wr, int wc, int fr, int fq) const {
        const int b = u.z >> 2, h = u.z & 3; const int row0 = b * PS + u.pm * BM + wr * 64 + fr, col0 = h * 256 + wc * 32 + 8 * fq;
#pragma unroll
        for (int ai = 0; ai < 2; ++ai)
#pragma unroll
            for (int m = 0; m < 4; ++m) { bf16_t* rowp = O + (size_t)(row0 + ai * HALF + m * 16) * BW + col0;
#pragma unroll
                for (int bj = 0; bj < 2; ++bj) { const f32x4 v0 = acc[ai][bj][m][0], v1 = acc[ai][bj][m][1];
                    u32x4 w; w.x = pk2(v0[0], v0[1]); w.y = pk2(v0[2], v0[3]); w.z = pk2(v1[0], v1[1]); w.w = pk2(v1[2], v1[3]);
                    *(u32x4*)(rowp + bj * HALF) = w; } }
    }
};
}


#define XB_TMO      128
#define XB_XCNT(j)  (256  + 64 * (j))
#define XB_XSUB(j)  (1280 + 64 * (j))
#define XB_XGEN(j)  (2304 + 64 * (j))
#define XB_TOP      3328
#define XB_TOPGEN   3392
#define XCD_BAR_WORDS 3456
#define XB_SPIN_CAP (1u << 18)
__device__ __forceinline__ unsigned xb_ld(unsigned* p)              { return __hip_atomic_load(p, __ATOMIC_RELAXED, __HIP_MEMORY_SCOPE_AGENT); }
__device__ __forceinline__ unsigned xb_add(unsigned* p, unsigned v) { return __hip_atomic_fetch_add(p, v, __ATOMIC_RELAXED, __HIP_MEMORY_SCOPE_AGENT); }
__device__ __forceinline__ unsigned xb_xcc_id() { return (unsigned)__builtin_amdgcn_s_getreg((3 << 11) | 20) & 0xFu; }
#define XB_SPIN(cond, bar) do { unsigned _sp = 0; while (cond) { __builtin_amdgcn_s_sleep(1); \
    if ((++_sp & 255u) == 0u) { if (xb_ld(&(bar)[XB_TMO])) break; if (_sp > XB_SPIN_CAP) { atomicAdd(&(bar)[XB_TMO], 1u); break; } } } } while (0)
struct XcdBarrier { unsigned* bar; unsigned x; volatile LAS unsigned* st; };
__device__ __forceinline__ XcdBarrier xcd_barrier_post(unsigned* bar, volatile LAS unsigned* st) {
    XcdBarrier b; b.bar = bar; b.x = xb_xcc_id(); b.st = st;
    if (threadIdx.x == 0) (void)xb_add(&bar[XB_XCNT(b.x)], 1u);
    return b;
}
__device__ __forceinline__ void xcd_barrier_complete(unsigned* bar, unsigned x, unsigned& nloc, unsigned& nx) {
    const unsigned G = gridDim.x * gridDim.y * gridDim.z;
    unsigned sum, cnt, mine, sp = 0u;
    for (;;) {
        sum = 0u; cnt = 0u; mine = 0u;
#pragma unroll
        for (unsigned j = 0; j < 16; ++j) { const unsigned c = xb_ld(&bar[XB_XCNT(j)]); sum += c; cnt += (c > 0u) ? 1u : 0u; mine = (j == x) ? c : mine; }
        if (sum == G) break;
        __builtin_amdgcn_s_sleep(1);
        if ((++sp & 255u) == 0u) { if (xb_ld(&bar[XB_TMO])) break; if (sp > XB_SPIN_CAP) { atomicAdd(&bar[XB_TMO], 1u); break; } }
    }
    nloc = mine > 0u ? mine : 1u; nx = cnt > 0u ? cnt : 1u;
}
__device__ __forceinline__ void xcd_barrier(const XcdBarrier& b) {
    asm volatile("s_waitcnt vmcnt(0)" ::: "memory");
    __syncthreads();
    if (threadIdx.x == 0) {
        unsigned* bar = b.bar;
        __builtin_amdgcn_s_waitcnt(0);
        unsigned nloc = b.st[0], nx = b.st[1];
        if (nloc == 0u) { xcd_barrier_complete(bar, b.x, nloc, nx); b.st[0] = nloc; b.st[1] = nx; }
        const unsigned old = xb_add(&bar[XB_XSUB(b.x)], 1u);
        const unsigned gen = old / nloc;
        if (old + 1u == (gen + 1u) * nloc) {
            __builtin_amdgcn_fence(__ATOMIC_RELEASE, "agent");
            asm volatile("s_waitcnt vmcnt(0)" ::: "memory");
            const unsigned og = xb_add(&bar[XB_TOP], 1u);
            const unsigned tg = og / nx;
            if (og + 1u == (tg + 1u) * nx) xb_add(&bar[XB_TOPGEN], 1u);
            else XB_SPIN(xb_ld(&bar[XB_TOPGEN]) == tg, bar);
            __builtin_amdgcn_fence(__ATOMIC_ACQUIRE, "agent");
            xb_add(&bar[XB_XGEN(b.x)], 1u);
            asm volatile("s_waitcnt vmcnt(0)" ::: "memory");
        } else {
            XB_SPIN(xb_ld(&bar[XB_XGEN(b.x)]) == gen, bar);
            __builtin_amdgcn_fence(__ATOMIC_ACQUIRE, "agent");
            asm volatile("s_waitcnt vmcnt(0)" ::: "memory");
        }
    }
    __syncthreads();
}

struct Ctx { int tid, lane, wave, bid, G; LAS unsigned char* lds; };
__device__ __forceinline__ Ctx fresh(const Ctx& c0) { Ctx c; c.wave = c0.wave; c.bid = c0.bid; c.G = c0.G; c.lds = c0.lds; asm volatile("" : "+s"(c.bid), "+s"(c.G), "+s"(c.wave));
    int lane = (int)__builtin_amdgcn_mbcnt_hi(~0u, __builtin_amdgcn_mbcnt_lo(~0u, 0u)); asm volatile("" : "+v"(lane)); c.lane = lane; c.tid = c.wave * 64 + lane; return c; }

__device__ __forceinline__ int colmap(int mode, int n) {
    if (mode == 1) return n < 3088 ? n : (n < 3328 ? -1 : n - 240);
    if (mode == 2) { const int t = n >> 8, j = n & 255; return j < 128 ? t * 128 + j : DFF + t * 128 + (j - 128); }
    return n;
}
__device__ __forceinline__ void ph_wprep(const Ctx& c, const float* __restrict__ src, bf16_t* __restrict__ dst, int K, int Nsrc, int Ndst, int mode, int nbatch, size_t sbs, size_t dbs) {
    LAS float* tile = (LAS float*)c.lds;
    const int nx = Ndst / 64, ny = K / 64, total = nx * ny * nbatch;
    const int tx = c.tid & 63, ty = c.tid >> 6, r = c.tid >> 3, p = c.tid & 7;
    for (int t = c.bid; t < total; t += c.G) {
        const int bx = t % nx, by = (t / nx) % ny, bz = t / (nx * ny);
        const float* s = src + (size_t)bz * sbs; bf16_t* d = dst + (size_t)bz * dbs;
        const int n0 = bx * 64, k0 = by * 64, cm = colmap(mode, n0 + tx);
        for (int kk = ty; kk < 64; kk += 8) tile[kk * 65 + tx] = cm >= 0 ? s[(size_t)(k0 + kk) * Nsrc + cm] : 0.f;
        __syncthreads();
        { u32x4 w; w.x = pk2(tile[(p * 8 + 0) * 65 + r], tile[(p * 8 + 1) * 65 + r]); w.y = pk2(tile[(p * 8 + 2) * 65 + r], tile[(p * 8 + 3) * 65 + r]);
          w.z = pk2(tile[(p * 8 + 4) * 65 + r], tile[(p * 8 + 5) * 65 + r]); w.w = pk2(tile[(p * 8 + 6) * 65 + r], tile[(p * 8 + 7) * 65 + r]);
          *(u32x4*)(d + (size_t)(n0 + r) * K + k0 + p * 8) = w; }
        __syncthreads();
    }
}
__device__ __forceinline__ void ph_xprep(const Ctx& c, const float* __restrict__ xp, const float* __restrict__ xs, const float* __restrict__ mem, float* __restrict__ HF, bf16_t* __restrict__ HB, bf16_t* __restrict__ MEMB) {
    const size_t nH = (size_t)MPAD * DM / 4, nM = (size_t)512 * DM / 4;
    for (size_t i4 = (size_t)c.bid * 512 + c.tid; i4 < nH + nM; i4 += (size_t)c.G * 512) {
        if (i4 < nH) {
            const size_t e = i4 * 4; f32x4 v = (f32x4){0.f, 0.f, 0.f, 0.f};
            if (e < (size_t)MP * DM) v = *(const f32x4*)(xp + e); else if (e < (size_t)MT * DM) v = *(const f32x4*)(xs + (e - (size_t)MP * DM));
            *(f32x4*)(HF + e) = v; u32x2 w; w.x = pk2(v[0], v[1]); w.y = pk2(v[2], v[3]); *(u32x2*)(HB + e) = w;
        } else {
            const size_t e = (i4 - nH) * 4; const f32x4 v = *(const f32x4*)(mem + e); u32x2 w; w.x = pk2(v[0], v[1]); w.y = pk2(v[2], v[3]); *(u32x2*)(MEMB + e) = w;
        }
    }
}
__device__ __forceinline__ void ph_ln(const Ctx& c, const float* __restrict__ Y, const float* __restrict__ g, const float* __restrict__ b, float* __restrict__ XF, bf16_t* __restrict__ XB, float* __restrict__ OUT, int nrows, int nout) {
    const int lane = c.lane;
    for (int row = c.bid * 8 + c.wave; row < nrows; row += c.G * 8) {
        const float* y = Y + (size_t)row * DM; f32x4 v[8]; float s = 0.f;
#pragma unroll
        for (int j = 0; j < 8; ++j) { v[j] = *(const f32x4*)(y + j * 256 + lane * 4); s += (v[j][0] + v[j][1]) + (v[j][2] + v[j][3]); }
        const float mean = wave_sum(s) * (1.0f / DM); float q = 0.f;
#pragma unroll
        for (int j = 0; j < 8; ++j) { const f32x4 d = v[j] - mean; q += (d[0] * d[0] + d[1] * d[1]) + (d[2] * d[2] + d[3] * d[3]); }
        const float rstd = rsqrtf(wave_sum(q) * (1.0f / DM) + 1e-5f);
#pragma unroll
        for (int j = 0; j < 8; ++j) { const int cc = j * 256 + lane * 4; const f32x4 gg = *(const f32x4*)(g + cc), bb = *(const f32x4*)(b + cc);
            const f32x4 o = (v[j] - mean) * rstd * gg + bb; const size_t off = (size_t)row * DM + cc;
            *(f32x4*)(XF + off) = o; u32x2 w; w.x = pk2(o[0], o[1]); w.y = pk2(o[2], o[3]); *(u32x2*)(XB + off) = w;
            if (OUT != nullptr && row < nout) *(f32x4*)(OUT + off) = o; }
    }
}
__device__ __forceinline__ void ph_softmax256(const Ctx& c, const float* __restrict__ SC, bf16_t* __restrict__ P, int nrows) {
    const int lane = c.lane;
    for (int row = c.bid * 8 + c.wave; row < nrows; row += c.G * 8) {
        const f32x4 v = *(const f32x4*)(SC + (size_t)row * 256 + lane * 4);
        const float mx = wave_max(fmaxf(fmaxf(v[0], v[1]), fmaxf(v[2], v[3])));
        f32x4 e; e[0] = __expf(v[0] - mx); e[1] = __expf(v[1] - mx); e[2] = __expf(v[2] - mx); e[3] = __expf(v[3] - mx);
        const float inv = 1.0f / wave_sum((e[0] + e[1]) + (e[2] + e[3]));
        u32x2 w; w.x = pk2(e[0] * inv, e[1] * inv); w.y = pk2(e[2] * inv, e[3] * inv); *(u32x2*)(P + (size_t)row * 256 + lane * 4) = w;
    }
}
__device__ __forceinline__ void ph_copy_outs(const Ctx& c, const bf16_t* __restrict__ U, const float* __restrict__ ck, const float* __restrict__ cv, float* __restrict__ out, int layer) {
    constexpr int nA = PB * 128 * 128, nB = SB * 128 * 128, nC = PB * RWC, nD = SB * RWC;
    for (int i = c.bid * 512 + c.tid; i < nA + nB + nC + nD; i += c.G * 512) {
        if (i < nA) { const int b = i / 16384, j = (i >> 7) & 127, cc = i & 127; const size_t ur = (size_t)(b * PS + PS - 128 + j) * NINP;
            out[O_SWKP + (size_t)layer * nA + i] = bf2f(U[ur + U_SK + cc]); out[O_SWVP + (size_t)layer * nA + i] = bf2f(U[ur + U_SV + cc]); continue; }
        int k = i - nA;
        if (k < nB) { const int sq = k / 16384, j = (k >> 7) & 127, cc = k & 127; float kv, vv;
            if (j < 124) { const size_t o = ((size_t)sq * 128 + j + 4) * 128 + cc; kv = ck[o]; vv = cv[o]; }
            else { const size_t ur = (size_t)(MP + sq * SS + j - 124) * NINP; kv = bf2f(U[ur + U_SK + cc]); vv = bf2f(U[ur + U_SV + cc]); }
            out[O_SWKS + (size_t)layer * nB + k] = kv; out[O_SWVS + (size_t)layer * nB + k] = vv; continue; }
        k -= nB;
        if (k < nC) { const int b = k / RWC, cc = k - b * RWC; out[O_RSP + (size_t)layer * nC + k] = bf2f(U[(size_t)(b * PS + PS - 1) * NINP + U_RU + cc]); continue; }
        k -= nC;
        { const int sq = k / RWC, cc = k - sq * RWC; out[O_RSS + (size_t)layer * nD + k] = bf2f(U[(size_t)(MP + sq * SS + SS - 1) * NINP + U_RU + cc]); }
    }
}

__device__ __forceinline__ void seq_info(int sq, int& row0, int& L) { if (sq < PB) { row0 = sq * PS; L = PS; } else { row0 = MP + (sq - PB) * SS; L = SS; } }

__device__ __forceinline__ void ph_gla_naive(const Ctx& c, const bf16_t* __restrict__ U, const float* __restrict__ s0, const float* __restrict__ a_up, const float* __restrict__ a_b,
                                             const float* __restrict__ ng, const float* __restrict__ nb, bf16_t* __restrict__ OB, float* __restrict__ outP, float* __restrict__ outS) {
    LAS float* qs = (LAS float*)c.lds;
    LAS float* ks = qs + 16 * 128; LAS float* as = ks + 16 * 128; LAS float* os = as + 16 * 128;
    const int kh = c.tid >> 8, vt = c.tid & 255, lane = c.lane;
    for (int u = c.bid; u < (PB + SB) * 4; u += c.G) {
        const int sq = u >> 2, h = u & 3;
        int row0, L; seq_info(sq, row0, L);
        float S[64];
        if (sq >= PB) { const float* p = s0 + (((size_t)(sq - PB) * 4 + h) * 128 + kh * 64) * 256 + vt;
#pragma unroll
            for (int kk = 0; kk < 64; ++kk) S[kk] = p[(size_t)kk * 256]; }
        else {
#pragma unroll
            for (int kk = 0; kk < 64; ++kk) S[kk] = 0.f; }
        for (int t0 = 0; t0 < L; t0 += 16) {
            const int nT = (L - t0) < 16 ? (L - t0) : 16;
            for (int idx = c.tid; idx < nT * 128; idx += 512) {
                const int tt = idx >> 7, kk = idx & 127; const bf16_t* ur = U + (size_t)(row0 + t0 + tt) * NINP;
                qs[idx] = bf2f(ur[U_GQ + h * 128 + kk]) * 0.08838834764831845f; ks[idx] = bf2f(ur[U_GK + h * 128 + kk]);
                float x = a_b[h * 128 + kk];
#pragma unroll
                for (int r = 0; r < 16; ++r) x += bf2f(ur[U_GA + r]) * a_up[r * 512 + h * 128 + kk];
                const float ls = (fminf(x, 0.f) - log1pf(__expf(-fabsf(x)))) * (1.0f / 16.0f);
                as[idx] = __expf(ls);
            }
            __syncthreads();
            for (int tt = 0; tt < nT; ++tt) {
                const float v = bf2f(U[(size_t)(row0 + t0 + tt) * NINP + U_GV + h * 256 + vt]); float o = 0.f; const int lb = tt * 128 + kh * 64;
#pragma unroll
                for (int kk = 0; kk < 64; ++kk) { S[kk] = as[lb + kk] * S[kk] + ks[lb + kk] * v; o += qs[lb + kk] * S[kk]; }
                os[(kh * 16 + tt) * 256 + vt] = o;
            }
            __syncthreads();
            for (int tt = c.wave; tt < nT; tt += 8) {
                float x[4]; float s = 0.f;
#pragma unroll
                for (int j = 0; j < 4; ++j) { x[j] = os[tt * 256 + lane + 64 * j] + os[(16 + tt) * 256 + lane + 64 * j]; s += x[j]; }
                const float mean = wave_sum(s) * (1.0f / 256.0f); float q = 0.f;
#pragma unroll
                for (int j = 0; j < 4; ++j) { const float d = x[j] - mean; q += d * d; }
                const float rstd = rsqrtf(wave_sum(q) * (1.0f / 256.0f) + 1e-5f);
                const size_t row = (size_t)(row0 + t0 + tt);
#pragma unroll
                for (int j = 0; j < 4; ++j) { const int cc = h * 256 + lane + 64 * j; const float n = (x[j] - mean) * rstd * ng[cc] + nb[cc];
                    const float gr = bf2f(U[row * NINP + U_GR + cc]); OB[row * BW + cc] = f2bf(n * gr * sigmoidf_(gr)); }
            }
            __syncthreads();
        }
        float* op = (sq < PB ? outP + (((size_t)sq * 4 + h) * 128 + kh * 64) * 256 : outS + (((size_t)(sq - PB) * 4 + h) * 128 + kh * 64) * 256) + vt;
#pragma unroll
        for (int kk = 0; kk < 64; ++kk) op[(size_t)kk * 256] = S[kk];
    }
}

__device__ __forceinline__ f32x4 mma16(bf16x8 x, bf16x8 y, f32x4 c) { return __builtin_amdgcn_mfma_f32_16x16x32_bf16(x, y, c, 0, 0, 0); }
__device__ __forceinline__ void gla_chunk_info(int u, int& row0, int& ntok, int& h) {
    if (u < 512) { const int b = u >> 8; h = (u >> 6) & 3; row0 = b * PS + (u & 63) * 64; ntok = 64; }
    else { const int s = u - 512; h = s & 3; row0 = MP + (s >> 2) * SS; ntok = SS; }
}
__device__ __forceinline__ void ph_gla_pre(const Ctx& c, const bf16_t* __restrict__ U, const float* __restrict__ a_up, const float* __restrict__ a_b,
                                           bf16_t* __restrict__ QD, bf16_t* __restrict__ KHT, bf16_t* __restrict__ EE, bf16_t* __restrict__ VT, float* __restrict__ GC) {
    LAS float* ga_l = (LAS float*)c.lds;
    LAS float* tot = ga_l + 64 * 16;
    LAS bf16_t* Qd_l = (LAS bf16_t*)(tot + 4 * 128);
    LAS bf16_t* Kn_l = Qd_l + 64 * 136;
    LAS bf16_t* v_l = Kn_l + 64 * 136;
    const int tid = c.tid, lane = c.lane, r = lane & 15, q = lane >> 4, w = c.wave;
    for (int u = c.bid; u < GL_NCH; u += c.G) {
        int row0, ntok, h; gla_chunk_info(u, row0, ntok, h);
        for (int i = tid; i < 64 * 16; i += 512) { const int t = i >> 4, rr = i & 15; ga_l[i] = t < ntok ? bf2f(U[(size_t)(row0 + t) * NINP + U_GA + rr]) : 0.f; }
        for (int i = tid; i < 64 * 32; i += 512) { const int t = i >> 5, c8 = i & 31; u32x4 vv = (u32x4){0u, 0u, 0u, 0u};
            if (t < ntok) vv = *(const u32x4*)(U + (size_t)(row0 + t) * NINP + U_GV + h * 256 + c8 * 8);
            *(LAS u32x4*)(v_l + t * 264 + c8 * 8) = vv; }
        __syncthreads();
        const int kk = tid & 127, tq = tid >> 7;
        float cum[16];
        { float aup[16];
#pragma unroll
          for (int rr = 0; rr < 16; ++rr) aup[rr] = a_up[rr * 512 + h * 128 + kk];
          const float ab = a_b[h * 128 + kk]; float run = 0.f;
#pragma unroll
          for (int j = 0; j < 16; ++j) { const int t = tq * 16 + j; float x = ab;
#pragma unroll
              for (int rr = 0; rr < 16; ++rr) x += ga_l[t * 16 + rr] * aup[rr];
              const float la = t < ntok ? (fminf(x, 0.f) - log1pf(__expf(-fabsf(x)))) * (1.0f / 16.0f) : 0.f;
              run += la; cum[j] = run; }
          tot[tq * 128 + kk] = run; }
        __syncthreads();
        { float prefix = 0.f, bC = 0.f;
#pragma unroll
          for (int g = 0; g < 4; ++g) { const float tv = tot[g * 128 + kk]; bC += tv; if (g < tq) prefix += tv; }
          unsigned khp[8];
#pragma unroll
          for (int j = 0; j < 16; j += 2) { float kh2[2];
#pragma unroll
              for (int e = 0; e < 2; ++e) { const int t = tq * 16 + j + e; const float b = prefix + cum[j + e]; float qv = 0.f, kv = 0.f;
                  if (t < ntok) { const bf16_t* ur = U + (size_t)(row0 + t) * NINP; qv = bf2f(ur[U_GQ + h * 128 + kk]); kv = bf2f(ur[U_GK + h * 128 + kk]); }
                  Qd_l[t * 136 + kk] = f2bf(qv * __expf(b) * 0.08838834764831845f); Kn_l[t * 136 + kk] = f2bf(kv * __expf(-b)); kh2[e] = kv * __expf(bC - b); }
              khp[j >> 1] = pk2(kh2[0], kh2[1]); }
          bf16_t* kp = KHT + (size_t)u * 8192 + kk * 64 + tq * 16;
          *(u32x4*)kp = (u32x4){khp[0], khp[1], khp[2], khp[3]}; *(u32x4*)(kp + 8) = (u32x4){khp[4], khp[5], khp[6], khp[7]};
          if (tq == 0) GC[(size_t)u * 128 + kk] = __expf(bC); }
        __syncthreads();
        { const int tb = w >> 1;
#pragma unroll
          for (int e = 0; e < 2; ++e) { const int ib = (w & 1) * 2 + e; f32x4 d = (f32x4){0.f, 0.f, 0.f, 0.f};
              if (ib <= tb) {
#pragma unroll
                  for (int ks = 0; ks < 4; ++ks) d = mma16(*(const LAS bf16x8*)(Kn_l + (ib * 16 + r) * 136 + ks * 32 + q * 8), *(const LAS bf16x8*)(Qd_l + (tb * 16 + r) * 136 + ks * 32 + q * 8), d); }
              const int t = tb * 16 + r, i0 = ib * 16 + q * 4;
#pragma unroll
              for (int jj = 0; jj < 4; ++jj) if (i0 + jj > t) d[jj] = 0.f;
              u32x2 o; o.x = pk2(d[0], d[1]); o.y = pk2(d[2], d[3]); *(u32x2*)(EE + (size_t)u * 4096 + t * 64 + i0) = o; } }
        for (int i = tid; i < 64 * 16; i += 512) { const int t = i >> 4, c8 = i & 15; *(u32x4*)(QD + (size_t)u * 8192 + t * 128 + c8 * 8) = *(const LAS u32x4*)(Qd_l + t * 136 + c8 * 8); }
        { const int val = tid & 255, th = tid >> 8;
#pragma unroll
          for (int tg = 0; tg < 4; ++tg) { const int t0 = th * 32 + tg * 8; unsigned p4[4];
#pragma unroll
              for (int e = 0; e < 4; ++e) p4[e] = (unsigned)v_l[(t0 + 2 * e) * 264 + val] | ((unsigned)v_l[(t0 + 2 * e + 1) * 264 + val] << 16);
              *(u32x4*)(VT + (size_t)u * 16384 + val * 64 + t0) = (u32x4){p4[0], p4[1], p4[2], p4[3]}; } }
        __syncthreads();
    }
}
struct GlaFrag { bf16x8 qd[4], e[2], kh[2], vt[4][2]; f32x4 gc; };
__device__ __forceinline__ void gla_load_frag(GlaFrag& f, const bf16_t* __restrict__ QD, const bf16_t* __restrict__ KHT, const bf16_t* __restrict__ EE, const bf16_t* __restrict__ VT, const float* __restrict__ GC,
                                              int ch, int sl, int w, int r, int q) {
    const int rb = w >> 1;
#pragma unroll
    for (int ks = 0; ks < 4; ++ks) f.qd[ks] = *(const bf16x8*)(QD + (size_t)ch * 8192 + (rb * 16 + r) * 128 + ks * 32 + q * 8);
#pragma unroll
    for (int ks = 0; ks < 2; ++ks) { f.e[ks] = *(const bf16x8*)(EE + (size_t)ch * 4096 + (rb * 16 + r) * 64 + ks * 32 + q * 8);
        f.kh[ks] = *(const bf16x8*)(KHT + (size_t)ch * 8192 + (w * 16 + r) * 64 + ks * 32 + q * 8);
#pragma unroll
        for (int vb = 0; vb < 4; ++vb) f.vt[vb][ks] = *(const bf16x8*)(VT + (size_t)ch * 16384 + (sl * 64 + vb * 16 + r) * 64 + ks * 32 + q * 8); }
    f.gc = *(const f32x4*)(GC + (size_t)ch * 128 + w * 16 + q * 4);
}
__device__ __forceinline__ void ph_gla_seq(const Ctx& c, int boff, const bf16_t* __restrict__ QD, const bf16_t* __restrict__ KHT, const bf16_t* __restrict__ EE, const bf16_t* __restrict__ VT, const float* __restrict__ GC,
                                           const float* __restrict__ s0, float* __restrict__ outP, float* __restrict__ outS, bf16_t* __restrict__ OB) {
    LAS bf16_t* T_l = (LAS bf16_t*)c.lds;
    const int lane = c.lane, r = lane & 15, q = lane >> 4, w = c.wave;
    for (int u = (c.bid - boff + c.G) % c.G; u < 32 + 512; u += c.G) {
        int h, sl, nch, ch0, row0, ntok; const float* sp = nullptr; float* op;
        if (u < 32) { const int b = u >> 4; h = (u >> 2) & 3; sl = u & 3; nch = 64; ch0 = (b * 4 + h) * 64; row0 = b * PS; ntok = 64; op = outP + (size_t)(b * 4 + h) * 32768; }
        else { const int s = u - 32, sq = s >> 4; h = (s >> 2) & 3; sl = s & 3; nch = 1; ch0 = 512 + sq * 4 + h; row0 = MP + sq * SS; ntok = SS; sp = s0 + (size_t)(sq * 4 + h) * 32768; op = outS + (size_t)(sq * 4 + h) * 32768; }
        f32x4 acc[4];
#pragma unroll
        for (int vb = 0; vb < 4; ++vb)
#pragma unroll
            for (int jj = 0; jj < 4; ++jj) acc[vb][jj] = sp ? sp[(size_t)(w * 16 + q * 4 + jj) * 256 + sl * 64 + vb * 16 + r] : 0.f;
        GlaFrag cur; gla_load_frag(cur, QD, KHT, EE, VT, GC, ch0, sl, w, r, q);
        for (int ci = 0; ci < nch; ++ci) {
            GlaFrag nxt; if (ci + 1 < nch) gla_load_frag(nxt, QD, KHT, EE, VT, GC, ch0 + ci + 1, sl, w, r, q); else nxt = cur;
            LAS bf16_t* Tb = T_l + (ci & 1) * 64 * 136;
#pragma unroll
            for (int vb = 0; vb < 4; ++vb) { u32x2 o; o.x = pk2(acc[vb][0], acc[vb][1]); o.y = pk2(acc[vb][2], acc[vb][3]); *(LAS u32x2*)(Tb + (vb * 16 + r) * 136 + w * 16 + q * 4) = o; }
            __syncthreads();
            { const int rb = w >> 1, t = rb * 16 + r;
#pragma unroll
              for (int e = 0; e < 2; ++e) { const int cb = (w & 1) * 2 + e; f32x4 y = (f32x4){0.f, 0.f, 0.f, 0.f};
#pragma unroll
                  for (int ks = 0; ks < 4; ++ks) y = mma16(*(const LAS bf16x8*)(Tb + (cb * 16 + r) * 136 + ks * 32 + q * 8), cur.qd[ks], y);
#pragma unroll
                  for (int ks = 0; ks < 2; ++ks) y = mma16(e == 0 ? ((w & 1) ? cur.vt[2][ks] : cur.vt[0][ks]) : ((w & 1) ? cur.vt[3][ks] : cur.vt[1][ks]), cur.e[ks], y);
                  if (t < ntok) { u32x2 o; o.x = pk2(y[0], y[1]); o.y = pk2(y[2], y[3]); *(u32x2*)(OB + (size_t)(row0 + ci * 64 + t) * BW + h * 256 + sl * 64 + cb * 16 + q * 4) = o; } } }
#pragma unroll
            for (int vb = 0; vb < 4; ++vb) { acc[vb] = acc[vb] * cur.gc;
#pragma unroll
                for (int ks = 0; ks < 2; ++ks) acc[vb] = mma16(cur.kh[ks], cur.vt[vb][ks], acc[vb]); }
            cur = nxt;
        }
#pragma unroll
        for (int vb = 0; vb < 4; ++vb)
#pragma unroll
            for (int jj = 0; jj < 4; ++jj) op[(size_t)(w * 16 + q * 4 + jj) * 256 + sl * 64 + vb * 16 + r] = acc[vb][jj];
        __syncthreads();
    }
}
__device__ __forceinline__ void ph_gla_fin(const Ctx& c, const bf16_t* __restrict__ U, const float* __restrict__ ng, const float* __restrict__ nb, bf16_t* __restrict__ OB) {
    const int lane = c.lane;
    for (int i = c.bid * 8 + c.wave; i < MT * 4; i += c.G * 8) {
        const int row = i >> 2, h = i & 3, cc = h * 256 + lane * 4; bf16_t* p = OB + (size_t)row * BW + cc;
        const u32x2 raw = *(const u32x2*)p; float x[4] = {__uint_as_float(raw.x << 16), __uint_as_float(raw.x & 0xffff0000u), __uint_as_float(raw.y << 16), __uint_as_float(raw.y & 0xffff0000u)};
        const float mean = wave_sum((x[0] + x[1]) + (x[2] + x[3])) * (1.0f / 256.0f); float qq = 0.f;
#pragma unroll
        for (int j = 0; j < 4; ++j) { const float d = x[j] - mean; qq += d * d; }
        const float rstd = rsqrtf(wave_sum(qq) * (1.0f / 256.0f) + 1e-5f);
        const u32x2 gp = *(const u32x2*)(U + (size_t)row * NINP + U_GR + cc); const float gr[4] = {__uint_as_float(gp.x << 16), __uint_as_float(gp.x & 0xffff0000u), __uint_as_float(gp.y << 16), __uint_as_float(gp.y & 0xffff0000u)};
        const f32x4 gg = *(const f32x4*)(ng + cc), bb = *(const f32x4*)(nb + cc); float o[4];
#pragma unroll
        for (int j = 0; j < 4; ++j) o[j] = ((x[j] - mean) * rstd * gg[j] + bb[j]) * gr[j] * sigmoidf_(gr[j]);
        u32x2 ov; ov.x = pk2(o[0], o[1]); ov.y = pk2(o[2], o[3]); *(u32x2*)p = ov;
    }
}

__device__ __forceinline__ void unpack8(const u32x4 w, float (&x)[8]) {
    x[0] = __uint_as_float(w.x << 16); x[1] = __uint_as_float(w.x & 0xffff0000u); x[2] = __uint_as_float(w.y << 16); x[3] = __uint_as_float(w.y & 0xffff0000u);
    x[4] = __uint_as_float(w.z << 16); x[5] = __uint_as_float(w.z & 0xffff0000u); x[6] = __uint_as_float(w.w << 16); x[7] = __uint_as_float(w.w & 0xffff0000u);
}
template <bool ISBF> __device__ __forceinline__ void swa_step(const float (&q)[32], float (&acc)[32], float& m, float& l, const void* kp, const void* vp, float slope, float dist) {
    float s = 0.f;
#pragma unroll
    for (int j = 0; j < 4; ++j) { float x[8];
        if (ISBF) unpack8(*(const u32x4*)((const bf16_t*)kp + j * 8), x);
        else { const f32x4 a = *(const f32x4*)((const float*)kp + j * 8), b = *(const f32x4*)((const float*)kp + j * 8 + 4); x[0] = a[0]; x[1] = a[1]; x[2] = a[2]; x[3] = a[3]; x[4] = b[0]; x[5] = b[1]; x[6] = b[2]; x[7] = b[3]; }
#pragma unroll
        for (int d = 0; d < 8; ++d) s += q[j * 8 + d] * x[d]; }
    s += __shfl_xor(s, 1, 64);
    s = s * 0.125f - slope * dist;
    const float mn = fmaxf(m, s), cc = __expf(m - mn), p = __expf(s - mn);
    l = l * cc + p;
#pragma unroll
    for (int j = 0; j < 4; ++j) { float x[8];
        if (ISBF) unpack8(*(const u32x4*)((const bf16_t*)vp + j * 8), x);
        else { const f32x4 a = *(const f32x4*)((const float*)vp + j * 8), b = *(const f32x4*)((const float*)vp + j * 8 + 4); x[0] = a[0]; x[1] = a[1]; x[2] = a[2]; x[3] = a[3]; x[4] = b[0]; x[5] = b[1]; x[6] = b[2]; x[7] = b[3]; }
#pragma unroll
        for (int d = 0; d < 8; ++d) acc[j * 8 + d] = acc[j * 8 + d] * cc + p * x[d]; }
    m = mn;
}
__device__ __forceinline__ void ph_swa_naive(const Ctx& c, const bf16_t* __restrict__ U, const float* __restrict__ ck, const float* __restrict__ cv, const float* __restrict__ sinks, bf16_t* __restrict__ OB) {
    for (int gid = c.bid * 512 + c.tid; gid < MT * 32; gid += c.G * 512) {
        const int dh = gid & 1, h = (gid >> 1) & 15, row = gid >> 5, kvh = h >> 3, co = kvh * 64 + dh * 32;
        float q[32], acc[32];
#pragma unroll
        for (int j = 0; j < 4; ++j) { float x[8]; unpack8(*(const u32x4*)(U + (size_t)row * NINP + U_SQ + h * 64 + dh * 32 + j * 8), x);
#pragma unroll
            for (int d = 0; d < 8; ++d) { q[j * 8 + d] = x[d]; acc[j * 8 + d] = 0.f; } }
        const float slope = exp2f(-0.5f * (float)(h + 1)); float m = sinks[h], l = 1.0f;
        if (row < MP) {
            const int t = row % PS, base = row - t, lo = t - 128 < 0 ? 0 : t - 128;
            for (int s = lo; s <= t; ++s) { const bf16_t* ur = U + (size_t)(base + s) * NINP;
                swa_step<true>(q, acc, m, l, ur + U_SK + co, ur + U_SV + co, slope, (float)(t - s)); }
        } else {
            const int sq = (row - MP) / SS, i = (row - MP) % SS;
            for (int idx = i; idx <= 128 + i; ++idx) {
                if (idx < 128) { const size_t o = ((size_t)sq * 128 + idx) * 128 + co; swa_step<false>(q, acc, m, l, ck + o, cv + o, slope, (float)(128 + i - idx)); }
                else { const bf16_t* ur = U + (size_t)(MP + sq * SS + idx - 128) * NINP; swa_step<true>(q, acc, m, l, ur + U_SK + co, ur + U_SV + co, slope, (float)(128 + i - idx)); }
            }
        }
        const float inv = 1.0f / l; bf16_t* op = OB + (size_t)row * BW + h * 64 + dh * 32;
#pragma unroll
        for (int j = 0; j < 4; ++j) { u32x4 w; w.x = pk2(acc[j * 8] * inv, acc[j * 8 + 1] * inv); w.y = pk2(acc[j * 8 + 2] * inv, acc[j * 8 + 3] * inv);
            w.z = pk2(acc[j * 8 + 4] * inv, acc[j * 8 + 5] * inv); w.w = pk2(acc[j * 8 + 6] * inv, acc[j * 8 + 7] * inv); *(u32x4*)(op + j * 8) = w; }
    }
}

__device__ __forceinline__ void ph_rwkv_prep(const Ctx& c, const bf16_t* __restrict__ U, const float* __restrict__ shift, const float* __restrict__ mu, const float* __restrict__ w0, const float* __restrict__ w2,
                                             const float* __restrict__ a0, const float* __restrict__ a2, const float* __restrict__ g2, const float* __restrict__ k_k, const float* __restrict__ k_a,
                                             const float* __restrict__ r_k, float* __restrict__ RW) {
    LAS float* xm = (LAS float*)c.lds; LAS float* tw = xm + RWC; LAS float* ad = tw + 64; LAS float* sg = ad + 64;
    const int tid = c.tid;
    float* R = RW; float* WD = RW + (size_t)MPAD * BW; float* K2 = WD + (size_t)MPAD * BW; float* V = K2 + (size_t)MPAD * BW; float* KK = V + (size_t)MPAD * BW;
    float* BV = KK + (size_t)MPAD * BW; float* G = BV + (size_t)MPAD * BW; float* BON = G + (size_t)MPAD * BW;
    for (int row = c.bid; row < MT; row += c.G) {
        const bf16_t* ur = U + (size_t)row * NINP + U_RU; const bf16_t* pr = ur - NINP; const float* ps = nullptr; bool first;
        if (row < MP) first = (row % PS) == 0; else { first = ((row - MP) % SS) == 0; ps = shift + (size_t)((row - MP) / SS) * RWC; }
        for (int cc = tid; cc < RWC; cc += 512) { const float x = bf2f(ur[cc]); const float s = first ? (ps ? ps[cc] : 0.f) : bf2f(pr[cc]); xm[cc] = x + (s - x) * mu[cc]; }
        __syncthreads();
        if (tid < 64) { tw[tid] = tanhf(xm[3072 + tid]); ad[tid] = xm[3136 + tid]; }
        if (tid >= 128 && tid < 256) sg[tid - 128] = sigmoidf_(xm[3200 + tid - 128]);
        __syncthreads();
        for (int qd = 0; qd < 2; ++qd) {
            const int cc = qd * 512 + tid; float accw = w0[cc], acca = a0[cc], accg = 0.f;
#pragma unroll 4
            for (int j = 0; j < 64; ++j) { accw += tw[j] * w2[j * BW + cc]; acca += ad[j] * a2[j * BW + cc]; }
#pragma unroll 4
            for (int j = 0; j < 128; ++j) accg += sg[j] * g2[j * BW + cc];
            const float lw = -softplusf_(-accw) - 0.5f, decay = __expf(-__expf(lw)), a = sigmoidf_(acca);
            const float r = xm[cc], k = xm[1024 + cc], v = xm[2048 + cc];
            const float kkr = k * k_k[cc]; const float ss = wave_sum(kkr * kkr); const float kk = kkr / fmaxf(sqrtf(ss), 1e-12f);
            const float k2 = k * (1.0f + (a - 1.0f) * k_a[cc]); const float rk = wave_sum(r * k2 * r_k[cc]);
            const size_t o = (size_t)row * BW + cc;
            R[o] = r; WD[o] = decay; K2[o] = k2; V[o] = v; KK[o] = kk; BV[o] = kk * a; G[o] = accg; BON[o] = rk * v;
        }
        __syncthreads();
    }
}
constexpr int RWP_UNITS = (MP / 64) * 16 + SB * 16;
__device__ __forceinline__ void rwp_unit_info(int u, int& row0, int& ntok, int& h, int& sq, bool& seq_first) {
    if (u < (MP / 64) * 16) { const int blk = u >> 4; h = u & 15; row0 = blk * 64; ntok = 64; sq = -1; seq_first = (row0 % PS) == 0; }
    else { const int s = u - (MP / 64) * 16; sq = s >> 4; h = s & 15; row0 = MP + sq * SS; ntok = SS; seq_first = true; }
}
__device__ __forceinline__ void ph_rwkv_pre(const Ctx& c, const bf16_t* __restrict__ U, const float* __restrict__ shift, const float* __restrict__ mu, const float* __restrict__ w0, const float* __restrict__ w2,
                                            const float* __restrict__ a0, const float* __restrict__ a2, const float* __restrict__ g2, const float* __restrict__ k_k, const float* __restrict__ k_a,
                                            const float* __restrict__ r_k, float* __restrict__ RW, bf16_t* __restrict__ RB) {
    LAS bf16_t* P_l = (LAS bf16_t*)c.lds; LAS bf16_t* Kn_l = P_l + 4608; LAS bf16_t* Bn_l = Kn_l + 4608; LAS bf16_t* Q_l = Bn_l + 4608;
    LAS bf16_t* PT_l = Q_l + 4608; LAS bf16_t* BhT_l = PT_l + 4608; LAS bf16_t* KhT_l = BhT_l + 4608; LAS bf16_t* VT_l = KhT_l + 4608;
    LAS float* A_l = (LAS float*)(c.lds + 73728);
    LAS bf16_t* BmT_l = (LAS bf16_t*)(c.lds + 78848); LAS bf16_t* F_l = (LAS bf16_t*)(c.lds + 81920); LAS bf16_t* Tinv_l = (LAS bf16_t*)(c.lds + 84992);
    LAS bf16_t* PpT_l = (LAS bf16_t*)(c.lds + 88064);
    LAS bf16_t* BmpT_l = (LAS bf16_t*)(c.lds + 97280);
    LAS float* GC_l = (LAS float*)(c.lds + 100352);
    LAS float* lg_l = (LAS float*)(c.lds + 125952);
    LAS bf16_t* act_l = (LAS bf16_t*)c.lds;
    LAS bf16_t* wT_l = act_l + 64 * 264;
    LAS bf16_t* aT_l = wT_l + 64 * 72;
    LAS bf16_t* gT_l = aT_l + 64 * 72;
    LAS float* pre_l = (LAS float*)(c.lds + 73728);
    const int tid = c.tid, lane = c.lane, r = lane & 15, q = lane >> 4, w = c.wave;
    float* Gg = RW + 6 * (size_t)MPAD * BW; float* BON = RW + 7 * (size_t)MPAD * BW;
    for (int u = c.bid; u < RWP_UNITS; u += c.G) {
        int row0, ntok, h, sq; bool seq_first; rwp_unit_info(u, row0, ntok, h, sq, seq_first);
        const float* sh = sq >= 0 ? shift + (size_t)sq * RWC : nullptr;
        for (int idx = tid; idx < 64 * 256; idx += 512) {
            const int t = idx >> 8, col = idx & 255; float val = 0.f;
            if (t < ntok) { const int cc = 3072 + col; const bf16_t* ur = U + (size_t)(row0 + t) * NINP + U_RU; const float x = bf2f(ur[cc]);
                const float p = (t == 0 && seq_first) ? (sh ? sh[cc] : 0.f) : bf2f(ur[cc - NINP]);
                const float xm = x + (p - x) * mu[cc];
                val = col < 64 ? tanhf(xm) : (col < 128 ? xm : sigmoidf_(xm)); }
            act_l[t * 264 + col] = f2bf(val);
        }
        for (int idx = tid; idx < 64 * 64; idx += 512) { const int j = idx >> 6, cc = idx & 63; wT_l[cc * 72 + j] = f2bf(w2[(size_t)j * BW + h * 64 + cc]); aT_l[cc * 72 + j] = f2bf(a2[(size_t)j * BW + h * 64 + cc]); }
        for (int idx = tid; idx < 128 * 64; idx += 512) { const int j = idx >> 6, cc = idx & 63; gT_l[cc * 136 + j] = f2bf(g2[(size_t)j * BW + h * 64 + cc]); }
        __syncthreads();
        { const int tb = w & 3, chf = w >> 2; bf16x8 af[8];
#pragma unroll
          for (int ks = 0; ks < 8; ++ks) af[ks] = *(const LAS bf16x8*)(act_l + (tb * 16 + r) * 264 + ks * 32 + q * 8);
#pragma unroll
          for (int e = 0; e < 2; ++e) { const int cb = chf * 2 + e; f32x4 dw = (f32x4){0.f, 0.f, 0.f, 0.f}, da = dw, dg = dw;
#pragma unroll
              for (int ks = 0; ks < 2; ++ks) { dw = mma16(*(const LAS bf16x8*)(wT_l + (cb * 16 + r) * 72 + ks * 32 + q * 8), af[ks], dw);
                  da = mma16(*(const LAS bf16x8*)(aT_l + (cb * 16 + r) * 72 + ks * 32 + q * 8), af[2 + ks], da); }
#pragma unroll
              for (int ks = 0; ks < 4; ++ks) dg = mma16(*(const LAS bf16x8*)(gT_l + (cb * 16 + r) * 136 + ks * 32 + q * 8), af[4 + ks], dg);
              const int o = (tb * 16 + r) * 68 + cb * 16 + q * 4;
              *(LAS f32x4*)(pre_l + o) = dw; *(LAS f32x4*)(pre_l + 64 * 68 + o) = da; *(LAS f32x4*)(pre_l + 2 * 64 * 68 + o) = dg; } }
        __syncthreads();
        const int t = tid >> 3, cg = tid & 7, c0 = h * 64 + cg * 8, sc = t >> 4;
        float rr[8], k2[8], kap[8], bet[8], nlw[8];
        { float vx[8], gg[8], kkr[8]; float ss = 0.f, rk = 0.f;
          if (t < ntok) {
            const size_t row = (size_t)(row0 + t); const bf16_t* ur = U + row * NINP + U_RU; const bool fst = (t == 0 && seq_first);
            float kx[8];
#pragma unroll
            for (int part = 0; part < 3; ++part) { const int cc = part * 1024 + c0; float x[8], p[8];
                unpack8(*(const u32x4*)(ur + cc), x);
                if (!fst) unpack8(*(const u32x4*)(ur + cc - NINP), p);
                else {
#pragma unroll
                    for (int j = 0; j < 8; ++j) p[j] = sh ? sh[cc + j] : 0.f; }
#pragma unroll
                for (int j = 0; j < 8; ++j) { const float xm = x[j] + (p[j] - x[j]) * mu[cc + j]; if (part == 0) rr[j] = xm; else if (part == 1) kx[j] = xm; else vx[j] = xm; } }
#pragma unroll
            for (int j = 0; j < 8; ++j) { const int cc = c0 + j; const int o = t * 68 + cg * 8 + j;
                const float lw = -softplusf_(-(w0[cc] + pre_l[o])) - 0.5f; nlw[j] = -__expf(lw); const float av = sigmoidf_(a0[cc] + pre_l[64 * 68 + o]); gg[j] = pre_l[2 * 64 * 68 + o];
                kkr[j] = kx[j] * k_k[cc]; ss += kkr[j] * kkr[j]; k2[j] = kx[j] * (1.0f + (av - 1.0f) * k_a[cc]); rk += rr[j] * k2[j] * r_k[cc]; bet[j] = av; }
          } else {
#pragma unroll
            for (int j = 0; j < 8; ++j) { rr[j] = 0.f; k2[j] = 0.f; kkr[j] = 0.f; bet[j] = 0.f; nlw[j] = 0.f; vx[j] = 0.f; gg[j] = 0.f; }
          }
          ss += __shfl_xor(ss, 1, 64); ss += __shfl_xor(ss, 2, 64); ss += __shfl_xor(ss, 4, 64);
          rk += __shfl_xor(rk, 1, 64); rk += __shfl_xor(rk, 2, 64); rk += __shfl_xor(rk, 4, 64);
          const float inv = 1.0f / fmaxf(sqrtf(ss), 1e-12f);
#pragma unroll
          for (int j = 0; j < 8; ++j) { kap[j] = kkr[j] * inv; bet[j] = kap[j] * bet[j]; }
          if (t < ntok) { const size_t o = (size_t)(row0 + t) * BW + c0;
              *(f32x4*)(Gg + o) = (f32x4){gg[0], gg[1], gg[2], gg[3]}; *(f32x4*)(Gg + o + 4) = (f32x4){gg[4], gg[5], gg[6], gg[7]};
              *(f32x4*)(BON + o) = (f32x4){rk * vx[0], rk * vx[1], rk * vx[2], rk * vx[3]}; *(f32x4*)(BON + o + 4) = (f32x4){rk * vx[4], rk * vx[5], rk * vx[6], rk * vx[7]}; }
          *(LAS f32x4*)(lg_l + t * 68 + cg * 8) = (f32x4){nlw[0], nlw[1], nlw[2], nlw[3]}; *(LAS f32x4*)(lg_l + t * 68 + cg * 8 + 4) = (f32x4){nlw[4], nlw[5], nlw[6], nlw[7]};
#pragma unroll
          for (int j = 0; j < 8; ++j) VT_l[(cg * 8 + j) * 72 + t] = f2bf(vx[j]);
        }
        __syncthreads();
        if (tid < 256) { const int cc = tid & 63, s4 = tid >> 6; float run = 0.f;
#pragma unroll
            for (int i = 0; i < 16; ++i) { const int o = (s4 * 16 + i) * 68 + cc; run += lg_l[o]; lg_l[o] = run; } }
        __syncthreads();
        { unsigned pp[4], pq[4], pk[4], pb[4];
#pragma unroll
          for (int j = 0; j < 8; j += 2) { float vP[2], vQ[2], vK[2], vB[2];
#pragma unroll
              for (int e = 0; e < 2; ++e) { const int jj = j + e, cc = cg * 8 + jj; const float ci = lg_l[t * 68 + cc], cC = lg_l[(sc * 16 + 15) * 68 + cc];
                  const float ei = __expf(-ci), eh = __expf(cC - ci);
                  vP[e] = kap[jj] * __expf(ci - nlw[jj]); vQ[e] = rr[jj] * __expf(ci); vK[e] = k2[jj] * ei; vB[e] = bet[jj] * ei;
                  PT_l[cc * 72 + t] = f2bf(vP[e]); BhT_l[cc * 72 + t] = f2bf(bet[jj] * eh); KhT_l[cc * 72 + t] = f2bf(k2[jj] * eh); }
              pp[j >> 1] = pk2(vP[0], vP[1]); pq[j >> 1] = pk2(vQ[0], vQ[1]); pk[j >> 1] = pk2(vK[0], vK[1]); pb[j >> 1] = pk2(vB[0], vB[1]); }
          const int o = t * 72 + cg * 8;
          *(LAS u32x4*)(P_l + o) = (u32x4){pp[0], pp[1], pp[2], pp[3]}; *(LAS u32x4*)(Q_l + o) = (u32x4){pq[0], pq[1], pq[2], pq[3]};
          *(LAS u32x4*)(Kn_l + o) = (u32x4){pk[0], pk[1], pk[2], pk[3]}; *(LAS u32x4*)(Bn_l + o) = (u32x4){pb[0], pb[1], pb[2], pb[3]};
          if ((t & 15) == 15) {
#pragma unroll
              for (int j = 0; j < 8; ++j) GC_l[sc * 64 + cg * 8 + j] = __expf(lg_l[t * 68 + cg * 8 + j]); } }
        __syncthreads();
        const int nsub = ntok == 64 ? 4 : 1;
        const bf16x8 zfrag = (bf16x8){0, 0, 0, 0, 0, 0, 0, 0};
        for (int id = w; id < nsub * 3; id += 8) { const int s4 = id / 3, prod = id - s4 * 3; f32x4 d = (f32x4){0.f, 0.f, 0.f, 0.f};
            const LAS bf16_t* X = (prod == 1 ? P_l : Bn_l) + (s4 * 16 + r) * 72 + q * 8; const LAS bf16_t* Y = (prod == 0 ? P_l : (prod == 1 ? Kn_l : Q_l)) + (s4 * 16 + r) * 72 + q * 8;
#pragma unroll
            for (int ks = 0; ks < 2; ++ks) d = mma16(*(const LAS bf16x8*)(X + ks * 32), *(const LAS bf16x8*)(Y + ks * 32), d);
            if (prod == 0) { f32x4 o4;
#pragma unroll
                for (int jj = 0; jj < 4; ++jj) o4[jj] = (q * 4 + jj < r) ? d[jj] : 0.f;
                *(LAS f32x4*)(A_l + s4 * 320 + r * 20 + q * 4) = o4; }
            else { float o4[4];
#pragma unroll
                for (int jj = 0; jj < 4; ++jj) o4[jj] = (prod == 1 ? (r < q * 4 + jj) : (q * 4 + jj <= r)) ? d[jj] : 0.f;
                u32x2 o; o.x = pk2(o4[0], o4[1]); o.y = pk2(o4[2], o4[3]); *(LAS u32x2*)((prod == 1 ? BmT_l : F_l) + s4 * 384 + r * 24 + q * 4) = o; } }
        __syncthreads();
        if (w == 0 && (lane >> 4) < nsub) { const int s4 = lane >> 4, jc = lane & 15; float x[16];
#pragma unroll
            for (int tt = 0; tt < 16; ++tt) { float s = (tt == jc) ? 1.f : 0.f;
#pragma unroll
                for (int i = 0; i < tt; ++i) s -= A_l[s4 * 320 + tt * 20 + i] * x[i];
                x[tt] = s; }
#pragma unroll
            for (int tt = 0; tt < 16; ++tt) Tinv_l[s4 * 384 + tt * 24 + jc] = f2bf(x[tt]); }
        __syncthreads();
        for (int id = w; id < nsub * 5; id += 8) { const int s4 = id / 5, rem = id - s4 * 5;
            const bf16x8 xf = q < 2 ? *(const LAS bf16x8*)(Tinv_l + s4 * 384 + r * 24 + q * 8) : zfrag;
            const bf16x8 yf = q < 2 ? (rem < 4 ? *(const LAS bf16x8*)(PT_l + (rem * 16 + r) * 72 + s4 * 16 + q * 8) : *(const LAS bf16x8*)(BmT_l + s4 * 384 + r * 24 + q * 8)) : zfrag;
            const f32x4 d = mma16(xf, yf, (f32x4){0.f, 0.f, 0.f, 0.f});
            u32x2 o; o.x = pk2(d[0], d[1]); o.y = pk2(d[2], d[3]);
            if (rem < 4) *(LAS u32x2*)(PpT_l + (rem * 16 + r) * 72 + s4 * 16 + q * 4) = o; else *(LAS u32x2*)(BmpT_l + s4 * 384 + r * 24 + q * 4) = o; }
        __syncthreads();
        { const int chunk0 = sq >= 0 ? PB * 16 * 256 + sq * 16 + h : ((row0 / PS) * 16 + h) * 256 + ((row0 % PS) >> 4);
          for (int id = w; id < nsub * 25; id += 8) { const int s4 = id / 25, rem = id - s4 * 25; bf16_t* blob = RB + (size_t)(chunk0 + s4) * RB_EL;
            const bf16x8 fF = q < 2 ? *(const LAS bf16x8*)(F_l + s4 * 384 + r * 24 + q * 8) : zfrag;
            if (rem < 4) {
                const bf16x8 xf = q < 2 ? *(const LAS bf16x8*)(PpT_l + (rem * 16 + r) * 72 + s4 * 16 + q * 8) : zfrag;
                const f32x4 d = mma16(xf, fF, (f32x4){0.f, 0.f, 0.f, 0.f});
                const u32x2 qv = *(const LAS u32x2*)(Q_l + (s4 * 16 + r) * 72 + rem * 16 + q * 4);
                u32x2 o; o.x = pk2(__uint_as_float(qv.x << 16) - d[0], __uint_as_float(qv.x & 0xffff0000u) - d[1]); o.y = pk2(__uint_as_float(qv.y << 16) - d[2], __uint_as_float(qv.y & 0xffff0000u) - d[3]);
                *(u32x2*)(blob + RB_QP + r * 72 + 32 * (rem >> 1) + 8 * q + 4 * (rem & 1)) = o;
            } else if (rem == 4) {
                f32x4 d2 = (f32x4){0.f, 0.f, 0.f, 0.f};
#pragma unroll
                for (int ks = 0; ks < 2; ++ks) d2 = mma16(*(const LAS bf16x8*)(Kn_l + (s4 * 16 + r) * 72 + ks * 32 + q * 8), *(const LAS bf16x8*)(Q_l + (s4 * 16 + r) * 72 + ks * 32 + q * 8), d2);
                const bf16x8 xf = q < 2 ? *(const LAS bf16x8*)(BmpT_l + s4 * 384 + r * 24 + q * 8) : zfrag;
                const f32x4 d1 = mma16(xf, fF, (f32x4){0.f, 0.f, 0.f, 0.f});
                float o4[4];
#pragma unroll
                for (int jj = 0; jj < 4; ++jj) o4[jj] = ((q * 4 + jj <= r) ? d2[jj] : 0.f) - d1[jj];
                u32x2 o; o.x = pk2(o4[0], o4[1]); o.y = pk2(o4[2], o4[3]); *(u32x2*)(blob + RB_EP + r * 24 + q * 4) = o;
            } else if (rem < 21) {
                const int cib = (rem - 5) >> 2, cob = (rem - 5) & 3;
                const bf16x8 xf = q < 2 ? *(const LAS bf16x8*)(PpT_l + (cib * 16 + r) * 72 + s4 * 16 + q * 8) : zfrag;
                const bf16x8 yf = q < 2 ? *(const LAS bf16x8*)(BhT_l + (cob * 16 + r) * 72 + s4 * 16 + q * 8) : zfrag;
                const f32x4 d = mma16(xf, yf, (f32x4){0.f, 0.f, 0.f, 0.f});
                const float gc = GC_l[s4 * 64 + cob * 16 + r]; float o4[4];
#pragma unroll
                for (int jj = 0; jj < 4; ++jj) o4[jj] = ((cib == cob && q * 4 + jj == r) ? gc : 0.f) - d[jj];
                u32x2 o; o.x = pk2(o4[0], o4[1]); o.y = pk2(o4[2], o4[3]); *(u32x2*)(blob + (cob * 16 + r) * 72 + 32 * (cib >> 1) + 8 * q + 4 * (cib & 1)) = o;
            } else {
                const int cb = rem - 21;
                const bf16x8 xf = q < 2 ? *(const LAS bf16x8*)(BmpT_l + s4 * 384 + r * 24 + q * 8) : zfrag;
                const bf16x8 yf = q < 2 ? *(const LAS bf16x8*)(BhT_l + (cb * 16 + r) * 72 + s4 * 16 + q * 8) : zfrag;
                const f32x4 d = mma16(xf, yf, (f32x4){0.f, 0.f, 0.f, 0.f});
                const u32x2 kv = *(const LAS u32x2*)(KhT_l + (cb * 16 + r) * 72 + s4 * 16 + q * 4);
                u32x2 o; o.x = pk2(__uint_as_float(kv.x << 16) - d[0], __uint_as_float(kv.x & 0xffff0000u) - d[1]); o.y = pk2(__uint_as_float(kv.y << 16) - d[2], __uint_as_float(kv.y & 0xffff0000u) - d[3]);
                *(u32x2*)(blob + RB_KHP + (cb * 16 + r) * 24 + q * 4) = o;
            } }
          for (int idx = tid; idx < nsub * 128; idx += 512) { const int s4 = idx >> 7, cc = (idx >> 1) & 63, hf = idx & 1;
              *(u32x4*)(RB + (size_t)(chunk0 + s4) * RB_EL + RB_VT + cc * 24 + hf * 8) = *(const LAS u32x4*)(VT_l + cc * 72 + s4 * 16 + hf * 8); } }
        __syncthreads();
    }
}

__device__ __forceinline__ void ph_rwkv_scan_naive(const Ctx& c, const float* __restrict__ RW, const float* __restrict__ s0, const float* __restrict__ lng, const float* __restrict__ lnb, bf16_t* __restrict__ OB,
                                                   float* __restrict__ outP, float* __restrict__ outS) {
    const float* R = RW; const float* WD = RW + (size_t)MPAD * BW; const float* K2 = WD + (size_t)MPAD * BW; const float* V = K2 + (size_t)MPAD * BW; const float* KK = V + (size_t)MPAD * BW;
    const float* BV = KK + (size_t)MPAD * BW; const float* G = BV + (size_t)MPAD * BW; const float* BON = G + (size_t)MPAD * BW;
    const int lane = c.lane;
    for (int it = 0;; ++it) {
        const int u = (it * 8 + c.wave) * c.G + c.bid;
        if (u >= (PB + SB) * 16) break;
        const int sq = u >> 4, h = u & 15;
        int row0, L; seq_info(sq, row0, L);
        float S[64];
        if (sq >= PB) { const float* p = s0 + (((size_t)(sq - PB) * 16 + h) * 64 + lane) * 64;
#pragma unroll
            for (int j = 0; j < 64; ++j) S[j] = p[j]; }
        else {
#pragma unroll
            for (int j = 0; j < 64; ++j) S[j] = 0.f; }
        const float lg = lng[h * 64 + lane], lb = lnb[h * 64 + lane];
        for (int t = 0; t < L; ++t) {
            const size_t base = (size_t)(row0 + t) * BW + h * 64; const float v = V[base + lane];
            float d = 0.f;
#pragma unroll
            for (int j = 0; j < 64; ++j) d += S[j] * KK[base + j];
            float y = 0.f;
#pragma unroll
            for (int j = 0; j < 64; ++j) { S[j] = S[j] * WD[base + j] - d * BV[base + j] + v * K2[base + j]; y += S[j] * R[base + j]; }
            const float mean = wave_sum(y) * (1.0f / 64.0f), dy = y - mean, var = wave_sum(dy * dy) * (1.0f / 64.0f);
            const float yn = dy * rsqrtf(var + 64e-5f) * lg + lb;
            OB[base + lane] = f2bf((yn + BON[base + lane]) * G[base + lane]);
        }
        float* op = (sq < PB ? outP + (((size_t)sq * 16 + h) * 64 + lane) * 64 : outS + (((size_t)(sq - PB) * 16 + h) * 64 + lane) * 64);
#pragma unroll
        for (int j = 0; j < 64; ++j) op[j] = S[j];
    }
}
__device__ __forceinline__ void ph_rwkv_scan2(const Ctx& c, int boff, const float* __restrict__ RW, const float* __restrict__ s0, const float* __restrict__ lng, const float* __restrict__ lnb, bf16_t* __restrict__ OB,
                                              float* __restrict__ outP, float* __restrict__ outS) {
    LAS float* opb = (LAS float*)c.lds;
    LAS float* yb = opb + 2 * 16 * 384;
    const int tid = c.tid, lane = c.lane, w = c.wave, rl = lane >> 3, cg = lane & 7, vrow = w * 8 + rl;
    const float* G = RW + 6 * (size_t)MPAD * BW; const float* BON = RW + 7 * (size_t)MPAD * BW;
    for (int u = (c.bid - boff + c.G) % c.G; u < (PB + SB) * 16; u += c.G) {
        const int sq = u >> 4, h = u & 15;
        int row0, L; seq_info(sq, row0, L);
        float S[8];
        if (sq >= PB) { const float* p = s0 + (((size_t)(sq - PB) * 16 + h) * 64 + vrow) * 64 + cg * 8;
#pragma unroll
            for (int j = 0; j < 8; ++j) S[j] = p[j]; }
        else {
#pragma unroll
            for (int j = 0; j < 8; ++j) S[j] = 0.f; }
        const float lg = lng[h * 64 + lane], lb = lnb[h * 64 + lane];
        const int nb = (L + 15) >> 4;
#define RW_STAGE(bi_) do { const int t0_ = (bi_) * 16, nT_ = (L - t0_) < 16 ? (L - t0_) : 16; LAS float* dst_ = opb + ((bi_) & 1) * 16 * 384; \
        for (int idx = tid; idx < nT_ * 96; idx += 512) { const int t = idx / 96, rem = idx - t * 96, slot = rem >> 4, c4 = rem & 15; \
            const int arr = slot == 0 ? 1 : slot == 1 ? 4 : slot == 2 ? 5 : slot == 3 ? 2 : slot == 4 ? 0 : 3; \
            *(LAS f32x4*)(dst_ + t * 384 + slot * 64 + c4 * 4) = *(const f32x4*)(RW + (size_t)arr * MPAD * BW + (size_t)(row0 + t0_ + t) * BW + h * 64 + c4 * 4); } } while (0)
        RW_STAGE(0);
        for (int bi = 0; bi < nb; ++bi) {
            __syncthreads();
            if (bi + 1 < nb) RW_STAGE(bi + 1);
            const int t0 = bi * 16, nT = (L - t0) < 16 ? (L - t0) : 16; const LAS float* src = opb + (bi & 1) * 16 * 384;
            for (int tt = 0; tt < nT; ++tt) {
                const LAS float* b = src + tt * 384 + cg * 8;
                const f32x4 w0 = *(const LAS f32x4*)(b), w1 = *(const LAS f32x4*)(b + 4), k0 = *(const LAS f32x4*)(b + 64), k1 = *(const LAS f32x4*)(b + 68);
                const f32x4 b0 = *(const LAS f32x4*)(b + 128), b1 = *(const LAS f32x4*)(b + 132), q0 = *(const LAS f32x4*)(b + 192), q1 = *(const LAS f32x4*)(b + 196);
                const f32x4 r0 = *(const LAS f32x4*)(b + 256), r1 = *(const LAS f32x4*)(b + 260); const float v = src[tt * 384 + 320 + vrow];
                float d = (S[0] * k0[0] + S[1] * k0[1]) + (S[2] * k0[2] + S[3] * k0[3]) + (S[4] * k1[0] + S[5] * k1[1]) + (S[6] * k1[2] + S[7] * k1[3]);
                d += __shfl_xor(d, 1, 64); d += __shfl_xor(d, 2, 64); d += __shfl_xor(d, 4, 64);
                float y = 0.f;
#pragma unroll
                for (int j = 0; j < 4; ++j) { S[j] = S[j] * w0[j] - d * b0[j] + v * q0[j]; y += S[j] * r0[j]; S[4 + j] = S[4 + j] * w1[j] - d * b1[j] + v * q1[j]; y += S[4 + j] * r1[j]; }
                y += __shfl_xor(y, 1, 64); y += __shfl_xor(y, 2, 64); y += __shfl_xor(y, 4, 64);
                if (cg == 0) yb[tt * 64 + vrow] = y;
            }
            __syncthreads();
            for (int tt = w; tt < nT; tt += 8) {
                const float y = yb[tt * 64 + lane]; const float mean = wave_sum(y) * (1.0f / 64.0f), dy = y - mean, var = wave_sum(dy * dy) * (1.0f / 64.0f);
                const float yn = dy * rsqrtf(var + 64e-5f) * lg + lb; const size_t o = (size_t)(row0 + t0 + tt) * BW + h * 64 + lane;
                OB[o] = f2bf((yn + BON[o]) * G[o]);
            }
        }
#undef RW_STAGE
        float* op = (sq < PB ? outP + (((size_t)sq * 16 + h) * 64 + vrow) * 64 : outS + (((size_t)(sq - PB) * 16 + h) * 64 + vrow) * 64) + cg * 8;
#pragma unroll
        for (int j = 0; j < 8; ++j) op[j] = S[j];
        __syncthreads();
    }
}
constexpr int RS_SLOTS = 8, RS_SLOT_B = RB_EL * 2;
__device__ __forceinline__ bf16x8 pack_acc(const f32x4& a, const f32x4& b) {
    u32x4 p; p.x = pk2(a[0], a[1]); p.y = pk2(a[2], a[3]); p.z = pk2(b[0], b[1]); p.w = pk2(b[2], b[3]); return __builtin_bit_cast(bf16x8, p);
}
__device__ __forceinline__ void ph_rwkv_seq(const Ctx& c, int boff, const bf16_t* __restrict__ RB, const float* __restrict__ s0, float* __restrict__ outP, float* __restrict__ outS, bf16_t* __restrict__ OB) {
    const int lane = c.lane, r = lane & 15, q = lane >> 4, w = c.wave;
    LAS unsigned char* ring = c.lds;
    for (int u = (c.bid - boff + c.G) % c.G; u < (PB + SB) * 16; u += c.G) {
        const int sq = u >> 4, h = u & 15;
        int nch, ch0, row0, ntok; const float* sp = nullptr; float* op;
        if (sq < PB) { nch = 256; ch0 = (sq * 16 + h) * 256; row0 = sq * PS; ntok = 16; op = outP + (size_t)(sq * 16 + h) * 4096; }
        else { nch = 1; ch0 = PB * 16 * 256 + (sq - PB) * 16 + h; row0 = MP + (sq - PB) * SS; ntok = SS; sp = s0 + (size_t)((sq - PB) * 16 + h) * 4096; op = outS + (size_t)((sq - PB) * 16 + h) * 4096; }
        if (w >= 4) {
            const int lw = w - 4, p0 = lw < 2 ? lw * 5 : 10 + (lw - 2) * 4, np = lw < 2 ? 5 : 4;
#define RS_ISSUE(ci_) do { const int cc_ = (ci_) < nch ? (ci_) : nch - 1; const char* g_ = (const char*)(RB + (size_t)(ch0 + cc_) * RB_EL) + p0 * 1024 + lane * 16; \
            LAS unsigned char* d_ = ring + ((ci_) % RS_SLOTS) * RS_SLOT_B + p0 * 1024; \
            _Pragma("unroll") for (int p_ = 0; p_ < 5; ++p_) if (p_ < np) __builtin_amdgcn_global_load_lds((const unsigned*)(g_ + p_ * 1024), (LAS unsigned*)(d_ + p_ * 1024), 16, 0, 0); } while (0)
            for (int ci = 0; ci < RS_SLOTS - 1; ++ci) RS_ISSUE(ci);
            if (lw < 2) asm volatile("s_waitcnt vmcnt(30)" ::: "memory"); else asm volatile("s_waitcnt vmcnt(24)" ::: "memory");
            __builtin_amdgcn_s_barrier();
            for (int ci = 0; ci < nch; ++ci) {
                RS_ISSUE(ci + RS_SLOTS - 1);
                if (lw < 2) asm volatile("s_waitcnt vmcnt(30)" ::: "memory"); else asm volatile("s_waitcnt vmcnt(24)" ::: "memory");
                __builtin_amdgcn_s_barrier();
            }
#undef RS_ISSUE
            asm volatile("s_waitcnt vmcnt(0)" ::: "memory");
        } else {
            const int vb = w; f32x4 acc[4];
#pragma unroll
            for (int kb = 0; kb < 4; ++kb) acc[kb] = sp ? *(const f32x4*)(sp + (size_t)(vb * 16 + r) * 64 + kb * 16 + q * 4) : (f32x4){0.f, 0.f, 0.f, 0.f};
            const bf16x8 zfrag = (bf16x8){0, 0, 0, 0, 0, 0, 0, 0};
            __builtin_amdgcn_s_barrier();
            for (int ci = 0; ci < nch; ++ci) {
                const LAS bf16_t* blob = (const LAS bf16_t*)(ring + (ci % RS_SLOTS) * RS_SLOT_B);
                const bf16x8 t0 = pack_acc(acc[0], acc[1]), t1 = pack_acc(acc[2], acc[3]);
                const bf16x8 vt = q < 2 ? *(const LAS bf16x8*)(blob + RB_VT + (vb * 16 + r) * 24 + q * 8) : zfrag;
                const bf16x8 ep = q < 2 ? *(const LAS bf16x8*)(blob + RB_EP + r * 24 + q * 8) : zfrag;
                f32x4 y = mma16(t0, *(const LAS bf16x8*)(blob + RB_QP + r * 72 + q * 8), (f32x4){0.f, 0.f, 0.f, 0.f});
                y = mma16(t1, *(const LAS bf16x8*)(blob + RB_QP + r * 72 + 32 + q * 8), y);
                y = mma16(vt, ep, y);
#pragma unroll
                for (int kb = 0; kb < 4; ++kb) { f32x4 a = mma16(*(const LAS bf16x8*)(blob + (kb * 16 + r) * 72 + q * 8), t0, (f32x4){0.f, 0.f, 0.f, 0.f});
                    a = mma16(*(const LAS bf16x8*)(blob + (kb * 16 + r) * 72 + 32 + q * 8), t1, a);
                    const bf16x8 kh = q < 2 ? *(const LAS bf16x8*)(blob + RB_KHP + (kb * 16 + r) * 24 + q * 8) : zfrag;
                    acc[kb] = mma16(kh, vt, a); }
                if (r < ntok) { u32x2 o; o.x = pk2(y[0], y[1]); o.y = pk2(y[2], y[3]); *(u32x2*)(OB + (size_t)(row0 + ci * 16 + r) * BW + h * 64 + vb * 16 + q * 4) = o; }
                asm volatile("s_waitcnt lgkmcnt(0)" ::: "memory");
                __builtin_amdgcn_s_barrier();
            }
#pragma unroll
            for (int kb = 0; kb < 4; ++kb) *(f32x4*)(op + (size_t)(vb * 16 + r) * 64 + kb * 16 + q * 4) = acc[kb];
        }
        __syncthreads();
    }
}
__device__ __forceinline__ void ph_rwkv_fin(const Ctx& c, const float* __restrict__ RW, const float* __restrict__ lng, const float* __restrict__ lnb, bf16_t* __restrict__ OB) {
    const int lane = c.lane; const float* G = RW + 6 * (size_t)MPAD * BW; const float* BON = RW + 7 * (size_t)MPAD * BW;
    for (int i = c.bid * 8 + c.wave; i < MT * 4; i += c.G * 8) {
        const int row = i >> 2, cc = (i & 3) * 256 + lane * 4; const size_t o = (size_t)row * BW + cc; bf16_t* p = OB + o;
        const u32x2 raw = *(const u32x2*)p; float x[4] = {__uint_as_float(raw.x << 16), __uint_as_float(raw.x & 0xffff0000u), __uint_as_float(raw.y << 16), __uint_as_float(raw.y & 0xffff0000u)};
        float s = (x[0] + x[1]) + (x[2] + x[3]); s += __shfl_xor(s, 1, 64); s += __shfl_xor(s, 2, 64); s += __shfl_xor(s, 4, 64); s += __shfl_xor(s, 8, 64);
        const float mean = s * (1.0f / 64.0f); float qq = 0.f;
#pragma unroll
        for (int j = 0; j < 4; ++j) { const float d = x[j] - mean; qq += d * d; }
        qq += __shfl_xor(qq, 1, 64); qq += __shfl_xor(qq, 2, 64); qq += __shfl_xor(qq, 4, 64); qq += __shfl_xor(qq, 8, 64);
        const float rstd = rsqrtf(qq * (1.0f / 64.0f) + 64e-5f);
        const f32x4 gg = *(const f32x4*)(lng + cc), bb = *(const f32x4*)(lnb + cc), bo = *(const f32x4*)(BON + o), gt = *(const f32x4*)(G + o); float ov[4];
#pragma unroll
        for (int j = 0; j < 4; ++j) ov[j] = ((x[j] - mean) * rstd * gg[j] + bb[j] + bo[j]) * gt[j];
        u32x2 oo; oo.x = pk2(ov[0], ov[1]); oo.y = pk2(ov[2], ov[3]); *(u32x2*)p = oo;
    }
}

__device__ __forceinline__ void ph_memattn_sample(const Ctx& c, const bf16_t* __restrict__ U, const float* __restrict__ mk, const float* __restrict__ mv, bf16_t* __restrict__ OB) {
    LAS float* qs = (LAS float*)c.lds; LAS float* ps = qs + 2 * 4 * 256;
    const int hh = c.tid >> 8, vt = c.tid & 255, lane = c.lane;
    for (int u = c.bid; u < SB * 2; u += c.G) {
        const int sq = u >> 1, h = (u & 1) * 2 + hh;
#pragma unroll
        for (int t = 0; t < 4; ++t) qs[(hh * 4 + t) * 256 + vt] = bf2f(U[(size_t)(MP + sq * SS + t) * NINP + U_MQ + h * 256 + vt]) * 0.0625f;
        __syncthreads();
        { const float* kr = mk + (((size_t)sq * MEMT + vt) * 4 + h) * 256; float s[4] = {0.f, 0.f, 0.f, 0.f};
            for (int d = 0; d < 256; d += 4) { const f32x4 kv = *(const f32x4*)(kr + d);
#pragma unroll
                for (int t = 0; t < 4; ++t) { const LAS float* qq = qs + (hh * 4 + t) * 256 + d; s[t] += kv[0] * qq[0] + kv[1] * qq[1] + kv[2] * qq[2] + kv[3] * qq[3]; } }
#pragma unroll
            for (int t = 0; t < 4; ++t) ps[(hh * 4 + t) * 256 + vt] = s[t]; }
        __syncthreads();
        { LAS float* pr = ps + c.wave * 256; float x[4]; float mx = -3.0e38f;
#pragma unroll
            for (int j = 0; j < 4; ++j) { x[j] = pr[lane + 64 * j]; mx = fmaxf(mx, x[j]); }
            mx = wave_max(mx); float s = 0.f;
#pragma unroll
            for (int j = 0; j < 4; ++j) { x[j] = __expf(x[j] - mx); s += x[j]; }
            const float inv = 1.0f / wave_sum(s);
#pragma unroll
            for (int j = 0; j < 4; ++j) pr[lane + 64 * j] = x[j] * inv; }
        __syncthreads();
        { float o[4] = {0.f, 0.f, 0.f, 0.f}; const float* vr = mv + ((size_t)sq * MEMT * 4 + h) * 256 + vt;
            for (int m = 0; m < MEMT; ++m) { const float vv = vr[(size_t)m * 1024];
#pragma unroll
                for (int t = 0; t < 4; ++t) o[t] += ps[(hh * 4 + t) * 256 + m] * vv; }
#pragma unroll
            for (int t = 0; t < 4; ++t) OB[(size_t)(MP + sq * SS + t) * BW + h * 256 + vt] = f2bf(o[t]); }
        __syncthreads();
    }
}

constexpr int LDS_BAR_OFF = 147456;
constexpr int LDS_BYTES = LDS_BAR_OFF + 64;
struct Args { const float* in[37]; float* out; unsigned char* ws; };

typedef pg8::Gemm<DM, DM, DM, 2, 8, NL, 1, false, 0, 0, (long)DM * DM, 0> GemmMem;
typedef pg8::Gemm<DM, DM, DM, MPAD / 256, NINP / 256> GemmIn;
typedef pg8::Gemm<NINP, 1024, 256, PS / 256, 1, 8, 4, false, (long)PS * NINP, 256, 256 * 1024, 256> GemmScore;
typedef pg8::Gemm<256, 256, 256, PS / 256, 1, 8, 4, false, (long)4 * 4096 * 256, (long)4096 * 256, 4 * 65536, 65536> GemmPV;
typedef pg8::Gemm<BW, BW, BW, MPAD / 256, DM / 256, 4, 1, true, (long)MPAD * BW, 0, (long)DM * BW, 0> GemmBranch;
typedef pg8::Gemm<DM, DM, DM, MPAD / 256, DM / 256> GemmOut;
typedef pg8::Gemm<DM, DM, DM, MPAD / 256, 2 * DFF / 256> GemmGU;
typedef pg8::Gemm<DFF, DFF, DFF, MPAD / 256, DM / 256> GemmDown;
template <class GT> __device__ __forceinline__ GT mk_gemm(const Ctx& c, const bf16_t* A, const bf16_t* B) { GT g; g.A = A; g.B = B; g.G = c.G; g.c = c.bid; return g; }

template <int OFF> __device__ __forceinline__ unsigned long long karg_u64(unsigned long long kargs) {
    unsigned long long p; asm volatile("s_load_dwordx2 %0, %1, %2\n\ts_waitcnt lgkmcnt(0)" : "=s"(p) : "s"(kargs), "n"(OFF) : "memory"); return p;
}
#define INP(k) ((const float*)karg_u64<(k) * 8>(kargs))
#define OUTP() ((float*)karg_u64<37 * 8>(kargs))
#define WSP() ((unsigned char*)karg_u64<38 * 8>(kargs))

__global__ void __launch_bounds__(512, 2) mega_fwd(Args a_unused) {
    extern __shared__ __attribute__((aligned(16))) unsigned char lds_raw[];
    const unsigned long long kargs = (unsigned long long)__builtin_amdgcn_kernarg_segment_ptr();
    Ctx c0; c0.tid = threadIdx.x; c0.lane = c0.tid & 63; c0.wave = __builtin_amdgcn_readfirstlane(c0.tid >> 6); c0.bid = blockIdx.x; c0.G = gridDim.x; c0.lds = (LAS unsigned char*)lds_raw;
    if (c0.tid < 4) ((LAS unsigned*)(c0.lds + LDS_BAR_OFF))[c0.tid] = 0u;
    __syncthreads();
    const XcdBarrier bar = xcd_barrier_post((unsigned*)(WSP() + WS_CTL), (volatile LAS unsigned*)(c0.lds + LDS_BAR_OFF));

    { const Ctx c = fresh(c0); unsigned char* ws = WSP();
      ph_wprep(c, INP(10), (bf16_t*)(ws + WS_WIN), DM, NIN, NINP, 1, NL, (size_t)DM * NIN, (size_t)NINP * DM);
      ph_wprep(c, INP(28), (bf16_t*)(ws + WS_WMEM), DM, DM, DM, 0, NL, (size_t)DM * DM, (size_t)DM * DM);
      ph_wprep(c, INP(29), (bf16_t*)(ws + WS_WBR), BW, DM, DM, 0, NL * 4, (size_t)BW * DM, (size_t)DM * BW);
      ph_wprep(c, INP(30), (bf16_t*)(ws + WS_WOUT), DM, DM, DM, 0, NL, (size_t)DM * DM, (size_t)DM * DM);
      ph_wprep(c, INP(33), (bf16_t*)(ws + WS_WGU), DM, 2 * DFF, 2 * DFF, 2, NL, (size_t)DM * 2 * DFF, (size_t)2 * DFF * DM);
      ph_wprep(c, INP(34), (bf16_t*)(ws + WS_WDN), DFF, DM, DM, 0, NL, (size_t)DFF * DM, (size_t)DM * DFF);
      ph_xprep(c, INP(0), INP(1), INP(2), (float*)(ws + WS_HF), (bf16_t*)(ws + WS_HB), (bf16_t*)(ws + WS_MEMB)); }
    xcd_barrier(bar);
    { const Ctx c = fresh(c0); unsigned char* ws = WSP(); float* out = OUTP();
      GemmMem g = mk_gemm<GemmMem>(c, (const bf16_t*)(ws + WS_MEMB), (const bf16_t*)(ws + WS_WMEM));
      pg8::EpiMem E; E.outK = out + O_MKP; E.outV = out + O_MVP; E.kb = (bf16_t*)(ws + WS_MKB); E.vt = (bf16_t*)(ws + WS_MVT); pg8::gemm_phase<GemmMem, pg8::EpiMem, true, true>(c.lds, c.tid, g, E); }

    for (int l = 0; l < NL; ++l) {
        { const Ctx c = fresh(c0); unsigned char* ws = WSP();
          GemmIn g = mk_gemm<GemmIn>(c, (const bf16_t*)(ws + WS_HB), (const bf16_t*)(ws + WS_WIN) + (size_t)l * NINP * DM);
          pg8::EpiBf16 E; E.O = (bf16_t*)(ws + WS_U); E.zs = 0; E.ldc = NINP; E.pad = 0; pg8::gemm_phase<GemmIn, pg8::EpiBf16, true, true>(c.lds, c.tid, g, E); }
        xcd_barrier(bar);
        { const Ctx c = fresh(c0); unsigned char* ws = WSP(); float* out = OUTP(); const bf16_t* U = (const bf16_t*)(ws + WS_U); bf16_t* BR = (bf16_t*)(ws + WS_BR);
          (void)out; (void)BR;
          ph_gla_pre(c, U, INP(12) + (size_t)l * 16 * 512, INP(13) + (size_t)l * 512, (bf16_t*)(ws + WS_GLQD), (bf16_t*)(ws + WS_GLKH), (bf16_t*)(ws + WS_GLE), (bf16_t*)(ws + WS_GLVT), (float*)(ws + WS_GLGC)); }
        { const Ctx c = fresh(c0); unsigned char* ws = WSP();
          ph_rwkv_pre(c, (const bf16_t*)(ws + WS_U), INP(9) + (size_t)l * SB * RWC, INP(17) + (size_t)l * RWC, INP(18) + (size_t)l * BW, INP(19) + (size_t)l * 64 * BW, INP(20) + (size_t)l * BW, INP(21) + (size_t)l * 64 * BW,
                       INP(22) + (size_t)l * 128 * BW, INP(23) + (size_t)l * BW, INP(24) + (size_t)l * BW, INP(25) + (size_t)l * BW, (float*)(ws + WS_RW), (bf16_t*)(ws + WS_RB)); }
        { const Ctx c = fresh(c0); unsigned char* ws = WSP();
          ph_swa_naive(c, (const bf16_t*)(ws + WS_U), INP(3) + (size_t)l * SB * 16384, INP(4) + (size_t)l * SB * 16384, INP(16) + (size_t)l * 16, (bf16_t*)(ws + WS_BR) + (size_t)MPAD * BW); }
        { const Ctx c = fresh(c0); unsigned char* ws = WSP();
          ph_copy_outs(c, (const bf16_t*)(ws + WS_U), INP(3) + (size_t)l * SB * 16384, INP(4) + (size_t)l * SB * 16384, OUTP(), l); }
        { const Ctx c = fresh(c0); unsigned char* ws = WSP();
          ph_memattn_sample(c, (const bf16_t*)(ws + WS_U), INP(5) + (size_t)l * SB * MEMT * 1024, INP(6) + (size_t)l * SB * MEMT * 1024, (bf16_t*)(ws + WS_BR) + (size_t)3 * MPAD * BW); }
        { const Ctx c = fresh(c0); unsigned char* ws = WSP();
          GemmScore g = mk_gemm<GemmScore>(c, (const bf16_t*)(ws + WS_U) + U_MQ, (const bf16_t*)(ws + WS_MKB) + (size_t)l * 512 * 1024);
          pg8::EpiScore E; E.SC = (float*)(ws + WS_SC); pg8::gemm_phase<GemmScore, pg8::EpiScore, true, true>(c.lds, c.tid, g, E); }
        xcd_barrier(bar);
        { const Ctx c = fresh(c0); unsigned char* ws = WSP(); float* out = OUTP();
          ph_rwkv_seq(c, 64, (const bf16_t*)(ws + WS_RB), INP(8) + (size_t)l * SB * 16 * 4096, out + O_RWP + (size_t)l * PB * 16 * 4096, out + O_RWS + (size_t)l * SB * 16 * 4096,
                      (bf16_t*)(ws + WS_BR) + (size_t)2 * MPAD * BW); }
        { const Ctx c = fresh(c0); unsigned char* ws = WSP(); float* out = OUTP();
          ph_gla_seq(c, 32, (const bf16_t*)(ws + WS_GLQD), (const bf16_t*)(ws + WS_GLKH), (const bf16_t*)(ws + WS_GLE), (const bf16_t*)(ws + WS_GLVT), (const float*)(ws + WS_GLGC),
                     INP(7) + (size_t)l * SB * 4 * 32768, out + O_GLAP + (size_t)l * PB * 4 * 32768, out + O_GLAS + (size_t)l * SB * 4 * 32768, (bf16_t*)(ws + WS_BR)); }
        { const Ctx c = fresh(c0); unsigned char* ws = WSP(); ph_softmax256(c, (const float*)(ws + WS_SC), (bf16_t*)(ws + WS_PB), 8 * 4096); }
        xcd_barrier(bar);
        { const Ctx c = fresh(c0); unsigned char* ws = WSP(); ph_rwkv_fin(c, (const float*)(ws + WS_RW), INP(26) + (size_t)l * BW, INP(27) + (size_t)l * BW, (bf16_t*)(ws + WS_BR) + (size_t)2 * MPAD * BW); }
        { const Ctx c = fresh(c0); unsigned char* ws = WSP(); ph_gla_fin(c, (const bf16_t*)(ws + WS_U), INP(14) + (size_t)l * BW, INP(15) + (size_t)l * BW, (bf16_t*)(ws + WS_BR)); }
        { const Ctx c = fresh(c0); unsigned char* ws = WSP();
          GemmPV g = mk_gemm<GemmPV>(c, (const bf16_t*)(ws + WS_PB), (const bf16_t*)(ws + WS_MVT) + (size_t)l * 8 * 65536);
          pg8::EpiPV E; E.O = (bf16_t*)(ws + WS_BR) + (size_t)3 * MPAD * BW; pg8::gemm_phase<GemmPV, pg8::EpiPV, true, true>(c.lds, c.tid, g, E); }
        xcd_barrier(bar);
        { const Ctx c = fresh(c0); unsigned char* ws = WSP();
          GemmBranch g = mk_gemm<GemmBranch>(c, (const bf16_t*)(ws + WS_BR), (const bf16_t*)(ws + WS_WBR) + (size_t)l * 4 * DM * BW);
          pg8::EpiMerge E; E.MG = (float*)(ws + WS_MG); E.MGB = (bf16_t*)(ws + WS_MGB); E.U = (const bf16_t*)(ws + WS_U); E.gate_b = INP(11) + (size_t)l * 4 * DM; pg8::gemm_phase<GemmBranch, pg8::EpiMerge, true, true>(c.lds, c.tid, g, E); }
        xcd_barrier(bar);
        { const Ctx c = fresh(c0); unsigned char* ws = WSP();
          GemmOut g = mk_gemm<GemmOut>(c, (const bf16_t*)(ws + WS_MGB), (const bf16_t*)(ws + WS_WOUT) + (size_t)l * DM * DM);
          pg8::EpiRes E; E.R = (const float*)(ws + WS_HF); E.Y = (float*)(ws + WS_Y); pg8::gemm_phase<GemmOut, pg8::EpiRes, true, true>(c.lds, c.tid, g, E); }
        xcd_barrier(bar);
        { const Ctx c = fresh(c0); unsigned char* ws = WSP(); ph_ln(c, (const float*)(ws + WS_Y), INP(31) + (size_t)l * DM, INP(32) + (size_t)l * DM, (float*)(ws + WS_X1F), (bf16_t*)(ws + WS_X1B), nullptr, MPAD, 0); }
        xcd_barrier(bar);
        { const Ctx c = fresh(c0); unsigned char* ws = WSP();
          GemmGU g = mk_gemm<GemmGU>(c, (const bf16_t*)(ws + WS_X1B), (const bf16_t*)(ws + WS_WGU) + (size_t)l * 2 * DFF * DM);
          pg8::EpiSwiGLU E; E.O = (bf16_t*)(ws + WS_ACT); pg8::gemm_phase<GemmGU, pg8::EpiSwiGLU, true, true>(c.lds, c.tid, g, E); }
        xcd_barrier(bar);
        { const Ctx c = fresh(c0); unsigned char* ws = WSP();
          GemmDown g = mk_gemm<GemmDown>(c, (const bf16_t*)(ws + WS_ACT), (const bf16_t*)(ws + WS_WDN) + (size_t)l * DM * DFF);
          pg8::EpiRes E; E.R = (const float*)(ws + WS_X1F); E.Y = (float*)(ws + WS_Y); pg8::gemm_phase<GemmDown, pg8::EpiRes, true, true>(c.lds, c.tid, g, E); }
        xcd_barrier(bar);
        { const Ctx c = fresh(c0); unsigned char* ws = WSP(); float* out = OUTP(); ph_ln(c, (const float*)(ws + WS_Y), INP(35) + (size_t)l * DM, INP(36) + (size_t)l * DM, (float*)(ws + WS_HF), (bf16_t*)(ws + WS_HB), l == NL - 1 ? out : nullptr, MPAD, MT); }
        xcd_barrier(bar);
    }
}

extern "C" void kernel_launch(void* const* d_in, const int* in_sizes, int n_in, void* d_out, int out_size, void* d_ws, size_t ws_size, hipStream_t stream) {
    static int grid = 0;
    if (grid == 0) {
        if (n_in != 37 || (size_t)out_size != O_END || ws_size < WS_END) { fprintf(stderr, "kernel_launch: unexpected sizes (n_in %d out %d ws %zu need %zu)\n", n_in, out_size, ws_size, (size_t)WS_END); grid = -1; return; }
        int dev = 0, cus = 0;
        if (hipGetDevice(&dev) != hipSuccess || hipDeviceGetAttribute(&cus, hipDeviceAttributeMultiprocessorCount, dev) != hipSuccess) { grid = -1; return; }
        if (hipFuncSetAttribute((const void*)mega_fwd, hipFuncAttributeMaxDynamicSharedMemorySize, LDS_BYTES) != hipSuccess) { fprintf(stderr, "kernel_launch: hipFuncSetAttribute failed\n"); grid = -1; return; }
        int per_cu = 0;
        if (hipOccupancyMaxActiveBlocksPerMultiprocessor(&per_cu, (const void*)mega_fwd, 512, LDS_BYTES) != hipSuccess || per_cu < 1) { fprintf(stderr, "kernel_launch: occupancy query says %d\n", per_cu); }
        (void)hipGetLastError();
        grid = cus;
    }
    if (grid < 0) return;
    (void)hipMemsetAsync((unsigned char*)d_ws + WS_CTL, 0, XCD_BAR_WORDS * sizeof(unsigned), stream);
    Args a; memset(&a, 0, sizeof a);
    for (int i = 0; i < 37; ++i) a.in[i] = (const float*)d_in[i];
    a.out = (float*)d_out; a.ws = (unsigned char*)d_ws;
    hipLaunchKernelGGL(mega_fwd, dim3(grid), dim3(512), LDS_BYTES, stream, a);
}
```

```cpp
#include <hip/hip_runtime.h>
#include <cstdio>
#include <cstdint>
#include <cstring>

#define LAS __attribute__((address_space(3)))
typedef unsigned short bf16_t;
typedef short bf16x8 __attribute__((ext_vector_type(8)));
typedef float f32x4 __attribute__((ext_vector_type(4)));
typedef float f32x2 __attribute__((ext_vector_type(2)));
typedef unsigned u32x4 __attribute__((ext_vector_type(4)));
typedef unsigned u32x2 __attribute__((ext_vector_type(2)));

constexpr int DM = 2048, NL = 4;
constexpr int PB = 2, PS = 4096, MP = PB * PS;
constexpr int SB = 32, SS = 4, MS = SB * SS;
constexpr int MT = MP + MS;
constexpr int MPAD = 8448;
constexpr int NIN = 16912, NINP = 17152;
constexpr int U_GQ = 0, U_GK = 512, U_GV = 1024, U_GR = 2048, U_GA = 3072, U_SQ = 3328, U_SK = 4352, U_SV = 4480, U_RU = 4608, U_MQ = 7936, U_GP = 8960;
constexpr int RWC = 3328, BW = 1024, DFF = 5632, MEMT = 256;
constexpr float ALPHA = 1.681792830507429f;

constexpr size_t O_YP = 0;
constexpr size_t O_YS = O_YP + (size_t)MP * DM;
constexpr size_t O_SWKP = O_YS + (size_t)MS * DM;
constexpr size_t O_SWVP = O_SWKP + (size_t)NL * PB * 128 * 128;
constexpr size_t O_MKP = O_SWVP + (size_t)NL * PB * 128 * 128;
constexpr size_t O_MVP = O_MKP + (size_t)NL * PB * 256 * 1024;
constexpr size_t O_GLAP = O_MVP + (size_t)NL * PB * 256 * 1024;
constexpr size_t O_RWP = O_GLAP + (size_t)NL * PB * 4 * 128 * 256;
constexpr size_t O_RSP = O_RWP + (size_t)NL * PB * 16 * 64 * 64;
constexpr size_t O_SWKS = O_RSP + (size_t)NL * PB * RWC;
constexpr size_t O_SWVS = O_SWKS + (size_t)NL * SB * 128 * 128;
constexpr size_t O_GLAS = O_SWVS + (size_t)NL * SB * 128 * 128;
constexpr size_t O_RWS = O_GLAS + (size_t)NL * SB * 4 * 128 * 256;
constexpr size_t O_RSS = O_RWS + (size_t)NL * SB * 16 * 64 * 64;
constexpr size_t O_END = O_RSS + (size_t)NL * SB * RWC;
static_assert(O_END == 52881408, "output size");

constexpr size_t al256(size_t x) { return (x + 255) & ~(size_t)255; }
constexpr size_t WS_CTL = 0;
constexpr size_t WS_WIN = 65536;
constexpr size_t WS_WMEM = WS_WIN + (size_t)NL * NINP * DM * 2;
constexpr size_t WS_WBR = WS_WMEM + (size_t)NL * DM * DM * 2;
constexpr size_t WS_WOUT = WS_WBR + (size_t)NL * 4 * DM * BW * 2;
constexpr size_t WS_WGU = WS_WOUT + (size_t)NL * DM * DM * 2;
constexpr size_t WS_WDN = WS_WGU + (size_t)NL * 2 * DFF * DM * 2;
constexpr size_t WS_HF = WS_WDN + (size_t)NL * DM * DFF * 2;
constexpr size_t WS_HB = WS_HF + (size_t)MPAD * DM * 4;
constexpr size_t WS_U = WS_HB + (size_t)MPAD * DM * 2;
constexpr size_t WS_BR = WS_U + (size_t)MPAD * NINP * 2;
constexpr size_t WS_MG = WS_BR + (size_t)4 * MPAD * BW * 2;
constexpr size_t WS_MGB = WS_MG + (size_t)MPAD * DM * 4;
constexpr size_t WS_Y = WS_MGB + (size_t)MPAD * DM * 2;
constexpr size_t WS_X1F = WS_Y + (size_t)MPAD * DM * 4;
constexpr size_t WS_X1B = WS_X1F + (size_t)MPAD * DM * 4;
constexpr size_t WS_ACT = WS_X1B + (size_t)MPAD * DM * 2;
constexpr size_t WS_MEMB = WS_ACT + (size_t)MPAD * DFF * 2;
constexpr size_t WS_MKB = WS_MEMB + (size_t)512 * DM * 2;
constexpr size_t WS_MVT = WS_MKB + (size_t)NL * 512 * 1024 * 2;
constexpr size_t WS_SC = WS_MVT + (size_t)NL * 8 * 256 * 256 * 2;
constexpr size_t WS_PB = WS_SC + (size_t)8 * 4096 * 256 * 4;
constexpr size_t WS_RW = WS_PB + (size_t)8 * 4096 * 256 * 2;
constexpr size_t RW_ARR = (size_t)MPAD * BW * 4;
constexpr int GL_NCH = 512 + 128;
constexpr size_t WS_GLQD = WS_RW + 8 * RW_ARR;
constexpr size_t WS_GLKH = WS_GLQD + (size_t)GL_NCH * 8192 * 2;
constexpr size_t WS_GLE = WS_GLKH + (size_t)GL_NCH * 8192 * 2;
constexpr size_t WS_GLVT = WS_GLE + (size_t)GL_NCH * 4096 * 2;
constexpr size_t WS_GLGC = WS_GLVT + (size_t)GL_NCH * 16384 * 2;
constexpr int RB_NCH = PB * 16 * 256 + SB * 16;
constexpr int RB_EL = 9216;
constexpr int RB_QP = 4608, RB_KHP = 5760, RB_VT = 7296, RB_EP = 8832;
constexpr size_t WS_RB = WS_GLGC + (size_t)GL_NCH * 128 * 4;
constexpr size_t WS_END = WS_RB + (size_t)RB_NCH * RB_EL * 2;

__device__ __forceinline__ float bf2f(bf16_t b) { return __uint_as_float(((unsigned)b) << 16); }
__device__ __forceinline__ bf16_t f2bf(float f) { unsigned u = __float_as_uint(f); u += 0x7FFFu + ((u >> 16) & 1u); return (bf16_t)(u >> 16); }
__device__ __forceinline__ unsigned pk2(float lo, float hi) { return (unsigned)f2bf(lo) | ((unsigned)f2bf(hi) << 16); }
__device__ __forceinline__ float wave_sum(float v) {
#pragma unroll
    for (int o = 32; o > 0; o >>= 1) v += __shfl_xor(v, o, 64);
    return v;
}
__device__ __forceinline__ float wave_max(float v) {
#pragma unroll
    for (int o = 32; o > 0; o >>= 1) v = fmaxf(v, __shfl_xor(v, o, 64));
    return v;
}
__device__ __forceinline__ float sigmoidf_(float x) { return 1.0f / (1.0f + __expf(-x)); }
__device__ __forceinline__ float softplusf_(float x) { return fmaxf(x, 0.f) + log1pf(__expf(-fabsf(x))); }

namespace pg8 {
constexpr int BM = 256, BK = 64, HALF = 128, HTB = HALF * BK * 2, STAGE_BYTES = 8 * HTB, NXCD = 8, WGM = 8;
__host__ __device__ __forceinline__ int lds_byte(int r, int c) { const int st = (r >> 4) * 2 + (c >> 5), rr = r & 15, cc = c & 31, ob = rr * 64 + cc * 2; return st * 1024 + (ob ^ (((ob >> 9) & 1) << 5)); }
__host__ __device__ __forceinline__ void stage_rc(int b, int& R, int& C) { const int st = b / 1024, sb = b % 1024, swz = sb ^ (((sb >> 9) & 1) << 5); R = (st >> 1) * 16 + swz / 64; C = (st & 1) * 32 + (swz % 64) / 2; }
__host__ __device__ __forceinline__ int perm32(int rho) { const int n = rho >> 4, i = rho & 15; return 8 * (i >> 2) + 4 * n + (i & 3); }

struct Unit { int pm, pn, z; };
template <int LDA_, int LDB_, int K_, int NM_, int NN_, int NZ_ = 1, int NZH_ = 1, bool ZINNER_ = false, long ZSAB_ = 0, long ZSAH_ = 0, long ZSBB_ = 0, long ZSBH_ = 0>
struct Gemm {
    static constexpr int LDA = LDA_, LDB = LDB_, K = K_, NM = NM_, NN = NN_, NZ = NZ_, NZH = NZH_; static constexpr bool ZINNER = ZINNER_;
    const bf16_t* A; const bf16_t* B; int G, c;
    __device__ __forceinline__ bool next(int i, Unit& u) const {
        constexpr int nt = NM * NN; int L, z;
        if (ZINNER) { const int it = i / NZ; z = i - it * NZ; const long LL = (long)it * G + c; if (LL >= nt) return false; L = (int)LL; }
        else { const long LL = (long)i * G + c; if (LL >= (long)nt * NZ) return false; z = (int)(LL / nt); L = (int)(LL - (long)z * nt); }
        int wgid = L; { constexpr int q = nt / NXCD, r = nt % NXCD; const int xcd = wgid % NXCD, off = wgid / NXCD; wgid = (xcd < r ? xcd * (q + 1) : r * (q + 1) + (xcd - r) * q) + off; }
        constexpr int nig = WGM * NN; const int gid = wgid / nig, fm = gid * WGM, gsz = (NM - fm) < WGM ? (NM - fm) : WGM;
        u.pm = fm + ((wgid % nig) % gsz); u.pn = (wgid % nig) / gsz; u.z = z; return true;
    }
    __device__ __forceinline__ const char* a_base(const Unit& u) const { const int zb = u.z / NZH, zh = u.z - zb * NZH; return (const char*)(A + zb * ZSAB_ + zh * ZSAH_ + (long)u.pm * BM * LDA); }
    __device__ __forceinline__ const char* b_base(const Unit& u) const { const int zb = u.z / NZH, zh = u.z - zb * NZH; return (const char*)(B + zb * ZSBB_ + zh * ZSBH_ + (long)u.pn * BM * LDB); }
};

template <class GT, class Epi, bool ALIGN_EPI = true, bool SP2 = true>
__device__ __forceinline__ void gemm_phase(LAS unsigned char* lds, const int tid, const GT& g, const Epi& E) {
    const int wid = __builtin_amdgcn_readfirstlane(tid >> 6), lane = tid & 63, wr = wid >> 2, wc = wid & 3, fr = lane & 15, fq = lane >> 4;
    constexpr int nt = GT::K / BK;
    unsigned voffA[2], voffB[2];
#pragma unroll
    for (int i = 0; i < 2; ++i) { int R, C; stage_rc(tid * 16 + i * 8192, R, C); const int Rb = Epi::PERM ? ((R & ~31) + perm32(R & 31)) : R;
        voffA[i] = (unsigned)(R * GT::LDA + C) * 2u; voffB[i] = (unsigned)(Rb * GT::LDB + C) * 2u; }
    constexpr size_t kstep = (size_t)(BK * 2);
    constexpr size_t hstepA = (size_t)HALF * GT::LDA * 2, hstepB = (size_t)HALF * GT::LDB * 2;
    const unsigned ldsw = (unsigned)wid * 1024u;
    const int aoff = lds_byte(wr * 64 + fr, fq * 8), boff = lds_byte(wc * 32 + fr, fq * 8);
#define PG8_SA(b, h) (((b) * 2 + (h)) * HTB)
#define PG8_SB(b, h) ((4 + (b) * 2 + (h)) * HTB)
#define PG8_STAGE(bufoff, gbase, voff) do { _Pragma("unroll") for (int _i = 0; _i < 2; ++_i) \
        __builtin_amdgcn_global_load_lds((const unsigned*)((const char*)(gbase) + (voff)[_i]), (LAS unsigned*)(lds + (bufoff) + ldsw + _i * 8192), 16, 0, 0); } while (0)
#define PG8_LDA(dst, b, h) do { _Pragma("unroll") for (int m = 0; m < 4; ++m) _Pragma("unroll") for (int k = 0; k < 2; ++k) dst[m][k] = *(const LAS bf16x8*)(lds + PG8_SA(b, h) + aoff + m * 2048 + k * 1024); } while (0)
#define PG8_LDB(dst, b, h) do { _Pragma("unroll") for (int n = 0; n < 2; ++n) _Pragma("unroll") for (int k = 0; k < 2; ++k) dst[n][k] = *(const LAS bf16x8*)(lds + PG8_SB(b, h) + boff + n * 2048 + k * 1024); } while (0)
#define PG8_MMA(ai, bj, At, Bt) do { __builtin_amdgcn_s_setprio(1); _Pragma("unroll") for (int m = 0; m < 4; ++m) _Pragma("unroll") for (int n = 0; n < 2; ++n) _Pragma("unroll") for (int k = 0; k < 2; ++k) \
        acc[ai][bj][m][n] = __builtin_amdgcn_mfma_f32_16x16x32_bf16(Bt[n][k], At[m][k], acc[ai][bj][m][n], 0, 0, 0); __builtin_amdgcn_s_setprio(0); } while (0)
#define PG8_WAIT_V(n) asm volatile("s_waitcnt vmcnt(" #n ")" ::: "memory")
#define PG8_WAIT_L(n) asm volatile("s_waitcnt lgkmcnt(" #n ")" ::: "memory")
#define PG8_BAR __builtin_amdgcn_s_barrier()
#define PG8_SCHED __builtin_amdgcn_sched_barrier(0)
    Unit cur, nxt; int ui = 0;
    if (!g.next(0, cur)) return;
    f32x4 acc[2][2][4][2];
#pragma unroll
    for (int a = 0; a < 2; ++a)
#pragma unroll
        for (int b = 0; b < 2; ++b)
#pragma unroll
            for (int m = 0; m < 4; ++m)
#pragma unroll
                for (int n = 0; n < 2; ++n) acc[a][b][m][n] = (f32x4){0.f, 0.f, 0.f, 0.f};
    bf16x8 At[4][2], B0[2][2], B1[2][2];
    const char* cA = g.a_base(cur); const char* cB = g.b_base(cur);
    if constexpr (SP2) {
        PG8_STAGE(PG8_SB(0, 0), cB, voffB); PG8_STAGE(PG8_SB(0, 1), cB + hstepB, voffB); PG8_STAGE(PG8_SA(0, 0), cA, voffA); PG8_STAGE(PG8_SA(0, 1), cA + hstepA, voffA);
        if (wr == 1) PG8_BAR;
        PG8_WAIT_V(2); PG8_BAR;
        PG8_STAGE(PG8_SB(1, 0), cB + kstep, voffB); PG8_STAGE(PG8_SA(1, 0), cA + kstep, voffA); PG8_STAGE(PG8_SB(1, 1), cB + hstepB + kstep, voffB);
        PG8_WAIT_V(6); PG8_BAR;
    } else {
        PG8_STAGE(PG8_SB(0, 0), cB, voffB); PG8_STAGE(PG8_SA(0, 0), cA, voffA); PG8_STAGE(PG8_SB(0, 1), cB + hstepB, voffB); PG8_STAGE(PG8_SA(0, 1), cA + hstepA, voffA);
        if (wr == 1) PG8_BAR;
        PG8_WAIT_V(4); PG8_BAR;
        PG8_STAGE(PG8_SB(1, 0), cB + kstep, voffB); PG8_STAGE(PG8_SA(1, 0), cA + kstep, voffA); PG8_STAGE(PG8_SB(1, 1), cB + hstepB + kstep, voffB);
        PG8_WAIT_V(6); PG8_BAR;
    }
    for (;;) {
        const bool has_next = g.next(ui + 1, nxt);
        const char* nA = has_next ? g.a_base(nxt) : cA; const char* nB = has_next ? g.b_base(nxt) : cB;
#pragma unroll 1
        for (int t = 0; t < nt; t += 2) {
            const bool last = (t == nt - 2);
            const char* a1 = cA + (size_t)(t + 1) * kstep;
            const char* a2 = last ? nA : cA + (size_t)(t + 2) * kstep; const char* b2 = last ? nB : cB + (size_t)(t + 2) * kstep;
            const char* a3 = a2 + kstep; const char* b3 = b2 + kstep;
            if constexpr (SP2) {
            PG8_LDB(B0, 0, 0); PG8_LDB(B1, 0, 1); PG8_SCHED; PG8_LDA(At, 0, 0); PG8_STAGE(PG8_SA(1, 1), a1 + hstepA, voffA);
            PG8_WAIT_V(8); PG8_WAIT_L(0); PG8_BAR; PG8_MMA(0, 0, At, B0); PG8_MMA(0, 1, At, B1); PG8_BAR; PG8_SCHED;
            PG8_LDA(At, 0, 1); PG8_STAGE(PG8_SB(0, 0), b2, voffB); PG8_STAGE(PG8_SB(0, 1), b2 + hstepB, voffB); PG8_STAGE(PG8_SA(0, 0), a2, voffA);
            PG8_WAIT_V(8); PG8_WAIT_L(0); PG8_BAR; PG8_MMA(1, 0, At, B0); PG8_MMA(1, 1, At, B1); PG8_BAR; PG8_SCHED;
            PG8_LDB(B0, 1, 0); PG8_LDB(B1, 1, 1); PG8_SCHED; PG8_LDA(At, 1, 0); PG8_STAGE(PG8_SA(0, 1), a2 + hstepA, voffA);
            PG8_WAIT_V(8); PG8_WAIT_L(0); PG8_BAR; PG8_MMA(0, 0, At, B0); PG8_MMA(0, 1, At, B1); PG8_BAR; PG8_SCHED;
            PG8_LDA(At, 1, 1); PG8_STAGE(PG8_SB(1, 0), b3, voffB); PG8_STAGE(PG8_SB(1, 1), b3 + hstepB, voffB); PG8_STAGE(PG8_SA(1, 0), a3, voffA);
            PG8_WAIT_V(8); PG8_WAIT_L(0); PG8_BAR; PG8_MMA(1, 0, At, B0); PG8_MMA(1, 1, At, B1); PG8_BAR; PG8_SCHED;
            } else {
            PG8_LDB(B0, 0, 0); PG8_SCHED; PG8_LDA(At, 0, 0); PG8_STAGE(PG8_SA(1, 1), a1 + hstepA, voffA);
            PG8_WAIT_L(8); PG8_BAR; PG8_WAIT_L(0); PG8_MMA(0, 0, At, B0); PG8_BAR; PG8_SCHED;
            PG8_LDB(B1, 0, 1); PG8_STAGE(PG8_SB(0, 0), b2, voffB);
            PG8_BAR; PG8_WAIT_L(0); PG8_MMA(0, 1, At, B1); PG8_BAR;
            PG8_LDA(At, 0, 1); PG8_STAGE(PG8_SA(0, 0), a2, voffA);
            PG8_BAR; PG8_WAIT_L(0); PG8_MMA(1, 0, At, B0); PG8_BAR; PG8_SCHED;
            PG8_STAGE(PG8_SB(0, 1), b2 + hstepB, voffB);
            PG8_WAIT_V(6); PG8_BAR; PG8_MMA(1, 1, At, B1); PG8_BAR;
            PG8_LDB(B0, 1, 0); PG8_SCHED; PG8_LDA(At, 1, 0); PG8_STAGE(PG8_SA(0, 1), a2 + hstepA, voffA);
            PG8_WAIT_L(8); PG8_BAR; PG8_WAIT_L(0); PG8_MMA(0, 0, At, B0); PG8_BAR; PG8_SCHED;
            PG8_LDB(B1, 1, 1); PG8_STAGE(PG8_SB(1, 0), b3, voffB);
            PG8_BAR; PG8_WAIT_L(0); PG8_MMA(0, 1, At, B1); PG8_BAR;
            PG8_LDA(At, 1, 1); PG8_STAGE(PG8_SA(1, 0), a3, voffA);
            PG8_BAR; PG8_WAIT_L(0); PG8_MMA(1, 0, At, B0); PG8_BAR; PG8_SCHED;
            PG8_STAGE(PG8_SB(1, 1), b3 + hstepB, voffB);
            PG8_WAIT_V(6); PG8_BAR; PG8_MMA(1, 1, At, B1); PG8_BAR;
            }
        }
        if constexpr (ALIGN_EPI) { if (wr == 0) PG8_BAR; }
        E(acc, cur, wr, wc, fr, fq);
        if (!has_next) break;
#pragma unroll
        for (int a = 0; a < 2; ++a)
#pragma unroll
            for (int b = 0; b < 2; ++b)
#pragma unroll
                for (int m = 0; m < 4; ++m)
#pragma unroll
                    for (int n = 0; n < 2; ++n) acc[a][b][m][n] = (f32x4){0.f, 0.f, 0.f, 0.f};
        cur = nxt; cA = nA; cB = nB; ++ui;
        if constexpr (ALIGN_EPI) { if (wr == 1) PG8_BAR; }
    }
    PG8_WAIT_V(0);
    if constexpr (!ALIGN_EPI) { if (wr == 0) PG8_BAR; }
    PG8_BAR;
#undef PG8_SA
#undef PG8_SB
#undef PG8_STAGE
#undef PG8_LDA
#undef PG8_LDB
#undef PG8_MMA
#undef PG8_WAIT_V
#undef PG8_WAIT_L
#undef PG8_BAR
#undef PG8_SCHED
}

struct EpiBf16 {
    static constexpr bool PERM = true;
    bf16_t* O; long zs; int ldc, pad;
    __device__ __forceinline__ void operator()(const f32x4 (&acc)[2][2][4][2], const Unit& u, int wr, int wc, int fr, int fq) const {
        const int row0 = u.pm * BM + wr * 64 + fr, col0 = u.pn * BM + wc * 32 + 8 * fq; bf16_t* base = O + (long)u.z * zs;
#pragma unroll
        for (int ai = 0; ai < 2; ++ai)
#pragma unroll
            for (int m = 0; m < 4; ++m) { bf16_t* rowp = base + (size_t)(row0 + ai * HALF + m * 16) * ldc + col0;
#pragma unroll
                for (int bj = 0; bj < 2; ++bj) { const f32x4 v0 = acc[ai][bj][m][0], v1 = acc[ai][bj][m][1];
                    u32x4 w; w.x = pk2(v0[0], v0[1]); w.y = pk2(v0[2], v0[3]); w.z = pk2(v1[0], v1[1]); w.w = pk2(v1[2], v1[3]);
                    *(u32x4*)(rowp + bj * HALF) = w; } }
    }
};
struct EpiMem {
    static constexpr bool PERM = false;
    float* outK; float* outV; bf16_t* kb; bf16_t* vt;
    __device__ __forceinline__ void operator()(const f32x4 (&acc)[2][2][4][2], const Unit& u, int wr, int wc, int fr, int fq) const {
        const int row0 = u.pm * BM + wr * 64 + fr, col0 = u.pn * BM + wc * 32 + 4 * fq;
#pragma unroll
        for (int ai = 0; ai < 2; ++ai)
#pragma unroll
            for (int m = 0; m < 4; ++m) { const int row = row0 + ai * HALF + m * 16;
#pragma unroll
                for (int bj = 0; bj < 2; ++bj)
#pragma unroll
                    for (int n = 0; n < 2; ++n) { const int col = col0 + bj * HALF + n * 16; const f32x4 v = acc[ai][bj][m][n];
                        if (col < 1024) { *(f32x4*)(outK + ((size_t)u.z * 512 + row) * 1024 + col) = v;
                            u32x2 w; w.x = pk2(v[0], v[1]); w.y = pk2(v[2], v[3]); *(u32x2*)(kb + ((size_t)u.z * 512 + row) * 1024 + col) = w; }
                        else { const int c = col - 1024; *(f32x4*)(outV + ((size_t)u.z * 512 + row) * 1024 + c) = v;
                            const int b = row >> 8, mm = row & 255, h = c >> 8, d = c & 255; bf16_t* p = vt + ((((size_t)u.z * 2 + b) * 4 + h) * 256 + d) * 256 + mm;
                            p[0] = f2bf(v[0]); p[256] = f2bf(v[1]); p[512] = f2bf(v[2]); p[768] = f2bf(v[3]); } } }
    }
};
struct EpiMerge {
    static constexpr bool PERM = false;
    float* MG; bf16_t* MGB; const bf16_t* U; const float* gate_b;
    __device__ __forceinline__ void operator()(const f32x4 (&acc)[2][2][4][2], const Unit& u, int wr, int wc, int fr, int fq) const {
        const int row0 = u.pm * BM + wr * 64 + fr, col0 = u.pn * BM + wc * 32 + 4 * fq;
#pragma unroll
        for (int ai = 0; ai < 2; ++ai)
#pragma unroll
            for (int m = 0; m < 4; ++m) { const int row = row0 + ai * HALF + m * 16;
#pragma unroll
                for (int bj = 0; bj < 2; ++bj)
#pragma unroll
                    for (int n = 0; n < 2; ++n) { const int col = col0 + bj * HALF + n * 16; const f32x4 v = acc[ai][bj][m][n];
                        const u32x2 gp = *(const u32x2*)(U + (size_t)row * NINP + U_GP + u.z * DM + col); const f32x4 gb = *(const f32x4*)(gate_b + u.z * DM + col);
                        f32x4 gt; gt[0] = sigmoidf_(__uint_as_float(gp.x << 16) + gb[0]); gt[1] = sigmoidf_(__uint_as_float(gp.x & 0xffff0000u) + gb[1]);
                        gt[2] = sigmoidf_(__uint_as_float(gp.y << 16) + gb[2]); gt[3] = sigmoidf_(__uint_as_float(gp.y & 0xffff0000u) + gb[3]);
                        float* mp = MG + (size_t)row * DM + col; f32x4 r = gt * v;
                        if (u.z > 0) r += *(const f32x4*)mp;
                        if (u.z < 3) *(f32x4*)mp = r;
                        else { u32x2 w; w.x = pk2(r[0], r[1]); w.y = pk2(r[2], r[3]); *(u32x2*)(MGB + (size_t)row * DM + col) = w; } } }
    }
};
struct EpiRes {
    static constexpr bool PERM = false;
    const float* R; float* Y;
    __device__ __forceinline__ void operator()(const f32x4 (&acc)[2][2][4][2], const Unit& u, int wr, int wc, int fr, int fq) const {
        const int row0 = u.pm * BM + wr * 64 + fr, col0 = u.pn * BM + wc * 32 + 4 * fq;
#pragma unroll
        for (int ai = 0; ai < 2; ++ai)
#pragma unroll
            for (int m = 0; m < 4; ++m) { const size_t ro = (size_t)(row0 + ai * HALF + m * 16) * DM + col0;
#pragma unroll
                for (int bj = 0; bj < 2; ++bj)
#pragma unroll
                    for (int n = 0; n < 2; ++n) { const size_t o = ro + bj * HALF + n * 16; *(f32x4*)(Y + o) = *(const f32x4*)(R + o) * ALPHA + acc[ai][bj][m][n]; } }
    }
};
struct EpiSwiGLU {
    static constexpr bool PERM = true;
    bf16_t* O;
    __device__ __forceinline__ void operator()(const f32x4 (&acc)[2][2][4][2], const Unit& u, int wr, int wc, int fr, int fq) const {
        const int row0 = u.pm * BM + wr * 64 + fr, col0 = u.pn * HALF + wc * 32 + 8 * fq;
#pragma unroll
        for (int ai = 0; ai < 2; ++ai)
#pragma unroll
            for (int m = 0; m < 4; ++m) { bf16_t* rowp = O + (size_t)(row0 + ai * HALF + m * 16) * DFF + col0;
                float r[8];
#pragma unroll
                for (int n = 0; n < 2; ++n)
#pragma unroll
                    for (int j = 0; j < 4; ++j) { const float gg = acc[ai][0][m][n][j], uu = acc[ai][1][m][n][j]; r[n * 4 + j] = gg * sigmoidf_(gg) * uu; }
                u32x4 w; w.x = pk2(r[0], r[1]); w.y = pk2(r[2], r[3]); w.z = pk2(r[4], r[5]); w.w = pk2(r[6], r[7]);
                *(u32x4*)rowp = w; }
    }
};
struct EpiScore {
    static constexpr bool PERM = false;
    float* SC;
    __device__ __forceinline__ void operator()(const f32x4 (&acc)[2][2][4][2], const Unit& u, int wr, int wc, int fr, int fq) const {
        const int row0 = u.pm * BM + wr * 64 + fr, col0 = wc * 32 + 4 * fq; float* base = SC + (size_t)u.z * 4096 * 256;
#pragma unroll
        for (int ai = 0; ai < 2; ++ai)
#pragma unroll
            for (int m = 0; m < 4; ++m) { float* rowp = base + (size_t)(row0 + ai * HALF + m * 16) * 256 + col0;
#pragma unroll
                for (int bj = 0; bj < 2; ++bj)
#pragma unroll
                    for (int n = 0; n < 2; ++n) *(f32x4*)(rowp + bj * HALF + n * 16) = acc[ai][bj][m][n] * 0.0625f; }
    }
};
struct EpiPV {
    static constexpr bool PERM = true;
    bf16_t* O;
    __device__ __forceinline__ void operator()(const f32x4 (&acc)[2][2][4][2], const Unit& u, int wr, int wc, int fr, int fq) const {
        const int b = u.z >> 2, h = u.z & 3; const int row0 = b * PS + u.pm * BM + wr * 64 + fr, col0 = h * 256 + wc * 32 + 8 * fq;
#pragma unroll
        for (int ai = 0; ai < 2; ++ai)
#pragma unroll
            for (int m = 0; m < 4; ++m) { bf16_t* rowp = O + (size_t)(row0 + ai * HALF + m * 16) * BW + col0;
#pragma unroll
                for (int bj = 0; bj < 2; ++bj) { const f32x4 v0 = acc[ai][bj][m][0], v1 = acc[ai][bj][m][1];
                    u32x4 w; w.x = pk2(v0[0], v0[1]); w.y = pk2(v0[2], v0[3]); w.z = pk2(v1[0], v1[1]); w.w = pk2(v1[2], v1[3]);
                    *(u32x4*)(rowp + bj * HALF) = w; } }
    }
};
}


#define XB_TMO      128
#define XB_XCNT(j)  (256  + 64 * (j))
#define XB_XSUB(j)  (1280 + 64 * (j))
#define XB_XGEN(j)  (2304 + 64 * (j))
#define XB_TOP      3328
#define XB_TOPGEN   3392
#define XCD_BAR_WORDS 3456
#define XB_SPIN_CAP (1u << 18)
__device__ __forceinline__ unsigned xb_ld(unsigned* p)              { return __hip_atomic_load(p, __ATOMIC_RELAXED, __HIP_MEMORY_SCOPE_AGENT); }
__device__ __forceinline__ unsigned xb_add(unsigned* p, unsigned v) { return __hip_atomic_fetch_add(p, v, __ATOMIC_RELAXED, __HIP_MEMORY_SCOPE_AGENT); }
__device__ __forceinline__ unsigned xb_xcc_id() { return (unsigned)__builtin_amdgcn_s_getreg((3 << 11) | 20) & 0xFu; }
#define XB_SPIN(cond, bar) do { unsigned _sp = 0; while (cond) { __builtin_amdgcn_s_sleep(1); \
    if ((++_sp & 255u) == 0u) { if (xb_ld(&(bar)[XB_TMO])) break; if (_sp > XB_SPIN_CAP) { atomicAdd(&(bar)[XB_TMO], 1u); break; } } } } while (0)
struct XcdBarrier { unsigned* bar; unsigned x; volatile LAS unsigned* st; };
__device__ __forceinline__ XcdBarrier xcd_barrier_post(unsigned* bar, volatile LAS unsigned* st) {
    XcdBarrier b; b.bar = bar; b.x = xb_xcc_id(); b.st = st;
    if (threadIdx.x == 0) (void)xb_add(&bar[XB_XCNT(b.x)], 1u);
    return b;
}
__device__ __forceinline__ void xcd_barrier_complete(unsigned* bar, unsigned x, unsigned& nloc, unsigned& nx) {
    const unsigned G = gridDim.x * gridDim.y * gridDim.z;
    unsigned sum, cnt, mine, sp = 0u;
    for (;;) {
        sum = 0u; cnt = 0u; mine = 0u;
#pragma unroll
        for (unsigned j = 0; j < 16; ++j) { const unsigned c = xb_ld(&bar[XB_XCNT(j)]); sum += c; cnt += (c > 0u) ? 1u : 0u; mine = (j == x) ? c : mine; }
        if (sum == G) break;
        __builtin_amdgcn_s_sleep(1);
        if ((++sp & 255u) == 0u) { if (xb_ld(&bar[XB_TMO])) break; if (sp > XB_SPIN_CAP) { atomicAdd(&bar[XB_TMO], 1u); break; } }
    }
    nloc = mine > 0u ? mine : 1u; nx = cnt > 0u ? cnt : 1u;
}
__device__ __forceinline__ void xcd_barrier(const XcdBarrier& b) {
    asm volatile("s_waitcnt vmcnt(0)" ::: "memory");
    __syncthreads();
    if (threadIdx.x == 0) {
        unsigned* bar = b.bar;
        __builtin_amdgcn_s_waitcnt(0);
        unsigned nloc = b.st[0], nx = b.st[1];
        if (nloc == 0u) { xcd_barrier_complete(bar, b.x, nloc, nx); b.st[0] = nloc; b.st[1] = nx; }
        const unsigned old = xb_add(&bar[XB_XSUB(b.x)], 1u);
        const unsigned gen = old / nloc;
        if (old + 1u == (gen + 1u) * nloc) {
            __builtin_amdgcn_fence(__ATOMIC_RELEASE, "agent");
            asm volatile("s_waitcnt vmcnt(0)" ::: "memory");
            const unsigned og = xb_add(&bar[XB_TOP], 1u);
            const unsigned tg = og / nx;
            if (og + 1u == (tg + 1u) * nx) xb_add(&bar[XB_TOPGEN], 1u);
            else XB_SPIN(xb_ld(&bar[XB_TOPGEN]) == tg, bar);
            __builtin_amdgcn_fence(__ATOMIC_ACQUIRE, "agent");
            xb_add(&bar[XB_XGEN(b.x)], 1u);
            asm volatile("s_waitcnt vmcnt(0)" ::: "memory");
        } else {
            XB_SPIN(xb_ld(&bar[XB_XGEN(b.x)]) == gen, bar);
            __builtin_amdgcn_fence(__ATOMIC_ACQUIRE, "agent");
            asm volatile("s_waitcnt vmcnt(0)" ::: "memory");
        }
    }
    __syncthreads();
}

struct Ctx { int tid, lane, wave, bid, G; LAS unsigned char* lds; };
__device__ __forceinline__ Ctx fresh(const Ctx& c0) { Ctx c; c.wave = c0.wave; c.bid = c0.bid; c.G = c0.G; c.lds = c0.lds; asm volatile("" : "+s"(c.bid), "+s"(c.G), "+s"(c.wave));
    int lane = (int)__builtin_amdgcn_mbcnt_hi(~0u, __builtin_amdgcn_mbcnt_lo(~0u, 0u)); asm volatile("" : "+v"(lane)); c.lane = lane; c.tid = c.wave * 64 + lane; return c; }

__device__ __forceinline__ int colmap(int mode, int n) {
    if (mode == 1) return n < 3088 ? n : (n < 3328 ? -1 : n - 240);
    if (mode == 2) { const int t = n >> 8, j = n & 255; return j < 128 ? t * 128 + j : DFF + t * 128 + (j - 128); }
    return n;
}
__device__ __forceinline__ void ph_wprep(const Ctx& c, const float* __restrict__ src, bf16_t* __restrict__ dst, int K, int Nsrc, int Ndst, int mode, int nbatch, size_t sbs, size_t dbs) {
    LAS float* tile = (LAS float*)c.lds;
    const int nx = Ndst / 64, ny = K / 64, total = nx * ny * nbatch;
    const int tx = c.tid & 63, ty = c.tid >> 6, r = c.tid >> 3, p = c.tid & 7;
    for (int t = c.bid; t < total; t += c.G) {
        const int bx = t % nx, by = (t / nx) % ny, bz = t / (nx * ny);
        const float* s = src + (size_t)bz * sbs; bf16_t* d = dst + (size_t)bz * dbs;
        const int n0 = bx * 64, k0 = by * 64, cm = colmap(mode, n0 + tx);
        for (int kk = ty; kk < 64; kk += 8) tile[kk * 65 + tx] = cm >= 0 ? s[(size_t)(k0 + kk) * Nsrc + cm] : 0.f;
        __syncthreads();
        { u32x4 w; w.x = pk2(tile[(p * 8 + 0) * 65 + r], tile[(p * 8 + 1) * 65 + r]); w.y = pk2(tile[(p * 8 + 2) * 65 + r], tile[(p * 8 + 3) * 65 + r]);
          w.z = pk2(tile[(p * 8 + 4) * 65 + r], tile[(p * 8 + 5) * 65 + r]); w.w = pk2(tile[(p * 8 + 6) * 65 + r], tile[(p * 8 + 7) * 65 + r]);
          *(u32x4*)(d + (size_t)(n0 + r) * K + k0 + p * 8) = w; }
        __syncthreads();
    }
}
__device__ __forceinline__ void ph_xprep(const Ctx& c, const float* __restrict__ xp, const float* __restrict__ xs, const float* __restrict__ mem, float* __restrict__ HF, bf16_t* __restrict__ HB, bf16_t* __restrict__ MEMB) {
    const size_t nH = (size_t)MPAD * DM / 4, nM = (size_t)512 * DM / 4;
    for (size_t i4 = (size_t)c.bid * 512 + c.tid; i4 < nH + nM; i4 += (size_t)c.G * 512) {
        if (i4 < nH) {
            const size_t e = i4 * 4; f32x4 v = (f32x4){0.f, 0.f, 0.f, 0.f};
            if (e < (size_t)MP * DM) v = *(const f32x4*)(xp + e); else if (e < (size_t)MT * DM) v = *(const f32x4*)(xs + (e - (size_t)MP * DM));
            *(f32x4*)(HF + e) = v; u32x2 w; w.x = pk2(v[0], v[1]); w.y = pk2(v[2], v[3]); *(u32x2*)(HB + e) = w;
        } else {
            const size_t e = (i4 - nH) * 4; const f32x4 v = *(const f32x4*)(mem + e); u32x2 w; w.x = pk2(v[0], v[1]); w.y = pk2(v[2], v[3]); *(u32x2*)(MEMB + e) = w;
        }
    }
}
__device__ __forceinline__ void ph_ln(const Ctx& c, const float* __restrict__ Y, const float* __restrict__ g, const float* __restrict__ b, float* __restrict__ XF, bf16_t* __restrict__ XB, float* __restrict__ OUT, int nrows, int nout) {
    const int lane = c.lane;
    for (int row = c.bid * 8 + c.wave; row < nrows; row += c.G * 8) {
        const float* y = Y + (size_t)row * DM; f32x4 v[8]; float s = 0.f;
#pragma unroll
        for (int j = 0; j < 8; ++j) { v[j] = *(const f32x4*)(y + j * 256 + lane * 4); s += (v[j][0] + v[j][1]) + (v[j][2] + v[j][3]); }
        const float mean = wave_sum(s) * (1.0f / DM); float q = 0.f;
#pragma unroll
        for (int j = 0; j < 8; ++j) { const f32x4 d = v[j] - mean; q += (d[0] * d[0] + d[1] * d[1]) + (d[2] * d[2] + d[3] * d[3]); }
        const float rstd = rsqrtf(wave_sum(q) * (1.0f / DM) + 1e-5f);
#pragma unroll
        for (int j = 0; j < 8; ++j) { const int cc = j * 256 + lane * 4; const f32x4 gg = *(const f32x4*)(g + cc), bb = *(const f32x4*)(b + cc);
            const f32x4 o = (v[j] - mean) * rstd * gg + bb; const size_t off = (size_t)row * DM + cc;
            *(f32x4*)(XF + off) = o; u32x2 w; w.x = pk2(o[0], o[1]); w.y = pk2(o[2], o[3]); *(u32x2*)(XB + off) = w;
            if (OUT != nullptr && row < nout) *(f32x4*)(OUT + off) = o; }
    }
}
__device__ __forceinline__ void ph_softmax256(const Ctx& c, const float* __restrict__ SC, bf16_t* __restrict__ P, int nrows) {
    const int lane = c.lane;
    for (int row = c.bid * 8 + c.wave; row < nrows; row += c.G * 8) {
        const f32x4 v = *(const f32x4*)(SC + (size_t)row * 256 + lane * 4);
        const float mx = wave_max(fmaxf(fmaxf(v[0], v[1]), fmaxf(v[2], v[3])));
        f32x4 e; e[0] = __expf(v[0] - mx); e[1] = __expf(v[1] - mx); e[2] = __expf(v[2] - mx); e[3] = __expf(v[3] - mx);
        const float inv = 1.0f / wave_sum((e[0] + e[1]) + (e[2] + e[3]));
        u32x2 w; w.x = pk2(e[0] * inv, e[1] * inv); w.y = pk2(e[2] * inv, e[3] * inv); *(u32x2*)(P + (size_t)row * 256 + lane * 4) = w;
    }
}
__device__ __forceinline__ void ph_copy_outs(const Ctx& c, const bf16_t* __restrict__ U, const float* __restrict__ ck, const float* __restrict__ cv, float* __restrict__ out, int layer) {
    constexpr int nA = PB * 128 * 128, nB = SB * 128 * 128, nC = PB * RWC, nD = SB * RWC;
    for (int i = c.bid * 512 + c.tid; i < nA + nB + nC + nD; i += c.G * 512) {
        if (i < nA) { const int b = i / 16384, j = (i >> 7) & 127, cc = i & 127; const size_t ur = (size_t)(b * PS + PS - 128 + j) * NINP;
            out[O_SWKP + (size_t)layer * nA + i] = bf2f(U[ur + U_SK + cc]); out[O_SWVP + (size_t)layer * nA + i] = bf2f(U[ur + U_SV + cc]); continue; }
        int k = i - nA;
        if (k < nB) { const int sq = k / 16384, j = (k >> 7) & 127, cc = k & 127; float kv, vv;
            if (j < 124) { const size_t o = ((size_t)sq * 128 + j + 4) * 128 + cc; kv = ck[o]; vv = cv[o]; }
            else { const size_t ur = (size_t)(MP + sq * SS + j - 124) * NINP; kv = bf2f(U[ur + U_SK + cc]); vv = bf2f(U[ur + U_SV + cc]); }
            out[O_SWKS + (size_t)layer * nB + k] = kv; out[O_SWVS + (size_t)layer * nB + k] = vv; continue; }
        k -= nB;
        if (k < nC) { const int b = k / RWC, cc = k - b * RWC; out[O_RSP + (size_t)layer * nC + k] = bf2f(U[(size_t)(b * PS + PS - 1) * NINP + U_RU + cc]); continue; }
        k -= nC;
        { const int sq = k / RWC, cc = k - sq * RWC; out[O_RSS + (size_t)layer * nD + k] = bf2f(U[(size_t)(MP + sq * SS + SS - 1) * NINP + U_RU + cc]); }
    }
}

__device__ __forceinline__ void seq_info(int sq, int& row0, int& L) { if (sq < PB) { row0 = sq * PS; L = PS; } else { row0 = MP + (sq - PB) * SS; L = SS; } }

__device__ __forceinline__ void ph_gla_naive(const Ctx& c, const bf16_t* __restrict__ U, const float* __restrict__ s0, const float* __restrict__ a_up, const float* __restrict__ a_b,
                                             const float* __restrict__ ng, const float* __restrict__ nb, bf16_t* __restrict__ OB, float* __restrict__ outP, float* __restrict__ outS) {
    LAS float* qs = (LAS float*)c.lds;
    LAS float* ks = qs + 16 * 128; LAS float* as = ks + 16 * 128; LAS float* os = as + 16 * 128;
    const int kh = c.tid >> 8, vt = c.tid & 255, lane = c.lane;
    for (int u = c.bid; u < (PB + SB) * 4; u += c.G) {
        const int sq = u >> 2, h = u & 3;
        int row0, L; seq_info(sq, row0, L);
        float S[64];
        if (sq >= PB) { const float* p = s0 + (((size_t)(sq - PB) * 4 + h) * 128 + kh * 64) * 256 + vt;
#pragma unroll
            for (int kk = 0; kk < 64; ++kk) S[kk] = p[(size_t)kk * 256]; }
        else {
#pragma unroll
            for (int kk = 0; kk < 64; ++kk) S[kk] = 0.f; }
        for (int t0 = 0; t0 < L; t0 += 16) {
            const int nT = (L - t0) < 16 ? (L - t0) : 16;
            for (int idx = c.tid; idx < nT * 128; idx += 512) {
                const int tt = idx >> 7, kk = idx & 127; const bf16_t* ur = U + (size_t)(row0 + t0 + tt) * NINP;
                qs[idx] = bf2f(ur[U_GQ + h * 128 + kk]) * 0.08838834764831845f; ks[idx] = bf2f(ur[U_GK + h * 128 + kk]);
                float x = a_b[h * 128 + kk];
#pragma unroll
                for (int r = 0; r < 16; ++r) x += bf2f(ur[U_GA + r]) * a_up[r * 512 + h * 128 + kk];
                const float ls = (fminf(x, 0.f) - log1pf(__expf(-fabsf(x)))) * (1.0f / 16.0f);
                as[idx] = __expf(ls);
            }
            __syncthreads();
            for (int tt = 0; tt < nT; ++tt) {
                const float v = bf2f(U[(size_t)(row0 + t0 + tt) * NINP + U_GV + h * 256 + vt]); float o = 0.f; const int lb = tt * 128 + kh * 64;
#pragma unroll
                for (int kk = 0; kk < 64; ++kk) { S[kk] = as[lb + kk] * S[kk] + ks[lb + kk] * v; o += qs[lb + kk] * S[kk]; }
                os[(kh * 16 + tt) * 256 + vt] = o;
            }
            __syncthreads();
            for (int tt = c.wave; tt < nT; tt += 8) {
                float x[4]; float s = 0.f;
#pragma unroll
                for (int j = 0; j < 4; ++j) { x[j] = os[tt * 256 + lane + 64 * j] + os[(16 + tt) * 256 + lane + 64 * j]; s += x[j]; }
                const float mean = wave_sum(s) * (1.0f / 256.0f); float q = 0.f;
#pragma unroll
                for (int j = 0; j < 4; ++j) { const float d = x[j] - mean; q += d * d; }
                const float rstd = rsqrtf(wave_sum(q) * (1.0f / 256.0f) + 1e-5f);
                const size_t row = (size_t)(row0 + t0 + tt);
#pragma unroll
                for (int j = 0; j < 4; ++j) { const int cc = h * 256 + lane + 64 * j; const float n = (x[j] - mean) * rstd * ng[cc] + nb[cc];
                    const float gr = bf2f(U[row * NINP + U_GR + cc]); OB[row * BW + cc] = f2bf(n * gr * sigmoidf_(gr)); }
            }
            __syncthreads();
        }
        float* op = (sq < PB ? outP + (((size_t)sq * 4 + h) * 128 + kh * 64) * 256 : outS + (((size_t)(sq - PB) * 4 + h) * 128 + kh * 64) * 256) + vt;
#pragma unroll
        for (int kk = 0; kk < 64; ++kk) op[(size_t)kk * 256] = S[kk];
    }
}

__device__ __forceinline__ f32x4 mma16(bf16x8 x, bf16x8 y, f32x4 c) { return __builtin_amdgcn_mfma_f32_16x16x32_bf16(x, y, c, 0, 0, 0); }
__device__ __forceinline__ bf16x8 pack_acc(const f32x4& a, const f32x4& b) {
    u32x4 p; p.x = pk2(a[0], a[1]); p.y = pk2(a[2], a[3]); p.z = pk2(b[0], b[1]); p.w = pk2(b[2], b[3]); return __builtin_bit_cast(bf16x8, p);
}
__device__ __forceinline__ void gla_chunk_info(int u, int& row0, int& ntok, int& h) {
    if (u < 512) { const int b = u >> 8; h = (u >> 6) & 3; row0 = b * PS + (u & 63) * 64; ntok = 64; }
    else { const int s = u - 512; h = s & 3; row0 = MP + (s >> 2) * SS; ntok = SS; }
}
__device__ __forceinline__ void ph_gla_pre(const Ctx& c, const bf16_t* __restrict__ U, const float* __restrict__ a_up, const float* __restrict__ a_b,
                                           bf16_t* __restrict__ QD, bf16_t* __restrict__ KHT, bf16_t* __restrict__ EE, bf16_t* __restrict__ VT, float* __restrict__ GC) {
    LAS float* ga_l = (LAS float*)c.lds;
    LAS float* tot = ga_l + 64 * 16;
    LAS bf16_t* Qd_l = (LAS bf16_t*)(tot + 4 * 128);
    LAS bf16_t* Kn_l = Qd_l + 64 * 136;
    LAS bf16_t* v_l = Kn_l + 64 * 136;
    const int tid = c.tid, lane = c.lane, r = lane & 15, q = lane >> 4, w = c.wave;
    for (int u = c.bid; u < GL_NCH; u += c.G) {
        int row0, ntok, h; gla_chunk_info(u, row0, ntok, h);
        for (int i = tid; i < 64 * 16; i += 512) { const int t = i >> 4, rr = i & 15; ga_l[i] = t < ntok ? bf2f(U[(size_t)(row0 + t) * NINP + U_GA + rr]) : 0.f; }
        for (int i = tid; i < 64 * 32; i += 512) { const int t = i >> 5, c8 = i & 31; u32x4 vv = (u32x4){0u, 0u, 0u, 0u};
            if (t < ntok) vv = *(const u32x4*)(U + (size_t)(row0 + t) * NINP + U_GV + h * 256 + c8 * 8);
            *(LAS u32x4*)(v_l + t * 264 + c8 * 8) = vv; }
        __syncthreads();
        const int kk = tid & 127, tq = tid >> 7;
        float cum[16];
        { float aup[16];
#pragma unroll
          for (int rr = 0; rr < 16; ++rr) aup[rr] = a_up[rr * 512 + h * 128 + kk];
          const float ab = a_b[h * 128 + kk]; float run = 0.f;
#pragma unroll
          for (int j = 0; j < 16; ++j) { const int t = tq * 16 + j; float x = ab;
#pragma unroll
              for (int rr = 0; rr < 16; ++rr) x += ga_l[t * 16 + rr] * aup[rr];
              const float la = t < ntok ? (fminf(x, 0.f) - log1pf(__expf(-fabsf(x)))) * (1.0f / 16.0f) : 0.f;
              run += la; cum[j] = run; }
          tot[tq * 128 + kk] = run; }
        __syncthreads();
        { float prefix = 0.f, bC = 0.f;
#pragma unroll
          for (int g = 0; g < 4; ++g) { const float tv = tot[g * 128 + kk]; bC += tv; if (g < tq) prefix += tv; }
          unsigned khp[8];
#pragma unroll
          for (int j = 0; j < 16; j += 2) { float kh2[2];
#pragma unroll
              for (int e = 0; e < 2; ++e) { const int t = tq * 16 + j + e; const float b = prefix + cum[j + e]; float qv = 0.f, kv = 0.f;
                  if (t < ntok) { const bf16_t* ur = U + (size_t)(row0 + t) * NINP; qv = bf2f(ur[U_GQ + h * 128 + kk]); kv = bf2f(ur[U_GK + h * 128 + kk]); }
                  Qd_l[t * 136 + kk] = f2bf(qv * __expf(b) * 0.08838834764831845f); Kn_l[t * 136 + kk] = f2bf(kv * __expf(-b)); kh2[e] = kv * __expf(bC - b); }
              khp[j >> 1] = pk2(kh2[0], kh2[1]); }
          bf16_t* kp = KHT + (size_t)u * 8192 + kk * 64 + tq * 16;
          *(u32x4*)kp = (u32x4){khp[0], khp[1], khp[2], khp[3]}; *(u32x4*)(kp + 8) = (u32x4){khp[4], khp[5], khp[6], khp[7]};
          if (tq == 0) GC[(size_t)u * 128 + kk] = __expf(bC); }
        __syncthreads();
        { const int tb = w >> 1;
#pragma unroll
          for (int e = 0; e < 2; ++e) { const int ib = (w & 1) * 2 + e; f32x4 d = (f32x4){0.f, 0.f, 0.f, 0.f};
              if (ib <= tb) {
#pragma unroll
                  for (int ks = 0; ks < 4; ++ks) d = mma16(*(const LAS bf16x8*)(Kn_l + (ib * 16 + r) * 136 + ks * 32 + q * 8), *(const LAS bf16x8*)(Qd_l + (tb * 16 + r) * 136 + ks * 32 + q * 8), d); }
              const int t = tb * 16 + r, i0 = ib * 16 + q * 4;
#pragma unroll
              for (int jj = 0; jj < 4; ++jj) if (i0 + jj > t) d[jj] = 0.f;
              u32x2 o; o.x = pk2(d[0], d[1]); o.y = pk2(d[2], d[3]); *(u32x2*)(EE + (size_t)u * 4096 + t * 64 + i0) = o; } }
        for (int i = tid; i < 64 * 16; i += 512) { const int t = i >> 4, c8 = i & 15; *(u32x4*)(QD + (size_t)u * 8192 + t * 128 + c8 * 8) = *(const LAS u32x4*)(Qd_l + t * 136 + c8 * 8); }
        { const int val = tid & 255, th = tid >> 8;
#pragma unroll
          for (int tg = 0; tg < 4; ++tg) { const int t0 = th * 32 + tg * 8; unsigned p4[4];
#pragma unroll
              for (int e = 0; e < 4; ++e) p4[e] = (unsigned)v_l[(t0 + 2 * e) * 264 + val] | ((unsigned)v_l[(t0 + 2 * e + 1) * 264 + val] << 16);
              *(u32x4*)(VT + (size_t)u * 16384 + val * 64 + t0) = (u32x4){p4[0], p4[1], p4[2], p4[3]}; } }
        __syncthreads();
    }
}
struct GlaFrag { bf16x8 qd[4], e[2], kh[2], vt[4][2]; f32x4 gc; };
__device__ __forceinline__ void gla_load_frag(GlaFrag& f, const bf16_t* __restrict__ QD, const bf16_t* __restrict__ KHT, const bf16_t* __restrict__ EE, const bf16_t* __restrict__ VT, const float* __restrict__ GC,
                                              int ch, int sl, int w, int r, int q) {
    const int rb = w >> 1;
#pragma unroll
    for (int ks = 0; ks < 4; ++ks) f.qd[ks] = *(const bf16x8*)(QD + (size_t)ch * 8192 + (rb * 16 + r) * 128 + ks * 32 + q * 8);
#pragma unroll
    for (int ks = 0; ks < 2; ++ks) { f.e[ks] = *(const bf16x8*)(EE + (size_t)ch * 4096 + (rb * 16 + r) * 64 + ks * 32 + q * 8);
        f.kh[ks] = *(const bf16x8*)(KHT + (size_t)ch * 8192 + (w * 16 + r) * 64 + ks * 32 + q * 8);
#pragma unroll
        for (int vb = 0; vb < 4; ++vb) f.vt[vb][ks] = *(const bf16x8*)(VT + (size_t)ch * 16384 + (sl * 64 + vb * 16 + r) * 64 + ks * 32 + q * 8); }
    f.gc = *(const f32x4*)(GC + (size_t)ch * 128 + w * 16 + q * 4);
}
__device__ __forceinline__ void ph_gla_seq(const Ctx& c, int boff, const bf16_t* __restrict__ QD, const bf16_t* __restrict__ KHT, const bf16_t* __restrict__ EE, const bf16_t* __restrict__ VT, const float* __restrict__ GC,
                                           const float* __restrict__ s0, float* __restrict__ outP, float* __restrict__ outS, bf16_t* __restrict__ OB) {
    LAS bf16_t* T_l = (LAS bf16_t*)c.lds;
    const int lane = c.lane, r = lane & 15, q = lane >> 4, w = c.wave;
    for (int u = (c.bid - boff + c.G) % c.G; u < 32 + 512; u += c.G) {
        int h, sl, nch, ch0, row0, ntok; const float* sp = nullptr; float* op;
        if (u < 32) { const int b = u >> 4; h = (u >> 2) & 3; sl = u & 3; nch = 64; ch0 = (b * 4 + h) * 64; row0 = b * PS; ntok = 64; op = outP + (size_t)(b * 4 + h) * 32768; }
        else { const int s = u - 32, sq = s >> 4; h = (s >> 2) & 3; sl = s & 3; nch = 1; ch0 = 512 + sq * 4 + h; row0 = MP + sq * SS; ntok = SS; sp = s0 + (size_t)(sq * 4 + h) * 32768; op = outS + (size_t)(sq * 4 + h) * 32768; }
        f32x4 acc[4];
#pragma unroll
        for (int vb = 0; vb < 4; ++vb)
#pragma unroll
            for (int jj = 0; jj < 4; ++jj) acc[vb][jj] = sp ? sp[(size_t)(w * 16 + q * 4 + jj) * 256 + sl * 64 + vb * 16 + r] : 0.f;
        GlaFrag cur; gla_load_frag(cur, QD, KHT, EE, VT, GC, ch0, sl, w, r, q);
        for (int ci = 0; ci < nch; ++ci) {
            GlaFrag nxt; if (ci + 1 < nch) gla_load_frag(nxt, QD, KHT, EE, VT, GC, ch0 + ci + 1, sl, w, r, q); else nxt = cur;
            LAS bf16_t* Tb = T_l + (ci & 1) * 64 * 136;
#pragma unroll
            for (int vb = 0; vb < 4; ++vb) { u32x2 o; o.x = pk2(acc[vb][0], acc[vb][1]); o.y = pk2(acc[vb][2], acc[vb][3]); *(LAS u32x2*)(Tb + (vb * 16 + r) * 136 + w * 16 + q * 4) = o; }
            __syncthreads();
            { const int rb = w >> 1, t = rb * 16 + r;
#pragma unroll
              for (int e = 0; e < 2; ++e) { const int cb = (w & 1) * 2 + e; f32x4 y = (f32x4){0.f, 0.f, 0.f, 0.f};
#pragma unroll
                  for (int ks = 0; ks < 4; ++ks) y = mma16(*(const LAS bf16x8*)(Tb + (cb * 16 + r) * 136 + ks * 32 + q * 8), cur.qd[ks], y);
#pragma unroll
                  for (int ks = 0; ks < 2; ++ks) y = mma16(e == 0 ? ((w & 1) ? cur.vt[2][ks] : cur.vt[0][ks]) : ((w & 1) ? cur.vt[3][ks] : cur.vt[1][ks]), cur.e[ks], y);
                  if (t < ntok) { u32x2 o; o.x = pk2(y[0], y[1]); o.y = pk2(y[2], y[3]); *(u32x2*)(OB + (size_t)(row0 + ci * 64 + t) * BW + h * 256 + sl * 64 + cb * 16 + q * 4) = o; } } }
#pragma unroll
            for (int vb = 0; vb < 4; ++vb) { acc[vb] = acc[vb] * cur.gc;
#pragma unroll
                for (int ks = 0; ks < 2; ++ks) acc[vb] = mma16(cur.kh[ks], cur.vt[vb][ks], acc[vb]); }
            cur = nxt;
        }
#pragma unroll
        for (int vb = 0; vb < 4; ++vb)
#pragma unroll
            for (int jj = 0; jj < 4; ++jj) op[(size_t)(w * 16 + q * 4 + jj) * 256 + sl * 64 + vb * 16 + r] = acc[vb][jj];
        __syncthreads();
    }
}
__device__ __forceinline__ void ph_gla_fin(const Ctx& c, const bf16_t* __restrict__ U, const float* __restrict__ ng, const float* __restrict__ nb, bf16_t* __restrict__ OB) {
    const int lane = c.lane;
    for (int i = c.bid * 8 + c.wave; i < MT * 4; i += c.G * 8) {
        const int row = i >> 2, h = i & 3, cc = h * 256 + lane * 4; bf16_t* p = OB + (size_t)row * BW + cc;
        const u32x2 raw = *(const u32x2*)p; float x[4] = {__uint_as_float(raw.x << 16), __uint_as_float(raw.x & 0xffff0000u), __uint_as_float(raw.y << 16), __uint_as_float(raw.y & 0xffff0000u)};
        const float mean = wave_sum((x[0] + x[1]) + (x[2] + x[3])) * (1.0f / 256.0f); float qq = 0.f;
#pragma unroll
        for (int j = 0; j < 4; ++j) { const float d = x[j] - mean; qq += d * d; }
        const float rstd = rsqrtf(wave_sum(qq) * (1.0f / 256.0f) + 1e-5f);
        const u32x2 gp = *(const u32x2*)(U + (size_t)row * NINP + U_GR + cc); const float gr[4] = {__uint_as_float(gp.x << 16), __uint_as_float(gp.x & 0xffff0000u), __uint_as_float(gp.y << 16), __uint_as_float(gp.y & 0xffff0000u)};
        const f32x4 gg = *(const f32x4*)(ng + cc), bb = *(const f32x4*)(nb + cc); float o[4];
#pragma unroll
        for (int j = 0; j < 4; ++j) o[j] = ((x[j] - mean) * rstd * gg[j] + bb[j]) * gr[j] * sigmoidf_(gr[j]);
        u32x2 ov; ov.x = pk2(o[0], o[1]); ov.y = pk2(o[2], o[3]); *(u32x2*)p = ov;
    }
}

__device__ __forceinline__ void unpack8(const u32x4 w, float (&x)[8]) {
    x[0] = __uint_as_float(w.x << 16); x[1] = __uint_as_float(w.x & 0xffff0000u); x[2] = __uint_as_float(w.y << 16); x[3] = __uint_as_float(w.y & 0xffff0000u);
    x[4] = __uint_as_float(w.z << 16); x[5] = __uint_as_float(w.z & 0xffff0000u); x[6] = __uint_as_float(w.w << 16); x[7] = __uint_as_float(w.w & 0xffff0000u);
}
template <bool ISBF> __device__ __forceinline__ void swa_step(const float (&q)[32], float (&acc)[32], float& m, float& l, const void* kp, const void* vp, float slope, float dist) {
    float s = 0.f;
#pragma unroll
    for (int j = 0; j < 4; ++j) { float x[8];
        if (ISBF) unpack8(*(const u32x4*)((const bf16_t*)kp + j * 8), x);
        else { const f32x4 a = *(const f32x4*)((const float*)kp + j * 8), b = *(const f32x4*)((const float*)kp + j * 8 + 4); x[0] = a[0]; x[1] = a[1]; x[2] = a[2]; x[3] = a[3]; x[4] = b[0]; x[5] = b[1]; x[6] = b[2]; x[7] = b[3]; }
#pragma unroll
        for (int d = 0; d < 8; ++d) s += q[j * 8 + d] * x[d]; }
    s += __shfl_xor(s, 1, 64);
    s = s * 0.125f - slope * dist;
    const float mn = fmaxf(m, s), cc = __expf(m - mn), p = __expf(s - mn);
    l = l * cc + p;
#pragma unroll
    for (int j = 0; j < 4; ++j) { float x[8];
        if (ISBF) unpack8(*(const u32x4*)((const bf16_t*)vp + j * 8), x);
        else { const f32x4 a = *(const f32x4*)((const float*)vp + j * 8), b = *(const f32x4*)((const float*)vp + j * 8 + 4); x[0] = a[0]; x[1] = a[1]; x[2] = a[2]; x[3] = a[3]; x[4] = b[0]; x[5] = b[1]; x[6] = b[2]; x[7] = b[3]; }
#pragma unroll
        for (int d = 0; d < 8; ++d) acc[j * 8 + d] = acc[j * 8 + d] * cc + p * x[d]; }
    m = mn;
}
__device__ __forceinline__ void ph_swa_naive(const Ctx& c, const bf16_t* __restrict__ U, const float* __restrict__ ck, const float* __restrict__ cv, const float* __restrict__ sinks, bf16_t* __restrict__ OB) {
    for (int gid = c.bid * 512 + c.tid; gid < MS * 32; gid += c.G * 512) {
        const int dh = gid & 1, h = (gid >> 1) & 15, row = MP + (gid >> 5), kvh = h >> 3, co = kvh * 64 + dh * 32;
        float q[32], acc[32];
#pragma unroll
        for (int j = 0; j < 4; ++j) { float x[8]; unpack8(*(const u32x4*)(U + (size_t)row * NINP + U_SQ + h * 64 + dh * 32 + j * 8), x);
#pragma unroll
            for (int d = 0; d < 8; ++d) { q[j * 8 + d] = x[d]; acc[j * 8 + d] = 0.f; } }
        const float slope = exp2f(-0.5f * (float)(h + 1)); float m = sinks[h], l = 1.0f;
        if (row < MP) {
            const int t = row % PS, base = row - t, lo = t - 128 < 0 ? 0 : t - 128;
            for (int s = lo; s <= t; ++s) { const bf16_t* ur = U + (size_t)(base + s) * NINP;
                swa_step<true>(q, acc, m, l, ur + U_SK + co, ur + U_SV + co, slope, (float)(t - s)); }
        } else {
            const int sq = (row - MP) / SS, i = (row - MP) % SS;
            for (int idx = i; idx <= 128 + i; ++idx) {
                if (idx < 128) { const size_t o = ((size_t)sq * 128 + idx) * 128 + co; swa_step<false>(q, acc, m, l, ck + o, cv + o, slope, (float)(128 + i - idx)); }
                else { const bf16_t* ur = U + (size_t)(MP + sq * SS + idx - 128) * NINP; swa_step<true>(q, acc, m, l, ur + U_SK + co, ur + U_SV + co, slope, (float)(128 + i - idx)); }
            }
        }
        const float inv = 1.0f / l; bf16_t* op = OB + (size_t)row * BW + h * 64 + dh * 32;
#pragma unroll
        for (int j = 0; j < 4; ++j) { u32x4 w; w.x = pk2(acc[j * 8] * inv, acc[j * 8 + 1] * inv); w.y = pk2(acc[j * 8 + 2] * inv, acc[j * 8 + 3] * inv);
            w.z = pk2(acc[j * 8 + 4] * inv, acc[j * 8 + 5] * inv); w.w = pk2(acc[j * 8 + 6] * inv, acc[j * 8 + 7] * inv); *(u32x4*)(op + j * 8) = w; }
    }
}

__device__ __forceinline__ void ph_rwkv_prep(const Ctx& c, const bf16_t* __restrict__ U, const float* __restrict__ shift, const float* __restrict__ mu, const float* __restrict__ w0, const float* __restrict__ w2,
                                             const float* __restrict__ a0, const float* __restrict__ a2, const float* __restrict__ g2, const float* __restrict__ k_k, const float* __restrict__ k_a,
                                             const float* __restrict__ r_k, float* __restrict__ RW) {
    LAS float* xm = (LAS float*)c.lds; LAS float* tw = xm + RWC; LAS float* ad = tw + 64; LAS float* sg = ad + 64;
    const int tid = c.tid;
    float* R = RW; float* WD = RW + (size_t)MPAD * BW; float* K2 = WD + (size_t)MPAD * BW; float* V = K2 + (size_t)MPAD * BW; float* KK = V + (size_t)MPAD * BW;
    float* BV = KK + (size_t)MPAD * BW; float* G = BV + (size_t)MPAD * BW; float* BON = G + (size_t)MPAD * BW;
    for (int row = c.bid; row < MT; row += c.G) {
        const bf16_t* ur = U + (size_t)row * NINP + U_RU; const bf16_t* pr = ur - NINP; const float* ps = nullptr; bool first;
        if (row < MP) first = (row % PS) == 0; else { first = ((row - MP) % SS) == 0; ps = shift + (size_t)((row - MP) / SS) * RWC; }
        for (int cc = tid; cc < RWC; cc += 512) { const float x = bf2f(ur[cc]); const float s = first ? (ps ? ps[cc] : 0.f) : bf2f(pr[cc]); xm[cc] = x + (s - x) * mu[cc]; }
        __syncthreads();
        if (tid < 64) { tw[tid] = tanhf(xm[3072 + tid]); ad[tid] = xm[3136 + tid]; }
        if (tid >= 128 && tid < 256) sg[tid - 128] = sigmoidf_(xm[3200 + tid - 128]);
        __syncthreads();
        for (int qd = 0; qd < 2; ++qd) {
            const int cc = qd * 512 + tid; float accw = w0[cc], acca = a0[cc], accg = 0.f;
#pragma unroll 4
            for (int j = 0; j < 64; ++j) { accw += tw[j] * w2[j * BW + cc]; acca += ad[j] * a2[j * BW + cc]; }
#pragma unroll 4
            for (int j = 0; j < 128; ++j) accg += sg[j] * g2[j * BW + cc];
            const float lw = -softplusf_(-accw) - 0.5f, decay = __expf(-__expf(lw)), a = sigmoidf_(acca);
            const float r = xm[cc], k = xm[1024 + cc], v = xm[2048 + cc];
            const float kkr = k * k_k[cc]; const float ss = wave_sum(kkr * kkr); const float kk = kkr / fmaxf(sqrtf(ss), 1e-12f);
            const float k2 = k * (1.0f + (a - 1.0f) * k_a[cc]); const float rk = wave_sum(r * k2 * r_k[cc]);
            const size_t o = (size_t)row * BW + cc;
            R[o] = r; WD[o] = decay; K2[o] = k2; V[o] = v; KK[o] = kk; BV[o] = kk * a; G[o] = accg; BON[o] = rk * v;
        }
        __syncthreads();
    }
}
__device__ __forceinline__ int kperm_pos(int k) { return (k & ~31) + 8 * ((k >> 2) & 3) + 4 * ((k >> 4) & 1) + (k & 3); }
__device__ __forceinline__ void ph_swa_prompt(const Ctx& c, const bf16_t* __restrict__ U, const float* __restrict__ sinks, bf16_t* __restrict__ OB) {
    LAS bf16_t* K_l = (LAS bf16_t*)c.lds;
    LAS bf16_t* VT_l = K_l + 192 * 72;
    const int tid = c.tid, lane = c.lane, r = lane & 15, q = lane >> 4, w = c.wave;
    for (int u = c.bid; u < PB * 64 * 2; u += c.G) {
        const int b = u >> 7, qb = (u >> 1) & 63, kvh = u & 1, h = kvh * 8 + w;
        const int tok0 = qb * 64 - 128;
        const size_t seq0 = (size_t)b * PS;
        for (int idx = tid; idx < 192 * 8; idx += 512) { const int kl = idx >> 3, c8 = idx & 7, tk = tok0 + kl; u32x4 kv = (u32x4){0u, 0u, 0u, 0u}, vv = kv;
            if (tk >= 0) { const bf16_t* ur = U + (seq0 + tk) * NINP; kv = *(const u32x4*)(ur + U_SK + kvh * 64 + c8 * 8); vv = *(const u32x4*)(ur + U_SV + kvh * 64 + c8 * 8); }
            *(LAS u32x4*)(K_l + kl * 72 + c8 * 8) = kv;
            const int kp = kperm_pos(kl); LAS bf16_t* vp = VT_l + (c8 * 8) * 200 + kp;
            vp[0] = (bf16_t)(vv.x & 0xffffu); vp[200] = (bf16_t)(vv.x >> 16); vp[400] = (bf16_t)(vv.y & 0xffffu); vp[600] = (bf16_t)(vv.y >> 16);
            vp[800] = (bf16_t)(vv.z & 0xffffu); vp[1000] = (bf16_t)(vv.z >> 16); vp[1200] = (bf16_t)(vv.w & 0xffffu); vp[1400] = (bf16_t)(vv.w >> 16); }
        __syncthreads();
        const float slope = exp2f(-0.5f * (float)(h + 1)), sink = sinks[h];
#pragma unroll 1
        for (int i = 0; i < 4; ++i) {
            const size_t qrow = seq0 + qb * 64 + i * 16 + r;
            const bf16x8 qf0 = *(const bf16x8*)(U + qrow * NINP + U_SQ + h * 64 + q * 8), qf1 = *(const bf16x8*)(U + qrow * NINP + U_SQ + h * 64 + 32 + q * 8);
            const int kt0 = i & ~1;
            f32x4 s[10]; float mx = sink;
#pragma unroll
            for (int kt = 0; kt < 10; ++kt) { const LAS bf16_t* kp = K_l + ((kt0 + kt) * 16 + r) * 72 + q * 8;
                f32x4 d = mma16(*(const LAS bf16x8*)kp, qf0, (f32x4){0.f, 0.f, 0.f, 0.f}); d = mma16(*(const LAS bf16x8*)(kp + 32), qf1, d);
#pragma unroll
                for (int jj = 0; jj < 4; ++jj) { const int kl = (kt0 + kt) * 16 + q * 4 + jj, dist = i * 16 + r + 128 - kl;
                    const float v = (dist >= 0 && dist <= 128 && tok0 + kl >= 0) ? d[jj] * 0.125f - slope * (float)dist : -1e30f; d[jj] = v; mx = fmaxf(mx, v); }
                s[kt] = d; }
            mx = fmaxf(mx, __shfl_xor(mx, 16, 64)); mx = fmaxf(mx, __shfl_xor(mx, 32, 64));
            float sum = 0.f; bf16x8 pf[5];
#pragma unroll
            for (int kp = 0; kp < 5; ++kp) { f32x4 a = s[2 * kp], bq = s[2 * kp + 1];
#pragma unroll
                for (int jj = 0; jj < 4; ++jj) { a[jj] = __expf(a[jj] - mx); bq[jj] = __expf(bq[jj] - mx); sum += a[jj] + bq[jj]; }
                pf[kp] = pack_acc(a, bq); }
            sum += __shfl_xor(sum, 16, 64); sum += __shfl_xor(sum, 32, 64);
            const float inv = 1.0f / (sum + __expf(sink - mx));
            bf16_t* op = OB + qrow * BW + h * 64 + q * 4;
#pragma unroll
            for (int dt = 0; dt < 4; ++dt) { f32x4 o = (f32x4){0.f, 0.f, 0.f, 0.f};
#pragma unroll
                for (int kp = 0; kp < 5; ++kp) o = mma16(*(const LAS bf16x8*)(VT_l + (dt * 16 + r) * 200 + (kt0 + 2 * kp) * 16 + q * 8), pf[kp], o);
                u32x2 ov; ov.x = pk2(o[0] * inv, o[1] * inv); ov.y = pk2(o[2] * inv, o[3] * inv); *(u32x2*)(op + dt * 16) = ov; }
        }
        __syncthreads();
    }
}

__device__ __forceinline__ void ph_swa_sample(const Ctx& c, const bf16_t* __restrict__ U, const float* __restrict__ ck, const float* __restrict__ cv, const float* __restrict__ sinks, bf16_t* __restrict__ OB) {
    LAS bf16_t* K_l = (LAS bf16_t*)c.lds;
    LAS bf16_t* VT_l = K_l + 160 * 72;
    const int tid = c.tid, lane = c.lane, r = lane & 15, q = lane >> 4, w = c.wave;
    for (int u = c.bid; u < SB * 2; u += c.G) {
        const int sq = u >> 1, kvh = u & 1;
        for (int idx = tid; idx < 160 * 8; idx += 512) { const int kl = idx >> 3, c8 = idx & 7; float kx[8], vx[8];
#pragma unroll
            for (int e = 0; e < 8; ++e) { kx[e] = 0.f; vx[e] = 0.f; }
            if (kl < 128) { const size_t o = ((size_t)sq * 128 + kl) * 128 + kvh * 64 + c8 * 8; const f32x4 a = *(const f32x4*)(ck + o), b2 = *(const f32x4*)(ck + o + 4), c2 = *(const f32x4*)(cv + o), d2 = *(const f32x4*)(cv + o + 4);
                kx[0] = a[0]; kx[1] = a[1]; kx[2] = a[2]; kx[3] = a[3]; kx[4] = b2[0]; kx[5] = b2[1]; kx[6] = b2[2]; kx[7] = b2[3];
                vx[0] = c2[0]; vx[1] = c2[1]; vx[2] = c2[2]; vx[3] = c2[3]; vx[4] = d2[0]; vx[5] = d2[1]; vx[6] = d2[2]; vx[7] = d2[3]; }
            else if (kl < 132) { const bf16_t* ur = U + (size_t)(MP + sq * SS + kl - 128) * NINP; unpack8(*(const u32x4*)(ur + U_SK + kvh * 64 + c8 * 8), kx); unpack8(*(const u32x4*)(ur + U_SV + kvh * 64 + c8 * 8), vx); }
            *(LAS u32x4*)(K_l + kl * 72 + c8 * 8) = (u32x4){pk2(kx[0], kx[1]), pk2(kx[2], kx[3]), pk2(kx[4], kx[5]), pk2(kx[6], kx[7])};
            LAS bf16_t* vp = VT_l + (c8 * 8) * 168 + kperm_pos(kl);
#pragma unroll
            for (int e = 0; e < 8; ++e) vp[e * 168] = f2bf(vx[e]); }
        __syncthreads();
        if (w < 2) {
            const int h = kvh * 8 + w * 4 + (r >> 2), tk = r & 3; const size_t qrow = (size_t)(MP + sq * SS + tk);
            const float slope = exp2f(-0.5f * (float)(h + 1)), sink = sinks[h];
            const bf16x8 qf0 = *(const bf16x8*)(U + qrow * NINP + U_SQ + h * 64 + q * 8), qf1 = *(const bf16x8*)(U + qrow * NINP + U_SQ + h * 64 + 32 + q * 8);
            f32x4 s[10]; float mx = sink;
#pragma unroll
            for (int kt = 0; kt < 10; ++kt) { const LAS bf16_t* kp = K_l + (kt * 16 + r) * 72 + q * 8;
                f32x4 d = mma16(*(const LAS bf16x8*)kp, qf0, (f32x4){0.f, 0.f, 0.f, 0.f}); d = mma16(*(const LAS bf16x8*)(kp + 32), qf1, d);
#pragma unroll
                for (int jj = 0; jj < 4; ++jj) { const int kl = kt * 16 + q * 4 + jj, dist = 128 + tk - kl;
                    const float v = (dist >= 0 && dist <= 128) ? d[jj] * 0.125f - slope * (float)dist : -1e30f; d[jj] = v; mx = fmaxf(mx, v); }
                s[kt] = d; }
            mx = fmaxf(mx, __shfl_xor(mx, 16, 64)); mx = fmaxf(mx, __shfl_xor(mx, 32, 64));
            float sum = 0.f; bf16x8 pf[5];
#pragma unroll
            for (int kp = 0; kp < 5; ++kp) { f32x4 a = s[2 * kp], bq = s[2 * kp + 1];
#pragma unroll
                for (int jj = 0; jj < 4; ++jj) { a[jj] = __expf(a[jj] - mx); bq[jj] = __expf(bq[jj] - mx); sum += a[jj] + bq[jj]; }
                pf[kp] = pack_acc(a, bq); }
            sum += __shfl_xor(sum, 16, 64); sum += __shfl_xor(sum, 32, 64);
            const float inv = 1.0f / (sum + __expf(sink - mx));
            bf16_t* op = OB + qrow * BW + h * 64 + q * 4;
#pragma unroll
            for (int dt = 0; dt < 4; ++dt) { f32x4 o = (f32x4){0.f, 0.f, 0.f, 0.f};
#pragma unroll
                for (int kp = 0; kp < 5; ++kp) o = mma16(*(const LAS bf16x8*)(VT_l + (dt * 16 + r) * 168 + kp * 32 + q * 8), pf[kp], o);
                u32x2 ov; ov.x = pk2(o[0] * inv, o[1] * inv); ov.y = pk2(o[2] * inv, o[3] * inv); *(u32x2*)(op + dt * 16) = ov; }
        }
        __syncthreads();
    }
}

constexpr int RWP_UNITS = (MP / 64) * 16 + SB * 16;
__device__ __forceinline__ void rwp_unit_info(int u, int& row0, int& ntok, int& h, int& sq, bool& seq_first) {
    if (u < (MP / 64) * 16) { const int blk = u >> 4; h = u & 15; row0 = blk * 64; ntok = 64; sq = -1; seq_first = (row0 % PS) == 0; }
    else { const int s = u - (MP / 64) * 16; sq = s >> 4; h = s & 15; row0 = MP + sq * SS; ntok = SS; seq_first = true; }
}
__device__ __forceinline__ void ph_rwkv_pre(const Ctx& c, const bf16_t* __restrict__ U, const float* __restrict__ shift, const float* __restrict__ mu, const float* __restrict__ w0, const float* __restrict__ w2,
                                            const float* __restrict__ a0, const float* __restrict__ a2, const float* __restrict__ g2, const float* __restrict__ k_k, const float* __restrict__ k_a,
                                            const float* __restrict__ r_k, float* __restrict__ RW, bf16_t* __restrict__ RB) {
    LAS bf16_t* P_l = (LAS bf16_t*)c.lds; LAS bf16_t* Kn_l = P_l + 4608; LAS bf16_t* Bn_l = Kn_l + 4608; LAS bf16_t* Q_l = Bn_l + 4608;
    LAS bf16_t* PT_l = Q_l + 4608; LAS bf16_t* BhT_l = PT_l + 4608; LAS bf16_t* KhT_l = BhT_l + 4608; LAS bf16_t* VT_l = KhT_l + 4608;
    LAS float* A_l = (LAS float*)(c.lds + 73728);
    LAS bf16_t* BmT_l = (LAS bf16_t*)(c.lds + 78848); LAS bf16_t* F_l = (LAS bf16_t*)(c.lds + 81920); LAS bf16_t* Tinv_l = (LAS bf16_t*)(c.lds + 84992);
    LAS bf16_t* PpT_l = (LAS bf16_t*)(c.lds + 88064);
    LAS bf16_t* BmpT_l = (LAS bf16_t*)(c.lds + 97280);
    LAS float* GC_l = (LAS float*)(c.lds + 100352);
    LAS float* lg_l = (LAS float*)(c.lds + 125952);
    LAS bf16_t* act_l = (LAS bf16_t*)c.lds;
    LAS bf16_t* wT_l = act_l + 64 * 264;
    LAS bf16_t* aT_l = wT_l + 64 * 72;
    LAS bf16_t* gT_l = aT_l + 64 * 72;
    LAS float* pre_l = (LAS float*)(c.lds + 73728);
    const int tid = c.tid, lane = c.lane, r = lane & 15, q = lane >> 4, w = c.wave;
    float* Gg = RW + 6 * (size_t)MPAD * BW; float* BON = RW + 7 * (size_t)MPAD * BW;
    for (int u = c.bid; u < RWP_UNITS; u += c.G) {
        int row0, ntok, h, sq; bool seq_first; rwp_unit_info(u, row0, ntok, h, sq, seq_first);
        const float* sh = sq >= 0 ? shift + (size_t)sq * RWC : nullptr;
        for (int idx = tid; idx < 64 * 256; idx += 512) {
            const int t = idx >> 8, col = idx & 255; float val = 0.f;
            if (t < ntok) { const int cc = 3072 + col; const bf16_t* ur = U + (size_t)(row0 + t) * NINP + U_RU; const float x = bf2f(ur[cc]);
                const float p = (t == 0 && seq_first) ? (sh ? sh[cc] : 0.f) : bf2f(ur[cc - NINP]);
                const float xm = x + (p - x) * mu[cc];
                val = col < 64 ? tanhf(xm) : (col < 128 ? xm : sigmoidf_(xm)); }
            act_l[t * 264 + col] = f2bf(val);
        }
        for (int idx = tid; idx < 64 * 64; idx += 512) { const int j = idx >> 6, cc = idx & 63; wT_l[cc * 72 + j] = f2bf(w2[(size_t)j * BW + h * 64 + cc]); aT_l[cc * 72 + j] = f2bf(a2[(size_t)j * BW + h * 64 + cc]); }
        for (int idx = tid; idx < 128 * 64; idx += 512) { const int j = idx >> 6, cc = idx & 63; gT_l[cc * 136 + j] = f2bf(g2[(size_t)j * BW + h * 64 + cc]); }
        __syncthreads();
        { const int tb = w & 3, chf = w >> 2; bf16x8 af[8];
#pragma unroll
          for (int ks = 0; ks < 8; ++ks) af[ks] = *(const LAS bf16x8*)(act_l + (tb * 16 + r) * 264 + ks * 32 + q * 8);
#pragma unroll
          for (int e = 0; e < 2; ++e) { const int cb = chf * 2 + e; f32x4 dw = (f32x4){0.f, 0.f, 0.f, 0.f}, da = dw, dg = dw;
#pragma unroll
              for (int ks = 0; ks < 2; ++ks) { dw = mma16(*(const LAS bf16x8*)(wT_l + (cb * 16 + r) * 72 + ks * 32 + q * 8), af[ks], dw);
                  da = mma16(*(const LAS bf16x8*)(aT_l + (cb * 16 + r) * 72 + ks * 32 + q * 8), af[2 + ks], da); }
#pragma unroll
              for (int ks = 0; ks < 4; ++ks) dg = mma16(*(const LAS bf16x8*)(gT_l + (cb * 16 + r) * 136 + ks * 32 + q * 8), af[4 + ks], dg);
              const int o = (tb * 16 + r) * 68 + cb * 16 + q * 4;
              *(LAS f32x4*)(pre_l + o) = dw; *(LAS f32x4*)(pre_l + 64 * 68 + o) = da; *(LAS f32x4*)(pre_l + 2 * 64 * 68 + o) = dg; } }
        __syncthreads();
        const int t = tid >> 3, cg = tid & 7, c0 = h * 64 + cg * 8, sc = t >> 4;
        float rr[8], k2[8], kap[8], bet[8], nlw[8];
        { float vx[8], gg[8], kkr[8]; float ss = 0.f, rk = 0.f;
          if (t < ntok) {
            const size_t row = (size_t)(row0 + t); const bf16_t* ur = U + row * NINP + U_RU; const bool fst = (t == 0 && seq_first);
            float kx[8];
#pragma unroll
            for (int part = 0; part < 3; ++part) { const int cc = part * 1024 + c0; float x[8], p[8];
                unpack8(*(const u32x4*)(ur + cc), x);
                if (!fst) unpack8(*(const u32x4*)(ur + cc - NINP), p);
                else {
#pragma unroll
                    for (int j = 0; j < 8; ++j) p[j] = sh ? sh[cc + j] : 0.f; }
#pragma unroll
                for (int j = 0; j < 8; ++j) { const float xm = x[j] + (p[j] - x[j]) * mu[cc + j]; if (part == 0) rr[j] = xm; else if (part == 1) kx[j] = xm; else vx[j] = xm; } }
#pragma unroll
            for (int j = 0; j < 8; ++j) { const int cc = c0 + j; const int o = t * 68 + cg * 8 + j;
                const float lw = -softplusf_(-(w0[cc] + pre_l[o])) - 0.5f; nlw[j] = -__expf(lw); const float av = sigmoidf_(a0[cc] + pre_l[64 * 68 + o]); gg[j] = pre_l[2 * 64 * 68 + o];
                kkr[j] = kx[j] * k_k[cc]; ss += kkr[j] * kkr[j]; k2[j] = kx[j] * (1.0f + (av - 1.0f) * k_a[cc]); rk += rr[j] * k2[j] * r_k[cc]; bet[j] = av; }
          } else {
#pragma unroll
            for (int j = 0; j < 8; ++j) { rr[j] = 0.f; k2[j] = 0.f; kkr[j] = 0.f; bet[j] = 0.f; nlw[j] = 0.f; vx[j] = 0.f; gg[j] = 0.f; }
          }
          ss += __shfl_xor(ss, 1, 64); ss += __shfl_xor(ss, 2, 64); ss += __shfl_xor(ss, 4, 64);
          rk += __shfl_xor(rk, 1, 64); rk += __shfl_xor(rk, 2, 64); rk += __shfl_xor(rk, 4, 64);
          const float inv = 1.0f / fmaxf(sqrtf(ss), 1e-12f);
#pragma unroll
          for (int j = 0; j < 8; ++j) { kap[j] = kkr[j] * inv; bet[j] = kap[j] * bet[j]; }
          if (t < ntok) { const size_t o = (size_t)(row0 + t) * BW + c0;
              *(f32x4*)(Gg + o) = (f32x4){gg[0], gg[1], gg[2], gg[3]}; *(f32x4*)(Gg + o + 4) = (f32x4){gg[4], gg[5], gg[6], gg[7]};
              *(f32x4*)(BON + o) = (f32x4){rk * vx[0], rk * vx[1], rk * vx[2], rk * vx[3]}; *(f32x4*)(BON + o + 4) = (f32x4){rk * vx[4], rk * vx[5], rk * vx[6], rk * vx[7]}; }
          *(LAS f32x4*)(lg_l + t * 68 + cg * 8) = (f32x4){nlw[0], nlw[1], nlw[2], nlw[3]}; *(LAS f32x4*)(lg_l + t * 68 + cg * 8 + 4) = (f32x4){nlw[4], nlw[5], nlw[6], nlw[7]};
#pragma unroll
          for (int j = 0; j < 8; ++j) VT_l[(cg * 8 + j) * 72 + t] = f2bf(vx[j]);
        }
        __syncthreads();
        if (tid < 256) { const int cc = tid & 63, s4 = tid >> 6; float run = 0.f;
#pragma unroll
            for (int i = 0; i < 16; ++i) { const int o = (s4 * 16 + i) * 68 + cc; run += lg_l[o]; lg_l[o] = run; } }
        __syncthreads();
        { unsigned pp[4], pq[4], pk[4], pb[4];
#pragma unroll
          for (int j = 0; j < 8; j += 2) { float vP[2], vQ[2], vK[2], vB[2];
#pragma unroll
              for (int e = 0; e < 2; ++e) { const int jj = j + e, cc = cg * 8 + jj; const float ci = lg_l[t * 68 + cc], cC = lg_l[(sc * 16 + 15) * 68 + cc];
                  const float ei = __expf(-ci), eh = __expf(cC - ci);
                  vP[e] = kap[jj] * __expf(ci - nlw[jj]); vQ[e] = rr[jj] * __expf(ci); vK[e] = k2[jj] * ei; vB[e] = bet[jj] * ei;
                  PT_l[cc * 72 + t] = f2bf(vP[e]); BhT_l[cc * 72 + t] = f2bf(bet[jj] * eh); KhT_l[cc * 72 + t] = f2bf(k2[jj] * eh); }
              pp[j >> 1] = pk2(vP[0], vP[1]); pq[j >> 1] = pk2(vQ[0], vQ[1]); pk[j >> 1] = pk2(vK[0], vK[1]); pb[j >> 1] = pk2(vB[0], vB[1]); }
          const int o = t * 72 + cg * 8;
          *(LAS u32x4*)(P_l + o) = (u32x4){pp[0], pp[1], pp[2], pp[3]}; *(LAS u32x4*)(Q_l + o) = (u32x4){pq[0], pq[1], pq[2], pq[3]};
          *(LAS u32x4*)(Kn_l + o) = (u32x4){pk[0], pk[1], pk[2], pk[3]}; *(LAS u32x4*)(Bn_l + o) = (u32x4){pb[0], pb[1], pb[2], pb[3]};
          if ((t & 15) == 15) {
#pragma unroll
              for (int j = 0; j < 8; ++j) GC_l[sc * 64 + cg * 8 + j] = __expf(lg_l[t * 68 + cg * 8 + j]); } }
        __syncthreads();
        const int nsub = ntok == 64 ? 4 : 1;
        const bf16x8 zfrag = (bf16x8){0, 0, 0, 0, 0, 0, 0, 0};
        for (int id = w; id < nsub * 3; id += 8) { const int s4 = id / 3, prod = id - s4 * 3; f32x4 d = (f32x4){0.f, 0.f, 0.f, 0.f};
            const LAS bf16_t* X = (prod == 1 ? P_l : Bn_l) + (s4 * 16 + r) * 72 + q * 8; const LAS bf16_t* Y = (prod == 0 ? P_l : (prod == 1 ? Kn_l : Q_l)) + (s4 * 16 + r) * 72 + q * 8;
#pragma unroll
            for (int ks = 0; ks < 2; ++ks) d = mma16(*(const LAS bf16x8*)(X + ks * 32), *(const LAS bf16x8*)(Y + ks * 32), d);
            if (prod == 0) { f32x4 o4;
#pragma unroll
                for (int jj = 0; jj < 4; ++jj) o4[jj] = (q * 4 + jj < r) ? d[jj] : 0.f;
                *(LAS f32x4*)(A_l + s4 * 320 + r * 20 + q * 4) = o4; }
            else { float o4[4];
#pragma unroll
                for (int jj = 0; jj < 4; ++jj) o4[jj] = (prod == 1 ? (r < q * 4 + jj) : (q * 4 + jj <= r)) ? d[jj] : 0.f;
                u32x2 o; o.x = pk2(o4[0], o4[1]); o.y = pk2(o4[2], o4[3]); *(LAS u32x2*)((prod == 1 ? BmT_l : F_l) + s4 * 384 + r * 24 + q * 4) = o; } }
        __syncthreads();
        if (w == 0 && (lane >> 4) < nsub) { const int s4 = lane >> 4, jc = lane & 15; float x[16];
#pragma unroll
            for (int tt = 0; tt < 16; ++tt) { float s = (tt == jc) ? 1.f : 0.f;
#pragma unroll
                for (int i = 0; i < tt; ++i) s -= A_l[s4 * 320 + tt * 20 + i] * x[i];
                x[tt] = s; }
#pragma unroll
            for (int tt = 0; tt < 16; ++tt) Tinv_l[s4 * 384 + tt * 24 + jc] = f2bf(x[tt]); }
        __syncthreads();
        for (int id = w; id < nsub * 5; id += 8) { const int s4 = id / 5, rem = id - s4 * 5;
            const bf16x8 xf = q < 2 ? *(const LAS bf16x8*)(Tinv_l + s4 * 384 + r * 24 + q * 8) : zfrag;
            const bf16x8 yf = q < 2 ? (rem < 4 ? *(const LAS bf16x8*)(PT_l + (rem * 16 + r) * 72 + s4 * 16 + q * 8) : *(const LAS bf16x8*)(BmT_l + s4 * 384 + r * 24 + q * 8)) : zfrag;
            const f32x4 d = mma16(xf, yf, (f32x4){0.f, 0.f, 0.f, 0.f});
            u32x2 o; o.x = pk2(d[0], d[1]); o.y = pk2(d[2], d[3]);
            if (rem < 4) *(LAS u32x2*)(PpT_l + (rem * 16 + r) * 72 + s4 * 16 + q * 4) = o; else *(LAS u32x2*)(BmpT_l + s4 * 384 + r * 24 + q * 4) = o; }
        __syncthreads();
        { const int chunk0 = sq >= 0 ? PB * 16 * 256 + sq * 16 + h : ((row0 / PS) * 16 + h) * 256 + ((row0 % PS) >> 4);
          for (int id = w; id < nsub * 25; id += 8) { const int s4 = id / 25, rem = id - s4 * 25; bf16_t* blob = RB + (size_t)(chunk0 + s4) * RB_EL;
            const bf16x8 fF = q < 2 ? *(const LAS bf16x8*)(F_l + s4 * 384 + r * 24 + q * 8) : zfrag;
            if (rem < 4) {
                const bf16x8 xf = q < 2 ? *(const LAS bf16x8*)(PpT_l + (rem * 16 + r) * 72 + s4 * 16 + q * 8) : zfrag;
                const f32x4 d = mma16(xf, fF, (f32x4){0.f, 0.f, 0.f, 0.f});
                const u32x2 qv = *(const LAS u32x2*)(Q_l + (s4 * 16 + r) * 72 + rem * 16 + q * 4);
                u32x2 o; o.x = pk2(__uint_as_float(qv.x << 16) - d[0], __uint_as_float(qv.x & 0xffff0000u) - d[1]); o.y = pk2(__uint_as_float(qv.y << 16) - d[2], __uint_as_float(qv.y & 0xffff0000u) - d[3]);
                *(u32x2*)(blob + RB_QP + r * 72 + 32 * (rem >> 1) + 8 * q + 4 * (rem & 1)) = o;
            } else if (rem == 4) {
                f32x4 d2 = (f32x4){0.f, 0.f, 0.f, 0.f};
#pragma unroll
                for (int ks = 0; ks < 2; ++ks) d2 = mma16(*(const LAS bf16x8*)(Kn_l + (s4 * 16 + r) * 72 + ks * 32 + q * 8), *(const LAS bf16x8*)(Q_l + (s4 * 16 + r) * 72 + ks * 32 + q * 8), d2);
                const bf16x8 xf = q < 2 ? *(const LAS bf16x8*)(BmpT_l + s4 * 384 + r * 24 + q * 8) : zfrag;
                const f32x4 d1 = mma16(xf, fF, (f32x4){0.f, 0.f, 0.f, 0.f});
                float o4[4];
#pragma unroll
                for (int jj = 0; jj < 4; ++jj) o4[jj] = ((q * 4 + jj <= r) ? d2[jj] : 0.f) - d1[jj];
                u32x2 o; o.x = pk2(o4[0], o4[1]); o.y = pk2(o4[2], o4[3]); *(u32x2*)(blob + RB_EP + r * 24 + q * 4) = o;
            } else if (rem < 21) {
                const int cib = (rem - 5) >> 2, cob = (rem - 5) & 3;
                const bf16x8 xf = q < 2 ? *(const LAS bf16x8*)(PpT_l + (cib * 16 + r) * 72 + s4 * 16 + q * 8) : zfrag;
                const bf16x8 yf = q < 2 ? *(const LAS bf16x8*)(BhT_l + (cob * 16 + r) * 72 + s4 * 16 + q * 8) : zfrag;
                const f32x4 d = mma16(xf, yf, (f32x4){0.f, 0.f, 0.f, 0.f});
                const float gc = GC_l[s4 * 64 + cob * 16 + r]; float o4[4];
#pragma unroll
                for (int jj = 0; jj < 4; ++jj) o4[jj] = ((cib == cob && q * 4 + jj == r) ? gc : 0.f) - d[jj];
                u32x2 o; o.x = pk2(o4[0], o4[1]); o.y = pk2(o4[2], o4[3]); *(u32x2*)(blob + (cob * 16 + r) * 72 + 32 * (cib >> 1) + 8 * q + 4 * (cib & 1)) = o;
            } else {
                const int cb = rem - 21;
                const bf16x8 xf = q < 2 ? *(const LAS bf16x8*)(BmpT_l + s4 * 384 + r * 24 + q * 8) : zfrag;
                const bf16x8 yf = q < 2 ? *(const LAS bf16x8*)(BhT_l + (cb * 16 + r) * 72 + s4 * 16 + q * 8) : zfrag;
                const f32x4 d = mma16(xf, yf, (f32x4){0.f, 0.f, 0.f, 0.f});
                const u32x2 kv = *(const LAS u32x2*)(KhT_l + (cb * 16 + r) * 72 + s4 * 16 + q * 4);
                u32x2 o; o.x = pk2(__uint_as_float(kv.x << 16) - d[0], __uint_as_float(kv.x & 0xffff0000u) - d[1]); o.y = pk2(__uint_as_float(kv.y << 16) - d[2], __uint_as_float(kv.y & 0xffff0000u) - d[3]);
                *(u32x2*)(blob + RB_KHP + (cb * 16 + r) * 24 + q * 4) = o;
            } }
          for (int idx = tid; idx < nsub * 128; idx += 512) { const int s4 = idx >> 7, cc = (idx >> 1) & 63, hf = idx & 1;
              *(u32x4*)(RB + (size_t)(chunk0 + s4) * RB_EL + RB_VT + cc * 24 + hf * 8) = *(const LAS u32x4*)(VT_l + cc * 72 + s4 * 16 + hf * 8); } }
        __syncthreads();
    }
}

__device__ __forceinline__ void ph_rwkv_scan_naive(const Ctx& c, const float* __restrict__ RW, const float* __restrict__ s0, const float* __restrict__ lng, const float* __restrict__ lnb, bf16_t* __restrict__ OB,
                                                   float* __restrict__ outP, float* __restrict__ outS) {
    const float* R = RW; const float* WD = RW + (size_t)MPAD * BW; const float* K2 = WD + (size_t)MPAD * BW; const float* V = K2 + (size_t)MPAD * BW; const float* KK = V + (size_t)MPAD * BW;
    const float* BV = KK + (size_t)MPAD * BW; const float* G = BV + (size_t)MPAD * BW; const float* BON = G + (size_t)MPAD * BW;
    const int lane = c.lane;
    for (int it = 0;; ++it) {
        const int u = (it * 8 + c.wave) * c.G + c.bid;
        if (u >= (PB + SB) * 16) break;
        const int sq = u >> 4, h = u & 15;
        int row0, L; seq_info(sq, row0, L);
        float S[64];
        if (sq >= PB) { const float* p = s0 + (((size_t)(sq - PB) * 16 + h) * 64 + lane) * 64;
#pragma unroll
            for (int j = 0; j < 64; ++j) S[j] = p[j]; }
        else {
#pragma unroll
            for (int j = 0; j < 64; ++j) S[j] = 0.f; }
        const float lg = lng[h * 64 + lane], lb = lnb[h * 64 + lane];
        for (int t = 0; t < L; ++t) {
            const size_t base = (size_t)(row0 + t) * BW + h * 64; const float v = V[base + lane];
            float d = 0.f;
#pragma unroll
            for (int j = 0; j < 64; ++j) d += S[j] * KK[base + j];
            float y = 0.f;
#pragma unroll
            for (int j = 0; j < 64; ++j) { S[j] = S[j] * WD[base + j] - d * BV[base + j] + v * K2[base + j]; y += S[j] * R[base + j]; }
            const float mean = wave_sum(y) * (1.0f / 64.0f), dy = y - mean, var = wave_sum(dy * dy) * (1.0f / 64.0f);
            const float yn = dy * rsqrtf(var + 64e-5f) * lg + lb;
            OB[base + lane] = f2bf((yn + BON[base + lane]) * G[base + lane]);
        }
        float* op = (sq < PB ? outP + (((size_t)sq * 16 + h) * 64 + lane) * 64 : outS + (((size_t)(sq - PB) * 16 + h) * 64 + lane) * 64);
#pragma unroll
        for (int j = 0; j < 64; ++j) op[j] = S[j];
    }
}
__device__ __forceinline__ void ph_rwkv_scan2(const Ctx& c, int boff, const float* __restrict__ RW, const float* __restrict__ s0, const float* __restrict__ lng, const float* __restrict__ lnb, bf16_t* __restrict__ OB,
                                              float* __restrict__ outP, float* __restrict__ outS) {
    LAS float* opb = (LAS float*)c.lds;
    LAS float* yb = opb + 2 * 16 * 384;
    const int tid = c.tid, lane = c.lane, w = c.wave, rl = lane >> 3, cg = lane & 7, vrow = w * 8 + rl;
    const float* G = RW + 6 * (size_t)MPAD * BW; const float* BON = RW + 7 * (size_t)MPAD * BW;
    for (int u = (c.bid - boff + c.G) % c.G; u < (PB + SB) * 16; u += c.G) {
        const int sq = u >> 4, h = u & 15;
        int row0, L; seq_info(sq, row0, L);
        float S[8];
        if (sq >= PB) { const float* p = s0 + (((size_t)(sq - PB) * 16 + h) * 64 + vrow) * 64 + cg * 8;
#pragma unroll
            for (int j = 0; j < 8; ++j) S[j] = p[j]; }
        else {
#pragma unroll
            for (int j = 0; j < 8; ++j) S[j] = 0.f; }
        const float lg = lng[h * 64 + lane], lb = lnb[h * 64 + lane];
        const int nb = (L + 15) >> 4;
#define RW_STAGE(bi_) do { const int t0_ = (bi_) * 16, nT_ = (L - t0_) < 16 ? (L - t0_) : 16; LAS float* dst_ = opb + ((bi_) & 1) * 16 * 384; \
        for (int idx = tid; idx < nT_ * 96; idx += 512) { const int t = idx / 96, rem = idx - t * 96, slot = rem >> 4, c4 = rem & 15; \
            const int arr = slot == 0 ? 1 : slot == 1 ? 4 : slot == 2 ? 5 : slot == 3 ? 2 : slot == 4 ? 0 : 3; \
            *(LAS f32x4*)(dst_ + t * 384 + slot * 64 + c4 * 4) = *(const f32x4*)(RW + (size_t)arr * MPAD * BW + (size_t)(row0 + t0_ + t) * BW + h * 64 + c4 * 4); } } while (0)
        RW_STAGE(0);
        for (int bi = 0; bi < nb; ++bi) {
            __syncthreads();
            if (bi + 1 < nb) RW_STAGE(bi + 1);
            const int t0 = bi * 16, nT = (L - t0) < 16 ? (L - t0) : 16; const LAS float* src = opb + (bi & 1) * 16 * 384;
            for (int tt = 0; tt < nT; ++tt) {
                const LAS float* b = src + tt * 384 + cg * 8;
                const f32x4 w0 = *(const LAS f32x4*)(b), w1 = *(const LAS f32x4*)(b + 4), k0 = *(const LAS f32x4*)(b + 64), k1 = *(const LAS f32x4*)(b + 68);
                const f32x4 b0 = *(const LAS f32x4*)(b + 128), b1 = *(const LAS f32x4*)(b + 132), q0 = *(const LAS f32x4*)(b + 192), q1 = *(const LAS f32x4*)(b + 196);
                const f32x4 r0 = *(const LAS f32x4*)(b + 256), r1 = *(const LAS f32x4*)(b + 260); const float v = src[tt * 384 + 320 + vrow];
                float d = (S[0] * k0[0] + S[1] * k0[1]) + (S[2] * k0[2] + S[3] * k0[3]) + (S[4] * k1[0] + S[5] * k1[1]) + (S[6] * k1[2] + S[7] * k1[3]);
                d += __shfl_xor(d, 1, 64); d += __shfl_xor(d, 2, 64); d += __shfl_xor(d, 4, 64);
                float y = 0.f;
#pragma unroll
                for (int j = 0; j < 4; ++j) { S[j] = S[j] * w0[j] - d * b0[j] + v * q0[j]; y += S[j] * r0[j]; S[4 + j] = S[4 + j] * w1[j] - d * b1[j] + v * q1[j]; y += S[4 + j] * r1[j]; }
                y += __shfl_xor(y, 1, 64); y += __shfl_xor(y, 2, 64); y += __shfl_xor(y, 4, 64);
                if (cg == 0) yb[tt * 64 + vrow] = y;
            }
            __syncthreads();
            for (int tt = w; tt < nT; tt += 8) {
                const float y = yb[tt * 64 + lane]; const float mean = wave_sum(y) * (1.0f / 64.0f), dy = y - mean, var = wave_sum(dy * dy) * (1.0f / 64.0f);
                const float yn = dy * rsqrtf(var + 64e-5f) * lg + lb; const size_t o = (size_t)(row0 + t0 + tt) * BW + h * 64 + lane;
                OB[o] = f2bf((yn + BON[o]) * G[o]);
            }
        }
#undef RW_STAGE
        float* op = (sq < PB ? outP + (((size_t)sq * 16 + h) * 64 + vrow) * 64 : outS + (((size_t)(sq - PB) * 16 + h) * 64 + vrow) * 64) + cg * 8;
#pragma unroll
        for (int j = 0; j < 8; ++j) op[j] = S[j];
        __syncthreads();
    }
}
constexpr int RS_SLOTS = 8, RS_SLOT_B = RB_EL * 2;
__device__ __forceinline__ void ph_rwkv_seq(const Ctx& c, int boff, const bf16_t* __restrict__ RB, const float* __restrict__ s0, float* __restrict__ outP, float* __restrict__ outS, bf16_t* __restrict__ OB) {
    const int lane = c.lane, r = lane & 15, q = lane >> 4, w = c.wave;
    LAS unsigned char* ring = c.lds;
    for (int u = (c.bid - boff + c.G) % c.G; u < (PB + SB) * 16; u += c.G) {
        const int sq = u >> 4, h = u & 15;
        int nch, ch0, row0, ntok; const float* sp = nullptr; float* op;
        if (sq < PB) { nch = 256; ch0 = (sq * 16 + h) * 256; row0 = sq * PS; ntok = 16; op = outP + (size_t)(sq * 16 + h) * 4096; }
        else { nch = 1; ch0 = PB * 16 * 256 + (sq - PB) * 16 + h; row0 = MP + (sq - PB) * SS; ntok = SS; sp = s0 + (size_t)((sq - PB) * 16 + h) * 4096; op = outS + (size_t)((sq - PB) * 16 + h) * 4096; }
        if (w >= 4) {
            const int lw = w - 4, p0 = lw < 2 ? lw * 5 : 10 + (lw - 2) * 4, np = lw < 2 ? 5 : 4;
#define RS_ISSUE(ci_) do { const int cc_ = (ci_) < nch ? (ci_) : nch - 1; const char* g_ = (const char*)(RB + (size_t)(ch0 + cc_) * RB_EL) + p0 * 1024 + lane * 16; \
            LAS unsigned char* d_ = ring + ((ci_) % RS_SLOTS) * RS_SLOT_B + p0 * 1024; \
            _Pragma("unroll") for (int p_ = 0; p_ < 5; ++p_) if (p_ < np) __builtin_amdgcn_global_load_lds((const unsigned*)(g_ + p_ * 1024), (LAS unsigned*)(d_ + p_ * 1024), 16, 0, 0); } while (0)
            for (int ci = 0; ci < RS_SLOTS - 1; ++ci) RS_ISSUE(ci);
            if (lw < 2) asm volatile("s_waitcnt vmcnt(30)" ::: "memory"); else asm volatile("s_waitcnt vmcnt(24)" ::: "memory");
            __builtin_amdgcn_s_barrier();
            for (int ci = 0; ci < nch; ++ci) {
                RS_ISSUE(ci + RS_SLOTS - 1);
                if (lw < 2) asm volatile("s_waitcnt vmcnt(30)" ::: "memory"); else asm volatile("s_waitcnt vmcnt(24)" ::: "memory");
                __builtin_amdgcn_s_barrier();
            }
#undef RS_ISSUE
            asm volatile("s_waitcnt vmcnt(0)" ::: "memory");
        } else {
            const int vb = w; f32x4 acc[4];
#pragma unroll
            for (int kb = 0; kb < 4; ++kb) acc[kb] = sp ? *(const f32x4*)(sp + (size_t)(vb * 16 + r) * 64 + kb * 16 + q * 4) : (f32x4){0.f, 0.f, 0.f, 0.f};
            const bf16x8 zfrag = (bf16x8){0, 0, 0, 0, 0, 0, 0, 0};
            __builtin_amdgcn_s_barrier();
            for (int ci = 0; ci < nch; ++ci) {
                const LAS bf16_t* blob = (const LAS bf16_t*)(ring + (ci % RS_SLOTS) * RS_SLOT_B);
                const bf16x8 t0 = pack_acc(acc[0], acc[1]), t1 = pack_acc(acc[2], acc[3]);
                const bf16x8 vt = q < 2 ? *(const LAS bf16x8*)(blob + RB_VT + (vb * 16 + r) * 24 + q * 8) : zfrag;
                const bf16x8 ep = q < 2 ? *(const LAS bf16x8*)(blob + RB_EP + r * 24 + q * 8) : zfrag;
                f32x4 y = mma16(t0, *(const LAS bf16x8*)(blob + RB_QP + r * 72 + q * 8), (f32x4){0.f, 0.f, 0.f, 0.f});
                y = mma16(t1, *(const LAS bf16x8*)(blob + RB_QP + r * 72 + 32 + q * 8), y);
                y = mma16(vt, ep, y);
#pragma unroll
                for (int kb = 0; kb < 4; ++kb) { f32x4 a = mma16(*(const LAS bf16x8*)(blob + (kb * 16 + r) * 72 + q * 8), t0, (f32x4){0.f, 0.f, 0.f, 0.f});
                    a = mma16(*(const LAS bf16x8*)(blob + (kb * 16 + r) * 72 + 32 + q * 8), t1, a);
                    const bf16x8 kh = q < 2 ? *(const LAS bf16x8*)(blob + RB_KHP + (kb * 16 + r) * 24 + q * 8) : zfrag;
                    acc[kb] = mma16(kh, vt, a); }
                if (r < ntok) { u32x2 o; o.x = pk2(y[0], y[1]); o.y = pk2(y[2], y[3]); *(u32x2*)(OB + (size_t)(row0 + ci * 16 + r) * BW + h * 64 + vb * 16 + q * 4) = o; }
                asm volatile("s_waitcnt lgkmcnt(0)" ::: "memory");
                __builtin_amdgcn_s_barrier();
            }
#pragma unroll
            for (int kb = 0; kb < 4; ++kb) *(f32x4*)(op + (size_t)(vb * 16 + r) * 64 + kb * 16 + q * 4) = acc[kb];
        }
        __syncthreads();
    }
}
__device__ __forceinline__ void ph_rwkv_fin(const Ctx& c, const float* __restrict__ RW, const float* __restrict__ lng, const float* __restrict__ lnb, bf16_t* __restrict__ OB) {
    const int lane = c.lane; const float* G = RW + 6 * (size_t)MPAD * BW; const float* BON = RW + 7 * (size_t)MPAD * BW;
    for (int i = c.bid * 8 + c.wave; i < MT * 4; i += c.G * 8) {
        const int row = i >> 2, cc = (i & 3) * 256 + lane * 4; const size_t o = (size_t)row * BW + cc; bf16_t* p = OB + o;
        const u32x2 raw = *(const u32x2*)p; float x[4] = {__uint_as_float(raw.x << 16), __uint_as_float(raw.x & 0xffff0000u), __uint_as_float(raw.y << 16), __uint_as_float(raw.y & 0xffff0000u)};
        float s = (x[0] + x[1]) + (x[2] + x[3]); s += __shfl_xor(s, 1, 64); s += __shfl_xor(s, 2, 64); s += __shfl_xor(s, 4, 64); s += __shfl_xor(s, 8, 64);
        const float mean = s * (1.0f / 64.0f); float qq = 0.f;
#pragma unroll
        for (int j = 0; j < 4; ++j) { const float d = x[j] - mean; qq += d * d; }
        qq += __shfl_xor(qq, 1, 64); qq += __shfl_xor(qq, 2, 64); qq += __shfl_xor(qq, 4, 64); qq += __shfl_xor(qq, 8, 64);
        const float rstd = rsqrtf(qq * (1.0f / 64.0f) + 64e-5f);
        const f32x4 gg = *(const f32x4*)(lng + cc), bb = *(const f32x4*)(lnb + cc), bo = *(const f32x4*)(BON + o), gt = *(const f32x4*)(G + o); float ov[4];
#pragma unroll
        for (int j = 0; j < 4; ++j) ov[j] = ((x[j] - mean) * rstd * gg[j] + bb[j] + bo[j]) * gt[j];
        u32x2 oo; oo.x = pk2(ov[0], ov[1]); oo.y = pk2(ov[2], ov[3]); *(u32x2*)p = oo;
    }
}

__device__ __forceinline__ void ph_memattn_sample(const Ctx& c, const bf16_t* __restrict__ U, const float* __restrict__ mk, const float* __restrict__ mv, bf16_t* __restrict__ OB) {
    LAS float* qs = (LAS float*)c.lds; LAS float* ps = qs + 2 * 4 * 256;
    const int hh = c.tid >> 8, vt = c.tid & 255, lane = c.lane;
    for (int u = c.bid; u < SB * 2; u += c.G) {
        const int sq = u >> 1, h = (u & 1) * 2 + hh;
#pragma unroll
        for (int t = 0; t < 4; ++t) qs[(hh * 4 + t) * 256 + vt] = bf2f(U[(size_t)(MP + sq * SS + t) * NINP + U_MQ + h * 256 + vt]) * 0.0625f;
        __syncthreads();
        { const float* kr = mk + (((size_t)sq * MEMT + vt) * 4 + h) * 256; float s[4] = {0.f, 0.f, 0.f, 0.f};
            for (int d = 0; d < 256; d += 4) { const f32x4 kv = *(const f32x4*)(kr + d);
#pragma unroll
                for (int t = 0; t < 4; ++t) { const LAS float* qq = qs + (hh * 4 + t) * 256 + d; s[t] += kv[0] * qq[0] + kv[1] * qq[1] + kv[2] * qq[2] + kv[3] * qq[3]; } }
#pragma unroll
            for (int t = 0; t < 4; ++t) ps[(hh * 4 + t) * 256 + vt] = s[t]; }
        __syncthreads();
        { LAS float* pr = ps + c.wave * 256; float x[4]; float mx = -3.0e38f;
#pragma unroll
            for (int j = 0; j < 4; ++j) { x[j] = pr[lane + 64 * j]; mx = fmaxf(mx, x[j]); }
            mx = wave_max(mx); float s = 0.f;
#pragma unroll
            for (int j = 0; j < 4; ++j) { x[j] = __expf(x[j] - mx); s += x[j]; }
            const float inv = 1.0f / wave_sum(s);
#pragma unroll
            for (int j = 0; j < 4; ++j) pr[lane + 64 * j] = x[j] * inv; }
        __syncthreads();
        { float o[4] = {0.f, 0.f, 0.f, 0.f}; const float* vr = mv + ((size_t)sq * MEMT * 4 + h) * 256 + vt;
            for (int m = 0; m < MEMT; ++m) { const float vv = vr[(size_t)m * 1024];
#pragma unroll
                for (int t = 0; t < 4; ++t) o[t] += ps[(hh * 4 + t) * 256 + m] * vv; }
#pragma unroll
            for (int t = 0; t < 4; ++t) OB[(size_t)(MP + sq * SS + t) * BW + h * 256 + vt] = f2bf(o[t]); }
        __syncthreads();
    }
}

constexpr int LDS_BAR_OFF = 147456;
constexpr int LDS_BYTES = LDS_BAR_OFF + 64;
struct Args { const float* in[37]; float* out; unsigned char* ws; };

typedef pg8::Gemm<DM, DM, DM, 2, 8, NL, 1, false, 0, 0, (long)DM * DM, 0> GemmMem;
typedef pg8::Gemm<DM, DM, DM, MPAD / 256, NINP / 256> GemmIn;
typedef pg8::Gemm<NINP, 1024, 256, PS / 256, 1, 8, 4, false, (long)PS * NINP, 256, 256 * 1024, 256> GemmScore;
typedef pg8::Gemm<256, 256, 256, PS / 256, 1, 8, 4, false, (long)4 * 4096 * 256, (long)4096 * 256, 4 * 65536, 65536> GemmPV;
typedef pg8::Gemm<BW, BW, BW, MPAD / 256, DM / 256, 4, 1, true, (long)MPAD * BW, 0, (long)DM * BW, 0> GemmBranch;
typedef pg8::Gemm<DM, DM, DM, MPAD / 256, DM / 256> GemmOut;
typedef pg8::Gemm<DM, DM, DM, MPAD / 256, 2 * DFF / 256> GemmGU;
typedef pg8::Gemm<DFF, DFF, DFF, MPAD / 256, DM / 256> GemmDown;
template <class GT> __device__ __forceinline__ GT mk_gemm(const Ctx& c, const bf16_t* A, const bf16_t* B) { GT g; g.A = A; g.B = B; g.G = c.G; g.c = c.bid; return g; }

template <int OFF> __device__ __forceinline__ unsigned long long karg_u64(unsigned long long kargs) {
    unsigned long long p; asm volatile("s_load_dwordx2 %0, %1, %2\n\ts_waitcnt lgkmcnt(0)" : "=s"(p) : "s"(kargs), "n"(OFF) : "memory"); return p;
}
#define INP(k) ((const float*)karg_u64<(k) * 8>(kargs))
#define OUTP() ((float*)karg_u64<37 * 8>(kargs))
#define WSP() ((unsigned char*)karg_u64<38 * 8>(kargs))

__global__ void __launch_bounds__(512, 2) mega_fwd(Args a_unused) {
    extern __shared__ __attribute__((aligned(16))) unsigned char lds_raw[];
    const unsigned long long kargs = (unsigned long long)__builtin_amdgcn_kernarg_segment_ptr();
    Ctx c0; c0.tid = threadIdx.x; c0.lane = c0.tid & 63; c0.wave = __builtin_amdgcn_readfirstlane(c0.tid >> 6); c0.bid = blockIdx.x; c0.G = gridDim.x; c0.lds = (LAS unsigned char*)lds_raw;
    if (c0.tid < 4) ((LAS unsigned*)(c0.lds + LDS_BAR_OFF))[c0.tid] = 0u;
    __syncthreads();
    const XcdBarrier bar = xcd_barrier_post((unsigned*)(WSP() + WS_CTL), (volatile LAS unsigned*)(c0.lds + LDS_BAR_OFF));

    { const Ctx c = fresh(c0); unsigned char* ws = WSP();
      ph_wprep(c, INP(10), (bf16_t*)(ws + WS_WIN), DM, NIN, NINP, 1, NL, (size_t)DM * NIN, (size_t)NINP * DM);
      ph_wprep(c, INP(28), (bf16_t*)(ws + WS_WMEM), DM, DM, DM, 0, NL, (size_t)DM * DM, (size_t)DM * DM);
      ph_wprep(c, INP(29), (bf16_t*)(ws + WS_WBR), BW, DM, DM, 0, NL * 4, (size_t)BW * DM, (size_t)DM * BW);
      ph_wprep(c, INP(30), (bf16_t*)(ws + WS_WOUT), DM, DM, DM, 0, NL, (size_t)DM * DM, (size_t)DM * DM);
      ph_wprep(c, INP(33), (bf16_t*)(ws + WS_WGU), DM, 2 * DFF, 2 * DFF, 2, NL, (size_t)DM * 2 * DFF, (size_t)2 * DFF * DM);
      ph_wprep(c, INP(34), (bf16_t*)(ws + WS_WDN), DFF, DM, DM, 0, NL, (size_t)DFF * DM, (size_t)DM * DFF);
      ph_xprep(c, INP(0), INP(1), INP(2), (float*)(ws + WS_HF), (bf16_t*)(ws + WS_HB), (bf16_t*)(ws + WS_MEMB)); }
    xcd_barrier(bar);
    { const Ctx c = fresh(c0); unsigned char* ws = WSP(); float* out = OUTP();
      GemmMem g = mk_gemm<GemmMem>(c, (const bf16_t*)(ws + WS_MEMB), (const bf16_t*)(ws + WS_WMEM));
      pg8::EpiMem E; E.outK = out + O_MKP; E.outV = out + O_MVP; E.kb = (bf16_t*)(ws + WS_MKB); E.vt = (bf16_t*)(ws + WS_MVT); pg8::gemm_phase<GemmMem, pg8::EpiMem, true, true>(c.lds, c.tid, g, E); }

    for (int l = 0; l < NL; ++l) {
        { const Ctx c = fresh(c0); unsigned char* ws = WSP();
          GemmIn g = mk_gemm<GemmIn>(c, (const bf16_t*)(ws + WS_HB), (const bf16_t*)(ws + WS_WIN) + (size_t)l * NINP * DM);
          pg8::EpiBf16 E; E.O = (bf16_t*)(ws + WS_U); E.zs = 0; E.ldc = NINP; E.pad = 0; pg8::gemm_phase<GemmIn, pg8::EpiBf16, true, true>(c.lds, c.tid, g, E); }
        xcd_barrier(bar);
        { const Ctx c = fresh(c0); unsigned char* ws = WSP(); float* out = OUTP(); const bf16_t* U = (const bf16_t*)(ws + WS_U); bf16_t* BR = (bf16_t*)(ws + WS_BR);
          (void)out; (void)BR;
          ph_gla_pre(c, U, INP(12) + (size_t)l * 16 * 512, INP(13) + (size_t)l * 512, (bf16_t*)(ws + WS_GLQD), (bf16_t*)(ws + WS_GLKH), (bf16_t*)(ws + WS_GLE), (bf16_t*)(ws + WS_GLVT), (float*)(ws + WS_GLGC)); }
        { const Ctx c = fresh(c0); unsigned char* ws = WSP();
          ph_rwkv_pre(c, (const bf16_t*)(ws + WS_U), INP(9) + (size_t)l * SB * RWC, INP(17) + (size_t)l * RWC, INP(18) + (size_t)l * BW, INP(19) + (size_t)l * 64 * BW, INP(20) + (size_t)l * BW, INP(21) + (size_t)l * 64 * BW,
                       INP(22) + (size_t)l * 128 * BW, INP(23) + (size_t)l * BW, INP(24) + (size_t)l * BW, INP(25) + (size_t)l * BW, (float*)(ws + WS_RW), (bf16_t*)(ws + WS_RB)); }
        { const Ctx c = fresh(c0); unsigned char* ws = WSP();
          ph_swa_sample(c, (const bf16_t*)(ws + WS_U), INP(3) + (size_t)l * SB * 16384, INP(4) + (size_t)l * SB * 16384, INP(16) + (size_t)l * 16, (bf16_t*)(ws + WS_BR) + (size_t)MPAD * BW); }
        { const Ctx c = fresh(c0); unsigned char* ws = WSP(); ph_swa_prompt(c, (const bf16_t*)(ws + WS_U), INP(16) + (size_t)l * 16, (bf16_t*)(ws + WS_BR) + (size_t)MPAD * BW); }
        { const Ctx c = fresh(c0); unsigned char* ws = WSP();
          ph_copy_outs(c, (const bf16_t*)(ws + WS_U), INP(3) + (size_t)l * SB * 16384, INP(4) + (size_t)l * SB * 16384, OUTP(), l); }
        { const Ctx c = fresh(c0); unsigned char* ws = WSP();
          ph_memattn_sample(c, (const bf16_t*)(ws + WS_U), INP(5) + (size_t)l * SB * MEMT * 1024, INP(6) + (size_t)l * SB * MEMT * 1024, (bf16_t*)(ws + WS_BR) + (size_t)3 * MPAD * BW); }
        { const Ctx c = fresh(c0); unsigned char* ws = WSP();
          GemmScore g = mk_gemm<GemmScore>(c, (const bf16_t*)(ws + WS_U) + U_MQ, (const bf16_t*)(ws + WS_MKB) + (size_t)l * 512 * 1024);
          pg8::EpiScore E; E.SC = (float*)(ws + WS_SC); pg8::gemm_phase<GemmScore, pg8::EpiScore, true, true>(c.lds, c.tid, g, E); }
        xcd_barrier(bar);
        { const Ctx c = fresh(c0); unsigned char* ws = WSP(); float* out = OUTP();
          ph_rwkv_seq(c, 64, (const bf16_t*)(ws + WS_RB), INP(8) + (size_t)l * SB * 16 * 4096, out + O_RWP + (size_t)l * PB * 16 * 4096, out + O_RWS + (size_t)l * SB * 16 * 4096,
                      (bf16_t*)(ws + WS_BR) + (size_t)2 * MPAD * BW); }
        { const Ctx c = fresh(c0); unsigned char* ws = WSP(); float* out = OUTP();
          ph_gla_seq(c, 32, (const bf16_t*)(ws + WS_GLQD), (const bf16_t*)(ws + WS_GLKH), (const bf16_t*)(ws + WS_GLE), (const bf16_t*)(ws + WS_GLVT), (const float*)(ws + WS_GLGC),
                     INP(7) + (size_t)l * SB * 4 * 32768, out + O_GLAP + (size_t)l * PB * 4 * 32768, out + O_GLAS + (size_t)l * SB * 4 * 32768, (bf16_t*)(ws + WS_BR)); }
        { const Ctx c = fresh(c0); unsigned char* ws = WSP(); ph_softmax256(c, (const float*)(ws + WS_SC), (bf16_t*)(ws + WS_PB), 8 * 4096); }
        xcd_barrier(bar);
        { const Ctx c = fresh(c0); unsigned char* ws = WSP(); ph_rwkv_fin(c, (const float*)(ws + WS_RW), INP(26) + (size_t)l * BW, INP(27) + (size_t)l * BW, (bf16_t*)(ws + WS_BR) + (size_t)2 * MPAD * BW); }
        { const Ctx c = fresh(c0); unsigned char* ws = WSP(); ph_gla_fin(c, (const bf16_t*)(ws + WS_U), INP(14) + (size_t)l * BW, INP(15) + (size_t)l * BW, (bf16_t*)(ws + WS_BR)); }
        { const Ctx c = fresh(c0); unsigned char* ws = WSP();
          GemmPV g = mk_gemm<GemmPV>(c, (const bf16_t*)(ws + WS_PB), (const bf16_t*)(ws + WS_MVT) + (size_t)l * 8 * 65536);
          pg8::EpiPV E; E.O = (bf16_t*)(ws + WS_BR) + (size_t)3 * MPAD * BW; pg8::gemm_phase<GemmPV, pg8::EpiPV, true, true>(c.lds, c.tid, g, E); }
        xcd_barrier(bar);
        { const Ctx c = fresh(c0); unsigned char* ws = WSP();
          GemmBranch g = mk_gemm<GemmBranch>(c, (const bf16_t*)(ws + WS_BR), (const bf16_t*)(ws + WS_WBR) + (size_t)l * 4 * DM * BW);
          pg8::EpiMerge E; E.MG = (float*)(ws + WS_MG); E.MGB = (bf16_t*)(ws + WS_MGB); E.U = (const bf16_t*)(ws + WS_U); E.gate_b = INP(11) + (size_t)l * 4 * DM; pg8::gemm_phase<GemmBranch, pg8::EpiMerge, true, true>(c.lds, c.tid, g, E); }
        xcd_barrier(bar);
        { const Ctx c = fresh(c0); unsigned char* ws = WSP();
          GemmOut g = mk_gemm<GemmOut>(c, (const bf16_t*)(ws + WS_MGB), (const bf16_t*)(ws + WS_WOUT) + (size_t)l * DM * DM);
          pg8::EpiRes E; E.R = (const float*)(ws + WS_HF); E.Y = (float*)(ws + WS_Y); pg8::gemm_phase<GemmOut, pg8::EpiRes, true, true>(c.lds, c.tid, g, E); }
        xcd_barrier(bar);
        { const Ctx c = fresh(c0); unsigned char* ws = WSP(); ph_ln(c, (const float*)(ws + WS_Y), INP(31) + (size_t)l * DM, INP(32) + (size_t)l * DM, (float*)(ws + WS_X1F), (bf16_t*)(ws + WS_X1B), nullptr, MPAD, 0); }
        xcd_barrier(bar);
        { const Ctx c = fresh(c0); unsigned char* ws = WSP();
          GemmGU g = mk_gemm<GemmGU>(c, (const bf16_t*)(ws + WS_X1B), (const bf16_t*)(ws + WS_WGU) + (size_t)l * 2 * DFF * DM);
          pg8::EpiSwiGLU E; E.O = (bf16_t*)(ws + WS_ACT); pg8::gemm_phase<GemmGU, pg8::EpiSwiGLU, true, true>(c.lds, c.tid, g, E); }
        xcd_barrier(bar);
        { const Ctx c = fresh(c0); unsigned char* ws = WSP();
          GemmDown g = mk_gemm<GemmDown>(c, (const bf16_t*)(ws + WS_ACT), (const bf16_t*)(ws + WS_WDN) + (size_t)l * DM * DFF);
          pg8::EpiRes E; E.R = (const float*)(ws + WS_X1F); E.Y = (float*)(ws + WS_Y); pg8::gemm_phase<GemmDown, pg8::EpiRes, true, true>(c.lds, c.tid, g, E); }
        xcd_barrier(bar);
        { const Ctx c = fresh(c0); unsigned char* ws = WSP(); float* out = OUTP(); ph_ln(c, (const float*)(ws + WS_Y), INP(35) + (size_t)l * DM, INP(36) + (size_t)l * DM, (float*)(ws + WS_HF), (bf16_t*)(ws + WS_HB), l == NL - 1 ? out : nullptr, MPAD, MT); }
        xcd_barrier(bar);
    }
}

extern "C" void kernel_launch(void* const* d_in, const int* in_sizes, int n_in, void* d_out, int out_size, void* d_ws, size_t ws_size, hipStream_t stream) {
    static int grid = 0;
    if (grid == 0) {
        if (n_in != 37 || (size_t)out_size != O_END || ws_size < WS_END) { fprintf(stderr, "kernel_launch: unexpected sizes (n_in %d out %d ws %zu need %zu)\n", n_in, out_size, ws_size, (size_t)WS_END); grid = -1; return; }
        int dev = 0, cus = 0;
        if (hipGetDevice(&dev) != hipSuccess || hipDeviceGetAttribute(&cus, hipDeviceAttributeMultiprocessorCount, dev) != hipSuccess) { grid = -1; return; }
        if (hipFuncSetAttribute((const void*)mega_fwd, hipFuncAttributeMaxDynamicSharedMemorySize, LDS_BYTES) != hipSuccess) { fprintf(stderr, "kernel_launch: hipFuncSetAttribute failed\n"); grid = -1; return; }
        int per_cu = 0;
        if (hipOccupancyMaxActiveBlocksPerMultiprocessor(&per_cu, (const void*)mega_fwd, 512, LDS_BYTES) != hipSuccess || per_cu < 1) { fprintf(stderr, "kernel_launch: occupancy query says %d\n", per_cu); }
        (void)hipGetLastError();
        grid = cus;
    }
    if (grid < 0) return;
    (void)hipMemsetAsync((unsigned char*)d_ws + WS_CTL, 0, XCD_BAR_WORDS * sizeof(unsigned), stream);
    Args a; memset(&a, 0, sizeof a);
    for (int i = 0; i < 37; ++i) a.in[i] = (const float*)d_in[i];
    a.out = (float*)d_out; a.ws = (unsigned char*)d_ws;
    hipLaunchKernelGGL(mega_fwd, dim3(grid), dim3(512), LDS_BYTES, stream, a);
}
```

```cpp
#include <hip/hip_runtime.h>
#include <cstdio>
#include <cstdint>
#include <cstring>

#define LAS __attribute__((address_space(3)))
typedef unsigned short bf16_t;
typedef short bf16x8 __attribute__((ext_vector_type(8)));
typedef float f32x4 __attribute__((ext_vector_type(4)));
typedef float f32x2 __attribute__((ext_vector_type(2)));
typedef unsigned u32x4 __attribute__((ext_vector_type(4)));
typedef unsigned u32x2 __attribute__((ext_vector_type(2)));

constexpr int DM = 2048, NL = 4;
constexpr int PB = 2, PS = 4096, MP = PB * PS;
constexpr int SB = 32, SS = 4, MS = SB * SS;
constexpr int MT = MP + MS;
constexpr int MPAD = 8448;
constexpr int NIN = 16912, NINP = 17152;
constexpr int U_GQ = 0, U_GK = 512, U_GV = 1024, U_GR = 2048, U_GA = 3072, U_SQ = 3328, U_SK = 4352, U_SV = 4480, U_RU = 4608, U_MQ = 7936, U_GP = 8960;
constexpr int RWC = 3328, BW = 1024, DFF = 5632, MEMT = 256;
constexpr float ALPHA = 1.681792830507429f;

constexpr size_t O_YP = 0;
constexpr size_t O_YS = O_YP + (size_t)MP * DM;
constexpr size_t O_SWKP = O_YS + (size_t)MS * DM;
constexpr size_t O_SWVP = O_SWKP + (size_t)NL * PB * 128 * 128;
constexpr size_t O_MKP = O_SWVP + (size_t)NL * PB * 128 * 128;
constexpr size_t O_MVP = O_MKP + (size_t)NL * PB * 256 * 1024;
constexpr size_t O_GLAP = O_MVP + (size_t)NL * PB * 256 * 1024;
constexpr size_t O_RWP = O_GLAP + (size_t)NL * PB * 4 * 128 * 256;
constexpr size_t O_RSP = O_RWP + (size_t)NL * PB * 16 * 64 * 64;
constexpr size_t O_SWKS = O_RSP + (size_t)NL * PB * RWC;
constexpr size_t O_SWVS = O_SWKS + (size_t)NL * SB * 128 * 128;
constexpr size_t O_GLAS = O_SWVS + (size_t)NL * SB * 128 * 128;
constexpr size_t O_RWS = O_GLAS + (size_t)NL * SB * 4 * 128 * 256;
constexpr size_t O_RSS = O_RWS + (size_t)NL * SB * 16 * 64 * 64;
constexpr size_t O_END = O_RSS + (size_t)NL * SB * RWC;
static_assert(O_END == 52881408, "output size");

constexpr size_t al256(size_t x) { return (x + 255) & ~(size_t)255; }
constexpr size_t WS_CTL = 0;
constexpr size_t WS_WIN = 65536;
constexpr size_t WS_WMEM = WS_WIN + (size_t)NL * NINP * DM * 2;
constexpr size_t WS_WBR = WS_WMEM + (size_t)NL * DM * DM * 2;
constexpr size_t WS_WOUT = WS_WBR + (size_t)NL * 4 * DM * BW * 2;
constexpr size_t WS_WGU = WS_WOUT + (size_t)NL * DM * DM * 2;
constexpr size_t WS_WDN = WS_WGU + (size_t)NL * 2 * DFF * DM * 2;
constexpr size_t WS_HF = WS_WDN + (size_t)NL * DM * DFF * 2;
constexpr size_t WS_HB = WS_HF + (size_t)MPAD * DM * 4;
constexpr size_t WS_U = WS_HB + (size_t)MPAD * DM * 2;
constexpr size_t WS_BR = WS_U + (size_t)MPAD * NINP * 2;
constexpr size_t WS_MG = WS_BR + (size_t)4 * MPAD * BW * 2;
constexpr size_t WS_MGB = WS_MG + (size_t)MPAD * DM * 4;
constexpr size_t WS_Y = WS_MGB + (size_t)MPAD * DM * 2;
constexpr size_t WS_X1F = WS_Y + (size_t)MPAD * DM * 4;
constexpr size_t WS_X1B = WS_X1F + (size_t)MPAD * DM * 4;
constexpr size_t WS_ACT = WS_X1B + (size_t)MPAD * DM * 2;
constexpr size_t WS_MEMB = WS_ACT + (size_t)MPAD * DFF * 2;
constexpr size_t WS_MKB = WS_MEMB + (size_t)512 * DM * 2;
constexpr size_t WS_MVT = WS_MKB + (size_t)NL * 512 * 1024 * 2;
constexpr size_t WS_SC = WS_MVT + (size_t)NL * 8 * 256 * 256 * 2;
constexpr size_t WS_PB = WS_SC + (size_t)8 * 4096 * 256 * 4;
constexpr size_t WS_RW = WS_PB + (size_t)8 * 4096 * 256 * 2;
constexpr size_t RW_ARR = (size_t)MPAD * BW * 4;
constexpr int GL_NCH = 512 + 128;
constexpr size_t WS_GLQD = WS_RW + 8 * RW_ARR;
constexpr size_t WS_GLKH = WS_GLQD + (size_t)GL_NCH * 8192 * 2;
constexpr size_t WS_GLE = WS_GLKH + (size_t)GL_NCH * 8192 * 2;
constexpr size_t WS_GLVT = WS_GLE + (size_t)GL_NCH * 4096 * 2;
constexpr size_t WS_GLGC = WS_GLVT + (size_t)GL_NCH * 16384 * 2;
constexpr int RB_NCH = PB * 16 * 256 + SB * 16;
constexpr int RB_EL = 9216;
constexpr int RB_QP = 4608, RB_KHP = 5760, RB_VT = 7296, RB_EP = 8832;
constexpr size_t WS_RB = WS_GLGC + (size_t)GL_NCH * 128 * 4;
constexpr size_t WS_END = WS_RB + (size_t)RB_NCH * RB_EL * 2;

__device__ __forceinline__ float bf2f(bf16_t b) { return __uint_as_float(((unsigned)b) << 16); }
__device__ __forceinline__ bf16_t f2bf(float f) { unsigned u = __float_as_uint(f); u += 0x7FFFu + ((u >> 16) & 1u); return (bf16_t)(u >> 16); }
__device__ __forceinline__ unsigned pk2(float lo, float hi) { return (unsigned)f2bf(lo) | ((unsigned)f2bf(hi) << 16); }
__device__ __forceinline__ float wave_sum(float v) {
#pragma unroll
    for (int o = 32; o > 0; o >>= 1) v += __shfl_xor(v, o, 64);
    return v;
}
__device__ __forceinline__ float wave_max(float v) {
#pragma unroll
    for (int o = 32; o > 0; o >>= 1) v = fmaxf(v, __shfl_xor(v, o, 64));
    return v;
}
__device__ __forceinline__ float sigmoidf_(float x) { return 1.0f / (1.0f + __expf(-x)); }
__device__ __forceinline__ float softplusf_(float x) { return fmaxf(x, 0.f) + log1pf(__expf(-fabsf(x))); }

namespace pg8 {
constexpr int BM = 256, BK = 64, HALF = 128, HTB = HALF * BK * 2, STAGE_BYTES = 8 * HTB, NXCD = 8, WGM = 8;
__host__ __device__ __forceinline__ int lds_byte(int r, int c) { const int st = (r >> 4) * 2 + (c >> 5), rr = r & 15, cc = c & 31, ob = rr * 64 + cc * 2; return st * 1024 + (ob ^ (((ob >> 9) & 1) << 5)); }
__host__ __device__ __forceinline__ void stage_rc(int b, int& R, int& C) { const int st = b / 1024, sb = b % 1024, swz = sb ^ (((sb >> 9) & 1) << 5); R = (st >> 1) * 16 + swz / 64; C = (st & 1) * 32 + (swz % 64) / 2; }
__host__ __device__ __forceinline__ int perm32(int rho) { const int n = rho >> 4, i = rho & 15; return 8 * (i >> 2) + 4 * n + (i & 3); }

struct Unit { int pm, pn, z; };
template <int LDA_, int LDB_, int K_, int NM_, int NN_, int NZ_ = 1, int NZH_ = 1, bool ZINNER_ = false, long ZSAB_ = 0, long ZSAH_ = 0, long ZSBB_ = 0, long ZSBH_ = 0>
struct Gemm {
    static constexpr int LDA = LDA_, LDB = LDB_, K = K_, NM = NM_, NN = NN_, NZ = NZ_, NZH = NZH_; static constexpr bool ZINNER = ZINNER_;
    const bf16_t* A; const bf16_t* B; int G, c;
    __device__ __forceinline__ bool next(int i, Unit& u) const {
        constexpr int nt = NM * NN; int L, z;
        if (ZINNER) { const int it = i / NZ; z = i - it * NZ; const long LL = (long)it * G + c; if (LL >= nt) return false; L = (int)LL; }
        else { const long LL = (long)i * G + c; if (LL >= (long)nt * NZ) return false; z = (int)(LL / nt); L = (int)(LL - (long)z * nt); }
        int wgid = L; { constexpr int q = nt / NXCD, r = nt % NXCD; const int xcd = wgid % NXCD, off = wgid / NXCD; wgid = (xcd < r ? xcd * (q + 1) : r * (q + 1) + (xcd - r) * q) + off; }
        constexpr int nig = WGM * NN; const int gid = wgid / nig, fm = gid * WGM, gsz = (NM - fm) < WGM ? (NM - fm) : WGM;
        u.pm = fm + ((wgid % nig) % gsz); u.pn = (wgid % nig) / gsz; u.z = z; return true;
    }
    __device__ __forceinline__ const char* a_base(const Unit& u) const { const int zb = u.z / NZH, zh = u.z - zb * NZH; return (const char*)(A + zb * ZSAB_ + zh * ZSAH_ + (long)u.pm * BM * LDA); }
    __device__ __forceinline__ const char* b_base(const Unit& u) const { const int zb = u.z / NZH, zh = u.z - zb * NZH; return (const char*)(B + zb * ZSBB_ + zh * ZSBH_ + (long)u.pn * BM * LDB); }
};

template <class GT, class Epi, bool ALIGN_EPI = true, bool SP2 = true>
__device__ __forceinline__ void gemm_phase(LAS unsigned char* lds, const int tid, const GT& g, const Epi& E) {
    const int wid = __builtin_amdgcn_readfirstlane(tid >> 6), lane = tid & 63, wr = wid >> 2, wc = wid & 3, fr = lane & 15, fq = lane >> 4;
    constexpr int nt = GT::K / BK;
    unsigned voffA[2], voffB[2];
#pragma unroll
    for (int i = 0; i < 2; ++i) { int R, C; stage_rc(tid * 16 + i * 8192, R, C); const int Rb = Epi::PERM ? ((R & ~31) + perm32(R & 31)) : R;
        voffA[i] = (unsigned)(R * GT::LDA + C) * 2u; voffB[i] = (unsigned)(Rb * GT::LDB + C) * 2u; }
    constexpr size_t kstep = (size_t)(BK * 2);
    constexpr size_t hstepA = (size_t)HALF * GT::LDA * 2, hstepB = (size_t)HALF * GT::LDB * 2;
    const unsigned ldsw = (unsigned)wid * 1024u;
    const int aoff = lds_byte(wr * 64 + fr, fq * 8), boff = lds_byte(wc * 32 + fr, fq * 8);
#define PG8_SA(b, h) (((b) * 2 + (h)) * HTB)
#define PG8_SB(b, h) ((4 + (b) * 2 + (h)) * HTB)
#define PG8_STAGE(bufoff, gbase, voff) do { _Pragma("unroll") for (int _i = 0; _i < 2; ++_i) \
        __builtin_amdgcn_global_load_lds((const unsigned*)((const char*)(gbase) + (voff)[_i]), (LAS unsigned*)(lds + (bufoff) + ldsw + _i * 8192), 16, 0, 0); } while (0)
#define PG8_LDA(dst, b, h) do { _Pragma("unroll") for (int m = 0; m < 4; ++m) _Pragma("unroll") for (int k = 0; k < 2; ++k) dst[m][k] = *(const LAS bf16x8*)(lds + PG8_SA(b, h) + aoff + m * 2048 + k * 1024); } while (0)
#define PG8_LDB(dst, b, h) do { _Pragma("unroll") for (int n = 0; n < 2; ++n) _Pragma("unroll") for (int k = 0; k < 2; ++k) dst[n][k] = *(const LAS bf16x8*)(lds + PG8_SB(b, h) + boff + n * 2048 + k * 1024); } while (0)
#define PG8_MMA(ai, bj, At, Bt) do { __builtin_amdgcn_s_setprio(1); _Pragma("unroll") for (int m = 0; m < 4; ++m) _Pragma("unroll") for (int n = 0; n < 2; ++n) _Pragma("unroll") for (int k = 0; k < 2; ++k) \
        acc[ai][bj][m][n] = __builtin_amdgcn_mfma_f32_16x16x32_bf16(Bt[n][k], At[m][k], acc[ai][bj][m][n], 0, 0, 0); __builtin_amdgcn_s_setprio(0); } while (0)
#define PG8_WAIT_V(n) asm volatile("s_waitcnt vmcnt(" #n ")" ::: "memory")
#define PG8_WAIT_L(n) asm volatile("s_waitcnt lgkmcnt(" #n ")" ::: "memory")
#define PG8_BAR __builtin_amdgcn_s_barrier()
#define PG8_SCHED __builtin_amdgcn_sched_barrier(0)
    Unit cur, nxt; int ui = 0;
    if (!g.next(0, cur)) return;
    f32x4 acc[2][2][4][2];
#pragma unroll
    for (int a = 0; a < 2; ++a)
#pragma unroll
        for (int b = 0; b < 2; ++b)
#pragma unroll
            for (int m = 0; m < 4; ++m)
#pragma unroll
                for (int n = 0; n < 2; ++n) acc[a][b][m][n] = (f32x4){0.f, 0.f, 0.f, 0.f};
    bf16x8 At[4][2], B0[2][2], B1[2][2];
    const char* cA = g.a_base(cur); const char* cB = g.b_base(cur);
    if constexpr (SP2) {
        PG8_STAGE(PG8_SB(0, 0), cB, voffB); PG8_STAGE(PG8_SB(0, 1), cB + hstepB, voffB); PG8_STAGE(PG8_SA(0, 0), cA, voffA); PG8_STAGE(PG8_SA(0, 1), cA + hstepA, voffA);
        if (wr == 1) PG8_BAR;
        PG8_WAIT_V(2); PG8_BAR;
        PG8_STAGE(PG8_SB(1, 0), cB + kstep, voffB); PG8_STAGE(PG8_SA(1, 0), cA + kstep, voffA); PG8_STAGE(PG8_SB(1, 1), cB + hstepB + kstep, voffB);
        PG8_WAIT_V(6); PG8_BAR;
    } else {
        PG8_STAGE(PG8_SB(0, 0), cB, voffB); PG8_STAGE(PG8_SA(0, 0), cA, voffA); PG8_STAGE(PG8_SB(0, 1), cB + hstepB, voffB); PG8_STAGE(PG8_SA(0, 1), cA + hstepA, voffA);
        if (wr == 1) PG8_BAR;
        PG8_WAIT_V(4); PG8_BAR;
        PG8_STAGE(PG8_SB(1, 0), cB + kstep, voffB); PG8_STAGE(PG8_SA(1, 0), cA + kstep, voffA); PG8_STAGE(PG8_SB(1, 1), cB + hstepB + kstep, voffB);
        PG8_WAIT_V(6); PG8_BAR;
    }
    for (;;) {
        const bool has_next = g.next(ui + 1, nxt);
        const char* nA = has_next ? g.a_base(nxt) : cA; const char* nB = has_next ? g.b_base(nxt) : cB;
#pragma unroll 1
        for (int t = 0; t < nt; t += 2) {
            const bool last = (t == nt - 2);
            const char* a1 = cA + (size_t)(t + 1) * kstep;
            const char* a2 = last ? nA : cA + (size_t)(t + 2) * kstep; const char* b2 = last ? nB : cB + (size_t)(t + 2) * kstep;
            const char* a3 = a2 + kstep; const char* b3 = b2 + kstep;
            if constexpr (SP2) {
            PG8_LDB(B0, 0, 0); PG8_LDB(B1, 0, 1); PG8_SCHED; PG8_LDA(At, 0, 0); PG8_STAGE(PG8_SA(1, 1), a1 + hstepA, voffA);
            PG8_WAIT_V(8); PG8_WAIT_L(0); PG8_BAR; PG8_MMA(0, 0, At, B0); PG8_MMA(0, 1, At, B1); PG8_BAR; PG8_SCHED;
            PG8_LDA(At, 0, 1); PG8_STAGE(PG8_SB(0, 0), b2, voffB); PG8_STAGE(PG8_SB(0, 1), b2 + hstepB, voffB); PG8_STAGE(PG8_SA(0, 0), a2, voffA);
            PG8_WAIT_V(8); PG8_WAIT_L(0); PG8_BAR; PG8_MMA(1, 0, At, B0); PG8_MMA(1, 1, At, B1); PG8_BAR; PG8_SCHED;
            PG8_LDB(B0, 1, 0); PG8_LDB(B1, 1, 1); PG8_SCHED; PG8_LDA(At, 1, 0); PG8_STAGE(PG8_SA(0, 1), a2 + hstepA, voffA);
            PG8_WAIT_V(8); PG8_WAIT_L(0); PG8_BAR; PG8_MMA(0, 0, At, B0); PG8_MMA(0, 1, At, B1); PG8_BAR; PG8_SCHED;
            PG8_LDA(At, 1, 1); PG8_STAGE(PG8_SB(1, 0), b3, voffB); PG8_STAGE(PG8_SB(1, 1), b3 + hstepB, voffB); PG8_STAGE(PG8_SA(1, 0), a3, voffA);
            PG8_WAIT_V(8); PG8_WAIT_L(0); PG8_BAR; PG8_MMA(1, 0, At, B0); PG8_MMA(1, 1, At, B1); PG8_BAR; PG8_SCHED;
            } else {
            PG8_LDB(B0, 0, 0); PG8_SCHED; PG8_LDA(At, 0, 0); PG8_STAGE(PG8_SA(1, 1), a1 + hstepA, voffA);
            PG8_WAIT_L(8); PG8_BAR; PG8_WAIT_L(0); PG8_MMA(0, 0, At, B0); PG8_BAR; PG8_SCHED;
            PG8_LDB(B1, 0, 1); PG8_STAGE(PG8_SB(0, 0), b2, voffB);
            PG8_BAR; PG8_WAIT_L(0); PG8_MMA(0, 1, At, B1); PG8_BAR;
            PG8_LDA(At, 0, 1); PG8_STAGE(PG8_SA(0, 0), a2, voffA);
            PG8_BAR; PG8_WAIT_L(0); PG8_MMA(1, 0, At, B0); PG8_BAR; PG8_SCHED;
            PG8_STAGE(PG8_SB(0, 1), b2 + hstepB, voffB);
            PG8_WAIT_V(6); PG8_BAR; PG8_MMA(1, 1, At, B1); PG8_BAR;
            PG8_LDB(B0, 1, 0); PG8_SCHED; PG8_LDA(At, 1, 0); PG8_STAGE(PG8_SA(0, 1), a2 + hstepA, voffA);
            PG8_WAIT_L(8); PG8_BAR; PG8_WAIT_L(0); PG8_MMA(0, 0, At, B0); PG8_BAR; PG8_SCHED;
            PG8_LDB(B1, 1, 1); PG8_STAGE(PG8_SB(1, 0), b3, voffB);
            PG8_BAR; PG8_WAIT_L(0); PG8_MMA(0, 1, At, B1); PG8_BAR;
            PG8_LDA(At, 1, 1); PG8_STAGE(PG8_SA(1, 0), a3, voffA);
            PG8_BAR; PG8_WAIT_L(0); PG8_MMA(1, 0, At, B0); PG8_BAR; PG8_SCHED;
            PG8_STAGE(PG8_SB(1, 1), b3 + hstepB, voffB);
            PG8_WAIT_V(6); PG8_BAR; PG8_MMA(1, 1, At, B1); PG8_BAR;
            }
        }
        if constexpr (ALIGN_EPI) { if (wr == 0) PG8_BAR; }
        E(acc, cur, wr, wc, fr, fq);
        if (!has_next) break;
#pragma unroll
        for (int a = 0; a < 2; ++a)
#pragma unroll
            for (int b = 0; b < 2; ++b)
#pragma unroll
                for (int m = 0; m < 4; ++m)
#pragma unroll
                    for (int n = 0; n < 2; ++n) acc[a][b][m][n] = (f32x4){0.f, 0.f, 0.f, 0.f};
        cur = nxt; cA = nA; cB = nB; ++ui;
        if constexpr (ALIGN_EPI) { if (wr == 1) PG8_BAR; }
    }
    PG8_WAIT_V(0);
    if constexpr (!ALIGN_EPI) { if (wr == 0) PG8_BAR; }
    PG8_BAR;
#undef PG8_SA
#undef PG8_SB
#undef PG8_STAGE
#undef PG8_LDA
#undef PG8_LDB
#undef PG8_MMA
#undef PG8_WAIT_V
#undef PG8_WAIT_L
#undef PG8_BAR
#undef PG8_SCHED
}

struct EpiBf16 {
    static constexpr bool PERM = true;
    bf16_t* O; long zs; int ldc, pad;
    __device__ __forceinline__ void operator()(const f32x4 (&acc)[2][2][4][2], const Unit& u, int wr, int wc, int fr, int fq) const {
        const int row0 = u.pm * BM + wr * 64 + fr, col0 = u.pn * BM + wc * 32 + 8 * fq; bf16_t* base = O + (long)u.z * zs;
#pragma unroll
        for (int ai = 0; ai < 2; ++ai)
#pragma unroll
            for (int m = 0; m < 4; ++m) { bf16_t* rowp = base + (size_t)(row0 + ai * HALF + m * 16) * ldc + col0;
#pragma unroll
                for (int bj = 0; bj < 2; ++bj) { const f32x4 v0 = acc[ai][bj][m][0], v1 = acc[ai][bj][m][1];
                    u32x4 w; w.x = pk2(v0[0], v0[1]); w.y = pk2(v0[2], v0[3]); w.z = pk2(v1[0], v1[1]); w.w = pk2(v1[2], v1[3]);
                    *(u32x4*)(rowp + bj * HALF) = w; } }
    }
};
struct EpiMem {
    static constexpr bool PERM = false;
    float* outK; float* outV; bf16_t* kb; bf16_t* vt;
    __device__ __forceinline__ void operator()(const f32x4 (&acc)[2][2][4][2], const Unit& u, int wr, int wc, int fr, int fq) const {
        const int row0 = u.pm * BM + wr * 64 + fr, col0 = u.pn * BM + wc * 32 + 4 * fq;
#pragma unroll
        for (int ai = 0; ai < 2; ++ai)
#pragma unroll
            for (int m = 0; m < 4; ++m) { const int row = row0 + ai * HALF + m * 16;
#pragma unroll
                for (int bj = 0; bj < 2; ++bj)
#pragma unroll
                    for (int n = 0; n < 2; ++n) { const int col = col0 + bj * HALF + n * 16; const f32x4 v = acc[ai][bj][m][n];
                        if (col < 1024) { *(f32x4*)(outK + ((size_t)u.z * 512 + row) * 1024 + col) = v;
                            u32x2 w; w.x = pk2(v[0], v[1]); w.y = pk2(v[2], v[3]); *(u32x2*)(kb + ((size_t)u.z * 512 + row) * 1024 + col) = w; }
                        else { const int c = col - 1024; *(f32x4*)(outV + ((size_t)u.z * 512 + row) * 1024 + c) = v;
                            const int b = row >> 8, mm = row & 255, h = c >> 8, d = c & 255; bf16_t* p = vt + ((((size_t)u.z * 2 + b) * 4 + h) * 256 + d) * 256 + mm;
                            p[0] = f2bf(v[0]); p[256] = f2bf(v[1]); p[512] = f2bf(v[2]); p[768] = f2bf(v[3]); } } }
    }
};
struct EpiMerge {
    static constexpr bool PERM = false;
    float* MG; bf16_t* MGB; const bf16_t* U; const float* gate_b;
    __device__ __forceinline__ void operator()(const f32x4 (&acc)[2][2][4][2], const Unit& u, int wr, int wc, int fr, int fq) const {
        const int row0 = u.pm * BM + wr * 64 + fr, col0 = u.pn * BM + wc * 32 + 4 * fq;
#pragma unroll
        for (int ai = 0; ai < 2; ++ai)
#pragma unroll
            for (int m = 0; m < 4; ++m) { const int row = row0 + ai * HALF + m * 16;
#pragma unroll
                for (int bj = 0; bj < 2; ++bj)
#pragma unroll
                    for (int n = 0; n < 2; ++n) { const int col = col0 + bj * HALF + n * 16; const f32x4 v = acc[ai][bj][m][n];
                        const u32x2 gp = *(const u32x2*)(U + (size_t)row * NINP + U_GP + u.z * DM + col); const f32x4 gb = *(const f32x4*)(gate_b + u.z * DM + col);
                        f32x4 gt; gt[0] = sigmoidf_(__uint_as_float(gp.x << 16) + gb[0]); gt[1] = sigmoidf_(__uint_as_float(gp.x & 0xffff0000u) + gb[1]);
                        gt[2] = sigmoidf_(__uint_as_float(gp.y << 16) + gb[2]); gt[3] = sigmoidf_(__uint_as_float(gp.y & 0xffff0000u) + gb[3]);
                        float* mp = MG + (size_t)row * DM + col; f32x4 r = gt * v;
                        if (u.z > 0) r += *(const f32x4*)mp;
                        if (u.z < 3) *(f32x4*)mp = r;
                        else { u32x2 w; w.x = pk2(r[0], r[1]); w.y = pk2(r[2], r[3]); *(u32x2*)(MGB + (size_t)row * DM + col) = w; } } }
    }
};
struct EpiRes {
    static constexpr bool PERM = false;
    const float* R; float* Y;
    __device__ __forceinline__ void operator()(const f32x4 (&acc)[2][2][4][2], const Unit& u, int wr, int wc, int fr, int fq) const {
        const int row0 = u.pm * BM + wr * 64 + fr, col0 = u.pn * BM + wc * 32 + 4 * fq;
#pragma unroll
        for (int ai = 0; ai < 2; ++ai)
#pragma unroll
            for (int m = 0; m < 4; ++m) { const size_t ro = (size_t)(row0 + ai * HALF + m * 16) * DM + col0;
#pragma unroll
                for (int bj = 0; bj < 2; ++bj)
#pragma unroll
                    for (int n = 0; n < 2; ++n) { const size_t o = ro + bj * HALF + n * 16; *(f32x4*)(Y + o) = *(const f32x4*)(R + o) * ALPHA + acc[ai][bj][m][n]; } }
    }
};
struct EpiSwiGLU {
    static constexpr bool PERM = true;
    bf16_t* O;
    __device__ __forceinline__ void operator()(const f32x4 (&acc)[2][2][4][2], const Unit& u, int wr, int wc, int fr, int fq) const {
        const int row0 = u.pm * BM + wr * 64 + fr, col0 = u.pn * HALF + wc * 32 + 8 * fq;
#pragma unroll
        for (int ai = 0; ai < 2; ++ai)
#pragma unroll
            for (int m = 0; m < 4; ++m) { bf16_t* rowp = O + (size_t)(row0 + ai * HALF + m * 16) * DFF + col0;
                float r[8];
#pragma unroll
                for (int n = 0; n < 2; ++n)
#pragma unroll
                    for (int j = 0; j < 4; ++j) { const float gg = acc[ai][0][m][n][j], uu = acc[ai][1][m][n][j]; r[n * 4 + j] = gg * sigmoidf_(gg) * uu; }
                u32x4 w; w.x = pk2(r[0], r[1]); w.y = pk2(r[2], r[3]); w.z = pk2(r[4], r[5]); w.w = pk2(r[6], r[7]);
                *(u32x4*)rowp = w; }
    }
};
struct EpiScore {
    static constexpr bool PERM = false;
    float* SC;
    __device__ __forceinline__ void operator()(const f32x4 (&acc)[2][2][4][2], const Unit& u, int wr, int wc, int fr, int fq) const {
        const int row0 = u.pm * BM + wr * 64 + fr, col0 = wc * 32 + 4 * fq; float* base = SC + (size_t)u.z * 4096 * 256;
#pragma unroll
        for (int ai = 0; ai < 2; ++ai)
#pragma unroll
            for (int m = 0; m < 4; ++m) { float* rowp = base + (size_t)(row0 + ai * HALF + m * 16) * 256 + col0;
#pragma unroll
                for (int bj = 0; bj < 2; ++bj)
#pragma unroll
                    for (int n = 0; n < 2; ++n) *(f32x4*)(rowp + bj * HALF + n * 16) = acc[ai][bj][m][n] * 0.0625f; }
    }
};
struct EpiPV {
    static constexpr bool PERM = true;
    bf16_t* O;
    __device__ __forceinline__ void operator()(const f32x4 (&acc)[2][2][4][2], const Unit& u, int wr, int wc, int fr, int fq) const {
        const int b = u.z >> 2, h = u.z & 3; const int row0 = b * PS + u.pm * BM + wr * 64 + fr, col0 = h * 256 + wc * 32 + 8 * fq;
#pragma unroll
        for (int ai = 0; ai < 2; ++ai)
#pragma unroll
            for (int m = 0; m < 4; ++m) { bf16_t* rowp = O + (size_t)(row0 + ai * HALF + m * 16) * BW + col0;
#pragma unroll
                for (int bj = 0; bj < 2; ++bj) { const f32x4 v0 = acc[ai][bj][m][0], v1 = acc[ai][bj][m][1];
                    u32x4 w; w.x = pk2(v0[0], v0[1]); w.y = pk2(v0[2], v0[3]); w.z = pk2(v1[0], v1[1]); w.w = pk2(v1[2], v1[3]);
                    *(u32x4*)(rowp + bj * HALF) = w; } }
    }
};
}


#define XB_TMO      128
#define XB_XCNT(j)  (256  + 64 * (j))
#define XB_XSUB(j)  (1280 + 64 * (j))
#define XB_XGEN(j)  (2304 + 64 * (j))
#define XB_TOP      3328
#define XB_TOPGEN   3392
#define XCD_BAR_WORDS 3456
#define XB_SPIN_CAP (1u << 18)
__device__ __forceinline__ unsigned xb_ld(unsigned* p)              { return __hip_atomic_load(p, __ATOMIC_RELAXED, __HIP_MEMORY_SCOPE_AGENT); }
__device__ __forceinline__ unsigned xb_add(unsigned* p, unsigned v) { return __hip_atomic_fetch_add(p, v, __ATOMIC_RELAXED, __HIP_MEMORY_SCOPE_AGENT); }
__device__ __forceinline__ unsigned xb_xcc_id() { return (unsigned)__builtin_amdgcn_s_getreg((3 << 11) | 20) & 0xFu; }
#define XB_SPIN(cond, bar) do { unsigned _sp = 0; while (cond) { __builtin_amdgcn_s_sleep(1); \
    if ((++_sp & 255u) == 0u) { if (xb_ld(&(bar)[XB_TMO])) break; if (_sp > XB_SPIN_CAP) { atomicAdd(&(bar)[XB_TMO], 1u); break; } } } } while (0)
struct XcdBarrier { unsigned* bar; unsigned x; volatile LAS unsigned* st; };
__device__ __forceinline__ XcdBarrier xcd_barrier_post(unsigned* bar, volatile LAS unsigned* st) {
    XcdBarrier b; b.bar = bar; b.x = xb_xcc_id(); b.st = st;
    if (threadIdx.x == 0) (void)xb_add(&bar[XB_XCNT(b.x)], 1u);
    return b;
}
__device__ __forceinline__ void xcd_barrier_complete(unsigned* bar, unsigned x, unsigned& nloc, unsigned& nx) {
    const unsigned G = gridDim.x * gridDim.y * gridDim.z;
    unsigned sum, cnt, mine, sp = 0u;
    for (;;) {
        sum = 0u; cnt = 0u; mine = 0u;
#pragma unroll
        for (unsigned j = 0; j < 16; ++j) { const unsigned c = xb_ld(&bar[XB_XCNT(j)]); sum += c; cnt += (c > 0u) ? 1u : 0u; mine = (j == x) ? c : mine; }
        if (sum == G) break;
        __builtin_amdgcn_s_sleep(1);
        if ((++sp & 255u) == 0u) { if (xb_ld(&bar[XB_TMO])) break; if (sp > XB_SPIN_CAP) { atomicAdd(&bar[XB_TMO], 1u); break; } }
    }
    nloc = mine > 0u ? mine : 1u; nx = cnt > 0u ? cnt : 1u;
}
__device__ __forceinline__ void xcd_barrier(const XcdBarrier& b) {
    asm volatile("s_waitcnt vmcnt(0)" ::: "memory");
    __syncthreads();
    if (threadIdx.x == 0) {
        unsigned* bar = b.bar;
        __builtin_amdgcn_s_waitcnt(0);
        unsigned nloc = b.st[0], nx = b.st[1];
        if (nloc == 0u) { xcd_barrier_complete(bar, b.x, nloc, nx); b.st[0] = nloc; b.st[1] = nx; }
        const unsigned old = xb_add(&bar[XB_XSUB(b.x)], 1u);
        const unsigned gen = old / nloc;
        if (old + 1u == (gen + 1u) * nloc) {
            __builtin_amdgcn_fence(__ATOMIC_RELEASE, "agent");
            asm volatile("s_waitcnt vmcnt(0)" ::: "memory");
            const unsigned og = xb_add(&bar[XB_TOP], 1u);
            const unsigned tg = og / nx;
            if (og + 1u == (tg + 1u) * nx) xb_add(&bar[XB_TOPGEN], 1u);
            else XB_SPIN(xb_ld(&bar[XB_TOPGEN]) == tg, bar);
            __builtin_amdgcn_fence(__ATOMIC_ACQUIRE, "agent");
            xb_add(&bar[XB_XGEN(b.x)], 1u);
            asm volatile("s_waitcnt vmcnt(0)" ::: "memory");
        } else {
            XB_SPIN(xb_ld(&bar[XB_XGEN(b.x)]) == gen, bar);
            __builtin_amdgcn_fence(__ATOMIC_ACQUIRE, "agent");
            asm volatile("s_waitcnt vmcnt(0)" ::: "memory");
        }
    }
    __syncthreads();
}

struct Ctx { int tid, lane, wave, bid, G; LAS unsigned char* lds; };
__device__ __forceinline__ Ctx fresh(const Ctx& c0) { Ctx c; c.wave = c0.wave; c.bid = c0.bid; c.G = c0.G; c.lds = c0.lds; asm volatile("" : "+s"(c.bid), "+s"(c.G), "+s"(c.wave));
    int lane = (int)__builtin_amdgcn_mbcnt_hi(~0u, __builtin_amdgcn_mbcnt_lo(~0u, 0u)); asm volatile("" : "+v"(lane)); c.lane = lane; c.tid = c.wave * 64 + lane; return c; }

__device__ __forceinline__ int colmap(int mode, int n) {
    if (mode == 1) return n < 3088 ? n : (n < 3328 ? -1 : n - 240);
    if (mode == 2) { const int t = n >> 8, j = n & 255; return j < 128 ? t * 128 + j : DFF + t * 128 + (j - 128); }
    return n;
}
__device__ __forceinline__ void wprep_load(f32x4 (&rg)[8], const float* __restrict__ src, int K, int Nsrc, int Ndst, int mode, size_t sbs, int item, int tid) {
    const int nx = Ndst / 256, ny = K / 64; const int bx = item % nx, by = (item / nx) % ny, bz = item / (nx * ny);
    const int tx = tid & 63, ty = tid >> 6, cm = colmap(mode, bx * 256 + tx * 4); const float* s = src + (size_t)bz * sbs + (size_t)(by * 64 + ty) * Nsrc + cm;
#pragma unroll
    for (int i = 0; i < 8; ++i) rg[i] = cm >= 0 ? *(const f32x4*)(s + (size_t)(8 * i) * Nsrc) : (f32x4){0.f, 0.f, 0.f, 0.f};
}
__device__ __forceinline__ void ph_wprep(const Ctx& c, const float* __restrict__ src, bf16_t* __restrict__ dst, int K, int Nsrc, int Ndst, int mode, int nbatch, size_t sbs, size_t dbs) {
    LAS float* tile = (LAS float*)c.lds;
    const int nx = Ndst / 256, ny = K / 64, total = nx * ny * nbatch;
    const int tid = c.tid, tx = tid & 63, ty = tid >> 6, n = tid >> 1, kh = tid & 1;
    f32x4 rg[8];
    int item = c.bid;
    if (item < total) wprep_load(rg, src, K, Nsrc, Ndst, mode, sbs, item, tid);
    for (; item < total; item += c.G) {
        __syncthreads();
#pragma unroll
        for (int i = 0; i < 8; ++i) *(LAS f32x4*)(tile + (ty + 8 * i) * 260 + tx * 4) = rg[i];
        __syncthreads();
        const int bx = item % nx, by = (item / nx) % ny, bz = item / (nx * ny);
        if (item + c.G < total) wprep_load(rg, src, K, Nsrc, Ndst, mode, sbs, item + c.G, tid);
        bf16_t* d = dst + (size_t)bz * dbs + (size_t)(bx * 256 + n) * K + by * 64 + kh * 32;
#pragma unroll
        for (int g = 0; g < 4; ++g) { unsigned p[4];
#pragma unroll
            for (int e = 0; e < 4; ++e) p[e] = pk2(tile[(kh * 32 + g * 8 + 2 * e) * 260 + n], tile[(kh * 32 + g * 8 + 2 * e + 1) * 260 + n]);
            *(u32x4*)(d + g * 8) = (u32x4){p[0], p[1], p[2], p[3]}; }
    }
    __syncthreads();
}
__device__ __forceinline__ void ph_xprep(const Ctx& c, const float* __restrict__ xp, const float* __restrict__ xs, const float* __restrict__ mem, float* __restrict__ HF, bf16_t* __restrict__ HB, bf16_t* __restrict__ MEMB) {
    const size_t nH = (size_t)MPAD * DM / 4, nM = (size_t)512 * DM / 4;
    for (size_t i4 = (size_t)c.bid * 512 + c.tid; i4 < nH + nM; i4 += (size_t)c.G * 512) {
        if (i4 < nH) {
            const size_t e = i4 * 4; f32x4 v = (f32x4){0.f, 0.f, 0.f, 0.f};
            if (e < (size_t)MP * DM) v = *(const f32x4*)(xp + e); else if (e < (size_t)MT * DM) v = *(const f32x4*)(xs + (e - (size_t)MP * DM));
            *(f32x4*)(HF + e) = v; u32x2 w; w.x = pk2(v[0], v[1]); w.y = pk2(v[2], v[3]); *(u32x2*)(HB + e) = w;
        } else {
            const size_t e = (i4 - nH) * 4; const f32x4 v = *(const f32x4*)(mem + e); u32x2 w; w.x = pk2(v[0], v[1]); w.y = pk2(v[2], v[3]); *(u32x2*)(MEMB + e) = w;
        }
    }
}
__device__ __forceinline__ void ph_ln(const Ctx& c, const float* __restrict__ Y, const float* __restrict__ g, const float* __restrict__ b, float* __restrict__ XF, bf16_t* __restrict__ XB, float* __restrict__ OUT, int nrows, int nout) {
    const int lane = c.lane;
    for (int row = c.bid * 8 + c.wave; row < nrows; row += c.G * 8) {
        const float* y = Y + (size_t)row * DM; f32x4 v[8]; float s = 0.f;
#pragma unroll
        for (int j = 0; j < 8; ++j) { v[j] = *(const f32x4*)(y + j * 256 + lane * 4); s += (v[j][0] + v[j][1]) + (v[j][2] + v[j][3]); }
        const float mean = wave_sum(s) * (1.0f / DM); float q = 0.f;
#pragma unroll
        for (int j = 0; j < 8; ++j) { const f32x4 d = v[j] - mean; q += (d[0] * d[0] + d[1] * d[1]) + (d[2] * d[2] + d[3] * d[3]); }
        const float rstd = rsqrtf(wave_sum(q) * (1.0f / DM) + 1e-5f);
#pragma unroll
        for (int j = 0; j < 8; ++j) { const int cc = j * 256 + lane * 4; const f32x4 gg = *(const f32x4*)(g + cc), bb = *(const f32x4*)(b + cc);
            const f32x4 o = (v[j] - mean) * rstd * gg + bb; const size_t off = (size_t)row * DM + cc;
            *(f32x4*)(XF + off) = o; u32x2 w; w.x = pk2(o[0], o[1]); w.y = pk2(o[2], o[3]); *(u32x2*)(XB + off) = w;
            if (OUT != nullptr && row < nout) *(f32x4*)(OUT + off) = o; }
    }
}
__device__ __forceinline__ void ph_softmax256(const Ctx& c, const float* __restrict__ SC, bf16_t* __restrict__ P, int nrows) {
    const int lane = c.lane;
    for (int row = c.bid * 8 + c.wave; row < nrows; row += c.G * 8) {
        const f32x4 v = *(const f32x4*)(SC + (size_t)row * 256 + lane * 4);
        const float mx = wave_max(fmaxf(fmaxf(v[0], v[1]), fmaxf(v[2], v[3])));
        f32x4 e; e[0] = __expf(v[0] - mx); e[1] = __expf(v[1] - mx); e[2] = __expf(v[2] - mx); e[3] = __expf(v[3] - mx);
        const float inv = 1.0f / wave_sum((e[0] + e[1]) + (e[2] + e[3]));
        u32x2 w; w.x = pk2(e[0] * inv, e[1] * inv); w.y = pk2(e[2] * inv, e[3] * inv); *(u32x2*)(P + (size_t)row * 256 + lane * 4) = w;
    }
}
__device__ __forceinline__ void ph_copy_outs(const Ctx& c, const bf16_t* __restrict__ U, const float* __restrict__ ck, const float* __restrict__ cv, float* __restrict__ out, int layer) {
    constexpr int nA = PB * 128 * 128, nB = SB * 128 * 128, nC = PB * RWC, nD = SB * RWC;
    for (int i = c.bid * 512 + c.tid; i < nA + nB + nC + nD; i += c.G * 512) {
        if (i < nA) { const int b = i / 16384, j = (i >> 7) & 127, cc = i & 127; const size_t ur = (size_t)(b * PS + PS - 128 + j) * NINP;
            out[O_SWKP + (size_t)layer * nA + i] = bf2f(U[ur + U_SK + cc]); out[O_SWVP + (size_t)layer * nA + i] = bf2f(U[ur + U_SV + cc]); continue; }
        int k = i - nA;
        if (k < nB) { const int sq = k / 16384, j = (k >> 7) & 127, cc = k & 127; float kv, vv;
            if (j < 124) { const size_t o = ((size_t)sq * 128 + j + 4) * 128 + cc; kv = ck[o]; vv = cv[o]; }
            else { const size_t ur = (size_t)(MP + sq * SS + j - 124) * NINP; kv = bf2f(U[ur + U_SK + cc]); vv = bf2f(U[ur + U_SV + cc]); }
            out[O_SWKS + (size_t)layer * nB + k] = kv; out[O_SWVS + (size_t)layer * nB + k] = vv; continue; }
        k -= nB;
        if (k < nC) { const int b = k / RWC, cc = k - b * RWC; out[O_RSP + (size_t)layer * nC + k] = bf2f(U[(size_t)(b * PS + PS - 1) * NINP + U_RU + cc]); continue; }
        k -= nC;
        { const int sq = k / RWC, cc = k - sq * RWC; out[O_RSS + (size_t)layer * nD + k] = bf2f(U[(size_t)(MP + sq * SS + SS - 1) * NINP + U_RU + cc]); }
    }
}

__device__ __forceinline__ void seq_info(int sq, int& row0, int& L) { if (sq < PB) { row0 = sq * PS; L = PS; } else { row0 = MP + (sq - PB) * SS; L = SS; } }

__device__ __forceinline__ void ph_gla_naive(const Ctx& c, const bf16_t* __restrict__ U, const float* __restrict__ s0, const float* __restrict__ a_up, const float* __restrict__ a_b,
                                             const float* __restrict__ ng, const float* __restrict__ nb, bf16_t* __restrict__ OB, float* __restrict__ outP, float* __restrict__ outS) {
    LAS float* qs = (LAS float*)c.lds;
    LAS float* ks = qs + 16 * 128; LAS float* as = ks + 16 * 128; LAS float* os = as + 16 * 128;
    const int kh = c.tid >> 8, vt = c.tid & 255, lane = c.lane;
    for (int u = c.bid; u < (PB + SB) * 4; u += c.G) {
        const int sq = u >> 2, h = u & 3;
        int row0, L; seq_info(sq, row0, L);
        float S[64];
        if (sq >= PB) { const float* p = s0 + (((size_t)(sq - PB) * 4 + h) * 128 + kh * 64) * 256 + vt;
#pragma unroll
            for (int kk = 0; kk < 64; ++kk) S[kk] = p[(size_t)kk * 256]; }
        else {
#pragma unroll
            for (int kk = 0; kk < 64; ++kk) S[kk] = 0.f; }
        for (int t0 = 0; t0 < L; t0 += 16) {
            const int nT = (L - t0) < 16 ? (L - t0) : 16;
            for (int idx = c.tid; idx < nT * 128; idx += 512) {
                const int tt = idx >> 7, kk = idx & 127; const bf16_t* ur = U + (size_t)(row0 + t0 + tt) * NINP;
                qs[idx] = bf2f(ur[U_GQ + h * 128 + kk]) * 0.08838834764831845f; ks[idx] = bf2f(ur[U_GK + h * 128 + kk]);
                float x = a_b[h * 128 + kk];
#pragma unroll
                for (int r = 0; r < 16; ++r) x += bf2f(ur[U_GA + r]) * a_up[r * 512 + h * 128 + kk];
                const float ls = (fminf(x, 0.f) - log1pf(__expf(-fabsf(x)))) * (1.0f / 16.0f);
                as[idx] = __expf(ls);
            }
            __syncthreads();
            for (int tt = 0; tt < nT; ++tt) {
                const float v = bf2f(U[(size_t)(row0 + t0 + tt) * NINP + U_GV + h * 256 + vt]); float o = 0.f; const int lb = tt * 128 + kh * 64;
#pragma unroll
                for (int kk = 0; kk < 64; ++kk) { S[kk] = as[lb + kk] * S[kk] + ks[lb + kk] * v; o += qs[lb + kk] * S[kk]; }
                os[(kh * 16 + tt) * 256 + vt] = o;
            }
            __syncthreads();
            for (int tt = c.wave; tt < nT; tt += 8) {
                float x[4]; float s = 0.f;
#pragma unroll
                for (int j = 0; j < 4; ++j) { x[j] = os[tt * 256 + lane + 64 * j] + os[(16 + tt) * 256 + lane + 64 * j]; s += x[j]; }
                const float mean = wave_sum(s) * (1.0f / 256.0f); float q = 0.f;
#pragma unroll
                for (int j = 0; j < 4; ++j) { const float d = x[j] - mean; q += d * d; }
                const float rstd = rsqrtf(wave_sum(q) * (1.0f / 256.0f) + 1e-5f);
                const size_t row = (size_t)(row0 + t0 + tt);
#pragma unroll
                for (int j = 0; j < 4; ++j) { const int cc = h * 256 + lane + 64 * j; const float n = (x[j] - mean) * rstd * ng[cc] + nb[cc];
                    const float gr = bf2f(U[row * NINP + U_GR + cc]); OB[row * BW + cc] = f2bf(n * gr * sigmoidf_(gr)); }
            }
            __syncthreads();
        }
        float* op = (sq < PB ? outP + (((size_t)sq * 4 + h) * 128 + kh * 64) * 256 : outS + (((size_t)(sq - PB) * 4 + h) * 128 + kh * 64) * 256) + vt;
#pragma unroll
        for (int kk = 0; kk < 64; ++kk) op[(size_t)kk * 256] = S[kk];
    }
}

__device__ __forceinline__ f32x4 mma16(bf16x8 x, bf16x8 y, f32x4 c) { return __builtin_amdgcn_mfma_f32_16x16x32_bf16(x, y, c, 0, 0, 0); }
__device__ __forceinline__ bf16x8 pack_acc(const f32x4& a, const f32x4& b) {
    u32x4 p; p.x = pk2(a[0], a[1]); p.y = pk2(a[2], a[3]); p.z = pk2(b[0], b[1]); p.w = pk2(b[2], b[3]); return __builtin_bit_cast(bf16x8, p);
}
__device__ __forceinline__ void gla_chunk_info(int u, int& row0, int& ntok, int& h) {
    if (u < 512) { const int b = u >> 8; h = (u >> 6) & 3; row0 = b * PS + (u & 63) * 64; ntok = 64; }
    else { const int s = u - 512; h = s & 3; row0 = MP + (s >> 2) * SS; ntok = SS; }
}
__device__ __forceinline__ void ph_gla_pre(const Ctx& c, const bf16_t* __restrict__ U, const float* __restrict__ a_up, const float* __restrict__ a_b,
                                           bf16_t* __restrict__ QD, bf16_t* __restrict__ KHT, bf16_t* __restrict__ EE, bf16_t* __restrict__ VT, float* __restrict__ GC) {
    LAS float* ga_l = (LAS float*)c.lds;
    LAS float* tot = ga_l + 64 * 16;
    LAS bf16_t* Qd_l = (LAS bf16_t*)(tot + 4 * 128);
    LAS bf16_t* Kn_l = Qd_l + 64 * 136;
    LAS bf16_t* v_l = Kn_l + 64 * 136;
    const int tid = c.tid, lane = c.lane, r = lane & 15, q = lane >> 4, w = c.wave;
    for (int u = c.bid; u < GL_NCH; u += c.G) {
        int row0, ntok, h; gla_chunk_info(u, row0, ntok, h);
        for (int i = tid; i < 64 * 16; i += 512) { const int t = i >> 4, rr = i & 15; ga_l[i] = t < ntok ? bf2f(U[(size_t)(row0 + t) * NINP + U_GA + rr]) : 0.f; }
        for (int i = tid; i < 64 * 32; i += 512) { const int t = i >> 5, c8 = i & 31; u32x4 vv = (u32x4){0u, 0u, 0u, 0u};
            if (t < ntok) vv = *(const u32x4*)(U + (size_t)(row0 + t) * NINP + U_GV + h * 256 + c8 * 8);
            *(LAS u32x4*)(v_l + t * 264 + c8 * 8) = vv; }
        __syncthreads();
        const int kk = tid & 127, tq = tid >> 7;
        float cum[16];
        { float aup[16];
#pragma unroll
          for (int rr = 0; rr < 16; ++rr) aup[rr] = a_up[rr * 512 + h * 128 + kk];
          const float ab = a_b[h * 128 + kk]; float run = 0.f;
#pragma unroll
          for (int j = 0; j < 16; ++j) { const int t = tq * 16 + j; float x = ab;
#pragma unroll
              for (int rr = 0; rr < 16; ++rr) x += ga_l[t * 16 + rr] * aup[rr];
              const float la = t < ntok ? (fminf(x, 0.f) - log1pf(__expf(-fabsf(x)))) * (1.0f / 16.0f) : 0.f;
              run += la; cum[j] = run; }
          tot[tq * 128 + kk] = run; }
        __syncthreads();
        { float prefix = 0.f, bC = 0.f;
#pragma unroll
          for (int g = 0; g < 4; ++g) { const float tv = tot[g * 128 + kk]; bC += tv; if (g < tq) prefix += tv; }
          unsigned khp[8];
#pragma unroll
          for (int j = 0; j < 16; j += 2) { float kh2[2];
#pragma unroll
              for (int e = 0; e < 2; ++e) { const int t = tq * 16 + j + e; const float b = prefix + cum[j + e]; float qv = 0.f, kv = 0.f;
                  if (t < ntok) { const bf16_t* ur = U + (size_t)(row0 + t) * NINP; qv = bf2f(ur[U_GQ + h * 128 + kk]); kv = bf2f(ur[U_GK + h * 128 + kk]); }
                  Qd_l[t * 136 + kk] = f2bf(qv * __expf(b) * 0.08838834764831845f); Kn_l[t * 136 + kk] = f2bf(kv * __expf(-b)); kh2[e] = kv * __expf(bC - b); }
              khp[j >> 1] = pk2(kh2[0], kh2[1]); }
          bf16_t* kp = KHT + (size_t)u * 8192 + kk * 64 + tq * 16;
          *(u32x4*)kp = (u32x4){khp[0], khp[1], khp[2], khp[3]}; *(u32x4*)(kp + 8) = (u32x4){khp[4], khp[5], khp[6], khp[7]};
          if (tq == 0) GC[(size_t)u * 128 + kk] = __expf(bC); }
        __syncthreads();
        { const int tb = w >> 1;
#pragma unroll
          for (int e = 0; e < 2; ++e) { const int ib = (w & 1) * 2 + e; f32x4 d = (f32x4){0.f, 0.f, 0.f, 0.f};
              if (ib <= tb) {
#pragma unroll
                  for (int ks = 0; ks < 4; ++ks) d = mma16(*(const LAS bf16x8*)(Kn_l + (ib * 16 + r) * 136 + ks * 32 + q * 8), *(const LAS bf16x8*)(Qd_l + (tb * 16 + r) * 136 + ks * 32 + q * 8), d); }
              const int t = tb * 16 + r, i0 = ib * 16 + q * 4;
#pragma unroll
              for (int jj = 0; jj < 4; ++jj) if (i0 + jj > t) d[jj] = 0.f;
              u32x2 o; o.x = pk2(d[0], d[1]); o.y = pk2(d[2], d[3]); *(u32x2*)(EE + (size_t)u * 4096 + t * 64 + i0) = o; } }
        for (int i = tid; i < 64 * 16; i += 512) { const int t = i >> 4, c8 = i & 15; *(u32x4*)(QD + (size_t)u * 8192 + t * 128 + c8 * 8) = *(const LAS u32x4*)(Qd_l + t * 136 + c8 * 8); }
        { const int val = tid & 255, th = tid >> 8;
#pragma unroll
          for (int tg = 0; tg < 4; ++tg) { const int t0 = th * 32 + tg * 8; unsigned p4[4];
#pragma unroll
              for (int e = 0; e < 4; ++e) p4[e] = (unsigned)v_l[(t0 + 2 * e) * 264 + val] | ((unsigned)v_l[(t0 + 2 * e + 1) * 264 + val] << 16);
              *(u32x4*)(VT + (size_t)u * 16384 + val * 64 + t0) = (u32x4){p4[0], p4[1], p4[2], p4[3]}; } }
        __syncthreads();
    }
}
struct GlaFrag { bf16x8 qd[4], e[2], kh[2], vt[4][2]; f32x4 gc; };
__device__ __forceinline__ void gla_load_frag(GlaFrag& f, const bf16_t* __restrict__ QD, const bf16_t* __restrict__ KHT, const bf16_t* __restrict__ EE, const bf16_t* __restrict__ VT, const float* __restrict__ GC,
                                              int ch, int sl, int w, int r, int q) {
    const int rb = w >> 1;
#pragma unroll
    for (int ks = 0; ks < 4; ++ks) f.qd[ks] = *(const bf16x8*)(QD + (size_t)ch * 8192 + (rb * 16 + r) * 128 + ks * 32 + q * 8);
#pragma unroll
    for (int ks = 0; ks < 2; ++ks) { f.e[ks] = *(const bf16x8*)(EE + (size_t)ch * 4096 + (rb * 16 + r) * 64 + ks * 32 + q * 8);
        f.kh[ks] = *(const bf16x8*)(KHT + (size_t)ch * 8192 + (w * 16 + r) * 64 + ks * 32 + q * 8);
#pragma unroll
        for (int vb = 0; vb < 4; ++vb) f.vt[vb][ks] = *(const bf16x8*)(VT + (size_t)ch * 16384 + (sl * 64 + vb * 16 + r) * 64 + ks * 32 + q * 8); }
    f.gc = *(const f32x4*)(GC + (size_t)ch * 128 + w * 16 + q * 4);
}
__device__ __forceinline__ void ph_gla_seq(const Ctx& c, int boff, const bf16_t* __restrict__ QD, const bf16_t* __restrict__ KHT, const bf16_t* __restrict__ EE, const bf16_t* __restrict__ VT, const float* __restrict__ GC,
                                           const float* __restrict__ s0, float* __restrict__ outP, float* __restrict__ outS, bf16_t* __restrict__ OB) {
    LAS bf16_t* T_l = (LAS bf16_t*)c.lds;
    const int lane = c.lane, r = lane & 15, q = lane >> 4, w = c.wave;
    for (int u = (c.bid - boff + c.G) % c.G; u < 32 + 512; u += c.G) {
        int h, sl, nch, ch0, row0, ntok; const float* sp = nullptr; float* op;
        if (u < 32) { const int b = u >> 4; h = (u >> 2) & 3; sl = u & 3; nch = 64; ch0 = (b * 4 + h) * 64; row0 = b * PS; ntok = 64; op = outP + (size_t)(b * 4 + h) * 32768; }
        else { const int s = u - 32, sq = s >> 4; h = (s >> 2) & 3; sl = s & 3; nch = 1; ch0 = 512 + sq * 4 + h; row0 = MP + sq * SS; ntok = SS; sp = s0 + (size_t)(sq * 4 + h) * 32768; op = outS + (size_t)(sq * 4 + h) * 32768; }
        f32x4 acc[4];
#pragma unroll
        for (int vb = 0; vb < 4; ++vb)
#pragma unroll
            for (int jj = 0; jj < 4; ++jj) acc[vb][jj] = sp ? sp[(size_t)(w * 16 + q * 4 + jj) * 256 + sl * 64 + vb * 16 + r] : 0.f;
        GlaFrag cur; gla_load_frag(cur, QD, KHT, EE, VT, GC, ch0, sl, w, r, q);
        for (int ci = 0; ci < nch; ++ci) {
            GlaFrag nxt; if (ci + 1 < nch) gla_load_frag(nxt, QD, KHT, EE, VT, GC, ch0 + ci + 1, sl, w, r, q); else nxt = cur;
            LAS bf16_t* Tb = T_l + (ci & 1) * 64 * 136;
#pragma unroll
            for (int vb = 0; vb < 4; ++vb) { u32x2 o; o.x = pk2(acc[vb][0], acc[vb][1]); o.y = pk2(acc[vb][2], acc[vb][3]); *(LAS u32x2*)(Tb + (vb * 16 + r) * 136 + w * 16 + q * 4) = o; }
            __syncthreads();
            { const int rb = w >> 1, t = rb * 16 + r;
#pragma unroll
              for (int e = 0; e < 2; ++e) { const int cb = (w & 1) * 2 + e; f32x4 y = (f32x4){0.f, 0.f, 0.f, 0.f};
#pragma unroll
                  for (int ks = 0; ks < 4; ++ks) y = mma16(*(const LAS bf16x8*)(Tb + (cb * 16 + r) * 136 + ks * 32 + q * 8), cur.qd[ks], y);
#pragma unroll
                  for (int ks = 0; ks < 2; ++ks) y = mma16(e == 0 ? ((w & 1) ? cur.vt[2][ks] : cur.vt[0][ks]) : ((w & 1) ? cur.vt[3][ks] : cur.vt[1][ks]), cur.e[ks], y);
                  if (t < ntok) { u32x2 o; o.x = pk2(y[0], y[1]); o.y = pk2(y[2], y[3]); *(u32x2*)(OB + (size_t)(row0 + ci * 64 + t) * BW + h * 256 + sl * 64 + cb * 16 + q * 4) = o; } } }
#pragma unroll
            for (int vb = 0; vb < 4; ++vb) { acc[vb] = acc[vb] * cur.gc;
#pragma unroll
                for (int ks = 0; ks < 2; ++ks) acc[vb] = mma16(cur.kh[ks], cur.vt[vb][ks], acc[vb]); }
            cur = nxt;
        }
#pragma unroll
        for (int vb = 0; vb < 4; ++vb)
#pragma unroll
            for (int jj = 0; jj < 4; ++jj) op[(size_t)(w * 16 + q * 4 + jj) * 256 + sl * 64 + vb * 16 + r] = acc[vb][jj];
        __syncthreads();
    }
}
__device__ __forceinline__ void ph_gla_fin(const Ctx& c, const bf16_t* __restrict__ U, const float* __restrict__ ng, const float* __restrict__ nb, bf16_t* __restrict__ OB) {
    const int lane = c.lane;
    for (int i = c.bid * 8 + c.wave; i < MT * 4; i += c.G * 8) {
        const int row = i >> 2, h = i & 3, cc = h * 256 + lane * 4; bf16_t* p = OB + (size_t)row * BW + cc;
        const u32x2 raw = *(const u32x2*)p; float x[4] = {__uint_as_float(raw.x << 16), __uint_as_float(raw.x & 0xffff0000u), __uint_as_float(raw.y << 16), __uint_as_float(raw.y & 0xffff0000u)};
        const float mean = wave_sum((x[0] + x[1]) + (x[2] + x[3])) * (1.0f / 256.0f); float qq = 0.f;
#pragma unroll
        for (int j = 0; j < 4; ++j) { const float d = x[j] - mean; qq += d * d; }
        const float rstd = rsqrtf(wave_sum(qq) * (1.0f / 256.0f) + 1e-5f);
        const u32x2 gp = *(const u32x2*)(U + (size_t)row * NINP + U_GR + cc); const float gr[4] = {__uint_as_float(gp.x << 16), __uint_as_float(gp.x & 0xffff0000u), __uint_as_float(gp.y << 16), __uint_as_float(gp.y & 0xffff0000u)};
        const f32x4 gg = *(const f32x4*)(ng + cc), bb = *(const f32x4*)(nb + cc); float o[4];
#pragma unroll
        for (int j = 0; j < 4; ++j) o[j] = ((x[j] - mean) * rstd * gg[j] + bb[j]) * gr[j] * sigmoidf_(gr[j]);
        u32x2 ov; ov.x = pk2(o[0], o[1]); ov.y = pk2(o[2], o[3]); *(u32x2*)p = ov;
    }
}

__device__ __forceinline__ void unpack8(const u32x4 w, float (&x)[8]) {
    x[0] = __uint_as_float(w.x << 16); x[1] = __uint_as_float(w.x & 0xffff0000u); x[2] = __uint_as_float(w.y << 16); x[3] = __uint_as_float(w.y & 0xffff0000u);
    x[4] = __uint_as_float(w.z << 16); x[5] = __uint_as_float(w.z & 0xffff0000u); x[6] = __uint_as_float(w.w << 16); x[7] = __uint_as_float(w.w & 0xffff0000u);
}
template <bool ISBF> __device__ __forceinline__ void swa_step(const float (&q)[32], float (&acc)[32], float& m, float& l, const void* kp, const void* vp, float slope, float dist) {
    float s = 0.f;
#pragma unroll
    for (int j = 0; j < 4; ++j) { float x[8];
        if (ISBF) unpack8(*(const u32x4*)((const bf16_t*)kp + j * 8), x);
        else { const f32x4 a = *(const f32x4*)((const float*)kp + j * 8), b = *(const f32x4*)((const float*)kp + j * 8 + 4); x[0] = a[0]; x[1] = a[1]; x[2] = a[2]; x[3] = a[3]; x[4] = b[0]; x[5] = b[1]; x[6] = b[2]; x[7] = b[3]; }
#pragma unroll
        for (int d = 0; d < 8; ++d) s += q[j * 8 + d] * x[d]; }
    s += __shfl_xor(s, 1, 64);
    s = s * 0.125f - slope * dist;
    const float mn = fmaxf(m, s), cc = __expf(m - mn), p = __expf(s - mn);
    l = l * cc + p;
#pragma unroll
    for (int j = 0; j < 4; ++j) { float x[8];
        if (ISBF) unpack8(*(const u32x4*)((const bf16_t*)vp + j * 8), x);
        else { const f32x4 a = *(const f32x4*)((const float*)vp + j * 8), b = *(const f32x4*)((const float*)vp + j * 8 + 4); x[0] = a[0]; x[1] = a[1]; x[2] = a[2]; x[3] = a[3]; x[4] = b[0]; x[5] = b[1]; x[6] = b[2]; x[7] = b[3]; }
#pragma unroll
        for (int d = 0; d < 8; ++d) acc[j * 8 + d] = acc[j * 8 + d] * cc + p * x[d]; }
    m = mn;
}
__device__ __forceinline__ void ph_swa_naive(const Ctx& c, const bf16_t* __restrict__ U, const float* __restrict__ ck, const float* __restrict__ cv, const float* __restrict__ sinks, bf16_t* __restrict__ OB) {
    for (int gid = c.bid * 512 + c.tid; gid < MS * 32; gid += c.G * 512) {
        const int dh = gid & 1, h = (gid >> 1) & 15, row = MP + (gid >> 5), kvh = h >> 3, co = kvh * 64 + dh * 32;
        float q[32], acc[32];
#pragma unroll
        for (int j = 0; j < 4; ++j) { float x[8]; unpack8(*(const u32x4*)(U + (size_t)row * NINP + U_SQ + h * 64 + dh * 32 + j * 8), x);
#pragma unroll
            for (int d = 0; d < 8; ++d) { q[j * 8 + d] = x[d]; acc[j * 8 + d] = 0.f; } }
        const float slope = exp2f(-0.5f * (float)(h + 1)); float m = sinks[h], l = 1.0f;
        if (row < MP) {
            const int t = row % PS, base = row - t, lo = t - 128 < 0 ? 0 : t - 128;
            for (int s = lo; s <= t; ++s) { const bf16_t* ur = U + (size_t)(base + s) * NINP;
                swa_step<true>(q, acc, m, l, ur + U_SK + co, ur + U_SV + co, slope, (float)(t - s)); }
        } else {
            const int sq = (row - MP) / SS, i = (row - MP) % SS;
            for (int idx = i; idx <= 128 + i; ++idx) {
                if (idx < 128) { const size_t o = ((size_t)sq * 128 + idx) * 128 + co; swa_step<false>(q, acc, m, l, ck + o, cv + o, slope, (float)(128 + i - idx)); }
                else { const bf16_t* ur = U + (size_t)(MP + sq * SS + idx - 128) * NINP; swa_step<true>(q, acc, m, l, ur + U_SK + co, ur + U_SV + co, slope, (float)(128 + i - idx)); }
            }
        }
        const float inv = 1.0f / l; bf16_t* op = OB + (size_t)row * BW + h * 64 + dh * 32;
#pragma unroll
        for (int j = 0; j < 4; ++j) { u32x4 w; w.x = pk2(acc[j * 8] * inv, acc[j * 8 + 1] * inv); w.y = pk2(acc[j * 8 + 2] * inv, acc[j * 8 + 3] * inv);
            w.z = pk2(acc[j * 8 + 4] * inv, acc[j * 8 + 5] * inv); w.w = pk2(acc[j * 8 + 6] * inv, acc[j * 8 + 7] * inv); *(u32x4*)(op + j * 8) = w; }
    }
}

__device__ __forceinline__ void ph_rwkv_prep(const Ctx& c, const bf16_t* __restrict__ U, const float* __restrict__ shift, const float* __restrict__ mu, const float* __restrict__ w0, const float* __restrict__ w2,
                                             const float* __restrict__ a0, const float* __restrict__ a2, const float* __restrict__ g2, const float* __restrict__ k_k, const float* __restrict__ k_a,
                                             const float* __restrict__ r_k, float* __restrict__ RW) {
    LAS float* xm = (LAS float*)c.lds; LAS float* tw = xm + RWC; LAS float* ad = tw + 64; LAS float* sg = ad + 64;
    const int tid = c.tid;
    float* R = RW; float* WD = RW + (size_t)MPAD * BW; float* K2 = WD + (size_t)MPAD * BW; float* V = K2 + (size_t)MPAD * BW; float* KK = V + (size_t)MPAD * BW;
    float* BV = KK + (size_t)MPAD * BW; float* G = BV + (size_t)MPAD * BW; float* BON = G + (size_t)MPAD * BW;
    for (int row = c.bid; row < MT; row += c.G) {
        const bf16_t* ur = U + (size_t)row * NINP + U_RU; const bf16_t* pr = ur - NINP; const float* ps = nullptr; bool first;
        if (row < MP) first = (row % PS) == 0; else { first = ((row - MP) % SS) == 0; ps = shift + (size_t)((row - MP) / SS) * RWC; }
        for (int cc = tid; cc < RWC; cc += 512) { const float x = bf2f(ur[cc]); const float s = first ? (ps ? ps[cc] : 0.f) : bf2f(pr[cc]); xm[cc] = x + (s - x) * mu[cc]; }
        __syncthreads();
        if (tid < 64) { tw[tid] = tanhf(xm[3072 + tid]); ad[tid] = xm[3136 + tid]; }
        if (tid >= 128 && tid < 256) sg[tid - 128] = sigmoidf_(xm[3200 + tid - 128]);
        __syncthreads();
        for (int qd = 0; qd < 2; ++qd) {
            const int cc = qd * 512 + tid; float accw = w0[cc], acca = a0[cc], accg = 0.f;
#pragma unroll 4
            for (int j = 0; j < 64; ++j) { accw += tw[j] * w2[j * BW + cc]; acca += ad[j] * a2[j * BW + cc]; }
#pragma unroll 4
            for (int j = 0; j < 128; ++j) accg += sg[j] * g2[j * BW + cc];
            const float lw = -softplusf_(-accw) - 0.5f, decay = __expf(-__expf(lw)), a = sigmoidf_(acca);
            const float r = xm[cc], k = xm[1024 + cc], v = xm[2048 + cc];
            const float kkr = k * k_k[cc]; const float ss = wave_sum(kkr * kkr); const float kk = kkr / fmaxf(sqrtf(ss), 1e-12f);
            const float k2 = k * (1.0f + (a - 1.0f) * k_a[cc]); const float rk = wave_sum(r * k2 * r_k[cc]);
            const size_t o = (size_t)row * BW + cc;
            R[o] = r; WD[o] = decay; K2[o] = k2; V[o] = v; KK[o] = kk; BV[o] = kk * a; G[o] = accg; BON[o] = rk * v;
        }
        __syncthreads();
    }
}
__device__ __forceinline__ int kperm_pos(int k) { return (k & ~31) + 8 * ((k >> 2) & 3) + 4 * ((k >> 4) & 1) + (k & 3); }
__device__ __forceinline__ void ph_swa_prompt(const Ctx& c, const bf16_t* __restrict__ U, const float* __restrict__ sinks, bf16_t* __restrict__ OB) {
    LAS bf16_t* K_l = (LAS bf16_t*)c.lds;
    LAS bf16_t* VT_l = K_l + 192 * 72;
    const int tid = c.tid, lane = c.lane, r = lane & 15, q = lane >> 4, w = c.wave;
    for (int u = c.bid; u < PB * 64 * 2; u += c.G) {
        const int b = u >> 7, qb = (u >> 1) & 63, kvh = u & 1, h = kvh * 8 + w;
        const int tok0 = qb * 64 - 128;
        const size_t seq0 = (size_t)b * PS;
        for (int idx = tid; idx < 192 * 8; idx += 512) { const int kl = idx >> 3, c8 = idx & 7, tk = tok0 + kl; u32x4 kv = (u32x4){0u, 0u, 0u, 0u}, vv = kv;
            if (tk >= 0) { const bf16_t* ur = U + (seq0 + tk) * NINP; kv = *(const u32x4*)(ur + U_SK + kvh * 64 + c8 * 8); vv = *(const u32x4*)(ur + U_SV + kvh * 64 + c8 * 8); }
            *(LAS u32x4*)(K_l + kl * 72 + c8 * 8) = kv;
            const int kp = kperm_pos(kl); LAS bf16_t* vp = VT_l + (c8 * 8) * 200 + kp;
            vp[0] = (bf16_t)(vv.x & 0xffffu); vp[200] = (bf16_t)(vv.x >> 16); vp[400] = (bf16_t)(vv.y & 0xffffu); vp[600] = (bf16_t)(vv.y >> 16);
            vp[800] = (bf16_t)(vv.z & 0xffffu); vp[1000] = (bf16_t)(vv.z >> 16); vp[1200] = (bf16_t)(vv.w & 0xffffu); vp[1400] = (bf16_t)(vv.w >> 16); }
        __syncthreads();
        const float slope = exp2f(-0.5f * (float)(h + 1)), sink = sinks[h];
#pragma unroll 1
        for (int i = 0; i < 4; ++i) {
            const size_t qrow = seq0 + qb * 64 + i * 16 + r;
            const bf16x8 qf0 = *(const bf16x8*)(U + qrow * NINP + U_SQ + h * 64 + q * 8), qf1 = *(const bf16x8*)(U + qrow * NINP + U_SQ + h * 64 + 32 + q * 8);
            const int kt0 = i & ~1;
            f32x4 s[10]; float mx = sink;
#pragma unroll
            for (int kt = 0; kt < 10; ++kt) { const LAS bf16_t* kp = K_l + ((kt0 + kt) * 16 + r) * 72 + q * 8;
                f32x4 d = mma16(*(const LAS bf16x8*)kp, qf0, (f32x4){0.f, 0.f, 0.f, 0.f}); d = mma16(*(const LAS bf16x8*)(kp + 32), qf1, d);
#pragma unroll
                for (int jj = 0; jj < 4; ++jj) { const int kl = (kt0 + kt) * 16 + q * 4 + jj, dist = i * 16 + r + 128 - kl;
                    const float v = (dist >= 0 && dist <= 128 && tok0 + kl >= 0) ? d[jj] * 0.125f - slope * (float)dist : -1e30f; d[jj] = v; mx = fmaxf(mx, v); }
                s[kt] = d; }
            mx = fmaxf(mx, __shfl_xor(mx, 16, 64)); mx = fmaxf(mx, __shfl_xor(mx, 32, 64));
            float sum = 0.f; bf16x8 pf[5];
#pragma unroll
            for (int kp = 0; kp < 5; ++kp) { f32x4 a = s[2 * kp], bq = s[2 * kp + 1];
#pragma unroll
                for (int jj = 0; jj < 4; ++jj) { a[jj] = __expf(a[jj] - mx); bq[jj] = __expf(bq[jj] - mx); sum += a[jj] + bq[jj]; }
                pf[kp] = pack_acc(a, bq); }
            sum += __shfl_xor(sum, 16, 64); sum += __shfl_xor(sum, 32, 64);
            const float inv = 1.0f / (sum + __expf(sink - mx));
            bf16_t* op = OB + qrow * BW + h * 64 + q * 4;
#pragma unroll
            for (int dt = 0; dt < 4; ++dt) { f32x4 o = (f32x4){0.f, 0.f, 0.f, 0.f};
#pragma unroll
                for (int kp = 0; kp < 5; ++kp) o = mma16(*(const LAS bf16x8*)(VT_l + (dt * 16 + r) * 200 + (kt0 + 2 * kp) * 16 + q * 8), pf[kp], o);
                u32x2 ov; ov.x = pk2(o[0] * inv, o[1] * inv); ov.y = pk2(o[2] * inv, o[3] * inv); *(u32x2*)(op + dt * 16) = ov; }
        }
        __syncthreads();
    }
}

__device__ __forceinline__ void ph_swa_sample(const Ctx& c, const bf16_t* __restrict__ U, const float* __restrict__ ck, const float* __restrict__ cv, const float* __restrict__ sinks, bf16_t* __restrict__ OB) {
    LAS bf16_t* K_l = (LAS bf16_t*)c.lds;
    LAS bf16_t* VT_l = K_l + 160 * 72;
    const int tid = c.tid, lane = c.lane, r = lane & 15, q = lane >> 4, w = c.wave;
    for (int u = c.bid; u < SB * 2; u += c.G) {
        const int sq = u >> 1, kvh = u & 1;
        for (int idx = tid; idx < 160 * 8; idx += 512) { const int kl = idx >> 3, c8 = idx & 7; float kx[8], vx[8];
#pragma unroll
            for (int e = 0; e < 8; ++e) { kx[e] = 0.f; vx[e] = 0.f; }
            if (kl < 128) { const size_t o = ((size_t)sq * 128 + kl) * 128 + kvh * 64 + c8 * 8; const f32x4 a = *(const f32x4*)(ck + o), b2 = *(const f32x4*)(ck + o + 4), c2 = *(const f32x4*)(cv + o), d2 = *(const f32x4*)(cv + o + 4);
                kx[0] = a[0]; kx[1] = a[1]; kx[2] = a[2]; kx[3] = a[3]; kx[4] = b2[0]; kx[5] = b2[1]; kx[6] = b2[2]; kx[7] = b2[3];
                vx[0] = c2[0]; vx[1] = c2[1]; vx[2] = c2[2]; vx[3] = c2[3]; vx[4] = d2[0]; vx[5] = d2[1]; vx[6] = d2[2]; vx[7] = d2[3]; }
            else if (kl < 132) { const bf16_t* ur = U + (size_t)(MP + sq * SS + kl - 128) * NINP; unpack8(*(const u32x4*)(ur + U_SK + kvh * 64 + c8 * 8), kx); unpack8(*(const u32x4*)(ur + U_SV + kvh * 64 + c8 * 8), vx); }
            *(LAS u32x4*)(K_l + kl * 72 + c8 * 8) = (u32x4){pk2(kx[0], kx[1]), pk2(kx[2], kx[3]), pk2(kx[4], kx[5]), pk2(kx[6], kx[7])};
            LAS bf16_t* vp = VT_l + (c8 * 8) * 168 + kperm_pos(kl);
#pragma unroll
            for (int e = 0; e < 8; ++e) vp[e * 168] = f2bf(vx[e]); }
        __syncthreads();
        if (w < 2) {
            const int h = kvh * 8 + w * 4 + (r >> 2), tk = r & 3; const size_t qrow = (size_t)(MP + sq * SS + tk);
            const float slope = exp2f(-0.5f * (float)(h + 1)), sink = sinks[h];
            const bf16x8 qf0 = *(const bf16x8*)(U + qrow * NINP + U_SQ + h * 64 + q * 8), qf1 = *(const bf16x8*)(U + qrow * NINP + U_SQ + h * 64 + 32 + q * 8);
            f32x4 s[10]; float mx = sink;
#pragma unroll
            for (int kt = 0; kt < 10; ++kt) { const LAS bf16_t* kp = K_l + (kt * 16 + r) * 72 + q * 8;
                f32x4 d = mma16(*(const LAS bf16x8*)kp, qf0, (f32x4){0.f, 0.f, 0.f, 0.f}); d = mma16(*(const LAS bf16x8*)(kp + 32), qf1, d);
#pragma unroll
                for (int jj = 0; jj < 4; ++jj) { const int kl = kt * 16 + q * 4 + jj, dist = 128 + tk - kl;
                    const float v = (dist >= 0 && dist <= 128) ? d[jj] * 0.125f - slope * (float)dist : -1e30f; d[jj] = v; mx = fmaxf(mx, v); }
                s[kt] = d; }
            mx = fmaxf(mx, __shfl_xor(mx, 16, 64)); mx = fmaxf(mx, __shfl_xor(mx, 32, 64));
            float sum = 0.f; bf16x8 pf[5];
#pragma unroll
            for (int kp = 0; kp < 5; ++kp) { f32x4 a = s[2 * kp], bq = s[2 * kp + 1];
#pragma unroll
                for (int jj = 0; jj < 4; ++jj) { a[jj] = __expf(a[jj] - mx); bq[jj] = __expf(bq[jj] - mx); sum += a[jj] + bq[jj]; }
                pf[kp] = pack_acc(a, bq); }
            sum += __shfl_xor(sum, 16, 64); sum += __shfl_xor(sum, 32, 64);
            const float inv = 1.0f / (sum + __expf(sink - mx));
            bf16_t* op = OB + qrow * BW + h * 64 + q * 4;
#pragma unroll
            for (int dt = 0; dt < 4; ++dt) { f32x4 o = (f32x4){0.f, 0.f, 0.f, 0.f};
#pragma unroll
                for (int kp = 0; kp < 5; ++kp) o = mma16(*(const LAS bf16x8*)(VT_l + (dt * 16 + r) * 168 + kp * 32 + q * 8), pf[kp], o);
                u32x2 ov; ov.x = pk2(o[0] * inv, o[1] * inv); ov.y = pk2(o[2] * inv, o[3] * inv); *(u32x2*)(op + dt * 16) = ov; }
        }
        __syncthreads();
    }
}

constexpr int RWP_UNITS = (MP / 64) * 16 + SB * 16;
__device__ __forceinline__ void rwp_unit_info(int u, int& row0, int& ntok, int& h, int& sq, bool& seq_first) {
    if (u < (MP / 64) * 16) { const int blk = u >> 4; h = u & 15; row0 = blk * 64; ntok = 64; sq = -1; seq_first = (row0 % PS) == 0; }
    else { const int s = u - (MP / 64) * 16; sq = s >> 4; h = s & 15; row0 = MP + sq * SS; ntok = SS; seq_first = true; }
}
__device__ __forceinline__ void ph_rwkv_pre(const Ctx& c, const bf16_t* __restrict__ U, const float* __restrict__ shift, const float* __restrict__ mu, const float* __restrict__ w0, const float* __restrict__ w2,
                                            const float* __restrict__ a0, const float* __restrict__ a2, const float* __restrict__ g2, const float* __restrict__ k_k, const float* __restrict__ k_a,
                                            const float* __restrict__ r_k, float* __restrict__ RW, bf16_t* __restrict__ RB) {
    LAS bf16_t* P_l = (LAS bf16_t*)c.lds; LAS bf16_t* Kn_l = P_l + 4608; LAS bf16_t* Bn_l = Kn_l + 4608; LAS bf16_t* Q_l = Bn_l + 4608;
    LAS bf16_t* PT_l = Q_l + 4608; LAS bf16_t* BhT_l = PT_l + 4608; LAS bf16_t* KhT_l = BhT_l + 4608; LAS bf16_t* VT_l = KhT_l + 4608;
    LAS float* A_l = (LAS float*)(c.lds + 73728);
    LAS bf16_t* BmT_l = (LAS bf16_t*)(c.lds + 78848); LAS bf16_t* F_l = (LAS bf16_t*)(c.lds + 81920); LAS bf16_t* Tinv_l = (LAS bf16_t*)(c.lds + 84992);
    LAS bf16_t* PpT_l = (LAS bf16_t*)(c.lds + 88064);
    LAS bf16_t* BmpT_l = (LAS bf16_t*)(c.lds + 97280);
    LAS float* GC_l = (LAS float*)(c.lds + 100352);
    LAS float* lg_l = (LAS float*)(c.lds + 125952);
    LAS bf16_t* act_l = (LAS bf16_t*)c.lds;
    LAS bf16_t* wT_l = act_l + 64 * 264;
    LAS bf16_t* aT_l = wT_l + 64 * 72;
    LAS bf16_t* gT_l = aT_l + 64 * 72;
    LAS float* pre_l = (LAS float*)(c.lds + 73728);
    const int tid = c.tid, lane = c.lane, r = lane & 15, q = lane >> 4, w = c.wave;
    float* Gg = RW + 6 * (size_t)MPAD * BW; float* BON = RW + 7 * (size_t)MPAD * BW;
    for (int u = c.bid; u < RWP_UNITS; u += c.G) {
        int row0, ntok, h, sq; bool seq_first; rwp_unit_info(u, row0, ntok, h, sq, seq_first);
        const float* sh = sq >= 0 ? shift + (size_t)sq * RWC : nullptr;
        for (int idx = tid; idx < 64 * 256; idx += 512) {
            const int t = idx >> 8, col = idx & 255; float val = 0.f;
            if (t < ntok) { const int cc = 3072 + col; const bf16_t* ur = U + (size_t)(row0 + t) * NINP + U_RU; const float x = bf2f(ur[cc]);
                const float p = (t == 0 && seq_first) ? (sh ? sh[cc] : 0.f) : bf2f(ur[cc - NINP]);
                const float xm = x + (p - x) * mu[cc];
                val = col < 64 ? tanhf(xm) : (col < 128 ? xm : sigmoidf_(xm)); }
            act_l[t * 264 + col] = f2bf(val);
        }
        for (int idx = tid; idx < 64 * 64; idx += 512) { const int j = idx >> 6, cc = idx & 63; wT_l[cc * 72 + j] = f2bf(w2[(size_t)j * BW + h * 64 + cc]); aT_l[cc * 72 + j] = f2bf(a2[(size_t)j * BW + h * 64 + cc]); }
        for (int idx = tid; idx < 128 * 64; idx += 512) { const int j = idx >> 6, cc = idx & 63; gT_l[cc * 136 + j] = f2bf(g2[(size_t)j * BW + h * 64 + cc]); }
        __syncthreads();
        { const int tb = w & 3, chf = w >> 2; bf16x8 af[8];
#pragma unroll
          for (int ks = 0; ks < 8; ++ks) af[ks] = *(const LAS bf16x8*)(act_l + (tb * 16 + r) * 264 + ks * 32 + q * 8);
#pragma unroll
          for (int e = 0; e < 2; ++e) { const int cb = chf * 2 + e; f32x4 dw = (f32x4){0.f, 0.f, 0.f, 0.f}, da = dw, dg = dw;
#pragma unroll
              for (int ks = 0; ks < 2; ++ks) { dw = mma16(*(const LAS bf16x8*)(wT_l + (cb * 16 + r) * 72 + ks * 32 + q * 8), af[ks], dw);
                  da = mma16(*(const LAS bf16x8*)(aT_l + (cb * 16 + r) * 72 + ks * 32 + q * 8), af[2 + ks], da); }
#pragma unroll
              for (int ks = 0; ks < 4; ++ks) dg = mma16(*(const LAS bf16x8*)(gT_l + (cb * 16 + r) * 136 + ks * 32 + q * 8), af[4 + ks], dg);
              const int o = (tb * 16 + r) * 68 + cb * 16 + q * 4;
              *(LAS f32x4*)(pre_l + o) = dw; *(LAS f32x4*)(pre_l + 64 * 68 + o) = da; *(LAS f32x4*)(pre_l + 2 * 64 * 68 + o) = dg; } }
        __syncthreads();
        const int t = tid >> 3, cg = tid & 7, c0 = h * 64 + cg * 8, sc = t >> 4;
        float rr[8], k2[8], kap[8], bet[8], nlw[8];
        { float vx[8], gg[8], kkr[8]; float ss = 0.f, rk = 0.f;
          if (t < ntok) {
            const size_t row = (size_t)(row0 + t); const bf16_t* ur = U + row * NINP + U_RU; const bool fst = (t == 0 && seq_first);
            float kx[8];
#pragma unroll
            for (int part = 0; part < 3; ++part) { const int cc = part * 1024 + c0; float x[8], p[8];
                unpack8(*(const u32x4*)(ur + cc), x);
                if (!fst) unpack8(*(const u32x4*)(ur + cc - NINP), p);
                else {
#pragma unroll
                    for (int j = 0; j < 8; ++j) p[j] = sh ? sh[cc + j] : 0.f; }
#pragma unroll
                for (int j = 0; j < 8; ++j) { const float xm = x[j] + (p[j] - x[j]) * mu[cc + j]; if (part == 0) rr[j] = xm; else if (part == 1) kx[j] = xm; else vx[j] = xm; } }
#pragma unroll
            for (int j = 0; j < 8; ++j) { const int cc = c0 + j; const int o = t * 68 + cg * 8 + j;
                const float lw = -softplusf_(-(w0[cc] + pre_l[o])) - 0.5f; nlw[j] = -__expf(lw); const float av = sigmoidf_(a0[cc] + pre_l[64 * 68 + o]); gg[j] = pre_l[2 * 64 * 68 + o];
                kkr[j] = kx[j] * k_k[cc]; ss += kkr[j] * kkr[j]; k2[j] = kx[j] * (1.0f + (av - 1.0f) * k_a[cc]); rk += rr[j] * k2[j] * r_k[cc]; bet[j] = av; }
          } else {
#pragma unroll
            for (int j = 0; j < 8; ++j) { rr[j] = 0.f; k2[j] = 0.f; kkr[j] = 0.f; bet[j] = 0.f; nlw[j] = 0.f; vx[j] = 0.f; gg[j] = 0.f; }
          }
          ss += __shfl_xor(ss, 1, 64); ss += __shfl_xor(ss, 2, 64); ss += __shfl_xor(ss, 4, 64);
          rk += __shfl_xor(rk, 1, 64); rk += __shfl_xor(rk, 2, 64); rk += __shfl_xor(rk, 4, 64);
          const float inv = 1.0f / fmaxf(sqrtf(ss), 1e-12f);
#pragma unroll
          for (int j = 0; j < 8; ++j) { kap[j] = kkr[j] * inv; bet[j] = kap[j] * bet[j]; }
          if (t < ntok) { const size_t o = (size_t)(row0 + t) * BW + c0;
              *(f32x4*)(Gg + o) = (f32x4){gg[0], gg[1], gg[2], gg[3]}; *(f32x4*)(Gg + o + 4) = (f32x4){gg[4], gg[5], gg[6], gg[7]};
              *(f32x4*)(BON + o) = (f32x4){rk * vx[0], rk * vx[1], rk * vx[2], rk * vx[3]}; *(f32x4*)(BON + o + 4) = (f32x4){rk * vx[4], rk * vx[5], rk * vx[6], rk * vx[7]}; }
          *(LAS f32x4*)(lg_l + t * 68 + cg * 8) = (f32x4){nlw[0], nlw[1], nlw[2], nlw[3]}; *(LAS f32x4*)(lg_l + t * 68 + cg * 8 + 4) = (f32x4){nlw[4], nlw[5], nlw[6], nlw[7]};
#pragma unroll
          for (int j = 0; j < 8; ++j) VT_l[(cg * 8 + j) * 72 + t] = f2bf(vx[j]);
        }
        __syncthreads();
        if (tid < 256) { const int cc = tid & 63, s4 = tid >> 6; float run = 0.f;
#pragma unroll
            for (int i = 0; i < 16; ++i) { const int o = (s4 * 16 + i) * 68 + cc; run += lg_l[o]; lg_l[o] = run; } }
        __syncthreads();
        { unsigned pp[4], pq[4], pk[4], pb[4];
#pragma unroll
          for (int j = 0; j < 8; j += 2) { float vP[2], vQ[2], vK[2], vB[2];
#pragma unroll
              for (int e = 0; e < 2; ++e) { const int jj = j + e, cc = cg * 8 + jj; const float ci = lg_l[t * 68 + cc], cC = lg_l[(sc * 16 + 15) * 68 + cc];
                  const float ei = __expf(-ci), eh = __expf(cC - ci);
                  vP[e] = kap[jj] * __expf(ci - nlw[jj]); vQ[e] = rr[jj] * __expf(ci); vK[e] = k2[jj] * ei; vB[e] = bet[jj] * ei;
                  PT_l[cc * 72 + t] = f2bf(vP[e]); BhT_l[cc * 72 + t] = f2bf(bet[jj] * eh); KhT_l[cc * 72 + t] = f2bf(k2[jj] * eh); }
              pp[j >> 1] = pk2(vP[0], vP[1]); pq[j >> 1] = pk2(vQ[0], vQ[1]); pk[j >> 1] = pk2(vK[0], vK[1]); pb[j >> 1] = pk2(vB[0], vB[1]); }
          const int o = t * 72 + cg * 8;
          *(LAS u32x4*)(P_l + o) = (u32x4){pp[0], pp[1], pp[2], pp[3]}; *(LAS u32x4*)(Q_l + o) = (u32x4){pq[0], pq[1], pq[2], pq[3]};
          *(LAS u32x4*)(Kn_l + o) = (u32x4){pk[0], pk[1], pk[2], pk[3]}; *(LAS u32x4*)(Bn_l + o) = (u32x4){pb[0], pb[1], pb[2], pb[3]};
          if ((t & 15) == 15) {
#pragma unroll
              for (int j = 0; j < 8; ++j) GC_l[sc * 64 + cg * 8 + j] = __expf(lg_l[t * 68 + cg * 8 + j]); } }
        __syncthreads();
        const int nsub = ntok == 64 ? 4 : 1;
        const bf16x8 zfrag = (bf16x8){0, 0, 0, 0, 0, 0, 0, 0};
        for (int id = w; id < nsub * 3; id += 8) { const int s4 = id / 3, prod = id - s4 * 3; f32x4 d = (f32x4){0.f, 0.f, 0.f, 0.f};
            const LAS bf16_t* X = (prod == 1 ? P_l : Bn_l) + (s4 * 16 + r) * 72 + q * 8; const LAS bf16_t* Y = (prod == 0 ? P_l : (prod == 1 ? Kn_l : Q_l)) + (s4 * 16 + r) * 72 + q * 8;
#pragma unroll
            for (int ks = 0; ks < 2; ++ks) d = mma16(*(const LAS bf16x8*)(X + ks * 32), *(const LAS bf16x8*)(Y + ks * 32), d);
            if (prod == 0) { f32x4 o4;
#pragma unroll
                for (int jj = 0; jj < 4; ++jj) o4[jj] = (q * 4 + jj < r) ? d[jj] : 0.f;
                *(LAS f32x4*)(A_l + s4 * 320 + r * 20 + q * 4) = o4; }
            else { float o4[4];
#pragma unroll
                for (int jj = 0; jj < 4; ++jj) o4[jj] = (prod == 1 ? (r < q * 4 + jj) : (q * 4 + jj <= r)) ? d[jj] : 0.f;
                u32x2 o; o.x = pk2(o4[0], o4[1]); o.y = pk2(o4[2], o4[3]); *(LAS u32x2*)((prod == 1 ? BmT_l : F_l) + s4 * 384 + r * 24 + q * 4) = o; } }
        __syncthreads();
        if (w == 0 && (lane >> 4) < nsub) { const int s4 = lane >> 4, jc = lane & 15; float x[16];
#pragma unroll
            for (int tt = 0; tt < 16; ++tt) { float s = (tt == jc) ? 1.f : 0.f;
#pragma unroll
                for (int i = 0; i < tt; ++i) s -= A_l[s4 * 320 + tt * 20 + i] * x[i];
                x[tt] = s; }
#pragma unroll
            for (int tt = 0; tt < 16; ++tt) Tinv_l[s4 * 384 + tt * 24 + jc] = f2bf(x[tt]); }
        __syncthreads();
        for (int id = w; id < nsub * 5; id += 8) { const int s4 = id / 5, rem = id - s4 * 5;
            const bf16x8 xf = q < 2 ? *(const LAS bf16x8*)(Tinv_l + s4 * 384 + r * 24 + q * 8) : zfrag;
            const bf16x8 yf = q < 2 ? (rem < 4 ? *(const LAS bf16x8*)(PT_l + (rem * 16 + r) * 72 + s4 * 16 + q * 8) : *(const LAS bf16x8*)(BmT_l + s4 * 384 + r * 24 + q * 8)) : zfrag;
            const f32x4 d = mma16(xf, yf, (f32x4){0.f, 0.f, 0.f, 0.f});
            u32x2 o; o.x = pk2(d[0], d[1]); o.y = pk2(d[2], d[3]);
            if (rem < 4) *(LAS u32x2*)(PpT_l + (rem * 16 + r) * 72 + s4 * 16 + q * 4) = o; else *(LAS u32x2*)(BmpT_l + s4 * 384 + r * 24 + q * 4) = o; }
        __syncthreads();
        { const int chunk0 = sq >= 0 ? PB * 16 * 256 + sq * 16 + h : ((row0 / PS) * 16 + h) * 256 + ((row0 % PS) >> 4);
          for (int id = w; id < nsub * 25; id += 8) { const int s4 = id / 25, rem = id - s4 * 25; bf16_t* blob = RB + (size_t)(chunk0 + s4) * RB_EL;
            const bf16x8 fF = q < 2 ? *(const LAS bf16x8*)(F_l + s4 * 384 + r * 24 + q * 8) : zfrag;
            if (rem < 4) {
                const bf16x8 xf = q < 2 ? *(const LAS bf16x8*)(PpT_l + (rem * 16 + r) * 72 + s4 * 16 + q * 8) : zfrag;
                const f32x4 d = mma16(xf, fF, (f32x4){0.f, 0.f, 0.f, 0.f});
                const u32x2 qv = *(const LAS u32x2*)(Q_l + (s4 * 16 + r) * 72 + rem * 16 + q * 4);
                u32x2 o; o.x = pk2(__uint_as_float(qv.x << 16) - d[0], __uint_as_float(qv.x & 0xffff0000u) - d[1]); o.y = pk2(__uint_as_float(qv.y << 16) - d[2], __uint_as_float(qv.y & 0xffff0000u) - d[3]);
                *(u32x2*)(blob + RB_QP + r * 72 + 32 * (rem >> 1) + 8 * q + 4 * (rem & 1)) = o;
            } else if (rem == 4) {
                f32x4 d2 = (f32x4){0.f, 0.f, 0.f, 0.f};
#pragma unroll
                for (int ks = 0; ks < 2; ++ks) d2 = mma16(*(const LAS bf16x8*)(Kn_l + (s4 * 16 + r) * 72 + ks * 32 + q * 8), *(const LAS bf16x8*)(Q_l + (s4 * 16 + r) * 72 + ks * 32 + q * 8), d2);
                const bf16x8 xf = q < 2 ? *(const LAS bf16x8*)(BmpT_l + s4 * 384 + r * 24 + q * 8) : zfrag;
                const f32x4 d1 = mma16(xf, fF, (f32x4){0.f, 0.f, 0.f, 0.f});
                float o4[4];
#pragma unroll
                for (int jj = 0; jj < 4; ++jj) o4[jj] = ((q * 4 + jj <= r) ? d2[jj] : 0.f) - d1[jj];
                u32x2 o; o.x = pk2(o4[0], o4[1]); o.y = pk2(o4[2], o4[3]); *(u32x2*)(blob + RB_EP + r * 24 + q * 4) = o;
            } else if (rem < 21) {
                const int cib = (rem - 5) >> 2, cob = (rem - 5) & 3;
                const bf16x8 xf = q < 2 ? *(const LAS bf16x8*)(PpT_l + (cib * 16 + r) * 72 + s4 * 16 + q * 8) : zfrag;
                const bf16x8 yf = q < 2 ? *(const LAS bf16x8*)(BhT_l + (cob * 16 + r) * 72 + s4 * 16 + q * 8) : zfrag;
                const f32x4 d = mma16(xf, yf, (f32x4){0.f, 0.f, 0.f, 0.f});
                const float gc = GC_l[s4 * 64 + cob * 16 + r]; float o4[4];
#pragma unroll
                for (int jj = 0; jj < 4; ++jj) o4[jj] = ((cib == cob && q * 4 + jj == r) ? gc : 0.f) - d[jj];
                u32x2 o; o.x = pk2(o4[0], o4[1]); o.y = pk2(o4[2], o4[3]); *(u32x2*)(blob + (cob * 16 + r) * 72 + 32 * (cib >> 1) + 8 * q + 4 * (cib & 1)) = o;
            } else {
                const int cb = rem - 21;
                const bf16x8 xf = q < 2 ? *(const LAS bf16x8*)(BmpT_l + s4 * 384 + r * 24 + q * 8) : zfrag;
                const bf16x8 yf = q < 2 ? *(const LAS bf16x8*)(BhT_l + (cb * 16 + r) * 72 + s4 * 16 + q * 8) : zfrag;
                const f32x4 d = mma16(xf, yf, (f32x4){0.f, 0.f, 0.f, 0.f});
                const u32x2 kv = *(const LAS u32x2*)(KhT_l + (cb * 16 + r) * 72 + s4 * 16 + q * 4);
                u32x2 o; o.x = pk2(__uint_as_float(kv.x << 16) - d[0], __uint_as_float(kv.x & 0xffff0000u) - d[1]); o.y = pk2(__uint_as_float(kv.y << 16) - d[2], __uint_as_float(kv.y & 0xffff0000u) - d[3]);
                *(u32x2*)(blob + RB_KHP + (cb * 16 + r) * 24 + q * 4) = o;
            } }
          for (int idx = tid; idx < nsub * 128; idx += 512) { const int s4 = idx >> 7, cc = (idx >> 1) & 63, hf = idx & 1;
              *(u32x4*)(RB + (size_t)(chunk0 + s4) * RB_EL + RB_VT + cc * 24 + hf * 8) = *(const LAS u32x4*)(VT_l + cc * 72 + s4 * 16 + hf * 8); } }
        __syncthreads();
    }
}

__device__ __forceinline__ void ph_rwkv_scan_naive(const Ctx& c, const float* __restrict__ RW, const float* __restrict__ s0, const float* __restrict__ lng, const float* __restrict__ lnb, bf16_t* __restrict__ OB,
                                                   float* __restrict__ outP, float* __restrict__ outS) {
    const float* R = RW; const float* WD = RW + (size_t)MPAD * BW; const float* K2 = WD + (size_t)MPAD * BW; const float* V = K2 + (size_t)MPAD * BW; const float* KK = V + (size_t)MPAD * BW;
    const float* BV = KK + (size_t)MPAD * BW; const float* G = BV + (size_t)MPAD * BW; const float* BON = G + (size_t)MPAD * BW;
    const int lane = c.lane;
    for (int it = 0;; ++it) {
        const int u = (it * 8 + c.wave) * c.G + c.bid;
        if (u >= (PB + SB) * 16) break;
        const int sq = u >> 4, h = u & 15;
        int row0, L; seq_info(sq, row0, L);
        float S[64];
        if (sq >= PB) { const float* p = s0 + (((size_t)(sq - PB) * 16 + h) * 64 + lane) * 64;
#pragma unroll
            for (int j = 0; j < 64; ++j) S[j] = p[j]; }
        else {
#pragma unroll
            for (int j = 0; j < 64; ++j) S[j] = 0.f; }
        const float lg = lng[h * 64 + lane], lb = lnb[h * 64 + lane];
        for (int t = 0; t < L; ++t) {
            const size_t base = (size_t)(row0 + t) * BW + h * 64; const float v = V[base + lane];
            float d = 0.f;
#pragma unroll
            for (int j = 0; j < 64; ++j) d += S[j] * KK[base + j];
            float y = 0.f;
#pragma unroll
            for (int j = 0; j < 64; ++j) { S[j] = S[j] * WD[base + j] - d * BV[base + j] + v * K2[base + j]; y += S[j] * R[base + j]; }
            const float mean = wave_sum(y) * (1.0f / 64.0f), dy = y - mean, var = wave_sum(dy * dy) * (1.0f / 64.0f);
            const float yn = dy * rsqrtf(var + 64e-5f) * lg + lb;
            OB[base + lane] = f2bf((yn + BON[base + lane]) * G[base + lane]);
        }
        float* op = (sq < PB ? outP + (((size_t)sq * 16 + h) * 64 + lane) * 64 : outS + (((size_t)(sq - PB) * 16 + h) * 64 + lane) * 64);
#pragma unroll
        for (int j = 0; j < 64; ++j) op[j] = S[j];
    }
}
__device__ __forceinline__ void ph_rwkv_scan2(const Ctx& c, int boff, const float* __restrict__ RW, const float* __restrict__ s0, const float* __restrict__ lng, const float* __restrict__ lnb, bf16_t* __restrict__ OB,
                                              float* __restrict__ outP, float* __restrict__ outS) {
    LAS float* opb = (LAS float*)c.lds;
    LAS float* yb = opb + 2 * 16 * 384;
    const int tid = c.tid, lane = c.lane, w = c.wave, rl = lane >> 3, cg = lane & 7, vrow = w * 8 + rl;
    const float* G = RW + 6 * (size_t)MPAD * BW; const float* BON = RW + 7 * (size_t)MPAD * BW;
    for (int u = (c.bid - boff + c.G) % c.G; u < (PB + SB) * 16; u += c.G) {
        const int sq = u >> 4, h = u & 15;
        int row0, L; seq_info(sq, row0, L);
        float S[8];
        if (sq >= PB) { const float* p = s0 + (((size_t)(sq - PB) * 16 + h) * 64 + vrow) * 64 + cg * 8;
#pragma unroll
            for (int j = 0; j < 8; ++j) S[j] = p[j]; }
        else {
#pragma unroll
            for (int j = 0; j < 8; ++j) S[j] = 0.f; }
        const float lg = lng[h * 64 + lane], lb = lnb[h * 64 + lane];
        const int nb = (L + 15) >> 4;
#define RW_STAGE(bi_) do { const int t0_ = (bi_) * 16, nT_ = (L - t0_) < 16 ? (L - t0_) : 16; LAS float* dst_ = opb + ((bi_) & 1) * 16 * 384; \
        for (int idx = tid; idx < nT_ * 96; idx += 512) { const int t = idx / 96, rem = idx - t * 96, slot = rem >> 4, c4 = rem & 15; \
            const int arr = slot == 0 ? 1 : slot == 1 ? 4 : slot == 2 ? 5 : slot == 3 ? 2 : slot == 4 ? 0 : 3; \
            *(LAS f32x4*)(dst_ + t * 384 + slot * 64 + c4 * 4) = *(const f32x4*)(RW + (size_t)arr * MPAD * BW + (size_t)(row0 + t0_ + t) * BW + h * 64 + c4 * 4); } } while (0)
        RW_STAGE(0);
        for (int bi = 0; bi < nb; ++bi) {
            __syncthreads();
            if (bi + 1 < nb) RW_STAGE(bi + 1);
            const int t0 = bi * 16, nT = (L - t0) < 16 ? (L - t0) : 16; const LAS float* src = opb + (bi & 1) * 16 * 384;
            for (int tt = 0; tt < nT; ++tt) {
                const LAS float* b = src + tt * 384 + cg * 8;
                const f32x4 w0 = *(const LAS f32x4*)(b), w1 = *(const LAS f32x4*)(b + 4), k0 = *(const LAS f32x4*)(b + 64), k1 = *(const LAS f32x4*)(b + 68);
                const f32x4 b0 = *(const LAS f32x4*)(b + 128), b1 = *(const LAS f32x4*)(b + 132), q0 = *(const LAS f32x4*)(b + 192), q1 = *(const LAS f32x4*)(b + 196);
                const f32x4 r0 = *(const LAS f32x4*)(b + 256), r1 = *(const LAS f32x4*)(b + 260); const float v = src[tt * 384 + 320 + vrow];
                float d = (S[0] * k0[0] + S[1] * k0[1]) + (S[2] * k0[2] + S[3] * k0[3]) + (S[4] * k1[0] + S[5] * k1[1]) + (S[6] * k1[2] + S[7] * k1[3]);
                d += __shfl_xor(d, 1, 64); d += __shfl_xor(d, 2, 64); d += __shfl_xor(d, 4, 64);
                float y = 0.f;
#pragma unroll
                for (int j = 0; j < 4; ++j) { S[j] = S[j] * w0[j] - d * b0[j] + v * q0[j]; y += S[j] * r0[j]; S[4 + j] = S[4 + j] * w1[j] - d * b1[j] + v * q1[j]; y += S[4 + j] * r1[j]; }
                y += __shfl_xor(y, 1, 64); y += __shfl_xor(y, 2, 64); y += __shfl_xor(y, 4, 64);
                if (cg == 0) yb[tt * 64 + vrow] = y;
            }
            __syncthreads();
            for (int tt = w; tt < nT; tt += 8) {
                const float y = yb[tt * 64 + lane]; const float mean = wave_sum(y) * (1.0f / 64.0f), dy = y - mean, var = wave_sum(dy * dy) * (1.0f / 64.0f);
                const float yn = dy * rsqrtf(var + 64e-5f) * lg + lb; const size_t o = (size_t)(row0 + t0 + tt) * BW + h * 64 + lane;
                OB[o] = f2bf((yn + BON[o]) * G[o]);
            }
        }
#undef RW_STAGE
        float* op = (sq < PB ? outP + (((size_t)sq * 16 + h) * 64 + vrow) * 64 : outS + (((size_t)(sq - PB) * 16 + h) * 64 + vrow) * 64) + cg * 8;
#pragma unroll
        for (int j = 0; j < 8; ++j) op[j] = S[j];
        __syncthreads();
    }
}
constexpr int RS_SLOTS = 8, RS_SLOT_B = RB_EL * 2;
__device__ __forceinline__ void ph_rwkv_seq(const Ctx& c, int boff, const bf16_t* __restrict__ RB, const float* __restrict__ s0, float* __restrict__ outP, float* __restrict__ outS, bf16_t* __restrict__ OB) {
    const int lane = c.lane, r = lane & 15, q = lane >> 4, w = c.wave;
    LAS unsigned char* ring = c.lds;
    for (int u = (c.bid - boff + c.G) % c.G; u < (PB + SB) * 16; u += c.G) {
        const int sq = u >> 4, h = u & 15;
        int nch, ch0, row0, ntok; const float* sp = nullptr; float* op;
        if (sq < PB) { nch = 256; ch0 = (sq * 16 + h) * 256; row0 = sq * PS; ntok = 16; op = outP + (size_t)(sq * 16 + h) * 4096; }
        else { nch = 1; ch0 = PB * 16 * 256 + (sq - PB) * 16 + h; row0 = MP + (sq - PB) * SS; ntok = SS; sp = s0 + (size_t)((sq - PB) * 16 + h) * 4096; op = outS + (size_t)((sq - PB) * 16 + h) * 4096; }
        if (w >= 4) {
            const int lw = w - 4, p0 = lw < 2 ? lw * 5 : 10 + (lw - 2) * 4, np = lw < 2 ? 5 : 4;
#define RS_ISSUE(ci_) do { const int cc_ = (ci_) < nch ? (ci_) : nch - 1; const char* g_ = (const char*)(RB + (size_t)(ch0 + cc_) * RB_EL) + p0 * 1024 + lane * 16; \
            LAS unsigned char* d_ = ring + ((ci_) % RS_SLOTS) * RS_SLOT_B + p0 * 1024; \
            _Pragma("unroll") for (int p_ = 0; p_ < 5; ++p_) if (p_ < np) __builtin_amdgcn_global_load_lds((const unsigned*)(g_ + p_ * 1024), (LAS unsigned*)(d_ + p_ * 1024), 16, 0, 0); } while (0)
            for (int ci = 0; ci < RS_SLOTS - 1; ++ci) RS_ISSUE(ci);
            if (lw < 2) asm volatile("s_waitcnt vmcnt(30)" ::: "memory"); else asm volatile("s_waitcnt vmcnt(24)" ::: "memory");
            __builtin_amdgcn_s_barrier();
            for (int ci = 0; ci < nch; ++ci) {
                RS_ISSUE(ci + RS_SLOTS - 1);
                if (lw < 2) asm volatile("s_waitcnt vmcnt(30)" ::: "memory"); else asm volatile("s_waitcnt vmcnt(24)" ::: "memory");
                __builtin_amdgcn_s_barrier();
            }
#undef RS_ISSUE
            asm volatile("s_waitcnt vmcnt(0)" ::: "memory");
        } else {
            const int vb = w; f32x4 acc[4];
#pragma unroll
            for (int kb = 0; kb < 4; ++kb) acc[kb] = sp ? *(const f32x4*)(sp + (size_t)(vb * 16 + r) * 64 + kb * 16 + q * 4) : (f32x4){0.f, 0.f, 0.f, 0.f};
            const bf16x8 zfrag = (bf16x8){0, 0, 0, 0, 0, 0, 0, 0};
            __builtin_amdgcn_s_barrier();
            for (int ci = 0; ci < nch; ++ci) {
                const LAS bf16_t* blob = (const LAS bf16_t*)(ring + (ci % RS_SLOTS) * RS_SLOT_B);
                const bf16x8 t0 = pack_acc(acc[0], acc[1]), t1 = pack_acc(acc[2], acc[3]);
                const bf16x8 vt = q < 2 ? *(const LAS bf16x8*)(blob + RB_VT + (vb * 16 + r) * 24 + q * 8) : zfrag;
                const bf16x8 ep = q < 2 ? *(const LAS bf16x8*)(blob + RB_EP + r * 24 + q * 8) : zfrag;
                f32x4 y = mma16(t0, *(const LAS bf16x8*)(blob + RB_QP + r * 72 + q * 8), (f32x4){0.f, 0.f, 0.f, 0.f});
                y = mma16(t1, *(const LAS bf16x8*)(blob + RB_QP + r * 72 + 32 + q * 8), y);
                y = mma16(vt, ep, y);
#pragma unroll
                for (int kb = 0; kb < 4; ++kb) { f32x4 a = mma16(*(const LAS bf16x8*)(blob + (kb * 16 + r) * 72 + q * 8), t0, (f32x4){0.f, 0.f, 0.f, 0.f});
                    a = mma16(*(const LAS bf16x8*)(blob + (kb * 16 + r) * 72 + 32 + q * 8), t1, a);
                    const bf16x8 kh = q < 2 ? *(const LAS bf16x8*)(blob + RB_KHP + (kb * 16 + r) * 24 + q * 8) : zfrag;
                    acc[kb] = mma16(kh, vt, a); }
                if (r < ntok) { u32x2 o; o.x = pk2(y[0], y[1]); o.y = pk2(y[2], y[3]); *(u32x2*)(OB + (size_t)(row0 + ci * 16 + r) * BW + h * 64 + vb * 16 + q * 4) = o; }
                asm volatile("s_waitcnt lgkmcnt(0)" ::: "memory");
                __builtin_amdgcn_s_barrier();
            }
#pragma unroll
            for (int kb = 0; kb < 4; ++kb) *(f32x4*)(op + (size_t)(vb * 16 + r) * 64 + kb * 16 + q * 4) = acc[kb];
        }
        __syncthreads();
    }
}
__device__ __forceinline__ void ph_rwkv_fin(const Ctx& c, const float* __restrict__ RW, const float* __restrict__ lng, const float* __restrict__ lnb, bf16_t* __restrict__ OB) {
    const int lane = c.lane; const float* G = RW + 6 * (size_t)MPAD * BW; const float* BON = RW + 7 * (size_t)MPAD * BW;
    for (int i = c.bid * 8 + c.wave; i < MT * 4; i += c.G * 8) {
        const int row = i >> 2, cc = (i & 3) * 256 + lane * 4; const size_t o = (size_t)row * BW + cc; bf16_t* p = OB + o;
        const u32x2 raw = *(const u32x2*)p; float x[4] = {__uint_as_float(raw.x << 16), __uint_as_float(raw.x & 0xffff0000u), __uint_as_float(raw.y << 16), __uint_as_float(raw.y & 0xffff0000u)};
        float s = (x[0] + x[1]) + (x[2] + x[3]); s += __shfl_xor(s, 1, 64); s += __shfl_xor(s, 2, 64); s += __shfl_xor(s, 4, 64); s += __shfl_xor(s, 8, 64);
        const float mean = s * (1.0f / 64.0f); float qq = 0.f;
#pragma unroll
        for (int j = 0; j < 4; ++j) { const float d = x[j] - mean; qq += d * d; }
        qq += __shfl_xor(qq, 1, 64); qq += __shfl_xor(qq, 2, 64); qq += __shfl_xor(qq, 4, 64); qq += __shfl_xor(qq, 8, 64);
        const float rstd = rsqrtf(qq * (1.0f / 64.0f) + 64e-5f);
        const f32x4 gg = *(const f32x4*)(lng + cc), bb = *(const f32x4*)(lnb + cc), bo = *(const f32x4*)(BON + o), gt = *(const f32x4*)(G + o); float ov[4];
#pragma unroll
        for (int j = 0; j < 4; ++j) ov[j] = ((x[j] - mean) * rstd * gg[j] + bb[j] + bo[j]) * gt[j];
        u32x2 oo; oo.x = pk2(ov[0], ov[1]); oo.y = pk2(ov[2], ov[3]); *(u32x2*)p = oo;
    }
}

__device__ __forceinline__ void ph_memattn_sample(const Ctx& c, const bf16_t* __restrict__ U, const float* __restrict__ mk, const float* __restrict__ mv, bf16_t* __restrict__ OB) {
    LAS float* qs = (LAS float*)c.lds; LAS float* ps = qs + 2 * 4 * 256;
    const int hh = c.tid >> 8, vt = c.tid & 255, lane = c.lane;
    for (int u = c.bid; u < SB * 2; u += c.G) {
        const int sq = u >> 1, h = (u & 1) * 2 + hh;
#pragma unroll
        for (int t = 0; t < 4; ++t) qs[(hh * 4 + t) * 256 + vt] = bf2f(U[(size_t)(MP + sq * SS + t) * NINP + U_MQ + h * 256 + vt]) * 0.0625f;
        __syncthreads();
        { const float* kr = mk + (((size_t)sq * MEMT + vt) * 4 + h) * 256; float s[4] = {0.f, 0.f, 0.f, 0.f};
            for (int d = 0; d < 256; d += 4) { const f32x4 kv = *(const f32x4*)(kr + d);
#pragma unroll
                for (int t = 0; t < 4; ++t) { const LAS float* qq = qs + (hh * 4 + t) * 256 + d; s[t] += kv[0] * qq[0] + kv[1] * qq[1] + kv[2] * qq[2] + kv[3] * qq[3]; } }
#pragma unroll
            for (int t = 0; t < 4; ++t) ps[(hh * 4 + t) * 256 + vt] = s[t]; }
        __syncthreads();
        { LAS float* pr = ps + c.wave * 256; float x[4]; float mx = -3.0e38f;
#pragma unroll
            for (int j = 0; j < 4; ++j) { x[j] = pr[lane + 64 * j]; mx = fmaxf(mx, x[j]); }
            mx = wave_max(mx); float s = 0.f;
#pragma unroll
            for (int j = 0; j < 4; ++j) { x[j] = __expf(x[j] - mx); s += x[j]; }
            const float inv = 1.0f / wave_sum(s);
#pragma unroll
            for (int j = 0; j < 4; ++j) pr[lane + 64 * j] = x[j] * inv; }
        __syncthreads();
        { float o[4] = {0.f, 0.f, 0.f, 0.f}; const float* vr = mv + ((size_t)sq * MEMT * 4 + h) * 256 + vt;
            for (int m = 0; m < MEMT; ++m) { const float vv = vr[(size_t)m * 1024];
#pragma unroll
                for (int t = 0; t < 4; ++t) o[t] += ps[(hh * 4 + t) * 256 + m] * vv; }
#pragma unroll
            for (int t = 0; t < 4; ++t) OB[(size_t)(MP + sq * SS + t) * BW + h * 256 + vt] = f2bf(o[t]); }
        __syncthreads();
    }
}

constexpr int LDS_BAR_OFF = 147456;
constexpr int LDS_BYTES = LDS_BAR_OFF + 64;
struct Args { const float* in[37]; float* out; unsigned char* ws; };

typedef pg8::Gemm<DM, DM, DM, 2, 8, NL, 1, false, 0, 0, (long)DM * DM, 0> GemmMem;
typedef pg8::Gemm<DM, DM, DM, MPAD / 256, NINP / 256> GemmIn;
typedef pg8::Gemm<NINP, 1024, 256, PS / 256, 1, 8, 4, false, (long)PS * NINP, 256, 256 * 1024, 256> GemmScore;
typedef pg8::Gemm<256, 256, 256, PS / 256, 1, 8, 4, false, (long)4 * 4096 * 256, (long)4096 * 256, 4 * 65536, 65536> GemmPV;
typedef pg8::Gemm<BW, BW, BW, MPAD / 256, DM / 256, 4, 1, true, (long)MPAD * BW, 0, (long)DM * BW, 0> GemmBranch;
typedef pg8::Gemm<DM, DM, DM, MPAD / 256, DM / 256> GemmOut;
typedef pg8::Gemm<DM, DM, DM, MPAD / 256, 2 * DFF / 256> GemmGU;
typedef pg8::Gemm<DFF, DFF, DFF, MPAD / 256, DM / 256> GemmDown;
template <class GT> __device__ __forceinline__ GT mk_gemm(const Ctx& c, const bf16_t* A, const bf16_t* B) { GT g; g.A = A; g.B = B; g.G = c.G; g.c = c.bid; return g; }

template <int OFF> __device__ __forceinline__ unsigned long long karg_u64(unsigned long long kargs) {
    unsigned long long p; asm volatile("s_load_dwordx2 %0, %1, %2\n\ts_waitcnt lgkmcnt(0)" : "=s"(p) : "s"(kargs), "n"(OFF) : "memory"); return p;
}
#define INP(k) ((const float*)karg_u64<(k) * 8>(kargs))
#define OUTP() ((float*)karg_u64<37 * 8>(kargs))
#define WSP() ((unsigned char*)karg_u64<38 * 8>(kargs))

__global__ void __launch_bounds__(512, 2) mega_fwd(Args a_unused) {
    extern __shared__ __attribute__((aligned(16))) unsigned char lds_raw[];
    const unsigned long long kargs = (unsigned long long)__builtin_amdgcn_kernarg_segment_ptr();
    Ctx c0; c0.tid = threadIdx.x; c0.lane = c0.tid & 63; c0.wave = __builtin_amdgcn_readfirstlane(c0.tid >> 6); c0.bid = blockIdx.x; c0.G = gridDim.x; c0.lds = (LAS unsigned char*)lds_raw;
    if (c0.tid < 4) ((LAS unsigned*)(c0.lds + LDS_BAR_OFF))[c0.tid] = 0u;
    __syncthreads();
    const XcdBarrier bar = xcd_barrier_post((unsigned*)(WSP() + WS_CTL), (volatile LAS unsigned*)(c0.lds + LDS_BAR_OFF));

#define WPREP_LAYER(cc_, L_) do { unsigned char* ws_ = WSP(); \
      ph_wprep(cc_, INP(10) + (size_t)(L_) * DM * NIN, (bf16_t*)(ws_ + WS_WIN) + (size_t)(L_) * NINP * DM, DM, NIN, NINP, 1, 1, 0, 0); \
      ph_wprep(cc_, INP(29) + (size_t)(L_) * 4 * BW * DM, (bf16_t*)(ws_ + WS_WBR) + (size_t)(L_) * 4 * DM * BW, BW, DM, DM, 0, 4, (size_t)BW * DM, (size_t)DM * BW); \
      ph_wprep(cc_, INP(30) + (size_t)(L_) * DM * DM, (bf16_t*)(ws_ + WS_WOUT) + (size_t)(L_) * DM * DM, DM, DM, DM, 0, 1, 0, 0); \
      ph_wprep(cc_, INP(33) + (size_t)(L_) * DM * 2 * DFF, (bf16_t*)(ws_ + WS_WGU) + (size_t)(L_) * 2 * DFF * DM, DM, 2 * DFF, 2 * DFF, 2, 1, 0, 0); \
      ph_wprep(cc_, INP(34) + (size_t)(L_) * DFF * DM, (bf16_t*)(ws_ + WS_WDN) + (size_t)(L_) * DM * DFF, DFF, DM, DM, 0, 1, 0, 0); } while (0)
    { const Ctx c = fresh(c0); unsigned char* ws = WSP();
      ph_wprep(c, INP(28), (bf16_t*)(ws + WS_WMEM), DM, DM, DM, 0, NL, (size_t)DM * DM, (size_t)DM * DM);
      WPREP_LAYER(c, 0);
      ph_xprep(c, INP(0), INP(1), INP(2), (float*)(ws + WS_HF), (bf16_t*)(ws + WS_HB), (bf16_t*)(ws + WS_MEMB)); }
    xcd_barrier(bar);
    { const Ctx c = fresh(c0); unsigned char* ws = WSP(); float* out = OUTP();
      GemmMem g = mk_gemm<GemmMem>(c, (const bf16_t*)(ws + WS_MEMB), (const bf16_t*)(ws + WS_WMEM));
      pg8::EpiMem E; E.outK = out + O_MKP; E.outV = out + O_MVP; E.kb = (bf16_t*)(ws + WS_MKB); E.vt = (bf16_t*)(ws + WS_MVT); pg8::gemm_phase<GemmMem, pg8::EpiMem, true, true>(c.lds, c.tid, g, E); }

    for (int l = 0; l < NL; ++l) {
        { const Ctx c = fresh(c0); unsigned char* ws = WSP();
          GemmIn g = mk_gemm<GemmIn>(c, (const bf16_t*)(ws + WS_HB), (const bf16_t*)(ws + WS_WIN) + (size_t)l * NINP * DM);
          pg8::EpiBf16 E; E.O = (bf16_t*)(ws + WS_U); E.zs = 0; E.ldc = NINP; E.pad = 0; pg8::gemm_phase<GemmIn, pg8::EpiBf16, true, true>(c.lds, c.tid, g, E); }
        xcd_barrier(bar);
        { const Ctx c = fresh(c0); unsigned char* ws = WSP(); float* out = OUTP(); const bf16_t* U = (const bf16_t*)(ws + WS_U); bf16_t* BR = (bf16_t*)(ws + WS_BR);
          (void)out; (void)BR;
          ph_gla_pre(c, U, INP(12) + (size_t)l * 16 * 512, INP(13) + (size_t)l * 512, (bf16_t*)(ws + WS_GLQD), (bf16_t*)(ws + WS_GLKH), (bf16_t*)(ws + WS_GLE), (bf16_t*)(ws + WS_GLVT), (float*)(ws + WS_GLGC)); }
        { const Ctx c = fresh(c0); unsigned char* ws = WSP();
          ph_rwkv_pre(c, (const bf16_t*)(ws + WS_U), INP(9) + (size_t)l * SB * RWC, INP(17) + (size_t)l * RWC, INP(18) + (size_t)l * BW, INP(19) + (size_t)l * 64 * BW, INP(20) + (size_t)l * BW, INP(21) + (size_t)l * 64 * BW,
                       INP(22) + (size_t)l * 128 * BW, INP(23) + (size_t)l * BW, INP(24) + (size_t)l * BW, INP(25) + (size_t)l * BW, (float*)(ws + WS_RW), (bf16_t*)(ws + WS_RB)); }
        { const Ctx c = fresh(c0); unsigned char* ws = WSP();
          ph_swa_sample(c, (const bf16_t*)(ws + WS_U), INP(3) + (size_t)l * SB * 16384, INP(4) + (size_t)l * SB * 16384, INP(16) + (size_t)l * 16, (bf16_t*)(ws + WS_BR) + (size_t)MPAD * BW); }
        { const Ctx c = fresh(c0); unsigned char* ws = WSP(); ph_swa_prompt(c, (const bf16_t*)(ws + WS_U), INP(16) + (size_t)l * 16, (bf16_t*)(ws + WS_BR) + (size_t)MPAD * BW); }
        { const Ctx c = fresh(c0); unsigned char* ws = WSP();
          ph_copy_outs(c, (const bf16_t*)(ws + WS_U), INP(3) + (size_t)l * SB * 16384, INP(4) + (size_t)l * SB * 16384, OUTP(), l); }
        { const Ctx c = fresh(c0); unsigned char* ws = WSP();
          ph_memattn_sample(c, (const bf16_t*)(ws + WS_U), INP(5) + (size_t)l * SB * MEMT * 1024, INP(6) + (size_t)l * SB * MEMT * 1024, (bf16_t*)(ws + WS_BR) + (size_t)3 * MPAD * BW); }
        { const Ctx c = fresh(c0); unsigned char* ws = WSP();
          GemmScore g = mk_gemm<GemmScore>(c, (const bf16_t*)(ws + WS_U) + U_MQ, (const bf16_t*)(ws + WS_MKB) + (size_t)l * 512 * 1024);
          pg8::EpiScore E; E.SC = (float*)(ws + WS_SC); pg8::gemm_phase<GemmScore, pg8::EpiScore, true, true>(c.lds, c.tid, g, E); }
        xcd_barrier(bar);
        { const Ctx c = fresh(c0); unsigned char* ws = WSP(); float* out = OUTP();
          ph_rwkv_seq(c, 64, (const bf16_t*)(ws + WS_RB), INP(8) + (size_t)l * SB * 16 * 4096, out + O_RWP + (size_t)l * PB * 16 * 4096, out + O_RWS + (size_t)l * SB * 16 * 4096,
                      (bf16_t*)(ws + WS_BR) + (size_t)2 * MPAD * BW); }
        { const Ctx c = fresh(c0); unsigned char* ws = WSP(); float* out = OUTP();
          ph_gla_seq(c, 32, (const bf16_t*)(ws + WS_GLQD), (const bf16_t*)(ws + WS_GLKH), (const bf16_t*)(ws + WS_GLE), (const bf16_t*)(ws + WS_GLVT), (const float*)(ws + WS_GLGC),
                     INP(7) + (size_t)l * SB * 4 * 32768, out + O_GLAP + (size_t)l * PB * 4 * 32768, out + O_GLAS + (size_t)l * SB * 4 * 32768, (bf16_t*)(ws + WS_BR)); }
        { const Ctx c = fresh(c0); unsigned char* ws = WSP(); ph_softmax256(c, (const float*)(ws + WS_SC), (bf16_t*)(ws + WS_PB), 8 * 4096); }
        if (l + 1 < NL && (c0.bid < 32 || c0.bid >= 96) && c0.G > 96) { Ctx c = fresh(c0); c.bid = c.bid < 32 ? c.bid : c.bid - 64; c.G = c.G - 64; WPREP_LAYER(c, l + 1); }
        xcd_barrier(bar);
        { const Ctx c = fresh(c0); unsigned char* ws = WSP(); ph_rwkv_fin(c, (const float*)(ws + WS_RW), INP(26) + (size_t)l * BW, INP(27) + (size_t)l * BW, (bf16_t*)(ws + WS_BR) + (size_t)2 * MPAD * BW); }
        { const Ctx c = fresh(c0); unsigned char* ws = WSP(); ph_gla_fin(c, (const bf16_t*)(ws + WS_U), INP(14) + (size_t)l * BW, INP(15) + (size_t)l * BW, (bf16_t*)(ws + WS_BR)); }
        { const Ctx c = fresh(c0); unsigned char* ws = WSP();
          GemmPV g = mk_gemm<GemmPV>(c, (const bf16_t*)(ws + WS_PB), (const bf16_t*)(ws + WS_MVT) + (size_t)l * 8 * 65536);
          pg8::EpiPV E; E.O = (bf16_t*)(ws + WS_BR) + (size_t)3 * MPAD * BW; pg8::gemm_phase<GemmPV, pg8::EpiPV, true, true>(c.lds, c.tid, g, E); }
        xcd_barrier(bar);
        { const Ctx c = fresh(c0); unsigned char* ws = WSP();
          GemmBranch g = mk_gemm<GemmBranch>(c, (const bf16_t*)(ws + WS_BR), (const bf16_t*)(ws + WS_WBR) + (size_t)l * 4 * DM * BW);
          pg8::EpiMerge E; E.MG = (float*)(ws + WS_MG); E.MGB = (bf16_t*)(ws + WS_MGB); E.U = (const bf16_t*)(ws + WS_U); E.gate_b = INP(11) + (size_t)l * 4 * DM; pg8::gemm_phase<GemmBranch, pg8::EpiMerge, true, true>(c.lds, c.tid, g, E); }
        xcd_barrier(bar);
        { const Ctx c = fresh(c0); unsigned char* ws = WSP();
          GemmOut g = mk_gemm<GemmOut>(c, (const bf16_t*)(ws + WS_MGB), (const bf16_t*)(ws + WS_WOUT) + (size_t)l * DM * DM);
          pg8::EpiRes E; E.R = (const float*)(ws + WS_HF); E.Y = (float*)(ws + WS_Y); pg8::gemm_phase<GemmOut, pg8::EpiRes, true, true>(c.lds, c.tid, g, E); }
        xcd_barrier(bar);
        { const Ctx c = fresh(c0); unsigned char* ws = WSP(); ph_ln(c, (const float*)(ws + WS_Y), INP(31) + (size_t)l * DM, INP(32) + (size_t)l * DM, (float*)(ws + WS_X1F), (bf16_t*)(ws + WS_X1B), nullptr, MPAD, 0); }
        xcd_barrier(bar);
        { const Ctx c = fresh(c0); unsigned char* ws = WSP();
          GemmGU g = mk_gemm<GemmGU>(c, (const bf16_t*)(ws + WS_X1B), (const bf16_t*)(ws + WS_WGU) + (size_t)l * 2 * DFF * DM);
          pg8::EpiSwiGLU E; E.O = (bf16_t*)(ws + WS_ACT); pg8::gemm_phase<GemmGU, pg8::EpiSwiGLU, true, true>(c.lds, c.tid, g, E); }
        xcd_barrier(bar);
        { const Ctx c = fresh(c0); unsigned char* ws = WSP();
          GemmDown g = mk_gemm<GemmDown>(c, (const bf16_t*)(ws + WS_ACT), (const bf16_t*)(ws + WS_WDN) + (size_t)l * DM * DFF);
          pg8::EpiRes E; E.R = (const float*)(ws + WS_X1F); E.Y = (float*)(ws + WS_Y); pg8::gemm_phase<GemmDown, pg8::EpiRes, true, true>(c.lds, c.tid, g, E); }
        xcd_barrier(bar);
        { const Ctx c = fresh(c0); unsigned char* ws = WSP(); float* out = OUTP(); ph_ln(c, (const float*)(ws + WS_Y), INP(35) + (size_t)l * DM, INP(36) + (size_t)l * DM, (float*)(ws + WS_HF), (bf16_t*)(ws + WS_HB), l == NL - 1 ? out : nullptr, MPAD, MT); }
        xcd_barrier(bar);
    }
}

extern "C" void kernel_launch(void* const* d_in, const int* in_sizes, int n_in, void* d_out, int out_size, void* d_ws, size_t ws_size, hipStream_t stream) {
    static int grid = 0;
    if (grid == 0) {
        if (n_in != 37 || (size_t)out_size != O_END || ws_size < WS_END) { fprintf(stderr, "kernel_launch: unexpected sizes (n_in %d out %d ws %zu need %zu)\n", n_in, out_size, ws_size, (size_t)WS_END); grid = -1; return; }
        int dev = 0, cus = 0;
        if (hipGetDevice(&dev) != hipSuccess || hipDeviceGetAttribute(&cus, hipDeviceAttributeMultiprocessorCount, dev) != hipSuccess) { grid = -1; return; }
        if (hipFuncSetAttribute((const void*)mega_fwd, hipFuncAttributeMaxDynamicSharedMemorySize, LDS_BYTES) != hipSuccess) { fprintf(stderr, "kernel_launch: hipFuncSetAttribute failed\n"); grid = -1; return; }
        int per_cu = 0;
        if (hipOccupancyMaxActiveBlocksPerMultiprocessor(&per_cu, (const void*)mega_fwd, 512, LDS_BYTES) != hipSuccess || per_cu < 1) { fprintf(stderr, "kernel_launch: occupancy query says %d\n", per_cu); }
        (void)hipGetLastError();
        grid = cus;
    }
    if (grid < 0) return;
    (void)hipMemsetAsync((unsigned char*)d_ws + WS_CTL, 0, XCD_BAR_WORDS * sizeof(unsigned), stream);
    Args a; memset(&a, 0, sizeof a);
    for (int i = 0; i < 37; ++i) a.in[i] = (const float*)d_in[i];
    a.out = (float*)d_out; a.ws = (unsigned char*)d_ws;
    hipLaunchKernelGGL(mega_fwd, dim3(grid), dim3(512), LDS_BYTES, stream, a);
}
```

```cpp
#include <hip/hip_runtime.h>
#include <cstdio>
#include <cstdint>
#include <cstring>

#define LAS __attribute__((address_space(3)))
typedef unsigned short bf16_t;
typedef short bf16x8 __attribute__((ext_vector_type(8)));
typedef float f32x4 __attribute__((ext_vector_type(4)));
typedef float f32x2 __attribute__((ext_vector_type(2)));
typedef unsigned u32x4 __attribute__((ext_vector_type(4)));
typedef unsigned u32x2 __attribute__((ext_vector_type(2)));

constexpr int DM = 2048, NL = 4;
constexpr int PB = 2, PS = 4096, MP = PB * PS;
constexpr int SB = 32, SS = 4, MS = SB * SS;
constexpr int MT = MP + MS;
constexpr int MPAD = 8448;
constexpr int NIN = 16912, NINP = 17152;
constexpr int U_GQ = 0, U_GK = 512, U_GV = 1024, U_GR = 2048, U_GA = 3072, U_SQ = 3328, U_SK = 4352, U_SV = 4480, U_RU = 4608, U_MQ = 7936, U_GP = 8960;
constexpr int RWC = 3328, BW = 1024, DFF = 5632, MEMT = 256;
constexpr float ALPHA = 1.681792830507429f;

constexpr size_t O_YP = 0;
constexpr size_t O_YS = O_YP + (size_t)MP * DM;
constexpr size_t O_SWKP = O_YS + (size_t)MS * DM;
constexpr size_t O_SWVP = O_SWKP + (size_t)NL * PB * 128 * 128;
constexpr size_t O_MKP = O_SWVP + (size_t)NL * PB * 128 * 128;
constexpr size_t O_MVP = O_MKP + (size_t)NL * PB * 256 * 1024;
constexpr size_t O_GLAP = O_MVP + (size_t)NL * PB * 256 * 1024;
constexpr size_t O_RWP = O_GLAP + (size_t)NL * PB * 4 * 128 * 256;
constexpr size_t O_RSP = O_RWP + (size_t)NL * PB * 16 * 64 * 64;
constexpr size_t O_SWKS = O_RSP + (size_t)NL * PB * RWC;
constexpr size_t O_SWVS = O_SWKS + (size_t)NL * SB * 128 * 128;
constexpr size_t O_GLAS = O_SWVS + (size_t)NL * SB * 128 * 128;
constexpr size_t O_RWS = O_GLAS + (size_t)NL * SB * 4 * 128 * 256;
constexpr size_t O_RSS = O_RWS + (size_t)NL * SB * 16 * 64 * 64;
constexpr size_t O_END = O_RSS + (size_t)NL * SB * RWC;
static_assert(O_END == 52881408, "output size");

constexpr size_t al256(size_t x) { return (x + 255) & ~(size_t)255; }
constexpr size_t WS_CTL = 0;
constexpr size_t WS_WIN = 65536;
constexpr size_t WS_WMEM = WS_WIN + (size_t)NL * NINP * DM * 2;
constexpr size_t WS_WBR = WS_WMEM + (size_t)NL * DM * DM * 2;
constexpr size_t WS_WOUT = WS_WBR + (size_t)NL * 4 * DM * BW * 2;
constexpr size_t WS_WGU = WS_WOUT + (size_t)NL * DM * DM * 2;
constexpr size_t WS_WDN = WS_WGU + (size_t)NL * 2 * DFF * DM * 2;
constexpr size_t WS_HF = WS_WDN + (size_t)NL * DM * DFF * 2;
constexpr size_t WS_HB = WS_HF + (size_t)MPAD * DM * 4;
constexpr size_t WS_U = WS_HB + (size_t)MPAD * DM * 2;
constexpr size_t WS_BR = WS_U + (size_t)MPAD * NINP * 2;
constexpr size_t WS_MG = WS_BR + (size_t)4 * MPAD * BW * 2;
constexpr size_t WS_MGB = WS_MG + (size_t)MPAD * DM * 4;
constexpr size_t WS_Y = WS_MGB + (size_t)MPAD * DM * 2;
constexpr size_t WS_X1F = WS_Y + (size_t)MPAD * DM * 4;
constexpr size_t WS_X1B = WS_X1F + (size_t)MPAD * DM * 4;
constexpr size_t WS_ACT = WS_X1B + (size_t)MPAD * DM * 2;
constexpr size_t WS_MEMB = WS_ACT + (size_t)MPAD * DFF * 2;
constexpr size_t WS_MKB = WS_MEMB + (size_t)512 * DM * 2;
constexpr size_t WS_MVT = WS_MKB + (size_t)NL * 512 * 1024 * 2;
constexpr size_t WS_SC = WS_MVT + (size_t)NL * 8 * 256 * 256 * 2;
constexpr size_t WS_PB = WS_SC + (size_t)8 * 4096 * 256 * 4;
constexpr size_t WS_RW = WS_PB + (size_t)8 * 4096 * 256 * 2;
constexpr size_t RW_ARR = (size_t)MPAD * BW * 4;
constexpr int GL_NCH = 512 + 128;
constexpr size_t WS_GLQD = WS_RW + 8 * RW_ARR;
constexpr size_t WS_GLKH = WS_GLQD + (size_t)GL_NCH * 8192 * 2;
constexpr size_t WS_GLE = WS_GLKH + (size_t)GL_NCH * 8192 * 2;
constexpr size_t WS_GLVT = WS_GLE + (size_t)GL_NCH * 4096 * 2;
constexpr size_t WS_GLGC = WS_GLVT + (size_t)GL_NCH * 16384 * 2;
constexpr int RB_NCH = PB * 16 * 256 + SB * 16;
constexpr int RB_EL = 9216;
constexpr int RB_QP = 4608, RB_KHP = 5760, RB_VT = 7296, RB_EP = 8832;
constexpr size_t WS_RB = WS_GLGC + (size_t)GL_NCH * 128 * 4;
constexpr size_t WS_LRW = WS_RB + (size_t)RB_NCH * RB_EL * 2;
constexpr size_t WS_END = WS_LRW + (size_t)NL * 16 * 64 * 256 * 2;

__device__ __forceinline__ float bf2f(bf16_t b) { return __uint_as_float(((unsigned)b) << 16); }
__device__ __forceinline__ bf16_t f2bf(float f) { unsigned u = __float_as_uint(f); u += 0x7FFFu + ((u >> 16) & 1u); return (bf16_t)(u >> 16); }
__device__ __forceinline__ unsigned pk2(float lo, float hi) { return (unsigned)f2bf(lo) | ((unsigned)f2bf(hi) << 16); }
__device__ __forceinline__ float wave_sum(float v) {
#pragma unroll
    for (int o = 32; o > 0; o >>= 1) v += __shfl_xor(v, o, 64);
    return v;
}
__device__ __forceinline__ float wave_max(float v) {
#pragma unroll
    for (int o = 32; o > 0; o >>= 1) v = fmaxf(v, __shfl_xor(v, o, 64));
    return v;
}
__device__ __forceinline__ float sigmoidf_(float x) { return 1.0f / (1.0f + __expf(-x)); }
__device__ __forceinline__ float softplusf_(float x) { return fmaxf(x, 0.f) + log1pf(__expf(-fabsf(x))); }
__device__ __forceinline__ float softplus_fast(float x) { return fmaxf(x, 0.f) + __logf(1.0f + __expf(-fabsf(x))); }
__device__ __forceinline__ float tanh_fast(float x) { return 1.0f - 2.0f / (1.0f + __expf(2.0f * x)); }

namespace pg8 {
constexpr int BM = 256, BK = 64, HALF = 128, HTB = HALF * BK * 2, STAGE_BYTES = 8 * HTB, NXCD = 8, WGM = 8;
__host__ __device__ __forceinline__ int lds_byte(int r, int c) { const int st = (r >> 4) * 2 + (c >> 5), rr = r & 15, cc = c & 31, ob = rr * 64 + cc * 2; return st * 1024 + (ob ^ (((ob >> 9) & 1) << 5)); }
__host__ __device__ __forceinline__ void stage_rc(int b, int& R, int& C) { const int st = b / 1024, sb = b % 1024, swz = sb ^ (((sb >> 9) & 1) << 5); R = (st >> 1) * 16 + swz / 64; C = (st & 1) * 32 + (swz % 64) / 2; }
__host__ __device__ __forceinline__ int perm32(int rho) { const int n = rho >> 4, i = rho & 15; return 8 * (i >> 2) + 4 * n + (i & 3); }

struct Unit { int pm, pn, z; };
template <int LDA_, int LDB_, int K_, int NM_, int NN_, int NZ_ = 1, int NZH_ = 1, bool ZINNER_ = false, long ZSAB_ = 0, long ZSAH_ = 0, long ZSBB_ = 0, long ZSBH_ = 0>
struct Gemm {
    static constexpr int LDA = LDA_, LDB = LDB_, K = K_, NM = NM_, NN = NN_, NZ = NZ_, NZH = NZH_; static constexpr bool ZINNER = ZINNER_;
    const bf16_t* A; const bf16_t* B; int G, c;
    __device__ __forceinline__ bool next(int i, Unit& u) const {
        constexpr int nt = NM * NN; int L, z;
        if (ZINNER) { const int it = i / NZ; z = i - it * NZ; const long LL = (long)it * G + c; if (LL >= nt) return false; L = (int)LL; }
        else { const long LL = (long)i * G + c; if (LL >= (long)nt * NZ) return false; z = (int)(LL / nt); L = (int)(LL - (long)z * nt); }
        int wgid = L; { constexpr int q = nt / NXCD, r = nt % NXCD; const int xcd = wgid % NXCD, off = wgid / NXCD; wgid = (xcd < r ? xcd * (q + 1) : r * (q + 1) + (xcd - r) * q) + off; }
        constexpr int nig = WGM * NN; const int gid = wgid / nig, fm = gid * WGM, gsz = (NM - fm) < WGM ? (NM - fm) : WGM;
        u.pm = fm + ((wgid % nig) % gsz); u.pn = (wgid % nig) / gsz; u.z = z; return true;
    }
    __device__ __forceinline__ const char* a_base(const Unit& u) const { const int zb = u.z / NZH, zh = u.z - zb * NZH; return (const char*)(A + zb * ZSAB_ + zh * ZSAH_ + (long)u.pm * BM * LDA); }
    __device__ __forceinline__ const char* b_base(const Unit& u) const { const int zb = u.z / NZH, zh = u.z - zb * NZH; return (const char*)(B + zb * ZSBB_ + zh * ZSBH_ + (long)u.pn * BM * LDB); }
};

template <class GT, class Epi, bool ALIGN_EPI = true, bool SP2 = true>
__device__ __forceinline__ void gemm_phase(LAS unsigned char* lds, const int tid, const GT& g, const Epi& E) {
    const int wid = __builtin_amdgcn_readfirstlane(tid >> 6), lane = tid & 63, wr = wid >> 2, wc = wid & 3, fr = lane & 15, fq = lane >> 4;
    constexpr int nt = GT::K / BK;
    unsigned voffA[2], voffB[2];
#pragma unroll
    for (int i = 0; i < 2; ++i) { int R, C; stage_rc(tid * 16 + i * 8192, R, C); const int Rb = Epi::PERM ? ((R & ~31) + perm32(R & 31)) : R;
        voffA[i] = (unsigned)(R * GT::LDA + C) * 2u; voffB[i] = (unsigned)(Rb * GT::LDB + C) * 2u; }
    constexpr size_t kstep = (size_t)(BK * 2);
    constexpr size_t hstepA = (size_t)HALF * GT::LDA * 2, hstepB = (size_t)HALF * GT::LDB * 2;
    const unsigned ldsw = (unsigned)wid * 1024u;
    const int aoff = lds_byte(wr * 64 + fr, fq * 8), boff = lds_byte(wc * 32 + fr, fq * 8);
#define PG8_SA(b, h) (((b) * 2 + (h)) * HTB)
#define PG8_SB(b, h) ((4 + (b) * 2 + (h)) * HTB)
#define PG8_STAGE(bufoff, gbase, voff) do { _Pragma("unroll") for (int _i = 0; _i < 2; ++_i) \
        __builtin_amdgcn_global_load_lds((const unsigned*)((const char*)(gbase) + (voff)[_i]), (LAS unsigned*)(lds + (bufoff) + ldsw + _i * 8192), 16, 0, 0); } while (0)
#define PG8_LDA(dst, b, h) do { _Pragma("unroll") for (int m = 0; m < 4; ++m) _Pragma("unroll") for (int k = 0; k < 2; ++k) dst[m][k] = *(const LAS bf16x8*)(lds + PG8_SA(b, h) + aoff + m * 2048 + k * 1024); } while (0)
#define PG8_LDB(dst, b, h) do { _Pragma("unroll") for (int n = 0; n < 2; ++n) _Pragma("unroll") for (int k = 0; k < 2; ++k) dst[n][k] = *(const LAS bf16x8*)(lds + PG8_SB(b, h) + boff + n * 2048 + k * 1024); } while (0)
#define PG8_MMA(ai, bj, At, Bt) do { __builtin_amdgcn_s_setprio(1); _Pragma("unroll") for (int m = 0; m < 4; ++m) _Pragma("unroll") for (int n = 0; n < 2; ++n) _Pragma("unroll") for (int k = 0; k < 2; ++k) \
        acc[ai][bj][m][n] = __builtin_amdgcn_mfma_f32_16x16x32_bf16(Bt[n][k], At[m][k], acc[ai][bj][m][n], 0, 0, 0); __builtin_amdgcn_s_setprio(0); } while (0)
#define PG8_WAIT_V(n) asm volatile("s_waitcnt vmcnt(" #n ")" ::: "memory")
#define PG8_WAIT_L(n) asm volatile("s_waitcnt lgkmcnt(" #n ")" ::: "memory")
#define PG8_BAR __builtin_amdgcn_s_barrier()
#define PG8_SCHED __builtin_amdgcn_sched_barrier(0)
    Unit cur, nxt; int ui = 0;
    if (!g.next(0, cur)) return;
    f32x4 acc[2][2][4][2];
#pragma unroll
    for (int a = 0; a < 2; ++a)
#pragma unroll
        for (int b = 0; b < 2; ++b)
#pragma unroll
            for (int m = 0; m < 4; ++m)
#pragma unroll
                for (int n = 0; n < 2; ++n) acc[a][b][m][n] = (f32x4){0.f, 0.f, 0.f, 0.f};
    bf16x8 At[4][2], B0[2][2], B1[2][2];
    const char* cA = g.a_base(cur); const char* cB = g.b_base(cur);
    if constexpr (SP2) {
        PG8_STAGE(PG8_SB(0, 0), cB, voffB); PG8_STAGE(PG8_SB(0, 1), cB + hstepB, voffB); PG8_STAGE(PG8_SA(0, 0), cA, voffA); PG8_STAGE(PG8_SA(0, 1), cA + hstepA, voffA);
        if (wr == 1) PG8_BAR;
        PG8_WAIT_V(2); PG8_BAR;
        PG8_STAGE(PG8_SB(1, 0), cB + kstep, voffB); PG8_STAGE(PG8_SA(1, 0), cA + kstep, voffA); PG8_STAGE(PG8_SB(1, 1), cB + hstepB + kstep, voffB);
        PG8_WAIT_V(6); PG8_BAR;
    } else {
        PG8_STAGE(PG8_SB(0, 0), cB, voffB); PG8_STAGE(PG8_SA(0, 0), cA, voffA); PG8_STAGE(PG8_SB(0, 1), cB + hstepB, voffB); PG8_STAGE(PG8_SA(0, 1), cA + hstepA, voffA);
        if (wr == 1) PG8_BAR;
        PG8_WAIT_V(4); PG8_BAR;
        PG8_STAGE(PG8_SB(1, 0), cB + kstep, voffB); PG8_STAGE(PG8_SA(1, 0), cA + kstep, voffA); PG8_STAGE(PG8_SB(1, 1), cB + hstepB + kstep, voffB);
        PG8_WAIT_V(6); PG8_BAR;
    }
    for (;;) {
        const bool has_next = g.next(ui + 1, nxt);
        const char* nA = has_next ? g.a_base(nxt) : cA; const char* nB = has_next ? g.b_base(nxt) : cB;
#pragma unroll 1
        for (int t = 0; t < nt; t += 2) {
            const bool last = (t == nt - 2);
            const char* a1 = cA + (size_t)(t + 1) * kstep;
            const char* a2 = last ? nA : cA + (size_t)(t + 2) * kstep; const char* b2 = last ? nB : cB + (size_t)(t + 2) * kstep;
            const char* a3 = a2 + kstep; const char* b3 = b2 + kstep;
            if constexpr (SP2) {
            PG8_LDB(B0, 0, 0); PG8_LDB(B1, 0, 1); PG8_SCHED; PG8_LDA(At, 0, 0); PG8_STAGE(PG8_SA(1, 1), a1 + hstepA, voffA);
            PG8_WAIT_V(8); PG8_WAIT_L(0); PG8_BAR; PG8_MMA(0, 0, At, B0); PG8_MMA(0, 1, At, B1); PG8_BAR; PG8_SCHED;
            PG8_LDA(At, 0, 1); PG8_STAGE(PG8_SB(0, 0), b2, voffB); PG8_STAGE(PG8_SB(0, 1), b2 + hstepB, voffB); PG8_STAGE(PG8_SA(0, 0), a2, voffA);
            PG8_WAIT_V(8); PG8_WAIT_L(0); PG8_BAR; PG8_MMA(1, 0, At, B0); PG8_MMA(1, 1, At, B1); PG8_BAR; PG8_SCHED;
            PG8_LDB(B0, 1, 0); PG8_LDB(B1, 1, 1); PG8_SCHED; PG8_LDA(At, 1, 0); PG8_STAGE(PG8_SA(0, 1), a2 + hstepA, voffA);
            PG8_WAIT_V(8); PG8_WAIT_L(0); PG8_BAR; PG8_MMA(0, 0, At, B0); PG8_MMA(0, 1, At, B1); PG8_BAR; PG8_SCHED;
            PG8_LDA(At, 1, 1); PG8_STAGE(PG8_SB(1, 0), b3, voffB); PG8_STAGE(PG8_SB(1, 1), b3 + hstepB, voffB); PG8_STAGE(PG8_SA(1, 0), a3, voffA);
            PG8_WAIT_V(8); PG8_WAIT_L(0); PG8_BAR; PG8_MMA(1, 0, At, B0); PG8_MMA(1, 1, At, B1); PG8_BAR; PG8_SCHED;
            } else {
            PG8_LDB(B0, 0, 0); PG8_SCHED; PG8_LDA(At, 0, 0); PG8_STAGE(PG8_SA(1, 1), a1 + hstepA, voffA);
            PG8_WAIT_L(8); PG8_BAR; PG8_WAIT_L(0); PG8_MMA(0, 0, At, B0); PG8_BAR; PG8_SCHED;
            PG8_LDB(B1, 0, 1); PG8_STAGE(PG8_SB(0, 0), b2, voffB);
            PG8_BAR; PG8_WAIT_L(0); PG8_MMA(0, 1, At, B1); PG8_BAR;
            PG8_LDA(At, 0, 1); PG8_STAGE(PG8_SA(0, 0), a2, voffA);
            PG8_BAR; PG8_WAIT_L(0); PG8_MMA(1, 0, At, B0); PG8_BAR; PG8_SCHED;
            PG8_STAGE(PG8_SB(0, 1), b2 + hstepB, voffB);
            PG8_WAIT_V(6); PG8_BAR; PG8_MMA(1, 1, At, B1); PG8_BAR;
            PG8_LDB(B0, 1, 0); PG8_SCHED; PG8_LDA(At, 1, 0); PG8_STAGE(PG8_SA(0, 1), a2 + hstepA, voffA);
            PG8_WAIT_L(8); PG8_BAR; PG8_WAIT_L(0); PG8_MMA(0, 0, At, B0); PG8_BAR; PG8_SCHED;
            PG8_LDB(B1, 1, 1); PG8_STAGE(PG8_SB(1, 0), b3, voffB);
            PG8_BAR; PG8_WAIT_L(0); PG8_MMA(0, 1, At, B1); PG8_BAR;
            PG8_LDA(At, 1, 1); PG8_STAGE(PG8_SA(1, 0), a3, voffA);
            PG8_BAR; PG8_WAIT_L(0); PG8_MMA(1, 0, At, B0); PG8_BAR; PG8_SCHED;
            PG8_STAGE(PG8_SB(1, 1), b3 + hstepB, voffB);
            PG8_WAIT_V(6); PG8_BAR; PG8_MMA(1, 1, At, B1); PG8_BAR;
            }
        }
        if constexpr (ALIGN_EPI) { if (wr == 0) PG8_BAR; }
        E(acc, cur, wr, wc, fr, fq);
        if (!has_next) break;
#pragma unroll
        for (int a = 0; a < 2; ++a)
#pragma unroll
            for (int b = 0; b < 2; ++b)
#pragma unroll
                for (int m = 0; m < 4; ++m)
#pragma unroll
                    for (int n = 0; n < 2; ++n) acc[a][b][m][n] = (f32x4){0.f, 0.f, 0.f, 0.f};
        cur = nxt; cA = nA; cB = nB; ++ui;
        if constexpr (ALIGN_EPI) { if (wr == 1) PG8_BAR; }
    }
    PG8_WAIT_V(0);
    if constexpr (!ALIGN_EPI) { if (wr == 0) PG8_BAR; }
    PG8_BAR;
#undef PG8_SA
#undef PG8_SB
#undef PG8_STAGE
#undef PG8_LDA
#undef PG8_LDB
#undef PG8_MMA
#undef PG8_WAIT_V
#undef PG8_WAIT_L
#undef PG8_BAR
#undef PG8_SCHED
}

struct EpiBf16 {
    static constexpr bool PERM = true;
    bf16_t* O; long zs; int ldc, pad;
    __device__ __forceinline__ void operator()(const f32x4 (&acc)[2][2][4][2], const Unit& u, int wr, int wc, int fr, int fq) const {
        const int row0 = u.pm * BM + wr * 64 + fr, col0 = u.pn * BM + wc * 32 + 8 * fq; bf16_t* base = O + (long)u.z * zs;
#pragma unroll
        for (int ai = 0; ai < 2; ++ai)
#pragma unroll
            for (int m = 0; m < 4; ++m) { bf16_t* rowp = base + (size_t)(row0 + ai * HALF + m * 16) * ldc + col0;
#pragma unroll
                for (int bj = 0; bj < 2; ++bj) { const f32x4 v0 = acc[ai][bj][m][0], v1 = acc[ai][bj][m][1];
                    u32x4 w; w.x = pk2(v0[0], v0[1]); w.y = pk2(v0[2], v0[3]); w.z = pk2(v1[0], v1[1]); w.w = pk2(v1[2], v1[3]);
                    *(u32x4*)(rowp + bj * HALF) = w; } }
    }
};
struct EpiMem {
    static constexpr bool PERM = false;
    float* outK; float* outV; bf16_t* kb; bf16_t* vt;
    __device__ __forceinline__ void operator()(const f32x4 (&acc)[2][2][4][2], const Unit& u, int wr, int wc, int fr, int fq) const {
        const int row0 = u.pm * BM + wr * 64 + fr, col0 = u.pn * BM + wc * 32 + 4 * fq;
#pragma unroll
        for (int ai = 0; ai < 2; ++ai)
#pragma unroll
            for (int m = 0; m < 4; ++m) { const int row = row0 + ai * HALF + m * 16;
#pragma unroll
                for (int bj = 0; bj < 2; ++bj)
#pragma unroll
                    for (int n = 0; n < 2; ++n) { const int col = col0 + bj * HALF + n * 16; const f32x4 v = acc[ai][bj][m][n];
                        if (col < 1024) { *(f32x4*)(outK + ((size_t)u.z * 512 + row) * 1024 + col) = v;
                            u32x2 w; w.x = pk2(v[0], v[1]); w.y = pk2(v[2], v[3]); *(u32x2*)(kb + ((size_t)u.z * 512 + row) * 1024 + col) = w; }
                        else { const int c = col - 1024; *(f32x4*)(outV + ((size_t)u.z * 512 + row) * 1024 + c) = v;
                            const int b = row >> 8, mm = row & 255, h = c >> 8, d = c & 255; bf16_t* p = vt + ((((size_t)u.z * 2 + b) * 4 + h) * 256 + d) * 256 + mm;
                            p[0] = f2bf(v[0]); p[256] = f2bf(v[1]); p[512] = f2bf(v[2]); p[768] = f2bf(v[3]); } } }
    }
};
struct EpiMerge {
    static constexpr bool PERM = false;
    float* MG; bf16_t* MGB; const bf16_t* U; const float* gate_b;
    __device__ __forceinline__ void operator()(const f32x4 (&acc)[2][2][4][2], const Unit& u, int wr, int wc, int fr, int fq) const {
        const int row0 = u.pm * BM + wr * 64 + fr, col0 = u.pn * BM + wc * 32 + 4 * fq;
#pragma unroll
        for (int ai = 0; ai < 2; ++ai)
#pragma unroll
            for (int m = 0; m < 4; ++m) { const int row = row0 + ai * HALF + m * 16;
#pragma unroll
                for (int bj = 0; bj < 2; ++bj)
#pragma unroll
                    for (int n = 0; n < 2; ++n) { const int col = col0 + bj * HALF + n * 16; const f32x4 v = acc[ai][bj][m][n];
                        const u32x2 gp = *(const u32x2*)(U + (size_t)row * NINP + U_GP + u.z * DM + col); const f32x4 gb = *(const f32x4*)(gate_b + u.z * DM + col);
                        f32x4 gt; gt[0] = sigmoidf_(__uint_as_float(gp.x << 16) + gb[0]); gt[1] = sigmoidf_(__uint_as_float(gp.x & 0xffff0000u) + gb[1]);
                        gt[2] = sigmoidf_(__uint_as_float(gp.y << 16) + gb[2]); gt[3] = sigmoidf_(__uint_as_float(gp.y & 0xffff0000u) + gb[3]);
                        float* mp = MG + (size_t)row * DM + col; f32x4 r = gt * v;
                        if (u.z > 0) r += *(const f32x4*)mp;
                        if (u.z < 3) *(f32x4*)mp = r;
                        else { u32x2 w; w.x = pk2(r[0], r[1]); w.y = pk2(r[2], r[3]); *(u32x2*)(MGB + (size_t)row * DM + col) = w; } } }
    }
};
struct EpiRes {
    static constexpr bool PERM = false;
    const float* R; float* Y;
    __device__ __forceinline__ void operator()(const f32x4 (&acc)[2][2][4][2], const Unit& u, int wr, int wc, int fr, int fq) const {
        const int row0 = u.pm * BM + wr * 64 + fr, col0 = u.pn * BM + wc * 32 + 4 * fq;
#pragma unroll
        for (int ai = 0; ai < 2; ++ai)
#pragma unroll
            for (int m = 0; m < 4; ++m) { const size_t ro = (size_t)(row0 + ai * HALF + m * 16) * DM + col0;
#pragma unroll
                for (int bj = 0; bj < 2; ++bj)
#pragma unroll
                    for (int n = 0; n < 2; ++n) { const size_t o = ro + bj * HALF + n * 16; *(f32x4*)(Y + o) = *(const f32x4*)(R + o) * ALPHA + acc[ai][bj][m][n]; } }
    }
};
struct EpiSwiGLU {
    static constexpr bool PERM = true;
    bf16_t* O;
    __device__ __forceinline__ void operator()(const f32x4 (&acc)[2][2][4][2], const Unit& u, int wr, int wc, int fr, int fq) const {
        const int row0 = u.pm * BM + wr * 64 + fr, col0 = u.pn * HALF + wc * 32 + 8 * fq;
#pragma unroll
        for (int ai = 0; ai < 2; ++ai)
#pragma unroll
            for (int m = 0; m < 4; ++m) { bf16_t* rowp = O + (size_t)(row0 + ai * HALF + m * 16) * DFF + col0;
                float r[8];
#pragma unroll
                for (int n = 0; n < 2; ++n)
#pragma unroll
                    for (int j = 0; j < 4; ++j) { const float gg = acc[ai][0][m][n][j], uu = acc[ai][1][m][n][j]; r[n * 4 + j] = gg * sigmoidf_(gg) * uu; }
                u32x4 w; w.x = pk2(r[0], r[1]); w.y = pk2(r[2], r[3]); w.z = pk2(r[4], r[5]); w.w = pk2(r[6], r[7]);
                *(u32x4*)rowp = w; }
    }
};
struct EpiScore {
    static constexpr bool PERM = false;
    float* SC;
    __device__ __forceinline__ void operator()(const f32x4 (&acc)[2][2][4][2], const Unit& u, int wr, int wc, int fr, int fq) const {
        const int row0 = u.pm * BM + wr * 64 + fr, col0 = wc * 32 + 4 * fq; float* base = SC + (size_t)u.z * 4096 * 256;
#pragma unroll
        for (int ai = 0; ai < 2; ++ai)
#pragma unroll
            for (int m = 0; m < 4; ++m) { float* rowp = base + (size_t)(row0 + ai * HALF + m * 16) * 256 + col0;
#pragma unroll
                for (int bj = 0; bj < 2; ++bj)
#pragma unroll
                    for (int n = 0; n < 2; ++n) *(f32x4*)(rowp + bj * HALF + n * 16) = acc[ai][bj][m][n] * 0.0625f; }
    }
};
struct EpiPV {
    static constexpr bool PERM = true;
    bf16_t* O;
    __device__ __forceinline__ void operator()(const f32x4 (&acc)[2][2][4][2], const Unit& u, int wr, int wc, int fr, int fq) const {
        const int b = u.z >> 2, h = u.z & 3; const int row0 = b * PS + u.pm * BM + wr * 64 + fr, col0 = h * 256 + wc * 32 + 8 * fq;
#pragma unroll
        for (int ai = 0; ai < 2; ++ai)
#pragma unroll
            for (int m = 0; m < 4; ++m) { bf16_t* rowp = O + (size_t)(row0 + ai * HALF + m * 16) * BW + col0;
#pragma unroll
                for (int bj = 0; bj < 2; ++bj) { const f32x4 v0 = acc[ai][bj][m][0], v1 = acc[ai][bj][m][1];
                    u32x4 w; w.x = pk2(v0[0], v0[1]); w.y = pk2(v0[2], v0[3]); w.z = pk2(v1[0], v1[1]); w.w = pk2(v1[2], v1[3]);
                    *(u32x4*)(rowp + bj * HALF) = w; } }
    }
};
}


#define XB_TMO      128
#define XB_XCNT(j)  (256  + 64 * (j))
#define XB_XSUB(j)  (1280 + 64 * (j))
#define XB_XGEN(j)  (2304 + 64 * (j))
#define XB_TOP      3328
#define XB_TOPGEN   3392
#define XCD_BAR_WORDS 3456
#define XB_SPIN_CAP (1u << 18)
__device__ __forceinline__ unsigned xb_ld(unsigned* p)              { return __hip_atomic_load(p, __ATOMIC_RELAXED, __HIP_MEMORY_SCOPE_AGENT); }
__device__ __forceinline__ unsigned xb_add(unsigned* p, unsigned v) { return __hip_atomic_fetch_add(p, v, __ATOMIC_RELAXED, __HIP_MEMORY_SCOPE_AGENT); }
__device__ __forceinline__ unsigned xb_xcc_id() { return (unsigned)__builtin_amdgcn_s_getreg((3 << 11) | 20) & 0xFu; }
#define XB_SPIN(cond, bar) do { unsigned _sp = 0; while (cond) { __builtin_amdgcn_s_sleep(1); \
    if ((++_sp & 255u) == 0u) { if (xb_ld(&(bar)[XB_TMO])) break; if (_sp > XB_SPIN_CAP) { atomicAdd(&(bar)[XB_TMO], 1u); break; } } } } while (0)
struct XcdBarrier { unsigned* bar; unsigned x; volatile LAS unsigned* st; };
__device__ __forceinline__ XcdBarrier xcd_barrier_post(unsigned* bar, volatile LAS unsigned* st) {
    XcdBarrier b; b.bar = bar; b.x = xb_xcc_id(); b.st = st;
    if (threadIdx.x == 0) (void)xb_add(&bar[XB_XCNT(b.x)], 1u);
    return b;
}
__device__ __forceinline__ void xcd_barrier_complete(unsigned* bar, unsigned x, unsigned& nloc, unsigned& nx) {
    const unsigned G = gridDim.x * gridDim.y * gridDim.z;
    unsigned sum, cnt, mine, sp = 0u;
    for (;;) {
        sum = 0u; cnt = 0u; mine = 0u;
#pragma unroll
        for (unsigned j = 0; j < 16; ++j) { const unsigned c = xb_ld(&bar[XB_XCNT(j)]); sum += c; cnt += (c > 0u) ? 1u : 0u; mine = (j == x) ? c : mine; }
        if (sum == G) break;
        __builtin_amdgcn_s_sleep(1);
        if ((++sp & 255u) == 0u) { if (xb_ld(&bar[XB_TMO])) break; if (sp > XB_SPIN_CAP) { atomicAdd(&bar[XB_TMO], 1u); break; } }
    }
    nloc = mine > 0u ? mine : 1u; nx = cnt > 0u ? cnt : 1u;
}
__device__ __forceinline__ void xcd_barrier(const XcdBarrier& b) {
    asm volatile("s_waitcnt vmcnt(0)" ::: "memory");
    __syncthreads();
    if (threadIdx.x == 0) {
        unsigned* bar = b.bar;
        __builtin_amdgcn_s_waitcnt(0);
        unsigned nloc = b.st[0], nx = b.st[1];
        if (nloc == 0u) { xcd_barrier_complete(bar, b.x, nloc, nx); b.st[0] = nloc; b.st[1] = nx; }
        const unsigned old = xb_add(&bar[XB_XSUB(b.x)], 1u);
        const unsigned gen = old / nloc;
        if (old + 1u == (gen + 1u) * nloc) {
            __builtin_amdgcn_fence(__ATOMIC_RELEASE, "agent");
            asm volatile("s_waitcnt vmcnt(0)" ::: "memory");
            const unsigned og = xb_add(&bar[XB_TOP], 1u);
            const unsigned tg = og / nx;
            if (og + 1u == (tg + 1u) * nx) xb_add(&bar[XB_TOPGEN], 1u);
            else XB_SPIN(xb_ld(&bar[XB_TOPGEN]) == tg, bar);
            __builtin_amdgcn_fence(__ATOMIC_ACQUIRE, "agent");
            xb_add(&bar[XB_XGEN(b.x)], 1u);
            asm volatile("s_waitcnt vmcnt(0)" ::: "memory");
        } else {
            XB_SPIN(xb_ld(&bar[XB_XGEN(b.x)]) == gen, bar);
            __builtin_amdgcn_fence(__ATOMIC_ACQUIRE, "agent");
            asm volatile("s_waitcnt vmcnt(0)" ::: "memory");
        }
    }
    __syncthreads();
}

struct Ctx { int tid, lane, wave, bid, G; LAS unsigned char* lds; };
__device__ __forceinline__ Ctx fresh(const Ctx& c0) { Ctx c; c.wave = c0.wave; c.bid = c0.bid; c.G = c0.G; c.lds = c0.lds; asm volatile("" : "+s"(c.bid), "+s"(c.G), "+s"(c.wave));
    int lane = (int)__builtin_amdgcn_mbcnt_hi(~0u, __builtin_amdgcn_mbcnt_lo(~0u, 0u)); asm volatile("" : "+v"(lane)); c.lane = lane; c.tid = c.wave * 64 + lane; return c; }

__device__ __forceinline__ int colmap(int mode, int n) {
    if (mode == 1) return n < 3088 ? n : (n < 3328 ? -1 : n - 240);
    if (mode == 2) { const int t = n >> 8, j = n & 255; return j < 128 ? t * 128 + j : DFF + t * 128 + (j - 128); }
    return n;
}
__device__ __forceinline__ void wprep_load(f32x4 (&rg)[8], const float* __restrict__ src, int K, int Nsrc, int Ndst, int mode, size_t sbs, int item, int tid) {
    const int nx = Ndst / 256, ny = K / 64; const int bx = item % nx, by = (item / nx) % ny, bz = item / (nx * ny);
    const int tx = tid & 63, ty = tid >> 6, cm = colmap(mode, bx * 256 + tx * 4); const float* s = src + (size_t)bz * sbs + (size_t)(by * 64 + ty) * Nsrc + cm;
#pragma unroll
    for (int i = 0; i < 8; ++i) rg[i] = cm >= 0 ? *(const f32x4*)(s + (size_t)(8 * i) * Nsrc) : (f32x4){0.f, 0.f, 0.f, 0.f};
}
__device__ __forceinline__ void ph_wprep(const Ctx& c, const float* __restrict__ src, bf16_t* __restrict__ dst, int K, int Nsrc, int Ndst, int mode, int nbatch, size_t sbs, size_t dbs) {
    LAS float* tile = (LAS float*)c.lds;
    const int nx = Ndst / 256, ny = K / 64, total = nx * ny * nbatch;
    const int tid = c.tid, tx = tid & 63, ty = tid >> 6, n = tid >> 1, kh = tid & 1;
    f32x4 rg[8];
    int item = c.bid;
    if (item < total) wprep_load(rg, src, K, Nsrc, Ndst, mode, sbs, item, tid);
    for (; item < total; item += c.G) {
        __syncthreads();
#pragma unroll
        for (int i = 0; i < 8; ++i) *(LAS f32x4*)(tile + (ty + 8 * i) * 260 + tx * 4) = rg[i];
        __syncthreads();
        const int bx = item % nx, by = (item / nx) % ny, bz = item / (nx * ny);
        if (item + c.G < total) wprep_load(rg, src, K, Nsrc, Ndst, mode, sbs, item + c.G, tid);
        bf16_t* d = dst + (size_t)bz * dbs + (size_t)(bx * 256 + n) * K + by * 64 + kh * 32;
#pragma unroll
        for (int g = 0; g < 4; ++g) { unsigned p[4];
#pragma unroll
            for (int e = 0; e < 4; ++e) p[e] = pk2(tile[(kh * 32 + g * 8 + 2 * e) * 260 + n], tile[(kh * 32 + g * 8 + 2 * e + 1) * 260 + n]);
            *(u32x4*)(d + g * 8) = (u32x4){p[0], p[1], p[2], p[3]}; }
    }
    __syncthreads();
}
__device__ __forceinline__ void ph_xprep(const Ctx& c, const float* __restrict__ xp, const float* __restrict__ xs, const float* __restrict__ mem, float* __restrict__ HF, bf16_t* __restrict__ HB, bf16_t* __restrict__ MEMB) {
    const size_t nH = (size_t)MPAD * DM / 4, nM = (size_t)512 * DM / 4;
    for (size_t i4 = (size_t)c.bid * 512 + c.tid; i4 < nH + nM; i4 += (size_t)c.G * 512) {
        if (i4 < nH) {
            const size_t e = i4 * 4; f32x4 v = (f32x4){0.f, 0.f, 0.f, 0.f};
            if (e < (size_t)MP * DM) v = *(const f32x4*)(xp + e); else if (e < (size_t)MT * DM) v = *(const f32x4*)(xs + (e - (size_t)MP * DM));
            *(f32x4*)(HF + e) = v; u32x2 w; w.x = pk2(v[0], v[1]); w.y = pk2(v[2], v[3]); *(u32x2*)(HB + e) = w;
        } else {
            const size_t e = (i4 - nH) * 4; const f32x4 v = *(const f32x4*)(mem + e); u32x2 w; w.x = pk2(v[0], v[1]); w.y = pk2(v[2], v[3]); *(u32x2*)(MEMB + e) = w;
        }
    }
}
__device__ __forceinline__ void ph_ln(const Ctx& c, const float* __restrict__ Y, const float* __restrict__ g, const float* __restrict__ b, float* __restrict__ XF, bf16_t* __restrict__ XB, float* __restrict__ OUT, int nrows, int nout) {
    const int lane = c.lane;
    for (int row = c.bid * 8 + c.wave; row < nrows; row += c.G * 8) {
        const float* y = Y + (size_t)row * DM; f32x4 v[8]; float s = 0.f;
#pragma unroll
        for (int j = 0; j < 8; ++j) { v[j] = *(const f32x4*)(y + j * 256 + lane * 4); s += (v[j][0] + v[j][1]) + (v[j][2] + v[j][3]); }
        const float mean = wave_sum(s) * (1.0f / DM); float q = 0.f;
#pragma unroll
        for (int j = 0; j < 8; ++j) { const f32x4 d = v[j] - mean; q += (d[0] * d[0] + d[1] * d[1]) + (d[2] * d[2] + d[3] * d[3]); }
        const float rstd = rsqrtf(wave_sum(q) * (1.0f / DM) + 1e-5f);
#pragma unroll
        for (int j = 0; j < 8; ++j) { const int cc = j * 256 + lane * 4; const f32x4 gg = *(const f32x4*)(g + cc), bb = *(const f32x4*)(b + cc);
            const f32x4 o = (v[j] - mean) * rstd * gg + bb; const size_t off = (size_t)row * DM + cc;
            *(f32x4*)(XF + off) = o; u32x2 w; w.x = pk2(o[0], o[1]); w.y = pk2(o[2], o[3]); *(u32x2*)(XB + off) = w;
            if (OUT != nullptr && row < nout) *(f32x4*)(OUT + off) = o; }
    }
}
__device__ __forceinline__ void ph_softmax256(const Ctx& c, const float* __restrict__ SC, bf16_t* __restrict__ P, int nrows) {
    const int lane = c.lane;
    for (int row = c.bid * 8 + c.wave; row < nrows; row += c.G * 8) {
        const f32x4 v = *(const f32x4*)(SC + (size_t)row * 256 + lane * 4);
        const float mx = wave_max(fmaxf(fmaxf(v[0], v[1]), fmaxf(v[2], v[3])));
        f32x4 e; e[0] = __expf(v[0] - mx); e[1] = __expf(v[1] - mx); e[2] = __expf(v[2] - mx); e[3] = __expf(v[3] - mx);
        const float inv = 1.0f / wave_sum((e[0] + e[1]) + (e[2] + e[3]));
        u32x2 w; w.x = pk2(e[0] * inv, e[1] * inv); w.y = pk2(e[2] * inv, e[3] * inv); *(u32x2*)(P + (size_t)row * 256 + lane * 4) = w;
    }
}
__device__ __forceinline__ void ph_copy_outs(const Ctx& c, const bf16_t* __restrict__ U, const float* __restrict__ ck, const float* __restrict__ cv, float* __restrict__ out, int layer) {
    constexpr int nA = PB * 128 * 128, nB = SB * 128 * 128, nC = PB * RWC, nD = SB * RWC;
    for (int i = c.bid * 512 + c.tid; i < nA + nB + nC + nD; i += c.G * 512) {
        if (i < nA) { const int b = i / 16384, j = (i >> 7) & 127, cc = i & 127; const size_t ur = (size_t)(b * PS + PS - 128 + j) * NINP;
            out[O_SWKP + (size_t)layer * nA + i] = bf2f(U[ur + U_SK + cc]); out[O_SWVP + (size_t)layer * nA + i] = bf2f(U[ur + U_SV + cc]); continue; }
        int k = i - nA;
        if (k < nB) { const int sq = k / 16384, j = (k >> 7) & 127, cc = k & 127; float kv, vv;
            if (j < 124) { const size_t o = ((size_t)sq * 128 + j + 4) * 128 + cc; kv = ck[o]; vv = cv[o]; }
            else { const size_t ur = (size_t)(MP + sq * SS + j - 124) * NINP; kv = bf2f(U[ur + U_SK + cc]); vv = bf2f(U[ur + U_SV + cc]); }
            out[O_SWKS + (size_t)layer * nB + k] = kv; out[O_SWVS + (size_t)layer * nB + k] = vv; continue; }
        k -= nB;
        if (k < nC) { const int b = k / RWC, cc = k - b * RWC; out[O_RSP + (size_t)layer * nC + k] = bf2f(U[(size_t)(b * PS + PS - 1) * NINP + U_RU + cc]); continue; }
        k -= nC;
        { const int sq = k / RWC, cc = k - sq * RWC; out[O_RSS + (size_t)layer * nD + k] = bf2f(U[(size_t)(MP + sq * SS + SS - 1) * NINP + U_RU + cc]); }
    }
}

__device__ __forceinline__ void seq_info(int sq, int& row0, int& L) { if (sq < PB) { row0 = sq * PS; L = PS; } else { row0 = MP + (sq - PB) * SS; L = SS; } }

__device__ __forceinline__ void ph_gla_naive(const Ctx& c, const bf16_t* __restrict__ U, const float* __restrict__ s0, const float* __restrict__ a_up, const float* __restrict__ a_b,
                                             const float* __restrict__ ng, const float* __restrict__ nb, bf16_t* __restrict__ OB, float* __restrict__ outP, float* __restrict__ outS) {
    LAS float* qs = (LAS float*)c.lds;
    LAS float* ks = qs + 16 * 128; LAS float* as = ks + 16 * 128; LAS float* os = as + 16 * 128;
    const int kh = c.tid >> 8, vt = c.tid & 255, lane = c.lane;
    for (int u = c.bid; u < (PB + SB) * 4; u += c.G) {
        const int sq = u >> 2, h = u & 3;
        int row0, L; seq_info(sq, row0, L);
        float S[64];
        if (sq >= PB) { const float* p = s0 + (((size_t)(sq - PB) * 4 + h) * 128 + kh * 64) * 256 + vt;
#pragma unroll
            for (int kk = 0; kk < 64; ++kk) S[kk] = p[(size_t)kk * 256]; }
        else {
#pragma unroll
            for (int kk = 0; kk < 64; ++kk) S[kk] = 0.f; }
        for (int t0 = 0; t0 < L; t0 += 16) {
            const int nT = (L - t0) < 16 ? (L - t0) : 16;
            for (int idx = c.tid; idx < nT * 128; idx += 512) {
                const int tt = idx >> 7, kk = idx & 127; const bf16_t* ur = U + (size_t)(row0 + t0 + tt) * NINP;
                qs[idx] = bf2f(ur[U_GQ + h * 128 + kk]) * 0.08838834764831845f; ks[idx] = bf2f(ur[U_GK + h * 128 + kk]);
                float x = a_b[h * 128 + kk];
#pragma unroll
                for (int r = 0; r < 16; ++r) x += bf2f(ur[U_GA + r]) * a_up[r * 512 + h * 128 + kk];
                const float ls = (fminf(x, 0.f) - log1pf(__expf(-fabsf(x)))) * (1.0f / 16.0f);
                as[idx] = __expf(ls);
            }
            __syncthreads();
            for (int tt = 0; tt < nT; ++tt) {
                const float v = bf2f(U[(size_t)(row0 + t0 + tt) * NINP + U_GV + h * 256 + vt]); float o = 0.f; const int lb = tt * 128 + kh * 64;
#pragma unroll
                for (int kk = 0; kk < 64; ++kk) { S[kk] = as[lb + kk] * S[kk] + ks[lb + kk] * v; o += qs[lb + kk] * S[kk]; }
                os[(kh * 16 + tt) * 256 + vt] = o;
            }
            __syncthreads();
            for (int tt = c.wave; tt < nT; tt += 8) {
                float x[4]; float s = 0.f;
#pragma unroll
                for (int j = 0; j < 4; ++j) { x[j] = os[tt * 256 + lane + 64 * j] + os[(16 + tt) * 256 + lane + 64 * j]; s += x[j]; }
                const float mean = wave_sum(s) * (1.0f / 256.0f); float q = 0.f;
#pragma unroll
                for (int j = 0; j < 4; ++j) { const float d = x[j] - mean; q += d * d; }
                const float rstd = rsqrtf(wave_sum(q) * (1.0f / 256.0f) + 1e-5f);
                const size_t row = (size_t)(row0 + t0 + tt);
#pragma unroll
                for (int j = 0; j < 4; ++j) { const int cc = h * 256 + lane + 64 * j; const float n = (x[j] - mean) * rstd * ng[cc] + nb[cc];
                    const float gr = bf2f(U[row * NINP + U_GR + cc]); OB[row * BW + cc] = f2bf(n * gr * sigmoidf_(gr)); }
            }
            __syncthreads();
        }
        float* op = (sq < PB ? outP + (((size_t)sq * 4 + h) * 128 + kh * 64) * 256 : outS + (((size_t)(sq - PB) * 4 + h) * 128 + kh * 64) * 256) + vt;
#pragma unroll
        for (int kk = 0; kk < 64; ++kk) op[(size_t)kk * 256] = S[kk];
    }
}

__device__ __forceinline__ f32x4 mma16(bf16x8 x, bf16x8 y, f32x4 c) { return __builtin_amdgcn_mfma_f32_16x16x32_bf16(x, y, c, 0, 0, 0); }
__device__ __forceinline__ bf16x8 pack_acc(const f32x4& a, const f32x4& b) {
    u32x4 p; p.x = pk2(a[0], a[1]); p.y = pk2(a[2], a[3]); p.z = pk2(b[0], b[1]); p.w = pk2(b[2], b[3]); return __builtin_bit_cast(bf16x8, p);
}
__device__ __forceinline__ void gla_chunk_info(int u, int& row0, int& ntok, int& h) {
    if (u < 512) { const int b = u >> 8; h = (u >> 6) & 3; row0 = b * PS + (u & 63) * 64; ntok = 64; }
    else { const int s = u - 512; h = s & 3; row0 = MP + (s >> 2) * SS; ntok = SS; }
}
__device__ __forceinline__ void ph_gla_pre(const Ctx& c, const bf16_t* __restrict__ U, const float* __restrict__ a_up, const float* __restrict__ a_b,
                                           bf16_t* __restrict__ QD, bf16_t* __restrict__ KHT, bf16_t* __restrict__ EE, bf16_t* __restrict__ VT, float* __restrict__ GC) {
    LAS float* ga_l = (LAS float*)c.lds;
    LAS float* tot = ga_l + 64 * 16;
    LAS bf16_t* Qd_l = (LAS bf16_t*)(tot + 4 * 128);
    LAS bf16_t* Kn_l = Qd_l + 64 * 136;
    LAS bf16_t* v_l = Kn_l + 64 * 136;
    const int tid = c.tid, lane = c.lane, r = lane & 15, q = lane >> 4, w = c.wave;
    for (int u = c.bid; u < GL_NCH; u += c.G) {
        int row0, ntok, h; gla_chunk_info(u, row0, ntok, h);
        for (int i = tid; i < 64 * 16; i += 512) { const int t = i >> 4, rr = i & 15; ga_l[i] = t < ntok ? bf2f(U[(size_t)(row0 + t) * NINP + U_GA + rr]) : 0.f; }
        for (int i = tid; i < 64 * 32; i += 512) { const int t = i >> 5, c8 = i & 31; u32x4 vv = (u32x4){0u, 0u, 0u, 0u};
            if (t < ntok) vv = *(const u32x4*)(U + (size_t)(row0 + t) * NINP + U_GV + h * 256 + c8 * 8);
            *(LAS u32x4*)(v_l + t * 264 + c8 * 8) = vv; }
        __syncthreads();
        const int kk = tid & 127, tq = tid >> 7;
        float cum[16];
        { float aup[16];
#pragma unroll
          for (int rr = 0; rr < 16; ++rr) aup[rr] = a_up[rr * 512 + h * 128 + kk];
          const float ab = a_b[h * 128 + kk]; float run = 0.f;
#pragma unroll
          for (int j = 0; j < 16; ++j) { const int t = tq * 16 + j; float x = ab;
#pragma unroll
              for (int rr = 0; rr < 16; ++rr) x += ga_l[t * 16 + rr] * aup[rr];
              const float la = t < ntok ? (fminf(x, 0.f) - log1pf(__expf(-fabsf(x)))) * (1.0f / 16.0f) : 0.f;
              run += la; cum[j] = run; }
          tot[tq * 128 + kk] = run; }
        __syncthreads();
        { float prefix = 0.f, bC = 0.f;
#pragma unroll
          for (int g = 0; g < 4; ++g) { const float tv = tot[g * 128 + kk]; bC += tv; if (g < tq) prefix += tv; }
          unsigned khp[8];
#pragma unroll
          for (int j = 0; j < 16; j += 2) { float kh2[2];
#pragma unroll
              for (int e = 0; e < 2; ++e) { const int t = tq * 16 + j + e; const float b = prefix + cum[j + e]; float qv = 0.f, kv = 0.f;
                  if (t < ntok) { const bf16_t* ur = U + (size_t)(row0 + t) * NINP; qv = bf2f(ur[U_GQ + h * 128 + kk]); kv = bf2f(ur[U_GK + h * 128 + kk]); }
                  Qd_l[t * 136 + kk] = f2bf(qv * __expf(b) * 0.08838834764831845f); Kn_l[t * 136 + kk] = f2bf(kv * __expf(-b)); kh2[e] = kv * __expf(bC - b); }
              khp[j >> 1] = pk2(kh2[0], kh2[1]); }
          bf16_t* kp = KHT + (size_t)u * 8192 + kk * 64 + tq * 16;
          *(u32x4*)kp = (u32x4){khp[0], khp[1], khp[2], khp[3]}; *(u32x4*)(kp + 8) = (u32x4){khp[4], khp[5], khp[6], khp[7]};
          if (tq == 0) GC[(size_t)u * 128 + kk] = __expf(bC); }
        __syncthreads();
        { const int tb = w >> 1;
#pragma unroll
          for (int e = 0; e < 2; ++e) { const int ib = (w & 1) * 2 + e; f32x4 d = (f32x4){0.f, 0.f, 0.f, 0.f};
              if (ib <= tb) {
#pragma unroll
                  for (int ks = 0; ks < 4; ++ks) d = mma16(*(const LAS bf16x8*)(Kn_l + (ib * 16 + r) * 136 + ks * 32 + q * 8), *(const LAS bf16x8*)(Qd_l + (tb * 16 + r) * 136 + ks * 32 + q * 8), d); }
              const int t = tb * 16 + r, i0 = ib * 16 + q * 4;
#pragma unroll
              for (int jj = 0; jj < 4; ++jj) if (i0 + jj > t) d[jj] = 0.f;
              u32x2 o; o.x = pk2(d[0], d[1]); o.y = pk2(d[2], d[3]); *(u32x2*)(EE + (size_t)u * 4096 + t * 64 + i0) = o; } }
        for (int i = tid; i < 64 * 16; i += 512) { const int t = i >> 4, c8 = i & 15; *(u32x4*)(QD + (size_t)u * 8192 + t * 128 + c8 * 8) = *(const LAS u32x4*)(Qd_l + t * 136 + c8 * 8); }
        { const int val = tid & 255, th = tid >> 8;
#pragma unroll
          for (int tg = 0; tg < 4; ++tg) { const int t0 = th * 32 + tg * 8; unsigned p4[4];
#pragma unroll
              for (int e = 0; e < 4; ++e) p4[e] = (unsigned)v_l[(t0 + 2 * e) * 264 + val] | ((unsigned)v_l[(t0 + 2 * e + 1) * 264 + val] << 16);
              *(u32x4*)(VT + (size_t)u * 16384 + val * 64 + t0) = (u32x4){p4[0], p4[1], p4[2], p4[3]}; } }
        __syncthreads();
    }
}
struct GlaStage { u32x4 qd[2], kh[2], e, vt, gc; };
__device__ __forceinline__ void gla_stage_load(GlaStage& s, const bf16_t* __restrict__ QD, const bf16_t* __restrict__ KHT, const bf16_t* __restrict__ EE, const bf16_t* __restrict__ VT, const float* __restrict__ GC,
                                               int ch, int sl, int tid) {
    const bf16_t* qp = QD + (size_t)ch * 8192 + tid * 8; s.qd[0] = *(const u32x4*)qp; s.qd[1] = *(const u32x4*)(qp + 4096);
    const bf16_t* kp = KHT + (size_t)ch * 8192 + tid * 8; s.kh[0] = *(const u32x4*)kp; s.kh[1] = *(const u32x4*)(kp + 4096);
    s.e = *(const u32x4*)(EE + (size_t)ch * 4096 + tid * 8);
    s.vt = *(const u32x4*)(VT + (size_t)ch * 16384 + sl * 4096 + tid * 8);
    if (tid < 32) s.gc = *(const u32x4*)(GC + (size_t)ch * 128 + tid * 4);
}
constexpr int GS_KH = 8704, GS_E = 17920, GS_VT = 22528, GS_GC = 27136, GS_EL = 27392;
__device__ __forceinline__ void gla_stage_store(const GlaStage& s, LAS bf16_t* b, int tid) {
    *(LAS u32x4*)(b + (tid >> 4) * 136 + (tid & 15) * 8) = s.qd[0]; *(LAS u32x4*)(b + (32 + (tid >> 4)) * 136 + (tid & 15) * 8) = s.qd[1];
    *(LAS u32x4*)(b + GS_KH + (tid >> 3) * 72 + (tid & 7) * 8) = s.kh[0]; *(LAS u32x4*)(b + GS_KH + (64 + (tid >> 3)) * 72 + (tid & 7) * 8) = s.kh[1];
    *(LAS u32x4*)(b + GS_E + (tid >> 3) * 72 + (tid & 7) * 8) = s.e; *(LAS u32x4*)(b + GS_VT + (tid >> 3) * 72 + (tid & 7) * 8) = s.vt;
    if (tid < 32) *(LAS u32x4*)(b + GS_GC + tid * 8) = s.gc;
}
__device__ __forceinline__ void ph_gla_seq(const Ctx& c, int boff, const bf16_t* __restrict__ QD, const bf16_t* __restrict__ KHT, const bf16_t* __restrict__ EE, const bf16_t* __restrict__ VT, const float* __restrict__ GC,
                                           const float* __restrict__ s0, float* __restrict__ outP, float* __restrict__ outS, bf16_t* __restrict__ OB) {
    LAS bf16_t* stg = (LAS bf16_t*)c.lds;
    LAS bf16_t* T_l = stg + 2 * GS_EL;
    const int tid = c.tid, lane = c.lane, r = lane & 15, q = lane >> 4, w = c.wave;
    for (int u = (c.bid - boff + c.G) % c.G; u < 32 + 512; u += c.G) {
        int h, sl, nch, ch0, row0, ntok; const float* sp = nullptr; float* op;
        if (u < 32) { const int b = u >> 4; h = (u >> 2) & 3; sl = u & 3; nch = 64; ch0 = (b * 4 + h) * 64; row0 = b * PS; ntok = 64; op = outP + (size_t)(b * 4 + h) * 32768; }
        else { const int s = u - 32, sq = s >> 4; h = (s >> 2) & 3; sl = s & 3; nch = 1; ch0 = 512 + sq * 4 + h; row0 = MP + sq * SS; ntok = SS; sp = s0 + (size_t)(sq * 4 + h) * 32768; op = outS + (size_t)(sq * 4 + h) * 32768; }
        f32x4 acc[4];
#pragma unroll
        for (int vb = 0; vb < 4; ++vb)
#pragma unroll
            for (int jj = 0; jj < 4; ++jj) acc[vb][jj] = sp ? sp[(size_t)(w * 16 + q * 4 + jj) * 256 + sl * 64 + vb * 16 + r] : 0.f;
        GlaStage R0, R1, R2;
        gla_stage_load(R0, QD, KHT, EE, VT, GC, ch0, sl, tid);
        if (1 < nch) gla_stage_load(R1, QD, KHT, EE, VT, GC, ch0 + 1, sl, tid);
        if (2 < nch) gla_stage_load(R2, QD, KHT, EE, VT, GC, ch0 + 2, sl, tid);
        __syncthreads();
        gla_stage_store(R0, stg, tid);
        if (3 < nch) gla_stage_load(R0, QD, KHT, EE, VT, GC, ch0 + 3, sl, tid);
#define GLA_STEP(ci, RN) do { \
            LAS bf16_t* Tb = T_l + ((ci) & 1) * 64 * 136; const LAS bf16_t* sb = stg + ((ci) & 1) * GS_EL; \
            _Pragma("unroll") for (int vb = 0; vb < 4; ++vb) { u32x2 o; o.x = pk2(acc[vb][0], acc[vb][1]); o.y = pk2(acc[vb][2], acc[vb][3]); *(LAS u32x2*)(Tb + (vb * 16 + r) * 136 + w * 16 + q * 4) = o; } \
            __syncthreads(); \
            if ((ci) + 1 < nch) { gla_stage_store(RN, stg + (((ci) + 1) & 1) * GS_EL, tid); if ((ci) + 4 < nch) gla_stage_load(RN, QD, KHT, EE, VT, GC, ch0 + (ci) + 4, sl, tid); } \
            { const int rb = w >> 1, t = rb * 16 + r; bf16x8 qf[4], ef[2]; \
              _Pragma("unroll") for (int ks = 0; ks < 4; ++ks) qf[ks] = *(const LAS bf16x8*)(sb + (rb * 16 + r) * 136 + ks * 32 + q * 8); \
              _Pragma("unroll") for (int ks = 0; ks < 2; ++ks) ef[ks] = *(const LAS bf16x8*)(sb + GS_E + (rb * 16 + r) * 72 + ks * 32 + q * 8); \
              _Pragma("unroll") for (int e2 = 0; e2 < 2; ++e2) { const int cb = (w & 1) * 2 + e2; f32x4 y = (f32x4){0.f, 0.f, 0.f, 0.f}; \
                  _Pragma("unroll") for (int ks = 0; ks < 4; ++ks) y = mma16(*(const LAS bf16x8*)(Tb + (cb * 16 + r) * 136 + ks * 32 + q * 8), qf[ks], y); \
                  _Pragma("unroll") for (int ks = 0; ks < 2; ++ks) y = mma16(*(const LAS bf16x8*)(sb + GS_VT + (cb * 16 + r) * 72 + ks * 32 + q * 8), ef[ks], y); \
                  if (t < ntok) { u32x2 o; o.x = pk2(y[0], y[1]); o.y = pk2(y[2], y[3]); *(u32x2*)(OB + (size_t)(row0 + (ci) * 64 + t) * BW + h * 256 + sl * 64 + cb * 16 + q * 4) = o; } } } \
            { const f32x4 gcv = *(const LAS f32x4*)((const LAS float*)(sb + GS_GC) + w * 16 + q * 4); bf16x8 kf[2]; \
              _Pragma("unroll") for (int ks = 0; ks < 2; ++ks) kf[ks] = *(const LAS bf16x8*)(sb + GS_KH + (w * 16 + r) * 72 + ks * 32 + q * 8); \
              _Pragma("unroll") for (int vb = 0; vb < 4; ++vb) { acc[vb] = acc[vb] * gcv; \
                  _Pragma("unroll") for (int ks = 0; ks < 2; ++ks) acc[vb] = mma16(kf[ks], *(const LAS bf16x8*)(sb + GS_VT + (vb * 16 + r) * 72 + ks * 32 + q * 8), acc[vb]); } } \
        } while (0)
#pragma unroll 1
        for (int ci = 0; ci < nch; ci += 3) {
            GLA_STEP(ci, R1);
            if (ci + 1 < nch) GLA_STEP(ci + 1, R2);
            if (ci + 2 < nch) GLA_STEP(ci + 2, R0);
        }
#undef GLA_STEP
#pragma unroll
        for (int vb = 0; vb < 4; ++vb)
#pragma unroll
            for (int jj = 0; jj < 4; ++jj) op[(size_t)(w * 16 + q * 4 + jj) * 256 + sl * 64 + vb * 16 + r] = acc[vb][jj];
        __syncthreads();
    }
}
__device__ __forceinline__ void ph_gla_fin(const Ctx& c, const bf16_t* __restrict__ U, const float* __restrict__ ng, const float* __restrict__ nb, bf16_t* __restrict__ OB) {
    const int lane = c.lane;
    for (int i = c.bid * 8 + c.wave; i < MT * 4; i += c.G * 8) {
        const int row = i >> 2, h = i & 3, cc = h * 256 + lane * 4; bf16_t* p = OB + (size_t)row * BW + cc;
        const u32x2 raw = *(const u32x2*)p; float x[4] = {__uint_as_float(raw.x << 16), __uint_as_float(raw.x & 0xffff0000u), __uint_as_float(raw.y << 16), __uint_as_float(raw.y & 0xffff0000u)};
        const float mean = wave_sum((x[0] + x[1]) + (x[2] + x[3])) * (1.0f / 256.0f); float qq = 0.f;
#pragma unroll
        for (int j = 0; j < 4; ++j) { const float d = x[j] - mean; qq += d * d; }
        const float rstd = rsqrtf(wave_sum(qq) * (1.0f / 256.0f) + 1e-5f);
        const u32x2 gp = *(const u32x2*)(U + (size_t)row * NINP + U_GR + cc); const float gr[4] = {__uint_as_float(gp.x << 16), __uint_as_float(gp.x & 0xffff0000u), __uint_as_float(gp.y << 16), __uint_as_float(gp.y & 0xffff0000u)};
        const f32x4 gg = *(const f32x4*)(ng + cc), bb = *(const f32x4*)(nb + cc); float o[4];
#pragma unroll
        for (int j = 0; j < 4; ++j) o[j] = ((x[j] - mean) * rstd * gg[j] + bb[j]) * gr[j] * sigmoidf_(gr[j]);
        u32x2 ov; ov.x = pk2(o[0], o[1]); ov.y = pk2(o[2], o[3]); *(u32x2*)p = ov;
    }
}

__device__ __forceinline__ void unpack8(const u32x4 w, float (&x)[8]) {
    x[0] = __uint_as_float(w.x << 16); x[1] = __uint_as_float(w.x & 0xffff0000u); x[2] = __uint_as_float(w.y << 16); x[3] = __uint_as_float(w.y & 0xffff0000u);
    x[4] = __uint_as_float(w.z << 16); x[5] = __uint_as_float(w.z & 0xffff0000u); x[6] = __uint_as_float(w.w << 16); x[7] = __uint_as_float(w.w & 0xffff0000u);
}
template <bool ISBF> __device__ __forceinline__ void swa_step(const float (&q)[32], float (&acc)[32], float& m, float& l, const void* kp, const void* vp, float slope, float dist) {
    float s = 0.f;
#pragma unroll
    for (int j = 0; j < 4; ++j) { float x[8];
        if (ISBF) unpack8(*(const u32x4*)((const bf16_t*)kp + j * 8), x);
        else { const f32x4 a = *(const f32x4*)((const float*)kp + j * 8), b = *(const f32x4*)((const float*)kp + j * 8 + 4); x[0] = a[0]; x[1] = a[1]; x[2] = a[2]; x[3] = a[3]; x[4] = b[0]; x[5] = b[1]; x[6] = b[2]; x[7] = b[3]; }
#pragma unroll
        for (int d = 0; d < 8; ++d) s += q[j * 8 + d] * x[d]; }
    s += __shfl_xor(s, 1, 64);
    s = s * 0.125f - slope * dist;
    const float mn = fmaxf(m, s), cc = __expf(m - mn), p = __expf(s - mn);
    l = l * cc + p;
#pragma unroll
    for (int j = 0; j < 4; ++j) { float x[8];
        if (ISBF) unpack8(*(const u32x4*)((const bf16_t*)vp + j * 8), x);
        else { const f32x4 a = *(const f32x4*)((const float*)vp + j * 8), b = *(const f32x4*)((const float*)vp + j * 8 + 4); x[0] = a[0]; x[1] = a[1]; x[2] = a[2]; x[3] = a[3]; x[4] = b[0]; x[5] = b[1]; x[6] = b[2]; x[7] = b[3]; }
#pragma unroll
        for (int d = 0; d < 8; ++d) acc[j * 8 + d] = acc[j * 8 + d] * cc + p * x[d]; }
    m = mn;
}
__device__ __forceinline__ void ph_swa_naive(const Ctx& c, const bf16_t* __restrict__ U, const float* __restrict__ ck, const float* __restrict__ cv, const float* __restrict__ sinks, bf16_t* __restrict__ OB) {
    for (int gid = c.bid * 512 + c.tid; gid < MS * 32; gid += c.G * 512) {
        const int dh = gid & 1, h = (gid >> 1) & 15, row = MP + (gid >> 5), kvh = h >> 3, co = kvh * 64 + dh * 32;
        float q[32], acc[32];
#pragma unroll
        for (int j = 0; j < 4; ++j) { float x[8]; unpack8(*(const u32x4*)(U + (size_t)row * NINP + U_SQ + h * 64 + dh * 32 + j * 8), x);
#pragma unroll
            for (int d = 0; d < 8; ++d) { q[j * 8 + d] = x[d]; acc[j * 8 + d] = 0.f; } }
        const float slope = exp2f(-0.5f * (float)(h + 1)); float m = sinks[h], l = 1.0f;
        if (row < MP) {
            const int t = row % PS, base = row - t, lo = t - 128 < 0 ? 0 : t - 128;
            for (int s = lo; s <= t; ++s) { const bf16_t* ur = U + (size_t)(base + s) * NINP;
                swa_step<true>(q, acc, m, l, ur + U_SK + co, ur + U_SV + co, slope, (float)(t - s)); }
        } else {
            const int sq = (row - MP) / SS, i = (row - MP) % SS;
            for (int idx = i; idx <= 128 + i; ++idx) {
                if (idx < 128) { const size_t o = ((size_t)sq * 128 + idx) * 128 + co; swa_step<false>(q, acc, m, l, ck + o, cv + o, slope, (float)(128 + i - idx)); }
                else { const bf16_t* ur = U + (size_t)(MP + sq * SS + idx - 128) * NINP; swa_step<true>(q, acc, m, l, ur + U_SK + co, ur + U_SV + co, slope, (float)(128 + i - idx)); }
            }
        }
        const float inv = 1.0f / l; bf16_t* op = OB + (size_t)row * BW + h * 64 + dh * 32;
#pragma unroll
        for (int j = 0; j < 4; ++j) { u32x4 w; w.x = pk2(acc[j * 8] * inv, acc[j * 8 + 1] * inv); w.y = pk2(acc[j * 8 + 2] * inv, acc[j * 8 + 3] * inv);
            w.z = pk2(acc[j * 8 + 4] * inv, acc[j * 8 + 5] * inv); w.w = pk2(acc[j * 8 + 6] * inv, acc[j * 8 + 7] * inv); *(u32x4*)(op + j * 8) = w; }
    }
}

__device__ __forceinline__ void ph_rwkv_prep(const Ctx& c, const bf16_t* __restrict__ U, const float* __restrict__ shift, const float* __restrict__ mu, const float* __restrict__ w0, const float* __restrict__ w2,
                                             const float* __restrict__ a0, const float* __restrict__ a2, const float* __restrict__ g2, const float* __restrict__ k_k, const float* __restrict__ k_a,
                                             const float* __restrict__ r_k, float* __restrict__ RW) {
    LAS float* xm = (LAS float*)c.lds; LAS float* tw = xm + RWC; LAS float* ad = tw + 64; LAS float* sg = ad + 64;
    const int tid = c.tid;
    float* R = RW; float* WD = RW + (size_t)MPAD * BW; float* K2 = WD + (size_t)MPAD * BW; float* V = K2 + (size_t)MPAD * BW; float* KK = V + (size_t)MPAD * BW;
    float* BV = KK + (size_t)MPAD * BW; float* G = BV + (size_t)MPAD * BW; float* BON = G + (size_t)MPAD * BW;
    for (int row = c.bid; row < MT; row += c.G) {
        const bf16_t* ur = U + (size_t)row * NINP + U_RU; const bf16_t* pr = ur - NINP; const float* ps = nullptr; bool first;
        if (row < MP) first = (row % PS) == 0; else { first = ((row - MP) % SS) == 0; ps = shift + (size_t)((row - MP) / SS) * RWC; }
        for (int cc = tid; cc < RWC; cc += 512) { const float x = bf2f(ur[cc]); const float s = first ? (ps ? ps[cc] : 0.f) : bf2f(pr[cc]); xm[cc] = x + (s - x) * mu[cc]; }
        __syncthreads();
        if (tid < 64) { tw[tid] = tanhf(xm[3072 + tid]); ad[tid] = xm[3136 + tid]; }
        if (tid >= 128 && tid < 256) sg[tid - 128] = sigmoidf_(xm[3200 + tid - 128]);
        __syncthreads();
        for (int qd = 0; qd < 2; ++qd) {
            const int cc = qd * 512 + tid; float accw = w0[cc], acca = a0[cc], accg = 0.f;
#pragma unroll 4
            for (int j = 0; j < 64; ++j) { accw += tw[j] * w2[j * BW + cc]; acca += ad[j] * a2[j * BW + cc]; }
#pragma unroll 4
            for (int j = 0; j < 128; ++j) accg += sg[j] * g2[j * BW + cc];
            const float lw = -softplusf_(-accw) - 0.5f, decay = __expf(-__expf(lw)), a = sigmoidf_(acca);
            const float r = xm[cc], k = xm[1024 + cc], v = xm[2048 + cc];
            const float kkr = k * k_k[cc]; const float ss = wave_sum(kkr * kkr); const float kk = kkr / fmaxf(sqrtf(ss), 1e-12f);
            const float k2 = k * (1.0f + (a - 1.0f) * k_a[cc]); const float rk = wave_sum(r * k2 * r_k[cc]);
            const size_t o = (size_t)row * BW + cc;
            R[o] = r; WD[o] = decay; K2[o] = k2; V[o] = v; KK[o] = kk; BV[o] = kk * a; G[o] = accg; BON[o] = rk * v;
        }
        __syncthreads();
    }
}
__device__ __forceinline__ int kperm_pos(int k) { return (k & ~31) + 8 * ((k >> 2) & 3) + 4 * ((k >> 4) & 1) + (k & 3); }
__device__ __forceinline__ void ph_swa_prompt(const Ctx& c, const bf16_t* __restrict__ U, const float* __restrict__ sinks, bf16_t* __restrict__ OB) {
    LAS bf16_t* K_l = (LAS bf16_t*)c.lds;
    LAS bf16_t* VT_l = K_l + 192 * 72;
    const int tid = c.tid, lane = c.lane, r = lane & 15, q = lane >> 4, w = c.wave;
    for (int u = c.bid; u < PB * 64 * 2; u += c.G) {
        const int b = u >> 7, qb = (u >> 1) & 63, kvh = u & 1, h = kvh * 8 + w;
        const int tok0 = qb * 64 - 128;
        const size_t seq0 = (size_t)b * PS;
        for (int idx = tid; idx < 192 * 8; idx += 512) { const int kl = idx >> 3, c8 = idx & 7, tk = tok0 + kl; u32x4 kv = (u32x4){0u, 0u, 0u, 0u}, vv = kv;
            if (tk >= 0) { const bf16_t* ur = U + (seq0 + tk) * NINP; kv = *(const u32x4*)(ur + U_SK + kvh * 64 + c8 * 8); vv = *(const u32x4*)(ur + U_SV + kvh * 64 + c8 * 8); }
            *(LAS u32x4*)(K_l + kl * 72 + c8 * 8) = kv;
            const int kp = kperm_pos(kl); LAS bf16_t* vp = VT_l + (c8 * 8) * 200 + kp;
            vp[0] = (bf16_t)(vv.x & 0xffffu); vp[200] = (bf16_t)(vv.x >> 16); vp[400] = (bf16_t)(vv.y & 0xffffu); vp[600] = (bf16_t)(vv.y >> 16);
            vp[800] = (bf16_t)(vv.z & 0xffffu); vp[1000] = (bf16_t)(vv.z >> 16); vp[1200] = (bf16_t)(vv.w & 0xffffu); vp[1400] = (bf16_t)(vv.w >> 16); }
        __syncthreads();
        const float slope = exp2f(-0.5f * (float)(h + 1)), sink = sinks[h];
#pragma unroll 1
        for (int i = 0; i < 4; ++i) {
            const size_t qrow = seq0 + qb * 64 + i * 16 + r;
            const bf16x8 qf0 = *(const bf16x8*)(U + qrow * NINP + U_SQ + h * 64 + q * 8), qf1 = *(const bf16x8*)(U + qrow * NINP + U_SQ + h * 64 + 32 + q * 8);
            const int kt0 = i & ~1;
            f32x4 s[10]; float mx = sink;
#pragma unroll
            for (int kt = 0; kt < 10; ++kt) { const LAS bf16_t* kp = K_l + ((kt0 + kt) * 16 + r) * 72 + q * 8;
                f32x4 d = mma16(*(const LAS bf16x8*)kp, qf0, (f32x4){0.f, 0.f, 0.f, 0.f}); d = mma16(*(const LAS bf16x8*)(kp + 32), qf1, d);
#pragma unroll
                for (int jj = 0; jj < 4; ++jj) { const int kl = (kt0 + kt) * 16 + q * 4 + jj, dist = i * 16 + r + 128 - kl;
                    const float v = (dist >= 0 && dist <= 128 && tok0 + kl >= 0) ? d[jj] * 0.125f - slope * (float)dist : -1e30f; d[jj] = v; mx = fmaxf(mx, v); }
                s[kt] = d; }
            mx = fmaxf(mx, __shfl_xor(mx, 16, 64)); mx = fmaxf(mx, __shfl_xor(mx, 32, 64));
            float sum = 0.f; bf16x8 pf[5];
#pragma unroll
            for (int kp = 0; kp < 5; ++kp) { f32x4 a = s[2 * kp], bq = s[2 * kp + 1];
#pragma unroll
                for (int jj = 0; jj < 4; ++jj) { a[jj] = __expf(a[jj] - mx); bq[jj] = __expf(bq[jj] - mx); sum += a[jj] + bq[jj]; }
                pf[kp] = pack_acc(a, bq); }
            sum += __shfl_xor(sum, 16, 64); sum += __shfl_xor(sum, 32, 64);
            const float inv = 1.0f / (sum + __expf(sink - mx));
            bf16_t* op = OB + qrow * BW + h * 64 + q * 4;
#pragma unroll
            for (int dt = 0; dt < 4; ++dt) { f32x4 o = (f32x4){0.f, 0.f, 0.f, 0.f};
#pragma unroll
                for (int kp = 0; kp < 5; ++kp) o = mma16(*(const LAS bf16x8*)(VT_l + (dt * 16 + r) * 200 + (kt0 + 2 * kp) * 16 + q * 8), pf[kp], o);
                u32x2 ov; ov.x = pk2(o[0] * inv, o[1] * inv); ov.y = pk2(o[2] * inv, o[3] * inv); *(u32x2*)(op + dt * 16) = ov; }
        }
        __syncthreads();
    }
}

__device__ __forceinline__ void ph_swa_sample(const Ctx& c, const bf16_t* __restrict__ U, const float* __restrict__ ck, const float* __restrict__ cv, const float* __restrict__ sinks, bf16_t* __restrict__ OB) {
    LAS bf16_t* K_l = (LAS bf16_t*)c.lds;
    LAS bf16_t* VT_l = K_l + 160 * 72;
    const int tid = c.tid, lane = c.lane, r = lane & 15, q = lane >> 4, w = c.wave;
    for (int u = c.bid; u < SB * 2; u += c.G) {
        const int sq = u >> 1, kvh = u & 1;
        for (int idx = tid; idx < 160 * 8; idx += 512) { const int kl = idx >> 3, c8 = idx & 7; float kx[8], vx[8];
#pragma unroll
            for (int e = 0; e < 8; ++e) { kx[e] = 0.f; vx[e] = 0.f; }
            if (kl < 128) { const size_t o = ((size_t)sq * 128 + kl) * 128 + kvh * 64 + c8 * 8; const f32x4 a = *(const f32x4*)(ck + o), b2 = *(const f32x4*)(ck + o + 4), c2 = *(const f32x4*)(cv + o), d2 = *(const f32x4*)(cv + o + 4);
                kx[0] = a[0]; kx[1] = a[1]; kx[2] = a[2]; kx[3] = a[3]; kx[4] = b2[0]; kx[5] = b2[1]; kx[6] = b2[2]; kx[7] = b2[3];
                vx[0] = c2[0]; vx[1] = c2[1]; vx[2] = c2[2]; vx[3] = c2[3]; vx[4] = d2[0]; vx[5] = d2[1]; vx[6] = d2[2]; vx[7] = d2[3]; }
            else if (kl < 132) { const bf16_t* ur = U + (size_t)(MP + sq * SS + kl - 128) * NINP; unpack8(*(const u32x4*)(ur + U_SK + kvh * 64 + c8 * 8), kx); unpack8(*(const u32x4*)(ur + U_SV + kvh * 64 + c8 * 8), vx); }
            *(LAS u32x4*)(K_l + kl * 72 + c8 * 8) = (u32x4){pk2(kx[0], kx[1]), pk2(kx[2], kx[3]), pk2(kx[4], kx[5]), pk2(kx[6], kx[7])};
            LAS bf16_t* vp = VT_l + (c8 * 8) * 168 + kperm_pos(kl);
#pragma unroll
            for (int e = 0; e < 8; ++e) vp[e * 168] = f2bf(vx[e]); }
        __syncthreads();
        if (w < 2) {
            const int h = kvh * 8 + w * 4 + (r >> 2), tk = r & 3; const size_t qrow = (size_t)(MP + sq * SS + tk);
            const float slope = exp2f(-0.5f * (float)(h + 1)), sink = sinks[h];
            const bf16x8 qf0 = *(const bf16x8*)(U + qrow * NINP + U_SQ + h * 64 + q * 8), qf1 = *(const bf16x8*)(U + qrow * NINP + U_SQ + h * 64 + 32 + q * 8);
            f32x4 s[10]; float mx = sink;
#pragma unroll
            for (int kt = 0; kt < 10; ++kt) { const LAS bf16_t* kp = K_l + (kt * 16 + r) * 72 + q * 8;
                f32x4 d = mma16(*(const LAS bf16x8*)kp, qf0, (f32x4){0.f, 0.f, 0.f, 0.f}); d = mma16(*(const LAS bf16x8*)(kp + 32), qf1, d);
#pragma unroll
                for (int jj = 0; jj < 4; ++jj) { const int kl = kt * 16 + q * 4 + jj, dist = 128 + tk - kl;
                    const float v = (dist >= 0 && dist <= 128) ? d[jj] * 0.125f - slope * (float)dist : -1e30f; d[jj] = v; mx = fmaxf(mx, v); }
                s[kt] = d; }
            mx = fmaxf(mx, __shfl_xor(mx, 16, 64)); mx = fmaxf(mx, __shfl_xor(mx, 32, 64));
            float sum = 0.f; bf16x8 pf[5];
#pragma unroll
            for (int kp = 0; kp < 5; ++kp) { f32x4 a = s[2 * kp], bq = s[2 * kp + 1];
#pragma unroll
                for (int jj = 0; jj < 4; ++jj) { a[jj] = __expf(a[jj] - mx); bq[jj] = __expf(bq[jj] - mx); sum += a[jj] + bq[jj]; }
                pf[kp] = pack_acc(a, bq); }
            sum += __shfl_xor(sum, 16, 64); sum += __shfl_xor(sum, 32, 64);
            const float inv = 1.0f / (sum + __expf(sink - mx));
            bf16_t* op = OB + qrow * BW + h * 64 + q * 4;
#pragma unroll
            for (int dt = 0; dt < 4; ++dt) { f32x4 o = (f32x4){0.f, 0.f, 0.f, 0.f};
#pragma unroll
                for (int kp = 0; kp < 5; ++kp) o = mma16(*(const LAS bf16x8*)(VT_l + (dt * 16 + r) * 168 + kp * 32 + q * 8), pf[kp], o);
                u32x2 ov; ov.x = pk2(o[0] * inv, o[1] * inv); ov.y = pk2(o[2] * inv, o[3] * inv); *(u32x2*)(op + dt * 16) = ov; }
        }
        __syncthreads();
    }
}

__device__ __forceinline__ void ph_lrw(const Ctx& c, const float* __restrict__ w2, const float* __restrict__ a2, const float* __restrict__ g2, bf16_t* __restrict__ LRW) {
    for (int idx = c.bid * 512 + c.tid; idx < NL * 256 * 1024; idx += c.G * 512) {
        const int ch = idx & 1023, j = (idx >> 10) & 255, l = idx >> 18;
        const float v = j < 64 ? w2[((size_t)l * 64 + j) * BW + ch] : (j < 128 ? a2[((size_t)l * 64 + j - 64) * BW + ch] : g2[((size_t)l * 128 + j - 128) * BW + ch]);
        LRW[((size_t)l * 1024 + ch) * 256 + j] = f2bf(v);
    }
}
constexpr int RWP_UNITS = (MP / 64) * 16 + SB * 16;
__device__ __forceinline__ void rwp_unit_info(int u, int& row0, int& ntok, int& h, int& sq, bool& seq_first) {
    if (u < (MP / 64) * 16) { const int blk = u >> 4; h = u & 15; row0 = blk * 64; ntok = 64; sq = -1; seq_first = (row0 % PS) == 0; }
    else { const int s = u - (MP / 64) * 16; sq = s >> 4; h = s & 15; row0 = MP + sq * SS; ntok = SS; seq_first = true; }
}
__device__ __forceinline__ void ph_rwkv_pre(const Ctx& c, const bf16_t* __restrict__ U, const float* __restrict__ shift, const float* __restrict__ mu, const float* __restrict__ w0, const float* __restrict__ w2,
                                            const float* __restrict__ a0, const float* __restrict__ a2, const float* __restrict__ g2, const float* __restrict__ k_k, const float* __restrict__ k_a,
                                            const float* __restrict__ r_k, float* __restrict__ RW, bf16_t* __restrict__ RB, const bf16_t* __restrict__ LRW) {
    LAS bf16_t* P_l = (LAS bf16_t*)c.lds; LAS bf16_t* Kn_l = P_l + 4608; LAS bf16_t* Bn_l = Kn_l + 4608; LAS bf16_t* Q_l = Bn_l + 4608;
    LAS bf16_t* PT_l = Q_l + 4608; LAS bf16_t* BhT_l = PT_l + 4608; LAS bf16_t* KhT_l = BhT_l + 4608; LAS bf16_t* VT_l = KhT_l + 4608;
    LAS float* A_l = (LAS float*)(c.lds + 73728);
    LAS bf16_t* BmT_l = (LAS bf16_t*)(c.lds + 78848); LAS bf16_t* F_l = (LAS bf16_t*)(c.lds + 81920); LAS bf16_t* Tinv_l = (LAS bf16_t*)(c.lds + 84992);
    LAS bf16_t* PpT_l = (LAS bf16_t*)(c.lds + 88064);
    LAS bf16_t* BmpT_l = (LAS bf16_t*)(c.lds + 97280);
    LAS float* GC_l = (LAS float*)(c.lds + 100352);
    LAS float* lg_l = (LAS float*)(c.lds + 125952);
    LAS bf16_t* act_l = (LAS bf16_t*)c.lds;
    LAS bf16_t* wT_l = act_l + 64 * 264;
    LAS bf16_t* aT_l = wT_l + 64 * 72;
    LAS bf16_t* gT_l = aT_l + 64 * 72;
    LAS float* pre_l = (LAS float*)(c.lds + 73728);
    const int tid = c.tid, lane = c.lane, r = lane & 15, q = lane >> 4, w = c.wave;
    float* Gg = RW + 6 * (size_t)MPAD * BW; float* BON = RW + 7 * (size_t)MPAD * BW;
    for (int u = c.bid; u < RWP_UNITS; u += c.G) {
        int row0, ntok, h, sq; bool seq_first; rwp_unit_info(u, row0, ntok, h, sq, seq_first);
        const float* sh = sq >= 0 ? shift + (size_t)sq * RWC : nullptr;
        const int nstage = ntok == 64 ? 64 : 16;
        for (int idx = tid; idx < nstage * 32; idx += 512) {
            const int t = idx >> 5, c8 = idx & 31, cc = 3072 + c8 * 8; float val[8];
#pragma unroll
            for (int e2 = 0; e2 < 8; ++e2) val[e2] = 0.f;
            if (t < ntok) { const bf16_t* ur = U + (size_t)(row0 + t) * NINP + U_RU; float x[8], p[8];
                unpack8(*(const u32x4*)(ur + cc), x);
                if (!(t == 0 && seq_first)) unpack8(*(const u32x4*)(ur + cc - NINP), p);
                else if (sh) { const f32x4 s0v = *(const f32x4*)(sh + cc), s1v = *(const f32x4*)(sh + cc + 4); p[0] = s0v[0]; p[1] = s0v[1]; p[2] = s0v[2]; p[3] = s0v[3]; p[4] = s1v[0]; p[5] = s1v[1]; p[6] = s1v[2]; p[7] = s1v[3]; }
                else {
#pragma unroll
                    for (int e2 = 0; e2 < 8; ++e2) p[e2] = 0.f; }
                const f32x4 m0 = *(const f32x4*)(mu + cc), m1 = *(const f32x4*)(mu + cc + 4);
#pragma unroll
                for (int e2 = 0; e2 < 8; ++e2) { const float xm = x[e2] + (p[e2] - x[e2]) * (e2 < 4 ? m0[e2] : m1[e2 - 4]); val[e2] = c8 < 8 ? tanh_fast(xm) : (c8 < 16 ? xm : sigmoidf_(xm)); } }
            *(LAS u32x4*)(act_l + t * 264 + c8 * 8) = (u32x4){pk2(val[0], val[1]), pk2(val[2], val[3]), pk2(val[4], val[5]), pk2(val[6], val[7])};
        }
        __syncthreads();
        { const int tb = w & 3, chf = w >> 2;
          if (tb * 16 < nstage) { bf16x8 af[8];
#pragma unroll
            for (int ks = 0; ks < 8; ++ks) af[ks] = *(const LAS bf16x8*)(act_l + (tb * 16 + r) * 264 + ks * 32 + q * 8);
#pragma unroll
            for (int e2 = 0; e2 < 2; ++e2) { const int cb = chf * 2 + e2; f32x4 dw = (f32x4){0.f, 0.f, 0.f, 0.f}, da = dw, dg = dw;
                const bf16_t* wr = LRW + ((size_t)h * 64 + cb * 16 + r) * 256 + q * 8;
#pragma unroll
                for (int ks = 0; ks < 2; ++ks) { dw = mma16(*(const bf16x8*)(wr + ks * 32), af[ks], dw); da = mma16(*(const bf16x8*)(wr + 64 + ks * 32), af[2 + ks], da); }
#pragma unroll
                for (int ks = 0; ks < 4; ++ks) dg = mma16(*(const bf16x8*)(wr + 128 + ks * 32), af[4 + ks], dg);
                const int o = (tb * 16 + r) * 68 + cb * 16 + q * 4;
                *(LAS f32x4*)(pre_l + o) = dw; *(LAS f32x4*)(pre_l + 64 * 68 + o) = da; *(LAS f32x4*)(pre_l + 2 * 64 * 68 + o) = dg; } } }
        __syncthreads();
        const int t = tid >> 3, cg = tid & 7, c0 = h * 64 + cg * 8, sc = t >> 4;
        float rr[8], k2[8], kap[8], bet[8], nlw[8];
        { float vx[8], gg[8], kkr[8]; float ss = 0.f, rk = 0.f;
          if (t < ntok) {
            const size_t row = (size_t)(row0 + t); const bf16_t* ur = U + row * NINP + U_RU; const bool fst = (t == 0 && seq_first);
            float kx[8];
#pragma unroll
            for (int part = 0; part < 3; ++part) { const int cc = part * 1024 + c0; float x[8], p[8];
                unpack8(*(const u32x4*)(ur + cc), x);
                if (!fst) unpack8(*(const u32x4*)(ur + cc - NINP), p);
                else {
#pragma unroll
                    for (int j = 0; j < 8; ++j) p[j] = sh ? sh[cc + j] : 0.f; }
                const f32x4 mA = *(const f32x4*)(mu + cc), mB = *(const f32x4*)(mu + cc + 4);
#pragma unroll
                for (int j = 0; j < 8; ++j) { const float xm = x[j] + (p[j] - x[j]) * (j < 4 ? mA[j] : mB[j - 4]); if (part == 0) rr[j] = xm; else if (part == 1) kx[j] = xm; else vx[j] = xm; } }
            float pw[8], pa[8], pkk[8], pka[8], prk[8];
#pragma unroll
            for (int hf = 0; hf < 2; ++hf) { const f32x4 v0 = *(const f32x4*)(w0 + c0 + hf * 4), v1 = *(const f32x4*)(a0 + c0 + hf * 4), v2 = *(const f32x4*)(k_k + c0 + hf * 4), v3 = *(const f32x4*)(k_a + c0 + hf * 4), v4 = *(const f32x4*)(r_k + c0 + hf * 4);
#pragma unroll
                for (int j = 0; j < 4; ++j) { pw[hf * 4 + j] = v0[j]; pa[hf * 4 + j] = v1[j]; pkk[hf * 4 + j] = v2[j]; pka[hf * 4 + j] = v3[j]; prk[hf * 4 + j] = v4[j]; } }
            float lwp[8], app[8];
#pragma unroll
            for (int hf = 0; hf < 2; ++hf) { const f32x4 v0 = *(const LAS f32x4*)(pre_l + t * 68 + cg * 8 + hf * 4), v1 = *(const LAS f32x4*)(pre_l + 64 * 68 + t * 68 + cg * 8 + hf * 4), v2 = *(const LAS f32x4*)(pre_l + 2 * 64 * 68 + t * 68 + cg * 8 + hf * 4);
#pragma unroll
                for (int j = 0; j < 4; ++j) { lwp[hf * 4 + j] = v0[j]; app[hf * 4 + j] = v1[j]; gg[hf * 4 + j] = v2[j]; } }
#pragma unroll
            for (int j = 0; j < 8; ++j) {
                const float lw = -softplus_fast(-(pw[j] + lwp[j])) - 0.5f; nlw[j] = -__expf(lw); const float av = sigmoidf_(pa[j] + app[j]);
                kkr[j] = kx[j] * pkk[j]; ss += kkr[j] * kkr[j]; k2[j] = kx[j] * (1.0f + (av - 1.0f) * pka[j]); rk += rr[j] * k2[j] * prk[j]; bet[j] = av; }
          } else {
#pragma unroll
            for (int j = 0; j < 8; ++j) { rr[j] = 0.f; k2[j] = 0.f; kkr[j] = 0.f; bet[j] = 0.f; nlw[j] = 0.f; vx[j] = 0.f; gg[j] = 0.f; }
          }
          ss += __shfl_xor(ss, 1, 64); ss += __shfl_xor(ss, 2, 64); ss += __shfl_xor(ss, 4, 64);
          rk += __shfl_xor(rk, 1, 64); rk += __shfl_xor(rk, 2, 64); rk += __shfl_xor(rk, 4, 64);
          const float inv = 1.0f / fmaxf(sqrtf(ss), 1e-12f);
#pragma unroll
          for (int j = 0; j < 8; ++j) { kap[j] = kkr[j] * inv; bet[j] = kap[j] * bet[j]; }
          if (t < ntok) { const size_t o = (size_t)(row0 + t) * BW + c0;
              *(f32x4*)(Gg + o) = (f32x4){gg[0], gg[1], gg[2], gg[3]}; *(f32x4*)(Gg + o + 4) = (f32x4){gg[4], gg[5], gg[6], gg[7]};
              *(f32x4*)(BON + o) = (f32x4){rk * vx[0], rk * vx[1], rk * vx[2], rk * vx[3]}; *(f32x4*)(BON + o + 4) = (f32x4){rk * vx[4], rk * vx[5], rk * vx[6], rk * vx[7]}; }
          *(LAS f32x4*)(lg_l + t * 68 + cg * 8) = (f32x4){nlw[0], nlw[1], nlw[2], nlw[3]}; *(LAS f32x4*)(lg_l + t * 68 + cg * 8 + 4) = (f32x4){nlw[4], nlw[5], nlw[6], nlw[7]};
#pragma unroll
          for (int j = 0; j < 8; ++j) VT_l[(cg * 8 + j) * 72 + t] = f2bf(vx[j]);
        }
        __syncthreads();
        if (tid < 256) { const int cc = tid & 63, s4 = tid >> 6; float run = 0.f;
#pragma unroll
            for (int i = 0; i < 16; ++i) { const int o = (s4 * 16 + i) * 68 + cc; run += lg_l[o]; lg_l[o] = run; } }
        __syncthreads();
        { unsigned pp[4], pq[4], pk[4], pb[4];
#pragma unroll
          for (int j = 0; j < 8; j += 2) { float vP[2], vQ[2], vK[2], vB[2];
#pragma unroll
              for (int e = 0; e < 2; ++e) { const int jj = j + e, cc = cg * 8 + jj; const float ci = lg_l[t * 68 + cc], cC = lg_l[(sc * 16 + 15) * 68 + cc];
                  const float ei = __expf(-ci), eh = __expf(cC - ci);
                  vP[e] = kap[jj] * __expf(ci - nlw[jj]); vQ[e] = rr[jj] * __expf(ci); vK[e] = k2[jj] * ei; vB[e] = bet[jj] * ei;
                  PT_l[cc * 72 + t] = f2bf(vP[e]); BhT_l[cc * 72 + t] = f2bf(bet[jj] * eh); KhT_l[cc * 72 + t] = f2bf(k2[jj] * eh); }
              pp[j >> 1] = pk2(vP[0], vP[1]); pq[j >> 1] = pk2(vQ[0], vQ[1]); pk[j >> 1] = pk2(vK[0], vK[1]); pb[j >> 1] = pk2(vB[0], vB[1]); }
          const int o = t * 72 + cg * 8;
          *(LAS u32x4*)(P_l + o) = (u32x4){pp[0], pp[1], pp[2], pp[3]}; *(LAS u32x4*)(Q_l + o) = (u32x4){pq[0], pq[1], pq[2], pq[3]};
          *(LAS u32x4*)(Kn_l + o) = (u32x4){pk[0], pk[1], pk[2], pk[3]}; *(LAS u32x4*)(Bn_l + o) = (u32x4){pb[0], pb[1], pb[2], pb[3]};
          if ((t & 15) == 15) {
#pragma unroll
              for (int j = 0; j < 8; ++j) GC_l[sc * 64 + cg * 8 + j] = __expf(lg_l[t * 68 + cg * 8 + j]); } }
        __syncthreads();
        const int nsub = ntok == 64 ? 4 : 1;
        const bf16x8 zfrag = (bf16x8){0, 0, 0, 0, 0, 0, 0, 0};
        for (int id = w; id < nsub * 3; id += 8) { const int s4 = id / 3, prod = id - s4 * 3; f32x4 d = (f32x4){0.f, 0.f, 0.f, 0.f};
            const LAS bf16_t* X = (prod == 1 ? P_l : Bn_l) + (s4 * 16 + r) * 72 + q * 8; const LAS bf16_t* Y = (prod == 0 ? P_l : (prod == 1 ? Kn_l : Q_l)) + (s4 * 16 + r) * 72 + q * 8;
#pragma unroll
            for (int ks = 0; ks < 2; ++ks) d = mma16(*(const LAS bf16x8*)(X + ks * 32), *(const LAS bf16x8*)(Y + ks * 32), d);
            if (prod == 0) { f32x4 o4;
#pragma unroll
                for (int jj = 0; jj < 4; ++jj) o4[jj] = (q * 4 + jj < r) ? d[jj] : 0.f;
                *(LAS f32x4*)(A_l + s4 * 320 + r * 20 + q * 4) = o4; }
            else { float o4[4];
#pragma unroll
                for (int jj = 0; jj < 4; ++jj) o4[jj] = (prod == 1 ? (r < q * 4 + jj) : (q * 4 + jj <= r)) ? d[jj] : 0.f;
                u32x2 o; o.x = pk2(o4[0], o4[1]); o.y = pk2(o4[2], o4[3]); *(LAS u32x2*)((prod == 1 ? BmT_l : F_l) + s4 * 384 + r * 24 + q * 4) = o; } }
        __syncthreads();
        if (w == 0 && (lane >> 4) < nsub) { const int s4 = lane >> 4, jc = lane & 15; float x[16];
#pragma unroll
            for (int tt = 0; tt < 16; ++tt) { float s = (tt == jc) ? 1.f : 0.f;
#pragma unroll
                for (int i = 0; i < tt; ++i) s -= A_l[s4 * 320 + tt * 20 + i] * x[i];
                x[tt] = s; }
#pragma unroll
            for (int tt = 0; tt < 16; ++tt) Tinv_l[s4 * 384 + tt * 24 + jc] = f2bf(x[tt]); }
        __syncthreads();
        for (int id = w; id < nsub * 5; id += 8) { const int s4 = id / 5, rem = id - s4 * 5;
            const bf16x8 xf = q < 2 ? *(const LAS bf16x8*)(Tinv_l + s4 * 384 + r * 24 + q * 8) : zfrag;
            const bf16x8 yf = q < 2 ? (rem < 4 ? *(const LAS bf16x8*)(PT_l + (rem * 16 + r) * 72 + s4 * 16 + q * 8) : *(const LAS bf16x8*)(BmT_l + s4 * 384 + r * 24 + q * 8)) : zfrag;
            const f32x4 d = mma16(xf, yf, (f32x4){0.f, 0.f, 0.f, 0.f});
            u32x2 o; o.x = pk2(d[0], d[1]); o.y = pk2(d[2], d[3]);
            if (rem < 4) *(LAS u32x2*)(PpT_l + (rem * 16 + r) * 72 + s4 * 16 + q * 4) = o; else *(LAS u32x2*)(BmpT_l + s4 * 384 + r * 24 + q * 4) = o; }
        __syncthreads();
        { const int chunk0 = sq >= 0 ? PB * 16 * 256 + sq * 16 + h : ((row0 / PS) * 16 + h) * 256 + ((row0 % PS) >> 4);
          for (int id = w; id < nsub * 25; id += 8) { const int s4 = id / 25, rem = id - s4 * 25; bf16_t* blob = RB + (size_t)(chunk0 + s4) * RB_EL;
            const bf16x8 fF = q < 2 ? *(const LAS bf16x8*)(F_l + s4 * 384 + r * 24 + q * 8) : zfrag;
            if (rem < 4) {
                const bf16x8 xf = q < 2 ? *(const LAS bf16x8*)(PpT_l + (rem * 16 + r) * 72 + s4 * 16 + q * 8) : zfrag;
                const f32x4 d = mma16(xf, fF, (f32x4){0.f, 0.f, 0.f, 0.f});
                const u32x2 qv = *(const LAS u32x2*)(Q_l + (s4 * 16 + r) * 72 + rem * 16 + q * 4);
                u32x2 o; o.x = pk2(__uint_as_float(qv.x << 16) - d[0], __uint_as_float(qv.x & 0xffff0000u) - d[1]); o.y = pk2(__uint_as_float(qv.y << 16) - d[2], __uint_as_float(qv.y & 0xffff0000u) - d[3]);
                *(u32x2*)(blob + RB_QP + r * 72 + 32 * (rem >> 1) + 8 * q + 4 * (rem & 1)) = o;
            } else if (rem == 4) {
                f32x4 d2 = (f32x4){0.f, 0.f, 0.f, 0.f};
#pragma unroll
                for (int ks = 0; ks < 2; ++ks) d2 = mma16(*(const LAS bf16x8*)(Kn_l + (s4 * 16 + r) * 72 + ks * 32 + q * 8), *(const LAS bf16x8*)(Q_l + (s4 * 16 + r) * 72 + ks * 32 + q * 8), d2);
                const bf16x8 xf = q < 2 ? *(const LAS bf16x8*)(BmpT_l + s4 * 384 + r * 24 + q * 8) : zfrag;
                const f32x4 d1 = mma16(xf, fF, (f32x4){0.f, 0.f, 0.f, 0.f});
                float o4[4];
#pragma unroll
                for (int jj = 0; jj < 4; ++jj) o4[jj] = ((q * 4 + jj <= r) ? d2[jj] : 0.f) - d1[jj];
                u32x2 o; o.x = pk2(o4[0], o4[1]); o.y = pk2(o4[2], o4[3]); *(u32x2*)(blob + RB_EP + r * 24 + q * 4) = o;
            } else if (rem < 21) {
                const int cib = (rem - 5) >> 2, cob = (rem - 5) & 3;
                const bf16x8 xf = q < 2 ? *(const LAS bf16x8*)(PpT_l + (cib * 16 + r) * 72 + s4 * 16 + q * 8) : zfrag;
                const bf16x8 yf = q < 2 ? *(const LAS bf16x8*)(BhT_l + (cob * 16 + r) * 72 + s4 * 16 + q * 8) : zfrag;
                const f32x4 d = mma16(xf, yf, (f32x4){0.f, 0.f, 0.f, 0.f});
                const float gc = GC_l[s4 * 64 + cob * 16 + r]; float o4[4];
#pragma unroll
                for (int jj = 0; jj < 4; ++jj) o4[jj] = ((cib == cob && q * 4 + jj == r) ? gc : 0.f) - d[jj];
                u32x2 o; o.x = pk2(o4[0], o4[1]); o.y = pk2(o4[2], o4[3]); *(u32x2*)(blob + (cob * 16 + r) * 72 + 32 * (cib >> 1) + 8 * q + 4 * (cib & 1)) = o;
            } else {
                const int cb = rem - 21;
                const bf16x8 xf = q < 2 ? *(const LAS bf16x8*)(BmpT_l + s4 * 384 + r * 24 + q * 8) : zfrag;
                const bf16x8 yf = q < 2 ? *(const LAS bf16x8*)(BhT_l + (cb * 16 + r) * 72 + s4 * 16 + q * 8) : zfrag;
                const f32x4 d = mma16(xf, yf, (f32x4){0.f, 0.f, 0.f, 0.f});
                const u32x2 kv = *(const LAS u32x2*)(KhT_l + (cb * 16 + r) * 72 + s4 * 16 + q * 4);
                u32x2 o; o.x = pk2(__uint_as_float(kv.x << 16) - d[0], __uint_as_float(kv.x & 0xffff0000u) - d[1]); o.y = pk2(__uint_as_float(kv.y << 16) - d[2], __uint_as_float(kv.y & 0xffff0000u) - d[3]);
                *(u32x2*)(blob + RB_KHP + (cb * 16 + r) * 24 + q * 4) = o;
            } }
          for (int idx = tid; idx < nsub * 128; idx += 512) { const int s4 = idx >> 7, cc = (idx >> 1) & 63, hf = idx & 1;
              *(u32x4*)(RB + (size_t)(chunk0 + s4) * RB_EL + RB_VT + cc * 24 + hf * 8) = *(const LAS u32x4*)(VT_l + cc * 72 + s4 * 16 + hf * 8); } }
        __syncthreads();
    }
}

__device__ __forceinline__ void ph_rwkv_scan_naive(const Ctx& c, const float* __restrict__ RW, const float* __restrict__ s0, const float* __restrict__ lng, const float* __restrict__ lnb, bf16_t* __restrict__ OB,
                                                   float* __restrict__ outP, float* __restrict__ outS) {
    const float* R = RW; const float* WD = RW + (size_t)MPAD * BW; const float* K2 = WD + (size_t)MPAD * BW; const float* V = K2 + (size_t)MPAD * BW; const float* KK = V + (size_t)MPAD * BW;
    const float* BV = KK + (size_t)MPAD * BW; const float* G = BV + (size_t)MPAD * BW; const float* BON = G + (size_t)MPAD * BW;
    const int lane = c.lane;
    for (int it = 0;; ++it) {
        const int u = (it * 8 + c.wave) * c.G + c.bid;
        if (u >= (PB + SB) * 16) break;
        const int sq = u >> 4, h = u & 15;
        int row0, L; seq_info(sq, row0, L);
        float S[64];
        if (sq >= PB) { const float* p = s0 + (((size_t)(sq - PB) * 16 + h) * 64 + lane) * 64;
#pragma unroll
            for (int j = 0; j < 64; ++j) S[j] = p[j]; }
        else {
#pragma unroll
            for (int j = 0; j < 64; ++j) S[j] = 0.f; }
        const float lg = lng[h * 64 + lane], lb = lnb[h * 64 + lane];
        for (int t = 0; t < L; ++t) {
            const size_t base = (size_t)(row0 + t) * BW + h * 64; const float v = V[base + lane];
            float d = 0.f;
#pragma unroll
            for (int j = 0; j < 64; ++j) d += S[j] * KK[base + j];
            float y = 0.f;
#pragma unroll
            for (int j = 0; j < 64; ++j) { S[j] = S[j] * WD[base + j] - d * BV[base + j] + v * K2[base + j]; y += S[j] * R[base + j]; }
            const float mean = wave_sum(y) * (1.0f / 64.0f), dy = y - mean, var = wave_sum(dy * dy) * (1.0f / 64.0f);
            const float yn = dy * rsqrtf(var + 64e-5f) * lg + lb;
            OB[base + lane] = f2bf((yn + BON[base + lane]) * G[base + lane]);
        }
        float* op = (sq < PB ? outP + (((size_t)sq * 16 + h) * 64 + lane) * 64 : outS + (((size_t)(sq - PB) * 16 + h) * 64 + lane) * 64);
#pragma unroll
        for (int j = 0; j < 64; ++j) op[j] = S[j];
    }
}
__device__ __forceinline__ void ph_rwkv_scan2(const Ctx& c, int boff, const float* __restrict__ RW, const float* __restrict__ s0, const float* __restrict__ lng, const float* __restrict__ lnb, bf16_t* __restrict__ OB,
                                              float* __restrict__ outP, float* __restrict__ outS) {
    LAS float* opb = (LAS float*)c.lds;
    LAS float* yb = opb + 2 * 16 * 384;
    const int tid = c.tid, lane = c.lane, w = c.wave, rl = lane >> 3, cg = lane & 7, vrow = w * 8 + rl;
    const float* G = RW + 6 * (size_t)MPAD * BW; const float* BON = RW + 7 * (size_t)MPAD * BW;
    for (int u = (c.bid - boff + c.G) % c.G; u < (PB + SB) * 16; u += c.G) {
        const int sq = u >> 4, h = u & 15;
        int row0, L; seq_info(sq, row0, L);
        float S[8];
        if (sq >= PB) { const float* p = s0 + (((size_t)(sq - PB) * 16 + h) * 64 + vrow) * 64 + cg * 8;
#pragma unroll
            for (int j = 0; j < 8; ++j) S[j] = p[j]; }
        else {
#pragma unroll
            for (int j = 0; j < 8; ++j) S[j] = 0.f; }
        const float lg = lng[h * 64 + lane], lb = lnb[h * 64 + lane];
        const int nb = (L + 15) >> 4;
#define RW_STAGE(bi_) do { const int t0_ = (bi_) * 16, nT_ = (L - t0_) < 16 ? (L - t0_) : 16; LAS float* dst_ = opb + ((bi_) & 1) * 16 * 384; \
        for (int idx = tid; idx < nT_ * 96; idx += 512) { const int t = idx / 96, rem = idx - t * 96, slot = rem >> 4, c4 = rem & 15; \
            const int arr = slot == 0 ? 1 : slot == 1 ? 4 : slot == 2 ? 5 : slot == 3 ? 2 : slot == 4 ? 0 : 3; \
            *(LAS f32x4*)(dst_ + t * 384 + slot * 64 + c4 * 4) = *(const f32x4*)(RW + (size_t)arr * MPAD * BW + (size_t)(row0 + t0_ + t) * BW + h * 64 + c4 * 4); } } while (0)
        RW_STAGE(0);
        for (int bi = 0; bi < nb; ++bi) {
            __syncthreads();
            if (bi + 1 < nb) RW_STAGE(bi + 1);
            const int t0 = bi * 16, nT = (L - t0) < 16 ? (L - t0) : 16; const LAS float* src = opb + (bi & 1) * 16 * 384;
            for (int tt = 0; tt < nT; ++tt) {
                const LAS float* b = src + tt * 384 + cg * 8;
                const f32x4 w0 = *(const LAS f32x4*)(b), w1 = *(const LAS f32x4*)(b + 4), k0 = *(const LAS f32x4*)(b + 64), k1 = *(const LAS f32x4*)(b + 68);
                const f32x4 b0 = *(const LAS f32x4*)(b + 128), b1 = *(const LAS f32x4*)(b + 132), q0 = *(const LAS f32x4*)(b + 192), q1 = *(const LAS f32x4*)(b + 196);
                const f32x4 r0 = *(const LAS f32x4*)(b + 256), r1 = *(const LAS f32x4*)(b + 260); const float v = src[tt * 384 + 320 + vrow];
                float d = (S[0] * k0[0] + S[1] * k0[1]) + (S[2] * k0[2] + S[3] * k0[3]) + (S[4] * k1[0] + S[5] * k1[1]) + (S[6] * k1[2] + S[7] * k1[3]);
                d += __shfl_xor(d, 1, 64); d += __shfl_xor(d, 2, 64); d += __shfl_xor(d, 4, 64);
                float y = 0.f;
#pragma unroll
                for (int j = 0; j < 4; ++j) { S[j] = S[j] * w0[j] - d * b0[j] + v * q0[j]; y += S[j] * r0[j]; S[4 + j] = S[4 + j] * w1[j] - d * b1[j] + v * q1[j]; y += S[4 + j] * r1[j]; }
                y += __shfl_xor(y, 1, 64); y += __shfl_xor(y, 2, 64); y += __shfl_xor(y, 4, 64);
                if (cg == 0) yb[tt * 64 + vrow] = y;
            }
            __syncthreads();
            for (int tt = w; tt < nT; tt += 8) {
                const float y = yb[tt * 64 + lane]; const float mean = wave_sum(y) * (1.0f / 64.0f), dy = y - mean, var = wave_sum(dy * dy) * (1.0f / 64.0f);
                const float yn = dy * rsqrtf(var + 64e-5f) * lg + lb; const size_t o = (size_t)(row0 + t0 + tt) * BW + h * 64 + lane;
                OB[o] = f2bf((yn + BON[o]) * G[o]);
            }
        }
#undef RW_STAGE
        float* op = (sq < PB ? outP + (((size_t)sq * 16 + h) * 64 + vrow) * 64 : outS + (((size_t)(sq - PB) * 16 + h) * 64 + vrow) * 64) + cg * 8;
#pragma unroll
        for (int j = 0; j < 8; ++j) op[j] = S[j];
        __syncthreads();
    }
}
constexpr int RS_SLOTS = 8, RS_SLOT_B = RB_EL * 2;
__device__ __forceinline__ void ph_rwkv_seq(const Ctx& c, int boff, const bf16_t* __restrict__ RB, const float* __restrict__ s0, float* __restrict__ outP, float* __restrict__ outS, bf16_t* __restrict__ OB) {
    const int lane = c.lane, r = lane & 15, q = lane >> 4, w = c.wave;
    LAS unsigned char* ring = c.lds;
    for (int u = (c.bid - boff + c.G) % c.G; u < (PB + SB) * 16; u += c.G) {
        const int sq = u >> 4, h = u & 15;
        int nch, ch0, row0, ntok; const float* sp = nullptr; float* op;
        if (sq < PB) { nch = 256; ch0 = (sq * 16 + h) * 256; row0 = sq * PS; ntok = 16; op = outP + (size_t)(sq * 16 + h) * 4096; }
        else { nch = 1; ch0 = PB * 16 * 256 + (sq - PB) * 16 + h; row0 = MP + (sq - PB) * SS; ntok = SS; sp = s0 + (size_t)((sq - PB) * 16 + h) * 4096; op = outS + (size_t)((sq - PB) * 16 + h) * 4096; }
        if (w >= 4) {
            const int lw = w - 4, p0 = lw < 2 ? lw * 5 : 10 + (lw - 2) * 4, np = lw < 2 ? 5 : 4;
#define RS_ISSUE(ci_) do { const int cc_ = (ci_) < nch ? (ci_) : nch - 1; const char* g_ = (const char*)(RB + (size_t)(ch0 + cc_) * RB_EL) + p0 * 1024 + lane * 16; \
            LAS unsigned char* d_ = ring + ((ci_) % RS_SLOTS) * RS_SLOT_B + p0 * 1024; \
            _Pragma("unroll") for (int p_ = 0; p_ < 5; ++p_) if (p_ < np) __builtin_amdgcn_global_load_lds((const unsigned*)(g_ + p_ * 1024), (LAS unsigned*)(d_ + p_ * 1024), 16, 0, 0); } while (0)
            for (int ci = 0; ci < RS_SLOTS - 1; ++ci) RS_ISSUE(ci);
            if (lw < 2) asm volatile("s_waitcnt vmcnt(30)" ::: "memory"); else asm volatile("s_waitcnt vmcnt(24)" ::: "memory");
            __builtin_amdgcn_s_barrier();
            for (int ci = 0; ci < nch; ++ci) {
                RS_ISSUE(ci + RS_SLOTS - 1);
                if (lw < 2) asm volatile("s_waitcnt vmcnt(30)" ::: "memory"); else asm volatile("s_waitcnt vmcnt(24)" ::: "memory");
                __builtin_amdgcn_s_barrier();
            }
#undef RS_ISSUE
            asm volatile("s_waitcnt vmcnt(0)" ::: "memory");
        } else {
            const int vb = w; f32x4 acc[4];
#pragma unroll
            for (int kb = 0; kb < 4; ++kb) acc[kb] = sp ? *(const f32x4*)(sp + (size_t)(vb * 16 + r) * 64 + kb * 16 + q * 4) : (f32x4){0.f, 0.f, 0.f, 0.f};
            const bf16x8 zfrag = (bf16x8){0, 0, 0, 0, 0, 0, 0, 0};
            __builtin_amdgcn_s_barrier();
            for (int ci = 0; ci < nch; ++ci) {
                const LAS bf16_t* blob = (const LAS bf16_t*)(ring + (ci % RS_SLOTS) * RS_SLOT_B);
                const bf16x8 t0 = pack_acc(acc[0], acc[1]), t1 = pack_acc(acc[2], acc[3]);
                const bf16x8 vt = q < 2 ? *(const LAS bf16x8*)(blob + RB_VT + (vb * 16 + r) * 24 + q * 8) : zfrag;
                const bf16x8 ep = q < 2 ? *(const LAS bf16x8*)(blob + RB_EP + r * 24 + q * 8) : zfrag;
                f32x4 y = mma16(t0, *(const LAS bf16x8*)(blob + RB_QP + r * 72 + q * 8), (f32x4){0.f, 0.f, 0.f, 0.f});
                y = mma16(t1, *(const LAS bf16x8*)(blob + RB_QP + r * 72 + 32 + q * 8), y);
                y = mma16(vt, ep, y);
#pragma unroll
                for (int kb = 0; kb < 4; ++kb) { f32x4 a = mma16(*(const LAS bf16x8*)(blob + (kb * 16 + r) * 72 + q * 8), t0, (f32x4){0.f, 0.f, 0.f, 0.f});
                    a = mma16(*(const LAS bf16x8*)(blob + (kb * 16 + r) * 72 + 32 + q * 8), t1, a);
                    const bf16x8 kh = q < 2 ? *(const LAS bf16x8*)(blob + RB_KHP + (kb * 16 + r) * 24 + q * 8) : zfrag;
                    acc[kb] = mma16(kh, vt, a); }
                if (r < ntok) { u32x2 o; o.x = pk2(y[0], y[1]); o.y = pk2(y[2], y[3]); *(u32x2*)(OB + (size_t)(row0 + ci * 16 + r) * BW + h * 64 + vb * 16 + q * 4) = o; }
                asm volatile("s_waitcnt lgkmcnt(0)" ::: "memory");
                __builtin_amdgcn_s_barrier();
            }
#pragma unroll
            for (int kb = 0; kb < 4; ++kb) *(f32x4*)(op + (size_t)(vb * 16 + r) * 64 + kb * 16 + q * 4) = acc[kb];
        }
        __syncthreads();
    }
}
__device__ __forceinline__ void ph_rwkv_fin(const Ctx& c, const float* __restrict__ RW, const float* __restrict__ lng, const float* __restrict__ lnb, bf16_t* __restrict__ OB) {
    const int lane = c.lane; const float* G = RW + 6 * (size_t)MPAD * BW; const float* BON = RW + 7 * (size_t)MPAD * BW;
    for (int i = c.bid * 8 + c.wave; i < MT * 4; i += c.G * 8) {
        const int row = i >> 2, cc = (i & 3) * 256 + lane * 4; const size_t o = (size_t)row * BW + cc; bf16_t* p = OB + o;
        const u32x2 raw = *(const u32x2*)p; float x[4] = {__uint_as_float(raw.x << 16), __uint_as_float(raw.x & 0xffff0000u), __uint_as_float(raw.y << 16), __uint_as_float(raw.y & 0xffff0000u)};
        float s = (x[0] + x[1]) + (x[2] + x[3]); s += __shfl_xor(s, 1, 64); s += __shfl_xor(s, 2, 64); s += __shfl_xor(s, 4, 64); s += __shfl_xor(s, 8, 64);
        const float mean = s * (1.0f / 64.0f); float qq = 0.f;
#pragma unroll
        for (int j = 0; j < 4; ++j) { const float d = x[j] - mean; qq += d * d; }
        qq += __shfl_xor(qq, 1, 64); qq += __shfl_xor(qq, 2, 64); qq += __shfl_xor(qq, 4, 64); qq += __shfl_xor(qq, 8, 64);
        const float rstd = rsqrtf(qq * (1.0f / 64.0f) + 64e-5f);
        const f32x4 gg = *(const f32x4*)(lng + cc), bb = *(const f32x4*)(lnb + cc), bo = *(const f32x4*)(BON + o), gt = *(const f32x4*)(G + o); float ov[4];
#pragma unroll
        for (int j = 0; j < 4; ++j) ov[j] = ((x[j] - mean) * rstd * gg[j] + bb[j] + bo[j]) * gt[j];
        u32x2 oo; oo.x = pk2(ov[0], ov[1]); oo.y = pk2(ov[2], ov[3]); *(u32x2*)p = oo;
    }
}

__device__ __forceinline__ void ph_memattn_sample(const Ctx& c, const bf16_t* __restrict__ U, const float* __restrict__ mk, const float* __restrict__ mv, bf16_t* __restrict__ OB) {
    LAS float* qs = (LAS float*)c.lds; LAS float* ps = qs + 2 * 4 * 256;
    const int hh = c.tid >> 8, vt = c.tid & 255, lane = c.lane;
    for (int u = c.bid; u < SB * 2; u += c.G) {
        const int sq = u >> 1, h = (u & 1) * 2 + hh;
#pragma unroll
        for (int t = 0; t < 4; ++t) qs[(hh * 4 + t) * 256 + vt] = bf2f(U[(size_t)(MP + sq * SS + t) * NINP + U_MQ + h * 256 + vt]) * 0.0625f;
        __syncthreads();
        { const float* kr = mk + (((size_t)sq * MEMT + vt) * 4 + h) * 256; float s[4] = {0.f, 0.f, 0.f, 0.f};
            for (int d = 0; d < 256; d += 4) { const f32x4 kv = *(const f32x4*)(kr + d);
#pragma unroll
                for (int t = 0; t < 4; ++t) { const LAS float* qq = qs + (hh * 4 + t) * 256 + d; s[t] += kv[0] * qq[0] + kv[1] * qq[1] + kv[2] * qq[2] + kv[3] * qq[3]; } }
#pragma unroll
            for (int t = 0; t < 4; ++t) ps[(hh * 4 + t) * 256 + vt] = s[t]; }
        __syncthreads();
        { LAS float* pr = ps + c.wave * 256; float x[4]; float mx = -3.0e38f;
#pragma unroll
            for (int j = 0; j < 4; ++j) { x[j] = pr[lane + 64 * j]; mx = fmaxf(mx, x[j]); }
            mx = wave_max(mx); float s = 0.f;
#pragma unroll
            for (int j = 0; j < 4; ++j) { x[j] = __expf(x[j] - mx); s += x[j]; }
            const float inv = 1.0f / wave_sum(s);
#pragma unroll
            for (int j = 0; j < 4; ++j) pr[lane + 64 * j] = x[j] * inv; }
        __syncthreads();
        { float o[4] = {0.f, 0.f, 0.f, 0.f}; const float* vr = mv + ((size_t)sq * MEMT * 4 + h) * 256 + vt;
            for (int m = 0; m < MEMT; ++m) { const float vv = vr[(size_t)m * 1024];
#pragma unroll
                for (int t = 0; t < 4; ++t) o[t] += ps[(hh * 4 + t) * 256 + m] * vv; }
#pragma unroll
            for (int t = 0; t < 4; ++t) OB[(size_t)(MP + sq * SS + t) * BW + h * 256 + vt] = f2bf(o[t]); }
        __syncthreads();
    }
}

template <int K, int LDA, int LDB> __device__ __forceinline__ void skinny_pair(const Ctx& c, const bf16_t* __restrict__ A, const bf16_t* __restrict__ B0, const bf16_t* __restrict__ B1, f32x4 (&out)[2], int rot) {
    LAS f32x4* red = (LAS f32x4*)c.lds;
    const int lane = c.lane, r = lane & 15, q = lane >> 4, w = c.wave;
    constexpr int KS = K / 8;
    const bf16_t* ap = A + (size_t)r * LDA + w * KS + q * 8; const bf16_t* b0 = B0 + (size_t)r * LDB + w * KS + q * 8; const bf16_t* b1 = B1 + (size_t)r * LDB + w * KS + q * 8;
    f32x4 acc[2][8];
#pragma unroll
    for (int n = 0; n < 2; ++n)
#pragma unroll
        for (int m = 0; m < 8; ++m) acc[n][m] = (f32x4){0.f, 0.f, 0.f, 0.f};
    int kk = (int)((unsigned)rot % (unsigned)(KS / 32));
#pragma unroll 2
    for (int it = 0; it < KS / 32; ++it) { const int ks = kk; kk = kk + 1 == KS / 32 ? 0 : kk + 1;
        const bf16x8 f0 = *(const bf16x8*)(b0 + ks * 32), f1 = *(const bf16x8*)(b1 + ks * 32); bf16x8 af[8];
#pragma unroll
        for (int m = 0; m < 8; ++m) af[m] = *(const bf16x8*)(ap + (size_t)(m * 16) * LDA + ks * 32);
#pragma unroll
        for (int m = 0; m < 8; ++m) { acc[0][m] = mma16(f0, af[m], acc[0][m]); acc[1][m] = mma16(f1, af[m], acc[1][m]); } }
    __syncthreads();
#pragma unroll
    for (int n = 0; n < 2; ++n)
#pragma unroll
        for (int m = 0; m < 8; ++m) red[(w * 16 + n * 8 + m) * 64 + lane] = acc[n][m];
    __syncthreads();
#pragma unroll
    for (int n = 0; n < 2; ++n) { f32x4 s = red[(n * 8 + w) * 64 + lane];
#pragma unroll
        for (int ww = 1; ww < 8; ++ww) s += red[(ww * 16 + n * 8 + w) * 64 + lane];
        out[n] = s; }
}
__device__ __forceinline__ u32x2 pk4(const f32x4 v) { u32x2 o; o.x = pk2(v[0], v[1]); o.y = pk2(v[2], v[3]); return o; }
#define SKINNY_LOOP(total_) for (int s = c.bid - base; s >= 0 && s < (total_); s += ncu)
__device__ __forceinline__ void ph_sk_in(const Ctx& c, int base, int ncu, const bf16_t* __restrict__ HB, const bf16_t* __restrict__ W, bf16_t* __restrict__ U) {
    const int r = c.lane & 15, q = c.lane >> 4, w = c.wave;
    SKINNY_LOOP(NINP / 32) { f32x4 o[2]; skinny_pair<DM, DM, DM>(c, HB + (size_t)MP * DM, W + (size_t)(s * 32) * DM, W + (size_t)(s * 32 + 16) * DM, o, s);
        bf16_t* up = U + (size_t)(MP + w * 16 + r) * NINP + s * 32 + q * 4; *(u32x2*)up = pk4(o[0]); *(u32x2*)(up + 16) = pk4(o[1]); }
}
__device__ __forceinline__ void ph_sk_merge(const Ctx& c, int base, int ncu, const bf16_t* __restrict__ BR, const bf16_t* __restrict__ W, const bf16_t* __restrict__ U, const float* __restrict__ gate_b, bf16_t* __restrict__ MGB) {
    const int r = c.lane & 15, q = c.lane >> 4, w = c.wave;
    SKINNY_LOOP(DM / 32) { const size_t row = (size_t)(MP + w * 16 + r); const int col = s * 32 + q * 4; f32x4 tot[2] = {(f32x4){0.f, 0.f, 0.f, 0.f}, (f32x4){0.f, 0.f, 0.f, 0.f}};
#pragma unroll 1
        for (int z = 0; z < 4; ++z) { f32x4 o[2]; skinny_pair<BW, BW, BW>(c, BR + ((size_t)z * MPAD + MP) * BW, W + ((size_t)z * DM + s * 32) * BW, W + ((size_t)z * DM + s * 32 + 16) * BW, o, s + z);
#pragma unroll
            for (int n = 0; n < 2; ++n) { const u32x2 gp = *(const u32x2*)(U + row * NINP + U_GP + z * DM + col + n * 16); const f32x4 gb = *(const f32x4*)(gate_b + z * DM + col + n * 16);
                tot[n][0] += sigmoidf_(__uint_as_float(gp.x << 16) + gb[0]) * o[n][0]; tot[n][1] += sigmoidf_(__uint_as_float(gp.x & 0xffff0000u) + gb[1]) * o[n][1];
                tot[n][2] += sigmoidf_(__uint_as_float(gp.y << 16) + gb[2]) * o[n][2]; tot[n][3] += sigmoidf_(__uint_as_float(gp.y & 0xffff0000u) + gb[3]) * o[n][3]; } }
        *(u32x2*)(MGB + row * DM + col) = pk4(tot[0]); *(u32x2*)(MGB + row * DM + col + 16) = pk4(tot[1]); }
}
template <int K> __device__ __forceinline__ void ph_sk_res(const Ctx& c, int base, int ncu, const bf16_t* __restrict__ A, const bf16_t* __restrict__ W, const float* __restrict__ R, float* __restrict__ Y) {
    const int r = c.lane & 15, q = c.lane >> 4, w = c.wave;
    SKINNY_LOOP(DM / 32) { f32x4 o[2]; skinny_pair<K, K, K>(c, A + (size_t)MP * K, W + (size_t)(s * 32) * K, W + (size_t)(s * 32 + 16) * K, o, s);
        const size_t off = (size_t)(MP + w * 16 + r) * DM + s * 32 + q * 4;
        *(f32x4*)(Y + off) = *(const f32x4*)(R + off) * ALPHA + o[0]; *(f32x4*)(Y + off + 16) = *(const f32x4*)(R + off + 16) * ALPHA + o[1]; }
}
__device__ __forceinline__ void ph_sk_gu(const Ctx& c, int base, int ncu, const bf16_t* __restrict__ X1B, const bf16_t* __restrict__ W, bf16_t* __restrict__ ACT) {
    const int r = c.lane & 15, q = c.lane >> 4, w = c.wave;
    SKINNY_LOOP(DFF / 16) { const int t = s >> 3, j0 = (s & 7) * 16; f32x4 o[2];
        skinny_pair<DM, DM, DM>(c, X1B + (size_t)MP * DM, W + (size_t)(t * 256 + j0) * DM, W + (size_t)(t * 256 + 128 + j0) * DM, o, s);
        f32x4 v;
#pragma unroll
        for (int j = 0; j < 4; ++j) v[j] = o[0][j] * sigmoidf_(o[0][j]) * o[1][j];
        *(u32x2*)(ACT + (size_t)(MP + w * 16 + r) * DFF + t * 128 + j0 + q * 4) = pk4(v); }
}
#undef SKINNY_LOOP

constexpr int LDS_BAR_OFF = 147456;
constexpr int LDS_BYTES = LDS_BAR_OFF + 64;
struct Args { const float* in[37]; float* out; unsigned char* ws; };

typedef pg8::Gemm<DM, DM, DM, 2, 8, NL, 1, false, 0, 0, (long)DM * DM, 0> GemmMem;
typedef pg8::Gemm<DM, DM, DM, MP / 256, NINP / 256> GemmIn;
typedef pg8::Gemm<NINP, 1024, 256, PS / 256, 1, 8, 4, false, (long)PS * NINP, 256, 256 * 1024, 256> GemmScore;
typedef pg8::Gemm<256, 256, 256, PS / 256, 1, 8, 4, false, (long)4 * 4096 * 256, (long)4096 * 256, 4 * 65536, 65536> GemmPV;
typedef pg8::Gemm<BW, BW, BW, MP / 256, DM / 256, 4, 1, true, (long)MPAD * BW, 0, (long)DM * BW, 0> GemmBranch;
typedef pg8::Gemm<DM, DM, DM, MP / 256, DM / 256> GemmOut;
typedef pg8::Gemm<DM, DM, DM, MP / 256, 2 * DFF / 256> GemmGU;
typedef pg8::Gemm<DFF, DFF, DFF, MP / 256, DM / 256> GemmDown;
template <class GT> __device__ __forceinline__ GT mk_gemm(const Ctx& c, const bf16_t* A, const bf16_t* B) { GT g; g.A = A; g.B = B; g.G = c.G; g.c = c.bid; return g; }

template <int OFF> __device__ __forceinline__ unsigned long long karg_u64(unsigned long long kargs) {
    unsigned long long p; asm volatile("s_load_dwordx2 %0, %1, %2\n\ts_waitcnt lgkmcnt(0)" : "=s"(p) : "s"(kargs), "n"(OFF) : "memory"); return p;
}
#define INP(k) ((const float*)karg_u64<(k) * 8>(kargs))
#define OUTP() ((float*)karg_u64<37 * 8>(kargs))
#define WSP() ((unsigned char*)karg_u64<38 * 8>(kargs))

__global__ void __launch_bounds__(512, 2) mega_fwd(Args a_unused) {
    extern __shared__ __attribute__((aligned(16))) unsigned char lds_raw[];
    const unsigned long long kargs = (unsigned long long)__builtin_amdgcn_kernarg_segment_ptr();
    Ctx c0; c0.tid = threadIdx.x; c0.lane = c0.tid & 63; c0.wave = __builtin_amdgcn_readfirstlane(c0.tid >> 6); c0.bid = blockIdx.x; c0.G = gridDim.x; c0.lds = (LAS unsigned char*)lds_raw;
    if (c0.tid < 4) ((LAS unsigned*)(c0.lds + LDS_BAR_OFF))[c0.tid] = 0u;
    __syncthreads();
    const XcdBarrier bar = xcd_barrier_post((unsigned*)(WSP() + WS_CTL), (volatile LAS unsigned*)(c0.lds + LDS_BAR_OFF));

#define WPREP_LAYER(cc_, L_) do { unsigned char* ws_ = WSP(); \
      ph_wprep(cc_, INP(10) + (size_t)(L_) * DM * NIN, (bf16_t*)(ws_ + WS_WIN) + (size_t)(L_) * NINP * DM, DM, NIN, NINP, 1, 1, 0, 0); \
      ph_wprep(cc_, INP(29) + (size_t)(L_) * 4 * BW * DM, (bf16_t*)(ws_ + WS_WBR) + (size_t)(L_) * 4 * DM * BW, BW, DM, DM, 0, 4, (size_t)BW * DM, (size_t)DM * BW); \
      ph_wprep(cc_, INP(30) + (size_t)(L_) * DM * DM, (bf16_t*)(ws_ + WS_WOUT) + (size_t)(L_) * DM * DM, DM, DM, DM, 0, 1, 0, 0); \
      ph_wprep(cc_, INP(33) + (size_t)(L_) * DM * 2 * DFF, (bf16_t*)(ws_ + WS_WGU) + (size_t)(L_) * 2 * DFF * DM, DM, 2 * DFF, 2 * DFF, 2, 1, 0, 0); \
      ph_wprep(cc_, INP(34) + (size_t)(L_) * DFF * DM, (bf16_t*)(ws_ + WS_WDN) + (size_t)(L_) * DM * DFF, DFF, DM, DM, 0, 1, 0, 0); } while (0)
    { const Ctx c = fresh(c0); unsigned char* ws = WSP();
      ph_wprep(c, INP(28), (bf16_t*)(ws + WS_WMEM), DM, DM, DM, 0, NL, (size_t)DM * DM, (size_t)DM * DM);
      WPREP_LAYER(c, 0);
      ph_lrw(c, INP(19), INP(21), INP(22), (bf16_t*)(ws + WS_LRW));
      ph_xprep(c, INP(0), INP(1), INP(2), (float*)(ws + WS_HF), (bf16_t*)(ws + WS_HB), (bf16_t*)(ws + WS_MEMB)); }
    xcd_barrier(bar);
    { const Ctx c = fresh(c0); unsigned char* ws = WSP(); float* out = OUTP();
      GemmMem g = mk_gemm<GemmMem>(c, (const bf16_t*)(ws + WS_MEMB), (const bf16_t*)(ws + WS_WMEM));
      pg8::EpiMem E; E.outK = out + O_MKP; E.outV = out + O_MVP; E.kb = (bf16_t*)(ws + WS_MKB); E.vt = (bf16_t*)(ws + WS_MVT); pg8::gemm_phase<GemmMem, pg8::EpiMem, true, true>(c.lds, c.tid, g, E); }

    for (int l = 0; l < NL; ++l) {
        { const Ctx c = fresh(c0); unsigned char* ws = WSP();
          GemmIn g = mk_gemm<GemmIn>(c, (const bf16_t*)(ws + WS_HB), (const bf16_t*)(ws + WS_WIN) + (size_t)l * NINP * DM);
          pg8::EpiBf16 E; E.O = (bf16_t*)(ws + WS_U); E.zs = 0; E.ldc = NINP; E.pad = 0; pg8::gemm_phase<GemmIn, pg8::EpiBf16, true, true>(c.lds, c.tid, g, E); }
        { const Ctx c = fresh(c0); unsigned char* ws = WSP(); ph_sk_in(c, c.G > 192 ? 96 : 0, c.G > 192 ? c.G - 96 : c.G, (const bf16_t*)(ws + WS_HB), (const bf16_t*)(ws + WS_WIN) + (size_t)l * NINP * DM, (bf16_t*)(ws + WS_U)); }
        xcd_barrier(bar);
        { const Ctx c = fresh(c0); unsigned char* ws = WSP(); float* out = OUTP(); const bf16_t* U = (const bf16_t*)(ws + WS_U); bf16_t* BR = (bf16_t*)(ws + WS_BR);
          (void)out; (void)BR;
          ph_gla_pre(c, U, INP(12) + (size_t)l * 16 * 512, INP(13) + (size_t)l * 512, (bf16_t*)(ws + WS_GLQD), (bf16_t*)(ws + WS_GLKH), (bf16_t*)(ws + WS_GLE), (bf16_t*)(ws + WS_GLVT), (float*)(ws + WS_GLGC)); }
        { const Ctx c = fresh(c0); unsigned char* ws = WSP();
          ph_rwkv_pre(c, (const bf16_t*)(ws + WS_U), INP(9) + (size_t)l * SB * RWC, INP(17) + (size_t)l * RWC, INP(18) + (size_t)l * BW, INP(19) + (size_t)l * 64 * BW, INP(20) + (size_t)l * BW, INP(21) + (size_t)l * 64 * BW,
                       INP(22) + (size_t)l * 128 * BW, INP(23) + (size_t)l * BW, INP(24) + (size_t)l * BW, INP(25) + (size_t)l * BW, (float*)(ws + WS_RW), (bf16_t*)(ws + WS_RB), (const bf16_t*)(ws + WS_LRW) + (size_t)l * 1024 * 256); }
        { const Ctx c = fresh(c0); unsigned char* ws = WSP();
          ph_swa_sample(c, (const bf16_t*)(ws + WS_U), INP(3) + (size_t)l * SB * 16384, INP(4) + (size_t)l * SB * 16384, INP(16) + (size_t)l * 16, (bf16_t*)(ws + WS_BR) + (size_t)MPAD * BW); }
        { const Ctx c = fresh(c0); unsigned char* ws = WSP(); ph_swa_prompt(c, (const bf16_t*)(ws + WS_U), INP(16) + (size_t)l * 16, (bf16_t*)(ws + WS_BR) + (size_t)MPAD * BW); }
        { const Ctx c = fresh(c0); unsigned char* ws = WSP();
          ph_copy_outs(c, (const bf16_t*)(ws + WS_U), INP(3) + (size_t)l * SB * 16384, INP(4) + (size_t)l * SB * 16384, OUTP(), l); }
        { const Ctx c = fresh(c0); unsigned char* ws = WSP();
          ph_memattn_sample(c, (const bf16_t*)(ws + WS_U), INP(5) + (size_t)l * SB * MEMT * 1024, INP(6) + (size_t)l * SB * MEMT * 1024, (bf16_t*)(ws + WS_BR) + (size_t)3 * MPAD * BW); }
        { const Ctx c = fresh(c0); unsigned char* ws = WSP();
          GemmScore g = mk_gemm<GemmScore>(c, (const bf16_t*)(ws + WS_U) + U_MQ, (const bf16_t*)(ws + WS_MKB) + (size_t)l * 512 * 1024);
          pg8::EpiScore E; E.SC = (float*)(ws + WS_SC); pg8::gemm_phase<GemmScore, pg8::EpiScore, true, true>(c.lds, c.tid, g, E); }
        xcd_barrier(bar);
        { const Ctx c = fresh(c0); unsigned char* ws = WSP(); float* out = OUTP();
          ph_rwkv_seq(c, 64, (const bf16_t*)(ws + WS_RB), INP(8) + (size_t)l * SB * 16 * 4096, out + O_RWP + (size_t)l * PB * 16 * 4096, out + O_RWS + (size_t)l * SB * 16 * 4096,
                      (bf16_t*)(ws + WS_BR) + (size_t)2 * MPAD * BW); }
        { const Ctx c = fresh(c0); unsigned char* ws = WSP(); float* out = OUTP();
          ph_gla_seq(c, 32, (const bf16_t*)(ws + WS_GLQD), (const bf16_t*)(ws + WS_GLKH), (const bf16_t*)(ws + WS_GLE), (const bf16_t*)(ws + WS_GLVT), (const float*)(ws + WS_GLGC),
                     INP(7) + (size_t)l * SB * 4 * 32768, out + O_GLAP + (size_t)l * PB * 4 * 32768, out + O_GLAS + (size_t)l * SB * 4 * 32768, (bf16_t*)(ws + WS_BR)); }
        { const Ctx c = fresh(c0); unsigned char* ws = WSP(); ph_softmax256(c, (const float*)(ws + WS_SC), (bf16_t*)(ws + WS_PB), 8 * 4096); }
        if (l + 1 < NL && (c0.bid < 32 || c0.bid >= 96) && c0.G > 96) { Ctx c = fresh(c0); c.bid = c.bid < 32 ? c.bid : c.bid - 64; c.G = c.G - 64; WPREP_LAYER(c, l + 1); }
        xcd_barrier(bar);
        { const Ctx c = fresh(c0); unsigned char* ws = WSP(); ph_rwkv_fin(c, (const float*)(ws + WS_RW), INP(26) + (size_t)l * BW, INP(27) + (size_t)l * BW, (bf16_t*)(ws + WS_BR) + (size_t)2 * MPAD * BW); }
        { const Ctx c = fresh(c0); unsigned char* ws = WSP(); ph_gla_fin(c, (const bf16_t*)(ws + WS_U), INP(14) + (size_t)l * BW, INP(15) + (size_t)l * BW, (bf16_t*)(ws + WS_BR)); }
        { const Ctx c = fresh(c0); unsigned char* ws = WSP();
          GemmPV g = mk_gemm<GemmPV>(c, (const bf16_t*)(ws + WS_PB), (const bf16_t*)(ws + WS_MVT) + (size_t)l * 8 * 65536);
          pg8::EpiPV E; E.O = (bf16_t*)(ws + WS_BR) + (size_t)3 * MPAD * BW; pg8::gemm_phase<GemmPV, pg8::EpiPV, true, true>(c.lds, c.tid, g, E); }
        xcd_barrier(bar);
        { const Ctx c = fresh(c0); unsigned char* ws = WSP();
          GemmBranch g = mk_gemm<GemmBranch>(c, (const bf16_t*)(ws + WS_BR), (const bf16_t*)(ws + WS_WBR) + (size_t)l * 4 * DM * BW);
          pg8::EpiMerge E; E.MG = (float*)(ws + WS_MG); E.MGB = (bf16_t*)(ws + WS_MGB); E.U = (const bf16_t*)(ws + WS_U); E.gate_b = INP(11) + (size_t)l * 4 * DM; pg8::gemm_phase<GemmBranch, pg8::EpiMerge, true, true>(c.lds, c.tid, g, E); }
        { const Ctx c = fresh(c0); unsigned char* ws = WSP(); ph_sk_merge(c, 0, c.G, (const bf16_t*)(ws + WS_BR), (const bf16_t*)(ws + WS_WBR) + (size_t)l * 4 * DM * BW, (const bf16_t*)(ws + WS_U), INP(11) + (size_t)l * 4 * DM, (bf16_t*)(ws + WS_MGB)); }
        xcd_barrier(bar);
        { const Ctx c = fresh(c0); unsigned char* ws = WSP();
          GemmOut g = mk_gemm<GemmOut>(c, (const bf16_t*)(ws + WS_MGB), (const bf16_t*)(ws + WS_WOUT) + (size_t)l * DM * DM);
          pg8::EpiRes E; E.R = (const float*)(ws + WS_HF); E.Y = (float*)(ws + WS_Y); pg8::gemm_phase<GemmOut, pg8::EpiRes, true, true>(c.lds, c.tid, g, E); }
        { const Ctx c = fresh(c0); unsigned char* ws = WSP(); ph_sk_res<DM>(c, c.G > 192 ? 128 : 0, c.G > 192 ? c.G - 128 : c.G, (const bf16_t*)(ws + WS_MGB), (const bf16_t*)(ws + WS_WOUT) + (size_t)l * DM * DM, (const float*)(ws + WS_HF), (float*)(ws + WS_Y)); }
        xcd_barrier(bar);
        { const Ctx c = fresh(c0); unsigned char* ws = WSP(); ph_ln(c, (const float*)(ws + WS_Y), INP(31) + (size_t)l * DM, INP(32) + (size_t)l * DM, (float*)(ws + WS_X1F), (bf16_t*)(ws + WS_X1B), nullptr, MT, 0); }
        xcd_barrier(bar);
        { const Ctx c = fresh(c0); unsigned char* ws = WSP();
          GemmGU g = mk_gemm<GemmGU>(c, (const bf16_t*)(ws + WS_X1B), (const bf16_t*)(ws + WS_WGU) + (size_t)l * 2 * DFF * DM);
          pg8::EpiSwiGLU E; E.O = (bf16_t*)(ws + WS_ACT); pg8::gemm_phase<GemmGU, pg8::EpiSwiGLU, true, true>(c.lds, c.tid, g, E); }
        { const Ctx c = fresh(c0); unsigned char* ws = WSP(); ph_sk_gu(c, c.G > 192 ? 128 : 0, c.G > 192 ? c.G - 128 : c.G, (const bf16_t*)(ws + WS_X1B), (const bf16_t*)(ws + WS_WGU) + (size_t)l * 2 * DFF * DM, (bf16_t*)(ws + WS_ACT)); }
        xcd_barrier(bar);
        { const Ctx c = fresh(c0); unsigned char* ws = WSP();
          GemmDown g = mk_gemm<GemmDown>(c, (const bf16_t*)(ws + WS_ACT), (const bf16_t*)(ws + WS_WDN) + (size_t)l * DM * DFF);
          pg8::EpiRes E; E.R = (const float*)(ws + WS_X1F); E.Y = (float*)(ws + WS_Y); pg8::gemm_phase<GemmDown, pg8::EpiRes, true, true>(c.lds, c.tid, g, E); }
        { const Ctx c = fresh(c0); unsigned char* ws = WSP(); ph_sk_res<DFF>(c, 0, c.G, (const bf16_t*)(ws + WS_ACT), (const bf16_t*)(ws + WS_WDN) + (size_t)l * DM * DFF, (const float*)(ws + WS_X1F), (float*)(ws + WS_Y)); }
        xcd_barrier(bar);
        { const Ctx c = fresh(c0); unsigned char* ws = WSP(); float* out = OUTP(); ph_ln(c, (const float*)(ws + WS_Y), INP(35) + (size_t)l * DM, INP(36) + (size_t)l * DM, (float*)(ws + WS_HF), (bf16_t*)(ws + WS_HB), l == NL - 1 ? out : nullptr, MT, MT); }
        xcd_barrier(bar);
    }
}

extern "C" void kernel_launch(void* const* d_in, const int* in_sizes, int n_in, void* d_out, int out_size, void* d_ws, size_t ws_size, hipStream_t stream) {
    static int grid = 0;
    if (grid == 0) {
        if (n_in != 37 || (size_t)out_size != O_END || ws_size < WS_END) { fprintf(stderr, "kernel_launch: unexpected sizes (n_in %d out %d ws %zu need %zu)\n", n_in, out_size, ws_size, (size_t)WS_END); grid = -1; return; }
        int dev = 0, cus = 0;
        if (hipGetDevice(&dev) != hipSuccess || hipDeviceGetAttribute(&cus, hipDeviceAttributeMultiprocessorCount, dev) != hipSuccess) { grid = -1; return; }
        if (hipFuncSetAttribute((const void*)mega_fwd, hipFuncAttributeMaxDynamicSharedMemorySize, LDS_BYTES) != hipSuccess) { fprintf(stderr, "kernel_launch: hipFuncSetAttribute failed\n"); grid = -1; return; }
        int per_cu = 0;
        if (hipOccupancyMaxActiveBlocksPerMultiprocessor(&per_cu, (const void*)mega_fwd, 512, LDS_BYTES) != hipSuccess || per_cu < 1) { fprintf(stderr, "kernel_launch: occupancy query says %d\n", per_cu); }
        (void)hipGetLastError();
        grid = cus;
    }
    if (grid < 0) return;
    (void)hipMemsetAsync((unsigned char*)d_ws + WS_CTL, 0, XCD_BAR_WORDS * sizeof(unsigned), stream);
    Args a; memset(&a, 0, sizeof a);
    for (int i = 0; i < 37; ++i) a.in[i] = (const float*)d_in[i];
    a.out = (float*)d_out; a.ws = (unsigned char*)d_ws;
    hipLaunchKernelGGL(mega_fwd, dim3(grid), dim3(512), LDS_BYTES, stream, a);
}
```

```cpp
#include <hip/hip_runtime.h>
#include <cstdio>
#include <cstdint>
#include <cstring>

#define LAS __attribute__((address_space(3)))
typedef unsigned short bf16_t;
typedef short bf16x8 __attribute__((ext_vector_type(8)));
typedef float f32x4 __attribute__((ext_vector_type(4)));
typedef float f32x2 __attribute__((ext_vector_type(2)));
typedef unsigned u32x4 __attribute__((ext_vector_type(4)));
typedef unsigned u32x2 __attribute__((ext_vector_type(2)));

constexpr int DM = 2048, NL = 4;
constexpr int PB = 2, PS = 4096, MP = PB * PS;
constexpr int SB = 32, SS = 4, MS = SB * SS;
constexpr int MT = MP + MS;
constexpr int MPAD = 8448;
constexpr int NIN = 16912, NINP = 17152;
constexpr int U_GQ = 0, U_GK = 512, U_GV = 1024, U_GR = 2048, U_GA = 3072, U_SQ = 3328, U_SK = 4352, U_SV = 4480, U_RU = 4608, U_MQ = 7936, U_GP = 8960;
constexpr int RWC = 3328, BW = 1024, DFF = 5632, MEMT = 256;
constexpr float ALPHA = 1.681792830507429f;

constexpr size_t O_YP = 0;
constexpr size_t O_YS = O_YP + (size_t)MP * DM;
constexpr size_t O_SWKP = O_YS + (size_t)MS * DM;
constexpr size_t O_SWVP = O_SWKP + (size_t)NL * PB * 128 * 128;
constexpr size_t O_MKP = O_SWVP + (size_t)NL * PB * 128 * 128;
constexpr size_t O_MVP = O_MKP + (size_t)NL * PB * 256 * 1024;
constexpr size_t O_GLAP = O_MVP + (size_t)NL * PB * 256 * 1024;
constexpr size_t O_RWP = O_GLAP + (size_t)NL * PB * 4 * 128 * 256;
constexpr size_t O_RSP = O_RWP + (size_t)NL * PB * 16 * 64 * 64;
constexpr size_t O_SWKS = O_RSP + (size_t)NL * PB * RWC;
constexpr size_t O_SWVS = O_SWKS + (size_t)NL * SB * 128 * 128;
constexpr size_t O_GLAS = O_SWVS + (size_t)NL * SB * 128 * 128;
constexpr size_t O_RWS = O_GLAS + (size_t)NL * SB * 4 * 128 * 256;
constexpr size_t O_RSS = O_RWS + (size_t)NL * SB * 16 * 64 * 64;
constexpr size_t O_END = O_RSS + (size_t)NL * SB * RWC;
static_assert(O_END == 52881408, "output size");

constexpr size_t al256(size_t x) { return (x + 255) & ~(size_t)255; }
constexpr size_t WS_CTL = 0;
constexpr size_t WS_WIN = 65536;
constexpr size_t WS_WMEM = WS_WIN + (size_t)NL * NINP * DM * 2;
constexpr size_t WS_WBR = WS_WMEM + (size_t)NL * DM * DM * 2;
constexpr size_t WS_WOUT = WS_WBR + (size_t)NL * 4 * DM * BW * 2;
constexpr size_t WS_WGU = WS_WOUT + (size_t)NL * DM * DM * 2;
constexpr size_t WS_WDN = WS_WGU + (size_t)NL * 2 * DFF * DM * 2;
constexpr size_t WS_HF = WS_WDN + (size_t)NL * DM * DFF * 2;
constexpr size_t WS_HB = WS_HF + (size_t)MPAD * DM * 4;
constexpr size_t WS_U = WS_HB + (size_t)MPAD * DM * 2;
constexpr size_t WS_BR = WS_U + (size_t)MPAD * NINP * 2;
constexpr size_t WS_MG = WS_BR + (size_t)4 * MPAD * BW * 2;
constexpr size_t WS_MGB = WS_MG + (size_t)MPAD * DM * 4;
constexpr size_t WS_Y = WS_MGB + (size_t)MPAD * DM * 2;
constexpr size_t WS_X1F = WS_Y + (size_t)MPAD * DM * 4;
constexpr size_t WS_X1B = WS_X1F + (size_t)MPAD * DM * 4;
constexpr size_t WS_ACT = WS_X1B + (size_t)MPAD * DM * 2;
constexpr size_t WS_MEMB = WS_ACT + (size_t)MPAD * DFF * 2;
constexpr size_t WS_MKB = WS_MEMB + (size_t)512 * DM * 2;
constexpr size_t WS_MVT = WS_MKB + (size_t)NL * 512 * 1024 * 2;
constexpr size_t WS_SC = WS_MVT + (size_t)NL * 8 * 256 * 256 * 2;
constexpr size_t WS_PB = WS_SC + (size_t)8 * 4096 * 256 * 4;
constexpr size_t WS_RW = WS_PB + (size_t)8 * 4096 * 256 * 2;
constexpr size_t RW_ARR = (size_t)MPAD * BW * 4;
constexpr int GL_NCH = 512 + 128;
constexpr size_t WS_GLQD = WS_RW + 8 * RW_ARR;
constexpr size_t WS_GLKH = WS_GLQD + (size_t)GL_NCH * 8192 * 2;
constexpr size_t WS_GLE = WS_GLKH + (size_t)GL_NCH * 8192 * 2;
constexpr size_t WS_GLVT = WS_GLE + (size_t)GL_NCH * 4096 * 2;
constexpr size_t WS_GLGC = WS_GLVT + (size_t)GL_NCH * 16384 * 2;
constexpr int RB_NCH = PB * 16 * 256 + SB * 16;
constexpr int RB_EL = 9216;
constexpr int RB_QP = 4608, RB_KHP = 5760, RB_VT = 7296, RB_EP = 8832;
constexpr size_t WS_RB = WS_GLGC + (size_t)GL_NCH * 128 * 4;
constexpr size_t WS_LRW = WS_RB + (size_t)RB_NCH * RB_EL * 2;
constexpr size_t WS_END = WS_LRW + (size_t)NL * 16 * 64 * 256 * 2;

__device__ __forceinline__ float bf2f(bf16_t b) { return __uint_as_float(((unsigned)b) << 16); }
__device__ __forceinline__ bf16_t f2bf(float f) { unsigned u = __float_as_uint(f); u += 0x7FFFu + ((u >> 16) & 1u); return (bf16_t)(u >> 16); }
__device__ __forceinline__ unsigned pk2(float lo, float hi) { return (unsigned)f2bf(lo) | ((unsigned)f2bf(hi) << 16); }
__device__ __forceinline__ float wave_sum(float v) {
#pragma unroll
    for (int o = 32; o > 0; o >>= 1) v += __shfl_xor(v, o, 64);
    return v;
}
__device__ __forceinline__ float wave_max(float v) {
#pragma unroll
    for (int o = 32; o > 0; o >>= 1) v = fmaxf(v, __shfl_xor(v, o, 64));
    return v;
}
__device__ __forceinline__ float sigmoidf_(float x) { return 1.0f / (1.0f + __expf(-x)); }
__device__ __forceinline__ float softplusf_(float x) { return fmaxf(x, 0.f) + log1pf(__expf(-fabsf(x))); }
__device__ __forceinline__ float softplus_fast(float x) { return fmaxf(x, 0.f) + __logf(1.0f + __expf(-fabsf(x))); }
__device__ __forceinline__ float tanh_fast(float x) { return 1.0f - 2.0f / (1.0f + __expf(2.0f * x)); }

namespace pg8 {
constexpr int BM = 256, BK = 64, HALF = 128, HTB = HALF * BK * 2, STAGE_BYTES = 8 * HTB, NXCD = 8, WGM = 8;
__host__ __device__ __forceinline__ int lds_byte(int r, int c) { const int st = (r >> 4) * 2 + (c >> 5), rr = r & 15, cc = c & 31, ob = rr * 64 + cc * 2; return st * 1024 + (ob ^ (((ob >> 9) & 1) << 5)); }
__host__ __device__ __forceinline__ void stage_rc(int b, int& R, int& C) { const int st = b / 1024, sb = b % 1024, swz = sb ^ (((sb >> 9) & 1) << 5); R = (st >> 1) * 16 + swz / 64; C = (st & 1) * 32 + (swz % 64) / 2; }
__host__ __device__ __forceinline__ int perm32(int rho) { const int n = rho >> 4, i = rho & 15; return 8 * (i >> 2) + 4 * n + (i & 3); }

struct Unit { int pm, pn, z; };
template <int LDA_, int LDB_, int K_, int NM_, int NN_, int NZ_ = 1, int NZH_ = 1, bool ZINNER_ = false, long ZSAB_ = 0, long ZSAH_ = 0, long ZSBB_ = 0, long ZSBH_ = 0>
struct Gemm {
    static constexpr int LDA = LDA_, LDB = LDB_, K = K_, NM = NM_, NN = NN_, NZ = NZ_, NZH = NZH_; static constexpr bool ZINNER = ZINNER_;
    const bf16_t* A; const bf16_t* B; int G, c;
    __device__ __forceinline__ bool next(int i, Unit& u) const {
        constexpr int nt = NM * NN; int L, z;
        if (ZINNER) { const int it = i / NZ; z = i - it * NZ; const long LL = (long)it * G + c; if (LL >= nt) return false; L = (int)LL; }
        else { const long LL = (long)i * G + c; if (LL >= (long)nt * NZ) return false; z = (int)(LL / nt); L = (int)(LL - (long)z * nt); }
        int wgid = L; { constexpr int q = nt / NXCD, r = nt % NXCD; const int xcd = wgid % NXCD, off = wgid / NXCD; wgid = (xcd < r ? xcd * (q + 1) : r * (q + 1) + (xcd - r) * q) + off; }
        constexpr int nig = WGM * NN; const int gid = wgid / nig, fm = gid * WGM, gsz = (NM - fm) < WGM ? (NM - fm) : WGM;
        u.pm = fm + ((wgid % nig) % gsz); u.pn = (wgid % nig) / gsz; u.z = z; return true;
    }
    __device__ __forceinline__ const char* a_base(const Unit& u) const { const int zb = u.z / NZH, zh = u.z - zb * NZH; return (const char*)(A + zb * ZSAB_ + zh * ZSAH_ + (long)u.pm * BM * LDA); }
    __device__ __forceinline__ const char* b_base(const Unit& u) const { const int zb = u.z / NZH, zh = u.z - zb * NZH; return (const char*)(B + zb * ZSBB_ + zh * ZSBH_ + (long)u.pn * BM * LDB); }
};

template <class GT, class Epi, bool ALIGN_EPI = true, bool SP2 = true>
__device__ __forceinline__ void gemm_phase(LAS unsigned char* lds, const int tid, const GT& g, const Epi& E) {
    const int wid = __builtin_amdgcn_readfirstlane(tid >> 6), lane = tid & 63, wr = wid >> 2, wc = wid & 3, fr = lane & 15, fq = lane >> 4;
    constexpr int nt = GT::K / BK;
    unsigned voffA[2], voffB[2];
#pragma unroll
    for (int i = 0; i < 2; ++i) { int R, C; stage_rc(tid * 16 + i * 8192, R, C); const int Rb = Epi::PERM ? ((R & ~31) + perm32(R & 31)) : R;
        voffA[i] = (unsigned)(R * GT::LDA + C) * 2u; voffB[i] = (unsigned)(Rb * GT::LDB + C) * 2u; }
    constexpr size_t kstep = (size_t)(BK * 2);
    constexpr size_t hstepA = (size_t)HALF * GT::LDA * 2, hstepB = (size_t)HALF * GT::LDB * 2;
    const unsigned ldsw = (unsigned)wid * 1024u;
    const int aoff = lds_byte(wr * 64 + fr, fq * 8), boff = lds_byte(wc * 32 + fr, fq * 8);
#define PG8_SA(b, h) (((b) * 2 + (h)) * HTB)
#define PG8_SB(b, h) ((4 + (b) * 2 + (h)) * HTB)
#define PG8_STAGE(bufoff, gbase, voff) do { _Pragma("unroll") for (int _i = 0; _i < 2; ++_i) \
        __builtin_amdgcn_global_load_lds((const unsigned*)((const char*)(gbase) + (voff)[_i]), (LAS unsigned*)(lds + (bufoff) + ldsw + _i * 8192), 16, 0, 0); } while (0)
#define PG8_LDA(dst, b, h) do { _Pragma("unroll") for (int m = 0; m < 4; ++m) _Pragma("unroll") for (int k = 0; k < 2; ++k) dst[m][k] = *(const LAS bf16x8*)(lds + PG8_SA(b, h) + aoff + m * 2048 + k * 1024); } while (0)
#define PG8_LDB(dst, b, h) do { _Pragma("unroll") for (int n = 0; n < 2; ++n) _Pragma("unroll") for (int k = 0; k < 2; ++k) dst[n][k] = *(const LAS bf16x8*)(lds + PG8_SB(b, h) + boff + n * 2048 + k * 1024); } while (0)
#define PG8_MMA(ai, bj, At, Bt) do { __builtin_amdgcn_s_setprio(1); _Pragma("unroll") for (int m = 0; m < 4; ++m) _Pragma("unroll") for (int n = 0; n < 2; ++n) _Pragma("unroll") for (int k = 0; k < 2; ++k) \
        acc[ai][bj][m][n] = __builtin_amdgcn_mfma_f32_16x16x32_bf16(Bt[n][k], At[m][k], acc[ai][bj][m][n], 0, 0, 0); __builtin_amdgcn_s_setprio(0); } while (0)
#define PG8_WAIT_V(n) asm volatile("s_waitcnt vmcnt(" #n ")" ::: "memory")
#define PG8_WAIT_L(n) asm volatile("s_waitcnt lgkmcnt(" #n ")" ::: "memory")
#define PG8_BAR __builtin_amdgcn_s_barrier()
#define PG8_SCHED __builtin_amdgcn_sched_barrier(0)
    Unit cur, nxt; int ui = 0;
    if (!g.next(0, cur)) return;
    f32x4 acc[2][2][4][2];
#pragma unroll
    for (int a = 0; a < 2; ++a)
#pragma unroll
        for (int b = 0; b < 2; ++b)
#pragma unroll
            for (int m = 0; m < 4; ++m)
#pragma unroll
                for (int n = 0; n < 2; ++n) acc[a][b][m][n] = (f32x4){0.f, 0.f, 0.f, 0.f};
    bf16x8 At[4][2], B0[2][2], B1[2][2];
    const char* cA = g.a_base(cur); const char* cB = g.b_base(cur);
    if constexpr (SP2) {
        PG8_STAGE(PG8_SB(0, 0), cB, voffB); PG8_STAGE(PG8_SB(0, 1), cB + hstepB, voffB); PG8_STAGE(PG8_SA(0, 0), cA, voffA); PG8_STAGE(PG8_SA(0, 1), cA + hstepA, voffA);
        if (wr == 1) PG8_BAR;
        PG8_WAIT_V(2); PG8_BAR;
        PG8_STAGE(PG8_SB(1, 0), cB + kstep, voffB); PG8_STAGE(PG8_SA(1, 0), cA + kstep, voffA); PG8_STAGE(PG8_SB(1, 1), cB + hstepB + kstep, voffB);
        PG8_WAIT_V(6); PG8_BAR;
    } else {
        PG8_STAGE(PG8_SB(0, 0), cB, voffB); PG8_STAGE(PG8_SA(0, 0), cA, voffA); PG8_STAGE(PG8_SB(0, 1), cB + hstepB, voffB); PG8_STAGE(PG8_SA(0, 1), cA + hstepA, voffA);
        if (wr == 1) PG8_BAR;
        PG8_WAIT_V(4); PG8_BAR;
        PG8_STAGE(PG8_SB(1, 0), cB + kstep, voffB); PG8_STAGE(PG8_SA(1, 0), cA + kstep, voffA); PG8_STAGE(PG8_SB(1, 1), cB + hstepB + kstep, voffB);
        PG8_WAIT_V(6); PG8_BAR;
    }
    for (;;) {
        const bool has_next = g.next(ui + 1, nxt);
        const char* nA = has_next ? g.a_base(nxt) : cA; const char* nB = has_next ? g.b_base(nxt) : cB;
#pragma unroll 1
        for (int t = 0; t < nt; t += 2) {
            const bool last = (t == nt - 2);
            const char* a1 = cA + (size_t)(t + 1) * kstep;
            const char* a2 = last ? nA : cA + (size_t)(t + 2) * kstep; const char* b2 = last ? nB : cB + (size_t)(t + 2) * kstep;
            const char* a3 = a2 + kstep; const char* b3 = b2 + kstep;
            if constexpr (SP2) {
            PG8_LDB(B0, 0, 0); PG8_LDB(B1, 0, 1); PG8_SCHED; PG8_LDA(At, 0, 0); PG8_STAGE(PG8_SA(1, 1), a1 + hstepA, voffA);
            PG8_WAIT_V(8); PG8_WAIT_L(0); PG8_BAR; PG8_MMA(0, 0, At, B0); PG8_MMA(0, 1, At, B1); PG8_BAR; PG8_SCHED;
            PG8_LDA(At, 0, 1); PG8_STAGE(PG8_SB(0, 0), b2, voffB); PG8_STAGE(PG8_SB(0, 1), b2 + hstepB, voffB); PG8_STAGE(PG8_SA(0, 0), a2, voffA);
            PG8_WAIT_V(8); PG8_WAIT_L(0); PG8_BAR; PG8_MMA(1, 0, At, B0); PG8_MMA(1, 1, At, B1); PG8_BAR; PG8_SCHED;
            PG8_LDB(B0, 1, 0); PG8_LDB(B1, 1, 1); PG8_SCHED; PG8_LDA(At, 1, 0); PG8_STAGE(PG8_SA(0, 1), a2 + hstepA, voffA);
            PG8_WAIT_V(8); PG8_WAIT_L(0); PG8_BAR; PG8_MMA(0, 0, At, B0); PG8_MMA(0, 1, At, B1); PG8_BAR; PG8_SCHED;
            PG8_LDA(At, 1, 1); PG8_STAGE(PG8_SB(1, 0), b3, voffB); PG8_STAGE(PG8_SB(1, 1), b3 + hstepB, voffB); PG8_STAGE(PG8_SA(1, 0), a3, voffA);
            PG8_WAIT_V(8); PG8_WAIT_L(0); PG8_BAR; PG8_MMA(1, 0, At, B0); PG8_MMA(1, 1, At, B1); PG8_BAR; PG8_SCHED;
            } else {
            PG8_LDB(B0, 0, 0); PG8_SCHED; PG8_LDA(At, 0, 0); PG8_STAGE(PG8_SA(1, 1), a1 + hstepA, voffA);
            PG8_WAIT_L(8); PG8_BAR; PG8_WAIT_L(0); PG8_MMA(0, 0, At, B0); PG8_BAR; PG8_SCHED;
            PG8_LDB(B1, 0, 1); PG8_STAGE(PG8_SB(0, 0), b2, voffB);
            PG8_BAR; PG8_WAIT_L(0); PG8_MMA(0, 1, At, B1); PG8_BAR;
            PG8_LDA(At, 0, 1); PG8_STAGE(PG8_SA(0, 0), a2, voffA);
            PG8_BAR; PG8_WAIT_L(0); PG8_MMA(1, 0, At, B0); PG8_BAR; PG8_SCHED;
            PG8_STAGE(PG8_SB(0, 1), b2 + hstepB, voffB);
            PG8_WAIT_V(6); PG8_BAR; PG8_MMA(1, 1, At, B1); PG8_BAR;
            PG8_LDB(B0, 1, 0); PG8_SCHED; PG8_LDA(At, 1, 0); PG8_STAGE(PG8_SA(0, 1), a2 + hstepA, voffA);
            PG8_WAIT_L(8); PG8_BAR; PG8_WAIT_L(0); PG8_MMA(0, 0, At, B0); PG8_BAR; PG8_SCHED;
            PG8_LDB(B1, 1, 1); PG8_STAGE(PG8_SB(1, 0), b3, voffB);
            PG8_BAR; PG8_WAIT_L(0); PG8_MMA(0, 1, At, B1); PG8_BAR;
            PG8_LDA(At, 1, 1); PG8_STAGE(PG8_SA(1, 0), a3, voffA);
            PG8_BAR; PG8_WAIT_L(0); PG8_MMA(1, 0, At, B0); PG8_BAR; PG8_SCHED;
            PG8_STAGE(PG8_SB(1, 1), b3 + hstepB, voffB);
            PG8_WAIT_V(6); PG8_BAR; PG8_MMA(1, 1, At, B1); PG8_BAR;
            }
        }
        if constexpr (ALIGN_EPI) { if (wr == 0) PG8_BAR; }
        E(acc, cur, wr, wc, fr, fq);
        if (!has_next) break;
#pragma unroll
        for (int a = 0; a < 2; ++a)
#pragma unroll
            for (int b = 0; b < 2; ++b)
#pragma unroll
                for (int m = 0; m < 4; ++m)
#pragma unroll
                    for (int n = 0; n < 2; ++n) acc[a][b][m][n] = (f32x4){0.f, 0.f, 0.f, 0.f};
        cur = nxt; cA = nA; cB = nB; ++ui;
        if constexpr (ALIGN_EPI) { if (wr == 1) PG8_BAR; }
    }
    PG8_WAIT_V(0);
    if constexpr (!ALIGN_EPI) { if (wr == 0) PG8_BAR; }
    PG8_BAR;
#undef PG8_SA
#undef PG8_SB
#undef PG8_STAGE
#undef PG8_LDA
#undef PG8_LDB
#undef PG8_MMA
#undef PG8_WAIT_V
#undef PG8_WAIT_L
#undef PG8_BAR
#undef PG8_SCHED
}

struct EpiBf16 {
    static constexpr bool PERM = true;
    bf16_t* O; long zs; int ldc, pad;
    __device__ __forceinline__ void operator()(const f32x4 (&acc)[2][2][4][2], const Unit& u, int wr, int wc, int fr, int fq) const {
        const int row0 = u.pm * BM + wr * 64 + fr, col0 = u.pn * BM + wc * 32 + 8 * fq; bf16_t* base = O + (long)u.z * zs;
#pragma unroll
        for (int ai = 0; ai < 2; ++ai)
#pragma unroll
            for (int m = 0; m < 4; ++m) { bf16_t* rowp = base + (size_t)(row0 + ai * HALF + m * 16) * ldc + col0;
#pragma unroll
                for (int bj = 0; bj < 2; ++bj) { const f32x4 v0 = acc[ai][bj][m][0], v1 = acc[ai][bj][m][1];
                    u32x4 w; w.x = pk2(v0[0], v0[1]); w.y = pk2(v0[2], v0[3]); w.z = pk2(v1[0], v1[1]); w.w = pk2(v1[2], v1[3]);
                    *(u32x4*)(rowp + bj * HALF) = w; } }
    }
};
struct EpiMem {
    static constexpr bool PERM = false;
    float* outK; float* outV; bf16_t* kb; bf16_t* vt;
    __device__ __forceinline__ void operator()(const f32x4 (&acc)[2][2][4][2], const Unit& u, int wr, int wc, int fr, int fq) const {
        const int row0 = u.pm * BM + wr * 64 + fr, col0 = u.pn * BM + wc * 32 + 4 * fq;
#pragma unroll
        for (int ai = 0; ai < 2; ++ai)
#pragma unroll
            for (int m = 0; m < 4; ++m) { const int row = row0 + ai * HALF + m * 16;
#pragma unroll
                for (int bj = 0; bj < 2; ++bj)
#pragma unroll
                    for (int n = 0; n < 2; ++n) { const int col = col0 + bj * HALF + n * 16; const f32x4 v = acc[ai][bj][m][n];
                        if (col < 1024) { *(f32x4*)(outK + ((size_t)u.z * 512 + row) * 1024 + col) = v;
                            u32x2 w; w.x = pk2(v[0], v[1]); w.y = pk2(v[2], v[3]); *(u32x2*)(kb + ((size_t)u.z * 512 + row) * 1024 + col) = w; }
                        else { const int c = col - 1024; *(f32x4*)(outV + ((size_t)u.z * 512 + row) * 1024 + c) = v;
                            const int b = row >> 8, mm = row & 255, h = c >> 8, d = c & 255; bf16_t* p = vt + ((((size_t)u.z * 2 + b) * 4 + h) * 256 + d) * 256 + mm;
                            p[0] = f2bf(v[0]); p[256] = f2bf(v[1]); p[512] = f2bf(v[2]); p[768] = f2bf(v[3]); } } }
    }
};
struct EpiMerge {
    static constexpr bool PERM = false;
    float* MG; bf16_t* MGB; const bf16_t* U; const float* gate_b;
    __device__ __forceinline__ void operator()(const f32x4 (&acc)[2][2][4][2], const Unit& u, int wr, int wc, int fr, int fq) const {
        const int row0 = u.pm * BM + wr * 64 + fr, col0 = u.pn * BM + wc * 32 + 4 * fq;
#pragma unroll
        for (int ai = 0; ai < 2; ++ai)
#pragma unroll
            for (int m = 0; m < 4; ++m) { const int row = row0 + ai * HALF + m * 16;
#pragma unroll
                for (int bj = 0; bj < 2; ++bj)
#pragma unroll
                    for (int n = 0; n < 2; ++n) { const int col = col0 + bj * HALF + n * 16; const f32x4 v = acc[ai][bj][m][n];
                        const u32x2 gp = *(const u32x2*)(U + (size_t)row * NINP + U_GP + u.z * DM + col); const f32x4 gb = *(const f32x4*)(gate_b + u.z * DM + col);
                        f32x4 gt; gt[0] = sigmoidf_(__uint_as_float(gp.x << 16) + gb[0]); gt[1] = sigmoidf_(__uint_as_float(gp.x & 0xffff0000u) + gb[1]);
                        gt[2] = sigmoidf_(__uint_as_float(gp.y << 16) + gb[2]); gt[3] = sigmoidf_(__uint_as_float(gp.y & 0xffff0000u) + gb[3]);
                        float* mp = MG + (size_t)row * DM + col; f32x4 r = gt * v;
                        if (u.z > 0) r += *(const f32x4*)mp;
                        if (u.z < 3) *(f32x4*)mp = r;
                        else { u32x2 w; w.x = pk2(r[0], r[1]); w.y = pk2(r[2], r[3]); *(u32x2*)(MGB + (size_t)row * DM + col) = w; } } }
    }
};
struct EpiRes {
    static constexpr bool PERM = false;
    const float* R; float* Y;
    __device__ __forceinline__ void operator()(const f32x4 (&acc)[2][2][4][2], const Unit& u, int wr, int wc, int fr, int fq) const {
        const int row0 = u.pm * BM + wr * 64 + fr, col0 = u.pn * BM + wc * 32 + 4 * fq;
#pragma unroll
        for (int ai = 0; ai < 2; ++ai)
#pragma unroll
            for (int m = 0; m < 4; ++m) { const size_t ro = (size_t)(row0 + ai * HALF + m * 16) * DM + col0;
#pragma unroll
                for (int bj = 0; bj < 2; ++bj)
#pragma unroll
                    for (int n = 0; n < 2; ++n) { const size_t o = ro + bj * HALF + n * 16; *(f32x4*)(Y + o) = *(const f32x4*)(R + o) * ALPHA + acc[ai][bj][m][n]; } }
    }
};
struct EpiSwiGLU {
    static constexpr bool PERM = true;
    bf16_t* O;
    __device__ __forceinline__ void operator()(const f32x4 (&acc)[2][2][4][2], const Unit& u, int wr, int wc, int fr, int fq) const {
        const int row0 = u.pm * BM + wr * 64 + fr, col0 = u.pn * HALF + wc * 32 + 8 * fq;
#pragma unroll
        for (int ai = 0; ai < 2; ++ai)
#pragma unroll
            for (int m = 0; m < 4; ++m) { bf16_t* rowp = O + (size_t)(row0 + ai * HALF + m * 16) * DFF + col0;
                float r[8];
#pragma unroll
                for (int n = 0; n < 2; ++n)
#pragma unroll
                    for (int j = 0; j < 4; ++j) { const float gg = acc[ai][0][m][n][j], uu = acc[ai][1][m][n][j]; r[n * 4 + j] = gg * sigmoidf_(gg) * uu; }
                u32x4 w; w.x = pk2(r[0], r[1]); w.y = pk2(r[2], r[3]); w.z = pk2(r[4], r[5]); w.w = pk2(r[6], r[7]);
                *(u32x4*)rowp = w; }
    }
};
struct EpiScore {
    static constexpr bool PERM = false;
    float* SC;
    __device__ __forceinline__ void operator()(const f32x4 (&acc)[2][2][4][2], const Unit& u, int wr, int wc, int fr, int fq) const {
        const int row0 = u.pm * BM + wr * 64 + fr, col0 = wc * 32 + 4 * fq; float* base = SC + (size_t)u.z * 4096 * 256;
#pragma unroll
        for (int ai = 0; ai < 2; ++ai)
#pragma unroll
            for (int m = 0; m < 4; ++m) { float* rowp = base + (size_t)(row0 + ai * HALF + m * 16) * 256 + col0;
#pragma unroll
                for (int bj = 0; bj < 2; ++bj)
#pragma unroll
                    for (int n = 0; n < 2; ++n) *(f32x4*)(rowp + bj * HALF + n * 16) = acc[ai][bj][m][n] * 0.0625f; }
    }
};
struct EpiPV {
    static constexpr bool PERM = true;
    bf16_t* O;
    __device__ __forceinline__ void operator()(const f32x4 (&acc)[2][2][4][2], const Unit& u, int wr, int wc, int fr, int fq) const {
        const int b = u.z >> 2, h = u.z & 3; const int row0 = b * PS + u.pm * BM + wr * 64 + fr, col0 = h * 256 + wc * 32 + 8 * fq;
#pragma unroll
        for (int ai = 0; ai < 2; ++ai)
#pragma unroll
            for (int m = 0; m < 4; ++m) { bf16_t* rowp = O + (size_t)(row0 + ai * HALF + m * 16) * BW + col0;
#pragma unroll
                for (int bj = 0; bj < 2; ++bj) { const f32x4 v0 = acc[ai][bj][m][0], v1 = acc[ai][bj][m][1];
                    u32x4 w; w.x = pk2(v0[0], v0[1]); w.y = pk2(v0[2], v0[3]); w.z = pk2(v1[0], v1[1]); w.w = pk2(v1[2], v1[3]);
                    *(u32x4*)(rowp + bj * HALF) = w; } }
    }
};
}


#define XB_TMO      128
#define XB_XCNT(j)  (256  + 64 * (j))
#define XB_XSUB(j)  (1280 + 64 * (j))
#define XB_XGEN(j)  (2304 + 64 * (j))
#define XB_TOP      3328
#define XB_TOPGEN   3392
#define XCD_BAR_WORDS 3456
#define XB_SPIN_CAP (1u << 18)
__device__ __forceinline__ unsigned xb_ld(unsigned* p)              { return __hip_atomic_load(p, __ATOMIC_RELAXED, __HIP_MEMORY_SCOPE_AGENT); }
__device__ __forceinline__ unsigned xb_add(unsigned* p, unsigned v) { return __hip_atomic_fetch_add(p, v, __ATOMIC_RELAXED, __HIP_MEMORY_SCOPE_AGENT); }
__device__ __forceinline__ unsigned xb_xcc_id() { return (unsigned)__builtin_amdgcn_s_getreg((3 << 11) | 20) & 0xFu; }
#define XB_SPIN(cond, bar) do { unsigned _sp = 0; while (cond) { __builtin_amdgcn_s_sleep(1); \
    if ((++_sp & 255u) == 0u) { if (xb_ld(&(bar)[XB_TMO])) break; if (_sp > XB_SPIN_CAP) { atomicAdd(&(bar)[XB_TMO], 1u); break; } } } } while (0)
struct XcdBarrier { unsigned* bar; unsigned x; volatile LAS unsigned* st; };
__device__ __forceinline__ XcdBarrier xcd_barrier_post(unsigned* bar, volatile LAS unsigned* st) {
    XcdBarrier b; b.bar = bar; b.x = xb_xcc_id(); b.st = st;
    if (threadIdx.x == 0) (void)xb_add(&bar[XB_XCNT(b.x)], 1u);
    return b;
}
__device__ __forceinline__ void xcd_barrier_complete(unsigned* bar, unsigned x, unsigned& nloc, unsigned& nx) {
    const unsigned G = gridDim.x * gridDim.y * gridDim.z;
    unsigned sum, cnt, mine, sp = 0u;
    for (;;) {
        sum = 0u; cnt = 0u; mine = 0u;
#pragma unroll
        for (unsigned j = 0; j < 16; ++j) { const unsigned c = xb_ld(&bar[XB_XCNT(j)]); sum += c; cnt += (c > 0u) ? 1u : 0u; mine = (j == x) ? c : mine; }
        if (sum == G) break;
        __builtin_amdgcn_s_sleep(1);
        if ((++sp & 255u) == 0u) { if (xb_ld(&bar[XB_TMO])) break; if (sp > XB_SPIN_CAP) { atomicAdd(&bar[XB_TMO], 1u); break; } }
    }
    nloc = mine > 0u ? mine : 1u; nx = cnt > 0u ? cnt : 1u;
}
__device__ __forceinline__ void xcd_barrier(const XcdBarrier& b) {
    asm volatile("s_waitcnt vmcnt(0)" ::: "memory");
    __syncthreads();
    if (threadIdx.x == 0) {
        unsigned* bar = b.bar;
        __builtin_amdgcn_s_waitcnt(0);
        unsigned nloc = b.st[0], nx = b.st[1];
        if (nloc == 0u) { xcd_barrier_complete(bar, b.x, nloc, nx); b.st[0] = nloc; b.st[1] = nx; }
        const unsigned old = xb_add(&bar[XB_XSUB(b.x)], 1u);
        const unsigned gen = old / nloc;
        if (old + 1u == (gen + 1u) * nloc) {
            __builtin_amdgcn_fence(__ATOMIC_RELEASE, "agent");
            asm volatile("s_waitcnt vmcnt(0)" ::: "memory");
            const unsigned og = xb_add(&bar[XB_TOP], 1u);
            const unsigned tg = og / nx;
            if (og + 1u == (tg + 1u) * nx) xb_add(&bar[XB_TOPGEN], 1u);
            else XB_SPIN(xb_ld(&bar[XB_TOPGEN]) == tg, bar);
            __builtin_amdgcn_fence(__ATOMIC_ACQUIRE, "agent");
            xb_add(&bar[XB_XGEN(b.x)], 1u);
            asm volatile("s_waitcnt vmcnt(0)" ::: "memory");
        } else {
            XB_SPIN(xb_ld(&bar[XB_XGEN(b.x)]) == gen, bar);
            __builtin_amdgcn_fence(__ATOMIC_ACQUIRE, "agent");
            asm volatile("s_waitcnt vmcnt(0)" ::: "memory");
        }
    }
    __syncthreads();
}

struct Ctx { int tid, lane, wave, bid, G; LAS unsigned char* lds; };
__device__ __forceinline__ Ctx fresh(const Ctx& c0) { Ctx c; c.wave = c0.wave; c.bid = c0.bid; c.G = c0.G; c.lds = c0.lds; asm volatile("" : "+s"(c.bid), "+s"(c.G), "+s"(c.wave));
    int lane = (int)__builtin_amdgcn_mbcnt_hi(~0u, __builtin_amdgcn_mbcnt_lo(~0u, 0u)); asm volatile("" : "+v"(lane)); c.lane = lane; c.tid = c.wave * 64 + lane; return c; }

__device__ __forceinline__ int colmap(int mode, int n) {
    if (mode == 1) return n < 3088 ? n : (n < 3328 ? -1 : n - 240);
    if (mode == 2) { const int t = n >> 8, j = n & 255; return j < 128 ? t * 128 + j : DFF + t * 128 + (j - 128); }
    return n;
}
__device__ __forceinline__ void wprep_load(f32x4 (&rg)[8], const float* __restrict__ src, int K, int Nsrc, int Ndst, int mode, size_t sbs, int item, int tid) {
    const int nx = Ndst / 256, ny = K / 64; const int bx = item % nx, by = (item / nx) % ny, bz = item / (nx * ny);
    const int tx = tid & 63, ty = tid >> 6, cm = colmap(mode, bx * 256 + tx * 4); const float* s = src + (size_t)bz * sbs + (size_t)(by * 64 + ty) * Nsrc + cm;
#pragma unroll
    for (int i = 0; i < 8; ++i) rg[i] = cm >= 0 ? *(const f32x4*)(s + (size_t)(8 * i) * Nsrc) : (f32x4){0.f, 0.f, 0.f, 0.f};
}
__device__ __forceinline__ void ph_wprep(const Ctx& c, const float* __restrict__ src, bf16_t* __restrict__ dst, int K, int Nsrc, int Ndst, int mode, int nbatch, size_t sbs, size_t dbs) {
    LAS float* tile = (LAS float*)c.lds;
    const int nx = Ndst / 256, ny = K / 64, total = nx * ny * nbatch;
    const int tid = c.tid, tx = tid & 63, ty = tid >> 6, n = tid >> 1, kh = tid & 1;
    f32x4 rg[8];
    int item = c.bid;
    if (item < total) wprep_load(rg, src, K, Nsrc, Ndst, mode, sbs, item, tid);
    for (; item < total; item += c.G) {
        __syncthreads();
#pragma unroll
        for (int i = 0; i < 8; ++i) *(LAS f32x4*)(tile + (ty + 8 * i) * 260 + tx * 4) = rg[i];
        __syncthreads();
        const int bx = item % nx, by = (item / nx) % ny, bz = item / (nx * ny);
        if (item + c.G < total) wprep_load(rg, src, K, Nsrc, Ndst, mode, sbs, item + c.G, tid);
        bf16_t* d = dst + (size_t)bz * dbs + (size_t)(bx * 256 + n) * K + by * 64 + kh * 32;
#pragma unroll
        for (int g = 0; g < 4; ++g) { unsigned p[4];
#pragma unroll
            for (int e = 0; e < 4; ++e) p[e] = pk2(tile[(kh * 32 + g * 8 + 2 * e) * 260 + n], tile[(kh * 32 + g * 8 + 2 * e + 1) * 260 + n]);
            *(u32x4*)(d + g * 8) = (u32x4){p[0], p[1], p[2], p[3]}; }
    }
    __syncthreads();
}
__device__ __forceinline__ void ph_xprep(const Ctx& c, const float* __restrict__ xp, const float* __restrict__ xs, const float* __restrict__ mem, float* __restrict__ HF, bf16_t* __restrict__ HB, bf16_t* __restrict__ MEMB) {
    const size_t nH = (size_t)MPAD * DM / 4, nM = (size_t)512 * DM / 4;
    for (size_t i4 = (size_t)c.bid * 512 + c.tid; i4 < nH + nM; i4 += (size_t)c.G * 512) {
        if (i4 < nH) {
            const size_t e = i4 * 4; f32x4 v = (f32x4){0.f, 0.f, 0.f, 0.f};
            if (e < (size_t)MP * DM) v = *(const f32x4*)(xp + e); else if (e < (size_t)MT * DM) v = *(const f32x4*)(xs + (e - (size_t)MP * DM));
            *(f32x4*)(HF + e) = v; u32x2 w; w.x = pk2(v[0], v[1]); w.y = pk2(v[2], v[3]); *(u32x2*)(HB + e) = w;
        } else {
            const size_t e = (i4 - nH) * 4; const f32x4 v = *(const f32x4*)(mem + e); u32x2 w; w.x = pk2(v[0], v[1]); w.y = pk2(v[2], v[3]); *(u32x2*)(MEMB + e) = w;
        }
    }
}
__device__ __forceinline__ void ph_ln(const Ctx& c, const float* __restrict__ Y, const float* __restrict__ g, const float* __restrict__ b, float* __restrict__ XF, bf16_t* __restrict__ XB, float* __restrict__ OUT, int nrows, int nout) {
    const int lane = c.lane;
    for (int row = c.bid * 8 + c.wave; row < nrows; row += c.G * 8) {
        const float* y = Y + (size_t)row * DM; f32x4 v[8]; float s = 0.f;
#pragma unroll
        for (int j = 0; j < 8; ++j) { v[j] = *(const f32x4*)(y + j * 256 + lane * 4); s += (v[j][0] + v[j][1]) + (v[j][2] + v[j][3]); }
        const float mean = wave_sum(s) * (1.0f / DM); float q = 0.f;
#pragma unroll
        for (int j = 0; j < 8; ++j) { const f32x4 d = v[j] - mean; q += (d[0] * d[0] + d[1] * d[1]) + (d[2] * d[2] + d[3] * d[3]); }
        const float rstd = rsqrtf(wave_sum(q) * (1.0f / DM) + 1e-5f);
#pragma unroll
        for (int j = 0; j < 8; ++j) { const int cc = j * 256 + lane * 4; const f32x4 gg = *(const f32x4*)(g + cc), bb = *(const f32x4*)(b + cc);
            const f32x4 o = (v[j] - mean) * rstd * gg + bb; const size_t off = (size_t)row * DM + cc;
            *(f32x4*)(XF + off) = o; u32x2 w; w.x = pk2(o[0], o[1]); w.y = pk2(o[2], o[3]); *(u32x2*)(XB + off) = w;
            if (OUT != nullptr && row < nout) *(f32x4*)(OUT + off) = o; }
    }
}
__device__ __forceinline__ void ph_softmax256(const Ctx& c, const float* __restrict__ SC, bf16_t* __restrict__ P, int nrows) {
    const int lane = c.lane;
    for (int row = c.bid * 8 + c.wave; row < nrows; row += c.G * 8) {
        const f32x4 v = *(const f32x4*)(SC + (size_t)row * 256 + lane * 4);
        const float mx = wave_max(fmaxf(fmaxf(v[0], v[1]), fmaxf(v[2], v[3])));
        f32x4 e; e[0] = __expf(v[0] - mx); e[1] = __expf(v[1] - mx); e[2] = __expf(v[2] - mx); e[3] = __expf(v[3] - mx);
        const float inv = 1.0f / wave_sum((e[0] + e[1]) + (e[2] + e[3]));
        u32x2 w; w.x = pk2(e[0] * inv, e[1] * inv); w.y = pk2(e[2] * inv, e[3] * inv); *(u32x2*)(P + (size_t)row * 256 + lane * 4) = w;
    }
}
__device__ __forceinline__ void ph_copy_outs(const Ctx& c, const bf16_t* __restrict__ U, const float* __restrict__ ck, const float* __restrict__ cv, float* __restrict__ out, int layer) {
    constexpr int nA = PB * 128 * 128, nB = SB * 128 * 128, nC = PB * RWC, nD = SB * RWC;
    for (int i = c.bid * 512 + c.tid; i < nA + nB + nC + nD; i += c.G * 512) {
        if (i < nA) { const int b = i / 16384, j = (i >> 7) & 127, cc = i & 127; const size_t ur = (size_t)(b * PS + PS - 128 + j) * NINP;
            out[O_SWKP + (size_t)layer * nA + i] = bf2f(U[ur + U_SK + cc]); out[O_SWVP + (size_t)layer * nA + i] = bf2f(U[ur + U_SV + cc]); continue; }
        int k = i - nA;
        if (k < nB) { const int sq = k / 16384, j = (k >> 7) & 127, cc = k & 127; float kv, vv;
            if (j < 124) { const size_t o = ((size_t)sq * 128 + j + 4) * 128 + cc; kv = ck[o]; vv = cv[o]; }
            else { const size_t ur = (size_t)(MP + sq * SS + j - 124) * NINP; kv = bf2f(U[ur + U_SK + cc]); vv = bf2f(U[ur + U_SV + cc]); }
            out[O_SWKS + (size_t)layer * nB + k] = kv; out[O_SWVS + (size_t)layer * nB + k] = vv; continue; }
        k -= nB;
        if (k < nC) { const int b = k / RWC, cc = k - b * RWC; out[O_RSP + (size_t)layer * nC + k] = bf2f(U[(size_t)(b * PS + PS - 1) * NINP + U_RU + cc]); continue; }
        k -= nC;
        { const int sq = k / RWC, cc = k - sq * RWC; out[O_RSS + (size_t)layer * nD + k] = bf2f(U[(size_t)(MP + sq * SS + SS - 1) * NINP + U_RU + cc]); }
    }
}

__device__ __forceinline__ void seq_info(int sq, int& row0, int& L) { if (sq < PB) { row0 = sq * PS; L = PS; } else { row0 = MP + (sq - PB) * SS; L = SS; } }

__device__ __forceinline__ void ph_gla_naive(const Ctx& c, const bf16_t* __restrict__ U, const float* __restrict__ s0, const float* __restrict__ a_up, const float* __restrict__ a_b,
                                             const float* __restrict__ ng, const float* __restrict__ nb, bf16_t* __restrict__ OB, float* __restrict__ outP, float* __restrict__ outS) {
    LAS float* qs = (LAS float*)c.lds;
    LAS float* ks = qs + 16 * 128; LAS float* as = ks + 16 * 128; LAS float* os = as + 16 * 128;
    const int kh = c.tid >> 8, vt = c.tid & 255, lane = c.lane;
    for (int u = c.bid; u < (PB + SB) * 4; u += c.G) {
        const int sq = u >> 2, h = u & 3;
        int row0, L; seq_info(sq, row0, L);
        float S[64];
        if (sq >= PB) { const float* p = s0 + (((size_t)(sq - PB) * 4 + h) * 128 + kh * 64) * 256 + vt;
#pragma unroll
            for (int kk = 0; kk < 64; ++kk) S[kk] = p[(size_t)kk * 256]; }
        else {
#pragma unroll
            for (int kk = 0; kk < 64; ++kk) S[kk] = 0.f; }
        for (int t0 = 0; t0 < L; t0 += 16) {
            const int nT = (L - t0) < 16 ? (L - t0) : 16;
            for (int idx = c.tid; idx < nT * 128; idx += 512) {
                const int tt = idx >> 7, kk = idx & 127; const bf16_t* ur = U + (size_t)(row0 + t0 + tt) * NINP;
                qs[idx] = bf2f(ur[U_GQ + h * 128 + kk]) * 0.08838834764831845f; ks[idx] = bf2f(ur[U_GK + h * 128 + kk]);
                float x = a_b[h * 128 + kk];
#pragma unroll
                for (int r = 0; r < 16; ++r) x += bf2f(ur[U_GA + r]) * a_up[r * 512 + h * 128 + kk];
                const float ls = (fminf(x, 0.f) - log1pf(__expf(-fabsf(x)))) * (1.0f / 16.0f);
                as[idx] = __expf(ls);
            }
            __syncthreads();
            for (int tt = 0; tt < nT; ++tt) {
                const float v = bf2f(U[(size_t)(row0 + t0 + tt) * NINP + U_GV + h * 256 + vt]); float o = 0.f; const int lb = tt * 128 + kh * 64;
#pragma unroll
                for (int kk = 0; kk < 64; ++kk) { S[kk] = as[lb + kk] * S[kk] + ks[lb + kk] * v; o += qs[lb + kk] * S[kk]; }
                os[(kh * 16 + tt) * 256 + vt] = o;
            }
            __syncthreads();
            for (int tt = c.wave; tt < nT; tt += 8) {
                float x[4]; float s = 0.f;
#pragma unroll
                for (int j = 0; j < 4; ++j) { x[j] = os[tt * 256 + lane + 64 * j] + os[(16 + tt) * 256 + lane + 64 * j]; s += x[j]; }
                const float mean = wave_sum(s) * (1.0f / 256.0f); float q = 0.f;
#pragma unroll
                for (int j = 0; j < 4; ++j) { const float d = x[j] - mean; q += d * d; }
                const float rstd = rsqrtf(wave_sum(q) * (1.0f / 256.0f) + 1e-5f);
                const size_t row = (size_t)(row0 + t0 + tt);
#pragma unroll
                for (int j = 0; j < 4; ++j) { const int cc = h * 256 + lane + 64 * j; const float n = (x[j] - mean) * rstd * ng[cc] + nb[cc];
                    const float gr = bf2f(U[row * NINP + U_GR + cc]); OB[row * BW + cc] = f2bf(n * gr * sigmoidf_(gr)); }
            }
            __syncthreads();
        }
        float* op = (sq < PB ? outP + (((size_t)sq * 4 + h) * 128 + kh * 64) * 256 : outS + (((size_t)(sq - PB) * 4 + h) * 128 + kh * 64) * 256) + vt;
#pragma unroll
        for (int kk = 0; kk < 64; ++kk) op[(size_t)kk * 256] = S[kk];
    }
}

__device__ __forceinline__ f32x4 mma16(bf16x8 x, bf16x8 y, f32x4 c) { return __builtin_amdgcn_mfma_f32_16x16x32_bf16(x, y, c, 0, 0, 0); }
__device__ __forceinline__ bf16x8 pack_acc(const f32x4& a, const f32x4& b) {
    u32x4 p; p.x = pk2(a[0], a[1]); p.y = pk2(a[2], a[3]); p.z = pk2(b[0], b[1]); p.w = pk2(b[2], b[3]); return __builtin_bit_cast(bf16x8, p);
}
__device__ __forceinline__ void gla_chunk_info(int u, int& row0, int& ntok, int& h) {
    if (u < 512) { const int b = u >> 8; h = (u >> 6) & 3; row0 = b * PS + (u & 63) * 64; ntok = 64; }
    else { const int s = u - 512; h = s & 3; row0 = MP + (s >> 2) * SS; ntok = SS; }
}
__device__ __forceinline__ void ph_gla_pre(const Ctx& c, const bf16_t* __restrict__ U, const float* __restrict__ a_up, const float* __restrict__ a_b,
                                           bf16_t* __restrict__ QD, bf16_t* __restrict__ KHT, bf16_t* __restrict__ EE, bf16_t* __restrict__ VT, float* __restrict__ GC) {
    LAS float* ga_l = (LAS float*)c.lds;
    LAS float* tot = ga_l + 64 * 16;
    LAS bf16_t* Qd_l = (LAS bf16_t*)(tot + 4 * 128);
    LAS bf16_t* Kn_l = Qd_l + 64 * 136;
    LAS bf16_t* v_l = Kn_l + 64 * 136;
    const int tid = c.tid, lane = c.lane, r = lane & 15, q = lane >> 4, w = c.wave;
    for (int u = c.bid; u < GL_NCH; u += c.G) {
        int row0, ntok, h; gla_chunk_info(u, row0, ntok, h);
        for (int i = tid; i < 64 * 16; i += 512) { const int t = i >> 4, rr = i & 15; ga_l[i] = t < ntok ? bf2f(U[(size_t)(row0 + t) * NINP + U_GA + rr]) : 0.f; }
        for (int i = tid; i < 64 * 32; i += 512) { const int t = i >> 5, c8 = i & 31; u32x4 vv = (u32x4){0u, 0u, 0u, 0u};
            if (t < ntok) vv = *(const u32x4*)(U + (size_t)(row0 + t) * NINP + U_GV + h * 256 + c8 * 8);
            *(LAS u32x4*)(v_l + t * 264 + c8 * 8) = vv; }
        __syncthreads();
        const int kk = tid & 127, tq = tid >> 7;
        float cum[16];
        { float aup[16];
#pragma unroll
          for (int rr = 0; rr < 16; ++rr) aup[rr] = a_up[rr * 512 + h * 128 + kk];
          const float ab = a_b[h * 128 + kk]; float run = 0.f;
#pragma unroll
          for (int j = 0; j < 16; ++j) { const int t = tq * 16 + j; float x = ab;
#pragma unroll
              for (int rr = 0; rr < 16; ++rr) x += ga_l[t * 16 + rr] * aup[rr];
              const float la = t < ntok ? (fminf(x, 0.f) - log1pf(__expf(-fabsf(x)))) * (1.0f / 16.0f) : 0.f;
              run += la; cum[j] = run; }
          tot[tq * 128 + kk] = run; }
        __syncthreads();
        { float prefix = 0.f, bC = 0.f;
#pragma unroll
          for (int g = 0; g < 4; ++g) { const float tv = tot[g * 128 + kk]; bC += tv; if (g < tq) prefix += tv; }
          unsigned khp[8];
#pragma unroll
          for (int j = 0; j < 16; j += 2) { float kh2[2];
#pragma unroll
              for (int e = 0; e < 2; ++e) { const int t = tq * 16 + j + e; const float b = prefix + cum[j + e]; float qv = 0.f, kv = 0.f;
                  if (t < ntok) { const bf16_t* ur = U + (size_t)(row0 + t) * NINP; qv = bf2f(ur[U_GQ + h * 128 + kk]); kv = bf2f(ur[U_GK + h * 128 + kk]); }
                  Qd_l[t * 136 + kk] = f2bf(qv * __expf(b) * 0.08838834764831845f); Kn_l[t * 136 + kk] = f2bf(kv * __expf(-b)); kh2[e] = kv * __expf(bC - b); }
              khp[j >> 1] = pk2(kh2[0], kh2[1]); }
          bf16_t* kp = KHT + (size_t)u * 8192 + kk * 64 + tq * 16;
          *(u32x4*)kp = (u32x4){khp[0], khp[1], khp[2], khp[3]}; *(u32x4*)(kp + 8) = (u32x4){khp[4], khp[5], khp[6], khp[7]};
          if (tq == 0) GC[(size_t)u * 128 + kk] = __expf(bC); }
        __syncthreads();
        { const int tb = w >> 1;
#pragma unroll
          for (int e = 0; e < 2; ++e) { const int ib = (w & 1) * 2 + e; f32x4 d = (f32x4){0.f, 0.f, 0.f, 0.f};
              if (ib <= tb) {
#pragma unroll
                  for (int ks = 0; ks < 4; ++ks) d = mma16(*(const LAS bf16x8*)(Kn_l + (ib * 16 + r) * 136 + ks * 32 + q * 8), *(const LAS bf16x8*)(Qd_l + (tb * 16 + r) * 136 + ks * 32 + q * 8), d); }
              const int t = tb * 16 + r, i0 = ib * 16 + q * 4;
#pragma unroll
              for (int jj = 0; jj < 4; ++jj) if (i0 + jj > t) d[jj] = 0.f;
              u32x2 o; o.x = pk2(d[0], d[1]); o.y = pk2(d[2], d[3]); *(u32x2*)(EE + (size_t)u * 4096 + t * 64 + i0) = o; } }
        for (int i = tid; i < 64 * 16; i += 512) { const int t = i >> 4, c8 = i & 15; *(u32x4*)(QD + (size_t)u * 8192 + t * 128 + c8 * 8) = *(const LAS u32x4*)(Qd_l + t * 136 + c8 * 8); }
        { const int val = tid & 255, th = tid >> 8;
#pragma unroll
          for (int tg = 0; tg < 4; ++tg) { const int t0 = th * 32 + tg * 8; unsigned p4[4];
#pragma unroll
              for (int e = 0; e < 4; ++e) p4[e] = (unsigned)v_l[(t0 + 2 * e) * 264 + val] | ((unsigned)v_l[(t0 + 2 * e + 1) * 264 + val] << 16);
              *(u32x4*)(VT + (size_t)u * 16384 + val * 64 + t0) = (u32x4){p4[0], p4[1], p4[2], p4[3]}; } }
        __syncthreads();
    }
}
struct GlaStage { u32x4 qd[2], kh[2], e, vt, gc; };
__device__ __forceinline__ void gla_stage_load(GlaStage& s, const bf16_t* __restrict__ QD, const bf16_t* __restrict__ KHT, const bf16_t* __restrict__ EE, const bf16_t* __restrict__ VT, const float* __restrict__ GC,
                                               int ch, int sl, int tid) {
    const bf16_t* qp = QD + (size_t)ch * 8192 + tid * 8; s.qd[0] = *(const u32x4*)qp; s.qd[1] = *(const u32x4*)(qp + 4096);
    const bf16_t* kp = KHT + (size_t)ch * 8192 + tid * 8; s.kh[0] = *(const u32x4*)kp; s.kh[1] = *(const u32x4*)(kp + 4096);
    s.e = *(const u32x4*)(EE + (size_t)ch * 4096 + tid * 8);
    s.vt = *(const u32x4*)(VT + (size_t)ch * 16384 + sl * 4096 + tid * 8);
    if (tid < 32) s.gc = *(const u32x4*)(GC + (size_t)ch * 128 + tid * 4);
}
constexpr int GS_KH = 8704, GS_E = 17920, GS_VT = 22528, GS_GC = 27136, GS_EL = 27392;
__device__ __forceinline__ void gla_stage_store(const GlaStage& s, LAS bf16_t* b, int tid) {
    *(LAS u32x4*)(b + (tid >> 4) * 136 + (tid & 15) * 8) = s.qd[0]; *(LAS u32x4*)(b + (32 + (tid >> 4)) * 136 + (tid & 15) * 8) = s.qd[1];
    *(LAS u32x4*)(b + GS_KH + (tid >> 3) * 72 + (tid & 7) * 8) = s.kh[0]; *(LAS u32x4*)(b + GS_KH + (64 + (tid >> 3)) * 72 + (tid & 7) * 8) = s.kh[1];
    *(LAS u32x4*)(b + GS_E + (tid >> 3) * 72 + (tid & 7) * 8) = s.e; *(LAS u32x4*)(b + GS_VT + (tid >> 3) * 72 + (tid & 7) * 8) = s.vt;
    if (tid < 32) *(LAS u32x4*)(b + GS_GC + tid * 8) = s.gc;
}
__device__ __forceinline__ void ph_gla_seq(const Ctx& c, int boff, const bf16_t* __restrict__ QD, const bf16_t* __restrict__ KHT, const bf16_t* __restrict__ EE, const bf16_t* __restrict__ VT, const float* __restrict__ GC,
                                           const float* __restrict__ s0, float* __restrict__ outP, float* __restrict__ outS, bf16_t* __restrict__ OB) {
    LAS bf16_t* stg = (LAS bf16_t*)c.lds;
    LAS bf16_t* T_l = stg + 2 * GS_EL;
    const int tid = c.tid, lane = c.lane, r = lane & 15, q = lane >> 4, w = c.wave;
    for (int u = (c.bid - boff + c.G) % c.G; u < 32 + 512; u += c.G) {
        int h, sl, nch, ch0, row0, ntok; const float* sp = nullptr; float* op;
        if (u < 32) { const int b = u >> 4; h = (u >> 2) & 3; sl = u & 3; nch = 64; ch0 = (b * 4 + h) * 64; row0 = b * PS; ntok = 64; op = outP + (size_t)(b * 4 + h) * 32768; }
        else { const int s = u - 32, sq = s >> 4; h = (s >> 2) & 3; sl = s & 3; nch = 1; ch0 = 512 + sq * 4 + h; row0 = MP + sq * SS; ntok = SS; sp = s0 + (size_t)(sq * 4 + h) * 32768; op = outS + (size_t)(sq * 4 + h) * 32768; }
        f32x4 acc[4];
#pragma unroll
        for (int vb = 0; vb < 4; ++vb)
#pragma unroll
            for (int jj = 0; jj < 4; ++jj) acc[vb][jj] = sp ? sp[(size_t)(w * 16 + q * 4 + jj) * 256 + sl * 64 + vb * 16 + r] : 0.f;
        GlaStage R0, R1, R2;
        gla_stage_load(R0, QD, KHT, EE, VT, GC, ch0, sl, tid);
        if (1 < nch) gla_stage_load(R1, QD, KHT, EE, VT, GC, ch0 + 1, sl, tid);
        if (2 < nch) gla_stage_load(R2, QD, KHT, EE, VT, GC, ch0 + 2, sl, tid);
        __syncthreads();
        gla_stage_store(R0, stg, tid);
        if (3 < nch) gla_stage_load(R0, QD, KHT, EE, VT, GC, ch0 + 3, sl, tid);
#define GLA_STEP(ci, RN) do { \
            LAS bf16_t* Tb = T_l + ((ci) & 1) * 64 * 136; const LAS bf16_t* sb = stg + ((ci) & 1) * GS_EL; \
            _Pragma("unroll") for (int vb = 0; vb < 4; ++vb) { u32x2 o; o.x = pk2(acc[vb][0], acc[vb][1]); o.y = pk2(acc[vb][2], acc[vb][3]); *(LAS u32x2*)(Tb + (vb * 16 + r) * 136 + w * 16 + q * 4) = o; } \
            __syncthreads(); \
            if ((ci) + 1 < nch) { gla_stage_store(RN, stg + (((ci) + 1) & 1) * GS_EL, tid); if ((ci) + 4 < nch) gla_stage_load(RN, QD, KHT, EE, VT, GC, ch0 + (ci) + 4, sl, tid); } \
            { const int rb = w >> 1, t = rb * 16 + r; bf16x8 qf[4], ef[2]; \
              _Pragma("unroll") for (int ks = 0; ks < 4; ++ks) qf[ks] = *(const LAS bf16x8*)(sb + (rb * 16 + r) * 136 + ks * 32 + q * 8); \
              _Pragma("unroll") for (int ks = 0; ks < 2; ++ks) ef[ks] = *(const LAS bf16x8*)(sb + GS_E + (rb * 16 + r) * 72 + ks * 32 + q * 8); \
              _Pragma("unroll") for (int e2 = 0; e2 < 2; ++e2) { const int cb = (w & 1) * 2 + e2; f32x4 y = (f32x4){0.f, 0.f, 0.f, 0.f}; \
                  _Pragma("unroll") for (int ks = 0; ks < 4; ++ks) y = mma16(*(const LAS bf16x8*)(Tb + (cb * 16 + r) * 136 + ks * 32 + q * 8), qf[ks], y); \
                  _Pragma("unroll") for (int ks = 0; ks < 2; ++ks) y = mma16(*(const LAS bf16x8*)(sb + GS_VT + (cb * 16 + r) * 72 + ks * 32 + q * 8), ef[ks], y); \
                  if (t < ntok) { u32x2 o; o.x = pk2(y[0], y[1]); o.y = pk2(y[2], y[3]); *(u32x2*)(OB + (size_t)(row0 + (ci) * 64 + t) * BW + h * 256 + sl * 64 + cb * 16 + q * 4) = o; } } } \
            { const f32x4 gcv = *(const LAS f32x4*)((const LAS float*)(sb + GS_GC) + w * 16 + q * 4); bf16x8 kf[2]; \
              _Pragma("unroll") for (int ks = 0; ks < 2; ++ks) kf[ks] = *(const LAS bf16x8*)(sb + GS_KH + (w * 16 + r) * 72 + ks * 32 + q * 8); \
              _Pragma("unroll") for (int vb = 0; vb < 4; ++vb) { acc[vb] = acc[vb] * gcv; \
                  _Pragma("unroll") for (int ks = 0; ks < 2; ++ks) acc[vb] = mma16(kf[ks], *(const LAS bf16x8*)(sb + GS_VT + (vb * 16 + r) * 72 + ks * 32 + q * 8), acc[vb]); } } \
        } while (0)
#pragma unroll 1
        for (int ci = 0; ci < nch; ci += 3) {
            GLA_STEP(ci, R1);
            if (ci + 1 < nch) GLA_STEP(ci + 1, R2);
            if (ci + 2 < nch) GLA_STEP(ci + 2, R0);
        }
#undef GLA_STEP
#pragma unroll
        for (int vb = 0; vb < 4; ++vb)
#pragma unroll
            for (int jj = 0; jj < 4; ++jj) op[(size_t)(w * 16 + q * 4 + jj) * 256 + sl * 64 + vb * 16 + r] = acc[vb][jj];
        __syncthreads();
    }
}
__device__ __forceinline__ void ph_gla_fin(const Ctx& c, const bf16_t* __restrict__ U, const float* __restrict__ ng, const float* __restrict__ nb, bf16_t* __restrict__ OB) {
    const int lane = c.lane;
    for (int i = c.bid * 8 + c.wave; i < MT * 4; i += c.G * 8) {
        const int row = i >> 2, h = i & 3, cc = h * 256 + lane * 4; bf16_t* p = OB + (size_t)row * BW + cc;
        const u32x2 raw = *(const u32x2*)p; float x[4] = {__uint_as_float(raw.x << 16), __uint_as_float(raw.x & 0xffff0000u), __uint_as_float(raw.y << 16), __uint_as_float(raw.y & 0xffff0000u)};
        const float mean = wave_sum((x[0] + x[1]) + (x[2] + x[3])) * (1.0f / 256.0f); float qq = 0.f;
#pragma unroll
        for (int j = 0; j < 4; ++j) { const float d = x[j] - mean; qq += d * d; }
        const float rstd = rsqrtf(wave_sum(qq) * (1.0f / 256.0f) + 1e-5f);
        const u32x2 gp = *(const u32x2*)(U + (size_t)row * NINP + U_GR + cc); const float gr[4] = {__uint_as_float(gp.x << 16), __uint_as_float(gp.x & 0xffff0000u), __uint_as_float(gp.y << 16), __uint_as_float(gp.y & 0xffff0000u)};
        const f32x4 gg = *(const f32x4*)(ng + cc), bb = *(const f32x4*)(nb + cc); float o[4];
#pragma unroll
        for (int j = 0; j < 4; ++j) o[j] = ((x[j] - mean) * rstd * gg[j] + bb[j]) * gr[j] * sigmoidf_(gr[j]);
        u32x2 ov; ov.x = pk2(o[0], o[1]); ov.y = pk2(o[2], o[3]); *(u32x2*)p = ov;
    }
}

__device__ __forceinline__ void unpack8(const u32x4 w, float (&x)[8]) {
    x[0] = __uint_as_float(w.x << 16); x[1] = __uint_as_float(w.x & 0xffff0000u); x[2] = __uint_as_float(w.y << 16); x[3] = __uint_as_float(w.y & 0xffff0000u);
    x[4] = __uint_as_float(w.z << 16); x[5] = __uint_as_float(w.z & 0xffff0000u); x[6] = __uint_as_float(w.w << 16); x[7] = __uint_as_float(w.w & 0xffff0000u);
}
template <bool ISBF> __device__ __forceinline__ void swa_step(const float (&q)[32], float (&acc)[32], float& m, float& l, const void* kp, const void* vp, float slope, float dist) {
    float s = 0.f;
#pragma unroll
    for (int j = 0; j < 4; ++j) { float x[8];
        if (ISBF) unpack8(*(const u32x4*)((const bf16_t*)kp + j * 8), x);
        else { const f32x4 a = *(const f32x4*)((const float*)kp + j * 8), b = *(const f32x4*)((const float*)kp + j * 8 + 4); x[0] = a[0]; x[1] = a[1]; x[2] = a[2]; x[3] = a[3]; x[4] = b[0]; x[5] = b[1]; x[6] = b[2]; x[7] = b[3]; }
#pragma unroll
        for (int d = 0; d < 8; ++d) s += q[j * 8 + d] * x[d]; }
    s += __shfl_xor(s, 1, 64);
    s = s * 0.125f - slope * dist;
    const float mn = fmaxf(m, s), cc = __expf(m - mn), p = __expf(s - mn);
    l = l * cc + p;
#pragma unroll
    for (int j = 0; j < 4; ++j) { float x[8];
        if (ISBF) unpack8(*(const u32x4*)((const bf16_t*)vp + j * 8), x);
        else { const f32x4 a = *(const f32x4*)((const float*)vp + j * 8), b = *(const f32x4*)((const float*)vp + j * 8 + 4); x[0] = a[0]; x[1] = a[1]; x[2] = a[2]; x[3] = a[3]; x[4] = b[0]; x[5] = b[1]; x[6] = b[2]; x[7] = b[3]; }
#pragma unroll
        for (int d = 0; d < 8; ++d) acc[j * 8 + d] = acc[j * 8 + d] * cc + p * x[d]; }
    m = mn;
}
__device__ __forceinline__ void ph_swa_naive(const Ctx& c, const bf16_t* __restrict__ U, const float* __restrict__ ck, const float* __restrict__ cv, const float* __restrict__ sinks, bf16_t* __restrict__ OB) {
    for (int gid = c.bid * 512 + c.tid; gid < MS * 32; gid += c.G * 512) {
        const int dh = gid & 1, h = (gid >> 1) & 15, row = MP + (gid >> 5), kvh = h >> 3, co = kvh * 64 + dh * 32;
        float q[32], acc[32];
#pragma unroll
        for (int j = 0; j < 4; ++j) { float x[8]; unpack8(*(const u32x4*)(U + (size_t)row * NINP + U_SQ + h * 64 + dh * 32 + j * 8), x);
#pragma unroll
            for (int d = 0; d < 8; ++d) { q[j * 8 + d] = x[d]; acc[j * 8 + d] = 0.f; } }
        const float slope = exp2f(-0.5f * (float)(h + 1)); float m = sinks[h], l = 1.0f;
        if (row < MP) {
            const int t = row % PS, base = row - t, lo = t - 128 < 0 ? 0 : t - 128;
            for (int s = lo; s <= t; ++s) { const bf16_t* ur = U + (size_t)(base + s) * NINP;
                swa_step<true>(q, acc, m, l, ur + U_SK + co, ur + U_SV + co, slope, (float)(t - s)); }
        } else {
            const int sq = (row - MP) / SS, i = (row - MP) % SS;
            for (int idx = i; idx <= 128 + i; ++idx) {
                if (idx < 128) { const size_t o = ((size_t)sq * 128 + idx) * 128 + co; swa_step<false>(q, acc, m, l, ck + o, cv + o, slope, (float)(128 + i - idx)); }
                else { const bf16_t* ur = U + (size_t)(MP + sq * SS + idx - 128) * NINP; swa_step<true>(q, acc, m, l, ur + U_SK + co, ur + U_SV + co, slope, (float)(128 + i - idx)); }
            }
        }
        const float inv = 1.0f / l; bf16_t* op = OB + (size_t)row * BW + h * 64 + dh * 32;
#pragma unroll
        for (int j = 0; j < 4; ++j) { u32x4 w; w.x = pk2(acc[j * 8] * inv, acc[j * 8 + 1] * inv); w.y = pk2(acc[j * 8 + 2] * inv, acc[j * 8 + 3] * inv);
            w.z = pk2(acc[j * 8 + 4] * inv, acc[j * 8 + 5] * inv); w.w = pk2(acc[j * 8 + 6] * inv, acc[j * 8 + 7] * inv); *(u32x4*)(op + j * 8) = w; }
    }
}

__device__ __forceinline__ void ph_rwkv_prep(const Ctx& c, const bf16_t* __restrict__ U, const float* __restrict__ shift, const float* __restrict__ mu, const float* __restrict__ w0, const float* __restrict__ w2,
                                             const float* __restrict__ a0, const float* __restrict__ a2, const float* __restrict__ g2, const float* __restrict__ k_k, const float* __restrict__ k_a,
                                             const float* __restrict__ r_k, float* __restrict__ RW) {
    LAS float* xm = (LAS float*)c.lds; LAS float* tw = xm + RWC; LAS float* ad = tw + 64; LAS float* sg = ad + 64;
    const int tid = c.tid;
    float* R = RW; float* WD = RW + (size_t)MPAD * BW; float* K2 = WD + (size_t)MPAD * BW; float* V = K2 + (size_t)MPAD * BW; float* KK = V + (size_t)MPAD * BW;
    float* BV = KK + (size_t)MPAD * BW; float* G = BV + (size_t)MPAD * BW; float* BON = G + (size_t)MPAD * BW;
    for (int row = c.bid; row < MT; row += c.G) {
        const bf16_t* ur = U + (size_t)row * NINP + U_RU; const bf16_t* pr = ur - NINP; const float* ps = nullptr; bool first;
        if (row < MP) first = (row % PS) == 0; else { first = ((row - MP) % SS) == 0; ps = shift + (size_t)((row - MP) / SS) * RWC; }
        for (int cc = tid; cc < RWC; cc += 512) { const float x = bf2f(ur[cc]); const float s = first ? (ps ? ps[cc] : 0.f) : bf2f(pr[cc]); xm[cc] = x + (s - x) * mu[cc]; }
        __syncthreads();
        if (tid < 64) { tw[tid] = tanhf(xm[3072 + tid]); ad[tid] = xm[3136 + tid]; }
        if (tid >= 128 && tid < 256) sg[tid - 128] = sigmoidf_(xm[3200 + tid - 128]);
        __syncthreads();
        for (int qd = 0; qd < 2; ++qd) {
            const int cc = qd * 512 + tid; float accw = w0[cc], acca = a0[cc], accg = 0.f;
#pragma unroll 4
            for (int j = 0; j < 64; ++j) { accw += tw[j] * w2[j * BW + cc]; acca += ad[j] * a2[j * BW + cc]; }
#pragma unroll 4
            for (int j = 0; j < 128; ++j) accg += sg[j] * g2[j * BW + cc];
            const float lw = -softplusf_(-accw) - 0.5f, decay = __expf(-__expf(lw)), a = sigmoidf_(acca);
            const float r = xm[cc], k = xm[1024 + cc], v = xm[2048 + cc];
            const float kkr = k * k_k[cc]; const float ss = wave_sum(kkr * kkr); const float kk = kkr / fmaxf(sqrtf(ss), 1e-12f);
            const float k2 = k * (1.0f + (a - 1.0f) * k_a[cc]); const float rk = wave_sum(r * k2 * r_k[cc]);
            const size_t o = (size_t)row * BW + cc;
            R[o] = r; WD[o] = decay; K2[o] = k2; V[o] = v; KK[o] = kk; BV[o] = kk * a; G[o] = accg; BON[o] = rk * v;
        }
        __syncthreads();
    }
}
__device__ __forceinline__ int kperm_pos(int k) { return (k & ~31) + 8 * ((k >> 2) & 3) + 4 * ((k >> 4) & 1) + (k & 3); }
__device__ __forceinline__ void ph_swa_prompt(const Ctx& c, const bf16_t* __restrict__ U, const float* __restrict__ sinks, bf16_t* __restrict__ OB) {
    LAS bf16_t* K_l = (LAS bf16_t*)c.lds;
    LAS bf16_t* VT_l = K_l + 192 * 72;
    const int tid = c.tid, lane = c.lane, r = lane & 15, q = lane >> 4, w = c.wave;
    for (int u = c.bid; u < PB * 64 * 2; u += c.G) {
        const int b = u >> 7, qb = (u >> 1) & 63, kvh = u & 1, h = kvh * 8 + w;
        const int tok0 = qb * 64 - 128;
        const size_t seq0 = (size_t)b * PS;
        for (int idx = tid; idx < 192 * 8; idx += 512) { const int kl = idx >> 3, c8 = idx & 7, tk = tok0 + kl; u32x4 kv = (u32x4){0u, 0u, 0u, 0u}, vv = kv;
            if (tk >= 0) { const bf16_t* ur = U + (seq0 + tk) * NINP; kv = *(const u32x4*)(ur + U_SK + kvh * 64 + c8 * 8); vv = *(const u32x4*)(ur + U_SV + kvh * 64 + c8 * 8); }
            *(LAS u32x4*)(K_l + kl * 72 + c8 * 8) = kv;
            const int kp = kperm_pos(kl); LAS bf16_t* vp = VT_l + (c8 * 8) * 200 + kp;
            vp[0] = (bf16_t)(vv.x & 0xffffu); vp[200] = (bf16_t)(vv.x >> 16); vp[400] = (bf16_t)(vv.y & 0xffffu); vp[600] = (bf16_t)(vv.y >> 16);
            vp[800] = (bf16_t)(vv.z & 0xffffu); vp[1000] = (bf16_t)(vv.z >> 16); vp[1200] = (bf16_t)(vv.w & 0xffffu); vp[1400] = (bf16_t)(vv.w >> 16); }
        __syncthreads();
        const float slope = exp2f(-0.5f * (float)(h + 1)), sink = sinks[h];
#pragma unroll 1
        for (int i = 0; i < 4; ++i) {
            const size_t qrow = seq0 + qb * 64 + i * 16 + r;
            const bf16x8 qf0 = *(const bf16x8*)(U + qrow * NINP + U_SQ + h * 64 + q * 8), qf1 = *(const bf16x8*)(U + qrow * NINP + U_SQ + h * 64 + 32 + q * 8);
            const int kt0 = i & ~1;
            f32x4 s[10]; float mx = sink;
#pragma unroll
            for (int kt = 0; kt < 10; ++kt) { const LAS bf16_t* kp = K_l + ((kt0 + kt) * 16 + r) * 72 + q * 8;
                f32x4 d = mma16(*(const LAS bf16x8*)kp, qf0, (f32x4){0.f, 0.f, 0.f, 0.f}); d = mma16(*(const LAS bf16x8*)(kp + 32), qf1, d);
#pragma unroll
                for (int jj = 0; jj < 4; ++jj) { const int kl = (kt0 + kt) * 16 + q * 4 + jj, dist = i * 16 + r + 128 - kl;
                    const float v = (dist >= 0 && dist <= 128 && tok0 + kl >= 0) ? d[jj] * 0.125f - slope * (float)dist : -1e30f; d[jj] = v; mx = fmaxf(mx, v); }
                s[kt] = d; }
            mx = fmaxf(mx, __shfl_xor(mx, 16, 64)); mx = fmaxf(mx, __shfl_xor(mx, 32, 64));
            float sum = 0.f; bf16x8 pf[5];
#pragma unroll
            for (int kp = 0; kp < 5; ++kp) { f32x4 a = s[2 * kp], bq = s[2 * kp + 1];
#pragma unroll
                for (int jj = 0; jj < 4; ++jj) { a[jj] = __expf(a[jj] - mx); bq[jj] = __expf(bq[jj] - mx); sum += a[jj] + bq[jj]; }
                pf[kp] = pack_acc(a, bq); }
            sum += __shfl_xor(sum, 16, 64); sum += __shfl_xor(sum, 32, 64);
            const float inv = 1.0f / (sum + __expf(sink - mx));
            bf16_t* op = OB + qrow * BW + h * 64 + q * 4;
#pragma unroll
            for (int dt = 0; dt < 4; ++dt) { f32x4 o = (f32x4){0.f, 0.f, 0.f, 0.f};
#pragma unroll
                for (int kp = 0; kp < 5; ++kp) o = mma16(*(const LAS bf16x8*)(VT_l + (dt * 16 + r) * 200 + (kt0 + 2 * kp) * 16 + q * 8), pf[kp], o);
                u32x2 ov; ov.x = pk2(o[0] * inv, o[1] * inv); ov.y = pk2(o[2] * inv, o[3] * inv); *(u32x2*)(op + dt * 16) = ov; }
        }
        __syncthreads();
    }
}

__device__ __forceinline__ void ph_swa_sample(const Ctx& c, const bf16_t* __restrict__ U, const float* __restrict__ ck, const float* __restrict__ cv, const float* __restrict__ sinks, bf16_t* __restrict__ OB) {
    LAS bf16_t* K_l = (LAS bf16_t*)c.lds;
    LAS bf16_t* VT_l = K_l + 160 * 72;
    const int tid = c.tid, lane = c.lane, r = lane & 15, q = lane >> 4, w = c.wave;
    for (int u = c.bid; u < SB * 2; u += c.G) {
        const int sq = u >> 1, kvh = u & 1;
        for (int idx = tid; idx < 160 * 8; idx += 512) { const int kl = idx >> 3, c8 = idx & 7; float kx[8], vx[8];
#pragma unroll
            for (int e = 0; e < 8; ++e) { kx[e] = 0.f; vx[e] = 0.f; }
            if (kl < 128) { const size_t o = ((size_t)sq * 128 + kl) * 128 + kvh * 64 + c8 * 8; const f32x4 a = *(const f32x4*)(ck + o), b2 = *(const f32x4*)(ck + o + 4), c2 = *(const f32x4*)(cv + o), d2 = *(const f32x4*)(cv + o + 4);
                kx[0] = a[0]; kx[1] = a[1]; kx[2] = a[2]; kx[3] = a[3]; kx[4] = b2[0]; kx[5] = b2[1]; kx[6] = b2[2]; kx[7] = b2[3];
                vx[0] = c2[0]; vx[1] = c2[1]; vx[2] = c2[2]; vx[3] = c2[3]; vx[4] = d2[0]; vx[5] = d2[1]; vx[6] = d2[2]; vx[7] = d2[3]; }
            else if (kl < 132) { const bf16_t* ur = U + (size_t)(MP + sq * SS + kl - 128) * NINP; unpack8(*(const u32x4*)(ur + U_SK + kvh * 64 + c8 * 8), kx); unpack8(*(const u32x4*)(ur + U_SV + kvh * 64 + c8 * 8), vx); }
            *(LAS u32x4*)(K_l + kl * 72 + c8 * 8) = (u32x4){pk2(kx[0], kx[1]), pk2(kx[2], kx[3]), pk2(kx[4], kx[5]), pk2(kx[6], kx[7])};
            LAS bf16_t* vp = VT_l + (c8 * 8) * 168 + kperm_pos(kl);
#pragma unroll
            for (int e = 0; e < 8; ++e) vp[e * 168] = f2bf(vx[e]); }
        __syncthreads();
        if (w < 2) {
            const int h = kvh * 8 + w * 4 + (r >> 2), tk = r & 3; const size_t qrow = (size_t)(MP + sq * SS + tk);
            const float slope = exp2f(-0.5f * (float)(h + 1)), sink = sinks[h];
            const bf16x8 qf0 = *(const bf16x8*)(U + qrow * NINP + U_SQ + h * 64 + q * 8), qf1 = *(const bf16x8*)(U + qrow * NINP + U_SQ + h * 64 + 32 + q * 8);
            f32x4 s[10]; float mx = sink;
#pragma unroll
            for (int kt = 0; kt < 10; ++kt) { const LAS bf16_t* kp = K_l + (kt * 16 + r) * 72 + q * 8;
                f32x4 d = mma16(*(const LAS bf16x8*)kp, qf0, (f32x4){0.f, 0.f, 0.f, 0.f}); d = mma16(*(const LAS bf16x8*)(kp + 32), qf1, d);
#pragma unroll
                for (int jj = 0; jj < 4; ++jj) { const int kl = kt * 16 + q * 4 + jj, dist = 128 + tk - kl;
                    const float v = (dist >= 0 && dist <= 128) ? d[jj] * 0.125f - slope * (float)dist : -1e30f; d[jj] = v; mx = fmaxf(mx, v); }
                s[kt] = d; }
            mx = fmaxf(mx, __shfl_xor(mx, 16, 64)); mx = fmaxf(mx, __shfl_xor(mx, 32, 64));
            float sum = 0.f; bf16x8 pf[5];
#pragma unroll
            for (int kp = 0; kp < 5; ++kp) { f32x4 a = s[2 * kp], bq = s[2 * kp + 1];
#pragma unroll
                for (int jj = 0; jj < 4; ++jj) { a[jj] = __expf(a[jj] - mx); bq[jj] = __expf(bq[jj] - mx); sum += a[jj] + bq[jj]; }
                pf[kp] = pack_acc(a, bq); }
            sum += __shfl_xor(sum, 16, 64); sum += __shfl_xor(sum, 32, 64);
            const float inv = 1.0f / (sum + __expf(sink - mx));
            bf16_t* op = OB + qrow * BW + h * 64 + q * 4;
#pragma unroll
            for (int dt = 0; dt < 4; ++dt) { f32x4 o = (f32x4){0.f, 0.f, 0.f, 0.f};
#pragma unroll
                for (int kp = 0; kp < 5; ++kp) o = mma16(*(const LAS bf16x8*)(VT_l + (dt * 16 + r) * 168 + kp * 32 + q * 8), pf[kp], o);
                u32x2 ov; ov.x = pk2(o[0] * inv, o[1] * inv); ov.y = pk2(o[2] * inv, o[3] * inv); *(u32x2*)(op + dt * 16) = ov; }
        }
        __syncthreads();
    }
}

__device__ __forceinline__ void ph_lrw(const Ctx& c, const float* __restrict__ w2, const float* __restrict__ a2, const float* __restrict__ g2, bf16_t* __restrict__ LRW) {
    for (int idx = c.bid * 512 + c.tid; idx < NL * 256 * 1024; idx += c.G * 512) {
        const int ch = idx & 1023, j = (idx >> 10) & 255, l = idx >> 18;
        const float v = j < 64 ? w2[((size_t)l * 64 + j) * BW + ch] : (j < 128 ? a2[((size_t)l * 64 + j - 64) * BW + ch] : g2[((size_t)l * 128 + j - 128) * BW + ch]);
        LRW[((size_t)l * 1024 + ch) * 256 + j] = f2bf(v);
    }
}
constexpr int RWP_UNITS = (MP / 64) * 16 + SB * 16;
__device__ __forceinline__ void rwp_unit_info(int u, int& row0, int& ntok, int& h, int& sq, bool& seq_first) {
    if (u < (MP / 64) * 16) { const int blk = u >> 4; h = u & 15; row0 = blk * 64; ntok = 64; sq = -1; seq_first = (row0 % PS) == 0; }
    else { const int s = u - (MP / 64) * 16; sq = s >> 4; h = s & 15; row0 = MP + sq * SS; ntok = SS; seq_first = true; }
}
__device__ __forceinline__ void ph_rwkv_pre(const Ctx& c, const bf16_t* __restrict__ U, const float* __restrict__ shift, const float* __restrict__ mu, const float* __restrict__ w0, const float* __restrict__ w2,
                                            const float* __restrict__ a0, const float* __restrict__ a2, const float* __restrict__ g2, const float* __restrict__ k_k, const float* __restrict__ k_a,
                                            const float* __restrict__ r_k, float* __restrict__ RW, bf16_t* __restrict__ RB, const bf16_t* __restrict__ LRW) {
    LAS bf16_t* P_l = (LAS bf16_t*)c.lds; LAS bf16_t* Kn_l = P_l + 4608; LAS bf16_t* Bn_l = Kn_l + 4608; LAS bf16_t* Q_l = Bn_l + 4608;
    LAS bf16_t* PT_l = Q_l + 4608; LAS bf16_t* BhT_l = PT_l + 4608; LAS bf16_t* KhT_l = BhT_l + 4608; LAS bf16_t* VT_l = KhT_l + 4608;
    LAS float* A_l = (LAS float*)(c.lds + 73728);
    LAS bf16_t* BmT_l = (LAS bf16_t*)(c.lds + 78848); LAS bf16_t* F_l = (LAS bf16_t*)(c.lds + 81920); LAS bf16_t* Tinv_l = (LAS bf16_t*)(c.lds + 84992);
    LAS bf16_t* PpT_l = (LAS bf16_t*)(c.lds + 88064);
    LAS bf16_t* BmpT_l = (LAS bf16_t*)(c.lds + 97280);
    LAS float* GC_l = (LAS float*)(c.lds + 100352);
    LAS float* lg_l = (LAS float*)(c.lds + 125952);
    LAS bf16_t* act_l = (LAS bf16_t*)c.lds;
    LAS bf16_t* wT_l = act_l + 64 * 264;
    LAS bf16_t* aT_l = wT_l + 64 * 72;
    LAS bf16_t* gT_l = aT_l + 64 * 72;
    LAS float* pre_l = (LAS float*)(c.lds + 73728);
    const int tid = c.tid, lane = c.lane, r = lane & 15, q = lane >> 4, w = c.wave;
    float* Gg = RW + 6 * (size_t)MPAD * BW; float* BON = RW + 7 * (size_t)MPAD * BW;
    for (int u = c.bid; u < RWP_UNITS; u += c.G) {
        int row0, ntok, h, sq; bool seq_first; rwp_unit_info(u, row0, ntok, h, sq, seq_first);
        const float* sh = sq >= 0 ? shift + (size_t)sq * RWC : nullptr;
        const int nstage = ntok == 64 ? 64 : 16;
        for (int idx = tid; idx < nstage * 32; idx += 512) {
            const int t = idx >> 5, c8 = idx & 31, cc = 3072 + c8 * 8; float val[8];
#pragma unroll
            for (int e2 = 0; e2 < 8; ++e2) val[e2] = 0.f;
            if (t < ntok) { const bf16_t* ur = U + (size_t)(row0 + t) * NINP + U_RU; float x[8], p[8];
                unpack8(*(const u32x4*)(ur + cc), x);
                if (!(t == 0 && seq_first)) unpack8(*(const u32x4*)(ur + cc - NINP), p);
                else if (sh) { const f32x4 s0v = *(const f32x4*)(sh + cc), s1v = *(const f32x4*)(sh + cc + 4); p[0] = s0v[0]; p[1] = s0v[1]; p[2] = s0v[2]; p[3] = s0v[3]; p[4] = s1v[0]; p[5] = s1v[1]; p[6] = s1v[2]; p[7] = s1v[3]; }
                else {
#pragma unroll
                    for (int e2 = 0; e2 < 8; ++e2) p[e2] = 0.f; }
                const f32x4 m0 = *(const f32x4*)(mu + cc), m1 = *(const f32x4*)(mu + cc + 4);
#pragma unroll
                for (int e2 = 0; e2 < 8; ++e2) { const float xm = x[e2] + (p[e2] - x[e2]) * (e2 < 4 ? m0[e2] : m1[e2 - 4]); val[e2] = c8 < 8 ? tanh_fast(xm) : (c8 < 16 ? xm : sigmoidf_(xm)); } }
            *(LAS u32x4*)(act_l + t * 264 + c8 * 8) = (u32x4){pk2(val[0], val[1]), pk2(val[2], val[3]), pk2(val[4], val[5]), pk2(val[6], val[7])};
        }
        __syncthreads();
        { const int tb = w & 3, chf = w >> 2;
          if (tb * 16 < nstage) { bf16x8 af[8];
#pragma unroll
            for (int ks = 0; ks < 8; ++ks) af[ks] = *(const LAS bf16x8*)(act_l + (tb * 16 + r) * 264 + ks * 32 + q * 8);
#pragma unroll
            for (int e2 = 0; e2 < 2; ++e2) { const int cb = chf * 2 + e2; f32x4 dw = (f32x4){0.f, 0.f, 0.f, 0.f}, da = dw, dg = dw;
                const bf16_t* wr = LRW + ((size_t)h * 64 + cb * 16 + r) * 256 + q * 8;
#pragma unroll
                for (int ks = 0; ks < 2; ++ks) { dw = mma16(*(const bf16x8*)(wr + ks * 32), af[ks], dw); da = mma16(*(const bf16x8*)(wr + 64 + ks * 32), af[2 + ks], da); }
#pragma unroll
                for (int ks = 0; ks < 4; ++ks) dg = mma16(*(const bf16x8*)(wr + 128 + ks * 32), af[4 + ks], dg);
                const int o = (tb * 16 + r) * 68 + cb * 16 + q * 4;
                *(LAS f32x4*)(pre_l + o) = dw; *(LAS f32x4*)(pre_l + 64 * 68 + o) = da; *(LAS f32x4*)(pre_l + 2 * 64 * 68 + o) = dg; } } }
        __syncthreads();
        const int t = tid >> 3, cg = tid & 7, c0 = h * 64 + cg * 8, sc = t >> 4;
        float rr[8], k2[8], kap[8], bet[8], nlw[8];
        { float vx[8], gg[8], kkr[8]; float ss = 0.f, rk = 0.f;
          if (t < ntok) {
            const size_t row = (size_t)(row0 + t); const bf16_t* ur = U + row * NINP + U_RU; const bool fst = (t == 0 && seq_first);
            float kx[8];
#pragma unroll
            for (int part = 0; part < 3; ++part) { const int cc = part * 1024 + c0; float x[8], p[8];
                unpack8(*(const u32x4*)(ur + cc), x);
                if (!fst) unpack8(*(const u32x4*)(ur + cc - NINP), p);
                else {
#pragma unroll
                    for (int j = 0; j < 8; ++j) p[j] = sh ? sh[cc + j] : 0.f; }
                const f32x4 mA = *(const f32x4*)(mu + cc), mB = *(const f32x4*)(mu + cc + 4);
#pragma unroll
                for (int j = 0; j < 8; ++j) { const float xm = x[j] + (p[j] - x[j]) * (j < 4 ? mA[j] : mB[j - 4]); if (part == 0) rr[j] = xm; else if (part == 1) kx[j] = xm; else vx[j] = xm; } }
            float pw[8], pa[8], pkk[8], pka[8], prk[8];
#pragma unroll
            for (int hf = 0; hf < 2; ++hf) { const f32x4 v0 = *(const f32x4*)(w0 + c0 + hf * 4), v1 = *(const f32x4*)(a0 + c0 + hf * 4), v2 = *(const f32x4*)(k_k + c0 + hf * 4), v3 = *(const f32x4*)(k_a + c0 + hf * 4), v4 = *(const f32x4*)(r_k + c0 + hf * 4);
#pragma unroll
                for (int j = 0; j < 4; ++j) { pw[hf * 4 + j] = v0[j]; pa[hf * 4 + j] = v1[j]; pkk[hf * 4 + j] = v2[j]; pka[hf * 4 + j] = v3[j]; prk[hf * 4 + j] = v4[j]; } }
            float lwp[8], app[8];
#pragma unroll
            for (int hf = 0; hf < 2; ++hf) { const f32x4 v0 = *(const LAS f32x4*)(pre_l + t * 68 + cg * 8 + hf * 4), v1 = *(const LAS f32x4*)(pre_l + 64 * 68 + t * 68 + cg * 8 + hf * 4), v2 = *(const LAS f32x4*)(pre_l + 2 * 64 * 68 + t * 68 + cg * 8 + hf * 4);
#pragma unroll
                for (int j = 0; j < 4; ++j) { lwp[hf * 4 + j] = v0[j]; app[hf * 4 + j] = v1[j]; gg[hf * 4 + j] = v2[j]; } }
#pragma unroll
            for (int j = 0; j < 8; ++j) {
                const float lw = -softplus_fast(-(pw[j] + lwp[j])) - 0.5f; nlw[j] = -__expf(lw); const float av = sigmoidf_(pa[j] + app[j]);
                kkr[j] = kx[j] * pkk[j]; ss += kkr[j] * kkr[j]; k2[j] = kx[j] * (1.0f + (av - 1.0f) * pka[j]); rk += rr[j] * k2[j] * prk[j]; bet[j] = av; }
          } else {
#pragma unroll
            for (int j = 0; j < 8; ++j) { rr[j] = 0.f; k2[j] = 0.f; kkr[j] = 0.f; bet[j] = 0.f; nlw[j] = 0.f; vx[j] = 0.f; gg[j] = 0.f; }
          }
          ss += __shfl_xor(ss, 1, 64); ss += __shfl_xor(ss, 2, 64); ss += __shfl_xor(ss, 4, 64);
          rk += __shfl_xor(rk, 1, 64); rk += __shfl_xor(rk, 2, 64); rk += __shfl_xor(rk, 4, 64);
          const float inv = 1.0f / fmaxf(sqrtf(ss), 1e-12f);
#pragma unroll
          for (int j = 0; j < 8; ++j) { kap[j] = kkr[j] * inv; bet[j] = kap[j] * bet[j]; }
          if (t < ntok) { const size_t o = (size_t)(row0 + t) * BW + c0;
              *(f32x4*)(Gg + o) = (f32x4){gg[0], gg[1], gg[2], gg[3]}; *(f32x4*)(Gg + o + 4) = (f32x4){gg[4], gg[5], gg[6], gg[7]};
              *(f32x4*)(BON + o) = (f32x4){rk * vx[0], rk * vx[1], rk * vx[2], rk * vx[3]}; *(f32x4*)(BON + o + 4) = (f32x4){rk * vx[4], rk * vx[5], rk * vx[6], rk * vx[7]}; }
          *(LAS f32x4*)(lg_l + t * 68 + cg * 8) = (f32x4){nlw[0], nlw[1], nlw[2], nlw[3]}; *(LAS f32x4*)(lg_l + t * 68 + cg * 8 + 4) = (f32x4){nlw[4], nlw[5], nlw[6], nlw[7]};
#pragma unroll
          for (int j = 0; j < 8; ++j) VT_l[(cg * 8 + j) * 72 + t] = f2bf(vx[j]);
        }
        __syncthreads();
        if (tid < 256) { const int cc = tid & 63, s4 = tid >> 6; float run = 0.f;
#pragma unroll
            for (int i = 0; i < 16; ++i) { const int o = (s4 * 16 + i) * 68 + cc; run += lg_l[o]; lg_l[o] = run; } }
        __syncthreads();
        { unsigned pp[4], pq[4], pk[4], pb[4];
#pragma unroll
          for (int j = 0; j < 8; j += 2) { float vP[2], vQ[2], vK[2], vB[2];
#pragma unroll
              for (int e = 0; e < 2; ++e) { const int jj = j + e, cc = cg * 8 + jj; const float ci = lg_l[t * 68 + cc], cC = lg_l[(sc * 16 + 15) * 68 + cc];
                  const float ei = __expf(-ci), eh = __expf(cC - ci);
                  vP[e] = kap[jj] * __expf(ci - nlw[jj]); vQ[e] = rr[jj] * __expf(ci); vK[e] = k2[jj] * ei; vB[e] = bet[jj] * ei;
                  PT_l[cc * 72 + t] = f2bf(vP[e]); BhT_l[cc * 72 + t] = f2bf(bet[jj] * eh); KhT_l[cc * 72 + t] = f2bf(k2[jj] * eh); }
              pp[j >> 1] = pk2(vP[0], vP[1]); pq[j >> 1] = pk2(vQ[0], vQ[1]); pk[j >> 1] = pk2(vK[0], vK[1]); pb[j >> 1] = pk2(vB[0], vB[1]); }
          const int o = t * 72 + cg * 8;
          *(LAS u32x4*)(P_l + o) = (u32x4){pp[0], pp[1], pp[2], pp[3]}; *(LAS u32x4*)(Q_l + o) = (u32x4){pq[0], pq[1], pq[2], pq[3]};
          *(LAS u32x4*)(Kn_l + o) = (u32x4){pk[0], pk[1], pk[2], pk[3]}; *(LAS u32x4*)(Bn_l + o) = (u32x4){pb[0], pb[1], pb[2], pb[3]};
          if ((t & 15) == 15) {
#pragma unroll
              for (int j = 0; j < 8; ++j) GC_l[sc * 64 + cg * 8 + j] = __expf(lg_l[t * 68 + cg * 8 + j]); } }
        __syncthreads();
        const int nsub = ntok == 64 ? 4 : 1;
        const bf16x8 zfrag = (bf16x8){0, 0, 0, 0, 0, 0, 0, 0};
        for (int id = w; id < nsub * 3; id += 8) { const int s4 = id / 3, prod = id - s4 * 3; f32x4 d = (f32x4){0.f, 0.f, 0.f, 0.f};
            const LAS bf16_t* X = (prod == 1 ? P_l : Bn_l) + (s4 * 16 + r) * 72 + q * 8; const LAS bf16_t* Y = (prod == 0 ? P_l : (prod == 1 ? Kn_l : Q_l)) + (s4 * 16 + r) * 72 + q * 8;
#pragma unroll
            for (int ks = 0; ks < 2; ++ks) d = mma16(*(const LAS bf16x8*)(X + ks * 32), *(const LAS bf16x8*)(Y + ks * 32), d);
            if (prod == 0) { f32x4 o4;
#pragma unroll
                for (int jj = 0; jj < 4; ++jj) o4[jj] = (q * 4 + jj < r) ? d[jj] : 0.f;
                *(LAS f32x4*)(A_l + s4 * 320 + r * 20 + q * 4) = o4; }
            else { float o4[4];
#pragma unroll
                for (int jj = 0; jj < 4; ++jj) o4[jj] = (prod == 1 ? (r < q * 4 + jj) : (q * 4 + jj <= r)) ? d[jj] : 0.f;
                u32x2 o; o.x = pk2(o4[0], o4[1]); o.y = pk2(o4[2], o4[3]); *(LAS u32x2*)((prod == 1 ? BmT_l : F_l) + s4 * 384 + r * 24 + q * 4) = o; } }
        __syncthreads();
        if (w == 0 && (lane >> 4) < nsub) { const int s4 = lane >> 4, jc = lane & 15; float x[16];
#pragma unroll
            for (int tt = 0; tt < 16; ++tt) { float s = (tt == jc) ? 1.f : 0.f;
#pragma unroll
                for (int i = 0; i < tt; ++i) s -= A_l[s4 * 320 + tt * 20 + i] * x[i];
                x[tt] = s; }
#pragma unroll
            for (int tt = 0; tt < 16; ++tt) Tinv_l[s4 * 384 + tt * 24 + jc] = f2bf(x[tt]); }
        __syncthreads();
        for (int id = w; id < nsub * 5; id += 8) { const int s4 = id / 5, rem = id - s4 * 5;
            const bf16x8 xf = q < 2 ? *(const LAS bf16x8*)(Tinv_l + s4 * 384 + r * 24 + q * 8) : zfrag;
            const bf16x8 yf = q < 2 ? (rem < 4 ? *(const LAS bf16x8*)(PT_l + (rem * 16 + r) * 72 + s4 * 16 + q * 8) : *(const LAS bf16x8*)(BmT_l + s4 * 384 + r * 24 + q * 8)) : zfrag;
            const f32x4 d = mma16(xf, yf, (f32x4){0.f, 0.f, 0.f, 0.f});
            u32x2 o; o.x = pk2(d[0], d[1]); o.y = pk2(d[2], d[3]);
            if (rem < 4) *(LAS u32x2*)(PpT_l + (rem * 16 + r) * 72 + s4 * 16 + q * 4) = o; else *(LAS u32x2*)(BmpT_l + s4 * 384 + r * 24 + q * 4) = o; }
        __syncthreads();
        { const int chunk0 = sq >= 0 ? PB * 16 * 256 + sq * 16 + h : ((row0 / PS) * 16 + h) * 256 + ((row0 % PS) >> 4);
          for (int id = w; id < nsub * 25; id += 8) { const int s4 = id / 25, rem = id - s4 * 25; bf16_t* blob = RB + (size_t)(chunk0 + s4) * RB_EL;
            const bf16x8 fF = q < 2 ? *(const LAS bf16x8*)(F_l + s4 * 384 + r * 24 + q * 8) : zfrag;
            if (rem < 4) {
                const bf16x8 xf = q < 2 ? *(const LAS bf16x8*)(PpT_l + (rem * 16 + r) * 72 + s4 * 16 + q * 8) : zfrag;
                const f32x4 d = mma16(xf, fF, (f32x4){0.f, 0.f, 0.f, 0.f});
                const u32x2 qv = *(const LAS u32x2*)(Q_l + (s4 * 16 + r) * 72 + rem * 16 + q * 4);
                u32x2 o; o.x = pk2(__uint_as_float(qv.x << 16) - d[0], __uint_as_float(qv.x & 0xffff0000u) - d[1]); o.y = pk2(__uint_as_float(qv.y << 16) - d[2], __uint_as_float(qv.y & 0xffff0000u) - d[3]);
                *(u32x2*)(blob + RB_QP + r * 72 + 32 * (rem >> 1) + 8 * q + 4 * (rem & 1)) = o;
            } else if (rem == 4) {
                f32x4 d2 = (f32x4){0.f, 0.f, 0.f, 0.f};
#pragma unroll
                for (int ks = 0; ks < 2; ++ks) d2 = mma16(*(const LAS bf16x8*)(Kn_l + (s4 * 16 + r) * 72 + ks * 32 + q * 8), *(const LAS bf16x8*)(Q_l + (s4 * 16 + r) * 72 + ks * 32 + q * 8), d2);
                const bf16x8 xf = q < 2 ? *(const LAS bf16x8*)(BmpT_l + s4 * 384 + r * 24 + q * 8) : zfrag;
                const f32x4 d1 = mma16(xf, fF, (f32x4){0.f, 0.f, 0.f, 0.f});
                float o4[4];
#pragma unroll
                for (int jj = 0; jj < 4; ++jj) o4[jj] = ((q * 4 + jj <= r) ? d2[jj] : 0.f) - d1[jj];
                u32x2 o; o.x = pk2(o4[0], o4[1]); o.y = pk2(o4[2], o4[3]); *(u32x2*)(blob + RB_EP + r * 24 + q * 4) = o;
            } else if (rem < 21) {
                const int cib = (rem - 5) >> 2, cob = (rem - 5) & 3;
                const bf16x8 xf = q < 2 ? *(const LAS bf16x8*)(PpT_l + (cib * 16 + r) * 72 + s4 * 16 + q * 8) : zfrag;
                const bf16x8 yf = q < 2 ? *(const LAS bf16x8*)(BhT_l + (cob * 16 + r) * 72 + s4 * 16 + q * 8) : zfrag;
                const f32x4 d = mma16(xf, yf, (f32x4){0.f, 0.f, 0.f, 0.f});
                const float gc = GC_l[s4 * 64 + cob * 16 + r]; float o4[4];
#pragma unroll
                for (int jj = 0; jj < 4; ++jj) o4[jj] = ((cib == cob && q * 4 + jj == r) ? gc : 0.f) - d[jj];
                u32x2 o; o.x = pk2(o4[0], o4[1]); o.y = pk2(o4[2], o4[3]); *(u32x2*)(blob + (cob * 16 + r) * 72 + 32 * (cib >> 1) + 8 * q + 4 * (cib & 1)) = o;
            } else {
                const int cb = rem - 21;
                const bf16x8 xf = q < 2 ? *(const LAS bf16x8*)(BmpT_l + s4 * 384 + r * 24 + q * 8) : zfrag;
                const bf16x8 yf = q < 2 ? *(const LAS bf16x8*)(BhT_l + (cb * 16 + r) * 72 + s4 * 16 + q * 8) : zfrag;
                const f32x4 d = mma16(xf, yf, (f32x4){0.f, 0.f, 0.f, 0.f});
                const u32x2 kv = *(const LAS u32x2*)(KhT_l + (cb * 16 + r) * 72 + s4 * 16 + q * 4);
                u32x2 o; o.x = pk2(__uint_as_float(kv.x << 16) - d[0], __uint_as_float(kv.x & 0xffff0000u) - d[1]); o.y = pk2(__uint_as_float(kv.y << 16) - d[2], __uint_as_float(kv.y & 0xffff0000u) - d[3]);
                *(u32x2*)(blob + RB_KHP + (cb * 16 + r) * 24 + q * 4) = o;
            } }
          for (int idx = tid; idx < nsub * 128; idx += 512) { const int s4 = idx >> 7, cc = (idx >> 1) & 63, hf = idx & 1;
              *(u32x4*)(RB + (size_t)(chunk0 + s4) * RB_EL + RB_VT + cc * 24 + hf * 8) = *(const LAS u32x4*)(VT_l + cc * 72 + s4 * 16 + hf * 8); } }
        __syncthreads();
    }
}

__device__ __forceinline__ void ph_rwkv_scan_naive(const Ctx& c, const float* __restrict__ RW, const float* __restrict__ s0, const float* __restrict__ lng, const float* __restrict__ lnb, bf16_t* __restrict__ OB,
                                                   float* __restrict__ outP, float* __restrict__ outS) {
    const float* R = RW; const float* WD = RW + (size_t)MPAD * BW; const float* K2 = WD + (size_t)MPAD * BW; const float* V = K2 + (size_t)MPAD * BW; const float* KK = V + (size_t)MPAD * BW;
    const float* BV = KK + (size_t)MPAD * BW; const float* G = BV + (size_t)MPAD * BW; const float* BON = G + (size_t)MPAD * BW;
    const int lane = c.lane;
    for (int it = 0;; ++it) {
        const int u = (it * 8 + c.wave) * c.G + c.bid;
        if (u >= (PB + SB) * 16) break;
        const int sq = u >> 4, h = u & 15;
        int row0, L; seq_info(sq, row0, L);
        float S[64];
        if (sq >= PB) { const float* p = s0 + (((size_t)(sq - PB) * 16 + h) * 64 + lane) * 64;
#pragma unroll
            for (int j = 0; j < 64; ++j) S[j] = p[j]; }
        else {
#pragma unroll
            for (int j = 0; j < 64; ++j) S[j] = 0.f; }
        const float lg = lng[h * 64 + lane], lb = lnb[h * 64 + lane];
        for (int t = 0; t < L; ++t) {
            const size_t base = (size_t)(row0 + t) * BW + h * 64; const float v = V[base + lane];
            float d = 0.f;
#pragma unroll
            for (int j = 0; j < 64; ++j) d += S[j] * KK[base + j];
            float y = 0.f;
#pragma unroll
            for (int j = 0; j < 64; ++j) { S[j] = S[j] * WD[base + j] - d * BV[base + j] + v * K2[base + j]; y += S[j] * R[base + j]; }
            const float mean = wave_sum(y) * (1.0f / 64.0f), dy = y - mean, var = wave_sum(dy * dy) * (1.0f / 64.0f);
            const float yn = dy * rsqrtf(var + 64e-5f) * lg + lb;
            OB[base + lane] = f2bf((yn + BON[base + lane]) * G[base + lane]);
        }
        float* op = (sq < PB ? outP + (((size_t)sq * 16 + h) * 64 + lane) * 64 : outS + (((size_t)(sq - PB) * 16 + h) * 64 + lane) * 64);
#pragma unroll
        for (int j = 0; j < 64; ++j) op[j] = S[j];
    }
}
__device__ __forceinline__ void ph_rwkv_scan2(const Ctx& c, int boff, const float* __restrict__ RW, const float* __restrict__ s0, const float* __restrict__ lng, const float* __restrict__ lnb, bf16_t* __restrict__ OB,
                                              float* __restrict__ outP, float* __restrict__ outS) {
    LAS float* opb = (LAS float*)c.lds;
    LAS float* yb = opb + 2 * 16 * 384;
    const int tid = c.tid, lane = c.lane, w = c.wave, rl = lane >> 3, cg = lane & 7, vrow = w * 8 + rl;
    const float* G = RW + 6 * (size_t)MPAD * BW; const float* BON = RW + 7 * (size_t)MPAD * BW;
    for (int u = (c.bid - boff + c.G) % c.G; u < (PB + SB) * 16; u += c.G) {
        const int sq = u >> 4, h = u & 15;
        int row0, L; seq_info(sq, row0, L);
        float S[8];
        if (sq >= PB) { const float* p = s0 + (((size_t)(sq - PB) * 16 + h) * 64 + vrow) * 64 + cg * 8;
#pragma unroll
            for (int j = 0; j < 8; ++j) S[j] = p[j]; }
        else {
#pragma unroll
            for (int j = 0; j < 8; ++j) S[j] = 0.f; }
        const float lg = lng[h * 64 + lane], lb = lnb[h * 64 + lane];
        const int nb = (L + 15) >> 4;
#define RW_STAGE(bi_) do { const int t0_ = (bi_) * 16, nT_ = (L - t0_) < 16 ? (L - t0_) : 16; LAS float* dst_ = opb + ((bi_) & 1) * 16 * 384; \
        for (int idx = tid; idx < nT_ * 96; idx += 512) { const int t = idx / 96, rem = idx - t * 96, slot = rem >> 4, c4 = rem & 15; \
            const int arr = slot == 0 ? 1 : slot == 1 ? 4 : slot == 2 ? 5 : slot == 3 ? 2 : slot == 4 ? 0 : 3; \
            *(LAS f32x4*)(dst_ + t * 384 + slot * 64 + c4 * 4) = *(const f32x4*)(RW + (size_t)arr * MPAD * BW + (size_t)(row0 + t0_ + t) * BW + h * 64 + c4 * 4); } } while (0)
        RW_STAGE(0);
        for (int bi = 0; bi < nb; ++bi) {
            __syncthreads();
            if (bi + 1 < nb) RW_STAGE(bi + 1);
            const int t0 = bi * 16, nT = (L - t0) < 16 ? (L - t0) : 16; const LAS float* src = opb + (bi & 1) * 16 * 384;
            for (int tt = 0; tt < nT; ++tt) {
                const LAS float* b = src + tt * 384 + cg * 8;
                const f32x4 w0 = *(const LAS f32x4*)(b), w1 = *(const LAS f32x4*)(b + 4), k0 = *(const LAS f32x4*)(b + 64), k1 = *(const LAS f32x4*)(b + 68);
                const f32x4 b0 = *(const LAS f32x4*)(b + 128), b1 = *(const LAS f32x4*)(b + 132), q0 = *(const LAS f32x4*)(b + 192), q1 = *(const LAS f32x4*)(b + 196);
                const f32x4 r0 = *(const LAS f32x4*)(b + 256), r1 = *(const LAS f32x4*)(b + 260); const float v = src[tt * 384 + 320 + vrow];
                float d = (S[0] * k0[0] + S[1] * k0[1]) + (S[2] * k0[2] + S[3] * k0[3]) + (S[4] * k1[0] + S[5] * k1[1]) + (S[6] * k1[2] + S[7] * k1[3]);
                d += __shfl_xor(d, 1, 64); d += __shfl_xor(d, 2, 64); d += __shfl_xor(d, 4, 64);
                float y = 0.f;
#pragma unroll
                for (int j = 0; j < 4; ++j) { S[j] = S[j] * w0[j] - d * b0[j] + v * q0[j]; y += S[j] * r0[j]; S[4 + j] = S[4 + j] * w1[j] - d * b1[j] + v * q1[j]; y += S[4 + j] * r1[j]; }
                y += __shfl_xor(y, 1, 64); y += __shfl_xor(y, 2, 64); y += __shfl_xor(y, 4, 64);
                if (cg == 0) yb[tt * 64 + vrow] = y;
            }
            __syncthreads();
            for (int tt = w; tt < nT; tt += 8) {
                const float y = yb[tt * 64 + lane]; const float mean = wave_sum(y) * (1.0f / 64.0f), dy = y - mean, var = wave_sum(dy * dy) * (1.0f / 64.0f);
                const float yn = dy * rsqrtf(var + 64e-5f) * lg + lb; const size_t o = (size_t)(row0 + t0 + tt) * BW + h * 64 + lane;
                OB[o] = f2bf((yn + BON[o]) * G[o]);
            }
        }
#undef RW_STAGE
        float* op = (sq < PB ? outP + (((size_t)sq * 16 + h) * 64 + vrow) * 64 : outS + (((size_t)(sq - PB) * 16 + h) * 64 + vrow) * 64) + cg * 8;
#pragma unroll
        for (int j = 0; j < 8; ++j) op[j] = S[j];
        __syncthreads();
    }
}
constexpr int RS_SLOTS = 8, RS_SLOT_B = RB_EL * 2;
__device__ __forceinline__ void ph_rwkv_seq(const Ctx& c, int boff, const bf16_t* __restrict__ RB, const float* __restrict__ s0, float* __restrict__ outP, float* __restrict__ outS, bf16_t* __restrict__ OB) {
    const int lane = c.lane, r = lane & 15, q = lane >> 4, w = c.wave;
    LAS unsigned char* ring = c.lds;
    for (int u = (c.bid - boff + c.G) % c.G; u < (PB + SB) * 16; u += c.G) {
        const int sq = u >> 4, h = u & 15;
        int nch, ch0, row0, ntok; const float* sp = nullptr; float* op;
        if (sq < PB) { nch = 256; ch0 = (sq * 16 + h) * 256; row0 = sq * PS; ntok = 16; op = outP + (size_t)(sq * 16 + h) * 4096; }
        else { nch = 1; ch0 = PB * 16 * 256 + (sq - PB) * 16 + h; row0 = MP + (sq - PB) * SS; ntok = SS; sp = s0 + (size_t)((sq - PB) * 16 + h) * 4096; op = outS + (size_t)((sq - PB) * 16 + h) * 4096; }
        if (w >= 4) {
            const int lw = w - 4, p0 = lw < 2 ? lw * 5 : 10 + (lw - 2) * 4, np = lw < 2 ? 5 : 4;
#define RS_ISSUE(ci_) do { const int cc_ = (ci_) < nch ? (ci_) : nch - 1; const char* g_ = (const char*)(RB + (size_t)(ch0 + cc_) * RB_EL) + p0 * 1024 + lane * 16; \
            LAS unsigned char* d_ = ring + ((ci_) % RS_SLOTS) * RS_SLOT_B + p0 * 1024; \
            _Pragma("unroll") for (int p_ = 0; p_ < 5; ++p_) if (p_ < np) __builtin_amdgcn_global_load_lds((const unsigned*)(g_ + p_ * 1024), (LAS unsigned*)(d_ + p_ * 1024), 16, 0, 0); } while (0)
            for (int ci = 0; ci < RS_SLOTS - 1; ++ci) RS_ISSUE(ci);
            if (lw < 2) asm volatile("s_waitcnt vmcnt(30)" ::: "memory"); else asm volatile("s_waitcnt vmcnt(24)" ::: "memory");
            __builtin_amdgcn_s_barrier();
            for (int ci = 0; ci < nch; ++ci) {
                RS_ISSUE(ci + RS_SLOTS - 1);
                if (lw < 2) asm volatile("s_waitcnt vmcnt(30)" ::: "memory"); else asm volatile("s_waitcnt vmcnt(24)" ::: "memory");
                __builtin_amdgcn_s_barrier();
            }
#undef RS_ISSUE
            asm volatile("s_waitcnt vmcnt(0)" ::: "memory");
        } else {
            const int vb = w; f32x4 acc[4];
#pragma unroll
            for (int kb = 0; kb < 4; ++kb) acc[kb] = sp ? *(const f32x4*)(sp + (size_t)(vb * 16 + r) * 64 + kb * 16 + q * 4) : (f32x4){0.f, 0.f, 0.f, 0.f};
            const bf16x8 zfrag = (bf16x8){0, 0, 0, 0, 0, 0, 0, 0};
            __builtin_amdgcn_s_barrier();
            for (int ci = 0; ci < nch; ++ci) {
                const LAS bf16_t* blob = (const LAS bf16_t*)(ring + (ci % RS_SLOTS) * RS_SLOT_B);
                const bf16x8 t0 = pack_acc(acc[0], acc[1]), t1 = pack_acc(acc[2], acc[3]);
                const bf16x8 vt = q < 2 ? *(const LAS bf16x8*)(blob + RB_VT + (vb * 16 + r) * 24 + q * 8) : zfrag;
                const bf16x8 ep = q < 2 ? *(const LAS bf16x8*)(blob + RB_EP + r * 24 + q * 8) : zfrag;
                f32x4 y = mma16(t0, *(const LAS bf16x8*)(blob + RB_QP + r * 72 + q * 8), (f32x4){0.f, 0.f, 0.f, 0.f});
                y = mma16(t1, *(const LAS bf16x8*)(blob + RB_QP + r * 72 + 32 + q * 8), y);
                y = mma16(vt, ep, y);
#pragma unroll
                for (int kb = 0; kb < 4; ++kb) { f32x4 a = mma16(*(const LAS bf16x8*)(blob + (kb * 16 + r) * 72 + q * 8), t0, (f32x4){0.f, 0.f, 0.f, 0.f});
                    a = mma16(*(const LAS bf16x8*)(blob + (kb * 16 + r) * 72 + 32 + q * 8), t1, a);
                    const bf16x8 kh = q < 2 ? *(const LAS bf16x8*)(blob + RB_KHP + (kb * 16 + r) * 24 + q * 8) : zfrag;
                    acc[kb] = mma16(kh, vt, a); }
                if (r < ntok) { u32x2 o; o.x = pk2(y[0], y[1]); o.y = pk2(y[2], y[3]); *(u32x2*)(OB + (size_t)(row0 + ci * 16 + r) * BW + h * 64 + vb * 16 + q * 4) = o; }
                asm volatile("s_waitcnt lgkmcnt(0)" ::: "memory");
                __builtin_amdgcn_s_barrier();
            }
#pragma unroll
            for (int kb = 0; kb < 4; ++kb) *(f32x4*)(op + (size_t)(vb * 16 + r) * 64 + kb * 16 + q * 4) = acc[kb];
        }
        __syncthreads();
    }
}
__device__ __forceinline__ void ph_rwkv_fin(const Ctx& c, const float* __restrict__ RW, const float* __restrict__ lng, const float* __restrict__ lnb, bf16_t* __restrict__ OB) {
    const int lane = c.lane; const float* G = RW + 6 * (size_t)MPAD * BW; const float* BON = RW + 7 * (size_t)MPAD * BW;
    for (int i = c.bid * 8 + c.wave; i < MT * 4; i += c.G * 8) {
        const int row = i >> 2, cc = (i & 3) * 256 + lane * 4; const size_t o = (size_t)row * BW + cc; bf16_t* p = OB + o;
        const u32x2 raw = *(const u32x2*)p; float x[4] = {__uint_as_float(raw.x << 16), __uint_as_float(raw.x & 0xffff0000u), __uint_as_float(raw.y << 16), __uint_as_float(raw.y & 0xffff0000u)};
        float s = (x[0] + x[1]) + (x[2] + x[3]); s += __shfl_xor(s, 1, 64); s += __shfl_xor(s, 2, 64); s += __shfl_xor(s, 4, 64); s += __shfl_xor(s, 8, 64);
        const float mean = s * (1.0f / 64.0f); float qq = 0.f;
#pragma unroll
        for (int j = 0; j < 4; ++j) { const float d = x[j] - mean; qq += d * d; }
        qq += __shfl_xor(qq, 1, 64); qq += __shfl_xor(qq, 2, 64); qq += __shfl_xor(qq, 4, 64); qq += __shfl_xor(qq, 8, 64);
        const float rstd = rsqrtf(qq * (1.0f / 64.0f) + 64e-5f);
        const f32x4 gg = *(const f32x4*)(lng + cc), bb = *(const f32x4*)(lnb + cc), bo = *(const f32x4*)(BON + o), gt = *(const f32x4*)(G + o); float ov[4];
#pragma unroll
        for (int j = 0; j < 4; ++j) ov[j] = ((x[j] - mean) * rstd * gg[j] + bb[j] + bo[j]) * gt[j];
        u32x2 oo; oo.x = pk2(ov[0], ov[1]); oo.y = pk2(ov[2], ov[3]); *(u32x2*)p = oo;
    }
}

__device__ __forceinline__ void ph_memattn_sample(const Ctx& c, const bf16_t* __restrict__ U, const float* __restrict__ mk, const float* __restrict__ mv, bf16_t* __restrict__ OB) {
    LAS float* qs = (LAS float*)c.lds; LAS float* ps = qs + 2 * 4 * 256;
    const int hh = c.tid >> 8, vt = c.tid & 255, lane = c.lane;
    for (int u = c.bid; u < SB * 2; u += c.G) {
        const int sq = u >> 1, h = (u & 1) * 2 + hh;
#pragma unroll
        for (int t = 0; t < 4; ++t) qs[(hh * 4 + t) * 256 + vt] = bf2f(U[(size_t)(MP + sq * SS + t) * NINP + U_MQ + h * 256 + vt]) * 0.0625f;
        __syncthreads();
        { const float* kr = mk + (((size_t)sq * MEMT + vt) * 4 + h) * 256; float s[4] = {0.f, 0.f, 0.f, 0.f};
            for (int d = 0; d < 256; d += 4) { const f32x4 kv = *(const f32x4*)(kr + d);
#pragma unroll
                for (int t = 0; t < 4; ++t) { const LAS float* qq = qs + (hh * 4 + t) * 256 + d; s[t] += kv[0] * qq[0] + kv[1] * qq[1] + kv[2] * qq[2] + kv[3] * qq[3]; } }
#pragma unroll
            for (int t = 0; t < 4; ++t) ps[(hh * 4 + t) * 256 + vt] = s[t]; }
        __syncthreads();
        { LAS float* pr = ps + c.wave * 256; float x[4]; float mx = -3.0e38f;
#pragma unroll
            for (int j = 0; j < 4; ++j) { x[j] = pr[lane + 64 * j]; mx = fmaxf(mx, x[j]); }
            mx = wave_max(mx); float s = 0.f;
#pragma unroll
            for (int j = 0; j < 4; ++j) { x[j] = __expf(x[j] - mx); s += x[j]; }
            const float inv = 1.0f / wave_sum(s);
#pragma unroll
            for (int j = 0; j < 4; ++j) pr[lane + 64 * j] = x[j] * inv; }
        __syncthreads();
        { float o[4] = {0.f, 0.f, 0.f, 0.f}; const float* vr = mv + ((size_t)sq * MEMT * 4 + h) * 256 + vt;
            for (int m = 0; m < MEMT; ++m) { const float vv = vr[(size_t)m * 1024];
#pragma unroll
                for (int t = 0; t < 4; ++t) o[t] += ps[(hh * 4 + t) * 256 + m] * vv; }
#pragma unroll
            for (int t = 0; t < 4; ++t) OB[(size_t)(MP + sq * SS + t) * BW + h * 256 + vt] = f2bf(o[t]); }
        __syncthreads();
    }
}

template <int K, int LDA, int LDB> __device__ __forceinline__ void skinny_pair(const Ctx& c, const bf16_t* __restrict__ A, const bf16_t* __restrict__ B0, const bf16_t* __restrict__ B1, f32x4 (&out)[2], int rot) {
    LAS f32x4* red = (LAS f32x4*)c.lds;
    const int lane = c.lane, r = lane & 15, q = lane >> 4, w = c.wave;
    constexpr int KS = K / 8;
    const bf16_t* ap = A + (size_t)r * LDA + w * KS + q * 8; const bf16_t* b0 = B0 + (size_t)r * LDB + w * KS + q * 8; const bf16_t* b1 = B1 + (size_t)r * LDB + w * KS + q * 8;
    f32x4 acc[2][8];
#pragma unroll
    for (int n = 0; n < 2; ++n)
#pragma unroll
        for (int m = 0; m < 8; ++m) acc[n][m] = (f32x4){0.f, 0.f, 0.f, 0.f};
    int kk = (int)((unsigned)rot % (unsigned)(KS / 32));
#pragma unroll 2
    for (int it = 0; it < KS / 32; ++it) { const int ks = kk; kk = kk + 1 == KS / 32 ? 0 : kk + 1;
        const bf16x8 f0 = *(const bf16x8*)(b0 + ks * 32), f1 = *(const bf16x8*)(b1 + ks * 32); bf16x8 af[8];
#pragma unroll
        for (int m = 0; m < 8; ++m) af[m] = *(const bf16x8*)(ap + (size_t)(m * 16) * LDA + ks * 32);
#pragma unroll
        for (int m = 0; m < 8; ++m) { acc[0][m] = mma16(f0, af[m], acc[0][m]); acc[1][m] = mma16(f1, af[m], acc[1][m]); } }
    __syncthreads();
#pragma unroll
    for (int n = 0; n < 2; ++n)
#pragma unroll
        for (int m = 0; m < 8; ++m) red[(w * 16 + n * 8 + m) * 64 + lane] = acc[n][m];
    __syncthreads();
#pragma unroll
    for (int n = 0; n < 2; ++n) { f32x4 s = red[(n * 8 + w) * 64 + lane];
#pragma unroll
        for (int ww = 1; ww < 8; ++ww) s += red[(ww * 16 + n * 8 + w) * 64 + lane];
        out[n] = s; }
}
__device__ __forceinline__ u32x2 pk4(const f32x4 v) { u32x2 o; o.x = pk2(v[0], v[1]); o.y = pk2(v[2], v[3]); return o; }
#define SKINNY_LOOP(total_) for (int s = c.bid - base; s >= 0 && s < (total_); s += ncu)
__device__ __forceinline__ void ph_sk_in(const Ctx& c, int base, int ncu, const bf16_t* __restrict__ HB, const bf16_t* __restrict__ W, bf16_t* __restrict__ U) {
    const int r = c.lane & 15, q = c.lane >> 4, w = c.wave;
    SKINNY_LOOP(NINP / 32) { f32x4 o[2]; skinny_pair<DM, DM, DM>(c, HB + (size_t)MP * DM, W + (size_t)(s * 32) * DM, W + (size_t)(s * 32 + 16) * DM, o, s);
        bf16_t* up = U + (size_t)(MP + w * 16 + r) * NINP + s * 32 + q * 4; *(u32x2*)up = pk4(o[0]); *(u32x2*)(up + 16) = pk4(o[1]); }
}
__device__ __forceinline__ void ph_sk_merge(const Ctx& c, int base, int ncu, const bf16_t* __restrict__ BR, const bf16_t* __restrict__ W, const bf16_t* __restrict__ U, const float* __restrict__ gate_b, bf16_t* __restrict__ MGB) {
    const int r = c.lane & 15, q = c.lane >> 4, w = c.wave;
    SKINNY_LOOP(DM / 32) { const size_t row = (size_t)(MP + w * 16 + r); const int col = s * 32 + q * 4; f32x4 tot[2] = {(f32x4){0.f, 0.f, 0.f, 0.f}, (f32x4){0.f, 0.f, 0.f, 0.f}};
#pragma unroll 1
        for (int z = 0; z < 4; ++z) { f32x4 o[2]; skinny_pair<BW, BW, BW>(c, BR + ((size_t)z * MPAD + MP) * BW, W + ((size_t)z * DM + s * 32) * BW, W + ((size_t)z * DM + s * 32 + 16) * BW, o, s + z);
#pragma unroll
            for (int n = 0; n < 2; ++n) { const u32x2 gp = *(const u32x2*)(U + row * NINP + U_GP + z * DM + col + n * 16); const f32x4 gb = *(const f32x4*)(gate_b + z * DM + col + n * 16);
                tot[n][0] += sigmoidf_(__uint_as_float(gp.x << 16) + gb[0]) * o[n][0]; tot[n][1] += sigmoidf_(__uint_as_float(gp.x & 0xffff0000u) + gb[1]) * o[n][1];
                tot[n][2] += sigmoidf_(__uint_as_float(gp.y << 16) + gb[2]) * o[n][2]; tot[n][3] += sigmoidf_(__uint_as_float(gp.y & 0xffff0000u) + gb[3]) * o[n][3]; } }
        *(u32x2*)(MGB + row * DM + col) = pk4(tot[0]); *(u32x2*)(MGB + row * DM + col + 16) = pk4(tot[1]); }
}
template <int K> __device__ __forceinline__ void ph_sk_res(const Ctx& c, int base, int ncu, const bf16_t* __restrict__ A, const bf16_t* __restrict__ W, const float* __restrict__ R, float* __restrict__ Y) {
    const int r = c.lane & 15, q = c.lane >> 4, w = c.wave;
    SKINNY_LOOP(DM / 32) { f32x4 o[2]; skinny_pair<K, K, K>(c, A + (size_t)MP * K, W + (size_t)(s * 32) * K, W + (size_t)(s * 32 + 16) * K, o, s);
        const size_t off = (size_t)(MP + w * 16 + r) * DM + s * 32 + q * 4;
        *(f32x4*)(Y + off) = *(const f32x4*)(R + off) * ALPHA + o[0]; *(f32x4*)(Y + off + 16) = *(const f32x4*)(R + off + 16) * ALPHA + o[1]; }
}
__device__ __forceinline__ void ph_sk_gu(const Ctx& c, int base, int ncu, const bf16_t* __restrict__ X1B, const bf16_t* __restrict__ W, bf16_t* __restrict__ ACT) {
    const int r = c.lane & 15, q = c.lane >> 4, w = c.wave;
    SKINNY_LOOP(DFF / 16) { const int t = s >> 3, j0 = (s & 7) * 16; f32x4 o[2];
        skinny_pair<DM, DM, DM>(c, X1B + (size_t)MP * DM, W + (size_t)(t * 256 + j0) * DM, W + (size_t)(t * 256 + 128 + j0) * DM, o, s);
        f32x4 v;
#pragma unroll
        for (int j = 0; j < 4; ++j) v[j] = o[0][j] * sigmoidf_(o[0][j]) * o[1][j];
        *(u32x2*)(ACT + (size_t)(MP + w * 16 + r) * DFF + t * 128 + j0 + q * 4) = pk4(v); }
}
#undef SKINNY_LOOP

constexpr int LDS_BAR_OFF = 147456;
constexpr int LDS_BYTES = LDS_BAR_OFF + 64;
struct Args { const float* in[37]; float* out; unsigned char* ws; };

typedef pg8::Gemm<DM, DM, DM, 2, 8, NL, 1, false, 0, 0, (long)DM * DM, 0> GemmMem;
typedef pg8::Gemm<DM, DM, DM, MP / 256, NINP / 256> GemmIn;
typedef pg8::Gemm<NINP, 1024, 256, PS / 256, 1, 8, 4, false, (long)PS * NINP, 256, 256 * 1024, 256> GemmScore;
typedef pg8::Gemm<256, 256, 256, PS / 256, 1, 8, 4, false, (long)4 * 4096 * 256, (long)4096 * 256, 4 * 65536, 65536> GemmPV;
typedef pg8::Gemm<BW, BW, BW, MP / 256, DM / 256, 4, 1, true, (long)MPAD * BW, 0, (long)DM * BW, 0> GemmBranch;
typedef pg8::Gemm<DM, DM, DM, MP / 256, DM / 256> GemmOut;
typedef pg8::Gemm<DM, DM, DM, MP / 256, 2 * DFF / 256> GemmGU;
typedef pg8::Gemm<DFF, DFF, DFF, MP / 256, DM / 256> GemmDown;
template <class GT> __device__ __forceinline__ GT mk_gemm(const Ctx& c, const bf16_t* A, const bf16_t* B) { GT g; g.A = A; g.B = B; g.G = c.G; g.c = c.bid; return g; }

template <int OFF> __device__ __forceinline__ unsigned long long karg_u64(unsigned long long kargs) {
    unsigned long long p; asm volatile("s_load_dwordx2 %0, %1, %2\n\ts_waitcnt lgkmcnt(0)" : "=s"(p) : "s"(kargs), "n"(OFF) : "memory"); return p;
}
#define INP(k) ((const float*)karg_u64<(k) * 8>(kargs))
#define OUTP() ((float*)karg_u64<37 * 8>(kargs))
#define WSP() ((unsigned char*)karg_u64<38 * 8>(kargs))

__global__ void __launch_bounds__(512, 2) mega_fwd(Args a_unused) {
    extern __shared__ __attribute__((aligned(16))) unsigned char lds_raw[];
    const unsigned long long kargs = (unsigned long long)__builtin_amdgcn_kernarg_segment_ptr();
    Ctx c0; c0.tid = threadIdx.x; c0.lane = c0.tid & 63; c0.wave = __builtin_amdgcn_readfirstlane(c0.tid >> 6); c0.bid = blockIdx.x; c0.G = gridDim.x; c0.lds = (LAS unsigned char*)lds_raw;
    if (c0.tid < 4) ((LAS unsigned*)(c0.lds + LDS_BAR_OFF))[c0.tid] = 0u;
    __syncthreads();
    const XcdBarrier bar = xcd_barrier_post((unsigned*)(WSP() + WS_CTL), (volatile LAS unsigned*)(c0.lds + LDS_BAR_OFF));

#define WPREP_LAYER(cc_, L_) do { unsigned char* ws_ = WSP(); \
      ph_wprep(cc_, INP(10) + (size_t)(L_) * DM * NIN, (bf16_t*)(ws_ + WS_WIN) + (size_t)(L_) * NINP * DM, DM, NIN, NINP, 1, 1, 0, 0); \
      ph_wprep(cc_, INP(29) + (size_t)(L_) * 4 * BW * DM, (bf16_t*)(ws_ + WS_WBR) + (size_t)(L_) * 4 * DM * BW, BW, DM, DM, 0, 4, (size_t)BW * DM, (size_t)DM * BW); \
      ph_wprep(cc_, INP(30) + (size_t)(L_) * DM * DM, (bf16_t*)(ws_ + WS_WOUT) + (size_t)(L_) * DM * DM, DM, DM, DM, 0, 1, 0, 0); \
      ph_wprep(cc_, INP(33) + (size_t)(L_) * DM * 2 * DFF, (bf16_t*)(ws_ + WS_WGU) + (size_t)(L_) * 2 * DFF * DM, DM, 2 * DFF, 2 * DFF, 2, 1, 0, 0); \
      ph_wprep(cc_, INP(34) + (size_t)(L_) * DFF * DM, (bf16_t*)(ws_ + WS_WDN) + (size_t)(L_) * DM * DFF, DFF, DM, DM, 0, 1, 0, 0); } while (0)
    { const Ctx c = fresh(c0); unsigned char* ws = WSP();
      ph_wprep(c, INP(28), (bf16_t*)(ws + WS_WMEM), DM, DM, DM, 0, NL, (size_t)DM * DM, (size_t)DM * DM);
      WPREP_LAYER(c, 0);
      ph_lrw(c, INP(19), INP(21), INP(22), (bf16_t*)(ws + WS_LRW));
      ph_xprep(c, INP(0), INP(1), INP(2), (float*)(ws + WS_HF), (bf16_t*)(ws + WS_HB), (bf16_t*)(ws + WS_MEMB)); }
    xcd_barrier(bar);
    { const Ctx c = fresh(c0); unsigned char* ws = WSP(); float* out = OUTP();
      GemmMem g = mk_gemm<GemmMem>(c, (const bf16_t*)(ws + WS_MEMB), (const bf16_t*)(ws + WS_WMEM));
      pg8::EpiMem E; E.outK = out + O_MKP; E.outV = out + O_MVP; E.kb = (bf16_t*)(ws + WS_MKB); E.vt = (bf16_t*)(ws + WS_MVT); pg8::gemm_phase<GemmMem, pg8::EpiMem, true, true>(c.lds, c.tid, g, E); }

    for (int l = 0; l < NL; ++l) {
        { const Ctx c = fresh(c0); unsigned char* ws = WSP();
          GemmIn g = mk_gemm<GemmIn>(c, (const bf16_t*)(ws + WS_HB), (const bf16_t*)(ws + WS_WIN) + (size_t)l * NINP * DM);
          pg8::EpiBf16 E; E.O = (bf16_t*)(ws + WS_U); E.zs = 0; E.ldc = NINP; E.pad = 0; pg8::gemm_phase<GemmIn, pg8::EpiBf16, true, true>(c.lds, c.tid, g, E); }
        { const Ctx c = fresh(c0); unsigned char* ws = WSP(); ph_sk_in(c, c.G > 192 ? 96 : 0, c.G > 192 ? c.G - 96 : c.G, (const bf16_t*)(ws + WS_HB), (const bf16_t*)(ws + WS_WIN) + (size_t)l * NINP * DM, (bf16_t*)(ws + WS_U)); }
        xcd_barrier(bar);
        { const Ctx c = fresh(c0); unsigned char* ws = WSP(); float* out = OUTP(); const bf16_t* U = (const bf16_t*)(ws + WS_U); bf16_t* BR = (bf16_t*)(ws + WS_BR);
          (void)out; (void)BR;
          ph_gla_pre(c, U, INP(12) + (size_t)l * 16 * 512, INP(13) + (size_t)l * 512, (bf16_t*)(ws + WS_GLQD), (bf16_t*)(ws + WS_GLKH), (bf16_t*)(ws + WS_GLE), (bf16_t*)(ws + WS_GLVT), (float*)(ws + WS_GLGC)); }
        { const Ctx c = fresh(c0); unsigned char* ws = WSP();
          ph_rwkv_pre(c, (const bf16_t*)(ws + WS_U), INP(9) + (size_t)l * SB * RWC, INP(17) + (size_t)l * RWC, INP(18) + (size_t)l * BW, INP(19) + (size_t)l * 64 * BW, INP(20) + (size_t)l * BW, INP(21) + (size_t)l * 64 * BW,
                       INP(22) + (size_t)l * 128 * BW, INP(23) + (size_t)l * BW, INP(24) + (size_t)l * BW, INP(25) + (size_t)l * BW, (float*)(ws + WS_RW), (bf16_t*)(ws + WS_RB), (const bf16_t*)(ws + WS_LRW) + (size_t)l * 1024 * 256); }
        { const Ctx c = fresh(c0); unsigned char* ws = WSP();
          GemmScore g = mk_gemm<GemmScore>(c, (const bf16_t*)(ws + WS_U) + U_MQ, (const bf16_t*)(ws + WS_MKB) + (size_t)l * 512 * 1024);
          pg8::EpiScore E; E.SC = (float*)(ws + WS_SC); pg8::gemm_phase<GemmScore, pg8::EpiScore, true, true>(c.lds, c.tid, g, E); }
        xcd_barrier(bar);
        { const Ctx c = fresh(c0); unsigned char* ws = WSP(); float* out = OUTP();
          ph_rwkv_seq(c, 64, (const bf16_t*)(ws + WS_RB), INP(8) + (size_t)l * SB * 16 * 4096, out + O_RWP + (size_t)l * PB * 16 * 4096, out + O_RWS + (size_t)l * SB * 16 * 4096,
                      (bf16_t*)(ws + WS_BR) + (size_t)2 * MPAD * BW); }
        { const Ctx c = fresh(c0); unsigned char* ws = WSP(); float* out = OUTP();
          ph_gla_seq(c, 32, (const bf16_t*)(ws + WS_GLQD), (const bf16_t*)(ws + WS_GLKH), (const bf16_t*)(ws + WS_GLE), (const bf16_t*)(ws + WS_GLVT), (const float*)(ws + WS_GLGC),
                     INP(7) + (size_t)l * SB * 4 * 32768, out + O_GLAP + (size_t)l * PB * 4 * 32768, out + O_GLAS + (size_t)l * SB * 4 * 32768, (bf16_t*)(ws + WS_BR)); }
        { const Ctx c = fresh(c0); unsigned char* ws = WSP(); ph_softmax256(c, (const float*)(ws + WS_SC), (bf16_t*)(ws + WS_PB), 8 * 4096); }
        if ((c0.bid < 32 || c0.bid >= 96) && c0.G > 96) {
        { Ctx c = fresh(c0); c.bid = c.bid < 32 ? c.bid : c.bid - 64; c.G = c.G - 64; unsigned char* ws = WSP(); ph_swa_prompt(c, (const bf16_t*)(ws + WS_U), INP(16) + (size_t)l * 16, (bf16_t*)(ws + WS_BR) + (size_t)MPAD * BW); }
        { Ctx c = fresh(c0); c.bid = c.bid < 32 ? c.bid : c.bid - 64; c.G = c.G - 64; unsigned char* ws = WSP();
          ph_swa_sample(c, (const bf16_t*)(ws + WS_U), INP(3) + (size_t)l * SB * 16384, INP(4) + (size_t)l * SB * 16384, INP(16) + (size_t)l * 16, (bf16_t*)(ws + WS_BR) + (size_t)MPAD * BW); }
        { Ctx c = fresh(c0); c.bid = c.bid < 32 ? c.bid : c.bid - 64; c.G = c.G - 64; unsigned char* ws = WSP();
          ph_memattn_sample(c, (const bf16_t*)(ws + WS_U), INP(5) + (size_t)l * SB * MEMT * 1024, INP(6) + (size_t)l * SB * MEMT * 1024, (bf16_t*)(ws + WS_BR) + (size_t)3 * MPAD * BW); }
        { Ctx c = fresh(c0); c.bid = c.bid < 32 ? c.bid : c.bid - 64; c.G = c.G - 64; unsigned char* ws = WSP();
          ph_copy_outs(c, (const bf16_t*)(ws + WS_U), INP(3) + (size_t)l * SB * 16384, INP(4) + (size_t)l * SB * 16384, OUTP(), l); }
          if (l + 1 < NL) { Ctx c = fresh(c0); c.bid = c.bid < 32 ? c.bid : c.bid - 64; c.G = c.G - 64; WPREP_LAYER(c, l + 1); }
        }
        xcd_barrier(bar);
        { const Ctx c = fresh(c0); unsigned char* ws = WSP(); ph_rwkv_fin(c, (const float*)(ws + WS_RW), INP(26) + (size_t)l * BW, INP(27) + (size_t)l * BW, (bf16_t*)(ws + WS_BR) + (size_t)2 * MPAD * BW); }
        { const Ctx c = fresh(c0); unsigned char* ws = WSP(); ph_gla_fin(c, (const bf16_t*)(ws + WS_U), INP(14) + (size_t)l * BW, INP(15) + (size_t)l * BW, (bf16_t*)(ws + WS_BR)); }
        { const Ctx c = fresh(c0); unsigned char* ws = WSP();
          GemmPV g = mk_gemm<GemmPV>(c, (const bf16_t*)(ws + WS_PB), (const bf16_t*)(ws + WS_MVT) + (size_t)l * 8 * 65536);
          pg8::EpiPV E; E.O = (bf16_t*)(ws + WS_BR) + (size_t)3 * MPAD * BW; pg8::gemm_phase<GemmPV, pg8::EpiPV, true, true>(c.lds, c.tid, g, E); }
        xcd_barrier(bar);
        { const Ctx c = fresh(c0); unsigned char* ws = WSP();
          GemmBranch g = mk_gemm<GemmBranch>(c, (const bf16_t*)(ws + WS_BR), (const bf16_t*)(ws + WS_WBR) + (size_t)l * 4 * DM * BW);
          pg8::EpiMerge E; E.MG = (float*)(ws + WS_MG); E.MGB = (bf16_t*)(ws + WS_MGB); E.U = (const bf16_t*)(ws + WS_U); E.gate_b = INP(11) + (size_t)l * 4 * DM; pg8::gemm_phase<GemmBranch, pg8::EpiMerge, true, true>(c.lds, c.tid, g, E); }
        { const Ctx c = fresh(c0); unsigned char* ws = WSP(); ph_sk_merge(c, 0, c.G, (const bf16_t*)(ws + WS_BR), (const bf16_t*)(ws + WS_WBR) + (size_t)l * 4 * DM * BW, (const bf16_t*)(ws + WS_U), INP(11) + (size_t)l * 4 * DM, (bf16_t*)(ws + WS_MGB)); }
        xcd_barrier(bar);
        { const Ctx c = fresh(c0); unsigned char* ws = WSP();
          GemmOut g = mk_gemm<GemmOut>(c, (const bf16_t*)(ws + WS_MGB), (const bf16_t*)(ws + WS_WOUT) + (size_t)l * DM * DM);
          pg8::EpiRes E; E.R = (const float*)(ws + WS_HF); E.Y = (float*)(ws + WS_Y); pg8::gemm_phase<GemmOut, pg8::EpiRes, true, true>(c.lds, c.tid, g, E); }
        { const Ctx c = fresh(c0); unsigned char* ws = WSP(); ph_sk_res<DM>(c, c.G > 192 ? 128 : 0, c.G > 192 ? c.G - 128 : c.G, (const bf16_t*)(ws + WS_MGB), (const bf16_t*)(ws + WS_WOUT) + (size_t)l * DM * DM, (const float*)(ws + WS_HF), (float*)(ws + WS_Y)); }
        xcd_barrier(bar);
        { const Ctx c = fresh(c0); unsigned char* ws = WSP(); ph_ln(c, (const float*)(ws + WS_Y), INP(31) + (size_t)l * DM, INP(32) + (size_t)l * DM, (float*)(ws + WS_X1F), (bf16_t*)(ws + WS_X1B), nullptr, MT, 0); }
        xcd_barrier(bar);
        { const Ctx c = fresh(c0); unsigned char* ws = WSP();
          GemmGU g = mk_gemm<GemmGU>(c, (const bf16_t*)(ws + WS_X1B), (const bf16_t*)(ws + WS_WGU) + (size_t)l * 2 * DFF * DM);
          pg8::EpiSwiGLU E; E.O = (bf16_t*)(ws + WS_ACT); pg8::gemm_phase<GemmGU, pg8::EpiSwiGLU, true, true>(c.lds, c.tid, g, E); }
        { const Ctx c = fresh(c0); unsigned char* ws = WSP(); ph_sk_gu(c, c.G > 192 ? 128 : 0, c.G > 192 ? c.G - 128 : c.G, (const bf16_t*)(ws + WS_X1B), (const bf16_t*)(ws + WS_WGU) + (size_t)l * 2 * DFF * DM, (bf16_t*)(ws + WS_ACT)); }
        xcd_barrier(bar);
        { const Ctx c = fresh(c0); unsigned char* ws = WSP();
          GemmDown g = mk_gemm<GemmDown>(c, (const bf16_t*)(ws + WS_ACT), (const bf16_t*)(ws + WS_WDN) + (size_t)l * DM * DFF);
          pg8::EpiRes E; E.R = (const float*)(ws + WS_X1F); E.Y = (float*)(ws + WS_Y); pg8::gemm_phase<GemmDown, pg8::EpiRes, true, true>(c.lds, c.tid, g, E); }
        { const Ctx c = fresh(c0); unsigned char* ws = WSP(); ph_sk_res<DFF>(c, 0, c.G, (const bf16_t*)(ws + WS_ACT), (const bf16_t*)(ws + WS_WDN) + (size_t)l * DM * DFF, (const float*)(ws + WS_X1F), (float*)(ws + WS_Y)); }
        xcd_barrier(bar);
        { const Ctx c = fresh(c0); unsigned char* ws = WSP(); float* out = OUTP(); ph_ln(c, (const float*)(ws + WS_Y), INP(35) + (size_t)l * DM, INP(36) + (size_t)l * DM, (float*)(ws + WS_HF), (bf16_t*)(ws + WS_HB), l == NL - 1 ? out : nullptr, MT, MT); }
        xcd_barrier(bar);
    }
}

extern "C" void kernel_launch(void* const* d_in, const int* in_sizes, int n_in, void* d_out, int out_size, void* d_ws, size_t ws_size, hipStream_t stream) {
    static int grid = 0;
    if (grid == 0) {
        if (n_in != 37 || (size_t)out_size != O_END || ws_size < WS_END) { fprintf(stderr, "kernel_launch: unexpected sizes (n_in %d out %d ws %zu need %zu)\n", n_in, out_size, ws_size, (size_t)WS_END); grid = -1; return; }
        int dev = 0, cus = 0;
        if (hipGetDevice(&dev) != hipSuccess || hipDeviceGetAttribute(&cus, hipDeviceAttributeMultiprocessorCount, dev) != hipSuccess) { grid = -1; return; }
        if (hipFuncSetAttribute((const void*)mega_fwd, hipFuncAttributeMaxDynamicSharedMemorySize, LDS_BYTES) != hipSuccess) { fprintf(stderr, "kernel_launch: hipFuncSetAttribute failed\n"); grid = -1; return; }
        int per_cu = 0;
        if (hipOccupancyMaxActiveBlocksPerMultiprocessor(&per_cu, (const void*)mega_fwd, 512, LDS_BYTES) != hipSuccess || per_cu < 1) { fprintf(stderr, "kernel_launch: occupancy query says %d\n", per_cu); }
        (void)hipGetLastError();
        grid = cus;
    }
    if (grid < 0) return;
    (void)hipMemsetAsync((unsigned char*)d_ws + WS_CTL, 0, XCD_BAR_WORDS * sizeof(unsigned), stream);
    Args a; memset(&a, 0, sizeof a);
    for (int i = 0; i < 37; ++i) a.in[i] = (const float*)d_in[i];
    a.out = (float*)d_out; a.ws = (unsigned char*)d_ws;
    hipLaunchKernelGGL(mega_fwd, dim3(grid), dim3(512), LDS_BYTES, stream, a);
}
```

```cpp
#include <hip/hip_runtime.h>
#include <cstdio>
#include <cstdint>
#include <cstring>

#define LAS __attribute__((address_space(3)))
typedef unsigned short bf16_t;
typedef short bf16x8 __attribute__((ext_vector_type(8)));
typedef float f32x4 __attribute__((ext_vector_type(4)));
typedef float f32x2 __attribute__((ext_vector_type(2)));
typedef unsigned u32x4 __attribute__((ext_vector_type(4)));
typedef unsigned u32x2 __attribute__((ext_vector_type(2)));

constexpr int DM = 2048, NL = 4;
constexpr int PB = 2, PS = 4096, MP = PB * PS;
constexpr int SB = 32, SS = 4, MS = SB * SS;
constexpr int MT = MP + MS;
constexpr int MPAD = 8448;
constexpr int NIN = 16912, NINP = 17152;
constexpr int U_GQ = 0, U_GK = 512, U_GV = 1024, U_GR = 2048, U_GA = 3072, U_SQ = 3328, U_SK = 4352, U_SV = 4480, U_RU = 4608, U_MQ = 7936, U_GP = 8960;
constexpr int RWC = 3328, BW = 1024, DFF = 5632, MEMT = 256;
constexpr float ALPHA = 1.681792830507429f;

constexpr size_t O_YP = 0;
constexpr size_t O_YS = O_YP + (size_t)MP * DM;
constexpr size_t O_SWKP = O_YS + (size_t)MS * DM;
constexpr size_t O_SWVP = O_SWKP + (size_t)NL * PB * 128 * 128;
constexpr size_t O_MKP = O_SWVP + (size_t)NL * PB * 128 * 128;
constexpr size_t O_MVP = O_MKP + (size_t)NL * PB * 256 * 1024;
constexpr size_t O_GLAP = O_MVP + (size_t)NL * PB * 256 * 1024;
constexpr size_t O_RWP = O_GLAP + (size_t)NL * PB * 4 * 128 * 256;
constexpr size_t O_RSP = O_RWP + (size_t)NL * PB * 16 * 64 * 64;
constexpr size_t O_SWKS = O_RSP + (size_t)NL * PB * RWC;
constexpr size_t O_SWVS = O_SWKS + (size_t)NL * SB * 128 * 128;
constexpr size_t O_GLAS = O_SWVS + (size_t)NL * SB * 128 * 128;
constexpr size_t O_RWS = O_GLAS + (size_t)NL * SB * 4 * 128 * 256;
constexpr size_t O_RSS = O_RWS + (size_t)NL * SB * 16 * 64 * 64;
constexpr size_t O_END = O_RSS + (size_t)NL * SB * RWC;
static_assert(O_END == 52881408, "output size");

constexpr size_t al256(size_t x) { return (x + 255) & ~(size_t)255; }
constexpr size_t WS_CTL = 0;
constexpr size_t WS_WIN = 65536;
constexpr size_t WS_WMEM = WS_WIN + (size_t)NL * NINP * DM * 2;
constexpr size_t WS_WBR = WS_WMEM + (size_t)NL * DM * DM * 2;
constexpr size_t WS_WOUT = WS_WBR + (size_t)NL * 4 * DM * BW * 2;
constexpr size_t WS_WGU = WS_WOUT + (size_t)NL * DM * DM * 2;
constexpr size_t WS_WDN = WS_WGU + (size_t)NL * 2 * DFF * DM * 2;
constexpr size_t WS_HF = WS_WDN + (size_t)NL * DM * DFF * 2;
constexpr size_t WS_HB = WS_HF + (size_t)MPAD * DM * 4;
constexpr size_t WS_U = WS_HB + (size_t)MPAD * DM * 2;
constexpr size_t WS_BR = WS_U + (size_t)MPAD * NINP * 2;
constexpr size_t WS_MG = WS_BR + (size_t)4 * MPAD * BW * 2;
constexpr size_t WS_MGB = WS_MG + (size_t)MPAD * DM * 4;
constexpr size_t WS_Y = WS_MGB + (size_t)MPAD * DM * 2;
constexpr size_t WS_X1F = WS_Y + (size_t)MPAD * DM * 4;
constexpr size_t WS_X1B = WS_X1F + (size_t)MPAD * DM * 4;
constexpr size_t WS_ACT = WS_X1B + (size_t)MPAD * DM * 2;
constexpr size_t WS_MEMB = WS_ACT + (size_t)MPAD * DFF * 2;
constexpr size_t WS_MKB = WS_MEMB + (size_t)512 * DM * 2;
constexpr size_t WS_MVT = WS_MKB + (size_t)NL * 512 * 1024 * 2;
constexpr size_t WS_SC = WS_MVT + (size_t)NL * 8 * 256 * 256 * 2;
constexpr size_t WS_PB = WS_SC + (size_t)8 * 4096 * 256 * 4;
constexpr size_t WS_RW = WS_PB + (size_t)8 * 4096 * 256 * 2;
constexpr size_t RW_ARR = (size_t)MPAD * BW * 4;
constexpr int GL_NCH = 512 + 128;
constexpr size_t WS_GLQD = WS_RW + 8 * RW_ARR;
constexpr size_t WS_GLKH = WS_GLQD + (size_t)GL_NCH * 8192 * 2;
constexpr size_t WS_GLE = WS_GLKH + (size_t)GL_NCH * 8192 * 2;
constexpr size_t WS_GLVT = WS_GLE + (size_t)GL_NCH * 4096 * 2;
constexpr size_t WS_GLGC = WS_GLVT + (size_t)GL_NCH * 16384 * 2;
constexpr int RB_NCH = PB * 16 * 256 + SB * 16;
constexpr int RB_EL = 9216;
constexpr int RB_QP = 4608, RB_KHP = 5760, RB_VT = 7296, RB_EP = 8832;
constexpr size_t WS_RB = WS_GLGC + (size_t)GL_NCH * 128 * 4;
constexpr size_t WS_RAW = WS_RB + (size_t)RB_NCH * RB_EL * 2;
constexpr size_t WS_LRW = WS_RAW + (size_t)2 * MPAD * BW * 2;
constexpr size_t WS_END = WS_LRW + (size_t)NL * 16 * 64 * 256 * 2;

__device__ __forceinline__ float bf2f(bf16_t b) { return __uint_as_float(((unsigned)b) << 16); }
typedef __bf16 bf16v2_t __attribute__((ext_vector_type(2)));
__device__ __forceinline__ unsigned pk2(float lo, float hi) { const f32x2 v = {lo, hi}; return __builtin_bit_cast(unsigned, __builtin_convertvector(v, bf16v2_t)); }
__device__ __forceinline__ bf16_t f2bf(float f) { return (bf16_t)(pk2(f, 0.f) & 0xffffu); }
__device__ __forceinline__ float wave_sum(float v) {
#pragma unroll
    for (int o = 32; o > 0; o >>= 1) v += __shfl_xor(v, o, 64);
    return v;
}
__device__ __forceinline__ float wave_max(float v) {
#pragma unroll
    for (int o = 32; o > 0; o >>= 1) v = fmaxf(v, __shfl_xor(v, o, 64));
    return v;
}
__device__ __forceinline__ float sigmoidf_(float x) { return 1.0f / (1.0f + __expf(-x)); }
__device__ __forceinline__ float softplusf_(float x) { return fmaxf(x, 0.f) + log1pf(__expf(-fabsf(x))); }
__device__ __forceinline__ float softplus_fast(float x) { return fmaxf(x, 0.f) + __logf(1.0f + __expf(-fabsf(x))); }
__device__ __forceinline__ float tanh_fast(float x) { return 1.0f - 2.0f / (1.0f + __expf(2.0f * x)); }

namespace pg8 {
constexpr int BM = 256, BK = 64, HALF = 128, HTB = HALF * BK * 2, STAGE_BYTES = 8 * HTB, NXCD = 8, WGM = 8;
__host__ __device__ __forceinline__ int lds_byte(int r, int c) { const int st = (r >> 4) * 2 + (c >> 5), rr = r & 15, cc = c & 31, ob = rr * 64 + cc * 2; return st * 1024 + (ob ^ (((ob >> 9) & 1) << 5)); }
__host__ __device__ __forceinline__ void stage_rc(int b, int& R, int& C) { const int st = b / 1024, sb = b % 1024, swz = sb ^ (((sb >> 9) & 1) << 5); R = (st >> 1) * 16 + swz / 64; C = (st & 1) * 32 + (swz % 64) / 2; }
__host__ __device__ __forceinline__ int perm32(int rho) { const int n = rho >> 4, i = rho & 15; return 8 * (i >> 2) + 4 * n + (i & 3); }

struct Unit { int pm, pn, z; };
template <int LDA_, int LDB_, int K_, int NM_, int NN_, int NZ_ = 1, int NZH_ = 1, bool ZINNER_ = false, long ZSAB_ = 0, long ZSAH_ = 0, long ZSBB_ = 0, long ZSBH_ = 0>
struct Gemm {
    static constexpr int LDA = LDA_, LDB = LDB_, K = K_, NM = NM_, NN = NN_, NZ = NZ_, NZH = NZH_; static constexpr bool ZINNER = ZINNER_;
    const bf16_t* A; const bf16_t* B; int G, c;
    __device__ __forceinline__ bool next(int i, Unit& u) const {
        constexpr int nt = NM * NN; int L, z;
        if (ZINNER) { const int it = i / NZ; z = i - it * NZ; const long LL = (long)it * G + c; if (LL >= nt) return false; L = (int)LL; }
        else { const long LL = (long)i * G + c; if (LL >= (long)nt * NZ) return false; z = (int)(LL / nt); L = (int)(LL - (long)z * nt); }
        int wgid = L; { constexpr int q = nt / NXCD, r = nt % NXCD; const int xcd = wgid % NXCD, off = wgid / NXCD; wgid = (xcd < r ? xcd * (q + 1) : r * (q + 1) + (xcd - r) * q) + off; }
        constexpr int nig = WGM * NN; const int gid = wgid / nig, fm = gid * WGM, gsz = (NM - fm) < WGM ? (NM - fm) : WGM;
        u.pm = fm + ((wgid % nig) % gsz); u.pn = (wgid % nig) / gsz; u.z = z; return true;
    }
    __device__ __forceinline__ const char* a_base(const Unit& u) const { const int zb = u.z / NZH, zh = u.z - zb * NZH; return (const char*)(A + zb * ZSAB_ + zh * ZSAH_ + (long)u.pm * BM * LDA); }
    __device__ __forceinline__ const char* b_base(const Unit& u) const { const int zb = u.z / NZH, zh = u.z - zb * NZH; return (const char*)(B + zb * ZSBB_ + zh * ZSBH_ + (long)u.pn * BM * LDB); }
};

template <class GT, class Epi, bool ALIGN_EPI = true, bool SP2 = true>
__device__ __forceinline__ void gemm_phase(LAS unsigned char* lds, const int tid, const GT& g, const Epi& E) {
    const int wid = __builtin_amdgcn_readfirstlane(tid >> 6), lane = tid & 63, wr = wid >> 2, wc = wid & 3, fr = lane & 15, fq = lane >> 4;
    constexpr int nt = GT::K / BK;
    unsigned voffA[2], voffB[2];
#pragma unroll
    for (int i = 0; i < 2; ++i) { int R, C; stage_rc(tid * 16 + i * 8192, R, C); const int Rb = Epi::PERM ? ((R & ~31) + perm32(R & 31)) : R;
        voffA[i] = (unsigned)(R * GT::LDA + C) * 2u; voffB[i] = (unsigned)(Rb * GT::LDB + C) * 2u; }
    constexpr size_t kstep = (size_t)(BK * 2);
    constexpr size_t hstepA = (size_t)HALF * GT::LDA * 2, hstepB = (size_t)HALF * GT::LDB * 2;
    const unsigned ldsw = (unsigned)wid * 1024u;
    const int aoff = lds_byte(wr * 64 + fr, fq * 8), boff = lds_byte(wc * 32 + fr, fq * 8);
#define PG8_SA(b, h) (((b) * 2 + (h)) * HTB)
#define PG8_SB(b, h) ((4 + (b) * 2 + (h)) * HTB)
#define PG8_STAGE(bufoff, gbase, voff) do { _Pragma("unroll") for (int _i = 0; _i < 2; ++_i) \
        __builtin_amdgcn_global_load_lds((const unsigned*)((const char*)(gbase) + (voff)[_i]), (LAS unsigned*)(lds + (bufoff) + ldsw + _i * 8192), 16, 0, 0); } while (0)
#define PG8_LDA(dst, b, h) do { _Pragma("unroll") for (int m = 0; m < 4; ++m) _Pragma("unroll") for (int k = 0; k < 2; ++k) dst[m][k] = *(const LAS bf16x8*)(lds + PG8_SA(b, h) + aoff + m * 2048 + k * 1024); } while (0)
#define PG8_LDB(dst, b, h) do { _Pragma("unroll") for (int n = 0; n < 2; ++n) _Pragma("unroll") for (int k = 0; k < 2; ++k) dst[n][k] = *(const LAS bf16x8*)(lds + PG8_SB(b, h) + boff + n * 2048 + k * 1024); } while (0)
#define PG8_MMA(ai, bj, At, Bt) do { __builtin_amdgcn_s_setprio(1); _Pragma("unroll") for (int m = 0; m < 4; ++m) _Pragma("unroll") for (int n = 0; n < 2; ++n) _Pragma("unroll") for (int k = 0; k < 2; ++k) \
        acc[ai][bj][m][n] = __builtin_amdgcn_mfma_f32_16x16x32_bf16(Bt[n][k], At[m][k], acc[ai][bj][m][n], 0, 0, 0); __builtin_amdgcn_s_setprio(0); } while (0)
#define PG8_WAIT_V(n) asm volatile("s_waitcnt vmcnt(" #n ")" ::: "memory")
#define PG8_WAIT_L(n) asm volatile("s_waitcnt lgkmcnt(" #n ")" ::: "memory")
#define PG8_BAR __builtin_amdgcn_s_barrier()
#define PG8_SCHED __builtin_amdgcn_sched_barrier(0)
    Unit cur, nxt; int ui = 0;
    if (!g.next(0, cur)) return;
    f32x4 acc[2][2][4][2];
#pragma unroll
    for (int a = 0; a < 2; ++a)
#pragma unroll
        for (int b = 0; b < 2; ++b)
#pragma unroll
            for (int m = 0; m < 4; ++m)
#pragma unroll
                for (int n = 0; n < 2; ++n) acc[a][b][m][n] = (f32x4){0.f, 0.f, 0.f, 0.f};
    bf16x8 At[4][2], B0[2][2], B1[2][2];
    const char* cA = g.a_base(cur); const char* cB = g.b_base(cur);
    if constexpr (SP2) {
        PG8_STAGE(PG8_SB(0, 0), cB, voffB); PG8_STAGE(PG8_SB(0, 1), cB + hstepB, voffB); PG8_STAGE(PG8_SA(0, 0), cA, voffA); PG8_STAGE(PG8_SA(0, 1), cA + hstepA, voffA);
        if (wr == 1) PG8_BAR;
        PG8_WAIT_V(2); PG8_BAR;
        PG8_STAGE(PG8_SB(1, 0), cB + kstep, voffB); PG8_STAGE(PG8_SA(1, 0), cA + kstep, voffA); PG8_STAGE(PG8_SB(1, 1), cB + hstepB + kstep, voffB);
        PG8_WAIT_V(6); PG8_BAR;
    } else {
        PG8_STAGE(PG8_SB(0, 0), cB, voffB); PG8_STAGE(PG8_SA(0, 0), cA, voffA); PG8_STAGE(PG8_SB(0, 1), cB + hstepB, voffB); PG8_STAGE(PG8_SA(0, 1), cA + hstepA, voffA);
        if (wr == 1) PG8_BAR;
        PG8_WAIT_V(4); PG8_BAR;
        PG8_STAGE(PG8_SB(1, 0), cB + kstep, voffB); PG8_STAGE(PG8_SA(1, 0), cA + kstep, voffA); PG8_STAGE(PG8_SB(1, 1), cB + hstepB + kstep, voffB);
        PG8_WAIT_V(6); PG8_BAR;
    }
    for (;;) {
        const bool has_next = g.next(ui + 1, nxt);
        const char* nA = has_next ? g.a_base(nxt) : cA; const char* nB = has_next ? g.b_base(nxt) : cB;
#pragma unroll 1
        for (int t = 0; t < nt; t += 2) {
            const bool last = (t == nt - 2);
            const char* a1 = cA + (size_t)(t + 1) * kstep;
            const char* a2 = last ? nA : cA + (size_t)(t + 2) * kstep; const char* b2 = last ? nB : cB + (size_t)(t + 2) * kstep;
            const char* a3 = a2 + kstep; const char* b3 = b2 + kstep;
            if constexpr (SP2) {
            PG8_LDB(B0, 0, 0); PG8_LDB(B1, 0, 1); PG8_SCHED; PG8_LDA(At, 0, 0); PG8_STAGE(PG8_SA(1, 1), a1 + hstepA, voffA);
            PG8_WAIT_V(8); PG8_WAIT_L(0); PG8_BAR; PG8_MMA(0, 0, At, B0); PG8_MMA(0, 1, At, B1); PG8_BAR; PG8_SCHED;
            PG8_LDA(At, 0, 1); PG8_STAGE(PG8_SB(0, 0), b2, voffB); PG8_STAGE(PG8_SB(0, 1), b2 + hstepB, voffB); PG8_STAGE(PG8_SA(0, 0), a2, voffA);
            PG8_WAIT_V(8); PG8_WAIT_L(0); PG8_BAR; PG8_MMA(1, 0, At, B0); PG8_MMA(1, 1, At, B1); PG8_BAR; PG8_SCHED;
            PG8_LDB(B0, 1, 0); PG8_LDB(B1, 1, 1); PG8_SCHED; PG8_LDA(At, 1, 0); PG8_STAGE(PG8_SA(0, 1), a2 + hstepA, voffA);
            PG8_WAIT_V(8); PG8_WAIT_L(0); PG8_BAR; PG8_MMA(0, 0, At, B0); PG8_MMA(0, 1, At, B1); PG8_BAR; PG8_SCHED;
            PG8_LDA(At, 1, 1); PG8_STAGE(PG8_SB(1, 0), b3, voffB); PG8_STAGE(PG8_SB(1, 1), b3 + hstepB, voffB); PG8_STAGE(PG8_SA(1, 0), a3, voffA);
            PG8_WAIT_V(8); PG8_WAIT_L(0); PG8_BAR; PG8_MMA(1, 0, At, B0); PG8_MMA(1, 1, At, B1); PG8_BAR; PG8_SCHED;
            } else {
            PG8_LDB(B0, 0, 0); PG8_SCHED; PG8_LDA(At, 0, 0); PG8_STAGE(PG8_SA(1, 1), a1 + hstepA, voffA);
            PG8_WAIT_L(8); PG8_BAR; PG8_WAIT_L(0); PG8_MMA(0, 0, At, B0); PG8_BAR; PG8_SCHED;
            PG8_LDB(B1, 0, 1); PG8_STAGE(PG8_SB(0, 0), b2, voffB);
            PG8_BAR; PG8_WAIT_L(0); PG8_MMA(0, 1, At, B1); PG8_BAR;
            PG8_LDA(At, 0, 1); PG8_STAGE(PG8_SA(0, 0), a2, voffA);
            PG8_BAR; PG8_WAIT_L(0); PG8_MMA(1, 0, At, B0); PG8_BAR; PG8_SCHED;
            PG8_STAGE(PG8_SB(0, 1), b2 + hstepB, voffB);
            PG8_WAIT_V(6); PG8_BAR; PG8_MMA(1, 1, At, B1); PG8_BAR;
            PG8_LDB(B0, 1, 0); PG8_SCHED; PG8_LDA(At, 1, 0); PG8_STAGE(PG8_SA(0, 1), a2 + hstepA, voffA);
            PG8_WAIT_L(8); PG8_BAR; PG8_WAIT_L(0); PG8_MMA(0, 0, At, B0); PG8_BAR; PG8_SCHED;
            PG8_LDB(B1, 1, 1); PG8_STAGE(PG8_SB(1, 0), b3, voffB);
            PG8_BAR; PG8_WAIT_L(0); PG8_MMA(0, 1, At, B1); PG8_BAR;
            PG8_LDA(At, 1, 1); PG8_STAGE(PG8_SA(1, 0), a3, voffA);
            PG8_BAR; PG8_WAIT_L(0); PG8_MMA(1, 0, At, B0); PG8_BAR; PG8_SCHED;
            PG8_STAGE(PG8_SB(1, 1), b3 + hstepB, voffB);
            PG8_WAIT_V(6); PG8_BAR; PG8_MMA(1, 1, At, B1); PG8_BAR;
            }
        }
        if constexpr (ALIGN_EPI) { if (wr == 0) PG8_BAR; }
        E(acc, cur, wr, wc, fr, fq);
        if (!has_next) break;
#pragma unroll
        for (int a = 0; a < 2; ++a)
#pragma unroll
            for (int b = 0; b < 2; ++b)
#pragma unroll
                for (int m = 0; m < 4; ++m)
#pragma unroll
                    for (int n = 0; n < 2; ++n) acc[a][b][m][n] = (f32x4){0.f, 0.f, 0.f, 0.f};
        cur = nxt; cA = nA; cB = nB; ++ui;
        if constexpr (ALIGN_EPI) { if (wr == 1) PG8_BAR; }
    }
    PG8_WAIT_V(0);
    if constexpr (!ALIGN_EPI) { if (wr == 0) PG8_BAR; }
    PG8_BAR;
#undef PG8_SA
#undef PG8_SB
#undef PG8_STAGE
#undef PG8_LDA
#undef PG8_LDB
#undef PG8_MMA
#undef PG8_WAIT_V
#undef PG8_WAIT_L
#undef PG8_BAR
#undef PG8_SCHED
}

struct EpiBf16 {
    static constexpr bool PERM = true;
    bf16_t* O; long zs; int ldc, pad;
    __device__ __forceinline__ void operator()(const f32x4 (&acc)[2][2][4][2], const Unit& u, int wr, int wc, int fr, int fq) const {
        const int row0 = u.pm * BM + wr * 64 + fr, col0 = u.pn * BM + wc * 32 + 8 * fq; bf16_t* base = O + (long)u.z * zs;
#pragma unroll
        for (int ai = 0; ai < 2; ++ai)
#pragma unroll
            for (int m = 0; m < 4; ++m) { bf16_t* rowp = base + (size_t)(row0 + ai * HALF + m * 16) * ldc + col0;
#pragma unroll
                for (int bj = 0; bj < 2; ++bj) { const f32x4 v0 = acc[ai][bj][m][0], v1 = acc[ai][bj][m][1];
                    u32x4 w; w.x = pk2(v0[0], v0[1]); w.y = pk2(v0[2], v0[3]); w.z = pk2(v1[0], v1[1]); w.w = pk2(v1[2], v1[3]);
                    *(u32x4*)(rowp + bj * HALF) = w; } }
    }
};
struct EpiMem {
    static constexpr bool PERM = false;
    float* outK; float* outV; bf16_t* kb; bf16_t* vt;
    __device__ __forceinline__ void operator()(const f32x4 (&acc)[2][2][4][2], const Unit& u, int wr, int wc, int fr, int fq) const {
        const int row0 = u.pm * BM + wr * 64 + fr, col0 = u.pn * BM + wc * 32 + 4 * fq;
#pragma unroll
        for (int ai = 0; ai < 2; ++ai)
#pragma unroll
            for (int m = 0; m < 4; ++m) { const int row = row0 + ai * HALF + m * 16;
#pragma unroll
                for (int bj = 0; bj < 2; ++bj)
#pragma unroll
                    for (int n = 0; n < 2; ++n) { const int col = col0 + bj * HALF + n * 16; const f32x4 v = acc[ai][bj][m][n];
                        if (col < 1024) { *(f32x4*)(outK + ((size_t)u.z * 512 + row) * 1024 + col) = v;
                            u32x2 w; w.x = pk2(v[0], v[1]); w.y = pk2(v[2], v[3]); *(u32x2*)(kb + ((size_t)u.z * 512 + row) * 1024 + col) = w; }
                        else { const int c = col - 1024; *(f32x4*)(outV + ((size_t)u.z * 512 + row) * 1024 + c) = v;
                            const int b = row >> 8, mm = row & 255, h = c >> 8, d = c & 255; bf16_t* p = vt + ((((size_t)u.z * 2 + b) * 4 + h) * 256 + d) * 256 + mm;
                            p[0] = f2bf(v[0]); p[256] = f2bf(v[1]); p[512] = f2bf(v[2]); p[768] = f2bf(v[3]); } } }
    }
};
struct EpiMerge {
    static constexpr bool PERM = false;
    float* MG; bf16_t* MGB; const bf16_t* U; const float* gate_b;
    __device__ __forceinline__ void operator()(const f32x4 (&acc)[2][2][4][2], const Unit& u, int wr, int wc, int fr, int fq) const {
        const int row0 = u.pm * BM + wr * 64 + fr, col0 = u.pn * BM + wc * 32 + 4 * fq;
#pragma unroll
        for (int ai = 0; ai < 2; ++ai)
#pragma unroll
            for (int m = 0; m < 4; ++m) { const int row = row0 + ai * HALF + m * 16;
#pragma unroll
                for (int bj = 0; bj < 2; ++bj)
#pragma unroll
                    for (int n = 0; n < 2; ++n) { const int col = col0 + bj * HALF + n * 16; const f32x4 v = acc[ai][bj][m][n];
                        const u32x2 gp = *(const u32x2*)(U + (size_t)row * NINP + U_GP + u.z * DM + col); const f32x4 gb = *(const f32x4*)(gate_b + u.z * DM + col);
                        f32x4 gt; gt[0] = sigmoidf_(__uint_as_float(gp.x << 16) + gb[0]); gt[1] = sigmoidf_(__uint_as_float(gp.x & 0xffff0000u) + gb[1]);
                        gt[2] = sigmoidf_(__uint_as_float(gp.y << 16) + gb[2]); gt[3] = sigmoidf_(__uint_as_float(gp.y & 0xffff0000u) + gb[3]);
                        float* mp = MG + (size_t)row * DM + col; f32x4 r = gt * v;
                        if (u.z > 0) r += *(const f32x4*)mp;
                        if (u.z < 3) *(f32x4*)mp = r;
                        else { u32x2 w; w.x = pk2(r[0], r[1]); w.y = pk2(r[2], r[3]); *(u32x2*)(MGB + (size_t)row * DM + col) = w; } } }
    }
};
struct EpiRes {
    static constexpr bool PERM = false;
    const float* R; float* Y;
    __device__ __forceinline__ void operator()(const f32x4 (&acc)[2][2][4][2], const Unit& u, int wr, int wc, int fr, int fq) const {
        const int row0 = u.pm * BM + wr * 64 + fr, col0 = u.pn * BM + wc * 32 + 4 * fq;
#pragma unroll
        for (int ai = 0; ai < 2; ++ai)
#pragma unroll
            for (int m = 0; m < 4; ++m) { const size_t ro = (size_t)(row0 + ai * HALF + m * 16) * DM + col0;
#pragma unroll
                for (int bj = 0; bj < 2; ++bj)
#pragma unroll
                    for (int n = 0; n < 2; ++n) { const size_t o = ro + bj * HALF + n * 16; *(f32x4*)(Y + o) = *(const f32x4*)(R + o) * ALPHA + acc[ai][bj][m][n]; } }
    }
};
struct EpiSwiGLU {
    static constexpr bool PERM = true;
    bf16_t* O;
    __device__ __forceinline__ void operator()(const f32x4 (&acc)[2][2][4][2], const Unit& u, int wr, int wc, int fr, int fq) const {
        const int row0 = u.pm * BM + wr * 64 + fr, col0 = u.pn * HALF + wc * 32 + 8 * fq;
#pragma unroll
        for (int ai = 0; ai < 2; ++ai)
#pragma unroll
            for (int m = 0; m < 4; ++m) { bf16_t* rowp = O + (size_t)(row0 + ai * HALF + m * 16) * DFF + col0;
                float r[8];
#pragma unroll
                for (int n = 0; n < 2; ++n)
#pragma unroll
                    for (int j = 0; j < 4; ++j) { const float gg = acc[ai][0][m][n][j], uu = acc[ai][1][m][n][j]; r[n * 4 + j] = gg * sigmoidf_(gg) * uu; }
                u32x4 w; w.x = pk2(r[0], r[1]); w.y = pk2(r[2], r[3]); w.z = pk2(r[4], r[5]); w.w = pk2(r[6], r[7]);
                *(u32x4*)rowp = w; }
    }
};
struct EpiScore {
    static constexpr bool PERM = false;
    float* SC;
    __device__ __forceinline__ void operator()(const f32x4 (&acc)[2][2][4][2], const Unit& u, int wr, int wc, int fr, int fq) const {
        const int row0 = u.pm * BM + wr * 64 + fr, col0 = wc * 32 + 4 * fq; float* base = SC + (size_t)u.z * 4096 * 256;
#pragma unroll
        for (int ai = 0; ai < 2; ++ai)
#pragma unroll
            for (int m = 0; m < 4; ++m) { float* rowp = base + (size_t)(row0 + ai * HALF + m * 16) * 256 + col0;
#pragma unroll
                for (int bj = 0; bj < 2; ++bj)
#pragma unroll
                    for (int n = 0; n < 2; ++n) *(f32x4*)(rowp + bj * HALF + n * 16) = acc[ai][bj][m][n] * 0.0625f; }
    }
};
struct EpiPV {
    static constexpr bool PERM = true;
    bf16_t* O;
    __device__ __forceinline__ void operator()(const f32x4 (&acc)[2][2][4][2], const Unit& u, int wr, int wc, int fr, int fq) const {
        const int b = u.z >> 2, h = u.z & 3; const int row0 = b * PS + u.pm * BM + wr * 64 + fr, col0 = h * 256 + wc * 32 + 8 * fq;
#pragma unroll
        for (int ai = 0; ai < 2; ++ai)
#pragma unroll
            for (int m = 0; m < 4; ++m) { bf16_t* rowp = O + (size_t)(row0 + ai * HALF + m * 16) * BW + col0;
#pragma unroll
                for (int bj = 0; bj < 2; ++bj) { const f32x4 v0 = acc[ai][bj][m][0], v1 = acc[ai][bj][m][1];
                    u32x4 w; w.x = pk2(v0[0], v0[1]); w.y = pk2(v0[2], v0[3]); w.z = pk2(v1[0], v1[1]); w.w = pk2(v1[2], v1[3]);
                    *(u32x4*)(rowp + bj * HALF) = w; } }
    }
};
}


#define XB_TMO      128
#define XB_XCNT(j)  (256  + 64 * (j))
#define XB_XSUB(j)  (1280 + 64 * (j))
#define XB_XGEN(j)  (2304 + 64 * (j))
#define XB_TOP      3328
#define XB_TOPGEN   3392
#define XCD_BAR_WORDS 3456
#define XB_SPIN_CAP (1u << 18)
__device__ __forceinline__ unsigned xb_ld(unsigned* p)              { return __hip_atomic_load(p, __ATOMIC_RELAXED, __HIP_MEMORY_SCOPE_AGENT); }
__device__ __forceinline__ unsigned xb_add(unsigned* p, unsigned v) { return __hip_atomic_fetch_add(p, v, __ATOMIC_RELAXED, __HIP_MEMORY_SCOPE_AGENT); }
__device__ __forceinline__ unsigned xb_xcc_id() { return (unsigned)__builtin_amdgcn_s_getreg((3 << 11) | 20) & 0xFu; }
#define XB_SPIN(cond, bar) do { unsigned _sp = 0; while (cond) { __builtin_amdgcn_s_sleep(1); \
    if ((++_sp & 255u) == 0u) { if (xb_ld(&(bar)[XB_TMO])) break; if (_sp > XB_SPIN_CAP) { atomicAdd(&(bar)[XB_TMO], 1u); break; } } } } while (0)
struct XcdBarrier { unsigned* bar; unsigned x; volatile LAS unsigned* st; };
__device__ __forceinline__ XcdBarrier xcd_barrier_post(unsigned* bar, volatile LAS unsigned* st) {
    XcdBarrier b; b.bar = bar; b.x = xb_xcc_id(); b.st = st;
    if (threadIdx.x == 0) (void)xb_add(&bar[XB_XCNT(b.x)], 1u);
    return b;
}
__device__ __forceinline__ void xcd_barrier_complete(unsigned* bar, unsigned x, unsigned& nloc, unsigned& nx) {
    const unsigned G = gridDim.x * gridDim.y * gridDim.z;
    unsigned sum, cnt, mine, sp = 0u;
    for (;;) {
        sum = 0u; cnt = 0u; mine = 0u;
#pragma unroll
        for (unsigned j = 0; j < 16; ++j) { const unsigned c = xb_ld(&bar[XB_XCNT(j)]); sum += c; cnt += (c > 0u) ? 1u : 0u; mine = (j == x) ? c : mine; }
        if (sum == G) break;
        __builtin_amdgcn_s_sleep(1);
        if ((++sp & 255u) == 0u) { if (xb_ld(&bar[XB_TMO])) break; if (sp > XB_SPIN_CAP) { atomicAdd(&bar[XB_TMO], 1u); break; } }
    }
    nloc = mine > 0u ? mine : 1u; nx = cnt > 0u ? cnt : 1u;
}
__device__ __forceinline__ void xcd_barrier(const XcdBarrier& b) {
    asm volatile("s_waitcnt vmcnt(0)" ::: "memory");
    __syncthreads();
    if (threadIdx.x == 0) {
        unsigned* bar = b.bar;
        __builtin_amdgcn_s_waitcnt(0);
        unsigned nloc = b.st[0], nx = b.st[1];
        if (nloc == 0u) { xcd_barrier_complete(bar, b.x, nloc, nx); b.st[0] = nloc; b.st[1] = nx; }
        const unsigned old = xb_add(&bar[XB_XSUB(b.x)], 1u);
        const unsigned gen = old / nloc;
        if (old + 1u == (gen + 1u) * nloc) {
            __builtin_amdgcn_fence(__ATOMIC_RELEASE, "agent");
            asm volatile("s_waitcnt vmcnt(0)" ::: "memory");
            const unsigned og = xb_add(&bar[XB_TOP], 1u);
            const unsigned tg = og / nx;
            if (og + 1u == (tg + 1u) * nx) xb_add(&bar[XB_TOPGEN], 1u);
            else XB_SPIN(xb_ld(&bar[XB_TOPGEN]) == tg, bar);
            __builtin_amdgcn_fence(__ATOMIC_ACQUIRE, "agent");
            xb_add(&bar[XB_XGEN(b.x)], 1u);
            asm volatile("s_waitcnt vmcnt(0)" ::: "memory");
        } else {
            XB_SPIN(xb_ld(&bar[XB_XGEN(b.x)]) == gen, bar);
            __builtin_amdgcn_fence(__ATOMIC_ACQUIRE, "agent");
            asm volatile("s_waitcnt vmcnt(0)" ::: "memory");
        }
    }
    __syncthreads();
}

struct Ctx { int tid, lane, wave, bid, G; LAS unsigned char* lds; };
__device__ __forceinline__ Ctx fresh(const Ctx& c0) { Ctx c; c.wave = c0.wave; c.bid = c0.bid; c.G = c0.G; c.lds = c0.lds; asm volatile("" : "+s"(c.bid), "+s"(c.G), "+s"(c.wave));
    int lane = (int)__builtin_amdgcn_mbcnt_hi(~0u, __builtin_amdgcn_mbcnt_lo(~0u, 0u)); asm volatile("" : "+v"(lane)); c.lane = lane; c.tid = c.wave * 64 + lane; return c; }

__device__ __forceinline__ int colmap(int mode, int n) {
    if (mode == 1) return n < 3088 ? n : (n < 3328 ? -1 : n - 240);
    if (mode == 2) { const int t = n >> 8, j = n & 255; return j < 128 ? t * 128 + j : DFF + t * 128 + (j - 128); }
    return n;
}
__device__ __forceinline__ void wprep_load(f32x4 (&rg)[8], const float* __restrict__ src, int K, int Nsrc, int Ndst, int mode, size_t sbs, int item, int tid) {
    const int nx = Ndst / 256, ny = K / 64; const int bx = item % nx, by = (item / nx) % ny, bz = item / (nx * ny);
    const int tx = tid & 63, ty = tid >> 6, cm = colmap(mode, bx * 256 + tx * 4); const float* s = src + (size_t)bz * sbs + (size_t)(by * 64 + ty) * Nsrc + cm;
#pragma unroll
    for (int i = 0; i < 8; ++i) rg[i] = cm >= 0 ? *(const f32x4*)(s + (size_t)(8 * i) * Nsrc) : (f32x4){0.f, 0.f, 0.f, 0.f};
}
__device__ __forceinline__ void ph_wprep(const Ctx& c, const float* __restrict__ src, bf16_t* __restrict__ dst, int K, int Nsrc, int Ndst, int mode, int nbatch, size_t sbs, size_t dbs) {
    LAS float* tile = (LAS float*)c.lds;
    const int nx = Ndst / 256, ny = K / 64, total = nx * ny * nbatch;
    const int tid = c.tid, tx = tid & 63, ty = tid >> 6, n = tid >> 1, kh = tid & 1;
    f32x4 rg[8];
    int item = c.bid;
    if (item < total) wprep_load(rg, src, K, Nsrc, Ndst, mode, sbs, item, tid);
    for (; item < total; item += c.G) {
        __syncthreads();
#pragma unroll
        for (int i = 0; i < 8; ++i) *(LAS f32x4*)(tile + (ty + 8 * i) * 260 + tx * 4) = rg[i];
        __syncthreads();
        const int bx = item % nx, by = (item / nx) % ny, bz = item / (nx * ny);
        if (item + c.G < total) wprep_load(rg, src, K, Nsrc, Ndst, mode, sbs, item + c.G, tid);
        bf16_t* d = dst + (size_t)bz * dbs + (size_t)(bx * 256 + n) * K + by * 64 + kh * 32;
#pragma unroll
        for (int g = 0; g < 4; ++g) { unsigned p[4];
#pragma unroll
            for (int e = 0; e < 4; ++e) p[e] = pk2(tile[(kh * 32 + g * 8 + 2 * e) * 260 + n], tile[(kh * 32 + g * 8 + 2 * e + 1) * 260 + n]);
            *(u32x4*)(d + g * 8) = (u32x4){p[0], p[1], p[2], p[3]}; }
    }
    __syncthreads();
}
__device__ __forceinline__ void ph_xprep(const Ctx& c, const float* __restrict__ xp, const float* __restrict__ xs, const float* __restrict__ mem, float* __restrict__ HF, bf16_t* __restrict__ HB, bf16_t* __restrict__ MEMB) {
    const size_t nH = (size_t)MPAD * DM / 4, nM = (size_t)512 * DM / 4;
    for (size_t i4 = (size_t)c.bid * 512 + c.tid; i4 < nH + nM; i4 += (size_t)c.G * 512) {
        if (i4 < nH) {
            const size_t e = i4 * 4; f32x4 v = (f32x4){0.f, 0.f, 0.f, 0.f};
            if (e < (size_t)MP * DM) v = *(const f32x4*)(xp + e); else if (e < (size_t)MT * DM) v = *(const f32x4*)(xs + (e - (size_t)MP * DM));
            *(f32x4*)(HF + e) = v; u32x2 w; w.x = pk2(v[0], v[1]); w.y = pk2(v[2], v[3]); *(u32x2*)(HB + e) = w;
        } else {
            const size_t e = (i4 - nH) * 4; const f32x4 v = *(const f32x4*)(mem + e); u32x2 w; w.x = pk2(v[0], v[1]); w.y = pk2(v[2], v[3]); *(u32x2*)(MEMB + e) = w;
        }
    }
}
__device__ __forceinline__ void ph_ln(const Ctx& c, const float* __restrict__ Y, const float* __restrict__ g, const float* __restrict__ b, float* __restrict__ XF, bf16_t* __restrict__ XB, float* __restrict__ OUT, int nrows, int nout) {
    const int lane = c.lane;
    for (int row = c.bid * 8 + c.wave; row < nrows; row += c.G * 8) {
        const float* y = Y + (size_t)row * DM; f32x4 v[8]; float s = 0.f;
#pragma unroll
        for (int j = 0; j < 8; ++j) { v[j] = *(const f32x4*)(y + j * 256 + lane * 4); s += (v[j][0] + v[j][1]) + (v[j][2] + v[j][3]); }
        const float mean = wave_sum(s) * (1.0f / DM); float q = 0.f;
#pragma unroll
        for (int j = 0; j < 8; ++j) { const f32x4 d = v[j] - mean; q += (d[0] * d[0] + d[1] * d[1]) + (d[2] * d[2] + d[3] * d[3]); }
        const float rstd = rsqrtf(wave_sum(q) * (1.0f / DM) + 1e-5f);
#pragma unroll
        for (int j = 0; j < 8; ++j) { const int cc = j * 256 + lane * 4; const f32x4 gg = *(const f32x4*)(g + cc), bb = *(const f32x4*)(b + cc);
            const f32x4 o = (v[j] - mean) * rstd * gg + bb; const size_t off = (size_t)row * DM + cc;
            *(f32x4*)(XF + off) = o; u32x2 w; w.x = pk2(o[0], o[1]); w.y = pk2(o[2], o[3]); *(u32x2*)(XB + off) = w;
            if (OUT != nullptr && row < nout) *(f32x4*)(OUT + off) = o; }
    }
}
__device__ __forceinline__ void ph_softmax256(const Ctx& c, const float* __restrict__ SC, bf16_t* __restrict__ P, int nrows) {
    const int lane = c.lane;
    for (int row = c.bid * 8 + c.wave; row < nrows; row += c.G * 8) {
        const f32x4 v = *(const f32x4*)(SC + (size_t)row * 256 + lane * 4);
        const float mx = wave_max(fmaxf(fmaxf(v[0], v[1]), fmaxf(v[2], v[3])));
        f32x4 e; e[0] = __expf(v[0] - mx); e[1] = __expf(v[1] - mx); e[2] = __expf(v[2] - mx); e[3] = __expf(v[3] - mx);
        const float inv = 1.0f / wave_sum((e[0] + e[1]) + (e[2] + e[3]));
        u32x2 w; w.x = pk2(e[0] * inv, e[1] * inv); w.y = pk2(e[2] * inv, e[3] * inv); *(u32x2*)(P + (size_t)row * 256 + lane * 4) = w;
    }
}
__device__ __forceinline__ void ph_copy_outs(const Ctx& c, const bf16_t* __restrict__ U, const float* __restrict__ ck, const float* __restrict__ cv, float* __restrict__ out, int layer) {
    constexpr int nA = PB * 128 * 128, nB = SB * 128 * 128, nC = PB * RWC, nD = SB * RWC;
    for (int i = c.bid * 512 + c.tid; i < nA + nB + nC + nD; i += c.G * 512) {
        if (i < nA) { const int b = i / 16384, j = (i >> 7) & 127, cc = i & 127; const size_t ur = (size_t)(b * PS + PS - 128 + j) * NINP;
            out[O_SWKP + (size_t)layer * nA + i] = bf2f(U[ur + U_SK + cc]); out[O_SWVP + (size_t)layer * nA + i] = bf2f(U[ur + U_SV + cc]); continue; }
        int k = i - nA;
        if (k < nB) { const int sq = k / 16384, j = (k >> 7) & 127, cc = k & 127; float kv, vv;
            if (j < 124) { const size_t o = ((size_t)sq * 128 + j + 4) * 128 + cc; kv = ck[o]; vv = cv[o]; }
            else { const size_t ur = (size_t)(MP + sq * SS + j - 124) * NINP; kv = bf2f(U[ur + U_SK + cc]); vv = bf2f(U[ur + U_SV + cc]); }
            out[O_SWKS + (size_t)layer * nB + k] = kv; out[O_SWVS + (size_t)layer * nB + k] = vv; continue; }
        k -= nB;
        if (k < nC) { const int b = k / RWC, cc = k - b * RWC; out[O_RSP + (size_t)layer * nC + k] = bf2f(U[(size_t)(b * PS + PS - 1) * NINP + U_RU + cc]); continue; }
        k -= nC;
        { const int sq = k / RWC, cc = k - sq * RWC; out[O_RSS + (size_t)layer * nD + k] = bf2f(U[(size_t)(MP + sq * SS + SS - 1) * NINP + U_RU + cc]); }
    }
}

__device__ __forceinline__ void seq_info(int sq, int& row0, int& L) { if (sq < PB) { row0 = sq * PS; L = PS; } else { row0 = MP + (sq - PB) * SS; L = SS; } }

__device__ __forceinline__ void ph_gla_naive(const Ctx& c, const bf16_t* __restrict__ U, const float* __restrict__ s0, const float* __restrict__ a_up, const float* __restrict__ a_b,
                                             const float* __restrict__ ng, const float* __restrict__ nb, bf16_t* __restrict__ OB, float* __restrict__ outP, float* __restrict__ outS) {
    LAS float* qs = (LAS float*)c.lds;
    LAS float* ks = qs + 16 * 128; LAS float* as = ks + 16 * 128; LAS float* os = as + 16 * 128;
    const int kh = c.tid >> 8, vt = c.tid & 255, lane = c.lane;
    for (int u = c.bid; u < (PB + SB) * 4; u += c.G) {
        const int sq = u >> 2, h = u & 3;
        int row0, L; seq_info(sq, row0, L);
        float S[64];
        if (sq >= PB) { const float* p = s0 + (((size_t)(sq - PB) * 4 + h) * 128 + kh * 64) * 256 + vt;
#pragma unroll
            for (int kk = 0; kk < 64; ++kk) S[kk] = p[(size_t)kk * 256]; }
        else {
#pragma unroll
            for (int kk = 0; kk < 64; ++kk) S[kk] = 0.f; }
        for (int t0 = 0; t0 < L; t0 += 16) {
            const int nT = (L - t0) < 16 ? (L - t0) : 16;
            for (int idx = c.tid; idx < nT * 128; idx += 512) {
                const int tt = idx >> 7, kk = idx & 127; const bf16_t* ur = U + (size_t)(row0 + t0 + tt) * NINP;
                qs[idx] = bf2f(ur[U_GQ + h * 128 + kk]) * 0.08838834764831845f; ks[idx] = bf2f(ur[U_GK + h * 128 + kk]);
                float x = a_b[h * 128 + kk];
#pragma unroll
                for (int r = 0; r < 16; ++r) x += bf2f(ur[U_GA + r]) * a_up[r * 512 + h * 128 + kk];
                const float ls = (fminf(x, 0.f) - log1pf(__expf(-fabsf(x)))) * (1.0f / 16.0f);
                as[idx] = __expf(ls);
            }
            __syncthreads();
            for (int tt = 0; tt < nT; ++tt) {
                const float v = bf2f(U[(size_t)(row0 + t0 + tt) * NINP + U_GV + h * 256 + vt]); float o = 0.f; const int lb = tt * 128 + kh * 64;
#pragma unroll
                for (int kk = 0; kk < 64; ++kk) { S[kk] = as[lb + kk] * S[kk] + ks[lb + kk] * v; o += qs[lb + kk] * S[kk]; }
                os[(kh * 16 + tt) * 256 + vt] = o;
            }
            __syncthreads();
            for (int tt = c.wave; tt < nT; tt += 8) {
                float x[4]; float s = 0.f;
#pragma unroll
                for (int j = 0; j < 4; ++j) { x[j] = os[tt * 256 + lane + 64 * j] + os[(16 + tt) * 256 + lane + 64 * j]; s += x[j]; }
                const float mean = wave_sum(s) * (1.0f / 256.0f); float q = 0.f;
#pragma unroll
                for (int j = 0; j < 4; ++j) { const float d = x[j] - mean; q += d * d; }
                const float rstd = rsqrtf(wave_sum(q) * (1.0f / 256.0f) + 1e-5f);
                const size_t row = (size_t)(row0 + t0 + tt);
#pragma unroll
                for (int j = 0; j < 4; ++j) { const int cc = h * 256 + lane + 64 * j; const float n = (x[j] - mean) * rstd * ng[cc] + nb[cc];
                    const float gr = bf2f(U[row * NINP + U_GR + cc]); OB[row * BW + cc] = f2bf(n * gr * sigmoidf_(gr)); }
            }
            __syncthreads();
        }
        float* op = (sq < PB ? outP + (((size_t)sq * 4 + h) * 128 + kh * 64) * 256 : outS + (((size_t)(sq - PB) * 4 + h) * 128 + kh * 64) * 256) + vt;
#pragma unroll
        for (int kk = 0; kk < 64; ++kk) op[(size_t)kk * 256] = S[kk];
    }
}

__device__ __forceinline__ f32x4 mma16(bf16x8 x, bf16x8 y, f32x4 c) { return __builtin_amdgcn_mfma_f32_16x16x32_bf16(x, y, c, 0, 0, 0); }
__device__ __forceinline__ bf16x8 pack_acc(const f32x4& a, const f32x4& b) {
    u32x4 p; p.x = pk2(a[0], a[1]); p.y = pk2(a[2], a[3]); p.z = pk2(b[0], b[1]); p.w = pk2(b[2], b[3]); return __builtin_bit_cast(bf16x8, p);
}
__device__ __forceinline__ void gla_chunk_info(int u, int& row0, int& ntok, int& h) {
    if (u < 512) { const int b = u >> 8; h = (u >> 6) & 3; row0 = b * PS + (u & 63) * 64; ntok = 64; }
    else { const int s = u - 512; h = s & 3; row0 = MP + (s >> 2) * SS; ntok = SS; }
}
__device__ __forceinline__ void ph_gla_pre(const Ctx& c, const bf16_t* __restrict__ U, const float* __restrict__ a_up, const float* __restrict__ a_b,
                                           bf16_t* __restrict__ QD, bf16_t* __restrict__ KHT, bf16_t* __restrict__ EE, bf16_t* __restrict__ VT, float* __restrict__ GC) {
    LAS float* ga_l = (LAS float*)c.lds;
    LAS float* tot = ga_l + 64 * 16;
    LAS bf16_t* Qd_l = (LAS bf16_t*)(tot + 4 * 128);
    LAS bf16_t* Kn_l = Qd_l + 64 * 136;
    LAS bf16_t* v_l = Kn_l + 64 * 136;
    LAS bf16_t* qr_l = v_l + 64 * 264;
    LAS bf16_t* kr_l = qr_l + 64 * 136;
    const int tid = c.tid, lane = c.lane, r = lane & 15, q = lane >> 4, w = c.wave;
    for (int u = c.bid; u < GL_NCH; u += c.G) {
        int row0, ntok, h; gla_chunk_info(u, row0, ntok, h);
        for (int i = tid; i < 64 * 16; i += 512) { const int t = i >> 4, rr = i & 15; ga_l[i] = t < ntok ? bf2f(U[(size_t)(row0 + t) * NINP + U_GA + rr]) : 0.f; }
        for (int i = tid; i < 64 * 32; i += 512) { const int t = i >> 5, c8 = i & 31; u32x4 vv = (u32x4){0u, 0u, 0u, 0u};
            if (t < ntok) vv = *(const u32x4*)(U + (size_t)(row0 + t) * NINP + U_GV + h * 256 + c8 * 8);
            *(LAS u32x4*)(v_l + t * 264 + c8 * 8) = vv; }
        for (int i = tid; i < 64 * 16; i += 512) { const int t = i >> 4, c8 = i & 15; u32x4 qv = (u32x4){0u, 0u, 0u, 0u}, kv = qv;
            if (t < ntok) { const bf16_t* ur = U + (size_t)(row0 + t) * NINP + h * 128 + c8 * 8; qv = *(const u32x4*)(ur + U_GQ); kv = *(const u32x4*)(ur + U_GK); }
            *(LAS u32x4*)(qr_l + t * 136 + c8 * 8) = qv; *(LAS u32x4*)(kr_l + t * 136 + c8 * 8) = kv; }
        __syncthreads();
        const int kk = tid & 127, tq = tid >> 7;
        float cum[16];
        { float aup[16];
#pragma unroll
          for (int rr = 0; rr < 16; ++rr) aup[rr] = a_up[rr * 512 + h * 128 + kk];
          const float ab = a_b[h * 128 + kk]; float run = 0.f;
#pragma unroll
          for (int j = 0; j < 16; ++j) { const int t = tq * 16 + j; float x = ab;
#pragma unroll
              for (int rr = 0; rr < 16; ++rr) x += ga_l[t * 16 + rr] * aup[rr];
              const float la = t < ntok ? (fminf(x, 0.f) - __logf(1.0f + __expf(-fabsf(x)))) * (1.0f / 16.0f) : 0.f;
              run += la; cum[j] = run; }
          tot[tq * 128 + kk] = run; }
        __syncthreads();
        { float prefix = 0.f, bC = 0.f;
#pragma unroll
          for (int g = 0; g < 4; ++g) { const float tv = tot[g * 128 + kk]; bC += tv; if (g < tq) prefix += tv; }
          unsigned khp[8];
#pragma unroll
          for (int j = 0; j < 16; j += 2) { float kh2[2];
#pragma unroll
              for (int e = 0; e < 2; ++e) { const int t = tq * 16 + j + e; const float b = prefix + cum[j + e]; const float qv = bf2f(qr_l[t * 136 + kk]), kv = bf2f(kr_l[t * 136 + kk]);
                  Qd_l[t * 136 + kk] = f2bf(qv * __expf(b) * 0.08838834764831845f); Kn_l[t * 136 + kk] = f2bf(kv * __expf(-b)); kh2[e] = kv * __expf(bC - b); }
              khp[j >> 1] = pk2(kh2[0], kh2[1]); }
          bf16_t* kp = KHT + (size_t)u * 8192 + kk * 64 + tq * 16;
          *(u32x4*)kp = (u32x4){khp[0], khp[1], khp[2], khp[3]}; *(u32x4*)(kp + 8) = (u32x4){khp[4], khp[5], khp[6], khp[7]};
          if (tq == 0) GC[(size_t)u * 128 + kk] = __expf(bC); }
        __syncthreads();
        { const int tb = w >> 1;
#pragma unroll
          for (int e = 0; e < 2; ++e) { const int ib = (w & 1) * 2 + e; f32x4 d = (f32x4){0.f, 0.f, 0.f, 0.f};
              if (ib <= tb) {
#pragma unroll
                  for (int ks = 0; ks < 4; ++ks) d = mma16(*(const LAS bf16x8*)(Kn_l + (ib * 16 + r) * 136 + ks * 32 + q * 8), *(const LAS bf16x8*)(Qd_l + (tb * 16 + r) * 136 + ks * 32 + q * 8), d); }
              const int t = tb * 16 + r, i0 = ib * 16 + q * 4;
#pragma unroll
              for (int jj = 0; jj < 4; ++jj) if (i0 + jj > t) d[jj] = 0.f;
              u32x2 o; o.x = pk2(d[0], d[1]); o.y = pk2(d[2], d[3]); *(u32x2*)(EE + (size_t)u * 4096 + t * 64 + i0) = o; } }
        for (int i = tid; i < 64 * 16; i += 512) { const int t = i >> 4, c8 = i & 15; *(u32x4*)(QD + (size_t)u * 8192 + t * 128 + c8 * 8) = *(const LAS u32x4*)(Qd_l + t * 136 + c8 * 8); }
        { const int val = tid & 255, th = tid >> 8;
#pragma unroll
          for (int tg = 0; tg < 4; ++tg) { const int t0 = th * 32 + tg * 8; unsigned p4[4];
#pragma unroll
              for (int e = 0; e < 4; ++e) p4[e] = (unsigned)v_l[(t0 + 2 * e) * 264 + val] | ((unsigned)v_l[(t0 + 2 * e + 1) * 264 + val] << 16);
              *(u32x4*)(VT + (size_t)u * 16384 + val * 64 + t0) = (u32x4){p4[0], p4[1], p4[2], p4[3]}; } }
        __syncthreads();
    }
}
struct GlaStage { u32x4 qd[2], kh[2], e, vt, gc; };
__device__ __forceinline__ void gla_stage_load(GlaStage& s, const bf16_t* __restrict__ QD, const bf16_t* __restrict__ KHT, const bf16_t* __restrict__ EE, const bf16_t* __restrict__ VT, const float* __restrict__ GC,
                                               int ch, int sl, int tid) {
    const bf16_t* qp = QD + (size_t)ch * 8192 + tid * 8; s.qd[0] = *(const u32x4*)qp; s.qd[1] = *(const u32x4*)(qp + 4096);
    const bf16_t* kp = KHT + (size_t)ch * 8192 + tid * 8; s.kh[0] = *(const u32x4*)kp; s.kh[1] = *(const u32x4*)(kp + 4096);
    s.e = *(const u32x4*)(EE + (size_t)ch * 4096 + tid * 8);
    s.vt = *(const u32x4*)(VT + (size_t)ch * 16384 + sl * 4096 + tid * 8);
    if (tid < 32) s.gc = *(const u32x4*)(GC + (size_t)ch * 128 + tid * 4);
}
constexpr int GS_KH = 8704, GS_E = 17920, GS_VT = 22528, GS_GC = 27136, GS_EL = 27392;
__device__ __forceinline__ void gla_stage_store(const GlaStage& s, LAS bf16_t* b, int tid) {
    *(LAS u32x4*)(b + (tid >> 4) * 136 + (tid & 15) * 8) = s.qd[0]; *(LAS u32x4*)(b + (32 + (tid >> 4)) * 136 + (tid & 15) * 8) = s.qd[1];
    *(LAS u32x4*)(b + GS_KH + (tid >> 3) * 72 + (tid & 7) * 8) = s.kh[0]; *(LAS u32x4*)(b + GS_KH + (64 + (tid >> 3)) * 72 + (tid & 7) * 8) = s.kh[1];
    *(LAS u32x4*)(b + GS_E + (tid >> 3) * 72 + (tid & 7) * 8) = s.e; *(LAS u32x4*)(b + GS_VT + (tid >> 3) * 72 + (tid & 7) * 8) = s.vt;
    if (tid < 32) *(LAS u32x4*)(b + GS_GC + tid * 8) = s.gc;
}
__device__ __forceinline__ void ph_gla_seq(const Ctx& c, int boff, const bf16_t* __restrict__ QD, const bf16_t* __restrict__ KHT, const bf16_t* __restrict__ EE, const bf16_t* __restrict__ VT, const float* __restrict__ GC,
                                           const float* __restrict__ s0, float* __restrict__ outP, float* __restrict__ outS, bf16_t* __restrict__ OB) {
    LAS bf16_t* stg = (LAS bf16_t*)c.lds;
    LAS bf16_t* T_l = stg + 2 * GS_EL;
    const int tid = c.tid, lane = c.lane, r = lane & 15, q = lane >> 4, w = c.wave;
    for (int u = (c.bid - boff + c.G) % c.G; u < 32 + 512; u += c.G) {
        int h, sl, nch, ch0, row0, ntok; const float* sp = nullptr; float* op;
        if (u < 32) { const int b = u >> 4; h = (u >> 2) & 3; sl = u & 3; nch = 64; ch0 = (b * 4 + h) * 64; row0 = b * PS; ntok = 64; op = outP + (size_t)(b * 4 + h) * 32768; }
        else { const int s = u - 32, sq = s >> 4; h = (s >> 2) & 3; sl = s & 3; nch = 1; ch0 = 512 + sq * 4 + h; row0 = MP + sq * SS; ntok = SS; sp = s0 + (size_t)(sq * 4 + h) * 32768; op = outS + (size_t)(sq * 4 + h) * 32768; }
        f32x4 acc[4];
#pragma unroll
        for (int vb = 0; vb < 4; ++vb)
#pragma unroll
            for (int jj = 0; jj < 4; ++jj) acc[vb][jj] = sp ? sp[(size_t)(w * 16 + q * 4 + jj) * 256 + sl * 64 + vb * 16 + r] : 0.f;
        GlaStage R0, R1, R2;
        gla_stage_load(R0, QD, KHT, EE, VT, GC, ch0, sl, tid);
        if (1 < nch) gla_stage_load(R1, QD, KHT, EE, VT, GC, ch0 + 1, sl, tid);
        if (2 < nch) gla_stage_load(R2, QD, KHT, EE, VT, GC, ch0 + 2, sl, tid);
        __syncthreads();
        gla_stage_store(R0, stg, tid);
        if (3 < nch) gla_stage_load(R0, QD, KHT, EE, VT, GC, ch0 + 3, sl, tid);
#define GLA_STEP(ci, RN) do { \
            LAS bf16_t* Tb = T_l + ((ci) & 1) * 64 * 136; const LAS bf16_t* sb = stg + ((ci) & 1) * GS_EL; \
            _Pragma("unroll") for (int vb = 0; vb < 4; ++vb) { u32x2 o; o.x = pk2(acc[vb][0], acc[vb][1]); o.y = pk2(acc[vb][2], acc[vb][3]); *(LAS u32x2*)(Tb + (vb * 16 + r) * 136 + w * 16 + q * 4) = o; } \
            __syncthreads(); \
            if ((ci) + 1 < nch) { gla_stage_store(RN, stg + (((ci) + 1) & 1) * GS_EL, tid); if ((ci) + 4 < nch) gla_stage_load(RN, QD, KHT, EE, VT, GC, ch0 + (ci) + 4, sl, tid); } \
            { const int rb = w >> 1, t = rb * 16 + r; bf16x8 qf[4], ef[2]; \
              _Pragma("unroll") for (int ks = 0; ks < 4; ++ks) qf[ks] = *(const LAS bf16x8*)(sb + (rb * 16 + r) * 136 + ks * 32 + q * 8); \
              _Pragma("unroll") for (int ks = 0; ks < 2; ++ks) ef[ks] = *(const LAS bf16x8*)(sb + GS_E + (rb * 16 + r) * 72 + ks * 32 + q * 8); \
              _Pragma("unroll") for (int e2 = 0; e2 < 2; ++e2) { const int cb = (w & 1) * 2 + e2; f32x4 y = (f32x4){0.f, 0.f, 0.f, 0.f}; \
                  _Pragma("unroll") for (int ks = 0; ks < 4; ++ks) y = mma16(*(const LAS bf16x8*)(Tb + (cb * 16 + r) * 136 + ks * 32 + q * 8), qf[ks], y); \
                  _Pragma("unroll") for (int ks = 0; ks < 2; ++ks) y = mma16(*(const LAS bf16x8*)(sb + GS_VT + (cb * 16 + r) * 72 + ks * 32 + q * 8), ef[ks], y); \
                  if (t < ntok) { u32x2 o; o.x = pk2(y[0], y[1]); o.y = pk2(y[2], y[3]); *(u32x2*)(OB + (size_t)(row0 + (ci) * 64 + t) * BW + h * 256 + sl * 64 + cb * 16 + q * 4) = o; } } } \
            { const f32x4 gcv = *(const LAS f32x4*)((const LAS float*)(sb + GS_GC) + w * 16 + q * 4); bf16x8 kf[2]; \
              _Pragma("unroll") for (int ks = 0; ks < 2; ++ks) kf[ks] = *(const LAS bf16x8*)(sb + GS_KH + (w * 16 + r) * 72 + ks * 32 + q * 8); \
              _Pragma("unroll") for (int vb = 0; vb < 4; ++vb) { acc[vb] = acc[vb] * gcv; \
                  _Pragma("unroll") for (int ks = 0; ks < 2; ++ks) acc[vb] = mma16(kf[ks], *(const LAS bf16x8*)(sb + GS_VT + (vb * 16 + r) * 72 + ks * 32 + q * 8), acc[vb]); } } \
        } while (0)
#pragma unroll 1
        for (int ci = 0; ci < nch; ci += 3) {
            GLA_STEP(ci, R1);
            if (ci + 1 < nch) GLA_STEP(ci + 1, R2);
            if (ci + 2 < nch) GLA_STEP(ci + 2, R0);
        }
#undef GLA_STEP
#pragma unroll
        for (int vb = 0; vb < 4; ++vb)
#pragma unroll
            for (int jj = 0; jj < 4; ++jj) op[(size_t)(w * 16 + q * 4 + jj) * 256 + sl * 64 + vb * 16 + r] = acc[vb][jj];
        __syncthreads();
    }
}
__device__ __forceinline__ void ph_gla_fin(const Ctx& c, const bf16_t* __restrict__ U, const float* __restrict__ ng, const float* __restrict__ nb, const bf16_t* __restrict__ RAW, bf16_t* __restrict__ OB) {
    const int lane = c.lane;
    for (int i = c.bid * 8 + c.wave; i < MT * 4; i += c.G * 8) {
        const int row = i >> 2, h = i & 3, cc = h * 256 + lane * 4; bf16_t* p = OB + (size_t)row * BW + cc;
        const u32x2 raw = *(const u32x2*)(RAW + (size_t)row * BW + cc); float x[4] = {__uint_as_float(raw.x << 16), __uint_as_float(raw.x & 0xffff0000u), __uint_as_float(raw.y << 16), __uint_as_float(raw.y & 0xffff0000u)};
        const float mean = wave_sum((x[0] + x[1]) + (x[2] + x[3])) * (1.0f / 256.0f); float qq = 0.f;
#pragma unroll
        for (int j = 0; j < 4; ++j) { const float d = x[j] - mean; qq += d * d; }
        const float rstd = rsqrtf(wave_sum(qq) * (1.0f / 256.0f) + 1e-5f);
        const u32x2 gp = *(const u32x2*)(U + (size_t)row * NINP + U_GR + cc); const float gr[4] = {__uint_as_float(gp.x << 16), __uint_as_float(gp.x & 0xffff0000u), __uint_as_float(gp.y << 16), __uint_as_float(gp.y & 0xffff0000u)};
        const f32x4 gg = *(const f32x4*)(ng + cc), bb = *(const f32x4*)(nb + cc); float o[4];
#pragma unroll
        for (int j = 0; j < 4; ++j) o[j] = ((x[j] - mean) * rstd * gg[j] + bb[j]) * gr[j] * sigmoidf_(gr[j]);
        u32x2 ov; ov.x = pk2(o[0], o[1]); ov.y = pk2(o[2], o[3]); *(u32x2*)p = ov;
    }
}

__device__ __forceinline__ void unpack8(const u32x4 w, float (&x)[8]) {
    x[0] = __uint_as_float(w.x << 16); x[1] = __uint_as_float(w.x & 0xffff0000u); x[2] = __uint_as_float(w.y << 16); x[3] = __uint_as_float(w.y & 0xffff0000u);
    x[4] = __uint_as_float(w.z << 16); x[5] = __uint_as_float(w.z & 0xffff0000u); x[6] = __uint_as_float(w.w << 16); x[7] = __uint_as_float(w.w & 0xffff0000u);
}
template <bool ISBF> __device__ __forceinline__ void swa_step(const float (&q)[32], float (&acc)[32], float& m, float& l, const void* kp, const void* vp, float slope, float dist) {
    float s = 0.f;
#pragma unroll
    for (int j = 0; j < 4; ++j) { float x[8];
        if (ISBF) unpack8(*(const u32x4*)((const bf16_t*)kp + j * 8), x);
        else { const f32x4 a = *(const f32x4*)((const float*)kp + j * 8), b = *(const f32x4*)((const float*)kp + j * 8 + 4); x[0] = a[0]; x[1] = a[1]; x[2] = a[2]; x[3] = a[3]; x[4] = b[0]; x[5] = b[1]; x[6] = b[2]; x[7] = b[3]; }
#pragma unroll
        for (int d = 0; d < 8; ++d) s += q[j * 8 + d] * x[d]; }
    s += __shfl_xor(s, 1, 64);
    s = s * 0.125f - slope * dist;
    const float mn = fmaxf(m, s), cc = __expf(m - mn), p = __expf(s - mn);
    l = l * cc + p;
#pragma unroll
    for (int j = 0; j < 4; ++j) { float x[8];
        if (ISBF) unpack8(*(const u32x4*)((const bf16_t*)vp + j * 8), x);
        else { const f32x4 a = *(const f32x4*)((const float*)vp + j * 8), b = *(const f32x4*)((const float*)vp + j * 8 + 4); x[0] = a[0]; x[1] = a[1]; x[2] = a[2]; x[3] = a[3]; x[4] = b[0]; x[5] = b[1]; x[6] = b[2]; x[7] = b[3]; }
#pragma unroll
        for (int d = 0; d < 8; ++d) acc[j * 8 + d] = acc[j * 8 + d] * cc + p * x[d]; }
    m = mn;
}
__device__ __forceinline__ void ph_swa_naive(const Ctx& c, const bf16_t* __restrict__ U, const float* __restrict__ ck, const float* __restrict__ cv, const float* __restrict__ sinks, bf16_t* __restrict__ OB) {
    for (int gid = c.bid * 512 + c.tid; gid < MS * 32; gid += c.G * 512) {
        const int dh = gid & 1, h = (gid >> 1) & 15, row = MP + (gid >> 5), kvh = h >> 3, co = kvh * 64 + dh * 32;
        float q[32], acc[32];
#pragma unroll
        for (int j = 0; j < 4; ++j) { float x[8]; unpack8(*(const u32x4*)(U + (size_t)row * NINP + U_SQ + h * 64 + dh * 32 + j * 8), x);
#pragma unroll
            for (int d = 0; d < 8; ++d) { q[j * 8 + d] = x[d]; acc[j * 8 + d] = 0.f; } }
        const float slope = exp2f(-0.5f * (float)(h + 1)); float m = sinks[h], l = 1.0f;
        if (row < MP) {
            const int t = row % PS, base = row - t, lo = t - 128 < 0 ? 0 : t - 128;
            for (int s = lo; s <= t; ++s) { const bf16_t* ur = U + (size_t)(base + s) * NINP;
                swa_step<true>(q, acc, m, l, ur + U_SK + co, ur + U_SV + co, slope, (float)(t - s)); }
        } else {
            const int sq = (row - MP) / SS, i = (row - MP) % SS;
            for (int idx = i; idx <= 128 + i; ++idx) {
                if (idx < 128) { const size_t o = ((size_t)sq * 128 + idx) * 128 + co; swa_step<false>(q, acc, m, l, ck + o, cv + o, slope, (float)(128 + i - idx)); }
                else { const bf16_t* ur = U + (size_t)(MP + sq * SS + idx - 128) * NINP; swa_step<true>(q, acc, m, l, ur + U_SK + co, ur + U_SV + co, slope, (float)(128 + i - idx)); }
            }
        }
        const float inv = 1.0f / l; bf16_t* op = OB + (size_t)row * BW + h * 64 + dh * 32;
#pragma unroll
        for (int j = 0; j < 4; ++j) { u32x4 w; w.x = pk2(acc[j * 8] * inv, acc[j * 8 + 1] * inv); w.y = pk2(acc[j * 8 + 2] * inv, acc[j * 8 + 3] * inv);
            w.z = pk2(acc[j * 8 + 4] * inv, acc[j * 8 + 5] * inv); w.w = pk2(acc[j * 8 + 6] * inv, acc[j * 8 + 7] * inv); *(u32x4*)(op + j * 8) = w; }
    }
}

__device__ __forceinline__ void ph_rwkv_prep(const Ctx& c, const bf16_t* __restrict__ U, const float* __restrict__ shift, const float* __restrict__ mu, const float* __restrict__ w0, const float* __restrict__ w2,
                                             const float* __restrict__ a0, const float* __restrict__ a2, const float* __restrict__ g2, const float* __restrict__ k_k, const float* __restrict__ k_a,
                                             const float* __restrict__ r_k, float* __restrict__ RW) {
    LAS float* xm = (LAS float*)c.lds; LAS float* tw = xm + RWC; LAS float* ad = tw + 64; LAS float* sg = ad + 64;
    const int tid = c.tid;
    float* R = RW; float* WD = RW + (size_t)MPAD * BW; float* K2 = WD + (size_t)MPAD * BW; float* V = K2 + (size_t)MPAD * BW; float* KK = V + (size_t)MPAD * BW;
    float* BV = KK + (size_t)MPAD * BW; float* G = BV + (size_t)MPAD * BW; float* BON = G + (size_t)MPAD * BW;
    for (int row = c.bid; row < MT; row += c.G) {
        const bf16_t* ur = U + (size_t)row * NINP + U_RU; const bf16_t* pr = ur - NINP; const float* ps = nullptr; bool first;
        if (row < MP) first = (row % PS) == 0; else { first = ((row - MP) % SS) == 0; ps = shift + (size_t)((row - MP) / SS) * RWC; }
        for (int cc = tid; cc < RWC; cc += 512) { const float x = bf2f(ur[cc]); const float s = first ? (ps ? ps[cc] : 0.f) : bf2f(pr[cc]); xm[cc] = x + (s - x) * mu[cc]; }
        __syncthreads();
        if (tid < 64) { tw[tid] = tanhf(xm[3072 + tid]); ad[tid] = xm[3136 + tid]; }
        if (tid >= 128 && tid < 256) sg[tid - 128] = sigmoidf_(xm[3200 + tid - 128]);
        __syncthreads();
        for (int qd = 0; qd < 2; ++qd) {
            const int cc = qd * 512 + tid; float accw = w0[cc], acca = a0[cc], accg = 0.f;
#pragma unroll 4
            for (int j = 0; j < 64; ++j) { accw += tw[j] * w2[j * BW + cc]; acca += ad[j] * a2[j * BW + cc]; }
#pragma unroll 4
            for (int j = 0; j < 128; ++j) accg += sg[j] * g2[j * BW + cc];
            const float lw = -softplusf_(-accw) - 0.5f, decay = __expf(-__expf(lw)), a = sigmoidf_(acca);
            const float r = xm[cc], k = xm[1024 + cc], v = xm[2048 + cc];
            const float kkr = k * k_k[cc]; const float ss = wave_sum(kkr * kkr); const float kk = kkr / fmaxf(sqrtf(ss), 1e-12f);
            const float k2 = k * (1.0f + (a - 1.0f) * k_a[cc]); const float rk = wave_sum(r * k2 * r_k[cc]);
            const size_t o = (size_t)row * BW + cc;
            R[o] = r; WD[o] = decay; K2[o] = k2; V[o] = v; KK[o] = kk; BV[o] = kk * a; G[o] = accg; BON[o] = rk * v;
        }
        __syncthreads();
    }
}
__device__ __forceinline__ int kperm_pos(int k) { return (k & ~31) + 8 * ((k >> 2) & 3) + 4 * ((k >> 4) & 1) + (k & 3); }
__device__ __forceinline__ void ph_swa_prompt(const Ctx& c, const bf16_t* __restrict__ U, const float* __restrict__ sinks, bf16_t* __restrict__ OB) {
    LAS bf16_t* K_l = (LAS bf16_t*)c.lds;
    LAS bf16_t* VT_l = K_l + 192 * 72;
    const int tid = c.tid, lane = c.lane, r = lane & 15, q = lane >> 4, w = c.wave;
    for (int u = c.bid; u < PB * 64 * 2; u += c.G) {
        const int b = u >> 7, qb = (u >> 1) & 63, kvh = u & 1, h = kvh * 8 + w;
        const int tok0 = qb * 64 - 128;
        const size_t seq0 = (size_t)b * PS;
        for (int idx = tid; idx < 192 * 8; idx += 512) { const int kl = idx >> 3, c8 = idx & 7, tk = tok0 + kl; u32x4 kv = (u32x4){0u, 0u, 0u, 0u}, vv = kv;
            if (tk >= 0) { const bf16_t* ur = U + (seq0 + tk) * NINP; kv = *(const u32x4*)(ur + U_SK + kvh * 64 + c8 * 8); vv = *(const u32x4*)(ur + U_SV + kvh * 64 + c8 * 8); }
            *(LAS u32x4*)(K_l + kl * 72 + c8 * 8) = kv;
            const int kp = kperm_pos(kl); LAS bf16_t* vp = VT_l + (c8 * 8) * 200 + kp;
            vp[0] = (bf16_t)(vv.x & 0xffffu); vp[200] = (bf16_t)(vv.x >> 16); vp[400] = (bf16_t)(vv.y & 0xffffu); vp[600] = (bf16_t)(vv.y >> 16);
            vp[800] = (bf16_t)(vv.z & 0xffffu); vp[1000] = (bf16_t)(vv.z >> 16); vp[1200] = (bf16_t)(vv.w & 0xffffu); vp[1400] = (bf16_t)(vv.w >> 16); }
        __syncthreads();
        const float slope = exp2f(-0.5f * (float)(h + 1)), sink = sinks[h];
#pragma unroll 1
        for (int i = 0; i < 4; ++i) {
            const size_t qrow = seq0 + qb * 64 + i * 16 + r;
            const bf16x8 qf0 = *(const bf16x8*)(U + qrow * NINP + U_SQ + h * 64 + q * 8), qf1 = *(const bf16x8*)(U + qrow * NINP + U_SQ + h * 64 + 32 + q * 8);
            const int kt0 = i & ~1;
            f32x4 s[10]; float mx = sink;
#pragma unroll
            for (int kt = 0; kt < 10; ++kt) { const LAS bf16_t* kp = K_l + ((kt0 + kt) * 16 + r) * 72 + q * 8;
                f32x4 d = mma16(*(const LAS bf16x8*)kp, qf0, (f32x4){0.f, 0.f, 0.f, 0.f}); d = mma16(*(const LAS bf16x8*)(kp + 32), qf1, d);
#pragma unroll
                for (int jj = 0; jj < 4; ++jj) { const int kl = (kt0 + kt) * 16 + q * 4 + jj, dist = i * 16 + r + 128 - kl;
                    const float v = (dist >= 0 && dist <= 128 && tok0 + kl >= 0) ? d[jj] * 0.125f - slope * (float)dist : -1e30f; d[jj] = v; mx = fmaxf(mx, v); }
                s[kt] = d; }
            mx = fmaxf(mx, __shfl_xor(mx, 16, 64)); mx = fmaxf(mx, __shfl_xor(mx, 32, 64));
            float sum = 0.f; bf16x8 pf[5];
#pragma unroll
            for (int kp = 0; kp < 5; ++kp) { f32x4 a = s[2 * kp], bq = s[2 * kp + 1];
#pragma unroll
                for (int jj = 0; jj < 4; ++jj) { a[jj] = __expf(a[jj] - mx); bq[jj] = __expf(bq[jj] - mx); sum += a[jj] + bq[jj]; }
                pf[kp] = pack_acc(a, bq); }
            sum += __shfl_xor(sum, 16, 64); sum += __shfl_xor(sum, 32, 64);
            const float inv = 1.0f / (sum + __expf(sink - mx));
            bf16_t* op = OB + qrow * BW + h * 64 + q * 4;
#pragma unroll
            for (int dt = 0; dt < 4; ++dt) { f32x4 o = (f32x4){0.f, 0.f, 0.f, 0.f};
#pragma unroll
                for (int kp = 0; kp < 5; ++kp) o = mma16(*(const LAS bf16x8*)(VT_l + (dt * 16 + r) * 200 + (kt0 + 2 * kp) * 16 + q * 8), pf[kp], o);
                u32x2 ov; ov.x = pk2(o[0] * inv, o[1] * inv); ov.y = pk2(o[2] * inv, o[3] * inv); *(u32x2*)(op + dt * 16) = ov; }
        }
        __syncthreads();
    }
}

__device__ __forceinline__ void ph_swa_sample(const Ctx& c, const bf16_t* __restrict__ U, const float* __restrict__ ck, const float* __restrict__ cv, const float* __restrict__ sinks, bf16_t* __restrict__ OB) {
    LAS bf16_t* K_l = (LAS bf16_t*)c.lds;
    LAS bf16_t* VT_l = K_l + 160 * 72;
    const int tid = c.tid, lane = c.lane, r = lane & 15, q = lane >> 4, w = c.wave;
    for (int u = c.bid; u < SB * 2; u += c.G) {
        const int sq = u >> 1, kvh = u & 1;
        for (int idx = tid; idx < 160 * 8; idx += 512) { const int kl = idx >> 3, c8 = idx & 7; float kx[8], vx[8];
#pragma unroll
            for (int e = 0; e < 8; ++e) { kx[e] = 0.f; vx[e] = 0.f; }
            if (kl < 128) { const size_t o = ((size_t)sq * 128 + kl) * 128 + kvh * 64 + c8 * 8; const f32x4 a = *(const f32x4*)(ck + o), b2 = *(const f32x4*)(ck + o + 4), c2 = *(const f32x4*)(cv + o), d2 = *(const f32x4*)(cv + o + 4);
                kx[0] = a[0]; kx[1] = a[1]; kx[2] = a[2]; kx[3] = a[3]; kx[4] = b2[0]; kx[5] = b2[1]; kx[6] = b2[2]; kx[7] = b2[3];
                vx[0] = c2[0]; vx[1] = c2[1]; vx[2] = c2[2]; vx[3] = c2[3]; vx[4] = d2[0]; vx[5] = d2[1]; vx[6] = d2[2]; vx[7] = d2[3]; }
            else if (kl < 132) { const bf16_t* ur = U + (size_t)(MP + sq * SS + kl - 128) * NINP; unpack8(*(const u32x4*)(ur + U_SK + kvh * 64 + c8 * 8), kx); unpack8(*(const u32x4*)(ur + U_SV + kvh * 64 + c8 * 8), vx); }
            *(LAS u32x4*)(K_l + kl * 72 + c8 * 8) = (u32x4){pk2(kx[0], kx[1]), pk2(kx[2], kx[3]), pk2(kx[4], kx[5]), pk2(kx[6], kx[7])};
            LAS bf16_t* vp = VT_l + (c8 * 8) * 168 + kperm_pos(kl);
#pragma unroll
            for (int e = 0; e < 8; ++e) vp[e * 168] = f2bf(vx[e]); }
        __syncthreads();
        if (w < 2) {
            const int h = kvh * 8 + w * 4 + (r >> 2), tk = r & 3; const size_t qrow = (size_t)(MP + sq * SS + tk);
            const float slope = exp2f(-0.5f * (float)(h + 1)), sink = sinks[h];
            const bf16x8 qf0 = *(const bf16x8*)(U + qrow * NINP + U_SQ + h * 64 + q * 8), qf1 = *(const bf16x8*)(U + qrow * NINP + U_SQ + h * 64 + 32 + q * 8);
            f32x4 s[10]; float mx = sink;
#pragma unroll
            for (int kt = 0; kt < 10; ++kt) { const LAS bf16_t* kp = K_l + (kt * 16 + r) * 72 + q * 8;
                f32x4 d = mma16(*(const LAS bf16x8*)kp, qf0, (f32x4){0.f, 0.f, 0.f, 0.f}); d = mma16(*(const LAS bf16x8*)(kp + 32), qf1, d);
#pragma unroll
                for (int jj = 0; jj < 4; ++jj) { const int kl = kt * 16 + q * 4 + jj, dist = 128 + tk - kl;
                    const float v = (dist >= 0 && dist <= 128) ? d[jj] * 0.125f - slope * (float)dist : -1e30f; d[jj] = v; mx = fmaxf(mx, v); }
                s[kt] = d; }
            mx = fmaxf(mx, __shfl_xor(mx, 16, 64)); mx = fmaxf(mx, __shfl_xor(mx, 32, 64));
            float sum = 0.f; bf16x8 pf[5];
#pragma unroll
            for (int kp = 0; kp < 5; ++kp) { f32x4 a = s[2 * kp], bq = s[2 * kp + 1];
#pragma unroll
                for (int jj = 0; jj < 4; ++jj) { a[jj] = __expf(a[jj] - mx); bq[jj] = __expf(bq[jj] - mx); sum += a[jj] + bq[jj]; }
                pf[kp] = pack_acc(a, bq); }
            sum += __shfl_xor(sum, 16, 64); sum += __shfl_xor(sum, 32, 64);
            const float inv = 1.0f / (sum + __expf(sink - mx));
            bf16_t* op = OB + qrow * BW + h * 64 + q * 4;
#pragma unroll
            for (int dt = 0; dt < 4; ++dt) { f32x4 o = (f32x4){0.f, 0.f, 0.f, 0.f};
#pragma unroll
                for (int kp = 0; kp < 5; ++kp) o = mma16(*(const LAS bf16x8*)(VT_l + (dt * 16 + r) * 168 + kp * 32 + q * 8), pf[kp], o);
                u32x2 ov; ov.x = pk2(o[0] * inv, o[1] * inv); ov.y = pk2(o[2] * inv, o[3] * inv); *(u32x2*)(op + dt * 16) = ov; }
        }
        __syncthreads();
    }
}

__device__ __forceinline__ void ph_lrw(const Ctx& c, const float* __restrict__ w2, const float* __restrict__ a2, const float* __restrict__ g2, bf16_t* __restrict__ LRW) {
    for (int idx = c.bid * 512 + c.tid; idx < NL * 256 * 1024; idx += c.G * 512) {
        const int ch = idx & 1023, j = (idx >> 10) & 255, l = idx >> 18;
        const float v = j < 64 ? w2[((size_t)l * 64 + j) * BW + ch] : (j < 128 ? a2[((size_t)l * 64 + j - 64) * BW + ch] : g2[((size_t)l * 128 + j - 128) * BW + ch]);
        LRW[((size_t)l * 1024 + ch) * 256 + j] = f2bf(v);
    }
}
constexpr int RWP_UNITS = (MP / 64) * 4 + SB * 4;
__device__ __forceinline__ void rwp_unit_info(int u, int& row0, int& ntok, int& hg, int& sq, bool& seq_first) {
    if (u < (MP / 64) * 4) { const int blk = u >> 2; hg = u & 3; row0 = blk * 64; ntok = 64; sq = -1; seq_first = (row0 % PS) == 0; }
    else { const int s = u - (MP / 64) * 4; sq = s >> 2; hg = s & 3; row0 = MP + sq * SS; ntok = SS; seq_first = true; }
}
__device__ __forceinline__ void ph_rwkv_pre(const Ctx& c, const bf16_t* __restrict__ U, const float* __restrict__ shift, const float* __restrict__ mu, const float* __restrict__ w0, const float* __restrict__ w2,
                                            const float* __restrict__ a0, const float* __restrict__ a2, const float* __restrict__ g2, const float* __restrict__ k_k, const float* __restrict__ k_a,
                                            const float* __restrict__ r_k, float* __restrict__ RW, bf16_t* __restrict__ RB, const bf16_t* __restrict__ LRW) {
    LAS bf16_t* P_l = (LAS bf16_t*)c.lds; LAS bf16_t* Kn_l = P_l + 4608; LAS bf16_t* Bn_l = Kn_l + 4608; LAS bf16_t* Q_l = Bn_l + 4608;
    LAS bf16_t* PT_l = Q_l + 4608; LAS bf16_t* BhT_l = PT_l + 4608; LAS bf16_t* KhT_l = BhT_l + 4608; LAS bf16_t* VT_l = KhT_l + 4608;
    LAS float* A_l = (LAS float*)(c.lds + 73728);
    LAS bf16_t* BmT_l = (LAS bf16_t*)(c.lds + 78848); LAS bf16_t* F_l = (LAS bf16_t*)(c.lds + 81920); LAS bf16_t* Tinv_l = (LAS bf16_t*)(c.lds + 84992);
    LAS bf16_t* PpT_l = (LAS bf16_t*)(c.lds + 88064);
    LAS bf16_t* BmpT_l = (LAS bf16_t*)(c.lds + 97280);
    LAS float* GC_l = (LAS float*)(c.lds + 100352);
    LAS float* lg_l = (LAS float*)(c.lds + 125952);
    LAS bf16_t* act_l = (LAS bf16_t*)c.lds;
    LAS bf16_t* wT_l = act_l + 64 * 264;
    LAS bf16_t* aT_l = wT_l + 64 * 72;
    LAS bf16_t* gT_l = aT_l + 64 * 72;
    LAS float* pre_l = (LAS float*)(c.lds + 73728);
    const int tid = c.tid, lane = c.lane, r = lane & 15, q = lane >> 4, w = c.wave;
    float* Gg = RW + 6 * (size_t)MPAD * BW; float* BON = RW + 7 * (size_t)MPAD * BW;
    for (int u = c.bid; u < RWP_UNITS; u += c.G) {
        int row0, ntok, hg, sq; bool seq_first; rwp_unit_info(u, row0, ntok, hg, sq, seq_first);
        const float* sh = sq >= 0 ? shift + (size_t)sq * RWC : nullptr;
        const int nstage = ntok == 64 ? 64 : 16;
        for (int idx = tid; idx < nstage * 32; idx += 512) {
            const int t = idx >> 5, c8 = idx & 31, cc = 3072 + c8 * 8; float val[8];
#pragma unroll
            for (int e2 = 0; e2 < 8; ++e2) val[e2] = 0.f;
            if (t < ntok) { const bf16_t* ur = U + (size_t)(row0 + t) * NINP + U_RU; float x[8], p[8];
                unpack8(*(const u32x4*)(ur + cc), x);
                if (!(t == 0 && seq_first)) unpack8(*(const u32x4*)(ur + cc - NINP), p);
                else if (sh) { const f32x4 s0v = *(const f32x4*)(sh + cc), s1v = *(const f32x4*)(sh + cc + 4); p[0] = s0v[0]; p[1] = s0v[1]; p[2] = s0v[2]; p[3] = s0v[3]; p[4] = s1v[0]; p[5] = s1v[1]; p[6] = s1v[2]; p[7] = s1v[3]; }
                else {
#pragma unroll
                    for (int e2 = 0; e2 < 8; ++e2) p[e2] = 0.f; }
                const f32x4 m0 = *(const f32x4*)(mu + cc), m1 = *(const f32x4*)(mu + cc + 4);
#pragma unroll
                for (int e2 = 0; e2 < 8; ++e2) { const float xm = x[e2] + (p[e2] - x[e2]) * (e2 < 4 ? m0[e2] : m1[e2 - 4]); val[e2] = c8 < 8 ? tanh_fast(xm) : (c8 < 16 ? xm : sigmoidf_(xm)); } }
            *(LAS u32x4*)(act_l + t * 264 + c8 * 8) = (u32x4){pk2(val[0], val[1]), pk2(val[2], val[3]), pk2(val[4], val[5]), pk2(val[6], val[7])};
        }
        __syncthreads();
        bf16x8 af[8];
        { const int tb = w & 3;
#pragma unroll
          for (int ks = 0; ks < 8; ++ks) af[ks] = *(const LAS bf16x8*)(act_l + (tb * 16 + r) * 264 + ks * 32 + q * 8); }
        __syncthreads();
#pragma unroll 1
        for (int hh = 0; hh < 4; ++hh) { const int h = hg * 4 + hh;
        { const int tb = w & 3, chf = w >> 2;
          if (tb * 16 < nstage) {
#pragma unroll
            for (int e2 = 0; e2 < 2; ++e2) { const int cb = chf * 2 + e2; f32x4 dw = (f32x4){0.f, 0.f, 0.f, 0.f}, da = dw, dg = dw;
                const bf16_t* wr = LRW + ((size_t)h * 64 + cb * 16 + r) * 256 + q * 8;
#pragma unroll
                for (int ks = 0; ks < 2; ++ks) { dw = mma16(*(const bf16x8*)(wr + ks * 32), af[ks], dw); da = mma16(*(const bf16x8*)(wr + 64 + ks * 32), af[2 + ks], da); }
#pragma unroll
                for (int ks = 0; ks < 4; ++ks) dg = mma16(*(const bf16x8*)(wr + 128 + ks * 32), af[4 + ks], dg);
                const int o = (tb * 16 + r) * 68 + cb * 16 + q * 4;
                *(LAS f32x4*)(pre_l + o) = dw; *(LAS f32x4*)(pre_l + 64 * 68 + o) = da; *(LAS f32x4*)(pre_l + 2 * 64 * 68 + o) = dg; } } }
        __syncthreads();
        const int t = tid >> 3, cg = tid & 7, c0 = h * 64 + cg * 8, sc = t >> 4;
        float rr[8], k2[8], kap[8], bet[8], nlw[8];
        { float vx[8], gg[8], kkr[8]; float ss = 0.f, rk = 0.f;
          if (t < ntok) {
            const size_t row = (size_t)(row0 + t); const bf16_t* ur = U + row * NINP + U_RU; const bool fst = (t == 0 && seq_first);
            float kx[8];
#pragma unroll
            for (int part = 0; part < 3; ++part) { const int cc = part * 1024 + c0; float x[8], p[8];
                unpack8(*(const u32x4*)(ur + cc), x);
                if (!fst) unpack8(*(const u32x4*)(ur + cc - NINP), p);
                else {
#pragma unroll
                    for (int j = 0; j < 8; ++j) p[j] = sh ? sh[cc + j] : 0.f; }
                const f32x4 mA = *(const f32x4*)(mu + cc), mB = *(const f32x4*)(mu + cc + 4);
#pragma unroll
                for (int j = 0; j < 8; ++j) { const float xm = x[j] + (p[j] - x[j]) * (j < 4 ? mA[j] : mB[j - 4]); if (part == 0) rr[j] = xm; else if (part == 1) kx[j] = xm; else vx[j] = xm; } }
            float pw[8], pa[8], pkk[8], pka[8], prk[8];
#pragma unroll
            for (int hf = 0; hf < 2; ++hf) { const f32x4 v0 = *(const f32x4*)(w0 + c0 + hf * 4), v1 = *(const f32x4*)(a0 + c0 + hf * 4), v2 = *(const f32x4*)(k_k + c0 + hf * 4), v3 = *(const f32x4*)(k_a + c0 + hf * 4), v4 = *(const f32x4*)(r_k + c0 + hf * 4);
#pragma unroll
                for (int j = 0; j < 4; ++j) { pw[hf * 4 + j] = v0[j]; pa[hf * 4 + j] = v1[j]; pkk[hf * 4 + j] = v2[j]; pka[hf * 4 + j] = v3[j]; prk[hf * 4 + j] = v4[j]; } }
            float lwp[8], app[8];
#pragma unroll
            for (int hf = 0; hf < 2; ++hf) { const f32x4 v0 = *(const LAS f32x4*)(pre_l + t * 68 + cg * 8 + hf * 4), v1 = *(const LAS f32x4*)(pre_l + 64 * 68 + t * 68 + cg * 8 + hf * 4), v2 = *(const LAS f32x4*)(pre_l + 2 * 64 * 68 + t * 68 + cg * 8 + hf * 4);
#pragma unroll
                for (int j = 0; j < 4; ++j) { lwp[hf * 4 + j] = v0[j]; app[hf * 4 + j] = v1[j]; gg[hf * 4 + j] = v2[j]; } }
#pragma unroll
            for (int j = 0; j < 8; ++j) {
                const float lw = -softplus_fast(-(pw[j] + lwp[j])) - 0.5f; nlw[j] = -__expf(lw); const float av = sigmoidf_(pa[j] + app[j]);
                kkr[j] = kx[j] * pkk[j]; ss += kkr[j] * kkr[j]; k2[j] = kx[j] * (1.0f + (av - 1.0f) * pka[j]); rk += rr[j] * k2[j] * prk[j]; bet[j] = av; }
          } else {
#pragma unroll
            for (int j = 0; j < 8; ++j) { rr[j] = 0.f; k2[j] = 0.f; kkr[j] = 0.f; bet[j] = 0.f; nlw[j] = 0.f; vx[j] = 0.f; gg[j] = 0.f; }
          }
          ss += __shfl_xor(ss, 1, 64); ss += __shfl_xor(ss, 2, 64); ss += __shfl_xor(ss, 4, 64);
          rk += __shfl_xor(rk, 1, 64); rk += __shfl_xor(rk, 2, 64); rk += __shfl_xor(rk, 4, 64);
          const float inv = 1.0f / fmaxf(sqrtf(ss), 1e-12f);
#pragma unroll
          for (int j = 0; j < 8; ++j) { kap[j] = kkr[j] * inv; bet[j] = kap[j] * bet[j]; }
          if (t < ntok) { const size_t o = (size_t)(row0 + t) * BW + c0;
              *(f32x4*)(Gg + o) = (f32x4){gg[0], gg[1], gg[2], gg[3]}; *(f32x4*)(Gg + o + 4) = (f32x4){gg[4], gg[5], gg[6], gg[7]};
              *(f32x4*)(BON + o) = (f32x4){rk * vx[0], rk * vx[1], rk * vx[2], rk * vx[3]}; *(f32x4*)(BON + o + 4) = (f32x4){rk * vx[4], rk * vx[5], rk * vx[6], rk * vx[7]}; }
          *(LAS f32x4*)(lg_l + t * 68 + cg * 8) = (f32x4){nlw[0], nlw[1], nlw[2], nlw[3]}; *(LAS f32x4*)(lg_l + t * 68 + cg * 8 + 4) = (f32x4){nlw[4], nlw[5], nlw[6], nlw[7]};
#pragma unroll
          for (int j = 0; j < 8; ++j) VT_l[(cg * 8 + j) * 72 + t] = f2bf(vx[j]);
        }
        __syncthreads();
        if (tid < 256) { const int cc = tid & 63, s4 = tid >> 6; float run = 0.f;
#pragma unroll
            for (int i = 0; i < 16; ++i) { const int o = (s4 * 16 + i) * 68 + cc; run += lg_l[o]; lg_l[o] = run; } }
        __syncthreads();
        { unsigned pp[4], pq[4], pk[4], pb[4];
#pragma unroll
          for (int j = 0; j < 8; j += 2) { float vP[2], vQ[2], vK[2], vB[2];
#pragma unroll
              for (int e = 0; e < 2; ++e) { const int jj = j + e, cc = cg * 8 + jj; const float ci = lg_l[t * 68 + cc], cC = lg_l[(sc * 16 + 15) * 68 + cc];
                  const float ei = __expf(-ci), eh = __expf(cC - ci);
                  vP[e] = kap[jj] * __expf(ci - nlw[jj]); vQ[e] = rr[jj] * __expf(ci); vK[e] = k2[jj] * ei; vB[e] = bet[jj] * ei;
                  PT_l[cc * 72 + t] = f2bf(vP[e]); BhT_l[cc * 72 + t] = f2bf(bet[jj] * eh); KhT_l[cc * 72 + t] = f2bf(k2[jj] * eh); }
              pp[j >> 1] = pk2(vP[0], vP[1]); pq[j >> 1] = pk2(vQ[0], vQ[1]); pk[j >> 1] = pk2(vK[0], vK[1]); pb[j >> 1] = pk2(vB[0], vB[1]); }
          const int o = t * 72 + cg * 8;
          *(LAS u32x4*)(P_l + o) = (u32x4){pp[0], pp[1], pp[2], pp[3]}; *(LAS u32x4*)(Q_l + o) = (u32x4){pq[0], pq[1], pq[2], pq[3]};
          *(LAS u32x4*)(Kn_l + o) = (u32x4){pk[0], pk[1], pk[2], pk[3]}; *(LAS u32x4*)(Bn_l + o) = (u32x4){pb[0], pb[1], pb[2], pb[3]};
          if ((t & 15) == 15) {
#pragma unroll
              for (int j = 0; j < 8; ++j) GC_l[sc * 64 + cg * 8 + j] = __expf(lg_l[t * 68 + cg * 8 + j]); } }
        __syncthreads();
        const int nsub = ntok == 64 ? 4 : 1;
        const bf16x8 zfrag = (bf16x8){0, 0, 0, 0, 0, 0, 0, 0};
        for (int id = w; id < nsub * 3; id += 8) { const int s4 = id / 3, prod = id - s4 * 3; f32x4 d = (f32x4){0.f, 0.f, 0.f, 0.f};
            const LAS bf16_t* X = (prod == 1 ? P_l : Bn_l) + (s4 * 16 + r) * 72 + q * 8; const LAS bf16_t* Y = (prod == 0 ? P_l : (prod == 1 ? Kn_l : Q_l)) + (s4 * 16 + r) * 72 + q * 8;
#pragma unroll
            for (int ks = 0; ks < 2; ++ks) d = mma16(*(const LAS bf16x8*)(X + ks * 32), *(const LAS bf16x8*)(Y + ks * 32), d);
            if (prod == 0) { f32x4 o4;
#pragma unroll
                for (int jj = 0; jj < 4; ++jj) o4[jj] = (q * 4 + jj < r) ? d[jj] : 0.f;
                *(LAS f32x4*)(A_l + s4 * 320 + r * 20 + q * 4) = o4; }
            else { float o4[4];
#pragma unroll
                for (int jj = 0; jj < 4; ++jj) o4[jj] = (prod == 1 ? (r < q * 4 + jj) : (q * 4 + jj <= r)) ? d[jj] : 0.f;
                u32x2 o; o.x = pk2(o4[0], o4[1]); o.y = pk2(o4[2], o4[3]); *(LAS u32x2*)((prod == 1 ? BmT_l : F_l) + s4 * 384 + r * 24 + q * 4) = o; } }
        __syncthreads();
        if (w == 0 && (lane >> 4) < nsub) { const int s4 = lane >> 4, jc = lane & 15; float x[16];
#pragma unroll
            for (int tt = 0; tt < 16; ++tt) { float s = (tt == jc) ? 1.f : 0.f;
#pragma unroll
                for (int i = 0; i < tt; ++i) s -= A_l[s4 * 320 + tt * 20 + i] * x[i];
                x[tt] = s; }
#pragma unroll
            for (int tt = 0; tt < 16; ++tt) Tinv_l[s4 * 384 + tt * 24 + jc] = f2bf(x[tt]); }
        __syncthreads();
        for (int id = w; id < nsub * 5; id += 8) { const int s4 = id / 5, rem = id - s4 * 5;
            const bf16x8 xf = q < 2 ? *(const LAS bf16x8*)(Tinv_l + s4 * 384 + r * 24 + q * 8) : zfrag;
            const bf16x8 yf = q < 2 ? (rem < 4 ? *(const LAS bf16x8*)(PT_l + (rem * 16 + r) * 72 + s4 * 16 + q * 8) : *(const LAS bf16x8*)(BmT_l + s4 * 384 + r * 24 + q * 8)) : zfrag;
            const f32x4 d = mma16(xf, yf, (f32x4){0.f, 0.f, 0.f, 0.f});
            u32x2 o; o.x = pk2(d[0], d[1]); o.y = pk2(d[2], d[3]);
            if (rem < 4) *(LAS u32x2*)(PpT_l + (rem * 16 + r) * 72 + s4 * 16 + q * 4) = o; else *(LAS u32x2*)(BmpT_l + s4 * 384 + r * 24 + q * 4) = o; }
        __syncthreads();
        { const int chunk0 = sq >= 0 ? PB * 16 * 256 + sq * 16 + h : ((row0 / PS) * 16 + h) * 256 + ((row0 % PS) >> 4);
          for (int id = w; id < nsub * 25; id += 8) { const int s4 = id / 25, rem = id - s4 * 25; bf16_t* blob = RB + (size_t)(chunk0 + s4) * RB_EL;
            const bf16x8 fF = q < 2 ? *(const LAS bf16x8*)(F_l + s4 * 384 + r * 24 + q * 8) : zfrag;
            if (rem < 4) {
                const bf16x8 xf = q < 2 ? *(const LAS bf16x8*)(PpT_l + (rem * 16 + r) * 72 + s4 * 16 + q * 8) : zfrag;
                const f32x4 d = mma16(xf, fF, (f32x4){0.f, 0.f, 0.f, 0.f});
                const u32x2 qv = *(const LAS u32x2*)(Q_l + (s4 * 16 + r) * 72 + rem * 16 + q * 4);
                u32x2 o; o.x = pk2(__uint_as_float(qv.x << 16) - d[0], __uint_as_float(qv.x & 0xffff0000u) - d[1]); o.y = pk2(__uint_as_float(qv.y << 16) - d[2], __uint_as_float(qv.y & 0xffff0000u) - d[3]);
                *(u32x2*)(blob + RB_QP + r * 72 + 32 * (rem >> 1) + 8 * q + 4 * (rem & 1)) = o;
            } else if (rem == 4) {
                f32x4 d2 = (f32x4){0.f, 0.f, 0.f, 0.f};
#pragma unroll
                for (int ks = 0; ks < 2; ++ks) d2 = mma16(*(const LAS bf16x8*)(Kn_l + (s4 * 16 + r) * 72 + ks * 32 + q * 8), *(const LAS bf16x8*)(Q_l + (s4 * 16 + r) * 72 + ks * 32 + q * 8), d2);
                const bf16x8 xf = q < 2 ? *(const LAS bf16x8*)(BmpT_l + s4 * 384 + r * 24 + q * 8) : zfrag;
                const f32x4 d1 = mma16(xf, fF, (f32x4){0.f, 0.f, 0.f, 0.f});
                float o4[4];
#pragma unroll
                for (int jj = 0; jj < 4; ++jj) o4[jj] = ((q * 4 + jj <= r) ? d2[jj] : 0.f) - d1[jj];
                u32x2 o; o.x = pk2(o4[0], o4[1]); o.y = pk2(o4[2], o4[3]); *(u32x2*)(blob + RB_EP + r * 24 + q * 4) = o;
            } else if (rem < 21) {
                const int cib = (rem - 5) >> 2, cob = (rem - 5) & 3;
                const bf16x8 xf = q < 2 ? *(const LAS bf16x8*)(PpT_l + (cib * 16 + r) * 72 + s4 * 16 + q * 8) : zfrag;
                const bf16x8 yf = q < 2 ? *(const LAS bf16x8*)(BhT_l + (cob * 16 + r) * 72 + s4 * 16 + q * 8) : zfrag;
                const f32x4 d = mma16(xf, yf, (f32x4){0.f, 0.f, 0.f, 0.f});
                const float gc = GC_l[s4 * 64 + cob * 16 + r]; float o4[4];
#pragma unroll
                for (int jj = 0; jj < 4; ++jj) o4[jj] = ((cib == cob && q * 4 + jj == r) ? gc : 0.f) - d[jj];
                u32x2 o; o.x = pk2(o4[0], o4[1]); o.y = pk2(o4[2], o4[3]); *(u32x2*)(blob + (cob * 16 + r) * 72 + 32 * (cib >> 1) + 8 * q + 4 * (cib & 1)) = o;
            } else {
                const int cb = rem - 21;
                const bf16x8 xf = q < 2 ? *(const LAS bf16x8*)(BmpT_l + s4 * 384 + r * 24 + q * 8) : zfrag;
                const bf16x8 yf = q < 2 ? *(const LAS bf16x8*)(BhT_l + (cb * 16 + r) * 72 + s4 * 16 + q * 8) : zfrag;
                const f32x4 d = mma16(xf, yf, (f32x4){0.f, 0.f, 0.f, 0.f});
                const u32x2 kv = *(const LAS u32x2*)(KhT_l + (cb * 16 + r) * 72 + s4 * 16 + q * 4);
                u32x2 o; o.x = pk2(__uint_as_float(kv.x << 16) - d[0], __uint_as_float(kv.x & 0xffff0000u) - d[1]); o.y = pk2(__uint_as_float(kv.y << 16) - d[2], __uint_as_float(kv.y & 0xffff0000u) - d[3]);
                *(u32x2*)(blob + RB_KHP + (cb * 16 + r) * 24 + q * 4) = o;
            } }
          for (int idx = tid; idx < nsub * 128; idx += 512) { const int s4 = idx >> 7, cc = (idx >> 1) & 63, hf = idx & 1;
              *(u32x4*)(RB + (size_t)(chunk0 + s4) * RB_EL + RB_VT + cc * 24 + hf * 8) = *(const LAS u32x4*)(VT_l + cc * 72 + s4 * 16 + hf * 8); } }
        __syncthreads();
        }
    }
}

__device__ __forceinline__ void ph_rwkv_scan_naive(const Ctx& c, const float* __restrict__ RW, const float* __restrict__ s0, const float* __restrict__ lng, const float* __restrict__ lnb, bf16_t* __restrict__ OB,
                                                   float* __restrict__ outP, float* __restrict__ outS) {
    const float* R = RW; const float* WD = RW + (size_t)MPAD * BW; const float* K2 = WD + (size_t)MPAD * BW; const float* V = K2 + (size_t)MPAD * BW; const float* KK = V + (size_t)MPAD * BW;
    const float* BV = KK + (size_t)MPAD * BW; const float* G = BV + (size_t)MPAD * BW; const float* BON = G + (size_t)MPAD * BW;
    const int lane = c.lane;
    for (int it = 0;; ++it) {
        const int u = (it * 8 + c.wave) * c.G + c.bid;
        if (u >= (PB + SB) * 16) break;
        const int sq = u >> 4, h = u & 15;
        int row0, L; seq_info(sq, row0, L);
        float S[64];
        if (sq >= PB) { const float* p = s0 + (((size_t)(sq - PB) * 16 + h) * 64 + lane) * 64;
#pragma unroll
            for (int j = 0; j < 64; ++j) S[j] = p[j]; }
        else {
#pragma unroll
            for (int j = 0; j < 64; ++j) S[j] = 0.f; }
        const float lg = lng[h * 64 + lane], lb = lnb[h * 64 + lane];
        for (int t = 0; t < L; ++t) {
            const size_t base = (size_t)(row0 + t) * BW + h * 64; const float v = V[base + lane];
            float d = 0.f;
#pragma unroll
            for (int j = 0; j < 64; ++j) d += S[j] * KK[base + j];
            float y = 0.f;
#pragma unroll
            for (int j = 0; j < 64; ++j) { S[j] = S[j] * WD[base + j] - d * BV[base + j] + v * K2[base + j]; y += S[j] * R[base + j]; }
            const float mean = wave_sum(y) * (1.0f / 64.0f), dy = y - mean, var = wave_sum(dy * dy) * (1.0f / 64.0f);
            const float yn = dy * rsqrtf(var + 64e-5f) * lg + lb;
            OB[base + lane] = f2bf((yn + BON[base + lane]) * G[base + lane]);
        }
        float* op = (sq < PB ? outP + (((size_t)sq * 16 + h) * 64 + lane) * 64 : outS + (((size_t)(sq - PB) * 16 + h) * 64 + lane) * 64);
#pragma unroll
        for (int j = 0; j < 64; ++j) op[j] = S[j];
    }
}
__device__ __forceinline__ void ph_rwkv_scan2(const Ctx& c, int boff, const float* __restrict__ RW, const float* __restrict__ s0, const float* __restrict__ lng, const float* __restrict__ lnb, bf16_t* __restrict__ OB,
                                              float* __restrict__ outP, float* __restrict__ outS) {
    LAS float* opb = (LAS float*)c.lds;
    LAS float* yb = opb + 2 * 16 * 384;
    const int tid = c.tid, lane = c.lane, w = c.wave, rl = lane >> 3, cg = lane & 7, vrow = w * 8 + rl;
    const float* G = RW + 6 * (size_t)MPAD * BW; const float* BON = RW + 7 * (size_t)MPAD * BW;
    for (int u = (c.bid - boff + c.G) % c.G; u < (PB + SB) * 16; u += c.G) {
        const int sq = u >> 4, h = u & 15;
        int row0, L; seq_info(sq, row0, L);
        float S[8];
        if (sq >= PB) { const float* p = s0 + (((size_t)(sq - PB) * 16 + h) * 64 + vrow) * 64 + cg * 8;
#pragma unroll
            for (int j = 0; j < 8; ++j) S[j] = p[j]; }
        else {
#pragma unroll
            for (int j = 0; j < 8; ++j) S[j] = 0.f; }
        const float lg = lng[h * 64 + lane], lb = lnb[h * 64 + lane];
        const int nb = (L + 15) >> 4;
#define RW_STAGE(bi_) do { const int t0_ = (bi_) * 16, nT_ = (L - t0_) < 16 ? (L - t0_) : 16; LAS float* dst_ = opb + ((bi_) & 1) * 16 * 384; \
        for (int idx = tid; idx < nT_ * 96; idx += 512) { const int t = idx / 96, rem = idx - t * 96, slot = rem >> 4, c4 = rem & 15; \
            const int arr = slot == 0 ? 1 : slot == 1 ? 4 : slot == 2 ? 5 : slot == 3 ? 2 : slot == 4 ? 0 : 3; \
            *(LAS f32x4*)(dst_ + t * 384 + slot * 64 + c4 * 4) = *(const f32x4*)(RW + (size_t)arr * MPAD * BW + (size_t)(row0 + t0_ + t) * BW + h * 64 + c4 * 4); } } while (0)
        RW_STAGE(0);
        for (int bi = 0; bi < nb; ++bi) {
            __syncthreads();
            if (bi + 1 < nb) RW_STAGE(bi + 1);
            const int t0 = bi * 16, nT = (L - t0) < 16 ? (L - t0) : 16; const LAS float* src = opb + (bi & 1) * 16 * 384;
            for (int tt = 0; tt < nT; ++tt) {
                const LAS float* b = src + tt * 384 + cg * 8;
                const f32x4 w0 = *(const LAS f32x4*)(b), w1 = *(const LAS f32x4*)(b + 4), k0 = *(const LAS f32x4*)(b + 64), k1 = *(const LAS f32x4*)(b + 68);
                const f32x4 b0 = *(const LAS f32x4*)(b + 128), b1 = *(const LAS f32x4*)(b + 132), q0 = *(const LAS f32x4*)(b + 192), q1 = *(const LAS f32x4*)(b + 196);
                const f32x4 r0 = *(const LAS f32x4*)(b + 256), r1 = *(const LAS f32x4*)(b + 260); const float v = src[tt * 384 + 320 + vrow];
                float d = (S[0] * k0[0] + S[1] * k0[1]) + (S[2] * k0[2] + S[3] * k0[3]) + (S[4] * k1[0] + S[5] * k1[1]) + (S[6] * k1[2] + S[7] * k1[3]);
                d += __shfl_xor(d, 1, 64); d += __shfl_xor(d, 2, 64); d += __shfl_xor(d, 4, 64);
                float y = 0.f;
#pragma unroll
                for (int j = 0; j < 4; ++j) { S[j] = S[j] * w0[j] - d * b0[j] + v * q0[j]; y += S[j] * r0[j]; S[4 + j] = S[4 + j] * w1[j] - d * b1[j] + v * q1[j]; y += S[4 + j] * r1[j]; }
                y += __shfl_xor(y, 1, 64); y += __shfl_xor(y, 2, 64); y += __shfl_xor(y, 4, 64);
                if (cg == 0) yb[tt * 64 + vrow] = y;
            }
            __syncthreads();
            for (int tt = w; tt < nT; tt += 8) {
                const float y = yb[tt * 64 + lane]; const float mean = wave_sum(y) * (1.0f / 64.0f), dy = y - mean, var = wave_sum(dy * dy) * (1.0f / 64.0f);
                const float yn = dy * rsqrtf(var + 64e-5f) * lg + lb; const size_t o = (size_t)(row0 + t0 + tt) * BW + h * 64 + lane;
                OB[o] = f2bf((yn + BON[o]) * G[o]);
            }
        }
#undef RW_STAGE
        float* op = (sq < PB ? outP + (((size_t)sq * 16 + h) * 64 + vrow) * 64 : outS + (((size_t)(sq - PB) * 16 + h) * 64 + vrow) * 64) + cg * 8;
#pragma unroll
        for (int j = 0; j < 8; ++j) op[j] = S[j];
        __syncthreads();
    }
}
constexpr int RS_SLOTS = 8, RS_SLOT_B = RB_EL * 2;
__device__ __forceinline__ void ph_rwkv_seq(const Ctx& c, int boff, const bf16_t* __restrict__ RB, const float* __restrict__ s0, float* __restrict__ outP, float* __restrict__ outS, bf16_t* __restrict__ OB) {
    const int lane = c.lane, r = lane & 15, q = lane >> 4, w = c.wave;
    LAS unsigned char* ring = c.lds;
    for (int u = (c.bid - boff + c.G) % c.G; u < (PB + SB) * 16; u += c.G) {
        const int sq = u >> 4, h = u & 15;
        int nch, ch0, row0, ntok; const float* sp = nullptr; float* op;
        if (sq < PB) { nch = 256; ch0 = (sq * 16 + h) * 256; row0 = sq * PS; ntok = 16; op = outP + (size_t)(sq * 16 + h) * 4096; }
        else { nch = 1; ch0 = PB * 16 * 256 + (sq - PB) * 16 + h; row0 = MP + (sq - PB) * SS; ntok = SS; sp = s0 + (size_t)((sq - PB) * 16 + h) * 4096; op = outS + (size_t)((sq - PB) * 16 + h) * 4096; }
        if (w >= 4) {
            const int lw = w - 4, p0 = lw < 2 ? lw * 5 : 10 + (lw - 2) * 4, np = lw < 2 ? 5 : 4;
#define RS_ISSUE(ci_) do { const int cc_ = (ci_) < nch ? (ci_) : nch - 1; const char* g_ = (const char*)(RB + (size_t)(ch0 + cc_) * RB_EL) + p0 * 1024 + lane * 16; \
            LAS unsigned char* d_ = ring + ((ci_) % RS_SLOTS) * RS_SLOT_B + p0 * 1024; \
            _Pragma("unroll") for (int p_ = 0; p_ < 5; ++p_) if (p_ < np) __builtin_amdgcn_global_load_lds((const unsigned*)(g_ + p_ * 1024), (LAS unsigned*)(d_ + p_ * 1024), 16, 0, 0); } while (0)
            for (int ci = 0; ci < RS_SLOTS - 1; ++ci) RS_ISSUE(ci);
            if (lw < 2) asm volatile("s_waitcnt vmcnt(30)" ::: "memory"); else asm volatile("s_waitcnt vmcnt(24)" ::: "memory");
            __builtin_amdgcn_s_barrier();
            for (int ci = 0; ci < nch; ++ci) {
                RS_ISSUE(ci + RS_SLOTS - 1);
                if (lw < 2) asm volatile("s_waitcnt vmcnt(30)" ::: "memory"); else asm volatile("s_waitcnt vmcnt(24)" ::: "memory");
                __builtin_amdgcn_s_barrier();
            }
#undef RS_ISSUE
            asm volatile("s_waitcnt vmcnt(0)" ::: "memory");
        } else {
            const int vb = w; f32x4 acc[4];
#pragma unroll
            for (int kb = 0; kb < 4; ++kb) acc[kb] = sp ? *(const f32x4*)(sp + (size_t)(vb * 16 + r) * 64 + kb * 16 + q * 4) : (f32x4){0.f, 0.f, 0.f, 0.f};
            const bf16x8 zfrag = (bf16x8){0, 0, 0, 0, 0, 0, 0, 0};
            __builtin_amdgcn_s_barrier();
            for (int ci = 0; ci < nch; ++ci) {
                const LAS bf16_t* blob = (const LAS bf16_t*)(ring + (ci % RS_SLOTS) * RS_SLOT_B);
                const bf16x8 t0 = pack_acc(acc[0], acc[1]), t1 = pack_acc(acc[2], acc[3]);
                const bf16x8 vt = q < 2 ? *(const LAS bf16x8*)(blob + RB_VT + (vb * 16 + r) * 24 + q * 8) : zfrag;
                const bf16x8 ep = q < 2 ? *(const LAS bf16x8*)(blob + RB_EP + r * 24 + q * 8) : zfrag;
                f32x4 y = mma16(t0, *(const LAS bf16x8*)(blob + RB_QP + r * 72 + q * 8), (f32x4){0.f, 0.f, 0.f, 0.f});
                y = mma16(t1, *(const LAS bf16x8*)(blob + RB_QP + r * 72 + 32 + q * 8), y);
                y = mma16(vt, ep, y);
#pragma unroll
                for (int kb = 0; kb < 4; ++kb) { f32x4 a = mma16(*(const LAS bf16x8*)(blob + (kb * 16 + r) * 72 + q * 8), t0, (f32x4){0.f, 0.f, 0.f, 0.f});
                    a = mma16(*(const LAS bf16x8*)(blob + (kb * 16 + r) * 72 + 32 + q * 8), t1, a);
                    const bf16x8 kh = q < 2 ? *(const LAS bf16x8*)(blob + RB_KHP + (kb * 16 + r) * 24 + q * 8) : zfrag;
                    acc[kb] = mma16(kh, vt, a); }
                if (r < ntok) { u32x2 o; o.x = pk2(y[0], y[1]); o.y = pk2(y[2], y[3]); *(u32x2*)(OB + (size_t)(row0 + ci * 16 + r) * BW + h * 64 + vb * 16 + q * 4) = o; }
                asm volatile("s_waitcnt lgkmcnt(0)" ::: "memory");
                __builtin_amdgcn_s_barrier();
            }
#pragma unroll
            for (int kb = 0; kb < 4; ++kb) *(f32x4*)(op + (size_t)(vb * 16 + r) * 64 + kb * 16 + q * 4) = acc[kb];
        }
        __syncthreads();
    }
}
__device__ __forceinline__ void ph_rwkv_fin(const Ctx& c, const float* __restrict__ RW, const float* __restrict__ lng, const float* __restrict__ lnb, const bf16_t* __restrict__ RAW, bf16_t* __restrict__ OB) {
    const int lane = c.lane; const float* G = RW + 6 * (size_t)MPAD * BW; const float* BON = RW + 7 * (size_t)MPAD * BW;
    for (int i = c.bid * 8 + c.wave; i < MT * 4; i += c.G * 8) {
        const int row = i >> 2, cc = (i & 3) * 256 + lane * 4; const size_t o = (size_t)row * BW + cc; bf16_t* p = OB + o;
        const u32x2 raw = *(const u32x2*)(RAW + o); float x[4] = {__uint_as_float(raw.x << 16), __uint_as_float(raw.x & 0xffff0000u), __uint_as_float(raw.y << 16), __uint_as_float(raw.y & 0xffff0000u)};
        float s = (x[0] + x[1]) + (x[2] + x[3]); s += __shfl_xor(s, 1, 64); s += __shfl_xor(s, 2, 64); s += __shfl_xor(s, 4, 64); s += __shfl_xor(s, 8, 64);
        const float mean = s * (1.0f / 64.0f); float qq = 0.f;
#pragma unroll
        for (int j = 0; j < 4; ++j) { const float d = x[j] - mean; qq += d * d; }
        qq += __shfl_xor(qq, 1, 64); qq += __shfl_xor(qq, 2, 64); qq += __shfl_xor(qq, 4, 64); qq += __shfl_xor(qq, 8, 64);
        const float rstd = rsqrtf(qq * (1.0f / 64.0f) + 64e-5f);
        const f32x4 gg = *(const f32x4*)(lng + cc), bb = *(const f32x4*)(lnb + cc), bo = *(const f32x4*)(BON + o), gt = *(const f32x4*)(G + o); float ov[4];
#pragma unroll
        for (int j = 0; j < 4; ++j) ov[j] = ((x[j] - mean) * rstd * gg[j] + bb[j] + bo[j]) * gt[j];
        u32x2 oo; oo.x = pk2(ov[0], ov[1]); oo.y = pk2(ov[2], ov[3]); *(u32x2*)p = oo;
    }
}

__device__ __forceinline__ void ph_memattn_sample(const Ctx& c, const bf16_t* __restrict__ U, const float* __restrict__ mk, const float* __restrict__ mv, bf16_t* __restrict__ OB) {
    LAS float* qs = (LAS float*)c.lds; LAS float* ps = qs + 2 * 4 * 256;
    const int hh = c.tid >> 8, vt = c.tid & 255, lane = c.lane;
    for (int u = c.bid; u < SB * 2; u += c.G) {
        const int sq = u >> 1, h = (u & 1) * 2 + hh;
#pragma unroll
        for (int t = 0; t < 4; ++t) qs[(hh * 4 + t) * 256 + vt] = bf2f(U[(size_t)(MP + sq * SS + t) * NINP + U_MQ + h * 256 + vt]) * 0.0625f;
        __syncthreads();
        { const float* kr = mk + (((size_t)sq * MEMT + vt) * 4 + h) * 256; float s[4] = {0.f, 0.f, 0.f, 0.f};
            for (int d = 0; d < 256; d += 4) { const f32x4 kv = *(const f32x4*)(kr + d);
#pragma unroll
                for (int t = 0; t < 4; ++t) { const LAS float* qq = qs + (hh * 4 + t) * 256 + d; s[t] += kv[0] * qq[0] + kv[1] * qq[1] + kv[2] * qq[2] + kv[3] * qq[3]; } }
#pragma unroll
            for (int t = 0; t < 4; ++t) ps[(hh * 4 + t) * 256 + vt] = s[t]; }
        __syncthreads();
        { LAS float* pr = ps + c.wave * 256; float x[4]; float mx = -3.0e38f;
#pragma unroll
            for (int j = 0; j < 4; ++j) { x[j] = pr[lane + 64 * j]; mx = fmaxf(mx, x[j]); }
            mx = wave_max(mx); float s = 0.f;
#pragma unroll
            for (int j = 0; j < 4; ++j) { x[j] = __expf(x[j] - mx); s += x[j]; }
            const float inv = 1.0f / wave_sum(s);
#pragma unroll
            for (int j = 0; j < 4; ++j) pr[lane + 64 * j] = x[j] * inv; }
        __syncthreads();
        { float o[4] = {0.f, 0.f, 0.f, 0.f}; const float* vr = mv + ((size_t)sq * MEMT * 4 + h) * 256 + vt;
            for (int m = 0; m < MEMT; ++m) { const float vv = vr[(size_t)m * 1024];
#pragma unroll
                for (int t = 0; t < 4; ++t) o[t] += ps[(hh * 4 + t) * 256 + m] * vv; }
#pragma unroll
            for (int t = 0; t < 4; ++t) OB[(size_t)(MP + sq * SS + t) * BW + h * 256 + vt] = f2bf(o[t]); }
        __syncthreads();
    }
}

template <int K, int LDA, int LDB> __device__ __forceinline__ void skinny_pair(const Ctx& c, const bf16_t* __restrict__ A, const bf16_t* __restrict__ B0, const bf16_t* __restrict__ B1, f32x4 (&out)[2], int rot) {
    LAS f32x4* red = (LAS f32x4*)c.lds;
    const int lane = c.lane, r = lane & 15, q = lane >> 4, w = c.wave;
    constexpr int KS = K / 8;
    const bf16_t* ap = A + (size_t)r * LDA + w * KS + q * 8; const bf16_t* b0 = B0 + (size_t)r * LDB + w * KS + q * 8; const bf16_t* b1 = B1 + (size_t)r * LDB + w * KS + q * 8;
    f32x4 acc[2][8];
#pragma unroll
    for (int n = 0; n < 2; ++n)
#pragma unroll
        for (int m = 0; m < 8; ++m) acc[n][m] = (f32x4){0.f, 0.f, 0.f, 0.f};
    int kk = (int)((unsigned)rot % (unsigned)(KS / 32));
#pragma unroll 2
    for (int it = 0; it < KS / 32; ++it) { const int ks = kk; kk = kk + 1 == KS / 32 ? 0 : kk + 1;
        const bf16x8 f0 = *(const bf16x8*)(b0 + ks * 32), f1 = *(const bf16x8*)(b1 + ks * 32); bf16x8 af[8];
#pragma unroll
        for (int m = 0; m < 8; ++m) af[m] = *(const bf16x8*)(ap + (size_t)(m * 16) * LDA + ks * 32);
#pragma unroll
        for (int m = 0; m < 8; ++m) { acc[0][m] = mma16(f0, af[m], acc[0][m]); acc[1][m] = mma16(f1, af[m], acc[1][m]); } }
    __syncthreads();
#pragma unroll
    for (int n = 0; n < 2; ++n)
#pragma unroll
        for (int m = 0; m < 8; ++m) red[(w * 16 + n * 8 + m) * 64 + lane] = acc[n][m];
    __syncthreads();
#pragma unroll
    for (int n = 0; n < 2; ++n) { f32x4 s = red[(n * 8 + w) * 64 + lane];
#pragma unroll
        for (int ww = 1; ww < 8; ++ww) s += red[(ww * 16 + n * 8 + w) * 64 + lane];
        out[n] = s; }
}
template <int K, int LDA, int LDB> __device__ __forceinline__ f32x4 skinny_one(const Ctx& c, const bf16_t* __restrict__ A, const bf16_t* __restrict__ B0, int rot) {
    LAS f32x4* red = (LAS f32x4*)c.lds;
    const int lane = c.lane, r = lane & 15, q = lane >> 4, w = c.wave;
    constexpr int KS = K / 8, NK = KS / 32;
    const bf16_t* ap = A + (size_t)r * LDA + w * KS + q * 8; const bf16_t* b0 = B0 + (size_t)r * LDB + w * KS + q * 8;
    f32x4 acc[8];
#pragma unroll
    for (int m = 0; m < 8; ++m) acc[m] = (f32x4){0.f, 0.f, 0.f, 0.f};
    int kk = (int)((unsigned)rot % (unsigned)NK);
#pragma unroll 4
    for (int it = 0; it < NK; ++it) { const int ks = kk; kk = kk + 1 == NK ? 0 : kk + 1;
        const bf16x8 f0 = *(const bf16x8*)(b0 + ks * 32); bf16x8 af[8];
#pragma unroll
        for (int m = 0; m < 8; ++m) af[m] = *(const bf16x8*)(ap + (size_t)(m * 16) * LDA + ks * 32);
#pragma unroll
        for (int m = 0; m < 8; ++m) acc[m] = mma16(f0, af[m], acc[m]); }
    __syncthreads();
#pragma unroll
    for (int m = 0; m < 8; ++m) red[(w * 8 + m) * 64 + lane] = acc[m];
    __syncthreads();
    f32x4 s = red[w * 64 + lane];
#pragma unroll
    for (int ww = 1; ww < 8; ++ww) s += red[(ww * 8 + w) * 64 + lane];
    return s;
}
__device__ __forceinline__ u32x2 pk4(const f32x4 v) { u32x2 o; o.x = pk2(v[0], v[1]); o.y = pk2(v[2], v[3]); return o; }
#define SKINNY_LOOP(total_) for (int s = c.bid - base; s >= 0 && s < (total_); s += ncu)
__device__ __forceinline__ void ph_sk_in(const Ctx& c, int base, int ncu, const bf16_t* __restrict__ HB, const bf16_t* __restrict__ W, bf16_t* __restrict__ U) {
    const int r = c.lane & 15, q = c.lane >> 4, w = c.wave;
    SKINNY_LOOP(NINP / 32) { f32x4 o[2]; skinny_pair<DM, DM, DM>(c, HB + (size_t)MP * DM, W + (size_t)(s * 32) * DM, W + (size_t)(s * 32 + 16) * DM, o, s);
        bf16_t* up = U + (size_t)(MP + w * 16 + r) * NINP + s * 32 + q * 4; *(u32x2*)up = pk4(o[0]); *(u32x2*)(up + 16) = pk4(o[1]); }
}
__device__ __forceinline__ void ph_sk_merge(const Ctx& c, int base, int ncu, const bf16_t* __restrict__ BR, const bf16_t* __restrict__ W, const bf16_t* __restrict__ U, const float* __restrict__ gate_b, bf16_t* __restrict__ MGB) {
    const int r = c.lane & 15, q = c.lane >> 4, w = c.wave;
    SKINNY_LOOP(DM / 16) { const size_t row = (size_t)(MP + w * 16 + r); const int col = s * 16 + q * 4; f32x4 tot = (f32x4){0.f, 0.f, 0.f, 0.f};
#pragma unroll 1
        for (int z = 0; z < 4; ++z) { const f32x4 o = skinny_one<BW, BW, BW>(c, BR + ((size_t)z * MPAD + MP) * BW, W + ((size_t)z * DM + s * 16) * BW, s + z);
            const u32x2 gp = *(const u32x2*)(U + row * NINP + U_GP + z * DM + col); const f32x4 gb = *(const f32x4*)(gate_b + z * DM + col);
            tot[0] += sigmoidf_(__uint_as_float(gp.x << 16) + gb[0]) * o[0]; tot[1] += sigmoidf_(__uint_as_float(gp.x & 0xffff0000u) + gb[1]) * o[1];
            tot[2] += sigmoidf_(__uint_as_float(gp.y << 16) + gb[2]) * o[2]; tot[3] += sigmoidf_(__uint_as_float(gp.y & 0xffff0000u) + gb[3]) * o[3]; }
        *(u32x2*)(MGB + row * DM + col) = pk4(tot); }
}
template <int K> __device__ __forceinline__ void ph_sk_res(const Ctx& c, int base, int ncu, const bf16_t* __restrict__ A, const bf16_t* __restrict__ W, const float* __restrict__ R, float* __restrict__ Y) {
    const int r = c.lane & 15, q = c.lane >> 4, w = c.wave;
    SKINNY_LOOP(DM / 16) { const f32x4 o = skinny_one<K, K, K>(c, A + (size_t)MP * K, W + (size_t)(s * 16) * K, s);
        const size_t off = (size_t)(MP + w * 16 + r) * DM + s * 16 + q * 4; *(f32x4*)(Y + off) = *(const f32x4*)(R + off) * ALPHA + o; }
}
__device__ __forceinline__ void ph_sk_gu(const Ctx& c, int base, int ncu, const bf16_t* __restrict__ X1B, const bf16_t* __restrict__ W, bf16_t* __restrict__ ACT) {
    const int r = c.lane & 15, q = c.lane >> 4, w = c.wave;
    SKINNY_LOOP(DFF / 16) { const int t = s >> 3, j0 = (s & 7) * 16; f32x4 o[2];
        skinny_pair<DM, DM, DM>(c, X1B + (size_t)MP * DM, W + (size_t)(t * 256 + j0) * DM, W + (size_t)(t * 256 + 128 + j0) * DM, o, s);
        f32x4 v;
#pragma unroll
        for (int j = 0; j < 4; ++j) v[j] = o[0][j] * sigmoidf_(o[0][j]) * o[1][j];
        *(u32x2*)(ACT + (size_t)(MP + w * 16 + r) * DFF + t * 128 + j0 + q * 4) = pk4(v); }
}
#undef SKINNY_LOOP

constexpr int LDS_BAR_OFF = 147456;
constexpr int LDS_BYTES = LDS_BAR_OFF + 64;
struct Args { const float* in[37]; float* out; unsigned char* ws; };

typedef pg8::Gemm<DM, DM, DM, 2, 8, NL, 1, false, 0, 0, (long)DM * DM, 0> GemmMem;
typedef pg8::Gemm<DM, DM, DM, MP / 256, NINP / 256> GemmIn;
typedef pg8::Gemm<NINP, 1024, 256, PS / 256, 1, 8, 4, false, (long)PS * NINP, 256, 256 * 1024, 256> GemmScore;
typedef pg8::Gemm<256, 256, 256, PS / 256, 1, 8, 4, false, (long)4 * 4096 * 256, (long)4096 * 256, 4 * 65536, 65536> GemmPV;
typedef pg8::Gemm<BW, BW, BW, MP / 256, DM / 256, 4, 1, true, (long)MPAD * BW, 0, (long)DM * BW, 0> GemmBranch;
typedef pg8::Gemm<DM, DM, DM, MP / 256, DM / 256> GemmOut;
typedef pg8::Gemm<DM, DM, DM, MP / 256, 2 * DFF / 256> GemmGU;
typedef pg8::Gemm<DFF, DFF, DFF, MP / 256, DM / 256> GemmDown;
template <class GT> __device__ __forceinline__ GT mk_gemm(const Ctx& c, const bf16_t* A, const bf16_t* B) { GT g; g.A = A; g.B = B; g.G = c.G; g.c = c.bid; return g; }

template <int OFF> __device__ __forceinline__ unsigned long long karg_u64(unsigned long long kargs) {
    unsigned long long p; asm volatile("s_load_dwordx2 %0, %1, %2\n\ts_waitcnt lgkmcnt(0)" : "=s"(p) : "s"(kargs), "n"(OFF) : "memory"); return p;
}
#define INP(k) ((const float*)karg_u64<(k) * 8>(kargs))
#define OUTP() ((float*)karg_u64<37 * 8>(kargs))
#define WSP() ((unsigned char*)karg_u64<38 * 8>(kargs))

__global__ void __launch_bounds__(512, 2) mega_fwd(Args a_unused) {
    extern __shared__ __attribute__((aligned(16))) unsigned char lds_raw[];
    const unsigned long long kargs = (unsigned long long)__builtin_amdgcn_kernarg_segment_ptr();
    Ctx c0; c0.tid = threadIdx.x; c0.lane = c0.tid & 63; c0.wave = __builtin_amdgcn_readfirstlane(c0.tid >> 6); c0.bid = blockIdx.x; c0.G = gridDim.x; c0.lds = (LAS unsigned char*)lds_raw;
    if (c0.tid < 4) ((LAS unsigned*)(c0.lds + LDS_BAR_OFF))[c0.tid] = 0u;
    __syncthreads();
    const XcdBarrier bar = xcd_barrier_post((unsigned*)(WSP() + WS_CTL), (volatile LAS unsigned*)(c0.lds + LDS_BAR_OFF));

#define WPREP_LAYER(cc_, L_) do { unsigned char* ws_ = WSP(); \
      ph_wprep(cc_, INP(10) + (size_t)(L_) * DM * NIN, (bf16_t*)(ws_ + WS_WIN) + (size_t)(L_) * NINP * DM, DM, NIN, NINP, 1, 1, 0, 0); \
      ph_wprep(cc_, INP(29) + (size_t)(L_) * 4 * BW * DM, (bf16_t*)(ws_ + WS_WBR) + (size_t)(L_) * 4 * DM * BW, BW, DM, DM, 0, 4, (size_t)BW * DM, (size_t)DM * BW); \
      ph_wprep(cc_, INP(30) + (size_t)(L_) * DM * DM, (bf16_t*)(ws_ + WS_WOUT) + (size_t)(L_) * DM * DM, DM, DM, DM, 0, 1, 0, 0); \
      ph_wprep(cc_, INP(33) + (size_t)(L_) * DM * 2 * DFF, (bf16_t*)(ws_ + WS_WGU) + (size_t)(L_) * 2 * DFF * DM, DM, 2 * DFF, 2 * DFF, 2, 1, 0, 0); \
      ph_wprep(cc_, INP(34) + (size_t)(L_) * DFF * DM, (bf16_t*)(ws_ + WS_WDN) + (size_t)(L_) * DM * DFF, DFF, DM, DM, 0, 1, 0, 0); } while (0)
    { const Ctx c = fresh(c0); unsigned char* ws = WSP();
      ph_wprep(c, INP(28), (bf16_t*)(ws + WS_WMEM), DM, DM, DM, 0, NL, (size_t)DM * DM, (size_t)DM * DM);
      WPREP_LAYER(c, 0);
      ph_lrw(c, INP(19), INP(21), INP(22), (bf16_t*)(ws + WS_LRW));
      ph_xprep(c, INP(0), INP(1), INP(2), (float*)(ws + WS_HF), (bf16_t*)(ws + WS_HB), (bf16_t*)(ws + WS_MEMB)); }
    xcd_barrier(bar);
    { const Ctx c = fresh(c0); unsigned char* ws = WSP(); float* out = OUTP();
      GemmMem g = mk_gemm<GemmMem>(c, (const bf16_t*)(ws + WS_MEMB), (const bf16_t*)(ws + WS_WMEM));
      pg8::EpiMem E; E.outK = out + O_MKP; E.outV = out + O_MVP; E.kb = (bf16_t*)(ws + WS_MKB); E.vt = (bf16_t*)(ws + WS_MVT); pg8::gemm_phase<GemmMem, pg8::EpiMem, true, true>(c.lds, c.tid, g, E); }

    for (int l = 0; l < NL; ++l) {
        { const Ctx c = fresh(c0); unsigned char* ws = WSP();
          GemmIn g = mk_gemm<GemmIn>(c, (const bf16_t*)(ws + WS_HB), (const bf16_t*)(ws + WS_WIN) + (size_t)l * NINP * DM);
          pg8::EpiBf16 E; E.O = (bf16_t*)(ws + WS_U); E.zs = 0; E.ldc = NINP; E.pad = 0; pg8::gemm_phase<GemmIn, pg8::EpiBf16, true, true>(c.lds, c.tid, g, E); }
        { const Ctx c = fresh(c0); unsigned char* ws = WSP(); ph_sk_in(c, c.G > 192 ? 96 : 0, c.G > 192 ? c.G - 96 : c.G, (const bf16_t*)(ws + WS_HB), (const bf16_t*)(ws + WS_WIN) + (size_t)l * NINP * DM, (bf16_t*)(ws + WS_U)); }
        xcd_barrier(bar);
        { const Ctx c = fresh(c0); unsigned char* ws = WSP(); float* out = OUTP(); const bf16_t* U = (const bf16_t*)(ws + WS_U); bf16_t* BR = (bf16_t*)(ws + WS_BR);
          (void)out; (void)BR;
          ph_gla_pre(c, U, INP(12) + (size_t)l * 16 * 512, INP(13) + (size_t)l * 512, (bf16_t*)(ws + WS_GLQD), (bf16_t*)(ws + WS_GLKH), (bf16_t*)(ws + WS_GLE), (bf16_t*)(ws + WS_GLVT), (float*)(ws + WS_GLGC)); }
        { const Ctx c = fresh(c0); unsigned char* ws = WSP();
          ph_rwkv_pre(c, (const bf16_t*)(ws + WS_U), INP(9) + (size_t)l * SB * RWC, INP(17) + (size_t)l * RWC, INP(18) + (size_t)l * BW, INP(19) + (size_t)l * 64 * BW, INP(20) + (size_t)l * BW, INP(21) + (size_t)l * 64 * BW,
                       INP(22) + (size_t)l * 128 * BW, INP(23) + (size_t)l * BW, INP(24) + (size_t)l * BW, INP(25) + (size_t)l * BW, (float*)(ws + WS_RW), (bf16_t*)(ws + WS_RB), (const bf16_t*)(ws + WS_LRW) + (size_t)l * 1024 * 256); }
        { const Ctx c = fresh(c0); unsigned char* ws = WSP();
          GemmScore g = mk_gemm<GemmScore>(c, (const bf16_t*)(ws + WS_U) + U_MQ, (const bf16_t*)(ws + WS_MKB) + (size_t)l * 512 * 1024);
          pg8::EpiScore E; E.SC = (float*)(ws + WS_SC); pg8::gemm_phase<GemmScore, pg8::EpiScore, true, true>(c.lds, c.tid, g, E); }
        xcd_barrier(bar);
        { const Ctx c = fresh(c0); unsigned char* ws = WSP(); float* out = OUTP();
          ph_rwkv_seq(c, 64, (const bf16_t*)(ws + WS_RB), INP(8) + (size_t)l * SB * 16 * 4096, out + O_RWP + (size_t)l * PB * 16 * 4096, out + O_RWS + (size_t)l * SB * 16 * 4096,
                      (bf16_t*)(ws + WS_RAW) + (size_t)MPAD * BW); }
        { const Ctx c = fresh(c0); unsigned char* ws = WSP(); float* out = OUTP();
          ph_gla_seq(c, 32, (const bf16_t*)(ws + WS_GLQD), (const bf16_t*)(ws + WS_GLKH), (const bf16_t*)(ws + WS_GLE), (const bf16_t*)(ws + WS_GLVT), (const float*)(ws + WS_GLGC),
                     INP(7) + (size_t)l * SB * 4 * 32768, out + O_GLAP + (size_t)l * PB * 4 * 32768, out + O_GLAS + (size_t)l * SB * 4 * 32768, (bf16_t*)(ws + WS_RAW)); }
        { const Ctx c = fresh(c0); unsigned char* ws = WSP(); ph_softmax256(c, (const float*)(ws + WS_SC), (bf16_t*)(ws + WS_PB), 8 * 4096); }
        if ((c0.bid < 32 || c0.bid >= 96) && c0.G > 96) {
        { Ctx c = fresh(c0); c.bid = c.bid < 32 ? c.bid : c.bid - 64; c.G = c.G - 64; unsigned char* ws = WSP(); ph_swa_prompt(c, (const bf16_t*)(ws + WS_U), INP(16) + (size_t)l * 16, (bf16_t*)(ws + WS_BR) + (size_t)MPAD * BW); }
        { Ctx c = fresh(c0); c.bid = c.bid < 32 ? c.bid : c.bid - 64; c.G = c.G - 64; unsigned char* ws = WSP();
          ph_swa_sample(c, (const bf16_t*)(ws + WS_U), INP(3) + (size_t)l * SB * 16384, INP(4) + (size_t)l * SB * 16384, INP(16) + (size_t)l * 16, (bf16_t*)(ws + WS_BR) + (size_t)MPAD * BW); }
        { Ctx c = fresh(c0); c.bid = c.bid < 32 ? c.bid : c.bid - 64; c.G = c.G - 64; unsigned char* ws = WSP();
          ph_memattn_sample(c, (const bf16_t*)(ws + WS_U), INP(5) + (size_t)l * SB * MEMT * 1024, INP(6) + (size_t)l * SB * MEMT * 1024, (bf16_t*)(ws + WS_BR) + (size_t)3 * MPAD * BW); }
        { Ctx c = fresh(c0); c.bid = c.bid < 32 ? c.bid : c.bid - 64; c.G = c.G - 64; unsigned char* ws = WSP();
          ph_copy_outs(c, (const bf16_t*)(ws + WS_U), INP(3) + (size_t)l * SB * 16384, INP(4) + (size_t)l * SB * 16384, OUTP(), l); }
          if (l + 1 < NL) { Ctx c = fresh(c0); c.bid = c.bid < 32 ? c.bid : c.bid - 64; c.G = c.G - 64; WPREP_LAYER(c, l + 1); }
        }
        xcd_barrier(bar);
        { const Ctx c = fresh(c0); unsigned char* ws = WSP(); ph_rwkv_fin(c, (const float*)(ws + WS_RW), INP(26) + (size_t)l * BW, INP(27) + (size_t)l * BW, (const bf16_t*)(ws + WS_RAW) + (size_t)MPAD * BW, (bf16_t*)(ws + WS_BR) + (size_t)2 * MPAD * BW); }
        { const Ctx c = fresh(c0); unsigned char* ws = WSP(); ph_gla_fin(c, (const bf16_t*)(ws + WS_U), INP(14) + (size_t)l * BW, INP(15) + (size_t)l * BW, (const bf16_t*)(ws + WS_RAW), (bf16_t*)(ws + WS_BR)); }
        { const Ctx c = fresh(c0); unsigned char* ws = WSP();
          GemmPV g = mk_gemm<GemmPV>(c, (const bf16_t*)(ws + WS_PB), (const bf16_t*)(ws + WS_MVT) + (size_t)l * 8 * 65536);
          pg8::EpiPV E; E.O = (bf16_t*)(ws + WS_BR) + (size_t)3 * MPAD * BW; pg8::gemm_phase<GemmPV, pg8::EpiPV, true, true>(c.lds, c.tid, g, E); }
        xcd_barrier(bar);
        { const Ctx c = fresh(c0); unsigned char* ws = WSP();
          GemmBranch g = mk_gemm<GemmBranch>(c, (const bf16_t*)(ws + WS_BR), (const bf16_t*)(ws + WS_WBR) + (size_t)l * 4 * DM * BW);
          pg8::EpiMerge E; E.MG = (float*)(ws + WS_MG); E.MGB = (bf16_t*)(ws + WS_MGB); E.U = (const bf16_t*)(ws + WS_U); E.gate_b = INP(11) + (size_t)l * 4 * DM; pg8::gemm_phase<GemmBranch, pg8::EpiMerge, true, true>(c.lds, c.tid, g, E); }
        { const Ctx c = fresh(c0); unsigned char* ws = WSP(); ph_sk_merge(c, 0, c.G, (const bf16_t*)(ws + WS_BR), (const bf16_t*)(ws + WS_WBR) + (size_t)l * 4 * DM * BW, (const bf16_t*)(ws + WS_U), INP(11) + (size_t)l * 4 * DM, (bf16_t*)(ws + WS_MGB)); }
        xcd_barrier(bar);
        { const Ctx c = fresh(c0); unsigned char* ws = WSP();
          GemmOut g = mk_gemm<GemmOut>(c, (const bf16_t*)(ws + WS_MGB), (const bf16_t*)(ws + WS_WOUT) + (size_t)l * DM * DM);
          pg8::EpiRes E; E.R = (const float*)(ws + WS_HF); E.Y = (float*)(ws + WS_Y); pg8::gemm_phase<GemmOut, pg8::EpiRes, true, true>(c.lds, c.tid, g, E); }
        { const Ctx c = fresh(c0); unsigned char* ws = WSP(); ph_sk_res<DM>(c, c.G > 192 ? 128 : 0, c.G > 192 ? c.G - 128 : c.G, (const bf16_t*)(ws + WS_MGB), (const bf16_t*)(ws + WS_WOUT) + (size_t)l * DM * DM, (const float*)(ws + WS_HF), (float*)(ws + WS_Y)); }
        xcd_barrier(bar);
        { const Ctx c = fresh(c0); unsigned char* ws = WSP(); ph_ln(c, (const float*)(ws + WS_Y), INP(31) + (size_t)l * DM, INP(32) + (size_t)l * DM, (float*)(ws + WS_X1F), (bf16_t*)(ws + WS_X1B), nullptr, MT, 0); }
        xcd_barrier(bar);
        { const Ctx c = fresh(c0); unsigned char* ws = WSP();
          GemmGU g = mk_gemm<GemmGU>(c, (const bf16_t*)(ws + WS_X1B), (const bf16_t*)(ws + WS_WGU) + (size_t)l * 2 * DFF * DM);
          pg8::EpiSwiGLU E; E.O = (bf16_t*)(ws + WS_ACT); pg8::gemm_phase<GemmGU, pg8::EpiSwiGLU, true, true>(c.lds, c.tid, g, E); }
        { const Ctx c = fresh(c0); unsigned char* ws = WSP(); ph_sk_gu(c, c.G > 192 ? 128 : 0, c.G > 192 ? c.G - 128 : c.G, (const bf16_t*)(ws + WS_X1B), (const bf16_t*)(ws + WS_WGU) + (size_t)l * 2 * DFF * DM, (bf16_t*)(ws + WS_ACT)); }
        xcd_barrier(bar);
        { const Ctx c = fresh(c0); unsigned char* ws = WSP();
          GemmDown g = mk_gemm<GemmDown>(c, (const bf16_t*)(ws + WS_ACT), (const bf16_t*)(ws + WS_WDN) + (size_t)l * DM * DFF);
          pg8::EpiRes E; E.R = (const float*)(ws + WS_X1F); E.Y = (float*)(ws + WS_Y); pg8::gemm_phase<GemmDown, pg8::EpiRes, true, true>(c.lds, c.tid, g, E); }
        { const Ctx c = fresh(c0); unsigned char* ws = WSP(); ph_sk_res<DFF>(c, 0, c.G, (const bf16_t*)(ws + WS_ACT), (const bf16_t*)(ws + WS_WDN) + (size_t)l * DM * DFF, (const float*)(ws + WS_X1F), (float*)(ws + WS_Y)); }
        xcd_barrier(bar);
        { const Ctx c = fresh(c0); unsigned char* ws = WSP(); float* out = OUTP(); ph_ln(c, (const float*)(ws + WS_Y), INP(35) + (size_t)l * DM, INP(36) + (size_t)l * DM, (float*)(ws + WS_HF), (bf16_t*)(ws + WS_HB), l == NL - 1 ? out : nullptr, MT, MT); }
        xcd_barrier(bar);
    }
}

extern "C" void kernel_launch(void* const* d_in, const int* in_sizes, int n_in, void* d_out, int out_size, void* d_ws, size_t ws_size, hipStream_t stream) {
    static int grid = 0;
    if (grid == 0) {
        if (n_in != 37 || (size_t)out_size != O_END || ws_size < WS_END) { fprintf(stderr, "kernel_launch: unexpected sizes (n_in %d out %d ws %zu need %zu)\n", n_in, out_size, ws_size, (size_t)WS_END); grid = -1; return; }
        int dev = 0, cus = 0;
        if (hipGetDevice(&dev) != hipSuccess || hipDeviceGetAttribute(&cus, hipDeviceAttributeMultiprocessorCount, dev) != hipSuccess) { grid = -1; return; }
        if (hipFuncSetAttribute((const void*)mega_fwd, hipFuncAttributeMaxDynamicSharedMemorySize, LDS_BYTES) != hipSuccess) { fprintf(stderr, "kernel_launch: hipFuncSetAttribute failed\n"); grid = -1; return; }
        int per_cu = 0;
        if (hipOccupancyMaxActiveBlocksPerMultiprocessor(&per_cu, (const void*)mega_fwd, 512, LDS_BYTES) != hipSuccess || per_cu < 1) { fprintf(stderr, "kernel_launch: occupancy query says %d\n", per_cu); }
        (void)hipGetLastError();
        grid = cus;
    }
    if (grid < 0) return;
    (void)hipMemsetAsync((unsigned char*)d_ws + WS_CTL, 0, XCD_BAR_WORDS * sizeof(unsigned), stream);
    Args a; memset(&a, 0, sizeof a);
    for (int i = 0; i < 37; ++i) a.in[i] = (const float*)d_in[i];
    a.out = (float*)d_out; a.ws = (unsigned char*)d_ws;
    hipLaunchKernelGGL(mega_fwd, dim3(grid), dim3(512), LDS_BYTES, stream, a);
}
```

```cpp
#include <hip/hip_runtime.h>
#include <cstdio>
#include <cstdint>
#include <cstring>

#define LAS __attribute__((address_space(3)))
typedef unsigned short bf16_t;
typedef short bf16x8 __attribute__((ext_vector_type(8)));
typedef float f32x4 __attribute__((ext_vector_type(4)));
typedef float f32x2 __attribute__((ext_vector_type(2)));
typedef unsigned u32x4 __attribute__((ext_vector_type(4)));
typedef unsigned u32x2 __attribute__((ext_vector_type(2)));

constexpr int DM = 2048, NL = 4;
constexpr int PB = 2, PS = 4096, MP = PB * PS;
constexpr int SB = 32, SS = 4, MS = SB * SS;
constexpr int MT = MP + MS;
constexpr int MPAD = 8448;
constexpr int NIN = 16912, NINP = 17152;
constexpr int U_GQ = 0, U_GK = 512, U_GV = 1024, U_GR = 2048, U_GA = 3072, U_SQ = 3328, U_SK = 4352, U_SV = 4480, U_RU = 4608, U_MQ = 7936, U_GP = 8960;
constexpr int RWC = 3328, BW = 1024, DFF = 5632, MEMT = 256;
constexpr float ALPHA = 1.681792830507429f;

constexpr size_t O_YP = 0;
constexpr size_t O_YS = O_YP + (size_t)MP * DM;
constexpr size_t O_SWKP = O_YS + (size_t)MS * DM;
constexpr size_t O_SWVP = O_SWKP + (size_t)NL * PB * 128 * 128;
constexpr size_t O_MKP = O_SWVP + (size_t)NL * PB * 128 * 128;
constexpr size_t O_MVP = O_MKP + (size_t)NL * PB * 256 * 1024;
constexpr size_t O_GLAP = O_MVP + (size_t)NL * PB * 256 * 1024;
constexpr size_t O_RWP = O_GLAP + (size_t)NL * PB * 4 * 128 * 256;
constexpr size_t O_RSP = O_RWP + (size_t)NL * PB * 16 * 64 * 64;
constexpr size_t O_SWKS = O_RSP + (size_t)NL * PB * RWC;
constexpr size_t O_SWVS = O_SWKS + (size_t)NL * SB * 128 * 128;
constexpr size_t O_GLAS = O_SWVS + (size_t)NL * SB * 128 * 128;
constexpr size_t O_RWS = O_GLAS + (size_t)NL * SB * 4 * 128 * 256;
constexpr size_t O_RSS = O_RWS + (size_t)NL * SB * 16 * 64 * 64;
constexpr size_t O_END = O_RSS + (size_t)NL * SB * RWC;
static_assert(O_END == 52881408, "output size");

constexpr size_t al256(size_t x) { return (x + 255) & ~(size_t)255; }
constexpr size_t WS_CTL = 0;
constexpr size_t WS_WIN = 65536;
constexpr size_t WS_WMEM = WS_WIN + (size_t)NL * NINP * DM * 2;
constexpr size_t WS_WBR = WS_WMEM + (size_t)NL * DM * DM * 2;
constexpr size_t WS_WOUT = WS_WBR + (size_t)NL * 4 * DM * BW * 2;
constexpr size_t WS_WGU = WS_WOUT + (size_t)NL * DM * DM * 2;
constexpr size_t WS_WDN = WS_WGU + (size_t)NL * 2 * DFF * DM * 2;
constexpr size_t WS_HF = WS_WDN + (size_t)NL * DM * DFF * 2;
constexpr size_t WS_HB = WS_HF + (size_t)MPAD * DM * 4;
constexpr size_t WS_U = WS_HB + (size_t)MPAD * DM * 2;
constexpr size_t WS_BR = WS_U + (size_t)MPAD * NINP * 2;
constexpr size_t WS_MG = WS_BR + (size_t)4 * MPAD * BW * 2;
constexpr size_t WS_MGB = WS_MG + (size_t)MPAD * DM * 4;
constexpr size_t WS_Y = WS_MGB + (size_t)MPAD * DM * 2;
constexpr size_t WS_X1F = WS_Y + (size_t)MPAD * DM * 4;
constexpr size_t WS_X1B = WS_X1F + (size_t)MPAD * DM * 4;
constexpr size_t WS_ACT = WS_X1B + (size_t)MPAD * DM * 2;
constexpr size_t WS_MEMB = WS_ACT + (size_t)MPAD * DFF * 2;
constexpr size_t WS_MKB = WS_MEMB + (size_t)512 * DM * 2;
constexpr size_t WS_MVT = WS_MKB + (size_t)NL * 512 * 1024 * 2;
constexpr size_t WS_SC = WS_MVT + (size_t)NL * 8 * 256 * 256 * 2;
constexpr size_t WS_PB = WS_SC + (size_t)8 * 4096 * 256 * 4;
constexpr size_t WS_RW = WS_PB + (size_t)8 * 4096 * 256 * 2;
constexpr size_t RW_ARR = (size_t)MPAD * BW * 4;
constexpr int GL_NCH = 512 + 128;
constexpr size_t WS_GLQD = WS_RW + 8 * RW_ARR;
constexpr size_t WS_GLKH = WS_GLQD + (size_t)GL_NCH * 8192 * 2;
constexpr size_t WS_GLE = WS_GLKH + (size_t)GL_NCH * 8192 * 2;
constexpr size_t WS_GLVT = WS_GLE + (size_t)GL_NCH * 4096 * 2;
constexpr size_t WS_GLGC = WS_GLVT + (size_t)GL_NCH * 16384 * 2;
constexpr int RB_NCH = PB * 16 * 256 + SB * 16;
constexpr int RB_EL = 9216;
constexpr int RB_QP = 4608, RB_KHP = 5760, RB_VT = 7296, RB_EP = 8832;
constexpr size_t WS_RB = WS_GLGC + (size_t)GL_NCH * 128 * 4;
constexpr size_t WS_RAW = WS_RB + (size_t)RB_NCH * RB_EL * 2;
constexpr size_t WS_LRW = WS_RAW + (size_t)2 * MPAD * BW * 2;
constexpr size_t WS_END = WS_LRW + (size_t)NL * 16 * 64 * 256 * 2;

__device__ __forceinline__ float bf2f(bf16_t b) { return __uint_as_float(((unsigned)b) << 16); }
typedef __bf16 bf16v2_t __attribute__((ext_vector_type(2)));
__device__ __forceinline__ unsigned pk2(float lo, float hi) { const f32x2 v = {lo, hi}; return __builtin_bit_cast(unsigned, __builtin_convertvector(v, bf16v2_t)); }
__device__ __forceinline__ bf16_t f2bf(float f) { return (bf16_t)(pk2(f, 0.f) & 0xffffu); }
__device__ __forceinline__ float wave_sum(float v) {
#pragma unroll
    for (int o = 32; o > 0; o >>= 1) v += __shfl_xor(v, o, 64);
    return v;
}
__device__ __forceinline__ float wave_max(float v) {
#pragma unroll
    for (int o = 32; o > 0; o >>= 1) v = fmaxf(v, __shfl_xor(v, o, 64));
    return v;
}
__device__ __forceinline__ float sigmoidf_(float x) { return 1.0f / (1.0f + __expf(-x)); }
__device__ __forceinline__ float softplusf_(float x) { return fmaxf(x, 0.f) + log1pf(__expf(-fabsf(x))); }
__device__ __forceinline__ float softplus_fast(float x) { return fmaxf(x, 0.f) + __logf(1.0f + __expf(-fabsf(x))); }
__device__ __forceinline__ float tanh_fast(float x) { return 1.0f - 2.0f / (1.0f + __expf(2.0f * x)); }

namespace pg8 {
constexpr int BM = 256, BK = 64, HALF = 128, HTB = HALF * BK * 2, STAGE_BYTES = 8 * HTB, NXCD = 8, WGM = 8;
__host__ __device__ __forceinline__ int lds_byte(int r, int c) { const int st = (r >> 4) * 2 + (c >> 5), rr = r & 15, cc = c & 31, ob = rr * 64 + cc * 2; return st * 1024 + (ob ^ (((ob >> 9) & 1) << 5)); }
__host__ __device__ __forceinline__ void stage_rc(int b, int& R, int& C) { const int st = b / 1024, sb = b % 1024, swz = sb ^ (((sb >> 9) & 1) << 5); R = (st >> 1) * 16 + swz / 64; C = (st & 1) * 32 + (swz % 64) / 2; }
__host__ __device__ __forceinline__ int perm32(int rho) { const int n = rho >> 4, i = rho & 15; return 8 * (i >> 2) + 4 * n + (i & 3); }

struct Unit { int pm, pn, z; };
template <int LDA_, int LDB_, int K_, int NM_, int NN_, int NZ_ = 1, int NZH_ = 1, bool ZINNER_ = false, long ZSAB_ = 0, long ZSAH_ = 0, long ZSBB_ = 0, long ZSBH_ = 0>
struct Gemm {
    static constexpr int LDA = LDA_, LDB = LDB_, K = K_, NM = NM_, NN = NN_, NZ = NZ_, NZH = NZH_; static constexpr bool ZINNER = ZINNER_;
    const bf16_t* A; const bf16_t* B; int G, c;
    __device__ __forceinline__ bool next(int i, Unit& u) const {
        constexpr int nt = NM * NN; int L, z;
        if (ZINNER) { const int it = i / NZ; z = i - it * NZ; const long LL = (long)it * G + c; if (LL >= nt) return false; L = (int)LL; }
        else { const long LL = (long)i * G + c; if (LL >= (long)nt * NZ) return false; z = (int)(LL / nt); L = (int)(LL - (long)z * nt); }
        int wgid = L; { constexpr int q = nt / NXCD, r = nt % NXCD; const int xcd = wgid % NXCD, off = wgid / NXCD; wgid = (xcd < r ? xcd * (q + 1) : r * (q + 1) + (xcd - r) * q) + off; }
        constexpr int nig = WGM * NN; const int gid = wgid / nig, fm = gid * WGM, gsz = (NM - fm) < WGM ? (NM - fm) : WGM;
        u.pm = fm + ((wgid % nig) % gsz); u.pn = (wgid % nig) / gsz; u.z = z; return true;
    }
    __device__ __forceinline__ const char* a_base(const Unit& u) const { const int zb = u.z / NZH, zh = u.z - zb * NZH; return (const char*)(A + zb * ZSAB_ + zh * ZSAH_ + (long)u.pm * BM * LDA); }
    __device__ __forceinline__ const char* b_base(const Unit& u) const { const int zb = u.z / NZH, zh = u.z - zb * NZH; return (const char*)(B + zb * ZSBB_ + zh * ZSBH_ + (long)u.pn * BM * LDB); }
};

template <class GT, class Epi, bool ALIGN_EPI = true, bool SP2 = true>
__device__ __forceinline__ void gemm_phase(LAS unsigned char* lds, const int tid, const GT& g, const Epi& E) {
    const int wid = __builtin_amdgcn_readfirstlane(tid >> 6), lane = tid & 63, wr = wid >> 2, wc = wid & 3, fr = lane & 15, fq = lane >> 4;
    constexpr int nt = GT::K / BK;
    unsigned voffA[2], voffB[2];
#pragma unroll
    for (int i = 0; i < 2; ++i) { int R, C; stage_rc(tid * 16 + i * 8192, R, C); const int Rb = Epi::PERM ? ((R & ~31) + perm32(R & 31)) : R;
        voffA[i] = (unsigned)(R * GT::LDA + C) * 2u; voffB[i] = (unsigned)(Rb * GT::LDB + C) * 2u; }
    constexpr size_t kstep = (size_t)(BK * 2);
    constexpr size_t hstepA = (size_t)HALF * GT::LDA * 2, hstepB = (size_t)HALF * GT::LDB * 2;
    const unsigned ldsw = (unsigned)wid * 1024u;
    const int aoff = lds_byte(wr * 64 + fr, fq * 8), boff = lds_byte(wc * 32 + fr, fq * 8);
#define PG8_SA(b, h) (((b) * 2 + (h)) * HTB)
#define PG8_SB(b, h) ((4 + (b) * 2 + (h)) * HTB)
#define PG8_STAGE(bufoff, gbase, voff) do { _Pragma("unroll") for (int _i = 0; _i < 2; ++_i) \
        __builtin_amdgcn_global_load_lds((const unsigned*)((const char*)(gbase) + (voff)[_i]), (LAS unsigned*)(lds + (bufoff) + ldsw + _i * 8192), 16, 0, 0); } while (0)
#define PG8_LDA(dst, b, h) do { _Pragma("unroll") for (int m = 0; m < 4; ++m) _Pragma("unroll") for (int k = 0; k < 2; ++k) dst[m][k] = *(const LAS bf16x8*)(lds + PG8_SA(b, h) + aoff + m * 2048 + k * 1024); } while (0)
#define PG8_LDB(dst, b, h) do { _Pragma("unroll") for (int n = 0; n < 2; ++n) _Pragma("unroll") for (int k = 0; k < 2; ++k) dst[n][k] = *(const LAS bf16x8*)(lds + PG8_SB(b, h) + boff + n * 2048 + k * 1024); } while (0)
#define PG8_MMA(ai, bj, At, Bt) do { __builtin_amdgcn_s_setprio(1); _Pragma("unroll") for (int m = 0; m < 4; ++m) _Pragma("unroll") for (int n = 0; n < 2; ++n) _Pragma("unroll") for (int k = 0; k < 2; ++k) \
        acc[ai][bj][m][n] = __builtin_amdgcn_mfma_f32_16x16x32_bf16(Bt[n][k], At[m][k], acc[ai][bj][m][n], 0, 0, 0); __builtin_amdgcn_s_setprio(0); } while (0)
#define PG8_WAIT_V(n) asm volatile("s_waitcnt vmcnt(" #n ")" ::: "memory")
#define PG8_WAIT_L(n) asm volatile("s_waitcnt lgkmcnt(" #n ")" ::: "memory")
#define PG8_BAR __builtin_amdgcn_s_barrier()
#define PG8_SCHED __builtin_amdgcn_sched_barrier(0)
    Unit cur, nxt; int ui = 0;
    if (!g.next(0, cur)) return;
    f32x4 acc[2][2][4][2];
#pragma unroll
    for (int a = 0; a < 2; ++a)
#pragma unroll
        for (int b = 0; b < 2; ++b)
#pragma unroll
            for (int m = 0; m < 4; ++m)
#pragma unroll
                for (int n = 0; n < 2; ++n) acc[a][b][m][n] = (f32x4){0.f, 0.f, 0.f, 0.f};
    bf16x8 At[4][2], B0[2][2], B1[2][2];
    const char* cA = g.a_base(cur); const char* cB = g.b_base(cur);
    if constexpr (SP2) {
        PG8_STAGE(PG8_SB(0, 0), cB, voffB); PG8_STAGE(PG8_SB(0, 1), cB + hstepB, voffB); PG8_STAGE(PG8_SA(0, 0), cA, voffA); PG8_STAGE(PG8_SA(0, 1), cA + hstepA, voffA);
        if (wr == 1) PG8_BAR;
        PG8_WAIT_V(2); PG8_BAR;
        PG8_STAGE(PG8_SB(1, 0), cB + kstep, voffB); PG8_STAGE(PG8_SA(1, 0), cA + kstep, voffA); PG8_STAGE(PG8_SB(1, 1), cB + hstepB + kstep, voffB);
        PG8_WAIT_V(6); PG8_BAR;
    } else {
        PG8_STAGE(PG8_SB(0, 0), cB, voffB); PG8_STAGE(PG8_SA(0, 0), cA, voffA); PG8_STAGE(PG8_SB(0, 1), cB + hstepB, voffB); PG8_STAGE(PG8_SA(0, 1), cA + hstepA, voffA);
        if (wr == 1) PG8_BAR;
        PG8_WAIT_V(4); PG8_BAR;
        PG8_STAGE(PG8_SB(1, 0), cB + kstep, voffB); PG8_STAGE(PG8_SA(1, 0), cA + kstep, voffA); PG8_STAGE(PG8_SB(1, 1), cB + hstepB + kstep, voffB);
        PG8_WAIT_V(6); PG8_BAR;
    }
    for (;;) {
        const bool has_next = g.next(ui + 1, nxt);
        const char* nA = has_next ? g.a_base(nxt) : cA; const char* nB = has_next ? g.b_base(nxt) : cB;
#pragma unroll 1
        for (int t = 0; t < nt; t += 2) {
            const bool last = (t == nt - 2);
            const char* a1 = cA + (size_t)(t + 1) * kstep;
            const char* a2 = last ? nA : cA + (size_t)(t + 2) * kstep; const char* b2 = last ? nB : cB + (size_t)(t + 2) * kstep;
            const char* a3 = a2 + kstep; const char* b3 = b2 + kstep;
            if constexpr (SP2) {
            PG8_LDB(B0, 0, 0); PG8_LDB(B1, 0, 1); PG8_SCHED; PG8_LDA(At, 0, 0); PG8_STAGE(PG8_SA(1, 1), a1 + hstepA, voffA);
            PG8_WAIT_V(8); PG8_WAIT_L(0); PG8_BAR; PG8_MMA(0, 0, At, B0); PG8_MMA(0, 1, At, B1); PG8_BAR; PG8_SCHED;
            PG8_LDA(At, 0, 1); PG8_STAGE(PG8_SB(0, 0), b2, voffB); PG8_STAGE(PG8_SB(0, 1), b2 + hstepB, voffB); PG8_STAGE(PG8_SA(0, 0), a2, voffA);
            PG8_WAIT_V(8); PG8_WAIT_L(0); PG8_BAR; PG8_MMA(1, 0, At, B0); PG8_MMA(1, 1, At, B1); PG8_BAR; PG8_SCHED;
            PG8_LDB(B0, 1, 0); PG8_LDB(B1, 1, 1); PG8_SCHED; PG8_LDA(At, 1, 0); PG8_STAGE(PG8_SA(0, 1), a2 + hstepA, voffA);
            PG8_WAIT_V(8); PG8_WAIT_L(0); PG8_BAR; PG8_MMA(0, 0, At, B0); PG8_MMA(0, 1, At, B1); PG8_BAR; PG8_SCHED;
            PG8_LDA(At, 1, 1); PG8_STAGE(PG8_SB(1, 0), b3, voffB); PG8_STAGE(PG8_SB(1, 1), b3 + hstepB, voffB); PG8_STAGE(PG8_SA(1, 0), a3, voffA);
            PG8_WAIT_V(8); PG8_WAIT_L(0); PG8_BAR; PG8_MMA(1, 0, At, B0); PG8_MMA(1, 1, At, B1); PG8_BAR; PG8_SCHED;
            } else {
            PG8_LDB(B0, 0, 0); PG8_SCHED; PG8_LDA(At, 0, 0); PG8_STAGE(PG8_SA(1, 1), a1 + hstepA, voffA);
            PG8_WAIT_L(8); PG8_BAR; PG8_WAIT_L(0); PG8_MMA(0, 0, At, B0); PG8_BAR; PG8_SCHED;
            PG8_LDB(B1, 0, 1); PG8_STAGE(PG8_SB(0, 0), b2, voffB);
            PG8_BAR; PG8_WAIT_L(0); PG8_MMA(0, 1, At, B1); PG8_BAR;
            PG8_LDA(At, 0, 1); PG8_STAGE(PG8_SA(0, 0), a2, voffA);
            PG8_BAR; PG8_WAIT_L(0); PG8_MMA(1, 0, At, B0); PG8_BAR; PG8_SCHED;
            PG8_STAGE(PG8_SB(0, 1), b2 + hstepB, voffB);
            PG8_WAIT_V(6); PG8_BAR; PG8_MMA(1, 1, At, B1); PG8_BAR;
            PG8_LDB(B0, 1, 0); PG8_SCHED; PG8_LDA(At, 1, 0); PG8_STAGE(PG8_SA(0, 1), a2 + hstepA, voffA);
            PG8_WAIT_L(8); PG8_BAR; PG8_WAIT_L(0); PG8_MMA(0, 0, At, B0); PG8_BAR; PG8_SCHED;
            PG8_LDB(B1, 1, 1); PG8_STAGE(PG8_SB(1, 0), b3, voffB);
            PG8_BAR; PG8_WAIT_L(0); PG8_MMA(0, 1, At, B1); PG8_BAR;
            PG8_LDA(At, 1, 1); PG8_STAGE(PG8_SA(1, 0), a3, voffA);
            PG8_BAR; PG8_WAIT_L(0); PG8_MMA(1, 0, At, B0); PG8_BAR; PG8_SCHED;
            PG8_STAGE(PG8_SB(1, 1), b3 + hstepB, voffB);
            PG8_WAIT_V(6); PG8_BAR; PG8_MMA(1, 1, At, B1); PG8_BAR;
            }
        }
        if constexpr (ALIGN_EPI) { if (wr == 0) PG8_BAR; }
        E(acc, cur, wr, wc, fr, fq);
        if (!has_next) break;
#pragma unroll
        for (int a = 0; a < 2; ++a)
#pragma unroll
            for (int b = 0; b < 2; ++b)
#pragma unroll
                for (int m = 0; m < 4; ++m)
#pragma unroll
                    for (int n = 0; n < 2; ++n) acc[a][b][m][n] = (f32x4){0.f, 0.f, 0.f, 0.f};
        cur = nxt; cA = nA; cB = nB; ++ui;
        if constexpr (ALIGN_EPI) { if (wr == 1) PG8_BAR; }
    }
    PG8_WAIT_V(0);
    if constexpr (!ALIGN_EPI) { if (wr == 0) PG8_BAR; }
    PG8_BAR;
#undef PG8_SA
#undef PG8_SB
#undef PG8_STAGE
#undef PG8_LDA
#undef PG8_LDB
#undef PG8_MMA
#undef PG8_WAIT_V
#undef PG8_WAIT_L
#undef PG8_BAR
#undef PG8_SCHED
}

struct EpiBf16 {
    static constexpr bool PERM = true;
    bf16_t* O; long zs; int ldc, pad;
    __device__ __forceinline__ void operator()(const f32x4 (&acc)[2][2][4][2], const Unit& u, int wr, int wc, int fr, int fq) const {
        const int row0 = u.pm * BM + wr * 64 + fr, col0 = u.pn * BM + wc * 32 + 8 * fq; bf16_t* base = O + (long)u.z * zs;
#pragma unroll
        for (int ai = 0; ai < 2; ++ai)
#pragma unroll
            for (int m = 0; m < 4; ++m) { bf16_t* rowp = base + (size_t)(row0 + ai * HALF + m * 16) * ldc + col0;
#pragma unroll
                for (int bj = 0; bj < 2; ++bj) { const f32x4 v0 = acc[ai][bj][m][0], v1 = acc[ai][bj][m][1];
                    u32x4 w; w.x = pk2(v0[0], v0[1]); w.y = pk2(v0[2], v0[3]); w.z = pk2(v1[0], v1[1]); w.w = pk2(v1[2], v1[3]);
                    *(u32x4*)(rowp + bj * HALF) = w; } }
    }
};
struct EpiMem {
    static constexpr bool PERM = false;
    float* outK; float* outV; bf16_t* kb; bf16_t* vt;
    __device__ __forceinline__ void operator()(const f32x4 (&acc)[2][2][4][2], const Unit& u, int wr, int wc, int fr, int fq) const {
        const int row0 = u.pm * BM + wr * 64 + fr, col0 = u.pn * BM + wc * 32 + 4 * fq;
#pragma unroll
        for (int ai = 0; ai < 2; ++ai)
#pragma unroll
            for (int m = 0; m < 4; ++m) { const int row = row0 + ai * HALF + m * 16;
#pragma unroll
                for (int bj = 0; bj < 2; ++bj)
#pragma unroll
                    for (int n = 0; n < 2; ++n) { const int col = col0 + bj * HALF + n * 16; const f32x4 v = acc[ai][bj][m][n];
                        if (col < 1024) { *(f32x4*)(outK + ((size_t)u.z * 512 + row) * 1024 + col) = v;
                            u32x2 w; w.x = pk2(v[0], v[1]); w.y = pk2(v[2], v[3]); *(u32x2*)(kb + ((size_t)u.z * 512 + row) * 1024 + col) = w; }
                        else { const int c = col - 1024; *(f32x4*)(outV + ((size_t)u.z * 512 + row) * 1024 + c) = v;
                            const int b = row >> 8, mm = row & 255, h = c >> 8, d = c & 255; bf16_t* p = vt + ((((size_t)u.z * 2 + b) * 4 + h) * 256 + d) * 256 + mm;
                            p[0] = f2bf(v[0]); p[256] = f2bf(v[1]); p[512] = f2bf(v[2]); p[768] = f2bf(v[3]); } } }
    }
};
struct EpiMerge {
    static constexpr bool PERM = false;
    float* MG; bf16_t* MGB; const bf16_t* U; const float* gate_b;
    __device__ __forceinline__ void operator()(const f32x4 (&acc)[2][2][4][2], const Unit& u, int wr, int wc, int fr, int fq) const {
        const int row0 = u.pm * BM + wr * 64 + fr, col0 = u.pn * BM + wc * 32 + 4 * fq;
#pragma unroll
        for (int ai = 0; ai < 2; ++ai)
#pragma unroll
            for (int m = 0; m < 4; ++m) { const int row = row0 + ai * HALF + m * 16;
#pragma unroll
                for (int bj = 0; bj < 2; ++bj)
#pragma unroll
                    for (int n = 0; n < 2; ++n) { const int col = col0 + bj * HALF + n * 16; const f32x4 v = acc[ai][bj][m][n];
                        const u32x2 gp = *(const u32x2*)(U + (size_t)row * NINP + U_GP + u.z * DM + col); const f32x4 gb = *(const f32x4*)(gate_b + u.z * DM + col);
                        f32x4 gt; gt[0] = sigmoidf_(__uint_as_float(gp.x << 16) + gb[0]); gt[1] = sigmoidf_(__uint_as_float(gp.x & 0xffff0000u) + gb[1]);
                        gt[2] = sigmoidf_(__uint_as_float(gp.y << 16) + gb[2]); gt[3] = sigmoidf_(__uint_as_float(gp.y & 0xffff0000u) + gb[3]);
                        float* mp = MG + (size_t)row * DM + col; f32x4 r = gt * v;
                        if (u.z > 0) r += *(const f32x4*)mp;
                        if (u.z < 3) *(f32x4*)mp = r;
                        else { u32x2 w; w.x = pk2(r[0], r[1]); w.y = pk2(r[2], r[3]); *(u32x2*)(MGB + (size_t)row * DM + col) = w; } } }
    }
};
struct EpiRes {
    static constexpr bool PERM = false;
    const float* R; float* Y;
    __device__ __forceinline__ void operator()(const f32x4 (&acc)[2][2][4][2], const Unit& u, int wr, int wc, int fr, int fq) const {
        const int row0 = u.pm * BM + wr * 64 + fr, col0 = u.pn * BM + wc * 32 + 4 * fq;
#pragma unroll
        for (int ai = 0; ai < 2; ++ai)
#pragma unroll
            for (int m = 0; m < 4; ++m) { const size_t ro = (size_t)(row0 + ai * HALF + m * 16) * DM + col0;
#pragma unroll
                for (int bj = 0; bj < 2; ++bj)
#pragma unroll
                    for (int n = 0; n < 2; ++n) { const size_t o = ro + bj * HALF + n * 16; *(f32x4*)(Y + o) = *(const f32x4*)(R + o) * ALPHA + acc[ai][bj][m][n]; } }
    }
};
struct EpiSwiGLU {
    static constexpr bool PERM = true;
    bf16_t* O;
    __device__ __forceinline__ void operator()(const f32x4 (&acc)[2][2][4][2], const Unit& u, int wr, int wc, int fr, int fq) const {
        const int row0 = u.pm * BM + wr * 64 + fr, col0 = u.pn * HALF + wc * 32 + 8 * fq;
#pragma unroll
        for (int ai = 0; ai < 2; ++ai)
#pragma unroll
            for (int m = 0; m < 4; ++m) { bf16_t* rowp = O + (size_t)(row0 + ai * HALF + m * 16) * DFF + col0;
                float r[8];
#pragma unroll
                for (int n = 0; n < 2; ++n)
#pragma unroll
                    for (int j = 0; j < 4; ++j) { const float gg = acc[ai][0][m][n][j], uu = acc[ai][1][m][n][j]; r[n * 4 + j] = gg * sigmoidf_(gg) * uu; }
                u32x4 w; w.x = pk2(r[0], r[1]); w.y = pk2(r[2], r[3]); w.z = pk2(r[4], r[5]); w.w = pk2(r[6], r[7]);
                *(u32x4*)rowp = w; }
    }
};
struct EpiScore {
    static constexpr bool PERM = false;
    float* SC;
    __device__ __forceinline__ void operator()(const f32x4 (&acc)[2][2][4][2], const Unit& u, int wr, int wc, int fr, int fq) const {
        const int row0 = u.pm * BM + wr * 64 + fr, col0 = wc * 32 + 4 * fq; float* base = SC + (size_t)u.z * 4096 * 256;
#pragma unroll
        for (int ai = 0; ai < 2; ++ai)
#pragma unroll
            for (int m = 0; m < 4; ++m) { float* rowp = base + (size_t)(row0 + ai * HALF + m * 16) * 256 + col0;
#pragma unroll
                for (int bj = 0; bj < 2; ++bj)
#pragma unroll
                    for (int n = 0; n < 2; ++n) *(f32x4*)(rowp + bj * HALF + n * 16) = acc[ai][bj][m][n] * 0.0625f; }
    }
};
struct EpiPV {
    static constexpr bool PERM = true;
    bf16_t* O;
    __device__ __forceinline__ void operator()(const f32x4 (&acc)[2][2][4][2], const Unit& u, int wr, int wc, int fr, int fq) const {
        const int b = u.z >> 2, h = u.z & 3; const int row0 = b * PS + u.pm * BM + wr * 64 + fr, col0 = h * 256 + wc * 32 + 8 * fq;
#pragma unroll
        for (int ai = 0; ai < 2; ++ai)
#pragma unroll
            for (int m = 0; m < 4; ++m) { bf16_t* rowp = O + (size_t)(row0 + ai * HALF + m * 16) * BW + col0;
#pragma unroll
                for (int bj = 0; bj < 2; ++bj) { const f32x4 v0 = acc[ai][bj][m][0], v1 = acc[ai][bj][m][1];
                    u32x4 w; w.x = pk2(v0[0], v0[1]); w.y = pk2(v0[2], v0[3]); w.z = pk2(v1[0], v1[1]); w.w = pk2(v1[2], v1[3]);
                    *(u32x4*)(rowp + bj * HALF) = w; } }
    }
};
}


#define XB_TMO      128
#define XB_XCNT(j)  (256  + 64 * (j))
#define XB_XSUB(j)  (1280 + 64 * (j))
#define XB_XGEN(j)  (2304 + 64 * (j))
#define XB_TOP      3328
#define XB_TOPGEN   3392
#define XCD_BAR_WORDS 3456
#define XB_SPIN_CAP (1u << 18)
__device__ __forceinline__ unsigned xb_ld(unsigned* p)              { return __hip_atomic_load(p, __ATOMIC_RELAXED, __HIP_MEMORY_SCOPE_AGENT); }
__device__ __forceinline__ unsigned xb_add(unsigned* p, unsigned v) { return __hip_atomic_fetch_add(p, v, __ATOMIC_RELAXED, __HIP_MEMORY_SCOPE_AGENT); }
__device__ __forceinline__ unsigned xb_xcc_id() { return (unsigned)__builtin_amdgcn_s_getreg((3 << 11) | 20) & 0xFu; }
#define XB_SPIN(cond, bar) do { unsigned _sp = 0; while (cond) { __builtin_amdgcn_s_sleep(1); \
    if ((++_sp & 255u) == 0u) { if (xb_ld(&(bar)[XB_TMO])) break; if (_sp > XB_SPIN_CAP) { atomicAdd(&(bar)[XB_TMO], 1u); break; } } } } while (0)
struct XcdBarrier { unsigned* bar; unsigned x; volatile LAS unsigned* st; };
__device__ __forceinline__ XcdBarrier xcd_barrier_post(unsigned* bar, volatile LAS unsigned* st) {
    XcdBarrier b; b.bar = bar; b.x = xb_xcc_id(); b.st = st;
    if (threadIdx.x == 0) (void)xb_add(&bar[XB_XCNT(b.x)], 1u);
    return b;
}
__device__ __forceinline__ void xcd_barrier_complete(unsigned* bar, unsigned x, unsigned& nloc, unsigned& nx) {
    const unsigned G = gridDim.x * gridDim.y * gridDim.z;
    unsigned sum, cnt, mine, sp = 0u;
    for (;;) {
        sum = 0u; cnt = 0u; mine = 0u;
#pragma unroll
        for (unsigned j = 0; j < 16; ++j) { const unsigned c = xb_ld(&bar[XB_XCNT(j)]); sum += c; cnt += (c > 0u) ? 1u : 0u; mine = (j == x) ? c : mine; }
        if (sum == G) break;
        __builtin_amdgcn_s_sleep(1);
        if ((++sp & 255u) == 0u) { if (xb_ld(&bar[XB_TMO])) break; if (sp > XB_SPIN_CAP) { atomicAdd(&bar[XB_TMO], 1u); break; } }
    }
    nloc = mine > 0u ? mine : 1u; nx = cnt > 0u ? cnt : 1u;
}
__device__ __forceinline__ void xcd_barrier(const XcdBarrier& b) {
    asm volatile("s_waitcnt vmcnt(0)" ::: "memory");
    __syncthreads();
    if (threadIdx.x == 0) {
        unsigned* bar = b.bar;
        __builtin_amdgcn_s_waitcnt(0);
        unsigned nloc = b.st[0], nx = b.st[1];
        if (nloc == 0u) { xcd_barrier_complete(bar, b.x, nloc, nx); b.st[0] = nloc; b.st[1] = nx; }
        const unsigned old = xb_add(&bar[XB_XSUB(b.x)], 1u);
        const unsigned gen = old / nloc;
        if (old + 1u == (gen + 1u) * nloc) {
            __builtin_amdgcn_fence(__ATOMIC_RELEASE, "agent");
            asm volatile("s_waitcnt vmcnt(0)" ::: "memory");
            const unsigned og = xb_add(&bar[XB_TOP], 1u);
            const unsigned tg = og / nx;
            if (og + 1u == (tg + 1u) * nx) xb_add(&bar[XB_TOPGEN], 1u);
            else XB_SPIN(xb_ld(&bar[XB_TOPGEN]) == tg, bar);
            __builtin_amdgcn_fence(__ATOMIC_ACQUIRE, "agent");
            xb_add(&bar[XB_XGEN(b.x)], 1u);
            asm volatile("s_waitcnt vmcnt(0)" ::: "memory");
        } else {
            XB_SPIN(xb_ld(&bar[XB_XGEN(b.x)]) == gen, bar);
            __builtin_amdgcn_fence(__ATOMIC_ACQUIRE, "agent");
            asm volatile("s_waitcnt vmcnt(0)" ::: "memory");
        }
    }
    __syncthreads();
}

struct Ctx { int tid, lane, wave, bid, G; LAS unsigned char* lds; };
__device__ __forceinline__ Ctx fresh(const Ctx& c0) { Ctx c; c.wave = c0.wave; c.bid = c0.bid; c.G = c0.G; c.lds = c0.lds; asm volatile("" : "+s"(c.bid), "+s"(c.G), "+s"(c.wave));
    int lane = (int)__builtin_amdgcn_mbcnt_hi(~0u, __builtin_amdgcn_mbcnt_lo(~0u, 0u)); asm volatile("" : "+v"(lane)); c.lane = lane; c.tid = c.wave * 64 + lane; return c; }

__device__ __forceinline__ int colmap(int mode, int n) {
    if (mode == 1) return n < 3088 ? n : (n < 3328 ? -1 : n - 240);
    if (mode == 2) { const int t = n >> 8, j = n & 255; return j < 128 ? t * 128 + j : DFF + t * 128 + (j - 128); }
    return n;
}
__device__ __forceinline__ void wprep_load(f32x4 (&rg)[8], const float* __restrict__ src, int K, int Nsrc, int Ndst, int mode, size_t sbs, int item, int tid) {
    const int nx = Ndst / 256, ny = K / 64; const int bx = item % nx, by = (item / nx) % ny, bz = item / (nx * ny);
    const int tx = tid & 63, ty = tid >> 6, cm = colmap(mode, bx * 256 + tx * 4); const float* s = src + (size_t)bz * sbs + (size_t)(by * 64 + ty) * Nsrc + cm;
#pragma unroll
    for (int i = 0; i < 8; ++i) rg[i] = cm >= 0 ? *(const f32x4*)(s + (size_t)(8 * i) * Nsrc) : (f32x4){0.f, 0.f, 0.f, 0.f};
}
__device__ __forceinline__ void ph_wprep(const Ctx& c, const float* __restrict__ src, bf16_t* __restrict__ dst, int K, int Nsrc, int Ndst, int mode, int nbatch, size_t sbs, size_t dbs) {
    LAS float* tile = (LAS float*)c.lds;
    const int nx = Ndst / 256, ny = K / 64, total = nx * ny * nbatch;
    const int tid = c.tid, tx = tid & 63, ty = tid >> 6, n = tid >> 1, kh = tid & 1;
    f32x4 rg[8];
    int item = c.bid;
    if (item < total) wprep_load(rg, src, K, Nsrc, Ndst, mode, sbs, item, tid);
    for (; item < total; item += c.G) {
        __syncthreads();
#pragma unroll
        for (int i = 0; i < 8; ++i) *(LAS f32x4*)(tile + (ty + 8 * i) * 260 + tx * 4) = rg[i];
        __syncthreads();
        const int bx = item % nx, by = (item / nx) % ny, bz = item / (nx * ny);
        if (item + c.G < total) wprep_load(rg, src, K, Nsrc, Ndst, mode, sbs, item + c.G, tid);
        bf16_t* d = dst + (size_t)bz * dbs + (size_t)(bx * 256 + n) * K + by * 64 + kh * 32;
#pragma unroll
        for (int g = 0; g < 4; ++g) { unsigned p[4];
#pragma unroll
            for (int e = 0; e < 4; ++e) p[e] = pk2(tile[(kh * 32 + g * 8 + 2 * e) * 260 + n], tile[(kh * 32 + g * 8 + 2 * e + 1) * 260 + n]);
            *(u32x4*)(d + g * 8) = (u32x4){p[0], p[1], p[2], p[3]}; }
    }
    __syncthreads();
}
__device__ __forceinline__ void ph_xprep(const Ctx& c, const float* __restrict__ xp, const float* __restrict__ xs, const float* __restrict__ mem, float* __restrict__ HF, bf16_t* __restrict__ HB, bf16_t* __restrict__ MEMB) {
    const size_t nH = (size_t)MPAD * DM / 4, nM = (size_t)512 * DM / 4;
    for (size_t i4 = (size_t)c.bid * 512 + c.tid; i4 < nH + nM; i4 += (size_t)c.G * 512) {
        if (i4 < nH) {
            const size_t e = i4 * 4; f32x4 v = (f32x4){0.f, 0.f, 0.f, 0.f};
            if (e < (size_t)MP * DM) v = *(const f32x4*)(xp + e); else if (e < (size_t)MT * DM) v = *(const f32x4*)(xs + (e - (size_t)MP * DM));
            *(f32x4*)(HF + e) = v; u32x2 w; w.x = pk2(v[0], v[1]); w.y = pk2(v[2], v[3]); *(u32x2*)(HB + e) = w;
        } else {
            const size_t e = (i4 - nH) * 4; const f32x4 v = *(const f32x4*)(mem + e); u32x2 w; w.x = pk2(v[0], v[1]); w.y = pk2(v[2], v[3]); *(u32x2*)(MEMB + e) = w;
        }
    }
}
__device__ __forceinline__ void ph_ln(const Ctx& c, const float* __restrict__ Y, const float* __restrict__ g, const float* __restrict__ b, float* __restrict__ XF, bf16_t* __restrict__ XB, float* __restrict__ OUT, int nrows, int nout) {
    const int lane = c.lane;
    for (int row = c.bid * 8 + c.wave; row < nrows; row += c.G * 8) {
        const float* y = Y + (size_t)row * DM; f32x4 v[8]; float s = 0.f;
#pragma unroll
        for (int j = 0; j < 8; ++j) { v[j] = *(const f32x4*)(y + j * 256 + lane * 4); s += (v[j][0] + v[j][1]) + (v[j][2] + v[j][3]); }
        const float mean = wave_sum(s) * (1.0f / DM); float q = 0.f;
#pragma unroll
        for (int j = 0; j < 8; ++j) { const f32x4 d = v[j] - mean; q += (d[0] * d[0] + d[1] * d[1]) + (d[2] * d[2] + d[3] * d[3]); }
        const float rstd = rsqrtf(wave_sum(q) * (1.0f / DM) + 1e-5f);
#pragma unroll
        for (int j = 0; j < 8; ++j) { const int cc = j * 256 + lane * 4; const f32x4 gg = *(const f32x4*)(g + cc), bb = *(const f32x4*)(b + cc);
            const f32x4 o = (v[j] - mean) * rstd * gg + bb; const size_t off = (size_t)row * DM + cc;
            *(f32x4*)(XF + off) = o; u32x2 w; w.x = pk2(o[0], o[1]); w.y = pk2(o[2], o[3]); *(u32x2*)(XB + off) = w;
            if (OUT != nullptr && row < nout) *(f32x4*)(OUT + off) = o; }
    }
}
__device__ __forceinline__ void ph_softmax256(const Ctx& c, const float* __restrict__ SC, bf16_t* __restrict__ P, int nrows) {
    const int lane = c.lane;
    for (int row = c.bid * 8 + c.wave; row < nrows; row += c.G * 8) {
        const f32x4 v = *(const f32x4*)(SC + (size_t)row * 256 + lane * 4);
        const float mx = wave_max(fmaxf(fmaxf(v[0], v[1]), fmaxf(v[2], v[3])));
        f32x4 e; e[0] = __expf(v[0] - mx); e[1] = __expf(v[1] - mx); e[2] = __expf(v[2] - mx); e[3] = __expf(v[3] - mx);
        const float inv = 1.0f / wave_sum((e[0] + e[1]) + (e[2] + e[3]));
        u32x2 w; w.x = pk2(e[0] * inv, e[1] * inv); w.y = pk2(e[2] * inv, e[3] * inv); *(u32x2*)(P + (size_t)row * 256 + lane * 4) = w;
    }
}
__device__ __forceinline__ void ph_copy_outs(const Ctx& c, const bf16_t* __restrict__ U, const float* __restrict__ ck, const float* __restrict__ cv, float* __restrict__ out, int layer) {
    constexpr int nA = PB * 128 * 128, nB = SB * 128 * 128, nC = PB * RWC, nD = SB * RWC;
    for (int i = c.bid * 512 + c.tid; i < nA + nB + nC + nD; i += c.G * 512) {
        if (i < nA) { const int b = i / 16384, j = (i >> 7) & 127, cc = i & 127; const size_t ur = (size_t)(b * PS + PS - 128 + j) * NINP;
            out[O_SWKP + (size_t)layer * nA + i] = bf2f(U[ur + U_SK + cc]); out[O_SWVP + (size_t)layer * nA + i] = bf2f(U[ur + U_SV + cc]); continue; }
        int k = i - nA;
        if (k < nB) { const int sq = k / 16384, j = (k >> 7) & 127, cc = k & 127; float kv, vv;
            if (j < 124) { const size_t o = ((size_t)sq * 128 + j + 4) * 128 + cc; kv = ck[o]; vv = cv[o]; }
            else { const size_t ur = (size_t)(MP + sq * SS + j - 124) * NINP; kv = bf2f(U[ur + U_SK + cc]); vv = bf2f(U[ur + U_SV + cc]); }
            out[O_SWKS + (size_t)layer * nB + k] = kv; out[O_SWVS + (size_t)layer * nB + k] = vv; continue; }
        k -= nB;
        if (k < nC) { const int b = k / RWC, cc = k - b * RWC; out[O_RSP + (size_t)layer * nC + k] = bf2f(U[(size_t)(b * PS + PS - 1) * NINP + U_RU + cc]); continue; }
        k -= nC;
        { const int sq = k / RWC, cc = k - sq * RWC; out[O_RSS + (size_t)layer * nD + k] = bf2f(U[(size_t)(MP + sq * SS + SS - 1) * NINP + U_RU + cc]); }
    }
}

__device__ __forceinline__ void seq_info(int sq, int& row0, int& L) { if (sq < PB) { row0 = sq * PS; L = PS; } else { row0 = MP + (sq - PB) * SS; L = SS; } }

__device__ __forceinline__ void ph_gla_naive(const Ctx& c, const bf16_t* __restrict__ U, const float* __restrict__ s0, const float* __restrict__ a_up, const float* __restrict__ a_b,
                                             const float* __restrict__ ng, const float* __restrict__ nb, bf16_t* __restrict__ OB, float* __restrict__ outP, float* __restrict__ outS) {
    LAS float* qs = (LAS float*)c.lds;
    LAS float* ks = qs + 16 * 128; LAS float* as = ks + 16 * 128; LAS float* os = as + 16 * 128;
    const int kh = c.tid >> 8, vt = c.tid & 255, lane = c.lane;
    for (int u = c.bid; u < (PB + SB) * 4; u += c.G) {
        const int sq = u >> 2, h = u & 3;
        int row0, L; seq_info(sq, row0, L);
        float S[64];
        if (sq >= PB) { const float* p = s0 + (((size_t)(sq - PB) * 4 + h) * 128 + kh * 64) * 256 + vt;
#pragma unroll
            for (int kk = 0; kk < 64; ++kk) S[kk] = p[(size_t)kk * 256]; }
        else {
#pragma unroll
            for (int kk = 0; kk < 64; ++kk) S[kk] = 0.f; }
        for (int t0 = 0; t0 < L; t0 += 16) {
            const int nT = (L - t0) < 16 ? (L - t0) : 16;
            for (int idx = c.tid; idx < nT * 128; idx += 512) {
                const int tt = idx >> 7, kk = idx & 127; const bf16_t* ur = U + (size_t)(row0 + t0 + tt) * NINP;
                qs[idx] = bf2f(ur[U_GQ + h * 128 + kk]) * 0.08838834764831845f; ks[idx] = bf2f(ur[U_GK + h * 128 + kk]);
                float x = a_b[h * 128 + kk];
#pragma unroll
                for (int r = 0; r < 16; ++r) x += bf2f(ur[U_GA + r]) * a_up[r * 512 + h * 128 + kk];
                const float ls = (fminf(x, 0.f) - log1pf(__expf(-fabsf(x)))) * (1.0f / 16.0f);
                as[idx] = __expf(ls);
            }
            __syncthreads();
            for (int tt = 0; tt < nT; ++tt) {
                const float v = bf2f(U[(size_t)(row0 + t0 + tt) * NINP + U_GV + h * 256 + vt]); float o = 0.f; const int lb = tt * 128 + kh * 64;
#pragma unroll
                for (int kk = 0; kk < 64; ++kk) { S[kk] = as[lb + kk] * S[kk] + ks[lb + kk] * v; o += qs[lb + kk] * S[kk]; }
                os[(kh * 16 + tt) * 256 + vt] = o;
            }
            __syncthreads();
            for (int tt = c.wave; tt < nT; tt += 8) {
                float x[4]; float s = 0.f;
#pragma unroll
                for (int j = 0; j < 4; ++j) { x[j] = os[tt * 256 + lane + 64 * j] + os[(16 + tt) * 256 + lane + 64 * j]; s += x[j]; }
                const float mean = wave_sum(s) * (1.0f / 256.0f); float q = 0.f;
#pragma unroll
                for (int j = 0; j < 4; ++j) { const float d = x[j] - mean; q += d * d; }
                const float rstd = rsqrtf(wave_sum(q) * (1.0f / 256.0f) + 1e-5f);
                const size_t row = (size_t)(row0 + t0 + tt);
#pragma unroll
                for (int j = 0; j < 4; ++j) { const int cc = h * 256 + lane + 64 * j; const float n = (x[j] - mean) * rstd * ng[cc] + nb[cc];
                    const float gr = bf2f(U[row * NINP + U_GR + cc]); OB[row * BW + cc] = f2bf(n * gr * sigmoidf_(gr)); }
            }
            __syncthreads();
        }
        float* op = (sq < PB ? outP + (((size_t)sq * 4 + h) * 128 + kh * 64) * 256 : outS + (((size_t)(sq - PB) * 4 + h) * 128 + kh * 64) * 256) + vt;
#pragma unroll
        for (int kk = 0; kk < 64; ++kk) op[(size_t)kk * 256] = S[kk];
    }
}

__device__ __forceinline__ f32x4 mma16(bf16x8 x, bf16x8 y, f32x4 c) { return __builtin_amdgcn_mfma_f32_16x16x32_bf16(x, y, c, 0, 0, 0); }
__device__ __forceinline__ bf16x8 pack_acc(const f32x4& a, const f32x4& b) {
    u32x4 p; p.x = pk2(a[0], a[1]); p.y = pk2(a[2], a[3]); p.z = pk2(b[0], b[1]); p.w = pk2(b[2], b[3]); return __builtin_bit_cast(bf16x8, p);
}
__device__ __forceinline__ void gla_chunk_info(int u, int& row0, int& ntok, int& h) {
    if (u < 512) { const int b = u >> 8; h = (u >> 6) & 3; row0 = b * PS + (u & 63) * 64; ntok = 64; }
    else { const int s = u - 512; h = s & 3; row0 = MP + (s >> 2) * SS; ntok = SS; }
}
__device__ __forceinline__ void ph_gla_pre(const Ctx& c, const bf16_t* __restrict__ U, const float* __restrict__ a_up, const float* __restrict__ a_b,
                                           bf16_t* __restrict__ QD, bf16_t* __restrict__ KHT, bf16_t* __restrict__ EE, bf16_t* __restrict__ VT, float* __restrict__ GC) {
    LAS float* ga_l = (LAS float*)c.lds;
    LAS float* tot = ga_l + 64 * 16;
    LAS bf16_t* Qd_l = (LAS bf16_t*)(tot + 4 * 128);
    LAS bf16_t* Kn_l = Qd_l + 64 * 136;
    LAS bf16_t* v_l = Kn_l + 64 * 136;
    LAS bf16_t* qr_l = v_l + 64 * 264;
    LAS bf16_t* kr_l = qr_l + 64 * 136;
    const int tid = c.tid, lane = c.lane, r = lane & 15, q = lane >> 4, w = c.wave;
    for (int u = (c.bid + c.G / 2) % c.G; u < GL_NCH; u += c.G) {
        int row0, ntok, h; gla_chunk_info(u, row0, ntok, h);
        for (int i = tid; i < 64 * 16; i += 512) { const int t = i >> 4, rr = i & 15; ga_l[i] = t < ntok ? bf2f(U[(size_t)(row0 + t) * NINP + U_GA + rr]) : 0.f; }
        for (int i = tid; i < 64 * 32; i += 512) { const int t = i >> 5, c8 = i & 31; u32x4 vv = (u32x4){0u, 0u, 0u, 0u};
            if (t < ntok) vv = *(const u32x4*)(U + (size_t)(row0 + t) * NINP + U_GV + h * 256 + c8 * 8);
            *(LAS u32x4*)(v_l + t * 264 + c8 * 8) = vv; }
        for (int i = tid; i < 64 * 16; i += 512) { const int t = i >> 4, c8 = i & 15; u32x4 qv = (u32x4){0u, 0u, 0u, 0u}, kv = qv;
            if (t < ntok) { const bf16_t* ur = U + (size_t)(row0 + t) * NINP + h * 128 + c8 * 8; qv = *(const u32x4*)(ur + U_GQ); kv = *(const u32x4*)(ur + U_GK); }
            *(LAS u32x4*)(qr_l + t * 136 + c8 * 8) = qv; *(LAS u32x4*)(kr_l + t * 136 + c8 * 8) = kv; }
        __syncthreads();
        const int kk = tid & 127, tq = tid >> 7;
        float cum[16];
        { float aup[16];
#pragma unroll
          for (int rr = 0; rr < 16; ++rr) aup[rr] = a_up[rr * 512 + h * 128 + kk];
          const float ab = a_b[h * 128 + kk]; float run = 0.f;
#pragma unroll
          for (int j = 0; j < 16; ++j) { const int t = tq * 16 + j; float x = ab;
#pragma unroll
              for (int rr = 0; rr < 16; ++rr) x += ga_l[t * 16 + rr] * aup[rr];
              const float la = t < ntok ? (fminf(x, 0.f) - __logf(1.0f + __expf(-fabsf(x)))) * (1.0f / 16.0f) : 0.f;
              run += la; cum[j] = run; }
          tot[tq * 128 + kk] = run; }
        __syncthreads();
        { float prefix = 0.f, bC = 0.f;
#pragma unroll
          for (int g = 0; g < 4; ++g) { const float tv = tot[g * 128 + kk]; bC += tv; if (g < tq) prefix += tv; }
          unsigned khp[8];
#pragma unroll
          for (int j = 0; j < 16; j += 2) { float kh2[2];
#pragma unroll
              for (int e = 0; e < 2; ++e) { const int t = tq * 16 + j + e; const float b = prefix + cum[j + e]; const float qv = bf2f(qr_l[t * 136 + kk]), kv = bf2f(kr_l[t * 136 + kk]);
                  Qd_l[t * 136 + kk] = f2bf(qv * __expf(b) * 0.08838834764831845f); Kn_l[t * 136 + kk] = f2bf(kv * __expf(-b)); kh2[e] = kv * __expf(bC - b); }
              khp[j >> 1] = pk2(kh2[0], kh2[1]); }
          bf16_t* kp = KHT + (size_t)u * 8192 + kk * 64 + tq * 16;
          *(u32x4*)kp = (u32x4){khp[0], khp[1], khp[2], khp[3]}; *(u32x4*)(kp + 8) = (u32x4){khp[4], khp[5], khp[6], khp[7]};
          if (tq == 0) GC[(size_t)u * 128 + kk] = __expf(bC); }
        __syncthreads();
        { const int tb = w >> 1;
#pragma unroll
          for (int e = 0; e < 2; ++e) { const int ib = (w & 1) * 2 + e; f32x4 d = (f32x4){0.f, 0.f, 0.f, 0.f};
              if (ib <= tb) {
                  bf16x8 kf4[4], qf4[4];
#pragma unroll
                  for (int ks = 0; ks < 4; ++ks) { kf4[ks] = *(const LAS bf16x8*)(Kn_l + (ib * 16 + r) * 136 + ks * 32 + q * 8); qf4[ks] = *(const LAS bf16x8*)(Qd_l + (tb * 16 + r) * 136 + ks * 32 + q * 8); }
                  __builtin_amdgcn_sched_barrier(0);
#pragma unroll
                  for (int ks = 0; ks < 4; ++ks) d = mma16(kf4[ks], qf4[ks], d); }
              const int t = tb * 16 + r, i0 = ib * 16 + q * 4;
#pragma unroll
              for (int jj = 0; jj < 4; ++jj) if (i0 + jj > t) d[jj] = 0.f;
              u32x2 o; o.x = pk2(d[0], d[1]); o.y = pk2(d[2], d[3]); *(u32x2*)(EE + (size_t)u * 4096 + t * 64 + i0) = o; } }
        for (int i = tid; i < 64 * 16; i += 512) { const int t = i >> 4, c8 = i & 15; *(u32x4*)(QD + (size_t)u * 8192 + t * 128 + c8 * 8) = *(const LAS u32x4*)(Qd_l + t * 136 + c8 * 8); }
        { const int val = tid & 255, th = tid >> 8;
#pragma unroll
          for (int tg = 0; tg < 4; ++tg) { const int t0 = th * 32 + tg * 8; unsigned p4[4];
#pragma unroll
              for (int e = 0; e < 4; ++e) p4[e] = (unsigned)v_l[(t0 + 2 * e) * 264 + val] | ((unsigned)v_l[(t0 + 2 * e + 1) * 264 + val] << 16);
              *(u32x4*)(VT + (size_t)u * 16384 + val * 64 + t0) = (u32x4){p4[0], p4[1], p4[2], p4[3]}; } }
        __syncthreads();
    }
}
struct GlaStage { u32x4 qd[2], kh[2], e, vt, gc; };
__device__ __forceinline__ void gla_stage_load(GlaStage& s, const bf16_t* __restrict__ QD, const bf16_t* __restrict__ KHT, const bf16_t* __restrict__ EE, const bf16_t* __restrict__ VT, const float* __restrict__ GC,
                                               int ch, int sl, int tid) {
    const bf16_t* qp = QD + (size_t)ch * 8192 + tid * 8; s.qd[0] = *(const u32x4*)qp; s.qd[1] = *(const u32x4*)(qp + 4096);
    const bf16_t* kp = KHT + (size_t)ch * 8192 + tid * 8; s.kh[0] = *(const u32x4*)kp; s.kh[1] = *(const u32x4*)(kp + 4096);
    s.e = *(const u32x4*)(EE + (size_t)ch * 4096 + tid * 8);
    s.vt = *(const u32x4*)(VT + (size_t)ch * 16384 + sl * 4096 + tid * 8);
    if (tid < 32) s.gc = *(const u32x4*)(GC + (size_t)ch * 128 + tid * 4);
}
constexpr int GS_KH = 8704, GS_E = 17920, GS_VT = 22528, GS_GC = 27136, GS_EL = 27392;
__device__ __forceinline__ void gla_stage_store(const GlaStage& s, LAS bf16_t* b, int tid) {
    *(LAS u32x4*)(b + (tid >> 4) * 136 + (tid & 15) * 8) = s.qd[0]; *(LAS u32x4*)(b + (32 + (tid >> 4)) * 136 + (tid & 15) * 8) = s.qd[1];
    *(LAS u32x4*)(b + GS_KH + (tid >> 3) * 72 + (tid & 7) * 8) = s.kh[0]; *(LAS u32x4*)(b + GS_KH + (64 + (tid >> 3)) * 72 + (tid & 7) * 8) = s.kh[1];
    *(LAS u32x4*)(b + GS_E + (tid >> 3) * 72 + (tid & 7) * 8) = s.e; *(LAS u32x4*)(b + GS_VT + (tid >> 3) * 72 + (tid & 7) * 8) = s.vt;
    if (tid < 32) *(LAS u32x4*)(b + GS_GC + tid * 8) = s.gc;
}
__device__ __forceinline__ void ph_gla_seq(const Ctx& c, int boff, const bf16_t* __restrict__ QD, const bf16_t* __restrict__ KHT, const bf16_t* __restrict__ EE, const bf16_t* __restrict__ VT, const float* __restrict__ GC,
                                           const float* __restrict__ s0, float* __restrict__ outP, float* __restrict__ outS, bf16_t* __restrict__ OB) {
    LAS bf16_t* stg = (LAS bf16_t*)c.lds;
    LAS bf16_t* T_l = stg + 2 * GS_EL;
    const int tid = c.tid, lane = c.lane, r = lane & 15, q = lane >> 4, w = c.wave;
    const int side = c.bid < 32 ? c.bid : c.bid - 64, nside = c.G - 64;
    for (int u = (c.bid >= boff && c.bid < boff + 32) ? c.bid - boff : ((c.bid < 32 || c.bid >= 96) ? 32 + side : 32 + 512); u < 32 + 512; u = u < 32 ? 32 + 512 : u + nside) {
        int h, sl, nch, ch0, row0, ntok; const float* sp = nullptr; float* op;
        if (u < 32) { const int b = u >> 4; h = (u >> 2) & 3; sl = u & 3; nch = 64; ch0 = (b * 4 + h) * 64; row0 = b * PS; ntok = 64; op = outP + (size_t)(b * 4 + h) * 32768; }
        else { const int s = u - 32, sq = s >> 4; h = (s >> 2) & 3; sl = s & 3; nch = 1; ch0 = 512 + sq * 4 + h; row0 = MP + sq * SS; ntok = SS; sp = s0 + (size_t)(sq * 4 + h) * 32768; op = outS + (size_t)(sq * 4 + h) * 32768; }
        f32x4 acc[4];
#pragma unroll
        for (int vb = 0; vb < 4; ++vb)
#pragma unroll
            for (int jj = 0; jj < 4; ++jj) acc[vb][jj] = sp ? sp[(size_t)(w * 16 + q * 4 + jj) * 256 + sl * 64 + vb * 16 + r] : 0.f;
        GlaStage R0, R1, R2;
        gla_stage_load(R0, QD, KHT, EE, VT, GC, ch0, sl, tid);
        if (1 < nch) gla_stage_load(R1, QD, KHT, EE, VT, GC, ch0 + 1, sl, tid);
        if (2 < nch) gla_stage_load(R2, QD, KHT, EE, VT, GC, ch0 + 2, sl, tid);
        __syncthreads();
        gla_stage_store(R0, stg, tid);
        if (3 < nch) gla_stage_load(R0, QD, KHT, EE, VT, GC, ch0 + 3, sl, tid);
#define GLA_STEP(ci, RN) do { \
            LAS bf16_t* Tb = T_l + ((ci) & 1) * 64 * 136; const LAS bf16_t* sb = stg + ((ci) & 1) * GS_EL; \
            _Pragma("unroll") for (int vb = 0; vb < 4; ++vb) { u32x2 o; o.x = pk2(acc[vb][0], acc[vb][1]); o.y = pk2(acc[vb][2], acc[vb][3]); *(LAS u32x2*)(Tb + (vb * 16 + r) * 136 + w * 16 + q * 4) = o; } \
            __syncthreads(); \
            if ((ci) + 1 < nch) { gla_stage_store(RN, stg + (((ci) + 1) & 1) * GS_EL, tid); if ((ci) + 4 < nch) gla_stage_load(RN, QD, KHT, EE, VT, GC, ch0 + (ci) + 4, sl, tid); } \
            { const int rb = w >> 1, t = rb * 16 + r; bf16x8 qf[4], ef[2]; \
              _Pragma("unroll") for (int ks = 0; ks < 4; ++ks) qf[ks] = *(const LAS bf16x8*)(sb + (rb * 16 + r) * 136 + ks * 32 + q * 8); \
              _Pragma("unroll") for (int ks = 0; ks < 2; ++ks) ef[ks] = *(const LAS bf16x8*)(sb + GS_E + (rb * 16 + r) * 72 + ks * 32 + q * 8); \
              bf16x8 tf[2][4], vf[2][2]; \
              _Pragma("unroll") for (int e2 = 0; e2 < 2; ++e2) { const int cb = (w & 1) * 2 + e2; \
                  _Pragma("unroll") for (int ks = 0; ks < 4; ++ks) tf[e2][ks] = *(const LAS bf16x8*)(Tb + (cb * 16 + r) * 136 + ks * 32 + q * 8); \
                  _Pragma("unroll") for (int ks = 0; ks < 2; ++ks) vf[e2][ks] = *(const LAS bf16x8*)(sb + GS_VT + (cb * 16 + r) * 72 + ks * 32 + q * 8); } \
              __builtin_amdgcn_sched_barrier(0); \
              _Pragma("unroll") for (int e2 = 0; e2 < 2; ++e2) { const int cb = (w & 1) * 2 + e2; f32x4 y = (f32x4){0.f, 0.f, 0.f, 0.f}; \
                  _Pragma("unroll") for (int ks = 0; ks < 4; ++ks) y = mma16(tf[e2][ks], qf[ks], y); \
                  _Pragma("unroll") for (int ks = 0; ks < 2; ++ks) y = mma16(vf[e2][ks], ef[ks], y); \
                  if (t < ntok) { u32x2 o; o.x = pk2(y[0], y[1]); o.y = pk2(y[2], y[3]); *(u32x2*)(OB + (size_t)(row0 + (ci) * 64 + t) * BW + h * 256 + sl * 64 + cb * 16 + q * 4) = o; } } } \
            { const f32x4 gcv = *(const LAS f32x4*)((const LAS float*)(sb + GS_GC) + w * 16 + q * 4); bf16x8 kf[2]; \
              _Pragma("unroll") for (int ks = 0; ks < 2; ++ks) kf[ks] = *(const LAS bf16x8*)(sb + GS_KH + (w * 16 + r) * 72 + ks * 32 + q * 8); \
              bf16x8 vs[4][2]; \
              _Pragma("unroll") for (int vb = 0; vb < 4; ++vb) _Pragma("unroll") for (int ks = 0; ks < 2; ++ks) vs[vb][ks] = *(const LAS bf16x8*)(sb + GS_VT + (vb * 16 + r) * 72 + ks * 32 + q * 8); \
              __builtin_amdgcn_sched_barrier(0); \
              _Pragma("unroll") for (int vb = 0; vb < 4; ++vb) { acc[vb] = acc[vb] * gcv; \
                  _Pragma("unroll") for (int ks = 0; ks < 2; ++ks) acc[vb] = mma16(kf[ks], vs[vb][ks], acc[vb]); } } \
        } while (0)
#pragma unroll 1
        for (int ci = 0; ci < nch; ci += 3) {
            GLA_STEP(ci, R1);
            if (ci + 1 < nch) GLA_STEP(ci + 1, R2);
            if (ci + 2 < nch) GLA_STEP(ci + 2, R0);
        }
#undef GLA_STEP
#pragma unroll
        for (int vb = 0; vb < 4; ++vb)
#pragma unroll
            for (int jj = 0; jj < 4; ++jj) op[(size_t)(w * 16 + q * 4 + jj) * 256 + sl * 64 + vb * 16 + r] = acc[vb][jj];
        __syncthreads();
    }
}
__device__ __forceinline__ void ph_gla_fin(const Ctx& c, const bf16_t* __restrict__ U, const float* __restrict__ ng, const float* __restrict__ nb, const bf16_t* __restrict__ RAW, bf16_t* __restrict__ OB) {
    const int lane = c.lane;
    for (int i = c.bid * 8 + c.wave; i < MT * 4; i += c.G * 8) {
        const int row = i >> 2, h = i & 3, cc = h * 256 + lane * 4; bf16_t* p = OB + (size_t)row * BW + cc;
        const u32x2 raw = *(const u32x2*)(RAW + (size_t)row * BW + cc); float x[4] = {__uint_as_float(raw.x << 16), __uint_as_float(raw.x & 0xffff0000u), __uint_as_float(raw.y << 16), __uint_as_float(raw.y & 0xffff0000u)};
        const float mean = wave_sum((x[0] + x[1]) + (x[2] + x[3])) * (1.0f / 256.0f); float qq = 0.f;
#pragma unroll
        for (int j = 0; j < 4; ++j) { const float d = x[j] - mean; qq += d * d; }
        const float rstd = rsqrtf(wave_sum(qq) * (1.0f / 256.0f) + 1e-5f);
        const u32x2 gp = *(const u32x2*)(U + (size_t)row * NINP + U_GR + cc); const float gr[4] = {__uint_as_float(gp.x << 16), __uint_as_float(gp.x & 0xffff0000u), __uint_as_float(gp.y << 16), __uint_as_float(gp.y & 0xffff0000u)};
        const f32x4 gg = *(const f32x4*)(ng + cc), bb = *(const f32x4*)(nb + cc); float o[4];
#pragma unroll
        for (int j = 0; j < 4; ++j) o[j] = ((x[j] - mean) * rstd * gg[j] + bb[j]) * gr[j] * sigmoidf_(gr[j]);
        u32x2 ov; ov.x = pk2(o[0], o[1]); ov.y = pk2(o[2], o[3]); *(u32x2*)p = ov;
    }
}

__device__ __forceinline__ void unpack8(const u32x4 w, float (&x)[8]) {
    x[0] = __uint_as_float(w.x << 16); x[1] = __uint_as_float(w.x & 0xffff0000u); x[2] = __uint_as_float(w.y << 16); x[3] = __uint_as_float(w.y & 0xffff0000u);
    x[4] = __uint_as_float(w.z << 16); x[5] = __uint_as_float(w.z & 0xffff0000u); x[6] = __uint_as_float(w.w << 16); x[7] = __uint_as_float(w.w & 0xffff0000u);
}
template <bool ISBF> __device__ __forceinline__ void swa_step(const float (&q)[32], float (&acc)[32], float& m, float& l, const void* kp, const void* vp, float slope, float dist) {
    float s = 0.f;
#pragma unroll
    for (int j = 0; j < 4; ++j) { float x[8];
        if (ISBF) unpack8(*(const u32x4*)((const bf16_t*)kp + j * 8), x);
        else { const f32x4 a = *(const f32x4*)((const float*)kp + j * 8), b = *(const f32x4*)((const float*)kp + j * 8 + 4); x[0] = a[0]; x[1] = a[1]; x[2] = a[2]; x[3] = a[3]; x[4] = b[0]; x[5] = b[1]; x[6] = b[2]; x[7] = b[3]; }
#pragma unroll
        for (int d = 0; d < 8; ++d) s += q[j * 8 + d] * x[d]; }
    s += __shfl_xor(s, 1, 64);
    s = s * 0.125f - slope * dist;
    const float mn = fmaxf(m, s), cc = __expf(m - mn), p = __expf(s - mn);
    l = l * cc + p;
#pragma unroll
    for (int j = 0; j < 4; ++j) { float x[8];
        if (ISBF) unpack8(*(const u32x4*)((const bf16_t*)vp + j * 8), x);
        else { const f32x4 a = *(const f32x4*)((const float*)vp + j * 8), b = *(const f32x4*)((const float*)vp + j * 8 + 4); x[0] = a[0]; x[1] = a[1]; x[2] = a[2]; x[3] = a[3]; x[4] = b[0]; x[5] = b[1]; x[6] = b[2]; x[7] = b[3]; }
#pragma unroll
        for (int d = 0; d < 8; ++d) acc[j * 8 + d] = acc[j * 8 + d] * cc + p * x[d]; }
    m = mn;
}
__device__ __forceinline__ void ph_swa_naive(const Ctx& c, const bf16_t* __restrict__ U, const float* __restrict__ ck, const float* __restrict__ cv, const float* __restrict__ sinks, bf16_t* __restrict__ OB) {
    for (int gid = c.bid * 512 + c.tid; gid < MS * 32; gid += c.G * 512) {
        const int dh = gid & 1, h = (gid >> 1) & 15, row = MP + (gid >> 5), kvh = h >> 3, co = kvh * 64 + dh * 32;
        float q[32], acc[32];
#pragma unroll
        for (int j = 0; j < 4; ++j) { float x[8]; unpack8(*(const u32x4*)(U + (size_t)row * NINP + U_SQ + h * 64 + dh * 32 + j * 8), x);
#pragma unroll
            for (int d = 0; d < 8; ++d) { q[j * 8 + d] = x[d]; acc[j * 8 + d] = 0.f; } }
        const float slope = exp2f(-0.5f * (float)(h + 1)); float m = sinks[h], l = 1.0f;
        if (row < MP) {
            const int t = row % PS, base = row - t, lo = t - 128 < 0 ? 0 : t - 128;
            for (int s = lo; s <= t; ++s) { const bf16_t* ur = U + (size_t)(base + s) * NINP;
                swa_step<true>(q, acc, m, l, ur + U_SK + co, ur + U_SV + co, slope, (float)(t - s)); }
        } else {
            const int sq = (row - MP) / SS, i = (row - MP) % SS;
            for (int idx = i; idx <= 128 + i; ++idx) {
                if (idx < 128) { const size_t o = ((size_t)sq * 128 + idx) * 128 + co; swa_step<false>(q, acc, m, l, ck + o, cv + o, slope, (float)(128 + i - idx)); }
                else { const bf16_t* ur = U + (size_t)(MP + sq * SS + idx - 128) * NINP; swa_step<true>(q, acc, m, l, ur + U_SK + co, ur + U_SV + co, slope, (float)(128 + i - idx)); }
            }
        }
        const float inv = 1.0f / l; bf16_t* op = OB + (size_t)row * BW + h * 64 + dh * 32;
#pragma unroll
        for (int j = 0; j < 4; ++j) { u32x4 w; w.x = pk2(acc[j * 8] * inv, acc[j * 8 + 1] * inv); w.y = pk2(acc[j * 8 + 2] * inv, acc[j * 8 + 3] * inv);
            w.z = pk2(acc[j * 8 + 4] * inv, acc[j * 8 + 5] * inv); w.w = pk2(acc[j * 8 + 6] * inv, acc[j * 8 + 7] * inv); *(u32x4*)(op + j * 8) = w; }
    }
}

__device__ __forceinline__ void ph_rwkv_prep(const Ctx& c, const bf16_t* __restrict__ U, const float* __restrict__ shift, const float* __restrict__ mu, const float* __restrict__ w0, const float* __restrict__ w2,
                                             const float* __restrict__ a0, const float* __restrict__ a2, const float* __restrict__ g2, const float* __restrict__ k_k, const float* __restrict__ k_a,
                                             const float* __restrict__ r_k, float* __restrict__ RW) {
    LAS float* xm = (LAS float*)c.lds; LAS float* tw = xm + RWC; LAS float* ad = tw + 64; LAS float* sg = ad + 64;
    const int tid = c.tid;
    float* R = RW; float* WD = RW + (size_t)MPAD * BW; float* K2 = WD + (size_t)MPAD * BW; float* V = K2 + (size_t)MPAD * BW; float* KK = V + (size_t)MPAD * BW;
    float* BV = KK + (size_t)MPAD * BW; float* G = BV + (size_t)MPAD * BW; float* BON = G + (size_t)MPAD * BW;
    for (int row = c.bid; row < MT; row += c.G) {
        const bf16_t* ur = U + (size_t)row * NINP + U_RU; const bf16_t* pr = ur - NINP; const float* ps = nullptr; bool first;
        if (row < MP) first = (row % PS) == 0; else { first = ((row - MP) % SS) == 0; ps = shift + (size_t)((row - MP) / SS) * RWC; }
        for (int cc = tid; cc < RWC; cc += 512) { const float x = bf2f(ur[cc]); const float s = first ? (ps ? ps[cc] : 0.f) : bf2f(pr[cc]); xm[cc] = x + (s - x) * mu[cc]; }
        __syncthreads();
        if (tid < 64) { tw[tid] = tanhf(xm[3072 + tid]); ad[tid] = xm[3136 + tid]; }
        if (tid >= 128 && tid < 256) sg[tid - 128] = sigmoidf_(xm[3200 + tid - 128]);
        __syncthreads();
        for (int qd = 0; qd < 2; ++qd) {
            const int cc = qd * 512 + tid; float accw = w0[cc], acca = a0[cc], accg = 0.f;
#pragma unroll 4
            for (int j = 0; j < 64; ++j) { accw += tw[j] * w2[j * BW + cc]; acca += ad[j] * a2[j * BW + cc]; }
#pragma unroll 4
            for (int j = 0; j < 128; ++j) accg += sg[j] * g2[j * BW + cc];
            const float lw = -softplusf_(-accw) - 0.5f, decay = __expf(-__expf(lw)), a = sigmoidf_(acca);
            const float r = xm[cc], k = xm[1024 + cc], v = xm[2048 + cc];
            const float kkr = k * k_k[cc]; const float ss = wave_sum(kkr * kkr); const float kk = kkr / fmaxf(sqrtf(ss), 1e-12f);
            const float k2 = k * (1.0f + (a - 1.0f) * k_a[cc]); const float rk = wave_sum(r * k2 * r_k[cc]);
            const size_t o = (size_t)row * BW + cc;
            R[o] = r; WD[o] = decay; K2[o] = k2; V[o] = v; KK[o] = kk; BV[o] = kk * a; G[o] = accg; BON[o] = rk * v;
        }
        __syncthreads();
    }
}
__device__ __forceinline__ int kperm_pos(int k) { return (k & ~31) + 8 * ((k >> 2) & 3) + 4 * ((k >> 4) & 1) + (k & 3); }
__device__ __forceinline__ void ph_swa_prompt(const Ctx& c, const bf16_t* __restrict__ U, const float* __restrict__ sinks, bf16_t* __restrict__ OB) {
    LAS bf16_t* K_l = (LAS bf16_t*)c.lds;
    LAS bf16_t* VT_l = K_l + 192 * 72;
    const int tid = c.tid, lane = c.lane, r = lane & 15, q = lane >> 4, w = c.wave;
    for (int u = c.bid; u < PB * 64 * 2; u += c.G) {
        const int b = u >> 7, qb = (u >> 1) & 63, kvh = u & 1, h = kvh * 8 + w;
        const int tok0 = qb * 64 - 128;
        const size_t seq0 = (size_t)b * PS;
        for (int idx = tid; idx < 192 * 8; idx += 512) { const int kl = idx >> 3, c8 = idx & 7, tk = tok0 + kl; u32x4 kv = (u32x4){0u, 0u, 0u, 0u}, vv = kv;
            if (tk >= 0) { const bf16_t* ur = U + (seq0 + tk) * NINP; kv = *(const u32x4*)(ur + U_SK + kvh * 64 + c8 * 8); vv = *(const u32x4*)(ur + U_SV + kvh * 64 + c8 * 8); }
            *(LAS u32x4*)(K_l + kl * 72 + c8 * 8) = kv;
            const int kp = kperm_pos(kl); LAS bf16_t* vp = VT_l + (c8 * 8) * 200 + kp;
            vp[0] = (bf16_t)(vv.x & 0xffffu); vp[200] = (bf16_t)(vv.x >> 16); vp[400] = (bf16_t)(vv.y & 0xffffu); vp[600] = (bf16_t)(vv.y >> 16);
            vp[800] = (bf16_t)(vv.z & 0xffffu); vp[1000] = (bf16_t)(vv.z >> 16); vp[1200] = (bf16_t)(vv.w & 0xffffu); vp[1400] = (bf16_t)(vv.w >> 16); }
        __syncthreads();
        const float slope = exp2f(-0.5f * (float)(h + 1)), sink = sinks[h];
#pragma unroll 1
        for (int i = 0; i < 4; ++i) {
            const size_t qrow = seq0 + qb * 64 + i * 16 + r;
            const bf16x8 qf0 = *(const bf16x8*)(U + qrow * NINP + U_SQ + h * 64 + q * 8), qf1 = *(const bf16x8*)(U + qrow * NINP + U_SQ + h * 64 + 32 + q * 8);
            const int kt0 = i & ~1;
            f32x4 s[10]; float mx = sink; bf16x8 kfr[5][2];
#pragma unroll
            for (int kt = 0; kt < 10; ++kt) { f32x4 d;
                if (kt % 5 == 0) {
#pragma unroll
                    for (int k5 = 0; k5 < 5; ++k5) { const LAS bf16_t* kp = K_l + ((kt0 + kt + k5) * 16 + r) * 72 + q * 8; kfr[k5][0] = *(const LAS bf16x8*)kp; kfr[k5][1] = *(const LAS bf16x8*)(kp + 32); }
                    __builtin_amdgcn_sched_barrier(0); }
                d = mma16(kfr[kt % 5][0], qf0, (f32x4){0.f, 0.f, 0.f, 0.f}); d = mma16(kfr[kt % 5][1], qf1, d);
#pragma unroll
                for (int jj = 0; jj < 4; ++jj) { const int kl = (kt0 + kt) * 16 + q * 4 + jj, dist = i * 16 + r + 128 - kl;
                    const float v = (dist >= 0 && dist <= 128 && tok0 + kl >= 0) ? d[jj] * 0.125f - slope * (float)dist : -1e30f; d[jj] = v; mx = fmaxf(mx, v); }
                s[kt] = d; }
            mx = fmaxf(mx, __shfl_xor(mx, 16, 64)); mx = fmaxf(mx, __shfl_xor(mx, 32, 64));
            float sum = 0.f; bf16x8 pf[5];
#pragma unroll
            for (int kp = 0; kp < 5; ++kp) { f32x4 a = s[2 * kp], bq = s[2 * kp + 1];
#pragma unroll
                for (int jj = 0; jj < 4; ++jj) { a[jj] = __expf(a[jj] - mx); bq[jj] = __expf(bq[jj] - mx); sum += a[jj] + bq[jj]; }
                pf[kp] = pack_acc(a, bq); }
            sum += __shfl_xor(sum, 16, 64); sum += __shfl_xor(sum, 32, 64);
            const float inv = 1.0f / (sum + __expf(sink - mx));
            bf16_t* op = OB + qrow * BW + h * 64 + q * 4;
#pragma unroll
            for (int dt = 0; dt < 4; ++dt) { f32x4 o = (f32x4){0.f, 0.f, 0.f, 0.f}; bf16x8 vfr[5];
#pragma unroll
                for (int kp = 0; kp < 5; ++kp) vfr[kp] = *(const LAS bf16x8*)(VT_l + (dt * 16 + r) * 200 + (kt0 + 2 * kp) * 16 + q * 8);
                __builtin_amdgcn_sched_barrier(0);
#pragma unroll
                for (int kp = 0; kp < 5; ++kp) o = mma16(vfr[kp], pf[kp], o);
                u32x2 ov; ov.x = pk2(o[0] * inv, o[1] * inv); ov.y = pk2(o[2] * inv, o[3] * inv); *(u32x2*)(op + dt * 16) = ov; }
        }
        __syncthreads();
    }
}

__device__ __forceinline__ void ph_swa_sample(const Ctx& c, const bf16_t* __restrict__ U, const float* __restrict__ ck, const float* __restrict__ cv, const float* __restrict__ sinks, bf16_t* __restrict__ OB) {
    LAS bf16_t* K_l = (LAS bf16_t*)c.lds;
    LAS bf16_t* VT_l = K_l + 160 * 72;
    const int tid = c.tid, lane = c.lane, r = lane & 15, q = lane >> 4, w = c.wave;
    for (int u = c.bid; u < SB * 2; u += c.G) {
        const int sq = u >> 1, kvh = u & 1;
        for (int idx = tid; idx < 160 * 8; idx += 512) { const int kl = idx >> 3, c8 = idx & 7; float kx[8], vx[8];
#pragma unroll
            for (int e = 0; e < 8; ++e) { kx[e] = 0.f; vx[e] = 0.f; }
            if (kl < 128) { const size_t o = ((size_t)sq * 128 + kl) * 128 + kvh * 64 + c8 * 8; const f32x4 a = *(const f32x4*)(ck + o), b2 = *(const f32x4*)(ck + o + 4), c2 = *(const f32x4*)(cv + o), d2 = *(const f32x4*)(cv + o + 4);
                kx[0] = a[0]; kx[1] = a[1]; kx[2] = a[2]; kx[3] = a[3]; kx[4] = b2[0]; kx[5] = b2[1]; kx[6] = b2[2]; kx[7] = b2[3];
                vx[0] = c2[0]; vx[1] = c2[1]; vx[2] = c2[2]; vx[3] = c2[3]; vx[4] = d2[0]; vx[5] = d2[1]; vx[6] = d2[2]; vx[7] = d2[3]; }
            else if (kl < 132) { const bf16_t* ur = U + (size_t)(MP + sq * SS + kl - 128) * NINP; unpack8(*(const u32x4*)(ur + U_SK + kvh * 64 + c8 * 8), kx); unpack8(*(const u32x4*)(ur + U_SV + kvh * 64 + c8 * 8), vx); }
            *(LAS u32x4*)(K_l + kl * 72 + c8 * 8) = (u32x4){pk2(kx[0], kx[1]), pk2(kx[2], kx[3]), pk2(kx[4], kx[5]), pk2(kx[6], kx[7])};
            LAS bf16_t* vp = VT_l + (c8 * 8) * 168 + kperm_pos(kl);
#pragma unroll
            for (int e = 0; e < 8; ++e) vp[e * 168] = f2bf(vx[e]); }
        __syncthreads();
        if (w < 2) {
            const int h = kvh * 8 + w * 4 + (r >> 2), tk = r & 3; const size_t qrow = (size_t)(MP + sq * SS + tk);
            const float slope = exp2f(-0.5f * (float)(h + 1)), sink = sinks[h];
            const bf16x8 qf0 = *(const bf16x8*)(U + qrow * NINP + U_SQ + h * 64 + q * 8), qf1 = *(const bf16x8*)(U + qrow * NINP + U_SQ + h * 64 + 32 + q * 8);
            f32x4 s[10]; float mx = sink;
#pragma unroll
            for (int kt = 0; kt < 10; ++kt) { const LAS bf16_t* kp = K_l + (kt * 16 + r) * 72 + q * 8;
                f32x4 d = mma16(*(const LAS bf16x8*)kp, qf0, (f32x4){0.f, 0.f, 0.f, 0.f}); d = mma16(*(const LAS bf16x8*)(kp + 32), qf1, d);
#pragma unroll
                for (int jj = 0; jj < 4; ++jj) { const int kl = kt * 16 + q * 4 + jj, dist = 128 + tk - kl;
                    const float v = (dist >= 0 && dist <= 128) ? d[jj] * 0.125f - slope * (float)dist : -1e30f; d[jj] = v; mx = fmaxf(mx, v); }
                s[kt] = d; }
            mx = fmaxf(mx, __shfl_xor(mx, 16, 64)); mx = fmaxf(mx, __shfl_xor(mx, 32, 64));
            float sum = 0.f; bf16x8 pf[5];
#pragma unroll
            for (int kp = 0; kp < 5; ++kp) { f32x4 a = s[2 * kp], bq = s[2 * kp + 1];
#pragma unroll
                for (int jj = 0; jj < 4; ++jj) { a[jj] = __expf(a[jj] - mx); bq[jj] = __expf(bq[jj] - mx); sum += a[jj] + bq[jj]; }
                pf[kp] = pack_acc(a, bq); }
            sum += __shfl_xor(sum, 16, 64); sum += __shfl_xor(sum, 32, 64);
            const float inv = 1.0f / (sum + __expf(sink - mx));
            bf16_t* op = OB + qrow * BW + h * 64 + q * 4;
#pragma unroll
            for (int dt = 0; dt < 4; ++dt) { f32x4 o = (f32x4){0.f, 0.f, 0.f, 0.f};
#pragma unroll
                for (int kp = 0; kp < 5; ++kp) o = mma16(*(const LAS bf16x8*)(VT_l + (dt * 16 + r) * 168 + kp * 32 + q * 8), pf[kp], o);
                u32x2 ov; ov.x = pk2(o[0] * inv, o[1] * inv); ov.y = pk2(o[2] * inv, o[3] * inv); *(u32x2*)(op + dt * 16) = ov; }
        }
        __syncthreads();
    }
}

__device__ __forceinline__ void ph_lrw(const Ctx& c, const float* __restrict__ w2, const float* __restrict__ a2, const float* __restrict__ g2, bf16_t* __restrict__ LRW) {
    for (int idx = c.bid * 512 + c.tid; idx < NL * 256 * 1024; idx += c.G * 512) {
        const int ch = idx & 1023, j = (idx >> 10) & 255, l = idx >> 18;
        const float v = j < 64 ? w2[((size_t)l * 64 + j) * BW + ch] : (j < 128 ? a2[((size_t)l * 64 + j - 64) * BW + ch] : g2[((size_t)l * 128 + j - 128) * BW + ch]);
        LRW[((size_t)l * 1024 + ch) * 256 + j] = f2bf(v);
    }
}
constexpr int RWP_UNITS = (MP / 64) * 4 + SB * 4;
__device__ __forceinline__ void rwp_unit_info(int u, int& row0, int& ntok, int& hg, int& sq, bool& seq_first) {
    if (u < (MP / 64) * 4) { const int blk = u >> 2; hg = u & 3; row0 = blk * 64; ntok = 64; sq = -1; seq_first = (row0 % PS) == 0; }
    else { const int s = u - (MP / 64) * 4; sq = s >> 2; hg = s & 3; row0 = MP + sq * SS; ntok = SS; seq_first = true; }
}
__device__ __forceinline__ void ph_rwkv_pre(const Ctx& c, const bf16_t* __restrict__ U, const float* __restrict__ shift, const float* __restrict__ mu, const float* __restrict__ w0, const float* __restrict__ w2,
                                            const float* __restrict__ a0, const float* __restrict__ a2, const float* __restrict__ g2, const float* __restrict__ k_k, const float* __restrict__ k_a,
                                            const float* __restrict__ r_k, float* __restrict__ RW, bf16_t* __restrict__ RB, const bf16_t* __restrict__ LRW) {
    LAS bf16_t* P_l = (LAS bf16_t*)c.lds; LAS bf16_t* Kn_l = P_l + 4608; LAS bf16_t* Bn_l = Kn_l + 4608; LAS bf16_t* Q_l = Bn_l + 4608;
    LAS bf16_t* PT_l = Q_l + 4608; LAS bf16_t* BhT_l = PT_l + 4608; LAS bf16_t* KhT_l = BhT_l + 4608; LAS bf16_t* VT_l = KhT_l + 4608;
    LAS float* A_l = (LAS float*)(c.lds + 73728);
    LAS bf16_t* BmT_l = (LAS bf16_t*)(c.lds + 78848); LAS bf16_t* F_l = (LAS bf16_t*)(c.lds + 81920); LAS bf16_t* Tinv_l = (LAS bf16_t*)(c.lds + 84992);
    LAS bf16_t* PpT_l = (LAS bf16_t*)(c.lds + 88064);
    LAS bf16_t* BmpT_l = (LAS bf16_t*)(c.lds + 97280);
    LAS float* GC_l = (LAS float*)(c.lds + 100352);
    LAS float* lg_l = (LAS float*)(c.lds + 125952);
    LAS bf16_t* act_l = (LAS bf16_t*)c.lds;
    LAS bf16_t* wT_l = act_l + 64 * 264;
    LAS bf16_t* aT_l = wT_l + 64 * 72;
    LAS bf16_t* gT_l = aT_l + 64 * 72;
    LAS float* pre_l = (LAS float*)(c.lds + 73728);
    const int tid = c.tid, lane = c.lane, r = lane & 15, q = lane >> 4, w = c.wave;
    float* Gg = RW + 6 * (size_t)MPAD * BW; float* BON = RW + 7 * (size_t)MPAD * BW;
    for (int u = c.bid; u < RWP_UNITS; u += c.G) {
        int row0, ntok, hg, sq; bool seq_first; rwp_unit_info(u, row0, ntok, hg, sq, seq_first);
        const float* sh = sq >= 0 ? shift + (size_t)sq * RWC : nullptr;
        const int nstage = ntok == 64 ? 64 : 16;
        for (int idx = tid; idx < nstage * 32; idx += 512) {
            const int t = idx >> 5, c8 = idx & 31, cc = 3072 + c8 * 8; float val[8];
#pragma unroll
            for (int e2 = 0; e2 < 8; ++e2) val[e2] = 0.f;
            if (t < ntok) { const bf16_t* ur = U + (size_t)(row0 + t) * NINP + U_RU; float x[8], p[8];
                unpack8(*(const u32x4*)(ur + cc), x);
                if (!(t == 0 && seq_first)) unpack8(*(const u32x4*)(ur + cc - NINP), p);
                else if (sh) { const f32x4 s0v = *(const f32x4*)(sh + cc), s1v = *(const f32x4*)(sh + cc + 4); p[0] = s0v[0]; p[1] = s0v[1]; p[2] = s0v[2]; p[3] = s0v[3]; p[4] = s1v[0]; p[5] = s1v[1]; p[6] = s1v[2]; p[7] = s1v[3]; }
                else {
#pragma unroll
                    for (int e2 = 0; e2 < 8; ++e2) p[e2] = 0.f; }
                const f32x4 m0 = *(const f32x4*)(mu + cc), m1 = *(const f32x4*)(mu + cc + 4);
#pragma unroll
                for (int e2 = 0; e2 < 8; ++e2) { const float xm = x[e2] + (p[e2] - x[e2]) * (e2 < 4 ? m0[e2] : m1[e2 - 4]); val[e2] = c8 < 8 ? tanh_fast(xm) : (c8 < 16 ? xm : sigmoidf_(xm)); } }
            *(LAS u32x4*)(act_l + t * 264 + c8 * 8) = (u32x4){pk2(val[0], val[1]), pk2(val[2], val[3]), pk2(val[4], val[5]), pk2(val[6], val[7])};
        }
        __syncthreads();
        bf16x8 af[8];
        { const int tb = w & 3;
#pragma unroll
          for (int ks = 0; ks < 8; ++ks) af[ks] = *(const LAS bf16x8*)(act_l + (tb * 16 + r) * 264 + ks * 32 + q * 8); }
        __syncthreads();
#pragma unroll 1
        for (int hh = 0; hh < 4; ++hh) { const int h = hg * 4 + hh;
        { const int tb = w & 3, chf = w >> 2;
          if (tb * 16 < nstage) {
#pragma unroll
            for (int e2 = 0; e2 < 2; ++e2) { const int cb = chf * 2 + e2; f32x4 dw = (f32x4){0.f, 0.f, 0.f, 0.f}, da = dw, dg = dw;
                const bf16_t* wr = LRW + ((size_t)h * 64 + cb * 16 + r) * 256 + q * 8; bf16x8 wf[8];
#pragma unroll
                for (int ks = 0; ks < 8; ++ks) wf[ks] = *(const bf16x8*)(wr + ks * 32);
                __builtin_amdgcn_sched_barrier(0);
#pragma unroll
                for (int ks = 0; ks < 2; ++ks) { dw = mma16(wf[ks], af[ks], dw); da = mma16(wf[2 + ks], af[2 + ks], da); }
#pragma unroll
                for (int ks = 0; ks < 4; ++ks) dg = mma16(wf[4 + ks], af[4 + ks], dg);
                const int o = (tb * 16 + r) * 68 + cb * 16 + q * 4;
                *(LAS f32x4*)(pre_l + o) = dw; *(LAS f32x4*)(pre_l + 64 * 68 + o) = da; *(LAS f32x4*)(pre_l + 2 * 64 * 68 + o) = dg; } } }
        __syncthreads();
        const int t = tid >> 3, cg = tid & 7, c0 = h * 64 + cg * 8, sc = t >> 4;
        float rr[8], k2[8], kap[8], bet[8], nlw[8];
        { float vx[8], gg[8], kkr[8]; float ss = 0.f, rk = 0.f;
          if (t < ntok) {
            const size_t row = (size_t)(row0 + t); const bf16_t* ur = U + row * NINP + U_RU; const bool fst = (t == 0 && seq_first);
            float kx[8];
#pragma unroll
            for (int part = 0; part < 3; ++part) { const int cc = part * 1024 + c0; float x[8], p[8];
                unpack8(*(const u32x4*)(ur + cc), x);
                if (!fst) unpack8(*(const u32x4*)(ur + cc - NINP), p);
                else {
#pragma unroll
                    for (int j = 0; j < 8; ++j) p[j] = sh ? sh[cc + j] : 0.f; }
                const f32x4 mA = *(const f32x4*)(mu + cc), mB = *(const f32x4*)(mu + cc + 4);
#pragma unroll
                for (int j = 0; j < 8; ++j) { const float xm = x[j] + (p[j] - x[j]) * (j < 4 ? mA[j] : mB[j - 4]); if (part == 0) rr[j] = xm; else if (part == 1) kx[j] = xm; else vx[j] = xm; } }
            float pw[8], pa[8], pkk[8], pka[8], prk[8];
#pragma unroll
            for (int hf = 0; hf < 2; ++hf) { const f32x4 v0 = *(const f32x4*)(w0 + c0 + hf * 4), v1 = *(const f32x4*)(a0 + c0 + hf * 4), v2 = *(const f32x4*)(k_k + c0 + hf * 4), v3 = *(const f32x4*)(k_a + c0 + hf * 4), v4 = *(const f32x4*)(r_k + c0 + hf * 4);
#pragma unroll
                for (int j = 0; j < 4; ++j) { pw[hf * 4 + j] = v0[j]; pa[hf * 4 + j] = v1[j]; pkk[hf * 4 + j] = v2[j]; pka[hf * 4 + j] = v3[j]; prk[hf * 4 + j] = v4[j]; } }
            float lwp[8], app[8];
#pragma unroll
            for (int hf = 0; hf < 2; ++hf) { const f32x4 v0 = *(const LAS f32x4*)(pre_l + t * 68 + cg * 8 + hf * 4), v1 = *(const LAS f32x4*)(pre_l + 64 * 68 + t * 68 + cg * 8 + hf * 4), v2 = *(const LAS f32x4*)(pre_l + 2 * 64 * 68 + t * 68 + cg * 8 + hf * 4);
#pragma unroll
                for (int j = 0; j < 4; ++j) { lwp[hf * 4 + j] = v0[j]; app[hf * 4 + j] = v1[j]; gg[hf * 4 + j] = v2[j]; } }
#pragma unroll
            for (int j = 0; j < 8; ++j) {
                const float lw = -softplus_fast(-(pw[j] + lwp[j])) - 0.5f; nlw[j] = -__expf(lw); const float av = sigmoidf_(pa[j] + app[j]);
                kkr[j] = kx[j] * pkk[j]; ss += kkr[j] * kkr[j]; k2[j] = kx[j] * (1.0f + (av - 1.0f) * pka[j]); rk += rr[j] * k2[j] * prk[j]; bet[j] = av; }
          } else {
#pragma unroll
            for (int j = 0; j < 8; ++j) { rr[j] = 0.f; k2[j] = 0.f; kkr[j] = 0.f; bet[j] = 0.f; nlw[j] = 0.f; vx[j] = 0.f; gg[j] = 0.f; }
          }
          ss += __shfl_xor(ss, 1, 64); ss += __shfl_xor(ss, 2, 64); ss += __shfl_xor(ss, 4, 64);
          rk += __shfl_xor(rk, 1, 64); rk += __shfl_xor(rk, 2, 64); rk += __shfl_xor(rk, 4, 64);
          const float inv = 1.0f / fmaxf(sqrtf(ss), 1e-12f);
#pragma unroll
          for (int j = 0; j < 8; ++j) { kap[j] = kkr[j] * inv; bet[j] = kap[j] * bet[j]; }
          if (t < ntok) { const size_t o = (size_t)(row0 + t) * BW + c0;
              *(f32x4*)(Gg + o) = (f32x4){gg[0], gg[1], gg[2], gg[3]}; *(f32x4*)(Gg + o + 4) = (f32x4){gg[4], gg[5], gg[6], gg[7]};
              *(f32x4*)(BON + o) = (f32x4){rk * vx[0], rk * vx[1], rk * vx[2], rk * vx[3]}; *(f32x4*)(BON + o + 4) = (f32x4){rk * vx[4], rk * vx[5], rk * vx[6], rk * vx[7]}; }
          *(LAS f32x4*)(lg_l + t * 68 + cg * 8) = (f32x4){nlw[0], nlw[1], nlw[2], nlw[3]}; *(LAS f32x4*)(lg_l + t * 68 + cg * 8 + 4) = (f32x4){nlw[4], nlw[5], nlw[6], nlw[7]};
#pragma unroll
          for (int j = 0; j < 8; ++j) VT_l[(cg * 8 + j) * 72 + t] = f2bf(vx[j]);
        }
        __syncthreads();
        if (tid < 256) { const int cc = tid & 63, s4 = tid >> 6; float run = 0.f;
#pragma unroll
            for (int i = 0; i < 16; ++i) { const int o = (s4 * 16 + i) * 68 + cc; run += lg_l[o]; lg_l[o] = run; } }
        __syncthreads();
        { unsigned pp[4], pq[4], pk[4], pb[4];
#pragma unroll
          for (int j = 0; j < 8; j += 2) { float vP[2], vQ[2], vK[2], vB[2];
#pragma unroll
              for (int e = 0; e < 2; ++e) { const int jj = j + e, cc = cg * 8 + jj; const float ci = lg_l[t * 68 + cc], cC = lg_l[(sc * 16 + 15) * 68 + cc];
                  const float ei = __expf(-ci), eh = __expf(cC - ci);
                  vP[e] = kap[jj] * __expf(ci - nlw[jj]); vQ[e] = rr[jj] * __expf(ci); vK[e] = k2[jj] * ei; vB[e] = bet[jj] * ei;
                  PT_l[cc * 72 + t] = f2bf(vP[e]); BhT_l[cc * 72 + t] = f2bf(bet[jj] * eh); KhT_l[cc * 72 + t] = f2bf(k2[jj] * eh); }
              pp[j >> 1] = pk2(vP[0], vP[1]); pq[j >> 1] = pk2(vQ[0], vQ[1]); pk[j >> 1] = pk2(vK[0], vK[1]); pb[j >> 1] = pk2(vB[0], vB[1]); }
          const int o = t * 72 + cg * 8;
          *(LAS u32x4*)(P_l + o) = (u32x4){pp[0], pp[1], pp[2], pp[3]}; *(LAS u32x4*)(Q_l + o) = (u32x4){pq[0], pq[1], pq[2], pq[3]};
          *(LAS u32x4*)(Kn_l + o) = (u32x4){pk[0], pk[1], pk[2], pk[3]}; *(LAS u32x4*)(Bn_l + o) = (u32x4){pb[0], pb[1], pb[2], pb[3]};
          if ((t & 15) == 15) {
#pragma unroll
              for (int j = 0; j < 8; ++j) GC_l[sc * 64 + cg * 8 + j] = __expf(lg_l[t * 68 + cg * 8 + j]); } }
        __syncthreads();
        const int nsub = ntok == 64 ? 4 : 1;
        const bf16x8 zfrag = (bf16x8){0, 0, 0, 0, 0, 0, 0, 0};
        for (int id = w; id < nsub * 3; id += 8) { const int s4 = id / 3, prod = id - s4 * 3; f32x4 d = (f32x4){0.f, 0.f, 0.f, 0.f};
            const LAS bf16_t* X = (prod == 1 ? P_l : Bn_l) + (s4 * 16 + r) * 72 + q * 8; const LAS bf16_t* Y = (prod == 0 ? P_l : (prod == 1 ? Kn_l : Q_l)) + (s4 * 16 + r) * 72 + q * 8;
            { const bf16x8 x0 = *(const LAS bf16x8*)X, x1 = *(const LAS bf16x8*)(X + 32), y0 = *(const LAS bf16x8*)Y, y1 = *(const LAS bf16x8*)(Y + 32);
              __builtin_amdgcn_sched_barrier(0); d = mma16(x0, y0, d); d = mma16(x1, y1, d); }
            if (prod == 0) { f32x4 o4;
#pragma unroll
                for (int jj = 0; jj < 4; ++jj) o4[jj] = (q * 4 + jj < r) ? d[jj] : 0.f;
                *(LAS f32x4*)(A_l + s4 * 320 + r * 20 + q * 4) = o4; }
            else { float o4[4];
#pragma unroll
                for (int jj = 0; jj < 4; ++jj) o4[jj] = (prod == 1 ? (r < q * 4 + jj) : (q * 4 + jj <= r)) ? d[jj] : 0.f;
                u32x2 o; o.x = pk2(o4[0], o4[1]); o.y = pk2(o4[2], o4[3]); *(LAS u32x2*)((prod == 1 ? BmT_l : F_l) + s4 * 384 + r * 24 + q * 4) = o; } }
        __syncthreads();
        if (w == 0 && (lane >> 4) < nsub) { const int s4 = lane >> 4, jc = lane & 15; float x[16];
#pragma unroll
            for (int tt = 0; tt < 16; ++tt) { float s = (tt == jc) ? 1.f : 0.f;
#pragma unroll
                for (int i = 0; i < tt; ++i) s -= A_l[s4 * 320 + tt * 20 + i] * x[i];
                x[tt] = s; }
#pragma unroll
            for (int tt = 0; tt < 16; ++tt) Tinv_l[s4 * 384 + tt * 24 + jc] = f2bf(x[tt]); }
        __syncthreads();
        for (int id = w; id < nsub * 5; id += 8) { const int s4 = id / 5, rem = id - s4 * 5;
            const bf16x8 xf = q < 2 ? *(const LAS bf16x8*)(Tinv_l + s4 * 384 + r * 24 + q * 8) : zfrag;
            const bf16x8 yf = q < 2 ? (rem < 4 ? *(const LAS bf16x8*)(PT_l + (rem * 16 + r) * 72 + s4 * 16 + q * 8) : *(const LAS bf16x8*)(BmT_l + s4 * 384 + r * 24 + q * 8)) : zfrag;
            const f32x4 d = mma16(xf, yf, (f32x4){0.f, 0.f, 0.f, 0.f});
            u32x2 o; o.x = pk2(d[0], d[1]); o.y = pk2(d[2], d[3]);
            if (rem < 4) *(LAS u32x2*)(PpT_l + (rem * 16 + r) * 72 + s4 * 16 + q * 4) = o; else *(LAS u32x2*)(BmpT_l + s4 * 384 + r * 24 + q * 4) = o; }
        __syncthreads();
        { const int chunk0 = sq >= 0 ? PB * 16 * 256 + sq * 16 + h : ((row0 / PS) * 16 + h) * 256 + ((row0 % PS) >> 4);
          for (int id = w; id < nsub * 25; id += 8) { const int s4 = id / 25, rem = id - s4 * 25; bf16_t* blob = RB + (size_t)(chunk0 + s4) * RB_EL;
            const bf16x8 fF = q < 2 ? *(const LAS bf16x8*)(F_l + s4 * 384 + r * 24 + q * 8) : zfrag;
            if (rem < 4) {
                const bf16x8 xf = q < 2 ? *(const LAS bf16x8*)(PpT_l + (rem * 16 + r) * 72 + s4 * 16 + q * 8) : zfrag;
                const f32x4 d = mma16(xf, fF, (f32x4){0.f, 0.f, 0.f, 0.f});
                const u32x2 qv = *(const LAS u32x2*)(Q_l + (s4 * 16 + r) * 72 + rem * 16 + q * 4);
                u32x2 o; o.x = pk2(__uint_as_float(qv.x << 16) - d[0], __uint_as_float(qv.x & 0xffff0000u) - d[1]); o.y = pk2(__uint_as_float(qv.y << 16) - d[2], __uint_as_float(qv.y & 0xffff0000u) - d[3]);
                *(u32x2*)(blob + RB_QP + r * 72 + 32 * (rem >> 1) + 8 * q + 4 * (rem & 1)) = o;
            } else if (rem == 4) {
                f32x4 d2 = (f32x4){0.f, 0.f, 0.f, 0.f};
#pragma unroll
                for (int ks = 0; ks < 2; ++ks) d2 = mma16(*(const LAS bf16x8*)(Kn_l + (s4 * 16 + r) * 72 + ks * 32 + q * 8), *(const LAS bf16x8*)(Q_l + (s4 * 16 + r) * 72 + ks * 32 + q * 8), d2);
                const bf16x8 xf = q < 2 ? *(const LAS bf16x8*)(BmpT_l + s4 * 384 + r * 24 + q * 8) : zfrag;
                const f32x4 d1 = mma16(xf, fF, (f32x4){0.f, 0.f, 0.f, 0.f});
                float o4[4];
#pragma unroll
                for (int jj = 0; jj < 4; ++jj) o4[jj] = ((q * 4 + jj <= r) ? d2[jj] : 0.f) - d1[jj];
                u32x2 o; o.x = pk2(o4[0], o4[1]); o.y = pk2(o4[2], o4[3]); *(u32x2*)(blob + RB_EP + r * 24 + q * 4) = o;
            } else if (rem < 21) {
                const int cib = (rem - 5) >> 2, cob = (rem - 5) & 3;
                const bf16x8 xf = q < 2 ? *(const LAS bf16x8*)(PpT_l + (cib * 16 + r) * 72 + s4 * 16 + q * 8) : zfrag;
                const bf16x8 yf = q < 2 ? *(const LAS bf16x8*)(BhT_l + (cob * 16 + r) * 72 + s4 * 16 + q * 8) : zfrag;
                const f32x4 d = mma16(xf, yf, (f32x4){0.f, 0.f, 0.f, 0.f});
                const float gc = GC_l[s4 * 64 + cob * 16 + r]; float o4[4];
#pragma unroll
                for (int jj = 0; jj < 4; ++jj) o4[jj] = ((cib == cob && q * 4 + jj == r) ? gc : 0.f) - d[jj];
                u32x2 o; o.x = pk2(o4[0], o4[1]); o.y = pk2(o4[2], o4[3]); *(u32x2*)(blob + (cob * 16 + r) * 72 + 32 * (cib >> 1) + 8 * q + 4 * (cib & 1)) = o;
            } else {
                const int cb = rem - 21;
                const bf16x8 xf = q < 2 ? *(const LAS bf16x8*)(BmpT_l + s4 * 384 + r * 24 + q * 8) : zfrag;
                const bf16x8 yf = q < 2 ? *(const LAS bf16x8*)(BhT_l + (cb * 16 + r) * 72 + s4 * 16 + q * 8) : zfrag;
                const f32x4 d = mma16(xf, yf, (f32x4){0.f, 0.f, 0.f, 0.f});
                const u32x2 kv = *(const LAS u32x2*)(KhT_l + (cb * 16 + r) * 72 + s4 * 16 + q * 4);
                u32x2 o; o.x = pk2(__uint_as_float(kv.x << 16) - d[0], __uint_as_float(kv.x & 0xffff0000u) - d[1]); o.y = pk2(__uint_as_float(kv.y << 16) - d[2], __uint_as_float(kv.y & 0xffff0000u) - d[3]);
                *(u32x2*)(blob + RB_KHP + (cb * 16 + r) * 24 + q * 4) = o;
            } }
          for (int idx = tid; idx < nsub * 128; idx += 512) { const int s4 = idx >> 7, cc = (idx >> 1) & 63, hf = idx & 1;
              *(u32x4*)(RB + (size_t)(chunk0 + s4) * RB_EL + RB_VT + cc * 24 + hf * 8) = *(const LAS u32x4*)(VT_l + cc * 72 + s4 * 16 + hf * 8); } }
        __syncthreads();
        }
    }
}

__device__ __forceinline__ void ph_rwkv_scan_naive(const Ctx& c, const float* __restrict__ RW, const float* __restrict__ s0, const float* __restrict__ lng, const float* __restrict__ lnb, bf16_t* __restrict__ OB,
                                                   float* __restrict__ outP, float* __restrict__ outS) {
    const float* R = RW; const float* WD = RW + (size_t)MPAD * BW; const float* K2 = WD + (size_t)MPAD * BW; const float* V = K2 + (size_t)MPAD * BW; const float* KK = V + (size_t)MPAD * BW;
    const float* BV = KK + (size_t)MPAD * BW; const float* G = BV + (size_t)MPAD * BW; const float* BON = G + (size_t)MPAD * BW;
    const int lane = c.lane;
    for (int it = 0;; ++it) {
        const int u = (it * 8 + c.wave) * c.G + c.bid;
        if (u >= (PB + SB) * 16) break;
        const int sq = u >> 4, h = u & 15;
        int row0, L; seq_info(sq, row0, L);
        float S[64];
        if (sq >= PB) { const float* p = s0 + (((size_t)(sq - PB) * 16 + h) * 64 + lane) * 64;
#pragma unroll
            for (int j = 0; j < 64; ++j) S[j] = p[j]; }
        else {
#pragma unroll
            for (int j = 0; j < 64; ++j) S[j] = 0.f; }
        const float lg = lng[h * 64 + lane], lb = lnb[h * 64 + lane];
        for (int t = 0; t < L; ++t) {
            const size_t base = (size_t)(row0 + t) * BW + h * 64; const float v = V[base + lane];
            float d = 0.f;
#pragma unroll
            for (int j = 0; j < 64; ++j) d += S[j] * KK[base + j];
            float y = 0.f;
#pragma unroll
            for (int j = 0; j < 64; ++j) { S[j] = S[j] * WD[base + j] - d * BV[base + j] + v * K2[base + j]; y += S[j] * R[base + j]; }
            const float mean = wave_sum(y) * (1.0f / 64.0f), dy = y - mean, var = wave_sum(dy * dy) * (1.0f / 64.0f);
            const float yn = dy * rsqrtf(var + 64e-5f) * lg + lb;
            OB[base + lane] = f2bf((yn + BON[base + lane]) * G[base + lane]);
        }
        float* op = (sq < PB ? outP + (((size_t)sq * 16 + h) * 64 + lane) * 64 : outS + (((size_t)(sq - PB) * 16 + h) * 64 + lane) * 64);
#pragma unroll
        for (int j = 0; j < 64; ++j) op[j] = S[j];
    }
}
__device__ __forceinline__ void ph_rwkv_scan2(const Ctx& c, int boff, const float* __restrict__ RW, const float* __restrict__ s0, const float* __restrict__ lng, const float* __restrict__ lnb, bf16_t* __restrict__ OB,
                                              float* __restrict__ outP, float* __restrict__ outS) {
    LAS float* opb = (LAS float*)c.lds;
    LAS float* yb = opb + 2 * 16 * 384;
    const int tid = c.tid, lane = c.lane, w = c.wave, rl = lane >> 3, cg = lane & 7, vrow = w * 8 + rl;
    const float* G = RW + 6 * (size_t)MPAD * BW; const float* BON = RW + 7 * (size_t)MPAD * BW;
    for (int u = (c.bid - boff + c.G) % c.G; u < (PB + SB) * 16; u += c.G) {
        const int sq = u >> 4, h = u & 15;
        int row0, L; seq_info(sq, row0, L);
        float S[8];
        if (sq >= PB) { const float* p = s0 + (((size_t)(sq - PB) * 16 + h) * 64 + vrow) * 64 + cg * 8;
#pragma unroll
            for (int j = 0; j < 8; ++j) S[j] = p[j]; }
        else {
#pragma unroll
            for (int j = 0; j < 8; ++j) S[j] = 0.f; }
        const float lg = lng[h * 64 + lane], lb = lnb[h * 64 + lane];
        const int nb = (L + 15) >> 4;
#define RW_STAGE(bi_) do { const int t0_ = (bi_) * 16, nT_ = (L - t0_) < 16 ? (L - t0_) : 16; LAS float* dst_ = opb + ((bi_) & 1) * 16 * 384; \
        for (int idx = tid; idx < nT_ * 96; idx += 512) { const int t = idx / 96, rem = idx - t * 96, slot = rem >> 4, c4 = rem & 15; \
            const int arr = slot == 0 ? 1 : slot == 1 ? 4 : slot == 2 ? 5 : slot == 3 ? 2 : slot == 4 ? 0 : 3; \
            *(LAS f32x4*)(dst_ + t * 384 + slot * 64 + c4 * 4) = *(const f32x4*)(RW + (size_t)arr * MPAD * BW + (size_t)(row0 + t0_ + t) * BW + h * 64 + c4 * 4); } } while (0)
        RW_STAGE(0);
        for (int bi = 0; bi < nb; ++bi) {
            __syncthreads();
            if (bi + 1 < nb) RW_STAGE(bi + 1);
            const int t0 = bi * 16, nT = (L - t0) < 16 ? (L - t0) : 16; const LAS float* src = opb + (bi & 1) * 16 * 384;
            for (int tt = 0; tt < nT; ++tt) {
                const LAS float* b = src + tt * 384 + cg * 8;
                const f32x4 w0 = *(const LAS f32x4*)(b), w1 = *(const LAS f32x4*)(b + 4), k0 = *(const LAS f32x4*)(b + 64), k1 = *(const LAS f32x4*)(b + 68);
                const f32x4 b0 = *(const LAS f32x4*)(b + 128), b1 = *(const LAS f32x4*)(b + 132), q0 = *(const LAS f32x4*)(b + 192), q1 = *(const LAS f32x4*)(b + 196);
                const f32x4 r0 = *(const LAS f32x4*)(b + 256), r1 = *(const LAS f32x4*)(b + 260); const float v = src[tt * 384 + 320 + vrow];
                float d = (S[0] * k0[0] + S[1] * k0[1]) + (S[2] * k0[2] + S[3] * k0[3]) + (S[4] * k1[0] + S[5] * k1[1]) + (S[6] * k1[2] + S[7] * k1[3]);
                d += __shfl_xor(d, 1, 64); d += __shfl_xor(d, 2, 64); d += __shfl_xor(d, 4, 64);
                float y = 0.f;
#pragma unroll
                for (int j = 0; j < 4; ++j) { S[j] = S[j] * w0[j] - d * b0[j] + v * q0[j]; y += S[j] * r0[j]; S[4 + j] = S[4 + j] * w1[j] - d * b1[j] + v * q1[j]; y += S[4 + j] * r1[j]; }
                y += __shfl_xor(y, 1, 64); y += __shfl_xor(y, 2, 64); y += __shfl_xor(y, 4, 64);
                if (cg == 0) yb[tt * 64 + vrow] = y;
            }
            __syncthreads();
            for (int tt = w; tt < nT; tt += 8) {
                const float y = yb[tt * 64 + lane]; const float mean = wave_sum(y) * (1.0f / 64.0f), dy = y - mean, var = wave_sum(dy * dy) * (1.0f / 64.0f);
                const float yn = dy * rsqrtf(var + 64e-5f) * lg + lb; const size_t o = (size_t)(row0 + t0 + tt) * BW + h * 64 + lane;
                OB[o] = f2bf((yn + BON[o]) * G[o]);
            }
        }
#undef RW_STAGE
        float* op = (sq < PB ? outP + (((size_t)sq * 16 + h) * 64 + vrow) * 64 : outS + (((size_t)(sq - PB) * 16 + h) * 64 + vrow) * 64) + cg * 8;
#pragma unroll
        for (int j = 0; j < 8; ++j) op[j] = S[j];
        __syncthreads();
    }
}
constexpr int RS_SLOTS = 8, RS_SLOT_B = RB_EL * 2;
__device__ __forceinline__ void ph_rwkv_seq(const Ctx& c, int boff, const bf16_t* __restrict__ RB, const float* __restrict__ s0, float* __restrict__ outP, float* __restrict__ outS, bf16_t* __restrict__ OB) {
    const int lane = c.lane, r = lane & 15, q = lane >> 4, w = c.wave;
    LAS unsigned char* ring = c.lds;
    const int side = c.bid < 32 ? c.bid : c.bid - 64, nside = c.G - 64;
    for (int u = (c.bid >= boff && c.bid < boff + 32) ? c.bid - boff : ((c.bid < 32 || c.bid >= 96) ? 32 + side : (PB + SB) * 16); u < (PB + SB) * 16; u = u < 32 ? (PB + SB) * 16 : u + nside) {
        const int sq = u >> 4, h = u & 15;
        int nch, ch0, row0, ntok; const float* sp = nullptr; float* op;
        if (sq < PB) { nch = 256; ch0 = (sq * 16 + h) * 256; row0 = sq * PS; ntok = 16; op = outP + (size_t)(sq * 16 + h) * 4096; }
        else { nch = 1; ch0 = PB * 16 * 256 + (sq - PB) * 16 + h; row0 = MP + (sq - PB) * SS; ntok = SS; sp = s0 + (size_t)((sq - PB) * 16 + h) * 4096; op = outS + (size_t)((sq - PB) * 16 + h) * 4096; }
        if (w >= 4) {
            const int lw = w - 4, p0 = lw < 2 ? lw * 5 : 10 + (lw - 2) * 4, np = lw < 2 ? 5 : 4;
#define RS_ISSUE(ci_) do { const int cc_ = (ci_) < nch ? (ci_) : nch - 1; const char* g_ = (const char*)(RB + (size_t)(ch0 + cc_) * RB_EL) + p0 * 1024 + lane * 16; \
            LAS unsigned char* d_ = ring + ((ci_) % RS_SLOTS) * RS_SLOT_B + p0 * 1024; \
            _Pragma("unroll") for (int p_ = 0; p_ < 5; ++p_) if (p_ < np) __builtin_amdgcn_global_load_lds((const unsigned*)(g_ + p_ * 1024), (LAS unsigned*)(d_ + p_ * 1024), 16, 0, 0); } while (0)
            for (int ci = 0; ci < RS_SLOTS - 1; ++ci) RS_ISSUE(ci);
            if (lw < 2) asm volatile("s_waitcnt vmcnt(30)" ::: "memory"); else asm volatile("s_waitcnt vmcnt(24)" ::: "memory");
            __builtin_amdgcn_s_barrier();
            for (int ci = 0; ci < nch; ++ci) {
                RS_ISSUE(ci + RS_SLOTS - 1);
                if (lw < 2) asm volatile("s_waitcnt vmcnt(30)" ::: "memory"); else asm volatile("s_waitcnt vmcnt(24)" ::: "memory");
                __builtin_amdgcn_s_barrier();
            }
#undef RS_ISSUE
            asm volatile("s_waitcnt vmcnt(0)" ::: "memory");
        } else {
            const int vb = w; f32x4 acc[4];
#pragma unroll
            for (int kb = 0; kb < 4; ++kb) acc[kb] = sp ? *(const f32x4*)(sp + (size_t)(vb * 16 + r) * 64 + kb * 16 + q * 4) : (f32x4){0.f, 0.f, 0.f, 0.f};
            const bf16x8 zfrag = (bf16x8){0, 0, 0, 0, 0, 0, 0, 0};
            __builtin_amdgcn_s_barrier();
            for (int ci = 0; ci < nch; ++ci) {
                const LAS bf16_t* blob = (const LAS bf16_t*)(ring + (ci % RS_SLOTS) * RS_SLOT_B);
                bf16x8 mf[4][2], khf[4], qpf[2];
#pragma unroll
                for (int kb = 0; kb < 4; ++kb) { mf[kb][0] = *(const LAS bf16x8*)(blob + (kb * 16 + r) * 72 + q * 8); mf[kb][1] = *(const LAS bf16x8*)(blob + (kb * 16 + r) * 72 + 32 + q * 8);
                    khf[kb] = q < 2 ? *(const LAS bf16x8*)(blob + RB_KHP + (kb * 16 + r) * 24 + q * 8) : zfrag; }
                qpf[0] = *(const LAS bf16x8*)(blob + RB_QP + r * 72 + q * 8); qpf[1] = *(const LAS bf16x8*)(blob + RB_QP + r * 72 + 32 + q * 8);
                const bf16x8 vt = q < 2 ? *(const LAS bf16x8*)(blob + RB_VT + (vb * 16 + r) * 24 + q * 8) : zfrag;
                const bf16x8 ep = q < 2 ? *(const LAS bf16x8*)(blob + RB_EP + r * 24 + q * 8) : zfrag;
                const bf16x8 t0 = pack_acc(acc[0], acc[1]), t1 = pack_acc(acc[2], acc[3]);
                __builtin_amdgcn_sched_barrier(0);
#pragma unroll
                for (int kb = 0; kb < 4; ++kb) acc[kb] = mma16(mf[kb][0], t0, (f32x4){0.f, 0.f, 0.f, 0.f});
#pragma unroll
                for (int kb = 0; kb < 4; ++kb) acc[kb] = mma16(mf[kb][1], t1, acc[kb]);
#pragma unroll
                for (int kb = 0; kb < 4; ++kb) acc[kb] = mma16(khf[kb], vt, acc[kb]);
                f32x4 y = mma16(t0, qpf[0], (f32x4){0.f, 0.f, 0.f, 0.f}); y = mma16(t1, qpf[1], y); y = mma16(vt, ep, y);
                if (r < ntok) { u32x2 o; o.x = pk2(y[0], y[1]); o.y = pk2(y[2], y[3]); *(u32x2*)(OB + (size_t)(row0 + ci * 16 + r) * BW + h * 64 + vb * 16 + q * 4) = o; }
                asm volatile("s_waitcnt lgkmcnt(0)" ::: "memory");
                __builtin_amdgcn_s_barrier();
            }
#pragma unroll
            for (int kb = 0; kb < 4; ++kb) *(f32x4*)(op + (size_t)(vb * 16 + r) * 64 + kb * 16 + q * 4) = acc[kb];
        }
        __syncthreads();
    }
}
__device__ __forceinline__ void ph_rwkv_fin(const Ctx& c, const float* __restrict__ RW, const float* __restrict__ lng, const float* __restrict__ lnb, const bf16_t* __restrict__ RAW, bf16_t* __restrict__ OB) {
    const int lane = c.lane; const float* G = RW + 6 * (size_t)MPAD * BW; const float* BON = RW + 7 * (size_t)MPAD * BW;
    for (int i = c.bid * 8 + c.wave; i < MT * 4; i += c.G * 8) {
        const int row = i >> 2, cc = (i & 3) * 256 + lane * 4; const size_t o = (size_t)row * BW + cc; bf16_t* p = OB + o;
        const u32x2 raw = *(const u32x2*)(RAW + o); float x[4] = {__uint_as_float(raw.x << 16), __uint_as_float(raw.x & 0xffff0000u), __uint_as_float(raw.y << 16), __uint_as_float(raw.y & 0xffff0000u)};
        float s = (x[0] + x[1]) + (x[2] + x[3]); s += __shfl_xor(s, 1, 64); s += __shfl_xor(s, 2, 64); s += __shfl_xor(s, 4, 64); s += __shfl_xor(s, 8, 64);
        const float mean = s * (1.0f / 64.0f); float qq = 0.f;
#pragma unroll
        for (int j = 0; j < 4; ++j) { const float d = x[j] - mean; qq += d * d; }
        qq += __shfl_xor(qq, 1, 64); qq += __shfl_xor(qq, 2, 64); qq += __shfl_xor(qq, 4, 64); qq += __shfl_xor(qq, 8, 64);
        const float rstd = rsqrtf(qq * (1.0f / 64.0f) + 64e-5f);
        const f32x4 gg = *(const f32x4*)(lng + cc), bb = *(const f32x4*)(lnb + cc), bo = *(const f32x4*)(BON + o), gt = *(const f32x4*)(G + o); float ov[4];
#pragma unroll
        for (int j = 0; j < 4; ++j) ov[j] = ((x[j] - mean) * rstd * gg[j] + bb[j] + bo[j]) * gt[j];
        u32x2 oo; oo.x = pk2(ov[0], ov[1]); oo.y = pk2(ov[2], ov[3]); *(u32x2*)p = oo;
    }
}

__device__ __forceinline__ void ph_memattn_sample(const Ctx& c, const bf16_t* __restrict__ U, const float* __restrict__ mk, const float* __restrict__ mv, bf16_t* __restrict__ OB) {
    LAS float* qs = (LAS float*)c.lds; LAS float* ps = qs + 2 * 4 * 256;
    const int hh = c.tid >> 8, vt = c.tid & 255, lane = c.lane;
    for (int u = c.bid; u < SB * 2; u += c.G) {
        const int sq = u >> 1, h = (u & 1) * 2 + hh;
#pragma unroll
        for (int t = 0; t < 4; ++t) qs[(hh * 4 + t) * 256 + vt] = bf2f(U[(size_t)(MP + sq * SS + t) * NINP + U_MQ + h * 256 + vt]) * 0.0625f;
        __syncthreads();
        { const float* kr = mk + (((size_t)sq * MEMT + vt) * 4 + h) * 256; float s[4] = {0.f, 0.f, 0.f, 0.f};
            for (int d = 0; d < 256; d += 4) { const f32x4 kv = *(const f32x4*)(kr + d);
#pragma unroll
                for (int t = 0; t < 4; ++t) { const LAS float* qq = qs + (hh * 4 + t) * 256 + d; s[t] += kv[0] * qq[0] + kv[1] * qq[1] + kv[2] * qq[2] + kv[3] * qq[3]; } }
#pragma unroll
            for (int t = 0; t < 4; ++t) ps[(hh * 4 + t) * 256 + vt] = s[t]; }
        __syncthreads();
        { LAS float* pr = ps + c.wave * 256; float x[4]; float mx = -3.0e38f;
#pragma unroll
            for (int j = 0; j < 4; ++j) { x[j] = pr[lane + 64 * j]; mx = fmaxf(mx, x[j]); }
            mx = wave_max(mx); float s = 0.f;
#pragma unroll
            for (int j = 0; j < 4; ++j) { x[j] = __expf(x[j] - mx); s += x[j]; }
            const float inv = 1.0f / wave_sum(s);
#pragma unroll
            for (int j = 0; j < 4; ++j) pr[lane + 64 * j] = x[j] * inv; }
        __syncthreads();
        { float o[4] = {0.f, 0.f, 0.f, 0.f}; const float* vr = mv + ((size_t)sq * MEMT * 4 + h) * 256 + vt;
            for (int m = 0; m < MEMT; ++m) { const float vv = vr[(size_t)m * 1024];
#pragma unroll
                for (int t = 0; t < 4; ++t) o[t] += ps[(hh * 4 + t) * 256 + m] * vv; }
#pragma unroll
            for (int t = 0; t < 4; ++t) OB[(size_t)(MP + sq * SS + t) * BW + h * 256 + vt] = f2bf(o[t]); }
        __syncthreads();
    }
}

template <int K, int LDA, int LDB> __device__ __forceinline__ void skinny_pair(const Ctx& c, const bf16_t* __restrict__ A, const bf16_t* __restrict__ B0, const bf16_t* __restrict__ B1, f32x4 (&out)[2], int rot) {
    LAS f32x4* red = (LAS f32x4*)c.lds;
    const int lane = c.lane, r = lane & 15, q = lane >> 4, w = c.wave;
    constexpr int KS = K / 8;
    const bf16_t* ap = A + (size_t)r * LDA + w * KS + q * 8; const bf16_t* b0 = B0 + (size_t)r * LDB + w * KS + q * 8; const bf16_t* b1 = B1 + (size_t)r * LDB + w * KS + q * 8;
    f32x4 acc[2][8];
#pragma unroll
    for (int n = 0; n < 2; ++n)
#pragma unroll
        for (int m = 0; m < 8; ++m) acc[n][m] = (f32x4){0.f, 0.f, 0.f, 0.f};
    int kk = (int)((unsigned)rot % (unsigned)(KS / 32));
#pragma unroll 2
    for (int it = 0; it < KS / 32; ++it) { const int ks = kk; kk = kk + 1 == KS / 32 ? 0 : kk + 1;
        const bf16x8 f0 = *(const bf16x8*)(b0 + ks * 32), f1 = *(const bf16x8*)(b1 + ks * 32); bf16x8 af[8];
#pragma unroll
        for (int m = 0; m < 8; ++m) af[m] = *(const bf16x8*)(ap + (size_t)(m * 16) * LDA + ks * 32);
        __builtin_amdgcn_sched_barrier(0);
#pragma unroll
        for (int m = 0; m < 8; ++m) { acc[0][m] = mma16(f0, af[m], acc[0][m]); acc[1][m] = mma16(f1, af[m], acc[1][m]); } }
    __syncthreads();
#pragma unroll
    for (int n = 0; n < 2; ++n)
#pragma unroll
        for (int m = 0; m < 8; ++m) red[(w * 16 + n * 8 + m) * 64 + lane] = acc[n][m];
    __syncthreads();
#pragma unroll
    for (int n = 0; n < 2; ++n) { f32x4 s = red[(n * 8 + w) * 64 + lane];
#pragma unroll
        for (int ww = 1; ww < 8; ++ww) s += red[(ww * 16 + n * 8 + w) * 64 + lane];
        out[n] = s; }
}
template <int K, int LDA, int LDB> __device__ __forceinline__ f32x4 skinny_one(const Ctx& c, const bf16_t* __restrict__ A, const bf16_t* __restrict__ B0, int rot) {
    LAS f32x4* red = (LAS f32x4*)c.lds;
    const int lane = c.lane, r = lane & 15, q = lane >> 4, w = c.wave;
    constexpr int KS = K / 8, NK = KS / 32;
    const bf16_t* ap = A + (size_t)r * LDA + w * KS + q * 8; const bf16_t* b0 = B0 + (size_t)r * LDB + w * KS + q * 8;
    f32x4 acc[8];
#pragma unroll
    for (int m = 0; m < 8; ++m) acc[m] = (f32x4){0.f, 0.f, 0.f, 0.f};
    int kk = (int)((unsigned)rot % (unsigned)NK);
#pragma unroll 4
    for (int it = 0; it < NK; ++it) { const int ks = kk; kk = kk + 1 == NK ? 0 : kk + 1;
        const bf16x8 f0 = *(const bf16x8*)(b0 + ks * 32); bf16x8 af[8];
#pragma unroll
        for (int m = 0; m < 8; ++m) af[m] = *(const bf16x8*)(ap + (size_t)(m * 16) * LDA + ks * 32);
        __builtin_amdgcn_sched_barrier(0);
#pragma unroll
        for (int m = 0; m < 8; ++m) acc[m] = mma16(f0, af[m], acc[m]); }
    __syncthreads();
#pragma unroll
    for (int m = 0; m < 8; ++m) red[(w * 8 + m) * 64 + lane] = acc[m];
    __syncthreads();
    f32x4 s = red[w * 64 + lane];
#pragma unroll
    for (int ww = 1; ww < 8; ++ww) s += red[(ww * 8 + w) * 64 + lane];
    return s;
}
__device__ __forceinline__ u32x2 pk4(const f32x4 v) { u32x2 o; o.x = pk2(v[0], v[1]); o.y = pk2(v[2], v[3]); return o; }
#define SKINNY_LOOP(total_) for (int s = c.bid - base; s >= 0 && s < (total_); s += ncu)
__device__ __forceinline__ void ph_sk_in(const Ctx& c, int base, int ncu, const bf16_t* __restrict__ HB, const bf16_t* __restrict__ W, bf16_t* __restrict__ U) {
    const int r = c.lane & 15, q = c.lane >> 4, w = c.wave;
    SKINNY_LOOP(NINP / 32) { f32x4 o[2]; skinny_pair<DM, DM, DM>(c, HB + (size_t)MP * DM, W + (size_t)(s * 32) * DM, W + (size_t)(s * 32 + 16) * DM, o, s);
        bf16_t* up = U + (size_t)(MP + w * 16 + r) * NINP + s * 32 + q * 4; *(u32x2*)up = pk4(o[0]); *(u32x2*)(up + 16) = pk4(o[1]); }
}
__device__ __forceinline__ void ph_sk_merge(const Ctx& c, int base, int ncu, const bf16_t* __restrict__ BR, const bf16_t* __restrict__ W, const bf16_t* __restrict__ U, const float* __restrict__ gate_b, bf16_t* __restrict__ MGB) {
    const int r = c.lane & 15, q = c.lane >> 4, w = c.wave;
    SKINNY_LOOP(DM / 16) { const size_t row = (size_t)(MP + w * 16 + r); const int col = s * 16 + q * 4; f32x4 tot = (f32x4){0.f, 0.f, 0.f, 0.f};
#pragma unroll 1
        for (int z = 0; z < 4; ++z) { const f32x4 o = skinny_one<BW, BW, BW>(c, BR + ((size_t)z * MPAD + MP) * BW, W + ((size_t)z * DM + s * 16) * BW, s + z);
            const u32x2 gp = *(const u32x2*)(U + row * NINP + U_GP + z * DM + col); const f32x4 gb = *(const f32x4*)(gate_b + z * DM + col);
            tot[0] += sigmoidf_(__uint_as_float(gp.x << 16) + gb[0]) * o[0]; tot[1] += sigmoidf_(__uint_as_float(gp.x & 0xffff0000u) + gb[1]) * o[1];
            tot[2] += sigmoidf_(__uint_as_float(gp.y << 16) + gb[2]) * o[2]; tot[3] += sigmoidf_(__uint_as_float(gp.y & 0xffff0000u) + gb[3]) * o[3]; }
        *(u32x2*)(MGB + row * DM + col) = pk4(tot); }
}
template <int K> __device__ __forceinline__ void ph_sk_res(const Ctx& c, int base, int ncu, const bf16_t* __restrict__ A, const bf16_t* __restrict__ W, const float* __restrict__ R, float* __restrict__ Y) {
    const int r = c.lane & 15, q = c.lane >> 4, w = c.wave;
    SKINNY_LOOP(DM / 16) { const f32x4 o = skinny_one<K, K, K>(c, A + (size_t)MP * K, W + (size_t)(s * 16) * K, s);
        const size_t off = (size_t)(MP + w * 16 + r) * DM + s * 16 + q * 4; *(f32x4*)(Y + off) = *(const f32x4*)(R + off) * ALPHA + o; }
}
__device__ __forceinline__ void ph_sk_gu(const Ctx& c, int base, int ncu, const bf16_t* __restrict__ X1B, const bf16_t* __restrict__ W, bf16_t* __restrict__ ACT) {
    const int r = c.lane & 15, q = c.lane >> 4, w = c.wave;
    SKINNY_LOOP(DFF / 16) { const int t = s >> 3, j0 = (s & 7) * 16; f32x4 o[2];
        skinny_pair<DM, DM, DM>(c, X1B + (size_t)MP * DM, W + (size_t)(t * 256 + j0) * DM, W + (size_t)(t * 256 + 128 + j0) * DM, o, s);
        f32x4 v;
#pragma unroll
        for (int j = 0; j < 4; ++j) v[j] = o[0][j] * sigmoidf_(o[0][j]) * o[1][j];
        *(u32x2*)(ACT + (size_t)(MP + w * 16 + r) * DFF + t * 128 + j0 + q * 4) = pk4(v); }
}
#undef SKINNY_LOOP

constexpr int LDS_BAR_OFF = 147456;
constexpr int LDS_BYTES = LDS_BAR_OFF + 64;
struct Args { const float* in[37]; float* out; unsigned char* ws; };

typedef pg8::Gemm<DM, DM, DM, 2, 8, NL, 1, false, 0, 0, (long)DM * DM, 0> GemmMem;
typedef pg8::Gemm<DM, DM, DM, MP / 256, NINP / 256> GemmIn;
typedef pg8::Gemm<NINP, 1024, 256, PS / 256, 1, 8, 4, false, (long)PS * NINP, 256, 256 * 1024, 256> GemmScore;
typedef pg8::Gemm<256, 256, 256, PS / 256, 1, 8, 4, false, (long)4 * 4096 * 256, (long)4096 * 256, 4 * 65536, 65536> GemmPV;
typedef pg8::Gemm<BW, BW, BW, MP / 256, DM / 256, 4, 1, true, (long)MPAD * BW, 0, (long)DM * BW, 0> GemmBranch;
typedef pg8::Gemm<DM, DM, DM, MP / 256, DM / 256> GemmOut;
typedef pg8::Gemm<DM, DM, DM, MP / 256, 2 * DFF / 256> GemmGU;
typedef pg8::Gemm<DFF, DFF, DFF, MP / 256, DM / 256> GemmDown;
template <class GT> __device__ __forceinline__ GT mk_gemm(const Ctx& c, const bf16_t* A, const bf16_t* B) { GT g; g.A = A; g.B = B; g.G = c.G; g.c = c.bid; return g; }

template <int OFF> __device__ __forceinline__ unsigned long long karg_u64(unsigned long long kargs) {
    unsigned long long p; asm volatile("s_load_dwordx2 %0, %1, %2\n\ts_waitcnt lgkmcnt(0)" : "=s"(p) : "s"(kargs), "n"(OFF) : "memory"); return p;
}
#define GPTR(T, x) ((T*)(__attribute__((address_space(1))) T*)(x))
#define INP(k) GPTR(const float, karg_u64<(k) * 8>(kargs))
#define OUTP() GPTR(float, karg_u64<37 * 8>(kargs))
#define WSP() GPTR(unsigned char, karg_u64<38 * 8>(kargs))

__global__ void __launch_bounds__(512, 2) mega_fwd(Args a_unused) {
    extern __shared__ __attribute__((aligned(16))) unsigned char lds_raw[];
    const unsigned long long kargs = (unsigned long long)__builtin_amdgcn_kernarg_segment_ptr();
    Ctx c0; c0.tid = threadIdx.x; c0.lane = c0.tid & 63; c0.wave = __builtin_amdgcn_readfirstlane(c0.tid >> 6); c0.bid = blockIdx.x; c0.G = gridDim.x; c0.lds = (LAS unsigned char*)lds_raw;
    if (c0.tid < 4) ((LAS unsigned*)(c0.lds + LDS_BAR_OFF))[c0.tid] = 0u;
    __syncthreads();
    const XcdBarrier bar = xcd_barrier_post((unsigned*)(WSP() + WS_CTL), (volatile LAS unsigned*)(c0.lds + LDS_BAR_OFF));

#define WPREP_LAYER(cc_, L_) do { unsigned char* ws_ = WSP(); \
      ph_wprep(cc_, INP(10) + (size_t)(L_) * DM * NIN, (bf16_t*)(ws_ + WS_WIN) + (size_t)(L_) * NINP * DM, DM, NIN, NINP, 1, 1, 0, 0); \
      ph_wprep(cc_, INP(29) + (size_t)(L_) * 4 * BW * DM, (bf16_t*)(ws_ + WS_WBR) + (size_t)(L_) * 4 * DM * BW, BW, DM, DM, 0, 4, (size_t)BW * DM, (size_t)DM * BW); \
      ph_wprep(cc_, INP(30) + (size_t)(L_) * DM * DM, (bf16_t*)(ws_ + WS_WOUT) + (size_t)(L_) * DM * DM, DM, DM, DM, 0, 1, 0, 0); \
      ph_wprep(cc_, INP(33) + (size_t)(L_) * DM * 2 * DFF, (bf16_t*)(ws_ + WS_WGU) + (size_t)(L_) * 2 * DFF * DM, DM, 2 * DFF, 2 * DFF, 2, 1, 0, 0); \
      ph_wprep(cc_, INP(34) + (size_t)(L_) * DFF * DM, (bf16_t*)(ws_ + WS_WDN) + (size_t)(L_) * DM * DFF, DFF, DM, DM, 0, 1, 0, 0); } while (0)
    { const Ctx c = fresh(c0); unsigned char* ws = WSP();
      ph_wprep(c, INP(28), (bf16_t*)(ws + WS_WMEM), DM, DM, DM, 0, NL, (size_t)DM * DM, (size_t)DM * DM);
      WPREP_LAYER(c, 0);
      ph_lrw(c, INP(19), INP(21), INP(22), (bf16_t*)(ws + WS_LRW));
      ph_xprep(c, INP(0), INP(1), INP(2), (float*)(ws + WS_HF), (bf16_t*)(ws + WS_HB), (bf16_t*)(ws + WS_MEMB)); }
    xcd_barrier(bar);
    { const Ctx c = fresh(c0); unsigned char* ws = WSP(); float* out = OUTP();
      GemmMem g = mk_gemm<GemmMem>(c, (const bf16_t*)(ws + WS_MEMB), (const bf16_t*)(ws + WS_WMEM));
      pg8::EpiMem E; E.outK = out + O_MKP; E.outV = out + O_MVP; E.kb = (bf16_t*)(ws + WS_MKB); E.vt = (bf16_t*)(ws + WS_MVT); pg8::gemm_phase<GemmMem, pg8::EpiMem, true, true>(c.lds, c.tid, g, E); }

    for (int l = 0; l < NL; ++l) {
        { const Ctx c = fresh(c0); unsigned char* ws = WSP();
          GemmIn g = mk_gemm<GemmIn>(c, (const bf16_t*)(ws + WS_HB), (const bf16_t*)(ws + WS_WIN) + (size_t)l * NINP * DM);
          pg8::EpiBf16 E; E.O = (bf16_t*)(ws + WS_U); E.zs = 0; E.ldc = NINP; E.pad = 0; pg8::gemm_phase<GemmIn, pg8::EpiBf16, true, true>(c.lds, c.tid, g, E); }
        { const Ctx c = fresh(c0); unsigned char* ws = WSP(); ph_sk_in(c, c.G > 192 ? 96 : 0, c.G > 192 ? c.G - 96 : c.G, (const bf16_t*)(ws + WS_HB), (const bf16_t*)(ws + WS_WIN) + (size_t)l * NINP * DM, (bf16_t*)(ws + WS_U)); }
        xcd_barrier(bar);
        { const Ctx c = fresh(c0); unsigned char* ws = WSP(); float* out = OUTP(); const bf16_t* U = (const bf16_t*)(ws + WS_U); bf16_t* BR = (bf16_t*)(ws + WS_BR);
          (void)out; (void)BR;
          ph_gla_pre(c, U, INP(12) + (size_t)l * 16 * 512, INP(13) + (size_t)l * 512, (bf16_t*)(ws + WS_GLQD), (bf16_t*)(ws + WS_GLKH), (bf16_t*)(ws + WS_GLE), (bf16_t*)(ws + WS_GLVT), (float*)(ws + WS_GLGC)); }
        { const Ctx c = fresh(c0); unsigned char* ws = WSP();
          ph_rwkv_pre(c, (const bf16_t*)(ws + WS_U), INP(9) + (size_t)l * SB * RWC, INP(17) + (size_t)l * RWC, INP(18) + (size_t)l * BW, INP(19) + (size_t)l * 64 * BW, INP(20) + (size_t)l * BW, INP(21) + (size_t)l * 64 * BW,
                       INP(22) + (size_t)l * 128 * BW, INP(23) + (size_t)l * BW, INP(24) + (size_t)l * BW, INP(25) + (size_t)l * BW, (float*)(ws + WS_RW), (bf16_t*)(ws + WS_RB), (const bf16_t*)(ws + WS_LRW) + (size_t)l * 1024 * 256); }
        { const Ctx c = fresh(c0); unsigned char* ws = WSP();
          GemmScore g = mk_gemm<GemmScore>(c, (const bf16_t*)(ws + WS_U) + U_MQ, (const bf16_t*)(ws + WS_MKB) + (size_t)l * 512 * 1024); g.c = (c.bid + c.G / 2) % c.G;
          pg8::EpiScore E; E.SC = (float*)(ws + WS_SC); pg8::gemm_phase<GemmScore, pg8::EpiScore, true, true>(c.lds, c.tid, g, E); }
        xcd_barrier(bar);
        { const Ctx c = fresh(c0); unsigned char* ws = WSP(); float* out = OUTP();
          ph_rwkv_seq(c, 64, (const bf16_t*)(ws + WS_RB), INP(8) + (size_t)l * SB * 16 * 4096, out + O_RWP + (size_t)l * PB * 16 * 4096, out + O_RWS + (size_t)l * SB * 16 * 4096,
                      (bf16_t*)(ws + WS_RAW) + (size_t)MPAD * BW); }
        { const Ctx c = fresh(c0); unsigned char* ws = WSP(); float* out = OUTP();
          ph_gla_seq(c, 32, (const bf16_t*)(ws + WS_GLQD), (const bf16_t*)(ws + WS_GLKH), (const bf16_t*)(ws + WS_GLE), (const bf16_t*)(ws + WS_GLVT), (const float*)(ws + WS_GLGC),
                     INP(7) + (size_t)l * SB * 4 * 32768, out + O_GLAP + (size_t)l * PB * 4 * 32768, out + O_GLAS + (size_t)l * SB * 4 * 32768, (bf16_t*)(ws + WS_RAW)); }
        if ((c0.bid < 32 || c0.bid >= 96) && c0.G > 96) {
        { Ctx c = fresh(c0); c.bid = c.bid < 32 ? c.bid : c.bid - 64; c.G = c.G - 64; unsigned char* ws = WSP(); ph_softmax256(c, (const float*)(ws + WS_SC), (bf16_t*)(ws + WS_PB), 8 * 4096); }
        { Ctx c = fresh(c0); c.bid = c.bid < 32 ? c.bid : c.bid - 64; c.G = c.G - 64; unsigned char* ws = WSP(); ph_swa_prompt(c, (const bf16_t*)(ws + WS_U), INP(16) + (size_t)l * 16, (bf16_t*)(ws + WS_BR) + (size_t)MPAD * BW); }
        { Ctx c = fresh(c0); c.bid = c.bid < 32 ? c.bid : c.bid - 64; c.G = c.G - 64; unsigned char* ws = WSP();
          ph_swa_sample(c, (const bf16_t*)(ws + WS_U), INP(3) + (size_t)l * SB * 16384, INP(4) + (size_t)l * SB * 16384, INP(16) + (size_t)l * 16, (bf16_t*)(ws + WS_BR) + (size_t)MPAD * BW); }
        { Ctx c = fresh(c0); c.bid = c.bid < 32 ? c.bid : c.bid - 64; c.G = c.G - 64; unsigned char* ws = WSP();
          ph_memattn_sample(c, (const bf16_t*)(ws + WS_U), INP(5) + (size_t)l * SB * MEMT * 1024, INP(6) + (size_t)l * SB * MEMT * 1024, (bf16_t*)(ws + WS_BR) + (size_t)3 * MPAD * BW); }
        { Ctx c = fresh(c0); c.bid = c.bid < 32 ? c.bid : c.bid - 64; c.G = c.G - 64; unsigned char* ws = WSP();
          ph_copy_outs(c, (const bf16_t*)(ws + WS_U), INP(3) + (size_t)l * SB * 16384, INP(4) + (size_t)l * SB * 16384, OUTP(), l); }
          if (l + 1 < NL) { Ctx c = fresh(c0); c.bid = c.bid < 32 ? c.bid : c.bid - 64; c.G = c.G - 64; WPREP_LAYER(c, l + 1); }
        }
        xcd_barrier(bar);
        { const Ctx c = fresh(c0); unsigned char* ws = WSP(); ph_rwkv_fin(c, (const float*)(ws + WS_RW), INP(26) + (size_t)l * BW, INP(27) + (size_t)l * BW, (const bf16_t*)(ws + WS_RAW) + (size_t)MPAD * BW, (bf16_t*)(ws + WS_BR) + (size_t)2 * MPAD * BW); }
        { const Ctx c = fresh(c0); unsigned char* ws = WSP(); ph_gla_fin(c, (const bf16_t*)(ws + WS_U), INP(14) + (size_t)l * BW, INP(15) + (size_t)l * BW, (const bf16_t*)(ws + WS_RAW), (bf16_t*)(ws + WS_BR)); }
        { const Ctx c = fresh(c0); unsigned char* ws = WSP();
          GemmPV g = mk_gemm<GemmPV>(c, (const bf16_t*)(ws + WS_PB), (const bf16_t*)(ws + WS_MVT) + (size_t)l * 8 * 65536);
          pg8::EpiPV E; E.O = (bf16_t*)(ws + WS_BR) + (size_t)3 * MPAD * BW; pg8::gemm_phase<GemmPV, pg8::EpiPV, true, true>(c.lds, c.tid, g, E); }
        xcd_barrier(bar);
        { const Ctx c = fresh(c0); unsigned char* ws = WSP();
          GemmBranch g = mk_gemm<GemmBranch>(c, (const bf16_t*)(ws + WS_BR), (const bf16_t*)(ws + WS_WBR) + (size_t)l * 4 * DM * BW);
          pg8::EpiMerge E; E.MG = (float*)(ws + WS_MG); E.MGB = (bf16_t*)(ws + WS_MGB); E.U = (const bf16_t*)(ws + WS_U); E.gate_b = INP(11) + (size_t)l * 4 * DM; pg8::gemm_phase<GemmBranch, pg8::EpiMerge, true, true>(c.lds, c.tid, g, E); }
        { const Ctx c = fresh(c0); unsigned char* ws = WSP(); ph_sk_merge(c, 0, c.G, (const bf16_t*)(ws + WS_BR), (const bf16_t*)(ws + WS_WBR) + (size_t)l * 4 * DM * BW, (const bf16_t*)(ws + WS_U), INP(11) + (size_t)l * 4 * DM, (bf16_t*)(ws + WS_MGB)); }
        xcd_barrier(bar);
        { const Ctx c = fresh(c0); unsigned char* ws = WSP();
          GemmOut g = mk_gemm<GemmOut>(c, (const bf16_t*)(ws + WS_MGB), (const bf16_t*)(ws + WS_WOUT) + (size_t)l * DM * DM);
          pg8::EpiRes E; E.R = (const float*)(ws + WS_HF); E.Y = (float*)(ws + WS_Y); pg8::gemm_phase<GemmOut, pg8::EpiRes, true, true>(c.lds, c.tid, g, E); }
        { const Ctx c = fresh(c0); unsigned char* ws = WSP(); ph_sk_res<DM>(c, c.G > 192 ? 128 : 0, c.G > 192 ? c.G - 128 : c.G, (const bf16_t*)(ws + WS_MGB), (const bf16_t*)(ws + WS_WOUT) + (size_t)l * DM * DM, (const float*)(ws + WS_HF), (float*)(ws + WS_Y)); }
        xcd_barrier(bar);
        { const Ctx c = fresh(c0); unsigned char* ws = WSP(); ph_ln(c, (const float*)(ws + WS_Y), INP(31) + (size_t)l * DM, INP(32) + (size_t)l * DM, (float*)(ws + WS_X1F), (bf16_t*)(ws + WS_X1B), nullptr, MT, 0); }
        xcd_barrier(bar);
        { const Ctx c = fresh(c0); unsigned char* ws = WSP();
          GemmGU g = mk_gemm<GemmGU>(c, (const bf16_t*)(ws + WS_X1B), (const bf16_t*)(ws + WS_WGU) + (size_t)l * 2 * DFF * DM);
          pg8::EpiSwiGLU E; E.O = (bf16_t*)(ws + WS_ACT); pg8::gemm_phase<GemmGU, pg8::EpiSwiGLU, true, true>(c.lds, c.tid, g, E); }
        { const Ctx c = fresh(c0); unsigned char* ws = WSP(); ph_sk_gu(c, c.G > 192 ? 128 : 0, c.G > 192 ? c.G - 128 : c.G, (const bf16_t*)(ws + WS_X1B), (const bf16_t*)(ws + WS_WGU) + (size_t)l * 2 * DFF * DM, (bf16_t*)(ws + WS_ACT)); }
        xcd_barrier(bar);
        { const Ctx c = fresh(c0); unsigned char* ws = WSP();
          GemmDown g = mk_gemm<GemmDown>(c, (const bf16_t*)(ws + WS_ACT), (const bf16_t*)(ws + WS_WDN) + (size_t)l * DM * DFF);
          pg8::EpiRes E; E.R = (const float*)(ws + WS_X1F); E.Y = (float*)(ws + WS_Y); pg8::gemm_phase<GemmDown, pg8::EpiRes, true, true>(c.lds, c.tid, g, E); }
        { const Ctx c = fresh(c0); unsigned char* ws = WSP(); ph_sk_res<DFF>(c, 0, c.G, (const bf16_t*)(ws + WS_ACT), (const bf16_t*)(ws + WS_WDN) + (size_t)l * DM * DFF, (const float*)(ws + WS_X1F), (float*)(ws + WS_Y)); }
        xcd_barrier(bar);
        { const Ctx c = fresh(c0); unsigned char* ws = WSP(); float* out = OUTP(); ph_ln(c, (const float*)(ws + WS_Y), INP(35) + (size_t)l * DM, INP(36) + (size_t)l * DM, (float*)(ws + WS_HF), (bf16_t*)(ws + WS_HB), l == NL - 1 ? out : nullptr, MT, MT); }
        xcd_barrier(bar);
    }
}

extern "C" void kernel_launch(void* const* d_in, const int* in_sizes, int n_in, void* d_out, int out_size, void* d_ws, size_t ws_size, hipStream_t stream) {
    static int grid = 0;
    if (grid == 0) {
        if (n_in != 37 || (size_t)out_size != O_END || ws_size < WS_END) { fprintf(stderr, "kernel_launch: unexpected sizes (n_in %d out %d ws %zu need %zu)\n", n_in, out_size, ws_size, (size_t)WS_END); grid = -1; return; }
        int dev = 0, cus = 0;
        if (hipGetDevice(&dev) != hipSuccess || hipDeviceGetAttribute(&cus, hipDeviceAttributeMultiprocessorCount, dev) != hipSuccess) { grid = -1; return; }
        if (hipFuncSetAttribute((const void*)mega_fwd, hipFuncAttributeMaxDynamicSharedMemorySize, LDS_BYTES) != hipSuccess) { fprintf(stderr, "kernel_launch: hipFuncSetAttribute failed\n"); grid = -1; return; }
        int per_cu = 0;
        if (hipOccupancyMaxActiveBlocksPerMultiprocessor(&per_cu, (const void*)mega_fwd, 512, LDS_BYTES) != hipSuccess || per_cu < 1) { fprintf(stderr, "kernel_launch: occupancy query says %d\n", per_cu); }
        (void)hipGetLastError();
        grid = cus;
    }
    if (grid < 0) return;
    (void)hipMemsetAsync((unsigned char*)d_ws + WS_CTL, 0, XCD_BAR_WORDS * sizeof(unsigned), stream);
    Args a; memset(&a, 0, sizeof a);
    for (int i = 0; i < 37; ++i) a.in[i] = (const float*)d_in[i];
    a.out = (float*)d_out; a.ws = (unsigned char*)d_ws;
    hipLaunchKernelGGL(mega_fwd, dim3(grid), dim3(512), LDS_BYTES, stream, a);
}
```

```cpp
#include <hip/hip_runtime.h>
#include <cstdio>
#include <cstdint>
#include <cstring>

#define LAS __attribute__((address_space(3)))
typedef unsigned short bf16_t;
typedef short bf16x8 __attribute__((ext_vector_type(8)));
typedef float f32x4 __attribute__((ext_vector_type(4)));
typedef float f32x2 __attribute__((ext_vector_type(2)));
typedef unsigned u32x4 __attribute__((ext_vector_type(4)));
typedef unsigned u32x2 __attribute__((ext_vector_type(2)));

constexpr int DM = 2048, NL = 4;
constexpr int PB = 2, PS = 4096, MP = PB * PS;
constexpr int SB = 32, SS = 4, MS = SB * SS;
constexpr int MT = MP + MS;
constexpr int MPAD = 8448;
constexpr int NIN = 16912, NINP = 17152;
constexpr int U_GQ = 0, U_GK = 512, U_GV = 1024, U_GR = 2048, U_GA = 3072, U_SQ = 3328, U_SK = 4352, U_SV = 4480, U_RU = 4608, U_MQ = 7936, U_GP = 8960;
constexpr int RWC = 3328, BW = 1024, DFF = 5632, MEMT = 256;
constexpr float ALPHA = 1.681792830507429f;

constexpr size_t O_YP = 0;
constexpr size_t O_YS = O_YP + (size_t)MP * DM;
constexpr size_t O_SWKP = O_YS + (size_t)MS * DM;
constexpr size_t O_SWVP = O_SWKP + (size_t)NL * PB * 128 * 128;
constexpr size_t O_MKP = O_SWVP + (size_t)NL * PB * 128 * 128;
constexpr size_t O_MVP = O_MKP + (size_t)NL * PB * 256 * 1024;
constexpr size_t O_GLAP = O_MVP + (size_t)NL * PB * 256 * 1024;
constexpr size_t O_RWP = O_GLAP + (size_t)NL * PB * 4 * 128 * 256;
constexpr size_t O_RSP = O_RWP + (size_t)NL * PB * 16 * 64 * 64;
constexpr size_t O_SWKS = O_RSP + (size_t)NL * PB * RWC;
constexpr size_t O_SWVS = O_SWKS + (size_t)NL * SB * 128 * 128;
constexpr size_t O_GLAS = O_SWVS + (size_t)NL * SB * 128 * 128;
constexpr size_t O_RWS = O_GLAS + (size_t)NL * SB * 4 * 128 * 256;
constexpr size_t O_RSS = O_RWS + (size_t)NL * SB * 16 * 64 * 64;
constexpr size_t O_END = O_RSS + (size_t)NL * SB * RWC;
static_assert(O_END == 52881408, "output size");

constexpr size_t al256(size_t x) { return (x + 255) & ~(size_t)255; }
constexpr size_t WS_CTL = 0;
constexpr size_t WS_WIN = 65536;
constexpr size_t WS_WMEM = WS_WIN + (size_t)NL * NINP * DM * 2;
constexpr size_t WS_WBR = WS_WMEM + (size_t)NL * DM * DM * 2;
constexpr size_t WS_WOUT = WS_WBR + (size_t)NL * 4 * DM * BW * 2;
constexpr size_t WS_WGU = WS_WOUT + (size_t)NL * DM * DM * 2;
constexpr size_t WS_WDN = WS_WGU + (size_t)NL * 2 * DFF * DM * 2;
constexpr size_t WS_HF = WS_WDN + (size_t)NL * DM * DFF * 2;
constexpr size_t WS_HB = WS_HF + (size_t)MPAD * DM * 4;
constexpr size_t WS_U = WS_HB + (size_t)MPAD * DM * 2;
constexpr size_t WS_BR = WS_U + (size_t)MPAD * NINP * 2;
constexpr size_t WS_MG = WS_BR + (size_t)4 * MPAD * BW * 2;
constexpr size_t WS_MGB = WS_MG + (size_t)MPAD * DM * 4;
constexpr size_t WS_Y = WS_MGB + (size_t)MPAD * DM * 2;
constexpr size_t WS_X1F = WS_Y + (size_t)MPAD * DM * 4;
constexpr size_t WS_X1B = WS_X1F + (size_t)MPAD * DM * 4;
constexpr size_t WS_ACT = WS_X1B + (size_t)MPAD * DM * 2;
constexpr size_t WS_MEMB = WS_ACT + (size_t)MPAD * DFF * 2;
constexpr size_t WS_MKB = WS_MEMB + (size_t)512 * DM * 2;
constexpr size_t WS_MVT = WS_MKB + (size_t)NL * 512 * 1024 * 2;
constexpr size_t WS_SC = WS_MVT + (size_t)NL * 8 * 256 * 256 * 2;
constexpr size_t WS_PB = WS_SC + (size_t)8 * 4096 * 256 * 4;
constexpr size_t WS_RW = WS_PB + (size_t)8 * 4096 * 256 * 2;
constexpr size_t RW_ARR = (size_t)MPAD * BW * 4;
constexpr int GL_NCH = 512 + 128;
constexpr size_t WS_GLQD = WS_RW + 8 * RW_ARR;
constexpr size_t WS_GLKH = WS_GLQD + (size_t)GL_NCH * 8192 * 2;
constexpr size_t WS_GLE = WS_GLKH + (size_t)GL_NCH * 8192 * 2;
constexpr size_t WS_GLVT = WS_GLE + (size_t)GL_NCH * 4096 * 2;
constexpr size_t WS_GLGC = WS_GLVT + (size_t)GL_NCH * 16384 * 2;
constexpr int RB_NCH = PB * 16 * 256 + SB * 16;
constexpr int RB_EL = 9216;
constexpr int RB_QP = 4608, RB_KHP = 5760, RB_VT = 7296, RB_EP = 8832;
constexpr size_t WS_RB = WS_GLGC + (size_t)GL_NCH * 128 * 4;
constexpr size_t WS_RAW = WS_RB + (size_t)RB_NCH * RB_EL * 2;
constexpr size_t WS_LRW = WS_RAW + (size_t)2 * MPAD * BW * 2;
constexpr size_t WS_END = WS_LRW + (size_t)NL * 16 * 64 * 256 * 2;

__device__ __forceinline__ float bf2f(bf16_t b) { return __uint_as_float(((unsigned)b) << 16); }
typedef __bf16 bf16v2_t __attribute__((ext_vector_type(2)));
__device__ __forceinline__ unsigned pk2(float lo, float hi) { const f32x2 v = {lo, hi}; return __builtin_bit_cast(unsigned, __builtin_convertvector(v, bf16v2_t)); }
__device__ __forceinline__ bf16_t f2bf(float f) { return (bf16_t)(pk2(f, 0.f) & 0xffffu); }
__device__ __forceinline__ float wave_sum(float v) {
#pragma unroll
    for (int o = 32; o > 0; o >>= 1) v += __shfl_xor(v, o, 64);
    return v;
}
__device__ __forceinline__ float wave_max(float v) {
#pragma unroll
    for (int o = 32; o > 0; o >>= 1) v = fmaxf(v, __shfl_xor(v, o, 64));
    return v;
}
__device__ __forceinline__ float sigmoidf_(float x) { return 1.0f / (1.0f + __expf(-x)); }
__device__ __forceinline__ float softplusf_(float x) { return fmaxf(x, 0.f) + log1pf(__expf(-fabsf(x))); }
__device__ __forceinline__ float softplus_fast(float x) { return fmaxf(x, 0.f) + __logf(1.0f + __expf(-fabsf(x))); }
__device__ __forceinline__ float tanh_fast(float x) { return 1.0f - 2.0f / (1.0f + __expf(2.0f * x)); }

namespace pg8 {
constexpr int BM = 256, BK = 64, HALF = 128, HTB = HALF * BK * 2, STAGE_BYTES = 8 * HTB, NXCD = 8, WGM = 8;
__host__ __device__ __forceinline__ int lds_byte(int r, int c) { const int st = (r >> 4) * 2 + (c >> 5), rr = r & 15, cc = c & 31, ob = rr * 64 + cc * 2; return st * 1024 + (ob ^ (((ob >> 9) & 1) << 5)); }
__host__ __device__ __forceinline__ void stage_rc(int b, int& R, int& C) { const int st = b / 1024, sb = b % 1024, swz = sb ^ (((sb >> 9) & 1) << 5); R = (st >> 1) * 16 + swz / 64; C = (st & 1) * 32 + (swz % 64) / 2; }
__host__ __device__ __forceinline__ int perm32(int rho) { const int n = rho >> 4, i = rho & 15; return 8 * (i >> 2) + 4 * n + (i & 3); }

struct Unit { int pm, pn, z; };
template <int LDA_, int LDB_, int K_, int NM_, int NN_, int NZ_ = 1, int NZH_ = 1, bool ZINNER_ = false, long ZSAB_ = 0, long ZSAH_ = 0, long ZSBB_ = 0, long ZSBH_ = 0>
struct Gemm {
    static constexpr int LDA = LDA_, LDB = LDB_, K = K_, NM = NM_, NN = NN_, NZ = NZ_, NZH = NZH_; static constexpr bool ZINNER = ZINNER_;
    const bf16_t* A; const bf16_t* B; int G, c;
    __device__ __forceinline__ bool next(int i, Unit& u) const {
        constexpr int nt = NM * NN; int L, z;
        if (ZINNER) { const int it = i / NZ; z = i - it * NZ; const long LL = (long)it * G + c; if (LL >= nt) return false; L = (int)LL; }
        else { const long LL = (long)i * G + c; if (LL >= (long)nt * NZ) return false; z = (int)(LL / nt); L = (int)(LL - (long)z * nt); }
        int wgid = L; { constexpr int q = nt / NXCD, r = nt % NXCD; const int xcd = wgid % NXCD, off = wgid / NXCD; wgid = (xcd < r ? xcd * (q + 1) : r * (q + 1) + (xcd - r) * q) + off; }
        constexpr int nig = WGM * NN; const int gid = wgid / nig, fm = gid * WGM, gsz = (NM - fm) < WGM ? (NM - fm) : WGM;
        u.pm = fm + ((wgid % nig) % gsz); u.pn = (wgid % nig) / gsz; u.z = z; return true;
    }
    __device__ __forceinline__ const char* a_base(const Unit& u) const { const int zb = u.z / NZH, zh = u.z - zb * NZH; return (const char*)(A + zb * ZSAB_ + zh * ZSAH_ + (long)u.pm * BM * LDA); }
    __device__ __forceinline__ const char* b_base(const Unit& u) const { const int zb = u.z / NZH, zh = u.z - zb * NZH; return (const char*)(B + zb * ZSBB_ + zh * ZSBH_ + (long)u.pn * BM * LDB); }
};

template <class GT, class Epi, bool ALIGN_EPI = true, bool SP2 = true>
__device__ __forceinline__ void gemm_phase(LAS unsigned char* lds, const int tid, const GT& g, const Epi& E) {
    const int wid = __builtin_amdgcn_readfirstlane(tid >> 6), lane = tid & 63, wr = wid >> 2, wc = wid & 3, fr = lane & 15, fq = lane >> 4;
    constexpr int nt = GT::K / BK;
    unsigned voffA[2], voffB[2];
#pragma unroll
    for (int i = 0; i < 2; ++i) { int R, C; stage_rc(tid * 16 + i * 8192, R, C); const int Rb = Epi::PERM ? ((R & ~31) + perm32(R & 31)) : R;
        voffA[i] = (unsigned)(R * GT::LDA + C) * 2u; voffB[i] = (unsigned)(Rb * GT::LDB + C) * 2u; }
    constexpr size_t kstep = (size_t)(BK * 2);
    constexpr size_t hstepA = (size_t)HALF * GT::LDA * 2, hstepB = (size_t)HALF * GT::LDB * 2;
    const unsigned ldsw = (unsigned)wid * 1024u;
    const int aoff = lds_byte(wr * 64 + fr, fq * 8), boff = lds_byte(wc * 32 + fr, fq * 8);
#define PG8_SA(b, h) (((b) * 2 + (h)) * HTB)
#define PG8_SB(b, h) ((4 + (b) * 2 + (h)) * HTB)
#define PG8_STAGE(bufoff, gbase, voff) do { _Pragma("unroll") for (int _i = 0; _i < 2; ++_i) \
        __builtin_amdgcn_global_load_lds((const unsigned*)((const char*)(gbase) + (voff)[_i]), (LAS unsigned*)(lds + (bufoff) + ldsw + _i * 8192), 16, 0, 0); } while (0)
#define PG8_LDA(dst, b, h) do { _Pragma("unroll") for (int m = 0; m < 4; ++m) _Pragma("unroll") for (int k = 0; k < 2; ++k) dst[m][k] = *(const LAS bf16x8*)(lds + PG8_SA(b, h) + aoff + m * 2048 + k * 1024); } while (0)
#define PG8_LDB(dst, b, h) do { _Pragma("unroll") for (int n = 0; n < 2; ++n) _Pragma("unroll") for (int k = 0; k < 2; ++k) dst[n][k] = *(const LAS bf16x8*)(lds + PG8_SB(b, h) + boff + n * 2048 + k * 1024); } while (0)
#define PG8_MMA(ai, bj, At, Bt) do { __builtin_amdgcn_s_setprio(1); _Pragma("unroll") for (int m = 0; m < 4; ++m) _Pragma("unroll") for (int n = 0; n < 2; ++n) _Pragma("unroll") for (int k = 0; k < 2; ++k) \
        acc[ai][bj][m][n] = __builtin_amdgcn_mfma_f32_16x16x32_bf16(Bt[n][k], At[m][k], acc[ai][bj][m][n], 0, 0, 0); __builtin_amdgcn_s_setprio(0); } while (0)
#define PG8_WAIT_V(n) asm volatile("s_waitcnt vmcnt(" #n ")" ::: "memory")
#define PG8_WAIT_L(n) asm volatile("s_waitcnt lgkmcnt(" #n ")" ::: "memory")
#define PG8_BAR __builtin_amdgcn_s_barrier()
#define PG8_SCHED __builtin_amdgcn_sched_barrier(0)
    Unit cur, nxt; int ui = 0;
    if (!g.next(0, cur)) return;
    f32x4 acc[2][2][4][2];
#pragma unroll
    for (int a = 0; a < 2; ++a)
#pragma unroll
        for (int b = 0; b < 2; ++b)
#pragma unroll
            for (int m = 0; m < 4; ++m)
#pragma unroll
                for (int n = 0; n < 2; ++n) acc[a][b][m][n] = (f32x4){0.f, 0.f, 0.f, 0.f};
    bf16x8 At[4][2], B0[2][2], B1[2][2];
    const char* cA = g.a_base(cur); const char* cB = g.b_base(cur);
    if constexpr (SP2) {
        PG8_STAGE(PG8_SB(0, 0), cB, voffB); PG8_STAGE(PG8_SB(0, 1), cB + hstepB, voffB); PG8_STAGE(PG8_SA(0, 0), cA, voffA); PG8_STAGE(PG8_SA(0, 1), cA + hstepA, voffA);
        if (wr == 1) PG8_BAR;
        PG8_WAIT_V(2); PG8_BAR;
        PG8_STAGE(PG8_SB(1, 0), cB + kstep, voffB); PG8_STAGE(PG8_SA(1, 0), cA + kstep, voffA); PG8_STAGE(PG8_SB(1, 1), cB + hstepB + kstep, voffB);
        PG8_WAIT_V(6); PG8_BAR;
    } else {
        PG8_STAGE(PG8_SB(0, 0), cB, voffB); PG8_STAGE(PG8_SA(0, 0), cA, voffA); PG8_STAGE(PG8_SB(0, 1), cB + hstepB, voffB); PG8_STAGE(PG8_SA(0, 1), cA + hstepA, voffA);
        if (wr == 1) PG8_BAR;
        PG8_WAIT_V(4); PG8_BAR;
        PG8_STAGE(PG8_SB(1, 0), cB + kstep, voffB); PG8_STAGE(PG8_SA(1, 0), cA + kstep, voffA); PG8_STAGE(PG8_SB(1, 1), cB + hstepB + kstep, voffB);
        PG8_WAIT_V(6); PG8_BAR;
    }
    for (;;) {
        const bool has_next = g.next(ui + 1, nxt);
        const char* nA = has_next ? g.a_base(nxt) : cA; const char* nB = has_next ? g.b_base(nxt) : cB;
#pragma unroll 1
        for (int t = 0; t < nt; t += 2) {
            const bool last = (t == nt - 2);
            const char* a1 = cA + (size_t)(t + 1) * kstep;
            const char* a2 = last ? nA : cA + (size_t)(t + 2) * kstep; const char* b2 = last ? nB : cB + (size_t)(t + 2) * kstep;
            const char* a3 = a2 + kstep; const char* b3 = b2 + kstep;
            if constexpr (SP2) {
            PG8_LDB(B0, 0, 0); PG8_LDB(B1, 0, 1); PG8_SCHED; PG8_LDA(At, 0, 0); PG8_STAGE(PG8_SA(1, 1), a1 + hstepA, voffA);
            PG8_WAIT_V(8); PG8_WAIT_L(0); PG8_BAR; PG8_MMA(0, 0, At, B0); PG8_MMA(0, 1, At, B1); PG8_BAR; PG8_SCHED;
            PG8_LDA(At, 0, 1); PG8_STAGE(PG8_SB(0, 0), b2, voffB); PG8_STAGE(PG8_SB(0, 1), b2 + hstepB, voffB); PG8_STAGE(PG8_SA(0, 0), a2, voffA);
            PG8_WAIT_V(8); PG8_WAIT_L(0); PG8_BAR; PG8_MMA(1, 0, At, B0); PG8_MMA(1, 1, At, B1); PG8_BAR; PG8_SCHED;
            PG8_LDB(B0, 1, 0); PG8_LDB(B1, 1, 1); PG8_SCHED; PG8_LDA(At, 1, 0); PG8_STAGE(PG8_SA(0, 1), a2 + hstepA, voffA);
            PG8_WAIT_V(8); PG8_WAIT_L(0); PG8_BAR; PG8_MMA(0, 0, At, B0); PG8_MMA(0, 1, At, B1); PG8_BAR; PG8_SCHED;
            PG8_LDA(At, 1, 1); PG8_STAGE(PG8_SB(1, 0), b3, voffB); PG8_STAGE(PG8_SB(1, 1), b3 + hstepB, voffB); PG8_STAGE(PG8_SA(1, 0), a3, voffA);
            PG8_WAIT_V(8); PG8_WAIT_L(0); PG8_BAR; PG8_MMA(1, 0, At, B0); PG8_MMA(1, 1, At, B1); PG8_BAR; PG8_SCHED;
            } else {
            PG8_LDB(B0, 0, 0); PG8_SCHED; PG8_LDA(At, 0, 0); PG8_STAGE(PG8_SA(1, 1), a1 + hstepA, voffA);
            PG8_WAIT_L(8); PG8_BAR; PG8_WAIT_L(0); PG8_MMA(0, 0, At, B0); PG8_BAR; PG8_SCHED;
            PG8_LDB(B1, 0, 1); PG8_STAGE(PG8_SB(0, 0), b2, voffB);
            PG8_BAR; PG8_WAIT_L(0); PG8_MMA(0, 1, At, B1); PG8_BAR;
            PG8_LDA(At, 0, 1); PG8_STAGE(PG8_SA(0, 0), a2, voffA);
            PG8_BAR; PG8_WAIT_L(0); PG8_MMA(1, 0, At, B0); PG8_BAR; PG8_SCHED;
            PG8_STAGE(PG8_SB(0, 1), b2 + hstepB, voffB);
            PG8_WAIT_V(6); PG8_BAR; PG8_MMA(1, 1, At, B1); PG8_BAR;
            PG8_LDB(B0, 1, 0); PG8_SCHED; PG8_LDA(At, 1, 0); PG8_STAGE(PG8_SA(0, 1), a2 + hstepA, voffA);
            PG8_WAIT_L(8); PG8_BAR; PG8_WAIT_L(0); PG8_MMA(0, 0, At, B0); PG8_BAR; PG8_SCHED;
            PG8_LDB(B1, 1, 1); PG8_STAGE(PG8_SB(1, 0), b3, voffB);
            PG8_BAR; PG8_WAIT_L(0); PG8_MMA(0, 1, At, B1); PG8_BAR;
            PG8_LDA(At, 1, 1); PG8_STAGE(PG8_SA(1, 0), a3, voffA);
            PG8_BAR; PG8_WAIT_L(0); PG8_MMA(1, 0, At, B0); PG8_BAR; PG8_SCHED;
            PG8_STAGE(PG8_SB(1, 1), b3 + hstepB, voffB);
            PG8_WAIT_V(6); PG8_BAR; PG8_MMA(1, 1, At, B1); PG8_BAR;
            }
        }
        if constexpr (ALIGN_EPI) { if (wr == 0) PG8_BAR; }
        E(acc, cur, wr, wc, fr, fq);
        if (!has_next) break;
#pragma unroll
        for (int a = 0; a < 2; ++a)
#pragma unroll
            for (int b = 0; b < 2; ++b)
#pragma unroll
                for (int m = 0; m < 4; ++m)
#pragma unroll
                    for (int n = 0; n < 2; ++n) acc[a][b][m][n] = (f32x4){0.f, 0.f, 0.f, 0.f};
        cur = nxt; cA = nA; cB = nB; ++ui;
        if constexpr (ALIGN_EPI) { if (wr == 1) PG8_BAR; }
    }
    PG8_WAIT_V(0);
    if constexpr (!ALIGN_EPI) { if (wr == 0) PG8_BAR; }
    PG8_BAR;
#undef PG8_SA
#undef PG8_SB
#undef PG8_STAGE
#undef PG8_LDA
#undef PG8_LDB
#undef PG8_MMA
#undef PG8_WAIT_V
#undef PG8_WAIT_L
#undef PG8_BAR
#undef PG8_SCHED
}

struct EpiBf16 {
    static constexpr bool PERM = true;
    bf16_t* O; long zs; int ldc, pad;
    __device__ __forceinline__ void operator()(const f32x4 (&acc)[2][2][4][2], const Unit& u, int wr, int wc, int fr, int fq) const {
        const int row0 = u.pm * BM + wr * 64 + fr, col0 = u.pn * BM + wc * 32 + 8 * fq; bf16_t* base = O + (long)u.z * zs;
#pragma unroll
        for (int ai = 0; ai < 2; ++ai)
#pragma unroll
            for (int m = 0; m < 4; ++m) { bf16_t* rowp = base + (size_t)(row0 + ai * HALF + m * 16) * ldc + col0;
#pragma unroll
                for (int bj = 0; bj < 2; ++bj) { const f32x4 v0 = acc[ai][bj][m][0], v1 = acc[ai][bj][m][1];
                    u32x4 w; w.x = pk2(v0[0], v0[1]); w.y = pk2(v0[2], v0[3]); w.z = pk2(v1[0], v1[1]); w.w = pk2(v1[2], v1[3]);
                    *(u32x4*)(rowp + bj * HALF) = w; } }
    }
};
struct EpiMem {
    static constexpr bool PERM = false;
    float* outK; float* outV; bf16_t* kb; bf16_t* vt;
    __device__ __forceinline__ void operator()(const f32x4 (&acc)[2][2][4][2], const Unit& u, int wr, int wc, int fr, int fq) const {
        const int row0 = u.pm * BM + wr * 64 + fr, col0 = u.pn * BM + wc * 32 + 4 * fq;
#pragma unroll
        for (int ai = 0; ai < 2; ++ai)
#pragma unroll
            for (int m = 0; m < 4; ++m) { const int row = row0 + ai * HALF + m * 16;
#pragma unroll
                for (int bj = 0; bj < 2; ++bj)
#pragma unroll
                    for (int n = 0; n < 2; ++n) { const int col = col0 + bj * HALF + n * 16; const f32x4 v = acc[ai][bj][m][n];
                        if (col < 1024) { *(f32x4*)(outK + ((size_t)u.z * 512 + row) * 1024 + col) = v;
                            u32x2 w; w.x = pk2(v[0], v[1]); w.y = pk2(v[2], v[3]); *(u32x2*)(kb + ((size_t)u.z * 512 + row) * 1024 + col) = w; }
                        else { const int c = col - 1024; *(f32x4*)(outV + ((size_t)u.z * 512 + row) * 1024 + c) = v;
                            const int b = row >> 8, mm = row & 255, h = c >> 8, d = c & 255; bf16_t* p = vt + ((((size_t)u.z * 2 + b) * 4 + h) * 256 + d) * 256 + mm;
                            p[0] = f2bf(v[0]); p[256] = f2bf(v[1]); p[512] = f2bf(v[2]); p[768] = f2bf(v[3]); } } }
    }
};
struct EpiMerge {
    static constexpr bool PERM = false;
    float* MG; bf16_t* MGB; const bf16_t* U; const float* gate_b;
    __device__ __forceinline__ void operator()(const f32x4 (&acc)[2][2][4][2], const Unit& u, int wr, int wc, int fr, int fq) const {
        const int row0 = u.pm * BM + wr * 64 + fr, col0 = u.pn * BM + wc * 32 + 4 * fq;
#pragma unroll
        for (int ai = 0; ai < 2; ++ai)
#pragma unroll
            for (int m = 0; m < 4; ++m) { const int row = row0 + ai * HALF + m * 16;
#pragma unroll
                for (int bj = 0; bj < 2; ++bj)
#pragma unroll
                    for (int n = 0; n < 2; ++n) { const int col = col0 + bj * HALF + n * 16; const f32x4 v = acc[ai][bj][m][n];
                        const u32x2 gp = *(const u32x2*)(U + (size_t)row * NINP + U_GP + u.z * DM + col); const f32x4 gb = *(const f32x4*)(gate_b + u.z * DM + col);
                        f32x4 gt; gt[0] = sigmoidf_(__uint_as_float(gp.x << 16) + gb[0]); gt[1] = sigmoidf_(__uint_as_float(gp.x & 0xffff0000u) + gb[1]);
                        gt[2] = sigmoidf_(__uint_as_float(gp.y << 16) + gb[2]); gt[3] = sigmoidf_(__uint_as_float(gp.y & 0xffff0000u) + gb[3]);
                        float* mp = MG + (size_t)row * DM + col; f32x4 r = gt * v;
                        if (u.z > 0) r += *(const f32x4*)mp;
                        if (u.z < 3) *(f32x4*)mp = r;
                        else { u32x2 w; w.x = pk2(r[0], r[1]); w.y = pk2(r[2], r[3]); *(u32x2*)(MGB + (size_t)row * DM + col) = w; } } }
    }
};
struct EpiRes {
    static constexpr bool PERM = false;
    const float* R; float* Y;
    __device__ __forceinline__ void operator()(const f32x4 (&acc)[2][2][4][2], const Unit& u, int wr, int wc, int fr, int fq) const {
        const int row0 = u.pm * BM + wr * 64 + fr, col0 = u.pn * BM + wc * 32 + 4 * fq;
#pragma unroll
        for (int ai = 0; ai < 2; ++ai)
#pragma unroll
            for (int m = 0; m < 4; ++m) { const size_t ro = (size_t)(row0 + ai * HALF + m * 16) * DM + col0;
#pragma unroll
                for (int bj = 0; bj < 2; ++bj)
#pragma unroll
                    for (int n = 0; n < 2; ++n) { const size_t o = ro + bj * HALF + n * 16; *(f32x4*)(Y + o) = *(const f32x4*)(R + o) * ALPHA + acc[ai][bj][m][n]; } }
    }
};
struct EpiSwiGLU {
    static constexpr bool PERM = true;
    bf16_t* O;
    __device__ __forceinline__ void operator()(const f32x4 (&acc)[2][2][4][2], const Unit& u, int wr, int wc, int fr, int fq) const {
        const int row0 = u.pm * BM + wr * 64 + fr, col0 = u.pn * HALF + wc * 32 + 8 * fq;
#pragma unroll
        for (int ai = 0; ai < 2; ++ai)
#pragma unroll
            for (int m = 0; m < 4; ++m) { bf16_t* rowp = O + (size_t)(row0 + ai * HALF + m * 16) * DFF + col0;
                float r[8];
#pragma unroll
                for (int n = 0; n < 2; ++n)
#pragma unroll
                    for (int j = 0; j < 4; ++j) { const float gg = acc[ai][0][m][n][j], uu = acc[ai][1][m][n][j]; r[n * 4 + j] = gg * sigmoidf_(gg) * uu; }
                u32x4 w; w.x = pk2(r[0], r[1]); w.y = pk2(r[2], r[3]); w.z = pk2(r[4], r[5]); w.w = pk2(r[6], r[7]);
                *(u32x4*)rowp = w; }
    }
};
struct EpiScore {
    static constexpr bool PERM = false;
    float* SC;
    __device__ __forceinline__ void operator()(const f32x4 (&acc)[2][2][4][2], const Unit& u, int wr, int wc, int fr, int fq) const {
        const int row0 = u.pm * BM + wr * 64 + fr, col0 = wc * 32 + 4 * fq; float* base = SC + (size_t)u.z * 4096 * 256;
#pragma unroll
        for (int ai = 0; ai < 2; ++ai)
#pragma unroll
            for (int m = 0; m < 4; ++m) { float* rowp = base + (size_t)(row0 + ai * HALF + m * 16) * 256 + col0;
#pragma unroll
                for (int bj = 0; bj < 2; ++bj)
#pragma unroll
                    for (int n = 0; n < 2; ++n) *(f32x4*)(rowp + bj * HALF + n * 16) = acc[ai][bj][m][n] * 0.0625f; }
    }
};
struct EpiPV {
    static constexpr bool PERM = true;
    bf16_t* O;
    __device__ __forceinline__ void operator()(const f32x4 (&acc)[2][2][4][2], const Unit& u, int wr, int wc, int fr, int fq) const {
        const int b = u.z >> 2, h = u.z & 3; const int row0 = b * PS + u.pm * BM + wr * 64 + fr, col0 = h * 256 + wc * 32 + 8 * fq;
#pragma unroll
        for (int ai = 0; ai < 2; ++ai)
#pragma unroll
            for (int m = 0; m < 4; ++m) { bf16_t* rowp = O + (size_t)(row0 + ai * HALF + m * 16) * BW + col0;
#pragma unroll
                for (int bj = 0; bj < 2; ++bj) { const f32x4 v0 = acc[ai][bj][m][0], v1 = acc[ai][bj][m][1];
                    u32x4 w; w.x = pk2(v0[0], v0[1]); w.y = pk2(v0[2], v0[3]); w.z = pk2(v1[0], v1[1]); w.w = pk2(v1[2], v1[3]);
                    *(u32x4*)(rowp + bj * HALF) = w; } }
    }
};
}


#define XB_TMO      128
#define XB_XCNT(j)  (256  + 64 * (j))
#define XB_XSUB(j)  (1280 + 64 * (j))
#define XB_XGEN(j)  (2304 + 64 * (j))
#define XB_TOP      3328
#define XB_TOPGEN   3392
#define XCD_BAR_WORDS 3456
#define XB_SPIN_CAP (1u << 18)
__device__ __forceinline__ unsigned xb_ld(unsigned* p)              { return __hip_atomic_load(p, __ATOMIC_RELAXED, __HIP_MEMORY_SCOPE_AGENT); }
__device__ __forceinline__ unsigned xb_add(unsigned* p, unsigned v) { return __hip_atomic_fetch_add(p, v, __ATOMIC_RELAXED, __HIP_MEMORY_SCOPE_AGENT); }
__device__ __forceinline__ unsigned xb_xcc_id() { return (unsigned)__builtin_amdgcn_s_getreg((3 << 11) | 20) & 0xFu; }
#define XB_SPIN(cond, bar) do { unsigned _sp = 0; while (cond) { __builtin_amdgcn_s_sleep(1); \
    if ((++_sp & 255u) == 0u) { if (xb_ld(&(bar)[XB_TMO])) break; if (_sp > XB_SPIN_CAP) { atomicAdd(&(bar)[XB_TMO], 1u); break; } } } } while (0)
struct XcdBarrier { unsigned* bar; unsigned x; volatile LAS unsigned* st; };
__device__ __forceinline__ XcdBarrier xcd_barrier_post(unsigned* bar, volatile LAS unsigned* st) {
    XcdBarrier b; b.bar = bar; b.x = xb_xcc_id(); b.st = st;
    if (threadIdx.x == 0) (void)xb_add(&bar[XB_XCNT(b.x)], 1u);
    return b;
}
__device__ __forceinline__ void xcd_barrier_complete(unsigned* bar, unsigned x, unsigned& nloc, unsigned& nx) {
    const unsigned G = gridDim.x * gridDim.y * gridDim.z;
    unsigned sum, cnt, mine, sp = 0u;
    for (;;) {
        sum = 0u; cnt = 0u; mine = 0u;
#pragma unroll
        for (unsigned j = 0; j < 16; ++j) { const unsigned c = xb_ld(&bar[XB_XCNT(j)]); sum += c; cnt += (c > 0u) ? 1u : 0u; mine = (j == x) ? c : mine; }
        if (sum == G) break;
        __builtin_amdgcn_s_sleep(1);
        if ((++sp & 255u) == 0u) { if (xb_ld(&bar[XB_TMO])) break; if (sp > XB_SPIN_CAP) { atomicAdd(&bar[XB_TMO], 1u); break; } }
    }
    nloc = mine > 0u ? mine : 1u; nx = cnt > 0u ? cnt : 1u;
}
__device__ __forceinline__ void xcd_barrier(const XcdBarrier& b) {
    asm volatile("s_waitcnt vmcnt(0)" ::: "memory");
    __syncthreads();
    if (threadIdx.x == 0) {
        unsigned* bar = b.bar;
        __builtin_amdgcn_s_waitcnt(0);
        unsigned nloc = b.st[0], nx = b.st[1];
        if (nloc == 0u) { xcd_barrier_complete(bar, b.x, nloc, nx); b.st[0] = nloc; b.st[1] = nx; }
        const unsigned old = xb_add(&bar[XB_XSUB(b.x)], 1u);
        const unsigned gen = old / nloc;
        if (old + 1u == (gen + 1u) * nloc) {
            __builtin_amdgcn_fence(__ATOMIC_RELEASE, "agent");
            asm volatile("s_waitcnt vmcnt(0)" ::: "memory");
            const unsigned og = xb_add(&bar[XB_TOP], 1u);
            const unsigned tg = og / nx;
            if (og + 1u == (tg + 1u) * nx) xb_add(&bar[XB_TOPGEN], 1u);
            else XB_SPIN(xb_ld(&bar[XB_TOPGEN]) == tg, bar);
            __builtin_amdgcn_fence(__ATOMIC_ACQUIRE, "agent");
            xb_add(&bar[XB_XGEN(b.x)], 1u);
            asm volatile("s_waitcnt vmcnt(0)" ::: "memory");
        } else {
            XB_SPIN(xb_ld(&bar[XB_XGEN(b.x)]) == gen, bar);
            __builtin_amdgcn_fence(__ATOMIC_ACQUIRE, "agent");
            asm volatile("s_waitcnt vmcnt(0)" ::: "memory");
        }
    }
    __syncthreads();
}

struct Ctx { int tid, lane, wave, bid, G; LAS unsigned char* lds; };
__device__ __forceinline__ Ctx fresh(const Ctx& c0) { Ctx c; c.wave = c0.wave; c.bid = c0.bid; c.G = c0.G; c.lds = c0.lds; asm volatile("" : "+s"(c.bid), "+s"(c.G), "+s"(c.wave));
    int lane = (int)__builtin_amdgcn_mbcnt_hi(~0u, __builtin_amdgcn_mbcnt_lo(~0u, 0u)); asm volatile("" : "+v"(lane)); c.lane = lane; c.tid = c.wave * 64 + lane; return c; }

__device__ __forceinline__ int colmap(int mode, int n) {
    if (mode == 1) return n < 3088 ? n : (n < 3328 ? -1 : n - 240);
    if (mode == 2) { const int t = n >> 8, j = n & 255; return j < 128 ? t * 128 + j : DFF + t * 128 + (j - 128); }
    return n;
}
__device__ __forceinline__ void wprep_load(f32x4 (&rg)[8], const float* __restrict__ src, int K, int Nsrc, int Ndst, int mode, size_t sbs, int item, int tid) {
    const int nx = Ndst / 256, ny = K / 64; const int bx = item % nx, by = (item / nx) % ny, bz = item / (nx * ny);
    const int tx = tid & 63, ty = tid >> 6, cm = colmap(mode, bx * 256 + tx * 4); const float* s = src + (size_t)bz * sbs + (size_t)(by * 64 + ty) * Nsrc + cm;
#pragma unroll
    for (int i = 0; i < 8; ++i) rg[i] = cm >= 0 ? *(const f32x4*)(s + (size_t)(8 * i) * Nsrc) : (f32x4){0.f, 0.f, 0.f, 0.f};
}
__device__ __forceinline__ void ph_wprep(const Ctx& c, const float* __restrict__ src, bf16_t* __restrict__ dst, int K, int Nsrc, int Ndst, int mode, int nbatch, size_t sbs, size_t dbs) {
    LAS float* tile = (LAS float*)c.lds;
    const int nx = Ndst / 256, ny = K / 64, total = nx * ny * nbatch;
    const int tid = c.tid, tx = tid & 63, ty = tid >> 6, n = tid >> 1, kh = tid & 1;
    f32x4 rg[8];
    int item = c.bid;
    if (item < total) wprep_load(rg, src, K, Nsrc, Ndst, mode, sbs, item, tid);
    for (; item < total; item += c.G) {
        __syncthreads();
#pragma unroll
        for (int i = 0; i < 8; ++i) *(LAS f32x4*)(tile + (ty + 8 * i) * 260 + tx * 4) = rg[i];
        __syncthreads();
        const int bx = item % nx, by = (item / nx) % ny, bz = item / (nx * ny);
        if (item + c.G < total) wprep_load(rg, src, K, Nsrc, Ndst, mode, sbs, item + c.G, tid);
        bf16_t* d = dst + (size_t)bz * dbs + (size_t)(bx * 256 + n) * K + by * 64 + kh * 32;
#pragma unroll
        for (int g = 0; g < 4; ++g) { unsigned p[4];
#pragma unroll
            for (int e = 0; e < 4; ++e) p[e] = pk2(tile[(kh * 32 + g * 8 + 2 * e) * 260 + n], tile[(kh * 32 + g * 8 + 2 * e + 1) * 260 + n]);
            *(u32x4*)(d + g * 8) = (u32x4){p[0], p[1], p[2], p[3]}; }
    }
    __syncthreads();
}
__device__ __forceinline__ void ph_xprep(const Ctx& c, const float* __restrict__ xp, const float* __restrict__ xs, const float* __restrict__ mem, float* __restrict__ HF, bf16_t* __restrict__ HB, bf16_t* __restrict__ MEMB) {
    const size_t nH = (size_t)MPAD * DM / 4, nM = (size_t)512 * DM / 4;
    for (size_t i4 = (size_t)c.bid * 512 + c.tid; i4 < nH + nM; i4 += (size_t)c.G * 512) {
        if (i4 < nH) {
            const size_t e = i4 * 4; f32x4 v = (f32x4){0.f, 0.f, 0.f, 0.f};
            if (e < (size_t)MP * DM) v = *(const f32x4*)(xp + e); else if (e < (size_t)MT * DM) v = *(const f32x4*)(xs + (e - (size_t)MP * DM));
            *(f32x4*)(HF + e) = v; u32x2 w; w.x = pk2(v[0], v[1]); w.y = pk2(v[2], v[3]); *(u32x2*)(HB + e) = w;
        } else {
            const size_t e = (i4 - nH) * 4; const f32x4 v = *(const f32x4*)(mem + e); u32x2 w; w.x = pk2(v[0], v[1]); w.y = pk2(v[2], v[3]); *(u32x2*)(MEMB + e) = w;
        }
    }
}
__device__ __forceinline__ void ph_ln(const Ctx& c, const float* __restrict__ Y, const float* __restrict__ g, const float* __restrict__ b, float* __restrict__ XF, bf16_t* __restrict__ XB, float* __restrict__ OUT, int nrows, int nout) {
    const int lane = c.lane;
    for (int row = c.bid * 8 + c.wave; row < nrows; row += c.G * 8) {
        const float* y = Y + (size_t)row * DM; f32x4 v[8]; float s = 0.f;
#pragma unroll
        for (int j = 0; j < 8; ++j) { v[j] = *(const f32x4*)(y + j * 256 + lane * 4); s += (v[j][0] + v[j][1]) + (v[j][2] + v[j][3]); }
        const float mean = wave_sum(s) * (1.0f / DM); float q = 0.f;
#pragma unroll
        for (int j = 0; j < 8; ++j) { const f32x4 d = v[j] - mean; q += (d[0] * d[0] + d[1] * d[1]) + (d[2] * d[2] + d[3] * d[3]); }
        const float rstd = rsqrtf(wave_sum(q) * (1.0f / DM) + 1e-5f);
#pragma unroll
        for (int j = 0; j < 8; ++j) { const int cc = j * 256 + lane * 4; const f32x4 gg = *(const f32x4*)(g + cc), bb = *(const f32x4*)(b + cc);
            const f32x4 o = (v[j] - mean) * rstd * gg + bb; const size_t off = (size_t)row * DM + cc;
            *(f32x4*)(XF + off) = o; u32x2 w; w.x = pk2(o[0], o[1]); w.y = pk2(o[2], o[3]); *(u32x2*)(XB + off) = w;
            if (OUT != nullptr && row < nout) *(f32x4*)(OUT + off) = o; }
    }
}
__device__ __forceinline__ void ph_softmax256(const Ctx& c, const float* __restrict__ SC, bf16_t* __restrict__ P, int nrows) {
    const int lane = c.lane;
    for (int row = c.bid * 8 + c.wave; row < nrows; row += c.G * 8) {
        const f32x4 v = *(const f32x4*)(SC + (size_t)row * 256 + lane * 4);
        const float mx = wave_max(fmaxf(fmaxf(v[0], v[1]), fmaxf(v[2], v[3])));
        f32x4 e; e[0] = __expf(v[0] - mx); e[1] = __expf(v[1] - mx); e[2] = __expf(v[2] - mx); e[3] = __expf(v[3] - mx);
        const float inv = 1.0f / wave_sum((e[0] + e[1]) + (e[2] + e[3]));
        u32x2 w; w.x = pk2(e[0] * inv, e[1] * inv); w.y = pk2(e[2] * inv, e[3] * inv); *(u32x2*)(P + (size_t)row * 256 + lane * 4) = w;
    }
}
__device__ __forceinline__ void ph_copy_outs(const Ctx& c, const bf16_t* __restrict__ U, const float* __restrict__ ck, const float* __restrict__ cv, float* __restrict__ out, int layer) {
    constexpr int nA = PB * 128 * 128, nB = SB * 128 * 128, nC = PB * RWC, nD = SB * RWC;
    for (int i = c.bid * 512 + c.tid; i < nA + nB + nC + nD; i += c.G * 512) {
        if (i < nA) { const int b = i / 16384, j = (i >> 7) & 127, cc = i & 127; const size_t ur = (size_t)(b * PS + PS - 128 + j) * NINP;
            out[O_SWKP + (size_t)layer * nA + i] = bf2f(U[ur + U_SK + cc]); out[O_SWVP + (size_t)layer * nA + i] = bf2f(U[ur + U_SV + cc]); continue; }
        int k = i - nA;
        if (k < nB) { const int sq = k / 16384, j = (k >> 7) & 127, cc = k & 127; float kv, vv;
            if (j < 124) { const size_t o = ((size_t)sq * 128 + j + 4) * 128 + cc; kv = ck[o]; vv = cv[o]; }
            else { const size_t ur = (size_t)(MP + sq * SS + j - 124) * NINP; kv = bf2f(U[ur + U_SK + cc]); vv = bf2f(U[ur + U_SV + cc]); }
            out[O_SWKS + (size_t)layer * nB + k] = kv; out[O_SWVS + (size_t)layer * nB + k] = vv; continue; }
        k -= nB;
        if (k < nC) { const int b = k / RWC, cc = k - b * RWC; out[O_RSP + (size_t)layer * nC + k] = bf2f(U[(size_t)(b * PS + PS - 1) * NINP + U_RU + cc]); continue; }
        k -= nC;
        { const int sq = k / RWC, cc = k - sq * RWC; out[O_RSS + (size_t)layer * nD + k] = bf2f(U[(size_t)(MP + sq * SS + SS - 1) * NINP + U_RU + cc]); }
    }
}

__device__ __forceinline__ void seq_info(int sq, int& row0, int& L) { if (sq < PB) { row0 = sq * PS; L = PS; } else { row0 = MP + (sq - PB) * SS; L = SS; } }

__device__ __forceinline__ void ph_gla_naive(const Ctx& c, const bf16_t* __restrict__ U, const float* __restrict__ s0, const float* __restrict__ a_up, const float* __restrict__ a_b,
                                             const float* __restrict__ ng, const float* __restrict__ nb, bf16_t* __restrict__ OB, float* __restrict__ outP, float* __restrict__ outS) {
    LAS float* qs = (LAS float*)c.lds;
    LAS float* ks = qs + 16 * 128; LAS float* as = ks + 16 * 128; LAS float* os = as + 16 * 128;
    const int kh = c.tid >> 8, vt = c.tid & 255, lane = c.lane;
    for (int u = c.bid; u < (PB + SB) * 4; u += c.G) {
        const int sq = u >> 2, h = u & 3;
        int row0, L; seq_info(sq, row0, L);
        float S[64];
        if (sq >= PB) { const float* p = s0 + (((size_t)(sq - PB) * 4 + h) * 128 + kh * 64) * 256 + vt;
#pragma unroll
            for (int kk = 0; kk < 64; ++kk) S[kk] = p[(size_t)kk * 256]; }
        else {
#pragma unroll
            for (int kk = 0; kk < 64; ++kk) S[kk] = 0.f; }
        for (int t0 = 0; t0 < L; t0 += 16) {
            const int nT = (L - t0) < 16 ? (L - t0) : 16;
            for (int idx = c.tid; idx < nT * 128; idx += 512) {
                const int tt = idx >> 7, kk = idx & 127; const bf16_t* ur = U + (size_t)(row0 + t0 + tt) * NINP;
                qs[idx] = bf2f(ur[U_GQ + h * 128 + kk]) * 0.08838834764831845f; ks[idx] = bf2f(ur[U_GK + h * 128 + kk]);
                float x = a_b[h * 128 + kk];
#pragma unroll
                for (int r = 0; r < 16; ++r) x += bf2f(ur[U_GA + r]) * a_up[r * 512 + h * 128 + kk];
                const float ls = (fminf(x, 0.f) - log1pf(__expf(-fabsf(x)))) * (1.0f / 16.0f);
                as[idx] = __expf(ls);
            }
            __syncthreads();
            for (int tt = 0; tt < nT; ++tt) {
                const float v = bf2f(U[(size_t)(row0 + t0 + tt) * NINP + U_GV + h * 256 + vt]); float o = 0.f; const int lb = tt * 128 + kh * 64;
#pragma unroll
                for (int kk = 0; kk < 64; ++kk) { S[kk] = as[lb + kk] * S[kk] + ks[lb + kk] * v; o += qs[lb + kk] * S[kk]; }
                os[(kh * 16 + tt) * 256 + vt] = o;
            }
            __syncthreads();
            for (int tt = c.wave; tt < nT; tt += 8) {
                float x[4]; float s = 0.f;
#pragma unroll
                for (int j = 0; j < 4; ++j) { x[j] = os[tt * 256 + lane + 64 * j] + os[(16 + tt) * 256 + lane + 64 * j]; s += x[j]; }
                const float mean = wave_sum(s) * (1.0f / 256.0f); float q = 0.f;
#pragma unroll
                for (int j = 0; j < 4; ++j) { const float d = x[j] - mean; q += d * d; }
                const float rstd = rsqrtf(wave_sum(q) * (1.0f / 256.0f) + 1e-5f);
                const size_t row = (size_t)(row0 + t0 + tt);
#pragma unroll
                for (int j = 0; j < 4; ++j) { const int cc = h * 256 + lane + 64 * j; const float n = (x[j] - mean) * rstd * ng[cc] + nb[cc];
                    const float gr = bf2f(U[row * NINP + U_GR + cc]); OB[row * BW + cc] = f2bf(n * gr * sigmoidf_(gr)); }
            }
            __syncthreads();
        }
        float* op = (sq < PB ? outP + (((size_t)sq * 4 + h) * 128 + kh * 64) * 256 : outS + (((size_t)(sq - PB) * 4 + h) * 128 + kh * 64) * 256) + vt;
#pragma unroll
        for (int kk = 0; kk < 64; ++kk) op[(size_t)kk * 256] = S[kk];
    }
}

__device__ __forceinline__ f32x4 mma16(bf16x8 x, bf16x8 y, f32x4 c) { return __builtin_amdgcn_mfma_f32_16x16x32_bf16(x, y, c, 0, 0, 0); }
__device__ __forceinline__ bf16x8 pack_acc(const f32x4& a, const f32x4& b) {
    u32x4 p; p.x = pk2(a[0], a[1]); p.y = pk2(a[2], a[3]); p.z = pk2(b[0], b[1]); p.w = pk2(b[2], b[3]); return __builtin_bit_cast(bf16x8, p);
}
__device__ __forceinline__ void gla_chunk_info(int u, int& row0, int& ntok, int& h) {
    if (u < 512) { const int b = u >> 8; h = (u >> 6) & 3; row0 = b * PS + (u & 63) * 64; ntok = 64; }
    else { const int s = u - 512; h = s & 3; row0 = MP + (s >> 2) * SS; ntok = SS; }
}
__device__ __forceinline__ void ph_gla_pre(const Ctx& c, const bf16_t* __restrict__ U, const float* __restrict__ a_up, const float* __restrict__ a_b,
                                           bf16_t* __restrict__ QD, bf16_t* __restrict__ KHT, bf16_t* __restrict__ EE, bf16_t* __restrict__ VT, float* __restrict__ GC) {
    LAS float* ga_l = (LAS float*)c.lds;
    LAS float* tot = ga_l + 64 * 16;
    LAS bf16_t* Qd_l = (LAS bf16_t*)(tot + 4 * 128);
    LAS bf16_t* Kn_l = Qd_l + 64 * 136;
    LAS bf16_t* v_l = Kn_l + 64 * 136;
    LAS bf16_t* qr_l = v_l + 64 * 264;
    LAS bf16_t* kr_l = qr_l + 64 * 136;
    const int tid = c.tid, lane = c.lane, r = lane & 15, q = lane >> 4, w = c.wave;
    for (int u = (c.bid + c.G / 2) % c.G; u < GL_NCH; u += c.G) {
        int row0, ntok, h; gla_chunk_info(u, row0, ntok, h);
        for (int i = tid; i < 64 * 16; i += 512) { const int t = i >> 4, rr = i & 15; ga_l[i] = t < ntok ? bf2f(U[(size_t)(row0 + t) * NINP + U_GA + rr]) : 0.f; }
        for (int i = tid; i < 64 * 32; i += 512) { const int t = i >> 5, c8 = i & 31; u32x4 vv = (u32x4){0u, 0u, 0u, 0u};
            if (t < ntok) vv = *(const u32x4*)(U + (size_t)(row0 + t) * NINP + U_GV + h * 256 + c8 * 8);
            *(LAS u32x4*)(v_l + t * 264 + c8 * 8) = vv; }
        for (int i = tid; i < 64 * 16; i += 512) { const int t = i >> 4, c8 = i & 15; u32x4 qv = (u32x4){0u, 0u, 0u, 0u}, kv = qv;
            if (t < ntok) { const bf16_t* ur = U + (size_t)(row0 + t) * NINP + h * 128 + c8 * 8; qv = *(const u32x4*)(ur + U_GQ); kv = *(const u32x4*)(ur + U_GK); }
            *(LAS u32x4*)(qr_l + t * 136 + c8 * 8) = qv; *(LAS u32x4*)(kr_l + t * 136 + c8 * 8) = kv; }
        __syncthreads();
        const int kk = tid & 127, tq = tid >> 7;
        float cum[16];
        { float aup[16];
#pragma unroll
          for (int rr = 0; rr < 16; ++rr) aup[rr] = a_up[rr * 512 + h * 128 + kk];
          const float ab = a_b[h * 128 + kk]; float run = 0.f;
#pragma unroll
          for (int j = 0; j < 16; ++j) { const int t = tq * 16 + j; float x = ab;
#pragma unroll
              for (int rr = 0; rr < 16; ++rr) x += ga_l[t * 16 + rr] * aup[rr];
              const float la = t < ntok ? (fminf(x, 0.f) - __logf(1.0f + __expf(-fabsf(x)))) * (1.0f / 16.0f) : 0.f;
              run += la; cum[j] = run; }
          tot[tq * 128 + kk] = run; }
        __syncthreads();
        { float prefix = 0.f, bC = 0.f;
#pragma unroll
          for (int g = 0; g < 4; ++g) { const float tv = tot[g * 128 + kk]; bC += tv; if (g < tq) prefix += tv; }
          unsigned khp[8];
#pragma unroll
          for (int j = 0; j < 16; j += 2) { float kh2[2];
#pragma unroll
              for (int e = 0; e < 2; ++e) { const int t = tq * 16 + j + e; const float b = prefix + cum[j + e]; const float qv = bf2f(qr_l[t * 136 + kk]), kv = bf2f(kr_l[t * 136 + kk]);
                  Qd_l[t * 136 + kk] = f2bf(qv * __expf(b) * 0.08838834764831845f); Kn_l[t * 136 + kk] = f2bf(kv * __expf(-b)); kh2[e] = kv * __expf(bC - b); }
              khp[j >> 1] = pk2(kh2[0], kh2[1]); }
          bf16_t* kp = KHT + (size_t)u * 8192 + kk * 64 + tq * 16;
          *(u32x4*)kp = (u32x4){khp[0], khp[1], khp[2], khp[3]}; *(u32x4*)(kp + 8) = (u32x4){khp[4], khp[5], khp[6], khp[7]};
          if (tq == 0) GC[(size_t)u * 128 + kk] = __expf(bC); }
        __syncthreads();
        { const int tb = w >> 1;
#pragma unroll
          for (int e = 0; e < 2; ++e) { const int ib = (w & 1) * 2 + e; f32x4 d = (f32x4){0.f, 0.f, 0.f, 0.f};
              if (ib <= tb) {
                  bf16x8 kf4[4], qf4[4];
#pragma unroll
                  for (int ks = 0; ks < 4; ++ks) { kf4[ks] = *(const LAS bf16x8*)(Kn_l + (ib * 16 + r) * 136 + ks * 32 + q * 8); qf4[ks] = *(const LAS bf16x8*)(Qd_l + (tb * 16 + r) * 136 + ks * 32 + q * 8); }
                  __builtin_amdgcn_sched_barrier(0);
#pragma unroll
                  for (int ks = 0; ks < 4; ++ks) d = mma16(kf4[ks], qf4[ks], d); }
              const int t = tb * 16 + r, i0 = ib * 16 + q * 4;
#pragma unroll
              for (int jj = 0; jj < 4; ++jj) if (i0 + jj > t) d[jj] = 0.f;
              u32x2 o; o.x = pk2(d[0], d[1]); o.y = pk2(d[2], d[3]); *(u32x2*)(EE + (size_t)u * 4096 + t * 64 + i0) = o; } }
        for (int i = tid; i < 64 * 16; i += 512) { const int t = i >> 4, c8 = i & 15; *(u32x4*)(QD + (size_t)u * 8192 + t * 128 + c8 * 8) = *(const LAS u32x4*)(Qd_l + t * 136 + c8 * 8); }
        { const int val = tid & 255, th = tid >> 8;
#pragma unroll
          for (int tg = 0; tg < 4; ++tg) { const int t0 = th * 32 + tg * 8; unsigned p4[4];
#pragma unroll
              for (int e = 0; e < 4; ++e) p4[e] = (unsigned)v_l[(t0 + 2 * e) * 264 + val] | ((unsigned)v_l[(t0 + 2 * e + 1) * 264 + val] << 16);
              *(u32x4*)(VT + (size_t)u * 16384 + val * 64 + t0) = (u32x4){p4[0], p4[1], p4[2], p4[3]}; } }
        __syncthreads();
    }
}
struct GlaStage { u32x4 qd[2], kh[2], e, vt, gc; };
__device__ __forceinline__ void gla_stage_load(GlaStage& s, const bf16_t* __restrict__ QD, const bf16_t* __restrict__ KHT, const bf16_t* __restrict__ EE, const bf16_t* __restrict__ VT, const float* __restrict__ GC,
                                               int ch, int sl, int tid) {
    const bf16_t* qp = QD + (size_t)ch * 8192 + tid * 8; s.qd[0] = *(const u32x4*)qp; s.qd[1] = *(const u32x4*)(qp + 4096);
    const bf16_t* kp = KHT + (size_t)ch * 8192 + tid * 8; s.kh[0] = *(const u32x4*)kp; s.kh[1] = *(const u32x4*)(kp + 4096);
    s.e = *(const u32x4*)(EE + (size_t)ch * 4096 + tid * 8);
    s.vt = *(const u32x4*)(VT + (size_t)ch * 16384 + sl * 4096 + tid * 8);
    if (tid < 32) s.gc = *(const u32x4*)(GC + (size_t)ch * 128 + tid * 4);
}
constexpr int GS_KH = 8704, GS_E = 17920, GS_VT = 22528, GS_GC = 27136, GS_EL = 27392;
__device__ __forceinline__ void gla_stage_store(const GlaStage& s, LAS bf16_t* b, int tid) {
    *(LAS u32x4*)(b + (tid >> 4) * 136 + (tid & 15) * 8) = s.qd[0]; *(LAS u32x4*)(b + (32 + (tid >> 4)) * 136 + (tid & 15) * 8) = s.qd[1];
    *(LAS u32x4*)(b + GS_KH + (tid >> 3) * 72 + (tid & 7) * 8) = s.kh[0]; *(LAS u32x4*)(b + GS_KH + (64 + (tid >> 3)) * 72 + (tid & 7) * 8) = s.kh[1];
    *(LAS u32x4*)(b + GS_E + (tid >> 3) * 72 + (tid & 7) * 8) = s.e; *(LAS u32x4*)(b + GS_VT + (tid >> 3) * 72 + (tid & 7) * 8) = s.vt;
    if (tid < 32) *(LAS u32x4*)(b + GS_GC + tid * 8) = s.gc;
}
__device__ __forceinline__ void ph_gla_seq(const Ctx& c, int boff, const bf16_t* __restrict__ QD, const bf16_t* __restrict__ KHT, const bf16_t* __restrict__ EE, const bf16_t* __restrict__ VT, const float* __restrict__ GC,
                                           const float* __restrict__ s0, float* __restrict__ outP, float* __restrict__ outS, bf16_t* __restrict__ OB) {
    LAS bf16_t* stg = (LAS bf16_t*)c.lds;
    LAS bf16_t* T_l = stg + 2 * GS_EL;
    const int tid = c.tid, lane = c.lane, r = lane & 15, q = lane >> 4, w = c.wave;
    const int side = c.bid < 32 ? c.bid : c.bid - 64, nside = c.G - 64;
    for (int u = (c.bid >= boff && c.bid < boff + 32) ? c.bid - boff : ((c.bid < 32 || c.bid >= 96) ? 32 + side : 32 + 512); u < 32 + 512; u = u < 32 ? 32 + 512 : u + nside) {
        int h, sl, nch, ch0, row0, ntok; const float* sp = nullptr; float* op;
        if (u < 32) { const int b = u >> 4; h = (u >> 2) & 3; sl = u & 3; nch = 64; ch0 = (b * 4 + h) * 64; row0 = b * PS; ntok = 64; op = outP + (size_t)(b * 4 + h) * 32768; }
        else { const int s = u - 32, sq = s >> 4; h = (s >> 2) & 3; sl = s & 3; nch = 1; ch0 = 512 + sq * 4 + h; row0 = MP + sq * SS; ntok = SS; sp = s0 + (size_t)(sq * 4 + h) * 32768; op = outS + (size_t)(sq * 4 + h) * 32768; }
        f32x4 acc[4];
#pragma unroll
        for (int vb = 0; vb < 4; ++vb)
#pragma unroll
            for (int jj = 0; jj < 4; ++jj) acc[vb][jj] = sp ? sp[(size_t)(w * 16 + q * 4 + jj) * 256 + sl * 64 + vb * 16 + r] : 0.f;
        GlaStage R0, R1, R2;
        gla_stage_load(R0, QD, KHT, EE, VT, GC, ch0, sl, tid);
        if (1 < nch) gla_stage_load(R1, QD, KHT, EE, VT, GC, ch0 + 1, sl, tid);
        if (2 < nch) gla_stage_load(R2, QD, KHT, EE, VT, GC, ch0 + 2, sl, tid);
        __syncthreads();
        gla_stage_store(R0, stg, tid);
        if (3 < nch) gla_stage_load(R0, QD, KHT, EE, VT, GC, ch0 + 3, sl, tid);
#define GLA_STEP(ci, RN) do { \
            LAS bf16_t* Tb = T_l + ((ci) & 1) * 64 * 136; const LAS bf16_t* sb = stg + ((ci) & 1) * GS_EL; \
            _Pragma("unroll") for (int vb = 0; vb < 4; ++vb) { u32x2 o; o.x = pk2(acc[vb][0], acc[vb][1]); o.y = pk2(acc[vb][2], acc[vb][3]); *(LAS u32x2*)(Tb + (vb * 16 + r) * 136 + w * 16 + q * 4) = o; } \
            __syncthreads(); \
            if ((ci) + 1 < nch) { gla_stage_store(RN, stg + (((ci) + 1) & 1) * GS_EL, tid); if ((ci) + 4 < nch) gla_stage_load(RN, QD, KHT, EE, VT, GC, ch0 + (ci) + 4, sl, tid); } \
            { const int rb = w >> 1, t = rb * 16 + r; bf16x8 qf[4], ef[2]; \
              _Pragma("unroll") for (int ks = 0; ks < 4; ++ks) qf[ks] = *(const LAS bf16x8*)(sb + (rb * 16 + r) * 136 + ks * 32 + q * 8); \
              _Pragma("unroll") for (int ks = 0; ks < 2; ++ks) ef[ks] = *(const LAS bf16x8*)(sb + GS_E + (rb * 16 + r) * 72 + ks * 32 + q * 8); \
              bf16x8 tf[2][4], vf[2][2]; \
              _Pragma("unroll") for (int e2 = 0; e2 < 2; ++e2) { const int cb = (w & 1) * 2 + e2; \
                  _Pragma("unroll") for (int ks = 0; ks < 4; ++ks) tf[e2][ks] = *(const LAS bf16x8*)(Tb + (cb * 16 + r) * 136 + ks * 32 + q * 8); \
                  _Pragma("unroll") for (int ks = 0; ks < 2; ++ks) vf[e2][ks] = *(const LAS bf16x8*)(sb + GS_VT + (cb * 16 + r) * 72 + ks * 32 + q * 8); } \
              __builtin_amdgcn_sched_barrier(0); \
              _Pragma("unroll") for (int e2 = 0; e2 < 2; ++e2) { const int cb = (w & 1) * 2 + e2; f32x4 y = (f32x4){0.f, 0.f, 0.f, 0.f}; \
                  _Pragma("unroll") for (int ks = 0; ks < 4; ++ks) y = mma16(tf[e2][ks], qf[ks], y); \
                  _Pragma("unroll") for (int ks = 0; ks < 2; ++ks) y = mma16(vf[e2][ks], ef[ks], y); \
                  if (t < ntok) { u32x2 o; o.x = pk2(y[0], y[1]); o.y = pk2(y[2], y[3]); *(u32x2*)(OB + (size_t)(row0 + (ci) * 64 + t) * BW + h * 256 + sl * 64 + cb * 16 + q * 4) = o; } } } \
            { const f32x4 gcv = *(const LAS f32x4*)((const LAS float*)(sb + GS_GC) + w * 16 + q * 4); bf16x8 kf[2]; \
              _Pragma("unroll") for (int ks = 0; ks < 2; ++ks) kf[ks] = *(const LAS bf16x8*)(sb + GS_KH + (w * 16 + r) * 72 + ks * 32 + q * 8); \
              bf16x8 vs[4][2]; \
              _Pragma("unroll") for (int vb = 0; vb < 4; ++vb) _Pragma("unroll") for (int ks = 0; ks < 2; ++ks) vs[vb][ks] = *(const LAS bf16x8*)(sb + GS_VT + (vb * 16 + r) * 72 + ks * 32 + q * 8); \
              __builtin_amdgcn_sched_barrier(0); \
              _Pragma("unroll") for (int vb = 0; vb < 4; ++vb) { acc[vb] = acc[vb] * gcv; \
                  _Pragma("unroll") for (int ks = 0; ks < 2; ++ks) acc[vb] = mma16(kf[ks], vs[vb][ks], acc[vb]); } } \
        } while (0)
#pragma unroll 1
        for (int ci = 0; ci < nch; ci += 3) {
            GLA_STEP(ci, R1);
            if (ci + 1 < nch) GLA_STEP(ci + 1, R2);
            if (ci + 2 < nch) GLA_STEP(ci + 2, R0);
        }
#undef GLA_STEP
#pragma unroll
        for (int vb = 0; vb < 4; ++vb)
#pragma unroll
            for (int jj = 0; jj < 4; ++jj) op[(size_t)(w * 16 + q * 4 + jj) * 256 + sl * 64 + vb * 16 + r] = acc[vb][jj];
        __syncthreads();
    }
}
__device__ __forceinline__ void ph_gla_fin(const Ctx& c, const bf16_t* __restrict__ U, const float* __restrict__ ng, const float* __restrict__ nb, const bf16_t* __restrict__ RAW, bf16_t* __restrict__ OB) {
    const int lane = c.lane;
    for (int i = c.bid * 8 + c.wave; i < MT * 4; i += c.G * 8) {
        const int row = i >> 2, h = i & 3, cc = h * 256 + lane * 4; bf16_t* p = OB + (size_t)row * BW + cc;
        const u32x2 raw = *(const u32x2*)(RAW + (size_t)row * BW + cc); float x[4] = {__uint_as_float(raw.x << 16), __uint_as_float(raw.x & 0xffff0000u), __uint_as_float(raw.y << 16), __uint_as_float(raw.y & 0xffff0000u)};
        const float mean = wave_sum((x[0] + x[1]) + (x[2] + x[3])) * (1.0f / 256.0f); float qq = 0.f;
#pragma unroll
        for (int j = 0; j < 4; ++j) { const float d = x[j] - mean; qq += d * d; }
        const float rstd = rsqrtf(wave_sum(qq) * (1.0f / 256.0f) + 1e-5f);
        const u32x2 gp = *(const u32x2*)(U + (size_t)row * NINP + U_GR + cc); const float gr[4] = {__uint_as_float(gp.x << 16), __uint_as_float(gp.x & 0xffff0000u), __uint_as_float(gp.y << 16), __uint_as_float(gp.y & 0xffff0000u)};
        const f32x4 gg = *(const f32x4*)(ng + cc), bb = *(const f32x4*)(nb + cc); float o[4];
#pragma unroll
        for (int j = 0; j < 4; ++j) o[j] = ((x[j] - mean) * rstd * gg[j] + bb[j]) * gr[j] * sigmoidf_(gr[j]);
        u32x2 ov; ov.x = pk2(o[0], o[1]); ov.y = pk2(o[2], o[3]); *(u32x2*)p = ov;
    }
}

__device__ __forceinline__ void unpack8(const u32x4 w, float (&x)[8]) {
    x[0] = __uint_as_float(w.x << 16); x[1] = __uint_as_float(w.x & 0xffff0000u); x[2] = __uint_as_float(w.y << 16); x[3] = __uint_as_float(w.y & 0xffff0000u);
    x[4] = __uint_as_float(w.z << 16); x[5] = __uint_as_float(w.z & 0xffff0000u); x[6] = __uint_as_float(w.w << 16); x[7] = __uint_as_float(w.w & 0xffff0000u);
}
template <bool ISBF> __device__ __forceinline__ void swa_step(const float (&q)[32], float (&acc)[32], float& m, float& l, const void* kp, const void* vp, float slope, float dist) {
    float s = 0.f;
#pragma unroll
    for (int j = 0; j < 4; ++j) { float x[8];
        if (ISBF) unpack8(*(const u32x4*)((const bf16_t*)kp + j * 8), x);
        else { const f32x4 a = *(const f32x4*)((const float*)kp + j * 8), b = *(const f32x4*)((const float*)kp + j * 8 + 4); x[0] = a[0]; x[1] = a[1]; x[2] = a[2]; x[3] = a[3]; x[4] = b[0]; x[5] = b[1]; x[6] = b[2]; x[7] = b[3]; }
#pragma unroll
        for (int d = 0; d < 8; ++d) s += q[j * 8 + d] * x[d]; }
    s += __shfl_xor(s, 1, 64);
    s = s * 0.125f - slope * dist;
    const float mn = fmaxf(m, s), cc = __expf(m - mn), p = __expf(s - mn);
    l = l * cc + p;
#pragma unroll
    for (int j = 0; j < 4; ++j) { float x[8];
        if (ISBF) unpack8(*(const u32x4*)((const bf16_t*)vp + j * 8), x);
        else { const f32x4 a = *(const f32x4*)((const float*)vp + j * 8), b = *(const f32x4*)((const float*)vp + j * 8 + 4); x[0] = a[0]; x[1] = a[1]; x[2] = a[2]; x[3] = a[3]; x[4] = b[0]; x[5] = b[1]; x[6] = b[2]; x[7] = b[3]; }
#pragma unroll
        for (int d = 0; d < 8; ++d) acc[j * 8 + d] = acc[j * 8 + d] * cc + p * x[d]; }
    m = mn;
}
__device__ __forceinline__ void ph_swa_naive(const Ctx& c, const bf16_t* __restrict__ U, const float* __restrict__ ck, const float* __restrict__ cv, const float* __restrict__ sinks, bf16_t* __restrict__ OB) {
    for (int gid = c.bid * 512 + c.tid; gid < MS * 32; gid += c.G * 512) {
        const int dh = gid & 1, h = (gid >> 1) & 15, row = MP + (gid >> 5), kvh = h >> 3, co = kvh * 64 + dh * 32;
        float q[32], acc[32];
#pragma unroll
        for (int j = 0; j < 4; ++j) { float x[8]; unpack8(*(const u32x4*)(U + (size_t)row * NINP + U_SQ + h * 64 + dh * 32 + j * 8), x);
#pragma unroll
            for (int d = 0; d < 8; ++d) { q[j * 8 + d] = x[d]; acc[j * 8 + d] = 0.f; } }
        const float slope = exp2f(-0.5f * (float)(h + 1)); float m = sinks[h], l = 1.0f;
        if (row < MP) {
            const int t = row % PS, base = row - t, lo = t - 128 < 0 ? 0 : t - 128;
            for (int s = lo; s <= t; ++s) { const bf16_t* ur = U + (size_t)(base + s) * NINP;
                swa_step<true>(q, acc, m, l, ur + U_SK + co, ur + U_SV + co, slope, (float)(t - s)); }
        } else {
            const int sq = (row - MP) / SS, i = (row - MP) % SS;
            for (int idx = i; idx <= 128 + i; ++idx) {
                if (idx < 128) { const size_t o = ((size_t)sq * 128 + idx) * 128 + co; swa_step<false>(q, acc, m, l, ck + o, cv + o, slope, (float)(128 + i - idx)); }
                else { const bf16_t* ur = U + (size_t)(MP + sq * SS + idx - 128) * NINP; swa_step<true>(q, acc, m, l, ur + U_SK + co, ur + U_SV + co, slope, (float)(128 + i - idx)); }
            }
        }
        const float inv = 1.0f / l; bf16_t* op = OB + (size_t)row * BW + h * 64 + dh * 32;
#pragma unroll
        for (int j = 0; j < 4; ++j) { u32x4 w; w.x = pk2(acc[j * 8] * inv, acc[j * 8 + 1] * inv); w.y = pk2(acc[j * 8 + 2] * inv, acc[j * 8 + 3] * inv);
            w.z = pk2(acc[j * 8 + 4] * inv, acc[j * 8 + 5] * inv); w.w = pk2(acc[j * 8 + 6] * inv, acc[j * 8 + 7] * inv); *(u32x4*)(op + j * 8) = w; }
    }
}

__device__ __forceinline__ void ph_rwkv_prep(const Ctx& c, const bf16_t* __restrict__ U, const float* __restrict__ shift, const float* __restrict__ mu, const float* __restrict__ w0, const float* __restrict__ w2,
                                             const float* __restrict__ a0, const float* __restrict__ a2, const float* __restrict__ g2, const float* __restrict__ k_k, const float* __restrict__ k_a,
                                             const float* __restrict__ r_k, float* __restrict__ RW) {
    LAS float* xm = (LAS float*)c.lds; LAS float* tw = xm + RWC; LAS float* ad = tw + 64; LAS float* sg = ad + 64;
    const int tid = c.tid;
    float* R = RW; float* WD = RW + (size_t)MPAD * BW; float* K2 = WD + (size_t)MPAD * BW; float* V = K2 + (size_t)MPAD * BW; float* KK = V + (size_t)MPAD * BW;
    float* BV = KK + (size_t)MPAD * BW; float* G = BV + (size_t)MPAD * BW; float* BON = G + (size_t)MPAD * BW;
    for (int row = c.bid; row < MT; row += c.G) {
        const bf16_t* ur = U + (size_t)row * NINP + U_RU; const bf16_t* pr = ur - NINP; const float* ps = nullptr; bool first;
        if (row < MP) first = (row % PS) == 0; else { first = ((row - MP) % SS) == 0; ps = shift + (size_t)((row - MP) / SS) * RWC; }
        for (int cc = tid; cc < RWC; cc += 512) { const float x = bf2f(ur[cc]); const float s = first ? (ps ? ps[cc] : 0.f) : bf2f(pr[cc]); xm[cc] = x + (s - x) * mu[cc]; }
        __syncthreads();
        if (tid < 64) { tw[tid] = tanhf(xm[3072 + tid]); ad[tid] = xm[3136 + tid]; }
        if (tid >= 128 && tid < 256) sg[tid - 128] = sigmoidf_(xm[3200 + tid - 128]);
        __syncthreads();
        for (int qd = 0; qd < 2; ++qd) {
            const int cc = qd * 512 + tid; float accw = w0[cc], acca = a0[cc], accg = 0.f;
#pragma unroll 4
            for (int j = 0; j < 64; ++j) { accw += tw[j] * w2[j * BW + cc]; acca += ad[j] * a2[j * BW + cc]; }
#pragma unroll 4
            for (int j = 0; j < 128; ++j) accg += sg[j] * g2[j * BW + cc];
            const float lw = -softplusf_(-accw) - 0.5f, decay = __expf(-__expf(lw)), a = sigmoidf_(acca);
            const float r = xm[cc], k = xm[1024 + cc], v = xm[2048 + cc];
            const float kkr = k * k_k[cc]; const float ss = wave_sum(kkr * kkr); const float kk = kkr / fmaxf(sqrtf(ss), 1e-12f);
            const float k2 = k * (1.0f + (a - 1.0f) * k_a[cc]); const float rk = wave_sum(r * k2 * r_k[cc]);
            const size_t o = (size_t)row * BW + cc;
            R[o] = r; WD[o] = decay; K2[o] = k2; V[o] = v; KK[o] = kk; BV[o] = kk * a; G[o] = accg; BON[o] = rk * v;
        }
        __syncthreads();
    }
}
__device__ __forceinline__ int kperm_pos(int k) { return (k & ~31) + 8 * ((k >> 2) & 3) + 4 * ((k >> 4) & 1) + (k & 3); }
__device__ __forceinline__ void ph_swa_prompt(const Ctx& c, const bf16_t* __restrict__ U, const float* __restrict__ sinks, bf16_t* __restrict__ OB) {
    LAS bf16_t* K_l = (LAS bf16_t*)c.lds;
    LAS bf16_t* VT_l = K_l + 192 * 72;
    const int tid = c.tid, lane = c.lane, r = lane & 15, q = lane >> 4, w = c.wave;
    for (int u = c.bid; u < PB * 64 * 2; u += c.G) {
        const int b = u >> 7, qb = (u >> 1) & 63, kvh = u & 1, h = kvh * 8 + w;
        const int tok0 = qb * 64 - 128;
        const size_t seq0 = (size_t)b * PS;
        for (int idx = tid; idx < 192 * 8; idx += 512) { const int kl = idx >> 3, c8 = idx & 7, tk = tok0 + kl; u32x4 kv = (u32x4){0u, 0u, 0u, 0u}, vv = kv;
            if (tk >= 0) { const bf16_t* ur = U + (seq0 + tk) * NINP; kv = *(const u32x4*)(ur + U_SK + kvh * 64 + c8 * 8); vv = *(const u32x4*)(ur + U_SV + kvh * 64 + c8 * 8); }
            *(LAS u32x4*)(K_l + kl * 72 + c8 * 8) = kv;
            const int kp = kperm_pos(kl); LAS bf16_t* vp = VT_l + (c8 * 8) * 200 + kp;
            vp[0] = (bf16_t)(vv.x & 0xffffu); vp[200] = (bf16_t)(vv.x >> 16); vp[400] = (bf16_t)(vv.y & 0xffffu); vp[600] = (bf16_t)(vv.y >> 16);
            vp[800] = (bf16_t)(vv.z & 0xffffu); vp[1000] = (bf16_t)(vv.z >> 16); vp[1200] = (bf16_t)(vv.w & 0xffffu); vp[1400] = (bf16_t)(vv.w >> 16); }
        __syncthreads();
        const float slope = exp2f(-0.5f * (float)(h + 1)), sink = sinks[h];
#pragma unroll 1
        for (int i = 0; i < 4; ++i) {
            const size_t qrow = seq0 + qb * 64 + i * 16 + r;
            const bf16x8 qf0 = *(const bf16x8*)(U + qrow * NINP + U_SQ + h * 64 + q * 8), qf1 = *(const bf16x8*)(U + qrow * NINP + U_SQ + h * 64 + 32 + q * 8);
            const int kt0 = i & ~1;
            f32x4 s[10]; float mx = sink; bf16x8 kfr[5][2];
#pragma unroll
            for (int kt = 0; kt < 10; ++kt) { f32x4 d;
                if (kt % 5 == 0) {
#pragma unroll
                    for (int k5 = 0; k5 < 5; ++k5) { const LAS bf16_t* kp = K_l + ((kt0 + kt + k5) * 16 + r) * 72 + q * 8; kfr[k5][0] = *(const LAS bf16x8*)kp; kfr[k5][1] = *(const LAS bf16x8*)(kp + 32); }
                    __builtin_amdgcn_sched_barrier(0); }
                d = mma16(kfr[kt % 5][0], qf0, (f32x4){0.f, 0.f, 0.f, 0.f}); d = mma16(kfr[kt % 5][1], qf1, d);
#pragma unroll
                for (int jj = 0; jj < 4; ++jj) { const int kl = (kt0 + kt) * 16 + q * 4 + jj, dist = i * 16 + r + 128 - kl;
                    const float v = (dist >= 0 && dist <= 128 && tok0 + kl >= 0) ? d[jj] * 0.125f - slope * (float)dist : -1e30f; d[jj] = v; mx = fmaxf(mx, v); }
                s[kt] = d; }
            mx = fmaxf(mx, __shfl_xor(mx, 16, 64)); mx = fmaxf(mx, __shfl_xor(mx, 32, 64));
            float sum = 0.f; bf16x8 pf[5];
#pragma unroll
            for (int kp = 0; kp < 5; ++kp) { f32x4 a = s[2 * kp], bq = s[2 * kp + 1];
#pragma unroll
                for (int jj = 0; jj < 4; ++jj) { a[jj] = __expf(a[jj] - mx); bq[jj] = __expf(bq[jj] - mx); sum += a[jj] + bq[jj]; }
                pf[kp] = pack_acc(a, bq); }
            sum += __shfl_xor(sum, 16, 64); sum += __shfl_xor(sum, 32, 64);
            const float inv = 1.0f / (sum + __expf(sink - mx));
            bf16_t* op = OB + qrow * BW + h * 64 + q * 4;
#pragma unroll
            for (int dt = 0; dt < 4; ++dt) { f32x4 o = (f32x4){0.f, 0.f, 0.f, 0.f}; bf16x8 vfr[5];
#pragma unroll
                for (int kp = 0; kp < 5; ++kp) vfr[kp] = *(const LAS bf16x8*)(VT_l + (dt * 16 + r) * 200 + (kt0 + 2 * kp) * 16 + q * 8);
                __builtin_amdgcn_sched_barrier(0);
#pragma unroll
                for (int kp = 0; kp < 5; ++kp) o = mma16(vfr[kp], pf[kp], o);
                u32x2 ov; ov.x = pk2(o[0] * inv, o[1] * inv); ov.y = pk2(o[2] * inv, o[3] * inv); *(u32x2*)(op + dt * 16) = ov; }
        }
        __syncthreads();
    }
}

__device__ __forceinline__ void ph_swa_sample(const Ctx& c, const bf16_t* __restrict__ U, const float* __restrict__ ck, const float* __restrict__ cv, const float* __restrict__ sinks, bf16_t* __restrict__ OB) {
    LAS bf16_t* K_l = (LAS bf16_t*)c.lds;
    LAS bf16_t* VT_l = K_l + 160 * 72;
    const int tid = c.tid, lane = c.lane, r = lane & 15, q = lane >> 4, w = c.wave;
    for (int u = c.bid; u < SB * 2; u += c.G) {
        const int sq = u >> 1, kvh = u & 1;
        for (int idx = tid; idx < 160 * 8; idx += 512) { const int kl = idx >> 3, c8 = idx & 7; float kx[8], vx[8];
#pragma unroll
            for (int e = 0; e < 8; ++e) { kx[e] = 0.f; vx[e] = 0.f; }
            if (kl < 128) { const size_t o = ((size_t)sq * 128 + kl) * 128 + kvh * 64 + c8 * 8; const f32x4 a = *(const f32x4*)(ck + o), b2 = *(const f32x4*)(ck + o + 4), c2 = *(const f32x4*)(cv + o), d2 = *(const f32x4*)(cv + o + 4);
                kx[0] = a[0]; kx[1] = a[1]; kx[2] = a[2]; kx[3] = a[3]; kx[4] = b2[0]; kx[5] = b2[1]; kx[6] = b2[2]; kx[7] = b2[3];
                vx[0] = c2[0]; vx[1] = c2[1]; vx[2] = c2[2]; vx[3] = c2[3]; vx[4] = d2[0]; vx[5] = d2[1]; vx[6] = d2[2]; vx[7] = d2[3]; }
            else if (kl < 132) { const bf16_t* ur = U + (size_t)(MP + sq * SS + kl - 128) * NINP; unpack8(*(const u32x4*)(ur + U_SK + kvh * 64 + c8 * 8), kx); unpack8(*(const u32x4*)(ur + U_SV + kvh * 64 + c8 * 8), vx); }
            *(LAS u32x4*)(K_l + kl * 72 + c8 * 8) = (u32x4){pk2(kx[0], kx[1]), pk2(kx[2], kx[3]), pk2(kx[4], kx[5]), pk2(kx[6], kx[7])};
            LAS bf16_t* vp = VT_l + (c8 * 8) * 168 + kperm_pos(kl);
#pragma unroll
            for (int e = 0; e < 8; ++e) vp[e * 168] = f2bf(vx[e]); }
        __syncthreads();
        if (w < 2) {
            const int h = kvh * 8 + w * 4 + (r >> 2), tk = r & 3; const size_t qrow = (size_t)(MP + sq * SS + tk);
            const float slope = exp2f(-0.5f * (float)(h + 1)), sink = sinks[h];
            const bf16x8 qf0 = *(const bf16x8*)(U + qrow * NINP + U_SQ + h * 64 + q * 8), qf1 = *(const bf16x8*)(U + qrow * NINP + U_SQ + h * 64 + 32 + q * 8);
            f32x4 s[10]; float mx = sink;
#pragma unroll
            for (int kt = 0; kt < 10; ++kt) { const LAS bf16_t* kp = K_l + (kt * 16 + r) * 72 + q * 8;
                f32x4 d = mma16(*(const LAS bf16x8*)kp, qf0, (f32x4){0.f, 0.f, 0.f, 0.f}); d = mma16(*(const LAS bf16x8*)(kp + 32), qf1, d);
#pragma unroll
                for (int jj = 0; jj < 4; ++jj) { const int kl = kt * 16 + q * 4 + jj, dist = 128 + tk - kl;
                    const float v = (dist >= 0 && dist <= 128) ? d[jj] * 0.125f - slope * (float)dist : -1e30f; d[jj] = v; mx = fmaxf(mx, v); }
                s[kt] = d; }
            mx = fmaxf(mx, __shfl_xor(mx, 16, 64)); mx = fmaxf(mx, __shfl_xor(mx, 32, 64));
            float sum = 0.f; bf16x8 pf[5];
#pragma unroll
            for (int kp = 0; kp < 5; ++kp) { f32x4 a = s[2 * kp], bq = s[2 * kp + 1];
#pragma unroll
                for (int jj = 0; jj < 4; ++jj) { a[jj] = __expf(a[jj] - mx); bq[jj] = __expf(bq[jj] - mx); sum += a[jj] + bq[jj]; }
                pf[kp] = pack_acc(a, bq); }
            sum += __shfl_xor(sum, 16, 64); sum += __shfl_xor(sum, 32, 64);
            const float inv = 1.0f / (sum + __expf(sink - mx));
            bf16_t* op = OB + qrow * BW + h * 64 + q * 4;
#pragma unroll
            for (int dt = 0; dt < 4; ++dt) { f32x4 o = (f32x4){0.f, 0.f, 0.f, 0.f};
#pragma unroll
                for (int kp = 0; kp < 5; ++kp) o = mma16(*(const LAS bf16x8*)(VT_l + (dt * 16 + r) * 168 + kp * 32 + q * 8), pf[kp], o);
                u32x2 ov; ov.x = pk2(o[0] * inv, o[1] * inv); ov.y = pk2(o[2] * inv, o[3] * inv); *(u32x2*)(op + dt * 16) = ov; }
        }
        __syncthreads();
    }
}

__device__ __forceinline__ void ph_lrw(const Ctx& c, const float* __restrict__ w2, const float* __restrict__ a2, const float* __restrict__ g2, bf16_t* __restrict__ LRW) {
    for (int idx = c.bid * 512 + c.tid; idx < NL * 256 * 1024; idx += c.G * 512) {
        const int ch = idx & 1023, j = (idx >> 10) & 255, l = idx >> 18;
        const float v = j < 64 ? w2[((size_t)l * 64 + j) * BW + ch] : (j < 128 ? a2[((size_t)l * 64 + j - 64) * BW + ch] : g2[((size_t)l * 128 + j - 128) * BW + ch]);
        LRW[((size_t)l * 1024 + ch) * 256 + j] = f2bf(v);
    }
}
constexpr int RWP_UNITS = (MP / 64) * 4 + SB * 4;
__device__ __forceinline__ void rwp_unit_info(int u, int& row0, int& ntok, int& hg, int& sq, bool& seq_first) {
    if (u < (MP / 64) * 4) { const int blk = u >> 2; hg = u & 3; row0 = blk * 64; ntok = 64; sq = -1; seq_first = (row0 % PS) == 0; }
    else { const int s = u - (MP / 64) * 4; sq = s >> 2; hg = s & 3; row0 = MP + sq * SS; ntok = SS; seq_first = true; }
}
__device__ __forceinline__ void ph_rwkv_pre(const Ctx& c, const bf16_t* __restrict__ U, const float* __restrict__ shift, const float* __restrict__ mu, const float* __restrict__ w0, const float* __restrict__ w2,
                                            const float* __restrict__ a0, const float* __restrict__ a2, const float* __restrict__ g2, const float* __restrict__ k_k, const float* __restrict__ k_a,
                                            const float* __restrict__ r_k, float* __restrict__ RW, bf16_t* __restrict__ RB, const bf16_t* __restrict__ LRW) {
    LAS bf16_t* P_l = (LAS bf16_t*)c.lds; LAS bf16_t* Kn_l = P_l + 4608; LAS bf16_t* Bn_l = Kn_l + 4608; LAS bf16_t* Q_l = Bn_l + 4608;
    LAS bf16_t* PT_l = Q_l + 4608; LAS bf16_t* BhT_l = PT_l + 4608; LAS bf16_t* KhT_l = BhT_l + 4608; LAS bf16_t* VT_l = KhT_l + 4608;
    LAS float* A_l = (LAS float*)(c.lds + 73728);
    LAS bf16_t* BmT_l = (LAS bf16_t*)(c.lds + 78848); LAS bf16_t* F_l = (LAS bf16_t*)(c.lds + 81920); LAS bf16_t* Tinv_l = (LAS bf16_t*)(c.lds + 84992);
    LAS bf16_t* PpT_l = (LAS bf16_t*)(c.lds + 88064);
    LAS bf16_t* BmpT_l = (LAS bf16_t*)(c.lds + 97280);
    LAS float* GC_l = (LAS float*)(c.lds + 100352);
    LAS float* lg_l = (LAS float*)(c.lds + 125952);
    LAS bf16_t* act_l = (LAS bf16_t*)c.lds;
    LAS bf16_t* wT_l = act_l + 64 * 264;
    LAS bf16_t* aT_l = wT_l + 64 * 72;
    LAS bf16_t* gT_l = aT_l + 64 * 72;
    LAS float* pre_l = (LAS float*)(c.lds + 73728);
    const int tid = c.tid, lane = c.lane, r = lane & 15, q = lane >> 4, w = c.wave;
    float* Gg = RW + 6 * (size_t)MPAD * BW; float* BON = RW + 7 * (size_t)MPAD * BW;
    for (int u = c.bid; u < RWP_UNITS; u += c.G) {
        int row0, ntok, hg, sq; bool seq_first; rwp_unit_info(u, row0, ntok, hg, sq, seq_first);
        const float* sh = sq >= 0 ? shift + (size_t)sq * RWC : nullptr;
        const int nstage = ntok == 64 ? 64 : 16;
        for (int idx = tid; idx < nstage * 32; idx += 512) {
            const int t = idx >> 5, c8 = idx & 31, cc = 3072 + c8 * 8; float val[8];
#pragma unroll
            for (int e2 = 0; e2 < 8; ++e2) val[e2] = 0.f;
            if (t < ntok) { const bf16_t* ur = U + (size_t)(row0 + t) * NINP + U_RU; float x[8], p[8];
                unpack8(*(const u32x4*)(ur + cc), x);
                if (!(t == 0 && seq_first)) unpack8(*(const u32x4*)(ur + cc - NINP), p);
                else if (sh) { const f32x4 s0v = *(const f32x4*)(sh + cc), s1v = *(const f32x4*)(sh + cc + 4); p[0] = s0v[0]; p[1] = s0v[1]; p[2] = s0v[2]; p[3] = s0v[3]; p[4] = s1v[0]; p[5] = s1v[1]; p[6] = s1v[2]; p[7] = s1v[3]; }
                else {
#pragma unroll
                    for (int e2 = 0; e2 < 8; ++e2) p[e2] = 0.f; }
                const f32x4 m0 = *(const f32x4*)(mu + cc), m1 = *(const f32x4*)(mu + cc + 4);
#pragma unroll
                for (int e2 = 0; e2 < 8; ++e2) { const float xm = x[e2] + (p[e2] - x[e2]) * (e2 < 4 ? m0[e2] : m1[e2 - 4]); val[e2] = c8 < 8 ? tanh_fast(xm) : (c8 < 16 ? xm : sigmoidf_(xm)); } }
            *(LAS u32x4*)(act_l + t * 264 + c8 * 8) = (u32x4){pk2(val[0], val[1]), pk2(val[2], val[3]), pk2(val[4], val[5]), pk2(val[6], val[7])};
        }
        __syncthreads();
        bf16x8 af[8];
        { const int tb = w & 3;
#pragma unroll
          for (int ks = 0; ks < 8; ++ks) af[ks] = *(const LAS bf16x8*)(act_l + (tb * 16 + r) * 264 + ks * 32 + q * 8); }
        __syncthreads();
#pragma unroll 1
        for (int hh = 0; hh < 4; ++hh) { const int h = hg * 4 + hh;
        { const int tb = w & 3, chf = w >> 2;
          if (tb * 16 < nstage) {
#pragma unroll
            for (int e2 = 0; e2 < 2; ++e2) { const int cb = chf * 2 + e2; f32x4 dw = (f32x4){0.f, 0.f, 0.f, 0.f}, da = dw, dg = dw;
                const bf16_t* wr = LRW + ((size_t)h * 64 + cb * 16 + r) * 256 + q * 8; bf16x8 wf[8];
#pragma unroll
                for (int ks = 0; ks < 8; ++ks) wf[ks] = *(const bf16x8*)(wr + ks * 32);
                __builtin_amdgcn_sched_barrier(0);
#pragma unroll
                for (int ks = 0; ks < 2; ++ks) { dw = mma16(wf[ks], af[ks], dw); da = mma16(wf[2 + ks], af[2 + ks], da); }
#pragma unroll
                for (int ks = 0; ks < 4; ++ks) dg = mma16(wf[4 + ks], af[4 + ks], dg);
                const int o = (tb * 16 + r) * 68 + cb * 16 + q * 4;
                *(LAS f32x4*)(pre_l + o) = dw; *(LAS f32x4*)(pre_l + 64 * 68 + o) = da; *(LAS f32x4*)(pre_l + 2 * 64 * 68 + o) = dg; } } }
        __syncthreads();
        const int t = tid >> 3, cg = tid & 7, c0 = h * 64 + cg * 8, sc = t >> 4;
        float rr[8], k2[8], kap[8], bet[8], nlw[8];
        { float vx[8], gg[8], kkr[8]; float ss = 0.f, rk = 0.f;
          if (t < ntok) {
            const size_t row = (size_t)(row0 + t); const bf16_t* ur = U + row * NINP + U_RU; const bool fst = (t == 0 && seq_first);
            float kx[8];
#pragma unroll
            for (int part = 0; part < 3; ++part) { const int cc = part * 1024 + c0; float x[8], p[8];
                unpack8(*(const u32x4*)(ur + cc), x);
                if (!fst) unpack8(*(const u32x4*)(ur + cc - NINP), p);
                else {
#pragma unroll
                    for (int j = 0; j < 8; ++j) p[j] = sh ? sh[cc + j] : 0.f; }
                const f32x4 mA = *(const f32x4*)(mu + cc), mB = *(const f32x4*)(mu + cc + 4);
#pragma unroll
                for (int j = 0; j < 8; ++j) { const float xm = x[j] + (p[j] - x[j]) * (j < 4 ? mA[j] : mB[j - 4]); if (part == 0) rr[j] = xm; else if (part == 1) kx[j] = xm; else vx[j] = xm; } }
            float pw[8], pa[8], pkk[8], pka[8], prk[8];
#pragma unroll
            for (int hf = 0; hf < 2; ++hf) { const f32x4 v0 = *(const f32x4*)(w0 + c0 + hf * 4), v1 = *(const f32x4*)(a0 + c0 + hf * 4), v2 = *(const f32x4*)(k_k + c0 + hf * 4), v3 = *(const f32x4*)(k_a + c0 + hf * 4), v4 = *(const f32x4*)(r_k + c0 + hf * 4);
#pragma unroll
                for (int j = 0; j < 4; ++j) { pw[hf * 4 + j] = v0[j]; pa[hf * 4 + j] = v1[j]; pkk[hf * 4 + j] = v2[j]; pka[hf * 4 + j] = v3[j]; prk[hf * 4 + j] = v4[j]; } }
            float lwp[8], app[8];
#pragma unroll
            for (int hf = 0; hf < 2; ++hf) { const f32x4 v0 = *(const LAS f32x4*)(pre_l + t * 68 + cg * 8 + hf * 4), v1 = *(const LAS f32x4*)(pre_l + 64 * 68 + t * 68 + cg * 8 + hf * 4), v2 = *(const LAS f32x4*)(pre_l + 2 * 64 * 68 + t * 68 + cg * 8 + hf * 4);
#pragma unroll
                for (int j = 0; j < 4; ++j) { lwp[hf * 4 + j] = v0[j]; app[hf * 4 + j] = v1[j]; gg[hf * 4 + j] = v2[j]; } }
#pragma unroll
            for (int j = 0; j < 8; ++j) {
                const float lw = -softplus_fast(-(pw[j] + lwp[j])) - 0.5f; nlw[j] = -__expf(lw); const float av = sigmoidf_(pa[j] + app[j]);
                kkr[j] = kx[j] * pkk[j]; ss += kkr[j] * kkr[j]; k2[j] = kx[j] * (1.0f + (av - 1.0f) * pka[j]); rk += rr[j] * k2[j] * prk[j]; bet[j] = av; }
          } else {
#pragma unroll
            for (int j = 0; j < 8; ++j) { rr[j] = 0.f; k2[j] = 0.f; kkr[j] = 0.f; bet[j] = 0.f; nlw[j] = 0.f; vx[j] = 0.f; gg[j] = 0.f; }
          }
          ss += __shfl_xor(ss, 1, 64); ss += __shfl_xor(ss, 2, 64); ss += __shfl_xor(ss, 4, 64);
          rk += __shfl_xor(rk, 1, 64); rk += __shfl_xor(rk, 2, 64); rk += __shfl_xor(rk, 4, 64);
          const float inv = 1.0f / fmaxf(sqrtf(ss), 1e-12f);
#pragma unroll
          for (int j = 0; j < 8; ++j) { kap[j] = kkr[j] * inv; bet[j] = kap[j] * bet[j]; }
          if (t < ntok) { const size_t o = (size_t)(row0 + t) * BW + c0;
              *(f32x4*)(Gg + o) = (f32x4){gg[0], gg[1], gg[2], gg[3]}; *(f32x4*)(Gg + o + 4) = (f32x4){gg[4], gg[5], gg[6], gg[7]};
              *(f32x4*)(BON + o) = (f32x4){rk * vx[0], rk * vx[1], rk * vx[2], rk * vx[3]}; *(f32x4*)(BON + o + 4) = (f32x4){rk * vx[4], rk * vx[5], rk * vx[6], rk * vx[7]}; }
          *(LAS f32x4*)(lg_l + t * 68 + cg * 8) = (f32x4){nlw[0], nlw[1], nlw[2], nlw[3]}; *(LAS f32x4*)(lg_l + t * 68 + cg * 8 + 4) = (f32x4){nlw[4], nlw[5], nlw[6], nlw[7]};
#pragma unroll
          for (int j = 0; j < 8; ++j) VT_l[(cg * 8 + j) * 72 + t] = f2bf(vx[j]);
        }
        __syncthreads();
        if (tid < 256) { const int cc = tid & 63, s4 = tid >> 6; float run = 0.f;
#pragma unroll
            for (int i = 0; i < 16; ++i) { const int o = (s4 * 16 + i) * 68 + cc; run += lg_l[o]; lg_l[o] = run; } }
        __syncthreads();
        { unsigned pp[4], pq[4], pk[4], pb[4];
#pragma unroll
          for (int j = 0; j < 8; j += 2) { float vP[2], vQ[2], vK[2], vB[2];
#pragma unroll
              for (int e = 0; e < 2; ++e) { const int jj = j + e, cc = cg * 8 + jj; const float ci = lg_l[t * 68 + cc], cC = lg_l[(sc * 16 + 15) * 68 + cc];
                  const float ei = __expf(-ci), eh = __expf(cC - ci);
                  vP[e] = kap[jj] * __expf(ci - nlw[jj]); vQ[e] = rr[jj] * __expf(ci); vK[e] = k2[jj] * ei; vB[e] = bet[jj] * ei;
                  PT_l[cc * 72 + t] = f2bf(vP[e]); BhT_l[cc * 72 + t] = f2bf(bet[jj] * eh); KhT_l[cc * 72 + t] = f2bf(k2[jj] * eh); }
              pp[j >> 1] = pk2(vP[0], vP[1]); pq[j >> 1] = pk2(vQ[0], vQ[1]); pk[j >> 1] = pk2(vK[0], vK[1]); pb[j >> 1] = pk2(vB[0], vB[1]); }
          const int o = t * 72 + cg * 8;
          *(LAS u32x4*)(P_l + o) = (u32x4){pp[0], pp[1], pp[2], pp[3]}; *(LAS u32x4*)(Q_l + o) = (u32x4){pq[0], pq[1], pq[2], pq[3]};
          *(LAS u32x4*)(Kn_l + o) = (u32x4){pk[0], pk[1], pk[2], pk[3]}; *(LAS u32x4*)(Bn_l + o) = (u32x4){pb[0], pb[1], pb[2], pb[3]};
          if ((t & 15) == 15) {
#pragma unroll
              for (int j = 0; j < 8; ++j) GC_l[sc * 64 + cg * 8 + j] = __expf(lg_l[t * 68 + cg * 8 + j]); } }
        __syncthreads();
        const int nsub = ntok == 64 ? 4 : 1;
        const bf16x8 zfrag = (bf16x8){0, 0, 0, 0, 0, 0, 0, 0};
        for (int id = w; id < nsub * 3; id += 8) { const int s4 = id / 3, prod = id - s4 * 3; f32x4 d = (f32x4){0.f, 0.f, 0.f, 0.f};
            const LAS bf16_t* X = (prod == 1 ? P_l : Bn_l) + (s4 * 16 + r) * 72 + q * 8; const LAS bf16_t* Y = (prod == 0 ? P_l : (prod == 1 ? Kn_l : Q_l)) + (s4 * 16 + r) * 72 + q * 8;
            { const bf16x8 x0 = *(const LAS bf16x8*)X, x1 = *(const LAS bf16x8*)(X + 32), y0 = *(const LAS bf16x8*)Y, y1 = *(const LAS bf16x8*)(Y + 32);
              __builtin_amdgcn_sched_barrier(0); d = mma16(x0, y0, d); d = mma16(x1, y1, d); }
            if (prod == 0) { f32x4 o4;
#pragma unroll
                for (int jj = 0; jj < 4; ++jj) o4[jj] = (q * 4 + jj < r) ? d[jj] : 0.f;
                *(LAS f32x4*)(A_l + s4 * 320 + r * 20 + q * 4) = o4; }
            else { float o4[4];
#pragma unroll
                for (int jj = 0; jj < 4; ++jj) o4[jj] = (prod == 1 ? (r < q * 4 + jj) : (q * 4 + jj <= r)) ? d[jj] : 0.f;
                u32x2 o; o.x = pk2(o4[0], o4[1]); o.y = pk2(o4[2], o4[3]); *(LAS u32x2*)((prod == 1 ? BmT_l : F_l) + s4 * 384 + r * 24 + q * 4) = o; } }
        __syncthreads();
        if (w == 0 && (lane >> 4) < nsub) { const int s4 = lane >> 4, jc = lane & 15; float x[16];
#pragma unroll
            for (int tt = 0; tt < 16; ++tt) { float s = (tt == jc) ? 1.f : 0.f;
#pragma unroll
                for (int i = 0; i < tt; ++i) s -= A_l[s4 * 320 + tt * 20 + i] * x[i];
                x[tt] = s; }
#pragma unroll
            for (int tt = 0; tt < 16; ++tt) Tinv_l[s4 * 384 + tt * 24 + jc] = f2bf(x[tt]); }
        __syncthreads();
        for (int id = w; id < nsub * 5; id += 8) { const int s4 = id / 5, rem = id - s4 * 5;
            const bf16x8 xf = q < 2 ? *(const LAS bf16x8*)(Tinv_l + s4 * 384 + r * 24 + q * 8) : zfrag;
            const bf16x8 yf = q < 2 ? (rem < 4 ? *(const LAS bf16x8*)(PT_l + (rem * 16 + r) * 72 + s4 * 16 + q * 8) : *(const LAS bf16x8*)(BmT_l + s4 * 384 + r * 24 + q * 8)) : zfrag;
            const f32x4 d = mma16(xf, yf, (f32x4){0.f, 0.f, 0.f, 0.f});
            u32x2 o; o.x = pk2(d[0], d[1]); o.y = pk2(d[2], d[3]);
            if (rem < 4) *(LAS u32x2*)(PpT_l + (rem * 16 + r) * 72 + s4 * 16 + q * 4) = o; else *(LAS u32x2*)(BmpT_l + s4 * 384 + r * 24 + q * 4) = o; }
        __syncthreads();
        { const int chunk0 = sq >= 0 ? PB * 16 * 256 + sq * 16 + h : ((row0 / PS) * 16 + h) * 256 + ((row0 % PS) >> 4);
          for (int id = w; id < nsub * 25; id += 8) { const int s4 = id / 25, rem = id - s4 * 25; bf16_t* blob = RB + (size_t)(chunk0 + s4) * RB_EL;
            const bf16x8 fF = q < 2 ? *(const LAS bf16x8*)(F_l + s4 * 384 + r * 24 + q * 8) : zfrag;
            if (rem < 4) {
                const bf16x8 xf = q < 2 ? *(const LAS bf16x8*)(PpT_l + (rem * 16 + r) * 72 + s4 * 16 + q * 8) : zfrag;
                const f32x4 d = mma16(xf, fF, (f32x4){0.f, 0.f, 0.f, 0.f});
                const u32x2 qv = *(const LAS u32x2*)(Q_l + (s4 * 16 + r) * 72 + rem * 16 + q * 4);
                u32x2 o; o.x = pk2(__uint_as_float(qv.x << 16) - d[0], __uint_as_float(qv.x & 0xffff0000u) - d[1]); o.y = pk2(__uint_as_float(qv.y << 16) - d[2], __uint_as_float(qv.y & 0xffff0000u) - d[3]);
                *(u32x2*)(blob + RB_QP + r * 72 + 32 * (rem >> 1) + 8 * q + 4 * (rem & 1)) = o;
            } else if (rem == 4) {
                f32x4 d2 = (f32x4){0.f, 0.f, 0.f, 0.f};
#pragma unroll
                for (int ks = 0; ks < 2; ++ks) d2 = mma16(*(const LAS bf16x8*)(Kn_l + (s4 * 16 + r) * 72 + ks * 32 + q * 8), *(const LAS bf16x8*)(Q_l + (s4 * 16 + r) * 72 + ks * 32 + q * 8), d2);
                const bf16x8 xf = q < 2 ? *(const LAS bf16x8*)(BmpT_l + s4 * 384 + r * 24 + q * 8) : zfrag;
                const f32x4 d1 = mma16(xf, fF, (f32x4){0.f, 0.f, 0.f, 0.f});
                float o4[4];
#pragma unroll
                for (int jj = 0; jj < 4; ++jj) o4[jj] = ((q * 4 + jj <= r) ? d2[jj] : 0.f) - d1[jj];
                u32x2 o; o.x = pk2(o4[0], o4[1]); o.y = pk2(o4[2], o4[3]); *(u32x2*)(blob + RB_EP + r * 24 + q * 4) = o;
            } else if (rem < 21) {
                const int cib = (rem - 5) >> 2, cob = (rem - 5) & 3;
                const bf16x8 xf = q < 2 ? *(const LAS bf16x8*)(PpT_l + (cib * 16 + r) * 72 + s4 * 16 + q * 8) : zfrag;
                const bf16x8 yf = q < 2 ? *(const LAS bf16x8*)(BhT_l + (cob * 16 + r) * 72 + s4 * 16 + q * 8) : zfrag;
                const f32x4 d = mma16(xf, yf, (f32x4){0.f, 0.f, 0.f, 0.f});
                const float gc = GC_l[s4 * 64 + cob * 16 + r]; float o4[4];
#pragma unroll
                for (int jj = 0; jj < 4; ++jj) o4[jj] = ((cib == cob && q * 4 + jj == r) ? gc : 0.f) - d[jj];
                u32x2 o; o.x = pk2(o4[0], o4[1]); o.y = pk2(o4[2], o4[3]); *(u32x2*)(blob + (cob * 16 + r) * 72 + 32 * (cib >> 1) + 8 * q + 4 * (cib & 1)) = o;
            } else {
                const int cb = rem - 21;
                const bf16x8 xf = q < 2 ? *(const LAS bf16x8*)(BmpT_l + s4 * 384 + r * 24 + q * 8) : zfrag;
                const bf16x8 yf = q < 2 ? *(const LAS bf16x8*)(BhT_l + (cb * 16 + r) * 72 + s4 * 16 + q * 8) : zfrag;
                const f32x4 d = mma16(xf, yf, (f32x4){0.f, 0.f, 0.f, 0.f});
                const u32x2 kv = *(const LAS u32x2*)(KhT_l + (cb * 16 + r) * 72 + s4 * 16 + q * 4);
                u32x2 o; o.x = pk2(__uint_as_float(kv.x << 16) - d[0], __uint_as_float(kv.x & 0xffff0000u) - d[1]); o.y = pk2(__uint_as_float(kv.y << 16) - d[2], __uint_as_float(kv.y & 0xffff0000u) - d[3]);
                *(u32x2*)(blob + RB_KHP + (cb * 16 + r) * 24 + q * 4) = o;
            } }
          for (int idx = tid; idx < nsub * 128; idx += 512) { const int s4 = idx >> 7, cc = (idx >> 1) & 63, hf = idx & 1;
              *(u32x4*)(RB + (size_t)(chunk0 + s4) * RB_EL + RB_VT + cc * 24 + hf * 8) = *(const LAS u32x4*)(VT_l + cc * 72 + s4 * 16 + hf * 8); } }
        __syncthreads();
        }
    }
}

__device__ __forceinline__ void ph_rwkv_scan_naive(const Ctx& c, const float* __restrict__ RW, const float* __restrict__ s0, const float* __restrict__ lng, const float* __restrict__ lnb, bf16_t* __restrict__ OB,
                                                   float* __restrict__ outP, float* __restrict__ outS) {
    const float* R = RW; const float* WD = RW + (size_t)MPAD * BW; const float* K2 = WD + (size_t)MPAD * BW; const float* V = K2 + (size_t)MPAD * BW; const float* KK = V + (size_t)MPAD * BW;
    const float* BV = KK + (size_t)MPAD * BW; const float* G = BV + (size_t)MPAD * BW; const float* BON = G + (size_t)MPAD * BW;
    const int lane = c.lane;
    for (int it = 0;; ++it) {
        const int u = (it * 8 + c.wave) * c.G + c.bid;
        if (u >= (PB + SB) * 16) break;
        const int sq = u >> 4, h = u & 15;
        int row0, L; seq_info(sq, row0, L);
        float S[64];
        if (sq >= PB) { const float* p = s0 + (((size_t)(sq - PB) * 16 + h) * 64 + lane) * 64;
#pragma unroll
            for (int j = 0; j < 64; ++j) S[j] = p[j]; }
        else {
#pragma unroll
            for (int j = 0; j < 64; ++j) S[j] = 0.f; }
        const float lg = lng[h * 64 + lane], lb = lnb[h * 64 + lane];
        for (int t = 0; t < L; ++t) {
            const size_t base = (size_t)(row0 + t) * BW + h * 64; const float v = V[base + lane];
            float d = 0.f;
#pragma unroll
            for (int j = 0; j < 64; ++j) d += S[j] * KK[base + j];
            float y = 0.f;
#pragma unroll
            for (int j = 0; j < 64; ++j) { S[j] = S[j] * WD[base + j] - d * BV[base + j] + v * K2[base + j]; y += S[j] * R[base + j]; }
            const float mean = wave_sum(y) * (1.0f / 64.0f), dy = y - mean, var = wave_sum(dy * dy) * (1.0f / 64.0f);
            const float yn = dy * rsqrtf(var + 64e-5f) * lg + lb;
            OB[base + lane] = f2bf((yn + BON[base + lane]) * G[base + lane]);
        }
        float* op = (sq < PB ? outP + (((size_t)sq * 16 + h) * 64 + lane) * 64 : outS + (((size_t)(sq - PB) * 16 + h) * 64 + lane) * 64);
#pragma unroll
        for (int j = 0; j < 64; ++j) op[j] = S[j];
    }
}
__device__ __forceinline__ void ph_rwkv_scan2(const Ctx& c, int boff, const float* __restrict__ RW, const float* __restrict__ s0, const float* __restrict__ lng, const float* __restrict__ lnb, bf16_t* __restrict__ OB,
                                              float* __restrict__ outP, float* __restrict__ outS) {
    LAS float* opb = (LAS float*)c.lds;
    LAS float* yb = opb + 2 * 16 * 384;
    const int tid = c.tid, lane = c.lane, w = c.wave, rl = lane >> 3, cg = lane & 7, vrow = w * 8 + rl;
    const float* G = RW + 6 * (size_t)MPAD * BW; const float* BON = RW + 7 * (size_t)MPAD * BW;
    for (int u = (c.bid - boff + c.G) % c.G; u < (PB + SB) * 16; u += c.G) {
        const int sq = u >> 4, h = u & 15;
        int row0, L; seq_info(sq, row0, L);
        float S[8];
        if (sq >= PB) { const float* p = s0 + (((size_t)(sq - PB) * 16 + h) * 64 + vrow) * 64 + cg * 8;
#pragma unroll
            for (int j = 0; j < 8; ++j) S[j] = p[j]; }
        else {
#pragma unroll
            for (int j = 0; j < 8; ++j) S[j] = 0.f; }
        const float lg = lng[h * 64 + lane], lb = lnb[h * 64 + lane];
        const int nb = (L + 15) >> 4;
#define RW_STAGE(bi_) do { const int t0_ = (bi_) * 16, nT_ = (L - t0_) < 16 ? (L - t0_) : 16; LAS float* dst_ = opb + ((bi_) & 1) * 16 * 384; \
        for (int idx = tid; idx < nT_ * 96; idx += 512) { const int t = idx / 96, rem = idx - t * 96, slot = rem >> 4, c4 = rem & 15; \
            const int arr = slot == 0 ? 1 : slot == 1 ? 4 : slot == 2 ? 5 : slot == 3 ? 2 : slot == 4 ? 0 : 3; \
            *(LAS f32x4*)(dst_ + t * 384 + slot * 64 + c4 * 4) = *(const f32x4*)(RW + (size_t)arr * MPAD * BW + (size_t)(row0 + t0_ + t) * BW + h * 64 + c4 * 4); } } while (0)
        RW_STAGE(0);
        for (int bi = 0; bi < nb; ++bi) {
            __syncthreads();
            if (bi + 1 < nb) RW_STAGE(bi + 1);
            const int t0 = bi * 16, nT = (L - t0) < 16 ? (L - t0) : 16; const LAS float* src = opb + (bi & 1) * 16 * 384;
            for (int tt = 0; tt < nT; ++tt) {
                const LAS float* b = src + tt * 384 + cg * 8;
                const f32x4 w0 = *(const LAS f32x4*)(b), w1 = *(const LAS f32x4*)(b + 4), k0 = *(const LAS f32x4*)(b + 64), k1 = *(const LAS f32x4*)(b + 68);
                const f32x4 b0 = *(const LAS f32x4*)(b + 128), b1 = *(const LAS f32x4*)(b + 132), q0 = *(const LAS f32x4*)(b + 192), q1 = *(const LAS f32x4*)(b + 196);
                const f32x4 r0 = *(const LAS f32x4*)(b + 256), r1 = *(const LAS f32x4*)(b + 260); const float v = src[tt * 384 + 320 + vrow];
                float d = (S[0] * k0[0] + S[1] * k0[1]) + (S[2] * k0[2] + S[3] * k0[3]) + (S[4] * k1[0] + S[5] * k1[1]) + (S[6] * k1[2] + S[7] * k1[3]);
                d += __shfl_xor(d, 1, 64); d += __shfl_xor(d, 2, 64); d += __shfl_xor(d, 4, 64);
                float y = 0.f;
#pragma unroll
                for (int j = 0; j < 4; ++j) { S[j] = S[j] * w0[j] - d * b0[j] + v * q0[j]; y += S[j] * r0[j]; S[4 + j] = S[4 + j] * w1[j] - d * b1[j] + v * q1[j]; y += S[4 + j] * r1[j]; }
                y += __shfl_xor(y, 1, 64); y += __shfl_xor(y, 2, 64); y += __shfl_xor(y, 4, 64);
                if (cg == 0) yb[tt * 64 + vrow] = y;
            }
            __syncthreads();
            for (int tt = w; tt < nT; tt += 8) {
                const float y = yb[tt * 64 + lane]; const float mean = wave_sum(y) * (1.0f / 64.0f), dy = y - mean, var = wave_sum(dy * dy) * (1.0f / 64.0f);
                const float yn = dy * rsqrtf(var + 64e-5f) * lg + lb; const size_t o = (size_t)(row0 + t0 + tt) * BW + h * 64 + lane;
                OB[o] = f2bf((yn + BON[o]) * G[o]);
            }
        }
#undef RW_STAGE
        float* op = (sq < PB ? outP + (((size_t)sq * 16 + h) * 64 + vrow) * 64 : outS + (((size_t)(sq - PB) * 16 + h) * 64 + vrow) * 64) + cg * 8;
#pragma unroll
        for (int j = 0; j < 8; ++j) op[j] = S[j];
        __syncthreads();
    }
}
constexpr int RS_SLOTS = 8, RS_SLOT_B = RB_EL * 2;
__device__ __forceinline__ void ph_rwkv_seq(const Ctx& c, int boff, const bf16_t* __restrict__ RB, const float* __restrict__ s0, float* __restrict__ outP, float* __restrict__ outS, bf16_t* __restrict__ OB) {
    const int lane = c.lane, r = lane & 15, q = lane >> 4, w = c.wave;
    LAS unsigned char* ring = c.lds;
    const int side = c.bid < 32 ? c.bid : c.bid - 64, nside = c.G - 64;
    for (int u = (c.bid >= boff && c.bid < boff + 32) ? c.bid - boff : ((c.bid < 32 || c.bid >= 96) ? 32 + side : (PB + SB) * 16); u < (PB + SB) * 16; u = u < 32 ? (PB + SB) * 16 : u + nside) {
        const int sq = u >> 4, h = u & 15;
        int nch, ch0, row0, ntok; const float* sp = nullptr; float* op;
        if (sq < PB) { nch = 256; ch0 = (sq * 16 + h) * 256; row0 = sq * PS; ntok = 16; op = outP + (size_t)(sq * 16 + h) * 4096; }
        else { nch = 1; ch0 = PB * 16 * 256 + (sq - PB) * 16 + h; row0 = MP + (sq - PB) * SS; ntok = SS; sp = s0 + (size_t)((sq - PB) * 16 + h) * 4096; op = outS + (size_t)((sq - PB) * 16 + h) * 4096; }
        if (w >= 4) {
            const int lw = w - 4, p0 = lw < 2 ? lw * 5 : 10 + (lw - 2) * 4, np = lw < 2 ? 5 : 4;
#define RS_ISSUE(ci_) do { const int cc_ = (ci_) < nch ? (ci_) : nch - 1; const char* g_ = (const char*)(RB + (size_t)(ch0 + cc_) * RB_EL) + p0 * 1024 + lane * 16; \
            LAS unsigned char* d_ = ring + ((ci_) % RS_SLOTS) * RS_SLOT_B + p0 * 1024; \
            _Pragma("unroll") for (int p_ = 0; p_ < 5; ++p_) if (p_ < np) __builtin_amdgcn_global_load_lds((const unsigned*)(g_ + p_ * 1024), (LAS unsigned*)(d_ + p_ * 1024), 16, 0, 0); } while (0)
            for (int ci = 0; ci < RS_SLOTS - 1; ++ci) RS_ISSUE(ci);
            if (lw < 2) asm volatile("s_waitcnt vmcnt(30)" ::: "memory"); else asm volatile("s_waitcnt vmcnt(24)" ::: "memory");
            __builtin_amdgcn_s_barrier();
            for (int ci = 0; ci < nch; ++ci) {
                RS_ISSUE(ci + RS_SLOTS - 1);
                if (lw < 2) asm volatile("s_waitcnt vmcnt(30)" ::: "memory"); else asm volatile("s_waitcnt vmcnt(24)" ::: "memory");
                __builtin_amdgcn_s_barrier();
            }
#undef RS_ISSUE
            asm volatile("s_waitcnt vmcnt(0)" ::: "memory");
        } else {
            const int vb = w; f32x4 acc[4];
#pragma unroll
            for (int kb = 0; kb < 4; ++kb) acc[kb] = sp ? *(const f32x4*)(sp + (size_t)(vb * 16 + r) * 64 + kb * 16 + q * 4) : (f32x4){0.f, 0.f, 0.f, 0.f};
            const bf16x8 zfrag = (bf16x8){0, 0, 0, 0, 0, 0, 0, 0};
            __builtin_amdgcn_s_barrier();
            for (int ci = 0; ci < nch; ++ci) {
                const LAS bf16_t* blob = (const LAS bf16_t*)(ring + (ci % RS_SLOTS) * RS_SLOT_B);
                bf16x8 mf[4][2], khf[4], qpf[2];
#pragma unroll
                for (int kb = 0; kb < 4; ++kb) { mf[kb][0] = *(const LAS bf16x8*)(blob + (kb * 16 + r) * 72 + q * 8); mf[kb][1] = *(const LAS bf16x8*)(blob + (kb * 16 + r) * 72 + 32 + q * 8);
                    khf[kb] = q < 2 ? *(const LAS bf16x8*)(blob + RB_KHP + (kb * 16 + r) * 24 + q * 8) : zfrag; }
                qpf[0] = *(const LAS bf16x8*)(blob + RB_QP + r * 72 + q * 8); qpf[1] = *(const LAS bf16x8*)(blob + RB_QP + r * 72 + 32 + q * 8);
                const bf16x8 vt = q < 2 ? *(const LAS bf16x8*)(blob + RB_VT + (vb * 16 + r) * 24 + q * 8) : zfrag;
                const bf16x8 ep = q < 2 ? *(const LAS bf16x8*)(blob + RB_EP + r * 24 + q * 8) : zfrag;
                const bf16x8 t0 = pack_acc(acc[0], acc[1]), t1 = pack_acc(acc[2], acc[3]);
                __builtin_amdgcn_sched_barrier(0);
#pragma unroll
                for (int kb = 0; kb < 4; ++kb) acc[kb] = mma16(mf[kb][0], t0, (f32x4){0.f, 0.f, 0.f, 0.f});
#pragma unroll
                for (int kb = 0; kb < 4; ++kb) acc[kb] = mma16(mf[kb][1], t1, acc[kb]);
#pragma unroll
                for (int kb = 0; kb < 4; ++kb) acc[kb] = mma16(khf[kb], vt, acc[kb]);
                f32x4 y = mma16(t0, qpf[0], (f32x4){0.f, 0.f, 0.f, 0.f}); y = mma16(t1, qpf[1], y); y = mma16(vt, ep, y);
                if (r < ntok) { u32x2 o; o.x = pk2(y[0], y[1]); o.y = pk2(y[2], y[3]); *(u32x2*)(OB + (size_t)(row0 + ci * 16 + r) * BW + h * 64 + vb * 16 + q * 4) = o; }
                asm volatile("s_waitcnt lgkmcnt(0)" ::: "memory");
                __builtin_amdgcn_s_barrier();
            }
#pragma unroll
            for (int kb = 0; kb < 4; ++kb) *(f32x4*)(op + (size_t)(vb * 16 + r) * 64 + kb * 16 + q * 4) = acc[kb];
        }
        __syncthreads();
    }
}
__device__ __forceinline__ void ph_rwkv_fin(const Ctx& c, const float* __restrict__ RW, const float* __restrict__ lng, const float* __restrict__ lnb, const bf16_t* __restrict__ RAW, bf16_t* __restrict__ OB) {
    const int lane = c.lane; const float* G = RW + 6 * (size_t)MPAD * BW; const float* BON = RW + 7 * (size_t)MPAD * BW;
    for (int i = c.bid * 8 + c.wave; i < MT * 4; i += c.G * 8) {
        const int row = i >> 2, cc = (i & 3) * 256 + lane * 4; const size_t o = (size_t)row * BW + cc; bf16_t* p = OB + o;
        const u32x2 raw = *(const u32x2*)(RAW + o); float x[4] = {__uint_as_float(raw.x << 16), __uint_as_float(raw.x & 0xffff0000u), __uint_as_float(raw.y << 16), __uint_as_float(raw.y & 0xffff0000u)};
        float s = (x[0] + x[1]) + (x[2] + x[3]); s += __shfl_xor(s, 1, 64); s += __shfl_xor(s, 2, 64); s += __shfl_xor(s, 4, 64); s += __shfl_xor(s, 8, 64);
        const float mean = s * (1.0f / 64.0f); float qq = 0.f;
#pragma unroll
        for (int j = 0; j < 4; ++j) { const float d = x[j] - mean; qq += d * d; }
        qq += __shfl_xor(qq, 1, 64); qq += __shfl_xor(qq, 2, 64); qq += __shfl_xor(qq, 4, 64); qq += __shfl_xor(qq, 8, 64);
        const float rstd = rsqrtf(qq * (1.0f / 64.0f) + 64e-5f);
        const f32x4 gg = *(const f32x4*)(lng + cc), bb = *(const f32x4*)(lnb + cc), bo = *(const f32x4*)(BON + o), gt = *(const f32x4*)(G + o); float ov[4];
#pragma unroll
        for (int j = 0; j < 4; ++j) ov[j] = ((x[j] - mean) * rstd * gg[j] + bb[j] + bo[j]) * gt[j];
        u32x2 oo; oo.x = pk2(ov[0], ov[1]); oo.y = pk2(ov[2], ov[3]); *(u32x2*)p = oo;
    }
}

__device__ __forceinline__ void ph_memattn_sample(const Ctx& c, int boff, const bf16_t* __restrict__ U, const float* __restrict__ mk, const float* __restrict__ mv, bf16_t* __restrict__ OB) {
    LAS float* ps = (LAS float*)c.lds;
    const int hh = c.tid >> 8, vt = c.tid & 255, lane = c.lane, r = lane & 15, q = lane >> 4, w4 = c.wave & 3;
    for (int u = (c.bid - boff + c.G) % c.G; u < SB * 2; u += c.G) {
        const int sq = u >> 1, h = (u & 1) * 2 + hh;
        bf16x8 qf[8];
#pragma unroll
        for (int ks = 0; ks < 8; ++ks) { u32x4 raw = (u32x4){0u, 0u, 0u, 0u};
            if (r < 4) raw = *(const u32x4*)(U + (size_t)(MP + sq * SS + r) * NINP + U_MQ + h * 256 + ks * 32 + q * 8);
            qf[ks] = __builtin_bit_cast(bf16x8, raw); }
#pragma unroll 1
        for (int mt = 0; mt < 4; ++mt) { const float* kr = mk + (((size_t)sq * MEMT + (w4 * 4 + mt) * 16 + r) * 4 + h) * 256 + q * 8; f32x4 ka[8], kb2[8];
#pragma unroll
            for (int ks = 0; ks < 8; ++ks) { ka[ks] = *(const f32x4*)(kr + ks * 32); kb2[ks] = *(const f32x4*)(kr + ks * 32 + 4); }
            __builtin_amdgcn_sched_barrier(0);
            f32x4 d = (f32x4){0.f, 0.f, 0.f, 0.f};
#pragma unroll
            for (int ks = 0; ks < 8; ++ks) { u32x4 p; p.x = pk2(ka[ks][0], ka[ks][1]); p.y = pk2(ka[ks][2], ka[ks][3]); p.z = pk2(kb2[ks][0], kb2[ks][1]); p.w = pk2(kb2[ks][2], kb2[ks][3]);
                d = mma16(__builtin_bit_cast(bf16x8, p), qf[ks], d); }
            if (r < 4) *(LAS f32x4*)(ps + (hh * 4 + r) * 256 + (w4 * 4 + mt) * 16 + q * 4) = d * 0.0625f; }
        __syncthreads();
        { LAS float* pr = ps + c.wave * 256; float x[4]; float mx = -3.0e38f;
#pragma unroll
            for (int j = 0; j < 4; ++j) { x[j] = pr[lane + 64 * j]; mx = fmaxf(mx, x[j]); }
            mx = wave_max(mx); float s = 0.f;
#pragma unroll
            for (int j = 0; j < 4; ++j) { x[j] = __expf(x[j] - mx); s += x[j]; }
            const float inv = 1.0f / wave_sum(s);
#pragma unroll
            for (int j = 0; j < 4; ++j) pr[lane + 64 * j] = x[j] * inv; }
        __syncthreads();
        { float o[4] = {0.f, 0.f, 0.f, 0.f}; const float* vr = mv + ((size_t)sq * MEMT * 4 + h) * 256 + vt;
#pragma unroll 8
            for (int m = 0; m < MEMT; ++m) { const float vv = vr[(size_t)m * 1024];
#pragma unroll
                for (int t = 0; t < 4; ++t) o[t] += ps[(hh * 4 + t) * 256 + m] * vv; }
#pragma unroll
            for (int t = 0; t < 4; ++t) OB[(size_t)(MP + sq * SS + t) * BW + h * 256 + vt] = f2bf(o[t]); }
        __syncthreads();
    }
}

template <int K, int LDA, int LDB> __device__ __forceinline__ void skinny_pair(const Ctx& c, const bf16_t* __restrict__ A, const bf16_t* __restrict__ B0, const bf16_t* __restrict__ B1, f32x4 (&out)[2], int rot) {
    LAS f32x4* red = (LAS f32x4*)c.lds;
    const int lane = c.lane, r = lane & 15, q = lane >> 4, w = c.wave;
    constexpr int KS = K / 8;
    const bf16_t* ap = A + (size_t)r * LDA + w * KS + q * 8; const bf16_t* b0 = B0 + (size_t)r * LDB + w * KS + q * 8; const bf16_t* b1 = B1 + (size_t)r * LDB + w * KS + q * 8;
    f32x4 acc[2][8];
#pragma unroll
    for (int n = 0; n < 2; ++n)
#pragma unroll
        for (int m = 0; m < 8; ++m) acc[n][m] = (f32x4){0.f, 0.f, 0.f, 0.f};
    int kk = (int)((unsigned)rot % (unsigned)(KS / 32));
#pragma unroll 2
    for (int it = 0; it < KS / 32; ++it) { const int ks = kk; kk = kk + 1 == KS / 32 ? 0 : kk + 1;
        const bf16x8 f0 = *(const bf16x8*)(b0 + ks * 32), f1 = *(const bf16x8*)(b1 + ks * 32); bf16x8 af[8];
#pragma unroll
        for (int m = 0; m < 8; ++m) af[m] = *(const bf16x8*)(ap + (size_t)(m * 16) * LDA + ks * 32);
        __builtin_amdgcn_sched_barrier(0);
#pragma unroll
        for (int m = 0; m < 8; ++m) { acc[0][m] = mma16(f0, af[m], acc[0][m]); acc[1][m] = mma16(f1, af[m], acc[1][m]); } }
    __syncthreads();
#pragma unroll
    for (int n = 0; n < 2; ++n)
#pragma unroll
        for (int m = 0; m < 8; ++m) red[(w * 16 + n * 8 + m) * 64 + lane] = acc[n][m];
    __syncthreads();
#pragma unroll
    for (int n = 0; n < 2; ++n) { f32x4 s = red[(n * 8 + w) * 64 + lane];
#pragma unroll
        for (int ww = 1; ww < 8; ++ww) s += red[(ww * 16 + n * 8 + w) * 64 + lane];
        out[n] = s; }
}
template <int K, int LDA, int LDB> __device__ __forceinline__ f32x4 skinny_one(const Ctx& c, const bf16_t* __restrict__ A, const bf16_t* __restrict__ B0, int rot) {
    LAS f32x4* red = (LAS f32x4*)c.lds;
    const int lane = c.lane, r = lane & 15, q = lane >> 4, w = c.wave;
    constexpr int KS = K / 8, NK = KS / 32;
    const bf16_t* ap = A + (size_t)r * LDA + w * KS + q * 8; const bf16_t* b0 = B0 + (size_t)r * LDB + w * KS + q * 8;
    f32x4 acc[8];
#pragma unroll
    for (int m = 0; m < 8; ++m) acc[m] = (f32x4){0.f, 0.f, 0.f, 0.f};
    int kk = (int)((unsigned)rot % (unsigned)NK);
#pragma unroll 4
    for (int it = 0; it < NK; ++it) { const int ks = kk; kk = kk + 1 == NK ? 0 : kk + 1;
        const bf16x8 f0 = *(const bf16x8*)(b0 + ks * 32); bf16x8 af[8];
#pragma unroll
        for (int m = 0; m < 8; ++m) af[m] = *(const bf16x8*)(ap + (size_t)(m * 16) * LDA + ks * 32);
        __builtin_amdgcn_sched_barrier(0);
#pragma unroll
        for (int m = 0; m < 8; ++m) acc[m] = mma16(f0, af[m], acc[m]); }
    __syncthreads();
#pragma unroll
    for (int m = 0; m < 8; ++m) red[(w * 8 + m) * 64 + lane] = acc[m];
    __syncthreads();
    f32x4 s = red[w * 64 + lane];
#pragma unroll
    for (int ww = 1; ww < 8; ++ww) s += red[(ww * 8 + w) * 64 + lane];
    return s;
}
__device__ __forceinline__ u32x2 pk4(const f32x4 v) { u32x2 o; o.x = pk2(v[0], v[1]); o.y = pk2(v[2], v[3]); return o; }
#define SKINNY_LOOP(total_) for (int s = c.bid - base; s >= 0 && s < (total_); s += ncu)
__device__ __forceinline__ void ph_sk_in(const Ctx& c, int base, int ncu, const bf16_t* __restrict__ HB, const bf16_t* __restrict__ W, bf16_t* __restrict__ U) {
    const int r = c.lane & 15, q = c.lane >> 4, w = c.wave;
    SKINNY_LOOP(NINP / 32) { f32x4 o[2]; skinny_pair<DM, DM, DM>(c, HB + (size_t)MP * DM, W + (size_t)(s * 32) * DM, W + (size_t)(s * 32 + 16) * DM, o, s);
        bf16_t* up = U + (size_t)(MP + w * 16 + r) * NINP + s * 32 + q * 4; *(u32x2*)up = pk4(o[0]); *(u32x2*)(up + 16) = pk4(o[1]); }
}
__device__ __forceinline__ void ph_sk_merge(const Ctx& c, int base, int ncu, const bf16_t* __restrict__ BR, const bf16_t* __restrict__ W, const bf16_t* __restrict__ U, const float* __restrict__ gate_b, bf16_t* __restrict__ MGB) {
    const int r = c.lane & 15, q = c.lane >> 4, w = c.wave;
    SKINNY_LOOP(DM / 16) { const size_t row = (size_t)(MP + w * 16 + r); const int col = s * 16 + q * 4; f32x4 tot = (f32x4){0.f, 0.f, 0.f, 0.f};
#pragma unroll 1
        for (int z = 0; z < 4; ++z) { const f32x4 o = skinny_one<BW, BW, BW>(c, BR + ((size_t)z * MPAD + MP) * BW, W + ((size_t)z * DM + s * 16) * BW, s + z);
            const u32x2 gp = *(const u32x2*)(U + row * NINP + U_GP + z * DM + col); const f32x4 gb = *(const f32x4*)(gate_b + z * DM + col);
            tot[0] += sigmoidf_(__uint_as_float(gp.x << 16) + gb[0]) * o[0]; tot[1] += sigmoidf_(__uint_as_float(gp.x & 0xffff0000u) + gb[1]) * o[1];
            tot[2] += sigmoidf_(__uint_as_float(gp.y << 16) + gb[2]) * o[2]; tot[3] += sigmoidf_(__uint_as_float(gp.y & 0xffff0000u) + gb[3]) * o[3]; }
        *(u32x2*)(MGB + row * DM + col) = pk4(tot); }
}
template <int K> __device__ __forceinline__ void ph_sk_res(const Ctx& c, int base, int ncu, const bf16_t* __restrict__ A, const bf16_t* __restrict__ W, const float* __restrict__ R, float* __restrict__ Y) {
    const int r = c.lane & 15, q = c.lane >> 4, w = c.wave;
    SKINNY_LOOP(DM / 16) { const f32x4 o = skinny_one<K, K, K>(c, A + (size_t)MP * K, W + (size_t)(s * 16) * K, s);
        const size_t off = (size_t)(MP + w * 16 + r) * DM + s * 16 + q * 4; *(f32x4*)(Y + off) = *(const f32x4*)(R + off) * ALPHA + o; }
}
__device__ __forceinline__ void ph_sk_gu(const Ctx& c, int base, int ncu, const bf16_t* __restrict__ X1B, const bf16_t* __restrict__ W, bf16_t* __restrict__ ACT) {
    const int r = c.lane & 15, q = c.lane >> 4, w = c.wave;
    SKINNY_LOOP(DFF / 16) { const int t = s >> 3, j0 = (s & 7) * 16; f32x4 o[2];
        skinny_pair<DM, DM, DM>(c, X1B + (size_t)MP * DM, W + (size_t)(t * 256 + j0) * DM, W + (size_t)(t * 256 + 128 + j0) * DM, o, s);
        f32x4 v;
#pragma unroll
        for (int j = 0; j < 4; ++j) v[j] = o[0][j] * sigmoidf_(o[0][j]) * o[1][j];
        *(u32x2*)(ACT + (size_t)(MP + w * 16 + r) * DFF + t * 128 + j0 + q * 4) = pk4(v); }
}
#undef SKINNY_LOOP

constexpr int LDS_BAR_OFF = 147456;
constexpr int LDS_BYTES = LDS_BAR_OFF + 64;
struct Args { const float* in[37]; float* out; unsigned char* ws; };

typedef pg8::Gemm<DM, DM, DM, 2, 8, NL, 1, false, 0, 0, (long)DM * DM, 0> GemmMem;
typedef pg8::Gemm<DM, DM, DM, MP / 256, NINP / 256> GemmIn;
typedef pg8::Gemm<NINP, 1024, 256, PS / 256, 1, 8, 4, false, (long)PS * NINP, 256, 256 * 1024, 256> GemmScore;
typedef pg8::Gemm<256, 256, 256, PS / 256, 1, 8, 4, false, (long)4 * 4096 * 256, (long)4096 * 256, 4 * 65536, 65536> GemmPV;
typedef pg8::Gemm<BW, BW, BW, MP / 256, DM / 256, 4, 1, true, (long)MPAD * BW, 0, (long)DM * BW, 0> GemmBranch;
typedef pg8::Gemm<DM, DM, DM, MP / 256, DM / 256> GemmOut;
typedef pg8::Gemm<DM, DM, DM, MP / 256, 2 * DFF / 256> GemmGU;
typedef pg8::Gemm<DFF, DFF, DFF, MP / 256, DM / 256> GemmDown;
template <class GT> __device__ __forceinline__ GT mk_gemm(const Ctx& c, const bf16_t* A, const bf16_t* B) { GT g; g.A = A; g.B = B; g.G = c.G; g.c = c.bid; return g; }

template <int OFF> __device__ __forceinline__ unsigned long long karg_u64(unsigned long long kargs) {
    unsigned long long p; asm volatile("s_load_dwordx2 %0, %1, %2\n\ts_waitcnt lgkmcnt(0)" : "=s"(p) : "s"(kargs), "n"(OFF) : "memory"); return p;
}
#define GPTR(T, x) ((T*)(__attribute__((address_space(1))) T*)(x))
#define INP(k) GPTR(const float, karg_u64<(k) * 8>(kargs))
#define OUTP() GPTR(float, karg_u64<37 * 8>(kargs))
#define WSP() GPTR(unsigned char, karg_u64<38 * 8>(kargs))

__global__ void __launch_bounds__(512, 2) mega_fwd(Args a_unused) {
    extern __shared__ __attribute__((aligned(16))) unsigned char lds_raw[];
    const unsigned long long kargs = (unsigned long long)__builtin_amdgcn_kernarg_segment_ptr();
    Ctx c0; c0.tid = threadIdx.x; c0.lane = c0.tid & 63; c0.wave = __builtin_amdgcn_readfirstlane(c0.tid >> 6); c0.bid = blockIdx.x; c0.G = gridDim.x; c0.lds = (LAS unsigned char*)lds_raw;
    if (c0.tid < 4) ((LAS unsigned*)(c0.lds + LDS_BAR_OFF))[c0.tid] = 0u;
    __syncthreads();
    const XcdBarrier bar = xcd_barrier_post((unsigned*)(WSP() + WS_CTL), (volatile LAS unsigned*)(c0.lds + LDS_BAR_OFF));

#define WPREP_LAYER(cc_, L_) do { unsigned char* ws_ = WSP(); \
      ph_wprep(cc_, INP(10) + (size_t)(L_) * DM * NIN, (bf16_t*)(ws_ + WS_WIN) + (size_t)(L_) * NINP * DM, DM, NIN, NINP, 1, 1, 0, 0); \
      ph_wprep(cc_, INP(29) + (size_t)(L_) * 4 * BW * DM, (bf16_t*)(ws_ + WS_WBR) + (size_t)(L_) * 4 * DM * BW, BW, DM, DM, 0, 4, (size_t)BW * DM, (size_t)DM * BW); \
      ph_wprep(cc_, INP(30) + (size_t)(L_) * DM * DM, (bf16_t*)(ws_ + WS_WOUT) + (size_t)(L_) * DM * DM, DM, DM, DM, 0, 1, 0, 0); \
      ph_wprep(cc_, INP(33) + (size_t)(L_) * DM * 2 * DFF, (bf16_t*)(ws_ + WS_WGU) + (size_t)(L_) * 2 * DFF * DM, DM, 2 * DFF, 2 * DFF, 2, 1, 0, 0); \
      ph_wprep(cc_, INP(34) + (size_t)(L_) * DFF * DM, (bf16_t*)(ws_ + WS_WDN) + (size_t)(L_) * DM * DFF, DFF, DM, DM, 0, 1, 0, 0); } while (0)
    { const Ctx c = fresh(c0); unsigned char* ws = WSP();
      ph_wprep(c, INP(28), (bf16_t*)(ws + WS_WMEM), DM, DM, DM, 0, NL, (size_t)DM * DM, (size_t)DM * DM);
      WPREP_LAYER(c, 0);
      ph_lrw(c, INP(19), INP(21), INP(22), (bf16_t*)(ws + WS_LRW));
      ph_xprep(c, INP(0), INP(1), INP(2), (float*)(ws + WS_HF), (bf16_t*)(ws + WS_HB), (bf16_t*)(ws + WS_MEMB)); }
    xcd_barrier(bar);
    { const Ctx c = fresh(c0); unsigned char* ws = WSP(); float* out = OUTP();
      GemmMem g = mk_gemm<GemmMem>(c, (const bf16_t*)(ws + WS_MEMB), (const bf16_t*)(ws + WS_WMEM));
      pg8::EpiMem E; E.outK = out + O_MKP; E.outV = out + O_MVP; E.kb = (bf16_t*)(ws + WS_MKB); E.vt = (bf16_t*)(ws + WS_MVT); pg8::gemm_phase<GemmMem, pg8::EpiMem, true, true>(c.lds, c.tid, g, E); }

    for (int l = 0; l < NL; ++l) {
        { const Ctx c = fresh(c0); unsigned char* ws = WSP();
          GemmIn g = mk_gemm<GemmIn>(c, (const bf16_t*)(ws + WS_HB), (const bf16_t*)(ws + WS_WIN) + (size_t)l * NINP * DM);
          pg8::EpiBf16 E; E.O = (bf16_t*)(ws + WS_U); E.zs = 0; E.ldc = NINP; E.pad = 0; pg8::gemm_phase<GemmIn, pg8::EpiBf16, true, true>(c.lds, c.tid, g, E); }
        { const Ctx c = fresh(c0); unsigned char* ws = WSP(); ph_sk_in(c, c.G > 192 ? 96 : 0, c.G > 192 ? c.G - 96 : c.G, (const bf16_t*)(ws + WS_HB), (const bf16_t*)(ws + WS_WIN) + (size_t)l * NINP * DM, (bf16_t*)(ws + WS_U)); }
        xcd_barrier(bar);
        { const Ctx c = fresh(c0); unsigned char* ws = WSP(); float* out = OUTP(); const bf16_t* U = (const bf16_t*)(ws + WS_U); bf16_t* BR = (bf16_t*)(ws + WS_BR);
          (void)out; (void)BR;
          ph_gla_pre(c, U, INP(12) + (size_t)l * 16 * 512, INP(13) + (size_t)l * 512, (bf16_t*)(ws + WS_GLQD), (bf16_t*)(ws + WS_GLKH), (bf16_t*)(ws + WS_GLE), (bf16_t*)(ws + WS_GLVT), (float*)(ws + WS_GLGC)); }
        { const Ctx c = fresh(c0); unsigned char* ws = WSP();
          ph_rwkv_pre(c, (const bf16_t*)(ws + WS_U), INP(9) + (size_t)l * SB * RWC, INP(17) + (size_t)l * RWC, INP(18) + (size_t)l * BW, INP(19) + (size_t)l * 64 * BW, INP(20) + (size_t)l * BW, INP(21) + (size_t)l * 64 * BW,
                       INP(22) + (size_t)l * 128 * BW, INP(23) + (size_t)l * BW, INP(24) + (size_t)l * BW, INP(25) + (size_t)l * BW, (float*)(ws + WS_RW), (bf16_t*)(ws + WS_RB), (const bf16_t*)(ws + WS_LRW) + (size_t)l * 1024 * 256); }
        { const Ctx c = fresh(c0); unsigned char* ws = WSP();
          GemmScore g = mk_gemm<GemmScore>(c, (const bf16_t*)(ws + WS_U) + U_MQ, (const bf16_t*)(ws + WS_MKB) + (size_t)l * 512 * 1024); g.c = (c.bid + c.G / 2) % c.G;
          pg8::EpiScore E; E.SC = (float*)(ws + WS_SC); pg8::gemm_phase<GemmScore, pg8::EpiScore, true, true>(c.lds, c.tid, g, E); }
        xcd_barrier(bar);
        { const Ctx c = fresh(c0); unsigned char* ws = WSP(); float* out = OUTP();
          ph_rwkv_seq(c, 64, (const bf16_t*)(ws + WS_RB), INP(8) + (size_t)l * SB * 16 * 4096, out + O_RWP + (size_t)l * PB * 16 * 4096, out + O_RWS + (size_t)l * SB * 16 * 4096,
                      (bf16_t*)(ws + WS_RAW) + (size_t)MPAD * BW); }
        { const Ctx c = fresh(c0); unsigned char* ws = WSP(); float* out = OUTP();
          ph_gla_seq(c, 32, (const bf16_t*)(ws + WS_GLQD), (const bf16_t*)(ws + WS_GLKH), (const bf16_t*)(ws + WS_GLE), (const bf16_t*)(ws + WS_GLVT), (const float*)(ws + WS_GLGC),
                     INP(7) + (size_t)l * SB * 4 * 32768, out + O_GLAP + (size_t)l * PB * 4 * 32768, out + O_GLAS + (size_t)l * SB * 4 * 32768, (bf16_t*)(ws + WS_RAW)); }
        if ((c0.bid < 32 || c0.bid >= 96) && c0.G > 96) {
        { Ctx c = fresh(c0); c.bid = c.bid < 32 ? c.bid : c.bid - 64; c.G = c.G - 64; unsigned char* ws = WSP(); ph_softmax256(c, (const float*)(ws + WS_SC), (bf16_t*)(ws + WS_PB), 8 * 4096); }
        { Ctx c = fresh(c0); c.bid = c.bid < 32 ? c.bid : c.bid - 64; c.G = c.G - 64; unsigned char* ws = WSP(); ph_swa_prompt(c, (const bf16_t*)(ws + WS_U), INP(16) + (size_t)l * 16, (bf16_t*)(ws + WS_BR) + (size_t)MPAD * BW); }
        { Ctx c = fresh(c0); c.bid = c.bid < 32 ? c.bid : c.bid - 64; c.G = c.G - 64; unsigned char* ws = WSP();
          ph_swa_sample(c, (const bf16_t*)(ws + WS_U), INP(3) + (size_t)l * SB * 16384, INP(4) + (size_t)l * SB * 16384, INP(16) + (size_t)l * 16, (bf16_t*)(ws + WS_BR) + (size_t)MPAD * BW); }
        { Ctx c = fresh(c0); c.bid = c.bid < 32 ? c.bid : c.bid - 64; c.G = c.G - 64; unsigned char* ws = WSP();
          ph_memattn_sample(c, 64, (const bf16_t*)(ws + WS_U), INP(5) + (size_t)l * SB * MEMT * 1024, INP(6) + (size_t)l * SB * MEMT * 1024, (bf16_t*)(ws + WS_BR) + (size_t)3 * MPAD * BW); }
        { Ctx c = fresh(c0); c.bid = c.bid < 32 ? c.bid : c.bid - 64; c.G = c.G - 64; unsigned char* ws = WSP();
          ph_copy_outs(c, (const bf16_t*)(ws + WS_U), INP(3) + (size_t)l * SB * 16384, INP(4) + (size_t)l * SB * 16384, OUTP(), l); }
          if (l + 1 < NL) { Ctx c = fresh(c0); const int sd = c.bid < 32 ? c.bid : c.bid - 64; c.G = 2 * (c.G - 64) + 96;
            c.bid = 2 * sd; WPREP_LAYER(c, l + 1); c.bid = 2 * sd + 1; WPREP_LAYER(c, l + 1); }
        } else if (l + 1 < NL && c0.G > 96) { Ctx c = fresh(c0); const int nside2 = 2 * (c.G - 64); c.G = nside2 + 96;
          if (c0.bid < 64) { c.bid = nside2 + 2 * (c0.bid - 32); WPREP_LAYER(c, l + 1); c.bid = nside2 + 2 * (c0.bid - 32) + 1; WPREP_LAYER(c, l + 1); }
          else { c.bid = nside2 + 64 + (c0.bid - 64); WPREP_LAYER(c, l + 1); }
        }
        xcd_barrier(bar);
        { const Ctx c = fresh(c0); unsigned char* ws = WSP(); ph_rwkv_fin(c, (const float*)(ws + WS_RW), INP(26) + (size_t)l * BW, INP(27) + (size_t)l * BW, (const bf16_t*)(ws + WS_RAW) + (size_t)MPAD * BW, (bf16_t*)(ws + WS_BR) + (size_t)2 * MPAD * BW); }
        { const Ctx c = fresh(c0); unsigned char* ws = WSP(); ph_gla_fin(c, (const bf16_t*)(ws + WS_U), INP(14) + (size_t)l * BW, INP(15) + (size_t)l * BW, (const bf16_t*)(ws + WS_RAW), (bf16_t*)(ws + WS_BR)); }
        { const Ctx c = fresh(c0); unsigned char* ws = WSP();
          GemmPV g = mk_gemm<GemmPV>(c, (const bf16_t*)(ws + WS_PB), (const bf16_t*)(ws + WS_MVT) + (size_t)l * 8 * 65536);
          pg8::EpiPV E; E.O = (bf16_t*)(ws + WS_BR) + (size_t)3 * MPAD * BW; pg8::gemm_phase<GemmPV, pg8::EpiPV, true, true>(c.lds, c.tid, g, E); }
        xcd_barrier(bar);
        { const Ctx c = fresh(c0); unsigned char* ws = WSP();
          GemmBranch g = mk_gemm<GemmBranch>(c, (const bf16_t*)(ws + WS_BR), (const bf16_t*)(ws + WS_WBR) + (size_t)l * 4 * DM * BW);
          pg8::EpiMerge E; E.MG = (float*)(ws + WS_MG); E.MGB = (bf16_t*)(ws + WS_MGB); E.U = (const bf16_t*)(ws + WS_U); E.gate_b = INP(11) + (size_t)l * 4 * DM; pg8::gemm_phase<GemmBranch, pg8::EpiMerge, true, true>(c.lds, c.tid, g, E); }
        { const Ctx c = fresh(c0); unsigned char* ws = WSP(); ph_sk_merge(c, 0, c.G, (const bf16_t*)(ws + WS_BR), (const bf16_t*)(ws + WS_WBR) + (size_t)l * 4 * DM * BW, (const bf16_t*)(ws + WS_U), INP(11) + (size_t)l * 4 * DM, (bf16_t*)(ws + WS_MGB)); }
        xcd_barrier(bar);
        { const Ctx c = fresh(c0); unsigned char* ws = WSP();
          GemmOut g = mk_gemm<GemmOut>(c, (const bf16_t*)(ws + WS_MGB), (const bf16_t*)(ws + WS_WOUT) + (size_t)l * DM * DM);
          pg8::EpiRes E; E.R = (const float*)(ws + WS_HF); E.Y = (float*)(ws + WS_Y); pg8::gemm_phase<GemmOut, pg8::EpiRes, true, true>(c.lds, c.tid, g, E); }
        { const Ctx c = fresh(c0); unsigned char* ws = WSP(); ph_sk_res<DM>(c, c.G > 192 ? 128 : 0, c.G > 192 ? c.G - 128 : c.G, (const bf16_t*)(ws + WS_MGB), (const bf16_t*)(ws + WS_WOUT) + (size_t)l * DM * DM, (const float*)(ws + WS_HF), (float*)(ws + WS_Y)); }
        xcd_barrier(bar);
        { const Ctx c = fresh(c0); unsigned char* ws = WSP(); ph_ln(c, (const float*)(ws + WS_Y), INP(31) + (size_t)l * DM, INP(32) + (size_t)l * DM, (float*)(ws + WS_X1F), (bf16_t*)(ws + WS_X1B), nullptr, MT, 0); }
        xcd_barrier(bar);
        { const Ctx c = fresh(c0); unsigned char* ws = WSP();
          GemmGU g = mk_gemm<GemmGU>(c, (const bf16_t*)(ws + WS_X1B), (const bf16_t*)(ws + WS_WGU) + (size_t)l * 2 * DFF * DM);
          pg8::EpiSwiGLU E; E.O = (bf16_t*)(ws + WS_ACT); pg8::gemm_phase<GemmGU, pg8::EpiSwiGLU, true, true>(c.lds, c.tid, g, E); }
        { const Ctx c = fresh(c0); unsigned char* ws = WSP(); ph_sk_gu(c, c.G > 192 ? 128 : 0, c.G > 192 ? c.G - 128 : c.G, (const bf16_t*)(ws + WS_X1B), (const bf16_t*)(ws + WS_WGU) + (size_t)l * 2 * DFF * DM, (bf16_t*)(ws + WS_ACT)); }
        xcd_barrier(bar);
        { const Ctx c = fresh(c0); unsigned char* ws = WSP();
          GemmDown g = mk_gemm<GemmDown>(c, (const bf16_t*)(ws + WS_ACT), (const bf16_t*)(ws + WS_WDN) + (size_t)l * DM * DFF);
          pg8::EpiRes E; E.R = (const float*)(ws + WS_X1F); E.Y = (float*)(ws + WS_Y); pg8::gemm_phase<GemmDown, pg8::EpiRes, true, true>(c.lds, c.tid, g, E); }
        { const Ctx c = fresh(c0); unsigned char* ws = WSP(); ph_sk_res<DFF>(c, 0, c.G, (const bf16_t*)(ws + WS_ACT), (const bf16_t*)(ws + WS_WDN) + (size_t)l * DM * DFF, (const float*)(ws + WS_X1F), (float*)(ws + WS_Y)); }
        xcd_barrier(bar);
        { const Ctx c = fresh(c0); unsigned char* ws = WSP(); float* out = OUTP(); ph_ln(c, (const float*)(ws + WS_Y), INP(35) + (size_t)l * DM, INP(36) + (size_t)l * DM, (float*)(ws + WS_HF), (bf16_t*)(ws + WS_HB), l == NL - 1 ? out : nullptr, MT, MT); }
        xcd_barrier(bar);
    }
}

extern "C" void kernel_launch(void* const* d_in, const int* in_sizes, int n_in, void* d_out, int out_size, void* d_ws, size_t ws_size, hipStream_t stream) {
    static int grid = 0;
    if (grid == 0) {
        if (n_in != 37 || (size_t)out_size != O_END || ws_size < WS_END) { fprintf(stderr, "kernel_launch: unexpected sizes (n_in %d out %d ws %zu need %zu)\n", n_in, out_size, ws_size, (size_t)WS_END); grid = -1; return; }
        int dev = 0, cus = 0;
        if (hipGetDevice(&dev) != hipSuccess || hipDeviceGetAttribute(&cus, hipDeviceAttributeMultiprocessorCount, dev) != hipSuccess) { grid = -1; return; }
        if (hipFuncSetAttribute((const void*)mega_fwd, hipFuncAttributeMaxDynamicSharedMemorySize, LDS_BYTES) != hipSuccess) { fprintf(stderr, "kernel_launch: hipFuncSetAttribute failed\n"); grid = -1; return; }
        int per_cu = 0;
        if (hipOccupancyMaxActiveBlocksPerMultiprocessor(&per_cu, (const void*)mega_fwd, 512, LDS_BYTES) != hipSuccess || per_cu < 1) { fprintf(stderr, "kernel_launch: occupancy query says %d\n", per_cu); }
        (void)hipGetLastError();
        grid = cus;
    }
    if (grid < 0) return;
    (void)hipMemsetAsync((unsigned char*)d_ws + WS_CTL, 0, XCD_BAR_WORDS * sizeof(unsigned), stream);
    Args a; memset(&a, 0, sizeof a);
    for (int i = 0; i < 37; ++i) a.in[i] = (const float*)d_in[i];
    a.out = (float*)d_out; a.ws = (unsigned char*)d_ws;
    hipLaunchKernelGGL(mega_fwd, dim3(grid), dim3(512), LDS_BYTES, stream, a);
}
```

```cpp
#include <hip/hip_runtime.h>
#include <cstdio>
#include <cstdint>
#include <cstring>

#define LAS __attribute__((address_space(3)))
typedef unsigned short bf16_t;
typedef short bf16x8 __attribute__((ext_vector_type(8)));
typedef float f32x4 __attribute__((ext_vector_type(4)));
typedef float f32x2 __attribute__((ext_vector_type(2)));
typedef unsigned u32x4 __attribute__((ext_vector_type(4)));
typedef unsigned u32x2 __attribute__((ext_vector_type(2)));

constexpr int DM = 2048, NL = 4;
constexpr int PB = 2, PS = 4096, MP = PB * PS;
constexpr int SB = 32, SS = 4, MS = SB * SS;
constexpr int MT = MP + MS;
constexpr int MPAD = 8448;
constexpr int NIN = 16912, NINP = 17152;
constexpr int U_GQ = 0, U_GK = 512, U_GV = 1024, U_GR = 2048, U_GA = 3072, U_SQ = 3328, U_SK = 4352, U_SV = 4480, U_RU = 4608, U_MQ = 7936, U_GP = 8960;
constexpr int RWC = 3328, BW = 1024, DFF = 5632, MEMT = 256;
constexpr float ALPHA = 1.681792830507429f;

constexpr size_t O_YP = 0;
constexpr size_t O_YS = O_YP + (size_t)MP * DM;
constexpr size_t O_SWKP = O_YS + (size_t)MS * DM;
constexpr size_t O_SWVP = O_SWKP + (size_t)NL * PB * 128 * 128;
constexpr size_t O_MKP = O_SWVP + (size_t)NL * PB * 128 * 128;
constexpr size_t O_MVP = O_MKP + (size_t)NL * PB * 256 * 1024;
constexpr size_t O_GLAP = O_MVP + (size_t)NL * PB * 256 * 1024;
constexpr size_t O_RWP = O_GLAP + (size_t)NL * PB * 4 * 128 * 256;
constexpr size_t O_RSP = O_RWP + (size_t)NL * PB * 16 * 64 * 64;
constexpr size_t O_SWKS = O_RSP + (size_t)NL * PB * RWC;
constexpr size_t O_SWVS = O_SWKS + (size_t)NL * SB * 128 * 128;
constexpr size_t O_GLAS = O_SWVS + (size_t)NL * SB * 128 * 128;
constexpr size_t O_RWS = O_GLAS + (size_t)NL * SB * 4 * 128 * 256;
constexpr size_t O_RSS = O_RWS + (size_t)NL * SB * 16 * 64 * 64;
constexpr size_t O_END = O_RSS + (size_t)NL * SB * RWC;
static_assert(O_END == 52881408, "output size");

constexpr size_t al256(size_t x) { return (x + 255) & ~(size_t)255; }
constexpr size_t WS_CTL = 0;
constexpr size_t WS_WIN = 65536;
constexpr size_t WS_WMEM = WS_WIN + (size_t)NL * NINP * DM * 2;
constexpr size_t WS_WBR = WS_WMEM + (size_t)NL * DM * DM * 2;
constexpr size_t WS_WOUT = WS_WBR + (size_t)NL * 4 * DM * BW * 2;
constexpr size_t WS_WGU = WS_WOUT + (size_t)NL * DM * DM * 2;
constexpr size_t WS_WDN = WS_WGU + (size_t)NL * 2 * DFF * DM * 2;
constexpr size_t WS_HF = WS_WDN + (size_t)NL * DM * DFF * 2;
constexpr size_t WS_HB = WS_HF + (size_t)MPAD * DM * 4;
constexpr size_t WS_U = WS_HB + (size_t)MPAD * DM * 2;
constexpr size_t WS_BR = WS_U + (size_t)MPAD * NINP * 2;
constexpr size_t WS_MG = WS_BR + (size_t)4 * MPAD * BW * 2;
constexpr size_t WS_MGB = WS_MG + (size_t)MPAD * DM * 4;
constexpr size_t WS_Y = WS_MGB + (size_t)MPAD * DM * 2;
constexpr size_t WS_X1F = WS_Y + (size_t)MPAD * DM * 4;
constexpr size_t WS_X1B = WS_X1F + (size_t)MPAD * DM * 4;
constexpr size_t WS_ACT = WS_X1B + (size_t)MPAD * DM * 2;
constexpr size_t WS_MEMB = WS_ACT + (size_t)MPAD * DFF * 2;
constexpr size_t WS_MKB = WS_MEMB + (size_t)512 * DM * 2;
constexpr size_t WS_MVT = WS_MKB + (size_t)NL * 512 * 1024 * 2;
constexpr size_t WS_SC = WS_MVT + (size_t)NL * 8 * 256 * 256 * 2;
constexpr size_t WS_PB = WS_SC + (size_t)8 * 4096 * 256 * 4;
constexpr size_t WS_RW = WS_PB + (size_t)8 * 4096 * 256 * 2;
constexpr size_t RW_ARR = (size_t)MPAD * BW * 4;
constexpr int GL_NCH = 512 + 128;
constexpr size_t WS_GLQD = WS_RW + 8 * RW_ARR;
constexpr size_t WS_GLKH = WS_GLQD + (size_t)GL_NCH * 8192 * 2;
constexpr size_t WS_GLE = WS_GLKH + (size_t)GL_NCH * 8192 * 2;
constexpr size_t WS_GLVT = WS_GLE + (size_t)GL_NCH * 4096 * 2;
constexpr size_t WS_GLGC = WS_GLVT + (size_t)GL_NCH * 16384 * 2;
constexpr int RB_NCH = PB * 16 * 256 + SB * 16;
constexpr int RB_EL = 9216;
constexpr int RB_QP = 4608, RB_KHP = 5760, RB_VT = 7296, RB_EP = 8832;
constexpr size_t WS_RB = WS_GLGC + (size_t)GL_NCH * 128 * 4;
constexpr size_t WS_RAW = WS_RB + (size_t)RB_NCH * RB_EL * 2;
constexpr size_t WS_LRW = WS_RAW + (size_t)2 * MPAD * BW * 2;
constexpr size_t WS_END = WS_LRW + (size_t)NL * 16 * 64 * 256 * 2;

__device__ __forceinline__ float bf2f(bf16_t b) { return __uint_as_float(((unsigned)b) << 16); }
typedef __bf16 bf16v2_t __attribute__((ext_vector_type(2)));
__device__ __forceinline__ unsigned pk2(float lo, float hi) { const f32x2 v = {lo, hi}; return __builtin_bit_cast(unsigned, __builtin_convertvector(v, bf16v2_t)); }
__device__ __forceinline__ bf16_t f2bf(float f) { return (bf16_t)(pk2(f, 0.f) & 0xffffu); }
__device__ __forceinline__ float wave_sum(float v) {
#pragma unroll
    for (int o = 32; o > 0; o >>= 1) v += __shfl_xor(v, o, 64);
    return v;
}
__device__ __forceinline__ float wave_max(float v) {
#pragma unroll
    for (int o = 32; o > 0; o >>= 1) v = fmaxf(v, __shfl_xor(v, o, 64));
    return v;
}
__device__ __forceinline__ float sigmoidf_(float x) { return 1.0f / (1.0f + __expf(-x)); }
__device__ __forceinline__ float softplusf_(float x) { return fmaxf(x, 0.f) + log1pf(__expf(-fabsf(x))); }
__device__ __forceinline__ float softplus_fast(float x) { return fmaxf(x, 0.f) + __logf(1.0f + __expf(-fabsf(x))); }
__device__ __forceinline__ float tanh_fast(float x) { return 1.0f - 2.0f / (1.0f + __expf(2.0f * x)); }

namespace pg8 {
constexpr int BM = 256, BK = 64, HALF = 128, HTB = HALF * BK * 2, STAGE_BYTES = 8 * HTB, NXCD = 8, WGM = 8;
__host__ __device__ __forceinline__ int lds_byte(int r, int c) { const int st = (r >> 4) * 2 + (c >> 5), rr = r & 15, cc = c & 31, ob = rr * 64 + cc * 2; return st * 1024 + (ob ^ (((ob >> 9) & 1) << 5)); }
__host__ __device__ __forceinline__ void stage_rc(int b, int& R, int& C) { const int st = b / 1024, sb = b % 1024, swz = sb ^ (((sb >> 9) & 1) << 5); R = (st >> 1) * 16 + swz / 64; C = (st & 1) * 32 + (swz % 64) / 2; }
__host__ __device__ __forceinline__ int perm32(int rho) { const int n = rho >> 4, i = rho & 15; return 8 * (i >> 2) + 4 * n + (i & 3); }

struct Unit { int pm, pn, z; };
template <int LDA_, int LDB_, int K_, int NM_, int NN_, int NZ_ = 1, int NZH_ = 1, bool ZINNER_ = false, long ZSAB_ = 0, long ZSAH_ = 0, long ZSBB_ = 0, long ZSBH_ = 0>
struct Gemm {
    static constexpr int LDA = LDA_, LDB = LDB_, K = K_, NM = NM_, NN = NN_, NZ = NZ_, NZH = NZH_; static constexpr bool ZINNER = ZINNER_;
    const bf16_t* A; const bf16_t* B; int G, c;
    __device__ __forceinline__ bool next(int i, Unit& u) const {
        constexpr int nt = NM * NN; int L, z;
        if (ZINNER) { const int it = i / NZ; z = i - it * NZ; const long LL = (long)it * G + c; if (LL >= nt) return false; L = (int)LL; }
        else { const long LL = (long)i * G + c; if (LL >= (long)nt * NZ) return false; z = (int)(LL / nt); L = (int)(LL - (long)z * nt); }
        int wgid = L; { constexpr int q = nt / NXCD, r = nt % NXCD; const int xcd = wgid % NXCD, off = wgid / NXCD; wgid = (xcd < r ? xcd * (q + 1) : r * (q + 1) + (xcd - r) * q) + off; }
        constexpr int nig = WGM * NN; const int gid = wgid / nig, fm = gid * WGM, gsz = (NM - fm) < WGM ? (NM - fm) : WGM;
        u.pm = fm + ((wgid % nig) % gsz); u.pn = (wgid % nig) / gsz; u.z = z; return true;
    }
    __device__ __forceinline__ const char* a_base(const Unit& u) const { const int zb = u.z / NZH, zh = u.z - zb * NZH; return (const char*)(A + zb * ZSAB_ + zh * ZSAH_ + (long)u.pm * BM * LDA); }
    __device__ __forceinline__ const char* b_base(const Unit& u) const { const int zb = u.z / NZH, zh = u.z - zb * NZH; return (const char*)(B + zb * ZSBB_ + zh * ZSBH_ + (long)u.pn * BM * LDB); }
};

template <class GT, class Epi, bool ALIGN_EPI = true, bool SP2 = true>
__device__ __forceinline__ void gemm_phase(LAS unsigned char* lds, const int tid, const GT& g, const Epi& E) {
    const int wid = __builtin_amdgcn_readfirstlane(tid >> 6), lane = tid & 63, wr = wid >> 2, wc = wid & 3, fr = lane & 15, fq = lane >> 4;
    constexpr int nt = GT::K / BK;
    unsigned voffA[2], voffB[2];
#pragma unroll
    for (int i = 0; i < 2; ++i) { int R, C; stage_rc(tid * 16 + i * 8192, R, C); const int Rb = Epi::PERM ? ((R & ~31) + perm32(R & 31)) : R;
        voffA[i] = (unsigned)(R * GT::LDA + C) * 2u; voffB[i] = (unsigned)(Rb * GT::LDB + C) * 2u; }
    constexpr size_t kstep = (size_t)(BK * 2);
    constexpr size_t hstepA = (size_t)HALF * GT::LDA * 2, hstepB = (size_t)HALF * GT::LDB * 2;
    const unsigned ldsw = (unsigned)wid * 1024u;
    const int aoff = lds_byte(wr * 64 + fr, fq * 8), boff = lds_byte(wc * 32 + fr, fq * 8);
#define PG8_SA(b, h) (((b) * 2 + (h)) * HTB)
#define PG8_SB(b, h) ((4 + (b) * 2 + (h)) * HTB)
#define PG8_STAGE(bufoff, gbase, voff) do { _Pragma("unroll") for (int _i = 0; _i < 2; ++_i) \
        __builtin_amdgcn_global_load_lds((const unsigned*)((const char*)(gbase) + (voff)[_i]), (LAS unsigned*)(lds + (bufoff) + ldsw + _i * 8192), 16, 0, 0); } while (0)
#define PG8_LDA(dst, b, h) do { _Pragma("unroll") for (int m = 0; m < 4; ++m) _Pragma("unroll") for (int k = 0; k < 2; ++k) dst[m][k] = *(const LAS bf16x8*)(lds + PG8_SA(b, h) + aoff + m * 2048 + k * 1024); } while (0)
#define PG8_LDB(dst, b, h) do { _Pragma("unroll") for (int n = 0; n < 2; ++n) _Pragma("unroll") for (int k = 0; k < 2; ++k) dst[n][k] = *(const LAS bf16x8*)(lds + PG8_SB(b, h) + boff + n * 2048 + k * 1024); } while (0)
#define PG8_MMA(ai, bj, At, Bt) do { __builtin_amdgcn_s_setprio(1); _Pragma("unroll") for (int m = 0; m < 4; ++m) _Pragma("unroll") for (int n = 0; n < 2; ++n) _Pragma("unroll") for (int k = 0; k < 2; ++k) \
        acc[ai][bj][m][n] = __builtin_amdgcn_mfma_f32_16x16x32_bf16(Bt[n][k], At[m][k], acc[ai][bj][m][n], 0, 0, 0); __builtin_amdgcn_s_setprio(0); } while (0)
#define PG8_WAIT_V(n) asm volatile("s_waitcnt vmcnt(" #n ")" ::: "memory")
#define PG8_WAIT_L(n) asm volatile("s_waitcnt lgkmcnt(" #n ")" ::: "memory")
#define PG8_BAR __builtin_amdgcn_s_barrier()
#define PG8_SCHED __builtin_amdgcn_sched_barrier(0)
    Unit cur, nxt; int ui = 0;
    if (!g.next(0, cur)) return;
    f32x4 acc[2][2][4][2];
#pragma unroll
    for (int a = 0; a < 2; ++a)
#pragma unroll
        for (int b = 0; b < 2; ++b)
#pragma unroll
            for (int m = 0; m < 4; ++m)
#pragma unroll
                for (int n = 0; n < 2; ++n) acc[a][b][m][n] = (f32x4){0.f, 0.f, 0.f, 0.f};
    bf16x8 At[4][2], B0[2][2], B1[2][2];
    const char* cA = g.a_base(cur); const char* cB = g.b_base(cur);
    if constexpr (SP2) {
        PG8_STAGE(PG8_SB(0, 0), cB, voffB); PG8_STAGE(PG8_SB(0, 1), cB + hstepB, voffB); PG8_STAGE(PG8_SA(0, 0), cA, voffA); PG8_STAGE(PG8_SA(0, 1), cA + hstepA, voffA);
        if (wr == 1) PG8_BAR;
        PG8_WAIT_V(2); PG8_BAR;
        PG8_STAGE(PG8_SB(1, 0), cB + kstep, voffB); PG8_STAGE(PG8_SA(1, 0), cA + kstep, voffA); PG8_STAGE(PG8_SB(1, 1), cB + hstepB + kstep, voffB);
        PG8_WAIT_V(6); PG8_BAR;
    } else {
        PG8_STAGE(PG8_SB(0, 0), cB, voffB); PG8_STAGE(PG8_SA(0, 0), cA, voffA); PG8_STAGE(PG8_SB(0, 1), cB + hstepB, voffB); PG8_STAGE(PG8_SA(0, 1), cA + hstepA, voffA);
        if (wr == 1) PG8_BAR;
        PG8_WAIT_V(4); PG8_BAR;
        PG8_STAGE(PG8_SB(1, 0), cB + kstep, voffB); PG8_STAGE(PG8_SA(1, 0), cA + kstep, voffA); PG8_STAGE(PG8_SB(1, 1), cB + hstepB + kstep, voffB);
        PG8_WAIT_V(6); PG8_BAR;
    }
    for (;;) {
        const bool has_next = g.next(ui + 1, nxt);
        const char* nA = has_next ? g.a_base(nxt) : cA; const char* nB = has_next ? g.b_base(nxt) : cB;
#pragma unroll 1
        for (int t = 0; t < nt; t += 2) {
            const bool last = (t == nt - 2);
            const char* a1 = cA + (size_t)(t + 1) * kstep;
            const char* a2 = last ? nA : cA + (size_t)(t + 2) * kstep; const char* b2 = last ? nB : cB + (size_t)(t + 2) * kstep;
            const char* a3 = a2 + kstep; const char* b3 = b2 + kstep;
            if constexpr (SP2) {
            PG8_LDB(B0, 0, 0); PG8_LDB(B1, 0, 1); PG8_SCHED; PG8_LDA(At, 0, 0); PG8_STAGE(PG8_SA(1, 1), a1 + hstepA, voffA);
            PG8_WAIT_V(8); PG8_WAIT_L(0); PG8_BAR; PG8_MMA(0, 0, At, B0); PG8_MMA(0, 1, At, B1); PG8_BAR; PG8_SCHED;
            PG8_LDA(At, 0, 1); PG8_STAGE(PG8_SB(0, 0), b2, voffB); PG8_STAGE(PG8_SB(0, 1), b2 + hstepB, voffB); PG8_STAGE(PG8_SA(0, 0), a2, voffA);
            PG8_WAIT_V(8); PG8_WAIT_L(0); PG8_BAR; PG8_MMA(1, 0, At, B0); PG8_MMA(1, 1, At, B1); PG8_BAR; PG8_SCHED;
            PG8_LDB(B0, 1, 0); PG8_LDB(B1, 1, 1); PG8_SCHED; PG8_LDA(At, 1, 0); PG8_STAGE(PG8_SA(0, 1), a2 + hstepA, voffA);
            PG8_WAIT_V(8); PG8_WAIT_L(0); PG8_BAR; PG8_MMA(0, 0, At, B0); PG8_MMA(0, 1, At, B1); PG8_BAR; PG8_SCHED;
            PG8_LDA(At, 1, 1); PG8_STAGE(PG8_SB(1, 0), b3, voffB); PG8_STAGE(PG8_SB(1, 1), b3 + hstepB, voffB); PG8_STAGE(PG8_SA(1, 0), a3, voffA);
            PG8_WAIT_V(8); PG8_WAIT_L(0); PG8_BAR; PG8_MMA(1, 0, At, B0); PG8_MMA(1, 1, At, B1); PG8_BAR; PG8_SCHED;
            } else {
            PG8_LDB(B0, 0, 0); PG8_SCHED; PG8_LDA(At, 0, 0); PG8_STAGE(PG8_SA(1, 1), a1 + hstepA, voffA);
            PG8_WAIT_L(8); PG8_BAR; PG8_WAIT_L(0); PG8_MMA(0, 0, At, B0); PG8_BAR; PG8_SCHED;
            PG8_LDB(B1, 0, 1); PG8_STAGE(PG8_SB(0, 0), b2, voffB);
            PG8_BAR; PG8_WAIT_L(0); PG8_MMA(0, 1, At, B1); PG8_BAR;
            PG8_LDA(At, 0, 1); PG8_STAGE(PG8_SA(0, 0), a2, voffA);
            PG8_BAR; PG8_WAIT_L(0); PG8_MMA(1, 0, At, B0); PG8_BAR; PG8_SCHED;
            PG8_STAGE(PG8_SB(0, 1), b2 + hstepB, voffB);
            PG8_WAIT_V(6); PG8_BAR; PG8_MMA(1, 1, At, B1); PG8_BAR;
            PG8_LDB(B0, 1, 0); PG8_SCHED; PG8_LDA(At, 1, 0); PG8_STAGE(PG8_SA(0, 1), a2 + hstepA, voffA);
            PG8_WAIT_L(8); PG8_BAR; PG8_WAIT_L(0); PG8_MMA(0, 0, At, B0); PG8_BAR; PG8_SCHED;
            PG8_LDB(B1, 1, 1); PG8_STAGE(PG8_SB(1, 0), b3, voffB);
            PG8_BAR; PG8_WAIT_L(0); PG8_MMA(0, 1, At, B1); PG8_BAR;
            PG8_LDA(At, 1, 1); PG8_STAGE(PG8_SA(1, 0), a3, voffA);
            PG8_BAR; PG8_WAIT_L(0); PG8_MMA(1, 0, At, B0); PG8_BAR; PG8_SCHED;
            PG8_STAGE(PG8_SB(1, 1), b3 + hstepB, voffB);
            PG8_WAIT_V(6); PG8_BAR; PG8_MMA(1, 1, At, B1); PG8_BAR;
            }
        }
        if constexpr (ALIGN_EPI) { if (wr == 0) PG8_BAR; }
        E(acc, cur, wr, wc, fr, fq);
        if (!has_next) break;
#pragma unroll
        for (int a = 0; a < 2; ++a)
#pragma unroll
            for (int b = 0; b < 2; ++b)
#pragma unroll
                for (int m = 0; m < 4; ++m)
#pragma unroll
                    for (int n = 0; n < 2; ++n) acc[a][b][m][n] = (f32x4){0.f, 0.f, 0.f, 0.f};
        cur = nxt; cA = nA; cB = nB; ++ui;
        if constexpr (ALIGN_EPI) { if (wr == 1) PG8_BAR; }
    }
    PG8_WAIT_V(0);
    if constexpr (!ALIGN_EPI) { if (wr == 0) PG8_BAR; }
    PG8_BAR;
#undef PG8_SA
#undef PG8_SB
#undef PG8_STAGE
#undef PG8_LDA
#undef PG8_LDB
#undef PG8_MMA
#undef PG8_WAIT_V
#undef PG8_WAIT_L
#undef PG8_BAR
#undef PG8_SCHED
}

struct EpiBf16 {
    static constexpr bool PERM = true;
    bf16_t* O; long zs; int ldc, pad;
    __device__ __forceinline__ void operator()(const f32x4 (&acc)[2][2][4][2], const Unit& u, int wr, int wc, int fr, int fq) const {
        const int row0 = u.pm * BM + wr * 64 + fr, col0 = u.pn * BM + wc * 32 + 8 * fq; bf16_t* base = O + (long)u.z * zs;
#pragma unroll
        for (int ai = 0; ai < 2; ++ai)
#pragma unroll
            for (int m = 0; m < 4; ++m) { bf16_t* rowp = base + (size_t)(row0 + ai * HALF + m * 16) * ldc + col0;
#pragma unroll
                for (int bj = 0; bj < 2; ++bj) { const f32x4 v0 = acc[ai][bj][m][0], v1 = acc[ai][bj][m][1];
                    u32x4 w; w.x = pk2(v0[0], v0[1]); w.y = pk2(v0[2], v0[3]); w.z = pk2(v1[0], v1[1]); w.w = pk2(v1[2], v1[3]);
                    *(u32x4*)(rowp + bj * HALF) = w; } }
    }
};
struct EpiMem {
    static constexpr bool PERM = false;
    float* outK; float* outV; bf16_t* kb; bf16_t* vt;
    __device__ __forceinline__ void operator()(const f32x4 (&acc)[2][2][4][2], const Unit& u, int wr, int wc, int fr, int fq) const {
        const int row0 = u.pm * BM + wr * 64 + fr, col0 = u.pn * BM + wc * 32 + 4 * fq;
#pragma unroll
        for (int ai = 0; ai < 2; ++ai)
#pragma unroll
            for (int m = 0; m < 4; ++m) { const int row = row0 + ai * HALF + m * 16;
#pragma unroll
                for (int bj = 0; bj < 2; ++bj)
#pragma unroll
                    for (int n = 0; n < 2; ++n) { const int col = col0 + bj * HALF + n * 16; const f32x4 v = acc[ai][bj][m][n];
                        if (col < 1024) { *(f32x4*)(outK + ((size_t)u.z * 512 + row) * 1024 + col) = v;
                            u32x2 w; w.x = pk2(v[0], v[1]); w.y = pk2(v[2], v[3]); *(u32x2*)(kb + ((size_t)u.z * 512 + row) * 1024 + col) = w; }
                        else { const int c = col - 1024; *(f32x4*)(outV + ((size_t)u.z * 512 + row) * 1024 + c) = v;
                            const int b = row >> 8, mm = row & 255, h = c >> 8, d = c & 255; bf16_t* p = vt + ((((size_t)u.z * 2 + b) * 4 + h) * 256 + d) * 256 + mm;
                            p[0] = f2bf(v[0]); p[256] = f2bf(v[1]); p[512] = f2bf(v[2]); p[768] = f2bf(v[3]); } } }
    }
};
struct EpiMerge {
    static constexpr bool PERM = false;
    float* MG; bf16_t* MGB; const bf16_t* U; const float* gate_b;
    __device__ __forceinline__ void operator()(const f32x4 (&acc)[2][2][4][2], const Unit& u, int wr, int wc, int fr, int fq) const {
        const int row0 = u.pm * BM + wr * 64 + fr, col0 = u.pn * BM + wc * 32 + 4 * fq;
#pragma unroll
        for (int ai = 0; ai < 2; ++ai)
#pragma unroll
            for (int m = 0; m < 4; ++m) { const int row = row0 + ai * HALF + m * 16;
#pragma unroll
                for (int bj = 0; bj < 2; ++bj)
#pragma unroll
                    for (int n = 0; n < 2; ++n) { const int col = col0 + bj * HALF + n * 16; const f32x4 v = acc[ai][bj][m][n];
                        const u32x2 gp = *(const u32x2*)(U + (size_t)row * NINP + U_GP + u.z * DM + col); const f32x4 gb = *(const f32x4*)(gate_b + u.z * DM + col);
                        f32x4 gt; gt[0] = sigmoidf_(__uint_as_float(gp.x << 16) + gb[0]); gt[1] = sigmoidf_(__uint_as_float(gp.x & 0xffff0000u) + gb[1]);
                        gt[2] = sigmoidf_(__uint_as_float(gp.y << 16) + gb[2]); gt[3] = sigmoidf_(__uint_as_float(gp.y & 0xffff0000u) + gb[3]);
                        float* mp = MG + (size_t)row * DM + col; f32x4 r = gt * v;
                        if (u.z > 0) r += *(const f32x4*)mp;
                        if (u.z < 3) *(f32x4*)mp = r;
                        else { u32x2 w; w.x = pk2(r[0], r[1]); w.y = pk2(r[2], r[3]); *(u32x2*)(MGB + (size_t)row * DM + col) = w; } } }
    }
};
struct EpiRes {
    static constexpr bool PERM = false;
    const bf16_t* R; bf16_t* Y;
    __device__ __forceinline__ void operator()(const f32x4 (&acc)[2][2][4][2], const Unit& u, int wr, int wc, int fr, int fq) const {
        const int row0 = u.pm * BM + wr * 64 + fr, col0 = u.pn * BM + wc * 32 + 4 * fq;
#pragma unroll
        for (int ai = 0; ai < 2; ++ai)
#pragma unroll
            for (int m = 0; m < 4; ++m) { const size_t ro = (size_t)(row0 + ai * HALF + m * 16) * DM + col0;
#pragma unroll
                for (int bj = 0; bj < 2; ++bj)
#pragma unroll
                    for (int n = 0; n < 2; ++n) { const size_t o = ro + bj * HALF + n * 16; const u32x2 rr = *(const u32x2*)(R + o);
                        const f32x4 rv = (f32x4){__uint_as_float(rr.x << 16), __uint_as_float(rr.x & 0xffff0000u), __uint_as_float(rr.y << 16), __uint_as_float(rr.y & 0xffff0000u)};
                        const f32x4 yv = rv * ALPHA + acc[ai][bj][m][n]; u32x2 yw; yw.x = pk2(yv[0], yv[1]); yw.y = pk2(yv[2], yv[3]); *(u32x2*)(Y + o) = yw; } }
    }
};
struct EpiSwiGLU {
    static constexpr bool PERM = true;
    bf16_t* O;
    __device__ __forceinline__ void operator()(const f32x4 (&acc)[2][2][4][2], const Unit& u, int wr, int wc, int fr, int fq) const {
        const int row0 = u.pm * BM + wr * 64 + fr, col0 = u.pn * HALF + wc * 32 + 8 * fq;
#pragma unroll
        for (int ai = 0; ai < 2; ++ai)
#pragma unroll
            for (int m = 0; m < 4; ++m) { bf16_t* rowp = O + (size_t)(row0 + ai * HALF + m * 16) * DFF + col0;
                float r[8];
#pragma unroll
                for (int n = 0; n < 2; ++n)
#pragma unroll
                    for (int j = 0; j < 4; ++j) { const float gg = acc[ai][0][m][n][j], uu = acc[ai][1][m][n][j]; r[n * 4 + j] = gg * sigmoidf_(gg) * uu; }
                u32x4 w; w.x = pk2(r[0], r[1]); w.y = pk2(r[2], r[3]); w.z = pk2(r[4], r[5]); w.w = pk2(r[6], r[7]);
                *(u32x4*)rowp = w; }
    }
};
struct EpiScore {
    static constexpr bool PERM = false;
    float* SC;
    __device__ __forceinline__ void operator()(const f32x4 (&acc)[2][2][4][2], const Unit& u, int wr, int wc, int fr, int fq) const {
        const int row0 = u.pm * BM + wr * 64 + fr, col0 = wc * 32 + 4 * fq; float* base = SC + (size_t)u.z * 4096 * 256;
#pragma unroll
        for (int ai = 0; ai < 2; ++ai)
#pragma unroll
            for (int m = 0; m < 4; ++m) { float* rowp = base + (size_t)(row0 + ai * HALF + m * 16) * 256 + col0;
#pragma unroll
                for (int bj = 0; bj < 2; ++bj)
#pragma unroll
                    for (int n = 0; n < 2; ++n) *(f32x4*)(rowp + bj * HALF + n * 16) = acc[ai][bj][m][n] * 0.0625f; }
    }
};
struct EpiPV {
    static constexpr bool PERM = true;
    bf16_t* O;
    __device__ __forceinline__ void operator()(const f32x4 (&acc)[2][2][4][2], const Unit& u, int wr, int wc, int fr, int fq) const {
        const int b = u.z >> 2, h = u.z & 3; const int row0 = b * PS + u.pm * BM + wr * 64 + fr, col0 = h * 256 + wc * 32 + 8 * fq;
#pragma unroll
        for (int ai = 0; ai < 2; ++ai)
#pragma unroll
            for (int m = 0; m < 4; ++m) { bf16_t* rowp = O + (size_t)(row0 + ai * HALF + m * 16) * BW + col0;
#pragma unroll
                for (int bj = 0; bj < 2; ++bj) { const f32x4 v0 = acc[ai][bj][m][0], v1 = acc[ai][bj][m][1];
                    u32x4 w; w.x = pk2(v0[0], v0[1]); w.y = pk2(v0[2], v0[3]); w.z = pk2(v1[0], v1[1]); w.w = pk2(v1[2], v1[3]);
                    *(u32x4*)(rowp + bj * HALF) = w; } }
    }
};
}


#define XB_TMO      128
#define XB_XCNT(j)  (256  + 64 * (j))
#define XB_XSUB(j)  (1280 + 64 * (j))
#define XB_XGEN(j)  (2304 + 64 * (j))
#define XB_TOP      3328
#define XB_TOPGEN   3392
#define XCD_BAR_WORDS 3456
#define XB_SPIN_CAP (1u << 18)
__device__ __forceinline__ unsigned xb_ld(unsigned* p)              { return __hip_atomic_load(p, __ATOMIC_RELAXED, __HIP_MEMORY_SCOPE_AGENT); }
__device__ __forceinline__ unsigned xb_add(unsigned* p, unsigned v) { return __hip_atomic_fetch_add(p, v, __ATOMIC_RELAXED, __HIP_MEMORY_SCOPE_AGENT); }
__device__ __forceinline__ unsigned xb_xcc_id() { return (unsigned)__builtin_amdgcn_s_getreg((3 << 11) | 20) & 0xFu; }
#define XB_SPIN(cond, bar) do { unsigned _sp = 0; while (cond) { __builtin_amdgcn_s_sleep(1); \
    if ((++_sp & 255u) == 0u) { if (xb_ld(&(bar)[XB_TMO])) break; if (_sp > XB_SPIN_CAP) { atomicAdd(&(bar)[XB_TMO], 1u); break; } } } } while (0)
struct XcdBarrier { unsigned* bar; unsigned x; volatile LAS unsigned* st; };
__device__ __forceinline__ XcdBarrier xcd_barrier_post(unsigned* bar, volatile LAS unsigned* st) {
    XcdBarrier b; b.bar = bar; b.x = xb_xcc_id(); b.st = st;
    if (threadIdx.x == 0) (void)xb_add(&bar[XB_XCNT(b.x)], 1u);
    return b;
}
__device__ __forceinline__ void xcd_barrier_complete(unsigned* bar, unsigned x, unsigned& nloc, unsigned& nx) {
    const unsigned G = gridDim.x * gridDim.y * gridDim.z;
    unsigned sum, cnt, mine, sp = 0u;
    for (;;) {
        sum = 0u; cnt = 0u; mine = 0u;
#pragma unroll
        for (unsigned j = 0; j < 16; ++j) { const unsigned c = xb_ld(&bar[XB_XCNT(j)]); sum += c; cnt += (c > 0u) ? 1u : 0u; mine = (j == x) ? c : mine; }
        if (sum == G) break;
        __builtin_amdgcn_s_sleep(1);
        if ((++sp & 255u) == 0u) { if (xb_ld(&bar[XB_TMO])) break; if (sp > XB_SPIN_CAP) { atomicAdd(&bar[XB_TMO], 1u); break; } }
    }
    nloc = mine > 0u ? mine : 1u; nx = cnt > 0u ? cnt : 1u;
}
__device__ __forceinline__ void xcd_barrier(const XcdBarrier& b) {
    asm volatile("s_waitcnt vmcnt(0)" ::: "memory");
    __syncthreads();
    if (threadIdx.x == 0) {
        unsigned* bar = b.bar;
        __builtin_amdgcn_s_waitcnt(0);
        unsigned nloc = b.st[0], nx = b.st[1];
        if (nloc == 0u) { xcd_barrier_complete(bar, b.x, nloc, nx); b.st[0] = nloc; b.st[1] = nx; }
        const unsigned old = xb_add(&bar[XB_XSUB(b.x)], 1u);
        const unsigned gen = old / nloc;
        if (old + 1u == (gen + 1u) * nloc) {
            __builtin_amdgcn_fence(__ATOMIC_RELEASE, "agent");
            asm volatile("s_waitcnt vmcnt(0)" ::: "memory");
            const unsigned og = xb_add(&bar[XB_TOP], 1u);
            const unsigned tg = og / nx;
            if (og + 1u == (tg + 1u) * nx) xb_add(&bar[XB_TOPGEN], 1u);
            else XB_SPIN(xb_ld(&bar[XB_TOPGEN]) == tg, bar);
            __builtin_amdgcn_fence(__ATOMIC_ACQUIRE, "agent");
            xb_add(&bar[XB_XGEN(b.x)], 1u);
            asm volatile("s_waitcnt vmcnt(0)" ::: "memory");
        } else {
            XB_SPIN(xb_ld(&bar[XB_XGEN(b.x)]) == gen, bar);
            __builtin_amdgcn_fence(__ATOMIC_ACQUIRE, "agent");
            asm volatile("s_waitcnt vmcnt(0)" ::: "memory");
        }
    }
    __syncthreads();
}

struct Ctx { int tid, lane, wave, bid, G; LAS unsigned char* lds; };
__device__ __forceinline__ Ctx fresh(const Ctx& c0) { Ctx c; c.wave = c0.wave; c.bid = c0.bid; c.G = c0.G; c.lds = c0.lds; asm volatile("" : "+s"(c.bid), "+s"(c.G), "+s"(c.wave));
    int lane = (int)__builtin_amdgcn_mbcnt_hi(~0u, __builtin_amdgcn_mbcnt_lo(~0u, 0u)); asm volatile("" : "+v"(lane)); c.lane = lane; c.tid = c.wave * 64 + lane; return c; }

__device__ __forceinline__ int colmap(int mode, int n) {
    if (mode == 1) return n < 3088 ? n : (n < 3328 ? -1 : n - 240);
    if (mode == 2) { const int t = n >> 8, j = n & 255; return j < 128 ? t * 128 + j : DFF + t * 128 + (j - 128); }
    return n;
}
__device__ __forceinline__ void wprep_load(f32x4 (&rg)[8], const float* __restrict__ src, int K, int Nsrc, int Ndst, int mode, size_t sbs, int item, int tid) {
    const int nx = Ndst / 256, ny = K / 64; const int bx = item % nx, by = (item / nx) % ny, bz = item / (nx * ny);
    const int tx = tid & 63, ty = tid >> 6, cm = colmap(mode, bx * 256 + tx * 4); const float* s = src + (size_t)bz * sbs + (size_t)(by * 64 + ty) * Nsrc + cm;
#pragma unroll
    for (int i = 0; i < 8; ++i) rg[i] = cm >= 0 ? *(const f32x4*)(s + (size_t)(8 * i) * Nsrc) : (f32x4){0.f, 0.f, 0.f, 0.f};
}
__device__ __forceinline__ void ph_wprep(const Ctx& c, const float* __restrict__ src, bf16_t* __restrict__ dst, int K, int Nsrc, int Ndst, int mode, int nbatch, size_t sbs, size_t dbs) {
    LAS float* tile = (LAS float*)c.lds;
    const int nx = Ndst / 256, ny = K / 64, total = nx * ny * nbatch;
    const int tid = c.tid, tx = tid & 63, ty = tid >> 6, n = tid >> 1, kh = tid & 1;
    f32x4 rg[8];
    int item = c.bid;
    if (item < total) wprep_load(rg, src, K, Nsrc, Ndst, mode, sbs, item, tid);
    for (; item < total; item += c.G) {
        __syncthreads();
#pragma unroll
        for (int i = 0; i < 8; ++i) *(LAS f32x4*)(tile + (ty + 8 * i) * 260 + tx * 4) = rg[i];
        __syncthreads();
        const int bx = item % nx, by = (item / nx) % ny, bz = item / (nx * ny);
        if (item + c.G < total) wprep_load(rg, src, K, Nsrc, Ndst, mode, sbs, item + c.G, tid);
        bf16_t* d = dst + (size_t)bz * dbs + (size_t)(bx * 256 + n) * K + by * 64 + kh * 32;
#pragma unroll
        for (int g = 0; g < 4; ++g) { unsigned p[4];
#pragma unroll
            for (int e = 0; e < 4; ++e) p[e] = pk2(tile[(kh * 32 + g * 8 + 2 * e) * 260 + n], tile[(kh * 32 + g * 8 + 2 * e + 1) * 260 + n]);
            *(u32x4*)(d + g * 8) = (u32x4){p[0], p[1], p[2], p[3]}; }
    }
    __syncthreads();
}
__device__ __forceinline__ void ph_xprep(const Ctx& c, const float* __restrict__ xp, const float* __restrict__ xs, const float* __restrict__ mem, float* __restrict__ HF, bf16_t* __restrict__ HB, bf16_t* __restrict__ MEMB) {
    const size_t nH = (size_t)MPAD * DM / 4, nM = (size_t)512 * DM / 4;
    for (size_t i4 = (size_t)c.bid * 512 + c.tid; i4 < nH + nM; i4 += (size_t)c.G * 512) {
        if (i4 < nH) {
            const size_t e = i4 * 4; f32x4 v = (f32x4){0.f, 0.f, 0.f, 0.f};
            if (e < (size_t)MP * DM) v = *(const f32x4*)(xp + e); else if (e < (size_t)MT * DM) v = *(const f32x4*)(xs + (e - (size_t)MP * DM));
            if (HF != nullptr) *(f32x4*)(HF + e) = v;
            u32x2 w; w.x = pk2(v[0], v[1]); w.y = pk2(v[2], v[3]); *(u32x2*)(HB + e) = w;
        } else {
            const size_t e = (i4 - nH) * 4; const f32x4 v = *(const f32x4*)(mem + e); u32x2 w; w.x = pk2(v[0], v[1]); w.y = pk2(v[2], v[3]); *(u32x2*)(MEMB + e) = w;
        }
    }
}
__device__ __forceinline__ void ph_ln(const Ctx& c, const bf16_t* __restrict__ Y, const float* __restrict__ g, const float* __restrict__ b, float* __restrict__ XF, bf16_t* __restrict__ XB, float* __restrict__ OUT, int nrows, int nout) {
    const int lane = c.lane;
    for (int row = c.bid * 8 + c.wave; row < nrows; row += c.G * 8) {
        const bf16_t* y = Y + (size_t)row * DM; f32x4 v[8]; float s = 0.f;
#pragma unroll
        for (int j = 0; j < 8; ++j) { const u32x2 yr = *(const u32x2*)(y + j * 256 + lane * 4);
            v[j] = (f32x4){__uint_as_float(yr.x << 16), __uint_as_float(yr.x & 0xffff0000u), __uint_as_float(yr.y << 16), __uint_as_float(yr.y & 0xffff0000u)}; s += (v[j][0] + v[j][1]) + (v[j][2] + v[j][3]); }
        const float mean = wave_sum(s) * (1.0f / DM); float q = 0.f;
#pragma unroll
        for (int j = 0; j < 8; ++j) { const f32x4 d = v[j] - mean; q += (d[0] * d[0] + d[1] * d[1]) + (d[2] * d[2] + d[3] * d[3]); }
        const float rstd = rsqrtf(wave_sum(q) * (1.0f / DM) + 1e-5f);
#pragma unroll
        for (int j = 0; j < 8; ++j) { const int cc = j * 256 + lane * 4; const f32x4 gg = *(const f32x4*)(g + cc), bb = *(const f32x4*)(b + cc);
            const f32x4 o = (v[j] - mean) * rstd * gg + bb; const size_t off = (size_t)row * DM + cc;
            if (XF != nullptr) *(f32x4*)(XF + off) = o;
            u32x2 w; w.x = pk2(o[0], o[1]); w.y = pk2(o[2], o[3]); *(u32x2*)(XB + off) = w;
            if (OUT != nullptr && row < nout) *(f32x4*)(OUT + off) = o; }
    }
}
__device__ __forceinline__ void ph_softmax256(const Ctx& c, const float* __restrict__ SC, bf16_t* __restrict__ P, int nrows) {
    const int lane = c.lane;
    for (int row = c.bid * 8 + c.wave; row < nrows; row += c.G * 8) {
        const f32x4 v = *(const f32x4*)(SC + (size_t)row * 256 + lane * 4);
        const float mx = wave_max(fmaxf(fmaxf(v[0], v[1]), fmaxf(v[2], v[3])));
        f32x4 e; e[0] = __expf(v[0] - mx); e[1] = __expf(v[1] - mx); e[2] = __expf(v[2] - mx); e[3] = __expf(v[3] - mx);
        const float inv = 1.0f / wave_sum((e[0] + e[1]) + (e[2] + e[3]));
        u32x2 w; w.x = pk2(e[0] * inv, e[1] * inv); w.y = pk2(e[2] * inv, e[3] * inv); *(u32x2*)(P + (size_t)row * 256 + lane * 4) = w;
    }
}
__device__ __forceinline__ void ph_copy_outs(const Ctx& c, const bf16_t* __restrict__ U, const float* __restrict__ ck, const float* __restrict__ cv, float* __restrict__ out, int layer) {
    constexpr int nA = PB * 128 * 128, nB = SB * 128 * 128, nC = PB * RWC, nD = SB * RWC;
    for (int i = c.bid * 512 + c.tid; i < nA + nB + nC + nD; i += c.G * 512) {
        if (i < nA) { const int b = i / 16384, j = (i >> 7) & 127, cc = i & 127; const size_t ur = (size_t)(b * PS + PS - 128 + j) * NINP;
            out[O_SWKP + (size_t)layer * nA + i] = bf2f(U[ur + U_SK + cc]); out[O_SWVP + (size_t)layer * nA + i] = bf2f(U[ur + U_SV + cc]); continue; }
        int k = i - nA;
        if (k < nB) { const int sq = k / 16384, j = (k >> 7) & 127, cc = k & 127; float kv, vv;
            if (j < 124) { const size_t o = ((size_t)sq * 128 + j + 4) * 128 + cc; kv = ck[o]; vv = cv[o]; }
            else { const size_t ur = (size_t)(MP + sq * SS + j - 124) * NINP; kv = bf2f(U[ur + U_SK + cc]); vv = bf2f(U[ur + U_SV + cc]); }
            out[O_SWKS + (size_t)layer * nB + k] = kv; out[O_SWVS + (size_t)layer * nB + k] = vv; continue; }
        k -= nB;
        if (k < nC) { const int b = k / RWC, cc = k - b * RWC; out[O_RSP + (size_t)layer * nC + k] = bf2f(U[(size_t)(b * PS + PS - 1) * NINP + U_RU + cc]); continue; }
        k -= nC;
        { const int sq = k / RWC, cc = k - sq * RWC; out[O_RSS + (size_t)layer * nD + k] = bf2f(U[(size_t)(MP + sq * SS + SS - 1) * NINP + U_RU + cc]); }
    }
}

__device__ __forceinline__ void seq_info(int sq, int& row0, int& L) { if (sq < PB) { row0 = sq * PS; L = PS; } else { row0 = MP + (sq - PB) * SS; L = SS; } }

__device__ __forceinline__ void ph_gla_naive(const Ctx& c, const bf16_t* __restrict__ U, const float* __restrict__ s0, const float* __restrict__ a_up, const float* __restrict__ a_b,
                                             const float* __restrict__ ng, const float* __restrict__ nb, bf16_t* __restrict__ OB, float* __restrict__ outP, float* __restrict__ outS) {
    LAS float* qs = (LAS float*)c.lds;
    LAS float* ks = qs + 16 * 128; LAS float* as = ks + 16 * 128; LAS float* os = as + 16 * 128;
    const int kh = c.tid >> 8, vt = c.tid & 255, lane = c.lane;
    for (int u = c.bid; u < (PB + SB) * 4; u += c.G) {
        const int sq = u >> 2, h = u & 3;
        int row0, L; seq_info(sq, row0, L);
        float S[64];
        if (sq >= PB) { const float* p = s0 + (((size_t)(sq - PB) * 4 + h) * 128 + kh * 64) * 256 + vt;
#pragma unroll
            for (int kk = 0; kk < 64; ++kk) S[kk] = p[(size_t)kk * 256]; }
        else {
#pragma unroll
            for (int kk = 0; kk < 64; ++kk) S[kk] = 0.f; }
        for (int t0 = 0; t0 < L; t0 += 16) {
            const int nT = (L - t0) < 16 ? (L - t0) : 16;
            for (int idx = c.tid; idx < nT * 128; idx += 512) {
                const int tt = idx >> 7, kk = idx & 127; const bf16_t* ur = U + (size_t)(row0 + t0 + tt) * NINP;
                qs[idx] = bf2f(ur[U_GQ + h * 128 + kk]) * 0.08838834764831845f; ks[idx] = bf2f(ur[U_GK + h * 128 + kk]);
                float x = a_b[h * 128 + kk];
#pragma unroll
                for (int r = 0; r < 16; ++r) x += bf2f(ur[U_GA + r]) * a_up[r * 512 + h * 128 + kk];
                const float ls = (fminf(x, 0.f) - log1pf(__expf(-fabsf(x)))) * (1.0f / 16.0f);
                as[idx] = __expf(ls);
            }
            __syncthreads();
            for (int tt = 0; tt < nT; ++tt) {
                const float v = bf2f(U[(size_t)(row0 + t0 + tt) * NINP + U_GV + h * 256 + vt]); float o = 0.f; const int lb = tt * 128 + kh * 64;
#pragma unroll
                for (int kk = 0; kk < 64; ++kk) { S[kk] = as[lb + kk] * S[kk] + ks[lb + kk] * v; o += qs[lb + kk] * S[kk]; }
                os[(kh * 16 + tt) * 256 + vt] = o;
            }
            __syncthreads();
            for (int tt = c.wave; tt < nT; tt += 8) {
                float x[4]; float s = 0.f;
#pragma unroll
                for (int j = 0; j < 4; ++j) { x[j] = os[tt * 256 + lane + 64 * j] + os[(16 + tt) * 256 + lane + 64 * j]; s += x[j]; }
                const float mean = wave_sum(s) * (1.0f / 256.0f); float q = 0.f;
#pragma unroll
                for (int j = 0; j < 4; ++j) { const float d = x[j] - mean; q += d * d; }
                const float rstd = rsqrtf(wave_sum(q) * (1.0f / 256.0f) + 1e-5f);
                const size_t row = (size_t)(row0 + t0 + tt);
#pragma unroll
                for (int j = 0; j < 4; ++j) { const int cc = h * 256 + lane + 64 * j; const float n = (x[j] - mean) * rstd * ng[cc] + nb[cc];
                    const float gr = bf2f(U[row * NINP + U_GR + cc]); OB[row * BW + cc] = f2bf(n * gr * sigmoidf_(gr)); }
            }
            __syncthreads();
        }
        float* op = (sq < PB ? outP + (((size_t)sq * 4 + h) * 128 + kh * 64) * 256 : outS + (((size_t)(sq - PB) * 4 + h) * 128 + kh * 64) * 256) + vt;
#pragma unroll
        for (int kk = 0; kk < 64; ++kk) op[(size_t)kk * 256] = S[kk];
    }
}

__device__ __forceinline__ f32x4 mma16(bf16x8 x, bf16x8 y, f32x4 c) { return __builtin_amdgcn_mfma_f32_16x16x32_bf16(x, y, c, 0, 0, 0); }
__device__ __forceinline__ bf16x8 pack_acc(const f32x4& a, const f32x4& b) {
    u32x4 p; p.x = pk2(a[0], a[1]); p.y = pk2(a[2], a[3]); p.z = pk2(b[0], b[1]); p.w = pk2(b[2], b[3]); return __builtin_bit_cast(bf16x8, p);
}
__device__ __forceinline__ void gla_chunk_info(int u, int& row0, int& ntok, int& h) {
    if (u < 512) { const int b = u >> 8; h = (u >> 6) & 3; row0 = b * PS + (u & 63) * 64; ntok = 64; }
    else { const int s = u - 512; h = s & 3; row0 = MP + (s >> 2) * SS; ntok = SS; }
}
__device__ __forceinline__ void ph_gla_pre(const Ctx& c, const bf16_t* __restrict__ U, const float* __restrict__ a_up, const float* __restrict__ a_b,
                                           bf16_t* __restrict__ QD, bf16_t* __restrict__ KHT, bf16_t* __restrict__ EE, bf16_t* __restrict__ VT, float* __restrict__ GC) {
    LAS float* ga_l = (LAS float*)c.lds;
    LAS float* tot = ga_l + 64 * 16;
    LAS bf16_t* Qd_l = (LAS bf16_t*)(tot + 4 * 128);
    LAS bf16_t* Kn_l = Qd_l + 64 * 136;
    LAS bf16_t* v_l = Kn_l + 64 * 136;
    LAS bf16_t* qr_l = v_l + 64 * 264;
    LAS bf16_t* kr_l = qr_l + 64 * 136;
    const int tid = c.tid, lane = c.lane, r = lane & 15, q = lane >> 4, w = c.wave;
    for (int u = (c.bid + c.G / 2) % c.G; u < GL_NCH; u += c.G) {
        int row0, ntok, h; gla_chunk_info(u, row0, ntok, h);
        for (int i = tid; i < 64 * 16; i += 512) { const int t = i >> 4, rr = i & 15; ga_l[i] = t < ntok ? bf2f(U[(size_t)(row0 + t) * NINP + U_GA + rr]) : 0.f; }
        for (int i = tid; i < 64 * 32; i += 512) { const int t = i >> 5, c8 = i & 31; u32x4 vv = (u32x4){0u, 0u, 0u, 0u};
            if (t < ntok) vv = *(const u32x4*)(U + (size_t)(row0 + t) * NINP + U_GV + h * 256 + c8 * 8);
            *(LAS u32x4*)(v_l + t * 264 + c8 * 8) = vv; }
        for (int i = tid; i < 64 * 16; i += 512) { const int t = i >> 4, c8 = i & 15; u32x4 qv = (u32x4){0u, 0u, 0u, 0u}, kv = qv;
            if (t < ntok) { const bf16_t* ur = U + (size_t)(row0 + t) * NINP + h * 128 + c8 * 8; qv = *(const u32x4*)(ur + U_GQ); kv = *(const u32x4*)(ur + U_GK); }
            *(LAS u32x4*)(qr_l + t * 136 + c8 * 8) = qv; *(LAS u32x4*)(kr_l + t * 136 + c8 * 8) = kv; }
        __syncthreads();
        const int kk = tid & 127, tq = tid >> 7;
        float cum[16];
        { float aup[16];
#pragma unroll
          for (int rr = 0; rr < 16; ++rr) aup[rr] = a_up[rr * 512 + h * 128 + kk];
          const float ab = a_b[h * 128 + kk]; float run = 0.f;
#pragma unroll
          for (int j = 0; j < 16; ++j) { const int t = tq * 16 + j; float x = ab;
#pragma unroll
              for (int rr = 0; rr < 16; ++rr) x += ga_l[t * 16 + rr] * aup[rr];
              const float la = t < ntok ? (fminf(x, 0.f) - __logf(1.0f + __expf(-fabsf(x)))) * (1.0f / 16.0f) : 0.f;
              run += la; cum[j] = run; }
          tot[tq * 128 + kk] = run; }
        __syncthreads();
        { float prefix = 0.f, bC = 0.f;
#pragma unroll
          for (int g = 0; g < 4; ++g) { const float tv = tot[g * 128 + kk]; bC += tv; if (g < tq) prefix += tv; }
          unsigned khp[8];
#pragma unroll
          for (int j = 0; j < 16; j += 2) { float kh2[2];
#pragma unroll
              for (int e = 0; e < 2; ++e) { const int t = tq * 16 + j + e; const float b = prefix + cum[j + e]; const float qv = bf2f(qr_l[t * 136 + kk]), kv = bf2f(kr_l[t * 136 + kk]);
                  Qd_l[t * 136 + kk] = f2bf(qv * __expf(b) * 0.08838834764831845f); Kn_l[t * 136 + kk] = f2bf(kv * __expf(-b)); kh2[e] = kv * __expf(bC - b); }
              khp[j >> 1] = pk2(kh2[0], kh2[1]); }
          bf16_t* kp = KHT + (size_t)u * 8192 + kk * 64 + tq * 16;
          *(u32x4*)kp = (u32x4){khp[0], khp[1], khp[2], khp[3]}; *(u32x4*)(kp + 8) = (u32x4){khp[4], khp[5], khp[6], khp[7]};
          if (tq == 0) GC[(size_t)u * 128 + kk] = __expf(bC); }
        __syncthreads();
        { const int tb = w >> 1;
#pragma unroll
          for (int e = 0; e < 2; ++e) { const int ib = (w & 1) * 2 + e; f32x4 d = (f32x4){0.f, 0.f, 0.f, 0.f};
              if (ib <= tb) {
                  bf16x8 kf4[4], qf4[4];
#pragma unroll
                  for (int ks = 0; ks < 4; ++ks) { kf4[ks] = *(const LAS bf16x8*)(Kn_l + (ib * 16 + r) * 136 + ks * 32 + q * 8); qf4[ks] = *(const LAS bf16x8*)(Qd_l + (tb * 16 + r) * 136 + ks * 32 + q * 8); }
                  __builtin_amdgcn_sched_barrier(0);
#pragma unroll
                  for (int ks = 0; ks < 4; ++ks) d = mma16(kf4[ks], qf4[ks], d); }
              const int t = tb * 16 + r, i0 = ib * 16 + q * 4;
#pragma unroll
              for (int jj = 0; jj < 4; ++jj) if (i0 + jj > t) d[jj] = 0.f;
              u32x2 o; o.x = pk2(d[0], d[1]); o.y = pk2(d[2], d[3]); *(u32x2*)(EE + (size_t)u * 4096 + t * 64 + i0) = o; } }
        for (int i = tid; i < 64 * 16; i += 512) { const int t = i >> 4, c8 = i & 15; *(u32x4*)(QD + (size_t)u * 8192 + t * 128 + c8 * 8) = *(const LAS u32x4*)(Qd_l + t * 136 + c8 * 8); }
        { const int val = tid & 255, th = tid >> 8;
#pragma unroll
          for (int tg = 0; tg < 4; ++tg) { const int t0 = th * 32 + tg * 8; unsigned p4[4];
#pragma unroll
              for (int e = 0; e < 4; ++e) p4[e] = (unsigned)v_l[(t0 + 2 * e) * 264 + val] | ((unsigned)v_l[(t0 + 2 * e + 1) * 264 + val] << 16);
              *(u32x4*)(VT + (size_t)u * 16384 + val * 64 + t0) = (u32x4){p4[0], p4[1], p4[2], p4[3]}; } }
        __syncthreads();
    }
}
struct GlaStage { u32x4 qd[2], kh[2], e, vt, gc; };
__device__ __forceinline__ void gla_stage_load(GlaStage& s, const bf16_t* __restrict__ QD, const bf16_t* __restrict__ KHT, const bf16_t* __restrict__ EE, const bf16_t* __restrict__ VT, const float* __restrict__ GC,
                                               int ch, int sl, int tid) {
    const bf16_t* qp = QD + (size_t)ch * 8192 + tid * 8; s.qd[0] = *(const u32x4*)qp; s.qd[1] = *(const u32x4*)(qp + 4096);
    const bf16_t* kp = KHT + (size_t)ch * 8192 + tid * 8; s.kh[0] = *(const u32x4*)kp; s.kh[1] = *(const u32x4*)(kp + 4096);
    s.e = *(const u32x4*)(EE + (size_t)ch * 4096 + tid * 8);
    s.vt = *(const u32x4*)(VT + (size_t)ch * 16384 + sl * 4096 + tid * 8);
    if (tid < 32) s.gc = *(const u32x4*)(GC + (size_t)ch * 128 + tid * 4);
}
constexpr int GS_KH = 8704, GS_E = 17920, GS_VT = 22528, GS_GC = 27136, GS_EL = 27392;
__device__ __forceinline__ void gla_stage_store(const GlaStage& s, LAS bf16_t* b, int tid) {
    *(LAS u32x4*)(b + (tid >> 4) * 136 + (tid & 15) * 8) = s.qd[0]; *(LAS u32x4*)(b + (32 + (tid >> 4)) * 136 + (tid & 15) * 8) = s.qd[1];
    *(LAS u32x4*)(b + GS_KH + (tid >> 3) * 72 + (tid & 7) * 8) = s.kh[0]; *(LAS u32x4*)(b + GS_KH + (64 + (tid >> 3)) * 72 + (tid & 7) * 8) = s.kh[1];
    *(LAS u32x4*)(b + GS_E + (tid >> 3) * 72 + (tid & 7) * 8) = s.e; *(LAS u32x4*)(b + GS_VT + (tid >> 3) * 72 + (tid & 7) * 8) = s.vt;
    if (tid < 32) *(LAS u32x4*)(b + GS_GC + tid * 8) = s.gc;
}
__device__ __forceinline__ void ph_gla_seq(const Ctx& c, int boff, const bf16_t* __restrict__ QD, const bf16_t* __restrict__ KHT, const bf16_t* __restrict__ EE, const bf16_t* __restrict__ VT, const float* __restrict__ GC,
                                           const float* __restrict__ s0, float* __restrict__ outP, float* __restrict__ outS, bf16_t* __restrict__ OB) {
    LAS bf16_t* stg = (LAS bf16_t*)c.lds;
    LAS bf16_t* T_l = stg + 2 * GS_EL;
    const int tid = c.tid, lane = c.lane, r = lane & 15, q = lane >> 4, w = c.wave;
    const int side = c.bid < 32 ? c.bid : c.bid - 64, nside = c.G - 64;
    for (int u = (c.bid >= boff && c.bid < boff + 32) ? c.bid - boff : ((c.bid < 32 || c.bid >= 96) ? 32 + side : 32 + 512); u < 32 + 512; u = u < 32 ? 32 + 512 : u + nside) {
        int h, sl, nch, ch0, row0, ntok; const float* sp = nullptr; float* op;
        if (u < 32) { const int b = u >> 4; h = (u >> 2) & 3; sl = u & 3; nch = 64; ch0 = (b * 4 + h) * 64; row0 = b * PS; ntok = 64; op = outP + (size_t)(b * 4 + h) * 32768; }
        else { const int s = u - 32, sq = s >> 4; h = (s >> 2) & 3; sl = s & 3; nch = 1; ch0 = 512 + sq * 4 + h; row0 = MP + sq * SS; ntok = SS; sp = s0 + (size_t)(sq * 4 + h) * 32768; op = outS + (size_t)(sq * 4 + h) * 32768; }
        f32x4 acc[4];
#pragma unroll
        for (int vb = 0; vb < 4; ++vb)
#pragma unroll
            for (int jj = 0; jj < 4; ++jj) acc[vb][jj] = sp ? sp[(size_t)(w * 16 + q * 4 + jj) * 256 + sl * 64 + vb * 16 + r] : 0.f;
        GlaStage R0, R1, R2;
        gla_stage_load(R0, QD, KHT, EE, VT, GC, ch0, sl, tid);
        if (1 < nch) gla_stage_load(R1, QD, KHT, EE, VT, GC, ch0 + 1, sl, tid);
        if (2 < nch) gla_stage_load(R2, QD, KHT, EE, VT, GC, ch0 + 2, sl, tid);
        __syncthreads();
        gla_stage_store(R0, stg, tid);
        if (3 < nch) gla_stage_load(R0, QD, KHT, EE, VT, GC, ch0 + 3, sl, tid);
#define GLA_STEP(ci, RN) do { \
            LAS bf16_t* Tb = T_l + ((ci) & 1) * 64 * 136; const LAS bf16_t* sb = stg + ((ci) & 1) * GS_EL; \
            _Pragma("unroll") for (int vb = 0; vb < 4; ++vb) { u32x2 o; o.x = pk2(acc[vb][0], acc[vb][1]); o.y = pk2(acc[vb][2], acc[vb][3]); *(LAS u32x2*)(Tb + (vb * 16 + r) * 136 + w * 16 + q * 4) = o; } \
            __syncthreads(); \
            if ((ci) + 1 < nch) { gla_stage_store(RN, stg + (((ci) + 1) & 1) * GS_EL, tid); if ((ci) + 4 < nch) gla_stage_load(RN, QD, KHT, EE, VT, GC, ch0 + (ci) + 4, sl, tid); } \
            { const int rb = w >> 1, t = rb * 16 + r; bf16x8 qf[4], ef[2]; \
              _Pragma("unroll") for (int ks = 0; ks < 4; ++ks) qf[ks] = *(const LAS bf16x8*)(sb + (rb * 16 + r) * 136 + ks * 32 + q * 8); \
              _Pragma("unroll") for (int ks = 0; ks < 2; ++ks) ef[ks] = *(const LAS bf16x8*)(sb + GS_E + (rb * 16 + r) * 72 + ks * 32 + q * 8); \
              bf16x8 tf[2][4], vf[2][2]; \
              _Pragma("unroll") for (int e2 = 0; e2 < 2; ++e2) { const int cb = (w & 1) * 2 + e2; \
                  _Pragma("unroll") for (int ks = 0; ks < 4; ++ks) tf[e2][ks] = *(const LAS bf16x8*)(Tb + (cb * 16 + r) * 136 + ks * 32 + q * 8); \
                  _Pragma("unroll") for (int ks = 0; ks < 2; ++ks) vf[e2][ks] = *(const LAS bf16x8*)(sb + GS_VT + (cb * 16 + r) * 72 + ks * 32 + q * 8); } \
              __builtin_amdgcn_sched_barrier(0); \
              _Pragma("unroll") for (int e2 = 0; e2 < 2; ++e2) { const int cb = (w & 1) * 2 + e2; f32x4 y = (f32x4){0.f, 0.f, 0.f, 0.f}; \
                  _Pragma("unroll") for (int ks = 0; ks < 4; ++ks) y = mma16(tf[e2][ks], qf[ks], y); \
                  _Pragma("unroll") for (int ks = 0; ks < 2; ++ks) y = mma16(vf[e2][ks], ef[ks], y); \
                  if (t < ntok) { u32x2 o; o.x = pk2(y[0], y[1]); o.y = pk2(y[2], y[3]); *(u32x2*)(OB + (size_t)(row0 + (ci) * 64 + t) * BW + h * 256 + sl * 64 + cb * 16 + q * 4) = o; } } } \
            { const f32x4 gcv = *(const LAS f32x4*)((const LAS float*)(sb + GS_GC) + w * 16 + q * 4); bf16x8 kf[2]; \
              _Pragma("unroll") for (int ks = 0; ks < 2; ++ks) kf[ks] = *(const LAS bf16x8*)(sb + GS_KH + (w * 16 + r) * 72 + ks * 32 + q * 8); \
              bf16x8 vs[4][2]; \
              _Pragma("unroll") for (int vb = 0; vb < 4; ++vb) _Pragma("unroll") for (int ks = 0; ks < 2; ++ks) vs[vb][ks] = *(const LAS bf16x8*)(sb + GS_VT + (vb * 16 + r) * 72 + ks * 32 + q * 8); \
              __builtin_amdgcn_sched_barrier(0); \
              _Pragma("unroll") for (int vb = 0; vb < 4; ++vb) { acc[vb] = acc[vb] * gcv; \
                  _Pragma("unroll") for (int ks = 0; ks < 2; ++ks) acc[vb] = mma16(kf[ks], vs[vb][ks], acc[vb]); } } \
        } while (0)
#pragma unroll 1
        for (int ci = 0; ci < nch; ci += 3) {
            GLA_STEP(ci, R1);
            if (ci + 1 < nch) GLA_STEP(ci + 1, R2);
            if (ci + 2 < nch) GLA_STEP(ci + 2, R0);
        }
#undef GLA_STEP
#pragma unroll
        for (int vb = 0; vb < 4; ++vb)
#pragma unroll
            for (int jj = 0; jj < 4; ++jj) op[(size_t)(w * 16 + q * 4 + jj) * 256 + sl * 64 + vb * 16 + r] = acc[vb][jj];
        __syncthreads();
    }
}
__device__ __forceinline__ void ph_gla_fin(const Ctx& c, const bf16_t* __restrict__ U, const float* __restrict__ ng, const float* __restrict__ nb, const bf16_t* __restrict__ RAW, bf16_t* __restrict__ OB) {
    const int lane = c.lane;
    for (int i = c.bid * 8 + c.wave; i < MT * 4; i += c.G * 8) {
        const int row = i >> 2, h = i & 3, cc = h * 256 + lane * 4; bf16_t* p = OB + (size_t)row * BW + cc;
        const u32x2 raw = *(const u32x2*)(RAW + (size_t)row * BW + cc); float x[4] = {__uint_as_float(raw.x << 16), __uint_as_float(raw.x & 0xffff0000u), __uint_as_float(raw.y << 16), __uint_as_float(raw.y & 0xffff0000u)};
        const float mean = wave_sum((x[0] + x[1]) + (x[2] + x[3])) * (1.0f / 256.0f); float qq = 0.f;
#pragma unroll
        for (int j = 0; j < 4; ++j) { const float d = x[j] - mean; qq += d * d; }
        const float rstd = rsqrtf(wave_sum(qq) * (1.0f / 256.0f) + 1e-5f);
        const u32x2 gp = *(const u32x2*)(U + (size_t)row * NINP + U_GR + cc); const float gr[4] = {__uint_as_float(gp.x << 16), __uint_as_float(gp.x & 0xffff0000u), __uint_as_float(gp.y << 16), __uint_as_float(gp.y & 0xffff0000u)};
        const f32x4 gg = *(const f32x4*)(ng + cc), bb = *(const f32x4*)(nb + cc); float o[4];
#pragma unroll
        for (int j = 0; j < 4; ++j) o[j] = ((x[j] - mean) * rstd * gg[j] + bb[j]) * gr[j] * sigmoidf_(gr[j]);
        u32x2 ov; ov.x = pk2(o[0], o[1]); ov.y = pk2(o[2], o[3]); *(u32x2*)p = ov;
    }
}

__device__ __forceinline__ void unpack8(const u32x4 w, float (&x)[8]) {
    x[0] = __uint_as_float(w.x << 16); x[1] = __uint_as_float(w.x & 0xffff0000u); x[2] = __uint_as_float(w.y << 16); x[3] = __uint_as_float(w.y & 0xffff0000u);
    x[4] = __uint_as_float(w.z << 16); x[5] = __uint_as_float(w.z & 0xffff0000u); x[6] = __uint_as_float(w.w << 16); x[7] = __uint_as_float(w.w & 0xffff0000u);
}
template <bool ISBF> __device__ __forceinline__ void swa_step(const float (&q)[32], float (&acc)[32], float& m, float& l, const void* kp, const void* vp, float slope, float dist) {
    float s = 0.f;
#pragma unroll
    for (int j = 0; j < 4; ++j) { float x[8];
        if (ISBF) unpack8(*(const u32x4*)((const bf16_t*)kp + j * 8), x);
        else { const f32x4 a = *(const f32x4*)((const float*)kp + j * 8), b = *(const f32x4*)((const float*)kp + j * 8 + 4); x[0] = a[0]; x[1] = a[1]; x[2] = a[2]; x[3] = a[3]; x[4] = b[0]; x[5] = b[1]; x[6] = b[2]; x[7] = b[3]; }
#pragma unroll
        for (int d = 0; d < 8; ++d) s += q[j * 8 + d] * x[d]; }
    s += __shfl_xor(s, 1, 64);
    s = s * 0.125f - slope * dist;
    const float mn = fmaxf(m, s), cc = __expf(m - mn), p = __expf(s - mn);
    l = l * cc + p;
#pragma unroll
    for (int j = 0; j < 4; ++j) { float x[8];
        if (ISBF) unpack8(*(const u32x4*)((const bf16_t*)vp + j * 8), x);
        else { const f32x4 a = *(const f32x4*)((const float*)vp + j * 8), b = *(const f32x4*)((const float*)vp + j * 8 + 4); x[0] = a[0]; x[1] = a[1]; x[2] = a[2]; x[3] = a[3]; x[4] = b[0]; x[5] = b[1]; x[6] = b[2]; x[7] = b[3]; }
#pragma unroll
        for (int d = 0; d < 8; ++d) acc[j * 8 + d] = acc[j * 8 + d] * cc + p * x[d]; }
    m = mn;
}
__device__ __forceinline__ void ph_swa_naive(const Ctx& c, const bf16_t* __restrict__ U, const float* __restrict__ ck, const float* __restrict__ cv, const float* __restrict__ sinks, bf16_t* __restrict__ OB) {
    for (int gid = c.bid * 512 + c.tid; gid < MS * 32; gid += c.G * 512) {
        const int dh = gid & 1, h = (gid >> 1) & 15, row = MP + (gid >> 5), kvh = h >> 3, co = kvh * 64 + dh * 32;
        float q[32], acc[32];
#pragma unroll
        for (int j = 0; j < 4; ++j) { float x[8]; unpack8(*(const u32x4*)(U + (size_t)row * NINP + U_SQ + h * 64 + dh * 32 + j * 8), x);
#pragma unroll
            for (int d = 0; d < 8; ++d) { q[j * 8 + d] = x[d]; acc[j * 8 + d] = 0.f; } }
        const float slope = exp2f(-0.5f * (float)(h + 1)); float m = sinks[h], l = 1.0f;
        if (row < MP) {
            const int t = row % PS, base = row - t, lo = t - 128 < 0 ? 0 : t - 128;
            for (int s = lo; s <= t; ++s) { const bf16_t* ur = U + (size_t)(base + s) * NINP;
                swa_step<true>(q, acc, m, l, ur + U_SK + co, ur + U_SV + co, slope, (float)(t - s)); }
        } else {
            const int sq = (row - MP) / SS, i = (row - MP) % SS;
            for (int idx = i; idx <= 128 + i; ++idx) {
                if (idx < 128) { const size_t o = ((size_t)sq * 128 + idx) * 128 + co; swa_step<false>(q, acc, m, l, ck + o, cv + o, slope, (float)(128 + i - idx)); }
                else { const bf16_t* ur = U + (size_t)(MP + sq * SS + idx - 128) * NINP; swa_step<true>(q, acc, m, l, ur + U_SK + co, ur + U_SV + co, slope, (float)(128 + i - idx)); }
            }
        }
        const float inv = 1.0f / l; bf16_t* op = OB + (size_t)row * BW + h * 64 + dh * 32;
#pragma unroll
        for (int j = 0; j < 4; ++j) { u32x4 w; w.x = pk2(acc[j * 8] * inv, acc[j * 8 + 1] * inv); w.y = pk2(acc[j * 8 + 2] * inv, acc[j * 8 + 3] * inv);
            w.z = pk2(acc[j * 8 + 4] * inv, acc[j * 8 + 5] * inv); w.w = pk2(acc[j * 8 + 6] * inv, acc[j * 8 + 7] * inv); *(u32x4*)(op + j * 8) = w; }
    }
}

__device__ __forceinline__ void ph_rwkv_prep(const Ctx& c, const bf16_t* __restrict__ U, const float* __restrict__ shift, const float* __restrict__ mu, const float* __restrict__ w0, const float* __restrict__ w2,
                                             const float* __restrict__ a0, const float* __restrict__ a2, const float* __restrict__ g2, const float* __restrict__ k_k, const float* __restrict__ k_a,
                                             const float* __restrict__ r_k, float* __restrict__ RW) {
    LAS float* xm = (LAS float*)c.lds; LAS float* tw = xm + RWC; LAS float* ad = tw + 64; LAS float* sg = ad + 64;
    const int tid = c.tid;
    float* R = RW; float* WD = RW + (size_t)MPAD * BW; float* K2 = WD + (size_t)MPAD * BW; float* V = K2 + (size_t)MPAD * BW; float* KK = V + (size_t)MPAD * BW;
    float* BV = KK + (size_t)MPAD * BW; float* G = BV + (size_t)MPAD * BW; float* BON = G + (size_t)MPAD * BW;
    for (int row = c.bid; row < MT; row += c.G) {
        const bf16_t* ur = U + (size_t)row * NINP + U_RU; const bf16_t* pr = ur - NINP; const float* ps = nullptr; bool first;
        if (row < MP) first = (row % PS) == 0; else { first = ((row - MP) % SS) == 0; ps = shift + (size_t)((row - MP) / SS) * RWC; }
        for (int cc = tid; cc < RWC; cc += 512) { const float x = bf2f(ur[cc]); const float s = first ? (ps ? ps[cc] : 0.f) : bf2f(pr[cc]); xm[cc] = x + (s - x) * mu[cc]; }
        __syncthreads();
        if (tid < 64) { tw[tid] = tanhf(xm[3072 + tid]); ad[tid] = xm[3136 + tid]; }
        if (tid >= 128 && tid < 256) sg[tid - 128] = sigmoidf_(xm[3200 + tid - 128]);
        __syncthreads();
        for (int qd = 0; qd < 2; ++qd) {
            const int cc = qd * 512 + tid; float accw = w0[cc], acca = a0[cc], accg = 0.f;
#pragma unroll 4
            for (int j = 0; j < 64; ++j) { accw += tw[j] * w2[j * BW + cc]; acca += ad[j] * a2[j * BW + cc]; }
#pragma unroll 4
            for (int j = 0; j < 128; ++j) accg += sg[j] * g2[j * BW + cc];
            const float lw = -softplusf_(-accw) - 0.5f, decay = __expf(-__expf(lw)), a = sigmoidf_(acca);
            const float r = xm[cc], k = xm[1024 + cc], v = xm[2048 + cc];
            const float kkr = k * k_k[cc]; const float ss = wave_sum(kkr * kkr); const float kk = kkr / fmaxf(sqrtf(ss), 1e-12f);
            const float k2 = k * (1.0f + (a - 1.0f) * k_a[cc]); const float rk = wave_sum(r * k2 * r_k[cc]);
            const size_t o = (size_t)row * BW + cc;
            R[o] = r; WD[o] = decay; K2[o] = k2; V[o] = v; KK[o] = kk; BV[o] = kk * a; G[o] = accg; BON[o] = rk * v;
        }
        __syncthreads();
    }
}
__device__ __forceinline__ int kperm_pos(int k) { return (k & ~31) + 8 * ((k >> 2) & 3) + 4 * ((k >> 4) & 1) + (k & 3); }
__device__ __forceinline__ void ph_swa_prompt(const Ctx& c, const bf16_t* __restrict__ U, const float* __restrict__ sinks, bf16_t* __restrict__ OB) {
    LAS bf16_t* K_l = (LAS bf16_t*)c.lds;
    LAS bf16_t* VT_l = K_l + 192 * 72;
    const int tid = c.tid, lane = c.lane, r = lane & 15, q = lane >> 4, w = c.wave;
    for (int u = c.bid; u < PB * 64 * 2; u += c.G) {
        const int b = u >> 7, qb = (u >> 1) & 63, kvh = u & 1, h = kvh * 8 + w;
        const int tok0 = qb * 64 - 128;
        const size_t seq0 = (size_t)b * PS;
        for (int idx = tid; idx < 192 * 8; idx += 512) { const int kl = idx >> 3, c8 = idx & 7, tk = tok0 + kl; u32x4 kv = (u32x4){0u, 0u, 0u, 0u}, vv = kv;
            if (tk >= 0) { const bf16_t* ur = U + (seq0 + tk) * NINP; kv = *(const u32x4*)(ur + U_SK + kvh * 64 + c8 * 8); vv = *(const u32x4*)(ur + U_SV + kvh * 64 + c8 * 8); }
            *(LAS u32x4*)(K_l + kl * 72 + c8 * 8) = kv;
            const int kp = kperm_pos(kl); LAS bf16_t* vp = VT_l + (c8 * 8) * 200 + kp;
            vp[0] = (bf16_t)(vv.x & 0xffffu); vp[200] = (bf16_t)(vv.x >> 16); vp[400] = (bf16_t)(vv.y & 0xffffu); vp[600] = (bf16_t)(vv.y >> 16);
            vp[800] = (bf16_t)(vv.z & 0xffffu); vp[1000] = (bf16_t)(vv.z >> 16); vp[1200] = (bf16_t)(vv.w & 0xffffu); vp[1400] = (bf16_t)(vv.w >> 16); }
        __syncthreads();
        const float slope = exp2f(-0.5f * (float)(h + 1)), sink = sinks[h];
#pragma unroll 1
        for (int i = 0; i < 4; ++i) {
            const size_t qrow = seq0 + qb * 64 + i * 16 + r;
            const bf16x8 qf0 = *(const bf16x8*)(U + qrow * NINP + U_SQ + h * 64 + q * 8), qf1 = *(const bf16x8*)(U + qrow * NINP + U_SQ + h * 64 + 32 + q * 8);
            const int kt0 = i & ~1;
            f32x4 s[10]; float mx = sink; bf16x8 kfr[5][2];
#pragma unroll
            for (int kt = 0; kt < 10; ++kt) { f32x4 d;
                if (kt % 5 == 0) {
#pragma unroll
                    for (int k5 = 0; k5 < 5; ++k5) { const LAS bf16_t* kp = K_l + ((kt0 + kt + k5) * 16 + r) * 72 + q * 8; kfr[k5][0] = *(const LAS bf16x8*)kp; kfr[k5][1] = *(const LAS bf16x8*)(kp + 32); }
                    __builtin_amdgcn_sched_barrier(0); }
                d = mma16(kfr[kt % 5][0], qf0, (f32x4){0.f, 0.f, 0.f, 0.f}); d = mma16(kfr[kt % 5][1], qf1, d);
#pragma unroll
                for (int jj = 0; jj < 4; ++jj) { const int kl = (kt0 + kt) * 16 + q * 4 + jj, dist = i * 16 + r + 128 - kl;
                    const float v = (dist >= 0 && dist <= 128 && tok0 + kl >= 0) ? d[jj] * 0.125f - slope * (float)dist : -1e30f; d[jj] = v; mx = fmaxf(mx, v); }
                s[kt] = d; }
            mx = fmaxf(mx, __shfl_xor(mx, 16, 64)); mx = fmaxf(mx, __shfl_xor(mx, 32, 64));
            float sum = 0.f; bf16x8 pf[5];
#pragma unroll
            for (int kp = 0; kp < 5; ++kp) { f32x4 a = s[2 * kp], bq = s[2 * kp + 1];
#pragma unroll
                for (int jj = 0; jj < 4; ++jj) { a[jj] = __expf(a[jj] - mx); bq[jj] = __expf(bq[jj] - mx); sum += a[jj] + bq[jj]; }
                pf[kp] = pack_acc(a, bq); }
            sum += __shfl_xor(sum, 16, 64); sum += __shfl_xor(sum, 32, 64);
            const float inv = 1.0f / (sum + __expf(sink - mx));
            bf16_t* op = OB + qrow * BW + h * 64 + q * 4;
#pragma unroll
            for (int dt = 0; dt < 4; ++dt) { f32x4 o = (f32x4){0.f, 0.f, 0.f, 0.f}; bf16x8 vfr[5];
#pragma unroll
                for (int kp = 0; kp < 5; ++kp) vfr[kp] = *(const LAS bf16x8*)(VT_l + (dt * 16 + r) * 200 + (kt0 + 2 * kp) * 16 + q * 8);
                __builtin_amdgcn_sched_barrier(0);
#pragma unroll
                for (int kp = 0; kp < 5; ++kp) o = mma16(vfr[kp], pf[kp], o);
                u32x2 ov; ov.x = pk2(o[0] * inv, o[1] * inv); ov.y = pk2(o[2] * inv, o[3] * inv); *(u32x2*)(op + dt * 16) = ov; }
        }
        __syncthreads();
    }
}

__device__ __forceinline__ void ph_swa_sample(const Ctx& c, const bf16_t* __restrict__ U, const float* __restrict__ ck, const float* __restrict__ cv, const float* __restrict__ sinks, bf16_t* __restrict__ OB) {
    LAS bf16_t* K_l = (LAS bf16_t*)c.lds;
    LAS bf16_t* VT_l = K_l + 160 * 72;
    const int tid = c.tid, lane = c.lane, r = lane & 15, q = lane >> 4, w = c.wave;
    for (int u = c.bid; u < SB * 2; u += c.G) {
        const int sq = u >> 1, kvh = u & 1;
        for (int idx = tid; idx < 160 * 8; idx += 512) { const int kl = idx >> 3, c8 = idx & 7; float kx[8], vx[8];
#pragma unroll
            for (int e = 0; e < 8; ++e) { kx[e] = 0.f; vx[e] = 0.f; }
            if (kl < 128) { const size_t o = ((size_t)sq * 128 + kl) * 128 + kvh * 64 + c8 * 8; const f32x4 a = *(const f32x4*)(ck + o), b2 = *(const f32x4*)(ck + o + 4), c2 = *(const f32x4*)(cv + o), d2 = *(const f32x4*)(cv + o + 4);
                kx[0] = a[0]; kx[1] = a[1]; kx[2] = a[2]; kx[3] = a[3]; kx[4] = b2[0]; kx[5] = b2[1]; kx[6] = b2[2]; kx[7] = b2[3];
                vx[0] = c2[0]; vx[1] = c2[1]; vx[2] = c2[2]; vx[3] = c2[3]; vx[4] = d2[0]; vx[5] = d2[1]; vx[6] = d2[2]; vx[7] = d2[3]; }
            else if (kl < 132) { const bf16_t* ur = U + (size_t)(MP + sq * SS + kl - 128) * NINP; unpack8(*(const u32x4*)(ur + U_SK + kvh * 64 + c8 * 8), kx); unpack8(*(const u32x4*)(ur + U_SV + kvh * 64 + c8 * 8), vx); }
            *(LAS u32x4*)(K_l + kl * 72 + c8 * 8) = (u32x4){pk2(kx[0], kx[1]), pk2(kx[2], kx[3]), pk2(kx[4], kx[5]), pk2(kx[6], kx[7])};
            LAS bf16_t* vp = VT_l + (c8 * 8) * 168 + kperm_pos(kl);
#pragma unroll
            for (int e = 0; e < 8; ++e) vp[e * 168] = f2bf(vx[e]); }
        __syncthreads();
        if (w < 2) {
            const int h = kvh * 8 + w * 4 + (r >> 2), tk = r & 3; const size_t qrow = (size_t)(MP + sq * SS + tk);
            const float slope = exp2f(-0.5f * (float)(h + 1)), sink = sinks[h];
            const bf16x8 qf0 = *(const bf16x8*)(U + qrow * NINP + U_SQ + h * 64 + q * 8), qf1 = *(const bf16x8*)(U + qrow * NINP + U_SQ + h * 64 + 32 + q * 8);
            f32x4 s[10]; float mx = sink;
#pragma unroll
            for (int kt = 0; kt < 10; ++kt) { const LAS bf16_t* kp = K_l + (kt * 16 + r) * 72 + q * 8;
                f32x4 d = mma16(*(const LAS bf16x8*)kp, qf0, (f32x4){0.f, 0.f, 0.f, 0.f}); d = mma16(*(const LAS bf16x8*)(kp + 32), qf1, d);
#pragma unroll
                for (int jj = 0; jj < 4; ++jj) { const int kl = kt * 16 + q * 4 + jj, dist = 128 + tk - kl;
                    const float v = (dist >= 0 && dist <= 128) ? d[jj] * 0.125f - slope * (float)dist : -1e30f; d[jj] = v; mx = fmaxf(mx, v); }
                s[kt] = d; }
            mx = fmaxf(mx, __shfl_xor(mx, 16, 64)); mx = fmaxf(mx, __shfl_xor(mx, 32, 64));
            float sum = 0.f; bf16x8 pf[5];
#pragma unroll
            for (int kp = 0; kp < 5; ++kp) { f32x4 a = s[2 * kp], bq = s[2 * kp + 1];
#pragma unroll
                for (int jj = 0; jj < 4; ++jj) { a[jj] = __expf(a[jj] - mx); bq[jj] = __expf(bq[jj] - mx); sum += a[jj] + bq[jj]; }
                pf[kp] = pack_acc(a, bq); }
            sum += __shfl_xor(sum, 16, 64); sum += __shfl_xor(sum, 32, 64);
            const float inv = 1.0f / (sum + __expf(sink - mx));
            bf16_t* op = OB + qrow * BW + h * 64 + q * 4;
#pragma unroll
            for (int dt = 0; dt < 4; ++dt) { f32x4 o = (f32x4){0.f, 0.f, 0.f, 0.f};
#pragma unroll
                for (int kp = 0; kp < 5; ++kp) o = mma16(*(const LAS bf16x8*)(VT_l + (dt * 16 + r) * 168 + kp * 32 + q * 8), pf[kp], o);
                u32x2 ov; ov.x = pk2(o[0] * inv, o[1] * inv); ov.y = pk2(o[2] * inv, o[3] * inv); *(u32x2*)(op + dt * 16) = ov; }
        }
        __syncthreads();
    }
}

__device__ __forceinline__ void ph_lrw(const Ctx& c, const float* __restrict__ w2, const float* __restrict__ a2, const float* __restrict__ g2, bf16_t* __restrict__ LRW) {
    for (int idx = c.bid * 512 + c.tid; idx < NL * 256 * 1024; idx += c.G * 512) {
        const int ch = idx & 1023, j = (idx >> 10) & 255, l = idx >> 18;
        const float v = j < 64 ? w2[((size_t)l * 64 + j) * BW + ch] : (j < 128 ? a2[((size_t)l * 64 + j - 64) * BW + ch] : g2[((size_t)l * 128 + j - 128) * BW + ch]);
        LRW[((size_t)l * 1024 + ch) * 256 + j] = f2bf(v);
    }
}
constexpr int RWP_UNITS = (MP / 64) * 4 + SB * 4;
__device__ __forceinline__ void rwp_unit_info(int u, int& row0, int& ntok, int& hg, int& sq, bool& seq_first) {
    if (u < (MP / 64) * 4) { const int blk = u >> 2; hg = u & 3; row0 = blk * 64; ntok = 64; sq = -1; seq_first = (row0 % PS) == 0; }
    else { const int s = u - (MP / 64) * 4; sq = s >> 2; hg = s & 3; row0 = MP + sq * SS; ntok = SS; seq_first = true; }
}
__device__ __forceinline__ void ph_rwkv_pre(const Ctx& c, const bf16_t* __restrict__ U, const float* __restrict__ shift, const float* __restrict__ mu, const float* __restrict__ w0, const float* __restrict__ w2,
                                            const float* __restrict__ a0, const float* __restrict__ a2, const float* __restrict__ g2, const float* __restrict__ k_k, const float* __restrict__ k_a,
                                            const float* __restrict__ r_k, float* __restrict__ RW, bf16_t* __restrict__ RB, const bf16_t* __restrict__ LRW) {
    LAS bf16_t* P_l = (LAS bf16_t*)c.lds; LAS bf16_t* Kn_l = P_l + 4608; LAS bf16_t* Bn_l = Kn_l + 4608; LAS bf16_t* Q_l = Bn_l + 4608;
    LAS bf16_t* PT_l = Q_l + 4608; LAS bf16_t* BhT_l = PT_l + 4608; LAS bf16_t* KhT_l = BhT_l + 4608; LAS bf16_t* VT_l = KhT_l + 4608;
    LAS float* A_l = (LAS float*)(c.lds + 73728);
    LAS bf16_t* BmT_l = (LAS bf16_t*)(c.lds + 78848); LAS bf16_t* F_l = (LAS bf16_t*)(c.lds + 81920); LAS bf16_t* Tinv_l = (LAS bf16_t*)(c.lds + 84992);
    LAS bf16_t* PpT_l = (LAS bf16_t*)(c.lds + 88064);
    LAS bf16_t* BmpT_l = (LAS bf16_t*)(c.lds + 97280);
    LAS float* GC_l = (LAS float*)(c.lds + 100352);
    LAS float* lg_l = (LAS float*)(c.lds + 125952);
    LAS bf16_t* act_l = (LAS bf16_t*)c.lds;
    LAS bf16_t* wT_l = act_l + 64 * 264;
    LAS bf16_t* aT_l = wT_l + 64 * 72;
    LAS bf16_t* gT_l = aT_l + 64 * 72;
    LAS float* pre_l = (LAS float*)(c.lds + 73728);
    const int tid = c.tid, lane = c.lane, r = lane & 15, q = lane >> 4, w = c.wave;
    float* Gg = RW + 6 * (size_t)MPAD * BW; float* BON = RW + 7 * (size_t)MPAD * BW;
    for (int u = c.bid; u < RWP_UNITS; u += c.G) {
        int row0, ntok, hg, sq; bool seq_first; rwp_unit_info(u, row0, ntok, hg, sq, seq_first);
        const float* sh = sq >= 0 ? shift + (size_t)sq * RWC : nullptr;
        const int nstage = ntok == 64 ? 64 : 16;
        for (int idx = tid; idx < nstage * 32; idx += 512) {
            const int t = idx >> 5, c8 = idx & 31, cc = 3072 + c8 * 8; float val[8];
#pragma unroll
            for (int e2 = 0; e2 < 8; ++e2) val[e2] = 0.f;
            if (t < ntok) { const bf16_t* ur = U + (size_t)(row0 + t) * NINP + U_RU; float x[8], p[8];
                unpack8(*(const u32x4*)(ur + cc), x);
                if (!(t == 0 && seq_first)) unpack8(*(const u32x4*)(ur + cc - NINP), p);
                else if (sh) { const f32x4 s0v = *(const f32x4*)(sh + cc), s1v = *(const f32x4*)(sh + cc + 4); p[0] = s0v[0]; p[1] = s0v[1]; p[2] = s0v[2]; p[3] = s0v[3]; p[4] = s1v[0]; p[5] = s1v[1]; p[6] = s1v[2]; p[7] = s1v[3]; }
                else {
#pragma unroll
                    for (int e2 = 0; e2 < 8; ++e2) p[e2] = 0.f; }
                const f32x4 m0 = *(const f32x4*)(mu + cc), m1 = *(const f32x4*)(mu + cc + 4);
#pragma unroll
                for (int e2 = 0; e2 < 8; ++e2) { const float xm = x[e2] + (p[e2] - x[e2]) * (e2 < 4 ? m0[e2] : m1[e2 - 4]); val[e2] = c8 < 8 ? tanh_fast(xm) : (c8 < 16 ? xm : sigmoidf_(xm)); } }
            *(LAS u32x4*)(act_l + t * 264 + c8 * 8) = (u32x4){pk2(val[0], val[1]), pk2(val[2], val[3]), pk2(val[4], val[5]), pk2(val[6], val[7])};
        }
        __syncthreads();
        bf16x8 af[8];
        { const int tb = w & 3;
#pragma unroll
          for (int ks = 0; ks < 8; ++ks) af[ks] = *(const LAS bf16x8*)(act_l + (tb * 16 + r) * 264 + ks * 32 + q * 8); }
        __syncthreads();
#pragma unroll 1
        for (int hh = 0; hh < 4; ++hh) { const int h = hg * 4 + hh;
        { const int tb = w & 3, chf = w >> 2;
          if (tb * 16 < nstage) {
#pragma unroll
            for (int e2 = 0; e2 < 2; ++e2) { const int cb = chf * 2 + e2; f32x4 dw = (f32x4){0.f, 0.f, 0.f, 0.f}, da = dw, dg = dw;
                const bf16_t* wr = LRW + ((size_t)h * 64 + cb * 16 + r) * 256 + q * 8; bf16x8 wf[8];
#pragma unroll
                for (int ks = 0; ks < 8; ++ks) wf[ks] = *(const bf16x8*)(wr + ks * 32);
                __builtin_amdgcn_sched_barrier(0);
#pragma unroll
                for (int ks = 0; ks < 2; ++ks) { dw = mma16(wf[ks], af[ks], dw); da = mma16(wf[2 + ks], af[2 + ks], da); }
#pragma unroll
                for (int ks = 0; ks < 4; ++ks) dg = mma16(wf[4 + ks], af[4 + ks], dg);
                const int o = (tb * 16 + r) * 68 + cb * 16 + q * 4;
                *(LAS f32x4*)(pre_l + o) = dw; *(LAS f32x4*)(pre_l + 64 * 68 + o) = da; *(LAS f32x4*)(pre_l + 2 * 64 * 68 + o) = dg; } } }
        __syncthreads();
        const int t = tid >> 3, cg = tid & 7, c0 = h * 64 + cg * 8, sc = t >> 4;
        float rr[8], k2[8], kap[8], bet[8], nlw[8];
        { float vx[8], gg[8], kkr[8]; float ss = 0.f, rk = 0.f;
          if (t < ntok) {
            const size_t row = (size_t)(row0 + t); const bf16_t* ur = U + row * NINP + U_RU; const bool fst = (t == 0 && seq_first);
            float kx[8];
#pragma unroll
            for (int part = 0; part < 3; ++part) { const int cc = part * 1024 + c0; float x[8], p[8];
                unpack8(*(const u32x4*)(ur + cc), x);
                if (!fst) unpack8(*(const u32x4*)(ur + cc - NINP), p);
                else {
#pragma unroll
                    for (int j = 0; j < 8; ++j) p[j] = sh ? sh[cc + j] : 0.f; }
                const f32x4 mA = *(const f32x4*)(mu + cc), mB = *(const f32x4*)(mu + cc + 4);
#pragma unroll
                for (int j = 0; j < 8; ++j) { const float xm = x[j] + (p[j] - x[j]) * (j < 4 ? mA[j] : mB[j - 4]); if (part == 0) rr[j] = xm; else if (part == 1) kx[j] = xm; else vx[j] = xm; } }
            float pw[8], pa[8], pkk[8], pka[8], prk[8];
#pragma unroll
            for (int hf = 0; hf < 2; ++hf) { const f32x4 v0 = *(const f32x4*)(w0 + c0 + hf * 4), v1 = *(const f32x4*)(a0 + c0 + hf * 4), v2 = *(const f32x4*)(k_k + c0 + hf * 4), v3 = *(const f32x4*)(k_a + c0 + hf * 4), v4 = *(const f32x4*)(r_k + c0 + hf * 4);
#pragma unroll
                for (int j = 0; j < 4; ++j) { pw[hf * 4 + j] = v0[j]; pa[hf * 4 + j] = v1[j]; pkk[hf * 4 + j] = v2[j]; pka[hf * 4 + j] = v3[j]; prk[hf * 4 + j] = v4[j]; } }
            float lwp[8], app[8];
#pragma unroll
            for (int hf = 0; hf < 2; ++hf) { const f32x4 v0 = *(const LAS f32x4*)(pre_l + t * 68 + cg * 8 + hf * 4), v1 = *(const LAS f32x4*)(pre_l + 64 * 68 + t * 68 + cg * 8 + hf * 4), v2 = *(const LAS f32x4*)(pre_l + 2 * 64 * 68 + t * 68 + cg * 8 + hf * 4);
#pragma unroll
                for (int j = 0; j < 4; ++j) { lwp[hf * 4 + j] = v0[j]; app[hf * 4 + j] = v1[j]; gg[hf * 4 + j] = v2[j]; } }
#pragma unroll
            for (int j = 0; j < 8; ++j) {
                const float lw = -softplus_fast(-(pw[j] + lwp[j])) - 0.5f; nlw[j] = -__expf(lw); const float av = sigmoidf_(pa[j] + app[j]);
                kkr[j] = kx[j] * pkk[j]; ss += kkr[j] * kkr[j]; k2[j] = kx[j] * (1.0f + (av - 1.0f) * pka[j]); rk += rr[j] * k2[j] * prk[j]; bet[j] = av; }
          } else {
#pragma unroll
            for (int j = 0; j < 8; ++j) { rr[j] = 0.f; k2[j] = 0.f; kkr[j] = 0.f; bet[j] = 0.f; nlw[j] = 0.f; vx[j] = 0.f; gg[j] = 0.f; }
          }
          ss += __shfl_xor(ss, 1, 64); ss += __shfl_xor(ss, 2, 64); ss += __shfl_xor(ss, 4, 64);
          rk += __shfl_xor(rk, 1, 64); rk += __shfl_xor(rk, 2, 64); rk += __shfl_xor(rk, 4, 64);
          const float inv = 1.0f / fmaxf(sqrtf(ss), 1e-12f);
#pragma unroll
          for (int j = 0; j < 8; ++j) { kap[j] = kkr[j] * inv; bet[j] = kap[j] * bet[j]; }
          if (t < ntok) { const size_t o = (size_t)(row0 + t) * BW + c0;
              *(f32x4*)(Gg + o) = (f32x4){gg[0], gg[1], gg[2], gg[3]}; *(f32x4*)(Gg + o + 4) = (f32x4){gg[4], gg[5], gg[6], gg[7]};
              *(f32x4*)(BON + o) = (f32x4){rk * vx[0], rk * vx[1], rk * vx[2], rk * vx[3]}; *(f32x4*)(BON + o + 4) = (f32x4){rk * vx[4], rk * vx[5], rk * vx[6], rk * vx[7]}; }
          *(LAS f32x4*)(lg_l + t * 68 + cg * 8) = (f32x4){nlw[0], nlw[1], nlw[2], nlw[3]}; *(LAS f32x4*)(lg_l + t * 68 + cg * 8 + 4) = (f32x4){nlw[4], nlw[5], nlw[6], nlw[7]};
#pragma unroll
          for (int j = 0; j < 8; ++j) VT_l[(cg * 8 + j) * 72 + t] = f2bf(vx[j]);
        }
        __syncthreads();
        if (tid < 256) { const int cc = tid & 63, s4 = tid >> 6; float run = 0.f;
#pragma unroll
            for (int i = 0; i < 16; ++i) { const int o = (s4 * 16 + i) * 68 + cc; run += lg_l[o]; lg_l[o] = run; } }
        __syncthreads();
        { unsigned pp[4], pq[4], pk[4], pb[4];
#pragma unroll
          for (int j = 0; j < 8; j += 2) { float vP[2], vQ[2], vK[2], vB[2];
#pragma unroll
              for (int e = 0; e < 2; ++e) { const int jj = j + e, cc = cg * 8 + jj; const float ci = lg_l[t * 68 + cc], cC = lg_l[(sc * 16 + 15) * 68 + cc];
                  const float ei = __expf(-ci), eh = __expf(cC - ci);
                  vP[e] = kap[jj] * __expf(ci - nlw[jj]); vQ[e] = rr[jj] * __expf(ci); vK[e] = k2[jj] * ei; vB[e] = bet[jj] * ei;
                  PT_l[cc * 72 + t] = f2bf(vP[e]); BhT_l[cc * 72 + t] = f2bf(bet[jj] * eh); KhT_l[cc * 72 + t] = f2bf(k2[jj] * eh); }
              pp[j >> 1] = pk2(vP[0], vP[1]); pq[j >> 1] = pk2(vQ[0], vQ[1]); pk[j >> 1] = pk2(vK[0], vK[1]); pb[j >> 1] = pk2(vB[0], vB[1]); }
          const int o = t * 72 + cg * 8;
          *(LAS u32x4*)(P_l + o) = (u32x4){pp[0], pp[1], pp[2], pp[3]}; *(LAS u32x4*)(Q_l + o) = (u32x4){pq[0], pq[1], pq[2], pq[3]};
          *(LAS u32x4*)(Kn_l + o) = (u32x4){pk[0], pk[1], pk[2], pk[3]}; *(LAS u32x4*)(Bn_l + o) = (u32x4){pb[0], pb[1], pb[2], pb[3]};
          if ((t & 15) == 15) {
#pragma unroll
              for (int j = 0; j < 8; ++j) GC_l[sc * 64 + cg * 8 + j] = __expf(lg_l[t * 68 + cg * 8 + j]); } }
        __syncthreads();
        const int nsub = ntok == 64 ? 4 : 1;
        const bf16x8 zfrag = (bf16x8){0, 0, 0, 0, 0, 0, 0, 0};
        for (int id = w; id < nsub * 3; id += 8) { const int s4 = id / 3, prod = id - s4 * 3; f32x4 d = (f32x4){0.f, 0.f, 0.f, 0.f};
            const LAS bf16_t* X = (prod == 1 ? P_l : Bn_l) + (s4 * 16 + r) * 72 + q * 8; const LAS bf16_t* Y = (prod == 0 ? P_l : (prod == 1 ? Kn_l : Q_l)) + (s4 * 16 + r) * 72 + q * 8;
            { const bf16x8 x0 = *(const LAS bf16x8*)X, x1 = *(const LAS bf16x8*)(X + 32), y0 = *(const LAS bf16x8*)Y, y1 = *(const LAS bf16x8*)(Y + 32);
              __builtin_amdgcn_sched_barrier(0); d = mma16(x0, y0, d); d = mma16(x1, y1, d); }
            if (prod == 0) { f32x4 o4;
#pragma unroll
                for (int jj = 0; jj < 4; ++jj) o4[jj] = (q * 4 + jj < r) ? d[jj] : 0.f;
                *(LAS f32x4*)(A_l + s4 * 320 + r * 20 + q * 4) = o4; }
            else { float o4[4];
#pragma unroll
                for (int jj = 0; jj < 4; ++jj) o4[jj] = (prod == 1 ? (r < q * 4 + jj) : (q * 4 + jj <= r)) ? d[jj] : 0.f;
                u32x2 o; o.x = pk2(o4[0], o4[1]); o.y = pk2(o4[2], o4[3]); *(LAS u32x2*)((prod == 1 ? BmT_l : F_l) + s4 * 384 + r * 24 + q * 4) = o; } }
        __syncthreads();
        if (w == 0 && (lane >> 4) < nsub) { const int s4 = lane >> 4, jc = lane & 15; float x[16];
#pragma unroll
            for (int tt = 0; tt < 16; ++tt) { float s = (tt == jc) ? 1.f : 0.f;
#pragma unroll
                for (int i = 0; i < tt; ++i) s -= A_l[s4 * 320 + tt * 20 + i] * x[i];
                x[tt] = s; }
#pragma unroll
            for (int tt = 0; tt < 16; ++tt) Tinv_l[s4 * 384 + tt * 24 + jc] = f2bf(x[tt]); }
        __syncthreads();
        for (int id = w; id < nsub * 5; id += 8) { const int s4 = id / 5, rem = id - s4 * 5;
            const bf16x8 xf = q < 2 ? *(const LAS bf16x8*)(Tinv_l + s4 * 384 + r * 24 + q * 8) : zfrag;
            const bf16x8 yf = q < 2 ? (rem < 4 ? *(const LAS bf16x8*)(PT_l + (rem * 16 + r) * 72 + s4 * 16 + q * 8) : *(const LAS bf16x8*)(BmT_l + s4 * 384 + r * 24 + q * 8)) : zfrag;
            const f32x4 d = mma16(xf, yf, (f32x4){0.f, 0.f, 0.f, 0.f});
            u32x2 o; o.x = pk2(d[0], d[1]); o.y = pk2(d[2], d[3]);
            if (rem < 4) *(LAS u32x2*)(PpT_l + (rem * 16 + r) * 72 + s4 * 16 + q * 4) = o; else *(LAS u32x2*)(BmpT_l + s4 * 384 + r * 24 + q * 4) = o; }
        __syncthreads();
        { const int chunk0 = sq >= 0 ? PB * 16 * 256 + sq * 16 + h : ((row0 / PS) * 16 + h) * 256 + ((row0 % PS) >> 4);
          for (int id = w; id < nsub * 25; id += 8) { const int s4 = id / 25, rem = id - s4 * 25; bf16_t* blob = RB + (size_t)(chunk0 + s4) * RB_EL;
            const bf16x8 fF = q < 2 ? *(const LAS bf16x8*)(F_l + s4 * 384 + r * 24 + q * 8) : zfrag;
            if (rem < 4) {
                const bf16x8 xf = q < 2 ? *(const LAS bf16x8*)(PpT_l + (rem * 16 + r) * 72 + s4 * 16 + q * 8) : zfrag;
                const f32x4 d = mma16(xf, fF, (f32x4){0.f, 0.f, 0.f, 0.f});
                const u32x2 qv = *(const LAS u32x2*)(Q_l + (s4 * 16 + r) * 72 + rem * 16 + q * 4);
                u32x2 o; o.x = pk2(__uint_as_float(qv.x << 16) - d[0], __uint_as_float(qv.x & 0xffff0000u) - d[1]); o.y = pk2(__uint_as_float(qv.y << 16) - d[2], __uint_as_float(qv.y & 0xffff0000u) - d[3]);
                *(u32x2*)(blob + RB_QP + r * 72 + 32 * (rem >> 1) + 8 * q + 4 * (rem & 1)) = o;
            } else if (rem == 4) {
                f32x4 d2 = (f32x4){0.f, 0.f, 0.f, 0.f};
#pragma unroll
                for (int ks = 0; ks < 2; ++ks) d2 = mma16(*(const LAS bf16x8*)(Kn_l + (s4 * 16 + r) * 72 + ks * 32 + q * 8), *(const LAS bf16x8*)(Q_l + (s4 * 16 + r) * 72 + ks * 32 + q * 8), d2);
                const bf16x8 xf = q < 2 ? *(const LAS bf16x8*)(BmpT_l + s4 * 384 + r * 24 + q * 8) : zfrag;
                const f32x4 d1 = mma16(xf, fF, (f32x4){0.f, 0.f, 0.f, 0.f});
                float o4[4];
#pragma unroll
                for (int jj = 0; jj < 4; ++jj) o4[jj] = ((q * 4 + jj <= r) ? d2[jj] : 0.f) - d1[jj];
                u32x2 o; o.x = pk2(o4[0], o4[1]); o.y = pk2(o4[2], o4[3]); *(u32x2*)(blob + RB_EP + r * 24 + q * 4) = o;
            } else if (rem < 21) {
                const int cib = (rem - 5) >> 2, cob = (rem - 5) & 3;
                const bf16x8 xf = q < 2 ? *(const LAS bf16x8*)(PpT_l + (cib * 16 + r) * 72 + s4 * 16 + q * 8) : zfrag;
                const bf16x8 yf = q < 2 ? *(const LAS bf16x8*)(BhT_l + (cob * 16 + r) * 72 + s4 * 16 + q * 8) : zfrag;
                const f32x4 d = mma16(xf, yf, (f32x4){0.f, 0.f, 0.f, 0.f});
                const float gc = GC_l[s4 * 64 + cob * 16 + r]; float o4[4];
#pragma unroll
                for (int jj = 0; jj < 4; ++jj) o4[jj] = ((cib == cob && q * 4 + jj == r) ? gc : 0.f) - d[jj];
                u32x2 o; o.x = pk2(o4[0], o4[1]); o.y = pk2(o4[2], o4[3]); *(u32x2*)(blob + (cob * 16 + r) * 72 + 32 * (cib >> 1) + 8 * q + 4 * (cib & 1)) = o;
            } else {
                const int cb = rem - 21;
                const bf16x8 xf = q < 2 ? *(const LAS bf16x8*)(BmpT_l + s4 * 384 + r * 24 + q * 8) : zfrag;
                const bf16x8 yf = q < 2 ? *(const LAS bf16x8*)(BhT_l + (cb * 16 + r) * 72 + s4 * 16 + q * 8) : zfrag;
                const f32x4 d = mma16(xf, yf, (f32x4){0.f, 0.f, 0.f, 0.f});
                const u32x2 kv = *(const LAS u32x2*)(KhT_l + (cb * 16 + r) * 72 + s4 * 16 + q * 4);
                u32x2 o; o.x = pk2(__uint_as_float(kv.x << 16) - d[0], __uint_as_float(kv.x & 0xffff0000u) - d[1]); o.y = pk2(__uint_as_float(kv.y << 16) - d[2], __uint_as_float(kv.y & 0xffff0000u) - d[3]);
                *(u32x2*)(blob + RB_KHP + (cb * 16 + r) * 24 + q * 4) = o;
            } }
          for (int idx = tid; idx < nsub * 128; idx += 512) { const int s4 = idx >> 7, cc = (idx >> 1) & 63, hf = idx & 1;
              *(u32x4*)(RB + (size_t)(chunk0 + s4) * RB_EL + RB_VT + cc * 24 + hf * 8) = *(const LAS u32x4*)(VT_l + cc * 72 + s4 * 16 + hf * 8); } }
        __syncthreads();
        }
    }
}

__device__ __forceinline__ void ph_rwkv_scan_naive(const Ctx& c, const float* __restrict__ RW, const float* __restrict__ s0, const float* __restrict__ lng, const float* __restrict__ lnb, bf16_t* __restrict__ OB,
                                                   float* __restrict__ outP, float* __restrict__ outS) {
    const float* R = RW; const float* WD = RW + (size_t)MPAD * BW; const float* K2 = WD + (size_t)MPAD * BW; const float* V = K2 + (size_t)MPAD * BW; const float* KK = V + (size_t)MPAD * BW;
    const float* BV = KK + (size_t)MPAD * BW; const float* G = BV + (size_t)MPAD * BW; const float* BON = G + (size_t)MPAD * BW;
    const int lane = c.lane;
    for (int it = 0;; ++it) {
        const int u = (it * 8 + c.wave) * c.G + c.bid;
        if (u >= (PB + SB) * 16) break;
        const int sq = u >> 4, h = u & 15;
        int row0, L; seq_info(sq, row0, L);
        float S[64];
        if (sq >= PB) { const float* p = s0 + (((size_t)(sq - PB) * 16 + h) * 64 + lane) * 64;
#pragma unroll
            for (int j = 0; j < 64; ++j) S[j] = p[j]; }
        else {
#pragma unroll
            for (int j = 0; j < 64; ++j) S[j] = 0.f; }
        const float lg = lng[h * 64 + lane], lb = lnb[h * 64 + lane];
        for (int t = 0; t < L; ++t) {
            const size_t base = (size_t)(row0 + t) * BW + h * 64; const float v = V[base + lane];
            float d = 0.f;
#pragma unroll
            for (int j = 0; j < 64; ++j) d += S[j] * KK[base + j];
            float y = 0.f;
#pragma unroll
            for (int j = 0; j < 64; ++j) { S[j] = S[j] * WD[base + j] - d * BV[base + j] + v * K2[base + j]; y += S[j] * R[base + j]; }
            const float mean = wave_sum(y) * (1.0f / 64.0f), dy = y - mean, var = wave_sum(dy * dy) * (1.0f / 64.0f);
            const float yn = dy * rsqrtf(var + 64e-5f) * lg + lb;
            OB[base + lane] = f2bf((yn + BON[base + lane]) * G[base + lane]);
        }
        float* op = (sq < PB ? outP + (((size_t)sq * 16 + h) * 64 + lane) * 64 : outS + (((size_t)(sq - PB) * 16 + h) * 64 + lane) * 64);
#pragma unroll
        for (int j = 0; j < 64; ++j) op[j] = S[j];
    }
}
__device__ __forceinline__ void ph_rwkv_scan2(const Ctx& c, int boff, const float* __restrict__ RW, const float* __restrict__ s0, const float* __restrict__ lng, const float* __restrict__ lnb, bf16_t* __restrict__ OB,
                                              float* __restrict__ outP, float* __restrict__ outS) {
    LAS float* opb = (LAS float*)c.lds;
    LAS float* yb = opb + 2 * 16 * 384;
    const int tid = c.tid, lane = c.lane, w = c.wave, rl = lane >> 3, cg = lane & 7, vrow = w * 8 + rl;
    const float* G = RW + 6 * (size_t)MPAD * BW; const float* BON = RW + 7 * (size_t)MPAD * BW;
    for (int u = (c.bid - boff + c.G) % c.G; u < (PB + SB) * 16; u += c.G) {
        const int sq = u >> 4, h = u & 15;
        int row0, L; seq_info(sq, row0, L);
        float S[8];
        if (sq >= PB) { const float* p = s0 + (((size_t)(sq - PB) * 16 + h) * 64 + vrow) * 64 + cg * 8;
#pragma unroll
            for (int j = 0; j < 8; ++j) S[j] = p[j]; }
        else {
#pragma unroll
            for (int j = 0; j < 8; ++j) S[j] = 0.f; }
        const float lg = lng[h * 64 + lane], lb = lnb[h * 64 + lane];
        const int nb = (L + 15) >> 4;
#define RW_STAGE(bi_) do { const int t0_ = (bi_) * 16, nT_ = (L - t0_) < 16 ? (L - t0_) : 16; LAS float* dst_ = opb + ((bi_) & 1) * 16 * 384; \
        for (int idx = tid; idx < nT_ * 96; idx += 512) { const int t = idx / 96, rem = idx - t * 96, slot = rem >> 4, c4 = rem & 15; \
            const int arr = slot == 0 ? 1 : slot == 1 ? 4 : slot == 2 ? 5 : slot == 3 ? 2 : slot == 4 ? 0 : 3; \
            *(LAS f32x4*)(dst_ + t * 384 + slot * 64 + c4 * 4) = *(const f32x4*)(RW + (size_t)arr * MPAD * BW + (size_t)(row0 + t0_ + t) * BW + h * 64 + c4 * 4); } } while (0)
        RW_STAGE(0);
        for (int bi = 0; bi < nb; ++bi) {
            __syncthreads();
            if (bi + 1 < nb) RW_STAGE(bi + 1);
            const int t0 = bi * 16, nT = (L - t0) < 16 ? (L - t0) : 16; const LAS float* src = opb + (bi & 1) * 16 * 384;
            for (int tt = 0; tt < nT; ++tt) {
                const LAS float* b = src + tt * 384 + cg * 8;
                const f32x4 w0 = *(const LAS f32x4*)(b), w1 = *(const LAS f32x4*)(b + 4), k0 = *(const LAS f32x4*)(b + 64), k1 = *(const LAS f32x4*)(b + 68);
                const f32x4 b0 = *(const LAS f32x4*)(b + 128), b1 = *(const LAS f32x4*)(b + 132), q0 = *(const LAS f32x4*)(b + 192), q1 = *(const LAS f32x4*)(b + 196);
                const f32x4 r0 = *(const LAS f32x4*)(b + 256), r1 = *(const LAS f32x4*)(b + 260); const float v = src[tt * 384 + 320 + vrow];
                float d = (S[0] * k0[0] + S[1] * k0[1]) + (S[2] * k0[2] + S[3] * k0[3]) + (S[4] * k1[0] + S[5] * k1[1]) + (S[6] * k1[2] + S[7] * k1[3]);
                d += __shfl_xor(d, 1, 64); d += __shfl_xor(d, 2, 64); d += __shfl_xor(d, 4, 64);
                float y = 0.f;
#pragma unroll
                for (int j = 0; j < 4; ++j) { S[j] = S[j] * w0[j] - d * b0[j] + v * q0[j]; y += S[j] * r0[j]; S[4 + j] = S[4 + j] * w1[j] - d * b1[j] + v * q1[j]; y += S[4 + j] * r1[j]; }
                y += __shfl_xor(y, 1, 64); y += __shfl_xor(y, 2, 64); y += __shfl_xor(y, 4, 64);
                if (cg == 0) yb[tt * 64 + vrow] = y;
            }
            __syncthreads();
            for (int tt = w; tt < nT; tt += 8) {
                const float y = yb[tt * 64 + lane]; const float mean = wave_sum(y) * (1.0f / 64.0f), dy = y - mean, var = wave_sum(dy * dy) * (1.0f / 64.0f);
                const float yn = dy * rsqrtf(var + 64e-5f) * lg + lb; const size_t o = (size_t)(row0 + t0 + tt) * BW + h * 64 + lane;
                OB[o] = f2bf((yn + BON[o]) * G[o]);
            }
        }
#undef RW_STAGE
        float* op = (sq < PB ? outP + (((size_t)sq * 16 + h) * 64 + vrow) * 64 : outS + (((size_t)(sq - PB) * 16 + h) * 64 + vrow) * 64) + cg * 8;
#pragma unroll
        for (int j = 0; j < 8; ++j) op[j] = S[j];
        __syncthreads();
    }
}
constexpr int RS_SLOTS = 8, RS_SLOT_B = RB_EL * 2;
__device__ __forceinline__ void ph_rwkv_seq(const Ctx& c, int boff, const bf16_t* __restrict__ RB, const float* __restrict__ s0, float* __restrict__ outP, float* __restrict__ outS, bf16_t* __restrict__ OB) {
    const int lane = c.lane, r = lane & 15, q = lane >> 4, w = c.wave;
    LAS unsigned char* ring = c.lds;
    const int side = c.bid < 32 ? c.bid : c.bid - 64, nside = c.G - 64;
    for (int u = (c.bid >= boff && c.bid < boff + 32) ? c.bid - boff : ((c.bid < 32 || c.bid >= 96) ? 32 + side : (PB + SB) * 16); u < (PB + SB) * 16; u = u < 32 ? (PB + SB) * 16 : u + nside) {
        const int sq = u >> 4, h = u & 15;
        int nch, ch0, row0, ntok; const float* sp = nullptr; float* op;
        if (sq < PB) { nch = 256; ch0 = (sq * 16 + h) * 256; row0 = sq * PS; ntok = 16; op = outP + (size_t)(sq * 16 + h) * 4096; }
        else { nch = 1; ch0 = PB * 16 * 256 + (sq - PB) * 16 + h; row0 = MP + (sq - PB) * SS; ntok = SS; sp = s0 + (size_t)((sq - PB) * 16 + h) * 4096; op = outS + (size_t)((sq - PB) * 16 + h) * 4096; }
        if (w >= 4) {
            const int lw = w - 4, p0 = lw < 2 ? lw * 5 : 10 + (lw - 2) * 4, np = lw < 2 ? 5 : 4;
#define RS_ISSUE(ci_) do { const int cc_ = (ci_) < nch ? (ci_) : nch - 1; const char* g_ = (const char*)(RB + (size_t)(ch0 + cc_) * RB_EL) + p0 * 1024 + lane * 16; \
            LAS unsigned char* d_ = ring + ((ci_) % RS_SLOTS) * RS_SLOT_B + p0 * 1024; \
            _Pragma("unroll") for (int p_ = 0; p_ < 5; ++p_) if (p_ < np) __builtin_amdgcn_global_load_lds((const unsigned*)(g_ + p_ * 1024), (LAS unsigned*)(d_ + p_ * 1024), 16, 0, 0); } while (0)
            for (int ci = 0; ci < RS_SLOTS - 1; ++ci) RS_ISSUE(ci);
            if (lw < 2) asm volatile("s_waitcnt vmcnt(30)" ::: "memory"); else asm volatile("s_waitcnt vmcnt(24)" ::: "memory");
            __builtin_amdgcn_s_barrier();
            for (int ci = 0; ci < nch; ++ci) {
                RS_ISSUE(ci + RS_SLOTS - 1);
                if (lw < 2) asm volatile("s_waitcnt vmcnt(30)" ::: "memory"); else asm volatile("s_waitcnt vmcnt(24)" ::: "memory");
                __builtin_amdgcn_s_barrier();
            }
#undef RS_ISSUE
            asm volatile("s_waitcnt vmcnt(0)" ::: "memory");
        } else {
            const int vb = w; f32x4 acc[4];
#pragma unroll
            for (int kb = 0; kb < 4; ++kb) acc[kb] = sp ? *(const f32x4*)(sp + (size_t)(vb * 16 + r) * 64 + kb * 16 + q * 4) : (f32x4){0.f, 0.f, 0.f, 0.f};
            const bf16x8 zfrag = (bf16x8){0, 0, 0, 0, 0, 0, 0, 0};
            __builtin_amdgcn_s_barrier();
            for (int ci = 0; ci < nch; ++ci) {
                const LAS bf16_t* blob = (const LAS bf16_t*)(ring + (ci % RS_SLOTS) * RS_SLOT_B);
                bf16x8 mf[4][2], khf[4], qpf[2];
#pragma unroll
                for (int kb = 0; kb < 4; ++kb) { mf[kb][0] = *(const LAS bf16x8*)(blob + (kb * 16 + r) * 72 + q * 8); mf[kb][1] = *(const LAS bf16x8*)(blob + (kb * 16 + r) * 72 + 32 + q * 8);
                    khf[kb] = q < 2 ? *(const LAS bf16x8*)(blob + RB_KHP + (kb * 16 + r) * 24 + q * 8) : zfrag; }
                qpf[0] = *(const LAS bf16x8*)(blob + RB_QP + r * 72 + q * 8); qpf[1] = *(const LAS bf16x8*)(blob + RB_QP + r * 72 + 32 + q * 8);
                const bf16x8 vt = q < 2 ? *(const LAS bf16x8*)(blob + RB_VT + (vb * 16 + r) * 24 + q * 8) : zfrag;
                const bf16x8 ep = q < 2 ? *(const LAS bf16x8*)(blob + RB_EP + r * 24 + q * 8) : zfrag;
                const bf16x8 t0 = pack_acc(acc[0], acc[1]), t1 = pack_acc(acc[2], acc[3]);
                __builtin_amdgcn_sched_barrier(0);
#pragma unroll
                for (int kb = 0; kb < 4; ++kb) acc[kb] = mma16(mf[kb][0], t0, (f32x4){0.f, 0.f, 0.f, 0.f});
#pragma unroll
                for (int kb = 0; kb < 4; ++kb) acc[kb] = mma16(mf[kb][1], t1, acc[kb]);
#pragma unroll
                for (int kb = 0; kb < 4; ++kb) acc[kb] = mma16(khf[kb], vt, acc[kb]);
                f32x4 y = mma16(t0, qpf[0], (f32x4){0.f, 0.f, 0.f, 0.f}); y = mma16(t1, qpf[1], y); y = mma16(vt, ep, y);
                if (r < ntok) { u32x2 o; o.x = pk2(y[0], y[1]); o.y = pk2(y[2], y[3]); *(u32x2*)(OB + (size_t)(row0 + ci * 16 + r) * BW + h * 64 + vb * 16 + q * 4) = o; }
                asm volatile("s_waitcnt lgkmcnt(0)" ::: "memory");
                __builtin_amdgcn_s_barrier();
            }
#pragma unroll
            for (int kb = 0; kb < 4; ++kb) *(f32x4*)(op + (size_t)(vb * 16 + r) * 64 + kb * 16 + q * 4) = acc[kb];
        }
        __syncthreads();
    }
}
__device__ __forceinline__ void ph_rwkv_fin(const Ctx& c, const float* __restrict__ RW, const float* __restrict__ lng, const float* __restrict__ lnb, const bf16_t* __restrict__ RAW, bf16_t* __restrict__ OB) {
    const int lane = c.lane; const float* G = RW + 6 * (size_t)MPAD * BW; const float* BON = RW + 7 * (size_t)MPAD * BW;
    for (int i = c.bid * 8 + c.wave; i < MT * 4; i += c.G * 8) {
        const int row = i >> 2, cc = (i & 3) * 256 + lane * 4; const size_t o = (size_t)row * BW + cc; bf16_t* p = OB + o;
        const u32x2 raw = *(const u32x2*)(RAW + o); float x[4] = {__uint_as_float(raw.x << 16), __uint_as_float(raw.x & 0xffff0000u), __uint_as_float(raw.y << 16), __uint_as_float(raw.y & 0xffff0000u)};
        float s = (x[0] + x[1]) + (x[2] + x[3]); s += __shfl_xor(s, 1, 64); s += __shfl_xor(s, 2, 64); s += __shfl_xor(s, 4, 64); s += __shfl_xor(s, 8, 64);
        const float mean = s * (1.0f / 64.0f); float qq = 0.f;
#pragma unroll
        for (int j = 0; j < 4; ++j) { const float d = x[j] - mean; qq += d * d; }
        qq += __shfl_xor(qq, 1, 64); qq += __shfl_xor(qq, 2, 64); qq += __shfl_xor(qq, 4, 64); qq += __shfl_xor(qq, 8, 64);
        const float rstd = rsqrtf(qq * (1.0f / 64.0f) + 64e-5f);
        const f32x4 gg = *(const f32x4*)(lng + cc), bb = *(const f32x4*)(lnb + cc), bo = *(const f32x4*)(BON + o), gt = *(const f32x4*)(G + o); float ov[4];
#pragma unroll
        for (int j = 0; j < 4; ++j) ov[j] = ((x[j] - mean) * rstd * gg[j] + bb[j] + bo[j]) * gt[j];
        u32x2 oo; oo.x = pk2(ov[0], ov[1]); oo.y = pk2(ov[2], ov[3]); *(u32x2*)p = oo;
    }
}

__device__ __forceinline__ void ph_memattn_sample(const Ctx& c, int boff, const bf16_t* __restrict__ U, const float* __restrict__ mk, const float* __restrict__ mv, bf16_t* __restrict__ OB) {
    LAS float* ps = (LAS float*)c.lds;
    const int hh = c.tid >> 8, vt = c.tid & 255, lane = c.lane, r = lane & 15, q = lane >> 4, w4 = c.wave & 3;
    for (int u = (c.bid - boff + c.G) % c.G; u < SB * 2; u += c.G) {
        const int sq = u >> 1, h = (u & 1) * 2 + hh;
        bf16x8 qf[8];
#pragma unroll
        for (int ks = 0; ks < 8; ++ks) { u32x4 raw = (u32x4){0u, 0u, 0u, 0u};
            if (r < 4) raw = *(const u32x4*)(U + (size_t)(MP + sq * SS + r) * NINP + U_MQ + h * 256 + ks * 32 + q * 8);
            qf[ks] = __builtin_bit_cast(bf16x8, raw); }
#pragma unroll 1
        for (int mt = 0; mt < 4; ++mt) { const float* kr = mk + (((size_t)sq * MEMT + (w4 * 4 + mt) * 16 + r) * 4 + h) * 256 + q * 8; f32x4 ka[8], kb2[8];
#pragma unroll
            for (int ks = 0; ks < 8; ++ks) { ka[ks] = *(const f32x4*)(kr + ks * 32); kb2[ks] = *(const f32x4*)(kr + ks * 32 + 4); }
            __builtin_amdgcn_sched_barrier(0);
            f32x4 d = (f32x4){0.f, 0.f, 0.f, 0.f};
#pragma unroll
            for (int ks = 0; ks < 8; ++ks) { u32x4 p; p.x = pk2(ka[ks][0], ka[ks][1]); p.y = pk2(ka[ks][2], ka[ks][3]); p.z = pk2(kb2[ks][0], kb2[ks][1]); p.w = pk2(kb2[ks][2], kb2[ks][3]);
                d = mma16(__builtin_bit_cast(bf16x8, p), qf[ks], d); }
            if (r < 4) *(LAS f32x4*)(ps + (hh * 4 + r) * 256 + (w4 * 4 + mt) * 16 + q * 4) = d * 0.0625f; }
        __syncthreads();
        { LAS float* pr = ps + c.wave * 256; float x[4]; float mx = -3.0e38f;
#pragma unroll
            for (int j = 0; j < 4; ++j) { x[j] = pr[lane + 64 * j]; mx = fmaxf(mx, x[j]); }
            mx = wave_max(mx); float s = 0.f;
#pragma unroll
            for (int j = 0; j < 4; ++j) { x[j] = __expf(x[j] - mx); s += x[j]; }
            const float inv = 1.0f / wave_sum(s);
#pragma unroll
            for (int j = 0; j < 4; ++j) pr[lane + 64 * j] = x[j] * inv; }
        __syncthreads();
        { float o[4] = {0.f, 0.f, 0.f, 0.f}; const float* vr = mv + ((size_t)sq * MEMT * 4 + h) * 256 + vt;
#pragma unroll 8
            for (int m = 0; m < MEMT; ++m) { const float vv = vr[(size_t)m * 1024];
#pragma unroll
                for (int t = 0; t < 4; ++t) o[t] += ps[(hh * 4 + t) * 256 + m] * vv; }
#pragma unroll
            for (int t = 0; t < 4; ++t) OB[(size_t)(MP + sq * SS + t) * BW + h * 256 + vt] = f2bf(o[t]); }
        __syncthreads();
    }
}

template <int K, int LDA, int LDB> __device__ __forceinline__ void skinny_pair(const Ctx& c, const bf16_t* __restrict__ A, const bf16_t* __restrict__ B0, const bf16_t* __restrict__ B1, f32x4 (&out)[2], int rot) {
    LAS f32x4* red = (LAS f32x4*)c.lds;
    const int lane = c.lane, r = lane & 15, q = lane >> 4, w = c.wave;
    constexpr int KS = K / 8;
    const bf16_t* ap = A + (size_t)r * LDA + w * KS + q * 8; const bf16_t* b0 = B0 + (size_t)r * LDB + w * KS + q * 8; const bf16_t* b1 = B1 + (size_t)r * LDB + w * KS + q * 8;
    f32x4 acc[2][8];
#pragma unroll
    for (int n = 0; n < 2; ++n)
#pragma unroll
        for (int m = 0; m < 8; ++m) acc[n][m] = (f32x4){0.f, 0.f, 0.f, 0.f};
    int kk = (int)((unsigned)rot % (unsigned)(KS / 32));
#pragma unroll 2
    for (int it = 0; it < KS / 32; ++it) { const int ks = kk; kk = kk + 1 == KS / 32 ? 0 : kk + 1;
        const bf16x8 f0 = *(const bf16x8*)(b0 + ks * 32), f1 = *(const bf16x8*)(b1 + ks * 32); bf16x8 af[8];
#pragma unroll
        for (int m = 0; m < 8; ++m) af[m] = *(const bf16x8*)(ap + (size_t)(m * 16) * LDA + ks * 32);
        __builtin_amdgcn_sched_barrier(0);
#pragma unroll
        for (int m = 0; m < 8; ++m) { acc[0][m] = mma16(f0, af[m], acc[0][m]); acc[1][m] = mma16(f1, af[m], acc[1][m]); } }
    __syncthreads();
#pragma unroll
    for (int n = 0; n < 2; ++n)
#pragma unroll
        for (int m = 0; m < 8; ++m) red[(w * 16 + n * 8 + m) * 64 + lane] = acc[n][m];
    __syncthreads();
#pragma unroll
    for (int n = 0; n < 2; ++n) { f32x4 s = red[(n * 8 + w) * 64 + lane];
#pragma unroll
        for (int ww = 1; ww < 8; ++ww) s += red[(ww * 16 + n * 8 + w) * 64 + lane];
        out[n] = s; }
}
template <int K, int LDA, int LDB> __device__ __forceinline__ f32x4 skinny_one(const Ctx& c, const bf16_t* __restrict__ A, const bf16_t* __restrict__ B0, int rot) {
    LAS f32x4* red = (LAS f32x4*)c.lds;
    const int lane = c.lane, r = lane & 15, q = lane >> 4, w = c.wave;
    constexpr int KS = K / 8, NK = KS / 32;
    const bf16_t* ap = A + (size_t)r * LDA + w * KS + q * 8; const bf16_t* b0 = B0 + (size_t)r * LDB + w * KS + q * 8;
    f32x4 acc[8];
#pragma unroll
    for (int m = 0; m < 8; ++m) acc[m] = (f32x4){0.f, 0.f, 0.f, 0.f};
    int kk = (int)((unsigned)rot % (unsigned)NK);
#pragma unroll 4
    for (int it = 0; it < NK; ++it) { const int ks = kk; kk = kk + 1 == NK ? 0 : kk + 1;
        const bf16x8 f0 = *(const bf16x8*)(b0 + ks * 32); bf16x8 af[8];
#pragma unroll
        for (int m = 0; m < 8; ++m) af[m] = *(const bf16x8*)(ap + (size_t)(m * 16) * LDA + ks * 32);
        __builtin_amdgcn_sched_barrier(0);
#pragma unroll
        for (int m = 0; m < 8; ++m) acc[m] = mma16(f0, af[m], acc[m]); }
    __syncthreads();
#pragma unroll
    for (int m = 0; m < 8; ++m) red[(w * 8 + m) * 64 + lane] = acc[m];
    __syncthreads();
    f32x4 s = red[w * 64 + lane];
#pragma unroll
    for (int ww = 1; ww < 8; ++ww) s += red[(ww * 8 + w) * 64 + lane];
    return s;
}
__device__ __forceinline__ u32x2 pk4(const f32x4 v) { u32x2 o; o.x = pk2(v[0], v[1]); o.y = pk2(v[2], v[3]); return o; }
#define SKINNY_LOOP(total_) for (int s = c.bid - base; s >= 0 && s < (total_); s += ncu)
__device__ __forceinline__ void ph_sk_in(const Ctx& c, int base, int ncu, const bf16_t* __restrict__ HB, const bf16_t* __restrict__ W, bf16_t* __restrict__ U) {
    const int r = c.lane & 15, q = c.lane >> 4, w = c.wave;
    SKINNY_LOOP(NINP / 32) { f32x4 o[2]; skinny_pair<DM, DM, DM>(c, HB + (size_t)MP * DM, W + (size_t)(s * 32) * DM, W + (size_t)(s * 32 + 16) * DM, o, s);
        bf16_t* up = U + (size_t)(MP + w * 16 + r) * NINP + s * 32 + q * 4; *(u32x2*)up = pk4(o[0]); *(u32x2*)(up + 16) = pk4(o[1]); }
}
__device__ __forceinline__ void ph_sk_merge(const Ctx& c, int base, int ncu, const bf16_t* __restrict__ BR, const bf16_t* __restrict__ W, const bf16_t* __restrict__ U, const float* __restrict__ gate_b, bf16_t* __restrict__ MGB) {
    const int r = c.lane & 15, q = c.lane >> 4, w = c.wave;
    SKINNY_LOOP(DM / 16) { const size_t row = (size_t)(MP + w * 16 + r); const int col = s * 16 + q * 4; f32x4 tot = (f32x4){0.f, 0.f, 0.f, 0.f};
#pragma unroll 1
        for (int z = 0; z < 4; ++z) { const f32x4 o = skinny_one<BW, BW, BW>(c, BR + ((size_t)z * MPAD + MP) * BW, W + ((size_t)z * DM + s * 16) * BW, s + z);
            const u32x2 gp = *(const u32x2*)(U + row * NINP + U_GP + z * DM + col); const f32x4 gb = *(const f32x4*)(gate_b + z * DM + col);
            tot[0] += sigmoidf_(__uint_as_float(gp.x << 16) + gb[0]) * o[0]; tot[1] += sigmoidf_(__uint_as_float(gp.x & 0xffff0000u) + gb[1]) * o[1];
            tot[2] += sigmoidf_(__uint_as_float(gp.y << 16) + gb[2]) * o[2]; tot[3] += sigmoidf_(__uint_as_float(gp.y & 0xffff0000u) + gb[3]) * o[3]; }
        *(u32x2*)(MGB + row * DM + col) = pk4(tot); }
}
template <int K> __device__ __forceinline__ void ph_sk_res(const Ctx& c, int base, int ncu, const bf16_t* __restrict__ A, const bf16_t* __restrict__ W, const bf16_t* __restrict__ R, bf16_t* __restrict__ Y) {
    const int r = c.lane & 15, q = c.lane >> 4, w = c.wave;
    SKINNY_LOOP(DM / 16) { const f32x4 o = skinny_one<K, K, K>(c, A + (size_t)MP * K, W + (size_t)(s * 16) * K, s);
        const size_t off = (size_t)(MP + w * 16 + r) * DM + s * 16 + q * 4; const u32x2 rr = *(const u32x2*)(R + off);
        const f32x4 rv = (f32x4){__uint_as_float(rr.x << 16), __uint_as_float(rr.x & 0xffff0000u), __uint_as_float(rr.y << 16), __uint_as_float(rr.y & 0xffff0000u)};
        *(u32x2*)(Y + off) = pk4(rv * ALPHA + o); }
}
__device__ __forceinline__ void ph_sk_gu(const Ctx& c, int base, int ncu, const bf16_t* __restrict__ X1B, const bf16_t* __restrict__ W, bf16_t* __restrict__ ACT) {
    const int r = c.lane & 15, q = c.lane >> 4, w = c.wave;
    SKINNY_LOOP(DFF / 16) { const int t = s >> 3, j0 = (s & 7) * 16; f32x4 o[2];
        skinny_pair<DM, DM, DM>(c, X1B + (size_t)MP * DM, W + (size_t)(t * 256 + j0) * DM, W + (size_t)(t * 256 + 128 + j0) * DM, o, s);
        f32x4 v;
#pragma unroll
        for (int j = 0; j < 4; ++j) v[j] = o[0][j] * sigmoidf_(o[0][j]) * o[1][j];
        *(u32x2*)(ACT + (size_t)(MP + w * 16 + r) * DFF + t * 128 + j0 + q * 4) = pk4(v); }
}
#undef SKINNY_LOOP

constexpr int LDS_BAR_OFF = 147456;
constexpr int LDS_BYTES = LDS_BAR_OFF + 64;
struct Args { const float* in[37]; float* out; unsigned char* ws; };

typedef pg8::Gemm<DM, DM, DM, 2, 8, NL, 1, false, 0, 0, (long)DM * DM, 0> GemmMem;
typedef pg8::Gemm<DM, DM, DM, MP / 256, NINP / 256> GemmIn;
typedef pg8::Gemm<NINP, 1024, 256, PS / 256, 1, 8, 4, false, (long)PS * NINP, 256, 256 * 1024, 256> GemmScore;
typedef pg8::Gemm<256, 256, 256, PS / 256, 1, 8, 4, false, (long)4 * 4096 * 256, (long)4096 * 256, 4 * 65536, 65536> GemmPV;
typedef pg8::Gemm<BW, BW, BW, MP / 256, DM / 256, 4, 1, true, (long)MPAD * BW, 0, (long)DM * BW, 0> GemmBranch;
typedef pg8::Gemm<DM, DM, DM, MP / 256, DM / 256> GemmOut;
typedef pg8::Gemm<DM, DM, DM, MP / 256, 2 * DFF / 256> GemmGU;
typedef pg8::Gemm<DFF, DFF, DFF, MP / 256, DM / 256> GemmDown;
template <class GT> __device__ __forceinline__ GT mk_gemm(const Ctx& c, const bf16_t* A, const bf16_t* B) { GT g; g.A = A; g.B = B; g.G = c.G; g.c = c.bid; return g; }

template <int OFF> __device__ __forceinline__ unsigned long long karg_u64(unsigned long long kargs) {
    unsigned long long p; asm volatile("s_load_dwordx2 %0, %1, %2\n\ts_waitcnt lgkmcnt(0)" : "=s"(p) : "s"(kargs), "n"(OFF) : "memory"); return p;
}
#define GPTR(T, x) ((T*)(__attribute__((address_space(1))) T*)(x))
#define INP(k) GPTR(const float, karg_u64<(k) * 8>(kargs))
#define OUTP() GPTR(float, karg_u64<37 * 8>(kargs))
#define WSP() GPTR(unsigned char, karg_u64<38 * 8>(kargs))

__global__ void __launch_bounds__(512, 2) mega_fwd(Args a_unused) {
    extern __shared__ __attribute__((aligned(16))) unsigned char lds_raw[];
    const unsigned long long kargs = (unsigned long long)__builtin_amdgcn_kernarg_segment_ptr();
    Ctx c0; c0.tid = threadIdx.x; c0.lane = c0.tid & 63; c0.wave = __builtin_amdgcn_readfirstlane(c0.tid >> 6); c0.bid = blockIdx.x; c0.G = gridDim.x; c0.lds = (LAS unsigned char*)lds_raw;
    if (c0.tid < 4) ((LAS unsigned*)(c0.lds + LDS_BAR_OFF))[c0.tid] = 0u;
    __syncthreads();
    const XcdBarrier bar = xcd_barrier_post((unsigned*)(WSP() + WS_CTL), (volatile LAS unsigned*)(c0.lds + LDS_BAR_OFF));

#define WPREP_LAYER(cc_, L_) do { unsigned char* ws_ = WSP(); \
      ph_wprep(cc_, INP(10) + (size_t)(L_) * DM * NIN, (bf16_t*)(ws_ + WS_WIN) + (size_t)(L_) * NINP * DM, DM, NIN, NINP, 1, 1, 0, 0); \
      ph_wprep(cc_, INP(29) + (size_t)(L_) * 4 * BW * DM, (bf16_t*)(ws_ + WS_WBR) + (size_t)(L_) * 4 * DM * BW, BW, DM, DM, 0, 4, (size_t)BW * DM, (size_t)DM * BW); \
      ph_wprep(cc_, INP(30) + (size_t)(L_) * DM * DM, (bf16_t*)(ws_ + WS_WOUT) + (size_t)(L_) * DM * DM, DM, DM, DM, 0, 1, 0, 0); \
      ph_wprep(cc_, INP(33) + (size_t)(L_) * DM * 2 * DFF, (bf16_t*)(ws_ + WS_WGU) + (size_t)(L_) * 2 * DFF * DM, DM, 2 * DFF, 2 * DFF, 2, 1, 0, 0); \
      ph_wprep(cc_, INP(34) + (size_t)(L_) * DFF * DM, (bf16_t*)(ws_ + WS_WDN) + (size_t)(L_) * DM * DFF, DFF, DM, DM, 0, 1, 0, 0); } while (0)
    { const Ctx c = fresh(c0); unsigned char* ws = WSP();
      ph_wprep(c, INP(28), (bf16_t*)(ws + WS_WMEM), DM, DM, DM, 0, NL, (size_t)DM * DM, (size_t)DM * DM);
      WPREP_LAYER(c, 0);
      ph_lrw(c, INP(19), INP(21), INP(22), (bf16_t*)(ws + WS_LRW));
      ph_xprep(c, INP(0), INP(1), INP(2), (float*)nullptr, (bf16_t*)(ws + WS_HB), (bf16_t*)(ws + WS_MEMB)); }
    xcd_barrier(bar);
    { const Ctx c = fresh(c0); unsigned char* ws = WSP(); float* out = OUTP();
      GemmMem g = mk_gemm<GemmMem>(c, (const bf16_t*)(ws + WS_MEMB), (const bf16_t*)(ws + WS_WMEM));
      pg8::EpiMem E; E.outK = out + O_MKP; E.outV = out + O_MVP; E.kb = (bf16_t*)(ws + WS_MKB); E.vt = (bf16_t*)(ws + WS_MVT); pg8::gemm_phase<GemmMem, pg8::EpiMem, true, true>(c.lds, c.tid, g, E); }

    for (int l = 0; l < NL; ++l) {
        { const Ctx c = fresh(c0); unsigned char* ws = WSP();
          GemmIn g = mk_gemm<GemmIn>(c, (const bf16_t*)(ws + WS_HB), (const bf16_t*)(ws + WS_WIN) + (size_t)l * NINP * DM);
          pg8::EpiBf16 E; E.O = (bf16_t*)(ws + WS_U); E.zs = 0; E.ldc = NINP; E.pad = 0; pg8::gemm_phase<GemmIn, pg8::EpiBf16, true, true>(c.lds, c.tid, g, E); }
        { const Ctx c = fresh(c0); unsigned char* ws = WSP(); ph_sk_in(c, c.G > 192 ? 96 : 0, c.G > 192 ? c.G - 96 : c.G, (const bf16_t*)(ws + WS_HB), (const bf16_t*)(ws + WS_WIN) + (size_t)l * NINP * DM, (bf16_t*)(ws + WS_U)); }
        xcd_barrier(bar);
        { const Ctx c = fresh(c0); unsigned char* ws = WSP(); float* out = OUTP(); const bf16_t* U = (const bf16_t*)(ws + WS_U); bf16_t* BR = (bf16_t*)(ws + WS_BR);
          (void)out; (void)BR;
          ph_gla_pre(c, U, INP(12) + (size_t)l * 16 * 512, INP(13) + (size_t)l * 512, (bf16_t*)(ws + WS_GLQD), (bf16_t*)(ws + WS_GLKH), (bf16_t*)(ws + WS_GLE), (bf16_t*)(ws + WS_GLVT), (float*)(ws + WS_GLGC)); }
        { const Ctx c = fresh(c0); unsigned char* ws = WSP();
          ph_rwkv_pre(c, (const bf16_t*)(ws + WS_U), INP(9) + (size_t)l * SB * RWC, INP(17) + (size_t)l * RWC, INP(18) + (size_t)l * BW, INP(19) + (size_t)l * 64 * BW, INP(20) + (size_t)l * BW, INP(21) + (size_t)l * 64 * BW,
                       INP(22) + (size_t)l * 128 * BW, INP(23) + (size_t)l * BW, INP(24) + (size_t)l * BW, INP(25) + (size_t)l * BW, (float*)(ws + WS_RW), (bf16_t*)(ws + WS_RB), (const bf16_t*)(ws + WS_LRW) + (size_t)l * 1024 * 256); }
        { const Ctx c = fresh(c0); unsigned char* ws = WSP();
          GemmScore g = mk_gemm<GemmScore>(c, (const bf16_t*)(ws + WS_U) + U_MQ, (const bf16_t*)(ws + WS_MKB) + (size_t)l * 512 * 1024); g.c = (c.bid + c.G / 2) % c.G;
          pg8::EpiScore E; E.SC = (float*)(ws + WS_SC); pg8::gemm_phase<GemmScore, pg8::EpiScore, true, true>(c.lds, c.tid, g, E); }
        xcd_barrier(bar);
        { const Ctx c = fresh(c0); unsigned char* ws = WSP(); float* out = OUTP();
          ph_rwkv_seq(c, 64, (const bf16_t*)(ws + WS_RB), INP(8) + (size_t)l * SB * 16 * 4096, out + O_RWP + (size_t)l * PB * 16 * 4096, out + O_RWS + (size_t)l * SB * 16 * 4096,
                      (bf16_t*)(ws + WS_RAW) + (size_t)MPAD * BW); }
        { const Ctx c = fresh(c0); unsigned char* ws = WSP(); float* out = OUTP();
          ph_gla_seq(c, 32, (const bf16_t*)(ws + WS_GLQD), (const bf16_t*)(ws + WS_GLKH), (const bf16_t*)(ws + WS_GLE), (const bf16_t*)(ws + WS_GLVT), (const float*)(ws + WS_GLGC),
                     INP(7) + (size_t)l * SB * 4 * 32768, out + O_GLAP + (size_t)l * PB * 4 * 32768, out + O_GLAS + (size_t)l * SB * 4 * 32768, (bf16_t*)(ws + WS_RAW)); }
        if ((c0.bid < 32 || c0.bid >= 96) && c0.G > 96) {
        { Ctx c = fresh(c0); c.bid = c.bid < 32 ? c.bid : c.bid - 64; c.G = c.G - 64; unsigned char* ws = WSP(); ph_softmax256(c, (const float*)(ws + WS_SC), (bf16_t*)(ws + WS_PB), 8 * 4096); }
        { Ctx c = fresh(c0); c.bid = c.bid < 32 ? c.bid : c.bid - 64; c.G = c.G - 64; unsigned char* ws = WSP(); ph_swa_prompt(c, (const bf16_t*)(ws + WS_U), INP(16) + (size_t)l * 16, (bf16_t*)(ws + WS_BR) + (size_t)MPAD * BW); }
        { Ctx c = fresh(c0); c.bid = c.bid < 32 ? c.bid : c.bid - 64; c.G = c.G - 64; unsigned char* ws = WSP();
          ph_swa_sample(c, (const bf16_t*)(ws + WS_U), INP(3) + (size_t)l * SB * 16384, INP(4) + (size_t)l * SB * 16384, INP(16) + (size_t)l * 16, (bf16_t*)(ws + WS_BR) + (size_t)MPAD * BW); }
        { Ctx c = fresh(c0); c.bid = c.bid < 32 ? c.bid : c.bid - 64; c.G = c.G - 64; unsigned char* ws = WSP();
          ph_memattn_sample(c, 64, (const bf16_t*)(ws + WS_U), INP(5) + (size_t)l * SB * MEMT * 1024, INP(6) + (size_t)l * SB * MEMT * 1024, (bf16_t*)(ws + WS_BR) + (size_t)3 * MPAD * BW); }
        { Ctx c = fresh(c0); c.bid = c.bid < 32 ? c.bid : c.bid - 64; c.G = c.G - 64; unsigned char* ws = WSP();
          ph_copy_outs(c, (const bf16_t*)(ws + WS_U), INP(3) + (size_t)l * SB * 16384, INP(4) + (size_t)l * SB * 16384, OUTP(), l); }
          if (l + 1 < NL) { Ctx c = fresh(c0); const int sd = c.bid < 32 ? c.bid : c.bid - 64; c.G = 2 * (c.G - 64) + 96;
            c.bid = 2 * sd; WPREP_LAYER(c, l + 1); c.bid = 2 * sd + 1; WPREP_LAYER(c, l + 1); }
        } else if (l + 1 < NL && c0.G > 96) { Ctx c = fresh(c0); const int nside2 = 2 * (c.G - 64); c.G = nside2 + 96;
          if (c0.bid < 64) { c.bid = nside2 + 2 * (c0.bid - 32); WPREP_LAYER(c, l + 1); c.bid = nside2 + 2 * (c0.bid - 32) + 1; WPREP_LAYER(c, l + 1); }
          else { c.bid = nside2 + 64 + (c0.bid - 64); WPREP_LAYER(c, l + 1); }
        }
        xcd_barrier(bar);
        { const Ctx c = fresh(c0); unsigned char* ws = WSP(); ph_rwkv_fin(c, (const float*)(ws + WS_RW), INP(26) + (size_t)l * BW, INP(27) + (size_t)l * BW, (const bf16_t*)(ws + WS_RAW) + (size_t)MPAD * BW, (bf16_t*)(ws + WS_BR) + (size_t)2 * MPAD * BW); }
        { const Ctx c = fresh(c0); unsigned char* ws = WSP(); ph_gla_fin(c, (const bf16_t*)(ws + WS_U), INP(14) + (size_t)l * BW, INP(15) + (size_t)l * BW, (const bf16_t*)(ws + WS_RAW), (bf16_t*)(ws + WS_BR)); }
        { const Ctx c = fresh(c0); unsigned char* ws = WSP();
          GemmPV g = mk_gemm<GemmPV>(c, (const bf16_t*)(ws + WS_PB), (const bf16_t*)(ws + WS_MVT) + (size_t)l * 8 * 65536);
          pg8::EpiPV E; E.O = (bf16_t*)(ws + WS_BR) + (size_t)3 * MPAD * BW; pg8::gemm_phase<GemmPV, pg8::EpiPV, true, true>(c.lds, c.tid, g, E); }
        xcd_barrier(bar);
        { const Ctx c = fresh(c0); unsigned char* ws = WSP();
          GemmBranch g = mk_gemm<GemmBranch>(c, (const bf16_t*)(ws + WS_BR), (const bf16_t*)(ws + WS_WBR) + (size_t)l * 4 * DM * BW);
          pg8::EpiMerge E; E.MG = (float*)(ws + WS_MG); E.MGB = (bf16_t*)(ws + WS_MGB); E.U = (const bf16_t*)(ws + WS_U); E.gate_b = INP(11) + (size_t)l * 4 * DM; pg8::gemm_phase<GemmBranch, pg8::EpiMerge, true, true>(c.lds, c.tid, g, E); }
        { const Ctx c = fresh(c0); unsigned char* ws = WSP(); ph_sk_merge(c, 0, c.G, (const bf16_t*)(ws + WS_BR), (const bf16_t*)(ws + WS_WBR) + (size_t)l * 4 * DM * BW, (const bf16_t*)(ws + WS_U), INP(11) + (size_t)l * 4 * DM, (bf16_t*)(ws + WS_MGB)); }
        xcd_barrier(bar);
        { const Ctx c = fresh(c0); unsigned char* ws = WSP();
          GemmOut g = mk_gemm<GemmOut>(c, (const bf16_t*)(ws + WS_MGB), (const bf16_t*)(ws + WS_WOUT) + (size_t)l * DM * DM);
          pg8::EpiRes E; E.R = (const bf16_t*)(ws + WS_HB); E.Y = (bf16_t*)(ws + WS_Y); pg8::gemm_phase<GemmOut, pg8::EpiRes, true, true>(c.lds, c.tid, g, E); }
        { const Ctx c = fresh(c0); unsigned char* ws = WSP(); ph_sk_res<DM>(c, c.G > 192 ? 128 : 0, c.G > 192 ? c.G - 128 : c.G, (const bf16_t*)(ws + WS_MGB), (const bf16_t*)(ws + WS_WOUT) + (size_t)l * DM * DM, (const bf16_t*)(ws + WS_HB), (bf16_t*)(ws + WS_Y)); }
        xcd_barrier(bar);
        { const Ctx c = fresh(c0); unsigned char* ws = WSP(); ph_ln(c, (const bf16_t*)(ws + WS_Y), INP(31) + (size_t)l * DM, INP(32) + (size_t)l * DM, (float*)nullptr, (bf16_t*)(ws + WS_X1B), nullptr, MT, 0); }
        xcd_barrier(bar);
        { const Ctx c = fresh(c0); unsigned char* ws = WSP();
          GemmGU g = mk_gemm<GemmGU>(c, (const bf16_t*)(ws + WS_X1B), (const bf16_t*)(ws + WS_WGU) + (size_t)l * 2 * DFF * DM);
          pg8::EpiSwiGLU E; E.O = (bf16_t*)(ws + WS_ACT); pg8::gemm_phase<GemmGU, pg8::EpiSwiGLU, true, true>(c.lds, c.tid, g, E); }
        { const Ctx c = fresh(c0); unsigned char* ws = WSP(); ph_sk_gu(c, c.G > 192 ? 128 : 0, c.G > 192 ? c.G - 128 : c.G, (const bf16_t*)(ws + WS_X1B), (const bf16_t*)(ws + WS_WGU) + (size_t)l * 2 * DFF * DM, (bf16_t*)(ws + WS_ACT)); }
        xcd_barrier(bar);
        { const Ctx c = fresh(c0); unsigned char* ws = WSP();
          GemmDown g = mk_gemm<GemmDown>(c, (const bf16_t*)(ws + WS_ACT), (const bf16_t*)(ws + WS_WDN) + (size_t)l * DM * DFF);
          pg8::EpiRes E; E.R = (const bf16_t*)(ws + WS_X1B); E.Y = (bf16_t*)(ws + WS_Y); pg8::gemm_phase<GemmDown, pg8::EpiRes, true, true>(c.lds, c.tid, g, E); }
        { const Ctx c = fresh(c0); unsigned char* ws = WSP(); ph_sk_res<DFF>(c, 0, c.G, (const bf16_t*)(ws + WS_ACT), (const bf16_t*)(ws + WS_WDN) + (size_t)l * DM * DFF, (const bf16_t*)(ws + WS_X1B), (bf16_t*)(ws + WS_Y)); }
        xcd_barrier(bar);
        { const Ctx c = fresh(c0); unsigned char* ws = WSP(); float* out = OUTP(); ph_ln(c, (const bf16_t*)(ws + WS_Y), INP(35) + (size_t)l * DM, INP(36) + (size_t)l * DM, (float*)nullptr, (bf16_t*)(ws + WS_HB), l == NL - 1 ? out : nullptr, MT, MT); }
        xcd_barrier(bar);
    }
}

extern "C" void kernel_launch(void* const* d_in, const int* in_sizes, int n_in, void* d_out, int out_size, void* d_ws, size_t ws_size, hipStream_t stream) {
    static int grid = 0;
    if (grid == 0) {
        if (n_in != 37 || (size_t)out_size != O_END || ws_size < WS_END) { fprintf(stderr, "kernel_launch: unexpected sizes (n_in %d out %d ws %zu need %zu)\n", n_in, out_size, ws_size, (size_t)WS_END); grid = -1; return; }
        int dev = 0, cus = 0;
        if (hipGetDevice(&dev) != hipSuccess || hipDeviceGetAttribute(&cus, hipDeviceAttributeMultiprocessorCount, dev) != hipSuccess) { grid = -1; return; }
        if (hipFuncSetAttribute((const void*)mega_fwd, hipFuncAttributeMaxDynamicSharedMemorySize, LDS_BYTES) != hipSuccess) { fprintf(stderr, "kernel_launch: hipFuncSetAttribute failed\n"); grid = -1; return; }
        int per_cu = 0;
        if (hipOccupancyMaxActiveBlocksPerMultiprocessor(&per_cu, (const void*)mega_fwd, 512, LDS_BYTES) != hipSuccess || per_cu < 1) { fprintf(stderr, "kernel_launch: occupancy query says %d\n", per_cu); }
        (void)hipGetLastError();
        grid = cus;
    }
    if (grid < 0) return;
    (void)hipMemsetAsync((unsigned char*)d_ws + WS_CTL, 0, XCD_BAR_WORDS * sizeof(unsigned), stream);
    Args a; memset(&a, 0, sizeof a);
    for (int i = 0; i < 37; ++i) a.in[i] = (const float*)d_in[i];
    a.out = (float*)d_out; a.ws = (unsigned char*)d_ws;
    hipLaunchKernelGGL(mega_fwd, dim3(grid), dim3(512), LDS_BYTES, stream, a);
}
```

```cpp
#include <hip/hip_runtime.h>
#include <cstdio>
#include <cstdint>
#include <cstring>

#define LAS __attribute__((address_space(3)))
typedef unsigned short bf16_t;
typedef short bf16x8 __attribute__((ext_vector_type(8)));
typedef float f32x4 __attribute__((ext_vector_type(4)));
typedef float f32x2 __attribute__((ext_vector_type(2)));
typedef unsigned u32x4 __attribute__((ext_vector_type(4)));
typedef unsigned u32x2 __attribute__((ext_vector_type(2)));

constexpr int DM = 2048, NL = 4;
constexpr int PB = 2, PS = 4096, MP = PB * PS;
constexpr int SB = 32, SS = 4, MS = SB * SS;
constexpr int MT = MP + MS;
constexpr int MPAD = 8448;
constexpr int NIN = 16912, NINP = 17152;
constexpr int U_GQ = 0, U_GK = 512, U_GV = 1024, U_GR = 2048, U_GA = 3072, U_SQ = 3328, U_SK = 4352, U_SV = 4480, U_RU = 4608, U_MQ = 7936, U_GP = 8960;
constexpr int RWC = 3328, BW = 1024, DFF = 5632, MEMT = 256;
constexpr float ALPHA = 1.681792830507429f;

constexpr size_t O_YP = 0;
constexpr size_t O_YS = O_YP + (size_t)MP * DM;
constexpr size_t O_SWKP = O_YS + (size_t)MS * DM;
constexpr size_t O_SWVP = O_SWKP + (size_t)NL * PB * 128 * 128;
constexpr size_t O_MKP = O_SWVP + (size_t)NL * PB * 128 * 128;
constexpr size_t O_MVP = O_MKP + (size_t)NL * PB * 256 * 1024;
constexpr size_t O_GLAP = O_MVP + (size_t)NL * PB * 256 * 1024;
constexpr size_t O_RWP = O_GLAP + (size_t)NL * PB * 4 * 128 * 256;
constexpr size_t O_RSP = O_RWP + (size_t)NL * PB * 16 * 64 * 64;
constexpr size_t O_SWKS = O_RSP + (size_t)NL * PB * RWC;
constexpr size_t O_SWVS = O_SWKS + (size_t)NL * SB * 128 * 128;
constexpr size_t O_GLAS = O_SWVS + (size_t)NL * SB * 128 * 128;
constexpr size_t O_RWS = O_GLAS + (size_t)NL * SB * 4 * 128 * 256;
constexpr size_t O_RSS = O_RWS + (size_t)NL * SB * 16 * 64 * 64;
constexpr size_t O_END = O_RSS + (size_t)NL * SB * RWC;
static_assert(O_END == 52881408, "output size");

constexpr size_t al256(size_t x) { return (x + 255) & ~(size_t)255; }
constexpr size_t WS_CTL = 0;
constexpr size_t WS_WIN = 65536;
constexpr size_t WS_WMEM = WS_WIN + (size_t)NL * NINP * DM * 2;
constexpr size_t WS_WBR = WS_WMEM + (size_t)NL * DM * DM * 2;
constexpr size_t WS_WOUT = WS_WBR + (size_t)NL * 4 * DM * BW * 2;
constexpr size_t WS_WGU = WS_WOUT + (size_t)NL * DM * DM * 2;
constexpr size_t WS_WDN = WS_WGU + (size_t)NL * 2 * DFF * DM * 2;
constexpr size_t WS_HF = WS_WDN + (size_t)NL * DM * DFF * 2;
constexpr size_t WS_HB = WS_HF + (size_t)MPAD * DM * 4;
constexpr size_t WS_U = WS_HB + (size_t)MPAD * DM * 2;
constexpr size_t WS_BR = WS_U + (size_t)MPAD * NINP * 2;
constexpr size_t WS_MG = WS_BR + (size_t)4 * MPAD * BW * 2;
constexpr size_t WS_MGB = WS_MG + (size_t)MPAD * DM * 4;
constexpr size_t WS_Y = WS_MGB + (size_t)MPAD * DM * 2;
constexpr size_t WS_X1F = WS_Y + (size_t)MPAD * DM * 4;
constexpr size_t WS_X1B = WS_X1F + (size_t)MPAD * DM * 4;
constexpr size_t WS_ACT = WS_X1B + (size_t)MPAD * DM * 2;
constexpr size_t WS_MEMB = WS_ACT + (size_t)MPAD * DFF * 2;
constexpr size_t WS_MKB = WS_MEMB + (size_t)512 * DM * 2;
constexpr size_t WS_MVT = WS_MKB + (size_t)NL * 512 * 1024 * 2;
constexpr size_t WS_SC = WS_MVT + (size_t)NL * 8 * 256 * 256 * 2;
constexpr size_t WS_PB = WS_SC + (size_t)8 * 4096 * 256 * 4;
constexpr size_t WS_RW = WS_PB + (size_t)8 * 4096 * 256 * 2;
constexpr size_t RW_ARR = (size_t)MPAD * BW * 4;
constexpr int GL_NCH = 512 + 128;
constexpr size_t WS_GLQD = WS_RW + 8 * RW_ARR;
constexpr size_t WS_GLKH = WS_GLQD + (size_t)GL_NCH * 8192 * 2;
constexpr size_t WS_GLE = WS_GLKH + (size_t)GL_NCH * 8192 * 2;
constexpr size_t WS_GLVT = WS_GLE + (size_t)GL_NCH * 4096 * 2;
constexpr size_t WS_GLGC = WS_GLVT + (size_t)GL_NCH * 16384 * 2;
constexpr int RB_NCH = PB * 16 * 256 + SB * 16;
constexpr int RB_EL = 9216;
constexpr int RB_QP = 4608, RB_KHP = 5760, RB_VT = 7296, RB_EP = 8832;
constexpr size_t WS_RB = WS_GLGC + (size_t)GL_NCH * 128 * 4;
constexpr size_t WS_RAW = WS_RB + (size_t)RB_NCH * RB_EL * 2;
constexpr size_t WS_LRW = WS_RAW + (size_t)2 * MPAD * BW * 2;
constexpr size_t WS_END = WS_LRW + (size_t)NL * 16 * 64 * 256 * 2;

__device__ __forceinline__ float bf2f(bf16_t b) { return __uint_as_float(((unsigned)b) << 16); }
typedef __bf16 bf16v2_t __attribute__((ext_vector_type(2)));
__device__ __forceinline__ unsigned pk2(float lo, float hi) { const f32x2 v = {lo, hi}; return __builtin_bit_cast(unsigned, __builtin_convertvector(v, bf16v2_t)); }
__device__ __forceinline__ bf16_t f2bf(float f) { return (bf16_t)(pk2(f, 0.f) & 0xffffu); }
__device__ __forceinline__ f32x4 ld4bf(const bf16_t* p) { const u32x2 w = *(const u32x2*)p; return (f32x4){__uint_as_float(w.x << 16), __uint_as_float(w.x & 0xffff0000u), __uint_as_float(w.y << 16), __uint_as_float(w.y & 0xffff0000u)}; }
__device__ __forceinline__ float wave_sum(float v) {
#pragma unroll
    for (int o = 32; o > 0; o >>= 1) v += __shfl_xor(v, o, 64);
    return v;
}
__device__ __forceinline__ float wave_max(float v) {
#pragma unroll
    for (int o = 32; o > 0; o >>= 1) v = fmaxf(v, __shfl_xor(v, o, 64));
    return v;
}
__device__ __forceinline__ float sigmoidf_(float x) { return 1.0f / (1.0f + __expf(-x)); }
__device__ __forceinline__ float softplusf_(float x) { return fmaxf(x, 0.f) + log1pf(__expf(-fabsf(x))); }
__device__ __forceinline__ float softplus_fast(float x) { return fmaxf(x, 0.f) + __logf(1.0f + __expf(-fabsf(x))); }
__device__ __forceinline__ float tanh_fast(float x) { return 1.0f - 2.0f / (1.0f + __expf(2.0f * x)); }

namespace pg8 {
constexpr int BM = 256, BK = 64, HALF = 128, HTB = HALF * BK * 2, STAGE_BYTES = 8 * HTB, NXCD = 8, WGM = 8;
__host__ __device__ __forceinline__ int lds_byte(int r, int c) { const int st = (r >> 4) * 2 + (c >> 5), rr = r & 15, cc = c & 31, ob = rr * 64 + cc * 2; return st * 1024 + (ob ^ (((ob >> 9) & 1) << 5)); }
__host__ __device__ __forceinline__ void stage_rc(int b, int& R, int& C) { const int st = b / 1024, sb = b % 1024, swz = sb ^ (((sb >> 9) & 1) << 5); R = (st >> 1) * 16 + swz / 64; C = (st & 1) * 32 + (swz % 64) / 2; }
__host__ __device__ __forceinline__ int perm32(int rho) { const int n = rho >> 4, i = rho & 15; return 8 * (i >> 2) + 4 * n + (i & 3); }

struct Unit { int pm, pn, z; };
template <int LDA_, int LDB_, int K_, int NM_, int NN_, int NZ_ = 1, int NZH_ = 1, bool ZINNER_ = false, long ZSAB_ = 0, long ZSAH_ = 0, long ZSBB_ = 0, long ZSBH_ = 0>
struct Gemm {
    static constexpr int LDA = LDA_, LDB = LDB_, K = K_, NM = NM_, NN = NN_, NZ = NZ_, NZH = NZH_; static constexpr bool ZINNER = ZINNER_;
    const bf16_t* A; const bf16_t* B; int G, c;
    __device__ __forceinline__ bool next(int i, Unit& u) const {
        constexpr int nt = NM * NN; int L, z;
        if (ZINNER) { const int it = i / NZ; z = i - it * NZ; const long LL = (long)it * G + c; if (LL >= nt) return false; L = (int)LL; }
        else { const long LL = (long)i * G + c; if (LL >= (long)nt * NZ) return false; z = (int)(LL / nt); L = (int)(LL - (long)z * nt); }
        int wgid = L; { constexpr int q = nt / NXCD, r = nt % NXCD; const int xcd = wgid % NXCD, off = wgid / NXCD; wgid = (xcd < r ? xcd * (q + 1) : r * (q + 1) + (xcd - r) * q) + off; }
        constexpr int nig = WGM * NN; const int gid = wgid / nig, fm = gid * WGM, gsz = (NM - fm) < WGM ? (NM - fm) : WGM;
        u.pm = fm + ((wgid % nig) % gsz); u.pn = (wgid % nig) / gsz; u.z = z; return true;
    }
    __device__ __forceinline__ const char* a_base(const Unit& u) const { const int zb = u.z / NZH, zh = u.z - zb * NZH; return (const char*)(A + zb * ZSAB_ + zh * ZSAH_ + (long)u.pm * BM * LDA); }
    __device__ __forceinline__ const char* b_base(const Unit& u) const { const int zb = u.z / NZH, zh = u.z - zb * NZH; return (const char*)(B + zb * ZSBB_ + zh * ZSBH_ + (long)u.pn * BM * LDB); }
};

template <class GT, class Epi, bool ALIGN_EPI = true, bool SP2 = true>
__device__ __forceinline__ void gemm_phase(LAS unsigned char* lds, const int tid, const GT& g, const Epi& E) {
    const int wid = __builtin_amdgcn_readfirstlane(tid >> 6), lane = tid & 63, wr = wid >> 2, wc = wid & 3, fr = lane & 15, fq = lane >> 4;
    constexpr int nt = GT::K / BK;
    unsigned voffA[2], voffB[2];
#pragma unroll
    for (int i = 0; i < 2; ++i) { int R, C; stage_rc(tid * 16 + i * 8192, R, C); const int Rb = Epi::PERM ? ((R & ~31) + perm32(R & 31)) : R;
        voffA[i] = (unsigned)(R * GT::LDA + C) * 2u; voffB[i] = (unsigned)(Rb * GT::LDB + C) * 2u; }
    constexpr size_t kstep = (size_t)(BK * 2);
    constexpr size_t hstepA = (size_t)HALF * GT::LDA * 2, hstepB = (size_t)HALF * GT::LDB * 2;
    const unsigned ldsw = (unsigned)wid * 1024u;
    const int aoff = lds_byte(wr * 64 + fr, fq * 8), boff = lds_byte(wc * 32 + fr, fq * 8);
#define PG8_SA(b, h) (((b) * 2 + (h)) * HTB)
#define PG8_SB(b, h) ((4 + (b) * 2 + (h)) * HTB)
#define PG8_STAGE(bufoff, gbase, voff) do { _Pragma("unroll") for (int _i = 0; _i < 2; ++_i) \
        __builtin_amdgcn_global_load_lds((const unsigned*)((const char*)(gbase) + (voff)[_i]), (LAS unsigned*)(lds + (bufoff) + ldsw + _i * 8192), 16, 0, 0); } while (0)
#define PG8_LDA(dst, b, h) do { _Pragma("unroll") for (int m = 0; m < 4; ++m) _Pragma("unroll") for (int k = 0; k < 2; ++k) dst[m][k] = *(const LAS bf16x8*)(lds + PG8_SA(b, h) + aoff + m * 2048 + k * 1024); } while (0)
#define PG8_LDB(dst, b, h) do { _Pragma("unroll") for (int n = 0; n < 2; ++n) _Pragma("unroll") for (int k = 0; k < 2; ++k) dst[n][k] = *(const LAS bf16x8*)(lds + PG8_SB(b, h) + boff + n * 2048 + k * 1024); } while (0)
#define PG8_MMA(ai, bj, At, Bt) do { __builtin_amdgcn_s_setprio(1); _Pragma("unroll") for (int m = 0; m < 4; ++m) _Pragma("unroll") for (int n = 0; n < 2; ++n) _Pragma("unroll") for (int k = 0; k < 2; ++k) \
        acc[ai][bj][m][n] = __builtin_amdgcn_mfma_f32_16x16x32_bf16(Bt[n][k], At[m][k], acc[ai][bj][m][n], 0, 0, 0); __builtin_amdgcn_s_setprio(0); } while (0)
#define PG8_WAIT_V(n) asm volatile("s_waitcnt vmcnt(" #n ")" ::: "memory")
#define PG8_WAIT_L(n) asm volatile("s_waitcnt lgkmcnt(" #n ")" ::: "memory")
#define PG8_BAR __builtin_amdgcn_s_barrier()
#define PG8_SCHED __builtin_amdgcn_sched_barrier(0)
    Unit cur, nxt; int ui = 0;
    if (!g.next(0, cur)) return;
    f32x4 acc[2][2][4][2];
#pragma unroll
    for (int a = 0; a < 2; ++a)
#pragma unroll
        for (int b = 0; b < 2; ++b)
#pragma unroll
            for (int m = 0; m < 4; ++m)
#pragma unroll
                for (int n = 0; n < 2; ++n) acc[a][b][m][n] = (f32x4){0.f, 0.f, 0.f, 0.f};
    bf16x8 At[4][2], B0[2][2], B1[2][2];
    const char* cA = g.a_base(cur); const char* cB = g.b_base(cur);
    if constexpr (SP2) {
        PG8_STAGE(PG8_SB(0, 0), cB, voffB); PG8_STAGE(PG8_SB(0, 1), cB + hstepB, voffB); PG8_STAGE(PG8_SA(0, 0), cA, voffA); PG8_STAGE(PG8_SA(0, 1), cA + hstepA, voffA);
        if (wr == 1) PG8_BAR;
        PG8_WAIT_V(2); PG8_BAR;
        PG8_STAGE(PG8_SB(1, 0), cB + kstep, voffB); PG8_STAGE(PG8_SA(1, 0), cA + kstep, voffA); PG8_STAGE(PG8_SB(1, 1), cB + hstepB + kstep, voffB);
        PG8_WAIT_V(6); PG8_BAR;
    } else {
        PG8_STAGE(PG8_SB(0, 0), cB, voffB); PG8_STAGE(PG8_SA(0, 0), cA, voffA); PG8_STAGE(PG8_SB(0, 1), cB + hstepB, voffB); PG8_STAGE(PG8_SA(0, 1), cA + hstepA, voffA);
        if (wr == 1) PG8_BAR;
        PG8_WAIT_V(4); PG8_BAR;
        PG8_STAGE(PG8_SB(1, 0), cB + kstep, voffB); PG8_STAGE(PG8_SA(1, 0), cA + kstep, voffA); PG8_STAGE(PG8_SB(1, 1), cB + hstepB + kstep, voffB);
        PG8_WAIT_V(6); PG8_BAR;
    }
    for (;;) {
        const bool has_next = g.next(ui + 1, nxt);
        const char* nA = has_next ? g.a_base(nxt) : cA; const char* nB = has_next ? g.b_base(nxt) : cB;
#pragma unroll 1
        for (int t = 0; t < nt; t += 2) {
            const bool last = (t == nt - 2);
            const char* a1 = cA + (size_t)(t + 1) * kstep;
            const char* a2 = last ? nA : cA + (size_t)(t + 2) * kstep; const char* b2 = last ? nB : cB + (size_t)(t + 2) * kstep;
            const char* a3 = a2 + kstep; const char* b3 = b2 + kstep;
            if constexpr (SP2) {
            PG8_LDB(B0, 0, 0); PG8_LDB(B1, 0, 1); PG8_SCHED; PG8_LDA(At, 0, 0); PG8_STAGE(PG8_SA(1, 1), a1 + hstepA, voffA);
            PG8_WAIT_V(8); PG8_WAIT_L(0); PG8_BAR; PG8_MMA(0, 0, At, B0); PG8_MMA(0, 1, At, B1); PG8_BAR; PG8_SCHED;
            PG8_LDA(At, 0, 1); PG8_STAGE(PG8_SB(0, 0), b2, voffB); PG8_STAGE(PG8_SB(0, 1), b2 + hstepB, voffB); PG8_STAGE(PG8_SA(0, 0), a2, voffA);
            PG8_WAIT_V(8); PG8_WAIT_L(0); PG8_BAR; PG8_MMA(1, 0, At, B0); PG8_MMA(1, 1, At, B1); PG8_BAR; PG8_SCHED;
            PG8_LDB(B0, 1, 0); PG8_LDB(B1, 1, 1); PG8_SCHED; PG8_LDA(At, 1, 0); PG8_STAGE(PG8_SA(0, 1), a2 + hstepA, voffA);
            PG8_WAIT_V(8); PG8_WAIT_L(0); PG8_BAR; PG8_MMA(0, 0, At, B0); PG8_MMA(0, 1, At, B1); PG8_BAR; PG8_SCHED;
            PG8_LDA(At, 1, 1); PG8_STAGE(PG8_SB(1, 0), b3, voffB); PG8_STAGE(PG8_SB(1, 1), b3 + hstepB, voffB); PG8_STAGE(PG8_SA(1, 0), a3, voffA);
            PG8_WAIT_V(8); PG8_WAIT_L(0); PG8_BAR; PG8_MMA(1, 0, At, B0); PG8_MMA(1, 1, At, B1); PG8_BAR; PG8_SCHED;
            } else {
            PG8_LDB(B0, 0, 0); PG8_SCHED; PG8_LDA(At, 0, 0); PG8_STAGE(PG8_SA(1, 1), a1 + hstepA, voffA);
            PG8_WAIT_L(8); PG8_BAR; PG8_WAIT_L(0); PG8_MMA(0, 0, At, B0); PG8_BAR; PG8_SCHED;
            PG8_LDB(B1, 0, 1); PG8_STAGE(PG8_SB(0, 0), b2, voffB);
            PG8_BAR; PG8_WAIT_L(0); PG8_MMA(0, 1, At, B1); PG8_BAR;
            PG8_LDA(At, 0, 1); PG8_STAGE(PG8_SA(0, 0), a2, voffA);
            PG8_BAR; PG8_WAIT_L(0); PG8_MMA(1, 0, At, B0); PG8_BAR; PG8_SCHED;
            PG8_STAGE(PG8_SB(0, 1), b2 + hstepB, voffB);
            PG8_WAIT_V(6); PG8_BAR; PG8_MMA(1, 1, At, B1); PG8_BAR;
            PG8_LDB(B0, 1, 0); PG8_SCHED; PG8_LDA(At, 1, 0); PG8_STAGE(PG8_SA(0, 1), a2 + hstepA, voffA);
            PG8_WAIT_L(8); PG8_BAR; PG8_WAIT_L(0); PG8_MMA(0, 0, At, B0); PG8_BAR; PG8_SCHED;
            PG8_LDB(B1, 1, 1); PG8_STAGE(PG8_SB(1, 0), b3, voffB);
            PG8_BAR; PG8_WAIT_L(0); PG8_MMA(0, 1, At, B1); PG8_BAR;
            PG8_LDA(At, 1, 1); PG8_STAGE(PG8_SA(1, 0), a3, voffA);
            PG8_BAR; PG8_WAIT_L(0); PG8_MMA(1, 0, At, B0); PG8_BAR; PG8_SCHED;
            PG8_STAGE(PG8_SB(1, 1), b3 + hstepB, voffB);
            PG8_WAIT_V(6); PG8_BAR; PG8_MMA(1, 1, At, B1); PG8_BAR;
            }
        }
        if constexpr (ALIGN_EPI) { if (wr == 0) PG8_BAR; }
        E(acc, cur, wr, wc, fr, fq);
        if (!has_next) break;
#pragma unroll
        for (int a = 0; a < 2; ++a)
#pragma unroll
            for (int b = 0; b < 2; ++b)
#pragma unroll
                for (int m = 0; m < 4; ++m)
#pragma unroll
                    for (int n = 0; n < 2; ++n) acc[a][b][m][n] = (f32x4){0.f, 0.f, 0.f, 0.f};
        cur = nxt; cA = nA; cB = nB; ++ui;
        if constexpr (ALIGN_EPI) { if (wr == 1) PG8_BAR; }
    }
    PG8_WAIT_V(0);
    if constexpr (!ALIGN_EPI) { if (wr == 0) PG8_BAR; }
    PG8_BAR;
#undef PG8_SA
#undef PG8_SB
#undef PG8_STAGE
#undef PG8_LDA
#undef PG8_LDB
#undef PG8_MMA
#undef PG8_WAIT_V
#undef PG8_WAIT_L
#undef PG8_BAR
#undef PG8_SCHED
}

struct EpiBf16 {
    static constexpr bool PERM = true;
    bf16_t* O; long zs; int ldc, pad;
    __device__ __forceinline__ void operator()(const f32x4 (&acc)[2][2][4][2], const Unit& u, int wr, int wc, int fr, int fq) const {
        const int row0 = u.pm * BM + wr * 64 + fr, col0 = u.pn * BM + wc * 32 + 8 * fq; bf16_t* base = O + (long)u.z * zs;
#pragma unroll
        for (int ai = 0; ai < 2; ++ai)
#pragma unroll
            for (int m = 0; m < 4; ++m) { bf16_t* rowp = base + (size_t)(row0 + ai * HALF + m * 16) * ldc + col0;
#pragma unroll
                for (int bj = 0; bj < 2; ++bj) { const f32x4 v0 = acc[ai][bj][m][0], v1 = acc[ai][bj][m][1];
                    u32x4 w; w.x = pk2(v0[0], v0[1]); w.y = pk2(v0[2], v0[3]); w.z = pk2(v1[0], v1[1]); w.w = pk2(v1[2], v1[3]);
                    *(u32x4*)(rowp + bj * HALF) = w; } }
    }
};
struct EpiMem {
    static constexpr bool PERM = false;
    float* outK; float* outV; bf16_t* kb; bf16_t* vt;
    __device__ __forceinline__ void operator()(const f32x4 (&acc)[2][2][4][2], const Unit& u, int wr, int wc, int fr, int fq) const {
        const int row0 = u.pm * BM + wr * 64 + fr, col0 = u.pn * BM + wc * 32 + 4 * fq;
#pragma unroll
        for (int ai = 0; ai < 2; ++ai)
#pragma unroll
            for (int m = 0; m < 4; ++m) { const int row = row0 + ai * HALF + m * 16;
#pragma unroll
                for (int bj = 0; bj < 2; ++bj)
#pragma unroll
                    for (int n = 0; n < 2; ++n) { const int col = col0 + bj * HALF + n * 16; const f32x4 v = acc[ai][bj][m][n];
                        if (col < 1024) { *(f32x4*)(outK + ((size_t)u.z * 512 + row) * 1024 + col) = v;
                            u32x2 w; w.x = pk2(v[0], v[1]); w.y = pk2(v[2], v[3]); *(u32x2*)(kb + ((size_t)u.z * 512 + row) * 1024 + col) = w; }
                        else { const int c = col - 1024; *(f32x4*)(outV + ((size_t)u.z * 512 + row) * 1024 + c) = v;
                            const int b = row >> 8, mm = row & 255, h = c >> 8, d = c & 255; bf16_t* p = vt + ((((size_t)u.z * 2 + b) * 4 + h) * 256 + d) * 256 + mm;
                            p[0] = f2bf(v[0]); p[256] = f2bf(v[1]); p[512] = f2bf(v[2]); p[768] = f2bf(v[3]); } } }
    }
};
struct EpiMerge {
    static constexpr bool PERM = false;
    float* MG; bf16_t* MGB; const bf16_t* U; const float* gate_b;
    __device__ __forceinline__ void operator()(const f32x4 (&acc)[2][2][4][2], const Unit& u, int wr, int wc, int fr, int fq) const {
        const int row0 = u.pm * BM + wr * 64 + fr, col0 = u.pn * BM + wc * 32 + 4 * fq;
#pragma unroll
        for (int ai = 0; ai < 2; ++ai)
#pragma unroll
            for (int m = 0; m < 4; ++m) { const int row = row0 + ai * HALF + m * 16;
#pragma unroll
                for (int bj = 0; bj < 2; ++bj)
#pragma unroll
                    for (int n = 0; n < 2; ++n) { const int col = col0 + bj * HALF + n * 16; const f32x4 v = acc[ai][bj][m][n];
                        const u32x2 gp = *(const u32x2*)(U + (size_t)row * NINP + U_GP + u.z * DM + col); const f32x4 gb = *(const f32x4*)(gate_b + u.z * DM + col);
                        f32x4 gt; gt[0] = sigmoidf_(__uint_as_float(gp.x << 16) + gb[0]); gt[1] = sigmoidf_(__uint_as_float(gp.x & 0xffff0000u) + gb[1]);
                        gt[2] = sigmoidf_(__uint_as_float(gp.y << 16) + gb[2]); gt[3] = sigmoidf_(__uint_as_float(gp.y & 0xffff0000u) + gb[3]);
                        float* mp = MG + (size_t)row * DM + col; f32x4 r = gt * v;
                        if (u.z > 0) r += *(const f32x4*)mp;
                        if (u.z < 3) *(f32x4*)mp = r;
                        else { u32x2 w; w.x = pk2(r[0], r[1]); w.y = pk2(r[2], r[3]); *(u32x2*)(MGB + (size_t)row * DM + col) = w; } } }
    }
};
struct EpiRes {
    static constexpr bool PERM = false;
    const bf16_t* R; bf16_t* Y;
    __device__ __forceinline__ void operator()(const f32x4 (&acc)[2][2][4][2], const Unit& u, int wr, int wc, int fr, int fq) const {
        const int row0 = u.pm * BM + wr * 64 + fr, col0 = u.pn * BM + wc * 32 + 4 * fq;
#pragma unroll
        for (int ai = 0; ai < 2; ++ai)
#pragma unroll
            for (int m = 0; m < 4; ++m) { const size_t ro = (size_t)(row0 + ai * HALF + m * 16) * DM + col0;
#pragma unroll
                for (int bj = 0; bj < 2; ++bj)
#pragma unroll
                    for (int n = 0; n < 2; ++n) { const size_t o = ro + bj * HALF + n * 16; const u32x2 rr = *(const u32x2*)(R + o);
                        const f32x4 rv = (f32x4){__uint_as_float(rr.x << 16), __uint_as_float(rr.x & 0xffff0000u), __uint_as_float(rr.y << 16), __uint_as_float(rr.y & 0xffff0000u)};
                        const f32x4 yv = rv * ALPHA + acc[ai][bj][m][n]; u32x2 yw; yw.x = pk2(yv[0], yv[1]); yw.y = pk2(yv[2], yv[3]); *(u32x2*)(Y + o) = yw; } }
    }
};
struct EpiSwiGLU {
    static constexpr bool PERM = true;
    bf16_t* O;
    __device__ __forceinline__ void operator()(const f32x4 (&acc)[2][2][4][2], const Unit& u, int wr, int wc, int fr, int fq) const {
        const int row0 = u.pm * BM + wr * 64 + fr, col0 = u.pn * HALF + wc * 32 + 8 * fq;
#pragma unroll
        for (int ai = 0; ai < 2; ++ai)
#pragma unroll
            for (int m = 0; m < 4; ++m) { bf16_t* rowp = O + (size_t)(row0 + ai * HALF + m * 16) * DFF + col0;
                float r[8];
#pragma unroll
                for (int n = 0; n < 2; ++n)
#pragma unroll
                    for (int j = 0; j < 4; ++j) { const float gg = acc[ai][0][m][n][j], uu = acc[ai][1][m][n][j]; r[n * 4 + j] = gg * sigmoidf_(gg) * uu; }
                u32x4 w; w.x = pk2(r[0], r[1]); w.y = pk2(r[2], r[3]); w.z = pk2(r[4], r[5]); w.w = pk2(r[6], r[7]);
                *(u32x4*)rowp = w; }
    }
};
struct EpiScore {
    static constexpr bool PERM = false;
    float* SC;
    __device__ __forceinline__ void operator()(const f32x4 (&acc)[2][2][4][2], const Unit& u, int wr, int wc, int fr, int fq) const {
        const int row0 = u.pm * BM + wr * 64 + fr, col0 = wc * 32 + 4 * fq; float* base = SC + (size_t)u.z * 4096 * 256;
#pragma unroll
        for (int ai = 0; ai < 2; ++ai)
#pragma unroll
            for (int m = 0; m < 4; ++m) { float* rowp = base + (size_t)(row0 + ai * HALF + m * 16) * 256 + col0;
#pragma unroll
                for (int bj = 0; bj < 2; ++bj)
#pragma unroll
                    for (int n = 0; n < 2; ++n) *(f32x4*)(rowp + bj * HALF + n * 16) = acc[ai][bj][m][n] * 0.0625f; }
    }
};
struct EpiPV {
    static constexpr bool PERM = true;
    bf16_t* O;
    __device__ __forceinline__ void operator()(const f32x4 (&acc)[2][2][4][2], const Unit& u, int wr, int wc, int fr, int fq) const {
        const int b = u.z >> 2, h = u.z & 3; const int row0 = b * PS + u.pm * BM + wr * 64 + fr, col0 = h * 256 + wc * 32 + 8 * fq;
#pragma unroll
        for (int ai = 0; ai < 2; ++ai)
#pragma unroll
            for (int m = 0; m < 4; ++m) { bf16_t* rowp = O + (size_t)(row0 + ai * HALF + m * 16) * BW + col0;
#pragma unroll
                for (int bj = 0; bj < 2; ++bj) { const f32x4 v0 = acc[ai][bj][m][0], v1 = acc[ai][bj][m][1];
                    u32x4 w; w.x = pk2(v0[0], v0[1]); w.y = pk2(v0[2], v0[3]); w.z = pk2(v1[0], v1[1]); w.w = pk2(v1[2], v1[3]);
                    *(u32x4*)(rowp + bj * HALF) = w; } }
    }
};
}


#define XB_TMO      128
#define XB_XCNT(j)  (256  + 64 * (j))
#define XB_XSUB(j)  (1280 + 64 * (j))
#define XB_XGEN(j)  (2304 + 64 * (j))
#define XB_TOP      3328
#define XB_TOPGEN   3392
#define XCD_BAR_WORDS 3456
#define XB_SPIN_CAP (1u << 18)
__device__ __forceinline__ unsigned xb_ld(unsigned* p)              { return __hip_atomic_load(p, __ATOMIC_RELAXED, __HIP_MEMORY_SCOPE_AGENT); }
__device__ __forceinline__ unsigned xb_add(unsigned* p, unsigned v) { return __hip_atomic_fetch_add(p, v, __ATOMIC_RELAXED, __HIP_MEMORY_SCOPE_AGENT); }
__device__ __forceinline__ unsigned xb_xcc_id() { return (unsigned)__builtin_amdgcn_s_getreg((3 << 11) | 20) & 0xFu; }
#define XB_SPIN(cond, bar) do { unsigned _sp = 0; while (cond) { __builtin_amdgcn_s_sleep(1); \
    if ((++_sp & 255u) == 0u) { if (xb_ld(&(bar)[XB_TMO])) break; if (_sp > XB_SPIN_CAP) { atomicAdd(&(bar)[XB_TMO], 1u); break; } } } } while (0)
struct XcdBarrier { unsigned* bar; unsigned x; volatile LAS unsigned* st; };
__device__ __forceinline__ XcdBarrier xcd_barrier_post(unsigned* bar, volatile LAS unsigned* st) {
    XcdBarrier b; b.bar = bar; b.x = xb_xcc_id(); b.st = st;
    if (threadIdx.x == 0) (void)xb_add(&bar[XB_XCNT(b.x)], 1u);
    return b;
}
__device__ __forceinline__ void xcd_barrier_complete(unsigned* bar, unsigned x, unsigned& nloc, unsigned& nx) {
    const unsigned G = gridDim.x * gridDim.y * gridDim.z;
    unsigned sum, cnt, mine, sp = 0u;
    for (;;) {
        sum = 0u; cnt = 0u; mine = 0u;
#pragma unroll
        for (unsigned j = 0; j < 16; ++j) { const unsigned c = xb_ld(&bar[XB_XCNT(j)]); sum += c; cnt += (c > 0u) ? 1u : 0u; mine = (j == x) ? c : mine; }
        if (sum == G) break;
        __builtin_amdgcn_s_sleep(1);
        if ((++sp & 255u) == 0u) { if (xb_ld(&bar[XB_TMO])) break; if (sp > XB_SPIN_CAP) { atomicAdd(&bar[XB_TMO], 1u); break; } }
    }
    nloc = mine > 0u ? mine : 1u; nx = cnt > 0u ? cnt : 1u;
}
__device__ __forceinline__ void xcd_barrier(const XcdBarrier& b) {
    asm volatile("s_waitcnt vmcnt(0)" ::: "memory");
    __syncthreads();
    if (threadIdx.x == 0) {
        unsigned* bar = b.bar;
        __builtin_amdgcn_s_waitcnt(0);
        unsigned nloc = b.st[0], nx = b.st[1];
        if (nloc == 0u) { xcd_barrier_complete(bar, b.x, nloc, nx); b.st[0] = nloc; b.st[1] = nx; }
        const unsigned old = xb_add(&bar[XB_XSUB(b.x)], 1u);
        const unsigned gen = old / nloc;
        if (old + 1u == (gen + 1u) * nloc) {
            __builtin_amdgcn_fence(__ATOMIC_RELEASE, "agent");
            asm volatile("s_waitcnt vmcnt(0)" ::: "memory");
            const unsigned og = xb_add(&bar[XB_TOP], 1u);
            const unsigned tg = og / nx;
            if (og + 1u == (tg + 1u) * nx) xb_add(&bar[XB_TOPGEN], 1u);
            else XB_SPIN(xb_ld(&bar[XB_TOPGEN]) == tg, bar);
            __builtin_amdgcn_fence(__ATOMIC_ACQUIRE, "agent");
            xb_add(&bar[XB_XGEN(b.x)], 1u);
            asm volatile("s_waitcnt vmcnt(0)" ::: "memory");
        } else {
            XB_SPIN(xb_ld(&bar[XB_XGEN(b.x)]) == gen, bar);
            __builtin_amdgcn_fence(__ATOMIC_ACQUIRE, "agent");
            asm volatile("s_waitcnt vmcnt(0)" ::: "memory");
        }
    }
    __syncthreads();
}

struct Ctx { int tid, lane, wave, bid, G; LAS unsigned char* lds; };
__device__ __forceinline__ Ctx fresh(const Ctx& c0) { Ctx c; c.wave = c0.wave; c.bid = c0.bid; c.G = c0.G; c.lds = c0.lds; asm volatile("" : "+s"(c.bid), "+s"(c.G), "+s"(c.wave));
    int lane = (int)__builtin_amdgcn_mbcnt_hi(~0u, __builtin_amdgcn_mbcnt_lo(~0u, 0u)); asm volatile("" : "+v"(lane)); c.lane = lane; c.tid = c.wave * 64 + lane; return c; }

__device__ __forceinline__ int colmap(int mode, int n) {
    if (mode == 1) return n < 3088 ? n : (n < 3328 ? -1 : n - 240);
    if (mode == 2) { const int t = n >> 8, j = n & 255; return j < 128 ? t * 128 + j : DFF + t * 128 + (j - 128); }
    return n;
}
__device__ __forceinline__ void wprep_load(f32x4 (&rg)[8], const float* __restrict__ src, int K, int Nsrc, int Ndst, int mode, size_t sbs, int item, int tid) {
    const int nx = Ndst / 256, ny = K / 64; const int bx = item % nx, by = (item / nx) % ny, bz = item / (nx * ny);
    const int tx = tid & 63, ty = tid >> 6, cm = colmap(mode, bx * 256 + tx * 4); const float* s = src + (size_t)bz * sbs + (size_t)(by * 64 + ty) * Nsrc + cm;
#pragma unroll
    for (int i = 0; i < 8; ++i) rg[i] = cm >= 0 ? *(const f32x4*)(s + (size_t)(8 * i) * Nsrc) : (f32x4){0.f, 0.f, 0.f, 0.f};
}
__device__ __forceinline__ void ph_wprep(const Ctx& c, const float* __restrict__ src, bf16_t* __restrict__ dst, int K, int Nsrc, int Ndst, int mode, int nbatch, size_t sbs, size_t dbs) {
    LAS float* tile = (LAS float*)c.lds;
    const int nx = Ndst / 256, ny = K / 64, total = nx * ny * nbatch;
    const int tid = c.tid, tx = tid & 63, ty = tid >> 6, n = tid >> 1, kh = tid & 1;
    f32x4 rg[8];
    int item = c.bid;
    if (item < total) wprep_load(rg, src, K, Nsrc, Ndst, mode, sbs, item, tid);
    for (; item < total; item += c.G) {
        __syncthreads();
#pragma unroll
        for (int i = 0; i < 8; ++i) *(LAS f32x4*)(tile + (ty + 8 * i) * 260 + tx * 4) = rg[i];
        __syncthreads();
        const int bx = item % nx, by = (item / nx) % ny, bz = item / (nx * ny);
        if (item + c.G < total) wprep_load(rg, src, K, Nsrc, Ndst, mode, sbs, item + c.G, tid);
        bf16_t* d = dst + (size_t)bz * dbs + (size_t)(bx * 256 + n) * K + by * 64 + kh * 32;
#pragma unroll
        for (int g = 0; g < 4; ++g) { unsigned p[4];
#pragma unroll
            for (int e = 0; e < 4; ++e) p[e] = pk2(tile[(kh * 32 + g * 8 + 2 * e) * 260 + n], tile[(kh * 32 + g * 8 + 2 * e + 1) * 260 + n]);
            *(u32x4*)(d + g * 8) = (u32x4){p[0], p[1], p[2], p[3]}; }
    }
    __syncthreads();
}
__device__ __forceinline__ void ph_xprep(const Ctx& c, const float* __restrict__ xp, const float* __restrict__ xs, const float* __restrict__ mem, float* __restrict__ HF, bf16_t* __restrict__ HB, bf16_t* __restrict__ MEMB) {
    const size_t nH = (size_t)MPAD * DM / 4, nM = (size_t)512 * DM / 4;
    for (size_t i4 = (size_t)c.bid * 512 + c.tid; i4 < nH + nM; i4 += (size_t)c.G * 512) {
        if (i4 < nH) {
            const size_t e = i4 * 4; f32x4 v = (f32x4){0.f, 0.f, 0.f, 0.f};
            if (e < (size_t)MP * DM) v = *(const f32x4*)(xp + e); else if (e < (size_t)MT * DM) v = *(const f32x4*)(xs + (e - (size_t)MP * DM));
            if (HF != nullptr) *(f32x4*)(HF + e) = v;
            u32x2 w; w.x = pk2(v[0], v[1]); w.y = pk2(v[2], v[3]); *(u32x2*)(HB + e) = w;
        } else {
            const size_t e = (i4 - nH) * 4; const f32x4 v = *(const f32x4*)(mem + e); u32x2 w; w.x = pk2(v[0], v[1]); w.y = pk2(v[2], v[3]); *(u32x2*)(MEMB + e) = w;
        }
    }
}
__device__ __forceinline__ void ph_ln(const Ctx& c, const bf16_t* __restrict__ Y, const float* __restrict__ g, const float* __restrict__ b, float* __restrict__ XF, bf16_t* __restrict__ XB, float* __restrict__ OUT, int nrows, int nout) {
    const int lane = c.lane;
    for (int row = c.bid * 8 + c.wave; row < nrows; row += c.G * 8) {
        const bf16_t* y = Y + (size_t)row * DM; f32x4 v[8]; float s = 0.f;
#pragma unroll
        for (int j = 0; j < 8; ++j) { const u32x2 yr = *(const u32x2*)(y + j * 256 + lane * 4);
            v[j] = (f32x4){__uint_as_float(yr.x << 16), __uint_as_float(yr.x & 0xffff0000u), __uint_as_float(yr.y << 16), __uint_as_float(yr.y & 0xffff0000u)}; s += (v[j][0] + v[j][1]) + (v[j][2] + v[j][3]); }
        const float mean = wave_sum(s) * (1.0f / DM); float q = 0.f;
#pragma unroll
        for (int j = 0; j < 8; ++j) { const f32x4 d = v[j] - mean; q += (d[0] * d[0] + d[1] * d[1]) + (d[2] * d[2] + d[3] * d[3]); }
        const float rstd = rsqrtf(wave_sum(q) * (1.0f / DM) + 1e-5f);
#pragma unroll
        for (int j = 0; j < 8; ++j) { const int cc = j * 256 + lane * 4; const f32x4 gg = *(const f32x4*)(g + cc), bb = *(const f32x4*)(b + cc);
            const f32x4 o = (v[j] - mean) * rstd * gg + bb; const size_t off = (size_t)row * DM + cc;
            if (XF != nullptr) *(f32x4*)(XF + off) = o;
            u32x2 w; w.x = pk2(o[0], o[1]); w.y = pk2(o[2], o[3]); *(u32x2*)(XB + off) = w;
            if (OUT != nullptr && row < nout) *(f32x4*)(OUT + off) = o; }
    }
}
__device__ __forceinline__ void ph_softmax256(const Ctx& c, const float* __restrict__ SC, bf16_t* __restrict__ P, int nrows) {
    const int lane = c.lane;
    for (int row = c.bid * 8 + c.wave; row < nrows; row += c.G * 8) {
        const f32x4 v = *(const f32x4*)(SC + (size_t)row * 256 + lane * 4);
        const float mx = wave_max(fmaxf(fmaxf(v[0], v[1]), fmaxf(v[2], v[3])));
        f32x4 e; e[0] = __expf(v[0] - mx); e[1] = __expf(v[1] - mx); e[2] = __expf(v[2] - mx); e[3] = __expf(v[3] - mx);
        const float inv = 1.0f / wave_sum((e[0] + e[1]) + (e[2] + e[3]));
        u32x2 w; w.x = pk2(e[0] * inv, e[1] * inv); w.y = pk2(e[2] * inv, e[3] * inv); *(u32x2*)(P + (size_t)row * 256 + lane * 4) = w;
    }
}
__device__ __forceinline__ void ph_copy_outs(const Ctx& c, const bf16_t* __restrict__ U, const float* __restrict__ ck, const float* __restrict__ cv, float* __restrict__ out, int layer) {
    constexpr int nA = PB * 128 * 128, nB = SB * 128 * 128, nC = PB * RWC, nD = SB * RWC;
    for (int i = c.bid * 512 + c.tid; i < nA + nB + nC + nD; i += c.G * 512) {
        if (i < nA) { const int b = i / 16384, j = (i >> 7) & 127, cc = i & 127; const size_t ur = (size_t)(b * PS + PS - 128 + j) * NINP;
            out[O_SWKP + (size_t)layer * nA + i] = bf2f(U[ur + U_SK + cc]); out[O_SWVP + (size_t)layer * nA + i] = bf2f(U[ur + U_SV + cc]); continue; }
        int k = i - nA;
        if (k < nB) { const int sq = k / 16384, j = (k >> 7) & 127, cc = k & 127; float kv, vv;
            if (j < 124) { const size_t o = ((size_t)sq * 128 + j + 4) * 128 + cc; kv = ck[o]; vv = cv[o]; }
            else { const size_t ur = (size_t)(MP + sq * SS + j - 124) * NINP; kv = bf2f(U[ur + U_SK + cc]); vv = bf2f(U[ur + U_SV + cc]); }
            out[O_SWKS + (size_t)layer * nB + k] = kv; out[O_SWVS + (size_t)layer * nB + k] = vv; continue; }
        k -= nB;
        if (k < nC) { const int b = k / RWC, cc = k - b * RWC; out[O_RSP + (size_t)layer * nC + k] = bf2f(U[(size_t)(b * PS + PS - 1) * NINP + U_RU + cc]); continue; }
        k -= nC;
        { const int sq = k / RWC, cc = k - sq * RWC; out[O_RSS + (size_t)layer * nD + k] = bf2f(U[(size_t)(MP + sq * SS + SS - 1) * NINP + U_RU + cc]); }
    }
}

__device__ __forceinline__ void seq_info(int sq, int& row0, int& L) { if (sq < PB) { row0 = sq * PS; L = PS; } else { row0 = MP + (sq - PB) * SS; L = SS; } }

__device__ __forceinline__ void ph_gla_naive(const Ctx& c, const bf16_t* __restrict__ U, const float* __restrict__ s0, const float* __restrict__ a_up, const float* __restrict__ a_b,
                                             const float* __restrict__ ng, const float* __restrict__ nb, bf16_t* __restrict__ OB, float* __restrict__ outP, float* __restrict__ outS) {
    LAS float* qs = (LAS float*)c.lds;
    LAS float* ks = qs + 16 * 128; LAS float* as = ks + 16 * 128; LAS float* os = as + 16 * 128;
    const int kh = c.tid >> 8, vt = c.tid & 255, lane = c.lane;
    for (int u = c.bid; u < (PB + SB) * 4; u += c.G) {
        const int sq = u >> 2, h = u & 3;
        int row0, L; seq_info(sq, row0, L);
        float S[64];
        if (sq >= PB) { const float* p = s0 + (((size_t)(sq - PB) * 4 + h) * 128 + kh * 64) * 256 + vt;
#pragma unroll
            for (int kk = 0; kk < 64; ++kk) S[kk] = p[(size_t)kk * 256]; }
        else {
#pragma unroll
            for (int kk = 0; kk < 64; ++kk) S[kk] = 0.f; }
        for (int t0 = 0; t0 < L; t0 += 16) {
            const int nT = (L - t0) < 16 ? (L - t0) : 16;
            for (int idx = c.tid; idx < nT * 128; idx += 512) {
                const int tt = idx >> 7, kk = idx & 127; const bf16_t* ur = U + (size_t)(row0 + t0 + tt) * NINP;
                qs[idx] = bf2f(ur[U_GQ + h * 128 + kk]) * 0.08838834764831845f; ks[idx] = bf2f(ur[U_GK + h * 128 + kk]);
                float x = a_b[h * 128 + kk];
#pragma unroll
                for (int r = 0; r < 16; ++r) x += bf2f(ur[U_GA + r]) * a_up[r * 512 + h * 128 + kk];
                const float ls = (fminf(x, 0.f) - log1pf(__expf(-fabsf(x)))) * (1.0f / 16.0f);
                as[idx] = __expf(ls);
            }
            __syncthreads();
            for (int tt = 0; tt < nT; ++tt) {
                const float v = bf2f(U[(size_t)(row0 + t0 + tt) * NINP + U_GV + h * 256 + vt]); float o = 0.f; const int lb = tt * 128 + kh * 64;
#pragma unroll
                for (int kk = 0; kk < 64; ++kk) { S[kk] = as[lb + kk] * S[kk] + ks[lb + kk] * v; o += qs[lb + kk] * S[kk]; }
                os[(kh * 16 + tt) * 256 + vt] = o;
            }
            __syncthreads();
            for (int tt = c.wave; tt < nT; tt += 8) {
                float x[4]; float s = 0.f;
#pragma unroll
                for (int j = 0; j < 4; ++j) { x[j] = os[tt * 256 + lane + 64 * j] + os[(16 + tt) * 256 + lane + 64 * j]; s += x[j]; }
                const float mean = wave_sum(s) * (1.0f / 256.0f); float q = 0.f;
#pragma unroll
                for (int j = 0; j < 4; ++j) { const float d = x[j] - mean; q += d * d; }
                const float rstd = rsqrtf(wave_sum(q) * (1.0f / 256.0f) + 1e-5f);
                const size_t row = (size_t)(row0 + t0 + tt);
#pragma unroll
                for (int j = 0; j < 4; ++j) { const int cc = h * 256 + lane + 64 * j; const float n = (x[j] - mean) * rstd * ng[cc] + nb[cc];
                    const float gr = bf2f(U[row * NINP + U_GR + cc]); OB[row * BW + cc] = f2bf(n * gr * sigmoidf_(gr)); }
            }
            __syncthreads();
        }
        float* op = (sq < PB ? outP + (((size_t)sq * 4 + h) * 128 + kh * 64) * 256 : outS + (((size_t)(sq - PB) * 4 + h) * 128 + kh * 64) * 256) + vt;
#pragma unroll
        for (int kk = 0; kk < 64; ++kk) op[(size_t)kk * 256] = S[kk];
    }
}

__device__ __forceinline__ f32x4 mma16(bf16x8 x, bf16x8 y, f32x4 c) { return __builtin_amdgcn_mfma_f32_16x16x32_bf16(x, y, c, 0, 0, 0); }
__device__ __forceinline__ bf16x8 pack_acc(const f32x4& a, const f32x4& b) {
    u32x4 p; p.x = pk2(a[0], a[1]); p.y = pk2(a[2], a[3]); p.z = pk2(b[0], b[1]); p.w = pk2(b[2], b[3]); return __builtin_bit_cast(bf16x8, p);
}
__device__ __forceinline__ void gla_chunk_info(int u, int& row0, int& ntok, int& h) {
    if (u < 512) { const int b = u >> 8; h = (u >> 6) & 3; row0 = b * PS + (u & 63) * 64; ntok = 64; }
    else { const int s = u - 512; h = s & 3; row0 = MP + (s >> 2) * SS; ntok = SS; }
}
__device__ __forceinline__ void ph_gla_pre(const Ctx& c, const bf16_t* __restrict__ U, const float* __restrict__ a_up, const float* __restrict__ a_b,
                                           bf16_t* __restrict__ QD, bf16_t* __restrict__ KHT, bf16_t* __restrict__ EE, bf16_t* __restrict__ VT, float* __restrict__ GC) {
    LAS float* ga_l = (LAS float*)c.lds;
    LAS float* tot = ga_l + 64 * 16;
    LAS bf16_t* Qd_l = (LAS bf16_t*)(tot + 4 * 128);
    LAS bf16_t* Kn_l = Qd_l + 64 * 136;
    LAS bf16_t* v_l = Kn_l + 64 * 136;
    LAS bf16_t* qr_l = v_l + 64 * 264;
    LAS bf16_t* kr_l = qr_l + 64 * 136;
    const int tid = c.tid, lane = c.lane, r = lane & 15, q = lane >> 4, w = c.wave;
    for (int u = (c.bid + c.G / 2) % c.G; u < GL_NCH; u += c.G) {
        int row0, ntok, h; gla_chunk_info(u, row0, ntok, h);
        for (int i = tid; i < 64 * 16; i += 512) { const int t = i >> 4, rr = i & 15; ga_l[i] = t < ntok ? bf2f(U[(size_t)(row0 + t) * NINP + U_GA + rr]) : 0.f; }
        for (int i = tid; i < 64 * 32; i += 512) { const int t = i >> 5, c8 = i & 31; u32x4 vv = (u32x4){0u, 0u, 0u, 0u};
            if (t < ntok) vv = *(const u32x4*)(U + (size_t)(row0 + t) * NINP + U_GV + h * 256 + c8 * 8);
            *(LAS u32x4*)(v_l + t * 264 + c8 * 8) = vv; }
        for (int i = tid; i < 64 * 16; i += 512) { const int t = i >> 4, c8 = i & 15; u32x4 qv = (u32x4){0u, 0u, 0u, 0u}, kv = qv;
            if (t < ntok) { const bf16_t* ur = U + (size_t)(row0 + t) * NINP + h * 128 + c8 * 8; qv = *(const u32x4*)(ur + U_GQ); kv = *(const u32x4*)(ur + U_GK); }
            *(LAS u32x4*)(qr_l + t * 136 + c8 * 8) = qv; *(LAS u32x4*)(kr_l + t * 136 + c8 * 8) = kv; }
        __syncthreads();
        const int kk = tid & 127, tq = tid >> 7;
        float cum[16];
        { float aup[16];
#pragma unroll
          for (int rr = 0; rr < 16; ++rr) aup[rr] = a_up[rr * 512 + h * 128 + kk];
          const float ab = a_b[h * 128 + kk]; float run = 0.f;
#pragma unroll
          for (int j = 0; j < 16; ++j) { const int t = tq * 16 + j; float x = ab;
#pragma unroll
              for (int rr = 0; rr < 16; ++rr) x += ga_l[t * 16 + rr] * aup[rr];
              const float la = t < ntok ? (fminf(x, 0.f) - __logf(1.0f + __expf(-fabsf(x)))) * (1.0f / 16.0f) : 0.f;
              run += la; cum[j] = run; }
          tot[tq * 128 + kk] = run; }
        __syncthreads();
        { float prefix = 0.f, bC = 0.f;
#pragma unroll
          for (int g = 0; g < 4; ++g) { const float tv = tot[g * 128 + kk]; bC += tv; if (g < tq) prefix += tv; }
          unsigned khp[8];
#pragma unroll
          for (int j = 0; j < 16; j += 2) { float kh2[2];
#pragma unroll
              for (int e = 0; e < 2; ++e) { const int t = tq * 16 + j + e; const float b = prefix + cum[j + e]; const float qv = bf2f(qr_l[t * 136 + kk]), kv = bf2f(kr_l[t * 136 + kk]);
                  Qd_l[t * 136 + kk] = f2bf(qv * __expf(b) * 0.08838834764831845f); Kn_l[t * 136 + kk] = f2bf(kv * __expf(-b)); kh2[e] = kv * __expf(bC - b); }
              khp[j >> 1] = pk2(kh2[0], kh2[1]); }
          bf16_t* kp = KHT + (size_t)u * 8192 + kk * 64 + tq * 16;
          *(u32x4*)kp = (u32x4){khp[0], khp[1], khp[2], khp[3]}; *(u32x4*)(kp + 8) = (u32x4){khp[4], khp[5], khp[6], khp[7]};
          if (tq == 0) GC[(size_t)u * 128 + kk] = __expf(bC); }
        __syncthreads();
        { const int tb = w >> 1;
#pragma unroll
          for (int e = 0; e < 2; ++e) { const int ib = (w & 1) * 2 + e; f32x4 d = (f32x4){0.f, 0.f, 0.f, 0.f};
              if (ib <= tb) {
                  bf16x8 kf4[4], qf4[4];
#pragma unroll
                  for (int ks = 0; ks < 4; ++ks) { kf4[ks] = *(const LAS bf16x8*)(Kn_l + (ib * 16 + r) * 136 + ks * 32 + q * 8); qf4[ks] = *(const LAS bf16x8*)(Qd_l + (tb * 16 + r) * 136 + ks * 32 + q * 8); }
                  __builtin_amdgcn_sched_barrier(0);
#pragma unroll
                  for (int ks = 0; ks < 4; ++ks) d = mma16(kf4[ks], qf4[ks], d); }
              const int t = tb * 16 + r, i0 = ib * 16 + q * 4;
#pragma unroll
              for (int jj = 0; jj < 4; ++jj) if (i0 + jj > t) d[jj] = 0.f;
              u32x2 o; o.x = pk2(d[0], d[1]); o.y = pk2(d[2], d[3]); *(u32x2*)(EE + (size_t)u * 4096 + t * 64 + i0) = o; } }
        for (int i = tid; i < 64 * 16; i += 512) { const int t = i >> 4, c8 = i & 15; *(u32x4*)(QD + (size_t)u * 8192 + t * 128 + c8 * 8) = *(const LAS u32x4*)(Qd_l + t * 136 + c8 * 8); }
        { const int val = tid & 255, th = tid >> 8;
#pragma unroll
          for (int tg = 0; tg < 4; ++tg) { const int t0 = th * 32 + tg * 8; unsigned p4[4];
#pragma unroll
              for (int e = 0; e < 4; ++e) p4[e] = (unsigned)v_l[(t0 + 2 * e) * 264 + val] | ((unsigned)v_l[(t0 + 2 * e + 1) * 264 + val] << 16);
              *(u32x4*)(VT + (size_t)u * 16384 + val * 64 + t0) = (u32x4){p4[0], p4[1], p4[2], p4[3]}; } }
        __syncthreads();
    }
}
struct GlaStage { u32x4 qd[2], kh[2], e, vt, gc; };
__device__ __forceinline__ void gla_stage_load(GlaStage& s, const bf16_t* __restrict__ QD, const bf16_t* __restrict__ KHT, const bf16_t* __restrict__ EE, const bf16_t* __restrict__ VT, const float* __restrict__ GC,
                                               int ch, int sl, int tid) {
    const bf16_t* qp = QD + (size_t)ch * 8192 + tid * 8; s.qd[0] = *(const u32x4*)qp; s.qd[1] = *(const u32x4*)(qp + 4096);
    const bf16_t* kp = KHT + (size_t)ch * 8192 + tid * 8; s.kh[0] = *(const u32x4*)kp; s.kh[1] = *(const u32x4*)(kp + 4096);
    s.e = *(const u32x4*)(EE + (size_t)ch * 4096 + tid * 8);
    s.vt = *(const u32x4*)(VT + (size_t)ch * 16384 + sl * 4096 + tid * 8);
    if (tid < 32) s.gc = *(const u32x4*)(GC + (size_t)ch * 128 + tid * 4);
}
constexpr int GS_KH = 8704, GS_E = 17920, GS_VT = 22528, GS_GC = 27136, GS_EL = 27392;
__device__ __forceinline__ void gla_stage_store(const GlaStage& s, LAS bf16_t* b, int tid) {
    *(LAS u32x4*)(b + (tid >> 4) * 136 + (tid & 15) * 8) = s.qd[0]; *(LAS u32x4*)(b + (32 + (tid >> 4)) * 136 + (tid & 15) * 8) = s.qd[1];
    *(LAS u32x4*)(b + GS_KH + (tid >> 3) * 72 + (tid & 7) * 8) = s.kh[0]; *(LAS u32x4*)(b + GS_KH + (64 + (tid >> 3)) * 72 + (tid & 7) * 8) = s.kh[1];
    *(LAS u32x4*)(b + GS_E + (tid >> 3) * 72 + (tid & 7) * 8) = s.e; *(LAS u32x4*)(b + GS_VT + (tid >> 3) * 72 + (tid & 7) * 8) = s.vt;
    if (tid < 32) *(LAS u32x4*)(b + GS_GC + tid * 8) = s.gc;
}
__device__ __forceinline__ void ph_gla_seq(const Ctx& c, int boff, const bf16_t* __restrict__ QD, const bf16_t* __restrict__ KHT, const bf16_t* __restrict__ EE, const bf16_t* __restrict__ VT, const float* __restrict__ GC,
                                           const float* __restrict__ s0, float* __restrict__ outP, float* __restrict__ outS, bf16_t* __restrict__ OB) {
    LAS bf16_t* stg = (LAS bf16_t*)c.lds;
    LAS bf16_t* T_l = stg + 2 * GS_EL;
    const int tid = c.tid, lane = c.lane, r = lane & 15, q = lane >> 4, w = c.wave;
    const int side = c.bid < 32 ? c.bid : c.bid - 64, nside = c.G - 64;
    for (int u = (c.bid >= boff && c.bid < boff + 32) ? c.bid - boff : ((c.bid < 32 || c.bid >= 96) ? 32 + side : 32 + 512); u < 32 + 512; u = u < 32 ? 32 + 512 : u + nside) {
        int h, sl, nch, ch0, row0, ntok; const float* sp = nullptr; float* op;
        if (u < 32) { const int b = u >> 4; h = (u >> 2) & 3; sl = u & 3; nch = 64; ch0 = (b * 4 + h) * 64; row0 = b * PS; ntok = 64; op = outP + (size_t)(b * 4 + h) * 32768; }
        else { const int s = u - 32, sq = s >> 4; h = (s >> 2) & 3; sl = s & 3; nch = 1; ch0 = 512 + sq * 4 + h; row0 = MP + sq * SS; ntok = SS; sp = s0 + (size_t)(sq * 4 + h) * 32768; op = outS + (size_t)(sq * 4 + h) * 32768; }
        f32x4 acc[4];
#pragma unroll
        for (int vb = 0; vb < 4; ++vb)
#pragma unroll
            for (int jj = 0; jj < 4; ++jj) acc[vb][jj] = sp ? sp[(size_t)(w * 16 + q * 4 + jj) * 256 + sl * 64 + vb * 16 + r] : 0.f;
        GlaStage R0, R1, R2;
        gla_stage_load(R0, QD, KHT, EE, VT, GC, ch0, sl, tid);
        if (1 < nch) gla_stage_load(R1, QD, KHT, EE, VT, GC, ch0 + 1, sl, tid);
        if (2 < nch) gla_stage_load(R2, QD, KHT, EE, VT, GC, ch0 + 2, sl, tid);
        __syncthreads();
        gla_stage_store(R0, stg, tid);
        if (3 < nch) gla_stage_load(R0, QD, KHT, EE, VT, GC, ch0 + 3, sl, tid);
#define GLA_STEP(ci, RN) do { \
            LAS bf16_t* Tb = T_l + ((ci) & 1) * 64 * 136; const LAS bf16_t* sb = stg + ((ci) & 1) * GS_EL; \
            _Pragma("unroll") for (int vb = 0; vb < 4; ++vb) { u32x2 o; o.x = pk2(acc[vb][0], acc[vb][1]); o.y = pk2(acc[vb][2], acc[vb][3]); *(LAS u32x2*)(Tb + (vb * 16 + r) * 136 + w * 16 + q * 4) = o; } \
            __syncthreads(); \
            if ((ci) + 1 < nch) { gla_stage_store(RN, stg + (((ci) + 1) & 1) * GS_EL, tid); if ((ci) + 4 < nch) gla_stage_load(RN, QD, KHT, EE, VT, GC, ch0 + (ci) + 4, sl, tid); } \
            { const int rb = w >> 1, t = rb * 16 + r; bf16x8 qf[4], ef[2]; \
              _Pragma("unroll") for (int ks = 0; ks < 4; ++ks) qf[ks] = *(const LAS bf16x8*)(sb + (rb * 16 + r) * 136 + ks * 32 + q * 8); \
              _Pragma("unroll") for (int ks = 0; ks < 2; ++ks) ef[ks] = *(const LAS bf16x8*)(sb + GS_E + (rb * 16 + r) * 72 + ks * 32 + q * 8); \
              bf16x8 tf[2][4], vf[2][2]; \
              _Pragma("unroll") for (int e2 = 0; e2 < 2; ++e2) { const int cb = (w & 1) * 2 + e2; \
                  _Pragma("unroll") for (int ks = 0; ks < 4; ++ks) tf[e2][ks] = *(const LAS bf16x8*)(Tb + (cb * 16 + r) * 136 + ks * 32 + q * 8); \
                  _Pragma("unroll") for (int ks = 0; ks < 2; ++ks) vf[e2][ks] = *(const LAS bf16x8*)(sb + GS_VT + (cb * 16 + r) * 72 + ks * 32 + q * 8); } \
              __builtin_amdgcn_sched_barrier(0); \
              _Pragma("unroll") for (int e2 = 0; e2 < 2; ++e2) { const int cb = (w & 1) * 2 + e2; f32x4 y = (f32x4){0.f, 0.f, 0.f, 0.f}; \
                  _Pragma("unroll") for (int ks = 0; ks < 4; ++ks) y = mma16(tf[e2][ks], qf[ks], y); \
                  _Pragma("unroll") for (int ks = 0; ks < 2; ++ks) y = mma16(vf[e2][ks], ef[ks], y); \
                  if (t < ntok) { u32x2 o; o.x = pk2(y[0], y[1]); o.y = pk2(y[2], y[3]); *(u32x2*)(OB + (size_t)(row0 + (ci) * 64 + t) * BW + h * 256 + sl * 64 + cb * 16 + q * 4) = o; } } } \
            { const f32x4 gcv = *(const LAS f32x4*)((const LAS float*)(sb + GS_GC) + w * 16 + q * 4); bf16x8 kf[2]; \
              _Pragma("unroll") for (int ks = 0; ks < 2; ++ks) kf[ks] = *(const LAS bf16x8*)(sb + GS_KH + (w * 16 + r) * 72 + ks * 32 + q * 8); \
              bf16x8 vs[4][2]; \
              _Pragma("unroll") for (int vb = 0; vb < 4; ++vb) _Pragma("unroll") for (int ks = 0; ks < 2; ++ks) vs[vb][ks] = *(const LAS bf16x8*)(sb + GS_VT + (vb * 16 + r) * 72 + ks * 32 + q * 8); \
              __builtin_amdgcn_sched_barrier(0); \
              _Pragma("unroll") for (int vb = 0; vb < 4; ++vb) { acc[vb] = acc[vb] * gcv; \
                  _Pragma("unroll") for (int ks = 0; ks < 2; ++ks) acc[vb] = mma16(kf[ks], vs[vb][ks], acc[vb]); } } \
        } while (0)
#pragma unroll 1
        for (int ci = 0; ci < nch; ci += 3) {
            GLA_STEP(ci, R1);
            if (ci + 1 < nch) GLA_STEP(ci + 1, R2);
            if (ci + 2 < nch) GLA_STEP(ci + 2, R0);
        }
#undef GLA_STEP
#pragma unroll
        for (int vb = 0; vb < 4; ++vb)
#pragma unroll
            for (int jj = 0; jj < 4; ++jj) op[(size_t)(w * 16 + q * 4 + jj) * 256 + sl * 64 + vb * 16 + r] = acc[vb][jj];
        __syncthreads();
    }
}
__device__ __forceinline__ void ph_gla_fin(const Ctx& c, const bf16_t* __restrict__ U, const float* __restrict__ ng, const float* __restrict__ nb, const bf16_t* __restrict__ RAW, bf16_t* __restrict__ OB) {
    const int lane = c.lane;
    for (int i = c.bid * 8 + c.wave; i < MT * 4; i += c.G * 8) {
        const int row = i >> 2, h = i & 3, cc = h * 256 + lane * 4; bf16_t* p = OB + (size_t)row * BW + cc;
        const u32x2 raw = *(const u32x2*)(RAW + (size_t)row * BW + cc); float x[4] = {__uint_as_float(raw.x << 16), __uint_as_float(raw.x & 0xffff0000u), __uint_as_float(raw.y << 16), __uint_as_float(raw.y & 0xffff0000u)};
        const float mean = wave_sum((x[0] + x[1]) + (x[2] + x[3])) * (1.0f / 256.0f); float qq = 0.f;
#pragma unroll
        for (int j = 0; j < 4; ++j) { const float d = x[j] - mean; qq += d * d; }
        const float rstd = rsqrtf(wave_sum(qq) * (1.0f / 256.0f) + 1e-5f);
        const u32x2 gp = *(const u32x2*)(U + (size_t)row * NINP + U_GR + cc); const float gr[4] = {__uint_as_float(gp.x << 16), __uint_as_float(gp.x & 0xffff0000u), __uint_as_float(gp.y << 16), __uint_as_float(gp.y & 0xffff0000u)};
        const f32x4 gg = *(const f32x4*)(ng + cc), bb = *(const f32x4*)(nb + cc); float o[4];
#pragma unroll
        for (int j = 0; j < 4; ++j) o[j] = ((x[j] - mean) * rstd * gg[j] + bb[j]) * gr[j] * sigmoidf_(gr[j]);
        u32x2 ov; ov.x = pk2(o[0], o[1]); ov.y = pk2(o[2], o[3]); *(u32x2*)p = ov;
    }
}

__device__ __forceinline__ void unpack8(const u32x4 w, float (&x)[8]) {
    x[0] = __uint_as_float(w.x << 16); x[1] = __uint_as_float(w.x & 0xffff0000u); x[2] = __uint_as_float(w.y << 16); x[3] = __uint_as_float(w.y & 0xffff0000u);
    x[4] = __uint_as_float(w.z << 16); x[5] = __uint_as_float(w.z & 0xffff0000u); x[6] = __uint_as_float(w.w << 16); x[7] = __uint_as_float(w.w & 0xffff0000u);
}
template <bool ISBF> __device__ __forceinline__ void swa_step(const float (&q)[32], float (&acc)[32], float& m, float& l, const void* kp, const void* vp, float slope, float dist) {
    float s = 0.f;
#pragma unroll
    for (int j = 0; j < 4; ++j) { float x[8];
        if (ISBF) unpack8(*(const u32x4*)((const bf16_t*)kp + j * 8), x);
        else { const f32x4 a = *(const f32x4*)((const float*)kp + j * 8), b = *(const f32x4*)((const float*)kp + j * 8 + 4); x[0] = a[0]; x[1] = a[1]; x[2] = a[2]; x[3] = a[3]; x[4] = b[0]; x[5] = b[1]; x[6] = b[2]; x[7] = b[3]; }
#pragma unroll
        for (int d = 0; d < 8; ++d) s += q[j * 8 + d] * x[d]; }
    s += __shfl_xor(s, 1, 64);
    s = s * 0.125f - slope * dist;
    const float mn = fmaxf(m, s), cc = __expf(m - mn), p = __expf(s - mn);
    l = l * cc + p;
#pragma unroll
    for (int j = 0; j < 4; ++j) { float x[8];
        if (ISBF) unpack8(*(const u32x4*)((const bf16_t*)vp + j * 8), x);
        else { const f32x4 a = *(const f32x4*)((const float*)vp + j * 8), b = *(const f32x4*)((const float*)vp + j * 8 + 4); x[0] = a[0]; x[1] = a[1]; x[2] = a[2]; x[3] = a[3]; x[4] = b[0]; x[5] = b[1]; x[6] = b[2]; x[7] = b[3]; }
#pragma unroll
        for (int d = 0; d < 8; ++d) acc[j * 8 + d] = acc[j * 8 + d] * cc + p * x[d]; }
    m = mn;
}
__device__ __forceinline__ void ph_swa_naive(const Ctx& c, const bf16_t* __restrict__ U, const float* __restrict__ ck, const float* __restrict__ cv, const float* __restrict__ sinks, bf16_t* __restrict__ OB) {
    for (int gid = c.bid * 512 + c.tid; gid < MS * 32; gid += c.G * 512) {
        const int dh = gid & 1, h = (gid >> 1) & 15, row = MP + (gid >> 5), kvh = h >> 3, co = kvh * 64 + dh * 32;
        float q[32], acc[32];
#pragma unroll
        for (int j = 0; j < 4; ++j) { float x[8]; unpack8(*(const u32x4*)(U + (size_t)row * NINP + U_SQ + h * 64 + dh * 32 + j * 8), x);
#pragma unroll
            for (int d = 0; d < 8; ++d) { q[j * 8 + d] = x[d]; acc[j * 8 + d] = 0.f; } }
        const float slope = exp2f(-0.5f * (float)(h + 1)); float m = sinks[h], l = 1.0f;
        if (row < MP) {
            const int t = row % PS, base = row - t, lo = t - 128 < 0 ? 0 : t - 128;
            for (int s = lo; s <= t; ++s) { const bf16_t* ur = U + (size_t)(base + s) * NINP;
                swa_step<true>(q, acc, m, l, ur + U_SK + co, ur + U_SV + co, slope, (float)(t - s)); }
        } else {
            const int sq = (row - MP) / SS, i = (row - MP) % SS;
            for (int idx = i; idx <= 128 + i; ++idx) {
                if (idx < 128) { const size_t o = ((size_t)sq * 128 + idx) * 128 + co; swa_step<false>(q, acc, m, l, ck + o, cv + o, slope, (float)(128 + i - idx)); }
                else { const bf16_t* ur = U + (size_t)(MP + sq * SS + idx - 128) * NINP; swa_step<true>(q, acc, m, l, ur + U_SK + co, ur + U_SV + co, slope, (float)(128 + i - idx)); }
            }
        }
        const float inv = 1.0f / l; bf16_t* op = OB + (size_t)row * BW + h * 64 + dh * 32;
#pragma unroll
        for (int j = 0; j < 4; ++j) { u32x4 w; w.x = pk2(acc[j * 8] * inv, acc[j * 8 + 1] * inv); w.y = pk2(acc[j * 8 + 2] * inv, acc[j * 8 + 3] * inv);
            w.z = pk2(acc[j * 8 + 4] * inv, acc[j * 8 + 5] * inv); w.w = pk2(acc[j * 8 + 6] * inv, acc[j * 8 + 7] * inv); *(u32x4*)(op + j * 8) = w; }
    }
}

__device__ __forceinline__ void ph_rwkv_prep(const Ctx& c, const bf16_t* __restrict__ U, const float* __restrict__ shift, const float* __restrict__ mu, const float* __restrict__ w0, const float* __restrict__ w2,
                                             const float* __restrict__ a0, const float* __restrict__ a2, const float* __restrict__ g2, const float* __restrict__ k_k, const float* __restrict__ k_a,
                                             const float* __restrict__ r_k, float* __restrict__ RW) {
    LAS float* xm = (LAS float*)c.lds; LAS float* tw = xm + RWC; LAS float* ad = tw + 64; LAS float* sg = ad + 64;
    const int tid = c.tid;
    float* R = RW; float* WD = RW + (size_t)MPAD * BW; float* K2 = WD + (size_t)MPAD * BW; float* V = K2 + (size_t)MPAD * BW; float* KK = V + (size_t)MPAD * BW;
    float* BV = KK + (size_t)MPAD * BW; float* G = BV + (size_t)MPAD * BW; float* BON = G + (size_t)MPAD * BW;
    for (int row = c.bid; row < MT; row += c.G) {
        const bf16_t* ur = U + (size_t)row * NINP + U_RU; const bf16_t* pr = ur - NINP; const float* ps = nullptr; bool first;
        if (row < MP) first = (row % PS) == 0; else { first = ((row - MP) % SS) == 0; ps = shift + (size_t)((row - MP) / SS) * RWC; }
        for (int cc = tid; cc < RWC; cc += 512) { const float x = bf2f(ur[cc]); const float s = first ? (ps ? ps[cc] : 0.f) : bf2f(pr[cc]); xm[cc] = x + (s - x) * mu[cc]; }
        __syncthreads();
        if (tid < 64) { tw[tid] = tanhf(xm[3072 + tid]); ad[tid] = xm[3136 + tid]; }
        if (tid >= 128 && tid < 256) sg[tid - 128] = sigmoidf_(xm[3200 + tid - 128]);
        __syncthreads();
        for (int qd = 0; qd < 2; ++qd) {
            const int cc = qd * 512 + tid; float accw = w0[cc], acca = a0[cc], accg = 0.f;
#pragma unroll 4
            for (int j = 0; j < 64; ++j) { accw += tw[j] * w2[j * BW + cc]; acca += ad[j] * a2[j * BW + cc]; }
#pragma unroll 4
            for (int j = 0; j < 128; ++j) accg += sg[j] * g2[j * BW + cc];
            const float lw = -softplusf_(-accw) - 0.5f, decay = __expf(-__expf(lw)), a = sigmoidf_(acca);
            const float r = xm[cc], k = xm[1024 + cc], v = xm[2048 + cc];
            const float kkr = k * k_k[cc]; const float ss = wave_sum(kkr * kkr); const float kk = kkr / fmaxf(sqrtf(ss), 1e-12f);
            const float k2 = k * (1.0f + (a - 1.0f) * k_a[cc]); const float rk = wave_sum(r * k2 * r_k[cc]);
            const size_t o = (size_t)row * BW + cc;
            R[o] = r; WD[o] = decay; K2[o] = k2; V[o] = v; KK[o] = kk; BV[o] = kk * a; G[o] = accg; BON[o] = rk * v;
        }
        __syncthreads();
    }
}
__device__ __forceinline__ int kperm_pos(int k) { return (k & ~31) + 8 * ((k >> 2) & 3) + 4 * ((k >> 4) & 1) + (k & 3); }
__device__ __forceinline__ void ph_swa_prompt(const Ctx& c, const bf16_t* __restrict__ U, const float* __restrict__ sinks, bf16_t* __restrict__ OB) {
    LAS bf16_t* K_l = (LAS bf16_t*)c.lds;
    LAS bf16_t* VT_l = K_l + 192 * 72;
    const int tid = c.tid, lane = c.lane, r = lane & 15, q = lane >> 4, w = c.wave;
    for (int u = c.bid; u < PB * 64 * 2; u += c.G) {
        const int b = u >> 7, qb = (u >> 1) & 63, kvh = u & 1, h = kvh * 8 + w;
        const int tok0 = qb * 64 - 128;
        const size_t seq0 = (size_t)b * PS;
        for (int idx = tid; idx < 192 * 8; idx += 512) { const int kl = idx >> 3, c8 = idx & 7, tk = tok0 + kl; u32x4 kv = (u32x4){0u, 0u, 0u, 0u}, vv = kv;
            if (tk >= 0) { const bf16_t* ur = U + (seq0 + tk) * NINP; kv = *(const u32x4*)(ur + U_SK + kvh * 64 + c8 * 8); vv = *(const u32x4*)(ur + U_SV + kvh * 64 + c8 * 8); }
            *(LAS u32x4*)(K_l + kl * 72 + c8 * 8) = kv;
            const int kp = kperm_pos(kl); LAS bf16_t* vp = VT_l + (c8 * 8) * 200 + kp;
            vp[0] = (bf16_t)(vv.x & 0xffffu); vp[200] = (bf16_t)(vv.x >> 16); vp[400] = (bf16_t)(vv.y & 0xffffu); vp[600] = (bf16_t)(vv.y >> 16);
            vp[800] = (bf16_t)(vv.z & 0xffffu); vp[1000] = (bf16_t)(vv.z >> 16); vp[1200] = (bf16_t)(vv.w & 0xffffu); vp[1400] = (bf16_t)(vv.w >> 16); }
        __syncthreads();
        const float slope = exp2f(-0.5f * (float)(h + 1)), sink = sinks[h];
#pragma unroll 1
        for (int i = 0; i < 4; ++i) {
            const size_t qrow = seq0 + qb * 64 + i * 16 + r;
            const bf16x8 qf0 = *(const bf16x8*)(U + qrow * NINP + U_SQ + h * 64 + q * 8), qf1 = *(const bf16x8*)(U + qrow * NINP + U_SQ + h * 64 + 32 + q * 8);
            const int kt0 = i & ~1;
            f32x4 s[10]; float mx = sink; bf16x8 kfr[5][2];
#pragma unroll
            for (int kt = 0; kt < 10; ++kt) { f32x4 d;
                if (kt % 5 == 0) {
#pragma unroll
                    for (int k5 = 0; k5 < 5; ++k5) { const LAS bf16_t* kp = K_l + ((kt0 + kt + k5) * 16 + r) * 72 + q * 8; kfr[k5][0] = *(const LAS bf16x8*)kp; kfr[k5][1] = *(const LAS bf16x8*)(kp + 32); }
                    __builtin_amdgcn_sched_barrier(0); }
                d = mma16(kfr[kt % 5][0], qf0, (f32x4){0.f, 0.f, 0.f, 0.f}); d = mma16(kfr[kt % 5][1], qf1, d);
#pragma unroll
                for (int jj = 0; jj < 4; ++jj) { const int kl = (kt0 + kt) * 16 + q * 4 + jj, dist = i * 16 + r + 128 - kl;
                    const float v = (dist >= 0 && dist <= 128 && tok0 + kl >= 0) ? d[jj] * 0.125f - slope * (float)dist : -1e30f; d[jj] = v; mx = fmaxf(mx, v); }
                s[kt] = d; }
            mx = fmaxf(mx, __shfl_xor(mx, 16, 64)); mx = fmaxf(mx, __shfl_xor(mx, 32, 64));
            float sum = 0.f; bf16x8 pf[5];
#pragma unroll
            for (int kp = 0; kp < 5; ++kp) { f32x4 a = s[2 * kp], bq = s[2 * kp + 1];
#pragma unroll
                for (int jj = 0; jj < 4; ++jj) { a[jj] = __expf(a[jj] - mx); bq[jj] = __expf(bq[jj] - mx); sum += a[jj] + bq[jj]; }
                pf[kp] = pack_acc(a, bq); }
            sum += __shfl_xor(sum, 16, 64); sum += __shfl_xor(sum, 32, 64);
            const float inv = 1.0f / (sum + __expf(sink - mx));
            bf16_t* op = OB + qrow * BW + h * 64 + q * 4;
#pragma unroll
            for (int dt = 0; dt < 4; ++dt) { f32x4 o = (f32x4){0.f, 0.f, 0.f, 0.f}; bf16x8 vfr[5];
#pragma unroll
                for (int kp = 0; kp < 5; ++kp) vfr[kp] = *(const LAS bf16x8*)(VT_l + (dt * 16 + r) * 200 + (kt0 + 2 * kp) * 16 + q * 8);
                __builtin_amdgcn_sched_barrier(0);
#pragma unroll
                for (int kp = 0; kp < 5; ++kp) o = mma16(vfr[kp], pf[kp], o);
                u32x2 ov; ov.x = pk2(o[0] * inv, o[1] * inv); ov.y = pk2(o[2] * inv, o[3] * inv); *(u32x2*)(op + dt * 16) = ov; }
        }
        __syncthreads();
    }
}

__device__ __forceinline__ void ph_swa_sample(const Ctx& c, const bf16_t* __restrict__ U, const float* __restrict__ ck, const float* __restrict__ cv, const float* __restrict__ sinks, bf16_t* __restrict__ OB) {
    LAS bf16_t* K_l = (LAS bf16_t*)c.lds;
    LAS bf16_t* VT_l = K_l + 160 * 72;
    const int tid = c.tid, lane = c.lane, r = lane & 15, q = lane >> 4, w = c.wave;
    for (int u = c.bid; u < SB * 2; u += c.G) {
        const int sq = u >> 1, kvh = u & 1;
        for (int idx = tid; idx < 160 * 8; idx += 512) { const int kl = idx >> 3, c8 = idx & 7; float kx[8], vx[8];
#pragma unroll
            for (int e = 0; e < 8; ++e) { kx[e] = 0.f; vx[e] = 0.f; }
            if (kl < 128) { const size_t o = ((size_t)sq * 128 + kl) * 128 + kvh * 64 + c8 * 8; const f32x4 a = *(const f32x4*)(ck + o), b2 = *(const f32x4*)(ck + o + 4), c2 = *(const f32x4*)(cv + o), d2 = *(const f32x4*)(cv + o + 4);
                kx[0] = a[0]; kx[1] = a[1]; kx[2] = a[2]; kx[3] = a[3]; kx[4] = b2[0]; kx[5] = b2[1]; kx[6] = b2[2]; kx[7] = b2[3];
                vx[0] = c2[0]; vx[1] = c2[1]; vx[2] = c2[2]; vx[3] = c2[3]; vx[4] = d2[0]; vx[5] = d2[1]; vx[6] = d2[2]; vx[7] = d2[3]; }
            else if (kl < 132) { const bf16_t* ur = U + (size_t)(MP + sq * SS + kl - 128) * NINP; unpack8(*(const u32x4*)(ur + U_SK + kvh * 64 + c8 * 8), kx); unpack8(*(const u32x4*)(ur + U_SV + kvh * 64 + c8 * 8), vx); }
            *(LAS u32x4*)(K_l + kl * 72 + c8 * 8) = (u32x4){pk2(kx[0], kx[1]), pk2(kx[2], kx[3]), pk2(kx[4], kx[5]), pk2(kx[6], kx[7])};
            LAS bf16_t* vp = VT_l + (c8 * 8) * 168 + kperm_pos(kl);
#pragma unroll
            for (int e = 0; e < 8; ++e) vp[e * 168] = f2bf(vx[e]); }
        __syncthreads();
        if (w < 2) {
            const int h = kvh * 8 + w * 4 + (r >> 2), tk = r & 3; const size_t qrow = (size_t)(MP + sq * SS + tk);
            const float slope = exp2f(-0.5f * (float)(h + 1)), sink = sinks[h];
            const bf16x8 qf0 = *(const bf16x8*)(U + qrow * NINP + U_SQ + h * 64 + q * 8), qf1 = *(const bf16x8*)(U + qrow * NINP + U_SQ + h * 64 + 32 + q * 8);
            f32x4 s[10]; float mx = sink;
#pragma unroll
            for (int kt = 0; kt < 10; ++kt) { const LAS bf16_t* kp = K_l + (kt * 16 + r) * 72 + q * 8;
                f32x4 d = mma16(*(const LAS bf16x8*)kp, qf0, (f32x4){0.f, 0.f, 0.f, 0.f}); d = mma16(*(const LAS bf16x8*)(kp + 32), qf1, d);
#pragma unroll
                for (int jj = 0; jj < 4; ++jj) { const int kl = kt * 16 + q * 4 + jj, dist = 128 + tk - kl;
                    const float v = (dist >= 0 && dist <= 128) ? d[jj] * 0.125f - slope * (float)dist : -1e30f; d[jj] = v; mx = fmaxf(mx, v); }
                s[kt] = d; }
            mx = fmaxf(mx, __shfl_xor(mx, 16, 64)); mx = fmaxf(mx, __shfl_xor(mx, 32, 64));
            float sum = 0.f; bf16x8 pf[5];
#pragma unroll
            for (int kp = 0; kp < 5; ++kp) { f32x4 a = s[2 * kp], bq = s[2 * kp + 1];
#pragma unroll
                for (int jj = 0; jj < 4; ++jj) { a[jj] = __expf(a[jj] - mx); bq[jj] = __expf(bq[jj] - mx); sum += a[jj] + bq[jj]; }
                pf[kp] = pack_acc(a, bq); }
            sum += __shfl_xor(sum, 16, 64); sum += __shfl_xor(sum, 32, 64);
            const float inv = 1.0f / (sum + __expf(sink - mx));
            bf16_t* op = OB + qrow * BW + h * 64 + q * 4;
#pragma unroll
            for (int dt = 0; dt < 4; ++dt) { f32x4 o = (f32x4){0.f, 0.f, 0.f, 0.f};
#pragma unroll
                for (int kp = 0; kp < 5; ++kp) o = mma16(*(const LAS bf16x8*)(VT_l + (dt * 16 + r) * 168 + kp * 32 + q * 8), pf[kp], o);
                u32x2 ov; ov.x = pk2(o[0] * inv, o[1] * inv); ov.y = pk2(o[2] * inv, o[3] * inv); *(u32x2*)(op + dt * 16) = ov; }
        }
        __syncthreads();
    }
}

__device__ __forceinline__ void ph_lrw(const Ctx& c, const float* __restrict__ w2, const float* __restrict__ a2, const float* __restrict__ g2, bf16_t* __restrict__ LRW) {
    for (int idx = c.bid * 512 + c.tid; idx < NL * 256 * 1024; idx += c.G * 512) {
        const int ch = idx & 1023, j = (idx >> 10) & 255, l = idx >> 18;
        const float v = j < 64 ? w2[((size_t)l * 64 + j) * BW + ch] : (j < 128 ? a2[((size_t)l * 64 + j - 64) * BW + ch] : g2[((size_t)l * 128 + j - 128) * BW + ch]);
        LRW[((size_t)l * 1024 + ch) * 256 + j] = f2bf(v);
    }
}
constexpr int RWP_UNITS = (MP / 64) * 4 + SB * 4;
__device__ __forceinline__ void rwp_unit_info(int u, int& row0, int& ntok, int& hg, int& sq, bool& seq_first) {
    if (u < (MP / 64) * 4) { const int blk = u >> 2; hg = u & 3; row0 = blk * 64; ntok = 64; sq = -1; seq_first = (row0 % PS) == 0; }
    else { const int s = u - (MP / 64) * 4; sq = s >> 2; hg = s & 3; row0 = MP + sq * SS; ntok = SS; seq_first = true; }
}
__device__ __forceinline__ void ph_rwkv_pre(const Ctx& c, const bf16_t* __restrict__ U, const float* __restrict__ shift, const float* __restrict__ mu, const float* __restrict__ w0, const float* __restrict__ w2,
                                            const float* __restrict__ a0, const float* __restrict__ a2, const float* __restrict__ g2, const float* __restrict__ k_k, const float* __restrict__ k_a,
                                            const float* __restrict__ r_k, float* __restrict__ RW, bf16_t* __restrict__ RB, const bf16_t* __restrict__ LRW) {
    LAS bf16_t* P_l = (LAS bf16_t*)c.lds; LAS bf16_t* Kn_l = P_l + 4608; LAS bf16_t* Bn_l = Kn_l + 4608; LAS bf16_t* Q_l = Bn_l + 4608;
    LAS bf16_t* PT_l = Q_l + 4608; LAS bf16_t* BhT_l = PT_l + 4608; LAS bf16_t* KhT_l = BhT_l + 4608; LAS bf16_t* VT_l = KhT_l + 4608;
    LAS float* A_l = (LAS float*)(c.lds + 73728);
    LAS bf16_t* BmT_l = (LAS bf16_t*)(c.lds + 78848); LAS bf16_t* F_l = (LAS bf16_t*)(c.lds + 81920); LAS bf16_t* Tinv_l = (LAS bf16_t*)(c.lds + 84992);
    LAS bf16_t* PpT_l = (LAS bf16_t*)(c.lds + 88064);
    LAS bf16_t* BmpT_l = (LAS bf16_t*)(c.lds + 97280);
    LAS float* GC_l = (LAS float*)(c.lds + 100352);
    LAS float* lg_l = (LAS float*)(c.lds + 125952);
    LAS bf16_t* act_l = (LAS bf16_t*)c.lds;
    LAS bf16_t* wT_l = act_l + 64 * 264;
    LAS bf16_t* aT_l = wT_l + 64 * 72;
    LAS bf16_t* gT_l = aT_l + 64 * 72;
    LAS float* pre_l = (LAS float*)(c.lds + 73728);
    const int tid = c.tid, lane = c.lane, r = lane & 15, q = lane >> 4, w = c.wave;
    bf16_t* Gg = (bf16_t*)(RW + 6 * (size_t)MPAD * BW); bf16_t* BON = (bf16_t*)(RW + 7 * (size_t)MPAD * BW);
    for (int u = c.bid; u < RWP_UNITS; u += c.G) {
        int row0, ntok, hg, sq; bool seq_first; rwp_unit_info(u, row0, ntok, hg, sq, seq_first);
        const float* sh = sq >= 0 ? shift + (size_t)sq * RWC : nullptr;
        const int nstage = ntok == 64 ? 64 : 16;
        for (int idx = tid; idx < nstage * 32; idx += 512) {
            const int t = idx >> 5, c8 = idx & 31, cc = 3072 + c8 * 8; float val[8];
#pragma unroll
            for (int e2 = 0; e2 < 8; ++e2) val[e2] = 0.f;
            if (t < ntok) { const bf16_t* ur = U + (size_t)(row0 + t) * NINP + U_RU; float x[8], p[8];
                unpack8(*(const u32x4*)(ur + cc), x);
                if (!(t == 0 && seq_first)) unpack8(*(const u32x4*)(ur + cc - NINP), p);
                else if (sh) { const f32x4 s0v = *(const f32x4*)(sh + cc), s1v = *(const f32x4*)(sh + cc + 4); p[0] = s0v[0]; p[1] = s0v[1]; p[2] = s0v[2]; p[3] = s0v[3]; p[4] = s1v[0]; p[5] = s1v[1]; p[6] = s1v[2]; p[7] = s1v[3]; }
                else {
#pragma unroll
                    for (int e2 = 0; e2 < 8; ++e2) p[e2] = 0.f; }
                const f32x4 m0 = *(const f32x4*)(mu + cc), m1 = *(const f32x4*)(mu + cc + 4);
#pragma unroll
                for (int e2 = 0; e2 < 8; ++e2) { const float xm = x[e2] + (p[e2] - x[e2]) * (e2 < 4 ? m0[e2] : m1[e2 - 4]); val[e2] = c8 < 8 ? tanh_fast(xm) : (c8 < 16 ? xm : sigmoidf_(xm)); } }
            *(LAS u32x4*)(act_l + t * 264 + c8 * 8) = (u32x4){pk2(val[0], val[1]), pk2(val[2], val[3]), pk2(val[4], val[5]), pk2(val[6], val[7])};
        }
        __syncthreads();
        bf16x8 af[8];
        { const int tb = w & 3;
#pragma unroll
          for (int ks = 0; ks < 8; ++ks) af[ks] = *(const LAS bf16x8*)(act_l + (tb * 16 + r) * 264 + ks * 32 + q * 8); }
        __syncthreads();
#pragma unroll 1
        for (int hh = 0; hh < 4; ++hh) { const int h = hg * 4 + hh;
        { const int tb = w & 3, chf = w >> 2;
          if (tb * 16 < nstage) {
#pragma unroll
            for (int e2 = 0; e2 < 2; ++e2) { const int cb = chf * 2 + e2; f32x4 dw = (f32x4){0.f, 0.f, 0.f, 0.f}, da = dw, dg = dw;
                const bf16_t* wr = LRW + ((size_t)h * 64 + cb * 16 + r) * 256 + q * 8; bf16x8 wf[8];
#pragma unroll
                for (int ks = 0; ks < 8; ++ks) wf[ks] = *(const bf16x8*)(wr + ks * 32);
                __builtin_amdgcn_sched_barrier(0);
#pragma unroll
                for (int ks = 0; ks < 2; ++ks) { dw = mma16(wf[ks], af[ks], dw); da = mma16(wf[2 + ks], af[2 + ks], da); }
#pragma unroll
                for (int ks = 0; ks < 4; ++ks) dg = mma16(wf[4 + ks], af[4 + ks], dg);
                const int o = (tb * 16 + r) * 68 + cb * 16 + q * 4;
                *(LAS f32x4*)(pre_l + o) = dw; *(LAS f32x4*)(pre_l + 64 * 68 + o) = da; *(LAS f32x4*)(pre_l + 2 * 64 * 68 + o) = dg; } } }
        __syncthreads();
        const int t = tid >> 3, cg = tid & 7, c0 = h * 64 + cg * 8, sc = t >> 4;
        float rr[8], k2[8], kap[8], bet[8], nlw[8];
        { float vx[8], gg[8], kkr[8]; float ss = 0.f, rk = 0.f;
          if (t < ntok) {
            const size_t row = (size_t)(row0 + t); const bf16_t* ur = U + row * NINP + U_RU; const bool fst = (t == 0 && seq_first);
            float kx[8];
#pragma unroll
            for (int part = 0; part < 3; ++part) { const int cc = part * 1024 + c0; float x[8], p[8];
                unpack8(*(const u32x4*)(ur + cc), x);
                if (!fst) unpack8(*(const u32x4*)(ur + cc - NINP), p);
                else {
#pragma unroll
                    for (int j = 0; j < 8; ++j) p[j] = sh ? sh[cc + j] : 0.f; }
                const f32x4 mA = *(const f32x4*)(mu + cc), mB = *(const f32x4*)(mu + cc + 4);
#pragma unroll
                for (int j = 0; j < 8; ++j) { const float xm = x[j] + (p[j] - x[j]) * (j < 4 ? mA[j] : mB[j - 4]); if (part == 0) rr[j] = xm; else if (part == 1) kx[j] = xm; else vx[j] = xm; } }
            float pw[8], pa[8], pkk[8], pka[8], prk[8];
#pragma unroll
            for (int hf = 0; hf < 2; ++hf) { const f32x4 v0 = *(const f32x4*)(w0 + c0 + hf * 4), v1 = *(const f32x4*)(a0 + c0 + hf * 4), v2 = *(const f32x4*)(k_k + c0 + hf * 4), v3 = *(const f32x4*)(k_a + c0 + hf * 4), v4 = *(const f32x4*)(r_k + c0 + hf * 4);
#pragma unroll
                for (int j = 0; j < 4; ++j) { pw[hf * 4 + j] = v0[j]; pa[hf * 4 + j] = v1[j]; pkk[hf * 4 + j] = v2[j]; pka[hf * 4 + j] = v3[j]; prk[hf * 4 + j] = v4[j]; } }
            float lwp[8], app[8];
#pragma unroll
            for (int hf = 0; hf < 2; ++hf) { const f32x4 v0 = *(const LAS f32x4*)(pre_l + t * 68 + cg * 8 + hf * 4), v1 = *(const LAS f32x4*)(pre_l + 64 * 68 + t * 68 + cg * 8 + hf * 4), v2 = *(const LAS f32x4*)(pre_l + 2 * 64 * 68 + t * 68 + cg * 8 + hf * 4);
#pragma unroll
                for (int j = 0; j < 4; ++j) { lwp[hf * 4 + j] = v0[j]; app[hf * 4 + j] = v1[j]; gg[hf * 4 + j] = v2[j]; } }
#pragma unroll
            for (int j = 0; j < 8; ++j) {
                const float lw = -softplus_fast(-(pw[j] + lwp[j])) - 0.5f; nlw[j] = -__expf(lw); const float av = sigmoidf_(pa[j] + app[j]);
                kkr[j] = kx[j] * pkk[j]; ss += kkr[j] * kkr[j]; k2[j] = kx[j] * (1.0f + (av - 1.0f) * pka[j]); rk += rr[j] * k2[j] * prk[j]; bet[j] = av; }
          } else {
#pragma unroll
            for (int j = 0; j < 8; ++j) { rr[j] = 0.f; k2[j] = 0.f; kkr[j] = 0.f; bet[j] = 0.f; nlw[j] = 0.f; vx[j] = 0.f; gg[j] = 0.f; }
          }
          ss += __shfl_xor(ss, 1, 64); ss += __shfl_xor(ss, 2, 64); ss += __shfl_xor(ss, 4, 64);
          rk += __shfl_xor(rk, 1, 64); rk += __shfl_xor(rk, 2, 64); rk += __shfl_xor(rk, 4, 64);
          const float inv = 1.0f / fmaxf(sqrtf(ss), 1e-12f);
#pragma unroll
          for (int j = 0; j < 8; ++j) { kap[j] = kkr[j] * inv; bet[j] = kap[j] * bet[j]; }
          if (t < ntok) { const size_t o = (size_t)(row0 + t) * BW + c0;
              *(u32x4*)(Gg + o) = (u32x4){pk2(gg[0], gg[1]), pk2(gg[2], gg[3]), pk2(gg[4], gg[5]), pk2(gg[6], gg[7])};
              *(u32x4*)(BON + o) = (u32x4){pk2(rk * vx[0], rk * vx[1]), pk2(rk * vx[2], rk * vx[3]), pk2(rk * vx[4], rk * vx[5]), pk2(rk * vx[6], rk * vx[7])}; }
          *(LAS f32x4*)(lg_l + t * 68 + cg * 8) = (f32x4){nlw[0], nlw[1], nlw[2], nlw[3]}; *(LAS f32x4*)(lg_l + t * 68 + cg * 8 + 4) = (f32x4){nlw[4], nlw[5], nlw[6], nlw[7]};
#pragma unroll
          for (int j = 0; j < 8; ++j) VT_l[(cg * 8 + j) * 72 + t] = f2bf(vx[j]);
        }
        __syncthreads();
        if (tid < 256) { const int cc = tid & 63, s4 = tid >> 6; float run = 0.f;
#pragma unroll
            for (int i = 0; i < 16; ++i) { const int o = (s4 * 16 + i) * 68 + cc; run += lg_l[o]; lg_l[o] = run; } }
        __syncthreads();
        { unsigned pp[4], pq[4], pk[4], pb[4];
#pragma unroll
          for (int j = 0; j < 8; j += 2) { float vP[2], vQ[2], vK[2], vB[2];
#pragma unroll
              for (int e = 0; e < 2; ++e) { const int jj = j + e, cc = cg * 8 + jj; const float ci = lg_l[t * 68 + cc], cC = lg_l[(sc * 16 + 15) * 68 + cc];
                  const float ei = __expf(-ci), eh = __expf(cC - ci);
                  vP[e] = kap[jj] * __expf(ci - nlw[jj]); vQ[e] = rr[jj] * __expf(ci); vK[e] = k2[jj] * ei; vB[e] = bet[jj] * ei;
                  PT_l[cc * 72 + t] = f2bf(vP[e]); BhT_l[cc * 72 + t] = f2bf(bet[jj] * eh); KhT_l[cc * 72 + t] = f2bf(k2[jj] * eh); }
              pp[j >> 1] = pk2(vP[0], vP[1]); pq[j >> 1] = pk2(vQ[0], vQ[1]); pk[j >> 1] = pk2(vK[0], vK[1]); pb[j >> 1] = pk2(vB[0], vB[1]); }
          const int o = t * 72 + cg * 8;
          *(LAS u32x4*)(P_l + o) = (u32x4){pp[0], pp[1], pp[2], pp[3]}; *(LAS u32x4*)(Q_l + o) = (u32x4){pq[0], pq[1], pq[2], pq[3]};
          *(LAS u32x4*)(Kn_l + o) = (u32x4){pk[0], pk[1], pk[2], pk[3]}; *(LAS u32x4*)(Bn_l + o) = (u32x4){pb[0], pb[1], pb[2], pb[3]};
          if ((t & 15) == 15) {
#pragma unroll
              for (int j = 0; j < 8; ++j) GC_l[sc * 64 + cg * 8 + j] = __expf(lg_l[t * 68 + cg * 8 + j]); } }
        __syncthreads();
        const int nsub = ntok == 64 ? 4 : 1;
        const bf16x8 zfrag = (bf16x8){0, 0, 0, 0, 0, 0, 0, 0};
        for (int id = w; id < nsub * 3; id += 8) { const int s4 = id / 3, prod = id - s4 * 3; f32x4 d = (f32x4){0.f, 0.f, 0.f, 0.f};
            const LAS bf16_t* X = (prod == 1 ? P_l : Bn_l) + (s4 * 16 + r) * 72 + q * 8; const LAS bf16_t* Y = (prod == 0 ? P_l : (prod == 1 ? Kn_l : Q_l)) + (s4 * 16 + r) * 72 + q * 8;
            { const bf16x8 x0 = *(const LAS bf16x8*)X, x1 = *(const LAS bf16x8*)(X + 32), y0 = *(const LAS bf16x8*)Y, y1 = *(const LAS bf16x8*)(Y + 32);
              __builtin_amdgcn_sched_barrier(0); d = mma16(x0, y0, d); d = mma16(x1, y1, d); }
            if (prod == 0) { f32x4 o4;
#pragma unroll
                for (int jj = 0; jj < 4; ++jj) o4[jj] = (q * 4 + jj < r) ? d[jj] : 0.f;
                *(LAS f32x4*)(A_l + s4 * 320 + r * 20 + q * 4) = o4; }
            else { float o4[4];
#pragma unroll
                for (int jj = 0; jj < 4; ++jj) o4[jj] = (prod == 1 ? (r < q * 4 + jj) : (q * 4 + jj <= r)) ? d[jj] : 0.f;
                u32x2 o; o.x = pk2(o4[0], o4[1]); o.y = pk2(o4[2], o4[3]); *(LAS u32x2*)((prod == 1 ? BmT_l : F_l) + s4 * 384 + r * 24 + q * 4) = o; } }
        __syncthreads();
        if (w == 0 && (lane >> 4) < nsub) { const int s4 = lane >> 4, jc = lane & 15; float x[16];
#pragma unroll
            for (int tt = 0; tt < 16; ++tt) { float s = (tt == jc) ? 1.f : 0.f;
#pragma unroll
                for (int i = 0; i < tt; ++i) s -= A_l[s4 * 320 + tt * 20 + i] * x[i];
                x[tt] = s; }
#pragma unroll
            for (int tt = 0; tt < 16; ++tt) Tinv_l[s4 * 384 + tt * 24 + jc] = f2bf(x[tt]); }
        __syncthreads();
        for (int id = w; id < nsub * 5; id += 8) { const int s4 = id / 5, rem = id - s4 * 5;
            const bf16x8 xf = q < 2 ? *(const LAS bf16x8*)(Tinv_l + s4 * 384 + r * 24 + q * 8) : zfrag;
            const bf16x8 yf = q < 2 ? (rem < 4 ? *(const LAS bf16x8*)(PT_l + (rem * 16 + r) * 72 + s4 * 16 + q * 8) : *(const LAS bf16x8*)(BmT_l + s4 * 384 + r * 24 + q * 8)) : zfrag;
            const f32x4 d = mma16(xf, yf, (f32x4){0.f, 0.f, 0.f, 0.f});
            u32x2 o; o.x = pk2(d[0], d[1]); o.y = pk2(d[2], d[3]);
            if (rem < 4) *(LAS u32x2*)(PpT_l + (rem * 16 + r) * 72 + s4 * 16 + q * 4) = o; else *(LAS u32x2*)(BmpT_l + s4 * 384 + r * 24 + q * 4) = o; }
        __syncthreads();
        { const int chunk0 = sq >= 0 ? PB * 16 * 256 + sq * 16 + h : ((row0 / PS) * 16 + h) * 256 + ((row0 % PS) >> 4);
          for (int id = w; id < nsub * 25; id += 8) { const int s4 = id / 25, rem = id - s4 * 25; bf16_t* blob = RB + (size_t)(chunk0 + s4) * RB_EL;
            const bf16x8 fF = q < 2 ? *(const LAS bf16x8*)(F_l + s4 * 384 + r * 24 + q * 8) : zfrag;
            if (rem < 4) {
                const bf16x8 xf = q < 2 ? *(const LAS bf16x8*)(PpT_l + (rem * 16 + r) * 72 + s4 * 16 + q * 8) : zfrag;
                const f32x4 d = mma16(xf, fF, (f32x4){0.f, 0.f, 0.f, 0.f});
                const u32x2 qv = *(const LAS u32x2*)(Q_l + (s4 * 16 + r) * 72 + rem * 16 + q * 4);
                u32x2 o; o.x = pk2(__uint_as_float(qv.x << 16) - d[0], __uint_as_float(qv.x & 0xffff0000u) - d[1]); o.y = pk2(__uint_as_float(qv.y << 16) - d[2], __uint_as_float(qv.y & 0xffff0000u) - d[3]);
                *(u32x2*)(blob + RB_QP + r * 72 + 32 * (rem >> 1) + 8 * q + 4 * (rem & 1)) = o;
            } else if (rem == 4) {
                f32x4 d2 = (f32x4){0.f, 0.f, 0.f, 0.f};
#pragma unroll
                for (int ks = 0; ks < 2; ++ks) d2 = mma16(*(const LAS bf16x8*)(Kn_l + (s4 * 16 + r) * 72 + ks * 32 + q * 8), *(const LAS bf16x8*)(Q_l + (s4 * 16 + r) * 72 + ks * 32 + q * 8), d2);
                const bf16x8 xf = q < 2 ? *(const LAS bf16x8*)(BmpT_l + s4 * 384 + r * 24 + q * 8) : zfrag;
                const f32x4 d1 = mma16(xf, fF, (f32x4){0.f, 0.f, 0.f, 0.f});
                float o4[4];
#pragma unroll
                for (int jj = 0; jj < 4; ++jj) o4[jj] = ((q * 4 + jj <= r) ? d2[jj] : 0.f) - d1[jj];
                u32x2 o; o.x = pk2(o4[0], o4[1]); o.y = pk2(o4[2], o4[3]); *(u32x2*)(blob + RB_EP + r * 24 + q * 4) = o;
            } else if (rem < 21) {
                const int cib = (rem - 5) >> 2, cob = (rem - 5) & 3;
                const bf16x8 xf = q < 2 ? *(const LAS bf16x8*)(PpT_l + (cib * 16 + r) * 72 + s4 * 16 + q * 8) : zfrag;
                const bf16x8 yf = q < 2 ? *(const LAS bf16x8*)(BhT_l + (cob * 16 + r) * 72 + s4 * 16 + q * 8) : zfrag;
                const f32x4 d = mma16(xf, yf, (f32x4){0.f, 0.f, 0.f, 0.f});
                const float gc = GC_l[s4 * 64 + cob * 16 + r]; float o4[4];
#pragma unroll
                for (int jj = 0; jj < 4; ++jj) o4[jj] = ((cib == cob && q * 4 + jj == r) ? gc : 0.f) - d[jj];
                u32x2 o; o.x = pk2(o4[0], o4[1]); o.y = pk2(o4[2], o4[3]); *(u32x2*)(blob + (cob * 16 + r) * 72 + 32 * (cib >> 1) + 8 * q + 4 * (cib & 1)) = o;
            } else {
                const int cb = rem - 21;
                const bf16x8 xf = q < 2 ? *(const LAS bf16x8*)(BmpT_l + s4 * 384 + r * 24 + q * 8) : zfrag;
                const bf16x8 yf = q < 2 ? *(const LAS bf16x8*)(BhT_l + (cb * 16 + r) * 72 + s4 * 16 + q * 8) : zfrag;
                const f32x4 d = mma16(xf, yf, (f32x4){0.f, 0.f, 0.f, 0.f});
                const u32x2 kv = *(const LAS u32x2*)(KhT_l + (cb * 16 + r) * 72 + s4 * 16 + q * 4);
                u32x2 o; o.x = pk2(__uint_as_float(kv.x << 16) - d[0], __uint_as_float(kv.x & 0xffff0000u) - d[1]); o.y = pk2(__uint_as_float(kv.y << 16) - d[2], __uint_as_float(kv.y & 0xffff0000u) - d[3]);
                *(u32x2*)(blob + RB_KHP + (cb * 16 + r) * 24 + q * 4) = o;
            } }
          for (int idx = tid; idx < nsub * 128; idx += 512) { const int s4 = idx >> 7, cc = (idx >> 1) & 63, hf = idx & 1;
              *(u32x4*)(RB + (size_t)(chunk0 + s4) * RB_EL + RB_VT + cc * 24 + hf * 8) = *(const LAS u32x4*)(VT_l + cc * 72 + s4 * 16 + hf * 8); } }
        __syncthreads();
        }
    }
}

__device__ __forceinline__ void ph_rwkv_scan_naive(const Ctx& c, const float* __restrict__ RW, const float* __restrict__ s0, const float* __restrict__ lng, const float* __restrict__ lnb, bf16_t* __restrict__ OB,
                                                   float* __restrict__ outP, float* __restrict__ outS) {
    const float* R = RW; const float* WD = RW + (size_t)MPAD * BW; const float* K2 = WD + (size_t)MPAD * BW; const float* V = K2 + (size_t)MPAD * BW; const float* KK = V + (size_t)MPAD * BW;
    const float* BV = KK + (size_t)MPAD * BW; const float* G = BV + (size_t)MPAD * BW; const float* BON = G + (size_t)MPAD * BW;
    const int lane = c.lane;
    for (int it = 0;; ++it) {
        const int u = (it * 8 + c.wave) * c.G + c.bid;
        if (u >= (PB + SB) * 16) break;
        const int sq = u >> 4, h = u & 15;
        int row0, L; seq_info(sq, row0, L);
        float S[64];
        if (sq >= PB) { const float* p = s0 + (((size_t)(sq - PB) * 16 + h) * 64 + lane) * 64;
#pragma unroll
            for (int j = 0; j < 64; ++j) S[j] = p[j]; }
        else {
#pragma unroll
            for (int j = 0; j < 64; ++j) S[j] = 0.f; }
        const float lg = lng[h * 64 + lane], lb = lnb[h * 64 + lane];
        for (int t = 0; t < L; ++t) {
            const size_t base = (size_t)(row0 + t) * BW + h * 64; const float v = V[base + lane];
            float d = 0.f;
#pragma unroll
            for (int j = 0; j < 64; ++j) d += S[j] * KK[base + j];
            float y = 0.f;
#pragma unroll
            for (int j = 0; j < 64; ++j) { S[j] = S[j] * WD[base + j] - d * BV[base + j] + v * K2[base + j]; y += S[j] * R[base + j]; }
            const float mean = wave_sum(y) * (1.0f / 64.0f), dy = y - mean, var = wave_sum(dy * dy) * (1.0f / 64.0f);
            const float yn = dy * rsqrtf(var + 64e-5f) * lg + lb;
            OB[base + lane] = f2bf((yn + BON[base + lane]) * G[base + lane]);
        }
        float* op = (sq < PB ? outP + (((size_t)sq * 16 + h) * 64 + lane) * 64 : outS + (((size_t)(sq - PB) * 16 + h) * 64 + lane) * 64);
#pragma unroll
        for (int j = 0; j < 64; ++j) op[j] = S[j];
    }
}
__device__ __forceinline__ void ph_rwkv_scan2(const Ctx& c, int boff, const float* __restrict__ RW, const float* __restrict__ s0, const float* __restrict__ lng, const float* __restrict__ lnb, bf16_t* __restrict__ OB,
                                              float* __restrict__ outP, float* __restrict__ outS) {
    LAS float* opb = (LAS float*)c.lds;
    LAS float* yb = opb + 2 * 16 * 384;
    const int tid = c.tid, lane = c.lane, w = c.wave, rl = lane >> 3, cg = lane & 7, vrow = w * 8 + rl;
    const float* G = RW + 6 * (size_t)MPAD * BW; const float* BON = RW + 7 * (size_t)MPAD * BW;
    for (int u = (c.bid - boff + c.G) % c.G; u < (PB + SB) * 16; u += c.G) {
        const int sq = u >> 4, h = u & 15;
        int row0, L; seq_info(sq, row0, L);
        float S[8];
        if (sq >= PB) { const float* p = s0 + (((size_t)(sq - PB) * 16 + h) * 64 + vrow) * 64 + cg * 8;
#pragma unroll
            for (int j = 0; j < 8; ++j) S[j] = p[j]; }
        else {
#pragma unroll
            for (int j = 0; j < 8; ++j) S[j] = 0.f; }
        const float lg = lng[h * 64 + lane], lb = lnb[h * 64 + lane];
        const int nb = (L + 15) >> 4;
#define RW_STAGE(bi_) do { const int t0_ = (bi_) * 16, nT_ = (L - t0_) < 16 ? (L - t0_) : 16; LAS float* dst_ = opb + ((bi_) & 1) * 16 * 384; \
        for (int idx = tid; idx < nT_ * 96; idx += 512) { const int t = idx / 96, rem = idx - t * 96, slot = rem >> 4, c4 = rem & 15; \
            const int arr = slot == 0 ? 1 : slot == 1 ? 4 : slot == 2 ? 5 : slot == 3 ? 2 : slot == 4 ? 0 : 3; \
            *(LAS f32x4*)(dst_ + t * 384 + slot * 64 + c4 * 4) = *(const f32x4*)(RW + (size_t)arr * MPAD * BW + (size_t)(row0 + t0_ + t) * BW + h * 64 + c4 * 4); } } while (0)
        RW_STAGE(0);
        for (int bi = 0; bi < nb; ++bi) {
            __syncthreads();
            if (bi + 1 < nb) RW_STAGE(bi + 1);
            const int t0 = bi * 16, nT = (L - t0) < 16 ? (L - t0) : 16; const LAS float* src = opb + (bi & 1) * 16 * 384;
            for (int tt = 0; tt < nT; ++tt) {
                const LAS float* b = src + tt * 384 + cg * 8;
                const f32x4 w0 = *(const LAS f32x4*)(b), w1 = *(const LAS f32x4*)(b + 4), k0 = *(const LAS f32x4*)(b + 64), k1 = *(const LAS f32x4*)(b + 68);
                const f32x4 b0 = *(const LAS f32x4*)(b + 128), b1 = *(const LAS f32x4*)(b + 132), q0 = *(const LAS f32x4*)(b + 192), q1 = *(const LAS f32x4*)(b + 196);
                const f32x4 r0 = *(const LAS f32x4*)(b + 256), r1 = *(const LAS f32x4*)(b + 260); const float v = src[tt * 384 + 320 + vrow];
                float d = (S[0] * k0[0] + S[1] * k0[1]) + (S[2] * k0[2] + S[3] * k0[3]) + (S[4] * k1[0] + S[5] * k1[1]) + (S[6] * k1[2] + S[7] * k1[3]);
                d += __shfl_xor(d, 1, 64); d += __shfl_xor(d, 2, 64); d += __shfl_xor(d, 4, 64);
                float y = 0.f;
#pragma unroll
                for (int j = 0; j < 4; ++j) { S[j] = S[j] * w0[j] - d * b0[j] + v * q0[j]; y += S[j] * r0[j]; S[4 + j] = S[4 + j] * w1[j] - d * b1[j] + v * q1[j]; y += S[4 + j] * r1[j]; }
                y += __shfl_xor(y, 1, 64); y += __shfl_xor(y, 2, 64); y += __shfl_xor(y, 4, 64);
                if (cg == 0) yb[tt * 64 + vrow] = y;
            }
            __syncthreads();
            for (int tt = w; tt < nT; tt += 8) {
                const float y = yb[tt * 64 + lane]; const float mean = wave_sum(y) * (1.0f / 64.0f), dy = y - mean, var = wave_sum(dy * dy) * (1.0f / 64.0f);
                const float yn = dy * rsqrtf(var + 64e-5f) * lg + lb; const size_t o = (size_t)(row0 + t0 + tt) * BW + h * 64 + lane;
                OB[o] = f2bf((yn + BON[o]) * G[o]);
            }
        }
#undef RW_STAGE
        float* op = (sq < PB ? outP + (((size_t)sq * 16 + h) * 64 + vrow) * 64 : outS + (((size_t)(sq - PB) * 16 + h) * 64 + vrow) * 64) + cg * 8;
#pragma unroll
        for (int j = 0; j < 8; ++j) op[j] = S[j];
        __syncthreads();
    }
}
constexpr int RS_SLOTS = 8, RS_SLOT_B = RB_EL * 2;
__device__ __forceinline__ void ph_rwkv_seq(const Ctx& c, int boff, const bf16_t* __restrict__ RB, const float* __restrict__ s0, float* __restrict__ outP, float* __restrict__ outS, bf16_t* __restrict__ OB) {
    const int lane = c.lane, r = lane & 15, q = lane >> 4, w = c.wave;
    LAS unsigned char* ring = c.lds;
    const int side = c.bid < 32 ? c.bid : c.bid - 64, nside = c.G - 64;
    for (int u = (c.bid >= boff && c.bid < boff + 32) ? c.bid - boff : ((c.bid < 32 || c.bid >= 96) ? 32 + side : (PB + SB) * 16); u < (PB + SB) * 16; u = u < 32 ? (PB + SB) * 16 : u + nside) {
        const int sq = u >> 4, h = u & 15;
        int nch, ch0, row0, ntok; const float* sp = nullptr; float* op;
        if (sq < PB) { nch = 256; ch0 = (sq * 16 + h) * 256; row0 = sq * PS; ntok = 16; op = outP + (size_t)(sq * 16 + h) * 4096; }
        else { nch = 1; ch0 = PB * 16 * 256 + (sq - PB) * 16 + h; row0 = MP + (sq - PB) * SS; ntok = SS; sp = s0 + (size_t)((sq - PB) * 16 + h) * 4096; op = outS + (size_t)((sq - PB) * 16 + h) * 4096; }
        if (w >= 4) {
            const int lw = w - 4, p0 = lw < 2 ? lw * 5 : 10 + (lw - 2) * 4, np = lw < 2 ? 5 : 4;
#define RS_ISSUE(ci_) do { const int cc_ = (ci_) < nch ? (ci_) : nch - 1; const char* g_ = (const char*)(RB + (size_t)(ch0 + cc_) * RB_EL) + p0 * 1024 + lane * 16; \
            LAS unsigned char* d_ = ring + ((ci_) % RS_SLOTS) * RS_SLOT_B + p0 * 1024; \
            _Pragma("unroll") for (int p_ = 0; p_ < 5; ++p_) if (p_ < np) __builtin_amdgcn_global_load_lds((const unsigned*)(g_ + p_ * 1024), (LAS unsigned*)(d_ + p_ * 1024), 16, 0, 0); } while (0)
            for (int ci = 0; ci < RS_SLOTS - 1; ++ci) RS_ISSUE(ci);
            if (lw < 2) asm volatile("s_waitcnt vmcnt(30)" ::: "memory"); else asm volatile("s_waitcnt vmcnt(24)" ::: "memory");
            __builtin_amdgcn_s_barrier();
            for (int ci = 0; ci < nch; ++ci) {
                RS_ISSUE(ci + RS_SLOTS - 1);
                if (lw < 2) asm volatile("s_waitcnt vmcnt(30)" ::: "memory"); else asm volatile("s_waitcnt vmcnt(24)" ::: "memory");
                __builtin_amdgcn_s_barrier();
            }
#undef RS_ISSUE
            asm volatile("s_waitcnt vmcnt(0)" ::: "memory");
        } else {
            const int vb = w; f32x4 acc[4];
#pragma unroll
            for (int kb = 0; kb < 4; ++kb) acc[kb] = sp ? *(const f32x4*)(sp + (size_t)(vb * 16 + r) * 64 + kb * 16 + q * 4) : (f32x4){0.f, 0.f, 0.f, 0.f};
            const bf16x8 zfrag = (bf16x8){0, 0, 0, 0, 0, 0, 0, 0};
            __builtin_amdgcn_s_barrier();
            for (int ci = 0; ci < nch; ++ci) {
                const LAS bf16_t* blob = (const LAS bf16_t*)(ring + (ci % RS_SLOTS) * RS_SLOT_B);
                bf16x8 mf[4][2], khf[4], qpf[2];
#pragma unroll
                for (int kb = 0; kb < 4; ++kb) { mf[kb][0] = *(const LAS bf16x8*)(blob + (kb * 16 + r) * 72 + q * 8); mf[kb][1] = *(const LAS bf16x8*)(blob + (kb * 16 + r) * 72 + 32 + q * 8);
                    khf[kb] = q < 2 ? *(const LAS bf16x8*)(blob + RB_KHP + (kb * 16 + r) * 24 + q * 8) : zfrag; }
                qpf[0] = *(const LAS bf16x8*)(blob + RB_QP + r * 72 + q * 8); qpf[1] = *(const LAS bf16x8*)(blob + RB_QP + r * 72 + 32 + q * 8);
                const bf16x8 vt = q < 2 ? *(const LAS bf16x8*)(blob + RB_VT + (vb * 16 + r) * 24 + q * 8) : zfrag;
                const bf16x8 ep = q < 2 ? *(const LAS bf16x8*)(blob + RB_EP + r * 24 + q * 8) : zfrag;
                const bf16x8 t0 = pack_acc(acc[0], acc[1]), t1 = pack_acc(acc[2], acc[3]);
                __builtin_amdgcn_sched_barrier(0);
#pragma unroll
                for (int kb = 0; kb < 4; ++kb) acc[kb] = mma16(mf[kb][0], t0, (f32x4){0.f, 0.f, 0.f, 0.f});
#pragma unroll
                for (int kb = 0; kb < 4; ++kb) acc[kb] = mma16(mf[kb][1], t1, acc[kb]);
#pragma unroll
                for (int kb = 0; kb < 4; ++kb) acc[kb] = mma16(khf[kb], vt, acc[kb]);
                f32x4 y = mma16(t0, qpf[0], (f32x4){0.f, 0.f, 0.f, 0.f}); y = mma16(t1, qpf[1], y); y = mma16(vt, ep, y);
                if (r < ntok) { u32x2 o; o.x = pk2(y[0], y[1]); o.y = pk2(y[2], y[3]); *(u32x2*)(OB + (size_t)(row0 + ci * 16 + r) * BW + h * 64 + vb * 16 + q * 4) = o; }
                asm volatile("s_waitcnt lgkmcnt(0)" ::: "memory");
                __builtin_amdgcn_s_barrier();
            }
#pragma unroll
            for (int kb = 0; kb < 4; ++kb) *(f32x4*)(op + (size_t)(vb * 16 + r) * 64 + kb * 16 + q * 4) = acc[kb];
        }
        __syncthreads();
    }
}
__device__ __forceinline__ void ph_rwkv_fin(const Ctx& c, const float* __restrict__ RW, const float* __restrict__ lng, const float* __restrict__ lnb, const bf16_t* __restrict__ RAW, bf16_t* __restrict__ OB) {
    const int lane = c.lane; const bf16_t* G = (const bf16_t*)(RW + 6 * (size_t)MPAD * BW); const bf16_t* BON = (const bf16_t*)(RW + 7 * (size_t)MPAD * BW);
    for (int i = c.bid * 8 + c.wave; i < MT * 4; i += c.G * 8) {
        const int row = i >> 2, cc = (i & 3) * 256 + lane * 4; const size_t o = (size_t)row * BW + cc; bf16_t* p = OB + o;
        const u32x2 raw = *(const u32x2*)(RAW + o); float x[4] = {__uint_as_float(raw.x << 16), __uint_as_float(raw.x & 0xffff0000u), __uint_as_float(raw.y << 16), __uint_as_float(raw.y & 0xffff0000u)};
        float s = (x[0] + x[1]) + (x[2] + x[3]); s += __shfl_xor(s, 1, 64); s += __shfl_xor(s, 2, 64); s += __shfl_xor(s, 4, 64); s += __shfl_xor(s, 8, 64);
        const float mean = s * (1.0f / 64.0f); float qq = 0.f;
#pragma unroll
        for (int j = 0; j < 4; ++j) { const float d = x[j] - mean; qq += d * d; }
        qq += __shfl_xor(qq, 1, 64); qq += __shfl_xor(qq, 2, 64); qq += __shfl_xor(qq, 4, 64); qq += __shfl_xor(qq, 8, 64);
        const float rstd = rsqrtf(qq * (1.0f / 64.0f) + 64e-5f);
        const f32x4 gg = *(const f32x4*)(lng + cc), bb = *(const f32x4*)(lnb + cc), bo = ld4bf(BON + o), gt = ld4bf(G + o); float ov[4];
#pragma unroll
        for (int j = 0; j < 4; ++j) ov[j] = ((x[j] - mean) * rstd * gg[j] + bb[j] + bo[j]) * gt[j];
        u32x2 oo; oo.x = pk2(ov[0], ov[1]); oo.y = pk2(ov[2], ov[3]); *(u32x2*)p = oo;
    }
}

__device__ __forceinline__ void ph_memattn_sample(const Ctx& c, int boff, const bf16_t* __restrict__ U, const float* __restrict__ mk, const float* __restrict__ mv, bf16_t* __restrict__ OB) {
    LAS float* ps = (LAS float*)c.lds;
    const int hh = c.tid >> 8, vt = c.tid & 255, lane = c.lane, r = lane & 15, q = lane >> 4, w4 = c.wave & 3;
    for (int u = (c.bid - boff + c.G) % c.G; u < SB * 2; u += c.G) {
        const int sq = u >> 1, h = (u & 1) * 2 + hh;
        bf16x8 qf[8];
#pragma unroll
        for (int ks = 0; ks < 8; ++ks) { u32x4 raw = (u32x4){0u, 0u, 0u, 0u};
            if (r < 4) raw = *(const u32x4*)(U + (size_t)(MP + sq * SS + r) * NINP + U_MQ + h * 256 + ks * 32 + q * 8);
            qf[ks] = __builtin_bit_cast(bf16x8, raw); }
#pragma unroll 1
        for (int mt = 0; mt < 4; ++mt) { const float* kr = mk + (((size_t)sq * MEMT + (w4 * 4 + mt) * 16 + r) * 4 + h) * 256 + q * 8; f32x4 ka[8], kb2[8];
#pragma unroll
            for (int ks = 0; ks < 8; ++ks) { ka[ks] = *(const f32x4*)(kr + ks * 32); kb2[ks] = *(const f32x4*)(kr + ks * 32 + 4); }
            __builtin_amdgcn_sched_barrier(0);
            f32x4 d = (f32x4){0.f, 0.f, 0.f, 0.f};
#pragma unroll
            for (int ks = 0; ks < 8; ++ks) { u32x4 p; p.x = pk2(ka[ks][0], ka[ks][1]); p.y = pk2(ka[ks][2], ka[ks][3]); p.z = pk2(kb2[ks][0], kb2[ks][1]); p.w = pk2(kb2[ks][2], kb2[ks][3]);
                d = mma16(__builtin_bit_cast(bf16x8, p), qf[ks], d); }
            if (r < 4) *(LAS f32x4*)(ps + (hh * 4 + r) * 256 + (w4 * 4 + mt) * 16 + q * 4) = d * 0.0625f; }
        __syncthreads();
        { LAS float* pr = ps + c.wave * 256; float x[4]; float mx = -3.0e38f;
#pragma unroll
            for (int j = 0; j < 4; ++j) { x[j] = pr[lane + 64 * j]; mx = fmaxf(mx, x[j]); }
            mx = wave_max(mx); float s = 0.f;
#pragma unroll
            for (int j = 0; j < 4; ++j) { x[j] = __expf(x[j] - mx); s += x[j]; }
            const float inv = 1.0f / wave_sum(s);
#pragma unroll
            for (int j = 0; j < 4; ++j) pr[lane + 64 * j] = x[j] * inv; }
        __syncthreads();
        { float o[4] = {0.f, 0.f, 0.f, 0.f}; const float* vr = mv + ((size_t)sq * MEMT * 4 + h) * 256 + vt;
#pragma unroll 8
            for (int m = 0; m < MEMT; ++m) { const float vv = vr[(size_t)m * 1024];
#pragma unroll
                for (int t = 0; t < 4; ++t) o[t] += ps[(hh * 4 + t) * 256 + m] * vv; }
#pragma unroll
            for (int t = 0; t < 4; ++t) OB[(size_t)(MP + sq * SS + t) * BW + h * 256 + vt] = f2bf(o[t]); }
        __syncthreads();
    }
}

template <int K, int LDA, int LDB> __device__ __forceinline__ void skinny_pair(const Ctx& c, const bf16_t* __restrict__ A, const bf16_t* __restrict__ B0, const bf16_t* __restrict__ B1, f32x4 (&out)[2], int rot) {
    LAS f32x4* red = (LAS f32x4*)c.lds;
    const int lane = c.lane, r = lane & 15, q = lane >> 4, w = c.wave;
    constexpr int KS = K / 8;
    const bf16_t* ap = A + (size_t)r * LDA + w * KS + q * 8; const bf16_t* b0 = B0 + (size_t)r * LDB + w * KS + q * 8; const bf16_t* b1 = B1 + (size_t)r * LDB + w * KS + q * 8;
    f32x4 acc[2][8];
#pragma unroll
    for (int n = 0; n < 2; ++n)
#pragma unroll
        for (int m = 0; m < 8; ++m) acc[n][m] = (f32x4){0.f, 0.f, 0.f, 0.f};
    int kk = (int)((unsigned)rot % (unsigned)(KS / 32));
#pragma unroll 2
    for (int it = 0; it < KS / 32; ++it) { const int ks = kk; kk = kk + 1 == KS / 32 ? 0 : kk + 1;
        const bf16x8 f0 = *(const bf16x8*)(b0 + ks * 32), f1 = *(const bf16x8*)(b1 + ks * 32); bf16x8 af[8];
#pragma unroll
        for (int m = 0; m < 8; ++m) af[m] = *(const bf16x8*)(ap + (size_t)(m * 16) * LDA + ks * 32);
        __builtin_amdgcn_sched_barrier(0);
#pragma unroll
        for (int m = 0; m < 8; ++m) { acc[0][m] = mma16(f0, af[m], acc[0][m]); acc[1][m] = mma16(f1, af[m], acc[1][m]); } }
    __syncthreads();
#pragma unroll
    for (int n = 0; n < 2; ++n)
#pragma unroll
        for (int m = 0; m < 8; ++m) red[(w * 16 + n * 8 + m) * 64 + lane] = acc[n][m];
    __syncthreads();
#pragma unroll
    for (int n = 0; n < 2; ++n) { f32x4 s = red[(n * 8 + w) * 64 + lane];
#pragma unroll
        for (int ww = 1; ww < 8; ++ww) s += red[(ww * 16 + n * 8 + w) * 64 + lane];
        out[n] = s; }
}
template <int K, int LDA, int LDB> __device__ __forceinline__ f32x4 skinny_one(const Ctx& c, const bf16_t* __restrict__ A, const bf16_t* __restrict__ B0, int rot) {
    LAS f32x4* red = (LAS f32x4*)c.lds;
    const int lane = c.lane, r = lane & 15, q = lane >> 4, w = c.wave;
    constexpr int KS = K / 8, NK = KS / 32;
    const bf16_t* ap = A + (size_t)r * LDA + w * KS + q * 8; const bf16_t* b0 = B0 + (size_t)r * LDB + w * KS + q * 8;
    f32x4 acc[8];
#pragma unroll
    for (int m = 0; m < 8; ++m) acc[m] = (f32x4){0.f, 0.f, 0.f, 0.f};
    int kk = (int)((unsigned)rot % (unsigned)NK);
#pragma unroll 4
    for (int it = 0; it < NK; ++it) { const int ks = kk; kk = kk + 1 == NK ? 0 : kk + 1;
        const bf16x8 f0 = *(const bf16x8*)(b0 + ks * 32); bf16x8 af[8];
#pragma unroll
        for (int m = 0; m < 8; ++m) af[m] = *(const bf16x8*)(ap + (size_t)(m * 16) * LDA + ks * 32);
        __builtin_amdgcn_sched_barrier(0);
#pragma unroll
        for (int m = 0; m < 8; ++m) acc[m] = mma16(f0, af[m], acc[m]); }
    __syncthreads();
#pragma unroll
    for (int m = 0; m < 8; ++m) red[(w * 8 + m) * 64 + lane] = acc[m];
    __syncthreads();
    f32x4 s = red[w * 64 + lane];
#pragma unroll
    for (int ww = 1; ww < 8; ++ww) s += red[(ww * 8 + w) * 64 + lane];
    return s;
}
__device__ __forceinline__ u32x2 pk4(const f32x4 v) { u32x2 o; o.x = pk2(v[0], v[1]); o.y = pk2(v[2], v[3]); return o; }
#define SKINNY_LOOP(total_) for (int s = c.bid - base; s >= 0 && s < (total_); s += ncu)
__device__ __forceinline__ void ph_sk_in(const Ctx& c, int base, int ncu, const bf16_t* __restrict__ HB, const bf16_t* __restrict__ W, bf16_t* __restrict__ U) {
    const int r = c.lane & 15, q = c.lane >> 4, w = c.wave;
    SKINNY_LOOP(NINP / 32) { f32x4 o[2]; skinny_pair<DM, DM, DM>(c, HB + (size_t)MP * DM, W + (size_t)(s * 32) * DM, W + (size_t)(s * 32 + 16) * DM, o, s);
        bf16_t* up = U + (size_t)(MP + w * 16 + r) * NINP + s * 32 + q * 4; *(u32x2*)up = pk4(o[0]); *(u32x2*)(up + 16) = pk4(o[1]); }
}
__device__ __forceinline__ void ph_sk_merge(const Ctx& c, int base, int ncu, const bf16_t* __restrict__ BR, const bf16_t* __restrict__ W, const bf16_t* __restrict__ U, const float* __restrict__ gate_b, bf16_t* __restrict__ MGB) {
    const int r = c.lane & 15, q = c.lane >> 4, w = c.wave;
    SKINNY_LOOP(DM / 16) { const size_t row = (size_t)(MP + w * 16 + r); const int col = s * 16 + q * 4; f32x4 tot = (f32x4){0.f, 0.f, 0.f, 0.f};
#pragma unroll 1
        for (int z = 0; z < 4; ++z) { const f32x4 o = skinny_one<BW, BW, BW>(c, BR + ((size_t)z * MPAD + MP) * BW, W + ((size_t)z * DM + s * 16) * BW, s + z);
            const u32x2 gp = *(const u32x2*)(U + row * NINP + U_GP + z * DM + col); const f32x4 gb = *(const f32x4*)(gate_b + z * DM + col);
            tot[0] += sigmoidf_(__uint_as_float(gp.x << 16) + gb[0]) * o[0]; tot[1] += sigmoidf_(__uint_as_float(gp.x & 0xffff0000u) + gb[1]) * o[1];
            tot[2] += sigmoidf_(__uint_as_float(gp.y << 16) + gb[2]) * o[2]; tot[3] += sigmoidf_(__uint_as_float(gp.y & 0xffff0000u) + gb[3]) * o[3]; }
        *(u32x2*)(MGB + row * DM + col) = pk4(tot); }
}
template <int K> __device__ __forceinline__ void ph_sk_res(const Ctx& c, int base, int ncu, const bf16_t* __restrict__ A, const bf16_t* __restrict__ W, const bf16_t* __restrict__ R, bf16_t* __restrict__ Y) {
    const int r = c.lane & 15, q = c.lane >> 4, w = c.wave;
    SKINNY_LOOP(DM / 16) { const f32x4 o = skinny_one<K, K, K>(c, A + (size_t)MP * K, W + (size_t)(s * 16) * K, s);
        const size_t off = (size_t)(MP + w * 16 + r) * DM + s * 16 + q * 4; const u32x2 rr = *(const u32x2*)(R + off);
        const f32x4 rv = (f32x4){__uint_as_float(rr.x << 16), __uint_as_float(rr.x & 0xffff0000u), __uint_as_float(rr.y << 16), __uint_as_float(rr.y & 0xffff0000u)};
        *(u32x2*)(Y + off) = pk4(rv * ALPHA + o); }
}
__device__ __forceinline__ void ph_sk_gu(const Ctx& c, int base, int ncu, const bf16_t* __restrict__ X1B, const bf16_t* __restrict__ W, bf16_t* __restrict__ ACT) {
    const int r = c.lane & 15, q = c.lane >> 4, w = c.wave;
    SKINNY_LOOP(DFF / 16) { const int t = s >> 3, j0 = (s & 7) * 16; f32x4 o[2];
        skinny_pair<DM, DM, DM>(c, X1B + (size_t)MP * DM, W + (size_t)(t * 256 + j0) * DM, W + (size_t)(t * 256 + 128 + j0) * DM, o, s);
        f32x4 v;
#pragma unroll
        for (int j = 0; j < 4; ++j) v[j] = o[0][j] * sigmoidf_(o[0][j]) * o[1][j];
        *(u32x2*)(ACT + (size_t)(MP + w * 16 + r) * DFF + t * 128 + j0 + q * 4) = pk4(v); }
}
#undef SKINNY_LOOP

constexpr int LDS_BAR_OFF = 147456;
constexpr int LDS_BYTES = LDS_BAR_OFF + 64;
struct Args { const float* in[37]; float* out; unsigned char* ws; };

typedef pg8::Gemm<DM, DM, DM, 2, 8, NL, 1, false, 0, 0, (long)DM * DM, 0> GemmMem;
typedef pg8::Gemm<DM, DM, DM, MP / 256, NINP / 256> GemmIn;
typedef pg8::Gemm<NINP, 1024, 256, PS / 256, 1, 8, 4, false, (long)PS * NINP, 256, 256 * 1024, 256> GemmScore;
typedef pg8::Gemm<256, 256, 256, PS / 256, 1, 8, 4, false, (long)4 * 4096 * 256, (long)4096 * 256, 4 * 65536, 65536> GemmPV;
typedef pg8::Gemm<BW, BW, BW, MP / 256, DM / 256, 4, 1, true, (long)MPAD * BW, 0, (long)DM * BW, 0> GemmBranch;
typedef pg8::Gemm<DM, DM, DM, MP / 256, DM / 256> GemmOut;
typedef pg8::Gemm<DM, DM, DM, MP / 256, 2 * DFF / 256> GemmGU;
typedef pg8::Gemm<DFF, DFF, DFF, MP / 256, DM / 256> GemmDown;
template <class GT> __device__ __forceinline__ GT mk_gemm(const Ctx& c, const bf16_t* A, const bf16_t* B) { GT g; g.A = A; g.B = B; g.G = c.G; g.c = c.bid; return g; }

template <int OFF> __device__ __forceinline__ unsigned long long karg_u64(unsigned long long kargs) {
    unsigned long long p; asm volatile("s_load_dwordx2 %0, %1, %2\n\ts_waitcnt lgkmcnt(0)" : "=s"(p) : "s"(kargs), "n"(OFF) : "memory"); return p;
}
#define GPTR(T, x) ((T*)(__attribute__((address_space(1))) T*)(x))
#define INP(k) GPTR(const float, karg_u64<(k) * 8>(kargs))
#define OUTP() GPTR(float, karg_u64<37 * 8>(kargs))
#define WSP() GPTR(unsigned char, karg_u64<38 * 8>(kargs))

__global__ void __launch_bounds__(512, 2) mega_fwd(Args a_unused) {
    extern __shared__ __attribute__((aligned(16))) unsigned char lds_raw[];
    const unsigned long long kargs = (unsigned long long)__builtin_amdgcn_kernarg_segment_ptr();
    Ctx c0; c0.tid = threadIdx.x; c0.lane = c0.tid & 63; c0.wave = __builtin_amdgcn_readfirstlane(c0.tid >> 6); c0.bid = blockIdx.x; c0.G = gridDim.x; c0.lds = (LAS unsigned char*)lds_raw;
    if (c0.tid < 4) ((LAS unsigned*)(c0.lds + LDS_BAR_OFF))[c0.tid] = 0u;
    __syncthreads();
    const XcdBarrier bar = xcd_barrier_post((unsigned*)(WSP() + WS_CTL), (volatile LAS unsigned*)(c0.lds + LDS_BAR_OFF));

#define WPREP_LAYER(cc_, L_) do { unsigned char* ws_ = WSP(); \
      ph_wprep(cc_, INP(10) + (size_t)(L_) * DM * NIN, (bf16_t*)(ws_ + WS_WIN) + (size_t)(L_) * NINP * DM, DM, NIN, NINP, 1, 1, 0, 0); \
      ph_wprep(cc_, INP(29) + (size_t)(L_) * 4 * BW * DM, (bf16_t*)(ws_ + WS_WBR) + (size_t)(L_) * 4 * DM * BW, BW, DM, DM, 0, 4, (size_t)BW * DM, (size_t)DM * BW); \
      ph_wprep(cc_, INP(30) + (size_t)(L_) * DM * DM, (bf16_t*)(ws_ + WS_WOUT) + (size_t)(L_) * DM * DM, DM, DM, DM, 0, 1, 0, 0); \
      ph_wprep(cc_, INP(33) + (size_t)(L_) * DM * 2 * DFF, (bf16_t*)(ws_ + WS_WGU) + (size_t)(L_) * 2 * DFF * DM, DM, 2 * DFF, 2 * DFF, 2, 1, 0, 0); \
      ph_wprep(cc_, INP(34) + (size_t)(L_) * DFF * DM, (bf16_t*)(ws_ + WS_WDN) + (size_t)(L_) * DM * DFF, DFF, DM, DM, 0, 1, 0, 0); } while (0)
    { const Ctx c = fresh(c0); unsigned char* ws = WSP();
      ph_wprep(c, INP(28), (bf16_t*)(ws + WS_WMEM), DM, DM, DM, 0, NL, (size_t)DM * DM, (size_t)DM * DM);
      WPREP_LAYER(c, 0);
      ph_lrw(c, INP(19), INP(21), INP(22), (bf16_t*)(ws + WS_LRW));
      ph_xprep(c, INP(0), INP(1), INP(2), (float*)nullptr, (bf16_t*)(ws + WS_HB), (bf16_t*)(ws + WS_MEMB)); }
    xcd_barrier(bar);
    { const Ctx c = fresh(c0); unsigned char* ws = WSP(); float* out = OUTP();
      GemmMem g = mk_gemm<GemmMem>(c, (const bf16_t*)(ws + WS_MEMB), (const bf16_t*)(ws + WS_WMEM));
      pg8::EpiMem E; E.outK = out + O_MKP; E.outV = out + O_MVP; E.kb = (bf16_t*)(ws + WS_MKB); E.vt = (bf16_t*)(ws + WS_MVT); pg8::gemm_phase<GemmMem, pg8::EpiMem, true, true>(c.lds, c.tid, g, E); }

    for (int l = 0; l < NL; ++l) {
        { const Ctx c = fresh(c0); unsigned char* ws = WSP();
          GemmIn g = mk_gemm<GemmIn>(c, (const bf16_t*)(ws + WS_HB), (const bf16_t*)(ws + WS_WIN) + (size_t)l * NINP * DM);
          pg8::EpiBf16 E; E.O = (bf16_t*)(ws + WS_U); E.zs = 0; E.ldc = NINP; E.pad = 0; pg8::gemm_phase<GemmIn, pg8::EpiBf16, true, true>(c.lds, c.tid, g, E); }
        { const Ctx c = fresh(c0); unsigned char* ws = WSP(); ph_sk_in(c, c.G > 192 ? 96 : 0, c.G > 192 ? c.G - 96 : c.G, (const bf16_t*)(ws + WS_HB), (const bf16_t*)(ws + WS_WIN) + (size_t)l * NINP * DM, (bf16_t*)(ws + WS_U)); }
        xcd_barrier(bar);
        { const Ctx c = fresh(c0); unsigned char* ws = WSP(); float* out = OUTP(); const bf16_t* U = (const bf16_t*)(ws + WS_U); bf16_t* BR = (bf16_t*)(ws + WS_BR);
          (void)out; (void)BR;
          ph_gla_pre(c, U, INP(12) + (size_t)l * 16 * 512, INP(13) + (size_t)l * 512, (bf16_t*)(ws + WS_GLQD), (bf16_t*)(ws + WS_GLKH), (bf16_t*)(ws + WS_GLE), (bf16_t*)(ws + WS_GLVT), (float*)(ws + WS_GLGC)); }
        { const Ctx c = fresh(c0); unsigned char* ws = WSP();
          ph_rwkv_pre(c, (const bf16_t*)(ws + WS_U), INP(9) + (size_t)l * SB * RWC, INP(17) + (size_t)l * RWC, INP(18) + (size_t)l * BW, INP(19) + (size_t)l * 64 * BW, INP(20) + (size_t)l * BW, INP(21) + (size_t)l * 64 * BW,
                       INP(22) + (size_t)l * 128 * BW, INP(23) + (size_t)l * BW, INP(24) + (size_t)l * BW, INP(25) + (size_t)l * BW, (float*)(ws + WS_RW), (bf16_t*)(ws + WS_RB), (const bf16_t*)(ws + WS_LRW) + (size_t)l * 1024 * 256); }
        { const Ctx c = fresh(c0); unsigned char* ws = WSP();
          GemmScore g = mk_gemm<GemmScore>(c, (const bf16_t*)(ws + WS_U) + U_MQ, (const bf16_t*)(ws + WS_MKB) + (size_t)l * 512 * 1024); g.c = (c.bid + c.G / 2) % c.G;
          pg8::EpiScore E; E.SC = (float*)(ws + WS_SC); pg8::gemm_phase<GemmScore, pg8::EpiScore, true, true>(c.lds, c.tid, g, E); }
        xcd_barrier(bar);
        { const Ctx c = fresh(c0); unsigned char* ws = WSP(); float* out = OUTP();
          ph_rwkv_seq(c, 64, (const bf16_t*)(ws + WS_RB), INP(8) + (size_t)l * SB * 16 * 4096, out + O_RWP + (size_t)l * PB * 16 * 4096, out + O_RWS + (size_t)l * SB * 16 * 4096,
                      (bf16_t*)(ws + WS_RAW) + (size_t)MPAD * BW); }
        { const Ctx c = fresh(c0); unsigned char* ws = WSP(); float* out = OUTP();
          ph_gla_seq(c, 32, (const bf16_t*)(ws + WS_GLQD), (const bf16_t*)(ws + WS_GLKH), (const bf16_t*)(ws + WS_GLE), (const bf16_t*)(ws + WS_GLVT), (const float*)(ws + WS_GLGC),
                     INP(7) + (size_t)l * SB * 4 * 32768, out + O_GLAP + (size_t)l * PB * 4 * 32768, out + O_GLAS + (size_t)l * SB * 4 * 32768, (bf16_t*)(ws + WS_RAW)); }
        if ((c0.bid < 32 || c0.bid >= 96) && c0.G > 96) {
        { Ctx c = fresh(c0); c.bid = c.bid < 32 ? c.bid : c.bid - 64; c.G = c.G - 64; unsigned char* ws = WSP(); ph_softmax256(c, (const float*)(ws + WS_SC), (bf16_t*)(ws + WS_PB), 8 * 4096); }
        { Ctx c = fresh(c0); c.bid = c.bid < 32 ? c.bid : c.bid - 64; c.G = c.G - 64; unsigned char* ws = WSP(); ph_swa_prompt(c, (const bf16_t*)(ws + WS_U), INP(16) + (size_t)l * 16, (bf16_t*)(ws + WS_BR) + (size_t)MPAD * BW); }
        { Ctx c = fresh(c0); c.bid = c.bid < 32 ? c.bid : c.bid - 64; c.G = c.G - 64; unsigned char* ws = WSP();
          ph_swa_sample(c, (const bf16_t*)(ws + WS_U), INP(3) + (size_t)l * SB * 16384, INP(4) + (size_t)l * SB * 16384, INP(16) + (size_t)l * 16, (bf16_t*)(ws + WS_BR) + (size_t)MPAD * BW); }
        { Ctx c = fresh(c0); c.bid = c.bid < 32 ? c.bid : c.bid - 64; c.G = c.G - 64; unsigned char* ws = WSP();
          ph_memattn_sample(c, 64, (const bf16_t*)(ws + WS_U), INP(5) + (size_t)l * SB * MEMT * 1024, INP(6) + (size_t)l * SB * MEMT * 1024, (bf16_t*)(ws + WS_BR) + (size_t)3 * MPAD * BW); }
        { Ctx c = fresh(c0); c.bid = c.bid < 32 ? c.bid : c.bid - 64; c.G = c.G - 64; unsigned char* ws = WSP();
          ph_copy_outs(c, (const bf16_t*)(ws + WS_U), INP(3) + (size_t)l * SB * 16384, INP(4) + (size_t)l * SB * 16384, OUTP(), l); }
          if (l + 1 < NL) { Ctx c = fresh(c0); const int sd = c.bid < 32 ? c.bid : c.bid - 64; c.G = 2 * (c.G - 64) + 96;
            c.bid = 2 * sd; WPREP_LAYER(c, l + 1); c.bid = 2 * sd + 1; WPREP_LAYER(c, l + 1); }
        } else if (l + 1 < NL && c0.G > 96) { Ctx c = fresh(c0); const int nside2 = 2 * (c.G - 64); c.G = nside2 + 96;
          if (c0.bid < 64) { c.bid = nside2 + 2 * (c0.bid - 32); WPREP_LAYER(c, l + 1); c.bid = nside2 + 2 * (c0.bid - 32) + 1; WPREP_LAYER(c, l + 1); }
          else { c.bid = nside2 + 64 + (c0.bid - 64); WPREP_LAYER(c, l + 1); }
        }
        xcd_barrier(bar);
        { const Ctx c = fresh(c0); unsigned char* ws = WSP(); ph_rwkv_fin(c, (const float*)(ws + WS_RW), INP(26) + (size_t)l * BW, INP(27) + (size_t)l * BW, (const bf16_t*)(ws + WS_RAW) + (size_t)MPAD * BW, (bf16_t*)(ws + WS_BR) + (size_t)2 * MPAD * BW); }
        { const Ctx c = fresh(c0); unsigned char* ws = WSP(); ph_gla_fin(c, (const bf16_t*)(ws + WS_U), INP(14) + (size_t)l * BW, INP(15) + (size_t)l * BW, (const bf16_t*)(ws + WS_RAW), (bf16_t*)(ws + WS_BR)); }
        { const Ctx c = fresh(c0); unsigned char* ws = WSP();
          GemmPV g = mk_gemm<GemmPV>(c, (const bf16_t*)(ws + WS_PB), (const bf16_t*)(ws + WS_MVT) + (size_t)l * 8 * 65536);
          pg8::EpiPV E; E.O = (bf16_t*)(ws + WS_BR) + (size_t)3 * MPAD * BW; pg8::gemm_phase<GemmPV, pg8::EpiPV, true, true>(c.lds, c.tid, g, E); }
        xcd_barrier(bar);
        { const Ctx c = fresh(c0); unsigned char* ws = WSP();
          GemmBranch g = mk_gemm<GemmBranch>(c, (const bf16_t*)(ws + WS_BR), (const bf16_t*)(ws + WS_WBR) + (size_t)l * 4 * DM * BW);
          pg8::EpiMerge E; E.MG = (float*)(ws + WS_MG); E.MGB = (bf16_t*)(ws + WS_MGB); E.U = (const bf16_t*)(ws + WS_U); E.gate_b = INP(11) + (size_t)l * 4 * DM; pg8::gemm_phase<GemmBranch, pg8::EpiMerge, true, true>(c.lds, c.tid, g, E); }
        { const Ctx c = fresh(c0); unsigned char* ws = WSP(); ph_sk_merge(c, 0, c.G, (const bf16_t*)(ws + WS_BR), (const bf16_t*)(ws + WS_WBR) + (size_t)l * 4 * DM * BW, (const bf16_t*)(ws + WS_U), INP(11) + (size_t)l * 4 * DM, (bf16_t*)(ws + WS_MGB)); }
        xcd_barrier(bar);
        { const Ctx c = fresh(c0); unsigned char* ws = WSP();
          GemmOut g = mk_gemm<GemmOut>(c, (const bf16_t*)(ws + WS_MGB), (const bf16_t*)(ws + WS_WOUT) + (size_t)l * DM * DM);
          pg8::EpiRes E; E.R = (const bf16_t*)(ws + WS_HB); E.Y = (bf16_t*)(ws + WS_Y); pg8::gemm_phase<GemmOut, pg8::EpiRes, true, true>(c.lds, c.tid, g, E); }
        { const Ctx c = fresh(c0); unsigned char* ws = WSP(); ph_sk_res<DM>(c, c.G > 192 ? 128 : 0, c.G > 192 ? c.G - 128 : c.G, (const bf16_t*)(ws + WS_MGB), (const bf16_t*)(ws + WS_WOUT) + (size_t)l * DM * DM, (const bf16_t*)(ws + WS_HB), (bf16_t*)(ws + WS_Y)); }
        xcd_barrier(bar);
        { const Ctx c = fresh(c0); unsigned char* ws = WSP(); ph_ln(c, (const bf16_t*)(ws + WS_Y), INP(31) + (size_t)l * DM, INP(32) + (size_t)l * DM, (float*)nullptr, (bf16_t*)(ws + WS_X1B), nullptr, MT, 0); }
        xcd_barrier(bar);
        { const Ctx c = fresh(c0); unsigned char* ws = WSP();
          GemmGU g = mk_gemm<GemmGU>(c, (const bf16_t*)(ws + WS_X1B), (const bf16_t*)(ws + WS_WGU) + (size_t)l * 2 * DFF * DM);
          pg8::EpiSwiGLU E; E.O = (bf16_t*)(ws + WS_ACT); pg8::gemm_phase<GemmGU, pg8::EpiSwiGLU, true, true>(c.lds, c.tid, g, E); }
        { const Ctx c = fresh(c0); unsigned char* ws = WSP(); ph_sk_gu(c, c.G > 192 ? 128 : 0, c.G > 192 ? c.G - 128 : c.G, (const bf16_t*)(ws + WS_X1B), (const bf16_t*)(ws + WS_WGU) + (size_t)l * 2 * DFF * DM, (bf16_t*)(ws + WS_ACT)); }
        xcd_barrier(bar);
        { const Ctx c = fresh(c0); unsigned char* ws = WSP();
          GemmDown g = mk_gemm<GemmDown>(c, (const bf16_t*)(ws + WS_ACT), (const bf16_t*)(ws + WS_WDN) + (size_t)l * DM * DFF);
          pg8::EpiRes E; E.R = (const bf16_t*)(ws + WS_X1B); E.Y = (bf16_t*)(ws + WS_Y); pg8::gemm_phase<GemmDown, pg8::EpiRes, true, true>(c.lds, c.tid, g, E); }
        { const Ctx c = fresh(c0); unsigned char* ws = WSP(); ph_sk_res<DFF>(c, 0, c.G, (const bf16_t*)(ws + WS_ACT), (const bf16_t*)(ws + WS_WDN) + (size_t)l * DM * DFF, (const bf16_t*)(ws + WS_X1B), (bf16_t*)(ws + WS_Y)); }
        xcd_barrier(bar);
        { const Ctx c = fresh(c0); unsigned char* ws = WSP(); float* out = OUTP(); ph_ln(c, (const bf16_t*)(ws + WS_Y), INP(35) + (size_t)l * DM, INP(36) + (size_t)l * DM, (float*)nullptr, (bf16_t*)(ws + WS_HB), l == NL - 1 ? out : nullptr, MT, MT); }
        xcd_barrier(bar);
    }
}

extern "C" void kernel_launch(void* const* d_in, const int* in_sizes, int n_in, void* d_out, int out_size, void* d_ws, size_t ws_size, hipStream_t stream) {
    static int grid = 0;
    if (grid == 0) {
        if (n_in != 37 || (size_t)out_size != O_END || ws_size < WS_END) { fprintf(stderr, "kernel_launch: unexpected sizes (n_in %d out %d ws %zu need %zu)\n", n_in, out_size, ws_size, (size_t)WS_END); grid = -1; return; }
        int dev = 0, cus = 0;
        if (hipGetDevice(&dev) != hipSuccess || hipDeviceGetAttribute(&cus, hipDeviceAttributeMultiprocessorCount, dev) != hipSuccess) { grid = -1; return; }
        if (hipFuncSetAttribute((const void*)mega_fwd, hipFuncAttributeMaxDynamicSharedMemorySize, LDS_BYTES) != hipSuccess) { fprintf(stderr, "kernel_launch: hipFuncSetAttribute failed\n"); grid = -1; return; }
        int per_cu = 0;
        if (hipOccupancyMaxActiveBlocksPerMultiprocessor(&per_cu, (const void*)mega_fwd, 512, LDS_BYTES) != hipSuccess || per_cu < 1) { fprintf(stderr, "kernel_launch: occupancy query says %d\n", per_cu); }
        (void)hipGetLastError();
        grid = cus;
    }
    if (grid < 0) return;
    (void)hipMemsetAsync((unsigned char*)d_ws + WS_CTL, 0, XCD_BAR_WORDS * sizeof(unsigned), stream);
    Args a; memset(&a, 0, sizeof a);
    for (int i = 0; i < 37; ++i) a.in[i] = (const float*)d_in[i];
    a.out = (float*)d_out; a.ws = (unsigned char*)d_ws;
    hipLaunchKernelGGL(mega_fwd, dim3(grid), dim3(512), LDS_BYTES, stream, a);
}
```

```cpp
#include <hip/hip_runtime.h>
#include <cstdio>
#include <cstdint>
#include <cstring>

#define LAS __attribute__((address_space(3)))
typedef unsigned short bf16_t;
typedef short bf16x8 __attribute__((ext_vector_type(8)));
typedef float f32x4 __attribute__((ext_vector_type(4)));
typedef float f32x2 __attribute__((ext_vector_type(2)));
typedef unsigned u32x4 __attribute__((ext_vector_type(4)));
typedef unsigned u32x2 __attribute__((ext_vector_type(2)));

constexpr int DM = 2048, NL = 4;
constexpr int PB = 2, PS = 4096, MP = PB * PS;
constexpr int SB = 32, SS = 4, MS = SB * SS;
constexpr int MT = MP + MS;
constexpr int MPAD = 8448;
constexpr int NIN = 16912, NINP = 17152;
constexpr int U_GQ = 0, U_GK = 512, U_GV = 1024, U_GR = 2048, U_GA = 3072, U_SQ = 3328, U_SK = 4352, U_SV = 4480, U_RU = 4608, U_MQ = 7936, U_GP = 8960;
constexpr int RWC = 3328, BW = 1024, DFF = 5632, MEMT = 256;
constexpr float ALPHA = 1.681792830507429f;

constexpr size_t O_YP = 0;
constexpr size_t O_YS = O_YP + (size_t)MP * DM;
constexpr size_t O_SWKP = O_YS + (size_t)MS * DM;
constexpr size_t O_SWVP = O_SWKP + (size_t)NL * PB * 128 * 128;
constexpr size_t O_MKP = O_SWVP + (size_t)NL * PB * 128 * 128;
constexpr size_t O_MVP = O_MKP + (size_t)NL * PB * 256 * 1024;
constexpr size_t O_GLAP = O_MVP + (size_t)NL * PB * 256 * 1024;
constexpr size_t O_RWP = O_GLAP + (size_t)NL * PB * 4 * 128 * 256;
constexpr size_t O_RSP = O_RWP + (size_t)NL * PB * 16 * 64 * 64;
constexpr size_t O_SWKS = O_RSP + (size_t)NL * PB * RWC;
constexpr size_t O_SWVS = O_SWKS + (size_t)NL * SB * 128 * 128;
constexpr size_t O_GLAS = O_SWVS + (size_t)NL * SB * 128 * 128;
constexpr size_t O_RWS = O_GLAS + (size_t)NL * SB * 4 * 128 * 256;
constexpr size_t O_RSS = O_RWS + (size_t)NL * SB * 16 * 64 * 64;
constexpr size_t O_END = O_RSS + (size_t)NL * SB * RWC;
static_assert(O_END == 52881408, "output size");

constexpr size_t al256(size_t x) { return (x + 255) & ~(size_t)255; }
constexpr size_t WS_CTL = 0;
constexpr size_t WS_WIN = 65536;
constexpr size_t WS_WMEM = WS_WIN + (size_t)NL * NINP * DM * 2;
constexpr size_t WS_WBR = WS_WMEM + (size_t)NL * DM * DM * 2;
constexpr size_t WS_WOUT = WS_WBR + (size_t)NL * 4 * DM * BW * 2;
constexpr size_t WS_WGU = WS_WOUT + (size_t)NL * DM * DM * 2;
constexpr size_t WS_WDN = WS_WGU + (size_t)NL * 2 * DFF * DM * 2;
constexpr size_t WS_HF = WS_WDN + (size_t)NL * DM * DFF * 2;
constexpr size_t WS_HB = WS_HF + (size_t)MPAD * DM * 4;
constexpr size_t WS_U = WS_HB + (size_t)MPAD * DM * 2;
constexpr size_t WS_BR = WS_U + (size_t)MPAD * NINP * 2;
constexpr size_t WS_MG = WS_BR + (size_t)4 * MPAD * BW * 2;
constexpr size_t WS_MGB = WS_MG + (size_t)MPAD * DM * 4;
constexpr size_t WS_Y = WS_MGB + (size_t)MPAD * DM * 2;
constexpr size_t WS_X1F = WS_Y + (size_t)MPAD * DM * 4;
constexpr size_t WS_X1B = WS_X1F + (size_t)MPAD * DM * 4;
constexpr size_t WS_ACT = WS_X1B + (size_t)MPAD * DM * 2;
constexpr size_t WS_MEMB = WS_ACT + (size_t)MPAD * DFF * 2;
constexpr size_t WS_MKB = WS_MEMB + (size_t)512 * DM * 2;
constexpr size_t WS_MVT = WS_MKB + (size_t)NL * 512 * 1024 * 2;
constexpr size_t WS_SC = WS_MVT + (size_t)NL * 8 * 256 * 256 * 2;
constexpr size_t WS_PB = WS_SC + (size_t)8 * 4096 * 256 * 4;
constexpr size_t WS_RW = WS_PB + (size_t)8 * 4096 * 256 * 2;
constexpr size_t RW_ARR = (size_t)MPAD * BW * 4;
constexpr int GL_NCH = 512 + 128;
constexpr size_t WS_GLQD = WS_RW + 8 * RW_ARR;
constexpr size_t WS_GLKH = WS_GLQD + (size_t)GL_NCH * 8192 * 2;
constexpr size_t WS_GLE = WS_GLKH + (size_t)GL_NCH * 8192 * 2;
constexpr size_t WS_GLVT = WS_GLE + (size_t)GL_NCH * 4096 * 2;
constexpr size_t WS_GLGC = WS_GLVT + (size_t)GL_NCH * 16384 * 2;
constexpr int RB_NCH = PB * 16 * 256 + SB * 16;
constexpr int RB_EL = 9216;
constexpr int RB_QP = 4608, RB_KHP = 5760, RB_VT = 7296, RB_EP = 8832;
constexpr size_t WS_RB = WS_GLGC + (size_t)GL_NCH * 128 * 4;
constexpr size_t WS_RAW = WS_RB + (size_t)RB_NCH * RB_EL * 2;
constexpr size_t WS_LRW = WS_RAW + (size_t)2 * MPAD * BW * 2;
constexpr size_t WS_END = WS_LRW + (size_t)NL * 16 * 64 * 256 * 2;

__device__ __forceinline__ float bf2f(bf16_t b) { return __uint_as_float(((unsigned)b) << 16); }
typedef __bf16 bf16v2_t __attribute__((ext_vector_type(2)));
__device__ __forceinline__ unsigned pk2(float lo, float hi) { const f32x2 v = {lo, hi}; return __builtin_bit_cast(unsigned, __builtin_convertvector(v, bf16v2_t)); }
__device__ __forceinline__ bf16_t f2bf(float f) { return (bf16_t)(pk2(f, 0.f) & 0xffffu); }
__device__ __forceinline__ f32x4 ld4bf(const bf16_t* p) { const u32x2 w = *(const u32x2*)p; return (f32x4){__uint_as_float(w.x << 16), __uint_as_float(w.x & 0xffff0000u), __uint_as_float(w.y << 16), __uint_as_float(w.y & 0xffff0000u)}; }
__device__ __forceinline__ float wave_sum(float v) {
#pragma unroll
    for (int o = 32; o > 0; o >>= 1) v += __shfl_xor(v, o, 64);
    return v;
}
__device__ __forceinline__ float wave_max(float v) {
#pragma unroll
    for (int o = 32; o > 0; o >>= 1) v = fmaxf(v, __shfl_xor(v, o, 64));
    return v;
}
__device__ __forceinline__ float sigmoidf_(float x) { return 1.0f / (1.0f + __expf(-x)); }
__device__ __forceinline__ float softplusf_(float x) { return fmaxf(x, 0.f) + log1pf(__expf(-fabsf(x))); }
__device__ __forceinline__ float softplus_fast(float x) { return fmaxf(x, 0.f) + __logf(1.0f + __expf(-fabsf(x))); }
__device__ __forceinline__ float tanh_fast(float x) { return 1.0f - 2.0f / (1.0f + __expf(2.0f * x)); }

namespace pg8 {
constexpr int BM = 256, BK = 64, HALF = 128, HTB = HALF * BK * 2, STAGE_BYTES = 8 * HTB, NXCD = 8, WGM = 8;
__host__ __device__ __forceinline__ int lds_byte(int r, int c) { const int st = (r >> 4) * 2 + (c >> 5), rr = r & 15, cc = c & 31, ob = rr * 64 + cc * 2; return st * 1024 + (ob ^ (((ob >> 9) & 1) << 5)); }
__host__ __device__ __forceinline__ void stage_rc(int b, int& R, int& C) { const int st = b / 1024, sb = b % 1024, swz = sb ^ (((sb >> 9) & 1) << 5); R = (st >> 1) * 16 + swz / 64; C = (st & 1) * 32 + (swz % 64) / 2; }
__host__ __device__ __forceinline__ int perm32(int rho) { const int n = rho >> 4, i = rho & 15; return 8 * (i >> 2) + 4 * n + (i & 3); }

struct Unit { int pm, pn, z; };
template <int LDA_, int LDB_, int K_, int NM_, int NN_, int NZ_ = 1, int NZH_ = 1, bool ZINNER_ = false, long ZSAB_ = 0, long ZSAH_ = 0, long ZSBB_ = 0, long ZSBH_ = 0>
struct Gemm {
    static constexpr int LDA = LDA_, LDB = LDB_, K = K_, NM = NM_, NN = NN_, NZ = NZ_, NZH = NZH_; static constexpr bool ZINNER = ZINNER_;
    const bf16_t* A; const bf16_t* B; int G, c;
    __device__ __forceinline__ bool next(int i, Unit& u) const {
        constexpr int nt = NM * NN; int L, z;
        if (ZINNER) { const int it = i / NZ; z = i - it * NZ; const long LL = (long)it * G + c; if (LL >= nt) return false; L = (int)LL; }
        else { const long LL = (long)i * G + c; if (LL >= (long)nt * NZ) return false; z = (int)(LL / nt); L = (int)(LL - (long)z * nt); }
        int wgid = L; { constexpr int q = nt / NXCD, r = nt % NXCD; const int xcd = wgid % NXCD, off = wgid / NXCD; wgid = (xcd < r ? xcd * (q + 1) : r * (q + 1) + (xcd - r) * q) + off; }
        constexpr int nig = WGM * NN; const int gid = wgid / nig, fm = gid * WGM, gsz = (NM - fm) < WGM ? (NM - fm) : WGM;
        u.pm = fm + ((wgid % nig) % gsz); u.pn = (wgid % nig) / gsz; u.z = z; return true;
    }
    __device__ __forceinline__ const char* a_base(const Unit& u) const { const int zb = u.z / NZH, zh = u.z - zb * NZH; return (const char*)(A + zb * ZSAB_ + zh * ZSAH_ + (long)u.pm * BM * LDA); }
    __device__ __forceinline__ const char* b_base(const Unit& u) const { const int zb = u.z / NZH, zh = u.z - zb * NZH; return (const char*)(B + zb * ZSBB_ + zh * ZSBH_ + (long)u.pn * BM * LDB); }
};

template <class GT, class Epi, bool ALIGN_EPI = true, bool SP2 = true>
__device__ __forceinline__ void gemm_phase(LAS unsigned char* lds, const int tid, const GT& g, const Epi& E) {
    const int wid = __builtin_amdgcn_readfirstlane(tid >> 6), lane = tid & 63, wr = wid >> 2, wc = wid & 3, fr = lane & 15, fq = lane >> 4;
    constexpr int nt = GT::K / BK;
    unsigned voffA[2], voffB[2];
#pragma unroll
    for (int i = 0; i < 2; ++i) { int R, C; stage_rc(tid * 16 + i * 8192, R, C); const int Rb = Epi::PERM ? ((R & ~31) + perm32(R & 31)) : R;
        voffA[i] = (unsigned)(R * GT::LDA + C) * 2u; voffB[i] = (unsigned)(Rb * GT::LDB + C) * 2u; }
    constexpr size_t kstep = (size_t)(BK * 2);
    constexpr size_t hstepA = (size_t)HALF * GT::LDA * 2, hstepB = (size_t)HALF * GT::LDB * 2;
    const unsigned ldsw = (unsigned)wid * 1024u;
    const int aoff = lds_byte(wr * 64 + fr, fq * 8), boff = lds_byte(wc * 32 + fr, fq * 8);
#define PG8_SA(b, h) (((b) * 2 + (h)) * HTB)
#define PG8_SB(b, h) ((4 + (b) * 2 + (h)) * HTB)
#define PG8_STAGE(bufoff, gbase, voff) do { _Pragma("unroll") for (int _i = 0; _i < 2; ++_i) \
        __builtin_amdgcn_global_load_lds((const unsigned*)((const char*)(gbase) + (voff)[_i]), (LAS unsigned*)(lds + (bufoff) + ldsw + _i * 8192), 16, 0, 0); } while (0)
#define PG8_LDA(dst, b, h) do { _Pragma("unroll") for (int m = 0; m < 4; ++m) _Pragma("unroll") for (int k = 0; k < 2; ++k) dst[m][k] = *(const LAS bf16x8*)(lds + PG8_SA(b, h) + aoff + m * 2048 + k * 1024); } while (0)
#define PG8_LDB(dst, b, h) do { _Pragma("unroll") for (int n = 0; n < 2; ++n) _Pragma("unroll") for (int k = 0; k < 2; ++k) dst[n][k] = *(const LAS bf16x8*)(lds + PG8_SB(b, h) + boff + n * 2048 + k * 1024); } while (0)
#define PG8_MMA(ai, bj, At, Bt) do { __builtin_amdgcn_s_setprio(1); _Pragma("unroll") for (int m = 0; m < 4; ++m) _Pragma("unroll") for (int n = 0; n < 2; ++n) _Pragma("unroll") for (int k = 0; k < 2; ++k) \
        acc[ai][bj][m][n] = __builtin_amdgcn_mfma_f32_16x16x32_bf16(Bt[n][k], At[m][k], acc[ai][bj][m][n], 0, 0, 0); __builtin_amdgcn_s_setprio(0); } while (0)
#define PG8_WAIT_V(n) asm volatile("s_waitcnt vmcnt(" #n ")" ::: "memory")
#define PG8_WAIT_L(n) asm volatile("s_waitcnt lgkmcnt(" #n ")" ::: "memory")
#define PG8_BAR __builtin_amdgcn_s_barrier()
#define PG8_SCHED __builtin_amdgcn_sched_barrier(0)
    Unit cur, nxt; int ui = 0;
    if (!g.next(0, cur)) return;
    f32x4 acc[2][2][4][2];
#pragma unroll
    for (int a = 0; a < 2; ++a)
#pragma unroll
        for (int b = 0; b < 2; ++b)
#pragma unroll
            for (int m = 0; m < 4; ++m)
#pragma unroll
                for (int n = 0; n < 2; ++n) acc[a][b][m][n] = (f32x4){0.f, 0.f, 0.f, 0.f};
    bf16x8 At[4][2], B0[2][2], B1[2][2];
    const char* cA = g.a_base(cur); const char* cB = g.b_base(cur);
    if constexpr (SP2) {
        PG8_STAGE(PG8_SB(0, 0), cB, voffB); PG8_STAGE(PG8_SB(0, 1), cB + hstepB, voffB); PG8_STAGE(PG8_SA(0, 0), cA, voffA); PG8_STAGE(PG8_SA(0, 1), cA + hstepA, voffA);
        if (wr == 1) PG8_BAR;
        PG8_WAIT_V(2); PG8_BAR;
        PG8_STAGE(PG8_SB(1, 0), cB + kstep, voffB); PG8_STAGE(PG8_SA(1, 0), cA + kstep, voffA); PG8_STAGE(PG8_SB(1, 1), cB + hstepB + kstep, voffB);
        PG8_WAIT_V(6); PG8_BAR;
    } else {
        PG8_STAGE(PG8_SB(0, 0), cB, voffB); PG8_STAGE(PG8_SA(0, 0), cA, voffA); PG8_STAGE(PG8_SB(0, 1), cB + hstepB, voffB); PG8_STAGE(PG8_SA(0, 1), cA + hstepA, voffA);
        if (wr == 1) PG8_BAR;
        PG8_WAIT_V(4); PG8_BAR;
        PG8_STAGE(PG8_SB(1, 0), cB + kstep, voffB); PG8_STAGE(PG8_SA(1, 0), cA + kstep, voffA); PG8_STAGE(PG8_SB(1, 1), cB + hstepB + kstep, voffB);
        PG8_WAIT_V(6); PG8_BAR;
    }
    for (;;) {
        const bool has_next = g.next(ui + 1, nxt);
        const char* nA = has_next ? g.a_base(nxt) : cA; const char* nB = has_next ? g.b_base(nxt) : cB;
#pragma unroll 1
        for (int t = 0; t < nt; t += 2) {
            const bool last = (t == nt - 2);
            const char* a1 = cA + (size_t)(t + 1) * kstep;
            const char* a2 = last ? nA : cA + (size_t)(t + 2) * kstep; const char* b2 = last ? nB : cB + (size_t)(t + 2) * kstep;
            const char* a3 = a2 + kstep; const char* b3 = b2 + kstep;
            if constexpr (SP2) {
            PG8_LDB(B0, 0, 0); PG8_LDB(B1, 0, 1); PG8_SCHED; PG8_LDA(At, 0, 0); PG8_STAGE(PG8_SA(1, 1), a1 + hstepA, voffA);
            PG8_WAIT_V(8); PG8_WAIT_L(0); PG8_BAR; PG8_MMA(0, 0, At, B0); PG8_MMA(0, 1, At, B1); PG8_BAR; PG8_SCHED;
            PG8_LDA(At, 0, 1); PG8_STAGE(PG8_SB(0, 0), b2, voffB); PG8_STAGE(PG8_SB(0, 1), b2 + hstepB, voffB); PG8_STAGE(PG8_SA(0, 0), a2, voffA);
            PG8_WAIT_V(8); PG8_WAIT_L(0); PG8_BAR; PG8_MMA(1, 0, At, B0); PG8_MMA(1, 1, At, B1); PG8_BAR; PG8_SCHED;
            PG8_LDB(B0, 1, 0); PG8_LDB(B1, 1, 1); PG8_SCHED; PG8_LDA(At, 1, 0); PG8_STAGE(PG8_SA(0, 1), a2 + hstepA, voffA);
            PG8_WAIT_V(8); PG8_WAIT_L(0); PG8_BAR; PG8_MMA(0, 0, At, B0); PG8_MMA(0, 1, At, B1); PG8_BAR; PG8_SCHED;
            PG8_LDA(At, 1, 1); PG8_STAGE(PG8_SB(1, 0), b3, voffB); PG8_STAGE(PG8_SB(1, 1), b3 + hstepB, voffB); PG8_STAGE(PG8_SA(1, 0), a3, voffA);
            PG8_WAIT_V(8); PG8_WAIT_L(0); PG8_BAR; PG8_MMA(1, 0, At, B0); PG8_MMA(1, 1, At, B1); PG8_BAR; PG8_SCHED;
            } else {
            PG8_LDB(B0, 0, 0); PG8_SCHED; PG8_LDA(At, 0, 0); PG8_STAGE(PG8_SA(1, 1), a1 + hstepA, voffA);
            PG8_WAIT_L(8); PG8_BAR; PG8_WAIT_L(0); PG8_MMA(0, 0, At, B0); PG8_BAR; PG8_SCHED;
            PG8_LDB(B1, 0, 1); PG8_STAGE(PG8_SB(0, 0), b2, voffB);
            PG8_BAR; PG8_WAIT_L(0); PG8_MMA(0, 1, At, B1); PG8_BAR;
            PG8_LDA(At, 0, 1); PG8_STAGE(PG8_SA(0, 0), a2, voffA);
            PG8_BAR; PG8_WAIT_L(0); PG8_MMA(1, 0, At, B0); PG8_BAR; PG8_SCHED;
            PG8_STAGE(PG8_SB(0, 1), b2 + hstepB, voffB);
            PG8_WAIT_V(6); PG8_BAR; PG8_MMA(1, 1, At, B1); PG8_BAR;
            PG8_LDB(B0, 1, 0); PG8_SCHED; PG8_LDA(At, 1, 0); PG8_STAGE(PG8_SA(0, 1), a2 + hstepA, voffA);
            PG8_WAIT_L(8); PG8_BAR; PG8_WAIT_L(0); PG8_MMA(0, 0, At, B0); PG8_BAR; PG8_SCHED;
            PG8_LDB(B1, 1, 1); PG8_STAGE(PG8_SB(1, 0), b3, voffB);
            PG8_BAR; PG8_WAIT_L(0); PG8_MMA(0, 1, At, B1); PG8_BAR;
            PG8_LDA(At, 1, 1); PG8_STAGE(PG8_SA(1, 0), a3, voffA);
            PG8_BAR; PG8_WAIT_L(0); PG8_MMA(1, 0, At, B0); PG8_BAR; PG8_SCHED;
            PG8_STAGE(PG8_SB(1, 1), b3 + hstepB, voffB);
            PG8_WAIT_V(6); PG8_BAR; PG8_MMA(1, 1, At, B1); PG8_BAR;
            }
        }
        if constexpr (ALIGN_EPI) { if (wr == 0) PG8_BAR; }
        E(acc, cur, wr, wc, fr, fq);
        if (!has_next) break;
#pragma unroll
        for (int a = 0; a < 2; ++a)
#pragma unroll
            for (int b = 0; b < 2; ++b)
#pragma unroll
                for (int m = 0; m < 4; ++m)
#pragma unroll
                    for (int n = 0; n < 2; ++n) acc[a][b][m][n] = (f32x4){0.f, 0.f, 0.f, 0.f};
        cur = nxt; cA = nA; cB = nB; ++ui;
        if constexpr (ALIGN_EPI) { if (wr == 1) PG8_BAR; }
    }
    PG8_WAIT_V(0);
    if constexpr (!ALIGN_EPI) { if (wr == 0) PG8_BAR; }
    PG8_BAR;
#undef PG8_SA
#undef PG8_SB
#undef PG8_STAGE
#undef PG8_LDA
#undef PG8_LDB
#undef PG8_MMA
#undef PG8_WAIT_V
#undef PG8_WAIT_L
#undef PG8_BAR
#undef PG8_SCHED
}

struct EpiBf16 {
    static constexpr bool PERM = true;
    bf16_t* O; long zs; int ldc, pad;
    __device__ __forceinline__ void operator()(const f32x4 (&acc)[2][2][4][2], const Unit& u, int wr, int wc, int fr, int fq) const {
        const int row0 = u.pm * BM + wr * 64 + fr, col0 = u.pn * BM + wc * 32 + 8 * fq; bf16_t* base = O + (long)u.z * zs;
#pragma unroll
        for (int ai = 0; ai < 2; ++ai)
#pragma unroll
            for (int m = 0; m < 4; ++m) { bf16_t* rowp = base + (size_t)(row0 + ai * HALF + m * 16) * ldc + col0;
#pragma unroll
                for (int bj = 0; bj < 2; ++bj) { const f32x4 v0 = acc[ai][bj][m][0], v1 = acc[ai][bj][m][1];
                    u32x4 w; w.x = pk2(v0[0], v0[1]); w.y = pk2(v0[2], v0[3]); w.z = pk2(v1[0], v1[1]); w.w = pk2(v1[2], v1[3]);
                    *(u32x4*)(rowp + bj * HALF) = w; } }
    }
};
struct EpiMem {
    static constexpr bool PERM = false;
    float* outK; float* outV; bf16_t* kb; bf16_t* vt;
    __device__ __forceinline__ void operator()(const f32x4 (&acc)[2][2][4][2], const Unit& u, int wr, int wc, int fr, int fq) const {
        const int row0 = u.pm * BM + wr * 64 + fr, col0 = u.pn * BM + wc * 32 + 4 * fq;
#pragma unroll
        for (int ai = 0; ai < 2; ++ai)
#pragma unroll
            for (int m = 0; m < 4; ++m) { const int row = row0 + ai * HALF + m * 16;
#pragma unroll
                for (int bj = 0; bj < 2; ++bj)
#pragma unroll
                    for (int n = 0; n < 2; ++n) { const int col = col0 + bj * HALF + n * 16; const f32x4 v = acc[ai][bj][m][n];
                        if (col < 1024) { *(f32x4*)(outK + ((size_t)u.z * 512 + row) * 1024 + col) = v;
                            u32x2 w; w.x = pk2(v[0], v[1]); w.y = pk2(v[2], v[3]); *(u32x2*)(kb + ((size_t)u.z * 512 + row) * 1024 + col) = w; }
                        else { const int c = col - 1024; *(f32x4*)(outV + ((size_t)u.z * 512 + row) * 1024 + c) = v;
                            const int b = row >> 8, mm = row & 255, h = c >> 8, d = c & 255; bf16_t* p = vt + ((((size_t)u.z * 2 + b) * 4 + h) * 256 + d) * 256 + mm;
                            p[0] = f2bf(v[0]); p[256] = f2bf(v[1]); p[512] = f2bf(v[2]); p[768] = f2bf(v[3]); } } }
    }
};
struct EpiMerge {
    static constexpr bool PERM = false;
    float* MG; bf16_t* MGB; const bf16_t* U; const float* gate_b;
    __device__ __forceinline__ void operator()(const f32x4 (&acc)[2][2][4][2], const Unit& u, int wr, int wc, int fr, int fq) const {
        const int row0 = u.pm * BM + wr * 64 + fr, col0 = u.pn * BM + wc * 32 + 4 * fq;
#pragma unroll
        for (int ai = 0; ai < 2; ++ai)
#pragma unroll
            for (int m = 0; m < 4; ++m) { const int row = row0 + ai * HALF + m * 16;
#pragma unroll
                for (int bj = 0; bj < 2; ++bj)
#pragma unroll
                    for (int n = 0; n < 2; ++n) { const int col = col0 + bj * HALF + n * 16; const f32x4 v = acc[ai][bj][m][n];
                        const u32x2 gp = *(const u32x2*)(U + (size_t)row * NINP + U_GP + u.z * DM + col); const f32x4 gb = *(const f32x4*)(gate_b + u.z * DM + col);
                        f32x4 gt; gt[0] = sigmoidf_(__uint_as_float(gp.x << 16) + gb[0]); gt[1] = sigmoidf_(__uint_as_float(gp.x & 0xffff0000u) + gb[1]);
                        gt[2] = sigmoidf_(__uint_as_float(gp.y << 16) + gb[2]); gt[3] = sigmoidf_(__uint_as_float(gp.y & 0xffff0000u) + gb[3]);
                        bf16_t* mp = MGB + (size_t)row * DM + col; f32x4 r = gt * v;
                        if (u.z > 0) r += ld4bf(mp);
                        { u32x2 w; w.x = pk2(r[0], r[1]); w.y = pk2(r[2], r[3]); *(u32x2*)mp = w; } } }
    }
};
struct EpiRes {
    static constexpr bool PERM = false;
    const bf16_t* R; bf16_t* Y;
    __device__ __forceinline__ void operator()(const f32x4 (&acc)[2][2][4][2], const Unit& u, int wr, int wc, int fr, int fq) const {
        const int row0 = u.pm * BM + wr * 64 + fr, col0 = u.pn * BM + wc * 32 + 4 * fq;
#pragma unroll
        for (int ai = 0; ai < 2; ++ai)
#pragma unroll
            for (int m = 0; m < 4; ++m) { const size_t ro = (size_t)(row0 + ai * HALF + m * 16) * DM + col0;
#pragma unroll
                for (int bj = 0; bj < 2; ++bj)
#pragma unroll
                    for (int n = 0; n < 2; ++n) { const size_t o = ro + bj * HALF + n * 16; const u32x2 rr = *(const u32x2*)(R + o);
                        const f32x4 rv = (f32x4){__uint_as_float(rr.x << 16), __uint_as_float(rr.x & 0xffff0000u), __uint_as_float(rr.y << 16), __uint_as_float(rr.y & 0xffff0000u)};
                        const f32x4 yv = rv * ALPHA + acc[ai][bj][m][n]; u32x2 yw; yw.x = pk2(yv[0], yv[1]); yw.y = pk2(yv[2], yv[3]); *(u32x2*)(Y + o) = yw; } }
    }
};
struct EpiSwiGLU {
    static constexpr bool PERM = true;
    bf16_t* O;
    __device__ __forceinline__ void operator()(const f32x4 (&acc)[2][2][4][2], const Unit& u, int wr, int wc, int fr, int fq) const {
        const int row0 = u.pm * BM + wr * 64 + fr, col0 = u.pn * HALF + wc * 32 + 8 * fq;
#pragma unroll
        for (int ai = 0; ai < 2; ++ai)
#pragma unroll
            for (int m = 0; m < 4; ++m) { bf16_t* rowp = O + (size_t)(row0 + ai * HALF + m * 16) * DFF + col0;
                float r[8];
#pragma unroll
                for (int n = 0; n < 2; ++n)
#pragma unroll
                    for (int j = 0; j < 4; ++j) { const float gg = acc[ai][0][m][n][j], uu = acc[ai][1][m][n][j]; r[n * 4 + j] = gg * sigmoidf_(gg) * uu; }
                u32x4 w; w.x = pk2(r[0], r[1]); w.y = pk2(r[2], r[3]); w.z = pk2(r[4], r[5]); w.w = pk2(r[6], r[7]);
                *(u32x4*)rowp = w; }
    }
};
struct EpiScore {
    static constexpr bool PERM = false;
    float* SC;
    __device__ __forceinline__ void operator()(const f32x4 (&acc)[2][2][4][2], const Unit& u, int wr, int wc, int fr, int fq) const {
        const int row0 = u.pm * BM + wr * 64 + fr, col0 = wc * 32 + 4 * fq; float* base = SC + (size_t)u.z * 4096 * 256;
#pragma unroll
        for (int ai = 0; ai < 2; ++ai)
#pragma unroll
            for (int m = 0; m < 4; ++m) { float* rowp = base + (size_t)(row0 + ai * HALF + m * 16) * 256 + col0;
#pragma unroll
                for (int bj = 0; bj < 2; ++bj)
#pragma unroll
                    for (int n = 0; n < 2; ++n) *(f32x4*)(rowp + bj * HALF + n * 16) = acc[ai][bj][m][n] * 0.0625f; }
    }
};
struct EpiPV {
    static constexpr bool PERM = true;
    bf16_t* O;
    __device__ __forceinline__ void operator()(const f32x4 (&acc)[2][2][4][2], const Unit& u, int wr, int wc, int fr, int fq) const {
        const int b = u.z >> 2, h = u.z & 3; const int row0 = b * PS + u.pm * BM + wr * 64 + fr, col0 = h * 256 + wc * 32 + 8 * fq;
#pragma unroll
        for (int ai = 0; ai < 2; ++ai)
#pragma unroll
            for (int m = 0; m < 4; ++m) { bf16_t* rowp = O + (size_t)(row0 + ai * HALF + m * 16) * BW + col0;
#pragma unroll
                for (int bj = 0; bj < 2; ++bj) { const f32x4 v0 = acc[ai][bj][m][0], v1 = acc[ai][bj][m][1];
                    u32x4 w; w.x = pk2(v0[0], v0[1]); w.y = pk2(v0[2], v0[3]); w.z = pk2(v1[0], v1[1]); w.w = pk2(v1[2], v1[3]);
                    *(u32x4*)(rowp + bj * HALF) = w; } }
    }
};
}


#define XB_TMO      128
#define XB_XCNT(j)  (256  + 64 * (j))
#define XB_XSUB(j)  (1280 + 64 * (j))
#define XB_XGEN(j)  (2304 + 64 * (j))
#define XB_TOP      3328
#define XB_TOPGEN   3392
#define XCD_BAR_WORDS 3456
#define XB_SPIN_CAP (1u << 18)
__device__ __forceinline__ unsigned xb_ld(unsigned* p)              { return __hip_atomic_load(p, __ATOMIC_RELAXED, __HIP_MEMORY_SCOPE_AGENT); }
__device__ __forceinline__ unsigned xb_add(unsigned* p, unsigned v) { return __hip_atomic_fetch_add(p, v, __ATOMIC_RELAXED, __HIP_MEMORY_SCOPE_AGENT); }
__device__ __forceinline__ unsigned xb_xcc_id() { return (unsigned)__builtin_amdgcn_s_getreg((3 << 11) | 20) & 0xFu; }
#define XB_SPIN(cond, bar) do { unsigned _sp = 0; while (cond) { __builtin_amdgcn_s_sleep(1); \
    if ((++_sp & 255u) == 0u) { if (xb_ld(&(bar)[XB_TMO])) break; if (_sp > XB_SPIN_CAP) { atomicAdd(&(bar)[XB_TMO], 1u); break; } } } } while (0)
struct XcdBarrier { unsigned* bar; unsigned x; volatile LAS unsigned* st; };
__device__ __forceinline__ XcdBarrier xcd_barrier_post(unsigned* bar, volatile LAS unsigned* st) {
    XcdBarrier b; b.bar = bar; b.x = xb_xcc_id(); b.st = st;
    if (threadIdx.x == 0) (void)xb_add(&bar[XB_XCNT(b.x)], 1u);
    return b;
}
__device__ __forceinline__ void xcd_barrier_complete(unsigned* bar, unsigned x, unsigned& nloc, unsigned& nx) {
    const unsigned G = gridDim.x * gridDim.y * gridDim.z;
    unsigned sum, cnt, mine, sp = 0u;
    for (;;) {
        sum = 0u; cnt = 0u; mine = 0u;
#pragma unroll
        for (unsigned j = 0; j < 16; ++j) { const unsigned c = xb_ld(&bar[XB_XCNT(j)]); sum += c; cnt += (c > 0u) ? 1u : 0u; mine = (j == x) ? c : mine; }
        if (sum == G) break;
        __builtin_amdgcn_s_sleep(1);
        if ((++sp & 255u) == 0u) { if (xb_ld(&bar[XB_TMO])) break; if (sp > XB_SPIN_CAP) { atomicAdd(&bar[XB_TMO], 1u); break; } }
    }
    nloc = mine > 0u ? mine : 1u; nx = cnt > 0u ? cnt : 1u;
}
__device__ __forceinline__ void xcd_barrier(const XcdBarrier& b) {
    asm volatile("s_waitcnt vmcnt(0)" ::: "memory");
    __syncthreads();
    if (threadIdx.x == 0) {
        unsigned* bar = b.bar;
        __builtin_amdgcn_s_waitcnt(0);
        unsigned nloc = b.st[0], nx = b.st[1];
        if (nloc == 0u) { xcd_barrier_complete(bar, b.x, nloc, nx); b.st[0] = nloc; b.st[1] = nx; }
        const unsigned old = xb_add(&bar[XB_XSUB(b.x)], 1u);
        const unsigned gen = old / nloc;
        if (old + 1u == (gen + 1u) * nloc) {
            __builtin_amdgcn_fence(__ATOMIC_RELEASE, "agent");
            asm volatile("s_waitcnt vmcnt(0)" ::: "memory");
            const unsigned og = xb_add(&bar[XB_TOP], 1u);
            const unsigned tg = og / nx;
            if (og + 1u == (tg + 1u) * nx) xb_add(&bar[XB_TOPGEN], 1u);
            else XB_SPIN(xb_ld(&bar[XB_TOPGEN]) == tg, bar);
            __builtin_amdgcn_fence(__ATOMIC_ACQUIRE, "agent");
            xb_add(&bar[XB_XGEN(b.x)], 1u);
            asm volatile("s_waitcnt vmcnt(0)" ::: "memory");
        } else {
            XB_SPIN(xb_ld(&bar[XB_XGEN(b.x)]) == gen, bar);
            __builtin_amdgcn_fence(__ATOMIC_ACQUIRE, "agent");
            asm volatile("s_waitcnt vmcnt(0)" ::: "memory");
        }
    }
    __syncthreads();
}

struct Ctx { int tid, lane, wave, bid, G; LAS unsigned char* lds; };
__device__ __forceinline__ Ctx fresh(const Ctx& c0) { Ctx c; c.wave = c0.wave; c.bid = c0.bid; c.G = c0.G; c.lds = c0.lds; asm volatile("" : "+s"(c.bid), "+s"(c.G), "+s"(c.wave));
    int lane = (int)__builtin_amdgcn_mbcnt_hi(~0u, __builtin_amdgcn_mbcnt_lo(~0u, 0u)); asm volatile("" : "+v"(lane)); c.lane = lane; c.tid = c.wave * 64 + lane; return c; }

__device__ __forceinline__ int colmap(int mode, int n) {
    if (mode == 1) return n < 3088 ? n : (n < 3328 ? -1 : n - 240);
    if (mode == 2) { const int t = n >> 8, j = n & 255; return j < 128 ? t * 128 + j : DFF + t * 128 + (j - 128); }
    return n;
}
__device__ __forceinline__ void wprep_load(f32x4 (&rg)[8], const float* __restrict__ src, int K, int Nsrc, int Ndst, int mode, size_t sbs, int item, int tid) {
    const int nx = Ndst / 256, ny = K / 64; const int bx = item % nx, by = (item / nx) % ny, bz = item / (nx * ny);
    const int tx = tid & 63, ty = tid >> 6, cm = colmap(mode, bx * 256 + tx * 4); const float* s = src + (size_t)bz * sbs + (size_t)(by * 64 + ty) * Nsrc + cm;
#pragma unroll
    for (int i = 0; i < 8; ++i) rg[i] = cm >= 0 ? *(const f32x4*)(s + (size_t)(8 * i) * Nsrc) : (f32x4){0.f, 0.f, 0.f, 0.f};
}
__device__ __forceinline__ void ph_wprep(const Ctx& c, const float* __restrict__ src, bf16_t* __restrict__ dst, int K, int Nsrc, int Ndst, int mode, int nbatch, size_t sbs, size_t dbs) {
    LAS float* tile = (LAS float*)c.lds;
    const int nx = Ndst / 256, ny = K / 64, total = nx * ny * nbatch;
    const int tid = c.tid, tx = tid & 63, ty = tid >> 6, n = tid >> 1, kh = tid & 1;
    f32x4 rg[8];
    int item = c.bid;
    if (item < total) wprep_load(rg, src, K, Nsrc, Ndst, mode, sbs, item, tid);
    for (; item < total; item += c.G) {
        __syncthreads();
#pragma unroll
        for (int i = 0; i < 8; ++i) *(LAS f32x4*)(tile + (ty + 8 * i) * 260 + tx * 4) = rg[i];
        __syncthreads();
        const int bx = item % nx, by = (item / nx) % ny, bz = item / (nx * ny);
        if (item + c.G < total) wprep_load(rg, src, K, Nsrc, Ndst, mode, sbs, item + c.G, tid);
        bf16_t* d = dst + (size_t)bz * dbs + (size_t)(bx * 256 + n) * K + by * 64 + kh * 32;
#pragma unroll
        for (int g = 0; g < 4; ++g) { unsigned p[4];
#pragma unroll
            for (int e = 0; e < 4; ++e) p[e] = pk2(tile[(kh * 32 + g * 8 + 2 * e) * 260 + n], tile[(kh * 32 + g * 8 + 2 * e + 1) * 260 + n]);
            *(u32x4*)(d + g * 8) = (u32x4){p[0], p[1], p[2], p[3]}; }
    }
    __syncthreads();
}
__device__ __forceinline__ void ph_xprep(const Ctx& c, const float* __restrict__ xp, const float* __restrict__ xs, const float* __restrict__ mem, float* __restrict__ HF, bf16_t* __restrict__ HB, bf16_t* __restrict__ MEMB) {
    const size_t nH = (size_t)MPAD * DM / 4, nM = (size_t)512 * DM / 4;
    for (size_t i4 = (size_t)c.bid * 512 + c.tid; i4 < nH + nM; i4 += (size_t)c.G * 512) {
        if (i4 < nH) {
            const size_t e = i4 * 4; f32x4 v = (f32x4){0.f, 0.f, 0.f, 0.f};
            if (e < (size_t)MP * DM) v = *(const f32x4*)(xp + e); else if (e < (size_t)MT * DM) v = *(const f32x4*)(xs + (e - (size_t)MP * DM));
            if (HF != nullptr) *(f32x4*)(HF + e) = v;
            u32x2 w; w.x = pk2(v[0], v[1]); w.y = pk2(v[2], v[3]); *(u32x2*)(HB + e) = w;
        } else {
            const size_t e = (i4 - nH) * 4; const f32x4 v = *(const f32x4*)(mem + e); u32x2 w; w.x = pk2(v[0], v[1]); w.y = pk2(v[2], v[3]); *(u32x2*)(MEMB + e) = w;
        }
    }
}
__device__ __forceinline__ void ph_ln(const Ctx& c, const bf16_t* __restrict__ Y, const float* __restrict__ g, const float* __restrict__ b, float* __restrict__ XF, bf16_t* __restrict__ XB, float* __restrict__ OUT, int nrows, int nout) {
    const int lane = c.lane;
    for (int row = c.bid * 8 + c.wave; row < nrows; row += c.G * 8) {
        const bf16_t* y = Y + (size_t)row * DM; f32x4 v[8]; float s = 0.f;
#pragma unroll
        for (int j = 0; j < 8; ++j) { const u32x2 yr = *(const u32x2*)(y + j * 256 + lane * 4);
            v[j] = (f32x4){__uint_as_float(yr.x << 16), __uint_as_float(yr.x & 0xffff0000u), __uint_as_float(yr.y << 16), __uint_as_float(yr.y & 0xffff0000u)}; s += (v[j][0] + v[j][1]) + (v[j][2] + v[j][3]); }
        const float mean = wave_sum(s) * (1.0f / DM); float q = 0.f;
#pragma unroll
        for (int j = 0; j < 8; ++j) { const f32x4 d = v[j] - mean; q += (d[0] * d[0] + d[1] * d[1]) + (d[2] * d[2] + d[3] * d[3]); }
        const float rstd = rsqrtf(wave_sum(q) * (1.0f / DM) + 1e-5f);
#pragma unroll
        for (int j = 0; j < 8; ++j) { const int cc = j * 256 + lane * 4; const f32x4 gg = *(const f32x4*)(g + cc), bb = *(const f32x4*)(b + cc);
            const f32x4 o = (v[j] - mean) * rstd * gg + bb; const size_t off = (size_t)row * DM + cc;
            if (XF != nullptr) *(f32x4*)(XF + off) = o;
            u32x2 w; w.x = pk2(o[0], o[1]); w.y = pk2(o[2], o[3]); *(u32x2*)(XB + off) = w;
            if (OUT != nullptr && row < nout) *(f32x4*)(OUT + off) = o; }
    }
}
__device__ __forceinline__ void ph_softmax256(const Ctx& c, const float* __restrict__ SC, bf16_t* __restrict__ P, int nrows) {
    const int lane = c.lane;
    for (int row = c.bid * 8 + c.wave; row < nrows; row += c.G * 8) {
        const f32x4 v = *(const f32x4*)(SC + (size_t)row * 256 + lane * 4);
        const float mx = wave_max(fmaxf(fmaxf(v[0], v[1]), fmaxf(v[2], v[3])));
        f32x4 e; e[0] = __expf(v[0] - mx); e[1] = __expf(v[1] - mx); e[2] = __expf(v[2] - mx); e[3] = __expf(v[3] - mx);
        const float inv = 1.0f / wave_sum((e[0] + e[1]) + (e[2] + e[3]));
        u32x2 w; w.x = pk2(e[0] * inv, e[1] * inv); w.y = pk2(e[2] * inv, e[3] * inv); *(u32x2*)(P + (size_t)row * 256 + lane * 4) = w;
    }
}
__device__ __forceinline__ void ph_copy_outs(const Ctx& c, const bf16_t* __restrict__ U, const float* __restrict__ ck, const float* __restrict__ cv, float* __restrict__ out, int layer) {
    constexpr int nA = PB * 128 * 128, nB = SB * 128 * 128, nC = PB * RWC, nD = SB * RWC;
    for (int i = c.bid * 512 + c.tid; i < nA + nB + nC + nD; i += c.G * 512) {
        if (i < nA) { const int b = i / 16384, j = (i >> 7) & 127, cc = i & 127; const size_t ur = (size_t)(b * PS + PS - 128 + j) * NINP;
            out[O_SWKP + (size_t)layer * nA + i] = bf2f(U[ur + U_SK + cc]); out[O_SWVP + (size_t)layer * nA + i] = bf2f(U[ur + U_SV + cc]); continue; }
        int k = i - nA;
        if (k < nB) { const int sq = k / 16384, j = (k >> 7) & 127, cc = k & 127; float kv, vv;
            if (j < 124) { const size_t o = ((size_t)sq * 128 + j + 4) * 128 + cc; kv = ck[o]; vv = cv[o]; }
            else { const size_t ur = (size_t)(MP + sq * SS + j - 124) * NINP; kv = bf2f(U[ur + U_SK + cc]); vv = bf2f(U[ur + U_SV + cc]); }
            out[O_SWKS + (size_t)layer * nB + k] = kv; out[O_SWVS + (size_t)layer * nB + k] = vv; continue; }
        k -= nB;
        if (k < nC) { const int b = k / RWC, cc = k - b * RWC; out[O_RSP + (size_t)layer * nC + k] = bf2f(U[(size_t)(b * PS + PS - 1) * NINP + U_RU + cc]); continue; }
        k -= nC;
        { const int sq = k / RWC, cc = k - sq * RWC; out[O_RSS + (size_t)layer * nD + k] = bf2f(U[(size_t)(MP + sq * SS + SS - 1) * NINP + U_RU + cc]); }
    }
}

__device__ __forceinline__ void seq_info(int sq, int& row0, int& L) { if (sq < PB) { row0 = sq * PS; L = PS; } else { row0 = MP + (sq - PB) * SS; L = SS; } }

__device__ __forceinline__ void ph_gla_naive(const Ctx& c, const bf16_t* __restrict__ U, const float* __restrict__ s0, const float* __restrict__ a_up, const float* __restrict__ a_b,
                                             const float* __restrict__ ng, const float* __restrict__ nb, bf16_t* __restrict__ OB, float* __restrict__ outP, float* __restrict__ outS) {
    LAS float* qs = (LAS float*)c.lds;
    LAS float* ks = qs + 16 * 128; LAS float* as = ks + 16 * 128; LAS float* os = as + 16 * 128;
    const int kh = c.tid >> 8, vt = c.tid & 255, lane = c.lane;
    for (int u = c.bid; u < (PB + SB) * 4; u += c.G) {
        const int sq = u >> 2, h = u & 3;
        int row0, L; seq_info(sq, row0, L);
        float S[64];
        if (sq >= PB) { const float* p = s0 + (((size_t)(sq - PB) * 4 + h) * 128 + kh * 64) * 256 + vt;
#pragma unroll
            for (int kk = 0; kk < 64; ++kk) S[kk] = p[(size_t)kk * 256]; }
        else {
#pragma unroll
            for (int kk = 0; kk < 64; ++kk) S[kk] = 0.f; }
        for (int t0 = 0; t0 < L; t0 += 16) {
            const int nT = (L - t0) < 16 ? (L - t0) : 16;
            for (int idx = c.tid; idx < nT * 128; idx += 512) {
                const int tt = idx >> 7, kk = idx & 127; const bf16_t* ur = U + (size_t)(row0 + t0 + tt) * NINP;
                qs[idx] = bf2f(ur[U_GQ + h * 128 + kk]) * 0.08838834764831845f; ks[idx] = bf2f(ur[U_GK + h * 128 + kk]);
                float x = a_b[h * 128 + kk];
#pragma unroll
                for (int r = 0; r < 16; ++r) x += bf2f(ur[U_GA + r]) * a_up[r * 512 + h * 128 + kk];
                const float ls = (fminf(x, 0.f) - log1pf(__expf(-fabsf(x)))) * (1.0f / 16.0f);
                as[idx] = __expf(ls);
            }
            __syncthreads();
            for (int tt = 0; tt < nT; ++tt) {
                const float v = bf2f(U[(size_t)(row0 + t0 + tt) * NINP + U_GV + h * 256 + vt]); float o = 0.f; const int lb = tt * 128 + kh * 64;
#pragma unroll
                for (int kk = 0; kk < 64; ++kk) { S[kk] = as[lb + kk] * S[kk] + ks[lb + kk] * v; o += qs[lb + kk] * S[kk]; }
                os[(kh * 16 + tt) * 256 + vt] = o;
            }
            __syncthreads();
            for (int tt = c.wave; tt < nT; tt += 8) {
                float x[4]; float s = 0.f;
#pragma unroll
                for (int j = 0; j < 4; ++j) { x[j] = os[tt * 256 + lane + 64 * j] + os[(16 + tt) * 256 + lane + 64 * j]; s += x[j]; }
                const float mean = wave_sum(s) * (1.0f / 256.0f); float q = 0.f;
#pragma unroll
                for (int j = 0; j < 4; ++j) { const float d = x[j] - mean; q += d * d; }
                const float rstd = rsqrtf(wave_sum(q) * (1.0f / 256.0f) + 1e-5f);
                const size_t row = (size_t)(row0 + t0 + tt);
#pragma unroll
                for (int j = 0; j < 4; ++j) { const int cc = h * 256 + lane + 64 * j; const float n = (x[j] - mean) * rstd * ng[cc] + nb[cc];
                    const float gr = bf2f(U[row * NINP + U_GR + cc]); OB[row * BW + cc] = f2bf(n * gr * sigmoidf_(gr)); }
            }
            __syncthreads();
        }
        float* op = (sq < PB ? outP + (((size_t)sq * 4 + h) * 128 + kh * 64) * 256 : outS + (((size_t)(sq - PB) * 4 + h) * 128 + kh * 64) * 256) + vt;
#pragma unroll
        for (int kk = 0; kk < 64; ++kk) op[(size_t)kk * 256] = S[kk];
    }
}

__device__ __forceinline__ f32x4 mma16(bf16x8 x, bf16x8 y, f32x4 c) { return __builtin_amdgcn_mfma_f32_16x16x32_bf16(x, y, c, 0, 0, 0); }
__device__ __forceinline__ bf16x8 pack_acc(const f32x4& a, const f32x4& b) {
    u32x4 p; p.x = pk2(a[0], a[1]); p.y = pk2(a[2], a[3]); p.z = pk2(b[0], b[1]); p.w = pk2(b[2], b[3]); return __builtin_bit_cast(bf16x8, p);
}
__device__ __forceinline__ void gla_chunk_info(int u, int& row0, int& ntok, int& h) {
    if (u < 512) { const int b = u >> 8; h = (u >> 6) & 3; row0 = b * PS + (u & 63) * 64; ntok = 64; }
    else { const int s = u - 512; h = s & 3; row0 = MP + (s >> 2) * SS; ntok = SS; }
}
__device__ __forceinline__ void ph_gla_pre(const Ctx& c, const bf16_t* __restrict__ U, const float* __restrict__ a_up, const float* __restrict__ a_b,
                                           bf16_t* __restrict__ QD, bf16_t* __restrict__ KHT, bf16_t* __restrict__ EE, bf16_t* __restrict__ VT, float* __restrict__ GC) {
    LAS float* ga_l = (LAS float*)c.lds;
    LAS float* tot = ga_l + 64 * 16;
    LAS bf16_t* Qd_l = (LAS bf16_t*)(tot + 4 * 128);
    LAS bf16_t* Kn_l = Qd_l + 64 * 136;
    LAS bf16_t* v_l = Kn_l + 64 * 136;
    LAS bf16_t* qr_l = v_l + 64 * 264;
    LAS bf16_t* kr_l = qr_l + 64 * 136;
    const int tid = c.tid, lane = c.lane, r = lane & 15, q = lane >> 4, w = c.wave;
    for (int u = (c.bid + c.G / 2) % c.G; u < GL_NCH; u += c.G) {
        int row0, ntok, h; gla_chunk_info(u, row0, ntok, h);
        for (int i = tid; i < 64 * 16; i += 512) { const int t = i >> 4, rr = i & 15; ga_l[i] = t < ntok ? bf2f(U[(size_t)(row0 + t) * NINP + U_GA + rr]) : 0.f; }
        for (int i = tid; i < 64 * 32; i += 512) { const int t = i >> 5, c8 = i & 31; u32x4 vv = (u32x4){0u, 0u, 0u, 0u};
            if (t < ntok) vv = *(const u32x4*)(U + (size_t)(row0 + t) * NINP + U_GV + h * 256 + c8 * 8);
            *(LAS u32x4*)(v_l + t * 264 + c8 * 8) = vv; }
        for (int i = tid; i < 64 * 16; i += 512) { const int t = i >> 4, c8 = i & 15; u32x4 qv = (u32x4){0u, 0u, 0u, 0u}, kv = qv;
            if (t < ntok) { const bf16_t* ur = U + (size_t)(row0 + t) * NINP + h * 128 + c8 * 8; qv = *(const u32x4*)(ur + U_GQ); kv = *(const u32x4*)(ur + U_GK); }
            *(LAS u32x4*)(qr_l + t * 136 + c8 * 8) = qv; *(LAS u32x4*)(kr_l + t * 136 + c8 * 8) = kv; }
        __syncthreads();
        const int kk = tid & 127, tq = tid >> 7;
        float cum[16];
        { float aup[16];
#pragma unroll
          for (int rr = 0; rr < 16; ++rr) aup[rr] = a_up[rr * 512 + h * 128 + kk];
          const float ab = a_b[h * 128 + kk]; float run = 0.f;
#pragma unroll
          for (int j = 0; j < 16; ++j) { const int t = tq * 16 + j; float x = ab;
#pragma unroll
              for (int rr = 0; rr < 16; ++rr) x += ga_l[t * 16 + rr] * aup[rr];
              const float la = t < ntok ? (fminf(x, 0.f) - __logf(1.0f + __expf(-fabsf(x)))) * (1.0f / 16.0f) : 0.f;
              run += la; cum[j] = run; }
          tot[tq * 128 + kk] = run; }
        __syncthreads();
        { float prefix = 0.f, bC = 0.f;
#pragma unroll
          for (int g = 0; g < 4; ++g) { const float tv = tot[g * 128 + kk]; bC += tv; if (g < tq) prefix += tv; }
          unsigned khp[8];
#pragma unroll
          for (int j = 0; j < 16; j += 2) { float kh2[2];
#pragma unroll
              for (int e = 0; e < 2; ++e) { const int t = tq * 16 + j + e; const float b = prefix + cum[j + e]; const float qv = bf2f(qr_l[t * 136 + kk]), kv = bf2f(kr_l[t * 136 + kk]);
                  Qd_l[t * 136 + kk] = f2bf(qv * __expf(b) * 0.08838834764831845f); Kn_l[t * 136 + kk] = f2bf(kv * __expf(-b)); kh2[e] = kv * __expf(bC - b); }
              khp[j >> 1] = pk2(kh2[0], kh2[1]); }
          bf16_t* kp = KHT + (size_t)u * 8192 + kk * 64 + tq * 16;
          *(u32x4*)kp = (u32x4){khp[0], khp[1], khp[2], khp[3]}; *(u32x4*)(kp + 8) = (u32x4){khp[4], khp[5], khp[6], khp[7]};
          if (tq == 0) GC[(size_t)u * 128 + kk] = __expf(bC); }
        __syncthreads();
        { const int tb = w >> 1;
#pragma unroll
          for (int e = 0; e < 2; ++e) { const int ib = (w & 1) * 2 + e; f32x4 d = (f32x4){0.f, 0.f, 0.f, 0.f};
              if (ib <= tb) {
                  bf16x8 kf4[4], qf4[4];
#pragma unroll
                  for (int ks = 0; ks < 4; ++ks) { kf4[ks] = *(const LAS bf16x8*)(Kn_l + (ib * 16 + r) * 136 + ks * 32 + q * 8); qf4[ks] = *(const LAS bf16x8*)(Qd_l + (tb * 16 + r) * 136 + ks * 32 + q * 8); }
                  __builtin_amdgcn_sched_barrier(0);
#pragma unroll
                  for (int ks = 0; ks < 4; ++ks) d = mma16(kf4[ks], qf4[ks], d); }
              const int t = tb * 16 + r, i0 = ib * 16 + q * 4;
#pragma unroll
              for (int jj = 0; jj < 4; ++jj) if (i0 + jj > t) d[jj] = 0.f;
              u32x2 o; o.x = pk2(d[0], d[1]); o.y = pk2(d[2], d[3]); *(u32x2*)(EE + (size_t)u * 4096 + t * 64 + i0) = o; } }
        for (int i = tid; i < 64 * 16; i += 512) { const int t = i >> 4, c8 = i & 15; *(u32x4*)(QD + (size_t)u * 8192 + t * 128 + c8 * 8) = *(const LAS u32x4*)(Qd_l + t * 136 + c8 * 8); }
        { const int val = tid & 255, th = tid >> 8;
#pragma unroll
          for (int tg = 0; tg < 4; ++tg) { const int t0 = th * 32 + tg * 8; unsigned p4[4];
#pragma unroll
              for (int e = 0; e < 4; ++e) p4[e] = (unsigned)v_l[(t0 + 2 * e) * 264 + val] | ((unsigned)v_l[(t0 + 2 * e + 1) * 264 + val] << 16);
              *(u32x4*)(VT + (size_t)u * 16384 + val * 64 + t0) = (u32x4){p4[0], p4[1], p4[2], p4[3]}; } }
        __syncthreads();
    }
}
struct GlaStage { u32x4 qd[2], kh[2], e, vt, gc; };
__device__ __forceinline__ void gla_stage_load(GlaStage& s, const bf16_t* __restrict__ QD, const bf16_t* __restrict__ KHT, const bf16_t* __restrict__ EE, const bf16_t* __restrict__ VT, const float* __restrict__ GC,
                                               int ch, int sl, int tid) {
    const bf16_t* qp = QD + (size_t)ch * 8192 + tid * 8; s.qd[0] = *(const u32x4*)qp; s.qd[1] = *(const u32x4*)(qp + 4096);
    const bf16_t* kp = KHT + (size_t)ch * 8192 + tid * 8; s.kh[0] = *(const u32x4*)kp; s.kh[1] = *(const u32x4*)(kp + 4096);
    s.e = *(const u32x4*)(EE + (size_t)ch * 4096 + tid * 8);
    s.vt = *(const u32x4*)(VT + (size_t)ch * 16384 + sl * 4096 + tid * 8);
    if (tid < 32) s.gc = *(const u32x4*)(GC + (size_t)ch * 128 + tid * 4);
}
constexpr int GS_KH = 8704, GS_E = 17920, GS_VT = 22528, GS_GC = 27136, GS_EL = 27392;
__device__ __forceinline__ void gla_stage_store(const GlaStage& s, LAS bf16_t* b, int tid) {
    *(LAS u32x4*)(b + (tid >> 4) * 136 + (tid & 15) * 8) = s.qd[0]; *(LAS u32x4*)(b + (32 + (tid >> 4)) * 136 + (tid & 15) * 8) = s.qd[1];
    *(LAS u32x4*)(b + GS_KH + (tid >> 3) * 72 + (tid & 7) * 8) = s.kh[0]; *(LAS u32x4*)(b + GS_KH + (64 + (tid >> 3)) * 72 + (tid & 7) * 8) = s.kh[1];
    *(LAS u32x4*)(b + GS_E + (tid >> 3) * 72 + (tid & 7) * 8) = s.e; *(LAS u32x4*)(b + GS_VT + (tid >> 3) * 72 + (tid & 7) * 8) = s.vt;
    if (tid < 32) *(LAS u32x4*)(b + GS_GC + tid * 8) = s.gc;
}
__device__ __forceinline__ void ph_gla_seq(const Ctx& c, int boff, const bf16_t* __restrict__ QD, const bf16_t* __restrict__ KHT, const bf16_t* __restrict__ EE, const bf16_t* __restrict__ VT, const float* __restrict__ GC,
                                           const float* __restrict__ s0, float* __restrict__ outP, float* __restrict__ outS, bf16_t* __restrict__ OB) {
    LAS bf16_t* stg = (LAS bf16_t*)c.lds;
    LAS bf16_t* T_l = stg + 2 * GS_EL;
    const int tid = c.tid, lane = c.lane, r = lane & 15, q = lane >> 4, w = c.wave;
    const int side = c.bid < 32 ? c.bid : c.bid - 64, nside = c.G - 64;
    for (int u = (c.bid >= boff && c.bid < boff + 32) ? c.bid - boff : ((c.bid < 32 || c.bid >= 96) ? 32 + side : 32 + 512); u < 32 + 512; u = u < 32 ? 32 + 512 : u + nside) {
        int h, sl, nch, ch0, row0, ntok; const float* sp = nullptr; float* op;
        if (u < 32) { const int b = u >> 4; h = (u >> 2) & 3; sl = u & 3; nch = 64; ch0 = (b * 4 + h) * 64; row0 = b * PS; ntok = 64; op = outP + (size_t)(b * 4 + h) * 32768; }
        else { const int s = u - 32, sq = s >> 4; h = (s >> 2) & 3; sl = s & 3; nch = 1; ch0 = 512 + sq * 4 + h; row0 = MP + sq * SS; ntok = SS; sp = s0 + (size_t)(sq * 4 + h) * 32768; op = outS + (size_t)(sq * 4 + h) * 32768; }
        f32x4 acc[4];
#pragma unroll
        for (int vb = 0; vb < 4; ++vb)
#pragma unroll
            for (int jj = 0; jj < 4; ++jj) acc[vb][jj] = sp ? sp[(size_t)(w * 16 + q * 4 + jj) * 256 + sl * 64 + vb * 16 + r] : 0.f;
        GlaStage R0, R1, R2;
        gla_stage_load(R0, QD, KHT, EE, VT, GC, ch0, sl, tid);
        if (1 < nch) gla_stage_load(R1, QD, KHT, EE, VT, GC, ch0 + 1, sl, tid);
        if (2 < nch) gla_stage_load(R2, QD, KHT, EE, VT, GC, ch0 + 2, sl, tid);
        __syncthreads();
        gla_stage_store(R0, stg, tid);
        if (3 < nch) gla_stage_load(R0, QD, KHT, EE, VT, GC, ch0 + 3, sl, tid);
#define GLA_STEP(ci, RN) do { \
            LAS bf16_t* Tb = T_l + ((ci) & 1) * 64 * 136; const LAS bf16_t* sb = stg + ((ci) & 1) * GS_EL; \
            _Pragma("unroll") for (int vb = 0; vb < 4; ++vb) { u32x2 o; o.x = pk2(acc[vb][0], acc[vb][1]); o.y = pk2(acc[vb][2], acc[vb][3]); *(LAS u32x2*)(Tb + (vb * 16 + r) * 136 + w * 16 + q * 4) = o; } \
            __syncthreads(); \
            if ((ci) + 1 < nch) { gla_stage_store(RN, stg + (((ci) + 1) & 1) * GS_EL, tid); if ((ci) + 4 < nch) gla_stage_load(RN, QD, KHT, EE, VT, GC, ch0 + (ci) + 4, sl, tid); } \
            { const int rb = w >> 1, t = rb * 16 + r; bf16x8 qf[4], ef[2]; \
              _Pragma("unroll") for (int ks = 0; ks < 4; ++ks) qf[ks] = *(const LAS bf16x8*)(sb + (rb * 16 + r) * 136 + ks * 32 + q * 8); \
              _Pragma("unroll") for (int ks = 0; ks < 2; ++ks) ef[ks] = *(const LAS bf16x8*)(sb + GS_E + (rb * 16 + r) * 72 + ks * 32 + q * 8); \
              bf16x8 tf[2][4], vf[2][2]; \
              _Pragma("unroll") for (int e2 = 0; e2 < 2; ++e2) { const int cb = (w & 1) * 2 + e2; \
                  _Pragma("unroll") for (int ks = 0; ks < 4; ++ks) tf[e2][ks] = *(const LAS bf16x8*)(Tb + (cb * 16 + r) * 136 + ks * 32 + q * 8); \
                  _Pragma("unroll") for (int ks = 0; ks < 2; ++ks) vf[e2][ks] = *(const LAS bf16x8*)(sb + GS_VT + (cb * 16 + r) * 72 + ks * 32 + q * 8); } \
              __builtin_amdgcn_sched_barrier(0); \
              _Pragma("unroll") for (int e2 = 0; e2 < 2; ++e2) { const int cb = (w & 1) * 2 + e2; f32x4 y = (f32x4){0.f, 0.f, 0.f, 0.f}; \
                  _Pragma("unroll") for (int ks = 0; ks < 4; ++ks) y = mma16(tf[e2][ks], qf[ks], y); \
                  _Pragma("unroll") for (int ks = 0; ks < 2; ++ks) y = mma16(vf[e2][ks], ef[ks], y); \
                  if (t < ntok) { u32x2 o; o.x = pk2(y[0], y[1]); o.y = pk2(y[2], y[3]); *(u32x2*)(OB + (size_t)(row0 + (ci) * 64 + t) * BW + h * 256 + sl * 64 + cb * 16 + q * 4) = o; } } } \
            { const f32x4 gcv = *(const LAS f32x4*)((const LAS float*)(sb + GS_GC) + w * 16 + q * 4); bf16x8 kf[2]; \
              _Pragma("unroll") for (int ks = 0; ks < 2; ++ks) kf[ks] = *(const LAS bf16x8*)(sb + GS_KH + (w * 16 + r) * 72 + ks * 32 + q * 8); \
              bf16x8 vs[4][2]; \
              _Pragma("unroll") for (int vb = 0; vb < 4; ++vb) _Pragma("unroll") for (int ks = 0; ks < 2; ++ks) vs[vb][ks] = *(const LAS bf16x8*)(sb + GS_VT + (vb * 16 + r) * 72 + ks * 32 + q * 8); \
              __builtin_amdgcn_sched_barrier(0); \
              _Pragma("unroll") for (int vb = 0; vb < 4; ++vb) { acc[vb] = acc[vb] * gcv; \
                  _Pragma("unroll") for (int ks = 0; ks < 2; ++ks) acc[vb] = mma16(kf[ks], vs[vb][ks], acc[vb]); } } \
        } while (0)
#pragma unroll 1
        for (int ci = 0; ci < nch; ci += 3) {
            GLA_STEP(ci, R1);
            if (ci + 1 < nch) GLA_STEP(ci + 1, R2);
            if (ci + 2 < nch) GLA_STEP(ci + 2, R0);
        }
#undef GLA_STEP
#pragma unroll
        for (int vb = 0; vb < 4; ++vb)
#pragma unroll
            for (int jj = 0; jj < 4; ++jj) op[(size_t)(w * 16 + q * 4 + jj) * 256 + sl * 64 + vb * 16 + r] = acc[vb][jj];
        __syncthreads();
    }
}
__device__ __forceinline__ void ph_gla_fin(const Ctx& c, const bf16_t* __restrict__ U, const float* __restrict__ ng, const float* __restrict__ nb, const bf16_t* __restrict__ RAW, bf16_t* __restrict__ OB) {
    const int lane = c.lane;
    for (int i = c.bid * 8 + c.wave; i < MT * 4; i += c.G * 8) {
        const int row = i >> 2, h = i & 3, cc = h * 256 + lane * 4; bf16_t* p = OB + (size_t)row * BW + cc;
        const u32x2 raw = *(const u32x2*)(RAW + (size_t)row * BW + cc); float x[4] = {__uint_as_float(raw.x << 16), __uint_as_float(raw.x & 0xffff0000u), __uint_as_float(raw.y << 16), __uint_as_float(raw.y & 0xffff0000u)};
        const float mean = wave_sum((x[0] + x[1]) + (x[2] + x[3])) * (1.0f / 256.0f); float qq = 0.f;
#pragma unroll
        for (int j = 0; j < 4; ++j) { const float d = x[j] - mean; qq += d * d; }
        const float rstd = rsqrtf(wave_sum(qq) * (1.0f / 256.0f) + 1e-5f);
        const u32x2 gp = *(const u32x2*)(U + (size_t)row * NINP + U_GR + cc); const float gr[4] = {__uint_as_float(gp.x << 16), __uint_as_float(gp.x & 0xffff0000u), __uint_as_float(gp.y << 16), __uint_as_float(gp.y & 0xffff0000u)};
        const f32x4 gg = *(const f32x4*)(ng + cc), bb = *(const f32x4*)(nb + cc); float o[4];
#pragma unroll
        for (int j = 0; j < 4; ++j) o[j] = ((x[j] - mean) * rstd * gg[j] + bb[j]) * gr[j] * sigmoidf_(gr[j]);
        u32x2 ov; ov.x = pk2(o[0], o[1]); ov.y = pk2(o[2], o[3]); *(u32x2*)p = ov;
    }
}

__device__ __forceinline__ void unpack8(const u32x4 w, float (&x)[8]) {
    x[0] = __uint_as_float(w.x << 16); x[1] = __uint_as_float(w.x & 0xffff0000u); x[2] = __uint_as_float(w.y << 16); x[3] = __uint_as_float(w.y & 0xffff0000u);
    x[4] = __uint_as_float(w.z << 16); x[5] = __uint_as_float(w.z & 0xffff0000u); x[6] = __uint_as_float(w.w << 16); x[7] = __uint_as_float(w.w & 0xffff0000u);
}
template <bool ISBF> __device__ __forceinline__ void swa_step(const float (&q)[32], float (&acc)[32], float& m, float& l, const void* kp, const void* vp, float slope, float dist) {
    float s = 0.f;
#pragma unroll
    for (int j = 0; j < 4; ++j) { float x[8];
        if (ISBF) unpack8(*(const u32x4*)((const bf16_t*)kp + j * 8), x);
        else { const f32x4 a = *(const f32x4*)((const float*)kp + j * 8), b = *(const f32x4*)((const float*)kp + j * 8 + 4); x[0] = a[0]; x[1] = a[1]; x[2] = a[2]; x[3] = a[3]; x[4] = b[0]; x[5] = b[1]; x[6] = b[2]; x[7] = b[3]; }
#pragma unroll
        for (int d = 0; d < 8; ++d) s += q[j * 8 + d] * x[d]; }
    s += __shfl_xor(s, 1, 64);
    s = s * 0.125f - slope * dist;
    const float mn = fmaxf(m, s), cc = __expf(m - mn), p = __expf(s - mn);
    l = l * cc + p;
#pragma unroll
    for (int j = 0; j < 4; ++j) { float x[8];
        if (ISBF) unpack8(*(const u32x4*)((const bf16_t*)vp + j * 8), x);
        else { const f32x4 a = *(const f32x4*)((const float*)vp + j * 8), b = *(const f32x4*)((const float*)vp + j * 8 + 4); x[0] = a[0]; x[1] = a[1]; x[2] = a[2]; x[3] = a[3]; x[4] = b[0]; x[5] = b[1]; x[6] = b[2]; x[7] = b[3]; }
#pragma unroll
        for (int d = 0; d < 8; ++d) acc[j * 8 + d] = acc[j * 8 + d] * cc + p * x[d]; }
    m = mn;
}
__device__ __forceinline__ void ph_swa_naive(const Ctx& c, const bf16_t* __restrict__ U, const float* __restrict__ ck, const float* __restrict__ cv, const float* __restrict__ sinks, bf16_t* __restrict__ OB) {
    for (int gid = c.bid * 512 + c.tid; gid < MS * 32; gid += c.G * 512) {
        const int dh = gid & 1, h = (gid >> 1) & 15, row = MP + (gid >> 5), kvh = h >> 3, co = kvh * 64 + dh * 32;
        float q[32], acc[32];
#pragma unroll
        for (int j = 0; j < 4; ++j) { float x[8]; unpack8(*(const u32x4*)(U + (size_t)row * NINP + U_SQ + h * 64 + dh * 32 + j * 8), x);
#pragma unroll
            for (int d = 0; d < 8; ++d) { q[j * 8 + d] = x[d]; acc[j * 8 + d] = 0.f; } }
        const float slope = exp2f(-0.5f * (float)(h + 1)); float m = sinks[h], l = 1.0f;
        if (row < MP) {
            const int t = row % PS, base = row - t, lo = t - 128 < 0 ? 0 : t - 128;
            for (int s = lo; s <= t; ++s) { const bf16_t* ur = U + (size_t)(base + s) * NINP;
                swa_step<true>(q, acc, m, l, ur + U_SK + co, ur + U_SV + co, slope, (float)(t - s)); }
        } else {
            const int sq = (row - MP) / SS, i = (row - MP) % SS;
            for (int idx = i; idx <= 128 + i; ++idx) {
                if (idx < 128) { const size_t o = ((size_t)sq * 128 + idx) * 128 + co; swa_step<false>(q, acc, m, l, ck + o, cv + o, slope, (float)(128 + i - idx)); }
                else { const bf16_t* ur = U + (size_t)(MP + sq * SS + idx - 128) * NINP; swa_step<true>(q, acc, m, l, ur + U_SK + co, ur + U_SV + co, slope, (float)(128 + i - idx)); }
            }
        }
        const float inv = 1.0f / l; bf16_t* op = OB + (size_t)row * BW + h * 64 + dh * 32;
#pragma unroll
        for (int j = 0; j < 4; ++j) { u32x4 w; w.x = pk2(acc[j * 8] * inv, acc[j * 8 + 1] * inv); w.y = pk2(acc[j * 8 + 2] * inv, acc[j * 8 + 3] * inv);
            w.z = pk2(acc[j * 8 + 4] * inv, acc[j * 8 + 5] * inv); w.w = pk2(acc[j * 8 + 6] * inv, acc[j * 8 + 7] * inv); *(u32x4*)(op + j * 8) = w; }
    }
}

__device__ __forceinline__ void ph_rwkv_prep(const Ctx& c, const bf16_t* __restrict__ U, const float* __restrict__ shift, const float* __restrict__ mu, const float* __restrict__ w0, const float* __restrict__ w2,
                                             const float* __restrict__ a0, const float* __restrict__ a2, const float* __restrict__ g2, const float* __restrict__ k_k, const float* __restrict__ k_a,
                                             const float* __restrict__ r_k, float* __restrict__ RW) {
    LAS float* xm = (LAS float*)c.lds; LAS float* tw = xm + RWC; LAS float* ad = tw + 64; LAS float* sg = ad + 64;
    const int tid = c.tid;
    float* R = RW; float* WD = RW + (size_t)MPAD * BW; float* K2 = WD + (size_t)MPAD * BW; float* V = K2 + (size_t)MPAD * BW; float* KK = V + (size_t)MPAD * BW;
    float* BV = KK + (size_t)MPAD * BW; float* G = BV + (size_t)MPAD * BW; float* BON = G + (size_t)MPAD * BW;
    for (int row = c.bid; row < MT; row += c.G) {
        const bf16_t* ur = U + (size_t)row * NINP + U_RU; const bf16_t* pr = ur - NINP; const float* ps = nullptr; bool first;
        if (row < MP) first = (row % PS) == 0; else { first = ((row - MP) % SS) == 0; ps = shift + (size_t)((row - MP) / SS) * RWC; }
        for (int cc = tid; cc < RWC; cc += 512) { const float x = bf2f(ur[cc]); const float s = first ? (ps ? ps[cc] : 0.f) : bf2f(pr[cc]); xm[cc] = x + (s - x) * mu[cc]; }
        __syncthreads();
        if (tid < 64) { tw[tid] = tanhf(xm[3072 + tid]); ad[tid] = xm[3136 + tid]; }
        if (tid >= 128 && tid < 256) sg[tid - 128] = sigmoidf_(xm[3200 + tid - 128]);
        __syncthreads();
        for (int qd = 0; qd < 2; ++qd) {
            const int cc = qd * 512 + tid; float accw = w0[cc], acca = a0[cc], accg = 0.f;
#pragma unroll 4
            for (int j = 0; j < 64; ++j) { accw += tw[j] * w2[j * BW + cc]; acca += ad[j] * a2[j * BW + cc]; }
#pragma unroll 4
            for (int j = 0; j < 128; ++j) accg += sg[j] * g2[j * BW + cc];
            const float lw = -softplusf_(-accw) - 0.5f, decay = __expf(-__expf(lw)), a = sigmoidf_(acca);
            const float r = xm[cc], k = xm[1024 + cc], v = xm[2048 + cc];
            const float kkr = k * k_k[cc]; const float ss = wave_sum(kkr * kkr); const float kk = kkr / fmaxf(sqrtf(ss), 1e-12f);
            const float k2 = k * (1.0f + (a - 1.0f) * k_a[cc]); const float rk = wave_sum(r * k2 * r_k[cc]);
            const size_t o = (size_t)row * BW + cc;
            R[o] = r; WD[o] = decay; K2[o] = k2; V[o] = v; KK[o] = kk; BV[o] = kk * a; G[o] = accg; BON[o] = rk * v;
        }
        __syncthreads();
    }
}
__device__ __forceinline__ int kperm_pos(int k) { return (k & ~31) + 8 * ((k >> 2) & 3) + 4 * ((k >> 4) & 1) + (k & 3); }
__device__ __forceinline__ void ph_swa_prompt(const Ctx& c, const bf16_t* __restrict__ U, const float* __restrict__ sinks, bf16_t* __restrict__ OB) {
    LAS bf16_t* K_l = (LAS bf16_t*)c.lds;
    LAS bf16_t* VT_l = K_l + 192 * 72;
    const int tid = c.tid, lane = c.lane, r = lane & 15, q = lane >> 4, w = c.wave;
    for (int u = c.bid; u < PB * 64 * 2; u += c.G) {
        const int b = u >> 7, qb = (u >> 1) & 63, kvh = u & 1, h = kvh * 8 + w;
        const int tok0 = qb * 64 - 128;
        const size_t seq0 = (size_t)b * PS;
        for (int idx = tid; idx < 192 * 8; idx += 512) { const int kl = idx >> 3, c8 = idx & 7, tk = tok0 + kl; u32x4 kv = (u32x4){0u, 0u, 0u, 0u}, vv = kv;
            if (tk >= 0) { const bf16_t* ur = U + (seq0 + tk) * NINP; kv = *(const u32x4*)(ur + U_SK + kvh * 64 + c8 * 8); vv = *(const u32x4*)(ur + U_SV + kvh * 64 + c8 * 8); }
            *(LAS u32x4*)(K_l + kl * 72 + c8 * 8) = kv;
            const int kp = kperm_pos(kl); LAS bf16_t* vp = VT_l + (c8 * 8) * 200 + kp;
            vp[0] = (bf16_t)(vv.x & 0xffffu); vp[200] = (bf16_t)(vv.x >> 16); vp[400] = (bf16_t)(vv.y & 0xffffu); vp[600] = (bf16_t)(vv.y >> 16);
            vp[800] = (bf16_t)(vv.z & 0xffffu); vp[1000] = (bf16_t)(vv.z >> 16); vp[1200] = (bf16_t)(vv.w & 0xffffu); vp[1400] = (bf16_t)(vv.w >> 16); }
        __syncthreads();
        const float slope = exp2f(-0.5f * (float)(h + 1)), sink = sinks[h];
#pragma unroll 1
        for (int i = 0; i < 4; ++i) {
            const size_t qrow = seq0 + qb * 64 + i * 16 + r;
            const bf16x8 qf0 = *(const bf16x8*)(U + qrow * NINP + U_SQ + h * 64 + q * 8), qf1 = *(const bf16x8*)(U + qrow * NINP + U_SQ + h * 64 + 32 + q * 8);
            const int kt0 = i & ~1;
            f32x4 s[10]; float mx = sink; bf16x8 kfr[5][2];
#pragma unroll
            for (int kt = 0; kt < 10; ++kt) { f32x4 d;
                if (kt % 5 == 0) {
#pragma unroll
                    for (int k5 = 0; k5 < 5; ++k5) { const LAS bf16_t* kp = K_l + ((kt0 + kt + k5) * 16 + r) * 72 + q * 8; kfr[k5][0] = *(const LAS bf16x8*)kp; kfr[k5][1] = *(const LAS bf16x8*)(kp + 32); }
                    __builtin_amdgcn_sched_barrier(0); }
                d = mma16(kfr[kt % 5][0], qf0, (f32x4){0.f, 0.f, 0.f, 0.f}); d = mma16(kfr[kt % 5][1], qf1, d);
#pragma unroll
                for (int jj = 0; jj < 4; ++jj) { const int kl = (kt0 + kt) * 16 + q * 4 + jj, dist = i * 16 + r + 128 - kl;
                    const float v = (dist >= 0 && dist <= 128 && tok0 + kl >= 0) ? d[jj] * 0.125f - slope * (float)dist : -1e30f; d[jj] = v; mx = fmaxf(mx, v); }
                s[kt] = d; }
            mx = fmaxf(mx, __shfl_xor(mx, 16, 64)); mx = fmaxf(mx, __shfl_xor(mx, 32, 64));
            float sum = 0.f; bf16x8 pf[5];
#pragma unroll
            for (int kp = 0; kp < 5; ++kp) { f32x4 a = s[2 * kp], bq = s[2 * kp + 1];
#pragma unroll
                for (int jj = 0; jj < 4; ++jj) { a[jj] = __expf(a[jj] - mx); bq[jj] = __expf(bq[jj] - mx); sum += a[jj] + bq[jj]; }
                pf[kp] = pack_acc(a, bq); }
            sum += __shfl_xor(sum, 16, 64); sum += __shfl_xor(sum, 32, 64);
            const float inv = 1.0f / (sum + __expf(sink - mx));
            bf16_t* op = OB + qrow * BW + h * 64 + q * 4;
#pragma unroll
            for (int dt = 0; dt < 4; ++dt) { f32x4 o = (f32x4){0.f, 0.f, 0.f, 0.f}; bf16x8 vfr[5];
#pragma unroll
                for (int kp = 0; kp < 5; ++kp) vfr[kp] = *(const LAS bf16x8*)(VT_l + (dt * 16 + r) * 200 + (kt0 + 2 * kp) * 16 + q * 8);
                __builtin_amdgcn_sched_barrier(0);
#pragma unroll
                for (int kp = 0; kp < 5; ++kp) o = mma16(vfr[kp], pf[kp], o);
                u32x2 ov; ov.x = pk2(o[0] * inv, o[1] * inv); ov.y = pk2(o[2] * inv, o[3] * inv); *(u32x2*)(op + dt * 16) = ov; }
        }
        __syncthreads();
    }
}

__device__ __forceinline__ void ph_swa_sample(const Ctx& c, const bf16_t* __restrict__ U, const float* __restrict__ ck, const float* __restrict__ cv, const float* __restrict__ sinks, bf16_t* __restrict__ OB) {
    LAS bf16_t* K_l = (LAS bf16_t*)c.lds;
    LAS bf16_t* VT_l = K_l + 160 * 72;
    const int tid = c.tid, lane = c.lane, r = lane & 15, q = lane >> 4, w = c.wave;
    for (int u = c.bid; u < SB * 2; u += c.G) {
        const int sq = u >> 1, kvh = u & 1;
        for (int idx = tid; idx < 160 * 8; idx += 512) { const int kl = idx >> 3, c8 = idx & 7; float kx[8], vx[8];
#pragma unroll
            for (int e = 0; e < 8; ++e) { kx[e] = 0.f; vx[e] = 0.f; }
            if (kl < 128) { const size_t o = ((size_t)sq * 128 + kl) * 128 + kvh * 64 + c8 * 8; const f32x4 a = *(const f32x4*)(ck + o), b2 = *(const f32x4*)(ck + o + 4), c2 = *(const f32x4*)(cv + o), d2 = *(const f32x4*)(cv + o + 4);
                kx[0] = a[0]; kx[1] = a[1]; kx[2] = a[2]; kx[3] = a[3]; kx[4] = b2[0]; kx[5] = b2[1]; kx[6] = b2[2]; kx[7] = b2[3];
                vx[0] = c2[0]; vx[1] = c2[1]; vx[2] = c2[2]; vx[3] = c2[3]; vx[4] = d2[0]; vx[5] = d2[1]; vx[6] = d2[2]; vx[7] = d2[3]; }
            else if (kl < 132) { const bf16_t* ur = U + (size_t)(MP + sq * SS + kl - 128) * NINP; unpack8(*(const u32x4*)(ur + U_SK + kvh * 64 + c8 * 8), kx); unpack8(*(const u32x4*)(ur + U_SV + kvh * 64 + c8 * 8), vx); }
            *(LAS u32x4*)(K_l + kl * 72 + c8 * 8) = (u32x4){pk2(kx[0], kx[1]), pk2(kx[2], kx[3]), pk2(kx[4], kx[5]), pk2(kx[6], kx[7])};
            LAS bf16_t* vp = VT_l + (c8 * 8) * 168 + kperm_pos(kl);
#pragma unroll
            for (int e = 0; e < 8; ++e) vp[e * 168] = f2bf(vx[e]); }
        __syncthreads();
        if (w < 2) {
            const int h = kvh * 8 + w * 4 + (r >> 2), tk = r & 3; const size_t qrow = (size_t)(MP + sq * SS + tk);
            const float slope = exp2f(-0.5f * (float)(h + 1)), sink = sinks[h];
            const bf16x8 qf0 = *(const bf16x8*)(U + qrow * NINP + U_SQ + h * 64 + q * 8), qf1 = *(const bf16x8*)(U + qrow * NINP + U_SQ + h * 64 + 32 + q * 8);
            f32x4 s[10]; float mx = sink;
#pragma unroll
            for (int kt = 0; kt < 10; ++kt) { const LAS bf16_t* kp = K_l + (kt * 16 + r) * 72 + q * 8;
                f32x4 d = mma16(*(const LAS bf16x8*)kp, qf0, (f32x4){0.f, 0.f, 0.f, 0.f}); d = mma16(*(const LAS bf16x8*)(kp + 32), qf1, d);
#pragma unroll
                for (int jj = 0; jj < 4; ++jj) { const int kl = kt * 16 + q * 4 + jj, dist = 128 + tk - kl;
                    const float v = (dist >= 0 && dist <= 128) ? d[jj] * 0.125f - slope * (float)dist : -1e30f; d[jj] = v; mx = fmaxf(mx, v); }
                s[kt] = d; }
            mx = fmaxf(mx, __shfl_xor(mx, 16, 64)); mx = fmaxf(mx, __shfl_xor(mx, 32, 64));
            float sum = 0.f; bf16x8 pf[5];
#pragma unroll
            for (int kp = 0; kp < 5; ++kp) { f32x4 a = s[2 * kp], bq = s[2 * kp + 1];
#pragma unroll
                for (int jj = 0; jj < 4; ++jj) { a[jj] = __expf(a[jj] - mx); bq[jj] = __expf(bq[jj] - mx); sum += a[jj] + bq[jj]; }
                pf[kp] = pack_acc(a, bq); }
            sum += __shfl_xor(sum, 16, 64); sum += __shfl_xor(sum, 32, 64);
            const float inv = 1.0f / (sum + __expf(sink - mx));
            bf16_t* op = OB + qrow * BW + h * 64 + q * 4;
#pragma unroll
            for (int dt = 0; dt < 4; ++dt) { f32x4 o = (f32x4){0.f, 0.f, 0.f, 0.f};
#pragma unroll
                for (int kp = 0; kp < 5; ++kp) o = mma16(*(const LAS bf16x8*)(VT_l + (dt * 16 + r) * 168 + kp * 32 + q * 8), pf[kp], o);
                u32x2 ov; ov.x = pk2(o[0] * inv, o[1] * inv); ov.y = pk2(o[2] * inv, o[3] * inv); *(u32x2*)(op + dt * 16) = ov; }
        }
        __syncthreads();
    }
}

__device__ __forceinline__ void ph_lrw(const Ctx& c, const float* __restrict__ w2, const float* __restrict__ a2, const float* __restrict__ g2, bf16_t* __restrict__ LRW) {
    for (int idx = c.bid * 512 + c.tid; idx < NL * 256 * 1024; idx += c.G * 512) {
        const int ch = idx & 1023, j = (idx >> 10) & 255, l = idx >> 18;
        const float v = j < 64 ? w2[((size_t)l * 64 + j) * BW + ch] : (j < 128 ? a2[((size_t)l * 64 + j - 64) * BW + ch] : g2[((size_t)l * 128 + j - 128) * BW + ch]);
        LRW[((size_t)l * 1024 + ch) * 256 + j] = f2bf(v);
    }
}
constexpr int RWP_UNITS = (MP / 64) * 4 + SB * 4;
__device__ __forceinline__ void rwp_unit_info(int u, int& row0, int& ntok, int& hg, int& sq, bool& seq_first) {
    if (u < (MP / 64) * 4) { const int blk = u >> 2; hg = u & 3; row0 = blk * 64; ntok = 64; sq = -1; seq_first = (row0 % PS) == 0; }
    else { const int s = u - (MP / 64) * 4; sq = s >> 2; hg = s & 3; row0 = MP + sq * SS; ntok = SS; seq_first = true; }
}
__device__ __forceinline__ void ph_rwkv_pre(const Ctx& c, const bf16_t* __restrict__ U, const float* __restrict__ shift, const float* __restrict__ mu, const float* __restrict__ w0, const float* __restrict__ w2,
                                            const float* __restrict__ a0, const float* __restrict__ a2, const float* __restrict__ g2, const float* __restrict__ k_k, const float* __restrict__ k_a,
                                            const float* __restrict__ r_k, float* __restrict__ RW, bf16_t* __restrict__ RB, const bf16_t* __restrict__ LRW) {
    LAS bf16_t* P_l = (LAS bf16_t*)c.lds; LAS bf16_t* Kn_l = P_l + 4608; LAS bf16_t* Bn_l = Kn_l + 4608; LAS bf16_t* Q_l = Bn_l + 4608;
    LAS bf16_t* PT_l = Q_l + 4608; LAS bf16_t* BhT_l = PT_l + 4608; LAS bf16_t* KhT_l = BhT_l + 4608; LAS bf16_t* VT_l = KhT_l + 4608;
    LAS float* A_l = (LAS float*)(c.lds + 73728);
    LAS bf16_t* BmT_l = (LAS bf16_t*)(c.lds + 78848); LAS bf16_t* F_l = (LAS bf16_t*)(c.lds + 81920); LAS bf16_t* Tinv_l = (LAS bf16_t*)(c.lds + 84992);
    LAS bf16_t* PpT_l = (LAS bf16_t*)(c.lds + 88064);
    LAS bf16_t* BmpT_l = (LAS bf16_t*)(c.lds + 97280);
    LAS float* GC_l = (LAS float*)(c.lds + 100352);
    LAS float* lg_l = (LAS float*)(c.lds + 125952);
    LAS bf16_t* act_l = (LAS bf16_t*)c.lds;
    LAS bf16_t* wT_l = act_l + 64 * 264;
    LAS bf16_t* aT_l = wT_l + 64 * 72;
    LAS bf16_t* gT_l = aT_l + 64 * 72;
    LAS float* pre_l = (LAS float*)(c.lds + 73728);
    const int tid = c.tid, lane = c.lane, r = lane & 15, q = lane >> 4, w = c.wave;
    bf16_t* Gg = (bf16_t*)(RW + 6 * (size_t)MPAD * BW); bf16_t* BON = (bf16_t*)(RW + 7 * (size_t)MPAD * BW);
    for (int u = c.bid; u < RWP_UNITS; u += c.G) {
        int row0, ntok, hg, sq; bool seq_first; rwp_unit_info(u, row0, ntok, hg, sq, seq_first);
        const float* sh = sq >= 0 ? shift + (size_t)sq * RWC : nullptr;
        const int nstage = ntok == 64 ? 64 : 16;
        for (int idx = tid; idx < nstage * 32; idx += 512) {
            const int t = idx >> 5, c8 = idx & 31, cc = 3072 + c8 * 8; float val[8];
#pragma unroll
            for (int e2 = 0; e2 < 8; ++e2) val[e2] = 0.f;
            if (t < ntok) { const bf16_t* ur = U + (size_t)(row0 + t) * NINP + U_RU; float x[8], p[8];
                unpack8(*(const u32x4*)(ur + cc), x);
                if (!(t == 0 && seq_first)) unpack8(*(const u32x4*)(ur + cc - NINP), p);
                else if (sh) { const f32x4 s0v = *(const f32x4*)(sh + cc), s1v = *(const f32x4*)(sh + cc + 4); p[0] = s0v[0]; p[1] = s0v[1]; p[2] = s0v[2]; p[3] = s0v[3]; p[4] = s1v[0]; p[5] = s1v[1]; p[6] = s1v[2]; p[7] = s1v[3]; }
                else {
#pragma unroll
                    for (int e2 = 0; e2 < 8; ++e2) p[e2] = 0.f; }
                const f32x4 m0 = *(const f32x4*)(mu + cc), m1 = *(const f32x4*)(mu + cc + 4);
#pragma unroll
                for (int e2 = 0; e2 < 8; ++e2) { const float xm = x[e2] + (p[e2] - x[e2]) * (e2 < 4 ? m0[e2] : m1[e2 - 4]); val[e2] = c8 < 8 ? tanh_fast(xm) : (c8 < 16 ? xm : sigmoidf_(xm)); } }
            *(LAS u32x4*)(act_l + t * 264 + c8 * 8) = (u32x4){pk2(val[0], val[1]), pk2(val[2], val[3]), pk2(val[4], val[5]), pk2(val[6], val[7])};
        }
        __syncthreads();
        bf16x8 af[8];
        { const int tb = w & 3;
#pragma unroll
          for (int ks = 0; ks < 8; ++ks) af[ks] = *(const LAS bf16x8*)(act_l + (tb * 16 + r) * 264 + ks * 32 + q * 8); }
        __syncthreads();
#pragma unroll 1
        for (int hh = 0; hh < 4; ++hh) { const int h = hg * 4 + hh;
        { const int tb = w & 3, chf = w >> 2;
          if (tb * 16 < nstage) {
#pragma unroll
            for (int e2 = 0; e2 < 2; ++e2) { const int cb = chf * 2 + e2; f32x4 dw = (f32x4){0.f, 0.f, 0.f, 0.f}, da = dw, dg = dw;
                const bf16_t* wr = LRW + ((size_t)h * 64 + cb * 16 + r) * 256 + q * 8; bf16x8 wf[8];
#pragma unroll
                for (int ks = 0; ks < 8; ++ks) wf[ks] = *(const bf16x8*)(wr + ks * 32);
                __builtin_amdgcn_sched_barrier(0);
#pragma unroll
                for (int ks = 0; ks < 2; ++ks) { dw = mma16(wf[ks], af[ks], dw); da = mma16(wf[2 + ks], af[2 + ks], da); }
#pragma unroll
                for (int ks = 0; ks < 4; ++ks) dg = mma16(wf[4 + ks], af[4 + ks], dg);
                const int o = (tb * 16 + r) * 68 + cb * 16 + q * 4;
                *(LAS f32x4*)(pre_l + o) = dw; *(LAS f32x4*)(pre_l + 64 * 68 + o) = da; *(LAS f32x4*)(pre_l + 2 * 64 * 68 + o) = dg; } } }
        __syncthreads();
        const int t = tid >> 3, cg = tid & 7, c0 = h * 64 + cg * 8, sc = t >> 4;
        float rr[8], k2[8], kap[8], bet[8], nlw[8];
        { float vx[8], gg[8], kkr[8]; float ss = 0.f, rk = 0.f;
          if (t < ntok) {
            const size_t row = (size_t)(row0 + t); const bf16_t* ur = U + row * NINP + U_RU; const bool fst = (t == 0 && seq_first);
            float kx[8];
#pragma unroll
            for (int part = 0; part < 3; ++part) { const int cc = part * 1024 + c0; float x[8], p[8];
                unpack8(*(const u32x4*)(ur + cc), x);
                if (!fst) unpack8(*(const u32x4*)(ur + cc - NINP), p);
                else {
#pragma unroll
                    for (int j = 0; j < 8; ++j) p[j] = sh ? sh[cc + j] : 0.f; }
                const f32x4 mA = *(const f32x4*)(mu + cc), mB = *(const f32x4*)(mu + cc + 4);
#pragma unroll
                for (int j = 0; j < 8; ++j) { const float xm = x[j] + (p[j] - x[j]) * (j < 4 ? mA[j] : mB[j - 4]); if (part == 0) rr[j] = xm; else if (part == 1) kx[j] = xm; else vx[j] = xm; } }
            float pw[8], pa[8], pkk[8], pka[8], prk[8];
#pragma unroll
            for (int hf = 0; hf < 2; ++hf) { const f32x4 v0 = *(const f32x4*)(w0 + c0 + hf * 4), v1 = *(const f32x4*)(a0 + c0 + hf * 4), v2 = *(const f32x4*)(k_k + c0 + hf * 4), v3 = *(const f32x4*)(k_a + c0 + hf * 4), v4 = *(const f32x4*)(r_k + c0 + hf * 4);
#pragma unroll
                for (int j = 0; j < 4; ++j) { pw[hf * 4 + j] = v0[j]; pa[hf * 4 + j] = v1[j]; pkk[hf * 4 + j] = v2[j]; pka[hf * 4 + j] = v3[j]; prk[hf * 4 + j] = v4[j]; } }
            float lwp[8], app[8];
#pragma unroll
            for (int hf = 0; hf < 2; ++hf) { const f32x4 v0 = *(const LAS f32x4*)(pre_l + t * 68 + cg * 8 + hf * 4), v1 = *(const LAS f32x4*)(pre_l + 64 * 68 + t * 68 + cg * 8 + hf * 4), v2 = *(const LAS f32x4*)(pre_l + 2 * 64 * 68 + t * 68 + cg * 8 + hf * 4);
#pragma unroll
                for (int j = 0; j < 4; ++j) { lwp[hf * 4 + j] = v0[j]; app[hf * 4 + j] = v1[j]; gg[hf * 4 + j] = v2[j]; } }
#pragma unroll
            for (int j = 0; j < 8; ++j) {
                const float lw = -softplus_fast(-(pw[j] + lwp[j])) - 0.5f; nlw[j] = -__expf(lw); const float av = sigmoidf_(pa[j] + app[j]);
                kkr[j] = kx[j] * pkk[j]; ss += kkr[j] * kkr[j]; k2[j] = kx[j] * (1.0f + (av - 1.0f) * pka[j]); rk += rr[j] * k2[j] * prk[j]; bet[j] = av; }
          } else {
#pragma unroll
            for (int j = 0; j < 8; ++j) { rr[j] = 0.f; k2[j] = 0.f; kkr[j] = 0.f; bet[j] = 0.f; nlw[j] = 0.f; vx[j] = 0.f; gg[j] = 0.f; }
          }
          ss += __shfl_xor(ss, 1, 64); ss += __shfl_xor(ss, 2, 64); ss += __shfl_xor(ss, 4, 64);
          rk += __shfl_xor(rk, 1, 64); rk += __shfl_xor(rk, 2, 64); rk += __shfl_xor(rk, 4, 64);
          const float inv = 1.0f / fmaxf(sqrtf(ss), 1e-12f);
#pragma unroll
          for (int j = 0; j < 8; ++j) { kap[j] = kkr[j] * inv; bet[j] = kap[j] * bet[j]; }
          if (t < ntok) { const size_t o = (size_t)(row0 + t) * BW + c0;
              *(u32x4*)(Gg + o) = (u32x4){pk2(gg[0], gg[1]), pk2(gg[2], gg[3]), pk2(gg[4], gg[5]), pk2(gg[6], gg[7])};
              *(u32x4*)(BON + o) = (u32x4){pk2(rk * vx[0], rk * vx[1]), pk2(rk * vx[2], rk * vx[3]), pk2(rk * vx[4], rk * vx[5]), pk2(rk * vx[6], rk * vx[7])}; }
          *(LAS f32x4*)(lg_l + t * 68 + cg * 8) = (f32x4){nlw[0], nlw[1], nlw[2], nlw[3]}; *(LAS f32x4*)(lg_l + t * 68 + cg * 8 + 4) = (f32x4){nlw[4], nlw[5], nlw[6], nlw[7]};
#pragma unroll
          for (int j = 0; j < 8; ++j) VT_l[(cg * 8 + j) * 72 + t] = f2bf(vx[j]);
        }
        __syncthreads();
        if (tid < 256) { const int cc = tid & 63, s4 = tid >> 6; float run = 0.f;
#pragma unroll
            for (int i = 0; i < 16; ++i) { const int o = (s4 * 16 + i) * 68 + cc; run += lg_l[o]; lg_l[o] = run; } }
        __syncthreads();
        { unsigned pp[4], pq[4], pk[4], pb[4];
#pragma unroll
          for (int j = 0; j < 8; j += 2) { float vP[2], vQ[2], vK[2], vB[2];
#pragma unroll
              for (int e = 0; e < 2; ++e) { const int jj = j + e, cc = cg * 8 + jj; const float ci = lg_l[t * 68 + cc], cC = lg_l[(sc * 16 + 15) * 68 + cc];
                  const float ei = __expf(-ci), eh = __expf(cC - ci);
                  vP[e] = kap[jj] * __expf(ci - nlw[jj]); vQ[e] = rr[jj] * __expf(ci); vK[e] = k2[jj] * ei; vB[e] = bet[jj] * ei;
                  PT_l[cc * 72 + t] = f2bf(vP[e]); BhT_l[cc * 72 + t] = f2bf(bet[jj] * eh); KhT_l[cc * 72 + t] = f2bf(k2[jj] * eh); }
              pp[j >> 1] = pk2(vP[0], vP[1]); pq[j >> 1] = pk2(vQ[0], vQ[1]); pk[j >> 1] = pk2(vK[0], vK[1]); pb[j >> 1] = pk2(vB[0], vB[1]); }
          const int o = t * 72 + cg * 8;
          *(LAS u32x4*)(P_l + o) = (u32x4){pp[0], pp[1], pp[2], pp[3]}; *(LAS u32x4*)(Q_l + o) = (u32x4){pq[0], pq[1], pq[2], pq[3]};
          *(LAS u32x4*)(Kn_l + o) = (u32x4){pk[0], pk[1], pk[2], pk[3]}; *(LAS u32x4*)(Bn_l + o) = (u32x4){pb[0], pb[1], pb[2], pb[3]};
          if ((t & 15) == 15) {
#pragma unroll
              for (int j = 0; j < 8; ++j) GC_l[sc * 64 + cg * 8 + j] = __expf(lg_l[t * 68 + cg * 8 + j]); } }
        __syncthreads();
        const int nsub = ntok == 64 ? 4 : 1;
        const bf16x8 zfrag = (bf16x8){0, 0, 0, 0, 0, 0, 0, 0};
        for (int id = w; id < nsub * 3; id += 8) { const int s4 = id / 3, prod = id - s4 * 3; f32x4 d = (f32x4){0.f, 0.f, 0.f, 0.f};
            const LAS bf16_t* X = (prod == 1 ? P_l : Bn_l) + (s4 * 16 + r) * 72 + q * 8; const LAS bf16_t* Y = (prod == 0 ? P_l : (prod == 1 ? Kn_l : Q_l)) + (s4 * 16 + r) * 72 + q * 8;
            { const bf16x8 x0 = *(const LAS bf16x8*)X, x1 = *(const LAS bf16x8*)(X + 32), y0 = *(const LAS bf16x8*)Y, y1 = *(const LAS bf16x8*)(Y + 32);
              __builtin_amdgcn_sched_barrier(0); d = mma16(x0, y0, d); d = mma16(x1, y1, d); }
            if (prod == 0) { f32x4 o4;
#pragma unroll
                for (int jj = 0; jj < 4; ++jj) o4[jj] = (q * 4 + jj < r) ? d[jj] : 0.f;
                *(LAS f32x4*)(A_l + s4 * 320 + r * 20 + q * 4) = o4; }
            else { float o4[4];
#pragma unroll
                for (int jj = 0; jj < 4; ++jj) o4[jj] = (prod == 1 ? (r < q * 4 + jj) : (q * 4 + jj <= r)) ? d[jj] : 0.f;
                u32x2 o; o.x = pk2(o4[0], o4[1]); o.y = pk2(o4[2], o4[3]); *(LAS u32x2*)((prod == 1 ? BmT_l : F_l) + s4 * 384 + r * 24 + q * 4) = o; } }
        __syncthreads();
        if (w == 0 && (lane >> 4) < nsub) { const int s4 = lane >> 4, jc = lane & 15; float x[16];
#pragma unroll
            for (int tt = 0; tt < 16; ++tt) { float s = (tt == jc) ? 1.f : 0.f;
#pragma unroll
                for (int i = 0; i < tt; ++i) s -= A_l[s4 * 320 + tt * 20 + i] * x[i];
                x[tt] = s; }
#pragma unroll
            for (int tt = 0; tt < 16; ++tt) Tinv_l[s4 * 384 + tt * 24 + jc] = f2bf(x[tt]); }
        __syncthreads();
        for (int id = w; id < nsub * 5; id += 8) { const int s4 = id / 5, rem = id - s4 * 5;
            const bf16x8 xf = q < 2 ? *(const LAS bf16x8*)(Tinv_l + s4 * 384 + r * 24 + q * 8) : zfrag;
            const bf16x8 yf = q < 2 ? (rem < 4 ? *(const LAS bf16x8*)(PT_l + (rem * 16 + r) * 72 + s4 * 16 + q * 8) : *(const LAS bf16x8*)(BmT_l + s4 * 384 + r * 24 + q * 8)) : zfrag;
            const f32x4 d = mma16(xf, yf, (f32x4){0.f, 0.f, 0.f, 0.f});
            u32x2 o; o.x = pk2(d[0], d[1]); o.y = pk2(d[2], d[3]);
            if (rem < 4) *(LAS u32x2*)(PpT_l + (rem * 16 + r) * 72 + s4 * 16 + q * 4) = o; else *(LAS u32x2*)(BmpT_l + s4 * 384 + r * 24 + q * 4) = o; }
        __syncthreads();
        { const int chunk0 = sq >= 0 ? PB * 16 * 256 + sq * 16 + h : ((row0 / PS) * 16 + h) * 256 + ((row0 % PS) >> 4);
          for (int id = w; id < nsub * 25; id += 8) { const int s4 = id / 25, rem = id - s4 * 25; bf16_t* blob = RB + (size_t)(chunk0 + s4) * RB_EL;
            const bf16x8 fF = q < 2 ? *(const LAS bf16x8*)(F_l + s4 * 384 + r * 24 + q * 8) : zfrag;
            if (rem < 4) {
                const bf16x8 xf = q < 2 ? *(const LAS bf16x8*)(PpT_l + (rem * 16 + r) * 72 + s4 * 16 + q * 8) : zfrag;
                const f32x4 d = mma16(xf, fF, (f32x4){0.f, 0.f, 0.f, 0.f});
                const u32x2 qv = *(const LAS u32x2*)(Q_l + (s4 * 16 + r) * 72 + rem * 16 + q * 4);
                u32x2 o; o.x = pk2(__uint_as_float(qv.x << 16) - d[0], __uint_as_float(qv.x & 0xffff0000u) - d[1]); o.y = pk2(__uint_as_float(qv.y << 16) - d[2], __uint_as_float(qv.y & 0xffff0000u) - d[3]);
                *(u32x2*)(blob + RB_QP + r * 72 + 32 * (rem >> 1) + 8 * q + 4 * (rem & 1)) = o;
            } else if (rem == 4) {
                f32x4 d2 = (f32x4){0.f, 0.f, 0.f, 0.f};
#pragma unroll
                for (int ks = 0; ks < 2; ++ks) d2 = mma16(*(const LAS bf16x8*)(Kn_l + (s4 * 16 + r) * 72 + ks * 32 + q * 8), *(const LAS bf16x8*)(Q_l + (s4 * 16 + r) * 72 + ks * 32 + q * 8), d2);
                const bf16x8 xf = q < 2 ? *(const LAS bf16x8*)(BmpT_l + s4 * 384 + r * 24 + q * 8) : zfrag;
                const f32x4 d1 = mma16(xf, fF, (f32x4){0.f, 0.f, 0.f, 0.f});
                float o4[4];
#pragma unroll
                for (int jj = 0; jj < 4; ++jj) o4[jj] = ((q * 4 + jj <= r) ? d2[jj] : 0.f) - d1[jj];
                u32x2 o; o.x = pk2(o4[0], o4[1]); o.y = pk2(o4[2], o4[3]); *(u32x2*)(blob + RB_EP + r * 24 + q * 4) = o;
            } else if (rem < 21) {
                const int cib = (rem - 5) >> 2, cob = (rem - 5) & 3;
                const bf16x8 xf = q < 2 ? *(const LAS bf16x8*)(PpT_l + (cib * 16 + r) * 72 + s4 * 16 + q * 8) : zfrag;
                const bf16x8 yf = q < 2 ? *(const LAS bf16x8*)(BhT_l + (cob * 16 + r) * 72 + s4 * 16 + q * 8) : zfrag;
                const f32x4 d = mma16(xf, yf, (f32x4){0.f, 0.f, 0.f, 0.f});
                const float gc = GC_l[s4 * 64 + cob * 16 + r]; float o4[4];
#pragma unroll
                for (int jj = 0; jj < 4; ++jj) o4[jj] = ((cib == cob && q * 4 + jj == r) ? gc : 0.f) - d[jj];
                u32x2 o; o.x = pk2(o4[0], o4[1]); o.y = pk2(o4[2], o4[3]); *(u32x2*)(blob + (cob * 16 + r) * 72 + 32 * (cib >> 1) + 8 * q + 4 * (cib & 1)) = o;
            } else {
                const int cb = rem - 21;
                const bf16x8 xf = q < 2 ? *(const LAS bf16x8*)(BmpT_l + s4 * 384 + r * 24 + q * 8) : zfrag;
                const bf16x8 yf = q < 2 ? *(const LAS bf16x8*)(BhT_l + (cb * 16 + r) * 72 + s4 * 16 + q * 8) : zfrag;
                const f32x4 d = mma16(xf, yf, (f32x4){0.f, 0.f, 0.f, 0.f});
                const u32x2 kv = *(const LAS u32x2*)(KhT_l + (cb * 16 + r) * 72 + s4 * 16 + q * 4);
                u32x2 o; o.x = pk2(__uint_as_float(kv.x << 16) - d[0], __uint_as_float(kv.x & 0xffff0000u) - d[1]); o.y = pk2(__uint_as_float(kv.y << 16) - d[2], __uint_as_float(kv.y & 0xffff0000u) - d[3]);
                *(u32x2*)(blob + RB_KHP + (cb * 16 + r) * 24 + q * 4) = o;
            } }
          for (int idx = tid; idx < nsub * 128; idx += 512) { const int s4 = idx >> 7, cc = (idx >> 1) & 63, hf = idx & 1;
              *(u32x4*)(RB + (size_t)(chunk0 + s4) * RB_EL + RB_VT + cc * 24 + hf * 8) = *(const LAS u32x4*)(VT_l + cc * 72 + s4 * 16 + hf * 8); } }
        __syncthreads();
        }
    }
}

__device__ __forceinline__ void ph_rwkv_scan_naive(const Ctx& c, const float* __restrict__ RW, const float* __restrict__ s0, const float* __restrict__ lng, const float* __restrict__ lnb, bf16_t* __restrict__ OB,
                                                   float* __restrict__ outP, float* __restrict__ outS) {
    const float* R = RW; const float* WD = RW + (size_t)MPAD * BW; const float* K2 = WD + (size_t)MPAD * BW; const float* V = K2 + (size_t)MPAD * BW; const float* KK = V + (size_t)MPAD * BW;
    const float* BV = KK + (size_t)MPAD * BW; const float* G = BV + (size_t)MPAD * BW; const float* BON = G + (size_t)MPAD * BW;
    const int lane = c.lane;
    for (int it = 0;; ++it) {
        const int u = (it * 8 + c.wave) * c.G + c.bid;
        if (u >= (PB + SB) * 16) break;
        const int sq = u >> 4, h = u & 15;
        int row0, L; seq_info(sq, row0, L);
        float S[64];
        if (sq >= PB) { const float* p = s0 + (((size_t)(sq - PB) * 16 + h) * 64 + lane) * 64;
#pragma unroll
            for (int j = 0; j < 64; ++j) S[j] = p[j]; }
        else {
#pragma unroll
            for (int j = 0; j < 64; ++j) S[j] = 0.f; }
        const float lg = lng[h * 64 + lane], lb = lnb[h * 64 + lane];
        for (int t = 0; t < L; ++t) {
            const size_t base = (size_t)(row0 + t) * BW + h * 64; const float v = V[base + lane];
            float d = 0.f;
#pragma unroll
            for (int j = 0; j < 64; ++j) d += S[j] * KK[base + j];
            float y = 0.f;
#pragma unroll
            for (int j = 0; j < 64; ++j) { S[j] = S[j] * WD[base + j] - d * BV[base + j] + v * K2[base + j]; y += S[j] * R[base + j]; }
            const float mean = wave_sum(y) * (1.0f / 64.0f), dy = y - mean, var = wave_sum(dy * dy) * (1.0f / 64.0f);
            const float yn = dy * rsqrtf(var + 64e-5f) * lg + lb;
            OB[base + lane] = f2bf((yn + BON[base + lane]) * G[base + lane]);
        }
        float* op = (sq < PB ? outP + (((size_t)sq * 16 + h) * 64 + lane) * 64 : outS + (((size_t)(sq - PB) * 16 + h) * 64 + lane) * 64);
#pragma unroll
        for (int j = 0; j < 64; ++j) op[j] = S[j];
    }
}
__device__ __forceinline__ void ph_rwkv_scan2(const Ctx& c, int boff, const float* __restrict__ RW, const float* __restrict__ s0, const float* __restrict__ lng, const float* __restrict__ lnb, bf16_t* __restrict__ OB,
                                              float* __restrict__ outP, float* __restrict__ outS) {
    LAS float* opb = (LAS float*)c.lds;
    LAS float* yb = opb + 2 * 16 * 384;
    const int tid = c.tid, lane = c.lane, w = c.wave, rl = lane >> 3, cg = lane & 7, vrow = w * 8 + rl;
    const float* G = RW + 6 * (size_t)MPAD * BW; const float* BON = RW + 7 * (size_t)MPAD * BW;
    for (int u = (c.bid - boff + c.G) % c.G; u < (PB + SB) * 16; u += c.G) {
        const int sq = u >> 4, h = u & 15;
        int row0, L; seq_info(sq, row0, L);
        float S[8];
        if (sq >= PB) { const float* p = s0 + (((size_t)(sq - PB) * 16 + h) * 64 + vrow) * 64 + cg * 8;
#pragma unroll
            for (int j = 0; j < 8; ++j) S[j] = p[j]; }
        else {
#pragma unroll
            for (int j = 0; j < 8; ++j) S[j] = 0.f; }
        const float lg = lng[h * 64 + lane], lb = lnb[h * 64 + lane];
        const int nb = (L + 15) >> 4;
#define RW_STAGE(bi_) do { const int t0_ = (bi_) * 16, nT_ = (L - t0_) < 16 ? (L - t0_) : 16; LAS float* dst_ = opb + ((bi_) & 1) * 16 * 384; \
        for (int idx = tid; idx < nT_ * 96; idx += 512) { const int t = idx / 96, rem = idx - t * 96, slot = rem >> 4, c4 = rem & 15; \
            const int arr = slot == 0 ? 1 : slot == 1 ? 4 : slot == 2 ? 5 : slot == 3 ? 2 : slot == 4 ? 0 : 3; \
            *(LAS f32x4*)(dst_ + t * 384 + slot * 64 + c4 * 4) = *(const f32x4*)(RW + (size_t)arr * MPAD * BW + (size_t)(row0 + t0_ + t) * BW + h * 64 + c4 * 4); } } while (0)
        RW_STAGE(0);
        for (int bi = 0; bi < nb; ++bi) {
            __syncthreads();
            if (bi + 1 < nb) RW_STAGE(bi + 1);
            const int t0 = bi * 16, nT = (L - t0) < 16 ? (L - t0) : 16; const LAS float* src = opb + (bi & 1) * 16 * 384;
            for (int tt = 0; tt < nT; ++tt) {
                const LAS float* b = src + tt * 384 + cg * 8;
                const f32x4 w0 = *(const LAS f32x4*)(b), w1 = *(const LAS f32x4*)(b + 4), k0 = *(const LAS f32x4*)(b + 64), k1 = *(const LAS f32x4*)(b + 68);
                const f32x4 b0 = *(const LAS f32x4*)(b + 128), b1 = *(const LAS f32x4*)(b + 132), q0 = *(const LAS f32x4*)(b + 192), q1 = *(const LAS f32x4*)(b + 196);
                const f32x4 r0 = *(const LAS f32x4*)(b + 256), r1 = *(const LAS f32x4*)(b + 260); const float v = src[tt * 384 + 320 + vrow];
                float d = (S[0] * k0[0] + S[1] * k0[1]) + (S[2] * k0[2] + S[3] * k0[3]) + (S[4] * k1[0] + S[5] * k1[1]) + (S[6] * k1[2] + S[7] * k1[3]);
                d += __shfl_xor(d, 1, 64); d += __shfl_xor(d, 2, 64); d += __shfl_xor(d, 4, 64);
                float y = 0.f;
#pragma unroll
                for (int j = 0; j < 4; ++j) { S[j] = S[j] * w0[j] - d * b0[j] + v * q0[j]; y += S[j] * r0[j]; S[4 + j] = S[4 + j] * w1[j] - d * b1[j] + v * q1[j]; y += S[4 + j] * r1[j]; }
                y += __shfl_xor(y, 1, 64); y += __shfl_xor(y, 2, 64); y += __shfl_xor(y, 4, 64);
                if (cg == 0) yb[tt * 64 + vrow] = y;
            }
            __syncthreads();
            for (int tt = w; tt < nT; tt += 8) {
                const float y = yb[tt * 64 + lane]; const float mean = wave_sum(y) * (1.0f / 64.0f), dy = y - mean, var = wave_sum(dy * dy) * (1.0f / 64.0f);
                const float yn = dy * rsqrtf(var + 64e-5f) * lg + lb; const size_t o = (size_t)(row0 + t0 + tt) * BW + h * 64 + lane;
                OB[o] = f2bf((yn + BON[o]) * G[o]);
            }
        }
#undef RW_STAGE
        float* op = (sq < PB ? outP + (((size_t)sq * 16 + h) * 64 + vrow) * 64 : outS + (((size_t)(sq - PB) * 16 + h) * 64 + vrow) * 64) + cg * 8;
#pragma unroll
        for (int j = 0; j < 8; ++j) op[j] = S[j];
        __syncthreads();
    }
}
constexpr int RS_SLOTS = 8, RS_SLOT_B = RB_EL * 2;
__device__ __forceinline__ void ph_rwkv_seq(const Ctx& c, int boff, const bf16_t* __restrict__ RB, const float* __restrict__ s0, float* __restrict__ outP, float* __restrict__ outS, bf16_t* __restrict__ OB) {
    const int lane = c.lane, r = lane & 15, q = lane >> 4, w = c.wave;
    LAS unsigned char* ring = c.lds;
    const int side = c.bid < 32 ? c.bid : c.bid - 64, nside = c.G - 64;
    for (int u = (c.bid >= boff && c.bid < boff + 32) ? c.bid - boff : ((c.bid < 32 || c.bid >= 96) ? 32 + side : (PB + SB) * 16); u < (PB + SB) * 16; u = u < 32 ? (PB + SB) * 16 : u + nside) {
        const int sq = u >> 4, h = u & 15;
        int nch, ch0, row0, ntok; const float* sp = nullptr; float* op;
        if (sq < PB) { nch = 256; ch0 = (sq * 16 + h) * 256; row0 = sq * PS; ntok = 16; op = outP + (size_t)(sq * 16 + h) * 4096; }
        else { nch = 1; ch0 = PB * 16 * 256 + (sq - PB) * 16 + h; row0 = MP + (sq - PB) * SS; ntok = SS; sp = s0 + (size_t)((sq - PB) * 16 + h) * 4096; op = outS + (size_t)((sq - PB) * 16 + h) * 4096; }
        if (w >= 4) {
            const int lw = w - 4, p0 = lw < 2 ? lw * 5 : 10 + (lw - 2) * 4, np = lw < 2 ? 5 : 4;
#define RS_ISSUE(ci_) do { const int cc_ = (ci_) < nch ? (ci_) : nch - 1; const char* g_ = (const char*)(RB + (size_t)(ch0 + cc_) * RB_EL) + p0 * 1024 + lane * 16; \
            LAS unsigned char* d_ = ring + ((ci_) % RS_SLOTS) * RS_SLOT_B + p0 * 1024; \
            _Pragma("unroll") for (int p_ = 0; p_ < 5; ++p_) if (p_ < np) __builtin_amdgcn_global_load_lds((const unsigned*)(g_ + p_ * 1024), (LAS unsigned*)(d_ + p_ * 1024), 16, 0, 0); } while (0)
            for (int ci = 0; ci < RS_SLOTS - 1; ++ci) RS_ISSUE(ci);
            if (lw < 2) asm volatile("s_waitcnt vmcnt(30)" ::: "memory"); else asm volatile("s_waitcnt vmcnt(24)" ::: "memory");
            __builtin_amdgcn_s_barrier();
            for (int ci = 0; ci < nch; ++ci) {
                RS_ISSUE(ci + RS_SLOTS - 1);
                if (lw < 2) asm volatile("s_waitcnt vmcnt(30)" ::: "memory"); else asm volatile("s_waitcnt vmcnt(24)" ::: "memory");
                __builtin_amdgcn_s_barrier();
            }
#undef RS_ISSUE
            asm volatile("s_waitcnt vmcnt(0)" ::: "memory");
        } else {
            const int vb = w; f32x4 acc[4];
#pragma unroll
            for (int kb = 0; kb < 4; ++kb) acc[kb] = sp ? *(const f32x4*)(sp + (size_t)(vb * 16 + r) * 64 + kb * 16 + q * 4) : (f32x4){0.f, 0.f, 0.f, 0.f};
            const bf16x8 zfrag = (bf16x8){0, 0, 0, 0, 0, 0, 0, 0};
            __builtin_amdgcn_s_barrier();
            for (int ci = 0; ci < nch; ++ci) {
                const LAS bf16_t* blob = (const LAS bf16_t*)(ring + (ci % RS_SLOTS) * RS_SLOT_B);
                bf16x8 mf[4][2], khf[4], qpf[2];
#pragma unroll
                for (int kb = 0; kb < 4; ++kb) { mf[kb][0] = *(const LAS bf16x8*)(blob + (kb * 16 + r) * 72 + q * 8); mf[kb][1] = *(const LAS bf16x8*)(blob + (kb * 16 + r) * 72 + 32 + q * 8);
                    khf[kb] = q < 2 ? *(const LAS bf16x8*)(blob + RB_KHP + (kb * 16 + r) * 24 + q * 8) : zfrag; }
                qpf[0] = *(const LAS bf16x8*)(blob + RB_QP + r * 72 + q * 8); qpf[1] = *(const LAS bf16x8*)(blob + RB_QP + r * 72 + 32 + q * 8);
                const bf16x8 vt = q < 2 ? *(const LAS bf16x8*)(blob + RB_VT + (vb * 16 + r) * 24 + q * 8) : zfrag;
                const bf16x8 ep = q < 2 ? *(const LAS bf16x8*)(blob + RB_EP + r * 24 + q * 8) : zfrag;
                const bf16x8 t0 = pack_acc(acc[0], acc[1]), t1 = pack_acc(acc[2], acc[3]);
                __builtin_amdgcn_sched_barrier(0);
#pragma unroll
                for (int kb = 0; kb < 4; ++kb) acc[kb] = mma16(mf[kb][0], t0, (f32x4){0.f, 0.f, 0.f, 0.f});
#pragma unroll
                for (int kb = 0; kb < 4; ++kb) acc[kb] = mma16(mf[kb][1], t1, acc[kb]);
#pragma unroll
                for (int kb = 0; kb < 4; ++kb) acc[kb] = mma16(khf[kb], vt, acc[kb]);
                f32x4 y = mma16(t0, qpf[0], (f32x4){0.f, 0.f, 0.f, 0.f}); y = mma16(t1, qpf[1], y); y = mma16(vt, ep, y);
                if (r < ntok) { u32x2 o; o.x = pk2(y[0], y[1]); o.y = pk2(y[2], y[3]); *(u32x2*)(OB + (size_t)(row0 + ci * 16 + r) * BW + h * 64 + vb * 16 + q * 4) = o; }
                asm volatile("s_waitcnt lgkmcnt(0)" ::: "memory");
                __builtin_amdgcn_s_barrier();
            }
#pragma unroll
            for (int kb = 0; kb < 4; ++kb) *(f32x4*)(op + (size_t)(vb * 16 + r) * 64 + kb * 16 + q * 4) = acc[kb];
        }
        __syncthreads();
    }
}
__device__ __forceinline__ void ph_rwkv_fin(const Ctx& c, const float* __restrict__ RW, const float* __restrict__ lng, const float* __restrict__ lnb, const bf16_t* __restrict__ RAW, bf16_t* __restrict__ OB) {
    const int lane = c.lane; const bf16_t* G = (const bf16_t*)(RW + 6 * (size_t)MPAD * BW); const bf16_t* BON = (const bf16_t*)(RW + 7 * (size_t)MPAD * BW);
    for (int i = c.bid * 8 + c.wave; i < MT * 4; i += c.G * 8) {
        const int row = i >> 2, cc = (i & 3) * 256 + lane * 4; const size_t o = (size_t)row * BW + cc; bf16_t* p = OB + o;
        const u32x2 raw = *(const u32x2*)(RAW + o); float x[4] = {__uint_as_float(raw.x << 16), __uint_as_float(raw.x & 0xffff0000u), __uint_as_float(raw.y << 16), __uint_as_float(raw.y & 0xffff0000u)};
        float s = (x[0] + x[1]) + (x[2] + x[3]); s += __shfl_xor(s, 1, 64); s += __shfl_xor(s, 2, 64); s += __shfl_xor(s, 4, 64); s += __shfl_xor(s, 8, 64);
        const float mean = s * (1.0f / 64.0f); float qq = 0.f;
#pragma unroll
        for (int j = 0; j < 4; ++j) { const float d = x[j] - mean; qq += d * d; }
        qq += __shfl_xor(qq, 1, 64); qq += __shfl_xor(qq, 2, 64); qq += __shfl_xor(qq, 4, 64); qq += __shfl_xor(qq, 8, 64);
        const float rstd = rsqrtf(qq * (1.0f / 64.0f) + 64e-5f);
        const f32x4 gg = *(const f32x4*)(lng + cc), bb = *(const f32x4*)(lnb + cc), bo = ld4bf(BON + o), gt = ld4bf(G + o); float ov[4];
#pragma unroll
        for (int j = 0; j < 4; ++j) ov[j] = ((x[j] - mean) * rstd * gg[j] + bb[j] + bo[j]) * gt[j];
        u32x2 oo; oo.x = pk2(ov[0], ov[1]); oo.y = pk2(ov[2], ov[3]); *(u32x2*)p = oo;
    }
}

__device__ __forceinline__ void ph_memattn_sample(const Ctx& c, int boff, const bf16_t* __restrict__ U, const float* __restrict__ mk, const float* __restrict__ mv, bf16_t* __restrict__ OB) {
    LAS float* ps = (LAS float*)c.lds;
    const int hh = c.tid >> 8, vt = c.tid & 255, lane = c.lane, r = lane & 15, q = lane >> 4, w4 = c.wave & 3;
    for (int u = (c.bid - boff + c.G) % c.G; u < SB * 2; u += c.G) {
        const int sq = u >> 1, h = (u & 1) * 2 + hh;
        bf16x8 qf[8];
#pragma unroll
        for (int ks = 0; ks < 8; ++ks) { u32x4 raw = (u32x4){0u, 0u, 0u, 0u};
            if (r < 4) raw = *(const u32x4*)(U + (size_t)(MP + sq * SS + r) * NINP + U_MQ + h * 256 + ks * 32 + q * 8);
            qf[ks] = __builtin_bit_cast(bf16x8, raw); }
#pragma unroll 1
        for (int mt = 0; mt < 4; ++mt) { const float* kr = mk + (((size_t)sq * MEMT + (w4 * 4 + mt) * 16 + r) * 4 + h) * 256 + q * 8; f32x4 ka[8], kb2[8];
#pragma unroll
            for (int ks = 0; ks < 8; ++ks) { ka[ks] = *(const f32x4*)(kr + ks * 32); kb2[ks] = *(const f32x4*)(kr + ks * 32 + 4); }
            __builtin_amdgcn_sched_barrier(0);
            f32x4 d = (f32x4){0.f, 0.f, 0.f, 0.f};
#pragma unroll
            for (int ks = 0; ks < 8; ++ks) { u32x4 p; p.x = pk2(ka[ks][0], ka[ks][1]); p.y = pk2(ka[ks][2], ka[ks][3]); p.z = pk2(kb2[ks][0], kb2[ks][1]); p.w = pk2(kb2[ks][2], kb2[ks][3]);
                d = mma16(__builtin_bit_cast(bf16x8, p), qf[ks], d); }
            if (r < 4) *(LAS f32x4*)(ps + (hh * 4 + r) * 256 + (w4 * 4 + mt) * 16 + q * 4) = d * 0.0625f; }
        __syncthreads();
        { LAS float* pr = ps + c.wave * 256; float x[4]; float mx = -3.0e38f;
#pragma unroll
            for (int j = 0; j < 4; ++j) { x[j] = pr[lane + 64 * j]; mx = fmaxf(mx, x[j]); }
            mx = wave_max(mx); float s = 0.f;
#pragma unroll
            for (int j = 0; j < 4; ++j) { x[j] = __expf(x[j] - mx); s += x[j]; }
            const float inv = 1.0f / wave_sum(s);
#pragma unroll
            for (int j = 0; j < 4; ++j) pr[lane + 64 * j] = x[j] * inv; }
        __syncthreads();
        { float o[4] = {0.f, 0.f, 0.f, 0.f}; const float* vr = mv + ((size_t)sq * MEMT * 4 + h) * 256 + vt;
#pragma unroll 8
            for (int m = 0; m < MEMT; ++m) { const float vv = vr[(size_t)m * 1024];
#pragma unroll
                for (int t = 0; t < 4; ++t) o[t] += ps[(hh * 4 + t) * 256 + m] * vv; }
#pragma unroll
            for (int t = 0; t < 4; ++t) OB[(size_t)(MP + sq * SS + t) * BW + h * 256 + vt] = f2bf(o[t]); }
        __syncthreads();
    }
}

template <int K, int LDA, int LDB> __device__ __forceinline__ void skinny_pair(const Ctx& c, const bf16_t* __restrict__ A, const bf16_t* __restrict__ B0, const bf16_t* __restrict__ B1, f32x4 (&out)[2], int rot) {
    LAS f32x4* red = (LAS f32x4*)c.lds;
    const int lane = c.lane, r = lane & 15, q = lane >> 4, w = c.wave;
    constexpr int KS = K / 8;
    const bf16_t* ap = A + (size_t)r * LDA + w * KS + q * 8; const bf16_t* b0 = B0 + (size_t)r * LDB + w * KS + q * 8; const bf16_t* b1 = B1 + (size_t)r * LDB + w * KS + q * 8;
    f32x4 acc[2][8];
#pragma unroll
    for (int n = 0; n < 2; ++n)
#pragma unroll
        for (int m = 0; m < 8; ++m) acc[n][m] = (f32x4){0.f, 0.f, 0.f, 0.f};
    int kk = (int)((unsigned)rot % (unsigned)(KS / 32));
#pragma unroll 2
    for (int it = 0; it < KS / 32; ++it) { const int ks = kk; kk = kk + 1 == KS / 32 ? 0 : kk + 1;
        const bf16x8 f0 = *(const bf16x8*)(b0 + ks * 32), f1 = *(const bf16x8*)(b1 + ks * 32); bf16x8 af[8];
#pragma unroll
        for (int m = 0; m < 8; ++m) af[m] = *(const bf16x8*)(ap + (size_t)(m * 16) * LDA + ks * 32);
        __builtin_amdgcn_sched_barrier(0);
#pragma unroll
        for (int m = 0; m < 8; ++m) { acc[0][m] = mma16(f0, af[m], acc[0][m]); acc[1][m] = mma16(f1, af[m], acc[1][m]); } }
    __syncthreads();
#pragma unroll
    for (int n = 0; n < 2; ++n)
#pragma unroll
        for (int m = 0; m < 8; ++m) red[(w * 16 + n * 8 + m) * 64 + lane] = acc[n][m];
    __syncthreads();
#pragma unroll
    for (int n = 0; n < 2; ++n) { f32x4 s = red[(n * 8 + w) * 64 + lane];
#pragma unroll
        for (int ww = 1; ww < 8; ++ww) s += red[(ww * 16 + n * 8 + w) * 64 + lane];
        out[n] = s; }
}
template <int K, int LDA, int LDB> __device__ __forceinline__ f32x4 skinny_one(const Ctx& c, const bf16_t* __restrict__ A, const bf16_t* __restrict__ B0, int rot) {
    LAS f32x4* red = (LAS f32x4*)c.lds;
    const int lane = c.lane, r = lane & 15, q = lane >> 4, w = c.wave;
    constexpr int KS = K / 8, NK = KS / 32;
    const bf16_t* ap = A + (size_t)r * LDA + w * KS + q * 8; const bf16_t* b0 = B0 + (size_t)r * LDB + w * KS + q * 8;
    f32x4 acc[8];
#pragma unroll
    for (int m = 0; m < 8; ++m) acc[m] = (f32x4){0.f, 0.f, 0.f, 0.f};
    int kk = (int)((unsigned)rot % (unsigned)NK);
#pragma unroll 4
    for (int it = 0; it < NK; ++it) { const int ks = kk; kk = kk + 1 == NK ? 0 : kk + 1;
        const bf16x8 f0 = *(const bf16x8*)(b0 + ks * 32); bf16x8 af[8];
#pragma unroll
        for (int m = 0; m < 8; ++m) af[m] = *(const bf16x8*)(ap + (size_t)(m * 16) * LDA + ks * 32);
        __builtin_amdgcn_sched_barrier(0);
#pragma unroll
        for (int m = 0; m < 8; ++m) acc[m] = mma16(f0, af[m], acc[m]); }
    __syncthreads();
#pragma unroll
    for (int m = 0; m < 8; ++m) red[(w * 8 + m) * 64 + lane] = acc[m];
    __syncthreads();
    f32x4 s = red[w * 64 + lane];
#pragma unroll
    for (int ww = 1; ww < 8; ++ww) s += red[(ww * 8 + w) * 64 + lane];
    return s;
}
__device__ __forceinline__ u32x2 pk4(const f32x4 v) { u32x2 o; o.x = pk2(v[0], v[1]); o.y = pk2(v[2], v[3]); return o; }
#define SKINNY_LOOP(total_) for (int s = c.bid - base; s >= 0 && s < (total_); s += ncu)
__device__ __forceinline__ void ph_sk_in(const Ctx& c, int base, int ncu, const bf16_t* __restrict__ HB, const bf16_t* __restrict__ W, bf16_t* __restrict__ U) {
    const int r = c.lane & 15, q = c.lane >> 4, w = c.wave;
    SKINNY_LOOP(NINP / 32) { f32x4 o[2]; skinny_pair<DM, DM, DM>(c, HB + (size_t)MP * DM, W + (size_t)(s * 32) * DM, W + (size_t)(s * 32 + 16) * DM, o, s);
        bf16_t* up = U + (size_t)(MP + w * 16 + r) * NINP + s * 32 + q * 4; *(u32x2*)up = pk4(o[0]); *(u32x2*)(up + 16) = pk4(o[1]); }
}
__device__ __forceinline__ void ph_sk_merge(const Ctx& c, int base, int ncu, const bf16_t* __restrict__ BR, const bf16_t* __restrict__ W, const bf16_t* __restrict__ U, const float* __restrict__ gate_b, bf16_t* __restrict__ MGB) {
    const int r = c.lane & 15, q = c.lane >> 4, w = c.wave;
    SKINNY_LOOP(DM / 16) { const size_t row = (size_t)(MP + w * 16 + r); const int col = s * 16 + q * 4; f32x4 tot = (f32x4){0.f, 0.f, 0.f, 0.f};
#pragma unroll 1
        for (int z = 0; z < 4; ++z) { const f32x4 o = skinny_one<BW, BW, BW>(c, BR + ((size_t)z * MPAD + MP) * BW, W + ((size_t)z * DM + s * 16) * BW, s + z);
            const u32x2 gp = *(const u32x2*)(U + row * NINP + U_GP + z * DM + col); const f32x4 gb = *(const f32x4*)(gate_b + z * DM + col);
            tot[0] += sigmoidf_(__uint_as_float(gp.x << 16) + gb[0]) * o[0]; tot[1] += sigmoidf_(__uint_as_float(gp.x & 0xffff0000u) + gb[1]) * o[1];
            tot[2] += sigmoidf_(__uint_as_float(gp.y << 16) + gb[2]) * o[2]; tot[3] += sigmoidf_(__uint_as_float(gp.y & 0xffff0000u) + gb[3]) * o[3]; }
        *(u32x2*)(MGB + row * DM + col) = pk4(tot); }
}
template <int K> __device__ __forceinline__ void ph_sk_res(const Ctx& c, int base, int ncu, const bf16_t* __restrict__ A, const bf16_t* __restrict__ W, const bf16_t* __restrict__ R, bf16_t* __restrict__ Y) {
    const int r = c.lane & 15, q = c.lane >> 4, w = c.wave;
    SKINNY_LOOP(DM / 16) { const f32x4 o = skinny_one<K, K, K>(c, A + (size_t)MP * K, W + (size_t)(s * 16) * K, s);
        const size_t off = (size_t)(MP + w * 16 + r) * DM + s * 16 + q * 4; const u32x2 rr = *(const u32x2*)(R + off);
        const f32x4 rv = (f32x4){__uint_as_float(rr.x << 16), __uint_as_float(rr.x & 0xffff0000u), __uint_as_float(rr.y << 16), __uint_as_float(rr.y & 0xffff0000u)};
        *(u32x2*)(Y + off) = pk4(rv * ALPHA + o); }
}
__device__ __forceinline__ void ph_sk_gu(const Ctx& c, int base, int ncu, const bf16_t* __restrict__ X1B, const bf16_t* __restrict__ W, bf16_t* __restrict__ ACT) {
    const int r = c.lane & 15, q = c.lane >> 4, w = c.wave;
    SKINNY_LOOP(DFF / 16) { const int t = s >> 3, j0 = (s & 7) * 16; f32x4 o[2];
        skinny_pair<DM, DM, DM>(c, X1B + (size_t)MP * DM, W + (size_t)(t * 256 + j0) * DM, W + (size_t)(t * 256 + 128 + j0) * DM, o, s);
        f32x4 v;
#pragma unroll
        for (int j = 0; j < 4; ++j) v[j] = o[0][j] * sigmoidf_(o[0][j]) * o[1][j];
        *(u32x2*)(ACT + (size_t)(MP + w * 16 + r) * DFF + t * 128 + j0 + q * 4) = pk4(v); }
}
#undef SKINNY_LOOP

constexpr int LDS_BAR_OFF = 147456;
constexpr int LDS_BYTES = LDS_BAR_OFF + 64;
struct Args { const float* in[37]; float* out; unsigned char* ws; };

typedef pg8::Gemm<DM, DM, DM, 2, 8, NL, 1, false, 0, 0, (long)DM * DM, 0> GemmMem;
typedef pg8::Gemm<DM, DM, DM, MP / 256, NINP / 256> GemmIn;
typedef pg8::Gemm<NINP, 1024, 256, PS / 256, 1, 8, 4, false, (long)PS * NINP, 256, 256 * 1024, 256> GemmScore;
typedef pg8::Gemm<256, 256, 256, PS / 256, 1, 8, 4, false, (long)4 * 4096 * 256, (long)4096 * 256, 4 * 65536, 65536> GemmPV;
typedef pg8::Gemm<BW, BW, BW, MP / 256, DM / 256, 4, 1, true, (long)MPAD * BW, 0, (long)DM * BW, 0> GemmBranch;
typedef pg8::Gemm<DM, DM, DM, MP / 256, DM / 256> GemmOut;
typedef pg8::Gemm<DM, DM, DM, MP / 256, 2 * DFF / 256> GemmGU;
typedef pg8::Gemm<DFF, DFF, DFF, MP / 256, DM / 256> GemmDown;
template <class GT> __device__ __forceinline__ GT mk_gemm(const Ctx& c, const bf16_t* A, const bf16_t* B) { GT g; g.A = A; g.B = B; g.G = c.G; g.c = c.bid; return g; }

template <int OFF> __device__ __forceinline__ unsigned long long karg_u64(unsigned long long kargs) {
    unsigned long long p; asm volatile("s_load_dwordx2 %0, %1, %2\n\ts_waitcnt lgkmcnt(0)" : "=s"(p) : "s"(kargs), "n"(OFF) : "memory"); return p;
}
#define GPTR(T, x) ((T*)(__attribute__((address_space(1))) T*)(x))
#define INP(k) GPTR(const float, karg_u64<(k) * 8>(kargs))
#define OUTP() GPTR(float, karg_u64<37 * 8>(kargs))
#define WSP() GPTR(unsigned char, karg_u64<38 * 8>(kargs))

__global__ void __launch_bounds__(512, 2) mega_fwd(Args a_unused) {
    extern __shared__ __attribute__((aligned(16))) unsigned char lds_raw[];
    const unsigned long long kargs = (unsigned long long)__builtin_amdgcn_kernarg_segment_ptr();
    Ctx c0; c0.tid = threadIdx.x; c0.lane = c0.tid & 63; c0.wave = __builtin_amdgcn_readfirstlane(c0.tid >> 6); c0.bid = blockIdx.x; c0.G = gridDim.x; c0.lds = (LAS unsigned char*)lds_raw;
    if (c0.tid < 4) ((LAS unsigned*)(c0.lds + LDS_BAR_OFF))[c0.tid] = 0u;
    __syncthreads();
    const XcdBarrier bar = xcd_barrier_post((unsigned*)(WSP() + WS_CTL), (volatile LAS unsigned*)(c0.lds + LDS_BAR_OFF));

#define WPREP_LAYER(cc_, L_) do { unsigned char* ws_ = WSP(); \
      ph_wprep(cc_, INP(10) + (size_t)(L_) * DM * NIN, (bf16_t*)(ws_ + WS_WIN) + (size_t)(L_) * NINP * DM, DM, NIN, NINP, 1, 1, 0, 0); \
      ph_wprep(cc_, INP(29) + (size_t)(L_) * 4 * BW * DM, (bf16_t*)(ws_ + WS_WBR) + (size_t)(L_) * 4 * DM * BW, BW, DM, DM, 0, 4, (size_t)BW * DM, (size_t)DM * BW); \
      ph_wprep(cc_, INP(30) + (size_t)(L_) * DM * DM, (bf16_t*)(ws_ + WS_WOUT) + (size_t)(L_) * DM * DM, DM, DM, DM, 0, 1, 0, 0); \
      ph_wprep(cc_, INP(33) + (size_t)(L_) * DM * 2 * DFF, (bf16_t*)(ws_ + WS_WGU) + (size_t)(L_) * 2 * DFF * DM, DM, 2 * DFF, 2 * DFF, 2, 1, 0, 0); \
      ph_wprep(cc_, INP(34) + (size_t)(L_) * DFF * DM, (bf16_t*)(ws_ + WS_WDN) + (size_t)(L_) * DM * DFF, DFF, DM, DM, 0, 1, 0, 0); } while (0)
    { const Ctx c = fresh(c0); unsigned char* ws = WSP();
      ph_wprep(c, INP(28), (bf16_t*)(ws + WS_WMEM), DM, DM, DM, 0, NL, (size_t)DM * DM, (size_t)DM * DM);
      WPREP_LAYER(c, 0);
      ph_lrw(c, INP(19), INP(21), INP(22), (bf16_t*)(ws + WS_LRW));
      ph_xprep(c, INP(0), INP(1), INP(2), (float*)nullptr, (bf16_t*)(ws + WS_HB), (bf16_t*)(ws + WS_MEMB)); }
    xcd_barrier(bar);
    { const Ctx c = fresh(c0); unsigned char* ws = WSP(); float* out = OUTP();
      GemmMem g = mk_gemm<GemmMem>(c, (const bf16_t*)(ws + WS_MEMB), (const bf16_t*)(ws + WS_WMEM));
      pg8::EpiMem E; E.outK = out + O_MKP; E.outV = out + O_MVP; E.kb = (bf16_t*)(ws + WS_MKB); E.vt = (bf16_t*)(ws + WS_MVT); pg8::gemm_phase<GemmMem, pg8::EpiMem, true, true>(c.lds, c.tid, g, E); }

    for (int l = 0; l < NL; ++l) {
        { const Ctx c = fresh(c0); unsigned char* ws = WSP();
          GemmIn g = mk_gemm<GemmIn>(c, (const bf16_t*)(ws + WS_HB), (const bf16_t*)(ws + WS_WIN) + (size_t)l * NINP * DM);
          pg8::EpiBf16 E; E.O = (bf16_t*)(ws + WS_U); E.zs = 0; E.ldc = NINP; E.pad = 0; pg8::gemm_phase<GemmIn, pg8::EpiBf16, true, true>(c.lds, c.tid, g, E); }
        { const Ctx c = fresh(c0); unsigned char* ws = WSP(); ph_sk_in(c, c.G > 192 ? 96 : 0, c.G > 192 ? c.G - 96 : c.G, (const bf16_t*)(ws + WS_HB), (const bf16_t*)(ws + WS_WIN) + (size_t)l * NINP * DM, (bf16_t*)(ws + WS_U)); }
        xcd_barrier(bar);
        { const Ctx c = fresh(c0); unsigned char* ws = WSP(); float* out = OUTP(); const bf16_t* U = (const bf16_t*)(ws + WS_U); bf16_t* BR = (bf16_t*)(ws + WS_BR);
          (void)out; (void)BR;
          ph_gla_pre(c, U, INP(12) + (size_t)l * 16 * 512, INP(13) + (size_t)l * 512, (bf16_t*)(ws + WS_GLQD), (bf16_t*)(ws + WS_GLKH), (bf16_t*)(ws + WS_GLE), (bf16_t*)(ws + WS_GLVT), (float*)(ws + WS_GLGC)); }
        { const Ctx c = fresh(c0); unsigned char* ws = WSP();
          ph_rwkv_pre(c, (const bf16_t*)(ws + WS_U), INP(9) + (size_t)l * SB * RWC, INP(17) + (size_t)l * RWC, INP(18) + (size_t)l * BW, INP(19) + (size_t)l * 64 * BW, INP(20) + (size_t)l * BW, INP(21) + (size_t)l * 64 * BW,
                       INP(22) + (size_t)l * 128 * BW, INP(23) + (size_t)l * BW, INP(24) + (size_t)l * BW, INP(25) + (size_t)l * BW, (float*)(ws + WS_RW), (bf16_t*)(ws + WS_RB), (const bf16_t*)(ws + WS_LRW) + (size_t)l * 1024 * 256); }
        { const Ctx c = fresh(c0); unsigned char* ws = WSP();
          GemmScore g = mk_gemm<GemmScore>(c, (const bf16_t*)(ws + WS_U) + U_MQ, (const bf16_t*)(ws + WS_MKB) + (size_t)l * 512 * 1024); g.c = (c.bid + c.G / 2) % c.G;
          pg8::EpiScore E; E.SC = (float*)(ws + WS_SC); pg8::gemm_phase<GemmScore, pg8::EpiScore, true, true>(c.lds, c.tid, g, E); }
        xcd_barrier(bar);
        { const Ctx c = fresh(c0); unsigned char* ws = WSP(); float* out = OUTP();
          ph_rwkv_seq(c, 64, (const bf16_t*)(ws + WS_RB), INP(8) + (size_t)l * SB * 16 * 4096, out + O_RWP + (size_t)l * PB * 16 * 4096, out + O_RWS + (size_t)l * SB * 16 * 4096,
                      (bf16_t*)(ws + WS_RAW) + (size_t)MPAD * BW); }
        { const Ctx c = fresh(c0); unsigned char* ws = WSP(); float* out = OUTP();
          ph_gla_seq(c, 32, (const bf16_t*)(ws + WS_GLQD), (const bf16_t*)(ws + WS_GLKH), (const bf16_t*)(ws + WS_GLE), (const bf16_t*)(ws + WS_GLVT), (const float*)(ws + WS_GLGC),
                     INP(7) + (size_t)l * SB * 4 * 32768, out + O_GLAP + (size_t)l * PB * 4 * 32768, out + O_GLAS + (size_t)l * SB * 4 * 32768, (bf16_t*)(ws + WS_RAW)); }
        if ((c0.bid < 32 || c0.bid >= 96) && c0.G > 96) {
        { Ctx c = fresh(c0); c.bid = c.bid < 32 ? c.bid : c.bid - 64; c.G = c.G - 64; unsigned char* ws = WSP(); ph_softmax256(c, (const float*)(ws + WS_SC), (bf16_t*)(ws + WS_PB), 8 * 4096); }
        { Ctx c = fresh(c0); c.bid = c.bid < 32 ? c.bid : c.bid - 64; c.G = c.G - 64; unsigned char* ws = WSP(); ph_swa_prompt(c, (const bf16_t*)(ws + WS_U), INP(16) + (size_t)l * 16, (bf16_t*)(ws + WS_BR) + (size_t)MPAD * BW); }
        { Ctx c = fresh(c0); c.bid = c.bid < 32 ? c.bid : c.bid - 64; c.G = c.G - 64; unsigned char* ws = WSP();
          ph_swa_sample(c, (const bf16_t*)(ws + WS_U), INP(3) + (size_t)l * SB * 16384, INP(4) + (size_t)l * SB * 16384, INP(16) + (size_t)l * 16, (bf16_t*)(ws + WS_BR) + (size_t)MPAD * BW); }
        { Ctx c = fresh(c0); c.bid = c.bid < 32 ? c.bid : c.bid - 64; c.G = c.G - 64; unsigned char* ws = WSP();
          ph_memattn_sample(c, 64, (const bf16_t*)(ws + WS_U), INP(5) + (size_t)l * SB * MEMT * 1024, INP(6) + (size_t)l * SB * MEMT * 1024, (bf16_t*)(ws + WS_BR) + (size_t)3 * MPAD * BW); }
        { Ctx c = fresh(c0); c.bid = c.bid < 32 ? c.bid : c.bid - 64; c.G = c.G - 64; unsigned char* ws = WSP();
          ph_copy_outs(c, (const bf16_t*)(ws + WS_U), INP(3) + (size_t)l * SB * 16384, INP(4) + (size_t)l * SB * 16384, OUTP(), l); }
          if (l + 1 < NL) { Ctx c = fresh(c0); const int sd = c.bid < 32 ? c.bid : c.bid - 64; c.G = 2 * (c.G - 64) + 96;
            c.bid = 2 * sd; WPREP_LAYER(c, l + 1); c.bid = 2 * sd + 1; WPREP_LAYER(c, l + 1); }
        } else if (l + 1 < NL && c0.G > 96) { Ctx c = fresh(c0); const int nside2 = 2 * (c.G - 64); c.G = nside2 + 96;
          if (c0.bid < 64) { c.bid = nside2 + 2 * (c0.bid - 32); WPREP_LAYER(c, l + 1); c.bid = nside2 + 2 * (c0.bid - 32) + 1; WPREP_LAYER(c, l + 1); }
          else { c.bid = nside2 + 64 + (c0.bid - 64); WPREP_LAYER(c, l + 1); }
        }
        xcd_barrier(bar);
        { const Ctx c = fresh(c0); unsigned char* ws = WSP(); ph_rwkv_fin(c, (const float*)(ws + WS_RW), INP(26) + (size_t)l * BW, INP(27) + (size_t)l * BW, (const bf16_t*)(ws + WS_RAW) + (size_t)MPAD * BW, (bf16_t*)(ws + WS_BR) + (size_t)2 * MPAD * BW); }
        { const Ctx c = fresh(c0); unsigned char* ws = WSP(); ph_gla_fin(c, (const bf16_t*)(ws + WS_U), INP(14) + (size_t)l * BW, INP(15) + (size_t)l * BW, (const bf16_t*)(ws + WS_RAW), (bf16_t*)(ws + WS_BR)); }
        { const Ctx c = fresh(c0); unsigned char* ws = WSP();
          GemmPV g = mk_gemm<GemmPV>(c, (const bf16_t*)(ws + WS_PB), (const bf16_t*)(ws + WS_MVT) + (size_t)l * 8 * 65536);
          pg8::EpiPV E; E.O = (bf16_t*)(ws + WS_BR) + (size_t)3 * MPAD * BW; pg8::gemm_phase<GemmPV, pg8::EpiPV, true, true>(c.lds, c.tid, g, E); }
        xcd_barrier(bar);
        { const Ctx c = fresh(c0); unsigned char* ws = WSP();
          GemmBranch g = mk_gemm<GemmBranch>(c, (const bf16_t*)(ws + WS_BR), (const bf16_t*)(ws + WS_WBR) + (size_t)l * 4 * DM * BW);
          pg8::EpiMerge E; E.MG = (float*)(ws + WS_MG); E.MGB = (bf16_t*)(ws + WS_MGB); E.U = (const bf16_t*)(ws + WS_U); E.gate_b = INP(11) + (size_t)l * 4 * DM; pg8::gemm_phase<GemmBranch, pg8::EpiMerge, true, true>(c.lds, c.tid, g, E); }
        { const Ctx c = fresh(c0); unsigned char* ws = WSP(); ph_sk_merge(c, 0, c.G, (const bf16_t*)(ws + WS_BR), (const bf16_t*)(ws + WS_WBR) + (size_t)l * 4 * DM * BW, (const bf16_t*)(ws + WS_U), INP(11) + (size_t)l * 4 * DM, (bf16_t*)(ws + WS_MGB)); }
        xcd_barrier(bar);
        { const Ctx c = fresh(c0); unsigned char* ws = WSP();
          GemmOut g = mk_gemm<GemmOut>(c, (const bf16_t*)(ws + WS_MGB), (const bf16_t*)(ws + WS_WOUT) + (size_t)l * DM * DM);
          pg8::EpiRes E; E.R = (const bf16_t*)(ws + WS_HB); E.Y = (bf16_t*)(ws + WS_Y); pg8::gemm_phase<GemmOut, pg8::EpiRes, true, true>(c.lds, c.tid, g, E); }
        { const Ctx c = fresh(c0); unsigned char* ws = WSP(); ph_sk_res<DM>(c, c.G > 192 ? 128 : 0, c.G > 192 ? c.G - 128 : c.G, (const bf16_t*)(ws + WS_MGB), (const bf16_t*)(ws + WS_WOUT) + (size_t)l * DM * DM, (const bf16_t*)(ws + WS_HB), (bf16_t*)(ws + WS_Y)); }
        xcd_barrier(bar);
        { const Ctx c = fresh(c0); unsigned char* ws = WSP(); ph_ln(c, (const bf16_t*)(ws + WS_Y), INP(31) + (size_t)l * DM, INP(32) + (size_t)l * DM, (float*)nullptr, (bf16_t*)(ws + WS_X1B), nullptr, MT, 0); }
        xcd_barrier(bar);
        { const Ctx c = fresh(c0); unsigned char* ws = WSP();
          GemmGU g = mk_gemm<GemmGU>(c, (const bf16_t*)(ws + WS_X1B), (const bf16_t*)(ws + WS_WGU) + (size_t)l * 2 * DFF * DM);
          pg8::EpiSwiGLU E; E.O = (bf16_t*)(ws + WS_ACT); pg8::gemm_phase<GemmGU, pg8::EpiSwiGLU, true, true>(c.lds, c.tid, g, E); }
        { const Ctx c = fresh(c0); unsigned char* ws = WSP(); ph_sk_gu(c, c.G > 192 ? 128 : 0, c.G > 192 ? c.G - 128 : c.G, (const bf16_t*)(ws + WS_X1B), (const bf16_t*)(ws + WS_WGU) + (size_t)l * 2 * DFF * DM, (bf16_t*)(ws + WS_ACT)); }
        xcd_barrier(bar);
        { const Ctx c = fresh(c0); unsigned char* ws = WSP();
          GemmDown g = mk_gemm<GemmDown>(c, (const bf16_t*)(ws + WS_ACT), (const bf16_t*)(ws + WS_WDN) + (size_t)l * DM * DFF);
          pg8::EpiRes E; E.R = (const bf16_t*)(ws + WS_X1B); E.Y = (bf16_t*)(ws + WS_Y); pg8::gemm_phase<GemmDown, pg8::EpiRes, true, true>(c.lds, c.tid, g, E); }
        { const Ctx c = fresh(c0); unsigned char* ws = WSP(); ph_sk_res<DFF>(c, 0, c.G, (const bf16_t*)(ws + WS_ACT), (const bf16_t*)(ws + WS_WDN) + (size_t)l * DM * DFF, (const bf16_t*)(ws + WS_X1B), (bf16_t*)(ws + WS_Y)); }
        xcd_barrier(bar);
        { const Ctx c = fresh(c0); unsigned char* ws = WSP(); float* out = OUTP(); ph_ln(c, (const bf16_t*)(ws + WS_Y), INP(35) + (size_t)l * DM, INP(36) + (size_t)l * DM, (float*)nullptr, (bf16_t*)(ws + WS_HB), l == NL - 1 ? out : nullptr, MT, MT); }
        xcd_barrier(bar);
    }
}

extern "C" void kernel_launch(void* const* d_in, const int* in_sizes, int n_in, void* d_out, int out_size, void* d_ws, size_t ws_size, hipStream_t stream) {
    static int grid = 0;
    if (grid == 0) {
        if (n_in != 37 || (size_t)out_size != O_END || ws_size < WS_END) { fprintf(stderr, "kernel_launch: unexpected sizes (n_in %d out %d ws %zu need %zu)\n", n_in, out_size, ws_size, (size_t)WS_END); grid = -1; return; }
        int dev = 0, cus = 0;
        if (hipGetDevice(&dev) != hipSuccess || hipDeviceGetAttribute(&cus, hipDeviceAttributeMultiprocessorCount, dev) != hipSuccess) { grid = -1; return; }
        if (hipFuncSetAttribute((const void*)mega_fwd, hipFuncAttributeMaxDynamicSharedMemorySize, LDS_BYTES) != hipSuccess) { fprintf(stderr, "kernel_launch: hipFuncSetAttribute failed\n"); grid = -1; return; }
        int per_cu = 0;
        if (hipOccupancyMaxActiveBlocksPerMultiprocessor(&per_cu, (const void*)mega_fwd, 512, LDS_BYTES) != hipSuccess || per_cu < 1) { fprintf(stderr, "kernel_launch: occupancy query says %d\n", per_cu); }
        (void)hipGetLastError();
        grid = cus;
    }
    if (grid < 0) return;
    (void)hipMemsetAsync((unsigned char*)d_ws + WS_CTL, 0, XCD_BAR_WORDS * sizeof(unsigned), stream);
    Args a; memset(&a, 0, sizeof a);
    for (int i = 0; i < 37; ++i) a.in[i] = (const float*)d_in[i];
    a.out = (float*)d_out; a.ws = (unsigned char*)d_ws;
    hipLaunchKernelGGL(mega_fwd, dim3(grid), dim3(512), LDS_BYTES, stream, a);
}
```

```cpp
#include <hip/hip_runtime.h>
#include <cstdio>
#include <cstdint>
#include <cstring>

#define LAS __attribute__((address_space(3)))
typedef unsigned short bf16_t;
typedef short bf16x8 __attribute__((ext_vector_type(8)));
typedef float f32x4 __attribute__((ext_vector_type(4)));
typedef float f32x2 __attribute__((ext_vector_type(2)));
typedef unsigned u32x4 __attribute__((ext_vector_type(4)));
typedef unsigned u32x2 __attribute__((ext_vector_type(2)));

constexpr int DM = 2048, NL = 4;
constexpr int PB = 2, PS = 4096, MP = PB * PS;
constexpr int SB = 32, SS = 4, MS = SB * SS;
constexpr int MT = MP + MS;
constexpr int MPAD = 8448;
constexpr int NIN = 16912, NINP = 17152;
constexpr int U_GQ = 0, U_GK = 512, U_GV = 1024, U_GR = 2048, U_GA = 3072, U_SQ = 3328, U_SK = 4352, U_SV = 4480, U_RU = 4608, U_MQ = 7936, U_GP = 8960;
constexpr int RWC = 3328, BW = 1024, DFF = 5632, MEMT = 256;
constexpr float ALPHA = 1.681792830507429f;

constexpr size_t O_YP = 0;
constexpr size_t O_YS = O_YP + (size_t)MP * DM;
constexpr size_t O_SWKP = O_YS + (size_t)MS * DM;
constexpr size_t O_SWVP = O_SWKP + (size_t)NL * PB * 128 * 128;
constexpr size_t O_MKP = O_SWVP + (size_t)NL * PB * 128 * 128;
constexpr size_t O_MVP = O_MKP + (size_t)NL * PB * 256 * 1024;
constexpr size_t O_GLAP = O_MVP + (size_t)NL * PB * 256 * 1024;
constexpr size_t O_RWP = O_GLAP + (size_t)NL * PB * 4 * 128 * 256;
constexpr size_t O_RSP = O_RWP + (size_t)NL * PB * 16 * 64 * 64;
constexpr size_t O_SWKS = O_RSP + (size_t)NL * PB * RWC;
constexpr size_t O_SWVS = O_SWKS + (size_t)NL * SB * 128 * 128;
constexpr size_t O_GLAS = O_SWVS + (size_t)NL * SB * 128 * 128;
constexpr size_t O_RWS = O_GLAS + (size_t)NL * SB * 4 * 128 * 256;
constexpr size_t O_RSS = O_RWS + (size_t)NL * SB * 16 * 64 * 64;
constexpr size_t O_END = O_RSS + (size_t)NL * SB * RWC;
static_assert(O_END == 52881408, "output size");

constexpr size_t al256(size_t x) { return (x + 255) & ~(size_t)255; }
constexpr size_t WS_CTL = 0;
constexpr size_t WS_WIN = 65536;
constexpr size_t WS_WMEM = WS_WIN + (size_t)NL * NINP * DM * 2;
constexpr size_t WS_WBR = WS_WMEM + (size_t)NL * DM * DM * 2;
constexpr size_t WS_WOUT = WS_WBR + (size_t)NL * 4 * DM * BW * 2;
constexpr size_t WS_WGU = WS_WOUT + (size_t)NL * DM * DM * 2;
constexpr size_t WS_WDN = WS_WGU + (size_t)NL * 2 * DFF * DM * 2;
constexpr size_t WS_HF = WS_WDN + (size_t)NL * DM * DFF * 2;
constexpr size_t WS_HB = WS_HF + (size_t)MPAD * DM * 4;
constexpr size_t WS_U = WS_HB + (size_t)MPAD * DM * 2;
constexpr size_t WS_BR = WS_U + (size_t)MPAD * NINP * 2;
constexpr size_t WS_MG = WS_BR + (size_t)4 * MPAD * BW * 2;
constexpr size_t WS_MGB = WS_MG + (size_t)MPAD * DM * 4;
constexpr size_t WS_Y = WS_MGB + (size_t)MPAD * DM * 2;
constexpr size_t WS_X1F = WS_Y + (size_t)MPAD * DM * 4;
constexpr size_t WS_X1B = WS_X1F + (size_t)MPAD * DM * 4;
constexpr size_t WS_ACT = WS_X1B + (size_t)MPAD * DM * 2;
constexpr size_t WS_MEMB = WS_ACT + (size_t)MPAD * DFF * 2;
constexpr size_t WS_MKB = WS_MEMB + (size_t)512 * DM * 2;
constexpr size_t WS_MVT = WS_MKB + (size_t)NL * 512 * 1024 * 2;
constexpr size_t WS_SC = WS_MVT + (size_t)NL * 8 * 256 * 256 * 2;
constexpr size_t WS_PB = WS_SC + (size_t)8 * 4096 * 256 * 4;
constexpr size_t WS_RW = WS_PB + (size_t)8 * 4096 * 256 * 2;
constexpr size_t RW_ARR = (size_t)MPAD * BW * 4;
constexpr int GL_NCH = 512 + 128;
constexpr size_t WS_GLQD = WS_RW + 8 * RW_ARR;
constexpr size_t WS_GLKH = WS_GLQD + (size_t)GL_NCH * 8192 * 2;
constexpr size_t WS_GLE = WS_GLKH + (size_t)GL_NCH * 8192 * 2;
constexpr size_t WS_GLVT = WS_GLE + (size_t)GL_NCH * 4096 * 2;
constexpr size_t WS_GLGC = WS_GLVT + (size_t)GL_NCH * 16384 * 2;
constexpr int RB_NCH = PB * 16 * 256 + SB * 16;
constexpr int RB_EL = 9216;
constexpr int RB_QP = 4608, RB_KHP = 5760, RB_VT = 7296, RB_EP = 8832;
constexpr size_t WS_RB = WS_GLGC + (size_t)GL_NCH * 128 * 4;
constexpr size_t WS_RAW = WS_RB + (size_t)RB_NCH * RB_EL * 2;
constexpr size_t WS_LRW = WS_RAW + (size_t)2 * MPAD * BW * 2;
constexpr size_t WS_END = WS_LRW + (size_t)NL * 16 * 64 * 256 * 2;

__device__ __forceinline__ float bf2f(bf16_t b) { return __uint_as_float(((unsigned)b) << 16); }
typedef __bf16 bf16v2_t __attribute__((ext_vector_type(2)));
__device__ __forceinline__ unsigned pk2(float lo, float hi) { const f32x2 v = {lo, hi}; return __builtin_bit_cast(unsigned, __builtin_convertvector(v, bf16v2_t)); }
__device__ __forceinline__ bf16_t f2bf(float f) { return (bf16_t)(pk2(f, 0.f) & 0xffffu); }
__device__ __forceinline__ f32x4 ld4bf(const bf16_t* p) { const u32x2 w = *(const u32x2*)p; return (f32x4){__uint_as_float(w.x << 16), __uint_as_float(w.x & 0xffff0000u), __uint_as_float(w.y << 16), __uint_as_float(w.y & 0xffff0000u)}; }
__device__ __forceinline__ float wave_sum(float v) {
#pragma unroll
    for (int o = 32; o > 0; o >>= 1) v += __shfl_xor(v, o, 64);
    return v;
}
__device__ __forceinline__ float wave_max(float v) {
#pragma unroll
    for (int o = 32; o > 0; o >>= 1) v = fmaxf(v, __shfl_xor(v, o, 64));
    return v;
}
__device__ __forceinline__ float sigmoidf_(float x) { return 1.0f / (1.0f + __expf(-x)); }
__device__ __forceinline__ float softplusf_(float x) { return fmaxf(x, 0.f) + log1pf(__expf(-fabsf(x))); }
__device__ __forceinline__ float softplus_fast(float x) { return fmaxf(x, 0.f) + __logf(1.0f + __expf(-fabsf(x))); }
__device__ __forceinline__ float tanh_fast(float x) { return 1.0f - 2.0f / (1.0f + __expf(2.0f * x)); }

namespace pg8 {
constexpr int BM = 256, BK = 64, HALF = 128, HTB = HALF * BK * 2, STAGE_BYTES = 8 * HTB, NXCD = 8, WGM = 8;
__host__ __device__ __forceinline__ int lds_byte(int r, int c) { const int st = (r >> 4) * 2 + (c >> 5), rr = r & 15, cc = c & 31, ob = rr * 64 + cc * 2; return st * 1024 + (ob ^ (((ob >> 9) & 1) << 5)); }
__host__ __device__ __forceinline__ void stage_rc(int b, int& R, int& C) { const int st = b / 1024, sb = b % 1024, swz = sb ^ (((sb >> 9) & 1) << 5); R = (st >> 1) * 16 + swz / 64; C = (st & 1) * 32 + (swz % 64) / 2; }
__host__ __device__ __forceinline__ int perm32(int rho) { const int n = rho >> 4, i = rho & 15; return 8 * (i >> 2) + 4 * n + (i & 3); }

struct Unit { int pm, pn, z; };
template <int LDA_, int LDB_, int K_, int NM_, int NN_, int NZ_ = 1, int NZH_ = 1, bool ZINNER_ = false, long ZSAB_ = 0, long ZSAH_ = 0, long ZSBB_ = 0, long ZSBH_ = 0>
struct Gemm {
    static constexpr int LDA = LDA_, LDB = LDB_, K = K_, NM = NM_, NN = NN_, NZ = NZ_, NZH = NZH_; static constexpr bool ZINNER = ZINNER_;
    const bf16_t* A; const bf16_t* B; int G, c;
    __device__ __forceinline__ bool next(int i, Unit& u) const {
        constexpr int nt = NM * NN; int L, z;
        if (ZINNER) { const int it = i / NZ; z = i - it * NZ; const long LL = (long)it * G + c; if (LL >= nt) return false; L = (int)LL; }
        else { const long LL = (long)i * G + c; if (LL >= (long)nt * NZ) return false; z = (int)(LL / nt); L = (int)(LL - (long)z * nt); }
        int wgid = L; { constexpr int q = nt / NXCD, r = nt % NXCD; const int xcd = wgid % NXCD, off = wgid / NXCD; wgid = (xcd < r ? xcd * (q + 1) : r * (q + 1) + (xcd - r) * q) + off; }
        constexpr int nig = WGM * NN; const int gid = wgid / nig, fm = gid * WGM, gsz = (NM - fm) < WGM ? (NM - fm) : WGM;
        u.pm = fm + ((wgid % nig) % gsz); u.pn = (wgid % nig) / gsz; u.z = z; return true;
    }
    __device__ __forceinline__ const char* a_base(const Unit& u) const { const int zb = u.z / NZH, zh = u.z - zb * NZH; return (const char*)(A + zb * ZSAB_ + zh * ZSAH_ + (long)u.pm * BM * LDA); }
    __device__ __forceinline__ const char* b_base(const Unit& u) const { const int zb = u.z / NZH, zh = u.z - zb * NZH; return (const char*)(B + zb * ZSBB_ + zh * ZSBH_ + (long)u.pn * BM * LDB); }
};

template <class GT, class Epi, bool ALIGN_EPI = true, bool SP2 = true>
__device__ __forceinline__ void gemm_phase(LAS unsigned char* lds, const int tid, const GT& g, const Epi& E) {
    const int wid = __builtin_amdgcn_readfirstlane(tid >> 6), lane = tid & 63, wr = wid >> 2, wc = wid & 3, fr = lane & 15, fq = lane >> 4;
    constexpr int nt = GT::K / BK;
    unsigned voffA[2], voffB[2];
#pragma unroll
    for (int i = 0; i < 2; ++i) { int R, C; stage_rc(tid * 16 + i * 8192, R, C); const int Rb = Epi::PERM ? ((R & ~31) + perm32(R & 31)) : R;
        voffA[i] = (unsigned)(R * GT::LDA + C) * 2u; voffB[i] = (unsigned)(Rb * GT::LDB + C) * 2u; }
    constexpr size_t kstep = (size_t)(BK * 2);
    constexpr size_t hstepA = (size_t)HALF * GT::LDA * 2, hstepB = (size_t)HALF * GT::LDB * 2;
    const unsigned ldsw = (unsigned)wid * 1024u;
    const int aoff = lds_byte(wr * 64 + fr, fq * 8), boff = lds_byte(wc * 32 + fr, fq * 8);
#define PG8_SA(b, h) (((b) * 2 + (h)) * HTB)
#define PG8_SB(b, h) ((4 + (b) * 2 + (h)) * HTB)
#define PG8_STAGE(bufoff, gbase, voff) do { _Pragma("unroll") for (int _i = 0; _i < 2; ++_i) \
        __builtin_amdgcn_global_load_lds((const unsigned*)((const char*)(gbase) + (voff)[_i]), (LAS unsigned*)(lds + (bufoff) + ldsw + _i * 8192), 16, 0, 0); } while (0)
#define PG8_LDA(dst, b, h) do { _Pragma("unroll") for (int m = 0; m < 4; ++m) _Pragma("unroll") for (int k = 0; k < 2; ++k) dst[m][k] = *(const LAS bf16x8*)(lds + PG8_SA(b, h) + aoff + m * 2048 + k * 1024); } while (0)
#define PG8_LDB(dst, b, h) do { _Pragma("unroll") for (int n = 0; n < 2; ++n) _Pragma("unroll") for (int k = 0; k < 2; ++k) dst[n][k] = *(const LAS bf16x8*)(lds + PG8_SB(b, h) + boff + n * 2048 + k * 1024); } while (0)
#define PG8_MMA(ai, bj, At, Bt) do { __builtin_amdgcn_s_setprio(1); _Pragma("unroll") for (int m = 0; m < 4; ++m) _Pragma("unroll") for (int n = 0; n < 2; ++n) _Pragma("unroll") for (int k = 0; k < 2; ++k) \
        acc[ai][bj][m][n] = __builtin_amdgcn_mfma_f32_16x16x32_bf16(Bt[n][k], At[m][k], acc[ai][bj][m][n], 0, 0, 0); __builtin_amdgcn_s_setprio(0); } while (0)
#define PG8_WAIT_V(n) asm volatile("s_waitcnt vmcnt(" #n ")" ::: "memory")
#define PG8_WAIT_L(n) asm volatile("s_waitcnt lgkmcnt(" #n ")" ::: "memory")
#define PG8_BAR __builtin_amdgcn_s_barrier()
#define PG8_SCHED __builtin_amdgcn_sched_barrier(0)
    Unit cur, nxt; int ui = 0;
    if (!g.next(0, cur)) return;
    f32x4 acc[2][2][4][2];
#pragma unroll
    for (int a = 0; a < 2; ++a)
#pragma unroll
        for (int b = 0; b < 2; ++b)
#pragma unroll
            for (int m = 0; m < 4; ++m)
#pragma unroll
                for (int n = 0; n < 2; ++n) acc[a][b][m][n] = (f32x4){0.f, 0.f, 0.f, 0.f};
    bf16x8 At[4][2], B0[2][2], B1[2][2];
    const char* cA = g.a_base(cur); const char* cB = g.b_base(cur);
    if constexpr (SP2) {
        PG8_STAGE(PG8_SB(0, 0), cB, voffB); PG8_STAGE(PG8_SB(0, 1), cB + hstepB, voffB); PG8_STAGE(PG8_SA(0, 0), cA, voffA); PG8_STAGE(PG8_SA(0, 1), cA + hstepA, voffA);
        if (wr == 1) PG8_BAR;
        PG8_WAIT_V(2); PG8_BAR;
        PG8_STAGE(PG8_SB(1, 0), cB + kstep, voffB); PG8_STAGE(PG8_SA(1, 0), cA + kstep, voffA); PG8_STAGE(PG8_SB(1, 1), cB + hstepB + kstep, voffB);
        PG8_WAIT_V(6); PG8_BAR;
    } else {
        PG8_STAGE(PG8_SB(0, 0), cB, voffB); PG8_STAGE(PG8_SA(0, 0), cA, voffA); PG8_STAGE(PG8_SB(0, 1), cB + hstepB, voffB); PG8_STAGE(PG8_SA(0, 1), cA + hstepA, voffA);
        if (wr == 1) PG8_BAR;
        PG8_WAIT_V(4); PG8_BAR;
        PG8_STAGE(PG8_SB(1, 0), cB + kstep, voffB); PG8_STAGE(PG8_SA(1, 0), cA + kstep, voffA); PG8_STAGE(PG8_SB(1, 1), cB + hstepB + kstep, voffB);
        PG8_WAIT_V(6); PG8_BAR;
    }
    for (;;) {
        const bool has_next = g.next(ui + 1, nxt);
        const char* nA = has_next ? g.a_base(nxt) : cA; const char* nB = has_next ? g.b_base(nxt) : cB;
#pragma unroll 1
        for (int t = 0; t < nt; t += 2) {
            const bool last = (t == nt - 2);
            const char* a1 = cA + (size_t)(t + 1) * kstep;
            const char* a2 = last ? nA : cA + (size_t)(t + 2) * kstep; const char* b2 = last ? nB : cB + (size_t)(t + 2) * kstep;
            const char* a3 = a2 + kstep; const char* b3 = b2 + kstep;
            if constexpr (SP2) {
            PG8_LDB(B0, 0, 0); PG8_LDB(B1, 0, 1); PG8_SCHED; PG8_LDA(At, 0, 0); PG8_STAGE(PG8_SA(1, 1), a1 + hstepA, voffA);
            PG8_WAIT_V(8); PG8_WAIT_L(0); PG8_BAR; PG8_MMA(0, 0, At, B0); PG8_MMA(0, 1, At, B1); PG8_BAR; PG8_SCHED;
            PG8_LDA(At, 0, 1); PG8_STAGE(PG8_SB(0, 0), b2, voffB); PG8_STAGE(PG8_SB(0, 1), b2 + hstepB, voffB); PG8_STAGE(PG8_SA(0, 0), a2, voffA);
            PG8_WAIT_V(8); PG8_WAIT_L(0); PG8_BAR; PG8_MMA(1, 0, At, B0); PG8_MMA(1, 1, At, B1); PG8_BAR; PG8_SCHED;
            PG8_LDB(B0, 1, 0); PG8_LDB(B1, 1, 1); PG8_SCHED; PG8_LDA(At, 1, 0); PG8_STAGE(PG8_SA(0, 1), a2 + hstepA, voffA);
            PG8_WAIT_V(8); PG8_WAIT_L(0); PG8_BAR; PG8_MMA(0, 0, At, B0); PG8_MMA(0, 1, At, B1); PG8_BAR; PG8_SCHED;
            PG8_LDA(At, 1, 1); PG8_STAGE(PG8_SB(1, 0), b3, voffB); PG8_STAGE(PG8_SB(1, 1), b3 + hstepB, voffB); PG8_STAGE(PG8_SA(1, 0), a3, voffA);
            PG8_WAIT_V(8); PG8_WAIT_L(0); PG8_BAR; PG8_MMA(1, 0, At, B0); PG8_MMA(1, 1, At, B1); PG8_BAR; PG8_SCHED;
            } else {
            PG8_LDB(B0, 0, 0); PG8_SCHED; PG8_LDA(At, 0, 0); PG8_STAGE(PG8_SA(1, 1), a1 + hstepA, voffA);
            PG8_WAIT_L(8); PG8_BAR; PG8_WAIT_L(0); PG8_MMA(0, 0, At, B0); PG8_BAR; PG8_SCHED;
            PG8_LDB(B1, 0, 1); PG8_STAGE(PG8_SB(0, 0), b2, voffB);
            PG8_BAR; PG8_WAIT_L(0); PG8_MMA(0, 1, At, B1); PG8_BAR;
            PG8_LDA(At, 0, 1); PG8_STAGE(PG8_SA(0, 0), a2, voffA);
            PG8_BAR; PG8_WAIT_L(0); PG8_MMA(1, 0, At, B0); PG8_BAR; PG8_SCHED;
            PG8_STAGE(PG8_SB(0, 1), b2 + hstepB, voffB);
            PG8_WAIT_V(6); PG8_BAR; PG8_MMA(1, 1, At, B1); PG8_BAR;
            PG8_LDB(B0, 1, 0); PG8_SCHED; PG8_LDA(At, 1, 0); PG8_STAGE(PG8_SA(0, 1), a2 + hstepA, voffA);
            PG8_WAIT_L(8); PG8_BAR; PG8_WAIT_L(0); PG8_MMA(0, 0, At, B0); PG8_BAR; PG8_SCHED;
            PG8_LDB(B1, 1, 1); PG8_STAGE(PG8_SB(1, 0), b3, voffB);
            PG8_BAR; PG8_WAIT_L(0); PG8_MMA(0, 1, At, B1); PG8_BAR;
            PG8_LDA(At, 1, 1); PG8_STAGE(PG8_SA(1, 0), a3, voffA);
            PG8_BAR; PG8_WAIT_L(0); PG8_MMA(1, 0, At, B0); PG8_BAR; PG8_SCHED;
            PG8_STAGE(PG8_SB(1, 1), b3 + hstepB, voffB);
            PG8_WAIT_V(6); PG8_BAR; PG8_MMA(1, 1, At, B1); PG8_BAR;
            }
        }
        if constexpr (ALIGN_EPI) { if (wr == 0) PG8_BAR; }
        E(acc, cur, wr, wc, fr, fq);
        if (!has_next) break;
#pragma unroll
        for (int a = 0; a < 2; ++a)
#pragma unroll
            for (int b = 0; b < 2; ++b)
#pragma unroll
                for (int m = 0; m < 4; ++m)
#pragma unroll
                    for (int n = 0; n < 2; ++n) acc[a][b][m][n] = (f32x4){0.f, 0.f, 0.f, 0.f};
        cur = nxt; cA = nA; cB = nB; ++ui;
        if constexpr (ALIGN_EPI) { if (wr == 1) PG8_BAR; }
    }
    PG8_WAIT_V(0);
    if constexpr (!ALIGN_EPI) { if (wr == 0) PG8_BAR; }
    PG8_BAR;
#undef PG8_SA
#undef PG8_SB
#undef PG8_STAGE
#undef PG8_LDA
#undef PG8_LDB
#undef PG8_MMA
#undef PG8_WAIT_V
#undef PG8_WAIT_L
#undef PG8_BAR
#undef PG8_SCHED
}

struct EpiBf16 {
    static constexpr bool PERM = true;
    bf16_t* O; long zs; int ldc, pad;
    __device__ __forceinline__ void operator()(const f32x4 (&acc)[2][2][4][2], const Unit& u, int wr, int wc, int fr, int fq) const {
        const int row0 = u.pm * BM + wr * 64 + fr, col0 = u.pn * BM + wc * 32 + 8 * fq; bf16_t* base = O + (long)u.z * zs;
#pragma unroll
        for (int ai = 0; ai < 2; ++ai)
#pragma unroll
            for (int m = 0; m < 4; ++m) { bf16_t* rowp = base + (size_t)(row0 + ai * HALF + m * 16) * ldc + col0;
#pragma unroll
                for (int bj = 0; bj < 2; ++bj) { const f32x4 v0 = acc[ai][bj][m][0], v1 = acc[ai][bj][m][1];
                    u32x4 w; w.x = pk2(v0[0], v0[1]); w.y = pk2(v0[2], v0[3]); w.z = pk2(v1[0], v1[1]); w.w = pk2(v1[2], v1[3]);
                    *(u32x4*)(rowp + bj * HALF) = w; } }
    }
};
struct EpiMem {
    static constexpr bool PERM = false;
    float* outK; float* outV; bf16_t* kb; bf16_t* vt;
    __device__ __forceinline__ void operator()(const f32x4 (&acc)[2][2][4][2], const Unit& u, int wr, int wc, int fr, int fq) const {
        const int row0 = u.pm * BM + wr * 64 + fr, col0 = u.pn * BM + wc * 32 + 4 * fq;
#pragma unroll
        for (int ai = 0; ai < 2; ++ai)
#pragma unroll
            for (int m = 0; m < 4; ++m) { const int row = row0 + ai * HALF + m * 16;
#pragma unroll
                for (int bj = 0; bj < 2; ++bj)
#pragma unroll
                    for (int n = 0; n < 2; ++n) { const int col = col0 + bj * HALF + n * 16; const f32x4 v = acc[ai][bj][m][n];
                        if (col < 1024) { *(f32x4*)(outK + ((size_t)u.z * 512 + row) * 1024 + col) = v;
                            u32x2 w; w.x = pk2(v[0], v[1]); w.y = pk2(v[2], v[3]); *(u32x2*)(kb + ((size_t)u.z * 512 + row) * 1024 + col) = w; }
                        else { const int c = col - 1024; *(f32x4*)(outV + ((size_t)u.z * 512 + row) * 1024 + c) = v;
                            const int b = row >> 8, mm = row & 255, h = c >> 8, d = c & 255; bf16_t* p = vt + ((((size_t)u.z * 2 + b) * 4 + h) * 256 + d) * 256 + mm;
                            p[0] = f2bf(v[0]); p[256] = f2bf(v[1]); p[512] = f2bf(v[2]); p[768] = f2bf(v[3]); } } }
    }
};
struct EpiMerge {
    static constexpr bool PERM = false;
    float* MG; bf16_t* MGB; const bf16_t* U; const float* gate_b;
    __device__ __forceinline__ void operator()(const f32x4 (&acc)[2][2][4][2], const Unit& u, int wr, int wc, int fr, int fq) const {
        const int row0 = u.pm * BM + wr * 64 + fr, col0 = u.pn * BM + wc * 32 + 4 * fq;
#pragma unroll
        for (int ai = 0; ai < 2; ++ai)
#pragma unroll
            for (int m = 0; m < 4; ++m) { const int row = row0 + ai * HALF + m * 16;
#pragma unroll
                for (int bj = 0; bj < 2; ++bj)
#pragma unroll
                    for (int n = 0; n < 2; ++n) { const int col = col0 + bj * HALF + n * 16; const f32x4 v = acc[ai][bj][m][n];
                        const u32x2 gp = *(const u32x2*)(U + (size_t)row * NINP + U_GP + u.z * DM + col); const f32x4 gb = *(const f32x4*)(gate_b + u.z * DM + col);
                        f32x4 gt; gt[0] = sigmoidf_(__uint_as_float(gp.x << 16) + gb[0]); gt[1] = sigmoidf_(__uint_as_float(gp.x & 0xffff0000u) + gb[1]);
                        gt[2] = sigmoidf_(__uint_as_float(gp.y << 16) + gb[2]); gt[3] = sigmoidf_(__uint_as_float(gp.y & 0xffff0000u) + gb[3]);
                        bf16_t* mp = MGB + (size_t)row * DM + col; f32x4 r = gt * v;
                        if (u.z > 0) r += ld4bf(mp);
                        { u32x2 w; w.x = pk2(r[0], r[1]); w.y = pk2(r[2], r[3]); *(u32x2*)mp = w; } } }
    }
};
struct EpiRes {
    static constexpr bool PERM = false;
    const bf16_t* R; bf16_t* Y;
    __device__ __forceinline__ void operator()(const f32x4 (&acc)[2][2][4][2], const Unit& u, int wr, int wc, int fr, int fq) const {
        const int row0 = u.pm * BM + wr * 64 + fr, col0 = u.pn * BM + wc * 32 + 4 * fq;
#pragma unroll
        for (int ai = 0; ai < 2; ++ai)
#pragma unroll
            for (int m = 0; m < 4; ++m) { const size_t ro = (size_t)(row0 + ai * HALF + m * 16) * DM + col0;
#pragma unroll
                for (int bj = 0; bj < 2; ++bj)
#pragma unroll
                    for (int n = 0; n < 2; ++n) { const size_t o = ro + bj * HALF + n * 16; const u32x2 rr = *(const u32x2*)(R + o);
                        const f32x4 rv = (f32x4){__uint_as_float(rr.x << 16), __uint_as_float(rr.x & 0xffff0000u), __uint_as_float(rr.y << 16), __uint_as_float(rr.y & 0xffff0000u)};
                        const f32x4 yv = rv * ALPHA + acc[ai][bj][m][n]; u32x2 yw; yw.x = pk2(yv[0], yv[1]); yw.y = pk2(yv[2], yv[3]); *(u32x2*)(Y + o) = yw; } }
    }
};
struct EpiSwiGLU {
    static constexpr bool PERM = true;
    bf16_t* O;
    __device__ __forceinline__ void operator()(const f32x4 (&acc)[2][2][4][2], const Unit& u, int wr, int wc, int fr, int fq) const {
        const int row0 = u.pm * BM + wr * 64 + fr, col0 = u.pn * HALF + wc * 32 + 8 * fq;
#pragma unroll
        for (int ai = 0; ai < 2; ++ai)
#pragma unroll
            for (int m = 0; m < 4; ++m) { bf16_t* rowp = O + (size_t)(row0 + ai * HALF + m * 16) * DFF + col0;
                float r[8];
#pragma unroll
                for (int n = 0; n < 2; ++n)
#pragma unroll
                    for (int j = 0; j < 4; ++j) { const float gg = acc[ai][0][m][n][j], uu = acc[ai][1][m][n][j]; r[n * 4 + j] = gg * sigmoidf_(gg) * uu; }
                u32x4 w; w.x = pk2(r[0], r[1]); w.y = pk2(r[2], r[3]); w.z = pk2(r[4], r[5]); w.w = pk2(r[6], r[7]);
                *(u32x4*)rowp = w; }
    }
};
struct EpiScore {
    static constexpr bool PERM = false;
    float* SC;
    __device__ __forceinline__ void operator()(const f32x4 (&acc)[2][2][4][2], const Unit& u, int wr, int wc, int fr, int fq) const {
        const int row0 = u.pm * BM + wr * 64 + fr, col0 = wc * 32 + 4 * fq; float* base = SC + (size_t)u.z * 4096 * 256;
#pragma unroll
        for (int ai = 0; ai < 2; ++ai)
#pragma unroll
            for (int m = 0; m < 4; ++m) { float* rowp = base + (size_t)(row0 + ai * HALF + m * 16) * 256 + col0;
#pragma unroll
                for (int bj = 0; bj < 2; ++bj)
#pragma unroll
                    for (int n = 0; n < 2; ++n) *(f32x4*)(rowp + bj * HALF + n * 16) = acc[ai][bj][m][n] * 0.0625f; }
    }
};
struct EpiPV {
    static constexpr bool PERM = true;
    bf16_t* O;
    __device__ __forceinline__ void operator()(const f32x4 (&acc)[2][2][4][2], const Unit& u, int wr, int wc, int fr, int fq) const {
        const int b = u.z >> 2, h = u.z & 3; const int row0 = b * PS + u.pm * BM + wr * 64 + fr, col0 = h * 256 + wc * 32 + 8 * fq;
#pragma unroll
        for (int ai = 0; ai < 2; ++ai)
#pragma unroll
            for (int m = 0; m < 4; ++m) { bf16_t* rowp = O + (size_t)(row0 + ai * HALF + m * 16) * BW + col0;
#pragma unroll
                for (int bj = 0; bj < 2; ++bj) { const f32x4 v0 = acc[ai][bj][m][0], v1 = acc[ai][bj][m][1];
                    u32x4 w; w.x = pk2(v0[0], v0[1]); w.y = pk2(v0[2], v0[3]); w.z = pk2(v1[0], v1[1]); w.w = pk2(v1[2], v1[3]);
                    *(u32x4*)(rowp + bj * HALF) = w; } }
    }
};
}


#define XB_TMO      128
#define XB_XCNT(j)  (256  + 64 * (j))
#define XB_XSUB(j)  (1280 + 64 * (j))
#define XB_XGEN(j)  (2304 + 64 * (j))
#define XB_TOP      3328
#define XB_TOPGEN   3392
#define XCD_BAR_WORDS 3456
#define XB_SPIN_CAP (1u << 18)
__device__ __forceinline__ unsigned xb_ld(unsigned* p)              { return __hip_atomic_load(p, __ATOMIC_RELAXED, __HIP_MEMORY_SCOPE_AGENT); }
__device__ __forceinline__ unsigned xb_add(unsigned* p, unsigned v) { return __hip_atomic_fetch_add(p, v, __ATOMIC_RELAXED, __HIP_MEMORY_SCOPE_AGENT); }
__device__ __forceinline__ unsigned xb_xcc_id() { return (unsigned)__builtin_amdgcn_s_getreg((3 << 11) | 20) & 0xFu; }
#define XB_SPIN(cond, bar) do { unsigned _sp = 0; while (cond) { __builtin_amdgcn_s_sleep(1); \
    if ((++_sp & 255u) == 0u) { if (xb_ld(&(bar)[XB_TMO])) break; if (_sp > XB_SPIN_CAP) { atomicAdd(&(bar)[XB_TMO], 1u); break; } } } } while (0)
struct XcdBarrier { unsigned* bar; unsigned x; volatile LAS unsigned* st; };
__device__ __forceinline__ XcdBarrier xcd_barrier_post(unsigned* bar, volatile LAS unsigned* st) {
    XcdBarrier b; b.bar = bar; b.x = xb_xcc_id(); b.st = st;
    if (threadIdx.x == 0) (void)xb_add(&bar[XB_XCNT(b.x)], 1u);
    return b;
}
__device__ __forceinline__ void xcd_barrier_complete(unsigned* bar, unsigned x, unsigned& nloc, unsigned& nx) {
    const unsigned G = gridDim.x * gridDim.y * gridDim.z;
    unsigned sum, cnt, mine, sp = 0u;
    for (;;) {
        sum = 0u; cnt = 0u; mine = 0u;
#pragma unroll
        for (unsigned j = 0; j < 16; ++j) { const unsigned c = xb_ld(&bar[XB_XCNT(j)]); sum += c; cnt += (c > 0u) ? 1u : 0u; mine = (j == x) ? c : mine; }
        if (sum == G) break;
        __builtin_amdgcn_s_sleep(1);
        if ((++sp & 255u) == 0u) { if (xb_ld(&bar[XB_TMO])) break; if (sp > XB_SPIN_CAP) { atomicAdd(&bar[XB_TMO], 1u); break; } }
    }
    nloc = mine > 0u ? mine : 1u; nx = cnt > 0u ? cnt : 1u;
}
__device__ __forceinline__ void xcd_barrier(const XcdBarrier& b) {
    asm volatile("s_waitcnt vmcnt(0)" ::: "memory");
    __syncthreads();
    if (threadIdx.x == 0) {
        unsigned* bar = b.bar;
        __builtin_amdgcn_s_waitcnt(0);
        unsigned nloc = b.st[0], nx = b.st[1];
        if (nloc == 0u) { xcd_barrier_complete(bar, b.x, nloc, nx); b.st[0] = nloc; b.st[1] = nx; }
        const unsigned old = xb_add(&bar[XB_XSUB(b.x)], 1u);
        const unsigned gen = old / nloc;
        if (old + 1u == (gen + 1u) * nloc) {
            __builtin_amdgcn_fence(__ATOMIC_RELEASE, "agent");
            asm volatile("s_waitcnt vmcnt(0)" ::: "memory");
            const unsigned og = xb_add(&bar[XB_TOP], 1u);
            const unsigned tg = og / nx;
            if (og + 1u == (tg + 1u) * nx) xb_add(&bar[XB_TOPGEN], 1u);
            else XB_SPIN(xb_ld(&bar[XB_TOPGEN]) == tg, bar);
            __builtin_amdgcn_fence(__ATOMIC_ACQUIRE, "agent");
            xb_add(&bar[XB_XGEN(b.x)], 1u);
            asm volatile("s_waitcnt vmcnt(0)" ::: "memory");
        } else {
            XB_SPIN(xb_ld(&bar[XB_XGEN(b.x)]) == gen, bar);
            __builtin_amdgcn_fence(__ATOMIC_ACQUIRE, "agent");
            asm volatile("s_waitcnt vmcnt(0)" ::: "memory");
        }
    }
    __syncthreads();
}

struct Ctx { int tid, lane, wave, bid, G; LAS unsigned char* lds; };
__device__ __forceinline__ Ctx fresh(const Ctx& c0) { Ctx c; c.wave = c0.wave; c.bid = c0.bid; c.G = c0.G; c.lds = c0.lds; asm volatile("" : "+s"(c.bid), "+s"(c.G), "+s"(c.wave));
    int lane = (int)__builtin_amdgcn_mbcnt_hi(~0u, __builtin_amdgcn_mbcnt_lo(~0u, 0u)); asm volatile("" : "+v"(lane)); c.lane = lane; c.tid = c.wave * 64 + lane; return c; }

__device__ __forceinline__ int colmap(int mode, int n) {
    if (mode == 1) return n < 3088 ? n : (n < 3328 ? -1 : n - 240);
    if (mode == 2) { const int t = n >> 8, j = n & 255; return j < 128 ? t * 128 + j : DFF + t * 128 + (j - 128); }
    return n;
}
__device__ __forceinline__ void wprep_load(f32x4 (&rg)[8], const float* __restrict__ src, int K, int Nsrc, int Ndst, int mode, size_t sbs, int item, int tid) {
    const int nx = Ndst / 256, ny = K / 64; const int bx = item % nx, by = (item / nx) % ny, bz = item / (nx * ny);
    const int tx = tid & 63, ty = tid >> 6, cm = colmap(mode, bx * 256 + tx * 4); const float* s = src + (size_t)bz * sbs + (size_t)(by * 64 + ty) * Nsrc + cm;
#pragma unroll
    for (int i = 0; i < 8; ++i) rg[i] = cm >= 0 ? *(const f32x4*)(s + (size_t)(8 * i) * Nsrc) : (f32x4){0.f, 0.f, 0.f, 0.f};
}
__device__ __forceinline__ void ph_wprep(const Ctx& c, const float* __restrict__ src, bf16_t* __restrict__ dst, int K, int Nsrc, int Ndst, int mode, int nbatch, size_t sbs, size_t dbs) {
    LAS float* tile = (LAS float*)c.lds;
    const int nx = Ndst / 256, ny = K / 64, total = nx * ny * nbatch;
    const int tid = c.tid, tx = tid & 63, ty = tid >> 6, n = tid >> 1, kh = tid & 1;
    f32x4 rg[8];
    int item = c.bid;
    if (item < total) wprep_load(rg, src, K, Nsrc, Ndst, mode, sbs, item, tid);
    for (; item < total; item += c.G) {
        __syncthreads();
#pragma unroll
        for (int i = 0; i < 8; ++i) *(LAS f32x4*)(tile + (ty + 8 * i) * 260 + tx * 4) = rg[i];
        __syncthreads();
        const int bx = item % nx, by = (item / nx) % ny, bz = item / (nx * ny);
        if (item + c.G < total) wprep_load(rg, src, K, Nsrc, Ndst, mode, sbs, item + c.G, tid);
        bf16_t* d = dst + (size_t)bz * dbs + (size_t)(bx * 256 + n) * K + by * 64 + kh * 32;
#pragma unroll
        for (int g = 0; g < 4; ++g) { unsigned p[4];
#pragma unroll
            for (int e = 0; e < 4; ++e) p[e] = pk2(tile[(kh * 32 + g * 8 + 2 * e) * 260 + n], tile[(kh * 32 + g * 8 + 2 * e + 1) * 260 + n]);
            *(u32x4*)(d + g * 8) = (u32x4){p[0], p[1], p[2], p[3]}; }
    }
    __syncthreads();
}
__device__ __forceinline__ void ph_xprep(const Ctx& c, const float* __restrict__ xp, const float* __restrict__ xs, const float* __restrict__ mem, float* __restrict__ HF, bf16_t* __restrict__ HB, bf16_t* __restrict__ MEMB) {
    const size_t nH = (size_t)MPAD * DM / 4, nM = (size_t)512 * DM / 4;
    for (size_t i4 = (size_t)c.bid * 512 + c.tid; i4 < nH + nM; i4 += (size_t)c.G * 512) {
        if (i4 < nH) {
            const size_t e = i4 * 4; f32x4 v = (f32x4){0.f, 0.f, 0.f, 0.f};
            if (e < (size_t)MP * DM) v = *(const f32x4*)(xp + e); else if (e < (size_t)MT * DM) v = *(const f32x4*)(xs + (e - (size_t)MP * DM));
            if (HF != nullptr) *(f32x4*)(HF + e) = v;
            u32x2 w; w.x = pk2(v[0], v[1]); w.y = pk2(v[2], v[3]); *(u32x2*)(HB + e) = w;
        } else {
            const size_t e = (i4 - nH) * 4; const f32x4 v = *(const f32x4*)(mem + e); u32x2 w; w.x = pk2(v[0], v[1]); w.y = pk2(v[2], v[3]); *(u32x2*)(MEMB + e) = w;
        }
    }
}
__device__ __forceinline__ void ph_ln(const Ctx& c, const bf16_t* __restrict__ Y, const float* __restrict__ g, const float* __restrict__ b, float* __restrict__ XF, bf16_t* __restrict__ XB, float* __restrict__ OUT, int nrows, int nout) {
    const int lane = c.lane;
    for (int row = c.bid * 8 + c.wave; row < nrows; row += c.G * 8) {
        const bf16_t* y = Y + (size_t)row * DM; f32x4 v[8]; float s = 0.f;
#pragma unroll
        for (int j = 0; j < 8; ++j) { const u32x2 yr = *(const u32x2*)(y + j * 256 + lane * 4);
            v[j] = (f32x4){__uint_as_float(yr.x << 16), __uint_as_float(yr.x & 0xffff0000u), __uint_as_float(yr.y << 16), __uint_as_float(yr.y & 0xffff0000u)}; s += (v[j][0] + v[j][1]) + (v[j][2] + v[j][3]); }
        const float mean = wave_sum(s) * (1.0f / DM); float q = 0.f;
#pragma unroll
        for (int j = 0; j < 8; ++j) { const f32x4 d = v[j] - mean; q += (d[0] * d[0] + d[1] * d[1]) + (d[2] * d[2] + d[3] * d[3]); }
        const float rstd = rsqrtf(wave_sum(q) * (1.0f / DM) + 1e-5f);
#pragma unroll
        for (int j = 0; j < 8; ++j) { const int cc = j * 256 + lane * 4; const f32x4 gg = *(const f32x4*)(g + cc), bb = *(const f32x4*)(b + cc);
            const f32x4 o = (v[j] - mean) * rstd * gg + bb; const size_t off = (size_t)row * DM + cc;
            if (XF != nullptr) *(f32x4*)(XF + off) = o;
            u32x2 w; w.x = pk2(o[0], o[1]); w.y = pk2(o[2], o[3]); *(u32x2*)(XB + off) = w;
            if (OUT != nullptr && row < nout) *(f32x4*)(OUT + off) = o; }
    }
}
__device__ __forceinline__ void ph_softmax256(const Ctx& c, const float* __restrict__ SC, bf16_t* __restrict__ P, int nrows) {
    const int lane = c.lane;
    for (int row = c.bid * 8 + c.wave; row < nrows; row += c.G * 8) {
        const f32x4 v = *(const f32x4*)(SC + (size_t)row * 256 + lane * 4);
        const float mx = wave_max(fmaxf(fmaxf(v[0], v[1]), fmaxf(v[2], v[3])));
        f32x4 e; e[0] = __expf(v[0] - mx); e[1] = __expf(v[1] - mx); e[2] = __expf(v[2] - mx); e[3] = __expf(v[3] - mx);
        const float inv = 1.0f / wave_sum((e[0] + e[1]) + (e[2] + e[3]));
        u32x2 w; w.x = pk2(e[0] * inv, e[1] * inv); w.y = pk2(e[2] * inv, e[3] * inv); *(u32x2*)(P + (size_t)row * 256 + lane * 4) = w;
    }
}
__device__ __forceinline__ void ph_copy_outs(const Ctx& c, const bf16_t* __restrict__ U, const float* __restrict__ ck, const float* __restrict__ cv, float* __restrict__ out, int layer) {
    constexpr int nA = PB * 128 * 128, nB = SB * 128 * 128, nC = PB * RWC, nD = SB * RWC;
    for (int i = c.bid * 512 + c.tid; i < nA + nB + nC + nD; i += c.G * 512) {
        if (i < nA) { const int b = i / 16384, j = (i >> 7) & 127, cc = i & 127; const size_t ur = (size_t)(b * PS + PS - 128 + j) * NINP;
            out[O_SWKP + (size_t)layer * nA + i] = bf2f(U[ur + U_SK + cc]); out[O_SWVP + (size_t)layer * nA + i] = bf2f(U[ur + U_SV + cc]); continue; }
        int k = i - nA;
        if (k < nB) { const int sq = k / 16384, j = (k >> 7) & 127, cc = k & 127; float kv, vv;
            if (j < 124) { const size_t o = ((size_t)sq * 128 + j + 4) * 128 + cc; kv = ck[o]; vv = cv[o]; }
            else { const size_t ur = (size_t)(MP + sq * SS + j - 124) * NINP; kv = bf2f(U[ur + U_SK + cc]); vv = bf2f(U[ur + U_SV + cc]); }
            out[O_SWKS + (size_t)layer * nB + k] = kv; out[O_SWVS + (size_t)layer * nB + k] = vv; continue; }
        k -= nB;
        if (k < nC) { const int b = k / RWC, cc = k - b * RWC; out[O_RSP + (size_t)layer * nC + k] = bf2f(U[(size_t)(b * PS + PS - 1) * NINP + U_RU + cc]); continue; }
        k -= nC;
        { const int sq = k / RWC, cc = k - sq * RWC; out[O_RSS + (size_t)layer * nD + k] = bf2f(U[(size_t)(MP + sq * SS + SS - 1) * NINP + U_RU + cc]); }
    }
}

__device__ __forceinline__ void seq_info(int sq, int& row0, int& L) { if (sq < PB) { row0 = sq * PS; L = PS; } else { row0 = MP + (sq - PB) * SS; L = SS; } }

__device__ __forceinline__ void ph_gla_naive(const Ctx& c, const bf16_t* __restrict__ U, const float* __restrict__ s0, const float* __restrict__ a_up, const float* __restrict__ a_b,
                                             const float* __restrict__ ng, const float* __restrict__ nb, bf16_t* __restrict__ OB, float* __restrict__ outP, float* __restrict__ outS) {
    LAS float* qs = (LAS float*)c.lds;
    LAS float* ks = qs + 16 * 128; LAS float* as = ks + 16 * 128; LAS float* os = as + 16 * 128;
    const int kh = c.tid >> 8, vt = c.tid & 255, lane = c.lane;
    for (int u = c.bid; u < (PB + SB) * 4; u += c.G) {
        const int sq = u >> 2, h = u & 3;
        int row0, L; seq_info(sq, row0, L);
        float S[64];
        if (sq >= PB) { const float* p = s0 + (((size_t)(sq - PB) * 4 + h) * 128 + kh * 64) * 256 + vt;
#pragma unroll
            for (int kk = 0; kk < 64; ++kk) S[kk] = p[(size_t)kk * 256]; }
        else {
#pragma unroll
            for (int kk = 0; kk < 64; ++kk) S[kk] = 0.f; }
        for (int t0 = 0; t0 < L; t0 += 16) {
            const int nT = (L - t0) < 16 ? (L - t0) : 16;
            for (int idx = c.tid; idx < nT * 128; idx += 512) {
                const int tt = idx >> 7, kk = idx & 127; const bf16_t* ur = U + (size_t)(row0 + t0 + tt) * NINP;
                qs[idx] = bf2f(ur[U_GQ + h * 128 + kk]) * 0.08838834764831845f; ks[idx] = bf2f(ur[U_GK + h * 128 + kk]);
                float x = a_b[h * 128 + kk];
#pragma unroll
                for (int r = 0; r < 16; ++r) x += bf2f(ur[U_GA + r]) * a_up[r * 512 + h * 128 + kk];
                const float ls = (fminf(x, 0.f) - log1pf(__expf(-fabsf(x)))) * (1.0f / 16.0f);
                as[idx] = __expf(ls);
            }
            __syncthreads();
            for (int tt = 0; tt < nT; ++tt) {
                const float v = bf2f(U[(size_t)(row0 + t0 + tt) * NINP + U_GV + h * 256 + vt]); float o = 0.f; const int lb = tt * 128 + kh * 64;
#pragma unroll
                for (int kk = 0; kk < 64; ++kk) { S[kk] = as[lb + kk] * S[kk] + ks[lb + kk] * v; o += qs[lb + kk] * S[kk]; }
                os[(kh * 16 + tt) * 256 + vt] = o;
            }
            __syncthreads();
            for (int tt = c.wave; tt < nT; tt += 8) {
                float x[4]; float s = 0.f;
#pragma unroll
                for (int j = 0; j < 4; ++j) { x[j] = os[tt * 256 + lane + 64 * j] + os[(16 + tt) * 256 + lane + 64 * j]; s += x[j]; }
                const float mean = wave_sum(s) * (1.0f / 256.0f); float q = 0.f;
#pragma unroll
                for (int j = 0; j < 4; ++j) { const float d = x[j] - mean; q += d * d; }
                const float rstd = rsqrtf(wave_sum(q) * (1.0f / 256.0f) + 1e-5f);
                const size_t row = (size_t)(row0 + t0 + tt);
#pragma unroll
                for (int j = 0; j < 4; ++j) { const int cc = h * 256 + lane + 64 * j; const float n = (x[j] - mean) * rstd * ng[cc] + nb[cc];
                    const float gr = bf2f(U[row * NINP + U_GR + cc]); OB[row * BW + cc] = f2bf(n * gr * sigmoidf_(gr)); }
            }
            __syncthreads();
        }
        float* op = (sq < PB ? outP + (((size_t)sq * 4 + h) * 128 + kh * 64) * 256 : outS + (((size_t)(sq - PB) * 4 + h) * 128 + kh * 64) * 256) + vt;
#pragma unroll
        for (int kk = 0; kk < 64; ++kk) op[(size_t)kk * 256] = S[kk];
    }
}

__device__ __forceinline__ f32x4 mma16(bf16x8 x, bf16x8 y, f32x4 c) { return __builtin_amdgcn_mfma_f32_16x16x32_bf16(x, y, c, 0, 0, 0); }
__device__ __forceinline__ bf16x8 pack_acc(const f32x4& a, const f32x4& b) {
    u32x4 p; p.x = pk2(a[0], a[1]); p.y = pk2(a[2], a[3]); p.z = pk2(b[0], b[1]); p.w = pk2(b[2], b[3]); return __builtin_bit_cast(bf16x8, p);
}
__device__ __forceinline__ void gla_chunk_info(int u, int& row0, int& ntok, int& h) {
    if (u < 512) { const int b = u >> 8; h = (u >> 6) & 3; row0 = b * PS + (u & 63) * 64; ntok = 64; }
    else { const int s = u - 512; h = s & 3; row0 = MP + (s >> 2) * SS; ntok = SS; }
}
__device__ __forceinline__ void ph_gla_pre(const Ctx& c, const bf16_t* __restrict__ U, const float* __restrict__ a_up, const float* __restrict__ a_b,
                                           bf16_t* __restrict__ QD, bf16_t* __restrict__ KHT, bf16_t* __restrict__ EE, bf16_t* __restrict__ VT, float* __restrict__ GC) {
    LAS float* ga_l = (LAS float*)c.lds;
    LAS float* tot = ga_l + 64 * 16;
    LAS bf16_t* Qd_l = (LAS bf16_t*)(tot + 4 * 128);
    LAS bf16_t* Kn_l = Qd_l + 64 * 136;
    LAS bf16_t* v_l = Kn_l + 64 * 136;
    LAS bf16_t* qr_l = v_l + 64 * 264;
    LAS bf16_t* kr_l = qr_l + 64 * 136;
    const int tid = c.tid, lane = c.lane, r = lane & 15, q = lane >> 4, w = c.wave;
    for (int u = (c.bid + c.G / 2) % c.G; u < GL_NCH; u += c.G) {
        int row0, ntok, h; gla_chunk_info(u, row0, ntok, h);
        for (int i = tid; i < 64 * 16; i += 512) { const int t = i >> 4, rr = i & 15; ga_l[i] = t < ntok ? bf2f(U[(size_t)(row0 + t) * NINP + U_GA + rr]) : 0.f; }
        for (int i = tid; i < 64 * 32; i += 512) { const int t = i >> 5, c8 = i & 31; u32x4 vv = (u32x4){0u, 0u, 0u, 0u};
            if (t < ntok) vv = *(const u32x4*)(U + (size_t)(row0 + t) * NINP + U_GV + h * 256 + c8 * 8);
            *(LAS u32x4*)(v_l + t * 264 + c8 * 8) = vv; }
        for (int i = tid; i < 64 * 16; i += 512) { const int t = i >> 4, c8 = i & 15; u32x4 qv = (u32x4){0u, 0u, 0u, 0u}, kv = qv;
            if (t < ntok) { const bf16_t* ur = U + (size_t)(row0 + t) * NINP + h * 128 + c8 * 8; qv = *(const u32x4*)(ur + U_GQ); kv = *(const u32x4*)(ur + U_GK); }
            *(LAS u32x4*)(qr_l + t * 136 + c8 * 8) = qv; *(LAS u32x4*)(kr_l + t * 136 + c8 * 8) = kv; }
        __syncthreads();
        const int kk = tid & 127, tq = tid >> 7;
        float cum[16];
        { float aup[16];
#pragma unroll
          for (int rr = 0; rr < 16; ++rr) aup[rr] = a_up[rr * 512 + h * 128 + kk];
          const float ab = a_b[h * 128 + kk]; float run = 0.f;
#pragma unroll
          for (int j = 0; j < 16; ++j) { const int t = tq * 16 + j; float x = ab;
#pragma unroll
              for (int rr = 0; rr < 16; ++rr) x += ga_l[t * 16 + rr] * aup[rr];
              const float la = t < ntok ? (fminf(x, 0.f) - __logf(1.0f + __expf(-fabsf(x)))) * (1.0f / 16.0f) : 0.f;
              run += la; cum[j] = run; }
          tot[tq * 128 + kk] = run; }
        __syncthreads();
        { float prefix = 0.f, bC = 0.f;
#pragma unroll
          for (int g = 0; g < 4; ++g) { const float tv = tot[g * 128 + kk]; bC += tv; if (g < tq) prefix += tv; }
          unsigned khp[8];
#pragma unroll
          for (int j = 0; j < 16; j += 2) { float kh2[2];
#pragma unroll
              for (int e = 0; e < 2; ++e) { const int t = tq * 16 + j + e; const float b = prefix + cum[j + e]; const float qv = bf2f(qr_l[t * 136 + kk]), kv = bf2f(kr_l[t * 136 + kk]);
                  Qd_l[t * 136 + kk] = f2bf(qv * __expf(b) * 0.08838834764831845f); Kn_l[t * 136 + kk] = f2bf(kv * __expf(-b)); kh2[e] = kv * __expf(bC - b); }
              khp[j >> 1] = pk2(kh2[0], kh2[1]); }
          bf16_t* kp = KHT + (size_t)u * 8192 + kk * 64 + tq * 16;
          *(u32x4*)kp = (u32x4){khp[0], khp[1], khp[2], khp[3]}; *(u32x4*)(kp + 8) = (u32x4){khp[4], khp[5], khp[6], khp[7]};
          if (tq == 0) GC[(size_t)u * 128 + kk] = __expf(bC); }
        __syncthreads();
        { const int tb = w >> 1;
#pragma unroll
          for (int e = 0; e < 2; ++e) { const int ib = (w & 1) * 2 + e; f32x4 d = (f32x4){0.f, 0.f, 0.f, 0.f};
              if (ib <= tb) {
                  bf16x8 kf4[4], qf4[4];
#pragma unroll
                  for (int ks = 0; ks < 4; ++ks) { kf4[ks] = *(const LAS bf16x8*)(Kn_l + (ib * 16 + r) * 136 + ks * 32 + q * 8); qf4[ks] = *(const LAS bf16x8*)(Qd_l + (tb * 16 + r) * 136 + ks * 32 + q * 8); }
                  __builtin_amdgcn_sched_barrier(0);
#pragma unroll
                  for (int ks = 0; ks < 4; ++ks) d = mma16(kf4[ks], qf4[ks], d); }
              const int t = tb * 16 + r, i0 = ib * 16 + q * 4;
#pragma unroll
              for (int jj = 0; jj < 4; ++jj) if (i0 + jj > t) d[jj] = 0.f;
              u32x2 o; o.x = pk2(d[0], d[1]); o.y = pk2(d[2], d[3]); *(u32x2*)(EE + (size_t)u * 4096 + t * 64 + i0) = o; } }
        for (int i = tid; i < 64 * 16; i += 512) { const int t = i >> 4, c8 = i & 15; *(u32x4*)(QD + (size_t)u * 8192 + t * 128 + c8 * 8) = *(const LAS u32x4*)(Qd_l + t * 136 + c8 * 8); }
        { const int val = tid & 255, th = tid >> 8;
#pragma unroll
          for (int tg = 0; tg < 4; ++tg) { const int t0 = th * 32 + tg * 8; unsigned p4[4];
#pragma unroll
              for (int e = 0; e < 4; ++e) p4[e] = (unsigned)v_l[(t0 + 2 * e) * 264 + val] | ((unsigned)v_l[(t0 + 2 * e + 1) * 264 + val] << 16);
              *(u32x4*)(VT + (size_t)u * 16384 + val * 64 + t0) = (u32x4){p4[0], p4[1], p4[2], p4[3]}; } }
        __syncthreads();
    }
}
struct GlaStage { u32x4 qd[2], kh[2], e, vt, gc; };
__device__ __forceinline__ void gla_stage_load(GlaStage& s, const bf16_t* __restrict__ QD, const bf16_t* __restrict__ KHT, const bf16_t* __restrict__ EE, const bf16_t* __restrict__ VT, const float* __restrict__ GC,
                                               int ch, int sl, int tid) {
    const bf16_t* qp = QD + (size_t)ch * 8192 + tid * 8; s.qd[0] = *(const u32x4*)qp; s.qd[1] = *(const u32x4*)(qp + 4096);
    const bf16_t* kp = KHT + (size_t)ch * 8192 + tid * 8; s.kh[0] = *(const u32x4*)kp; s.kh[1] = *(const u32x4*)(kp + 4096);
    s.e = *(const u32x4*)(EE + (size_t)ch * 4096 + tid * 8);
    s.vt = *(const u32x4*)(VT + (size_t)ch * 16384 + sl * 4096 + tid * 8);
    if (tid < 32) s.gc = *(const u32x4*)(GC + (size_t)ch * 128 + tid * 4);
}
constexpr int GS_KH = 8704, GS_E = 17920, GS_VT = 22528, GS_GC = 27136, GS_EL = 27392;
__device__ __forceinline__ void gla_stage_store(const GlaStage& s, LAS bf16_t* b, int tid) {
    *(LAS u32x4*)(b + (tid >> 4) * 136 + (tid & 15) * 8) = s.qd[0]; *(LAS u32x4*)(b + (32 + (tid >> 4)) * 136 + (tid & 15) * 8) = s.qd[1];
    *(LAS u32x4*)(b + GS_KH + (tid >> 3) * 72 + (tid & 7) * 8) = s.kh[0]; *(LAS u32x4*)(b + GS_KH + (64 + (tid >> 3)) * 72 + (tid & 7) * 8) = s.kh[1];
    *(LAS u32x4*)(b + GS_E + (tid >> 3) * 72 + (tid & 7) * 8) = s.e; *(LAS u32x4*)(b + GS_VT + (tid >> 3) * 72 + (tid & 7) * 8) = s.vt;
    if (tid < 32) *(LAS u32x4*)(b + GS_GC + tid * 8) = s.gc;
}
__device__ __forceinline__ void ph_gla_seq(const Ctx& c, int boff, const bf16_t* __restrict__ QD, const bf16_t* __restrict__ KHT, const bf16_t* __restrict__ EE, const bf16_t* __restrict__ VT, const float* __restrict__ GC,
                                           const float* __restrict__ s0, float* __restrict__ outP, float* __restrict__ outS, bf16_t* __restrict__ OB) {
    LAS bf16_t* stg = (LAS bf16_t*)c.lds;
    LAS bf16_t* T_l = stg + 2 * GS_EL;
    const int tid = c.tid, lane = c.lane, r = lane & 15, q = lane >> 4, w = c.wave;
    const int side = c.bid < 32 ? c.bid : c.bid - 64, nside = c.G - 64;
    for (int u = (c.bid >= boff && c.bid < boff + 32) ? c.bid - boff : ((c.bid < 32 || c.bid >= 96) ? 32 + side : 32 + 512); u < 32 + 512; u = u < 32 ? 32 + 512 : u + nside) {
        int h, sl, nch, ch0, row0, ntok; const float* sp = nullptr; float* op;
        if (u < 32) { const int b = u >> 4; h = (u >> 2) & 3; sl = u & 3; nch = 64; ch0 = (b * 4 + h) * 64; row0 = b * PS; ntok = 64; op = outP + (size_t)(b * 4 + h) * 32768; }
        else { const int s = u - 32, sq = s >> 4; h = (s >> 2) & 3; sl = s & 3; nch = 1; ch0 = 512 + sq * 4 + h; row0 = MP + sq * SS; ntok = SS; sp = s0 + (size_t)(sq * 4 + h) * 32768; op = outS + (size_t)(sq * 4 + h) * 32768; }
        f32x4 acc[4];
#pragma unroll
        for (int vb = 0; vb < 4; ++vb)
#pragma unroll
            for (int jj = 0; jj < 4; ++jj) acc[vb][jj] = sp ? sp[(size_t)(w * 16 + q * 4 + jj) * 256 + sl * 64 + vb * 16 + r] : 0.f;
        GlaStage R0, R1, R2;
        gla_stage_load(R0, QD, KHT, EE, VT, GC, ch0, sl, tid);
        if (1 < nch) gla_stage_load(R1, QD, KHT, EE, VT, GC, ch0 + 1, sl, tid);
        if (2 < nch) gla_stage_load(R2, QD, KHT, EE, VT, GC, ch0 + 2, sl, tid);
        __syncthreads();
        gla_stage_store(R0, stg, tid);
        if (3 < nch) gla_stage_load(R0, QD, KHT, EE, VT, GC, ch0 + 3, sl, tid);
#define GLA_STEP(ci, RN) do { \
            LAS bf16_t* Tb = T_l + ((ci) & 1) * 64 * 136; const LAS bf16_t* sb = stg + ((ci) & 1) * GS_EL; \
            _Pragma("unroll") for (int vb = 0; vb < 4; ++vb) { u32x2 o; o.x = pk2(acc[vb][0], acc[vb][1]); o.y = pk2(acc[vb][2], acc[vb][3]); *(LAS u32x2*)(Tb + (vb * 16 + r) * 136 + w * 16 + q * 4) = o; } \
            __syncthreads(); \
            if ((ci) + 1 < nch) { gla_stage_store(RN, stg + (((ci) + 1) & 1) * GS_EL, tid); if ((ci) + 4 < nch) gla_stage_load(RN, QD, KHT, EE, VT, GC, ch0 + (ci) + 4, sl, tid); } \
            { const int rb = w >> 1, t = rb * 16 + r; bf16x8 qf[4], ef[2]; \
              _Pragma("unroll") for (int ks = 0; ks < 4; ++ks) qf[ks] = *(const LAS bf16x8*)(sb + (rb * 16 + r) * 136 + ks * 32 + q * 8); \
              _Pragma("unroll") for (int ks = 0; ks < 2; ++ks) ef[ks] = *(const LAS bf16x8*)(sb + GS_E + (rb * 16 + r) * 72 + ks * 32 + q * 8); \
              bf16x8 tf[2][4], vf[2][2]; \
              _Pragma("unroll") for (int e2 = 0; e2 < 2; ++e2) { const int cb = (w & 1) * 2 + e2; \
                  _Pragma("unroll") for (int ks = 0; ks < 4; ++ks) tf[e2][ks] = *(const LAS bf16x8*)(Tb + (cb * 16 + r) * 136 + ks * 32 + q * 8); \
                  _Pragma("unroll") for (int ks = 0; ks < 2; ++ks) vf[e2][ks] = *(const LAS bf16x8*)(sb + GS_VT + (cb * 16 + r) * 72 + ks * 32 + q * 8); } \
              __builtin_amdgcn_sched_barrier(0); \
              _Pragma("unroll") for (int e2 = 0; e2 < 2; ++e2) { const int cb = (w & 1) * 2 + e2; f32x4 y = (f32x4){0.f, 0.f, 0.f, 0.f}; \
                  _Pragma("unroll") for (int ks = 0; ks < 4; ++ks) y = mma16(tf[e2][ks], qf[ks], y); \
                  _Pragma("unroll") for (int ks = 0; ks < 2; ++ks) y = mma16(vf[e2][ks], ef[ks], y); \
                  if (t < ntok) { u32x2 o; o.x = pk2(y[0], y[1]); o.y = pk2(y[2], y[3]); *(u32x2*)(OB + (size_t)(row0 + (ci) * 64 + t) * BW + h * 256 + sl * 64 + cb * 16 + q * 4) = o; } } } \
            { const f32x4 gcv = *(const LAS f32x4*)((const LAS float*)(sb + GS_GC) + w * 16 + q * 4); bf16x8 kf[2]; \
              _Pragma("unroll") for (int ks = 0; ks < 2; ++ks) kf[ks] = *(const LAS bf16x8*)(sb + GS_KH + (w * 16 + r) * 72 + ks * 32 + q * 8); \
              bf16x8 vs[4][2]; \
              _Pragma("unroll") for (int vb = 0; vb < 4; ++vb) _Pragma("unroll") for (int ks = 0; ks < 2; ++ks) vs[vb][ks] = *(const LAS bf16x8*)(sb + GS_VT + (vb * 16 + r) * 72 + ks * 32 + q * 8); \
              __builtin_amdgcn_sched_barrier(0); \
              _Pragma("unroll") for (int vb = 0; vb < 4; ++vb) { acc[vb] = acc[vb] * gcv; \
                  _Pragma("unroll") for (int ks = 0; ks < 2; ++ks) acc[vb] = mma16(kf[ks], vs[vb][ks], acc[vb]); } } \
        } while (0)
#pragma unroll 1
        for (int ci = 0; ci < nch; ci += 3) {
            GLA_STEP(ci, R1);
            if (ci + 1 < nch) GLA_STEP(ci + 1, R2);
            if (ci + 2 < nch) GLA_STEP(ci + 2, R0);
        }
#undef GLA_STEP
#pragma unroll
        for (int vb = 0; vb < 4; ++vb)
#pragma unroll
            for (int jj = 0; jj < 4; ++jj) op[(size_t)(w * 16 + q * 4 + jj) * 256 + sl * 64 + vb * 16 + r] = acc[vb][jj];
        __syncthreads();
    }
}
__device__ __forceinline__ void ph_gla_fin(const Ctx& c, const bf16_t* __restrict__ U, const float* __restrict__ ng, const float* __restrict__ nb, const bf16_t* __restrict__ RAW, bf16_t* __restrict__ OB) {
    const int lane = c.lane;
    for (int i = c.bid * 8 + c.wave; i < MT * 4; i += c.G * 8) {
        const int row = i >> 2, h = i & 3, cc = h * 256 + lane * 4; bf16_t* p = OB + (size_t)row * BW + cc;
        const u32x2 raw = *(const u32x2*)(RAW + (size_t)row * BW + cc); float x[4] = {__uint_as_float(raw.x << 16), __uint_as_float(raw.x & 0xffff0000u), __uint_as_float(raw.y << 16), __uint_as_float(raw.y & 0xffff0000u)};
        const float mean = wave_sum((x[0] + x[1]) + (x[2] + x[3])) * (1.0f / 256.0f); float qq = 0.f;
#pragma unroll
        for (int j = 0; j < 4; ++j) { const float d = x[j] - mean; qq += d * d; }
        const float rstd = rsqrtf(wave_sum(qq) * (1.0f / 256.0f) + 1e-5f);
        const u32x2 gp = *(const u32x2*)(U + (size_t)row * NINP + U_GR + cc); const float gr[4] = {__uint_as_float(gp.x << 16), __uint_as_float(gp.x & 0xffff0000u), __uint_as_float(gp.y << 16), __uint_as_float(gp.y & 0xffff0000u)};
        const f32x4 gg = *(const f32x4*)(ng + cc), bb = *(const f32x4*)(nb + cc); float o[4];
#pragma unroll
        for (int j = 0; j < 4; ++j) o[j] = ((x[j] - mean) * rstd * gg[j] + bb[j]) * gr[j] * sigmoidf_(gr[j]);
        u32x2 ov; ov.x = pk2(o[0], o[1]); ov.y = pk2(o[2], o[3]); *(u32x2*)p = ov;
    }
}

__device__ __forceinline__ void unpack8(const u32x4 w, float (&x)[8]) {
    x[0] = __uint_as_float(w.x << 16); x[1] = __uint_as_float(w.x & 0xffff0000u); x[2] = __uint_as_float(w.y << 16); x[3] = __uint_as_float(w.y & 0xffff0000u);
    x[4] = __uint_as_float(w.z << 16); x[5] = __uint_as_float(w.z & 0xffff0000u); x[6] = __uint_as_float(w.w << 16); x[7] = __uint_as_float(w.w & 0xffff0000u);
}
template <bool ISBF> __device__ __forceinline__ void swa_step(const float (&q)[32], float (&acc)[32], float& m, float& l, const void* kp, const void* vp, float slope, float dist) {
    float s = 0.f;
#pragma unroll
    for (int j = 0; j < 4; ++j) { float x[8];
        if (ISBF) unpack8(*(const u32x4*)((const bf16_t*)kp + j * 8), x);
        else { const f32x4 a = *(const f32x4*)((const float*)kp + j * 8), b = *(const f32x4*)((const float*)kp + j * 8 + 4); x[0] = a[0]; x[1] = a[1]; x[2] = a[2]; x[3] = a[3]; x[4] = b[0]; x[5] = b[1]; x[6] = b[2]; x[7] = b[3]; }
#pragma unroll
        for (int d = 0; d < 8; ++d) s += q[j * 8 + d] * x[d]; }
    s += __shfl_xor(s, 1, 64);
    s = s * 0.125f - slope * dist;
    const float mn = fmaxf(m, s), cc = __expf(m - mn), p = __expf(s - mn);
    l = l * cc + p;
#pragma unroll
    for (int j = 0; j < 4; ++j) { float x[8];
        if (ISBF) unpack8(*(const u32x4*)((const bf16_t*)vp + j * 8), x);
        else { const f32x4 a = *(const f32x4*)((const float*)vp + j * 8), b = *(const f32x4*)((const float*)vp + j * 8 + 4); x[0] = a[0]; x[1] = a[1]; x[2] = a[2]; x[3] = a[3]; x[4] = b[0]; x[5] = b[1]; x[6] = b[2]; x[7] = b[3]; }
#pragma unroll
        for (int d = 0; d < 8; ++d) acc[j * 8 + d] = acc[j * 8 + d] * cc + p * x[d]; }
    m = mn;
}
__device__ __forceinline__ void ph_swa_naive(const Ctx& c, const bf16_t* __restrict__ U, const float* __restrict__ ck, const float* __restrict__ cv, const float* __restrict__ sinks, bf16_t* __restrict__ OB) {
    for (int gid = c.bid * 512 + c.tid; gid < MS * 32; gid += c.G * 512) {
        const int dh = gid & 1, h = (gid >> 1) & 15, row = MP + (gid >> 5), kvh = h >> 3, co = kvh * 64 + dh * 32;
        float q[32], acc[32];
#pragma unroll
        for (int j = 0; j < 4; ++j) { float x[8]; unpack8(*(const u32x4*)(U + (size_t)row * NINP + U_SQ + h * 64 + dh * 32 + j * 8), x);
#pragma unroll
            for (int d = 0; d < 8; ++d) { q[j * 8 + d] = x[d]; acc[j * 8 + d] = 0.f; } }
        const float slope = exp2f(-0.5f * (float)(h + 1)); float m = sinks[h], l = 1.0f;
        if (row < MP) {
            const int t = row % PS, base = row - t, lo = t - 128 < 0 ? 0 : t - 128;
            for (int s = lo; s <= t; ++s) { const bf16_t* ur = U + (size_t)(base + s) * NINP;
                swa_step<true>(q, acc, m, l, ur + U_SK + co, ur + U_SV + co, slope, (float)(t - s)); }
        } else {
            const int sq = (row - MP) / SS, i = (row - MP) % SS;
            for (int idx = i; idx <= 128 + i; ++idx) {
                if (idx < 128) { const size_t o = ((size_t)sq * 128 + idx) * 128 + co; swa_step<false>(q, acc, m, l, ck + o, cv + o, slope, (float)(128 + i - idx)); }
                else { const bf16_t* ur = U + (size_t)(MP + sq * SS + idx - 128) * NINP; swa_step<true>(q, acc, m, l, ur + U_SK + co, ur + U_SV + co, slope, (float)(128 + i - idx)); }
            }
        }
        const float inv = 1.0f / l; bf16_t* op = OB + (size_t)row * BW + h * 64 + dh * 32;
#pragma unroll
        for (int j = 0; j < 4; ++j) { u32x4 w; w.x = pk2(acc[j * 8] * inv, acc[j * 8 + 1] * inv); w.y = pk2(acc[j * 8 + 2] * inv, acc[j * 8 + 3] * inv);
            w.z = pk2(acc[j * 8 + 4] * inv, acc[j * 8 + 5] * inv); w.w = pk2(acc[j * 8 + 6] * inv, acc[j * 8 + 7] * inv); *(u32x4*)(op + j * 8) = w; }
    }
}

__device__ __forceinline__ void ph_rwkv_prep(const Ctx& c, const bf16_t* __restrict__ U, const float* __restrict__ shift, const float* __restrict__ mu, const float* __restrict__ w0, const float* __restrict__ w2,
                                             const float* __restrict__ a0, const float* __restrict__ a2, const float* __restrict__ g2, const float* __restrict__ k_k, const float* __restrict__ k_a,
                                             const float* __restrict__ r_k, float* __restrict__ RW) {
    LAS float* xm = (LAS float*)c.lds; LAS float* tw = xm + RWC; LAS float* ad = tw + 64; LAS float* sg = ad + 64;
    const int tid = c.tid;
    float* R = RW; float* WD = RW + (size_t)MPAD * BW; float* K2 = WD + (size_t)MPAD * BW; float* V = K2 + (size_t)MPAD * BW; float* KK = V + (size_t)MPAD * BW;
    float* BV = KK + (size_t)MPAD * BW; float* G = BV + (size_t)MPAD * BW; float* BON = G + (size_t)MPAD * BW;
    for (int row = c.bid; row < MT; row += c.G) {
        const bf16_t* ur = U + (size_t)row * NINP + U_RU; const bf16_t* pr = ur - NINP; const float* ps = nullptr; bool first;
        if (row < MP) first = (row % PS) == 0; else { first = ((row - MP) % SS) == 0; ps = shift + (size_t)((row - MP) / SS) * RWC; }
        for (int cc = tid; cc < RWC; cc += 512) { const float x = bf2f(ur[cc]); const float s = first ? (ps ? ps[cc] : 0.f) : bf2f(pr[cc]); xm[cc] = x + (s - x) * mu[cc]; }
        __syncthreads();
        if (tid < 64) { tw[tid] = tanhf(xm[3072 + tid]); ad[tid] = xm[3136 + tid]; }
        if (tid >= 128 && tid < 256) sg[tid - 128] = sigmoidf_(xm[3200 + tid - 128]);
        __syncthreads();
        for (int qd = 0; qd < 2; ++qd) {
            const int cc = qd * 512 + tid; float accw = w0[cc], acca = a0[cc], accg = 0.f;
#pragma unroll 4
            for (int j = 0; j < 64; ++j) { accw += tw[j] * w2[j * BW + cc]; acca += ad[j] * a2[j * BW + cc]; }
#pragma unroll 4
            for (int j = 0; j < 128; ++j) accg += sg[j] * g2[j * BW + cc];
            const float lw = -softplusf_(-accw) - 0.5f, decay = __expf(-__expf(lw)), a = sigmoidf_(acca);
            const float r = xm[cc], k = xm[1024 + cc], v = xm[2048 + cc];
            const float kkr = k * k_k[cc]; const float ss = wave_sum(kkr * kkr); const float kk = kkr / fmaxf(sqrtf(ss), 1e-12f);
            const float k2 = k * (1.0f + (a - 1.0f) * k_a[cc]); const float rk = wave_sum(r * k2 * r_k[cc]);
            const size_t o = (size_t)row * BW + cc;
            R[o] = r; WD[o] = decay; K2[o] = k2; V[o] = v; KK[o] = kk; BV[o] = kk * a; G[o] = accg; BON[o] = rk * v;
        }
        __syncthreads();
    }
}
__device__ __forceinline__ int kperm_pos(int k) { return (k & ~31) + 8 * ((k >> 2) & 3) + 4 * ((k >> 4) & 1) + (k & 3); }
__device__ __forceinline__ void ph_swa_prompt(const Ctx& c, const bf16_t* __restrict__ U, const float* __restrict__ sinks, bf16_t* __restrict__ OB) {
    LAS bf16_t* K_l = (LAS bf16_t*)c.lds;
    LAS bf16_t* VT_l = K_l + 192 * 72;
    const int tid = c.tid, lane = c.lane, r = lane & 15, q = lane >> 4, w = c.wave;
    for (int u = c.bid; u < PB * 64 * 2; u += c.G) {
        const int b = u >> 7, qb = (u >> 1) & 63, kvh = u & 1, h = kvh * 8 + w;
        const int tok0 = qb * 64 - 128;
        const size_t seq0 = (size_t)b * PS;
        for (int idx = tid; idx < 192 * 8; idx += 512) { const int kl = idx >> 3, c8 = idx & 7, tk = tok0 + kl; u32x4 kv = (u32x4){0u, 0u, 0u, 0u}, vv = kv;
            if (tk >= 0) { const bf16_t* ur = U + (seq0 + tk) * NINP; kv = *(const u32x4*)(ur + U_SK + kvh * 64 + c8 * 8); vv = *(const u32x4*)(ur + U_SV + kvh * 64 + c8 * 8); }
            *(LAS u32x4*)(K_l + kl * 72 + c8 * 8) = kv;
            const int kp = kperm_pos(kl); LAS bf16_t* vp = VT_l + (c8 * 8) * 200 + kp;
            vp[0] = (bf16_t)(vv.x & 0xffffu); vp[200] = (bf16_t)(vv.x >> 16); vp[400] = (bf16_t)(vv.y & 0xffffu); vp[600] = (bf16_t)(vv.y >> 16);
            vp[800] = (bf16_t)(vv.z & 0xffffu); vp[1000] = (bf16_t)(vv.z >> 16); vp[1200] = (bf16_t)(vv.w & 0xffffu); vp[1400] = (bf16_t)(vv.w >> 16); }
        __syncthreads();
        const float slope = exp2f(-0.5f * (float)(h + 1)), sink = sinks[h];
#pragma unroll 1
        for (int i = 0; i < 4; ++i) {
            const size_t qrow = seq0 + qb * 64 + i * 16 + r;
            const bf16x8 qf0 = *(const bf16x8*)(U + qrow * NINP + U_SQ + h * 64 + q * 8), qf1 = *(const bf16x8*)(U + qrow * NINP + U_SQ + h * 64 + 32 + q * 8);
            const int kt0 = i & ~1;
            f32x4 s[10]; float mx = sink; bf16x8 kfr[5][2];
#pragma unroll
            for (int kt = 0; kt < 10; ++kt) { f32x4 d;
                if (kt % 5 == 0) {
#pragma unroll
                    for (int k5 = 0; k5 < 5; ++k5) { const LAS bf16_t* kp = K_l + ((kt0 + kt + k5) * 16 + r) * 72 + q * 8; kfr[k5][0] = *(const LAS bf16x8*)kp; kfr[k5][1] = *(const LAS bf16x8*)(kp + 32); }
                    __builtin_amdgcn_sched_barrier(0); }
                d = mma16(kfr[kt % 5][0], qf0, (f32x4){0.f, 0.f, 0.f, 0.f}); d = mma16(kfr[kt % 5][1], qf1, d);
#pragma unroll
                for (int jj = 0; jj < 4; ++jj) { const int kl = (kt0 + kt) * 16 + q * 4 + jj, dist = i * 16 + r + 128 - kl;
                    const float v = (dist >= 0 && dist <= 128 && tok0 + kl >= 0) ? d[jj] * 0.125f - slope * (float)dist : -1e30f; d[jj] = v; mx = fmaxf(mx, v); }
                s[kt] = d; }
            mx = fmaxf(mx, __shfl_xor(mx, 16, 64)); mx = fmaxf(mx, __shfl_xor(mx, 32, 64));
            float sum = 0.f; bf16x8 pf[5];
#pragma unroll
            for (int kp = 0; kp < 5; ++kp) { f32x4 a = s[2 * kp], bq = s[2 * kp + 1];
#pragma unroll
                for (int jj = 0; jj < 4; ++jj) { a[jj] = __expf(a[jj] - mx); bq[jj] = __expf(bq[jj] - mx); sum += a[jj] + bq[jj]; }
                pf[kp] = pack_acc(a, bq); }
            sum += __shfl_xor(sum, 16, 64); sum += __shfl_xor(sum, 32, 64);
            const float inv = 1.0f / (sum + __expf(sink - mx));
            bf16_t* op = OB + qrow * BW + h * 64 + q * 4;
#pragma unroll
            for (int dt = 0; dt < 4; ++dt) { f32x4 o = (f32x4){0.f, 0.f, 0.f, 0.f}; bf16x8 vfr[5];
#pragma unroll
                for (int kp = 0; kp < 5; ++kp) vfr[kp] = *(const LAS bf16x8*)(VT_l + (dt * 16 + r) * 200 + (kt0 + 2 * kp) * 16 + q * 8);
                __builtin_amdgcn_sched_barrier(0);
#pragma unroll
                for (int kp = 0; kp < 5; ++kp) o = mma16(vfr[kp], pf[kp], o);
                u32x2 ov; ov.x = pk2(o[0] * inv, o[1] * inv); ov.y = pk2(o[2] * inv, o[3] * inv); *(u32x2*)(op + dt * 16) = ov; }
        }
        __syncthreads();
    }
}

__device__ __forceinline__ void ph_swa_sample(const Ctx& c, const bf16_t* __restrict__ U, const float* __restrict__ ck, const float* __restrict__ cv, const float* __restrict__ sinks, bf16_t* __restrict__ OB) {
    LAS bf16_t* K_l = (LAS bf16_t*)c.lds;
    LAS bf16_t* VT_l = K_l + 160 * 72;
    const int tid = c.tid, lane = c.lane, r = lane & 15, q = lane >> 4, w = c.wave;
    for (int u = c.bid; u < SB * 2; u += c.G) {
        const int sq = u >> 1, kvh = u & 1;
        for (int idx = tid; idx < 160 * 8; idx += 512) { const int kl = idx >> 3, c8 = idx & 7; float kx[8], vx[8];
#pragma unroll
            for (int e = 0; e < 8; ++e) { kx[e] = 0.f; vx[e] = 0.f; }
            if (kl < 128) { const size_t o = ((size_t)sq * 128 + kl) * 128 + kvh * 64 + c8 * 8; const f32x4 a = *(const f32x4*)(ck + o), b2 = *(const f32x4*)(ck + o + 4), c2 = *(const f32x4*)(cv + o), d2 = *(const f32x4*)(cv + o + 4);
                kx[0] = a[0]; kx[1] = a[1]; kx[2] = a[2]; kx[3] = a[3]; kx[4] = b2[0]; kx[5] = b2[1]; kx[6] = b2[2]; kx[7] = b2[3];
                vx[0] = c2[0]; vx[1] = c2[1]; vx[2] = c2[2]; vx[3] = c2[3]; vx[4] = d2[0]; vx[5] = d2[1]; vx[6] = d2[2]; vx[7] = d2[3]; }
            else if (kl < 132) { const bf16_t* ur = U + (size_t)(MP + sq * SS + kl - 128) * NINP; unpack8(*(const u32x4*)(ur + U_SK + kvh * 64 + c8 * 8), kx); unpack8(*(const u32x4*)(ur + U_SV + kvh * 64 + c8 * 8), vx); }
            *(LAS u32x4*)(K_l + kl * 72 + c8 * 8) = (u32x4){pk2(kx[0], kx[1]), pk2(kx[2], kx[3]), pk2(kx[4], kx[5]), pk2(kx[6], kx[7])};
            LAS bf16_t* vp = VT_l + (c8 * 8) * 168 + kperm_pos(kl);
#pragma unroll
            for (int e = 0; e < 8; ++e) vp[e * 168] = f2bf(vx[e]); }
        __syncthreads();
        if (w < 2) {
            const int h = kvh * 8 + w * 4 + (r >> 2), tk = r & 3; const size_t qrow = (size_t)(MP + sq * SS + tk);
            const float slope = exp2f(-0.5f * (float)(h + 1)), sink = sinks[h];
            const bf16x8 qf0 = *(const bf16x8*)(U + qrow * NINP + U_SQ + h * 64 + q * 8), qf1 = *(const bf16x8*)(U + qrow * NINP + U_SQ + h * 64 + 32 + q * 8);
            f32x4 s[10]; float mx = sink;
#pragma unroll
            for (int kt = 0; kt < 10; ++kt) { const LAS bf16_t* kp = K_l + (kt * 16 + r) * 72 + q * 8;
                f32x4 d = mma16(*(const LAS bf16x8*)kp, qf0, (f32x4){0.f, 0.f, 0.f, 0.f}); d = mma16(*(const LAS bf16x8*)(kp + 32), qf1, d);
#pragma unroll
                for (int jj = 0; jj < 4; ++jj) { const int kl = kt * 16 + q * 4 + jj, dist = 128 + tk - kl;
                    const float v = (dist >= 0 && dist <= 128) ? d[jj] * 0.125f - slope * (float)dist : -1e30f; d[jj] = v; mx = fmaxf(mx, v); }
                s[kt] = d; }
            mx = fmaxf(mx, __shfl_xor(mx, 16, 64)); mx = fmaxf(mx, __shfl_xor(mx, 32, 64));
            float sum = 0.f; bf16x8 pf[5];
#pragma unroll
            for (int kp = 0; kp < 5; ++kp) { f32x4 a = s[2 * kp], bq = s[2 * kp + 1];
#pragma unroll
                for (int jj = 0; jj < 4; ++jj) { a[jj] = __expf(a[jj] - mx); bq[jj] = __expf(bq[jj] - mx); sum += a[jj] + bq[jj]; }
                pf[kp] = pack_acc(a, bq); }
            sum += __shfl_xor(sum, 16, 64); sum += __shfl_xor(sum, 32, 64);
            const float inv = 1.0f / (sum + __expf(sink - mx));
            bf16_t* op = OB + qrow * BW + h * 64 + q * 4;
#pragma unroll
            for (int dt = 0; dt < 4; ++dt) { f32x4 o = (f32x4){0.f, 0.f, 0.f, 0.f};
#pragma unroll
                for (int kp = 0; kp < 5; ++kp) o = mma16(*(const LAS bf16x8*)(VT_l + (dt * 16 + r) * 168 + kp * 32 + q * 8), pf[kp], o);
                u32x2 ov; ov.x = pk2(o[0] * inv, o[1] * inv); ov.y = pk2(o[2] * inv, o[3] * inv); *(u32x2*)(op + dt * 16) = ov; }
        }
        __syncthreads();
    }
}

__device__ __forceinline__ void ph_memattn_prompt(const Ctx& c, const bf16_t* __restrict__ U, const bf16_t* __restrict__ MKB, const bf16_t* __restrict__ MVT, bf16_t* __restrict__ OB) {
    LAS bf16_t* buf = (LAS bf16_t*)c.lds;
    const int tid = c.tid, lane = c.lane, r = lane & 15, q = lane >> 4, w = c.wave;
    for (int u = c.bid; u < PB * 4 * 32; u += c.G) {
        const int b = u >> 7, h = (u >> 5) & 3, qb = u & 31;
        const size_t qrow = (size_t)b * PS + qb * 128 + w * 16 + r;
        const bf16_t* kg = MKB + (size_t)(b * 256) * 1024 + h * 256;
        const bf16_t* vg = MVT + (size_t)(b * 4 + h) * 65536;
        const bf16_t* qg = U + qrow * NINP + U_MQ + h * 256 + q * 8;
        bf16x8 qn0 = *(const bf16x8*)qg, qn1 = *(const bf16x8*)(qg + 32);
        u32x4 st[4];
#pragma unroll
        for (int i = 0; i < 4; ++i) { const int p = tid + 512 * i; st[i] = *(const u32x4*)(kg + (size_t)(p >> 3) * 1024 + (p & 7) * 8); }
        f32x4 s[16];
#pragma unroll
        for (int mt = 0; mt < 16; ++mt) s[mt] = (f32x4){0.f, 0.f, 0.f, 0.f};
        __syncthreads();
#pragma unroll 1
        for (int ck = 0; ck < 4; ++ck) {
            LAS bf16_t* kb = buf + (ck & 1) * 18432;
#pragma unroll
            for (int i = 0; i < 4; ++i) { const int p = tid + 512 * i; *(LAS u32x4*)(kb + (p >> 3) * 72 + (p & 7) * 8) = st[i]; }
            __syncthreads();
            const bf16x8 qc0 = qn0, qc1 = qn1;
            if (ck < 3) { qn0 = *(const bf16x8*)(qg + (ck + 1) * 64); qn1 = *(const bf16x8*)(qg + (ck + 1) * 64 + 32);
#pragma unroll
                for (int i = 0; i < 4; ++i) { const int p = tid + 512 * i; st[i] = *(const u32x4*)(kg + (size_t)(p >> 3) * 1024 + (ck + 1) * 64 + (p & 7) * 8); } }
#pragma unroll
            for (int m2 = 0; m2 < 16; m2 += 2) { bf16x8 kf[2][2];
#pragma unroll
                for (int j = 0; j < 2; ++j) { kf[j][0] = *(const LAS bf16x8*)(kb + ((m2 + j) * 16 + r) * 72 + q * 8); kf[j][1] = *(const LAS bf16x8*)(kb + ((m2 + j) * 16 + r) * 72 + 32 + q * 8); }
                __builtin_amdgcn_sched_barrier(0);
#pragma unroll
                for (int j = 0; j < 2; ++j) { s[m2 + j] = mma16(kf[j][0], qc0, s[m2 + j]); s[m2 + j] = mma16(kf[j][1], qc1, s[m2 + j]); } }
        }
#pragma unroll
        for (int i = 0; i < 4; ++i) { const int p = tid + 512 * i; st[i] = *(const u32x4*)(vg + (size_t)(p >> 5) * 256 + (p & 31) * 8); }
        float mx = -3.0e38f;
#pragma unroll
        for (int mt = 0; mt < 16; ++mt)
#pragma unroll
            for (int jj = 0; jj < 4; ++jj) { s[mt][jj] *= 0.0625f; mx = fmaxf(mx, s[mt][jj]); }
        mx = fmaxf(mx, __shfl_xor(mx, 16, 64)); mx = fmaxf(mx, __shfl_xor(mx, 32, 64));
        float sum = 0.f; bf16x8 pf[8];
#pragma unroll
        for (int kp = 0; kp < 8; ++kp) { f32x4 a = s[2 * kp], b2 = s[2 * kp + 1];
#pragma unroll
            for (int jj = 0; jj < 4; ++jj) { a[jj] = __expf(a[jj] - mx); b2[jj] = __expf(b2[jj] - mx); sum += a[jj] + b2[jj]; }
            pf[kp] = pack_acc(a, b2); }
        sum += __shfl_xor(sum, 16, 64); sum += __shfl_xor(sum, 32, 64);
        const float inv = 1.0f / sum;
        bf16_t* op = OB + qrow * BW + h * 256 + q * 4;
#pragma unroll 1
        for (int cv = 0; cv < 4; ++cv) {
            LAS bf16_t* vb = buf + (cv & 1) * 18432;
#pragma unroll
            for (int i = 0; i < 4; ++i) { const int p = tid + 512 * i, m0 = (p & 31) * 8; LAS bf16_t* d0 = vb + (p >> 5) * 264;
                *(LAS u32x2*)(d0 + kperm_pos(m0)) = (u32x2){st[i].x, st[i].y}; *(LAS u32x2*)(d0 + kperm_pos(m0 + 4)) = (u32x2){st[i].z, st[i].w}; }
            __syncthreads();
            if (cv < 3) {
#pragma unroll
                for (int i = 0; i < 4; ++i) { const int p = tid + 512 * i; st[i] = *(const u32x4*)(vg + (size_t)((cv + 1) * 64 + (p >> 5)) * 256 + (p & 31) * 8); } }
#pragma unroll
            for (int dt = 0; dt < 4; ++dt) { bf16x8 vf[8];
#pragma unroll
                for (int kp = 0; kp < 8; ++kp) vf[kp] = *(const LAS bf16x8*)(vb + (dt * 16 + r) * 264 + kp * 32 + q * 8);
                __builtin_amdgcn_sched_barrier(0);
                f32x4 o = (f32x4){0.f, 0.f, 0.f, 0.f};
#pragma unroll
                for (int kp = 0; kp < 8; ++kp) o = mma16(vf[kp], pf[kp], o);
                u32x2 ov; ov.x = pk2(o[0] * inv, o[1] * inv); ov.y = pk2(o[2] * inv, o[3] * inv); *(u32x2*)(op + (cv * 4 + dt) * 16) = ov; }
        }
        __syncthreads();
    }
}

__device__ __forceinline__ void ph_lrw(const Ctx& c, const float* __restrict__ w2, const float* __restrict__ a2, const float* __restrict__ g2, bf16_t* __restrict__ LRW) {
    for (int idx = c.bid * 512 + c.tid; idx < NL * 256 * 1024; idx += c.G * 512) {
        const int ch = idx & 1023, j = (idx >> 10) & 255, l = idx >> 18;
        const float v = j < 64 ? w2[((size_t)l * 64 + j) * BW + ch] : (j < 128 ? a2[((size_t)l * 64 + j - 64) * BW + ch] : g2[((size_t)l * 128 + j - 128) * BW + ch]);
        LRW[((size_t)l * 1024 + ch) * 256 + j] = f2bf(v);
    }
}
constexpr int RWP_UNITS = (MP / 64) * 4 + SB * 4;
__device__ __forceinline__ void rwp_unit_info(int u, int& row0, int& ntok, int& hg, int& sq, bool& seq_first) {
    if (u < (MP / 64) * 4) { const int blk = u >> 2; hg = u & 3; row0 = blk * 64; ntok = 64; sq = -1; seq_first = (row0 % PS) == 0; }
    else { const int s = u - (MP / 64) * 4; sq = s >> 2; hg = s & 3; row0 = MP + sq * SS; ntok = SS; seq_first = true; }
}
__device__ __forceinline__ void ph_rwkv_pre(const Ctx& c, const bf16_t* __restrict__ U, const float* __restrict__ shift, const float* __restrict__ mu, const float* __restrict__ w0, const float* __restrict__ w2,
                                            const float* __restrict__ a0, const float* __restrict__ a2, const float* __restrict__ g2, const float* __restrict__ k_k, const float* __restrict__ k_a,
                                            const float* __restrict__ r_k, float* __restrict__ RW, bf16_t* __restrict__ RB, const bf16_t* __restrict__ LRW) {
    LAS bf16_t* P_l = (LAS bf16_t*)c.lds; LAS bf16_t* Kn_l = P_l + 4608; LAS bf16_t* Bn_l = Kn_l + 4608; LAS bf16_t* Q_l = Bn_l + 4608;
    LAS bf16_t* PT_l = Q_l + 4608; LAS bf16_t* BhT_l = PT_l + 4608; LAS bf16_t* KhT_l = BhT_l + 4608; LAS bf16_t* VT_l = KhT_l + 4608;
    LAS float* A_l = (LAS float*)(c.lds + 73728);
    LAS bf16_t* BmT_l = (LAS bf16_t*)(c.lds + 78848); LAS bf16_t* F_l = (LAS bf16_t*)(c.lds + 81920); LAS bf16_t* Tinv_l = (LAS bf16_t*)(c.lds + 84992);
    LAS bf16_t* PpT_l = (LAS bf16_t*)(c.lds + 88064);
    LAS bf16_t* BmpT_l = (LAS bf16_t*)(c.lds + 97280);
    LAS float* GC_l = (LAS float*)(c.lds + 100352);
    LAS float* lg_l = (LAS float*)(c.lds + 125952);
    LAS bf16_t* act_l = (LAS bf16_t*)c.lds;
    LAS bf16_t* wT_l = act_l + 64 * 264;
    LAS bf16_t* aT_l = wT_l + 64 * 72;
    LAS bf16_t* gT_l = aT_l + 64 * 72;
    LAS float* pre_l = (LAS float*)(c.lds + 73728);
    const int tid = c.tid, lane = c.lane, r = lane & 15, q = lane >> 4, w = c.wave;
    bf16_t* Gg = (bf16_t*)(RW + 6 * (size_t)MPAD * BW); bf16_t* BON = (bf16_t*)(RW + 7 * (size_t)MPAD * BW);
    for (int u = c.bid; u < RWP_UNITS; u += c.G) {
        int row0, ntok, hg, sq; bool seq_first; rwp_unit_info(u, row0, ntok, hg, sq, seq_first);
        const float* sh = sq >= 0 ? shift + (size_t)sq * RWC : nullptr;
        const int nstage = ntok == 64 ? 64 : 16;
        for (int idx = tid; idx < nstage * 32; idx += 512) {
            const int t = idx >> 5, c8 = idx & 31, cc = 3072 + c8 * 8; float val[8];
#pragma unroll
            for (int e2 = 0; e2 < 8; ++e2) val[e2] = 0.f;
            if (t < ntok) { const bf16_t* ur = U + (size_t)(row0 + t) * NINP + U_RU; float x[8], p[8];
                unpack8(*(const u32x4*)(ur + cc), x);
                if (!(t == 0 && seq_first)) unpack8(*(const u32x4*)(ur + cc - NINP), p);
                else if (sh) { const f32x4 s0v = *(const f32x4*)(sh + cc), s1v = *(const f32x4*)(sh + cc + 4); p[0] = s0v[0]; p[1] = s0v[1]; p[2] = s0v[2]; p[3] = s0v[3]; p[4] = s1v[0]; p[5] = s1v[1]; p[6] = s1v[2]; p[7] = s1v[3]; }
                else {
#pragma unroll
                    for (int e2 = 0; e2 < 8; ++e2) p[e2] = 0.f; }
                const f32x4 m0 = *(const f32x4*)(mu + cc), m1 = *(const f32x4*)(mu + cc + 4);
#pragma unroll
                for (int e2 = 0; e2 < 8; ++e2) { const float xm = x[e2] + (p[e2] - x[e2]) * (e2 < 4 ? m0[e2] : m1[e2 - 4]); val[e2] = c8 < 8 ? tanh_fast(xm) : (c8 < 16 ? xm : sigmoidf_(xm)); } }
            *(LAS u32x4*)(act_l + t * 264 + c8 * 8) = (u32x4){pk2(val[0], val[1]), pk2(val[2], val[3]), pk2(val[4], val[5]), pk2(val[6], val[7])};
        }
        __syncthreads();
        bf16x8 af[8];
        { const int tb = w & 3;
#pragma unroll
          for (int ks = 0; ks < 8; ++ks) af[ks] = *(const LAS bf16x8*)(act_l + (tb * 16 + r) * 264 + ks * 32 + q * 8); }
        __syncthreads();
#pragma unroll 1
        for (int hh = 0; hh < 4; ++hh) { const int h = hg * 4 + hh;
        { const int tb = w & 3, chf = w >> 2;
          if (tb * 16 < nstage) {
#pragma unroll
            for (int e2 = 0; e2 < 2; ++e2) { const int cb = chf * 2 + e2; f32x4 dw = (f32x4){0.f, 0.f, 0.f, 0.f}, da = dw, dg = dw;
                const bf16_t* wr = LRW + ((size_t)h * 64 + cb * 16 + r) * 256 + q * 8; bf16x8 wf[8];
#pragma unroll
                for (int ks = 0; ks < 8; ++ks) wf[ks] = *(const bf16x8*)(wr + ks * 32);
                __builtin_amdgcn_sched_barrier(0);
#pragma unroll
                for (int ks = 0; ks < 2; ++ks) { dw = mma16(wf[ks], af[ks], dw); da = mma16(wf[2 + ks], af[2 + ks], da); }
#pragma unroll
                for (int ks = 0; ks < 4; ++ks) dg = mma16(wf[4 + ks], af[4 + ks], dg);
                const int o = (tb * 16 + r) * 68 + cb * 16 + q * 4;
                *(LAS f32x4*)(pre_l + o) = dw; *(LAS f32x4*)(pre_l + 64 * 68 + o) = da; *(LAS f32x4*)(pre_l + 2 * 64 * 68 + o) = dg; } } }
        __syncthreads();
        const int t = tid >> 3, cg = tid & 7, c0 = h * 64 + cg * 8, sc = t >> 4;
        float rr[8], k2[8], kap[8], bet[8], nlw[8];
        { float vx[8], gg[8], kkr[8]; float ss = 0.f, rk = 0.f;
          if (t < ntok) {
            const size_t row = (size_t)(row0 + t); const bf16_t* ur = U + row * NINP + U_RU; const bool fst = (t == 0 && seq_first);
            float kx[8];
#pragma unroll
            for (int part = 0; part < 3; ++part) { const int cc = part * 1024 + c0; float x[8], p[8];
                unpack8(*(const u32x4*)(ur + cc), x);
                if (!fst) unpack8(*(const u32x4*)(ur + cc - NINP), p);
                else {
#pragma unroll
                    for (int j = 0; j < 8; ++j) p[j] = sh ? sh[cc + j] : 0.f; }
                const f32x4 mA = *(const f32x4*)(mu + cc), mB = *(const f32x4*)(mu + cc + 4);
#pragma unroll
                for (int j = 0; j < 8; ++j) { const float xm = x[j] + (p[j] - x[j]) * (j < 4 ? mA[j] : mB[j - 4]); if (part == 0) rr[j] = xm; else if (part == 1) kx[j] = xm; else vx[j] = xm; } }
            float pw[8], pa[8], pkk[8], pka[8], prk[8];
#pragma unroll
            for (int hf = 0; hf < 2; ++hf) { const f32x4 v0 = *(const f32x4*)(w0 + c0 + hf * 4), v1 = *(const f32x4*)(a0 + c0 + hf * 4), v2 = *(const f32x4*)(k_k + c0 + hf * 4), v3 = *(const f32x4*)(k_a + c0 + hf * 4), v4 = *(const f32x4*)(r_k + c0 + hf * 4);
#pragma unroll
                for (int j = 0; j < 4; ++j) { pw[hf * 4 + j] = v0[j]; pa[hf * 4 + j] = v1[j]; pkk[hf * 4 + j] = v2[j]; pka[hf * 4 + j] = v3[j]; prk[hf * 4 + j] = v4[j]; } }
            float lwp[8], app[8];
#pragma unroll
            for (int hf = 0; hf < 2; ++hf) { const f32x4 v0 = *(const LAS f32x4*)(pre_l + t * 68 + cg * 8 + hf * 4), v1 = *(const LAS f32x4*)(pre_l + 64 * 68 + t * 68 + cg * 8 + hf * 4), v2 = *(const LAS f32x4*)(pre_l + 2 * 64 * 68 + t * 68 + cg * 8 + hf * 4);
#pragma unroll
                for (int j = 0; j < 4; ++j) { lwp[hf * 4 + j] = v0[j]; app[hf * 4 + j] = v1[j]; gg[hf * 4 + j] = v2[j]; } }
#pragma unroll
            for (int j = 0; j < 8; ++j) {
                const float lw = -softplus_fast(-(pw[j] + lwp[j])) - 0.5f; nlw[j] = -__expf(lw); const float av = sigmoidf_(pa[j] + app[j]);
                kkr[j] = kx[j] * pkk[j]; ss += kkr[j] * kkr[j]; k2[j] = kx[j] * (1.0f + (av - 1.0f) * pka[j]); rk += rr[j] * k2[j] * prk[j]; bet[j] = av; }
          } else {
#pragma unroll
            for (int j = 0; j < 8; ++j) { rr[j] = 0.f; k2[j] = 0.f; kkr[j] = 0.f; bet[j] = 0.f; nlw[j] = 0.f; vx[j] = 0.f; gg[j] = 0.f; }
          }
          ss += __shfl_xor(ss, 1, 64); ss += __shfl_xor(ss, 2, 64); ss += __shfl_xor(ss, 4, 64);
          rk += __shfl_xor(rk, 1, 64); rk += __shfl_xor(rk, 2, 64); rk += __shfl_xor(rk, 4, 64);
          const float inv = 1.0f / fmaxf(sqrtf(ss), 1e-12f);
#pragma unroll
          for (int j = 0; j < 8; ++j) { kap[j] = kkr[j] * inv; bet[j] = kap[j] * bet[j]; }
          if (t < ntok) { const size_t o = (size_t)(row0 + t) * BW + c0;
              *(u32x4*)(Gg + o) = (u32x4){pk2(gg[0], gg[1]), pk2(gg[2], gg[3]), pk2(gg[4], gg[5]), pk2(gg[6], gg[7])};
              *(u32x4*)(BON + o) = (u32x4){pk2(rk * vx[0], rk * vx[1]), pk2(rk * vx[2], rk * vx[3]), pk2(rk * vx[4], rk * vx[5]), pk2(rk * vx[6], rk * vx[7])}; }
          *(LAS f32x4*)(lg_l + t * 68 + cg * 8) = (f32x4){nlw[0], nlw[1], nlw[2], nlw[3]}; *(LAS f32x4*)(lg_l + t * 68 + cg * 8 + 4) = (f32x4){nlw[4], nlw[5], nlw[6], nlw[7]};
#pragma unroll
          for (int j = 0; j < 8; ++j) VT_l[(cg * 8 + j) * 72 + t] = f2bf(vx[j]);
        }
        __syncthreads();
        if (tid < 256) { const int cc = tid & 63, s4 = tid >> 6; float run = 0.f;
#pragma unroll
            for (int i = 0; i < 16; ++i) { const int o = (s4 * 16 + i) * 68 + cc; run += lg_l[o]; lg_l[o] = run; } }
        __syncthreads();
        { unsigned pp[4], pq[4], pk[4], pb[4];
#pragma unroll
          for (int j = 0; j < 8; j += 2) { float vP[2], vQ[2], vK[2], vB[2];
#pragma unroll
              for (int e = 0; e < 2; ++e) { const int jj = j + e, cc = cg * 8 + jj; const float ci = lg_l[t * 68 + cc], cC = lg_l[(sc * 16 + 15) * 68 + cc];
                  const float ei = __expf(-ci), eh = __expf(cC - ci);
                  vP[e] = kap[jj] * __expf(ci - nlw[jj]); vQ[e] = rr[jj] * __expf(ci); vK[e] = k2[jj] * ei; vB[e] = bet[jj] * ei;
                  PT_l[cc * 72 + t] = f2bf(vP[e]); BhT_l[cc * 72 + t] = f2bf(bet[jj] * eh); KhT_l[cc * 72 + t] = f2bf(k2[jj] * eh); }
              pp[j >> 1] = pk2(vP[0], vP[1]); pq[j >> 1] = pk2(vQ[0], vQ[1]); pk[j >> 1] = pk2(vK[0], vK[1]); pb[j >> 1] = pk2(vB[0], vB[1]); }
          const int o = t * 72 + cg * 8;
          *(LAS u32x4*)(P_l + o) = (u32x4){pp[0], pp[1], pp[2], pp[3]}; *(LAS u32x4*)(Q_l + o) = (u32x4){pq[0], pq[1], pq[2], pq[3]};
          *(LAS u32x4*)(Kn_l + o) = (u32x4){pk[0], pk[1], pk[2], pk[3]}; *(LAS u32x4*)(Bn_l + o) = (u32x4){pb[0], pb[1], pb[2], pb[3]};
          if ((t & 15) == 15) {
#pragma unroll
              for (int j = 0; j < 8; ++j) GC_l[sc * 64 + cg * 8 + j] = __expf(lg_l[t * 68 + cg * 8 + j]); } }
        __syncthreads();
        const int nsub = ntok == 64 ? 4 : 1;
        const bf16x8 zfrag = (bf16x8){0, 0, 0, 0, 0, 0, 0, 0};
        for (int id = w; id < nsub * 3; id += 8) { const int s4 = id / 3, prod = id - s4 * 3; f32x4 d = (f32x4){0.f, 0.f, 0.f, 0.f};
            const LAS bf16_t* X = (prod == 1 ? P_l : Bn_l) + (s4 * 16 + r) * 72 + q * 8; const LAS bf16_t* Y = (prod == 0 ? P_l : (prod == 1 ? Kn_l : Q_l)) + (s4 * 16 + r) * 72 + q * 8;
            { const bf16x8 x0 = *(const LAS bf16x8*)X, x1 = *(const LAS bf16x8*)(X + 32), y0 = *(const LAS bf16x8*)Y, y1 = *(const LAS bf16x8*)(Y + 32);
              __builtin_amdgcn_sched_barrier(0); d = mma16(x0, y0, d); d = mma16(x1, y1, d); }
            if (prod == 0) { f32x4 o4;
#pragma unroll
                for (int jj = 0; jj < 4; ++jj) o4[jj] = (q * 4 + jj < r) ? d[jj] : 0.f;
                *(LAS f32x4*)(A_l + s4 * 320 + r * 20 + q * 4) = o4; }
            else { float o4[4];
#pragma unroll
                for (int jj = 0; jj < 4; ++jj) o4[jj] = (prod == 1 ? (r < q * 4 + jj) : (q * 4 + jj <= r)) ? d[jj] : 0.f;
                u32x2 o; o.x = pk2(o4[0], o4[1]); o.y = pk2(o4[2], o4[3]); *(LAS u32x2*)((prod == 1 ? BmT_l : F_l) + s4 * 384 + r * 24 + q * 4) = o; } }
        __syncthreads();
        if (w == 0 && (lane >> 4) < nsub) { const int s4 = lane >> 4, jc = lane & 15; float x[16];
#pragma unroll
            for (int tt = 0; tt < 16; ++tt) { float s = (tt == jc) ? 1.f : 0.f;
#pragma unroll
                for (int i = 0; i < tt; ++i) s -= A_l[s4 * 320 + tt * 20 + i] * x[i];
                x[tt] = s; }
#pragma unroll
            for (int tt = 0; tt < 16; ++tt) Tinv_l[s4 * 384 + tt * 24 + jc] = f2bf(x[tt]); }
        __syncthreads();
        for (int id = w; id < nsub * 5; id += 8) { const int s4 = id / 5, rem = id - s4 * 5;
            const bf16x8 xf = q < 2 ? *(const LAS bf16x8*)(Tinv_l + s4 * 384 + r * 24 + q * 8) : zfrag;
            const bf16x8 yf = q < 2 ? (rem < 4 ? *(const LAS bf16x8*)(PT_l + (rem * 16 + r) * 72 + s4 * 16 + q * 8) : *(const LAS bf16x8*)(BmT_l + s4 * 384 + r * 24 + q * 8)) : zfrag;
            const f32x4 d = mma16(xf, yf, (f32x4){0.f, 0.f, 0.f, 0.f});
            u32x2 o; o.x = pk2(d[0], d[1]); o.y = pk2(d[2], d[3]);
            if (rem < 4) *(LAS u32x2*)(PpT_l + (rem * 16 + r) * 72 + s4 * 16 + q * 4) = o; else *(LAS u32x2*)(BmpT_l + s4 * 384 + r * 24 + q * 4) = o; }
        __syncthreads();
        { const int chunk0 = sq >= 0 ? PB * 16 * 256 + sq * 16 + h : ((row0 / PS) * 16 + h) * 256 + ((row0 % PS) >> 4);
          for (int id = w; id < nsub * 25; id += 8) { const int s4 = id / 25, rem = id - s4 * 25; bf16_t* blob = RB + (size_t)(chunk0 + s4) * RB_EL;
            const bf16x8 fF = q < 2 ? *(const LAS bf16x8*)(F_l + s4 * 384 + r * 24 + q * 8) : zfrag;
            if (rem < 4) {
                const bf16x8 xf = q < 2 ? *(const LAS bf16x8*)(PpT_l + (rem * 16 + r) * 72 + s4 * 16 + q * 8) : zfrag;
                const f32x4 d = mma16(xf, fF, (f32x4){0.f, 0.f, 0.f, 0.f});
                const u32x2 qv = *(const LAS u32x2*)(Q_l + (s4 * 16 + r) * 72 + rem * 16 + q * 4);
                u32x2 o; o.x = pk2(__uint_as_float(qv.x << 16) - d[0], __uint_as_float(qv.x & 0xffff0000u) - d[1]); o.y = pk2(__uint_as_float(qv.y << 16) - d[2], __uint_as_float(qv.y & 0xffff0000u) - d[3]);
                *(u32x2*)(blob + RB_QP + r * 72 + 32 * (rem >> 1) + 8 * q + 4 * (rem & 1)) = o;
            } else if (rem == 4) {
                f32x4 d2 = (f32x4){0.f, 0.f, 0.f, 0.f};
#pragma unroll
                for (int ks = 0; ks < 2; ++ks) d2 = mma16(*(const LAS bf16x8*)(Kn_l + (s4 * 16 + r) * 72 + ks * 32 + q * 8), *(const LAS bf16x8*)(Q_l + (s4 * 16 + r) * 72 + ks * 32 + q * 8), d2);
                const bf16x8 xf = q < 2 ? *(const LAS bf16x8*)(BmpT_l + s4 * 384 + r * 24 + q * 8) : zfrag;
                const f32x4 d1 = mma16(xf, fF, (f32x4){0.f, 0.f, 0.f, 0.f});
                float o4[4];
#pragma unroll
                for (int jj = 0; jj < 4; ++jj) o4[jj] = ((q * 4 + jj <= r) ? d2[jj] : 0.f) - d1[jj];
                u32x2 o; o.x = pk2(o4[0], o4[1]); o.y = pk2(o4[2], o4[3]); *(u32x2*)(blob + RB_EP + r * 24 + q * 4) = o;
            } else if (rem < 21) {
                const int cib = (rem - 5) >> 2, cob = (rem - 5) & 3;
                const bf16x8 xf = q < 2 ? *(const LAS bf16x8*)(PpT_l + (cib * 16 + r) * 72 + s4 * 16 + q * 8) : zfrag;
                const bf16x8 yf = q < 2 ? *(const LAS bf16x8*)(BhT_l + (cob * 16 + r) * 72 + s4 * 16 + q * 8) : zfrag;
                const f32x4 d = mma16(xf, yf, (f32x4){0.f, 0.f, 0.f, 0.f});
                const float gc = GC_l[s4 * 64 + cob * 16 + r]; float o4[4];
#pragma unroll
                for (int jj = 0; jj < 4; ++jj) o4[jj] = ((cib == cob && q * 4 + jj == r) ? gc : 0.f) - d[jj];
                u32x2 o; o.x = pk2(o4[0], o4[1]); o.y = pk2(o4[2], o4[3]); *(u32x2*)(blob + (cob * 16 + r) * 72 + 32 * (cib >> 1) + 8 * q + 4 * (cib & 1)) = o;
            } else {
                const int cb = rem - 21;
                const bf16x8 xf = q < 2 ? *(const LAS bf16x8*)(BmpT_l + s4 * 384 + r * 24 + q * 8) : zfrag;
                const bf16x8 yf = q < 2 ? *(const LAS bf16x8*)(BhT_l + (cb * 16 + r) * 72 + s4 * 16 + q * 8) : zfrag;
                const f32x4 d = mma16(xf, yf, (f32x4){0.f, 0.f, 0.f, 0.f});
                const u32x2 kv = *(const LAS u32x2*)(KhT_l + (cb * 16 + r) * 72 + s4 * 16 + q * 4);
                u32x2 o; o.x = pk2(__uint_as_float(kv.x << 16) - d[0], __uint_as_float(kv.x & 0xffff0000u) - d[1]); o.y = pk2(__uint_as_float(kv.y << 16) - d[2], __uint_as_float(kv.y & 0xffff0000u) - d[3]);
                *(u32x2*)(blob + RB_KHP + (cb * 16 + r) * 24 + q * 4) = o;
            } }
          for (int idx = tid; idx < nsub * 128; idx += 512) { const int s4 = idx >> 7, cc = (idx >> 1) & 63, hf = idx & 1;
              *(u32x4*)(RB + (size_t)(chunk0 + s4) * RB_EL + RB_VT + cc * 24 + hf * 8) = *(const LAS u32x4*)(VT_l + cc * 72 + s4 * 16 + hf * 8); } }
        __syncthreads();
        }
    }
}

__device__ __forceinline__ void ph_rwkv_scan_naive(const Ctx& c, const float* __restrict__ RW, const float* __restrict__ s0, const float* __restrict__ lng, const float* __restrict__ lnb, bf16_t* __restrict__ OB,
                                                   float* __restrict__ outP, float* __restrict__ outS) {
    const float* R = RW; const float* WD = RW + (size_t)MPAD * BW; const float* K2 = WD + (size_t)MPAD * BW; const float* V = K2 + (size_t)MPAD * BW; const float* KK = V + (size_t)MPAD * BW;
    const float* BV = KK + (size_t)MPAD * BW; const float* G = BV + (size_t)MPAD * BW; const float* BON = G + (size_t)MPAD * BW;
    const int lane = c.lane;
    for (int it = 0;; ++it) {
        const int u = (it * 8 + c.wave) * c.G + c.bid;
        if (u >= (PB + SB) * 16) break;
        const int sq = u >> 4, h = u & 15;
        int row0, L; seq_info(sq, row0, L);
        float S[64];
        if (sq >= PB) { const float* p = s0 + (((size_t)(sq - PB) * 16 + h) * 64 + lane) * 64;
#pragma unroll
            for (int j = 0; j < 64; ++j) S[j] = p[j]; }
        else {
#pragma unroll
            for (int j = 0; j < 64; ++j) S[j] = 0.f; }
        const float lg = lng[h * 64 + lane], lb = lnb[h * 64 + lane];
        for (int t = 0; t < L; ++t) {
            const size_t base = (size_t)(row0 + t) * BW + h * 64; const float v = V[base + lane];
            float d = 0.f;
#pragma unroll
            for (int j = 0; j < 64; ++j) d += S[j] * KK[base + j];
            float y = 0.f;
#pragma unroll
            for (int j = 0; j < 64; ++j) { S[j] = S[j] * WD[base + j] - d * BV[base + j] + v * K2[base + j]; y += S[j] * R[base + j]; }
            const float mean = wave_sum(y) * (1.0f / 64.0f), dy = y - mean, var = wave_sum(dy * dy) * (1.0f / 64.0f);
            const float yn = dy * rsqrtf(var + 64e-5f) * lg + lb;
            OB[base + lane] = f2bf((yn + BON[base + lane]) * G[base + lane]);
        }
        float* op = (sq < PB ? outP + (((size_t)sq * 16 + h) * 64 + lane) * 64 : outS + (((size_t)(sq - PB) * 16 + h) * 64 + lane) * 64);
#pragma unroll
        for (int j = 0; j < 64; ++j) op[j] = S[j];
    }
}
__device__ __forceinline__ void ph_rwkv_scan2(const Ctx& c, int boff, const float* __restrict__ RW, const float* __restrict__ s0, const float* __restrict__ lng, const float* __restrict__ lnb, bf16_t* __restrict__ OB,
                                              float* __restrict__ outP, float* __restrict__ outS) {
    LAS float* opb = (LAS float*)c.lds;
    LAS float* yb = opb + 2 * 16 * 384;
    const int tid = c.tid, lane = c.lane, w = c.wave, rl = lane >> 3, cg = lane & 7, vrow = w * 8 + rl;
    const float* G = RW + 6 * (size_t)MPAD * BW; const float* BON = RW + 7 * (size_t)MPAD * BW;
    for (int u = (c.bid - boff + c.G) % c.G; u < (PB + SB) * 16; u += c.G) {
        const int sq = u >> 4, h = u & 15;
        int row0, L; seq_info(sq, row0, L);
        float S[8];
        if (sq >= PB) { const float* p = s0 + (((size_t)(sq - PB) * 16 + h) * 64 + vrow) * 64 + cg * 8;
#pragma unroll
            for (int j = 0; j < 8; ++j) S[j] = p[j]; }
        else {
#pragma unroll
            for (int j = 0; j < 8; ++j) S[j] = 0.f; }
        const float lg = lng[h * 64 + lane], lb = lnb[h * 64 + lane];
        const int nb = (L + 15) >> 4;
#define RW_STAGE(bi_) do { const int t0_ = (bi_) * 16, nT_ = (L - t0_) < 16 ? (L - t0_) : 16; LAS float* dst_ = opb + ((bi_) & 1) * 16 * 384; \
        for (int idx = tid; idx < nT_ * 96; idx += 512) { const int t = idx / 96, rem = idx - t * 96, slot = rem >> 4, c4 = rem & 15; \
            const int arr = slot == 0 ? 1 : slot == 1 ? 4 : slot == 2 ? 5 : slot == 3 ? 2 : slot == 4 ? 0 : 3; \
            *(LAS f32x4*)(dst_ + t * 384 + slot * 64 + c4 * 4) = *(const f32x4*)(RW + (size_t)arr * MPAD * BW + (size_t)(row0 + t0_ + t) * BW + h * 64 + c4 * 4); } } while (0)
        RW_STAGE(0);
        for (int bi = 0; bi < nb; ++bi) {
            __syncthreads();
            if (bi + 1 < nb) RW_STAGE(bi + 1);
            const int t0 = bi * 16, nT = (L - t0) < 16 ? (L - t0) : 16; const LAS float* src = opb + (bi & 1) * 16 * 384;
            for (int tt = 0; tt < nT; ++tt) {
                const LAS float* b = src + tt * 384 + cg * 8;
                const f32x4 w0 = *(const LAS f32x4*)(b), w1 = *(const LAS f32x4*)(b + 4), k0 = *(const LAS f32x4*)(b + 64), k1 = *(const LAS f32x4*)(b + 68);
                const f32x4 b0 = *(const LAS f32x4*)(b + 128), b1 = *(const LAS f32x4*)(b + 132), q0 = *(const LAS f32x4*)(b + 192), q1 = *(const LAS f32x4*)(b + 196);
                const f32x4 r0 = *(const LAS f32x4*)(b + 256), r1 = *(const LAS f32x4*)(b + 260); const float v = src[tt * 384 + 320 + vrow];
                float d = (S[0] * k0[0] + S[1] * k0[1]) + (S[2] * k0[2] + S[3] * k0[3]) + (S[4] * k1[0] + S[5] * k1[1]) + (S[6] * k1[2] + S[7] * k1[3]);
                d += __shfl_xor(d, 1, 64); d += __shfl_xor(d, 2, 64); d += __shfl_xor(d, 4, 64);
                float y = 0.f;
#pragma unroll
                for (int j = 0; j < 4; ++j) { S[j] = S[j] * w0[j] - d * b0[j] + v * q0[j]; y += S[j] * r0[j]; S[4 + j] = S[4 + j] * w1[j] - d * b1[j] + v * q1[j]; y += S[4 + j] * r1[j]; }
                y += __shfl_xor(y, 1, 64); y += __shfl_xor(y, 2, 64); y += __shfl_xor(y, 4, 64);
                if (cg == 0) yb[tt * 64 + vrow] = y;
            }
            __syncthreads();
            for (int tt = w; tt < nT; tt += 8) {
                const float y = yb[tt * 64 + lane]; const float mean = wave_sum(y) * (1.0f / 64.0f), dy = y - mean, var = wave_sum(dy * dy) * (1.0f / 64.0f);
                const float yn = dy * rsqrtf(var + 64e-5f) * lg + lb; const size_t o = (size_t)(row0 + t0 + tt) * BW + h * 64 + lane;
                OB[o] = f2bf((yn + BON[o]) * G[o]);
            }
        }
#undef RW_STAGE
        float* op = (sq < PB ? outP + (((size_t)sq * 16 + h) * 64 + vrow) * 64 : outS + (((size_t)(sq - PB) * 16 + h) * 64 + vrow) * 64) + cg * 8;
#pragma unroll
        for (int j = 0; j < 8; ++j) op[j] = S[j];
        __syncthreads();
    }
}
constexpr int RS_SLOTS = 8, RS_SLOT_B = RB_EL * 2;
__device__ __forceinline__ void ph_rwkv_seq(const Ctx& c, int boff, const bf16_t* __restrict__ RB, const float* __restrict__ s0, float* __restrict__ outP, float* __restrict__ outS, bf16_t* __restrict__ OB) {
    const int lane = c.lane, r = lane & 15, q = lane >> 4, w = c.wave;
    LAS unsigned char* ring = c.lds;
    const int side = c.bid < 32 ? c.bid : c.bid - 64, nside = c.G - 64;
    for (int u = (c.bid >= boff && c.bid < boff + 32) ? c.bid - boff : ((c.bid < 32 || c.bid >= 96) ? 32 + side : (PB + SB) * 16); u < (PB + SB) * 16; u = u < 32 ? (PB + SB) * 16 : u + nside) {
        const int sq = u >> 4, h = u & 15;
        int nch, ch0, row0, ntok; const float* sp = nullptr; float* op;
        if (sq < PB) { nch = 256; ch0 = (sq * 16 + h) * 256; row0 = sq * PS; ntok = 16; op = outP + (size_t)(sq * 16 + h) * 4096; }
        else { nch = 1; ch0 = PB * 16 * 256 + (sq - PB) * 16 + h; row0 = MP + (sq - PB) * SS; ntok = SS; sp = s0 + (size_t)((sq - PB) * 16 + h) * 4096; op = outS + (size_t)((sq - PB) * 16 + h) * 4096; }
        if (w >= 4) {
            const int lw = w - 4, p0 = lw < 2 ? lw * 5 : 10 + (lw - 2) * 4, np = lw < 2 ? 5 : 4;
#define RS_ISSUE(ci_) do { const int cc_ = (ci_) < nch ? (ci_) : nch - 1; const char* g_ = (const char*)(RB + (size_t)(ch0 + cc_) * RB_EL) + p0 * 1024 + lane * 16; \
            LAS unsigned char* d_ = ring + ((ci_) % RS_SLOTS) * RS_SLOT_B + p0 * 1024; \
            _Pragma("unroll") for (int p_ = 0; p_ < 5; ++p_) if (p_ < np) __builtin_amdgcn_global_load_lds((const unsigned*)(g_ + p_ * 1024), (LAS unsigned*)(d_ + p_ * 1024), 16, 0, 0); } while (0)
            for (int ci = 0; ci < RS_SLOTS - 1; ++ci) RS_ISSUE(ci);
            if (lw < 2) asm volatile("s_waitcnt vmcnt(30)" ::: "memory"); else asm volatile("s_waitcnt vmcnt(24)" ::: "memory");
            __builtin_amdgcn_s_barrier();
            for (int ci = 0; ci < nch; ++ci) {
                RS_ISSUE(ci + RS_SLOTS - 1);
                if (lw < 2) asm volatile("s_waitcnt vmcnt(30)" ::: "memory"); else asm volatile("s_waitcnt vmcnt(24)" ::: "memory");
                __builtin_amdgcn_s_barrier();
            }
#undef RS_ISSUE
            asm volatile("s_waitcnt vmcnt(0)" ::: "memory");
        } else {
            const int vb = w; f32x4 acc[4];
#pragma unroll
            for (int kb = 0; kb < 4; ++kb) acc[kb] = sp ? *(const f32x4*)(sp + (size_t)(vb * 16 + r) * 64 + kb * 16 + q * 4) : (f32x4){0.f, 0.f, 0.f, 0.f};
            const bf16x8 zfrag = (bf16x8){0, 0, 0, 0, 0, 0, 0, 0};
            __builtin_amdgcn_s_barrier();
            for (int ci = 0; ci < nch; ++ci) {
                const LAS bf16_t* blob = (const LAS bf16_t*)(ring + (ci % RS_SLOTS) * RS_SLOT_B);
                bf16x8 mf[4][2], khf[4], qpf[2];
#pragma unroll
                for (int kb = 0; kb < 4; ++kb) { mf[kb][0] = *(const LAS bf16x8*)(blob + (kb * 16 + r) * 72 + q * 8); mf[kb][1] = *(const LAS bf16x8*)(blob + (kb * 16 + r) * 72 + 32 + q * 8);
                    khf[kb] = q < 2 ? *(const LAS bf16x8*)(blob + RB_KHP + (kb * 16 + r) * 24 + q * 8) : zfrag; }
                qpf[0] = *(const LAS bf16x8*)(blob + RB_QP + r * 72 + q * 8); qpf[1] = *(const LAS bf16x8*)(blob + RB_QP + r * 72 + 32 + q * 8);
                const bf16x8 vt = q < 2 ? *(const LAS bf16x8*)(blob + RB_VT + (vb * 16 + r) * 24 + q * 8) : zfrag;
                const bf16x8 ep = q < 2 ? *(const LAS bf16x8*)(blob + RB_EP + r * 24 + q * 8) : zfrag;
                const bf16x8 t0 = pack_acc(acc[0], acc[1]), t1 = pack_acc(acc[2], acc[3]);
                __builtin_amdgcn_sched_barrier(0);
#pragma unroll
                for (int kb = 0; kb < 4; ++kb) acc[kb] = mma16(mf[kb][0], t0, (f32x4){0.f, 0.f, 0.f, 0.f});
#pragma unroll
                for (int kb = 0; kb < 4; ++kb) acc[kb] = mma16(mf[kb][1], t1, acc[kb]);
#pragma unroll
                for (int kb = 0; kb < 4; ++kb) acc[kb] = mma16(khf[kb], vt, acc[kb]);
                f32x4 y = mma16(t0, qpf[0], (f32x4){0.f, 0.f, 0.f, 0.f}); y = mma16(t1, qpf[1], y); y = mma16(vt, ep, y);
                if (r < ntok) { u32x2 o; o.x = pk2(y[0], y[1]); o.y = pk2(y[2], y[3]); *(u32x2*)(OB + (size_t)(row0 + ci * 16 + r) * BW + h * 64 + vb * 16 + q * 4) = o; }
                asm volatile("s_waitcnt lgkmcnt(0)" ::: "memory");
                __builtin_amdgcn_s_barrier();
            }
#pragma unroll
            for (int kb = 0; kb < 4; ++kb) *(f32x4*)(op + (size_t)(vb * 16 + r) * 64 + kb * 16 + q * 4) = acc[kb];
        }
        __syncthreads();
    }
}
__device__ __forceinline__ void ph_rwkv_fin(const Ctx& c, const float* __restrict__ RW, const float* __restrict__ lng, const float* __restrict__ lnb, const bf16_t* __restrict__ RAW, bf16_t* __restrict__ OB) {
    const int lane = c.lane; const bf16_t* G = (const bf16_t*)(RW + 6 * (size_t)MPAD * BW); const bf16_t* BON = (const bf16_t*)(RW + 7 * (size_t)MPAD * BW);
    for (int i = c.bid * 8 + c.wave; i < MT * 4; i += c.G * 8) {
        const int row = i >> 2, cc = (i & 3) * 256 + lane * 4; const size_t o = (size_t)row * BW + cc; bf16_t* p = OB + o;
        const u32x2 raw = *(const u32x2*)(RAW + o); float x[4] = {__uint_as_float(raw.x << 16), __uint_as_float(raw.x & 0xffff0000u), __uint_as_float(raw.y << 16), __uint_as_float(raw.y & 0xffff0000u)};
        float s = (x[0] + x[1]) + (x[2] + x[3]); s += __shfl_xor(s, 1, 64); s += __shfl_xor(s, 2, 64); s += __shfl_xor(s, 4, 64); s += __shfl_xor(s, 8, 64);
        const float mean = s * (1.0f / 64.0f); float qq = 0.f;
#pragma unroll
        for (int j = 0; j < 4; ++j) { const float d = x[j] - mean; qq += d * d; }
        qq += __shfl_xor(qq, 1, 64); qq += __shfl_xor(qq, 2, 64); qq += __shfl_xor(qq, 4, 64); qq += __shfl_xor(qq, 8, 64);
        const float rstd = rsqrtf(qq * (1.0f / 64.0f) + 64e-5f);
        const f32x4 gg = *(const f32x4*)(lng + cc), bb = *(const f32x4*)(lnb + cc), bo = ld4bf(BON + o), gt = ld4bf(G + o); float ov[4];
#pragma unroll
        for (int j = 0; j < 4; ++j) ov[j] = ((x[j] - mean) * rstd * gg[j] + bb[j] + bo[j]) * gt[j];
        u32x2 oo; oo.x = pk2(ov[0], ov[1]); oo.y = pk2(ov[2], ov[3]); *(u32x2*)p = oo;
    }
}

__device__ __forceinline__ void ph_memattn_sample(const Ctx& c, int boff, const bf16_t* __restrict__ U, const float* __restrict__ mk, const float* __restrict__ mv, bf16_t* __restrict__ OB) {
    LAS float* ps = (LAS float*)c.lds;
    const int hh = c.tid >> 8, vt = c.tid & 255, lane = c.lane, r = lane & 15, q = lane >> 4, w4 = c.wave & 3;
    for (int u = (c.bid - boff + c.G) % c.G; u < SB * 2; u += c.G) {
        const int sq = u >> 1, h = (u & 1) * 2 + hh;
        bf16x8 qf[8];
#pragma unroll
        for (int ks = 0; ks < 8; ++ks) { u32x4 raw = (u32x4){0u, 0u, 0u, 0u};
            if (r < 4) raw = *(const u32x4*)(U + (size_t)(MP + sq * SS + r) * NINP + U_MQ + h * 256 + ks * 32 + q * 8);
            qf[ks] = __builtin_bit_cast(bf16x8, raw); }
#pragma unroll 1
        for (int mt = 0; mt < 4; ++mt) { const float* kr = mk + (((size_t)sq * MEMT + (w4 * 4 + mt) * 16 + r) * 4 + h) * 256 + q * 8; f32x4 ka[8], kb2[8];
#pragma unroll
            for (int ks = 0; ks < 8; ++ks) { ka[ks] = *(const f32x4*)(kr + ks * 32); kb2[ks] = *(const f32x4*)(kr + ks * 32 + 4); }
            __builtin_amdgcn_sched_barrier(0);
            f32x4 d = (f32x4){0.f, 0.f, 0.f, 0.f};
#pragma unroll
            for (int ks = 0; ks < 8; ++ks) { u32x4 p; p.x = pk2(ka[ks][0], ka[ks][1]); p.y = pk2(ka[ks][2], ka[ks][3]); p.z = pk2(kb2[ks][0], kb2[ks][1]); p.w = pk2(kb2[ks][2], kb2[ks][3]);
                d = mma16(__builtin_bit_cast(bf16x8, p), qf[ks], d); }
            if (r < 4) *(LAS f32x4*)(ps + (hh * 4 + r) * 256 + (w4 * 4 + mt) * 16 + q * 4) = d * 0.0625f; }
        __syncthreads();
        { LAS float* pr = ps + c.wave * 256; float x[4]; float mx = -3.0e38f;
#pragma unroll
            for (int j = 0; j < 4; ++j) { x[j] = pr[lane + 64 * j]; mx = fmaxf(mx, x[j]); }
            mx = wave_max(mx); float s = 0.f;
#pragma unroll
            for (int j = 0; j < 4; ++j) { x[j] = __expf(x[j] - mx); s += x[j]; }
            const float inv = 1.0f / wave_sum(s);
#pragma unroll
            for (int j = 0; j < 4; ++j) pr[lane + 64 * j] = x[j] * inv; }
        __syncthreads();
        { float o[4] = {0.f, 0.f, 0.f, 0.f}; const float* vr = mv + ((size_t)sq * MEMT * 4 + h) * 256 + vt;
#pragma unroll 8
            for (int m = 0; m < MEMT; ++m) { const float vv = vr[(size_t)m * 1024];
#pragma unroll
                for (int t = 0; t < 4; ++t) o[t] += ps[(hh * 4 + t) * 256 + m] * vv; }
#pragma unroll
            for (int t = 0; t < 4; ++t) OB[(size_t)(MP + sq * SS + t) * BW + h * 256 + vt] = f2bf(o[t]); }
        __syncthreads();
    }
}

template <int K, int LDA, int LDB> __device__ __forceinline__ void skinny_pair(const Ctx& c, const bf16_t* __restrict__ A, const bf16_t* __restrict__ B0, const bf16_t* __restrict__ B1, f32x4 (&out)[2], int rot) {
    LAS f32x4* red = (LAS f32x4*)c.lds;
    const int lane = c.lane, r = lane & 15, q = lane >> 4, w = c.wave;
    constexpr int KS = K / 8;
    const bf16_t* ap = A + (size_t)r * LDA + w * KS + q * 8; const bf16_t* b0 = B0 + (size_t)r * LDB + w * KS + q * 8; const bf16_t* b1 = B1 + (size_t)r * LDB + w * KS + q * 8;
    f32x4 acc[2][8];
#pragma unroll
    for (int n = 0; n < 2; ++n)
#pragma unroll
        for (int m = 0; m < 8; ++m) acc[n][m] = (f32x4){0.f, 0.f, 0.f, 0.f};
    int kk = (int)((unsigned)rot % (unsigned)(KS / 32));
#pragma unroll 2
    for (int it = 0; it < KS / 32; ++it) { const int ks = kk; kk = kk + 1 == KS / 32 ? 0 : kk + 1;
        const bf16x8 f0 = *(const bf16x8*)(b0 + ks * 32), f1 = *(const bf16x8*)(b1 + ks * 32); bf16x8 af[8];
#pragma unroll
        for (int m = 0; m < 8; ++m) af[m] = *(const bf16x8*)(ap + (size_t)(m * 16) * LDA + ks * 32);
        __builtin_amdgcn_sched_barrier(0);
#pragma unroll
        for (int m = 0; m < 8; ++m) { acc[0][m] = mma16(f0, af[m], acc[0][m]); acc[1][m] = mma16(f1, af[m], acc[1][m]); } }
    __syncthreads();
#pragma unroll
    for (int n = 0; n < 2; ++n)
#pragma unroll
        for (int m = 0; m < 8; ++m) red[(w * 16 + n * 8 + m) * 64 + lane] = acc[n][m];
    __syncthreads();
#pragma unroll
    for (int n = 0; n < 2; ++n) { f32x4 s = red[(n * 8 + w) * 64 + lane];
#pragma unroll
        for (int ww = 1; ww < 8; ++ww) s += red[(ww * 16 + n * 8 + w) * 64 + lane];
        out[n] = s; }
}
template <int K, int LDA, int LDB> __device__ __forceinline__ f32x4 skinny_one(const Ctx& c, const bf16_t* __restrict__ A, const bf16_t* __restrict__ B0, int rot) {
    LAS f32x4* red = (LAS f32x4*)c.lds;
    const int lane = c.lane, r = lane & 15, q = lane >> 4, w = c.wave;
    constexpr int KS = K / 8, NK = KS / 32;
    const bf16_t* ap = A + (size_t)r * LDA + w * KS + q * 8; const bf16_t* b0 = B0 + (size_t)r * LDB + w * KS + q * 8;
    f32x4 acc[8];
#pragma unroll
    for (int m = 0; m < 8; ++m) acc[m] = (f32x4){0.f, 0.f, 0.f, 0.f};
    int kk = (int)((unsigned)rot % (unsigned)NK);
#pragma unroll 4
    for (int it = 0; it < NK; ++it) { const int ks = kk; kk = kk + 1 == NK ? 0 : kk + 1;
        const bf16x8 f0 = *(const bf16x8*)(b0 + ks * 32); bf16x8 af[8];
#pragma unroll
        for (int m = 0; m < 8; ++m) af[m] = *(const bf16x8*)(ap + (size_t)(m * 16) * LDA + ks * 32);
        __builtin_amdgcn_sched_barrier(0);
#pragma unroll
        for (int m = 0; m < 8; ++m) acc[m] = mma16(f0, af[m], acc[m]); }
    __syncthreads();
#pragma unroll
    for (int m = 0; m < 8; ++m) red[(w * 8 + m) * 64 + lane] = acc[m];
    __syncthreads();
    f32x4 s = red[w * 64 + lane];
#pragma unroll
    for (int ww = 1; ww < 8; ++ww) s += red[(ww * 8 + w) * 64 + lane];
    return s;
}
__device__ __forceinline__ u32x2 pk4(const f32x4 v) { u32x2 o; o.x = pk2(v[0], v[1]); o.y = pk2(v[2], v[3]); return o; }
#define SKINNY_LOOP(total_) for (int s = c.bid - base; s >= 0 && s < (total_); s += ncu)
__device__ __forceinline__ void ph_sk_in(const Ctx& c, int base, int ncu, const bf16_t* __restrict__ HB, const bf16_t* __restrict__ W, bf16_t* __restrict__ U) {
    const int r = c.lane & 15, q = c.lane >> 4, w = c.wave;
    SKINNY_LOOP(NINP / 32) { f32x4 o[2]; skinny_pair<DM, DM, DM>(c, HB + (size_t)MP * DM, W + (size_t)(s * 32) * DM, W + (size_t)(s * 32 + 16) * DM, o, s);
        bf16_t* up = U + (size_t)(MP + w * 16 + r) * NINP + s * 32 + q * 4; *(u32x2*)up = pk4(o[0]); *(u32x2*)(up + 16) = pk4(o[1]); }
}
__device__ __forceinline__ void ph_sk_merge(const Ctx& c, int base, int ncu, const bf16_t* __restrict__ BR, const bf16_t* __restrict__ W, const bf16_t* __restrict__ U, const float* __restrict__ gate_b, bf16_t* __restrict__ MGB) {
    const int r = c.lane & 15, q = c.lane >> 4, w = c.wave;
    SKINNY_LOOP(DM / 16) { const size_t row = (size_t)(MP + w * 16 + r); const int col = s * 16 + q * 4; f32x4 tot = (f32x4){0.f, 0.f, 0.f, 0.f};
#pragma unroll 1
        for (int z = 0; z < 4; ++z) { const f32x4 o = skinny_one<BW, BW, BW>(c, BR + ((size_t)z * MPAD + MP) * BW, W + ((size_t)z * DM + s * 16) * BW, s + z);
            const u32x2 gp = *(const u32x2*)(U + row * NINP + U_GP + z * DM + col); const f32x4 gb = *(const f32x4*)(gate_b + z * DM + col);
            tot[0] += sigmoidf_(__uint_as_float(gp.x << 16) + gb[0]) * o[0]; tot[1] += sigmoidf_(__uint_as_float(gp.x & 0xffff0000u) + gb[1]) * o[1];
            tot[2] += sigmoidf_(__uint_as_float(gp.y << 16) + gb[2]) * o[2]; tot[3] += sigmoidf_(__uint_as_float(gp.y & 0xffff0000u) + gb[3]) * o[3]; }
        *(u32x2*)(MGB + row * DM + col) = pk4(tot); }
}
template <int K> __device__ __forceinline__ void ph_sk_res(const Ctx& c, int base, int ncu, const bf16_t* __restrict__ A, const bf16_t* __restrict__ W, const bf16_t* __restrict__ R, bf16_t* __restrict__ Y) {
    const int r = c.lane & 15, q = c.lane >> 4, w = c.wave;
    SKINNY_LOOP(DM / 16) { const f32x4 o = skinny_one<K, K, K>(c, A + (size_t)MP * K, W + (size_t)(s * 16) * K, s);
        const size_t off = (size_t)(MP + w * 16 + r) * DM + s * 16 + q * 4; const u32x2 rr = *(const u32x2*)(R + off);
        const f32x4 rv = (f32x4){__uint_as_float(rr.x << 16), __uint_as_float(rr.x & 0xffff0000u), __uint_as_float(rr.y << 16), __uint_as_float(rr.y & 0xffff0000u)};
        *(u32x2*)(Y + off) = pk4(rv * ALPHA + o); }
}
__device__ __forceinline__ void ph_sk_gu(const Ctx& c, int base, int ncu, const bf16_t* __restrict__ X1B, const bf16_t* __restrict__ W, bf16_t* __restrict__ ACT) {
    const int r = c.lane & 15, q = c.lane >> 4, w = c.wave;
    SKINNY_LOOP(DFF / 16) { const int t = s >> 3, j0 = (s & 7) * 16; f32x4 o[2];
        skinny_pair<DM, DM, DM>(c, X1B + (size_t)MP * DM, W + (size_t)(t * 256 + j0) * DM, W + (size_t)(t * 256 + 128 + j0) * DM, o, s);
        f32x4 v;
#pragma unroll
        for (int j = 0; j < 4; ++j) v[j] = o[0][j] * sigmoidf_(o[0][j]) * o[1][j];
        *(u32x2*)(ACT + (size_t)(MP + w * 16 + r) * DFF + t * 128 + j0 + q * 4) = pk4(v); }
}
#undef SKINNY_LOOP

constexpr int LDS_BAR_OFF = 147456;
constexpr int LDS_BYTES = LDS_BAR_OFF + 64;
struct Args { const float* in[37]; float* out; unsigned char* ws; };

typedef pg8::Gemm<DM, DM, DM, 2, 8, NL, 1, false, 0, 0, (long)DM * DM, 0> GemmMem;
typedef pg8::Gemm<DM, DM, DM, MP / 256, NINP / 256> GemmIn;
typedef pg8::Gemm<NINP, 1024, 256, PS / 256, 1, 8, 4, false, (long)PS * NINP, 256, 256 * 1024, 256> GemmScore;
typedef pg8::Gemm<256, 256, 256, PS / 256, 1, 8, 4, false, (long)4 * 4096 * 256, (long)4096 * 256, 4 * 65536, 65536> GemmPV;
typedef pg8::Gemm<BW, BW, BW, MP / 256, DM / 256, 4, 1, true, (long)MPAD * BW, 0, (long)DM * BW, 0> GemmBranch;
typedef pg8::Gemm<DM, DM, DM, MP / 256, DM / 256> GemmOut;
typedef pg8::Gemm<DM, DM, DM, MP / 256, 2 * DFF / 256> GemmGU;
typedef pg8::Gemm<DFF, DFF, DFF, MP / 256, DM / 256> GemmDown;
template <class GT> __device__ __forceinline__ GT mk_gemm(const Ctx& c, const bf16_t* A, const bf16_t* B) { GT g; g.A = A; g.B = B; g.G = c.G; g.c = c.bid; return g; }

template <int OFF> __device__ __forceinline__ unsigned long long karg_u64(unsigned long long kargs) {
    unsigned long long p; asm volatile("s_load_dwordx2 %0, %1, %2\n\ts_waitcnt lgkmcnt(0)" : "=s"(p) : "s"(kargs), "n"(OFF) : "memory"); return p;
}
#define GPTR(T, x) ((T*)(__attribute__((address_space(1))) T*)(x))
#define INP(k) GPTR(const float, karg_u64<(k) * 8>(kargs))
#define OUTP() GPTR(float, karg_u64<37 * 8>(kargs))
#define WSP() GPTR(unsigned char, karg_u64<38 * 8>(kargs))

__global__ void __launch_bounds__(512, 2) mega_fwd(Args a_unused) {
    extern __shared__ __attribute__((aligned(16))) unsigned char lds_raw[];
    const unsigned long long kargs = (unsigned long long)__builtin_amdgcn_kernarg_segment_ptr();
    Ctx c0; c0.tid = threadIdx.x; c0.lane = c0.tid & 63; c0.wave = __builtin_amdgcn_readfirstlane(c0.tid >> 6); c0.bid = blockIdx.x; c0.G = gridDim.x; c0.lds = (LAS unsigned char*)lds_raw;
    if (c0.tid < 4) ((LAS unsigned*)(c0.lds + LDS_BAR_OFF))[c0.tid] = 0u;
    __syncthreads();
    const XcdBarrier bar = xcd_barrier_post((unsigned*)(WSP() + WS_CTL), (volatile LAS unsigned*)(c0.lds + LDS_BAR_OFF));

#define WPREP_LAYER(cc_, L_) do { unsigned char* ws_ = WSP(); \
      ph_wprep(cc_, INP(10) + (size_t)(L_) * DM * NIN, (bf16_t*)(ws_ + WS_WIN) + (size_t)(L_) * NINP * DM, DM, NIN, NINP, 1, 1, 0, 0); \
      ph_wprep(cc_, INP(29) + (size_t)(L_) * 4 * BW * DM, (bf16_t*)(ws_ + WS_WBR) + (size_t)(L_) * 4 * DM * BW, BW, DM, DM, 0, 4, (size_t)BW * DM, (size_t)DM * BW); \
      ph_wprep(cc_, INP(30) + (size_t)(L_) * DM * DM, (bf16_t*)(ws_ + WS_WOUT) + (size_t)(L_) * DM * DM, DM, DM, DM, 0, 1, 0, 0); \
      ph_wprep(cc_, INP(33) + (size_t)(L_) * DM * 2 * DFF, (bf16_t*)(ws_ + WS_WGU) + (size_t)(L_) * 2 * DFF * DM, DM, 2 * DFF, 2 * DFF, 2, 1, 0, 0); \
      ph_wprep(cc_, INP(34) + (size_t)(L_) * DFF * DM, (bf16_t*)(ws_ + WS_WDN) + (size_t)(L_) * DM * DFF, DFF, DM, DM, 0, 1, 0, 0); } while (0)
    { const Ctx c = fresh(c0); unsigned char* ws = WSP();
      ph_wprep(c, INP(28), (bf16_t*)(ws + WS_WMEM), DM, DM, DM, 0, NL, (size_t)DM * DM, (size_t)DM * DM);
      WPREP_LAYER(c, 0);
      ph_lrw(c, INP(19), INP(21), INP(22), (bf16_t*)(ws + WS_LRW));
      ph_xprep(c, INP(0), INP(1), INP(2), (float*)nullptr, (bf16_t*)(ws + WS_HB), (bf16_t*)(ws + WS_MEMB)); }
    xcd_barrier(bar);
    { const Ctx c = fresh(c0); unsigned char* ws = WSP(); float* out = OUTP();
      GemmMem g = mk_gemm<GemmMem>(c, (const bf16_t*)(ws + WS_MEMB), (const bf16_t*)(ws + WS_WMEM));
      pg8::EpiMem E; E.outK = out + O_MKP; E.outV = out + O_MVP; E.kb = (bf16_t*)(ws + WS_MKB); E.vt = (bf16_t*)(ws + WS_MVT); pg8::gemm_phase<GemmMem, pg8::EpiMem, true, true>(c.lds, c.tid, g, E); }

    for (int l = 0; l < NL; ++l) {
        { const Ctx c = fresh(c0); unsigned char* ws = WSP();
          GemmIn g = mk_gemm<GemmIn>(c, (const bf16_t*)(ws + WS_HB), (const bf16_t*)(ws + WS_WIN) + (size_t)l * NINP * DM);
          pg8::EpiBf16 E; E.O = (bf16_t*)(ws + WS_U); E.zs = 0; E.ldc = NINP; E.pad = 0; pg8::gemm_phase<GemmIn, pg8::EpiBf16, true, true>(c.lds, c.tid, g, E); }
        { const Ctx c = fresh(c0); unsigned char* ws = WSP(); ph_sk_in(c, c.G > 192 ? 96 : 0, c.G > 192 ? c.G - 96 : c.G, (const bf16_t*)(ws + WS_HB), (const bf16_t*)(ws + WS_WIN) + (size_t)l * NINP * DM, (bf16_t*)(ws + WS_U)); }
        xcd_barrier(bar);
        { const Ctx c = fresh(c0); unsigned char* ws = WSP(); float* out = OUTP(); const bf16_t* U = (const bf16_t*)(ws + WS_U); bf16_t* BR = (bf16_t*)(ws + WS_BR);
          (void)out; (void)BR;
          ph_gla_pre(c, U, INP(12) + (size_t)l * 16 * 512, INP(13) + (size_t)l * 512, (bf16_t*)(ws + WS_GLQD), (bf16_t*)(ws + WS_GLKH), (bf16_t*)(ws + WS_GLE), (bf16_t*)(ws + WS_GLVT), (float*)(ws + WS_GLGC)); }
        { const Ctx c = fresh(c0); unsigned char* ws = WSP();
          ph_rwkv_pre(c, (const bf16_t*)(ws + WS_U), INP(9) + (size_t)l * SB * RWC, INP(17) + (size_t)l * RWC, INP(18) + (size_t)l * BW, INP(19) + (size_t)l * 64 * BW, INP(20) + (size_t)l * BW, INP(21) + (size_t)l * 64 * BW,
                       INP(22) + (size_t)l * 128 * BW, INP(23) + (size_t)l * BW, INP(24) + (size_t)l * BW, INP(25) + (size_t)l * BW, (float*)(ws + WS_RW), (bf16_t*)(ws + WS_RB), (const bf16_t*)(ws + WS_LRW) + (size_t)l * 1024 * 256); }
        { const Ctx c = fresh(c0); unsigned char* ws = WSP(); ph_memattn_prompt(c, (const bf16_t*)(ws + WS_U), (const bf16_t*)(ws + WS_MKB) + (size_t)l * 512 * 1024, (const bf16_t*)(ws + WS_MVT) + (size_t)l * 8 * 65536, (bf16_t*)(ws + WS_BR) + (size_t)3 * MPAD * BW); }
        xcd_barrier(bar);
        { const Ctx c = fresh(c0); unsigned char* ws = WSP(); float* out = OUTP();
          ph_rwkv_seq(c, 64, (const bf16_t*)(ws + WS_RB), INP(8) + (size_t)l * SB * 16 * 4096, out + O_RWP + (size_t)l * PB * 16 * 4096, out + O_RWS + (size_t)l * SB * 16 * 4096,
                      (bf16_t*)(ws + WS_RAW) + (size_t)MPAD * BW); }
        { const Ctx c = fresh(c0); unsigned char* ws = WSP(); float* out = OUTP();
          ph_gla_seq(c, 32, (const bf16_t*)(ws + WS_GLQD), (const bf16_t*)(ws + WS_GLKH), (const bf16_t*)(ws + WS_GLE), (const bf16_t*)(ws + WS_GLVT), (const float*)(ws + WS_GLGC),
                     INP(7) + (size_t)l * SB * 4 * 32768, out + O_GLAP + (size_t)l * PB * 4 * 32768, out + O_GLAS + (size_t)l * SB * 4 * 32768, (bf16_t*)(ws + WS_RAW)); }
        if ((c0.bid < 32 || c0.bid >= 96) && c0.G > 96) {
        { Ctx c = fresh(c0); c.bid = c.bid < 32 ? c.bid : c.bid - 64; c.G = c.G - 64; unsigned char* ws = WSP(); ph_swa_prompt(c, (const bf16_t*)(ws + WS_U), INP(16) + (size_t)l * 16, (bf16_t*)(ws + WS_BR) + (size_t)MPAD * BW); }
        { Ctx c = fresh(c0); c.bid = c.bid < 32 ? c.bid : c.bid - 64; c.G = c.G - 64; unsigned char* ws = WSP();
          ph_swa_sample(c, (const bf16_t*)(ws + WS_U), INP(3) + (size_t)l * SB * 16384, INP(4) + (size_t)l * SB * 16384, INP(16) + (size_t)l * 16, (bf16_t*)(ws + WS_BR) + (size_t)MPAD * BW); }
        { Ctx c = fresh(c0); c.bid = c.bid < 32 ? c.bid : c.bid - 64; c.G = c.G - 64; unsigned char* ws = WSP();
          ph_memattn_sample(c, 64, (const bf16_t*)(ws + WS_U), INP(5) + (size_t)l * SB * MEMT * 1024, INP(6) + (size_t)l * SB * MEMT * 1024, (bf16_t*)(ws + WS_BR) + (size_t)3 * MPAD * BW); }
        { Ctx c = fresh(c0); c.bid = c.bid < 32 ? c.bid : c.bid - 64; c.G = c.G - 64; unsigned char* ws = WSP();
          ph_copy_outs(c, (const bf16_t*)(ws + WS_U), INP(3) + (size_t)l * SB * 16384, INP(4) + (size_t)l * SB * 16384, OUTP(), l); }
          if (l + 1 < NL) { Ctx c = fresh(c0); const int sd = c.bid < 32 ? c.bid : c.bid - 64; c.G = 2 * (c.G - 64) + 96;
            c.bid = 2 * sd; WPREP_LAYER(c, l + 1); c.bid = 2 * sd + 1; WPREP_LAYER(c, l + 1); }
        } else if (l + 1 < NL && c0.G > 96) { Ctx c = fresh(c0); const int nside2 = 2 * (c.G - 64); c.G = nside2 + 96;
          if (c0.bid < 64) { c.bid = nside2 + 2 * (c0.bid - 32); WPREP_LAYER(c, l + 1); c.bid = nside2 + 2 * (c0.bid - 32) + 1; WPREP_LAYER(c, l + 1); }
          else { c.bid = nside2 + 64 + (c0.bid - 64); WPREP_LAYER(c, l + 1); }
        }
        xcd_barrier(bar);
        { const Ctx c = fresh(c0); unsigned char* ws = WSP(); ph_rwkv_fin(c, (const float*)(ws + WS_RW), INP(26) + (size_t)l * BW, INP(27) + (size_t)l * BW, (const bf16_t*)(ws + WS_RAW) + (size_t)MPAD * BW, (bf16_t*)(ws + WS_BR) + (size_t)2 * MPAD * BW); }
        { const Ctx c = fresh(c0); unsigned char* ws = WSP(); ph_gla_fin(c, (const bf16_t*)(ws + WS_U), INP(14) + (size_t)l * BW, INP(15) + (size_t)l * BW, (const bf16_t*)(ws + WS_RAW), (bf16_t*)(ws + WS_BR)); }
        xcd_barrier(bar);
        { const Ctx c = fresh(c0); unsigned char* ws = WSP();
          GemmBranch g = mk_gemm<GemmBranch>(c, (const bf16_t*)(ws + WS_BR), (const bf16_t*)(ws + WS_WBR) + (size_t)l * 4 * DM * BW);
          pg8::EpiMerge E; E.MG = (float*)(ws + WS_MG); E.MGB = (bf16_t*)(ws + WS_MGB); E.U = (const bf16_t*)(ws + WS_U); E.gate_b = INP(11) + (size_t)l * 4 * DM; pg8::gemm_phase<GemmBranch, pg8::EpiMerge, true, true>(c.lds, c.tid, g, E); }
        { const Ctx c = fresh(c0); unsigned char* ws = WSP(); ph_sk_merge(c, 0, c.G, (const bf16_t*)(ws + WS_BR), (const bf16_t*)(ws + WS_WBR) + (size_t)l * 4 * DM * BW, (const bf16_t*)(ws + WS_U), INP(11) + (size_t)l * 4 * DM, (bf16_t*)(ws + WS_MGB)); }
        xcd_barrier(bar);
        { const Ctx c = fresh(c0); unsigned char* ws = WSP();
          GemmOut g = mk_gemm<GemmOut>(c, (const bf16_t*)(ws + WS_MGB), (const bf16_t*)(ws + WS_WOUT) + (size_t)l * DM * DM);
          pg8::EpiRes E; E.R = (const bf16_t*)(ws + WS_HB); E.Y = (bf16_t*)(ws + WS_Y); pg8::gemm_phase<GemmOut, pg8::EpiRes, true, true>(c.lds, c.tid, g, E); }
        { const Ctx c = fresh(c0); unsigned char* ws = WSP(); ph_sk_res<DM>(c, c.G > 192 ? 128 : 0, c.G > 192 ? c.G - 128 : c.G, (const bf16_t*)(ws + WS_MGB), (const bf16_t*)(ws + WS_WOUT) + (size_t)l * DM * DM, (const bf16_t*)(ws + WS_HB), (bf16_t*)(ws + WS_Y)); }
        xcd_barrier(bar);
        { const Ctx c = fresh(c0); unsigned char* ws = WSP(); ph_ln(c, (const bf16_t*)(ws + WS_Y), INP(31) + (size_t)l * DM, INP(32) + (size_t)l * DM, (float*)nullptr, (bf16_t*)(ws + WS_X1B), nullptr, MT, 0); }
        xcd_barrier(bar);
        { const Ctx c = fresh(c0); unsigned char* ws = WSP();
          GemmGU g = mk_gemm<GemmGU>(c, (const bf16_t*)(ws + WS_X1B), (const bf16_t*)(ws + WS_WGU) + (size_t)l * 2 * DFF * DM);
          pg8::EpiSwiGLU E; E.O = (bf16_t*)(ws + WS_ACT); pg8::gemm_phase<GemmGU, pg8::EpiSwiGLU, true, true>(c.lds, c.tid, g, E); }
        { const Ctx c = fresh(c0); unsigned char* ws = WSP(); ph_sk_gu(c, c.G > 192 ? 128 : 0, c.G > 192 ? c.G - 128 : c.G, (const bf16_t*)(ws + WS_X1B), (const bf16_t*)(ws + WS_WGU) + (size_t)l * 2 * DFF * DM, (bf16_t*)(ws + WS_ACT)); }
        xcd_barrier(bar);
        { const Ctx c = fresh(c0); unsigned char* ws = WSP();
          GemmDown g = mk_gemm<GemmDown>(c, (const bf16_t*)(ws + WS_ACT), (const bf16_t*)(ws + WS_WDN) + (size_t)l * DM * DFF);
          pg8::EpiRes E; E.R = (const bf16_t*)(ws + WS_X1B); E.Y = (bf16_t*)(ws + WS_Y); pg8::gemm_phase<GemmDown, pg8::EpiRes, true, true>(c.lds, c.tid, g, E); }
        { const Ctx c = fresh(c0); unsigned char* ws = WSP(); ph_sk_res<DFF>(c, 0, c.G, (const bf16_t*)(ws + WS_ACT), (const bf16_t*)(ws + WS_WDN) + (size_t)l * DM * DFF, (const bf16_t*)(ws + WS_X1B), (bf16_t*)(ws + WS_Y)); }
        xcd_barrier(bar);
        { const Ctx c = fresh(c0); unsigned char* ws = WSP(); float* out = OUTP(); ph_ln(c, (const bf16_t*)(ws + WS_Y), INP(35) + (size_t)l * DM, INP(36) + (size_t)l * DM, (float*)nullptr, (bf16_t*)(ws + WS_HB), l == NL - 1 ? out : nullptr, MT, MT); }
        xcd_barrier(bar);
    }
}

extern "C" void kernel_launch(void* const* d_in, const int* in_sizes, int n_in, void* d_out, int out_size, void* d_ws, size_t ws_size, hipStream_t stream) {
    static int grid = 0;
    if (grid == 0) {
        if (n_in != 37 || (size_t)out_size != O_END || ws_size < WS_END) { fprintf(stderr, "kernel_launch: unexpected sizes (n_in %d out %d ws %zu need %zu)\n", n_in, out_size, ws_size, (size_t)WS_END); grid = -1; return; }
        int dev = 0, cus = 0;
        if (hipGetDevice(&dev) != hipSuccess || hipDeviceGetAttribute(&cus, hipDeviceAttributeMultiprocessorCount, dev) != hipSuccess) { grid = -1; return; }
        if (hipFuncSetAttribute((const void*)mega_fwd, hipFuncAttributeMaxDynamicSharedMemorySize, LDS_BYTES) != hipSuccess) { fprintf(stderr, "kernel_launch: hipFuncSetAttribute failed\n"); grid = -1; return; }
        int per_cu = 0;
        if (hipOccupancyMaxActiveBlocksPerMultiprocessor(&per_cu, (const void*)mega_fwd, 512, LDS_BYTES) != hipSuccess || per_cu < 1) { fprintf(stderr, "kernel_launch: occupancy query says %d\n", per_cu); }
        (void)hipGetLastError();
        grid = cus;
    }
    if (grid < 0) return;
    (void)hipMemsetAsync((unsigned char*)d_ws + WS_CTL, 0, XCD_BAR_WORDS * sizeof(unsigned), stream);
    Args a; memset(&a, 0, sizeof a);
    for (int i = 0; i < 37; ++i) a.in[i] = (const float*)d_in[i];
    a.out = (float*)d_out; a.ws = (unsigned char*)d_ws;
    hipLaunchKernelGGL(mega_fwd, dim3(grid), dim3(512), LDS_BYTES, stream, a);
}
```

```cpp
#include <hip/hip_runtime.h>
#include <cstdio>
#include <cstdint>
#include <cstring>

#define LAS __attribute__((address_space(3)))
typedef unsigned short bf16_t;
typedef short bf16x8 __attribute__((ext_vector_type(8)));
typedef float f32x4 __attribute__((ext_vector_type(4)));
typedef float f32x2 __attribute__((ext_vector_type(2)));
typedef unsigned u32x4 __attribute__((ext_vector_type(4)));
typedef unsigned u32x2 __attribute__((ext_vector_type(2)));

constexpr int DM = 2048, NL = 4;
constexpr int PB = 2, PS = 4096, MP = PB * PS;
constexpr int SB = 32, SS = 4, MS = SB * SS;
constexpr int MT = MP + MS;
constexpr int MPAD = 8448;
constexpr int NIN = 16912, NINP = 17152;
constexpr int U_GQ = 0, U_GK = 512, U_GV = 1024, U_GR = 2048, U_GA = 3072, U_SQ = 3328, U_SK = 4352, U_SV = 4480, U_RU = 4608, U_MQ = 7936, U_GP = 8960;
constexpr int RWC = 3328, BW = 1024, DFF = 5632, MEMT = 256;
constexpr float ALPHA = 1.681792830507429f;

constexpr size_t O_YP = 0;
constexpr size_t O_YS = O_YP + (size_t)MP * DM;
constexpr size_t O_SWKP = O_YS + (size_t)MS * DM;
constexpr size_t O_SWVP = O_SWKP + (size_t)NL * PB * 128 * 128;
constexpr size_t O_MKP = O_SWVP + (size_t)NL * PB * 128 * 128;
constexpr size_t O_MVP = O_MKP + (size_t)NL * PB * 256 * 1024;
constexpr size_t O_GLAP = O_MVP + (size_t)NL * PB * 256 * 1024;
constexpr size_t O_RWP = O_GLAP + (size_t)NL * PB * 4 * 128 * 256;
constexpr size_t O_RSP = O_RWP + (size_t)NL * PB * 16 * 64 * 64;
constexpr size_t O_SWKS = O_RSP + (size_t)NL * PB * RWC;
constexpr size_t O_SWVS = O_SWKS + (size_t)NL * SB * 128 * 128;
constexpr size_t O_GLAS = O_SWVS + (size_t)NL * SB * 128 * 128;
constexpr size_t O_RWS = O_GLAS + (size_t)NL * SB * 4 * 128 * 256;
constexpr size_t O_RSS = O_RWS + (size_t)NL * SB * 16 * 64 * 64;
constexpr size_t O_END = O_RSS + (size_t)NL * SB * RWC;
static_assert(O_END == 52881408, "output size");

constexpr size_t al256(size_t x) { return (x + 255) & ~(size_t)255; }
constexpr size_t WS_CTL = 0;
constexpr size_t WS_WIN = 65536;
constexpr size_t WS_WMEM = WS_WIN + (size_t)NL * NINP * DM * 2;
constexpr size_t WS_WBR = WS_WMEM + (size_t)NL * DM * DM * 2;
constexpr size_t WS_WOUT = WS_WBR + (size_t)NL * 4 * DM * BW * 2;
constexpr size_t WS_WGU = WS_WOUT + (size_t)NL * DM * DM * 2;
constexpr size_t WS_WDN = WS_WGU + (size_t)NL * 2 * DFF * DM * 2;
constexpr size_t WS_HF = WS_WDN + (size_t)NL * DM * DFF * 2;
constexpr size_t WS_HB = WS_HF + (size_t)MPAD * DM * 4;
constexpr size_t WS_U = WS_HB + (size_t)MPAD * DM * 2;
constexpr size_t WS_BR = WS_U + (size_t)MPAD * NINP * 2;
constexpr size_t WS_MG = WS_BR + (size_t)4 * MPAD * BW * 2;
constexpr size_t WS_MGB = WS_MG + (size_t)MPAD * DM * 4;
constexpr size_t WS_Y = WS_MGB + (size_t)MPAD * DM * 2;
constexpr size_t WS_X1F = WS_Y + (size_t)MPAD * DM * 4;
constexpr size_t WS_X1B = WS_X1F + (size_t)MPAD * DM * 4;
constexpr size_t WS_ACT = WS_X1B + (size_t)MPAD * DM * 2;
constexpr size_t WS_MEMB = WS_ACT + (size_t)MPAD * DFF * 2;
constexpr size_t WS_MKB = WS_MEMB + (size_t)512 * DM * 2;
constexpr size_t WS_MVT = WS_MKB + (size_t)NL * 512 * 1024 * 2;
constexpr size_t WS_SC = WS_MVT + (size_t)NL * 8 * 256 * 256 * 2;
constexpr size_t WS_PB = WS_SC + (size_t)8 * 4096 * 256 * 4;
constexpr size_t WS_RW = WS_PB + (size_t)8 * 4096 * 256 * 2;
constexpr size_t RW_ARR = (size_t)MPAD * BW * 4;
constexpr int GL_NCH = 512 + 128;
constexpr size_t WS_GLQD = WS_RW + 8 * RW_ARR;
constexpr size_t WS_GLKH = WS_GLQD + (size_t)GL_NCH * 8192 * 2;
constexpr size_t WS_GLE = WS_GLKH + (size_t)GL_NCH * 8192 * 2;
constexpr size_t WS_GLVT = WS_GLE + (size_t)GL_NCH * 4096 * 2;
constexpr size_t WS_GLGC = WS_GLVT + (size_t)GL_NCH * 16384 * 2;
constexpr int RB_NCH = PB * 16 * 256 + SB * 16;
constexpr int RB_EL = 9216;
constexpr int RB_QP = 4608, RB_KHP = 5760, RB_VT = 7296, RB_EP = 8832;
constexpr size_t WS_RB = WS_GLGC + (size_t)GL_NCH * 128 * 4;
constexpr size_t WS_RAW = WS_RB + (size_t)RB_NCH * RB_EL * 2;
constexpr size_t WS_LRW = WS_RAW + (size_t)2 * MPAD * BW * 2;
constexpr size_t WS_END = WS_LRW + (size_t)NL * 16 * 64 * 256 * 2;

__device__ __forceinline__ float bf2f(bf16_t b) { return __uint_as_float(((unsigned)b) << 16); }
typedef __bf16 bf16v2_t __attribute__((ext_vector_type(2)));
__device__ __forceinline__ unsigned pk2(float lo, float hi) { const f32x2 v = {lo, hi}; return __builtin_bit_cast(unsigned, __builtin_convertvector(v, bf16v2_t)); }
__device__ __forceinline__ bf16_t f2bf(float f) { return (bf16_t)(pk2(f, 0.f) & 0xffffu); }
__device__ __forceinline__ f32x4 ld4bf(const bf16_t* p) { const u32x2 w = *(const u32x2*)p; return (f32x4){__uint_as_float(w.x << 16), __uint_as_float(w.x & 0xffff0000u), __uint_as_float(w.y << 16), __uint_as_float(w.y & 0xffff0000u)}; }
__device__ __forceinline__ float wave_sum(float v) {
#pragma unroll
    for (int o = 32; o > 0; o >>= 1) v += __shfl_xor(v, o, 64);
    return v;
}
__device__ __forceinline__ float wave_max(float v) {
#pragma unroll
    for (int o = 32; o > 0; o >>= 1) v = fmaxf(v, __shfl_xor(v, o, 64));
    return v;
}
__device__ __forceinline__ float sigmoidf_(float x) { return 1.0f / (1.0f + __expf(-x)); }
__device__ __forceinline__ void unpack8(const u32x4 w, float (&x)[8]) {
    x[0] = __uint_as_float(w.x << 16); x[1] = __uint_as_float(w.x & 0xffff0000u); x[2] = __uint_as_float(w.y << 16); x[3] = __uint_as_float(w.y & 0xffff0000u);
    x[4] = __uint_as_float(w.z << 16); x[5] = __uint_as_float(w.z & 0xffff0000u); x[6] = __uint_as_float(w.w << 16); x[7] = __uint_as_float(w.w & 0xffff0000u);
}
__device__ __forceinline__ float softplusf_(float x) { return fmaxf(x, 0.f) + log1pf(__expf(-fabsf(x))); }
__device__ __forceinline__ float softplus_fast(float x) { return fmaxf(x, 0.f) + __logf(1.0f + __expf(-fabsf(x))); }
__device__ __forceinline__ float tanh_fast(float x) { return 1.0f - 2.0f / (1.0f + __expf(2.0f * x)); }

namespace pg8 {
constexpr int BM = 256, BK = 64, HALF = 128, HTB = HALF * BK * 2, STAGE_BYTES = 8 * HTB, NXCD = 8, WGM = 8;
__host__ __device__ __forceinline__ int lds_byte(int r, int c) { const int st = (r >> 4) * 2 + (c >> 5), rr = r & 15, cc = c & 31, ob = rr * 64 + cc * 2; return st * 1024 + (ob ^ (((ob >> 9) & 1) << 5)); }
__host__ __device__ __forceinline__ void stage_rc(int b, int& R, int& C) { const int st = b / 1024, sb = b % 1024, swz = sb ^ (((sb >> 9) & 1) << 5); R = (st >> 1) * 16 + swz / 64; C = (st & 1) * 32 + (swz % 64) / 2; }
__host__ __device__ __forceinline__ int perm32(int rho) { const int n = rho >> 4, i = rho & 15; return 8 * (i >> 2) + 4 * n + (i & 3); }

struct Unit { int pm, pn, z; };
template <int LDA_, int LDB_, int K_, int NM_, int NN_, int NZ_ = 1, int NZH_ = 1, bool ZINNER_ = false, long ZSAB_ = 0, long ZSAH_ = 0, long ZSBB_ = 0, long ZSBH_ = 0>
struct Gemm {
    static constexpr int LDA = LDA_, LDB = LDB_, K = K_, NM = NM_, NN = NN_, NZ = NZ_, NZH = NZH_; static constexpr bool ZINNER = ZINNER_;
    const bf16_t* A; const bf16_t* B; int G, c;
    __device__ __forceinline__ bool next(int i, Unit& u) const {
        constexpr int nt = NM * NN; int L, z;
        if (ZINNER) { const int it = i / NZ; z = i - it * NZ; const long LL = (long)it * G + c; if (LL >= nt) return false; L = (int)LL; }
        else { const long LL = (long)i * G + c; if (LL >= (long)nt * NZ) return false; z = (int)(LL / nt); L = (int)(LL - (long)z * nt); }
        int wgid = L; { constexpr int q = nt / NXCD, r = nt % NXCD; const int xcd = wgid % NXCD, off = wgid / NXCD; wgid = (xcd < r ? xcd * (q + 1) : r * (q + 1) + (xcd - r) * q) + off; }
        constexpr int nig = WGM * NN; const int gid = wgid / nig, fm = gid * WGM, gsz = (NM - fm) < WGM ? (NM - fm) : WGM;
        u.pm = fm + ((wgid % nig) % gsz); u.pn = (wgid % nig) / gsz; u.z = z; return true;
    }
    __device__ __forceinline__ const char* a_base(const Unit& u) const { const int zb = u.z / NZH, zh = u.z - zb * NZH; return (const char*)(A + zb * ZSAB_ + zh * ZSAH_ + (long)u.pm * BM * LDA); }
    __device__ __forceinline__ const char* b_base(const Unit& u) const { const int zb = u.z / NZH, zh = u.z - zb * NZH; return (const char*)(B + zb * ZSBB_ + zh * ZSBH_ + (long)u.pn * BM * LDB); }
};

template <class GT, class Epi, bool ALIGN_EPI = true, bool SP2 = true>
__device__ __forceinline__ void gemm_phase(LAS unsigned char* lds, const int tid, const GT& g, const Epi& E) {
    const int wid = __builtin_amdgcn_readfirstlane(tid >> 6), lane = tid & 63, wr = wid >> 2, wc = wid & 3, fr = lane & 15, fq = lane >> 4;
    constexpr int nt = GT::K / BK;
    unsigned voffA[2], voffB[2];
#pragma unroll
    for (int i = 0; i < 2; ++i) { int R, C; stage_rc(tid * 16 + i * 8192, R, C); const int Rb = Epi::PERM ? ((R & ~31) + perm32(R & 31)) : R;
        voffA[i] = (unsigned)(R * GT::LDA + C) * 2u; voffB[i] = (unsigned)(Rb * GT::LDB + C) * 2u; }
    constexpr size_t kstep = (size_t)(BK * 2);
    constexpr size_t hstepA = (size_t)HALF * GT::LDA * 2, hstepB = (size_t)HALF * GT::LDB * 2;
    const unsigned ldsw = (unsigned)wid * 1024u;
    const int aoff = lds_byte(wr * 64 + fr, fq * 8), boff = lds_byte(wc * 32 + fr, fq * 8);
#define PG8_SA(b, h) (((b) * 2 + (h)) * HTB)
#define PG8_SB(b, h) ((4 + (b) * 2 + (h)) * HTB)
#define PG8_STAGE(bufoff, gbase, voff) do { _Pragma("unroll") for (int _i = 0; _i < 2; ++_i) \
        __builtin_amdgcn_global_load_lds((const unsigned*)((const char*)(gbase) + (voff)[_i]), (LAS unsigned*)(lds + (bufoff) + ldsw + _i * 8192), 16, 0, 0); } while (0)
#define PG8_LDA(dst, b, h) do { _Pragma("unroll") for (int m = 0; m < 4; ++m) _Pragma("unroll") for (int k = 0; k < 2; ++k) dst[m][k] = *(const LAS bf16x8*)(lds + PG8_SA(b, h) + aoff + m * 2048 + k * 1024); } while (0)
#define PG8_LDB(dst, b, h) do { _Pragma("unroll") for (int n = 0; n < 2; ++n) _Pragma("unroll") for (int k = 0; k < 2; ++k) dst[n][k] = *(const LAS bf16x8*)(lds + PG8_SB(b, h) + boff + n * 2048 + k * 1024); } while (0)
#define PG8_MMA(ai, bj, At, Bt) do { __builtin_amdgcn_s_setprio(1); _Pragma("unroll") for (int m = 0; m < 4; ++m) _Pragma("unroll") for (int n = 0; n < 2; ++n) _Pragma("unroll") for (int k = 0; k < 2; ++k) \
        acc[ai][bj][m][n] = __builtin_amdgcn_mfma_f32_16x16x32_bf16(Bt[n][k], At[m][k], acc[ai][bj][m][n], 0, 0, 0); __builtin_amdgcn_s_setprio(0); } while (0)
#define PG8_WAIT_V(n) asm volatile("s_waitcnt vmcnt(" #n ")" ::: "memory")
#define PG8_WAIT_L(n) asm volatile("s_waitcnt lgkmcnt(" #n ")" ::: "memory")
#define PG8_BAR __builtin_amdgcn_s_barrier()
#define PG8_SCHED __builtin_amdgcn_sched_barrier(0)
    Unit cur, nxt; int ui = 0;
    if (!g.next(0, cur)) return;
    f32x4 acc[2][2][4][2];
#pragma unroll
    for (int a = 0; a < 2; ++a)
#pragma unroll
        for (int b = 0; b < 2; ++b)
#pragma unroll
            for (int m = 0; m < 4; ++m)
#pragma unroll
                for (int n = 0; n < 2; ++n) acc[a][b][m][n] = (f32x4){0.f, 0.f, 0.f, 0.f};
    bf16x8 At[4][2], B0[2][2], B1[2][2];
    const char* cA = g.a_base(cur); const char* cB = g.b_base(cur);
    if constexpr (SP2) {
        PG8_STAGE(PG8_SB(0, 0), cB, voffB); PG8_STAGE(PG8_SB(0, 1), cB + hstepB, voffB); PG8_STAGE(PG8_SA(0, 0), cA, voffA); PG8_STAGE(PG8_SA(0, 1), cA + hstepA, voffA);
        if (wr == 1) PG8_BAR;
        PG8_WAIT_V(2); PG8_BAR;
        PG8_STAGE(PG8_SB(1, 0), cB + kstep, voffB); PG8_STAGE(PG8_SA(1, 0), cA + kstep, voffA); PG8_STAGE(PG8_SB(1, 1), cB + hstepB + kstep, voffB);
        PG8_WAIT_V(6); PG8_BAR;
    } else {
        PG8_STAGE(PG8_SB(0, 0), cB, voffB); PG8_STAGE(PG8_SA(0, 0), cA, voffA); PG8_STAGE(PG8_SB(0, 1), cB + hstepB, voffB); PG8_STAGE(PG8_SA(0, 1), cA + hstepA, voffA);
        if (wr == 1) PG8_BAR;
        PG8_WAIT_V(4); PG8_BAR;
        PG8_STAGE(PG8_SB(1, 0), cB + kstep, voffB); PG8_STAGE(PG8_SA(1, 0), cA + kstep, voffA); PG8_STAGE(PG8_SB(1, 1), cB + hstepB + kstep, voffB);
        PG8_WAIT_V(6); PG8_BAR;
    }
    for (;;) {
        const bool has_next = g.next(ui + 1, nxt);
        const char* nA = has_next ? g.a_base(nxt) : cA; const char* nB = has_next ? g.b_base(nxt) : cB;
#pragma unroll 1
        for (int t = 0; t < nt; t += 2) {
            const bool last = (t == nt - 2);
            const char* a1 = cA + (size_t)(t + 1) * kstep;
            const char* a2 = last ? nA : cA + (size_t)(t + 2) * kstep; const char* b2 = last ? nB : cB + (size_t)(t + 2) * kstep;
            const char* a3 = a2 + kstep; const char* b3 = b2 + kstep;
            if constexpr (SP2) {
            PG8_LDB(B0, 0, 0); PG8_LDB(B1, 0, 1); PG8_SCHED; PG8_LDA(At, 0, 0); PG8_STAGE(PG8_SA(1, 1), a1 + hstepA, voffA);
            PG8_WAIT_V(8); PG8_WAIT_L(0); PG8_BAR; PG8_MMA(0, 0, At, B0); PG8_MMA(0, 1, At, B1); PG8_BAR; PG8_SCHED;
            PG8_LDA(At, 0, 1); PG8_STAGE(PG8_SB(0, 0), b2, voffB); PG8_STAGE(PG8_SB(0, 1), b2 + hstepB, voffB); PG8_STAGE(PG8_SA(0, 0), a2, voffA);
            PG8_WAIT_V(8); PG8_WAIT_L(0); PG8_BAR; PG8_MMA(1, 0, At, B0); PG8_MMA(1, 1, At, B1); PG8_BAR; PG8_SCHED;
            PG8_LDB(B0, 1, 0); PG8_LDB(B1, 1, 1); PG8_SCHED; PG8_LDA(At, 1, 0); PG8_STAGE(PG8_SA(0, 1), a2 + hstepA, voffA);
            PG8_WAIT_V(8); PG8_WAIT_L(0); PG8_BAR; PG8_MMA(0, 0, At, B0); PG8_MMA(0, 1, At, B1); PG8_BAR; PG8_SCHED;
            PG8_LDA(At, 1, 1); PG8_STAGE(PG8_SB(1, 0), b3, voffB); PG8_STAGE(PG8_SB(1, 1), b3 + hstepB, voffB); PG8_STAGE(PG8_SA(1, 0), a3, voffA);
            PG8_WAIT_V(8); PG8_WAIT_L(0); PG8_BAR; PG8_MMA(1, 0, At, B0); PG8_MMA(1, 1, At, B1); PG8_BAR; PG8_SCHED;
            } else {
            PG8_LDB(B0, 0, 0); PG8_SCHED; PG8_LDA(At, 0, 0); PG8_STAGE(PG8_SA(1, 1), a1 + hstepA, voffA);
            PG8_WAIT_L(8); PG8_BAR; PG8_WAIT_L(0); PG8_MMA(0, 0, At, B0); PG8_BAR; PG8_SCHED;
            PG8_LDB(B1, 0, 1); PG8_STAGE(PG8_SB(0, 0), b2, voffB);
            PG8_BAR; PG8_WAIT_L(0); PG8_MMA(0, 1, At, B1); PG8_BAR;
            PG8_LDA(At, 0, 1); PG8_STAGE(PG8_SA(0, 0), a2, voffA);
            PG8_BAR; PG8_WAIT_L(0); PG8_MMA(1, 0, At, B0); PG8_BAR; PG8_SCHED;
            PG8_STAGE(PG8_SB(0, 1), b2 + hstepB, voffB);
            PG8_WAIT_V(6); PG8_BAR; PG8_MMA(1, 1, At, B1); PG8_BAR;
            PG8_LDB(B0, 1, 0); PG8_SCHED; PG8_LDA(At, 1, 0); PG8_STAGE(PG8_SA(0, 1), a2 + hstepA, voffA);
            PG8_WAIT_L(8); PG8_BAR; PG8_WAIT_L(0); PG8_MMA(0, 0, At, B0); PG8_BAR; PG8_SCHED;
            PG8_LDB(B1, 1, 1); PG8_STAGE(PG8_SB(1, 0), b3, voffB);
            PG8_BAR; PG8_WAIT_L(0); PG8_MMA(0, 1, At, B1); PG8_BAR;
            PG8_LDA(At, 1, 1); PG8_STAGE(PG8_SA(1, 0), a3, voffA);
            PG8_BAR; PG8_WAIT_L(0); PG8_MMA(1, 0, At, B0); PG8_BAR; PG8_SCHED;
            PG8_STAGE(PG8_SB(1, 1), b3 + hstepB, voffB);
            PG8_WAIT_V(6); PG8_BAR; PG8_MMA(1, 1, At, B1); PG8_BAR;
            }
        }
        if constexpr (ALIGN_EPI) { if (wr == 0) PG8_BAR; }
        E(acc, cur, wr, wc, fr, fq);
        if (!has_next) break;
#pragma unroll
        for (int a = 0; a < 2; ++a)
#pragma unroll
            for (int b = 0; b < 2; ++b)
#pragma unroll
                for (int m = 0; m < 4; ++m)
#pragma unroll
                    for (int n = 0; n < 2; ++n) acc[a][b][m][n] = (f32x4){0.f, 0.f, 0.f, 0.f};
        cur = nxt; cA = nA; cB = nB; ++ui;
        if constexpr (ALIGN_EPI) { if (wr == 1) PG8_BAR; }
    }
    PG8_WAIT_V(0);
    if constexpr (!ALIGN_EPI) { if (wr == 0) PG8_BAR; }
    PG8_BAR;
#undef PG8_SA
#undef PG8_SB
#undef PG8_STAGE
#undef PG8_LDA
#undef PG8_LDB
#undef PG8_MMA
#undef PG8_WAIT_V
#undef PG8_WAIT_L
#undef PG8_BAR
#undef PG8_SCHED
}

struct EpiBf16 {
    static constexpr bool PERM = true;
    bf16_t* O; long zs; int ldc, pad;
    __device__ __forceinline__ void operator()(const f32x4 (&acc)[2][2][4][2], const Unit& u, int wr, int wc, int fr, int fq) const {
        const int row0 = u.pm * BM + wr * 64 + fr, col0 = u.pn * BM + wc * 32 + 8 * fq; bf16_t* base = O + (long)u.z * zs;
#pragma unroll
        for (int ai = 0; ai < 2; ++ai)
#pragma unroll
            for (int m = 0; m < 4; ++m) { bf16_t* rowp = base + (size_t)(row0 + ai * HALF + m * 16) * ldc + col0;
#pragma unroll
                for (int bj = 0; bj < 2; ++bj) { const f32x4 v0 = acc[ai][bj][m][0], v1 = acc[ai][bj][m][1];
                    u32x4 w; w.x = pk2(v0[0], v0[1]); w.y = pk2(v0[2], v0[3]); w.z = pk2(v1[0], v1[1]); w.w = pk2(v1[2], v1[3]);
                    *(u32x4*)(rowp + bj * HALF) = w; } }
    }
};
struct EpiMem {
    static constexpr bool PERM = false;
    float* outK; float* outV; bf16_t* kb; bf16_t* vt;
    __device__ __forceinline__ void operator()(const f32x4 (&acc)[2][2][4][2], const Unit& u, int wr, int wc, int fr, int fq) const {
        const int row0 = u.pm * BM + wr * 64 + fr, col0 = u.pn * BM + wc * 32 + 4 * fq;
#pragma unroll
        for (int ai = 0; ai < 2; ++ai)
#pragma unroll
            for (int m = 0; m < 4; ++m) { const int row = row0 + ai * HALF + m * 16;
#pragma unroll
                for (int bj = 0; bj < 2; ++bj)
#pragma unroll
                    for (int n = 0; n < 2; ++n) { const int col = col0 + bj * HALF + n * 16; const f32x4 v = acc[ai][bj][m][n];
                        if (col < 1024) { *(f32x4*)(outK + ((size_t)u.z * 512 + row) * 1024 + col) = v;
                            u32x2 w; w.x = pk2(v[0], v[1]); w.y = pk2(v[2], v[3]); *(u32x2*)(kb + ((size_t)u.z * 512 + row) * 1024 + col) = w; }
                        else { const int c = col - 1024; *(f32x4*)(outV + ((size_t)u.z * 512 + row) * 1024 + c) = v;
                            const int b = row >> 8, mm = row & 255, h = c >> 8, d = c & 255; bf16_t* p = vt + ((((size_t)u.z * 2 + b) * 4 + h) * 256 + d) * 256 + mm;
                            p[0] = f2bf(v[0]); p[256] = f2bf(v[1]); p[512] = f2bf(v[2]); p[768] = f2bf(v[3]); } } }
    }
};
struct EpiMerge {
    static constexpr bool PERM = true;
    float* MG; bf16_t* MGB; const bf16_t* U; const float* gate_b;
    __device__ __forceinline__ void operator()(const f32x4 (&acc)[2][2][4][2], const Unit& u, int wr, int wc, int fr, int fq) const {
        const int row0 = u.pm * BM + wr * 64 + fr, col0 = u.pn * BM + wc * 32 + 8 * fq;
#pragma unroll
        for (int bj = 0; bj < 2; ++bj) { const int col = col0 + bj * HALF; const f32x4 gb0 = *(const f32x4*)(gate_b + u.z * DM + col), gb1 = *(const f32x4*)(gate_b + u.z * DM + col + 4);
#pragma unroll
            for (int ai = 0; ai < 2; ++ai)
#pragma unroll
                for (int m = 0; m < 4; ++m) { const int row = row0 + ai * HALF + m * 16; float gp[8], r[8];
                    unpack8(*(const u32x4*)(U + (size_t)row * NINP + U_GP + u.z * DM + col), gp);
#pragma unroll
                    for (int j = 0; j < 4; ++j) { r[j] = sigmoidf_(gp[j] + gb0[j]) * acc[ai][bj][m][0][j]; r[4 + j] = sigmoidf_(gp[4 + j] + gb1[j]) * acc[ai][bj][m][1][j]; }
                    bf16_t* mp = MGB + (size_t)row * DM + col;
                    if (u.z > 0) { float pv[8]; unpack8(*(const u32x4*)mp, pv);
#pragma unroll
                        for (int j = 0; j < 8; ++j) r[j] += pv[j]; }
                    *(u32x4*)mp = (u32x4){pk2(r[0], r[1]), pk2(r[2], r[3]), pk2(r[4], r[5]), pk2(r[6], r[7])}; } }
    }
};
struct EpiRes {
    static constexpr bool PERM = true;
    const bf16_t* R; bf16_t* Y;
    __device__ __forceinline__ void operator()(const f32x4 (&acc)[2][2][4][2], const Unit& u, int wr, int wc, int fr, int fq) const {
        const int row0 = u.pm * BM + wr * 64 + fr, col0 = u.pn * BM + wc * 32 + 8 * fq;
#pragma unroll
        for (int ai = 0; ai < 2; ++ai)
#pragma unroll
            for (int m = 0; m < 4; ++m) { const size_t ro = (size_t)(row0 + ai * HALF + m * 16) * DM + col0;
#pragma unroll
                for (int bj = 0; bj < 2; ++bj) { const size_t o = ro + bj * HALF; float rv[8]; unpack8(*(const u32x4*)(R + o), rv);
                    const f32x4 y0 = (f32x4){rv[0], rv[1], rv[2], rv[3]} * ALPHA + acc[ai][bj][m][0], y1 = (f32x4){rv[4], rv[5], rv[6], rv[7]} * ALPHA + acc[ai][bj][m][1];
                    *(u32x4*)(Y + o) = (u32x4){pk2(y0[0], y0[1]), pk2(y0[2], y0[3]), pk2(y1[0], y1[1]), pk2(y1[2], y1[3])}; } }
    }
};
struct EpiSwiGLU {
    static constexpr bool PERM = true;
    bf16_t* O;
    __device__ __forceinline__ void operator()(const f32x4 (&acc)[2][2][4][2], const Unit& u, int wr, int wc, int fr, int fq) const {
        const int row0 = u.pm * BM + wr * 64 + fr, col0 = u.pn * HALF + wc * 32 + 8 * fq;
#pragma unroll
        for (int ai = 0; ai < 2; ++ai)
#pragma unroll
            for (int m = 0; m < 4; ++m) { bf16_t* rowp = O + (size_t)(row0 + ai * HALF + m * 16) * DFF + col0;
                float r[8];
#pragma unroll
                for (int n = 0; n < 2; ++n)
#pragma unroll
                    for (int j = 0; j < 4; ++j) { const float gg = acc[ai][0][m][n][j], uu = acc[ai][1][m][n][j]; r[n * 4 + j] = gg * sigmoidf_(gg) * uu; }
                u32x4 w; w.x = pk2(r[0], r[1]); w.y = pk2(r[2], r[3]); w.z = pk2(r[4], r[5]); w.w = pk2(r[6], r[7]);
                *(u32x4*)rowp = w; }
    }
};
struct EpiScore {
    static constexpr bool PERM = false;
    float* SC;
    __device__ __forceinline__ void operator()(const f32x4 (&acc)[2][2][4][2], const Unit& u, int wr, int wc, int fr, int fq) const {
        const int row0 = u.pm * BM + wr * 64 + fr, col0 = wc * 32 + 4 * fq; float* base = SC + (size_t)u.z * 4096 * 256;
#pragma unroll
        for (int ai = 0; ai < 2; ++ai)
#pragma unroll
            for (int m = 0; m < 4; ++m) { float* rowp = base + (size_t)(row0 + ai * HALF + m * 16) * 256 + col0;
#pragma unroll
                for (int bj = 0; bj < 2; ++bj)
#pragma unroll
                    for (int n = 0; n < 2; ++n) *(f32x4*)(rowp + bj * HALF + n * 16) = acc[ai][bj][m][n] * 0.0625f; }
    }
};
struct EpiPV {
    static constexpr bool PERM = true;
    bf16_t* O;
    __device__ __forceinline__ void operator()(const f32x4 (&acc)[2][2][4][2], const Unit& u, int wr, int wc, int fr, int fq) const {
        const int b = u.z >> 2, h = u.z & 3; const int row0 = b * PS + u.pm * BM + wr * 64 + fr, col0 = h * 256 + wc * 32 + 8 * fq;
#pragma unroll
        for (int ai = 0; ai < 2; ++ai)
#pragma unroll
            for (int m = 0; m < 4; ++m) { bf16_t* rowp = O + (size_t)(row0 + ai * HALF + m * 16) * BW + col0;
#pragma unroll
                for (int bj = 0; bj < 2; ++bj) { const f32x4 v0 = acc[ai][bj][m][0], v1 = acc[ai][bj][m][1];
                    u32x4 w; w.x = pk2(v0[0], v0[1]); w.y = pk2(v0[2], v0[3]); w.z = pk2(v1[0], v1[1]); w.w = pk2(v1[2], v1[3]);
                    *(u32x4*)(rowp + bj * HALF) = w; } }
    }
};
}


#define XB_TMO      128
#define XB_XCNT(j)  (256  + 64 * (j))
#define XB_XSUB(j)  (1280 + 64 * (j))
#define XB_XGEN(j)  (2304 + 64 * (j))
#define XB_TOP      3328
#define XB_TOPGEN   3392
#define XCD_BAR_WORDS 3456
#define XB_SPIN_CAP (1u << 18)
__device__ __forceinline__ unsigned xb_ld(unsigned* p)              { return __hip_atomic_load(p, __ATOMIC_RELAXED, __HIP_MEMORY_SCOPE_AGENT); }
__device__ __forceinline__ unsigned xb_add(unsigned* p, unsigned v) { return __hip_atomic_fetch_add(p, v, __ATOMIC_RELAXED, __HIP_MEMORY_SCOPE_AGENT); }
__device__ __forceinline__ unsigned xb_xcc_id() { return (unsigned)__builtin_amdgcn_s_getreg((3 << 11) | 20) & 0xFu; }
#define XB_SPIN(cond, bar) do { unsigned _sp = 0; while (cond) { __builtin_amdgcn_s_sleep(1); \
    if ((++_sp & 255u) == 0u) { if (xb_ld(&(bar)[XB_TMO])) break; if (_sp > XB_SPIN_CAP) { atomicAdd(&(bar)[XB_TMO], 1u); break; } } } } while (0)
struct XcdBarrier { unsigned* bar; unsigned x; volatile LAS unsigned* st; };
__device__ __forceinline__ XcdBarrier xcd_barrier_post(unsigned* bar, volatile LAS unsigned* st) {
    XcdBarrier b; b.bar = bar; b.x = xb_xcc_id(); b.st = st;
    if (threadIdx.x == 0) (void)xb_add(&bar[XB_XCNT(b.x)], 1u);
    return b;
}
__device__ __forceinline__ void xcd_barrier_complete(unsigned* bar, unsigned x, unsigned& nloc, unsigned& nx) {
    const unsigned G = gridDim.x * gridDim.y * gridDim.z;
    unsigned sum, cnt, mine, sp = 0u;
    for (;;) {
        sum = 0u; cnt = 0u; mine = 0u;
#pragma unroll
        for (unsigned j = 0; j < 16; ++j) { const unsigned c = xb_ld(&bar[XB_XCNT(j)]); sum += c; cnt += (c > 0u) ? 1u : 0u; mine = (j == x) ? c : mine; }
        if (sum == G) break;
        __builtin_amdgcn_s_sleep(1);
        if ((++sp & 255u) == 0u) { if (xb_ld(&bar[XB_TMO])) break; if (sp > XB_SPIN_CAP) { atomicAdd(&bar[XB_TMO], 1u); break; } }
    }
    nloc = mine > 0u ? mine : 1u; nx = cnt > 0u ? cnt : 1u;
}
__device__ __forceinline__ void xcd_barrier(const XcdBarrier& b) {
    asm volatile("s_waitcnt vmcnt(0)" ::: "memory");
    __syncthreads();
    if (threadIdx.x == 0) {
        unsigned* bar = b.bar;
        __builtin_amdgcn_s_waitcnt(0);
        unsigned nloc = b.st[0], nx = b.st[1];
        if (nloc == 0u) { xcd_barrier_complete(bar, b.x, nloc, nx); b.st[0] = nloc; b.st[1] = nx; }
        const unsigned old = xb_add(&bar[XB_XSUB(b.x)], 1u);
        const unsigned gen = old / nloc;
        if (old + 1u == (gen + 1u) * nloc) {
            __builtin_amdgcn_fence(__ATOMIC_RELEASE, "agent");
            asm volatile("s_waitcnt vmcnt(0)" ::: "memory");
            const unsigned og = xb_add(&bar[XB_TOP], 1u);
            const unsigned tg = og / nx;
            if (og + 1u == (tg + 1u) * nx) xb_add(&bar[XB_TOPGEN], 1u);
            else XB_SPIN(xb_ld(&bar[XB_TOPGEN]) == tg, bar);
            __builtin_amdgcn_fence(__ATOMIC_ACQUIRE, "agent");
            xb_add(&bar[XB_XGEN(b.x)], 1u);
            asm volatile("s_waitcnt vmcnt(0)" ::: "memory");
        } else {
            XB_SPIN(xb_ld(&bar[XB_XGEN(b.x)]) == gen, bar);
            __builtin_amdgcn_fence(__ATOMIC_ACQUIRE, "agent");
            asm volatile("s_waitcnt vmcnt(0)" ::: "memory");
        }
    }
    __syncthreads();
}

struct Ctx { int tid, lane, wave, bid, G; LAS unsigned char* lds; };
__device__ __forceinline__ Ctx fresh(const Ctx& c0) { Ctx c; c.wave = c0.wave; c.bid = c0.bid; c.G = c0.G; c.lds = c0.lds; asm volatile("" : "+s"(c.bid), "+s"(c.G), "+s"(c.wave));
    int lane = (int)__builtin_amdgcn_mbcnt_hi(~0u, __builtin_amdgcn_mbcnt_lo(~0u, 0u)); asm volatile("" : "+v"(lane)); c.lane = lane; c.tid = c.wave * 64 + lane; return c; }

__device__ __forceinline__ int colmap(int mode, int n) {
    if (mode == 1) return n < 3088 ? n : (n < 3328 ? -1 : n - 240);
    if (mode == 2) { const int t = n >> 8, j = n & 255; return j < 128 ? t * 128 + j : DFF + t * 128 + (j - 128); }
    return n;
}
__device__ __forceinline__ void wprep_load(f32x4 (&rg)[8], const float* __restrict__ src, int K, int Nsrc, int Ndst, int mode, size_t sbs, int item, int tid) {
    const int nx = Ndst / 256, ny = K / 64; const int bx = item % nx, by = (item / nx) % ny, bz = item / (nx * ny);
    const int tx = tid & 63, ty = tid >> 6, cm = colmap(mode, bx * 256 + tx * 4); const float* s = src + (size_t)bz * sbs + (size_t)(by * 64 + ty) * Nsrc + cm;
#pragma unroll
    for (int i = 0; i < 8; ++i) rg[i] = cm >= 0 ? *(const f32x4*)(s + (size_t)(8 * i) * Nsrc) : (f32x4){0.f, 0.f, 0.f, 0.f};
}
__device__ __forceinline__ void ph_wprep(const Ctx& c, const float* __restrict__ src, bf16_t* __restrict__ dst, int K, int Nsrc, int Ndst, int mode, int nbatch, size_t sbs, size_t dbs) {
    LAS float* tile = (LAS float*)c.lds;
    const int nx = Ndst / 256, ny = K / 64, total = nx * ny * nbatch;
    const int tid = c.tid, tx = tid & 63, ty = tid >> 6, n = tid >> 1, kh = tid & 1;
    f32x4 rg[8];
    int item = c.bid;
    if (item < total) wprep_load(rg, src, K, Nsrc, Ndst, mode, sbs, item, tid);
    for (; item < total; item += c.G) {
        __syncthreads();
#pragma unroll
        for (int i = 0; i < 8; ++i) *(LAS f32x4*)(tile + (ty + 8 * i) * 260 + tx * 4) = rg[i];
        __syncthreads();
        const int bx = item % nx, by = (item / nx) % ny, bz = item / (nx * ny);
        if (item + c.G < total) wprep_load(rg, src, K, Nsrc, Ndst, mode, sbs, item + c.G, tid);
        bf16_t* d = dst + (size_t)bz * dbs + (size_t)(bx * 256 + n) * K + by * 64 + kh * 32;
#pragma unroll
        for (int g = 0; g < 4; ++g) { unsigned p[4];
#pragma unroll
            for (int e = 0; e < 4; ++e) p[e] = pk2(tile[(kh * 32 + g * 8 + 2 * e) * 260 + n], tile[(kh * 32 + g * 8 + 2 * e + 1) * 260 + n]);
            *(u32x4*)(d + g * 8) = (u32x4){p[0], p[1], p[2], p[3]}; }
    }
    __syncthreads();
}
__device__ __forceinline__ void ph_xprep(const Ctx& c, const float* __restrict__ xp, const float* __restrict__ xs, const float* __restrict__ mem, float* __restrict__ HF, bf16_t* __restrict__ HB, bf16_t* __restrict__ MEMB) {
    const size_t nH = (size_t)MPAD * DM / 4, nM = (size_t)512 * DM / 4;
    for (size_t i4 = (size_t)c.bid * 512 + c.tid; i4 < nH + nM; i4 += (size_t)c.G * 512) {
        if (i4 < nH) {
            const size_t e = i4 * 4; f32x4 v = (f32x4){0.f, 0.f, 0.f, 0.f};
            if (e < (size_t)MP * DM) v = *(const f32x4*)(xp + e); else if (e < (size_t)MT * DM) v = *(const f32x4*)(xs + (e - (size_t)MP * DM));
            if (HF != nullptr) *(f32x4*)(HF + e) = v;
            u32x2 w; w.x = pk2(v[0], v[1]); w.y = pk2(v[2], v[3]); *(u32x2*)(HB + e) = w;
        } else {
            const size_t e = (i4 - nH) * 4; const f32x4 v = *(const f32x4*)(mem + e); u32x2 w; w.x = pk2(v[0], v[1]); w.y = pk2(v[2], v[3]); *(u32x2*)(MEMB + e) = w;
        }
    }
}
__device__ __forceinline__ void ph_ln(const Ctx& c, const bf16_t* __restrict__ Y, const float* __restrict__ g, const float* __restrict__ b, float* __restrict__ XF, bf16_t* __restrict__ XB, float* __restrict__ OUT, int nrows, int nout) {
    const int lane = c.lane;
    for (int row = c.bid * 8 + c.wave; row < nrows; row += c.G * 8) {
        const bf16_t* y = Y + (size_t)row * DM; f32x4 v[8]; float s = 0.f;
#pragma unroll
        for (int j = 0; j < 8; ++j) { const u32x2 yr = *(const u32x2*)(y + j * 256 + lane * 4);
            v[j] = (f32x4){__uint_as_float(yr.x << 16), __uint_as_float(yr.x & 0xffff0000u), __uint_as_float(yr.y << 16), __uint_as_float(yr.y & 0xffff0000u)}; s += (v[j][0] + v[j][1]) + (v[j][2] + v[j][3]); }
        const float mean = wave_sum(s) * (1.0f / DM); float q = 0.f;
#pragma unroll
        for (int j = 0; j < 8; ++j) { const f32x4 d = v[j] - mean; q += (d[0] * d[0] + d[1] * d[1]) + (d[2] * d[2] + d[3] * d[3]); }
        const float rstd = rsqrtf(wave_sum(q) * (1.0f / DM) + 1e-5f);
#pragma unroll
        for (int j = 0; j < 8; ++j) { const int cc = j * 256 + lane * 4; const f32x4 gg = *(const f32x4*)(g + cc), bb = *(const f32x4*)(b + cc);
            const f32x4 o = (v[j] - mean) * rstd * gg + bb; const size_t off = (size_t)row * DM + cc;
            if (XF != nullptr) *(f32x4*)(XF + off) = o;
            u32x2 w; w.x = pk2(o[0], o[1]); w.y = pk2(o[2], o[3]); *(u32x2*)(XB + off) = w;
            if (OUT != nullptr && row < nout) *(f32x4*)(OUT + off) = o; }
    }
}
__device__ __forceinline__ void ph_softmax256(const Ctx& c, const float* __restrict__ SC, bf16_t* __restrict__ P, int nrows) {
    const int lane = c.lane;
    for (int row = c.bid * 8 + c.wave; row < nrows; row += c.G * 8) {
        const f32x4 v = *(const f32x4*)(SC + (size_t)row * 256 + lane * 4);
        const float mx = wave_max(fmaxf(fmaxf(v[0], v[1]), fmaxf(v[2], v[3])));
        f32x4 e; e[0] = __expf(v[0] - mx); e[1] = __expf(v[1] - mx); e[2] = __expf(v[2] - mx); e[3] = __expf(v[3] - mx);
        const float inv = 1.0f / wave_sum((e[0] + e[1]) + (e[2] + e[3]));
        u32x2 w; w.x = pk2(e[0] * inv, e[1] * inv); w.y = pk2(e[2] * inv, e[3] * inv); *(u32x2*)(P + (size_t)row * 256 + lane * 4) = w;
    }
}
__device__ __forceinline__ void ph_copy_outs(const Ctx& c, const bf16_t* __restrict__ U, const float* __restrict__ ck, const float* __restrict__ cv, float* __restrict__ out, int layer) {
    constexpr int nA = PB * 128 * 128, nB = SB * 128 * 128, nC = PB * RWC, nD = SB * RWC;
    for (int i = c.bid * 512 + c.tid; i < nA + nB + nC + nD; i += c.G * 512) {
        if (i < nA) { const int b = i / 16384, j = (i >> 7) & 127, cc = i & 127; const size_t ur = (size_t)(b * PS + PS - 128 + j) * NINP;
            out[O_SWKP + (size_t)layer * nA + i] = bf2f(U[ur + U_SK + cc]); out[O_SWVP + (size_t)layer * nA + i] = bf2f(U[ur + U_SV + cc]); continue; }
        int k = i - nA;
        if (k < nB) { const int sq = k / 16384, j = (k >> 7) & 127, cc = k & 127; float kv, vv;
            if (j < 124) { const size_t o = ((size_t)sq * 128 + j + 4) * 128 + cc; kv = ck[o]; vv = cv[o]; }
            else { const size_t ur = (size_t)(MP + sq * SS + j - 124) * NINP; kv = bf2f(U[ur + U_SK + cc]); vv = bf2f(U[ur + U_SV + cc]); }
            out[O_SWKS + (size_t)layer * nB + k] = kv; out[O_SWVS + (size_t)layer * nB + k] = vv; continue; }
        k -= nB;
        if (k < nC) { const int b = k / RWC, cc = k - b * RWC; out[O_RSP + (size_t)layer * nC + k] = bf2f(U[(size_t)(b * PS + PS - 1) * NINP + U_RU + cc]); continue; }
        k -= nC;
        { const int sq = k / RWC, cc = k - sq * RWC; out[O_RSS + (size_t)layer * nD + k] = bf2f(U[(size_t)(MP + sq * SS + SS - 1) * NINP + U_RU + cc]); }
    }
}

__device__ __forceinline__ void seq_info(int sq, int& row0, int& L) { if (sq < PB) { row0 = sq * PS; L = PS; } else { row0 = MP + (sq - PB) * SS; L = SS; } }

__device__ __forceinline__ void ph_gla_naive(const Ctx& c, const bf16_t* __restrict__ U, const float* __restrict__ s0, const float* __restrict__ a_up, const float* __restrict__ a_b,
                                             const float* __restrict__ ng, const float* __restrict__ nb, bf16_t* __restrict__ OB, float* __restrict__ outP, float* __restrict__ outS) {
    LAS float* qs = (LAS float*)c.lds;
    LAS float* ks = qs + 16 * 128; LAS float* as = ks + 16 * 128; LAS float* os = as + 16 * 128;
    const int kh = c.tid >> 8, vt = c.tid & 255, lane = c.lane;
    for (int u = c.bid; u < (PB + SB) * 4; u += c.G) {
        const int sq = u >> 2, h = u & 3;
        int row0, L; seq_info(sq, row0, L);
        float S[64];
        if (sq >= PB) { const float* p = s0 + (((size_t)(sq - PB) * 4 + h) * 128 + kh * 64) * 256 + vt;
#pragma unroll
            for (int kk = 0; kk < 64; ++kk) S[kk] = p[(size_t)kk * 256]; }
        else {
#pragma unroll
            for (int kk = 0; kk < 64; ++kk) S[kk] = 0.f; }
        for (int t0 = 0; t0 < L; t0 += 16) {
            const int nT = (L - t0) < 16 ? (L - t0) : 16;
            for (int idx = c.tid; idx < nT * 128; idx += 512) {
                const int tt = idx >> 7, kk = idx & 127; const bf16_t* ur = U + (size_t)(row0 + t0 + tt) * NINP;
                qs[idx] = bf2f(ur[U_GQ + h * 128 + kk]) * 0.08838834764831845f; ks[idx] = bf2f(ur[U_GK + h * 128 + kk]);
                float x = a_b[h * 128 + kk];
#pragma unroll
                for (int r = 0; r < 16; ++r) x += bf2f(ur[U_GA + r]) * a_up[r * 512 + h * 128 + kk];
                const float ls = (fminf(x, 0.f) - log1pf(__expf(-fabsf(x)))) * (1.0f / 16.0f);
                as[idx] = __expf(ls);
            }
            __syncthreads();
            for (int tt = 0; tt < nT; ++tt) {
                const float v = bf2f(U[(size_t)(row0 + t0 + tt) * NINP + U_GV + h * 256 + vt]); float o = 0.f; const int lb = tt * 128 + kh * 64;
#pragma unroll
                for (int kk = 0; kk < 64; ++kk) { S[kk] = as[lb + kk] * S[kk] + ks[lb + kk] * v; o += qs[lb + kk] * S[kk]; }
                os[(kh * 16 + tt) * 256 + vt] = o;
            }
            __syncthreads();
            for (int tt = c.wave; tt < nT; tt += 8) {
                float x[4]; float s = 0.f;
#pragma unroll
                for (int j = 0; j < 4; ++j) { x[j] = os[tt * 256 + lane + 64 * j] + os[(16 + tt) * 256 + lane + 64 * j]; s += x[j]; }
                const float mean = wave_sum(s) * (1.0f / 256.0f); float q = 0.f;
#pragma unroll
                for (int j = 0; j < 4; ++j) { const float d = x[j] - mean; q += d * d; }
                const float rstd = rsqrtf(wave_sum(q) * (1.0f / 256.0f) + 1e-5f);
                const size_t row = (size_t)(row0 + t0 + tt);
#pragma unroll
                for (int j = 0; j < 4; ++j) { const int cc = h * 256 + lane + 64 * j; const float n = (x[j] - mean) * rstd * ng[cc] + nb[cc];
                    const float gr = bf2f(U[row * NINP + U_GR + cc]); OB[row * BW + cc] = f2bf(n * gr * sigmoidf_(gr)); }
            }
            __syncthreads();
        }
        float* op = (sq < PB ? outP + (((size_t)sq * 4 + h) * 128 + kh * 64) * 256 : outS + (((size_t)(sq - PB) * 4 + h) * 128 + kh * 64) * 256) + vt;
#pragma unroll
        for (int kk = 0; kk < 64; ++kk) op[(size_t)kk * 256] = S[kk];
    }
}

__device__ __forceinline__ f32x4 mma16(bf16x8 x, bf16x8 y, f32x4 c) { return __builtin_amdgcn_mfma_f32_16x16x32_bf16(x, y, c, 0, 0, 0); }
__device__ __forceinline__ bf16x8 pack_acc(const f32x4& a, const f32x4& b) {
    u32x4 p; p.x = pk2(a[0], a[1]); p.y = pk2(a[2], a[3]); p.z = pk2(b[0], b[1]); p.w = pk2(b[2], b[3]); return __builtin_bit_cast(bf16x8, p);
}
__device__ __forceinline__ void gla_chunk_info(int u, int& row0, int& ntok, int& h) {
    if (u < 512) { const int b = u >> 8; h = (u >> 6) & 3; row0 = b * PS + (u & 63) * 64; ntok = 64; }
    else { const int s = u - 512; h = s & 3; row0 = MP + (s >> 2) * SS; ntok = SS; }
}
__device__ __forceinline__ void ph_gla_pre(const Ctx& c, const bf16_t* __restrict__ U, const float* __restrict__ a_up, const float* __restrict__ a_b,
                                           bf16_t* __restrict__ QD, bf16_t* __restrict__ KHT, bf16_t* __restrict__ EE, bf16_t* __restrict__ VT, float* __restrict__ GC) {
    LAS float* ga_l = (LAS float*)c.lds;
    LAS float* tot = ga_l + 64 * 16;
    LAS bf16_t* Qd_l = (LAS bf16_t*)(tot + 4 * 128);
    LAS bf16_t* Kn_l = Qd_l + 64 * 136;
    LAS bf16_t* v_l = Kn_l + 64 * 136;
    LAS bf16_t* qr_l = v_l + 64 * 264;
    LAS bf16_t* kr_l = qr_l + 64 * 136;
    const int tid = c.tid, lane = c.lane, r = lane & 15, q = lane >> 4, w = c.wave;
    for (int u = (c.bid + c.G / 2) % c.G; u < GL_NCH; u += c.G) {
        int row0, ntok, h; gla_chunk_info(u, row0, ntok, h);
        for (int i = tid; i < 64 * 16; i += 512) { const int t = i >> 4, rr = i & 15; ga_l[i] = t < ntok ? bf2f(U[(size_t)(row0 + t) * NINP + U_GA + rr]) : 0.f; }
        for (int i = tid; i < 64 * 32; i += 512) { const int t = i >> 5, c8 = i & 31; u32x4 vv = (u32x4){0u, 0u, 0u, 0u};
            if (t < ntok) vv = *(const u32x4*)(U + (size_t)(row0 + t) * NINP + U_GV + h * 256 + c8 * 8);
            *(LAS u32x4*)(v_l + t * 264 + c8 * 8) = vv; }
        for (int i = tid; i < 64 * 16; i += 512) { const int t = i >> 4, c8 = i & 15; u32x4 qv = (u32x4){0u, 0u, 0u, 0u}, kv = qv;
            if (t < ntok) { const bf16_t* ur = U + (size_t)(row0 + t) * NINP + h * 128 + c8 * 8; qv = *(const u32x4*)(ur + U_GQ); kv = *(const u32x4*)(ur + U_GK); }
            *(LAS u32x4*)(qr_l + t * 136 + c8 * 8) = qv; *(LAS u32x4*)(kr_l + t * 136 + c8 * 8) = kv; }
        __syncthreads();
        const int kk = tid & 127, tq = tid >> 7;
        float cum[16];
        { float aup[16];
#pragma unroll
          for (int rr = 0; rr < 16; ++rr) aup[rr] = a_up[rr * 512 + h * 128 + kk];
          const float ab = a_b[h * 128 + kk]; float run = 0.f;
#pragma unroll
          for (int j = 0; j < 16; ++j) { const int t = tq * 16 + j; float x = ab;
#pragma unroll
              for (int rr = 0; rr < 16; ++rr) x += ga_l[t * 16 + rr] * aup[rr];
              const float la = t < ntok ? (fminf(x, 0.f) - __logf(1.0f + __expf(-fabsf(x)))) * (1.0f / 16.0f) : 0.f;
              run += la; cum[j] = run; }
          tot[tq * 128 + kk] = run; }
        __syncthreads();
        { float prefix = 0.f, bC = 0.f;
#pragma unroll
          for (int g = 0; g < 4; ++g) { const float tv = tot[g * 128 + kk]; bC += tv; if (g < tq) prefix += tv; }
          unsigned khp[8];
#pragma unroll
          for (int j = 0; j < 16; j += 2) { float kh2[2];
#pragma unroll
              for (int e = 0; e < 2; ++e) { const int t = tq * 16 + j + e; const float b = prefix + cum[j + e]; const float qv = bf2f(qr_l[t * 136 + kk]), kv = bf2f(kr_l[t * 136 + kk]);
                  Qd_l[t * 136 + kk] = f2bf(qv * __expf(b) * 0.08838834764831845f); Kn_l[t * 136 + kk] = f2bf(kv * __expf(-b)); kh2[e] = kv * __expf(bC - b); }
              khp[j >> 1] = pk2(kh2[0], kh2[1]); }
          bf16_t* kp = KHT + (size_t)u * 8192 + kk * 64 + tq * 16;
          *(u32x4*)kp = (u32x4){khp[0], khp[1], khp[2], khp[3]}; *(u32x4*)(kp + 8) = (u32x4){khp[4], khp[5], khp[6], khp[7]};
          if (tq == 0) GC[(size_t)u * 128 + kk] = __expf(bC); }
        __syncthreads();
        { const int tb = w >> 1;
#pragma unroll
          for (int e = 0; e < 2; ++e) { const int ib = (w & 1) * 2 + e; f32x4 d = (f32x4){0.f, 0.f, 0.f, 0.f};
              if (ib <= tb) {
                  bf16x8 kf4[4], qf4[4];
#pragma unroll
                  for (int ks = 0; ks < 4; ++ks) { kf4[ks] = *(const LAS bf16x8*)(Kn_l + (ib * 16 + r) * 136 + ks * 32 + q * 8); qf4[ks] = *(const LAS bf16x8*)(Qd_l + (tb * 16 + r) * 136 + ks * 32 + q * 8); }
                  __builtin_amdgcn_sched_barrier(0);
#pragma unroll
                  for (int ks = 0; ks < 4; ++ks) d = mma16(kf4[ks], qf4[ks], d); }
              const int t = tb * 16 + r, i0 = ib * 16 + q * 4;
#pragma unroll
              for (int jj = 0; jj < 4; ++jj) if (i0 + jj > t) d[jj] = 0.f;
              u32x2 o; o.x = pk2(d[0], d[1]); o.y = pk2(d[2], d[3]); *(u32x2*)(EE + (size_t)u * 4096 + t * 64 + i0) = o; } }
        for (int i = tid; i < 64 * 16; i += 512) { const int t = i >> 4, c8 = i & 15; *(u32x4*)(QD + (size_t)u * 8192 + t * 128 + c8 * 8) = *(const LAS u32x4*)(Qd_l + t * 136 + c8 * 8); }
        { const int val = tid & 255, th = tid >> 8;
#pragma unroll
          for (int tg = 0; tg < 4; ++tg) { const int t0 = th * 32 + tg * 8; unsigned p4[4];
#pragma unroll
              for (int e = 0; e < 4; ++e) p4[e] = (unsigned)v_l[(t0 + 2 * e) * 264 + val] | ((unsigned)v_l[(t0 + 2 * e + 1) * 264 + val] << 16);
              *(u32x4*)(VT + (size_t)u * 16384 + val * 64 + t0) = (u32x4){p4[0], p4[1], p4[2], p4[3]}; } }
        __syncthreads();
    }
}
struct GlaStage { u32x4 qd[2], kh[2], e, vt, gc; };
__device__ __forceinline__ void gla_stage_load(GlaStage& s, const bf16_t* __restrict__ QD, const bf16_t* __restrict__ KHT, const bf16_t* __restrict__ EE, const bf16_t* __restrict__ VT, const float* __restrict__ GC,
                                               int ch, int sl, int tid) {
    const bf16_t* qp = QD + (size_t)ch * 8192 + tid * 8; s.qd[0] = *(const u32x4*)qp; s.qd[1] = *(const u32x4*)(qp + 4096);
    const bf16_t* kp = KHT + (size_t)ch * 8192 + tid * 8; s.kh[0] = *(const u32x4*)kp; s.kh[1] = *(const u32x4*)(kp + 4096);
    s.e = *(const u32x4*)(EE + (size_t)ch * 4096 + tid * 8);
    s.vt = *(const u32x4*)(VT + (size_t)ch * 16384 + sl * 4096 + tid * 8);
    if (tid < 32) s.gc = *(const u32x4*)(GC + (size_t)ch * 128 + tid * 4);
}
constexpr int GS_KH = 8704, GS_E = 17920, GS_VT = 22528, GS_GC = 27136, GS_EL = 27392;
__device__ __forceinline__ void gla_stage_store(const GlaStage& s, LAS bf16_t* b, int tid) {
    *(LAS u32x4*)(b + (tid >> 4) * 136 + (tid & 15) * 8) = s.qd[0]; *(LAS u32x4*)(b + (32 + (tid >> 4)) * 136 + (tid & 15) * 8) = s.qd[1];
    *(LAS u32x4*)(b + GS_KH + (tid >> 3) * 72 + (tid & 7) * 8) = s.kh[0]; *(LAS u32x4*)(b + GS_KH + (64 + (tid >> 3)) * 72 + (tid & 7) * 8) = s.kh[1];
    *(LAS u32x4*)(b + GS_E + (tid >> 3) * 72 + (tid & 7) * 8) = s.e; *(LAS u32x4*)(b + GS_VT + (tid >> 3) * 72 + (tid & 7) * 8) = s.vt;
    if (tid < 32) *(LAS u32x4*)(b + GS_GC + tid * 8) = s.gc;
}
__device__ __forceinline__ void ph_gla_seq(const Ctx& c, int boff, const bf16_t* __restrict__ QD, const bf16_t* __restrict__ KHT, const bf16_t* __restrict__ EE, const bf16_t* __restrict__ VT, const float* __restrict__ GC,
                                           const float* __restrict__ s0, float* __restrict__ outP, float* __restrict__ outS, bf16_t* __restrict__ OB) {
    LAS bf16_t* stg = (LAS bf16_t*)c.lds;
    LAS bf16_t* T_l = stg + 2 * GS_EL;
    const int tid = c.tid, lane = c.lane, r = lane & 15, q = lane >> 4, w = c.wave;
    const int side = c.bid < 32 ? c.bid : c.bid - 64, nside = c.G - 64;
    for (int u = (c.bid >= boff && c.bid < boff + 32) ? c.bid - boff : ((c.bid < 32 || c.bid >= 96) ? 32 + side : 32 + 512); u < 32 + 512; u = u < 32 ? 32 + 512 : u + nside) {
        int h, sl, nch, ch0, row0, ntok; const float* sp = nullptr; float* op;
        if (u < 32) { const int b = u >> 4; h = (u >> 2) & 3; sl = u & 3; nch = 64; ch0 = (b * 4 + h) * 64; row0 = b * PS; ntok = 64; op = outP + (size_t)(b * 4 + h) * 32768; }
        else { const int s = u - 32, sq = s >> 4; h = (s >> 2) & 3; sl = s & 3; nch = 1; ch0 = 512 + sq * 4 + h; row0 = MP + sq * SS; ntok = SS; sp = s0 + (size_t)(sq * 4 + h) * 32768; op = outS + (size_t)(sq * 4 + h) * 32768; }
        f32x4 acc[4];
#pragma unroll
        for (int vb = 0; vb < 4; ++vb)
#pragma unroll
            for (int jj = 0; jj < 4; ++jj) acc[vb][jj] = sp ? sp[(size_t)(w * 16 + q * 4 + jj) * 256 + sl * 64 + vb * 16 + r] : 0.f;
        GlaStage R0, R1, R2;
        gla_stage_load(R0, QD, KHT, EE, VT, GC, ch0, sl, tid);
        if (1 < nch) gla_stage_load(R1, QD, KHT, EE, VT, GC, ch0 + 1, sl, tid);
        if (2 < nch) gla_stage_load(R2, QD, KHT, EE, VT, GC, ch0 + 2, sl, tid);
        __syncthreads();
        gla_stage_store(R0, stg, tid);
        if (3 < nch) gla_stage_load(R0, QD, KHT, EE, VT, GC, ch0 + 3, sl, tid);
#define GLA_STEP(ci, RN) do { \
            LAS bf16_t* Tb = T_l + ((ci) & 1) * 64 * 136; const LAS bf16_t* sb = stg + ((ci) & 1) * GS_EL; \
            _Pragma("unroll") for (int vb = 0; vb < 4; ++vb) { u32x2 o; o.x = pk2(acc[vb][0], acc[vb][1]); o.y = pk2(acc[vb][2], acc[vb][3]); *(LAS u32x2*)(Tb + (vb * 16 + r) * 136 + w * 16 + q * 4) = o; } \
            __syncthreads(); \
            if ((ci) + 1 < nch) { gla_stage_store(RN, stg + (((ci) + 1) & 1) * GS_EL, tid); if ((ci) + 4 < nch) gla_stage_load(RN, QD, KHT, EE, VT, GC, ch0 + (ci) + 4, sl, tid); } \
            { const int rb = w >> 1, t = rb * 16 + r; bf16x8 qf[4], ef[2]; \
              _Pragma("unroll") for (int ks = 0; ks < 4; ++ks) qf[ks] = *(const LAS bf16x8*)(sb + (rb * 16 + r) * 136 + ks * 32 + q * 8); \
              _Pragma("unroll") for (int ks = 0; ks < 2; ++ks) ef[ks] = *(const LAS bf16x8*)(sb + GS_E + (rb * 16 + r) * 72 + ks * 32 + q * 8); \
              bf16x8 tf[2][4], vf[2][2]; \
              _Pragma("unroll") for (int e2 = 0; e2 < 2; ++e2) { const int cb = (w & 1) * 2 + e2; \
                  _Pragma("unroll") for (int ks = 0; ks < 4; ++ks) tf[e2][ks] = *(const LAS bf16x8*)(Tb + (cb * 16 + r) * 136 + ks * 32 + q * 8); \
                  _Pragma("unroll") for (int ks = 0; ks < 2; ++ks) vf[e2][ks] = *(const LAS bf16x8*)(sb + GS_VT + (cb * 16 + r) * 72 + ks * 32 + q * 8); } \
              __builtin_amdgcn_sched_barrier(0); \
              _Pragma("unroll") for (int e2 = 0; e2 < 2; ++e2) { const int cb = (w & 1) * 2 + e2; f32x4 y = (f32x4){0.f, 0.f, 0.f, 0.f}; \
                  _Pragma("unroll") for (int ks = 0; ks < 4; ++ks) y = mma16(tf[e2][ks], qf[ks], y); \
                  _Pragma("unroll") for (int ks = 0; ks < 2; ++ks) y = mma16(vf[e2][ks], ef[ks], y); \
                  if (t < ntok) { u32x2 o; o.x = pk2(y[0], y[1]); o.y = pk2(y[2], y[3]); *(u32x2*)(OB + (size_t)(row0 + (ci) * 64 + t) * BW + h * 256 + sl * 64 + cb * 16 + q * 4) = o; } } } \
            { const f32x4 gcv = *(const LAS f32x4*)((const LAS float*)(sb + GS_GC) + w * 16 + q * 4); bf16x8 kf[2]; \
              _Pragma("unroll") for (int ks = 0; ks < 2; ++ks) kf[ks] = *(const LAS bf16x8*)(sb + GS_KH + (w * 16 + r) * 72 + ks * 32 + q * 8); \
              bf16x8 vs[4][2]; \
              _Pragma("unroll") for (int vb = 0; vb < 4; ++vb) _Pragma("unroll") for (int ks = 0; ks < 2; ++ks) vs[vb][ks] = *(const LAS bf16x8*)(sb + GS_VT + (vb * 16 + r) * 72 + ks * 32 + q * 8); \
              __builtin_amdgcn_sched_barrier(0); \
              _Pragma("unroll") for (int vb = 0; vb < 4; ++vb) { acc[vb] = acc[vb] * gcv; \
                  _Pragma("unroll") for (int ks = 0; ks < 2; ++ks) acc[vb] = mma16(kf[ks], vs[vb][ks], acc[vb]); } } \
        } while (0)
#pragma unroll 1
        for (int ci = 0; ci < nch; ci += 3) {
            GLA_STEP(ci, R1);
            if (ci + 1 < nch) GLA_STEP(ci + 1, R2);
            if (ci + 2 < nch) GLA_STEP(ci + 2, R0);
        }
#undef GLA_STEP
#pragma unroll
        for (int vb = 0; vb < 4; ++vb)
#pragma unroll
            for (int jj = 0; jj < 4; ++jj) op[(size_t)(w * 16 + q * 4 + jj) * 256 + sl * 64 + vb * 16 + r] = acc[vb][jj];
        __syncthreads();
    }
}
__device__ __forceinline__ void ph_gla_fin(const Ctx& c, const bf16_t* __restrict__ U, const float* __restrict__ ng, const float* __restrict__ nb, const bf16_t* __restrict__ RAW, bf16_t* __restrict__ OB) {
    const int lane = c.lane;
    for (int i = c.bid * 8 + c.wave; i < MT * 4; i += c.G * 8) {
        const int row = i >> 2, h = i & 3, cc = h * 256 + lane * 4; bf16_t* p = OB + (size_t)row * BW + cc;
        const u32x2 raw = *(const u32x2*)(RAW + (size_t)row * BW + cc); float x[4] = {__uint_as_float(raw.x << 16), __uint_as_float(raw.x & 0xffff0000u), __uint_as_float(raw.y << 16), __uint_as_float(raw.y & 0xffff0000u)};
        const float mean = wave_sum((x[0] + x[1]) + (x[2] + x[3])) * (1.0f / 256.0f); float qq = 0.f;
#pragma unroll
        for (int j = 0; j < 4; ++j) { const float d = x[j] - mean; qq += d * d; }
        const float rstd = rsqrtf(wave_sum(qq) * (1.0f / 256.0f) + 1e-5f);
        const u32x2 gp = *(const u32x2*)(U + (size_t)row * NINP + U_GR + cc); const float gr[4] = {__uint_as_float(gp.x << 16), __uint_as_float(gp.x & 0xffff0000u), __uint_as_float(gp.y << 16), __uint_as_float(gp.y & 0xffff0000u)};
        const f32x4 gg = *(const f32x4*)(ng + cc), bb = *(const f32x4*)(nb + cc); float o[4];
#pragma unroll
        for (int j = 0; j < 4; ++j) o[j] = ((x[j] - mean) * rstd * gg[j] + bb[j]) * gr[j] * sigmoidf_(gr[j]);
        u32x2 ov; ov.x = pk2(o[0], o[1]); ov.y = pk2(o[2], o[3]); *(u32x2*)p = ov;
    }
}

template <bool ISBF> __device__ __forceinline__ void swa_step(const float (&q)[32], float (&acc)[32], float& m, float& l, const void* kp, const void* vp, float slope, float dist) {
    float s = 0.f;
#pragma unroll
    for (int j = 0; j < 4; ++j) { float x[8];
        if (ISBF) unpack8(*(const u32x4*)((const bf16_t*)kp + j * 8), x);
        else { const f32x4 a = *(const f32x4*)((const float*)kp + j * 8), b = *(const f32x4*)((const float*)kp + j * 8 + 4); x[0] = a[0]; x[1] = a[1]; x[2] = a[2]; x[3] = a[3]; x[4] = b[0]; x[5] = b[1]; x[6] = b[2]; x[7] = b[3]; }
#pragma unroll
        for (int d = 0; d < 8; ++d) s += q[j * 8 + d] * x[d]; }
    s += __shfl_xor(s, 1, 64);
    s = s * 0.125f - slope * dist;
    const float mn = fmaxf(m, s), cc = __expf(m - mn), p = __expf(s - mn);
    l = l * cc + p;
#pragma unroll
    for (int j = 0; j < 4; ++j) { float x[8];
        if (ISBF) unpack8(*(const u32x4*)((const bf16_t*)vp + j * 8), x);
        else { const f32x4 a = *(const f32x4*)((const float*)vp + j * 8), b = *(const f32x4*)((const float*)vp + j * 8 + 4); x[0] = a[0]; x[1] = a[1]; x[2] = a[2]; x[3] = a[3]; x[4] = b[0]; x[5] = b[1]; x[6] = b[2]; x[7] = b[3]; }
#pragma unroll
        for (int d = 0; d < 8; ++d) acc[j * 8 + d] = acc[j * 8 + d] * cc + p * x[d]; }
    m = mn;
}
__device__ __forceinline__ void ph_swa_naive(const Ctx& c, const bf16_t* __restrict__ U, const float* __restrict__ ck, const float* __restrict__ cv, const float* __restrict__ sinks, bf16_t* __restrict__ OB) {
    for (int gid = c.bid * 512 + c.tid; gid < MS * 32; gid += c.G * 512) {
        const int dh = gid & 1, h = (gid >> 1) & 15, row = MP + (gid >> 5), kvh = h >> 3, co = kvh * 64 + dh * 32;
        float q[32], acc[32];
#pragma unroll
        for (int j = 0; j < 4; ++j) { float x[8]; unpack8(*(const u32x4*)(U + (size_t)row * NINP + U_SQ + h * 64 + dh * 32 + j * 8), x);
#pragma unroll
            for (int d = 0; d < 8; ++d) { q[j * 8 + d] = x[d]; acc[j * 8 + d] = 0.f; } }
        const float slope = exp2f(-0.5f * (float)(h + 1)); float m = sinks[h], l = 1.0f;
        if (row < MP) {
            const int t = row % PS, base = row - t, lo = t - 128 < 0 ? 0 : t - 128;
            for (int s = lo; s <= t; ++s) { const bf16_t* ur = U + (size_t)(base + s) * NINP;
                swa_step<true>(q, acc, m, l, ur + U_SK + co, ur + U_SV + co, slope, (float)(t - s)); }
        } else {
            const int sq = (row - MP) / SS, i = (row - MP) % SS;
            for (int idx = i; idx <= 128 + i; ++idx) {
                if (idx < 128) { const size_t o = ((size_t)sq * 128 + idx) * 128 + co; swa_step<false>(q, acc, m, l, ck + o, cv + o, slope, (float)(128 + i - idx)); }
                else { const bf16_t* ur = U + (size_t)(MP + sq * SS + idx - 128) * NINP; swa_step<true>(q, acc, m, l, ur + U_SK + co, ur + U_SV + co, slope, (float)(128 + i - idx)); }
            }
        }
        const float inv = 1.0f / l; bf16_t* op = OB + (size_t)row * BW + h * 64 + dh * 32;
#pragma unroll
        for (int j = 0; j < 4; ++j) { u32x4 w; w.x = pk2(acc[j * 8] * inv, acc[j * 8 + 1] * inv); w.y = pk2(acc[j * 8 + 2] * inv, acc[j * 8 + 3] * inv);
            w.z = pk2(acc[j * 8 + 4] * inv, acc[j * 8 + 5] * inv); w.w = pk2(acc[j * 8 + 6] * inv, acc[j * 8 + 7] * inv); *(u32x4*)(op + j * 8) = w; }
    }
}

__device__ __forceinline__ void ph_rwkv_prep(const Ctx& c, const bf16_t* __restrict__ U, const float* __restrict__ shift, const float* __restrict__ mu, const float* __restrict__ w0, const float* __restrict__ w2,
                                             const float* __restrict__ a0, const float* __restrict__ a2, const float* __restrict__ g2, const float* __restrict__ k_k, const float* __restrict__ k_a,
                                             const float* __restrict__ r_k, float* __restrict__ RW) {
    LAS float* xm = (LAS float*)c.lds; LAS float* tw = xm + RWC; LAS float* ad = tw + 64; LAS float* sg = ad + 64;
    const int tid = c.tid;
    float* R = RW; float* WD = RW + (size_t)MPAD * BW; float* K2 = WD + (size_t)MPAD * BW; float* V = K2 + (size_t)MPAD * BW; float* KK = V + (size_t)MPAD * BW;
    float* BV = KK + (size_t)MPAD * BW; float* G = BV + (size_t)MPAD * BW; float* BON = G + (size_t)MPAD * BW;
    for (int row = c.bid; row < MT; row += c.G) {
        const bf16_t* ur = U + (size_t)row * NINP + U_RU; const bf16_t* pr = ur - NINP; const float* ps = nullptr; bool first;
        if (row < MP) first = (row % PS) == 0; else { first = ((row - MP) % SS) == 0; ps = shift + (size_t)((row - MP) / SS) * RWC; }
        for (int cc = tid; cc < RWC; cc += 512) { const float x = bf2f(ur[cc]); const float s = first ? (ps ? ps[cc] : 0.f) : bf2f(pr[cc]); xm[cc] = x + (s - x) * mu[cc]; }
        __syncthreads();
        if (tid < 64) { tw[tid] = tanhf(xm[3072 + tid]); ad[tid] = xm[3136 + tid]; }
        if (tid >= 128 && tid < 256) sg[tid - 128] = sigmoidf_(xm[3200 + tid - 128]);
        __syncthreads();
        for (int qd = 0; qd < 2; ++qd) {
            const int cc = qd * 512 + tid; float accw = w0[cc], acca = a0[cc], accg = 0.f;
#pragma unroll 4
            for (int j = 0; j < 64; ++j) { accw += tw[j] * w2[j * BW + cc]; acca += ad[j] * a2[j * BW + cc]; }
#pragma unroll 4
            for (int j = 0; j < 128; ++j) accg += sg[j] * g2[j * BW + cc];
            const float lw = -softplusf_(-accw) - 0.5f, decay = __expf(-__expf(lw)), a = sigmoidf_(acca);
            const float r = xm[cc], k = xm[1024 + cc], v = xm[2048 + cc];
            const float kkr = k * k_k[cc]; const float ss = wave_sum(kkr * kkr); const float kk = kkr / fmaxf(sqrtf(ss), 1e-12f);
            const float k2 = k * (1.0f + (a - 1.0f) * k_a[cc]); const float rk = wave_sum(r * k2 * r_k[cc]);
            const size_t o = (size_t)row * BW + cc;
            R[o] = r; WD[o] = decay; K2[o] = k2; V[o] = v; KK[o] = kk; BV[o] = kk * a; G[o] = accg; BON[o] = rk * v;
        }
        __syncthreads();
    }
}
__device__ __forceinline__ int kperm_pos(int k) { return (k & ~31) + 8 * ((k >> 2) & 3) + 4 * ((k >> 4) & 1) + (k & 3); }
__device__ __forceinline__ void ph_swa_prompt(const Ctx& c, const bf16_t* __restrict__ U, const float* __restrict__ sinks, bf16_t* __restrict__ OB) {
    LAS bf16_t* K_l = (LAS bf16_t*)c.lds;
    LAS bf16_t* VT_l = K_l + 192 * 72;
    const int tid = c.tid, lane = c.lane, r = lane & 15, q = lane >> 4, w = c.wave;
    for (int u = c.bid; u < PB * 64 * 2; u += c.G) {
        const int b = u >> 7, qb = (u >> 1) & 63, kvh = u & 1, h = kvh * 8 + w;
        const int tok0 = qb * 64 - 128;
        const size_t seq0 = (size_t)b * PS;
        for (int idx = tid; idx < 192 * 8; idx += 512) { const int kl = idx >> 3, c8 = idx & 7, tk = tok0 + kl; u32x4 kv = (u32x4){0u, 0u, 0u, 0u}, vv = kv;
            if (tk >= 0) { const bf16_t* ur = U + (seq0 + tk) * NINP; kv = *(const u32x4*)(ur + U_SK + kvh * 64 + c8 * 8); vv = *(const u32x4*)(ur + U_SV + kvh * 64 + c8 * 8); }
            *(LAS u32x4*)(K_l + kl * 72 + c8 * 8) = kv;
            const int kp = kperm_pos(kl); LAS bf16_t* vp = VT_l + (c8 * 8) * 200 + kp;
            vp[0] = (bf16_t)(vv.x & 0xffffu); vp[200] = (bf16_t)(vv.x >> 16); vp[400] = (bf16_t)(vv.y & 0xffffu); vp[600] = (bf16_t)(vv.y >> 16);
            vp[800] = (bf16_t)(vv.z & 0xffffu); vp[1000] = (bf16_t)(vv.z >> 16); vp[1200] = (bf16_t)(vv.w & 0xffffu); vp[1400] = (bf16_t)(vv.w >> 16); }
        __syncthreads();
        const float slope = exp2f(-0.5f * (float)(h + 1)), sink = sinks[h];
#pragma unroll 1
        for (int i = 0; i < 4; ++i) {
            const size_t qrow = seq0 + qb * 64 + i * 16 + r;
            const bf16x8 qf0 = *(const bf16x8*)(U + qrow * NINP + U_SQ + h * 64 + q * 8), qf1 = *(const bf16x8*)(U + qrow * NINP + U_SQ + h * 64 + 32 + q * 8);
            const int kt0 = i & ~1;
            f32x4 s[10]; float mx = sink; bf16x8 kfr[5][2];
#pragma unroll
            for (int kt = 0; kt < 10; ++kt) { f32x4 d;
                if (kt % 5 == 0) {
#pragma unroll
                    for (int k5 = 0; k5 < 5; ++k5) { const LAS bf16_t* kp = K_l + ((kt0 + kt + k5) * 16 + r) * 72 + q * 8; kfr[k5][0] = *(const LAS bf16x8*)kp; kfr[k5][1] = *(const LAS bf16x8*)(kp + 32); }
                    __builtin_amdgcn_sched_barrier(0); }
                d = mma16(kfr[kt % 5][0], qf0, (f32x4){0.f, 0.f, 0.f, 0.f}); d = mma16(kfr[kt % 5][1], qf1, d);
#pragma unroll
                for (int jj = 0; jj < 4; ++jj) { const int kl = (kt0 + kt) * 16 + q * 4 + jj, dist = i * 16 + r + 128 - kl;
                    const float v = (dist >= 0 && dist <= 128 && tok0 + kl >= 0) ? d[jj] * 0.125f - slope * (float)dist : -1e30f; d[jj] = v; mx = fmaxf(mx, v); }
                s[kt] = d; }
            mx = fmaxf(mx, __shfl_xor(mx, 16, 64)); mx = fmaxf(mx, __shfl_xor(mx, 32, 64));
            float sum = 0.f; bf16x8 pf[5];
#pragma unroll
            for (int kp = 0; kp < 5; ++kp) { f32x4 a = s[2 * kp], bq = s[2 * kp + 1];
#pragma unroll
                for (int jj = 0; jj < 4; ++jj) { a[jj] = __expf(a[jj] - mx); bq[jj] = __expf(bq[jj] - mx); sum += a[jj] + bq[jj]; }
                pf[kp] = pack_acc(a, bq); }
            sum += __shfl_xor(sum, 16, 64); sum += __shfl_xor(sum, 32, 64);
            const float inv = 1.0f / (sum + __expf(sink - mx));
            bf16_t* op = OB + qrow * BW + h * 64 + q * 4;
#pragma unroll
            for (int dt = 0; dt < 4; ++dt) { f32x4 o = (f32x4){0.f, 0.f, 0.f, 0.f}; bf16x8 vfr[5];
#pragma unroll
                for (int kp = 0; kp < 5; ++kp) vfr[kp] = *(const LAS bf16x8*)(VT_l + (dt * 16 + r) * 200 + (kt0 + 2 * kp) * 16 + q * 8);
                __builtin_amdgcn_sched_barrier(0);
#pragma unroll
                for (int kp = 0; kp < 5; ++kp) o = mma16(vfr[kp], pf[kp], o);
                u32x2 ov; ov.x = pk2(o[0] * inv, o[1] * inv); ov.y = pk2(o[2] * inv, o[3] * inv); *(u32x2*)(op + dt * 16) = ov; }
        }
        __syncthreads();
    }
}

__device__ __forceinline__ void ph_swa_sample(const Ctx& c, const bf16_t* __restrict__ U, const float* __restrict__ ck, const float* __restrict__ cv, const float* __restrict__ sinks, bf16_t* __restrict__ OB) {
    LAS bf16_t* K_l = (LAS bf16_t*)c.lds;
    LAS bf16_t* VT_l = K_l + 160 * 72;
    const int tid = c.tid, lane = c.lane, r = lane & 15, q = lane >> 4, w = c.wave;
    for (int u = c.bid; u < SB * 2; u += c.G) {
        const int sq = u >> 1, kvh = u & 1;
        for (int idx = tid; idx < 160 * 8; idx += 512) { const int kl = idx >> 3, c8 = idx & 7; float kx[8], vx[8];
#pragma unroll
            for (int e = 0; e < 8; ++e) { kx[e] = 0.f; vx[e] = 0.f; }
            if (kl < 128) { const size_t o = ((size_t)sq * 128 + kl) * 128 + kvh * 64 + c8 * 8; const f32x4 a = *(const f32x4*)(ck + o), b2 = *(const f32x4*)(ck + o + 4), c2 = *(const f32x4*)(cv + o), d2 = *(const f32x4*)(cv + o + 4);
                kx[0] = a[0]; kx[1] = a[1]; kx[2] = a[2]; kx[3] = a[3]; kx[4] = b2[0]; kx[5] = b2[1]; kx[6] = b2[2]; kx[7] = b2[3];
                vx[0] = c2[0]; vx[1] = c2[1]; vx[2] = c2[2]; vx[3] = c2[3]; vx[4] = d2[0]; vx[5] = d2[1]; vx[6] = d2[2]; vx[7] = d2[3]; }
            else if (kl < 132) { const bf16_t* ur = U + (size_t)(MP + sq * SS + kl - 128) * NINP; unpack8(*(const u32x4*)(ur + U_SK + kvh * 64 + c8 * 8), kx); unpack8(*(const u32x4*)(ur + U_SV + kvh * 64 + c8 * 8), vx); }
            *(LAS u32x4*)(K_l + kl * 72 + c8 * 8) = (u32x4){pk2(kx[0], kx[1]), pk2(kx[2], kx[3]), pk2(kx[4], kx[5]), pk2(kx[6], kx[7])};
            LAS bf16_t* vp = VT_l + (c8 * 8) * 168 + kperm_pos(kl);
#pragma unroll
            for (int e = 0; e < 8; ++e) vp[e * 168] = f2bf(vx[e]); }
        __syncthreads();
        if (w < 2) {
            const int h = kvh * 8 + w * 4 + (r >> 2), tk = r & 3; const size_t qrow = (size_t)(MP + sq * SS + tk);
            const float slope = exp2f(-0.5f * (float)(h + 1)), sink = sinks[h];
            const bf16x8 qf0 = *(const bf16x8*)(U + qrow * NINP + U_SQ + h * 64 + q * 8), qf1 = *(const bf16x8*)(U + qrow * NINP + U_SQ + h * 64 + 32 + q * 8);
            f32x4 s[10]; float mx = sink;
#pragma unroll
            for (int kt = 0; kt < 10; ++kt) { const LAS bf16_t* kp = K_l + (kt * 16 + r) * 72 + q * 8;
                f32x4 d = mma16(*(const LAS bf16x8*)kp, qf0, (f32x4){0.f, 0.f, 0.f, 0.f}); d = mma16(*(const LAS bf16x8*)(kp + 32), qf1, d);
#pragma unroll
                for (int jj = 0; jj < 4; ++jj) { const int kl = kt * 16 + q * 4 + jj, dist = 128 + tk - kl;
                    const float v = (dist >= 0 && dist <= 128) ? d[jj] * 0.125f - slope * (float)dist : -1e30f; d[jj] = v; mx = fmaxf(mx, v); }
                s[kt] = d; }
            mx = fmaxf(mx, __shfl_xor(mx, 16, 64)); mx = fmaxf(mx, __shfl_xor(mx, 32, 64));
            float sum = 0.f; bf16x8 pf[5];
#pragma unroll
            for (int kp = 0; kp < 5; ++kp) { f32x4 a = s[2 * kp], bq = s[2 * kp + 1];
#pragma unroll
                for (int jj = 0; jj < 4; ++jj) { a[jj] = __expf(a[jj] - mx); bq[jj] = __expf(bq[jj] - mx); sum += a[jj] + bq[jj]; }
                pf[kp] = pack_acc(a, bq); }
            sum += __shfl_xor(sum, 16, 64); sum += __shfl_xor(sum, 32, 64);
            const float inv = 1.0f / (sum + __expf(sink - mx));
            bf16_t* op = OB + qrow * BW + h * 64 + q * 4;
#pragma unroll
            for (int dt = 0; dt < 4; ++dt) { f32x4 o = (f32x4){0.f, 0.f, 0.f, 0.f};
#pragma unroll
                for (int kp = 0; kp < 5; ++kp) o = mma16(*(const LAS bf16x8*)(VT_l + (dt * 16 + r) * 168 + kp * 32 + q * 8), pf[kp], o);
                u32x2 ov; ov.x = pk2(o[0] * inv, o[1] * inv); ov.y = pk2(o[2] * inv, o[3] * inv); *(u32x2*)(op + dt * 16) = ov; }
        }
        __syncthreads();
    }
}

__device__ __forceinline__ void ph_memattn_prompt(const Ctx& c, const bf16_t* __restrict__ U, const bf16_t* __restrict__ MKB, const bf16_t* __restrict__ MVT, bf16_t* __restrict__ OB) {
    LAS bf16_t* buf = (LAS bf16_t*)c.lds;
    const int tid = c.tid, lane = c.lane, r = lane & 15, q = lane >> 4, w = c.wave;
    for (int u = c.bid; u < PB * 4 * 32; u += c.G) {
        const int b = u >> 7, h = (u >> 5) & 3, qb = u & 31;
        const size_t qrow = (size_t)b * PS + qb * 128 + w * 16 + r;
        const bf16_t* kg = MKB + (size_t)(b * 256) * 1024 + h * 256;
        const bf16_t* vg = MVT + (size_t)(b * 4 + h) * 65536;
        const bf16_t* qg = U + qrow * NINP + U_MQ + h * 256 + q * 8;
        bf16x8 qn0 = *(const bf16x8*)qg, qn1 = *(const bf16x8*)(qg + 32);
        u32x4 st[4];
#pragma unroll
        for (int i = 0; i < 4; ++i) { const int p = tid + 512 * i; st[i] = *(const u32x4*)(kg + (size_t)(p >> 3) * 1024 + (p & 7) * 8); }
        f32x4 s[16];
#pragma unroll
        for (int mt = 0; mt < 16; ++mt) s[mt] = (f32x4){0.f, 0.f, 0.f, 0.f};
        __syncthreads();
#pragma unroll 1
        for (int ck = 0; ck < 4; ++ck) {
            LAS bf16_t* kb = buf + (ck & 1) * 18432;
#pragma unroll
            for (int i = 0; i < 4; ++i) { const int p = tid + 512 * i; *(LAS u32x4*)(kb + (p >> 3) * 72 + (p & 7) * 8) = st[i]; }
            __syncthreads();
            const bf16x8 qc0 = qn0, qc1 = qn1;
            if (ck < 3) { qn0 = *(const bf16x8*)(qg + (ck + 1) * 64); qn1 = *(const bf16x8*)(qg + (ck + 1) * 64 + 32);
#pragma unroll
                for (int i = 0; i < 4; ++i) { const int p = tid + 512 * i; st[i] = *(const u32x4*)(kg + (size_t)(p >> 3) * 1024 + (ck + 1) * 64 + (p & 7) * 8); } }
#pragma unroll
            for (int m2 = 0; m2 < 16; m2 += 2) { bf16x8 kf[2][2];
#pragma unroll
                for (int j = 0; j < 2; ++j) { kf[j][0] = *(const LAS bf16x8*)(kb + ((m2 + j) * 16 + r) * 72 + q * 8); kf[j][1] = *(const LAS bf16x8*)(kb + ((m2 + j) * 16 + r) * 72 + 32 + q * 8); }
                __builtin_amdgcn_sched_barrier(0);
#pragma unroll
                for (int j = 0; j < 2; ++j) { s[m2 + j] = mma16(kf[j][0], qc0, s[m2 + j]); s[m2 + j] = mma16(kf[j][1], qc1, s[m2 + j]); } }
        }
#pragma unroll
        for (int i = 0; i < 4; ++i) { const int p = tid + 512 * i; st[i] = *(const u32x4*)(vg + (size_t)(p >> 5) * 256 + (p & 31) * 8); }
        float mx = -3.0e38f;
#pragma unroll
        for (int mt = 0; mt < 16; ++mt)
#pragma unroll
            for (int jj = 0; jj < 4; ++jj) { s[mt][jj] *= 0.0625f; mx = fmaxf(mx, s[mt][jj]); }
        mx = fmaxf(mx, __shfl_xor(mx, 16, 64)); mx = fmaxf(mx, __shfl_xor(mx, 32, 64));
        float sum = 0.f; bf16x8 pf[8];
#pragma unroll
        for (int kp = 0; kp < 8; ++kp) { f32x4 a = s[2 * kp], b2 = s[2 * kp + 1];
#pragma unroll
            for (int jj = 0; jj < 4; ++jj) { a[jj] = __expf(a[jj] - mx); b2[jj] = __expf(b2[jj] - mx); sum += a[jj] + b2[jj]; }
            pf[kp] = pack_acc(a, b2); }
        sum += __shfl_xor(sum, 16, 64); sum += __shfl_xor(sum, 32, 64);
        const float inv = 1.0f / sum;
        bf16_t* op = OB + qrow * BW + h * 256 + q * 4;
#pragma unroll 1
        for (int cv = 0; cv < 4; ++cv) {
            LAS bf16_t* vb = buf + (cv & 1) * 18432;
#pragma unroll
            for (int i = 0; i < 4; ++i) { const int p = tid + 512 * i, m0 = (p & 31) * 8; LAS bf16_t* d0 = vb + (p >> 5) * 264;
                *(LAS u32x2*)(d0 + kperm_pos(m0)) = (u32x2){st[i].x, st[i].y}; *(LAS u32x2*)(d0 + kperm_pos(m0 + 4)) = (u32x2){st[i].z, st[i].w}; }
            __syncthreads();
            if (cv < 3) {
#pragma unroll
                for (int i = 0; i < 4; ++i) { const int p = tid + 512 * i; st[i] = *(const u32x4*)(vg + (size_t)((cv + 1) * 64 + (p >> 5)) * 256 + (p & 31) * 8); } }
#pragma unroll
            for (int dt = 0; dt < 4; ++dt) { bf16x8 vf[8];
#pragma unroll
                for (int kp = 0; kp < 8; ++kp) vf[kp] = *(const LAS bf16x8*)(vb + (dt * 16 + r) * 264 + kp * 32 + q * 8);
                __builtin_amdgcn_sched_barrier(0);
                f32x4 o = (f32x4){0.f, 0.f, 0.f, 0.f};
#pragma unroll
                for (int kp = 0; kp < 8; ++kp) o = mma16(vf[kp], pf[kp], o);
                u32x2 ov; ov.x = pk2(o[0] * inv, o[1] * inv); ov.y = pk2(o[2] * inv, o[3] * inv); *(u32x2*)(op + (cv * 4 + dt) * 16) = ov; }
        }
        __syncthreads();
    }
}

__device__ __forceinline__ void ph_lrw(const Ctx& c, const float* __restrict__ w2, const float* __restrict__ a2, const float* __restrict__ g2, bf16_t* __restrict__ LRW) {
    for (int idx = c.bid * 512 + c.tid; idx < NL * 256 * 1024; idx += c.G * 512) {
        const int ch = idx & 1023, j = (idx >> 10) & 255, l = idx >> 18;
        const float v = j < 64 ? w2[((size_t)l * 64 + j) * BW + ch] : (j < 128 ? a2[((size_t)l * 64 + j - 64) * BW + ch] : g2[((size_t)l * 128 + j - 128) * BW + ch]);
        LRW[((size_t)l * 1024 + ch) * 256 + j] = f2bf(v);
    }
}
constexpr int RWP_UNITS = (MP / 64) * 4 + SB * 4;
__device__ __forceinline__ void rwp_unit_info(int u, int& row0, int& ntok, int& hg, int& sq, bool& seq_first) {
    if (u < (MP / 64) * 4) { const int blk = u >> 2; hg = u & 3; row0 = blk * 64; ntok = 64; sq = -1; seq_first = (row0 % PS) == 0; }
    else { const int s = u - (MP / 64) * 4; sq = s >> 2; hg = s & 3; row0 = MP + sq * SS; ntok = SS; seq_first = true; }
}
__device__ __forceinline__ void ph_rwkv_pre(const Ctx& c, const bf16_t* __restrict__ U, const float* __restrict__ shift, const float* __restrict__ mu, const float* __restrict__ w0, const float* __restrict__ w2,
                                            const float* __restrict__ a0, const float* __restrict__ a2, const float* __restrict__ g2, const float* __restrict__ k_k, const float* __restrict__ k_a,
                                            const float* __restrict__ r_k, float* __restrict__ RW, bf16_t* __restrict__ RB, const bf16_t* __restrict__ LRW) {
    LAS bf16_t* P_l = (LAS bf16_t*)c.lds; LAS bf16_t* Kn_l = P_l + 4608; LAS bf16_t* Bn_l = Kn_l + 4608; LAS bf16_t* Q_l = Bn_l + 4608;
    LAS bf16_t* PT_l = Q_l + 4608; LAS bf16_t* BhT_l = PT_l + 4608; LAS bf16_t* KhT_l = BhT_l + 4608; LAS bf16_t* VT_l = KhT_l + 4608;
    LAS float* A_l = (LAS float*)(c.lds + 73728);
    LAS bf16_t* BmT_l = (LAS bf16_t*)(c.lds + 78848); LAS bf16_t* F_l = (LAS bf16_t*)(c.lds + 81920); LAS bf16_t* Tinv_l = (LAS bf16_t*)(c.lds + 84992);
    LAS bf16_t* PpT_l = (LAS bf16_t*)(c.lds + 88064);
    LAS bf16_t* BmpT_l = (LAS bf16_t*)(c.lds + 97280);
    LAS float* GC_l = (LAS float*)(c.lds + 100352);
    LAS float* lg_l = (LAS float*)(c.lds + 125952);
    LAS bf16_t* act_l = (LAS bf16_t*)c.lds;
    LAS bf16_t* wT_l = act_l + 64 * 264;
    LAS bf16_t* aT_l = wT_l + 64 * 72;
    LAS bf16_t* gT_l = aT_l + 64 * 72;
    LAS float* pre_l = (LAS float*)(c.lds + 73728);
    const int tid = c.tid, lane = c.lane, r = lane & 15, q = lane >> 4, w = c.wave;
    bf16_t* Gg = (bf16_t*)(RW + 6 * (size_t)MPAD * BW); bf16_t* BON = (bf16_t*)(RW + 7 * (size_t)MPAD * BW);
    for (int u = c.bid; u < RWP_UNITS; u += c.G) {
        int row0, ntok, hg, sq; bool seq_first; rwp_unit_info(u, row0, ntok, hg, sq, seq_first);
        const float* sh = sq >= 0 ? shift + (size_t)sq * RWC : nullptr;
        const int nstage = ntok == 64 ? 64 : 16;
        for (int idx = tid; idx < nstage * 32; idx += 512) {
            const int t = idx >> 5, c8 = idx & 31, cc = 3072 + c8 * 8; float val[8];
#pragma unroll
            for (int e2 = 0; e2 < 8; ++e2) val[e2] = 0.f;
            if (t < ntok) { const bf16_t* ur = U + (size_t)(row0 + t) * NINP + U_RU; float x[8], p[8];
                unpack8(*(const u32x4*)(ur + cc), x);
                if (!(t == 0 && seq_first)) unpack8(*(const u32x4*)(ur + cc - NINP), p);
                else if (sh) { const f32x4 s0v = *(const f32x4*)(sh + cc), s1v = *(const f32x4*)(sh + cc + 4); p[0] = s0v[0]; p[1] = s0v[1]; p[2] = s0v[2]; p[3] = s0v[3]; p[4] = s1v[0]; p[5] = s1v[1]; p[6] = s1v[2]; p[7] = s1v[3]; }
                else {
#pragma unroll
                    for (int e2 = 0; e2 < 8; ++e2) p[e2] = 0.f; }
                const f32x4 m0 = *(const f32x4*)(mu + cc), m1 = *(const f32x4*)(mu + cc + 4);
#pragma unroll
                for (int e2 = 0; e2 < 8; ++e2) { const float xm = x[e2] + (p[e2] - x[e2]) * (e2 < 4 ? m0[e2] : m1[e2 - 4]); val[e2] = c8 < 8 ? tanh_fast(xm) : (c8 < 16 ? xm : sigmoidf_(xm)); } }
            *(LAS u32x4*)(act_l + t * 264 + c8 * 8) = (u32x4){pk2(val[0], val[1]), pk2(val[2], val[3]), pk2(val[4], val[5]), pk2(val[6], val[7])};
        }
        __syncthreads();
        bf16x8 af[8];
        { const int tb = w & 3;
#pragma unroll
          for (int ks = 0; ks < 8; ++ks) af[ks] = *(const LAS bf16x8*)(act_l + (tb * 16 + r) * 264 + ks * 32 + q * 8); }
        __syncthreads();
#pragma unroll 1
        for (int hh = 0; hh < 4; ++hh) { const int h = hg * 4 + hh;
        { const int tb = w & 3, chf = w >> 2;
          if (tb * 16 < nstage) {
#pragma unroll
            for (int e2 = 0; e2 < 2; ++e2) { const int cb = chf * 2 + e2; f32x4 dw = (f32x4){0.f, 0.f, 0.f, 0.f}, da = dw, dg = dw;
                const bf16_t* wr = LRW + ((size_t)h * 64 + cb * 16 + r) * 256 + q * 8; bf16x8 wf[8];
#pragma unroll
                for (int ks = 0; ks < 8; ++ks) wf[ks] = *(const bf16x8*)(wr + ks * 32);
                __builtin_amdgcn_sched_barrier(0);
#pragma unroll
                for (int ks = 0; ks < 2; ++ks) { dw = mma16(wf[ks], af[ks], dw); da = mma16(wf[2 + ks], af[2 + ks], da); }
#pragma unroll
                for (int ks = 0; ks < 4; ++ks) dg = mma16(wf[4 + ks], af[4 + ks], dg);
                const int o = (tb * 16 + r) * 68 + cb * 16 + q * 4;
                *(LAS f32x4*)(pre_l + o) = dw; *(LAS f32x4*)(pre_l + 64 * 68 + o) = da; *(LAS f32x4*)(pre_l + 2 * 64 * 68 + o) = dg; } } }
        __syncthreads();
        const int t = tid >> 3, cg = tid & 7, c0 = h * 64 + cg * 8, sc = t >> 4;
        float rr[8], k2[8], kap[8], bet[8], nlw[8];
        { float vx[8], gg[8], kkr[8]; float ss = 0.f, rk = 0.f;
          if (t < ntok) {
            const size_t row = (size_t)(row0 + t); const bf16_t* ur = U + row * NINP + U_RU; const bool fst = (t == 0 && seq_first);
            float kx[8];
#pragma unroll
            for (int part = 0; part < 3; ++part) { const int cc = part * 1024 + c0; float x[8], p[8];
                unpack8(*(const u32x4*)(ur + cc), x);
                if (!fst) unpack8(*(const u32x4*)(ur + cc - NINP), p);
                else {
#pragma unroll
                    for (int j = 0; j < 8; ++j) p[j] = sh ? sh[cc + j] : 0.f; }
                const f32x4 mA = *(const f32x4*)(mu + cc), mB = *(const f32x4*)(mu + cc + 4);
#pragma unroll
                for (int j = 0; j < 8; ++j) { const float xm = x[j] + (p[j] - x[j]) * (j < 4 ? mA[j] : mB[j - 4]); if (part == 0) rr[j] = xm; else if (part == 1) kx[j] = xm; else vx[j] = xm; } }
            float pw[8], pa[8], pkk[8], pka[8], prk[8];
#pragma unroll
            for (int hf = 0; hf < 2; ++hf) { const f32x4 v0 = *(const f32x4*)(w0 + c0 + hf * 4), v1 = *(const f32x4*)(a0 + c0 + hf * 4), v2 = *(const f32x4*)(k_k + c0 + hf * 4), v3 = *(const f32x4*)(k_a + c0 + hf * 4), v4 = *(const f32x4*)(r_k + c0 + hf * 4);
#pragma unroll
                for (int j = 0; j < 4; ++j) { pw[hf * 4 + j] = v0[j]; pa[hf * 4 + j] = v1[j]; pkk[hf * 4 + j] = v2[j]; pka[hf * 4 + j] = v3[j]; prk[hf * 4 + j] = v4[j]; } }
            float lwp[8], app[8];
#pragma unroll
            for (int hf = 0; hf < 2; ++hf) { const f32x4 v0 = *(const LAS f32x4*)(pre_l + t * 68 + cg * 8 + hf * 4), v1 = *(const LAS f32x4*)(pre_l + 64 * 68 + t * 68 + cg * 8 + hf * 4), v2 = *(const LAS f32x4*)(pre_l + 2 * 64 * 68 + t * 68 + cg * 8 + hf * 4);
#pragma unroll
                for (int j = 0; j < 4; ++j) { lwp[hf * 4 + j] = v0[j]; app[hf * 4 + j] = v1[j]; gg[hf * 4 + j] = v2[j]; } }
#pragma unroll
            for (int j = 0; j < 8; ++j) {
                const float lw = -softplus_fast(-(pw[j] + lwp[j])) - 0.5f; nlw[j] = -__expf(lw); const float av = sigmoidf_(pa[j] + app[j]);
                kkr[j] = kx[j] * pkk[j]; ss += kkr[j] * kkr[j]; k2[j] = kx[j] * (1.0f + (av - 1.0f) * pka[j]); rk += rr[j] * k2[j] * prk[j]; bet[j] = av; }
          } else {
#pragma unroll
            for (int j = 0; j < 8; ++j) { rr[j] = 0.f; k2[j] = 0.f; kkr[j] = 0.f; bet[j] = 0.f; nlw[j] = 0.f; vx[j] = 0.f; gg[j] = 0.f; }
          }
          ss += __shfl_xor(ss, 1, 64); ss += __shfl_xor(ss, 2, 64); ss += __shfl_xor(ss, 4, 64);
          rk += __shfl_xor(rk, 1, 64); rk += __shfl_xor(rk, 2, 64); rk += __shfl_xor(rk, 4, 64);
          const float inv = 1.0f / fmaxf(sqrtf(ss), 1e-12f);
#pragma unroll
          for (int j = 0; j < 8; ++j) { kap[j] = kkr[j] * inv; bet[j] = kap[j] * bet[j]; }
          if (t < ntok) { const size_t o = (size_t)(row0 + t) * BW + c0;
              *(u32x4*)(Gg + o) = (u32x4){pk2(gg[0], gg[1]), pk2(gg[2], gg[3]), pk2(gg[4], gg[5]), pk2(gg[6], gg[7])};
              *(u32x4*)(BON + o) = (u32x4){pk2(rk * vx[0], rk * vx[1]), pk2(rk * vx[2], rk * vx[3]), pk2(rk * vx[4], rk * vx[5]), pk2(rk * vx[6], rk * vx[7])}; }
          *(LAS f32x4*)(lg_l + t * 68 + cg * 8) = (f32x4){nlw[0], nlw[1], nlw[2], nlw[3]}; *(LAS f32x4*)(lg_l + t * 68 + cg * 8 + 4) = (f32x4){nlw[4], nlw[5], nlw[6], nlw[7]};
#pragma unroll
          for (int j = 0; j < 8; ++j) VT_l[(cg * 8 + j) * 72 + t] = f2bf(vx[j]);
        }
        __syncthreads();
        if (tid < 256) { const int cc = tid & 63, s4 = tid >> 6; float run = 0.f;
#pragma unroll
            for (int i = 0; i < 16; ++i) { const int o = (s4 * 16 + i) * 68 + cc; run += lg_l[o]; lg_l[o] = run; } }
        __syncthreads();
        { unsigned pp[4], pq[4], pk[4], pb[4];
#pragma unroll
          for (int j = 0; j < 8; j += 2) { float vP[2], vQ[2], vK[2], vB[2];
#pragma unroll
              for (int e = 0; e < 2; ++e) { const int jj = j + e, cc = cg * 8 + jj; const float ci = lg_l[t * 68 + cc], cC = lg_l[(sc * 16 + 15) * 68 + cc];
                  const float ei = __expf(-ci), eh = __expf(cC - ci);
                  vP[e] = kap[jj] * __expf(ci - nlw[jj]); vQ[e] = rr[jj] * __expf(ci); vK[e] = k2[jj] * ei; vB[e] = bet[jj] * ei;
                  PT_l[cc * 72 + t] = f2bf(vP[e]); BhT_l[cc * 72 + t] = f2bf(bet[jj] * eh); KhT_l[cc * 72 + t] = f2bf(k2[jj] * eh); }
              pp[j >> 1] = pk2(vP[0], vP[1]); pq[j >> 1] = pk2(vQ[0], vQ[1]); pk[j >> 1] = pk2(vK[0], vK[1]); pb[j >> 1] = pk2(vB[0], vB[1]); }
          const int o = t * 72 + cg * 8;
          *(LAS u32x4*)(P_l + o) = (u32x4){pp[0], pp[1], pp[2], pp[3]}; *(LAS u32x4*)(Q_l + o) = (u32x4){pq[0], pq[1], pq[2], pq[3]};
          *(LAS u32x4*)(Kn_l + o) = (u32x4){pk[0], pk[1], pk[2], pk[3]}; *(LAS u32x4*)(Bn_l + o) = (u32x4){pb[0], pb[1], pb[2], pb[3]};
          if ((t & 15) == 15) {
#pragma unroll
              for (int j = 0; j < 8; ++j) GC_l[sc * 64 + cg * 8 + j] = __expf(lg_l[t * 68 + cg * 8 + j]); } }
        __syncthreads();
        const int nsub = ntok == 64 ? 4 : 1;
        const bf16x8 zfrag = (bf16x8){0, 0, 0, 0, 0, 0, 0, 0};
        for (int id = w; id < nsub * 3; id += 8) { const int s4 = id / 3, prod = id - s4 * 3; f32x4 d = (f32x4){0.f, 0.f, 0.f, 0.f};
            const LAS bf16_t* X = (prod == 1 ? P_l : Bn_l) + (s4 * 16 + r) * 72 + q * 8; const LAS bf16_t* Y = (prod == 0 ? P_l : (prod == 1 ? Kn_l : Q_l)) + (s4 * 16 + r) * 72 + q * 8;
            { const bf16x8 x0 = *(const LAS bf16x8*)X, x1 = *(const LAS bf16x8*)(X + 32), y0 = *(const LAS bf16x8*)Y, y1 = *(const LAS bf16x8*)(Y + 32);
              __builtin_amdgcn_sched_barrier(0); d = mma16(x0, y0, d); d = mma16(x1, y1, d); }
            if (prod == 0) { f32x4 o4;
#pragma unroll
                for (int jj = 0; jj < 4; ++jj) o4[jj] = (q * 4 + jj < r) ? d[jj] : 0.f;
                *(LAS f32x4*)(A_l + s4 * 320 + r * 20 + q * 4) = o4; }
            else { float o4[4];
#pragma unroll
                for (int jj = 0; jj < 4; ++jj) o4[jj] = (prod == 1 ? (r < q * 4 + jj) : (q * 4 + jj <= r)) ? d[jj] : 0.f;
                u32x2 o; o.x = pk2(o4[0], o4[1]); o.y = pk2(o4[2], o4[3]); *(LAS u32x2*)((prod == 1 ? BmT_l : F_l) + s4 * 384 + r * 24 + q * 4) = o; } }
        __syncthreads();
        if (w == 0 && (lane >> 4) < nsub) { const int s4 = lane >> 4, jc = lane & 15; float x[16];
#pragma unroll
            for (int tt = 0; tt < 16; ++tt) { float s = (tt == jc) ? 1.f : 0.f;
#pragma unroll
                for (int i = 0; i < tt; ++i) s -= A_l[s4 * 320 + tt * 20 + i] * x[i];
                x[tt] = s; }
#pragma unroll
            for (int tt = 0; tt < 16; ++tt) Tinv_l[s4 * 384 + tt * 24 + jc] = f2bf(x[tt]); }
        __syncthreads();
        for (int id = w; id < nsub * 5; id += 8) { const int s4 = id / 5, rem = id - s4 * 5;
            const bf16x8 xf = q < 2 ? *(const LAS bf16x8*)(Tinv_l + s4 * 384 + r * 24 + q * 8) : zfrag;
            const bf16x8 yf = q < 2 ? (rem < 4 ? *(const LAS bf16x8*)(PT_l + (rem * 16 + r) * 72 + s4 * 16 + q * 8) : *(const LAS bf16x8*)(BmT_l + s4 * 384 + r * 24 + q * 8)) : zfrag;
            const f32x4 d = mma16(xf, yf, (f32x4){0.f, 0.f, 0.f, 0.f});
            u32x2 o; o.x = pk2(d[0], d[1]); o.y = pk2(d[2], d[3]);
            if (rem < 4) *(LAS u32x2*)(PpT_l + (rem * 16 + r) * 72 + s4 * 16 + q * 4) = o; else *(LAS u32x2*)(BmpT_l + s4 * 384 + r * 24 + q * 4) = o; }
        __syncthreads();
        { const int chunk0 = sq >= 0 ? PB * 16 * 256 + sq * 16 + h : ((row0 / PS) * 16 + h) * 256 + ((row0 % PS) >> 4);
          for (int id = w; id < nsub * 25; id += 8) { const int s4 = id / 25, rem = id - s4 * 25; bf16_t* blob = RB + (size_t)(chunk0 + s4) * RB_EL;
            const bf16x8 fF = q < 2 ? *(const LAS bf16x8*)(F_l + s4 * 384 + r * 24 + q * 8) : zfrag;
            if (rem < 4) {
                const bf16x8 xf = q < 2 ? *(const LAS bf16x8*)(PpT_l + (rem * 16 + r) * 72 + s4 * 16 + q * 8) : zfrag;
                const f32x4 d = mma16(xf, fF, (f32x4){0.f, 0.f, 0.f, 0.f});
                const u32x2 qv = *(const LAS u32x2*)(Q_l + (s4 * 16 + r) * 72 + rem * 16 + q * 4);
                u32x2 o; o.x = pk2(__uint_as_float(qv.x << 16) - d[0], __uint_as_float(qv.x & 0xffff0000u) - d[1]); o.y = pk2(__uint_as_float(qv.y << 16) - d[2], __uint_as_float(qv.y & 0xffff0000u) - d[3]);
                *(u32x2*)(blob + RB_QP + r * 72 + 32 * (rem >> 1) + 8 * q + 4 * (rem & 1)) = o;
            } else if (rem == 4) {
                f32x4 d2 = (f32x4){0.f, 0.f, 0.f, 0.f};
#pragma unroll
                for (int ks = 0; ks < 2; ++ks) d2 = mma16(*(const LAS bf16x8*)(Kn_l + (s4 * 16 + r) * 72 + ks * 32 + q * 8), *(const LAS bf16x8*)(Q_l + (s4 * 16 + r) * 72 + ks * 32 + q * 8), d2);
                const bf16x8 xf = q < 2 ? *(const LAS bf16x8*)(BmpT_l + s4 * 384 + r * 24 + q * 8) : zfrag;
                const f32x4 d1 = mma16(xf, fF, (f32x4){0.f, 0.f, 0.f, 0.f});
                float o4[4];
#pragma unroll
                for (int jj = 0; jj < 4; ++jj) o4[jj] = ((q * 4 + jj <= r) ? d2[jj] : 0.f) - d1[jj];
                u32x2 o; o.x = pk2(o4[0], o4[1]); o.y = pk2(o4[2], o4[3]); *(u32x2*)(blob + RB_EP + r * 24 + q * 4) = o;
            } else if (rem < 21) {
                const int cib = (rem - 5) >> 2, cob = (rem - 5) & 3;
                const bf16x8 xf = q < 2 ? *(const LAS bf16x8*)(PpT_l + (cib * 16 + r) * 72 + s4 * 16 + q * 8) : zfrag;
                const bf16x8 yf = q < 2 ? *(const LAS bf16x8*)(BhT_l + (cob * 16 + r) * 72 + s4 * 16 + q * 8) : zfrag;
                const f32x4 d = mma16(xf, yf, (f32x4){0.f, 0.f, 0.f, 0.f});
                const float gc = GC_l[s4 * 64 + cob * 16 + r]; float o4[4];
#pragma unroll
                for (int jj = 0; jj < 4; ++jj) o4[jj] = ((cib == cob && q * 4 + jj == r) ? gc : 0.f) - d[jj];
                u32x2 o; o.x = pk2(o4[0], o4[1]); o.y = pk2(o4[2], o4[3]); *(u32x2*)(blob + (cob * 16 + r) * 72 + 32 * (cib >> 1) + 8 * q + 4 * (cib & 1)) = o;
            } else {
                const int cb = rem - 21;
                const bf16x8 xf = q < 2 ? *(const LAS bf16x8*)(BmpT_l + s4 * 384 + r * 24 + q * 8) : zfrag;
                const bf16x8 yf = q < 2 ? *(const LAS bf16x8*)(BhT_l + (cb * 16 + r) * 72 + s4 * 16 + q * 8) : zfrag;
                const f32x4 d = mma16(xf, yf, (f32x4){0.f, 0.f, 0.f, 0.f});
                const u32x2 kv = *(const LAS u32x2*)(KhT_l + (cb * 16 + r) * 72 + s4 * 16 + q * 4);
                u32x2 o; o.x = pk2(__uint_as_float(kv.x << 16) - d[0], __uint_as_float(kv.x & 0xffff0000u) - d[1]); o.y = pk2(__uint_as_float(kv.y << 16) - d[2], __uint_as_float(kv.y & 0xffff0000u) - d[3]);
                *(u32x2*)(blob + RB_KHP + (cb * 16 + r) * 24 + q * 4) = o;
            } }
          for (int idx = tid; idx < nsub * 128; idx += 512) { const int s4 = idx >> 7, cc = (idx >> 1) & 63, hf = idx & 1;
              *(u32x4*)(RB + (size_t)(chunk0 + s4) * RB_EL + RB_VT + cc * 24 + hf * 8) = *(const LAS u32x4*)(VT_l + cc * 72 + s4 * 16 + hf * 8); } }
        __syncthreads();
        }
    }
}

__device__ __forceinline__ void ph_rwkv_scan_naive(const Ctx& c, const float* __restrict__ RW, const float* __restrict__ s0, const float* __restrict__ lng, const float* __restrict__ lnb, bf16_t* __restrict__ OB,
                                                   float* __restrict__ outP, float* __restrict__ outS) {
    const float* R = RW; const float* WD = RW + (size_t)MPAD * BW; const float* K2 = WD + (size_t)MPAD * BW; const float* V = K2 + (size_t)MPAD * BW; const float* KK = V + (size_t)MPAD * BW;
    const float* BV = KK + (size_t)MPAD * BW; const float* G = BV + (size_t)MPAD * BW; const float* BON = G + (size_t)MPAD * BW;
    const int lane = c.lane;
    for (int it = 0;; ++it) {
        const int u = (it * 8 + c.wave) * c.G + c.bid;
        if (u >= (PB + SB) * 16) break;
        const int sq = u >> 4, h = u & 15;
        int row0, L; seq_info(sq, row0, L);
        float S[64];
        if (sq >= PB) { const float* p = s0 + (((size_t)(sq - PB) * 16 + h) * 64 + lane) * 64;
#pragma unroll
            for (int j = 0; j < 64; ++j) S[j] = p[j]; }
        else {
#pragma unroll
            for (int j = 0; j < 64; ++j) S[j] = 0.f; }
        const float lg = lng[h * 64 + lane], lb = lnb[h * 64 + lane];
        for (int t = 0; t < L; ++t) {
            const size_t base = (size_t)(row0 + t) * BW + h * 64; const float v = V[base + lane];
            float d = 0.f;
#pragma unroll
            for (int j = 0; j < 64; ++j) d += S[j] * KK[base + j];
            float y = 0.f;
#pragma unroll
            for (int j = 0; j < 64; ++j) { S[j] = S[j] * WD[base + j] - d * BV[base + j] + v * K2[base + j]; y += S[j] * R[base + j]; }
            const float mean = wave_sum(y) * (1.0f / 64.0f), dy = y - mean, var = wave_sum(dy * dy) * (1.0f / 64.0f);
            const float yn = dy * rsqrtf(var + 64e-5f) * lg + lb;
            OB[base + lane] = f2bf((yn + BON[base + lane]) * G[base + lane]);
        }
        float* op = (sq < PB ? outP + (((size_t)sq * 16 + h) * 64 + lane) * 64 : outS + (((size_t)(sq - PB) * 16 + h) * 64 + lane) * 64);
#pragma unroll
        for (int j = 0; j < 64; ++j) op[j] = S[j];
    }
}
__device__ __forceinline__ void ph_rwkv_scan2(const Ctx& c, int boff, const float* __restrict__ RW, const float* __restrict__ s0, const float* __restrict__ lng, const float* __restrict__ lnb, bf16_t* __restrict__ OB,
                                              float* __restrict__ outP, float* __restrict__ outS) {
    LAS float* opb = (LAS float*)c.lds;
    LAS float* yb = opb + 2 * 16 * 384;
    const int tid = c.tid, lane = c.lane, w = c.wave, rl = lane >> 3, cg = lane & 7, vrow = w * 8 + rl;
    const float* G = RW + 6 * (size_t)MPAD * BW; const float* BON = RW + 7 * (size_t)MPAD * BW;
    for (int u = (c.bid - boff + c.G) % c.G; u < (PB + SB) * 16; u += c.G) {
        const int sq = u >> 4, h = u & 15;
        int row0, L; seq_info(sq, row0, L);
        float S[8];
        if (sq >= PB) { const float* p = s0 + (((size_t)(sq - PB) * 16 + h) * 64 + vrow) * 64 + cg * 8;
#pragma unroll
            for (int j = 0; j < 8; ++j) S[j] = p[j]; }
        else {
#pragma unroll
            for (int j = 0; j < 8; ++j) S[j] = 0.f; }
        const float lg = lng[h * 64 + lane], lb = lnb[h * 64 + lane];
        const int nb = (L + 15) >> 4;
#define RW_STAGE(bi_) do { const int t0_ = (bi_) * 16, nT_ = (L - t0_) < 16 ? (L - t0_) : 16; LAS float* dst_ = opb + ((bi_) & 1) * 16 * 384; \
        for (int idx = tid; idx < nT_ * 96; idx += 512) { const int t = idx / 96, rem = idx - t * 96, slot = rem >> 4, c4 = rem & 15; \
            const int arr = slot == 0 ? 1 : slot == 1 ? 4 : slot == 2 ? 5 : slot == 3 ? 2 : slot == 4 ? 0 : 3; \
            *(LAS f32x4*)(dst_ + t * 384 + slot * 64 + c4 * 4) = *(const f32x4*)(RW + (size_t)arr * MPAD * BW + (size_t)(row0 + t0_ + t) * BW + h * 64 + c4 * 4); } } while (0)
        RW_STAGE(0);
        for (int bi = 0; bi < nb; ++bi) {
            __syncthreads();
            if (bi + 1 < nb) RW_STAGE(bi + 1);
            const int t0 = bi * 16, nT = (L - t0) < 16 ? (L - t0) : 16; const LAS float* src = opb + (bi & 1) * 16 * 384;
            for (int tt = 0; tt < nT; ++tt) {
                const LAS float* b = src + tt * 384 + cg * 8;
                const f32x4 w0 = *(const LAS f32x4*)(b), w1 = *(const LAS f32x4*)(b + 4), k0 = *(const LAS f32x4*)(b + 64), k1 = *(const LAS f32x4*)(b + 68);
                const f32x4 b0 = *(const LAS f32x4*)(b + 128), b1 = *(const LAS f32x4*)(b + 132), q0 = *(const LAS f32x4*)(b + 192), q1 = *(const LAS f32x4*)(b + 196);
                const f32x4 r0 = *(const LAS f32x4*)(b + 256), r1 = *(const LAS f32x4*)(b + 260); const float v = src[tt * 384 + 320 + vrow];
                float d = (S[0] * k0[0] + S[1] * k0[1]) + (S[2] * k0[2] + S[3] * k0[3]) + (S[4] * k1[0] + S[5] * k1[1]) + (S[6] * k1[2] + S[7] * k1[3]);
                d += __shfl_xor(d, 1, 64); d += __shfl_xor(d, 2, 64); d += __shfl_xor(d, 4, 64);
                float y = 0.f;
#pragma unroll
                for (int j = 0; j < 4; ++j) { S[j] = S[j] * w0[j] - d * b0[j] + v * q0[j]; y += S[j] * r0[j]; S[4 + j] = S[4 + j] * w1[j] - d * b1[j] + v * q1[j]; y += S[4 + j] * r1[j]; }
                y += __shfl_xor(y, 1, 64); y += __shfl_xor(y, 2, 64); y += __shfl_xor(y, 4, 64);
                if (cg == 0) yb[tt * 64 + vrow] = y;
            }
            __syncthreads();
            for (int tt = w; tt < nT; tt += 8) {
                const float y = yb[tt * 64 + lane]; const float mean = wave_sum(y) * (1.0f / 64.0f), dy = y - mean, var = wave_sum(dy * dy) * (1.0f / 64.0f);
                const float yn = dy * rsqrtf(var + 64e-5f) * lg + lb; const size_t o = (size_t)(row0 + t0 + tt) * BW + h * 64 + lane;
                OB[o] = f2bf((yn + BON[o]) * G[o]);
            }
        }
#undef RW_STAGE
        float* op = (sq < PB ? outP + (((size_t)sq * 16 + h) * 64 + vrow) * 64 : outS + (((size_t)(sq - PB) * 16 + h) * 64 + vrow) * 64) + cg * 8;
#pragma unroll
        for (int j = 0; j < 8; ++j) op[j] = S[j];
        __syncthreads();
    }
}
constexpr int RS_SLOTS = 8, RS_SLOT_B = RB_EL * 2;
__device__ __forceinline__ void ph_rwkv_seq(const Ctx& c, int boff, const bf16_t* __restrict__ RB, const float* __restrict__ s0, float* __restrict__ outP, float* __restrict__ outS, bf16_t* __restrict__ OB) {
    const int lane = c.lane, r = lane & 15, q = lane >> 4, w = c.wave;
    LAS unsigned char* ring = c.lds;
    const int side = c.bid < 32 ? c.bid : c.bid - 64, nside = c.G - 64;
    for (int u = (c.bid >= boff && c.bid < boff + 32) ? c.bid - boff : ((c.bid < 32 || c.bid >= 96) ? 32 + side : (PB + SB) * 16); u < (PB + SB) * 16; u = u < 32 ? (PB + SB) * 16 : u + nside) {
        const int sq = u >> 4, h = u & 15;
        int nch, ch0, row0, ntok; const float* sp = nullptr; float* op;
        if (sq < PB) { nch = 256; ch0 = (sq * 16 + h) * 256; row0 = sq * PS; ntok = 16; op = outP + (size_t)(sq * 16 + h) * 4096; }
        else { nch = 1; ch0 = PB * 16 * 256 + (sq - PB) * 16 + h; row0 = MP + (sq - PB) * SS; ntok = SS; sp = s0 + (size_t)((sq - PB) * 16 + h) * 4096; op = outS + (size_t)((sq - PB) * 16 + h) * 4096; }
        if (w >= 4) {
            const int lw = w - 4, p0 = lw < 2 ? lw * 5 : 10 + (lw - 2) * 4, np = lw < 2 ? 5 : 4;
#define RS_ISSUE(ci_) do { const int cc_ = (ci_) < nch ? (ci_) : nch - 1; const char* g_ = (const char*)(RB + (size_t)(ch0 + cc_) * RB_EL) + p0 * 1024 + lane * 16; \
            LAS unsigned char* d_ = ring + ((ci_) % RS_SLOTS) * RS_SLOT_B + p0 * 1024; \
            _Pragma("unroll") for (int p_ = 0; p_ < 5; ++p_) if (p_ < np) __builtin_amdgcn_global_load_lds((const unsigned*)(g_ + p_ * 1024), (LAS unsigned*)(d_ + p_ * 1024), 16, 0, 0); } while (0)
            for (int ci = 0; ci < RS_SLOTS - 1; ++ci) RS_ISSUE(ci);
            if (lw < 2) asm volatile("s_waitcnt vmcnt(30)" ::: "memory"); else asm volatile("s_waitcnt vmcnt(24)" ::: "memory");
            __builtin_amdgcn_s_barrier();
            for (int ci = 0; ci < nch; ++ci) {
                RS_ISSUE(ci + RS_SLOTS - 1);
                if (lw < 2) asm volatile("s_waitcnt vmcnt(30)" ::: "memory"); else asm volatile("s_waitcnt vmcnt(24)" ::: "memory");
                __builtin_amdgcn_s_barrier();
            }
#undef RS_ISSUE
            asm volatile("s_waitcnt vmcnt(0)" ::: "memory");
        } else {
            const int vb = w; f32x4 acc[4];
#pragma unroll
            for (int kb = 0; kb < 4; ++kb) acc[kb] = sp ? *(const f32x4*)(sp + (size_t)(vb * 16 + r) * 64 + kb * 16 + q * 4) : (f32x4){0.f, 0.f, 0.f, 0.f};
            const bf16x8 zfrag = (bf16x8){0, 0, 0, 0, 0, 0, 0, 0};
            __builtin_amdgcn_s_barrier();
            for (int ci = 0; ci < nch; ++ci) {
                const LAS bf16_t* blob = (const LAS bf16_t*)(ring + (ci % RS_SLOTS) * RS_SLOT_B);
                bf16x8 mf[4][2], khf[4], qpf[2];
#pragma unroll
                for (int kb = 0; kb < 4; ++kb) { mf[kb][0] = *(const LAS bf16x8*)(blob + (kb * 16 + r) * 72 + q * 8); mf[kb][1] = *(const LAS bf16x8*)(blob + (kb * 16 + r) * 72 + 32 + q * 8);
                    khf[kb] = q < 2 ? *(const LAS bf16x8*)(blob + RB_KHP + (kb * 16 + r) * 24 + q * 8) : zfrag; }
                qpf[0] = *(const LAS bf16x8*)(blob + RB_QP + r * 72 + q * 8); qpf[1] = *(const LAS bf16x8*)(blob + RB_QP + r * 72 + 32 + q * 8);
                const bf16x8 vt = q < 2 ? *(const LAS bf16x8*)(blob + RB_VT + (vb * 16 + r) * 24 + q * 8) : zfrag;
                const bf16x8 ep = q < 2 ? *(const LAS bf16x8*)(blob + RB_EP + r * 24 + q * 8) : zfrag;
                const bf16x8 t0 = pack_acc(acc[0], acc[1]), t1 = pack_acc(acc[2], acc[3]);
                __builtin_amdgcn_sched_barrier(0);
#pragma unroll
                for (int kb = 0; kb < 4; ++kb) acc[kb] = mma16(mf[kb][0], t0, (f32x4){0.f, 0.f, 0.f, 0.f});
#pragma unroll
                for (int kb = 0; kb < 4; ++kb) acc[kb] = mma16(mf[kb][1], t1, acc[kb]);
#pragma unroll
                for (int kb = 0; kb < 4; ++kb) acc[kb] = mma16(khf[kb], vt, acc[kb]);
                f32x4 y = mma16(t0, qpf[0], (f32x4){0.f, 0.f, 0.f, 0.f}); y = mma16(t1, qpf[1], y); y = mma16(vt, ep, y);
                if (r < ntok) { u32x2 o; o.x = pk2(y[0], y[1]); o.y = pk2(y[2], y[3]); *(u32x2*)(OB + (size_t)(row0 + ci * 16 + r) * BW + h * 64 + vb * 16 + q * 4) = o; }
                asm volatile("s_waitcnt lgkmcnt(0)" ::: "memory");
                __builtin_amdgcn_s_barrier();
            }
#pragma unroll
            for (int kb = 0; kb < 4; ++kb) *(f32x4*)(op + (size_t)(vb * 16 + r) * 64 + kb * 16 + q * 4) = acc[kb];
        }
        __syncthreads();
    }
}
__device__ __forceinline__ void ph_rwkv_fin(const Ctx& c, const float* __restrict__ RW, const float* __restrict__ lng, const float* __restrict__ lnb, const bf16_t* __restrict__ RAW, bf16_t* __restrict__ OB) {
    const int lane = c.lane; const bf16_t* G = (const bf16_t*)(RW + 6 * (size_t)MPAD * BW); const bf16_t* BON = (const bf16_t*)(RW + 7 * (size_t)MPAD * BW);
    for (int i = c.bid * 8 + c.wave; i < MT * 4; i += c.G * 8) {
        const int row = i >> 2, cc = (i & 3) * 256 + lane * 4; const size_t o = (size_t)row * BW + cc; bf16_t* p = OB + o;
        const u32x2 raw = *(const u32x2*)(RAW + o); float x[4] = {__uint_as_float(raw.x << 16), __uint_as_float(raw.x & 0xffff0000u), __uint_as_float(raw.y << 16), __uint_as_float(raw.y & 0xffff0000u)};
        float s = (x[0] + x[1]) + (x[2] + x[3]); s += __shfl_xor(s, 1, 64); s += __shfl_xor(s, 2, 64); s += __shfl_xor(s, 4, 64); s += __shfl_xor(s, 8, 64);
        const float mean = s * (1.0f / 64.0f); float qq = 0.f;
#pragma unroll
        for (int j = 0; j < 4; ++j) { const float d = x[j] - mean; qq += d * d; }
        qq += __shfl_xor(qq, 1, 64); qq += __shfl_xor(qq, 2, 64); qq += __shfl_xor(qq, 4, 64); qq += __shfl_xor(qq, 8, 64);
        const float rstd = rsqrtf(qq * (1.0f / 64.0f) + 64e-5f);
        const f32x4 gg = *(const f32x4*)(lng + cc), bb = *(const f32x4*)(lnb + cc), bo = ld4bf(BON + o), gt = ld4bf(G + o); float ov[4];
#pragma unroll
        for (int j = 0; j < 4; ++j) ov[j] = ((x[j] - mean) * rstd * gg[j] + bb[j] + bo[j]) * gt[j];
        u32x2 oo; oo.x = pk2(ov[0], ov[1]); oo.y = pk2(ov[2], ov[3]); *(u32x2*)p = oo;
    }
}

__device__ __forceinline__ void ph_memattn_sample(const Ctx& c, int boff, const bf16_t* __restrict__ U, const float* __restrict__ mk, const float* __restrict__ mv, bf16_t* __restrict__ OB) {
    LAS float* ps = (LAS float*)c.lds;
    const int hh = c.tid >> 8, vt = c.tid & 255, lane = c.lane, r = lane & 15, q = lane >> 4, w4 = c.wave & 3;
    for (int u = (c.bid - boff + c.G) % c.G; u < SB * 2; u += c.G) {
        const int sq = u >> 1, h = (u & 1) * 2 + hh;
        bf16x8 qf[8];
#pragma unroll
        for (int ks = 0; ks < 8; ++ks) { u32x4 raw = (u32x4){0u, 0u, 0u, 0u};
            if (r < 4) raw = *(const u32x4*)(U + (size_t)(MP + sq * SS + r) * NINP + U_MQ + h * 256 + ks * 32 + q * 8);
            qf[ks] = __builtin_bit_cast(bf16x8, raw); }
#pragma unroll 1
        for (int mt = 0; mt < 4; ++mt) { const float* kr = mk + (((size_t)sq * MEMT + (w4 * 4 + mt) * 16 + r) * 4 + h) * 256 + q * 8; f32x4 ka[8], kb2[8];
#pragma unroll
            for (int ks = 0; ks < 8; ++ks) { ka[ks] = *(const f32x4*)(kr + ks * 32); kb2[ks] = *(const f32x4*)(kr + ks * 32 + 4); }
            __builtin_amdgcn_sched_barrier(0);
            f32x4 d = (f32x4){0.f, 0.f, 0.f, 0.f};
#pragma unroll
            for (int ks = 0; ks < 8; ++ks) { u32x4 p; p.x = pk2(ka[ks][0], ka[ks][1]); p.y = pk2(ka[ks][2], ka[ks][3]); p.z = pk2(kb2[ks][0], kb2[ks][1]); p.w = pk2(kb2[ks][2], kb2[ks][3]);
                d = mma16(__builtin_bit_cast(bf16x8, p), qf[ks], d); }
            if (r < 4) *(LAS f32x4*)(ps + (hh * 4 + r) * 256 + (w4 * 4 + mt) * 16 + q * 4) = d * 0.0625f; }
        __syncthreads();
        { LAS float* pr = ps + c.wave * 256; float x[4]; float mx = -3.0e38f;
#pragma unroll
            for (int j = 0; j < 4; ++j) { x[j] = pr[lane + 64 * j]; mx = fmaxf(mx, x[j]); }
            mx = wave_max(mx); float s = 0.f;
#pragma unroll
            for (int j = 0; j < 4; ++j) { x[j] = __expf(x[j] - mx); s += x[j]; }
            const float inv = 1.0f / wave_sum(s);
#pragma unroll
            for (int j = 0; j < 4; ++j) pr[lane + 64 * j] = x[j] * inv; }
        __syncthreads();
        { float o[4] = {0.f, 0.f, 0.f, 0.f}; const float* vr = mv + ((size_t)sq * MEMT * 4 + h) * 256 + vt;
#pragma unroll 8
            for (int m = 0; m < MEMT; ++m) { const float vv = vr[(size_t)m * 1024];
#pragma unroll
                for (int t = 0; t < 4; ++t) o[t] += ps[(hh * 4 + t) * 256 + m] * vv; }
#pragma unroll
            for (int t = 0; t < 4; ++t) OB[(size_t)(MP + sq * SS + t) * BW + h * 256 + vt] = f2bf(o[t]); }
        __syncthreads();
    }
}

template <int K, int LDA, int LDB> __device__ __forceinline__ void skinny_pair(const Ctx& c, const bf16_t* __restrict__ A, const bf16_t* __restrict__ B0, const bf16_t* __restrict__ B1, f32x4 (&out)[2], int rot) {
    LAS f32x4* red = (LAS f32x4*)c.lds;
    const int lane = c.lane, r = lane & 15, q = lane >> 4, w = c.wave;
    constexpr int KS = K / 8;
    const bf16_t* ap = A + (size_t)r * LDA + w * KS + q * 8; const bf16_t* b0 = B0 + (size_t)r * LDB + w * KS + q * 8; const bf16_t* b1 = B1 + (size_t)r * LDB + w * KS + q * 8;
    f32x4 acc[2][8];
#pragma unroll
    for (int n = 0; n < 2; ++n)
#pragma unroll
        for (int m = 0; m < 8; ++m) acc[n][m] = (f32x4){0.f, 0.f, 0.f, 0.f};
    int kk = (int)((unsigned)rot % (unsigned)(KS / 32));
#pragma unroll 2
    for (int it = 0; it < KS / 32; ++it) { const int ks = kk; kk = kk + 1 == KS / 32 ? 0 : kk + 1;
        const bf16x8 f0 = *(const bf16x8*)(b0 + ks * 32), f1 = *(const bf16x8*)(b1 + ks * 32); bf16x8 af[8];
#pragma unroll
        for (int m = 0; m < 8; ++m) af[m] = *(const bf16x8*)(ap + (size_t)(m * 16) * LDA + ks * 32);
        __builtin_amdgcn_sched_barrier(0);
#pragma unroll
        for (int m = 0; m < 8; ++m) { acc[0][m] = mma16(f0, af[m], acc[0][m]); acc[1][m] = mma16(f1, af[m], acc[1][m]); } }
    __syncthreads();
#pragma unroll
    for (int n = 0; n < 2; ++n)
#pragma unroll
        for (int m = 0; m < 8; ++m) red[(w * 16 + n * 8 + m) * 64 + lane] = acc[n][m];
    __syncthreads();
#pragma unroll
    for (int n = 0; n < 2; ++n) { f32x4 s = red[(n * 8 + w) * 64 + lane];
#pragma unroll
        for (int ww = 1; ww < 8; ++ww) s += red[(ww * 16 + n * 8 + w) * 64 + lane];
        out[n] = s; }
}
template <int K, int LDA, int LDB> __device__ __forceinline__ f32x4 skinny_one(const Ctx& c, const bf16_t* __restrict__ A, const bf16_t* __restrict__ B0, int rot) {
    LAS f32x4* red = (LAS f32x4*)c.lds;
    const int lane = c.lane, r = lane & 15, q = lane >> 4, w = c.wave;
    constexpr int KS = K / 8, NK = KS / 32;
    const bf16_t* ap = A + (size_t)r * LDA + w * KS + q * 8; const bf16_t* b0 = B0 + (size_t)r * LDB + w * KS + q * 8;
    f32x4 acc[8];
#pragma unroll
    for (int m = 0; m < 8; ++m) acc[m] = (f32x4){0.f, 0.f, 0.f, 0.f};
    int kk = (int)((unsigned)rot % (unsigned)NK);
#pragma unroll 4
    for (int it = 0; it < NK; ++it) { const int ks = kk; kk = kk + 1 == NK ? 0 : kk + 1;
        const bf16x8 f0 = *(const bf16x8*)(b0 + ks * 32); bf16x8 af[8];
#pragma unroll
        for (int m = 0; m < 8; ++m) af[m] = *(const bf16x8*)(ap + (size_t)(m * 16) * LDA + ks * 32);
        __builtin_amdgcn_sched_barrier(0);
#pragma unroll
        for (int m = 0; m < 8; ++m) acc[m] = mma16(f0, af[m], acc[m]); }
    __syncthreads();
#pragma unroll
    for (int m = 0; m < 8; ++m) red[(w * 8 + m) * 64 + lane] = acc[m];
    __syncthreads();
    f32x4 s = red[w * 64 + lane];
#pragma unroll
    for (int ww = 1; ww < 8; ++ww) s += red[(ww * 8 + w) * 64 + lane];
    return s;
}
__device__ __forceinline__ u32x2 pk4(const f32x4 v) { u32x2 o; o.x = pk2(v[0], v[1]); o.y = pk2(v[2], v[3]); return o; }
#define SKINNY_LOOP(total_) for (int s = c.bid - base; s >= 0 && s < (total_); s += ncu)
__device__ __forceinline__ void ph_sk_in(const Ctx& c, int base, int ncu, const bf16_t* __restrict__ HB, const bf16_t* __restrict__ W, bf16_t* __restrict__ U) {
    const int r = c.lane & 15, q = c.lane >> 4, w = c.wave;
    SKINNY_LOOP(NINP / 32) { f32x4 o[2]; skinny_pair<DM, DM, DM>(c, HB + (size_t)MP * DM, W + (size_t)(s * 32) * DM, W + (size_t)(s * 32 + 16) * DM, o, s);
        bf16_t* up = U + (size_t)(MP + w * 16 + r) * NINP + s * 32 + q * 4; *(u32x2*)up = pk4(o[0]); *(u32x2*)(up + 16) = pk4(o[1]); }
}
__device__ __forceinline__ void ph_sk_merge(const Ctx& c, int base, int ncu, const bf16_t* __restrict__ BR, const bf16_t* __restrict__ W, const bf16_t* __restrict__ U, const float* __restrict__ gate_b, bf16_t* __restrict__ MGB) {
    const int r = c.lane & 15, q = c.lane >> 4, w = c.wave;
    SKINNY_LOOP(DM / 16) { const size_t row = (size_t)(MP + w * 16 + r); const int col = s * 16 + q * 4; f32x4 tot = (f32x4){0.f, 0.f, 0.f, 0.f};
#pragma unroll 1
        for (int z = 0; z < 4; ++z) { const f32x4 o = skinny_one<BW, BW, BW>(c, BR + ((size_t)z * MPAD + MP) * BW, W + ((size_t)z * DM + s * 16) * BW, s + z);
            const u32x2 gp = *(const u32x2*)(U + row * NINP + U_GP + z * DM + col); const f32x4 gb = *(const f32x4*)(gate_b + z * DM + col);
            tot[0] += sigmoidf_(__uint_as_float(gp.x << 16) + gb[0]) * o[0]; tot[1] += sigmoidf_(__uint_as_float(gp.x & 0xffff0000u) + gb[1]) * o[1];
            tot[2] += sigmoidf_(__uint_as_float(gp.y << 16) + gb[2]) * o[2]; tot[3] += sigmoidf_(__uint_as_float(gp.y & 0xffff0000u) + gb[3]) * o[3]; }
        *(u32x2*)(MGB + row * DM + col) = pk4(tot); }
}
template <int K> __device__ __forceinline__ void ph_sk_res(const Ctx& c, int base, int ncu, const bf16_t* __restrict__ A, const bf16_t* __restrict__ W, const bf16_t* __restrict__ R, bf16_t* __restrict__ Y) {
    const int r = c.lane & 15, q = c.lane >> 4, w = c.wave;
    SKINNY_LOOP(DM / 16) { const f32x4 o = skinny_one<K, K, K>(c, A + (size_t)MP * K, W + (size_t)(s * 16) * K, s);
        const size_t off = (size_t)(MP + w * 16 + r) * DM + s * 16 + q * 4; const u32x2 rr = *(const u32x2*)(R + off);
        const f32x4 rv = (f32x4){__uint_as_float(rr.x << 16), __uint_as_float(rr.x & 0xffff0000u), __uint_as_float(rr.y << 16), __uint_as_float(rr.y & 0xffff0000u)};
        *(u32x2*)(Y + off) = pk4(rv * ALPHA + o); }
}
__device__ __forceinline__ void ph_sk_gu(const Ctx& c, int base, int ncu, const bf16_t* __restrict__ X1B, const bf16_t* __restrict__ W, bf16_t* __restrict__ ACT) {
    const int r = c.lane & 15, q = c.lane >> 4, w = c.wave;
    SKINNY_LOOP(DFF / 16) { const int t = s >> 3, j0 = (s & 7) * 16; f32x4 o[2];
        skinny_pair<DM, DM, DM>(c, X1B + (size_t)MP * DM, W + (size_t)(t * 256 + j0) * DM, W + (size_t)(t * 256 + 128 + j0) * DM, o, s);
        f32x4 v;
#pragma unroll
        for (int j = 0; j < 4; ++j) v[j] = o[0][j] * sigmoidf_(o[0][j]) * o[1][j];
        *(u32x2*)(ACT + (size_t)(MP + w * 16 + r) * DFF + t * 128 + j0 + q * 4) = pk4(v); }
}
#undef SKINNY_LOOP

constexpr int LDS_BAR_OFF = 147456;
constexpr int LDS_BYTES = LDS_BAR_OFF + 64;
struct Args { const float* in[37]; float* out; unsigned char* ws; };

typedef pg8::Gemm<DM, DM, DM, 2, 8, NL, 1, false, 0, 0, (long)DM * DM, 0> GemmMem;
typedef pg8::Gemm<DM, DM, DM, MP / 256, NINP / 256> GemmIn;
typedef pg8::Gemm<NINP, 1024, 256, PS / 256, 1, 8, 4, false, (long)PS * NINP, 256, 256 * 1024, 256> GemmScore;
typedef pg8::Gemm<256, 256, 256, PS / 256, 1, 8, 4, false, (long)4 * 4096 * 256, (long)4096 * 256, 4 * 65536, 65536> GemmPV;
typedef pg8::Gemm<BW, BW, BW, MP / 256, DM / 256, 4, 1, true, (long)MPAD * BW, 0, (long)DM * BW, 0> GemmBranch;
typedef pg8::Gemm<DM, DM, DM, MP / 256, DM / 256> GemmOut;
typedef pg8::Gemm<DM, DM, DM, MP / 256, 2 * DFF / 256> GemmGU;
typedef pg8::Gemm<DFF, DFF, DFF, MP / 256, DM / 256> GemmDown;
template <class GT> __device__ __forceinline__ GT mk_gemm(const Ctx& c, const bf16_t* A, const bf16_t* B) { GT g; g.A = A; g.B = B; g.G = c.G; g.c = c.bid; return g; }

template <int OFF> __device__ __forceinline__ unsigned long long karg_u64(unsigned long long kargs) {
    unsigned long long p; asm volatile("s_load_dwordx2 %0, %1, %2\n\ts_waitcnt lgkmcnt(0)" : "=s"(p) : "s"(kargs), "n"(OFF) : "memory"); return p;
}
#define GPTR(T, x) ((T*)(__attribute__((address_space(1))) T*)(x))
#define INP(k) GPTR(const float, karg_u64<(k) * 8>(kargs))
#define OUTP() GPTR(float, karg_u64<37 * 8>(kargs))
#define WSP() GPTR(unsigned char, karg_u64<38 * 8>(kargs))

__global__ void __launch_bounds__(512, 2) mega_fwd(Args a_unused) {
    extern __shared__ __attribute__((aligned(16))) unsigned char lds_raw[];
    const unsigned long long kargs = (unsigned long long)__builtin_amdgcn_kernarg_segment_ptr();
    Ctx c0; c0.tid = threadIdx.x; c0.lane = c0.tid & 63; c0.wave = __builtin_amdgcn_readfirstlane(c0.tid >> 6); c0.bid = blockIdx.x; c0.G = gridDim.x; c0.lds = (LAS unsigned char*)lds_raw;
    if (c0.tid < 4) ((LAS unsigned*)(c0.lds + LDS_BAR_OFF))[c0.tid] = 0u;
    __syncthreads();
    const XcdBarrier bar = xcd_barrier_post((unsigned*)(WSP() + WS_CTL), (volatile LAS unsigned*)(c0.lds + LDS_BAR_OFF));

#define WPREP_LAYER(cc_, L_) do { unsigned char* ws_ = WSP(); \
      ph_wprep(cc_, INP(10) + (size_t)(L_) * DM * NIN, (bf16_t*)(ws_ + WS_WIN) + (size_t)(L_) * NINP * DM, DM, NIN, NINP, 1, 1, 0, 0); \
      ph_wprep(cc_, INP(29) + (size_t)(L_) * 4 * BW * DM, (bf16_t*)(ws_ + WS_WBR) + (size_t)(L_) * 4 * DM * BW, BW, DM, DM, 0, 4, (size_t)BW * DM, (size_t)DM * BW); \
      ph_wprep(cc_, INP(30) + (size_t)(L_) * DM * DM, (bf16_t*)(ws_ + WS_WOUT) + (size_t)(L_) * DM * DM, DM, DM, DM, 0, 1, 0, 0); \
      ph_wprep(cc_, INP(33) + (size_t)(L_) * DM * 2 * DFF, (bf16_t*)(ws_ + WS_WGU) + (size_t)(L_) * 2 * DFF * DM, DM, 2 * DFF, 2 * DFF, 2, 1, 0, 0); \
      ph_wprep(cc_, INP(34) + (size_t)(L_) * DFF * DM, (bf16_t*)(ws_ + WS_WDN) + (size_t)(L_) * DM * DFF, DFF, DM, DM, 0, 1, 0, 0); } while (0)
    { const Ctx c = fresh(c0); unsigned char* ws = WSP();
      ph_wprep(c, INP(28), (bf16_t*)(ws + WS_WMEM), DM, DM, DM, 0, NL, (size_t)DM * DM, (size_t)DM * DM);
      WPREP_LAYER(c, 0);
      ph_lrw(c, INP(19), INP(21), INP(22), (bf16_t*)(ws + WS_LRW));
      ph_xprep(c, INP(0), INP(1), INP(2), (float*)nullptr, (bf16_t*)(ws + WS_HB), (bf16_t*)(ws + WS_MEMB)); }
    xcd_barrier(bar);
    { const Ctx c = fresh(c0); unsigned char* ws = WSP(); float* out = OUTP();
      GemmMem g = mk_gemm<GemmMem>(c, (const bf16_t*)(ws + WS_MEMB), (const bf16_t*)(ws + WS_WMEM));
      pg8::EpiMem E; E.outK = out + O_MKP; E.outV = out + O_MVP; E.kb = (bf16_t*)(ws + WS_MKB); E.vt = (bf16_t*)(ws + WS_MVT); pg8::gemm_phase<GemmMem, pg8::EpiMem, true, true>(c.lds, c.tid, g, E); }

    for (int l = 0; l < NL; ++l) {
        { const Ctx c = fresh(c0); unsigned char* ws = WSP();
          GemmIn g = mk_gemm<GemmIn>(c, (const bf16_t*)(ws + WS_HB), (const bf16_t*)(ws + WS_WIN) + (size_t)l * NINP * DM);
          pg8::EpiBf16 E; E.O = (bf16_t*)(ws + WS_U); E.zs = 0; E.ldc = NINP; E.pad = 0; pg8::gemm_phase<GemmIn, pg8::EpiBf16, true, true>(c.lds, c.tid, g, E); }
        { const Ctx c = fresh(c0); unsigned char* ws = WSP(); ph_sk_in(c, c.G > 192 ? 96 : 0, c.G > 192 ? c.G - 96 : c.G, (const bf16_t*)(ws + WS_HB), (const bf16_t*)(ws + WS_WIN) + (size_t)l * NINP * DM, (bf16_t*)(ws + WS_U)); }
        xcd_barrier(bar);
        { const Ctx c = fresh(c0); unsigned char* ws = WSP(); float* out = OUTP(); const bf16_t* U = (const bf16_t*)(ws + WS_U); bf16_t* BR = (bf16_t*)(ws + WS_BR);
          (void)out; (void)BR;
          ph_gla_pre(c, U, INP(12) + (size_t)l * 16 * 512, INP(13) + (size_t)l * 512, (bf16_t*)(ws + WS_GLQD), (bf16_t*)(ws + WS_GLKH), (bf16_t*)(ws + WS_GLE), (bf16_t*)(ws + WS_GLVT), (float*)(ws + WS_GLGC)); }
        { const Ctx c = fresh(c0); unsigned char* ws = WSP();
          ph_rwkv_pre(c, (const bf16_t*)(ws + WS_U), INP(9) + (size_t)l * SB * RWC, INP(17) + (size_t)l * RWC, INP(18) + (size_t)l * BW, INP(19) + (size_t)l * 64 * BW, INP(20) + (size_t)l * BW, INP(21) + (size_t)l * 64 * BW,
                       INP(22) + (size_t)l * 128 * BW, INP(23) + (size_t)l * BW, INP(24) + (size_t)l * BW, INP(25) + (size_t)l * BW, (float*)(ws + WS_RW), (bf16_t*)(ws + WS_RB), (const bf16_t*)(ws + WS_LRW) + (size_t)l * 1024 * 256); }
        { const Ctx c = fresh(c0); unsigned char* ws = WSP(); ph_memattn_prompt(c, (const bf16_t*)(ws + WS_U), (const bf16_t*)(ws + WS_MKB) + (size_t)l * 512 * 1024, (const bf16_t*)(ws + WS_MVT) + (size_t)l * 8 * 65536, (bf16_t*)(ws + WS_BR) + (size_t)3 * MPAD * BW); }
        xcd_barrier(bar);
        { const Ctx c = fresh(c0); unsigned char* ws = WSP(); float* out = OUTP();
          ph_rwkv_seq(c, 64, (const bf16_t*)(ws + WS_RB), INP(8) + (size_t)l * SB * 16 * 4096, out + O_RWP + (size_t)l * PB * 16 * 4096, out + O_RWS + (size_t)l * SB * 16 * 4096,
                      (bf16_t*)(ws + WS_RAW) + (size_t)MPAD * BW); }
        { const Ctx c = fresh(c0); unsigned char* ws = WSP(); float* out = OUTP();
          ph_gla_seq(c, 32, (const bf16_t*)(ws + WS_GLQD), (const bf16_t*)(ws + WS_GLKH), (const bf16_t*)(ws + WS_GLE), (const bf16_t*)(ws + WS_GLVT), (const float*)(ws + WS_GLGC),
                     INP(7) + (size_t)l * SB * 4 * 32768, out + O_GLAP + (size_t)l * PB * 4 * 32768, out + O_GLAS + (size_t)l * SB * 4 * 32768, (bf16_t*)(ws + WS_RAW)); }
        if ((c0.bid < 32 || c0.bid >= 96) && c0.G > 96) {
        { Ctx c = fresh(c0); c.bid = c.bid < 32 ? c.bid : c.bid - 64; c.G = c.G - 64; unsigned char* ws = WSP(); ph_swa_prompt(c, (const bf16_t*)(ws + WS_U), INP(16) + (size_t)l * 16, (bf16_t*)(ws + WS_BR) + (size_t)MPAD * BW); }
        { Ctx c = fresh(c0); c.bid = c.bid < 32 ? c.bid : c.bid - 64; c.G = c.G - 64; unsigned char* ws = WSP();
          ph_swa_sample(c, (const bf16_t*)(ws + WS_U), INP(3) + (size_t)l * SB * 16384, INP(4) + (size_t)l * SB * 16384, INP(16) + (size_t)l * 16, (bf16_t*)(ws + WS_BR) + (size_t)MPAD * BW); }
        { Ctx c = fresh(c0); c.bid = c.bid < 32 ? c.bid : c.bid - 64; c.G = c.G - 64; unsigned char* ws = WSP();
          ph_memattn_sample(c, 64, (const bf16_t*)(ws + WS_U), INP(5) + (size_t)l * SB * MEMT * 1024, INP(6) + (size_t)l * SB * MEMT * 1024, (bf16_t*)(ws + WS_BR) + (size_t)3 * MPAD * BW); }
        { Ctx c = fresh(c0); c.bid = c.bid < 32 ? c.bid : c.bid - 64; c.G = c.G - 64; unsigned char* ws = WSP();
          ph_copy_outs(c, (const bf16_t*)(ws + WS_U), INP(3) + (size_t)l * SB * 16384, INP(4) + (size_t)l * SB * 16384, OUTP(), l); }
          if (l + 1 < NL) { Ctx c = fresh(c0); const int sd = c.bid < 32 ? c.bid : c.bid - 64; c.G = 2 * (c.G - 64) + 96;
            c.bid = 2 * sd; WPREP_LAYER(c, l + 1); c.bid = 2 * sd + 1; WPREP_LAYER(c, l + 1); }
        } else if (l + 1 < NL && c0.G > 96) { Ctx c = fresh(c0); const int nside2 = 2 * (c.G - 64); c.G = nside2 + 96;
          if (c0.bid < 64) { c.bid = nside2 + 2 * (c0.bid - 32); WPREP_LAYER(c, l + 1); c.bid = nside2 + 2 * (c0.bid - 32) + 1; WPREP_LAYER(c, l + 1); }
          else { c.bid = nside2 + 64 + (c0.bid - 64); WPREP_LAYER(c, l + 1); }
        }
        xcd_barrier(bar);
        { const Ctx c = fresh(c0); unsigned char* ws = WSP(); ph_rwkv_fin(c, (const float*)(ws + WS_RW), INP(26) + (size_t)l * BW, INP(27) + (size_t)l * BW, (const bf16_t*)(ws + WS_RAW) + (size_t)MPAD * BW, (bf16_t*)(ws + WS_BR) + (size_t)2 * MPAD * BW); }
        { const Ctx c = fresh(c0); unsigned char* ws = WSP(); ph_gla_fin(c, (const bf16_t*)(ws + WS_U), INP(14) + (size_t)l * BW, INP(15) + (size_t)l * BW, (const bf16_t*)(ws + WS_RAW), (bf16_t*)(ws + WS_BR)); }
        xcd_barrier(bar);
        { const Ctx c = fresh(c0); unsigned char* ws = WSP();
          GemmBranch g = mk_gemm<GemmBranch>(c, (const bf16_t*)(ws + WS_BR), (const bf16_t*)(ws + WS_WBR) + (size_t)l * 4 * DM * BW);
          pg8::EpiMerge E; E.MG = (float*)(ws + WS_MG); E.MGB = (bf16_t*)(ws + WS_MGB); E.U = (const bf16_t*)(ws + WS_U); E.gate_b = INP(11) + (size_t)l * 4 * DM; pg8::gemm_phase<GemmBranch, pg8::EpiMerge, true, true>(c.lds, c.tid, g, E); }
        { const Ctx c = fresh(c0); unsigned char* ws = WSP(); ph_sk_merge(c, 0, c.G, (const bf16_t*)(ws + WS_BR), (const bf16_t*)(ws + WS_WBR) + (size_t)l * 4 * DM * BW, (const bf16_t*)(ws + WS_U), INP(11) + (size_t)l * 4 * DM, (bf16_t*)(ws + WS_MGB)); }
        xcd_barrier(bar);
        { const Ctx c = fresh(c0); unsigned char* ws = WSP();
          GemmOut g = mk_gemm<GemmOut>(c, (const bf16_t*)(ws + WS_MGB), (const bf16_t*)(ws + WS_WOUT) + (size_t)l * DM * DM);
          pg8::EpiRes E; E.R = (const bf16_t*)(ws + WS_HB); E.Y = (bf16_t*)(ws + WS_Y); pg8::gemm_phase<GemmOut, pg8::EpiRes, true, true>(c.lds, c.tid, g, E); }
        { const Ctx c = fresh(c0); unsigned char* ws = WSP(); ph_sk_res<DM>(c, c.G > 192 ? 128 : 0, c.G > 192 ? c.G - 128 : c.G, (const bf16_t*)(ws + WS_MGB), (const bf16_t*)(ws + WS_WOUT) + (size_t)l * DM * DM, (const bf16_t*)(ws + WS_HB), (bf16_t*)(ws + WS_Y)); }
        xcd_barrier(bar);
        { const Ctx c = fresh(c0); unsigned char* ws = WSP(); ph_ln(c, (const bf16_t*)(ws + WS_Y), INP(31) + (size_t)l * DM, INP(32) + (size_t)l * DM, (float*)nullptr, (bf16_t*)(ws + WS_X1B), nullptr, MT, 0); }
        xcd_barrier(bar);
        { const Ctx c = fresh(c0); unsigned char* ws = WSP();
          GemmGU g = mk_gemm<GemmGU>(c, (const bf16_t*)(ws + WS_X1B), (const bf16_t*)(ws + WS_WGU) + (size_t)l * 2 * DFF * DM);
          pg8::EpiSwiGLU E; E.O = (bf16_t*)(ws + WS_ACT); pg8::gemm_phase<GemmGU, pg8::EpiSwiGLU, true, true>(c.lds, c.tid, g, E); }
        { const Ctx c = fresh(c0); unsigned char* ws = WSP(); ph_sk_gu(c, c.G > 192 ? 128 : 0, c.G > 192 ? c.G - 128 : c.G, (const bf16_t*)(ws + WS_X1B), (const bf16_t*)(ws + WS_WGU) + (size_t)l * 2 * DFF * DM, (bf16_t*)(ws + WS_ACT)); }
        xcd_barrier(bar);
        { const Ctx c = fresh(c0); unsigned char* ws = WSP();
          GemmDown g = mk_gemm<GemmDown>(c, (const bf16_t*)(ws + WS_ACT), (const bf16_t*)(ws + WS_WDN) + (size_t)l * DM * DFF);
          pg8::EpiRes E; E.R = (const bf16_t*)(ws + WS_X1B); E.Y = (bf16_t*)(ws + WS_Y); pg8::gemm_phase<GemmDown, pg8::EpiRes, true, true>(c.lds, c.tid, g, E); }
        { const Ctx c = fresh(c0); unsigned char* ws = WSP(); ph_sk_res<DFF>(c, 0, c.G, (const bf16_t*)(ws + WS_ACT), (const bf16_t*)(ws + WS_WDN) + (size_t)l * DM * DFF, (const bf16_t*)(ws + WS_X1B), (bf16_t*)(ws + WS_Y)); }
        xcd_barrier(bar);
        { const Ctx c = fresh(c0); unsigned char* ws = WSP(); float* out = OUTP(); ph_ln(c, (const bf16_t*)(ws + WS_Y), INP(35) + (size_t)l * DM, INP(36) + (size_t)l * DM, (float*)nullptr, (bf16_t*)(ws + WS_HB), l == NL - 1 ? out : nullptr, MT, MT); }
        xcd_barrier(bar);
    }
}

extern "C" void kernel_launch(void* const* d_in, const int* in_sizes, int n_in, void* d_out, int out_size, void* d_ws, size_t ws_size, hipStream_t stream) {
    static int grid = 0;
    if (grid == 0) {
        if (n_in != 37 || (size_t)out_size != O_END || ws_size < WS_END) { fprintf(stderr, "kernel_launch: unexpected sizes (n_in %d out %d ws %zu need %zu)\n", n_in, out_size, ws_size, (size_t)WS_END); grid = -1; return; }
        int dev = 0, cus = 0;
        if (hipGetDevice(&dev) != hipSuccess || hipDeviceGetAttribute(&cus, hipDeviceAttributeMultiprocessorCount, dev) != hipSuccess) { grid = -1; return; }
        if (hipFuncSetAttribute((const void*)mega_fwd, hipFuncAttributeMaxDynamicSharedMemorySize, LDS_BYTES) != hipSuccess) { fprintf(stderr, "kernel_launch: hipFuncSetAttribute failed\n"); grid = -1; return; }
        int per_cu = 0;
        if (hipOccupancyMaxActiveBlocksPerMultiprocessor(&per_cu, (const void*)mega_fwd, 512, LDS_BYTES) != hipSuccess || per_cu < 1) { fprintf(stderr, "kernel_launch: occupancy query says %d\n", per_cu); }
        (void)hipGetLastError();
        grid = cus;
    }
    if (grid < 0) return;
    (void)hipMemsetAsync((unsigned char*)d_ws + WS_CTL, 0, XCD_BAR_WORDS * sizeof(unsigned), stream);
    Args a; memset(&a, 0, sizeof a);
    for (int i = 0; i < 37; ++i) a.in[i] = (const float*)d_in[i];
    a.out = (float*)d_out; a.ws = (unsigned char*)d_ws;
    hipLaunchKernelGGL(mega_fwd, dim3(grid), dim3(512), LDS_BYTES, stream, a);
}
```

```cpp
#include <hip/hip_runtime.h>
#include <cstdio>
#include <cstdint>
#include <cstring>

#define LAS __attribute__((address_space(3)))
typedef unsigned short bf16_t;
typedef short bf16x8 __attribute__((ext_vector_type(8)));
typedef float f32x4 __attribute__((ext_vector_type(4)));
typedef float f32x2 __attribute__((ext_vector_type(2)));
typedef unsigned u32x4 __attribute__((ext_vector_type(4)));
typedef unsigned u32x2 __attribute__((ext_vector_type(2)));

constexpr int DM = 2048, NL = 4;
constexpr int PB = 2, PS = 4096, MP = PB * PS;
constexpr int SB = 32, SS = 4, MS = SB * SS;
constexpr int MT = MP + MS;
constexpr int MPAD = 8448;
constexpr int NIN = 16912, NINP = 17152;
constexpr int U_GQ = 0, U_GK = 512, U_GV = 1024, U_GR = 2048, U_GA = 3072, U_SQ = 3328, U_SK = 4352, U_SV = 4480, U_RU = 4608, U_MQ = 7936, U_GP = 8960;
constexpr int RWC = 3328, BW = 1024, DFF = 5632, MEMT = 256;
constexpr float ALPHA = 1.681792830507429f;

constexpr size_t O_YP = 0;
constexpr size_t O_YS = O_YP + (size_t)MP * DM;
constexpr size_t O_SWKP = O_YS + (size_t)MS * DM;
constexpr size_t O_SWVP = O_SWKP + (size_t)NL * PB * 128 * 128;
constexpr size_t O_MKP = O_SWVP + (size_t)NL * PB * 128 * 128;
constexpr size_t O_MVP = O_MKP + (size_t)NL * PB * 256 * 1024;
constexpr size_t O_GLAP = O_MVP + (size_t)NL * PB * 256 * 1024;
constexpr size_t O_RWP = O_GLAP + (size_t)NL * PB * 4 * 128 * 256;
constexpr size_t O_RSP = O_RWP + (size_t)NL * PB * 16 * 64 * 64;
constexpr size_t O_SWKS = O_RSP + (size_t)NL * PB * RWC;
constexpr size_t O_SWVS = O_SWKS + (size_t)NL * SB * 128 * 128;
constexpr size_t O_GLAS = O_SWVS + (size_t)NL * SB * 128 * 128;
constexpr size_t O_RWS = O_GLAS + (size_t)NL * SB * 4 * 128 * 256;
constexpr size_t O_RSS = O_RWS + (size_t)NL * SB * 16 * 64 * 64;
constexpr size_t O_END = O_RSS + (size_t)NL * SB * RWC;
static_assert(O_END == 52881408, "output size");

constexpr size_t al256(size_t x) { return (x + 255) & ~(size_t)255; }
constexpr size_t WS_CTL = 0;
constexpr size_t WS_WIN = 65536;
constexpr size_t WS_WMEM = WS_WIN + (size_t)NL * NINP * DM * 2;
constexpr size_t WS_WBR = WS_WMEM + (size_t)NL * DM * DM * 2;
constexpr size_t WS_WOUT = WS_WBR + (size_t)NL * 4 * DM * BW * 2;
constexpr size_t WS_WGU = WS_WOUT + (size_t)NL * DM * DM * 2;
constexpr size_t WS_WDN = WS_WGU + (size_t)NL * 2 * DFF * DM * 2;
constexpr size_t WS_HF = WS_WDN + (size_t)NL * DM * DFF * 2;
constexpr size_t WS_HB = WS_HF + (size_t)MPAD * DM * 4;
constexpr size_t WS_U = WS_HB + (size_t)MPAD * DM * 2;
constexpr size_t WS_BR = WS_U + (size_t)MPAD * NINP * 2;
constexpr size_t WS_MG = WS_BR + (size_t)4 * MPAD * BW * 2;
constexpr size_t WS_MGB = WS_MG + (size_t)MPAD * DM * 4;
constexpr size_t WS_Y = WS_MGB + (size_t)MPAD * DM * 2;
constexpr size_t WS_X1F = WS_Y + (size_t)MPAD * DM * 4;
constexpr size_t WS_X1B = WS_X1F + (size_t)MPAD * DM * 4;
constexpr size_t WS_ACT = WS_X1B + (size_t)MPAD * DM * 2;
constexpr size_t WS_MEMB = WS_ACT + (size_t)MPAD * DFF * 2;
constexpr size_t WS_MKB = WS_MEMB + (size_t)512 * DM * 2;
constexpr size_t WS_MVT = WS_MKB + (size_t)NL * 512 * 1024 * 2;
constexpr size_t WS_SC = WS_MVT + (size_t)NL * 8 * 256 * 256 * 2;
constexpr size_t WS_PB = WS_SC + (size_t)8 * 4096 * 256 * 4;
constexpr size_t WS_RW = WS_PB + (size_t)8 * 4096 * 256 * 2;
constexpr size_t RW_ARR = (size_t)MPAD * BW * 4;
constexpr int GL_NCH = 512 + 128;
constexpr size_t WS_GLQD = WS_RW + 8 * RW_ARR;
constexpr size_t WS_GLKH = WS_GLQD + (size_t)GL_NCH * 8192 * 2;
constexpr size_t WS_GLE = WS_GLKH + (size_t)GL_NCH * 8192 * 2;
constexpr size_t WS_GLVT = WS_GLE + (size_t)GL_NCH * 4096 * 2;
constexpr size_t WS_GLGC = WS_GLVT + (size_t)GL_NCH * 16384 * 2;
constexpr int RB_NCH = PB * 16 * 256 + SB * 16;
constexpr int RB_EL = 9216;
constexpr int RB_QP = 4608, RB_KHP = 5760, RB_VT = 7296, RB_EP = 8832;
constexpr size_t WS_RB = WS_GLGC + (size_t)GL_NCH * 128 * 4;
constexpr size_t WS_RAW = WS_RB + (size_t)RB_NCH * RB_EL * 2;
constexpr size_t WS_LRW = WS_RAW + (size_t)2 * MPAD * BW * 2;
constexpr size_t WS_END = WS_LRW + (size_t)NL * 16 * 64 * 256 * 2;

__device__ __forceinline__ float bf2f(bf16_t b) { return __uint_as_float(((unsigned)b) << 16); }
typedef __bf16 bf16v2_t __attribute__((ext_vector_type(2)));
__device__ __forceinline__ unsigned pk2(float lo, float hi) { const f32x2 v = {lo, hi}; return __builtin_bit_cast(unsigned, __builtin_convertvector(v, bf16v2_t)); }
__device__ __forceinline__ bf16_t f2bf(float f) { return (bf16_t)(pk2(f, 0.f) & 0xffffu); }
__device__ __forceinline__ f32x4 ld4bf(const bf16_t* p) { const u32x2 w = *(const u32x2*)p; return (f32x4){__uint_as_float(w.x << 16), __uint_as_float(w.x & 0xffff0000u), __uint_as_float(w.y << 16), __uint_as_float(w.y & 0xffff0000u)}; }
__device__ __forceinline__ float wave_sum(float v) {
#pragma unroll
    for (int o = 32; o > 0; o >>= 1) v += __shfl_xor(v, o, 64);
    return v;
}
__device__ __forceinline__ float wave_max(float v) {
#pragma unroll
    for (int o = 32; o > 0; o >>= 1) v = fmaxf(v, __shfl_xor(v, o, 64));
    return v;
}
__device__ __forceinline__ float sigmoidf_(float x) { return 1.0f / (1.0f + __expf(-x)); }
__device__ __forceinline__ void unpack8(const u32x4 w, float (&x)[8]) {
    x[0] = __uint_as_float(w.x << 16); x[1] = __uint_as_float(w.x & 0xffff0000u); x[2] = __uint_as_float(w.y << 16); x[3] = __uint_as_float(w.y & 0xffff0000u);
    x[4] = __uint_as_float(w.z << 16); x[5] = __uint_as_float(w.z & 0xffff0000u); x[6] = __uint_as_float(w.w << 16); x[7] = __uint_as_float(w.w & 0xffff0000u);
}
__device__ __forceinline__ float softplusf_(float x) { return fmaxf(x, 0.f) + log1pf(__expf(-fabsf(x))); }
__device__ __forceinline__ float softplus_fast(float x) { return fmaxf(x, 0.f) + __logf(1.0f + __expf(-fabsf(x))); }
__device__ __forceinline__ float tanh_fast(float x) { return 1.0f - 2.0f / (1.0f + __expf(2.0f * x)); }

namespace pg8 {
constexpr int BM = 256, BK = 64, HALF = 128, HTB = HALF * BK * 2, STAGE_BYTES = 8 * HTB, NXCD = 8, WGM = 8;
__host__ __device__ __forceinline__ int lds_byte(int r, int c) { const int st = (r >> 4) * 2 + (c >> 5), rr = r & 15, cc = c & 31, ob = rr * 64 + cc * 2; return st * 1024 + (ob ^ (((ob >> 9) & 1) << 5)); }
__host__ __device__ __forceinline__ void stage_rc(int b, int& R, int& C) { const int st = b / 1024, sb = b % 1024, swz = sb ^ (((sb >> 9) & 1) << 5); R = (st >> 1) * 16 + swz / 64; C = (st & 1) * 32 + (swz % 64) / 2; }
__host__ __device__ __forceinline__ int perm32(int rho) { const int n = rho >> 4, i = rho & 15; return 8 * (i >> 2) + 4 * n + (i & 3); }

struct Unit { int pm, pn, z; };
template <int LDA_, int LDB_, int K_, int NM_, int NN_, int NZ_ = 1, int NZH_ = 1, bool ZINNER_ = false, long ZSAB_ = 0, long ZSAH_ = 0, long ZSBB_ = 0, long ZSBH_ = 0>
struct Gemm {
    static constexpr int LDA = LDA_, LDB = LDB_, K = K_, NM = NM_, NN = NN_, NZ = NZ_, NZH = NZH_; static constexpr bool ZINNER = ZINNER_;
    const bf16_t* A; const bf16_t* B; int G, c;
    __device__ __forceinline__ bool next(int i, Unit& u) const {
        constexpr int nt = NM * NN; int L, z;
        if (ZINNER) { const int it = i / NZ; z = i - it * NZ; const long LL = (long)it * G + c; if (LL >= nt) return false; L = (int)LL; }
        else { const long LL = (long)i * G + c; if (LL >= (long)nt * NZ) return false; z = (int)(LL / nt); L = (int)(LL - (long)z * nt); }
        int wgid = L; { constexpr int q = nt / NXCD, r = nt % NXCD; const int xcd = wgid % NXCD, off = wgid / NXCD; wgid = (xcd < r ? xcd * (q + 1) : r * (q + 1) + (xcd - r) * q) + off; }
        constexpr int nig = WGM * NN; const int gid = wgid / nig, fm = gid * WGM, gsz = (NM - fm) < WGM ? (NM - fm) : WGM;
        u.pm = fm + ((wgid % nig) % gsz); u.pn = (wgid % nig) / gsz; u.z = z; return true;
    }
    __device__ __forceinline__ const char* a_base(const Unit& u) const { const int zb = u.z / NZH, zh = u.z - zb * NZH; return (const char*)(A + zb * ZSAB_ + zh * ZSAH_ + (long)u.pm * BM * LDA); }
    __device__ __forceinline__ const char* b_base(const Unit& u) const { const int zb = u.z / NZH, zh = u.z - zb * NZH; return (const char*)(B + zb * ZSBB_ + zh * ZSBH_ + (long)u.pn * BM * LDB); }
};

template <class GT, class Epi, bool ALIGN_EPI = true, bool SP2 = true>
__device__ __forceinline__ void gemm_phase(LAS unsigned char* lds, const int tid, const GT& g, const Epi& E) {
    const int wid = __builtin_amdgcn_readfirstlane(tid >> 6), lane = tid & 63, wr = wid >> 2, wc = wid & 3, fr = lane & 15, fq = lane >> 4;
    constexpr int nt = GT::K / BK;
    unsigned voffA[2], voffB[2];
#pragma unroll
    for (int i = 0; i < 2; ++i) { int R, C; stage_rc(tid * 16 + i * 8192, R, C); const int Rb = Epi::PERM ? ((R & ~31) + perm32(R & 31)) : R;
        voffA[i] = (unsigned)(R * GT::LDA + C) * 2u; voffB[i] = (unsigned)(Rb * GT::LDB + C) * 2u; }
    constexpr size_t kstep = (size_t)(BK * 2);
    constexpr size_t hstepA = (size_t)HALF * GT::LDA * 2, hstepB = (size_t)HALF * GT::LDB * 2;
    const unsigned ldsw = (unsigned)wid * 1024u;
    const int aoff = lds_byte(wr * 64 + fr, fq * 8), boff = lds_byte(wc * 32 + fr, fq * 8);
#define PG8_SA(b, h) (((b) * 2 + (h)) * HTB)
#define PG8_SB(b, h) ((4 + (b) * 2 + (h)) * HTB)
#define PG8_STAGE(bufoff, gbase, voff) do { _Pragma("unroll") for (int _i = 0; _i < 2; ++_i) \
        __builtin_amdgcn_global_load_lds((const unsigned*)((const char*)(gbase) + (voff)[_i]), (LAS unsigned*)(lds + (bufoff) + ldsw + _i * 8192), 16, 0, 0); } while (0)
#define PG8_LDA(dst, b, h) do { _Pragma("unroll") for (int m = 0; m < 4; ++m) _Pragma("unroll") for (int k = 0; k < 2; ++k) dst[m][k] = *(const LAS bf16x8*)(lds + PG8_SA(b, h) + aoff + m * 2048 + k * 1024); } while (0)
#define PG8_LDB(dst, b, h) do { _Pragma("unroll") for (int n = 0; n < 2; ++n) _Pragma("unroll") for (int k = 0; k < 2; ++k) dst[n][k] = *(const LAS bf16x8*)(lds + PG8_SB(b, h) + boff + n * 2048 + k * 1024); } while (0)
#define PG8_MMA(ai, bj, At, Bt) do { __builtin_amdgcn_s_setprio(1); _Pragma("unroll") for (int m = 0; m < 4; ++m) _Pragma("unroll") for (int n = 0; n < 2; ++n) _Pragma("unroll") for (int k = 0; k < 2; ++k) \
        acc[ai][bj][m][n] = __builtin_amdgcn_mfma_f32_16x16x32_bf16(Bt[n][k], At[m][k], acc[ai][bj][m][n], 0, 0, 0); __builtin_amdgcn_s_setprio(0); } while (0)
#define PG8_WAIT_V(n) asm volatile("s_waitcnt vmcnt(" #n ")" ::: "memory")
#define PG8_WAIT_L(n) asm volatile("s_waitcnt lgkmcnt(" #n ")" ::: "memory")
#define PG8_BAR __builtin_amdgcn_s_barrier()
#define PG8_SCHED __builtin_amdgcn_sched_barrier(0)
    Unit cur, nxt; int ui = 0;
    if (!g.next(0, cur)) return;
    f32x4 acc[2][2][4][2];
#pragma unroll
    for (int a = 0; a < 2; ++a)
#pragma unroll
        for (int b = 0; b < 2; ++b)
#pragma unroll
            for (int m = 0; m < 4; ++m)
#pragma unroll
                for (int n = 0; n < 2; ++n) acc[a][b][m][n] = (f32x4){0.f, 0.f, 0.f, 0.f};
    bf16x8 At[4][2], B0[2][2], B1[2][2];
    const char* cA = g.a_base(cur); const char* cB = g.b_base(cur);
    if constexpr (SP2) {
        PG8_STAGE(PG8_SB(0, 0), cB, voffB); PG8_STAGE(PG8_SB(0, 1), cB + hstepB, voffB); PG8_STAGE(PG8_SA(0, 0), cA, voffA); PG8_STAGE(PG8_SA(0, 1), cA + hstepA, voffA);
        if (wr == 1) PG8_BAR;
        PG8_WAIT_V(2); PG8_BAR;
        PG8_STAGE(PG8_SB(1, 0), cB + kstep, voffB); PG8_STAGE(PG8_SA(1, 0), cA + kstep, voffA); PG8_STAGE(PG8_SB(1, 1), cB + hstepB + kstep, voffB);
        PG8_WAIT_V(6); PG8_BAR;
    } else {
        PG8_STAGE(PG8_SB(0, 0), cB, voffB); PG8_STAGE(PG8_SA(0, 0), cA, voffA); PG8_STAGE(PG8_SB(0, 1), cB + hstepB, voffB); PG8_STAGE(PG8_SA(0, 1), cA + hstepA, voffA);
        if (wr == 1) PG8_BAR;
        PG8_WAIT_V(4); PG8_BAR;
        PG8_STAGE(PG8_SB(1, 0), cB + kstep, voffB); PG8_STAGE(PG8_SA(1, 0), cA + kstep, voffA); PG8_STAGE(PG8_SB(1, 1), cB + hstepB + kstep, voffB);
        PG8_WAIT_V(6); PG8_BAR;
    }
    for (;;) {
        const bool has_next = g.next(ui + 1, nxt);
        const char* nA = has_next ? g.a_base(nxt) : cA; const char* nB = has_next ? g.b_base(nxt) : cB;
#pragma unroll 1
        for (int t = 0; t < nt; t += 2) {
            const bool last = (t == nt - 2);
            const char* a1 = cA + (size_t)(t + 1) * kstep;
            const char* a2 = last ? nA : cA + (size_t)(t + 2) * kstep; const char* b2 = last ? nB : cB + (size_t)(t + 2) * kstep;
            const char* a3 = a2 + kstep; const char* b3 = b2 + kstep;
            if constexpr (SP2) {
            PG8_LDB(B0, 0, 0); PG8_LDB(B1, 0, 1); PG8_SCHED; PG8_LDA(At, 0, 0); PG8_STAGE(PG8_SA(1, 1), a1 + hstepA, voffA);
            PG8_WAIT_V(8); PG8_WAIT_L(0); PG8_BAR; PG8_MMA(0, 0, At, B0); PG8_MMA(0, 1, At, B1); PG8_BAR; PG8_SCHED;
            PG8_LDA(At, 0, 1); PG8_STAGE(PG8_SB(0, 0), b2, voffB); PG8_STAGE(PG8_SB(0, 1), b2 + hstepB, voffB); PG8_STAGE(PG8_SA(0, 0), a2, voffA);
            PG8_WAIT_V(8); PG8_WAIT_L(0); PG8_BAR; PG8_MMA(1, 0, At, B0); PG8_MMA(1, 1, At, B1); PG8_BAR; PG8_SCHED;
            PG8_LDB(B0, 1, 0); PG8_LDB(B1, 1, 1); PG8_SCHED; PG8_LDA(At, 1, 0); PG8_STAGE(PG8_SA(0, 1), a2 + hstepA, voffA);
            PG8_WAIT_V(8); PG8_WAIT_L(0); PG8_BAR; PG8_MMA(0, 0, At, B0); PG8_MMA(0, 1, At, B1); PG8_BAR; PG8_SCHED;
            PG8_LDA(At, 1, 1); PG8_STAGE(PG8_SB(1, 0), b3, voffB); PG8_STAGE(PG8_SB(1, 1), b3 + hstepB, voffB); PG8_STAGE(PG8_SA(1, 0), a3, voffA);
            PG8_WAIT_V(8); PG8_WAIT_L(0); PG8_BAR; PG8_MMA(1, 0, At, B0); PG8_MMA(1, 1, At, B1); PG8_BAR; PG8_SCHED;
            } else {
            PG8_LDB(B0, 0, 0); PG8_SCHED; PG8_LDA(At, 0, 0); PG8_STAGE(PG8_SA(1, 1), a1 + hstepA, voffA);
            PG8_WAIT_L(8); PG8_BAR; PG8_WAIT_L(0); PG8_MMA(0, 0, At, B0); PG8_BAR; PG8_SCHED;
            PG8_LDB(B1, 0, 1); PG8_STAGE(PG8_SB(0, 0), b2, voffB);
            PG8_BAR; PG8_WAIT_L(0); PG8_MMA(0, 1, At, B1); PG8_BAR;
            PG8_LDA(At, 0, 1); PG8_STAGE(PG8_SA(0, 0), a2, voffA);
            PG8_BAR; PG8_WAIT_L(0); PG8_MMA(1, 0, At, B0); PG8_BAR; PG8_SCHED;
            PG8_STAGE(PG8_SB(0, 1), b2 + hstepB, voffB);
            PG8_WAIT_V(6); PG8_BAR; PG8_MMA(1, 1, At, B1); PG8_BAR;
            PG8_LDB(B0, 1, 0); PG8_SCHED; PG8_LDA(At, 1, 0); PG8_STAGE(PG8_SA(0, 1), a2 + hstepA, voffA);
            PG8_WAIT_L(8); PG8_BAR; PG8_WAIT_L(0); PG8_MMA(0, 0, At, B0); PG8_BAR; PG8_SCHED;
            PG8_LDB(B1, 1, 1); PG8_STAGE(PG8_SB(1, 0), b3, voffB);
            PG8_BAR; PG8_WAIT_L(0); PG8_MMA(0, 1, At, B1); PG8_BAR;
            PG8_LDA(At, 1, 1); PG8_STAGE(PG8_SA(1, 0), a3, voffA);
            PG8_BAR; PG8_WAIT_L(0); PG8_MMA(1, 0, At, B0); PG8_BAR; PG8_SCHED;
            PG8_STAGE(PG8_SB(1, 1), b3 + hstepB, voffB);
            PG8_WAIT_V(6); PG8_BAR; PG8_MMA(1, 1, At, B1); PG8_BAR;
            }
        }
        if constexpr (ALIGN_EPI) { if (wr == 0) PG8_BAR; }
        E(acc, cur, wr, wc, fr, fq);
        if (!has_next) break;
#pragma unroll
        for (int a = 0; a < 2; ++a)
#pragma unroll
            for (int b = 0; b < 2; ++b)
#pragma unroll
                for (int m = 0; m < 4; ++m)
#pragma unroll
                    for (int n = 0; n < 2; ++n) acc[a][b][m][n] = (f32x4){0.f, 0.f, 0.f, 0.f};
        cur = nxt; cA = nA; cB = nB; ++ui;
        if constexpr (ALIGN_EPI) { if (wr == 1) PG8_BAR; }
    }
    PG8_WAIT_V(0);
    if constexpr (!ALIGN_EPI) { if (wr == 0) PG8_BAR; }
    PG8_BAR;
#undef PG8_SA
#undef PG8_SB
#undef PG8_STAGE
#undef PG8_LDA
#undef PG8_LDB
#undef PG8_MMA
#undef PG8_WAIT_V
#undef PG8_WAIT_L
#undef PG8_BAR
#undef PG8_SCHED
}

struct EpiBf16 {
    static constexpr bool PERM = true;
    bf16_t* O; long zs; int ldc, pad;
    __device__ __forceinline__ void operator()(const f32x4 (&acc)[2][2][4][2], const Unit& u, int wr, int wc, int fr, int fq) const {
        const int row0 = u.pm * BM + wr * 64 + fr, col0 = u.pn * BM + wc * 32 + 8 * fq; bf16_t* base = O + (long)u.z * zs;
#pragma unroll
        for (int ai = 0; ai < 2; ++ai)
#pragma unroll
            for (int m = 0; m < 4; ++m) { bf16_t* rowp = base + (size_t)(row0 + ai * HALF + m * 16) * ldc + col0;
#pragma unroll
                for (int bj = 0; bj < 2; ++bj) { const f32x4 v0 = acc[ai][bj][m][0], v1 = acc[ai][bj][m][1];
                    u32x4 w; w.x = pk2(v0[0], v0[1]); w.y = pk2(v0[2], v0[3]); w.z = pk2(v1[0], v1[1]); w.w = pk2(v1[2], v1[3]);
                    *(u32x4*)(rowp + bj * HALF) = w; } }
    }
};
struct EpiMem {
    static constexpr bool PERM = false;
    float* outK; float* outV; bf16_t* kb; bf16_t* vt;
    __device__ __forceinline__ void operator()(const f32x4 (&acc)[2][2][4][2], const Unit& u, int wr, int wc, int fr, int fq) const {
        const int row0 = u.pm * BM + wr * 64 + fr, col0 = u.pn * BM + wc * 32 + 4 * fq;
#pragma unroll
        for (int ai = 0; ai < 2; ++ai)
#pragma unroll
            for (int m = 0; m < 4; ++m) { const int row = row0 + ai * HALF + m * 16;
#pragma unroll
                for (int bj = 0; bj < 2; ++bj)
#pragma unroll
                    for (int n = 0; n < 2; ++n) { const int col = col0 + bj * HALF + n * 16; const f32x4 v = acc[ai][bj][m][n];
                        if (col < 1024) { *(f32x4*)(outK + ((size_t)u.z * 512 + row) * 1024 + col) = v;
                            u32x2 w; w.x = pk2(v[0], v[1]); w.y = pk2(v[2], v[3]); *(u32x2*)(kb + ((size_t)u.z * 512 + row) * 1024 + col) = w; }
                        else { const int c = col - 1024; *(f32x4*)(outV + ((size_t)u.z * 512 + row) * 1024 + c) = v;
                            const int b = row >> 8, mm = row & 255, h = c >> 8, d = c & 255; bf16_t* p = vt + ((((size_t)u.z * 2 + b) * 4 + h) * 256 + d) * 256 + mm;
                            p[0] = f2bf(v[0]); p[256] = f2bf(v[1]); p[512] = f2bf(v[2]); p[768] = f2bf(v[3]); } } }
    }
};
struct EpiMerge {
    static constexpr bool PERM = true;
    float* MG; bf16_t* MGB; const bf16_t* U; const float* gate_b;
    __device__ __forceinline__ void operator()(const f32x4 (&acc)[2][2][4][2], const Unit& u, int wr, int wc, int fr, int fq) const {
        const int row0 = u.pm * BM + wr * 64 + fr, col0 = u.pn * BM + wc * 32 + 8 * fq;
#pragma unroll
        for (int bj = 0; bj < 2; ++bj) { const int col = col0 + bj * HALF; const f32x4 gb0 = *(const f32x4*)(gate_b + u.z * DM + col), gb1 = *(const f32x4*)(gate_b + u.z * DM + col + 4);
#pragma unroll
            for (int ai = 0; ai < 2; ++ai)
#pragma unroll
                for (int m = 0; m < 4; ++m) { const int row = row0 + ai * HALF + m * 16; float gp[8], r[8];
                    unpack8(*(const u32x4*)(U + (size_t)row * NINP + U_GP + u.z * DM + col), gp);
#pragma unroll
                    for (int j = 0; j < 4; ++j) { r[j] = sigmoidf_(gp[j] + gb0[j]) * acc[ai][bj][m][0][j]; r[4 + j] = sigmoidf_(gp[4 + j] + gb1[j]) * acc[ai][bj][m][1][j]; }
                    bf16_t* mp = MGB + (size_t)row * DM + col;
                    if (u.z > 0) { float pv[8]; unpack8(*(const u32x4*)mp, pv);
#pragma unroll
                        for (int j = 0; j < 8; ++j) r[j] += pv[j]; }
                    *(u32x4*)mp = (u32x4){pk2(r[0], r[1]), pk2(r[2], r[3]), pk2(r[4], r[5]), pk2(r[6], r[7])}; } }
    }
};
struct EpiRes {
    static constexpr bool PERM = true;
    const bf16_t* R; bf16_t* Y;
    __device__ __forceinline__ void operator()(const f32x4 (&acc)[2][2][4][2], const Unit& u, int wr, int wc, int fr, int fq) const {
        const int row0 = u.pm * BM + wr * 64 + fr, col0 = u.pn * BM + wc * 32 + 8 * fq;
#pragma unroll
        for (int ai = 0; ai < 2; ++ai)
#pragma unroll
            for (int m = 0; m < 4; ++m) { const size_t ro = (size_t)(row0 + ai * HALF + m * 16) * DM + col0;
#pragma unroll
                for (int bj = 0; bj < 2; ++bj) { const size_t o = ro + bj * HALF; float rv[8]; unpack8(*(const u32x4*)(R + o), rv);
                    const f32x4 y0 = (f32x4){rv[0], rv[1], rv[2], rv[3]} * ALPHA + acc[ai][bj][m][0], y1 = (f32x4){rv[4], rv[5], rv[6], rv[7]} * ALPHA + acc[ai][bj][m][1];
                    *(u32x4*)(Y + o) = (u32x4){pk2(y0[0], y0[1]), pk2(y0[2], y0[3]), pk2(y1[0], y1[1]), pk2(y1[2], y1[3])}; } }
    }
};
struct EpiSwiGLU {
    static constexpr bool PERM = true;
    bf16_t* O;
    __device__ __forceinline__ void operator()(const f32x4 (&acc)[2][2][4][2], const Unit& u, int wr, int wc, int fr, int fq) const {
        const int row0 = u.pm * BM + wr * 64 + fr, col0 = u.pn * HALF + wc * 32 + 8 * fq;
#pragma unroll
        for (int ai = 0; ai < 2; ++ai)
#pragma unroll
            for (int m = 0; m < 4; ++m) { bf16_t* rowp = O + (size_t)(row0 + ai * HALF + m * 16) * DFF + col0;
                float r[8];
#pragma unroll
                for (int n = 0; n < 2; ++n)
#pragma unroll
                    for (int j = 0; j < 4; ++j) { const float gg = acc[ai][0][m][n][j], uu = acc[ai][1][m][n][j]; r[n * 4 + j] = gg * sigmoidf_(gg) * uu; }
                u32x4 w; w.x = pk2(r[0], r[1]); w.y = pk2(r[2], r[3]); w.z = pk2(r[4], r[5]); w.w = pk2(r[6], r[7]);
                *(u32x4*)rowp = w; }
    }
};
struct EpiScore {
    static constexpr bool PERM = false;
    float* SC;
    __device__ __forceinline__ void operator()(const f32x4 (&acc)[2][2][4][2], const Unit& u, int wr, int wc, int fr, int fq) const {
        const int row0 = u.pm * BM + wr * 64 + fr, col0 = wc * 32 + 4 * fq; float* base = SC + (size_t)u.z * 4096 * 256;
#pragma unroll
        for (int ai = 0; ai < 2; ++ai)
#pragma unroll
            for (int m = 0; m < 4; ++m) { float* rowp = base + (size_t)(row0 + ai * HALF + m * 16) * 256 + col0;
#pragma unroll
                for (int bj = 0; bj < 2; ++bj)
#pragma unroll
                    for (int n = 0; n < 2; ++n) *(f32x4*)(rowp + bj * HALF + n * 16) = acc[ai][bj][m][n] * 0.0625f; }
    }
};
struct EpiPV {
    static constexpr bool PERM = true;
    bf16_t* O;
    __device__ __forceinline__ void operator()(const f32x4 (&acc)[2][2][4][2], const Unit& u, int wr, int wc, int fr, int fq) const {
        const int b = u.z >> 2, h = u.z & 3; const int row0 = b * PS + u.pm * BM + wr * 64 + fr, col0 = h * 256 + wc * 32 + 8 * fq;
#pragma unroll
        for (int ai = 0; ai < 2; ++ai)
#pragma unroll
            for (int m = 0; m < 4; ++m) { bf16_t* rowp = O + (size_t)(row0 + ai * HALF + m * 16) * BW + col0;
#pragma unroll
                for (int bj = 0; bj < 2; ++bj) { const f32x4 v0 = acc[ai][bj][m][0], v1 = acc[ai][bj][m][1];
                    u32x4 w; w.x = pk2(v0[0], v0[1]); w.y = pk2(v0[2], v0[3]); w.z = pk2(v1[0], v1[1]); w.w = pk2(v1[2], v1[3]);
                    *(u32x4*)(rowp + bj * HALF) = w; } }
    }
};
}


#define XB_TMO      128
#define XB_XCNT(j)  (256  + 64 * (j))
#define XB_XSUB(j)  (1280 + 64 * (j))
#define XB_XGEN(j)  (2304 + 64 * (j))
#define XB_TOP      3328
#define XB_TOPGEN   3392
#define XCD_BAR_WORDS 3456
#define XB_SPIN_CAP (1u << 18)
__device__ __forceinline__ unsigned xb_ld(unsigned* p)              { return __hip_atomic_load(p, __ATOMIC_RELAXED, __HIP_MEMORY_SCOPE_AGENT); }
__device__ __forceinline__ unsigned xb_add(unsigned* p, unsigned v) { return __hip_atomic_fetch_add(p, v, __ATOMIC_RELAXED, __HIP_MEMORY_SCOPE_AGENT); }
__device__ __forceinline__ unsigned xb_xcc_id() { return (unsigned)__builtin_amdgcn_s_getreg((3 << 11) | 20) & 0xFu; }
#define XB_SPIN(cond, bar) do { unsigned _sp = 0; while (cond) { __builtin_amdgcn_s_sleep(1); \
    if ((++_sp & 255u) == 0u) { if (xb_ld(&(bar)[XB_TMO])) break; if (_sp > XB_SPIN_CAP) { atomicAdd(&(bar)[XB_TMO], 1u); break; } } } } while (0)
struct XcdBarrier { unsigned* bar; unsigned x; volatile LAS unsigned* st; };
__device__ __forceinline__ XcdBarrier xcd_barrier_post(unsigned* bar, volatile LAS unsigned* st) {
    XcdBarrier b; b.bar = bar; b.x = xb_xcc_id(); b.st = st;
    if (threadIdx.x == 0) (void)xb_add(&bar[XB_XCNT(b.x)], 1u);
    return b;
}
__device__ __forceinline__ void xcd_barrier_complete(unsigned* bar, unsigned x, unsigned& nloc, unsigned& nx) {
    const unsigned G = gridDim.x * gridDim.y * gridDim.z;
    unsigned sum, cnt, mine, sp = 0u;
    for (;;) {
        sum = 0u; cnt = 0u; mine = 0u;
#pragma unroll
        for (unsigned j = 0; j < 16; ++j) { const unsigned c = xb_ld(&bar[XB_XCNT(j)]); sum += c; cnt += (c > 0u) ? 1u : 0u; mine = (j == x) ? c : mine; }
        if (sum == G) break;
        __builtin_amdgcn_s_sleep(1);
        if ((++sp & 255u) == 0u) { if (xb_ld(&bar[XB_TMO])) break; if (sp > XB_SPIN_CAP) { atomicAdd(&bar[XB_TMO], 1u); break; } }
    }
    nloc = mine > 0u ? mine : 1u; nx = cnt > 0u ? cnt : 1u;
}
__device__ __forceinline__ void xcd_barrier(const XcdBarrier& b) {
    asm volatile("s_waitcnt vmcnt(0)" ::: "memory");
    __syncthreads();
    if (threadIdx.x == 0) {
        unsigned* bar = b.bar;
        __builtin_amdgcn_s_waitcnt(0);
        unsigned nloc = b.st[0], nx = b.st[1];
        if (nloc == 0u) { xcd_barrier_complete(bar, b.x, nloc, nx); b.st[0] = nloc; b.st[1] = nx; }
        const unsigned old = xb_add(&bar[XB_XSUB(b.x)], 1u);
        const unsigned gen = old / nloc;
        if (old + 1u == (gen + 1u) * nloc) {
            __builtin_amdgcn_fence(__ATOMIC_RELEASE, "agent");
            asm volatile("s_waitcnt vmcnt(0)" ::: "memory");
            const unsigned og = xb_add(&bar[XB_TOP], 1u);
            const unsigned tg = og / nx;
            if (og + 1u == (tg + 1u) * nx) xb_add(&bar[XB_TOPGEN], 1u);
            else XB_SPIN(xb_ld(&bar[XB_TOPGEN]) == tg, bar);
            __builtin_amdgcn_fence(__ATOMIC_ACQUIRE, "agent");
            xb_add(&bar[XB_XGEN(b.x)], 1u);
            asm volatile("s_waitcnt vmcnt(0)" ::: "memory");
        } else {
            XB_SPIN(xb_ld(&bar[XB_XGEN(b.x)]) == gen, bar);
            __builtin_amdgcn_fence(__ATOMIC_ACQUIRE, "agent");
            asm volatile("s_waitcnt vmcnt(0)" ::: "memory");
        }
    }
    __syncthreads();
}

struct Ctx { int tid, lane, wave, bid, G; LAS unsigned char* lds; };
__device__ __forceinline__ Ctx fresh(const Ctx& c0) { Ctx c; c.wave = c0.wave; c.bid = c0.bid; c.G = c0.G; c.lds = c0.lds; asm volatile("" : "+s"(c.bid), "+s"(c.G), "+s"(c.wave));
    int lane = (int)__builtin_amdgcn_mbcnt_hi(~0u, __builtin_amdgcn_mbcnt_lo(~0u, 0u)); asm volatile("" : "+v"(lane)); c.lane = lane; c.tid = c.wave * 64 + lane; return c; }

__device__ __forceinline__ int colmap(int mode, int n) {
    if (mode == 1) return n < 3088 ? n : (n < 3328 ? -1 : n - 240);
    if (mode == 2) { const int t = n >> 8, j = n & 255; return j < 128 ? t * 128 + j : DFF + t * 128 + (j - 128); }
    return n;
}
__device__ __forceinline__ void wprep_load(f32x4 (&rg)[8], const float* __restrict__ src, int K, int Nsrc, int Ndst, int mode, size_t sbs, int item, int tid) {
    const int nx = Ndst / 256, ny = K / 64; const int bx = item % nx, by = (item / nx) % ny, bz = item / (nx * ny);
    const int tx = tid & 63, ty = tid >> 6, cm = colmap(mode, bx * 256 + tx * 4); const float* s = src + (size_t)bz * sbs + (size_t)(by * 64 + ty) * Nsrc + cm;
#pragma unroll
    for (int i = 0; i < 8; ++i) rg[i] = cm >= 0 ? *(const f32x4*)(s + (size_t)(8 * i) * Nsrc) : (f32x4){0.f, 0.f, 0.f, 0.f};
}
__device__ __forceinline__ void ph_wprep(const Ctx& c, const float* __restrict__ src, bf16_t* __restrict__ dst, int K, int Nsrc, int Ndst, int mode, int nbatch, size_t sbs, size_t dbs) {
    LAS float* tile = (LAS float*)c.lds;
    const int nx = Ndst / 256, ny = K / 64, total = nx * ny * nbatch;
    const int tid = c.tid, tx = tid & 63, ty = tid >> 6, n = tid >> 1, kh = tid & 1;
    f32x4 rg[8];
    int item = c.bid;
    if (item < total) wprep_load(rg, src, K, Nsrc, Ndst, mode, sbs, item, tid);
    for (; item < total; item += c.G) {
        __syncthreads();
#pragma unroll
        for (int i = 0; i < 8; ++i) *(LAS f32x4*)(tile + (ty + 8 * i) * 260 + tx * 4) = rg[i];
        __syncthreads();
        const int bx = item % nx, by = (item / nx) % ny, bz = item / (nx * ny);
        if (item + c.G < total) wprep_load(rg, src, K, Nsrc, Ndst, mode, sbs, item + c.G, tid);
        bf16_t* d = dst + (size_t)bz * dbs + (size_t)(bx * 256 + n) * K + by * 64 + kh * 32;
#pragma unroll
        for (int g = 0; g < 4; ++g) { unsigned p[4];
#pragma unroll
            for (int e = 0; e < 4; ++e) p[e] = pk2(tile[(kh * 32 + g * 8 + 2 * e) * 260 + n], tile[(kh * 32 + g * 8 + 2 * e + 1) * 260 + n]);
            *(u32x4*)(d + g * 8) = (u32x4){p[0], p[1], p[2], p[3]}; }
    }
    __syncthreads();
}
__device__ __forceinline__ void ph_xprep(const Ctx& c, const float* __restrict__ xp, const float* __restrict__ xs, const float* __restrict__ mem, float* __restrict__ HF, bf16_t* __restrict__ HB, bf16_t* __restrict__ MEMB) {
    const size_t nH = (size_t)MPAD * DM / 4, nM = (size_t)512 * DM / 4;
    for (size_t i4 = (size_t)c.bid * 512 + c.tid; i4 < nH + nM; i4 += (size_t)c.G * 512) {
        if (i4 < nH) {
            const size_t e = i4 * 4; f32x4 v = (f32x4){0.f, 0.f, 0.f, 0.f};
            if (e < (size_t)MP * DM) v = *(const f32x4*)(xp + e); else if (e < (size_t)MT * DM) v = *(const f32x4*)(xs + (e - (size_t)MP * DM));
            if (HF != nullptr) *(f32x4*)(HF + e) = v;
            u32x2 w; w.x = pk2(v[0], v[1]); w.y = pk2(v[2], v[3]); *(u32x2*)(HB + e) = w;
        } else {
            const size_t e = (i4 - nH) * 4; const f32x4 v = *(const f32x4*)(mem + e); u32x2 w; w.x = pk2(v[0], v[1]); w.y = pk2(v[2], v[3]); *(u32x2*)(MEMB + e) = w;
        }
    }
}
__device__ __forceinline__ void ph_ln(const Ctx& c, const bf16_t* __restrict__ Y, const float* __restrict__ g, const float* __restrict__ b, float* __restrict__ XF, bf16_t* __restrict__ XB, float* __restrict__ OUT, int nrows, int nout) {
    const int lane = c.lane;
    for (int row = c.bid * 8 + c.wave; row < nrows; row += c.G * 8) {
        const bf16_t* y = Y + (size_t)row * DM; float v[4][8]; float s = 0.f;
#pragma unroll
        for (int j = 0; j < 4; ++j) { unpack8(*(const u32x4*)(y + j * 512 + lane * 8), v[j]);
#pragma unroll
            for (int e2 = 0; e2 < 8; ++e2) s += v[j][e2]; }
        const float mean = wave_sum(s) * (1.0f / DM); float q = 0.f;
#pragma unroll
        for (int j = 0; j < 4; ++j)
#pragma unroll
            for (int e2 = 0; e2 < 8; ++e2) { const float d = v[j][e2] - mean; q += d * d; }
        const float rstd = rsqrtf(wave_sum(q) * (1.0f / DM) + 1e-5f);
#pragma unroll
        for (int j = 0; j < 4; ++j) { const int cc = j * 512 + lane * 8; const f32x4 g0 = *(const f32x4*)(g + cc), g1 = *(const f32x4*)(g + cc + 4), b0 = *(const f32x4*)(b + cc), b1 = *(const f32x4*)(b + cc + 4);
            const f32x4 o0 = ((f32x4){v[j][0], v[j][1], v[j][2], v[j][3]} - mean) * rstd * g0 + b0, o1 = ((f32x4){v[j][4], v[j][5], v[j][6], v[j][7]} - mean) * rstd * g1 + b1;
            const size_t off = (size_t)row * DM + cc;
            if (XF != nullptr) { *(f32x4*)(XF + off) = o0; *(f32x4*)(XF + off + 4) = o1; }
            *(u32x4*)(XB + off) = (u32x4){pk2(o0[0], o0[1]), pk2(o0[2], o0[3]), pk2(o1[0], o1[1]), pk2(o1[2], o1[3])};
            if (OUT != nullptr && row < nout) { *(f32x4*)(OUT + off) = o0; *(f32x4*)(OUT + off + 4) = o1; } }
    }
}
__device__ __forceinline__ void ph_softmax256(const Ctx& c, const float* __restrict__ SC, bf16_t* __restrict__ P, int nrows) {
    const int lane = c.lane;
    for (int row = c.bid * 8 + c.wave; row < nrows; row += c.G * 8) {
        const f32x4 v = *(const f32x4*)(SC + (size_t)row * 256 + lane * 4);
        const float mx = wave_max(fmaxf(fmaxf(v[0], v[1]), fmaxf(v[2], v[3])));
        f32x4 e; e[0] = __expf(v[0] - mx); e[1] = __expf(v[1] - mx); e[2] = __expf(v[2] - mx); e[3] = __expf(v[3] - mx);
        const float inv = 1.0f / wave_sum((e[0] + e[1]) + (e[2] + e[3]));
        u32x2 w; w.x = pk2(e[0] * inv, e[1] * inv); w.y = pk2(e[2] * inv, e[3] * inv); *(u32x2*)(P + (size_t)row * 256 + lane * 4) = w;
    }
}
__device__ __forceinline__ void ph_copy_outs(const Ctx& c, const bf16_t* __restrict__ U, const float* __restrict__ ck, const float* __restrict__ cv, float* __restrict__ out, int layer) {
    constexpr int nA = PB * 128 * 128, nB = SB * 128 * 128, nC = PB * RWC, nD = SB * RWC;
    for (int i = c.bid * 512 + c.tid; i < nA + nB + nC + nD; i += c.G * 512) {
        if (i < nA) { const int b = i / 16384, j = (i >> 7) & 127, cc = i & 127; const size_t ur = (size_t)(b * PS + PS - 128 + j) * NINP;
            out[O_SWKP + (size_t)layer * nA + i] = bf2f(U[ur + U_SK + cc]); out[O_SWVP + (size_t)layer * nA + i] = bf2f(U[ur + U_SV + cc]); continue; }
        int k = i - nA;
        if (k < nB) { const int sq = k / 16384, j = (k >> 7) & 127, cc = k & 127; float kv, vv;
            if (j < 124) { const size_t o = ((size_t)sq * 128 + j + 4) * 128 + cc; kv = ck[o]; vv = cv[o]; }
            else { const size_t ur = (size_t)(MP + sq * SS + j - 124) * NINP; kv = bf2f(U[ur + U_SK + cc]); vv = bf2f(U[ur + U_SV + cc]); }
            out[O_SWKS + (size_t)layer * nB + k] = kv; out[O_SWVS + (size_t)layer * nB + k] = vv; continue; }
        k -= nB;
        if (k < nC) { const int b = k / RWC, cc = k - b * RWC; out[O_RSP + (size_t)layer * nC + k] = bf2f(U[(size_t)(b * PS + PS - 1) * NINP + U_RU + cc]); continue; }
        k -= nC;
        { const int sq = k / RWC, cc = k - sq * RWC; out[O_RSS + (size_t)layer * nD + k] = bf2f(U[(size_t)(MP + sq * SS + SS - 1) * NINP + U_RU + cc]); }
    }
}

__device__ __forceinline__ void seq_info(int sq, int& row0, int& L) { if (sq < PB) { row0 = sq * PS; L = PS; } else { row0 = MP + (sq - PB) * SS; L = SS; } }

__device__ __forceinline__ void ph_gla_naive(const Ctx& c, const bf16_t* __restrict__ U, const float* __restrict__ s0, const float* __restrict__ a_up, const float* __restrict__ a_b,
                                             const float* __restrict__ ng, const float* __restrict__ nb, bf16_t* __restrict__ OB, float* __restrict__ outP, float* __restrict__ outS) {
    LAS float* qs = (LAS float*)c.lds;
    LAS float* ks = qs + 16 * 128; LAS float* as = ks + 16 * 128; LAS float* os = as + 16 * 128;
    const int kh = c.tid >> 8, vt = c.tid & 255, lane = c.lane;
    for (int u = c.bid; u < (PB + SB) * 4; u += c.G) {
        const int sq = u >> 2, h = u & 3;
        int row0, L; seq_info(sq, row0, L);
        float S[64];
        if (sq >= PB) { const float* p = s0 + (((size_t)(sq - PB) * 4 + h) * 128 + kh * 64) * 256 + vt;
#pragma unroll
            for (int kk = 0; kk < 64; ++kk) S[kk] = p[(size_t)kk * 256]; }
        else {
#pragma unroll
            for (int kk = 0; kk < 64; ++kk) S[kk] = 0.f; }
        for (int t0 = 0; t0 < L; t0 += 16) {
            const int nT = (L - t0) < 16 ? (L - t0) : 16;
            for (int idx = c.tid; idx < nT * 128; idx += 512) {
                const int tt = idx >> 7, kk = idx & 127; const bf16_t* ur = U + (size_t)(row0 + t0 + tt) * NINP;
                qs[idx] = bf2f(ur[U_GQ + h * 128 + kk]) * 0.08838834764831845f; ks[idx] = bf2f(ur[U_GK + h * 128 + kk]);
                float x = a_b[h * 128 + kk];
#pragma unroll
                for (int r = 0; r < 16; ++r) x += bf2f(ur[U_GA + r]) * a_up[r * 512 + h * 128 + kk];
                const float ls = (fminf(x, 0.f) - log1pf(__expf(-fabsf(x)))) * (1.0f / 16.0f);
                as[idx] = __expf(ls);
            }
            __syncthreads();
            for (int tt = 0; tt < nT; ++tt) {
                const float v = bf2f(U[(size_t)(row0 + t0 + tt) * NINP + U_GV + h * 256 + vt]); float o = 0.f; const int lb = tt * 128 + kh * 64;
#pragma unroll
                for (int kk = 0; kk < 64; ++kk) { S[kk] = as[lb + kk] * S[kk] + ks[lb + kk] * v; o += qs[lb + kk] * S[kk]; }
                os[(kh * 16 + tt) * 256 + vt] = o;
            }
            __syncthreads();
            for (int tt = c.wave; tt < nT; tt += 8) {
                float x[4]; float s = 0.f;
#pragma unroll
                for (int j = 0; j < 4; ++j) { x[j] = os[tt * 256 + lane + 64 * j] + os[(16 + tt) * 256 + lane + 64 * j]; s += x[j]; }
                const float mean = wave_sum(s) * (1.0f / 256.0f); float q = 0.f;
#pragma unroll
                for (int j = 0; j < 4; ++j) { const float d = x[j] - mean; q += d * d; }
                const float rstd = rsqrtf(wave_sum(q) * (1.0f / 256.0f) + 1e-5f);
                const size_t row = (size_t)(row0 + t0 + tt);
#pragma unroll
                for (int j = 0; j < 4; ++j) { const int cc = h * 256 + lane + 64 * j; const float n = (x[j] - mean) * rstd * ng[cc] + nb[cc];
                    const float gr = bf2f(U[row * NINP + U_GR + cc]); OB[row * BW + cc] = f2bf(n * gr * sigmoidf_(gr)); }
            }
            __syncthreads();
        }
        float* op = (sq < PB ? outP + (((size_t)sq * 4 + h) * 128 + kh * 64) * 256 : outS + (((size_t)(sq - PB) * 4 + h) * 128 + kh * 64) * 256) + vt;
#pragma unroll
        for (int kk = 0; kk < 64; ++kk) op[(size_t)kk * 256] = S[kk];
    }
}

__device__ __forceinline__ f32x4 mma16(bf16x8 x, bf16x8 y, f32x4 c) { return __builtin_amdgcn_mfma_f32_16x16x32_bf16(x, y, c, 0, 0, 0); }
__device__ __forceinline__ bf16x8 pack_acc(const f32x4& a, const f32x4& b) {
    u32x4 p; p.x = pk2(a[0], a[1]); p.y = pk2(a[2], a[3]); p.z = pk2(b[0], b[1]); p.w = pk2(b[2], b[3]); return __builtin_bit_cast(bf16x8, p);
}
__device__ __forceinline__ void gla_chunk_info(int u, int& row0, int& ntok, int& h) {
    if (u < 512) { const int b = u >> 8; h = (u >> 6) & 3; row0 = b * PS + (u & 63) * 64; ntok = 64; }
    else { const int s = u - 512; h = s & 3; row0 = MP + (s >> 2) * SS; ntok = SS; }
}
__device__ __forceinline__ void ph_gla_pre(const Ctx& c, const bf16_t* __restrict__ U, const float* __restrict__ a_up, const float* __restrict__ a_b,
                                           bf16_t* __restrict__ QD, bf16_t* __restrict__ KHT, bf16_t* __restrict__ EE, bf16_t* __restrict__ VT, float* __restrict__ GC) {
    LAS float* ga_l = (LAS float*)c.lds;
    LAS float* tot = ga_l + 64 * 16;
    LAS bf16_t* Qd_l = (LAS bf16_t*)(tot + 4 * 128);
    LAS bf16_t* Kn_l = Qd_l + 64 * 136;
    LAS bf16_t* v_l = Kn_l + 64 * 136;
    LAS bf16_t* qr_l = v_l + 64 * 264;
    LAS bf16_t* kr_l = qr_l + 64 * 136;
    const int tid = c.tid, lane = c.lane, r = lane & 15, q = lane >> 4, w = c.wave;
    for (int u = (c.bid + c.G / 2) % c.G; u < GL_NCH; u += c.G) {
        int row0, ntok, h; gla_chunk_info(u, row0, ntok, h);
        for (int i = tid; i < 64 * 16; i += 512) { const int t = i >> 4, rr = i & 15; ga_l[i] = t < ntok ? bf2f(U[(size_t)(row0 + t) * NINP + U_GA + rr]) : 0.f; }
        for (int i = tid; i < 64 * 32; i += 512) { const int t = i >> 5, c8 = i & 31; u32x4 vv = (u32x4){0u, 0u, 0u, 0u};
            if (t < ntok) vv = *(const u32x4*)(U + (size_t)(row0 + t) * NINP + U_GV + h * 256 + c8 * 8);
            *(LAS u32x4*)(v_l + t * 264 + c8 * 8) = vv; }
        for (int i = tid; i < 64 * 16; i += 512) { const int t = i >> 4, c8 = i & 15; u32x4 qv = (u32x4){0u, 0u, 0u, 0u}, kv = qv;
            if (t < ntok) { const bf16_t* ur = U + (size_t)(row0 + t) * NINP + h * 128 + c8 * 8; qv = *(const u32x4*)(ur + U_GQ); kv = *(const u32x4*)(ur + U_GK); }
            *(LAS u32x4*)(qr_l + t * 136 + c8 * 8) = qv; *(LAS u32x4*)(kr_l + t * 136 + c8 * 8) = kv; }
        __syncthreads();
        const int kk = tid & 127, tq = tid >> 7;
        float cum[16];
        { float aup[16];
#pragma unroll
          for (int rr = 0; rr < 16; ++rr) aup[rr] = a_up[rr * 512 + h * 128 + kk];
          const float ab = a_b[h * 128 + kk]; float run = 0.f;
#pragma unroll
          for (int j = 0; j < 16; ++j) { const int t = tq * 16 + j; float x = ab;
#pragma unroll
              for (int rr = 0; rr < 16; ++rr) x += ga_l[t * 16 + rr] * aup[rr];
              const float la = t < ntok ? (fminf(x, 0.f) - __logf(1.0f + __expf(-fabsf(x)))) * (1.0f / 16.0f) : 0.f;
              run += la; cum[j] = run; }
          tot[tq * 128 + kk] = run; }
        __syncthreads();
        { float prefix = 0.f, bC = 0.f;
#pragma unroll
          for (int g = 0; g < 4; ++g) { const float tv = tot[g * 128 + kk]; bC += tv; if (g < tq) prefix += tv; }
          unsigned khp[8];
#pragma unroll
          for (int j = 0; j < 16; j += 2) { float kh2[2];
#pragma unroll
              for (int e = 0; e < 2; ++e) { const int t = tq * 16 + j + e; const float b = prefix + cum[j + e]; const float qv = bf2f(qr_l[t * 136 + kk]), kv = bf2f(kr_l[t * 136 + kk]);
                  Qd_l[t * 136 + kk] = f2bf(qv * __expf(b) * 0.08838834764831845f); Kn_l[t * 136 + kk] = f2bf(kv * __expf(-b)); kh2[e] = kv * __expf(bC - b); }
              khp[j >> 1] = pk2(kh2[0], kh2[1]); }
          bf16_t* kp = KHT + (size_t)u * 8192 + kk * 64 + tq * 16;
          *(u32x4*)kp = (u32x4){khp[0], khp[1], khp[2], khp[3]}; *(u32x4*)(kp + 8) = (u32x4){khp[4], khp[5], khp[6], khp[7]};
          if (tq == 0) GC[(size_t)u * 128 + kk] = __expf(bC); }
        __syncthreads();
        { const int tb = w >> 1;
#pragma unroll
          for (int e = 0; e < 2; ++e) { const int ib = (w & 1) * 2 + e; f32x4 d = (f32x4){0.f, 0.f, 0.f, 0.f};
              if (ib <= tb) {
                  bf16x8 kf4[4], qf4[4];
#pragma unroll
                  for (int ks = 0; ks < 4; ++ks) { kf4[ks] = *(const LAS bf16x8*)(Kn_l + (ib * 16 + r) * 136 + ks * 32 + q * 8); qf4[ks] = *(const LAS bf16x8*)(Qd_l + (tb * 16 + r) * 136 + ks * 32 + q * 8); }
                  __builtin_amdgcn_sched_barrier(0);
#pragma unroll
                  for (int ks = 0; ks < 4; ++ks) d = mma16(kf4[ks], qf4[ks], d); }
              const int t = tb * 16 + r, i0 = ib * 16 + q * 4;
#pragma unroll
              for (int jj = 0; jj < 4; ++jj) if (i0 + jj > t) d[jj] = 0.f;
              u32x2 o; o.x = pk2(d[0], d[1]); o.y = pk2(d[2], d[3]); *(u32x2*)(EE + (size_t)u * 4096 + t * 64 + i0) = o; } }
        for (int i = tid; i < 64 * 16; i += 512) { const int t = i >> 4, c8 = i & 15; *(u32x4*)(QD + (size_t)u * 8192 + t * 128 + c8 * 8) = *(const LAS u32x4*)(Qd_l + t * 136 + c8 * 8); }
        { const int val = tid & 255, th = tid >> 8;
#pragma unroll
          for (int tg = 0; tg < 4; ++tg) { const int t0 = th * 32 + tg * 8; unsigned p4[4];
#pragma unroll
              for (int e = 0; e < 4; ++e) p4[e] = (unsigned)v_l[(t0 + 2 * e) * 264 + val] | ((unsigned)v_l[(t0 + 2 * e + 1) * 264 + val] << 16);
              *(u32x4*)(VT + (size_t)u * 16384 + val * 64 + t0) = (u32x4){p4[0], p4[1], p4[2], p4[3]}; } }
        __syncthreads();
    }
}
struct GlaStage { u32x4 qd[2], kh[2], e, vt, gc; };
__device__ __forceinline__ void gla_stage_load(GlaStage& s, const bf16_t* __restrict__ QD, const bf16_t* __restrict__ KHT, const bf16_t* __restrict__ EE, const bf16_t* __restrict__ VT, const float* __restrict__ GC,
                                               int ch, int sl, int tid) {
    const bf16_t* qp = QD + (size_t)ch * 8192 + tid * 8; s.qd[0] = *(const u32x4*)qp; s.qd[1] = *(const u32x4*)(qp + 4096);
    const bf16_t* kp = KHT + (size_t)ch * 8192 + tid * 8; s.kh[0] = *(const u32x4*)kp; s.kh[1] = *(const u32x4*)(kp + 4096);
    s.e = *(const u32x4*)(EE + (size_t)ch * 4096 + tid * 8);
    s.vt = *(const u32x4*)(VT + (size_t)ch * 16384 + sl * 4096 + tid * 8);
    if (tid < 32) s.gc = *(const u32x4*)(GC + (size_t)ch * 128 + tid * 4);
}
constexpr int GS_KH = 8704, GS_E = 17920, GS_VT = 22528, GS_GC = 27136, GS_EL = 27392;
__device__ __forceinline__ void gla_stage_store(const GlaStage& s, LAS bf16_t* b, int tid) {
    *(LAS u32x4*)(b + (tid >> 4) * 136 + (tid & 15) * 8) = s.qd[0]; *(LAS u32x4*)(b + (32 + (tid >> 4)) * 136 + (tid & 15) * 8) = s.qd[1];
    *(LAS u32x4*)(b + GS_KH + (tid >> 3) * 72 + (tid & 7) * 8) = s.kh[0]; *(LAS u32x4*)(b + GS_KH + (64 + (tid >> 3)) * 72 + (tid & 7) * 8) = s.kh[1];
    *(LAS u32x4*)(b + GS_E + (tid >> 3) * 72 + (tid & 7) * 8) = s.e; *(LAS u32x4*)(b + GS_VT + (tid >> 3) * 72 + (tid & 7) * 8) = s.vt;
    if (tid < 32) *(LAS u32x4*)(b + GS_GC + tid * 8) = s.gc;
}
__device__ __forceinline__ void ph_gla_seq(const Ctx& c, int boff, const bf16_t* __restrict__ QD, const bf16_t* __restrict__ KHT, const bf16_t* __restrict__ EE, const bf16_t* __restrict__ VT, const float* __restrict__ GC,
                                           const float* __restrict__ s0, float* __restrict__ outP, float* __restrict__ outS, bf16_t* __restrict__ OB) {
    LAS bf16_t* stg = (LAS bf16_t*)c.lds;
    LAS bf16_t* T_l = stg + 2 * GS_EL;
    const int tid = c.tid, lane = c.lane, r = lane & 15, q = lane >> 4, w = c.wave;
    const int side = c.bid < 32 ? c.bid : c.bid - 64, nside = c.G - 64;
    for (int u = (c.bid >= boff && c.bid < boff + 32) ? c.bid - boff : ((c.bid < 32 || c.bid >= 96) ? 32 + side : 32 + 512); u < 32 + 512; u = u < 32 ? 32 + 512 : u + nside) {
        int h, sl, nch, ch0, row0, ntok; const float* sp = nullptr; float* op;
        if (u < 32) { const int b = u >> 4; h = (u >> 2) & 3; sl = u & 3; nch = 64; ch0 = (b * 4 + h) * 64; row0 = b * PS; ntok = 64; op = outP + (size_t)(b * 4 + h) * 32768; }
        else { const int s = u - 32, sq = s >> 4; h = (s >> 2) & 3; sl = s & 3; nch = 1; ch0 = 512 + sq * 4 + h; row0 = MP + sq * SS; ntok = SS; sp = s0 + (size_t)(sq * 4 + h) * 32768; op = outS + (size_t)(sq * 4 + h) * 32768; }
        f32x4 acc[4];
#pragma unroll
        for (int vb = 0; vb < 4; ++vb)
#pragma unroll
            for (int jj = 0; jj < 4; ++jj) acc[vb][jj] = sp ? sp[(size_t)(w * 16 + q * 4 + jj) * 256 + sl * 64 + vb * 16 + r] : 0.f;
        GlaStage R0, R1, R2;
        gla_stage_load(R0, QD, KHT, EE, VT, GC, ch0, sl, tid);
        if (1 < nch) gla_stage_load(R1, QD, KHT, EE, VT, GC, ch0 + 1, sl, tid);
        if (2 < nch) gla_stage_load(R2, QD, KHT, EE, VT, GC, ch0 + 2, sl, tid);
        __syncthreads();
        gla_stage_store(R0, stg, tid);
        if (3 < nch) gla_stage_load(R0, QD, KHT, EE, VT, GC, ch0 + 3, sl, tid);
#define GLA_STEP(ci, RN) do { \
            LAS bf16_t* Tb = T_l + ((ci) & 1) * 64 * 136; const LAS bf16_t* sb = stg + ((ci) & 1) * GS_EL; \
            _Pragma("unroll") for (int vb = 0; vb < 4; ++vb) { u32x2 o; o.x = pk2(acc[vb][0], acc[vb][1]); o.y = pk2(acc[vb][2], acc[vb][3]); *(LAS u32x2*)(Tb + (vb * 16 + r) * 136 + w * 16 + q * 4) = o; } \
            __syncthreads(); \
            if ((ci) + 1 < nch) { gla_stage_store(RN, stg + (((ci) + 1) & 1) * GS_EL, tid); if ((ci) + 4 < nch) gla_stage_load(RN, QD, KHT, EE, VT, GC, ch0 + (ci) + 4, sl, tid); } \
            { const int rb = w >> 1, t = rb * 16 + r; bf16x8 qf[4], ef[2]; \
              _Pragma("unroll") for (int ks = 0; ks < 4; ++ks) qf[ks] = *(const LAS bf16x8*)(sb + (rb * 16 + r) * 136 + ks * 32 + q * 8); \
              _Pragma("unroll") for (int ks = 0; ks < 2; ++ks) ef[ks] = *(const LAS bf16x8*)(sb + GS_E + (rb * 16 + r) * 72 + ks * 32 + q * 8); \
              bf16x8 tf[2][4], vf[2][2]; \
              _Pragma("unroll") for (int e2 = 0; e2 < 2; ++e2) { const int cb = (w & 1) * 2 + e2; \
                  _Pragma("unroll") for (int ks = 0; ks < 4; ++ks) tf[e2][ks] = *(const LAS bf16x8*)(Tb + (cb * 16 + r) * 136 + ks * 32 + q * 8); \
                  _Pragma("unroll") for (int ks = 0; ks < 2; ++ks) vf[e2][ks] = *(const LAS bf16x8*)(sb + GS_VT + (cb * 16 + r) * 72 + ks * 32 + q * 8); } \
              __builtin_amdgcn_sched_barrier(0); \
              _Pragma("unroll") for (int e2 = 0; e2 < 2; ++e2) { const int cb = (w & 1) * 2 + e2; f32x4 y = (f32x4){0.f, 0.f, 0.f, 0.f}; \
                  _Pragma("unroll") for (int ks = 0; ks < 4; ++ks) y = mma16(tf[e2][ks], qf[ks], y); \
                  _Pragma("unroll") for (int ks = 0; ks < 2; ++ks) y = mma16(vf[e2][ks], ef[ks], y); \
                  if (t < ntok) { u32x2 o; o.x = pk2(y[0], y[1]); o.y = pk2(y[2], y[3]); *(u32x2*)(OB + (size_t)(row0 + (ci) * 64 + t) * BW + h * 256 + sl * 64 + cb * 16 + q * 4) = o; } } } \
            { const f32x4 gcv = *(const LAS f32x4*)((const LAS float*)(sb + GS_GC) + w * 16 + q * 4); bf16x8 kf[2]; \
              _Pragma("unroll") for (int ks = 0; ks < 2; ++ks) kf[ks] = *(const LAS bf16x8*)(sb + GS_KH + (w * 16 + r) * 72 + ks * 32 + q * 8); \
              bf16x8 vs[4][2]; \
              _Pragma("unroll") for (int vb = 0; vb < 4; ++vb) _Pragma("unroll") for (int ks = 0; ks < 2; ++ks) vs[vb][ks] = *(const LAS bf16x8*)(sb + GS_VT + (vb * 16 + r) * 72 + ks * 32 + q * 8); \
              __builtin_amdgcn_sched_barrier(0); \
              _Pragma("unroll") for (int vb = 0; vb < 4; ++vb) { acc[vb] = acc[vb] * gcv; \
                  _Pragma("unroll") for (int ks = 0; ks < 2; ++ks) acc[vb] = mma16(kf[ks], vs[vb][ks], acc[vb]); } } \
        } while (0)
#pragma unroll 1
        for (int ci = 0; ci < nch; ci += 3) {
            GLA_STEP(ci, R1);
            if (ci + 1 < nch) GLA_STEP(ci + 1, R2);
            if (ci + 2 < nch) GLA_STEP(ci + 2, R0);
        }
#undef GLA_STEP
#pragma unroll
        for (int vb = 0; vb < 4; ++vb)
#pragma unroll
            for (int jj = 0; jj < 4; ++jj) op[(size_t)(w * 16 + q * 4 + jj) * 256 + sl * 64 + vb * 16 + r] = acc[vb][jj];
        __syncthreads();
    }
}
__device__ __forceinline__ void ph_gla_fin(const Ctx& c, const bf16_t* __restrict__ U, const float* __restrict__ ng, const float* __restrict__ nb, const bf16_t* __restrict__ RAW, bf16_t* __restrict__ OB) {
    const int lane = c.lane, hs = lane >> 5, l32 = lane & 31;
    for (int i = c.bid * 8 + c.wave; i < MT * 2; i += c.G * 8) {
        const int row = i >> 1, h = (i & 1) * 2 + hs, cc = h * 256 + l32 * 8; bf16_t* p = OB + (size_t)row * BW + cc;
        float x[8], gr[8]; unpack8(*(const u32x4*)(RAW + (size_t)row * BW + cc), x); unpack8(*(const u32x4*)(U + (size_t)row * NINP + U_GR + cc), gr);
        float s = 0.f;
#pragma unroll
        for (int j = 0; j < 8; ++j) s += x[j];
#pragma unroll
        for (int o = 16; o > 0; o >>= 1) s += __shfl_xor(s, o, 64);
        const float mean = s * (1.0f / 256.0f); float qq = 0.f;
#pragma unroll
        for (int j = 0; j < 8; ++j) { const float d = x[j] - mean; qq += d * d; }
#pragma unroll
        for (int o = 16; o > 0; o >>= 1) qq += __shfl_xor(qq, o, 64);
        const float rstd = rsqrtf(qq * (1.0f / 256.0f) + 1e-5f);
        const f32x4 g0 = *(const f32x4*)(ng + cc), g1 = *(const f32x4*)(ng + cc + 4), b0 = *(const f32x4*)(nb + cc), b1 = *(const f32x4*)(nb + cc + 4); float o8[8];
#pragma unroll
        for (int j = 0; j < 8; ++j) o8[j] = ((x[j] - mean) * rstd * (j < 4 ? g0[j] : g1[j - 4]) + (j < 4 ? b0[j] : b1[j - 4])) * gr[j] * sigmoidf_(gr[j]);
        *(u32x4*)p = (u32x4){pk2(o8[0], o8[1]), pk2(o8[2], o8[3]), pk2(o8[4], o8[5]), pk2(o8[6], o8[7])};
    }
}

template <bool ISBF> __device__ __forceinline__ void swa_step(const float (&q)[32], float (&acc)[32], float& m, float& l, const void* kp, const void* vp, float slope, float dist) {
    float s = 0.f;
#pragma unroll
    for (int j = 0; j < 4; ++j) { float x[8];
        if (ISBF) unpack8(*(const u32x4*)((const bf16_t*)kp + j * 8), x);
        else { const f32x4 a = *(const f32x4*)((const float*)kp + j * 8), b = *(const f32x4*)((const float*)kp + j * 8 + 4); x[0] = a[0]; x[1] = a[1]; x[2] = a[2]; x[3] = a[3]; x[4] = b[0]; x[5] = b[1]; x[6] = b[2]; x[7] = b[3]; }
#pragma unroll
        for (int d = 0; d < 8; ++d) s += q[j * 8 + d] * x[d]; }
    s += __shfl_xor(s, 1, 64);
    s = s * 0.125f - slope * dist;
    const float mn = fmaxf(m, s), cc = __expf(m - mn), p = __expf(s - mn);
    l = l * cc + p;
#pragma unroll
    for (int j = 0; j < 4; ++j) { float x[8];
        if (ISBF) unpack8(*(const u32x4*)((const bf16_t*)vp + j * 8), x);
        else { const f32x4 a = *(const f32x4*)((const float*)vp + j * 8), b = *(const f32x4*)((const float*)vp + j * 8 + 4); x[0] = a[0]; x[1] = a[1]; x[2] = a[2]; x[3] = a[3]; x[4] = b[0]; x[5] = b[1]; x[6] = b[2]; x[7] = b[3]; }
#pragma unroll
        for (int d = 0; d < 8; ++d) acc[j * 8 + d] = acc[j * 8 + d] * cc + p * x[d]; }
    m = mn;
}
__device__ __forceinline__ void ph_swa_naive(const Ctx& c, const bf16_t* __restrict__ U, const float* __restrict__ ck, const float* __restrict__ cv, const float* __restrict__ sinks, bf16_t* __restrict__ OB) {
    for (int gid = c.bid * 512 + c.tid; gid < MS * 32; gid += c.G * 512) {
        const int dh = gid & 1, h = (gid >> 1) & 15, row = MP + (gid >> 5), kvh = h >> 3, co = kvh * 64 + dh * 32;
        float q[32], acc[32];
#pragma unroll
        for (int j = 0; j < 4; ++j) { float x[8]; unpack8(*(const u32x4*)(U + (size_t)row * NINP + U_SQ + h * 64 + dh * 32 + j * 8), x);
#pragma unroll
            for (int d = 0; d < 8; ++d) { q[j * 8 + d] = x[d]; acc[j * 8 + d] = 0.f; } }
        const float slope = exp2f(-0.5f * (float)(h + 1)); float m = sinks[h], l = 1.0f;
        if (row < MP) {
            const int t = row % PS, base = row - t, lo = t - 128 < 0 ? 0 : t - 128;
            for (int s = lo; s <= t; ++s) { const bf16_t* ur = U + (size_t)(base + s) * NINP;
                swa_step<true>(q, acc, m, l, ur + U_SK + co, ur + U_SV + co, slope, (float)(t - s)); }
        } else {
            const int sq = (row - MP) / SS, i = (row - MP) % SS;
            for (int idx = i; idx <= 128 + i; ++idx) {
                if (idx < 128) { const size_t o = ((size_t)sq * 128 + idx) * 128 + co; swa_step<false>(q, acc, m, l, ck + o, cv + o, slope, (float)(128 + i - idx)); }
                else { const bf16_t* ur = U + (size_t)(MP + sq * SS + idx - 128) * NINP; swa_step<true>(q, acc, m, l, ur + U_SK + co, ur + U_SV + co, slope, (float)(128 + i - idx)); }
            }
        }
        const float inv = 1.0f / l; bf16_t* op = OB + (size_t)row * BW + h * 64 + dh * 32;
#pragma unroll
        for (int j = 0; j < 4; ++j) { u32x4 w; w.x = pk2(acc[j * 8] * inv, acc[j * 8 + 1] * inv); w.y = pk2(acc[j * 8 + 2] * inv, acc[j * 8 + 3] * inv);
            w.z = pk2(acc[j * 8 + 4] * inv, acc[j * 8 + 5] * inv); w.w = pk2(acc[j * 8 + 6] * inv, acc[j * 8 + 7] * inv); *(u32x4*)(op + j * 8) = w; }
    }
}

__device__ __forceinline__ void ph_rwkv_prep(const Ctx& c, const bf16_t* __restrict__ U, const float* __restrict__ shift, const float* __restrict__ mu, const float* __restrict__ w0, const float* __restrict__ w2,
                                             const float* __restrict__ a0, const float* __restrict__ a2, const float* __restrict__ g2, const float* __restrict__ k_k, const float* __restrict__ k_a,
                                             const float* __restrict__ r_k, float* __restrict__ RW) {
    LAS float* xm = (LAS float*)c.lds; LAS float* tw = xm + RWC; LAS float* ad = tw + 64; LAS float* sg = ad + 64;
    const int tid = c.tid;
    float* R = RW; float* WD = RW + (size_t)MPAD * BW; float* K2 = WD + (size_t)MPAD * BW; float* V = K2 + (size_t)MPAD * BW; float* KK = V + (size_t)MPAD * BW;
    float* BV = KK + (size_t)MPAD * BW; float* G = BV + (size_t)MPAD * BW; float* BON = G + (size_t)MPAD * BW;
    for (int row = c.bid; row < MT; row += c.G) {
        const bf16_t* ur = U + (size_t)row * NINP + U_RU; const bf16_t* pr = ur - NINP; const float* ps = nullptr; bool first;
        if (row < MP) first = (row % PS) == 0; else { first = ((row - MP) % SS) == 0; ps = shift + (size_t)((row - MP) / SS) * RWC; }
        for (int cc = tid; cc < RWC; cc += 512) { const float x = bf2f(ur[cc]); const float s = first ? (ps ? ps[cc] : 0.f) : bf2f(pr[cc]); xm[cc] = x + (s - x) * mu[cc]; }
        __syncthreads();
        if (tid < 64) { tw[tid] = tanhf(xm[3072 + tid]); ad[tid] = xm[3136 + tid]; }
        if (tid >= 128 && tid < 256) sg[tid - 128] = sigmoidf_(xm[3200 + tid - 128]);
        __syncthreads();
        for (int qd = 0; qd < 2; ++qd) {
            const int cc = qd * 512 + tid; float accw = w0[cc], acca = a0[cc], accg = 0.f;
#pragma unroll 4
            for (int j = 0; j < 64; ++j) { accw += tw[j] * w2[j * BW + cc]; acca += ad[j] * a2[j * BW + cc]; }
#pragma unroll 4
            for (int j = 0; j < 128; ++j) accg += sg[j] * g2[j * BW + cc];
            const float lw = -softplusf_(-accw) - 0.5f, decay = __expf(-__expf(lw)), a = sigmoidf_(acca);
            const float r = xm[cc], k = xm[1024 + cc], v = xm[2048 + cc];
            const float kkr = k * k_k[cc]; const float ss = wave_sum(kkr * kkr); const float kk = kkr / fmaxf(sqrtf(ss), 1e-12f);
            const float k2 = k * (1.0f + (a - 1.0f) * k_a[cc]); const float rk = wave_sum(r * k2 * r_k[cc]);
            const size_t o = (size_t)row * BW + cc;
            R[o] = r; WD[o] = decay; K2[o] = k2; V[o] = v; KK[o] = kk; BV[o] = kk * a; G[o] = accg; BON[o] = rk * v;
        }
        __syncthreads();
    }
}
__device__ __forceinline__ int kperm_pos(int k) { return (k & ~31) + 8 * ((k >> 2) & 3) + 4 * ((k >> 4) & 1) + (k & 3); }
__device__ __forceinline__ void ph_swa_prompt(const Ctx& c, const bf16_t* __restrict__ U, const float* __restrict__ sinks, bf16_t* __restrict__ OB) {
    LAS bf16_t* K_l = (LAS bf16_t*)c.lds;
    LAS bf16_t* VT_l = K_l + 192 * 72;
    const int tid = c.tid, lane = c.lane, r = lane & 15, q = lane >> 4, w = c.wave;
    for (int u = c.bid; u < PB * 64 * 2; u += c.G) {
        const int b = u >> 7, qb = (u >> 1) & 63, kvh = u & 1, h = kvh * 8 + w;
        const int tok0 = qb * 64 - 128;
        const size_t seq0 = (size_t)b * PS;
        for (int idx = tid; idx < 192 * 8; idx += 512) { const int kl = idx >> 3, c8 = idx & 7, tk = tok0 + kl; u32x4 kv = (u32x4){0u, 0u, 0u, 0u}, vv = kv;
            if (tk >= 0) { const bf16_t* ur = U + (seq0 + tk) * NINP; kv = *(const u32x4*)(ur + U_SK + kvh * 64 + c8 * 8); vv = *(const u32x4*)(ur + U_SV + kvh * 64 + c8 * 8); }
            *(LAS u32x4*)(K_l + kl * 72 + c8 * 8) = kv;
            const int kp = kperm_pos(kl); LAS bf16_t* vp = VT_l + (c8 * 8) * 200 + kp;
            vp[0] = (bf16_t)(vv.x & 0xffffu); vp[200] = (bf16_t)(vv.x >> 16); vp[400] = (bf16_t)(vv.y & 0xffffu); vp[600] = (bf16_t)(vv.y >> 16);
            vp[800] = (bf16_t)(vv.z & 0xffffu); vp[1000] = (bf16_t)(vv.z >> 16); vp[1200] = (bf16_t)(vv.w & 0xffffu); vp[1400] = (bf16_t)(vv.w >> 16); }
        __syncthreads();
        const float slope = exp2f(-0.5f * (float)(h + 1)), sink = sinks[h];
#pragma unroll 1
        for (int i = 0; i < 4; ++i) {
            const size_t qrow = seq0 + qb * 64 + i * 16 + r;
            const bf16x8 qf0 = *(const bf16x8*)(U + qrow * NINP + U_SQ + h * 64 + q * 8), qf1 = *(const bf16x8*)(U + qrow * NINP + U_SQ + h * 64 + 32 + q * 8);
            const int kt0 = i & ~1;
            f32x4 s[10]; float mx = sink; bf16x8 kfr[5][2];
#pragma unroll
            for (int kt = 0; kt < 10; ++kt) { f32x4 d;
                if (kt % 5 == 0) {
#pragma unroll
                    for (int k5 = 0; k5 < 5; ++k5) { const LAS bf16_t* kp = K_l + ((kt0 + kt + k5) * 16 + r) * 72 + q * 8; kfr[k5][0] = *(const LAS bf16x8*)kp; kfr[k5][1] = *(const LAS bf16x8*)(kp + 32); }
                    __builtin_amdgcn_sched_barrier(0); }
                d = mma16(kfr[kt % 5][0], qf0, (f32x4){0.f, 0.f, 0.f, 0.f}); d = mma16(kfr[kt % 5][1], qf1, d);
#pragma unroll
                for (int jj = 0; jj < 4; ++jj) { const int kl = (kt0 + kt) * 16 + q * 4 + jj, dist = i * 16 + r + 128 - kl;
                    const float v = (dist >= 0 && dist <= 128 && tok0 + kl >= 0) ? d[jj] * 0.125f - slope * (float)dist : -1e30f; d[jj] = v; mx = fmaxf(mx, v); }
                s[kt] = d; }
            mx = fmaxf(mx, __shfl_xor(mx, 16, 64)); mx = fmaxf(mx, __shfl_xor(mx, 32, 64));
            float sum = 0.f; bf16x8 pf[5];
#pragma unroll
            for (int kp = 0; kp < 5; ++kp) { f32x4 a = s[2 * kp], bq = s[2 * kp + 1];
#pragma unroll
                for (int jj = 0; jj < 4; ++jj) { a[jj] = __expf(a[jj] - mx); bq[jj] = __expf(bq[jj] - mx); sum += a[jj] + bq[jj]; }
                pf[kp] = pack_acc(a, bq); }
            sum += __shfl_xor(sum, 16, 64); sum += __shfl_xor(sum, 32, 64);
            const float inv = 1.0f / (sum + __expf(sink - mx));
            bf16_t* op = OB + qrow * BW + h * 64 + q * 4;
#pragma unroll
            for (int dt = 0; dt < 4; ++dt) { f32x4 o = (f32x4){0.f, 0.f, 0.f, 0.f}; bf16x8 vfr[5];
#pragma unroll
                for (int kp = 0; kp < 5; ++kp) vfr[kp] = *(const LAS bf16x8*)(VT_l + (dt * 16 + r) * 200 + (kt0 + 2 * kp) * 16 + q * 8);
                __builtin_amdgcn_sched_barrier(0);
#pragma unroll
                for (int kp = 0; kp < 5; ++kp) o = mma16(vfr[kp], pf[kp], o);
                u32x2 ov; ov.x = pk2(o[0] * inv, o[1] * inv); ov.y = pk2(o[2] * inv, o[3] * inv); *(u32x2*)(op + dt * 16) = ov; }
        }
        __syncthreads();
    }
}

__device__ __forceinline__ void ph_swa_sample(const Ctx& c, const bf16_t* __restrict__ U, const float* __restrict__ ck, const float* __restrict__ cv, const float* __restrict__ sinks, bf16_t* __restrict__ OB) {
    LAS bf16_t* K_l = (LAS bf16_t*)c.lds;
    LAS bf16_t* VT_l = K_l + 160 * 72;
    const int tid = c.tid, lane = c.lane, r = lane & 15, q = lane >> 4, w = c.wave;
    for (int u = c.bid; u < SB * 2; u += c.G) {
        const int sq = u >> 1, kvh = u & 1;
        for (int idx = tid; idx < 160 * 8; idx += 512) { const int kl = idx >> 3, c8 = idx & 7; float kx[8], vx[8];
#pragma unroll
            for (int e = 0; e < 8; ++e) { kx[e] = 0.f; vx[e] = 0.f; }
            if (kl < 128) { const size_t o = ((size_t)sq * 128 + kl) * 128 + kvh * 64 + c8 * 8; const f32x4 a = *(const f32x4*)(ck + o), b2 = *(const f32x4*)(ck + o + 4), c2 = *(const f32x4*)(cv + o), d2 = *(const f32x4*)(cv + o + 4);
                kx[0] = a[0]; kx[1] = a[1]; kx[2] = a[2]; kx[3] = a[3]; kx[4] = b2[0]; kx[5] = b2[1]; kx[6] = b2[2]; kx[7] = b2[3];
                vx[0] = c2[0]; vx[1] = c2[1]; vx[2] = c2[2]; vx[3] = c2[3]; vx[4] = d2[0]; vx[5] = d2[1]; vx[6] = d2[2]; vx[7] = d2[3]; }
            else if (kl < 132) { const bf16_t* ur = U + (size_t)(MP + sq * SS + kl - 128) * NINP; unpack8(*(const u32x4*)(ur + U_SK + kvh * 64 + c8 * 8), kx); unpack8(*(const u32x4*)(ur + U_SV + kvh * 64 + c8 * 8), vx); }
            *(LAS u32x4*)(K_l + kl * 72 + c8 * 8) = (u32x4){pk2(kx[0], kx[1]), pk2(kx[2], kx[3]), pk2(kx[4], kx[5]), pk2(kx[6], kx[7])};
            LAS bf16_t* vp = VT_l + (c8 * 8) * 168 + kperm_pos(kl);
#pragma unroll
            for (int e = 0; e < 8; ++e) vp[e * 168] = f2bf(vx[e]); }
        __syncthreads();
        if (w < 2) {
            const int h = kvh * 8 + w * 4 + (r >> 2), tk = r & 3; const size_t qrow = (size_t)(MP + sq * SS + tk);
            const float slope = exp2f(-0.5f * (float)(h + 1)), sink = sinks[h];
            const bf16x8 qf0 = *(const bf16x8*)(U + qrow * NINP + U_SQ + h * 64 + q * 8), qf1 = *(const bf16x8*)(U + qrow * NINP + U_SQ + h * 64 + 32 + q * 8);
            f32x4 s[10]; float mx = sink;
#pragma unroll
            for (int kt = 0; kt < 10; ++kt) { const LAS bf16_t* kp = K_l + (kt * 16 + r) * 72 + q * 8;
                f32x4 d = mma16(*(const LAS bf16x8*)kp, qf0, (f32x4){0.f, 0.f, 0.f, 0.f}); d = mma16(*(const LAS bf16x8*)(kp + 32), qf1, d);
#pragma unroll
                for (int jj = 0; jj < 4; ++jj) { const int kl = kt * 16 + q * 4 + jj, dist = 128 + tk - kl;
                    const float v = (dist >= 0 && dist <= 128) ? d[jj] * 0.125f - slope * (float)dist : -1e30f; d[jj] = v; mx = fmaxf(mx, v); }
                s[kt] = d; }
            mx = fmaxf(mx, __shfl_xor(mx, 16, 64)); mx = fmaxf(mx, __shfl_xor(mx, 32, 64));
            float sum = 0.f; bf16x8 pf[5];
#pragma unroll
            for (int kp = 0; kp < 5; ++kp) { f32x4 a = s[2 * kp], bq = s[2 * kp + 1];
#pragma unroll
                for (int jj = 0; jj < 4; ++jj) { a[jj] = __expf(a[jj] - mx); bq[jj] = __expf(bq[jj] - mx); sum += a[jj] + bq[jj]; }
                pf[kp] = pack_acc(a, bq); }
            sum += __shfl_xor(sum, 16, 64); sum += __shfl_xor(sum, 32, 64);
            const float inv = 1.0f / (sum + __expf(sink - mx));
            bf16_t* op = OB + qrow * BW + h * 64 + q * 4;
#pragma unroll
            for (int dt = 0; dt < 4; ++dt) { f32x4 o = (f32x4){0.f, 0.f, 0.f, 0.f};
#pragma unroll
                for (int kp = 0; kp < 5; ++kp) o = mma16(*(const LAS bf16x8*)(VT_l + (dt * 16 + r) * 168 + kp * 32 + q * 8), pf[kp], o);
                u32x2 ov; ov.x = pk2(o[0] * inv, o[1] * inv); ov.y = pk2(o[2] * inv, o[3] * inv); *(u32x2*)(op + dt * 16) = ov; }
        }
        __syncthreads();
    }
}

__device__ __forceinline__ void ph_memattn_prompt(const Ctx& c, const bf16_t* __restrict__ U, const bf16_t* __restrict__ MKB, const bf16_t* __restrict__ MVT, bf16_t* __restrict__ OB) {
    LAS bf16_t* buf = (LAS bf16_t*)c.lds;
    const int tid = c.tid, lane = c.lane, r = lane & 15, q = lane >> 4, w = c.wave;
    for (int u = c.bid; u < PB * 4 * 32; u += c.G) {
        const int b = u >> 7, h = (u >> 5) & 3, qb = u & 31;
        const size_t qrow = (size_t)b * PS + qb * 128 + w * 16 + r;
        const bf16_t* kg = MKB + (size_t)(b * 256) * 1024 + h * 256;
        const bf16_t* vg = MVT + (size_t)(b * 4 + h) * 65536;
        const bf16_t* qg = U + qrow * NINP + U_MQ + h * 256 + q * 8;
        bf16x8 qn0 = *(const bf16x8*)qg, qn1 = *(const bf16x8*)(qg + 32);
        u32x4 st[4];
#pragma unroll
        for (int i = 0; i < 4; ++i) { const int p = tid + 512 * i; st[i] = *(const u32x4*)(kg + (size_t)(p >> 3) * 1024 + (p & 7) * 8); }
        f32x4 s[16];
#pragma unroll
        for (int mt = 0; mt < 16; ++mt) s[mt] = (f32x4){0.f, 0.f, 0.f, 0.f};
        __syncthreads();
#pragma unroll 1
        for (int ck = 0; ck < 4; ++ck) {
            LAS bf16_t* kb = buf + (ck & 1) * 18432;
#pragma unroll
            for (int i = 0; i < 4; ++i) { const int p = tid + 512 * i; *(LAS u32x4*)(kb + (p >> 3) * 72 + (p & 7) * 8) = st[i]; }
            __syncthreads();
            const bf16x8 qc0 = qn0, qc1 = qn1;
            if (ck < 3) { qn0 = *(const bf16x8*)(qg + (ck + 1) * 64); qn1 = *(const bf16x8*)(qg + (ck + 1) * 64 + 32);
#pragma unroll
                for (int i = 0; i < 4; ++i) { const int p = tid + 512 * i; st[i] = *(const u32x4*)(kg + (size_t)(p >> 3) * 1024 + (ck + 1) * 64 + (p & 7) * 8); } }
#pragma unroll
            for (int m2 = 0; m2 < 16; m2 += 2) { bf16x8 kf[2][2];
#pragma unroll
                for (int j = 0; j < 2; ++j) { kf[j][0] = *(const LAS bf16x8*)(kb + ((m2 + j) * 16 + r) * 72 + q * 8); kf[j][1] = *(const LAS bf16x8*)(kb + ((m2 + j) * 16 + r) * 72 + 32 + q * 8); }
                __builtin_amdgcn_sched_barrier(0);
#pragma unroll
                for (int j = 0; j < 2; ++j) { s[m2 + j] = mma16(kf[j][0], qc0, s[m2 + j]); s[m2 + j] = mma16(kf[j][1], qc1, s[m2 + j]); } }
        }
#pragma unroll
        for (int i = 0; i < 4; ++i) { const int p = tid + 512 * i; st[i] = *(const u32x4*)(vg + (size_t)(p >> 5) * 256 + (p & 31) * 8); }
        float mx = -3.0e38f;
#pragma unroll
        for (int mt = 0; mt < 16; ++mt)
#pragma unroll
            for (int jj = 0; jj < 4; ++jj) { s[mt][jj] *= 0.0625f; mx = fmaxf(mx, s[mt][jj]); }
        mx = fmaxf(mx, __shfl_xor(mx, 16, 64)); mx = fmaxf(mx, __shfl_xor(mx, 32, 64));
        float sum = 0.f; bf16x8 pf[8];
#pragma unroll
        for (int kp = 0; kp < 8; ++kp) { f32x4 a = s[2 * kp], b2 = s[2 * kp + 1];
#pragma unroll
            for (int jj = 0; jj < 4; ++jj) { a[jj] = __expf(a[jj] - mx); b2[jj] = __expf(b2[jj] - mx); sum += a[jj] + b2[jj]; }
            pf[kp] = pack_acc(a, b2); }
        sum += __shfl_xor(sum, 16, 64); sum += __shfl_xor(sum, 32, 64);
        const float inv = 1.0f / sum;
        bf16_t* op = OB + qrow * BW + h * 256 + q * 4;
#pragma unroll 1
        for (int cv = 0; cv < 4; ++cv) {
            LAS bf16_t* vb = buf + (cv & 1) * 18432;
#pragma unroll
            for (int i = 0; i < 4; ++i) { const int p = tid + 512 * i, m0 = (p & 31) * 8; LAS bf16_t* d0 = vb + (p >> 5) * 264;
                *(LAS u32x2*)(d0 + kperm_pos(m0)) = (u32x2){st[i].x, st[i].y}; *(LAS u32x2*)(d0 + kperm_pos(m0 + 4)) = (u32x2){st[i].z, st[i].w}; }
            __syncthreads();
            if (cv < 3) {
#pragma unroll
                for (int i = 0; i < 4; ++i) { const int p = tid + 512 * i; st[i] = *(const u32x4*)(vg + (size_t)((cv + 1) * 64 + (p >> 5)) * 256 + (p & 31) * 8); } }
#pragma unroll
            for (int dt = 0; dt < 4; ++dt) { bf16x8 vf[8];
#pragma unroll
                for (int kp = 0; kp < 8; ++kp) vf[kp] = *(const LAS bf16x8*)(vb + (dt * 16 + r) * 264 + kp * 32 + q * 8);
                __builtin_amdgcn_sched_barrier(0);
                f32x4 o = (f32x4){0.f, 0.f, 0.f, 0.f};
#pragma unroll
                for (int kp = 0; kp < 8; ++kp) o = mma16(vf[kp], pf[kp], o);
                u32x2 ov; ov.x = pk2(o[0] * inv, o[1] * inv); ov.y = pk2(o[2] * inv, o[3] * inv); *(u32x2*)(op + (cv * 4 + dt) * 16) = ov; }
        }
        __syncthreads();
    }
}

__device__ __forceinline__ void ph_lrw(const Ctx& c, const float* __restrict__ w2, const float* __restrict__ a2, const float* __restrict__ g2, bf16_t* __restrict__ LRW) {
    for (int idx = c.bid * 512 + c.tid; idx < NL * 256 * 1024; idx += c.G * 512) {
        const int ch = idx & 1023, j = (idx >> 10) & 255, l = idx >> 18;
        const float v = j < 64 ? w2[((size_t)l * 64 + j) * BW + ch] : (j < 128 ? a2[((size_t)l * 64 + j - 64) * BW + ch] : g2[((size_t)l * 128 + j - 128) * BW + ch]);
        LRW[((size_t)l * 1024 + ch) * 256 + j] = f2bf(v);
    }
}
constexpr int RWP_UNITS = (MP / 64) * 4 + SB * 4;
__device__ __forceinline__ void rwp_unit_info(int u, int& row0, int& ntok, int& hg, int& sq, bool& seq_first) {
    if (u < (MP / 64) * 4) { const int blk = u >> 2; hg = u & 3; row0 = blk * 64; ntok = 64; sq = -1; seq_first = (row0 % PS) == 0; }
    else { const int s = u - (MP / 64) * 4; sq = s >> 2; hg = s & 3; row0 = MP + sq * SS; ntok = SS; seq_first = true; }
}
__device__ __forceinline__ void ph_rwkv_pre(const Ctx& c, const bf16_t* __restrict__ U, const float* __restrict__ shift, const float* __restrict__ mu, const float* __restrict__ w0, const float* __restrict__ w2,
                                            const float* __restrict__ a0, const float* __restrict__ a2, const float* __restrict__ g2, const float* __restrict__ k_k, const float* __restrict__ k_a,
                                            const float* __restrict__ r_k, float* __restrict__ RW, bf16_t* __restrict__ RB, const bf16_t* __restrict__ LRW) {
    LAS bf16_t* P_l = (LAS bf16_t*)c.lds; LAS bf16_t* Kn_l = P_l + 4608; LAS bf16_t* Bn_l = Kn_l + 4608; LAS bf16_t* Q_l = Bn_l + 4608;
    LAS bf16_t* PT_l = Q_l + 4608; LAS bf16_t* BhT_l = PT_l + 4608; LAS bf16_t* KhT_l = BhT_l + 4608; LAS bf16_t* VT_l = KhT_l + 4608;
    LAS float* A_l = (LAS float*)(c.lds + 73728);
    LAS bf16_t* BmT_l = (LAS bf16_t*)(c.lds + 78848); LAS bf16_t* F_l = (LAS bf16_t*)(c.lds + 81920); LAS bf16_t* Tinv_l = (LAS bf16_t*)(c.lds + 84992);
    LAS bf16_t* PpT_l = (LAS bf16_t*)(c.lds + 88064);
    LAS bf16_t* BmpT_l = (LAS bf16_t*)(c.lds + 97280);
    LAS float* GC_l = (LAS float*)(c.lds + 100352);
    LAS float* lg_l = (LAS float*)(c.lds + 125952);
    LAS bf16_t* act_l = (LAS bf16_t*)c.lds;
    LAS bf16_t* wT_l = act_l + 64 * 264;
    LAS bf16_t* aT_l = wT_l + 64 * 72;
    LAS bf16_t* gT_l = aT_l + 64 * 72;
    LAS float* pre_l = (LAS float*)(c.lds + 73728);
    const int tid = c.tid, lane = c.lane, r = lane & 15, q = lane >> 4, w = c.wave;
    bf16_t* Gg = (bf16_t*)(RW + 6 * (size_t)MPAD * BW); bf16_t* BON = (bf16_t*)(RW + 7 * (size_t)MPAD * BW);
    for (int u = c.bid; u < RWP_UNITS; u += c.G) {
        int row0, ntok, hg, sq; bool seq_first; rwp_unit_info(u, row0, ntok, hg, sq, seq_first);
        const float* sh = sq >= 0 ? shift + (size_t)sq * RWC : nullptr;
        const int nstage = ntok == 64 ? 64 : 16;
        for (int idx = tid; idx < nstage * 32; idx += 512) {
            const int t = idx >> 5, c8 = idx & 31, cc = 3072 + c8 * 8; float val[8];
#pragma unroll
            for (int e2 = 0; e2 < 8; ++e2) val[e2] = 0.f;
            if (t < ntok) { const bf16_t* ur = U + (size_t)(row0 + t) * NINP + U_RU; float x[8], p[8];
                unpack8(*(const u32x4*)(ur + cc), x);
                if (!(t == 0 && seq_first)) unpack8(*(const u32x4*)(ur + cc - NINP), p);
                else if (sh) { const f32x4 s0v = *(const f32x4*)(sh + cc), s1v = *(const f32x4*)(sh + cc + 4); p[0] = s0v[0]; p[1] = s0v[1]; p[2] = s0v[2]; p[3] = s0v[3]; p[4] = s1v[0]; p[5] = s1v[1]; p[6] = s1v[2]; p[7] = s1v[3]; }
                else {
#pragma unroll
                    for (int e2 = 0; e2 < 8; ++e2) p[e2] = 0.f; }
                const f32x4 m0 = *(const f32x4*)(mu + cc), m1 = *(const f32x4*)(mu + cc + 4);
#pragma unroll
                for (int e2 = 0; e2 < 8; ++e2) { const float xm = x[e2] + (p[e2] - x[e2]) * (e2 < 4 ? m0[e2] : m1[e2 - 4]); val[e2] = c8 < 8 ? tanh_fast(xm) : (c8 < 16 ? xm : sigmoidf_(xm)); } }
            *(LAS u32x4*)(act_l + t * 264 + c8 * 8) = (u32x4){pk2(val[0], val[1]), pk2(val[2], val[3]), pk2(val[4], val[5]), pk2(val[6], val[7])};
        }
        __syncthreads();
        bf16x8 af[8];
        { const int tb = w & 3;
#pragma unroll
          for (int ks = 0; ks < 8; ++ks) af[ks] = *(const LAS bf16x8*)(act_l + (tb * 16 + r) * 264 + ks * 32 + q * 8); }
        __syncthreads();
#pragma unroll 1
        for (int hh = 0; hh < 4; ++hh) { const int h = hg * 4 + hh;
        { const int tb = w & 3, chf = w >> 2;
          if (tb * 16 < nstage) {
#pragma unroll
            for (int e2 = 0; e2 < 2; ++e2) { const int cb = chf * 2 + e2; f32x4 dw = (f32x4){0.f, 0.f, 0.f, 0.f}, da = dw, dg = dw;
                const bf16_t* wr = LRW + ((size_t)h * 64 + cb * 16 + r) * 256 + q * 8; bf16x8 wf[8];
#pragma unroll
                for (int ks = 0; ks < 8; ++ks) wf[ks] = *(const bf16x8*)(wr + ks * 32);
                __builtin_amdgcn_sched_barrier(0);
#pragma unroll
                for (int ks = 0; ks < 2; ++ks) { dw = mma16(wf[ks], af[ks], dw); da = mma16(wf[2 + ks], af[2 + ks], da); }
#pragma unroll
                for (int ks = 0; ks < 4; ++ks) dg = mma16(wf[4 + ks], af[4 + ks], dg);
                const int o = (tb * 16 + r) * 68 + cb * 16 + q * 4;
                *(LAS f32x4*)(pre_l + o) = dw; *(LAS f32x4*)(pre_l + 64 * 68 + o) = da; *(LAS f32x4*)(pre_l + 2 * 64 * 68 + o) = dg; } } }
        __syncthreads();
        const int t = tid >> 3, cg = tid & 7, c0 = h * 64 + cg * 8, sc = t >> 4;
        float rr[8], k2[8], kap[8], bet[8], nlw[8];
        { float vx[8], gg[8], kkr[8]; float ss = 0.f, rk = 0.f;
          if (t < ntok) {
            const size_t row = (size_t)(row0 + t); const bf16_t* ur = U + row * NINP + U_RU; const bool fst = (t == 0 && seq_first);
            float kx[8];
#pragma unroll
            for (int part = 0; part < 3; ++part) { const int cc = part * 1024 + c0; float x[8], p[8];
                unpack8(*(const u32x4*)(ur + cc), x);
                if (!fst) unpack8(*(const u32x4*)(ur + cc - NINP), p);
                else {
#pragma unroll
                    for (int j = 0; j < 8; ++j) p[j] = sh ? sh[cc + j] : 0.f; }
                const f32x4 mA = *(const f32x4*)(mu + cc), mB = *(const f32x4*)(mu + cc + 4);
#pragma unroll
                for (int j = 0; j < 8; ++j) { const float xm = x[j] + (p[j] - x[j]) * (j < 4 ? mA[j] : mB[j - 4]); if (part == 0) rr[j] = xm; else if (part == 1) kx[j] = xm; else vx[j] = xm; } }
            float pw[8], pa[8], pkk[8], pka[8], prk[8];
#pragma unroll
            for (int hf = 0; hf < 2; ++hf) { const f32x4 v0 = *(const f32x4*)(w0 + c0 + hf * 4), v1 = *(const f32x4*)(a0 + c0 + hf * 4), v2 = *(const f32x4*)(k_k + c0 + hf * 4), v3 = *(const f32x4*)(k_a + c0 + hf * 4), v4 = *(const f32x4*)(r_k + c0 + hf * 4);
#pragma unroll
                for (int j = 0; j < 4; ++j) { pw[hf * 4 + j] = v0[j]; pa[hf * 4 + j] = v1[j]; pkk[hf * 4 + j] = v2[j]; pka[hf * 4 + j] = v3[j]; prk[hf * 4 + j] = v4[j]; } }
            float lwp[8], app[8];
#pragma unroll
            for (int hf = 0; hf < 2; ++hf) { const f32x4 v0 = *(const LAS f32x4*)(pre_l + t * 68 + cg * 8 + hf * 4), v1 = *(const LAS f32x4*)(pre_l + 64 * 68 + t * 68 + cg * 8 + hf * 4), v2 = *(const LAS f32x4*)(pre_l + 2 * 64 * 68 + t * 68 + cg * 8 + hf * 4);
#pragma unroll
                for (int j = 0; j < 4; ++j) { lwp[hf * 4 + j] = v0[j]; app[hf * 4 + j] = v1[j]; gg[hf * 4 + j] = v2[j]; } }
#pragma unroll
            for (int j = 0; j < 8; ++j) {
                const float lw = -softplus_fast(-(pw[j] + lwp[j])) - 0.5f; nlw[j] = -__expf(lw); const float av = sigmoidf_(pa[j] + app[j]);
                kkr[j] = kx[j] * pkk[j]; ss += kkr[j] * kkr[j]; k2[j] = kx[j] * (1.0f + (av - 1.0f) * pka[j]); rk += rr[j] * k2[j] * prk[j]; bet[j] = av; }
          } else {
#pragma unroll
            for (int j = 0; j < 8; ++j) { rr[j] = 0.f; k2[j] = 0.f; kkr[j] = 0.f; bet[j] = 0.f; nlw[j] = 0.f; vx[j] = 0.f; gg[j] = 0.f; }
          }
          ss += __shfl_xor(ss, 1, 64); ss += __shfl_xor(ss, 2, 64); ss += __shfl_xor(ss, 4, 64);
          rk += __shfl_xor(rk, 1, 64); rk += __shfl_xor(rk, 2, 64); rk += __shfl_xor(rk, 4, 64);
          const float inv = 1.0f / fmaxf(sqrtf(ss), 1e-12f);
#pragma unroll
          for (int j = 0; j < 8; ++j) { kap[j] = kkr[j] * inv; bet[j] = kap[j] * bet[j]; }
          if (t < ntok) { const size_t o = (size_t)(row0 + t) * BW + c0;
              *(u32x4*)(Gg + o) = (u32x4){pk2(gg[0], gg[1]), pk2(gg[2], gg[3]), pk2(gg[4], gg[5]), pk2(gg[6], gg[7])};
              *(u32x4*)(BON + o) = (u32x4){pk2(rk * vx[0], rk * vx[1]), pk2(rk * vx[2], rk * vx[3]), pk2(rk * vx[4], rk * vx[5]), pk2(rk * vx[6], rk * vx[7])}; }
          *(LAS f32x4*)(lg_l + t * 68 + cg * 8) = (f32x4){nlw[0], nlw[1], nlw[2], nlw[3]}; *(LAS f32x4*)(lg_l + t * 68 + cg * 8 + 4) = (f32x4){nlw[4], nlw[5], nlw[6], nlw[7]};
#pragma unroll
          for (int j = 0; j < 8; ++j) VT_l[(cg * 8 + j) * 72 + t] = f2bf(vx[j]);
        }
        __syncthreads();
        if (tid < 256) { const int cc = tid & 63, s4 = tid >> 6; float run = 0.f;
#pragma unroll
            for (int i = 0; i < 16; ++i) { const int o = (s4 * 16 + i) * 68 + cc; run += lg_l[o]; lg_l[o] = run; } }
        __syncthreads();
        { unsigned pp[4], pq[4], pk[4], pb[4];
#pragma unroll
          for (int j = 0; j < 8; j += 2) { float vP[2], vQ[2], vK[2], vB[2];
#pragma unroll
              for (int e = 0; e < 2; ++e) { const int jj = j + e, cc = cg * 8 + jj; const float ci = lg_l[t * 68 + cc], cC = lg_l[(sc * 16 + 15) * 68 + cc];
                  const float ei = __expf(-ci), eh = __expf(cC - ci);
                  vP[e] = kap[jj] * __expf(ci - nlw[jj]); vQ[e] = rr[jj] * __expf(ci); vK[e] = k2[jj] * ei; vB[e] = bet[jj] * ei;
                  PT_l[cc * 72 + t] = f2bf(vP[e]); BhT_l[cc * 72 + t] = f2bf(bet[jj] * eh); KhT_l[cc * 72 + t] = f2bf(k2[jj] * eh); }
              pp[j >> 1] = pk2(vP[0], vP[1]); pq[j >> 1] = pk2(vQ[0], vQ[1]); pk[j >> 1] = pk2(vK[0], vK[1]); pb[j >> 1] = pk2(vB[0], vB[1]); }
          const int o = t * 72 + cg * 8;
          *(LAS u32x4*)(P_l + o) = (u32x4){pp[0], pp[1], pp[2], pp[3]}; *(LAS u32x4*)(Q_l + o) = (u32x4){pq[0], pq[1], pq[2], pq[3]};
          *(LAS u32x4*)(Kn_l + o) = (u32x4){pk[0], pk[1], pk[2], pk[3]}; *(LAS u32x4*)(Bn_l + o) = (u32x4){pb[0], pb[1], pb[2], pb[3]};
          if ((t & 15) == 15) {
#pragma unroll
              for (int j = 0; j < 8; ++j) GC_l[sc * 64 + cg * 8 + j] = __expf(lg_l[t * 68 + cg * 8 + j]); } }
        __syncthreads();
        const int nsub = ntok == 64 ? 4 : 1;
        const bf16x8 zfrag = (bf16x8){0, 0, 0, 0, 0, 0, 0, 0};
        for (int id = w; id < nsub * 3; id += 8) { const int s4 = id / 3, prod = id - s4 * 3; f32x4 d = (f32x4){0.f, 0.f, 0.f, 0.f};
            const LAS bf16_t* X = (prod == 1 ? P_l : Bn_l) + (s4 * 16 + r) * 72 + q * 8; const LAS bf16_t* Y = (prod == 0 ? P_l : (prod == 1 ? Kn_l : Q_l)) + (s4 * 16 + r) * 72 + q * 8;
            { const bf16x8 x0 = *(const LAS bf16x8*)X, x1 = *(const LAS bf16x8*)(X + 32), y0 = *(const LAS bf16x8*)Y, y1 = *(const LAS bf16x8*)(Y + 32);
              __builtin_amdgcn_sched_barrier(0); d = mma16(x0, y0, d); d = mma16(x1, y1, d); }
            if (prod == 0) { f32x4 o4;
#pragma unroll
                for (int jj = 0; jj < 4; ++jj) o4[jj] = (q * 4 + jj < r) ? d[jj] : 0.f;
                *(LAS f32x4*)(A_l + s4 * 320 + r * 20 + q * 4) = o4; }
            else { float o4[4];
#pragma unroll
                for (int jj = 0; jj < 4; ++jj) o4[jj] = (prod == 1 ? (r < q * 4 + jj) : (q * 4 + jj <= r)) ? d[jj] : 0.f;
                u32x2 o; o.x = pk2(o4[0], o4[1]); o.y = pk2(o4[2], o4[3]); *(LAS u32x2*)((prod == 1 ? BmT_l : F_l) + s4 * 384 + r * 24 + q * 4) = o; } }
        __syncthreads();
        if (w == 0 && (lane >> 4) < nsub) { const int s4 = lane >> 4, jc = lane & 15; float x[16];
#pragma unroll
            for (int tt = 0; tt < 16; ++tt) { float s = (tt == jc) ? 1.f : 0.f;
#pragma unroll
                for (int i = 0; i < tt; ++i) s -= A_l[s4 * 320 + tt * 20 + i] * x[i];
                x[tt] = s; }
#pragma unroll
            for (int tt = 0; tt < 16; ++tt) Tinv_l[s4 * 384 + tt * 24 + jc] = f2bf(x[tt]); }
        __syncthreads();
        for (int id = w; id < nsub * 5; id += 8) { const int s4 = id / 5, rem = id - s4 * 5;
            const bf16x8 xf = q < 2 ? *(const LAS bf16x8*)(Tinv_l + s4 * 384 + r * 24 + q * 8) : zfrag;
            const bf16x8 yf = q < 2 ? (rem < 4 ? *(const LAS bf16x8*)(PT_l + (rem * 16 + r) * 72 + s4 * 16 + q * 8) : *(const LAS bf16x8*)(BmT_l + s4 * 384 + r * 24 + q * 8)) : zfrag;
            const f32x4 d = mma16(xf, yf, (f32x4){0.f, 0.f, 0.f, 0.f});
            u32x2 o; o.x = pk2(d[0], d[1]); o.y = pk2(d[2], d[3]);
            if (rem < 4) *(LAS u32x2*)(PpT_l + (rem * 16 + r) * 72 + s4 * 16 + q * 4) = o; else *(LAS u32x2*)(BmpT_l + s4 * 384 + r * 24 + q * 4) = o; }
        __syncthreads();
        { const int chunk0 = sq >= 0 ? PB * 16 * 256 + sq * 16 + h : ((row0 / PS) * 16 + h) * 256 + ((row0 % PS) >> 4);
          for (int id = w; id < nsub * 25; id += 8) { const int s4 = id / 25, rem = id - s4 * 25; bf16_t* blob = RB + (size_t)(chunk0 + s4) * RB_EL;
            const bf16x8 fF = q < 2 ? *(const LAS bf16x8*)(F_l + s4 * 384 + r * 24 + q * 8) : zfrag;
            if (rem < 4) {
                const bf16x8 xf = q < 2 ? *(const LAS bf16x8*)(PpT_l + (rem * 16 + r) * 72 + s4 * 16 + q * 8) : zfrag;
                const f32x4 d = mma16(xf, fF, (f32x4){0.f, 0.f, 0.f, 0.f});
                const u32x2 qv = *(const LAS u32x2*)(Q_l + (s4 * 16 + r) * 72 + rem * 16 + q * 4);
                u32x2 o; o.x = pk2(__uint_as_float(qv.x << 16) - d[0], __uint_as_float(qv.x & 0xffff0000u) - d[1]); o.y = pk2(__uint_as_float(qv.y << 16) - d[2], __uint_as_float(qv.y & 0xffff0000u) - d[3]);
                *(u32x2*)(blob + RB_QP + r * 72 + 32 * (rem >> 1) + 8 * q + 4 * (rem & 1)) = o;
            } else if (rem == 4) {
                f32x4 d2 = (f32x4){0.f, 0.f, 0.f, 0.f};
#pragma unroll
                for (int ks = 0; ks < 2; ++ks) d2 = mma16(*(const LAS bf16x8*)(Kn_l + (s4 * 16 + r) * 72 + ks * 32 + q * 8), *(const LAS bf16x8*)(Q_l + (s4 * 16 + r) * 72 + ks * 32 + q * 8), d2);
                const bf16x8 xf = q < 2 ? *(const LAS bf16x8*)(BmpT_l + s4 * 384 + r * 24 + q * 8) : zfrag;
                const f32x4 d1 = mma16(xf, fF, (f32x4){0.f, 0.f, 0.f, 0.f});
                float o4[4];
#pragma unroll
                for (int jj = 0; jj < 4; ++jj) o4[jj] = ((q * 4 + jj <= r) ? d2[jj] : 0.f) - d1[jj];
                u32x2 o; o.x = pk2(o4[0], o4[1]); o.y = pk2(o4[2], o4[3]); *(u32x2*)(blob + RB_EP + r * 24 + q * 4) = o;
            } else if (rem < 21) {
                const int cib = (rem - 5) >> 2, cob = (rem - 5) & 3;
                const bf16x8 xf = q < 2 ? *(const LAS bf16x8*)(PpT_l + (cib * 16 + r) * 72 + s4 * 16 + q * 8) : zfrag;
                const bf16x8 yf = q < 2 ? *(const LAS bf16x8*)(BhT_l + (cob * 16 + r) * 72 + s4 * 16 + q * 8) : zfrag;
                const f32x4 d = mma16(xf, yf, (f32x4){0.f, 0.f, 0.f, 0.f});
                const float gc = GC_l[s4 * 64 + cob * 16 + r]; float o4[4];
#pragma unroll
                for (int jj = 0; jj < 4; ++jj) o4[jj] = ((cib == cob && q * 4 + jj == r) ? gc : 0.f) - d[jj];
                u32x2 o; o.x = pk2(o4[0], o4[1]); o.y = pk2(o4[2], o4[3]); *(u32x2*)(blob + (cob * 16 + r) * 72 + 32 * (cib >> 1) + 8 * q + 4 * (cib & 1)) = o;
            } else {
                const int cb = rem - 21;
                const bf16x8 xf = q < 2 ? *(const LAS bf16x8*)(BmpT_l + s4 * 384 + r * 24 + q * 8) : zfrag;
                const bf16x8 yf = q < 2 ? *(const LAS bf16x8*)(BhT_l + (cb * 16 + r) * 72 + s4 * 16 + q * 8) : zfrag;
                const f32x4 d = mma16(xf, yf, (f32x4){0.f, 0.f, 0.f, 0.f});
                const u32x2 kv = *(const LAS u32x2*)(KhT_l + (cb * 16 + r) * 72 + s4 * 16 + q * 4);
                u32x2 o; o.x = pk2(__uint_as_float(kv.x << 16) - d[0], __uint_as_float(kv.x & 0xffff0000u) - d[1]); o.y = pk2(__uint_as_float(kv.y << 16) - d[2], __uint_as_float(kv.y & 0xffff0000u) - d[3]);
                *(u32x2*)(blob + RB_KHP + (cb * 16 + r) * 24 + q * 4) = o;
            } }
          for (int idx = tid; idx < nsub * 128; idx += 512) { const int s4 = idx >> 7, cc = (idx >> 1) & 63, hf = idx & 1;
              *(u32x4*)(RB + (size_t)(chunk0 + s4) * RB_EL + RB_VT + cc * 24 + hf * 8) = *(const LAS u32x4*)(VT_l + cc * 72 + s4 * 16 + hf * 8); } }
        __syncthreads();
        }
    }
}

__device__ __forceinline__ void ph_rwkv_scan_naive(const Ctx& c, const float* __restrict__ RW, const float* __restrict__ s0, const float* __restrict__ lng, const float* __restrict__ lnb, bf16_t* __restrict__ OB,
                                                   float* __restrict__ outP, float* __restrict__ outS) {
    const float* R = RW; const float* WD = RW + (size_t)MPAD * BW; const float* K2 = WD + (size_t)MPAD * BW; const float* V = K2 + (size_t)MPAD * BW; const float* KK = V + (size_t)MPAD * BW;
    const float* BV = KK + (size_t)MPAD * BW; const float* G = BV + (size_t)MPAD * BW; const float* BON = G + (size_t)MPAD * BW;
    const int lane = c.lane;
    for (int it = 0;; ++it) {
        const int u = (it * 8 + c.wave) * c.G + c.bid;
        if (u >= (PB + SB) * 16) break;
        const int sq = u >> 4, h = u & 15;
        int row0, L; seq_info(sq, row0, L);
        float S[64];
        if (sq >= PB) { const float* p = s0 + (((size_t)(sq - PB) * 16 + h) * 64 + lane) * 64;
#pragma unroll
            for (int j = 0; j < 64; ++j) S[j] = p[j]; }
        else {
#pragma unroll
            for (int j = 0; j < 64; ++j) S[j] = 0.f; }
        const float lg = lng[h * 64 + lane], lb = lnb[h * 64 + lane];
        for (int t = 0; t < L; ++t) {
            const size_t base = (size_t)(row0 + t) * BW + h * 64; const float v = V[base + lane];
            float d = 0.f;
#pragma unroll
            for (int j = 0; j < 64; ++j) d += S[j] * KK[base + j];
            float y = 0.f;
#pragma unroll
            for (int j = 0; j < 64; ++j) { S[j] = S[j] * WD[base + j] - d * BV[base + j] + v * K2[base + j]; y += S[j] * R[base + j]; }
            const float mean = wave_sum(y) * (1.0f / 64.0f), dy = y - mean, var = wave_sum(dy * dy) * (1.0f / 64.0f);
            const float yn = dy * rsqrtf(var + 64e-5f) * lg + lb;
            OB[base + lane] = f2bf((yn + BON[base + lane]) * G[base + lane]);
        }
        float* op = (sq < PB ? outP + (((size_t)sq * 16 + h) * 64 + lane) * 64 : outS + (((size_t)(sq - PB) * 16 + h) * 64 + lane) * 64);
#pragma unroll
        for (int j = 0; j < 64; ++j) op[j] = S[j];
    }
}
__device__ __forceinline__ void ph_rwkv_scan2(const Ctx& c, int boff, const float* __restrict__ RW, const float* __restrict__ s0, const float* __restrict__ lng, const float* __restrict__ lnb, bf16_t* __restrict__ OB,
                                              float* __restrict__ outP, float* __restrict__ outS) {
    LAS float* opb = (LAS float*)c.lds;
    LAS float* yb = opb + 2 * 16 * 384;
    const int tid = c.tid, lane = c.lane, w = c.wave, rl = lane >> 3, cg = lane & 7, vrow = w * 8 + rl;
    const float* G = RW + 6 * (size_t)MPAD * BW; const float* BON = RW + 7 * (size_t)MPAD * BW;
    for (int u = (c.bid - boff + c.G) % c.G; u < (PB + SB) * 16; u += c.G) {
        const int sq = u >> 4, h = u & 15;
        int row0, L; seq_info(sq, row0, L);
        float S[8];
        if (sq >= PB) { const float* p = s0 + (((size_t)(sq - PB) * 16 + h) * 64 + vrow) * 64 + cg * 8;
#pragma unroll
            for (int j = 0; j < 8; ++j) S[j] = p[j]; }
        else {
#pragma unroll
            for (int j = 0; j < 8; ++j) S[j] = 0.f; }
        const float lg = lng[h * 64 + lane], lb = lnb[h * 64 + lane];
        const int nb = (L + 15) >> 4;
#define RW_STAGE(bi_) do { const int t0_ = (bi_) * 16, nT_ = (L - t0_) < 16 ? (L - t0_) : 16; LAS float* dst_ = opb + ((bi_) & 1) * 16 * 384; \
        for (int idx = tid; idx < nT_ * 96; idx += 512) { const int t = idx / 96, rem = idx - t * 96, slot = rem >> 4, c4 = rem & 15; \
            const int arr = slot == 0 ? 1 : slot == 1 ? 4 : slot == 2 ? 5 : slot == 3 ? 2 : slot == 4 ? 0 : 3; \
            *(LAS f32x4*)(dst_ + t * 384 + slot * 64 + c4 * 4) = *(const f32x4*)(RW + (size_t)arr * MPAD * BW + (size_t)(row0 + t0_ + t) * BW + h * 64 + c4 * 4); } } while (0)
        RW_STAGE(0);
        for (int bi = 0; bi < nb; ++bi) {
            __syncthreads();
            if (bi + 1 < nb) RW_STAGE(bi + 1);
            const int t0 = bi * 16, nT = (L - t0) < 16 ? (L - t0) : 16; const LAS float* src = opb + (bi & 1) * 16 * 384;
            for (int tt = 0; tt < nT; ++tt) {
                const LAS float* b = src + tt * 384 + cg * 8;
                const f32x4 w0 = *(const LAS f32x4*)(b), w1 = *(const LAS f32x4*)(b + 4), k0 = *(const LAS f32x4*)(b + 64), k1 = *(const LAS f32x4*)(b + 68);
                const f32x4 b0 = *(const LAS f32x4*)(b + 128), b1 = *(const LAS f32x4*)(b + 132), q0 = *(const LAS f32x4*)(b + 192), q1 = *(const LAS f32x4*)(b + 196);
                const f32x4 r0 = *(const LAS f32x4*)(b + 256), r1 = *(const LAS f32x4*)(b + 260); const float v = src[tt * 384 + 320 + vrow];
                float d = (S[0] * k0[0] + S[1] * k0[1]) + (S[2] * k0[2] + S[3] * k0[3]) + (S[4] * k1[0] + S[5] * k1[1]) + (S[6] * k1[2] + S[7] * k1[3]);
                d += __shfl_xor(d, 1, 64); d += __shfl_xor(d, 2, 64); d += __shfl_xor(d, 4, 64);
                float y = 0.f;
#pragma unroll
                for (int j = 0; j < 4; ++j) { S[j] = S[j] * w0[j] - d * b0[j] + v * q0[j]; y += S[j] * r0[j]; S[4 + j] = S[4 + j] * w1[j] - d * b1[j] + v * q1[j]; y += S[4 + j] * r1[j]; }
                y += __shfl_xor(y, 1, 64); y += __shfl_xor(y, 2, 64); y += __shfl_xor(y, 4, 64);
                if (cg == 0) yb[tt * 64 + vrow] = y;
            }
            __syncthreads();
            for (int tt = w; tt < nT; tt += 8) {
                const float y = yb[tt * 64 + lane]; const float mean = wave_sum(y) * (1.0f / 64.0f), dy = y - mean, var = wave_sum(dy * dy) * (1.0f / 64.0f);
                const float yn = dy * rsqrtf(var + 64e-5f) * lg + lb; const size_t o = (size_t)(row0 + t0 + tt) * BW + h * 64 + lane;
                OB[o] = f2bf((yn + BON[o]) * G[o]);
            }
        }
#undef RW_STAGE
        float* op = (sq < PB ? outP + (((size_t)sq * 16 + h) * 64 + vrow) * 64 : outS + (((size_t)(sq - PB) * 16 + h) * 64 + vrow) * 64) + cg * 8;
#pragma unroll
        for (int j = 0; j < 8; ++j) op[j] = S[j];
        __syncthreads();
    }
}
constexpr int RS_SLOTS = 8, RS_SLOT_B = RB_EL * 2;
__device__ __forceinline__ void ph_rwkv_seq(const Ctx& c, int boff, const bf16_t* __restrict__ RB, const float* __restrict__ s0, float* __restrict__ outP, float* __restrict__ outS, bf16_t* __restrict__ OB) {
    const int lane = c.lane, r = lane & 15, q = lane >> 4, w = c.wave;
    LAS unsigned char* ring = c.lds;
    const int side = c.bid < 32 ? c.bid : c.bid - 64, nside = c.G - 64;
    for (int u = (c.bid >= boff && c.bid < boff + 32) ? c.bid - boff : ((c.bid < 32 || c.bid >= 96) ? 32 + side : (PB + SB) * 16); u < (PB + SB) * 16; u = u < 32 ? (PB + SB) * 16 : u + nside) {
        const int sq = u >> 4, h = u & 15;
        int nch, ch0, row0, ntok; const float* sp = nullptr; float* op;
        if (sq < PB) { nch = 256; ch0 = (sq * 16 + h) * 256; row0 = sq * PS; ntok = 16; op = outP + (size_t)(sq * 16 + h) * 4096; }
        else { nch = 1; ch0 = PB * 16 * 256 + (sq - PB) * 16 + h; row0 = MP + (sq - PB) * SS; ntok = SS; sp = s0 + (size_t)((sq - PB) * 16 + h) * 4096; op = outS + (size_t)((sq - PB) * 16 + h) * 4096; }
        if (w >= 4) {
            const int lw = w - 4, p0 = lw < 2 ? lw * 5 : 10 + (lw - 2) * 4, np = lw < 2 ? 5 : 4;
#define RS_ISSUE(ci_) do { const int cc_ = (ci_) < nch ? (ci_) : nch - 1; const char* g_ = (const char*)(RB + (size_t)(ch0 + cc_) * RB_EL) + p0 * 1024 + lane * 16; \
            LAS unsigned char* d_ = ring + ((ci_) % RS_SLOTS) * RS_SLOT_B + p0 * 1024; \
            _Pragma("unroll") for (int p_ = 0; p_ < 5; ++p_) if (p_ < np) __builtin_amdgcn_global_load_lds((const unsigned*)(g_ + p_ * 1024), (LAS unsigned*)(d_ + p_ * 1024), 16, 0, 0); } while (0)
            for (int ci = 0; ci < RS_SLOTS - 1; ++ci) RS_ISSUE(ci);
            if (lw < 2) asm volatile("s_waitcnt vmcnt(30)" ::: "memory"); else asm volatile("s_waitcnt vmcnt(24)" ::: "memory");
            __builtin_amdgcn_s_barrier();
            for (int ci = 0; ci < nch; ++ci) {
                RS_ISSUE(ci + RS_SLOTS - 1);
                if (lw < 2) asm volatile("s_waitcnt vmcnt(30)" ::: "memory"); else asm volatile("s_waitcnt vmcnt(24)" ::: "memory");
                __builtin_amdgcn_s_barrier();
            }
#undef RS_ISSUE
            asm volatile("s_waitcnt vmcnt(0)" ::: "memory");
        } else {
            const int vb = w; f32x4 acc[4];
#pragma unroll
            for (int kb = 0; kb < 4; ++kb) acc[kb] = sp ? *(const f32x4*)(sp + (size_t)(vb * 16 + r) * 64 + kb * 16 + q * 4) : (f32x4){0.f, 0.f, 0.f, 0.f};
            const bf16x8 zfrag = (bf16x8){0, 0, 0, 0, 0, 0, 0, 0};
            __builtin_amdgcn_s_barrier();
            for (int ci = 0; ci < nch; ++ci) {
                const LAS bf16_t* blob = (const LAS bf16_t*)(ring + (ci % RS_SLOTS) * RS_SLOT_B);
                bf16x8 mf[4][2], khf[4], qpf[2];
#pragma unroll
                for (int kb = 0; kb < 4; ++kb) { mf[kb][0] = *(const LAS bf16x8*)(blob + (kb * 16 + r) * 72 + q * 8); mf[kb][1] = *(const LAS bf16x8*)(blob + (kb * 16 + r) * 72 + 32 + q * 8);
                    khf[kb] = q < 2 ? *(const LAS bf16x8*)(blob + RB_KHP + (kb * 16 + r) * 24 + q * 8) : zfrag; }
                qpf[0] = *(const LAS bf16x8*)(blob + RB_QP + r * 72 + q * 8); qpf[1] = *(const LAS bf16x8*)(blob + RB_QP + r * 72 + 32 + q * 8);
                const bf16x8 vt = q < 2 ? *(const LAS bf16x8*)(blob + RB_VT + (vb * 16 + r) * 24 + q * 8) : zfrag;
                const bf16x8 ep = q < 2 ? *(const LAS bf16x8*)(blob + RB_EP + r * 24 + q * 8) : zfrag;
                const bf16x8 t0 = pack_acc(acc[0], acc[1]), t1 = pack_acc(acc[2], acc[3]);
                __builtin_amdgcn_sched_barrier(0);
#pragma unroll
                for (int kb = 0; kb < 4; ++kb) acc[kb] = mma16(mf[kb][0], t0, (f32x4){0.f, 0.f, 0.f, 0.f});
#pragma unroll
                for (int kb = 0; kb < 4; ++kb) acc[kb] = mma16(mf[kb][1], t1, acc[kb]);
#pragma unroll
                for (int kb = 0; kb < 4; ++kb) acc[kb] = mma16(khf[kb], vt, acc[kb]);
                f32x4 y = mma16(t0, qpf[0], (f32x4){0.f, 0.f, 0.f, 0.f}); y = mma16(t1, qpf[1], y); y = mma16(vt, ep, y);
                if (r < ntok) { u32x2 o; o.x = pk2(y[0], y[1]); o.y = pk2(y[2], y[3]); *(u32x2*)(OB + (size_t)(row0 + ci * 16 + r) * BW + h * 64 + vb * 16 + q * 4) = o; }
                asm volatile("s_waitcnt lgkmcnt(0)" ::: "memory");
                __builtin_amdgcn_s_barrier();
            }
#pragma unroll
            for (int kb = 0; kb < 4; ++kb) *(f32x4*)(op + (size_t)(vb * 16 + r) * 64 + kb * 16 + q * 4) = acc[kb];
        }
        __syncthreads();
    }
}
__device__ __forceinline__ void ph_rwkv_fin(const Ctx& c, const float* __restrict__ RW, const float* __restrict__ lng, const float* __restrict__ lnb, const bf16_t* __restrict__ RAW, bf16_t* __restrict__ OB) {
    const int lane = c.lane; const bf16_t* G = (const bf16_t*)(RW + 6 * (size_t)MPAD * BW); const bf16_t* BON = (const bf16_t*)(RW + 7 * (size_t)MPAD * BW);
    for (int i = c.bid * 8 + c.wave; i < MT * 2; i += c.G * 8) {
        const int row = i >> 1, cc = (i & 1) * 512 + lane * 8; const size_t o = (size_t)row * BW + cc;
        float x[8], bo[8], gt[8]; unpack8(*(const u32x4*)(RAW + o), x); unpack8(*(const u32x4*)(BON + o), bo); unpack8(*(const u32x4*)(G + o), gt);
        float s = 0.f;
#pragma unroll
        for (int j = 0; j < 8; ++j) s += x[j];
        s += __shfl_xor(s, 1, 64); s += __shfl_xor(s, 2, 64); s += __shfl_xor(s, 4, 64);
        const float mean = s * (1.0f / 64.0f); float qq = 0.f;
#pragma unroll
        for (int j = 0; j < 8; ++j) { const float d = x[j] - mean; qq += d * d; }
        qq += __shfl_xor(qq, 1, 64); qq += __shfl_xor(qq, 2, 64); qq += __shfl_xor(qq, 4, 64);
        const float rstd = rsqrtf(qq * (1.0f / 64.0f) + 64e-5f);
        const f32x4 g0 = *(const f32x4*)(lng + cc), g1 = *(const f32x4*)(lng + cc + 4), b0 = *(const f32x4*)(lnb + cc), b1 = *(const f32x4*)(lnb + cc + 4); float ov[8];
#pragma unroll
        for (int j = 0; j < 8; ++j) ov[j] = ((x[j] - mean) * rstd * (j < 4 ? g0[j] : g1[j - 4]) + (j < 4 ? b0[j] : b1[j - 4]) + bo[j]) * gt[j];
        *(u32x4*)(OB + o) = (u32x4){pk2(ov[0], ov[1]), pk2(ov[2], ov[3]), pk2(ov[4], ov[5]), pk2(ov[6], ov[7])};
    }
}

__device__ __forceinline__ void ph_memattn_sample(const Ctx& c, int boff, const bf16_t* __restrict__ U, const float* __restrict__ mk, const float* __restrict__ mv, bf16_t* __restrict__ OB) {
    LAS float* ps = (LAS float*)c.lds;
    const int hh = c.tid >> 8, vt = c.tid & 255, lane = c.lane, r = lane & 15, q = lane >> 4, w4 = c.wave & 3;
    for (int u = (c.bid - boff + c.G) % c.G; u < SB * 2; u += c.G) {
        const int sq = u >> 1, h = (u & 1) * 2 + hh;
        bf16x8 qf[8];
#pragma unroll
        for (int ks = 0; ks < 8; ++ks) { u32x4 raw = (u32x4){0u, 0u, 0u, 0u};
            if (r < 4) raw = *(const u32x4*)(U + (size_t)(MP + sq * SS + r) * NINP + U_MQ + h * 256 + ks * 32 + q * 8);
            qf[ks] = __builtin_bit_cast(bf16x8, raw); }
#pragma unroll 1
        for (int mt = 0; mt < 4; ++mt) { const float* kr = mk + (((size_t)sq * MEMT + (w4 * 4 + mt) * 16 + r) * 4 + h) * 256 + q * 8; f32x4 ka[8], kb2[8];
#pragma unroll
            for (int ks = 0; ks < 8; ++ks) { ka[ks] = *(const f32x4*)(kr + ks * 32); kb2[ks] = *(const f32x4*)(kr + ks * 32 + 4); }
            __builtin_amdgcn_sched_barrier(0);
            f32x4 d = (f32x4){0.f, 0.f, 0.f, 0.f};
#pragma unroll
            for (int ks = 0; ks < 8; ++ks) { u32x4 p; p.x = pk2(ka[ks][0], ka[ks][1]); p.y = pk2(ka[ks][2], ka[ks][3]); p.z = pk2(kb2[ks][0], kb2[ks][1]); p.w = pk2(kb2[ks][2], kb2[ks][3]);
                d = mma16(__builtin_bit_cast(bf16x8, p), qf[ks], d); }
            if (r < 4) *(LAS f32x4*)(ps + (hh * 4 + r) * 256 + (w4 * 4 + mt) * 16 + q * 4) = d * 0.0625f; }
        __syncthreads();
        { LAS float* pr = ps + c.wave * 256; float x[4]; float mx = -3.0e38f;
#pragma unroll
            for (int j = 0; j < 4; ++j) { x[j] = pr[lane + 64 * j]; mx = fmaxf(mx, x[j]); }
            mx = wave_max(mx); float s = 0.f;
#pragma unroll
            for (int j = 0; j < 4; ++j) { x[j] = __expf(x[j] - mx); s += x[j]; }
            const float inv = 1.0f / wave_sum(s);
#pragma unroll
            for (int j = 0; j < 4; ++j) pr[lane + 64 * j] = x[j] * inv; }
        __syncthreads();
        { float o[4] = {0.f, 0.f, 0.f, 0.f}; const float* vr = mv + ((size_t)sq * MEMT * 4 + h) * 256 + vt;
#pragma unroll 8
            for (int m = 0; m < MEMT; ++m) { const float vv = vr[(size_t)m * 1024];
#pragma unroll
                for (int t = 0; t < 4; ++t) o[t] += ps[(hh * 4 + t) * 256 + m] * vv; }
#pragma unroll
            for (int t = 0; t < 4; ++t) OB[(size_t)(MP + sq * SS + t) * BW + h * 256 + vt] = f2bf(o[t]); }
        __syncthreads();
    }
}

template <int K, int LDA, int LDB> __device__ __forceinline__ void skinny_pair(const Ctx& c, const bf16_t* __restrict__ A, const bf16_t* __restrict__ B0, const bf16_t* __restrict__ B1, f32x4 (&out)[2], int rot) {
    LAS f32x4* red = (LAS f32x4*)c.lds;
    const int lane = c.lane, r = lane & 15, q = lane >> 4, w = c.wave;
    constexpr int KS = K / 8;
    const bf16_t* ap = A + (size_t)r * LDA + w * KS + q * 8; const bf16_t* b0 = B0 + (size_t)r * LDB + w * KS + q * 8; const bf16_t* b1 = B1 + (size_t)r * LDB + w * KS + q * 8;
    f32x4 acc[2][8];
#pragma unroll
    for (int n = 0; n < 2; ++n)
#pragma unroll
        for (int m = 0; m < 8; ++m) acc[n][m] = (f32x4){0.f, 0.f, 0.f, 0.f};
    int kk = (int)((unsigned)rot % (unsigned)(KS / 32));
#pragma unroll 2
    for (int it = 0; it < KS / 32; ++it) { const int ks = kk; kk = kk + 1 == KS / 32 ? 0 : kk + 1;
        const bf16x8 f0 = *(const bf16x8*)(b0 + ks * 32), f1 = *(const bf16x8*)(b1 + ks * 32); bf16x8 af[8];
#pragma unroll
        for (int m = 0; m < 8; ++m) af[m] = *(const bf16x8*)(ap + (size_t)(m * 16) * LDA + ks * 32);
        __builtin_amdgcn_sched_barrier(0);
#pragma unroll
        for (int m = 0; m < 8; ++m) { acc[0][m] = mma16(f0, af[m], acc[0][m]); acc[1][m] = mma16(f1, af[m], acc[1][m]); } }
    __syncthreads();
#pragma unroll
    for (int n = 0; n < 2; ++n)
#pragma unroll
        for (int m = 0; m < 8; ++m) red[(w * 16 + n * 8 + m) * 64 + lane] = acc[n][m];
    __syncthreads();
#pragma unroll
    for (int n = 0; n < 2; ++n) { f32x4 s = red[(n * 8 + w) * 64 + lane];
#pragma unroll
        for (int ww = 1; ww < 8; ++ww) s += red[(ww * 16 + n * 8 + w) * 64 + lane];
        out[n] = s; }
}
template <int K, int LDA, int LDB> __device__ __forceinline__ f32x4 skinny_one(const Ctx& c, const bf16_t* __restrict__ A, const bf16_t* __restrict__ B0, int rot) {
    LAS f32x4* red = (LAS f32x4*)c.lds;
    const int lane = c.lane, r = lane & 15, q = lane >> 4, w = c.wave;
    constexpr int KS = K / 8, NK = KS / 32;
    const bf16_t* ap = A + (size_t)r * LDA + w * KS + q * 8; const bf16_t* b0 = B0 + (size_t)r * LDB + w * KS + q * 8;
    f32x4 acc[8];
#pragma unroll
    for (int m = 0; m < 8; ++m) acc[m] = (f32x4){0.f, 0.f, 0.f, 0.f};
    int kk = (int)((unsigned)rot % (unsigned)NK);
#pragma unroll 4
    for (int it = 0; it < NK; ++it) { const int ks = kk; kk = kk + 1 == NK ? 0 : kk + 1;
        const bf16x8 f0 = *(const bf16x8*)(b0 + ks * 32); bf16x8 af[8];
#pragma unroll
        for (int m = 0; m < 8; ++m) af[m] = *(const bf16x8*)(ap + (size_t)(m * 16) * LDA + ks * 32);
        __builtin_amdgcn_sched_barrier(0);
#pragma unroll
        for (int m = 0; m < 8; ++m) acc[m] = mma16(f0, af[m], acc[m]); }
    __syncthreads();
#pragma unroll
    for (int m = 0; m < 8; ++m) red[(w * 8 + m) * 64 + lane] = acc[m];
    __syncthreads();
    f32x4 s = red[w * 64 + lane];
#pragma unroll
    for (int ww = 1; ww < 8; ++ww) s += red[(ww * 8 + w) * 64 + lane];
    return s;
}
__device__ __forceinline__ u32x2 pk4(const f32x4 v) { u32x2 o; o.x = pk2(v[0], v[1]); o.y = pk2(v[2], v[3]); return o; }
#define SKINNY_LOOP(total_) for (int s = c.bid - base; s >= 0 && s < (total_); s += ncu)
__device__ __forceinline__ void ph_sk_in(const Ctx& c, int base, int ncu, const bf16_t* __restrict__ HB, const bf16_t* __restrict__ W, bf16_t* __restrict__ U) {
    const int r = c.lane & 15, q = c.lane >> 4, w = c.wave;
    SKINNY_LOOP(NINP / 32) { f32x4 o[2]; skinny_pair<DM, DM, DM>(c, HB + (size_t)MP * DM, W + (size_t)(s * 32) * DM, W + (size_t)(s * 32 + 16) * DM, o, s);
        bf16_t* up = U + (size_t)(MP + w * 16 + r) * NINP + s * 32 + q * 4; *(u32x2*)up = pk4(o[0]); *(u32x2*)(up + 16) = pk4(o[1]); }
}
__device__ __forceinline__ void ph_sk_merge(const Ctx& c, int base, int ncu, const bf16_t* __restrict__ BR, const bf16_t* __restrict__ W, const bf16_t* __restrict__ U, const float* __restrict__ gate_b, bf16_t* __restrict__ MGB) {
    const int r = c.lane & 15, q = c.lane >> 4, w = c.wave;
    SKINNY_LOOP(DM / 16) { const size_t row = (size_t)(MP + w * 16 + r); const int col = s * 16 + q * 4; f32x4 tot = (f32x4){0.f, 0.f, 0.f, 0.f};
#pragma unroll 1
        for (int z = 0; z < 4; ++z) { const f32x4 o = skinny_one<BW, BW, BW>(c, BR + ((size_t)z * MPAD + MP) * BW, W + ((size_t)z * DM + s * 16) * BW, s + z);
            const u32x2 gp = *(const u32x2*)(U + row * NINP + U_GP + z * DM + col); const f32x4 gb = *(const f32x4*)(gate_b + z * DM + col);
            tot[0] += sigmoidf_(__uint_as_float(gp.x << 16) + gb[0]) * o[0]; tot[1] += sigmoidf_(__uint_as_float(gp.x & 0xffff0000u) + gb[1]) * o[1];
            tot[2] += sigmoidf_(__uint_as_float(gp.y << 16) + gb[2]) * o[2]; tot[3] += sigmoidf_(__uint_as_float(gp.y & 0xffff0000u) + gb[3]) * o[3]; }
        *(u32x2*)(MGB + row * DM + col) = pk4(tot); }
}
template <int K> __device__ __forceinline__ void ph_sk_res(const Ctx& c, int base, int ncu, const bf16_t* __restrict__ A, const bf16_t* __restrict__ W, const bf16_t* __restrict__ R, bf16_t* __restrict__ Y) {
    const int r = c.lane & 15, q = c.lane >> 4, w = c.wave;
    SKINNY_LOOP(DM / 16) { const f32x4 o = skinny_one<K, K, K>(c, A + (size_t)MP * K, W + (size_t)(s * 16) * K, s);
        const size_t off = (size_t)(MP + w * 16 + r) * DM + s * 16 + q * 4; const u32x2 rr = *(const u32x2*)(R + off);
        const f32x4 rv = (f32x4){__uint_as_float(rr.x << 16), __uint_as_float(rr.x & 0xffff0000u), __uint_as_float(rr.y << 16), __uint_as_float(rr.y & 0xffff0000u)};
        *(u32x2*)(Y + off) = pk4(rv * ALPHA + o); }
}
__device__ __forceinline__ void ph_sk_gu(const Ctx& c, int base, int ncu, const bf16_t* __restrict__ X1B, const bf16_t* __restrict__ W, bf16_t* __restrict__ ACT) {
    const int r = c.lane & 15, q = c.lane >> 4, w = c.wave;
    SKINNY_LOOP(DFF / 16) { const int t = s >> 3, j0 = (s & 7) * 16; f32x4 o[2];
        skinny_pair<DM, DM, DM>(c, X1B + (size_t)MP * DM, W + (size_t)(t * 256 + j0) * DM, W + (size_t)(t * 256 + 128 + j0) * DM, o, s);
        f32x4 v;
#pragma unroll
        for (int j = 0; j < 4; ++j) v[j] = o[0][j] * sigmoidf_(o[0][j]) * o[1][j];
        *(u32x2*)(ACT + (size_t)(MP + w * 16 + r) * DFF + t * 128 + j0 + q * 4) = pk4(v); }
}
#undef SKINNY_LOOP

constexpr int LDS_BAR_OFF = 147456;
constexpr int LDS_BYTES = LDS_BAR_OFF + 64;
struct Args { const float* in[37]; float* out; unsigned char* ws; };

typedef pg8::Gemm<DM, DM, DM, 2, 8, NL, 1, false, 0, 0, (long)DM * DM, 0> GemmMem;
typedef pg8::Gemm<DM, DM, DM, MP / 256, NINP / 256> GemmIn;
typedef pg8::Gemm<NINP, 1024, 256, PS / 256, 1, 8, 4, false, (long)PS * NINP, 256, 256 * 1024, 256> GemmScore;
typedef pg8::Gemm<256, 256, 256, PS / 256, 1, 8, 4, false, (long)4 * 4096 * 256, (long)4096 * 256, 4 * 65536, 65536> GemmPV;
typedef pg8::Gemm<BW, BW, BW, MP / 256, DM / 256, 4, 1, true, (long)MPAD * BW, 0, (long)DM * BW, 0> GemmBranch;
typedef pg8::Gemm<DM, DM, DM, MP / 256, DM / 256> GemmOut;
typedef pg8::Gemm<DM, DM, DM, MP / 256, 2 * DFF / 256> GemmGU;
typedef pg8::Gemm<DFF, DFF, DFF, MP / 256, DM / 256> GemmDown;
template <class GT> __device__ __forceinline__ GT mk_gemm(const Ctx& c, const bf16_t* A, const bf16_t* B) { GT g; g.A = A; g.B = B; g.G = c.G; g.c = c.bid; return g; }

template <int OFF> __device__ __forceinline__ unsigned long long karg_u64(unsigned long long kargs) {
    unsigned long long p; asm volatile("s_load_dwordx2 %0, %1, %2\n\ts_waitcnt lgkmcnt(0)" : "=s"(p) : "s"(kargs), "n"(OFF) : "memory"); return p;
}
#define GPTR(T, x) ((T*)(__attribute__((address_space(1))) T*)(x))
#define INP(k) GPTR(const float, karg_u64<(k) * 8>(kargs))
#define OUTP() GPTR(float, karg_u64<37 * 8>(kargs))
#define WSP() GPTR(unsigned char, karg_u64<38 * 8>(kargs))

__global__ void __launch_bounds__(512, 2) mega_fwd(Args a_unused) {
    extern __shared__ __attribute__((aligned(16))) unsigned char lds_raw[];
    const unsigned long long kargs = (unsigned long long)__builtin_amdgcn_kernarg_segment_ptr();
    Ctx c0; c0.tid = threadIdx.x; c0.lane = c0.tid & 63; c0.wave = __builtin_amdgcn_readfirstlane(c0.tid >> 6); c0.bid = blockIdx.x; c0.G = gridDim.x; c0.lds = (LAS unsigned char*)lds_raw;
    if (c0.tid < 4) ((LAS unsigned*)(c0.lds + LDS_BAR_OFF))[c0.tid] = 0u;
    __syncthreads();
    const XcdBarrier bar = xcd_barrier_post((unsigned*)(WSP() + WS_CTL), (volatile LAS unsigned*)(c0.lds + LDS_BAR_OFF));

#define WPREP_LAYER(cc_, L_) do { unsigned char* ws_ = WSP(); \
      ph_wprep(cc_, INP(10) + (size_t)(L_) * DM * NIN, (bf16_t*)(ws_ + WS_WIN) + (size_t)(L_) * NINP * DM, DM, NIN, NINP, 1, 1, 0, 0); \
      ph_wprep(cc_, INP(29) + (size_t)(L_) * 4 * BW * DM, (bf16_t*)(ws_ + WS_WBR) + (size_t)(L_) * 4 * DM * BW, BW, DM, DM, 0, 4, (size_t)BW * DM, (size_t)DM * BW); \
      ph_wprep(cc_, INP(30) + (size_t)(L_) * DM * DM, (bf16_t*)(ws_ + WS_WOUT) + (size_t)(L_) * DM * DM, DM, DM, DM, 0, 1, 0, 0); \
      ph_wprep(cc_, INP(33) + (size_t)(L_) * DM * 2 * DFF, (bf16_t*)(ws_ + WS_WGU) + (size_t)(L_) * 2 * DFF * DM, DM, 2 * DFF, 2 * DFF, 2, 1, 0, 0); \
      ph_wprep(cc_, INP(34) + (size_t)(L_) * DFF * DM, (bf16_t*)(ws_ + WS_WDN) + (size_t)(L_) * DM * DFF, DFF, DM, DM, 0, 1, 0, 0); } while (0)
    { const Ctx c = fresh(c0); unsigned char* ws = WSP();
      ph_wprep(c, INP(28), (bf16_t*)(ws + WS_WMEM), DM, DM, DM, 0, NL, (size_t)DM * DM, (size_t)DM * DM);
      WPREP_LAYER(c, 0);
      ph_lrw(c, INP(19), INP(21), INP(22), (bf16_t*)(ws + WS_LRW));
      ph_xprep(c, INP(0), INP(1), INP(2), (float*)nullptr, (bf16_t*)(ws + WS_HB), (bf16_t*)(ws + WS_MEMB)); }
    xcd_barrier(bar);
    { const Ctx c = fresh(c0); unsigned char* ws = WSP(); float* out = OUTP();
      GemmMem g = mk_gemm<GemmMem>(c, (const bf16_t*)(ws + WS_MEMB), (const bf16_t*)(ws + WS_WMEM));
      pg8::EpiMem E; E.outK = out + O_MKP; E.outV = out + O_MVP; E.kb = (bf16_t*)(ws + WS_MKB); E.vt = (bf16_t*)(ws + WS_MVT); pg8::gemm_phase<GemmMem, pg8::EpiMem, true, true>(c.lds, c.tid, g, E); }

    for (int l = 0; l < NL; ++l) {
        { const Ctx c = fresh(c0); unsigned char* ws = WSP();
          GemmIn g = mk_gemm<GemmIn>(c, (const bf16_t*)(ws + WS_HB), (const bf16_t*)(ws + WS_WIN) + (size_t)l * NINP * DM);
          pg8::EpiBf16 E; E.O = (bf16_t*)(ws + WS_U); E.zs = 0; E.ldc = NINP; E.pad = 0; pg8::gemm_phase<GemmIn, pg8::EpiBf16, true, true>(c.lds, c.tid, g, E); }
        { const Ctx c = fresh(c0); unsigned char* ws = WSP(); ph_sk_in(c, c.G > 192 ? 96 : 0, c.G > 192 ? c.G - 96 : c.G, (const bf16_t*)(ws + WS_HB), (const bf16_t*)(ws + WS_WIN) + (size_t)l * NINP * DM, (bf16_t*)(ws + WS_U)); }
        xcd_barrier(bar);
        { const Ctx c = fresh(c0); unsigned char* ws = WSP(); float* out = OUTP(); const bf16_t* U = (const bf16_t*)(ws + WS_U); bf16_t* BR = (bf16_t*)(ws + WS_BR);
          (void)out; (void)BR;
          ph_gla_pre(c, U, INP(12) + (size_t)l * 16 * 512, INP(13) + (size_t)l * 512, (bf16_t*)(ws + WS_GLQD), (bf16_t*)(ws + WS_GLKH), (bf16_t*)(ws + WS_GLE), (bf16_t*)(ws + WS_GLVT), (float*)(ws + WS_GLGC)); }
        { const Ctx c = fresh(c0); unsigned char* ws = WSP();
          ph_rwkv_pre(c, (const bf16_t*)(ws + WS_U), INP(9) + (size_t)l * SB * RWC, INP(17) + (size_t)l * RWC, INP(18) + (size_t)l * BW, INP(19) + (size_t)l * 64 * BW, INP(20) + (size_t)l * BW, INP(21) + (size_t)l * 64 * BW,
                       INP(22) + (size_t)l * 128 * BW, INP(23) + (size_t)l * BW, INP(24) + (size_t)l * BW, INP(25) + (size_t)l * BW, (float*)(ws + WS_RW), (bf16_t*)(ws + WS_RB), (const bf16_t*)(ws + WS_LRW) + (size_t)l * 1024 * 256); }
        { const Ctx c = fresh(c0); unsigned char* ws = WSP(); ph_memattn_prompt(c, (const bf16_t*)(ws + WS_U), (const bf16_t*)(ws + WS_MKB) + (size_t)l * 512 * 1024, (const bf16_t*)(ws + WS_MVT) + (size_t)l * 8 * 65536, (bf16_t*)(ws + WS_BR) + (size_t)3 * MPAD * BW); }
        xcd_barrier(bar);
        { const Ctx c = fresh(c0); unsigned char* ws = WSP(); float* out = OUTP();
          ph_rwkv_seq(c, 64, (const bf16_t*)(ws + WS_RB), INP(8) + (size_t)l * SB * 16 * 4096, out + O_RWP + (size_t)l * PB * 16 * 4096, out + O_RWS + (size_t)l * SB * 16 * 4096,
                      (bf16_t*)(ws + WS_RAW) + (size_t)MPAD * BW); }
        { const Ctx c = fresh(c0); unsigned char* ws = WSP(); float* out = OUTP();
          ph_gla_seq(c, 32, (const bf16_t*)(ws + WS_GLQD), (const bf16_t*)(ws + WS_GLKH), (const bf16_t*)(ws + WS_GLE), (const bf16_t*)(ws + WS_GLVT), (const float*)(ws + WS_GLGC),
                     INP(7) + (size_t)l * SB * 4 * 32768, out + O_GLAP + (size_t)l * PB * 4 * 32768, out + O_GLAS + (size_t)l * SB * 4 * 32768, (bf16_t*)(ws + WS_RAW)); }
        if ((c0.bid < 32 || c0.bid >= 96) && c0.G > 96) {
        { Ctx c = fresh(c0); c.bid = c.bid < 32 ? c.bid : c.bid - 64; c.G = c.G - 64; unsigned char* ws = WSP(); ph_swa_prompt(c, (const bf16_t*)(ws + WS_U), INP(16) + (size_t)l * 16, (bf16_t*)(ws + WS_BR) + (size_t)MPAD * BW); }
        { Ctx c = fresh(c0); c.bid = c.bid < 32 ? c.bid : c.bid - 64; c.G = c.G - 64; unsigned char* ws = WSP();
          ph_swa_sample(c, (const bf16_t*)(ws + WS_U), INP(3) + (size_t)l * SB * 16384, INP(4) + (size_t)l * SB * 16384, INP(16) + (size_t)l * 16, (bf16_t*)(ws + WS_BR) + (size_t)MPAD * BW); }
        { Ctx c = fresh(c0); c.bid = c.bid < 32 ? c.bid : c.bid - 64; c.G = c.G - 64; unsigned char* ws = WSP();
          ph_memattn_sample(c, 64, (const bf16_t*)(ws + WS_U), INP(5) + (size_t)l * SB * MEMT * 1024, INP(6) + (size_t)l * SB * MEMT * 1024, (bf16_t*)(ws + WS_BR) + (size_t)3 * MPAD * BW); }
        { Ctx c = fresh(c0); c.bid = c.bid < 32 ? c.bid : c.bid - 64; c.G = c.G - 64; unsigned char* ws = WSP();
          ph_copy_outs(c, (const bf16_t*)(ws + WS_U), INP(3) + (size_t)l * SB * 16384, INP(4) + (size_t)l * SB * 16384, OUTP(), l); }
          if (l + 1 < NL) { Ctx c = fresh(c0); const int sd = c.bid < 32 ? c.bid : c.bid - 64; c.G = 2 * (c.G - 64) + 96;
            c.bid = 2 * sd; WPREP_LAYER(c, l + 1); c.bid = 2 * sd + 1; WPREP_LAYER(c, l + 1); }
        } else if (l + 1 < NL && c0.G > 96) { Ctx c = fresh(c0); const int nside2 = 2 * (c.G - 64); c.G = nside2 + 96;
          if (c0.bid < 64) { c.bid = nside2 + 2 * (c0.bid - 32); WPREP_LAYER(c, l + 1); c.bid = nside2 + 2 * (c0.bid - 32) + 1; WPREP_LAYER(c, l + 1); }
          else { c.bid = nside2 + 64 + (c0.bid - 64); WPREP_LAYER(c, l + 1); }
        }
        xcd_barrier(bar);
        { const Ctx c = fresh(c0); unsigned char* ws = WSP(); ph_rwkv_fin(c, (const float*)(ws + WS_RW), INP(26) + (size_t)l * BW, INP(27) + (size_t)l * BW, (const bf16_t*)(ws + WS_RAW) + (size_t)MPAD * BW, (bf16_t*)(ws + WS_BR) + (size_t)2 * MPAD * BW); }
        { const Ctx c = fresh(c0); unsigned char* ws = WSP(); ph_gla_fin(c, (const bf16_t*)(ws + WS_U), INP(14) + (size_t)l * BW, INP(15) + (size_t)l * BW, (const bf16_t*)(ws + WS_RAW), (bf16_t*)(ws + WS_BR)); }
        xcd_barrier(bar);
        { const Ctx c = fresh(c0); unsigned char* ws = WSP();
          GemmBranch g = mk_gemm<GemmBranch>(c, (const bf16_t*)(ws + WS_BR), (const bf16_t*)(ws + WS_WBR) + (size_t)l * 4 * DM * BW);
          pg8::EpiMerge E; E.MG = (float*)(ws + WS_MG); E.MGB = (bf16_t*)(ws + WS_MGB); E.U = (const bf16_t*)(ws + WS_U); E.gate_b = INP(11) + (size_t)l * 4 * DM; pg8::gemm_phase<GemmBranch, pg8::EpiMerge, true, true>(c.lds, c.tid, g, E); }
        { const Ctx c = fresh(c0); unsigned char* ws = WSP(); ph_sk_merge(c, 0, c.G, (const bf16_t*)(ws + WS_BR), (const bf16_t*)(ws + WS_WBR) + (size_t)l * 4 * DM * BW, (const bf16_t*)(ws + WS_U), INP(11) + (size_t)l * 4 * DM, (bf16_t*)(ws + WS_MGB)); }
        xcd_barrier(bar);
        { const Ctx c = fresh(c0); unsigned char* ws = WSP();
          GemmOut g = mk_gemm<GemmOut>(c, (const bf16_t*)(ws + WS_MGB), (const bf16_t*)(ws + WS_WOUT) + (size_t)l * DM * DM);
          pg8::EpiRes E; E.R = (const bf16_t*)(ws + WS_HB); E.Y = (bf16_t*)(ws + WS_Y); pg8::gemm_phase<GemmOut, pg8::EpiRes, true, true>(c.lds, c.tid, g, E); }
        { const Ctx c = fresh(c0); unsigned char* ws = WSP(); ph_sk_res<DM>(c, c.G > 192 ? 128 : 0, c.G > 192 ? c.G - 128 : c.G, (const bf16_t*)(ws + WS_MGB), (const bf16_t*)(ws + WS_WOUT) + (size_t)l * DM * DM, (const bf16_t*)(ws + WS_HB), (bf16_t*)(ws + WS_Y)); }
        xcd_barrier(bar);
        { const Ctx c = fresh(c0); unsigned char* ws = WSP(); ph_ln(c, (const bf16_t*)(ws + WS_Y), INP(31) + (size_t)l * DM, INP(32) + (size_t)l * DM, (float*)nullptr, (bf16_t*)(ws + WS_X1B), nullptr, MT, 0); }
        xcd_barrier(bar);
        { const Ctx c = fresh(c0); unsigned char* ws = WSP();
          GemmGU g = mk_gemm<GemmGU>(c, (const bf16_t*)(ws + WS_X1B), (const bf16_t*)(ws + WS_WGU) + (size_t)l * 2 * DFF * DM);
          pg8::EpiSwiGLU E; E.O = (bf16_t*)(ws + WS_ACT); pg8::gemm_phase<GemmGU, pg8::EpiSwiGLU, true, true>(c.lds, c.tid, g, E); }
        { const Ctx c = fresh(c0); unsigned char* ws = WSP(); ph_sk_gu(c, c.G > 192 ? 128 : 0, c.G > 192 ? c.G - 128 : c.G, (const bf16_t*)(ws + WS_X1B), (const bf16_t*)(ws + WS_WGU) + (size_t)l * 2 * DFF * DM, (bf16_t*)(ws + WS_ACT)); }
        xcd_barrier(bar);
        { const Ctx c = fresh(c0); unsigned char* ws = WSP();
          GemmDown g = mk_gemm<GemmDown>(c, (const bf16_t*)(ws + WS_ACT), (const bf16_t*)(ws + WS_WDN) + (size_t)l * DM * DFF);
          pg8::EpiRes E; E.R = (const bf16_t*)(ws + WS_X1B); E.Y = (bf16_t*)(ws + WS_Y); pg8::gemm_phase<GemmDown, pg8::EpiRes, true, true>(c.lds, c.tid, g, E); }
        { const Ctx c = fresh(c0); unsigned char* ws = WSP(); ph_sk_res<DFF>(c, 0, c.G, (const bf16_t*)(ws + WS_ACT), (const bf16_t*)(ws + WS_WDN) + (size_t)l * DM * DFF, (const bf16_t*)(ws + WS_X1B), (bf16_t*)(ws + WS_Y)); }
        xcd_barrier(bar);
        { const Ctx c = fresh(c0); unsigned char* ws = WSP(); float* out = OUTP(); ph_ln(c, (const bf16_t*)(ws + WS_Y), INP(35) + (size_t)l * DM, INP(36) + (size_t)l * DM, (float*)nullptr, (bf16_t*)(ws + WS_HB), l == NL - 1 ? out : nullptr, MT, MT); }
        xcd_barrier(bar);
    }
}

extern "C" void kernel_launch(void* const* d_in, const int* in_sizes, int n_in, void* d_out, int out_size, void* d_ws, size_t ws_size, hipStream_t stream) {
    static int grid = 0;
    if (grid == 0) {
        if (n_in != 37 || (size_t)out_size != O_END || ws_size < WS_END) { fprintf(stderr, "kernel_launch: unexpected sizes (n_in %d out %d ws %zu need %zu)\n", n_in, out_size, ws_size, (size_t)WS_END); grid = -1; return; }
        int dev = 0, cus = 0;
        if (hipGetDevice(&dev) != hipSuccess || hipDeviceGetAttribute(&cus, hipDeviceAttributeMultiprocessorCount, dev) != hipSuccess) { grid = -1; return; }
        if (hipFuncSetAttribute((const void*)mega_fwd, hipFuncAttributeMaxDynamicSharedMemorySize, LDS_BYTES) != hipSuccess) { fprintf(stderr, "kernel_launch: hipFuncSetAttribute failed\n"); grid = -1; return; }
        int per_cu = 0;
        if (hipOccupancyMaxActiveBlocksPerMultiprocessor(&per_cu, (const void*)mega_fwd, 512, LDS_BYTES) != hipSuccess || per_cu < 1) { fprintf(stderr, "kernel_launch: occupancy query says %d\n", per_cu); }
        (void)hipGetLastError();
        grid = cus;
    }
    if (grid < 0) return;
    (void)hipMemsetAsync((unsigned char*)d_ws + WS_CTL, 0, XCD_BAR_WORDS * sizeof(unsigned), stream);
    Args a; memset(&a, 0, sizeof a);
    for (int i = 0; i < 37; ++i) a.in[i] = (const float*)d_in[i];
    a.out = (float*)d_out; a.ws = (unsigned char*)d_ws;
    hipLaunchKernelGGL(mega_fwd, dim3(grid), dim3(512), LDS_BYTES, stream, a);
}
```

```cpp
#include <hip/hip_runtime.h>
#include <cstdio>
#include <cstdint>
#include <cstring>

#define LAS __attribute__((address_space(3)))
typedef unsigned short bf16_t;
typedef short bf16x8 __attribute__((ext_vector_type(8)));
typedef float f32x4 __attribute__((ext_vector_type(4)));
typedef float f32x2 __attribute__((ext_vector_type(2)));
typedef unsigned u32x4 __attribute__((ext_vector_type(4)));
typedef unsigned u32x2 __attribute__((ext_vector_type(2)));

constexpr int DM = 2048, NL = 4;
constexpr int PB = 2, PS = 4096, MP = PB * PS;
constexpr int SB = 32, SS = 4, MS = SB * SS;
constexpr int MT = MP + MS;
constexpr int MPAD = 8448;
constexpr int NIN = 16912, NINP = 17152;
constexpr int U_GQ = 0, U_GK = 512, U_GV = 1024, U_GR = 2048, U_GA = 3072, U_SQ = 3328, U_SK = 4352, U_SV = 4480, U_RU = 4608, U_MQ = 7936, U_GP = 8960;
constexpr int RWC = 3328, BW = 1024, DFF = 5632, MEMT = 256;
constexpr float ALPHA = 1.681792830507429f;

constexpr size_t O_YP = 0;
constexpr size_t O_YS = O_YP + (size_t)MP * DM;
constexpr size_t O_SWKP = O_YS + (size_t)MS * DM;
constexpr size_t O_SWVP = O_SWKP + (size_t)NL * PB * 128 * 128;
constexpr size_t O_MKP = O_SWVP + (size_t)NL * PB * 128 * 128;
constexpr size_t O_MVP = O_MKP + (size_t)NL * PB * 256 * 1024;
constexpr size_t O_GLAP = O_MVP + (size_t)NL * PB * 256 * 1024;
constexpr size_t O_RWP = O_GLAP + (size_t)NL * PB * 4 * 128 * 256;
constexpr size_t O_RSP = O_RWP + (size_t)NL * PB * 16 * 64 * 64;
constexpr size_t O_SWKS = O_RSP + (size_t)NL * PB * RWC;
constexpr size_t O_SWVS = O_SWKS + (size_t)NL * SB * 128 * 128;
constexpr size_t O_GLAS = O_SWVS + (size_t)NL * SB * 128 * 128;
constexpr size_t O_RWS = O_GLAS + (size_t)NL * SB * 4 * 128 * 256;
constexpr size_t O_RSS = O_RWS + (size_t)NL * SB * 16 * 64 * 64;
constexpr size_t O_END = O_RSS + (size_t)NL * SB * RWC;
static_assert(O_END == 52881408, "output size");

constexpr size_t al256(size_t x) { return (x + 255) & ~(size_t)255; }
constexpr size_t WS_CTL = 0;
constexpr size_t WS_WIN = 65536;
constexpr size_t WS_WMEM = WS_WIN + (size_t)NL * NINP * DM * 2;
constexpr size_t WS_WBR = WS_WMEM + (size_t)NL * DM * DM * 2;
constexpr size_t WS_WOUT = WS_WBR + (size_t)NL * 4 * DM * BW * 2;
constexpr size_t WS_WGU = WS_WOUT + (size_t)NL * DM * DM * 2;
constexpr size_t WS_WDN = WS_WGU + (size_t)NL * 2 * DFF * DM * 2;
constexpr size_t WS_HF = WS_WDN + (size_t)NL * DM * DFF * 2;
constexpr size_t WS_HB = WS_HF + (size_t)MPAD * DM * 4;
constexpr size_t WS_U = WS_HB + (size_t)MPAD * DM * 2;
constexpr size_t WS_BR = WS_U + (size_t)MPAD * NINP * 2;
constexpr size_t WS_MG = WS_BR + (size_t)4 * MPAD * BW * 2;
constexpr size_t WS_MGB = WS_MG + (size_t)MPAD * DM * 4;
constexpr size_t WS_Y = WS_MGB + (size_t)MPAD * DM * 2;
constexpr size_t WS_X1F = WS_Y + (size_t)MPAD * DM * 4;
constexpr size_t WS_X1B = WS_X1F + (size_t)MPAD * DM * 4;
constexpr size_t WS_ACT = WS_X1B + (size_t)MPAD * DM * 2;
constexpr size_t WS_MEMB = WS_ACT + (size_t)MPAD * DFF * 2;
constexpr size_t WS_MKB = WS_MEMB + (size_t)512 * DM * 2;
constexpr size_t WS_MVT = WS_MKB + (size_t)NL * 512 * 1024 * 2;
constexpr size_t WS_SC = WS_MVT + (size_t)NL * 8 * 256 * 256 * 2;
constexpr size_t WS_PB = WS_SC + (size_t)8 * 4096 * 256 * 4;
constexpr size_t WS_RW = WS_PB + (size_t)8 * 4096 * 256 * 2;
constexpr size_t RW_ARR = (size_t)MPAD * BW * 4;
constexpr int GL_NCH = 512 + 128;
constexpr size_t WS_GLQD = WS_RW + 8 * RW_ARR;
constexpr size_t WS_GLKH = WS_GLQD + (size_t)GL_NCH * 8192 * 2;
constexpr size_t WS_GLE = WS_GLKH + (size_t)GL_NCH * 8192 * 2;
constexpr size_t WS_GLVT = WS_GLE + (size_t)GL_NCH * 4096 * 2;
constexpr size_t WS_GLGC = WS_GLVT + (size_t)GL_NCH * 16384 * 2;
constexpr int RB_NCH = PB * 16 * 256 + SB * 16;
constexpr int RB_EL = 9216;
constexpr int RB_QP = 4608, RB_KHP = 5760, RB_VT = 7296, RB_EP = 8832;
constexpr size_t WS_RB = WS_GLGC + (size_t)GL_NCH * 128 * 4;
constexpr size_t WS_RAW = WS_RB + (size_t)RB_NCH * RB_EL * 2;
constexpr size_t WS_LRW = WS_RAW + (size_t)2 * MPAD * BW * 2;
constexpr size_t WS_END = WS_LRW + (size_t)NL * 16 * 64 * 256 * 2;

__device__ __forceinline__ float bf2f(bf16_t b) { return __uint_as_float(((unsigned)b) << 16); }
typedef __bf16 bf16v2_t __attribute__((ext_vector_type(2)));
__device__ __forceinline__ unsigned pk2(float lo, float hi) { const f32x2 v = {lo, hi}; return __builtin_bit_cast(unsigned, __builtin_convertvector(v, bf16v2_t)); }
__device__ __forceinline__ bf16_t f2bf(float f) { return (bf16_t)(pk2(f, 0.f) & 0xffffu); }
__device__ __forceinline__ f32x4 ld4bf(const bf16_t* p) { const u32x2 w = *(const u32x2*)p; return (f32x4){__uint_as_float(w.x << 16), __uint_as_float(w.x & 0xffff0000u), __uint_as_float(w.y << 16), __uint_as_float(w.y & 0xffff0000u)}; }
__device__ __forceinline__ float wave_sum(float v) {
#pragma unroll
    for (int o = 32; o > 0; o >>= 1) v += __shfl_xor(v, o, 64);
    return v;
}
__device__ __forceinline__ float wave_max(float v) {
#pragma unroll
    for (int o = 32; o > 0; o >>= 1) v = fmaxf(v, __shfl_xor(v, o, 64));
    return v;
}
__device__ __forceinline__ float sigmoidf_(float x) { return 1.0f / (1.0f + __expf(-x)); }
__device__ __forceinline__ void unpack8(const u32x4 w, float (&x)[8]) {
    x[0] = __uint_as_float(w.x << 16); x[1] = __uint_as_float(w.x & 0xffff0000u); x[2] = __uint_as_float(w.y << 16); x[3] = __uint_as_float(w.y & 0xffff0000u);
    x[4] = __uint_as_float(w.z << 16); x[5] = __uint_as_float(w.z & 0xffff0000u); x[6] = __uint_as_float(w.w << 16); x[7] = __uint_as_float(w.w & 0xffff0000u);
}
__device__ __forceinline__ float softplusf_(float x) { return fmaxf(x, 0.f) + log1pf(__expf(-fabsf(x))); }
__device__ __forceinline__ float softplus_fast(float x) { return fmaxf(x, 0.f) + __logf(1.0f + __expf(-fabsf(x))); }
__device__ __forceinline__ float tanh_fast(float x) { return 1.0f - 2.0f / (1.0f + __expf(2.0f * x)); }

namespace pg8 {
constexpr int BM = 256, BK = 64, HALF = 128, HTB = HALF * BK * 2, STAGE_BYTES = 8 * HTB, NXCD = 8, WGM = 8;
__host__ __device__ __forceinline__ int lds_byte(int r, int c) { const int st = (r >> 4) * 2 + (c >> 5), rr = r & 15, cc = c & 31, ob = rr * 64 + cc * 2; return st * 1024 + (ob ^ (((ob >> 9) & 1) << 5)); }
__host__ __device__ __forceinline__ void stage_rc(int b, int& R, int& C) { const int st = b / 1024, sb = b % 1024, swz = sb ^ (((sb >> 9) & 1) << 5); R = (st >> 1) * 16 + swz / 64; C = (st & 1) * 32 + (swz % 64) / 2; }
__host__ __device__ __forceinline__ int perm32(int rho) { const int n = rho >> 4, i = rho & 15; return 8 * (i >> 2) + 4 * n + (i & 3); }

struct Unit { int pm, pn, z; };
template <int LDA_, int LDB_, int K_, int NM_, int NN_, int NZ_ = 1, int NZH_ = 1, bool ZINNER_ = false, long ZSAB_ = 0, long ZSAH_ = 0, long ZSBB_ = 0, long ZSBH_ = 0>
struct Gemm {
    static constexpr int LDA = LDA_, LDB = LDB_, K = K_, NM = NM_, NN = NN_, NZ = NZ_, NZH = NZH_; static constexpr bool ZINNER = ZINNER_;
    const bf16_t* A; const bf16_t* B; int G, c;
    __device__ __forceinline__ bool next(int i, Unit& u) const {
        constexpr int nt = NM * NN; int L, z;
        if (ZINNER) { const int it = i / NZ; z = i - it * NZ; const long LL = (long)it * G + c; if (LL >= nt) return false; L = (int)LL; }
        else { const long LL = (long)i * G + c; if (LL >= (long)nt * NZ) return false; z = (int)(LL / nt); L = (int)(LL - (long)z * nt); }
        int wgid = L; { constexpr int q = nt / NXCD, r = nt % NXCD; const int xcd = wgid % NXCD, off = wgid / NXCD; wgid = (xcd < r ? xcd * (q + 1) : r * (q + 1) + (xcd - r) * q) + off; }
        constexpr int nig = WGM * NN; const int gid = wgid / nig, fm = gid * WGM, gsz = (NM - fm) < WGM ? (NM - fm) : WGM;
        u.pm = fm + ((wgid % nig) % gsz); u.pn = (wgid % nig) / gsz; u.z = z; return true;
    }
    __device__ __forceinline__ const char* a_base(const Unit& u) const { const int zb = u.z / NZH, zh = u.z - zb * NZH; return (const char*)(A + zb * ZSAB_ + zh * ZSAH_ + (long)u.pm * BM * LDA); }
    __device__ __forceinline__ const char* b_base(const Unit& u) const { const int zb = u.z / NZH, zh = u.z - zb * NZH; return (const char*)(B + zb * ZSBB_ + zh * ZSBH_ + (long)u.pn * BM * LDB); }
};

template <class GT, class Epi, bool ALIGN_EPI = true, bool SP2 = true>
__device__ __forceinline__ void gemm_phase(LAS unsigned char* lds, const int tid, const GT& g, const Epi& E) {
    const int wid = __builtin_amdgcn_readfirstlane(tid >> 6), lane = tid & 63, wr = wid >> 2, wc = wid & 3, fr = lane & 15, fq = lane >> 4;
    constexpr int nt = GT::K / BK;
    unsigned voffA[2], voffB[2];
#pragma unroll
    for (int i = 0; i < 2; ++i) { int R, C; stage_rc(tid * 16 + i * 8192, R, C); const int Rb = Epi::PERM ? ((R & ~31) + perm32(R & 31)) : R;
        voffA[i] = (unsigned)(R * GT::LDA + C) * 2u; voffB[i] = (unsigned)(Rb * GT::LDB + C) * 2u; }
    constexpr size_t kstep = (size_t)(BK * 2);
    constexpr size_t hstepA = (size_t)HALF * GT::LDA * 2, hstepB = (size_t)HALF * GT::LDB * 2;
    const unsigned ldsw = (unsigned)wid * 1024u;
    const int aoff = lds_byte(wr * 64 + fr, fq * 8), boff = lds_byte(wc * 32 + fr, fq * 8);
#define PG8_SA(b, h) (((b) * 2 + (h)) * HTB)
#define PG8_SB(b, h) ((4 + (b) * 2 + (h)) * HTB)
#define PG8_STAGE(bufoff, gbase, voff) do { _Pragma("unroll") for (int _i = 0; _i < 2; ++_i) \
        __builtin_amdgcn_global_load_lds((const unsigned*)((const char*)(gbase) + (voff)[_i]), (LAS unsigned*)(lds + (bufoff) + ldsw + _i * 8192), 16, 0, 0); } while (0)
#define PG8_LDA(dst, b, h) do { _Pragma("unroll") for (int m = 0; m < 4; ++m) _Pragma("unroll") for (int k = 0; k < 2; ++k) dst[m][k] = *(const LAS bf16x8*)(lds + PG8_SA(b, h) + aoff + m * 2048 + k * 1024); } while (0)
#define PG8_LDB(dst, b, h) do { _Pragma("unroll") for (int n = 0; n < 2; ++n) _Pragma("unroll") for (int k = 0; k < 2; ++k) dst[n][k] = *(const LAS bf16x8*)(lds + PG8_SB(b, h) + boff + n * 2048 + k * 1024); } while (0)
#define PG8_MMA(ai, bj, At, Bt) do { __builtin_amdgcn_s_setprio(1); _Pragma("unroll") for (int m = 0; m < 4; ++m) _Pragma("unroll") for (int n = 0; n < 2; ++n) _Pragma("unroll") for (int k = 0; k < 2; ++k) \
        acc[ai][bj][m][n] = __builtin_amdgcn_mfma_f32_16x16x32_bf16(Bt[n][k], At[m][k], acc[ai][bj][m][n], 0, 0, 0); __builtin_amdgcn_s_setprio(0); } while (0)
#define PG8_WAIT_V(n) asm volatile("s_waitcnt vmcnt(" #n ")" ::: "memory")
#define PG8_WAIT_L(n) asm volatile("s_waitcnt lgkmcnt(" #n ")" ::: "memory")
#define PG8_BAR __builtin_amdgcn_s_barrier()
#define PG8_SCHED __builtin_amdgcn_sched_barrier(0)
    Unit cur, nxt; int ui = 0;
    if (!g.next(0, cur)) return;
    f32x4 acc[2][2][4][2];
#pragma unroll
    for (int a = 0; a < 2; ++a)
#pragma unroll
        for (int b = 0; b < 2; ++b)
#pragma unroll
            for (int m = 0; m < 4; ++m)
#pragma unroll
                for (int n = 0; n < 2; ++n) acc[a][b][m][n] = (f32x4){0.f, 0.f, 0.f, 0.f};
    bf16x8 At[4][2], B0[2][2], B1[2][2];
    const char* cA = g.a_base(cur); const char* cB = g.b_base(cur);
    if constexpr (SP2) {
        PG8_STAGE(PG8_SB(0, 0), cB, voffB); PG8_STAGE(PG8_SB(0, 1), cB + hstepB, voffB); PG8_STAGE(PG8_SA(0, 0), cA, voffA); PG8_STAGE(PG8_SA(0, 1), cA + hstepA, voffA);
        if (wr == 1) PG8_BAR;
        PG8_WAIT_V(2); PG8_BAR;
        PG8_STAGE(PG8_SB(1, 0), cB + kstep, voffB); PG8_STAGE(PG8_SA(1, 0), cA + kstep, voffA); PG8_STAGE(PG8_SB(1, 1), cB + hstepB + kstep, voffB);
        PG8_WAIT_V(6); PG8_BAR;
    } else {
        PG8_STAGE(PG8_SB(0, 0), cB, voffB); PG8_STAGE(PG8_SA(0, 0), cA, voffA); PG8_STAGE(PG8_SB(0, 1), cB + hstepB, voffB); PG8_STAGE(PG8_SA(0, 1), cA + hstepA, voffA);
        if (wr == 1) PG8_BAR;
        PG8_WAIT_V(4); PG8_BAR;
        PG8_STAGE(PG8_SB(1, 0), cB + kstep, voffB); PG8_STAGE(PG8_SA(1, 0), cA + kstep, voffA); PG8_STAGE(PG8_SB(1, 1), cB + hstepB + kstep, voffB);
        PG8_WAIT_V(6); PG8_BAR;
    }
    for (;;) {
        const bool has_next = g.next(ui + 1, nxt);
        const char* nA = has_next ? g.a_base(nxt) : cA; const char* nB = has_next ? g.b_base(nxt) : cB;
#pragma unroll 1
        for (int t = 0; t < nt; t += 2) {
            const bool last = (t == nt - 2);
            const char* a1 = cA + (size_t)(t + 1) * kstep;
            const char* a2 = last ? nA : cA + (size_t)(t + 2) * kstep; const char* b2 = last ? nB : cB + (size_t)(t + 2) * kstep;
            const char* a3 = a2 + kstep; const char* b3 = b2 + kstep;
            if constexpr (SP2) {
            PG8_LDB(B0, 0, 0); PG8_LDB(B1, 0, 1); PG8_SCHED; PG8_LDA(At, 0, 0); PG8_STAGE(PG8_SA(1, 1), a1 + hstepA, voffA);
            PG8_WAIT_V(8); PG8_WAIT_L(0); PG8_BAR; PG8_MMA(0, 0, At, B0); PG8_MMA(0, 1, At, B1); PG8_BAR; PG8_SCHED;
            PG8_LDA(At, 0, 1); PG8_STAGE(PG8_SB(0, 0), b2, voffB); PG8_STAGE(PG8_SB(0, 1), b2 + hstepB, voffB); PG8_STAGE(PG8_SA(0, 0), a2, voffA);
            PG8_WAIT_V(8); PG8_WAIT_L(0); PG8_BAR; PG8_MMA(1, 0, At, B0); PG8_MMA(1, 1, At, B1); PG8_BAR; PG8_SCHED;
            PG8_LDB(B0, 1, 0); PG8_LDB(B1, 1, 1); PG8_SCHED; PG8_LDA(At, 1, 0); PG8_STAGE(PG8_SA(0, 1), a2 + hstepA, voffA);
            PG8_WAIT_V(8); PG8_WAIT_L(0); PG8_BAR; PG8_MMA(0, 0, At, B0); PG8_MMA(0, 1, At, B1); PG8_BAR; PG8_SCHED;
            PG8_LDA(At, 1, 1); PG8_STAGE(PG8_SB(1, 0), b3, voffB); PG8_STAGE(PG8_SB(1, 1), b3 + hstepB, voffB); PG8_STAGE(PG8_SA(1, 0), a3, voffA);
            PG8_WAIT_V(8); PG8_WAIT_L(0); PG8_BAR; PG8_MMA(1, 0, At, B0); PG8_MMA(1, 1, At, B1); PG8_BAR; PG8_SCHED;
            } else {
            PG8_LDB(B0, 0, 0); PG8_SCHED; PG8_LDA(At, 0, 0); PG8_STAGE(PG8_SA(1, 1), a1 + hstepA, voffA);
            PG8_WAIT_L(8); PG8_BAR; PG8_WAIT_L(0); PG8_MMA(0, 0, At, B0); PG8_BAR; PG8_SCHED;
            PG8_LDB(B1, 0, 1); PG8_STAGE(PG8_SB(0, 0), b2, voffB);
            PG8_BAR; PG8_WAIT_L(0); PG8_MMA(0, 1, At, B1); PG8_BAR;
            PG8_LDA(At, 0, 1); PG8_STAGE(PG8_SA(0, 0), a2, voffA);
            PG8_BAR; PG8_WAIT_L(0); PG8_MMA(1, 0, At, B0); PG8_BAR; PG8_SCHED;
            PG8_STAGE(PG8_SB(0, 1), b2 + hstepB, voffB);
            PG8_WAIT_V(6); PG8_BAR; PG8_MMA(1, 1, At, B1); PG8_BAR;
            PG8_LDB(B0, 1, 0); PG8_SCHED; PG8_LDA(At, 1, 0); PG8_STAGE(PG8_SA(0, 1), a2 + hstepA, voffA);
            PG8_WAIT_L(8); PG8_BAR; PG8_WAIT_L(0); PG8_MMA(0, 0, At, B0); PG8_BAR; PG8_SCHED;
            PG8_LDB(B1, 1, 1); PG8_STAGE(PG8_SB(1, 0), b3, voffB);
            PG8_BAR; PG8_WAIT_L(0); PG8_MMA(0, 1, At, B1); PG8_BAR;
            PG8_LDA(At, 1, 1); PG8_STAGE(PG8_SA(1, 0), a3, voffA);
            PG8_BAR; PG8_WAIT_L(0); PG8_MMA(1, 0, At, B0); PG8_BAR; PG8_SCHED;
            PG8_STAGE(PG8_SB(1, 1), b3 + hstepB, voffB);
            PG8_WAIT_V(6); PG8_BAR; PG8_MMA(1, 1, At, B1); PG8_BAR;
            }
        }
        if constexpr (ALIGN_EPI) { if (wr == 0) PG8_BAR; }
        E(acc, cur, wr, wc, fr, fq);
        if (!has_next) break;
#pragma unroll
        for (int a = 0; a < 2; ++a)
#pragma unroll
            for (int b = 0; b < 2; ++b)
#pragma unroll
                for (int m = 0; m < 4; ++m)
#pragma unroll
                    for (int n = 0; n < 2; ++n) acc[a][b][m][n] = (f32x4){0.f, 0.f, 0.f, 0.f};
        cur = nxt; cA = nA; cB = nB; ++ui;
        if constexpr (ALIGN_EPI) { if (wr == 1) PG8_BAR; }
    }
    PG8_WAIT_V(0);
    if constexpr (!ALIGN_EPI) { if (wr == 0) PG8_BAR; }
    PG8_BAR;
#undef PG8_SA
#undef PG8_SB
#undef PG8_STAGE
#undef PG8_LDA
#undef PG8_LDB
#undef PG8_MMA
#undef PG8_WAIT_V
#undef PG8_WAIT_L
#undef PG8_BAR
#undef PG8_SCHED
}

struct EpiBf16 {
    static constexpr bool PERM = true;
    bf16_t* O; long zs; int ldc, pad;
    __device__ __forceinline__ void operator()(const f32x4 (&acc)[2][2][4][2], const Unit& u, int wr, int wc, int fr, int fq) const {
        const int row0 = u.pm * BM + wr * 64 + fr, col0 = u.pn * BM + wc * 32 + 8 * fq; bf16_t* base = O + (long)u.z * zs;
#pragma unroll
        for (int ai = 0; ai < 2; ++ai)
#pragma unroll
            for (int m = 0; m < 4; ++m) { bf16_t* rowp = base + (size_t)(row0 + ai * HALF + m * 16) * ldc + col0;
#pragma unroll
                for (int bj = 0; bj < 2; ++bj) { const f32x4 v0 = acc[ai][bj][m][0], v1 = acc[ai][bj][m][1];
                    u32x4 w; w.x = pk2(v0[0], v0[1]); w.y = pk2(v0[2], v0[3]); w.z = pk2(v1[0], v1[1]); w.w = pk2(v1[2], v1[3]);
                    *(u32x4*)(rowp + bj * HALF) = w; } }
    }
};
struct EpiMem {
    static constexpr bool PERM = false;
    float* outK; float* outV; bf16_t* kb; bf16_t* vt;
    __device__ __forceinline__ void operator()(const f32x4 (&acc)[2][2][4][2], const Unit& u, int wr, int wc, int fr, int fq) const {
        const int row0 = u.pm * BM + wr * 64 + fr, col0 = u.pn * BM + wc * 32 + 4 * fq;
#pragma unroll
        for (int ai = 0; ai < 2; ++ai)
#pragma unroll
            for (int m = 0; m < 4; ++m) { const int row = row0 + ai * HALF + m * 16;
#pragma unroll
                for (int bj = 0; bj < 2; ++bj)
#pragma unroll
                    for (int n = 0; n < 2; ++n) { const int col = col0 + bj * HALF + n * 16; const f32x4 v = acc[ai][bj][m][n];
                        if (col < 1024) { *(f32x4*)(outK + ((size_t)u.z * 512 + row) * 1024 + col) = v;
                            u32x2 w; w.x = pk2(v[0], v[1]); w.y = pk2(v[2], v[3]); *(u32x2*)(kb + ((size_t)u.z * 512 + row) * 1024 + col) = w; }
                        else { const int c = col - 1024; *(f32x4*)(outV + ((size_t)u.z * 512 + row) * 1024 + c) = v;
                            const int b = row >> 8, mm = row & 255, h = c >> 8, d = c & 255; bf16_t* p = vt + ((((size_t)u.z * 2 + b) * 4 + h) * 256 + d) * 256 + mm;
                            p[0] = f2bf(v[0]); p[256] = f2bf(v[1]); p[512] = f2bf(v[2]); p[768] = f2bf(v[3]); } } }
    }
};
struct EpiMerge {
    static constexpr bool PERM = true;
    float* MG; bf16_t* MGB; const bf16_t* U; const float* gate_b;
    __device__ __forceinline__ void operator()(const f32x4 (&acc)[2][2][4][2], const Unit& u, int wr, int wc, int fr, int fq) const {
        const int row0 = u.pm * BM + wr * 64 + fr, col0 = u.pn * BM + wc * 32 + 8 * fq;
#pragma unroll
        for (int bj = 0; bj < 2; ++bj) { const int col = col0 + bj * HALF; const f32x4 gb0 = *(const f32x4*)(gate_b + u.z * DM + col), gb1 = *(const f32x4*)(gate_b + u.z * DM + col + 4);
#pragma unroll
            for (int ai = 0; ai < 2; ++ai)
#pragma unroll
                for (int m = 0; m < 4; ++m) { const int row = row0 + ai * HALF + m * 16; float gp[8], r[8];
                    unpack8(*(const u32x4*)(U + (size_t)row * NINP + U_GP + u.z * DM + col), gp);
#pragma unroll
                    for (int j = 0; j < 4; ++j) { r[j] = sigmoidf_(gp[j] + gb0[j]) * acc[ai][bj][m][0][j]; r[4 + j] = sigmoidf_(gp[4 + j] + gb1[j]) * acc[ai][bj][m][1][j]; }
                    bf16_t* mp = MGB + (size_t)row * DM + col;
                    if (u.z > 0) { float pv[8]; unpack8(*(const u32x4*)mp, pv);
#pragma unroll
                        for (int j = 0; j < 8; ++j) r[j] += pv[j]; }
                    *(u32x4*)mp = (u32x4){pk2(r[0], r[1]), pk2(r[2], r[3]), pk2(r[4], r[5]), pk2(r[6], r[7])}; } }
    }
};
struct EpiRes {
    static constexpr bool PERM = true;
    const bf16_t* R; bf16_t* Y;
    __device__ __forceinline__ void operator()(const f32x4 (&acc)[2][2][4][2], const Unit& u, int wr, int wc, int fr, int fq) const {
        const int row0 = u.pm * BM + wr * 64 + fr, col0 = u.pn * BM + wc * 32 + 8 * fq;
#pragma unroll
        for (int ai = 0; ai < 2; ++ai)
#pragma unroll
            for (int m = 0; m < 4; ++m) { const size_t ro = (size_t)(row0 + ai * HALF + m * 16) * DM + col0;
#pragma unroll
                for (int bj = 0; bj < 2; ++bj) { const size_t o = ro + bj * HALF; float rv[8]; unpack8(*(const u32x4*)(R + o), rv);
                    const f32x4 y0 = (f32x4){rv[0], rv[1], rv[2], rv[3]} * ALPHA + acc[ai][bj][m][0], y1 = (f32x4){rv[4], rv[5], rv[6], rv[7]} * ALPHA + acc[ai][bj][m][1];
                    *(u32x4*)(Y + o) = (u32x4){pk2(y0[0], y0[1]), pk2(y0[2], y0[3]), pk2(y1[0], y1[1]), pk2(y1[2], y1[3])}; } }
    }
};
struct EpiSwiGLU {
    static constexpr bool PERM = true;
    bf16_t* O;
    __device__ __forceinline__ void operator()(const f32x4 (&acc)[2][2][4][2], const Unit& u, int wr, int wc, int fr, int fq) const {
        const int row0 = u.pm * BM + wr * 64 + fr, col0 = u.pn * HALF + wc * 32 + 8 * fq;
#pragma unroll
        for (int ai = 0; ai < 2; ++ai)
#pragma unroll
            for (int m = 0; m < 4; ++m) { bf16_t* rowp = O + (size_t)(row0 + ai * HALF + m * 16) * DFF + col0;
                float r[8];
#pragma unroll
                for (int n = 0; n < 2; ++n)
#pragma unroll
                    for (int j = 0; j < 4; ++j) { const float gg = acc[ai][0][m][n][j], uu = acc[ai][1][m][n][j]; r[n * 4 + j] = gg * sigmoidf_(gg) * uu; }
                u32x4 w; w.x = pk2(r[0], r[1]); w.y = pk2(r[2], r[3]); w.z = pk2(r[4], r[5]); w.w = pk2(r[6], r[7]);
                *(u32x4*)rowp = w; }
    }
};
struct EpiScore {
    static constexpr bool PERM = false;
    float* SC;
    __device__ __forceinline__ void operator()(const f32x4 (&acc)[2][2][4][2], const Unit& u, int wr, int wc, int fr, int fq) const {
        const int row0 = u.pm * BM + wr * 64 + fr, col0 = wc * 32 + 4 * fq; float* base = SC + (size_t)u.z * 4096 * 256;
#pragma unroll
        for (int ai = 0; ai < 2; ++ai)
#pragma unroll
            for (int m = 0; m < 4; ++m) { float* rowp = base + (size_t)(row0 + ai * HALF + m * 16) * 256 + col0;
#pragma unroll
                for (int bj = 0; bj < 2; ++bj)
#pragma unroll
                    for (int n = 0; n < 2; ++n) *(f32x4*)(rowp + bj * HALF + n * 16) = acc[ai][bj][m][n] * 0.0625f; }
    }
};
struct EpiPV {
    static constexpr bool PERM = true;
    bf16_t* O;
    __device__ __forceinline__ void operator()(const f32x4 (&acc)[2][2][4][2], const Unit& u, int wr, int wc, int fr, int fq) const {
        const int b = u.z >> 2, h = u.z & 3; const int row0 = b * PS + u.pm * BM + wr * 64 + fr, col0 = h * 256 + wc * 32 + 8 * fq;
#pragma unroll
        for (int ai = 0; ai < 2; ++ai)
#pragma unroll
            for (int m = 0; m < 4; ++m) { bf16_t* rowp = O + (size_t)(row0 + ai * HALF + m * 16) * BW + col0;
#pragma unroll
                for (int bj = 0; bj < 2; ++bj) { const f32x4 v0 = acc[ai][bj][m][0], v1 = acc[ai][bj][m][1];
                    u32x4 w; w.x = pk2(v0[0], v0[1]); w.y = pk2(v0[2], v0[3]); w.z = pk2(v1[0], v1[1]); w.w = pk2(v1[2], v1[3]);
                    *(u32x4*)(rowp + bj * HALF) = w; } }
    }
};
}


#define XB_TMO      128
#define XB_XCNT(j)  (256  + 64 * (j))
#define XB_XSUB(j)  (1280 + 64 * (j))
#define XB_XGEN(j)  (2304 + 64 * (j))
#define XB_TOP      3328
#define XB_TOPGEN   3392
#define XCD_BAR_WORDS 3456
#define XB_SPIN_CAP (1u << 18)
__device__ __forceinline__ unsigned xb_ld(unsigned* p)              { return __hip_atomic_load(p, __ATOMIC_RELAXED, __HIP_MEMORY_SCOPE_AGENT); }
__device__ __forceinline__ unsigned xb_add(unsigned* p, unsigned v) { return __hip_atomic_fetch_add(p, v, __ATOMIC_RELAXED, __HIP_MEMORY_SCOPE_AGENT); }
__device__ __forceinline__ unsigned xb_xcc_id() { return (unsigned)__builtin_amdgcn_s_getreg((3 << 11) | 20) & 0xFu; }
#define XB_SPIN(cond, bar) do { unsigned _sp = 0; while (cond) { __builtin_amdgcn_s_sleep(1); \
    if ((++_sp & 255u) == 0u) { if (xb_ld(&(bar)[XB_TMO])) break; if (_sp > XB_SPIN_CAP) { atomicAdd(&(bar)[XB_TMO], 1u); break; } } } } while (0)
struct XcdBarrier { unsigned* bar; unsigned x; volatile LAS unsigned* st; };
__device__ __forceinline__ XcdBarrier xcd_barrier_post(unsigned* bar, volatile LAS unsigned* st) {
    XcdBarrier b; b.bar = bar; b.x = xb_xcc_id(); b.st = st;
    if (threadIdx.x == 0) (void)xb_add(&bar[XB_XCNT(b.x)], 1u);
    return b;
}
__device__ __forceinline__ void xcd_barrier_complete(unsigned* bar, unsigned x, unsigned& nloc, unsigned& nx) {
    const unsigned G = gridDim.x * gridDim.y * gridDim.z;
    unsigned sum, cnt, mine, sp = 0u;
    for (;;) {
        sum = 0u; cnt = 0u; mine = 0u;
#pragma unroll
        for (unsigned j = 0; j < 16; ++j) { const unsigned c = xb_ld(&bar[XB_XCNT(j)]); sum += c; cnt += (c > 0u) ? 1u : 0u; mine = (j == x) ? c : mine; }
        if (sum == G) break;
        __builtin_amdgcn_s_sleep(1);
        if ((++sp & 255u) == 0u) { if (xb_ld(&bar[XB_TMO])) break; if (sp > XB_SPIN_CAP) { atomicAdd(&bar[XB_TMO], 1u); break; } }
    }
    nloc = mine > 0u ? mine : 1u; nx = cnt > 0u ? cnt : 1u;
}
__device__ __forceinline__ void xcd_barrier(const XcdBarrier& b) {
    asm volatile("s_waitcnt vmcnt(0)" ::: "memory");
    __syncthreads();
    if (threadIdx.x == 0) {
        unsigned* bar = b.bar;
        __builtin_amdgcn_s_waitcnt(0);
        unsigned nloc = b.st[0], nx = b.st[1];
        if (nloc == 0u) { xcd_barrier_complete(bar, b.x, nloc, nx); b.st[0] = nloc; b.st[1] = nx; }
        const unsigned old = xb_add(&bar[XB_XSUB(b.x)], 1u);
        const unsigned gen = old / nloc;
        if (old + 1u == (gen + 1u) * nloc) {
            __builtin_amdgcn_fence(__ATOMIC_RELEASE, "agent");
            asm volatile("s_waitcnt vmcnt(0)" ::: "memory");
            const unsigned og = xb_add(&bar[XB_TOP], 1u);
            const unsigned tg = og / nx;
            if (og + 1u == (tg + 1u) * nx) xb_add(&bar[XB_TOPGEN], 1u);
            else XB_SPIN(xb_ld(&bar[XB_TOPGEN]) == tg, bar);
            __builtin_amdgcn_fence(__ATOMIC_ACQUIRE, "agent");
            xb_add(&bar[XB_XGEN(b.x)], 1u);
            asm volatile("s_waitcnt vmcnt(0)" ::: "memory");
        } else {
            XB_SPIN(xb_ld(&bar[XB_XGEN(b.x)]) == gen, bar);
            __builtin_amdgcn_fence(__ATOMIC_ACQUIRE, "agent");
            asm volatile("s_waitcnt vmcnt(0)" ::: "memory");
        }
    }
    __syncthreads();
}

struct Ctx { int tid, lane, wave, bid, G; LAS unsigned char* lds; };
__device__ __forceinline__ Ctx fresh(const Ctx& c0) { Ctx c; c.wave = c0.wave; c.bid = c0.bid; c.G = c0.G; c.lds = c0.lds; asm volatile("" : "+s"(c.bid), "+s"(c.G), "+s"(c.wave));
    int lane = (int)__builtin_amdgcn_mbcnt_hi(~0u, __builtin_amdgcn_mbcnt_lo(~0u, 0u)); asm volatile("" : "+v"(lane)); c.lane = lane; c.tid = c.wave * 64 + lane; return c; }

__device__ __forceinline__ int colmap(int mode, int n) {
    if (mode == 1) return n < 3088 ? n : (n < 3328 ? -1 : n - 240);
    if (mode == 2) { const int t = n >> 8, j = n & 255; return j < 128 ? t * 128 + j : DFF + t * 128 + (j - 128); }
    return n;
}
__device__ __forceinline__ void wprep_load(f32x4 (&rg)[8], const float* __restrict__ src, int K, int Nsrc, int Ndst, int mode, size_t sbs, int item, int tid) {
    const int nx = Ndst / 256, ny = K / 64; const int bx = item % nx, by = (item / nx) % ny, bz = item / (nx * ny);
    const int tx = tid & 63, ty = tid >> 6, cm = colmap(mode, bx * 256 + tx * 4); const float* s = src + (size_t)bz * sbs + (size_t)(by * 64 + ty) * Nsrc + cm;
#pragma unroll
    for (int i = 0; i < 8; ++i) rg[i] = cm >= 0 ? *(const f32x4*)(s + (size_t)(8 * i) * Nsrc) : (f32x4){0.f, 0.f, 0.f, 0.f};
}
__device__ __forceinline__ void ph_wprep(const Ctx& c, const float* __restrict__ src, bf16_t* __restrict__ dst, int K, int Nsrc, int Ndst, int mode, int nbatch, size_t sbs, size_t dbs) {
    LAS float* tile = (LAS float*)c.lds;
    const int nx = Ndst / 256, ny = K / 64, total = nx * ny * nbatch;
    const int tid = c.tid, tx = tid & 63, ty = tid >> 6, n = tid >> 1, kh = tid & 1;
    f32x4 rg[8];
    int item = c.bid;
    if (item < total) wprep_load(rg, src, K, Nsrc, Ndst, mode, sbs, item, tid);
    for (; item < total; item += c.G) {
        __syncthreads();
#pragma unroll
        for (int i = 0; i < 8; ++i) *(LAS f32x4*)(tile + (ty + 8 * i) * 260 + tx * 4) = rg[i];
        __syncthreads();
        const int bx = item % nx, by = (item / nx) % ny, bz = item / (nx * ny);
        if (item + c.G < total) wprep_load(rg, src, K, Nsrc, Ndst, mode, sbs, item + c.G, tid);
        bf16_t* d = dst + (size_t)bz * dbs + (size_t)(bx * 256 + n) * K + by * 64 + kh * 32;
#pragma unroll
        for (int g = 0; g < 4; ++g) { unsigned p[4];
#pragma unroll
            for (int e = 0; e < 4; ++e) p[e] = pk2(tile[(kh * 32 + g * 8 + 2 * e) * 260 + n], tile[(kh * 32 + g * 8 + 2 * e + 1) * 260 + n]);
            *(u32x4*)(d + g * 8) = (u32x4){p[0], p[1], p[2], p[3]}; }
    }
    __syncthreads();
}
__device__ __forceinline__ void ph_xprep(const Ctx& c, const float* __restrict__ xp, const float* __restrict__ xs, const float* __restrict__ mem, float* __restrict__ HF, bf16_t* __restrict__ HB, bf16_t* __restrict__ MEMB) {
    const size_t nH = (size_t)MPAD * DM / 4, nM = (size_t)512 * DM / 4;
    for (size_t i4 = (size_t)c.bid * 512 + c.tid; i4 < nH + nM; i4 += (size_t)c.G * 512) {
        if (i4 < nH) {
            const size_t e = i4 * 4; f32x4 v = (f32x4){0.f, 0.f, 0.f, 0.f};
            if (e < (size_t)MP * DM) v = *(const f32x4*)(xp + e); else if (e < (size_t)MT * DM) v = *(const f32x4*)(xs + (e - (size_t)MP * DM));
            if (HF != nullptr) *(f32x4*)(HF + e) = v;
            u32x2 w; w.x = pk2(v[0], v[1]); w.y = pk2(v[2], v[3]); *(u32x2*)(HB + e) = w;
        } else {
            const size_t e = (i4 - nH) * 4; const f32x4 v = *(const f32x4*)(mem + e); u32x2 w; w.x = pk2(v[0], v[1]); w.y = pk2(v[2], v[3]); *(u32x2*)(MEMB + e) = w;
        }
    }
}
__device__ __forceinline__ void ph_ln(const Ctx& c, const bf16_t* __restrict__ Y, const float* __restrict__ g, const float* __restrict__ b, float* __restrict__ XF, bf16_t* __restrict__ XB, float* __restrict__ OUT, int nrows, int nout) {
    const int lane = c.lane;
    for (int row = c.bid * 8 + c.wave; row < nrows; row += c.G * 8) {
        const bf16_t* y = Y + (size_t)row * DM; float v[4][8]; float s = 0.f;
#pragma unroll
        for (int j = 0; j < 4; ++j) { unpack8(*(const u32x4*)(y + j * 512 + lane * 8), v[j]);
#pragma unroll
            for (int e2 = 0; e2 < 8; ++e2) s += v[j][e2]; }
        const float mean = wave_sum(s) * (1.0f / DM); float q = 0.f;
#pragma unroll
        for (int j = 0; j < 4; ++j)
#pragma unroll
            for (int e2 = 0; e2 < 8; ++e2) { const float d = v[j][e2] - mean; q += d * d; }
        const float rstd = rsqrtf(wave_sum(q) * (1.0f / DM) + 1e-5f);
#pragma unroll
        for (int j = 0; j < 4; ++j) { const int cc = j * 512 + lane * 8; const f32x4 g0 = *(const f32x4*)(g + cc), g1 = *(const f32x4*)(g + cc + 4), b0 = *(const f32x4*)(b + cc), b1 = *(const f32x4*)(b + cc + 4);
            const f32x4 o0 = ((f32x4){v[j][0], v[j][1], v[j][2], v[j][3]} - mean) * rstd * g0 + b0, o1 = ((f32x4){v[j][4], v[j][5], v[j][6], v[j][7]} - mean) * rstd * g1 + b1;
            const size_t off = (size_t)row * DM + cc;
            if (XF != nullptr) { *(f32x4*)(XF + off) = o0; *(f32x4*)(XF + off + 4) = o1; }
            *(u32x4*)(XB + off) = (u32x4){pk2(o0[0], o0[1]), pk2(o0[2], o0[3]), pk2(o1[0], o1[1]), pk2(o1[2], o1[3])};
            if (OUT != nullptr && row < nout) { *(f32x4*)(OUT + off) = o0; *(f32x4*)(OUT + off + 4) = o1; } }
    }
}
__device__ __forceinline__ void ph_softmax256(const Ctx& c, const float* __restrict__ SC, bf16_t* __restrict__ P, int nrows) {
    const int lane = c.lane;
    for (int row = c.bid * 8 + c.wave; row < nrows; row += c.G * 8) {
        const f32x4 v = *(const f32x4*)(SC + (size_t)row * 256 + lane * 4);
        const float mx = wave_max(fmaxf(fmaxf(v[0], v[1]), fmaxf(v[2], v[3])));
        f32x4 e; e[0] = __expf(v[0] - mx); e[1] = __expf(v[1] - mx); e[2] = __expf(v[2] - mx); e[3] = __expf(v[3] - mx);
        const float inv = 1.0f / wave_sum((e[0] + e[1]) + (e[2] + e[3]));
        u32x2 w; w.x = pk2(e[0] * inv, e[1] * inv); w.y = pk2(e[2] * inv, e[3] * inv); *(u32x2*)(P + (size_t)row * 256 + lane * 4) = w;
    }
}
__device__ __forceinline__ void ph_copy_outs(const Ctx& c, const bf16_t* __restrict__ U, const float* __restrict__ ck, const float* __restrict__ cv, float* __restrict__ out, int layer) {
    constexpr int nA = PB * 128 * 128, nB = SB * 128 * 128, nC = PB * RWC, nD = SB * RWC;
    for (int i = c.bid * 512 + c.tid; i < nA + nB + nC + nD; i += c.G * 512) {
        if (i < nA) { const int b = i / 16384, j = (i >> 7) & 127, cc = i & 127; const size_t ur = (size_t)(b * PS + PS - 128 + j) * NINP;
            out[O_SWKP + (size_t)layer * nA + i] = bf2f(U[ur + U_SK + cc]); out[O_SWVP + (size_t)layer * nA + i] = bf2f(U[ur + U_SV + cc]); continue; }
        int k = i - nA;
        if (k < nB) { const int sq = k / 16384, j = (k >> 7) & 127, cc = k & 127; float kv, vv;
            if (j < 124) { const size_t o = ((size_t)sq * 128 + j + 4) * 128 + cc; kv = ck[o]; vv = cv[o]; }
            else { const size_t ur = (size_t)(MP + sq * SS + j - 124) * NINP; kv = bf2f(U[ur + U_SK + cc]); vv = bf2f(U[ur + U_SV + cc]); }
            out[O_SWKS + (size_t)layer * nB + k] = kv; out[O_SWVS + (size_t)layer * nB + k] = vv; continue; }
        k -= nB;
        if (k < nC) { const int b = k / RWC, cc = k - b * RWC; out[O_RSP + (size_t)layer * nC + k] = bf2f(U[(size_t)(b * PS + PS - 1) * NINP + U_RU + cc]); continue; }
        k -= nC;
        { const int sq = k / RWC, cc = k - sq * RWC; out[O_RSS + (size_t)layer * nD + k] = bf2f(U[(size_t)(MP + sq * SS + SS - 1) * NINP + U_RU + cc]); }
    }
}

__device__ __forceinline__ void seq_info(int sq, int& row0, int& L) { if (sq < PB) { row0 = sq * PS; L = PS; } else { row0 = MP + (sq - PB) * SS; L = SS; } }

__device__ __forceinline__ void ph_gla_naive(const Ctx& c, const bf16_t* __restrict__ U, const float* __restrict__ s0, const float* __restrict__ a_up, const float* __restrict__ a_b,
                                             const float* __restrict__ ng, const float* __restrict__ nb, bf16_t* __restrict__ OB, float* __restrict__ outP, float* __restrict__ outS) {
    LAS float* qs = (LAS float*)c.lds;
    LAS float* ks = qs + 16 * 128; LAS float* as = ks + 16 * 128; LAS float* os = as + 16 * 128;
    const int kh = c.tid >> 8, vt = c.tid & 255, lane = c.lane;
    for (int u = c.bid; u < (PB + SB) * 4; u += c.G) {
        const int sq = u >> 2, h = u & 3;
        int row0, L; seq_info(sq, row0, L);
        float S[64];
        if (sq >= PB) { const float* p = s0 + (((size_t)(sq - PB) * 4 + h) * 128 + kh * 64) * 256 + vt;
#pragma unroll
            for (int kk = 0; kk < 64; ++kk) S[kk] = p[(size_t)kk * 256]; }
        else {
#pragma unroll
            for (int kk = 0; kk < 64; ++kk) S[kk] = 0.f; }
        for (int t0 = 0; t0 < L; t0 += 16) {
            const int nT = (L - t0) < 16 ? (L - t0) : 16;
            for (int idx = c.tid; idx < nT * 128; idx += 512) {
                const int tt = idx >> 7, kk = idx & 127; const bf16_t* ur = U + (size_t)(row0 + t0 + tt) * NINP;
                qs[idx] = bf2f(ur[U_GQ + h * 128 + kk]) * 0.08838834764831845f; ks[idx] = bf2f(ur[U_GK + h * 128 + kk]);
                float x = a_b[h * 128 + kk];
#pragma unroll
                for (int r = 0; r < 16; ++r) x += bf2f(ur[U_GA + r]) * a_up[r * 512 + h * 128 + kk];
                const float ls = (fminf(x, 0.f) - log1pf(__expf(-fabsf(x)))) * (1.0f / 16.0f);
                as[idx] = __expf(ls);
            }
            __syncthreads();
            for (int tt = 0; tt < nT; ++tt) {
                const float v = bf2f(U[(size_t)(row0 + t0 + tt) * NINP + U_GV + h * 256 + vt]); float o = 0.f; const int lb = tt * 128 + kh * 64;
#pragma unroll
                for (int kk = 0; kk < 64; ++kk) { S[kk] = as[lb + kk] * S[kk] + ks[lb + kk] * v; o += qs[lb + kk] * S[kk]; }
                os[(kh * 16 + tt) * 256 + vt] = o;
            }
            __syncthreads();
            for (int tt = c.wave; tt < nT; tt += 8) {
                float x[4]; float s = 0.f;
#pragma unroll
                for (int j = 0; j < 4; ++j) { x[j] = os[tt * 256 + lane + 64 * j] + os[(16 + tt) * 256 + lane + 64 * j]; s += x[j]; }
                const float mean = wave_sum(s) * (1.0f / 256.0f); float q = 0.f;
#pragma unroll
                for (int j = 0; j < 4; ++j) { const float d = x[j] - mean; q += d * d; }
                const float rstd = rsqrtf(wave_sum(q) * (1.0f / 256.0f) + 1e-5f);
                const size_t row = (size_t)(row0 + t0 + tt);
#pragma unroll
                for (int j = 0; j < 4; ++j) { const int cc = h * 256 + lane + 64 * j; const float n = (x[j] - mean) * rstd * ng[cc] + nb[cc];
                    const float gr = bf2f(U[row * NINP + U_GR + cc]); OB[row * BW + cc] = f2bf(n * gr * sigmoidf_(gr)); }
            }
            __syncthreads();
        }
        float* op = (sq < PB ? outP + (((size_t)sq * 4 + h) * 128 + kh * 64) * 256 : outS + (((size_t)(sq - PB) * 4 + h) * 128 + kh * 64) * 256) + vt;
#pragma unroll
        for (int kk = 0; kk < 64; ++kk) op[(size_t)kk * 256] = S[kk];
    }
}

__device__ __forceinline__ f32x4 mma16(bf16x8 x, bf16x8 y, f32x4 c) { return __builtin_amdgcn_mfma_f32_16x16x32_bf16(x, y, c, 0, 0, 0); }
__device__ __forceinline__ bf16x8 pack_acc(const f32x4& a, const f32x4& b) {
    u32x4 p; p.x = pk2(a[0], a[1]); p.y = pk2(a[2], a[3]); p.z = pk2(b[0], b[1]); p.w = pk2(b[2], b[3]); return __builtin_bit_cast(bf16x8, p);
}
__device__ __forceinline__ void gla_chunk_info(int u, int& row0, int& ntok, int& h) {
    if (u < 512) { const int b = u >> 8; h = (u >> 6) & 3; row0 = b * PS + (u & 63) * 64; ntok = 64; }
    else { const int s = u - 512; h = s & 3; row0 = MP + (s >> 2) * SS; ntok = SS; }
}
__device__ __forceinline__ void ph_gla_pre(const Ctx& c, const bf16_t* __restrict__ U, const float* __restrict__ a_up, const float* __restrict__ a_b,
                                           bf16_t* __restrict__ QD, bf16_t* __restrict__ KHT, bf16_t* __restrict__ EE, bf16_t* __restrict__ VT, float* __restrict__ GC) {
    LAS float* ga_l = (LAS float*)c.lds;
    LAS float* tot = ga_l + 64 * 16;
    LAS bf16_t* Qd_l = (LAS bf16_t*)(tot + 4 * 128);
    LAS bf16_t* Kn_l = Qd_l + 64 * 136;
    LAS bf16_t* v_l = Kn_l + 64 * 136;
    LAS bf16_t* qr_l = v_l + 64 * 264;
    LAS bf16_t* kr_l = qr_l + 64 * 136;
    const int tid = c.tid, lane = c.lane, r = lane & 15, q = lane >> 4, w = c.wave;
    for (int u = (c.bid + c.G / 2) % c.G; u < GL_NCH; u += c.G) {
        int row0, ntok, h; gla_chunk_info(u, row0, ntok, h);
        for (int i = tid; i < 64 * 16; i += 512) { const int t = i >> 4, rr = i & 15; ga_l[i] = t < ntok ? bf2f(U[(size_t)(row0 + t) * NINP + U_GA + rr]) : 0.f; }
        for (int i = tid; i < 64 * 32; i += 512) { const int t = i >> 5, c8 = i & 31; u32x4 vv = (u32x4){0u, 0u, 0u, 0u};
            if (t < ntok) vv = *(const u32x4*)(U + (size_t)(row0 + t) * NINP + U_GV + h * 256 + c8 * 8);
            *(LAS u32x4*)(v_l + t * 264 + c8 * 8) = vv; }
        for (int i = tid; i < 64 * 16; i += 512) { const int t = i >> 4, c8 = i & 15; u32x4 qv = (u32x4){0u, 0u, 0u, 0u}, kv = qv;
            if (t < ntok) { const bf16_t* ur = U + (size_t)(row0 + t) * NINP + h * 128 + c8 * 8; qv = *(const u32x4*)(ur + U_GQ); kv = *(const u32x4*)(ur + U_GK); }
            *(LAS u32x4*)(qr_l + t * 136 + c8 * 8) = qv; *(LAS u32x4*)(kr_l + t * 136 + c8 * 8) = kv; }
        __syncthreads();
        const int kk = tid & 127, tq = tid >> 7;
        float cum[16];
        { float aup[16];
#pragma unroll
          for (int rr = 0; rr < 16; ++rr) aup[rr] = a_up[rr * 512 + h * 128 + kk];
          const float ab = a_b[h * 128 + kk]; float run = 0.f;
#pragma unroll
          for (int j = 0; j < 16; ++j) { const int t = tq * 16 + j; float x = ab;
#pragma unroll
              for (int rr = 0; rr < 16; ++rr) x += ga_l[t * 16 + rr] * aup[rr];
              const float la = t < ntok ? (fminf(x, 0.f) - __logf(1.0f + __expf(-fabsf(x)))) * (1.0f / 16.0f) : 0.f;
              run += la; cum[j] = run; }
          tot[tq * 128 + kk] = run; }
        __syncthreads();
        { float prefix = 0.f, bC = 0.f;
#pragma unroll
          for (int g = 0; g < 4; ++g) { const float tv = tot[g * 128 + kk]; bC += tv; if (g < tq) prefix += tv; }
          unsigned khp[8];
#pragma unroll
          for (int j = 0; j < 16; j += 2) { float kh2[2];
#pragma unroll
              for (int e = 0; e < 2; ++e) { const int t = tq * 16 + j + e; const float b = prefix + cum[j + e]; const float qv = bf2f(qr_l[t * 136 + kk]), kv = bf2f(kr_l[t * 136 + kk]);
                  Qd_l[t * 136 + kk] = f2bf(qv * __expf(b) * 0.08838834764831845f); Kn_l[t * 136 + kk] = f2bf(kv * __expf(-b)); kh2[e] = kv * __expf(bC - b); }
              khp[j >> 1] = pk2(kh2[0], kh2[1]); }
          bf16_t* kp = KHT + (size_t)u * 8192 + kk * 64 + tq * 16;
          *(u32x4*)kp = (u32x4){khp[0], khp[1], khp[2], khp[3]}; *(u32x4*)(kp + 8) = (u32x4){khp[4], khp[5], khp[6], khp[7]};
          if (tq == 0) GC[(size_t)u * 128 + kk] = __expf(bC); }
        __syncthreads();
        { const int tb = w >> 1;
#pragma unroll
          for (int e = 0; e < 2; ++e) { const int ib = (w & 1) * 2 + e; f32x4 d = (f32x4){0.f, 0.f, 0.f, 0.f};
              if (ib <= tb) {
                  bf16x8 kf4[4], qf4[4];
#pragma unroll
                  for (int ks = 0; ks < 4; ++ks) { kf4[ks] = *(const LAS bf16x8*)(Kn_l + (ib * 16 + r) * 136 + ks * 32 + q * 8); qf4[ks] = *(const LAS bf16x8*)(Qd_l + (tb * 16 + r) * 136 + ks * 32 + q * 8); }
                  __builtin_amdgcn_sched_barrier(0);
#pragma unroll
                  for (int ks = 0; ks < 4; ++ks) d = mma16(kf4[ks], qf4[ks], d); }
              const int t = tb * 16 + r, i0 = ib * 16 + q * 4;
#pragma unroll
              for (int jj = 0; jj < 4; ++jj) if (i0 + jj > t) d[jj] = 0.f;
              u32x2 o; o.x = pk2(d[0], d[1]); o.y = pk2(d[2], d[3]); *(u32x2*)(EE + (size_t)u * 4096 + t * 64 + i0) = o; } }
        for (int i = tid; i < 64 * 16; i += 512) { const int t = i >> 4, c8 = i & 15; *(u32x4*)(QD + (size_t)u * 8192 + t * 128 + c8 * 8) = *(const LAS u32x4*)(Qd_l + t * 136 + c8 * 8); }
        { const int val = tid & 255, th = tid >> 8;
#pragma unroll
          for (int tg = 0; tg < 4; ++tg) { const int t0 = th * 32 + tg * 8; unsigned p4[4];
#pragma unroll
              for (int e = 0; e < 4; ++e) p4[e] = (unsigned)v_l[(t0 + 2 * e) * 264 + val] | ((unsigned)v_l[(t0 + 2 * e + 1) * 264 + val] << 16);
              *(u32x4*)(VT + (size_t)u * 16384 + val * 64 + t0) = (u32x4){p4[0], p4[1], p4[2], p4[3]}; } }
        __syncthreads();
    }
}
struct GlaStage { u32x4 qd[2], kh[2], e, vt, gc; };
__device__ __forceinline__ void gla_stage_load(GlaStage& s, const bf16_t* __restrict__ QD, const bf16_t* __restrict__ KHT, const bf16_t* __restrict__ EE, const bf16_t* __restrict__ VT, const float* __restrict__ GC,
                                               int ch, int sl, int tid) {
    const bf16_t* qp = QD + (size_t)ch * 8192 + tid * 8; s.qd[0] = *(const u32x4*)qp; s.qd[1] = *(const u32x4*)(qp + 4096);
    const bf16_t* kp = KHT + (size_t)ch * 8192 + tid * 8; s.kh[0] = *(const u32x4*)kp; s.kh[1] = *(const u32x4*)(kp + 4096);
    s.e = *(const u32x4*)(EE + (size_t)ch * 4096 + tid * 8);
    s.vt = *(const u32x4*)(VT + (size_t)ch * 16384 + sl * 4096 + tid * 8);
    if (tid < 32) s.gc = *(const u32x4*)(GC + (size_t)ch * 128 + tid * 4);
}
constexpr int GS_KH = 8704, GS_E = 17920, GS_VT = 22528, GS_GC = 27136, GS_EL = 27392;
__device__ __forceinline__ void gla_stage_store(const GlaStage& s, LAS bf16_t* b, int tid) {
    *(LAS u32x4*)(b + (tid >> 4) * 136 + (tid & 15) * 8) = s.qd[0]; *(LAS u32x4*)(b + (32 + (tid >> 4)) * 136 + (tid & 15) * 8) = s.qd[1];
    *(LAS u32x4*)(b + GS_KH + (tid >> 3) * 72 + (tid & 7) * 8) = s.kh[0]; *(LAS u32x4*)(b + GS_KH + (64 + (tid >> 3)) * 72 + (tid & 7) * 8) = s.kh[1];
    *(LAS u32x4*)(b + GS_E + (tid >> 3) * 72 + (tid & 7) * 8) = s.e; *(LAS u32x4*)(b + GS_VT + (tid >> 3) * 72 + (tid & 7) * 8) = s.vt;
    if (tid < 32) *(LAS u32x4*)(b + GS_GC + tid * 8) = s.gc;
}
__device__ __forceinline__ void ph_gla_seq(const Ctx& c, int boff, const bf16_t* __restrict__ QD, const bf16_t* __restrict__ KHT, const bf16_t* __restrict__ EE, const bf16_t* __restrict__ VT, const float* __restrict__ GC,
                                           const float* __restrict__ s0, float* __restrict__ outP, float* __restrict__ outS, bf16_t* __restrict__ OB) {
    LAS bf16_t* stg = (LAS bf16_t*)c.lds;
    LAS bf16_t* T_l = stg + 2 * GS_EL;
    const int tid = c.tid, lane = c.lane, r = lane & 15, q = lane >> 4, w = c.wave;
    const int side = c.bid < 32 ? c.bid : c.bid - 64, nside = c.G - 64;
    for (int u = (c.bid >= boff && c.bid < boff + 32) ? c.bid - boff : ((c.bid < 32 || c.bid >= 96) ? 32 + side : 32 + 512); u < 32 + 512; u = u < 32 ? 32 + 512 : u + nside) {
        int h, sl, nch, ch0, row0, ntok; const float* sp = nullptr; float* op;
        if (u < 32) { const int b = u >> 4; h = (u >> 2) & 3; sl = u & 3; nch = 64; ch0 = (b * 4 + h) * 64; row0 = b * PS; ntok = 64; op = outP + (size_t)(b * 4 + h) * 32768; }
        else { const int s = u - 32, sq = s >> 4; h = (s >> 2) & 3; sl = s & 3; nch = 1; ch0 = 512 + sq * 4 + h; row0 = MP + sq * SS; ntok = SS; sp = s0 + (size_t)(sq * 4 + h) * 32768; op = outS + (size_t)(sq * 4 + h) * 32768; }
        f32x4 acc[4];
#pragma unroll
        for (int vb = 0; vb < 4; ++vb)
#pragma unroll
            for (int jj = 0; jj < 4; ++jj) acc[vb][jj] = sp ? sp[(size_t)(w * 16 + q * 4 + jj) * 256 + sl * 64 + vb * 16 + r] : 0.f;
        GlaStage R0, R1, R2;
        gla_stage_load(R0, QD, KHT, EE, VT, GC, ch0, sl, tid);
        if (1 < nch) gla_stage_load(R1, QD, KHT, EE, VT, GC, ch0 + 1, sl, tid);
        if (2 < nch) gla_stage_load(R2, QD, KHT, EE, VT, GC, ch0 + 2, sl, tid);
        __syncthreads();
        gla_stage_store(R0, stg, tid);
        if (3 < nch) gla_stage_load(R0, QD, KHT, EE, VT, GC, ch0 + 3, sl, tid);
#define GLA_STEP(ci, RN) do { \
            LAS bf16_t* Tb = T_l + ((ci) & 1) * 64 * 136; const LAS bf16_t* sb = stg + ((ci) & 1) * GS_EL; \
            _Pragma("unroll") for (int vb = 0; vb < 4; ++vb) { u32x2 o; o.x = pk2(acc[vb][0], acc[vb][1]); o.y = pk2(acc[vb][2], acc[vb][3]); *(LAS u32x2*)(Tb + (vb * 16 + r) * 136 + w * 16 + q * 4) = o; } \
            __syncthreads(); \
            if ((ci) + 1 < nch) { gla_stage_store(RN, stg + (((ci) + 1) & 1) * GS_EL, tid); if ((ci) + 4 < nch) gla_stage_load(RN, QD, KHT, EE, VT, GC, ch0 + (ci) + 4, sl, tid); } \
            { const int rb = w >> 1, t = rb * 16 + r; bf16x8 qf[4], ef[2]; \
              _Pragma("unroll") for (int ks = 0; ks < 4; ++ks) qf[ks] = *(const LAS bf16x8*)(sb + (rb * 16 + r) * 136 + ks * 32 + q * 8); \
              _Pragma("unroll") for (int ks = 0; ks < 2; ++ks) ef[ks] = *(const LAS bf16x8*)(sb + GS_E + (rb * 16 + r) * 72 + ks * 32 + q * 8); \
              bf16x8 tf[2][4], vf[2][2]; \
              _Pragma("unroll") for (int e2 = 0; e2 < 2; ++e2) { const int cb = (w & 1) * 2 + e2; \
                  _Pragma("unroll") for (int ks = 0; ks < 4; ++ks) tf[e2][ks] = *(const LAS bf16x8*)(Tb + (cb * 16 + r) * 136 + ks * 32 + q * 8); \
                  _Pragma("unroll") for (int ks = 0; ks < 2; ++ks) vf[e2][ks] = *(const LAS bf16x8*)(sb + GS_VT + (cb * 16 + r) * 72 + ks * 32 + q * 8); } \
              __builtin_amdgcn_sched_barrier(0); \
              _Pragma("unroll") for (int e2 = 0; e2 < 2; ++e2) { const int cb = (w & 1) * 2 + e2; f32x4 y = (f32x4){0.f, 0.f, 0.f, 0.f}; \
                  _Pragma("unroll") for (int ks = 0; ks < 4; ++ks) y = mma16(tf[e2][ks], qf[ks], y); \
                  _Pragma("unroll") for (int ks = 0; ks < 2; ++ks) y = mma16(vf[e2][ks], ef[ks], y); \
                  if (t < ntok) { u32x2 o; o.x = pk2(y[0], y[1]); o.y = pk2(y[2], y[3]); *(u32x2*)(OB + (size_t)(row0 + (ci) * 64 + t) * BW + h * 256 + sl * 64 + cb * 16 + q * 4) = o; } } } \
            { const f32x4 gcv = *(const LAS f32x4*)((const LAS float*)(sb + GS_GC) + w * 16 + q * 4); bf16x8 kf[2]; \
              _Pragma("unroll") for (int ks = 0; ks < 2; ++ks) kf[ks] = *(const LAS bf16x8*)(sb + GS_KH + (w * 16 + r) * 72 + ks * 32 + q * 8); \
              bf16x8 vs[4][2]; \
              _Pragma("unroll") for (int vb = 0; vb < 4; ++vb) _Pragma("unroll") for (int ks = 0; ks < 2; ++ks) vs[vb][ks] = *(const LAS bf16x8*)(sb + GS_VT + (vb * 16 + r) * 72 + ks * 32 + q * 8); \
              __builtin_amdgcn_sched_barrier(0); \
              _Pragma("unroll") for (int vb = 0; vb < 4; ++vb) { acc[vb] = acc[vb] * gcv; \
                  _Pragma("unroll") for (int ks = 0; ks < 2; ++ks) acc[vb] = mma16(kf[ks], vs[vb][ks], acc[vb]); } } \
        } while (0)
#pragma unroll 1
        for (int ci = 0; ci < nch; ci += 3) {
            GLA_STEP(ci, R1);
            if (ci + 1 < nch) GLA_STEP(ci + 1, R2);
            if (ci + 2 < nch) GLA_STEP(ci + 2, R0);
        }
#undef GLA_STEP
#pragma unroll
        for (int vb = 0; vb < 4; ++vb)
#pragma unroll
            for (int jj = 0; jj < 4; ++jj) op[(size_t)(w * 16 + q * 4 + jj) * 256 + sl * 64 + vb * 16 + r] = acc[vb][jj];
        __syncthreads();
    }
}
__device__ __forceinline__ void ph_gla_fin(const Ctx& c, const bf16_t* __restrict__ U, const float* __restrict__ ng, const float* __restrict__ nb, const bf16_t* __restrict__ RAW, bf16_t* __restrict__ OB) {
    const int lane = c.lane, hs = lane >> 5, l32 = lane & 31;
    for (int i = c.bid * 8 + c.wave; i < MT * 2; i += c.G * 8) {
        const int row = i >> 1, h = (i & 1) * 2 + hs, cc = h * 256 + l32 * 8; bf16_t* p = OB + (size_t)row * BW + cc;
        float x[8], gr[8]; unpack8(*(const u32x4*)(RAW + (size_t)row * BW + cc), x); unpack8(*(const u32x4*)(U + (size_t)row * NINP + U_GR + cc), gr);
        float s = 0.f;
#pragma unroll
        for (int j = 0; j < 8; ++j) s += x[j];
#pragma unroll
        for (int o = 16; o > 0; o >>= 1) s += __shfl_xor(s, o, 64);
        const float mean = s * (1.0f / 256.0f); float qq = 0.f;
#pragma unroll
        for (int j = 0; j < 8; ++j) { const float d = x[j] - mean; qq += d * d; }
#pragma unroll
        for (int o = 16; o > 0; o >>= 1) qq += __shfl_xor(qq, o, 64);
        const float rstd = rsqrtf(qq * (1.0f / 256.0f) + 1e-5f);
        const f32x4 g0 = *(const f32x4*)(ng + cc), g1 = *(const f32x4*)(ng + cc + 4), b0 = *(const f32x4*)(nb + cc), b1 = *(const f32x4*)(nb + cc + 4); float o8[8];
#pragma unroll
        for (int j = 0; j < 8; ++j) o8[j] = ((x[j] - mean) * rstd * (j < 4 ? g0[j] : g1[j - 4]) + (j < 4 ? b0[j] : b1[j - 4])) * gr[j] * sigmoidf_(gr[j]);
        *(u32x4*)p = (u32x4){pk2(o8[0], o8[1]), pk2(o8[2], o8[3]), pk2(o8[4], o8[5]), pk2(o8[6], o8[7])};
    }
}

template <bool ISBF> __device__ __forceinline__ void swa_step(const float (&q)[32], float (&acc)[32], float& m, float& l, const void* kp, const void* vp, float slope, float dist) {
    float s = 0.f;
#pragma unroll
    for (int j = 0; j < 4; ++j) { float x[8];
        if (ISBF) unpack8(*(const u32x4*)((const bf16_t*)kp + j * 8), x);
        else { const f32x4 a = *(const f32x4*)((const float*)kp + j * 8), b = *(const f32x4*)((const float*)kp + j * 8 + 4); x[0] = a[0]; x[1] = a[1]; x[2] = a[2]; x[3] = a[3]; x[4] = b[0]; x[5] = b[1]; x[6] = b[2]; x[7] = b[3]; }
#pragma unroll
        for (int d = 0; d < 8; ++d) s += q[j * 8 + d] * x[d]; }
    s += __shfl_xor(s, 1, 64);
    s = s * 0.125f - slope * dist;
    const float mn = fmaxf(m, s), cc = __expf(m - mn), p = __expf(s - mn);
    l = l * cc + p;
#pragma unroll
    for (int j = 0; j < 4; ++j) { float x[8];
        if (ISBF) unpack8(*(const u32x4*)((const bf16_t*)vp + j * 8), x);
        else { const f32x4 a = *(const f32x4*)((const float*)vp + j * 8), b = *(const f32x4*)((const float*)vp + j * 8 + 4); x[0] = a[0]; x[1] = a[1]; x[2] = a[2]; x[3] = a[3]; x[4] = b[0]; x[5] = b[1]; x[6] = b[2]; x[7] = b[3]; }
#pragma unroll
        for (int d = 0; d < 8; ++d) acc[j * 8 + d] = acc[j * 8 + d] * cc + p * x[d]; }
    m = mn;
}
__device__ __forceinline__ void ph_swa_naive(const Ctx& c, const bf16_t* __restrict__ U, const float* __restrict__ ck, const float* __restrict__ cv, const float* __restrict__ sinks, bf16_t* __restrict__ OB) {
    for (int gid = c.bid * 512 + c.tid; gid < MS * 32; gid += c.G * 512) {
        const int dh = gid & 1, h = (gid >> 1) & 15, row = MP + (gid >> 5), kvh = h >> 3, co = kvh * 64 + dh * 32;
        float q[32], acc[32];
#pragma unroll
        for (int j = 0; j < 4; ++j) { float x[8]; unpack8(*(const u32x4*)(U + (size_t)row * NINP + U_SQ + h * 64 + dh * 32 + j * 8), x);
#pragma unroll
            for (int d = 0; d < 8; ++d) { q[j * 8 + d] = x[d]; acc[j * 8 + d] = 0.f; } }
        const float slope = exp2f(-0.5f * (float)(h + 1)); float m = sinks[h], l = 1.0f;
        if (row < MP) {
            const int t = row % PS, base = row - t, lo = t - 128 < 0 ? 0 : t - 128;
            for (int s = lo; s <= t; ++s) { const bf16_t* ur = U + (size_t)(base + s) * NINP;
                swa_step<true>(q, acc, m, l, ur + U_SK + co, ur + U_SV + co, slope, (float)(t - s)); }
        } else {
            const int sq = (row - MP) / SS, i = (row - MP) % SS;
            for (int idx = i; idx <= 128 + i; ++idx) {
                if (idx < 128) { const size_t o = ((size_t)sq * 128 + idx) * 128 + co; swa_step<false>(q, acc, m, l, ck + o, cv + o, slope, (float)(128 + i - idx)); }
                else { const bf16_t* ur = U + (size_t)(MP + sq * SS + idx - 128) * NINP; swa_step<true>(q, acc, m, l, ur + U_SK + co, ur + U_SV + co, slope, (float)(128 + i - idx)); }
            }
        }
        const float inv = 1.0f / l; bf16_t* op = OB + (size_t)row * BW + h * 64 + dh * 32;
#pragma unroll
        for (int j = 0; j < 4; ++j) { u32x4 w; w.x = pk2(acc[j * 8] * inv, acc[j * 8 + 1] * inv); w.y = pk2(acc[j * 8 + 2] * inv, acc[j * 8 + 3] * inv);
            w.z = pk2(acc[j * 8 + 4] * inv, acc[j * 8 + 5] * inv); w.w = pk2(acc[j * 8 + 6] * inv, acc[j * 8 + 7] * inv); *(u32x4*)(op + j * 8) = w; }
    }
}

__device__ __forceinline__ void ph_rwkv_prep(const Ctx& c, const bf16_t* __restrict__ U, const float* __restrict__ shift, const float* __restrict__ mu, const float* __restrict__ w0, const float* __restrict__ w2,
                                             const float* __restrict__ a0, const float* __restrict__ a2, const float* __restrict__ g2, const float* __restrict__ k_k, const float* __restrict__ k_a,
                                             const float* __restrict__ r_k, float* __restrict__ RW) {
    LAS float* xm = (LAS float*)c.lds; LAS float* tw = xm + RWC; LAS float* ad = tw + 64; LAS float* sg = ad + 64;
    const int tid = c.tid;
    float* R = RW; float* WD = RW + (size_t)MPAD * BW; float* K2 = WD + (size_t)MPAD * BW; float* V = K2 + (size_t)MPAD * BW; float* KK = V + (size_t)MPAD * BW;
    float* BV = KK + (size_t)MPAD * BW; float* G = BV + (size_t)MPAD * BW; float* BON = G + (size_t)MPAD * BW;
    for (int row = c.bid; row < MT; row += c.G) {
        const bf16_t* ur = U + (size_t)row * NINP + U_RU; const bf16_t* pr = ur - NINP; const float* ps = nullptr; bool first;
        if (row < MP) first = (row % PS) == 0; else { first = ((row - MP) % SS) == 0; ps = shift + (size_t)((row - MP) / SS) * RWC; }
        for (int cc = tid; cc < RWC; cc += 512) { const float x = bf2f(ur[cc]); const float s = first ? (ps ? ps[cc] : 0.f) : bf2f(pr[cc]); xm[cc] = x + (s - x) * mu[cc]; }
        __syncthreads();
        if (tid < 64) { tw[tid] = tanhf(xm[3072 + tid]); ad[tid] = xm[3136 + tid]; }
        if (tid >= 128 && tid < 256) sg[tid - 128] = sigmoidf_(xm[3200 + tid - 128]);
        __syncthreads();
        for (int qd = 0; qd < 2; ++qd) {
            const int cc = qd * 512 + tid; float accw = w0[cc], acca = a0[cc], accg = 0.f;
#pragma unroll 4
            for (int j = 0; j < 64; ++j) { accw += tw[j] * w2[j * BW + cc]; acca += ad[j] * a2[j * BW + cc]; }
#pragma unroll 4
            for (int j = 0; j < 128; ++j) accg += sg[j] * g2[j * BW + cc];
            const float lw = -softplusf_(-accw) - 0.5f, decay = __expf(-__expf(lw)), a = sigmoidf_(acca);
            const float r = xm[cc], k = xm[1024 + cc], v = xm[2048 + cc];
            const float kkr = k * k_k[cc]; const float ss = wave_sum(kkr * kkr); const float kk = kkr / fmaxf(sqrtf(ss), 1e-12f);
            const float k2 = k * (1.0f + (a - 1.0f) * k_a[cc]); const float rk = wave_sum(r * k2 * r_k[cc]);
            const size_t o = (size_t)row * BW + cc;
            R[o] = r; WD[o] = decay; K2[o] = k2; V[o] = v; KK[o] = kk; BV[o] = kk * a; G[o] = accg; BON[o] = rk * v;
        }
        __syncthreads();
    }
}
__device__ __forceinline__ int kperm_pos(int k) { return (k & ~31) + 8 * ((k >> 2) & 3) + 4 * ((k >> 4) & 1) + (k & 3); }
__device__ __forceinline__ void ph_swa_prompt(const Ctx& c, const bf16_t* __restrict__ U, const float* __restrict__ sinks, bf16_t* __restrict__ OB) {
    LAS bf16_t* K_l = (LAS bf16_t*)c.lds;
    LAS bf16_t* VT_l = K_l + 192 * 72;
    const int tid = c.tid, lane = c.lane, r = lane & 15, q = lane >> 4, w = c.wave;
    for (int u = c.bid; u < PB * 64 * 2; u += c.G) {
        const int b = u >> 7, qb = (u >> 1) & 63, kvh = u & 1, h = kvh * 8 + w;
        const int tok0 = qb * 64 - 128;
        const size_t seq0 = (size_t)b * PS;
        for (int idx = tid; idx < 192 * 8; idx += 512) { const int kl = idx >> 3, c8 = idx & 7, tk = tok0 + kl; u32x4 kv = (u32x4){0u, 0u, 0u, 0u}, vv = kv;
            if (tk >= 0) { const bf16_t* ur = U + (seq0 + tk) * NINP; kv = *(const u32x4*)(ur + U_SK + kvh * 64 + c8 * 8); vv = *(const u32x4*)(ur + U_SV + kvh * 64 + c8 * 8); }
            *(LAS u32x4*)(K_l + kl * 72 + c8 * 8) = kv;
            const int kp = kperm_pos(kl); LAS bf16_t* vp = VT_l + (c8 * 8) * 200 + kp;
            vp[0] = (bf16_t)(vv.x & 0xffffu); vp[200] = (bf16_t)(vv.x >> 16); vp[400] = (bf16_t)(vv.y & 0xffffu); vp[600] = (bf16_t)(vv.y >> 16);
            vp[800] = (bf16_t)(vv.z & 0xffffu); vp[1000] = (bf16_t)(vv.z >> 16); vp[1200] = (bf16_t)(vv.w & 0xffffu); vp[1400] = (bf16_t)(vv.w >> 16); }
        __syncthreads();
        const float slope = exp2f(-0.5f * (float)(h + 1)), sink = sinks[h];
#pragma unroll 1
        for (int i = 0; i < 4; ++i) {
            const size_t qrow = seq0 + qb * 64 + i * 16 + r;
            const bf16x8 qf0 = *(const bf16x8*)(U + qrow * NINP + U_SQ + h * 64 + q * 8), qf1 = *(const bf16x8*)(U + qrow * NINP + U_SQ + h * 64 + 32 + q * 8);
            const int kt0 = i & ~1;
            f32x4 s[10]; float mx = sink; bf16x8 kfr[5][2];
#pragma unroll
            for (int kt = 0; kt < 10; ++kt) { f32x4 d;
                if (kt % 5 == 0) {
#pragma unroll
                    for (int k5 = 0; k5 < 5; ++k5) { const LAS bf16_t* kp = K_l + ((kt0 + kt + k5) * 16 + r) * 72 + q * 8; kfr[k5][0] = *(const LAS bf16x8*)kp; kfr[k5][1] = *(const LAS bf16x8*)(kp + 32); }
                    __builtin_amdgcn_sched_barrier(0); }
                d = mma16(kfr[kt % 5][0], qf0, (f32x4){0.f, 0.f, 0.f, 0.f}); d = mma16(kfr[kt % 5][1], qf1, d);
#pragma unroll
                for (int jj = 0; jj < 4; ++jj) { const int kl = (kt0 + kt) * 16 + q * 4 + jj, dist = i * 16 + r + 128 - kl;
                    const float v = (dist >= 0 && dist <= 128 && tok0 + kl >= 0) ? d[jj] * 0.125f - slope * (float)dist : -1e30f; d[jj] = v; mx = fmaxf(mx, v); }
                s[kt] = d; }
            mx = fmaxf(mx, __shfl_xor(mx, 16, 64)); mx = fmaxf(mx, __shfl_xor(mx, 32, 64));
            float sum = 0.f; bf16x8 pf[5];
#pragma unroll
            for (int kp = 0; kp < 5; ++kp) { f32x4 a = s[2 * kp], bq = s[2 * kp + 1];
#pragma unroll
                for (int jj = 0; jj < 4; ++jj) { a[jj] = __expf(a[jj] - mx); bq[jj] = __expf(bq[jj] - mx); sum += a[jj] + bq[jj]; }
                pf[kp] = pack_acc(a, bq); }
            sum += __shfl_xor(sum, 16, 64); sum += __shfl_xor(sum, 32, 64);
            const float inv = 1.0f / (sum + __expf(sink - mx));
            bf16_t* op = OB + qrow * BW + h * 64 + q * 4;
#pragma unroll
            for (int dt = 0; dt < 4; ++dt) { f32x4 o = (f32x4){0.f, 0.f, 0.f, 0.f}; bf16x8 vfr[5];
#pragma unroll
                for (int kp = 0; kp < 5; ++kp) vfr[kp] = *(const LAS bf16x8*)(VT_l + (dt * 16 + r) * 200 + (kt0 + 2 * kp) * 16 + q * 8);
                __builtin_amdgcn_sched_barrier(0);
#pragma unroll
                for (int kp = 0; kp < 5; ++kp) o = mma16(vfr[kp], pf[kp], o);
                u32x2 ov; ov.x = pk2(o[0] * inv, o[1] * inv); ov.y = pk2(o[2] * inv, o[3] * inv); *(u32x2*)(op + dt * 16) = ov; }
        }
        __syncthreads();
    }
}

__device__ __forceinline__ void ph_swa_sample(const Ctx& c, const bf16_t* __restrict__ U, const float* __restrict__ ck, const float* __restrict__ cv, const float* __restrict__ sinks, bf16_t* __restrict__ OB) {
    LAS bf16_t* K_l = (LAS bf16_t*)c.lds;
    LAS bf16_t* VT_l = K_l + 160 * 72;
    const int tid = c.tid, lane = c.lane, r = lane & 15, q = lane >> 4, w = c.wave;
    for (int u = c.bid; u < SB * 2; u += c.G) {
        const int sq = u >> 1, kvh = u & 1;
        for (int idx = tid; idx < 160 * 8; idx += 512) { const int kl = idx >> 3, c8 = idx & 7; float kx[8], vx[8];
#pragma unroll
            for (int e = 0; e < 8; ++e) { kx[e] = 0.f; vx[e] = 0.f; }
            if (kl < 128) { const size_t o = ((size_t)sq * 128 + kl) * 128 + kvh * 64 + c8 * 8; const f32x4 a = *(const f32x4*)(ck + o), b2 = *(const f32x4*)(ck + o + 4), c2 = *(const f32x4*)(cv + o), d2 = *(const f32x4*)(cv + o + 4);
                kx[0] = a[0]; kx[1] = a[1]; kx[2] = a[2]; kx[3] = a[3]; kx[4] = b2[0]; kx[5] = b2[1]; kx[6] = b2[2]; kx[7] = b2[3];
                vx[0] = c2[0]; vx[1] = c2[1]; vx[2] = c2[2]; vx[3] = c2[3]; vx[4] = d2[0]; vx[5] = d2[1]; vx[6] = d2[2]; vx[7] = d2[3]; }
            else if (kl < 132) { const bf16_t* ur = U + (size_t)(MP + sq * SS + kl - 128) * NINP; unpack8(*(const u32x4*)(ur + U_SK + kvh * 64 + c8 * 8), kx); unpack8(*(const u32x4*)(ur + U_SV + kvh * 64 + c8 * 8), vx); }
            *(LAS u32x4*)(K_l + kl * 72 + c8 * 8) = (u32x4){pk2(kx[0], kx[1]), pk2(kx[2], kx[3]), pk2(kx[4], kx[5]), pk2(kx[6], kx[7])};
            LAS bf16_t* vp = VT_l + (c8 * 8) * 168 + kperm_pos(kl);
#pragma unroll
            for (int e = 0; e < 8; ++e) vp[e * 168] = f2bf(vx[e]); }
        __syncthreads();
        if (w < 2) {
            const int h = kvh * 8 + w * 4 + (r >> 2), tk = r & 3; const size_t qrow = (size_t)(MP + sq * SS + tk);
            const float slope = exp2f(-0.5f * (float)(h + 1)), sink = sinks[h];
            const bf16x8 qf0 = *(const bf16x8*)(U + qrow * NINP + U_SQ + h * 64 + q * 8), qf1 = *(const bf16x8*)(U + qrow * NINP + U_SQ + h * 64 + 32 + q * 8);
            f32x4 s[10]; float mx = sink;
#pragma unroll
            for (int kt = 0; kt < 10; ++kt) { const LAS bf16_t* kp = K_l + (kt * 16 + r) * 72 + q * 8;
                f32x4 d = mma16(*(const LAS bf16x8*)kp, qf0, (f32x4){0.f, 0.f, 0.f, 0.f}); d = mma16(*(const LAS bf16x8*)(kp + 32), qf1, d);
#pragma unroll
                for (int jj = 0; jj < 4; ++jj) { const int kl = kt * 16 + q * 4 + jj, dist = 128 + tk - kl;
                    const float v = (dist >= 0 && dist <= 128) ? d[jj] * 0.125f - slope * (float)dist : -1e30f; d[jj] = v; mx = fmaxf(mx, v); }
                s[kt] = d; }
            mx = fmaxf(mx, __shfl_xor(mx, 16, 64)); mx = fmaxf(mx, __shfl_xor(mx, 32, 64));
            float sum = 0.f; bf16x8 pf[5];
#pragma unroll
            for (int kp = 0; kp < 5; ++kp) { f32x4 a = s[2 * kp], bq = s[2 * kp + 1];
#pragma unroll
                for (int jj = 0; jj < 4; ++jj) { a[jj] = __expf(a[jj] - mx); bq[jj] = __expf(bq[jj] - mx); sum += a[jj] + bq[jj]; }
                pf[kp] = pack_acc(a, bq); }
            sum += __shfl_xor(sum, 16, 64); sum += __shfl_xor(sum, 32, 64);
            const float inv = 1.0f / (sum + __expf(sink - mx));
            bf16_t* op = OB + qrow * BW + h * 64 + q * 4;
#pragma unroll
            for (int dt = 0; dt < 4; ++dt) { f32x4 o = (f32x4){0.f, 0.f, 0.f, 0.f};
#pragma unroll
                for (int kp = 0; kp < 5; ++kp) o = mma16(*(const LAS bf16x8*)(VT_l + (dt * 16 + r) * 168 + kp * 32 + q * 8), pf[kp], o);
                u32x2 ov; ov.x = pk2(o[0] * inv, o[1] * inv); ov.y = pk2(o[2] * inv, o[3] * inv); *(u32x2*)(op + dt * 16) = ov; }
        }
        __syncthreads();
    }
}

__device__ __forceinline__ void ph_memattn_prompt(const Ctx& c, const bf16_t* __restrict__ U, const bf16_t* __restrict__ MKB, const bf16_t* __restrict__ MVT, bf16_t* __restrict__ OB) {
    LAS bf16_t* buf = (LAS bf16_t*)c.lds;
    const int tid = c.tid, lane = c.lane, r = lane & 15, q = lane >> 4, w = c.wave;
    for (int u = c.bid; u < PB * 4 * 32; u += c.G) {
        const int b = u >> 7, h = (u >> 5) & 3, qb = u & 31;
        const size_t qrow = (size_t)b * PS + qb * 128 + w * 16 + r;
        const bf16_t* kg = MKB + (size_t)(b * 256) * 1024 + h * 256;
        const bf16_t* vg = MVT + (size_t)(b * 4 + h) * 65536;
        const bf16_t* qg = U + qrow * NINP + U_MQ + h * 256 + q * 8;
        bf16x8 qn0 = *(const bf16x8*)qg, qn1 = *(const bf16x8*)(qg + 32);
        u32x4 st[4];
#pragma unroll
        for (int i = 0; i < 4; ++i) { const int p = tid + 512 * i; st[i] = *(const u32x4*)(kg + (size_t)(p >> 3) * 1024 + (p & 7) * 8); }
        f32x4 s[16];
#pragma unroll
        for (int mt = 0; mt < 16; ++mt) s[mt] = (f32x4){0.f, 0.f, 0.f, 0.f};
        __syncthreads();
#pragma unroll 1
        for (int ck = 0; ck < 4; ++ck) {
            LAS bf16_t* kb = buf + (ck & 1) * 18432;
#pragma unroll
            for (int i = 0; i < 4; ++i) { const int p = tid + 512 * i; *(LAS u32x4*)(kb + (p >> 3) * 72 + (p & 7) * 8) = st[i]; }
            __syncthreads();
            const bf16x8 qc0 = qn0, qc1 = qn1;
            if (ck < 3) { qn0 = *(const bf16x8*)(qg + (ck + 1) * 64); qn1 = *(const bf16x8*)(qg + (ck + 1) * 64 + 32);
#pragma unroll
                for (int i = 0; i < 4; ++i) { const int p = tid + 512 * i; st[i] = *(const u32x4*)(kg + (size_t)(p >> 3) * 1024 + (ck + 1) * 64 + (p & 7) * 8); } }
#pragma unroll
            for (int m2 = 0; m2 < 16; m2 += 2) { bf16x8 kf[2][2];
#pragma unroll
                for (int j = 0; j < 2; ++j) { kf[j][0] = *(const LAS bf16x8*)(kb + ((m2 + j) * 16 + r) * 72 + q * 8); kf[j][1] = *(const LAS bf16x8*)(kb + ((m2 + j) * 16 + r) * 72 + 32 + q * 8); }
                __builtin_amdgcn_sched_barrier(0);
#pragma unroll
                for (int j = 0; j < 2; ++j) { s[m2 + j] = mma16(kf[j][0], qc0, s[m2 + j]); s[m2 + j] = mma16(kf[j][1], qc1, s[m2 + j]); } }
        }
#pragma unroll
        for (int i = 0; i < 4; ++i) { const int p = tid + 512 * i; st[i] = *(const u32x4*)(vg + (size_t)(p >> 5) * 256 + (p & 31) * 8); }
        float mx = -3.0e38f;
#pragma unroll
        for (int mt = 0; mt < 16; ++mt)
#pragma unroll
            for (int jj = 0; jj < 4; ++jj) { s[mt][jj] *= 0.0625f; mx = fmaxf(mx, s[mt][jj]); }
        mx = fmaxf(mx, __shfl_xor(mx, 16, 64)); mx = fmaxf(mx, __shfl_xor(mx, 32, 64));
        float sum = 0.f; bf16x8 pf[8];
#pragma unroll
        for (int kp = 0; kp < 8; ++kp) { f32x4 a = s[2 * kp], b2 = s[2 * kp + 1];
#pragma unroll
            for (int jj = 0; jj < 4; ++jj) { a[jj] = __expf(a[jj] - mx); b2[jj] = __expf(b2[jj] - mx); sum += a[jj] + b2[jj]; }
            pf[kp] = pack_acc(a, b2); }
        sum += __shfl_xor(sum, 16, 64); sum += __shfl_xor(sum, 32, 64);
        const float inv = 1.0f / sum;
        bf16_t* op = OB + qrow * BW + h * 256 + q * 4;
#pragma unroll 1
        for (int cv = 0; cv < 4; ++cv) {
            LAS bf16_t* vb = buf + (cv & 1) * 18432;
#pragma unroll
            for (int i = 0; i < 4; ++i) { const int p = tid + 512 * i, m0 = (p & 31) * 8; LAS bf16_t* d0 = vb + (p >> 5) * 264;
                *(LAS u32x2*)(d0 + kperm_pos(m0)) = (u32x2){st[i].x, st[i].y}; *(LAS u32x2*)(d0 + kperm_pos(m0 + 4)) = (u32x2){st[i].z, st[i].w}; }
            __syncthreads();
            if (cv < 3) {
#pragma unroll
                for (int i = 0; i < 4; ++i) { const int p = tid + 512 * i; st[i] = *(const u32x4*)(vg + (size_t)((cv + 1) * 64 + (p >> 5)) * 256 + (p & 31) * 8); } }
#pragma unroll
            for (int dt = 0; dt < 4; ++dt) { bf16x8 vf[8];
#pragma unroll
                for (int kp = 0; kp < 8; ++kp) vf[kp] = *(const LAS bf16x8*)(vb + (dt * 16 + r) * 264 + kp * 32 + q * 8);
                __builtin_amdgcn_sched_barrier(0);
                f32x4 o = (f32x4){0.f, 0.f, 0.f, 0.f};
#pragma unroll
                for (int kp = 0; kp < 8; ++kp) o = mma16(vf[kp], pf[kp], o);
                u32x2 ov; ov.x = pk2(o[0] * inv, o[1] * inv); ov.y = pk2(o[2] * inv, o[3] * inv); *(u32x2*)(op + (cv * 4 + dt) * 16) = ov; }
        }
        __syncthreads();
    }
}

__device__ __forceinline__ void ph_lrw(const Ctx& c, const float* __restrict__ w2, const float* __restrict__ a2, const float* __restrict__ g2, bf16_t* __restrict__ LRW) {
    for (int idx = c.bid * 512 + c.tid; idx < NL * 256 * 1024; idx += c.G * 512) {
        const int ch = idx & 1023, j = (idx >> 10) & 255, l = idx >> 18;
        const float v = j < 64 ? w2[((size_t)l * 64 + j) * BW + ch] : (j < 128 ? a2[((size_t)l * 64 + j - 64) * BW + ch] : g2[((size_t)l * 128 + j - 128) * BW + ch]);
        LRW[((size_t)l * 1024 + ch) * 256 + j] = f2bf(v);
    }
}
constexpr int RWP_UNITS = (MP / 64) * 4 + SB * 4;
__device__ __forceinline__ void rwp_unit_info(int u, int& row0, int& ntok, int& hg, int& sq, bool& seq_first) {
    if (u < (MP / 64) * 4) { const int blk = u >> 2; hg = u & 3; row0 = blk * 64; ntok = 64; sq = -1; seq_first = (row0 % PS) == 0; }
    else { const int s = u - (MP / 64) * 4; sq = s >> 2; hg = s & 3; row0 = MP + sq * SS; ntok = SS; seq_first = true; }
}
__device__ __forceinline__ void ph_rwkv_pre(const Ctx& c, const bf16_t* __restrict__ U, const float* __restrict__ shift, const float* __restrict__ mu, const float* __restrict__ w0, const float* __restrict__ w2,
                                            const float* __restrict__ a0, const float* __restrict__ a2, const float* __restrict__ g2, const float* __restrict__ k_k, const float* __restrict__ k_a,
                                            const float* __restrict__ r_k, float* __restrict__ RW, bf16_t* __restrict__ RB, const bf16_t* __restrict__ LRW) {
    LAS bf16_t* P_l = (LAS bf16_t*)c.lds; LAS bf16_t* Kn_l = P_l + 4608; LAS bf16_t* Bn_l = Kn_l + 4608; LAS bf16_t* Q_l = Bn_l + 4608;
    LAS bf16_t* PT_l = Q_l + 4608; LAS bf16_t* BhT_l = PT_l + 4608; LAS bf16_t* KhT_l = BhT_l + 4608; LAS bf16_t* VT_l = KhT_l + 4608;
    LAS float* A_l = (LAS float*)(c.lds + 73728);
    LAS bf16_t* BmT_l = (LAS bf16_t*)(c.lds + 78848); LAS bf16_t* F_l = (LAS bf16_t*)(c.lds + 81920); LAS bf16_t* Tinv_l = (LAS bf16_t*)(c.lds + 84992);
    LAS bf16_t* PpT_l = (LAS bf16_t*)(c.lds + 88064);
    LAS bf16_t* BmpT_l = (LAS bf16_t*)(c.lds + 97280);
    LAS float* GC_l = (LAS float*)(c.lds + 100352);
    LAS float* lg_l = (LAS float*)(c.lds + 125952);
    LAS bf16_t* act_l = (LAS bf16_t*)c.lds;
    LAS bf16_t* wT_l = act_l + 64 * 264;
    LAS bf16_t* aT_l = wT_l + 64 * 72;
    LAS bf16_t* gT_l = aT_l + 64 * 72;
    LAS float* pre_l = (LAS float*)(c.lds + 73728);
    const int tid = c.tid, lane = c.lane, r = lane & 15, q = lane >> 4, w = c.wave;
    bf16_t* Gg = (bf16_t*)(RW + 6 * (size_t)MPAD * BW); bf16_t* BON = (bf16_t*)(RW + 7 * (size_t)MPAD * BW);
    for (int u = c.bid; u < RWP_UNITS; u += c.G) {
        int row0, ntok, hg, sq; bool seq_first; rwp_unit_info(u, row0, ntok, hg, sq, seq_first);
        const float* sh = sq >= 0 ? shift + (size_t)sq * RWC : nullptr;
        const int nstage = ntok == 64 ? 64 : 16;
        for (int idx = tid; idx < nstage * 32; idx += 512) {
            const int t = idx >> 5, c8 = idx & 31, cc = 3072 + c8 * 8; float val[8];
#pragma unroll
            for (int e2 = 0; e2 < 8; ++e2) val[e2] = 0.f;
            if (t < ntok) { const bf16_t* ur = U + (size_t)(row0 + t) * NINP + U_RU; float x[8], p[8];
                unpack8(*(const u32x4*)(ur + cc), x);
                if (!(t == 0 && seq_first)) unpack8(*(const u32x4*)(ur + cc - NINP), p);
                else if (sh) { const f32x4 s0v = *(const f32x4*)(sh + cc), s1v = *(const f32x4*)(sh + cc + 4); p[0] = s0v[0]; p[1] = s0v[1]; p[2] = s0v[2]; p[3] = s0v[3]; p[4] = s1v[0]; p[5] = s1v[1]; p[6] = s1v[2]; p[7] = s1v[3]; }
                else {
#pragma unroll
                    for (int e2 = 0; e2 < 8; ++e2) p[e2] = 0.f; }
                const f32x4 m0 = *(const f32x4*)(mu + cc), m1 = *(const f32x4*)(mu + cc + 4);
#pragma unroll
                for (int e2 = 0; e2 < 8; ++e2) { const float xm = x[e2] + (p[e2] - x[e2]) * (e2 < 4 ? m0[e2] : m1[e2 - 4]); val[e2] = c8 < 8 ? tanh_fast(xm) : (c8 < 16 ? xm : sigmoidf_(xm)); } }
            *(LAS u32x4*)(act_l + t * 264 + c8 * 8) = (u32x4){pk2(val[0], val[1]), pk2(val[2], val[3]), pk2(val[4], val[5]), pk2(val[6], val[7])};
        }
        __syncthreads();
        bf16x8 af[8];
        { const int tb = w & 3;
#pragma unroll
          for (int ks = 0; ks < 8; ++ks) af[ks] = *(const LAS bf16x8*)(act_l + (tb * 16 + r) * 264 + ks * 32 + q * 8); }
        __syncthreads();
#pragma unroll 1
        for (int hh = 0; hh < 4; ++hh) { const int h = hg * 4 + hh;
        { const int tb = w & 3, chf = w >> 2;
          if (tb * 16 < nstage) {
#pragma unroll
            for (int e2 = 0; e2 < 2; ++e2) { const int cb = chf * 2 + e2; f32x4 dw = (f32x4){0.f, 0.f, 0.f, 0.f}, da = dw, dg = dw;
                const bf16_t* wr = LRW + ((size_t)h * 64 + cb * 16 + r) * 256 + q * 8; bf16x8 wf[8];
#pragma unroll
                for (int ks = 0; ks < 8; ++ks) wf[ks] = *(const bf16x8*)(wr + ks * 32);
                __builtin_amdgcn_sched_barrier(0);
#pragma unroll
                for (int ks = 0; ks < 2; ++ks) { dw = mma16(wf[ks], af[ks], dw); da = mma16(wf[2 + ks], af[2 + ks], da); }
#pragma unroll
                for (int ks = 0; ks < 4; ++ks) dg = mma16(wf[4 + ks], af[4 + ks], dg);
                const int o = (tb * 16 + r) * 68 + cb * 16 + q * 4;
                *(LAS f32x4*)(pre_l + o) = dw; *(LAS f32x4*)(pre_l + 64 * 68 + o) = da; *(LAS f32x4*)(pre_l + 2 * 64 * 68 + o) = dg; } } }
        __syncthreads();
        const int t = tid >> 3, cg = tid & 7, c0 = h * 64 + cg * 8, sc = t >> 4;
        float rr[8], k2[8], kap[8], bet[8], nlw[8];
        { float vx[8], gg[8], kkr[8]; float ss = 0.f, rk = 0.f;
          if (t < ntok) {
            const size_t row = (size_t)(row0 + t); const bf16_t* ur = U + row * NINP + U_RU; const bool fst = (t == 0 && seq_first);
            float kx[8];
#pragma unroll
            for (int part = 0; part < 3; ++part) { const int cc = part * 1024 + c0; float x[8], p[8];
                unpack8(*(const u32x4*)(ur + cc), x);
                if (!fst) unpack8(*(const u32x4*)(ur + cc - NINP), p);
                else {
#pragma unroll
                    for (int j = 0; j < 8; ++j) p[j] = sh ? sh[cc + j] : 0.f; }
                const f32x4 mA = *(const f32x4*)(mu + cc), mB = *(const f32x4*)(mu + cc + 4);
#pragma unroll
                for (int j = 0; j < 8; ++j) { const float xm = x[j] + (p[j] - x[j]) * (j < 4 ? mA[j] : mB[j - 4]); if (part == 0) rr[j] = xm; else if (part == 1) kx[j] = xm; else vx[j] = xm; } }
            float pw[8], pa[8], pkk[8], pka[8], prk[8];
#pragma unroll
            for (int hf = 0; hf < 2; ++hf) { const f32x4 v0 = *(const f32x4*)(w0 + c0 + hf * 4), v1 = *(const f32x4*)(a0 + c0 + hf * 4), v2 = *(const f32x4*)(k_k + c0 + hf * 4), v3 = *(const f32x4*)(k_a + c0 + hf * 4), v4 = *(const f32x4*)(r_k + c0 + hf * 4);
#pragma unroll
                for (int j = 0; j < 4; ++j) { pw[hf * 4 + j] = v0[j]; pa[hf * 4 + j] = v1[j]; pkk[hf * 4 + j] = v2[j]; pka[hf * 4 + j] = v3[j]; prk[hf * 4 + j] = v4[j]; } }
            float lwp[8], app[8];
#pragma unroll
            for (int hf = 0; hf < 2; ++hf) { const f32x4 v0 = *(const LAS f32x4*)(pre_l + t * 68 + cg * 8 + hf * 4), v1 = *(const LAS f32x4*)(pre_l + 64 * 68 + t * 68 + cg * 8 + hf * 4), v2 = *(const LAS f32x4*)(pre_l + 2 * 64 * 68 + t * 68 + cg * 8 + hf * 4);
#pragma unroll
                for (int j = 0; j < 4; ++j) { lwp[hf * 4 + j] = v0[j]; app[hf * 4 + j] = v1[j]; gg[hf * 4 + j] = v2[j]; } }
#pragma unroll
            for (int j = 0; j < 8; ++j) {
                const float lw = -softplus_fast(-(pw[j] + lwp[j])) - 0.5f; nlw[j] = -__expf(lw); const float av = sigmoidf_(pa[j] + app[j]);
                kkr[j] = kx[j] * pkk[j]; ss += kkr[j] * kkr[j]; k2[j] = kx[j] * (1.0f + (av - 1.0f) * pka[j]); rk += rr[j] * k2[j] * prk[j]; bet[j] = av; }
          } else {
#pragma unroll
            for (int j = 0; j < 8; ++j) { rr[j] = 0.f; k2[j] = 0.f; kkr[j] = 0.f; bet[j] = 0.f; nlw[j] = 0.f; vx[j] = 0.f; gg[j] = 0.f; }
          }
          ss += __shfl_xor(ss, 1, 64); ss += __shfl_xor(ss, 2, 64); ss += __shfl_xor(ss, 4, 64);
          rk += __shfl_xor(rk, 1, 64); rk += __shfl_xor(rk, 2, 64); rk += __shfl_xor(rk, 4, 64);
          const float inv = 1.0f / fmaxf(sqrtf(ss), 1e-12f);
#pragma unroll
          for (int j = 0; j < 8; ++j) { kap[j] = kkr[j] * inv; bet[j] = kap[j] * bet[j]; }
          if (t < ntok) { const size_t o = (size_t)(row0 + t) * BW + c0;
              *(u32x4*)(Gg + o) = (u32x4){pk2(gg[0], gg[1]), pk2(gg[2], gg[3]), pk2(gg[4], gg[5]), pk2(gg[6], gg[7])};
              *(u32x4*)(BON + o) = (u32x4){pk2(rk * vx[0], rk * vx[1]), pk2(rk * vx[2], rk * vx[3]), pk2(rk * vx[4], rk * vx[5]), pk2(rk * vx[6], rk * vx[7])}; }
          *(LAS f32x4*)(lg_l + t * 68 + cg * 8) = (f32x4){nlw[0], nlw[1], nlw[2], nlw[3]}; *(LAS f32x4*)(lg_l + t * 68 + cg * 8 + 4) = (f32x4){nlw[4], nlw[5], nlw[6], nlw[7]};
#pragma unroll
          for (int j = 0; j < 8; ++j) VT_l[(cg * 8 + j) * 72 + t] = f2bf(vx[j]);
        }
        __syncthreads();
        if (tid < 256) { const int cc = tid & 63, s4 = tid >> 6; float run = 0.f;
#pragma unroll
            for (int i = 0; i < 16; ++i) { const int o = (s4 * 16 + i) * 68 + cc; run += lg_l[o]; lg_l[o] = run; } }
        __syncthreads();
        { unsigned pp[4], pq[4], pk[4], pb[4];
#pragma unroll
          for (int j = 0; j < 8; j += 2) { float vP[2], vQ[2], vK[2], vB[2];
#pragma unroll
              for (int e = 0; e < 2; ++e) { const int jj = j + e, cc = cg * 8 + jj; const float ci = lg_l[t * 68 + cc], cC = lg_l[(sc * 16 + 15) * 68 + cc];
                  const float ei = __expf(-ci), eh = __expf(cC - ci);
                  vP[e] = kap[jj] * __expf(ci - nlw[jj]); vQ[e] = rr[jj] * __expf(ci); vK[e] = k2[jj] * ei; vB[e] = bet[jj] * ei;
                  PT_l[cc * 72 + t] = f2bf(vP[e]); BhT_l[cc * 72 + t] = f2bf(bet[jj] * eh); KhT_l[cc * 72 + t] = f2bf(k2[jj] * eh); }
              pp[j >> 1] = pk2(vP[0], vP[1]); pq[j >> 1] = pk2(vQ[0], vQ[1]); pk[j >> 1] = pk2(vK[0], vK[1]); pb[j >> 1] = pk2(vB[0], vB[1]); }
          const int o = t * 72 + cg * 8;
          *(LAS u32x4*)(P_l + o) = (u32x4){pp[0], pp[1], pp[2], pp[3]}; *(LAS u32x4*)(Q_l + o) = (u32x4){pq[0], pq[1], pq[2], pq[3]};
          *(LAS u32x4*)(Kn_l + o) = (u32x4){pk[0], pk[1], pk[2], pk[3]}; *(LAS u32x4*)(Bn_l + o) = (u32x4){pb[0], pb[1], pb[2], pb[3]};
          if ((t & 15) == 15) {
#pragma unroll
              for (int j = 0; j < 8; ++j) GC_l[sc * 64 + cg * 8 + j] = __expf(lg_l[t * 68 + cg * 8 + j]); } }
        __syncthreads();
        const int nsub = ntok == 64 ? 4 : 1;
        const bf16x8 zfrag = (bf16x8){0, 0, 0, 0, 0, 0, 0, 0};
        for (int id = w; id < nsub * 3; id += 8) { const int s4 = id / 3, prod = id - s4 * 3; f32x4 d = (f32x4){0.f, 0.f, 0.f, 0.f};
            const LAS bf16_t* X = (prod == 1 ? P_l : Bn_l) + (s4 * 16 + r) * 72 + q * 8; const LAS bf16_t* Y = (prod == 0 ? P_l : (prod == 1 ? Kn_l : Q_l)) + (s4 * 16 + r) * 72 + q * 8;
            { const bf16x8 x0 = *(const LAS bf16x8*)X, x1 = *(const LAS bf16x8*)(X + 32), y0 = *(const LAS bf16x8*)Y, y1 = *(const LAS bf16x8*)(Y + 32);
              __builtin_amdgcn_sched_barrier(0); d = mma16(x0, y0, d); d = mma16(x1, y1, d); }
            if (prod == 0) { f32x4 o4;
#pragma unroll
                for (int jj = 0; jj < 4; ++jj) o4[jj] = (q * 4 + jj < r) ? d[jj] : 0.f;
                *(LAS f32x4*)(A_l + s4 * 320 + r * 20 + q * 4) = o4; }
            else { float o4[4];
#pragma unroll
                for (int jj = 0; jj < 4; ++jj) o4[jj] = (prod == 1 ? (r < q * 4 + jj) : (q * 4 + jj <= r)) ? d[jj] : 0.f;
                u32x2 o; o.x = pk2(o4[0], o4[1]); o.y = pk2(o4[2], o4[3]); *(LAS u32x2*)((prod == 1 ? BmT_l : F_l) + s4 * 384 + r * 24 + q * 4) = o; } }
        __syncthreads();
        if (w == 0 && (lane >> 4) < nsub) { const int s4 = lane >> 4, jc = lane & 15; float x[16];
#pragma unroll
            for (int tt = 0; tt < 16; ++tt) { float s = (tt == jc) ? 1.f : 0.f;
#pragma unroll
                for (int i = 0; i < tt; ++i) s -= A_l[s4 * 320 + tt * 20 + i] * x[i];
                x[tt] = s; }
#pragma unroll
            for (int tt = 0; tt < 16; ++tt) Tinv_l[s4 * 384 + tt * 24 + jc] = f2bf(x[tt]); }
        __syncthreads();
        for (int id = w; id < nsub * 5; id += 8) { const int s4 = id / 5, rem = id - s4 * 5;
            const bf16x8 xf = q < 2 ? *(const LAS bf16x8*)(Tinv_l + s4 * 384 + r * 24 + q * 8) : zfrag;
            const bf16x8 yf = q < 2 ? (rem < 4 ? *(const LAS bf16x8*)(PT_l + (rem * 16 + r) * 72 + s4 * 16 + q * 8) : *(const LAS bf16x8*)(BmT_l + s4 * 384 + r * 24 + q * 8)) : zfrag;
            const f32x4 d = mma16(xf, yf, (f32x4){0.f, 0.f, 0.f, 0.f});
            u32x2 o; o.x = pk2(d[0], d[1]); o.y = pk2(d[2], d[3]);
            if (rem < 4) *(LAS u32x2*)(PpT_l + (rem * 16 + r) * 72 + s4 * 16 + q * 4) = o; else *(LAS u32x2*)(BmpT_l + s4 * 384 + r * 24 + q * 4) = o; }
        __syncthreads();
        { const int chunk0 = sq >= 0 ? PB * 16 * 256 + sq * 16 + h : ((row0 / PS) * 16 + h) * 256 + ((row0 % PS) >> 4);
          for (int id = w; id < nsub * 25; id += 8) { const int s4 = id / 25, rem = id - s4 * 25; bf16_t* blob = RB + (size_t)(chunk0 + s4) * RB_EL;
            const bf16x8 fF = q < 2 ? *(const LAS bf16x8*)(F_l + s4 * 384 + r * 24 + q * 8) : zfrag;
            if (rem < 4) {
                const bf16x8 xf = q < 2 ? *(const LAS bf16x8*)(PpT_l + (rem * 16 + r) * 72 + s4 * 16 + q * 8) : zfrag;
                const f32x4 d = mma16(xf, fF, (f32x4){0.f, 0.f, 0.f, 0.f});
                const u32x2 qv = *(const LAS u32x2*)(Q_l + (s4 * 16 + r) * 72 + rem * 16 + q * 4);
                u32x2 o; o.x = pk2(__uint_as_float(qv.x << 16) - d[0], __uint_as_float(qv.x & 0xffff0000u) - d[1]); o.y = pk2(__uint_as_float(qv.y << 16) - d[2], __uint_as_float(qv.y & 0xffff0000u) - d[3]);
                *(u32x2*)(blob + RB_QP + r * 72 + 32 * (rem >> 1) + 8 * q + 4 * (rem & 1)) = o;
            } else if (rem == 4) {
                f32x4 d2 = (f32x4){0.f, 0.f, 0.f, 0.f};
#pragma unroll
                for (int ks = 0; ks < 2; ++ks) d2 = mma16(*(const LAS bf16x8*)(Kn_l + (s4 * 16 + r) * 72 + ks * 32 + q * 8), *(const LAS bf16x8*)(Q_l + (s4 * 16 + r) * 72 + ks * 32 + q * 8), d2);
                const bf16x8 xf = q < 2 ? *(const LAS bf16x8*)(BmpT_l + s4 * 384 + r * 24 + q * 8) : zfrag;
                const f32x4 d1 = mma16(xf, fF, (f32x4){0.f, 0.f, 0.f, 0.f});
                float o4[4];
#pragma unroll
                for (int jj = 0; jj < 4; ++jj) o4[jj] = ((q * 4 + jj <= r) ? d2[jj] : 0.f) - d1[jj];
                u32x2 o; o.x = pk2(o4[0], o4[1]); o.y = pk2(o4[2], o4[3]); *(u32x2*)(blob + RB_EP + r * 24 + q * 4) = o;
            } else if (rem < 21) {
                const int cib = (rem - 5) >> 2, cob = (rem - 5) & 3;
                const bf16x8 xf = q < 2 ? *(const LAS bf16x8*)(PpT_l + (cib * 16 + r) * 72 + s4 * 16 + q * 8) : zfrag;
                const bf16x8 yf = q < 2 ? *(const LAS bf16x8*)(BhT_l + (cob * 16 + r) * 72 + s4 * 16 + q * 8) : zfrag;
                const f32x4 d = mma16(xf, yf, (f32x4){0.f, 0.f, 0.f, 0.f});
                const float gc = GC_l[s4 * 64 + cob * 16 + r]; float o4[4];
#pragma unroll
                for (int jj = 0; jj < 4; ++jj) o4[jj] = ((cib == cob && q * 4 + jj == r) ? gc : 0.f) - d[jj];
                u32x2 o; o.x = pk2(o4[0], o4[1]); o.y = pk2(o4[2], o4[3]); *(u32x2*)(blob + (cob * 16 + r) * 72 + 32 * (cib >> 1) + 8 * q + 4 * (cib & 1)) = o;
            } else {
                const int cb = rem - 21;
                const bf16x8 xf = q < 2 ? *(const LAS bf16x8*)(BmpT_l + s4 * 384 + r * 24 + q * 8) : zfrag;
                const bf16x8 yf = q < 2 ? *(const LAS bf16x8*)(BhT_l + (cb * 16 + r) * 72 + s4 * 16 + q * 8) : zfrag;
                const f32x4 d = mma16(xf, yf, (f32x4){0.f, 0.f, 0.f, 0.f});
                const u32x2 kv = *(const LAS u32x2*)(KhT_l + (cb * 16 + r) * 72 + s4 * 16 + q * 4);
                u32x2 o; o.x = pk2(__uint_as_float(kv.x << 16) - d[0], __uint_as_float(kv.x & 0xffff0000u) - d[1]); o.y = pk2(__uint_as_float(kv.y << 16) - d[2], __uint_as_float(kv.y & 0xffff0000u) - d[3]);
                *(u32x2*)(blob + RB_KHP + (cb * 16 + r) * 24 + q * 4) = o;
            } }
          for (int idx = tid; idx < nsub * 128; idx += 512) { const int s4 = idx >> 7, cc = (idx >> 1) & 63, hf = idx & 1;
              *(u32x4*)(RB + (size_t)(chunk0 + s4) * RB_EL + RB_VT + cc * 24 + hf * 8) = *(const LAS u32x4*)(VT_l + cc * 72 + s4 * 16 + hf * 8); } }
        __syncthreads();
        }
    }
}

__device__ __forceinline__ void ph_rwkv_scan_naive(const Ctx& c, const float* __restrict__ RW, const float* __restrict__ s0, const float* __restrict__ lng, const float* __restrict__ lnb, bf16_t* __restrict__ OB,
                                                   float* __restrict__ outP, float* __restrict__ outS) {
    const float* R = RW; const float* WD = RW + (size_t)MPAD * BW; const float* K2 = WD + (size_t)MPAD * BW; const float* V = K2 + (size_t)MPAD * BW; const float* KK = V + (size_t)MPAD * BW;
    const float* BV = KK + (size_t)MPAD * BW; const float* G = BV + (size_t)MPAD * BW; const float* BON = G + (size_t)MPAD * BW;
    const int lane = c.lane;
    for (int it = 0;; ++it) {
        const int u = (it * 8 + c.wave) * c.G + c.bid;
        if (u >= (PB + SB) * 16) break;
        const int sq = u >> 4, h = u & 15;
        int row0, L; seq_info(sq, row0, L);
        float S[64];
        if (sq >= PB) { const float* p = s0 + (((size_t)(sq - PB) * 16 + h) * 64 + lane) * 64;
#pragma unroll
            for (int j = 0; j < 64; ++j) S[j] = p[j]; }
        else {
#pragma unroll
            for (int j = 0; j < 64; ++j) S[j] = 0.f; }
        const float lg = lng[h * 64 + lane], lb = lnb[h * 64 + lane];
        for (int t = 0; t < L; ++t) {
            const size_t base = (size_t)(row0 + t) * BW + h * 64; const float v = V[base + lane];
            float d = 0.f;
#pragma unroll
            for (int j = 0; j < 64; ++j) d += S[j] * KK[base + j];
            float y = 0.f;
#pragma unroll
            for (int j = 0; j < 64; ++j) { S[j] = S[j] * WD[base + j] - d * BV[base + j] + v * K2[base + j]; y += S[j] * R[base + j]; }
            const float mean = wave_sum(y) * (1.0f / 64.0f), dy = y - mean, var = wave_sum(dy * dy) * (1.0f / 64.0f);
            const float yn = dy * rsqrtf(var + 64e-5f) * lg + lb;
            OB[base + lane] = f2bf((yn + BON[base + lane]) * G[base + lane]);
        }
        float* op = (sq < PB ? outP + (((size_t)sq * 16 + h) * 64 + lane) * 64 : outS + (((size_t)(sq - PB) * 16 + h) * 64 + lane) * 64);
#pragma unroll
        for (int j = 0; j < 64; ++j) op[j] = S[j];
    }
}
__device__ __forceinline__ void ph_rwkv_scan2(const Ctx& c, int boff, const float* __restrict__ RW, const float* __restrict__ s0, const float* __restrict__ lng, const float* __restrict__ lnb, bf16_t* __restrict__ OB,
                                              float* __restrict__ outP, float* __restrict__ outS) {
    LAS float* opb = (LAS float*)c.lds;
    LAS float* yb = opb + 2 * 16 * 384;
    const int tid = c.tid, lane = c.lane, w = c.wave, rl = lane >> 3, cg = lane & 7, vrow = w * 8 + rl;
    const float* G = RW + 6 * (size_t)MPAD * BW; const float* BON = RW + 7 * (size_t)MPAD * BW;
    for (int u = (c.bid - boff + c.G) % c.G; u < (PB + SB) * 16; u += c.G) {
        const int sq = u >> 4, h = u & 15;
        int row0, L; seq_info(sq, row0, L);
        float S[8];
        if (sq >= PB) { const float* p = s0 + (((size_t)(sq - PB) * 16 + h) * 64 + vrow) * 64 + cg * 8;
#pragma unroll
            for (int j = 0; j < 8; ++j) S[j] = p[j]; }
        else {
#pragma unroll
            for (int j = 0; j < 8; ++j) S[j] = 0.f; }
        const float lg = lng[h * 64 + lane], lb = lnb[h * 64 + lane];
        const int nb = (L + 15) >> 4;
#define RW_STAGE(bi_) do { const int t0_ = (bi_) * 16, nT_ = (L - t0_) < 16 ? (L - t0_) : 16; LAS float* dst_ = opb + ((bi_) & 1) * 16 * 384; \
        for (int idx = tid; idx < nT_ * 96; idx += 512) { const int t = idx / 96, rem = idx - t * 96, slot = rem >> 4, c4 = rem & 15; \
            const int arr = slot == 0 ? 1 : slot == 1 ? 4 : slot == 2 ? 5 : slot == 3 ? 2 : slot == 4 ? 0 : 3; \
            *(LAS f32x4*)(dst_ + t * 384 + slot * 64 + c4 * 4) = *(const f32x4*)(RW + (size_t)arr * MPAD * BW + (size_t)(row0 + t0_ + t) * BW + h * 64 + c4 * 4); } } while (0)
        RW_STAGE(0);
        for (int bi = 0; bi < nb; ++bi) {
            __syncthreads();
            if (bi + 1 < nb) RW_STAGE(bi + 1);
            const int t0 = bi * 16, nT = (L - t0) < 16 ? (L - t0) : 16; const LAS float* src = opb + (bi & 1) * 16 * 384;
            for (int tt = 0; tt < nT; ++tt) {
                const LAS float* b = src + tt * 384 + cg * 8;
                const f32x4 w0 = *(const LAS f32x4*)(b), w1 = *(const LAS f32x4*)(b + 4), k0 = *(const LAS f32x4*)(b + 64), k1 = *(const LAS f32x4*)(b + 68);
                const f32x4 b0 = *(const LAS f32x4*)(b + 128), b1 = *(const LAS f32x4*)(b + 132), q0 = *(const LAS f32x4*)(b + 192), q1 = *(const LAS f32x4*)(b + 196);
                const f32x4 r0 = *(const LAS f32x4*)(b + 256), r1 = *(const LAS f32x4*)(b + 260); const float v = src[tt * 384 + 320 + vrow];
                float d = (S[0] * k0[0] + S[1] * k0[1]) + (S[2] * k0[2] + S[3] * k0[3]) + (S[4] * k1[0] + S[5] * k1[1]) + (S[6] * k1[2] + S[7] * k1[3]);
                d += __shfl_xor(d, 1, 64); d += __shfl_xor(d, 2, 64); d += __shfl_xor(d, 4, 64);
                float y = 0.f;
#pragma unroll
                for (int j = 0; j < 4; ++j) { S[j] = S[j] * w0[j] - d * b0[j] + v * q0[j]; y += S[j] * r0[j]; S[4 + j] = S[4 + j] * w1[j] - d * b1[j] + v * q1[j]; y += S[4 + j] * r1[j]; }
                y += __shfl_xor(y, 1, 64); y += __shfl_xor(y, 2, 64); y += __shfl_xor(y, 4, 64);
                if (cg == 0) yb[tt * 64 + vrow] = y;
            }
            __syncthreads();
            for (int tt = w; tt < nT; tt += 8) {
                const float y = yb[tt * 64 + lane]; const float mean = wave_sum(y) * (1.0f / 64.0f), dy = y - mean, var = wave_sum(dy * dy) * (1.0f / 64.0f);
                const float yn = dy * rsqrtf(var + 64e-5f) * lg + lb; const size_t o = (size_t)(row0 + t0 + tt) * BW + h * 64 + lane;
                OB[o] = f2bf((yn + BON[o]) * G[o]);
            }
        }
#undef RW_STAGE
        float* op = (sq < PB ? outP + (((size_t)sq * 16 + h) * 64 + vrow) * 64 : outS + (((size_t)(sq - PB) * 16 + h) * 64 + vrow) * 64) + cg * 8;
#pragma unroll
        for (int j = 0; j < 8; ++j) op[j] = S[j];
        __syncthreads();
    }
}
constexpr int RS_SLOTS = 8, RS_SLOT_B = RB_EL * 2;
__device__ __forceinline__ void ph_rwkv_seq(const Ctx& c, int boff, const bf16_t* __restrict__ RB, const float* __restrict__ s0, float* __restrict__ outP, float* __restrict__ outS, bf16_t* __restrict__ OB) {
    const int lane = c.lane, r = lane & 15, q = lane >> 4, w = c.wave;
    LAS unsigned char* ring = c.lds;
    const int side = c.bid < 32 ? c.bid : c.bid - 64, nside = c.G - 64;
    for (int u = (c.bid >= boff && c.bid < boff + 32) ? c.bid - boff : ((c.bid < 32 || c.bid >= 96) ? 32 + side : (PB + SB) * 16); u < (PB + SB) * 16; u = u < 32 ? (PB + SB) * 16 : u + nside) {
        const int sq = u >> 4, h = u & 15;
        int nch, ch0, row0, ntok; const float* sp = nullptr; float* op;
        if (sq < PB) { nch = 256; ch0 = (sq * 16 + h) * 256; row0 = sq * PS; ntok = 16; op = outP + (size_t)(sq * 16 + h) * 4096; }
        else { nch = 1; ch0 = PB * 16 * 256 + (sq - PB) * 16 + h; row0 = MP + (sq - PB) * SS; ntok = SS; sp = s0 + (size_t)((sq - PB) * 16 + h) * 4096; op = outS + (size_t)((sq - PB) * 16 + h) * 4096; }
        if (w >= 4) {
            const int lw = w - 4, p0 = lw < 2 ? lw * 5 : 10 + (lw - 2) * 4, np = lw < 2 ? 5 : 4;
#define RS_ISSUE(ci_) do { const int cc_ = (ci_) < nch ? (ci_) : nch - 1; const char* g_ = (const char*)(RB + (size_t)(ch0 + cc_) * RB_EL) + p0 * 1024 + lane * 16; \
            LAS unsigned char* d_ = ring + ((ci_) % RS_SLOTS) * RS_SLOT_B + p0 * 1024; \
            _Pragma("unroll") for (int p_ = 0; p_ < 5; ++p_) if (p_ < np) __builtin_amdgcn_global_load_lds((const unsigned*)(g_ + p_ * 1024), (LAS unsigned*)(d_ + p_ * 1024), 16, 0, 0); } while (0)
            for (int ci = 0; ci < RS_SLOTS - 1; ++ci) RS_ISSUE(ci);
            if (lw < 2) asm volatile("s_waitcnt vmcnt(30)" ::: "memory"); else asm volatile("s_waitcnt vmcnt(24)" ::: "memory");
            __builtin_amdgcn_s_barrier();
            for (int ci = 0; ci < nch; ++ci) {
                RS_ISSUE(ci + RS_SLOTS - 1);
                if (lw < 2) asm volatile("s_waitcnt vmcnt(30)" ::: "memory"); else asm volatile("s_waitcnt vmcnt(24)" ::: "memory");
                __builtin_amdgcn_s_barrier();
            }
#undef RS_ISSUE
            asm volatile("s_waitcnt vmcnt(0)" ::: "memory");
        } else {
            const int vb = w; f32x4 acc[4];
#pragma unroll
            for (int kb = 0; kb < 4; ++kb) acc[kb] = sp ? *(const f32x4*)(sp + (size_t)(vb * 16 + r) * 64 + kb * 16 + q * 4) : (f32x4){0.f, 0.f, 0.f, 0.f};
            const bf16x8 zfrag = (bf16x8){0, 0, 0, 0, 0, 0, 0, 0};
            __builtin_amdgcn_s_barrier();
            for (int ci = 0; ci < nch; ++ci) {
                const LAS bf16_t* blob = (const LAS bf16_t*)(ring + (ci % RS_SLOTS) * RS_SLOT_B);
                bf16x8 mf[4][2], khf[4], qpf[2];
#pragma unroll
                for (int kb = 0; kb < 4; ++kb) { mf[kb][0] = *(const LAS bf16x8*)(blob + (kb * 16 + r) * 72 + q * 8); mf[kb][1] = *(const LAS bf16x8*)(blob + (kb * 16 + r) * 72 + 32 + q * 8);
                    khf[kb] = q < 2 ? *(const LAS bf16x8*)(blob + RB_KHP + (kb * 16 + r) * 24 + q * 8) : zfrag; }
                qpf[0] = *(const LAS bf16x8*)(blob + RB_QP + r * 72 + q * 8); qpf[1] = *(const LAS bf16x8*)(blob + RB_QP + r * 72 + 32 + q * 8);
                const bf16x8 vt = q < 2 ? *(const LAS bf16x8*)(blob + RB_VT + (vb * 16 + r) * 24 + q * 8) : zfrag;
                const bf16x8 ep = q < 2 ? *(const LAS bf16x8*)(blob + RB_EP + r * 24 + q * 8) : zfrag;
                const bf16x8 t0 = pack_acc(acc[0], acc[1]), t1 = pack_acc(acc[2], acc[3]);
                __builtin_amdgcn_sched_barrier(0);
#pragma unroll
                for (int kb = 0; kb < 4; ++kb) acc[kb] = mma16(mf[kb][0], t0, (f32x4){0.f, 0.f, 0.f, 0.f});
#pragma unroll
                for (int kb = 0; kb < 4; ++kb) acc[kb] = mma16(mf[kb][1], t1, acc[kb]);
#pragma unroll
                for (int kb = 0; kb < 4; ++kb) acc[kb] = mma16(khf[kb], vt, acc[kb]);
                f32x4 y = mma16(t0, qpf[0], (f32x4){0.f, 0.f, 0.f, 0.f}); y = mma16(t1, qpf[1], y); y = mma16(vt, ep, y);
                if (r < ntok) { u32x2 o; o.x = pk2(y[0], y[1]); o.y = pk2(y[2], y[3]); *(u32x2*)(OB + (size_t)(row0 + ci * 16 + r) * BW + h * 64 + vb * 16 + q * 4) = o; }
                asm volatile("s_waitcnt lgkmcnt(0)" ::: "memory");
                __builtin_amdgcn_s_barrier();
            }
#pragma unroll
            for (int kb = 0; kb < 4; ++kb) *(f32x4*)(op + (size_t)(vb * 16 + r) * 64 + kb * 16 + q * 4) = acc[kb];
        }
        __syncthreads();
    }
}
__device__ __forceinline__ void ph_rwkv_fin(const Ctx& c, const float* __restrict__ RW, const float* __restrict__ lng, const float* __restrict__ lnb, const bf16_t* __restrict__ RAW, bf16_t* __restrict__ OB) {
    const int lane = c.lane; const bf16_t* G = (const bf16_t*)(RW + 6 * (size_t)MPAD * BW); const bf16_t* BON = (const bf16_t*)(RW + 7 * (size_t)MPAD * BW);
    for (int i = c.bid * 8 + c.wave; i < MT * 2; i += c.G * 8) {
        const int row = i >> 1, cc = (i & 1) * 512 + lane * 8; const size_t o = (size_t)row * BW + cc;
        float x[8], bo[8], gt[8]; unpack8(*(const u32x4*)(RAW + o), x); unpack8(*(const u32x4*)(BON + o), bo); unpack8(*(const u32x4*)(G + o), gt);
        float s = 0.f;
#pragma unroll
        for (int j = 0; j < 8; ++j) s += x[j];
        s += __shfl_xor(s, 1, 64); s += __shfl_xor(s, 2, 64); s += __shfl_xor(s, 4, 64);
        const float mean = s * (1.0f / 64.0f); float qq = 0.f;
#pragma unroll
        for (int j = 0; j < 8; ++j) { const float d = x[j] - mean; qq += d * d; }
        qq += __shfl_xor(qq, 1, 64); qq += __shfl_xor(qq, 2, 64); qq += __shfl_xor(qq, 4, 64);
        const float rstd = rsqrtf(qq * (1.0f / 64.0f) + 64e-5f);
        const f32x4 g0 = *(const f32x4*)(lng + cc), g1 = *(const f32x4*)(lng + cc + 4), b0 = *(const f32x4*)(lnb + cc), b1 = *(const f32x4*)(lnb + cc + 4); float ov[8];
#pragma unroll
        for (int j = 0; j < 8; ++j) ov[j] = ((x[j] - mean) * rstd * (j < 4 ? g0[j] : g1[j - 4]) + (j < 4 ? b0[j] : b1[j - 4]) + bo[j]) * gt[j];
        *(u32x4*)(OB + o) = (u32x4){pk2(ov[0], ov[1]), pk2(ov[2], ov[3]), pk2(ov[4], ov[5]), pk2(ov[6], ov[7])};
    }
}

__device__ __forceinline__ void ph_memattn_sample(const Ctx& c, int boff, const bf16_t* __restrict__ U, const float* __restrict__ mk, const float* __restrict__ mv, bf16_t* __restrict__ OB) {
    LAS float* ps = (LAS float*)c.lds;
    const int hh = c.tid >> 8, vt = c.tid & 255, lane = c.lane, r = lane & 15, q = lane >> 4, w4 = c.wave & 3;
    for (int u = (c.bid - boff + c.G) % c.G; u < SB * 2; u += c.G) {
        const int sq = u >> 1, h = (u & 1) * 2 + hh;
        bf16x8 qf[8];
#pragma unroll
        for (int ks = 0; ks < 8; ++ks) { u32x4 raw = (u32x4){0u, 0u, 0u, 0u};
            if (r < 4) raw = *(const u32x4*)(U + (size_t)(MP + sq * SS + r) * NINP + U_MQ + h * 256 + ks * 32 + q * 8);
            qf[ks] = __builtin_bit_cast(bf16x8, raw); }
#pragma unroll 1
        for (int mt = 0; mt < 4; ++mt) { const float* kr = mk + (((size_t)sq * MEMT + (w4 * 4 + mt) * 16 + r) * 4 + h) * 256 + q * 8; f32x4 ka[8], kb2[8];
#pragma unroll
            for (int ks = 0; ks < 8; ++ks) { ka[ks] = *(const f32x4*)(kr + ks * 32); kb2[ks] = *(const f32x4*)(kr + ks * 32 + 4); }
            __builtin_amdgcn_sched_barrier(0);
            f32x4 d = (f32x4){0.f, 0.f, 0.f, 0.f};
#pragma unroll
            for (int ks = 0; ks < 8; ++ks) { u32x4 p; p.x = pk2(ka[ks][0], ka[ks][1]); p.y = pk2(ka[ks][2], ka[ks][3]); p.z = pk2(kb2[ks][0], kb2[ks][1]); p.w = pk2(kb2[ks][2], kb2[ks][3]);
                d = mma16(__builtin_bit_cast(bf16x8, p), qf[ks], d); }
            if (r < 4) *(LAS f32x4*)(ps + (hh * 4 + r) * 256 + (w4 * 4 + mt) * 16 + q * 4) = d * 0.0625f; }
        __syncthreads();
        { LAS float* pr = ps + c.wave * 256; float x[4]; float mx = -3.0e38f;
#pragma unroll
            for (int j = 0; j < 4; ++j) { x[j] = pr[lane + 64 * j]; mx = fmaxf(mx, x[j]); }
            mx = wave_max(mx); float s = 0.f;
#pragma unroll
            for (int j = 0; j < 4; ++j) { x[j] = __expf(x[j] - mx); s += x[j]; }
            const float inv = 1.0f / wave_sum(s);
#pragma unroll
            for (int j = 0; j < 4; ++j) pr[lane + 64 * j] = x[j] * inv; }
        __syncthreads();
        { float o[4] = {0.f, 0.f, 0.f, 0.f}; const float* vr = mv + ((size_t)sq * MEMT * 4 + h) * 256 + vt;
#pragma unroll 8
            for (int m = 0; m < MEMT; ++m) { const float vv = vr[(size_t)m * 1024];
#pragma unroll
                for (int t = 0; t < 4; ++t) o[t] += ps[(hh * 4 + t) * 256 + m] * vv; }
#pragma unroll
            for (int t = 0; t < 4; ++t) OB[(size_t)(MP + sq * SS + t) * BW + h * 256 + vt] = f2bf(o[t]); }
        __syncthreads();
    }
}

template <int K, int LDA, int LDB> __device__ __forceinline__ void skinny_pair(const Ctx& c, const bf16_t* __restrict__ A, const bf16_t* __restrict__ B0, const bf16_t* __restrict__ B1, f32x4 (&out)[2], int rot) {
    LAS f32x4* red = (LAS f32x4*)c.lds;
    const int lane = c.lane, r = lane & 15, q = lane >> 4, w = c.wave;
    constexpr int KS = K / 8;
    const bf16_t* ap = A + (size_t)r * LDA + w * KS + q * 8; const bf16_t* b0 = B0 + (size_t)r * LDB + w * KS + q * 8; const bf16_t* b1 = B1 + (size_t)r * LDB + w * KS + q * 8;
    f32x4 acc[2][8];
#pragma unroll
    for (int n = 0; n < 2; ++n)
#pragma unroll
        for (int m = 0; m < 8; ++m) acc[n][m] = (f32x4){0.f, 0.f, 0.f, 0.f};
    int kk = (int)((unsigned)rot % (unsigned)(KS / 32));
#pragma unroll 2
    for (int it = 0; it < KS / 32; ++it) { const int ks = kk; kk = kk + 1 == KS / 32 ? 0 : kk + 1;
        const bf16x8 f0 = *(const bf16x8*)(b0 + ks * 32), f1 = *(const bf16x8*)(b1 + ks * 32); bf16x8 af[8];
#pragma unroll
        for (int m = 0; m < 8; ++m) af[m] = *(const bf16x8*)(ap + (size_t)(m * 16) * LDA + ks * 32);
        __builtin_amdgcn_sched_barrier(0);
#pragma unroll
        for (int m = 0; m < 8; ++m) { acc[0][m] = mma16(f0, af[m], acc[0][m]); acc[1][m] = mma16(f1, af[m], acc[1][m]); } }
    __syncthreads();
#pragma unroll
    for (int n = 0; n < 2; ++n)
#pragma unroll
        for (int m = 0; m < 8; ++m) red[(w * 16 + n * 8 + m) * 64 + lane] = acc[n][m];
    __syncthreads();
#pragma unroll
    for (int n = 0; n < 2; ++n) { f32x4 s = red[(n * 8 + w) * 64 + lane];
#pragma unroll
        for (int ww = 1; ww < 8; ++ww) s += red[(ww * 16 + n * 8 + w) * 64 + lane];
        out[n] = s; }
}
template <int K, int LDA, int LDB> __device__ __forceinline__ f32x4 skinny_one(const Ctx& c, const bf16_t* __restrict__ A, const bf16_t* __restrict__ B0, int rot) {
    LAS f32x4* red = (LAS f32x4*)c.lds;
    const int lane = c.lane, r = lane & 15, q = lane >> 4, w = c.wave;
    constexpr int KS = K / 8, NK = KS / 32;
    const bf16_t* ap = A + (size_t)r * LDA + w * KS + q * 8; const bf16_t* b0 = B0 + (size_t)r * LDB + w * KS + q * 8;
    f32x4 acc[8];
#pragma unroll
    for (int m = 0; m < 8; ++m) acc[m] = (f32x4){0.f, 0.f, 0.f, 0.f};
    int kk = (int)((unsigned)rot % (unsigned)NK);
#pragma unroll 4
    for (int it = 0; it < NK; ++it) { const int ks = kk; kk = kk + 1 == NK ? 0 : kk + 1;
        const bf16x8 f0 = *(const bf16x8*)(b0 + ks * 32); bf16x8 af[8];
#pragma unroll
        for (int m = 0; m < 8; ++m) af[m] = *(const bf16x8*)(ap + (size_t)(m * 16) * LDA + ks * 32);
        __builtin_amdgcn_sched_barrier(0);
#pragma unroll
        for (int m = 0; m < 8; ++m) acc[m] = mma16(f0, af[m], acc[m]); }
    __syncthreads();
#pragma unroll
    for (int m = 0; m < 8; ++m) red[(w * 8 + m) * 64 + lane] = acc[m];
    __syncthreads();
    f32x4 s = red[w * 64 + lane];
#pragma unroll
    for (int ww = 1; ww < 8; ++ww) s += red[(ww * 8 + w) * 64 + lane];
    return s;
}
template <int K, int LDA, int LDB> __device__ __forceinline__ f32x4 skinny_half(const Ctx& c, const bf16_t* __restrict__ A, const bf16_t* __restrict__ B0) {
    LAS f32x4* red = (LAS f32x4*)c.lds;
    const int lane = c.lane, r = lane & 15, q = lane >> 4, w = c.wave;
    constexpr int KS = K / 8, NK = KS / 32;
    const bf16_t* ap = A + (size_t)r * LDA + w * KS + q * 8; const bf16_t* b0 = B0 + (size_t)r * LDB + w * KS + q * 8;
    f32x4 acc[4];
#pragma unroll
    for (int m = 0; m < 4; ++m) acc[m] = (f32x4){0.f, 0.f, 0.f, 0.f};
#pragma unroll 4
    for (int ks = 0; ks < NK; ++ks) {
        const bf16x8 f0 = *(const bf16x8*)(b0 + ks * 32); bf16x8 af[4];
#pragma unroll
        for (int m = 0; m < 4; ++m) af[m] = *(const bf16x8*)(ap + (size_t)(m * 16) * LDA + ks * 32);
        __builtin_amdgcn_sched_barrier(0);
#pragma unroll
        for (int m = 0; m < 4; ++m) acc[m] = mma16(f0, af[m], acc[m]); }
    __syncthreads();
#pragma unroll
    for (int m = 0; m < 4; ++m) red[(w * 4 + m) * 64 + lane] = acc[m];
    __syncthreads();
    f32x4 s = (f32x4){0.f, 0.f, 0.f, 0.f};
    if (w < 4) { s = red[w * 64 + lane];
#pragma unroll
        for (int ww = 1; ww < 8; ++ww) s += red[(ww * 4 + w) * 64 + lane]; }
    return s;
}
__device__ __forceinline__ u32x2 pk4(const f32x4 v) { u32x2 o; o.x = pk2(v[0], v[1]); o.y = pk2(v[2], v[3]); return o; }
#define SKINNY_LOOP(total_) for (int s = c.bid - base; s >= 0 && s < (total_); s += ncu)
__device__ __forceinline__ void ph_sk_in(const Ctx& c, int base, int ncu, const bf16_t* __restrict__ HB, const bf16_t* __restrict__ W, bf16_t* __restrict__ U) {
    const int r = c.lane & 15, q = c.lane >> 4, w = c.wave;
    SKINNY_LOOP(NINP / 32) { f32x4 o[2]; skinny_pair<DM, DM, DM>(c, HB + (size_t)MP * DM, W + (size_t)(s * 32) * DM, W + (size_t)(s * 32 + 16) * DM, o, s);
        bf16_t* up = U + (size_t)(MP + w * 16 + r) * NINP + s * 32 + q * 4; *(u32x2*)up = pk4(o[0]); *(u32x2*)(up + 16) = pk4(o[1]); }
}
__device__ __forceinline__ void ph_sk_merge(const Ctx& c, int base, int ncu, const bf16_t* __restrict__ BR, const bf16_t* __restrict__ W, const bf16_t* __restrict__ U, const float* __restrict__ gate_b, bf16_t* __restrict__ MGB) {
    const int r = c.lane & 15, q = c.lane >> 4, w = c.wave;
    SKINNY_LOOP(DM / 8) { const int ct = s >> 1, hf = s & 1; const size_t row = (size_t)(MP + hf * 64 + (w & 3) * 16 + r); const int col = ct * 16 + q * 4; f32x4 tot = (f32x4){0.f, 0.f, 0.f, 0.f};
#pragma unroll 1
        for (int z = 0; z < 4; ++z) { const f32x4 o = skinny_half<BW, BW, BW>(c, BR + ((size_t)z * MPAD + MP + hf * 64) * BW, W + ((size_t)z * DM + ct * 16) * BW);
            if (w < 4) { const u32x2 gp = *(const u32x2*)(U + row * NINP + U_GP + z * DM + col); const f32x4 gb = *(const f32x4*)(gate_b + z * DM + col);
            tot[0] += sigmoidf_(__uint_as_float(gp.x << 16) + gb[0]) * o[0]; tot[1] += sigmoidf_(__uint_as_float(gp.x & 0xffff0000u) + gb[1]) * o[1];
            tot[2] += sigmoidf_(__uint_as_float(gp.y << 16) + gb[2]) * o[2]; tot[3] += sigmoidf_(__uint_as_float(gp.y & 0xffff0000u) + gb[3]) * o[3]; } }
        if (w < 4) *(u32x2*)(MGB + row * DM + col) = pk4(tot); }
}
template <int K> __device__ __forceinline__ void ph_sk_res(const Ctx& c, int base, int ncu, const bf16_t* __restrict__ A, const bf16_t* __restrict__ W, const bf16_t* __restrict__ R, bf16_t* __restrict__ Y) {
    const int r = c.lane & 15, q = c.lane >> 4, w = c.wave;
    SKINNY_LOOP(DM / 8) { const int ct = s >> 1, hf = s & 1; const f32x4 o = skinny_half<K, K, K>(c, A + (size_t)(MP + hf * 64) * K, W + (size_t)(ct * 16) * K);
        if (w < 4) { const size_t off = (size_t)(MP + hf * 64 + w * 16 + r) * DM + ct * 16 + q * 4; const u32x2 rr = *(const u32x2*)(R + off);
        const f32x4 rv = (f32x4){__uint_as_float(rr.x << 16), __uint_as_float(rr.x & 0xffff0000u), __uint_as_float(rr.y << 16), __uint_as_float(rr.y & 0xffff0000u)};
        *(u32x2*)(Y + off) = pk4(rv * ALPHA + o); } }
}
__device__ __forceinline__ void ph_sk_gu(const Ctx& c, int base, int ncu, const bf16_t* __restrict__ X1B, const bf16_t* __restrict__ W, bf16_t* __restrict__ ACT) {
    const int r = c.lane & 15, q = c.lane >> 4, w = c.wave;
    SKINNY_LOOP(DFF / 16) { const int t = s >> 3, j0 = (s & 7) * 16; f32x4 o[2];
        skinny_pair<DM, DM, DM>(c, X1B + (size_t)MP * DM, W + (size_t)(t * 256 + j0) * DM, W + (size_t)(t * 256 + 128 + j0) * DM, o, s);
        f32x4 v;
#pragma unroll
        for (int j = 0; j < 4; ++j) v[j] = o[0][j] * sigmoidf_(o[0][j]) * o[1][j];
        *(u32x2*)(ACT + (size_t)(MP + w * 16 + r) * DFF + t * 128 + j0 + q * 4) = pk4(v); }
}
#undef SKINNY_LOOP

constexpr int LDS_BAR_OFF = 147456;
constexpr int LDS_BYTES = LDS_BAR_OFF + 64;
struct Args { const float* in[37]; float* out; unsigned char* ws; };

typedef pg8::Gemm<DM, DM, DM, 2, 8, NL, 1, false, 0, 0, (long)DM * DM, 0> GemmMem;
typedef pg8::Gemm<DM, DM, DM, MP / 256, NINP / 256> GemmIn;
typedef pg8::Gemm<NINP, 1024, 256, PS / 256, 1, 8, 4, false, (long)PS * NINP, 256, 256 * 1024, 256> GemmScore;
typedef pg8::Gemm<256, 256, 256, PS / 256, 1, 8, 4, false, (long)4 * 4096 * 256, (long)4096 * 256, 4 * 65536, 65536> GemmPV;
typedef pg8::Gemm<BW, BW, BW, MP / 256, DM / 256, 4, 1, true, (long)MPAD * BW, 0, (long)DM * BW, 0> GemmBranch;
typedef pg8::Gemm<DM, DM, DM, MP / 256, DM / 256> GemmOut;
typedef pg8::Gemm<DM, DM, DM, MP / 256, 2 * DFF / 256> GemmGU;
typedef pg8::Gemm<DFF, DFF, DFF, MP / 256, DM / 256> GemmDown;
template <class GT> __device__ __forceinline__ GT mk_gemm(const Ctx& c, const bf16_t* A, const bf16_t* B) { GT g; g.A = A; g.B = B; g.G = c.G; g.c = c.bid; return g; }

template <int OFF> __device__ __forceinline__ unsigned long long karg_u64(unsigned long long kargs) {
    unsigned long long p; asm volatile("s_load_dwordx2 %0, %1, %2\n\ts_waitcnt lgkmcnt(0)" : "=s"(p) : "s"(kargs), "n"(OFF) : "memory"); return p;
}
#define GPTR(T, x) ((T*)(__attribute__((address_space(1))) T*)(x))
#define INP(k) GPTR(const float, karg_u64<(k) * 8>(kargs))
#define OUTP() GPTR(float, karg_u64<37 * 8>(kargs))
#define WSP() GPTR(unsigned char, karg_u64<38 * 8>(kargs))

__global__ void __launch_bounds__(512, 2) mega_fwd(Args a_unused) {
    extern __shared__ __attribute__((aligned(16))) unsigned char lds_raw[];
    const unsigned long long kargs = (unsigned long long)__builtin_amdgcn_kernarg_segment_ptr();
    Ctx c0; c0.tid = threadIdx.x; c0.lane = c0.tid & 63; c0.wave = __builtin_amdgcn_readfirstlane(c0.tid >> 6); c0.bid = blockIdx.x; c0.G = gridDim.x; c0.lds = (LAS unsigned char*)lds_raw;
    if (c0.tid < 4) ((LAS unsigned*)(c0.lds + LDS_BAR_OFF))[c0.tid] = 0u;
    __syncthreads();
    const XcdBarrier bar = xcd_barrier_post((unsigned*)(WSP() + WS_CTL), (volatile LAS unsigned*)(c0.lds + LDS_BAR_OFF));

#define WPREP_LAYER(cc_, L_) do { unsigned char* ws_ = WSP(); \
      ph_wprep(cc_, INP(10) + (size_t)(L_) * DM * NIN, (bf16_t*)(ws_ + WS_WIN) + (size_t)(L_) * NINP * DM, DM, NIN, NINP, 1, 1, 0, 0); \
      ph_wprep(cc_, INP(29) + (size_t)(L_) * 4 * BW * DM, (bf16_t*)(ws_ + WS_WBR) + (size_t)(L_) * 4 * DM * BW, BW, DM, DM, 0, 4, (size_t)BW * DM, (size_t)DM * BW); \
      ph_wprep(cc_, INP(30) + (size_t)(L_) * DM * DM, (bf16_t*)(ws_ + WS_WOUT) + (size_t)(L_) * DM * DM, DM, DM, DM, 0, 1, 0, 0); \
      ph_wprep(cc_, INP(33) + (size_t)(L_) * DM * 2 * DFF, (bf16_t*)(ws_ + WS_WGU) + (size_t)(L_) * 2 * DFF * DM, DM, 2 * DFF, 2 * DFF, 2, 1, 0, 0); \
      ph_wprep(cc_, INP(34) + (size_t)(L_) * DFF * DM, (bf16_t*)(ws_ + WS_WDN) + (size_t)(L_) * DM * DFF, DFF, DM, DM, 0, 1, 0, 0); } while (0)
    { const Ctx c = fresh(c0); unsigned char* ws = WSP();
      ph_wprep(c, INP(28), (bf16_t*)(ws + WS_WMEM), DM, DM, DM, 0, NL, (size_t)DM * DM, (size_t)DM * DM);
      WPREP_LAYER(c, 0);
      ph_lrw(c, INP(19), INP(21), INP(22), (bf16_t*)(ws + WS_LRW));
      ph_xprep(c, INP(0), INP(1), INP(2), (float*)nullptr, (bf16_t*)(ws + WS_HB), (bf16_t*)(ws + WS_MEMB)); }
    xcd_barrier(bar);
    { const Ctx c = fresh(c0); unsigned char* ws = WSP(); float* out = OUTP();
      GemmMem g = mk_gemm<GemmMem>(c, (const bf16_t*)(ws + WS_MEMB), (const bf16_t*)(ws + WS_WMEM));
      pg8::EpiMem E; E.outK = out + O_MKP; E.outV = out + O_MVP; E.kb = (bf16_t*)(ws + WS_MKB); E.vt = (bf16_t*)(ws + WS_MVT); pg8::gemm_phase<GemmMem, pg8::EpiMem, true, true>(c.lds, c.tid, g, E); }

    for (int l = 0; l < NL; ++l) {
        { const Ctx c = fresh(c0); unsigned char* ws = WSP();
          GemmIn g = mk_gemm<GemmIn>(c, (const bf16_t*)(ws + WS_HB), (const bf16_t*)(ws + WS_WIN) + (size_t)l * NINP * DM);
          pg8::EpiBf16 E; E.O = (bf16_t*)(ws + WS_U); E.zs = 0; E.ldc = NINP; E.pad = 0; pg8::gemm_phase<GemmIn, pg8::EpiBf16, true, true>(c.lds, c.tid, g, E); }
        { const Ctx c = fresh(c0); unsigned char* ws = WSP(); ph_sk_in(c, c.G > 192 ? 96 : 0, c.G > 192 ? c.G - 96 : c.G, (const bf16_t*)(ws + WS_HB), (const bf16_t*)(ws + WS_WIN) + (size_t)l * NINP * DM, (bf16_t*)(ws + WS_U)); }
        xcd_barrier(bar);
        { const Ctx c = fresh(c0); unsigned char* ws = WSP(); float* out = OUTP(); const bf16_t* U = (const bf16_t*)(ws + WS_U); bf16_t* BR = (bf16_t*)(ws + WS_BR);
          (void)out; (void)BR;
          ph_gla_pre(c, U, INP(12) + (size_t)l * 16 * 512, INP(13) + (size_t)l * 512, (bf16_t*)(ws + WS_GLQD), (bf16_t*)(ws + WS_GLKH), (bf16_t*)(ws + WS_GLE), (bf16_t*)(ws + WS_GLVT), (float*)(ws + WS_GLGC)); }
        { const Ctx c = fresh(c0); unsigned char* ws = WSP();
          ph_rwkv_pre(c, (const bf16_t*)(ws + WS_U), INP(9) + (size_t)l * SB * RWC, INP(17) + (size_t)l * RWC, INP(18) + (size_t)l * BW, INP(19) + (size_t)l * 64 * BW, INP(20) + (size_t)l * BW, INP(21) + (size_t)l * 64 * BW,
                       INP(22) + (size_t)l * 128 * BW, INP(23) + (size_t)l * BW, INP(24) + (size_t)l * BW, INP(25) + (size_t)l * BW, (float*)(ws + WS_RW), (bf16_t*)(ws + WS_RB), (const bf16_t*)(ws + WS_LRW) + (size_t)l * 1024 * 256); }
        { const Ctx c = fresh(c0); unsigned char* ws = WSP(); ph_memattn_prompt(c, (const bf16_t*)(ws + WS_U), (const bf16_t*)(ws + WS_MKB) + (size_t)l * 512 * 1024, (const bf16_t*)(ws + WS_MVT) + (size_t)l * 8 * 65536, (bf16_t*)(ws + WS_BR) + (size_t)3 * MPAD * BW); }
        xcd_barrier(bar);
        { const Ctx c = fresh(c0); unsigned char* ws = WSP(); float* out = OUTP();
          ph_rwkv_seq(c, 64, (const bf16_t*)(ws + WS_RB), INP(8) + (size_t)l * SB * 16 * 4096, out + O_RWP + (size_t)l * PB * 16 * 4096, out + O_RWS + (size_t)l * SB * 16 * 4096,
                      (bf16_t*)(ws + WS_RAW) + (size_t)MPAD * BW); }
        { const Ctx c = fresh(c0); unsigned char* ws = WSP(); float* out = OUTP();
          ph_gla_seq(c, 32, (const bf16_t*)(ws + WS_GLQD), (const bf16_t*)(ws + WS_GLKH), (const bf16_t*)(ws + WS_GLE), (const bf16_t*)(ws + WS_GLVT), (const float*)(ws + WS_GLGC),
                     INP(7) + (size_t)l * SB * 4 * 32768, out + O_GLAP + (size_t)l * PB * 4 * 32768, out + O_GLAS + (size_t)l * SB * 4 * 32768, (bf16_t*)(ws + WS_RAW)); }
        if ((c0.bid < 32 || c0.bid >= 96) && c0.G > 96) {
        { Ctx c = fresh(c0); c.bid = c.bid < 32 ? c.bid : c.bid - 64; c.G = c.G - 64; unsigned char* ws = WSP(); ph_swa_prompt(c, (const bf16_t*)(ws + WS_U), INP(16) + (size_t)l * 16, (bf16_t*)(ws + WS_BR) + (size_t)MPAD * BW); }
        { Ctx c = fresh(c0); c.bid = c.bid < 32 ? c.bid : c.bid - 64; c.G = c.G - 64; unsigned char* ws = WSP();
          ph_swa_sample(c, (const bf16_t*)(ws + WS_U), INP(3) + (size_t)l * SB * 16384, INP(4) + (size_t)l * SB * 16384, INP(16) + (size_t)l * 16, (bf16_t*)(ws + WS_BR) + (size_t)MPAD * BW); }
        { Ctx c = fresh(c0); c.bid = c.bid < 32 ? c.bid : c.bid - 64; c.G = c.G - 64; unsigned char* ws = WSP();
          ph_memattn_sample(c, 64, (const bf16_t*)(ws + WS_U), INP(5) + (size_t)l * SB * MEMT * 1024, INP(6) + (size_t)l * SB * MEMT * 1024, (bf16_t*)(ws + WS_BR) + (size_t)3 * MPAD * BW); }
        { Ctx c = fresh(c0); c.bid = c.bid < 32 ? c.bid : c.bid - 64; c.G = c.G - 64; unsigned char* ws = WSP();
          ph_copy_outs(c, (const bf16_t*)(ws + WS_U), INP(3) + (size_t)l * SB * 16384, INP(4) + (size_t)l * SB * 16384, OUTP(), l); }
          if (l + 1 < NL) { Ctx c = fresh(c0); const int sd = c.bid < 32 ? c.bid : c.bid - 64; c.G = 2 * (c.G - 64) + 96;
            c.bid = 2 * sd; WPREP_LAYER(c, l + 1); c.bid = 2 * sd + 1; WPREP_LAYER(c, l + 1); }
        } else if (l + 1 < NL && c0.G > 96) { Ctx c = fresh(c0); const int nside2 = 2 * (c.G - 64); c.G = nside2 + 96;
          if (c0.bid < 64) { c.bid = nside2 + 2 * (c0.bid - 32); WPREP_LAYER(c, l + 1); c.bid = nside2 + 2 * (c0.bid - 32) + 1; WPREP_LAYER(c, l + 1); }
          else { c.bid = nside2 + 64 + (c0.bid - 64); WPREP_LAYER(c, l + 1); }
        }
        xcd_barrier(bar);
        { const Ctx c = fresh(c0); unsigned char* ws = WSP(); ph_rwkv_fin(c, (const float*)(ws + WS_RW), INP(26) + (size_t)l * BW, INP(27) + (size_t)l * BW, (const bf16_t*)(ws + WS_RAW) + (size_t)MPAD * BW, (bf16_t*)(ws + WS_BR) + (size_t)2 * MPAD * BW); }
        { const Ctx c = fresh(c0); unsigned char* ws = WSP(); ph_gla_fin(c, (const bf16_t*)(ws + WS_U), INP(14) + (size_t)l * BW, INP(15) + (size_t)l * BW, (const bf16_t*)(ws + WS_RAW), (bf16_t*)(ws + WS_BR)); }
        xcd_barrier(bar);
        { const Ctx c = fresh(c0); unsigned char* ws = WSP();
          GemmBranch g = mk_gemm<GemmBranch>(c, (const bf16_t*)(ws + WS_BR), (const bf16_t*)(ws + WS_WBR) + (size_t)l * 4 * DM * BW);
          pg8::EpiMerge E; E.MG = (float*)(ws + WS_MG); E.MGB = (bf16_t*)(ws + WS_MGB); E.U = (const bf16_t*)(ws + WS_U); E.gate_b = INP(11) + (size_t)l * 4 * DM; pg8::gemm_phase<GemmBranch, pg8::EpiMerge, true, true>(c.lds, c.tid, g, E); }
        { const Ctx c = fresh(c0); unsigned char* ws = WSP(); ph_sk_merge(c, 0, c.G, (const bf16_t*)(ws + WS_BR), (const bf16_t*)(ws + WS_WBR) + (size_t)l * 4 * DM * BW, (const bf16_t*)(ws + WS_U), INP(11) + (size_t)l * 4 * DM, (bf16_t*)(ws + WS_MGB)); }
        xcd_barrier(bar);
        { const Ctx c = fresh(c0); unsigned char* ws = WSP();
          GemmOut g = mk_gemm<GemmOut>(c, (const bf16_t*)(ws + WS_MGB), (const bf16_t*)(ws + WS_WOUT) + (size_t)l * DM * DM);
          pg8::EpiRes E; E.R = (const bf16_t*)(ws + WS_HB); E.Y = (bf16_t*)(ws + WS_Y); pg8::gemm_phase<GemmOut, pg8::EpiRes, true, true>(c.lds, c.tid, g, E); }
        { const Ctx c = fresh(c0); unsigned char* ws = WSP(); ph_sk_res<DM>(c, 0, c.G, (const bf16_t*)(ws + WS_MGB), (const bf16_t*)(ws + WS_WOUT) + (size_t)l * DM * DM, (const bf16_t*)(ws + WS_HB), (bf16_t*)(ws + WS_Y)); }
        xcd_barrier(bar);
        { const Ctx c = fresh(c0); unsigned char* ws = WSP(); ph_ln(c, (const bf16_t*)(ws + WS_Y), INP(31) + (size_t)l * DM, INP(32) + (size_t)l * DM, (float*)nullptr, (bf16_t*)(ws + WS_X1B), nullptr, MT, 0); }
        xcd_barrier(bar);
        { const Ctx c = fresh(c0); unsigned char* ws = WSP();
          GemmGU g = mk_gemm<GemmGU>(c, (const bf16_t*)(ws + WS_X1B), (const bf16_t*)(ws + WS_WGU) + (size_t)l * 2 * DFF * DM);
          pg8::EpiSwiGLU E; E.O = (bf16_t*)(ws + WS_ACT); pg8::gemm_phase<GemmGU, pg8::EpiSwiGLU, true, true>(c.lds, c.tid, g, E); }
        { const Ctx c = fresh(c0); unsigned char* ws = WSP(); ph_sk_gu(c, c.G > 192 ? 128 : 0, c.G > 192 ? c.G - 128 : c.G, (const bf16_t*)(ws + WS_X1B), (const bf16_t*)(ws + WS_WGU) + (size_t)l * 2 * DFF * DM, (bf16_t*)(ws + WS_ACT)); }
        xcd_barrier(bar);
        { const Ctx c = fresh(c0); unsigned char* ws = WSP();
          GemmDown g = mk_gemm<GemmDown>(c, (const bf16_t*)(ws + WS_ACT), (const bf16_t*)(ws + WS_WDN) + (size_t)l * DM * DFF);
          pg8::EpiRes E; E.R = (const bf16_t*)(ws + WS_X1B); E.Y = (bf16_t*)(ws + WS_Y); pg8::gemm_phase<GemmDown, pg8::EpiRes, true, true>(c.lds, c.tid, g, E); }
        { const Ctx c = fresh(c0); unsigned char* ws = WSP(); ph_sk_res<DFF>(c, 0, c.G, (const bf16_t*)(ws + WS_ACT), (const bf16_t*)(ws + WS_WDN) + (size_t)l * DM * DFF, (const bf16_t*)(ws + WS_X1B), (bf16_t*)(ws + WS_Y)); }
        xcd_barrier(bar);
        { const Ctx c = fresh(c0); unsigned char* ws = WSP(); float* out = OUTP(); ph_ln(c, (const bf16_t*)(ws + WS_Y), INP(35) + (size_t)l * DM, INP(36) + (size_t)l * DM, (float*)nullptr, (bf16_t*)(ws + WS_HB), l == NL - 1 ? out : nullptr, MT, MT); }
        xcd_barrier(bar);
    }
}

extern "C" void kernel_launch(void* const* d_in, const int* in_sizes, int n_in, void* d_out, int out_size, void* d_ws, size_t ws_size, hipStream_t stream) {
    static int grid = 0;
    if (grid == 0) {
        if (n_in != 37 || (size_t)out_size != O_END || ws_size < WS_END) { fprintf(stderr, "kernel_launch: unexpected sizes (n_in %d out %d ws %zu need %zu)\n", n_in, out_size, ws_size, (size_t)WS_END); grid = -1; return; }
        int dev = 0, cus = 0;
        if (hipGetDevice(&dev) != hipSuccess || hipDeviceGetAttribute(&cus, hipDeviceAttributeMultiprocessorCount, dev) != hipSuccess) { grid = -1; return; }
        if (hipFuncSetAttribute((const void*)mega_fwd, hipFuncAttributeMaxDynamicSharedMemorySize, LDS_BYTES) != hipSuccess) { fprintf(stderr, "kernel_launch: hipFuncSetAttribute failed\n"); grid = -1; return; }
        int per_cu = 0;
        if (hipOccupancyMaxActiveBlocksPerMultiprocessor(&per_cu, (const void*)mega_fwd, 512, LDS_BYTES) != hipSuccess || per_cu < 1) { fprintf(stderr, "kernel_launch: occupancy query says %d\n", per_cu); }
        (void)hipGetLastError();
        grid = cus;
    }
    if (grid < 0) return;
    (void)hipMemsetAsync((unsigned char*)d_ws + WS_CTL, 0, XCD_BAR_WORDS * sizeof(unsigned), stream);
    Args a; memset(&a, 0, sizeof a);
    for (int i = 0; i < 37; ++i) a.in[i] = (const float*)d_in[i];
    a.out = (float*)d_out; a.ws = (unsigned char*)d_ws;
    hipLaunchKernelGGL(mega_fwd, dim3(grid), dim3(512), LDS_BYTES, stream, a);
}
```

```cpp
#include <hip/hip_runtime.h>
#include <cstdio>
#include <cstdint>
#include <cstring>

#define LAS __attribute__((address_space(3)))
typedef unsigned short bf16_t;
typedef short bf16x8 __attribute__((ext_vector_type(8)));
typedef float f32x4 __attribute__((ext_vector_type(4)));
typedef float f32x2 __attribute__((ext_vector_type(2)));
typedef unsigned u32x4 __attribute__((ext_vector_type(4)));
typedef unsigned u32x2 __attribute__((ext_vector_type(2)));

constexpr int DM = 2048, NL = 4;
constexpr int PB = 2, PS = 4096, MP = PB * PS;
constexpr int SB = 32, SS = 4, MS = SB * SS;
constexpr int MT = MP + MS;
constexpr int MPAD = 8448;
constexpr int NIN = 16912, NINP = 17152;
constexpr int U_GQ = 0, U_GK = 512, U_GV = 1024, U_GR = 2048, U_GA = 3072, U_SQ = 3328, U_SK = 4352, U_SV = 4480, U_RU = 4608, U_MQ = 7936, U_GP = 8960;
constexpr int RWC = 3328, BW = 1024, DFF = 5632, MEMT = 256;
constexpr float ALPHA = 1.681792830507429f;

constexpr size_t O_YP = 0;
constexpr size_t O_YS = O_YP + (size_t)MP * DM;
constexpr size_t O_SWKP = O_YS + (size_t)MS * DM;
constexpr size_t O_SWVP = O_SWKP + (size_t)NL * PB * 128 * 128;
constexpr size_t O_MKP = O_SWVP + (size_t)NL * PB * 128 * 128;
constexpr size_t O_MVP = O_MKP + (size_t)NL * PB * 256 * 1024;
constexpr size_t O_GLAP = O_MVP + (size_t)NL * PB * 256 * 1024;
constexpr size_t O_RWP = O_GLAP + (size_t)NL * PB * 4 * 128 * 256;
constexpr size_t O_RSP = O_RWP + (size_t)NL * PB * 16 * 64 * 64;
constexpr size_t O_SWKS = O_RSP + (size_t)NL * PB * RWC;
constexpr size_t O_SWVS = O_SWKS + (size_t)NL * SB * 128 * 128;
constexpr size_t O_GLAS = O_SWVS + (size_t)NL * SB * 128 * 128;
constexpr size_t O_RWS = O_GLAS + (size_t)NL * SB * 4 * 128 * 256;
constexpr size_t O_RSS = O_RWS + (size_t)NL * SB * 16 * 64 * 64;
constexpr size_t O_END = O_RSS + (size_t)NL * SB * RWC;
static_assert(O_END == 52881408, "output size");

constexpr size_t al256(size_t x) { return (x + 255) & ~(size_t)255; }
constexpr size_t WS_CTL = 0;
constexpr size_t WS_WIN = 65536;
constexpr size_t WS_WMEM = WS_WIN + (size_t)NL * NINP * DM * 2;
constexpr size_t WS_WBR = WS_WMEM + (size_t)NL * DM * DM * 2;
constexpr size_t WS_WOUT = WS_WBR + (size_t)NL * 4 * DM * BW * 2;
constexpr size_t WS_WGU = WS_WOUT + (size_t)NL * DM * DM * 2;
constexpr size_t WS_WDN = WS_WGU + (size_t)NL * 2 * DFF * DM * 2;
constexpr size_t WS_HF = WS_WDN + (size_t)NL * DM * DFF * 2;
constexpr size_t WS_HB = WS_HF + (size_t)MPAD * DM * 4;
constexpr size_t WS_U = WS_HB + (size_t)MPAD * DM * 2;
constexpr size_t WS_BR = WS_U + (size_t)MPAD * NINP * 2;
constexpr size_t WS_MG = WS_BR + (size_t)4 * MPAD * BW * 2;
constexpr size_t WS_MGB = WS_MG + (size_t)MPAD * DM * 4;
constexpr size_t WS_Y = WS_MGB + (size_t)MPAD * DM * 2;
constexpr size_t WS_X1F = WS_Y + (size_t)MPAD * DM * 4;
constexpr size_t WS_X1B = WS_X1F + (size_t)MPAD * DM * 4;
constexpr size_t WS_ACT = WS_X1B + (size_t)MPAD * DM * 2;
constexpr size_t WS_MEMB = WS_ACT + (size_t)MPAD * DFF * 2;
constexpr size_t WS_MKB = WS_MEMB + (size_t)512 * DM * 2;
constexpr size_t WS_MVT = WS_MKB + (size_t)NL * 512 * 1024 * 2;
constexpr size_t WS_SC = WS_MVT + (size_t)NL * 8 * 256 * 256 * 2;
constexpr size_t WS_PB = WS_SC + (size_t)8 * 4096 * 256 * 4;
constexpr size_t WS_RW = WS_PB + (size_t)8 * 4096 * 256 * 2;
constexpr size_t RW_ARR = (size_t)MPAD * BW * 4;
constexpr int GL_NCH = 512 + 128;
constexpr size_t WS_GLQD = WS_RW + 8 * RW_ARR;
constexpr size_t WS_GLKH = WS_GLQD + (size_t)GL_NCH * 8192 * 2;
constexpr size_t WS_GLE = WS_GLKH + (size_t)GL_NCH * 8192 * 2;
constexpr size_t WS_GLVT = WS_GLE + (size_t)GL_NCH * 4096 * 2;
constexpr size_t WS_GLGC = WS_GLVT + (size_t)GL_NCH * 16384 * 2;
constexpr int RB_NCH = PB * 16 * 256 + SB * 16;
constexpr int RB_EL = 9216;
constexpr int RB_QP = 4608, RB_KHP = 5760, RB_VT = 7296, RB_EP = 8832;
constexpr size_t WS_RB = WS_GLGC + (size_t)GL_NCH * 128 * 4;
constexpr size_t WS_RAW = WS_RB + (size_t)RB_NCH * RB_EL * 2;
constexpr size_t WS_LRW = WS_RAW + (size_t)2 * MPAD * BW * 2;
constexpr size_t WS_END = WS_LRW + (size_t)NL * 16 * 64 * 256 * 2;

__device__ __forceinline__ float bf2f(bf16_t b) { return __uint_as_float(((unsigned)b) << 16); }
typedef __bf16 bf16v2_t __attribute__((ext_vector_type(2)));
__device__ __forceinline__ unsigned pk2(float lo, float hi) { const f32x2 v = {lo, hi}; return __builtin_bit_cast(unsigned, __builtin_convertvector(v, bf16v2_t)); }
__device__ __forceinline__ bf16_t f2bf(float f) { return (bf16_t)(pk2(f, 0.f) & 0xffffu); }
__device__ __forceinline__ f32x4 ld4bf(const bf16_t* p) { const u32x2 w = *(const u32x2*)p; return (f32x4){__uint_as_float(w.x << 16), __uint_as_float(w.x & 0xffff0000u), __uint_as_float(w.y << 16), __uint_as_float(w.y & 0xffff0000u)}; }
__device__ __forceinline__ float wave_sum(float v) {
#pragma unroll
    for (int o = 32; o > 0; o >>= 1) v += __shfl_xor(v, o, 64);
    return v;
}
__device__ __forceinline__ float wave_max(float v) {
#pragma unroll
    for (int o = 32; o > 0; o >>= 1) v = fmaxf(v, __shfl_xor(v, o, 64));
    return v;
}
__device__ __forceinline__ float sigmoidf_(float x) { return 1.0f / (1.0f + __expf(-x)); }
__device__ __forceinline__ void unpack8(const u32x4 w, float (&x)[8]) {
    x[0] = __uint_as_float(w.x << 16); x[1] = __uint_as_float(w.x & 0xffff0000u); x[2] = __uint_as_float(w.y << 16); x[3] = __uint_as_float(w.y & 0xffff0000u);
    x[4] = __uint_as_float(w.z << 16); x[5] = __uint_as_float(w.z & 0xffff0000u); x[6] = __uint_as_float(w.w << 16); x[7] = __uint_as_float(w.w & 0xffff0000u);
}
__device__ __forceinline__ float softplusf_(float x) { return fmaxf(x, 0.f) + log1pf(__expf(-fabsf(x))); }
__device__ __forceinline__ float softplus_fast(float x) { return fmaxf(x, 0.f) + __logf(1.0f + __expf(-fabsf(x))); }
__device__ __forceinline__ float tanh_fast(float x) { return 1.0f - 2.0f / (1.0f + __expf(2.0f * x)); }

namespace pg8 {
constexpr int BM = 256, BK = 64, HALF = 128, HTB = HALF * BK * 2, STAGE_BYTES = 8 * HTB, NXCD = 8, WGM = 8;
__host__ __device__ __forceinline__ int lds_byte(int r, int c) { const int st = (r >> 4) * 2 + (c >> 5), rr = r & 15, cc = c & 31, ob = rr * 64 + cc * 2; return st * 1024 + (ob ^ (((ob >> 9) & 1) << 5)); }
__host__ __device__ __forceinline__ void stage_rc(int b, int& R, int& C) { const int st = b / 1024, sb = b % 1024, swz = sb ^ (((sb >> 9) & 1) << 5); R = (st >> 1) * 16 + swz / 64; C = (st & 1) * 32 + (swz % 64) / 2; }
__host__ __device__ __forceinline__ int perm32(int rho) { const int n = rho >> 4, i = rho & 15; return 8 * (i >> 2) + 4 * n + (i & 3); }

struct Unit { int pm, pn, z; };
template <int LDA_, int LDB_, int K_, int NM_, int NN_, int NZ_ = 1, int NZH_ = 1, bool ZINNER_ = false, long ZSAB_ = 0, long ZSAH_ = 0, long ZSBB_ = 0, long ZSBH_ = 0>
struct Gemm {
    static constexpr int LDA = LDA_, LDB = LDB_, K = K_, NM = NM_, NN = NN_, NZ = NZ_, NZH = NZH_; static constexpr bool ZINNER = ZINNER_;
    const bf16_t* A; const bf16_t* B; int G, c;
    __device__ __forceinline__ bool next(int i, Unit& u) const {
        constexpr int nt = NM * NN; int L, z;
        if (ZINNER) { const int it = i / NZ; z = i - it * NZ; const long LL = (long)it * G + c; if (LL >= nt) return false; L = (int)LL; }
        else { const long LL = (long)i * G + c; if (LL >= (long)nt * NZ) return false; z = (int)(LL / nt); L = (int)(LL - (long)z * nt); }
        int wgid = L; { constexpr int q = nt / NXCD, r = nt % NXCD; const int xcd = wgid % NXCD, off = wgid / NXCD; wgid = (xcd < r ? xcd * (q + 1) : r * (q + 1) + (xcd - r) * q) + off; }
        constexpr int nig = WGM * NN; const int gid = wgid / nig, fm = gid * WGM, gsz = (NM - fm) < WGM ? (NM - fm) : WGM;
        u.pm = fm + ((wgid % nig) % gsz); u.pn = (wgid % nig) / gsz; u.z = z; return true;
    }
    __device__ __forceinline__ const char* a_base(const Unit& u) const { const int zb = u.z / NZH, zh = u.z - zb * NZH; return (const char*)(A + zb * ZSAB_ + zh * ZSAH_ + (long)u.pm * BM * LDA); }
    __device__ __forceinline__ const char* b_base(const Unit& u) const { const int zb = u.z / NZH, zh = u.z - zb * NZH; return (const char*)(B + zb * ZSBB_ + zh * ZSBH_ + (long)u.pn * BM * LDB); }
};

template <class GT, class Epi, bool ALIGN_EPI = true, bool SP2 = true>
__device__ __forceinline__ void gemm_phase(LAS unsigned char* lds, const int tid, const GT& g, const Epi& E) {
    const int wid = __builtin_amdgcn_readfirstlane(tid >> 6), lane = tid & 63, wr = wid >> 2, wc = wid & 3, fr = lane & 15, fq = lane >> 4;
    constexpr int nt = GT::K / BK;
    unsigned voffA[2], voffB[2];
#pragma unroll
    for (int i = 0; i < 2; ++i) { int R, C; stage_rc(tid * 16 + i * 8192, R, C); const int Rb = Epi::PERM ? ((R & ~31) + perm32(R & 31)) : R;
        voffA[i] = (unsigned)(R * GT::LDA + C) * 2u; voffB[i] = (unsigned)(Rb * GT::LDB + C) * 2u; }
    constexpr size_t kstep = (size_t)(BK * 2);
    constexpr size_t hstepA = (size_t)HALF * GT::LDA * 2, hstepB = (size_t)HALF * GT::LDB * 2;
    const unsigned ldsw = (unsigned)wid * 1024u;
    const int aoff = lds_byte(wr * 64 + fr, fq * 8), boff = lds_byte(wc * 32 + fr, fq * 8);
#define PG8_SA(b, h) (((b) * 2 + (h)) * HTB)
#define PG8_SB(b, h) ((4 + (b) * 2 + (h)) * HTB)
#define PG8_STAGE(bufoff, gbase, voff) do { _Pragma("unroll") for (int _i = 0; _i < 2; ++_i) \
        __builtin_amdgcn_global_load_lds((const unsigned*)((const char*)(gbase) + (voff)[_i]), (LAS unsigned*)(lds + (bufoff) + ldsw + _i * 8192), 16, 0, 0); } while (0)
#define PG8_LDA(dst, b, h) do { _Pragma("unroll") for (int m = 0; m < 4; ++m) _Pragma("unroll") for (int k = 0; k < 2; ++k) dst[m][k] = *(const LAS bf16x8*)(lds + PG8_SA(b, h) + aoff + m * 2048 + k * 1024); } while (0)
#define PG8_LDB(dst, b, h) do { _Pragma("unroll") for (int n = 0; n < 2; ++n) _Pragma("unroll") for (int k = 0; k < 2; ++k) dst[n][k] = *(const LAS bf16x8*)(lds + PG8_SB(b, h) + boff + n * 2048 + k * 1024); } while (0)
#define PG8_MMA(ai, bj, At, Bt) do { __builtin_amdgcn_s_setprio(1); _Pragma("unroll") for (int m = 0; m < 4; ++m) _Pragma("unroll") for (int n = 0; n < 2; ++n) _Pragma("unroll") for (int k = 0; k < 2; ++k) \
        acc[ai][bj][m][n] = __builtin_amdgcn_mfma_f32_16x16x32_bf16(Bt[n][k], At[m][k], acc[ai][bj][m][n], 0, 0, 0); __builtin_amdgcn_s_setprio(0); } while (0)
#define PG8_WAIT_V(n) asm volatile("s_waitcnt vmcnt(" #n ")" ::: "memory")
#define PG8_WAIT_L(n) asm volatile("s_waitcnt lgkmcnt(" #n ")" ::: "memory")
#define PG8_BAR __builtin_amdgcn_s_barrier()
#define PG8_SCHED __builtin_amdgcn_sched_barrier(0)
    Unit cur, nxt; int ui = 0;
    if (!g.next(0, cur)) return;
    f32x4 acc[2][2][4][2];
#pragma unroll
    for (int a = 0; a < 2; ++a)
#pragma unroll
        for (int b = 0; b < 2; ++b)
#pragma unroll
            for (int m = 0; m < 4; ++m)
#pragma unroll
                for (int n = 0; n < 2; ++n) acc[a][b][m][n] = (f32x4){0.f, 0.f, 0.f, 0.f};
    bf16x8 At[4][2], B0[2][2], B1[2][2];
    const char* cA = g.a_base(cur); const char* cB = g.b_base(cur);
    if constexpr (SP2) {
        PG8_STAGE(PG8_SB(0, 0), cB, voffB); PG8_STAGE(PG8_SB(0, 1), cB + hstepB, voffB); PG8_STAGE(PG8_SA(0, 0), cA, voffA); PG8_STAGE(PG8_SA(0, 1), cA + hstepA, voffA);
        if (wr == 1) PG8_BAR;
        PG8_WAIT_V(2); PG8_BAR;
        PG8_STAGE(PG8_SB(1, 0), cB + kstep, voffB); PG8_STAGE(PG8_SA(1, 0), cA + kstep, voffA); PG8_STAGE(PG8_SB(1, 1), cB + hstepB + kstep, voffB);
        PG8_WAIT_V(6); PG8_BAR;
    } else {
        PG8_STAGE(PG8_SB(0, 0), cB, voffB); PG8_STAGE(PG8_SA(0, 0), cA, voffA); PG8_STAGE(PG8_SB(0, 1), cB + hstepB, voffB); PG8_STAGE(PG8_SA(0, 1), cA + hstepA, voffA);
        if (wr == 1) PG8_BAR;
        PG8_WAIT_V(4); PG8_BAR;
        PG8_STAGE(PG8_SB(1, 0), cB + kstep, voffB); PG8_STAGE(PG8_SA(1, 0), cA + kstep, voffA); PG8_STAGE(PG8_SB(1, 1), cB + hstepB + kstep, voffB);
        PG8_WAIT_V(6); PG8_BAR;
    }
    for (;;) {
        const bool has_next = g.next(ui + 1, nxt);
        const char* nA = has_next ? g.a_base(nxt) : cA; const char* nB = has_next ? g.b_base(nxt) : cB;
#pragma unroll 1
        for (int t = 0; t < nt; t += 2) {
            const bool last = (t == nt - 2);
            const char* a1 = cA + (size_t)(t + 1) * kstep;
            const char* a2 = last ? nA : cA + (size_t)(t + 2) * kstep; const char* b2 = last ? nB : cB + (size_t)(t + 2) * kstep;
            const char* a3 = a2 + kstep; const char* b3 = b2 + kstep;
            if constexpr (SP2) {
            PG8_LDB(B0, 0, 0); PG8_LDB(B1, 0, 1); PG8_SCHED; PG8_LDA(At, 0, 0); PG8_STAGE(PG8_SA(1, 1), a1 + hstepA, voffA);
            PG8_WAIT_V(8); PG8_WAIT_L(0); PG8_BAR; PG8_MMA(0, 0, At, B0); PG8_MMA(0, 1, At, B1); PG8_BAR; PG8_SCHED;
            PG8_LDA(At, 0, 1); PG8_STAGE(PG8_SB(0, 0), b2, voffB); PG8_STAGE(PG8_SB(0, 1), b2 + hstepB, voffB); PG8_STAGE(PG8_SA(0, 0), a2, voffA);
            PG8_WAIT_V(8); PG8_WAIT_L(0); PG8_BAR; PG8_MMA(1, 0, At, B0); PG8_MMA(1, 1, At, B1); PG8_BAR; PG8_SCHED;
            PG8_LDB(B0, 1, 0); PG8_LDB(B1, 1, 1); PG8_SCHED; PG8_LDA(At, 1, 0); PG8_STAGE(PG8_SA(0, 1), a2 + hstepA, voffA);
            PG8_WAIT_V(8); PG8_WAIT_L(0); PG8_BAR; PG8_MMA(0, 0, At, B0); PG8_MMA(0, 1, At, B1); PG8_BAR; PG8_SCHED;
            PG8_LDA(At, 1, 1); PG8_STAGE(PG8_SB(1, 0), b3, voffB); PG8_STAGE(PG8_SB(1, 1), b3 + hstepB, voffB); PG8_STAGE(PG8_SA(1, 0), a3, voffA);
            PG8_WAIT_V(8); PG8_WAIT_L(0); PG8_BAR; PG8_MMA(1, 0, At, B0); PG8_MMA(1, 1, At, B1); PG8_BAR; PG8_SCHED;
            } else {
            PG8_LDB(B0, 0, 0); PG8_SCHED; PG8_LDA(At, 0, 0); PG8_STAGE(PG8_SA(1, 1), a1 + hstepA, voffA);
            PG8_WAIT_L(8); PG8_BAR; PG8_WAIT_L(0); PG8_MMA(0, 0, At, B0); PG8_BAR; PG8_SCHED;
            PG8_LDB(B1, 0, 1); PG8_STAGE(PG8_SB(0, 0), b2, voffB);
            PG8_BAR; PG8_WAIT_L(0); PG8_MMA(0, 1, At, B1); PG8_BAR;
            PG8_LDA(At, 0, 1); PG8_STAGE(PG8_SA(0, 0), a2, voffA);
            PG8_BAR; PG8_WAIT_L(0); PG8_MMA(1, 0, At, B0); PG8_BAR; PG8_SCHED;
            PG8_STAGE(PG8_SB(0, 1), b2 + hstepB, voffB);
            PG8_WAIT_V(6); PG8_BAR; PG8_MMA(1, 1, At, B1); PG8_BAR;
            PG8_LDB(B0, 1, 0); PG8_SCHED; PG8_LDA(At, 1, 0); PG8_STAGE(PG8_SA(0, 1), a2 + hstepA, voffA);
            PG8_WAIT_L(8); PG8_BAR; PG8_WAIT_L(0); PG8_MMA(0, 0, At, B0); PG8_BAR; PG8_SCHED;
            PG8_LDB(B1, 1, 1); PG8_STAGE(PG8_SB(1, 0), b3, voffB);
            PG8_BAR; PG8_WAIT_L(0); PG8_MMA(0, 1, At, B1); PG8_BAR;
            PG8_LDA(At, 1, 1); PG8_STAGE(PG8_SA(1, 0), a3, voffA);
            PG8_BAR; PG8_WAIT_L(0); PG8_MMA(1, 0, At, B0); PG8_BAR; PG8_SCHED;
            PG8_STAGE(PG8_SB(1, 1), b3 + hstepB, voffB);
            PG8_WAIT_V(6); PG8_BAR; PG8_MMA(1, 1, At, B1); PG8_BAR;
            }
        }
        if constexpr (ALIGN_EPI) { if (wr == 0) PG8_BAR; }
        E(acc, cur, wr, wc, fr, fq);
        if (!has_next) break;
#pragma unroll
        for (int a = 0; a < 2; ++a)
#pragma unroll
            for (int b = 0; b < 2; ++b)
#pragma unroll
                for (int m = 0; m < 4; ++m)
#pragma unroll
                    for (int n = 0; n < 2; ++n) acc[a][b][m][n] = (f32x4){0.f, 0.f, 0.f, 0.f};
        cur = nxt; cA = nA; cB = nB; ++ui;
        if constexpr (ALIGN_EPI) { if (wr == 1) PG8_BAR; }
    }
    PG8_WAIT_V(0);
    if constexpr (!ALIGN_EPI) { if (wr == 0) PG8_BAR; }
    PG8_BAR;
#undef PG8_SA
#undef PG8_SB
#undef PG8_STAGE
#undef PG8_LDA
#undef PG8_LDB
#undef PG8_MMA
#undef PG8_WAIT_V
#undef PG8_WAIT_L
#undef PG8_BAR
#undef PG8_SCHED
}

struct EpiBf16 {
    static constexpr bool PERM = true;
    bf16_t* O; long zs; int ldc, pad;
    __device__ __forceinline__ void operator()(const f32x4 (&acc)[2][2][4][2], const Unit& u, int wr, int wc, int fr, int fq) const {
        const int row0 = u.pm * BM + wr * 64 + fr, col0 = u.pn * BM + wc * 32 + 8 * fq; bf16_t* base = O + (long)u.z * zs;
#pragma unroll
        for (int ai = 0; ai < 2; ++ai)
#pragma unroll
            for (int m = 0; m < 4; ++m) { bf16_t* rowp = base + (size_t)(row0 + ai * HALF + m * 16) * ldc + col0;
#pragma unroll
                for (int bj = 0; bj < 2; ++bj) { const f32x4 v0 = acc[ai][bj][m][0], v1 = acc[ai][bj][m][1];
                    u32x4 w; w.x = pk2(v0[0], v0[1]); w.y = pk2(v0[2], v0[3]); w.z = pk2(v1[0], v1[1]); w.w = pk2(v1[2], v1[3]);
                    *(u32x4*)(rowp + bj * HALF) = w; } }
    }
};
struct EpiMem {
    static constexpr bool PERM = false;
    float* outK; float* outV; bf16_t* kb; bf16_t* vt;
    __device__ __forceinline__ void operator()(const f32x4 (&acc)[2][2][4][2], const Unit& u, int wr, int wc, int fr, int fq) const {
        const int row0 = u.pm * BM + wr * 64 + fr, col0 = u.pn * BM + wc * 32 + 4 * fq;
#pragma unroll
        for (int ai = 0; ai < 2; ++ai)
#pragma unroll
            for (int m = 0; m < 4; ++m) { const int row = row0 + ai * HALF + m * 16;
#pragma unroll
                for (int bj = 0; bj < 2; ++bj)
#pragma unroll
                    for (int n = 0; n < 2; ++n) { const int col = col0 + bj * HALF + n * 16; const f32x4 v = acc[ai][bj][m][n];
                        if (col < 1024) { *(f32x4*)(outK + ((size_t)u.z * 512 + row) * 1024 + col) = v;
                            u32x2 w; w.x = pk2(v[0], v[1]); w.y = pk2(v[2], v[3]); *(u32x2*)(kb + ((size_t)u.z * 512 + row) * 1024 + col) = w; }
                        else { const int c = col - 1024; *(f32x4*)(outV + ((size_t)u.z * 512 + row) * 1024 + c) = v;
                            const int b = row >> 8, mm = row & 255, h = c >> 8, d = c & 255; bf16_t* p = vt + ((((size_t)u.z * 2 + b) * 4 + h) * 256 + d) * 256 + mm;
                            p[0] = f2bf(v[0]); p[256] = f2bf(v[1]); p[512] = f2bf(v[2]); p[768] = f2bf(v[3]); } } }
    }
};
struct EpiMerge {
    static constexpr bool PERM = true;
    float* MG; bf16_t* MGB; const bf16_t* U; const float* gate_b;
    __device__ __forceinline__ void operator()(const f32x4 (&acc)[2][2][4][2], const Unit& u, int wr, int wc, int fr, int fq) const {
        const int row0 = u.pm * BM + wr * 64 + fr, col0 = u.pn * BM + wc * 32 + 8 * fq;
#pragma unroll
        for (int bj = 0; bj < 2; ++bj) { const int col = col0 + bj * HALF; const f32x4 gb0 = *(const f32x4*)(gate_b + u.z * DM + col), gb1 = *(const f32x4*)(gate_b + u.z * DM + col + 4);
#pragma unroll
            for (int ai = 0; ai < 2; ++ai)
#pragma unroll
                for (int m = 0; m < 4; ++m) { const int row = row0 + ai * HALF + m * 16; float gp[8], r[8];
                    unpack8(*(const u32x4*)(U + (size_t)row * NINP + U_GP + u.z * DM + col), gp);
#pragma unroll
                    for (int j = 0; j < 4; ++j) { r[j] = sigmoidf_(gp[j] + gb0[j]) * acc[ai][bj][m][0][j]; r[4 + j] = sigmoidf_(gp[4 + j] + gb1[j]) * acc[ai][bj][m][1][j]; }
                    bf16_t* mp = MGB + (size_t)row * DM + col;
                    if (u.z > 0) { float pv[8]; unpack8(*(const u32x4*)mp, pv);
#pragma unroll
                        for (int j = 0; j < 8; ++j) r[j] += pv[j]; }
                    *(u32x4*)mp = (u32x4){pk2(r[0], r[1]), pk2(r[2], r[3]), pk2(r[4], r[5]), pk2(r[6], r[7])}; } }
    }
};
struct EpiRes {
    static constexpr bool PERM = true;
    const bf16_t* R; bf16_t* Y;
    __device__ __forceinline__ void operator()(const f32x4 (&acc)[2][2][4][2], const Unit& u, int wr, int wc, int fr, int fq) const {
        const int row0 = u.pm * BM + wr * 64 + fr, col0 = u.pn * BM + wc * 32 + 8 * fq;
#pragma unroll
        for (int ai = 0; ai < 2; ++ai)
#pragma unroll
            for (int m = 0; m < 4; ++m) { const size_t ro = (size_t)(row0 + ai * HALF + m * 16) * DM + col0;
#pragma unroll
                for (int bj = 0; bj < 2; ++bj) { const size_t o = ro + bj * HALF; float rv[8]; unpack8(*(const u32x4*)(R + o), rv);
                    const f32x4 y0 = (f32x4){rv[0], rv[1], rv[2], rv[3]} * ALPHA + acc[ai][bj][m][0], y1 = (f32x4){rv[4], rv[5], rv[6], rv[7]} * ALPHA + acc[ai][bj][m][1];
                    *(u32x4*)(Y + o) = (u32x4){pk2(y0[0], y0[1]), pk2(y0[2], y0[3]), pk2(y1[0], y1[1]), pk2(y1[2], y1[3])}; } }
    }
};
struct EpiSwiGLU {
    static constexpr bool PERM = true;
    bf16_t* O;
    __device__ __forceinline__ void operator()(const f32x4 (&acc)[2][2][4][2], const Unit& u, int wr, int wc, int fr, int fq) const {
        const int row0 = u.pm * BM + wr * 64 + fr, col0 = u.pn * HALF + wc * 32 + 8 * fq;
#pragma unroll
        for (int ai = 0; ai < 2; ++ai)
#pragma unroll
            for (int m = 0; m < 4; ++m) { bf16_t* rowp = O + (size_t)(row0 + ai * HALF + m * 16) * DFF + col0;
                float r[8];
#pragma unroll
                for (int n = 0; n < 2; ++n)
#pragma unroll
                    for (int j = 0; j < 4; ++j) { const float gg = acc[ai][0][m][n][j], uu = acc[ai][1][m][n][j]; r[n * 4 + j] = gg * sigmoidf_(gg) * uu; }
                u32x4 w; w.x = pk2(r[0], r[1]); w.y = pk2(r[2], r[3]); w.z = pk2(r[4], r[5]); w.w = pk2(r[6], r[7]);
                *(u32x4*)rowp = w; }
    }
};
struct EpiScore {
    static constexpr bool PERM = false;
    float* SC;
    __device__ __forceinline__ void operator()(const f32x4 (&acc)[2][2][4][2], const Unit& u, int wr, int wc, int fr, int fq) const {
        const int row0 = u.pm * BM + wr * 64 + fr, col0 = wc * 32 + 4 * fq; float* base = SC + (size_t)u.z * 4096 * 256;
#pragma unroll
        for (int ai = 0; ai < 2; ++ai)
#pragma unroll
            for (int m = 0; m < 4; ++m) { float* rowp = base + (size_t)(row0 + ai * HALF + m * 16) * 256 + col0;
#pragma unroll
                for (int bj = 0; bj < 2; ++bj)
#pragma unroll
                    for (int n = 0; n < 2; ++n) *(f32x4*)(rowp + bj * HALF + n * 16) = acc[ai][bj][m][n] * 0.0625f; }
    }
};
struct EpiPV {
    static constexpr bool PERM = true;
    bf16_t* O;
    __device__ __forceinline__ void operator()(const f32x4 (&acc)[2][2][4][2], const Unit& u, int wr, int wc, int fr, int fq) const {
        const int b = u.z >> 2, h = u.z & 3; const int row0 = b * PS + u.pm * BM + wr * 64 + fr, col0 = h * 256 + wc * 32 + 8 * fq;
#pragma unroll
        for (int ai = 0; ai < 2; ++ai)
#pragma unroll
            for (int m = 0; m < 4; ++m) { bf16_t* rowp = O + (size_t)(row0 + ai * HALF + m * 16) * BW + col0;
#pragma unroll
                for (int bj = 0; bj < 2; ++bj) { const f32x4 v0 = acc[ai][bj][m][0], v1 = acc[ai][bj][m][1];
                    u32x4 w; w.x = pk2(v0[0], v0[1]); w.y = pk2(v0[2], v0[3]); w.z = pk2(v1[0], v1[1]); w.w = pk2(v1[2], v1[3]);
                    *(u32x4*)(rowp + bj * HALF) = w; } }
    }
};
}


#define XB_TMO      128
#define XB_XCNT(j)  (256  + 64 * (j))
#define XB_XSUB(j)  (1280 + 64 * (j))
#define XB_XGEN(j)  (2304 + 64 * (j))
#define XB_TOP      3328
#define XB_TOPGEN   3392
#define XCD_BAR_WORDS 3456
#define XB_SPIN_CAP (1u << 18)
__device__ __forceinline__ unsigned xb_ld(unsigned* p)              { return __hip_atomic_load(p, __ATOMIC_RELAXED, __HIP_MEMORY_SCOPE_AGENT); }
__device__ __forceinline__ unsigned xb_add(unsigned* p, unsigned v) { return __hip_atomic_fetch_add(p, v, __ATOMIC_RELAXED, __HIP_MEMORY_SCOPE_AGENT); }
__device__ __forceinline__ unsigned xb_xcc_id() { return (unsigned)__builtin_amdgcn_s_getreg((3 << 11) | 20) & 0xFu; }
#define XB_SPIN(cond, bar) do { unsigned _sp = 0; while (cond) { __builtin_amdgcn_s_sleep(1); \
    if ((++_sp & 255u) == 0u) { if (xb_ld(&(bar)[XB_TMO])) break; if (_sp > XB_SPIN_CAP) { atomicAdd(&(bar)[XB_TMO], 1u); break; } } } } while (0)
struct XcdBarrier { unsigned* bar; unsigned x; volatile LAS unsigned* st; };
__device__ __forceinline__ XcdBarrier xcd_barrier_post(unsigned* bar, volatile LAS unsigned* st) {
    XcdBarrier b; b.bar = bar; b.x = xb_xcc_id(); b.st = st;
    if (threadIdx.x == 0) (void)xb_add(&bar[XB_XCNT(b.x)], 1u);
    return b;
}
__device__ __forceinline__ void xcd_barrier_complete(unsigned* bar, unsigned x, unsigned& nloc, unsigned& nx) {
    const unsigned G = gridDim.x * gridDim.y * gridDim.z;
    unsigned sum, cnt, mine, sp = 0u;
    for (;;) {
        sum = 0u; cnt = 0u; mine = 0u;
#pragma unroll
        for (unsigned j = 0; j < 16; ++j) { const unsigned c = xb_ld(&bar[XB_XCNT(j)]); sum += c; cnt += (c > 0u) ? 1u : 0u; mine = (j == x) ? c : mine; }
        if (sum == G) break;
        __builtin_amdgcn_s_sleep(1);
        if ((++sp & 255u) == 0u) { if (xb_ld(&bar[XB_TMO])) break; if (sp > XB_SPIN_CAP) { atomicAdd(&bar[XB_TMO], 1u); break; } }
    }
    nloc = mine > 0u ? mine : 1u; nx = cnt > 0u ? cnt : 1u;
}
__device__ __forceinline__ void xcd_barrier(const XcdBarrier& b) {
    asm volatile("s_waitcnt vmcnt(0)" ::: "memory");
    __syncthreads();
    if (threadIdx.x == 0) {
        unsigned* bar = b.bar;
        __builtin_amdgcn_s_waitcnt(0);
        unsigned nloc = b.st[0], nx = b.st[1];
        if (nloc == 0u) { xcd_barrier_complete(bar, b.x, nloc, nx); b.st[0] = nloc; b.st[1] = nx; }
        const unsigned old = xb_add(&bar[XB_XSUB(b.x)], 1u);
        const unsigned gen = old / nloc;
        if (old + 1u == (gen + 1u) * nloc) {
            __builtin_amdgcn_fence(__ATOMIC_RELEASE, "agent");
            asm volatile("s_waitcnt vmcnt(0)" ::: "memory");
            const unsigned og = xb_add(&bar[XB_TOP], 1u);
            const unsigned tg = og / nx;
            if (og + 1u == (tg + 1u) * nx) xb_add(&bar[XB_TOPGEN], 1u);
            else XB_SPIN(xb_ld(&bar[XB_TOPGEN]) == tg, bar);
            __builtin_amdgcn_fence(__ATOMIC_ACQUIRE, "agent");
            xb_add(&bar[XB_XGEN(b.x)], 1u);
            asm volatile("s_waitcnt vmcnt(0)" ::: "memory");
        } else {
            XB_SPIN(xb_ld(&bar[XB_XGEN(b.x)]) == gen, bar);
            __builtin_amdgcn_fence(__ATOMIC_ACQUIRE, "agent");
            asm volatile("s_waitcnt vmcnt(0)" ::: "memory");
        }
    }
    __syncthreads();
}

struct Ctx { int tid, lane, wave, bid, G; LAS unsigned char* lds; };
__device__ __forceinline__ Ctx fresh(const Ctx& c0) { Ctx c; c.wave = c0.wave; c.bid = c0.bid; c.G = c0.G; c.lds = c0.lds; asm volatile("" : "+s"(c.bid), "+s"(c.G), "+s"(c.wave));
    int lane = (int)__builtin_amdgcn_mbcnt_hi(~0u, __builtin_amdgcn_mbcnt_lo(~0u, 0u)); asm volatile("" : "+v"(lane)); c.lane = lane; c.tid = c.wave * 64 + lane; return c; }

__device__ __forceinline__ int colmap(int mode, int n) {
    if (mode == 1) return n < 3088 ? n : (n < 3328 ? -1 : n - 240);
    if (mode == 2) { const int t = n >> 8, j = n & 255; return j < 128 ? t * 128 + j : DFF + t * 128 + (j - 128); }
    return n;
}
__device__ __forceinline__ void wprep_load(f32x4 (&rg)[8], const float* __restrict__ src, int K, int Nsrc, int Ndst, int mode, size_t sbs, int item, int tid) {
    const int nx = Ndst / 256, ny = K / 64; const int bx = item % nx, by = (item / nx) % ny, bz = item / (nx * ny);
    const int tx = tid & 63, ty = tid >> 6, cm = colmap(mode, bx * 256 + tx * 4); const float* s = src + (size_t)bz * sbs + (size_t)(by * 64 + ty) * Nsrc + cm;
#pragma unroll
    for (int i = 0; i < 8; ++i) rg[i] = cm >= 0 ? *(const f32x4*)(s + (size_t)(8 * i) * Nsrc) : (f32x4){0.f, 0.f, 0.f, 0.f};
}
__device__ __forceinline__ void ph_wprep(const Ctx& c, const float* __restrict__ src, bf16_t* __restrict__ dst, int K, int Nsrc, int Ndst, int mode, int nbatch, size_t sbs, size_t dbs) {
    LAS float* tile = (LAS float*)c.lds;
    const int nx = Ndst / 256, ny = K / 64, total = nx * ny * nbatch;
    const int tid = c.tid, tx = tid & 63, ty = tid >> 6, n = tid >> 1, kh = tid & 1;
    f32x4 rg[8];
    int item = c.bid;
    if (item < total) wprep_load(rg, src, K, Nsrc, Ndst, mode, sbs, item, tid);
    for (; item < total; item += c.G) {
        __syncthreads();
#pragma unroll
        for (int i = 0; i < 8; ++i) *(LAS f32x4*)(tile + (ty + 8 * i) * 260 + tx * 4) = rg[i];
        __syncthreads();
        const int bx = item % nx, by = (item / nx) % ny, bz = item / (nx * ny);
        if (item + c.G < total) wprep_load(rg, src, K, Nsrc, Ndst, mode, sbs, item + c.G, tid);
        bf16_t* d = dst + (size_t)bz * dbs + (size_t)(bx * 256 + n) * K + by * 64 + kh * 32;
#pragma unroll
        for (int g = 0; g < 4; ++g) { unsigned p[4];
#pragma unroll
            for (int e = 0; e < 4; ++e) p[e] = pk2(tile[(kh * 32 + g * 8 + 2 * e) * 260 + n], tile[(kh * 32 + g * 8 + 2 * e + 1) * 260 + n]);
            *(u32x4*)(d + g * 8) = (u32x4){p[0], p[1], p[2], p[3]}; }
    }
    __syncthreads();
}
__device__ __forceinline__ void ph_xprep(const Ctx& c, const float* __restrict__ xp, const float* __restrict__ xs, const float* __restrict__ mem, float* __restrict__ HF, bf16_t* __restrict__ HB, bf16_t* __restrict__ MEMB) {
    const size_t nH = (size_t)MPAD * DM / 4, nM = (size_t)512 * DM / 4;
    for (size_t i4 = (size_t)c.bid * 512 + c.tid; i4 < nH + nM; i4 += (size_t)c.G * 512) {
        if (i4 < nH) {
            const size_t e = i4 * 4; f32x4 v = (f32x4){0.f, 0.f, 0.f, 0.f};
            if (e < (size_t)MP * DM) v = *(const f32x4*)(xp + e); else if (e < (size_t)MT * DM) v = *(const f32x4*)(xs + (e - (size_t)MP * DM));
            if (HF != nullptr) *(f32x4*)(HF + e) = v;
            u32x2 w; w.x = pk2(v[0], v[1]); w.y = pk2(v[2], v[3]); *(u32x2*)(HB + e) = w;
        } else {
            const size_t e = (i4 - nH) * 4; const f32x4 v = *(const f32x4*)(mem + e); u32x2 w; w.x = pk2(v[0], v[1]); w.y = pk2(v[2], v[3]); *(u32x2*)(MEMB + e) = w;
        }
    }
}
__device__ __forceinline__ void ph_ln(const Ctx& c, const bf16_t* __restrict__ Y, const float* __restrict__ g, const float* __restrict__ b, float* __restrict__ XF, bf16_t* __restrict__ XB, float* __restrict__ OUT, int nrows, int nout) {
    const int lane = c.lane;
    for (int row = c.bid * 8 + c.wave; row < nrows; row += c.G * 8) {
        const bf16_t* y = Y + (size_t)row * DM; float v[4][8]; float s = 0.f;
#pragma unroll
        for (int j = 0; j < 4; ++j) { unpack8(*(const u32x4*)(y + j * 512 + lane * 8), v[j]);
#pragma unroll
            for (int e2 = 0; e2 < 8; ++e2) s += v[j][e2]; }
        const float mean = wave_sum(s) * (1.0f / DM); float q = 0.f;
#pragma unroll
        for (int j = 0; j < 4; ++j)
#pragma unroll
            for (int e2 = 0; e2 < 8; ++e2) { const float d = v[j][e2] - mean; q += d * d; }
        const float rstd = rsqrtf(wave_sum(q) * (1.0f / DM) + 1e-5f);
#pragma unroll
        for (int j = 0; j < 4; ++j) { const int cc = j * 512 + lane * 8; const f32x4 g0 = *(const f32x4*)(g + cc), g1 = *(const f32x4*)(g + cc + 4), b0 = *(const f32x4*)(b + cc), b1 = *(const f32x4*)(b + cc + 4);
            const f32x4 o0 = ((f32x4){v[j][0], v[j][1], v[j][2], v[j][3]} - mean) * rstd * g0 + b0, o1 = ((f32x4){v[j][4], v[j][5], v[j][6], v[j][7]} - mean) * rstd * g1 + b1;
            const size_t off = (size_t)row * DM + cc;
            if (XF != nullptr) { *(f32x4*)(XF + off) = o0; *(f32x4*)(XF + off + 4) = o1; }
            *(u32x4*)(XB + off) = (u32x4){pk2(o0[0], o0[1]), pk2(o0[2], o0[3]), pk2(o1[0], o1[1]), pk2(o1[2], o1[3])};
            if (OUT != nullptr && row < nout) { *(f32x4*)(OUT + off) = o0; *(f32x4*)(OUT + off + 4) = o1; } }
    }
}
__device__ __forceinline__ void ph_softmax256(const Ctx& c, const float* __restrict__ SC, bf16_t* __restrict__ P, int nrows) {
    const int lane = c.lane;
    for (int row = c.bid * 8 + c.wave; row < nrows; row += c.G * 8) {
        const f32x4 v = *(const f32x4*)(SC + (size_t)row * 256 + lane * 4);
        const float mx = wave_max(fmaxf(fmaxf(v[0], v[1]), fmaxf(v[2], v[3])));
        f32x4 e; e[0] = __expf(v[0] - mx); e[1] = __expf(v[1] - mx); e[2] = __expf(v[2] - mx); e[3] = __expf(v[3] - mx);
        const float inv = 1.0f / wave_sum((e[0] + e[1]) + (e[2] + e[3]));
        u32x2 w; w.x = pk2(e[0] * inv, e[1] * inv); w.y = pk2(e[2] * inv, e[3] * inv); *(u32x2*)(P + (size_t)row * 256 + lane * 4) = w;
    }
}
__device__ __forceinline__ void ph_copy_outs(const Ctx& c, const bf16_t* __restrict__ U, const float* __restrict__ ck, const float* __restrict__ cv, float* __restrict__ out, int layer) {
    constexpr int nA = PB * 128 * 128, nB = SB * 128 * 128, nC = PB * RWC, nD = SB * RWC;
    for (int i = c.bid * 512 + c.tid; i < nA + nB + nC + nD; i += c.G * 512) {
        if (i < nA) { const int b = i / 16384, j = (i >> 7) & 127, cc = i & 127; const size_t ur = (size_t)(b * PS + PS - 128 + j) * NINP;
            out[O_SWKP + (size_t)layer * nA + i] = bf2f(U[ur + U_SK + cc]); out[O_SWVP + (size_t)layer * nA + i] = bf2f(U[ur + U_SV + cc]); continue; }
        int k = i - nA;
        if (k < nB) { const int sq = k / 16384, j = (k >> 7) & 127, cc = k & 127; float kv, vv;
            if (j < 124) { const size_t o = ((size_t)sq * 128 + j + 4) * 128 + cc; kv = ck[o]; vv = cv[o]; }
            else { const size_t ur = (size_t)(MP + sq * SS + j - 124) * NINP; kv = bf2f(U[ur + U_SK + cc]); vv = bf2f(U[ur + U_SV + cc]); }
            out[O_SWKS + (size_t)layer * nB + k] = kv; out[O_SWVS + (size_t)layer * nB + k] = vv; continue; }
        k -= nB;
        if (k < nC) { const int b = k / RWC, cc = k - b * RWC; out[O_RSP + (size_t)layer * nC + k] = bf2f(U[(size_t)(b * PS + PS - 1) * NINP + U_RU + cc]); continue; }
        k -= nC;
        { const int sq = k / RWC, cc = k - sq * RWC; out[O_RSS + (size_t)layer * nD + k] = bf2f(U[(size_t)(MP + sq * SS + SS - 1) * NINP + U_RU + cc]); }
    }
}

__device__ __forceinline__ void seq_info(int sq, int& row0, int& L) { if (sq < PB) { row0 = sq * PS; L = PS; } else { row0 = MP + (sq - PB) * SS; L = SS; } }

__device__ __forceinline__ void ph_gla_naive(const Ctx& c, const bf16_t* __restrict__ U, const float* __restrict__ s0, const float* __restrict__ a_up, const float* __restrict__ a_b,
                                             const float* __restrict__ ng, const float* __restrict__ nb, bf16_t* __restrict__ OB, float* __restrict__ outP, float* __restrict__ outS) {
    LAS float* qs = (LAS float*)c.lds;
    LAS float* ks = qs + 16 * 128; LAS float* as = ks + 16 * 128; LAS float* os = as + 16 * 128;
    const int kh = c.tid >> 8, vt = c.tid & 255, lane = c.lane;
    for (int u = c.bid; u < (PB + SB) * 4; u += c.G) {
        const int sq = u >> 2, h = u & 3;
        int row0, L; seq_info(sq, row0, L);
        float S[64];
        if (sq >= PB) { const float* p = s0 + (((size_t)(sq - PB) * 4 + h) * 128 + kh * 64) * 256 + vt;
#pragma unroll
            for (int kk = 0; kk < 64; ++kk) S[kk] = p[(size_t)kk * 256]; }
        else {
#pragma unroll
            for (int kk = 0; kk < 64; ++kk) S[kk] = 0.f; }
        for (int t0 = 0; t0 < L; t0 += 16) {
            const int nT = (L - t0) < 16 ? (L - t0) : 16;
            for (int idx = c.tid; idx < nT * 128; idx += 512) {
                const int tt = idx >> 7, kk = idx & 127; const bf16_t* ur = U + (size_t)(row0 + t0 + tt) * NINP;
                qs[idx] = bf2f(ur[U_GQ + h * 128 + kk]) * 0.08838834764831845f; ks[idx] = bf2f(ur[U_GK + h * 128 + kk]);
                float x = a_b[h * 128 + kk];
#pragma unroll
                for (int r = 0; r < 16; ++r) x += bf2f(ur[U_GA + r]) * a_up[r * 512 + h * 128 + kk];
                const float ls = (fminf(x, 0.f) - log1pf(__expf(-fabsf(x)))) * (1.0f / 16.0f);
                as[idx] = __expf(ls);
            }
            __syncthreads();
            for (int tt = 0; tt < nT; ++tt) {
                const float v = bf2f(U[(size_t)(row0 + t0 + tt) * NINP + U_GV + h * 256 + vt]); float o = 0.f; const int lb = tt * 128 + kh * 64;
#pragma unroll
                for (int kk = 0; kk < 64; ++kk) { S[kk] = as[lb + kk] * S[kk] + ks[lb + kk] * v; o += qs[lb + kk] * S[kk]; }
                os[(kh * 16 + tt) * 256 + vt] = o;
            }
            __syncthreads();
            for (int tt = c.wave; tt < nT; tt += 8) {
                float x[4]; float s = 0.f;
#pragma unroll
                for (int j = 0; j < 4; ++j) { x[j] = os[tt * 256 + lane + 64 * j] + os[(16 + tt) * 256 + lane + 64 * j]; s += x[j]; }
                const float mean = wave_sum(s) * (1.0f / 256.0f); float q = 0.f;
#pragma unroll
                for (int j = 0; j < 4; ++j) { const float d = x[j] - mean; q += d * d; }
                const float rstd = rsqrtf(wave_sum(q) * (1.0f / 256.0f) + 1e-5f);
                const size_t row = (size_t)(row0 + t0 + tt);
#pragma unroll
                for (int j = 0; j < 4; ++j) { const int cc = h * 256 + lane + 64 * j; const float n = (x[j] - mean) * rstd * ng[cc] + nb[cc];
                    const float gr = bf2f(U[row * NINP + U_GR + cc]); OB[row * BW + cc] = f2bf(n * gr * sigmoidf_(gr)); }
            }
            __syncthreads();
        }
        float* op = (sq < PB ? outP + (((size_t)sq * 4 + h) * 128 + kh * 64) * 256 : outS + (((size_t)(sq - PB) * 4 + h) * 128 + kh * 64) * 256) + vt;
#pragma unroll
        for (int kk = 0; kk < 64; ++kk) op[(size_t)kk * 256] = S[kk];
    }
}

__device__ __forceinline__ f32x4 mma16(bf16x8 x, bf16x8 y, f32x4 c) { return __builtin_amdgcn_mfma_f32_16x16x32_bf16(x, y, c, 0, 0, 0); }
__device__ __forceinline__ bf16x8 pack_acc(const f32x4& a, const f32x4& b) {
    u32x4 p; p.x = pk2(a[0], a[1]); p.y = pk2(a[2], a[3]); p.z = pk2(b[0], b[1]); p.w = pk2(b[2], b[3]); return __builtin_bit_cast(bf16x8, p);
}
__device__ __forceinline__ void gla_chunk_info(int u, int& row0, int& ntok, int& h) {
    if (u < 512) { const int b = u >> 8; h = (u >> 6) & 3; row0 = b * PS + (u & 63) * 64; ntok = 64; }
    else { const int s = u - 512; h = s & 3; row0 = MP + (s >> 2) * SS; ntok = SS; }
}
__device__ __forceinline__ void ph_gla_pre(const Ctx& c, const bf16_t* __restrict__ U, const float* __restrict__ a_up, const float* __restrict__ a_b,
                                           bf16_t* __restrict__ QD, bf16_t* __restrict__ KHT, bf16_t* __restrict__ EE, bf16_t* __restrict__ VT, float* __restrict__ GC) {
    LAS float* ga_l = (LAS float*)c.lds;
    LAS float* tot = ga_l + 64 * 16;
    LAS bf16_t* Qd_l = (LAS bf16_t*)(tot + 4 * 128);
    LAS bf16_t* Kn_l = Qd_l + 64 * 136;
    LAS bf16_t* v_l = Kn_l + 64 * 136;
    LAS bf16_t* qr_l = v_l + 64 * 264;
    LAS bf16_t* kr_l = qr_l + 64 * 136;
    const int tid = c.tid, lane = c.lane, r = lane & 15, q = lane >> 4, w = c.wave;
    for (int u = (c.bid + c.G / 2) % c.G; u < GL_NCH; u += c.G) {
        int row0, ntok, h; gla_chunk_info(u, row0, ntok, h);
        for (int i = tid; i < 64 * 16; i += 512) { const int t = i >> 4, rr = i & 15; ga_l[i] = t < ntok ? bf2f(U[(size_t)(row0 + t) * NINP + U_GA + rr]) : 0.f; }
        for (int i = tid; i < 64 * 32; i += 512) { const int t = i >> 5, c8 = i & 31; u32x4 vv = (u32x4){0u, 0u, 0u, 0u};
            if (t < ntok) vv = *(const u32x4*)(U + (size_t)(row0 + t) * NINP + U_GV + h * 256 + c8 * 8);
            *(LAS u32x4*)(v_l + t * 264 + c8 * 8) = vv; }
        for (int i = tid; i < 64 * 16; i += 512) { const int t = i >> 4, c8 = i & 15; u32x4 qv = (u32x4){0u, 0u, 0u, 0u}, kv = qv;
            if (t < ntok) { const bf16_t* ur = U + (size_t)(row0 + t) * NINP + h * 128 + c8 * 8; qv = *(const u32x4*)(ur + U_GQ); kv = *(const u32x4*)(ur + U_GK); }
            *(LAS u32x4*)(qr_l + t * 136 + c8 * 8) = qv; *(LAS u32x4*)(kr_l + t * 136 + c8 * 8) = kv; }
        __syncthreads();
        const int kk = tid & 127, tq = tid >> 7;
        float cum[16];
        { float aup[16];
#pragma unroll
          for (int rr = 0; rr < 16; ++rr) aup[rr] = a_up[rr * 512 + h * 128 + kk];
          const float ab = a_b[h * 128 + kk]; float run = 0.f;
#pragma unroll
          for (int j = 0; j < 16; ++j) { const int t = tq * 16 + j; float x = ab;
#pragma unroll
              for (int rr = 0; rr < 16; ++rr) x += ga_l[t * 16 + rr] * aup[rr];
              const float la = t < ntok ? (fminf(x, 0.f) - __logf(1.0f + __expf(-fabsf(x)))) * (1.0f / 16.0f) : 0.f;
              run += la; cum[j] = run; }
          tot[tq * 128 + kk] = run; }
        __syncthreads();
        { float prefix = 0.f, bC = 0.f;
#pragma unroll
          for (int g = 0; g < 4; ++g) { const float tv = tot[g * 128 + kk]; bC += tv; if (g < tq) prefix += tv; }
          unsigned khp[8];
#pragma unroll
          for (int j = 0; j < 16; j += 2) { float kh2[2];
#pragma unroll
              for (int e = 0; e < 2; ++e) { const int t = tq * 16 + j + e; const float b = prefix + cum[j + e]; const float qv = bf2f(qr_l[t * 136 + kk]), kv = bf2f(kr_l[t * 136 + kk]);
                  Qd_l[t * 136 + kk] = f2bf(qv * __expf(b) * 0.08838834764831845f); Kn_l[t * 136 + kk] = f2bf(kv * __expf(-b)); kh2[e] = kv * __expf(bC - b); }
              khp[j >> 1] = pk2(kh2[0], kh2[1]); }
          bf16_t* kp = KHT + (size_t)u * 8192 + kk * 64 + tq * 16;
          *(u32x4*)kp = (u32x4){khp[0], khp[1], khp[2], khp[3]}; *(u32x4*)(kp + 8) = (u32x4){khp[4], khp[5], khp[6], khp[7]};
          if (tq == 0) GC[(size_t)u * 128 + kk] = __expf(bC); }
        __syncthreads();
        { const int tb = w >> 1;
#pragma unroll
          for (int e = 0; e < 2; ++e) { const int ib = (w & 1) * 2 + e; f32x4 d = (f32x4){0.f, 0.f, 0.f, 0.f};
              if (ib <= tb) {
                  bf16x8 kf4[4], qf4[4];
#pragma unroll
                  for (int ks = 0; ks < 4; ++ks) { kf4[ks] = *(const LAS bf16x8*)(Kn_l + (ib * 16 + r) * 136 + ks * 32 + q * 8); qf4[ks] = *(const LAS bf16x8*)(Qd_l + (tb * 16 + r) * 136 + ks * 32 + q * 8); }
                  __builtin_amdgcn_sched_barrier(0);
#pragma unroll
                  for (int ks = 0; ks < 4; ++ks) d = mma16(kf4[ks], qf4[ks], d); }
              const int t = tb * 16 + r, i0 = ib * 16 + q * 4;
#pragma unroll
              for (int jj = 0; jj < 4; ++jj) if (i0 + jj > t) d[jj] = 0.f;
              u32x2 o; o.x = pk2(d[0], d[1]); o.y = pk2(d[2], d[3]); *(u32x2*)(EE + (size_t)u * 4096 + t * 64 + i0) = o; } }
        for (int i = tid; i < 64 * 16; i += 512) { const int t = i >> 4, c8 = i & 15; *(u32x4*)(QD + (size_t)u * 8192 + t * 128 + c8 * 8) = *(const LAS u32x4*)(Qd_l + t * 136 + c8 * 8); }
        { const int val = tid & 255, th = tid >> 8;
#pragma unroll
          for (int tg = 0; tg < 4; ++tg) { const int t0 = th * 32 + tg * 8; unsigned p4[4];
#pragma unroll
              for (int e = 0; e < 4; ++e) p4[e] = (unsigned)v_l[(t0 + 2 * e) * 264 + val] | ((unsigned)v_l[(t0 + 2 * e + 1) * 264 + val] << 16);
              *(u32x4*)(VT + (size_t)u * 16384 + val * 64 + t0) = (u32x4){p4[0], p4[1], p4[2], p4[3]}; } }
        __syncthreads();
    }
}
struct GlaStage { u32x4 qd[2], kh[2], e, vt, gc; };
__device__ __forceinline__ void gla_stage_load(GlaStage& s, const bf16_t* __restrict__ QD, const bf16_t* __restrict__ KHT, const bf16_t* __restrict__ EE, const bf16_t* __restrict__ VT, const float* __restrict__ GC,
                                               int ch, int sl, int tid) {
    const bf16_t* qp = QD + (size_t)ch * 8192 + tid * 8; s.qd[0] = *(const u32x4*)qp; s.qd[1] = *(const u32x4*)(qp + 4096);
    const bf16_t* kp = KHT + (size_t)ch * 8192 + tid * 8; s.kh[0] = *(const u32x4*)kp; s.kh[1] = *(const u32x4*)(kp + 4096);
    s.e = *(const u32x4*)(EE + (size_t)ch * 4096 + tid * 8);
    s.vt = *(const u32x4*)(VT + (size_t)ch * 16384 + sl * 4096 + tid * 8);
    if (tid < 32) s.gc = *(const u32x4*)(GC + (size_t)ch * 128 + tid * 4);
}
constexpr int GS_KH = 8704, GS_E = 17920, GS_VT = 22528, GS_GC = 27136, GS_EL = 27392;
__device__ __forceinline__ void gla_stage_store(const GlaStage& s, LAS bf16_t* b, int tid) {
    *(LAS u32x4*)(b + (tid >> 4) * 136 + (tid & 15) * 8) = s.qd[0]; *(LAS u32x4*)(b + (32 + (tid >> 4)) * 136 + (tid & 15) * 8) = s.qd[1];
    *(LAS u32x4*)(b + GS_KH + (tid >> 3) * 72 + (tid & 7) * 8) = s.kh[0]; *(LAS u32x4*)(b + GS_KH + (64 + (tid >> 3)) * 72 + (tid & 7) * 8) = s.kh[1];
    *(LAS u32x4*)(b + GS_E + (tid >> 3) * 72 + (tid & 7) * 8) = s.e; *(LAS u32x4*)(b + GS_VT + (tid >> 3) * 72 + (tid & 7) * 8) = s.vt;
    if (tid < 32) *(LAS u32x4*)(b + GS_GC + tid * 8) = s.gc;
}
__device__ __forceinline__ void ph_gla_seq(const Ctx& c, int boff, const bf16_t* __restrict__ QD, const bf16_t* __restrict__ KHT, const bf16_t* __restrict__ EE, const bf16_t* __restrict__ VT, const float* __restrict__ GC,
                                           const float* __restrict__ s0, float* __restrict__ outP, float* __restrict__ outS, bf16_t* __restrict__ OB) {
    LAS bf16_t* stg = (LAS bf16_t*)c.lds;
    LAS bf16_t* T_l = stg + 2 * GS_EL;
    const int tid = c.tid, lane = c.lane, r = lane & 15, q = lane >> 4, w = c.wave;
    const int side = c.bid < 32 ? c.bid : c.bid - 64, nside = c.G - 64;
    for (int u = (c.bid >= boff && c.bid < boff + 32) ? c.bid - boff : ((c.bid < 32 || c.bid >= 96) ? 32 + side : 32 + 512); u < 32 + 512; u = u < 32 ? 32 + 512 : u + nside) {
        int h, sl, nch, ch0, row0, ntok; const float* sp = nullptr; float* op;
        if (u < 32) { const int b = u >> 4; h = (u >> 2) & 3; sl = u & 3; nch = 64; ch0 = (b * 4 + h) * 64; row0 = b * PS; ntok = 64; op = outP + (size_t)(b * 4 + h) * 32768; }
        else { const int s = u - 32, sq = s >> 4; h = (s >> 2) & 3; sl = s & 3; nch = 1; ch0 = 512 + sq * 4 + h; row0 = MP + sq * SS; ntok = SS; sp = s0 + (size_t)(sq * 4 + h) * 32768; op = outS + (size_t)(sq * 4 + h) * 32768; }
        f32x4 acc[4];
#pragma unroll
        for (int vb = 0; vb < 4; ++vb)
#pragma unroll
            for (int jj = 0; jj < 4; ++jj) acc[vb][jj] = sp ? sp[(size_t)(w * 16 + q * 4 + jj) * 256 + sl * 64 + vb * 16 + r] : 0.f;
        GlaStage R0, R1, R2;
        gla_stage_load(R0, QD, KHT, EE, VT, GC, ch0, sl, tid);
        if (1 < nch) gla_stage_load(R1, QD, KHT, EE, VT, GC, ch0 + 1, sl, tid);
        if (2 < nch) gla_stage_load(R2, QD, KHT, EE, VT, GC, ch0 + 2, sl, tid);
        __syncthreads();
        gla_stage_store(R0, stg, tid);
        if (3 < nch) gla_stage_load(R0, QD, KHT, EE, VT, GC, ch0 + 3, sl, tid);
#define GLA_STEP(ci, RN) do { \
            LAS bf16_t* Tb = T_l + ((ci) & 1) * 64 * 136; const LAS bf16_t* sb = stg + ((ci) & 1) * GS_EL; \
            _Pragma("unroll") for (int vb = 0; vb < 4; ++vb) { u32x2 o; o.x = pk2(acc[vb][0], acc[vb][1]); o.y = pk2(acc[vb][2], acc[vb][3]); *(LAS u32x2*)(Tb + (vb * 16 + r) * 136 + w * 16 + q * 4) = o; } \
            __syncthreads(); \
            if ((ci) + 1 < nch) { gla_stage_store(RN, stg + (((ci) + 1) & 1) * GS_EL, tid); if ((ci) + 4 < nch) gla_stage_load(RN, QD, KHT, EE, VT, GC, ch0 + (ci) + 4, sl, tid); } \
            { const int rb = w >> 1, t = rb * 16 + r; bf16x8 qf[4], ef[2]; \
              _Pragma("unroll") for (int ks = 0; ks < 4; ++ks) qf[ks] = *(const LAS bf16x8*)(sb + (rb * 16 + r) * 136 + ks * 32 + q * 8); \
              _Pragma("unroll") for (int ks = 0; ks < 2; ++ks) ef[ks] = *(const LAS bf16x8*)(sb + GS_E + (rb * 16 + r) * 72 + ks * 32 + q * 8); \
              bf16x8 tf[2][4], vf[2][2]; \
              _Pragma("unroll") for (int e2 = 0; e2 < 2; ++e2) { const int cb = (w & 1) * 2 + e2; \
                  _Pragma("unroll") for (int ks = 0; ks < 4; ++ks) tf[e2][ks] = *(const LAS bf16x8*)(Tb + (cb * 16 + r) * 136 + ks * 32 + q * 8); \
                  _Pragma("unroll") for (int ks = 0; ks < 2; ++ks) vf[e2][ks] = *(const LAS bf16x8*)(sb + GS_VT + (cb * 16 + r) * 72 + ks * 32 + q * 8); } \
              __builtin_amdgcn_sched_barrier(0); \
              _Pragma("unroll") for (int e2 = 0; e2 < 2; ++e2) { const int cb = (w & 1) * 2 + e2; f32x4 y = (f32x4){0.f, 0.f, 0.f, 0.f}; \
                  _Pragma("unroll") for (int ks = 0; ks < 4; ++ks) y = mma16(tf[e2][ks], qf[ks], y); \
                  _Pragma("unroll") for (int ks = 0; ks < 2; ++ks) y = mma16(vf[e2][ks], ef[ks], y); \
                  if (t < ntok) { u32x2 o; o.x = pk2(y[0], y[1]); o.y = pk2(y[2], y[3]); *(u32x2*)(OB + (size_t)(row0 + (ci) * 64 + t) * BW + h * 256 + sl * 64 + cb * 16 + q * 4) = o; } } } \
            { const f32x4 gcv = *(const LAS f32x4*)((const LAS float*)(sb + GS_GC) + w * 16 + q * 4); bf16x8 kf[2]; \
              _Pragma("unroll") for (int ks = 0; ks < 2; ++ks) kf[ks] = *(const LAS bf16x8*)(sb + GS_KH + (w * 16 + r) * 72 + ks * 32 + q * 8); \
              bf16x8 vs[4][2]; \
              _Pragma("unroll") for (int vb = 0; vb < 4; ++vb) _Pragma("unroll") for (int ks = 0; ks < 2; ++ks) vs[vb][ks] = *(const LAS bf16x8*)(sb + GS_VT + (vb * 16 + r) * 72 + ks * 32 + q * 8); \
              __builtin_amdgcn_sched_barrier(0); \
              _Pragma("unroll") for (int vb = 0; vb < 4; ++vb) { acc[vb] = acc[vb] * gcv; \
                  _Pragma("unroll") for (int ks = 0; ks < 2; ++ks) acc[vb] = mma16(kf[ks], vs[vb][ks], acc[vb]); } } \
        } while (0)
#pragma unroll 1
        for (int ci = 0; ci < nch; ci += 3) {
            GLA_STEP(ci, R1);
            if (ci + 1 < nch) GLA_STEP(ci + 1, R2);
            if (ci + 2 < nch) GLA_STEP(ci + 2, R0);
        }
#undef GLA_STEP
#pragma unroll
        for (int vb = 0; vb < 4; ++vb)
#pragma unroll
            for (int jj = 0; jj < 4; ++jj) op[(size_t)(w * 16 + q * 4 + jj) * 256 + sl * 64 + vb * 16 + r] = acc[vb][jj];
        __syncthreads();
    }
}
__device__ __forceinline__ void ph_gla_fin(const Ctx& c, const bf16_t* __restrict__ U, const float* __restrict__ ng, const float* __restrict__ nb, const bf16_t* __restrict__ RAW, bf16_t* __restrict__ OB) {
    const int lane = c.lane, hs = lane >> 5, l32 = lane & 31;
    for (int i = c.bid * 8 + c.wave; i < MT * 2; i += c.G * 8) {
        const int row = i >> 1, h = (i & 1) * 2 + hs, cc = h * 256 + l32 * 8; bf16_t* p = OB + (size_t)row * BW + cc;
        float x[8], gr[8]; unpack8(*(const u32x4*)(RAW + (size_t)row * BW + cc), x); unpack8(*(const u32x4*)(U + (size_t)row * NINP + U_GR + cc), gr);
        float s = 0.f;
#pragma unroll
        for (int j = 0; j < 8; ++j) s += x[j];
#pragma unroll
        for (int o = 16; o > 0; o >>= 1) s += __shfl_xor(s, o, 64);
        const float mean = s * (1.0f / 256.0f); float qq = 0.f;
#pragma unroll
        for (int j = 0; j < 8; ++j) { const float d = x[j] - mean; qq += d * d; }
#pragma unroll
        for (int o = 16; o > 0; o >>= 1) qq += __shfl_xor(qq, o, 64);
        const float rstd = rsqrtf(qq * (1.0f / 256.0f) + 1e-5f);
        const f32x4 g0 = *(const f32x4*)(ng + cc), g1 = *(const f32x4*)(ng + cc + 4), b0 = *(const f32x4*)(nb + cc), b1 = *(const f32x4*)(nb + cc + 4); float o8[8];
#pragma unroll
        for (int j = 0; j < 8; ++j) o8[j] = ((x[j] - mean) * rstd * (j < 4 ? g0[j] : g1[j - 4]) + (j < 4 ? b0[j] : b1[j - 4])) * gr[j] * sigmoidf_(gr[j]);
        *(u32x4*)p = (u32x4){pk2(o8[0], o8[1]), pk2(o8[2], o8[3]), pk2(o8[4], o8[5]), pk2(o8[6], o8[7])};
    }
}

template <bool ISBF> __device__ __forceinline__ void swa_step(const float (&q)[32], float (&acc)[32], float& m, float& l, const void* kp, const void* vp, float slope, float dist) {
    float s = 0.f;
#pragma unroll
    for (int j = 0; j < 4; ++j) { float x[8];
        if (ISBF) unpack8(*(const u32x4*)((const bf16_t*)kp + j * 8), x);
        else { const f32x4 a = *(const f32x4*)((const float*)kp + j * 8), b = *(const f32x4*)((const float*)kp + j * 8 + 4); x[0] = a[0]; x[1] = a[1]; x[2] = a[2]; x[3] = a[3]; x[4] = b[0]; x[5] = b[1]; x[6] = b[2]; x[7] = b[3]; }
#pragma unroll
        for (int d = 0; d < 8; ++d) s += q[j * 8 + d] * x[d]; }
    s += __shfl_xor(s, 1, 64);
    s = s * 0.125f - slope * dist;
    const float mn = fmaxf(m, s), cc = __expf(m - mn), p = __expf(s - mn);
    l = l * cc + p;
#pragma unroll
    for (int j = 0; j < 4; ++j) { float x[8];
        if (ISBF) unpack8(*(const u32x4*)((const bf16_t*)vp + j * 8), x);
        else { const f32x4 a = *(const f32x4*)((const float*)vp + j * 8), b = *(const f32x4*)((const float*)vp + j * 8 + 4); x[0] = a[0]; x[1] = a[1]; x[2] = a[2]; x[3] = a[3]; x[4] = b[0]; x[5] = b[1]; x[6] = b[2]; x[7] = b[3]; }
#pragma unroll
        for (int d = 0; d < 8; ++d) acc[j * 8 + d] = acc[j * 8 + d] * cc + p * x[d]; }
    m = mn;
}
__device__ __forceinline__ void ph_swa_naive(const Ctx& c, const bf16_t* __restrict__ U, const float* __restrict__ ck, const float* __restrict__ cv, const float* __restrict__ sinks, bf16_t* __restrict__ OB) {
    for (int gid = c.bid * 512 + c.tid; gid < MS * 32; gid += c.G * 512) {
        const int dh = gid & 1, h = (gid >> 1) & 15, row = MP + (gid >> 5), kvh = h >> 3, co = kvh * 64 + dh * 32;
        float q[32], acc[32];
#pragma unroll
        for (int j = 0; j < 4; ++j) { float x[8]; unpack8(*(const u32x4*)(U + (size_t)row * NINP + U_SQ + h * 64 + dh * 32 + j * 8), x);
#pragma unroll
            for (int d = 0; d < 8; ++d) { q[j * 8 + d] = x[d]; acc[j * 8 + d] = 0.f; } }
        const float slope = exp2f(-0.5f * (float)(h + 1)); float m = sinks[h], l = 1.0f;
        if (row < MP) {
            const int t = row % PS, base = row - t, lo = t - 128 < 0 ? 0 : t - 128;
            for (int s = lo; s <= t; ++s) { const bf16_t* ur = U + (size_t)(base + s) * NINP;
                swa_step<true>(q, acc, m, l, ur + U_SK + co, ur + U_SV + co, slope, (float)(t - s)); }
        } else {
            const int sq = (row - MP) / SS, i = (row - MP) % SS;
            for (int idx = i; idx <= 128 + i; ++idx) {
                if (idx < 128) { const size_t o = ((size_t)sq * 128 + idx) * 128 + co; swa_step<false>(q, acc, m, l, ck + o, cv + o, slope, (float)(128 + i - idx)); }
                else { const bf16_t* ur = U + (size_t)(MP + sq * SS + idx - 128) * NINP; swa_step<true>(q, acc, m, l, ur + U_SK + co, ur + U_SV + co, slope, (float)(128 + i - idx)); }
            }
        }
        const float inv = 1.0f / l; bf16_t* op = OB + (size_t)row * BW + h * 64 + dh * 32;
#pragma unroll
        for (int j = 0; j < 4; ++j) { u32x4 w; w.x = pk2(acc[j * 8] * inv, acc[j * 8 + 1] * inv); w.y = pk2(acc[j * 8 + 2] * inv, acc[j * 8 + 3] * inv);
            w.z = pk2(acc[j * 8 + 4] * inv, acc[j * 8 + 5] * inv); w.w = pk2(acc[j * 8 + 6] * inv, acc[j * 8 + 7] * inv); *(u32x4*)(op + j * 8) = w; }
    }
}

__device__ __forceinline__ void ph_rwkv_prep(const Ctx& c, const bf16_t* __restrict__ U, const float* __restrict__ shift, const float* __restrict__ mu, const float* __restrict__ w0, const float* __restrict__ w2,
                                             const float* __restrict__ a0, const float* __restrict__ a2, const float* __restrict__ g2, const float* __restrict__ k_k, const float* __restrict__ k_a,
                                             const float* __restrict__ r_k, float* __restrict__ RW) {
    LAS float* xm = (LAS float*)c.lds; LAS float* tw = xm + RWC; LAS float* ad = tw + 64; LAS float* sg = ad + 64;
    const int tid = c.tid;
    float* R = RW; float* WD = RW + (size_t)MPAD * BW; float* K2 = WD + (size_t)MPAD * BW; float* V = K2 + (size_t)MPAD * BW; float* KK = V + (size_t)MPAD * BW;
    float* BV = KK + (size_t)MPAD * BW; float* G = BV + (size_t)MPAD * BW; float* BON = G + (size_t)MPAD * BW;
    for (int row = c.bid; row < MT; row += c.G) {
        const bf16_t* ur = U + (size_t)row * NINP + U_RU; const bf16_t* pr = ur - NINP; const float* ps = nullptr; bool first;
        if (row < MP) first = (row % PS) == 0; else { first = ((row - MP) % SS) == 0; ps = shift + (size_t)((row - MP) / SS) * RWC; }
        for (int cc = tid; cc < RWC; cc += 512) { const float x = bf2f(ur[cc]); const float s = first ? (ps ? ps[cc] : 0.f) : bf2f(pr[cc]); xm[cc] = x + (s - x) * mu[cc]; }
        __syncthreads();
        if (tid < 64) { tw[tid] = tanhf(xm[3072 + tid]); ad[tid] = xm[3136 + tid]; }
        if (tid >= 128 && tid < 256) sg[tid - 128] = sigmoidf_(xm[3200 + tid - 128]);
        __syncthreads();
        for (int qd = 0; qd < 2; ++qd) {
            const int cc = qd * 512 + tid; float accw = w0[cc], acca = a0[cc], accg = 0.f;
#pragma unroll 4
            for (int j = 0; j < 64; ++j) { accw += tw[j] * w2[j * BW + cc]; acca += ad[j] * a2[j * BW + cc]; }
#pragma unroll 4
            for (int j = 0; j < 128; ++j) accg += sg[j] * g2[j * BW + cc];
            const float lw = -softplusf_(-accw) - 0.5f, decay = __expf(-__expf(lw)), a = sigmoidf_(acca);
            const float r = xm[cc], k = xm[1024 + cc], v = xm[2048 + cc];
            const float kkr = k * k_k[cc]; const float ss = wave_sum(kkr * kkr); const float kk = kkr / fmaxf(sqrtf(ss), 1e-12f);
            const float k2 = k * (1.0f + (a - 1.0f) * k_a[cc]); const float rk = wave_sum(r * k2 * r_k[cc]);
            const size_t o = (size_t)row * BW + cc;
            R[o] = r; WD[o] = decay; K2[o] = k2; V[o] = v; KK[o] = kk; BV[o] = kk * a; G[o] = accg; BON[o] = rk * v;
        }
        __syncthreads();
    }
}
__device__ __forceinline__ int kperm_pos(int k) { return (k & ~31) + 8 * ((k >> 2) & 3) + 4 * ((k >> 4) & 1) + (k & 3); }
__device__ __forceinline__ void ph_swa_prompt(const Ctx& c, const bf16_t* __restrict__ U, const float* __restrict__ sinks, bf16_t* __restrict__ OB) {
    LAS bf16_t* K_l = (LAS bf16_t*)c.lds;
    LAS bf16_t* VT_l = K_l + 192 * 72;
    const int tid = c.tid, lane = c.lane, r = lane & 15, q = lane >> 4, w = c.wave;
    for (int u = c.bid; u < PB * 64 * 2; u += c.G) {
        const int b = u >> 7, qb = (u >> 1) & 63, kvh = u & 1, h = kvh * 8 + w;
        const int tok0 = qb * 64 - 128;
        const size_t seq0 = (size_t)b * PS;
        for (int idx = tid; idx < 192 * 8; idx += 512) { const int kl = idx >> 3, c8 = idx & 7, tk = tok0 + kl; u32x4 kv = (u32x4){0u, 0u, 0u, 0u}, vv = kv;
            if (tk >= 0) { const bf16_t* ur = U + (seq0 + tk) * NINP; kv = *(const u32x4*)(ur + U_SK + kvh * 64 + c8 * 8); vv = *(const u32x4*)(ur + U_SV + kvh * 64 + c8 * 8); }
            *(LAS u32x4*)(K_l + kl * 72 + c8 * 8) = kv;
            const int kp = kperm_pos(kl); LAS bf16_t* vp = VT_l + (c8 * 8) * 200 + kp;
            vp[0] = (bf16_t)(vv.x & 0xffffu); vp[200] = (bf16_t)(vv.x >> 16); vp[400] = (bf16_t)(vv.y & 0xffffu); vp[600] = (bf16_t)(vv.y >> 16);
            vp[800] = (bf16_t)(vv.z & 0xffffu); vp[1000] = (bf16_t)(vv.z >> 16); vp[1200] = (bf16_t)(vv.w & 0xffffu); vp[1400] = (bf16_t)(vv.w >> 16); }
        __syncthreads();
        const float slope = exp2f(-0.5f * (float)(h + 1)), sink = sinks[h];
#pragma unroll 1
        for (int i = 0; i < 4; ++i) {
            const size_t qrow = seq0 + qb * 64 + i * 16 + r;
            const bf16x8 qf0 = *(const bf16x8*)(U + qrow * NINP + U_SQ + h * 64 + q * 8), qf1 = *(const bf16x8*)(U + qrow * NINP + U_SQ + h * 64 + 32 + q * 8);
            const int kt0 = i & ~1;
            f32x4 s[10]; float mx = sink; bf16x8 kfr[5][2];
#pragma unroll
            for (int kt = 0; kt < 10; ++kt) { f32x4 d;
                if (kt % 5 == 0) {
#pragma unroll
                    for (int k5 = 0; k5 < 5; ++k5) { const LAS bf16_t* kp = K_l + ((kt0 + kt + k5) * 16 + r) * 72 + q * 8; kfr[k5][0] = *(const LAS bf16x8*)kp; kfr[k5][1] = *(const LAS bf16x8*)(kp + 32); }
                    __builtin_amdgcn_sched_barrier(0); }
                d = mma16(kfr[kt % 5][0], qf0, (f32x4){0.f, 0.f, 0.f, 0.f}); d = mma16(kfr[kt % 5][1], qf1, d);
#pragma unroll
                for (int jj = 0; jj < 4; ++jj) { const int kl = (kt0 + kt) * 16 + q * 4 + jj, dist = i * 16 + r + 128 - kl;
                    const float v = (dist >= 0 && dist <= 128 && tok0 + kl >= 0) ? d[jj] * 0.125f - slope * (float)dist : -1e30f; d[jj] = v; mx = fmaxf(mx, v); }
                s[kt] = d; }
            mx = fmaxf(mx, __shfl_xor(mx, 16, 64)); mx = fmaxf(mx, __shfl_xor(mx, 32, 64));
            float sum = 0.f; bf16x8 pf[5];
#pragma unroll
            for (int kp = 0; kp < 5; ++kp) { f32x4 a = s[2 * kp], bq = s[2 * kp + 1];
#pragma unroll
                for (int jj = 0; jj < 4; ++jj) { a[jj] = __expf(a[jj] - mx); bq[jj] = __expf(bq[jj] - mx); sum += a[jj] + bq[jj]; }
                pf[kp] = pack_acc(a, bq); }
            sum += __shfl_xor(sum, 16, 64); sum += __shfl_xor(sum, 32, 64);
            const float inv = 1.0f / (sum + __expf(sink - mx));
            bf16_t* op = OB + qrow * BW + h * 64 + q * 4;
#pragma unroll
            for (int dt = 0; dt < 4; ++dt) { f32x4 o = (f32x4){0.f, 0.f, 0.f, 0.f}; bf16x8 vfr[5];
#pragma unroll
                for (int kp = 0; kp < 5; ++kp) vfr[kp] = *(const LAS bf16x8*)(VT_l + (dt * 16 + r) * 200 + (kt0 + 2 * kp) * 16 + q * 8);
                __builtin_amdgcn_sched_barrier(0);
#pragma unroll
                for (int kp = 0; kp < 5; ++kp) o = mma16(vfr[kp], pf[kp], o);
                u32x2 ov; ov.x = pk2(o[0] * inv, o[1] * inv); ov.y = pk2(o[2] * inv, o[3] * inv); *(u32x2*)(op + dt * 16) = ov; }
        }
        __syncthreads();
    }
}

__device__ __forceinline__ void ph_swa_sample(const Ctx& c, const bf16_t* __restrict__ U, const float* __restrict__ ck, const float* __restrict__ cv, const float* __restrict__ sinks, bf16_t* __restrict__ OB) {
    LAS bf16_t* K_l = (LAS bf16_t*)c.lds;
    LAS bf16_t* VT_l = K_l + 160 * 72;
    const int tid = c.tid, lane = c.lane, r = lane & 15, q = lane >> 4, w = c.wave;
    for (int u = c.bid; u < SB * 2; u += c.G) {
        const int sq = u >> 1, kvh = u & 1;
        for (int idx = tid; idx < 160 * 8; idx += 512) { const int kl = idx >> 3, c8 = idx & 7; float kx[8], vx[8];
#pragma unroll
            for (int e = 0; e < 8; ++e) { kx[e] = 0.f; vx[e] = 0.f; }
            if (kl < 128) { const size_t o = ((size_t)sq * 128 + kl) * 128 + kvh * 64 + c8 * 8; const f32x4 a = *(const f32x4*)(ck + o), b2 = *(const f32x4*)(ck + o + 4), c2 = *(const f32x4*)(cv + o), d2 = *(const f32x4*)(cv + o + 4);
                kx[0] = a[0]; kx[1] = a[1]; kx[2] = a[2]; kx[3] = a[3]; kx[4] = b2[0]; kx[5] = b2[1]; kx[6] = b2[2]; kx[7] = b2[3];
                vx[0] = c2[0]; vx[1] = c2[1]; vx[2] = c2[2]; vx[3] = c2[3]; vx[4] = d2[0]; vx[5] = d2[1]; vx[6] = d2[2]; vx[7] = d2[3]; }
            else if (kl < 132) { const bf16_t* ur = U + (size_t)(MP + sq * SS + kl - 128) * NINP; unpack8(*(const u32x4*)(ur + U_SK + kvh * 64 + c8 * 8), kx); unpack8(*(const u32x4*)(ur + U_SV + kvh * 64 + c8 * 8), vx); }
            *(LAS u32x4*)(K_l + kl * 72 + c8 * 8) = (u32x4){pk2(kx[0], kx[1]), pk2(kx[2], kx[3]), pk2(kx[4], kx[5]), pk2(kx[6], kx[7])};
            LAS bf16_t* vp = VT_l + (c8 * 8) * 168 + kperm_pos(kl);
#pragma unroll
            for (int e = 0; e < 8; ++e) vp[e * 168] = f2bf(vx[e]); }
        __syncthreads();
        if (w < 2) {
            const int h = kvh * 8 + w * 4 + (r >> 2), tk = r & 3; const size_t qrow = (size_t)(MP + sq * SS + tk);
            const float slope = exp2f(-0.5f * (float)(h + 1)), sink = sinks[h];
            const bf16x8 qf0 = *(const bf16x8*)(U + qrow * NINP + U_SQ + h * 64 + q * 8), qf1 = *(const bf16x8*)(U + qrow * NINP + U_SQ + h * 64 + 32 + q * 8);
            f32x4 s[10]; float mx = sink;
#pragma unroll
            for (int kt = 0; kt < 10; ++kt) { const LAS bf16_t* kp = K_l + (kt * 16 + r) * 72 + q * 8;
                f32x4 d = mma16(*(const LAS bf16x8*)kp, qf0, (f32x4){0.f, 0.f, 0.f, 0.f}); d = mma16(*(const LAS bf16x8*)(kp + 32), qf1, d);
#pragma unroll
                for (int jj = 0; jj < 4; ++jj) { const int kl = kt * 16 + q * 4 + jj, dist = 128 + tk - kl;
                    const float v = (dist >= 0 && dist <= 128) ? d[jj] * 0.125f - slope * (float)dist : -1e30f; d[jj] = v; mx = fmaxf(mx, v); }
                s[kt] = d; }
            mx = fmaxf(mx, __shfl_xor(mx, 16, 64)); mx = fmaxf(mx, __shfl_xor(mx, 32, 64));
            float sum = 0.f; bf16x8 pf[5];
#pragma unroll
            for (int kp = 0; kp < 5; ++kp) { f32x4 a = s[2 * kp], bq = s[2 * kp + 1];
#pragma unroll
                for (int jj = 0; jj < 4; ++jj) { a[jj] = __expf(a[jj] - mx); bq[jj] = __expf(bq[jj] - mx); sum += a[jj] + bq[jj]; }
                pf[kp] = pack_acc(a, bq); }
            sum += __shfl_xor(sum, 16, 64); sum += __shfl_xor(sum, 32, 64);
            const float inv = 1.0f / (sum + __expf(sink - mx));
            bf16_t* op = OB + qrow * BW + h * 64 + q * 4;
#pragma unroll
            for (int dt = 0; dt < 4; ++dt) { f32x4 o = (f32x4){0.f, 0.f, 0.f, 0.f};
#pragma unroll
                for (int kp = 0; kp < 5; ++kp) o = mma16(*(const LAS bf16x8*)(VT_l + (dt * 16 + r) * 168 + kp * 32 + q * 8), pf[kp], o);
                u32x2 ov; ov.x = pk2(o[0] * inv, o[1] * inv); ov.y = pk2(o[2] * inv, o[3] * inv); *(u32x2*)(op + dt * 16) = ov; }
        }
        __syncthreads();
    }
}

__device__ __forceinline__ void ph_memattn_prompt(const Ctx& c, const bf16_t* __restrict__ U, const bf16_t* __restrict__ MKB, const bf16_t* __restrict__ MVT, bf16_t* __restrict__ OB) {
    LAS bf16_t* buf = (LAS bf16_t*)c.lds;
    const int tid = c.tid, lane = c.lane, r = lane & 15, q = lane >> 4, w = c.wave;
    for (int u = c.bid; u < PB * 4 * 32; u += c.G) {
        const int b = u >> 7, h = (u >> 5) & 3, qb = u & 31;
        const size_t qrow = (size_t)b * PS + qb * 128 + w * 16 + r;
        const bf16_t* kg = MKB + (size_t)(b * 256) * 1024 + h * 256;
        const bf16_t* vg = MVT + (size_t)(b * 4 + h) * 65536;
        const bf16_t* qg = U + qrow * NINP + U_MQ + h * 256 + q * 8;
        bf16x8 qn0 = *(const bf16x8*)qg, qn1 = *(const bf16x8*)(qg + 32);
        u32x4 st[4];
#pragma unroll
        for (int i = 0; i < 4; ++i) { const int p = tid + 512 * i; st[i] = *(const u32x4*)(kg + (size_t)(p >> 3) * 1024 + (p & 7) * 8); }
        f32x4 s[16];
#pragma unroll
        for (int mt = 0; mt < 16; ++mt) s[mt] = (f32x4){0.f, 0.f, 0.f, 0.f};
        __syncthreads();
#pragma unroll 1
        for (int ck = 0; ck < 4; ++ck) {
            LAS bf16_t* kb = buf + (ck & 1) * 18432;
#pragma unroll
            for (int i = 0; i < 4; ++i) { const int p = tid + 512 * i; *(LAS u32x4*)(kb + (p >> 3) * 72 + (p & 7) * 8) = st[i]; }
            __syncthreads();
            const bf16x8 qc0 = qn0, qc1 = qn1;
            if (ck < 3) { qn0 = *(const bf16x8*)(qg + (ck + 1) * 64); qn1 = *(const bf16x8*)(qg + (ck + 1) * 64 + 32);
#pragma unroll
                for (int i = 0; i < 4; ++i) { const int p = tid + 512 * i; st[i] = *(const u32x4*)(kg + (size_t)(p >> 3) * 1024 + (ck + 1) * 64 + (p & 7) * 8); } }
#pragma unroll
            for (int m2 = 0; m2 < 16; m2 += 2) { bf16x8 kf[2][2];
#pragma unroll
                for (int j = 0; j < 2; ++j) { kf[j][0] = *(const LAS bf16x8*)(kb + ((m2 + j) * 16 + r) * 72 + q * 8); kf[j][1] = *(const LAS bf16x8*)(kb + ((m2 + j) * 16 + r) * 72 + 32 + q * 8); }
                __builtin_amdgcn_sched_barrier(0);
#pragma unroll
                for (int j = 0; j < 2; ++j) { s[m2 + j] = mma16(kf[j][0], qc0, s[m2 + j]); s[m2 + j] = mma16(kf[j][1], qc1, s[m2 + j]); } }
        }
#pragma unroll
        for (int i = 0; i < 4; ++i) { const int p = tid + 512 * i; st[i] = *(const u32x4*)(vg + (size_t)(p >> 5) * 256 + (p & 31) * 8); }
        float mx = -3.0e38f;
#pragma unroll
        for (int mt = 0; mt < 16; ++mt)
#pragma unroll
            for (int jj = 0; jj < 4; ++jj) { s[mt][jj] *= 0.0625f; mx = fmaxf(mx, s[mt][jj]); }
        mx = fmaxf(mx, __shfl_xor(mx, 16, 64)); mx = fmaxf(mx, __shfl_xor(mx, 32, 64));
        float sum = 0.f; bf16x8 pf[8];
#pragma unroll
        for (int kp = 0; kp < 8; ++kp) { f32x4 a = s[2 * kp], b2 = s[2 * kp + 1];
#pragma unroll
            for (int jj = 0; jj < 4; ++jj) { a[jj] = __expf(a[jj] - mx); b2[jj] = __expf(b2[jj] - mx); sum += a[jj] + b2[jj]; }
            pf[kp] = pack_acc(a, b2); }
        sum += __shfl_xor(sum, 16, 64); sum += __shfl_xor(sum, 32, 64);
        const float inv = 1.0f / sum;
        bf16_t* op = OB + qrow * BW + h * 256 + q * 4;
#pragma unroll 1
        for (int cv = 0; cv < 4; ++cv) {
            LAS bf16_t* vb = buf + (cv & 1) * 18432;
#pragma unroll
            for (int i = 0; i < 4; ++i) { const int p = tid + 512 * i, m0 = (p & 31) * 8; LAS bf16_t* d0 = vb + (p >> 5) * 264;
                *(LAS u32x2*)(d0 + kperm_pos(m0)) = (u32x2){st[i].x, st[i].y}; *(LAS u32x2*)(d0 + kperm_pos(m0 + 4)) = (u32x2){st[i].z, st[i].w}; }
            __syncthreads();
            if (cv < 3) {
#pragma unroll
                for (int i = 0; i < 4; ++i) { const int p = tid + 512 * i; st[i] = *(const u32x4*)(vg + (size_t)((cv + 1) * 64 + (p >> 5)) * 256 + (p & 31) * 8); } }
#pragma unroll
            for (int dt = 0; dt < 4; ++dt) { bf16x8 vf[8];
#pragma unroll
                for (int kp = 0; kp < 8; ++kp) vf[kp] = *(const LAS bf16x8*)(vb + (dt * 16 + r) * 264 + kp * 32 + q * 8);
                __builtin_amdgcn_sched_barrier(0);
                f32x4 o = (f32x4){0.f, 0.f, 0.f, 0.f};
#pragma unroll
                for (int kp = 0; kp < 8; ++kp) o = mma16(vf[kp], pf[kp], o);
                u32x2 ov; ov.x = pk2(o[0] * inv, o[1] * inv); ov.y = pk2(o[2] * inv, o[3] * inv); *(u32x2*)(op + (cv * 4 + dt) * 16) = ov; }
        }
        __syncthreads();
    }
}

__device__ __forceinline__ void ph_lrw(const Ctx& c, const float* __restrict__ w2, const float* __restrict__ a2, const float* __restrict__ g2, bf16_t* __restrict__ LRW) {
    for (int idx = c.bid * 512 + c.tid; idx < NL * 256 * 1024; idx += c.G * 512) {
        const int ch = idx & 1023, j = (idx >> 10) & 255, l = idx >> 18;
        const float v = j < 64 ? w2[((size_t)l * 64 + j) * BW + ch] : (j < 128 ? a2[((size_t)l * 64 + j - 64) * BW + ch] : g2[((size_t)l * 128 + j - 128) * BW + ch]);
        LRW[((size_t)l * 1024 + ch) * 256 + j] = f2bf(v);
    }
}
constexpr int RWP_UNITS = (MP / 64) * 4 + SB * 4;
__device__ __forceinline__ void rwp_unit_info(int u, int& row0, int& ntok, int& hg, int& sq, bool& seq_first) {
    if (u < (MP / 64) * 4) { const int blk = u >> 2; hg = u & 3; row0 = blk * 64; ntok = 64; sq = -1; seq_first = (row0 % PS) == 0; }
    else { const int s = u - (MP / 64) * 4; sq = s >> 2; hg = s & 3; row0 = MP + sq * SS; ntok = SS; seq_first = true; }
}
__device__ __forceinline__ void ph_rwkv_pre(const Ctx& c, const bf16_t* __restrict__ U, const float* __restrict__ shift, const float* __restrict__ mu, const float* __restrict__ w0, const float* __restrict__ w2,
                                            const float* __restrict__ a0, const float* __restrict__ a2, const float* __restrict__ g2, const float* __restrict__ k_k, const float* __restrict__ k_a,
                                            const float* __restrict__ r_k, float* __restrict__ RW, bf16_t* __restrict__ RB, const bf16_t* __restrict__ LRW) {
    LAS bf16_t* P_l = (LAS bf16_t*)c.lds; LAS bf16_t* Kn_l = P_l + 4608; LAS bf16_t* Bn_l = Kn_l + 4608; LAS bf16_t* Q_l = Bn_l + 4608;
    LAS bf16_t* PT_l = Q_l + 4608; LAS bf16_t* BhT_l = PT_l + 4608; LAS bf16_t* KhT_l = BhT_l + 4608; LAS bf16_t* VT_l = KhT_l + 4608;
    LAS float* A_l = (LAS float*)(c.lds + 73728);
    LAS bf16_t* BmT_l = (LAS bf16_t*)(c.lds + 78848); LAS bf16_t* F_l = (LAS bf16_t*)(c.lds + 81920); LAS bf16_t* Tinv_l = (LAS bf16_t*)(c.lds + 84992);
    LAS bf16_t* PpT_l = (LAS bf16_t*)(c.lds + 88064);
    LAS bf16_t* BmpT_l = (LAS bf16_t*)(c.lds + 97280);
    LAS float* GC_l = (LAS float*)(c.lds + 100352);
    LAS float* lg_l = (LAS float*)(c.lds + 125952);
    LAS bf16_t* act_l = (LAS bf16_t*)c.lds;
    LAS bf16_t* wT_l = act_l + 64 * 264;
    LAS bf16_t* aT_l = wT_l + 64 * 72;
    LAS bf16_t* gT_l = aT_l + 64 * 72;
    LAS float* pre_l = (LAS float*)(c.lds + 73728);
    const int tid = c.tid, lane = c.lane, r = lane & 15, q = lane >> 4, w = c.wave;
    bf16_t* Gg = (bf16_t*)(RW + 6 * (size_t)MPAD * BW); bf16_t* BON = (bf16_t*)(RW + 7 * (size_t)MPAD * BW);
    for (int u = c.bid; u < RWP_UNITS; u += c.G) {
        int row0, ntok, hg, sq; bool seq_first; rwp_unit_info(u, row0, ntok, hg, sq, seq_first);
        const float* sh = sq >= 0 ? shift + (size_t)sq * RWC : nullptr;
        const int nstage = ntok == 64 ? 64 : 16;
        for (int idx = tid; idx < nstage * 32; idx += 512) {
            const int t = idx >> 5, c8 = idx & 31, cc = 3072 + c8 * 8; float val[8];
#pragma unroll
            for (int e2 = 0; e2 < 8; ++e2) val[e2] = 0.f;
            if (t < ntok) { const bf16_t* ur = U + (size_t)(row0 + t) * NINP + U_RU; float x[8], p[8];
                unpack8(*(const u32x4*)(ur + cc), x);
                if (!(t == 0 && seq_first)) unpack8(*(const u32x4*)(ur + cc - NINP), p);
                else if (sh) { const f32x4 s0v = *(const f32x4*)(sh + cc), s1v = *(const f32x4*)(sh + cc + 4); p[0] = s0v[0]; p[1] = s0v[1]; p[2] = s0v[2]; p[3] = s0v[3]; p[4] = s1v[0]; p[5] = s1v[1]; p[6] = s1v[2]; p[7] = s1v[3]; }
                else {
#pragma unroll
                    for (int e2 = 0; e2 < 8; ++e2) p[e2] = 0.f; }
                const f32x4 m0 = *(const f32x4*)(mu + cc), m1 = *(const f32x4*)(mu + cc + 4);
#pragma unroll
                for (int e2 = 0; e2 < 8; ++e2) { const float xm = x[e2] + (p[e2] - x[e2]) * (e2 < 4 ? m0[e2] : m1[e2 - 4]); val[e2] = c8 < 8 ? tanh_fast(xm) : (c8 < 16 ? xm : sigmoidf_(xm)); } }
            *(LAS u32x4*)(act_l + t * 264 + c8 * 8) = (u32x4){pk2(val[0], val[1]), pk2(val[2], val[3]), pk2(val[4], val[5]), pk2(val[6], val[7])};
        }
        __syncthreads();
        bf16x8 af[8];
        { const int tb = w & 3;
#pragma unroll
          for (int ks = 0; ks < 8; ++ks) af[ks] = *(const LAS bf16x8*)(act_l + (tb * 16 + r) * 264 + ks * 32 + q * 8); }
        __syncthreads();
#pragma unroll 1
        for (int hh = 0; hh < 4; ++hh) { const int h = hg * 4 + hh;
        { const int tb = w & 3, chf = w >> 2;
          if (tb * 16 < nstage) {
#pragma unroll
            for (int e2 = 0; e2 < 2; ++e2) { const int cb = chf * 2 + e2; f32x4 dw = (f32x4){0.f, 0.f, 0.f, 0.f}, da = dw, dg = dw;
                const bf16_t* wr = LRW + ((size_t)h * 64 + cb * 16 + r) * 256 + q * 8; bf16x8 wf[8];
#pragma unroll
                for (int ks = 0; ks < 8; ++ks) wf[ks] = *(const bf16x8*)(wr + ks * 32);
                __builtin_amdgcn_sched_barrier(0);
#pragma unroll
                for (int ks = 0; ks < 2; ++ks) { dw = mma16(wf[ks], af[ks], dw); da = mma16(wf[2 + ks], af[2 + ks], da); }
#pragma unroll
                for (int ks = 0; ks < 4; ++ks) dg = mma16(wf[4 + ks], af[4 + ks], dg);
                const int o = (tb * 16 + r) * 68 + cb * 16 + q * 4;
                *(LAS f32x4*)(pre_l + o) = dw; *(LAS f32x4*)(pre_l + 64 * 68 + o) = da; *(LAS f32x4*)(pre_l + 2 * 64 * 68 + o) = dg; } } }
        __syncthreads();
        const int t = tid >> 3, cg = tid & 7, c0 = h * 64 + cg * 8, sc = t >> 4;
        float rr[8], k2[8], kap[8], bet[8], nlw[8];
        { float vx[8], gg[8], kkr[8]; float ss = 0.f, rk = 0.f;
          if (t < ntok) {
            const size_t row = (size_t)(row0 + t); const bf16_t* ur = U + row * NINP + U_RU; const bool fst = (t == 0 && seq_first);
            float kx[8];
#pragma unroll
            for (int part = 0; part < 3; ++part) { const int cc = part * 1024 + c0; float x[8], p[8];
                unpack8(*(const u32x4*)(ur + cc), x);
                if (!fst) unpack8(*(const u32x4*)(ur + cc - NINP), p);
                else {
#pragma unroll
                    for (int j = 0; j < 8; ++j) p[j] = sh ? sh[cc + j] : 0.f; }
                const f32x4 mA = *(const f32x4*)(mu + cc), mB = *(const f32x4*)(mu + cc + 4);
#pragma unroll
                for (int j = 0; j < 8; ++j) { const float xm = x[j] + (p[j] - x[j]) * (j < 4 ? mA[j] : mB[j - 4]); if (part == 0) rr[j] = xm; else if (part == 1) kx[j] = xm; else vx[j] = xm; } }
            float pw[8], pa[8], pkk[8], pka[8], prk[8];
#pragma unroll
            for (int hf = 0; hf < 2; ++hf) { const f32x4 v0 = *(const f32x4*)(w0 + c0 + hf * 4), v1 = *(const f32x4*)(a0 + c0 + hf * 4), v2 = *(const f32x4*)(k_k + c0 + hf * 4), v3 = *(const f32x4*)(k_a + c0 + hf * 4), v4 = *(const f32x4*)(r_k + c0 + hf * 4);
#pragma unroll
                for (int j = 0; j < 4; ++j) { pw[hf * 4 + j] = v0[j]; pa[hf * 4 + j] = v1[j]; pkk[hf * 4 + j] = v2[j]; pka[hf * 4 + j] = v3[j]; prk[hf * 4 + j] = v4[j]; } }
            float lwp[8], app[8];
#pragma unroll
            for (int hf = 0; hf < 2; ++hf) { const f32x4 v0 = *(const LAS f32x4*)(pre_l + t * 68 + cg * 8 + hf * 4), v1 = *(const LAS f32x4*)(pre_l + 64 * 68 + t * 68 + cg * 8 + hf * 4), v2 = *(const LAS f32x4*)(pre_l + 2 * 64 * 68 + t * 68 + cg * 8 + hf * 4);
#pragma unroll
                for (int j = 0; j < 4; ++j) { lwp[hf * 4 + j] = v0[j]; app[hf * 4 + j] = v1[j]; gg[hf * 4 + j] = v2[j]; } }
#pragma unroll
            for (int j = 0; j < 8; ++j) {
                const float lw = -softplus_fast(-(pw[j] + lwp[j])) - 0.5f; nlw[j] = -__expf(lw); const float av = sigmoidf_(pa[j] + app[j]);
                kkr[j] = kx[j] * pkk[j]; ss += kkr[j] * kkr[j]; k2[j] = kx[j] * (1.0f + (av - 1.0f) * pka[j]); rk += rr[j] * k2[j] * prk[j]; bet[j] = av; }
          } else {
#pragma unroll
            for (int j = 0; j < 8; ++j) { rr[j] = 0.f; k2[j] = 0.f; kkr[j] = 0.f; bet[j] = 0.f; nlw[j] = 0.f; vx[j] = 0.f; gg[j] = 0.f; }
          }
          ss += __shfl_xor(ss, 1, 64); ss += __shfl_xor(ss, 2, 64); ss += __shfl_xor(ss, 4, 64);
          rk += __shfl_xor(rk, 1, 64); rk += __shfl_xor(rk, 2, 64); rk += __shfl_xor(rk, 4, 64);
          const float inv = 1.0f / fmaxf(sqrtf(ss), 1e-12f);
#pragma unroll
          for (int j = 0; j < 8; ++j) { kap[j] = kkr[j] * inv; bet[j] = kap[j] * bet[j]; }
          if (t < ntok) { const size_t o = (size_t)(row0 + t) * BW + c0;
              *(u32x4*)(Gg + o) = (u32x4){pk2(gg[0], gg[1]), pk2(gg[2], gg[3]), pk2(gg[4], gg[5]), pk2(gg[6], gg[7])};
              *(u32x4*)(BON + o) = (u32x4){pk2(rk * vx[0], rk * vx[1]), pk2(rk * vx[2], rk * vx[3]), pk2(rk * vx[4], rk * vx[5]), pk2(rk * vx[6], rk * vx[7])}; }
          *(LAS f32x4*)(lg_l + t * 68 + cg * 8) = (f32x4){nlw[0], nlw[1], nlw[2], nlw[3]}; *(LAS f32x4*)(lg_l + t * 68 + cg * 8 + 4) = (f32x4){nlw[4], nlw[5], nlw[6], nlw[7]};
#pragma unroll
          for (int j = 0; j < 8; ++j) VT_l[(cg * 8 + j) * 72 + t] = f2bf(vx[j]);
        }
        __syncthreads();
        if (tid < 256) { const int cc = tid & 63, s4 = tid >> 6; float run = 0.f;
#pragma unroll
            for (int i = 0; i < 16; ++i) { const int o = (s4 * 16 + i) * 68 + cc; run += lg_l[o]; lg_l[o] = run; } }
        __syncthreads();
        { unsigned pp[4], pq[4], pk[4], pb[4];
#pragma unroll
          for (int j = 0; j < 8; j += 2) { float vP[2], vQ[2], vK[2], vB[2];
#pragma unroll
              for (int e = 0; e < 2; ++e) { const int jj = j + e, cc = cg * 8 + jj; const float ci = lg_l[t * 68 + cc], cC = lg_l[(sc * 16 + 15) * 68 + cc];
                  const float ei = __expf(-ci), eh = __expf(cC - ci);
                  vP[e] = kap[jj] * __expf(ci - nlw[jj]); vQ[e] = rr[jj] * __expf(ci); vK[e] = k2[jj] * ei; vB[e] = bet[jj] * ei;
                  PT_l[cc * 72 + t] = f2bf(vP[e]); BhT_l[cc * 72 + t] = f2bf(bet[jj] * eh); KhT_l[cc * 72 + t] = f2bf(k2[jj] * eh); }
              pp[j >> 1] = pk2(vP[0], vP[1]); pq[j >> 1] = pk2(vQ[0], vQ[1]); pk[j >> 1] = pk2(vK[0], vK[1]); pb[j >> 1] = pk2(vB[0], vB[1]); }
          const int o = t * 72 + cg * 8;
          *(LAS u32x4*)(P_l + o) = (u32x4){pp[0], pp[1], pp[2], pp[3]}; *(LAS u32x4*)(Q_l + o) = (u32x4){pq[0], pq[1], pq[2], pq[3]};
          *(LAS u32x4*)(Kn_l + o) = (u32x4){pk[0], pk[1], pk[2], pk[3]}; *(LAS u32x4*)(Bn_l + o) = (u32x4){pb[0], pb[1], pb[2], pb[3]};
          if ((t & 15) == 15) {
#pragma unroll
              for (int j = 0; j < 8; ++j) GC_l[sc * 64 + cg * 8 + j] = __expf(lg_l[t * 68 + cg * 8 + j]); } }
        __syncthreads();
        const int nsub = ntok == 64 ? 4 : 1;
        const bf16x8 zfrag = (bf16x8){0, 0, 0, 0, 0, 0, 0, 0};
        for (int id = w; id < nsub * 3; id += 8) { const int s4 = id / 3, prod = id - s4 * 3; f32x4 d = (f32x4){0.f, 0.f, 0.f, 0.f};
            const LAS bf16_t* X = (prod == 1 ? P_l : Bn_l) + (s4 * 16 + r) * 72 + q * 8; const LAS bf16_t* Y = (prod == 0 ? P_l : (prod == 1 ? Kn_l : Q_l)) + (s4 * 16 + r) * 72 + q * 8;
            { const bf16x8 x0 = *(const LAS bf16x8*)X, x1 = *(const LAS bf16x8*)(X + 32), y0 = *(const LAS bf16x8*)Y, y1 = *(const LAS bf16x8*)(Y + 32);
              __builtin_amdgcn_sched_barrier(0); d = mma16(x0, y0, d); d = mma16(x1, y1, d); }
            if (prod == 0) { f32x4 o4;
#pragma unroll
                for (int jj = 0; jj < 4; ++jj) o4[jj] = (q * 4 + jj < r) ? d[jj] : 0.f;
                *(LAS f32x4*)(A_l + s4 * 320 + r * 20 + q * 4) = o4; }
            else { float o4[4];
#pragma unroll
                for (int jj = 0; jj < 4; ++jj) o4[jj] = (prod == 1 ? (r < q * 4 + jj) : (q * 4 + jj <= r)) ? d[jj] : 0.f;
                u32x2 o; o.x = pk2(o4[0], o4[1]); o.y = pk2(o4[2], o4[3]); *(LAS u32x2*)((prod == 1 ? BmT_l : F_l) + s4 * 384 + r * 24 + q * 4) = o; } }
        __syncthreads();
        if (w == 0 && (lane >> 4) < nsub) { const int s4 = lane >> 4, jc = lane & 15; float x[16];
#pragma unroll
            for (int tt = 0; tt < 16; ++tt) { float s = (tt == jc) ? 1.f : 0.f;
#pragma unroll
                for (int i = 0; i < tt; ++i) s -= A_l[s4 * 320 + tt * 20 + i] * x[i];
                x[tt] = s; }
#pragma unroll
            for (int tt = 0; tt < 16; ++tt) Tinv_l[s4 * 384 + tt * 24 + jc] = f2bf(x[tt]); }
        __syncthreads();
        for (int id = w; id < nsub * 5; id += 8) { const int s4 = id / 5, rem = id - s4 * 5;
            const bf16x8 xf = q < 2 ? *(const LAS bf16x8*)(Tinv_l + s4 * 384 + r * 24 + q * 8) : zfrag;
            const bf16x8 yf = q < 2 ? (rem < 4 ? *(const LAS bf16x8*)(PT_l + (rem * 16 + r) * 72 + s4 * 16 + q * 8) : *(const LAS bf16x8*)(BmT_l + s4 * 384 + r * 24 + q * 8)) : zfrag;
            const f32x4 d = mma16(xf, yf, (f32x4){0.f, 0.f, 0.f, 0.f});
            u32x2 o; o.x = pk2(d[0], d[1]); o.y = pk2(d[2], d[3]);
            if (rem < 4) *(LAS u32x2*)(PpT_l + (rem * 16 + r) * 72 + s4 * 16 + q * 4) = o; else *(LAS u32x2*)(BmpT_l + s4 * 384 + r * 24 + q * 4) = o; }
        __syncthreads();
        { const int chunk0 = sq >= 0 ? PB * 16 * 256 + sq * 16 + h : ((row0 / PS) * 16 + h) * 256 + ((row0 % PS) >> 4);
          for (int id = w; id < nsub * 25; id += 8) { const int s4 = id / 25, rem = id - s4 * 25; bf16_t* blob = RB + (size_t)(chunk0 + s4) * RB_EL;
            const bf16x8 fF = q < 2 ? *(const LAS bf16x8*)(F_l + s4 * 384 + r * 24 + q * 8) : zfrag;
            if (rem < 4) {
                const bf16x8 xf = q < 2 ? *(const LAS bf16x8*)(PpT_l + (rem * 16 + r) * 72 + s4 * 16 + q * 8) : zfrag;
                const f32x4 d = mma16(xf, fF, (f32x4){0.f, 0.f, 0.f, 0.f});
                const u32x2 qv = *(const LAS u32x2*)(Q_l + (s4 * 16 + r) * 72 + rem * 16 + q * 4);
                u32x2 o; o.x = pk2(__uint_as_float(qv.x << 16) - d[0], __uint_as_float(qv.x & 0xffff0000u) - d[1]); o.y = pk2(__uint_as_float(qv.y << 16) - d[2], __uint_as_float(qv.y & 0xffff0000u) - d[3]);
                *(u32x2*)(blob + RB_QP + r * 72 + 32 * (rem >> 1) + 8 * q + 4 * (rem & 1)) = o;
            } else if (rem == 4) {
                f32x4 d2 = (f32x4){0.f, 0.f, 0.f, 0.f};
#pragma unroll
                for (int ks = 0; ks < 2; ++ks) d2 = mma16(*(const LAS bf16x8*)(Kn_l + (s4 * 16 + r) * 72 + ks * 32 + q * 8), *(const LAS bf16x8*)(Q_l + (s4 * 16 + r) * 72 + ks * 32 + q * 8), d2);
                const bf16x8 xf = q < 2 ? *(const LAS bf16x8*)(BmpT_l + s4 * 384 + r * 24 + q * 8) : zfrag;
                const f32x4 d1 = mma16(xf, fF, (f32x4){0.f, 0.f, 0.f, 0.f});
                float o4[4];
#pragma unroll
                for (int jj = 0; jj < 4; ++jj) o4[jj] = ((q * 4 + jj <= r) ? d2[jj] : 0.f) - d1[jj];
                u32x2 o; o.x = pk2(o4[0], o4[1]); o.y = pk2(o4[2], o4[3]); *(u32x2*)(blob + RB_EP + r * 24 + q * 4) = o;
            } else if (rem < 21) {
                const int cib = (rem - 5) >> 2, cob = (rem - 5) & 3;
                const bf16x8 xf = q < 2 ? *(const LAS bf16x8*)(PpT_l + (cib * 16 + r) * 72 + s4 * 16 + q * 8) : zfrag;
                const bf16x8 yf = q < 2 ? *(const LAS bf16x8*)(BhT_l + (cob * 16 + r) * 72 + s4 * 16 + q * 8) : zfrag;
                const f32x4 d = mma16(xf, yf, (f32x4){0.f, 0.f, 0.f, 0.f});
                const float gc = GC_l[s4 * 64 + cob * 16 + r]; float o4[4];
#pragma unroll
                for (int jj = 0; jj < 4; ++jj) o4[jj] = ((cib == cob && q * 4 + jj == r) ? gc : 0.f) - d[jj];
                u32x2 o; o.x = pk2(o4[0], o4[1]); o.y = pk2(o4[2], o4[3]); *(u32x2*)(blob + (cob * 16 + r) * 72 + 32 * (cib >> 1) + 8 * q + 4 * (cib & 1)) = o;
            } else {
                const int cb = rem - 21;
                const bf16x8 xf = q < 2 ? *(const LAS bf16x8*)(BmpT_l + s4 * 384 + r * 24 + q * 8) : zfrag;
                const bf16x8 yf = q < 2 ? *(const LAS bf16x8*)(BhT_l + (cb * 16 + r) * 72 + s4 * 16 + q * 8) : zfrag;
                const f32x4 d = mma16(xf, yf, (f32x4){0.f, 0.f, 0.f, 0.f});
                const u32x2 kv = *(const LAS u32x2*)(KhT_l + (cb * 16 + r) * 72 + s4 * 16 + q * 4);
                u32x2 o; o.x = pk2(__uint_as_float(kv.x << 16) - d[0], __uint_as_float(kv.x & 0xffff0000u) - d[1]); o.y = pk2(__uint_as_float(kv.y << 16) - d[2], __uint_as_float(kv.y & 0xffff0000u) - d[3]);
                *(u32x2*)(blob + RB_KHP + (cb * 16 + r) * 24 + q * 4) = o;
            } }
          for (int idx = tid; idx < nsub * 128; idx += 512) { const int s4 = idx >> 7, cc = (idx >> 1) & 63, hf = idx & 1;
              *(u32x4*)(RB + (size_t)(chunk0 + s4) * RB_EL + RB_VT + cc * 24 + hf * 8) = *(const LAS u32x4*)(VT_l + cc * 72 + s4 * 16 + hf * 8); } }
        __syncthreads();
        }
    }
}

__device__ __forceinline__ void ph_rwkv_scan_naive(const Ctx& c, const float* __restrict__ RW, const float* __restrict__ s0, const float* __restrict__ lng, const float* __restrict__ lnb, bf16_t* __restrict__ OB,
                                                   float* __restrict__ outP, float* __restrict__ outS) {
    const float* R = RW; const float* WD = RW + (size_t)MPAD * BW; const float* K2 = WD + (size_t)MPAD * BW; const float* V = K2 + (size_t)MPAD * BW; const float* KK = V + (size_t)MPAD * BW;
    const float* BV = KK + (size_t)MPAD * BW; const float* G = BV + (size_t)MPAD * BW; const float* BON = G + (size_t)MPAD * BW;
    const int lane = c.lane;
    for (int it = 0;; ++it) {
        const int u = (it * 8 + c.wave) * c.G + c.bid;
        if (u >= (PB + SB) * 16) break;
        const int sq = u >> 4, h = u & 15;
        int row0, L; seq_info(sq, row0, L);
        float S[64];
        if (sq >= PB) { const float* p = s0 + (((size_t)(sq - PB) * 16 + h) * 64 + lane) * 64;
#pragma unroll
            for (int j = 0; j < 64; ++j) S[j] = p[j]; }
        else {
#pragma unroll
            for (int j = 0; j < 64; ++j) S[j] = 0.f; }
        const float lg = lng[h * 64 + lane], lb = lnb[h * 64 + lane];
        for (int t = 0; t < L; ++t) {
            const size_t base = (size_t)(row0 + t) * BW + h * 64; const float v = V[base + lane];
            float d = 0.f;
#pragma unroll
            for (int j = 0; j < 64; ++j) d += S[j] * KK[base + j];
            float y = 0.f;
#pragma unroll
            for (int j = 0; j < 64; ++j) { S[j] = S[j] * WD[base + j] - d * BV[base + j] + v * K2[base + j]; y += S[j] * R[base + j]; }
            const float mean = wave_sum(y) * (1.0f / 64.0f), dy = y - mean, var = wave_sum(dy * dy) * (1.0f / 64.0f);
            const float yn = dy * rsqrtf(var + 64e-5f) * lg + lb;
            OB[base + lane] = f2bf((yn + BON[base + lane]) * G[base + lane]);
        }
        float* op = (sq < PB ? outP + (((size_t)sq * 16 + h) * 64 + lane) * 64 : outS + (((size_t)(sq - PB) * 16 + h) * 64 + lane) * 64);
#pragma unroll
        for (int j = 0; j < 64; ++j) op[j] = S[j];
    }
}
__device__ __forceinline__ void ph_rwkv_scan2(const Ctx& c, int boff, const float* __restrict__ RW, const float* __restrict__ s0, const float* __restrict__ lng, const float* __restrict__ lnb, bf16_t* __restrict__ OB,
                                              float* __restrict__ outP, float* __restrict__ outS) {
    LAS float* opb = (LAS float*)c.lds;
    LAS float* yb = opb + 2 * 16 * 384;
    const int tid = c.tid, lane = c.lane, w = c.wave, rl = lane >> 3, cg = lane & 7, vrow = w * 8 + rl;
    const float* G = RW + 6 * (size_t)MPAD * BW; const float* BON = RW + 7 * (size_t)MPAD * BW;
    for (int u = (c.bid - boff + c.G) % c.G; u < (PB + SB) * 16; u += c.G) {
        const int sq = u >> 4, h = u & 15;
        int row0, L; seq_info(sq, row0, L);
        float S[8];
        if (sq >= PB) { const float* p = s0 + (((size_t)(sq - PB) * 16 + h) * 64 + vrow) * 64 + cg * 8;
#pragma unroll
            for (int j = 0; j < 8; ++j) S[j] = p[j]; }
        else {
#pragma unroll
            for (int j = 0; j < 8; ++j) S[j] = 0.f; }
        const float lg = lng[h * 64 + lane], lb = lnb[h * 64 + lane];
        const int nb = (L + 15) >> 4;
#define RW_STAGE(bi_) do { const int t0_ = (bi_) * 16, nT_ = (L - t0_) < 16 ? (L - t0_) : 16; LAS float* dst_ = opb + ((bi_) & 1) * 16 * 384; \
        for (int idx = tid; idx < nT_ * 96; idx += 512) { const int t = idx / 96, rem = idx - t * 96, slot = rem >> 4, c4 = rem & 15; \
            const int arr = slot == 0 ? 1 : slot == 1 ? 4 : slot == 2 ? 5 : slot == 3 ? 2 : slot == 4 ? 0 : 3; \
            *(LAS f32x4*)(dst_ + t * 384 + slot * 64 + c4 * 4) = *(const f32x4*)(RW + (size_t)arr * MPAD * BW + (size_t)(row0 + t0_ + t) * BW + h * 64 + c4 * 4); } } while (0)
        RW_STAGE(0);
        for (int bi = 0; bi < nb; ++bi) {
            __syncthreads();
            if (bi + 1 < nb) RW_STAGE(bi + 1);
            const int t0 = bi * 16, nT = (L - t0) < 16 ? (L - t0) : 16; const LAS float* src = opb + (bi & 1) * 16 * 384;
            for (int tt = 0; tt < nT; ++tt) {
                const LAS float* b = src + tt * 384 + cg * 8;
                const f32x4 w0 = *(const LAS f32x4*)(b), w1 = *(const LAS f32x4*)(b + 4), k0 = *(const LAS f32x4*)(b + 64), k1 = *(const LAS f32x4*)(b + 68);
                const f32x4 b0 = *(const LAS f32x4*)(b + 128), b1 = *(const LAS f32x4*)(b + 132), q0 = *(const LAS f32x4*)(b + 192), q1 = *(const LAS f32x4*)(b + 196);
                const f32x4 r0 = *(const LAS f32x4*)(b + 256), r1 = *(const LAS f32x4*)(b + 260); const float v = src[tt * 384 + 320 + vrow];
                float d = (S[0] * k0[0] + S[1] * k0[1]) + (S[2] * k0[2] + S[3] * k0[3]) + (S[4] * k1[0] + S[5] * k1[1]) + (S[6] * k1[2] + S[7] * k1[3]);
                d += __shfl_xor(d, 1, 64); d += __shfl_xor(d, 2, 64); d += __shfl_xor(d, 4, 64);
                float y = 0.f;
#pragma unroll
                for (int j = 0; j < 4; ++j) { S[j] = S[j] * w0[j] - d * b0[j] + v * q0[j]; y += S[j] * r0[j]; S[4 + j] = S[4 + j] * w1[j] - d * b1[j] + v * q1[j]; y += S[4 + j] * r1[j]; }
                y += __shfl_xor(y, 1, 64); y += __shfl_xor(y, 2, 64); y += __shfl_xor(y, 4, 64);
                if (cg == 0) yb[tt * 64 + vrow] = y;
            }
            __syncthreads();
            for (int tt = w; tt < nT; tt += 8) {
                const float y = yb[tt * 64 + lane]; const float mean = wave_sum(y) * (1.0f / 64.0f), dy = y - mean, var = wave_sum(dy * dy) * (1.0f / 64.0f);
                const float yn = dy * rsqrtf(var + 64e-5f) * lg + lb; const size_t o = (size_t)(row0 + t0 + tt) * BW + h * 64 + lane;
                OB[o] = f2bf((yn + BON[o]) * G[o]);
            }
        }
#undef RW_STAGE
        float* op = (sq < PB ? outP + (((size_t)sq * 16 + h) * 64 + vrow) * 64 : outS + (((size_t)(sq - PB) * 16 + h) * 64 + vrow) * 64) + cg * 8;
#pragma unroll
        for (int j = 0; j < 8; ++j) op[j] = S[j];
        __syncthreads();
    }
}
constexpr int RS_SLOTS = 8, RS_SLOT_B = RB_EL * 2;
__device__ __forceinline__ void ph_rwkv_seq(const Ctx& c, int boff, const bf16_t* __restrict__ RB, const float* __restrict__ s0, float* __restrict__ outP, float* __restrict__ outS, bf16_t* __restrict__ OB) {
    const int lane = c.lane, r = lane & 15, q = lane >> 4, w = c.wave;
    LAS unsigned char* ring = c.lds;
    const int side = c.bid < 32 ? c.bid : c.bid - 64, nside = c.G - 64;
    for (int u = (c.bid >= boff && c.bid < boff + 32) ? c.bid - boff : ((c.bid < 32 || c.bid >= 96) ? 32 + side : (PB + SB) * 16); u < (PB + SB) * 16; u = u < 32 ? (PB + SB) * 16 : u + nside) {
        const int sq = u >> 4, h = u & 15;
        int nch, ch0, row0, ntok; const float* sp = nullptr; float* op;
        if (sq < PB) { nch = 256; ch0 = (sq * 16 + h) * 256; row0 = sq * PS; ntok = 16; op = outP + (size_t)(sq * 16 + h) * 4096; }
        else { nch = 1; ch0 = PB * 16 * 256 + (sq - PB) * 16 + h; row0 = MP + (sq - PB) * SS; ntok = SS; sp = s0 + (size_t)((sq - PB) * 16 + h) * 4096; op = outS + (size_t)((sq - PB) * 16 + h) * 4096; }
        if (w >= 4) {
            const int lw = w - 4, p0 = lw < 2 ? lw * 5 : 10 + (lw - 2) * 4, np = lw < 2 ? 5 : 4;
#define RS_ISSUE(ci_) do { const int cc_ = (ci_) < nch ? (ci_) : nch - 1; const char* g_ = (const char*)(RB + (size_t)(ch0 + cc_) * RB_EL) + p0 * 1024 + lane * 16; \
            LAS unsigned char* d_ = ring + ((ci_) % RS_SLOTS) * RS_SLOT_B + p0 * 1024; \
            _Pragma("unroll") for (int p_ = 0; p_ < 5; ++p_) if (p_ < np) __builtin_amdgcn_global_load_lds((const unsigned*)(g_ + p_ * 1024), (LAS unsigned*)(d_ + p_ * 1024), 16, 0, 0); } while (0)
            for (int ci = 0; ci < RS_SLOTS - 1; ++ci) RS_ISSUE(ci);
            if (lw < 2) asm volatile("s_waitcnt vmcnt(30)" ::: "memory"); else asm volatile("s_waitcnt vmcnt(24)" ::: "memory");
            __builtin_amdgcn_s_barrier();
            for (int ci = 0; ci < nch; ++ci) {
                RS_ISSUE(ci + RS_SLOTS - 1);
                if (lw < 2) asm volatile("s_waitcnt vmcnt(30)" ::: "memory"); else asm volatile("s_waitcnt vmcnt(24)" ::: "memory");
                __builtin_amdgcn_s_barrier();
            }
#undef RS_ISSUE
            asm volatile("s_waitcnt vmcnt(0)" ::: "memory");
        } else {
            const int vb = w; f32x4 acc[4];
#pragma unroll
            for (int kb = 0; kb < 4; ++kb) acc[kb] = sp ? *(const f32x4*)(sp + (size_t)(vb * 16 + r) * 64 + kb * 16 + q * 4) : (f32x4){0.f, 0.f, 0.f, 0.f};
            const bf16x8 zfrag = (bf16x8){0, 0, 0, 0, 0, 0, 0, 0};
            __builtin_amdgcn_s_barrier();
            for (int ci = 0; ci < nch; ++ci) {
                const LAS bf16_t* blob = (const LAS bf16_t*)(ring + (ci % RS_SLOTS) * RS_SLOT_B);
                bf16x8 mf[4][2], khf[4], qpf[2];
#pragma unroll
                for (int kb = 0; kb < 4; ++kb) { mf[kb][0] = *(const LAS bf16x8*)(blob + (kb * 16 + r) * 72 + q * 8); mf[kb][1] = *(const LAS bf16x8*)(blob + (kb * 16 + r) * 72 + 32 + q * 8);
                    khf[kb] = q < 2 ? *(const LAS bf16x8*)(blob + RB_KHP + (kb * 16 + r) * 24 + q * 8) : zfrag; }
                qpf[0] = *(const LAS bf16x8*)(blob + RB_QP + r * 72 + q * 8); qpf[1] = *(const LAS bf16x8*)(blob + RB_QP + r * 72 + 32 + q * 8);
                const bf16x8 vt = q < 2 ? *(const LAS bf16x8*)(blob + RB_VT + (vb * 16 + r) * 24 + q * 8) : zfrag;
                const bf16x8 ep = q < 2 ? *(const LAS bf16x8*)(blob + RB_EP + r * 24 + q * 8) : zfrag;
                const bf16x8 t0 = pack_acc(acc[0], acc[1]), t1 = pack_acc(acc[2], acc[3]);
                __builtin_amdgcn_sched_barrier(0);
#pragma unroll
                for (int kb = 0; kb < 4; ++kb) acc[kb] = mma16(mf[kb][0], t0, (f32x4){0.f, 0.f, 0.f, 0.f});
#pragma unroll
                for (int kb = 0; kb < 4; ++kb) acc[kb] = mma16(mf[kb][1], t1, acc[kb]);
#pragma unroll
                for (int kb = 0; kb < 4; ++kb) acc[kb] = mma16(khf[kb], vt, acc[kb]);
                f32x4 y = mma16(t0, qpf[0], (f32x4){0.f, 0.f, 0.f, 0.f}); y = mma16(t1, qpf[1], y); y = mma16(vt, ep, y);
                if (r < ntok) { u32x2 o; o.x = pk2(y[0], y[1]); o.y = pk2(y[2], y[3]); *(u32x2*)(OB + (size_t)(row0 + ci * 16 + r) * BW + h * 64 + vb * 16 + q * 4) = o; }
                asm volatile("s_waitcnt lgkmcnt(0)" ::: "memory");
                __builtin_amdgcn_s_barrier();
            }
#pragma unroll
            for (int kb = 0; kb < 4; ++kb) *(f32x4*)(op + (size_t)(vb * 16 + r) * 64 + kb * 16 + q * 4) = acc[kb];
        }
        __syncthreads();
    }
}
__device__ __forceinline__ void ph_rwkv_fin(const Ctx& c, const float* __restrict__ RW, const float* __restrict__ lng, const float* __restrict__ lnb, const bf16_t* __restrict__ RAW, bf16_t* __restrict__ OB) {
    const int lane = c.lane; const bf16_t* G = (const bf16_t*)(RW + 6 * (size_t)MPAD * BW); const bf16_t* BON = (const bf16_t*)(RW + 7 * (size_t)MPAD * BW);
    for (int i = c.bid * 8 + c.wave; i < MT * 2; i += c.G * 8) {
        const int row = i >> 1, cc = (i & 1) * 512 + lane * 8; const size_t o = (size_t)row * BW + cc;
        float x[8], bo[8], gt[8]; unpack8(*(const u32x4*)(RAW + o), x); unpack8(*(const u32x4*)(BON + o), bo); unpack8(*(const u32x4*)(G + o), gt);
        float s = 0.f;
#pragma unroll
        for (int j = 0; j < 8; ++j) s += x[j];
        s += __shfl_xor(s, 1, 64); s += __shfl_xor(s, 2, 64); s += __shfl_xor(s, 4, 64);
        const float mean = s * (1.0f / 64.0f); float qq = 0.f;
#pragma unroll
        for (int j = 0; j < 8; ++j) { const float d = x[j] - mean; qq += d * d; }
        qq += __shfl_xor(qq, 1, 64); qq += __shfl_xor(qq, 2, 64); qq += __shfl_xor(qq, 4, 64);
        const float rstd = rsqrtf(qq * (1.0f / 64.0f) + 64e-5f);
        const f32x4 g0 = *(const f32x4*)(lng + cc), g1 = *(const f32x4*)(lng + cc + 4), b0 = *(const f32x4*)(lnb + cc), b1 = *(const f32x4*)(lnb + cc + 4); float ov[8];
#pragma unroll
        for (int j = 0; j < 8; ++j) ov[j] = ((x[j] - mean) * rstd * (j < 4 ? g0[j] : g1[j - 4]) + (j < 4 ? b0[j] : b1[j - 4]) + bo[j]) * gt[j];
        *(u32x4*)(OB + o) = (u32x4){pk2(ov[0], ov[1]), pk2(ov[2], ov[3]), pk2(ov[4], ov[5]), pk2(ov[6], ov[7])};
    }
}

__device__ __forceinline__ void ph_memattn_sample(const Ctx& c, int boff, const bf16_t* __restrict__ U, const float* __restrict__ mk, const float* __restrict__ mv, bf16_t* __restrict__ OB) {
    LAS float* ps = (LAS float*)c.lds;
    const int hh = c.tid >> 8, vt = c.tid & 255, lane = c.lane, r = lane & 15, q = lane >> 4, w4 = c.wave & 3;
    for (int u = (c.bid - boff + c.G) % c.G; u < SB * 2; u += c.G) {
        const int sq = u >> 1, h = (u & 1) * 2 + hh;
        bf16x8 qf[8];
#pragma unroll
        for (int ks = 0; ks < 8; ++ks) { u32x4 raw = (u32x4){0u, 0u, 0u, 0u};
            if (r < 4) raw = *(const u32x4*)(U + (size_t)(MP + sq * SS + r) * NINP + U_MQ + h * 256 + ks * 32 + q * 8);
            qf[ks] = __builtin_bit_cast(bf16x8, raw); }
#pragma unroll 1
        for (int mt = 0; mt < 4; ++mt) { const float* kr = mk + (((size_t)sq * MEMT + (w4 * 4 + mt) * 16 + r) * 4 + h) * 256 + q * 8; f32x4 ka[8], kb2[8];
#pragma unroll
            for (int ks = 0; ks < 8; ++ks) { ka[ks] = *(const f32x4*)(kr + ks * 32); kb2[ks] = *(const f32x4*)(kr + ks * 32 + 4); }
            __builtin_amdgcn_sched_barrier(0);
            f32x4 d = (f32x4){0.f, 0.f, 0.f, 0.f};
#pragma unroll
            for (int ks = 0; ks < 8; ++ks) { u32x4 p; p.x = pk2(ka[ks][0], ka[ks][1]); p.y = pk2(ka[ks][2], ka[ks][3]); p.z = pk2(kb2[ks][0], kb2[ks][1]); p.w = pk2(kb2[ks][2], kb2[ks][3]);
                d = mma16(__builtin_bit_cast(bf16x8, p), qf[ks], d); }
            if (r < 4) *(LAS f32x4*)(ps + (hh * 4 + r) * 256 + (w4 * 4 + mt) * 16 + q * 4) = d * 0.0625f; }
        __syncthreads();
        { LAS float* pr = ps + c.wave * 256; float x[4]; float mx = -3.0e38f;
#pragma unroll
            for (int j = 0; j < 4; ++j) { x[j] = pr[lane + 64 * j]; mx = fmaxf(mx, x[j]); }
            mx = wave_max(mx); float s = 0.f;
#pragma unroll
            for (int j = 0; j < 4; ++j) { x[j] = __expf(x[j] - mx); s += x[j]; }
            const float inv = 1.0f / wave_sum(s);
#pragma unroll
            for (int j = 0; j < 4; ++j) pr[lane + 64 * j] = x[j] * inv; }
        __syncthreads();
        { float o[4] = {0.f, 0.f, 0.f, 0.f}; const float* vr = mv + ((size_t)sq * MEMT * 4 + h) * 256 + vt;
#pragma unroll 8
            for (int m = 0; m < MEMT; ++m) { const float vv = vr[(size_t)m * 1024];
#pragma unroll
                for (int t = 0; t < 4; ++t) o[t] += ps[(hh * 4 + t) * 256 + m] * vv; }
#pragma unroll
            for (int t = 0; t < 4; ++t) OB[(size_t)(MP + sq * SS + t) * BW + h * 256 + vt] = f2bf(o[t]); }
        __syncthreads();
    }
}

template <int K, int LDA, int LDB> __device__ __forceinline__ void skinny_pair(const Ctx& c, const bf16_t* __restrict__ A, const bf16_t* __restrict__ B0, const bf16_t* __restrict__ B1, f32x4 (&out)[2], int rot) {
    LAS f32x4* red = (LAS f32x4*)c.lds;
    const int lane = c.lane, r = lane & 15, q = lane >> 4, w = c.wave;
    constexpr int KS = K / 8;
    const bf16_t* ap = A + (size_t)r * LDA + w * KS + q * 8; const bf16_t* b0 = B0 + (size_t)r * LDB + w * KS + q * 8; const bf16_t* b1 = B1 + (size_t)r * LDB + w * KS + q * 8;
    f32x4 acc[2][8];
#pragma unroll
    for (int n = 0; n < 2; ++n)
#pragma unroll
        for (int m = 0; m < 8; ++m) acc[n][m] = (f32x4){0.f, 0.f, 0.f, 0.f};
    int kk = (int)((unsigned)rot % (unsigned)(KS / 32));
#pragma unroll 2
    for (int it = 0; it < KS / 32; ++it) { const int ks = kk; kk = kk + 1 == KS / 32 ? 0 : kk + 1;
        const bf16x8 f0 = *(const bf16x8*)(b0 + ks * 32), f1 = *(const bf16x8*)(b1 + ks * 32); bf16x8 af[8];
#pragma unroll
        for (int m = 0; m < 8; ++m) af[m] = *(const bf16x8*)(ap + (size_t)(m * 16) * LDA + ks * 32);
        __builtin_amdgcn_sched_barrier(0);
#pragma unroll
        for (int m = 0; m < 8; ++m) { acc[0][m] = mma16(f0, af[m], acc[0][m]); acc[1][m] = mma16(f1, af[m], acc[1][m]); } }
    __syncthreads();
#pragma unroll
    for (int n = 0; n < 2; ++n)
#pragma unroll
        for (int m = 0; m < 8; ++m) red[(w * 16 + n * 8 + m) * 64 + lane] = acc[n][m];
    __syncthreads();
#pragma unroll
    for (int n = 0; n < 2; ++n) { f32x4 s = red[(n * 8 + w) * 64 + lane];
#pragma unroll
        for (int ww = 1; ww < 8; ++ww) s += red[(ww * 16 + n * 8 + w) * 64 + lane];
        out[n] = s; }
}
template <int K, int LDA, int LDB> __device__ __forceinline__ f32x4 skinny_one(const Ctx& c, const bf16_t* __restrict__ A, const bf16_t* __restrict__ B0, int rot) {
    LAS f32x4* red = (LAS f32x4*)c.lds;
    const int lane = c.lane, r = lane & 15, q = lane >> 4, w = c.wave;
    constexpr int KS = K / 8, NK = KS / 32;
    const bf16_t* ap = A + (size_t)r * LDA + w * KS + q * 8; const bf16_t* b0 = B0 + (size_t)r * LDB + w * KS + q * 8;
    f32x4 acc[8];
#pragma unroll
    for (int m = 0; m < 8; ++m) acc[m] = (f32x4){0.f, 0.f, 0.f, 0.f};
    int kk = (int)((unsigned)rot % (unsigned)NK);
#pragma unroll 4
    for (int it = 0; it < NK; ++it) { const int ks = kk; kk = kk + 1 == NK ? 0 : kk + 1;
        const bf16x8 f0 = *(const bf16x8*)(b0 + ks * 32); bf16x8 af[8];
#pragma unroll
        for (int m = 0; m < 8; ++m) af[m] = *(const bf16x8*)(ap + (size_t)(m * 16) * LDA + ks * 32);
        __builtin_amdgcn_sched_barrier(0);
#pragma unroll
        for (int m = 0; m < 8; ++m) acc[m] = mma16(f0, af[m], acc[m]); }
    __syncthreads();
#pragma unroll
    for (int m = 0; m < 8; ++m) red[(w * 8 + m) * 64 + lane] = acc[m];
    __syncthreads();
    f32x4 s = red[w * 64 + lane];
#pragma unroll
    for (int ww = 1; ww < 8; ++ww) s += red[(ww * 8 + w) * 64 + lane];
    return s;
}
template <int K, int LDA, int LDB> __device__ __forceinline__ f32x4 skinny_half(const Ctx& c, const bf16_t* __restrict__ A, const bf16_t* __restrict__ B0) {
    LAS f32x4* red = (LAS f32x4*)c.lds;
    const int lane = c.lane, r = lane & 15, q = lane >> 4, w = c.wave;
    constexpr int KS = K / 8, NK = KS / 32;
    const bf16_t* ap = A + (size_t)r * LDA + w * KS + q * 8; const bf16_t* b0 = B0 + (size_t)r * LDB + w * KS + q * 8;
    f32x4 acc[4];
#pragma unroll
    for (int m = 0; m < 4; ++m) acc[m] = (f32x4){0.f, 0.f, 0.f, 0.f};
#pragma unroll 4
    for (int ks = 0; ks < NK; ++ks) {
        const bf16x8 f0 = *(const bf16x8*)(b0 + ks * 32); bf16x8 af[4];
#pragma unroll
        for (int m = 0; m < 4; ++m) af[m] = *(const bf16x8*)(ap + (size_t)(m * 16) * LDA + ks * 32);
        __builtin_amdgcn_sched_barrier(0);
#pragma unroll
        for (int m = 0; m < 4; ++m) acc[m] = mma16(f0, af[m], acc[m]); }
    __syncthreads();
#pragma unroll
    for (int m = 0; m < 4; ++m) red[(w * 4 + m) * 64 + lane] = acc[m];
    __syncthreads();
    f32x4 s = (f32x4){0.f, 0.f, 0.f, 0.f};
    if (w < 4) { s = red[w * 64 + lane];
#pragma unroll
        for (int ww = 1; ww < 8; ++ww) s += red[(ww * 4 + w) * 64 + lane]; }
    return s;
}
__device__ __forceinline__ u32x2 pk4(const f32x4 v) { u32x2 o; o.x = pk2(v[0], v[1]); o.y = pk2(v[2], v[3]); return o; }
#define SKINNY_LOOP(total_) for (int s = c.bid - base; s >= 0 && s < (total_); s += ncu)
__device__ __forceinline__ void ph_sk_in(const Ctx& c, int base, int ncu, const bf16_t* __restrict__ HB, const bf16_t* __restrict__ W, bf16_t* __restrict__ U) {
    const int r = c.lane & 15, q = c.lane >> 4, w = c.wave;
    SKINNY_LOOP(NINP / 32) { f32x4 o[2]; skinny_pair<DM, DM, DM>(c, HB + (size_t)MP * DM, W + (size_t)(s * 32) * DM, W + (size_t)(s * 32 + 16) * DM, o, s);
        bf16_t* up = U + (size_t)(MP + w * 16 + r) * NINP + s * 32 + q * 4; *(u32x2*)up = pk4(o[0]); *(u32x2*)(up + 16) = pk4(o[1]); }
}
__device__ __forceinline__ void ph_sk_merge(const Ctx& c, int base, int ncu, const bf16_t* __restrict__ BR, const bf16_t* __restrict__ W, const bf16_t* __restrict__ U, const float* __restrict__ gate_b, bf16_t* __restrict__ MGB) {
    const int r = c.lane & 15, q = c.lane >> 4, w = c.wave;
    SKINNY_LOOP(DM / 8) { const int ct = s >> 1, hf = s & 1; const size_t row = (size_t)(MP + hf * 64 + (w & 3) * 16 + r); const int col = ct * 16 + q * 4; f32x4 tot = (f32x4){0.f, 0.f, 0.f, 0.f};
#pragma unroll 1
        for (int z = 0; z < 4; ++z) { const f32x4 o = skinny_half<BW, BW, BW>(c, BR + ((size_t)z * MPAD + MP + hf * 64) * BW, W + ((size_t)z * DM + ct * 16) * BW);
            if (w < 4) { const u32x2 gp = *(const u32x2*)(U + row * NINP + U_GP + z * DM + col); const f32x4 gb = *(const f32x4*)(gate_b + z * DM + col);
            tot[0] += sigmoidf_(__uint_as_float(gp.x << 16) + gb[0]) * o[0]; tot[1] += sigmoidf_(__uint_as_float(gp.x & 0xffff0000u) + gb[1]) * o[1];
            tot[2] += sigmoidf_(__uint_as_float(gp.y << 16) + gb[2]) * o[2]; tot[3] += sigmoidf_(__uint_as_float(gp.y & 0xffff0000u) + gb[3]) * o[3]; } }
        if (w < 4) *(u32x2*)(MGB + row * DM + col) = pk4(tot); }
}
template <int K> __device__ __forceinline__ void ph_sk_res(const Ctx& c, int base, int ncu, const bf16_t* __restrict__ A, const bf16_t* __restrict__ W, const bf16_t* __restrict__ R, bf16_t* __restrict__ Y) {
    const int r = c.lane & 15, q = c.lane >> 4, w = c.wave;
    SKINNY_LOOP(DM / 8) { const int ct = s >> 1, hf = s & 1; const f32x4 o = skinny_half<K, K, K>(c, A + (size_t)(MP + hf * 64) * K, W + (size_t)(ct * 16) * K);
        if (w < 4) { const size_t off = (size_t)(MP + hf * 64 + w * 16 + r) * DM + ct * 16 + q * 4; const u32x2 rr = *(const u32x2*)(R + off);
        const f32x4 rv = (f32x4){__uint_as_float(rr.x << 16), __uint_as_float(rr.x & 0xffff0000u), __uint_as_float(rr.y << 16), __uint_as_float(rr.y & 0xffff0000u)};
        *(u32x2*)(Y + off) = pk4(rv * ALPHA + o); } }
}
__device__ __forceinline__ void ph_sk_gu(const Ctx& c, int base, int ncu, const bf16_t* __restrict__ X1B, const bf16_t* __restrict__ W, bf16_t* __restrict__ ACT) {
    const int r = c.lane & 15, q = c.lane >> 4, w = c.wave;
    SKINNY_LOOP(DFF / 16) { const int t = s >> 3, j0 = (s & 7) * 16; f32x4 o[2];
        skinny_pair<DM, DM, DM>(c, X1B + (size_t)MP * DM, W + (size_t)(t * 256 + j0) * DM, W + (size_t)(t * 256 + 128 + j0) * DM, o, s);
        f32x4 v;
#pragma unroll
        for (int j = 0; j < 4; ++j) v[j] = o[0][j] * sigmoidf_(o[0][j]) * o[1][j];
        *(u32x2*)(ACT + (size_t)(MP + w * 16 + r) * DFF + t * 128 + j0 + q * 4) = pk4(v); }
}
#undef SKINNY_LOOP

constexpr int LDS_BAR_OFF = 147456;
constexpr int LDS_BYTES = LDS_BAR_OFF + 64;
struct Args { const float* in[37]; float* out; unsigned char* ws; };

typedef pg8::Gemm<DM, DM, DM, 2, 8, NL, 1, false, 0, 0, (long)DM * DM, 0> GemmMem;
typedef pg8::Gemm<DM, DM, DM, MP / 256, NINP / 256> GemmIn;
typedef pg8::Gemm<NINP, 1024, 256, PS / 256, 1, 8, 4, false, (long)PS * NINP, 256, 256 * 1024, 256> GemmScore;
typedef pg8::Gemm<256, 256, 256, PS / 256, 1, 8, 4, false, (long)4 * 4096 * 256, (long)4096 * 256, 4 * 65536, 65536> GemmPV;
typedef pg8::Gemm<BW, BW, BW, MP / 256, DM / 256, 4, 1, true, (long)MPAD * BW, 0, (long)DM * BW, 0> GemmBranch;
typedef pg8::Gemm<DM, DM, DM, MP / 256, DM / 256> GemmOut;
typedef pg8::Gemm<DM, DM, DM, MP / 256, 2 * DFF / 256> GemmGU;
typedef pg8::Gemm<DFF, DFF, DFF, MP / 256, DM / 256> GemmDown;
template <class GT> __device__ __forceinline__ GT mk_gemm(const Ctx& c, const bf16_t* A, const bf16_t* B) { GT g; g.A = A; g.B = B; g.G = c.G; g.c = c.bid; return g; }

template <int OFF> __device__ __forceinline__ unsigned long long karg_u64(unsigned long long kargs) {
    unsigned long long p; asm volatile("s_load_dwordx2 %0, %1, %2\n\ts_waitcnt lgkmcnt(0)" : "=s"(p) : "s"(kargs), "n"(OFF) : "memory"); return p;
}
#define GPTR(T, x) ((T*)(__attribute__((address_space(1))) T*)(x))
#define INP(k) GPTR(const float, karg_u64<(k) * 8>(kargs))
#define OUTP() GPTR(float, karg_u64<37 * 8>(kargs))
#define WSP() GPTR(unsigned char, karg_u64<38 * 8>(kargs))

__global__ void __launch_bounds__(512, 2) mega_fwd(Args a_unused) {
    extern __shared__ __attribute__((aligned(16))) unsigned char lds_raw[];
    const unsigned long long kargs = (unsigned long long)__builtin_amdgcn_kernarg_segment_ptr();
    Ctx c0; c0.tid = threadIdx.x; c0.lane = c0.tid & 63; c0.wave = __builtin_amdgcn_readfirstlane(c0.tid >> 6); c0.bid = blockIdx.x; c0.G = gridDim.x; c0.lds = (LAS unsigned char*)lds_raw;
    if (c0.tid < 4) ((LAS unsigned*)(c0.lds + LDS_BAR_OFF))[c0.tid] = 0u;
    __syncthreads();
    const XcdBarrier bar = xcd_barrier_post((unsigned*)(WSP() + WS_CTL), (volatile LAS unsigned*)(c0.lds + LDS_BAR_OFF));

#define WPREP_WIN(cc_, L_) do { unsigned char* ws_ = WSP(); \
      ph_wprep(cc_, INP(10) + (size_t)(L_) * DM * NIN, (bf16_t*)(ws_ + WS_WIN) + (size_t)(L_) * NINP * DM, DM, NIN, NINP, 1, 1, 0, 0); } while (0)
#define WPREP_LAYER(cc_, L_) do { WPREP_WIN(cc_, L_); WPREP_REST(cc_, L_); } while (0)
#define WPREP_REST(cc_, L_) do { unsigned char* ws_ = WSP(); \
      ph_wprep(cc_, INP(29) + (size_t)(L_) * 4 * BW * DM, (bf16_t*)(ws_ + WS_WBR) + (size_t)(L_) * 4 * DM * BW, BW, DM, DM, 0, 4, (size_t)BW * DM, (size_t)DM * BW); \
      ph_wprep(cc_, INP(30) + (size_t)(L_) * DM * DM, (bf16_t*)(ws_ + WS_WOUT) + (size_t)(L_) * DM * DM, DM, DM, DM, 0, 1, 0, 0); \
      ph_wprep(cc_, INP(33) + (size_t)(L_) * DM * 2 * DFF, (bf16_t*)(ws_ + WS_WGU) + (size_t)(L_) * 2 * DFF * DM, DM, 2 * DFF, 2 * DFF, 2, 1, 0, 0); \
      ph_wprep(cc_, INP(34) + (size_t)(L_) * DFF * DM, (bf16_t*)(ws_ + WS_WDN) + (size_t)(L_) * DM * DFF, DFF, DM, DM, 0, 1, 0, 0); } while (0)
    { const Ctx c = fresh(c0); unsigned char* ws = WSP();
      ph_wprep(c, INP(28), (bf16_t*)(ws + WS_WMEM), DM, DM, DM, 0, NL, (size_t)DM * DM, (size_t)DM * DM);
      WPREP_WIN(c, 0);
      ph_lrw(c, INP(19), INP(21), INP(22), (bf16_t*)(ws + WS_LRW));
      ph_xprep(c, INP(0), INP(1), INP(2), (float*)nullptr, (bf16_t*)(ws + WS_HB), (bf16_t*)(ws + WS_MEMB)); }
    xcd_barrier(bar);
    if (c0.bid >= 64) { Ctx c = fresh(c0); c.bid -= 64; c.G -= 64; WPREP_REST(c, 0); }
    { const Ctx c = fresh(c0); unsigned char* ws = WSP(); float* out = OUTP();
      GemmMem g = mk_gemm<GemmMem>(c, (const bf16_t*)(ws + WS_MEMB), (const bf16_t*)(ws + WS_WMEM));
      pg8::EpiMem E; E.outK = out + O_MKP; E.outV = out + O_MVP; E.kb = (bf16_t*)(ws + WS_MKB); E.vt = (bf16_t*)(ws + WS_MVT); pg8::gemm_phase<GemmMem, pg8::EpiMem, true, true>(c.lds, c.tid, g, E); }

    for (int l = 0; l < NL; ++l) {
        { const Ctx c = fresh(c0); unsigned char* ws = WSP();
          GemmIn g = mk_gemm<GemmIn>(c, (const bf16_t*)(ws + WS_HB), (const bf16_t*)(ws + WS_WIN) + (size_t)l * NINP * DM);
          pg8::EpiBf16 E; E.O = (bf16_t*)(ws + WS_U); E.zs = 0; E.ldc = NINP; E.pad = 0; pg8::gemm_phase<GemmIn, pg8::EpiBf16, true, true>(c.lds, c.tid, g, E); }
        { const Ctx c = fresh(c0); unsigned char* ws = WSP(); ph_sk_in(c, c.G > 192 ? 96 : 0, c.G > 192 ? c.G - 96 : c.G, (const bf16_t*)(ws + WS_HB), (const bf16_t*)(ws + WS_WIN) + (size_t)l * NINP * DM, (bf16_t*)(ws + WS_U)); }
        xcd_barrier(bar);
        { const Ctx c = fresh(c0); unsigned char* ws = WSP(); float* out = OUTP(); const bf16_t* U = (const bf16_t*)(ws + WS_U); bf16_t* BR = (bf16_t*)(ws + WS_BR);
          (void)out; (void)BR;
          ph_gla_pre(c, U, INP(12) + (size_t)l * 16 * 512, INP(13) + (size_t)l * 512, (bf16_t*)(ws + WS_GLQD), (bf16_t*)(ws + WS_GLKH), (bf16_t*)(ws + WS_GLE), (bf16_t*)(ws + WS_GLVT), (float*)(ws + WS_GLGC)); }
        { const Ctx c = fresh(c0); unsigned char* ws = WSP();
          ph_rwkv_pre(c, (const bf16_t*)(ws + WS_U), INP(9) + (size_t)l * SB * RWC, INP(17) + (size_t)l * RWC, INP(18) + (size_t)l * BW, INP(19) + (size_t)l * 64 * BW, INP(20) + (size_t)l * BW, INP(21) + (size_t)l * 64 * BW,
                       INP(22) + (size_t)l * 128 * BW, INP(23) + (size_t)l * BW, INP(24) + (size_t)l * BW, INP(25) + (size_t)l * BW, (float*)(ws + WS_RW), (bf16_t*)(ws + WS_RB), (const bf16_t*)(ws + WS_LRW) + (size_t)l * 1024 * 256); }
        { const Ctx c = fresh(c0); unsigned char* ws = WSP(); ph_memattn_prompt(c, (const bf16_t*)(ws + WS_U), (const bf16_t*)(ws + WS_MKB) + (size_t)l * 512 * 1024, (const bf16_t*)(ws + WS_MVT) + (size_t)l * 8 * 65536, (bf16_t*)(ws + WS_BR) + (size_t)3 * MPAD * BW); }
        xcd_barrier(bar);
        { const Ctx c = fresh(c0); unsigned char* ws = WSP(); float* out = OUTP();
          ph_rwkv_seq(c, 64, (const bf16_t*)(ws + WS_RB), INP(8) + (size_t)l * SB * 16 * 4096, out + O_RWP + (size_t)l * PB * 16 * 4096, out + O_RWS + (size_t)l * SB * 16 * 4096,
                      (bf16_t*)(ws + WS_RAW) + (size_t)MPAD * BW); }
        { const Ctx c = fresh(c0); unsigned char* ws = WSP(); float* out = OUTP();
          ph_gla_seq(c, 32, (const bf16_t*)(ws + WS_GLQD), (const bf16_t*)(ws + WS_GLKH), (const bf16_t*)(ws + WS_GLE), (const bf16_t*)(ws + WS_GLVT), (const float*)(ws + WS_GLGC),
                     INP(7) + (size_t)l * SB * 4 * 32768, out + O_GLAP + (size_t)l * PB * 4 * 32768, out + O_GLAS + (size_t)l * SB * 4 * 32768, (bf16_t*)(ws + WS_RAW)); }
        if ((c0.bid < 32 || c0.bid >= 96) && c0.G > 96) {
        { Ctx c = fresh(c0); c.bid = c.bid < 32 ? c.bid : c.bid - 64; c.G = c.G - 64; unsigned char* ws = WSP(); ph_swa_prompt(c, (const bf16_t*)(ws + WS_U), INP(16) + (size_t)l * 16, (bf16_t*)(ws + WS_BR) + (size_t)MPAD * BW); }
        { Ctx c = fresh(c0); c.bid = c.bid < 32 ? c.bid : c.bid - 64; c.G = c.G - 64; unsigned char* ws = WSP();
          ph_swa_sample(c, (const bf16_t*)(ws + WS_U), INP(3) + (size_t)l * SB * 16384, INP(4) + (size_t)l * SB * 16384, INP(16) + (size_t)l * 16, (bf16_t*)(ws + WS_BR) + (size_t)MPAD * BW); }
        { Ctx c = fresh(c0); c.bid = c.bid < 32 ? c.bid : c.bid - 64; c.G = c.G - 64; unsigned char* ws = WSP();
          ph_memattn_sample(c, 64, (const bf16_t*)(ws + WS_U), INP(5) + (size_t)l * SB * MEMT * 1024, INP(6) + (size_t)l * SB * MEMT * 1024, (bf16_t*)(ws + WS_BR) + (size_t)3 * MPAD * BW); }
        { Ctx c = fresh(c0); c.bid = c.bid < 32 ? c.bid : c.bid - 64; c.G = c.G - 64; unsigned char* ws = WSP();
          ph_copy_outs(c, (const bf16_t*)(ws + WS_U), INP(3) + (size_t)l * SB * 16384, INP(4) + (size_t)l * SB * 16384, OUTP(), l); }
          if (l + 1 < NL) { Ctx c = fresh(c0); const int sd = c.bid < 32 ? c.bid : c.bid - 64; c.G = 2 * (c.G - 64) + 96;
            c.bid = 2 * sd; WPREP_LAYER(c, l + 1); c.bid = 2 * sd + 1; WPREP_LAYER(c, l + 1); }
        } else if (l + 1 < NL && c0.G > 96) { Ctx c = fresh(c0); const int nside2 = 2 * (c.G - 64); c.G = nside2 + 96;
          if (c0.bid < 64) { c.bid = nside2 + 2 * (c0.bid - 32); WPREP_LAYER(c, l + 1); c.bid = nside2 + 2 * (c0.bid - 32) + 1; WPREP_LAYER(c, l + 1); }
          else { c.bid = nside2 + 64 + (c0.bid - 64); WPREP_LAYER(c, l + 1); }
        }
        xcd_barrier(bar);
        { const Ctx c = fresh(c0); unsigned char* ws = WSP(); ph_rwkv_fin(c, (const float*)(ws + WS_RW), INP(26) + (size_t)l * BW, INP(27) + (size_t)l * BW, (const bf16_t*)(ws + WS_RAW) + (size_t)MPAD * BW, (bf16_t*)(ws + WS_BR) + (size_t)2 * MPAD * BW); }
        { const Ctx c = fresh(c0); unsigned char* ws = WSP(); ph_gla_fin(c, (const bf16_t*)(ws + WS_U), INP(14) + (size_t)l * BW, INP(15) + (size_t)l * BW, (const bf16_t*)(ws + WS_RAW), (bf16_t*)(ws + WS_BR)); }
        xcd_barrier(bar);
        { const Ctx c = fresh(c0); unsigned char* ws = WSP();
          GemmBranch g = mk_gemm<GemmBranch>(c, (const bf16_t*)(ws + WS_BR), (const bf16_t*)(ws + WS_WBR) + (size_t)l * 4 * DM * BW);
          pg8::EpiMerge E; E.MG = (float*)(ws + WS_MG); E.MGB = (bf16_t*)(ws + WS_MGB); E.U = (const bf16_t*)(ws + WS_U); E.gate_b = INP(11) + (size_t)l * 4 * DM; pg8::gemm_phase<GemmBranch, pg8::EpiMerge, true, true>(c.lds, c.tid, g, E); }
        { const Ctx c = fresh(c0); unsigned char* ws = WSP(); ph_sk_merge(c, 0, c.G, (const bf16_t*)(ws + WS_BR), (const bf16_t*)(ws + WS_WBR) + (size_t)l * 4 * DM * BW, (const bf16_t*)(ws + WS_U), INP(11) + (size_t)l * 4 * DM, (bf16_t*)(ws + WS_MGB)); }
        xcd_barrier(bar);
        { const Ctx c = fresh(c0); unsigned char* ws = WSP();
          GemmOut g = mk_gemm<GemmOut>(c, (const bf16_t*)(ws + WS_MGB), (const bf16_t*)(ws + WS_WOUT) + (size_t)l * DM * DM);
          pg8::EpiRes E; E.R = (const bf16_t*)(ws + WS_HB); E.Y = (bf16_t*)(ws + WS_Y); pg8::gemm_phase<GemmOut, pg8::EpiRes, true, true>(c.lds, c.tid, g, E); }
        { const Ctx c = fresh(c0); unsigned char* ws = WSP(); ph_sk_res<DM>(c, 0, c.G, (const bf16_t*)(ws + WS_MGB), (const bf16_t*)(ws + WS_WOUT) + (size_t)l * DM * DM, (const bf16_t*)(ws + WS_HB), (bf16_t*)(ws + WS_Y)); }
        xcd_barrier(bar);
        { const Ctx c = fresh(c0); unsigned char* ws = WSP(); ph_ln(c, (const bf16_t*)(ws + WS_Y), INP(31) + (size_t)l * DM, INP(32) + (size_t)l * DM, (float*)nullptr, (bf16_t*)(ws + WS_X1B), nullptr, MT, 0); }
        xcd_barrier(bar);
        { const Ctx c = fresh(c0); unsigned char* ws = WSP();
          GemmGU g = mk_gemm<GemmGU>(c, (const bf16_t*)(ws + WS_X1B), (const bf16_t*)(ws + WS_WGU) + (size_t)l * 2 * DFF * DM);
          pg8::EpiSwiGLU E; E.O = (bf16_t*)(ws + WS_ACT); pg8::gemm_phase<GemmGU, pg8::EpiSwiGLU, true, true>(c.lds, c.tid, g, E); }
        { const Ctx c = fresh(c0); unsigned char* ws = WSP(); ph_sk_gu(c, c.G > 192 ? 128 : 0, c.G > 192 ? c.G - 128 : c.G, (const bf16_t*)(ws + WS_X1B), (const bf16_t*)(ws + WS_WGU) + (size_t)l * 2 * DFF * DM, (bf16_t*)(ws + WS_ACT)); }
        xcd_barrier(bar);
        { const Ctx c = fresh(c0); unsigned char* ws = WSP();
          GemmDown g = mk_gemm<GemmDown>(c, (const bf16_t*)(ws + WS_ACT), (const bf16_t*)(ws + WS_WDN) + (size_t)l * DM * DFF);
          pg8::EpiRes E; E.R = (const bf16_t*)(ws + WS_X1B); E.Y = (bf16_t*)(ws + WS_Y); pg8::gemm_phase<GemmDown, pg8::EpiRes, true, true>(c.lds, c.tid, g, E); }
        { const Ctx c = fresh(c0); unsigned char* ws = WSP(); ph_sk_res<DFF>(c, 0, c.G, (const bf16_t*)(ws + WS_ACT), (const bf16_t*)(ws + WS_WDN) + (size_t)l * DM * DFF, (const bf16_t*)(ws + WS_X1B), (bf16_t*)(ws + WS_Y)); }
        xcd_barrier(bar);
        { const Ctx c = fresh(c0); unsigned char* ws = WSP(); float* out = OUTP(); ph_ln(c, (const bf16_t*)(ws + WS_Y), INP(35) + (size_t)l * DM, INP(36) + (size_t)l * DM, (float*)nullptr, (bf16_t*)(ws + WS_HB), l == NL - 1 ? out : nullptr, MT, MT); }
        xcd_barrier(bar);
    }
}

extern "C" void kernel_launch(void* const* d_in, const int* in_sizes, int n_in, void* d_out, int out_size, void* d_ws, size_t ws_size, hipStream_t stream) {
    static int grid = 0;
    if (grid == 0) {
        if (n_in != 37 || (size_t)out_size != O_END || ws_size < WS_END) { fprintf(stderr, "kernel_launch: unexpected sizes (n_in %d out %d ws %zu need %zu)\n", n_in, out_size, ws_size, (size_t)WS_END); grid = -1; return; }
        int dev = 0, cus = 0;
        if (hipGetDevice(&dev) != hipSuccess || hipDeviceGetAttribute(&cus, hipDeviceAttributeMultiprocessorCount, dev) != hipSuccess) { grid = -1; return; }
        if (hipFuncSetAttribute((const void*)mega_fwd, hipFuncAttributeMaxDynamicSharedMemorySize, LDS_BYTES) != hipSuccess) { fprintf(stderr, "kernel_launch: hipFuncSetAttribute failed\n"); grid = -1; return; }
        int per_cu = 0;
        if (hipOccupancyMaxActiveBlocksPerMultiprocessor(&per_cu, (const void*)mega_fwd, 512, LDS_BYTES) != hipSuccess || per_cu < 1) { fprintf(stderr, "kernel_launch: occupancy query says %d\n", per_cu); }
        (void)hipGetLastError();
        grid = cus;
    }
    if (grid < 0) return;
    (void)hipMemsetAsync((unsigned char*)d_ws + WS_CTL, 0, XCD_BAR_WORDS * sizeof(unsigned), stream);
    Args a; memset(&a, 0, sizeof a);
    for (int i = 0; i < 37; ++i) a.in[i] = (const float*)d_in[i];
    a.out = (float*)d_out; a.ws = (unsigned char*)d_ws;
    hipLaunchKernelGGL(mega_fwd, dim3(grid), dim3(512), LDS_BYTES, stream, a);
}
```

```cpp
#include <hip/hip_runtime.h>
#include <cstdio>
#include <cstdint>
#include <cstring>

#define LAS __attribute__((address_space(3)))
typedef unsigned short bf16_t;
typedef short bf16x8 __attribute__((ext_vector_type(8)));
typedef float f32x4 __attribute__((ext_vector_type(4)));
typedef float f32x2 __attribute__((ext_vector_type(2)));
typedef unsigned u32x4 __attribute__((ext_vector_type(4)));
typedef unsigned u32x2 __attribute__((ext_vector_type(2)));

constexpr int DM = 2048, NL = 4;
constexpr int PB = 2, PS = 4096, MP = PB * PS;
constexpr int SB = 32, SS = 4, MS = SB * SS;
constexpr int MT = MP + MS;
constexpr int MPAD = 8448;
constexpr int NIN = 16912, NINP = 17152;
constexpr int U_GQ = 0, U_GK = 512, U_GV = 1024, U_GR = 2048, U_GA = 3072, U_SQ = 3328, U_SK = 4352, U_SV = 4480, U_RU = 4608, U_MQ = 7936, U_GP = 8960;
constexpr int RWC = 3328, BW = 1024, DFF = 5632, MEMT = 256;
constexpr float ALPHA = 1.681792830507429f;

constexpr size_t O_YP = 0;
constexpr size_t O_YS = O_YP + (size_t)MP * DM;
constexpr size_t O_SWKP = O_YS + (size_t)MS * DM;
constexpr size_t O_SWVP = O_SWKP + (size_t)NL * PB * 128 * 128;
constexpr size_t O_MKP = O_SWVP + (size_t)NL * PB * 128 * 128;
constexpr size_t O_MVP = O_MKP + (size_t)NL * PB * 256 * 1024;
constexpr size_t O_GLAP = O_MVP + (size_t)NL * PB * 256 * 1024;
constexpr size_t O_RWP = O_GLAP + (size_t)NL * PB * 4 * 128 * 256;
constexpr size_t O_RSP = O_RWP + (size_t)NL * PB * 16 * 64 * 64;
constexpr size_t O_SWKS = O_RSP + (size_t)NL * PB * RWC;
constexpr size_t O_SWVS = O_SWKS + (size_t)NL * SB * 128 * 128;
constexpr size_t O_GLAS = O_SWVS + (size_t)NL * SB * 128 * 128;
constexpr size_t O_RWS = O_GLAS + (size_t)NL * SB * 4 * 128 * 256;
constexpr size_t O_RSS = O_RWS + (size_t)NL * SB * 16 * 64 * 64;
constexpr size_t O_END = O_RSS + (size_t)NL * SB * RWC;
static_assert(O_END == 52881408, "output size");

constexpr size_t al256(size_t x) { return (x + 255) & ~(size_t)255; }
constexpr size_t WS_CTL = 0;
constexpr size_t WS_WIN = 65536;
constexpr size_t WS_WMEM = WS_WIN + (size_t)NL * NINP * DM * 2;
constexpr size_t WS_WBR = WS_WMEM + (size_t)NL * DM * DM * 2;
constexpr size_t WS_WOUT = WS_WBR + (size_t)NL * 4 * DM * BW * 2;
constexpr size_t WS_WGU = WS_WOUT + (size_t)NL * DM * DM * 2;
constexpr size_t WS_WDN = WS_WGU + (size_t)NL * 2 * DFF * DM * 2;
constexpr size_t WS_HF = WS_WDN + (size_t)NL * DM * DFF * 2;
constexpr size_t WS_HB = WS_HF + (size_t)MPAD * DM * 4;
constexpr size_t WS_U = WS_HB + (size_t)MPAD * DM * 2;
constexpr size_t WS_BR = WS_U + (size_t)MPAD * NINP * 2;
constexpr size_t WS_MG = WS_BR + (size_t)4 * MPAD * BW * 2;
constexpr size_t WS_MGB = WS_MG + (size_t)MPAD * DM * 4;
constexpr size_t WS_Y = WS_MGB + (size_t)MPAD * DM * 2;
constexpr size_t WS_X1F = WS_Y + (size_t)MPAD * DM * 4;
constexpr size_t WS_X1B = WS_X1F + (size_t)MPAD * DM * 4;
constexpr size_t WS_ACT = WS_X1B + (size_t)MPAD * DM * 2;
constexpr size_t WS_MEMB = WS_ACT + (size_t)MPAD * DFF * 2;
constexpr size_t WS_MKB = WS_MEMB + (size_t)512 * DM * 2;
constexpr size_t WS_MVT = WS_MKB + (size_t)NL * 512 * 1024 * 2;
constexpr size_t WS_SC = WS_MVT + (size_t)NL * 8 * 256 * 256 * 2;
constexpr size_t WS_PB = WS_SC + (size_t)8 * 4096 * 256 * 4;
constexpr size_t WS_RW = WS_PB + (size_t)8 * 4096 * 256 * 2;
constexpr size_t RW_ARR = (size_t)MPAD * BW * 4;
constexpr int GL_NCH = 512 + 128;
constexpr size_t WS_GLQD = WS_RW + 8 * RW_ARR;
constexpr size_t WS_GLKH = WS_GLQD + (size_t)GL_NCH * 8192 * 2;
constexpr size_t WS_GLE = WS_GLKH + (size_t)GL_NCH * 8192 * 2;
constexpr size_t WS_GLVT = WS_GLE + (size_t)GL_NCH * 4096 * 2;
constexpr size_t WS_GLGC = WS_GLVT + (size_t)GL_NCH * 16384 * 2;
constexpr int RB_NCH = PB * 16 * 256 + SB * 16;
constexpr int RB_EL = 9216;
constexpr int RB_QP = 4608, RB_KHP = 5760, RB_VT = 7296, RB_EP = 8832;
constexpr size_t WS_RB = WS_GLGC + (size_t)GL_NCH * 128 * 4;
constexpr size_t WS_RAW = WS_RB + (size_t)RB_NCH * RB_EL * 2;
constexpr size_t WS_LRW = WS_RAW + (size_t)2 * MPAD * BW * 2;
constexpr size_t WS_END = WS_LRW + (size_t)NL * 16 * 64 * 256 * 2;

__device__ __forceinline__ float bf2f(bf16_t b) { return __uint_as_float(((unsigned)b) << 16); }
typedef __bf16 bf16v2_t __attribute__((ext_vector_type(2)));
__device__ __forceinline__ unsigned pk2(float lo, float hi) { const f32x2 v = {lo, hi}; return __builtin_bit_cast(unsigned, __builtin_convertvector(v, bf16v2_t)); }
__device__ __forceinline__ bf16_t f2bf(float f) { return (bf16_t)(pk2(f, 0.f) & 0xffffu); }
__device__ __forceinline__ f32x4 ld4bf(const bf16_t* p) { const u32x2 w = *(const u32x2*)p; return (f32x4){__uint_as_float(w.x << 16), __uint_as_float(w.x & 0xffff0000u), __uint_as_float(w.y << 16), __uint_as_float(w.y & 0xffff0000u)}; }
__device__ __forceinline__ float wave_sum(float v) {
#pragma unroll
    for (int o = 32; o > 0; o >>= 1) v += __shfl_xor(v, o, 64);
    return v;
}
__device__ __forceinline__ float wave_max(float v) {
#pragma unroll
    for (int o = 32; o > 0; o >>= 1) v = fmaxf(v, __shfl_xor(v, o, 64));
    return v;
}
__device__ __forceinline__ float sigmoidf_(float x) { return __builtin_amdgcn_rcpf(1.0f + __expf(-x)); }
__device__ __forceinline__ void unpack8(const u32x4 w, float (&x)[8]) {
    x[0] = __uint_as_float(w.x << 16); x[1] = __uint_as_float(w.x & 0xffff0000u); x[2] = __uint_as_float(w.y << 16); x[3] = __uint_as_float(w.y & 0xffff0000u);
    x[4] = __uint_as_float(w.z << 16); x[5] = __uint_as_float(w.z & 0xffff0000u); x[6] = __uint_as_float(w.w << 16); x[7] = __uint_as_float(w.w & 0xffff0000u);
}
__device__ __forceinline__ float softplusf_(float x) { return fmaxf(x, 0.f) + log1pf(__expf(-fabsf(x))); }
__device__ __forceinline__ float softplus_fast(float x) { return fmaxf(x, 0.f) + __logf(1.0f + __expf(-fabsf(x))); }
__device__ __forceinline__ float tanh_fast(float x) { return 1.0f - 2.0f * __builtin_amdgcn_rcpf(1.0f + __expf(2.0f * x)); }

namespace pg8 {
constexpr int BM = 256, BK = 64, HALF = 128, HTB = HALF * BK * 2, STAGE_BYTES = 8 * HTB, NXCD = 8, WGM = 8;
__host__ __device__ __forceinline__ int lds_byte(int r, int c) { const int st = (r >> 4) * 2 + (c >> 5), rr = r & 15, cc = c & 31, ob = rr * 64 + cc * 2; return st * 1024 + (ob ^ (((ob >> 9) & 1) << 5)); }
__host__ __device__ __forceinline__ void stage_rc(int b, int& R, int& C) { const int st = b / 1024, sb = b % 1024, swz = sb ^ (((sb >> 9) & 1) << 5); R = (st >> 1) * 16 + swz / 64; C = (st & 1) * 32 + (swz % 64) / 2; }
__host__ __device__ __forceinline__ int perm32(int rho) { const int n = rho >> 4, i = rho & 15; return 8 * (i >> 2) + 4 * n + (i & 3); }

struct Unit { int pm, pn, z; };
template <int LDA_, int LDB_, int K_, int NM_, int NN_, int NZ_ = 1, int NZH_ = 1, bool ZINNER_ = false, long ZSAB_ = 0, long ZSAH_ = 0, long ZSBB_ = 0, long ZSBH_ = 0>
struct Gemm {
    static constexpr int LDA = LDA_, LDB = LDB_, K = K_, NM = NM_, NN = NN_, NZ = NZ_, NZH = NZH_; static constexpr bool ZINNER = ZINNER_;
    const bf16_t* A; const bf16_t* B; int G, c;
    __device__ __forceinline__ bool next(int i, Unit& u) const {
        constexpr int nt = NM * NN; int L, z;
        if (ZINNER) { const int it = i / NZ; z = i - it * NZ; const long LL = (long)it * G + c; if (LL >= nt) return false; L = (int)LL; }
        else { const long LL = (long)i * G + c; if (LL >= (long)nt * NZ) return false; z = (int)(LL / nt); L = (int)(LL - (long)z * nt); }
        int wgid = L; { constexpr int q = nt / NXCD, r = nt % NXCD; const int xcd = wgid % NXCD, off = wgid / NXCD; wgid = (xcd < r ? xcd * (q + 1) : r * (q + 1) + (xcd - r) * q) + off; }
        constexpr int nig = WGM * NN; const int gid = wgid / nig, fm = gid * WGM, gsz = (NM - fm) < WGM ? (NM - fm) : WGM;
        u.pm = fm + ((wgid % nig) % gsz); u.pn = (wgid % nig) / gsz; u.z = z; return true;
    }
    __device__ __forceinline__ const char* a_base(const Unit& u) const { const int zb = u.z / NZH, zh = u.z - zb * NZH; return (const char*)(A + zb * ZSAB_ + zh * ZSAH_ + (long)u.pm * BM * LDA); }
    __device__ __forceinline__ const char* b_base(const Unit& u) const { const int zb = u.z / NZH, zh = u.z - zb * NZH; return (const char*)(B + zb * ZSBB_ + zh * ZSBH_ + (long)u.pn * BM * LDB); }
};

template <class GT, class Epi, bool ALIGN_EPI = true, bool SP2 = true>
__device__ __forceinline__ void gemm_phase(LAS unsigned char* lds, const int tid, const GT& g, const Epi& E) {
    const int wid = __builtin_amdgcn_readfirstlane(tid >> 6), lane = tid & 63, wr = wid >> 2, wc = wid & 3, fr = lane & 15, fq = lane >> 4;
    constexpr int nt = GT::K / BK;
    unsigned voffA[2], voffB[2];
#pragma unroll
    for (int i = 0; i < 2; ++i) { int R, C; stage_rc(tid * 16 + i * 8192, R, C); const int Rb = Epi::PERM ? ((R & ~31) + perm32(R & 31)) : R;
        voffA[i] = (unsigned)(R * GT::LDA + C) * 2u; voffB[i] = (unsigned)(Rb * GT::LDB + C) * 2u; }
    constexpr size_t kstep = (size_t)(BK * 2);
    constexpr size_t hstepA = (size_t)HALF * GT::LDA * 2, hstepB = (size_t)HALF * GT::LDB * 2;
    const unsigned ldsw = (unsigned)wid * 1024u;
    const int aoff = lds_byte(wr * 64 + fr, fq * 8), boff = lds_byte(wc * 32 + fr, fq * 8);
#define PG8_SA(b, h) (((b) * 2 + (h)) * HTB)
#define PG8_SB(b, h) ((4 + (b) * 2 + (h)) * HTB)
#define PG8_STAGE(bufoff, gbase, voff) do { _Pragma("unroll") for (int _i = 0; _i < 2; ++_i) \
        __builtin_amdgcn_global_load_lds((const unsigned*)((const char*)(gbase) + (voff)[_i]), (LAS unsigned*)(lds + (bufoff) + ldsw + _i * 8192), 16, 0, 0); } while (0)
#define PG8_LDA(dst, b, h) do { _Pragma("unroll") for (int m = 0; m < 4; ++m) _Pragma("unroll") for (int k = 0; k < 2; ++k) dst[m][k] = *(const LAS bf16x8*)(lds + PG8_SA(b, h) + aoff + m * 2048 + k * 1024); } while (0)
#define PG8_LDB(dst, b, h) do { _Pragma("unroll") for (int n = 0; n < 2; ++n) _Pragma("unroll") for (int k = 0; k < 2; ++k) dst[n][k] = *(const LAS bf16x8*)(lds + PG8_SB(b, h) + boff + n * 2048 + k * 1024); } while (0)
#define PG8_MMA(ai, bj, At, Bt) do { __builtin_amdgcn_s_setprio(1); _Pragma("unroll") for (int m = 0; m < 4; ++m) _Pragma("unroll") for (int n = 0; n < 2; ++n) _Pragma("unroll") for (int k = 0; k < 2; ++k) \
        acc[ai][bj][m][n] = __builtin_amdgcn_mfma_f32_16x16x32_bf16(Bt[n][k], At[m][k], acc[ai][bj][m][n], 0, 0, 0); __builtin_amdgcn_s_setprio(0); } while (0)
#define PG8_WAIT_V(n) asm volatile("s_waitcnt vmcnt(" #n ")" ::: "memory")
#define PG8_WAIT_L(n) asm volatile("s_waitcnt lgkmcnt(" #n ")" ::: "memory")
#define PG8_BAR __builtin_amdgcn_s_barrier()
#define PG8_SCHED __builtin_amdgcn_sched_barrier(0)
    Unit cur, nxt; int ui = 0;
    if (!g.next(0, cur)) return;
    f32x4 acc[2][2][4][2];
#pragma unroll
    for (int a = 0; a < 2; ++a)
#pragma unroll
        for (int b = 0; b < 2; ++b)
#pragma unroll
            for (int m = 0; m < 4; ++m)
#pragma unroll
                for (int n = 0; n < 2; ++n) acc[a][b][m][n] = (f32x4){0.f, 0.f, 0.f, 0.f};
    bf16x8 At[4][2], B0[2][2], B1[2][2];
    const char* cA = g.a_base(cur); const char* cB = g.b_base(cur);
    if constexpr (SP2) {
        PG8_STAGE(PG8_SB(0, 0), cB, voffB); PG8_STAGE(PG8_SB(0, 1), cB + hstepB, voffB); PG8_STAGE(PG8_SA(0, 0), cA, voffA); PG8_STAGE(PG8_SA(0, 1), cA + hstepA, voffA);
        if (wr == 1) PG8_BAR;
        PG8_WAIT_V(2); PG8_BAR;
        PG8_STAGE(PG8_SB(1, 0), cB + kstep, voffB); PG8_STAGE(PG8_SA(1, 0), cA + kstep, voffA); PG8_STAGE(PG8_SB(1, 1), cB + hstepB + kstep, voffB);
        PG8_WAIT_V(6); PG8_BAR;
    } else {
        PG8_STAGE(PG8_SB(0, 0), cB, voffB); PG8_STAGE(PG8_SA(0, 0), cA, voffA); PG8_STAGE(PG8_SB(0, 1), cB + hstepB, voffB); PG8_STAGE(PG8_SA(0, 1), cA + hstepA, voffA);
        if (wr == 1) PG8_BAR;
        PG8_WAIT_V(4); PG8_BAR;
        PG8_STAGE(PG8_SB(1, 0), cB + kstep, voffB); PG8_STAGE(PG8_SA(1, 0), cA + kstep, voffA); PG8_STAGE(PG8_SB(1, 1), cB + hstepB + kstep, voffB);
        PG8_WAIT_V(6); PG8_BAR;
    }
    for (;;) {
        const bool has_next = g.next(ui + 1, nxt);
        const char* nA = has_next ? g.a_base(nxt) : cA; const char* nB = has_next ? g.b_base(nxt) : cB;
#pragma unroll 1
        for (int t = 0; t < nt; t += 2) {
            const bool last = (t == nt - 2);
            const char* a1 = cA + (size_t)(t + 1) * kstep;
            const char* a2 = last ? nA : cA + (size_t)(t + 2) * kstep; const char* b2 = last ? nB : cB + (size_t)(t + 2) * kstep;
            const char* a3 = a2 + kstep; const char* b3 = b2 + kstep;
            if constexpr (SP2) {
            PG8_LDB(B0, 0, 0); PG8_LDB(B1, 0, 1); PG8_SCHED; PG8_LDA(At, 0, 0); PG8_STAGE(PG8_SA(1, 1), a1 + hstepA, voffA);
            PG8_WAIT_V(8); PG8_WAIT_L(0); PG8_BAR; PG8_MMA(0, 0, At, B0); PG8_MMA(0, 1, At, B1); PG8_BAR; PG8_SCHED;
            PG8_LDA(At, 0, 1); PG8_STAGE(PG8_SB(0, 0), b2, voffB); PG8_STAGE(PG8_SB(0, 1), b2 + hstepB, voffB); PG8_STAGE(PG8_SA(0, 0), a2, voffA);
            PG8_WAIT_V(8); PG8_WAIT_L(0); PG8_BAR; PG8_MMA(1, 0, At, B0); PG8_MMA(1, 1, At, B1); PG8_BAR; PG8_SCHED;
            PG8_LDB(B0, 1, 0); PG8_LDB(B1, 1, 1); PG8_SCHED; PG8_LDA(At, 1, 0); PG8_STAGE(PG8_SA(0, 1), a2 + hstepA, voffA);
            PG8_WAIT_V(8); PG8_WAIT_L(0); PG8_BAR; PG8_MMA(0, 0, At, B0); PG8_MMA(0, 1, At, B1); PG8_BAR; PG8_SCHED;
            PG8_LDA(At, 1, 1); PG8_STAGE(PG8_SB(1, 0), b3, voffB); PG8_STAGE(PG8_SB(1, 1), b3 + hstepB, voffB); PG8_STAGE(PG8_SA(1, 0), a3, voffA);
            PG8_WAIT_V(8); PG8_WAIT_L(0); PG8_BAR; PG8_MMA(1, 0, At, B0); PG8_MMA(1, 1, At, B1); PG8_BAR; PG8_SCHED;
            } else {
            PG8_LDB(B0, 0, 0); PG8_SCHED; PG8_LDA(At, 0, 0); PG8_STAGE(PG8_SA(1, 1), a1 + hstepA, voffA);
            PG8_WAIT_L(8); PG8_BAR; PG8_WAIT_L(0); PG8_MMA(0, 0, At, B0); PG8_BAR; PG8_SCHED;
            PG8_LDB(B1, 0, 1); PG8_STAGE(PG8_SB(0, 0), b2, voffB);
            PG8_BAR; PG8_WAIT_L(0); PG8_MMA(0, 1, At, B1); PG8_BAR;
            PG8_LDA(At, 0, 1); PG8_STAGE(PG8_SA(0, 0), a2, voffA);
            PG8_BAR; PG8_WAIT_L(0); PG8_MMA(1, 0, At, B0); PG8_BAR; PG8_SCHED;
            PG8_STAGE(PG8_SB(0, 1), b2 + hstepB, voffB);
            PG8_WAIT_V(6); PG8_BAR; PG8_MMA(1, 1, At, B1); PG8_BAR;
            PG8_LDB(B0, 1, 0); PG8_SCHED; PG8_LDA(At, 1, 0); PG8_STAGE(PG8_SA(0, 1), a2 + hstepA, voffA);
            PG8_WAIT_L(8); PG8_BAR; PG8_WAIT_L(0); PG8_MMA(0, 0, At, B0); PG8_BAR; PG8_SCHED;
            PG8_LDB(B1, 1, 1); PG8_STAGE(PG8_SB(1, 0), b3, voffB);
            PG8_BAR; PG8_WAIT_L(0); PG8_MMA(0, 1, At, B1); PG8_BAR;
            PG8_LDA(At, 1, 1); PG8_STAGE(PG8_SA(1, 0), a3, voffA);
            PG8_BAR; PG8_WAIT_L(0); PG8_MMA(1, 0, At, B0); PG8_BAR; PG8_SCHED;
            PG8_STAGE(PG8_SB(1, 1), b3 + hstepB, voffB);
            PG8_WAIT_V(6); PG8_BAR; PG8_MMA(1, 1, At, B1); PG8_BAR;
            }
        }
        if constexpr (ALIGN_EPI) { if (wr == 0) PG8_BAR; }
        E(acc, cur, wr, wc, fr, fq);
        if (!has_next) break;
#pragma unroll
        for (int a = 0; a < 2; ++a)
#pragma unroll
            for (int b = 0; b < 2; ++b)
#pragma unroll
                for (int m = 0; m < 4; ++m)
#pragma unroll
                    for (int n = 0; n < 2; ++n) acc[a][b][m][n] = (f32x4){0.f, 0.f, 0.f, 0.f};
        cur = nxt; cA = nA; cB = nB; ++ui;
        if constexpr (ALIGN_EPI) { if (wr == 1) PG8_BAR; }
    }
    PG8_WAIT_V(0);
    if constexpr (!ALIGN_EPI) { if (wr == 0) PG8_BAR; }
    PG8_BAR;
#undef PG8_SA
#undef PG8_SB
#undef PG8_STAGE
#undef PG8_LDA
#undef PG8_LDB
#undef PG8_MMA
#undef PG8_WAIT_V
#undef PG8_WAIT_L
#undef PG8_BAR
#undef PG8_SCHED
}

struct EpiBf16 {
    static constexpr bool PERM = true;
    bf16_t* O; long zs; int ldc, pad;
    __device__ __forceinline__ void operator()(const f32x4 (&acc)[2][2][4][2], const Unit& u, int wr, int wc, int fr, int fq) const {
        const int row0 = u.pm * BM + wr * 64 + fr, col0 = u.pn * BM + wc * 32 + 8 * fq; bf16_t* base = O + (long)u.z * zs;
#pragma unroll
        for (int ai = 0; ai < 2; ++ai)
#pragma unroll
            for (int m = 0; m < 4; ++m) { bf16_t* rowp = base + (size_t)(row0 + ai * HALF + m * 16) * ldc + col0;
#pragma unroll
                for (int bj = 0; bj < 2; ++bj) { const f32x4 v0 = acc[ai][bj][m][0], v1 = acc[ai][bj][m][1];
                    u32x4 w; w.x = pk2(v0[0], v0[1]); w.y = pk2(v0[2], v0[3]); w.z = pk2(v1[0], v1[1]); w.w = pk2(v1[2], v1[3]);
                    *(u32x4*)(rowp + bj * HALF) = w; } }
    }
};
struct EpiMem {
    static constexpr bool PERM = false;
    float* outK; float* outV; bf16_t* kb; bf16_t* vt;
    __device__ __forceinline__ void operator()(const f32x4 (&acc)[2][2][4][2], const Unit& u, int wr, int wc, int fr, int fq) const {
        const int row0 = u.pm * BM + wr * 64 + fr, col0 = u.pn * BM + wc * 32 + 4 * fq;
#pragma unroll
        for (int ai = 0; ai < 2; ++ai)
#pragma unroll
            for (int m = 0; m < 4; ++m) { const int row = row0 + ai * HALF + m * 16;
#pragma unroll
                for (int bj = 0; bj < 2; ++bj)
#pragma unroll
                    for (int n = 0; n < 2; ++n) { const int col = col0 + bj * HALF + n * 16; const f32x4 v = acc[ai][bj][m][n];
                        if (col < 1024) { *(f32x4*)(outK + ((size_t)u.z * 512 + row) * 1024 + col) = v;
                            u32x2 w; w.x = pk2(v[0], v[1]); w.y = pk2(v[2], v[3]); *(u32x2*)(kb + ((size_t)u.z * 512 + row) * 1024 + col) = w; }
                        else { const int c = col - 1024; *(f32x4*)(outV + ((size_t)u.z * 512 + row) * 1024 + c) = v;
                            const int b = row >> 8, mm = row & 255, h = c >> 8, d = c & 255; bf16_t* p = vt + ((((size_t)u.z * 2 + b) * 4 + h) * 256 + d) * 256 + mm;
                            p[0] = f2bf(v[0]); p[256] = f2bf(v[1]); p[512] = f2bf(v[2]); p[768] = f2bf(v[3]); } } }
    }
};
struct EpiMerge {
    static constexpr bool PERM = true;
    float* MG; bf16_t* MGB; const bf16_t* U; const float* gate_b;
    __device__ __forceinline__ void operator()(const f32x4 (&acc)[2][2][4][2], const Unit& u, int wr, int wc, int fr, int fq) const {
        const int row0 = u.pm * BM + wr * 64 + fr, col0 = u.pn * BM + wc * 32 + 8 * fq;
#pragma unroll
        for (int bj = 0; bj < 2; ++bj) { const int col = col0 + bj * HALF; const f32x4 gb0 = *(const f32x4*)(gate_b + u.z * DM + col), gb1 = *(const f32x4*)(gate_b + u.z * DM + col + 4);
#pragma unroll
            for (int ai = 0; ai < 2; ++ai)
#pragma unroll
                for (int m = 0; m < 4; ++m) { const int row = row0 + ai * HALF + m * 16; float gp[8], r[8];
                    unpack8(*(const u32x4*)(U + (size_t)row * NINP + U_GP + u.z * DM + col), gp);
#pragma unroll
                    for (int j = 0; j < 4; ++j) { r[j] = sigmoidf_(gp[j] + gb0[j]) * acc[ai][bj][m][0][j]; r[4 + j] = sigmoidf_(gp[4 + j] + gb1[j]) * acc[ai][bj][m][1][j]; }
                    bf16_t* mp = MGB + (size_t)row * DM + col;
                    if (u.z > 0) { float pv[8]; unpack8(*(const u32x4*)mp, pv);
#pragma unroll
                        for (int j = 0; j < 8; ++j) r[j] += pv[j]; }
                    *(u32x4*)mp = (u32x4){pk2(r[0], r[1]), pk2(r[2], r[3]), pk2(r[4], r[5]), pk2(r[6], r[7])}; } }
    }
};
struct EpiRes {
    static constexpr bool PERM = true;
    const bf16_t* R; bf16_t* Y;
    __device__ __forceinline__ void operator()(const f32x4 (&acc)[2][2][4][2], const Unit& u, int wr, int wc, int fr, int fq) const {
        const int row0 = u.pm * BM + wr * 64 + fr, col0 = u.pn * BM + wc * 32 + 8 * fq;
#pragma unroll
        for (int ai = 0; ai < 2; ++ai)
#pragma unroll
            for (int m = 0; m < 4; ++m) { const size_t ro = (size_t)(row0 + ai * HALF + m * 16) * DM + col0;
#pragma unroll
                for (int bj = 0; bj < 2; ++bj) { const size_t o = ro + bj * HALF; float rv[8]; unpack8(*(const u32x4*)(R + o), rv);
                    const f32x4 y0 = (f32x4){rv[0], rv[1], rv[2], rv[3]} * ALPHA + acc[ai][bj][m][0], y1 = (f32x4){rv[4], rv[5], rv[6], rv[7]} * ALPHA + acc[ai][bj][m][1];
                    *(u32x4*)(Y + o) = (u32x4){pk2(y0[0], y0[1]), pk2(y0[2], y0[3]), pk2(y1[0], y1[1]), pk2(y1[2], y1[3])}; } }
    }
};
struct EpiSwiGLU {
    static constexpr bool PERM = true;
    bf16_t* O;
    __device__ __forceinline__ void operator()(const f32x4 (&acc)[2][2][4][2], const Unit& u, int wr, int wc, int fr, int fq) const {
        const int row0 = u.pm * BM + wr * 64 + fr, col0 = u.pn * HALF + wc * 32 + 8 * fq;
#pragma unroll
        for (int ai = 0; ai < 2; ++ai)
#pragma unroll
            for (int m = 0; m < 4; ++m) { bf16_t* rowp = O + (size_t)(row0 + ai * HALF + m * 16) * DFF + col0;
                float r[8];
#pragma unroll
                for (int n = 0; n < 2; ++n)
#pragma unroll
                    for (int j = 0; j < 4; ++j) { const float gg = acc[ai][0][m][n][j], uu = acc[ai][1][m][n][j]; r[n * 4 + j] = gg * sigmoidf_(gg) * uu; }
                u32x4 w; w.x = pk2(r[0], r[1]); w.y = pk2(r[2], r[3]); w.z = pk2(r[4], r[5]); w.w = pk2(r[6], r[7]);
                *(u32x4*)rowp = w; }
    }
};
struct EpiScore {
    static constexpr bool PERM = false;
    float* SC;
    __device__ __forceinline__ void operator()(const f32x4 (&acc)[2][2][4][2], const Unit& u, int wr, int wc, int fr, int fq) const {
        const int row0 = u.pm * BM + wr * 64 + fr, col0 = wc * 32 + 4 * fq; float* base = SC + (size_t)u.z * 4096 * 256;
#pragma unroll
        for (int ai = 0; ai < 2; ++ai)
#pragma unroll
            for (int m = 0; m < 4; ++m) { float* rowp = base + (size_t)(row0 + ai * HALF + m * 16) * 256 + col0;
#pragma unroll
                for (int bj = 0; bj < 2; ++bj)
#pragma unroll
                    for (int n = 0; n < 2; ++n) *(f32x4*)(rowp + bj * HALF + n * 16) = acc[ai][bj][m][n] * 0.0625f; }
    }
};
struct EpiPV {
    static constexpr bool PERM = true;
    bf16_t* O;
    __device__ __forceinline__ void operator()(const f32x4 (&acc)[2][2][4][2], const Unit& u, int wr, int wc, int fr, int fq) const {
        const int b = u.z >> 2, h = u.z & 3; const int row0 = b * PS + u.pm * BM + wr * 64 + fr, col0 = h * 256 + wc * 32 + 8 * fq;
#pragma unroll
        for (int ai = 0; ai < 2; ++ai)
#pragma unroll
            for (int m = 0; m < 4; ++m) { bf16_t* rowp = O + (size_t)(row0 + ai * HALF + m * 16) * BW + col0;
#pragma unroll
                for (int bj = 0; bj < 2; ++bj) { const f32x4 v0 = acc[ai][bj][m][0], v1 = acc[ai][bj][m][1];
                    u32x4 w; w.x = pk2(v0[0], v0[1]); w.y = pk2(v0[2], v0[3]); w.z = pk2(v1[0], v1[1]); w.w = pk2(v1[2], v1[3]);
                    *(u32x4*)(rowp + bj * HALF) = w; } }
    }
};
}


#define XB_TMO      128
#define XB_XCNT(j)  (256  + 64 * (j))
#define XB_XSUB(j)  (1280 + 64 * (j))
#define XB_XGEN(j)  (2304 + 64 * (j))
#define XB_TOP      3328
#define XB_TOPGEN   3392
#define XCD_BAR_WORDS 3456
#define XB_SPIN_CAP (1u << 18)
__device__ __forceinline__ unsigned xb_ld(unsigned* p)              { return __hip_atomic_load(p, __ATOMIC_RELAXED, __HIP_MEMORY_SCOPE_AGENT); }
__device__ __forceinline__ unsigned xb_add(unsigned* p, unsigned v) { return __hip_atomic_fetch_add(p, v, __ATOMIC_RELAXED, __HIP_MEMORY_SCOPE_AGENT); }
__device__ __forceinline__ unsigned xb_xcc_id() { return (unsigned)__builtin_amdgcn_s_getreg((3 << 11) | 20) & 0xFu; }
#define XB_SPIN(cond, bar) do { unsigned _sp = 0; while (cond) { __builtin_amdgcn_s_sleep(1); \
    if ((++_sp & 255u) == 0u) { if (xb_ld(&(bar)[XB_TMO])) break; if (_sp > XB_SPIN_CAP) { atomicAdd(&(bar)[XB_TMO], 1u); break; } } } } while (0)
struct XcdBarrier { unsigned* bar; unsigned x; volatile LAS unsigned* st; };
__device__ __forceinline__ XcdBarrier xcd_barrier_post(unsigned* bar, volatile LAS unsigned* st) {
    XcdBarrier b; b.bar = bar; b.x = xb_xcc_id(); b.st = st;
    if (threadIdx.x == 0) (void)xb_add(&bar[XB_XCNT(b.x)], 1u);
    return b;
}
__device__ __forceinline__ void xcd_barrier_complete(unsigned* bar, unsigned x, unsigned& nloc, unsigned& nx) {
    const unsigned G = gridDim.x * gridDim.y * gridDim.z;
    unsigned sum, cnt, mine, sp = 0u;
    for (;;) {
        sum = 0u; cnt = 0u; mine = 0u;
#pragma unroll
        for (unsigned j = 0; j < 16; ++j) { const unsigned c = xb_ld(&bar[XB_XCNT(j)]); sum += c; cnt += (c > 0u) ? 1u : 0u; mine = (j == x) ? c : mine; }
        if (sum == G) break;
        __builtin_amdgcn_s_sleep(1);
        if ((++sp & 255u) == 0u) { if (xb_ld(&bar[XB_TMO])) break; if (sp > XB_SPIN_CAP) { atomicAdd(&bar[XB_TMO], 1u); break; } }
    }
    nloc = mine > 0u ? mine : 1u; nx = cnt > 0u ? cnt : 1u;
}
__device__ __forceinline__ void xcd_barrier(const XcdBarrier& b) {
    asm volatile("s_waitcnt vmcnt(0)" ::: "memory");
    __syncthreads();
    if (threadIdx.x == 0) {
        unsigned* bar = b.bar;
        __builtin_amdgcn_s_waitcnt(0);
        unsigned nloc = b.st[0], nx = b.st[1];
        if (nloc == 0u) { xcd_barrier_complete(bar, b.x, nloc, nx); b.st[0] = nloc; b.st[1] = nx; }
        const unsigned old = xb_add(&bar[XB_XSUB(b.x)], 1u);
        const unsigned gen = old / nloc;
        if (old + 1u == (gen + 1u) * nloc) {
            __builtin_amdgcn_fence(__ATOMIC_RELEASE, "agent");
            asm volatile("s_waitcnt vmcnt(0)" ::: "memory");
            const unsigned og = xb_add(&bar[XB_TOP], 1u);
            const unsigned tg = og / nx;
            if (og + 1u == (tg + 1u) * nx) xb_add(&bar[XB_TOPGEN], 1u);
            else XB_SPIN(xb_ld(&bar[XB_TOPGEN]) == tg, bar);
            __builtin_amdgcn_fence(__ATOMIC_ACQUIRE, "agent");
            xb_add(&bar[XB_XGEN(b.x)], 1u);
            asm volatile("s_waitcnt vmcnt(0)" ::: "memory");
        } else {
            XB_SPIN(xb_ld(&bar[XB_XGEN(b.x)]) == gen, bar);
            __builtin_amdgcn_fence(__ATOMIC_ACQUIRE, "agent");
            asm volatile("s_waitcnt vmcnt(0)" ::: "memory");
        }
    }
    __syncthreads();
}

struct Ctx { int tid, lane, wave, bid, G; LAS unsigned char* lds; };
__device__ __forceinline__ Ctx fresh(const Ctx& c0) { Ctx c; c.wave = c0.wave; c.bid = c0.bid; c.G = c0.G; c.lds = c0.lds; asm volatile("" : "+s"(c.bid), "+s"(c.G), "+s"(c.wave));
    int lane = (int)__builtin_amdgcn_mbcnt_hi(~0u, __builtin_amdgcn_mbcnt_lo(~0u, 0u)); asm volatile("" : "+v"(lane)); c.lane = lane; c.tid = c.wave * 64 + lane; return c; }

__device__ __forceinline__ int colmap(int mode, int n) {
    if (mode == 1) return n < 3088 ? n : (n < 3328 ? -1 : n - 240);
    if (mode == 2) { const int t = n >> 8, j = n & 255; return j < 128 ? t * 128 + j : DFF + t * 128 + (j - 128); }
    return n;
}
__device__ __forceinline__ void wprep_load(f32x4 (&rg)[8], const float* __restrict__ src, int K, int Nsrc, int Ndst, int mode, size_t sbs, int item, int tid) {
    const int nx = Ndst / 256, ny = K / 64; const int bx = item % nx, by = (item / nx) % ny, bz = item / (nx * ny);
    const int tx = tid & 63, ty = tid >> 6, cm = colmap(mode, bx * 256 + tx * 4); const float* s = src + (size_t)bz * sbs + (size_t)(by * 64 + ty) * Nsrc + cm;
#pragma unroll
    for (int i = 0; i < 8; ++i) rg[i] = cm >= 0 ? *(const f32x4*)(s + (size_t)(8 * i) * Nsrc) : (f32x4){0.f, 0.f, 0.f, 0.f};
}
__device__ __forceinline__ void ph_wprep(const Ctx& c, const float* __restrict__ src, bf16_t* __restrict__ dst, int K, int Nsrc, int Ndst, int mode, int nbatch, size_t sbs, size_t dbs) {
    LAS float* tile = (LAS float*)c.lds;
    const int nx = Ndst / 256, ny = K / 64, total = nx * ny * nbatch;
    const int tid = c.tid, tx = tid & 63, ty = tid >> 6, n = tid >> 1, kh = tid & 1;
    f32x4 rg[8];
    int item = c.bid;
    if (item < total) wprep_load(rg, src, K, Nsrc, Ndst, mode, sbs, item, tid);
    for (; item < total; item += c.G) {
        __syncthreads();
#pragma unroll
        for (int i = 0; i < 8; ++i) *(LAS f32x4*)(tile + (ty + 8 * i) * 260 + tx * 4) = rg[i];
        __syncthreads();
        const int bx = item % nx, by = (item / nx) % ny, bz = item / (nx * ny);
        if (item + c.G < total) wprep_load(rg, src, K, Nsrc, Ndst, mode, sbs, item + c.G, tid);
        bf16_t* d = dst + (size_t)bz * dbs + (size_t)(bx * 256 + n) * K + by * 64 + kh * 32;
#pragma unroll
        for (int g = 0; g < 4; ++g) { unsigned p[4];
#pragma unroll
            for (int e = 0; e < 4; ++e) p[e] = pk2(tile[(kh * 32 + g * 8 + 2 * e) * 260 + n], tile[(kh * 32 + g * 8 + 2 * e + 1) * 260 + n]);
            *(u32x4*)(d + g * 8) = (u32x4){p[0], p[1], p[2], p[3]}; }
    }
    __syncthreads();
}
__device__ __forceinline__ void ph_xprep(const Ctx& c, const float* __restrict__ xp, const float* __restrict__ xs, const float* __restrict__ mem, float* __restrict__ HF, bf16_t* __restrict__ HB, bf16_t* __restrict__ MEMB) {
    const size_t nH = (size_t)MPAD * DM / 4, nM = (size_t)512 * DM / 4;
    for (size_t i4 = (size_t)c.bid * 512 + c.tid; i4 < nH + nM; i4 += (size_t)c.G * 512) {
        if (i4 < nH) {
            const size_t e = i4 * 4; f32x4 v = (f32x4){0.f, 0.f, 0.f, 0.f};
            if (e < (size_t)MP * DM) v = *(const f32x4*)(xp + e); else if (e < (size_t)MT * DM) v = *(const f32x4*)(xs + (e - (size_t)MP * DM));
            if (HF != nullptr) *(f32x4*)(HF + e) = v;
            u32x2 w; w.x = pk2(v[0], v[1]); w.y = pk2(v[2], v[3]); *(u32x2*)(HB + e) = w;
        } else {
            const size_t e = (i4 - nH) * 4; const f32x4 v = *(const f32x4*)(mem + e); u32x2 w; w.x = pk2(v[0], v[1]); w.y = pk2(v[2], v[3]); *(u32x2*)(MEMB + e) = w;
        }
    }
}
__device__ __forceinline__ void ph_ln(const Ctx& c, const bf16_t* __restrict__ Y, const float* __restrict__ g, const float* __restrict__ b, float* __restrict__ XF, bf16_t* __restrict__ XB, float* __restrict__ OUT, int nrows, int nout) {
    const int lane = c.lane;
    for (int row = c.bid * 8 + c.wave; row < nrows; row += c.G * 8) {
        const bf16_t* y = Y + (size_t)row * DM; float v[4][8]; float s = 0.f;
#pragma unroll
        for (int j = 0; j < 4; ++j) { unpack8(*(const u32x4*)(y + j * 512 + lane * 8), v[j]);
#pragma unroll
            for (int e2 = 0; e2 < 8; ++e2) s += v[j][e2]; }
        const float mean = wave_sum(s) * (1.0f / DM); float q = 0.f;
#pragma unroll
        for (int j = 0; j < 4; ++j)
#pragma unroll
            for (int e2 = 0; e2 < 8; ++e2) { const float d = v[j][e2] - mean; q += d * d; }
        const float rstd = rsqrtf(wave_sum(q) * (1.0f / DM) + 1e-5f);
#pragma unroll
        for (int j = 0; j < 4; ++j) { const int cc = j * 512 + lane * 8; const f32x4 g0 = *(const f32x4*)(g + cc), g1 = *(const f32x4*)(g + cc + 4), b0 = *(const f32x4*)(b + cc), b1 = *(const f32x4*)(b + cc + 4);
            const f32x4 o0 = ((f32x4){v[j][0], v[j][1], v[j][2], v[j][3]} - mean) * rstd * g0 + b0, o1 = ((f32x4){v[j][4], v[j][5], v[j][6], v[j][7]} - mean) * rstd * g1 + b1;
            const size_t off = (size_t)row * DM + cc;
            if (XF != nullptr) { *(f32x4*)(XF + off) = o0; *(f32x4*)(XF + off + 4) = o1; }
            *(u32x4*)(XB + off) = (u32x4){pk2(o0[0], o0[1]), pk2(o0[2], o0[3]), pk2(o1[0], o1[1]), pk2(o1[2], o1[3])};
            if (OUT != nullptr && row < nout) { *(f32x4*)(OUT + off) = o0; *(f32x4*)(OUT + off + 4) = o1; } }
    }
}
__device__ __forceinline__ void ph_softmax256(const Ctx& c, const float* __restrict__ SC, bf16_t* __restrict__ P, int nrows) {
    const int lane = c.lane;
    for (int row = c.bid * 8 + c.wave; row < nrows; row += c.G * 8) {
        const f32x4 v = *(const f32x4*)(SC + (size_t)row * 256 + lane * 4);
        const float mx = wave_max(fmaxf(fmaxf(v[0], v[1]), fmaxf(v[2], v[3])));
        f32x4 e; e[0] = __expf(v[0] - mx); e[1] = __expf(v[1] - mx); e[2] = __expf(v[2] - mx); e[3] = __expf(v[3] - mx);
        const float inv = 1.0f / wave_sum((e[0] + e[1]) + (e[2] + e[3]));
        u32x2 w; w.x = pk2(e[0] * inv, e[1] * inv); w.y = pk2(e[2] * inv, e[3] * inv); *(u32x2*)(P + (size_t)row * 256 + lane * 4) = w;
    }
}
__device__ __forceinline__ void ph_copy_outs(const Ctx& c, const bf16_t* __restrict__ U, const float* __restrict__ ck, const float* __restrict__ cv, float* __restrict__ out, int layer) {
    constexpr int nA = PB * 128 * 128, nB = SB * 128 * 128, nC = PB * RWC, nD = SB * RWC;
    for (int i = c.bid * 512 + c.tid; i < nA + nB + nC + nD; i += c.G * 512) {
        if (i < nA) { const int b = i / 16384, j = (i >> 7) & 127, cc = i & 127; const size_t ur = (size_t)(b * PS + PS - 128 + j) * NINP;
            out[O_SWKP + (size_t)layer * nA + i] = bf2f(U[ur + U_SK + cc]); out[O_SWVP + (size_t)layer * nA + i] = bf2f(U[ur + U_SV + cc]); continue; }
        int k = i - nA;
        if (k < nB) { const int sq = k / 16384, j = (k >> 7) & 127, cc = k & 127; float kv, vv;
            if (j < 124) { const size_t o = ((size_t)sq * 128 + j + 4) * 128 + cc; kv = ck[o]; vv = cv[o]; }
            else { const size_t ur = (size_t)(MP + sq * SS + j - 124) * NINP; kv = bf2f(U[ur + U_SK + cc]); vv = bf2f(U[ur + U_SV + cc]); }
            out[O_SWKS + (size_t)layer * nB + k] = kv; out[O_SWVS + (size_t)layer * nB + k] = vv; continue; }
        k -= nB;
        if (k < nC) { const int b = k / RWC, cc = k - b * RWC; out[O_RSP + (size_t)layer * nC + k] = bf2f(U[(size_t)(b * PS + PS - 1) * NINP + U_RU + cc]); continue; }
        k -= nC;
        { const int sq = k / RWC, cc = k - sq * RWC; out[O_RSS + (size_t)layer * nD + k] = bf2f(U[(size_t)(MP + sq * SS + SS - 1) * NINP + U_RU + cc]); }
    }
}

__device__ __forceinline__ void seq_info(int sq, int& row0, int& L) { if (sq < PB) { row0 = sq * PS; L = PS; } else { row0 = MP + (sq - PB) * SS; L = SS; } }

__device__ __forceinline__ void ph_gla_naive(const Ctx& c, const bf16_t* __restrict__ U, const float* __restrict__ s0, const float* __restrict__ a_up, const float* __restrict__ a_b,
                                             const float* __restrict__ ng, const float* __restrict__ nb, bf16_t* __restrict__ OB, float* __restrict__ outP, float* __restrict__ outS) {
    LAS float* qs = (LAS float*)c.lds;
    LAS float* ks = qs + 16 * 128; LAS float* as = ks + 16 * 128; LAS float* os = as + 16 * 128;
    const int kh = c.tid >> 8, vt = c.tid & 255, lane = c.lane;
    for (int u = c.bid; u < (PB + SB) * 4; u += c.G) {
        const int sq = u >> 2, h = u & 3;
        int row0, L; seq_info(sq, row0, L);
        float S[64];
        if (sq >= PB) { const float* p = s0 + (((size_t)(sq - PB) * 4 + h) * 128 + kh * 64) * 256 + vt;
#pragma unroll
            for (int kk = 0; kk < 64; ++kk) S[kk] = p[(size_t)kk * 256]; }
        else {
#pragma unroll
            for (int kk = 0; kk < 64; ++kk) S[kk] = 0.f; }
        for (int t0 = 0; t0 < L; t0 += 16) {
            const int nT = (L - t0) < 16 ? (L - t0) : 16;
            for (int idx = c.tid; idx < nT * 128; idx += 512) {
                const int tt = idx >> 7, kk = idx & 127; const bf16_t* ur = U + (size_t)(row0 + t0 + tt) * NINP;
                qs[idx] = bf2f(ur[U_GQ + h * 128 + kk]) * 0.08838834764831845f; ks[idx] = bf2f(ur[U_GK + h * 128 + kk]);
                float x = a_b[h * 128 + kk];
#pragma unroll
                for (int r = 0; r < 16; ++r) x += bf2f(ur[U_GA + r]) * a_up[r * 512 + h * 128 + kk];
                const float ls = (fminf(x, 0.f) - log1pf(__expf(-fabsf(x)))) * (1.0f / 16.0f);
                as[idx] = __expf(ls);
            }
            __syncthreads();
            for (int tt = 0; tt < nT; ++tt) {
                const float v = bf2f(U[(size_t)(row0 + t0 + tt) * NINP + U_GV + h * 256 + vt]); float o = 0.f; const int lb = tt * 128 + kh * 64;
#pragma unroll
                for (int kk = 0; kk < 64; ++kk) { S[kk] = as[lb + kk] * S[kk] + ks[lb + kk] * v; o += qs[lb + kk] * S[kk]; }
                os[(kh * 16 + tt) * 256 + vt] = o;
            }
            __syncthreads();
            for (int tt = c.wave; tt < nT; tt += 8) {
                float x[4]; float s = 0.f;
#pragma unroll
                for (int j = 0; j < 4; ++j) { x[j] = os[tt * 256 + lane + 64 * j] + os[(16 + tt) * 256 + lane + 64 * j]; s += x[j]; }
                const float mean = wave_sum(s) * (1.0f / 256.0f); float q = 0.f;
#pragma unroll
                for (int j = 0; j < 4; ++j) { const float d = x[j] - mean; q += d * d; }
                const float rstd = rsqrtf(wave_sum(q) * (1.0f / 256.0f) + 1e-5f);
                const size_t row = (size_t)(row0 + t0 + tt);
#pragma unroll
                for (int j = 0; j < 4; ++j) { const int cc = h * 256 + lane + 64 * j; const float n = (x[j] - mean) * rstd * ng[cc] + nb[cc];
                    const float gr = bf2f(U[row * NINP + U_GR + cc]); OB[row * BW + cc] = f2bf(n * gr * sigmoidf_(gr)); }
            }
            __syncthreads();
        }
        float* op = (sq < PB ? outP + (((size_t)sq * 4 + h) * 128 + kh * 64) * 256 : outS + (((size_t)(sq - PB) * 4 + h) * 128 + kh * 64) * 256) + vt;
#pragma unroll
        for (int kk = 0; kk < 64; ++kk) op[(size_t)kk * 256] = S[kk];
    }
}

__device__ __forceinline__ f32x4 mma16(bf16x8 x, bf16x8 y, f32x4 c) { return __builtin_amdgcn_mfma_f32_16x16x32_bf16(x, y, c, 0, 0, 0); }
__device__ __forceinline__ bf16x8 pack_acc(const f32x4& a, const f32x4& b) {
    u32x4 p; p.x = pk2(a[0], a[1]); p.y = pk2(a[2], a[3]); p.z = pk2(b[0], b[1]); p.w = pk2(b[2], b[3]); return __builtin_bit_cast(bf16x8, p);
}
__device__ __forceinline__ void gla_chunk_info(int u, int& row0, int& ntok, int& h) {
    if (u < 512) { const int b = u >> 8; h = (u >> 6) & 3; row0 = b * PS + (u & 63) * 64; ntok = 64; }
    else { const int s = u - 512; h = s & 3; row0 = MP + (s >> 2) * SS; ntok = SS; }
}
__device__ __forceinline__ void ph_gla_pre(const Ctx& c, const bf16_t* __restrict__ U, const float* __restrict__ a_up, const float* __restrict__ a_b,
                                           bf16_t* __restrict__ QD, bf16_t* __restrict__ KHT, bf16_t* __restrict__ EE, bf16_t* __restrict__ VT, float* __restrict__ GC) {
    LAS float* ga_l = (LAS float*)c.lds;
    LAS float* tot = ga_l + 64 * 16;
    LAS bf16_t* Qd_l = (LAS bf16_t*)(tot + 4 * 128);
    LAS bf16_t* Kn_l = Qd_l + 64 * 136;
    LAS bf16_t* v_l = Kn_l + 64 * 136;
    LAS bf16_t* qr_l = v_l + 64 * 264;
    LAS bf16_t* kr_l = qr_l + 64 * 136;
    const int tid = c.tid, lane = c.lane, r = lane & 15, q = lane >> 4, w = c.wave;
    for (int u = (c.bid + c.G / 2) % c.G; u < GL_NCH; u += c.G) {
        int row0, ntok, h; gla_chunk_info(u, row0, ntok, h);
        for (int i = tid; i < 64 * 16; i += 512) { const int t = i >> 4, rr = i & 15; ga_l[i] = t < ntok ? bf2f(U[(size_t)(row0 + t) * NINP + U_GA + rr]) : 0.f; }
        for (int i = tid; i < 64 * 32; i += 512) { const int t = i >> 5, c8 = i & 31; u32x4 vv = (u32x4){0u, 0u, 0u, 0u};
            if (t < ntok) vv = *(const u32x4*)(U + (size_t)(row0 + t) * NINP + U_GV + h * 256 + c8 * 8);
            *(LAS u32x4*)(v_l + t * 264 + c8 * 8) = vv; }
        for (int i = tid; i < 64 * 16; i += 512) { const int t = i >> 4, c8 = i & 15; u32x4 qv = (u32x4){0u, 0u, 0u, 0u}, kv = qv;
            if (t < ntok) { const bf16_t* ur = U + (size_t)(row0 + t) * NINP + h * 128 + c8 * 8; qv = *(const u32x4*)(ur + U_GQ); kv = *(const u32x4*)(ur + U_GK); }
            *(LAS u32x4*)(qr_l + t * 136 + c8 * 8) = qv; *(LAS u32x4*)(kr_l + t * 136 + c8 * 8) = kv; }
        __syncthreads();
        const int kk = tid & 127, tq = tid >> 7;
        float cum[16];
        { float aup[16];
#pragma unroll
          for (int rr = 0; rr < 16; ++rr) aup[rr] = a_up[rr * 512 + h * 128 + kk];
          const float ab = a_b[h * 128 + kk]; float run = 0.f;
#pragma unroll
          for (int j = 0; j < 16; ++j) { const int t = tq * 16 + j; float x = ab;
#pragma unroll
              for (int rr = 0; rr < 16; ++rr) x += ga_l[t * 16 + rr] * aup[rr];
              const float la = t < ntok ? (fminf(x, 0.f) - __logf(1.0f + __expf(-fabsf(x)))) * (1.0f / 16.0f) : 0.f;
              run += la; cum[j] = run; }
          tot[tq * 128 + kk] = run; }
        __syncthreads();
        { float prefix = 0.f, bC = 0.f;
#pragma unroll
          for (int g = 0; g < 4; ++g) { const float tv = tot[g * 128 + kk]; bC += tv; if (g < tq) prefix += tv; }
          unsigned khp[8];
#pragma unroll
          for (int j = 0; j < 16; j += 2) { float kh2[2];
#pragma unroll
              for (int e = 0; e < 2; ++e) { const int t = tq * 16 + j + e; const float b = prefix + cum[j + e]; const float qv = bf2f(qr_l[t * 136 + kk]), kv = bf2f(kr_l[t * 136 + kk]);
                  Qd_l[t * 136 + kk] = f2bf(qv * __expf(b) * 0.08838834764831845f); Kn_l[t * 136 + kk] = f2bf(kv * __expf(-b)); kh2[e] = kv * __expf(bC - b); }
              khp[j >> 1] = pk2(kh2[0], kh2[1]); }
          bf16_t* kp = KHT + (size_t)u * 8192 + kk * 64 + tq * 16;
          *(u32x4*)kp = (u32x4){khp[0], khp[1], khp[2], khp[3]}; *(u32x4*)(kp + 8) = (u32x4){khp[4], khp[5], khp[6], khp[7]};
          if (tq == 0) GC[(size_t)u * 128 + kk] = __expf(bC); }
        __syncthreads();
        { const int tb = w >> 1;
#pragma unroll
          for (int e = 0; e < 2; ++e) { const int ib = (w & 1) * 2 + e; f32x4 d = (f32x4){0.f, 0.f, 0.f, 0.f};
              if (ib <= tb) {
                  bf16x8 kf4[4], qf4[4];
#pragma unroll
                  for (int ks = 0; ks < 4; ++ks) { kf4[ks] = *(const LAS bf16x8*)(Kn_l + (ib * 16 + r) * 136 + ks * 32 + q * 8); qf4[ks] = *(const LAS bf16x8*)(Qd_l + (tb * 16 + r) * 136 + ks * 32 + q * 8); }
                  __builtin_amdgcn_sched_barrier(0);
#pragma unroll
                  for (int ks = 0; ks < 4; ++ks) d = mma16(kf4[ks], qf4[ks], d); }
              const int t = tb * 16 + r, i0 = ib * 16 + q * 4;
#pragma unroll
              for (int jj = 0; jj < 4; ++jj) if (i0 + jj > t) d[jj] = 0.f;
              u32x2 o; o.x = pk2(d[0], d[1]); o.y = pk2(d[2], d[3]); *(u32x2*)(EE + (size_t)u * 4096 + t * 64 + i0) = o; } }
        for (int i = tid; i < 64 * 16; i += 512) { const int t = i >> 4, c8 = i & 15; *(u32x4*)(QD + (size_t)u * 8192 + t * 128 + c8 * 8) = *(const LAS u32x4*)(Qd_l + t * 136 + c8 * 8); }
        { const int val = tid & 255, th = tid >> 8;
#pragma unroll
          for (int tg = 0; tg < 4; ++tg) { const int t0 = th * 32 + tg * 8; unsigned p4[4];
#pragma unroll
              for (int e = 0; e < 4; ++e) p4[e] = (unsigned)v_l[(t0 + 2 * e) * 264 + val] | ((unsigned)v_l[(t0 + 2 * e + 1) * 264 + val] << 16);
              *(u32x4*)(VT + (size_t)u * 16384 + val * 64 + t0) = (u32x4){p4[0], p4[1], p4[2], p4[3]}; } }
        __syncthreads();
    }
}
struct GlaStage { u32x4 qd[2], kh[2], e, vt, gc; };
__device__ __forceinline__ void gla_stage_load(GlaStage& s, const bf16_t* __restrict__ QD, const bf16_t* __restrict__ KHT, const bf16_t* __restrict__ EE, const bf16_t* __restrict__ VT, const float* __restrict__ GC,
                                               int ch, int sl, int tid) {
    const bf16_t* qp = QD + (size_t)ch * 8192 + tid * 8; s.qd[0] = *(const u32x4*)qp; s.qd[1] = *(const u32x4*)(qp + 4096);
    const bf16_t* kp = KHT + (size_t)ch * 8192 + tid * 8; s.kh[0] = *(const u32x4*)kp; s.kh[1] = *(const u32x4*)(kp + 4096);
    s.e = *(const u32x4*)(EE + (size_t)ch * 4096 + tid * 8);
    s.vt = *(const u32x4*)(VT + (size_t)ch * 16384 + sl * 4096 + tid * 8);
    if (tid < 32) s.gc = *(const u32x4*)(GC + (size_t)ch * 128 + tid * 4);
}
constexpr int GS_KH = 8704, GS_E = 17920, GS_VT = 22528, GS_GC = 27136, GS_EL = 27392;
__device__ __forceinline__ void gla_stage_store(const GlaStage& s, LAS bf16_t* b, int tid) {
    *(LAS u32x4*)(b + (tid >> 4) * 136 + (tid & 15) * 8) = s.qd[0]; *(LAS u32x4*)(b + (32 + (tid >> 4)) * 136 + (tid & 15) * 8) = s.qd[1];
    *(LAS u32x4*)(b + GS_KH + (tid >> 3) * 72 + (tid & 7) * 8) = s.kh[0]; *(LAS u32x4*)(b + GS_KH + (64 + (tid >> 3)) * 72 + (tid & 7) * 8) = s.kh[1];
    *(LAS u32x4*)(b + GS_E + (tid >> 3) * 72 + (tid & 7) * 8) = s.e; *(LAS u32x4*)(b + GS_VT + (tid >> 3) * 72 + (tid & 7) * 8) = s.vt;
    if (tid < 32) *(LAS u32x4*)(b + GS_GC + tid * 8) = s.gc;
}
__device__ __forceinline__ void ph_gla_seq(const Ctx& c, int boff, const bf16_t* __restrict__ QD, const bf16_t* __restrict__ KHT, const bf16_t* __restrict__ EE, const bf16_t* __restrict__ VT, const float* __restrict__ GC,
                                           const float* __restrict__ s0, float* __restrict__ outP, float* __restrict__ outS, bf16_t* __restrict__ OB) {
    LAS bf16_t* stg = (LAS bf16_t*)c.lds;
    LAS bf16_t* T_l = stg + 2 * GS_EL;
    const int tid = c.tid, lane = c.lane, r = lane & 15, q = lane >> 4, w = c.wave;
    const int side = c.bid < 32 ? c.bid : c.bid - 64, nside = c.G - 64;
    for (int u = (c.bid >= boff && c.bid < boff + 32) ? c.bid - boff : ((c.bid < 32 || c.bid >= 96) ? 32 + side : 32 + 512); u < 32 + 512; u = u < 32 ? 32 + 512 : u + nside) {
        int h, sl, nch, ch0, row0, ntok; const float* sp = nullptr; float* op;
        if (u < 32) { const int b = u >> 4; h = (u >> 2) & 3; sl = u & 3; nch = 64; ch0 = (b * 4 + h) * 64; row0 = b * PS; ntok = 64; op = outP + (size_t)(b * 4 + h) * 32768; }
        else { const int s = u - 32, sq = s >> 4; h = (s >> 2) & 3; sl = s & 3; nch = 1; ch0 = 512 + sq * 4 + h; row0 = MP + sq * SS; ntok = SS; sp = s0 + (size_t)(sq * 4 + h) * 32768; op = outS + (size_t)(sq * 4 + h) * 32768; }
        f32x4 acc[4];
#pragma unroll
        for (int vb = 0; vb < 4; ++vb)
#pragma unroll
            for (int jj = 0; jj < 4; ++jj) acc[vb][jj] = sp ? sp[(size_t)(w * 16 + q * 4 + jj) * 256 + sl * 64 + vb * 16 + r] : 0.f;
        GlaStage R0, R1, R2;
        gla_stage_load(R0, QD, KHT, EE, VT, GC, ch0, sl, tid);
        if (1 < nch) gla_stage_load(R1, QD, KHT, EE, VT, GC, ch0 + 1, sl, tid);
        if (2 < nch) gla_stage_load(R2, QD, KHT, EE, VT, GC, ch0 + 2, sl, tid);
        __syncthreads();
        gla_stage_store(R0, stg, tid);
        if (3 < nch) gla_stage_load(R0, QD, KHT, EE, VT, GC, ch0 + 3, sl, tid);
#define GLA_STEP(ci, RN) do { \
            LAS bf16_t* Tb = T_l + ((ci) & 1) * 64 * 136; const LAS bf16_t* sb = stg + ((ci) & 1) * GS_EL; \
            _Pragma("unroll") for (int vb = 0; vb < 4; ++vb) { u32x2 o; o.x = pk2(acc[vb][0], acc[vb][1]); o.y = pk2(acc[vb][2], acc[vb][3]); *(LAS u32x2*)(Tb + (vb * 16 + r) * 136 + w * 16 + q * 4) = o; } \
            __syncthreads(); \
            if ((ci) + 1 < nch) { gla_stage_store(RN, stg + (((ci) + 1) & 1) * GS_EL, tid); if ((ci) + 4 < nch) gla_stage_load(RN, QD, KHT, EE, VT, GC, ch0 + (ci) + 4, sl, tid); } \
            { const int rb = w >> 1, t = rb * 16 + r; bf16x8 qf[4], ef[2]; \
              _Pragma("unroll") for (int ks = 0; ks < 4; ++ks) qf[ks] = *(const LAS bf16x8*)(sb + (rb * 16 + r) * 136 + ks * 32 + q * 8); \
              _Pragma("unroll") for (int ks = 0; ks < 2; ++ks) ef[ks] = *(const LAS bf16x8*)(sb + GS_E + (rb * 16 + r) * 72 + ks * 32 + q * 8); \
              bf16x8 tf[2][4], vf[2][2]; \
              _Pragma("unroll") for (int e2 = 0; e2 < 2; ++e2) { const int cb = (w & 1) * 2 + e2; \
                  _Pragma("unroll") for (int ks = 0; ks < 4; ++ks) tf[e2][ks] = *(const LAS bf16x8*)(Tb + (cb * 16 + r) * 136 + ks * 32 + q * 8); \
                  _Pragma("unroll") for (int ks = 0; ks < 2; ++ks) vf[e2][ks] = *(const LAS bf16x8*)(sb + GS_VT + (cb * 16 + r) * 72 + ks * 32 + q * 8); } \
              __builtin_amdgcn_sched_barrier(0); \
              _Pragma("unroll") for (int e2 = 0; e2 < 2; ++e2) { const int cb = (w & 1) * 2 + e2; f32x4 y = (f32x4){0.f, 0.f, 0.f, 0.f}; \
                  _Pragma("unroll") for (int ks = 0; ks < 4; ++ks) y = mma16(tf[e2][ks], qf[ks], y); \
                  _Pragma("unroll") for (int ks = 0; ks < 2; ++ks) y = mma16(vf[e2][ks], ef[ks], y); \
                  if (t < ntok) { u32x2 o; o.x = pk2(y[0], y[1]); o.y = pk2(y[2], y[3]); *(u32x2*)(OB + (size_t)(row0 + (ci) * 64 + t) * BW + h * 256 + sl * 64 + cb * 16 + q * 4) = o; } } } \
            { const f32x4 gcv = *(const LAS f32x4*)((const LAS float*)(sb + GS_GC) + w * 16 + q * 4); bf16x8 kf[2]; \
              _Pragma("unroll") for (int ks = 0; ks < 2; ++ks) kf[ks] = *(const LAS bf16x8*)(sb + GS_KH + (w * 16 + r) * 72 + ks * 32 + q * 8); \
              bf16x8 vs[4][2]; \
              _Pragma("unroll") for (int vb = 0; vb < 4; ++vb) _Pragma("unroll") for (int ks = 0; ks < 2; ++ks) vs[vb][ks] = *(const LAS bf16x8*)(sb + GS_VT + (vb * 16 + r) * 72 + ks * 32 + q * 8); \
              __builtin_amdgcn_sched_barrier(0); \
              _Pragma("unroll") for (int vb = 0; vb < 4; ++vb) { acc[vb] = acc[vb] * gcv; \
                  _Pragma("unroll") for (int ks = 0; ks < 2; ++ks) acc[vb] = mma16(kf[ks], vs[vb][ks], acc[vb]); } } \
        } while (0)
#pragma unroll 1
        for (int ci = 0; ci < nch; ci += 3) {
            GLA_STEP(ci, R1);
            if (ci + 1 < nch) GLA_STEP(ci + 1, R2);
            if (ci + 2 < nch) GLA_STEP(ci + 2, R0);
        }
#undef GLA_STEP
#pragma unroll
        for (int vb = 0; vb < 4; ++vb)
#pragma unroll
            for (int jj = 0; jj < 4; ++jj) op[(size_t)(w * 16 + q * 4 + jj) * 256 + sl * 64 + vb * 16 + r] = acc[vb][jj];
        __syncthreads();
    }
}
__device__ __forceinline__ void ph_gla_fin(const Ctx& c, const bf16_t* __restrict__ U, const float* __restrict__ ng, const float* __restrict__ nb, const bf16_t* __restrict__ RAW, bf16_t* __restrict__ OB) {
    const int lane = c.lane, hs = lane >> 5, l32 = lane & 31;
    for (int i = c.bid * 8 + c.wave; i < MT * 2; i += c.G * 8) {
        const int row = i >> 1, h = (i & 1) * 2 + hs, cc = h * 256 + l32 * 8; bf16_t* p = OB + (size_t)row * BW + cc;
        float x[8], gr[8]; unpack8(*(const u32x4*)(RAW + (size_t)row * BW + cc), x); unpack8(*(const u32x4*)(U + (size_t)row * NINP + U_GR + cc), gr);
        float s = 0.f;
#pragma unroll
        for (int j = 0; j < 8; ++j) s += x[j];
#pragma unroll
        for (int o = 16; o > 0; o >>= 1) s += __shfl_xor(s, o, 64);
        const float mean = s * (1.0f / 256.0f); float qq = 0.f;
#pragma unroll
        for (int j = 0; j < 8; ++j) { const float d = x[j] - mean; qq += d * d; }
#pragma unroll
        for (int o = 16; o > 0; o >>= 1) qq += __shfl_xor(qq, o, 64);
        const float rstd = rsqrtf(qq * (1.0f / 256.0f) + 1e-5f);
        const f32x4 g0 = *(const f32x4*)(ng + cc), g1 = *(const f32x4*)(ng + cc + 4), b0 = *(const f32x4*)(nb + cc), b1 = *(const f32x4*)(nb + cc + 4); float o8[8];
#pragma unroll
        for (int j = 0; j < 8; ++j) o8[j] = ((x[j] - mean) * rstd * (j < 4 ? g0[j] : g1[j - 4]) + (j < 4 ? b0[j] : b1[j - 4])) * gr[j] * sigmoidf_(gr[j]);
        *(u32x4*)p = (u32x4){pk2(o8[0], o8[1]), pk2(o8[2], o8[3]), pk2(o8[4], o8[5]), pk2(o8[6], o8[7])};
    }
}

template <bool ISBF> __device__ __forceinline__ void swa_step(const float (&q)[32], float (&acc)[32], float& m, float& l, const void* kp, const void* vp, float slope, float dist) {
    float s = 0.f;
#pragma unroll
    for (int j = 0; j < 4; ++j) { float x[8];
        if (ISBF) unpack8(*(const u32x4*)((const bf16_t*)kp + j * 8), x);
        else { const f32x4 a = *(const f32x4*)((const float*)kp + j * 8), b = *(const f32x4*)((const float*)kp + j * 8 + 4); x[0] = a[0]; x[1] = a[1]; x[2] = a[2]; x[3] = a[3]; x[4] = b[0]; x[5] = b[1]; x[6] = b[2]; x[7] = b[3]; }
#pragma unroll
        for (int d = 0; d < 8; ++d) s += q[j * 8 + d] * x[d]; }
    s += __shfl_xor(s, 1, 64);
    s = s * 0.125f - slope * dist;
    const float mn = fmaxf(m, s), cc = __expf(m - mn), p = __expf(s - mn);
    l = l * cc + p;
#pragma unroll
    for (int j = 0; j < 4; ++j) { float x[8];
        if (ISBF) unpack8(*(const u32x4*)((const bf16_t*)vp + j * 8), x);
        else { const f32x4 a = *(const f32x4*)((const float*)vp + j * 8), b = *(const f32x4*)((const float*)vp + j * 8 + 4); x[0] = a[0]; x[1] = a[1]; x[2] = a[2]; x[3] = a[3]; x[4] = b[0]; x[5] = b[1]; x[6] = b[2]; x[7] = b[3]; }
#pragma unroll
        for (int d = 0; d < 8; ++d) acc[j * 8 + d] = acc[j * 8 + d] * cc + p * x[d]; }
    m = mn;
}
__device__ __forceinline__ void ph_swa_naive(const Ctx& c, const bf16_t* __restrict__ U, const float* __restrict__ ck, const float* __restrict__ cv, const float* __restrict__ sinks, bf16_t* __restrict__ OB) {
    for (int gid = c.bid * 512 + c.tid; gid < MS * 32; gid += c.G * 512) {
        const int dh = gid & 1, h = (gid >> 1) & 15, row = MP + (gid >> 5), kvh = h >> 3, co = kvh * 64 + dh * 32;
        float q[32], acc[32];
#pragma unroll
        for (int j = 0; j < 4; ++j) { float x[8]; unpack8(*(const u32x4*)(U + (size_t)row * NINP + U_SQ + h * 64 + dh * 32 + j * 8), x);
#pragma unroll
            for (int d = 0; d < 8; ++d) { q[j * 8 + d] = x[d]; acc[j * 8 + d] = 0.f; } }
        const float slope = exp2f(-0.5f * (float)(h + 1)); float m = sinks[h], l = 1.0f;
        if (row < MP) {
            const int t = row % PS, base = row - t, lo = t - 128 < 0 ? 0 : t - 128;
            for (int s = lo; s <= t; ++s) { const bf16_t* ur = U + (size_t)(base + s) * NINP;
                swa_step<true>(q, acc, m, l, ur + U_SK + co, ur + U_SV + co, slope, (float)(t - s)); }
        } else {
            const int sq = (row - MP) / SS, i = (row - MP) % SS;
            for (int idx = i; idx <= 128 + i; ++idx) {
                if (idx < 128) { const size_t o = ((size_t)sq * 128 + idx) * 128 + co; swa_step<false>(q, acc, m, l, ck + o, cv + o, slope, (float)(128 + i - idx)); }
                else { const bf16_t* ur = U + (size_t)(MP + sq * SS + idx - 128) * NINP; swa_step<true>(q, acc, m, l, ur + U_SK + co, ur + U_SV + co, slope, (float)(128 + i - idx)); }
            }
        }
        const float inv = 1.0f / l; bf16_t* op = OB + (size_t)row * BW + h * 64 + dh * 32;
#pragma unroll
        for (int j = 0; j < 4; ++j) { u32x4 w; w.x = pk2(acc[j * 8] * inv, acc[j * 8 + 1] * inv); w.y = pk2(acc[j * 8 + 2] * inv, acc[j * 8 + 3] * inv);
            w.z = pk2(acc[j * 8 + 4] * inv, acc[j * 8 + 5] * inv); w.w = pk2(acc[j * 8 + 6] * inv, acc[j * 8 + 7] * inv); *(u32x4*)(op + j * 8) = w; }
    }
}

__device__ __forceinline__ void ph_rwkv_prep(const Ctx& c, const bf16_t* __restrict__ U, const float* __restrict__ shift, const float* __restrict__ mu, const float* __restrict__ w0, const float* __restrict__ w2,
                                             const float* __restrict__ a0, const float* __restrict__ a2, const float* __restrict__ g2, const float* __restrict__ k_k, const float* __restrict__ k_a,
                                             const float* __restrict__ r_k, float* __restrict__ RW) {
    LAS float* xm = (LAS float*)c.lds; LAS float* tw = xm + RWC; LAS float* ad = tw + 64; LAS float* sg = ad + 64;
    const int tid = c.tid;
    float* R = RW; float* WD = RW + (size_t)MPAD * BW; float* K2 = WD + (size_t)MPAD * BW; float* V = K2 + (size_t)MPAD * BW; float* KK = V + (size_t)MPAD * BW;
    float* BV = KK + (size_t)MPAD * BW; float* G = BV + (size_t)MPAD * BW; float* BON = G + (size_t)MPAD * BW;
    for (int row = c.bid; row < MT; row += c.G) {
        const bf16_t* ur = U + (size_t)row * NINP + U_RU; const bf16_t* pr = ur - NINP; const float* ps = nullptr; bool first;
        if (row < MP) first = (row % PS) == 0; else { first = ((row - MP) % SS) == 0; ps = shift + (size_t)((row - MP) / SS) * RWC; }
        for (int cc = tid; cc < RWC; cc += 512) { const float x = bf2f(ur[cc]); const float s = first ? (ps ? ps[cc] : 0.f) : bf2f(pr[cc]); xm[cc] = x + (s - x) * mu[cc]; }
        __syncthreads();
        if (tid < 64) { tw[tid] = tanhf(xm[3072 + tid]); ad[tid] = xm[3136 + tid]; }
        if (tid >= 128 && tid < 256) sg[tid - 128] = sigmoidf_(xm[3200 + tid - 128]);
        __syncthreads();
        for (int qd = 0; qd < 2; ++qd) {
            const int cc = qd * 512 + tid; float accw = w0[cc], acca = a0[cc], accg = 0.f;
#pragma unroll 4
            for (int j = 0; j < 64; ++j) { accw += tw[j] * w2[j * BW + cc]; acca += ad[j] * a2[j * BW + cc]; }
#pragma unroll 4
            for (int j = 0; j < 128; ++j) accg += sg[j] * g2[j * BW + cc];
            const float lw = -softplusf_(-accw) - 0.5f, decay = __expf(-__expf(lw)), a = sigmoidf_(acca);
            const float r = xm[cc], k = xm[1024 + cc], v = xm[2048 + cc];
            const float kkr = k * k_k[cc]; const float ss = wave_sum(kkr * kkr); const float kk = kkr / fmaxf(sqrtf(ss), 1e-12f);
            const float k2 = k * (1.0f + (a - 1.0f) * k_a[cc]); const float rk = wave_sum(r * k2 * r_k[cc]);
            const size_t o = (size_t)row * BW + cc;
            R[o] = r; WD[o] = decay; K2[o] = k2; V[o] = v; KK[o] = kk; BV[o] = kk * a; G[o] = accg; BON[o] = rk * v;
        }
        __syncthreads();
    }
}
__device__ __forceinline__ int kperm_pos(int k) { return (k & ~31) + 8 * ((k >> 2) & 3) + 4 * ((k >> 4) & 1) + (k & 3); }
__device__ __forceinline__ void ph_swa_prompt(const Ctx& c, const bf16_t* __restrict__ U, const float* __restrict__ sinks, bf16_t* __restrict__ OB) {
    LAS bf16_t* K_l = (LAS bf16_t*)c.lds;
    LAS bf16_t* VT_l = K_l + 192 * 72;
    const int tid = c.tid, lane = c.lane, r = lane & 15, q = lane >> 4, w = c.wave;
    for (int u = c.bid; u < PB * 64 * 2; u += c.G) {
        const int b = u >> 7, qb = (u >> 1) & 63, kvh = u & 1, h = kvh * 8 + w;
        const int tok0 = qb * 64 - 128;
        const size_t seq0 = (size_t)b * PS;
        for (int idx = tid; idx < 192 * 8; idx += 512) { const int kl = idx >> 3, c8 = idx & 7, tk = tok0 + kl; u32x4 kv = (u32x4){0u, 0u, 0u, 0u}, vv = kv;
            if (tk >= 0) { const bf16_t* ur = U + (seq0 + tk) * NINP; kv = *(const u32x4*)(ur + U_SK + kvh * 64 + c8 * 8); vv = *(const u32x4*)(ur + U_SV + kvh * 64 + c8 * 8); }
            *(LAS u32x4*)(K_l + kl * 72 + c8 * 8) = kv;
            const int kp = kperm_pos(kl); LAS bf16_t* vp = VT_l + (c8 * 8) * 200 + kp;
            vp[0] = (bf16_t)(vv.x & 0xffffu); vp[200] = (bf16_t)(vv.x >> 16); vp[400] = (bf16_t)(vv.y & 0xffffu); vp[600] = (bf16_t)(vv.y >> 16);
            vp[800] = (bf16_t)(vv.z & 0xffffu); vp[1000] = (bf16_t)(vv.z >> 16); vp[1200] = (bf16_t)(vv.w & 0xffffu); vp[1400] = (bf16_t)(vv.w >> 16); }
        __syncthreads();
        const float slope = exp2f(-0.5f * (float)(h + 1)), sink = sinks[h];
#pragma unroll 1
        for (int i = 0; i < 4; ++i) {
            const size_t qrow = seq0 + qb * 64 + i * 16 + r;
            const bf16x8 qf0 = *(const bf16x8*)(U + qrow * NINP + U_SQ + h * 64 + q * 8), qf1 = *(const bf16x8*)(U + qrow * NINP + U_SQ + h * 64 + 32 + q * 8);
            const int kt0 = i & ~1;
            f32x4 s[10]; float mx = sink; bf16x8 kfr[5][2];
#pragma unroll
            for (int kt = 0; kt < 10; ++kt) { f32x4 d;
                if (kt % 5 == 0) {
#pragma unroll
                    for (int k5 = 0; k5 < 5; ++k5) { const LAS bf16_t* kp = K_l + ((kt0 + kt + k5) * 16 + r) * 72 + q * 8; kfr[k5][0] = *(const LAS bf16x8*)kp; kfr[k5][1] = *(const LAS bf16x8*)(kp + 32); }
                    __builtin_amdgcn_sched_barrier(0); }
                d = mma16(kfr[kt % 5][0], qf0, (f32x4){0.f, 0.f, 0.f, 0.f}); d = mma16(kfr[kt % 5][1], qf1, d);
#pragma unroll
                for (int jj = 0; jj < 4; ++jj) { const int kl = (kt0 + kt) * 16 + q * 4 + jj, dist = i * 16 + r + 128 - kl;
                    const float v = (dist >= 0 && dist <= 128 && tok0 + kl >= 0) ? d[jj] * 0.125f - slope * (float)dist : -1e30f; d[jj] = v; mx = fmaxf(mx, v); }
                s[kt] = d; }
            mx = fmaxf(mx, __shfl_xor(mx, 16, 64)); mx = fmaxf(mx, __shfl_xor(mx, 32, 64));
            float sum = 0.f; bf16x8 pf[5];
#pragma unroll
            for (int kp = 0; kp < 5; ++kp) { f32x4 a = s[2 * kp], bq = s[2 * kp + 1];
#pragma unroll
                for (int jj = 0; jj < 4; ++jj) { a[jj] = __expf(a[jj] - mx); bq[jj] = __expf(bq[jj] - mx); sum += a[jj] + bq[jj]; }
                pf[kp] = pack_acc(a, bq); }
            sum += __shfl_xor(sum, 16, 64); sum += __shfl_xor(sum, 32, 64);
            const float inv = 1.0f / (sum + __expf(sink - mx));
            bf16_t* op = OB + qrow * BW + h * 64 + q * 4;
#pragma unroll
            for (int dt = 0; dt < 4; ++dt) { f32x4 o = (f32x4){0.f, 0.f, 0.f, 0.f}; bf16x8 vfr[5];
#pragma unroll
                for (int kp = 0; kp < 5; ++kp) vfr[kp] = *(const LAS bf16x8*)(VT_l + (dt * 16 + r) * 200 + (kt0 + 2 * kp) * 16 + q * 8);
                __builtin_amdgcn_sched_barrier(0);
#pragma unroll
                for (int kp = 0; kp < 5; ++kp) o = mma16(vfr[kp], pf[kp], o);
                u32x2 ov; ov.x = pk2(o[0] * inv, o[1] * inv); ov.y = pk2(o[2] * inv, o[3] * inv); *(u32x2*)(op + dt * 16) = ov; }
        }
        __syncthreads();
    }
}

__device__ __forceinline__ void ph_swa_sample(const Ctx& c, const bf16_t* __restrict__ U, const float* __restrict__ ck, const float* __restrict__ cv, const float* __restrict__ sinks, bf16_t* __restrict__ OB) {
    LAS bf16_t* K_l = (LAS bf16_t*)c.lds;
    LAS bf16_t* VT_l = K_l + 160 * 72;
    const int tid = c.tid, lane = c.lane, r = lane & 15, q = lane >> 4, w = c.wave;
    for (int u = c.bid; u < SB * 2; u += c.G) {
        const int sq = u >> 1, kvh = u & 1;
        for (int idx = tid; idx < 160 * 8; idx += 512) { const int kl = idx >> 3, c8 = idx & 7; float kx[8], vx[8];
#pragma unroll
            for (int e = 0; e < 8; ++e) { kx[e] = 0.f; vx[e] = 0.f; }
            if (kl < 128) { const size_t o = ((size_t)sq * 128 + kl) * 128 + kvh * 64 + c8 * 8; const f32x4 a = *(const f32x4*)(ck + o), b2 = *(const f32x4*)(ck + o + 4), c2 = *(const f32x4*)(cv + o), d2 = *(const f32x4*)(cv + o + 4);
                kx[0] = a[0]; kx[1] = a[1]; kx[2] = a[2]; kx[3] = a[3]; kx[4] = b2[0]; kx[5] = b2[1]; kx[6] = b2[2]; kx[7] = b2[3];
                vx[0] = c2[0]; vx[1] = c2[1]; vx[2] = c2[2]; vx[3] = c2[3]; vx[4] = d2[0]; vx[5] = d2[1]; vx[6] = d2[2]; vx[7] = d2[3]; }
            else if (kl < 132) { const bf16_t* ur = U + (size_t)(MP + sq * SS + kl - 128) * NINP; unpack8(*(const u32x4*)(ur + U_SK + kvh * 64 + c8 * 8), kx); unpack8(*(const u32x4*)(ur + U_SV + kvh * 64 + c8 * 8), vx); }
            *(LAS u32x4*)(K_l + kl * 72 + c8 * 8) = (u32x4){pk2(kx[0], kx[1]), pk2(kx[2], kx[3]), pk2(kx[4], kx[5]), pk2(kx[6], kx[7])};
            LAS bf16_t* vp = VT_l + (c8 * 8) * 168 + kperm_pos(kl);
#pragma unroll
            for (int e = 0; e < 8; ++e) vp[e * 168] = f2bf(vx[e]); }
        __syncthreads();
        if (w < 2) {
            const int h = kvh * 8 + w * 4 + (r >> 2), tk = r & 3; const size_t qrow = (size_t)(MP + sq * SS + tk);
            const float slope = exp2f(-0.5f * (float)(h + 1)), sink = sinks[h];
            const bf16x8 qf0 = *(const bf16x8*)(U + qrow * NINP + U_SQ + h * 64 + q * 8), qf1 = *(const bf16x8*)(U + qrow * NINP + U_SQ + h * 64 + 32 + q * 8);
            f32x4 s[10]; float mx = sink;
#pragma unroll
            for (int kt = 0; kt < 10; ++kt) { const LAS bf16_t* kp = K_l + (kt * 16 + r) * 72 + q * 8;
                f32x4 d = mma16(*(const LAS bf16x8*)kp, qf0, (f32x4){0.f, 0.f, 0.f, 0.f}); d = mma16(*(const LAS bf16x8*)(kp + 32), qf1, d);
#pragma unroll
                for (int jj = 0; jj < 4; ++jj) { const int kl = kt * 16 + q * 4 + jj, dist = 128 + tk - kl;
                    const float v = (dist >= 0 && dist <= 128) ? d[jj] * 0.125f - slope * (float)dist : -1e30f; d[jj] = v; mx = fmaxf(mx, v); }
                s[kt] = d; }
            mx = fmaxf(mx, __shfl_xor(mx, 16, 64)); mx = fmaxf(mx, __shfl_xor(mx, 32, 64));
            float sum = 0.f; bf16x8 pf[5];
#pragma unroll
            for (int kp = 0; kp < 5; ++kp) { f32x4 a = s[2 * kp], bq = s[2 * kp + 1];
#pragma unroll
                for (int jj = 0; jj < 4; ++jj) { a[jj] = __expf(a[jj] - mx); bq[jj] = __expf(bq[jj] - mx); sum += a[jj] + bq[jj]; }
                pf[kp] = pack_acc(a, bq); }
            sum += __shfl_xor(sum, 16, 64); sum += __shfl_xor(sum, 32, 64);
            const float inv = 1.0f / (sum + __expf(sink - mx));
            bf16_t* op = OB + qrow * BW + h * 64 + q * 4;
#pragma unroll
            for (int dt = 0; dt < 4; ++dt) { f32x4 o = (f32x4){0.f, 0.f, 0.f, 0.f};
#pragma unroll
                for (int kp = 0; kp < 5; ++kp) o = mma16(*(const LAS bf16x8*)(VT_l + (dt * 16 + r) * 168 + kp * 32 + q * 8), pf[kp], o);
                u32x2 ov; ov.x = pk2(o[0] * inv, o[1] * inv); ov.y = pk2(o[2] * inv, o[3] * inv); *(u32x2*)(op + dt * 16) = ov; }
        }
        __syncthreads();
    }
}

__device__ __forceinline__ void ph_memattn_prompt(const Ctx& c, const bf16_t* __restrict__ U, const bf16_t* __restrict__ MKB, const bf16_t* __restrict__ MVT, bf16_t* __restrict__ OB) {
    LAS bf16_t* buf = (LAS bf16_t*)c.lds;
    const int tid = c.tid, lane = c.lane, r = lane & 15, q = lane >> 4, w = c.wave;
    for (int u = c.bid; u < PB * 4 * 32; u += c.G) {
        const int b = u >> 7, h = (u >> 5) & 3, qb = u & 31;
        const size_t qrow = (size_t)b * PS + qb * 128 + w * 16 + r;
        const bf16_t* kg = MKB + (size_t)(b * 256) * 1024 + h * 256;
        const bf16_t* vg = MVT + (size_t)(b * 4 + h) * 65536;
        const bf16_t* qg = U + qrow * NINP + U_MQ + h * 256 + q * 8;
        bf16x8 qn0 = *(const bf16x8*)qg, qn1 = *(const bf16x8*)(qg + 32);
        u32x4 st[4];
#pragma unroll
        for (int i = 0; i < 4; ++i) { const int p = tid + 512 * i; st[i] = *(const u32x4*)(kg + (size_t)(p >> 3) * 1024 + (p & 7) * 8); }
        f32x4 s[16];
#pragma unroll
        for (int mt = 0; mt < 16; ++mt) s[mt] = (f32x4){0.f, 0.f, 0.f, 0.f};
        __syncthreads();
#pragma unroll 1
        for (int ck = 0; ck < 4; ++ck) {
            LAS bf16_t* kb = buf + (ck & 1) * 18432;
#pragma unroll
            for (int i = 0; i < 4; ++i) { const int p = tid + 512 * i; *(LAS u32x4*)(kb + (p >> 3) * 72 + (p & 7) * 8) = st[i]; }
            __syncthreads();
            const bf16x8 qc0 = qn0, qc1 = qn1;
            if (ck < 3) { qn0 = *(const bf16x8*)(qg + (ck + 1) * 64); qn1 = *(const bf16x8*)(qg + (ck + 1) * 64 + 32);
#pragma unroll
                for (int i = 0; i < 4; ++i) { const int p = tid + 512 * i; st[i] = *(const u32x4*)(kg + (size_t)(p >> 3) * 1024 + (ck + 1) * 64 + (p & 7) * 8); } }
#pragma unroll
            for (int m2 = 0; m2 < 16; m2 += 2) { bf16x8 kf[2][2];
#pragma unroll
                for (int j = 0; j < 2; ++j) { kf[j][0] = *(const LAS bf16x8*)(kb + ((m2 + j) * 16 + r) * 72 + q * 8); kf[j][1] = *(const LAS bf16x8*)(kb + ((m2 + j) * 16 + r) * 72 + 32 + q * 8); }
                __builtin_amdgcn_sched_barrier(0);
#pragma unroll
                for (int j = 0; j < 2; ++j) { s[m2 + j] = mma16(kf[j][0], qc0, s[m2 + j]); s[m2 + j] = mma16(kf[j][1], qc1, s[m2 + j]); } }
        }
#pragma unroll
        for (int i = 0; i < 4; ++i) { const int p = tid + 512 * i; st[i] = *(const u32x4*)(vg + (size_t)(p >> 5) * 256 + (p & 31) * 8); }
        float mx = -3.0e38f;
#pragma unroll
        for (int mt = 0; mt < 16; ++mt)
#pragma unroll
            for (int jj = 0; jj < 4; ++jj) { s[mt][jj] *= 0.0625f; mx = fmaxf(mx, s[mt][jj]); }
        mx = fmaxf(mx, __shfl_xor(mx, 16, 64)); mx = fmaxf(mx, __shfl_xor(mx, 32, 64));
        float sum = 0.f; bf16x8 pf[8];
#pragma unroll
        for (int kp = 0; kp < 8; ++kp) { f32x4 a = s[2 * kp], b2 = s[2 * kp + 1];
#pragma unroll
            for (int jj = 0; jj < 4; ++jj) { a[jj] = __expf(a[jj] - mx); b2[jj] = __expf(b2[jj] - mx); sum += a[jj] + b2[jj]; }
            pf[kp] = pack_acc(a, b2); }
        sum += __shfl_xor(sum, 16, 64); sum += __shfl_xor(sum, 32, 64);
        const float inv = 1.0f / sum;
        bf16_t* op = OB + qrow * BW + h * 256 + q * 4;
#pragma unroll 1
        for (int cv = 0; cv < 4; ++cv) {
            LAS bf16_t* vb = buf + (cv & 1) * 18432;
#pragma unroll
            for (int i = 0; i < 4; ++i) { const int p = tid + 512 * i, m0 = (p & 31) * 8; LAS bf16_t* d0 = vb + (p >> 5) * 264;
                *(LAS u32x2*)(d0 + kperm_pos(m0)) = (u32x2){st[i].x, st[i].y}; *(LAS u32x2*)(d0 + kperm_pos(m0 + 4)) = (u32x2){st[i].z, st[i].w}; }
            __syncthreads();
            if (cv < 3) {
#pragma unroll
                for (int i = 0; i < 4; ++i) { const int p = tid + 512 * i; st[i] = *(const u32x4*)(vg + (size_t)((cv + 1) * 64 + (p >> 5)) * 256 + (p & 31) * 8); } }
#pragma unroll
            for (int dt = 0; dt < 4; ++dt) { bf16x8 vf[8];
#pragma unroll
                for (int kp = 0; kp < 8; ++kp) vf[kp] = *(const LAS bf16x8*)(vb + (dt * 16 + r) * 264 + kp * 32 + q * 8);
                __builtin_amdgcn_sched_barrier(0);
                f32x4 o = (f32x4){0.f, 0.f, 0.f, 0.f};
#pragma unroll
                for (int kp = 0; kp < 8; ++kp) o = mma16(vf[kp], pf[kp], o);
                u32x2 ov; ov.x = pk2(o[0] * inv, o[1] * inv); ov.y = pk2(o[2] * inv, o[3] * inv); *(u32x2*)(op + (cv * 4 + dt) * 16) = ov; }
        }
        __syncthreads();
    }
}

__device__ __forceinline__ void ph_lrw(const Ctx& c, const float* __restrict__ w2, const float* __restrict__ a2, const float* __restrict__ g2, bf16_t* __restrict__ LRW) {
    for (int idx = c.bid * 512 + c.tid; idx < NL * 256 * 1024; idx += c.G * 512) {
        const int ch = idx & 1023, j = (idx >> 10) & 255, l = idx >> 18;
        const float v = j < 64 ? w2[((size_t)l * 64 + j) * BW + ch] : (j < 128 ? a2[((size_t)l * 64 + j - 64) * BW + ch] : g2[((size_t)l * 128 + j - 128) * BW + ch]);
        LRW[((size_t)l * 1024 + ch) * 256 + j] = f2bf(v);
    }
}
constexpr int RWP_UNITS = (MP / 64) * 4 + SB * 4;
__device__ __forceinline__ void rwp_unit_info(int u, int& row0, int& ntok, int& hg, int& sq, bool& seq_first) {
    if (u < (MP / 64) * 4) { const int blk = u >> 2; hg = u & 3; row0 = blk * 64; ntok = 64; sq = -1; seq_first = (row0 % PS) == 0; }
    else { const int s = u - (MP / 64) * 4; sq = s >> 2; hg = s & 3; row0 = MP + sq * SS; ntok = SS; seq_first = true; }
}
__device__ __forceinline__ void ph_rwkv_pre(const Ctx& c, const bf16_t* __restrict__ U, const float* __restrict__ shift, const float* __restrict__ mu, const float* __restrict__ w0, const float* __restrict__ w2,
                                            const float* __restrict__ a0, const float* __restrict__ a2, const float* __restrict__ g2, const float* __restrict__ k_k, const float* __restrict__ k_a,
                                            const float* __restrict__ r_k, float* __restrict__ RW, bf16_t* __restrict__ RB, const bf16_t* __restrict__ LRW) {
    LAS bf16_t* P_l = (LAS bf16_t*)c.lds; LAS bf16_t* Kn_l = P_l + 4608; LAS bf16_t* Bn_l = Kn_l + 4608; LAS bf16_t* Q_l = Bn_l + 4608;
    LAS bf16_t* PT_l = Q_l + 4608; LAS bf16_t* BhT_l = PT_l + 4608; LAS bf16_t* KhT_l = BhT_l + 4608; LAS bf16_t* VT_l = KhT_l + 4608;
    LAS float* A_l = (LAS float*)(c.lds + 73728);
    LAS bf16_t* BmT_l = (LAS bf16_t*)(c.lds + 78848); LAS bf16_t* F_l = (LAS bf16_t*)(c.lds + 81920); LAS bf16_t* Tinv_l = (LAS bf16_t*)(c.lds + 84992);
    LAS bf16_t* PpT_l = (LAS bf16_t*)(c.lds + 88064);
    LAS bf16_t* BmpT_l = (LAS bf16_t*)(c.lds + 97280);
    LAS float* GC_l = (LAS float*)(c.lds + 100352);
    LAS float* lg_l = (LAS float*)(c.lds + 125952);
    LAS bf16_t* act_l = (LAS bf16_t*)c.lds;
    LAS bf16_t* wT_l = act_l + 64 * 264;
    LAS bf16_t* aT_l = wT_l + 64 * 72;
    LAS bf16_t* gT_l = aT_l + 64 * 72;
    LAS float* pre_l = (LAS float*)(c.lds + 73728);
    const int tid = c.tid, lane = c.lane, r = lane & 15, q = lane >> 4, w = c.wave;
    bf16_t* Gg = (bf16_t*)(RW + 6 * (size_t)MPAD * BW); bf16_t* BON = (bf16_t*)(RW + 7 * (size_t)MPAD * BW);
    for (int u = c.bid; u < RWP_UNITS; u += c.G) {
        int row0, ntok, hg, sq; bool seq_first; rwp_unit_info(u, row0, ntok, hg, sq, seq_first);
        const float* sh = sq >= 0 ? shift + (size_t)sq * RWC : nullptr;
        const int nstage = ntok == 64 ? 64 : 16;
        for (int idx = tid; idx < nstage * 32; idx += 512) {
            const int t = idx >> 5, c8 = idx & 31, cc = 3072 + c8 * 8; float val[8];
#pragma unroll
            for (int e2 = 0; e2 < 8; ++e2) val[e2] = 0.f;
            if (t < ntok) { const bf16_t* ur = U + (size_t)(row0 + t) * NINP + U_RU; float x[8], p[8];
                unpack8(*(const u32x4*)(ur + cc), x);
                if (!(t == 0 && seq_first)) unpack8(*(const u32x4*)(ur + cc - NINP), p);
                else if (sh) { const f32x4 s0v = *(const f32x4*)(sh + cc), s1v = *(const f32x4*)(sh + cc + 4); p[0] = s0v[0]; p[1] = s0v[1]; p[2] = s0v[2]; p[3] = s0v[3]; p[4] = s1v[0]; p[5] = s1v[1]; p[6] = s1v[2]; p[7] = s1v[3]; }
                else {
#pragma unroll
                    for (int e2 = 0; e2 < 8; ++e2) p[e2] = 0.f; }
                const f32x4 m0 = *(const f32x4*)(mu + cc), m1 = *(const f32x4*)(mu + cc + 4);
#pragma unroll
                for (int e2 = 0; e2 < 8; ++e2) { const float xm = x[e2] + (p[e2] - x[e2]) * (e2 < 4 ? m0[e2] : m1[e2 - 4]); val[e2] = c8 < 8 ? tanh_fast(xm) : (c8 < 16 ? xm : sigmoidf_(xm)); } }
            *(LAS u32x4*)(act_l + t * 264 + c8 * 8) = (u32x4){pk2(val[0], val[1]), pk2(val[2], val[3]), pk2(val[4], val[5]), pk2(val[6], val[7])};
        }
        __syncthreads();
        bf16x8 af[8];
        { const int tb = w & 3;
#pragma unroll
          for (int ks = 0; ks < 8; ++ks) af[ks] = *(const LAS bf16x8*)(act_l + (tb * 16 + r) * 264 + ks * 32 + q * 8); }
        __syncthreads();
#pragma unroll 1
        for (int hh = 0; hh < 4; ++hh) { const int h = hg * 4 + hh;
        { const int tb = w & 3, chf = w >> 2;
          if (tb * 16 < nstage) {
#pragma unroll
            for (int e2 = 0; e2 < 2; ++e2) { const int cb = chf * 2 + e2; f32x4 dw = (f32x4){0.f, 0.f, 0.f, 0.f}, da = dw, dg = dw;
                const bf16_t* wr = LRW + ((size_t)h * 64 + cb * 16 + r) * 256 + q * 8; bf16x8 wf[8];
#pragma unroll
                for (int ks = 0; ks < 8; ++ks) wf[ks] = *(const bf16x8*)(wr + ks * 32);
                __builtin_amdgcn_sched_barrier(0);
#pragma unroll
                for (int ks = 0; ks < 2; ++ks) { dw = mma16(wf[ks], af[ks], dw); da = mma16(wf[2 + ks], af[2 + ks], da); }
#pragma unroll
                for (int ks = 0; ks < 4; ++ks) dg = mma16(wf[4 + ks], af[4 + ks], dg);
                const int o = (tb * 16 + r) * 68 + cb * 16 + q * 4;
                *(LAS f32x4*)(pre_l + o) = dw; *(LAS f32x4*)(pre_l + 64 * 68 + o) = da; *(LAS f32x4*)(pre_l + 2 * 64 * 68 + o) = dg; } } }
        __syncthreads();
        const int t = tid >> 3, cg = tid & 7, c0 = h * 64 + cg * 8, sc = t >> 4;
        float rr[8], k2[8], kap[8], bet[8], nlw[8];
        { float vx[8], gg[8], kkr[8]; float ss = 0.f, rk = 0.f;
          if (t < ntok) {
            const size_t row = (size_t)(row0 + t); const bf16_t* ur = U + row * NINP + U_RU; const bool fst = (t == 0 && seq_first);
            float kx[8];
#pragma unroll
            for (int part = 0; part < 3; ++part) { const int cc = part * 1024 + c0; float x[8], p[8];
                unpack8(*(const u32x4*)(ur + cc), x);
                if (!fst) unpack8(*(const u32x4*)(ur + cc - NINP), p);
                else {
#pragma unroll
                    for (int j = 0; j < 8; ++j) p[j] = sh ? sh[cc + j] : 0.f; }
                const f32x4 mA = *(const f32x4*)(mu + cc), mB = *(const f32x4*)(mu + cc + 4);
#pragma unroll
                for (int j = 0; j < 8; ++j) { const float xm = x[j] + (p[j] - x[j]) * (j < 4 ? mA[j] : mB[j - 4]); if (part == 0) rr[j] = xm; else if (part == 1) kx[j] = xm; else vx[j] = xm; } }
            float pw[8], pa[8], pkk[8], pka[8], prk[8];
#pragma unroll
            for (int hf = 0; hf < 2; ++hf) { const f32x4 v0 = *(const f32x4*)(w0 + c0 + hf * 4), v1 = *(const f32x4*)(a0 + c0 + hf * 4), v2 = *(const f32x4*)(k_k + c0 + hf * 4), v3 = *(const f32x4*)(k_a + c0 + hf * 4), v4 = *(const f32x4*)(r_k + c0 + hf * 4);
#pragma unroll
                for (int j = 0; j < 4; ++j) { pw[hf * 4 + j] = v0[j]; pa[hf * 4 + j] = v1[j]; pkk[hf * 4 + j] = v2[j]; pka[hf * 4 + j] = v3[j]; prk[hf * 4 + j] = v4[j]; } }
            float lwp[8], app[8];
#pragma unroll
            for (int hf = 0; hf < 2; ++hf) { const f32x4 v0 = *(const LAS f32x4*)(pre_l + t * 68 + cg * 8 + hf * 4), v1 = *(const LAS f32x4*)(pre_l + 64 * 68 + t * 68 + cg * 8 + hf * 4), v2 = *(const LAS f32x4*)(pre_l + 2 * 64 * 68 + t * 68 + cg * 8 + hf * 4);
#pragma unroll
                for (int j = 0; j < 4; ++j) { lwp[hf * 4 + j] = v0[j]; app[hf * 4 + j] = v1[j]; gg[hf * 4 + j] = v2[j]; } }
#pragma unroll
            for (int j = 0; j < 8; ++j) {
                const float lw = -softplus_fast(-(pw[j] + lwp[j])) - 0.5f; nlw[j] = -__expf(lw); const float av = sigmoidf_(pa[j] + app[j]);
                kkr[j] = kx[j] * pkk[j]; ss += kkr[j] * kkr[j]; k2[j] = kx[j] * (1.0f + (av - 1.0f) * pka[j]); rk += rr[j] * k2[j] * prk[j]; bet[j] = av; }
          } else {
#pragma unroll
            for (int j = 0; j < 8; ++j) { rr[j] = 0.f; k2[j] = 0.f; kkr[j] = 0.f; bet[j] = 0.f; nlw[j] = 0.f; vx[j] = 0.f; gg[j] = 0.f; }
          }
          ss += __shfl_xor(ss, 1, 64); ss += __shfl_xor(ss, 2, 64); ss += __shfl_xor(ss, 4, 64);
          rk += __shfl_xor(rk, 1, 64); rk += __shfl_xor(rk, 2, 64); rk += __shfl_xor(rk, 4, 64);
          const float inv = 1.0f / fmaxf(sqrtf(ss), 1e-12f);
#pragma unroll
          for (int j = 0; j < 8; ++j) { kap[j] = kkr[j] * inv; bet[j] = kap[j] * bet[j]; }
          if (t < ntok) { const size_t o = (size_t)(row0 + t) * BW + c0;
              *(u32x4*)(Gg + o) = (u32x4){pk2(gg[0], gg[1]), pk2(gg[2], gg[3]), pk2(gg[4], gg[5]), pk2(gg[6], gg[7])};
              *(u32x4*)(BON + o) = (u32x4){pk2(rk * vx[0], rk * vx[1]), pk2(rk * vx[2], rk * vx[3]), pk2(rk * vx[4], rk * vx[5]), pk2(rk * vx[6], rk * vx[7])}; }
          *(LAS f32x4*)(lg_l + t * 68 + cg * 8) = (f32x4){nlw[0], nlw[1], nlw[2], nlw[3]}; *(LAS f32x4*)(lg_l + t * 68 + cg * 8 + 4) = (f32x4){nlw[4], nlw[5], nlw[6], nlw[7]};
#pragma unroll
          for (int j = 0; j < 8; ++j) VT_l[(cg * 8 + j) * 72 + t] = f2bf(vx[j]);
        }
        __syncthreads();
        if (tid < 256) { const int cc = tid & 63, s4 = tid >> 6; float run = 0.f;
#pragma unroll
            for (int i = 0; i < 16; ++i) { const int o = (s4 * 16 + i) * 68 + cc; run += lg_l[o]; lg_l[o] = run; } }
        __syncthreads();
        { unsigned pp[4], pq[4], pk[4], pb[4];
#pragma unroll
          for (int j = 0; j < 8; j += 2) { float vP[2], vQ[2], vK[2], vB[2];
#pragma unroll
              for (int e = 0; e < 2; ++e) { const int jj = j + e, cc = cg * 8 + jj; const float ci = lg_l[t * 68 + cc], cC = lg_l[(sc * 16 + 15) * 68 + cc];
                  const float ei = __expf(-ci), eh = __expf(cC - ci);
                  vP[e] = kap[jj] * __expf(ci - nlw[jj]); vQ[e] = rr[jj] * __expf(ci); vK[e] = k2[jj] * ei; vB[e] = bet[jj] * ei;
                  PT_l[cc * 72 + t] = f2bf(vP[e]); BhT_l[cc * 72 + t] = f2bf(bet[jj] * eh); KhT_l[cc * 72 + t] = f2bf(k2[jj] * eh); }
              pp[j >> 1] = pk2(vP[0], vP[1]); pq[j >> 1] = pk2(vQ[0], vQ[1]); pk[j >> 1] = pk2(vK[0], vK[1]); pb[j >> 1] = pk2(vB[0], vB[1]); }
          const int o = t * 72 + cg * 8;
          *(LAS u32x4*)(P_l + o) = (u32x4){pp[0], pp[1], pp[2], pp[3]}; *(LAS u32x4*)(Q_l + o) = (u32x4){pq[0], pq[1], pq[2], pq[3]};
          *(LAS u32x4*)(Kn_l + o) = (u32x4){pk[0], pk[1], pk[2], pk[3]}; *(LAS u32x4*)(Bn_l + o) = (u32x4){pb[0], pb[1], pb[2], pb[3]};
          if ((t & 15) == 15) {
#pragma unroll
              for (int j = 0; j < 8; ++j) GC_l[sc * 64 + cg * 8 + j] = __expf(lg_l[t * 68 + cg * 8 + j]); } }
        __syncthreads();
        const int nsub = ntok == 64 ? 4 : 1;
        const bf16x8 zfrag = (bf16x8){0, 0, 0, 0, 0, 0, 0, 0};
        for (int id = w; id < nsub * 3; id += 8) { const int s4 = id / 3, prod = id - s4 * 3; f32x4 d = (f32x4){0.f, 0.f, 0.f, 0.f};
            const LAS bf16_t* X = (prod == 1 ? P_l : Bn_l) + (s4 * 16 + r) * 72 + q * 8; const LAS bf16_t* Y = (prod == 0 ? P_l : (prod == 1 ? Kn_l : Q_l)) + (s4 * 16 + r) * 72 + q * 8;
            { const bf16x8 x0 = *(const LAS bf16x8*)X, x1 = *(const LAS bf16x8*)(X + 32), y0 = *(const LAS bf16x8*)Y, y1 = *(const LAS bf16x8*)(Y + 32);
              __builtin_amdgcn_sched_barrier(0); d = mma16(x0, y0, d); d = mma16(x1, y1, d); }
            if (prod == 0) { f32x4 o4;
#pragma unroll
                for (int jj = 0; jj < 4; ++jj) o4[jj] = (q * 4 + jj < r) ? d[jj] : 0.f;
                *(LAS f32x4*)(A_l + s4 * 320 + r * 20 + q * 4) = o4; }
            else { float o4[4];
#pragma unroll
                for (int jj = 0; jj < 4; ++jj) o4[jj] = (prod == 1 ? (r < q * 4 + jj) : (q * 4 + jj <= r)) ? d[jj] : 0.f;
                u32x2 o; o.x = pk2(o4[0], o4[1]); o.y = pk2(o4[2], o4[3]); *(LAS u32x2*)((prod == 1 ? BmT_l : F_l) + s4 * 384 + r * 24 + q * 4) = o; } }
        __syncthreads();
        if (w == 0 && (lane >> 4) < nsub) { const int s4 = lane >> 4, jc = lane & 15; float x[16];
#pragma unroll
            for (int tt = 0; tt < 16; ++tt) { float s = (tt == jc) ? 1.f : 0.f;
#pragma unroll
                for (int i = 0; i < tt; ++i) s -= A_l[s4 * 320 + tt * 20 + i] * x[i];
                x[tt] = s; }
#pragma unroll
            for (int tt = 0; tt < 16; ++tt) Tinv_l[s4 * 384 + tt * 24 + jc] = f2bf(x[tt]); }
        __syncthreads();
        for (int id = w; id < nsub * 5; id += 8) { const int s4 = id / 5, rem = id - s4 * 5;
            const bf16x8 xf = q < 2 ? *(const LAS bf16x8*)(Tinv_l + s4 * 384 + r * 24 + q * 8) : zfrag;
            const bf16x8 yf = q < 2 ? (rem < 4 ? *(const LAS bf16x8*)(PT_l + (rem * 16 + r) * 72 + s4 * 16 + q * 8) : *(const LAS bf16x8*)(BmT_l + s4 * 384 + r * 24 + q * 8)) : zfrag;
            const f32x4 d = mma16(xf, yf, (f32x4){0.f, 0.f, 0.f, 0.f});
            u32x2 o; o.x = pk2(d[0], d[1]); o.y = pk2(d[2], d[3]);
            if (rem < 4) *(LAS u32x2*)(PpT_l + (rem * 16 + r) * 72 + s4 * 16 + q * 4) = o; else *(LAS u32x2*)(BmpT_l + s4 * 384 + r * 24 + q * 4) = o; }
        __syncthreads();
        { const int chunk0 = sq >= 0 ? PB * 16 * 256 + sq * 16 + h : ((row0 / PS) * 16 + h) * 256 + ((row0 % PS) >> 4);
          for (int id = w; id < nsub * 25; id += 8) { const int s4 = id / 25, rem = id - s4 * 25; bf16_t* blob = RB + (size_t)(chunk0 + s4) * RB_EL;
            const bf16x8 fF = q < 2 ? *(const LAS bf16x8*)(F_l + s4 * 384 + r * 24 + q * 8) : zfrag;
            if (rem < 4) {
                const bf16x8 xf = q < 2 ? *(const LAS bf16x8*)(PpT_l + (rem * 16 + r) * 72 + s4 * 16 + q * 8) : zfrag;
                const f32x4 d = mma16(xf, fF, (f32x4){0.f, 0.f, 0.f, 0.f});
                const u32x2 qv = *(const LAS u32x2*)(Q_l + (s4 * 16 + r) * 72 + rem * 16 + q * 4);
                u32x2 o; o.x = pk2(__uint_as_float(qv.x << 16) - d[0], __uint_as_float(qv.x & 0xffff0000u) - d[1]); o.y = pk2(__uint_as_float(qv.y << 16) - d[2], __uint_as_float(qv.y & 0xffff0000u) - d[3]);
                *(u32x2*)(blob + RB_QP + r * 72 + 32 * (rem >> 1) + 8 * q + 4 * (rem & 1)) = o;
            } else if (rem == 4) {
                f32x4 d2 = (f32x4){0.f, 0.f, 0.f, 0.f};
#pragma unroll
                for (int ks = 0; ks < 2; ++ks) d2 = mma16(*(const LAS bf16x8*)(Kn_l + (s4 * 16 + r) * 72 + ks * 32 + q * 8), *(const LAS bf16x8*)(Q_l + (s4 * 16 + r) * 72 + ks * 32 + q * 8), d2);
                const bf16x8 xf = q < 2 ? *(const LAS bf16x8*)(BmpT_l + s4 * 384 + r * 24 + q * 8) : zfrag;
                const f32x4 d1 = mma16(xf, fF, (f32x4){0.f, 0.f, 0.f, 0.f});
                float o4[4];
#pragma unroll
                for (int jj = 0; jj < 4; ++jj) o4[jj] = ((q * 4 + jj <= r) ? d2[jj] : 0.f) - d1[jj];
                u32x2 o; o.x = pk2(o4[0], o4[1]); o.y = pk2(o4[2], o4[3]); *(u32x2*)(blob + RB_EP + r * 24 + q * 4) = o;
            } else if (rem < 21) {
                const int cib = (rem - 5) >> 2, cob = (rem - 5) & 3;
                const bf16x8 xf = q < 2 ? *(const LAS bf16x8*)(PpT_l + (cib * 16 + r) * 72 + s4 * 16 + q * 8) : zfrag;
                const bf16x8 yf = q < 2 ? *(const LAS bf16x8*)(BhT_l + (cob * 16 + r) * 72 + s4 * 16 + q * 8) : zfrag;
                const f32x4 d = mma16(xf, yf, (f32x4){0.f, 0.f, 0.f, 0.f});
                const float gc = GC_l[s4 * 64 + cob * 16 + r]; float o4[4];
#pragma unroll
                for (int jj = 0; jj < 4; ++jj) o4[jj] = ((cib == cob && q * 4 + jj == r) ? gc : 0.f) - d[jj];
                u32x2 o; o.x = pk2(o4[0], o4[1]); o.y = pk2(o4[2], o4[3]); *(u32x2*)(blob + (cob * 16 + r) * 72 + 32 * (cib >> 1) + 8 * q + 4 * (cib & 1)) = o;
            } else {
                const int cb = rem - 21;
                const bf16x8 xf = q < 2 ? *(const LAS bf16x8*)(BmpT_l + s4 * 384 + r * 24 + q * 8) : zfrag;
                const bf16x8 yf = q < 2 ? *(const LAS bf16x8*)(BhT_l + (cb * 16 + r) * 72 + s4 * 16 + q * 8) : zfrag;
                const f32x4 d = mma16(xf, yf, (f32x4){0.f, 0.f, 0.f, 0.f});
                const u32x2 kv = *(const LAS u32x2*)(KhT_l + (cb * 16 + r) * 72 + s4 * 16 + q * 4);
                u32x2 o; o.x = pk2(__uint_as_float(kv.x << 16) - d[0], __uint_as_float(kv.x & 0xffff0000u) - d[1]); o.y = pk2(__uint_as_float(kv.y << 16) - d[2], __uint_as_float(kv.y & 0xffff0000u) - d[3]);
                *(u32x2*)(blob + RB_KHP + (cb * 16 + r) * 24 + q * 4) = o;
            } }
          for (int idx = tid; idx < nsub * 128; idx += 512) { const int s4 = idx >> 7, cc = (idx >> 1) & 63, hf = idx & 1;
              *(u32x4*)(RB + (size_t)(chunk0 + s4) * RB_EL + RB_VT + cc * 24 + hf * 8) = *(const LAS u32x4*)(VT_l + cc * 72 + s4 * 16 + hf * 8); } }
        __syncthreads();
        }
    }
}

__device__ __forceinline__ void ph_rwkv_scan_naive(const Ctx& c, const float* __restrict__ RW, const float* __restrict__ s0, const float* __restrict__ lng, const float* __restrict__ lnb, bf16_t* __restrict__ OB,
                                                   float* __restrict__ outP, float* __restrict__ outS) {
    const float* R = RW; const float* WD = RW + (size_t)MPAD * BW; const float* K2 = WD + (size_t)MPAD * BW; const float* V = K2 + (size_t)MPAD * BW; const float* KK = V + (size_t)MPAD * BW;
    const float* BV = KK + (size_t)MPAD * BW; const float* G = BV + (size_t)MPAD * BW; const float* BON = G + (size_t)MPAD * BW;
    const int lane = c.lane;
    for (int it = 0;; ++it) {
        const int u = (it * 8 + c.wave) * c.G + c.bid;
        if (u >= (PB + SB) * 16) break;
        const int sq = u >> 4, h = u & 15;
        int row0, L; seq_info(sq, row0, L);
        float S[64];
        if (sq >= PB) { const float* p = s0 + (((size_t)(sq - PB) * 16 + h) * 64 + lane) * 64;
#pragma unroll
            for (int j = 0; j < 64; ++j) S[j] = p[j]; }
        else {
#pragma unroll
            for (int j = 0; j < 64; ++j) S[j] = 0.f; }
        const float lg = lng[h * 64 + lane], lb = lnb[h * 64 + lane];
        for (int t = 0; t < L; ++t) {
            const size_t base = (size_t)(row0 + t) * BW + h * 64; const float v = V[base + lane];
            float d = 0.f;
#pragma unroll
            for (int j = 0; j < 64; ++j) d += S[j] * KK[base + j];
            float y = 0.f;
#pragma unroll
            for (int j = 0; j < 64; ++j) { S[j] = S[j] * WD[base + j] - d * BV[base + j] + v * K2[base + j]; y += S[j] * R[base + j]; }
            const float mean = wave_sum(y) * (1.0f / 64.0f), dy = y - mean, var = wave_sum(dy * dy) * (1.0f / 64.0f);
            const float yn = dy * rsqrtf(var + 64e-5f) * lg + lb;
            OB[base + lane] = f2bf((yn + BON[base + lane]) * G[base + lane]);
        }
        float* op = (sq < PB ? outP + (((size_t)sq * 16 + h) * 64 + lane) * 64 : outS + (((size_t)(sq - PB) * 16 + h) * 64 + lane) * 64);
#pragma unroll
        for (int j = 0; j < 64; ++j) op[j] = S[j];
    }
}
__device__ __forceinline__ void ph_rwkv_scan2(const Ctx& c, int boff, const float* __restrict__ RW, const float* __restrict__ s0, const float* __restrict__ lng, const float* __restrict__ lnb, bf16_t* __restrict__ OB,
                                              float* __restrict__ outP, float* __restrict__ outS) {
    LAS float* opb = (LAS float*)c.lds;
    LAS float* yb = opb + 2 * 16 * 384;
    const int tid = c.tid, lane = c.lane, w = c.wave, rl = lane >> 3, cg = lane & 7, vrow = w * 8 + rl;
    const float* G = RW + 6 * (size_t)MPAD * BW; const float* BON = RW + 7 * (size_t)MPAD * BW;
    for (int u = (c.bid - boff + c.G) % c.G; u < (PB + SB) * 16; u += c.G) {
        const int sq = u >> 4, h = u & 15;
        int row0, L; seq_info(sq, row0, L);
        float S[8];
        if (sq >= PB) { const float* p = s0 + (((size_t)(sq - PB) * 16 + h) * 64 + vrow) * 64 + cg * 8;
#pragma unroll
            for (int j = 0; j < 8; ++j) S[j] = p[j]; }
        else {
#pragma unroll
            for (int j = 0; j < 8; ++j) S[j] = 0.f; }
        const float lg = lng[h * 64 + lane], lb = lnb[h * 64 + lane];
        const int nb = (L + 15) >> 4;
#define RW_STAGE(bi_) do { const int t0_ = (bi_) * 16, nT_ = (L - t0_) < 16 ? (L - t0_) : 16; LAS float* dst_ = opb + ((bi_) & 1) * 16 * 384; \
        for (int idx = tid; idx < nT_ * 96; idx += 512) { const int t = idx / 96, rem = idx - t * 96, slot = rem >> 4, c4 = rem & 15; \
            const int arr = slot == 0 ? 1 : slot == 1 ? 4 : slot == 2 ? 5 : slot == 3 ? 2 : slot == 4 ? 0 : 3; \
            *(LAS f32x4*)(dst_ + t * 384 + slot * 64 + c4 * 4) = *(const f32x4*)(RW + (size_t)arr * MPAD * BW + (size_t)(row0 + t0_ + t) * BW + h * 64 + c4 * 4); } } while (0)
        RW_STAGE(0);
        for (int bi = 0; bi < nb; ++bi) {
            __syncthreads();
            if (bi + 1 < nb) RW_STAGE(bi + 1);
            const int t0 = bi * 16, nT = (L - t0) < 16 ? (L - t0) : 16; const LAS float* src = opb + (bi & 1) * 16 * 384;
            for (int tt = 0; tt < nT; ++tt) {
                const LAS float* b = src + tt * 384 + cg * 8;
                const f32x4 w0 = *(const LAS f32x4*)(b), w1 = *(const LAS f32x4*)(b + 4), k0 = *(const LAS f32x4*)(b + 64), k1 = *(const LAS f32x4*)(b + 68);
                const f32x4 b0 = *(const LAS f32x4*)(b + 128), b1 = *(const LAS f32x4*)(b + 132), q0 = *(const LAS f32x4*)(b + 192), q1 = *(const LAS f32x4*)(b + 196);
                const f32x4 r0 = *(const LAS f32x4*)(b + 256), r1 = *(const LAS f32x4*)(b + 260); const float v = src[tt * 384 + 320 + vrow];
                float d = (S[0] * k0[0] + S[1] * k0[1]) + (S[2] * k0[2] + S[3] * k0[3]) + (S[4] * k1[0] + S[5] * k1[1]) + (S[6] * k1[2] + S[7] * k1[3]);
                d += __shfl_xor(d, 1, 64); d += __shfl_xor(d, 2, 64); d += __shfl_xor(d, 4, 64);
                float y = 0.f;
#pragma unroll
                for (int j = 0; j < 4; ++j) { S[j] = S[j] * w0[j] - d * b0[j] + v * q0[j]; y += S[j] * r0[j]; S[4 + j] = S[4 + j] * w1[j] - d * b1[j] + v * q1[j]; y += S[4 + j] * r1[j]; }
                y += __shfl_xor(y, 1, 64); y += __shfl_xor(y, 2, 64); y += __shfl_xor(y, 4, 64);
                if (cg == 0) yb[tt * 64 + vrow] = y;
            }
            __syncthreads();
            for (int tt = w; tt < nT; tt += 8) {
                const float y = yb[tt * 64 + lane]; const float mean = wave_sum(y) * (1.0f / 64.0f), dy = y - mean, var = wave_sum(dy * dy) * (1.0f / 64.0f);
                const float yn = dy * rsqrtf(var + 64e-5f) * lg + lb; const size_t o = (size_t)(row0 + t0 + tt) * BW + h * 64 + lane;
                OB[o] = f2bf((yn + BON[o]) * G[o]);
            }
        }
#undef RW_STAGE
        float* op = (sq < PB ? outP + (((size_t)sq * 16 + h) * 64 + vrow) * 64 : outS + (((size_t)(sq - PB) * 16 + h) * 64 + vrow) * 64) + cg * 8;
#pragma unroll
        for (int j = 0; j < 8; ++j) op[j] = S[j];
        __syncthreads();
    }
}
constexpr int RS_SLOTS = 8, RS_SLOT_B = RB_EL * 2;
__device__ __forceinline__ void ph_rwkv_seq(const Ctx& c, int boff, const bf16_t* __restrict__ RB, const float* __restrict__ s0, float* __restrict__ outP, float* __restrict__ outS, bf16_t* __restrict__ OB) {
    const int lane = c.lane, r = lane & 15, q = lane >> 4, w = c.wave;
    LAS unsigned char* ring = c.lds;
    const int side = c.bid < 32 ? c.bid : c.bid - 64, nside = c.G - 64;
    for (int u = (c.bid >= boff && c.bid < boff + 32) ? c.bid - boff : ((c.bid < 32 || c.bid >= 96) ? 32 + side : (PB + SB) * 16); u < (PB + SB) * 16; u = u < 32 ? (PB + SB) * 16 : u + nside) {
        const int sq = u >> 4, h = u & 15;
        int nch, ch0, row0, ntok; const float* sp = nullptr; float* op;
        if (sq < PB) { nch = 256; ch0 = (sq * 16 + h) * 256; row0 = sq * PS; ntok = 16; op = outP + (size_t)(sq * 16 + h) * 4096; }
        else { nch = 1; ch0 = PB * 16 * 256 + (sq - PB) * 16 + h; row0 = MP + (sq - PB) * SS; ntok = SS; sp = s0 + (size_t)((sq - PB) * 16 + h) * 4096; op = outS + (size_t)((sq - PB) * 16 + h) * 4096; }
        if (w >= 4) {
            const int lw = w - 4, p0 = lw < 2 ? lw * 5 : 10 + (lw - 2) * 4, np = lw < 2 ? 5 : 4;
#define RS_ISSUE(ci_) do { const int cc_ = (ci_) < nch ? (ci_) : nch - 1; const char* g_ = (const char*)(RB + (size_t)(ch0 + cc_) * RB_EL) + p0 * 1024 + lane * 16; \
            LAS unsigned char* d_ = ring + ((ci_) % RS_SLOTS) * RS_SLOT_B + p0 * 1024; \
            _Pragma("unroll") for (int p_ = 0; p_ < 5; ++p_) if (p_ < np) __builtin_amdgcn_global_load_lds((const unsigned*)(g_ + p_ * 1024), (LAS unsigned*)(d_ + p_ * 1024), 16, 0, 0); } while (0)
            for (int ci = 0; ci < RS_SLOTS - 1; ++ci) RS_ISSUE(ci);
            if (lw < 2) asm volatile("s_waitcnt vmcnt(30)" ::: "memory"); else asm volatile("s_waitcnt vmcnt(24)" ::: "memory");
            __builtin_amdgcn_s_barrier();
            for (int ci = 0; ci < nch; ++ci) {
                RS_ISSUE(ci + RS_SLOTS - 1);
                if (lw < 2) asm volatile("s_waitcnt vmcnt(30)" ::: "memory"); else asm volatile("s_waitcnt vmcnt(24)" ::: "memory");
                __builtin_amdgcn_s_barrier();
            }
#undef RS_ISSUE
            asm volatile("s_waitcnt vmcnt(0)" ::: "memory");
        } else {
            const int vb = w; f32x4 acc[4];
#pragma unroll
            for (int kb = 0; kb < 4; ++kb) acc[kb] = sp ? *(const f32x4*)(sp + (size_t)(vb * 16 + r) * 64 + kb * 16 + q * 4) : (f32x4){0.f, 0.f, 0.f, 0.f};
            const bf16x8 zfrag = (bf16x8){0, 0, 0, 0, 0, 0, 0, 0};
            __builtin_amdgcn_s_barrier();
            for (int ci = 0; ci < nch; ++ci) {
                const LAS bf16_t* blob = (const LAS bf16_t*)(ring + (ci % RS_SLOTS) * RS_SLOT_B);
                bf16x8 mf[4][2], khf[4], qpf[2];
#pragma unroll
                for (int kb = 0; kb < 4; ++kb) { mf[kb][0] = *(const LAS bf16x8*)(blob + (kb * 16 + r) * 72 + q * 8); mf[kb][1] = *(const LAS bf16x8*)(blob + (kb * 16 + r) * 72 + 32 + q * 8);
                    khf[kb] = q < 2 ? *(const LAS bf16x8*)(blob + RB_KHP + (kb * 16 + r) * 24 + q * 8) : zfrag; }
                qpf[0] = *(const LAS bf16x8*)(blob + RB_QP + r * 72 + q * 8); qpf[1] = *(const LAS bf16x8*)(blob + RB_QP + r * 72 + 32 + q * 8);
                const bf16x8 vt = q < 2 ? *(const LAS bf16x8*)(blob + RB_VT + (vb * 16 + r) * 24 + q * 8) : zfrag;
                const bf16x8 ep = q < 2 ? *(const LAS bf16x8*)(blob + RB_EP + r * 24 + q * 8) : zfrag;
                const bf16x8 t0 = pack_acc(acc[0], acc[1]), t1 = pack_acc(acc[2], acc[3]);
                __builtin_amdgcn_sched_barrier(0);
#pragma unroll
                for (int kb = 0; kb < 4; ++kb) acc[kb] = mma16(mf[kb][0], t0, (f32x4){0.f, 0.f, 0.f, 0.f});
#pragma unroll
                for (int kb = 0; kb < 4; ++kb) acc[kb] = mma16(mf[kb][1], t1, acc[kb]);
#pragma unroll
                for (int kb = 0; kb < 4; ++kb) acc[kb] = mma16(khf[kb], vt, acc[kb]);
                f32x4 y = mma16(t0, qpf[0], (f32x4){0.f, 0.f, 0.f, 0.f}); y = mma16(t1, qpf[1], y); y = mma16(vt, ep, y);
                if (r < ntok) { u32x2 o; o.x = pk2(y[0], y[1]); o.y = pk2(y[2], y[3]); *(u32x2*)(OB + (size_t)(row0 + ci * 16 + r) * BW + h * 64 + vb * 16 + q * 4) = o; }
                asm volatile("s_waitcnt lgkmcnt(0)" ::: "memory");
                __builtin_amdgcn_s_barrier();
            }
#pragma unroll
            for (int kb = 0; kb < 4; ++kb) *(f32x4*)(op + (size_t)(vb * 16 + r) * 64 + kb * 16 + q * 4) = acc[kb];
        }
        __syncthreads();
    }
}
__device__ __forceinline__ void ph_rwkv_fin(const Ctx& c, const float* __restrict__ RW, const float* __restrict__ lng, const float* __restrict__ lnb, const bf16_t* __restrict__ RAW, bf16_t* __restrict__ OB) {
    const int lane = c.lane; const bf16_t* G = (const bf16_t*)(RW + 6 * (size_t)MPAD * BW); const bf16_t* BON = (const bf16_t*)(RW + 7 * (size_t)MPAD * BW);
    for (int i = c.bid * 8 + c.wave; i < MT * 2; i += c.G * 8) {
        const int row = i >> 1, cc = (i & 1) * 512 + lane * 8; const size_t o = (size_t)row * BW + cc;
        float x[8], bo[8], gt[8]; unpack8(*(const u32x4*)(RAW + o), x); unpack8(*(const u32x4*)(BON + o), bo); unpack8(*(const u32x4*)(G + o), gt);
        float s = 0.f;
#pragma unroll
        for (int j = 0; j < 8; ++j) s += x[j];
        s += __shfl_xor(s, 1, 64); s += __shfl_xor(s, 2, 64); s += __shfl_xor(s, 4, 64);
        const float mean = s * (1.0f / 64.0f); float qq = 0.f;
#pragma unroll
        for (int j = 0; j < 8; ++j) { const float d = x[j] - mean; qq += d * d; }
        qq += __shfl_xor(qq, 1, 64); qq += __shfl_xor(qq, 2, 64); qq += __shfl_xor(qq, 4, 64);
        const float rstd = rsqrtf(qq * (1.0f / 64.0f) + 64e-5f);
        const f32x4 g0 = *(const f32x4*)(lng + cc), g1 = *(const f32x4*)(lng + cc + 4), b0 = *(const f32x4*)(lnb + cc), b1 = *(const f32x4*)(lnb + cc + 4); float ov[8];
#pragma unroll
        for (int j = 0; j < 8; ++j) ov[j] = ((x[j] - mean) * rstd * (j < 4 ? g0[j] : g1[j - 4]) + (j < 4 ? b0[j] : b1[j - 4]) + bo[j]) * gt[j];
        *(u32x4*)(OB + o) = (u32x4){pk2(ov[0], ov[1]), pk2(ov[2], ov[3]), pk2(ov[4], ov[5]), pk2(ov[6], ov[7])};
    }
}

__device__ __forceinline__ void ph_memattn_sample(const Ctx& c, int boff, const bf16_t* __restrict__ U, const float* __restrict__ mk, const float* __restrict__ mv, bf16_t* __restrict__ OB) {
    LAS float* ps = (LAS float*)c.lds;
    const int hh = c.tid >> 8, vt = c.tid & 255, lane = c.lane, r = lane & 15, q = lane >> 4, w4 = c.wave & 3;
    for (int u = (c.bid - boff + c.G) % c.G; u < SB * 2; u += c.G) {
        const int sq = u >> 1, h = (u & 1) * 2 + hh;
        bf16x8 qf[8];
#pragma unroll
        for (int ks = 0; ks < 8; ++ks) { u32x4 raw = (u32x4){0u, 0u, 0u, 0u};
            if (r < 4) raw = *(const u32x4*)(U + (size_t)(MP + sq * SS + r) * NINP + U_MQ + h * 256 + ks * 32 + q * 8);
            qf[ks] = __builtin_bit_cast(bf16x8, raw); }
#pragma unroll 1
        for (int mt = 0; mt < 4; ++mt) { const float* kr = mk + (((size_t)sq * MEMT + (w4 * 4 + mt) * 16 + r) * 4 + h) * 256 + q * 8; f32x4 ka[8], kb2[8];
#pragma unroll
            for (int ks = 0; ks < 8; ++ks) { ka[ks] = *(const f32x4*)(kr + ks * 32); kb2[ks] = *(const f32x4*)(kr + ks * 32 + 4); }
            __builtin_amdgcn_sched_barrier(0);
            f32x4 d = (f32x4){0.f, 0.f, 0.f, 0.f};
#pragma unroll
            for (int ks = 0; ks < 8; ++ks) { u32x4 p; p.x = pk2(ka[ks][0], ka[ks][1]); p.y = pk2(ka[ks][2], ka[ks][3]); p.z = pk2(kb2[ks][0], kb2[ks][1]); p.w = pk2(kb2[ks][2], kb2[ks][3]);
                d = mma16(__builtin_bit_cast(bf16x8, p), qf[ks], d); }
            if (r < 4) *(LAS f32x4*)(ps + (hh * 4 + r) * 256 + (w4 * 4 + mt) * 16 + q * 4) = d * 0.0625f; }
        __syncthreads();
        { LAS float* pr = ps + c.wave * 256; float x[4]; float mx = -3.0e38f;
#pragma unroll
            for (int j = 0; j < 4; ++j) { x[j] = pr[lane + 64 * j]; mx = fmaxf(mx, x[j]); }
            mx = wave_max(mx); float s = 0.f;
#pragma unroll
            for (int j = 0; j < 4; ++j) { x[j] = __expf(x[j] - mx); s += x[j]; }
            const float inv = 1.0f / wave_sum(s);
#pragma unroll
            for (int j = 0; j < 4; ++j) pr[lane + 64 * j] = x[j] * inv; }
        __syncthreads();
        { float o[4] = {0.f, 0.f, 0.f, 0.f}; const float* vr = mv + ((size_t)sq * MEMT * 4 + h) * 256 + vt;
#pragma unroll 8
            for (int m = 0; m < MEMT; ++m) { const float vv = vr[(size_t)m * 1024];
#pragma unroll
                for (int t = 0; t < 4; ++t) o[t] += ps[(hh * 4 + t) * 256 + m] * vv; }
#pragma unroll
            for (int t = 0; t < 4; ++t) OB[(size_t)(MP + sq * SS + t) * BW + h * 256 + vt] = f2bf(o[t]); }
        __syncthreads();
    }
}

template <int K, int LDA, int LDB> __device__ __forceinline__ void skinny_pair(const Ctx& c, const bf16_t* __restrict__ A, const bf16_t* __restrict__ B0, const bf16_t* __restrict__ B1, f32x4 (&out)[2], int rot) {
    LAS f32x4* red = (LAS f32x4*)c.lds;
    const int lane = c.lane, r = lane & 15, q = lane >> 4, w = c.wave;
    constexpr int KS = K / 8;
    const bf16_t* ap = A + (size_t)r * LDA + w * KS + q * 8; const bf16_t* b0 = B0 + (size_t)r * LDB + w * KS + q * 8; const bf16_t* b1 = B1 + (size_t)r * LDB + w * KS + q * 8;
    f32x4 acc[2][8];
#pragma unroll
    for (int n = 0; n < 2; ++n)
#pragma unroll
        for (int m = 0; m < 8; ++m) acc[n][m] = (f32x4){0.f, 0.f, 0.f, 0.f};
    int kk = (int)((unsigned)rot % (unsigned)(KS / 32));
#pragma unroll 2
    for (int it = 0; it < KS / 32; ++it) { const int ks = kk; kk = kk + 1 == KS / 32 ? 0 : kk + 1;
        const bf16x8 f0 = *(const bf16x8*)(b0 + ks * 32), f1 = *(const bf16x8*)(b1 + ks * 32); bf16x8 af[8];
#pragma unroll
        for (int m = 0; m < 8; ++m) af[m] = *(const bf16x8*)(ap + (size_t)(m * 16) * LDA + ks * 32);
        __builtin_amdgcn_sched_barrier(0);
#pragma unroll
        for (int m = 0; m < 8; ++m) { acc[0][m] = mma16(f0, af[m], acc[0][m]); acc[1][m] = mma16(f1, af[m], acc[1][m]); } }
    __syncthreads();
#pragma unroll
    for (int n = 0; n < 2; ++n)
#pragma unroll
        for (int m = 0; m < 8; ++m) red[(w * 16 + n * 8 + m) * 64 + lane] = acc[n][m];
    __syncthreads();
#pragma unroll
    for (int n = 0; n < 2; ++n) { f32x4 s = red[(n * 8 + w) * 64 + lane];
#pragma unroll
        for (int ww = 1; ww < 8; ++ww) s += red[(ww * 16 + n * 8 + w) * 64 + lane];
        out[n] = s; }
}
template <int K, int LDA, int LDB> __device__ __forceinline__ f32x4 skinny_one(const Ctx& c, const bf16_t* __restrict__ A, const bf16_t* __restrict__ B0, int rot) {
    LAS f32x4* red = (LAS f32x4*)c.lds;
    const int lane = c.lane, r = lane & 15, q = lane >> 4, w = c.wave;
    constexpr int KS = K / 8, NK = KS / 32;
    const bf16_t* ap = A + (size_t)r * LDA + w * KS + q * 8; const bf16_t* b0 = B0 + (size_t)r * LDB + w * KS + q * 8;
    f32x4 acc[8];
#pragma unroll
    for (int m = 0; m < 8; ++m) acc[m] = (f32x4){0.f, 0.f, 0.f, 0.f};
    int kk = (int)((unsigned)rot % (unsigned)NK);
#pragma unroll 4
    for (int it = 0; it < NK; ++it) { const int ks = kk; kk = kk + 1 == NK ? 0 : kk + 1;
        const bf16x8 f0 = *(const bf16x8*)(b0 + ks * 32); bf16x8 af[8];
#pragma unroll
        for (int m = 0; m < 8; ++m) af[m] = *(const bf16x8*)(ap + (size_t)(m * 16) * LDA + ks * 32);
        __builtin_amdgcn_sched_barrier(0);
#pragma unroll
        for (int m = 0; m < 8; ++m) acc[m] = mma16(f0, af[m], acc[m]); }
    __syncthreads();
#pragma unroll
    for (int m = 0; m < 8; ++m) red[(w * 8 + m) * 64 + lane] = acc[m];
    __syncthreads();
    f32x4 s = red[w * 64 + lane];
#pragma unroll
    for (int ww = 1; ww < 8; ++ww) s += red[(ww * 8 + w) * 64 + lane];
    return s;
}
template <int K, int LDA, int LDB> __device__ __forceinline__ f32x4 skinny_half(const Ctx& c, const bf16_t* __restrict__ A, const bf16_t* __restrict__ B0) {
    LAS f32x4* red = (LAS f32x4*)c.lds;
    const int lane = c.lane, r = lane & 15, q = lane >> 4, w = c.wave;
    constexpr int KS = K / 8, NK = KS / 32;
    const bf16_t* ap = A + (size_t)r * LDA + w * KS + q * 8; const bf16_t* b0 = B0 + (size_t)r * LDB + w * KS + q * 8;
    f32x4 acc[4];
#pragma unroll
    for (int m = 0; m < 4; ++m) acc[m] = (f32x4){0.f, 0.f, 0.f, 0.f};
#pragma unroll 4
    for (int ks = 0; ks < NK; ++ks) {
        const bf16x8 f0 = *(const bf16x8*)(b0 + ks * 32); bf16x8 af[4];
#pragma unroll
        for (int m = 0; m < 4; ++m) af[m] = *(const bf16x8*)(ap + (size_t)(m * 16) * LDA + ks * 32);
        __builtin_amdgcn_sched_barrier(0);
#pragma unroll
        for (int m = 0; m < 4; ++m) acc[m] = mma16(f0, af[m], acc[m]); }
    __syncthreads();
#pragma unroll
    for (int m = 0; m < 4; ++m) red[(w * 4 + m) * 64 + lane] = acc[m];
    __syncthreads();
    f32x4 s = (f32x4){0.f, 0.f, 0.f, 0.f};
    if (w < 4) { s = red[w * 64 + lane];
#pragma unroll
        for (int ww = 1; ww < 8; ++ww) s += red[(ww * 4 + w) * 64 + lane]; }
    return s;
}
__device__ __forceinline__ u32x2 pk4(const f32x4 v) { u32x2 o; o.x = pk2(v[0], v[1]); o.y = pk2(v[2], v[3]); return o; }
#define SKINNY_LOOP(total_) for (int s = c.bid - base; s >= 0 && s < (total_); s += ncu)
__device__ __forceinline__ void ph_sk_in(const Ctx& c, int base, int ncu, const bf16_t* __restrict__ HB, const bf16_t* __restrict__ W, bf16_t* __restrict__ U) {
    const int r = c.lane & 15, q = c.lane >> 4, w = c.wave;
    SKINNY_LOOP(NINP / 32) { f32x4 o[2]; skinny_pair<DM, DM, DM>(c, HB + (size_t)MP * DM, W + (size_t)(s * 32) * DM, W + (size_t)(s * 32 + 16) * DM, o, s);
        bf16_t* up = U + (size_t)(MP + w * 16 + r) * NINP + s * 32 + q * 4; *(u32x2*)up = pk4(o[0]); *(u32x2*)(up + 16) = pk4(o[1]); }
}
__device__ __forceinline__ void ph_sk_merge(const Ctx& c, int base, int ncu, const bf16_t* __restrict__ BR, const bf16_t* __restrict__ W, const bf16_t* __restrict__ U, const float* __restrict__ gate_b, bf16_t* __restrict__ MGB) {
    const int r = c.lane & 15, q = c.lane >> 4, w = c.wave;
    SKINNY_LOOP(DM / 8) { const int ct = s >> 1, hf = s & 1; const size_t row = (size_t)(MP + hf * 64 + (w & 3) * 16 + r); const int col = ct * 16 + q * 4; f32x4 tot = (f32x4){0.f, 0.f, 0.f, 0.f};
#pragma unroll 1
        for (int z = 0; z < 4; ++z) { const f32x4 o = skinny_half<BW, BW, BW>(c, BR + ((size_t)z * MPAD + MP + hf * 64) * BW, W + ((size_t)z * DM + ct * 16) * BW);
            if (w < 4) { const u32x2 gp = *(const u32x2*)(U + row * NINP + U_GP + z * DM + col); const f32x4 gb = *(const f32x4*)(gate_b + z * DM + col);
            tot[0] += sigmoidf_(__uint_as_float(gp.x << 16) + gb[0]) * o[0]; tot[1] += sigmoidf_(__uint_as_float(gp.x & 0xffff0000u) + gb[1]) * o[1];
            tot[2] += sigmoidf_(__uint_as_float(gp.y << 16) + gb[2]) * o[2]; tot[3] += sigmoidf_(__uint_as_float(gp.y & 0xffff0000u) + gb[3]) * o[3]; } }
        if (w < 4) *(u32x2*)(MGB + row * DM + col) = pk4(tot); }
}
template <int K> __device__ __forceinline__ void ph_sk_res(const Ctx& c, int base, int ncu, const bf16_t* __restrict__ A, const bf16_t* __restrict__ W, const bf16_t* __restrict__ R, bf16_t* __restrict__ Y) {
    const int r = c.lane & 15, q = c.lane >> 4, w = c.wave;
    SKINNY_LOOP(DM / 8) { const int ct = s >> 1, hf = s & 1; const f32x4 o = skinny_half<K, K, K>(c, A + (size_t)(MP + hf * 64) * K, W + (size_t)(ct * 16) * K);
        if (w < 4) { const size_t off = (size_t)(MP + hf * 64 + w * 16 + r) * DM + ct * 16 + q * 4; const u32x2 rr = *(const u32x2*)(R + off);
        const f32x4 rv = (f32x4){__uint_as_float(rr.x << 16), __uint_as_float(rr.x & 0xffff0000u), __uint_as_float(rr.y << 16), __uint_as_float(rr.y & 0xffff0000u)};
        *(u32x2*)(Y + off) = pk4(rv * ALPHA + o); } }
}
__device__ __forceinline__ void ph_sk_gu(const Ctx& c, int base, int ncu, const bf16_t* __restrict__ X1B, const bf16_t* __restrict__ W, bf16_t* __restrict__ ACT) {
    const int r = c.lane & 15, q = c.lane >> 4, w = c.wave;
    SKINNY_LOOP(DFF / 16) { const int t = s >> 3, j0 = (s & 7) * 16; f32x4 o[2];
        skinny_pair<DM, DM, DM>(c, X1B + (size_t)MP * DM, W + (size_t)(t * 256 + j0) * DM, W + (size_t)(t * 256 + 128 + j0) * DM, o, s);
        f32x4 v;
#pragma unroll
        for (int j = 0; j < 4; ++j) v[j] = o[0][j] * sigmoidf_(o[0][j]) * o[1][j];
        *(u32x2*)(ACT + (size_t)(MP + w * 16 + r) * DFF + t * 128 + j0 + q * 4) = pk4(v); }
}
#undef SKINNY_LOOP

constexpr int LDS_BAR_OFF = 147456;
constexpr int LDS_BYTES = LDS_BAR_OFF + 64;
struct Args { const float* in[37]; float* out; unsigned char* ws; };

typedef pg8::Gemm<DM, DM, DM, 2, 8, NL, 1, false, 0, 0, (long)DM * DM, 0> GemmMem;
typedef pg8::Gemm<DM, DM, DM, MP / 256, NINP / 256> GemmIn;
typedef pg8::Gemm<NINP, 1024, 256, PS / 256, 1, 8, 4, false, (long)PS * NINP, 256, 256 * 1024, 256> GemmScore;
typedef pg8::Gemm<256, 256, 256, PS / 256, 1, 8, 4, false, (long)4 * 4096 * 256, (long)4096 * 256, 4 * 65536, 65536> GemmPV;
typedef pg8::Gemm<BW, BW, BW, MP / 256, DM / 256, 4, 1, true, (long)MPAD * BW, 0, (long)DM * BW, 0> GemmBranch;
typedef pg8::Gemm<DM, DM, DM, MP / 256, DM / 256> GemmOut;
typedef pg8::Gemm<DM, DM, DM, MP / 256, 2 * DFF / 256> GemmGU;
typedef pg8::Gemm<DFF, DFF, DFF, MP / 256, DM / 256> GemmDown;
template <class GT> __device__ __forceinline__ GT mk_gemm(const Ctx& c, const bf16_t* A, const bf16_t* B) { GT g; g.A = A; g.B = B; g.G = c.G; g.c = c.bid; return g; }

template <int OFF> __device__ __forceinline__ unsigned long long karg_u64(unsigned long long kargs) {
    unsigned long long p; asm volatile("s_load_dwordx2 %0, %1, %2\n\ts_waitcnt lgkmcnt(0)" : "=s"(p) : "s"(kargs), "n"(OFF) : "memory"); return p;
}
#define GPTR(T, x) ((T*)(__attribute__((address_space(1))) T*)(x))
#define INP(k) GPTR(const float, karg_u64<(k) * 8>(kargs))
#define OUTP() GPTR(float, karg_u64<37 * 8>(kargs))
#define WSP() GPTR(unsigned char, karg_u64<38 * 8>(kargs))

__global__ void __launch_bounds__(512, 2) mega_fwd(Args a_unused) {
    extern __shared__ __attribute__((aligned(16))) unsigned char lds_raw[];
    const unsigned long long kargs = (unsigned long long)__builtin_amdgcn_kernarg_segment_ptr();
    Ctx c0; c0.tid = threadIdx.x; c0.lane = c0.tid & 63; c0.wave = __builtin_amdgcn_readfirstlane(c0.tid >> 6); c0.bid = blockIdx.x; c0.G = gridDim.x; c0.lds = (LAS unsigned char*)lds_raw;
    if (c0.tid < 4) ((LAS unsigned*)(c0.lds + LDS_BAR_OFF))[c0.tid] = 0u;
    __syncthreads();
    const XcdBarrier bar = xcd_barrier_post((unsigned*)(WSP() + WS_CTL), (volatile LAS unsigned*)(c0.lds + LDS_BAR_OFF));

#define WPREP_WIN(cc_, L_) do { unsigned char* ws_ = WSP(); \
      ph_wprep(cc_, INP(10) + (size_t)(L_) * DM * NIN, (bf16_t*)(ws_ + WS_WIN) + (size_t)(L_) * NINP * DM, DM, NIN, NINP, 1, 1, 0, 0); } while (0)
#define WPREP_LAYER(cc_, L_) do { WPREP_WIN(cc_, L_); WPREP_REST(cc_, L_); } while (0)
#define WPREP_REST(cc_, L_) do { unsigned char* ws_ = WSP(); \
      ph_wprep(cc_, INP(29) + (size_t)(L_) * 4 * BW * DM, (bf16_t*)(ws_ + WS_WBR) + (size_t)(L_) * 4 * DM * BW, BW, DM, DM, 0, 4, (size_t)BW * DM, (size_t)DM * BW); \
      ph_wprep(cc_, INP(30) + (size_t)(L_) * DM * DM, (bf16_t*)(ws_ + WS_WOUT) + (size_t)(L_) * DM * DM, DM, DM, DM, 0, 1, 0, 0); \
      ph_wprep(cc_, INP(33) + (size_t)(L_) * DM * 2 * DFF, (bf16_t*)(ws_ + WS_WGU) + (size_t)(L_) * 2 * DFF * DM, DM, 2 * DFF, 2 * DFF, 2, 1, 0, 0); \
      ph_wprep(cc_, INP(34) + (size_t)(L_) * DFF * DM, (bf16_t*)(ws_ + WS_WDN) + (size_t)(L_) * DM * DFF, DFF, DM, DM, 0, 1, 0, 0); } while (0)
    { const Ctx c = fresh(c0); unsigned char* ws = WSP();
      ph_wprep(c, INP(28), (bf16_t*)(ws + WS_WMEM), DM, DM, DM, 0, NL, (size_t)DM * DM, (size_t)DM * DM);
      WPREP_WIN(c, 0);
      ph_lrw(c, INP(19), INP(21), INP(22), (bf16_t*)(ws + WS_LRW));
      ph_xprep(c, INP(0), INP(1), INP(2), (float*)nullptr, (bf16_t*)(ws + WS_HB), (bf16_t*)(ws + WS_MEMB)); }
    xcd_barrier(bar);
    if (c0.bid >= 64) { Ctx c = fresh(c0); c.bid -= 64; c.G -= 64; WPREP_REST(c, 0); }
    { const Ctx c = fresh(c0); unsigned char* ws = WSP(); float* out = OUTP();
      GemmMem g = mk_gemm<GemmMem>(c, (const bf16_t*)(ws + WS_MEMB), (const bf16_t*)(ws + WS_WMEM));
      pg8::EpiMem E; E.outK = out + O_MKP; E.outV = out + O_MVP; E.kb = (bf16_t*)(ws + WS_MKB); E.vt = (bf16_t*)(ws + WS_MVT); pg8::gemm_phase<GemmMem, pg8::EpiMem, true, true>(c.lds, c.tid, g, E); }

    for (int l = 0; l < NL; ++l) {
        { const Ctx c = fresh(c0); unsigned char* ws = WSP();
          GemmIn g = mk_gemm<GemmIn>(c, (const bf16_t*)(ws + WS_HB), (const bf16_t*)(ws + WS_WIN) + (size_t)l * NINP * DM);
          pg8::EpiBf16 E; E.O = (bf16_t*)(ws + WS_U); E.zs = 0; E.ldc = NINP; E.pad = 0; pg8::gemm_phase<GemmIn, pg8::EpiBf16, true, true>(c.lds, c.tid, g, E); }
        { const Ctx c = fresh(c0); unsigned char* ws = WSP(); ph_sk_in(c, c.G > 192 ? 96 : 0, c.G > 192 ? c.G - 96 : c.G, (const bf16_t*)(ws + WS_HB), (const bf16_t*)(ws + WS_WIN) + (size_t)l * NINP * DM, (bf16_t*)(ws + WS_U)); }
        xcd_barrier(bar);
        { const Ctx c = fresh(c0); unsigned char* ws = WSP(); float* out = OUTP(); const bf16_t* U = (const bf16_t*)(ws + WS_U); bf16_t* BR = (bf16_t*)(ws + WS_BR);
          (void)out; (void)BR;
          ph_gla_pre(c, U, INP(12) + (size_t)l * 16 * 512, INP(13) + (size_t)l * 512, (bf16_t*)(ws + WS_GLQD), (bf16_t*)(ws + WS_GLKH), (bf16_t*)(ws + WS_GLE), (bf16_t*)(ws + WS_GLVT), (float*)(ws + WS_GLGC)); }
        { const Ctx c = fresh(c0); unsigned char* ws = WSP();
          ph_rwkv_pre(c, (const bf16_t*)(ws + WS_U), INP(9) + (size_t)l * SB * RWC, INP(17) + (size_t)l * RWC, INP(18) + (size_t)l * BW, INP(19) + (size_t)l * 64 * BW, INP(20) + (size_t)l * BW, INP(21) + (size_t)l * 64 * BW,
                       INP(22) + (size_t)l * 128 * BW, INP(23) + (size_t)l * BW, INP(24) + (size_t)l * BW, INP(25) + (size_t)l * BW, (float*)(ws + WS_RW), (bf16_t*)(ws + WS_RB), (const bf16_t*)(ws + WS_LRW) + (size_t)l * 1024 * 256); }
        { const Ctx c = fresh(c0); unsigned char* ws = WSP(); ph_memattn_prompt(c, (const bf16_t*)(ws + WS_U), (const bf16_t*)(ws + WS_MKB) + (size_t)l * 512 * 1024, (const bf16_t*)(ws + WS_MVT) + (size_t)l * 8 * 65536, (bf16_t*)(ws + WS_BR) + (size_t)3 * MPAD * BW); }
        xcd_barrier(bar);
        { const Ctx c = fresh(c0); unsigned char* ws = WSP(); float* out = OUTP();
          ph_rwkv_seq(c, 64, (const bf16_t*)(ws + WS_RB), INP(8) + (size_t)l * SB * 16 * 4096, out + O_RWP + (size_t)l * PB * 16 * 4096, out + O_RWS + (size_t)l * SB * 16 * 4096,
                      (bf16_t*)(ws + WS_RAW) + (size_t)MPAD * BW); }
        { const Ctx c = fresh(c0); unsigned char* ws = WSP(); float* out = OUTP();
          ph_gla_seq(c, 32, (const bf16_t*)(ws + WS_GLQD), (const bf16_t*)(ws + WS_GLKH), (const bf16_t*)(ws + WS_GLE), (const bf16_t*)(ws + WS_GLVT), (const float*)(ws + WS_GLGC),
                     INP(7) + (size_t)l * SB * 4 * 32768, out + O_GLAP + (size_t)l * PB * 4 * 32768, out + O_GLAS + (size_t)l * SB * 4 * 32768, (bf16_t*)(ws + WS_RAW)); }
        if ((c0.bid < 32 || c0.bid >= 96) && c0.G > 96) {
        { Ctx c = fresh(c0); c.bid = c.bid < 32 ? c.bid : c.bid - 64; c.G = c.G - 64; unsigned char* ws = WSP(); ph_swa_prompt(c, (const bf16_t*)(ws + WS_U), INP(16) + (size_t)l * 16, (bf16_t*)(ws + WS_BR) + (size_t)MPAD * BW); }
        { Ctx c = fresh(c0); c.bid = c.bid < 32 ? c.bid : c.bid - 64; c.G = c.G - 64; unsigned char* ws = WSP();
          ph_swa_sample(c, (const bf16_t*)(ws + WS_U), INP(3) + (size_t)l * SB * 16384, INP(4) + (size_t)l * SB * 16384, INP(16) + (size_t)l * 16, (bf16_t*)(ws + WS_BR) + (size_t)MPAD * BW); }
        { Ctx c = fresh(c0); c.bid = c.bid < 32 ? c.bid : c.bid - 64; c.G = c.G - 64; unsigned char* ws = WSP();
          ph_memattn_sample(c, 64, (const bf16_t*)(ws + WS_U), INP(5) + (size_t)l * SB * MEMT * 1024, INP(6) + (size_t)l * SB * MEMT * 1024, (bf16_t*)(ws + WS_BR) + (size_t)3 * MPAD * BW); }
        { Ctx c = fresh(c0); c.bid = c.bid < 32 ? c.bid : c.bid - 64; c.G = c.G - 64; unsigned char* ws = WSP();
          ph_copy_outs(c, (const bf16_t*)(ws + WS_U), INP(3) + (size_t)l * SB * 16384, INP(4) + (size_t)l * SB * 16384, OUTP(), l); }
          if (l + 1 < NL) { Ctx c = fresh(c0); const int sd = c.bid < 32 ? c.bid : c.bid - 64; c.G = 2 * (c.G - 64) + 96;
            c.bid = 2 * sd; WPREP_LAYER(c, l + 1); c.bid = 2 * sd + 1; WPREP_LAYER(c, l + 1); }
        } else if (l + 1 < NL && c0.G > 96) { Ctx c = fresh(c0); const int nside2 = 2 * (c.G - 64); c.G = nside2 + 96;
          if (c0.bid < 64) { c.bid = nside2 + 2 * (c0.bid - 32); WPREP_LAYER(c, l + 1); c.bid = nside2 + 2 * (c0.bid - 32) + 1; WPREP_LAYER(c, l + 1); }
          else { c.bid = nside2 + 64 + (c0.bid - 64); WPREP_LAYER(c, l + 1); }
        }
        xcd_barrier(bar);
        { const Ctx c = fresh(c0); unsigned char* ws = WSP(); ph_rwkv_fin(c, (const float*)(ws + WS_RW), INP(26) + (size_t)l * BW, INP(27) + (size_t)l * BW, (const bf16_t*)(ws + WS_RAW) + (size_t)MPAD * BW, (bf16_t*)(ws + WS_BR) + (size_t)2 * MPAD * BW); }
        { const Ctx c = fresh(c0); unsigned char* ws = WSP(); ph_gla_fin(c, (const bf16_t*)(ws + WS_U), INP(14) + (size_t)l * BW, INP(15) + (size_t)l * BW, (const bf16_t*)(ws + WS_RAW), (bf16_t*)(ws + WS_BR)); }
        xcd_barrier(bar);
        { const Ctx c = fresh(c0); unsigned char* ws = WSP();
          GemmBranch g = mk_gemm<GemmBranch>(c, (const bf16_t*)(ws + WS_BR), (const bf16_t*)(ws + WS_WBR) + (size_t)l * 4 * DM * BW);
          pg8::EpiMerge E; E.MG = (float*)(ws + WS_MG); E.MGB = (bf16_t*)(ws + WS_MGB); E.U = (const bf16_t*)(ws + WS_U); E.gate_b = INP(11) + (size_t)l * 4 * DM; pg8::gemm_phase<GemmBranch, pg8::EpiMerge, true, true>(c.lds, c.tid, g, E); }
        { const Ctx c = fresh(c0); unsigned char* ws = WSP(); ph_sk_merge(c, 0, c.G, (const bf16_t*)(ws + WS_BR), (const bf16_t*)(ws + WS_WBR) + (size_t)l * 4 * DM * BW, (const bf16_t*)(ws + WS_U), INP(11) + (size_t)l * 4 * DM, (bf16_t*)(ws + WS_MGB)); }
        xcd_barrier(bar);
        { const Ctx c = fresh(c0); unsigned char* ws = WSP();
          GemmOut g = mk_gemm<GemmOut>(c, (const bf16_t*)(ws + WS_MGB), (const bf16_t*)(ws + WS_WOUT) + (size_t)l * DM * DM);
          pg8::EpiRes E; E.R = (const bf16_t*)(ws + WS_HB); E.Y = (bf16_t*)(ws + WS_Y); pg8::gemm_phase<GemmOut, pg8::EpiRes, true, true>(c.lds, c.tid, g, E); }
        { const Ctx c = fresh(c0); unsigned char* ws = WSP(); ph_sk_res<DM>(c, 0, c.G, (const bf16_t*)(ws + WS_MGB), (const bf16_t*)(ws + WS_WOUT) + (size_t)l * DM * DM, (const bf16_t*)(ws + WS_HB), (bf16_t*)(ws + WS_Y)); }
        xcd_barrier(bar);
        { const Ctx c = fresh(c0); unsigned char* ws = WSP(); ph_ln(c, (const bf16_t*)(ws + WS_Y), INP(31) + (size_t)l * DM, INP(32) + (size_t)l * DM, (float*)nullptr, (bf16_t*)(ws + WS_X1B), nullptr, MT, 0); }
        xcd_barrier(bar);
        { const Ctx c = fresh(c0); unsigned char* ws = WSP();
          GemmGU g = mk_gemm<GemmGU>(c, (const bf16_t*)(ws + WS_X1B), (const bf16_t*)(ws + WS_WGU) + (size_t)l * 2 * DFF * DM);
          pg8::EpiSwiGLU E; E.O = (bf16_t*)(ws + WS_ACT); pg8::gemm_phase<GemmGU, pg8::EpiSwiGLU, true, true>(c.lds, c.tid, g, E); }
        { const Ctx c = fresh(c0); unsigned char* ws = WSP(); ph_sk_gu(c, c.G > 192 ? 128 : 0, c.G > 192 ? c.G - 128 : c.G, (const bf16_t*)(ws + WS_X1B), (const bf16_t*)(ws + WS_WGU) + (size_t)l * 2 * DFF * DM, (bf16_t*)(ws + WS_ACT)); }
        xcd_barrier(bar);
        { const Ctx c = fresh(c0); unsigned char* ws = WSP();
          GemmDown g = mk_gemm<GemmDown>(c, (const bf16_t*)(ws + WS_ACT), (const bf16_t*)(ws + WS_WDN) + (size_t)l * DM * DFF);
          pg8::EpiRes E; E.R = (const bf16_t*)(ws + WS_X1B); E.Y = (bf16_t*)(ws + WS_Y); pg8::gemm_phase<GemmDown, pg8::EpiRes, true, true>(c.lds, c.tid, g, E); }
        { const Ctx c = fresh(c0); unsigned char* ws = WSP(); ph_sk_res<DFF>(c, 0, c.G, (const bf16_t*)(ws + WS_ACT), (const bf16_t*)(ws + WS_WDN) + (size_t)l * DM * DFF, (const bf16_t*)(ws + WS_X1B), (bf16_t*)(ws + WS_Y)); }
        xcd_barrier(bar);
        { const Ctx c = fresh(c0); unsigned char* ws = WSP(); float* out = OUTP(); ph_ln(c, (const bf16_t*)(ws + WS_Y), INP(35) + (size_t)l * DM, INP(36) + (size_t)l * DM, (float*)nullptr, (bf16_t*)(ws + WS_HB), l == NL - 1 ? out : nullptr, MT, MT); }
        xcd_barrier(bar);
    }
}

extern "C" void kernel_launch(void* const* d_in, const int* in_sizes, int n_in, void* d_out, int out_size, void* d_ws, size_t ws_size, hipStream_t stream) {
    static int grid = 0;
    if (grid == 0) {
        if (n_in != 37 || (size_t)out_size != O_END || ws_size < WS_END) { fprintf(stderr, "kernel_launch: unexpected sizes (n_in %d out %d ws %zu need %zu)\n", n_in, out_size, ws_size, (size_t)WS_END); grid = -1; return; }
        int dev = 0, cus = 0;
        if (hipGetDevice(&dev) != hipSuccess || hipDeviceGetAttribute(&cus, hipDeviceAttributeMultiprocessorCount, dev) != hipSuccess) { grid = -1; return; }
        if (hipFuncSetAttribute((const void*)mega_fwd, hipFuncAttributeMaxDynamicSharedMemorySize, LDS_BYTES) != hipSuccess) { fprintf(stderr, "kernel_launch: hipFuncSetAttribute failed\n"); grid = -1; return; }
        int per_cu = 0;
        if (hipOccupancyMaxActiveBlocksPerMultiprocessor(&per_cu, (const void*)mega_fwd, 512, LDS_BYTES) != hipSuccess || per_cu < 1) { fprintf(stderr, "kernel_launch: occupancy query says %d\n", per_cu); }
        (void)hipGetLastError();
        grid = cus;
    }
    if (grid < 0) return;
    (void)hipMemsetAsync((unsigned char*)d_ws + WS_CTL, 0, XCD_BAR_WORDS * sizeof(unsigned), stream);
    Args a; memset(&a, 0, sizeof a);
    for (int i = 0; i < 37; ++i) a.in[i] = (const float*)d_in[i];
    a.out = (float*)d_out; a.ws = (unsigned char*)d_ws;
    hipLaunchKernelGGL(mega_fwd, dim3(grid), dim3(512), LDS_BYTES, stream, a);
}
```

```cpp
#include <hip/hip_runtime.h>
#include <cstdio>
#include <cstdint>
#include <cstring>

#define LAS __attribute__((address_space(3)))
typedef unsigned short bf16_t;
typedef short bf16x8 __attribute__((ext_vector_type(8)));
typedef float f32x4 __attribute__((ext_vector_type(4)));
typedef float f32x2 __attribute__((ext_vector_type(2)));
typedef unsigned u32x4 __attribute__((ext_vector_type(4)));
typedef unsigned u32x2 __attribute__((ext_vector_type(2)));

constexpr int DM = 2048, NL = 4;
constexpr int PB = 2, PS = 4096, MP = PB * PS;
constexpr int SB = 32, SS = 4, MS = SB * SS;
constexpr int MT = MP + MS;
constexpr int MPAD = 8448;
constexpr int NIN = 16912, NINP = 17152;
constexpr int U_GQ = 0, U_GK = 512, U_GV = 1024, U_GR = 2048, U_GA = 3072, U_SQ = 3328, U_SK = 4352, U_SV = 4480, U_RU = 4608, U_MQ = 7936, U_GP = 8960;
constexpr int RWC = 3328, BW = 1024, DFF = 5632, MEMT = 256;
constexpr float ALPHA = 1.681792830507429f;

constexpr size_t O_YP = 0;
constexpr size_t O_YS = O_YP + (size_t)MP * DM;
constexpr size_t O_SWKP = O_YS + (size_t)MS * DM;
constexpr size_t O_SWVP = O_SWKP + (size_t)NL * PB * 128 * 128;
constexpr size_t O_MKP = O_SWVP + (size_t)NL * PB * 128 * 128;
constexpr size_t O_MVP = O_MKP + (size_t)NL * PB * 256 * 1024;
constexpr size_t O_GLAP = O_MVP + (size_t)NL * PB * 256 * 1024;
constexpr size_t O_RWP = O_GLAP + (size_t)NL * PB * 4 * 128 * 256;
constexpr size_t O_RSP = O_RWP + (size_t)NL * PB * 16 * 64 * 64;
constexpr size_t O_SWKS = O_RSP + (size_t)NL * PB * RWC;
constexpr size_t O_SWVS = O_SWKS + (size_t)NL * SB * 128 * 128;
constexpr size_t O_GLAS = O_SWVS + (size_t)NL * SB * 128 * 128;
constexpr size_t O_RWS = O_GLAS + (size_t)NL * SB * 4 * 128 * 256;
constexpr size_t O_RSS = O_RWS + (size_t)NL * SB * 16 * 64 * 64;
constexpr size_t O_END = O_RSS + (size_t)NL * SB * RWC;
static_assert(O_END == 52881408, "output size");

constexpr size_t al256(size_t x) { return (x + 255) & ~(size_t)255; }
constexpr size_t WS_CTL = 0;
constexpr size_t WS_WIN = 65536;
constexpr size_t WS_WMEM = WS_WIN + (size_t)NL * NINP * DM * 2;
constexpr size_t WS_WBR = WS_WMEM + (size_t)NL * DM * DM * 2;
constexpr size_t WS_WOUT = WS_WBR + (size_t)NL * 4 * DM * BW * 2;
constexpr size_t WS_WGU = WS_WOUT + (size_t)NL * DM * DM * 2;
constexpr size_t WS_WDN = WS_WGU + (size_t)NL * 2 * DFF * DM * 2;
constexpr size_t WS_HF = WS_WDN + (size_t)NL * DM * DFF * 2;
constexpr size_t WS_HB = WS_HF + (size_t)MPAD * DM * 4;
constexpr size_t WS_U = WS_HB + (size_t)MPAD * DM * 2;
constexpr size_t WS_BR = WS_U + (size_t)MPAD * NINP * 2;
constexpr size_t WS_MG = WS_BR + (size_t)4 * MPAD * BW * 2;
constexpr size_t WS_MGB = WS_MG + (size_t)MPAD * DM * 4;
constexpr size_t WS_Y = WS_MGB + (size_t)MPAD * DM * 2;
constexpr size_t WS_X1F = WS_Y + (size_t)MPAD * DM * 4;
constexpr size_t WS_X1B = WS_X1F + (size_t)MPAD * DM * 4;
constexpr size_t WS_ACT = WS_X1B + (size_t)MPAD * DM * 2;
constexpr size_t WS_MEMB = WS_ACT + (size_t)MPAD * DFF * 2;
constexpr size_t WS_MKB = WS_MEMB + (size_t)512 * DM * 2;
constexpr size_t WS_MVT = WS_MKB + (size_t)NL * 512 * 1024 * 2;
constexpr size_t WS_SC = WS_MVT + (size_t)NL * 8 * 256 * 256 * 2;
constexpr size_t WS_PB = WS_SC + (size_t)8 * 4096 * 256 * 4;
constexpr size_t WS_RW = WS_PB + (size_t)8 * 4096 * 256 * 2;
constexpr size_t RW_ARR = (size_t)MPAD * BW * 4;
constexpr int GL_NCH = 512 + 128;
constexpr size_t WS_GLQD = WS_RW + 8 * RW_ARR;
constexpr size_t WS_GLKH = WS_GLQD + (size_t)GL_NCH * 8192 * 2;
constexpr size_t WS_GLE = WS_GLKH + (size_t)GL_NCH * 8192 * 2;
constexpr size_t WS_GLVT = WS_GLE + (size_t)GL_NCH * 4096 * 2;
constexpr size_t WS_GLGC = WS_GLVT + (size_t)GL_NCH * 16384 * 2;
constexpr int RB_NCH = PB * 16 * 256 + SB * 16;
constexpr int RB_EL = 9216;
constexpr int RB_QP = 4608, RB_KHP = 5760, RB_VT = 7296, RB_EP = 8832;
constexpr size_t WS_RB = WS_GLGC + (size_t)GL_NCH * 128 * 4;
constexpr size_t WS_RAW = WS_RB + (size_t)RB_NCH * RB_EL * 2;
constexpr size_t WS_LRW = WS_RAW + (size_t)2 * MPAD * BW * 2;
constexpr size_t WS_END = WS_LRW + (size_t)NL * 16 * 64 * 256 * 2;

__device__ __forceinline__ float bf2f(bf16_t b) { return __uint_as_float(((unsigned)b) << 16); }
typedef __bf16 bf16v2_t __attribute__((ext_vector_type(2)));
__device__ __forceinline__ unsigned pk2(float lo, float hi) { const f32x2 v = {lo, hi}; return __builtin_bit_cast(unsigned, __builtin_convertvector(v, bf16v2_t)); }
__device__ __forceinline__ bf16_t f2bf(float f) { return (bf16_t)(pk2(f, 0.f) & 0xffffu); }
__device__ __forceinline__ f32x4 ld4bf(const bf16_t* p) { const u32x2 w = *(const u32x2*)p; return (f32x4){__uint_as_float(w.x << 16), __uint_as_float(w.x & 0xffff0000u), __uint_as_float(w.y << 16), __uint_as_float(w.y & 0xffff0000u)}; }
__device__ __forceinline__ float wave_sum(float v) {
#pragma unroll
    for (int o = 32; o > 0; o >>= 1) v += __shfl_xor(v, o, 64);
    return v;
}
__device__ __forceinline__ float wave_max(float v) {
#pragma unroll
    for (int o = 32; o > 0; o >>= 1) v = fmaxf(v, __shfl_xor(v, o, 64));
    return v;
}
__device__ __forceinline__ float sigmoidf_(float x) { return __builtin_amdgcn_rcpf(1.0f + __expf(-x)); }
__device__ __forceinline__ void unpack8(const u32x4 w, float (&x)[8]) {
    x[0] = __uint_as_float(w.x << 16); x[1] = __uint_as_float(w.x & 0xffff0000u); x[2] = __uint_as_float(w.y << 16); x[3] = __uint_as_float(w.y & 0xffff0000u);
    x[4] = __uint_as_float(w.z << 16); x[5] = __uint_as_float(w.z & 0xffff0000u); x[6] = __uint_as_float(w.w << 16); x[7] = __uint_as_float(w.w & 0xffff0000u);
}
__device__ __forceinline__ float softplusf_(float x) { return fmaxf(x, 0.f) + log1pf(__expf(-fabsf(x))); }
__device__ __forceinline__ float softplus_fast(float x) { return fmaxf(x, 0.f) + __logf(1.0f + __expf(-fabsf(x))); }
__device__ __forceinline__ float tanh_fast(float x) { return 1.0f - 2.0f * __builtin_amdgcn_rcpf(1.0f + __expf(2.0f * x)); }

namespace pg8 {
constexpr int BM = 256, BK = 64, HALF = 128, HTB = HALF * BK * 2, STAGE_BYTES = 8 * HTB, NXCD = 8, WGM = 8;
__host__ __device__ __forceinline__ int lds_byte(int r, int c) { const int st = (r >> 4) * 2 + (c >> 5), rr = r & 15, cc = c & 31, ob = rr * 64 + cc * 2; return st * 1024 + (ob ^ (((ob >> 9) & 1) << 5)); }
__host__ __device__ __forceinline__ void stage_rc(int b, int& R, int& C) { const int st = b / 1024, sb = b % 1024, swz = sb ^ (((sb >> 9) & 1) << 5); R = (st >> 1) * 16 + swz / 64; C = (st & 1) * 32 + (swz % 64) / 2; }
__host__ __device__ __forceinline__ int perm32(int rho) { const int n = rho >> 4, i = rho & 15; return 8 * (i >> 2) + 4 * n + (i & 3); }

struct Unit { int pm, pn, z; };
template <int LDA_, int LDB_, int K_, int NM_, int NN_, int NZ_ = 1, int NZH_ = 1, bool ZINNER_ = false, long ZSAB_ = 0, long ZSAH_ = 0, long ZSBB_ = 0, long ZSBH_ = 0>
struct Gemm {
    static constexpr int LDA = LDA_, LDB = LDB_, K = K_, NM = NM_, NN = NN_, NZ = NZ_, NZH = NZH_; static constexpr bool ZINNER = ZINNER_;
    const bf16_t* A; const bf16_t* B; int G, c;
    __device__ __forceinline__ bool next(int i, Unit& u) const {
        constexpr int nt = NM * NN; int L, z;
        if (ZINNER) { const int it = i / NZ; z = i - it * NZ; const long LL = (long)it * G + c; if (LL >= nt) return false; L = (int)LL; }
        else { const long LL = (long)i * G + c; if (LL >= (long)nt * NZ) return false; z = (int)(LL / nt); L = (int)(LL - (long)z * nt); }
        int wgid = L; { constexpr int q = nt / NXCD, r = nt % NXCD; const int xcd = wgid % NXCD, off = wgid / NXCD; wgid = (xcd < r ? xcd * (q + 1) : r * (q + 1) + (xcd - r) * q) + off; }
        constexpr int nig = WGM * NN; const int gid = wgid / nig, fm = gid * WGM, gsz = (NM - fm) < WGM ? (NM - fm) : WGM;
        u.pm = fm + ((wgid % nig) % gsz); u.pn = (wgid % nig) / gsz; u.z = z; return true;
    }
    __device__ __forceinline__ const char* a_base(const Unit& u) const { const int zb = u.z / NZH, zh = u.z - zb * NZH; return (const char*)(A + zb * ZSAB_ + zh * ZSAH_ + (long)u.pm * BM * LDA); }
    __device__ __forceinline__ const char* b_base(const Unit& u) const { const int zb = u.z / NZH, zh = u.z - zb * NZH; return (const char*)(B + zb * ZSBB_ + zh * ZSBH_ + (long)u.pn * BM * LDB); }
};

template <class GT, class Epi, bool ALIGN_EPI = true, bool SP2 = true>
__device__ __forceinline__ void gemm_phase(LAS unsigned char* lds, const int tid, const GT& g, const Epi& E) {
    const int wid = __builtin_amdgcn_readfirstlane(tid >> 6), lane = tid & 63, wr = wid >> 2, wc = wid & 3, fr = lane & 15, fq = lane >> 4;
    constexpr int nt = GT::K / BK;
    unsigned voffA[2], voffB[2];
#pragma unroll
    for (int i = 0; i < 2; ++i) { int R, C; stage_rc(tid * 16 + i * 8192, R, C); const int Rb = Epi::PERM ? ((R & ~31) + perm32(R & 31)) : R;
        voffA[i] = (unsigned)(R * GT::LDA + C) * 2u; voffB[i] = (unsigned)(Rb * GT::LDB + C) * 2u; }
    constexpr size_t kstep = (size_t)(BK * 2);
    constexpr size_t hstepA = (size_t)HALF * GT::LDA * 2, hstepB = (size_t)HALF * GT::LDB * 2;
    const unsigned ldsw = (unsigned)wid * 1024u;
    const int aoff = lds_byte(wr * 64 + fr, fq * 8), boff = lds_byte(wc * 32 + fr, fq * 8);
#define PG8_SA(b, h) (((b) * 2 + (h)) * HTB)
#define PG8_SB(b, h) ((4 + (b) * 2 + (h)) * HTB)
#define PG8_STAGE(bufoff, gbase, voff) do { _Pragma("unroll") for (int _i = 0; _i < 2; ++_i) \
        __builtin_amdgcn_global_load_lds((const unsigned*)((const char*)(gbase) + (voff)[_i]), (LAS unsigned*)(lds + (bufoff) + ldsw + _i * 8192), 16, 0, 0); } while (0)
#define PG8_LDA(dst, b, h) do { _Pragma("unroll") for (int m = 0; m < 4; ++m) _Pragma("unroll") for (int k = 0; k < 2; ++k) dst[m][k] = *(const LAS bf16x8*)(lds + PG8_SA(b, h) + aoff + m * 2048 + k * 1024); } while (0)
#define PG8_LDB(dst, b, h) do { _Pragma("unroll") for (int n = 0; n < 2; ++n) _Pragma("unroll") for (int k = 0; k < 2; ++k) dst[n][k] = *(const LAS bf16x8*)(lds + PG8_SB(b, h) + boff + n * 2048 + k * 1024); } while (0)
#define PG8_MMA(ai, bj, At, Bt) do { __builtin_amdgcn_s_setprio(1); _Pragma("unroll") for (int m = 0; m < 4; ++m) _Pragma("unroll") for (int n = 0; n < 2; ++n) _Pragma("unroll") for (int k = 0; k < 2; ++k) \
        acc[ai][bj][m][n] = __builtin_amdgcn_mfma_f32_16x16x32_bf16(Bt[n][k], At[m][k], acc[ai][bj][m][n], 0, 0, 0); __builtin_amdgcn_s_setprio(0); } while (0)
#define PG8_WAIT_V(n) asm volatile("s_waitcnt vmcnt(" #n ")" ::: "memory")
#define PG8_WAIT_L(n) asm volatile("s_waitcnt lgkmcnt(" #n ")" ::: "memory")
#define PG8_BAR __builtin_amdgcn_s_barrier()
#define PG8_SCHED __builtin_amdgcn_sched_barrier(0)
    Unit cur, nxt; int ui = 0;
    if (!g.next(0, cur)) return;
    f32x4 acc[2][2][4][2];
#pragma unroll
    for (int a = 0; a < 2; ++a)
#pragma unroll
        for (int b = 0; b < 2; ++b)
#pragma unroll
            for (int m = 0; m < 4; ++m)
#pragma unroll
                for (int n = 0; n < 2; ++n) acc[a][b][m][n] = (f32x4){0.f, 0.f, 0.f, 0.f};
    bf16x8 At[4][2], B0[2][2], B1[2][2];
    const char* cA = g.a_base(cur); const char* cB = g.b_base(cur);
    if constexpr (SP2) {
        PG8_STAGE(PG8_SB(0, 0), cB, voffB); PG8_STAGE(PG8_SB(0, 1), cB + hstepB, voffB); PG8_STAGE(PG8_SA(0, 0), cA, voffA); PG8_STAGE(PG8_SA(0, 1), cA + hstepA, voffA);
        if (wr == 1) PG8_BAR;
        PG8_WAIT_V(2); PG8_BAR;
        PG8_STAGE(PG8_SB(1, 0), cB + kstep, voffB); PG8_STAGE(PG8_SA(1, 0), cA + kstep, voffA); PG8_STAGE(PG8_SB(1, 1), cB + hstepB + kstep, voffB);
        PG8_WAIT_V(6); PG8_BAR;
    } else {
        PG8_STAGE(PG8_SB(0, 0), cB, voffB); PG8_STAGE(PG8_SA(0, 0), cA, voffA); PG8_STAGE(PG8_SB(0, 1), cB + hstepB, voffB); PG8_STAGE(PG8_SA(0, 1), cA + hstepA, voffA);
        if (wr == 1) PG8_BAR;
        PG8_WAIT_V(4); PG8_BAR;
        PG8_STAGE(PG8_SB(1, 0), cB + kstep, voffB); PG8_STAGE(PG8_SA(1, 0), cA + kstep, voffA); PG8_STAGE(PG8_SB(1, 1), cB + hstepB + kstep, voffB);
        PG8_WAIT_V(6); PG8_BAR;
    }
    for (;;) {
        const bool has_next = g.next(ui + 1, nxt);
        const char* nA = has_next ? g.a_base(nxt) : cA; const char* nB = has_next ? g.b_base(nxt) : cB;
#pragma unroll 1
        for (int t = 0; t < nt; t += 2) {
            const bool last = (t == nt - 2);
            const char* a1 = cA + (size_t)(t + 1) * kstep;
            const char* a2 = last ? nA : cA + (size_t)(t + 2) * kstep; const char* b2 = last ? nB : cB + (size_t)(t + 2) * kstep;
            const char* a3 = a2 + kstep; const char* b3 = b2 + kstep;
            if constexpr (SP2) {
            PG8_LDB(B0, 0, 0); PG8_LDB(B1, 0, 1); PG8_SCHED; PG8_LDA(At, 0, 0); PG8_STAGE(PG8_SA(1, 1), a1 + hstepA, voffA);
            PG8_WAIT_V(8); PG8_WAIT_L(0); PG8_BAR; PG8_MMA(0, 0, At, B0); PG8_MMA(0, 1, At, B1); PG8_BAR; PG8_SCHED;
            PG8_LDA(At, 0, 1); PG8_STAGE(PG8_SB(0, 0), b2, voffB); PG8_STAGE(PG8_SB(0, 1), b2 + hstepB, voffB); PG8_STAGE(PG8_SA(0, 0), a2, voffA);
            PG8_WAIT_V(8); PG8_WAIT_L(0); PG8_BAR; PG8_MMA(1, 0, At, B0); PG8_MMA(1, 1, At, B1); PG8_BAR; PG8_SCHED;
            PG8_LDB(B0, 1, 0); PG8_LDB(B1, 1, 1); PG8_SCHED; PG8_LDA(At, 1, 0); PG8_STAGE(PG8_SA(0, 1), a2 + hstepA, voffA);
            PG8_WAIT_V(8); PG8_WAIT_L(0); PG8_BAR; PG8_MMA(0, 0, At, B0); PG8_MMA(0, 1, At, B1); PG8_BAR; PG8_SCHED;
            PG8_LDA(At, 1, 1); PG8_STAGE(PG8_SB(1, 0), b3, voffB); PG8_STAGE(PG8_SB(1, 1), b3 + hstepB, voffB); PG8_STAGE(PG8_SA(1, 0), a3, voffA);
            PG8_WAIT_V(8); PG8_WAIT_L(0); PG8_BAR; PG8_MMA(1, 0, At, B0); PG8_MMA(1, 1, At, B1); PG8_BAR; PG8_SCHED;
            } else {
            PG8_LDB(B0, 0, 0); PG8_SCHED; PG8_LDA(At, 0, 0); PG8_STAGE(PG8_SA(1, 1), a1 + hstepA, voffA);
            PG8_WAIT_L(8); PG8_BAR; PG8_WAIT_L(0); PG8_MMA(0, 0, At, B0); PG8_BAR; PG8_SCHED;
            PG8_LDB(B1, 0, 1); PG8_STAGE(PG8_SB(0, 0), b2, voffB);
            PG8_BAR; PG8_WAIT_L(0); PG8_MMA(0, 1, At, B1); PG8_BAR;
            PG8_LDA(At, 0, 1); PG8_STAGE(PG8_SA(0, 0), a2, voffA);
            PG8_BAR; PG8_WAIT_L(0); PG8_MMA(1, 0, At, B0); PG8_BAR; PG8_SCHED;
            PG8_STAGE(PG8_SB(0, 1), b2 + hstepB, voffB);
            PG8_WAIT_V(6); PG8_BAR; PG8_MMA(1, 1, At, B1); PG8_BAR;
            PG8_LDB(B0, 1, 0); PG8_SCHED; PG8_LDA(At, 1, 0); PG8_STAGE(PG8_SA(0, 1), a2 + hstepA, voffA);
            PG8_WAIT_L(8); PG8_BAR; PG8_WAIT_L(0); PG8_MMA(0, 0, At, B0); PG8_BAR; PG8_SCHED;
            PG8_LDB(B1, 1, 1); PG8_STAGE(PG8_SB(1, 0), b3, voffB);
            PG8_BAR; PG8_WAIT_L(0); PG8_MMA(0, 1, At, B1); PG8_BAR;
            PG8_LDA(At, 1, 1); PG8_STAGE(PG8_SA(1, 0), a3, voffA);
            PG8_BAR; PG8_WAIT_L(0); PG8_MMA(1, 0, At, B0); PG8_BAR; PG8_SCHED;
            PG8_STAGE(PG8_SB(1, 1), b3 + hstepB, voffB);
            PG8_WAIT_V(6); PG8_BAR; PG8_MMA(1, 1, At, B1); PG8_BAR;
            }
        }
        if constexpr (ALIGN_EPI) { if (wr == 0) PG8_BAR; }
        E(acc, cur, wr, wc, fr, fq);
        if (!has_next) break;
#pragma unroll
        for (int a = 0; a < 2; ++a)
#pragma unroll
            for (int b = 0; b < 2; ++b)
#pragma unroll
                for (int m = 0; m < 4; ++m)
#pragma unroll
                    for (int n = 0; n < 2; ++n) acc[a][b][m][n] = (f32x4){0.f, 0.f, 0.f, 0.f};
        cur = nxt; cA = nA; cB = nB; ++ui;
        if constexpr (ALIGN_EPI) { if (wr == 1) PG8_BAR; }
    }
    PG8_WAIT_V(0);
    if constexpr (!ALIGN_EPI) { if (wr == 0) PG8_BAR; }
    PG8_BAR;
#undef PG8_SA
#undef PG8_SB
#undef PG8_STAGE
#undef PG8_LDA
#undef PG8_LDB
#undef PG8_MMA
#undef PG8_WAIT_V
#undef PG8_WAIT_L
#undef PG8_BAR
#undef PG8_SCHED
}

struct EpiBf16 {
    static constexpr bool PERM = true;
    bf16_t* O; long zs; int ldc, pad;
    __device__ __forceinline__ void operator()(const f32x4 (&acc)[2][2][4][2], const Unit& u, int wr, int wc, int fr, int fq) const {
        const int row0 = u.pm * BM + wr * 64 + fr, col0 = u.pn * BM + wc * 32 + 8 * fq; bf16_t* base = O + (long)u.z * zs;
#pragma unroll
        for (int ai = 0; ai < 2; ++ai)
#pragma unroll
            for (int m = 0; m < 4; ++m) { bf16_t* rowp = base + (size_t)(row0 + ai * HALF + m * 16) * ldc + col0;
#pragma unroll
                for (int bj = 0; bj < 2; ++bj) { const f32x4 v0 = acc[ai][bj][m][0], v1 = acc[ai][bj][m][1];
                    u32x4 w; w.x = pk2(v0[0], v0[1]); w.y = pk2(v0[2], v0[3]); w.z = pk2(v1[0], v1[1]); w.w = pk2(v1[2], v1[3]);
                    *(u32x4*)(rowp + bj * HALF) = w; } }
    }
};
struct EpiMem {
    static constexpr bool PERM = false;
    float* outK; float* outV; bf16_t* kb; bf16_t* vt;
    __device__ __forceinline__ void operator()(const f32x4 (&acc)[2][2][4][2], const Unit& u, int wr, int wc, int fr, int fq) const {
        const int row0 = u.pm * BM + wr * 64 + fr, col0 = u.pn * BM + wc * 32 + 4 * fq;
#pragma unroll
        for (int ai = 0; ai < 2; ++ai)
#pragma unroll
            for (int m = 0; m < 4; ++m) { const int row = row0 + ai * HALF + m * 16;
#pragma unroll
                for (int bj = 0; bj < 2; ++bj)
#pragma unroll
                    for (int n = 0; n < 2; ++n) { const int col = col0 + bj * HALF + n * 16; const f32x4 v = acc[ai][bj][m][n];
                        if (col < 1024) { *(f32x4*)(outK + ((size_t)u.z * 512 + row) * 1024 + col) = v;
                            u32x2 w; w.x = pk2(v[0], v[1]); w.y = pk2(v[2], v[3]); *(u32x2*)(kb + ((size_t)u.z * 512 + row) * 1024 + col) = w; }
                        else { const int c = col - 1024; *(f32x4*)(outV + ((size_t)u.z * 512 + row) * 1024 + c) = v;
                            const int b = row >> 8, mm = row & 255, h = c >> 8, d = c & 255; bf16_t* p = vt + ((((size_t)u.z * 2 + b) * 4 + h) * 256 + d) * 256 + mm;
                            p[0] = f2bf(v[0]); p[256] = f2bf(v[1]); p[512] = f2bf(v[2]); p[768] = f2bf(v[3]); } } }
    }
};
struct EpiMerge {
    static constexpr bool PERM = true;
    float* MG; bf16_t* MGB; const bf16_t* U; const float* gate_b;
    __device__ __forceinline__ void operator()(const f32x4 (&acc)[2][2][4][2], const Unit& u, int wr, int wc, int fr, int fq) const {
        const int row0 = u.pm * BM + wr * 64 + fr, col0 = u.pn * BM + wc * 32 + 8 * fq;
#pragma unroll
        for (int bj = 0; bj < 2; ++bj) { const int col = col0 + bj * HALF; const f32x4 gb0 = *(const f32x4*)(gate_b + u.z * DM + col), gb1 = *(const f32x4*)(gate_b + u.z * DM + col + 4);
#pragma unroll
            for (int ai = 0; ai < 2; ++ai)
#pragma unroll
                for (int m = 0; m < 4; ++m) { const int row = row0 + ai * HALF + m * 16; float gp[8], r[8];
                    unpack8(*(const u32x4*)(U + (size_t)row * NINP + U_GP + u.z * DM + col), gp);
#pragma unroll
                    for (int j = 0; j < 4; ++j) { r[j] = sigmoidf_(gp[j] + gb0[j]) * acc[ai][bj][m][0][j]; r[4 + j] = sigmoidf_(gp[4 + j] + gb1[j]) * acc[ai][bj][m][1][j]; }
                    bf16_t* mp = MGB + (size_t)row * DM + col;
                    if (u.z > 0) { float pv[8]; unpack8(*(const u32x4*)mp, pv);
#pragma unroll
                        for (int j = 0; j < 8; ++j) r[j] += pv[j]; }
                    *(u32x4*)mp = (u32x4){pk2(r[0], r[1]), pk2(r[2], r[3]), pk2(r[4], r[5]), pk2(r[6], r[7])}; } }
    }
};
struct EpiRes {
    static constexpr bool PERM = true;
    const bf16_t* R; bf16_t* Y;
    __device__ __forceinline__ void operator()(const f32x4 (&acc)[2][2][4][2], const Unit& u, int wr, int wc, int fr, int fq) const {
        const int row0 = u.pm * BM + wr * 64 + fr, col0 = u.pn * BM + wc * 32 + 8 * fq;
#pragma unroll
        for (int ai = 0; ai < 2; ++ai)
#pragma unroll
            for (int m = 0; m < 4; ++m) { const size_t ro = (size_t)(row0 + ai * HALF + m * 16) * DM + col0;
#pragma unroll
                for (int bj = 0; bj < 2; ++bj) { const size_t o = ro + bj * HALF; float rv[8]; unpack8(*(const u32x4*)(R + o), rv);
                    const f32x4 y0 = (f32x4){rv[0], rv[1], rv[2], rv[3]} * ALPHA + acc[ai][bj][m][0], y1 = (f32x4){rv[4], rv[5], rv[6], rv[7]} * ALPHA + acc[ai][bj][m][1];
                    *(u32x4*)(Y + o) = (u32x4){pk2(y0[0], y0[1]), pk2(y0[2], y0[3]), pk2(y1[0], y1[1]), pk2(y1[2], y1[3])}; } }
    }
};
struct EpiSwiGLU {
    static constexpr bool PERM = true;
    bf16_t* O;
    __device__ __forceinline__ void operator()(const f32x4 (&acc)[2][2][4][2], const Unit& u, int wr, int wc, int fr, int fq) const {
        const int row0 = u.pm * BM + wr * 64 + fr, col0 = u.pn * HALF + wc * 32 + 8 * fq;
#pragma unroll
        for (int ai = 0; ai < 2; ++ai)
#pragma unroll
            for (int m = 0; m < 4; ++m) { bf16_t* rowp = O + (size_t)(row0 + ai * HALF + m * 16) * DFF + col0;
                float r[8];
#pragma unroll
                for (int n = 0; n < 2; ++n)
#pragma unroll
                    for (int j = 0; j < 4; ++j) { const float gg = acc[ai][0][m][n][j], uu = acc[ai][1][m][n][j]; r[n * 4 + j] = gg * sigmoidf_(gg) * uu; }
                u32x4 w; w.x = pk2(r[0], r[1]); w.y = pk2(r[2], r[3]); w.z = pk2(r[4], r[5]); w.w = pk2(r[6], r[7]);
                *(u32x4*)rowp = w; }
    }
};
struct EpiScore {
    static constexpr bool PERM = false;
    float* SC;
    __device__ __forceinline__ void operator()(const f32x4 (&acc)[2][2][4][2], const Unit& u, int wr, int wc, int fr, int fq) const {
        const int row0 = u.pm * BM + wr * 64 + fr, col0 = wc * 32 + 4 * fq; float* base = SC + (size_t)u.z * 4096 * 256;
#pragma unroll
        for (int ai = 0; ai < 2; ++ai)
#pragma unroll
            for (int m = 0; m < 4; ++m) { float* rowp = base + (size_t)(row0 + ai * HALF + m * 16) * 256 + col0;
#pragma unroll
                for (int bj = 0; bj < 2; ++bj)
#pragma unroll
                    for (int n = 0; n < 2; ++n) *(f32x4*)(rowp + bj * HALF + n * 16) = acc[ai][bj][m][n] * 0.0625f; }
    }
};
struct EpiPV {
    static constexpr bool PERM = true;
    bf16_t* O;
    __device__ __forceinline__ void operator()(const f32x4 (&acc)[2][2][4][2], const Unit& u, int wr, int wc, int fr, int fq) const {
        const int b = u.z >> 2, h = u.z & 3; const int row0 = b * PS + u.pm * BM + wr * 64 + fr, col0 = h * 256 + wc * 32 + 8 * fq;
#pragma unroll
        for (int ai = 0; ai < 2; ++ai)
#pragma unroll
            for (int m = 0; m < 4; ++m) { bf16_t* rowp = O + (size_t)(row0 + ai * HALF + m * 16) * BW + col0;
#pragma unroll
                for (int bj = 0; bj < 2; ++bj) { const f32x4 v0 = acc[ai][bj][m][0], v1 = acc[ai][bj][m][1];
                    u32x4 w; w.x = pk2(v0[0], v0[1]); w.y = pk2(v0[2], v0[3]); w.z = pk2(v1[0], v1[1]); w.w = pk2(v1[2], v1[3]);
                    *(u32x4*)(rowp + bj * HALF) = w; } }
    }
};
}


#define XB_TMO      128
#define XB_XCNT(j)  (256  + 64 * (j))
#define XB_XSUB(j)  (1280 + 64 * (j))
#define XB_XGEN(j)  (2304 + 64 * (j))
#define XB_TOP      3328
#define XB_TOPGEN   3392
#define XCD_BAR_WORDS 3456
#define XB_SPIN_CAP (1u << 18)
__device__ __forceinline__ unsigned xb_ld(unsigned* p)              { return __hip_atomic_load(p, __ATOMIC_RELAXED, __HIP_MEMORY_SCOPE_AGENT); }
__device__ __forceinline__ unsigned xb_add(unsigned* p, unsigned v) { return __hip_atomic_fetch_add(p, v, __ATOMIC_RELAXED, __HIP_MEMORY_SCOPE_AGENT); }
__device__ __forceinline__ unsigned xb_xcc_id() { return (unsigned)__builtin_amdgcn_s_getreg((3 << 11) | 20) & 0xFu; }
#define XB_SPIN(cond, bar) do { unsigned _sp = 0; while (cond) { __builtin_amdgcn_s_sleep(1); \
    if ((++_sp & 255u) == 0u) { if (xb_ld(&(bar)[XB_TMO])) break; if (_sp > XB_SPIN_CAP) { atomicAdd(&(bar)[XB_TMO], 1u); break; } } } } while (0)
struct XcdBarrier { unsigned* bar; unsigned x; volatile LAS unsigned* st; };
__device__ __forceinline__ XcdBarrier xcd_barrier_post(unsigned* bar, volatile LAS unsigned* st) {
    XcdBarrier b; b.bar = bar; b.x = xb_xcc_id(); b.st = st;
    if (threadIdx.x == 0) (void)xb_add(&bar[XB_XCNT(b.x)], 1u);
    return b;
}
__device__ __forceinline__ void xcd_barrier_complete(unsigned* bar, unsigned x, unsigned& nloc, unsigned& nx) {
    const unsigned G = gridDim.x * gridDim.y * gridDim.z;
    unsigned sum, cnt, mine, sp = 0u;
    for (;;) {
        sum = 0u; cnt = 0u; mine = 0u;
#pragma unroll
        for (unsigned j = 0; j < 16; ++j) { const unsigned c = xb_ld(&bar[XB_XCNT(j)]); sum += c; cnt += (c > 0u) ? 1u : 0u; mine = (j == x) ? c : mine; }
        if (sum == G) break;
        __builtin_amdgcn_s_sleep(1);
        if ((++sp & 255u) == 0u) { if (xb_ld(&bar[XB_TMO])) break; if (sp > XB_SPIN_CAP) { atomicAdd(&bar[XB_TMO], 1u); break; } }
    }
    nloc = mine > 0u ? mine : 1u; nx = cnt > 0u ? cnt : 1u;
}
__device__ __forceinline__ void xcd_barrier(const XcdBarrier& b) {
    asm volatile("s_waitcnt vmcnt(0)" ::: "memory");
    __syncthreads();
    if (threadIdx.x == 0) {
        unsigned* bar = b.bar;
        __builtin_amdgcn_s_waitcnt(0);
        unsigned nloc = b.st[0], nx = b.st[1];
        if (nloc == 0u) { xcd_barrier_complete(bar, b.x, nloc, nx); b.st[0] = nloc; b.st[1] = nx; }
        const unsigned old = xb_add(&bar[XB_XSUB(b.x)], 1u);
        const unsigned gen = old / nloc;
        if (old + 1u == (gen + 1u) * nloc) {
            __builtin_amdgcn_fence(__ATOMIC_RELEASE, "agent");
            asm volatile("s_waitcnt vmcnt(0)" ::: "memory");
            const unsigned og = xb_add(&bar[XB_TOP], 1u);
            const unsigned tg = og / nx;
            if (og + 1u == (tg + 1u) * nx) xb_add(&bar[XB_TOPGEN], 1u);
            else XB_SPIN(xb_ld(&bar[XB_TOPGEN]) == tg, bar);
            __builtin_amdgcn_fence(__ATOMIC_ACQUIRE, "agent");
            xb_add(&bar[XB_XGEN(b.x)], 1u);
            asm volatile("s_waitcnt vmcnt(0)" ::: "memory");
        } else {
            XB_SPIN(xb_ld(&bar[XB_XGEN(b.x)]) == gen, bar);
            __builtin_amdgcn_fence(__ATOMIC_ACQUIRE, "agent");
            asm volatile("s_waitcnt vmcnt(0)" ::: "memory");
        }
    }
    __syncthreads();
}

struct Ctx { int tid, lane, wave, bid, G; LAS unsigned char* lds; };
__device__ __forceinline__ Ctx fresh(const Ctx& c0) { Ctx c; c.wave = c0.wave; c.bid = c0.bid; c.G = c0.G; c.lds = c0.lds; asm volatile("" : "+s"(c.bid), "+s"(c.G), "+s"(c.wave));
    int lane = (int)__builtin_amdgcn_mbcnt_hi(~0u, __builtin_amdgcn_mbcnt_lo(~0u, 0u)); asm volatile("" : "+v"(lane)); c.lane = lane; c.tid = c.wave * 64 + lane; return c; }

__device__ __forceinline__ int colmap(int mode, int n) {
    if (mode == 1) return n < 3088 ? n : (n < 3328 ? -1 : n - 240);
    if (mode == 2) { const int t = n >> 8, j = n & 255; return j < 128 ? t * 128 + j : DFF + t * 128 + (j - 128); }
    return n;
}
__device__ __forceinline__ void wprep_load(f32x4 (&rg)[8], const float* __restrict__ src, int K, int Nsrc, int Ndst, int mode, size_t sbs, int item, int tid) {
    const int nx = Ndst / 256, ny = K / 64; const int bx = item % nx, by = (item / nx) % ny, bz = item / (nx * ny);
    const int tx = tid & 63, ty = tid >> 6, cm = colmap(mode, bx * 256 + tx * 4); const float* s = src + (size_t)bz * sbs + (size_t)(by * 64 + ty) * Nsrc + cm;
#pragma unroll
    for (int i = 0; i < 8; ++i) rg[i] = cm >= 0 ? *(const f32x4*)(s + (size_t)(8 * i) * Nsrc) : (f32x4){0.f, 0.f, 0.f, 0.f};
}
__device__ __forceinline__ void ph_wprep(const Ctx& c, const float* __restrict__ src, bf16_t* __restrict__ dst, int K, int Nsrc, int Ndst, int mode, int nbatch, size_t sbs, size_t dbs) {
    LAS float* tile = (LAS float*)c.lds;
    const int nx = Ndst / 256, ny = K / 64, total = nx * ny * nbatch;
    const int tid = c.tid, tx = tid & 63, ty = tid >> 6, n = tid >> 1, kh = tid & 1;
    f32x4 rg[8];
    int item = c.bid;
    if (item < total) wprep_load(rg, src, K, Nsrc, Ndst, mode, sbs, item, tid);
    for (; item < total; item += c.G) {
        __syncthreads();
#pragma unroll
        for (int i = 0; i < 8; ++i) *(LAS f32x4*)(tile + (ty + 8 * i) * 260 + tx * 4) = rg[i];
        __syncthreads();
        const int bx = item % nx, by = (item / nx) % ny, bz = item / (nx * ny);
        if (item + c.G < total) wprep_load(rg, src, K, Nsrc, Ndst, mode, sbs, item + c.G, tid);
        bf16_t* d = dst + (size_t)bz * dbs + (size_t)(bx * 256 + n) * K + by * 64 + kh * 32;
#pragma unroll
        for (int g = 0; g < 4; ++g) { unsigned p[4];
#pragma unroll
            for (int e = 0; e < 4; ++e) p[e] = pk2(tile[(kh * 32 + g * 8 + 2 * e) * 260 + n], tile[(kh * 32 + g * 8 + 2 * e + 1) * 260 + n]);
            *(u32x4*)(d + g * 8) = (u32x4){p[0], p[1], p[2], p[3]}; }
    }
    __syncthreads();
}
constexpr int WD_CH = 4, WD_N0 = (NINP / 256) * (DM / 64), WD_N1 = 4 * (DM / 256) * (BW / 64), WD_N2 = (DM / 256) * (DM / 64), WD_N3 = (2 * DFF / 256) * (DM / 64), WD_N4 = (DM / 256) * (DFF / 64);
constexpr int WD_TOTAL = WD_N0 + WD_N1 + WD_N2 + WD_N3 + WD_N4;
struct WDesc { const float* src; bf16_t* dst; int K, Nsrc, Ndst, mode, item; size_t sbs, dbs; };
__device__ __forceinline__ WDesc wd_decode(int it, const float* s0, const float* s1, const float* s2, const float* s3, const float* s4, bf16_t* d0, bf16_t* d1, bf16_t* d2, bf16_t* d3, bf16_t* d4) {
    WDesc d;
    if (it < WD_N0) { d.src = s0; d.dst = d0; d.K = DM; d.Nsrc = NIN; d.Ndst = NINP; d.mode = 1; d.item = it; d.sbs = 0; d.dbs = 0; }
    else if (it < WD_N0 + WD_N1) { d.src = s1; d.dst = d1; d.K = BW; d.Nsrc = DM; d.Ndst = DM; d.mode = 0; d.item = it - WD_N0; d.sbs = (size_t)BW * DM; d.dbs = (size_t)DM * BW; }
    else if (it < WD_N0 + WD_N1 + WD_N2) { d.src = s2; d.dst = d2; d.K = DM; d.Nsrc = DM; d.Ndst = DM; d.mode = 0; d.item = it - WD_N0 - WD_N1; d.sbs = 0; d.dbs = 0; }
    else if (it < WD_N0 + WD_N1 + WD_N2 + WD_N3) { d.src = s3; d.dst = d3; d.K = DM; d.Nsrc = 2 * DFF; d.Ndst = 2 * DFF; d.mode = 2; d.item = it - WD_N0 - WD_N1 - WD_N2; d.sbs = 0; d.dbs = 0; }
    else { d.src = s4; d.dst = d4; d.K = DFF; d.Nsrc = DM; d.Ndst = DM; d.mode = 0; d.item = it - WD_N0 - WD_N1 - WD_N2 - WD_N3; d.sbs = 0; d.dbs = 0; }
    return d;
}
__device__ __forceinline__ void ph_wprep_dyn(const Ctx& c, unsigned* ctr, const float* s0, const float* s1, const float* s2, const float* s3, const float* s4, bf16_t* d0, bf16_t* d1, bf16_t* d2, bf16_t* d3, bf16_t* d4) {
    LAS float* tile = (LAS float*)c.lds;
    LAS int* slot = (LAS int*)(c.lds + 64 * 260 * 4 + 64);
    const int tid = c.tid, n = tid >> 1, kh = tid & 1, tx = tid & 63, ty = tid >> 6;
    __syncthreads();
    if (tid == 0) slot[0] = (int)__hip_atomic_fetch_add(ctr, 1u, __ATOMIC_RELAXED, __HIP_MEMORY_SCOPE_AGENT);
    __syncthreads();
    int it = slot[0] * WD_CH, pos = 0; unsigned nxt_chunk = 0u;
    f32x4 rg[8];
    if (it < WD_TOTAL) { const WDesc d = wd_decode(it, s0, s1, s2, s3, s4, d0, d1, d2, d3, d4); wprep_load(rg, d.src, d.K, d.Nsrc, d.Ndst, d.mode, d.sbs, d.item, tid); }
    while (it < WD_TOTAL) {
        __syncthreads();
        if (tid == 0) { if (pos == 0) nxt_chunk = __hip_atomic_fetch_add(ctr, 1u, __ATOMIC_RELAXED, __HIP_MEMORY_SCOPE_AGENT); else if (pos == 1) slot[1] = (int)nxt_chunk; }
#pragma unroll
        for (int i = 0; i < 8; ++i) *(LAS f32x4*)(tile + (ty + 8 * i) * 260 + tx * 4) = rg[i];
        __syncthreads();
        const WDesc d = wd_decode(it, s0, s1, s2, s3, s4, d0, d1, d2, d3, d4);
        int nit, npos;
        if (pos + 1 < WD_CH) { nit = it + 1; npos = pos + 1; } else { nit = slot[1] * WD_CH; npos = 0; }
        if (nit < WD_TOTAL) { const WDesc dn = wd_decode(nit, s0, s1, s2, s3, s4, d0, d1, d2, d3, d4); wprep_load(rg, dn.src, dn.K, dn.Nsrc, dn.Ndst, dn.mode, dn.sbs, dn.item, tid); }
        { const int nx = d.Ndst / 256, ny = d.K / 64; const int bx = d.item % nx, by = (d.item / nx) % ny, bz = d.item / (nx * ny);
          bf16_t* dp = d.dst + (size_t)bz * d.dbs + (size_t)(bx * 256 + n) * d.K + by * 64 + kh * 32;
#pragma unroll
          for (int g = 0; g < 4; ++g) { unsigned p[4];
#pragma unroll
              for (int e = 0; e < 4; ++e) p[e] = pk2(tile[(kh * 32 + g * 8 + 2 * e) * 260 + n], tile[(kh * 32 + g * 8 + 2 * e + 1) * 260 + n]);
              *(u32x4*)(dp + g * 8) = (u32x4){p[0], p[1], p[2], p[3]}; } }
        it = nit; pos = npos;
    }
    __syncthreads();
}
__device__ __forceinline__ void ph_xprep(const Ctx& c, const float* __restrict__ xp, const float* __restrict__ xs, const float* __restrict__ mem, float* __restrict__ HF, bf16_t* __restrict__ HB, bf16_t* __restrict__ MEMB) {
    const size_t nH = (size_t)MPAD * DM / 4, nM = (size_t)512 * DM / 4;
    for (size_t i4 = (size_t)c.bid * 512 + c.tid; i4 < nH + nM; i4 += (size_t)c.G * 512) {
        if (i4 < nH) {
            const size_t e = i4 * 4; f32x4 v = (f32x4){0.f, 0.f, 0.f, 0.f};
            if (e < (size_t)MP * DM) v = *(const f32x4*)(xp + e); else if (e < (size_t)MT * DM) v = *(const f32x4*)(xs + (e - (size_t)MP * DM));
            if (HF != nullptr) *(f32x4*)(HF + e) = v;
            u32x2 w; w.x = pk2(v[0], v[1]); w.y = pk2(v[2], v[3]); *(u32x2*)(HB + e) = w;
        } else {
            const size_t e = (i4 - nH) * 4; const f32x4 v = *(const f32x4*)(mem + e); u32x2 w; w.x = pk2(v[0], v[1]); w.y = pk2(v[2], v[3]); *(u32x2*)(MEMB + e) = w;
        }
    }
}
__device__ __forceinline__ void ph_ln(const Ctx& c, const bf16_t* __restrict__ Y, const float* __restrict__ g, const float* __restrict__ b, float* __restrict__ XF, bf16_t* __restrict__ XB, float* __restrict__ OUT, int nrows, int nout) {
    const int lane = c.lane;
    for (int row = c.bid * 8 + c.wave; row < nrows; row += c.G * 8) {
        const bf16_t* y = Y + (size_t)row * DM; float v[4][8]; float s = 0.f;
#pragma unroll
        for (int j = 0; j < 4; ++j) { unpack8(*(const u32x4*)(y + j * 512 + lane * 8), v[j]);
#pragma unroll
            for (int e2 = 0; e2 < 8; ++e2) s += v[j][e2]; }
        const float mean = wave_sum(s) * (1.0f / DM); float q = 0.f;
#pragma unroll
        for (int j = 0; j < 4; ++j)
#pragma unroll
            for (int e2 = 0; e2 < 8; ++e2) { const float d = v[j][e2] - mean; q += d * d; }
        const float rstd = rsqrtf(wave_sum(q) * (1.0f / DM) + 1e-5f);
#pragma unroll
        for (int j = 0; j < 4; ++j) { const int cc = j * 512 + lane * 8; const f32x4 g0 = *(const f32x4*)(g + cc), g1 = *(const f32x4*)(g + cc + 4), b0 = *(const f32x4*)(b + cc), b1 = *(const f32x4*)(b + cc + 4);
            const f32x4 o0 = ((f32x4){v[j][0], v[j][1], v[j][2], v[j][3]} - mean) * rstd * g0 + b0, o1 = ((f32x4){v[j][4], v[j][5], v[j][6], v[j][7]} - mean) * rstd * g1 + b1;
            const size_t off = (size_t)row * DM + cc;
            if (XF != nullptr) { *(f32x4*)(XF + off) = o0; *(f32x4*)(XF + off + 4) = o1; }
            *(u32x4*)(XB + off) = (u32x4){pk2(o0[0], o0[1]), pk2(o0[2], o0[3]), pk2(o1[0], o1[1]), pk2(o1[2], o1[3])};
            if (OUT != nullptr && row < nout) { *(f32x4*)(OUT + off) = o0; *(f32x4*)(OUT + off + 4) = o1; } }
    }
}
__device__ __forceinline__ void ph_softmax256(const Ctx& c, const float* __restrict__ SC, bf16_t* __restrict__ P, int nrows) {
    const int lane = c.lane;
    for (int row = c.bid * 8 + c.wave; row < nrows; row += c.G * 8) {
        const f32x4 v = *(const f32x4*)(SC + (size_t)row * 256 + lane * 4);
        const float mx = wave_max(fmaxf(fmaxf(v[0], v[1]), fmaxf(v[2], v[3])));
        f32x4 e; e[0] = __expf(v[0] - mx); e[1] = __expf(v[1] - mx); e[2] = __expf(v[2] - mx); e[3] = __expf(v[3] - mx);
        const float inv = 1.0f / wave_sum((e[0] + e[1]) + (e[2] + e[3]));
        u32x2 w; w.x = pk2(e[0] * inv, e[1] * inv); w.y = pk2(e[2] * inv, e[3] * inv); *(u32x2*)(P + (size_t)row * 256 + lane * 4) = w;
    }
}
__device__ __forceinline__ void ph_copy_outs(const Ctx& c, const bf16_t* __restrict__ U, const float* __restrict__ ck, const float* __restrict__ cv, float* __restrict__ out, int layer) {
    constexpr int nA = PB * 128 * 128, nB = SB * 128 * 128, nC = PB * RWC, nD = SB * RWC;
    for (int i = c.bid * 512 + c.tid; i < nA + nB + nC + nD; i += c.G * 512) {
        if (i < nA) { const int b = i / 16384, j = (i >> 7) & 127, cc = i & 127; const size_t ur = (size_t)(b * PS + PS - 128 + j) * NINP;
            out[O_SWKP + (size_t)layer * nA + i] = bf2f(U[ur + U_SK + cc]); out[O_SWVP + (size_t)layer * nA + i] = bf2f(U[ur + U_SV + cc]); continue; }
        int k = i - nA;
        if (k < nB) { const int sq = k / 16384, j = (k >> 7) & 127, cc = k & 127; float kv, vv;
            if (j < 124) { const size_t o = ((size_t)sq * 128 + j + 4) * 128 + cc; kv = ck[o]; vv = cv[o]; }
            else { const size_t ur = (size_t)(MP + sq * SS + j - 124) * NINP; kv = bf2f(U[ur + U_SK + cc]); vv = bf2f(U[ur + U_SV + cc]); }
            out[O_SWKS + (size_t)layer * nB + k] = kv; out[O_SWVS + (size_t)layer * nB + k] = vv; continue; }
        k -= nB;
        if (k < nC) { const int b = k / RWC, cc = k - b * RWC; out[O_RSP + (size_t)layer * nC + k] = bf2f(U[(size_t)(b * PS + PS - 1) * NINP + U_RU + cc]); continue; }
        k -= nC;
        { const int sq = k / RWC, cc = k - sq * RWC; out[O_RSS + (size_t)layer * nD + k] = bf2f(U[(size_t)(MP + sq * SS + SS - 1) * NINP + U_RU + cc]); }
    }
}

__device__ __forceinline__ void seq_info(int sq, int& row0, int& L) { if (sq < PB) { row0 = sq * PS; L = PS; } else { row0 = MP + (sq - PB) * SS; L = SS; } }

__device__ __forceinline__ void ph_gla_naive(const Ctx& c, const bf16_t* __restrict__ U, const float* __restrict__ s0, const float* __restrict__ a_up, const float* __restrict__ a_b,
                                             const float* __restrict__ ng, const float* __restrict__ nb, bf16_t* __restrict__ OB, float* __restrict__ outP, float* __restrict__ outS) {
    LAS float* qs = (LAS float*)c.lds;
    LAS float* ks = qs + 16 * 128; LAS float* as = ks + 16 * 128; LAS float* os = as + 16 * 128;
    const int kh = c.tid >> 8, vt = c.tid & 255, lane = c.lane;
    for (int u = c.bid; u < (PB + SB) * 4; u += c.G) {
        const int sq = u >> 2, h = u & 3;
        int row0, L; seq_info(sq, row0, L);
        float S[64];
        if (sq >= PB) { const float* p = s0 + (((size_t)(sq - PB) * 4 + h) * 128 + kh * 64) * 256 + vt;
#pragma unroll
            for (int kk = 0; kk < 64; ++kk) S[kk] = p[(size_t)kk * 256]; }
        else {
#pragma unroll
            for (int kk = 0; kk < 64; ++kk) S[kk] = 0.f; }
        for (int t0 = 0; t0 < L; t0 += 16) {
            const int nT = (L - t0) < 16 ? (L - t0) : 16;
            for (int idx = c.tid; idx < nT * 128; idx += 512) {
                const int tt = idx >> 7, kk = idx & 127; const bf16_t* ur = U + (size_t)(row0 + t0 + tt) * NINP;
                qs[idx] = bf2f(ur[U_GQ + h * 128 + kk]) * 0.08838834764831845f; ks[idx] = bf2f(ur[U_GK + h * 128 + kk]);
                float x = a_b[h * 128 + kk];
#pragma unroll
                for (int r = 0; r < 16; ++r) x += bf2f(ur[U_GA + r]) * a_up[r * 512 + h * 128 + kk];
                const float ls = (fminf(x, 0.f) - log1pf(__expf(-fabsf(x)))) * (1.0f / 16.0f);
                as[idx] = __expf(ls);
            }
            __syncthreads();
            for (int tt = 0; tt < nT; ++tt) {
                const float v = bf2f(U[(size_t)(row0 + t0 + tt) * NINP + U_GV + h * 256 + vt]); float o = 0.f; const int lb = tt * 128 + kh * 64;
#pragma unroll
                for (int kk = 0; kk < 64; ++kk) { S[kk] = as[lb + kk] * S[kk] + ks[lb + kk] * v; o += qs[lb + kk] * S[kk]; }
                os[(kh * 16 + tt) * 256 + vt] = o;
            }
            __syncthreads();
            for (int tt = c.wave; tt < nT; tt += 8) {
                float x[4]; float s = 0.f;
#pragma unroll
                for (int j = 0; j < 4; ++j) { x[j] = os[tt * 256 + lane + 64 * j] + os[(16 + tt) * 256 + lane + 64 * j]; s += x[j]; }
                const float mean = wave_sum(s) * (1.0f / 256.0f); float q = 0.f;
#pragma unroll
                for (int j = 0; j < 4; ++j) { const float d = x[j] - mean; q += d * d; }
                const float rstd = rsqrtf(wave_sum(q) * (1.0f / 256.0f) + 1e-5f);
                const size_t row = (size_t)(row0 + t0 + tt);
#pragma unroll
                for (int j = 0; j < 4; ++j) { const int cc = h * 256 + lane + 64 * j; const float n = (x[j] - mean) * rstd * ng[cc] + nb[cc];
                    const float gr = bf2f(U[row * NINP + U_GR + cc]); OB[row * BW + cc] = f2bf(n * gr * sigmoidf_(gr)); }
            }
            __syncthreads();
        }
        float* op = (sq < PB ? outP + (((size_t)sq * 4 + h) * 128 + kh * 64) * 256 : outS + (((size_t)(sq - PB) * 4 + h) * 128 + kh * 64) * 256) + vt;
#pragma unroll
        for (int kk = 0; kk < 64; ++kk) op[(size_t)kk * 256] = S[kk];
    }
}

__device__ __forceinline__ f32x4 mma16(bf16x8 x, bf16x8 y, f32x4 c) { return __builtin_amdgcn_mfma_f32_16x16x32_bf16(x, y, c, 0, 0, 0); }
__device__ __forceinline__ bf16x8 pack_acc(const f32x4& a, const f32x4& b) {
    u32x4 p; p.x = pk2(a[0], a[1]); p.y = pk2(a[2], a[3]); p.z = pk2(b[0], b[1]); p.w = pk2(b[2], b[3]); return __builtin_bit_cast(bf16x8, p);
}
__device__ __forceinline__ void gla_chunk_info(int u, int& row0, int& ntok, int& h) {
    if (u < 512) { const int b = u >> 8; h = (u >> 6) & 3; row0 = b * PS + (u & 63) * 64; ntok = 64; }
    else { const int s = u - 512; h = s & 3; row0 = MP + (s >> 2) * SS; ntok = SS; }
}
__device__ __forceinline__ void ph_gla_pre(const Ctx& c, const bf16_t* __restrict__ U, const float* __restrict__ a_up, const float* __restrict__ a_b,
                                           bf16_t* __restrict__ QD, bf16_t* __restrict__ KHT, bf16_t* __restrict__ EE, bf16_t* __restrict__ VT, float* __restrict__ GC) {
    LAS float* ga_l = (LAS float*)c.lds;
    LAS float* tot = ga_l + 64 * 16;
    LAS bf16_t* Qd_l = (LAS bf16_t*)(tot + 4 * 128);
    LAS bf16_t* Kn_l = Qd_l + 64 * 136;
    LAS bf16_t* v_l = Kn_l + 64 * 136;
    LAS bf16_t* qr_l = v_l + 64 * 264;
    LAS bf16_t* kr_l = qr_l + 64 * 136;
    const int tid = c.tid, lane = c.lane, r = lane & 15, q = lane >> 4, w = c.wave;
    for (int u = (c.bid + c.G / 2) % c.G; u < GL_NCH; u += c.G) {
        int row0, ntok, h; gla_chunk_info(u, row0, ntok, h);
        for (int i = tid; i < 64 * 16; i += 512) { const int t = i >> 4, rr = i & 15; ga_l[i] = t < ntok ? bf2f(U[(size_t)(row0 + t) * NINP + U_GA + rr]) : 0.f; }
        for (int i = tid; i < 64 * 32; i += 512) { const int t = i >> 5, c8 = i & 31; u32x4 vv = (u32x4){0u, 0u, 0u, 0u};
            if (t < ntok) vv = *(const u32x4*)(U + (size_t)(row0 + t) * NINP + U_GV + h * 256 + c8 * 8);
            *(LAS u32x4*)(v_l + t * 264 + c8 * 8) = vv; }
        for (int i = tid; i < 64 * 16; i += 512) { const int t = i >> 4, c8 = i & 15; u32x4 qv = (u32x4){0u, 0u, 0u, 0u}, kv = qv;
            if (t < ntok) { const bf16_t* ur = U + (size_t)(row0 + t) * NINP + h * 128 + c8 * 8; qv = *(const u32x4*)(ur + U_GQ); kv = *(const u32x4*)(ur + U_GK); }
            *(LAS u32x4*)(qr_l + t * 136 + c8 * 8) = qv; *(LAS u32x4*)(kr_l + t * 136 + c8 * 8) = kv; }
        __syncthreads();
        const int kk = tid & 127, tq = tid >> 7;
        float cum[16];
        { float aup[16];
#pragma unroll
          for (int rr = 0; rr < 16; ++rr) aup[rr] = a_up[rr * 512 + h * 128 + kk];
          const float ab = a_b[h * 128 + kk]; float run = 0.f;
#pragma unroll
          for (int j = 0; j < 16; ++j) { const int t = tq * 16 + j; float x = ab;
#pragma unroll
              for (int rr = 0; rr < 16; ++rr) x += ga_l[t * 16 + rr] * aup[rr];
              const float la = t < ntok ? (fminf(x, 0.f) - __logf(1.0f + __expf(-fabsf(x)))) * (1.0f / 16.0f) : 0.f;
              run += la; cum[j] = run; }
          tot[tq * 128 + kk] = run; }
        __syncthreads();
        { float prefix = 0.f, bC = 0.f;
#pragma unroll
          for (int g = 0; g < 4; ++g) { const float tv = tot[g * 128 + kk]; bC += tv; if (g < tq) prefix += tv; }
          unsigned khp[8];
#pragma unroll
          for (int j = 0; j < 16; j += 2) { float kh2[2];
#pragma unroll
              for (int e = 0; e < 2; ++e) { const int t = tq * 16 + j + e; const float b = prefix + cum[j + e]; const float qv = bf2f(qr_l[t * 136 + kk]), kv = bf2f(kr_l[t * 136 + kk]);
                  Qd_l[t * 136 + kk] = f2bf(qv * __expf(b) * 0.08838834764831845f); Kn_l[t * 136 + kk] = f2bf(kv * __expf(-b)); kh2[e] = kv * __expf(bC - b); }
              khp[j >> 1] = pk2(kh2[0], kh2[1]); }
          bf16_t* kp = KHT + (size_t)u * 8192 + kk * 64 + tq * 16;
          *(u32x4*)kp = (u32x4){khp[0], khp[1], khp[2], khp[3]}; *(u32x4*)(kp + 8) = (u32x4){khp[4], khp[5], khp[6], khp[7]};
          if (tq == 0) GC[(size_t)u * 128 + kk] = __expf(bC); }
        __syncthreads();
        { const int tb = w >> 1;
#pragma unroll
          for (int e = 0; e < 2; ++e) { const int ib = (w & 1) * 2 + e; f32x4 d = (f32x4){0.f, 0.f, 0.f, 0.f};
              if (ib <= tb) {
                  bf16x8 kf4[4], qf4[4];
#pragma unroll
                  for (int ks = 0; ks < 4; ++ks) { kf4[ks] = *(const LAS bf16x8*)(Kn_l + (ib * 16 + r) * 136 + ks * 32 + q * 8); qf4[ks] = *(const LAS bf16x8*)(Qd_l + (tb * 16 + r) * 136 + ks * 32 + q * 8); }
                  __builtin_amdgcn_sched_barrier(0);
#pragma unroll
                  for (int ks = 0; ks < 4; ++ks) d = mma16(kf4[ks], qf4[ks], d); }
              const int t = tb * 16 + r, i0 = ib * 16 + q * 4;
#pragma unroll
              for (int jj = 0; jj < 4; ++jj) if (i0 + jj > t) d[jj] = 0.f;
              u32x2 o; o.x = pk2(d[0], d[1]); o.y = pk2(d[2], d[3]); *(u32x2*)(EE + (size_t)u * 4096 + t * 64 + i0) = o; } }
        for (int i = tid; i < 64 * 16; i += 512) { const int t = i >> 4, c8 = i & 15; *(u32x4*)(QD + (size_t)u * 8192 + t * 128 + c8 * 8) = *(const LAS u32x4*)(Qd_l + t * 136 + c8 * 8); }
        { const int val = tid & 255, th = tid >> 8;
#pragma unroll
          for (int tg = 0; tg < 4; ++tg) { const int t0 = th * 32 + tg * 8; unsigned p4[4];
#pragma unroll
              for (int e = 0; e < 4; ++e) p4[e] = (unsigned)v_l[(t0 + 2 * e) * 264 + val] | ((unsigned)v_l[(t0 + 2 * e + 1) * 264 + val] << 16);
              *(u32x4*)(VT + (size_t)u * 16384 + val * 64 + t0) = (u32x4){p4[0], p4[1], p4[2], p4[3]}; } }
        __syncthreads();
    }
}
struct GlaStage { u32x4 qd[2], kh[2], e, vt, gc; };
__device__ __forceinline__ void gla_stage_load(GlaStage& s, const bf16_t* __restrict__ QD, const bf16_t* __restrict__ KHT, const bf16_t* __restrict__ EE, const bf16_t* __restrict__ VT, const float* __restrict__ GC,
                                               int ch, int sl, int tid) {
    const bf16_t* qp = QD + (size_t)ch * 8192 + tid * 8; s.qd[0] = *(const u32x4*)qp; s.qd[1] = *(const u32x4*)(qp + 4096);
    const bf16_t* kp = KHT + (size_t)ch * 8192 + tid * 8; s.kh[0] = *(const u32x4*)kp; s.kh[1] = *(const u32x4*)(kp + 4096);
    s.e = *(const u32x4*)(EE + (size_t)ch * 4096 + tid * 8);
    s.vt = *(const u32x4*)(VT + (size_t)ch * 16384 + sl * 4096 + tid * 8);
    if (tid < 32) s.gc = *(const u32x4*)(GC + (size_t)ch * 128 + tid * 4);
}
constexpr int GS_KH = 8704, GS_E = 17920, GS_VT = 22528, GS_GC = 27136, GS_EL = 27392;
__device__ __forceinline__ void gla_stage_store(const GlaStage& s, LAS bf16_t* b, int tid) {
    *(LAS u32x4*)(b + (tid >> 4) * 136 + (tid & 15) * 8) = s.qd[0]; *(LAS u32x4*)(b + (32 + (tid >> 4)) * 136 + (tid & 15) * 8) = s.qd[1];
    *(LAS u32x4*)(b + GS_KH + (tid >> 3) * 72 + (tid & 7) * 8) = s.kh[0]; *(LAS u32x4*)(b + GS_KH + (64 + (tid >> 3)) * 72 + (tid & 7) * 8) = s.kh[1];
    *(LAS u32x4*)(b + GS_E + (tid >> 3) * 72 + (tid & 7) * 8) = s.e; *(LAS u32x4*)(b + GS_VT + (tid >> 3) * 72 + (tid & 7) * 8) = s.vt;
    if (tid < 32) *(LAS u32x4*)(b + GS_GC + tid * 8) = s.gc;
}
__device__ __forceinline__ void ph_gla_seq(const Ctx& c, int boff, const bf16_t* __restrict__ QD, const bf16_t* __restrict__ KHT, const bf16_t* __restrict__ EE, const bf16_t* __restrict__ VT, const float* __restrict__ GC,
                                           const float* __restrict__ s0, float* __restrict__ outP, float* __restrict__ outS, bf16_t* __restrict__ OB) {
    LAS bf16_t* stg = (LAS bf16_t*)c.lds;
    LAS bf16_t* T_l = stg + 2 * GS_EL;
    const int tid = c.tid, lane = c.lane, r = lane & 15, q = lane >> 4, w = c.wave;
    const int side = c.bid < 32 ? c.bid : c.bid - 64, nside = c.G - 64;
    for (int u = (c.bid >= boff && c.bid < boff + 32) ? c.bid - boff : ((c.bid < 32 || c.bid >= 96) ? 32 + side : 32 + 512); u < 32 + 512; u = u < 32 ? 32 + 512 : u + nside) {
        int h, sl, nch, ch0, row0, ntok; const float* sp = nullptr; float* op;
        if (u < 32) { const int b = u >> 4; h = (u >> 2) & 3; sl = u & 3; nch = 64; ch0 = (b * 4 + h) * 64; row0 = b * PS; ntok = 64; op = outP + (size_t)(b * 4 + h) * 32768; }
        else { const int s = u - 32, sq = s >> 4; h = (s >> 2) & 3; sl = s & 3; nch = 1; ch0 = 512 + sq * 4 + h; row0 = MP + sq * SS; ntok = SS; sp = s0 + (size_t)(sq * 4 + h) * 32768; op = outS + (size_t)(sq * 4 + h) * 32768; }
        f32x4 acc[4];
#pragma unroll
        for (int vb = 0; vb < 4; ++vb)
#pragma unroll
            for (int jj = 0; jj < 4; ++jj) acc[vb][jj] = sp ? sp[(size_t)(w * 16 + q * 4 + jj) * 256 + sl * 64 + vb * 16 + r] : 0.f;
        GlaStage R0, R1, R2;
        gla_stage_load(R0, QD, KHT, EE, VT, GC, ch0, sl, tid);
        if (1 < nch) gla_stage_load(R1, QD, KHT, EE, VT, GC, ch0 + 1, sl, tid);
        if (2 < nch) gla_stage_load(R2, QD, KHT, EE, VT, GC, ch0 + 2, sl, tid);
        __syncthreads();
        gla_stage_store(R0, stg, tid);
        if (3 < nch) gla_stage_load(R0, QD, KHT, EE, VT, GC, ch0 + 3, sl, tid);
#define GLA_STEP(ci, RN) do { \
            LAS bf16_t* Tb = T_l + ((ci) & 1) * 64 * 136; const LAS bf16_t* sb = stg + ((ci) & 1) * GS_EL; \
            _Pragma("unroll") for (int vb = 0; vb < 4; ++vb) { u32x2 o; o.x = pk2(acc[vb][0], acc[vb][1]); o.y = pk2(acc[vb][2], acc[vb][3]); *(LAS u32x2*)(Tb + (vb * 16 + r) * 136 + w * 16 + q * 4) = o; } \
            __syncthreads(); \
            if ((ci) + 1 < nch) { gla_stage_store(RN, stg + (((ci) + 1) & 1) * GS_EL, tid); if ((ci) + 4 < nch) gla_stage_load(RN, QD, KHT, EE, VT, GC, ch0 + (ci) + 4, sl, tid); } \
            { const int rb = w >> 1, t = rb * 16 + r; bf16x8 qf[4], ef[2]; \
              _Pragma("unroll") for (int ks = 0; ks < 4; ++ks) qf[ks] = *(const LAS bf16x8*)(sb + (rb * 16 + r) * 136 + ks * 32 + q * 8); \
              _Pragma("unroll") for (int ks = 0; ks < 2; ++ks) ef[ks] = *(const LAS bf16x8*)(sb + GS_E + (rb * 16 + r) * 72 + ks * 32 + q * 8); \
              bf16x8 tf[2][4], vf[2][2]; \
              _Pragma("unroll") for (int e2 = 0; e2 < 2; ++e2) { const int cb = (w & 1) * 2 + e2; \
                  _Pragma("unroll") for (int ks = 0; ks < 4; ++ks) tf[e2][ks] = *(const LAS bf16x8*)(Tb + (cb * 16 + r) * 136 + ks * 32 + q * 8); \
                  _Pragma("unroll") for (int ks = 0; ks < 2; ++ks) vf[e2][ks] = *(const LAS bf16x8*)(sb + GS_VT + (cb * 16 + r) * 72 + ks * 32 + q * 8); } \
              __builtin_amdgcn_sched_barrier(0); \
              _Pragma("unroll") for (int e2 = 0; e2 < 2; ++e2) { const int cb = (w & 1) * 2 + e2; f32x4 y = (f32x4){0.f, 0.f, 0.f, 0.f}; \
                  _Pragma("unroll") for (int ks = 0; ks < 4; ++ks) y = mma16(tf[e2][ks], qf[ks], y); \
                  _Pragma("unroll") for (int ks = 0; ks < 2; ++ks) y = mma16(vf[e2][ks], ef[ks], y); \
                  if (t < ntok) { u32x2 o; o.x = pk2(y[0], y[1]); o.y = pk2(y[2], y[3]); *(u32x2*)(OB + (size_t)(row0 + (ci) * 64 + t) * BW + h * 256 + sl * 64 + cb * 16 + q * 4) = o; } } } \
            { const f32x4 gcv = *(const LAS f32x4*)((const LAS float*)(sb + GS_GC) + w * 16 + q * 4); bf16x8 kf[2]; \
              _Pragma("unroll") for (int ks = 0; ks < 2; ++ks) kf[ks] = *(const LAS bf16x8*)(sb + GS_KH + (w * 16 + r) * 72 + ks * 32 + q * 8); \
              bf16x8 vs[4][2]; \
              _Pragma("unroll") for (int vb = 0; vb < 4; ++vb) _Pragma("unroll") for (int ks = 0; ks < 2; ++ks) vs[vb][ks] = *(const LAS bf16x8*)(sb + GS_VT + (vb * 16 + r) * 72 + ks * 32 + q * 8); \
              __builtin_amdgcn_sched_barrier(0); \
              _Pragma("unroll") for (int vb = 0; vb < 4; ++vb) { acc[vb] = acc[vb] * gcv; \
                  _Pragma("unroll") for (int ks = 0; ks < 2; ++ks) acc[vb] = mma16(kf[ks], vs[vb][ks], acc[vb]); } } \
        } while (0)
#pragma unroll 1
        for (int ci = 0; ci < nch; ci += 3) {
            GLA_STEP(ci, R1);
            if (ci + 1 < nch) GLA_STEP(ci + 1, R2);
            if (ci + 2 < nch) GLA_STEP(ci + 2, R0);
        }
#undef GLA_STEP
#pragma unroll
        for (int vb = 0; vb < 4; ++vb)
#pragma unroll
            for (int jj = 0; jj < 4; ++jj) op[(size_t)(w * 16 + q * 4 + jj) * 256 + sl * 64 + vb * 16 + r] = acc[vb][jj];
        __syncthreads();
    }
}
__device__ __forceinline__ void ph_gla_fin(const Ctx& c, const bf16_t* __restrict__ U, const float* __restrict__ ng, const float* __restrict__ nb, const bf16_t* __restrict__ RAW, bf16_t* __restrict__ OB) {
    const int lane = c.lane, hs = lane >> 5, l32 = lane & 31;
    for (int i = c.bid * 8 + c.wave; i < MT * 2; i += c.G * 8) {
        const int row = i >> 1, h = (i & 1) * 2 + hs, cc = h * 256 + l32 * 8; bf16_t* p = OB + (size_t)row * BW + cc;
        float x[8], gr[8]; unpack8(*(const u32x4*)(RAW + (size_t)row * BW + cc), x); unpack8(*(const u32x4*)(U + (size_t)row * NINP + U_GR + cc), gr);
        float s = 0.f;
#pragma unroll
        for (int j = 0; j < 8; ++j) s += x[j];
#pragma unroll
        for (int o = 16; o > 0; o >>= 1) s += __shfl_xor(s, o, 64);
        const float mean = s * (1.0f / 256.0f); float qq = 0.f;
#pragma unroll
        for (int j = 0; j < 8; ++j) { const float d = x[j] - mean; qq += d * d; }
#pragma unroll
        for (int o = 16; o > 0; o >>= 1) qq += __shfl_xor(qq, o, 64);
        const float rstd = rsqrtf(qq * (1.0f / 256.0f) + 1e-5f);
        const f32x4 g0 = *(const f32x4*)(ng + cc), g1 = *(const f32x4*)(ng + cc + 4), b0 = *(const f32x4*)(nb + cc), b1 = *(const f32x4*)(nb + cc + 4); float o8[8];
#pragma unroll
        for (int j = 0; j < 8; ++j) o8[j] = ((x[j] - mean) * rstd * (j < 4 ? g0[j] : g1[j - 4]) + (j < 4 ? b0[j] : b1[j - 4])) * gr[j] * sigmoidf_(gr[j]);
        *(u32x4*)p = (u32x4){pk2(o8[0], o8[1]), pk2(o8[2], o8[3]), pk2(o8[4], o8[5]), pk2(o8[6], o8[7])};
    }
}

template <bool ISBF> __device__ __forceinline__ void swa_step(const float (&q)[32], float (&acc)[32], float& m, float& l, const void* kp, const void* vp, float slope, float dist) {
    float s = 0.f;
#pragma unroll
    for (int j = 0; j < 4; ++j) { float x[8];
        if (ISBF) unpack8(*(const u32x4*)((const bf16_t*)kp + j * 8), x);
        else { const f32x4 a = *(const f32x4*)((const float*)kp + j * 8), b = *(const f32x4*)((const float*)kp + j * 8 + 4); x[0] = a[0]; x[1] = a[1]; x[2] = a[2]; x[3] = a[3]; x[4] = b[0]; x[5] = b[1]; x[6] = b[2]; x[7] = b[3]; }
#pragma unroll
        for (int d = 0; d < 8; ++d) s += q[j * 8 + d] * x[d]; }
    s += __shfl_xor(s, 1, 64);
    s = s * 0.125f - slope * dist;
    const float mn = fmaxf(m, s), cc = __expf(m - mn), p = __expf(s - mn);
    l = l * cc + p;
#pragma unroll
    for (int j = 0; j < 4; ++j) { float x[8];
        if (ISBF) unpack8(*(const u32x4*)((const bf16_t*)vp + j * 8), x);
        else { const f32x4 a = *(const f32x4*)((const float*)vp + j * 8), b = *(const f32x4*)((const float*)vp + j * 8 + 4); x[0] = a[0]; x[1] = a[1]; x[2] = a[2]; x[3] = a[3]; x[4] = b[0]; x[5] = b[1]; x[6] = b[2]; x[7] = b[3]; }
#pragma unroll
        for (int d = 0; d < 8; ++d) acc[j * 8 + d] = acc[j * 8 + d] * cc + p * x[d]; }
    m = mn;
}
__device__ __forceinline__ void ph_swa_naive(const Ctx& c, const bf16_t* __restrict__ U, const float* __restrict__ ck, const float* __restrict__ cv, const float* __restrict__ sinks, bf16_t* __restrict__ OB) {
    for (int gid = c.bid * 512 + c.tid; gid < MS * 32; gid += c.G * 512) {
        const int dh = gid & 1, h = (gid >> 1) & 15, row = MP + (gid >> 5), kvh = h >> 3, co = kvh * 64 + dh * 32;
        float q[32], acc[32];
#pragma unroll
        for (int j = 0; j < 4; ++j) { float x[8]; unpack8(*(const u32x4*)(U + (size_t)row * NINP + U_SQ + h * 64 + dh * 32 + j * 8), x);
#pragma unroll
            for (int d = 0; d < 8; ++d) { q[j * 8 + d] = x[d]; acc[j * 8 + d] = 0.f; } }
        const float slope = exp2f(-0.5f * (float)(h + 1)); float m = sinks[h], l = 1.0f;
        if (row < MP) {
            const int t = row % PS, base = row - t, lo = t - 128 < 0 ? 0 : t - 128;
            for (int s = lo; s <= t; ++s) { const bf16_t* ur = U + (size_t)(base + s) * NINP;
                swa_step<true>(q, acc, m, l, ur + U_SK + co, ur + U_SV + co, slope, (float)(t - s)); }
        } else {
            const int sq = (row - MP) / SS, i = (row - MP) % SS;
            for (int idx = i; idx <= 128 + i; ++idx) {
                if (idx < 128) { const size_t o = ((size_t)sq * 128 + idx) * 128 + co; swa_step<false>(q, acc, m, l, ck + o, cv + o, slope, (float)(128 + i - idx)); }
                else { const bf16_t* ur = U + (size_t)(MP + sq * SS + idx - 128) * NINP; swa_step<true>(q, acc, m, l, ur + U_SK + co, ur + U_SV + co, slope, (float)(128 + i - idx)); }
            }
        }
        const float inv = 1.0f / l; bf16_t* op = OB + (size_t)row * BW + h * 64 + dh * 32;
#pragma unroll
        for (int j = 0; j < 4; ++j) { u32x4 w; w.x = pk2(acc[j * 8] * inv, acc[j * 8 + 1] * inv); w.y = pk2(acc[j * 8 + 2] * inv, acc[j * 8 + 3] * inv);
            w.z = pk2(acc[j * 8 + 4] * inv, acc[j * 8 + 5] * inv); w.w = pk2(acc[j * 8 + 6] * inv, acc[j * 8 + 7] * inv); *(u32x4*)(op + j * 8) = w; }
    }
}

__device__ __forceinline__ void ph_rwkv_prep(const Ctx& c, const bf16_t* __restrict__ U, const float* __restrict__ shift, const float* __restrict__ mu, const float* __restrict__ w0, const float* __restrict__ w2,
                                             const float* __restrict__ a0, const float* __restrict__ a2, const float* __restrict__ g2, const float* __restrict__ k_k, const float* __restrict__ k_a,
                                             const float* __restrict__ r_k, float* __restrict__ RW) {
    LAS float* xm = (LAS float*)c.lds; LAS float* tw = xm + RWC; LAS float* ad = tw + 64; LAS float* sg = ad + 64;
    const int tid = c.tid;
    float* R = RW; float* WD = RW + (size_t)MPAD * BW; float* K2 = WD + (size_t)MPAD * BW; float* V = K2 + (size_t)MPAD * BW; float* KK = V + (size_t)MPAD * BW;
    float* BV = KK + (size_t)MPAD * BW; float* G = BV + (size_t)MPAD * BW; float* BON = G + (size_t)MPAD * BW;
    for (int row = c.bid; row < MT; row += c.G) {
        const bf16_t* ur = U + (size_t)row * NINP + U_RU; const bf16_t* pr = ur - NINP; const float* ps = nullptr; bool first;
        if (row < MP) first = (row % PS) == 0; else { first = ((row - MP) % SS) == 0; ps = shift + (size_t)((row - MP) / SS) * RWC; }
        for (int cc = tid; cc < RWC; cc += 512) { const float x = bf2f(ur[cc]); const float s = first ? (ps ? ps[cc] : 0.f) : bf2f(pr[cc]); xm[cc] = x + (s - x) * mu[cc]; }
        __syncthreads();
        if (tid < 64) { tw[tid] = tanhf(xm[3072 + tid]); ad[tid] = xm[3136 + tid]; }
        if (tid >= 128 && tid < 256) sg[tid - 128] = sigmoidf_(xm[3200 + tid - 128]);
        __syncthreads();
        for (int qd = 0; qd < 2; ++qd) {
            const int cc = qd * 512 + tid; float accw = w0[cc], acca = a0[cc], accg = 0.f;
#pragma unroll 4
            for (int j = 0; j < 64; ++j) { accw += tw[j] * w2[j * BW + cc]; acca += ad[j] * a2[j * BW + cc]; }
#pragma unroll 4
            for (int j = 0; j < 128; ++j) accg += sg[j] * g2[j * BW + cc];
            const float lw = -softplusf_(-accw) - 0.5f, decay = __expf(-__expf(lw)), a = sigmoidf_(acca);
            const float r = xm[cc], k = xm[1024 + cc], v = xm[2048 + cc];
            const float kkr = k * k_k[cc]; const float ss = wave_sum(kkr * kkr); const float kk = kkr / fmaxf(sqrtf(ss), 1e-12f);
            const float k2 = k * (1.0f + (a - 1.0f) * k_a[cc]); const float rk = wave_sum(r * k2 * r_k[cc]);
            const size_t o = (size_t)row * BW + cc;
            R[o] = r; WD[o] = decay; K2[o] = k2; V[o] = v; KK[o] = kk; BV[o] = kk * a; G[o] = accg; BON[o] = rk * v;
        }
        __syncthreads();
    }
}
__device__ __forceinline__ int kperm_pos(int k) { return (k & ~31) + 8 * ((k >> 2) & 3) + 4 * ((k >> 4) & 1) + (k & 3); }
__device__ __forceinline__ void ph_swa_prompt(const Ctx& c, const bf16_t* __restrict__ U, const float* __restrict__ sinks, bf16_t* __restrict__ OB) {
    LAS bf16_t* K_l = (LAS bf16_t*)c.lds;
    LAS bf16_t* VT_l = K_l + 192 * 72;
    const int tid = c.tid, lane = c.lane, r = lane & 15, q = lane >> 4, w = c.wave;
    for (int u = c.bid; u < PB * 64 * 2; u += c.G) {
        const int b = u >> 7, qb = (u >> 1) & 63, kvh = u & 1, h = kvh * 8 + w;
        const int tok0 = qb * 64 - 128;
        const size_t seq0 = (size_t)b * PS;
        const bf16_t* qbase = U + (seq0 + qb * 64 + r) * NINP + U_SQ + h * 64 + q * 8;
        bf16x8 qn0 = *(const bf16x8*)qbase, qn1 = *(const bf16x8*)(qbase + 32);
        { u32x4 kv3[3], vv3[3];
#pragma unroll
          for (int k3 = 0; k3 < 3; ++k3) { const int idx = tid + 512 * k3, kl = idx >> 3, c8 = idx & 7, tk = tok0 + kl; kv3[k3] = (u32x4){0u, 0u, 0u, 0u}; vv3[k3] = kv3[k3];
            if (tk >= 0) { const bf16_t* ur = U + (seq0 + tk) * NINP; kv3[k3] = *(const u32x4*)(ur + U_SK + kvh * 64 + c8 * 8); vv3[k3] = *(const u32x4*)(ur + U_SV + kvh * 64 + c8 * 8); } }
#pragma unroll
          for (int k3 = 0; k3 < 3; ++k3) { const int idx = tid + 512 * k3, kl = idx >> 3, c8 = idx & 7; const u32x4 vv = vv3[k3];
            *(LAS u32x4*)(K_l + kl * 72 + c8 * 8) = kv3[k3];
            const int kp = kperm_pos(kl); LAS bf16_t* vp = VT_l + (c8 * 8) * 200 + kp;
            vp[0] = (bf16_t)(vv.x & 0xffffu); vp[200] = (bf16_t)(vv.x >> 16); vp[400] = (bf16_t)(vv.y & 0xffffu); vp[600] = (bf16_t)(vv.y >> 16);
            vp[800] = (bf16_t)(vv.z & 0xffffu); vp[1000] = (bf16_t)(vv.z >> 16); vp[1200] = (bf16_t)(vv.w & 0xffffu); vp[1400] = (bf16_t)(vv.w >> 16); } }
        __syncthreads();
        const float slope = exp2f(-0.5f * (float)(h + 1)), sink = sinks[h];
#pragma unroll 1
        for (int i = 0; i < 4; ++i) {
            const size_t qrow = seq0 + qb * 64 + i * 16 + r;
            const bf16x8 qf0 = qn0, qf1 = qn1;
            { const bf16_t* qp = qbase + (size_t)((i < 3 ? i + 1 : 3) * 16) * NINP; qn0 = *(const bf16x8*)qp; qn1 = *(const bf16x8*)(qp + 32); }
            const int kt0 = i & ~1;
            f32x4 s[10]; float mx = sink; bf16x8 kfr[5][2];
#pragma unroll
            for (int kt = 0; kt < 10; ++kt) { f32x4 d;
                if (kt % 5 == 0) {
#pragma unroll
                    for (int k5 = 0; k5 < 5; ++k5) { const LAS bf16_t* kp = K_l + ((kt0 + kt + k5) * 16 + r) * 72 + q * 8; kfr[k5][0] = *(const LAS bf16x8*)kp; kfr[k5][1] = *(const LAS bf16x8*)(kp + 32); }
                    __builtin_amdgcn_sched_barrier(0); }
                d = mma16(kfr[kt % 5][0], qf0, (f32x4){0.f, 0.f, 0.f, 0.f}); d = mma16(kfr[kt % 5][1], qf1, d);
#pragma unroll
                for (int jj = 0; jj < 4; ++jj) { const int kl = (kt0 + kt) * 16 + q * 4 + jj, dist = i * 16 + r + 128 - kl;
                    const float v = (dist >= 0 && dist <= 128 && tok0 + kl >= 0) ? d[jj] * 0.125f - slope * (float)dist : -1e30f; d[jj] = v; mx = fmaxf(mx, v); }
                s[kt] = d; }
            mx = fmaxf(mx, __shfl_xor(mx, 16, 64)); mx = fmaxf(mx, __shfl_xor(mx, 32, 64));
            float sum = 0.f; bf16x8 pf[5];
#pragma unroll
            for (int kp = 0; kp < 5; ++kp) { f32x4 a = s[2 * kp], bq = s[2 * kp + 1];
#pragma unroll
                for (int jj = 0; jj < 4; ++jj) { a[jj] = __expf(a[jj] - mx); bq[jj] = __expf(bq[jj] - mx); sum += a[jj] + bq[jj]; }
                pf[kp] = pack_acc(a, bq); }
            sum += __shfl_xor(sum, 16, 64); sum += __shfl_xor(sum, 32, 64);
            const float inv = 1.0f / (sum + __expf(sink - mx));
            bf16_t* op = OB + qrow * BW + h * 64 + q * 4;
#pragma unroll
            for (int dt = 0; dt < 4; ++dt) { f32x4 o = (f32x4){0.f, 0.f, 0.f, 0.f}; bf16x8 vfr[5];
#pragma unroll
                for (int kp = 0; kp < 5; ++kp) vfr[kp] = *(const LAS bf16x8*)(VT_l + (dt * 16 + r) * 200 + (kt0 + 2 * kp) * 16 + q * 8);
                __builtin_amdgcn_sched_barrier(0);
#pragma unroll
                for (int kp = 0; kp < 5; ++kp) o = mma16(vfr[kp], pf[kp], o);
                u32x2 ov; ov.x = pk2(o[0] * inv, o[1] * inv); ov.y = pk2(o[2] * inv, o[3] * inv); *(u32x2*)(op + dt * 16) = ov; }
        }
        __syncthreads();
    }
}

__device__ __forceinline__ void ph_swa_sample(const Ctx& c, const bf16_t* __restrict__ U, const float* __restrict__ ck, const float* __restrict__ cv, const float* __restrict__ sinks, bf16_t* __restrict__ OB) {
    LAS bf16_t* K_l = (LAS bf16_t*)c.lds;
    LAS bf16_t* VT_l = K_l + 160 * 72;
    const int tid = c.tid, lane = c.lane, r = lane & 15, q = lane >> 4, w = c.wave;
    for (int u = c.bid; u < SB * 2; u += c.G) {
        const int sq = u >> 1, kvh = u & 1;
        for (int idx = tid; idx < 160 * 8; idx += 512) { const int kl = idx >> 3, c8 = idx & 7; float kx[8], vx[8];
#pragma unroll
            for (int e = 0; e < 8; ++e) { kx[e] = 0.f; vx[e] = 0.f; }
            if (kl < 128) { const size_t o = ((size_t)sq * 128 + kl) * 128 + kvh * 64 + c8 * 8; const f32x4 a = *(const f32x4*)(ck + o), b2 = *(const f32x4*)(ck + o + 4), c2 = *(const f32x4*)(cv + o), d2 = *(const f32x4*)(cv + o + 4);
                kx[0] = a[0]; kx[1] = a[1]; kx[2] = a[2]; kx[3] = a[3]; kx[4] = b2[0]; kx[5] = b2[1]; kx[6] = b2[2]; kx[7] = b2[3];
                vx[0] = c2[0]; vx[1] = c2[1]; vx[2] = c2[2]; vx[3] = c2[3]; vx[4] = d2[0]; vx[5] = d2[1]; vx[6] = d2[2]; vx[7] = d2[3]; }
            else if (kl < 132) { const bf16_t* ur = U + (size_t)(MP + sq * SS + kl - 128) * NINP; unpack8(*(const u32x4*)(ur + U_SK + kvh * 64 + c8 * 8), kx); unpack8(*(const u32x4*)(ur + U_SV + kvh * 64 + c8 * 8), vx); }
            *(LAS u32x4*)(K_l + kl * 72 + c8 * 8) = (u32x4){pk2(kx[0], kx[1]), pk2(kx[2], kx[3]), pk2(kx[4], kx[5]), pk2(kx[6], kx[7])};
            LAS bf16_t* vp = VT_l + (c8 * 8) * 168 + kperm_pos(kl);
#pragma unroll
            for (int e = 0; e < 8; ++e) vp[e * 168] = f2bf(vx[e]); }
        __syncthreads();
        if (w < 2) {
            const int h = kvh * 8 + w * 4 + (r >> 2), tk = r & 3; const size_t qrow = (size_t)(MP + sq * SS + tk);
            const float slope = exp2f(-0.5f * (float)(h + 1)), sink = sinks[h];
            const bf16x8 qf0 = *(const bf16x8*)(U + qrow * NINP + U_SQ + h * 64 + q * 8), qf1 = *(const bf16x8*)(U + qrow * NINP + U_SQ + h * 64 + 32 + q * 8);
            f32x4 s[10]; float mx = sink;
#pragma unroll
            for (int kt = 0; kt < 10; ++kt) { const LAS bf16_t* kp = K_l + (kt * 16 + r) * 72 + q * 8;
                f32x4 d = mma16(*(const LAS bf16x8*)kp, qf0, (f32x4){0.f, 0.f, 0.f, 0.f}); d = mma16(*(const LAS bf16x8*)(kp + 32), qf1, d);
#pragma unroll
                for (int jj = 0; jj < 4; ++jj) { const int kl = kt * 16 + q * 4 + jj, dist = 128 + tk - kl;
                    const float v = (dist >= 0 && dist <= 128) ? d[jj] * 0.125f - slope * (float)dist : -1e30f; d[jj] = v; mx = fmaxf(mx, v); }
                s[kt] = d; }
            mx = fmaxf(mx, __shfl_xor(mx, 16, 64)); mx = fmaxf(mx, __shfl_xor(mx, 32, 64));
            float sum = 0.f; bf16x8 pf[5];
#pragma unroll
            for (int kp = 0; kp < 5; ++kp) { f32x4 a = s[2 * kp], bq = s[2 * kp + 1];
#pragma unroll
                for (int jj = 0; jj < 4; ++jj) { a[jj] = __expf(a[jj] - mx); bq[jj] = __expf(bq[jj] - mx); sum += a[jj] + bq[jj]; }
                pf[kp] = pack_acc(a, bq); }
            sum += __shfl_xor(sum, 16, 64); sum += __shfl_xor(sum, 32, 64);
            const float inv = 1.0f / (sum + __expf(sink - mx));
            bf16_t* op = OB + qrow * BW + h * 64 + q * 4;
#pragma unroll
            for (int dt = 0; dt < 4; ++dt) { f32x4 o = (f32x4){0.f, 0.f, 0.f, 0.f};
#pragma unroll
                for (int kp = 0; kp < 5; ++kp) o = mma16(*(const LAS bf16x8*)(VT_l + (dt * 16 + r) * 168 + kp * 32 + q * 8), pf[kp], o);
                u32x2 ov; ov.x = pk2(o[0] * inv, o[1] * inv); ov.y = pk2(o[2] * inv, o[3] * inv); *(u32x2*)(op + dt * 16) = ov; }
        }
        __syncthreads();
    }
}

__device__ __forceinline__ void ph_memattn_prompt(const Ctx& c, const bf16_t* __restrict__ U, const bf16_t* __restrict__ MKB, const bf16_t* __restrict__ MVT, bf16_t* __restrict__ OB) {
    LAS bf16_t* buf = (LAS bf16_t*)c.lds;
    const int tid = c.tid, lane = c.lane, r = lane & 15, q = lane >> 4, w = c.wave;
    for (int u = c.bid; u < PB * 4 * 32; u += c.G) {
        const int b = u >> 7, h = (u >> 5) & 3, qb = u & 31;
        const size_t qrow = (size_t)b * PS + qb * 128 + w * 16 + r;
        const bf16_t* kg = MKB + (size_t)(b * 256) * 1024 + h * 256;
        const bf16_t* vg = MVT + (size_t)(b * 4 + h) * 65536;
        const bf16_t* qg = U + qrow * NINP + U_MQ + h * 256 + q * 8;
        bf16x8 qn0 = *(const bf16x8*)qg, qn1 = *(const bf16x8*)(qg + 32);
        u32x4 st[4];
#pragma unroll
        for (int i = 0; i < 4; ++i) { const int p = tid + 512 * i; st[i] = *(const u32x4*)(kg + (size_t)(p >> 3) * 1024 + (p & 7) * 8); }
        f32x4 s[16];
#pragma unroll
        for (int mt = 0; mt < 16; ++mt) s[mt] = (f32x4){0.f, 0.f, 0.f, 0.f};
        __syncthreads();
#pragma unroll 1
        for (int ck = 0; ck < 4; ++ck) {
            LAS bf16_t* kb = buf + (ck & 1) * 18432;
#pragma unroll
            for (int i = 0; i < 4; ++i) { const int p = tid + 512 * i; *(LAS u32x4*)(kb + (p >> 3) * 72 + (p & 7) * 8) = st[i]; }
            __syncthreads();
            const bf16x8 qc0 = qn0, qc1 = qn1;
            if (ck < 3) { qn0 = *(const bf16x8*)(qg + (ck + 1) * 64); qn1 = *(const bf16x8*)(qg + (ck + 1) * 64 + 32);
#pragma unroll
                for (int i = 0; i < 4; ++i) { const int p = tid + 512 * i; st[i] = *(const u32x4*)(kg + (size_t)(p >> 3) * 1024 + (ck + 1) * 64 + (p & 7) * 8); } }
#pragma unroll
            for (int m2 = 0; m2 < 16; m2 += 2) { bf16x8 kf[2][2];
#pragma unroll
                for (int j = 0; j < 2; ++j) { kf[j][0] = *(const LAS bf16x8*)(kb + ((m2 + j) * 16 + r) * 72 + q * 8); kf[j][1] = *(const LAS bf16x8*)(kb + ((m2 + j) * 16 + r) * 72 + 32 + q * 8); }
                __builtin_amdgcn_sched_barrier(0);
#pragma unroll
                for (int j = 0; j < 2; ++j) { s[m2 + j] = mma16(kf[j][0], qc0, s[m2 + j]); s[m2 + j] = mma16(kf[j][1], qc1, s[m2 + j]); } }
        }
#pragma unroll
        for (int i = 0; i < 4; ++i) { const int p = tid + 512 * i; st[i] = *(const u32x4*)(vg + (size_t)(p >> 5) * 256 + (p & 31) * 8); }
        float mx = -3.0e38f;
#pragma unroll
        for (int mt = 0; mt < 16; ++mt)
#pragma unroll
            for (int jj = 0; jj < 4; ++jj) { s[mt][jj] *= 0.0625f; mx = fmaxf(mx, s[mt][jj]); }
        mx = fmaxf(mx, __shfl_xor(mx, 16, 64)); mx = fmaxf(mx, __shfl_xor(mx, 32, 64));
        float sum = 0.f; bf16x8 pf[8];
#pragma unroll
        for (int kp = 0; kp < 8; ++kp) { f32x4 a = s[2 * kp], b2 = s[2 * kp + 1];
#pragma unroll
            for (int jj = 0; jj < 4; ++jj) { a[jj] = __expf(a[jj] - mx); b2[jj] = __expf(b2[jj] - mx); sum += a[jj] + b2[jj]; }
            pf[kp] = pack_acc(a, b2); }
        sum += __shfl_xor(sum, 16, 64); sum += __shfl_xor(sum, 32, 64);
        const float inv = 1.0f / sum;
        bf16_t* op = OB + qrow * BW + h * 256 + q * 4;
#pragma unroll 1
        for (int cv = 0; cv < 4; ++cv) {
            LAS bf16_t* vb = buf + (cv & 1) * 18432;
#pragma unroll
            for (int i = 0; i < 4; ++i) { const int p = tid + 512 * i, m0 = (p & 31) * 8; LAS bf16_t* d0 = vb + (p >> 5) * 264;
                *(LAS u32x2*)(d0 + kperm_pos(m0)) = (u32x2){st[i].x, st[i].y}; *(LAS u32x2*)(d0 + kperm_pos(m0 + 4)) = (u32x2){st[i].z, st[i].w}; }
            __syncthreads();
            if (cv < 3) {
#pragma unroll
                for (int i = 0; i < 4; ++i) { const int p = tid + 512 * i; st[i] = *(const u32x4*)(vg + (size_t)((cv + 1) * 64 + (p >> 5)) * 256 + (p & 31) * 8); } }
#pragma unroll
            for (int dt = 0; dt < 4; ++dt) { bf16x8 vf[8];
#pragma unroll
                for (int kp = 0; kp < 8; ++kp) vf[kp] = *(const LAS bf16x8*)(vb + (dt * 16 + r) * 264 + kp * 32 + q * 8);
                __builtin_amdgcn_sched_barrier(0);
                f32x4 o = (f32x4){0.f, 0.f, 0.f, 0.f};
#pragma unroll
                for (int kp = 0; kp < 8; ++kp) o = mma16(vf[kp], pf[kp], o);
                u32x2 ov; ov.x = pk2(o[0] * inv, o[1] * inv); ov.y = pk2(o[2] * inv, o[3] * inv); *(u32x2*)(op + (cv * 4 + dt) * 16) = ov; }
        }
        __syncthreads();
    }
}

__device__ __forceinline__ void ph_lrw(const Ctx& c, const float* __restrict__ w2, const float* __restrict__ a2, const float* __restrict__ g2, bf16_t* __restrict__ LRW) {
    for (int idx = c.bid * 512 + c.tid; idx < NL * 256 * 1024; idx += c.G * 512) {
        const int ch = idx & 1023, j = (idx >> 10) & 255, l = idx >> 18;
        const float v = j < 64 ? w2[((size_t)l * 64 + j) * BW + ch] : (j < 128 ? a2[((size_t)l * 64 + j - 64) * BW + ch] : g2[((size_t)l * 128 + j - 128) * BW + ch]);
        LRW[((size_t)l * 1024 + ch) * 256 + j] = f2bf(v);
    }
}
constexpr int RWP_UNITS = (MP / 64) * 4 + SB * 4;
__device__ __forceinline__ void rwp_unit_info(int u, int& row0, int& ntok, int& hg, int& sq, bool& seq_first) {
    if (u < (MP / 64) * 4) { const int blk = u >> 2; hg = u & 3; row0 = blk * 64; ntok = 64; sq = -1; seq_first = (row0 % PS) == 0; }
    else { const int s = u - (MP / 64) * 4; sq = s >> 2; hg = s & 3; row0 = MP + sq * SS; ntok = SS; seq_first = true; }
}
__device__ __forceinline__ void ph_rwkv_pre(const Ctx& c, const bf16_t* __restrict__ U, const float* __restrict__ shift, const float* __restrict__ mu, const float* __restrict__ w0, const float* __restrict__ w2,
                                            const float* __restrict__ a0, const float* __restrict__ a2, const float* __restrict__ g2, const float* __restrict__ k_k, const float* __restrict__ k_a,
                                            const float* __restrict__ r_k, float* __restrict__ RW, bf16_t* __restrict__ RB, const bf16_t* __restrict__ LRW) {
    LAS bf16_t* P_l = (LAS bf16_t*)c.lds; LAS bf16_t* Kn_l = P_l + 4608; LAS bf16_t* Bn_l = Kn_l + 4608; LAS bf16_t* Q_l = Bn_l + 4608;
    LAS bf16_t* PT_l = Q_l + 4608; LAS bf16_t* BhT_l = PT_l + 4608; LAS bf16_t* KhT_l = BhT_l + 4608; LAS bf16_t* VT_l = KhT_l + 4608;
    LAS float* A_l = (LAS float*)(c.lds + 73728);
    LAS bf16_t* BmT_l = (LAS bf16_t*)(c.lds + 78848); LAS bf16_t* F_l = (LAS bf16_t*)(c.lds + 81920); LAS bf16_t* Tinv_l = (LAS bf16_t*)(c.lds + 84992);
    LAS bf16_t* PpT_l = (LAS bf16_t*)(c.lds + 88064);
    LAS bf16_t* BmpT_l = (LAS bf16_t*)(c.lds + 97280);
    LAS float* GC_l = (LAS float*)(c.lds + 100352);
    LAS float* lg_l = (LAS float*)(c.lds + 125952);
    LAS bf16_t* act_l = (LAS bf16_t*)c.lds;
    LAS bf16_t* wT_l = act_l + 64 * 264;
    LAS bf16_t* aT_l = wT_l + 64 * 72;
    LAS bf16_t* gT_l = aT_l + 64 * 72;
    LAS float* pre_l = (LAS float*)(c.lds + 73728);
    const int tid = c.tid, lane = c.lane, r = lane & 15, q = lane >> 4, w = c.wave;
    bf16_t* Gg = (bf16_t*)(RW + 6 * (size_t)MPAD * BW); bf16_t* BON = (bf16_t*)(RW + 7 * (size_t)MPAD * BW);
    for (int u = c.bid; u < RWP_UNITS; u += c.G) {
        int row0, ntok, hg, sq; bool seq_first; rwp_unit_info(u, row0, ntok, hg, sq, seq_first);
        const float* sh = sq >= 0 ? shift + (size_t)sq * RWC : nullptr;
        const int nstage = ntok == 64 ? 64 : 16;
        for (int idx = tid; idx < nstage * 32; idx += 512) {
            const int t = idx >> 5, c8 = idx & 31, cc = 3072 + c8 * 8; float val[8];
#pragma unroll
            for (int e2 = 0; e2 < 8; ++e2) val[e2] = 0.f;
            if (t < ntok) { const bf16_t* ur = U + (size_t)(row0 + t) * NINP + U_RU; float x[8], p[8];
                unpack8(*(const u32x4*)(ur + cc), x);
                if (!(t == 0 && seq_first)) unpack8(*(const u32x4*)(ur + cc - NINP), p);
                else if (sh) { const f32x4 s0v = *(const f32x4*)(sh + cc), s1v = *(const f32x4*)(sh + cc + 4); p[0] = s0v[0]; p[1] = s0v[1]; p[2] = s0v[2]; p[3] = s0v[3]; p[4] = s1v[0]; p[5] = s1v[1]; p[6] = s1v[2]; p[7] = s1v[3]; }
                else {
#pragma unroll
                    for (int e2 = 0; e2 < 8; ++e2) p[e2] = 0.f; }
                const f32x4 m0 = *(const f32x4*)(mu + cc), m1 = *(const f32x4*)(mu + cc + 4);
#pragma unroll
                for (int e2 = 0; e2 < 8; ++e2) { const float xm = x[e2] + (p[e2] - x[e2]) * (e2 < 4 ? m0[e2] : m1[e2 - 4]); val[e2] = c8 < 8 ? tanh_fast(xm) : (c8 < 16 ? xm : sigmoidf_(xm)); } }
            *(LAS u32x4*)(act_l + t * 264 + c8 * 8) = (u32x4){pk2(val[0], val[1]), pk2(val[2], val[3]), pk2(val[4], val[5]), pk2(val[6], val[7])};
        }
        __syncthreads();
        bf16x8 af[8];
        { const int tb = w & 3;
#pragma unroll
          for (int ks = 0; ks < 8; ++ks) af[ks] = *(const LAS bf16x8*)(act_l + (tb * 16 + r) * 264 + ks * 32 + q * 8); }
        __syncthreads();
#pragma unroll 1
        for (int hh = 0; hh < 4; ++hh) { const int h = hg * 4 + hh;
        const int t = tid >> 3, cg = tid & 7, c0 = h * 64 + cg * 8, sc = t >> 4;
        u32x4 ux[3], upv[3];
        if (t < ntok) { const bf16_t* ur = U + (size_t)(row0 + t) * NINP + U_RU; const bool fst = (t == 0 && seq_first);
#pragma unroll
            for (int part = 0; part < 3; ++part) { ux[part] = *(const u32x4*)(ur + part * 1024 + c0); if (!fst) upv[part] = *(const u32x4*)(ur + part * 1024 + c0 - NINP); } }
        { const int tb = w & 3, chf = w >> 2;
          if (tb * 16 < nstage) {
            bf16x8 wf[2][8];
#pragma unroll
            for (int e2 = 0; e2 < 2; ++e2) { const bf16_t* wr = LRW + ((size_t)h * 64 + (chf * 2 + e2) * 16 + r) * 256 + q * 8;
#pragma unroll
                for (int ks = 0; ks < 8; ++ks) wf[e2][ks] = *(const bf16x8*)(wr + ks * 32); }
            __builtin_amdgcn_sched_barrier(0);
#pragma unroll
            for (int e2 = 0; e2 < 2; ++e2) { const int cb = chf * 2 + e2; f32x4 dw = (f32x4){0.f, 0.f, 0.f, 0.f}, da = dw, dg = dw;
#pragma unroll
                for (int ks = 0; ks < 2; ++ks) { dw = mma16(wf[e2][ks], af[ks], dw); da = mma16(wf[e2][2 + ks], af[2 + ks], da); }
#pragma unroll
                for (int ks = 0; ks < 4; ++ks) dg = mma16(wf[e2][4 + ks], af[4 + ks], dg);
                const int o = (tb * 16 + r) * 68 + cb * 16 + q * 4;
                *(LAS f32x4*)(pre_l + o) = dw; *(LAS f32x4*)(pre_l + 64 * 68 + o) = da; *(LAS f32x4*)(pre_l + 2 * 64 * 68 + o) = dg; } } }
        __syncthreads();
        float rr[8], k2[8], kap[8], bet[8], nlw[8];
        { float vx[8], gg[8], kkr[8]; float ss = 0.f, rk = 0.f;
          if (t < ntok) {
            const size_t row = (size_t)(row0 + t); const bf16_t* ur = U + row * NINP + U_RU; const bool fst = (t == 0 && seq_first);
            float kx[8];
#pragma unroll
            for (int part = 0; part < 3; ++part) { const int cc = part * 1024 + c0; float x[8], p[8];
                unpack8(ux[part], x);
                if (!fst) unpack8(upv[part], p);
                else {
#pragma unroll
                    for (int j = 0; j < 8; ++j) p[j] = sh ? sh[cc + j] : 0.f; }
                const f32x4 mA = *(const f32x4*)(mu + cc), mB = *(const f32x4*)(mu + cc + 4);
#pragma unroll
                for (int j = 0; j < 8; ++j) { const float xm = x[j] + (p[j] - x[j]) * (j < 4 ? mA[j] : mB[j - 4]); if (part == 0) rr[j] = xm; else if (part == 1) kx[j] = xm; else vx[j] = xm; } }
            float pw[8], pa[8], pkk[8], pka[8], prk[8];
#pragma unroll
            for (int hf = 0; hf < 2; ++hf) { const f32x4 v0 = *(const f32x4*)(w0 + c0 + hf * 4), v1 = *(const f32x4*)(a0 + c0 + hf * 4), v2 = *(const f32x4*)(k_k + c0 + hf * 4), v3 = *(const f32x4*)(k_a + c0 + hf * 4), v4 = *(const f32x4*)(r_k + c0 + hf * 4);
#pragma unroll
                for (int j = 0; j < 4; ++j) { pw[hf * 4 + j] = v0[j]; pa[hf * 4 + j] = v1[j]; pkk[hf * 4 + j] = v2[j]; pka[hf * 4 + j] = v3[j]; prk[hf * 4 + j] = v4[j]; } }
            float lwp[8], app[8];
#pragma unroll
            for (int hf = 0; hf < 2; ++hf) { const f32x4 v0 = *(const LAS f32x4*)(pre_l + t * 68 + cg * 8 + hf * 4), v1 = *(const LAS f32x4*)(pre_l + 64 * 68 + t * 68 + cg * 8 + hf * 4), v2 = *(const LAS f32x4*)(pre_l + 2 * 64 * 68 + t * 68 + cg * 8 + hf * 4);
#pragma unroll
                for (int j = 0; j < 4; ++j) { lwp[hf * 4 + j] = v0[j]; app[hf * 4 + j] = v1[j]; gg[hf * 4 + j] = v2[j]; } }
#pragma unroll
            for (int j = 0; j < 8; ++j) {
                const float lw = -softplus_fast(-(pw[j] + lwp[j])) - 0.5f; nlw[j] = -__expf(lw); const float av = sigmoidf_(pa[j] + app[j]);
                kkr[j] = kx[j] * pkk[j]; ss += kkr[j] * kkr[j]; k2[j] = kx[j] * (1.0f + (av - 1.0f) * pka[j]); rk += rr[j] * k2[j] * prk[j]; bet[j] = av; }
          } else {
#pragma unroll
            for (int j = 0; j < 8; ++j) { rr[j] = 0.f; k2[j] = 0.f; kkr[j] = 0.f; bet[j] = 0.f; nlw[j] = 0.f; vx[j] = 0.f; gg[j] = 0.f; }
          }
          ss += __shfl_xor(ss, 1, 64); ss += __shfl_xor(ss, 2, 64); ss += __shfl_xor(ss, 4, 64);
          rk += __shfl_xor(rk, 1, 64); rk += __shfl_xor(rk, 2, 64); rk += __shfl_xor(rk, 4, 64);
          const float inv = 1.0f / fmaxf(sqrtf(ss), 1e-12f);
#pragma unroll
          for (int j = 0; j < 8; ++j) { kap[j] = kkr[j] * inv; bet[j] = kap[j] * bet[j]; }
          if (t < ntok) { const size_t o = (size_t)(row0 + t) * BW + c0;
              *(u32x4*)(Gg + o) = (u32x4){pk2(gg[0], gg[1]), pk2(gg[2], gg[3]), pk2(gg[4], gg[5]), pk2(gg[6], gg[7])};
              *(u32x4*)(BON + o) = (u32x4){pk2(rk * vx[0], rk * vx[1]), pk2(rk * vx[2], rk * vx[3]), pk2(rk * vx[4], rk * vx[5]), pk2(rk * vx[6], rk * vx[7])}; }
          *(LAS f32x4*)(lg_l + t * 68 + cg * 8) = (f32x4){nlw[0], nlw[1], nlw[2], nlw[3]}; *(LAS f32x4*)(lg_l + t * 68 + cg * 8 + 4) = (f32x4){nlw[4], nlw[5], nlw[6], nlw[7]};
#pragma unroll
          for (int j = 0; j < 8; ++j) VT_l[(cg * 8 + j) * 72 + t] = f2bf(vx[j]);
        }
        __syncthreads();
        if (tid < 256) { const int cc = tid & 63, s4 = tid >> 6; float vv[16];
#pragma unroll
            for (int i = 0; i < 16; ++i) vv[i] = lg_l[(s4 * 16 + i) * 68 + cc];
            float run = 0.f;
#pragma unroll
            for (int i = 0; i < 16; ++i) { run += vv[i]; lg_l[(s4 * 16 + i) * 68 + cc] = run; } }
        __syncthreads();
        { unsigned pp[4], pq[4], pk[4], pb[4];
#pragma unroll
          for (int j = 0; j < 8; j += 2) { float vP[2], vQ[2], vK[2], vB[2];
#pragma unroll
              for (int e = 0; e < 2; ++e) { const int jj = j + e, cc = cg * 8 + jj; const float ci = lg_l[t * 68 + cc], cC = lg_l[(sc * 16 + 15) * 68 + cc];
                  const float ei = __expf(-ci), eh = __expf(cC - ci);
                  vP[e] = kap[jj] * __expf(ci - nlw[jj]); vQ[e] = rr[jj] * __expf(ci); vK[e] = k2[jj] * ei; vB[e] = bet[jj] * ei;
                  PT_l[cc * 72 + t] = f2bf(vP[e]); BhT_l[cc * 72 + t] = f2bf(bet[jj] * eh); KhT_l[cc * 72 + t] = f2bf(k2[jj] * eh); }
              pp[j >> 1] = pk2(vP[0], vP[1]); pq[j >> 1] = pk2(vQ[0], vQ[1]); pk[j >> 1] = pk2(vK[0], vK[1]); pb[j >> 1] = pk2(vB[0], vB[1]); }
          const int o = t * 72 + cg * 8;
          *(LAS u32x4*)(P_l + o) = (u32x4){pp[0], pp[1], pp[2], pp[3]}; *(LAS u32x4*)(Q_l + o) = (u32x4){pq[0], pq[1], pq[2], pq[3]};
          *(LAS u32x4*)(Kn_l + o) = (u32x4){pk[0], pk[1], pk[2], pk[3]}; *(LAS u32x4*)(Bn_l + o) = (u32x4){pb[0], pb[1], pb[2], pb[3]};
          if ((t & 15) == 15) {
#pragma unroll
              for (int j = 0; j < 8; ++j) GC_l[sc * 64 + cg * 8 + j] = __expf(lg_l[t * 68 + cg * 8 + j]); } }
        __syncthreads();
        const int nsub = ntok == 64 ? 4 : 1;
        const bf16x8 zfrag = (bf16x8){0, 0, 0, 0, 0, 0, 0, 0};
        { const int s4 = w & 3, hf = w >> 2;
          if (s4 < nsub) { const int ro = (s4 * 16 + r) * 72 + q * 8;
            if (hf == 0) {
                const bf16x8 b0 = *(const LAS bf16x8*)(Bn_l + ro), b1 = *(const LAS bf16x8*)(Bn_l + ro + 32), p0 = *(const LAS bf16x8*)(P_l + ro), p1 = *(const LAS bf16x8*)(P_l + ro + 32),
                             q0 = *(const LAS bf16x8*)(Q_l + ro), q1 = *(const LAS bf16x8*)(Q_l + ro + 32);
                __builtin_amdgcn_sched_barrier(0);
                f32x4 da = (f32x4){0.f, 0.f, 0.f, 0.f}, df = da; da = mma16(b0, p0, da); df = mma16(b0, q0, df); da = mma16(b1, p1, da); df = mma16(b1, q1, df);
                f32x4 o4; float f4[4];
#pragma unroll
                for (int jj = 0; jj < 4; ++jj) { o4[jj] = (q * 4 + jj < r) ? da[jj] : 0.f; f4[jj] = (q * 4 + jj <= r) ? df[jj] : 0.f; }
                *(LAS f32x4*)(A_l + s4 * 320 + r * 20 + q * 4) = o4;
                u32x2 o; o.x = pk2(f4[0], f4[1]); o.y = pk2(f4[2], f4[3]); *(LAS u32x2*)(F_l + s4 * 384 + r * 24 + q * 4) = o;
            } else {
                const bf16x8 p0 = *(const LAS bf16x8*)(P_l + ro), p1 = *(const LAS bf16x8*)(P_l + ro + 32), k0 = *(const LAS bf16x8*)(Kn_l + ro), k1 = *(const LAS bf16x8*)(Kn_l + ro + 32);
                __builtin_amdgcn_sched_barrier(0);
                f32x4 d = (f32x4){0.f, 0.f, 0.f, 0.f}; d = mma16(p0, k0, d); d = mma16(p1, k1, d);
                float o4[4];
#pragma unroll
                for (int jj = 0; jj < 4; ++jj) o4[jj] = (r < q * 4 + jj) ? d[jj] : 0.f;
                u32x2 o; o.x = pk2(o4[0], o4[1]); o.y = pk2(o4[2], o4[3]); *(LAS u32x2*)(BmT_l + s4 * 384 + r * 24 + q * 4) = o;
            } } }
        __syncthreads();
        if (w == 0 && (lane >> 4) < nsub) { const int s4 = lane >> 4, jc = lane & 15; float x[16];
#pragma unroll
            for (int tt = 0; tt < 16; ++tt) { float s = (tt == jc) ? 1.f : 0.f;
#pragma unroll
                for (int i = 0; i < tt; ++i) s -= A_l[s4 * 320 + tt * 20 + i] * x[i];
                x[tt] = s; }
#pragma unroll
            for (int tt = 0; tt < 16; ++tt) Tinv_l[s4 * 384 + tt * 24 + jc] = f2bf(x[tt]); }
        __syncthreads();
        { const int s4 = w & 3, hf = w >> 2;
          if (s4 < nsub) {
            const bf16x8 xf = q < 2 ? *(const LAS bf16x8*)(Tinv_l + s4 * 384 + r * 24 + q * 8) : zfrag;
            const bf16x8 y0 = q < 2 ? *(const LAS bf16x8*)(PT_l + ((hf * 2) * 16 + r) * 72 + s4 * 16 + q * 8) : zfrag, y1 = q < 2 ? *(const LAS bf16x8*)(PT_l + ((hf * 2 + 1) * 16 + r) * 72 + s4 * 16 + q * 8) : zfrag;
            const bf16x8 y2 = (q < 2 && hf == 0) ? *(const LAS bf16x8*)(BmT_l + s4 * 384 + r * 24 + q * 8) : zfrag;
            __builtin_amdgcn_sched_barrier(0);
            const f32x4 z4 = (f32x4){0.f, 0.f, 0.f, 0.f};
            const f32x4 d0 = mma16(xf, y0, z4), d1 = mma16(xf, y1, z4);
            u32x2 o; o.x = pk2(d0[0], d0[1]); o.y = pk2(d0[2], d0[3]); *(LAS u32x2*)(PpT_l + ((hf * 2) * 16 + r) * 72 + s4 * 16 + q * 4) = o;
            o.x = pk2(d1[0], d1[1]); o.y = pk2(d1[2], d1[3]); *(LAS u32x2*)(PpT_l + ((hf * 2 + 1) * 16 + r) * 72 + s4 * 16 + q * 4) = o;
            if (hf == 0) { const f32x4 d2 = mma16(xf, y2, z4); o.x = pk2(d2[0], d2[1]); o.y = pk2(d2[2], d2[3]); *(LAS u32x2*)(BmpT_l + s4 * 384 + r * 24 + q * 4) = o; } } }
        __syncthreads();
        { const int chunk0 = sq >= 0 ? PB * 16 * 256 + sq * 16 + h : ((row0 / PS) * 16 + h) * 256 + ((row0 % PS) >> 4);
          { const int s4 = w & 3, hf = w >> 2;
            if (s4 < nsub) { bf16_t* blob = RB + (size_t)(chunk0 + s4) * RB_EL;
              bf16x8 pp[4], bhm[2], fF = zfrag, bmp = zfrag, x4[4];
#pragma unroll
              for (int i = 0; i < 4; ++i) pp[i] = zfrag;
              bhm[0] = zfrag; bhm[1] = zfrag;
              if (q < 2) {
#pragma unroll
                  for (int i = 0; i < 4; ++i) pp[i] = *(const LAS bf16x8*)(PpT_l + (i * 16 + r) * 72 + s4 * 16 + q * 8);
#pragma unroll
                  for (int i = 0; i < 2; ++i) bhm[i] = *(const LAS bf16x8*)(BhT_l + ((hf * 2 + i) * 16 + r) * 72 + s4 * 16 + q * 8);
                  fF = *(const LAS bf16x8*)(F_l + s4 * 384 + r * 24 + q * 8); bmp = *(const LAS bf16x8*)(BmpT_l + s4 * 384 + r * 24 + q * 8); }
              if (hf == 0) {
#pragma unroll
                  for (int ks = 0; ks < 2; ++ks) { x4[ks] = *(const LAS bf16x8*)(Kn_l + (s4 * 16 + r) * 72 + ks * 32 + q * 8); x4[2 + ks] = *(const LAS bf16x8*)(Q_l + (s4 * 16 + r) * 72 + ks * 32 + q * 8); }
              } else {
#pragma unroll
                  for (int i = 0; i < 4; ++i) x4[i] = q < 2 ? *(const LAS bf16x8*)(BhT_l + (i * 16 + r) * 72 + s4 * 16 + q * 8) : zfrag;
              }
              __builtin_amdgcn_sched_barrier(0);
              const f32x4 z4 = (f32x4){0.f, 0.f, 0.f, 0.f};
              f32x4 dx[4];
              f32x4 d2 = z4, d1 = z4;
              if (hf == 0) {
#pragma unroll
                  for (int j = 0; j < 4; ++j) dx[j] = mma16(pp[j], fF, z4);
                  d2 = mma16(x4[0], x4[2], d2); d2 = mma16(x4[1], x4[3], d2);
                  d1 = mma16(bmp, fF, z4);
              } else {
#pragma unroll
                  for (int j = 0; j < 4; ++j) dx[j] = mma16(bmp, x4[j], z4);
              }
#pragma unroll
              for (int i = 0; i < 2; ++i) { const int cob = hf * 2 + i; const float gc = GC_l[s4 * 64 + cob * 16 + r]; f32x4 dm[4];
#pragma unroll
                  for (int j = 0; j < 4; ++j) dm[j] = mma16(pp[j], bhm[i], z4);
#pragma unroll
                  for (int cp = 0; cp < 2; ++cp) { float o8[8];
#pragma unroll
                      for (int e2 = 0; e2 < 2; ++e2) { const int cib = cp * 2 + e2;
#pragma unroll
                          for (int jj = 0; jj < 4; ++jj) o8[e2 * 4 + jj] = ((cib == cob && q * 4 + jj == r) ? gc : 0.f) - dm[cib][jj]; }
                      *(u32x4*)(blob + (cob * 16 + r) * 72 + 32 * cp + 8 * q) = (u32x4){pk2(o8[0], o8[1]), pk2(o8[2], o8[3]), pk2(o8[4], o8[5]), pk2(o8[6], o8[7])}; } }
              if (hf == 0) {
#pragma unroll
                  for (int cp = 0; cp < 2; ++cp) {
                      const u32x2 qa = *(const LAS u32x2*)(Q_l + (s4 * 16 + r) * 72 + (cp * 2) * 16 + q * 4), qb = *(const LAS u32x2*)(Q_l + (s4 * 16 + r) * 72 + (cp * 2 + 1) * 16 + q * 4);
                      const f32x4 da = dx[cp * 2], db = dx[cp * 2 + 1];
                      *(u32x4*)(blob + RB_QP + r * 72 + 32 * cp + 8 * q) = (u32x4){
                          pk2(__uint_as_float(qa.x << 16) - da[0], __uint_as_float(qa.x & 0xffff0000u) - da[1]), pk2(__uint_as_float(qa.y << 16) - da[2], __uint_as_float(qa.y & 0xffff0000u) - da[3]),
                          pk2(__uint_as_float(qb.x << 16) - db[0], __uint_as_float(qb.x & 0xffff0000u) - db[1]), pk2(__uint_as_float(qb.y << 16) - db[2], __uint_as_float(qb.y & 0xffff0000u) - db[3])}; }
                  float o4[4];
#pragma unroll
                  for (int jj = 0; jj < 4; ++jj) o4[jj] = ((q * 4 + jj <= r) ? d2[jj] : 0.f) - d1[jj];
                  u32x2 o; o.x = pk2(o4[0], o4[1]); o.y = pk2(o4[2], o4[3]); *(u32x2*)(blob + RB_EP + r * 24 + q * 4) = o;
              } else {
#pragma unroll
                  for (int cb = 0; cb < 4; ++cb) { const u32x2 kv = *(const LAS u32x2*)(KhT_l + (cb * 16 + r) * 72 + s4 * 16 + q * 4); const f32x4 d = dx[cb];
                      u32x2 o; o.x = pk2(__uint_as_float(kv.x << 16) - d[0], __uint_as_float(kv.x & 0xffff0000u) - d[1]); o.y = pk2(__uint_as_float(kv.y << 16) - d[2], __uint_as_float(kv.y & 0xffff0000u) - d[3]);
                      *(u32x2*)(blob + RB_KHP + (cb * 16 + r) * 24 + q * 4) = o; }
              } } }
          for (int idx = tid; idx < nsub * 128; idx += 512) { const int s4 = idx >> 7, cc = (idx >> 1) & 63, hf = idx & 1;
              *(u32x4*)(RB + (size_t)(chunk0 + s4) * RB_EL + RB_VT + cc * 24 + hf * 8) = *(const LAS u32x4*)(VT_l + cc * 72 + s4 * 16 + hf * 8); } }
        __syncthreads();
        }
    }
}

__device__ __forceinline__ void ph_rwkv_scan_naive(const Ctx& c, const float* __restrict__ RW, const float* __restrict__ s0, const float* __restrict__ lng, const float* __restrict__ lnb, bf16_t* __restrict__ OB,
                                                   float* __restrict__ outP, float* __restrict__ outS) {
    const float* R = RW; const float* WD = RW + (size_t)MPAD * BW; const float* K2 = WD + (size_t)MPAD * BW; const float* V = K2 + (size_t)MPAD * BW; const float* KK = V + (size_t)MPAD * BW;
    const float* BV = KK + (size_t)MPAD * BW; const float* G = BV + (size_t)MPAD * BW; const float* BON = G + (size_t)MPAD * BW;
    const int lane = c.lane;
    for (int it = 0;; ++it) {
        const int u = (it * 8 + c.wave) * c.G + c.bid;
        if (u >= (PB + SB) * 16) break;
        const int sq = u >> 4, h = u & 15;
        int row0, L; seq_info(sq, row0, L);
        float S[64];
        if (sq >= PB) { const float* p = s0 + (((size_t)(sq - PB) * 16 + h) * 64 + lane) * 64;
#pragma unroll
            for (int j = 0; j < 64; ++j) S[j] = p[j]; }
        else {
#pragma unroll
            for (int j = 0; j < 64; ++j) S[j] = 0.f; }
        const float lg = lng[h * 64 + lane], lb = lnb[h * 64 + lane];
        for (int t = 0; t < L; ++t) {
            const size_t base = (size_t)(row0 + t) * BW + h * 64; const float v = V[base + lane];
            float d = 0.f;
#pragma unroll
            for (int j = 0; j < 64; ++j) d += S[j] * KK[base + j];
            float y = 0.f;
#pragma unroll
            for (int j = 0; j < 64; ++j) { S[j] = S[j] * WD[base + j] - d * BV[base + j] + v * K2[base + j]; y += S[j] * R[base + j]; }
            const float mean = wave_sum(y) * (1.0f / 64.0f), dy = y - mean, var = wave_sum(dy * dy) * (1.0f / 64.0f);
            const float yn = dy * rsqrtf(var + 64e-5f) * lg + lb;
            OB[base + lane] = f2bf((yn + BON[base + lane]) * G[base + lane]);
        }
        float* op = (sq < PB ? outP + (((size_t)sq * 16 + h) * 64 + lane) * 64 : outS + (((size_t)(sq - PB) * 16 + h) * 64 + lane) * 64);
#pragma unroll
        for (int j = 0; j < 64; ++j) op[j] = S[j];
    }
}
__device__ __forceinline__ void ph_rwkv_scan2(const Ctx& c, int boff, const float* __restrict__ RW, const float* __restrict__ s0, const float* __restrict__ lng, const float* __restrict__ lnb, bf16_t* __restrict__ OB,
                                              float* __restrict__ outP, float* __restrict__ outS) {
    LAS float* opb = (LAS float*)c.lds;
    LAS float* yb = opb + 2 * 16 * 384;
    const int tid = c.tid, lane = c.lane, w = c.wave, rl = lane >> 3, cg = lane & 7, vrow = w * 8 + rl;
    const float* G = RW + 6 * (size_t)MPAD * BW; const float* BON = RW + 7 * (size_t)MPAD * BW;
    for (int u = (c.bid - boff + c.G) % c.G; u < (PB + SB) * 16; u += c.G) {
        const int sq = u >> 4, h = u & 15;
        int row0, L; seq_info(sq, row0, L);
        float S[8];
        if (sq >= PB) { const float* p = s0 + (((size_t)(sq - PB) * 16 + h) * 64 + vrow) * 64 + cg * 8;
#pragma unroll
            for (int j = 0; j < 8; ++j) S[j] = p[j]; }
        else {
#pragma unroll
            for (int j = 0; j < 8; ++j) S[j] = 0.f; }
        const float lg = lng[h * 64 + lane], lb = lnb[h * 64 + lane];
        const int nb = (L + 15) >> 4;
#define RW_STAGE(bi_) do { const int t0_ = (bi_) * 16, nT_ = (L - t0_) < 16 ? (L - t0_) : 16; LAS float* dst_ = opb + ((bi_) & 1) * 16 * 384; \
        for (int idx = tid; idx < nT_ * 96; idx += 512) { const int t = idx / 96, rem = idx - t * 96, slot = rem >> 4, c4 = rem & 15; \
            const int arr = slot == 0 ? 1 : slot == 1 ? 4 : slot == 2 ? 5 : slot == 3 ? 2 : slot == 4 ? 0 : 3; \
            *(LAS f32x4*)(dst_ + t * 384 + slot * 64 + c4 * 4) = *(const f32x4*)(RW + (size_t)arr * MPAD * BW + (size_t)(row0 + t0_ + t) * BW + h * 64 + c4 * 4); } } while (0)
        RW_STAGE(0);
        for (int bi = 0; bi < nb; ++bi) {
            __syncthreads();
            if (bi + 1 < nb) RW_STAGE(bi + 1);
            const int t0 = bi * 16, nT = (L - t0) < 16 ? (L - t0) : 16; const LAS float* src = opb + (bi & 1) * 16 * 384;
            for (int tt = 0; tt < nT; ++tt) {
                const LAS float* b = src + tt * 384 + cg * 8;
                const f32x4 w0 = *(const LAS f32x4*)(b), w1 = *(const LAS f32x4*)(b + 4), k0 = *(const LAS f32x4*)(b + 64), k1 = *(const LAS f32x4*)(b + 68);
                const f32x4 b0 = *(const LAS f32x4*)(b + 128), b1 = *(const LAS f32x4*)(b + 132), q0 = *(const LAS f32x4*)(b + 192), q1 = *(const LAS f32x4*)(b + 196);
                const f32x4 r0 = *(const LAS f32x4*)(b + 256), r1 = *(const LAS f32x4*)(b + 260); const float v = src[tt * 384 + 320 + vrow];
                float d = (S[0] * k0[0] + S[1] * k0[1]) + (S[2] * k0[2] + S[3] * k0[3]) + (S[4] * k1[0] + S[5] * k1[1]) + (S[6] * k1[2] + S[7] * k1[3]);
                d += __shfl_xor(d, 1, 64); d += __shfl_xor(d, 2, 64); d += __shfl_xor(d, 4, 64);
                float y = 0.f;
#pragma unroll
                for (int j = 0; j < 4; ++j) { S[j] = S[j] * w0[j] - d * b0[j] + v * q0[j]; y += S[j] * r0[j]; S[4 + j] = S[4 + j] * w1[j] - d * b1[j] + v * q1[j]; y += S[4 + j] * r1[j]; }
                y += __shfl_xor(y, 1, 64); y += __shfl_xor(y, 2, 64); y += __shfl_xor(y, 4, 64);
                if (cg == 0) yb[tt * 64 + vrow] = y;
            }
            __syncthreads();
            for (int tt = w; tt < nT; tt += 8) {
                const float y = yb[tt * 64 + lane]; const float mean = wave_sum(y) * (1.0f / 64.0f), dy = y - mean, var = wave_sum(dy * dy) * (1.0f / 64.0f);
                const float yn = dy * rsqrtf(var + 64e-5f) * lg + lb; const size_t o = (size_t)(row0 + t0 + tt) * BW + h * 64 + lane;
                OB[o] = f2bf((yn + BON[o]) * G[o]);
            }
        }
#undef RW_STAGE
        float* op = (sq < PB ? outP + (((size_t)sq * 16 + h) * 64 + vrow) * 64 : outS + (((size_t)(sq - PB) * 16 + h) * 64 + vrow) * 64) + cg * 8;
#pragma unroll
        for (int j = 0; j < 8; ++j) op[j] = S[j];
        __syncthreads();
    }
}
constexpr int RS_SLOTS = 8, RS_SLOT_B = RB_EL * 2;
__device__ __forceinline__ void ph_rwkv_seq(const Ctx& c, int boff, const bf16_t* __restrict__ RB, const float* __restrict__ s0, float* __restrict__ outP, float* __restrict__ outS, bf16_t* __restrict__ OB) {
    const int lane = c.lane, r = lane & 15, q = lane >> 4, w = c.wave;
    LAS unsigned char* ring = c.lds;
    const int side = c.bid < 32 ? c.bid : c.bid - 64, nside = c.G - 64;
    for (int u = (c.bid >= boff && c.bid < boff + 32) ? c.bid - boff : ((c.bid < 32 || c.bid >= 96) ? 32 + side : (PB + SB) * 16); u < (PB + SB) * 16; u = u < 32 ? (PB + SB) * 16 : u + nside) {
        const int sq = u >> 4, h = u & 15;
        int nch, ch0, row0, ntok; const float* sp = nullptr; float* op;
        if (sq < PB) { nch = 256; ch0 = (sq * 16 + h) * 256; row0 = sq * PS; ntok = 16; op = outP + (size_t)(sq * 16 + h) * 4096; }
        else { nch = 1; ch0 = PB * 16 * 256 + (sq - PB) * 16 + h; row0 = MP + (sq - PB) * SS; ntok = SS; sp = s0 + (size_t)((sq - PB) * 16 + h) * 4096; op = outS + (size_t)((sq - PB) * 16 + h) * 4096; }
        if (w >= 4) {
            const int lw = w - 4, p0 = lw < 2 ? lw * 5 : 10 + (lw - 2) * 4, np = lw < 2 ? 5 : 4;
#define RS_ISSUE(ci_) do { const int cc_ = (ci_) < nch ? (ci_) : nch - 1; const char* g_ = (const char*)(RB + (size_t)(ch0 + cc_) * RB_EL) + p0 * 1024 + lane * 16; \
            LAS unsigned char* d_ = ring + ((ci_) % RS_SLOTS) * RS_SLOT_B + p0 * 1024; \
            _Pragma("unroll") for (int p_ = 0; p_ < 5; ++p_) if (p_ < np) __builtin_amdgcn_global_load_lds((const unsigned*)(g_ + p_ * 1024), (LAS unsigned*)(d_ + p_ * 1024), 16, 0, 0); } while (0)
            for (int ci = 0; ci < RS_SLOTS - 1; ++ci) RS_ISSUE(ci);
            if (lw < 2) asm volatile("s_waitcnt vmcnt(30)" ::: "memory"); else asm volatile("s_waitcnt vmcnt(24)" ::: "memory");
            __builtin_amdgcn_s_barrier();
            for (int ci = 0; ci < nch; ++ci) {
                RS_ISSUE(ci + RS_SLOTS - 1);
                if (lw < 2) asm volatile("s_waitcnt vmcnt(30)" ::: "memory"); else asm volatile("s_waitcnt vmcnt(24)" ::: "memory");
                __builtin_amdgcn_s_barrier();
            }
#undef RS_ISSUE
            asm volatile("s_waitcnt vmcnt(0)" ::: "memory");
        } else {
            const int vb = w; f32x4 acc[4];
#pragma unroll
            for (int kb = 0; kb < 4; ++kb) acc[kb] = sp ? *(const f32x4*)(sp + (size_t)(vb * 16 + r) * 64 + kb * 16 + q * 4) : (f32x4){0.f, 0.f, 0.f, 0.f};
            const bf16x8 zfrag = (bf16x8){0, 0, 0, 0, 0, 0, 0, 0};
            __builtin_amdgcn_s_barrier();
            for (int ci = 0; ci < nch; ++ci) {
                const LAS bf16_t* blob = (const LAS bf16_t*)(ring + (ci % RS_SLOTS) * RS_SLOT_B);
                bf16x8 mf[4][2], khf[4], qpf[2];
#pragma unroll
                for (int kb = 0; kb < 4; ++kb) { mf[kb][0] = *(const LAS bf16x8*)(blob + (kb * 16 + r) * 72 + q * 8); mf[kb][1] = *(const LAS bf16x8*)(blob + (kb * 16 + r) * 72 + 32 + q * 8);
                    khf[kb] = q < 2 ? *(const LAS bf16x8*)(blob + RB_KHP + (kb * 16 + r) * 24 + q * 8) : zfrag; }
                qpf[0] = *(const LAS bf16x8*)(blob + RB_QP + r * 72 + q * 8); qpf[1] = *(const LAS bf16x8*)(blob + RB_QP + r * 72 + 32 + q * 8);
                const bf16x8 vt = q < 2 ? *(const LAS bf16x8*)(blob + RB_VT + (vb * 16 + r) * 24 + q * 8) : zfrag;
                const bf16x8 ep = q < 2 ? *(const LAS bf16x8*)(blob + RB_EP + r * 24 + q * 8) : zfrag;
                const bf16x8 t0 = pack_acc(acc[0], acc[1]), t1 = pack_acc(acc[2], acc[3]);
                __builtin_amdgcn_sched_barrier(0);
#pragma unroll
                for (int kb = 0; kb < 4; ++kb) acc[kb] = mma16(mf[kb][0], t0, (f32x4){0.f, 0.f, 0.f, 0.f});
#pragma unroll
                for (int kb = 0; kb < 4; ++kb) acc[kb] = mma16(mf[kb][1], t1, acc[kb]);
#pragma unroll
                for (int kb = 0; kb < 4; ++kb) acc[kb] = mma16(khf[kb], vt, acc[kb]);
                f32x4 y = mma16(t0, qpf[0], (f32x4){0.f, 0.f, 0.f, 0.f}); y = mma16(t1, qpf[1], y); y = mma16(vt, ep, y);
                if (r < ntok) { u32x2 o; o.x = pk2(y[0], y[1]); o.y = pk2(y[2], y[3]); *(u32x2*)(OB + (size_t)(row0 + ci * 16 + r) * BW + h * 64 + vb * 16 + q * 4) = o; }
                asm volatile("s_waitcnt lgkmcnt(0)" ::: "memory");
                __builtin_amdgcn_s_barrier();
            }
#pragma unroll
            for (int kb = 0; kb < 4; ++kb) *(f32x4*)(op + (size_t)(vb * 16 + r) * 64 + kb * 16 + q * 4) = acc[kb];
        }
        __syncthreads();
    }
}
__device__ __forceinline__ void ph_rwkv_fin(const Ctx& c, const float* __restrict__ RW, const float* __restrict__ lng, const float* __restrict__ lnb, const bf16_t* __restrict__ RAW, bf16_t* __restrict__ OB) {
    const int lane = c.lane; const bf16_t* G = (const bf16_t*)(RW + 6 * (size_t)MPAD * BW); const bf16_t* BON = (const bf16_t*)(RW + 7 * (size_t)MPAD * BW);
    for (int i = c.bid * 8 + c.wave; i < MT * 2; i += c.G * 8) {
        const int row = i >> 1, cc = (i & 1) * 512 + lane * 8; const size_t o = (size_t)row * BW + cc;
        float x[8], bo[8], gt[8]; unpack8(*(const u32x4*)(RAW + o), x); unpack8(*(const u32x4*)(BON + o), bo); unpack8(*(const u32x4*)(G + o), gt);
        float s = 0.f;
#pragma unroll
        for (int j = 0; j < 8; ++j) s += x[j];
        s += __shfl_xor(s, 1, 64); s += __shfl_xor(s, 2, 64); s += __shfl_xor(s, 4, 64);
        const float mean = s * (1.0f / 64.0f); float qq = 0.f;
#pragma unroll
        for (int j = 0; j < 8; ++j) { const float d = x[j] - mean; qq += d * d; }
        qq += __shfl_xor(qq, 1, 64); qq += __shfl_xor(qq, 2, 64); qq += __shfl_xor(qq, 4, 64);
        const float rstd = rsqrtf(qq * (1.0f / 64.0f) + 64e-5f);
        const f32x4 g0 = *(const f32x4*)(lng + cc), g1 = *(const f32x4*)(lng + cc + 4), b0 = *(const f32x4*)(lnb + cc), b1 = *(const f32x4*)(lnb + cc + 4); float ov[8];
#pragma unroll
        for (int j = 0; j < 8; ++j) ov[j] = ((x[j] - mean) * rstd * (j < 4 ? g0[j] : g1[j - 4]) + (j < 4 ? b0[j] : b1[j - 4]) + bo[j]) * gt[j];
        *(u32x4*)(OB + o) = (u32x4){pk2(ov[0], ov[1]), pk2(ov[2], ov[3]), pk2(ov[4], ov[5]), pk2(ov[6], ov[7])};
    }
}

__device__ __forceinline__ void ph_memattn_sample(const Ctx& c, int boff, const bf16_t* __restrict__ U, const float* __restrict__ mk, const float* __restrict__ mv, bf16_t* __restrict__ OB) {
    LAS float* ps = (LAS float*)c.lds;
    LAS float* pT = ps + 1024;
    LAS float* red = pT + 1024;
    const int tid = c.tid, lane = c.lane, r = lane & 15, q = lane >> 4, w = c.wave;
    for (int u = (c.bid - boff + c.G) % c.G; u < SB * 4; u += c.G) {
        const int sq = u >> 2, h = u & 3;
        bf16x8 qf[8];
#pragma unroll
        for (int ks = 0; ks < 8; ++ks) { u32x4 raw = (u32x4){0u, 0u, 0u, 0u};
            if (r < 4) raw = *(const u32x4*)(U + (size_t)(MP + sq * SS + r) * NINP + U_MQ + h * 256 + ks * 32 + q * 8);
            qf[ks] = __builtin_bit_cast(bf16x8, raw); }
        { f32x4 ka[2][8], kb2[2][8];
#pragma unroll
          for (int mt = 0; mt < 2; ++mt) { const float* kr = mk + (((size_t)sq * MEMT + (w * 2 + mt) * 16 + r) * 4 + h) * 256 + q * 8;
#pragma unroll
            for (int ks = 0; ks < 8; ++ks) { ka[mt][ks] = *(const f32x4*)(kr + ks * 32); kb2[mt][ks] = *(const f32x4*)(kr + ks * 32 + 4); } }
          __builtin_amdgcn_sched_barrier(0);
#pragma unroll
          for (int mt = 0; mt < 2; ++mt) { f32x4 d = (f32x4){0.f, 0.f, 0.f, 0.f};
#pragma unroll
            for (int ks = 0; ks < 8; ++ks) { u32x4 p; p.x = pk2(ka[mt][ks][0], ka[mt][ks][1]); p.y = pk2(ka[mt][ks][2], ka[mt][ks][3]); p.z = pk2(kb2[mt][ks][0], kb2[mt][ks][1]); p.w = pk2(kb2[mt][ks][2], kb2[mt][ks][3]);
                d = mma16(__builtin_bit_cast(bf16x8, p), qf[ks], d); }
            if (r < 4) *(LAS f32x4*)(ps + r * 256 + (w * 2 + mt) * 16 + q * 4) = d * 0.0625f; } }
        __syncthreads();
        if (w < 4) { LAS float* pr = ps + w * 256; float x[4]; float mx = -3.0e38f;
#pragma unroll
            for (int j = 0; j < 4; ++j) { x[j] = pr[lane + 64 * j]; mx = fmaxf(mx, x[j]); }
            mx = wave_max(mx); float s = 0.f;
#pragma unroll
            for (int j = 0; j < 4; ++j) { x[j] = __expf(x[j] - mx); s += x[j]; }
            const float inv = 1.0f / wave_sum(s);
#pragma unroll
            for (int j = 0; j < 4; ++j) pT[(lane + 64 * j) * 4 + w] = x[j] * inv; }
        __syncthreads();
        { const int vq = tid & 63, ms = w; f32x4 o[4];
#pragma unroll
          for (int t = 0; t < 4; ++t) o[t] = (f32x4){0.f, 0.f, 0.f, 0.f};
          const float* vr = mv + (((size_t)sq * MEMT + ms * 32) * 4 + h) * 256 + vq * 4;
#pragma unroll 1
          for (int m0 = 0; m0 < 32; m0 += 16) { f32x4 vv[16];
#pragma unroll
              for (int m = 0; m < 16; ++m) vv[m] = *(const f32x4*)(vr + (size_t)(m0 + m) * 1024);
#pragma unroll
              for (int m = 0; m < 16; ++m) { const f32x4 p = *(const LAS f32x4*)(pT + (ms * 32 + m0 + m) * 4);
#pragma unroll
                  for (int t = 0; t < 4; ++t) o[t] += vv[m] * p[t]; } }
#pragma unroll
          for (int t = 0; t < 4; ++t) *(LAS f32x4*)(red + (ms * 4 + t) * 256 + vq * 4) = o[t]; }
        __syncthreads();
        { const int t = tid >> 7, v2 = (tid & 127) * 2; float a0 = 0.f, a1 = 0.f;
#pragma unroll
          for (int sl = 0; sl < 8; ++sl) { const f32x2 x = *(const LAS f32x2*)(red + (sl * 4 + t) * 256 + v2); a0 += x[0]; a1 += x[1]; }
          *(unsigned*)(OB + (size_t)(MP + sq * SS + t) * BW + h * 256 + v2) = pk2(a0, a1); }
        __syncthreads();
    }
}

template <int K, int LDA, int LDB> __device__ __forceinline__ void skinny_pair(const Ctx& c, const bf16_t* __restrict__ A, const bf16_t* __restrict__ B0, const bf16_t* __restrict__ B1, f32x4 (&out)[2], int rot) {
    LAS f32x4* red = (LAS f32x4*)c.lds;
    const int lane = c.lane, r = lane & 15, q = lane >> 4, w = c.wave;
    constexpr int KS = K / 8;
    const bf16_t* ap = A + (size_t)r * LDA + w * KS + q * 8; const bf16_t* b0 = B0 + (size_t)r * LDB + w * KS + q * 8; const bf16_t* b1 = B1 + (size_t)r * LDB + w * KS + q * 8;
    f32x4 acc[2][8];
#pragma unroll
    for (int n = 0; n < 2; ++n)
#pragma unroll
        for (int m = 0; m < 8; ++m) acc[n][m] = (f32x4){0.f, 0.f, 0.f, 0.f};
    int kk = (int)((unsigned)rot % (unsigned)(KS / 32));
#pragma unroll 2
    for (int it = 0; it < KS / 32; ++it) { const int ks = kk; kk = kk + 1 == KS / 32 ? 0 : kk + 1;
        const bf16x8 f0 = *(const bf16x8*)(b0 + ks * 32), f1 = *(const bf16x8*)(b1 + ks * 32); bf16x8 af[8];
#pragma unroll
        for (int m = 0; m < 8; ++m) af[m] = *(const bf16x8*)(ap + (size_t)(m * 16) * LDA + ks * 32);
        __builtin_amdgcn_sched_barrier(0);
#pragma unroll
        for (int m = 0; m < 8; ++m) { acc[0][m] = mma16(f0, af[m], acc[0][m]); acc[1][m] = mma16(f1, af[m], acc[1][m]); } }
    __syncthreads();
#pragma unroll
    for (int n = 0; n < 2; ++n)
#pragma unroll
        for (int m = 0; m < 8; ++m) red[(w * 16 + n * 8 + m) * 64 + lane] = acc[n][m];
    __syncthreads();
#pragma unroll
    for (int n = 0; n < 2; ++n) { f32x4 s = red[(n * 8 + w) * 64 + lane];
#pragma unroll
        for (int ww = 1; ww < 8; ++ww) s += red[(ww * 16 + n * 8 + w) * 64 + lane];
        out[n] = s; }
}
template <int K, int LDA, int LDB> __device__ __forceinline__ f32x4 skinny_one(const Ctx& c, const bf16_t* __restrict__ A, const bf16_t* __restrict__ B0, int rot) {
    LAS f32x4* red = (LAS f32x4*)c.lds;
    const int lane = c.lane, r = lane & 15, q = lane >> 4, w = c.wave;
    constexpr int KS = K / 8, NK = KS / 32;
    const bf16_t* ap = A + (size_t)r * LDA + w * KS + q * 8; const bf16_t* b0 = B0 + (size_t)r * LDB + w * KS + q * 8;
    f32x4 acc[8];
#pragma unroll
    for (int m = 0; m < 8; ++m) acc[m] = (f32x4){0.f, 0.f, 0.f, 0.f};
    int kk = (int)((unsigned)rot % (unsigned)NK);
#pragma unroll 4
    for (int it = 0; it < NK; ++it) { const int ks = kk; kk = kk + 1 == NK ? 0 : kk + 1;
        const bf16x8 f0 = *(const bf16x8*)(b0 + ks * 32); bf16x8 af[8];
#pragma unroll
        for (int m = 0; m < 8; ++m) af[m] = *(const bf16x8*)(ap + (size_t)(m * 16) * LDA + ks * 32);
        __builtin_amdgcn_sched_barrier(0);
#pragma unroll
        for (int m = 0; m < 8; ++m) acc[m] = mma16(f0, af[m], acc[m]); }
    __syncthreads();
#pragma unroll
    for (int m = 0; m < 8; ++m) red[(w * 8 + m) * 64 + lane] = acc[m];
    __syncthreads();
    f32x4 s = red[w * 64 + lane];
#pragma unroll
    for (int ww = 1; ww < 8; ++ww) s += red[(ww * 8 + w) * 64 + lane];
    return s;
}
template <int K, int LDA, int LDB> __device__ __forceinline__ f32x4 skinny_half(const Ctx& c, const bf16_t* __restrict__ A, const bf16_t* __restrict__ B0) {
    LAS f32x4* red = (LAS f32x4*)c.lds;
    const int lane = c.lane, r = lane & 15, q = lane >> 4, w = c.wave;
    constexpr int KS = K / 8, NK = KS / 32;
    const bf16_t* ap = A + (size_t)r * LDA + w * KS + q * 8; const bf16_t* b0 = B0 + (size_t)r * LDB + w * KS + q * 8;
    f32x4 acc[4];
#pragma unroll
    for (int m = 0; m < 4; ++m) acc[m] = (f32x4){0.f, 0.f, 0.f, 0.f};
#pragma unroll 4
    for (int ks = 0; ks < NK; ++ks) {
        const bf16x8 f0 = *(const bf16x8*)(b0 + ks * 32); bf16x8 af[4];
#pragma unroll
        for (int m = 0; m < 4; ++m) af[m] = *(const bf16x8*)(ap + (size_t)(m * 16) * LDA + ks * 32);
        __builtin_amdgcn_sched_barrier(0);
#pragma unroll
        for (int m = 0; m < 4; ++m) acc[m] = mma16(f0, af[m], acc[m]); }
    __syncthreads();
#pragma unroll
    for (int m = 0; m < 4; ++m) red[(w * 4 + m) * 64 + lane] = acc[m];
    __syncthreads();
    f32x4 s = (f32x4){0.f, 0.f, 0.f, 0.f};
    if (w < 4) { s = red[w * 64 + lane];
#pragma unroll
        for (int ww = 1; ww < 8; ++ww) s += red[(ww * 4 + w) * 64 + lane]; }
    return s;
}
__device__ __forceinline__ u32x2 pk4(const f32x4 v) { u32x2 o; o.x = pk2(v[0], v[1]); o.y = pk2(v[2], v[3]); return o; }
#define SKINNY_LOOP(total_) for (int s = c.bid - base; s >= 0 && s < (total_); s += ncu)
__device__ __forceinline__ void ph_sk_in(const Ctx& c, int base, int ncu, const bf16_t* __restrict__ HB, const bf16_t* __restrict__ W, bf16_t* __restrict__ U) {
    const int r = c.lane & 15, q = c.lane >> 4, w = c.wave;
    SKINNY_LOOP(NINP / 32) { f32x4 o[2]; skinny_pair<DM, DM, DM>(c, HB + (size_t)MP * DM, W + (size_t)(s * 32) * DM, W + (size_t)(s * 32 + 16) * DM, o, s);
        bf16_t* up = U + (size_t)(MP + w * 16 + r) * NINP + s * 32 + q * 4; *(u32x2*)up = pk4(o[0]); *(u32x2*)(up + 16) = pk4(o[1]); }
}
__device__ __forceinline__ void ph_sk_merge(const Ctx& c, int base, int ncu, const bf16_t* __restrict__ BR, const bf16_t* __restrict__ W, const bf16_t* __restrict__ U, const float* __restrict__ gate_b, bf16_t* __restrict__ MGB) {
    const int r = c.lane & 15, q = c.lane >> 4, w = c.wave;
    SKINNY_LOOP(DM / 8) { const int ct = s >> 1, hf = s & 1; const size_t row = (size_t)(MP + hf * 64 + (w & 3) * 16 + r); const int col = ct * 16 + q * 4; f32x4 tot = (f32x4){0.f, 0.f, 0.f, 0.f};
#pragma unroll 1
        for (int z = 0; z < 4; ++z) { const f32x4 o = skinny_half<BW, BW, BW>(c, BR + ((size_t)z * MPAD + MP + hf * 64) * BW, W + ((size_t)z * DM + ct * 16) * BW);
            if (w < 4) { const u32x2 gp = *(const u32x2*)(U + row * NINP + U_GP + z * DM + col); const f32x4 gb = *(const f32x4*)(gate_b + z * DM + col);
            tot[0] += sigmoidf_(__uint_as_float(gp.x << 16) + gb[0]) * o[0]; tot[1] += sigmoidf_(__uint_as_float(gp.x & 0xffff0000u) + gb[1]) * o[1];
            tot[2] += sigmoidf_(__uint_as_float(gp.y << 16) + gb[2]) * o[2]; tot[3] += sigmoidf_(__uint_as_float(gp.y & 0xffff0000u) + gb[3]) * o[3]; } }
        if (w < 4) *(u32x2*)(MGB + row * DM + col) = pk4(tot); }
}
template <int K> __device__ __forceinline__ void ph_sk_res(const Ctx& c, int base, int ncu, const bf16_t* __restrict__ A, const bf16_t* __restrict__ W, const bf16_t* __restrict__ R, bf16_t* __restrict__ Y) {
    const int r = c.lane & 15, q = c.lane >> 4, w = c.wave;
    SKINNY_LOOP(DM / 8) { const int ct = s >> 1, hf = s & 1; const f32x4 o = skinny_half<K, K, K>(c, A + (size_t)(MP + hf * 64) * K, W + (size_t)(ct * 16) * K);
        if (w < 4) { const size_t off = (size_t)(MP + hf * 64 + w * 16 + r) * DM + ct * 16 + q * 4; const u32x2 rr = *(const u32x2*)(R + off);
        const f32x4 rv = (f32x4){__uint_as_float(rr.x << 16), __uint_as_float(rr.x & 0xffff0000u), __uint_as_float(rr.y << 16), __uint_as_float(rr.y & 0xffff0000u)};
        *(u32x2*)(Y + off) = pk4(rv * ALPHA + o); } }
}
__device__ __forceinline__ void ph_sk_gu(const Ctx& c, int base, int ncu, const bf16_t* __restrict__ X1B, const bf16_t* __restrict__ W, bf16_t* __restrict__ ACT) {
    const int r = c.lane & 15, q = c.lane >> 4, w = c.wave;
    SKINNY_LOOP(DFF / 16) { const int t = s >> 3, j0 = (s & 7) * 16; f32x4 o[2];
        skinny_pair<DM, DM, DM>(c, X1B + (size_t)MP * DM, W + (size_t)(t * 256 + j0) * DM, W + (size_t)(t * 256 + 128 + j0) * DM, o, s);
        f32x4 v;
#pragma unroll
        for (int j = 0; j < 4; ++j) v[j] = o[0][j] * sigmoidf_(o[0][j]) * o[1][j];
        *(u32x2*)(ACT + (size_t)(MP + w * 16 + r) * DFF + t * 128 + j0 + q * 4) = pk4(v); }
}
#undef SKINNY_LOOP

constexpr int LDS_BAR_OFF = 147456;
constexpr int LDS_BYTES = LDS_BAR_OFF + 64;
struct Args { const float* in[37]; float* out; unsigned char* ws; };

typedef pg8::Gemm<DM, DM, DM, 2, 8, NL, 1, false, 0, 0, (long)DM * DM, 0> GemmMem;
typedef pg8::Gemm<DM, DM, DM, MP / 256, NINP / 256> GemmIn;
typedef pg8::Gemm<NINP, 1024, 256, PS / 256, 1, 8, 4, false, (long)PS * NINP, 256, 256 * 1024, 256> GemmScore;
typedef pg8::Gemm<256, 256, 256, PS / 256, 1, 8, 4, false, (long)4 * 4096 * 256, (long)4096 * 256, 4 * 65536, 65536> GemmPV;
typedef pg8::Gemm<BW, BW, BW, MP / 256, DM / 256, 4, 1, true, (long)MPAD * BW, 0, (long)DM * BW, 0> GemmBranch;
typedef pg8::Gemm<DM, DM, DM, MP / 256, DM / 256> GemmOut;
typedef pg8::Gemm<DM, DM, DM, MP / 256, 2 * DFF / 256> GemmGU;
typedef pg8::Gemm<DFF, DFF, DFF, MP / 256, DM / 256> GemmDown;
template <class GT> __device__ __forceinline__ GT mk_gemm(const Ctx& c, const bf16_t* A, const bf16_t* B) { GT g; g.A = A; g.B = B; g.G = c.G; g.c = c.bid; return g; }

template <int OFF> __device__ __forceinline__ unsigned long long karg_u64(unsigned long long kargs) {
    unsigned long long p; asm volatile("s_load_dwordx2 %0, %1, %2\n\ts_waitcnt lgkmcnt(0)" : "=s"(p) : "s"(kargs), "n"(OFF) : "memory"); return p;
}
#define GPTR(T, x) ((T*)(__attribute__((address_space(1))) T*)(x))
#define INP(k) GPTR(const float, karg_u64<(k) * 8>(kargs))
#define OUTP() GPTR(float, karg_u64<37 * 8>(kargs))
#define WSP() GPTR(unsigned char, karg_u64<38 * 8>(kargs))

__global__ void __launch_bounds__(512, 2) mega_fwd(Args a_unused) {
    extern __shared__ __attribute__((aligned(16))) unsigned char lds_raw[];
    const unsigned long long kargs = (unsigned long long)__builtin_amdgcn_kernarg_segment_ptr();
    Ctx c0; c0.tid = threadIdx.x; c0.lane = c0.tid & 63; c0.wave = __builtin_amdgcn_readfirstlane(c0.tid >> 6); c0.bid = blockIdx.x; c0.G = gridDim.x; c0.lds = (LAS unsigned char*)lds_raw;
    if (c0.tid < 4) ((LAS unsigned*)(c0.lds + LDS_BAR_OFF))[c0.tid] = 0u;
    __syncthreads();
    const XcdBarrier bar = xcd_barrier_post((unsigned*)(WSP() + WS_CTL), (volatile LAS unsigned*)(c0.lds + LDS_BAR_OFF));

#define WP_SIDE 2
#define WP_GLA 3
#define WP_RW 2
#define WPREP_WIN(cc_, L_) do { unsigned char* ws_ = WSP(); \
      ph_wprep(cc_, INP(10) + (size_t)(L_) * DM * NIN, (bf16_t*)(ws_ + WS_WIN) + (size_t)(L_) * NINP * DM, DM, NIN, NINP, 1, 1, 0, 0); } while (0)
#define WPREP_LAYER(cc_, L_) do { WPREP_WIN(cc_, L_); WPREP_REST(cc_, L_); } while (0)
#define WPREP_REST(cc_, L_) do { unsigned char* ws_ = WSP(); \
      ph_wprep(cc_, INP(29) + (size_t)(L_) * 4 * BW * DM, (bf16_t*)(ws_ + WS_WBR) + (size_t)(L_) * 4 * DM * BW, BW, DM, DM, 0, 4, (size_t)BW * DM, (size_t)DM * BW); \
      ph_wprep(cc_, INP(30) + (size_t)(L_) * DM * DM, (bf16_t*)(ws_ + WS_WOUT) + (size_t)(L_) * DM * DM, DM, DM, DM, 0, 1, 0, 0); \
      ph_wprep(cc_, INP(33) + (size_t)(L_) * DM * 2 * DFF, (bf16_t*)(ws_ + WS_WGU) + (size_t)(L_) * 2 * DFF * DM, DM, 2 * DFF, 2 * DFF, 2, 1, 0, 0); \
      ph_wprep(cc_, INP(34) + (size_t)(L_) * DFF * DM, (bf16_t*)(ws_ + WS_WDN) + (size_t)(L_) * DM * DFF, DFF, DM, DM, 0, 1, 0, 0); } while (0)
    { const Ctx c = fresh(c0); unsigned char* ws = WSP();
      ph_wprep(c, INP(28), (bf16_t*)(ws + WS_WMEM), DM, DM, DM, 0, NL, (size_t)DM * DM, (size_t)DM * DM);
      WPREP_WIN(c, 0);
      ph_lrw(c, INP(19), INP(21), INP(22), (bf16_t*)(ws + WS_LRW));
      ph_xprep(c, INP(0), INP(1), INP(2), (float*)nullptr, (bf16_t*)(ws + WS_HB), (bf16_t*)(ws + WS_MEMB)); }
    xcd_barrier(bar);
    if (c0.bid >= 64) { Ctx c = fresh(c0); c.bid -= 64; c.G -= 64; WPREP_REST(c, 0); }
    { const Ctx c = fresh(c0); unsigned char* ws = WSP(); float* out = OUTP();
      GemmMem g = mk_gemm<GemmMem>(c, (const bf16_t*)(ws + WS_MEMB), (const bf16_t*)(ws + WS_WMEM));
      pg8::EpiMem E; E.outK = out + O_MKP; E.outV = out + O_MVP; E.kb = (bf16_t*)(ws + WS_MKB); E.vt = (bf16_t*)(ws + WS_MVT); pg8::gemm_phase<GemmMem, pg8::EpiMem, true, true>(c.lds, c.tid, g, E); }

    for (int l = 0; l < NL; ++l) {
        { const Ctx c = fresh(c0); unsigned char* ws = WSP();
          GemmIn g = mk_gemm<GemmIn>(c, (const bf16_t*)(ws + WS_HB), (const bf16_t*)(ws + WS_WIN) + (size_t)l * NINP * DM);
          pg8::EpiBf16 E; E.O = (bf16_t*)(ws + WS_U); E.zs = 0; E.ldc = NINP; E.pad = 0; pg8::gemm_phase<GemmIn, pg8::EpiBf16, true, true>(c.lds, c.tid, g, E); }
        { const Ctx c = fresh(c0); unsigned char* ws = WSP(); ph_sk_in(c, c.G > 192 ? 96 : 0, c.G > 192 ? c.G - 96 : c.G, (const bf16_t*)(ws + WS_HB), (const bf16_t*)(ws + WS_WIN) + (size_t)l * NINP * DM, (bf16_t*)(ws + WS_U)); }
        xcd_barrier(bar);
        { const Ctx c = fresh(c0); unsigned char* ws = WSP(); float* out = OUTP(); const bf16_t* U = (const bf16_t*)(ws + WS_U); bf16_t* BR = (bf16_t*)(ws + WS_BR);
          (void)out; (void)BR;
          ph_gla_pre(c, U, INP(12) + (size_t)l * 16 * 512, INP(13) + (size_t)l * 512, (bf16_t*)(ws + WS_GLQD), (bf16_t*)(ws + WS_GLKH), (bf16_t*)(ws + WS_GLE), (bf16_t*)(ws + WS_GLVT), (float*)(ws + WS_GLGC)); }
        { const Ctx c = fresh(c0); unsigned char* ws = WSP();
          ph_rwkv_pre(c, (const bf16_t*)(ws + WS_U), INP(9) + (size_t)l * SB * RWC, INP(17) + (size_t)l * RWC, INP(18) + (size_t)l * BW, INP(19) + (size_t)l * 64 * BW, INP(20) + (size_t)l * BW, INP(21) + (size_t)l * 64 * BW,
                       INP(22) + (size_t)l * 128 * BW, INP(23) + (size_t)l * BW, INP(24) + (size_t)l * BW, INP(25) + (size_t)l * BW, (float*)(ws + WS_RW), (bf16_t*)(ws + WS_RB), (const bf16_t*)(ws + WS_LRW) + (size_t)l * 1024 * 256); }
        { const Ctx c = fresh(c0); unsigned char* ws = WSP(); ph_memattn_prompt(c, (const bf16_t*)(ws + WS_U), (const bf16_t*)(ws + WS_MKB) + (size_t)l * 512 * 1024, (const bf16_t*)(ws + WS_MVT) + (size_t)l * 8 * 65536, (bf16_t*)(ws + WS_BR) + (size_t)3 * MPAD * BW); }
        xcd_barrier(bar);
        { const Ctx c = fresh(c0); unsigned char* ws = WSP(); float* out = OUTP();
          ph_rwkv_seq(c, 64, (const bf16_t*)(ws + WS_RB), INP(8) + (size_t)l * SB * 16 * 4096, out + O_RWP + (size_t)l * PB * 16 * 4096, out + O_RWS + (size_t)l * SB * 16 * 4096,
                      (bf16_t*)(ws + WS_RAW) + (size_t)MPAD * BW); }
        { const Ctx c = fresh(c0); unsigned char* ws = WSP(); float* out = OUTP();
          ph_gla_seq(c, 32, (const bf16_t*)(ws + WS_GLQD), (const bf16_t*)(ws + WS_GLKH), (const bf16_t*)(ws + WS_GLE), (const bf16_t*)(ws + WS_GLVT), (const float*)(ws + WS_GLGC),
                     INP(7) + (size_t)l * SB * 4 * 32768, out + O_GLAP + (size_t)l * PB * 4 * 32768, out + O_GLAS + (size_t)l * SB * 4 * 32768, (bf16_t*)(ws + WS_RAW)); }
        if ((c0.bid < 32 || c0.bid >= 96) && c0.G > 96) {
        { Ctx c = fresh(c0); c.bid = c.bid < 32 ? c.bid : c.bid - 64; c.G = c.G - 64; unsigned char* ws = WSP(); ph_swa_prompt(c, (const bf16_t*)(ws + WS_U), INP(16) + (size_t)l * 16, (bf16_t*)(ws + WS_BR) + (size_t)MPAD * BW); }
        { Ctx c = fresh(c0); c.bid = c.bid < 32 ? c.bid : c.bid - 64; c.G = c.G - 64;
          unsigned char* ws = WSP();
          ph_swa_sample(c, (const bf16_t*)(ws + WS_U), INP(3) + (size_t)l * SB * 16384, INP(4) + (size_t)l * SB * 16384, INP(16) + (size_t)l * 16, (bf16_t*)(ws + WS_BR) + (size_t)MPAD * BW); }
        { Ctx c = fresh(c0); c.bid = c.bid < 32 ? c.bid : c.bid - 64; c.G = c.G - 64; unsigned char* ws = WSP();
          ph_memattn_sample(c, 64, (const bf16_t*)(ws + WS_U), INP(5) + (size_t)l * SB * MEMT * 1024, INP(6) + (size_t)l * SB * MEMT * 1024, (bf16_t*)(ws + WS_BR) + (size_t)3 * MPAD * BW); }
        { Ctx c = fresh(c0); c.bid = c.bid < 32 ? c.bid : c.bid - 64; c.G = c.G - 64; unsigned char* ws = WSP();
          ph_copy_outs(c, (const bf16_t*)(ws + WS_U), INP(3) + (size_t)l * SB * 16384, INP(4) + (size_t)l * SB * 16384, OUTP(), l); }
        }
        if (l + 1 < NL) { const Ctx c = fresh(c0); unsigned char* ws = WSP(); const int L = l + 1;
          ph_wprep_dyn(c, (unsigned*)(ws + WS_CTL + 16384) + 64 * L,
                       INP(10) + (size_t)L * DM * NIN, INP(29) + (size_t)L * 4 * BW * DM, INP(30) + (size_t)L * DM * DM, INP(33) + (size_t)L * DM * 2 * DFF, INP(34) + (size_t)L * DFF * DM,
                       (bf16_t*)(ws + WS_WIN) + (size_t)L * NINP * DM, (bf16_t*)(ws + WS_WBR) + (size_t)L * 4 * DM * BW, (bf16_t*)(ws + WS_WOUT) + (size_t)L * DM * DM,
                       (bf16_t*)(ws + WS_WGU) + (size_t)L * 2 * DFF * DM, (bf16_t*)(ws + WS_WDN) + (size_t)L * DM * DFF); }
        xcd_barrier(bar);
        { const Ctx c = fresh(c0); unsigned char* ws = WSP(); ph_rwkv_fin(c, (const float*)(ws + WS_RW), INP(26) + (size_t)l * BW, INP(27) + (size_t)l * BW, (const bf16_t*)(ws + WS_RAW) + (size_t)MPAD * BW, (bf16_t*)(ws + WS_BR) + (size_t)2 * MPAD * BW); }
        { const Ctx c = fresh(c0); unsigned char* ws = WSP(); ph_gla_fin(c, (const bf16_t*)(ws + WS_U), INP(14) + (size_t)l * BW, INP(15) + (size_t)l * BW, (const bf16_t*)(ws + WS_RAW), (bf16_t*)(ws + WS_BR)); }
        xcd_barrier(bar);
        { const Ctx c = fresh(c0); unsigned char* ws = WSP();
          GemmBranch g = mk_gemm<GemmBranch>(c, (const bf16_t*)(ws + WS_BR), (const bf16_t*)(ws + WS_WBR) + (size_t)l * 4 * DM * BW);
          pg8::EpiMerge E; E.MG = (float*)(ws + WS_MG); E.MGB = (bf16_t*)(ws + WS_MGB); E.U = (const bf16_t*)(ws + WS_U); E.gate_b = INP(11) + (size_t)l * 4 * DM; pg8::gemm_phase<GemmBranch, pg8::EpiMerge, true, true>(c.lds, c.tid, g, E); }
        { const Ctx c = fresh(c0); unsigned char* ws = WSP(); ph_sk_merge(c, 0, c.G, (const bf16_t*)(ws + WS_BR), (const bf16_t*)(ws + WS_WBR) + (size_t)l * 4 * DM * BW, (const bf16_t*)(ws + WS_U), INP(11) + (size_t)l * 4 * DM, (bf16_t*)(ws + WS_MGB)); }
        xcd_barrier(bar);
        { const Ctx c = fresh(c0); unsigned char* ws = WSP();
          GemmOut g = mk_gemm<GemmOut>(c, (const bf16_t*)(ws + WS_MGB), (const bf16_t*)(ws + WS_WOUT) + (size_t)l * DM * DM);
          pg8::EpiRes E; E.R = (const bf16_t*)(ws + WS_HB); E.Y = (bf16_t*)(ws + WS_Y); pg8::gemm_phase<GemmOut, pg8::EpiRes, true, true>(c.lds, c.tid, g, E); }
        { const Ctx c = fresh(c0); unsigned char* ws = WSP(); ph_sk_res<DM>(c, 0, c.G, (const bf16_t*)(ws + WS_MGB), (const bf16_t*)(ws + WS_WOUT) + (size_t)l * DM * DM, (const bf16_t*)(ws + WS_HB), (bf16_t*)(ws + WS_Y)); }
        xcd_barrier(bar);
        { const Ctx c = fresh(c0); unsigned char* ws = WSP(); ph_ln(c, (const bf16_t*)(ws + WS_Y), INP(31) + (size_t)l * DM, INP(32) + (size_t)l * DM, (float*)nullptr, (bf16_t*)(ws + WS_X1B), nullptr, MT, 0); }
        xcd_barrier(bar);
        { const Ctx c = fresh(c0); unsigned char* ws = WSP();
          GemmGU g = mk_gemm<GemmGU>(c, (const bf16_t*)(ws + WS_X1B), (const bf16_t*)(ws + WS_WGU) + (size_t)l * 2 * DFF * DM);
          pg8::EpiSwiGLU E; E.O = (bf16_t*)(ws + WS_ACT); pg8::gemm_phase<GemmGU, pg8::EpiSwiGLU, true, true>(c.lds, c.tid, g, E); }
        { const Ctx c = fresh(c0); unsigned char* ws = WSP(); ph_sk_gu(c, c.G > 192 ? 128 : 0, c.G > 192 ? c.G - 128 : c.G, (const bf16_t*)(ws + WS_X1B), (const bf16_t*)(ws + WS_WGU) + (size_t)l * 2 * DFF * DM, (bf16_t*)(ws + WS_ACT)); }
        xcd_barrier(bar);
        { const Ctx c = fresh(c0); unsigned char* ws = WSP();
          GemmDown g = mk_gemm<GemmDown>(c, (const bf16_t*)(ws + WS_ACT), (const bf16_t*)(ws + WS_WDN) + (size_t)l * DM * DFF);
          pg8::EpiRes E; E.R = (const bf16_t*)(ws + WS_X1B); E.Y = (bf16_t*)(ws + WS_Y); pg8::gemm_phase<GemmDown, pg8::EpiRes, true, true>(c.lds, c.tid, g, E); }
        { const Ctx c = fresh(c0); unsigned char* ws = WSP(); ph_sk_res<DFF>(c, 0, c.G, (const bf16_t*)(ws + WS_ACT), (const bf16_t*)(ws + WS_WDN) + (size_t)l * DM * DFF, (const bf16_t*)(ws + WS_X1B), (bf16_t*)(ws + WS_Y)); }
        xcd_barrier(bar);
        { const Ctx c = fresh(c0); unsigned char* ws = WSP(); float* out = OUTP(); ph_ln(c, (const bf16_t*)(ws + WS_Y), INP(35) + (size_t)l * DM, INP(36) + (size_t)l * DM, (float*)nullptr, (bf16_t*)(ws + WS_HB), l == NL - 1 ? out : nullptr, MT, MT); }
        xcd_barrier(bar);
    }
}

extern "C" void kernel_launch(void* const* d_in, const int* in_sizes, int n_in, void* d_out, int out_size, void* d_ws, size_t ws_size, hipStream_t stream) {
    static int grid = 0;
    if (grid == 0) {
        if (n_in != 37 || (size_t)out_size != O_END || ws_size < WS_END) { fprintf(stderr, "kernel_launch: unexpected sizes (n_in %d out %d ws %zu need %zu)\n", n_in, out_size, ws_size, (size_t)WS_END); grid = -1; return; }
        int dev = 0, cus = 0;
        if (hipGetDevice(&dev) != hipSuccess || hipDeviceGetAttribute(&cus, hipDeviceAttributeMultiprocessorCount, dev) != hipSuccess) { grid = -1; return; }
        if (hipFuncSetAttribute((const void*)mega_fwd, hipFuncAttributeMaxDynamicSharedMemorySize, LDS_BYTES) != hipSuccess) { fprintf(stderr, "kernel_launch: hipFuncSetAttribute failed\n"); grid = -1; return; }
        int per_cu = 0;
        if (hipOccupancyMaxActiveBlocksPerMultiprocessor(&per_cu, (const void*)mega_fwd, 512, LDS_BYTES) != hipSuccess || per_cu < 1) { fprintf(stderr, "kernel_launch: occupancy query says %d\n", per_cu); }
        (void)hipGetLastError();
        grid = cus;
    }
    if (grid < 0) return;
    (void)hipMemsetAsync((unsigned char*)d_ws + WS_CTL, 0, 16384 + 1024, stream);
    Args a; memset(&a, 0, sizeof a);
    for (int i = 0; i < 37; ++i) a.in[i] = (const float*)d_in[i];
    a.out = (float*)d_out; a.ws = (unsigned char*)d_ws;
    hipLaunchKernelGGL(mega_fwd, dim3(grid), dim3(512), LDS_BYTES, stream, a);
}
```

```cpp
#include <hip/hip_runtime.h>
#include <cstdio>
#include <cstdint>
#include <cstring>

#define LAS __attribute__((address_space(3)))
typedef unsigned short bf16_t;
typedef short bf16x8 __attribute__((ext_vector_type(8)));
typedef float f32x4 __attribute__((ext_vector_type(4)));
typedef float f32x2 __attribute__((ext_vector_type(2)));
typedef unsigned u32x4 __attribute__((ext_vector_type(4)));
typedef unsigned u32x2 __attribute__((ext_vector_type(2)));

constexpr int DM = 2048, NL = 4;
constexpr int PB = 2, PS = 4096, MP = PB * PS;
constexpr int SB = 32, SS = 4, MS = SB * SS;
constexpr int MT = MP + MS;
constexpr int MPAD = 8448;
constexpr int NIN = 16912, NINP = 17152;
constexpr int U_GQ = 0, U_GK = 512, U_GV = 1024, U_GR = 2048, U_GA = 3072, U_SQ = 3328, U_SK = 4352, U_SV = 4480, U_RU = 4608, U_MQ = 7936, U_GP = 8960;
constexpr int RWC = 3328, BW = 1024, DFF = 5632, MEMT = 256;
constexpr float ALPHA = 1.681792830507429f;

constexpr size_t O_YP = 0;
constexpr size_t O_YS = O_YP + (size_t)MP * DM;
constexpr size_t O_SWKP = O_YS + (size_t)MS * DM;
constexpr size_t O_SWVP = O_SWKP + (size_t)NL * PB * 128 * 128;
constexpr size_t O_MKP = O_SWVP + (size_t)NL * PB * 128 * 128;
constexpr size_t O_MVP = O_MKP + (size_t)NL * PB * 256 * 1024;
constexpr size_t O_GLAP = O_MVP + (size_t)NL * PB * 256 * 1024;
constexpr size_t O_RWP = O_GLAP + (size_t)NL * PB * 4 * 128 * 256;
constexpr size_t O_RSP = O_RWP + (size_t)NL * PB * 16 * 64 * 64;
constexpr size_t O_SWKS = O_RSP + (size_t)NL * PB * RWC;
constexpr size_t O_SWVS = O_SWKS + (size_t)NL * SB * 128 * 128;
constexpr size_t O_GLAS = O_SWVS + (size_t)NL * SB * 128 * 128;
constexpr size_t O_RWS = O_GLAS + (size_t)NL * SB * 4 * 128 * 256;
constexpr size_t O_RSS = O_RWS + (size_t)NL * SB * 16 * 64 * 64;
constexpr size_t O_END = O_RSS + (size_t)NL * SB * RWC;
static_assert(O_END == 52881408, "output size");

constexpr size_t al256(size_t x) { return (x + 255) & ~(size_t)255; }
constexpr size_t WS_CTL = 0;
constexpr size_t WS_WIN = 65536;
constexpr size_t WS_WMEM = WS_WIN + (size_t)NL * NINP * DM * 2;
constexpr size_t WS_WBR = WS_WMEM + (size_t)NL * DM * DM * 2;
constexpr size_t WS_WOUT = WS_WBR + (size_t)NL * 4 * DM * BW * 2;
constexpr size_t WS_WGU = WS_WOUT + (size_t)NL * DM * DM * 2;
constexpr size_t WS_WDN = WS_WGU + (size_t)NL * 2 * DFF * DM * 2;
constexpr size_t WS_HF = WS_WDN + (size_t)NL * DM * DFF * 2;
constexpr size_t WS_HB = WS_HF + (size_t)MPAD * DM * 4;
constexpr size_t WS_U = WS_HB + (size_t)MPAD * DM * 2;
constexpr size_t WS_BR = WS_U + (size_t)MPAD * NINP * 2;
constexpr size_t WS_MG = WS_BR + (size_t)4 * MPAD * BW * 2;
constexpr size_t WS_MGB = WS_MG + (size_t)MPAD * DM * 4;
constexpr size_t WS_Y = WS_MGB + (size_t)MPAD * DM * 2;
constexpr size_t WS_X1F = WS_Y + (size_t)MPAD * DM * 4;
constexpr size_t WS_X1B = WS_X1F + (size_t)MPAD * DM * 4;
constexpr size_t WS_ACT = WS_X1B + (size_t)MPAD * DM * 2;
constexpr size_t WS_MEMB = WS_ACT + (size_t)MPAD * DFF * 2;
constexpr size_t WS_MKB = WS_MEMB + (size_t)512 * DM * 2;
constexpr size_t WS_MVT = WS_MKB + (size_t)NL * 512 * 1024 * 2;
constexpr size_t WS_SC = WS_MVT + (size_t)NL * 8 * 256 * 256 * 2;
constexpr size_t WS_PB = WS_SC + (size_t)8 * 4096 * 256 * 4;
constexpr size_t WS_RW = WS_PB + (size_t)8 * 4096 * 256 * 2;
constexpr size_t RW_ARR = (size_t)MPAD * BW * 4;
constexpr int GL_NCH = 512 + 128;
constexpr size_t WS_GLQD = WS_RW + 8 * RW_ARR;
constexpr size_t WS_GLKH = WS_GLQD + (size_t)GL_NCH * 8192 * 2;
constexpr size_t WS_GLE = WS_GLKH + (size_t)GL_NCH * 8192 * 2;
constexpr size_t WS_GLVT = WS_GLE + (size_t)GL_NCH * 4096 * 2;
constexpr size_t WS_GLGC = WS_GLVT + (size_t)GL_NCH * 16384 * 2;
constexpr int RB_NCH = PB * 16 * 256 + SB * 16;
constexpr int RB_EL = 8192;
constexpr int RB_QP = 4608, RB_KHP = 5760, RB_VT = 6784, RB_EP = 7808;
constexpr size_t WS_RB = WS_GLGC + (size_t)GL_NCH * 128 * 4;
constexpr size_t WS_RAW = WS_RB + (size_t)RB_NCH * RB_EL * 2;
constexpr size_t WS_LRW = WS_RAW + (size_t)2 * MPAD * BW * 2;
constexpr size_t WS_END = WS_LRW + (size_t)NL * 16 * 64 * 256 * 2;

__device__ __forceinline__ float bf2f(bf16_t b) { return __uint_as_float(((unsigned)b) << 16); }
typedef __bf16 bf16v2_t __attribute__((ext_vector_type(2)));
__device__ __forceinline__ unsigned pk2(float lo, float hi) { const f32x2 v = {lo, hi}; return __builtin_bit_cast(unsigned, __builtin_convertvector(v, bf16v2_t)); }
__device__ __forceinline__ bf16_t f2bf(float f) { return (bf16_t)(pk2(f, 0.f) & 0xffffu); }
__device__ __forceinline__ f32x4 ld4bf(const bf16_t* p) { const u32x2 w = *(const u32x2*)p; return (f32x4){__uint_as_float(w.x << 16), __uint_as_float(w.x & 0xffff0000u), __uint_as_float(w.y << 16), __uint_as_float(w.y & 0xffff0000u)}; }
__device__ __forceinline__ float wave_sum(float v) {
#pragma unroll
    for (int o = 32; o > 0; o >>= 1) v += __shfl_xor(v, o, 64);
    return v;
}
__device__ __forceinline__ float wave_max(float v) {
#pragma unroll
    for (int o = 32; o > 0; o >>= 1) v = fmaxf(v, __shfl_xor(v, o, 64));
    return v;
}
__device__ __forceinline__ float sigmoidf_(float x) { return __builtin_amdgcn_rcpf(1.0f + __expf(-x)); }
__device__ __forceinline__ void unpack8(const u32x4 w, float (&x)[8]) {
    x[0] = __uint_as_float(w.x << 16); x[1] = __uint_as_float(w.x & 0xffff0000u); x[2] = __uint_as_float(w.y << 16); x[3] = __uint_as_float(w.y & 0xffff0000u);
    x[4] = __uint_as_float(w.z << 16); x[5] = __uint_as_float(w.z & 0xffff0000u); x[6] = __uint_as_float(w.w << 16); x[7] = __uint_as_float(w.w & 0xffff0000u);
}
__device__ __forceinline__ float softplusf_(float x) { return fmaxf(x, 0.f) + log1pf(__expf(-fabsf(x))); }
__device__ __forceinline__ float softplus_fast(float x) { return fmaxf(x, 0.f) + __logf(1.0f + __expf(-fabsf(x))); }
__device__ __forceinline__ float tanh_fast(float x) { return 1.0f - 2.0f * __builtin_amdgcn_rcpf(1.0f + __expf(2.0f * x)); }

namespace pg8 {
constexpr int BM = 256, BK = 64, HALF = 128, HTB = HALF * BK * 2, STAGE_BYTES = 8 * HTB, NXCD = 8, WGM = 8;
__host__ __device__ __forceinline__ int lds_byte(int r, int c) { const int st = (r >> 4) * 2 + (c >> 5), rr = r & 15, cc = c & 31, ob = rr * 64 + cc * 2; return st * 1024 + (ob ^ (((ob >> 9) & 1) << 5)); }
__host__ __device__ __forceinline__ void stage_rc(int b, int& R, int& C) { const int st = b / 1024, sb = b % 1024, swz = sb ^ (((sb >> 9) & 1) << 5); R = (st >> 1) * 16 + swz / 64; C = (st & 1) * 32 + (swz % 64) / 2; }
__host__ __device__ __forceinline__ int perm32(int rho) { const int n = rho >> 4, i = rho & 15; return 8 * (i >> 2) + 4 * n + (i & 3); }

struct Unit { int pm, pn, z; };
template <int LDA_, int LDB_, int K_, int NM_, int NN_, int NZ_ = 1, int NZH_ = 1, bool ZINNER_ = false, long ZSAB_ = 0, long ZSAH_ = 0, long ZSBB_ = 0, long ZSBH_ = 0>
struct Gemm {
    static constexpr int LDA = LDA_, LDB = LDB_, K = K_, NM = NM_, NN = NN_, NZ = NZ_, NZH = NZH_; static constexpr bool ZINNER = ZINNER_;
    const bf16_t* A; const bf16_t* B; int G, c;
    __device__ __forceinline__ bool next(int i, Unit& u) const {
        constexpr int nt = NM * NN; int L, z;
        if (ZINNER) { const int it = i / NZ; z = i - it * NZ; const long LL = (long)it * G + c; if (LL >= nt) return false; L = (int)LL; }
        else { const long LL = (long)i * G + c; if (LL >= (long)nt * NZ) return false; z = (int)(LL / nt); L = (int)(LL - (long)z * nt); }
        int wgid = L; { constexpr int q = nt / NXCD, r = nt % NXCD; const int xcd = wgid % NXCD, off = wgid / NXCD; wgid = (xcd < r ? xcd * (q + 1) : r * (q + 1) + (xcd - r) * q) + off; }
        constexpr int nig = WGM * NN; const int gid = wgid / nig, fm = gid * WGM, gsz = (NM - fm) < WGM ? (NM - fm) : WGM;
        u.pm = fm + ((wgid % nig) % gsz); u.pn = (wgid % nig) / gsz; u.z = z; return true;
    }
    __device__ __forceinline__ const char* a_base(const Unit& u) const { const int zb = u.z / NZH, zh = u.z - zb * NZH; return (const char*)(A + zb * ZSAB_ + zh * ZSAH_ + (long)u.pm * BM * LDA); }
    __device__ __forceinline__ const char* b_base(const Unit& u) const { const int zb = u.z / NZH, zh = u.z - zb * NZH; return (const char*)(B + zb * ZSBB_ + zh * ZSBH_ + (long)u.pn * BM * LDB); }
};

template <class GT, class Epi, bool ALIGN_EPI = true, bool SP2 = true>
__device__ __forceinline__ void gemm_phase(LAS unsigned char* lds, const int tid, const GT& g, const Epi& E) {
    const int wid = __builtin_amdgcn_readfirstlane(tid >> 6), lane = tid & 63, wr = wid >> 2, wc = wid & 3, fr = lane & 15, fq = lane >> 4;
    constexpr int nt = GT::K / BK;
    unsigned voffA[2], voffB[2];
#pragma unroll
    for (int i = 0; i < 2; ++i) { int R, C; stage_rc(tid * 16 + i * 8192, R, C); const int Rb = Epi::PERM ? ((R & ~31) + perm32(R & 31)) : R;
        voffA[i] = (unsigned)(R * GT::LDA + C) * 2u; voffB[i] = (unsigned)(Rb * GT::LDB + C) * 2u; }
    constexpr size_t kstep = (size_t)(BK * 2);
    constexpr size_t hstepA = (size_t)HALF * GT::LDA * 2, hstepB = (size_t)HALF * GT::LDB * 2;
    const unsigned ldsw = (unsigned)wid * 1024u;
    const int aoff = lds_byte(wr * 64 + fr, fq * 8), boff = lds_byte(wc * 32 + fr, fq * 8);
#define PG8_SA(b, h) (((b) * 2 + (h)) * HTB)
#define PG8_SB(b, h) ((4 + (b) * 2 + (h)) * HTB)
#define PG8_STAGE(bufoff, gbase, voff) do { _Pragma("unroll") for (int _i = 0; _i < 2; ++_i) \
        __builtin_amdgcn_global_load_lds((const unsigned*)((const char*)(gbase) + (voff)[_i]), (LAS unsigned*)(lds + (bufoff) + ldsw + _i * 8192), 16, 0, 0); } while (0)
#define PG8_LDA(dst, b, h) do { _Pragma("unroll") for (int m = 0; m < 4; ++m) _Pragma("unroll") for (int k = 0; k < 2; ++k) dst[m][k] = *(const LAS bf16x8*)(lds + PG8_SA(b, h) + aoff + m * 2048 + k * 1024); } while (0)
#define PG8_LDB(dst, b, h) do { _Pragma("unroll") for (int n = 0; n < 2; ++n) _Pragma("unroll") for (int k = 0; k < 2; ++k) dst[n][k] = *(const LAS bf16x8*)(lds + PG8_SB(b, h) + boff + n * 2048 + k * 1024); } while (0)
#define PG8_MMA(ai, bj, At, Bt) do { __builtin_amdgcn_s_setprio(1); _Pragma("unroll") for (int m = 0; m < 4; ++m) _Pragma("unroll") for (int n = 0; n < 2; ++n) _Pragma("unroll") for (int k = 0; k < 2; ++k) \
        acc[ai][bj][m][n] = __builtin_amdgcn_mfma_f32_16x16x32_bf16(Bt[n][k], At[m][k], acc[ai][bj][m][n], 0, 0, 0); __builtin_amdgcn_s_setprio(0); } while (0)
#define PG8_WAIT_V(n) asm volatile("s_waitcnt vmcnt(" #n ")" ::: "memory")
#define PG8_WAIT_L(n) asm volatile("s_waitcnt lgkmcnt(" #n ")" ::: "memory")
#define PG8_BAR __builtin_amdgcn_s_barrier()
#define PG8_SCHED __builtin_amdgcn_sched_barrier(0)
    Unit cur, nxt; int ui = 0;
    if (!g.next(0, cur)) return;
    f32x4 acc[2][2][4][2];
#pragma unroll
    for (int a = 0; a < 2; ++a)
#pragma unroll
        for (int b = 0; b < 2; ++b)
#pragma unroll
            for (int m = 0; m < 4; ++m)
#pragma unroll
                for (int n = 0; n < 2; ++n) acc[a][b][m][n] = (f32x4){0.f, 0.f, 0.f, 0.f};
    bf16x8 At[4][2], B0[2][2], B1[2][2];
    const char* cA = g.a_base(cur); const char* cB = g.b_base(cur);
    if constexpr (SP2) {
        PG8_STAGE(PG8_SB(0, 0), cB, voffB); PG8_STAGE(PG8_SB(0, 1), cB + hstepB, voffB); PG8_STAGE(PG8_SA(0, 0), cA, voffA); PG8_STAGE(PG8_SA(0, 1), cA + hstepA, voffA);
        if (wr == 1) PG8_BAR;
        PG8_WAIT_V(2); PG8_BAR;
        PG8_STAGE(PG8_SB(1, 0), cB + kstep, voffB); PG8_STAGE(PG8_SA(1, 0), cA + kstep, voffA); PG8_STAGE(PG8_SB(1, 1), cB + hstepB + kstep, voffB);
        PG8_WAIT_V(6); PG8_BAR;
    } else {
        PG8_STAGE(PG8_SB(0, 0), cB, voffB); PG8_STAGE(PG8_SA(0, 0), cA, voffA); PG8_STAGE(PG8_SB(0, 1), cB + hstepB, voffB); PG8_STAGE(PG8_SA(0, 1), cA + hstepA, voffA);
        if (wr == 1) PG8_BAR;
        PG8_WAIT_V(4); PG8_BAR;
        PG8_STAGE(PG8_SB(1, 0), cB + kstep, voffB); PG8_STAGE(PG8_SA(1, 0), cA + kstep, voffA); PG8_STAGE(PG8_SB(1, 1), cB + hstepB + kstep, voffB);
        PG8_WAIT_V(6); PG8_BAR;
    }
    for (;;) {
        const bool has_next = g.next(ui + 1, nxt);
        const char* nA = has_next ? g.a_base(nxt) : cA; const char* nB = has_next ? g.b_base(nxt) : cB;
#pragma unroll 1
        for (int t = 0; t < nt; t += 2) {
            const bool last = (t == nt - 2);
            const char* a1 = cA + (size_t)(t + 1) * kstep;
            const char* a2 = last ? nA : cA + (size_t)(t + 2) * kstep; const char* b2 = last ? nB : cB + (size_t)(t + 2) * kstep;
            const char* a3 = a2 + kstep; const char* b3 = b2 + kstep;
            if constexpr (SP2) {
            PG8_LDB(B0, 0, 0); PG8_LDB(B1, 0, 1); PG8_SCHED; PG8_LDA(At, 0, 0); PG8_STAGE(PG8_SA(1, 1), a1 + hstepA, voffA);
            PG8_WAIT_V(8); PG8_WAIT_L(0); PG8_BAR; PG8_MMA(0, 0, At, B0); PG8_MMA(0, 1, At, B1); PG8_BAR; PG8_SCHED;
            PG8_LDA(At, 0, 1); PG8_STAGE(PG8_SB(0, 0), b2, voffB); PG8_STAGE(PG8_SB(0, 1), b2 + hstepB, voffB); PG8_STAGE(PG8_SA(0, 0), a2, voffA);
            PG8_WAIT_V(8); PG8_WAIT_L(0); PG8_BAR; PG8_MMA(1, 0, At, B0); PG8_MMA(1, 1, At, B1); PG8_BAR; PG8_SCHED;
            PG8_LDB(B0, 1, 0); PG8_LDB(B1, 1, 1); PG8_SCHED; PG8_LDA(At, 1, 0); PG8_STAGE(PG8_SA(0, 1), a2 + hstepA, voffA);
            PG8_WAIT_V(8); PG8_WAIT_L(0); PG8_BAR; PG8_MMA(0, 0, At, B0); PG8_MMA(0, 1, At, B1); PG8_BAR; PG8_SCHED;
            PG8_LDA(At, 1, 1); PG8_STAGE(PG8_SB(1, 0), b3, voffB); PG8_STAGE(PG8_SB(1, 1), b3 + hstepB, voffB); PG8_STAGE(PG8_SA(1, 0), a3, voffA);
            PG8_WAIT_V(8); PG8_WAIT_L(0); PG8_BAR; PG8_MMA(1, 0, At, B0); PG8_MMA(1, 1, At, B1); PG8_BAR; PG8_SCHED;
            } else {
            PG8_LDB(B0, 0, 0); PG8_SCHED; PG8_LDA(At, 0, 0); PG8_STAGE(PG8_SA(1, 1), a1 + hstepA, voffA);
            PG8_WAIT_L(8); PG8_BAR; PG8_WAIT_L(0); PG8_MMA(0, 0, At, B0); PG8_BAR; PG8_SCHED;
            PG8_LDB(B1, 0, 1); PG8_STAGE(PG8_SB(0, 0), b2, voffB);
            PG8_BAR; PG8_WAIT_L(0); PG8_MMA(0, 1, At, B1); PG8_BAR;
            PG8_LDA(At, 0, 1); PG8_STAGE(PG8_SA(0, 0), a2, voffA);
            PG8_BAR; PG8_WAIT_L(0); PG8_MMA(1, 0, At, B0); PG8_BAR; PG8_SCHED;
            PG8_STAGE(PG8_SB(0, 1), b2 + hstepB, voffB);
            PG8_WAIT_V(6); PG8_BAR; PG8_MMA(1, 1, At, B1); PG8_BAR;
            PG8_LDB(B0, 1, 0); PG8_SCHED; PG8_LDA(At, 1, 0); PG8_STAGE(PG8_SA(0, 1), a2 + hstepA, voffA);
            PG8_WAIT_L(8); PG8_BAR; PG8_WAIT_L(0); PG8_MMA(0, 0, At, B0); PG8_BAR; PG8_SCHED;
            PG8_LDB(B1, 1, 1); PG8_STAGE(PG8_SB(1, 0), b3, voffB);
            PG8_BAR; PG8_WAIT_L(0); PG8_MMA(0, 1, At, B1); PG8_BAR;
            PG8_LDA(At, 1, 1); PG8_STAGE(PG8_SA(1, 0), a3, voffA);
            PG8_BAR; PG8_WAIT_L(0); PG8_MMA(1, 0, At, B0); PG8_BAR; PG8_SCHED;
            PG8_STAGE(PG8_SB(1, 1), b3 + hstepB, voffB);
            PG8_WAIT_V(6); PG8_BAR; PG8_MMA(1, 1, At, B1); PG8_BAR;
            }
        }
        if constexpr (ALIGN_EPI) { if (wr == 0) PG8_BAR; }
        E(acc, cur, wr, wc, fr, fq);
        if (!has_next) break;
#pragma unroll
        for (int a = 0; a < 2; ++a)
#pragma unroll
            for (int b = 0; b < 2; ++b)
#pragma unroll
                for (int m = 0; m < 4; ++m)
#pragma unroll
                    for (int n = 0; n < 2; ++n) acc[a][b][m][n] = (f32x4){0.f, 0.f, 0.f, 0.f};
        cur = nxt; cA = nA; cB = nB; ++ui;
        if constexpr (ALIGN_EPI) { if (wr == 1) PG8_BAR; }
    }
    PG8_WAIT_V(0);
    if constexpr (!ALIGN_EPI) { if (wr == 0) PG8_BAR; }
    PG8_BAR;
#undef PG8_SA
#undef PG8_SB
#undef PG8_STAGE
#undef PG8_LDA
#undef PG8_LDB
#undef PG8_MMA
#undef PG8_WAIT_V
#undef PG8_WAIT_L
#undef PG8_BAR
#undef PG8_SCHED
}

struct EpiBf16 {
    static constexpr bool PERM = true;
    bf16_t* O; long zs; int ldc, pad;
    __device__ __forceinline__ void operator()(const f32x4 (&acc)[2][2][4][2], const Unit& u, int wr, int wc, int fr, int fq) const {
        const int row0 = u.pm * BM + wr * 64 + fr, col0 = u.pn * BM + wc * 32 + 8 * fq; bf16_t* base = O + (long)u.z * zs;
#pragma unroll
        for (int ai = 0; ai < 2; ++ai)
#pragma unroll
            for (int m = 0; m < 4; ++m) { bf16_t* rowp = base + (size_t)(row0 + ai * HALF + m * 16) * ldc + col0;
#pragma unroll
                for (int bj = 0; bj < 2; ++bj) { const f32x4 v0 = acc[ai][bj][m][0], v1 = acc[ai][bj][m][1];
                    u32x4 w; w.x = pk2(v0[0], v0[1]); w.y = pk2(v0[2], v0[3]); w.z = pk2(v1[0], v1[1]); w.w = pk2(v1[2], v1[3]);
                    *(u32x4*)(rowp + bj * HALF) = w; } }
    }
};
struct EpiMem {
    static constexpr bool PERM = false;
    float* outK; float* outV; bf16_t* kb; bf16_t* vt;
    __device__ __forceinline__ void operator()(const f32x4 (&acc)[2][2][4][2], const Unit& u, int wr, int wc, int fr, int fq) const {
        const int row0 = u.pm * BM + wr * 64 + fr, col0 = u.pn * BM + wc * 32 + 4 * fq;
#pragma unroll
        for (int ai = 0; ai < 2; ++ai)
#pragma unroll
            for (int m = 0; m < 4; ++m) { const int row = row0 + ai * HALF + m * 16;
#pragma unroll
                for (int bj = 0; bj < 2; ++bj)
#pragma unroll
                    for (int n = 0; n < 2; ++n) { const int col = col0 + bj * HALF + n * 16; const f32x4 v = acc[ai][bj][m][n];
                        if (col < 1024) { *(f32x4*)(outK + ((size_t)u.z * 512 + row) * 1024 + col) = v;
                            u32x2 w; w.x = pk2(v[0], v[1]); w.y = pk2(v[2], v[3]); *(u32x2*)(kb + ((size_t)u.z * 512 + row) * 1024 + col) = w; }
                        else { const int c = col - 1024; *(f32x4*)(outV + ((size_t)u.z * 512 + row) * 1024 + c) = v;
                            const int b = row >> 8, mm = row & 255, h = c >> 8, d = c & 255; bf16_t* p = vt + ((((size_t)u.z * 2 + b) * 4 + h) * 256 + d) * 256 + mm;
                            p[0] = f2bf(v[0]); p[256] = f2bf(v[1]); p[512] = f2bf(v[2]); p[768] = f2bf(v[3]); } } }
    }
};
struct EpiMerge {
    static constexpr bool PERM = true;
    float* MG; bf16_t* MGB; const bf16_t* U; const float* gate_b;
    __device__ __forceinline__ void operator()(const f32x4 (&acc)[2][2][4][2], const Unit& u, int wr, int wc, int fr, int fq) const {
        const int row0 = u.pm * BM + wr * 64 + fr, col0 = u.pn * BM + wc * 32 + 8 * fq;
#pragma unroll
        for (int bj = 0; bj < 2; ++bj) { const int col = col0 + bj * HALF; const f32x4 gb0 = *(const f32x4*)(gate_b + u.z * DM + col), gb1 = *(const f32x4*)(gate_b + u.z * DM + col + 4);
#pragma unroll
            for (int ai = 0; ai < 2; ++ai)
#pragma unroll
                for (int m = 0; m < 4; ++m) { const int row = row0 + ai * HALF + m * 16; float gp[8], r[8];
                    unpack8(*(const u32x4*)(U + (size_t)row * NINP + U_GP + u.z * DM + col), gp);
#pragma unroll
                    for (int j = 0; j < 4; ++j) { r[j] = sigmoidf_(gp[j] + gb0[j]) * acc[ai][bj][m][0][j]; r[4 + j] = sigmoidf_(gp[4 + j] + gb1[j]) * acc[ai][bj][m][1][j]; }
                    bf16_t* mp = MGB + (size_t)row * DM + col;
                    if (u.z > 0) { float pv[8]; unpack8(*(const u32x4*)mp, pv);
#pragma unroll
                        for (int j = 0; j < 8; ++j) r[j] += pv[j]; }
                    *(u32x4*)mp = (u32x4){pk2(r[0], r[1]), pk2(r[2], r[3]), pk2(r[4], r[5]), pk2(r[6], r[7])}; } }
    }
};
struct EpiRes {
    static constexpr bool PERM = true;
    const bf16_t* R; bf16_t* Y;
    __device__ __forceinline__ void operator()(const f32x4 (&acc)[2][2][4][2], const Unit& u, int wr, int wc, int fr, int fq) const {
        const int row0 = u.pm * BM + wr * 64 + fr, col0 = u.pn * BM + wc * 32 + 8 * fq;
#pragma unroll
        for (int ai = 0; ai < 2; ++ai)
#pragma unroll
            for (int m = 0; m < 4; ++m) { const size_t ro = (size_t)(row0 + ai * HALF + m * 16) * DM + col0;
#pragma unroll
                for (int bj = 0; bj < 2; ++bj) { const size_t o = ro + bj * HALF; float rv[8]; unpack8(*(const u32x4*)(R + o), rv);
                    const f32x4 y0 = (f32x4){rv[0], rv[1], rv[2], rv[3]} * ALPHA + acc[ai][bj][m][0], y1 = (f32x4){rv[4], rv[5], rv[6], rv[7]} * ALPHA + acc[ai][bj][m][1];
                    *(u32x4*)(Y + o) = (u32x4){pk2(y0[0], y0[1]), pk2(y0[2], y0[3]), pk2(y1[0], y1[1]), pk2(y1[2], y1[3])}; } }
    }
};
struct EpiSwiGLU {
    static constexpr bool PERM = true;
    bf16_t* O;
    __device__ __forceinline__ void operator()(const f32x4 (&acc)[2][2][4][2], const Unit& u, int wr, int wc, int fr, int fq) const {
        const int row0 = u.pm * BM + wr * 64 + fr, col0 = u.pn * HALF + wc * 32 + 8 * fq;
#pragma unroll
        for (int ai = 0; ai < 2; ++ai)
#pragma unroll
            for (int m = 0; m < 4; ++m) { bf16_t* rowp = O + (size_t)(row0 + ai * HALF + m * 16) * DFF + col0;
                float r[8];
#pragma unroll
                for (int n = 0; n < 2; ++n)
#pragma unroll
                    for (int j = 0; j < 4; ++j) { const float gg = acc[ai][0][m][n][j], uu = acc[ai][1][m][n][j]; r[n * 4 + j] = gg * sigmoidf_(gg) * uu; }
                u32x4 w; w.x = pk2(r[0], r[1]); w.y = pk2(r[2], r[3]); w.z = pk2(r[4], r[5]); w.w = pk2(r[6], r[7]);
                *(u32x4*)rowp = w; }
    }
};
struct EpiScore {
    static constexpr bool PERM = false;
    float* SC;
    __device__ __forceinline__ void operator()(const f32x4 (&acc)[2][2][4][2], const Unit& u, int wr, int wc, int fr, int fq) const {
        const int row0 = u.pm * BM + wr * 64 + fr, col0 = wc * 32 + 4 * fq; float* base = SC + (size_t)u.z * 4096 * 256;
#pragma unroll
        for (int ai = 0; ai < 2; ++ai)
#pragma unroll
            for (int m = 0; m < 4; ++m) { float* rowp = base + (size_t)(row0 + ai * HALF + m * 16) * 256 + col0;
#pragma unroll
                for (int bj = 0; bj < 2; ++bj)
#pragma unroll
                    for (int n = 0; n < 2; ++n) *(f32x4*)(rowp + bj * HALF + n * 16) = acc[ai][bj][m][n] * 0.0625f; }
    }
};
struct EpiPV {
    static constexpr bool PERM = true;
    bf16_t* O;
    __device__ __forceinline__ void operator()(const f32x4 (&acc)[2][2][4][2], const Unit& u, int wr, int wc, int fr, int fq) const {
        const int b = u.z >> 2, h = u.z & 3; const int row0 = b * PS + u.pm * BM + wr * 64 + fr, col0 = h * 256 + wc * 32 + 8 * fq;
#pragma unroll
        for (int ai = 0; ai < 2; ++ai)
#pragma unroll
            for (int m = 0; m < 4; ++m) { bf16_t* rowp = O + (size_t)(row0 + ai * HALF + m * 16) * BW + col0;
#pragma unroll
                for (int bj = 0; bj < 2; ++bj) { const f32x4 v0 = acc[ai][bj][m][0], v1 = acc[ai][bj][m][1];
                    u32x4 w; w.x = pk2(v0[0], v0[1]); w.y = pk2(v0[2], v0[3]); w.z = pk2(v1[0], v1[1]); w.w = pk2(v1[2], v1[3]);
                    *(u32x4*)(rowp + bj * HALF) = w; } }
    }
};
}


#define XB_TMO      128
#define XB_XCNT(j)  (256  + 64 * (j))
#define XB_XSUB(j)  (1280 + 64 * (j))
#define XB_XGEN(j)  (2304 + 64 * (j))
#define XB_TOP      3328
#define XB_TOPGEN   3392
#define XCD_BAR_WORDS 3456
#define XB_SPIN_CAP (1u << 18)
__device__ __forceinline__ unsigned xb_ld(unsigned* p)              { return __hip_atomic_load(p, __ATOMIC_RELAXED, __HIP_MEMORY_SCOPE_AGENT); }
__device__ __forceinline__ unsigned xb_add(unsigned* p, unsigned v) { return __hip_atomic_fetch_add(p, v, __ATOMIC_RELAXED, __HIP_MEMORY_SCOPE_AGENT); }
__device__ __forceinline__ unsigned xb_xcc_id() { return (unsigned)__builtin_amdgcn_s_getreg((3 << 11) | 20) & 0xFu; }
#define XB_SPIN(cond, bar) do { unsigned _sp = 0; while (cond) { __builtin_amdgcn_s_sleep(1); \
    if ((++_sp & 255u) == 0u) { if (xb_ld(&(bar)[XB_TMO])) break; if (_sp > XB_SPIN_CAP) { atomicAdd(&(bar)[XB_TMO], 1u); break; } } } } while (0)
struct XcdBarrier { unsigned* bar; unsigned x; volatile LAS unsigned* st; };
__device__ __forceinline__ XcdBarrier xcd_barrier_post(unsigned* bar, volatile LAS unsigned* st) {
    XcdBarrier b; b.bar = bar; b.x = xb_xcc_id(); b.st = st;
    if (threadIdx.x == 0) (void)xb_add(&bar[XB_XCNT(b.x)], 1u);
    return b;
}
__device__ __forceinline__ void xcd_barrier_complete(unsigned* bar, unsigned x, unsigned& nloc, unsigned& nx) {
    const unsigned G = gridDim.x * gridDim.y * gridDim.z;
    unsigned sum, cnt, mine, sp = 0u;
    for (;;) {
        sum = 0u; cnt = 0u; mine = 0u;
#pragma unroll
        for (unsigned j = 0; j < 16; ++j) { const unsigned c = xb_ld(&bar[XB_XCNT(j)]); sum += c; cnt += (c > 0u) ? 1u : 0u; mine = (j == x) ? c : mine; }
        if (sum == G) break;
        __builtin_amdgcn_s_sleep(1);
        if ((++sp & 255u) == 0u) { if (xb_ld(&bar[XB_TMO])) break; if (sp > XB_SPIN_CAP) { atomicAdd(&bar[XB_TMO], 1u); break; } }
    }
    nloc = mine > 0u ? mine : 1u; nx = cnt > 0u ? cnt : 1u;
}
__device__ __forceinline__ void xcd_barrier(const XcdBarrier& b) {
    asm volatile("s_waitcnt vmcnt(0)" ::: "memory");
    __syncthreads();
    if (threadIdx.x == 0) {
        unsigned* bar = b.bar;
        __builtin_amdgcn_s_waitcnt(0);
        unsigned nloc = b.st[0], nx = b.st[1];
        if (nloc == 0u) { xcd_barrier_complete(bar, b.x, nloc, nx); b.st[0] = nloc; b.st[1] = nx; }
        const unsigned old = xb_add(&bar[XB_XSUB(b.x)], 1u);
        const unsigned gen = old / nloc;
        if (old + 1u == (gen + 1u) * nloc) {
            __builtin_amdgcn_fence(__ATOMIC_RELEASE, "agent");
            asm volatile("s_waitcnt vmcnt(0)" ::: "memory");
            const unsigned og = xb_add(&bar[XB_TOP], 1u);
            const unsigned tg = og / nx;
            if (og + 1u == (tg + 1u) * nx) xb_add(&bar[XB_TOPGEN], 1u);
            else XB_SPIN(xb_ld(&bar[XB_TOPGEN]) == tg, bar);
            __builtin_amdgcn_fence(__ATOMIC_ACQUIRE, "agent");
            xb_add(&bar[XB_XGEN(b.x)], 1u);
            asm volatile("s_waitcnt vmcnt(0)" ::: "memory");
        } else {
            XB_SPIN(xb_ld(&bar[XB_XGEN(b.x)]) == gen, bar);
            __builtin_amdgcn_fence(__ATOMIC_ACQUIRE, "agent");
            asm volatile("s_waitcnt vmcnt(0)" ::: "memory");
        }
    }
    __syncthreads();
}

struct Ctx { int tid, lane, wave, bid, G; LAS unsigned char* lds; };
__device__ __forceinline__ Ctx fresh(const Ctx& c0) { Ctx c; c.wave = c0.wave; c.bid = c0.bid; c.G = c0.G; c.lds = c0.lds; asm volatile("" : "+s"(c.bid), "+s"(c.G), "+s"(c.wave));
    int lane = (int)__builtin_amdgcn_mbcnt_hi(~0u, __builtin_amdgcn_mbcnt_lo(~0u, 0u)); asm volatile("" : "+v"(lane)); c.lane = lane; c.tid = c.wave * 64 + lane; return c; }

__device__ __forceinline__ int colmap(int mode, int n) {
    if (mode == 1) return n < 3088 ? n : (n < 3328 ? -1 : n - 240);
    if (mode == 2) { const int t = n >> 8, j = n & 255; return j < 128 ? t * 128 + j : DFF + t * 128 + (j - 128); }
    return n;
}
__device__ __forceinline__ void wprep_load(f32x4 (&rg)[8], const float* __restrict__ src, int K, int Nsrc, int Ndst, int mode, size_t sbs, int item, int tid) {
    const int nx = Ndst / 256, ny = K / 64; const int bx = item % nx, by = (item / nx) % ny, bz = item / (nx * ny);
    const int tx = tid & 63, ty = tid >> 6, cm = colmap(mode, bx * 256 + tx * 4); const float* s = src + (size_t)bz * sbs + (size_t)(by * 64 + ty) * Nsrc + cm;
#pragma unroll
    for (int i = 0; i < 8; ++i) rg[i] = cm >= 0 ? *(const f32x4*)(s + (size_t)(8 * i) * Nsrc) : (f32x4){0.f, 0.f, 0.f, 0.f};
}
__device__ __forceinline__ void ph_wprep(const Ctx& c, const float* __restrict__ src, bf16_t* __restrict__ dst, int K, int Nsrc, int Ndst, int mode, int nbatch, size_t sbs, size_t dbs) {
    LAS float* tile = (LAS float*)c.lds;
    const int nx = Ndst / 256, ny = K / 64, total = nx * ny * nbatch;
    const int tid = c.tid, tx = tid & 63, ty = tid >> 6, n = tid >> 1, kh = tid & 1;
    f32x4 rg[8];
    int item = c.bid;
    if (item < total) wprep_load(rg, src, K, Nsrc, Ndst, mode, sbs, item, tid);
    for (; item < total; item += c.G) {
        __syncthreads();
#pragma unroll
        for (int i = 0; i < 8; ++i) *(LAS f32x4*)(tile + (ty + 8 * i) * 260 + tx * 4) = rg[i];
        __syncthreads();
        const int bx = item % nx, by = (item / nx) % ny, bz = item / (nx * ny);
        if (item + c.G < total) wprep_load(rg, src, K, Nsrc, Ndst, mode, sbs, item + c.G, tid);
        bf16_t* d = dst + (size_t)bz * dbs + (size_t)(bx * 256 + n) * K + by * 64 + kh * 32;
#pragma unroll
        for (int g = 0; g < 4; ++g) { unsigned p[4];
#pragma unroll
            for (int e = 0; e < 4; ++e) p[e] = pk2(tile[(kh * 32 + g * 8 + 2 * e) * 260 + n], tile[(kh * 32 + g * 8 + 2 * e + 1) * 260 + n]);
            *(u32x4*)(d + g * 8) = (u32x4){p[0], p[1], p[2], p[3]}; }
    }
    __syncthreads();
}
constexpr int WD_CH = 4, WD_N0 = (NINP / 256) * (DM / 64), WD_N1 = 4 * (DM / 256) * (BW / 64), WD_N2 = (DM / 256) * (DM / 64), WD_N3 = (2 * DFF / 256) * (DM / 64), WD_N4 = (DM / 256) * (DFF / 64);
constexpr int WD_TOTAL = WD_N0 + WD_N1 + WD_N2 + WD_N3 + WD_N4;
struct WDesc { const float* src; bf16_t* dst; int K, Nsrc, Ndst, mode, item; size_t sbs, dbs; };
__device__ __forceinline__ WDesc wd_decode(int it, const float* s0, const float* s1, const float* s2, const float* s3, const float* s4, bf16_t* d0, bf16_t* d1, bf16_t* d2, bf16_t* d3, bf16_t* d4) {
    WDesc d;
    if (it < WD_N0) { d.src = s0; d.dst = d0; d.K = DM; d.Nsrc = NIN; d.Ndst = NINP; d.mode = 1; d.item = it; d.sbs = 0; d.dbs = 0; }
    else if (it < WD_N0 + WD_N1) { d.src = s1; d.dst = d1; d.K = BW; d.Nsrc = DM; d.Ndst = DM; d.mode = 0; d.item = it - WD_N0; d.sbs = (size_t)BW * DM; d.dbs = (size_t)DM * BW; }
    else if (it < WD_N0 + WD_N1 + WD_N2) { d.src = s2; d.dst = d2; d.K = DM; d.Nsrc = DM; d.Ndst = DM; d.mode = 0; d.item = it - WD_N0 - WD_N1; d.sbs = 0; d.dbs = 0; }
    else if (it < WD_N0 + WD_N1 + WD_N2 + WD_N3) { d.src = s3; d.dst = d3; d.K = DM; d.Nsrc = 2 * DFF; d.Ndst = 2 * DFF; d.mode = 2; d.item = it - WD_N0 - WD_N1 - WD_N2; d.sbs = 0; d.dbs = 0; }
    else { d.src = s4; d.dst = d4; d.K = DFF; d.Nsrc = DM; d.Ndst = DM; d.mode = 0; d.item = it - WD_N0 - WD_N1 - WD_N2 - WD_N3; d.sbs = 0; d.dbs = 0; }
    return d;
}
__device__ __forceinline__ void ph_wprep_dyn(const Ctx& c, unsigned* ctr, const float* s0, const float* s1, const float* s2, const float* s3, const float* s4, bf16_t* d0, bf16_t* d1, bf16_t* d2, bf16_t* d3, bf16_t* d4) {
    LAS float* tile = (LAS float*)c.lds;
    LAS int* slot = (LAS int*)(c.lds + 64 * 260 * 4 + 64);
    const int tid = c.tid, n = tid >> 1, kh = tid & 1, tx = tid & 63, ty = tid >> 6;
    __syncthreads();
    if (tid == 0) slot[0] = (int)__hip_atomic_fetch_add(ctr, 1u, __ATOMIC_RELAXED, __HIP_MEMORY_SCOPE_AGENT);
    __syncthreads();
    int it = slot[0] * WD_CH, pos = 0; unsigned nxt_chunk = 0u;
    f32x4 rg[8];
    if (it < WD_TOTAL) { const WDesc d = wd_decode(it, s0, s1, s2, s3, s4, d0, d1, d2, d3, d4); wprep_load(rg, d.src, d.K, d.Nsrc, d.Ndst, d.mode, d.sbs, d.item, tid); }
    while (it < WD_TOTAL) {
        __syncthreads();
        if (tid == 0) { if (pos == 0) nxt_chunk = __hip_atomic_fetch_add(ctr, 1u, __ATOMIC_RELAXED, __HIP_MEMORY_SCOPE_AGENT); else if (pos == 1) slot[1] = (int)nxt_chunk; }
#pragma unroll
        for (int i = 0; i < 8; ++i) *(LAS f32x4*)(tile + (ty + 8 * i) * 260 + tx * 4) = rg[i];
        __syncthreads();
        const WDesc d = wd_decode(it, s0, s1, s2, s3, s4, d0, d1, d2, d3, d4);
        int nit, npos;
        if (pos + 1 < WD_CH) { nit = it + 1; npos = pos + 1; } else { nit = slot[1] * WD_CH; npos = 0; }
        if (nit < WD_TOTAL) { const WDesc dn = wd_decode(nit, s0, s1, s2, s3, s4, d0, d1, d2, d3, d4); wprep_load(rg, dn.src, dn.K, dn.Nsrc, dn.Ndst, dn.mode, dn.sbs, dn.item, tid); }
        { const int nx = d.Ndst / 256, ny = d.K / 64; const int bx = d.item % nx, by = (d.item / nx) % ny, bz = d.item / (nx * ny);
          bf16_t* dp = d.dst + (size_t)bz * d.dbs + (size_t)(bx * 256 + n) * d.K + by * 64 + kh * 32;
#pragma unroll
          for (int g = 0; g < 4; ++g) { unsigned p[4];
#pragma unroll
              for (int e = 0; e < 4; ++e) p[e] = pk2(tile[(kh * 32 + g * 8 + 2 * e) * 260 + n], tile[(kh * 32 + g * 8 + 2 * e + 1) * 260 + n]);
              *(u32x4*)(dp + g * 8) = (u32x4){p[0], p[1], p[2], p[3]}; } }
        it = nit; pos = npos;
    }
    __syncthreads();
}
__device__ __forceinline__ void ph_xprep(const Ctx& c, const float* __restrict__ xp, const float* __restrict__ xs, const float* __restrict__ mem, float* __restrict__ HF, bf16_t* __restrict__ HB, bf16_t* __restrict__ MEMB) {
    const size_t nH = (size_t)MPAD * DM / 4, nM = (size_t)512 * DM / 4;
    for (size_t i4 = (size_t)c.bid * 512 + c.tid; i4 < nH + nM; i4 += (size_t)c.G * 512) {
        if (i4 < nH) {
            const size_t e = i4 * 4; f32x4 v = (f32x4){0.f, 0.f, 0.f, 0.f};
            if (e < (size_t)MP * DM) v = *(const f32x4*)(xp + e); else if (e < (size_t)MT * DM) v = *(const f32x4*)(xs + (e - (size_t)MP * DM));
            if (HF != nullptr) *(f32x4*)(HF + e) = v;
            u32x2 w; w.x = pk2(v[0], v[1]); w.y = pk2(v[2], v[3]); *(u32x2*)(HB + e) = w;
        } else {
            const size_t e = (i4 - nH) * 4; const f32x4 v = *(const f32x4*)(mem + e); u32x2 w; w.x = pk2(v[0], v[1]); w.y = pk2(v[2], v[3]); *(u32x2*)(MEMB + e) = w;
        }
    }
}
__device__ __forceinline__ void ph_ln(const Ctx& c, const bf16_t* __restrict__ Y, const float* __restrict__ g, const float* __restrict__ b, float* __restrict__ XF, bf16_t* __restrict__ XB, float* __restrict__ OUT, int nrows, int nout) {
    const int lane = c.lane;
    for (int row = c.bid * 8 + c.wave; row < nrows; row += c.G * 8) {
        const bf16_t* y = Y + (size_t)row * DM; float v[4][8]; float s = 0.f;
#pragma unroll
        for (int j = 0; j < 4; ++j) { unpack8(*(const u32x4*)(y + j * 512 + lane * 8), v[j]);
#pragma unroll
            for (int e2 = 0; e2 < 8; ++e2) s += v[j][e2]; }
        const float mean = wave_sum(s) * (1.0f / DM); float q = 0.f;
#pragma unroll
        for (int j = 0; j < 4; ++j)
#pragma unroll
            for (int e2 = 0; e2 < 8; ++e2) { const float d = v[j][e2] - mean; q += d * d; }
        const float rstd = rsqrtf(wave_sum(q) * (1.0f / DM) + 1e-5f);
#pragma unroll
        for (int j = 0; j < 4; ++j) { const int cc = j * 512 + lane * 8; const f32x4 g0 = *(const f32x4*)(g + cc), g1 = *(const f32x4*)(g + cc + 4), b0 = *(const f32x4*)(b + cc), b1 = *(const f32x4*)(b + cc + 4);
            const f32x4 o0 = ((f32x4){v[j][0], v[j][1], v[j][2], v[j][3]} - mean) * rstd * g0 + b0, o1 = ((f32x4){v[j][4], v[j][5], v[j][6], v[j][7]} - mean) * rstd * g1 + b1;
            const size_t off = (size_t)row * DM + cc;
            if (XF != nullptr) { *(f32x4*)(XF + off) = o0; *(f32x4*)(XF + off + 4) = o1; }
            *(u32x4*)(XB + off) = (u32x4){pk2(o0[0], o0[1]), pk2(o0[2], o0[3]), pk2(o1[0], o1[1]), pk2(o1[2], o1[3])};
            if (OUT != nullptr && row < nout) { *(f32x4*)(OUT + off) = o0; *(f32x4*)(OUT + off + 4) = o1; } }
    }
}
__device__ __forceinline__ void ph_softmax256(const Ctx& c, const float* __restrict__ SC, bf16_t* __restrict__ P, int nrows) {
    const int lane = c.lane;
    for (int row = c.bid * 8 + c.wave; row < nrows; row += c.G * 8) {
        const f32x4 v = *(const f32x4*)(SC + (size_t)row * 256 + lane * 4);
        const float mx = wave_max(fmaxf(fmaxf(v[0], v[1]), fmaxf(v[2], v[3])));
        f32x4 e; e[0] = __expf(v[0] - mx); e[1] = __expf(v[1] - mx); e[2] = __expf(v[2] - mx); e[3] = __expf(v[3] - mx);
        const float inv = 1.0f / wave_sum((e[0] + e[1]) + (e[2] + e[3]));
        u32x2 w; w.x = pk2(e[0] * inv, e[1] * inv); w.y = pk2(e[2] * inv, e[3] * inv); *(u32x2*)(P + (size_t)row * 256 + lane * 4) = w;
    }
}
__device__ __forceinline__ void ph_copy_outs(const Ctx& c, const bf16_t* __restrict__ U, const float* __restrict__ ck, const float* __restrict__ cv, float* __restrict__ out, int layer) {
    constexpr int nA = PB * 128 * 128, nB = SB * 128 * 128, nC = PB * RWC, nD = SB * RWC;
    for (int i = c.bid * 512 + c.tid; i < nA + nB + nC + nD; i += c.G * 512) {
        if (i < nA) { const int b = i / 16384, j = (i >> 7) & 127, cc = i & 127; const size_t ur = (size_t)(b * PS + PS - 128 + j) * NINP;
            out[O_SWKP + (size_t)layer * nA + i] = bf2f(U[ur + U_SK + cc]); out[O_SWVP + (size_t)layer * nA + i] = bf2f(U[ur + U_SV + cc]); continue; }
        int k = i - nA;
        if (k < nB) { const int sq = k / 16384, j = (k >> 7) & 127, cc = k & 127; float kv, vv;
            if (j < 124) { const size_t o = ((size_t)sq * 128 + j + 4) * 128 + cc; kv = ck[o]; vv = cv[o]; }
            else { const size_t ur = (size_t)(MP + sq * SS + j - 124) * NINP; kv = bf2f(U[ur + U_SK + cc]); vv = bf2f(U[ur + U_SV + cc]); }
            out[O_SWKS + (size_t)layer * nB + k] = kv; out[O_SWVS + (size_t)layer * nB + k] = vv; continue; }
        k -= nB;
        if (k < nC) { const int b = k / RWC, cc = k - b * RWC; out[O_RSP + (size_t)layer * nC + k] = bf2f(U[(size_t)(b * PS + PS - 1) * NINP + U_RU + cc]); continue; }
        k -= nC;
        { const int sq = k / RWC, cc = k - sq * RWC; out[O_RSS + (size_t)layer * nD + k] = bf2f(U[(size_t)(MP + sq * SS + SS - 1) * NINP + U_RU + cc]); }
    }
}

__device__ __forceinline__ void seq_info(int sq, int& row0, int& L) { if (sq < PB) { row0 = sq * PS; L = PS; } else { row0 = MP + (sq - PB) * SS; L = SS; } }

__device__ __forceinline__ void ph_gla_naive(const Ctx& c, const bf16_t* __restrict__ U, const float* __restrict__ s0, const float* __restrict__ a_up, const float* __restrict__ a_b,
                                             const float* __restrict__ ng, const float* __restrict__ nb, bf16_t* __restrict__ OB, float* __restrict__ outP, float* __restrict__ outS) {
    LAS float* qs = (LAS float*)c.lds;
    LAS float* ks = qs + 16 * 128; LAS float* as = ks + 16 * 128; LAS float* os = as + 16 * 128;
    const int kh = c.tid >> 8, vt = c.tid & 255, lane = c.lane;
    for (int u = c.bid; u < (PB + SB) * 4; u += c.G) {
        const int sq = u >> 2, h = u & 3;
        int row0, L; seq_info(sq, row0, L);
        float S[64];
        if (sq >= PB) { const float* p = s0 + (((size_t)(sq - PB) * 4 + h) * 128 + kh * 64) * 256 + vt;
#pragma unroll
            for (int kk = 0; kk < 64; ++kk) S[kk] = p[(size_t)kk * 256]; }
        else {
#pragma unroll
            for (int kk = 0; kk < 64; ++kk) S[kk] = 0.f; }
        for (int t0 = 0; t0 < L; t0 += 16) {
            const int nT = (L - t0) < 16 ? (L - t0) : 16;
            for (int idx = c.tid; idx < nT * 128; idx += 512) {
                const int tt = idx >> 7, kk = idx & 127; const bf16_t* ur = U + (size_t)(row0 + t0 + tt) * NINP;
                qs[idx] = bf2f(ur[U_GQ + h * 128 + kk]) * 0.08838834764831845f; ks[idx] = bf2f(ur[U_GK + h * 128 + kk]);
                float x = a_b[h * 128 + kk];
#pragma unroll
                for (int r = 0; r < 16; ++r) x += bf2f(ur[U_GA + r]) * a_up[r * 512 + h * 128 + kk];
                const float ls = (fminf(x, 0.f) - log1pf(__expf(-fabsf(x)))) * (1.0f / 16.0f);
                as[idx] = __expf(ls);
            }
            __syncthreads();
            for (int tt = 0; tt < nT; ++tt) {
                const float v = bf2f(U[(size_t)(row0 + t0 + tt) * NINP + U_GV + h * 256 + vt]); float o = 0.f; const int lb = tt * 128 + kh * 64;
#pragma unroll
                for (int kk = 0; kk < 64; ++kk) { S[kk] = as[lb + kk] * S[kk] + ks[lb + kk] * v; o += qs[lb + kk] * S[kk]; }
                os[(kh * 16 + tt) * 256 + vt] = o;
            }
            __syncthreads();
            for (int tt = c.wave; tt < nT; tt += 8) {
                float x[4]; float s = 0.f;
#pragma unroll
                for (int j = 0; j < 4; ++j) { x[j] = os[tt * 256 + lane + 64 * j] + os[(16 + tt) * 256 + lane + 64 * j]; s += x[j]; }
                const float mean = wave_sum(s) * (1.0f / 256.0f); float q = 0.f;
#pragma unroll
                for (int j = 0; j < 4; ++j) { const float d = x[j] - mean; q += d * d; }
                const float rstd = rsqrtf(wave_sum(q) * (1.0f / 256.0f) + 1e-5f);
                const size_t row = (size_t)(row0 + t0 + tt);
#pragma unroll
                for (int j = 0; j < 4; ++j) { const int cc = h * 256 + lane + 64 * j; const float n = (x[j] - mean) * rstd * ng[cc] + nb[cc];
                    const float gr = bf2f(U[row * NINP + U_GR + cc]); OB[row * BW + cc] = f2bf(n * gr * sigmoidf_(gr)); }
            }
            __syncthreads();
        }
        float* op = (sq < PB ? outP + (((size_t)sq * 4 + h) * 128 + kh * 64) * 256 : outS + (((size_t)(sq - PB) * 4 + h) * 128 + kh * 64) * 256) + vt;
#pragma unroll
        for (int kk = 0; kk < 64; ++kk) op[(size_t)kk * 256] = S[kk];
    }
}

__device__ __forceinline__ f32x4 mma16(bf16x8 x, bf16x8 y, f32x4 c) { return __builtin_amdgcn_mfma_f32_16x16x32_bf16(x, y, c, 0, 0, 0); }
__device__ __forceinline__ bf16x8 pack_acc(const f32x4& a, const f32x4& b) {
    u32x4 p; p.x = pk2(a[0], a[1]); p.y = pk2(a[2], a[3]); p.z = pk2(b[0], b[1]); p.w = pk2(b[2], b[3]); return __builtin_bit_cast(bf16x8, p);
}
__device__ __forceinline__ void gla_chunk_info(int u, int& row0, int& ntok, int& h) {
    if (u < 512) { const int b = u >> 8; h = (u >> 6) & 3; row0 = b * PS + (u & 63) * 64; ntok = 64; }
    else { const int s = u - 512; h = s & 3; row0 = MP + (s >> 2) * SS; ntok = SS; }
}
__device__ __forceinline__ void ph_gla_pre(const Ctx& c, const bf16_t* __restrict__ U, const float* __restrict__ a_up, const float* __restrict__ a_b,
                                           bf16_t* __restrict__ QD, bf16_t* __restrict__ KHT, bf16_t* __restrict__ EE, bf16_t* __restrict__ VT, float* __restrict__ GC) {
    LAS float* ga_l = (LAS float*)c.lds;
    LAS float* tot = ga_l + 64 * 16;
    LAS bf16_t* Qd_l = (LAS bf16_t*)(tot + 4 * 128);
    LAS bf16_t* Kn_l = Qd_l + 64 * 136;
    LAS bf16_t* v_l = Kn_l + 64 * 136;
    LAS bf16_t* qr_l = v_l + 64 * 264;
    LAS bf16_t* kr_l = qr_l + 64 * 136;
    const int tid = c.tid, lane = c.lane, r = lane & 15, q = lane >> 4, w = c.wave;
    for (int u = (c.bid + c.G / 2) % c.G; u < GL_NCH; u += c.G) {
        int row0, ntok, h; gla_chunk_info(u, row0, ntok, h);
        for (int i = tid; i < 64 * 16; i += 512) { const int t = i >> 4, rr = i & 15; ga_l[i] = t < ntok ? bf2f(U[(size_t)(row0 + t) * NINP + U_GA + rr]) : 0.f; }
        for (int i = tid; i < 64 * 32; i += 512) { const int t = i >> 5, c8 = i & 31; u32x4 vv = (u32x4){0u, 0u, 0u, 0u};
            if (t < ntok) vv = *(const u32x4*)(U + (size_t)(row0 + t) * NINP + U_GV + h * 256 + c8 * 8);
            *(LAS u32x4*)(v_l + t * 264 + c8 * 8) = vv; }
        for (int i = tid; i < 64 * 16; i += 512) { const int t = i >> 4, c8 = i & 15; u32x4 qv = (u32x4){0u, 0u, 0u, 0u}, kv = qv;
            if (t < ntok) { const bf16_t* ur = U + (size_t)(row0 + t) * NINP + h * 128 + c8 * 8; qv = *(const u32x4*)(ur + U_GQ); kv = *(const u32x4*)(ur + U_GK); }
            *(LAS u32x4*)(qr_l + t * 136 + c8 * 8) = qv; *(LAS u32x4*)(kr_l + t * 136 + c8 * 8) = kv; }
        __syncthreads();
        const int kk = tid & 127, tq = tid >> 7;
        float cum[16];
        { float aup[16];
#pragma unroll
          for (int rr = 0; rr < 16; ++rr) aup[rr] = a_up[rr * 512 + h * 128 + kk];
          const float ab = a_b[h * 128 + kk]; float run = 0.f;
#pragma unroll
          for (int j = 0; j < 16; ++j) { const int t = tq * 16 + j; float x = ab;
#pragma unroll
              for (int rr = 0; rr < 16; ++rr) x += ga_l[t * 16 + rr] * aup[rr];
              const float la = t < ntok ? (fminf(x, 0.f) - __logf(1.0f + __expf(-fabsf(x)))) * (1.0f / 16.0f) : 0.f;
              run += la; cum[j] = run; }
          tot[tq * 128 + kk] = run; }
        __syncthreads();
        { float prefix = 0.f, bC = 0.f;
#pragma unroll
          for (int g = 0; g < 4; ++g) { const float tv = tot[g * 128 + kk]; bC += tv; if (g < tq) prefix += tv; }
          unsigned khp[8];
#pragma unroll
          for (int j = 0; j < 16; j += 2) { float kh2[2];
#pragma unroll
              for (int e = 0; e < 2; ++e) { const int t = tq * 16 + j + e; const float b = prefix + cum[j + e]; const float qv = bf2f(qr_l[t * 136 + kk]), kv = bf2f(kr_l[t * 136 + kk]);
                  Qd_l[t * 136 + kk] = f2bf(qv * __expf(b) * 0.08838834764831845f); Kn_l[t * 136 + kk] = f2bf(kv * __expf(-b)); kh2[e] = kv * __expf(bC - b); }
              khp[j >> 1] = pk2(kh2[0], kh2[1]); }
          bf16_t* kp = KHT + (size_t)u * 8192 + kk * 64 + tq * 16;
          *(u32x4*)kp = (u32x4){khp[0], khp[1], khp[2], khp[3]}; *(u32x4*)(kp + 8) = (u32x4){khp[4], khp[5], khp[6], khp[7]};
          if (tq == 0) GC[(size_t)u * 128 + kk] = __expf(bC); }
        __syncthreads();
        { const int tb = w >> 1;
#pragma unroll
          for (int e = 0; e < 2; ++e) { const int ib = (w & 1) * 2 + e; f32x4 d = (f32x4){0.f, 0.f, 0.f, 0.f};
              if (ib <= tb) {
                  bf16x8 kf4[4], qf4[4];
#pragma unroll
                  for (int ks = 0; ks < 4; ++ks) { kf4[ks] = *(const LAS bf16x8*)(Kn_l + (ib * 16 + r) * 136 + ks * 32 + q * 8); qf4[ks] = *(const LAS bf16x8*)(Qd_l + (tb * 16 + r) * 136 + ks * 32 + q * 8); }
                  __builtin_amdgcn_sched_barrier(0);
#pragma unroll
                  for (int ks = 0; ks < 4; ++ks) d = mma16(kf4[ks], qf4[ks], d); }
              const int t = tb * 16 + r, i0 = ib * 16 + q * 4;
#pragma unroll
              for (int jj = 0; jj < 4; ++jj) if (i0 + jj > t) d[jj] = 0.f;
              u32x2 o; o.x = pk2(d[0], d[1]); o.y = pk2(d[2], d[3]); *(u32x2*)(EE + (size_t)u * 4096 + t * 64 + i0) = o; } }
        for (int i = tid; i < 64 * 16; i += 512) { const int t = i >> 4, c8 = i & 15; *(u32x4*)(QD + (size_t)u * 8192 + t * 128 + c8 * 8) = *(const LAS u32x4*)(Qd_l + t * 136 + c8 * 8); }
        { const int val = tid & 255, th = tid >> 8;
#pragma unroll
          for (int tg = 0; tg < 4; ++tg) { const int t0 = th * 32 + tg * 8; unsigned p4[4];
#pragma unroll
              for (int e = 0; e < 4; ++e) p4[e] = (unsigned)v_l[(t0 + 2 * e) * 264 + val] | ((unsigned)v_l[(t0 + 2 * e + 1) * 264 + val] << 16);
              *(u32x4*)(VT + (size_t)u * 16384 + val * 64 + t0) = (u32x4){p4[0], p4[1], p4[2], p4[3]}; } }
        __syncthreads();
    }
}
struct GlaStage { u32x4 qd[2], kh[2], e, vt, gc; };
__device__ __forceinline__ void gla_stage_load(GlaStage& s, const bf16_t* __restrict__ QD, const bf16_t* __restrict__ KHT, const bf16_t* __restrict__ EE, const bf16_t* __restrict__ VT, const float* __restrict__ GC,
                                               int ch, int sl, int tid) {
    const bf16_t* qp = QD + (size_t)ch * 8192 + tid * 8; s.qd[0] = *(const u32x4*)qp; s.qd[1] = *(const u32x4*)(qp + 4096);
    const bf16_t* kp = KHT + (size_t)ch * 8192 + tid * 8; s.kh[0] = *(const u32x4*)kp; s.kh[1] = *(const u32x4*)(kp + 4096);
    s.e = *(const u32x4*)(EE + (size_t)ch * 4096 + tid * 8);
    s.vt = *(const u32x4*)(VT + (size_t)ch * 16384 + sl * 4096 + tid * 8);
    if (tid < 32) s.gc = *(const u32x4*)(GC + (size_t)ch * 128 + tid * 4);
}
constexpr int GS_KH = 8704, GS_E = 17920, GS_VT = 22528, GS_GC = 27136, GS_EL = 27392;
__device__ __forceinline__ void gla_stage_store(const GlaStage& s, LAS bf16_t* b, int tid) {
    *(LAS u32x4*)(b + (tid >> 4) * 136 + (tid & 15) * 8) = s.qd[0]; *(LAS u32x4*)(b + (32 + (tid >> 4)) * 136 + (tid & 15) * 8) = s.qd[1];
    *(LAS u32x4*)(b + GS_KH + (tid >> 3) * 72 + (tid & 7) * 8) = s.kh[0]; *(LAS u32x4*)(b + GS_KH + (64 + (tid >> 3)) * 72 + (tid & 7) * 8) = s.kh[1];
    *(LAS u32x4*)(b + GS_E + (tid >> 3) * 72 + (tid & 7) * 8) = s.e; *(LAS u32x4*)(b + GS_VT + (tid >> 3) * 72 + (tid & 7) * 8) = s.vt;
    if (tid < 32) *(LAS u32x4*)(b + GS_GC + tid * 8) = s.gc;
}
__device__ __forceinline__ void ph_gla_seq(const Ctx& c, int boff, const bf16_t* __restrict__ QD, const bf16_t* __restrict__ KHT, const bf16_t* __restrict__ EE, const bf16_t* __restrict__ VT, const float* __restrict__ GC,
                                           const float* __restrict__ s0, float* __restrict__ outP, float* __restrict__ outS, bf16_t* __restrict__ OB) {
    LAS bf16_t* stg = (LAS bf16_t*)c.lds;
    LAS bf16_t* T_l = stg + 2 * GS_EL;
    const int tid = c.tid, lane = c.lane, r = lane & 15, q = lane >> 4, w = c.wave;
    const int side = c.bid < 32 ? c.bid : c.bid - 64, nside = c.G - 64;
    for (int u = (c.bid >= boff && c.bid < boff + 32) ? c.bid - boff : ((c.bid < 32 || c.bid >= 96) ? 32 + side : 32 + 512); u < 32 + 512; u = u < 32 ? 32 + 512 : u + nside) {
        int h, sl, nch, ch0, row0, ntok; const float* sp = nullptr; float* op;
        if (u < 32) { const int b = u >> 4; h = (u >> 2) & 3; sl = u & 3; nch = 64; ch0 = (b * 4 + h) * 64; row0 = b * PS; ntok = 64; op = outP + (size_t)(b * 4 + h) * 32768; }
        else { const int s = u - 32, sq = s >> 4; h = (s >> 2) & 3; sl = s & 3; nch = 1; ch0 = 512 + sq * 4 + h; row0 = MP + sq * SS; ntok = SS; sp = s0 + (size_t)(sq * 4 + h) * 32768; op = outS + (size_t)(sq * 4 + h) * 32768; }
        f32x4 acc[4];
#pragma unroll
        for (int vb = 0; vb < 4; ++vb)
#pragma unroll
            for (int jj = 0; jj < 4; ++jj) acc[vb][jj] = sp ? sp[(size_t)(w * 16 + q * 4 + jj) * 256 + sl * 64 + vb * 16 + r] : 0.f;
        GlaStage R0, R1, R2;
        gla_stage_load(R0, QD, KHT, EE, VT, GC, ch0, sl, tid);
        if (1 < nch) gla_stage_load(R1, QD, KHT, EE, VT, GC, ch0 + 1, sl, tid);
        if (2 < nch) gla_stage_load(R2, QD, KHT, EE, VT, GC, ch0 + 2, sl, tid);
        __syncthreads();
        gla_stage_store(R0, stg, tid);
        if (3 < nch) gla_stage_load(R0, QD, KHT, EE, VT, GC, ch0 + 3, sl, tid);
#define GLA_STEP(ci, RN) do { \
            LAS bf16_t* Tb = T_l + ((ci) & 1) * 64 * 136; const LAS bf16_t* sb = stg + ((ci) & 1) * GS_EL; \
            _Pragma("unroll") for (int vb = 0; vb < 4; ++vb) { u32x2 o; o.x = pk2(acc[vb][0], acc[vb][1]); o.y = pk2(acc[vb][2], acc[vb][3]); *(LAS u32x2*)(Tb + (vb * 16 + r) * 136 + w * 16 + q * 4) = o; } \
            __syncthreads(); \
            if ((ci) + 1 < nch) { gla_stage_store(RN, stg + (((ci) + 1) & 1) * GS_EL, tid); if ((ci) + 4 < nch) gla_stage_load(RN, QD, KHT, EE, VT, GC, ch0 + (ci) + 4, sl, tid); } \
            { const int rb = w >> 1, t = rb * 16 + r; bf16x8 qf[4], ef[2]; \
              _Pragma("unroll") for (int ks = 0; ks < 4; ++ks) qf[ks] = *(const LAS bf16x8*)(sb + (rb * 16 + r) * 136 + ks * 32 + q * 8); \
              _Pragma("unroll") for (int ks = 0; ks < 2; ++ks) ef[ks] = *(const LAS bf16x8*)(sb + GS_E + (rb * 16 + r) * 72 + ks * 32 + q * 8); \
              bf16x8 tf[2][4], vf[2][2]; \
              _Pragma("unroll") for (int e2 = 0; e2 < 2; ++e2) { const int cb = (w & 1) * 2 + e2; \
                  _Pragma("unroll") for (int ks = 0; ks < 4; ++ks) tf[e2][ks] = *(const LAS bf16x8*)(Tb + (cb * 16 + r) * 136 + ks * 32 + q * 8); \
                  _Pragma("unroll") for (int ks = 0; ks < 2; ++ks) vf[e2][ks] = *(const LAS bf16x8*)(sb + GS_VT + (cb * 16 + r) * 72 + ks * 32 + q * 8); } \
              __builtin_amdgcn_sched_barrier(0); \
              _Pragma("unroll") for (int e2 = 0; e2 < 2; ++e2) { const int cb = (w & 1) * 2 + e2; f32x4 y = (f32x4){0.f, 0.f, 0.f, 0.f}; \
                  _Pragma("unroll") for (int ks = 0; ks < 4; ++ks) y = mma16(tf[e2][ks], qf[ks], y); \
                  _Pragma("unroll") for (int ks = 0; ks < 2; ++ks) y = mma16(vf[e2][ks], ef[ks], y); \
                  if (t < ntok) { u32x2 o; o.x = pk2(y[0], y[1]); o.y = pk2(y[2], y[3]); *(u32x2*)(OB + (size_t)(row0 + (ci) * 64 + t) * BW + h * 256 + sl * 64 + cb * 16 + q * 4) = o; } } } \
            { const f32x4 gcv = *(const LAS f32x4*)((const LAS float*)(sb + GS_GC) + w * 16 + q * 4); bf16x8 kf[2]; \
              _Pragma("unroll") for (int ks = 0; ks < 2; ++ks) kf[ks] = *(const LAS bf16x8*)(sb + GS_KH + (w * 16 + r) * 72 + ks * 32 + q * 8); \
              bf16x8 vs[4][2]; \
              _Pragma("unroll") for (int vb = 0; vb < 4; ++vb) _Pragma("unroll") for (int ks = 0; ks < 2; ++ks) vs[vb][ks] = *(const LAS bf16x8*)(sb + GS_VT + (vb * 16 + r) * 72 + ks * 32 + q * 8); \
              __builtin_amdgcn_sched_barrier(0); \
              _Pragma("unroll") for (int vb = 0; vb < 4; ++vb) { acc[vb] = acc[vb] * gcv; \
                  _Pragma("unroll") for (int ks = 0; ks < 2; ++ks) acc[vb] = mma16(kf[ks], vs[vb][ks], acc[vb]); } } \
        } while (0)
#pragma unroll 1
        for (int ci = 0; ci < nch; ci += 3) {
            GLA_STEP(ci, R1);
            if (ci + 1 < nch) GLA_STEP(ci + 1, R2);
            if (ci + 2 < nch) GLA_STEP(ci + 2, R0);
        }
#undef GLA_STEP
#pragma unroll
        for (int vb = 0; vb < 4; ++vb)
#pragma unroll
            for (int jj = 0; jj < 4; ++jj) op[(size_t)(w * 16 + q * 4 + jj) * 256 + sl * 64 + vb * 16 + r] = acc[vb][jj];
        __syncthreads();
    }
}
__device__ __forceinline__ void ph_gla_fin(const Ctx& c, const bf16_t* __restrict__ U, const float* __restrict__ ng, const float* __restrict__ nb, const bf16_t* __restrict__ RAW, bf16_t* __restrict__ OB) {
    const int lane = c.lane, hs = lane >> 5, l32 = lane & 31;
    for (int i = c.bid * 8 + c.wave; i < MT * 2; i += c.G * 8) {
        const int row = i >> 1, h = (i & 1) * 2 + hs, cc = h * 256 + l32 * 8; bf16_t* p = OB + (size_t)row * BW + cc;
        float x[8], gr[8]; unpack8(*(const u32x4*)(RAW + (size_t)row * BW + cc), x); unpack8(*(const u32x4*)(U + (size_t)row * NINP + U_GR + cc), gr);
        float s = 0.f;
#pragma unroll
        for (int j = 0; j < 8; ++j) s += x[j];
#pragma unroll
        for (int o = 16; o > 0; o >>= 1) s += __shfl_xor(s, o, 64);
        const float mean = s * (1.0f / 256.0f); float qq = 0.f;
#pragma unroll
        for (int j = 0; j < 8; ++j) { const float d = x[j] - mean; qq += d * d; }
#pragma unroll
        for (int o = 16; o > 0; o >>= 1) qq += __shfl_xor(qq, o, 64);
        const float rstd = rsqrtf(qq * (1.0f / 256.0f) + 1e-5f);
        const f32x4 g0 = *(const f32x4*)(ng + cc), g1 = *(const f32x4*)(ng + cc + 4), b0 = *(const f32x4*)(nb + cc), b1 = *(const f32x4*)(nb + cc + 4); float o8[8];
#pragma unroll
        for (int j = 0; j < 8; ++j) o8[j] = ((x[j] - mean) * rstd * (j < 4 ? g0[j] : g1[j - 4]) + (j < 4 ? b0[j] : b1[j - 4])) * gr[j] * sigmoidf_(gr[j]);
        *(u32x4*)p = (u32x4){pk2(o8[0], o8[1]), pk2(o8[2], o8[3]), pk2(o8[4], o8[5]), pk2(o8[6], o8[7])};
    }
}

template <bool ISBF> __device__ __forceinline__ void swa_step(const float (&q)[32], float (&acc)[32], float& m, float& l, const void* kp, const void* vp, float slope, float dist) {
    float s = 0.f;
#pragma unroll
    for (int j = 0; j < 4; ++j) { float x[8];
        if (ISBF) unpack8(*(const u32x4*)((const bf16_t*)kp + j * 8), x);
        else { const f32x4 a = *(const f32x4*)((const float*)kp + j * 8), b = *(const f32x4*)((const float*)kp + j * 8 + 4); x[0] = a[0]; x[1] = a[1]; x[2] = a[2]; x[3] = a[3]; x[4] = b[0]; x[5] = b[1]; x[6] = b[2]; x[7] = b[3]; }
#pragma unroll
        for (int d = 0; d < 8; ++d) s += q[j * 8 + d] * x[d]; }
    s += __shfl_xor(s, 1, 64);
    s = s * 0.125f - slope * dist;
    const float mn = fmaxf(m, s), cc = __expf(m - mn), p = __expf(s - mn);
    l = l * cc + p;
#pragma unroll
    for (int j = 0; j < 4; ++j) { float x[8];
        if (ISBF) unpack8(*(const u32x4*)((const bf16_t*)vp + j * 8), x);
        else { const f32x4 a = *(const f32x4*)((const float*)vp + j * 8), b = *(const f32x4*)((const float*)vp + j * 8 + 4); x[0] = a[0]; x[1] = a[1]; x[2] = a[2]; x[3] = a[3]; x[4] = b[0]; x[5] = b[1]; x[6] = b[2]; x[7] = b[3]; }
#pragma unroll
        for (int d = 0; d < 8; ++d) acc[j * 8 + d] = acc[j * 8 + d] * cc + p * x[d]; }
    m = mn;
}
__device__ __forceinline__ void ph_swa_naive(const Ctx& c, const bf16_t* __restrict__ U, const float* __restrict__ ck, const float* __restrict__ cv, const float* __restrict__ sinks, bf16_t* __restrict__ OB) {
    for (int gid = c.bid * 512 + c.tid; gid < MS * 32; gid += c.G * 512) {
        const int dh = gid & 1, h = (gid >> 1) & 15, row = MP + (gid >> 5), kvh = h >> 3, co = kvh * 64 + dh * 32;
        float q[32], acc[32];
#pragma unroll
        for (int j = 0; j < 4; ++j) { float x[8]; unpack8(*(const u32x4*)(U + (size_t)row * NINP + U_SQ + h * 64 + dh * 32 + j * 8), x);
#pragma unroll
            for (int d = 0; d < 8; ++d) { q[j * 8 + d] = x[d]; acc[j * 8 + d] = 0.f; } }
        const float slope = exp2f(-0.5f * (float)(h + 1)); float m = sinks[h], l = 1.0f;
        if (row < MP) {
            const int t = row % PS, base = row - t, lo = t - 128 < 0 ? 0 : t - 128;
            for (int s = lo; s <= t; ++s) { const bf16_t* ur = U + (size_t)(base + s) * NINP;
                swa_step<true>(q, acc, m, l, ur + U_SK + co, ur + U_SV + co, slope, (float)(t - s)); }
        } else {
            const int sq = (row - MP) / SS, i = (row - MP) % SS;
            for (int idx = i; idx <= 128 + i; ++idx) {
                if (idx < 128) { const size_t o = ((size_t)sq * 128 + idx) * 128 + co; swa_step<false>(q, acc, m, l, ck + o, cv + o, slope, (float)(128 + i - idx)); }
                else { const bf16_t* ur = U + (size_t)(MP + sq * SS + idx - 128) * NINP; swa_step<true>(q, acc, m, l, ur + U_SK + co, ur + U_SV + co, slope, (float)(128 + i - idx)); }
            }
        }
        const float inv = 1.0f / l; bf16_t* op = OB + (size_t)row * BW + h * 64 + dh * 32;
#pragma unroll
        for (int j = 0; j < 4; ++j) { u32x4 w; w.x = pk2(acc[j * 8] * inv, acc[j * 8 + 1] * inv); w.y = pk2(acc[j * 8 + 2] * inv, acc[j * 8 + 3] * inv);
            w.z = pk2(acc[j * 8 + 4] * inv, acc[j * 8 + 5] * inv); w.w = pk2(acc[j * 8 + 6] * inv, acc[j * 8 + 7] * inv); *(u32x4*)(op + j * 8) = w; }
    }
}

__device__ __forceinline__ void ph_rwkv_prep(const Ctx& c, const bf16_t* __restrict__ U, const float* __restrict__ shift, const float* __restrict__ mu, const float* __restrict__ w0, const float* __restrict__ w2,
                                             const float* __restrict__ a0, const float* __restrict__ a2, const float* __restrict__ g2, const float* __restrict__ k_k, const float* __restrict__ k_a,
                                             const float* __restrict__ r_k, float* __restrict__ RW) {
    LAS float* xm = (LAS float*)c.lds; LAS float* tw = xm + RWC; LAS float* ad = tw + 64; LAS float* sg = ad + 64;
    const int tid = c.tid;
    float* R = RW; float* WD = RW + (size_t)MPAD * BW; float* K2 = WD + (size_t)MPAD * BW; float* V = K2 + (size_t)MPAD * BW; float* KK = V + (size_t)MPAD * BW;
    float* BV = KK + (size_t)MPAD * BW; float* G = BV + (size_t)MPAD * BW; float* BON = G + (size_t)MPAD * BW;
    for (int row = c.bid; row < MT; row += c.G) {
        const bf16_t* ur = U + (size_t)row * NINP + U_RU; const bf16_t* pr = ur - NINP; const float* ps = nullptr; bool first;
        if (row < MP) first = (row % PS) == 0; else { first = ((row - MP) % SS) == 0; ps = shift + (size_t)((row - MP) / SS) * RWC; }
        for (int cc = tid; cc < RWC; cc += 512) { const float x = bf2f(ur[cc]); const float s = first ? (ps ? ps[cc] : 0.f) : bf2f(pr[cc]); xm[cc] = x + (s - x) * mu[cc]; }
        __syncthreads();
        if (tid < 64) { tw[tid] = tanhf(xm[3072 + tid]); ad[tid] = xm[3136 + tid]; }
        if (tid >= 128 && tid < 256) sg[tid - 128] = sigmoidf_(xm[3200 + tid - 128]);
        __syncthreads();
        for (int qd = 0; qd < 2; ++qd) {
            const int cc = qd * 512 + tid; float accw = w0[cc], acca = a0[cc], accg = 0.f;
#pragma unroll 4
            for (int j = 0; j < 64; ++j) { accw += tw[j] * w2[j * BW + cc]; acca += ad[j] * a2[j * BW + cc]; }
#pragma unroll 4
            for (int j = 0; j < 128; ++j) accg += sg[j] * g2[j * BW + cc];
            const float lw = -softplusf_(-accw) - 0.5f, decay = __expf(-__expf(lw)), a = sigmoidf_(acca);
            const float r = xm[cc], k = xm[1024 + cc], v = xm[2048 + cc];
            const float kkr = k * k_k[cc]; const float ss = wave_sum(kkr * kkr); const float kk = kkr / fmaxf(sqrtf(ss), 1e-12f);
            const float k2 = k * (1.0f + (a - 1.0f) * k_a[cc]); const float rk = wave_sum(r * k2 * r_k[cc]);
            const size_t o = (size_t)row * BW + cc;
            R[o] = r; WD[o] = decay; K2[o] = k2; V[o] = v; KK[o] = kk; BV[o] = kk * a; G[o] = accg; BON[o] = rk * v;
        }
        __syncthreads();
    }
}
__device__ __forceinline__ int kperm_pos(int k) { return (k & ~31) + 8 * ((k >> 2) & 3) + 4 * ((k >> 4) & 1) + (k & 3); }
__device__ __forceinline__ void ph_swa_prompt(const Ctx& c, const bf16_t* __restrict__ U, const float* __restrict__ sinks, bf16_t* __restrict__ OB) {
    LAS bf16_t* K_l = (LAS bf16_t*)c.lds;
    LAS bf16_t* VT_l = K_l + 192 * 72;
    const int tid = c.tid, lane = c.lane, r = lane & 15, q = lane >> 4, w = c.wave;
    for (int u = c.bid; u < PB * 64 * 2; u += c.G) {
        const int b = u >> 7, qb = (u >> 1) & 63, kvh = u & 1, h = kvh * 8 + w;
        const int tok0 = qb * 64 - 128;
        const size_t seq0 = (size_t)b * PS;
        const bf16_t* qbase = U + (seq0 + qb * 64 + r) * NINP + U_SQ + h * 64 + q * 8;
        bf16x8 qn0 = *(const bf16x8*)qbase, qn1 = *(const bf16x8*)(qbase + 32);
        { u32x4 kv3[3], vv3[3];
#pragma unroll
          for (int k3 = 0; k3 < 3; ++k3) { const int idx = tid + 512 * k3, kl = idx >> 3, c8 = idx & 7, tk = tok0 + kl; kv3[k3] = (u32x4){0u, 0u, 0u, 0u}; vv3[k3] = kv3[k3];
            if (tk >= 0) { const bf16_t* ur = U + (seq0 + tk) * NINP; kv3[k3] = *(const u32x4*)(ur + U_SK + kvh * 64 + c8 * 8); vv3[k3] = *(const u32x4*)(ur + U_SV + kvh * 64 + c8 * 8); } }
#pragma unroll
          for (int k3 = 0; k3 < 3; ++k3) { const int idx = tid + 512 * k3, kl = idx >> 3, c8 = idx & 7; const u32x4 vv = vv3[k3];
            *(LAS u32x4*)(K_l + kl * 72 + c8 * 8) = kv3[k3];
            const int kp = kperm_pos(kl); LAS bf16_t* vp = VT_l + (c8 * 8) * 200 + kp;
            vp[0] = (bf16_t)(vv.x & 0xffffu); vp[200] = (bf16_t)(vv.x >> 16); vp[400] = (bf16_t)(vv.y & 0xffffu); vp[600] = (bf16_t)(vv.y >> 16);
            vp[800] = (bf16_t)(vv.z & 0xffffu); vp[1000] = (bf16_t)(vv.z >> 16); vp[1200] = (bf16_t)(vv.w & 0xffffu); vp[1400] = (bf16_t)(vv.w >> 16); } }
        __syncthreads();
        const float slope = exp2f(-0.5f * (float)(h + 1)), sink = sinks[h];
#pragma unroll 1
        for (int i = 0; i < 4; ++i) {
            const size_t qrow = seq0 + qb * 64 + i * 16 + r;
            const bf16x8 qf0 = qn0, qf1 = qn1;
            { const bf16_t* qp = qbase + (size_t)((i < 3 ? i + 1 : 3) * 16) * NINP; qn0 = *(const bf16x8*)qp; qn1 = *(const bf16x8*)(qp + 32); }
            const int kt0 = i & ~1;
            f32x4 s[10]; float mx = sink; bf16x8 kfr[5][2];
#pragma unroll
            for (int kt = 0; kt < 10; ++kt) { f32x4 d;
                if (kt % 5 == 0) {
#pragma unroll
                    for (int k5 = 0; k5 < 5; ++k5) { const LAS bf16_t* kp = K_l + ((kt0 + kt + k5) * 16 + r) * 72 + q * 8; kfr[k5][0] = *(const LAS bf16x8*)kp; kfr[k5][1] = *(const LAS bf16x8*)(kp + 32); }
                    __builtin_amdgcn_sched_barrier(0); }
                d = mma16(kfr[kt % 5][0], qf0, (f32x4){0.f, 0.f, 0.f, 0.f}); d = mma16(kfr[kt % 5][1], qf1, d);
#pragma unroll
                for (int jj = 0; jj < 4; ++jj) { const int kl = (kt0 + kt) * 16 + q * 4 + jj, dist = i * 16 + r + 128 - kl;
                    const float v = (dist >= 0 && dist <= 128 && tok0 + kl >= 0) ? d[jj] * 0.125f - slope * (float)dist : -1e30f; d[jj] = v; mx = fmaxf(mx, v); }
                s[kt] = d; }
            mx = fmaxf(mx, __shfl_xor(mx, 16, 64)); mx = fmaxf(mx, __shfl_xor(mx, 32, 64));
            float sum = 0.f; bf16x8 pf[5];
#pragma unroll
            for (int kp = 0; kp < 5; ++kp) { f32x4 a = s[2 * kp], bq = s[2 * kp + 1];
#pragma unroll
                for (int jj = 0; jj < 4; ++jj) { a[jj] = __expf(a[jj] - mx); bq[jj] = __expf(bq[jj] - mx); sum += a[jj] + bq[jj]; }
                pf[kp] = pack_acc(a, bq); }
            sum += __shfl_xor(sum, 16, 64); sum += __shfl_xor(sum, 32, 64);
            const float inv = 1.0f / (sum + __expf(sink - mx));
            bf16_t* op = OB + qrow * BW + h * 64 + q * 4;
#pragma unroll
            for (int dt = 0; dt < 4; ++dt) { f32x4 o = (f32x4){0.f, 0.f, 0.f, 0.f}; bf16x8 vfr[5];
#pragma unroll
                for (int kp = 0; kp < 5; ++kp) vfr[kp] = *(const LAS bf16x8*)(VT_l + (dt * 16 + r) * 200 + (kt0 + 2 * kp) * 16 + q * 8);
                __builtin_amdgcn_sched_barrier(0);
#pragma unroll
                for (int kp = 0; kp < 5; ++kp) o = mma16(vfr[kp], pf[kp], o);
                u32x2 ov; ov.x = pk2(o[0] * inv, o[1] * inv); ov.y = pk2(o[2] * inv, o[3] * inv); *(u32x2*)(op + dt * 16) = ov; }
        }
        __syncthreads();
    }
}

__device__ __forceinline__ void ph_swa_sample(const Ctx& c, const bf16_t* __restrict__ U, const float* __restrict__ ck, const float* __restrict__ cv, const float* __restrict__ sinks, bf16_t* __restrict__ OB) {
    LAS bf16_t* K_l = (LAS bf16_t*)c.lds;
    LAS bf16_t* VT_l = K_l + 160 * 72;
    const int tid = c.tid, lane = c.lane, r = lane & 15, q = lane >> 4, w = c.wave;
    for (int u = c.bid; u < SB * 2; u += c.G) {
        const int sq = u >> 1, kvh = u & 1;
        for (int idx = tid; idx < 160 * 8; idx += 512) { const int kl = idx >> 3, c8 = idx & 7; float kx[8], vx[8];
#pragma unroll
            for (int e = 0; e < 8; ++e) { kx[e] = 0.f; vx[e] = 0.f; }
            if (kl < 128) { const size_t o = ((size_t)sq * 128 + kl) * 128 + kvh * 64 + c8 * 8; const f32x4 a = *(const f32x4*)(ck + o), b2 = *(const f32x4*)(ck + o + 4), c2 = *(const f32x4*)(cv + o), d2 = *(const f32x4*)(cv + o + 4);
                kx[0] = a[0]; kx[1] = a[1]; kx[2] = a[2]; kx[3] = a[3]; kx[4] = b2[0]; kx[5] = b2[1]; kx[6] = b2[2]; kx[7] = b2[3];
                vx[0] = c2[0]; vx[1] = c2[1]; vx[2] = c2[2]; vx[3] = c2[3]; vx[4] = d2[0]; vx[5] = d2[1]; vx[6] = d2[2]; vx[7] = d2[3]; }
            else if (kl < 132) { const bf16_t* ur = U + (size_t)(MP + sq * SS + kl - 128) * NINP; unpack8(*(const u32x4*)(ur + U_SK + kvh * 64 + c8 * 8), kx); unpack8(*(const u32x4*)(ur + U_SV + kvh * 64 + c8 * 8), vx); }
            *(LAS u32x4*)(K_l + kl * 72 + c8 * 8) = (u32x4){pk2(kx[0], kx[1]), pk2(kx[2], kx[3]), pk2(kx[4], kx[5]), pk2(kx[6], kx[7])};
            LAS bf16_t* vp = VT_l + (c8 * 8) * 168 + kperm_pos(kl);
#pragma unroll
            for (int e = 0; e < 8; ++e) vp[e * 168] = f2bf(vx[e]); }
        __syncthreads();
        if (w < 2) {
            const int h = kvh * 8 + w * 4 + (r >> 2), tk = r & 3; const size_t qrow = (size_t)(MP + sq * SS + tk);
            const float slope = exp2f(-0.5f * (float)(h + 1)), sink = sinks[h];
            const bf16x8 qf0 = *(const bf16x8*)(U + qrow * NINP + U_SQ + h * 64 + q * 8), qf1 = *(const bf16x8*)(U + qrow * NINP + U_SQ + h * 64 + 32 + q * 8);
            f32x4 s[10]; float mx = sink;
#pragma unroll
            for (int kt = 0; kt < 10; ++kt) { const LAS bf16_t* kp = K_l + (kt * 16 + r) * 72 + q * 8;
                f32x4 d = mma16(*(const LAS bf16x8*)kp, qf0, (f32x4){0.f, 0.f, 0.f, 0.f}); d = mma16(*(const LAS bf16x8*)(kp + 32), qf1, d);
#pragma unroll
                for (int jj = 0; jj < 4; ++jj) { const int kl = kt * 16 + q * 4 + jj, dist = 128 + tk - kl;
                    const float v = (dist >= 0 && dist <= 128) ? d[jj] * 0.125f - slope * (float)dist : -1e30f; d[jj] = v; mx = fmaxf(mx, v); }
                s[kt] = d; }
            mx = fmaxf(mx, __shfl_xor(mx, 16, 64)); mx = fmaxf(mx, __shfl_xor(mx, 32, 64));
            float sum = 0.f; bf16x8 pf[5];
#pragma unroll
            for (int kp = 0; kp < 5; ++kp) { f32x4 a = s[2 * kp], bq = s[2 * kp + 1];
#pragma unroll
                for (int jj = 0; jj < 4; ++jj) { a[jj] = __expf(a[jj] - mx); bq[jj] = __expf(bq[jj] - mx); sum += a[jj] + bq[jj]; }
                pf[kp] = pack_acc(a, bq); }
            sum += __shfl_xor(sum, 16, 64); sum += __shfl_xor(sum, 32, 64);
            const float inv = 1.0f / (sum + __expf(sink - mx));
            bf16_t* op = OB + qrow * BW + h * 64 + q * 4;
#pragma unroll
            for (int dt = 0; dt < 4; ++dt) { f32x4 o = (f32x4){0.f, 0.f, 0.f, 0.f};
#pragma unroll
                for (int kp = 0; kp < 5; ++kp) o = mma16(*(const LAS bf16x8*)(VT_l + (dt * 16 + r) * 168 + kp * 32 + q * 8), pf[kp], o);
                u32x2 ov; ov.x = pk2(o[0] * inv, o[1] * inv); ov.y = pk2(o[2] * inv, o[3] * inv); *(u32x2*)(op + dt * 16) = ov; }
        }
        __syncthreads();
    }
}

__device__ __forceinline__ void ph_memattn_prompt(const Ctx& c, const bf16_t* __restrict__ U, const bf16_t* __restrict__ MKB, const bf16_t* __restrict__ MVT, bf16_t* __restrict__ OB) {
    LAS bf16_t* buf = (LAS bf16_t*)c.lds;
    const int tid = c.tid, lane = c.lane, r = lane & 15, q = lane >> 4, w = c.wave;
    for (int u = c.bid; u < PB * 4 * 32; u += c.G) {
        const int b = u >> 7, h = (u >> 5) & 3, qb = u & 31;
        const size_t qrow = (size_t)b * PS + qb * 128 + w * 16 + r;
        const bf16_t* kg = MKB + (size_t)(b * 256) * 1024 + h * 256;
        const bf16_t* vg = MVT + (size_t)(b * 4 + h) * 65536;
        const bf16_t* qg = U + qrow * NINP + U_MQ + h * 256 + q * 8;
        bf16x8 qn0 = *(const bf16x8*)qg, qn1 = *(const bf16x8*)(qg + 32);
        u32x4 st[4];
#pragma unroll
        for (int i = 0; i < 4; ++i) { const int p = tid + 512 * i; st[i] = *(const u32x4*)(kg + (size_t)(p >> 3) * 1024 + (p & 7) * 8); }
        f32x4 s[16];
#pragma unroll
        for (int mt = 0; mt < 16; ++mt) s[mt] = (f32x4){0.f, 0.f, 0.f, 0.f};
        __syncthreads();
#pragma unroll 1
        for (int ck = 0; ck < 4; ++ck) {
            LAS bf16_t* kb = buf + (ck & 1) * 18432;
#pragma unroll
            for (int i = 0; i < 4; ++i) { const int p = tid + 512 * i; *(LAS u32x4*)(kb + (p >> 3) * 72 + (p & 7) * 8) = st[i]; }
            __syncthreads();
            const bf16x8 qc0 = qn0, qc1 = qn1;
            if (ck < 3) { qn0 = *(const bf16x8*)(qg + (ck + 1) * 64); qn1 = *(const bf16x8*)(qg + (ck + 1) * 64 + 32);
#pragma unroll
                for (int i = 0; i < 4; ++i) { const int p = tid + 512 * i; st[i] = *(const u32x4*)(kg + (size_t)(p >> 3) * 1024 + (ck + 1) * 64 + (p & 7) * 8); } }
#pragma unroll
            for (int m2 = 0; m2 < 16; m2 += 2) { bf16x8 kf[2][2];
#pragma unroll
                for (int j = 0; j < 2; ++j) { kf[j][0] = *(const LAS bf16x8*)(kb + ((m2 + j) * 16 + r) * 72 + q * 8); kf[j][1] = *(const LAS bf16x8*)(kb + ((m2 + j) * 16 + r) * 72 + 32 + q * 8); }
                __builtin_amdgcn_sched_barrier(0);
#pragma unroll
                for (int j = 0; j < 2; ++j) { s[m2 + j] = mma16(kf[j][0], qc0, s[m2 + j]); s[m2 + j] = mma16(kf[j][1], qc1, s[m2 + j]); } }
        }
#pragma unroll
        for (int i = 0; i < 4; ++i) { const int p = tid + 512 * i; st[i] = *(const u32x4*)(vg + (size_t)(p >> 5) * 256 + (p & 31) * 8); }
        float mx = -3.0e38f;
#pragma unroll
        for (int mt = 0; mt < 16; ++mt)
#pragma unroll
            for (int jj = 0; jj < 4; ++jj) { s[mt][jj] *= 0.0625f; mx = fmaxf(mx, s[mt][jj]); }
        mx = fmaxf(mx, __shfl_xor(mx, 16, 64)); mx = fmaxf(mx, __shfl_xor(mx, 32, 64));
        float sum = 0.f; bf16x8 pf[8];
#pragma unroll
        for (int kp = 0; kp < 8; ++kp) { f32x4 a = s[2 * kp], b2 = s[2 * kp + 1];
#pragma unroll
            for (int jj = 0; jj < 4; ++jj) { a[jj] = __expf(a[jj] - mx); b2[jj] = __expf(b2[jj] - mx); sum += a[jj] + b2[jj]; }
            pf[kp] = pack_acc(a, b2); }
        sum += __shfl_xor(sum, 16, 64); sum += __shfl_xor(sum, 32, 64);
        const float inv = 1.0f / sum;
        bf16_t* op = OB + qrow * BW + h * 256 + q * 4;
#pragma unroll 1
        for (int cv = 0; cv < 4; ++cv) {
            LAS bf16_t* vb = buf + (cv & 1) * 18432;
#pragma unroll
            for (int i = 0; i < 4; ++i) { const int p = tid + 512 * i, m0 = (p & 31) * 8; LAS bf16_t* d0 = vb + (p >> 5) * 264;
                *(LAS u32x2*)(d0 + kperm_pos(m0)) = (u32x2){st[i].x, st[i].y}; *(LAS u32x2*)(d0 + kperm_pos(m0 + 4)) = (u32x2){st[i].z, st[i].w}; }
            __syncthreads();
            if (cv < 3) {
#pragma unroll
                for (int i = 0; i < 4; ++i) { const int p = tid + 512 * i; st[i] = *(const u32x4*)(vg + (size_t)((cv + 1) * 64 + (p >> 5)) * 256 + (p & 31) * 8); } }
#pragma unroll
            for (int dt = 0; dt < 4; ++dt) { bf16x8 vf[8];
#pragma unroll
                for (int kp = 0; kp < 8; ++kp) vf[kp] = *(const LAS bf16x8*)(vb + (dt * 16 + r) * 264 + kp * 32 + q * 8);
                __builtin_amdgcn_sched_barrier(0);
                f32x4 o = (f32x4){0.f, 0.f, 0.f, 0.f};
#pragma unroll
                for (int kp = 0; kp < 8; ++kp) o = mma16(vf[kp], pf[kp], o);
                u32x2 ov; ov.x = pk2(o[0] * inv, o[1] * inv); ov.y = pk2(o[2] * inv, o[3] * inv); *(u32x2*)(op + (cv * 4 + dt) * 16) = ov; }
        }
        __syncthreads();
    }
}

__device__ __forceinline__ void ph_lrw(const Ctx& c, const float* __restrict__ w2, const float* __restrict__ a2, const float* __restrict__ g2, bf16_t* __restrict__ LRW) {
    for (int idx = c.bid * 512 + c.tid; idx < NL * 256 * 1024; idx += c.G * 512) {
        const int ch = idx & 1023, j = (idx >> 10) & 255, l = idx >> 18;
        const float v = j < 64 ? w2[((size_t)l * 64 + j) * BW + ch] : (j < 128 ? a2[((size_t)l * 64 + j - 64) * BW + ch] : g2[((size_t)l * 128 + j - 128) * BW + ch]);
        LRW[((size_t)l * 1024 + ch) * 256 + j] = f2bf(v);
    }
}
constexpr int RWP_UNITS = (MP / 64) * 4 + SB * 4;
__device__ __forceinline__ void rwp_unit_info(int u, int& row0, int& ntok, int& hg, int& sq, bool& seq_first) {
    if (u < (MP / 64) * 4) { const int blk = u >> 2; hg = u & 3; row0 = blk * 64; ntok = 64; sq = -1; seq_first = (row0 % PS) == 0; }
    else { const int s = u - (MP / 64) * 4; sq = s >> 2; hg = s & 3; row0 = MP + sq * SS; ntok = SS; seq_first = true; }
}
__device__ __forceinline__ void ph_rwkv_pre(const Ctx& c, const bf16_t* __restrict__ U, const float* __restrict__ shift, const float* __restrict__ mu, const float* __restrict__ w0, const float* __restrict__ w2,
                                            const float* __restrict__ a0, const float* __restrict__ a2, const float* __restrict__ g2, const float* __restrict__ k_k, const float* __restrict__ k_a,
                                            const float* __restrict__ r_k, float* __restrict__ RW, bf16_t* __restrict__ RB, const bf16_t* __restrict__ LRW) {
    LAS bf16_t* P_l = (LAS bf16_t*)c.lds; LAS bf16_t* Kn_l = P_l + 4608; LAS bf16_t* Bn_l = Kn_l + 4608; LAS bf16_t* Q_l = Bn_l + 4608;
    LAS bf16_t* PT_l = Q_l + 4608; LAS bf16_t* BhT_l = PT_l + 4608; LAS bf16_t* KhT_l = BhT_l + 4608; LAS bf16_t* VT_l = KhT_l + 4608;
    LAS float* A_l = (LAS float*)(c.lds + 73728);
    LAS bf16_t* BmT_l = (LAS bf16_t*)(c.lds + 78848); LAS bf16_t* F_l = (LAS bf16_t*)(c.lds + 81920); LAS bf16_t* Tinv_l = (LAS bf16_t*)(c.lds + 84992);
    LAS bf16_t* PpT_l = (LAS bf16_t*)(c.lds + 88064);
    LAS bf16_t* BmpT_l = (LAS bf16_t*)(c.lds + 97280);
    LAS float* GC_l = (LAS float*)(c.lds + 100352);
    LAS float* lg_l = (LAS float*)(c.lds + 125952);
    LAS bf16_t* act_l = (LAS bf16_t*)c.lds;
    LAS bf16_t* wT_l = act_l + 64 * 264;
    LAS bf16_t* aT_l = wT_l + 64 * 72;
    LAS bf16_t* gT_l = aT_l + 64 * 72;
    LAS float* pre_l = (LAS float*)(c.lds + 73728);
    const int tid = c.tid, lane = c.lane, r = lane & 15, q = lane >> 4, w = c.wave;
    bf16_t* Gg = (bf16_t*)(RW + 6 * (size_t)MPAD * BW); bf16_t* BON = (bf16_t*)(RW + 7 * (size_t)MPAD * BW);
    for (int u = c.bid; u < RWP_UNITS; u += c.G) {
        int row0, ntok, hg, sq; bool seq_first; rwp_unit_info(u, row0, ntok, hg, sq, seq_first);
        const float* sh = sq >= 0 ? shift + (size_t)sq * RWC : nullptr;
        const int nstage = ntok == 64 ? 64 : 16;
        for (int idx = tid; idx < nstage * 32; idx += 512) {
            const int t = idx >> 5, c8 = idx & 31, cc = 3072 + c8 * 8; float val[8];
#pragma unroll
            for (int e2 = 0; e2 < 8; ++e2) val[e2] = 0.f;
            if (t < ntok) { const bf16_t* ur = U + (size_t)(row0 + t) * NINP + U_RU; float x[8], p[8];
                unpack8(*(const u32x4*)(ur + cc), x);
                if (!(t == 0 && seq_first)) unpack8(*(const u32x4*)(ur + cc - NINP), p);
                else if (sh) { const f32x4 s0v = *(const f32x4*)(sh + cc), s1v = *(const f32x4*)(sh + cc + 4); p[0] = s0v[0]; p[1] = s0v[1]; p[2] = s0v[2]; p[3] = s0v[3]; p[4] = s1v[0]; p[5] = s1v[1]; p[6] = s1v[2]; p[7] = s1v[3]; }
                else {
#pragma unroll
                    for (int e2 = 0; e2 < 8; ++e2) p[e2] = 0.f; }
                const f32x4 m0 = *(const f32x4*)(mu + cc), m1 = *(const f32x4*)(mu + cc + 4);
#pragma unroll
                for (int e2 = 0; e2 < 8; ++e2) { const float xm = x[e2] + (p[e2] - x[e2]) * (e2 < 4 ? m0[e2] : m1[e2 - 4]); val[e2] = c8 < 8 ? tanh_fast(xm) : (c8 < 16 ? xm : sigmoidf_(xm)); } }
            *(LAS u32x4*)(act_l + t * 264 + c8 * 8) = (u32x4){pk2(val[0], val[1]), pk2(val[2], val[3]), pk2(val[4], val[5]), pk2(val[6], val[7])};
        }
        __syncthreads();
        bf16x8 af[8];
        { const int tb = w & 3;
#pragma unroll
          for (int ks = 0; ks < 8; ++ks) af[ks] = *(const LAS bf16x8*)(act_l + (tb * 16 + r) * 264 + ks * 32 + q * 8); }
        __syncthreads();
#pragma unroll 1
        for (int hh = 0; hh < 4; ++hh) { const int h = hg * 4 + hh;
        const int t = tid >> 3, cg = tid & 7, c0 = h * 64 + cg * 8, sc = t >> 4;
        u32x4 ux[3], upv[3];
        if (t < ntok) { const bf16_t* ur = U + (size_t)(row0 + t) * NINP + U_RU; const bool fst = (t == 0 && seq_first);
#pragma unroll
            for (int part = 0; part < 3; ++part) { ux[part] = *(const u32x4*)(ur + part * 1024 + c0); if (!fst) upv[part] = *(const u32x4*)(ur + part * 1024 + c0 - NINP); } }
        { const int tb = w & 3, chf = w >> 2;
          if (tb * 16 < nstage) {
            bf16x8 wf[2][8];
#pragma unroll
            for (int e2 = 0; e2 < 2; ++e2) { const bf16_t* wr = LRW + ((size_t)h * 64 + (chf * 2 + e2) * 16 + r) * 256 + q * 8;
#pragma unroll
                for (int ks = 0; ks < 8; ++ks) wf[e2][ks] = *(const bf16x8*)(wr + ks * 32); }
            __builtin_amdgcn_sched_barrier(0);
#pragma unroll
            for (int e2 = 0; e2 < 2; ++e2) { const int cb = chf * 2 + e2; f32x4 dw = (f32x4){0.f, 0.f, 0.f, 0.f}, da = dw, dg = dw;
#pragma unroll
                for (int ks = 0; ks < 2; ++ks) { dw = mma16(wf[e2][ks], af[ks], dw); da = mma16(wf[e2][2 + ks], af[2 + ks], da); }
#pragma unroll
                for (int ks = 0; ks < 4; ++ks) dg = mma16(wf[e2][4 + ks], af[4 + ks], dg);
                const int o = (tb * 16 + r) * 68 + cb * 16 + q * 4;
                *(LAS f32x4*)(pre_l + o) = dw; *(LAS f32x4*)(pre_l + 64 * 68 + o) = da; *(LAS f32x4*)(pre_l + 2 * 64 * 68 + o) = dg; } } }
        __syncthreads();
        float rr[8], k2[8], kap[8], bet[8], nlw[8];
        { float vx[8], gg[8], kkr[8]; float ss = 0.f, rk = 0.f;
          if (t < ntok) {
            const size_t row = (size_t)(row0 + t); const bf16_t* ur = U + row * NINP + U_RU; const bool fst = (t == 0 && seq_first);
            float kx[8];
#pragma unroll
            for (int part = 0; part < 3; ++part) { const int cc = part * 1024 + c0; float x[8], p[8];
                unpack8(ux[part], x);
                if (!fst) unpack8(upv[part], p);
                else {
#pragma unroll
                    for (int j = 0; j < 8; ++j) p[j] = sh ? sh[cc + j] : 0.f; }
                const f32x4 mA = *(const f32x4*)(mu + cc), mB = *(const f32x4*)(mu + cc + 4);
#pragma unroll
                for (int j = 0; j < 8; ++j) { const float xm = x[j] + (p[j] - x[j]) * (j < 4 ? mA[j] : mB[j - 4]); if (part == 0) rr[j] = xm; else if (part == 1) kx[j] = xm; else vx[j] = xm; } }
            float pw[8], pa[8], pkk[8], pka[8], prk[8];
#pragma unroll
            for (int hf = 0; hf < 2; ++hf) { const f32x4 v0 = *(const f32x4*)(w0 + c0 + hf * 4), v1 = *(const f32x4*)(a0 + c0 + hf * 4), v2 = *(const f32x4*)(k_k + c0 + hf * 4), v3 = *(const f32x4*)(k_a + c0 + hf * 4), v4 = *(const f32x4*)(r_k + c0 + hf * 4);
#pragma unroll
                for (int j = 0; j < 4; ++j) { pw[hf * 4 + j] = v0[j]; pa[hf * 4 + j] = v1[j]; pkk[hf * 4 + j] = v2[j]; pka[hf * 4 + j] = v3[j]; prk[hf * 4 + j] = v4[j]; } }
            float lwp[8], app[8];
#pragma unroll
            for (int hf = 0; hf < 2; ++hf) { const f32x4 v0 = *(const LAS f32x4*)(pre_l + t * 68 + cg * 8 + hf * 4), v1 = *(const LAS f32x4*)(pre_l + 64 * 68 + t * 68 + cg * 8 + hf * 4), v2 = *(const LAS f32x4*)(pre_l + 2 * 64 * 68 + t * 68 + cg * 8 + hf * 4);
#pragma unroll
                for (int j = 0; j < 4; ++j) { lwp[hf * 4 + j] = v0[j]; app[hf * 4 + j] = v1[j]; gg[hf * 4 + j] = v2[j]; } }
#pragma unroll
            for (int j = 0; j < 8; ++j) {
                const float lw = -softplus_fast(-(pw[j] + lwp[j])) - 0.5f; nlw[j] = -__expf(lw); const float av = sigmoidf_(pa[j] + app[j]);
                kkr[j] = kx[j] * pkk[j]; ss += kkr[j] * kkr[j]; k2[j] = kx[j] * (1.0f + (av - 1.0f) * pka[j]); rk += rr[j] * k2[j] * prk[j]; bet[j] = av; }
          } else {
#pragma unroll
            for (int j = 0; j < 8; ++j) { rr[j] = 0.f; k2[j] = 0.f; kkr[j] = 0.f; bet[j] = 0.f; nlw[j] = 0.f; vx[j] = 0.f; gg[j] = 0.f; }
          }
          ss += __shfl_xor(ss, 1, 64); ss += __shfl_xor(ss, 2, 64); ss += __shfl_xor(ss, 4, 64);
          rk += __shfl_xor(rk, 1, 64); rk += __shfl_xor(rk, 2, 64); rk += __shfl_xor(rk, 4, 64);
          const float inv = 1.0f / fmaxf(sqrtf(ss), 1e-12f);
#pragma unroll
          for (int j = 0; j < 8; ++j) { kap[j] = kkr[j] * inv; bet[j] = kap[j] * bet[j]; }
          if (t < ntok) { const size_t o = (size_t)(row0 + t) * BW + c0;
              *(u32x4*)(Gg + o) = (u32x4){pk2(gg[0], gg[1]), pk2(gg[2], gg[3]), pk2(gg[4], gg[5]), pk2(gg[6], gg[7])};
              *(u32x4*)(BON + o) = (u32x4){pk2(rk * vx[0], rk * vx[1]), pk2(rk * vx[2], rk * vx[3]), pk2(rk * vx[4], rk * vx[5]), pk2(rk * vx[6], rk * vx[7])}; }
          *(LAS f32x4*)(lg_l + t * 68 + cg * 8) = (f32x4){nlw[0], nlw[1], nlw[2], nlw[3]}; *(LAS f32x4*)(lg_l + t * 68 + cg * 8 + 4) = (f32x4){nlw[4], nlw[5], nlw[6], nlw[7]};
#pragma unroll
          for (int j = 0; j < 8; ++j) VT_l[(cg * 8 + j) * 72 + t] = f2bf(vx[j]);
        }
        __syncthreads();
        if (tid < 256) { const int cc = tid & 63, s4 = tid >> 6; float vv[16];
#pragma unroll
            for (int i = 0; i < 16; ++i) vv[i] = lg_l[(s4 * 16 + i) * 68 + cc];
            float run = 0.f;
#pragma unroll
            for (int i = 0; i < 16; ++i) { run += vv[i]; lg_l[(s4 * 16 + i) * 68 + cc] = run; } }
        __syncthreads();
        { unsigned pp[4], pq[4], pk[4], pb[4];
#pragma unroll
          for (int j = 0; j < 8; j += 2) { float vP[2], vQ[2], vK[2], vB[2];
#pragma unroll
              for (int e = 0; e < 2; ++e) { const int jj = j + e, cc = cg * 8 + jj; const float ci = lg_l[t * 68 + cc], cC = lg_l[(sc * 16 + 15) * 68 + cc];
                  const float ei = __expf(-ci), eh = __expf(cC - ci);
                  vP[e] = kap[jj] * __expf(ci - nlw[jj]); vQ[e] = rr[jj] * __expf(ci); vK[e] = k2[jj] * ei; vB[e] = bet[jj] * ei;
                  PT_l[cc * 72 + t] = f2bf(vP[e]); BhT_l[cc * 72 + t] = f2bf(bet[jj] * eh); KhT_l[cc * 72 + t] = f2bf(k2[jj] * eh); }
              pp[j >> 1] = pk2(vP[0], vP[1]); pq[j >> 1] = pk2(vQ[0], vQ[1]); pk[j >> 1] = pk2(vK[0], vK[1]); pb[j >> 1] = pk2(vB[0], vB[1]); }
          const int o = t * 72 + cg * 8;
          *(LAS u32x4*)(P_l + o) = (u32x4){pp[0], pp[1], pp[2], pp[3]}; *(LAS u32x4*)(Q_l + o) = (u32x4){pq[0], pq[1], pq[2], pq[3]};
          *(LAS u32x4*)(Kn_l + o) = (u32x4){pk[0], pk[1], pk[2], pk[3]}; *(LAS u32x4*)(Bn_l + o) = (u32x4){pb[0], pb[1], pb[2], pb[3]};
          if ((t & 15) == 15) {
#pragma unroll
              for (int j = 0; j < 8; ++j) GC_l[sc * 64 + cg * 8 + j] = __expf(lg_l[t * 68 + cg * 8 + j]); } }
        __syncthreads();
        const int nsub = ntok == 64 ? 4 : 1;
        const bf16x8 zfrag = (bf16x8){0, 0, 0, 0, 0, 0, 0, 0};
        { const int s4 = w & 3, hf = w >> 2;
          if (s4 < nsub) { const int ro = (s4 * 16 + r) * 72 + q * 8;
            if (hf == 0) {
                const bf16x8 b0 = *(const LAS bf16x8*)(Bn_l + ro), b1 = *(const LAS bf16x8*)(Bn_l + ro + 32), p0 = *(const LAS bf16x8*)(P_l + ro), p1 = *(const LAS bf16x8*)(P_l + ro + 32),
                             q0 = *(const LAS bf16x8*)(Q_l + ro), q1 = *(const LAS bf16x8*)(Q_l + ro + 32);
                __builtin_amdgcn_sched_barrier(0);
                f32x4 da = (f32x4){0.f, 0.f, 0.f, 0.f}, df = da; da = mma16(b0, p0, da); df = mma16(b0, q0, df); da = mma16(b1, p1, da); df = mma16(b1, q1, df);
                f32x4 o4; float f4[4];
#pragma unroll
                for (int jj = 0; jj < 4; ++jj) { o4[jj] = (q * 4 + jj < r) ? da[jj] : 0.f; f4[jj] = (q * 4 + jj <= r) ? df[jj] : 0.f; }
                *(LAS f32x4*)(A_l + s4 * 320 + r * 20 + q * 4) = o4;
                u32x2 o; o.x = pk2(f4[0], f4[1]); o.y = pk2(f4[2], f4[3]); *(LAS u32x2*)(F_l + s4 * 384 + r * 24 + q * 4) = o;
            } else {
                const bf16x8 p0 = *(const LAS bf16x8*)(P_l + ro), p1 = *(const LAS bf16x8*)(P_l + ro + 32), k0 = *(const LAS bf16x8*)(Kn_l + ro), k1 = *(const LAS bf16x8*)(Kn_l + ro + 32);
                __builtin_amdgcn_sched_barrier(0);
                f32x4 d = (f32x4){0.f, 0.f, 0.f, 0.f}; d = mma16(p0, k0, d); d = mma16(p1, k1, d);
                float o4[4];
#pragma unroll
                for (int jj = 0; jj < 4; ++jj) o4[jj] = (r < q * 4 + jj) ? d[jj] : 0.f;
                u32x2 o; o.x = pk2(o4[0], o4[1]); o.y = pk2(o4[2], o4[3]); *(LAS u32x2*)(BmT_l + s4 * 384 + r * 24 + q * 4) = o;
            } } }
        __syncthreads();
        if (w == 0 && (lane >> 4) < nsub) { const int s4 = lane >> 4, jc = lane & 15; float x[16];
#pragma unroll
            for (int tt = 0; tt < 16; ++tt) { float s = (tt == jc) ? 1.f : 0.f;
#pragma unroll
                for (int i = 0; i < tt; ++i) s -= A_l[s4 * 320 + tt * 20 + i] * x[i];
                x[tt] = s; }
#pragma unroll
            for (int tt = 0; tt < 16; ++tt) Tinv_l[s4 * 384 + tt * 24 + jc] = f2bf(x[tt]); }
        __syncthreads();
        { const int s4 = w & 3, hf = w >> 2;
          if (s4 < nsub) {
            const bf16x8 xf = q < 2 ? *(const LAS bf16x8*)(Tinv_l + s4 * 384 + r * 24 + q * 8) : zfrag;
            const bf16x8 y0 = q < 2 ? *(const LAS bf16x8*)(PT_l + ((hf * 2) * 16 + r) * 72 + s4 * 16 + q * 8) : zfrag, y1 = q < 2 ? *(const LAS bf16x8*)(PT_l + ((hf * 2 + 1) * 16 + r) * 72 + s4 * 16 + q * 8) : zfrag;
            const bf16x8 y2 = (q < 2 && hf == 0) ? *(const LAS bf16x8*)(BmT_l + s4 * 384 + r * 24 + q * 8) : zfrag;
            __builtin_amdgcn_sched_barrier(0);
            const f32x4 z4 = (f32x4){0.f, 0.f, 0.f, 0.f};
            const f32x4 d0 = mma16(xf, y0, z4), d1 = mma16(xf, y1, z4);
            u32x2 o; o.x = pk2(d0[0], d0[1]); o.y = pk2(d0[2], d0[3]); *(LAS u32x2*)(PpT_l + ((hf * 2) * 16 + r) * 72 + s4 * 16 + q * 4) = o;
            o.x = pk2(d1[0], d1[1]); o.y = pk2(d1[2], d1[3]); *(LAS u32x2*)(PpT_l + ((hf * 2 + 1) * 16 + r) * 72 + s4 * 16 + q * 4) = o;
            if (hf == 0) { const f32x4 d2 = mma16(xf, y2, z4); o.x = pk2(d2[0], d2[1]); o.y = pk2(d2[2], d2[3]); *(LAS u32x2*)(BmpT_l + s4 * 384 + r * 24 + q * 4) = o; } } }
        __syncthreads();
        { const int chunk0 = sq >= 0 ? PB * 16 * 256 + sq * 16 + h : ((row0 / PS) * 16 + h) * 256 + ((row0 % PS) >> 4);
          { const int s4 = w & 3, hf = w >> 2;
            if (s4 < nsub) { bf16_t* blob = RB + (size_t)(chunk0 + s4) * RB_EL;
              bf16x8 pp[4], bhm[2], fF = zfrag, bmp = zfrag, x4[4];
#pragma unroll
              for (int i = 0; i < 4; ++i) pp[i] = zfrag;
              bhm[0] = zfrag; bhm[1] = zfrag;
              if (q < 2) {
#pragma unroll
                  for (int i = 0; i < 4; ++i) pp[i] = *(const LAS bf16x8*)(PpT_l + (i * 16 + r) * 72 + s4 * 16 + q * 8);
#pragma unroll
                  for (int i = 0; i < 2; ++i) bhm[i] = *(const LAS bf16x8*)(BhT_l + ((hf * 2 + i) * 16 + r) * 72 + s4 * 16 + q * 8);
                  fF = *(const LAS bf16x8*)(F_l + s4 * 384 + r * 24 + q * 8); bmp = *(const LAS bf16x8*)(BmpT_l + s4 * 384 + r * 24 + q * 8); }
              if (hf == 0) {
#pragma unroll
                  for (int ks = 0; ks < 2; ++ks) { x4[ks] = *(const LAS bf16x8*)(Kn_l + (s4 * 16 + r) * 72 + ks * 32 + q * 8); x4[2 + ks] = *(const LAS bf16x8*)(Q_l + (s4 * 16 + r) * 72 + ks * 32 + q * 8); }
              } else {
#pragma unroll
                  for (int i = 0; i < 4; ++i) x4[i] = q < 2 ? *(const LAS bf16x8*)(BhT_l + (i * 16 + r) * 72 + s4 * 16 + q * 8) : zfrag;
              }
              __builtin_amdgcn_sched_barrier(0);
              const f32x4 z4 = (f32x4){0.f, 0.f, 0.f, 0.f};
              f32x4 dx[4];
              f32x4 d2 = z4, d1 = z4;
              if (hf == 0) {
#pragma unroll
                  for (int j = 0; j < 4; ++j) dx[j] = mma16(pp[j], fF, z4);
                  d2 = mma16(x4[0], x4[2], d2); d2 = mma16(x4[1], x4[3], d2);
                  d1 = mma16(bmp, fF, z4);
              } else {
#pragma unroll
                  for (int j = 0; j < 4; ++j) dx[j] = mma16(bmp, x4[j], z4);
              }
#pragma unroll
              for (int i = 0; i < 2; ++i) { const int cob = hf * 2 + i; const float gc = GC_l[s4 * 64 + cob * 16 + r]; f32x4 dm[4];
#pragma unroll
                  for (int j = 0; j < 4; ++j) dm[j] = mma16(pp[j], bhm[i], z4);
#pragma unroll
                  for (int cp = 0; cp < 2; ++cp) { float o8[8];
#pragma unroll
                      for (int e2 = 0; e2 < 2; ++e2) { const int cib = cp * 2 + e2;
#pragma unroll
                          for (int jj = 0; jj < 4; ++jj) o8[e2 * 4 + jj] = ((cib == cob && q * 4 + jj == r) ? gc : 0.f) - dm[cib][jj]; }
                      *(u32x4*)(blob + (cob * 16 + r) * 72 + 32 * cp + 8 * q) = (u32x4){pk2(o8[0], o8[1]), pk2(o8[2], o8[3]), pk2(o8[4], o8[5]), pk2(o8[6], o8[7])}; } }
              if (hf == 0) {
#pragma unroll
                  for (int cp = 0; cp < 2; ++cp) {
                      const u32x2 qa = *(const LAS u32x2*)(Q_l + (s4 * 16 + r) * 72 + (cp * 2) * 16 + q * 4), qb = *(const LAS u32x2*)(Q_l + (s4 * 16 + r) * 72 + (cp * 2 + 1) * 16 + q * 4);
                      const f32x4 da = dx[cp * 2], db = dx[cp * 2 + 1];
                      *(u32x4*)(blob + RB_QP + r * 72 + 32 * cp + 8 * q) = (u32x4){
                          pk2(__uint_as_float(qa.x << 16) - da[0], __uint_as_float(qa.x & 0xffff0000u) - da[1]), pk2(__uint_as_float(qa.y << 16) - da[2], __uint_as_float(qa.y & 0xffff0000u) - da[3]),
                          pk2(__uint_as_float(qb.x << 16) - db[0], __uint_as_float(qb.x & 0xffff0000u) - db[1]), pk2(__uint_as_float(qb.y << 16) - db[2], __uint_as_float(qb.y & 0xffff0000u) - db[3])}; }
                  float o4[4];
#pragma unroll
                  for (int jj = 0; jj < 4; ++jj) o4[jj] = ((q * 4 + jj <= r) ? d2[jj] : 0.f) - d1[jj];
                  u32x2 o; o.x = pk2(o4[0], o4[1]); o.y = pk2(o4[2], o4[3]); *(u32x2*)(blob + RB_EP + r * 24 + q * 4) = o;
              } else {
#pragma unroll
                  for (int cb = 0; cb < 4; ++cb) { const u32x2 kv = *(const LAS u32x2*)(KhT_l + (cb * 16 + r) * 72 + s4 * 16 + q * 4); const f32x4 d = dx[cb];
                      u32x2 o; o.x = pk2(__uint_as_float(kv.x << 16) - d[0], __uint_as_float(kv.x & 0xffff0000u) - d[1]); o.y = pk2(__uint_as_float(kv.y << 16) - d[2], __uint_as_float(kv.y & 0xffff0000u) - d[3]);
                      *(u32x2*)(blob + RB_KHP + (cb * 16 + r) * 16 + q * 4) = o; }
              } } }
          for (int idx = tid; idx < nsub * 128; idx += 512) { const int s4 = idx >> 7, cc = (idx >> 1) & 63, hf = idx & 1;
              *(u32x4*)(RB + (size_t)(chunk0 + s4) * RB_EL + RB_VT + cc * 16 + hf * 8) = *(const LAS u32x4*)(VT_l + cc * 72 + s4 * 16 + hf * 8); } }
        __syncthreads();
        }
    }
}

__device__ __forceinline__ void ph_rwkv_scan_naive(const Ctx& c, const float* __restrict__ RW, const float* __restrict__ s0, const float* __restrict__ lng, const float* __restrict__ lnb, bf16_t* __restrict__ OB,
                                                   float* __restrict__ outP, float* __restrict__ outS) {
    const float* R = RW; const float* WD = RW + (size_t)MPAD * BW; const float* K2 = WD + (size_t)MPAD * BW; const float* V = K2 + (size_t)MPAD * BW; const float* KK = V + (size_t)MPAD * BW;
    const float* BV = KK + (size_t)MPAD * BW; const float* G = BV + (size_t)MPAD * BW; const float* BON = G + (size_t)MPAD * BW;
    const int lane = c.lane;
    for (int it = 0;; ++it) {
        const int u = (it * 8 + c.wave) * c.G + c.bid;
        if (u >= (PB + SB) * 16) break;
        const int sq = u >> 4, h = u & 15;
        int row0, L; seq_info(sq, row0, L);
        float S[64];
        if (sq >= PB) { const float* p = s0 + (((size_t)(sq - PB) * 16 + h) * 64 + lane) * 64;
#pragma unroll
            for (int j = 0; j < 64; ++j) S[j] = p[j]; }
        else {
#pragma unroll
            for (int j = 0; j < 64; ++j) S[j] = 0.f; }
        const float lg = lng[h * 64 + lane], lb = lnb[h * 64 + lane];
        for (int t = 0; t < L; ++t) {
            const size_t base = (size_t)(row0 + t) * BW + h * 64; const float v = V[base + lane];
            float d = 0.f;
#pragma unroll
            for (int j = 0; j < 64; ++j) d += S[j] * KK[base + j];
            float y = 0.f;
#pragma unroll
            for (int j = 0; j < 64; ++j) { S[j] = S[j] * WD[base + j] - d * BV[base + j] + v * K2[base + j]; y += S[j] * R[base + j]; }
            const float mean = wave_sum(y) * (1.0f / 64.0f), dy = y - mean, var = wave_sum(dy * dy) * (1.0f / 64.0f);
            const float yn = dy * rsqrtf(var + 64e-5f) * lg + lb;
            OB[base + lane] = f2bf((yn + BON[base + lane]) * G[base + lane]);
        }
        float* op = (sq < PB ? outP + (((size_t)sq * 16 + h) * 64 + lane) * 64 : outS + (((size_t)(sq - PB) * 16 + h) * 64 + lane) * 64);
#pragma unroll
        for (int j = 0; j < 64; ++j) op[j] = S[j];
    }
}
__device__ __forceinline__ void ph_rwkv_scan2(const Ctx& c, int boff, const float* __restrict__ RW, const float* __restrict__ s0, const float* __restrict__ lng, const float* __restrict__ lnb, bf16_t* __restrict__ OB,
                                              float* __restrict__ outP, float* __restrict__ outS) {
    LAS float* opb = (LAS float*)c.lds;
    LAS float* yb = opb + 2 * 16 * 384;
    const int tid = c.tid, lane = c.lane, w = c.wave, rl = lane >> 3, cg = lane & 7, vrow = w * 8 + rl;
    const float* G = RW + 6 * (size_t)MPAD * BW; const float* BON = RW + 7 * (size_t)MPAD * BW;
    for (int u = (c.bid - boff + c.G) % c.G; u < (PB + SB) * 16; u += c.G) {
        const int sq = u >> 4, h = u & 15;
        int row0, L; seq_info(sq, row0, L);
        float S[8];
        if (sq >= PB) { const float* p = s0 + (((size_t)(sq - PB) * 16 + h) * 64 + vrow) * 64 + cg * 8;
#pragma unroll
            for (int j = 0; j < 8; ++j) S[j] = p[j]; }
        else {
#pragma unroll
            for (int j = 0; j < 8; ++j) S[j] = 0.f; }
        const float lg = lng[h * 64 + lane], lb = lnb[h * 64 + lane];
        const int nb = (L + 15) >> 4;
#define RW_STAGE(bi_) do { const int t0_ = (bi_) * 16, nT_ = (L - t0_) < 16 ? (L - t0_) : 16; LAS float* dst_ = opb + ((bi_) & 1) * 16 * 384; \
        for (int idx = tid; idx < nT_ * 96; idx += 512) { const int t = idx / 96, rem = idx - t * 96, slot = rem >> 4, c4 = rem & 15; \
            const int arr = slot == 0 ? 1 : slot == 1 ? 4 : slot == 2 ? 5 : slot == 3 ? 2 : slot == 4 ? 0 : 3; \
            *(LAS f32x4*)(dst_ + t * 384 + slot * 64 + c4 * 4) = *(const f32x4*)(RW + (size_t)arr * MPAD * BW + (size_t)(row0 + t0_ + t) * BW + h * 64 + c4 * 4); } } while (0)
        RW_STAGE(0);
        for (int bi = 0; bi < nb; ++bi) {
            __syncthreads();
            if (bi + 1 < nb) RW_STAGE(bi + 1);
            const int t0 = bi * 16, nT = (L - t0) < 16 ? (L - t0) : 16; const LAS float* src = opb + (bi & 1) * 16 * 384;
            for (int tt = 0; tt < nT; ++tt) {
                const LAS float* b = src + tt * 384 + cg * 8;
                const f32x4 w0 = *(const LAS f32x4*)(b), w1 = *(const LAS f32x4*)(b + 4), k0 = *(const LAS f32x4*)(b + 64), k1 = *(const LAS f32x4*)(b + 68);
                const f32x4 b0 = *(const LAS f32x4*)(b + 128), b1 = *(const LAS f32x4*)(b + 132), q0 = *(const LAS f32x4*)(b + 192), q1 = *(const LAS f32x4*)(b + 196);
                const f32x4 r0 = *(const LAS f32x4*)(b + 256), r1 = *(const LAS f32x4*)(b + 260); const float v = src[tt * 384 + 320 + vrow];
                float d = (S[0] * k0[0] + S[1] * k0[1]) + (S[2] * k0[2] + S[3] * k0[3]) + (S[4] * k1[0] + S[5] * k1[1]) + (S[6] * k1[2] + S[7] * k1[3]);
                d += __shfl_xor(d, 1, 64); d += __shfl_xor(d, 2, 64); d += __shfl_xor(d, 4, 64);
                float y = 0.f;
#pragma unroll
                for (int j = 0; j < 4; ++j) { S[j] = S[j] * w0[j] - d * b0[j] + v * q0[j]; y += S[j] * r0[j]; S[4 + j] = S[4 + j] * w1[j] - d * b1[j] + v * q1[j]; y += S[4 + j] * r1[j]; }
                y += __shfl_xor(y, 1, 64); y += __shfl_xor(y, 2, 64); y += __shfl_xor(y, 4, 64);
                if (cg == 0) yb[tt * 64 + vrow] = y;
            }
            __syncthreads();
            for (int tt = w; tt < nT; tt += 8) {
                const float y = yb[tt * 64 + lane]; const float mean = wave_sum(y) * (1.0f / 64.0f), dy = y - mean, var = wave_sum(dy * dy) * (1.0f / 64.0f);
                const float yn = dy * rsqrtf(var + 64e-5f) * lg + lb; const size_t o = (size_t)(row0 + t0 + tt) * BW + h * 64 + lane;
                OB[o] = f2bf((yn + BON[o]) * G[o]);
            }
        }
#undef RW_STAGE
        float* op = (sq < PB ? outP + (((size_t)sq * 16 + h) * 64 + vrow) * 64 : outS + (((size_t)(sq - PB) * 16 + h) * 64 + vrow) * 64) + cg * 8;
#pragma unroll
        for (int j = 0; j < 8; ++j) op[j] = S[j];
        __syncthreads();
    }
}
constexpr int RS_SLOTS = 9, RS_SLOT_B = RB_EL * 2;
__device__ __forceinline__ void ph_rwkv_seq(const Ctx& c, int boff, const bf16_t* __restrict__ RB, const float* __restrict__ s0, float* __restrict__ outP, float* __restrict__ outS, bf16_t* __restrict__ OB) {
    const int lane = c.lane, r = lane & 15, q = lane >> 4, w = c.wave;
    LAS unsigned char* ring = c.lds;
    const int side = c.bid < 32 ? c.bid : c.bid - 64, nside = c.G - 64;
    for (int u = (c.bid >= boff && c.bid < boff + 32) ? c.bid - boff : ((c.bid < 32 || c.bid >= 96) ? 32 + side : (PB + SB) * 16); u < (PB + SB) * 16; u = u < 32 ? (PB + SB) * 16 : u + nside) {
        const int sq = u >> 4, h = u & 15;
        int nch, ch0, row0, ntok; const float* sp = nullptr; float* op;
        if (sq < PB) { nch = 256; ch0 = (sq * 16 + h) * 256; row0 = sq * PS; ntok = 16; op = outP + (size_t)(sq * 16 + h) * 4096; }
        else { nch = 1; ch0 = PB * 16 * 256 + (sq - PB) * 16 + h; row0 = MP + (sq - PB) * SS; ntok = SS; sp = s0 + (size_t)((sq - PB) * 16 + h) * 4096; op = outS + (size_t)((sq - PB) * 16 + h) * 4096; }
        if (w >= 4) {
            const int lw = w - 4, p0 = lw * 4;
#define RS_ISSUE(ci_) do { const int cc_ = (ci_) < nch ? (ci_) : nch - 1; const char* g_ = (const char*)(RB + (size_t)(ch0 + cc_) * RB_EL) + p0 * 1024 + lane * 16; \
            LAS unsigned char* d_ = ring + ((ci_) % RS_SLOTS) * RS_SLOT_B + p0 * 1024; \
            _Pragma("unroll") for (int p_ = 0; p_ < 4; ++p_) __builtin_amdgcn_global_load_lds((const unsigned*)(g_ + p_ * 1024), (LAS unsigned*)(d_ + p_ * 1024), 16, 0, 0); } while (0)
            for (int ci = 0; ci < RS_SLOTS - 1; ++ci) RS_ISSUE(ci);
            asm volatile("s_waitcnt vmcnt(28)" ::: "memory");
            __builtin_amdgcn_s_barrier();
            for (int ci = 0; ci < nch; ++ci) {
                RS_ISSUE(ci + RS_SLOTS - 1);
                asm volatile("s_waitcnt vmcnt(28)" ::: "memory");
                __builtin_amdgcn_s_barrier();
            }
#undef RS_ISSUE
            asm volatile("s_waitcnt vmcnt(0)" ::: "memory");
        } else {
            const int vb = w; f32x4 acc[4];
#pragma unroll
            for (int kb = 0; kb < 4; ++kb) acc[kb] = sp ? *(const f32x4*)(sp + (size_t)(vb * 16 + r) * 64 + kb * 16 + q * 4) : (f32x4){0.f, 0.f, 0.f, 0.f};
            const bf16x8 zfrag = (bf16x8){0, 0, 0, 0, 0, 0, 0, 0};
            __builtin_amdgcn_s_barrier();
            for (int ci = 0; ci < nch; ++ci) {
                const LAS bf16_t* blob = (const LAS bf16_t*)(ring + (ci % RS_SLOTS) * RS_SLOT_B);
                bf16x8 mf[4][2], khf[4], qpf[2];
#pragma unroll
                for (int kb = 0; kb < 4; ++kb) { mf[kb][0] = *(const LAS bf16x8*)(blob + (kb * 16 + r) * 72 + q * 8); mf[kb][1] = *(const LAS bf16x8*)(blob + (kb * 16 + r) * 72 + 32 + q * 8);
                    khf[kb] = q < 2 ? *(const LAS bf16x8*)(blob + RB_KHP + (kb * 16 + r) * 16 + q * 8) : zfrag; }
                qpf[0] = *(const LAS bf16x8*)(blob + RB_QP + r * 72 + q * 8); qpf[1] = *(const LAS bf16x8*)(blob + RB_QP + r * 72 + 32 + q * 8);
                const bf16x8 vt = q < 2 ? *(const LAS bf16x8*)(blob + RB_VT + (vb * 16 + r) * 16 + q * 8) : zfrag;
                const bf16x8 ep = q < 2 ? *(const LAS bf16x8*)(blob + RB_EP + r * 24 + q * 8) : zfrag;
                const bf16x8 t0 = pack_acc(acc[0], acc[1]), t1 = pack_acc(acc[2], acc[3]);
                __builtin_amdgcn_sched_barrier(0);
#pragma unroll
                for (int kb = 0; kb < 4; ++kb) acc[kb] = mma16(mf[kb][0], t0, (f32x4){0.f, 0.f, 0.f, 0.f});
#pragma unroll
                for (int kb = 0; kb < 4; ++kb) acc[kb] = mma16(mf[kb][1], t1, acc[kb]);
#pragma unroll
                for (int kb = 0; kb < 4; ++kb) acc[kb] = mma16(khf[kb], vt, acc[kb]);
                f32x4 y = mma16(t0, qpf[0], (f32x4){0.f, 0.f, 0.f, 0.f}); y = mma16(t1, qpf[1], y); y = mma16(vt, ep, y);
                if (r < ntok) { u32x2 o; o.x = pk2(y[0], y[1]); o.y = pk2(y[2], y[3]); *(u32x2*)(OB + (size_t)(row0 + ci * 16 + r) * BW + h * 64 + vb * 16 + q * 4) = o; }
                asm volatile("s_waitcnt lgkmcnt(0)" ::: "memory");
                __builtin_amdgcn_s_barrier();
            }
#pragma unroll
            for (int kb = 0; kb < 4; ++kb) *(f32x4*)(op + (size_t)(vb * 16 + r) * 64 + kb * 16 + q * 4) = acc[kb];
        }
        __syncthreads();
    }
}
__device__ __forceinline__ void ph_rwkv_fin(const Ctx& c, const float* __restrict__ RW, const float* __restrict__ lng, const float* __restrict__ lnb, const bf16_t* __restrict__ RAW, bf16_t* __restrict__ OB) {
    const int lane = c.lane; const bf16_t* G = (const bf16_t*)(RW + 6 * (size_t)MPAD * BW); const bf16_t* BON = (const bf16_t*)(RW + 7 * (size_t)MPAD * BW);
    for (int i = c.bid * 8 + c.wave; i < MT * 2; i += c.G * 8) {
        const int row = i >> 1, cc = (i & 1) * 512 + lane * 8; const size_t o = (size_t)row * BW + cc;
        float x[8], bo[8], gt[8]; unpack8(*(const u32x4*)(RAW + o), x); unpack8(*(const u32x4*)(BON + o), bo); unpack8(*(const u32x4*)(G + o), gt);
        float s = 0.f;
#pragma unroll
        for (int j = 0; j < 8; ++j) s += x[j];
        s += __shfl_xor(s, 1, 64); s += __shfl_xor(s, 2, 64); s += __shfl_xor(s, 4, 64);
        const float mean = s * (1.0f / 64.0f); float qq = 0.f;
#pragma unroll
        for (int j = 0; j < 8; ++j) { const float d = x[j] - mean; qq += d * d; }
        qq += __shfl_xor(qq, 1, 64); qq += __shfl_xor(qq, 2, 64); qq += __shfl_xor(qq, 4, 64);
        const float rstd = rsqrtf(qq * (1.0f / 64.0f) + 64e-5f);
        const f32x4 g0 = *(const f32x4*)(lng + cc), g1 = *(const f32x4*)(lng + cc + 4), b0 = *(const f32x4*)(lnb + cc), b1 = *(const f32x4*)(lnb + cc + 4); float ov[8];
#pragma unroll
        for (int j = 0; j < 8; ++j) ov[j] = ((x[j] - mean) * rstd * (j < 4 ? g0[j] : g1[j - 4]) + (j < 4 ? b0[j] : b1[j - 4]) + bo[j]) * gt[j];
        *(u32x4*)(OB + o) = (u32x4){pk2(ov[0], ov[1]), pk2(ov[2], ov[3]), pk2(ov[4], ov[5]), pk2(ov[6], ov[7])};
    }
}

__device__ __forceinline__ void ph_memattn_sample(const Ctx& c, int boff, const bf16_t* __restrict__ U, const float* __restrict__ mk, const float* __restrict__ mv, bf16_t* __restrict__ OB) {
    LAS float* ps = (LAS float*)c.lds;
    const int hh = c.tid >> 8, vt = c.tid & 255, lane = c.lane, r = lane & 15, q = lane >> 4, w4 = c.wave & 3;
    for (int u = (c.bid - boff + c.G) % c.G; u < SB * 2; u += c.G) {
        const int sq = u >> 1, h = (u & 1) * 2 + hh;
        bf16x8 qf[8];
#pragma unroll
        for (int ks = 0; ks < 8; ++ks) { u32x4 raw = (u32x4){0u, 0u, 0u, 0u};
            if (r < 4) raw = *(const u32x4*)(U + (size_t)(MP + sq * SS + r) * NINP + U_MQ + h * 256 + ks * 32 + q * 8);
            qf[ks] = __builtin_bit_cast(bf16x8, raw); }
#pragma unroll 1
        for (int mt = 0; mt < 4; ++mt) { const float* kr = mk + (((size_t)sq * MEMT + (w4 * 4 + mt) * 16 + r) * 4 + h) * 256 + q * 8; f32x4 ka[8], kb2[8];
#pragma unroll
            for (int ks = 0; ks < 8; ++ks) { ka[ks] = *(const f32x4*)(kr + ks * 32); kb2[ks] = *(const f32x4*)(kr + ks * 32 + 4); }
            __builtin_amdgcn_sched_barrier(0);
            f32x4 d = (f32x4){0.f, 0.f, 0.f, 0.f};
#pragma unroll
            for (int ks = 0; ks < 8; ++ks) { u32x4 p; p.x = pk2(ka[ks][0], ka[ks][1]); p.y = pk2(ka[ks][2], ka[ks][3]); p.z = pk2(kb2[ks][0], kb2[ks][1]); p.w = pk2(kb2[ks][2], kb2[ks][3]);
                d = mma16(__builtin_bit_cast(bf16x8, p), qf[ks], d); }
            if (r < 4) *(LAS f32x4*)(ps + (hh * 4 + r) * 256 + (w4 * 4 + mt) * 16 + q * 4) = d * 0.0625f; }
        __syncthreads();
        { LAS float* pr = ps + c.wave * 256; float x[4]; float mx = -3.0e38f;
#pragma unroll
            for (int j = 0; j < 4; ++j) { x[j] = pr[lane + 64 * j]; mx = fmaxf(mx, x[j]); }
            mx = wave_max(mx); float s = 0.f;
#pragma unroll
            for (int j = 0; j < 4; ++j) { x[j] = __expf(x[j] - mx); s += x[j]; }
            const float inv = 1.0f / wave_sum(s);
#pragma unroll
            for (int j = 0; j < 4; ++j) pr[lane + 64 * j] = x[j] * inv; }
        __syncthreads();
        { float o[4] = {0.f, 0.f, 0.f, 0.f}; const float* vr = mv + ((size_t)sq * MEMT * 4 + h) * 256 + vt;
#pragma unroll 8
            for (int m = 0; m < MEMT; ++m) { const float vv = vr[(size_t)m * 1024];
#pragma unroll
                for (int t = 0; t < 4; ++t) o[t] += ps[(hh * 4 + t) * 256 + m] * vv; }
#pragma unroll
            for (int t = 0; t < 4; ++t) OB[(size_t)(MP + sq * SS + t) * BW + h * 256 + vt] = f2bf(o[t]); }
        __syncthreads();
    }
}

template <int K, int LDA, int LDB> __device__ __forceinline__ void skinny_pair(const Ctx& c, const bf16_t* __restrict__ A, const bf16_t* __restrict__ B0, const bf16_t* __restrict__ B1, f32x4 (&out)[2], int rot) {
    LAS f32x4* red = (LAS f32x4*)c.lds;
    const int lane = c.lane, r = lane & 15, q = lane >> 4, w = c.wave;
    constexpr int KS = K / 8;
    const bf16_t* ap = A + (size_t)r * LDA + w * KS + q * 8; const bf16_t* b0 = B0 + (size_t)r * LDB + w * KS + q * 8; const bf16_t* b1 = B1 + (size_t)r * LDB + w * KS + q * 8;
    f32x4 acc[2][8];
#pragma unroll
    for (int n = 0; n < 2; ++n)
#pragma unroll
        for (int m = 0; m < 8; ++m) acc[n][m] = (f32x4){0.f, 0.f, 0.f, 0.f};
    int kk = (int)((unsigned)rot % (unsigned)(KS / 32));
#pragma unroll 2
    for (int it = 0; it < KS / 32; ++it) { const int ks = kk; kk = kk + 1 == KS / 32 ? 0 : kk + 1;
        const bf16x8 f0 = *(const bf16x8*)(b0 + ks * 32), f1 = *(const bf16x8*)(b1 + ks * 32); bf16x8 af[8];
#pragma unroll
        for (int m = 0; m < 8; ++m) af[m] = *(const bf16x8*)(ap + (size_t)(m * 16) * LDA + ks * 32);
        __builtin_amdgcn_sched_barrier(0);
#pragma unroll
        for (int m = 0; m < 8; ++m) { acc[0][m] = mma16(f0, af[m], acc[0][m]); acc[1][m] = mma16(f1, af[m], acc[1][m]); } }
    __syncthreads();
#pragma unroll
    for (int n = 0; n < 2; ++n)
#pragma unroll
        for (int m = 0; m < 8; ++m) red[(w * 16 + n * 8 + m) * 64 + lane] = acc[n][m];
    __syncthreads();
#pragma unroll
    for (int n = 0; n < 2; ++n) { f32x4 s = red[(n * 8 + w) * 64 + lane];
#pragma unroll
        for (int ww = 1; ww < 8; ++ww) s += red[(ww * 16 + n * 8 + w) * 64 + lane];
        out[n] = s; }
}
template <int K, int LDA, int LDB> __device__ __forceinline__ f32x4 skinny_one(const Ctx& c, const bf16_t* __restrict__ A, const bf16_t* __restrict__ B0, int rot) {
    LAS f32x4* red = (LAS f32x4*)c.lds;
    const int lane = c.lane, r = lane & 15, q = lane >> 4, w = c.wave;
    constexpr int KS = K / 8, NK = KS / 32;
    const bf16_t* ap = A + (size_t)r * LDA + w * KS + q * 8; const bf16_t* b0 = B0 + (size_t)r * LDB + w * KS + q * 8;
    f32x4 acc[8];
#pragma unroll
    for (int m = 0; m < 8; ++m) acc[m] = (f32x4){0.f, 0.f, 0.f, 0.f};
    int kk = (int)((unsigned)rot % (unsigned)NK);
#pragma unroll 4
    for (int it = 0; it < NK; ++it) { const int ks = kk; kk = kk + 1 == NK ? 0 : kk + 1;
        const bf16x8 f0 = *(const bf16x8*)(b0 + ks * 32); bf16x8 af[8];
#pragma unroll
        for (int m = 0; m < 8; ++m) af[m] = *(const bf16x8*)(ap + (size_t)(m * 16) * LDA + ks * 32);
        __builtin_amdgcn_sched_barrier(0);
#pragma unroll
        for (int m = 0; m < 8; ++m) acc[m] = mma16(f0, af[m], acc[m]); }
    __syncthreads();
#pragma unroll
    for (int m = 0; m < 8; ++m) red[(w * 8 + m) * 64 + lane] = acc[m];
    __syncthreads();
    f32x4 s = red[w * 64 + lane];
#pragma unroll
    for (int ww = 1; ww < 8; ++ww) s += red[(ww * 8 + w) * 64 + lane];
    return s;
}
template <int K, int LDA, int LDB> __device__ __forceinline__ f32x4 skinny_half(const Ctx& c, const bf16_t* __restrict__ A, const bf16_t* __restrict__ B0) {
    LAS f32x4* red = (LAS f32x4*)c.lds;
    const int lane = c.lane, r = lane & 15, q = lane >> 4, w = c.wave;
    constexpr int KS = K / 8, NK = KS / 32;
    const bf16_t* ap = A + (size_t)r * LDA + w * KS + q * 8; const bf16_t* b0 = B0 + (size_t)r * LDB + w * KS + q * 8;
    f32x4 acc[4];
#pragma unroll
    for (int m = 0; m < 4; ++m) acc[m] = (f32x4){0.f, 0.f, 0.f, 0.f};
#pragma unroll 4
    for (int ks = 0; ks < NK; ++ks) {
        const bf16x8 f0 = *(const bf16x8*)(b0 + ks * 32); bf16x8 af[4];
#pragma unroll
        for (int m = 0; m < 4; ++m) af[m] = *(const bf16x8*)(ap + (size_t)(m * 16) * LDA + ks * 32);
        __builtin_amdgcn_sched_barrier(0);
#pragma unroll
        for (int m = 0; m < 4; ++m) acc[m] = mma16(f0, af[m], acc[m]); }
    __syncthreads();
#pragma unroll
    for (int m = 0; m < 4; ++m) red[(w * 4 + m) * 64 + lane] = acc[m];
    __syncthreads();
    f32x4 s = (f32x4){0.f, 0.f, 0.f, 0.f};
    if (w < 4) { s = red[w * 64 + lane];
#pragma unroll
        for (int ww = 1; ww < 8; ++ww) s += red[(ww * 4 + w) * 64 + lane]; }
    return s;
}
__device__ __forceinline__ u32x2 pk4(const f32x4 v) { u32x2 o; o.x = pk2(v[0], v[1]); o.y = pk2(v[2], v[3]); return o; }
#define SKINNY_LOOP(total_) for (int s = c.bid - base; s >= 0 && s < (total_); s += ncu)
__device__ __forceinline__ void ph_sk_in(const Ctx& c, int base, int ncu, const bf16_t* __restrict__ HB, const bf16_t* __restrict__ W, bf16_t* __restrict__ U) {
    const int r = c.lane & 15, q = c.lane >> 4, w = c.wave;
    SKINNY_LOOP(NINP / 32) { f32x4 o[2]; skinny_pair<DM, DM, DM>(c, HB + (size_t)MP * DM, W + (size_t)(s * 32) * DM, W + (size_t)(s * 32 + 16) * DM, o, s);
        bf16_t* up = U + (size_t)(MP + w * 16 + r) * NINP + s * 32 + q * 4; *(u32x2*)up = pk4(o[0]); *(u32x2*)(up + 16) = pk4(o[1]); }
}
__device__ __forceinline__ void ph_sk_merge(const Ctx& c, int base, int ncu, const bf16_t* __restrict__ BR, const bf16_t* __restrict__ W, const bf16_t* __restrict__ U, const float* __restrict__ gate_b, bf16_t* __restrict__ MGB) {
    const int r = c.lane & 15, q = c.lane >> 4, w = c.wave;
    SKINNY_LOOP(DM / 8) { const int ct = s >> 1, hf = s & 1; const size_t row = (size_t)(MP + hf * 64 + (w & 3) * 16 + r); const int col = ct * 16 + q * 4; f32x4 tot = (f32x4){0.f, 0.f, 0.f, 0.f};
#pragma unroll 1
        for (int z = 0; z < 4; ++z) { const f32x4 o = skinny_half<BW, BW, BW>(c, BR + ((size_t)z * MPAD + MP + hf * 64) * BW, W + ((size_t)z * DM + ct * 16) * BW);
            if (w < 4) { const u32x2 gp = *(const u32x2*)(U + row * NINP + U_GP + z * DM + col); const f32x4 gb = *(const f32x4*)(gate_b + z * DM + col);
            tot[0] += sigmoidf_(__uint_as_float(gp.x << 16) + gb[0]) * o[0]; tot[1] += sigmoidf_(__uint_as_float(gp.x & 0xffff0000u) + gb[1]) * o[1];
            tot[2] += sigmoidf_(__uint_as_float(gp.y << 16) + gb[2]) * o[2]; tot[3] += sigmoidf_(__uint_as_float(gp.y & 0xffff0000u) + gb[3]) * o[3]; } }
        if (w < 4) *(u32x2*)(MGB + row * DM + col) = pk4(tot); }
}
template <int K> __device__ __forceinline__ void ph_sk_res(const Ctx& c, int base, int ncu, const bf16_t* __restrict__ A, const bf16_t* __restrict__ W, const bf16_t* __restrict__ R, bf16_t* __restrict__ Y) {
    const int r = c.lane & 15, q = c.lane >> 4, w = c.wave;
    SKINNY_LOOP(DM / 8) { const int ct = s >> 1, hf = s & 1; const f32x4 o = skinny_half<K, K, K>(c, A + (size_t)(MP + hf * 64) * K, W + (size_t)(ct * 16) * K);
        if (w < 4) { const size_t off = (size_t)(MP + hf * 64 + w * 16 + r) * DM + ct * 16 + q * 4; const u32x2 rr = *(const u32x2*)(R + off);
        const f32x4 rv = (f32x4){__uint_as_float(rr.x << 16), __uint_as_float(rr.x & 0xffff0000u), __uint_as_float(rr.y << 16), __uint_as_float(rr.y & 0xffff0000u)};
        *(u32x2*)(Y + off) = pk4(rv * ALPHA + o); } }
}
__device__ __forceinline__ void ph_sk_gu(const Ctx& c, int base, int ncu, const bf16_t* __restrict__ X1B, const bf16_t* __restrict__ W, bf16_t* __restrict__ ACT) {
    const int r = c.lane & 15, q = c.lane >> 4, w = c.wave;
    SKINNY_LOOP(DFF / 16) { const int t = s >> 3, j0 = (s & 7) * 16; f32x4 o[2];
        skinny_pair<DM, DM, DM>(c, X1B + (size_t)MP * DM, W + (size_t)(t * 256 + j0) * DM, W + (size_t)(t * 256 + 128 + j0) * DM, o, s);
        f32x4 v;
#pragma unroll
        for (int j = 0; j < 4; ++j) v[j] = o[0][j] * sigmoidf_(o[0][j]) * o[1][j];
        *(u32x2*)(ACT + (size_t)(MP + w * 16 + r) * DFF + t * 128 + j0 + q * 4) = pk4(v); }
}
#undef SKINNY_LOOP

constexpr int LDS_BAR_OFF = 147456;
constexpr int LDS_BYTES = LDS_BAR_OFF + 64;
struct Args { const float* in[37]; float* out; unsigned char* ws; };

typedef pg8::Gemm<DM, DM, DM, 2, 8, NL, 1, false, 0, 0, (long)DM * DM, 0> GemmMem;
typedef pg8::Gemm<DM, DM, DM, MP / 256, NINP / 256> GemmIn;
typedef pg8::Gemm<NINP, 1024, 256, PS / 256, 1, 8, 4, false, (long)PS * NINP, 256, 256 * 1024, 256> GemmScore;
typedef pg8::Gemm<256, 256, 256, PS / 256, 1, 8, 4, false, (long)4 * 4096 * 256, (long)4096 * 256, 4 * 65536, 65536> GemmPV;
typedef pg8::Gemm<BW, BW, BW, MP / 256, DM / 256, 4, 1, true, (long)MPAD * BW, 0, (long)DM * BW, 0> GemmBranch;
typedef pg8::Gemm<DM, DM, DM, MP / 256, DM / 256> GemmOut;
typedef pg8::Gemm<DM, DM, DM, MP / 256, 2 * DFF / 256> GemmGU;
typedef pg8::Gemm<DFF, DFF, DFF, MP / 256, DM / 256> GemmDown;
template <class GT> __device__ __forceinline__ GT mk_gemm(const Ctx& c, const bf16_t* A, const bf16_t* B) { GT g; g.A = A; g.B = B; g.G = c.G; g.c = c.bid; return g; }

template <int OFF> __device__ __forceinline__ unsigned long long karg_u64(unsigned long long kargs) {
    unsigned long long p; asm volatile("s_load_dwordx2 %0, %1, %2\n\ts_waitcnt lgkmcnt(0)" : "=s"(p) : "s"(kargs), "n"(OFF) : "memory"); return p;
}
#define GPTR(T, x) ((T*)(__attribute__((address_space(1))) T*)(x))
#define INP(k) GPTR(const float, karg_u64<(k) * 8>(kargs))
#define OUTP() GPTR(float, karg_u64<37 * 8>(kargs))
#define WSP() GPTR(unsigned char, karg_u64<38 * 8>(kargs))

__global__ void __launch_bounds__(512, 2) mega_fwd(Args a_unused) {
    extern __shared__ __attribute__((aligned(16))) unsigned char lds_raw[];
    const unsigned long long kargs = (unsigned long long)__builtin_amdgcn_kernarg_segment_ptr();
    Ctx c0; c0.tid = threadIdx.x; c0.lane = c0.tid & 63; c0.wave = __builtin_amdgcn_readfirstlane(c0.tid >> 6); c0.bid = blockIdx.x; c0.G = gridDim.x; c0.lds = (LAS unsigned char*)lds_raw;
    if (c0.tid < 4) ((LAS unsigned*)(c0.lds + LDS_BAR_OFF))[c0.tid] = 0u;
    __syncthreads();
    const XcdBarrier bar = xcd_barrier_post((unsigned*)(WSP() + WS_CTL), (volatile LAS unsigned*)(c0.lds + LDS_BAR_OFF));

#define WP_SIDE 2
#define WP_GLA 3
#define WP_RW 2
#define WPREP_WIN(cc_, L_) do { unsigned char* ws_ = WSP(); \
      ph_wprep(cc_, INP(10) + (size_t)(L_) * DM * NIN, (bf16_t*)(ws_ + WS_WIN) + (size_t)(L_) * NINP * DM, DM, NIN, NINP, 1, 1, 0, 0); } while (0)
#define WPREP_LAYER(cc_, L_) do { WPREP_WIN(cc_, L_); WPREP_REST(cc_, L_); } while (0)
#define WPREP_REST(cc_, L_) do { unsigned char* ws_ = WSP(); \
      ph_wprep(cc_, INP(29) + (size_t)(L_) * 4 * BW * DM, (bf16_t*)(ws_ + WS_WBR) + (size_t)(L_) * 4 * DM * BW, BW, DM, DM, 0, 4, (size_t)BW * DM, (size_t)DM * BW); \
      ph_wprep(cc_, INP(30) + (size_t)(L_) * DM * DM, (bf16_t*)(ws_ + WS_WOUT) + (size_t)(L_) * DM * DM, DM, DM, DM, 0, 1, 0, 0); \
      ph_wprep(cc_, INP(33) + (size_t)(L_) * DM * 2 * DFF, (bf16_t*)(ws_ + WS_WGU) + (size_t)(L_) * 2 * DFF * DM, DM, 2 * DFF, 2 * DFF, 2, 1, 0, 0); \
      ph_wprep(cc_, INP(34) + (size_t)(L_) * DFF * DM, (bf16_t*)(ws_ + WS_WDN) + (size_t)(L_) * DM * DFF, DFF, DM, DM, 0, 1, 0, 0); } while (0)
    { const Ctx c = fresh(c0); unsigned char* ws = WSP();
      ph_wprep(c, INP(28), (bf16_t*)(ws + WS_WMEM), DM, DM, DM, 0, NL, (size_t)DM * DM, (size_t)DM * DM);
      WPREP_WIN(c, 0);
      ph_lrw(c, INP(19), INP(21), INP(22), (bf16_t*)(ws + WS_LRW));
      ph_xprep(c, INP(0), INP(1), INP(2), (float*)nullptr, (bf16_t*)(ws + WS_HB), (bf16_t*)(ws + WS_MEMB)); }
    xcd_barrier(bar);
    if (c0.bid >= 64) { Ctx c = fresh(c0); c.bid -= 64; c.G -= 64; WPREP_REST(c, 0); }
    { const Ctx c = fresh(c0); unsigned char* ws = WSP(); float* out = OUTP();
      GemmMem g = mk_gemm<GemmMem>(c, (const bf16_t*)(ws + WS_MEMB), (const bf16_t*)(ws + WS_WMEM));
      pg8::EpiMem E; E.outK = out + O_MKP; E.outV = out + O_MVP; E.kb = (bf16_t*)(ws + WS_MKB); E.vt = (bf16_t*)(ws + WS_MVT); pg8::gemm_phase<GemmMem, pg8::EpiMem, true, true>(c.lds, c.tid, g, E); }

    for (int l = 0; l < NL; ++l) {
        { const Ctx c = fresh(c0); unsigned char* ws = WSP();
          GemmIn g = mk_gemm<GemmIn>(c, (const bf16_t*)(ws + WS_HB), (const bf16_t*)(ws + WS_WIN) + (size_t)l * NINP * DM);
          pg8::EpiBf16 E; E.O = (bf16_t*)(ws + WS_U); E.zs = 0; E.ldc = NINP; E.pad = 0; pg8::gemm_phase<GemmIn, pg8::EpiBf16, true, true>(c.lds, c.tid, g, E); }
        { const Ctx c = fresh(c0); unsigned char* ws = WSP(); ph_sk_in(c, c.G > 192 ? 96 : 0, c.G > 192 ? c.G - 96 : c.G, (const bf16_t*)(ws + WS_HB), (const bf16_t*)(ws + WS_WIN) + (size_t)l * NINP * DM, (bf16_t*)(ws + WS_U)); }
        xcd_barrier(bar);
        { const Ctx c = fresh(c0); unsigned char* ws = WSP(); float* out = OUTP(); const bf16_t* U = (const bf16_t*)(ws + WS_U); bf16_t* BR = (bf16_t*)(ws + WS_BR);
          (void)out; (void)BR;
          ph_gla_pre(c, U, INP(12) + (size_t)l * 16 * 512, INP(13) + (size_t)l * 512, (bf16_t*)(ws + WS_GLQD), (bf16_t*)(ws + WS_GLKH), (bf16_t*)(ws + WS_GLE), (bf16_t*)(ws + WS_GLVT), (float*)(ws + WS_GLGC)); }
        { const Ctx c = fresh(c0); unsigned char* ws = WSP();
          ph_rwkv_pre(c, (const bf16_t*)(ws + WS_U), INP(9) + (size_t)l * SB * RWC, INP(17) + (size_t)l * RWC, INP(18) + (size_t)l * BW, INP(19) + (size_t)l * 64 * BW, INP(20) + (size_t)l * BW, INP(21) + (size_t)l * 64 * BW,
                       INP(22) + (size_t)l * 128 * BW, INP(23) + (size_t)l * BW, INP(24) + (size_t)l * BW, INP(25) + (size_t)l * BW, (float*)(ws + WS_RW), (bf16_t*)(ws + WS_RB), (const bf16_t*)(ws + WS_LRW) + (size_t)l * 1024 * 256); }
        { const Ctx c = fresh(c0); unsigned char* ws = WSP(); ph_memattn_prompt(c, (const bf16_t*)(ws + WS_U), (const bf16_t*)(ws + WS_MKB) + (size_t)l * 512 * 1024, (const bf16_t*)(ws + WS_MVT) + (size_t)l * 8 * 65536, (bf16_t*)(ws + WS_BR) + (size_t)3 * MPAD * BW); }
        xcd_barrier(bar);
        { const Ctx c = fresh(c0); unsigned char* ws = WSP(); float* out = OUTP();
          ph_rwkv_seq(c, 64, (const bf16_t*)(ws + WS_RB), INP(8) + (size_t)l * SB * 16 * 4096, out + O_RWP + (size_t)l * PB * 16 * 4096, out + O_RWS + (size_t)l * SB * 16 * 4096,
                      (bf16_t*)(ws + WS_RAW) + (size_t)MPAD * BW); }
        { const Ctx c = fresh(c0); unsigned char* ws = WSP(); float* out = OUTP();
          ph_gla_seq(c, 32, (const bf16_t*)(ws + WS_GLQD), (const bf16_t*)(ws + WS_GLKH), (const bf16_t*)(ws + WS_GLE), (const bf16_t*)(ws + WS_GLVT), (const float*)(ws + WS_GLGC),
                     INP(7) + (size_t)l * SB * 4 * 32768, out + O_GLAP + (size_t)l * PB * 4 * 32768, out + O_GLAS + (size_t)l * SB * 4 * 32768, (bf16_t*)(ws + WS_RAW)); }
        if ((c0.bid < 32 || c0.bid >= 96) && c0.G > 96) {
        { Ctx c = fresh(c0); c.bid = c.bid < 32 ? c.bid : c.bid - 64; c.G = c.G - 64; unsigned char* ws = WSP(); ph_swa_prompt(c, (const bf16_t*)(ws + WS_U), INP(16) + (size_t)l * 16, (bf16_t*)(ws + WS_BR) + (size_t)MPAD * BW); }
        { Ctx c = fresh(c0); c.bid = c.bid < 32 ? c.bid : c.bid - 64; c.G = c.G - 64; if (c.G > 128) c.bid = (c.bid + c.G - 128) % c.G;
          unsigned char* ws = WSP();
          ph_swa_sample(c, (const bf16_t*)(ws + WS_U), INP(3) + (size_t)l * SB * 16384, INP(4) + (size_t)l * SB * 16384, INP(16) + (size_t)l * 16, (bf16_t*)(ws + WS_BR) + (size_t)MPAD * BW); }
        { Ctx c = fresh(c0); c.bid = c.bid < 32 ? c.bid : c.bid - 64; c.G = c.G - 64; unsigned char* ws = WSP();
          ph_memattn_sample(c, 64, (const bf16_t*)(ws + WS_U), INP(5) + (size_t)l * SB * MEMT * 1024, INP(6) + (size_t)l * SB * MEMT * 1024, (bf16_t*)(ws + WS_BR) + (size_t)3 * MPAD * BW); }
        { Ctx c = fresh(c0); c.bid = c.bid < 32 ? c.bid : c.bid - 64; c.G = c.G - 64; unsigned char* ws = WSP();
          ph_copy_outs(c, (const bf16_t*)(ws + WS_U), INP(3) + (size_t)l * SB * 16384, INP(4) + (size_t)l * SB * 16384, OUTP(), l); }
        }
        if (l + 1 < NL) { const Ctx c = fresh(c0); unsigned char* ws = WSP(); const int L = l + 1;
          ph_wprep_dyn(c, (unsigned*)(ws + WS_CTL + 16384) + 64 * L,
                       INP(10) + (size_t)L * DM * NIN, INP(29) + (size_t)L * 4 * BW * DM, INP(30) + (size_t)L * DM * DM, INP(33) + (size_t)L * DM * 2 * DFF, INP(34) + (size_t)L * DFF * DM,
                       (bf16_t*)(ws + WS_WIN) + (size_t)L * NINP * DM, (bf16_t*)(ws + WS_WBR) + (size_t)L * 4 * DM * BW, (bf16_t*)(ws + WS_WOUT) + (size_t)L * DM * DM,
                       (bf16_t*)(ws + WS_WGU) + (size_t)L * 2 * DFF * DM, (bf16_t*)(ws + WS_WDN) + (size_t)L * DM * DFF); }
        xcd_barrier(bar);
        { const Ctx c = fresh(c0); unsigned char* ws = WSP(); ph_rwkv_fin(c, (const float*)(ws + WS_RW), INP(26) + (size_t)l * BW, INP(27) + (size_t)l * BW, (const bf16_t*)(ws + WS_RAW) + (size_t)MPAD * BW, (bf16_t*)(ws + WS_BR) + (size_t)2 * MPAD * BW); }
        { const Ctx c = fresh(c0); unsigned char* ws = WSP(); ph_gla_fin(c, (const bf16_t*)(ws + WS_U), INP(14) + (size_t)l * BW, INP(15) + (size_t)l * BW, (const bf16_t*)(ws + WS_RAW), (bf16_t*)(ws + WS_BR)); }
        xcd_barrier(bar);
        { const Ctx c = fresh(c0); unsigned char* ws = WSP();
          GemmBranch g = mk_gemm<GemmBranch>(c, (const bf16_t*)(ws + WS_BR), (const bf16_t*)(ws + WS_WBR) + (size_t)l * 4 * DM * BW);
          pg8::EpiMerge E; E.MG = (float*)(ws + WS_MG); E.MGB = (bf16_t*)(ws + WS_MGB); E.U = (const bf16_t*)(ws + WS_U); E.gate_b = INP(11) + (size_t)l * 4 * DM; pg8::gemm_phase<GemmBranch, pg8::EpiMerge, true, true>(c.lds, c.tid, g, E); }
        { const Ctx c = fresh(c0); unsigned char* ws = WSP(); ph_sk_merge(c, 0, c.G, (const bf16_t*)(ws + WS_BR), (const bf16_t*)(ws + WS_WBR) + (size_t)l * 4 * DM * BW, (const bf16_t*)(ws + WS_U), INP(11) + (size_t)l * 4 * DM, (bf16_t*)(ws + WS_MGB)); }
        xcd_barrier(bar);
        { const Ctx c = fresh(c0); unsigned char* ws = WSP();
          GemmOut g = mk_gemm<GemmOut>(c, (const bf16_t*)(ws + WS_MGB), (const bf16_t*)(ws + WS_WOUT) + (size_t)l * DM * DM);
          pg8::EpiRes E; E.R = (const bf16_t*)(ws + WS_HB); E.Y = (bf16_t*)(ws + WS_Y); pg8::gemm_phase<GemmOut, pg8::EpiRes, true, true>(c.lds, c.tid, g, E); }
        { const Ctx c = fresh(c0); unsigned char* ws = WSP(); ph_sk_res<DM>(c, 0, c.G, (const bf16_t*)(ws + WS_MGB), (const bf16_t*)(ws + WS_WOUT) + (size_t)l * DM * DM, (const bf16_t*)(ws + WS_HB), (bf16_t*)(ws + WS_Y)); }
        xcd_barrier(bar);
        { const Ctx c = fresh(c0); unsigned char* ws = WSP(); ph_ln(c, (const bf16_t*)(ws + WS_Y), INP(31) + (size_t)l * DM, INP(32) + (size_t)l * DM, (float*)nullptr, (bf16_t*)(ws + WS_X1B), nullptr, MT, 0); }
        xcd_barrier(bar);
        { const Ctx c = fresh(c0); unsigned char* ws = WSP();
          GemmGU g = mk_gemm<GemmGU>(c, (const bf16_t*)(ws + WS_X1B), (const bf16_t*)(ws + WS_WGU) + (size_t)l * 2 * DFF * DM);
          pg8::EpiSwiGLU E; E.O = (bf16_t*)(ws + WS_ACT); pg8::gemm_phase<GemmGU, pg8::EpiSwiGLU, true, true>(c.lds, c.tid, g, E); }
        { const Ctx c = fresh(c0); unsigned char* ws = WSP(); ph_sk_gu(c, c.G > 192 ? 128 : 0, c.G > 192 ? c.G - 128 : c.G, (const bf16_t*)(ws + WS_X1B), (const bf16_t*)(ws + WS_WGU) + (size_t)l * 2 * DFF * DM, (bf16_t*)(ws + WS_ACT)); }
        xcd_barrier(bar);
        { const Ctx c = fresh(c0); unsigned char* ws = WSP();
          GemmDown g = mk_gemm<GemmDown>(c, (const bf16_t*)(ws + WS_ACT), (const bf16_t*)(ws + WS_WDN) + (size_t)l * DM * DFF);
          pg8::EpiRes E; E.R = (const bf16_t*)(ws + WS_X1B); E.Y = (bf16_t*)(ws + WS_Y); pg8::gemm_phase<GemmDown, pg8::EpiRes, true, true>(c.lds, c.tid, g, E); }
        { const Ctx c = fresh(c0); unsigned char* ws = WSP(); ph_sk_res<DFF>(c, 0, c.G, (const bf16_t*)(ws + WS_ACT), (const bf16_t*)(ws + WS_WDN) + (size_t)l * DM * DFF, (const bf16_t*)(ws + WS_X1B), (bf16_t*)(ws + WS_Y)); }
        xcd_barrier(bar);
        { const Ctx c = fresh(c0); unsigned char* ws = WSP(); float* out = OUTP(); ph_ln(c, (const bf16_t*)(ws + WS_Y), INP(35) + (size_t)l * DM, INP(36) + (size_t)l * DM, (float*)nullptr, (bf16_t*)(ws + WS_HB), l == NL - 1 ? out : nullptr, MT, MT); }
        xcd_barrier(bar);
    }
}

extern "C" void kernel_launch(void* const* d_in, const int* in_sizes, int n_in, void* d_out, int out_size, void* d_ws, size_t ws_size, hipStream_t stream) {
    static int grid = 0;
    if (grid == 0) {
        if (n_in != 37 || (size_t)out_size != O_END || ws_size < WS_END) { fprintf(stderr, "kernel_launch: unexpected sizes (n_in %d out %d ws %zu need %zu)\n", n_in, out_size, ws_size, (size_t)WS_END); grid = -1; return; }
        int dev = 0, cus = 0;
        if (hipGetDevice(&dev) != hipSuccess || hipDeviceGetAttribute(&cus, hipDeviceAttributeMultiprocessorCount, dev) != hipSuccess) { grid = -1; return; }
        if (hipFuncSetAttribute((const void*)mega_fwd, hipFuncAttributeMaxDynamicSharedMemorySize, LDS_BYTES) != hipSuccess) { fprintf(stderr, "kernel_launch: hipFuncSetAttribute failed\n"); grid = -1; return; }
        int per_cu = 0;
        if (hipOccupancyMaxActiveBlocksPerMultiprocessor(&per_cu, (const void*)mega_fwd, 512, LDS_BYTES) != hipSuccess || per_cu < 1) { fprintf(stderr, "kernel_launch: occupancy query says %d\n", per_cu); }
        (void)hipGetLastError();
        grid = cus;
    }
    if (grid < 0) return;
    (void)hipMemsetAsync((unsigned char*)d_ws + WS_CTL, 0, 16384 + 1024, stream);
    Args a; memset(&a, 0, sizeof a);
    for (int i = 0; i < 37; ++i) a.in[i] = (const float*)d_in[i];
    a.out = (float*)d_out; a.ws = (unsigned char*)d_ws;
    hipLaunchKernelGGL(mega_fwd, dim3(grid), dim3(512), LDS_BYTES, stream, a);
}
```

```cpp
#include <hip/hip_runtime.h>
#include <cstdio>
#include <cstdint>
#include <cstring>

#define LAS __attribute__((address_space(3)))
typedef unsigned short bf16_t;
typedef short bf16x8 __attribute__((ext_vector_type(8)));
typedef float f32x4 __attribute__((ext_vector_type(4)));
typedef float f32x2 __attribute__((ext_vector_type(2)));
typedef unsigned u32x4 __attribute__((ext_vector_type(4)));
typedef unsigned u32x2 __attribute__((ext_vector_type(2)));

constexpr int DM = 2048, NL = 4;
constexpr int PB = 2, PS = 4096, MP = PB * PS;
constexpr int SB = 32, SS = 4, MS = SB * SS;
constexpr int MT = MP + MS;
constexpr int MPAD = 8448;
constexpr int NIN = 16912, NINP = 17152;
constexpr int U_GQ = 0, U_GK = 512, U_GV = 1024, U_GR = 2048, U_GA = 3072, U_SQ = 3328, U_SK = 4352, U_SV = 4480, U_RU = 4608, U_MQ = 7936, U_GP = 8960;
constexpr int RWC = 3328, BW = 1024, DFF = 5632, MEMT = 256;
constexpr float ALPHA = 1.681792830507429f;

constexpr size_t O_YP = 0;
constexpr size_t O_YS = O_YP + (size_t)MP * DM;
constexpr size_t O_SWKP = O_YS + (size_t)MS * DM;
constexpr size_t O_SWVP = O_SWKP + (size_t)NL * PB * 128 * 128;
constexpr size_t O_MKP = O_SWVP + (size_t)NL * PB * 128 * 128;
constexpr size_t O_MVP = O_MKP + (size_t)NL * PB * 256 * 1024;
constexpr size_t O_GLAP = O_MVP + (size_t)NL * PB * 256 * 1024;
constexpr size_t O_RWP = O_GLAP + (size_t)NL * PB * 4 * 128 * 256;
constexpr size_t O_RSP = O_RWP + (size_t)NL * PB * 16 * 64 * 64;
constexpr size_t O_SWKS = O_RSP + (size_t)NL * PB * RWC;
constexpr size_t O_SWVS = O_SWKS + (size_t)NL * SB * 128 * 128;
constexpr size_t O_GLAS = O_SWVS + (size_t)NL * SB * 128 * 128;
constexpr size_t O_RWS = O_GLAS + (size_t)NL * SB * 4 * 128 * 256;
constexpr size_t O_RSS = O_RWS + (size_t)NL * SB * 16 * 64 * 64;
constexpr size_t O_END = O_RSS + (size_t)NL * SB * RWC;
static_assert(O_END == 52881408, "output size");

constexpr size_t al256(size_t x) { return (x + 255) & ~(size_t)255; }
constexpr size_t WS_CTL = 0;
constexpr size_t WS_WIN = 65536;
constexpr size_t WS_WMEM = WS_WIN + (size_t)NL * NINP * DM * 2;
constexpr size_t WS_WBR = WS_WMEM + (size_t)NL * DM * DM * 2;
constexpr size_t WS_WOUT = WS_WBR + (size_t)NL * 4 * DM * BW * 2;
constexpr size_t WS_WGU = WS_WOUT + (size_t)NL * DM * DM * 2;
constexpr size_t WS_WDN = WS_WGU + (size_t)NL * 2 * DFF * DM * 2;
constexpr size_t WS_HF = WS_WDN + (size_t)NL * DM * DFF * 2;
constexpr size_t WS_HB = WS_HF + (size_t)MPAD * DM * 4;
constexpr size_t WS_U = WS_HB + (size_t)MPAD * DM * 2;
constexpr size_t WS_BR = WS_U + (size_t)MPAD * NINP * 2;
constexpr size_t WS_MG = WS_BR + (size_t)4 * MPAD * BW * 2;
constexpr size_t WS_MGB = WS_MG + (size_t)MPAD * DM * 4;
constexpr size_t WS_Y = WS_MGB + (size_t)MPAD * DM * 2;
constexpr size_t WS_X1F = WS_Y + (size_t)MPAD * DM * 4;
constexpr size_t WS_X1B = WS_X1F + (size_t)MPAD * DM * 4;
constexpr size_t WS_ACT = WS_X1B + (size_t)MPAD * DM * 2;
constexpr size_t WS_MEMB = WS_ACT + (size_t)MPAD * DFF * 2;
constexpr size_t WS_MKB = WS_MEMB + (size_t)512 * DM * 2;
constexpr size_t WS_MVT = WS_MKB + (size_t)NL * 512 * 1024 * 2;
constexpr size_t WS_SC = WS_MVT + (size_t)NL * 8 * 256 * 256 * 2;
constexpr size_t WS_PB = WS_SC + (size_t)8 * 4096 * 256 * 4;
constexpr size_t WS_RW = WS_PB + (size_t)8 * 4096 * 256 * 2;
constexpr size_t RW_ARR = (size_t)MPAD * BW * 4;
constexpr int GL_NCH = 512 + 128;
constexpr size_t WS_GLQD = WS_RW + 8 * RW_ARR;
constexpr size_t WS_GLKH = WS_GLQD + (size_t)GL_NCH * 8192 * 2;
constexpr size_t WS_GLE = WS_GLKH + (size_t)GL_NCH * 8192 * 2;
constexpr size_t WS_GLVT = WS_GLE + (size_t)GL_NCH * 4096 * 2;
constexpr size_t WS_GLGC = WS_GLVT + (size_t)GL_NCH * 16384 * 2;
constexpr int RB_NCH = PB * 16 * 256 + SB * 16;
constexpr int RB_EL = 7424;
constexpr int RB_QP = 4096, RB_KHP = 5120, RB_VT = 6144, RB_EP = 7168;
constexpr size_t WS_RB = WS_GLGC + (size_t)GL_NCH * 128 * 4;
constexpr size_t WS_RAW = WS_RB + (size_t)RB_NCH * RB_EL * 2;
constexpr size_t WS_LRW = WS_RAW + (size_t)2 * MPAD * BW * 2;
constexpr size_t WS_END = WS_LRW + (size_t)NL * 16 * 64 * 256 * 2;

__device__ __forceinline__ float bf2f(bf16_t b) { return __uint_as_float(((unsigned)b) << 16); }
typedef __bf16 bf16v2_t __attribute__((ext_vector_type(2)));
__device__ __forceinline__ unsigned pk2(float lo, float hi) { const f32x2 v = {lo, hi}; return __builtin_bit_cast(unsigned, __builtin_convertvector(v, bf16v2_t)); }
__device__ __forceinline__ bf16_t f2bf(float f) { return (bf16_t)(pk2(f, 0.f) & 0xffffu); }
__device__ __forceinline__ f32x4 ld4bf(const bf16_t* p) { const u32x2 w = *(const u32x2*)p; return (f32x4){__uint_as_float(w.x << 16), __uint_as_float(w.x & 0xffff0000u), __uint_as_float(w.y << 16), __uint_as_float(w.y & 0xffff0000u)}; }
__device__ __forceinline__ float wave_sum(float v) {
#pragma unroll
    for (int o = 32; o > 0; o >>= 1) v += __shfl_xor(v, o, 64);
    return v;
}
__device__ __forceinline__ float wave_max(float v) {
#pragma unroll
    for (int o = 32; o > 0; o >>= 1) v = fmaxf(v, __shfl_xor(v, o, 64));
    return v;
}
__device__ __forceinline__ float sigmoidf_(float x) { return __builtin_amdgcn_rcpf(1.0f + __expf(-x)); }
__device__ __forceinline__ void unpack8(const u32x4 w, float (&x)[8]) {
    x[0] = __uint_as_float(w.x << 16); x[1] = __uint_as_float(w.x & 0xffff0000u); x[2] = __uint_as_float(w.y << 16); x[3] = __uint_as_float(w.y & 0xffff0000u);
    x[4] = __uint_as_float(w.z << 16); x[5] = __uint_as_float(w.z & 0xffff0000u); x[6] = __uint_as_float(w.w << 16); x[7] = __uint_as_float(w.w & 0xffff0000u);
}
__device__ __forceinline__ float softplusf_(float x) { return fmaxf(x, 0.f) + log1pf(__expf(-fabsf(x))); }
__device__ __forceinline__ float softplus_fast(float x) { return fmaxf(x, 0.f) + __logf(1.0f + __expf(-fabsf(x))); }
__device__ __forceinline__ float tanh_fast(float x) { return 1.0f - 2.0f * __builtin_amdgcn_rcpf(1.0f + __expf(2.0f * x)); }

namespace pg8 {
constexpr int BM = 256, BK = 64, HALF = 128, HTB = HALF * BK * 2, STAGE_BYTES = 8 * HTB, NXCD = 8, WGM = 8;
__host__ __device__ __forceinline__ int lds_byte(int r, int c) { const int st = (r >> 4) * 2 + (c >> 5), rr = r & 15, cc = c & 31, ob = rr * 64 + cc * 2; return st * 1024 + (ob ^ (((ob >> 9) & 1) << 5)); }
__host__ __device__ __forceinline__ void stage_rc(int b, int& R, int& C) { const int st = b / 1024, sb = b % 1024, swz = sb ^ (((sb >> 9) & 1) << 5); R = (st >> 1) * 16 + swz / 64; C = (st & 1) * 32 + (swz % 64) / 2; }
__host__ __device__ __forceinline__ int perm32(int rho) { const int n = rho >> 4, i = rho & 15; return 8 * (i >> 2) + 4 * n + (i & 3); }

struct Unit { int pm, pn, z; };
template <int LDA_, int LDB_, int K_, int NM_, int NN_, int NZ_ = 1, int NZH_ = 1, bool ZINNER_ = false, long ZSAB_ = 0, long ZSAH_ = 0, long ZSBB_ = 0, long ZSBH_ = 0>
struct Gemm {
    static constexpr int LDA = LDA_, LDB = LDB_, K = K_, NM = NM_, NN = NN_, NZ = NZ_, NZH = NZH_; static constexpr bool ZINNER = ZINNER_;
    const bf16_t* A; const bf16_t* B; int G, c;
    __device__ __forceinline__ bool next(int i, Unit& u) const {
        constexpr int nt = NM * NN; int L, z;
        if (ZINNER) { const int it = i / NZ; z = i - it * NZ; const long LL = (long)it * G + c; if (LL >= nt) return false; L = (int)LL; }
        else { const long LL = (long)i * G + c; if (LL >= (long)nt * NZ) return false; z = (int)(LL / nt); L = (int)(LL - (long)z * nt); }
        int wgid = L; { constexpr int q = nt / NXCD, r = nt % NXCD; const int xcd = wgid % NXCD, off = wgid / NXCD; wgid = (xcd < r ? xcd * (q + 1) : r * (q + 1) + (xcd - r) * q) + off; }
        constexpr int nig = WGM * NN; const int gid = wgid / nig, fm = gid * WGM, gsz = (NM - fm) < WGM ? (NM - fm) : WGM;
        u.pm = fm + ((wgid % nig) % gsz); u.pn = (wgid % nig) / gsz; u.z = z; return true;
    }
    __device__ __forceinline__ const char* a_base(const Unit& u) const { const int zb = u.z / NZH, zh = u.z - zb * NZH; return (const char*)(A + zb * ZSAB_ + zh * ZSAH_ + (long)u.pm * BM * LDA); }
    __device__ __forceinline__ const char* b_base(const Unit& u) const { const int zb = u.z / NZH, zh = u.z - zb * NZH; return (const char*)(B + zb * ZSBB_ + zh * ZSBH_ + (long)u.pn * BM * LDB); }
};

template <class GT, class Epi, bool ALIGN_EPI = true, bool SP2 = true>
__device__ __forceinline__ void gemm_phase(LAS unsigned char* lds, const int tid, const GT& g, const Epi& E) {
    const int wid = __builtin_amdgcn_readfirstlane(tid >> 6), lane = tid & 63, wr = wid >> 2, wc = wid & 3, fr = lane & 15, fq = lane >> 4;
    constexpr int nt = GT::K / BK;
    unsigned voffA[2], voffB[2];
#pragma unroll
    for (int i = 0; i < 2; ++i) { int R, C; stage_rc(tid * 16 + i * 8192, R, C); const int Rb = Epi::PERM ? ((R & ~31) + perm32(R & 31)) : R;
        voffA[i] = (unsigned)(R * GT::LDA + C) * 2u; voffB[i] = (unsigned)(Rb * GT::LDB + C) * 2u; }
    constexpr size_t kstep = (size_t)(BK * 2);
    constexpr size_t hstepA = (size_t)HALF * GT::LDA * 2, hstepB = (size_t)HALF * GT::LDB * 2;
    const unsigned ldsw = (unsigned)wid * 1024u;
    const int aoff = lds_byte(wr * 64 + fr, fq * 8), boff = lds_byte(wc * 32 + fr, fq * 8);
#define PG8_SA(b, h) (((b) * 2 + (h)) * HTB)
#define PG8_SB(b, h) ((4 + (b) * 2 + (h)) * HTB)
#define PG8_STAGE(bufoff, gbase, voff) do { _Pragma("unroll") for (int _i = 0; _i < 2; ++_i) \
        __builtin_amdgcn_global_load_lds((const unsigned*)((const char*)(gbase) + (voff)[_i]), (LAS unsigned*)(lds + (bufoff) + ldsw + _i * 8192), 16, 0, 0); } while (0)
#define PG8_LDA(dst, b, h) do { _Pragma("unroll") for (int m = 0; m < 4; ++m) _Pragma("unroll") for (int k = 0; k < 2; ++k) dst[m][k] = *(const LAS bf16x8*)(lds + PG8_SA(b, h) + aoff + m * 2048 + k * 1024); } while (0)
#define PG8_LDB(dst, b, h) do { _Pragma("unroll") for (int n = 0; n < 2; ++n) _Pragma("unroll") for (int k = 0; k < 2; ++k) dst[n][k] = *(const LAS bf16x8*)(lds + PG8_SB(b, h) + boff + n * 2048 + k * 1024); } while (0)
#define PG8_MMA(ai, bj, At, Bt) do { __builtin_amdgcn_s_setprio(1); _Pragma("unroll") for (int m = 0; m < 4; ++m) _Pragma("unroll") for (int n = 0; n < 2; ++n) _Pragma("unroll") for (int k = 0; k < 2; ++k) \
        acc[ai][bj][m][n] = __builtin_amdgcn_mfma_f32_16x16x32_bf16(Bt[n][k], At[m][k], acc[ai][bj][m][n], 0, 0, 0); __builtin_amdgcn_s_setprio(0); } while (0)
#define PG8_WAIT_V(n) asm volatile("s_waitcnt vmcnt(" #n ")" ::: "memory")
#define PG8_WAIT_L(n) asm volatile("s_waitcnt lgkmcnt(" #n ")" ::: "memory")
#define PG8_BAR __builtin_amdgcn_s_barrier()
#define PG8_SCHED __builtin_amdgcn_sched_barrier(0)
    Unit cur, nxt; int ui = 0;
    if (!g.next(0, cur)) return;
    f32x4 acc[2][2][4][2];
#pragma unroll
    for (int a = 0; a < 2; ++a)
#pragma unroll
        for (int b = 0; b < 2; ++b)
#pragma unroll
            for (int m = 0; m < 4; ++m)
#pragma unroll
                for (int n = 0; n < 2; ++n) acc[a][b][m][n] = (f32x4){0.f, 0.f, 0.f, 0.f};
    bf16x8 At[4][2], B0[2][2], B1[2][2];
    const char* cA = g.a_base(cur); const char* cB = g.b_base(cur);
    if constexpr (SP2) {
        PG8_STAGE(PG8_SB(0, 0), cB, voffB); PG8_STAGE(PG8_SB(0, 1), cB + hstepB, voffB); PG8_STAGE(PG8_SA(0, 0), cA, voffA); PG8_STAGE(PG8_SA(0, 1), cA + hstepA, voffA);
        if (wr == 1) PG8_BAR;
        PG8_WAIT_V(2); PG8_BAR;
        PG8_STAGE(PG8_SB(1, 0), cB + kstep, voffB); PG8_STAGE(PG8_SA(1, 0), cA + kstep, voffA); PG8_STAGE(PG8_SB(1, 1), cB + hstepB + kstep, voffB);
        PG8_WAIT_V(6); PG8_BAR;
    } else {
        PG8_STAGE(PG8_SB(0, 0), cB, voffB); PG8_STAGE(PG8_SA(0, 0), cA, voffA); PG8_STAGE(PG8_SB(0, 1), cB + hstepB, voffB); PG8_STAGE(PG8_SA(0, 1), cA + hstepA, voffA);
        if (wr == 1) PG8_BAR;
        PG8_WAIT_V(4); PG8_BAR;
        PG8_STAGE(PG8_SB(1, 0), cB + kstep, voffB); PG8_STAGE(PG8_SA(1, 0), cA + kstep, voffA); PG8_STAGE(PG8_SB(1, 1), cB + hstepB + kstep, voffB);
        PG8_WAIT_V(6); PG8_BAR;
    }
    for (;;) {
        const bool has_next = g.next(ui + 1, nxt);
        const char* nA = has_next ? g.a_base(nxt) : cA; const char* nB = has_next ? g.b_base(nxt) : cB;
#pragma unroll 1
        for (int t = 0; t < nt; t += 2) {
            const bool last = (t == nt - 2);
            const char* a1 = cA + (size_t)(t + 1) * kstep;
            const char* a2 = last ? nA : cA + (size_t)(t + 2) * kstep; const char* b2 = last ? nB : cB + (size_t)(t + 2) * kstep;
            const char* a3 = a2 + kstep; const char* b3 = b2 + kstep;
            if constexpr (SP2) {
            PG8_LDB(B0, 0, 0); PG8_LDB(B1, 0, 1); PG8_SCHED; PG8_LDA(At, 0, 0); PG8_STAGE(PG8_SA(1, 1), a1 + hstepA, voffA);
            PG8_WAIT_V(8); PG8_WAIT_L(0); PG8_BAR; PG8_MMA(0, 0, At, B0); PG8_MMA(0, 1, At, B1); PG8_BAR; PG8_SCHED;
            PG8_LDA(At, 0, 1); PG8_STAGE(PG8_SB(0, 0), b2, voffB); PG8_STAGE(PG8_SB(0, 1), b2 + hstepB, voffB); PG8_STAGE(PG8_SA(0, 0), a2, voffA);
            PG8_WAIT_V(8); PG8_WAIT_L(0); PG8_BAR; PG8_MMA(1, 0, At, B0); PG8_MMA(1, 1, At, B1); PG8_BAR; PG8_SCHED;
            PG8_LDB(B0, 1, 0); PG8_LDB(B1, 1, 1); PG8_SCHED; PG8_LDA(At, 1, 0); PG8_STAGE(PG8_SA(0, 1), a2 + hstepA, voffA);
            PG8_WAIT_V(8); PG8_WAIT_L(0); PG8_BAR; PG8_MMA(0, 0, At, B0); PG8_MMA(0, 1, At, B1); PG8_BAR; PG8_SCHED;
            PG8_LDA(At, 1, 1); PG8_STAGE(PG8_SB(1, 0), b3, voffB); PG8_STAGE(PG8_SB(1, 1), b3 + hstepB, voffB); PG8_STAGE(PG8_SA(1, 0), a3, voffA);
            PG8_WAIT_V(8); PG8_WAIT_L(0); PG8_BAR; PG8_MMA(1, 0, At, B0); PG8_MMA(1, 1, At, B1); PG8_BAR; PG8_SCHED;
            } else {
            PG8_LDB(B0, 0, 0); PG8_SCHED; PG8_LDA(At, 0, 0); PG8_STAGE(PG8_SA(1, 1), a1 + hstepA, voffA);
            PG8_WAIT_L(8); PG8_BAR; PG8_WAIT_L(0); PG8_MMA(0, 0, At, B0); PG8_BAR; PG8_SCHED;
            PG8_LDB(B1, 0, 1); PG8_STAGE(PG8_SB(0, 0), b2, voffB);
            PG8_BAR; PG8_WAIT_L(0); PG8_MMA(0, 1, At, B1); PG8_BAR;
            PG8_LDA(At, 0, 1); PG8_STAGE(PG8_SA(0, 0), a2, voffA);
            PG8_BAR; PG8_WAIT_L(0); PG8_MMA(1, 0, At, B0); PG8_BAR; PG8_SCHED;
            PG8_STAGE(PG8_SB(0, 1), b2 + hstepB, voffB);
            PG8_WAIT_V(6); PG8_BAR; PG8_MMA(1, 1, At, B1); PG8_BAR;
            PG8_LDB(B0, 1, 0); PG8_SCHED; PG8_LDA(At, 1, 0); PG8_STAGE(PG8_SA(0, 1), a2 + hstepA, voffA);
            PG8_WAIT_L(8); PG8_BAR; PG8_WAIT_L(0); PG8_MMA(0, 0, At, B0); PG8_BAR; PG8_SCHED;
            PG8_LDB(B1, 1, 1); PG8_STAGE(PG8_SB(1, 0), b3, voffB);
            PG8_BAR; PG8_WAIT_L(0); PG8_MMA(0, 1, At, B1); PG8_BAR;
            PG8_LDA(At, 1, 1); PG8_STAGE(PG8_SA(1, 0), a3, voffA);
            PG8_BAR; PG8_WAIT_L(0); PG8_MMA(1, 0, At, B0); PG8_BAR; PG8_SCHED;
            PG8_STAGE(PG8_SB(1, 1), b3 + hstepB, voffB);
            PG8_WAIT_V(6); PG8_BAR; PG8_MMA(1, 1, At, B1); PG8_BAR;
            }
        }
        if constexpr (ALIGN_EPI) { if (wr == 0) PG8_BAR; }
        E(acc, cur, wr, wc, fr, fq);
        if (!has_next) break;
#pragma unroll
        for (int a = 0; a < 2; ++a)
#pragma unroll
            for (int b = 0; b < 2; ++b)
#pragma unroll
                for (int m = 0; m < 4; ++m)
#pragma unroll
                    for (int n = 0; n < 2; ++n) acc[a][b][m][n] = (f32x4){0.f, 0.f, 0.f, 0.f};
        cur = nxt; cA = nA; cB = nB; ++ui;
        if constexpr (ALIGN_EPI) { if (wr == 1) PG8_BAR; }
    }
    PG8_WAIT_V(0);
    if constexpr (!ALIGN_EPI) { if (wr == 0) PG8_BAR; }
    PG8_BAR;
#undef PG8_SA
#undef PG8_SB
#undef PG8_STAGE
#undef PG8_LDA
#undef PG8_LDB
#undef PG8_MMA
#undef PG8_WAIT_V
#undef PG8_WAIT_L
#undef PG8_BAR
#undef PG8_SCHED
}

struct EpiBf16 {
    static constexpr bool PERM = true;
    bf16_t* O; long zs; int ldc, pad;
    __device__ __forceinline__ void operator()(const f32x4 (&acc)[2][2][4][2], const Unit& u, int wr, int wc, int fr, int fq) const {
        const int row0 = u.pm * BM + wr * 64 + fr, col0 = u.pn * BM + wc * 32 + 8 * fq; bf16_t* base = O + (long)u.z * zs;
#pragma unroll
        for (int ai = 0; ai < 2; ++ai)
#pragma unroll
            for (int m = 0; m < 4; ++m) { bf16_t* rowp = base + (size_t)(row0 + ai * HALF + m * 16) * ldc + col0;
#pragma unroll
                for (int bj = 0; bj < 2; ++bj) { const f32x4 v0 = acc[ai][bj][m][0], v1 = acc[ai][bj][m][1];
                    u32x4 w; w.x = pk2(v0[0], v0[1]); w.y = pk2(v0[2], v0[3]); w.z = pk2(v1[0], v1[1]); w.w = pk2(v1[2], v1[3]);
                    *(u32x4*)(rowp + bj * HALF) = w; } }
    }
};
struct EpiMem {
    static constexpr bool PERM = false;
    float* outK; float* outV; bf16_t* kb; bf16_t* vt;
    __device__ __forceinline__ void operator()(const f32x4 (&acc)[2][2][4][2], const Unit& u, int wr, int wc, int fr, int fq) const {
        const int row0 = u.pm * BM + wr * 64 + fr, col0 = u.pn * BM + wc * 32 + 4 * fq;
#pragma unroll
        for (int ai = 0; ai < 2; ++ai)
#pragma unroll
            for (int m = 0; m < 4; ++m) { const int row = row0 + ai * HALF + m * 16;
#pragma unroll
                for (int bj = 0; bj < 2; ++bj)
#pragma unroll
                    for (int n = 0; n < 2; ++n) { const int col = col0 + bj * HALF + n * 16; const f32x4 v = acc[ai][bj][m][n];
                        if (col < 1024) { *(f32x4*)(outK + ((size_t)u.z * 512 + row) * 1024 + col) = v;
                            u32x2 w; w.x = pk2(v[0], v[1]); w.y = pk2(v[2], v[3]); *(u32x2*)(kb + ((size_t)u.z * 512 + row) * 1024 + col) = w; }
                        else { const int c = col - 1024; *(f32x4*)(outV + ((size_t)u.z * 512 + row) * 1024 + c) = v;
                            const int b = row >> 8, mm = row & 255, h = c >> 8, d = c & 255; bf16_t* p = vt + ((((size_t)u.z * 2 + b) * 4 + h) * 256 + d) * 256 + mm;
                            p[0] = f2bf(v[0]); p[256] = f2bf(v[1]); p[512] = f2bf(v[2]); p[768] = f2bf(v[3]); } } }
    }
};
struct EpiMerge {
    static constexpr bool PERM = true;
    float* MG; bf16_t* MGB; const bf16_t* U; const float* gate_b;
    __device__ __forceinline__ void operator()(const f32x4 (&acc)[2][2][4][2], const Unit& u, int wr, int wc, int fr, int fq) const {
        const int row0 = u.pm * BM + wr * 64 + fr, col0 = u.pn * BM + wc * 32 + 8 * fq;
#pragma unroll
        for (int bj = 0; bj < 2; ++bj) { const int col = col0 + bj * HALF; const f32x4 gb0 = *(const f32x4*)(gate_b + u.z * DM + col), gb1 = *(const f32x4*)(gate_b + u.z * DM + col + 4);
#pragma unroll
            for (int ai = 0; ai < 2; ++ai)
#pragma unroll
                for (int m = 0; m < 4; ++m) { const int row = row0 + ai * HALF + m * 16; float gp[8], r[8];
                    unpack8(*(const u32x4*)(U + (size_t)row * NINP + U_GP + u.z * DM + col), gp);
#pragma unroll
                    for (int j = 0; j < 4; ++j) { r[j] = sigmoidf_(gp[j] + gb0[j]) * acc[ai][bj][m][0][j]; r[4 + j] = sigmoidf_(gp[4 + j] + gb1[j]) * acc[ai][bj][m][1][j]; }
                    bf16_t* mp = MGB + (size_t)row * DM + col;
                    if (u.z > 0) { float pv[8]; unpack8(*(const u32x4*)mp, pv);
#pragma unroll
                        for (int j = 0; j < 8; ++j) r[j] += pv[j]; }
                    *(u32x4*)mp = (u32x4){pk2(r[0], r[1]), pk2(r[2], r[3]), pk2(r[4], r[5]), pk2(r[6], r[7])}; } }
    }
};
struct EpiRes {
    static constexpr bool PERM = true;
    const bf16_t* R; bf16_t* Y;
    __device__ __forceinline__ void operator()(const f32x4 (&acc)[2][2][4][2], const Unit& u, int wr, int wc, int fr, int fq) const {
        const int row0 = u.pm * BM + wr * 64 + fr, col0 = u.pn * BM + wc * 32 + 8 * fq;
#pragma unroll
        for (int ai = 0; ai < 2; ++ai)
#pragma unroll
            for (int m = 0; m < 4; ++m) { const size_t ro = (size_t)(row0 + ai * HALF + m * 16) * DM + col0;
#pragma unroll
                for (int bj = 0; bj < 2; ++bj) { const size_t o = ro + bj * HALF; float rv[8]; unpack8(*(const u32x4*)(R + o), rv);
                    const f32x4 y0 = (f32x4){rv[0], rv[1], rv[2], rv[3]} * ALPHA + acc[ai][bj][m][0], y1 = (f32x4){rv[4], rv[5], rv[6], rv[7]} * ALPHA + acc[ai][bj][m][1];
                    *(u32x4*)(Y + o) = (u32x4){pk2(y0[0], y0[1]), pk2(y0[2], y0[3]), pk2(y1[0], y1[1]), pk2(y1[2], y1[3])}; } }
    }
};
struct EpiSwiGLU {
    static constexpr bool PERM = true;
    bf16_t* O;
    __device__ __forceinline__ void operator()(const f32x4 (&acc)[2][2][4][2], const Unit& u, int wr, int wc, int fr, int fq) const {
        const int row0 = u.pm * BM + wr * 64 + fr, col0 = u.pn * HALF + wc * 32 + 8 * fq;
#pragma unroll
        for (int ai = 0; ai < 2; ++ai)
#pragma unroll
            for (int m = 0; m < 4; ++m) { bf16_t* rowp = O + (size_t)(row0 + ai * HALF + m * 16) * DFF + col0;
                float r[8];
#pragma unroll
                for (int n = 0; n < 2; ++n)
#pragma unroll
                    for (int j = 0; j < 4; ++j) { const float gg = acc[ai][0][m][n][j], uu = acc[ai][1][m][n][j]; r[n * 4 + j] = gg * sigmoidf_(gg) * uu; }
                u32x4 w; w.x = pk2(r[0], r[1]); w.y = pk2(r[2], r[3]); w.z = pk2(r[4], r[5]); w.w = pk2(r[6], r[7]);
                *(u32x4*)rowp = w; }
    }
};
struct EpiScore {
    static constexpr bool PERM = false;
    float* SC;
    __device__ __forceinline__ void operator()(const f32x4 (&acc)[2][2][4][2], const Unit& u, int wr, int wc, int fr, int fq) const {
        const int row0 = u.pm * BM + wr * 64 + fr, col0 = wc * 32 + 4 * fq; float* base = SC + (size_t)u.z * 4096 * 256;
#pragma unroll
        for (int ai = 0; ai < 2; ++ai)
#pragma unroll
            for (int m = 0; m < 4; ++m) { float* rowp = base + (size_t)(row0 + ai * HALF + m * 16) * 256 + col0;
#pragma unroll
                for (int bj = 0; bj < 2; ++bj)
#pragma unroll
                    for (int n = 0; n < 2; ++n) *(f32x4*)(rowp + bj * HALF + n * 16) = acc[ai][bj][m][n] * 0.0625f; }
    }
};
struct EpiPV {
    static constexpr bool PERM = true;
    bf16_t* O;
    __device__ __forceinline__ void operator()(const f32x4 (&acc)[2][2][4][2], const Unit& u, int wr, int wc, int fr, int fq) const {
        const int b = u.z >> 2, h = u.z & 3; const int row0 = b * PS + u.pm * BM + wr * 64 + fr, col0 = h * 256 + wc * 32 + 8 * fq;
#pragma unroll
        for (int ai = 0; ai < 2; ++ai)
#pragma unroll
            for (int m = 0; m < 4; ++m) { bf16_t* rowp = O + (size_t)(row0 + ai * HALF + m * 16) * BW + col0;
#pragma unroll
                for (int bj = 0; bj < 2; ++bj) { const f32x4 v0 = acc[ai][bj][m][0], v1 = acc[ai][bj][m][1];
                    u32x4 w; w.x = pk2(v0[0], v0[1]); w.y = pk2(v0[2], v0[3]); w.z = pk2(v1[0], v1[1]); w.w = pk2(v1[2], v1[3]);
                    *(u32x4*)(rowp + bj * HALF) = w; } }
    }
};
}


#define XB_TMO      128
#define XB_XCNT(j)  (256  + 64 * (j))
#define XB_XSUB(j)  (1280 + 64 * (j))
#define XB_XGEN(j)  (2304 + 64 * (j))
#define XB_TOP      3328
#define XB_TOPGEN   3392
#define XCD_BAR_WORDS 3456
#define XB_SPIN_CAP (1u << 18)
__device__ __forceinline__ unsigned xb_ld(unsigned* p)              { return __hip_atomic_load(p, __ATOMIC_RELAXED, __HIP_MEMORY_SCOPE_AGENT); }
__device__ __forceinline__ unsigned xb_add(unsigned* p, unsigned v) { return __hip_atomic_fetch_add(p, v, __ATOMIC_RELAXED, __HIP_MEMORY_SCOPE_AGENT); }
__device__ __forceinline__ unsigned xb_xcc_id() { return (unsigned)__builtin_amdgcn_s_getreg((3 << 11) | 20) & 0xFu; }
#define XB_SPIN(cond, bar) do { unsigned _sp = 0; while (cond) { __builtin_amdgcn_s_sleep(1); \
    if ((++_sp & 255u) == 0u) { if (xb_ld(&(bar)[XB_TMO])) break; if (_sp > XB_SPIN_CAP) { atomicAdd(&(bar)[XB_TMO], 1u); break; } } } } while (0)
struct XcdBarrier { unsigned* bar; unsigned x; volatile LAS unsigned* st; };
__device__ __forceinline__ XcdBarrier xcd_barrier_post(unsigned* bar, volatile LAS unsigned* st) {
    XcdBarrier b; b.bar = bar; b.x = xb_xcc_id(); b.st = st;
    if (threadIdx.x == 0) (void)xb_add(&bar[XB_XCNT(b.x)], 1u);
    return b;
}
__device__ __forceinline__ void xcd_barrier_complete(unsigned* bar, unsigned x, unsigned& nloc, unsigned& nx) {
    const unsigned G = gridDim.x * gridDim.y * gridDim.z;
    unsigned sum, cnt, mine, sp = 0u;
    for (;;) {
        sum = 0u; cnt = 0u; mine = 0u;
#pragma unroll
        for (unsigned j = 0; j < 16; ++j) { const unsigned c = xb_ld(&bar[XB_XCNT(j)]); sum += c; cnt += (c > 0u) ? 1u : 0u; mine = (j == x) ? c : mine; }
        if (sum == G) break;
        __builtin_amdgcn_s_sleep(1);
        if ((++sp & 255u) == 0u) { if (xb_ld(&bar[XB_TMO])) break; if (sp > XB_SPIN_CAP) { atomicAdd(&bar[XB_TMO], 1u); break; } }
    }
    nloc = mine > 0u ? mine : 1u; nx = cnt > 0u ? cnt : 1u;
}
__device__ __forceinline__ void xcd_barrier(const XcdBarrier& b, const bool thread0) {
    asm volatile("s_waitcnt vmcnt(0)" ::: "memory");
    __syncthreads();
    if (thread0) {
        unsigned* bar = b.bar;
        __builtin_amdgcn_s_waitcnt(0);
        unsigned nloc = b.st[0], nx = b.st[1];
        if (nloc == 0u) { xcd_barrier_complete(bar, b.x, nloc, nx); b.st[0] = nloc; b.st[1] = nx; }
        const unsigned old = xb_add(&bar[XB_XSUB(b.x)], 1u);
        const unsigned gen = old / nloc;
        if (old + 1u == (gen + 1u) * nloc) {
            __builtin_amdgcn_fence(__ATOMIC_RELEASE, "agent");
            asm volatile("s_waitcnt vmcnt(0)" ::: "memory");
            const unsigned og = xb_add(&bar[XB_TOP], 1u);
            const unsigned tg = og / nx;
            if (og + 1u == (tg + 1u) * nx) xb_add(&bar[XB_TOPGEN], 1u);
            else XB_SPIN(xb_ld(&bar[XB_TOPGEN]) == tg, bar);
            __builtin_amdgcn_fence(__ATOMIC_ACQUIRE, "agent");
            xb_add(&bar[XB_XGEN(b.x)], 1u);
            asm volatile("s_waitcnt vmcnt(0)" ::: "memory");
        } else {
            XB_SPIN(xb_ld(&bar[XB_XGEN(b.x)]) == gen, bar);
            __builtin_amdgcn_fence(__ATOMIC_ACQUIRE, "agent");
            asm volatile("s_waitcnt vmcnt(0)" ::: "memory");
        }
    }
    __syncthreads();
}

struct Ctx { int tid, lane, wave, bid, G; LAS unsigned char* lds; };
__device__ __forceinline__ Ctx fresh(const Ctx& c0) { Ctx c; c.wave = c0.wave; c.bid = c0.bid; c.G = c0.G; c.lds = c0.lds; asm volatile("" : "+s"(c.bid), "+s"(c.G), "+s"(c.wave));
    int lane; asm volatile("v_mbcnt_lo_u32_b32 %0, -1, 0\n\tv_mbcnt_hi_u32_b32 %0, -1, %0" : "=v"(lane)); c.lane = lane; c.tid = c.wave * 64 + lane; return c; }

__device__ __forceinline__ int colmap(int mode, int n) {
    if (mode == 1) return n < 3088 ? n : (n < 3328 ? -1 : n - 240);
    if (mode == 2) { const int t = n >> 8, j = n & 255; return j < 128 ? t * 128 + j : DFF + t * 128 + (j - 128); }
    return n;
}
__device__ __forceinline__ void wprep_load(f32x4 (&rg)[8], const float* __restrict__ src, int K, int Nsrc, int Ndst, int mode, size_t sbs, int item, int tid) {
    const int nx = Ndst / 256, ny = K / 64; const int bx = item % nx, by = (item / nx) % ny, bz = item / (nx * ny);
    const int tx = tid & 63, ty = tid >> 6, cm = colmap(mode, bx * 256 + tx * 4); const float* s = src + (size_t)bz * sbs + (size_t)(by * 64 + ty) * Nsrc + cm;
#pragma unroll
    for (int i = 0; i < 8; ++i) rg[i] = cm >= 0 ? *(const f32x4*)(s + (size_t)(8 * i) * Nsrc) : (f32x4){0.f, 0.f, 0.f, 0.f};
}
__device__ __forceinline__ void ph_wprep(const Ctx& c, const float* __restrict__ src, bf16_t* __restrict__ dst, int K, int Nsrc, int Ndst, int mode, int nbatch, size_t sbs, size_t dbs) {
    LAS float* tile = (LAS float*)c.lds;
    const int nx = Ndst / 256, ny = K / 64, total = nx * ny * nbatch;
    const int tid = c.tid, tx = tid & 63, ty = tid >> 6, n = tid >> 1, kh = tid & 1;
    f32x4 rg[8];
    int item = c.bid;
    if (item < total) wprep_load(rg, src, K, Nsrc, Ndst, mode, sbs, item, tid);
    for (; item < total; item += c.G) {
        __syncthreads();
#pragma unroll
        for (int i = 0; i < 8; ++i) *(LAS f32x4*)(tile + (ty + 8 * i) * 260 + tx * 4) = rg[i];
        __syncthreads();
        const int bx = item % nx, by = (item / nx) % ny, bz = item / (nx * ny);
        if (item + c.G < total) wprep_load(rg, src, K, Nsrc, Ndst, mode, sbs, item + c.G, tid);
        bf16_t* d = dst + (size_t)bz * dbs + (size_t)(bx * 256 + n) * K + by * 64 + kh * 32;
#pragma unroll
        for (int g = 0; g < 4; ++g) { unsigned p[4];
#pragma unroll
            for (int e = 0; e < 4; ++e) p[e] = pk2(tile[(kh * 32 + g * 8 + 2 * e) * 260 + n], tile[(kh * 32 + g * 8 + 2 * e + 1) * 260 + n]);
            *(u32x4*)(d + g * 8) = (u32x4){p[0], p[1], p[2], p[3]}; }
    }
    __syncthreads();
}
constexpr int WD_CH = 4, WD_N0 = (NINP / 256) * (DM / 64), WD_N1 = 4 * (DM / 256) * (BW / 64), WD_N2 = (DM / 256) * (DM / 64), WD_N3 = (2 * DFF / 256) * (DM / 64), WD_N4 = (DM / 256) * (DFF / 64);
constexpr int WD_TOTAL = WD_N0 + WD_N1 + WD_N2 + WD_N3 + WD_N4;
struct WDesc { const float* src; bf16_t* dst; int K, Nsrc, Ndst, mode, item; size_t sbs, dbs; };
__device__ __forceinline__ WDesc wd_decode(int it, const float* s0, const float* s1, const float* s2, const float* s3, const float* s4, bf16_t* d0, bf16_t* d1, bf16_t* d2, bf16_t* d3, bf16_t* d4) {
    WDesc d;
    if (it < WD_N0) { d.src = s0; d.dst = d0; d.K = DM; d.Nsrc = NIN; d.Ndst = NINP; d.mode = 1; d.item = it; d.sbs = 0; d.dbs = 0; }
    else if (it < WD_N0 + WD_N1) { d.src = s1; d.dst = d1; d.K = BW; d.Nsrc = DM; d.Ndst = DM; d.mode = 0; d.item = it - WD_N0; d.sbs = (size_t)BW * DM; d.dbs = (size_t)DM * BW; }
    else if (it < WD_N0 + WD_N1 + WD_N2) { d.src = s2; d.dst = d2; d.K = DM; d.Nsrc = DM; d.Ndst = DM; d.mode = 0; d.item = it - WD_N0 - WD_N1; d.sbs = 0; d.dbs = 0; }
    else if (it < WD_N0 + WD_N1 + WD_N2 + WD_N3) { d.src = s3; d.dst = d3; d.K = DM; d.Nsrc = 2 * DFF; d.Ndst = 2 * DFF; d.mode = 2; d.item = it - WD_N0 - WD_N1 - WD_N2; d.sbs = 0; d.dbs = 0; }
    else { d.src = s4; d.dst = d4; d.K = DFF; d.Nsrc = DM; d.Ndst = DM; d.mode = 0; d.item = it - WD_N0 - WD_N1 - WD_N2 - WD_N3; d.sbs = 0; d.dbs = 0; }
    return d;
}
__device__ __forceinline__ void ph_wprep_dyn(const Ctx& c, unsigned* ctr, const float* s0, const float* s1, const float* s2, const float* s3, const float* s4, bf16_t* d0, bf16_t* d1, bf16_t* d2, bf16_t* d3, bf16_t* d4) {
    LAS float* tile = (LAS float*)c.lds;
    LAS int* slot = (LAS int*)(c.lds + 64 * 260 * 4 + 64);
    const int tid = c.tid, n = tid >> 1, kh = tid & 1, tx = tid & 63, ty = tid >> 6;
    __syncthreads();
    if (tid == 0) slot[0] = (int)__hip_atomic_fetch_add(ctr, 1u, __ATOMIC_RELAXED, __HIP_MEMORY_SCOPE_AGENT);
    __syncthreads();
    int it = slot[0] * WD_CH, pos = 0; unsigned nxt_chunk = 0u;
    f32x4 rg[8];
    if (it < WD_TOTAL) { const WDesc d = wd_decode(it, s0, s1, s2, s3, s4, d0, d1, d2, d3, d4); wprep_load(rg, d.src, d.K, d.Nsrc, d.Ndst, d.mode, d.sbs, d.item, tid); }
    while (it < WD_TOTAL) {
        __syncthreads();
        if (tid == 0) { if (pos == 0) nxt_chunk = __hip_atomic_fetch_add(ctr, 1u, __ATOMIC_RELAXED, __HIP_MEMORY_SCOPE_AGENT); else if (pos == 1) slot[1] = (int)nxt_chunk; }
#pragma unroll
        for (int i = 0; i < 8; ++i) *(LAS f32x4*)(tile + (ty + 8 * i) * 260 + tx * 4) = rg[i];
        __syncthreads();
        const WDesc d = wd_decode(it, s0, s1, s2, s3, s4, d0, d1, d2, d3, d4);
        int nit, npos;
        if (pos + 1 < WD_CH) { nit = it + 1; npos = pos + 1; } else { nit = slot[1] * WD_CH; npos = 0; }
        if (nit < WD_TOTAL) { const WDesc dn = wd_decode(nit, s0, s1, s2, s3, s4, d0, d1, d2, d3, d4); wprep_load(rg, dn.src, dn.K, dn.Nsrc, dn.Ndst, dn.mode, dn.sbs, dn.item, tid); }
        { const int nx = d.Ndst / 256, ny = d.K / 64; const int bx = d.item % nx, by = (d.item / nx) % ny, bz = d.item / (nx * ny);
          bf16_t* dp = d.dst + (size_t)bz * d.dbs + (size_t)(bx * 256 + n) * d.K + by * 64 + kh * 32;
#pragma unroll
          for (int g = 0; g < 4; ++g) { unsigned p[4];
#pragma unroll
              for (int e = 0; e < 4; ++e) p[e] = pk2(tile[(kh * 32 + g * 8 + 2 * e) * 260 + n], tile[(kh * 32 + g * 8 + 2 * e + 1) * 260 + n]);
              *(u32x4*)(dp + g * 8) = (u32x4){p[0], p[1], p[2], p[3]}; } }
        it = nit; pos = npos;
    }
    __syncthreads();
}
__device__ __forceinline__ void ph_xprep(const Ctx& c, const float* __restrict__ xp, const float* __restrict__ xs, const float* __restrict__ mem, float* __restrict__ HF, bf16_t* __restrict__ HB, bf16_t* __restrict__ MEMB) {
    const size_t nH = (size_t)MPAD * DM / 4, nM = (size_t)512 * DM / 4;
    for (size_t i4 = (size_t)c.bid * 512 + c.tid; i4 < nH + nM; i4 += (size_t)c.G * 512) {
        if (i4 < nH) {
            const size_t e = i4 * 4; f32x4 v = (f32x4){0.f, 0.f, 0.f, 0.f};
            if (e < (size_t)MP * DM) v = *(const f32x4*)(xp + e); else if (e < (size_t)MT * DM) v = *(const f32x4*)(xs + (e - (size_t)MP * DM));
            if (HF != nullptr) *(f32x4*)(HF + e) = v;
            u32x2 w; w.x = pk2(v[0], v[1]); w.y = pk2(v[2], v[3]); *(u32x2*)(HB + e) = w;
        } else {
            const size_t e = (i4 - nH) * 4; const f32x4 v = *(const f32x4*)(mem + e); u32x2 w; w.x = pk2(v[0], v[1]); w.y = pk2(v[2], v[3]); *(u32x2*)(MEMB + e) = w;
        }
    }
}
__device__ __forceinline__ void ph_ln(const Ctx& c, const bf16_t* __restrict__ Y, const float* __restrict__ g, const float* __restrict__ b, float* __restrict__ XF, bf16_t* __restrict__ XB, float* __restrict__ OUT, int nrows, int nout) {
    const int lane = c.lane;
    for (int row = c.bid * 8 + c.wave; row < nrows; row += c.G * 8) {
        const bf16_t* y = Y + (size_t)row * DM; float v[4][8]; float s = 0.f;
#pragma unroll
        for (int j = 0; j < 4; ++j) { unpack8(*(const u32x4*)(y + j * 512 + lane * 8), v[j]);
#pragma unroll
            for (int e2 = 0; e2 < 8; ++e2) s += v[j][e2]; }
        const float mean = wave_sum(s) * (1.0f / DM); float q = 0.f;
#pragma unroll
        for (int j = 0; j < 4; ++j)
#pragma unroll
            for (int e2 = 0; e2 < 8; ++e2) { const float d = v[j][e2] - mean; q += d * d; }
        const float rstd = rsqrtf(wave_sum(q) * (1.0f / DM) + 1e-5f);
#pragma unroll
        for (int j = 0; j < 4; ++j) { const int cc = j * 512 + lane * 8; const f32x4 g0 = *(const f32x4*)(g + cc), g1 = *(const f32x4*)(g + cc + 4), b0 = *(const f32x4*)(b + cc), b1 = *(const f32x4*)(b + cc + 4);
            const f32x4 o0 = ((f32x4){v[j][0], v[j][1], v[j][2], v[j][3]} - mean) * rstd * g0 + b0, o1 = ((f32x4){v[j][4], v[j][5], v[j][6], v[j][7]} - mean) * rstd * g1 + b1;
            const size_t off = (size_t)row * DM + cc;
            if (XF != nullptr) { *(f32x4*)(XF + off) = o0; *(f32x4*)(XF + off + 4) = o1; }
            *(u32x4*)(XB + off) = (u32x4){pk2(o0[0], o0[1]), pk2(o0[2], o0[3]), pk2(o1[0], o1[1]), pk2(o1[2], o1[3])};
            if (OUT != nullptr && row < nout) { *(f32x4*)(OUT + off) = o0; *(f32x4*)(OUT + off + 4) = o1; } }
    }
}
__device__ __forceinline__ void ph_softmax256(const Ctx& c, const float* __restrict__ SC, bf16_t* __restrict__ P, int nrows) {
    const int lane = c.lane;
    for (int row = c.bid * 8 + c.wave; row < nrows; row += c.G * 8) {
        const f32x4 v = *(const f32x4*)(SC + (size_t)row * 256 + lane * 4);
        const float mx = wave_max(fmaxf(fmaxf(v[0], v[1]), fmaxf(v[2], v[3])));
        f32x4 e; e[0] = __expf(v[0] - mx); e[1] = __expf(v[1] - mx); e[2] = __expf(v[2] - mx); e[3] = __expf(v[3] - mx);
        const float inv = 1.0f / wave_sum((e[0] + e[1]) + (e[2] + e[3]));
        u32x2 w; w.x = pk2(e[0] * inv, e[1] * inv); w.y = pk2(e[2] * inv, e[3] * inv); *(u32x2*)(P + (size_t)row * 256 + lane * 4) = w;
    }
}
__device__ __forceinline__ void ph_copy_outs(const Ctx& c, const bf16_t* __restrict__ U, const float* __restrict__ ck, const float* __restrict__ cv, float* __restrict__ out, int layer) {
    constexpr int nA = PB * 128 * 128, nB = SB * 128 * 128, nC = PB * RWC, nD = SB * RWC;
    for (int i = c.bid * 512 + c.tid; i < nA + nB + nC + nD; i += c.G * 512) {
        if (i < nA) { const int b = i / 16384, j = (i >> 7) & 127, cc = i & 127; const size_t ur = (size_t)(b * PS + PS - 128 + j) * NINP;
            out[O_SWKP + (size_t)layer * nA + i] = bf2f(U[ur + U_SK + cc]); out[O_SWVP + (size_t)layer * nA + i] = bf2f(U[ur + U_SV + cc]); continue; }
        int k = i - nA;
        if (k < nB) { const int sq = k / 16384, j = (k >> 7) & 127, cc = k & 127; float kv, vv;
            if (j < 124) { const size_t o = ((size_t)sq * 128 + j + 4) * 128 + cc; kv = ck[o]; vv = cv[o]; }
            else { const size_t ur = (size_t)(MP + sq * SS + j - 124) * NINP; kv = bf2f(U[ur + U_SK + cc]); vv = bf2f(U[ur + U_SV + cc]); }
            out[O_SWKS + (size_t)layer * nB + k] = kv; out[O_SWVS + (size_t)layer * nB + k] = vv; continue; }
        k -= nB;
        if (k < nC) { const int b = k / RWC, cc = k - b * RWC; out[O_RSP + (size_t)layer * nC + k] = bf2f(U[(size_t)(b * PS + PS - 1) * NINP + U_RU + cc]); continue; }
        k -= nC;
        { const int sq = k / RWC, cc = k - sq * RWC; out[O_RSS + (size_t)layer * nD + k] = bf2f(U[(size_t)(MP + sq * SS + SS - 1) * NINP + U_RU + cc]); }
    }
}

__device__ __forceinline__ void seq_info(int sq, int& row0, int& L) { if (sq < PB) { row0 = sq * PS; L = PS; } else { row0 = MP + (sq - PB) * SS; L = SS; } }

__device__ __forceinline__ void ph_gla_naive(const Ctx& c, const bf16_t* __restrict__ U, const float* __restrict__ s0, const float* __restrict__ a_up, const float* __restrict__ a_b,
                                             const float* __restrict__ ng, const float* __restrict__ nb, bf16_t* __restrict__ OB, float* __restrict__ outP, float* __restrict__ outS) {
    LAS float* qs = (LAS float*)c.lds;
    LAS float* ks = qs + 16 * 128; LAS float* as = ks + 16 * 128; LAS float* os = as + 16 * 128;
    const int kh = c.tid >> 8, vt = c.tid & 255, lane = c.lane;
    for (int u = c.bid; u < (PB + SB) * 4; u += c.G) {
        const int sq = u >> 2, h = u & 3;
        int row0, L; seq_info(sq, row0, L);
        float S[64];
        if (sq >= PB) { const float* p = s0 + (((size_t)(sq - PB) * 4 + h) * 128 + kh * 64) * 256 + vt;
#pragma unroll
            for (int kk = 0; kk < 64; ++kk) S[kk] = p[(size_t)kk * 256]; }
        else {
#pragma unroll
            for (int kk = 0; kk < 64; ++kk) S[kk] = 0.f; }
        for (int t0 = 0; t0 < L; t0 += 16) {
            const int nT = (L - t0) < 16 ? (L - t0) : 16;
            for (int idx = c.tid; idx < nT * 128; idx += 512) {
                const int tt = idx >> 7, kk = idx & 127; const bf16_t* ur = U + (size_t)(row0 + t0 + tt) * NINP;
                qs[idx] = bf2f(ur[U_GQ + h * 128 + kk]) * 0.08838834764831845f; ks[idx] = bf2f(ur[U_GK + h * 128 + kk]);
                float x = a_b[h * 128 + kk];
#pragma unroll
                for (int r = 0; r < 16; ++r) x += bf2f(ur[U_GA + r]) * a_up[r * 512 + h * 128 + kk];
                const float ls = (fminf(x, 0.f) - log1pf(__expf(-fabsf(x)))) * (1.0f / 16.0f);
                as[idx] = __expf(ls);
            }
            __syncthreads();
            for (int tt = 0; tt < nT; ++tt) {
                const float v = bf2f(U[(size_t)(row0 + t0 + tt) * NINP + U_GV + h * 256 + vt]); float o = 0.f; const int lb = tt * 128 + kh * 64;
#pragma unroll
                for (int kk = 0; kk < 64; ++kk) { S[kk] = as[lb + kk] * S[kk] + ks[lb + kk] * v; o += qs[lb + kk] * S[kk]; }
                os[(kh * 16 + tt) * 256 + vt] = o;
            }
            __syncthreads();
            for (int tt = c.wave; tt < nT; tt += 8) {
                float x[4]; float s = 0.f;
#pragma unroll
                for (int j = 0; j < 4; ++j) { x[j] = os[tt * 256 + lane + 64 * j] + os[(16 + tt) * 256 + lane + 64 * j]; s += x[j]; }
                const float mean = wave_sum(s) * (1.0f / 256.0f); float q = 0.f;
#pragma unroll
                for (int j = 0; j < 4; ++j) { const float d = x[j] - mean; q += d * d; }
                const float rstd = rsqrtf(wave_sum(q) * (1.0f / 256.0f) + 1e-5f);
                const size_t row = (size_t)(row0 + t0 + tt);
#pragma unroll
                for (int j = 0; j < 4; ++j) { const int cc = h * 256 + lane + 64 * j; const float n = (x[j] - mean) * rstd * ng[cc] + nb[cc];
                    const float gr = bf2f(U[row * NINP + U_GR + cc]); OB[row * BW + cc] = f2bf(n * gr * sigmoidf_(gr)); }
            }
            __syncthreads();
        }
        float* op = (sq < PB ? outP + (((size_t)sq * 4 + h) * 128 + kh * 64) * 256 : outS + (((size_t)(sq - PB) * 4 + h) * 128 + kh * 64) * 256) + vt;
#pragma unroll
        for (int kk = 0; kk < 64; ++kk) op[(size_t)kk * 256] = S[kk];
    }
}

__device__ __forceinline__ f32x4 mma16(bf16x8 x, bf16x8 y, f32x4 c) { return __builtin_amdgcn_mfma_f32_16x16x32_bf16(x, y, c, 0, 0, 0); }
__device__ __forceinline__ bf16x8 pack_acc(const f32x4& a, const f32x4& b) {
    u32x4 p; p.x = pk2(a[0], a[1]); p.y = pk2(a[2], a[3]); p.z = pk2(b[0], b[1]); p.w = pk2(b[2], b[3]); return __builtin_bit_cast(bf16x8, p);
}
__device__ __forceinline__ void gla_chunk_info(int u, int& row0, int& ntok, int& h) {
    if (u < 512) { const int b = u >> 8; h = (u >> 6) & 3; row0 = b * PS + (u & 63) * 64; ntok = 64; }
    else { const int s = u - 512; h = s & 3; row0 = MP + (s >> 2) * SS; ntok = SS; }
}
__device__ __forceinline__ void ph_gla_pre(const Ctx& c, const bf16_t* __restrict__ U, const float* __restrict__ a_up, const float* __restrict__ a_b,
                                           bf16_t* __restrict__ QD, bf16_t* __restrict__ KHT, bf16_t* __restrict__ EE, bf16_t* __restrict__ VT, float* __restrict__ GC) {
    LAS float* ga_l = (LAS float*)c.lds;
    LAS float* tot = ga_l + 64 * 16;
    LAS bf16_t* Qd_l = (LAS bf16_t*)(tot + 4 * 128);
    LAS bf16_t* Kn_l = Qd_l + 64 * 136;
    LAS bf16_t* v_l = Kn_l + 64 * 136;
    LAS bf16_t* qr_l = v_l + 64 * 264;
    LAS bf16_t* kr_l = qr_l + 64 * 136;
    const int tid = c.tid, lane = c.lane, r = lane & 15, q = lane >> 4, w = c.wave;
    for (int u = (c.bid + c.G / 2) % c.G; u < GL_NCH; u += c.G) {
        int row0, ntok, h; gla_chunk_info(u, row0, ntok, h);
        for (int i = tid; i < 64 * 16; i += 512) { const int t = i >> 4, rr = i & 15; ga_l[i] = t < ntok ? bf2f(U[(size_t)(row0 + t) * NINP + U_GA + rr]) : 0.f; }
        for (int i = tid; i < 64 * 32; i += 512) { const int t = i >> 5, c8 = i & 31; u32x4 vv = (u32x4){0u, 0u, 0u, 0u};
            if (t < ntok) vv = *(const u32x4*)(U + (size_t)(row0 + t) * NINP + U_GV + h * 256 + c8 * 8);
            *(LAS u32x4*)(v_l + t * 264 + c8 * 8) = vv; }
        for (int i = tid; i < 64 * 16; i += 512) { const int t = i >> 4, c8 = i & 15; u32x4 qv = (u32x4){0u, 0u, 0u, 0u}, kv = qv;
            if (t < ntok) { const bf16_t* ur = U + (size_t)(row0 + t) * NINP + h * 128 + c8 * 8; qv = *(const u32x4*)(ur + U_GQ); kv = *(const u32x4*)(ur + U_GK); }
            *(LAS u32x4*)(qr_l + t * 136 + c8 * 8) = qv; *(LAS u32x4*)(kr_l + t * 136 + c8 * 8) = kv; }
        __syncthreads();
        const int kk = tid & 127, tq = tid >> 7;
        float cum[16];
        { float aup[16];
#pragma unroll
          for (int rr = 0; rr < 16; ++rr) aup[rr] = a_up[rr * 512 + h * 128 + kk];
          const float ab = a_b[h * 128 + kk]; float run = 0.f;
#pragma unroll
          for (int j = 0; j < 16; ++j) { const int t = tq * 16 + j; float x = ab;
#pragma unroll
              for (int rr = 0; rr < 16; ++rr) x += ga_l[t * 16 + rr] * aup[rr];
              const float la = t < ntok ? (fminf(x, 0.f) - __logf(1.0f + __expf(-fabsf(x)))) * (1.0f / 16.0f) : 0.f;
              run += la; cum[j] = run; }
          tot[tq * 128 + kk] = run; }
        __syncthreads();
        { float prefix = 0.f, bC = 0.f;
#pragma unroll
          for (int g = 0; g < 4; ++g) { const float tv = tot[g * 128 + kk]; bC += tv; if (g < tq) prefix += tv; }
          unsigned khp[8];
#pragma unroll
          for (int j = 0; j < 16; j += 2) { float kh2[2];
#pragma unroll
              for (int e = 0; e < 2; ++e) { const int t = tq * 16 + j + e; const float b = prefix + cum[j + e]; const float qv = bf2f(qr_l[t * 136 + kk]), kv = bf2f(kr_l[t * 136 + kk]);
                  Qd_l[t * 136 + kk] = f2bf(qv * __expf(b) * 0.08838834764831845f); Kn_l[t * 136 + kk] = f2bf(kv * __expf(-b)); kh2[e] = kv * __expf(bC - b); }
              khp[j >> 1] = pk2(kh2[0], kh2[1]); }
          bf16_t* kp = KHT + (size_t)u * 8192 + kk * 64 + tq * 16;
          *(u32x4*)kp = (u32x4){khp[0], khp[1], khp[2], khp[3]}; *(u32x4*)(kp + 8) = (u32x4){khp[4], khp[5], khp[6], khp[7]};
          if (tq == 0) GC[(size_t)u * 128 + kk] = __expf(bC); }
        __syncthreads();
        { const int tb = w >> 1;
#pragma unroll
          for (int e = 0; e < 2; ++e) { const int ib = (w & 1) * 2 + e; f32x4 d = (f32x4){0.f, 0.f, 0.f, 0.f};
              if (ib <= tb) {
                  bf16x8 kf4[4], qf4[4];
#pragma unroll
                  for (int ks = 0; ks < 4; ++ks) { kf4[ks] = *(const LAS bf16x8*)(Kn_l + (ib * 16 + r) * 136 + ks * 32 + q * 8); qf4[ks] = *(const LAS bf16x8*)(Qd_l + (tb * 16 + r) * 136 + ks * 32 + q * 8); }
                  __builtin_amdgcn_sched_barrier(0);
#pragma unroll
                  for (int ks = 0; ks < 4; ++ks) d = mma16(kf4[ks], qf4[ks], d); }
              const int t = tb * 16 + r, i0 = ib * 16 + q * 4;
#pragma unroll
              for (int jj = 0; jj < 4; ++jj) if (i0 + jj > t) d[jj] = 0.f;
              u32x2 o; o.x = pk2(d[0], d[1]); o.y = pk2(d[2], d[3]); *(u32x2*)(EE + (size_t)u * 4096 + t * 64 + i0) = o; } }
        for (int i = tid; i < 64 * 16; i += 512) { const int t = i >> 4, c8 = i & 15; *(u32x4*)(QD + (size_t)u * 8192 + t * 128 + c8 * 8) = *(const LAS u32x4*)(Qd_l + t * 136 + c8 * 8); }
        { const int val = tid & 255, th = tid >> 8;
#pragma unroll
          for (int tg = 0; tg < 4; ++tg) { const int t0 = th * 32 + tg * 8; unsigned p4[4];
#pragma unroll
              for (int e = 0; e < 4; ++e) p4[e] = (unsigned)v_l[(t0 + 2 * e) * 264 + val] | ((unsigned)v_l[(t0 + 2 * e + 1) * 264 + val] << 16);
              *(u32x4*)(VT + (size_t)u * 16384 + val * 64 + t0) = (u32x4){p4[0], p4[1], p4[2], p4[3]}; } }
        __syncthreads();
    }
}
struct GlaStage { u32x4 qd[2], kh[2], e, vt, gc; };
__device__ __forceinline__ void gla_stage_load(GlaStage& s, const bf16_t* __restrict__ QD, const bf16_t* __restrict__ KHT, const bf16_t* __restrict__ EE, const bf16_t* __restrict__ VT, const float* __restrict__ GC,
                                               int ch, int sl, int tid) {
    const bf16_t* qp = QD + (size_t)ch * 8192 + tid * 8; s.qd[0] = *(const u32x4*)qp; s.qd[1] = *(const u32x4*)(qp + 4096);
    const bf16_t* kp = KHT + (size_t)ch * 8192 + tid * 8; s.kh[0] = *(const u32x4*)kp; s.kh[1] = *(const u32x4*)(kp + 4096);
    s.e = *(const u32x4*)(EE + (size_t)ch * 4096 + tid * 8);
    s.vt = *(const u32x4*)(VT + (size_t)ch * 16384 + sl * 4096 + tid * 8);
    if (tid < 32) s.gc = *(const u32x4*)(GC + (size_t)ch * 128 + tid * 4);
}
constexpr int GS_KH = 8704, GS_E = 17920, GS_VT = 22528, GS_GC = 27136, GS_EL = 27392;
__device__ __forceinline__ void gla_stage_store(const GlaStage& s, LAS bf16_t* b, int tid) {
    *(LAS u32x4*)(b + (tid >> 4) * 136 + (tid & 15) * 8) = s.qd[0]; *(LAS u32x4*)(b + (32 + (tid >> 4)) * 136 + (tid & 15) * 8) = s.qd[1];
    *(LAS u32x4*)(b + GS_KH + (tid >> 3) * 72 + (tid & 7) * 8) = s.kh[0]; *(LAS u32x4*)(b + GS_KH + (64 + (tid >> 3)) * 72 + (tid & 7) * 8) = s.kh[1];
    *(LAS u32x4*)(b + GS_E + (tid >> 3) * 72 + (tid & 7) * 8) = s.e; *(LAS u32x4*)(b + GS_VT + (tid >> 3) * 72 + (tid & 7) * 8) = s.vt;
    if (tid < 32) *(LAS u32x4*)(b + GS_GC + tid * 8) = s.gc;
}
__device__ __forceinline__ void ph_gla_seq(const Ctx& c, int boff, const bf16_t* __restrict__ QD, const bf16_t* __restrict__ KHT, const bf16_t* __restrict__ EE, const bf16_t* __restrict__ VT, const float* __restrict__ GC,
                                           const float* __restrict__ s0, float* __restrict__ outP, float* __restrict__ outS, bf16_t* __restrict__ OB) {
    LAS bf16_t* stg = (LAS bf16_t*)c.lds;
    LAS bf16_t* T_l = stg + 2 * GS_EL;
    const int tid = c.tid, lane = c.lane, r = lane & 15, q = lane >> 4, w = c.wave;
    const int side = c.bid < 32 ? c.bid : c.bid - 64, nside = c.G - 64;
    for (int u = (c.bid >= boff && c.bid < boff + 32) ? c.bid - boff : ((c.bid < 32 || c.bid >= 96) ? 32 + side : 32 + 512); u < 32 + 512; u = u < 32 ? 32 + 512 : u + nside) {
        int h, sl, nch, ch0, row0, ntok; const float* sp = nullptr; float* op;
        if (u < 32) { const int b = u >> 4; h = (u >> 2) & 3; sl = u & 3; nch = 64; ch0 = (b * 4 + h) * 64; row0 = b * PS; ntok = 64; op = outP + (size_t)(b * 4 + h) * 32768; }
        else { const int s = u - 32, sq = s >> 4; h = (s >> 2) & 3; sl = s & 3; nch = 1; ch0 = 512 + sq * 4 + h; row0 = MP + sq * SS; ntok = SS; sp = s0 + (size_t)(sq * 4 + h) * 32768; op = outS + (size_t)(sq * 4 + h) * 32768; }
        f32x4 acc[4];
#pragma unroll
        for (int vb = 0; vb < 4; ++vb)
#pragma unroll
            for (int jj = 0; jj < 4; ++jj) acc[vb][jj] = sp ? sp[(size_t)(w * 16 + q * 4 + jj) * 256 + sl * 64 + vb * 16 + r] : 0.f;
        GlaStage R0, R1, R2;
        gla_stage_load(R0, QD, KHT, EE, VT, GC, ch0, sl, tid);
        if (1 < nch) gla_stage_load(R1, QD, KHT, EE, VT, GC, ch0 + 1, sl, tid);
        if (2 < nch) gla_stage_load(R2, QD, KHT, EE, VT, GC, ch0 + 2, sl, tid);
        __syncthreads();
        gla_stage_store(R0, stg, tid);
        if (3 < nch) gla_stage_load(R0, QD, KHT, EE, VT, GC, ch0 + 3, sl, tid);
#define GLA_STEP(ci, RN) do { \
            LAS bf16_t* Tb = T_l + ((ci) & 1) * 64 * 136; const LAS bf16_t* sb = stg + ((ci) & 1) * GS_EL; \
            _Pragma("unroll") for (int vb = 0; vb < 4; ++vb) { u32x2 o; o.x = pk2(acc[vb][0], acc[vb][1]); o.y = pk2(acc[vb][2], acc[vb][3]); *(LAS u32x2*)(Tb + (vb * 16 + r) * 136 + w * 16 + q * 4) = o; } \
            __syncthreads(); \
            if ((ci) + 1 < nch) { gla_stage_store(RN, stg + (((ci) + 1) & 1) * GS_EL, tid); if ((ci) + 4 < nch) gla_stage_load(RN, QD, KHT, EE, VT, GC, ch0 + (ci) + 4, sl, tid); } \
            { const int rb = w >> 1, t = rb * 16 + r; bf16x8 qf[4], ef[2]; \
              _Pragma("unroll") for (int ks = 0; ks < 4; ++ks) qf[ks] = *(const LAS bf16x8*)(sb + (rb * 16 + r) * 136 + ks * 32 + q * 8); \
              _Pragma("unroll") for (int ks = 0; ks < 2; ++ks) ef[ks] = *(const LAS bf16x8*)(sb + GS_E + (rb * 16 + r) * 72 + ks * 32 + q * 8); \
              bf16x8 tf[2][4], vf[2][2]; \
              _Pragma("unroll") for (int e2 = 0; e2 < 2; ++e2) { const int cb = (w & 1) * 2 + e2; \
                  _Pragma("unroll") for (int ks = 0; ks < 4; ++ks) tf[e2][ks] = *(const LAS bf16x8*)(Tb + (cb * 16 + r) * 136 + ks * 32 + q * 8); \
                  _Pragma("unroll") for (int ks = 0; ks < 2; ++ks) vf[e2][ks] = *(const LAS bf16x8*)(sb + GS_VT + (cb * 16 + r) * 72 + ks * 32 + q * 8); } \
              __builtin_amdgcn_sched_barrier(0); \
              _Pragma("unroll") for (int e2 = 0; e2 < 2; ++e2) { const int cb = (w & 1) * 2 + e2; f32x4 y = (f32x4){0.f, 0.f, 0.f, 0.f}; \
                  _Pragma("unroll") for (int ks = 0; ks < 4; ++ks) y = mma16(tf[e2][ks], qf[ks], y); \
                  _Pragma("unroll") for (int ks = 0; ks < 2; ++ks) y = mma16(vf[e2][ks], ef[ks], y); \
                  if (t < ntok) { u32x2 o; o.x = pk2(y[0], y[1]); o.y = pk2(y[2], y[3]); *(u32x2*)(OB + (size_t)(row0 + (ci) * 64 + t) * BW + h * 256 + sl * 64 + cb * 16 + q * 4) = o; } } } \
            { const f32x4 gcv = *(const LAS f32x4*)((const LAS float*)(sb + GS_GC) + w * 16 + q * 4); bf16x8 kf[2]; \
              _Pragma("unroll") for (int ks = 0; ks < 2; ++ks) kf[ks] = *(const LAS bf16x8*)(sb + GS_KH + (w * 16 + r) * 72 + ks * 32 + q * 8); \
              bf16x8 vs[4][2]; \
              _Pragma("unroll") for (int vb = 0; vb < 4; ++vb) _Pragma("unroll") for (int ks = 0; ks < 2; ++ks) vs[vb][ks] = *(const LAS bf16x8*)(sb + GS_VT + (vb * 16 + r) * 72 + ks * 32 + q * 8); \
              __builtin_amdgcn_sched_barrier(0); \
              _Pragma("unroll") for (int vb = 0; vb < 4; ++vb) { acc[vb] = acc[vb] * gcv; \
                  _Pragma("unroll") for (int ks = 0; ks < 2; ++ks) acc[vb] = mma16(kf[ks], vs[vb][ks], acc[vb]); } } \
        } while (0)
#pragma unroll 1
        for (int ci = 0; ci < nch; ci += 3) {
            GLA_STEP(ci, R1);
            if (ci + 1 < nch) GLA_STEP(ci + 1, R2);
            if (ci + 2 < nch) GLA_STEP(ci + 2, R0);
        }
#undef GLA_STEP
#pragma unroll
        for (int vb = 0; vb < 4; ++vb)
#pragma unroll
            for (int jj = 0; jj < 4; ++jj) op[(size_t)(w * 16 + q * 4 + jj) * 256 + sl * 64 + vb * 16 + r] = acc[vb][jj];
        __syncthreads();
    }
}
__device__ __forceinline__ void ph_gla_fin(const Ctx& c, const bf16_t* __restrict__ U, const float* __restrict__ ng, const float* __restrict__ nb, const bf16_t* __restrict__ RAW, bf16_t* __restrict__ OB) {
    const int lane = c.lane, hs = lane >> 5, l32 = lane & 31;
    for (int i = c.bid * 8 + c.wave; i < MT * 2; i += c.G * 8) {
        const int row = i >> 1, h = (i & 1) * 2 + hs, cc = h * 256 + l32 * 8; bf16_t* p = OB + (size_t)row * BW + cc;
        float x[8], gr[8]; unpack8(*(const u32x4*)(RAW + (size_t)row * BW + cc), x); unpack8(*(const u32x4*)(U + (size_t)row * NINP + U_GR + cc), gr);
        float s = 0.f;
#pragma unroll
        for (int j = 0; j < 8; ++j) s += x[j];
#pragma unroll
        for (int o = 16; o > 0; o >>= 1) s += __shfl_xor(s, o, 64);
        const float mean = s * (1.0f / 256.0f); float qq = 0.f;
#pragma unroll
        for (int j = 0; j < 8; ++j) { const float d = x[j] - mean; qq += d * d; }
#pragma unroll
        for (int o = 16; o > 0; o >>= 1) qq += __shfl_xor(qq, o, 64);
        const float rstd = rsqrtf(qq * (1.0f / 256.0f) + 1e-5f);
        const f32x4 g0 = *(const f32x4*)(ng + cc), g1 = *(const f32x4*)(ng + cc + 4), b0 = *(const f32x4*)(nb + cc), b1 = *(const f32x4*)(nb + cc + 4); float o8[8];
#pragma unroll
        for (int j = 0; j < 8; ++j) o8[j] = ((x[j] - mean) * rstd * (j < 4 ? g0[j] : g1[j - 4]) + (j < 4 ? b0[j] : b1[j - 4])) * gr[j] * sigmoidf_(gr[j]);
        *(u32x4*)p = (u32x4){pk2(o8[0], o8[1]), pk2(o8[2], o8[3]), pk2(o8[4], o8[5]), pk2(o8[6], o8[7])};
    }
}

template <bool ISBF> __device__ __forceinline__ void swa_step(const float (&q)[32], float (&acc)[32], float& m, float& l, const void* kp, const void* vp, float slope, float dist) {
    float s = 0.f;
#pragma unroll
    for (int j = 0; j < 4; ++j) { float x[8];
        if (ISBF) unpack8(*(const u32x4*)((const bf16_t*)kp + j * 8), x);
        else { const f32x4 a = *(const f32x4*)((const float*)kp + j * 8), b = *(const f32x4*)((const float*)kp + j * 8 + 4); x[0] = a[0]; x[1] = a[1]; x[2] = a[2]; x[3] = a[3]; x[4] = b[0]; x[5] = b[1]; x[6] = b[2]; x[7] = b[3]; }
#pragma unroll
        for (int d = 0; d < 8; ++d) s += q[j * 8 + d] * x[d]; }
    s += __shfl_xor(s, 1, 64);
    s = s * 0.125f - slope * dist;
    const float mn = fmaxf(m, s), cc = __expf(m - mn), p = __expf(s - mn);
    l = l * cc + p;
#pragma unroll
    for (int j = 0; j < 4; ++j) { float x[8];
        if (ISBF) unpack8(*(const u32x4*)((const bf16_t*)vp + j * 8), x);
        else { const f32x4 a = *(const f32x4*)((const float*)vp + j * 8), b = *(const f32x4*)((const float*)vp + j * 8 + 4); x[0] = a[0]; x[1] = a[1]; x[2] = a[2]; x[3] = a[3]; x[4] = b[0]; x[5] = b[1]; x[6] = b[2]; x[7] = b[3]; }
#pragma unroll
        for (int d = 0; d < 8; ++d) acc[j * 8 + d] = acc[j * 8 + d] * cc + p * x[d]; }
    m = mn;
}
__device__ __forceinline__ void ph_swa_naive(const Ctx& c, const bf16_t* __restrict__ U, const float* __restrict__ ck, const float* __restrict__ cv, const float* __restrict__ sinks, bf16_t* __restrict__ OB) {
    for (int gid = c.bid * 512 + c.tid; gid < MS * 32; gid += c.G * 512) {
        const int dh = gid & 1, h = (gid >> 1) & 15, row = MP + (gid >> 5), kvh = h >> 3, co = kvh * 64 + dh * 32;
        float q[32], acc[32];
#pragma unroll
        for (int j = 0; j < 4; ++j) { float x[8]; unpack8(*(const u32x4*)(U + (size_t)row * NINP + U_SQ + h * 64 + dh * 32 + j * 8), x);
#pragma unroll
            for (int d = 0; d < 8; ++d) { q[j * 8 + d] = x[d]; acc[j * 8 + d] = 0.f; } }
        const float slope = exp2f(-0.5f * (float)(h + 1)); float m = sinks[h], l = 1.0f;
        if (row < MP) {
            const int t = row % PS, base = row - t, lo = t - 128 < 0 ? 0 : t - 128;
            for (int s = lo; s <= t; ++s) { const bf16_t* ur = U + (size_t)(base + s) * NINP;
                swa_step<true>(q, acc, m, l, ur + U_SK + co, ur + U_SV + co, slope, (float)(t - s)); }
        } else {
            const int sq = (row - MP) / SS, i = (row - MP) % SS;
            for (int idx = i; idx <= 128 + i; ++idx) {
                if (idx < 128) { const size_t o = ((size_t)sq * 128 + idx) * 128 + co; swa_step<false>(q, acc, m, l, ck + o, cv + o, slope, (float)(128 + i - idx)); }
                else { const bf16_t* ur = U + (size_t)(MP + sq * SS + idx - 128) * NINP; swa_step<true>(q, acc, m, l, ur + U_SK + co, ur + U_SV + co, slope, (float)(128 + i - idx)); }
            }
        }
        const float inv = 1.0f / l; bf16_t* op = OB + (size_t)row * BW + h * 64 + dh * 32;
#pragma unroll
        for (int j = 0; j < 4; ++j) { u32x4 w; w.x = pk2(acc[j * 8] * inv, acc[j * 8 + 1] * inv); w.y = pk2(acc[j * 8 + 2] * inv, acc[j * 8 + 3] * inv);
            w.z = pk2(acc[j * 8 + 4] * inv, acc[j * 8 + 5] * inv); w.w = pk2(acc[j * 8 + 6] * inv, acc[j * 8 + 7] * inv); *(u32x4*)(op + j * 8) = w; }
    }
}

__device__ __forceinline__ void ph_rwkv_prep(const Ctx& c, const bf16_t* __restrict__ U, const float* __restrict__ shift, const float* __restrict__ mu, const float* __restrict__ w0, const float* __restrict__ w2,
                                             const float* __restrict__ a0, const float* __restrict__ a2, const float* __restrict__ g2, const float* __restrict__ k_k, const float* __restrict__ k_a,
                                             const float* __restrict__ r_k, float* __restrict__ RW) {
    LAS float* xm = (LAS float*)c.lds; LAS float* tw = xm + RWC; LAS float* ad = tw + 64; LAS float* sg = ad + 64;
    const int tid = c.tid;
    float* R = RW; float* WD = RW + (size_t)MPAD * BW; float* K2 = WD + (size_t)MPAD * BW; float* V = K2 + (size_t)MPAD * BW; float* KK = V + (size_t)MPAD * BW;
    float* BV = KK + (size_t)MPAD * BW; float* G = BV + (size_t)MPAD * BW; float* BON = G + (size_t)MPAD * BW;
    for (int row = c.bid; row < MT; row += c.G) {
        const bf16_t* ur = U + (size_t)row * NINP + U_RU; const bf16_t* pr = ur - NINP; const float* ps = nullptr; bool first;
        if (row < MP) first = (row % PS) == 0; else { first = ((row - MP) % SS) == 0; ps = shift + (size_t)((row - MP) / SS) * RWC; }
        for (int cc = tid; cc < RWC; cc += 512) { const float x = bf2f(ur[cc]); const float s = first ? (ps ? ps[cc] : 0.f) : bf2f(pr[cc]); xm[cc] = x + (s - x) * mu[cc]; }
        __syncthreads();
        if (tid < 64) { tw[tid] = tanhf(xm[3072 + tid]); ad[tid] = xm[3136 + tid]; }
        if (tid >= 128 && tid < 256) sg[tid - 128] = sigmoidf_(xm[3200 + tid - 128]);
        __syncthreads();
        for (int qd = 0; qd < 2; ++qd) {
            const int cc = qd * 512 + tid; float accw = w0[cc], acca = a0[cc], accg = 0.f;
#pragma unroll 4
            for (int j = 0; j < 64; ++j) { accw += tw[j] * w2[j * BW + cc]; acca += ad[j] * a2[j * BW + cc]; }
#pragma unroll 4
            for (int j = 0; j < 128; ++j) accg += sg[j] * g2[j * BW + cc];
            const float lw = -softplusf_(-accw) - 0.5f, decay = __expf(-__expf(lw)), a = sigmoidf_(acca);
            const float r = xm[cc], k = xm[1024 + cc], v = xm[2048 + cc];
            const float kkr = k * k_k[cc]; const float ss = wave_sum(kkr * kkr); const float kk = kkr / fmaxf(sqrtf(ss), 1e-12f);
            const float k2 = k * (1.0f + (a - 1.0f) * k_a[cc]); const float rk = wave_sum(r * k2 * r_k[cc]);
            const size_t o = (size_t)row * BW + cc;
            R[o] = r; WD[o] = decay; K2[o] = k2; V[o] = v; KK[o] = kk; BV[o] = kk * a; G[o] = accg; BON[o] = rk * v;
        }
        __syncthreads();
    }
}
__device__ __forceinline__ int kperm_pos(int k) { return (k & ~31) + 8 * ((k >> 2) & 3) + 4 * ((k >> 4) & 1) + (k & 3); }
__device__ __forceinline__ void ph_swa_prompt(const Ctx& c, const bf16_t* __restrict__ U, const float* __restrict__ sinks, bf16_t* __restrict__ OB) {
    LAS bf16_t* K_l = (LAS bf16_t*)c.lds;
    LAS bf16_t* VT_l = K_l + 192 * 72;
    const int tid = c.tid, lane = c.lane, r = lane & 15, q = lane >> 4, w = c.wave;
    for (int u = c.bid; u < PB * 64 * 2; u += c.G) {
        const int b = u >> 7, qb = (u >> 1) & 63, kvh = u & 1, h = kvh * 8 + w;
        const int tok0 = qb * 64 - 128;
        const size_t seq0 = (size_t)b * PS;
        const bf16_t* qbase = U + (seq0 + qb * 64 + r) * NINP + U_SQ + h * 64 + q * 8;
        bf16x8 qn0 = *(const bf16x8*)qbase, qn1 = *(const bf16x8*)(qbase + 32);
        { u32x4 kv3[3], vv3[3];
#pragma unroll
          for (int k3 = 0; k3 < 3; ++k3) { const int idx = tid + 512 * k3, kl = idx >> 3, c8 = idx & 7, tk = tok0 + kl; kv3[k3] = (u32x4){0u, 0u, 0u, 0u}; vv3[k3] = kv3[k3];
            if (tk >= 0) { const bf16_t* ur = U + (seq0 + tk) * NINP; kv3[k3] = *(const u32x4*)(ur + U_SK + kvh * 64 + c8 * 8); vv3[k3] = *(const u32x4*)(ur + U_SV + kvh * 64 + c8 * 8); } }
#pragma unroll
          for (int k3 = 0; k3 < 3; ++k3) { const int idx = tid + 512 * k3, kl = idx >> 3, c8 = idx & 7; const u32x4 vv = vv3[k3];
            *(LAS u32x4*)(K_l + kl * 72 + c8 * 8) = kv3[k3];
            const int kp = kperm_pos(kl); LAS bf16_t* vp = VT_l + (c8 * 8) * 200 + kp;
            vp[0] = (bf16_t)(vv.x & 0xffffu); vp[200] = (bf16_t)(vv.x >> 16); vp[400] = (bf16_t)(vv.y & 0xffffu); vp[600] = (bf16_t)(vv.y >> 16);
            vp[800] = (bf16_t)(vv.z & 0xffffu); vp[1000] = (bf16_t)(vv.z >> 16); vp[1200] = (bf16_t)(vv.w & 0xffffu); vp[1400] = (bf16_t)(vv.w >> 16); } }
        __syncthreads();
        const float slope = exp2f(-0.5f * (float)(h + 1)), sink = sinks[h];
#pragma unroll 1
        for (int i = 0; i < 4; ++i) {
            const size_t qrow = seq0 + qb * 64 + i * 16 + r;
            const bf16x8 qf0 = qn0, qf1 = qn1;
            { const bf16_t* qp = qbase + (size_t)((i < 3 ? i + 1 : 3) * 16) * NINP; qn0 = *(const bf16x8*)qp; qn1 = *(const bf16x8*)(qp + 32); }
            const int kt0 = i & ~1;
            f32x4 s[10]; float mx = sink; bf16x8 kfr[5][2];
#pragma unroll
            for (int kt = 0; kt < 10; ++kt) { f32x4 d;
                if (kt % 5 == 0) {
#pragma unroll
                    for (int k5 = 0; k5 < 5; ++k5) { const LAS bf16_t* kp = K_l + ((kt0 + kt + k5) * 16 + r) * 72 + q * 8; kfr[k5][0] = *(const LAS bf16x8*)kp; kfr[k5][1] = *(const LAS bf16x8*)(kp + 32); }
                    __builtin_amdgcn_sched_barrier(0); }
                d = mma16(kfr[kt % 5][0], qf0, (f32x4){0.f, 0.f, 0.f, 0.f}); d = mma16(kfr[kt % 5][1], qf1, d);
#pragma unroll
                for (int jj = 0; jj < 4; ++jj) { const int kl = (kt0 + kt) * 16 + q * 4 + jj, dist = i * 16 + r + 128 - kl;
                    const float v = (dist >= 0 && dist <= 128 && tok0 + kl >= 0) ? d[jj] * 0.125f - slope * (float)dist : -1e30f; d[jj] = v; mx = fmaxf(mx, v); }
                s[kt] = d; }
            mx = fmaxf(mx, __shfl_xor(mx, 16, 64)); mx = fmaxf(mx, __shfl_xor(mx, 32, 64));
            float sum = 0.f; bf16x8 pf[5];
#pragma unroll
            for (int kp = 0; kp < 5; ++kp) { f32x4 a = s[2 * kp], bq = s[2 * kp + 1];
#pragma unroll
                for (int jj = 0; jj < 4; ++jj) { a[jj] = __expf(a[jj] - mx); bq[jj] = __expf(bq[jj] - mx); sum += a[jj] + bq[jj]; }
                pf[kp] = pack_acc(a, bq); }
            sum += __shfl_xor(sum, 16, 64); sum += __shfl_xor(sum, 32, 64);
            const float inv = 1.0f / (sum + __expf(sink - mx));
            bf16_t* op = OB + qrow * BW + h * 64 + q * 4;
#pragma unroll
            for (int dt = 0; dt < 4; ++dt) { f32x4 o = (f32x4){0.f, 0.f, 0.f, 0.f}; bf16x8 vfr[5];
#pragma unroll
                for (int kp = 0; kp < 5; ++kp) vfr[kp] = *(const LAS bf16x8*)(VT_l + (dt * 16 + r) * 200 + (kt0 + 2 * kp) * 16 + q * 8);
                __builtin_amdgcn_sched_barrier(0);
#pragma unroll
                for (int kp = 0; kp < 5; ++kp) o = mma16(vfr[kp], pf[kp], o);
                u32x2 ov; ov.x = pk2(o[0] * inv, o[1] * inv); ov.y = pk2(o[2] * inv, o[3] * inv); *(u32x2*)(op + dt * 16) = ov; }
        }
        __syncthreads();
    }
}

__device__ __forceinline__ void ph_swa_sample(const Ctx& c, const bf16_t* __restrict__ U, const float* __restrict__ ck, const float* __restrict__ cv, const float* __restrict__ sinks, bf16_t* __restrict__ OB) {
    LAS bf16_t* K_l = (LAS bf16_t*)c.lds;
    LAS bf16_t* VT_l = K_l + 160 * 72;
    const int tid = c.tid, lane = c.lane, r = lane & 15, q = lane >> 4, w = c.wave;
    for (int u = c.bid; u < SB * 2; u += c.G) {
        const int sq = u >> 1, kvh = u & 1;
        for (int idx = tid; idx < 160 * 8; idx += 512) { const int kl = idx >> 3, c8 = idx & 7; float kx[8], vx[8];
#pragma unroll
            for (int e = 0; e < 8; ++e) { kx[e] = 0.f; vx[e] = 0.f; }
            if (kl < 128) { const size_t o = ((size_t)sq * 128 + kl) * 128 + kvh * 64 + c8 * 8; const f32x4 a = *(const f32x4*)(ck + o), b2 = *(const f32x4*)(ck + o + 4), c2 = *(const f32x4*)(cv + o), d2 = *(const f32x4*)(cv + o + 4);
                kx[0] = a[0]; kx[1] = a[1]; kx[2] = a[2]; kx[3] = a[3]; kx[4] = b2[0]; kx[5] = b2[1]; kx[6] = b2[2]; kx[7] = b2[3];
                vx[0] = c2[0]; vx[1] = c2[1]; vx[2] = c2[2]; vx[3] = c2[3]; vx[4] = d2[0]; vx[5] = d2[1]; vx[6] = d2[2]; vx[7] = d2[3]; }
            else if (kl < 132) { const bf16_t* ur = U + (size_t)(MP + sq * SS + kl - 128) * NINP; unpack8(*(const u32x4*)(ur + U_SK + kvh * 64 + c8 * 8), kx); unpack8(*(const u32x4*)(ur + U_SV + kvh * 64 + c8 * 8), vx); }
            *(LAS u32x4*)(K_l + kl * 72 + c8 * 8) = (u32x4){pk2(kx[0], kx[1]), pk2(kx[2], kx[3]), pk2(kx[4], kx[5]), pk2(kx[6], kx[7])};
            LAS bf16_t* vp = VT_l + (c8 * 8) * 168 + kperm_pos(kl);
#pragma unroll
            for (int e = 0; e < 8; ++e) vp[e * 168] = f2bf(vx[e]); }
        __syncthreads();
        if (w < 2) {
            const int h = kvh * 8 + w * 4 + (r >> 2), tk = r & 3; const size_t qrow = (size_t)(MP + sq * SS + tk);
            const float slope = exp2f(-0.5f * (float)(h + 1)), sink = sinks[h];
            const bf16x8 qf0 = *(const bf16x8*)(U + qrow * NINP + U_SQ + h * 64 + q * 8), qf1 = *(const bf16x8*)(U + qrow * NINP + U_SQ + h * 64 + 32 + q * 8);
            f32x4 s[10]; float mx = sink;
#pragma unroll
            for (int kt = 0; kt < 10; ++kt) { const LAS bf16_t* kp = K_l + (kt * 16 + r) * 72 + q * 8;
                f32x4 d = mma16(*(const LAS bf16x8*)kp, qf0, (f32x4){0.f, 0.f, 0.f, 0.f}); d = mma16(*(const LAS bf16x8*)(kp + 32), qf1, d);
#pragma unroll
                for (int jj = 0; jj < 4; ++jj) { const int kl = kt * 16 + q * 4 + jj, dist = 128 + tk - kl;
                    const float v = (dist >= 0 && dist <= 128) ? d[jj] * 0.125f - slope * (float)dist : -1e30f; d[jj] = v; mx = fmaxf(mx, v); }
                s[kt] = d; }
            mx = fmaxf(mx, __shfl_xor(mx, 16, 64)); mx = fmaxf(mx, __shfl_xor(mx, 32, 64));
            float sum = 0.f; bf16x8 pf[5];
#pragma unroll
            for (int kp = 0; kp < 5; ++kp) { f32x4 a = s[2 * kp], bq = s[2 * kp + 1];
#pragma unroll
                for (int jj = 0; jj < 4; ++jj) { a[jj] = __expf(a[jj] - mx); bq[jj] = __expf(bq[jj] - mx); sum += a[jj] + bq[jj]; }
                pf[kp] = pack_acc(a, bq); }
            sum += __shfl_xor(sum, 16, 64); sum += __shfl_xor(sum, 32, 64);
            const float inv = 1.0f / (sum + __expf(sink - mx));
            bf16_t* op = OB + qrow * BW + h * 64 + q * 4;
#pragma unroll
            for (int dt = 0; dt < 4; ++dt) { f32x4 o = (f32x4){0.f, 0.f, 0.f, 0.f};
#pragma unroll
                for (int kp = 0; kp < 5; ++kp) o = mma16(*(const LAS bf16x8*)(VT_l + (dt * 16 + r) * 168 + kp * 32 + q * 8), pf[kp], o);
                u32x2 ov; ov.x = pk2(o[0] * inv, o[1] * inv); ov.y = pk2(o[2] * inv, o[3] * inv); *(u32x2*)(op + dt * 16) = ov; }
        }
        __syncthreads();
    }
}

__device__ __forceinline__ void ph_memattn_prompt(const Ctx& c, const bf16_t* __restrict__ U, const bf16_t* __restrict__ MKB, const bf16_t* __restrict__ MVT, bf16_t* __restrict__ OB) {
    LAS bf16_t* buf = (LAS bf16_t*)c.lds;
    const int tid = c.tid, lane = c.lane, r = lane & 15, q = lane >> 4, w = c.wave;
    for (int u = c.bid; u < PB * 4 * 32; u += c.G) {
        const int b = u >> 7, h = (u >> 5) & 3, qb = u & 31;
        const size_t qrow = (size_t)b * PS + qb * 128 + w * 16 + r;
        const bf16_t* kg = MKB + (size_t)(b * 256) * 1024 + h * 256;
        const bf16_t* vg = MVT + (size_t)(b * 4 + h) * 65536;
        const bf16_t* qg = U + qrow * NINP + U_MQ + h * 256 + q * 8;
        bf16x8 qn0 = *(const bf16x8*)qg, qn1 = *(const bf16x8*)(qg + 32);
        u32x4 st[4];
#pragma unroll
        for (int i = 0; i < 4; ++i) { const int p = tid + 512 * i; st[i] = *(const u32x4*)(kg + (size_t)(p >> 3) * 1024 + (p & 7) * 8); }
        f32x4 s[16];
#pragma unroll
        for (int mt = 0; mt < 16; ++mt) s[mt] = (f32x4){0.f, 0.f, 0.f, 0.f};
        __syncthreads();
#pragma unroll 1
        for (int ck = 0; ck < 4; ++ck) {
            LAS bf16_t* kb = buf + (ck & 1) * 18432;
#pragma unroll
            for (int i = 0; i < 4; ++i) { const int p = tid + 512 * i; *(LAS u32x4*)(kb + (p >> 3) * 72 + (p & 7) * 8) = st[i]; }
            __syncthreads();
            const bf16x8 qc0 = qn0, qc1 = qn1;
            if (ck < 3) { qn0 = *(const bf16x8*)(qg + (ck + 1) * 64); qn1 = *(const bf16x8*)(qg + (ck + 1) * 64 + 32);
#pragma unroll
                for (int i = 0; i < 4; ++i) { const int p = tid + 512 * i; st[i] = *(const u32x4*)(kg + (size_t)(p >> 3) * 1024 + (ck + 1) * 64 + (p & 7) * 8); } }
#pragma unroll
            for (int m2 = 0; m2 < 16; m2 += 2) { bf16x8 kf[2][2];
#pragma unroll
                for (int j = 0; j < 2; ++j) { kf[j][0] = *(const LAS bf16x8*)(kb + ((m2 + j) * 16 + r) * 72 + q * 8); kf[j][1] = *(const LAS bf16x8*)(kb + ((m2 + j) * 16 + r) * 72 + 32 + q * 8); }
                __builtin_amdgcn_sched_barrier(0);
#pragma unroll
                for (int j = 0; j < 2; ++j) { s[m2 + j] = mma16(kf[j][0], qc0, s[m2 + j]); s[m2 + j] = mma16(kf[j][1], qc1, s[m2 + j]); } }
        }
#pragma unroll
        for (int i = 0; i < 4; ++i) { const int p = tid + 512 * i; st[i] = *(const u32x4*)(vg + (size_t)(p >> 5) * 256 + (p & 31) * 8); }
        float mx = -3.0e38f;
#pragma unroll
        for (int mt = 0; mt < 16; ++mt)
#pragma unroll
            for (int jj = 0; jj < 4; ++jj) { s[mt][jj] *= 0.0625f; mx = fmaxf(mx, s[mt][jj]); }
        mx = fmaxf(mx, __shfl_xor(mx, 16, 64)); mx = fmaxf(mx, __shfl_xor(mx, 32, 64));
        float sum = 0.f; bf16x8 pf[8];
#pragma unroll
        for (int kp = 0; kp < 8; ++kp) { f32x4 a = s[2 * kp], b2 = s[2 * kp + 1];
#pragma unroll
            for (int jj = 0; jj < 4; ++jj) { a[jj] = __expf(a[jj] - mx); b2[jj] = __expf(b2[jj] - mx); sum += a[jj] + b2[jj]; }
            pf[kp] = pack_acc(a, b2); }
        sum += __shfl_xor(sum, 16, 64); sum += __shfl_xor(sum, 32, 64);
        const float inv = 1.0f / sum;
        bf16_t* op = OB + qrow * BW + h * 256 + q * 4;
#pragma unroll 1
        for (int cv = 0; cv < 4; ++cv) {
            LAS bf16_t* vb = buf + (cv & 1) * 18432;
#pragma unroll
            for (int i = 0; i < 4; ++i) { const int p = tid + 512 * i, m0 = (p & 31) * 8; LAS bf16_t* d0 = vb + (p >> 5) * 264;
                *(LAS u32x2*)(d0 + kperm_pos(m0)) = (u32x2){st[i].x, st[i].y}; *(LAS u32x2*)(d0 + kperm_pos(m0 + 4)) = (u32x2){st[i].z, st[i].w}; }
            __syncthreads();
            if (cv < 3) {
#pragma unroll
                for (int i = 0; i < 4; ++i) { const int p = tid + 512 * i; st[i] = *(const u32x4*)(vg + (size_t)((cv + 1) * 64 + (p >> 5)) * 256 + (p & 31) * 8); } }
#pragma unroll
            for (int dt = 0; dt < 4; ++dt) { bf16x8 vf[8];
#pragma unroll
                for (int kp = 0; kp < 8; ++kp) vf[kp] = *(const LAS bf16x8*)(vb + (dt * 16 + r) * 264 + kp * 32 + q * 8);
                __builtin_amdgcn_sched_barrier(0);
                f32x4 o = (f32x4){0.f, 0.f, 0.f, 0.f};
#pragma unroll
                for (int kp = 0; kp < 8; ++kp) o = mma16(vf[kp], pf[kp], o);
                u32x2 ov; ov.x = pk2(o[0] * inv, o[1] * inv); ov.y = pk2(o[2] * inv, o[3] * inv); *(u32x2*)(op + (cv * 4 + dt) * 16) = ov; }
        }
        __syncthreads();
    }
}

__device__ __forceinline__ void ph_lrw(const Ctx& c, const float* __restrict__ w2, const float* __restrict__ a2, const float* __restrict__ g2, bf16_t* __restrict__ LRW) {
    for (int idx = c.bid * 512 + c.tid; idx < NL * 256 * 1024; idx += c.G * 512) {
        const int ch = idx & 1023, j = (idx >> 10) & 255, l = idx >> 18;
        const float v = j < 64 ? w2[((size_t)l * 64 + j) * BW + ch] : (j < 128 ? a2[((size_t)l * 64 + j - 64) * BW + ch] : g2[((size_t)l * 128 + j - 128) * BW + ch]);
        LRW[((size_t)l * 1024 + ch) * 256 + j] = f2bf(v);
    }
}
constexpr int RWP_UNITS = (MP / 64) * 4 + SB * 4;
__device__ __forceinline__ void rwp_unit_info(int u, int& row0, int& ntok, int& hg, int& sq, bool& seq_first) {
    if (u < (MP / 64) * 4) { const int blk = u >> 2; hg = u & 3; row0 = blk * 64; ntok = 64; sq = -1; seq_first = (row0 % PS) == 0; }
    else { const int s = u - (MP / 64) * 4; sq = s >> 2; hg = s & 3; row0 = MP + sq * SS; ntok = SS; seq_first = true; }
}
__device__ __forceinline__ void ph_rwkv_pre(const Ctx& c, const bf16_t* __restrict__ U, const float* __restrict__ shift, const float* __restrict__ mu, const float* __restrict__ w0, const float* __restrict__ w2,
                                            const float* __restrict__ a0, const float* __restrict__ a2, const float* __restrict__ g2, const float* __restrict__ k_k, const float* __restrict__ k_a,
                                            const float* __restrict__ r_k, float* __restrict__ RW, bf16_t* __restrict__ RB, const bf16_t* __restrict__ LRW) {
    LAS bf16_t* P_l = (LAS bf16_t*)c.lds; LAS bf16_t* Kn_l = P_l + 4608; LAS bf16_t* Bn_l = Kn_l + 4608; LAS bf16_t* Q_l = Bn_l + 4608;
    LAS bf16_t* PT_l = Q_l + 4608; LAS bf16_t* BhT_l = PT_l + 4608; LAS bf16_t* KhT_l = BhT_l + 4608; LAS bf16_t* VT_l = KhT_l + 4608;
    LAS float* A_l = (LAS float*)(c.lds + 73728);
    LAS bf16_t* BmT_l = (LAS bf16_t*)(c.lds + 78848); LAS bf16_t* F_l = (LAS bf16_t*)(c.lds + 81920); LAS bf16_t* Tinv_l = (LAS bf16_t*)(c.lds + 84992);
    LAS bf16_t* PpT_l = (LAS bf16_t*)(c.lds + 88064);
    LAS bf16_t* BmpT_l = (LAS bf16_t*)(c.lds + 97280);
    LAS float* GC_l = (LAS float*)(c.lds + 100352);
    LAS float* lg_l = (LAS float*)(c.lds + 125952);
    LAS bf16_t* act_l = (LAS bf16_t*)c.lds;
    LAS bf16_t* wT_l = act_l + 64 * 264;
    LAS bf16_t* aT_l = wT_l + 64 * 72;
    LAS bf16_t* gT_l = aT_l + 64 * 72;
    LAS float* pre_l = (LAS float*)(c.lds + 73728);
    const int tid = c.tid, lane = c.lane, r = lane & 15, q = lane >> 4, w = c.wave;
    bf16_t* Gg = (bf16_t*)(RW + 6 * (size_t)MPAD * BW); bf16_t* BON = (bf16_t*)(RW + 7 * (size_t)MPAD * BW);
    for (int u = c.bid; u < RWP_UNITS; u += c.G) {
        int row0, ntok, hg, sq; bool seq_first; rwp_unit_info(u, row0, ntok, hg, sq, seq_first);
        const float* sh = sq >= 0 ? shift + (size_t)sq * RWC : nullptr;
        const int nstage = ntok == 64 ? 64 : 16;
        for (int idx = tid; idx < nstage * 32; idx += 512) {
            const int t = idx >> 5, c8 = idx & 31, cc = 3072 + c8 * 8; float val[8];
#pragma unroll
            for (int e2 = 0; e2 < 8; ++e2) val[e2] = 0.f;
            if (t < ntok) { const bf16_t* ur = U + (size_t)(row0 + t) * NINP + U_RU; float x[8], p[8];
                unpack8(*(const u32x4*)(ur + cc), x);
                if (!(t == 0 && seq_first)) unpack8(*(const u32x4*)(ur + cc - NINP), p);
                else if (sh) { const f32x4 s0v = *(const f32x4*)(sh + cc), s1v = *(const f32x4*)(sh + cc + 4); p[0] = s0v[0]; p[1] = s0v[1]; p[2] = s0v[2]; p[3] = s0v[3]; p[4] = s1v[0]; p[5] = s1v[1]; p[6] = s1v[2]; p[7] = s1v[3]; }
                else {
#pragma unroll
                    for (int e2 = 0; e2 < 8; ++e2) p[e2] = 0.f; }
                const f32x4 m0 = *(const f32x4*)(mu + cc), m1 = *(const f32x4*)(mu + cc + 4);
#pragma unroll
                for (int e2 = 0; e2 < 8; ++e2) { const float xm = x[e2] + (p[e2] - x[e2]) * (e2 < 4 ? m0[e2] : m1[e2 - 4]); val[e2] = c8 < 8 ? tanh_fast(xm) : (c8 < 16 ? xm : sigmoidf_(xm)); } }
            *(LAS u32x4*)(act_l + t * 264 + c8 * 8) = (u32x4){pk2(val[0], val[1]), pk2(val[2], val[3]), pk2(val[4], val[5]), pk2(val[6], val[7])};
        }
        __syncthreads();
        bf16x8 af[8];
        { const int tb = w & 3;
#pragma unroll
          for (int ks = 0; ks < 8; ++ks) af[ks] = *(const LAS bf16x8*)(act_l + (tb * 16 + r) * 264 + ks * 32 + q * 8); }
        __syncthreads();
#pragma unroll 1
        for (int hh = 0; hh < 4; ++hh) { const int h = hg * 4 + hh;
        const int t = tid >> 3, cg = tid & 7, c0 = h * 64 + cg * 8, sc = t >> 4;
        u32x4 ux[3], upv[3];
        if (t < ntok) { const bf16_t* ur = U + (size_t)(row0 + t) * NINP + U_RU; const bool fst = (t == 0 && seq_first);
#pragma unroll
            for (int part = 0; part < 3; ++part) { ux[part] = *(const u32x4*)(ur + part * 1024 + c0); if (!fst) upv[part] = *(const u32x4*)(ur + part * 1024 + c0 - NINP); } }
        { const int tb = w & 3, chf = w >> 2;
          if (tb * 16 < nstage) {
            bf16x8 wf[2][8];
#pragma unroll
            for (int e2 = 0; e2 < 2; ++e2) { const bf16_t* wr = LRW + ((size_t)h * 64 + (chf * 2 + e2) * 16 + r) * 256 + q * 8;
#pragma unroll
                for (int ks = 0; ks < 8; ++ks) wf[e2][ks] = *(const bf16x8*)(wr + ks * 32); }
            __builtin_amdgcn_sched_barrier(0);
#pragma unroll
            for (int e2 = 0; e2 < 2; ++e2) { const int cb = chf * 2 + e2; f32x4 dw = (f32x4){0.f, 0.f, 0.f, 0.f}, da = dw, dg = dw;
#pragma unroll
                for (int ks = 0; ks < 2; ++ks) { dw = mma16(wf[e2][ks], af[ks], dw); da = mma16(wf[e2][2 + ks], af[2 + ks], da); }
#pragma unroll
                for (int ks = 0; ks < 4; ++ks) dg = mma16(wf[e2][4 + ks], af[4 + ks], dg);
                const int o = (tb * 16 + r) * 68 + cb * 16 + q * 4;
                *(LAS f32x4*)(pre_l + o) = dw; *(LAS f32x4*)(pre_l + 64 * 68 + o) = da; *(LAS f32x4*)(pre_l + 2 * 64 * 68 + o) = dg; } } }
        __syncthreads();
        float rr[8], k2[8], kap[8], bet[8], nlw[8];
        { float vx[8], gg[8], kkr[8]; float ss = 0.f, rk = 0.f;
          if (t < ntok) {
            const size_t row = (size_t)(row0 + t); const bf16_t* ur = U + row * NINP + U_RU; const bool fst = (t == 0 && seq_first);
            float kx[8];
#pragma unroll
            for (int part = 0; part < 3; ++part) { const int cc = part * 1024 + c0; float x[8], p[8];
                unpack8(ux[part], x);
                if (!fst) unpack8(upv[part], p);
                else {
#pragma unroll
                    for (int j = 0; j < 8; ++j) p[j] = sh ? sh[cc + j] : 0.f; }
                const f32x4 mA = *(const f32x4*)(mu + cc), mB = *(const f32x4*)(mu + cc + 4);
#pragma unroll
                for (int j = 0; j < 8; ++j) { const float xm = x[j] + (p[j] - x[j]) * (j < 4 ? mA[j] : mB[j - 4]); if (part == 0) rr[j] = xm; else if (part == 1) kx[j] = xm; else vx[j] = xm; } }
            float pw[8], pa[8], pkk[8], pka[8], prk[8];
#pragma unroll
            for (int hf = 0; hf < 2; ++hf) { const f32x4 v0 = *(const f32x4*)(w0 + c0 + hf * 4), v1 = *(const f32x4*)(a0 + c0 + hf * 4), v2 = *(const f32x4*)(k_k + c0 + hf * 4), v3 = *(const f32x4*)(k_a + c0 + hf * 4), v4 = *(const f32x4*)(r_k + c0 + hf * 4);
#pragma unroll
                for (int j = 0; j < 4; ++j) { pw[hf * 4 + j] = v0[j]; pa[hf * 4 + j] = v1[j]; pkk[hf * 4 + j] = v2[j]; pka[hf * 4 + j] = v3[j]; prk[hf * 4 + j] = v4[j]; } }
            float lwp[8], app[8];
#pragma unroll
            for (int hf = 0; hf < 2; ++hf) { const f32x4 v0 = *(const LAS f32x4*)(pre_l + t * 68 + cg * 8 + hf * 4), v1 = *(const LAS f32x4*)(pre_l + 64 * 68 + t * 68 + cg * 8 + hf * 4), v2 = *(const LAS f32x4*)(pre_l + 2 * 64 * 68 + t * 68 + cg * 8 + hf * 4);
#pragma unroll
                for (int j = 0; j < 4; ++j) { lwp[hf * 4 + j] = v0[j]; app[hf * 4 + j] = v1[j]; gg[hf * 4 + j] = v2[j]; } }
#pragma unroll
            for (int j = 0; j < 8; ++j) {
                const float lw = -softplus_fast(-(pw[j] + lwp[j])) - 0.5f; nlw[j] = -__expf(lw); const float av = sigmoidf_(pa[j] + app[j]);
                kkr[j] = kx[j] * pkk[j]; ss += kkr[j] * kkr[j]; k2[j] = kx[j] * (1.0f + (av - 1.0f) * pka[j]); rk += rr[j] * k2[j] * prk[j]; bet[j] = av; }
          } else {
#pragma unroll
            for (int j = 0; j < 8; ++j) { rr[j] = 0.f; k2[j] = 0.f; kkr[j] = 0.f; bet[j] = 0.f; nlw[j] = 0.f; vx[j] = 0.f; gg[j] = 0.f; }
          }
          ss += __shfl_xor(ss, 1, 64); ss += __shfl_xor(ss, 2, 64); ss += __shfl_xor(ss, 4, 64);
          rk += __shfl_xor(rk, 1, 64); rk += __shfl_xor(rk, 2, 64); rk += __shfl_xor(rk, 4, 64);
          const float inv = 1.0f / fmaxf(sqrtf(ss), 1e-12f);
#pragma unroll
          for (int j = 0; j < 8; ++j) { kap[j] = kkr[j] * inv; bet[j] = kap[j] * bet[j]; }
          if (t < ntok) { const size_t o = (size_t)(row0 + t) * BW + c0;
              *(u32x4*)(Gg + o) = (u32x4){pk2(gg[0], gg[1]), pk2(gg[2], gg[3]), pk2(gg[4], gg[5]), pk2(gg[6], gg[7])};
              *(u32x4*)(BON + o) = (u32x4){pk2(rk * vx[0], rk * vx[1]), pk2(rk * vx[2], rk * vx[3]), pk2(rk * vx[4], rk * vx[5]), pk2(rk * vx[6], rk * vx[7])}; }
          *(LAS f32x4*)(lg_l + t * 68 + cg * 8) = (f32x4){nlw[0], nlw[1], nlw[2], nlw[3]}; *(LAS f32x4*)(lg_l + t * 68 + cg * 8 + 4) = (f32x4){nlw[4], nlw[5], nlw[6], nlw[7]};
#pragma unroll
          for (int j = 0; j < 8; ++j) VT_l[(cg * 8 + j) * 72 + t] = f2bf(vx[j]);
        }
        __syncthreads();
        if (tid < 256) { const int cc = tid & 63, s4 = tid >> 6; float vv[16];
#pragma unroll
            for (int i = 0; i < 16; ++i) vv[i] = lg_l[(s4 * 16 + i) * 68 + cc];
            float run = 0.f;
#pragma unroll
            for (int i = 0; i < 16; ++i) { run += vv[i]; lg_l[(s4 * 16 + i) * 68 + cc] = run; } }
        __syncthreads();
        { unsigned pp[4], pq[4], pk[4], pb[4];
#pragma unroll
          for (int j = 0; j < 8; j += 2) { float vP[2], vQ[2], vK[2], vB[2];
#pragma unroll
              for (int e = 0; e < 2; ++e) { const int jj = j + e, cc = cg * 8 + jj; const float ci = lg_l[t * 68 + cc], cC = lg_l[(sc * 16 + 15) * 68 + cc];
                  const float ei = __expf(-ci), eh = __expf(cC - ci);
                  vP[e] = kap[jj] * __expf(ci - nlw[jj]); vQ[e] = rr[jj] * __expf(ci); vK[e] = k2[jj] * ei; vB[e] = bet[jj] * ei;
                  PT_l[cc * 72 + t] = f2bf(vP[e]); BhT_l[cc * 72 + t] = f2bf(bet[jj] * eh); KhT_l[cc * 72 + t] = f2bf(k2[jj] * eh); }
              pp[j >> 1] = pk2(vP[0], vP[1]); pq[j >> 1] = pk2(vQ[0], vQ[1]); pk[j >> 1] = pk2(vK[0], vK[1]); pb[j >> 1] = pk2(vB[0], vB[1]); }
          const int o = t * 72 + cg * 8;
          *(LAS u32x4*)(P_l + o) = (u32x4){pp[0], pp[1], pp[2], pp[3]}; *(LAS u32x4*)(Q_l + o) = (u32x4){pq[0], pq[1], pq[2], pq[3]};
          *(LAS u32x4*)(Kn_l + o) = (u32x4){pk[0], pk[1], pk[2], pk[3]}; *(LAS u32x4*)(Bn_l + o) = (u32x4){pb[0], pb[1], pb[2], pb[3]};
          if ((t & 15) == 15) {
#pragma unroll
              for (int j = 0; j < 8; ++j) GC_l[sc * 64 + cg * 8 + j] = __expf(lg_l[t * 68 + cg * 8 + j]); } }
        __syncthreads();
        const int nsub = ntok == 64 ? 4 : 1;
        const bf16x8 zfrag = (bf16x8){0, 0, 0, 0, 0, 0, 0, 0};
        { const int s4 = w & 3, hf = w >> 2;
          if (s4 < nsub) { const int ro = (s4 * 16 + r) * 72 + q * 8;
            if (hf == 0) {
                const bf16x8 b0 = *(const LAS bf16x8*)(Bn_l + ro), b1 = *(const LAS bf16x8*)(Bn_l + ro + 32), p0 = *(const LAS bf16x8*)(P_l + ro), p1 = *(const LAS bf16x8*)(P_l + ro + 32),
                             q0 = *(const LAS bf16x8*)(Q_l + ro), q1 = *(const LAS bf16x8*)(Q_l + ro + 32);
                __builtin_amdgcn_sched_barrier(0);
                f32x4 da = (f32x4){0.f, 0.f, 0.f, 0.f}, df = da; da = mma16(b0, p0, da); df = mma16(b0, q0, df); da = mma16(b1, p1, da); df = mma16(b1, q1, df);
                f32x4 o4; float f4[4];
#pragma unroll
                for (int jj = 0; jj < 4; ++jj) { o4[jj] = (q * 4 + jj < r) ? da[jj] : 0.f; f4[jj] = (q * 4 + jj <= r) ? df[jj] : 0.f; }
                *(LAS f32x4*)(A_l + s4 * 320 + r * 20 + q * 4) = o4;
                u32x2 o; o.x = pk2(f4[0], f4[1]); o.y = pk2(f4[2], f4[3]); *(LAS u32x2*)(F_l + s4 * 384 + r * 24 + q * 4) = o;
            } else {
                const bf16x8 p0 = *(const LAS bf16x8*)(P_l + ro), p1 = *(const LAS bf16x8*)(P_l + ro + 32), k0 = *(const LAS bf16x8*)(Kn_l + ro), k1 = *(const LAS bf16x8*)(Kn_l + ro + 32);
                __builtin_amdgcn_sched_barrier(0);
                f32x4 d = (f32x4){0.f, 0.f, 0.f, 0.f}; d = mma16(p0, k0, d); d = mma16(p1, k1, d);
                float o4[4];
#pragma unroll
                for (int jj = 0; jj < 4; ++jj) o4[jj] = (r < q * 4 + jj) ? d[jj] : 0.f;
                u32x2 o; o.x = pk2(o4[0], o4[1]); o.y = pk2(o4[2], o4[3]); *(LAS u32x2*)(BmT_l + s4 * 384 + r * 24 + q * 4) = o;
            } } }
        __syncthreads();
        if (w == 0 && (lane >> 4) < nsub) { const int s4 = lane >> 4, jc = lane & 15; float x[16];
#pragma unroll
            for (int tt = 0; tt < 16; ++tt) { float s = (tt == jc) ? 1.f : 0.f;
#pragma unroll
                for (int i = 0; i < tt; ++i) s -= A_l[s4 * 320 + tt * 20 + i] * x[i];
                x[tt] = s; }
#pragma unroll
            for (int tt = 0; tt < 16; ++tt) Tinv_l[s4 * 384 + tt * 24 + jc] = f2bf(x[tt]); }
        __syncthreads();
        { const int s4 = w & 3, hf = w >> 2;
          if (s4 < nsub) {
            const bf16x8 xf = q < 2 ? *(const LAS bf16x8*)(Tinv_l + s4 * 384 + r * 24 + q * 8) : zfrag;
            const bf16x8 y0 = q < 2 ? *(const LAS bf16x8*)(PT_l + ((hf * 2) * 16 + r) * 72 + s4 * 16 + q * 8) : zfrag, y1 = q < 2 ? *(const LAS bf16x8*)(PT_l + ((hf * 2 + 1) * 16 + r) * 72 + s4 * 16 + q * 8) : zfrag;
            const bf16x8 y2 = (q < 2 && hf == 0) ? *(const LAS bf16x8*)(BmT_l + s4 * 384 + r * 24 + q * 8) : zfrag;
            __builtin_amdgcn_sched_barrier(0);
            const f32x4 z4 = (f32x4){0.f, 0.f, 0.f, 0.f};
            const f32x4 d0 = mma16(xf, y0, z4), d1 = mma16(xf, y1, z4);
            u32x2 o; o.x = pk2(d0[0], d0[1]); o.y = pk2(d0[2], d0[3]); *(LAS u32x2*)(PpT_l + ((hf * 2) * 16 + r) * 72 + s4 * 16 + q * 4) = o;
            o.x = pk2(d1[0], d1[1]); o.y = pk2(d1[2], d1[3]); *(LAS u32x2*)(PpT_l + ((hf * 2 + 1) * 16 + r) * 72 + s4 * 16 + q * 4) = o;
            if (hf == 0) { const f32x4 d2 = mma16(xf, y2, z4); o.x = pk2(d2[0], d2[1]); o.y = pk2(d2[2], d2[3]); *(LAS u32x2*)(BmpT_l + s4 * 384 + r * 24 + q * 4) = o; } } }
        __syncthreads();
        { const int chunk0 = sq >= 0 ? PB * 16 * 256 + sq * 16 + h : ((row0 / PS) * 16 + h) * 256 + ((row0 % PS) >> 4);
          { const int s4 = w & 3, hf = w >> 2;
            if (s4 < nsub) { bf16_t* blob = RB + (size_t)(chunk0 + s4) * RB_EL;
              bf16x8 pp[4], bhm[2], fF = zfrag, bmp = zfrag, x4[4];
#pragma unroll
              for (int i = 0; i < 4; ++i) pp[i] = zfrag;
              bhm[0] = zfrag; bhm[1] = zfrag;
              if (q < 2) {
#pragma unroll
                  for (int i = 0; i < 4; ++i) pp[i] = *(const LAS bf16x8*)(PpT_l + (i * 16 + r) * 72 + s4 * 16 + q * 8);
#pragma unroll
                  for (int i = 0; i < 2; ++i) bhm[i] = *(const LAS bf16x8*)(BhT_l + ((hf * 2 + i) * 16 + r) * 72 + s4 * 16 + q * 8);
                  fF = *(const LAS bf16x8*)(F_l + s4 * 384 + r * 24 + q * 8); bmp = *(const LAS bf16x8*)(BmpT_l + s4 * 384 + r * 24 + q * 8); }
              if (hf == 0) {
#pragma unroll
                  for (int ks = 0; ks < 2; ++ks) { x4[ks] = *(const LAS bf16x8*)(Kn_l + (s4 * 16 + r) * 72 + ks * 32 + q * 8); x4[2 + ks] = *(const LAS bf16x8*)(Q_l + (s4 * 16 + r) * 72 + ks * 32 + q * 8); }
              } else {
#pragma unroll
                  for (int i = 0; i < 4; ++i) x4[i] = q < 2 ? *(const LAS bf16x8*)(BhT_l + (i * 16 + r) * 72 + s4 * 16 + q * 8) : zfrag;
              }
              __builtin_amdgcn_sched_barrier(0);
              const f32x4 z4 = (f32x4){0.f, 0.f, 0.f, 0.f};
              f32x4 dx[4];
              f32x4 d2 = z4, d1 = z4;
              if (hf == 0) {
#pragma unroll
                  for (int j = 0; j < 4; ++j) dx[j] = mma16(pp[j], fF, z4);
                  d2 = mma16(x4[0], x4[2], d2); d2 = mma16(x4[1], x4[3], d2);
                  d1 = mma16(bmp, fF, z4);
              } else {
#pragma unroll
                  for (int j = 0; j < 4; ++j) dx[j] = mma16(bmp, x4[j], z4);
              }
#pragma unroll
              for (int i = 0; i < 2; ++i) { const int cob = hf * 2 + i; const float gc = GC_l[s4 * 64 + cob * 16 + r]; f32x4 dm[4];
#pragma unroll
                  for (int j = 0; j < 4; ++j) dm[j] = mma16(pp[j], bhm[i], z4);
#pragma unroll
                  for (int cp = 0; cp < 2; ++cp) { float o8[8];
#pragma unroll
                      for (int e2 = 0; e2 < 2; ++e2) { const int cib = cp * 2 + e2;
#pragma unroll
                          for (int jj = 0; jj < 4; ++jj) o8[e2 * 4 + jj] = ((cib == cob && q * 4 + jj == r) ? gc : 0.f) - dm[cib][jj]; }
                      *(u32x4*)(blob + (cob * 16 + r) * 64 + (((4 * cp + q) ^ ((r >> 1) & 7)) * 8)) = (u32x4){pk2(o8[0], o8[1]), pk2(o8[2], o8[3]), pk2(o8[4], o8[5]), pk2(o8[6], o8[7])}; } }
              if (hf == 0) {
#pragma unroll
                  for (int cp = 0; cp < 2; ++cp) {
                      const u32x2 qa = *(const LAS u32x2*)(Q_l + (s4 * 16 + r) * 72 + (cp * 2) * 16 + q * 4), qb = *(const LAS u32x2*)(Q_l + (s4 * 16 + r) * 72 + (cp * 2 + 1) * 16 + q * 4);
                      const f32x4 da = dx[cp * 2], db = dx[cp * 2 + 1];
                      *(u32x4*)(blob + RB_QP + r * 64 + (((4 * cp + q) ^ ((r >> 1) & 7)) * 8)) = (u32x4){
                          pk2(__uint_as_float(qa.x << 16) - da[0], __uint_as_float(qa.x & 0xffff0000u) - da[1]), pk2(__uint_as_float(qa.y << 16) - da[2], __uint_as_float(qa.y & 0xffff0000u) - da[3]),
                          pk2(__uint_as_float(qb.x << 16) - db[0], __uint_as_float(qb.x & 0xffff0000u) - db[1]), pk2(__uint_as_float(qb.y << 16) - db[2], __uint_as_float(qb.y & 0xffff0000u) - db[3])}; }
                  float o4[4];
#pragma unroll
                  for (int jj = 0; jj < 4; ++jj) o4[jj] = ((q * 4 + jj <= r) ? d2[jj] : 0.f) - d1[jj];
                  u32x2 o; o.x = pk2(o4[0], o4[1]); o.y = pk2(o4[2], o4[3]); *(u32x2*)(blob + RB_EP + r * 16 + q * 4) = o;
              } else {
#pragma unroll
                  for (int cb = 0; cb < 4; ++cb) { const u32x2 kv = *(const LAS u32x2*)(KhT_l + (cb * 16 + r) * 72 + s4 * 16 + q * 4); const f32x4 d = dx[cb];
                      u32x2 o; o.x = pk2(__uint_as_float(kv.x << 16) - d[0], __uint_as_float(kv.x & 0xffff0000u) - d[1]); o.y = pk2(__uint_as_float(kv.y << 16) - d[2], __uint_as_float(kv.y & 0xffff0000u) - d[3]);
                      *(u32x2*)(blob + RB_KHP + (cb * 16 + r) * 16 + q * 4) = o; }
              } } }
          for (int idx = tid; idx < nsub * 128; idx += 512) { const int s4 = idx >> 7, cc = (idx >> 1) & 63, hf = idx & 1;
              *(u32x4*)(RB + (size_t)(chunk0 + s4) * RB_EL + RB_VT + cc * 16 + hf * 8) = *(const LAS u32x4*)(VT_l + cc * 72 + s4 * 16 + hf * 8); } }
        __syncthreads();
        }
    }
}

__device__ __forceinline__ void ph_rwkv_scan_naive(const Ctx& c, const float* __restrict__ RW, const float* __restrict__ s0, const float* __restrict__ lng, const float* __restrict__ lnb, bf16_t* __restrict__ OB,
                                                   float* __restrict__ outP, float* __restrict__ outS) {
    const float* R = RW; const float* WD = RW + (size_t)MPAD * BW; const float* K2 = WD + (size_t)MPAD * BW; const float* V = K2 + (size_t)MPAD * BW; const float* KK = V + (size_t)MPAD * BW;
    const float* BV = KK + (size_t)MPAD * BW; const float* G = BV + (size_t)MPAD * BW; const float* BON = G + (size_t)MPAD * BW;
    const int lane = c.lane;
    for (int it = 0;; ++it) {
        const int u = (it * 8 + c.wave) * c.G + c.bid;
        if (u >= (PB + SB) * 16) break;
        const int sq = u >> 4, h = u & 15;
        int row0, L; seq_info(sq, row0, L);
        float S[64];
        if (sq >= PB) { const float* p = s0 + (((size_t)(sq - PB) * 16 + h) * 64 + lane) * 64;
#pragma unroll
            for (int j = 0; j < 64; ++j) S[j] = p[j]; }
        else {
#pragma unroll
            for (int j = 0; j < 64; ++j) S[j] = 0.f; }
        const float lg = lng[h * 64 + lane], lb = lnb[h * 64 + lane];
        for (int t = 0; t < L; ++t) {
            const size_t base = (size_t)(row0 + t) * BW + h * 64; const float v = V[base + lane];
            float d = 0.f;
#pragma unroll
            for (int j = 0; j < 64; ++j) d += S[j] * KK[base + j];
            float y = 0.f;
#pragma unroll
            for (int j = 0; j < 64; ++j) { S[j] = S[j] * WD[base + j] - d * BV[base + j] + v * K2[base + j]; y += S[j] * R[base + j]; }
            const float mean = wave_sum(y) * (1.0f / 64.0f), dy = y - mean, var = wave_sum(dy * dy) * (1.0f / 64.0f);
            const float yn = dy * rsqrtf(var + 64e-5f) * lg + lb;
            OB[base + lane] = f2bf((yn + BON[base + lane]) * G[base + lane]);
        }
        float* op = (sq < PB ? outP + (((size_t)sq * 16 + h) * 64 + lane) * 64 : outS + (((size_t)(sq - PB) * 16 + h) * 64 + lane) * 64);
#pragma unroll
        for (int j = 0; j < 64; ++j) op[j] = S[j];
    }
}
__device__ __forceinline__ void ph_rwkv_scan2(const Ctx& c, int boff, const float* __restrict__ RW, const float* __restrict__ s0, const float* __restrict__ lng, const float* __restrict__ lnb, bf16_t* __restrict__ OB,
                                              float* __restrict__ outP, float* __restrict__ outS) {
    LAS float* opb = (LAS float*)c.lds;
    LAS float* yb = opb + 2 * 16 * 384;
    const int tid = c.tid, lane = c.lane, w = c.wave, rl = lane >> 3, cg = lane & 7, vrow = w * 8 + rl;
    const float* G = RW + 6 * (size_t)MPAD * BW; const float* BON = RW + 7 * (size_t)MPAD * BW;
    for (int u = (c.bid - boff + c.G) % c.G; u < (PB + SB) * 16; u += c.G) {
        const int sq = u >> 4, h = u & 15;
        int row0, L; seq_info(sq, row0, L);
        float S[8];
        if (sq >= PB) { const float* p = s0 + (((size_t)(sq - PB) * 16 + h) * 64 + vrow) * 64 + cg * 8;
#pragma unroll
            for (int j = 0; j < 8; ++j) S[j] = p[j]; }
        else {
#pragma unroll
            for (int j = 0; j < 8; ++j) S[j] = 0.f; }
        const float lg = lng[h * 64 + lane], lb = lnb[h * 64 + lane];
        const int nb = (L + 15) >> 4;
#define RW_STAGE(bi_) do { const int t0_ = (bi_) * 16, nT_ = (L - t0_) < 16 ? (L - t0_) : 16; LAS float* dst_ = opb + ((bi_) & 1) * 16 * 384; \
        for (int idx = tid; idx < nT_ * 96; idx += 512) { const int t = idx / 96, rem = idx - t * 96, slot = rem >> 4, c4 = rem & 15; \
            const int arr = slot == 0 ? 1 : slot == 1 ? 4 : slot == 2 ? 5 : slot == 3 ? 2 : slot == 4 ? 0 : 3; \
            *(LAS f32x4*)(dst_ + t * 384 + slot * 64 + c4 * 4) = *(const f32x4*)(RW + (size_t)arr * MPAD * BW + (size_t)(row0 + t0_ + t) * BW + h * 64 + c4 * 4); } } while (0)
        RW_STAGE(0);
        for (int bi = 0; bi < nb; ++bi) {
            __syncthreads();
            if (bi + 1 < nb) RW_STAGE(bi + 1);
            const int t0 = bi * 16, nT = (L - t0) < 16 ? (L - t0) : 16; const LAS float* src = opb + (bi & 1) * 16 * 384;
            for (int tt = 0; tt < nT; ++tt) {
                const LAS float* b = src + tt * 384 + cg * 8;
                const f32x4 w0 = *(const LAS f32x4*)(b), w1 = *(const LAS f32x4*)(b + 4), k0 = *(const LAS f32x4*)(b + 64), k1 = *(const LAS f32x4*)(b + 68);
                const f32x4 b0 = *(const LAS f32x4*)(b + 128), b1 = *(const LAS f32x4*)(b + 132), q0 = *(const LAS f32x4*)(b + 192), q1 = *(const LAS f32x4*)(b + 196);
                const f32x4 r0 = *(const LAS f32x4*)(b + 256), r1 = *(const LAS f32x4*)(b + 260); const float v = src[tt * 384 + 320 + vrow];
                float d = (S[0] * k0[0] + S[1] * k0[1]) + (S[2] * k0[2] + S[3] * k0[3]) + (S[4] * k1[0] + S[5] * k1[1]) + (S[6] * k1[2] + S[7] * k1[3]);
                d += __shfl_xor(d, 1, 64); d += __shfl_xor(d, 2, 64); d += __shfl_xor(d, 4, 64);
                float y = 0.f;
#pragma unroll
                for (int j = 0; j < 4; ++j) { S[j] = S[j] * w0[j] - d * b0[j] + v * q0[j]; y += S[j] * r0[j]; S[4 + j] = S[4 + j] * w1[j] - d * b1[j] + v * q1[j]; y += S[4 + j] * r1[j]; }
                y += __shfl_xor(y, 1, 64); y += __shfl_xor(y, 2, 64); y += __shfl_xor(y, 4, 64);
                if (cg == 0) yb[tt * 64 + vrow] = y;
            }
            __syncthreads();
            for (int tt = w; tt < nT; tt += 8) {
                const float y = yb[tt * 64 + lane]; const float mean = wave_sum(y) * (1.0f / 64.0f), dy = y - mean, var = wave_sum(dy * dy) * (1.0f / 64.0f);
                const float yn = dy * rsqrtf(var + 64e-5f) * lg + lb; const size_t o = (size_t)(row0 + t0 + tt) * BW + h * 64 + lane;
                OB[o] = f2bf((yn + BON[o]) * G[o]);
            }
        }
#undef RW_STAGE
        float* op = (sq < PB ? outP + (((size_t)sq * 16 + h) * 64 + vrow) * 64 : outS + (((size_t)(sq - PB) * 16 + h) * 64 + vrow) * 64) + cg * 8;
#pragma unroll
        for (int j = 0; j < 8; ++j) op[j] = S[j];
        __syncthreads();
    }
}
constexpr int RS_SLOTS = 10, RS_SLOT_B = 15360;
__device__ __forceinline__ void ph_rwkv_seq(const Ctx& c, int boff, const bf16_t* __restrict__ RB, const float* __restrict__ s0, float* __restrict__ outP, float* __restrict__ outS, bf16_t* __restrict__ OB) {
    const int lane = c.lane, r = lane & 15, q = lane >> 4, w = c.wave;
    LAS unsigned char* ring = c.lds;
    const int side = c.bid < 32 ? c.bid : c.bid - 64, nside = c.G - 64;
    for (int u = (c.bid >= boff && c.bid < boff + 32) ? c.bid - boff : ((c.bid < 32 || c.bid >= 96) ? 32 + side : (PB + SB) * 16); u < (PB + SB) * 16; u = u < 32 ? (PB + SB) * 16 : u + nside) {
        const int sq = u >> 4, h = u & 15;
        int nch, ch0, row0, ntok; const float* sp = nullptr; float* op;
        if (sq < PB) { nch = 256; ch0 = (sq * 16 + h) * 256; row0 = sq * PS; ntok = 16; op = outP + (size_t)(sq * 16 + h) * 4096; }
        else { nch = 1; ch0 = PB * 16 * 256 + (sq - PB) * 16 + h; row0 = MP + (sq - PB) * SS; ntok = SS; sp = s0 + (size_t)((sq - PB) * 16 + h) * 4096; op = outS + (size_t)((sq - PB) * 16 + h) * 4096; }
        if (w >= 4) {
            const int lw = w - 4, p0 = lw * 4, np = lw < 3 ? 4 : 3;
#define RS_ISSUE(ci_) do { const int cc_ = (ci_) < nch ? (ci_) : nch - 1; const char* g_ = (const char*)(RB + (size_t)(ch0 + cc_) * RB_EL) + p0 * 1024 + lane * 16; \
            LAS unsigned char* d_ = ring + ((ci_) % RS_SLOTS) * RS_SLOT_B + p0 * 1024; \
            _Pragma("unroll") for (int p_ = 0; p_ < 4; ++p_) if (p_ < np) __builtin_amdgcn_global_load_lds((const unsigned*)(g_ + p_ * 1024), (LAS unsigned*)(d_ + p_ * 1024), 16, 0, 0); } while (0)
            for (int ci = 0; ci < RS_SLOTS - 1; ++ci) RS_ISSUE(ci);
            if (lw < 3) asm volatile("s_waitcnt vmcnt(32)" ::: "memory"); else asm volatile("s_waitcnt vmcnt(24)" ::: "memory");
            __builtin_amdgcn_s_barrier();
            for (int ci = 0; ci < nch; ++ci) {
                RS_ISSUE(ci + RS_SLOTS - 1);
                if (lw < 3) asm volatile("s_waitcnt vmcnt(32)" ::: "memory"); else asm volatile("s_waitcnt vmcnt(24)" ::: "memory");
                __builtin_amdgcn_s_barrier();
            }
#undef RS_ISSUE
            asm volatile("s_waitcnt vmcnt(0)" ::: "memory");
        } else {
            const int vb = w, sw = (r >> 1) & 7; f32x4 acc[4];
#pragma unroll
            for (int kb = 0; kb < 4; ++kb) acc[kb] = sp ? *(const f32x4*)(sp + (size_t)(vb * 16 + r) * 64 + kb * 16 + q * 4) : (f32x4){0.f, 0.f, 0.f, 0.f};
            const bf16x8 zfrag = (bf16x8){0, 0, 0, 0, 0, 0, 0, 0};
            __builtin_amdgcn_s_barrier();
            for (int ci = 0; ci < nch; ++ci) {
                const LAS bf16_t* blob = (const LAS bf16_t*)(ring + (ci % RS_SLOTS) * RS_SLOT_B);
                bf16x8 mf[4][2], khf[4], qpf[2];
#pragma unroll
                for (int kb = 0; kb < 4; ++kb) { mf[kb][0] = *(const LAS bf16x8*)(blob + (kb * 16 + r) * 64 + ((q ^ sw) * 8)); mf[kb][1] = *(const LAS bf16x8*)(blob + (kb * 16 + r) * 64 + (((4 + q) ^ sw) * 8));
                    khf[kb] = q < 2 ? *(const LAS bf16x8*)(blob + RB_KHP + (kb * 16 + r) * 16 + q * 8) : zfrag; }
                qpf[0] = *(const LAS bf16x8*)(blob + RB_QP + r * 64 + ((q ^ sw) * 8)); qpf[1] = *(const LAS bf16x8*)(blob + RB_QP + r * 64 + (((4 + q) ^ sw) * 8));
                const bf16x8 vt = q < 2 ? *(const LAS bf16x8*)(blob + RB_VT + (vb * 16 + r) * 16 + q * 8) : zfrag;
                const bf16x8 ep = q < 2 ? *(const LAS bf16x8*)(blob + RB_EP + r * 16 + q * 8) : zfrag;
                const bf16x8 t0 = pack_acc(acc[0], acc[1]), t1 = pack_acc(acc[2], acc[3]);
                __builtin_amdgcn_sched_barrier(0);
#pragma unroll
                for (int kb = 0; kb < 4; ++kb) acc[kb] = mma16(mf[kb][0], t0, (f32x4){0.f, 0.f, 0.f, 0.f});
#pragma unroll
                for (int kb = 0; kb < 4; ++kb) acc[kb] = mma16(mf[kb][1], t1, acc[kb]);
#pragma unroll
                for (int kb = 0; kb < 4; ++kb) acc[kb] = mma16(khf[kb], vt, acc[kb]);
                f32x4 y = mma16(t0, qpf[0], (f32x4){0.f, 0.f, 0.f, 0.f}); y = mma16(t1, qpf[1], y); y = mma16(vt, ep, y);
                if (r < ntok) { u32x2 o; o.x = pk2(y[0], y[1]); o.y = pk2(y[2], y[3]); *(u32x2*)(OB + (size_t)(row0 + ci * 16 + r) * BW + h * 64 + vb * 16 + q * 4) = o; }
                asm volatile("s_waitcnt lgkmcnt(0)" ::: "memory");
                __builtin_amdgcn_s_barrier();
            }
#pragma unroll
            for (int kb = 0; kb < 4; ++kb) *(f32x4*)(op + (size_t)(vb * 16 + r) * 64 + kb * 16 + q * 4) = acc[kb];
        }
        __syncthreads();
    }
}
__device__ __forceinline__ void ph_rwkv_fin(const Ctx& c, const float* __restrict__ RW, const float* __restrict__ lng, const float* __restrict__ lnb, const bf16_t* __restrict__ RAW, bf16_t* __restrict__ OB) {
    const int lane = c.lane; const bf16_t* G = (const bf16_t*)(RW + 6 * (size_t)MPAD * BW); const bf16_t* BON = (const bf16_t*)(RW + 7 * (size_t)MPAD * BW);
    for (int i = c.bid * 8 + c.wave; i < MT * 2; i += c.G * 8) {
        const int row = i >> 1, cc = (i & 1) * 512 + lane * 8; const size_t o = (size_t)row * BW + cc;
        float x[8], bo[8], gt[8]; unpack8(*(const u32x4*)(RAW + o), x); unpack8(*(const u32x4*)(BON + o), bo); unpack8(*(const u32x4*)(G + o), gt);
        float s = 0.f;
#pragma unroll
        for (int j = 0; j < 8; ++j) s += x[j];
        s += __shfl_xor(s, 1, 64); s += __shfl_xor(s, 2, 64); s += __shfl_xor(s, 4, 64);
        const float mean = s * (1.0f / 64.0f); float qq = 0.f;
#pragma unroll
        for (int j = 0; j < 8; ++j) { const float d = x[j] - mean; qq += d * d; }
        qq += __shfl_xor(qq, 1, 64); qq += __shfl_xor(qq, 2, 64); qq += __shfl_xor(qq, 4, 64);
        const float rstd = rsqrtf(qq * (1.0f / 64.0f) + 64e-5f);
        const f32x4 g0 = *(const f32x4*)(lng + cc), g1 = *(const f32x4*)(lng + cc + 4), b0 = *(const f32x4*)(lnb + cc), b1 = *(const f32x4*)(lnb + cc + 4); float ov[8];
#pragma unroll
        for (int j = 0; j < 8; ++j) ov[j] = ((x[j] - mean) * rstd * (j < 4 ? g0[j] : g1[j - 4]) + (j < 4 ? b0[j] : b1[j - 4]) + bo[j]) * gt[j];
        *(u32x4*)(OB + o) = (u32x4){pk2(ov[0], ov[1]), pk2(ov[2], ov[3]), pk2(ov[4], ov[5]), pk2(ov[6], ov[7])};
    }
}

__device__ __forceinline__ void ph_memattn_sample(const Ctx& c, int boff, const bf16_t* __restrict__ U, const float* __restrict__ mk, const float* __restrict__ mv, bf16_t* __restrict__ OB) {
    LAS float* ps = (LAS float*)c.lds;
    const int hh = c.tid >> 8, vt = c.tid & 255, lane = c.lane, r = lane & 15, q = lane >> 4, w4 = c.wave & 3;
    for (int u = (c.bid - boff + c.G) % c.G; u < SB * 2; u += c.G) {
        const int sq = u >> 1, h = (u & 1) * 2 + hh;
        bf16x8 qf[8];
#pragma unroll
        for (int ks = 0; ks < 8; ++ks) { u32x4 raw = (u32x4){0u, 0u, 0u, 0u};
            if (r < 4) raw = *(const u32x4*)(U + (size_t)(MP + sq * SS + r) * NINP + U_MQ + h * 256 + ks * 32 + q * 8);
            qf[ks] = __builtin_bit_cast(bf16x8, raw); }
#pragma unroll 1
        for (int mt = 0; mt < 4; ++mt) { const float* kr = mk + (((size_t)sq * MEMT + (w4 * 4 + mt) * 16 + r) * 4 + h) * 256 + q * 8; f32x4 ka[8], kb2[8];
#pragma unroll
            for (int ks = 0; ks < 8; ++ks) { ka[ks] = *(const f32x4*)(kr + ks * 32); kb2[ks] = *(const f32x4*)(kr + ks * 32 + 4); }
            __builtin_amdgcn_sched_barrier(0);
            f32x4 d = (f32x4){0.f, 0.f, 0.f, 0.f};
#pragma unroll
            for (int ks = 0; ks < 8; ++ks) { u32x4 p; p.x = pk2(ka[ks][0], ka[ks][1]); p.y = pk2(ka[ks][2], ka[ks][3]); p.z = pk2(kb2[ks][0], kb2[ks][1]); p.w = pk2(kb2[ks][2], kb2[ks][3]);
                d = mma16(__builtin_bit_cast(bf16x8, p), qf[ks], d); }
            if (r < 4) *(LAS f32x4*)(ps + (hh * 4 + r) * 256 + (w4 * 4 + mt) * 16 + q * 4) = d * 0.0625f; }
        __syncthreads();
        { LAS float* pr = ps + c.wave * 256; float x[4]; float mx = -3.0e38f;
#pragma unroll
            for (int j = 0; j < 4; ++j) { x[j] = pr[lane + 64 * j]; mx = fmaxf(mx, x[j]); }
            mx = wave_max(mx); float s = 0.f;
#pragma unroll
            for (int j = 0; j < 4; ++j) { x[j] = __expf(x[j] - mx); s += x[j]; }
            const float inv = 1.0f / wave_sum(s);
#pragma unroll
            for (int j = 0; j < 4; ++j) pr[lane + 64 * j] = x[j] * inv; }
        __syncthreads();
        { float o[4] = {0.f, 0.f, 0.f, 0.f}; const float* vr = mv + ((size_t)sq * MEMT * 4 + h) * 256 + vt;
#pragma unroll 8
            for (int m = 0; m < MEMT; ++m) { const float vv = vr[(size_t)m * 1024];
#pragma unroll
                for (int t = 0; t < 4; ++t) o[t] += ps[(hh * 4 + t) * 256 + m] * vv; }
#pragma unroll
            for (int t = 0; t < 4; ++t) OB[(size_t)(MP + sq * SS + t) * BW + h * 256 + vt] = f2bf(o[t]); }
        __syncthreads();
    }
}

template <int K, int LDA, int LDB> __device__ __forceinline__ void skinny_pair(const Ctx& c, const bf16_t* __restrict__ A, const bf16_t* __restrict__ B0, const bf16_t* __restrict__ B1, f32x4 (&out)[2], int rot) {
    LAS f32x4* red = (LAS f32x4*)c.lds;
    const int lane = c.lane, r = lane & 15, q = lane >> 4, w = c.wave;
    constexpr int KS = K / 8;
    const bf16_t* ap = A + (size_t)r * LDA + w * KS + q * 8; const bf16_t* b0 = B0 + (size_t)r * LDB + w * KS + q * 8; const bf16_t* b1 = B1 + (size_t)r * LDB + w * KS + q * 8;
    f32x4 acc[2][8];
#pragma unroll
    for (int n = 0; n < 2; ++n)
#pragma unroll
        for (int m = 0; m < 8; ++m) acc[n][m] = (f32x4){0.f, 0.f, 0.f, 0.f};
    int kk = (int)((unsigned)rot % (unsigned)(KS / 32));
#pragma unroll 2
    for (int it = 0; it < KS / 32; ++it) { const int ks = kk; kk = kk + 1 == KS / 32 ? 0 : kk + 1;
        const bf16x8 f0 = *(const bf16x8*)(b0 + ks * 32), f1 = *(const bf16x8*)(b1 + ks * 32); bf16x8 af[8];
#pragma unroll
        for (int m = 0; m < 8; ++m) af[m] = *(const bf16x8*)(ap + (size_t)(m * 16) * LDA + ks * 32);
        __builtin_amdgcn_sched_barrier(0);
#pragma unroll
        for (int m = 0; m < 8; ++m) { acc[0][m] = mma16(f0, af[m], acc[0][m]); acc[1][m] = mma16(f1, af[m], acc[1][m]); } }
    __syncthreads();
#pragma unroll
    for (int n = 0; n < 2; ++n)
#pragma unroll
        for (int m = 0; m < 8; ++m) red[(w * 16 + n * 8 + m) * 64 + lane] = acc[n][m];
    __syncthreads();
#pragma unroll
    for (int n = 0; n < 2; ++n) { f32x4 s = red[(n * 8 + w) * 64 + lane];
#pragma unroll
        for (int ww = 1; ww < 8; ++ww) s += red[(ww * 16 + n * 8 + w) * 64 + lane];
        out[n] = s; }
}
template <int K, int LDA, int LDB> __device__ __forceinline__ f32x4 skinny_one(const Ctx& c, const bf16_t* __restrict__ A, const bf16_t* __restrict__ B0, int rot) {
    LAS f32x4* red = (LAS f32x4*)c.lds;
    const int lane = c.lane, r = lane & 15, q = lane >> 4, w = c.wave;
    constexpr int KS = K / 8, NK = KS / 32;
    const bf16_t* ap = A + (size_t)r * LDA + w * KS + q * 8; const bf16_t* b0 = B0 + (size_t)r * LDB + w * KS + q * 8;
    f32x4 acc[8];
#pragma unroll
    for (int m = 0; m < 8; ++m) acc[m] = (f32x4){0.f, 0.f, 0.f, 0.f};
    int kk = (int)((unsigned)rot % (unsigned)NK);
#pragma unroll 4
    for (int it = 0; it < NK; ++it) { const int ks = kk; kk = kk + 1 == NK ? 0 : kk + 1;
        const bf16x8 f0 = *(const bf16x8*)(b0 + ks * 32); bf16x8 af[8];
#pragma unroll
        for (int m = 0; m < 8; ++m) af[m] = *(const bf16x8*)(ap + (size_t)(m * 16) * LDA + ks * 32);
        __builtin_amdgcn_sched_barrier(0);
#pragma unroll
        for (int m = 0; m < 8; ++m) acc[m] = mma16(f0, af[m], acc[m]); }
    __syncthreads();
#pragma unroll
    for (int m = 0; m < 8; ++m) red[(w * 8 + m) * 64 + lane] = acc[m];
    __syncthreads();
    f32x4 s = red[w * 64 + lane];
#pragma unroll
    for (int ww = 1; ww < 8; ++ww) s += red[(ww * 8 + w) * 64 + lane];
    return s;
}
template <int K, int LDA, int LDB> __device__ __forceinline__ f32x4 skinny_half(const Ctx& c, const bf16_t* __restrict__ A, const bf16_t* __restrict__ B0) {
    LAS f32x4* red = (LAS f32x4*)c.lds;
    const int lane = c.lane, r = lane & 15, q = lane >> 4, w = c.wave;
    constexpr int KS = K / 8, NK = KS / 32;
    const bf16_t* ap = A + (size_t)r * LDA + w * KS + q * 8; const bf16_t* b0 = B0 + (size_t)r * LDB + w * KS + q * 8;
    f32x4 acc[4];
#pragma unroll
    for (int m = 0; m < 4; ++m) acc[m] = (f32x4){0.f, 0.f, 0.f, 0.f};
#pragma unroll 4
    for (int ks = 0; ks < NK; ++ks) {
        const bf16x8 f0 = *(const bf16x8*)(b0 + ks * 32); bf16x8 af[4];
#pragma unroll
        for (int m = 0; m < 4; ++m) af[m] = *(const bf16x8*)(ap + (size_t)(m * 16) * LDA + ks * 32);
        __builtin_amdgcn_sched_barrier(0);
#pragma unroll
        for (int m = 0; m < 4; ++m) acc[m] = mma16(f0, af[m], acc[m]); }
    __syncthreads();
#pragma unroll
    for (int m = 0; m < 4; ++m) red[(w * 4 + m) * 64 + lane] = acc[m];
    __syncthreads();
    f32x4 s = (f32x4){0.f, 0.f, 0.f, 0.f};
    if (w < 4) { s = red[w * 64 + lane];
#pragma unroll
        for (int ww = 1; ww < 8; ++ww) s += red[(ww * 4 + w) * 64 + lane]; }
    return s;
}
__device__ __forceinline__ u32x2 pk4(const f32x4 v) { u32x2 o; o.x = pk2(v[0], v[1]); o.y = pk2(v[2], v[3]); return o; }
#define SKINNY_LOOP(total_) for (int s = c.bid - base; s >= 0 && s < (total_); s += ncu)
__device__ __forceinline__ void ph_sk_in(const Ctx& c, int base, int ncu, const bf16_t* __restrict__ HB, const bf16_t* __restrict__ W, bf16_t* __restrict__ U) {
    const int r = c.lane & 15, q = c.lane >> 4, w = c.wave;
    SKINNY_LOOP(NINP / 32) { f32x4 o[2]; skinny_pair<DM, DM, DM>(c, HB + (size_t)MP * DM, W + (size_t)(s * 32) * DM, W + (size_t)(s * 32 + 16) * DM, o, s);
        bf16_t* up = U + (size_t)(MP + w * 16 + r) * NINP + s * 32 + q * 4; *(u32x2*)up = pk4(o[0]); *(u32x2*)(up + 16) = pk4(o[1]); }
}
__device__ __forceinline__ void ph_sk_merge(const Ctx& c, int base, int ncu, const bf16_t* __restrict__ BR, const bf16_t* __restrict__ W, const bf16_t* __restrict__ U, const float* __restrict__ gate_b, bf16_t* __restrict__ MGB) {
    const int r = c.lane & 15, q = c.lane >> 4, w = c.wave;
    SKINNY_LOOP(DM / 8) { const int ct = s >> 1, hf = s & 1; const size_t row = (size_t)(MP + hf * 64 + (w & 3) * 16 + r); const int col = ct * 16 + q * 4; f32x4 tot = (f32x4){0.f, 0.f, 0.f, 0.f};
#pragma unroll 1
        for (int z = 0; z < 4; ++z) { const f32x4 o = skinny_half<BW, BW, BW>(c, BR + ((size_t)z * MPAD + MP + hf * 64) * BW, W + ((size_t)z * DM + ct * 16) * BW);
            if (w < 4) { const u32x2 gp = *(const u32x2*)(U + row * NINP + U_GP + z * DM + col); const f32x4 gb = *(const f32x4*)(gate_b + z * DM + col);
            tot[0] += sigmoidf_(__uint_as_float(gp.x << 16) + gb[0]) * o[0]; tot[1] += sigmoidf_(__uint_as_float(gp.x & 0xffff0000u) + gb[1]) * o[1];
            tot[2] += sigmoidf_(__uint_as_float(gp.y << 16) + gb[2]) * o[2]; tot[3] += sigmoidf_(__uint_as_float(gp.y & 0xffff0000u) + gb[3]) * o[3]; } }
        if (w < 4) *(u32x2*)(MGB + row * DM + col) = pk4(tot); }
}
template <int K> __device__ __forceinline__ void ph_sk_res(const Ctx& c, int base, int ncu, const bf16_t* __restrict__ A, const bf16_t* __restrict__ W, const bf16_t* __restrict__ R, bf16_t* __restrict__ Y) {
    const int r = c.lane & 15, q = c.lane >> 4, w = c.wave;
    SKINNY_LOOP(DM / 8) { const int ct = s >> 1, hf = s & 1; const f32x4 o = skinny_half<K, K, K>(c, A + (size_t)(MP + hf * 64) * K, W + (size_t)(ct * 16) * K);
        if (w < 4) { const size_t off = (size_t)(MP + hf * 64 + w * 16 + r) * DM + ct * 16 + q * 4; const u32x2 rr = *(const u32x2*)(R + off);
        const f32x4 rv = (f32x4){__uint_as_float(rr.x << 16), __uint_as_float(rr.x & 0xffff0000u), __uint_as_float(rr.y << 16), __uint_as_float(rr.y & 0xffff0000u)};
        *(u32x2*)(Y + off) = pk4(rv * ALPHA + o); } }
}
__device__ __forceinline__ void ph_sk_gu(const Ctx& c, int base, int ncu, const bf16_t* __restrict__ X1B, const bf16_t* __restrict__ W, bf16_t* __restrict__ ACT) {
    const int r = c.lane & 15, q = c.lane >> 4, w = c.wave;
    SKINNY_LOOP(DFF / 16) { const int t = s >> 3, j0 = (s & 7) * 16; f32x4 o[2];
        skinny_pair<DM, DM, DM>(c, X1B + (size_t)MP * DM, W + (size_t)(t * 256 + j0) * DM, W + (size_t)(t * 256 + 128 + j0) * DM, o, s);
        f32x4 v;
#pragma unroll
        for (int j = 0; j < 4; ++j) v[j] = o[0][j] * sigmoidf_(o[0][j]) * o[1][j];
        *(u32x2*)(ACT + (size_t)(MP + w * 16 + r) * DFF + t * 128 + j0 + q * 4) = pk4(v); }
}
#undef SKINNY_LOOP

constexpr int LDS_BAR_OFF = 153600;
constexpr int LDS_BYTES = LDS_BAR_OFF + 64;
struct Args { const float* in[37]; float* out; unsigned char* ws; };

typedef pg8::Gemm<DM, DM, DM, 2, 8, NL, 1, false, 0, 0, (long)DM * DM, 0> GemmMem;
typedef pg8::Gemm<DM, DM, DM, MP / 256, NINP / 256> GemmIn;
typedef pg8::Gemm<NINP, 1024, 256, PS / 256, 1, 8, 4, false, (long)PS * NINP, 256, 256 * 1024, 256> GemmScore;
typedef pg8::Gemm<256, 256, 256, PS / 256, 1, 8, 4, false, (long)4 * 4096 * 256, (long)4096 * 256, 4 * 65536, 65536> GemmPV;
typedef pg8::Gemm<BW, BW, BW, MP / 256, DM / 256, 4, 1, true, (long)MPAD * BW, 0, (long)DM * BW, 0> GemmBranch;
typedef pg8::Gemm<DM, DM, DM, MP / 256, DM / 256> GemmOut;
typedef pg8::Gemm<DM, DM, DM, MP / 256, 2 * DFF / 256> GemmGU;
typedef pg8::Gemm<DFF, DFF, DFF, MP / 256, DM / 256> GemmDown;
template <class GT> __device__ __forceinline__ GT mk_gemm(const Ctx& c, const bf16_t* A, const bf16_t* B) { GT g; g.A = A; g.B = B; g.G = c.G; g.c = c.bid; return g; }

template <int OFF> __device__ __forceinline__ unsigned long long karg_u64(unsigned long long kargs) {
    unsigned long long p; asm volatile("s_load_dwordx2 %0, %1, %2\n\ts_waitcnt lgkmcnt(0)" : "=s"(p) : "s"(kargs), "n"(OFF) : "memory"); return p;
}
#define GPTR(T, x) ((T*)(__attribute__((address_space(1))) T*)(x))
#define INP(k) GPTR(const float, karg_u64<(k) * 8>(kargs))
#define OUTP() GPTR(float, karg_u64<37 * 8>(kargs))
#define WSP() GPTR(unsigned char, karg_u64<38 * 8>(kargs))

__global__ void __launch_bounds__(512, 2) mega_fwd(Args a_unused) {
    extern __shared__ __attribute__((aligned(16))) unsigned char lds_raw[];
    const unsigned long long kargs = (unsigned long long)__builtin_amdgcn_kernarg_segment_ptr();
    Ctx c0; c0.tid = threadIdx.x; c0.lane = c0.tid & 63; c0.wave = __builtin_amdgcn_readfirstlane(c0.tid >> 6); c0.bid = blockIdx.x; c0.G = gridDim.x; c0.lds = (LAS unsigned char*)lds_raw;
    if (c0.tid < 4) ((LAS unsigned*)(c0.lds + LDS_BAR_OFF))[c0.tid] = 0u;
    __syncthreads();
    const XcdBarrier bar = xcd_barrier_post((unsigned*)(WSP() + WS_CTL), (volatile LAS unsigned*)(c0.lds + LDS_BAR_OFF));

#define WP_SIDE 2
#define WP_GLA 3
#define WP_RW 2
#define XBAR() do { const Ctx cb_ = fresh(c0); xcd_barrier(bar, cb_.tid == 0); } while (0)
#define WPREP_WIN(cc_, L_) do { unsigned char* ws_ = WSP(); \
      ph_wprep(cc_, INP(10) + (size_t)(L_) * DM * NIN, (bf16_t*)(ws_ + WS_WIN) + (size_t)(L_) * NINP * DM, DM, NIN, NINP, 1, 1, 0, 0); } while (0)
#define WPREP_LAYER(cc_, L_) do { WPREP_WIN(cc_, L_); WPREP_REST(cc_, L_); } while (0)
#define WPREP_REST(cc_, L_) do { unsigned char* ws_ = WSP(); \
      ph_wprep(cc_, INP(29) + (size_t)(L_) * 4 * BW * DM, (bf16_t*)(ws_ + WS_WBR) + (size_t)(L_) * 4 * DM * BW, BW, DM, DM, 0, 4, (size_t)BW * DM, (size_t)DM * BW); \
      ph_wprep(cc_, INP(30) + (size_t)(L_) * DM * DM, (bf16_t*)(ws_ + WS_WOUT) + (size_t)(L_) * DM * DM, DM, DM, DM, 0, 1, 0, 0); \
      ph_wprep(cc_, INP(33) + (size_t)(L_) * DM * 2 * DFF, (bf16_t*)(ws_ + WS_WGU) + (size_t)(L_) * 2 * DFF * DM, DM, 2 * DFF, 2 * DFF, 2, 1, 0, 0); \
      ph_wprep(cc_, INP(34) + (size_t)(L_) * DFF * DM, (bf16_t*)(ws_ + WS_WDN) + (size_t)(L_) * DM * DFF, DFF, DM, DM, 0, 1, 0, 0); } while (0)
    { const Ctx c = fresh(c0); unsigned char* ws = WSP();
      ph_wprep(c, INP(28), (bf16_t*)(ws + WS_WMEM), DM, DM, DM, 0, NL, (size_t)DM * DM, (size_t)DM * DM);
      WPREP_WIN(c, 0);
      ph_lrw(c, INP(19), INP(21), INP(22), (bf16_t*)(ws + WS_LRW));
      ph_xprep(c, INP(0), INP(1), INP(2), (float*)nullptr, (bf16_t*)(ws + WS_HB), (bf16_t*)(ws + WS_MEMB)); }
    XBAR();
    if (c0.bid >= 64) { Ctx c = fresh(c0); c.bid -= 64; c.G -= 64; WPREP_REST(c, 0); }
    { const Ctx c = fresh(c0); unsigned char* ws = WSP(); float* out = OUTP();
      GemmMem g = mk_gemm<GemmMem>(c, (const bf16_t*)(ws + WS_MEMB), (const bf16_t*)(ws + WS_WMEM));
      pg8::EpiMem E; E.outK = out + O_MKP; E.outV = out + O_MVP; E.kb = (bf16_t*)(ws + WS_MKB); E.vt = (bf16_t*)(ws + WS_MVT); pg8::gemm_phase<GemmMem, pg8::EpiMem, true, true>(c.lds, c.tid, g, E); }

    for (int l = 0; l < NL; ++l) {
        { const Ctx c = fresh(c0); unsigned char* ws = WSP();
          GemmIn g = mk_gemm<GemmIn>(c, (const bf16_t*)(ws + WS_HB), (const bf16_t*)(ws + WS_WIN) + (size_t)l * NINP * DM);
          pg8::EpiBf16 E; E.O = (bf16_t*)(ws + WS_U); E.zs = 0; E.ldc = NINP; E.pad = 0; pg8::gemm_phase<GemmIn, pg8::EpiBf16, true, true>(c.lds, c.tid, g, E); }
        { const Ctx c = fresh(c0); unsigned char* ws = WSP(); ph_sk_in(c, c.G > 192 ? 96 : 0, c.G > 192 ? c.G - 96 : c.G, (const bf16_t*)(ws + WS_HB), (const bf16_t*)(ws + WS_WIN) + (size_t)l * NINP * DM, (bf16_t*)(ws + WS_U)); }
        XBAR();
        { const Ctx c = fresh(c0); unsigned char* ws = WSP(); float* out = OUTP(); const bf16_t* U = (const bf16_t*)(ws + WS_U); bf16_t* BR = (bf16_t*)(ws + WS_BR);
          (void)out; (void)BR;
          ph_gla_pre(c, U, INP(12) + (size_t)l * 16 * 512, INP(13) + (size_t)l * 512, (bf16_t*)(ws + WS_GLQD), (bf16_t*)(ws + WS_GLKH), (bf16_t*)(ws + WS_GLE), (bf16_t*)(ws + WS_GLVT), (float*)(ws + WS_GLGC)); }
        { const Ctx c = fresh(c0); unsigned char* ws = WSP();
          ph_rwkv_pre(c, (const bf16_t*)(ws + WS_U), INP(9) + (size_t)l * SB * RWC, INP(17) + (size_t)l * RWC, INP(18) + (size_t)l * BW, INP(19) + (size_t)l * 64 * BW, INP(20) + (size_t)l * BW, INP(21) + (size_t)l * 64 * BW,
                       INP(22) + (size_t)l * 128 * BW, INP(23) + (size_t)l * BW, INP(24) + (size_t)l * BW, INP(25) + (size_t)l * BW, (float*)(ws + WS_RW), (bf16_t*)(ws + WS_RB), (const bf16_t*)(ws + WS_LRW) + (size_t)l * 1024 * 256); }
        { const Ctx c = fresh(c0); unsigned char* ws = WSP(); ph_memattn_prompt(c, (const bf16_t*)(ws + WS_U), (const bf16_t*)(ws + WS_MKB) + (size_t)l * 512 * 1024, (const bf16_t*)(ws + WS_MVT) + (size_t)l * 8 * 65536, (bf16_t*)(ws + WS_BR) + (size_t)3 * MPAD * BW); }
        XBAR();
        { const Ctx c = fresh(c0); unsigned char* ws = WSP(); float* out = OUTP();
          ph_rwkv_seq(c, 64, (const bf16_t*)(ws + WS_RB), INP(8) + (size_t)l * SB * 16 * 4096, out + O_RWP + (size_t)l * PB * 16 * 4096, out + O_RWS + (size_t)l * SB * 16 * 4096,
                      (bf16_t*)(ws + WS_RAW) + (size_t)MPAD * BW); }
        { const Ctx c = fresh(c0); unsigned char* ws = WSP(); float* out = OUTP();
          ph_gla_seq(c, 32, (const bf16_t*)(ws + WS_GLQD), (const bf16_t*)(ws + WS_GLKH), (const bf16_t*)(ws + WS_GLE), (const bf16_t*)(ws + WS_GLVT), (const float*)(ws + WS_GLGC),
                     INP(7) + (size_t)l * SB * 4 * 32768, out + O_GLAP + (size_t)l * PB * 4 * 32768, out + O_GLAS + (size_t)l * SB * 4 * 32768, (bf16_t*)(ws + WS_RAW)); }
        if ((c0.bid < 32 || c0.bid >= 96) && c0.G > 96) {
        { Ctx c = fresh(c0); c.bid = c.bid < 32 ? c.bid : c.bid - 64; c.G = c.G - 64; unsigned char* ws = WSP(); ph_swa_prompt(c, (const bf16_t*)(ws + WS_U), INP(16) + (size_t)l * 16, (bf16_t*)(ws + WS_BR) + (size_t)MPAD * BW); }
        { Ctx c = fresh(c0); c.bid = c.bid < 32 ? c.bid : c.bid - 64; c.G = c.G - 64; if (c.G > 128) c.bid = (c.bid + c.G - 128) % c.G;
          unsigned char* ws = WSP();
          ph_swa_sample(c, (const bf16_t*)(ws + WS_U), INP(3) + (size_t)l * SB * 16384, INP(4) + (size_t)l * SB * 16384, INP(16) + (size_t)l * 16, (bf16_t*)(ws + WS_BR) + (size_t)MPAD * BW); }
        { Ctx c = fresh(c0); c.bid = c.bid < 32 ? c.bid : c.bid - 64; c.G = c.G - 64; unsigned char* ws = WSP();
          ph_memattn_sample(c, 64, (const bf16_t*)(ws + WS_U), INP(5) + (size_t)l * SB * MEMT * 1024, INP(6) + (size_t)l * SB * MEMT * 1024, (bf16_t*)(ws + WS_BR) + (size_t)3 * MPAD * BW); }
        { Ctx c = fresh(c0); c.bid = c.bid < 32 ? c.bid : c.bid - 64; c.G = c.G - 64; unsigned char* ws = WSP();
          ph_copy_outs(c, (const bf16_t*)(ws + WS_U), INP(3) + (size_t)l * SB * 16384, INP(4) + (size_t)l * SB * 16384, OUTP(), l); }
        }
        if (l + 1 < NL) { const Ctx c = fresh(c0); unsigned char* ws = WSP(); const int L = l + 1;
          ph_wprep_dyn(c, (unsigned*)(ws + WS_CTL + 16384) + 64 * L,
                       INP(10) + (size_t)L * DM * NIN, INP(29) + (size_t)L * 4 * BW * DM, INP(30) + (size_t)L * DM * DM, INP(33) + (size_t)L * DM * 2 * DFF, INP(34) + (size_t)L * DFF * DM,
                       (bf16_t*)(ws + WS_WIN) + (size_t)L * NINP * DM, (bf16_t*)(ws + WS_WBR) + (size_t)L * 4 * DM * BW, (bf16_t*)(ws + WS_WOUT) + (size_t)L * DM * DM,
                       (bf16_t*)(ws + WS_WGU) + (size_t)L * 2 * DFF * DM, (bf16_t*)(ws + WS_WDN) + (size_t)L * DM * DFF); }
        XBAR();
        { const Ctx c = fresh(c0); unsigned char* ws = WSP(); ph_rwkv_fin(c, (const float*)(ws + WS_RW), INP(26) + (size_t)l * BW, INP(27) + (size_t)l * BW, (const bf16_t*)(ws + WS_RAW) + (size_t)MPAD * BW, (bf16_t*)(ws + WS_BR) + (size_t)2 * MPAD * BW); }
        { const Ctx c = fresh(c0); unsigned char* ws = WSP(); ph_gla_fin(c, (const bf16_t*)(ws + WS_U), INP(14) + (size_t)l * BW, INP(15) + (size_t)l * BW, (const bf16_t*)(ws + WS_RAW), (bf16_t*)(ws + WS_BR)); }
        XBAR();
        { const Ctx c = fresh(c0); unsigned char* ws = WSP();
          GemmBranch g = mk_gemm<GemmBranch>(c, (const bf16_t*)(ws + WS_BR), (const bf16_t*)(ws + WS_WBR) + (size_t)l * 4 * DM * BW);
          pg8::EpiMerge E; E.MG = (float*)(ws + WS_MG); E.MGB = (bf16_t*)(ws + WS_MGB); E.U = (const bf16_t*)(ws + WS_U); E.gate_b = INP(11) + (size_t)l * 4 * DM; pg8::gemm_phase<GemmBranch, pg8::EpiMerge, true, true>(c.lds, c.tid, g, E); }
        { const Ctx c = fresh(c0); unsigned char* ws = WSP(); ph_sk_merge(c, 0, c.G, (const bf16_t*)(ws + WS_BR), (const bf16_t*)(ws + WS_WBR) + (size_t)l * 4 * DM * BW, (const bf16_t*)(ws + WS_U), INP(11) + (size_t)l * 4 * DM, (bf16_t*)(ws + WS_MGB)); }
        XBAR();
        { const Ctx c = fresh(c0); unsigned char* ws = WSP();
          GemmOut g = mk_gemm<GemmOut>(c, (const bf16_t*)(ws + WS_MGB), (const bf16_t*)(ws + WS_WOUT) + (size_t)l * DM * DM);
          pg8::EpiRes E; E.R = (const bf16_t*)(ws + WS_HB); E.Y = (bf16_t*)(ws + WS_Y); pg8::gemm_phase<GemmOut, pg8::EpiRes, true, true>(c.lds, c.tid, g, E); }
        { const Ctx c = fresh(c0); unsigned char* ws = WSP(); ph_sk_res<DM>(c, 0, c.G, (const bf16_t*)(ws + WS_MGB), (const bf16_t*)(ws + WS_WOUT) + (size_t)l * DM * DM, (const bf16_t*)(ws + WS_HB), (bf16_t*)(ws + WS_Y)); }
        XBAR();
        { const Ctx c = fresh(c0); unsigned char* ws = WSP(); ph_ln(c, (const bf16_t*)(ws + WS_Y), INP(31) + (size_t)l * DM, INP(32) + (size_t)l * DM, (float*)nullptr, (bf16_t*)(ws + WS_X1B), nullptr, MT, 0); }
        XBAR();
        { const Ctx c = fresh(c0); unsigned char* ws = WSP();
          GemmGU g = mk_gemm<GemmGU>(c, (const bf16_t*)(ws + WS_X1B), (const bf16_t*)(ws + WS_WGU) + (size_t)l * 2 * DFF * DM);
          pg8::EpiSwiGLU E; E.O = (bf16_t*)(ws + WS_ACT); pg8::gemm_phase<GemmGU, pg8::EpiSwiGLU, true, true>(c.lds, c.tid, g, E); }
        { const Ctx c = fresh(c0); unsigned char* ws = WSP(); ph_sk_gu(c, c.G > 192 ? 128 : 0, c.G > 192 ? c.G - 128 : c.G, (const bf16_t*)(ws + WS_X1B), (const bf16_t*)(ws + WS_WGU) + (size_t)l * 2 * DFF * DM, (bf16_t*)(ws + WS_ACT)); }
        XBAR();
        { const Ctx c = fresh(c0); unsigned char* ws = WSP();
          GemmDown g = mk_gemm<GemmDown>(c, (const bf16_t*)(ws + WS_ACT), (const bf16_t*)(ws + WS_WDN) + (size_t)l * DM * DFF);
          pg8::EpiRes E; E.R = (const bf16_t*)(ws + WS_X1B); E.Y = (bf16_t*)(ws + WS_Y); pg8::gemm_phase<GemmDown, pg8::EpiRes, true, true>(c.lds, c.tid, g, E); }
        { const Ctx c = fresh(c0); unsigned char* ws = WSP(); ph_sk_res<DFF>(c, 0, c.G, (const bf16_t*)(ws + WS_ACT), (const bf16_t*)(ws + WS_WDN) + (size_t)l * DM * DFF, (const bf16_t*)(ws + WS_X1B), (bf16_t*)(ws + WS_Y)); }
        XBAR();
        { const Ctx c = fresh(c0); unsigned char* ws = WSP(); float* out = OUTP(); ph_ln(c, (const bf16_t*)(ws + WS_Y), INP(35) + (size_t)l * DM, INP(36) + (size_t)l * DM, (float*)nullptr, (bf16_t*)(ws + WS_HB), l == NL - 1 ? out : nullptr, MT, MT); }
        XBAR();
    }
}

extern "C" void kernel_launch(void* const* d_in, const int* in_sizes, int n_in, void* d_out, int out_size, void* d_ws, size_t ws_size, hipStream_t stream) {
    static int grid = 0;
    if (grid == 0) {
        if (n_in != 37 || (size_t)out_size != O_END || ws_size < WS_END) { fprintf(stderr, "kernel_launch: unexpected sizes (n_in %d out %d ws %zu need %zu)\n", n_in, out_size, ws_size, (size_t)WS_END); grid = -1; return; }
        int dev = 0, cus = 0;
        if (hipGetDevice(&dev) != hipSuccess || hipDeviceGetAttribute(&cus, hipDeviceAttributeMultiprocessorCount, dev) != hipSuccess) { grid = -1; return; }
        if (hipFuncSetAttribute((const void*)mega_fwd, hipFuncAttributeMaxDynamicSharedMemorySize, LDS_BYTES) != hipSuccess) { fprintf(stderr, "kernel_launch: hipFuncSetAttribute failed\n"); grid = -1; return; }
        int per_cu = 0;
        if (hipOccupancyMaxActiveBlocksPerMultiprocessor(&per_cu, (const void*)mega_fwd, 512, LDS_BYTES) != hipSuccess || per_cu < 1) { fprintf(stderr, "kernel_launch: occupancy query says %d\n", per_cu); }
        (void)hipGetLastError();
        grid = cus;
    }
    if (grid < 0) return;
    (void)hipMemsetAsync((unsigned char*)d_ws + WS_CTL, 0, 16384 + 1024, stream);
    Args a; memset(&a, 0, sizeof a);
    for (int i = 0; i < 37; ++i) a.in[i] = (const float*)d_in[i];
    a.out = (float*)d_out; a.ws = (unsigned char*)d_ws;
    hipLaunchKernelGGL(mega_fwd, dim3(grid), dim3(512), LDS_BYTES, stream, a);
}
```

```cpp
#include <hip/hip_runtime.h>
#include <cstdio>
#include <cstdint>
#include <cstring>

#define LAS __attribute__((address_space(3)))
typedef unsigned short bf16_t;
typedef short bf16x8 __attribute__((ext_vector_type(8)));
typedef float f32x4 __attribute__((ext_vector_type(4)));
typedef float f32x2 __attribute__((ext_vector_type(2)));
typedef unsigned u32x4 __attribute__((ext_vector_type(4)));
typedef unsigned u32x2 __attribute__((ext_vector_type(2)));

constexpr int DM = 2048, NL = 4;
constexpr int PB = 2, PS = 4096, MP = PB * PS;
constexpr int SB = 32, SS = 4, MS = SB * SS;
constexpr int MT = MP + MS;
constexpr int MPAD = 8448;
constexpr int NIN = 16912, NINP = 17152;
constexpr int U_GQ = 0, U_GK = 512, U_GV = 1024, U_GR = 2048, U_GA = 3072, U_SQ = 3328, U_SK = 4352, U_SV = 4480, U_RU = 4608, U_MQ = 7936, U_GP = 8960;
constexpr int RWC = 3328, BW = 1024, DFF = 5632, MEMT = 256;
constexpr float ALPHA = 1.681792830507429f;

constexpr size_t O_YP = 0;
constexpr size_t O_YS = O_YP + (size_t)MP * DM;
constexpr size_t O_SWKP = O_YS + (size_t)MS * DM;
constexpr size_t O_SWVP = O_SWKP + (size_t)NL * PB * 128 * 128;
constexpr size_t O_MKP = O_SWVP + (size_t)NL * PB * 128 * 128;
constexpr size_t O_MVP = O_MKP + (size_t)NL * PB * 256 * 1024;
constexpr size_t O_GLAP = O_MVP + (size_t)NL * PB * 256 * 1024;
constexpr size_t O_RWP = O_GLAP + (size_t)NL * PB * 4 * 128 * 256;
constexpr size_t O_RSP = O_RWP + (size_t)NL * PB * 16 * 64 * 64;
constexpr size_t O_SWKS = O_RSP + (size_t)NL * PB * RWC;
constexpr size_t O_SWVS = O_SWKS + (size_t)NL * SB * 128 * 128;
constexpr size_t O_GLAS = O_SWVS + (size_t)NL * SB * 128 * 128;
constexpr size_t O_RWS = O_GLAS + (size_t)NL * SB * 4 * 128 * 256;
constexpr size_t O_RSS = O_RWS + (size_t)NL * SB * 16 * 64 * 64;
constexpr size_t O_END = O_RSS + (size_t)NL * SB * RWC;
static_assert(O_END == 52881408, "output size");

constexpr size_t al256(size_t x) { return (x + 255) & ~(size_t)255; }
constexpr size_t WS_CTL = 0;
constexpr size_t WS_WIN = 65536;
constexpr size_t WS_WMEM = WS_WIN + (size_t)NL * NINP * DM * 2;
constexpr size_t WS_WBR = WS_WMEM + (size_t)NL * DM * DM * 2;
constexpr size_t WS_WOUT = WS_WBR + (size_t)NL * 4 * DM * BW * 2;
constexpr size_t WS_WGU = WS_WOUT + (size_t)NL * DM * DM * 2;
constexpr size_t WS_WDN = WS_WGU + (size_t)NL * 2 * DFF * DM * 2;
constexpr size_t WS_HF = WS_WDN + (size_t)NL * DM * DFF * 2;
constexpr size_t WS_HB = WS_HF + (size_t)MPAD * DM * 4;
constexpr size_t WS_U = WS_HB + (size_t)MPAD * DM * 2;
constexpr size_t WS_BR = WS_U + (size_t)MPAD * NINP * 2;
constexpr size_t WS_MG = WS_BR + (size_t)4 * MPAD * BW * 2;
constexpr size_t WS_MGB = WS_MG + (size_t)MPAD * DM * 4;
constexpr size_t WS_Y = WS_MGB + (size_t)MPAD * DM * 2;
constexpr size_t WS_X1F = WS_Y + (size_t)MPAD * DM * 4;
constexpr size_t WS_X1B = WS_X1F + (size_t)MPAD * DM * 4;
constexpr size_t WS_ACT = WS_X1B + (size_t)MPAD * DM * 2;
constexpr size_t WS_MEMB = WS_ACT + (size_t)MPAD * DFF * 2;
constexpr size_t WS_MKB = WS_MEMB + (size_t)512 * DM * 2;
constexpr size_t WS_MVT = WS_MKB + (size_t)NL * 512 * 1024 * 2;
constexpr size_t WS_SC = WS_MVT + (size_t)NL * 8 * 256 * 256 * 2;
constexpr size_t WS_PB = WS_SC + (size_t)8 * 4096 * 256 * 4;
constexpr size_t WS_RW = WS_PB + (size_t)8 * 4096 * 256 * 2;
constexpr size_t RW_ARR = (size_t)MPAD * BW * 4;
constexpr int GL_NCH = 512 + 128;
constexpr size_t WS_GLQD = WS_RW + 8 * RW_ARR;
constexpr size_t WS_GLKH = WS_GLQD + (size_t)GL_NCH * 8192 * 2;
constexpr size_t WS_GLE = WS_GLKH + (size_t)GL_NCH * 8192 * 2;
constexpr size_t WS_GLVT = WS_GLE + (size_t)GL_NCH * 4096 * 2;
constexpr size_t WS_GLGC = WS_GLVT + (size_t)GL_NCH * 16384 * 2;
constexpr int RB_NCH = PB * 16 * 256 + SB * 16;
constexpr int RB_EL = 7424;
constexpr int RB_QP = 4096, RB_KHP = 5120, RB_VT = 6144, RB_EP = 7168;
constexpr size_t WS_RB = WS_GLGC + (size_t)GL_NCH * 128 * 4;
constexpr size_t WS_RAW = WS_RB + (size_t)RB_NCH * RB_EL * 2;
constexpr size_t WS_LRW = WS_RAW + (size_t)2 * MPAD * BW * 2;
constexpr size_t WS_END = WS_LRW + (size_t)NL * 16 * 64 * 256 * 2;

__device__ __forceinline__ float bf2f(bf16_t b) { return __uint_as_float(((unsigned)b) << 16); }
typedef __bf16 bf16v2_t __attribute__((ext_vector_type(2)));
__device__ __forceinline__ unsigned pk2(float lo, float hi) { const f32x2 v = {lo, hi}; return __builtin_bit_cast(unsigned, __builtin_convertvector(v, bf16v2_t)); }
__device__ __forceinline__ bf16_t f2bf(float f) { return (bf16_t)(pk2(f, 0.f) & 0xffffu); }
__device__ __forceinline__ f32x4 ld4bf(const bf16_t* p) { const u32x2 w = *(const u32x2*)p; return (f32x4){__uint_as_float(w.x << 16), __uint_as_float(w.x & 0xffff0000u), __uint_as_float(w.y << 16), __uint_as_float(w.y & 0xffff0000u)}; }
__device__ __forceinline__ float wave_sum(float v) {
#pragma unroll
    for (int o = 32; o > 0; o >>= 1) v += __shfl_xor(v, o, 64);
    return v;
}
__device__ __forceinline__ float wave_max(float v) {
#pragma unroll
    for (int o = 32; o > 0; o >>= 1) v = fmaxf(v, __shfl_xor(v, o, 64));
    return v;
}
__device__ __forceinline__ float sigmoidf_(float x) { return __builtin_amdgcn_rcpf(1.0f + __expf(-x)); }
__device__ __forceinline__ void unpack8(const u32x4 w, float (&x)[8]) {
    x[0] = __uint_as_float(w.x << 16); x[1] = __uint_as_float(w.x & 0xffff0000u); x[2] = __uint_as_float(w.y << 16); x[3] = __uint_as_float(w.y & 0xffff0000u);
    x[4] = __uint_as_float(w.z << 16); x[5] = __uint_as_float(w.z & 0xffff0000u); x[6] = __uint_as_float(w.w << 16); x[7] = __uint_as_float(w.w & 0xffff0000u);
}
__device__ __forceinline__ float softplusf_(float x) { return fmaxf(x, 0.f) + log1pf(__expf(-fabsf(x))); }
__device__ __forceinline__ float softplus_fast(float x) { return fmaxf(x, 0.f) + __logf(1.0f + __expf(-fabsf(x))); }
__device__ __forceinline__ float tanh_fast(float x) { return 1.0f - 2.0f * __builtin_amdgcn_rcpf(1.0f + __expf(2.0f * x)); }

namespace pg8 {
constexpr int BM = 256, BK = 64, HALF = 128, HTB = HALF * BK * 2, STAGE_BYTES = 8 * HTB, NXCD = 8, WGM = 8;
__host__ __device__ __forceinline__ int lds_byte(int r, int c) { const int st = (r >> 4) * 2 + (c >> 5), rr = r & 15, cc = c & 31, ob = rr * 64 + cc * 2; return st * 1024 + (ob ^ (((ob >> 9) & 1) << 5)); }
__host__ __device__ __forceinline__ void stage_rc(int b, int& R, int& C) { const int st = b / 1024, sb = b % 1024, swz = sb ^ (((sb >> 9) & 1) << 5); R = (st >> 1) * 16 + swz / 64; C = (st & 1) * 32 + (swz % 64) / 2; }
__host__ __device__ __forceinline__ int perm32(int rho) { const int n = rho >> 4, i = rho & 15; return 8 * (i >> 2) + 4 * n + (i & 3); }

struct Unit { int pm, pn, z; };
template <int LDA_, int LDB_, int K_, int NM_, int NN_, int NZ_ = 1, int NZH_ = 1, bool ZINNER_ = false, long ZSAB_ = 0, long ZSAH_ = 0, long ZSBB_ = 0, long ZSBH_ = 0>
struct Gemm {
    static constexpr int LDA = LDA_, LDB = LDB_, K = K_, NM = NM_, NN = NN_, NZ = NZ_, NZH = NZH_; static constexpr bool ZINNER = ZINNER_;
    const bf16_t* A; const bf16_t* B; int G, c;
    __device__ __forceinline__ bool next(int i, Unit& u) const {
        constexpr int nt = NM * NN; int L, z;
        if (ZINNER) { const int it = i / NZ; z = i - it * NZ; const long LL = (long)it * G + c; if (LL >= nt) return false; L = (int)LL; }
        else { const long LL = (long)i * G + c; if (LL >= (long)nt * NZ) return false; z = (int)(LL / nt); L = (int)(LL - (long)z * nt); }
        int wgid = L; { constexpr int q = nt / NXCD, r = nt % NXCD; const int xcd = wgid % NXCD, off = wgid / NXCD; wgid = (xcd < r ? xcd * (q + 1) : r * (q + 1) + (xcd - r) * q) + off; }
        constexpr int nig = WGM * NN; const int gid = wgid / nig, fm = gid * WGM, gsz = (NM - fm) < WGM ? (NM - fm) : WGM;
        u.pm = fm + ((wgid % nig) % gsz); u.pn = (wgid % nig) / gsz; u.z = z; return true;
    }
    __device__ __forceinline__ const char* a_base(const Unit& u) const { const int zb = u.z / NZH, zh = u.z - zb * NZH; return (const char*)(A + zb * ZSAB_ + zh * ZSAH_ + (long)u.pm * BM * LDA); }
    __device__ __forceinline__ const char* b_base(const Unit& u) const { const int zb = u.z / NZH, zh = u.z - zb * NZH; return (const char*)(B + zb * ZSBB_ + zh * ZSBH_ + (long)u.pn * BM * LDB); }
};

template <class GT, class Epi, bool ALIGN_EPI = true, bool SP2 = true>
__device__ __forceinline__ void gemm_phase(LAS unsigned char* lds, const int tid, const GT& g, const Epi& E) {
    const int wid = __builtin_amdgcn_readfirstlane(tid >> 6), lane = tid & 63, wr = wid >> 2, wc = wid & 3, fr = lane & 15, fq = lane >> 4;
    constexpr int nt = GT::K / BK;
    unsigned voffA[2], voffB[2];
#pragma unroll
    for (int i = 0; i < 2; ++i) { int R, C; stage_rc(tid * 16 + i * 8192, R, C); const int Rb = Epi::PERM ? ((R & ~31) + perm32(R & 31)) : R;
        voffA[i] = (unsigned)(R * GT::LDA + C) * 2u; voffB[i] = (unsigned)(Rb * GT::LDB + C) * 2u; }
    constexpr size_t kstep = (size_t)(BK * 2);
    constexpr size_t hstepA = (size_t)HALF * GT::LDA * 2, hstepB = (size_t)HALF * GT::LDB * 2;
    const unsigned ldsw = (unsigned)wid * 1024u;
    const int aoff = lds_byte(wr * 64 + fr, fq * 8), boff = lds_byte(wc * 32 + fr, fq * 8);
#define PG8_SA(b, h) (((b) * 2 + (h)) * HTB)
#define PG8_SB(b, h) ((4 + (b) * 2 + (h)) * HTB)
#define PG8_STAGE(bufoff, gbase, voff) do { _Pragma("unroll") for (int _i = 0; _i < 2; ++_i) \
        __builtin_amdgcn_global_load_lds((const unsigned*)((const char*)(gbase) + (voff)[_i]), (LAS unsigned*)(lds + (bufoff) + ldsw + _i * 8192), 16, 0, 0); } while (0)
#define PG8_LDA(dst, b, h) do { _Pragma("unroll") for (int m = 0; m < 4; ++m) _Pragma("unroll") for (int k = 0; k < 2; ++k) dst[m][k] = *(const LAS bf16x8*)(lds + PG8_SA(b, h) + aoff + m * 2048 + k * 1024); } while (0)
#define PG8_LDB(dst, b, h) do { _Pragma("unroll") for (int n = 0; n < 2; ++n) _Pragma("unroll") for (int k = 0; k < 2; ++k) dst[n][k] = *(const LAS bf16x8*)(lds + PG8_SB(b, h) + boff + n * 2048 + k * 1024); } while (0)
#define PG8_MMA(ai, bj, At, Bt) do { __builtin_amdgcn_s_setprio(1); _Pragma("unroll") for (int m = 0; m < 4; ++m) _Pragma("unroll") for (int n = 0; n < 2; ++n) _Pragma("unroll") for (int k = 0; k < 2; ++k) \
        acc[ai][bj][m][n] = __builtin_amdgcn_mfma_f32_16x16x32_bf16(Bt[n][k], At[m][k], acc[ai][bj][m][n], 0, 0, 0); __builtin_amdgcn_s_setprio(0); } while (0)
#define PG8_WAIT_V(n) asm volatile("s_waitcnt vmcnt(" #n ")" ::: "memory")
#define PG8_WAIT_L(n) asm volatile("s_waitcnt lgkmcnt(" #n ")" ::: "memory")
#define PG8_BAR __builtin_amdgcn_s_barrier()
#define PG8_SCHED __builtin_amdgcn_sched_barrier(0)
    Unit cur, nxt; int ui = 0;
    if (!g.next(0, cur)) return;
    f32x4 acc[2][2][4][2];
#pragma unroll
    for (int a = 0; a < 2; ++a)
#pragma unroll
        for (int b = 0; b < 2; ++b)
#pragma unroll
            for (int m = 0; m < 4; ++m)
#pragma unroll
                for (int n = 0; n < 2; ++n) acc[a][b][m][n] = (f32x4){0.f, 0.f, 0.f, 0.f};
    bf16x8 At[4][2], B0[2][2], B1[2][2];
    const char* cA = g.a_base(cur); const char* cB = g.b_base(cur);
    if constexpr (SP2) {
        PG8_STAGE(PG8_SB(0, 0), cB, voffB); PG8_STAGE(PG8_SB(0, 1), cB + hstepB, voffB); PG8_STAGE(PG8_SA(0, 0), cA, voffA); PG8_STAGE(PG8_SA(0, 1), cA + hstepA, voffA);
        if (wr == 1) PG8_BAR;
        PG8_WAIT_V(2); PG8_BAR;
        PG8_STAGE(PG8_SB(1, 0), cB + kstep, voffB); PG8_STAGE(PG8_SA(1, 0), cA + kstep, voffA); PG8_STAGE(PG8_SB(1, 1), cB + hstepB + kstep, voffB);
        PG8_WAIT_V(6); PG8_BAR;
    } else {
        PG8_STAGE(PG8_SB(0, 0), cB, voffB); PG8_STAGE(PG8_SA(0, 0), cA, voffA); PG8_STAGE(PG8_SB(0, 1), cB + hstepB, voffB); PG8_STAGE(PG8_SA(0, 1), cA + hstepA, voffA);
        if (wr == 1) PG8_BAR;
        PG8_WAIT_V(4); PG8_BAR;
        PG8_STAGE(PG8_SB(1, 0), cB + kstep, voffB); PG8_STAGE(PG8_SA(1, 0), cA + kstep, voffA); PG8_STAGE(PG8_SB(1, 1), cB + hstepB + kstep, voffB);
        PG8_WAIT_V(6); PG8_BAR;
    }
    for (;;) {
        const bool has_next = g.next(ui + 1, nxt);
        const char* nA = has_next ? g.a_base(nxt) : cA; const char* nB = has_next ? g.b_base(nxt) : cB;
#pragma unroll 1
        for (int t = 0; t < nt; t += 2) {
            const bool last = (t == nt - 2);
            const char* a1 = cA + (size_t)(t + 1) * kstep;
            const char* a2 = last ? nA : cA + (size_t)(t + 2) * kstep; const char* b2 = last ? nB : cB + (size_t)(t + 2) * kstep;
            const char* a3 = a2 + kstep; const char* b3 = b2 + kstep;
            if constexpr (SP2) {
            PG8_LDB(B0, 0, 0); PG8_LDB(B1, 0, 1); PG8_SCHED; PG8_LDA(At, 0, 0); PG8_STAGE(PG8_SA(1, 1), a1 + hstepA, voffA);
            PG8_WAIT_V(8); PG8_WAIT_L(0); PG8_BAR; PG8_MMA(0, 0, At, B0); PG8_MMA(0, 1, At, B1); PG8_BAR; PG8_SCHED;
            PG8_LDA(At, 0, 1); PG8_STAGE(PG8_SB(0, 0), b2, voffB); PG8_STAGE(PG8_SB(0, 1), b2 + hstepB, voffB); PG8_STAGE(PG8_SA(0, 0), a2, voffA);
            PG8_WAIT_V(8); PG8_WAIT_L(0); PG8_BAR; PG8_MMA(1, 0, At, B0); PG8_MMA(1, 1, At, B1); PG8_BAR; PG8_SCHED;
            PG8_LDB(B0, 1, 0); PG8_LDB(B1, 1, 1); PG8_SCHED; PG8_LDA(At, 1, 0); PG8_STAGE(PG8_SA(0, 1), a2 + hstepA, voffA);
            PG8_WAIT_V(8); PG8_WAIT_L(0); PG8_BAR; PG8_MMA(0, 0, At, B0); PG8_MMA(0, 1, At, B1); PG8_BAR; PG8_SCHED;
            PG8_LDA(At, 1, 1); PG8_STAGE(PG8_SB(1, 0), b3, voffB); PG8_STAGE(PG8_SB(1, 1), b3 + hstepB, voffB); PG8_STAGE(PG8_SA(1, 0), a3, voffA);
            PG8_WAIT_V(8); PG8_WAIT_L(0); PG8_BAR; PG8_MMA(1, 0, At, B0); PG8_MMA(1, 1, At, B1); PG8_BAR; PG8_SCHED;
            } else {
            PG8_LDB(B0, 0, 0); PG8_SCHED; PG8_LDA(At, 0, 0); PG8_STAGE(PG8_SA(1, 1), a1 + hstepA, voffA);
            PG8_WAIT_L(8); PG8_BAR; PG8_WAIT_L(0); PG8_MMA(0, 0, At, B0); PG8_BAR; PG8_SCHED;
            PG8_LDB(B1, 0, 1); PG8_STAGE(PG8_SB(0, 0), b2, voffB);
            PG8_BAR; PG8_WAIT_L(0); PG8_MMA(0, 1, At, B1); PG8_BAR;
            PG8_LDA(At, 0, 1); PG8_STAGE(PG8_SA(0, 0), a2, voffA);
            PG8_BAR; PG8_WAIT_L(0); PG8_MMA(1, 0, At, B0); PG8_BAR; PG8_SCHED;
            PG8_STAGE(PG8_SB(0, 1), b2 + hstepB, voffB);
            PG8_WAIT_V(6); PG8_BAR; PG8_MMA(1, 1, At, B1); PG8_BAR;
            PG8_LDB(B0, 1, 0); PG8_SCHED; PG8_LDA(At, 1, 0); PG8_STAGE(PG8_SA(0, 1), a2 + hstepA, voffA);
            PG8_WAIT_L(8); PG8_BAR; PG8_WAIT_L(0); PG8_MMA(0, 0, At, B0); PG8_BAR; PG8_SCHED;
            PG8_LDB(B1, 1, 1); PG8_STAGE(PG8_SB(1, 0), b3, voffB);
            PG8_BAR; PG8_WAIT_L(0); PG8_MMA(0, 1, At, B1); PG8_BAR;
            PG8_LDA(At, 1, 1); PG8_STAGE(PG8_SA(1, 0), a3, voffA);
            PG8_BAR; PG8_WAIT_L(0); PG8_MMA(1, 0, At, B0); PG8_BAR; PG8_SCHED;
            PG8_STAGE(PG8_SB(1, 1), b3 + hstepB, voffB);
            PG8_WAIT_V(6); PG8_BAR; PG8_MMA(1, 1, At, B1); PG8_BAR;
            }
        }
        if constexpr (ALIGN_EPI) { if (wr == 0) PG8_BAR; }
        E(acc, cur, wr, wc, fr, fq);
        if (!has_next) break;
        if (!Epi::KEEP || nxt.z == 0) {
#pragma unroll
        for (int a = 0; a < 2; ++a)
#pragma unroll
            for (int b = 0; b < 2; ++b)
#pragma unroll
                for (int m = 0; m < 4; ++m)
#pragma unroll
                    for (int n = 0; n < 2; ++n) acc[a][b][m][n] = (f32x4){0.f, 0.f, 0.f, 0.f}; }
        cur = nxt; cA = nA; cB = nB; ++ui;
        if constexpr (ALIGN_EPI) { if (wr == 1) PG8_BAR; }
    }
    PG8_WAIT_V(0);
    if constexpr (!ALIGN_EPI) { if (wr == 0) PG8_BAR; }
    PG8_BAR;
#undef PG8_SA
#undef PG8_SB
#undef PG8_STAGE
#undef PG8_LDA
#undef PG8_LDB
#undef PG8_MMA
#undef PG8_WAIT_V
#undef PG8_WAIT_L
#undef PG8_BAR
#undef PG8_SCHED
}

struct EpiBf16 {
    static constexpr bool PERM = true; static constexpr bool KEEP = false;
    bf16_t* O; long zs; int ldc, pad;
    __device__ __forceinline__ void operator()(const f32x4 (&acc)[2][2][4][2], const Unit& u, int wr, int wc, int fr, int fq) const {
        const int row0 = u.pm * BM + wr * 64 + fr, col0 = u.pn * BM + wc * 32 + 8 * fq; bf16_t* base = O + (long)u.z * zs;
#pragma unroll
        for (int ai = 0; ai < 2; ++ai)
#pragma unroll
            for (int m = 0; m < 4; ++m) { bf16_t* rowp = base + (size_t)(row0 + ai * HALF + m * 16) * ldc + col0;
#pragma unroll
                for (int bj = 0; bj < 2; ++bj) { const f32x4 v0 = acc[ai][bj][m][0], v1 = acc[ai][bj][m][1];
                    u32x4 w; w.x = pk2(v0[0], v0[1]); w.y = pk2(v0[2], v0[3]); w.z = pk2(v1[0], v1[1]); w.w = pk2(v1[2], v1[3]);
                    *(u32x4*)(rowp + bj * HALF) = w; } }
    }
};
struct EpiMem {
    static constexpr bool PERM = false; static constexpr bool KEEP = false;
    float* outK; float* outV; bf16_t* kb; bf16_t* vt;
    __device__ __forceinline__ void operator()(const f32x4 (&acc)[2][2][4][2], const Unit& u, int wr, int wc, int fr, int fq) const {
        const int row0 = u.pm * BM + wr * 64 + fr, col0 = u.pn * BM + wc * 32 + 4 * fq;
#pragma unroll
        for (int ai = 0; ai < 2; ++ai)
#pragma unroll
            for (int m = 0; m < 4; ++m) { const int row = row0 + ai * HALF + m * 16;
#pragma unroll
                for (int bj = 0; bj < 2; ++bj)
#pragma unroll
                    for (int n = 0; n < 2; ++n) { const int col = col0 + bj * HALF + n * 16; const f32x4 v = acc[ai][bj][m][n];
                        if (col < 1024) { *(f32x4*)(outK + ((size_t)u.z * 512 + row) * 1024 + col) = v;
                            u32x2 w; w.x = pk2(v[0], v[1]); w.y = pk2(v[2], v[3]); *(u32x2*)(kb + ((size_t)u.z * 512 + row) * 1024 + col) = w; }
                        else { const int c = col - 1024; *(f32x4*)(outV + ((size_t)u.z * 512 + row) * 1024 + c) = v;
                            const int b = row >> 8, mm = row & 255, h = c >> 8, d = c & 255; bf16_t* p = vt + ((((size_t)u.z * 2 + b) * 4 + h) * 256 + d) * 256 + mm;
                            p[0] = f2bf(v[0]); p[256] = f2bf(v[1]); p[512] = f2bf(v[2]); p[768] = f2bf(v[3]); } } }
    }
};
struct EpiMerge {
    static constexpr bool PERM = true; static constexpr bool ADJ = false; static constexpr bool KEEP = true;
    float* MG; bf16_t* MGB; const bf16_t* U; const float* gate_b;
    __device__ __forceinline__ void operator()(f32x4 (&acc)[2][2][4][2], const Unit& u, int wr, int wc, int fr, int fq) const {
        const int row0 = u.pm * BM + wr * 64 + fr, col0 = u.pn * BM + wc * 32 + 8 * fq; const bool last = u.z == 3; const int zn = last ? 3 : u.z + 1;
#pragma unroll
        for (int bj = 0; bj < 2; ++bj) { const int col = col0 + bj * HALF;
            const f32x4 gb0 = *(const f32x4*)(gate_b + u.z * DM + col), gb1 = *(const f32x4*)(gate_b + u.z * DM + col + 4), gn0 = *(const f32x4*)(gate_b + zn * DM + col), gn1 = *(const f32x4*)(gate_b + zn * DM + col + 4);
#pragma unroll
            for (int ai = 0; ai < 2; ++ai)
#pragma unroll
                for (int m = 0; m < 4; ++m) { const int row = row0 + ai * HALF + m * 16; float gp[8], gq[8], f[8];
                    const bf16_t* up = U + (size_t)row * NINP + U_GP + col;
                    unpack8(*(const u32x4*)(up + u.z * DM), gp); unpack8(*(const u32x4*)(up + zn * DM), gq);
#pragma unroll
                    for (int j = 0; j < 8; ++j) { const float ea = __expf(-fmaxf(gp[j] + (j < 4 ? gb0[j] : gb1[j - 4]), -80.f)), eb = __expf(-fmaxf(gq[j] + (j < 4 ? gn0[j] : gn1[j - 4]), -80.f));
                        f[j] = (last ? 1.0f : 1.0f + eb) * __builtin_amdgcn_rcpf(1.0f + ea); }
#pragma unroll
                    for (int j = 0; j < 4; ++j) { acc[ai][bj][m][0][j] *= f[j]; acc[ai][bj][m][1][j] *= f[4 + j]; }
                    if (last) { const f32x4 a0 = acc[ai][bj][m][0], a1 = acc[ai][bj][m][1];
                        *(u32x4*)(MGB + (size_t)row * DM + col) = (u32x4){pk2(a0[0], a0[1]), pk2(a0[2], a0[3]), pk2(a1[0], a1[1]), pk2(a1[2], a1[3])}; } } }
    }
};
struct EpiRes {
    static constexpr bool PERM = true; static constexpr bool KEEP = false;
    const bf16_t* R; bf16_t* Y;
    __device__ __forceinline__ void operator()(const f32x4 (&acc)[2][2][4][2], const Unit& u, int wr, int wc, int fr, int fq) const {
        const int row0 = u.pm * BM + wr * 64 + fr, col0 = u.pn * BM + wc * 32 + 8 * fq;
#pragma unroll
        for (int ai = 0; ai < 2; ++ai)
#pragma unroll
            for (int m = 0; m < 4; ++m) { const size_t ro = (size_t)(row0 + ai * HALF + m * 16) * DM + col0;
#pragma unroll
                for (int bj = 0; bj < 2; ++bj) { const size_t o = ro + bj * HALF; float rv[8]; unpack8(*(const u32x4*)(R + o), rv);
                    const f32x4 y0 = (f32x4){rv[0], rv[1], rv[2], rv[3]} * ALPHA + acc[ai][bj][m][0], y1 = (f32x4){rv[4], rv[5], rv[6], rv[7]} * ALPHA + acc[ai][bj][m][1];
                    *(u32x4*)(Y + o) = (u32x4){pk2(y0[0], y0[1]), pk2(y0[2], y0[3]), pk2(y1[0], y1[1]), pk2(y1[2], y1[3])}; } }
    }
};
struct EpiSwiGLU {
    static constexpr bool PERM = true; static constexpr bool KEEP = false;
    bf16_t* O;
    __device__ __forceinline__ void operator()(const f32x4 (&acc)[2][2][4][2], const Unit& u, int wr, int wc, int fr, int fq) const {
        const int row0 = u.pm * BM + wr * 64 + fr, col0 = u.pn * HALF + wc * 32 + 8 * fq;
#pragma unroll
        for (int ai = 0; ai < 2; ++ai)
#pragma unroll
            for (int m = 0; m < 4; ++m) { bf16_t* rowp = O + (size_t)(row0 + ai * HALF + m * 16) * DFF + col0;
                float r[8];
#pragma unroll
                for (int n = 0; n < 2; ++n)
#pragma unroll
                    for (int j = 0; j < 4; ++j) { const float gg = acc[ai][0][m][n][j], uu = acc[ai][1][m][n][j]; r[n * 4 + j] = gg * sigmoidf_(gg) * uu; }
                u32x4 w; w.x = pk2(r[0], r[1]); w.y = pk2(r[2], r[3]); w.z = pk2(r[4], r[5]); w.w = pk2(r[6], r[7]);
                *(u32x4*)rowp = w; }
    }
};
struct EpiScore {
    static constexpr bool PERM = false; static constexpr bool KEEP = false;
    float* SC;
    __device__ __forceinline__ void operator()(const f32x4 (&acc)[2][2][4][2], const Unit& u, int wr, int wc, int fr, int fq) const {
        const int row0 = u.pm * BM + wr * 64 + fr, col0 = wc * 32 + 4 * fq; float* base = SC + (size_t)u.z * 4096 * 256;
#pragma unroll
        for (int ai = 0; ai < 2; ++ai)
#pragma unroll
            for (int m = 0; m < 4; ++m) { float* rowp = base + (size_t)(row0 + ai * HALF + m * 16) * 256 + col0;
#pragma unroll
                for (int bj = 0; bj < 2; ++bj)
#pragma unroll
                    for (int n = 0; n < 2; ++n) *(f32x4*)(rowp + bj * HALF + n * 16) = acc[ai][bj][m][n] * 0.0625f; }
    }
};
struct EpiPV {
    static constexpr bool PERM = true; static constexpr bool KEEP = false;
    bf16_t* O;
    __device__ __forceinline__ void operator()(const f32x4 (&acc)[2][2][4][2], const Unit& u, int wr, int wc, int fr, int fq) const {
        const int b = u.z >> 2, h = u.z & 3; const int row0 = b * PS + u.pm * BM + wr * 64 + fr, col0 = h * 256 + wc * 32 + 8 * fq;
#pragma unroll
        for (int ai = 0; ai < 2; ++ai)
#pragma unroll
            for (int m = 0; m < 4; ++m) { bf16_t* rowp = O + (size_t)(row0 + ai * HALF + m * 16) * BW + col0;
#pragma unroll
                for (int bj = 0; bj < 2; ++bj) { const f32x4 v0 = acc[ai][bj][m][0], v1 = acc[ai][bj][m][1];
                    u32x4 w; w.x = pk2(v0[0], v0[1]); w.y = pk2(v0[2], v0[3]); w.z = pk2(v1[0], v1[1]); w.w = pk2(v1[2], v1[3]);
                    *(u32x4*)(rowp + bj * HALF) = w; } }
    }
};
}


#define XB_TMO      128
#define XB_XCNT(j)  (256  + 64 * (j))
#define XB_XSUB(j)  (1280 + 64 * (j))
#define XB_XGEN(j)  (2304 + 64 * (j))
#define XB_TOP      3328
#define XB_TOPGEN   3392
#define XCD_BAR_WORDS 3456
#define XB_SPIN_CAP (1u << 18)
__device__ __forceinline__ unsigned xb_ld(unsigned* p)              { return __hip_atomic_load(p, __ATOMIC_RELAXED, __HIP_MEMORY_SCOPE_AGENT); }
__device__ __forceinline__ unsigned xb_add(unsigned* p, unsigned v) { return __hip_atomic_fetch_add(p, v, __ATOMIC_RELAXED, __HIP_MEMORY_SCOPE_AGENT); }
__device__ __forceinline__ unsigned xb_xcc_id() { return (unsigned)__builtin_amdgcn_s_getreg((3 << 11) | 20) & 0xFu; }
#define XB_SPIN(cond, bar) do { unsigned _sp = 0; while (cond) { __builtin_amdgcn_s_sleep(1); \
    if ((++_sp & 255u) == 0u) { if (xb_ld(&(bar)[XB_TMO])) break; if (_sp > XB_SPIN_CAP) { atomicAdd(&(bar)[XB_TMO], 1u); break; } } } } while (0)
struct XcdBarrier { unsigned* bar; unsigned x; volatile LAS unsigned* st; };
__device__ __forceinline__ XcdBarrier xcd_barrier_post(unsigned* bar, volatile LAS unsigned* st) {
    XcdBarrier b; b.bar = bar; b.x = xb_xcc_id(); b.st = st;
    if (threadIdx.x == 0) (void)xb_add(&bar[XB_XCNT(b.x)], 1u);
    return b;
}
__device__ __forceinline__ void xcd_barrier_complete(unsigned* bar, unsigned x, unsigned& nloc, unsigned& nx) {
    const unsigned G = gridDim.x * gridDim.y * gridDim.z;
    unsigned sum, cnt, mine, sp = 0u;
    for (;;) {
        sum = 0u; cnt = 0u; mine = 0u;
#pragma unroll
        for (unsigned j = 0; j < 16; ++j) { const unsigned c = xb_ld(&bar[XB_XCNT(j)]); sum += c; cnt += (c > 0u) ? 1u : 0u; mine = (j == x) ? c : mine; }
        if (sum == G) break;
        __builtin_amdgcn_s_sleep(1);
        if ((++sp & 255u) == 0u) { if (xb_ld(&bar[XB_TMO])) break; if (sp > XB_SPIN_CAP) { atomicAdd(&bar[XB_TMO], 1u); break; } }
    }
    nloc = mine > 0u ? mine : 1u; nx = cnt > 0u ? cnt : 1u;
}
__device__ __forceinline__ void xcd_barrier(const XcdBarrier& b, const bool thread0) {
    asm volatile("s_waitcnt vmcnt(0)" ::: "memory");
    __syncthreads();
    if (thread0) {
        unsigned* bar = b.bar;
        __builtin_amdgcn_s_waitcnt(0);
        unsigned nloc = b.st[0], nx = b.st[1];
        if (nloc == 0u) { xcd_barrier_complete(bar, b.x, nloc, nx); b.st[0] = nloc; b.st[1] = nx; }
        const unsigned old = xb_add(&bar[XB_XSUB(b.x)], 1u);
        const unsigned gen = old / nloc;
        if (old + 1u == (gen + 1u) * nloc) {
            __builtin_amdgcn_fence(__ATOMIC_RELEASE, "agent");
            asm volatile("s_waitcnt vmcnt(0)" ::: "memory");
            const unsigned og = xb_add(&bar[XB_TOP], 1u);
            const unsigned tg = og / nx;
            if (og + 1u == (tg + 1u) * nx) xb_add(&bar[XB_TOPGEN], 1u);
            else XB_SPIN(xb_ld(&bar[XB_TOPGEN]) == tg, bar);
            __builtin_amdgcn_fence(__ATOMIC_ACQUIRE, "agent");
            xb_add(&bar[XB_XGEN(b.x)], 1u);
            asm volatile("s_waitcnt vmcnt(0)" ::: "memory");
        } else {
            XB_SPIN(xb_ld(&bar[XB_XGEN(b.x)]) == gen, bar);
            __builtin_amdgcn_fence(__ATOMIC_ACQUIRE, "agent");
            asm volatile("s_waitcnt vmcnt(0)" ::: "memory");
        }
    }
    __syncthreads();
}

struct Ctx { int tid, lane, wave, bid, G; LAS unsigned char* lds; };
__device__ __forceinline__ Ctx fresh(const Ctx& c0) { Ctx c; c.wave = c0.wave; c.bid = c0.bid; c.G = c0.G; c.lds = c0.lds; asm volatile("" : "+s"(c.bid), "+s"(c.G), "+s"(c.wave));
    int lane; asm volatile("v_mbcnt_lo_u32_b32 %0, -1, 0\n\tv_mbcnt_hi_u32_b32 %0, -1, %0" : "=v"(lane)); c.lane = lane; c.tid = c.wave * 64 + lane; return c; }

__device__ __forceinline__ int colmap(int mode, int n) {
    if (mode == 1) return n < 3088 ? n : (n < 3328 ? -1 : n - 240);
    if (mode == 2) { const int t = n >> 8, j = n & 255; return j < 128 ? t * 128 + j : DFF + t * 128 + (j - 128); }
    return n;
}
__device__ __forceinline__ void wprep_load(f32x4 (&rg)[8], const float* __restrict__ src, int K, int Nsrc, int Ndst, int mode, size_t sbs, int item, int tid) {
    const int nx = Ndst / 256, ny = K / 64; const int bx = item % nx, by = (item / nx) % ny, bz = item / (nx * ny);
    const int tx = tid & 63, ty = tid >> 6, cm = colmap(mode, bx * 256 + tx * 4); const float* s = src + (size_t)bz * sbs + (size_t)(by * 64 + ty) * Nsrc + cm;
#pragma unroll
    for (int i = 0; i < 8; ++i) rg[i] = cm >= 0 ? *(const f32x4*)(s + (size_t)(8 * i) * Nsrc) : (f32x4){0.f, 0.f, 0.f, 0.f};
}
__device__ __forceinline__ void ph_wprep(const Ctx& c, const float* __restrict__ src, bf16_t* __restrict__ dst, int K, int Nsrc, int Ndst, int mode, int nbatch, size_t sbs, size_t dbs) {
    LAS float* tile = (LAS float*)c.lds;
    const int nx = Ndst / 256, ny = K / 64, total = nx * ny * nbatch;
    const int tid = c.tid, tx = tid & 63, ty = tid >> 6, n = tid >> 1, kh = tid & 1;
    f32x4 rg[8];
    int item = c.bid;
    if (item < total) wprep_load(rg, src, K, Nsrc, Ndst, mode, sbs, item, tid);
    for (; item < total; item += c.G) {
        __syncthreads();
#pragma unroll
        for (int i = 0; i < 8; ++i) *(LAS f32x4*)(tile + (ty + 8 * i) * 260 + tx * 4) = rg[i];
        __syncthreads();
        const int bx = item % nx, by = (item / nx) % ny, bz = item / (nx * ny);
        if (item + c.G < total) wprep_load(rg, src, K, Nsrc, Ndst, mode, sbs, item + c.G, tid);
        bf16_t* d = dst + (size_t)bz * dbs + (size_t)(bx * 256 + n) * K + by * 64 + kh * 32;
#pragma unroll
        for (int g = 0; g < 4; ++g) { unsigned p[4];
#pragma unroll
            for (int e = 0; e < 4; ++e) p[e] = pk2(tile[(kh * 32 + g * 8 + 2 * e) * 260 + n], tile[(kh * 32 + g * 8 + 2 * e + 1) * 260 + n]);
            *(u32x4*)(d + g * 8) = (u32x4){p[0], p[1], p[2], p[3]}; }
    }
    __syncthreads();
}
constexpr int WD_CH = 4, WD_N0 = (NINP / 256) * (DM / 64), WD_N1 = 4 * (DM / 256) * (BW / 64), WD_N2 = (DM / 256) * (DM / 64), WD_N3 = (2 * DFF / 256) * (DM / 64), WD_N4 = (DM / 256) * (DFF / 64);
constexpr int WD_TOTAL = WD_N0 + WD_N1 + WD_N2 + WD_N3 + WD_N4;
struct WDesc { const float* src; bf16_t* dst; int K, Nsrc, Ndst, mode, item; size_t sbs, dbs; };
__device__ __forceinline__ WDesc wd_decode(int it, const float* s0, const float* s1, const float* s2, const float* s3, const float* s4, bf16_t* d0, bf16_t* d1, bf16_t* d2, bf16_t* d3, bf16_t* d4) {
    WDesc d;
    if (it < WD_N0) { d.src = s0; d.dst = d0; d.K = DM; d.Nsrc = NIN; d.Ndst = NINP; d.mode = 1; d.item = it; d.sbs = 0; d.dbs = 0; }
    else if (it < WD_N0 + WD_N1) { d.src = s1; d.dst = d1; d.K = BW; d.Nsrc = DM; d.Ndst = DM; d.mode = 0; d.item = it - WD_N0; d.sbs = (size_t)BW * DM; d.dbs = (size_t)DM * BW; }
    else if (it < WD_N0 + WD_N1 + WD_N2) { d.src = s2; d.dst = d2; d.K = DM; d.Nsrc = DM; d.Ndst = DM; d.mode = 0; d.item = it - WD_N0 - WD_N1; d.sbs = 0; d.dbs = 0; }
    else if (it < WD_N0 + WD_N1 + WD_N2 + WD_N3) { d.src = s3; d.dst = d3; d.K = DM; d.Nsrc = 2 * DFF; d.Ndst = 2 * DFF; d.mode = 2; d.item = it - WD_N0 - WD_N1 - WD_N2; d.sbs = 0; d.dbs = 0; }
    else { d.src = s4; d.dst = d4; d.K = DFF; d.Nsrc = DM; d.Ndst = DM; d.mode = 0; d.item = it - WD_N0 - WD_N1 - WD_N2 - WD_N3; d.sbs = 0; d.dbs = 0; }
    return d;
}
__device__ __forceinline__ void ph_wprep_dyn(const Ctx& c, unsigned* ctr, const float* s0, const float* s1, const float* s2, const float* s3, const float* s4, bf16_t* d0, bf16_t* d1, bf16_t* d2, bf16_t* d3, bf16_t* d4) {
    LAS float* tile = (LAS float*)c.lds;
    LAS int* slot = (LAS int*)(c.lds + 64 * 260 * 4 + 64);
    const int tid = c.tid, n = tid >> 1, kh = tid & 1, tx = tid & 63, ty = tid >> 6;
    __syncthreads();
    if (tid == 0) slot[0] = (int)__hip_atomic_fetch_add(ctr, 1u, __ATOMIC_RELAXED, __HIP_MEMORY_SCOPE_AGENT);
    __syncthreads();
    int it = slot[0] * WD_CH, pos = 0; unsigned nxt_chunk = 0u;
    f32x4 rg[8];
    if (it < WD_TOTAL) { const WDesc d = wd_decode(it, s0, s1, s2, s3, s4, d0, d1, d2, d3, d4); wprep_load(rg, d.src, d.K, d.Nsrc, d.Ndst, d.mode, d.sbs, d.item, tid); }
    while (it < WD_TOTAL) {
        __syncthreads();
        if (tid == 0) { if (pos == 0) nxt_chunk = __hip_atomic_fetch_add(ctr, 1u, __ATOMIC_RELAXED, __HIP_MEMORY_SCOPE_AGENT); else if (pos == 1) slot[1] = (int)nxt_chunk; }
#pragma unroll
        for (int i = 0; i < 8; ++i) *(LAS f32x4*)(tile + (ty + 8 * i) * 260 + tx * 4) = rg[i];
        __syncthreads();
        const WDesc d = wd_decode(it, s0, s1, s2, s3, s4, d0, d1, d2, d3, d4);
        int nit, npos;
        if (pos + 1 < WD_CH) { nit = it + 1; npos = pos + 1; } else { nit = slot[1] * WD_CH; npos = 0; }
        if (nit < WD_TOTAL) { const WDesc dn = wd_decode(nit, s0, s1, s2, s3, s4, d0, d1, d2, d3, d4); wprep_load(rg, dn.src, dn.K, dn.Nsrc, dn.Ndst, dn.mode, dn.sbs, dn.item, tid); }
        { const int nx = d.Ndst / 256, ny = d.K / 64; const int bx = d.item % nx, by = (d.item / nx) % ny, bz = d.item / (nx * ny);
          bf16_t* dp = d.dst + (size_t)bz * d.dbs + (size_t)(bx * 256 + n) * d.K + by * 64 + kh * 32;
#pragma unroll
          for (int g = 0; g < 4; ++g) { unsigned p[4];
#pragma unroll
              for (int e = 0; e < 4; ++e) p[e] = pk2(tile[(kh * 32 + g * 8 + 2 * e) * 260 + n], tile[(kh * 32 + g * 8 + 2 * e + 1) * 260 + n]);
              *(u32x4*)(dp + g * 8) = (u32x4){p[0], p[1], p[2], p[3]}; } }
        it = nit; pos = npos;
    }
    __syncthreads();
}
__device__ __forceinline__ void ph_xprep(const Ctx& c, const float* __restrict__ xp, const float* __restrict__ xs, const float* __restrict__ mem, float* __restrict__ HF, bf16_t* __restrict__ HB, bf16_t* __restrict__ MEMB) {
    const size_t nH = (size_t)MPAD * DM / 4, nM = (size_t)512 * DM / 4;
    for (size_t i4 = (size_t)c.bid * 512 + c.tid; i4 < nH + nM; i4 += (size_t)c.G * 512) {
        if (i4 < nH) {
            const size_t e = i4 * 4; f32x4 v = (f32x4){0.f, 0.f, 0.f, 0.f};
            if (e < (size_t)MP * DM) v = *(const f32x4*)(xp + e); else if (e < (size_t)MT * DM) v = *(const f32x4*)(xs + (e - (size_t)MP * DM));
            if (HF != nullptr) *(f32x4*)(HF + e) = v;
            u32x2 w; w.x = pk2(v[0], v[1]); w.y = pk2(v[2], v[3]); *(u32x2*)(HB + e) = w;
        } else {
            const size_t e = (i4 - nH) * 4; const f32x4 v = *(const f32x4*)(mem + e); u32x2 w; w.x = pk2(v[0], v[1]); w.y = pk2(v[2], v[3]); *(u32x2*)(MEMB + e) = w;
        }
    }
}
__device__ __forceinline__ void ph_ln(const Ctx& c, const bf16_t* __restrict__ Y, const float* __restrict__ g, const float* __restrict__ b, float* __restrict__ XF, bf16_t* __restrict__ XB, float* __restrict__ OUT, int nrows, int nout) {
    const int lane = c.lane;
    for (int row = c.bid * 8 + c.wave; row < nrows; row += c.G * 8) {
        const bf16_t* y = Y + (size_t)row * DM; float v[4][8]; float s = 0.f;
#pragma unroll
        for (int j = 0; j < 4; ++j) { unpack8(*(const u32x4*)(y + j * 512 + lane * 8), v[j]);
#pragma unroll
            for (int e2 = 0; e2 < 8; ++e2) s += v[j][e2]; }
        const float mean = wave_sum(s) * (1.0f / DM); float q = 0.f;
#pragma unroll
        for (int j = 0; j < 4; ++j)
#pragma unroll
            for (int e2 = 0; e2 < 8; ++e2) { const float d = v[j][e2] - mean; q += d * d; }
        const float rstd = rsqrtf(wave_sum(q) * (1.0f / DM) + 1e-5f);
#pragma unroll
        for (int j = 0; j < 4; ++j) { const int cc = j * 512 + lane * 8; const f32x4 g0 = *(const f32x4*)(g + cc), g1 = *(const f32x4*)(g + cc + 4), b0 = *(const f32x4*)(b + cc), b1 = *(const f32x4*)(b + cc + 4);
            const f32x4 o0 = ((f32x4){v[j][0], v[j][1], v[j][2], v[j][3]} - mean) * rstd * g0 + b0, o1 = ((f32x4){v[j][4], v[j][5], v[j][6], v[j][7]} - mean) * rstd * g1 + b1;
            const size_t off = (size_t)row * DM + cc;
            if (XF != nullptr) { *(f32x4*)(XF + off) = o0; *(f32x4*)(XF + off + 4) = o1; }
            *(u32x4*)(XB + off) = (u32x4){pk2(o0[0], o0[1]), pk2(o0[2], o0[3]), pk2(o1[0], o1[1]), pk2(o1[2], o1[3])};
            if (OUT != nullptr && row < nout) { *(f32x4*)(OUT + off) = o0; *(f32x4*)(OUT + off + 4) = o1; } }
    }
}
__device__ __forceinline__ void ph_softmax256(const Ctx& c, const float* __restrict__ SC, bf16_t* __restrict__ P, int nrows) {
    const int lane = c.lane;
    for (int row = c.bid * 8 + c.wave; row < nrows; row += c.G * 8) {
        const f32x4 v = *(const f32x4*)(SC + (size_t)row * 256 + lane * 4);
        const float mx = wave_max(fmaxf(fmaxf(v[0], v[1]), fmaxf(v[2], v[3])));
        f32x4 e; e[0] = __expf(v[0] - mx); e[1] = __expf(v[1] - mx); e[2] = __expf(v[2] - mx); e[3] = __expf(v[3] - mx);
        const float inv = 1.0f / wave_sum((e[0] + e[1]) + (e[2] + e[3]));
        u32x2 w; w.x = pk2(e[0] * inv, e[1] * inv); w.y = pk2(e[2] * inv, e[3] * inv); *(u32x2*)(P + (size_t)row * 256 + lane * 4) = w;
    }
}
__device__ __forceinline__ void ph_copy_outs(const Ctx& c, const bf16_t* __restrict__ U, const float* __restrict__ ck, const float* __restrict__ cv, float* __restrict__ out, int layer) {
    constexpr int nA = PB * 128 * 128, nB = SB * 128 * 128, nC = PB * RWC, nD = SB * RWC;
    for (int i = c.bid * 512 + c.tid; i < nA + nB + nC + nD; i += c.G * 512) {
        if (i < nA) { const int b = i / 16384, j = (i >> 7) & 127, cc = i & 127; const size_t ur = (size_t)(b * PS + PS - 128 + j) * NINP;
            out[O_SWKP + (size_t)layer * nA + i] = bf2f(U[ur + U_SK + cc]); out[O_SWVP + (size_t)layer * nA + i] = bf2f(U[ur + U_SV + cc]); continue; }
        int k = i - nA;
        if (k < nB) { const int sq = k / 16384, j = (k >> 7) & 127, cc = k & 127; float kv, vv;
            if (j < 124) { const size_t o = ((size_t)sq * 128 + j + 4) * 128 + cc; kv = ck[o]; vv = cv[o]; }
            else { const size_t ur = (size_t)(MP + sq * SS + j - 124) * NINP; kv = bf2f(U[ur + U_SK + cc]); vv = bf2f(U[ur + U_SV + cc]); }
            out[O_SWKS + (size_t)layer * nB + k] = kv; out[O_SWVS + (size_t)layer * nB + k] = vv; continue; }
        k -= nB;
        if (k < nC) { const int b = k / RWC, cc = k - b * RWC; out[O_RSP + (size_t)layer * nC + k] = bf2f(U[(size_t)(b * PS + PS - 1) * NINP + U_RU + cc]); continue; }
        k -= nC;
        { const int sq = k / RWC, cc = k - sq * RWC; out[O_RSS + (size_t)layer * nD + k] = bf2f(U[(size_t)(MP + sq * SS + SS - 1) * NINP + U_RU + cc]); }
    }
}

__device__ __forceinline__ void seq_info(int sq, int& row0, int& L) { if (sq < PB) { row0 = sq * PS; L = PS; } else { row0 = MP + (sq - PB) * SS; L = SS; } }

__device__ __forceinline__ void ph_gla_naive(const Ctx& c, const bf16_t* __restrict__ U, const float* __restrict__ s0, const float* __restrict__ a_up, const float* __restrict__ a_b,
                                             const float* __restrict__ ng, const float* __restrict__ nb, bf16_t* __restrict__ OB, float* __restrict__ outP, float* __restrict__ outS) {
    LAS float* qs = (LAS float*)c.lds;
    LAS float* ks = qs + 16 * 128; LAS float* as = ks + 16 * 128; LAS float* os = as + 16 * 128;
    const int kh = c.tid >> 8, vt = c.tid & 255, lane = c.lane;
    for (int u = c.bid; u < (PB + SB) * 4; u += c.G) {
        const int sq = u >> 2, h = u & 3;
        int row0, L; seq_info(sq, row0, L);
        float S[64];
        if (sq >= PB) { const float* p = s0 + (((size_t)(sq - PB) * 4 + h) * 128 + kh * 64) * 256 + vt;
#pragma unroll
            for (int kk = 0; kk < 64; ++kk) S[kk] = p[(size_t)kk * 256]; }
        else {
#pragma unroll
            for (int kk = 0; kk < 64; ++kk) S[kk] = 0.f; }
        for (int t0 = 0; t0 < L; t0 += 16) {
            const int nT = (L - t0) < 16 ? (L - t0) : 16;
            for (int idx = c.tid; idx < nT * 128; idx += 512) {
                const int tt = idx >> 7, kk = idx & 127; const bf16_t* ur = U + (size_t)(row0 + t0 + tt) * NINP;
                qs[idx] = bf2f(ur[U_GQ + h * 128 + kk]) * 0.08838834764831845f; ks[idx] = bf2f(ur[U_GK + h * 128 + kk]);
                float x = a_b[h * 128 + kk];
#pragma unroll
                for (int r = 0; r < 16; ++r) x += bf2f(ur[U_GA + r]) * a_up[r * 512 + h * 128 + kk];
                const float ls = (fminf(x, 0.f) - log1pf(__expf(-fabsf(x)))) * (1.0f / 16.0f);
                as[idx] = __expf(ls);
            }
            __syncthreads();
            for (int tt = 0; tt < nT; ++tt) {
                const float v = bf2f(U[(size_t)(row0 + t0 + tt) * NINP + U_GV + h * 256 + vt]); float o = 0.f; const int lb = tt * 128 + kh * 64;
#pragma unroll
                for (int kk = 0; kk < 64; ++kk) { S[kk] = as[lb + kk] * S[kk] + ks[lb + kk] * v; o += qs[lb + kk] * S[kk]; }
                os[(kh * 16 + tt) * 256 + vt] = o;
            }
            __syncthreads();
            for (int tt = c.wave; tt < nT; tt += 8) {
                float x[4]; float s = 0.f;
#pragma unroll
                for (int j = 0; j < 4; ++j) { x[j] = os[tt * 256 + lane + 64 * j] + os[(16 + tt) * 256 + lane + 64 * j]; s += x[j]; }
                const float mean = wave_sum(s) * (1.0f / 256.0f); float q = 0.f;
#pragma unroll
                for (int j = 0; j < 4; ++j) { const float d = x[j] - mean; q += d * d; }
                const float rstd = rsqrtf(wave_sum(q) * (1.0f / 256.0f) + 1e-5f);
                const size_t row = (size_t)(row0 + t0 + tt);
#pragma unroll
                for (int j = 0; j < 4; ++j) { const int cc = h * 256 + lane + 64 * j; const float n = (x[j] - mean) * rstd * ng[cc] + nb[cc];
                    const float gr = bf2f(U[row * NINP + U_GR + cc]); OB[row * BW + cc] = f2bf(n * gr * sigmoidf_(gr)); }
            }
            __syncthreads();
        }
        float* op = (sq < PB ? outP + (((size_t)sq * 4 + h) * 128 + kh * 64) * 256 : outS + (((size_t)(sq - PB) * 4 + h) * 128 + kh * 64) * 256) + vt;
#pragma unroll
        for (int kk = 0; kk < 64; ++kk) op[(size_t)kk * 256] = S[kk];
    }
}

__device__ __forceinline__ f32x4 mma16(bf16x8 x, bf16x8 y, f32x4 c) { return __builtin_amdgcn_mfma_f32_16x16x32_bf16(x, y, c, 0, 0, 0); }
__device__ __forceinline__ bf16x8 pack_acc(const f32x4& a, const f32x4& b) {
    u32x4 p; p.x = pk2(a[0], a[1]); p.y = pk2(a[2], a[3]); p.z = pk2(b[0], b[1]); p.w = pk2(b[2], b[3]); return __builtin_bit_cast(bf16x8, p);
}
__device__ __forceinline__ void gla_chunk_info(int u, int& row0, int& ntok, int& h) {
    if (u < 512) { const int b = u >> 8; h = (u >> 6) & 3; row0 = b * PS + (u & 63) * 64; ntok = 64; }
    else { const int s = u - 512; h = s & 3; row0 = MP + (s >> 2) * SS; ntok = SS; }
}
__device__ __forceinline__ void ph_gla_pre(const Ctx& c, const bf16_t* __restrict__ U, const float* __restrict__ a_up, const float* __restrict__ a_b,
                                           bf16_t* __restrict__ QD, bf16_t* __restrict__ KHT, bf16_t* __restrict__ EE, bf16_t* __restrict__ VT, float* __restrict__ GC) {
    LAS float* ga_l = (LAS float*)c.lds;
    LAS float* tot = ga_l + 64 * 16;
    LAS bf16_t* Qd_l = (LAS bf16_t*)(tot + 4 * 128);
    LAS bf16_t* Kn_l = Qd_l + 64 * 136;
    LAS bf16_t* v_l = Kn_l + 64 * 136;
    LAS bf16_t* qr_l = v_l + 64 * 264;
    LAS bf16_t* kr_l = qr_l + 64 * 136;
    const int tid = c.tid, lane = c.lane, r = lane & 15, q = lane >> 4, w = c.wave;
    for (int u = (c.bid + c.G / 2) % c.G; u < GL_NCH; u += c.G) {
        int row0, ntok, h; gla_chunk_info(u, row0, ntok, h);
        for (int i = tid; i < 64 * 16; i += 512) { const int t = i >> 4, rr = i & 15; ga_l[i] = t < ntok ? bf2f(U[(size_t)(row0 + t) * NINP + U_GA + rr]) : 0.f; }
        for (int i = tid; i < 64 * 32; i += 512) { const int t = i >> 5, c8 = i & 31; u32x4 vv = (u32x4){0u, 0u, 0u, 0u};
            if (t < ntok) vv = *(const u32x4*)(U + (size_t)(row0 + t) * NINP + U_GV + h * 256 + c8 * 8);
            *(LAS u32x4*)(v_l + t * 264 + c8 * 8) = vv; }
        for (int i = tid; i < 64 * 16; i += 512) { const int t = i >> 4, c8 = i & 15; u32x4 qv = (u32x4){0u, 0u, 0u, 0u}, kv = qv;
            if (t < ntok) { const bf16_t* ur = U + (size_t)(row0 + t) * NINP + h * 128 + c8 * 8; qv = *(const u32x4*)(ur + U_GQ); kv = *(const u32x4*)(ur + U_GK); }
            *(LAS u32x4*)(qr_l + t * 136 + c8 * 8) = qv; *(LAS u32x4*)(kr_l + t * 136 + c8 * 8) = kv; }
        __syncthreads();
        const int kk = tid & 127, tq = tid >> 7;
        float cum[16];
        { float aup[16];
#pragma unroll
          for (int rr = 0; rr < 16; ++rr) aup[rr] = a_up[rr * 512 + h * 128 + kk];
          const float ab = a_b[h * 128 + kk]; float run = 0.f;
#pragma unroll
          for (int j = 0; j < 16; ++j) { const int t = tq * 16 + j; float x = ab;
#pragma unroll
              for (int rr = 0; rr < 16; ++rr) x += ga_l[t * 16 + rr] * aup[rr];
              const float la = t < ntok ? (fminf(x, 0.f) - __logf(1.0f + __expf(-fabsf(x)))) * (1.0f / 16.0f) : 0.f;
              run += la; cum[j] = run; }
          tot[tq * 128 + kk] = run; }
        __syncthreads();
        { float prefix = 0.f, bC = 0.f;
#pragma unroll
          for (int g = 0; g < 4; ++g) { const float tv = tot[g * 128 + kk]; bC += tv; if (g < tq) prefix += tv; }
          unsigned khp[8];
#pragma unroll
          for (int j = 0; j < 16; j += 2) { float kh2[2];
#pragma unroll
              for (int e = 0; e < 2; ++e) { const int t = tq * 16 + j + e; const float b = prefix + cum[j + e]; const float qv = bf2f(qr_l[t * 136 + kk]), kv = bf2f(kr_l[t * 136 + kk]);
                  Qd_l[t * 136 + kk] = f2bf(qv * __expf(b) * 0.08838834764831845f); Kn_l[t * 136 + kk] = f2bf(kv * __expf(-b)); kh2[e] = kv * __expf(bC - b); }
              khp[j >> 1] = pk2(kh2[0], kh2[1]); }
          bf16_t* kp = KHT + (size_t)u * 8192 + kk * 64 + tq * 16;
          *(u32x4*)kp = (u32x4){khp[0], khp[1], khp[2], khp[3]}; *(u32x4*)(kp + 8) = (u32x4){khp[4], khp[5], khp[6], khp[7]};
          if (tq == 0) GC[(size_t)u * 128 + kk] = __expf(bC); }
        __syncthreads();
        { const int tb = w >> 1;
#pragma unroll
          for (int e = 0; e < 2; ++e) { const int ib = (w & 1) * 2 + e; f32x4 d = (f32x4){0.f, 0.f, 0.f, 0.f};
              if (ib <= tb) {
                  bf16x8 kf4[4], qf4[4];
#pragma unroll
                  for (int ks = 0; ks < 4; ++ks) { kf4[ks] = *(const LAS bf16x8*)(Kn_l + (ib * 16 + r) * 136 + ks * 32 + q * 8); qf4[ks] = *(const LAS bf16x8*)(Qd_l + (tb * 16 + r) * 136 + ks * 32 + q * 8); }
                  __builtin_amdgcn_sched_barrier(0);
#pragma unroll
                  for (int ks = 0; ks < 4; ++ks) d = mma16(kf4[ks], qf4[ks], d); }
              const int t = tb * 16 + r, i0 = ib * 16 + q * 4;
#pragma unroll
              for (int jj = 0; jj < 4; ++jj) if (i0 + jj > t) d[jj] = 0.f;
              u32x2 o; o.x = pk2(d[0], d[1]); o.y = pk2(d[2], d[3]); *(u32x2*)(EE + (size_t)u * 4096 + t * 64 + i0) = o; } }
        for (int i = tid; i < 64 * 16; i += 512) { const int t = i >> 4, c8 = i & 15; *(u32x4*)(QD + (size_t)u * 8192 + t * 128 + c8 * 8) = *(const LAS u32x4*)(Qd_l + t * 136 + c8 * 8); }
        { const int val = tid & 255, th = tid >> 8;
#pragma unroll
          for (int tg = 0; tg < 4; ++tg) { const int t0 = th * 32 + tg * 8; unsigned p4[4];
#pragma unroll
              for (int e = 0; e < 4; ++e) p4[e] = (unsigned)v_l[(t0 + 2 * e) * 264 + val] | ((unsigned)v_l[(t0 + 2 * e + 1) * 264 + val] << 16);
              *(u32x4*)(VT + (size_t)u * 16384 + val * 64 + t0) = (u32x4){p4[0], p4[1], p4[2], p4[3]}; } }
        __syncthreads();
    }
}
struct GlaStage { u32x4 qd[2], kh[2], e, vt, gc; };
__device__ __forceinline__ void gla_stage_load(GlaStage& s, const bf16_t* __restrict__ QD, const bf16_t* __restrict__ KHT, const bf16_t* __restrict__ EE, const bf16_t* __restrict__ VT, const float* __restrict__ GC,
                                               int ch, int sl, int tid) {
    const bf16_t* qp = QD + (size_t)ch * 8192 + tid * 8; s.qd[0] = *(const u32x4*)qp; s.qd[1] = *(const u32x4*)(qp + 4096);
    const bf16_t* kp = KHT + (size_t)ch * 8192 + tid * 8; s.kh[0] = *(const u32x4*)kp; s.kh[1] = *(const u32x4*)(kp + 4096);
    s.e = *(const u32x4*)(EE + (size_t)ch * 4096 + tid * 8);
    s.vt = *(const u32x4*)(VT + (size_t)ch * 16384 + sl * 4096 + tid * 8);
    if (tid < 32) s.gc = *(const u32x4*)(GC + (size_t)ch * 128 + tid * 4);
}
constexpr int GS_KH = 8704, GS_E = 17920, GS_VT = 22528, GS_GC = 27136, GS_EL = 27392;
__device__ __forceinline__ void gla_stage_store(const GlaStage& s, LAS bf16_t* b, int tid) {
    *(LAS u32x4*)(b + (tid >> 4) * 136 + (tid & 15) * 8) = s.qd[0]; *(LAS u32x4*)(b + (32 + (tid >> 4)) * 136 + (tid & 15) * 8) = s.qd[1];
    *(LAS u32x4*)(b + GS_KH + (tid >> 3) * 72 + (tid & 7) * 8) = s.kh[0]; *(LAS u32x4*)(b + GS_KH + (64 + (tid >> 3)) * 72 + (tid & 7) * 8) = s.kh[1];
    *(LAS u32x4*)(b + GS_E + (tid >> 3) * 72 + (tid & 7) * 8) = s.e; *(LAS u32x4*)(b + GS_VT + (tid >> 3) * 72 + (tid & 7) * 8) = s.vt;
    if (tid < 32) *(LAS u32x4*)(b + GS_GC + tid * 8) = s.gc;
}
__device__ __forceinline__ void ph_gla_seq(const Ctx& c, int boff, const bf16_t* __restrict__ QD, const bf16_t* __restrict__ KHT, const bf16_t* __restrict__ EE, const bf16_t* __restrict__ VT, const float* __restrict__ GC,
                                           const float* __restrict__ s0, float* __restrict__ outP, float* __restrict__ outS, bf16_t* __restrict__ OB) {
    LAS bf16_t* stg = (LAS bf16_t*)c.lds;
    LAS bf16_t* T_l = stg + 2 * GS_EL;
    const int tid = c.tid, lane = c.lane, r = lane & 15, q = lane >> 4, w = c.wave;
    const int side = c.bid < 32 ? c.bid : c.bid - 64, nside = c.G - 64;
    for (int u = (c.bid >= boff && c.bid < boff + 32) ? c.bid - boff : ((c.bid < 32 || c.bid >= 96) ? 32 + side : 32 + 512); u < 32 + 512; u = u < 32 ? 32 + 512 : u + nside) {
        int h, sl, nch, ch0, row0, ntok; const float* sp = nullptr; float* op;
        if (u < 32) { const int b = u >> 4; h = (u >> 2) & 3; sl = u & 3; nch = 64; ch0 = (b * 4 + h) * 64; row0 = b * PS; ntok = 64; op = outP + (size_t)(b * 4 + h) * 32768; }
        else { const int s = u - 32, sq = s >> 4; h = (s >> 2) & 3; sl = s & 3; nch = 1; ch0 = 512 + sq * 4 + h; row0 = MP + sq * SS; ntok = SS; sp = s0 + (size_t)(sq * 4 + h) * 32768; op = outS + (size_t)(sq * 4 + h) * 32768; }
        f32x4 acc[4];
#pragma unroll
        for (int vb = 0; vb < 4; ++vb)
#pragma unroll
            for (int jj = 0; jj < 4; ++jj) acc[vb][jj] = sp ? sp[(size_t)(w * 16 + q * 4 + jj) * 256 + sl * 64 + vb * 16 + r] : 0.f;
        GlaStage R0, R1, R2;
        gla_stage_load(R0, QD, KHT, EE, VT, GC, ch0, sl, tid);
        if (1 < nch) gla_stage_load(R1, QD, KHT, EE, VT, GC, ch0 + 1, sl, tid);
        if (2 < nch) gla_stage_load(R2, QD, KHT, EE, VT, GC, ch0 + 2, sl, tid);
        __syncthreads();
        gla_stage_store(R0, stg, tid);
        if (3 < nch) gla_stage_load(R0, QD, KHT, EE, VT, GC, ch0 + 3, sl, tid);
#define GLA_STEP(ci, RN) do { \
            LAS bf16_t* Tb = T_l + ((ci) & 1) * 64 * 136; const LAS bf16_t* sb = stg + ((ci) & 1) * GS_EL; \
            _Pragma("unroll") for (int vb = 0; vb < 4; ++vb) { u32x2 o; o.x = pk2(acc[vb][0], acc[vb][1]); o.y = pk2(acc[vb][2], acc[vb][3]); *(LAS u32x2*)(Tb + (vb * 16 + r) * 136 + w * 16 + q * 4) = o; } \
            __syncthreads(); \
            if ((ci) + 1 < nch) { gla_stage_store(RN, stg + (((ci) + 1) & 1) * GS_EL, tid); if ((ci) + 4 < nch) gla_stage_load(RN, QD, KHT, EE, VT, GC, ch0 + (ci) + 4, sl, tid); } \
            { const int rb = w >> 1, t = rb * 16 + r; bf16x8 qf[4], ef[2]; \
              _Pragma("unroll") for (int ks = 0; ks < 4; ++ks) qf[ks] = *(const LAS bf16x8*)(sb + (rb * 16 + r) * 136 + ks * 32 + q * 8); \
              _Pragma("unroll") for (int ks = 0; ks < 2; ++ks) ef[ks] = *(const LAS bf16x8*)(sb + GS_E + (rb * 16 + r) * 72 + ks * 32 + q * 8); \
              bf16x8 tf[2][4], vf[2][2]; \
              _Pragma("unroll") for (int e2 = 0; e2 < 2; ++e2) { const int cb = (w & 1) * 2 + e2; \
                  _Pragma("unroll") for (int ks = 0; ks < 4; ++ks) tf[e2][ks] = *(const LAS bf16x8*)(Tb + (cb * 16 + r) * 136 + ks * 32 + q * 8); \
                  _Pragma("unroll") for (int ks = 0; ks < 2; ++ks) vf[e2][ks] = *(const LAS bf16x8*)(sb + GS_VT + (cb * 16 + r) * 72 + ks * 32 + q * 8); } \
              __builtin_amdgcn_sched_barrier(0); \
              _Pragma("unroll") for (int e2 = 0; e2 < 2; ++e2) { const int cb = (w & 1) * 2 + e2; f32x4 y = (f32x4){0.f, 0.f, 0.f, 0.f}; \
                  _Pragma("unroll") for (int ks = 0; ks < 4; ++ks) y = mma16(tf[e2][ks], qf[ks], y); \
                  _Pragma("unroll") for (int ks = 0; ks < 2; ++ks) y = mma16(vf[e2][ks], ef[ks], y); \
                  if (t < ntok) { u32x2 o; o.x = pk2(y[0], y[1]); o.y = pk2(y[2], y[3]); *(u32x2*)(OB + (size_t)(row0 + (ci) * 64 + t) * BW + h * 256 + sl * 64 + cb * 16 + q * 4) = o; } } } \
            { const f32x4 gcv = *(const LAS f32x4*)((const LAS float*)(sb + GS_GC) + w * 16 + q * 4); bf16x8 kf[2]; \
              _Pragma("unroll") for (int ks = 0; ks < 2; ++ks) kf[ks] = *(const LAS bf16x8*)(sb + GS_KH + (w * 16 + r) * 72 + ks * 32 + q * 8); \
              bf16x8 vs[4][2]; \
              _Pragma("unroll") for (int vb = 0; vb < 4; ++vb) _Pragma("unroll") for (int ks = 0; ks < 2; ++ks) vs[vb][ks] = *(const LAS bf16x8*)(sb + GS_VT + (vb * 16 + r) * 72 + ks * 32 + q * 8); \
              __builtin_amdgcn_sched_barrier(0); \
              _Pragma("unroll") for (int vb = 0; vb < 4; ++vb) { acc[vb] = acc[vb] * gcv; \
                  _Pragma("unroll") for (int ks = 0; ks < 2; ++ks) acc[vb] = mma16(kf[ks], vs[vb][ks], acc[vb]); } } \
        } while (0)
#pragma unroll 1
        for (int ci = 0; ci < nch; ci += 3) {
            GLA_STEP(ci, R1);
            if (ci + 1 < nch) GLA_STEP(ci + 1, R2);
            if (ci + 2 < nch) GLA_STEP(ci + 2, R0);
        }
#undef GLA_STEP
#pragma unroll
        for (int vb = 0; vb < 4; ++vb)
#pragma unroll
            for (int jj = 0; jj < 4; ++jj) op[(size_t)(w * 16 + q * 4 + jj) * 256 + sl * 64 + vb * 16 + r] = acc[vb][jj];
        __syncthreads();
    }
}
__device__ __forceinline__ void ph_gla_fin(const Ctx& c, const bf16_t* __restrict__ U, const float* __restrict__ ng, const float* __restrict__ nb, const bf16_t* __restrict__ RAW, bf16_t* __restrict__ OB) {
    const int lane = c.lane, hs = lane >> 5, l32 = lane & 31;
    for (int i = c.bid * 8 + c.wave; i < MT * 2; i += c.G * 8) {
        const int row = i >> 1, h = (i & 1) * 2 + hs, cc = h * 256 + l32 * 8; bf16_t* p = OB + (size_t)row * BW + cc;
        float x[8], gr[8]; unpack8(*(const u32x4*)(RAW + (size_t)row * BW + cc), x); unpack8(*(const u32x4*)(U + (size_t)row * NINP + U_GR + cc), gr);
        float s = 0.f;
#pragma unroll
        for (int j = 0; j < 8; ++j) s += x[j];
#pragma unroll
        for (int o = 16; o > 0; o >>= 1) s += __shfl_xor(s, o, 64);
        const float mean = s * (1.0f / 256.0f); float qq = 0.f;
#pragma unroll
        for (int j = 0; j < 8; ++j) { const float d = x[j] - mean; qq += d * d; }
#pragma unroll
        for (int o = 16; o > 0; o >>= 1) qq += __shfl_xor(qq, o, 64);
        const float rstd = rsqrtf(qq * (1.0f / 256.0f) + 1e-5f);
        const f32x4 g0 = *(const f32x4*)(ng + cc), g1 = *(const f32x4*)(ng + cc + 4), b0 = *(const f32x4*)(nb + cc), b1 = *(const f32x4*)(nb + cc + 4); float o8[8];
#pragma unroll
        for (int j = 0; j < 8; ++j) o8[j] = ((x[j] - mean) * rstd * (j < 4 ? g0[j] : g1[j - 4]) + (j < 4 ? b0[j] : b1[j - 4])) * gr[j] * sigmoidf_(gr[j]);
        *(u32x4*)p = (u32x4){pk2(o8[0], o8[1]), pk2(o8[2], o8[3]), pk2(o8[4], o8[5]), pk2(o8[6], o8[7])};
    }
}

template <bool ISBF> __device__ __forceinline__ void swa_step(const float (&q)[32], float (&acc)[32], float& m, float& l, const void* kp, const void* vp, float slope, float dist) {
    float s = 0.f;
#pragma unroll
    for (int j = 0; j < 4; ++j) { float x[8];
        if (ISBF) unpack8(*(const u32x4*)((const bf16_t*)kp + j * 8), x);
        else { const f32x4 a = *(const f32x4*)((const float*)kp + j * 8), b = *(const f32x4*)((const float*)kp + j * 8 + 4); x[0] = a[0]; x[1] = a[1]; x[2] = a[2]; x[3] = a[3]; x[4] = b[0]; x[5] = b[1]; x[6] = b[2]; x[7] = b[3]; }
#pragma unroll
        for (int d = 0; d < 8; ++d) s += q[j * 8 + d] * x[d]; }
    s += __shfl_xor(s, 1, 64);
    s = s * 0.125f - slope * dist;
    const float mn = fmaxf(m, s), cc = __expf(m - mn), p = __expf(s - mn);
    l = l * cc + p;
#pragma unroll
    for (int j = 0; j < 4; ++j) { float x[8];
        if (ISBF) unpack8(*(const u32x4*)((const bf16_t*)vp + j * 8), x);
        else { const f32x4 a = *(const f32x4*)((const float*)vp + j * 8), b = *(const f32x4*)((const float*)vp + j * 8 + 4); x[0] = a[0]; x[1] = a[1]; x[2] = a[2]; x[3] = a[3]; x[4] = b[0]; x[5] = b[1]; x[6] = b[2]; x[7] = b[3]; }
#pragma unroll
        for (int d = 0; d < 8; ++d) acc[j * 8 + d] = acc[j * 8 + d] * cc + p * x[d]; }
    m = mn;
}
__device__ __forceinline__ void ph_swa_naive(const Ctx& c, const bf16_t* __restrict__ U, const float* __restrict__ ck, const float* __restrict__ cv, const float* __restrict__ sinks, bf16_t* __restrict__ OB) {
    for (int gid = c.bid * 512 + c.tid; gid < MS * 32; gid += c.G * 512) {
        const int dh = gid & 1, h = (gid >> 1) & 15, row = MP + (gid >> 5), kvh = h >> 3, co = kvh * 64 + dh * 32;
        float q[32], acc[32];
#pragma unroll
        for (int j = 0; j < 4; ++j) { float x[8]; unpack8(*(const u32x4*)(U + (size_t)row * NINP + U_SQ + h * 64 + dh * 32 + j * 8), x);
#pragma unroll
            for (int d = 0; d < 8; ++d) { q[j * 8 + d] = x[d]; acc[j * 8 + d] = 0.f; } }
        const float slope = exp2f(-0.5f * (float)(h + 1)); float m = sinks[h], l = 1.0f;
        if (row < MP) {
            const int t = row % PS, base = row - t, lo = t - 128 < 0 ? 0 : t - 128;
            for (int s = lo; s <= t; ++s) { const bf16_t* ur = U + (size_t)(base + s) * NINP;
                swa_step<true>(q, acc, m, l, ur + U_SK + co, ur + U_SV + co, slope, (float)(t - s)); }
        } else {
            const int sq = (row - MP) / SS, i = (row - MP) % SS;
            for (int idx = i; idx <= 128 + i; ++idx) {
                if (idx < 128) { const size_t o = ((size_t)sq * 128 + idx) * 128 + co; swa_step<false>(q, acc, m, l, ck + o, cv + o, slope, (float)(128 + i - idx)); }
                else { const bf16_t* ur = U + (size_t)(MP + sq * SS + idx - 128) * NINP; swa_step<true>(q, acc, m, l, ur + U_SK + co, ur + U_SV + co, slope, (float)(128 + i - idx)); }
            }
        }
        const float inv = 1.0f / l; bf16_t* op = OB + (size_t)row * BW + h * 64 + dh * 32;
#pragma unroll
        for (int j = 0; j < 4; ++j) { u32x4 w; w.x = pk2(acc[j * 8] * inv, acc[j * 8 + 1] * inv); w.y = pk2(acc[j * 8 + 2] * inv, acc[j * 8 + 3] * inv);
            w.z = pk2(acc[j * 8 + 4] * inv, acc[j * 8 + 5] * inv); w.w = pk2(acc[j * 8 + 6] * inv, acc[j * 8 + 7] * inv); *(u32x4*)(op + j * 8) = w; }
    }
}

__device__ __forceinline__ void ph_rwkv_prep(const Ctx& c, const bf16_t* __restrict__ U, const float* __restrict__ shift, const float* __restrict__ mu, const float* __restrict__ w0, const float* __restrict__ w2,
                                             const float* __restrict__ a0, const float* __restrict__ a2, const float* __restrict__ g2, const float* __restrict__ k_k, const float* __restrict__ k_a,
                                             const float* __restrict__ r_k, float* __restrict__ RW) {
    LAS float* xm = (LAS float*)c.lds; LAS float* tw = xm + RWC; LAS float* ad = tw + 64; LAS float* sg = ad + 64;
    const int tid = c.tid;
    float* R = RW; float* WD = RW + (size_t)MPAD * BW; float* K2 = WD + (size_t)MPAD * BW; float* V = K2 + (size_t)MPAD * BW; float* KK = V + (size_t)MPAD * BW;
    float* BV = KK + (size_t)MPAD * BW; float* G = BV + (size_t)MPAD * BW; float* BON = G + (size_t)MPAD * BW;
    for (int row = c.bid; row < MT; row += c.G) {
        const bf16_t* ur = U + (size_t)row * NINP + U_RU; const bf16_t* pr = ur - NINP; const float* ps = nullptr; bool first;
        if (row < MP) first = (row % PS) == 0; else { first = ((row - MP) % SS) == 0; ps = shift + (size_t)((row - MP) / SS) * RWC; }
        for (int cc = tid; cc < RWC; cc += 512) { const float x = bf2f(ur[cc]); const float s = first ? (ps ? ps[cc] : 0.f) : bf2f(pr[cc]); xm[cc] = x + (s - x) * mu[cc]; }
        __syncthreads();
        if (tid < 64) { tw[tid] = tanhf(xm[3072 + tid]); ad[tid] = xm[3136 + tid]; }
        if (tid >= 128 && tid < 256) sg[tid - 128] = sigmoidf_(xm[3200 + tid - 128]);
        __syncthreads();
        for (int qd = 0; qd < 2; ++qd) {
            const int cc = qd * 512 + tid; float accw = w0[cc], acca = a0[cc], accg = 0.f;
#pragma unroll 4
            for (int j = 0; j < 64; ++j) { accw += tw[j] * w2[j * BW + cc]; acca += ad[j] * a2[j * BW + cc]; }
#pragma unroll 4
            for (int j = 0; j < 128; ++j) accg += sg[j] * g2[j * BW + cc];
            const float lw = -softplusf_(-accw) - 0.5f, decay = __expf(-__expf(lw)), a = sigmoidf_(acca);
            const float r = xm[cc], k = xm[1024 + cc], v = xm[2048 + cc];
            const float kkr = k * k_k[cc]; const float ss = wave_sum(kkr * kkr); const float kk = kkr / fmaxf(sqrtf(ss), 1e-12f);
            const float k2 = k * (1.0f + (a - 1.0f) * k_a[cc]); const float rk = wave_sum(r * k2 * r_k[cc]);
            const size_t o = (size_t)row * BW + cc;
            R[o] = r; WD[o] = decay; K2[o] = k2; V[o] = v; KK[o] = kk; BV[o] = kk * a; G[o] = accg; BON[o] = rk * v;
        }
        __syncthreads();
    }
}
__device__ __forceinline__ int kperm_pos(int k) { return (k & ~31) + 8 * ((k >> 2) & 3) + 4 * ((k >> 4) & 1) + (k & 3); }
__device__ __forceinline__ void ph_swa_prompt(const Ctx& c, const bf16_t* __restrict__ U, const float* __restrict__ sinks, bf16_t* __restrict__ OB) {
    LAS bf16_t* K_l = (LAS bf16_t*)c.lds;
    LAS bf16_t* VT_l = K_l + 192 * 72;
    const int tid = c.tid, lane = c.lane, r = lane & 15, q = lane >> 4, w = c.wave;
    for (int u = c.bid; u < PB * 64 * 2; u += c.G) {
        const int b = u >> 7, qb = (u >> 1) & 63, kvh = u & 1, h = kvh * 8 + w;
        const int tok0 = qb * 64 - 128;
        const size_t seq0 = (size_t)b * PS;
        const bf16_t* qbase = U + (seq0 + qb * 64 + r) * NINP + U_SQ + h * 64 + q * 8;
        bf16x8 qn0 = *(const bf16x8*)qbase, qn1 = *(const bf16x8*)(qbase + 32);
        { u32x4 kv3[3], vv3[3];
#pragma unroll
          for (int k3 = 0; k3 < 3; ++k3) { const int idx = tid + 512 * k3, kl = idx >> 3, c8 = idx & 7, tk = tok0 + kl; kv3[k3] = (u32x4){0u, 0u, 0u, 0u}; vv3[k3] = kv3[k3];
            if (tk >= 0) { const bf16_t* ur = U + (seq0 + tk) * NINP; kv3[k3] = *(const u32x4*)(ur + U_SK + kvh * 64 + c8 * 8); vv3[k3] = *(const u32x4*)(ur + U_SV + kvh * 64 + c8 * 8); } }
#pragma unroll
          for (int k3 = 0; k3 < 3; ++k3) { const int idx = tid + 512 * k3, kl = idx >> 3, c8 = idx & 7; const u32x4 vv = vv3[k3];
            *(LAS u32x4*)(K_l + kl * 72 + c8 * 8) = kv3[k3];
            const int kp = kperm_pos(kl); LAS bf16_t* vp = VT_l + (c8 * 8) * 200 + kp;
            vp[0] = (bf16_t)(vv.x & 0xffffu); vp[200] = (bf16_t)(vv.x >> 16); vp[400] = (bf16_t)(vv.y & 0xffffu); vp[600] = (bf16_t)(vv.y >> 16);
            vp[800] = (bf16_t)(vv.z & 0xffffu); vp[1000] = (bf16_t)(vv.z >> 16); vp[1200] = (bf16_t)(vv.w & 0xffffu); vp[1400] = (bf16_t)(vv.w >> 16); } }
        __syncthreads();
        const float slope = exp2f(-0.5f * (float)(h + 1)), sink = sinks[h];
#pragma unroll 1
        for (int i = 0; i < 4; ++i) {
            const size_t qrow = seq0 + qb * 64 + i * 16 + r;
            const bf16x8 qf0 = qn0, qf1 = qn1;
            { const bf16_t* qp = qbase + (size_t)((i < 3 ? i + 1 : 3) * 16) * NINP; qn0 = *(const bf16x8*)qp; qn1 = *(const bf16x8*)(qp + 32); }
            const int kt0 = i & ~1;
            f32x4 s[10]; float mx = sink; bf16x8 kfr[5][2];
#pragma unroll
            for (int kt = 0; kt < 10; ++kt) { f32x4 d;
                if (kt % 5 == 0) {
#pragma unroll
                    for (int k5 = 0; k5 < 5; ++k5) { const LAS bf16_t* kp = K_l + ((kt0 + kt + k5) * 16 + r) * 72 + q * 8; kfr[k5][0] = *(const LAS bf16x8*)kp; kfr[k5][1] = *(const LAS bf16x8*)(kp + 32); }
                    __builtin_amdgcn_sched_barrier(0); }
                d = mma16(kfr[kt % 5][0], qf0, (f32x4){0.f, 0.f, 0.f, 0.f}); d = mma16(kfr[kt % 5][1], qf1, d);
#pragma unroll
                for (int jj = 0; jj < 4; ++jj) { const int kl = (kt0 + kt) * 16 + q * 4 + jj, dist = i * 16 + r + 128 - kl;
                    const float v = (dist >= 0 && dist <= 128 && tok0 + kl >= 0) ? d[jj] * 0.125f - slope * (float)dist : -1e30f; d[jj] = v; mx = fmaxf(mx, v); }
                s[kt] = d; }
            mx = fmaxf(mx, __shfl_xor(mx, 16, 64)); mx = fmaxf(mx, __shfl_xor(mx, 32, 64));
            float sum = 0.f; bf16x8 pf[5];
#pragma unroll
            for (int kp = 0; kp < 5; ++kp) { f32x4 a = s[2 * kp], bq = s[2 * kp + 1];
#pragma unroll
                for (int jj = 0; jj < 4; ++jj) { a[jj] = __expf(a[jj] - mx); bq[jj] = __expf(bq[jj] - mx); sum += a[jj] + bq[jj]; }
                pf[kp] = pack_acc(a, bq); }
            sum += __shfl_xor(sum, 16, 64); sum += __shfl_xor(sum, 32, 64);
            const float inv = 1.0f / (sum + __expf(sink - mx));
            bf16_t* op = OB + qrow * BW + h * 64 + q * 4;
#pragma unroll
            for (int dt = 0; dt < 4; ++dt) { f32x4 o = (f32x4){0.f, 0.f, 0.f, 0.f}; bf16x8 vfr[5];
#pragma unroll
                for (int kp = 0; kp < 5; ++kp) vfr[kp] = *(const LAS bf16x8*)(VT_l + (dt * 16 + r) * 200 + (kt0 + 2 * kp) * 16 + q * 8);
                __builtin_amdgcn_sched_barrier(0);
#pragma unroll
                for (int kp = 0; kp < 5; ++kp) o = mma16(vfr[kp], pf[kp], o);
                u32x2 ov; ov.x = pk2(o[0] * inv, o[1] * inv); ov.y = pk2(o[2] * inv, o[3] * inv); *(u32x2*)(op + dt * 16) = ov; }
        }
        __syncthreads();
    }
}

__device__ __forceinline__ void ph_swa_sample(const Ctx& c, const bf16_t* __restrict__ U, const float* __restrict__ ck, const float* __restrict__ cv, const float* __restrict__ sinks, bf16_t* __restrict__ OB) {
    LAS bf16_t* K_l = (LAS bf16_t*)c.lds;
    LAS bf16_t* VT_l = K_l + 160 * 72;
    const int tid = c.tid, lane = c.lane, r = lane & 15, q = lane >> 4, w = c.wave;
    for (int u = c.bid; u < SB * 2; u += c.G) {
        const int sq = u >> 1, kvh = u & 1;
        for (int idx = tid; idx < 160 * 8; idx += 512) { const int kl = idx >> 3, c8 = idx & 7; float kx[8], vx[8];
#pragma unroll
            for (int e = 0; e < 8; ++e) { kx[e] = 0.f; vx[e] = 0.f; }
            if (kl < 128) { const size_t o = ((size_t)sq * 128 + kl) * 128 + kvh * 64 + c8 * 8; const f32x4 a = *(const f32x4*)(ck + o), b2 = *(const f32x4*)(ck + o + 4), c2 = *(const f32x4*)(cv + o), d2 = *(const f32x4*)(cv + o + 4);
                kx[0] = a[0]; kx[1] = a[1]; kx[2] = a[2]; kx[3] = a[3]; kx[4] = b2[0]; kx[5] = b2[1]; kx[6] = b2[2]; kx[7] = b2[3];
                vx[0] = c2[0]; vx[1] = c2[1]; vx[2] = c2[2]; vx[3] = c2[3]; vx[4] = d2[0]; vx[5] = d2[1]; vx[6] = d2[2]; vx[7] = d2[3]; }
            else if (kl < 132) { const bf16_t* ur = U + (size_t)(MP + sq * SS + kl - 128) * NINP; unpack8(*(const u32x4*)(ur + U_SK + kvh * 64 + c8 * 8), kx); unpack8(*(const u32x4*)(ur + U_SV + kvh * 64 + c8 * 8), vx); }
            *(LAS u32x4*)(K_l + kl * 72 + c8 * 8) = (u32x4){pk2(kx[0], kx[1]), pk2(kx[2], kx[3]), pk2(kx[4], kx[5]), pk2(kx[6], kx[7])};
            LAS bf16_t* vp = VT_l + (c8 * 8) * 168 + kperm_pos(kl);
#pragma unroll
            for (int e = 0; e < 8; ++e) vp[e * 168] = f2bf(vx[e]); }
        __syncthreads();
        if (w < 2) {
            const int h = kvh * 8 + w * 4 + (r >> 2), tk = r & 3; const size_t qrow = (size_t)(MP + sq * SS + tk);
            const float slope = exp2f(-0.5f * (float)(h + 1)), sink = sinks[h];
            const bf16x8 qf0 = *(const bf16x8*)(U + qrow * NINP + U_SQ + h * 64 + q * 8), qf1 = *(const bf16x8*)(U + qrow * NINP + U_SQ + h * 64 + 32 + q * 8);
            f32x4 s[10]; float mx = sink;
#pragma unroll
            for (int kt = 0; kt < 10; ++kt) { const LAS bf16_t* kp = K_l + (kt * 16 + r) * 72 + q * 8;
                f32x4 d = mma16(*(const LAS bf16x8*)kp, qf0, (f32x4){0.f, 0.f, 0.f, 0.f}); d = mma16(*(const LAS bf16x8*)(kp + 32), qf1, d);
#pragma unroll
                for (int jj = 0; jj < 4; ++jj) { const int kl = kt * 16 + q * 4 + jj, dist = 128 + tk - kl;
                    const float v = (dist >= 0 && dist <= 128) ? d[jj] * 0.125f - slope * (float)dist : -1e30f; d[jj] = v; mx = fmaxf(mx, v); }
                s[kt] = d; }
            mx = fmaxf(mx, __shfl_xor(mx, 16, 64)); mx = fmaxf(mx, __shfl_xor(mx, 32, 64));
            float sum = 0.f; bf16x8 pf[5];
#pragma unroll
            for (int kp = 0; kp < 5; ++kp) { f32x4 a = s[2 * kp], bq = s[2 * kp + 1];
#pragma unroll
                for (int jj = 0; jj < 4; ++jj) { a[jj] = __expf(a[jj] - mx); bq[jj] = __expf(bq[jj] - mx); sum += a[jj] + bq[jj]; }
                pf[kp] = pack_acc(a, bq); }
            sum += __shfl_xor(sum, 16, 64); sum += __shfl_xor(sum, 32, 64);
            const float inv = 1.0f / (sum + __expf(sink - mx));
            bf16_t* op = OB + qrow * BW + h * 64 + q * 4;
#pragma unroll
            for (int dt = 0; dt < 4; ++dt) { f32x4 o = (f32x4){0.f, 0.f, 0.f, 0.f};
#pragma unroll
                for (int kp = 0; kp < 5; ++kp) o = mma16(*(const LAS bf16x8*)(VT_l + (dt * 16 + r) * 168 + kp * 32 + q * 8), pf[kp], o);
                u32x2 ov; ov.x = pk2(o[0] * inv, o[1] * inv); ov.y = pk2(o[2] * inv, o[3] * inv); *(u32x2*)(op + dt * 16) = ov; }
        }
        __syncthreads();
    }
}

__device__ __forceinline__ void ph_memattn_prompt(const Ctx& c, const bf16_t* __restrict__ U, const bf16_t* __restrict__ MKB, const bf16_t* __restrict__ MVT, bf16_t* __restrict__ OB) {
    LAS bf16_t* buf = (LAS bf16_t*)c.lds;
    const int tid = c.tid, lane = c.lane, r = lane & 15, q = lane >> 4, w = c.wave;
    for (int u = c.bid; u < PB * 4 * 32; u += c.G) {
        const int b = u >> 7, h = (u >> 5) & 3, qb = u & 31;
        const size_t qrow = (size_t)b * PS + qb * 128 + w * 16 + r;
        const bf16_t* kg = MKB + (size_t)(b * 256) * 1024 + h * 256;
        const bf16_t* vg = MVT + (size_t)(b * 4 + h) * 65536;
        const bf16_t* qg = U + qrow * NINP + U_MQ + h * 256 + q * 8;
        bf16x8 qn0 = *(const bf16x8*)qg, qn1 = *(const bf16x8*)(qg + 32);
        u32x4 st[4];
#pragma unroll
        for (int i = 0; i < 4; ++i) { const int p = tid + 512 * i; st[i] = *(const u32x4*)(kg + (size_t)(p >> 3) * 1024 + (p & 7) * 8); }
        f32x4 s[16];
#pragma unroll
        for (int mt = 0; mt < 16; ++mt) s[mt] = (f32x4){0.f, 0.f, 0.f, 0.f};
        __syncthreads();
#pragma unroll 1
        for (int ck = 0; ck < 4; ++ck) {
            LAS bf16_t* kb = buf + (ck & 1) * 18432;
#pragma unroll
            for (int i = 0; i < 4; ++i) { const int p = tid + 512 * i; *(LAS u32x4*)(kb + (p >> 3) * 72 + (p & 7) * 8) = st[i]; }
            __syncthreads();
            const bf16x8 qc0 = qn0, qc1 = qn1;
            if (ck < 3) { qn0 = *(const bf16x8*)(qg + (ck + 1) * 64); qn1 = *(const bf16x8*)(qg + (ck + 1) * 64 + 32);
#pragma unroll
                for (int i = 0; i < 4; ++i) { const int p = tid + 512 * i; st[i] = *(const u32x4*)(kg + (size_t)(p >> 3) * 1024 + (ck + 1) * 64 + (p & 7) * 8); } }
#pragma unroll
            for (int m2 = 0; m2 < 16; m2 += 2) { bf16x8 kf[2][2];
#pragma unroll
                for (int j = 0; j < 2; ++j) { kf[j][0] = *(const LAS bf16x8*)(kb + ((m2 + j) * 16 + r) * 72 + q * 8); kf[j][1] = *(const LAS bf16x8*)(kb + ((m2 + j) * 16 + r) * 72 + 32 + q * 8); }
                __builtin_amdgcn_sched_barrier(0);
#pragma unroll
                for (int j = 0; j < 2; ++j) { s[m2 + j] = mma16(kf[j][0], qc0, s[m2 + j]); s[m2 + j] = mma16(kf[j][1], qc1, s[m2 + j]); } }
        }
#pragma unroll
        for (int i = 0; i < 4; ++i) { const int p = tid + 512 * i; st[i] = *(const u32x4*)(vg + (size_t)(p >> 5) * 256 + (p & 31) * 8); }
        float mx = -3.0e38f;
#pragma unroll
        for (int mt = 0; mt < 16; ++mt)
#pragma unroll
            for (int jj = 0; jj < 4; ++jj) { s[mt][jj] *= 0.0625f; mx = fmaxf(mx, s[mt][jj]); }
        mx = fmaxf(mx, __shfl_xor(mx, 16, 64)); mx = fmaxf(mx, __shfl_xor(mx, 32, 64));
        float sum = 0.f; bf16x8 pf[8];
#pragma unroll
        for (int kp = 0; kp < 8; ++kp) { f32x4 a = s[2 * kp], b2 = s[2 * kp + 1];
#pragma unroll
            for (int jj = 0; jj < 4; ++jj) { a[jj] = __expf(a[jj] - mx); b2[jj] = __expf(b2[jj] - mx); sum += a[jj] + b2[jj]; }
            pf[kp] = pack_acc(a, b2); }
        sum += __shfl_xor(sum, 16, 64); sum += __shfl_xor(sum, 32, 64);
        const float inv = 1.0f / sum;
        bf16_t* op = OB + qrow * BW + h * 256 + q * 4;
#pragma unroll 1
        for (int cv = 0; cv < 4; ++cv) {
            LAS bf16_t* vb = buf + (cv & 1) * 18432;
#pragma unroll
            for (int i = 0; i < 4; ++i) { const int p = tid + 512 * i, m0 = (p & 31) * 8; LAS bf16_t* d0 = vb + (p >> 5) * 264;
                *(LAS u32x2*)(d0 + kperm_pos(m0)) = (u32x2){st[i].x, st[i].y}; *(LAS u32x2*)(d0 + kperm_pos(m0 + 4)) = (u32x2){st[i].z, st[i].w}; }
            __syncthreads();
            if (cv < 3) {
#pragma unroll
                for (int i = 0; i < 4; ++i) { const int p = tid + 512 * i; st[i] = *(const u32x4*)(vg + (size_t)((cv + 1) * 64 + (p >> 5)) * 256 + (p & 31) * 8); } }
#pragma unroll
            for (int dt = 0; dt < 4; ++dt) { bf16x8 vf[8];
#pragma unroll
                for (int kp = 0; kp < 8; ++kp) vf[kp] = *(const LAS bf16x8*)(vb + (dt * 16 + r) * 264 + kp * 32 + q * 8);
                __builtin_amdgcn_sched_barrier(0);
                f32x4 o = (f32x4){0.f, 0.f, 0.f, 0.f};
#pragma unroll
                for (int kp = 0; kp < 8; ++kp) o = mma16(vf[kp], pf[kp], o);
                u32x2 ov; ov.x = pk2(o[0] * inv, o[1] * inv); ov.y = pk2(o[2] * inv, o[3] * inv); *(u32x2*)(op + (cv * 4 + dt) * 16) = ov; }
        }
        __syncthreads();
    }
}

__device__ __forceinline__ void ph_lrw(const Ctx& c, const float* __restrict__ w2, const float* __restrict__ a2, const float* __restrict__ g2, bf16_t* __restrict__ LRW) {
    for (int idx = c.bid * 512 + c.tid; idx < NL * 256 * 1024; idx += c.G * 512) {
        const int ch = idx & 1023, j = (idx >> 10) & 255, l = idx >> 18;
        const float v = j < 64 ? w2[((size_t)l * 64 + j) * BW + ch] : (j < 128 ? a2[((size_t)l * 64 + j - 64) * BW + ch] : g2[((size_t)l * 128 + j - 128) * BW + ch]);
        LRW[((size_t)l * 1024 + ch) * 256 + j] = f2bf(v);
    }
}
constexpr int RWP_UNITS = (MP / 64) * 4 + SB * 4;
__device__ __forceinline__ void rwp_unit_info(int u, int& row0, int& ntok, int& hg, int& sq, bool& seq_first) {
    if (u < (MP / 64) * 4) { const int blk = u >> 2; hg = u & 3; row0 = blk * 64; ntok = 64; sq = -1; seq_first = (row0 % PS) == 0; }
    else { const int s = u - (MP / 64) * 4; sq = s >> 2; hg = s & 3; row0 = MP + sq * SS; ntok = SS; seq_first = true; }
}
__device__ __forceinline__ void ph_rwkv_pre(const Ctx& c, const bf16_t* __restrict__ U, const float* __restrict__ shift, const float* __restrict__ mu, const float* __restrict__ w0, const float* __restrict__ w2,
                                            const float* __restrict__ a0, const float* __restrict__ a2, const float* __restrict__ g2, const float* __restrict__ k_k, const float* __restrict__ k_a,
                                            const float* __restrict__ r_k, float* __restrict__ RW, bf16_t* __restrict__ RB, const bf16_t* __restrict__ LRW) {
    LAS bf16_t* P_l = (LAS bf16_t*)c.lds; LAS bf16_t* Kn_l = P_l + 4608; LAS bf16_t* Bn_l = Kn_l + 4608; LAS bf16_t* Q_l = Bn_l + 4608;
    LAS bf16_t* PT_l = Q_l + 4608; LAS bf16_t* BhT_l = PT_l + 4608; LAS bf16_t* KhT_l = BhT_l + 4608; LAS bf16_t* VT_l = KhT_l + 4608;
    LAS float* A_l = (LAS float*)(c.lds + 73728);
    LAS bf16_t* BmT_l = (LAS bf16_t*)(c.lds + 78848); LAS bf16_t* F_l = (LAS bf16_t*)(c.lds + 81920); LAS bf16_t* Tinv_l = (LAS bf16_t*)(c.lds + 84992);
    LAS bf16_t* PpT_l = (LAS bf16_t*)(c.lds + 88064);
    LAS bf16_t* BmpT_l = (LAS bf16_t*)(c.lds + 97280);
    LAS float* GC_l = (LAS float*)(c.lds + 100352);
    LAS float* lg_l = (LAS float*)(c.lds + 125952);
    LAS bf16_t* act_l = (LAS bf16_t*)c.lds;
    LAS bf16_t* wT_l = act_l + 64 * 264;
    LAS bf16_t* aT_l = wT_l + 64 * 72;
    LAS bf16_t* gT_l = aT_l + 64 * 72;
    LAS float* pre_l = (LAS float*)(c.lds + 73728);
    const int tid = c.tid, lane = c.lane, r = lane & 15, q = lane >> 4, w = c.wave;
    bf16_t* Gg = (bf16_t*)(RW + 6 * (size_t)MPAD * BW); bf16_t* BON = (bf16_t*)(RW + 7 * (size_t)MPAD * BW);
    for (int u = c.bid; u < RWP_UNITS; u += c.G) {
        int row0, ntok, hg, sq; bool seq_first; rwp_unit_info(u, row0, ntok, hg, sq, seq_first);
        const float* sh = sq >= 0 ? shift + (size_t)sq * RWC : nullptr;
        const int nstage = ntok == 64 ? 64 : 16;
        for (int idx = tid; idx < nstage * 32; idx += 512) {
            const int t = idx >> 5, c8 = idx & 31, cc = 3072 + c8 * 8; float val[8];
#pragma unroll
            for (int e2 = 0; e2 < 8; ++e2) val[e2] = 0.f;
            if (t < ntok) { const bf16_t* ur = U + (size_t)(row0 + t) * NINP + U_RU; float x[8], p[8];
                unpack8(*(const u32x4*)(ur + cc), x);
                if (!(t == 0 && seq_first)) unpack8(*(const u32x4*)(ur + cc - NINP), p);
                else if (sh) { const f32x4 s0v = *(const f32x4*)(sh + cc), s1v = *(const f32x4*)(sh + cc + 4); p[0] = s0v[0]; p[1] = s0v[1]; p[2] = s0v[2]; p[3] = s0v[3]; p[4] = s1v[0]; p[5] = s1v[1]; p[6] = s1v[2]; p[7] = s1v[3]; }
                else {
#pragma unroll
                    for (int e2 = 0; e2 < 8; ++e2) p[e2] = 0.f; }
                const f32x4 m0 = *(const f32x4*)(mu + cc), m1 = *(const f32x4*)(mu + cc + 4);
#pragma unroll
                for (int e2 = 0; e2 < 8; ++e2) { const float xm = x[e2] + (p[e2] - x[e2]) * (e2 < 4 ? m0[e2] : m1[e2 - 4]); val[e2] = c8 < 8 ? tanh_fast(xm) : (c8 < 16 ? xm : sigmoidf_(xm)); } }
            *(LAS u32x4*)(act_l + t * 264 + c8 * 8) = (u32x4){pk2(val[0], val[1]), pk2(val[2], val[3]), pk2(val[4], val[5]), pk2(val[6], val[7])};
        }
        __syncthreads();
        bf16x8 af[8];
        { const int tb = w & 3;
#pragma unroll
          for (int ks = 0; ks < 8; ++ks) af[ks] = *(const LAS bf16x8*)(act_l + (tb * 16 + r) * 264 + ks * 32 + q * 8); }
        __syncthreads();
#pragma unroll 1
        for (int hh = 0; hh < 4; ++hh) { const int h = hg * 4 + hh;
        const int t = tid >> 3, cg = tid & 7, c0 = h * 64 + cg * 8, sc = t >> 4;
        u32x4 ux[3], upv[3];
        if (t < ntok) { const bf16_t* ur = U + (size_t)(row0 + t) * NINP + U_RU; const bool fst = (t == 0 && seq_first);
#pragma unroll
            for (int part = 0; part < 3; ++part) { ux[part] = *(const u32x4*)(ur + part * 1024 + c0); if (!fst) upv[part] = *(const u32x4*)(ur + part * 1024 + c0 - NINP); } }
        { const int tb = w & 3, chf = w >> 2;
          if (tb * 16 < nstage) {
            bf16x8 wf[2][8];
#pragma unroll
            for (int e2 = 0; e2 < 2; ++e2) { const bf16_t* wr = LRW + ((size_t)h * 64 + (chf * 2 + e2) * 16 + r) * 256 + q * 8;
#pragma unroll
                for (int ks = 0; ks < 8; ++ks) wf[e2][ks] = *(const bf16x8*)(wr + ks * 32); }
            __builtin_amdgcn_sched_barrier(0);
#pragma unroll
            for (int e2 = 0; e2 < 2; ++e2) { const int cb = chf * 2 + e2; f32x4 dw = (f32x4){0.f, 0.f, 0.f, 0.f}, da = dw, dg = dw;
#pragma unroll
                for (int ks = 0; ks < 2; ++ks) { dw = mma16(wf[e2][ks], af[ks], dw); da = mma16(wf[e2][2 + ks], af[2 + ks], da); }
#pragma unroll
                for (int ks = 0; ks < 4; ++ks) dg = mma16(wf[e2][4 + ks], af[4 + ks], dg);
                const int o = (tb * 16 + r) * 68 + cb * 16 + q * 4;
                *(LAS f32x4*)(pre_l + o) = dw; *(LAS f32x4*)(pre_l + 64 * 68 + o) = da; *(LAS f32x4*)(pre_l + 2 * 64 * 68 + o) = dg; } } }
        __syncthreads();
        float rr[8], k2[8], kap[8], bet[8], nlw[8];
        { float vx[8], gg[8], kkr[8]; float ss = 0.f, rk = 0.f;
          if (t < ntok) {
            const size_t row = (size_t)(row0 + t); const bf16_t* ur = U + row * NINP + U_RU; const bool fst = (t == 0 && seq_first);
            float kx[8];
#pragma unroll
            for (int part = 0; part < 3; ++part) { const int cc = part * 1024 + c0; float x[8], p[8];
                unpack8(ux[part], x);
                if (!fst) unpack8(upv[part], p);
                else {
#pragma unroll
                    for (int j = 0; j < 8; ++j) p[j] = sh ? sh[cc + j] : 0.f; }
                const f32x4 mA = *(const f32x4*)(mu + cc), mB = *(const f32x4*)(mu + cc + 4);
#pragma unroll
                for (int j = 0; j < 8; ++j) { const float xm = x[j] + (p[j] - x[j]) * (j < 4 ? mA[j] : mB[j - 4]); if (part == 0) rr[j] = xm; else if (part == 1) kx[j] = xm; else vx[j] = xm; } }
            float pw[8], pa[8], pkk[8], pka[8], prk[8];
#pragma unroll
            for (int hf = 0; hf < 2; ++hf) { const f32x4 v0 = *(const f32x4*)(w0 + c0 + hf * 4), v1 = *(const f32x4*)(a0 + c0 + hf * 4), v2 = *(const f32x4*)(k_k + c0 + hf * 4), v3 = *(const f32x4*)(k_a + c0 + hf * 4), v4 = *(const f32x4*)(r_k + c0 + hf * 4);
#pragma unroll
                for (int j = 0; j < 4; ++j) { pw[hf * 4 + j] = v0[j]; pa[hf * 4 + j] = v1[j]; pkk[hf * 4 + j] = v2[j]; pka[hf * 4 + j] = v3[j]; prk[hf * 4 + j] = v4[j]; } }
            float lwp[8], app[8];
#pragma unroll
            for (int hf = 0; hf < 2; ++hf) { const f32x4 v0 = *(const LAS f32x4*)(pre_l + t * 68 + cg * 8 + hf * 4), v1 = *(const LAS f32x4*)(pre_l + 64 * 68 + t * 68 + cg * 8 + hf * 4), v2 = *(const LAS f32x4*)(pre_l + 2 * 64 * 68 + t * 68 + cg * 8 + hf * 4);
#pragma unroll
                for (int j = 0; j < 4; ++j) { lwp[hf * 4 + j] = v0[j]; app[hf * 4 + j] = v1[j]; gg[hf * 4 + j] = v2[j]; } }
#pragma unroll
            for (int j = 0; j < 8; ++j) {
                const float lw = -softplus_fast(-(pw[j] + lwp[j])) - 0.5f; nlw[j] = -__expf(lw); const float av = sigmoidf_(pa[j] + app[j]);
                kkr[j] = kx[j] * pkk[j]; ss += kkr[j] * kkr[j]; k2[j] = kx[j] * (1.0f + (av - 1.0f) * pka[j]); rk += rr[j] * k2[j] * prk[j]; bet[j] = av; }
          } else {
#pragma unroll
            for (int j = 0; j < 8; ++j) { rr[j] = 0.f; k2[j] = 0.f; kkr[j] = 0.f; bet[j] = 0.f; nlw[j] = 0.f; vx[j] = 0.f; gg[j] = 0.f; }
          }
          ss += __shfl_xor(ss, 1, 64); ss += __shfl_xor(ss, 2, 64); ss += __shfl_xor(ss, 4, 64);
          rk += __shfl_xor(rk, 1, 64); rk += __shfl_xor(rk, 2, 64); rk += __shfl_xor(rk, 4, 64);
          const float inv = 1.0f / fmaxf(sqrtf(ss), 1e-12f);
#pragma unroll
          for (int j = 0; j < 8; ++j) { kap[j] = kkr[j] * inv; bet[j] = kap[j] * bet[j]; }
          if (t < ntok) { const size_t o = (size_t)(row0 + t) * BW + c0;
              *(u32x4*)(Gg + o) = (u32x4){pk2(gg[0], gg[1]), pk2(gg[2], gg[3]), pk2(gg[4], gg[5]), pk2(gg[6], gg[7])};
              *(u32x4*)(BON + o) = (u32x4){pk2(rk * vx[0], rk * vx[1]), pk2(rk * vx[2], rk * vx[3]), pk2(rk * vx[4], rk * vx[5]), pk2(rk * vx[6], rk * vx[7])}; }
          *(LAS f32x4*)(lg_l + t * 68 + cg * 8) = (f32x4){nlw[0], nlw[1], nlw[2], nlw[3]}; *(LAS f32x4*)(lg_l + t * 68 + cg * 8 + 4) = (f32x4){nlw[4], nlw[5], nlw[6], nlw[7]};
#pragma unroll
          for (int j = 0; j < 8; ++j) VT_l[(cg * 8 + j) * 72 + t] = f2bf(vx[j]);
        }
        __syncthreads();
        if (tid < 256) { const int cc = tid & 63, s4 = tid >> 6; float vv[16];
#pragma unroll
            for (int i = 0; i < 16; ++i) vv[i] = lg_l[(s4 * 16 + i) * 68 + cc];
            float run = 0.f;
#pragma unroll
            for (int i = 0; i < 16; ++i) { run += vv[i]; lg_l[(s4 * 16 + i) * 68 + cc] = run; } }
        __syncthreads();
        { unsigned pp[4], pq[4], pk[4], pb[4];
#pragma unroll
          for (int j = 0; j < 8; j += 2) { float vP[2], vQ[2], vK[2], vB[2];
#pragma unroll
              for (int e = 0; e < 2; ++e) { const int jj = j + e, cc = cg * 8 + jj; const float ci = lg_l[t * 68 + cc], cC = lg_l[(sc * 16 + 15) * 68 + cc];
                  const float ei = __expf(-ci), eh = __expf(cC - ci);
                  vP[e] = kap[jj] * __expf(ci - nlw[jj]); vQ[e] = rr[jj] * __expf(ci); vK[e] = k2[jj] * ei; vB[e] = bet[jj] * ei;
                  PT_l[cc * 72 + t] = f2bf(vP[e]); BhT_l[cc * 72 + t] = f2bf(bet[jj] * eh); KhT_l[cc * 72 + t] = f2bf(k2[jj] * eh); }
              pp[j >> 1] = pk2(vP[0], vP[1]); pq[j >> 1] = pk2(vQ[0], vQ[1]); pk[j >> 1] = pk2(vK[0], vK[1]); pb[j >> 1] = pk2(vB[0], vB[1]); }
          const int o = t * 72 + cg * 8;
          *(LAS u32x4*)(P_l + o) = (u32x4){pp[0], pp[1], pp[2], pp[3]}; *(LAS u32x4*)(Q_l + o) = (u32x4){pq[0], pq[1], pq[2], pq[3]};
          *(LAS u32x4*)(Kn_l + o) = (u32x4){pk[0], pk[1], pk[2], pk[3]}; *(LAS u32x4*)(Bn_l + o) = (u32x4){pb[0], pb[1], pb[2], pb[3]};
          if ((t & 15) == 15) {
#pragma unroll
              for (int j = 0; j < 8; ++j) GC_l[sc * 64 + cg * 8 + j] = __expf(lg_l[t * 68 + cg * 8 + j]); } }
        __syncthreads();
        const int nsub = ntok == 64 ? 4 : 1;
        const bf16x8 zfrag = (bf16x8){0, 0, 0, 0, 0, 0, 0, 0};
        { const int s4 = w & 3, hf = w >> 2;
          if (s4 < nsub) { const int ro = (s4 * 16 + r) * 72 + q * 8;
            if (hf == 0) {
                const bf16x8 b0 = *(const LAS bf16x8*)(Bn_l + ro), b1 = *(const LAS bf16x8*)(Bn_l + ro + 32), p0 = *(const LAS bf16x8*)(P_l + ro), p1 = *(const LAS bf16x8*)(P_l + ro + 32),
                             q0 = *(const LAS bf16x8*)(Q_l + ro), q1 = *(const LAS bf16x8*)(Q_l + ro + 32);
                __builtin_amdgcn_sched_barrier(0);
                f32x4 da = (f32x4){0.f, 0.f, 0.f, 0.f}, df = da; da = mma16(b0, p0, da); df = mma16(b0, q0, df); da = mma16(b1, p1, da); df = mma16(b1, q1, df);
                f32x4 o4; float f4[4];
#pragma unroll
                for (int jj = 0; jj < 4; ++jj) { o4[jj] = (q * 4 + jj < r) ? da[jj] : 0.f; f4[jj] = (q * 4 + jj <= r) ? df[jj] : 0.f; }
                *(LAS f32x4*)(A_l + s4 * 320 + r * 20 + q * 4) = o4;
                u32x2 o; o.x = pk2(f4[0], f4[1]); o.y = pk2(f4[2], f4[3]); *(LAS u32x2*)(F_l + s4 * 384 + r * 24 + q * 4) = o;
            } else {
                const bf16x8 p0 = *(const LAS bf16x8*)(P_l + ro), p1 = *(const LAS bf16x8*)(P_l + ro + 32), k0 = *(const LAS bf16x8*)(Kn_l + ro), k1 = *(const LAS bf16x8*)(Kn_l + ro + 32);
                __builtin_amdgcn_sched_barrier(0);
                f32x4 d = (f32x4){0.f, 0.f, 0.f, 0.f}; d = mma16(p0, k0, d); d = mma16(p1, k1, d);
                float o4[4];
#pragma unroll
                for (int jj = 0; jj < 4; ++jj) o4[jj] = (r < q * 4 + jj) ? d[jj] : 0.f;
                u32x2 o; o.x = pk2(o4[0], o4[1]); o.y = pk2(o4[2], o4[3]); *(LAS u32x2*)(BmT_l + s4 * 384 + r * 24 + q * 4) = o;
            } } }
        __syncthreads();
        if (w == 0 && (lane >> 4) < nsub) { const int s4 = lane >> 4, jc = lane & 15; float x[16];
#pragma unroll
            for (int tt = 0; tt < 16; ++tt) { float s = (tt == jc) ? 1.f : 0.f;
#pragma unroll
                for (int i = 0; i < tt; ++i) s -= A_l[s4 * 320 + tt * 20 + i] * x[i];
                x[tt] = s; }
#pragma unroll
            for (int tt = 0; tt < 16; ++tt) Tinv_l[s4 * 384 + tt * 24 + jc] = f2bf(x[tt]); }
        __syncthreads();
        { const int s4 = w & 3, hf = w >> 2;
          if (s4 < nsub) {
            const bf16x8 xf = q < 2 ? *(const LAS bf16x8*)(Tinv_l + s4 * 384 + r * 24 + q * 8) : zfrag;
            const bf16x8 y0 = q < 2 ? *(const LAS bf16x8*)(PT_l + ((hf * 2) * 16 + r) * 72 + s4 * 16 + q * 8) : zfrag, y1 = q < 2 ? *(const LAS bf16x8*)(PT_l + ((hf * 2 + 1) * 16 + r) * 72 + s4 * 16 + q * 8) : zfrag;
            const bf16x8 y2 = (q < 2 && hf == 0) ? *(const LAS bf16x8*)(BmT_l + s4 * 384 + r * 24 + q * 8) : zfrag;
            __builtin_amdgcn_sched_barrier(0);
            const f32x4 z4 = (f32x4){0.f, 0.f, 0.f, 0.f};
            const f32x4 d0 = mma16(xf, y0, z4), d1 = mma16(xf, y1, z4);
            u32x2 o; o.x = pk2(d0[0], d0[1]); o.y = pk2(d0[2], d0[3]); *(LAS u32x2*)(PpT_l + ((hf * 2) * 16 + r) * 72 + s4 * 16 + q * 4) = o;
            o.x = pk2(d1[0], d1[1]); o.y = pk2(d1[2], d1[3]); *(LAS u32x2*)(PpT_l + ((hf * 2 + 1) * 16 + r) * 72 + s4 * 16 + q * 4) = o;
            if (hf == 0) { const f32x4 d2 = mma16(xf, y2, z4); o.x = pk2(d2[0], d2[1]); o.y = pk2(d2[2], d2[3]); *(LAS u32x2*)(BmpT_l + s4 * 384 + r * 24 + q * 4) = o; } } }
        __syncthreads();
        { const int chunk0 = sq >= 0 ? PB * 16 * 256 + sq * 16 + h : ((row0 / PS) * 16 + h) * 256 + ((row0 % PS) >> 4);
          { const int s4 = w & 3, hf = w >> 2;
            if (s4 < nsub) { bf16_t* blob = RB + (size_t)(chunk0 + s4) * RB_EL;
              bf16x8 pp[4], bhm[2], fF = zfrag, bmp = zfrag, x4[4];
#pragma unroll
              for (int i = 0; i < 4; ++i) pp[i] = zfrag;
              bhm[0] = zfrag; bhm[1] = zfrag;
              if (q < 2) {
#pragma unroll
                  for (int i = 0; i < 4; ++i) pp[i] = *(const LAS bf16x8*)(PpT_l + (i * 16 + r) * 72 + s4 * 16 + q * 8);
#pragma unroll
                  for (int i = 0; i < 2; ++i) bhm[i] = *(const LAS bf16x8*)(BhT_l + ((hf * 2 + i) * 16 + r) * 72 + s4 * 16 + q * 8);
                  fF = *(const LAS bf16x8*)(F_l + s4 * 384 + r * 24 + q * 8); bmp = *(const LAS bf16x8*)(BmpT_l + s4 * 384 + r * 24 + q * 8); }
              if (hf == 0) {
#pragma unroll
                  for (int ks = 0; ks < 2; ++ks) { x4[ks] = *(const LAS bf16x8*)(Kn_l + (s4 * 16 + r) * 72 + ks * 32 + q * 8); x4[2 + ks] = *(const LAS bf16x8*)(Q_l + (s4 * 16 + r) * 72 + ks * 32 + q * 8); }
              } else {
#pragma unroll
                  for (int i = 0; i < 4; ++i) x4[i] = q < 2 ? *(const LAS bf16x8*)(BhT_l + (i * 16 + r) * 72 + s4 * 16 + q * 8) : zfrag;
              }
              __builtin_amdgcn_sched_barrier(0);
              const f32x4 z4 = (f32x4){0.f, 0.f, 0.f, 0.f};
              f32x4 dx[4];
              f32x4 d2 = z4, d1 = z4;
              if (hf == 0) {
#pragma unroll
                  for (int j = 0; j < 4; ++j) dx[j] = mma16(pp[j], fF, z4);
                  d2 = mma16(x4[0], x4[2], d2); d2 = mma16(x4[1], x4[3], d2);
                  d1 = mma16(bmp, fF, z4);
              } else {
#pragma unroll
                  for (int j = 0; j < 4; ++j) dx[j] = mma16(bmp, x4[j], z4);
              }
#pragma unroll
              for (int i = 0; i < 2; ++i) { const int cob = hf * 2 + i; const float gc = GC_l[s4 * 64 + cob * 16 + r]; f32x4 dm[4];
#pragma unroll
                  for (int j = 0; j < 4; ++j) dm[j] = mma16(pp[j], bhm[i], z4);
#pragma unroll
                  for (int cp = 0; cp < 2; ++cp) { float o8[8];
#pragma unroll
                      for (int e2 = 0; e2 < 2; ++e2) { const int cib = cp * 2 + e2;
#pragma unroll
                          for (int jj = 0; jj < 4; ++jj) o8[e2 * 4 + jj] = ((cib == cob && q * 4 + jj == r) ? gc : 0.f) - dm[cib][jj]; }
                      *(u32x4*)(blob + (cob * 16 + r) * 64 + (((4 * cp + q) ^ ((r >> 1) & 7)) * 8)) = (u32x4){pk2(o8[0], o8[1]), pk2(o8[2], o8[3]), pk2(o8[4], o8[5]), pk2(o8[6], o8[7])}; } }
              if (hf == 0) {
#pragma unroll
                  for (int cp = 0; cp < 2; ++cp) {
                      const u32x2 qa = *(const LAS u32x2*)(Q_l + (s4 * 16 + r) * 72 + (cp * 2) * 16 + q * 4), qb = *(const LAS u32x2*)(Q_l + (s4 * 16 + r) * 72 + (cp * 2 + 1) * 16 + q * 4);
                      const f32x4 da = dx[cp * 2], db = dx[cp * 2 + 1];
                      *(u32x4*)(blob + RB_QP + r * 64 + (((4 * cp + q) ^ ((r >> 1) & 7)) * 8)) = (u32x4){
                          pk2(__uint_as_float(qa.x << 16) - da[0], __uint_as_float(qa.x & 0xffff0000u) - da[1]), pk2(__uint_as_float(qa.y << 16) - da[2], __uint_as_float(qa.y & 0xffff0000u) - da[3]),
                          pk2(__uint_as_float(qb.x << 16) - db[0], __uint_as_float(qb.x & 0xffff0000u) - db[1]), pk2(__uint_as_float(qb.y << 16) - db[2], __uint_as_float(qb.y & 0xffff0000u) - db[3])}; }
                  float o4[4];
#pragma unroll
                  for (int jj = 0; jj < 4; ++jj) o4[jj] = ((q * 4 + jj <= r) ? d2[jj] : 0.f) - d1[jj];
                  u32x2 o; o.x = pk2(o4[0], o4[1]); o.y = pk2(o4[2], o4[3]); *(u32x2*)(blob + RB_EP + r * 16 + q * 4) = o;
              } else {
#pragma unroll
                  for (int cb = 0; cb < 4; ++cb) { const u32x2 kv = *(const LAS u32x2*)(KhT_l + (cb * 16 + r) * 72 + s4 * 16 + q * 4); const f32x4 d = dx[cb];
                      u32x2 o; o.x = pk2(__uint_as_float(kv.x << 16) - d[0], __uint_as_float(kv.x & 0xffff0000u) - d[1]); o.y = pk2(__uint_as_float(kv.y << 16) - d[2], __uint_as_float(kv.y & 0xffff0000u) - d[3]);
                      *(u32x2*)(blob + RB_KHP + (cb * 16 + r) * 16 + q * 4) = o; }
              } } }
          for (int idx = tid; idx < nsub * 128; idx += 512) { const int s4 = idx >> 7, cc = (idx >> 1) & 63, hf = idx & 1;
              *(u32x4*)(RB + (size_t)(chunk0 + s4) * RB_EL + RB_VT + cc * 16 + hf * 8) = *(const LAS u32x4*)(VT_l + cc * 72 + s4 * 16 + hf * 8); } }
        __syncthreads();
        }
    }
}

__device__ __forceinline__ void ph_rwkv_scan_naive(const Ctx& c, const float* __restrict__ RW, const float* __restrict__ s0, const float* __restrict__ lng, const float* __restrict__ lnb, bf16_t* __restrict__ OB,
                                                   float* __restrict__ outP, float* __restrict__ outS) {
    const float* R = RW; const float* WD = RW + (size_t)MPAD * BW; const float* K2 = WD + (size_t)MPAD * BW; const float* V = K2 + (size_t)MPAD * BW; const float* KK = V + (size_t)MPAD * BW;
    const float* BV = KK + (size_t)MPAD * BW; const float* G = BV + (size_t)MPAD * BW; const float* BON = G + (size_t)MPAD * BW;
    const int lane = c.lane;
    for (int it = 0;; ++it) {
        const int u = (it * 8 + c.wave) * c.G + c.bid;
        if (u >= (PB + SB) * 16) break;
        const int sq = u >> 4, h = u & 15;
        int row0, L; seq_info(sq, row0, L);
        float S[64];
        if (sq >= PB) { const float* p = s0 + (((size_t)(sq - PB) * 16 + h) * 64 + lane) * 64;
#pragma unroll
            for (int j = 0; j < 64; ++j) S[j] = p[j]; }
        else {
#pragma unroll
            for (int j = 0; j < 64; ++j) S[j] = 0.f; }
        const float lg = lng[h * 64 + lane], lb = lnb[h * 64 + lane];
        for (int t = 0; t < L; ++t) {
            const size_t base = (size_t)(row0 + t) * BW + h * 64; const float v = V[base + lane];
            float d = 0.f;
#pragma unroll
            for (int j = 0; j < 64; ++j) d += S[j] * KK[base + j];
            float y = 0.f;
#pragma unroll
            for (int j = 0; j < 64; ++j) { S[j] = S[j] * WD[base + j] - d * BV[base + j] + v * K2[base + j]; y += S[j] * R[base + j]; }
            const float mean = wave_sum(y) * (1.0f / 64.0f), dy = y - mean, var = wave_sum(dy * dy) * (1.0f / 64.0f);
            const float yn = dy * rsqrtf(var + 64e-5f) * lg + lb;
            OB[base + lane] = f2bf((yn + BON[base + lane]) * G[base + lane]);
        }
        float* op = (sq < PB ? outP + (((size_t)sq * 16 + h) * 64 + lane) * 64 : outS + (((size_t)(sq - PB) * 16 + h) * 64 + lane) * 64);
#pragma unroll
        for (int j = 0; j < 64; ++j) op[j] = S[j];
    }
}
__device__ __forceinline__ void ph_rwkv_scan2(const Ctx& c, int boff, const float* __restrict__ RW, const float* __restrict__ s0, const float* __restrict__ lng, const float* __restrict__ lnb, bf16_t* __restrict__ OB,
                                              float* __restrict__ outP, float* __restrict__ outS) {
    LAS float* opb = (LAS float*)c.lds;
    LAS float* yb = opb + 2 * 16 * 384;
    const int tid = c.tid, lane = c.lane, w = c.wave, rl = lane >> 3, cg = lane & 7, vrow = w * 8 + rl;
    const float* G = RW + 6 * (size_t)MPAD * BW; const float* BON = RW + 7 * (size_t)MPAD * BW;
    for (int u = (c.bid - boff + c.G) % c.G; u < (PB + SB) * 16; u += c.G) {
        const int sq = u >> 4, h = u & 15;
        int row0, L; seq_info(sq, row0, L);
        float S[8];
        if (sq >= PB) { const float* p = s0 + (((size_t)(sq - PB) * 16 + h) * 64 + vrow) * 64 + cg * 8;
#pragma unroll
            for (int j = 0; j < 8; ++j) S[j] = p[j]; }
        else {
#pragma unroll
            for (int j = 0; j < 8; ++j) S[j] = 0.f; }
        const float lg = lng[h * 64 + lane], lb = lnb[h * 64 + lane];
        const int nb = (L + 15) >> 4;
#define RW_STAGE(bi_) do { const int t0_ = (bi_) * 16, nT_ = (L - t0_) < 16 ? (L - t0_) : 16; LAS float* dst_ = opb + ((bi_) & 1) * 16 * 384; \
        for (int idx = tid; idx < nT_ * 96; idx += 512) { const int t = idx / 96, rem = idx - t * 96, slot = rem >> 4, c4 = rem & 15; \
            const int arr = slot == 0 ? 1 : slot == 1 ? 4 : slot == 2 ? 5 : slot == 3 ? 2 : slot == 4 ? 0 : 3; \
            *(LAS f32x4*)(dst_ + t * 384 + slot * 64 + c4 * 4) = *(const f32x4*)(RW + (size_t)arr * MPAD * BW + (size_t)(row0 + t0_ + t) * BW + h * 64 + c4 * 4); } } while (0)
        RW_STAGE(0);
        for (int bi = 0; bi < nb; ++bi) {
            __syncthreads();
            if (bi + 1 < nb) RW_STAGE(bi + 1);
            const int t0 = bi * 16, nT = (L - t0) < 16 ? (L - t0) : 16; const LAS float* src = opb + (bi & 1) * 16 * 384;
            for (int tt = 0; tt < nT; ++tt) {
                const LAS float* b = src + tt * 384 + cg * 8;
                const f32x4 w0 = *(const LAS f32x4*)(b), w1 = *(const LAS f32x4*)(b + 4), k0 = *(const LAS f32x4*)(b + 64), k1 = *(const LAS f32x4*)(b + 68);
                const f32x4 b0 = *(const LAS f32x4*)(b + 128), b1 = *(const LAS f32x4*)(b + 132), q0 = *(const LAS f32x4*)(b + 192), q1 = *(const LAS f32x4*)(b + 196);
                const f32x4 r0 = *(const LAS f32x4*)(b + 256), r1 = *(const LAS f32x4*)(b + 260); const float v = src[tt * 384 + 320 + vrow];
                float d = (S[0] * k0[0] + S[1] * k0[1]) + (S[2] * k0[2] + S[3] * k0[3]) + (S[4] * k1[0] + S[5] * k1[1]) + (S[6] * k1[2] + S[7] * k1[3]);
                d += __shfl_xor(d, 1, 64); d += __shfl_xor(d, 2, 64); d += __shfl_xor(d, 4, 64);
                float y = 0.f;
#pragma unroll
                for (int j = 0; j < 4; ++j) { S[j] = S[j] * w0[j] - d * b0[j] + v * q0[j]; y += S[j] * r0[j]; S[4 + j] = S[4 + j] * w1[j] - d * b1[j] + v * q1[j]; y += S[4 + j] * r1[j]; }
                y += __shfl_xor(y, 1, 64); y += __shfl_xor(y, 2, 64); y += __shfl_xor(y, 4, 64);
                if (cg == 0) yb[tt * 64 + vrow] = y;
            }
            __syncthreads();
            for (int tt = w; tt < nT; tt += 8) {
                const float y = yb[tt * 64 + lane]; const float mean = wave_sum(y) * (1.0f / 64.0f), dy = y - mean, var = wave_sum(dy * dy) * (1.0f / 64.0f);
                const float yn = dy * rsqrtf(var + 64e-5f) * lg + lb; const size_t o = (size_t)(row0 + t0 + tt) * BW + h * 64 + lane;
                OB[o] = f2bf((yn + BON[o]) * G[o]);
            }
        }
#undef RW_STAGE
        float* op = (sq < PB ? outP + (((size_t)sq * 16 + h) * 64 + vrow) * 64 : outS + (((size_t)(sq - PB) * 16 + h) * 64 + vrow) * 64) + cg * 8;
#pragma unroll
        for (int j = 0; j < 8; ++j) op[j] = S[j];
        __syncthreads();
    }
}
constexpr int RS_SLOTS = 10, RS_SLOT_B = 15360;
__device__ __forceinline__ void ph_rwkv_seq(const Ctx& c, int boff, const bf16_t* __restrict__ RB, const float* __restrict__ s0, float* __restrict__ outP, float* __restrict__ outS, bf16_t* __restrict__ OB) {
    const int lane = c.lane, r = lane & 15, q = lane >> 4, w = c.wave;
    LAS unsigned char* ring = c.lds;
    const int side = c.bid < 32 ? c.bid : c.bid - 64, nside = c.G - 64;
    for (int u = (c.bid >= boff && c.bid < boff + 32) ? c.bid - boff : ((c.bid < 32 || c.bid >= 96) ? 32 + side : (PB + SB) * 16); u < (PB + SB) * 16; u = u < 32 ? (PB + SB) * 16 : u + nside) {
        const int sq = u >> 4, h = u & 15;
        int nch, ch0, row0, ntok; const float* sp = nullptr; float* op;
        if (sq < PB) { nch = 256; ch0 = (sq * 16 + h) * 256; row0 = sq * PS; ntok = 16; op = outP + (size_t)(sq * 16 + h) * 4096; }
        else { nch = 1; ch0 = PB * 16 * 256 + (sq - PB) * 16 + h; row0 = MP + (sq - PB) * SS; ntok = SS; sp = s0 + (size_t)((sq - PB) * 16 + h) * 4096; op = outS + (size_t)((sq - PB) * 16 + h) * 4096; }
        if (w >= 4) {
            const int lw = w - 4, p0 = lw * 4, np = lw < 3 ? 4 : 3;
#define RS_ISSUE(ci_) do { const int cc_ = (ci_) < nch ? (ci_) : nch - 1; const char* g_ = (const char*)(RB + (size_t)(ch0 + cc_) * RB_EL) + p0 * 1024 + lane * 16; \
            LAS unsigned char* d_ = ring + ((ci_) % RS_SLOTS) * RS_SLOT_B + p0 * 1024; \
            _Pragma("unroll") for (int p_ = 0; p_ < 4; ++p_) if (p_ < np) __builtin_amdgcn_global_load_lds((const unsigned*)(g_ + p_ * 1024), (LAS unsigned*)(d_ + p_ * 1024), 16, 0, 0); } while (0)
            for (int ci = 0; ci < RS_SLOTS - 1; ++ci) RS_ISSUE(ci);
            if (lw < 3) asm volatile("s_waitcnt vmcnt(32)" ::: "memory"); else asm volatile("s_waitcnt vmcnt(24)" ::: "memory");
            __builtin_amdgcn_s_barrier();
            for (int ci = 0; ci < nch; ++ci) {
                RS_ISSUE(ci + RS_SLOTS - 1);
                if (lw < 3) asm volatile("s_waitcnt vmcnt(32)" ::: "memory"); else asm volatile("s_waitcnt vmcnt(24)" ::: "memory");
                __builtin_amdgcn_s_barrier();
            }
#undef RS_ISSUE
            asm volatile("s_waitcnt vmcnt(0)" ::: "memory");
        } else {
            const int vb = w, sw = (r >> 1) & 7; f32x4 acc[4];
#pragma unroll
            for (int kb = 0; kb < 4; ++kb) acc[kb] = sp ? *(const f32x4*)(sp + (size_t)(vb * 16 + r) * 64 + kb * 16 + q * 4) : (f32x4){0.f, 0.f, 0.f, 0.f};
            const bf16x8 zfrag = (bf16x8){0, 0, 0, 0, 0, 0, 0, 0};
            __builtin_amdgcn_s_barrier();
            for (int ci = 0; ci < nch; ++ci) {
                const LAS bf16_t* blob = (const LAS bf16_t*)(ring + (ci % RS_SLOTS) * RS_SLOT_B);
                bf16x8 mf[4][2], khf[4], qpf[2];
#pragma unroll
                for (int kb = 0; kb < 4; ++kb) { mf[kb][0] = *(const LAS bf16x8*)(blob + (kb * 16 + r) * 64 + ((q ^ sw) * 8)); mf[kb][1] = *(const LAS bf16x8*)(blob + (kb * 16 + r) * 64 + (((4 + q) ^ sw) * 8));
                    khf[kb] = q < 2 ? *(const LAS bf16x8*)(blob + RB_KHP + (kb * 16 + r) * 16 + q * 8) : zfrag; }
                qpf[0] = *(const LAS bf16x8*)(blob + RB_QP + r * 64 + ((q ^ sw) * 8)); qpf[1] = *(const LAS bf16x8*)(blob + RB_QP + r * 64 + (((4 + q) ^ sw) * 8));
                const bf16x8 vt = q < 2 ? *(const LAS bf16x8*)(blob + RB_VT + (vb * 16 + r) * 16 + q * 8) : zfrag;
                const bf16x8 ep = q < 2 ? *(const LAS bf16x8*)(blob + RB_EP + r * 16 + q * 8) : zfrag;
                const bf16x8 t0 = pack_acc(acc[0], acc[1]), t1 = pack_acc(acc[2], acc[3]);
                __builtin_amdgcn_sched_barrier(0);
#pragma unroll
                for (int kb = 0; kb < 4; ++kb) acc[kb] = mma16(mf[kb][0], t0, (f32x4){0.f, 0.f, 0.f, 0.f});
#pragma unroll
                for (int kb = 0; kb < 4; ++kb) acc[kb] = mma16(mf[kb][1], t1, acc[kb]);
#pragma unroll
                for (int kb = 0; kb < 4; ++kb) acc[kb] = mma16(khf[kb], vt, acc[kb]);
                f32x4 y = mma16(t0, qpf[0], (f32x4){0.f, 0.f, 0.f, 0.f}); y = mma16(t1, qpf[1], y); y = mma16(vt, ep, y);
                if (r < ntok) { u32x2 o; o.x = pk2(y[0], y[1]); o.y = pk2(y[2], y[3]); *(u32x2*)(OB + (size_t)(row0 + ci * 16 + r) * BW + h * 64 + vb * 16 + q * 4) = o; }
                asm volatile("s_waitcnt lgkmcnt(0)" ::: "memory");
                __builtin_amdgcn_s_barrier();
            }
#pragma unroll
            for (int kb = 0; kb < 4; ++kb) *(f32x4*)(op + (size_t)(vb * 16 + r) * 64 + kb * 16 + q * 4) = acc[kb];
        }
        __syncthreads();
    }
}
__device__ __forceinline__ void ph_rwkv_fin(const Ctx& c, const float* __restrict__ RW, const float* __restrict__ lng, const float* __restrict__ lnb, const bf16_t* __restrict__ RAW, bf16_t* __restrict__ OB) {
    const int lane = c.lane; const bf16_t* G = (const bf16_t*)(RW + 6 * (size_t)MPAD * BW); const bf16_t* BON = (const bf16_t*)(RW + 7 * (size_t)MPAD * BW);
    for (int i = c.bid * 8 + c.wave; i < MT * 2; i += c.G * 8) {
        const int row = i >> 1, cc = (i & 1) * 512 + lane * 8; const size_t o = (size_t)row * BW + cc;
        float x[8], bo[8], gt[8]; unpack8(*(const u32x4*)(RAW + o), x); unpack8(*(const u32x4*)(BON + o), bo); unpack8(*(const u32x4*)(G + o), gt);
        float s = 0.f;
#pragma unroll
        for (int j = 0; j < 8; ++j) s += x[j];
        s += __shfl_xor(s, 1, 64); s += __shfl_xor(s, 2, 64); s += __shfl_xor(s, 4, 64);
        const float mean = s * (1.0f / 64.0f); float qq = 0.f;
#pragma unroll
        for (int j = 0; j < 8; ++j) { const float d = x[j] - mean; qq += d * d; }
        qq += __shfl_xor(qq, 1, 64); qq += __shfl_xor(qq, 2, 64); qq += __shfl_xor(qq, 4, 64);
        const float rstd = rsqrtf(qq * (1.0f / 64.0f) + 64e-5f);
        const f32x4 g0 = *(const f32x4*)(lng + cc), g1 = *(const f32x4*)(lng + cc + 4), b0 = *(const f32x4*)(lnb + cc), b1 = *(const f32x4*)(lnb + cc + 4); float ov[8];
#pragma unroll
        for (int j = 0; j < 8; ++j) ov[j] = ((x[j] - mean) * rstd * (j < 4 ? g0[j] : g1[j - 4]) + (j < 4 ? b0[j] : b1[j - 4]) + bo[j]) * gt[j];
        *(u32x4*)(OB + o) = (u32x4){pk2(ov[0], ov[1]), pk2(ov[2], ov[3]), pk2(ov[4], ov[5]), pk2(ov[6], ov[7])};
    }
}

__device__ __forceinline__ void ph_memattn_sample(const Ctx& c, int boff, const bf16_t* __restrict__ U, const float* __restrict__ mk, const float* __restrict__ mv, bf16_t* __restrict__ OB) {
    LAS float* ps = (LAS float*)c.lds;
    const int hh = c.tid >> 8, vt = c.tid & 255, lane = c.lane, r = lane & 15, q = lane >> 4, w4 = c.wave & 3;
    for (int u = (c.bid - boff + c.G) % c.G; u < SB * 2; u += c.G) {
        const int sq = u >> 1, h = (u & 1) * 2 + hh;
        bf16x8 qf[8];
#pragma unroll
        for (int ks = 0; ks < 8; ++ks) { u32x4 raw = (u32x4){0u, 0u, 0u, 0u};
            if (r < 4) raw = *(const u32x4*)(U + (size_t)(MP + sq * SS + r) * NINP + U_MQ + h * 256 + ks * 32 + q * 8);
            qf[ks] = __builtin_bit_cast(bf16x8, raw); }
#pragma unroll 1
        for (int mt = 0; mt < 4; ++mt) { const float* kr = mk + (((size_t)sq * MEMT + (w4 * 4 + mt) * 16 + r) * 4 + h) * 256 + q * 8; f32x4 ka[8], kb2[8];
#pragma unroll
            for (int ks = 0; ks < 8; ++ks) { ka[ks] = *(const f32x4*)(kr + ks * 32); kb2[ks] = *(const f32x4*)(kr + ks * 32 + 4); }
            __builtin_amdgcn_sched_barrier(0);
            f32x4 d = (f32x4){0.f, 0.f, 0.f, 0.f};
#pragma unroll
            for (int ks = 0; ks < 8; ++ks) { u32x4 p; p.x = pk2(ka[ks][0], ka[ks][1]); p.y = pk2(ka[ks][2], ka[ks][3]); p.z = pk2(kb2[ks][0], kb2[ks][1]); p.w = pk2(kb2[ks][2], kb2[ks][3]);
                d = mma16(__builtin_bit_cast(bf16x8, p), qf[ks], d); }
            if (r < 4) *(LAS f32x4*)(ps + (hh * 4 + r) * 256 + (w4 * 4 + mt) * 16 + q * 4) = d * 0.0625f; }
        __syncthreads();
        { LAS float* pr = ps + c.wave * 256; float x[4]; float mx = -3.0e38f;
#pragma unroll
            for (int j = 0; j < 4; ++j) { x[j] = pr[lane + 64 * j]; mx = fmaxf(mx, x[j]); }
            mx = wave_max(mx); float s = 0.f;
#pragma unroll
            for (int j = 0; j < 4; ++j) { x[j] = __expf(x[j] - mx); s += x[j]; }
            const float inv = 1.0f / wave_sum(s);
#pragma unroll
            for (int j = 0; j < 4; ++j) pr[lane + 64 * j] = x[j] * inv; }
        __syncthreads();
        { float o[4] = {0.f, 0.f, 0.f, 0.f}; const float* vr = mv + ((size_t)sq * MEMT * 4 + h) * 256 + vt;
#pragma unroll 8
            for (int m = 0; m < MEMT; ++m) { const float vv = vr[(size_t)m * 1024];
#pragma unroll
                for (int t = 0; t < 4; ++t) o[t] += ps[(hh * 4 + t) * 256 + m] * vv; }
#pragma unroll
            for (int t = 0; t < 4; ++t) OB[(size_t)(MP + sq * SS + t) * BW + h * 256 + vt] = f2bf(o[t]); }
        __syncthreads();
    }
}

template <int K, int LDA, int LDB> __device__ __forceinline__ void skinny_pair(const Ctx& c, const bf16_t* __restrict__ A, const bf16_t* __restrict__ B0, const bf16_t* __restrict__ B1, f32x4 (&out)[2], int rot) {
    LAS f32x4* red = (LAS f32x4*)c.lds;
    const int lane = c.lane, r = lane & 15, q = lane >> 4, w = c.wave;
    constexpr int KS = K / 8;
    const bf16_t* ap = A + (size_t)r * LDA + w * KS + q * 8; const bf16_t* b0 = B0 + (size_t)r * LDB + w * KS + q * 8; const bf16_t* b1 = B1 + (size_t)r * LDB + w * KS + q * 8;
    f32x4 acc[2][8];
#pragma unroll
    for (int n = 0; n < 2; ++n)
#pragma unroll
        for (int m = 0; m < 8; ++m) acc[n][m] = (f32x4){0.f, 0.f, 0.f, 0.f};
    int kk = (int)((unsigned)rot % (unsigned)(KS / 32));
#pragma unroll 2
    for (int it = 0; it < KS / 32; ++it) { const int ks = kk; kk = kk + 1 == KS / 32 ? 0 : kk + 1;
        const bf16x8 f0 = *(const bf16x8*)(b0 + ks * 32), f1 = *(const bf16x8*)(b1 + ks * 32); bf16x8 af[8];
#pragma unroll
        for (int m = 0; m < 8; ++m) af[m] = *(const bf16x8*)(ap + (size_t)(m * 16) * LDA + ks * 32);
        __builtin_amdgcn_sched_barrier(0);
#pragma unroll
        for (int m = 0; m < 8; ++m) { acc[0][m] = mma16(f0, af[m], acc[0][m]); acc[1][m] = mma16(f1, af[m], acc[1][m]); } }
    __syncthreads();
#pragma unroll
    for (int n = 0; n < 2; ++n)
#pragma unroll
        for (int m = 0; m < 8; ++m) red[(w * 16 + n * 8 + m) * 64 + lane] = acc[n][m];
    __syncthreads();
#pragma unroll
    for (int n = 0; n < 2; ++n) { f32x4 s = red[(n * 8 + w) * 64 + lane];
#pragma unroll
        for (int ww = 1; ww < 8; ++ww) s += red[(ww * 16 + n * 8 + w) * 64 + lane];
        out[n] = s; }
}
template <int K, int LDA, int LDB> __device__ __forceinline__ f32x4 skinny_one(const Ctx& c, const bf16_t* __restrict__ A, const bf16_t* __restrict__ B0, int rot) {
    LAS f32x4* red = (LAS f32x4*)c.lds;
    const int lane = c.lane, r = lane & 15, q = lane >> 4, w = c.wave;
    constexpr int KS = K / 8, NK = KS / 32;
    const bf16_t* ap = A + (size_t)r * LDA + w * KS + q * 8; const bf16_t* b0 = B0 + (size_t)r * LDB + w * KS + q * 8;
    f32x4 acc[8];
#pragma unroll
    for (int m = 0; m < 8; ++m) acc[m] = (f32x4){0.f, 0.f, 0.f, 0.f};
    int kk = (int)((unsigned)rot % (unsigned)NK);
#pragma unroll 4
    for (int it = 0; it < NK; ++it) { const int ks = kk; kk = kk + 1 == NK ? 0 : kk + 1;
        const bf16x8 f0 = *(const bf16x8*)(b0 + ks * 32); bf16x8 af[8];
#pragma unroll
        for (int m = 0; m < 8; ++m) af[m] = *(const bf16x8*)(ap + (size_t)(m * 16) * LDA + ks * 32);
        __builtin_amdgcn_sched_barrier(0);
#pragma unroll
        for (int m = 0; m < 8; ++m) acc[m] = mma16(f0, af[m], acc[m]); }
    __syncthreads();
#pragma unroll
    for (int m = 0; m < 8; ++m) red[(w * 8 + m) * 64 + lane] = acc[m];
    __syncthreads();
    f32x4 s = red[w * 64 + lane];
#pragma unroll
    for (int ww = 1; ww < 8; ++ww) s += red[(ww * 8 + w) * 64 + lane];
    return s;
}
template <int K, int LDA, int LDB> __device__ __forceinline__ f32x4 skinny_half(const Ctx& c, const bf16_t* __restrict__ A, const bf16_t* __restrict__ B0) {
    LAS f32x4* red = (LAS f32x4*)c.lds;
    const int lane = c.lane, r = lane & 15, q = lane >> 4, w = c.wave;
    constexpr int KS = K / 8, NK = KS / 32;
    const bf16_t* ap = A + (size_t)r * LDA + w * KS + q * 8; const bf16_t* b0 = B0 + (size_t)r * LDB + w * KS + q * 8;
    f32x4 acc[4];
#pragma unroll
    for (int m = 0; m < 4; ++m) acc[m] = (f32x4){0.f, 0.f, 0.f, 0.f};
#pragma unroll 4
    for (int ks = 0; ks < NK; ++ks) {
        const bf16x8 f0 = *(const bf16x8*)(b0 + ks * 32); bf16x8 af[4];
#pragma unroll
        for (int m = 0; m < 4; ++m) af[m] = *(const bf16x8*)(ap + (size_t)(m * 16) * LDA + ks * 32);
        __builtin_amdgcn_sched_barrier(0);
#pragma unroll
        for (int m = 0; m < 4; ++m) acc[m] = mma16(f0, af[m], acc[m]); }
    __syncthreads();
#pragma unroll
    for (int m = 0; m < 4; ++m) red[(w * 4 + m) * 64 + lane] = acc[m];
    __syncthreads();
    f32x4 s = (f32x4){0.f, 0.f, 0.f, 0.f};
    if (w < 4) { s = red[w * 64 + lane];
#pragma unroll
        for (int ww = 1; ww < 8; ++ww) s += red[(ww * 4 + w) * 64 + lane]; }
    return s;
}
__device__ __forceinline__ u32x2 pk4(const f32x4 v) { u32x2 o; o.x = pk2(v[0], v[1]); o.y = pk2(v[2], v[3]); return o; }
#define SKINNY_LOOP(total_) for (int s = c.bid - base; s >= 0 && s < (total_); s += ncu)
__device__ __forceinline__ void ph_sk_in(const Ctx& c, int base, int ncu, const bf16_t* __restrict__ HB, const bf16_t* __restrict__ W, bf16_t* __restrict__ U) {
    const int r = c.lane & 15, q = c.lane >> 4, w = c.wave;
    SKINNY_LOOP(NINP / 32) { f32x4 o[2]; skinny_pair<DM, DM, DM>(c, HB + (size_t)MP * DM, W + (size_t)(s * 32) * DM, W + (size_t)(s * 32 + 16) * DM, o, s);
        bf16_t* up = U + (size_t)(MP + w * 16 + r) * NINP + s * 32 + q * 4; *(u32x2*)up = pk4(o[0]); *(u32x2*)(up + 16) = pk4(o[1]); }
}
__device__ __forceinline__ void ph_sk_merge(const Ctx& c, int base, int ncu, const bf16_t* __restrict__ BR, const bf16_t* __restrict__ W, const bf16_t* __restrict__ U, const float* __restrict__ gate_b, bf16_t* __restrict__ MGB) {
    const int r = c.lane & 15, q = c.lane >> 4, w = c.wave;
    SKINNY_LOOP(DM / 8) { const int ct = s >> 1, hf = s & 1; const size_t row = (size_t)(MP + hf * 64 + (w & 3) * 16 + r); const int col = ct * 16 + q * 4; f32x4 tot = (f32x4){0.f, 0.f, 0.f, 0.f};
#pragma unroll 1
        for (int z = 0; z < 4; ++z) { const f32x4 o = skinny_half<BW, BW, BW>(c, BR + ((size_t)z * MPAD + MP + hf * 64) * BW, W + ((size_t)z * DM + ct * 16) * BW);
            if (w < 4) { const u32x2 gp = *(const u32x2*)(U + row * NINP + U_GP + z * DM + col); const f32x4 gb = *(const f32x4*)(gate_b + z * DM + col);
            tot[0] += sigmoidf_(__uint_as_float(gp.x << 16) + gb[0]) * o[0]; tot[1] += sigmoidf_(__uint_as_float(gp.x & 0xffff0000u) + gb[1]) * o[1];
            tot[2] += sigmoidf_(__uint_as_float(gp.y << 16) + gb[2]) * o[2]; tot[3] += sigmoidf_(__uint_as_float(gp.y & 0xffff0000u) + gb[3]) * o[3]; } }
        if (w < 4) *(u32x2*)(MGB + row * DM + col) = pk4(tot); }
}
template <int K> __device__ __forceinline__ void ph_sk_res(const Ctx& c, int base, int ncu, const bf16_t* __restrict__ A, const bf16_t* __restrict__ W, const bf16_t* __restrict__ R, bf16_t* __restrict__ Y) {
    const int r = c.lane & 15, q = c.lane >> 4, w = c.wave;
    SKINNY_LOOP(DM / 8) { const int ct = s >> 1, hf = s & 1; const f32x4 o = skinny_half<K, K, K>(c, A + (size_t)(MP + hf * 64) * K, W + (size_t)(ct * 16) * K);
        if (w < 4) { const size_t off = (size_t)(MP + hf * 64 + w * 16 + r) * DM + ct * 16 + q * 4; const u32x2 rr = *(const u32x2*)(R + off);
        const f32x4 rv = (f32x4){__uint_as_float(rr.x << 16), __uint_as_float(rr.x & 0xffff0000u), __uint_as_float(rr.y << 16), __uint_as_float(rr.y & 0xffff0000u)};
        *(u32x2*)(Y + off) = pk4(rv * ALPHA + o); } }
}
__device__ __forceinline__ void ph_sk_gu(const Ctx& c, int base, int ncu, const bf16_t* __restrict__ X1B, const bf16_t* __restrict__ W, bf16_t* __restrict__ ACT) {
    const int r = c.lane & 15, q = c.lane >> 4, w = c.wave;
    SKINNY_LOOP(DFF / 16) { const int t = s >> 3, j0 = (s & 7) * 16; f32x4 o[2];
        skinny_pair<DM, DM, DM>(c, X1B + (size_t)MP * DM, W + (size_t)(t * 256 + j0) * DM, W + (size_t)(t * 256 + 128 + j0) * DM, o, s);
        f32x4 v;
#pragma unroll
        for (int j = 0; j < 4; ++j) v[j] = o[0][j] * sigmoidf_(o[0][j]) * o[1][j];
        *(u32x2*)(ACT + (size_t)(MP + w * 16 + r) * DFF + t * 128 + j0 + q * 4) = pk4(v); }
}
#undef SKINNY_LOOP

constexpr int LDS_BAR_OFF = 153600;
constexpr int LDS_BYTES = LDS_BAR_OFF + 64;
struct Args { const float* in[37]; float* out; unsigned char* ws; };

typedef pg8::Gemm<DM, DM, DM, 2, 8, NL, 1, false, 0, 0, (long)DM * DM, 0> GemmMem;
typedef pg8::Gemm<DM, DM, DM, MP / 256, NINP / 256> GemmIn;
typedef pg8::Gemm<NINP, 1024, 256, PS / 256, 1, 8, 4, false, (long)PS * NINP, 256, 256 * 1024, 256> GemmScore;
typedef pg8::Gemm<256, 256, 256, PS / 256, 1, 8, 4, false, (long)4 * 4096 * 256, (long)4096 * 256, 4 * 65536, 65536> GemmPV;
typedef pg8::Gemm<BW, BW, BW, MP / 256, DM / 256, 4, 1, true, (long)MPAD * BW, 0, (long)DM * BW, 0> GemmBranch;
typedef pg8::Gemm<DM, DM, DM, MP / 256, DM / 256> GemmOut;
typedef pg8::Gemm<DM, DM, DM, MP / 256, 2 * DFF / 256> GemmGU;
typedef pg8::Gemm<DFF, DFF, DFF, MP / 256, DM / 256> GemmDown;
template <class GT> __device__ __forceinline__ GT mk_gemm(const Ctx& c, const bf16_t* A, const bf16_t* B) { GT g; g.A = A; g.B = B; g.G = c.G; g.c = c.bid; return g; }

template <int OFF> __device__ __forceinline__ unsigned long long karg_u64(unsigned long long kargs) {
    unsigned long long p; asm volatile("s_load_dwordx2 %0, %1, %2\n\ts_waitcnt lgkmcnt(0)" : "=s"(p) : "s"(kargs), "n"(OFF) : "memory"); return p;
}
#define GPTR(T, x) ((T*)(__attribute__((address_space(1))) T*)(x))
#define INP(k) GPTR(const float, karg_u64<(k) * 8>(kargs))
#define OUTP() GPTR(float, karg_u64<37 * 8>(kargs))
#define WSP() GPTR(unsigned char, karg_u64<38 * 8>(kargs))

__global__ void __launch_bounds__(512, 2) mega_fwd(Args a_unused) {
    extern __shared__ __attribute__((aligned(16))) unsigned char lds_raw[];
    const unsigned long long kargs = (unsigned long long)__builtin_amdgcn_kernarg_segment_ptr();
    Ctx c0; c0.tid = threadIdx.x; c0.lane = c0.tid & 63; c0.wave = __builtin_amdgcn_readfirstlane(c0.tid >> 6); c0.bid = blockIdx.x; c0.G = gridDim.x; c0.lds = (LAS unsigned char*)lds_raw;
    if (c0.tid < 4) ((LAS unsigned*)(c0.lds + LDS_BAR_OFF))[c0.tid] = 0u;
    __syncthreads();
    const XcdBarrier bar = xcd_barrier_post((unsigned*)(WSP() + WS_CTL), (volatile LAS unsigned*)(c0.lds + LDS_BAR_OFF));

#define WP_SIDE 2
#define WP_GLA 3
#define WP_RW 2
#define XBAR() do { const Ctx cb_ = fresh(c0); xcd_barrier(bar, cb_.tid == 0); } while (0)
#define WPREP_WIN(cc_, L_) do { unsigned char* ws_ = WSP(); \
      ph_wprep(cc_, INP(10) + (size_t)(L_) * DM * NIN, (bf16_t*)(ws_ + WS_WIN) + (size_t)(L_) * NINP * DM, DM, NIN, NINP, 1, 1, 0, 0); } while (0)
#define WPREP_LAYER(cc_, L_) do { WPREP_WIN(cc_, L_); WPREP_REST(cc_, L_); } while (0)
#define WPREP_REST(cc_, L_) do { unsigned char* ws_ = WSP(); \
      ph_wprep(cc_, INP(29) + (size_t)(L_) * 4 * BW * DM, (bf16_t*)(ws_ + WS_WBR) + (size_t)(L_) * 4 * DM * BW, BW, DM, DM, 0, 4, (size_t)BW * DM, (size_t)DM * BW); \
      ph_wprep(cc_, INP(30) + (size_t)(L_) * DM * DM, (bf16_t*)(ws_ + WS_WOUT) + (size_t)(L_) * DM * DM, DM, DM, DM, 0, 1, 0, 0); \
      ph_wprep(cc_, INP(33) + (size_t)(L_) * DM * 2 * DFF, (bf16_t*)(ws_ + WS_WGU) + (size_t)(L_) * 2 * DFF * DM, DM, 2 * DFF, 2 * DFF, 2, 1, 0, 0); \
      ph_wprep(cc_, INP(34) + (size_t)(L_) * DFF * DM, (bf16_t*)(ws_ + WS_WDN) + (size_t)(L_) * DM * DFF, DFF, DM, DM, 0, 1, 0, 0); } while (0)
    { const Ctx c = fresh(c0); unsigned char* ws = WSP();
      ph_wprep(c, INP(28), (bf16_t*)(ws + WS_WMEM), DM, DM, DM, 0, NL, (size_t)DM * DM, (size_t)DM * DM);
      WPREP_WIN(c, 0);
      ph_lrw(c, INP(19), INP(21), INP(22), (bf16_t*)(ws + WS_LRW));
      ph_xprep(c, INP(0), INP(1), INP(2), (float*)nullptr, (bf16_t*)(ws + WS_HB), (bf16_t*)(ws + WS_MEMB)); }
    XBAR();
    if (c0.bid >= 64) { Ctx c = fresh(c0); c.bid -= 64; c.G -= 64; WPREP_REST(c, 0); }
    { const Ctx c = fresh(c0); unsigned char* ws = WSP(); float* out = OUTP();
      GemmMem g = mk_gemm<GemmMem>(c, (const bf16_t*)(ws + WS_MEMB), (const bf16_t*)(ws + WS_WMEM));
      pg8::EpiMem E; E.outK = out + O_MKP; E.outV = out + O_MVP; E.kb = (bf16_t*)(ws + WS_MKB); E.vt = (bf16_t*)(ws + WS_MVT); pg8::gemm_phase<GemmMem, pg8::EpiMem, true, true>(c.lds, c.tid, g, E); }

    for (int l = 0; l < NL; ++l) {
        { const Ctx c = fresh(c0); unsigned char* ws = WSP();
          GemmIn g = mk_gemm<GemmIn>(c, (const bf16_t*)(ws + WS_HB), (const bf16_t*)(ws + WS_WIN) + (size_t)l * NINP * DM);
          pg8::EpiBf16 E; E.O = (bf16_t*)(ws + WS_U); E.zs = 0; E.ldc = NINP; E.pad = 0; pg8::gemm_phase<GemmIn, pg8::EpiBf16, true, true>(c.lds, c.tid, g, E); }
        { const Ctx c = fresh(c0); unsigned char* ws = WSP(); ph_sk_in(c, c.G > 192 ? 96 : 0, c.G > 192 ? c.G - 96 : c.G, (const bf16_t*)(ws + WS_HB), (const bf16_t*)(ws + WS_WIN) + (size_t)l * NINP * DM, (bf16_t*)(ws + WS_U)); }
        XBAR();
        { const Ctx c = fresh(c0); unsigned char* ws = WSP(); float* out = OUTP(); const bf16_t* U = (const bf16_t*)(ws + WS_U); bf16_t* BR = (bf16_t*)(ws + WS_BR);
          (void)out; (void)BR;
          ph_gla_pre(c, U, INP(12) + (size_t)l * 16 * 512, INP(13) + (size_t)l * 512, (bf16_t*)(ws + WS_GLQD), (bf16_t*)(ws + WS_GLKH), (bf16_t*)(ws + WS_GLE), (bf16_t*)(ws + WS_GLVT), (float*)(ws + WS_GLGC)); }
        { const Ctx c = fresh(c0); unsigned char* ws = WSP();
          ph_rwkv_pre(c, (const bf16_t*)(ws + WS_U), INP(9) + (size_t)l * SB * RWC, INP(17) + (size_t)l * RWC, INP(18) + (size_t)l * BW, INP(19) + (size_t)l * 64 * BW, INP(20) + (size_t)l * BW, INP(21) + (size_t)l * 64 * BW,
                       INP(22) + (size_t)l * 128 * BW, INP(23) + (size_t)l * BW, INP(24) + (size_t)l * BW, INP(25) + (size_t)l * BW, (float*)(ws + WS_RW), (bf16_t*)(ws + WS_RB), (const bf16_t*)(ws + WS_LRW) + (size_t)l * 1024 * 256); }
        { const Ctx c = fresh(c0); unsigned char* ws = WSP(); ph_memattn_prompt(c, (const bf16_t*)(ws + WS_U), (const bf16_t*)(ws + WS_MKB) + (size_t)l * 512 * 1024, (const bf16_t*)(ws + WS_MVT) + (size_t)l * 8 * 65536, (bf16_t*)(ws + WS_BR) + (size_t)3 * MPAD * BW); }
        XBAR();
        { const Ctx c = fresh(c0); unsigned char* ws = WSP(); float* out = OUTP();
          ph_rwkv_seq(c, 64, (const bf16_t*)(ws + WS_RB), INP(8) + (size_t)l * SB * 16 * 4096, out + O_RWP + (size_t)l * PB * 16 * 4096, out + O_RWS + (size_t)l * SB * 16 * 4096,
                      (bf16_t*)(ws + WS_RAW) + (size_t)MPAD * BW); }
        { const Ctx c = fresh(c0); unsigned char* ws = WSP(); float* out = OUTP();
          ph_gla_seq(c, 32, (const bf16_t*)(ws + WS_GLQD), (const bf16_t*)(ws + WS_GLKH), (const bf16_t*)(ws + WS_GLE), (const bf16_t*)(ws + WS_GLVT), (const float*)(ws + WS_GLGC),
                     INP(7) + (size_t)l * SB * 4 * 32768, out + O_GLAP + (size_t)l * PB * 4 * 32768, out + O_GLAS + (size_t)l * SB * 4 * 32768, (bf16_t*)(ws + WS_RAW)); }
        if ((c0.bid < 32 || c0.bid >= 96) && c0.G > 96) {
        { Ctx c = fresh(c0); c.bid = c.bid < 32 ? c.bid : c.bid - 64; c.G = c.G - 64; unsigned char* ws = WSP(); ph_swa_prompt(c, (const bf16_t*)(ws + WS_U), INP(16) + (size_t)l * 16, (bf16_t*)(ws + WS_BR) + (size_t)MPAD * BW); }
        { Ctx c = fresh(c0); c.bid = c.bid < 32 ? c.bid : c.bid - 64; c.G = c.G - 64; if (c.G > 128) c.bid = (c.bid + c.G - 128) % c.G;
          unsigned char* ws = WSP();
          ph_swa_sample(c, (const bf16_t*)(ws + WS_U), INP(3) + (size_t)l * SB * 16384, INP(4) + (size_t)l * SB * 16384, INP(16) + (size_t)l * 16, (bf16_t*)(ws + WS_BR) + (size_t)MPAD * BW); }
        { Ctx c = fresh(c0); c.bid = c.bid < 32 ? c.bid : c.bid - 64; c.G = c.G - 64; unsigned char* ws = WSP();
          ph_memattn_sample(c, 64, (const bf16_t*)(ws + WS_U), INP(5) + (size_t)l * SB * MEMT * 1024, INP(6) + (size_t)l * SB * MEMT * 1024, (bf16_t*)(ws + WS_BR) + (size_t)3 * MPAD * BW); }
        { Ctx c = fresh(c0); c.bid = c.bid < 32 ? c.bid : c.bid - 64; c.G = c.G - 64; unsigned char* ws = WSP();
          ph_copy_outs(c, (const bf16_t*)(ws + WS_U), INP(3) + (size_t)l * SB * 16384, INP(4) + (size_t)l * SB * 16384, OUTP(), l); }
        }
        if (l + 1 < NL) { const Ctx c = fresh(c0); unsigned char* ws = WSP(); const int L = l + 1;
          ph_wprep_dyn(c, (unsigned*)(ws + WS_CTL + 16384) + 64 * L,
                       INP(10) + (size_t)L * DM * NIN, INP(29) + (size_t)L * 4 * BW * DM, INP(30) + (size_t)L * DM * DM, INP(33) + (size_t)L * DM * 2 * DFF, INP(34) + (size_t)L * DFF * DM,
                       (bf16_t*)(ws + WS_WIN) + (size_t)L * NINP * DM, (bf16_t*)(ws + WS_WBR) + (size_t)L * 4 * DM * BW, (bf16_t*)(ws + WS_WOUT) + (size_t)L * DM * DM,
                       (bf16_t*)(ws + WS_WGU) + (size_t)L * 2 * DFF * DM, (bf16_t*)(ws + WS_WDN) + (size_t)L * DM * DFF); }
        XBAR();
        { const Ctx c = fresh(c0); unsigned char* ws = WSP(); ph_rwkv_fin(c, (const float*)(ws + WS_RW), INP(26) + (size_t)l * BW, INP(27) + (size_t)l * BW, (const bf16_t*)(ws + WS_RAW) + (size_t)MPAD * BW, (bf16_t*)(ws + WS_BR) + (size_t)2 * MPAD * BW); }
        { const Ctx c = fresh(c0); unsigned char* ws = WSP(); ph_gla_fin(c, (const bf16_t*)(ws + WS_U), INP(14) + (size_t)l * BW, INP(15) + (size_t)l * BW, (const bf16_t*)(ws + WS_RAW), (bf16_t*)(ws + WS_BR)); }
        XBAR();
        { const Ctx c = fresh(c0); unsigned char* ws = WSP();
          GemmBranch g = mk_gemm<GemmBranch>(c, (const bf16_t*)(ws + WS_BR), (const bf16_t*)(ws + WS_WBR) + (size_t)l * 4 * DM * BW);
          pg8::EpiMerge E; E.MG = (float*)(ws + WS_MG); E.MGB = (bf16_t*)(ws + WS_MGB); E.U = (const bf16_t*)(ws + WS_U); E.gate_b = INP(11) + (size_t)l * 4 * DM; pg8::gemm_phase<GemmBranch, pg8::EpiMerge, true, true>(c.lds, c.tid, g, E); }
        { const Ctx c = fresh(c0); unsigned char* ws = WSP(); ph_sk_merge(c, 0, c.G, (const bf16_t*)(ws + WS_BR), (const bf16_t*)(ws + WS_WBR) + (size_t)l * 4 * DM * BW, (const bf16_t*)(ws + WS_U), INP(11) + (size_t)l * 4 * DM, (bf16_t*)(ws + WS_MGB)); }
        XBAR();
        { const Ctx c = fresh(c0); unsigned char* ws = WSP();
          GemmOut g = mk_gemm<GemmOut>(c, (const bf16_t*)(ws + WS_MGB), (const bf16_t*)(ws + WS_WOUT) + (size_t)l * DM * DM);
          pg8::EpiRes E; E.R = (const bf16_t*)(ws + WS_HB); E.Y = (bf16_t*)(ws + WS_Y); pg8::gemm_phase<GemmOut, pg8::EpiRes, true, true>(c.lds, c.tid, g, E); }
        { const Ctx c = fresh(c0); unsigned char* ws = WSP(); ph_sk_res<DM>(c, 0, c.G, (const bf16_t*)(ws + WS_MGB), (const bf16_t*)(ws + WS_WOUT) + (size_t)l * DM * DM, (const bf16_t*)(ws + WS_HB), (bf16_t*)(ws + WS_Y)); }
        XBAR();
        { const Ctx c = fresh(c0); unsigned char* ws = WSP(); ph_ln(c, (const bf16_t*)(ws + WS_Y), INP(31) + (size_t)l * DM, INP(32) + (size_t)l * DM, (float*)nullptr, (bf16_t*)(ws + WS_X1B), nullptr, MT, 0); }
        XBAR();
        { const Ctx c = fresh(c0); unsigned char* ws = WSP();
          GemmGU g = mk_gemm<GemmGU>(c, (const bf16_t*)(ws + WS_X1B), (const bf16_t*)(ws + WS_WGU) + (size_t)l * 2 * DFF * DM);
          pg8::EpiSwiGLU E; E.O = (bf16_t*)(ws + WS_ACT); pg8::gemm_phase<GemmGU, pg8::EpiSwiGLU, true, true>(c.lds, c.tid, g, E); }
        { const Ctx c = fresh(c0); unsigned char* ws = WSP(); ph_sk_gu(c, c.G > 192 ? 128 : 0, c.G > 192 ? c.G - 128 : c.G, (const bf16_t*)(ws + WS_X1B), (const bf16_t*)(ws + WS_WGU) + (size_t)l * 2 * DFF * DM, (bf16_t*)(ws + WS_ACT)); }
        XBAR();
        { const Ctx c = fresh(c0); unsigned char* ws = WSP();
          GemmDown g = mk_gemm<GemmDown>(c, (const bf16_t*)(ws + WS_ACT), (const bf16_t*)(ws + WS_WDN) + (size_t)l * DM * DFF);
          pg8::EpiRes E; E.R = (const bf16_t*)(ws + WS_X1B); E.Y = (bf16_t*)(ws + WS_Y); pg8::gemm_phase<GemmDown, pg8::EpiRes, true, true>(c.lds, c.tid, g, E); }
        { const Ctx c = fresh(c0); unsigned char* ws = WSP(); ph_sk_res<DFF>(c, 0, c.G, (const bf16_t*)(ws + WS_ACT), (const bf16_t*)(ws + WS_WDN) + (size_t)l * DM * DFF, (const bf16_t*)(ws + WS_X1B), (bf16_t*)(ws + WS_Y)); }
        XBAR();
        { const Ctx c = fresh(c0); unsigned char* ws = WSP(); float* out = OUTP(); ph_ln(c, (const bf16_t*)(ws + WS_Y), INP(35) + (size_t)l * DM, INP(36) + (size_t)l * DM, (float*)nullptr, (bf16_t*)(ws + WS_HB), l == NL - 1 ? out : nullptr, MT, MT); }
        XBAR();
    }
}

extern "C" void kernel_launch(void* const* d_in, const int* in_sizes, int n_in, void* d_out, int out_size, void* d_ws, size_t ws_size, hipStream_t stream) {
    static int grid = 0;
    if (grid == 0) {
        if (n_in != 37 || (size_t)out_size != O_END || ws_size < WS_END) { fprintf(stderr, "kernel_launch: unexpected sizes (n_in %d out %d ws %zu need %zu)\n", n_in, out_size, ws_size, (size_t)WS_END); grid = -1; return; }
        int dev = 0, cus = 0;
        if (hipGetDevice(&dev) != hipSuccess || hipDeviceGetAttribute(&cus, hipDeviceAttributeMultiprocessorCount, dev) != hipSuccess) { grid = -1; return; }
        if (hipFuncSetAttribute((const void*)mega_fwd, hipFuncAttributeMaxDynamicSharedMemorySize, LDS_BYTES) != hipSuccess) { fprintf(stderr, "kernel_launch: hipFuncSetAttribute failed\n"); grid = -1; return; }
        int per_cu = 0;
        if (hipOccupancyMaxActiveBlocksPerMultiprocessor(&per_cu, (const void*)mega_fwd, 512, LDS_BYTES) != hipSuccess || per_cu < 1) { fprintf(stderr, "kernel_launch: occupancy query says %d\n", per_cu); }
        (void)hipGetLastError();
        grid = cus;
    }
    if (grid < 0) return;
    (void)hipMemsetAsync((unsigned char*)d_ws + WS_CTL, 0, 16384 + 1024, stream);
    Args a; memset(&a, 0, sizeof a);
    for (int i = 0; i < 37; ++i) a.in[i] = (const float*)d_in[i];
    a.out = (float*)d_out; a.ws = (unsigned char*)d_ws;
    hipLaunchKernelGGL(mega_fwd, dim3(grid), dim3(512), LDS_BYTES, stream, a);
}
```
